# Optimizing an MI355X kernel written in HIP

```python
import math
import jax
import jax.numpy as jnp
from jax import lax
import numpy as np

D_MODEL = 1024
BATCH = 4
SEQ = 8192
DEPTH = 4

CTX_LEN = 256
GRID_W = 64
EPS = 1e-6
CONV_W = D_MODEL // 4
CONV_K = 31
MLSTM_DH = 64
MLSTM_W = D_MODEL // 4
MLSTM_HEADS = MLSTM_W // MLSTM_DH
MLSTM_CHUNK = 64
DIFF_DH = 64
DIFF_DV = 2 * DIFF_DH
DIFF_W = D_MODEL // 2
DIFF_HEADS = DIFF_W // DIFF_DV
MIX_W = CONV_W + MLSTM_W + DIFF_W
Q_BLOCK = 128
ROPE_BASE = 10000.0
AXIS_ROT = DIFF_DH // 2
IN_SIZES = (2 * CONV_W, MLSTM_W, MLSTM_W, MLSTM_W, MLSTM_W, 4 * MLSTM_HEADS, 2 * DIFF_HEADS * DIFF_DH, 2 * DIFF_HEADS * DIFF_DH, DIFF_W)
IN_W = sum(IN_SIZES)
PEER_HEADS = 8
PEER_DK = 128
N_KEYS = 128
N_EXPERTS = N_KEYS * N_KEYS
PEER_TOPK = 16
TOKEN_BLOCK = 128

kernel_name = "hybrid_conv_mlstm_diffattn_peer_block"


def rmsnorm(x, g):
    xf = x.astype(jnp.float32)
    y = xf * lax.rsqrt(jnp.mean(xf * xf, axis=-1, keepdims=True) + EPS)
    return (y * g.astype(jnp.float32)).astype(x.dtype)


def layernorm(x, g, b):
    xf = x.astype(jnp.float32)
    mu = jnp.mean(xf, axis=-1, keepdims=True)
    var = jnp.mean(jnp.square(xf - mu), axis=-1, keepdims=True)
    y = (xf - mu) * lax.rsqrt(var + EPS) * g.astype(jnp.float32) + b.astype(jnp.float32)
    return y.astype(x.dtype)


def heads(t, n):
    b, l, w = t.shape
    return t.reshape(b, l, n, w // n).transpose(0, 2, 1, 3)


def merge_heads(t):
    b, n, l, d = t.shape
    return t.transpose(0, 2, 1, 3).reshape(b, l, n * d)


def pair_heads(t):
    b, l, _ = t.shape
    t = t.reshape(b, l, DIFF_HEADS, 2, DIFF_DH)
    return t[:, :, :, 0].transpose(0, 2, 1, 3), t[:, :, :, 1].transpose(0, 2, 1, 3)


def flip_seq(t, rev):
    return jnp.flip(t, axis=2) if rev else t


def axial_rope(n_tokens):
    rows = n_tokens // GRID_W
    row = jnp.repeat(jnp.arange(rows), GRID_W).astype(jnp.float32)
    col = jnp.tile(jnp.arange(GRID_W), rows).astype(jnp.float32)
    inv = ROPE_BASE ** (-jnp.arange(0, AXIS_ROT, 2, dtype=jnp.float32) / AXIS_ROT)
    ang = jnp.concatenate([row[:, None] * inv, col[:, None] * inv], axis=-1)
    return jnp.cos(ang), jnp.sin(ang)


def apply_rope(t, cos, sin):
    tp = t.reshape(t.shape[:-1] + (t.shape[-1] // 2, 2))
    t1, t2 = tp[..., 0], tp[..., 1]
    c = cos.astype(t.dtype)
    s = sin.astype(t.dtype)
    return jnp.stack([t1 * c - t2 * s, t1 * s + t2 * c], axis=-1).reshape(t.shape)


def conv_module(a, conv_w, conv_b, ln_g, ln_b):
    u = a[..., :CONV_W] * jax.nn.sigmoid(a[..., CONV_W:])
    y = lax.conv_general_dilated(u, conv_w.astype(u.dtype), window_strides=(1,),
                                 padding=[(CONV_K // 2, CONV_K // 2)],
                                 dimension_numbers=("NWC", "WIO", "NWC"),
                                 feature_group_count=CONV_W) + conv_b
    return jax.nn.silu(layernorm(y, ln_g, ln_b))


def mlstm_chunk_scan(q, k, v, ig, lf, state):
    bsz, nh, seq, dh = q.shape
    nc = seq // MLSTM_CHUNK

    def chunks(t):
        t = t.reshape(t.shape[:2] + (nc, MLSTM_CHUNK) + t.shape[3:])
        return jnp.moveaxis(t, 2, 0)

    xs = tuple(chunks(t) for t in (q, k, v, ig, lf))
    tril = jnp.tril(jnp.ones((MLSTM_CHUNK, MLSTM_CHUNK), dtype=bool))

    def step(carry, inp):
        C, n, m = carry
        qc, kc, vc, ic, fc = inp
        qf, kf, vf = qc.astype(jnp.float32), kc.astype(jnp.float32), vc.astype(jnp.float32)
        b = jnp.cumsum(fc, axis=-1)
        dlog = jnp.where(tril, b[..., :, None] - b[..., None, :] + ic[..., None, :], -jnp.inf)
        inter = b + m[..., None]
        mt = jnp.maximum(inter, jnp.max(dlog, axis=-1))
        dw = jnp.exp(dlog - mt[..., None])
        iw = jnp.exp(inter - mt)
        s = jnp.einsum("bhtd,bhsd->bhts", qf, kf) * dw
        num = jnp.einsum("bhts,bhse->bhte", s, vf) + iw[..., None] * jnp.einsum("bhed,bhtd->bhte", C, qf)
        den = jnp.sum(s, axis=-1) + iw * jnp.einsum("bhd,bhtd->bht", n, qf)
        h = num / jnp.maximum(jnp.abs(den), jnp.exp(-mt))[..., None]
        bl = b[..., -1]
        wlog = bl[..., None] - b + ic
        mn = jnp.maximum(bl + m, jnp.max(wlog, axis=-1))
        wk = jnp.exp(wlog - mn[..., None])
        decay = jnp.exp(bl + m - mn)
        C = decay[..., None, None] * C + jnp.einsum("bhs,bhse,bhsd->bhed", wk, vf, kf)
        n = decay[..., None] * n + jnp.einsum("bhs,bhsd->bhd", wk, kf)
        return (C, n, mn), h

    state, hs = lax.scan(step, state, xs)
    h = jnp.moveaxis(hs, 0, 2).reshape(bsz, nh, seq, dh)
    return h, state


def mlstm_mixer(lat, ctx, gate_b, norm_g, need_ctx):
    gb = gate_b.reshape(-1).astype(jnp.float32)

    def prep(q, k, v, g):
        b, l, _ = q.shape
        g = (g.astype(jnp.float32) + gb).reshape(b, l, 4, MLSTM_HEADS).transpose(2, 0, 3, 1)
        return heads(q, MLSTM_HEADS), heads(k, MLSTM_HEADS) * (MLSTM_DH ** -0.5), heads(v, MLSTM_HEADS), g

    ql, kl, vl, gl = prep(lat[0], lat[1], lat[2], lat[4])
    qc, kc, vc, gc = prep(ctx[0], ctx[1], ctx[2], ctx[4])
    bsz = ql.shape[0]
    outs_l, outs_c = [], []
    for d, rev in enumerate((False, True)):
        state = (jnp.zeros((bsz, MLSTM_HEADS, MLSTM_DH, MLSTM_DH), jnp.float32),
                 jnp.zeros((bsz, MLSTM_HEADS, MLSTM_DH), jnp.float32),
                 jnp.zeros((bsz, MLSTM_HEADS), jnp.float32))
        hc, state = mlstm_chunk_scan(*[flip_seq(t, rev) for t in (qc, kc, vc, gc[2 * d], jax.nn.log_sigmoid(gc[2 * d + 1]))], state)
        hl, _ = mlstm_chunk_scan(*[flip_seq(t, rev) for t in (ql, kl, vl, gl[2 * d], jax.nn.log_sigmoid(gl[2 * d + 1]))], state)
        outs_c.append(flip_seq(hc, rev))
        outs_l.append(flip_seq(hl, rev))

    def finish(h, o):
        h = merge_heads(rmsnorm(h, norm_g))
        return (h * jax.nn.sigmoid(o.astype(jnp.float32))).astype(o.dtype)

    y_lat = finish(outs_l[0] + outs_l[1], lat[3])
    y_ctx = finish(outs_c[0] + outs_c[1], ctx[3]) if need_ctx else None
    return y_lat, y_ctx


def diff_attention(q1, q2, k1, k2, v, lam):
    bsz, nh, lq, dh = q1.shape
    nb = lq // Q_BLOCK
    scale = dh ** -0.5

    def blocks(t):
        return jnp.moveaxis(t.reshape(bsz, nh, nb, Q_BLOCK, dh), 2, 0)

    def one(args):
        a1, a2 = args
        p1 = jax.nn.softmax(jnp.einsum("bhqd,bhkd->bhqk", a1, k1).astype(jnp.float32) * scale, axis=-1)
        p2 = jax.nn.softmax(jnp.einsum("bhqd,bhkd->bhqk", a2, k2).astype(jnp.float32) * scale, axis=-1)
        p = p1 - lam * p2
        return jnp.einsum("bhqk,bhkd->bhqd", p.astype(v.dtype), v)

    o = lax.map(one, (blocks(q1), blocks(q2)))
    return jnp.moveaxis(o, 0, 2).reshape(bsz, nh, lq, v.shape[-1])


def diff_mixer(lat, ctx, lam_params, lam_init, norm_g, cos, sin, need_ctx):
    dql, dkl, dvl = lat
    dqc, dkc, dvc = ctx
    lp = lam_params.astype(jnp.float32)
    lam = jnp.exp(jnp.sum(lp[0] * lp[1])) - jnp.exp(jnp.sum(lp[2] * lp[3])) + lam_init
    ql1, ql2 = (apply_rope(t, cos, sin) for t in pair_heads(dql))
    kl1, kl2 = (apply_rope(t, cos, sin) for t in pair_heads(dkl))
    qc1, qc2 = pair_heads(dqc)
    kc1, kc2 = pair_heads(dkc)
    vl = heads(dvl, DIFF_HEADS)
    vc = heads(dvc, DIFF_HEADS)
    k1 = jnp.concatenate([kc1, kl1], axis=2)
    k2 = jnp.concatenate([kc2, kl2], axis=2)
    v = jnp.concatenate([vc, vl], axis=2)

    def finish(o):
        return merge_heads(rmsnorm(o, norm_g) * (1.0 - lam_init))

    y_lat = finish(diff_attention(ql1, ql2, k1, k2, v, lam))
    y_ctx = finish(diff_attention(qc1, qc2, kc1, kc2, vc, lam)) if need_ctx else None
    return y_lat, y_ctx


def peer_ffn(h, wq, sub_keys, eu, ev):
    bsz, seq, dm = h.shape
    nb = (bsz * seq) // TOKEN_BLOCK
    hb = h.reshape(nb, TOKEN_BLOCK, dm)

    def one(t):
        q = (t @ wq).reshape(TOKEN_BLOCK, PEER_HEADS, 2, PEER_DK // 2)
        s = jnp.einsum("thpd,hpnd->thpn", q, sub_keys).astype(jnp.float32)
        st, it = lax.top_k(s, PEER_TOPK)
        cand = (st[:, :, 0, :, None] + st[:, :, 1, None, :]).reshape(TOKEN_BLOCK, PEER_HEADS, PEER_TOPK * PEER_TOPK)
        cidx = (it[:, :, 0, :, None] * N_KEYS + it[:, :, 1, None, :]).reshape(TOKEN_BLOCK, PEER_HEADS, PEER_TOPK * PEER_TOPK)
        best, pos = lax.top_k(cand, PEER_TOPK)
        e = jnp.take_along_axis(cidx, pos, axis=-1)
        g = jax.nn.softmax(best, axis=-1)
        u = jnp.take(eu, e, axis=0)
        act = jax.nn.gelu(jnp.einsum("thkd,td->thk", u, t).astype(jnp.float32), approximate=False)
        return jnp.einsum("thk,thkd->td", (g * act).astype(ev.dtype), jnp.take(ev, e, axis=0))

    return lax.map(one, hb).reshape(bsz, seq, dm)


def trunk_layer(x, xc, mod, modc, lam_init, cos, sin, need_ctx,
                norm1_g, norm2_g, w_in, conv_w, conv_b, conv_ln_g, conv_ln_b,
                mlstm_gate_b, mlstm_norm_g, diff_lambda, diff_norm_g, w_out,
                peer_wq, peer_keys, peer_u, peer_v):
    sh1, sc1, g1, sh2, sc2, g2 = [m[:, None, :] for m in jnp.split(mod, 6, axis=-1)]
    sh1c, sc1c, g1c, sh2c, sc2c, g2c = jnp.split(modc, 6, axis=-1)
    splits = np.cumsum(IN_SIZES)[:-1].tolist()
    h = rmsnorm(x, norm1_g) * (1.0 + sc1) + sh1
    hc = rmsnorm(xc, norm1_g) * (1.0 + sc1c) + sh1c
    a, mq, mk, mv, mo, mg, dq, dk, dv = jnp.split(h @ w_in, splits, axis=-1)
    ac, mqc, mkc, mvc, moc, mgc, dqc, dkc, dvc = jnp.split(hc @ w_in, splits, axis=-1)
    conv_l = conv_module(a, conv_w, conv_b, conv_ln_g, conv_ln_b)
    mlstm_l, mlstm_c = mlstm_mixer((mq, mk, mv, mo, mg), (mqc, mkc, mvc, moc, mgc), mlstm_gate_b, mlstm_norm_g, need_ctx)
    diff_l, diff_c = diff_mixer((dq, dk, dv), (dqc, dkc, dvc), diff_lambda, lam_init, diff_norm_g, cos, sin, need_ctx)
    mix = jnp.concatenate([conv_l.astype(x.dtype), mlstm_l.astype(x.dtype), diff_l.astype(x.dtype)], axis=-1)
    x = x + g1 * (mix @ w_out)
    h2 = rmsnorm(x, norm2_g) * (1.0 + sc2) + sh2
    x = x + g2 * peer_ffn(h2, peer_wq, peer_keys, peer_u, peer_v)
    if need_ctx:
        conv_c = conv_module(ac, conv_w, conv_b, conv_ln_g, conv_ln_b)
        mix_c = jnp.concatenate([conv_c.astype(xc.dtype), mlstm_c.astype(xc.dtype), diff_c.astype(xc.dtype)], axis=-1)
        xc = xc + g1c * (mix_c @ w_out)
        h2c = rmsnorm(xc, norm2_g) * (1.0 + sc2c) + sh2c
        xc = xc + g2c * peer_ffn(h2c, peer_wq, peer_keys, peer_u, peer_v)
    return x, xc


def setup_inputs(seed: int = 0) -> dict:
    key = jax.random.key(seed)
    ks = jax.random.split(key, 24)
    f32 = jnp.float32

    def nrm(k, shape, scale):
        return jax.random.normal(k, shape, f32) * scale

    gate_offset = jnp.array([0.0, 3.0, 0.0, 3.0], f32)[None, :, None]
    return {
        "x": nrm(ks[0], (BATCH, SEQ, D_MODEL), 1.0),
        "c": nrm(ks[1], (BATCH, D_MODEL), 1.0),
        "ctx": nrm(ks[2], (BATCH, CTX_LEN, D_MODEL), 1.0),
        "c_ctx": nrm(ks[3], (D_MODEL,), 1.0),
        "ada_w": nrm(ks[4], (DEPTH, D_MODEL, 6 * D_MODEL), 0.5 * D_MODEL ** -0.5),
        "ada_b": nrm(ks[5], (DEPTH, 6 * D_MODEL), 0.02),
        "norm1_g": 1.0 + nrm(ks[6], (DEPTH, D_MODEL), 0.02),
        "norm2_g": 1.0 + nrm(ks[7], (DEPTH, D_MODEL), 0.02),
        "w_in": nrm(ks[8], (DEPTH, D_MODEL, IN_W), D_MODEL ** -0.5),
        "conv_w": nrm(ks[9], (DEPTH, CONV_K, 1, CONV_W), CONV_K ** -0.5),
        "conv_b": nrm(ks[10], (DEPTH, CONV_W), 0.02),
        "conv_ln_g": 1.0 + nrm(ks[11], (DEPTH, CONV_W), 0.02),
        "conv_ln_b": nrm(ks[12], (DEPTH, CONV_W), 0.02),
        "mlstm_gate_b": gate_offset + nrm(ks[13], (DEPTH, 4, MLSTM_HEADS), 0.5),
        "mlstm_norm_g": 1.0 + nrm(ks[14], (DEPTH, MLSTM_DH), 0.02),
        "diff_lambda": nrm(ks[15], (DEPTH, 4, DIFF_DH), 0.1),
        "diff_norm_g": 1.0 + nrm(ks[16], (DEPTH, DIFF_DV), 0.02),
        "w_out": nrm(ks[17], (DEPTH, MIX_W, D_MODEL), MIX_W ** -0.5),
        "peer_wq": nrm(ks[18], (DEPTH, D_MODEL, PEER_HEADS * PEER_DK), D_MODEL ** -0.5),
        "peer_keys": nrm(ks[19], (DEPTH, PEER_HEADS, 2, N_KEYS, PEER_DK // 2), (PEER_DK // 2) ** -0.5),
        "peer_u": nrm(ks[20], (DEPTH, N_EXPERTS, D_MODEL), D_MODEL ** -0.5),
        "peer_v": nrm(ks[21], (DEPTH, N_EXPERTS, D_MODEL), PEER_HEADS ** -0.5),
        "final_g": 1.0 + nrm(ks[22], (D_MODEL,), 0.02),
    }


def reference(x, c, ctx, c_ctx, ada_w, ada_b, norm1_g, norm2_g, w_in, conv_w, conv_b,
              conv_ln_g, conv_ln_b, mlstm_gate_b, mlstm_norm_g, diff_lambda, diff_norm_g,
              w_out, peer_wq, peer_keys, peer_u, peer_v, final_g):
    cos, sin = axial_rope(x.shape[1])
    sc = jax.nn.silu(c)
    scc = jax.nn.silu(c_ctx)
    xc = ctx
    for l in range(DEPTH):
        mod = sc @ ada_w[l] + ada_b[l]
        modc = scc @ ada_w[l] + ada_b[l]
        lam_init = 0.8 - 0.6 * math.exp(-0.3 * l)
        x, xc = trunk_layer(x, xc, mod, modc, lam_init, cos, sin, l < DEPTH - 1,
                            norm1_g[l], norm2_g[l], w_in[l], conv_w[l], conv_b[l],
                            conv_ln_g[l], conv_ln_b[l], mlstm_gate_b[l], mlstm_norm_g[l],
                            diff_lambda[l], diff_norm_g[l], w_out[l], peer_wq[l],
                            peer_keys[l], peer_u[l], peer_v[l])
    return rmsnorm(x, final_g)
```

```cpp
#include <hip/hip_runtime.h>
#include <hip/hip_cooperative_groups.h>
#include <cstdio>
#include <cstdint>
namespace cg = cooperative_groups;

constexpr int DM = 1024, NBATCH = 4, SEQ = 8192, CTXL = 256, SEGL = CTXL + SEQ, T = NBATCH * SEGL, DEPTH = 4;
constexpr int IN_W = 3088, PW = 3072;
constexpr int C_A = 0, C_MQ = 512, C_MK = 768, C_MV = 1024, C_MO = 1280, C_DQ = 1536, C_DK = 2048, C_DV = 2560;
constexpr int NCH = SEGL / 64;
constexpr int NEXP = 16384;
constexpr float EPS = 1e-6f;
#ifndef ABL
#define ABL 0
#endif
constexpr float QSCALE = 0.125f * 1.4426950408889634f;

constexpr size_t MiB = 1u << 20;
constexpr size_t WS_CTL = 0, WS_MOD = 1 * MiB, WS_ROPE = 2 * MiB, WS_WG = 4 * MiB, WS_KEYS = 5 * MiB, WS_MLMETA = 6 * MiB,
                 WS_GATES = 7 * MiB, WS_WIN = 10 * MiB, WS_WOUT = 34 * MiB, WS_WQ = 42 * MiB, WS_PU = 50 * MiB, WS_PV = 178 * MiB,
                 WS_XCUR = 306 * MiB, WS_H = 438 * MiB, WS_MIX = 504 * MiB, WS_PROJ = 570 * MiB, WS_ULOC = 768 * MiB, WS_END = 836 * MiB;
constexpr int USTRIDE = 4160;

constexpr int LDS_BYTES = 139264;

typedef unsigned short bf16_t;
typedef short bf16x8 __attribute__((ext_vector_type(8)));
typedef short s16x4 __attribute__((ext_vector_type(4)));
typedef float f32x4 __attribute__((ext_vector_type(4)));
typedef float f32x16 __attribute__((ext_vector_type(16)));
typedef unsigned u32x4 __attribute__((ext_vector_type(4)));
typedef unsigned u32x2 __attribute__((ext_vector_type(2)));
typedef __bf16 bf16x2v __attribute__((ext_vector_type(2)));

struct Params {
  const float* in[23];
  float* out;
  unsigned char* ws;
  int ph_lo, ph_hi;
};
enum { I_X = 0, I_C, I_CTX, I_CCTX, I_ADAW, I_ADAB, I_N1G, I_N2G, I_WIN, I_CONVW, I_CONVB, I_CLNG, I_CLNB, I_GATEB, I_MNORMG, I_DLAM, I_DNORMG,
       I_WOUT, I_PWQ, I_PKEYS, I_PU, I_PV, I_FINALG };

__device__ __forceinline__ unsigned cvtpk(float lo, float hi) { unsigned r; asm volatile("v_cvt_pk_bf16_f32 %0, %1, %2" : "=v"(r) : "v"(lo), "v"(hi)); return r; }
__device__ __forceinline__ float bflo(unsigned u) { return __uint_as_float(u << 16); }
__device__ __forceinline__ float bfhi(unsigned u) { return __uint_as_float(u & 0xffff0000u); }
__device__ __forceinline__ float bf1(bf16_t u) { return __uint_as_float(((unsigned)u) << 16); }
__device__ __forceinline__ int crow(int r, int hi) { return (r & 3) + 8 * (r >> 2) + 4 * hi; }
__device__ __forceinline__ float wave_sum(float v) {
#pragma unroll
  for (int o = 1; o < 64; o <<= 1) v += __shfl_xor(v, o);
  return v;
}
__device__ __forceinline__ float wave_max(float v) {
#pragma unroll
  for (int o = 1; o < 64; o <<= 1) v = fmaxf(v, __shfl_xor(v, o));
  return v;
}
__device__ __forceinline__ float sigmoidf_(float x) { return 1.f / (1.f + __expf(-x)); }
__device__ __forceinline__ float logsigmoidf_(float x) { return fminf(x, 0.f) - log1pf(__expf(-fabsf(x))); }
__device__ __forceinline__ const float* in_row(const float* x, const float* ctx, int row) {
  const int b = row / SEGL, s = row - b * SEGL;
  return s < CTXL ? ctx + ((size_t)(b * CTXL + s)) * DM : x + ((size_t)(b * SEQ + (s - CTXL))) * DM;
}
__device__ __forceinline__ int mod_row(int row) { const int b = row / SEGL, s = row - b * SEGL; return s < CTXL ? 4 : b; }

__device__ __forceinline__ void p0_mod(const Params& p, unsigned char* lds, float* MOD) {
  float* sil = (float*)lds;
  float* red = (float*)(lds + 20480);
  int tid_ = threadIdx.x; asm volatile("" : "+v"(tid_)); const int tid = tid_, lane = tid & 63, wid = tid >> 6;
  for (int i = tid; i < 5 * 1024; i += 512) {
    const float v = i < 4096 ? p.in[I_C][i] : p.in[I_CCTX][i - 4096];
    sil[i] = v / (1.f + __expf(-v));
  }
  __syncthreads();
  for (int item = blockIdx.x; item < DEPTH * 96; item += gridDim.x) {
    const int l = item / 96, j0 = (item % 96) * 64;
    const float* W = p.in[I_ADAW] + (size_t)l * DM * 6144 + j0 + lane;
    float a0 = 0.f, a1 = 0.f, a2 = 0.f, a3 = 0.f, a4 = 0.f;
    const int k0 = wid * 128;
#pragma unroll 8
    for (int k = k0; k < k0 + 128; ++k) {
      const float w = W[(size_t)k * 6144];
      a0 += sil[k] * w; a1 += sil[1024 + k] * w; a2 += sil[2048 + k] * w; a3 += sil[3072 + k] * w; a4 += sil[4096 + k] * w;
    }
    red[(wid * 5 + 0) * 64 + lane] = a0; red[(wid * 5 + 1) * 64 + lane] = a1; red[(wid * 5 + 2) * 64 + lane] = a2;
    red[(wid * 5 + 3) * 64 + lane] = a3; red[(wid * 5 + 4) * 64 + lane] = a4;
    __syncthreads();
    if (tid < 320) {
      const int r = tid >> 6;
      float s = 0.f;
#pragma unroll
      for (int w = 0; w < 8; ++w) s += red[(w * 5 + r) * 64 + lane];
      MOD[((size_t)l * 5 + r) * 6144 + j0 + lane] = s + p.in[I_ADAB][l * 6144 + j0 + lane];
    }
    __syncthreads();
  }
}
__device__ __forceinline__ void transpose_item(const float* W, int ldw, int srccol0, bf16_t* WT, int K, int n0, int k0, float* scr, int lane) {
#pragma unroll 8
  for (int i = 0; i < 32; ++i) { const int kk = 2 * i + (lane >> 5); scr[kk * 33 + (lane & 31)] = W[(size_t)(k0 + kk) * ldw + srccol0 + (lane & 31)]; }
  asm volatile("s_waitcnt lgkmcnt(0)" ::: "memory");
  const int c = lane & 7;
#pragma unroll
  for (int j = 0; j < 4; ++j) {
    const int n = (lane >> 3) + 8 * j; const float* s = scr + (8 * c) * 33 + n;
    u32x4 o; o.x = cvtpk(s[0], s[33]); o.y = cvtpk(s[66], s[99]); o.z = cvtpk(s[132], s[165]); o.w = cvtpk(s[198], s[231]);
    *(u32x4*)(WT + (size_t)(n0 + n) * K + k0 + 8 * c) = o;
  }
  asm volatile("s_waitcnt lgkmcnt(0)" ::: "memory");
}
__device__ __forceinline__ void p0_convert(const Params& p, unsigned char* lds) {
  int tid_ = threadIdx.x; asm volatile("" : "+v"(tid_)); const int tid = tid_, lane = tid & 63, wid = tid >> 6;
  const int gw = blockIdx.x * 8 + wid, NGW = gridDim.x * 8;
  const size_t gt = (size_t)blockIdx.x * 512 + tid, NGT = (size_t)gridDim.x * 512;
  float* scr = (float*)(lds + 32768) + wid * (64 * 33);
  bf16_t* WIN = (bf16_t*)(p.ws + WS_WIN); bf16_t* WOUT = (bf16_t*)(p.ws + WS_WOUT); bf16_t* WQ = (bf16_t*)(p.ws + WS_WQ);
  constexpr int I_IN = 16 * 96, I_O = 16 * 32, PER_L = I_IN + 2 * I_O;
  for (int it = gw; it < DEPTH * PER_L; it += NGW) {
    const int l = it / PER_L; int r = it % PER_L;
    if (r < I_IN) { const int kb = r / 96, nb = r % 96, n0 = nb * 32; const int src = n0 < 1536 ? n0 : n0 + 16;
      transpose_item(p.in[I_WIN] + (size_t)l * DM * IN_W, IN_W, src, WIN + (size_t)l * PW * DM, DM, n0, kb * 64, scr, lane); continue; }
    r -= I_IN;
    if (r < I_O) { const int kb = r / 32, nb = r % 32;
      transpose_item(p.in[I_WOUT] + (size_t)l * DM * DM, DM, nb * 32, WOUT + (size_t)l * DM * DM, DM, nb * 32, kb * 64, scr, lane); continue; }
    r -= I_O;
    { const int kb = r / 32, nb = r % 32;
      transpose_item(p.in[I_PWQ] + (size_t)l * DM * DM, DM, nb * 32, WQ + (size_t)l * DM * DM, DM, nb * 32, kb * 64, scr, lane); }
  }
  bf16_t* WG = (bf16_t*)(p.ws + WS_WG);
  for (size_t i = gt; i < (size_t)DEPTH * 16 * DM; i += NGT) {
    const int l = (int)(i / (16 * DM)), g = (int)((i / DM) % 16), k = (int)(i % DM);
    WG[i] = (bf16_t)(cvtpk(p.in[I_WIN][(size_t)l * DM * IN_W + (size_t)k * IN_W + 1536 + g], 0.f) & 0xffffu);
  }
  bf16_t* KEYS = (bf16_t*)(p.ws + WS_KEYS);
  for (size_t i = gt; i < (size_t)DEPTH * 131072 / 8; i += NGT) {
    const f32x4 a = ((const f32x4*)p.in[I_PKEYS])[2 * i], b = ((const f32x4*)p.in[I_PKEYS])[2 * i + 1];
    u32x4 o; o.x = cvtpk(a.x, a.y); o.y = cvtpk(a.z, a.w); o.z = cvtpk(b.x, b.y); o.w = cvtpk(b.z, b.w);
    ((u32x4*)KEYS)[i] = o;
  }
  {
    const size_t n8 = (size_t)DEPTH * NEXP * DM / 8;
    u32x4* PU = (u32x4*)(p.ws + WS_PU); u32x4* PV = (u32x4*)(p.ws + WS_PV);
    const f32x4* su = (const f32x4*)p.in[I_PU]; const f32x4* sv = (const f32x4*)p.in[I_PV];
    for (size_t i = gt; i < n8; i += NGT) {
      const f32x4 a = __builtin_nontemporal_load(su + 2 * i), b = __builtin_nontemporal_load(su + 2 * i + 1);
      const f32x4 c = __builtin_nontemporal_load(sv + 2 * i), d = __builtin_nontemporal_load(sv + 2 * i + 1);
      u32x4 o; o.x = cvtpk(a.x, a.y); o.y = cvtpk(a.z, a.w); o.z = cvtpk(b.x, b.y); o.w = cvtpk(b.z, b.w);
      u32x4 q; q.x = cvtpk(c.x, c.y); q.y = cvtpk(c.z, c.w); q.z = cvtpk(d.x, d.y); q.w = cvtpk(d.z, d.w);
      PU[i] = o; PV[i] = q;
    }
  }
  {
    float* RC = (float*)(p.ws + WS_ROPE); float* RS = RC + SEQ * 32;
    for (size_t i = gt; i < (size_t)SEQ * 32; i += NGT) {
      const int pos = (int)(i >> 5), j = (int)(i & 31);
      const int rr = pos >> 6, cc = pos & 63;
      const int jj = j & 15;
      const double e = -(double)jj * 0.83048202372184058696;
      const double fl = __builtin_floor(e); const double f = e - fl;
      const double z = f * 0.69314718055994530942;
      double ez = 1.0 + z * (1.0 + z * (0.5 + z * (1.0 / 6 + z * (1.0 / 24 + z * (1.0 / 120 + z * (1.0 / 720 + z * (1.0 / 5040 + z * (1.0 / 40320 + z * (1.0 / 362880 + z * (1.0 / 3628800 + z * (1.0 / 39916800 + z * (1.0 / 479001600))))))))))));
      const double inv = __builtin_ldexp(ez, (int)fl);
      const float invf = (float)inv;
      const float angf = (float)(j < 16 ? rr : cc) * invf;
      const double ang = (double)angf;
      const double kq = __builtin_rint(ang * 0.63661977236758134308);
      double r = __builtin_fma(-kq, 1.57079632679489655800e+00, ang);
      r = __builtin_fma(-kq, 6.12323399573676603587e-17, r);
      const double r2 = r * r;
      const double sn = r * (1.0 + r2 * (-1.0 / 6 + r2 * (1.0 / 120 + r2 * (-1.0 / 5040 + r2 * (1.0 / 362880 + r2 * (-1.0 / 39916800 + r2 * (1.0 / 6227020800.0)))))));
      const double cs = 1.0 + r2 * (-0.5 + r2 * (1.0 / 24 + r2 * (-1.0 / 720 + r2 * (1.0 / 40320 + r2 * (-1.0 / 3628800 + r2 * (1.0 / 479001600 + r2 * (-1.0 / 87178291200.0)))))));
      const int q = ((int)kq) & 3;
      double co, si;
      if (q == 0) { co = cs; si = sn; } else if (q == 1) { co = -sn; si = cs; } else if (q == 2) { co = -cs; si = -sn; } else { co = sn; si = -cs; }
      RC[i] = (float)co; RS[i] = (float)si;
    }
  }
}

__device__ __forceinline__ void norm_mod_row(const float* xrow, const float* g, const float* sc, const float* sh, bf16_t* orow, int lane) {
  const f32x4* xr = (const f32x4*)xrow + lane;
  f32x4 v[4]; float s = 0.f;
#pragma unroll
  for (int j = 0; j < 4; ++j) { v[j] = xr[64 * j]; s += (v[j].x * v[j].x + v[j].y * v[j].y) + (v[j].z * v[j].z + v[j].w * v[j].w); }
  const float rs = rsqrtf(wave_sum(s) * (1.f / DM) + EPS);
  u32x2* o = (u32x2*)orow + lane;
#pragma unroll
  for (int j = 0; j < 4; ++j) {
    const f32x4 gg = ((const f32x4*)g)[lane + 64 * j], cc = ((const f32x4*)sc)[lane + 64 * j], hh = ((const f32x4*)sh)[lane + 64 * j];
    const float y0 = v[j].x * rs * gg.x * (1.f + cc.x) + hh.x, y1 = v[j].y * rs * gg.y * (1.f + cc.y) + hh.y;
    const float y2 = v[j].z * rs * gg.z * (1.f + cc.z) + hh.z, y3 = v[j].w * rs * gg.w * (1.f + cc.w) + hh.w;
    u32x2 w; w.x = cvtpk(y0, y1); w.y = cvtpk(y2, y3);
    o[64 * j] = w;
  }
}
__device__ __forceinline__ void phase_norm(const Params& p, int l, int which, bool from_input, bool skip_ctx) {
  int tid_ = threadIdx.x; asm volatile("" : "+v"(tid_));
  const int lane = tid_ & 63, wid = tid_ >> 6;
  const int gw = blockIdx.x * 8 + wid, NGW = gridDim.x * 8;
  const float* MOD = (const float*)(p.ws + WS_MOD);
  const float* XC = (const float*)(p.ws + WS_XCUR);
  bf16_t* H = (bf16_t*)(p.ws + WS_H);
  const float* g = p.in[which ? I_N2G : I_N1G] + l * DM;
  for (int row = gw; row < T; row += NGW) {
    const int mr = mod_row(row);
    if (skip_ctx && mr == 4) continue;
    const float* m = MOD + ((size_t)l * 5 + mr) * 6144 + which * 3072;
    const float* xr = from_input ? in_row(p.in[I_X], p.in[I_CTX], row) : XC + (size_t)row * DM;
    norm_mod_row(xr, g, m + 1024, m, H + (size_t)row * DM, lane);
  }
}

__device__ __forceinline__ int gswz(int row, int chunk) { return row * 128 + ((chunk ^ ((row >> 1) & 7)) << 4); }
__device__ __forceinline__ void gemm_tile(const bf16_t* __restrict__ A, int lda, const bf16_t* __restrict__ Bt, int ldb, int K,
                                          int row0, int col0, unsigned char* lds, f32x16 (&acc)[2][2]) {
  int tid_ = threadIdx.x; asm volatile("" : "+v"(tid_)); const int tid = tid_, lane = tid & 63, wid = tid >> 6, wm = wid >> 1, wn = wid & 1, r32 = lane & 31, hi = lane >> 5;
  unsigned char* As = lds; unsigned char* Bs = lds + 65536;
#pragma unroll
  for (int i = 0; i < 2; ++i)
#pragma unroll
    for (int j = 0; j < 2; ++j) acc[i][j] = f32x16{};
  const int lrow = tid >> 3, lc = tid & 7;
  const bf16_t* Ag = A + (size_t)(row0 + lrow) * lda + lc * 8;
  const bf16_t* Bg = Bt + (size_t)(col0 + lrow) * ldb + lc * 8;
  u32x4 ra[4], rb[2];
#pragma unroll
  for (int i = 0; i < 4; ++i) ra[i] = *(const u32x4*)(Ag + (size_t)(64 * i) * lda);
#pragma unroll
  for (int i = 0; i < 2; ++i) rb[i] = *(const u32x4*)(Bg + (size_t)(64 * i) * ldb);
#pragma unroll
  for (int i = 0; i < 4; ++i) *(u32x4*)(As + gswz(lrow + 64 * i, lc)) = ra[i];
#pragma unroll
  for (int i = 0; i < 2; ++i) *(u32x4*)(Bs + gswz(lrow + 64 * i, lc)) = rb[i];
  __syncthreads();
  const int nk = K / 64;
  for (int kt = 0; kt < nk; ++kt) {
    const int cur = kt & 1;
    if (kt + 1 < nk) {
#pragma unroll
      for (int i = 0; i < 4; ++i) ra[i] = *(const u32x4*)(Ag + (size_t)(64 * i) * lda + (kt + 1) * 64);
#pragma unroll
      for (int i = 0; i < 2; ++i) rb[i] = *(const u32x4*)(Bg + (size_t)(64 * i) * ldb + (kt + 1) * 64);
    }
    const unsigned char* Ac = As + cur * 32768; const unsigned char* Bc = Bs + cur * 16384;
#pragma unroll
    for (int kk = 0; kk < 4; ++kk) {
      bf16x8 af[2], bfr[2];
#pragma unroll
      for (int i = 0; i < 2; ++i) af[i] = *(const bf16x8*)(Ac + gswz(wm * 64 + i * 32 + r32, 2 * kk + hi));
#pragma unroll
      for (int j = 0; j < 2; ++j) bfr[j] = *(const bf16x8*)(Bc + gswz(wn * 64 + j * 32 + r32, 2 * kk + hi));
#pragma unroll
      for (int i = 0; i < 2; ++i)
#pragma unroll
        for (int j = 0; j < 2; ++j) acc[i][j] = __builtin_amdgcn_mfma_f32_32x32x16_bf16(af[i], bfr[j], acc[i][j], 0, 0, 0);
    }
    if (kt + 1 < nk) {
      unsigned char* An = As + (cur ^ 1) * 32768; unsigned char* Bn = Bs + (cur ^ 1) * 16384;
#pragma unroll
      for (int i = 0; i < 4; ++i) *(u32x4*)(An + gswz(lrow + 64 * i, lc)) = ra[i];
#pragma unroll
      for (int i = 0; i < 2; ++i) *(u32x4*)(Bn + gswz(lrow + 64 * i, lc)) = rb[i];
    }
    __syncthreads();
  }
}
__device__ __forceinline__ void pair_xchg(float v0, float v1, int lane, float& lo, float& hi2) {
  const bool odd = lane & 1;
  const float send = odd ? v0 : v1;
  const float recv = __shfl_xor(send, 1);
  lo = odd ? recv : v0; hi2 = odd ? v1 : recv;
}

__device__ __forceinline__ void phase_inproj(const Params& p, int l, unsigned char* lds) {
  int tid_ = threadIdx.x; asm volatile("" : "+v"(tid_)); const int tid = tid_, lane = tid & 63, wid = tid >> 6, wm = wid >> 1, wn = wid & 1, r32 = lane & 31, hi = lane >> 5;
  const bf16_t* H = (const bf16_t*)(p.ws + WS_H);
  const bf16_t* W = (const bf16_t*)(p.ws + WS_WIN) + (size_t)l * PW * DM;
  bf16_t* PROJ = (bf16_t*)(p.ws + WS_PROJ);
  const float* RC = (const float*)(p.ws + WS_ROPE); const float* RS = RC + SEQ * 32;
  constexpr int NM = T / 256, NN = PW / 128, NU = NM * NN;
  for (int u = blockIdx.x; u < NU + NM; u += gridDim.x) {
    if (u < NU) {
      const int pn = u / NM, pm = u % NM;
      const int row0 = pm * 256, col0 = pn * 128;
      f32x16 acc[2][2];
      gemm_tile(H, DM, W, DM, DM, row0, col0, lds, acc);
      const bool rope = (col0 >= C_DQ && col0 < C_DV);
      const float scl = (col0 >= C_MK && col0 < C_MV) ? 0.125f : ((col0 >= C_DQ && col0 < C_DK) ? QSCALE : 1.f);
#pragma unroll
      for (int i = 0; i < 2; ++i)
#pragma unroll
        for (int j = 0; j < 2; ++j)
#pragma unroll
          for (int q = 0; q < 8; ++q) {
            float lo, hi2; pair_xchg(acc[i][j][2 * q], acc[i][j][2 * q + 1], lane, lo, hi2);
            const int row = row0 + wm * 64 + i * 32 + crow(2 * q, hi) + (lane & 1);
            const int col = col0 + wn * 64 + j * 32 + (r32 & ~1);
            if (rope) {
              const int s = row % SEGL;
              if (s >= CTXL) {
                const int idx = (s - CTXL) * 32 + ((col & 63) >> 1);
                const float c = RC[idx], sn = RS[idx];
                const float t1 = lo, t2 = hi2; lo = t1 * c - t2 * sn; hi2 = t1 * sn + t2 * c;
              }
            }
            *(unsigned*)(PROJ + (size_t)row * PW + col) = cvtpk(lo * scl, hi2 * scl);
          }
    } else {
      const int pm = u - NU, rowb = pm * 256 + wid * 32;
      const bf16_t* WG = (const bf16_t*)(p.ws + WS_WG) + (size_t)l * 16 * DM;
      float* GT = (float*)(p.ws + WS_GATES);
      const int r16 = lane & 15, q4 = lane >> 4;
      f32x4 c0 = {0.f, 0.f, 0.f, 0.f}, c1 = {0.f, 0.f, 0.f, 0.f};
      const bf16_t* a0p = H + (size_t)(rowb + r16) * DM + q4 * 8;
      const bf16_t* a1p = a0p + (size_t)16 * DM;
      const bf16_t* bp = WG + (size_t)r16 * DM + q4 * 8;
#pragma unroll 4
      for (int ks = 0; ks < 32; ++ks) {
        const bf16x8 a0 = *(const bf16x8*)(a0p + ks * 32), a1 = *(const bf16x8*)(a1p + ks * 32), b = *(const bf16x8*)(bp + ks * 32);
        c0 = __builtin_amdgcn_mfma_f32_16x16x32_bf16(a0, b, c0, 0, 0, 0);
        c1 = __builtin_amdgcn_mfma_f32_16x16x32_bf16(a1, b, c1, 0, 0, 0);
      }
      const float gb = p.in[I_GATEB][l * 16 + r16];
#pragma unroll
      for (int j = 0; j < 4; ++j) {
        GT[(size_t)(rowb + q4 * 4 + j) * 16 + r16] = c0[j] + gb;
        GT[(size_t)(rowb + 16 + q4 * 4 + j) * 16 + r16] = c1[j] + gb;
      }
    }
  }
}

__device__ __forceinline__ void phase_outproj(const Params& p, int l, unsigned char* lds) {
  int tid_ = threadIdx.x; asm volatile("" : "+v"(tid_)); const int tid = tid_, lane = tid & 63, wid = tid >> 6, wm = wid >> 1, wn = wid & 1, r32 = lane & 31, hi = lane >> 5;
  const bf16_t* MIX = (const bf16_t*)(p.ws + WS_MIX);
  const bf16_t* W = (const bf16_t*)(p.ws + WS_WOUT) + (size_t)l * DM * DM;
  float* XC = (float*)(p.ws + WS_XCUR);
  const float* MOD = (const float*)(p.ws + WS_MOD);
  constexpr int NM = T / 256, NN = DM / 128, NU = NM * NN;
  for (int u = blockIdx.x; u < NU; u += gridDim.x) {
    const int pm = u / NN, pn = u % NN;
    if (l == DEPTH - 1 && (pm % 33) == 0) continue;
    const int row0 = pm * 256, col0 = pn * 128;
    f32x16 acc[2][2];
    gemm_tile(MIX, DM, W, DM, DM, row0, col0, lds, acc);
    const int mr = (pm % 33) == 0 ? 4 : pm / 33;
    const float* g1 = MOD + ((size_t)l * 5 + mr) * 6144 + 2048;
#pragma unroll
    for (int i = 0; i < 2; ++i)
#pragma unroll
      for (int j = 0; j < 2; ++j) {
        const int col = col0 + wn * 64 + j * 32 + r32;
        const float gg = g1[col];
#pragma unroll
        for (int r = 0; r < 16; ++r) {
          const int row = row0 + wm * 64 + i * 32 + crow(r, hi);
          const float xo = (l == 0) ? in_row(p.in[I_X], p.in[I_CTX], row)[col] : XC[(size_t)row * DM + col];
          XC[(size_t)row * DM + col] = xo + gg * acc[i][j][r];
        }
      }
  }
}
__device__ __forceinline__ void phase_peerq(const Params& p, int l, unsigned char* lds) {
  int tid_ = threadIdx.x; asm volatile("" : "+v"(tid_)); const int tid = tid_, lane = tid & 63, wid = tid >> 6, wm = wid >> 1, wn = wid & 1, r32 = lane & 31, hi = lane >> 5;
  const bf16_t* H = (const bf16_t*)(p.ws + WS_H);
  const bf16_t* W = (const bf16_t*)(p.ws + WS_WQ) + (size_t)l * DM * DM;
  bf16_t* QP = (bf16_t*)(p.ws + WS_PROJ);
  constexpr int NM = T / 256, NN = DM / 128, NU = NM * NN;
  for (int u = blockIdx.x; u < NU; u += gridDim.x) {
    const int pm = u / NN, pn = u % NN;
    if (l == DEPTH - 1 && (pm % 33) == 0) continue;
    const int row0 = pm * 256, col0 = pn * 128;
    f32x16 acc[2][2];
    gemm_tile(H, DM, W, DM, DM, row0, col0, lds, acc);
#pragma unroll
    for (int i = 0; i < 2; ++i)
#pragma unroll
      for (int j = 0; j < 2; ++j)
#pragma unroll
        for (int q = 0; q < 8; ++q) {
          float lo, hi2; pair_xchg(acc[i][j][2 * q], acc[i][j][2 * q + 1], lane, lo, hi2);
          const int row = row0 + wm * 64 + i * 32 + crow(2 * q, hi) + (lane & 1);
          const int col = col0 + wn * 64 + j * 32 + (r32 & ~1);
          *(unsigned*)(QP + (size_t)row * DM + col) = cvtpk(lo, hi2);
        }
  }
}


__device__ __forceinline__ void conv_unit(const Params& p, int l, int unit, unsigned char* lds) {
  int tid_ = threadIdx.x; asm volatile("" : "+v"(tid_)); const int tid = tid_, lane = tid & 63, wid = tid >> 6;
  float* U = (float*)lds;
  const bf16_t* PROJ = (const bf16_t*)(p.ws + WS_PROJ);
  bf16_t* MIX = (bf16_t*)(p.ws + WS_MIX);
  const int row0 = unit * 32, b = row0 / SEGL, s0 = row0 - b * SEGL;
  const int seglo = s0 < CTXL ? 0 : CTXL, seghi = s0 < CTXL ? CTXL : SEGL;
  for (int rr = tid >> 5; rr < 62; rr += 16) {
    const int s = s0 - 15 + rr, c8 = (tid & 31) * 8;
    f32x4 u0 = {0.f, 0.f, 0.f, 0.f}, u1 = {0.f, 0.f, 0.f, 0.f};
    if (s >= seglo && s < seghi) {
      const bf16_t* pr = PROJ + (size_t)(b * SEGL + s) * PW + c8;
      const u32x4 a1 = *(const u32x4*)pr, a2 = *(const u32x4*)(pr + 256);
      u0.x = bflo(a1.x) * sigmoidf_(bflo(a2.x)); u0.y = bfhi(a1.x) * sigmoidf_(bfhi(a2.x));
      u0.z = bflo(a1.y) * sigmoidf_(bflo(a2.y)); u0.w = bfhi(a1.y) * sigmoidf_(bfhi(a2.y));
      u1.x = bflo(a1.z) * sigmoidf_(bflo(a2.z)); u1.y = bfhi(a1.z) * sigmoidf_(bfhi(a2.z));
      u1.z = bflo(a1.w) * sigmoidf_(bflo(a2.w)); u1.w = bfhi(a1.w) * sigmoidf_(bfhi(a2.w));
    }
    *(f32x4*)(U + rr * 256 + c8) = u0; *(f32x4*)(U + rr * 256 + c8 + 4) = u1;
  }
  __syncthreads();
  float* Y = U + 62 * 256;
  const float* cw = p.in[I_CONVW] + (size_t)l * 31 * 256;
#pragma unroll 1
  for (int q = 0; q < 4; ++q) {
    const int c = lane + 64 * q;
    float w[31];
#pragma unroll
    for (int j = 0; j < 31; ++j) w[j] = cw[j * 256 + c];
    const float bias = p.in[I_CONVB][l * 256 + c];
#pragma unroll
    for (int tt = 0; tt < 4; ++tt) {
      const int t = wid * 4 + tt;
      float a = bias;
#pragma unroll
      for (int j = 0; j < 31; ++j) a += U[(t + j) * 256 + c] * w[j];
      Y[t * 256 + c] = a;
    }
  }
  asm volatile("s_waitcnt lgkmcnt(0)" ::: "memory");
  float y[4][4];
#pragma unroll
  for (int tt = 0; tt < 4; ++tt)
#pragma unroll
    for (int q = 0; q < 4; ++q) y[tt][q] = Y[(wid * 4 + tt) * 256 + lane + 64 * q];
#pragma unroll
  for (int tt = 0; tt < 4; ++tt) {
    const int t = wid * 4 + tt;
    const float mean = wave_sum((y[tt][0] + y[tt][1]) + (y[tt][2] + y[tt][3])) * (1.f / 256.f);
    float v = 0.f;
#pragma unroll
    for (int q = 0; q < 4; ++q) { const float d = y[tt][q] - mean; v += d * d; }
    const float rs = rsqrtf(wave_sum(v) * (1.f / 256.f) + EPS);
#pragma unroll
    for (int q = 0; q < 4; ++q) {
      const int c = lane + 64 * q;
      const float z = (y[tt][q] - mean) * rs * p.in[I_CLNG][l * 256 + c] + p.in[I_CLNB][l * 256 + c];
      const float o = (ABL & 1) ? 0.f : z * sigmoidf_(z);
      MIX[(size_t)(row0 + t) * DM + c] = (bf16_t)(cvtpk(o, 0.f) & 0xffffu);
    }
  }
  __syncthreads();
}

__device__ __forceinline__ int ml_cidx(int ch, int dir) { return dir == 0 ? ch : (ch < 4 ? 3 - ch : 135 - ch); }
__device__ __forceinline__ void ml_load_tile(const bf16_t* src, float* dst, int tid) {
  const int r = tid >> 3, c8 = (tid & 7) * 8;
  const u32x4 a = *(const u32x4*)(src + (size_t)r * PW + c8);
  float* d = dst + r * 65 + c8;
  d[0] = bflo(a.x); d[1] = bfhi(a.x); d[2] = bflo(a.y); d[3] = bfhi(a.y); d[4] = bflo(a.z); d[5] = bfhi(a.z); d[6] = bflo(a.w); d[7] = bfhi(a.w);
}
__device__ __forceinline__ void ml_local_unit(const Params& p, int l, int unit, unsigned char* lds) {
  int tid_ = threadIdx.x; asm volatile("" : "+v"(tid_)); const int tid = tid_, lane = tid & 63, wid = tid >> 6, r32 = lane & 31, hi = lane >> 5;
  float* Kt = (float*)lds; float* Vt = Kt + 64 * 65; float* WK = Vt + 64 * 65;
  const bf16_t* PROJ = (const bf16_t*)(p.ws + WS_PROJ);
  const float* GT = (const float*)(p.ws + WS_GATES);
  float* UL = (float*)(p.ws + WS_ULOC); float* META = (float*)(p.ws + WS_MLMETA);
  const int b = unit / (4 * NCH), hh = (unit / NCH) & 3, ch = unit % NCH;
  const int row0 = b * SEGL + ch * 64;
  ml_load_tile(PROJ + (size_t)row0 * PW + C_MK + hh * 64, Kt, tid);
  ml_load_tile(PROJ + (size_t)row0 * PW + C_MV + hh * 64, Vt, tid);
  if (wid < 2) {
    const int dir = wid;
    const float ig = GT[(size_t)(row0 + lane) * 16 + (2 * dir) * 4 + hh];
    const float lf = logsigmoidf_(GT[(size_t)(row0 + lane) * 16 + (2 * dir + 1) * 4 + hh]);
    float ps = lf;
#pragma unroll
    for (int o = 1; o < 64; o <<= 1) { const float t = __shfl_up(ps, o); if (lane >= o) ps += t; }
    const float tot = __shfl(ps, 63);
    const float wlog = dir == 0 ? (tot - ps + ig) : (ps - lf + ig);
    const float mloc = wave_max(wlog);
    WK[dir * 64 + lane] = __expf(wlog - mloc);
    if (lane == 0) {
      const int seq = (b * 4 + hh) * 2 + dir, ci = ml_cidx(ch, dir);
      META[((size_t)seq * NCH + ci) * 4 + 0] = tot; META[((size_t)seq * NCH + ci) * 4 + 1] = mloc;
    }
  }
  __syncthreads();
  {
    const int dir = wid >> 2, et = (wid >> 1) & 1, dt = wid & 1;
    const int seq = (b * 4 + hh) * 2 + dir, ci = ml_cidx(ch, dir);
    float* slot = UL + ((size_t)seq * NCH + ci) * USTRIDE;
    f32x16 acc = {};
#pragma unroll 8
    for (int ks = 0; ks < 32; ++ks) {
      const int s = 2 * ks + hi;
      const float a = WK[dir * 64 + s] * Vt[s * 65 + et * 32 + r32];
      const float bb = Kt[s * 65 + dt * 32 + r32];
      acc = __builtin_amdgcn_mfma_f32_32x32x2f32(a, bb, acc, 0, 0, 0);
    }
#pragma unroll
    for (int r = 0; r < 16; ++r) slot[(et * 32 + crow(r, hi)) * 64 + dt * 32 + r32] = acc[r];
    if (et == 0) {
      float n = 0.f;
#pragma unroll 8
      for (int i = 0; i < 32; ++i) { const int s = hi * 32 + i; n += WK[dir * 64 + s] * Kt[s * 65 + dt * 32 + r32]; }
      n += __shfl_xor(n, 32);
      if (hi == 0) slot[4096 + dt * 32 + r32] = n;
    }
  }
  __syncthreads();
}
__device__ __forceinline__ void ml_scan(const Params& p) {
  float* UL = (float*)(p.ws + WS_ULOC); float* META = (float*)(p.ws + WS_MLMETA);
  int tid_ = threadIdx.x; asm volatile("" : "+v"(tid_));
  const int gt = blockIdx.x * 512 + tid_, NGT = gridDim.x * 512;
  for (int idx = gt; idx < 32 * USTRIDE; idx += NGT) {
    const int seq = idx / USTRIDE, e = idx - seq * USTRIDE;
    float* base = UL + (size_t)seq * NCH * USTRIDE + e;
    float* mt = META + (size_t)seq * NCH * 4;
    float m = 0.f, C = 0.f;
    for (int c = 0; c < NCH; ++c) {
      const float bl = mt[c * 4 + 0], mloc = mt[c * 4 + 1];
      const float u = base[(size_t)c * USTRIDE];
      base[(size_t)c * USTRIDE] = C;
      const float mn = fmaxf(bl + m, mloc);
      C = __expf(bl + m - mn) * C + __expf(mloc - mn) * u;
      if (e == 0) mt[c * 4 + 2] = m;
      m = mn;
    }
  }
}
__device__ __forceinline__ void ml_out_unit(const Params& p, int l, int unit, unsigned char* lds) {
  int tid_ = threadIdx.x; asm volatile("" : "+v"(tid_)); const int tid = tid_, lane = tid & 63, wid = tid >> 6, r32 = lane & 31, hi = lane >> 5;
  float* Qt = (float*)lds; float* Kt = Qt + 64 * 65; float* Vt = Kt + 64 * 65;
  float* Cs = Vt + 64 * 65;
  float* Ns = Cs + 2 * 64 * 65;
  float* Bq = Ns + 128;
  float* Gs = Bq + 128;
  float* Mi = Gs + 128;
  float* HB = Mi + 64;
  const bf16_t* PROJ = (const bf16_t*)(p.ws + WS_PROJ);
  const float* GT = (const float*)(p.ws + WS_GATES);
  const float* UL = (const float*)(p.ws + WS_ULOC); const float* META = (const float*)(p.ws + WS_MLMETA);
  bf16_t* MIX = (bf16_t*)(p.ws + WS_MIX);
  const int b = unit / (4 * NCH), hh = (unit / NCH) & 3, ch = unit % NCH;
  const int row0 = b * SEGL + ch * 64;
  ml_load_tile(PROJ + (size_t)row0 * PW + C_MQ + hh * 64, Qt, tid);
  ml_load_tile(PROJ + (size_t)row0 * PW + C_MK + hh * 64, Kt, tid);
  ml_load_tile(PROJ + (size_t)row0 * PW + C_MV + hh * 64, Vt, tid);
  for (int i = tid; i < 2 * USTRIDE; i += 512) {
    const int dir = i / USTRIDE, e = i - dir * USTRIDE;
    const int seq = (b * 4 + hh) * 2 + dir, ci = ml_cidx(ch, dir);
    const float v = UL[((size_t)seq * NCH + ci) * USTRIDE + e];
    if (e < 4096) Cs[dir * 64 * 65 + (e >> 6) * 65 + (e & 63)] = v; else Ns[dir * 64 + (e - 4096)] = v;
  }
  if (wid < 2) {
    const int dir = wid;
    const float ig = GT[(size_t)(row0 + lane) * 16 + (2 * dir) * 4 + hh];
    const float lf = logsigmoidf_(GT[(size_t)(row0 + lane) * 16 + (2 * dir + 1) * 4 + hh]);
    float ps = lf;
#pragma unroll
    for (int o = 1; o < 64; o <<= 1) { const float t = __shfl_up(ps, o); if (lane >= o) ps += t; }
    const float tot = __shfl(ps, 63);
    const float bc = dir == 0 ? ps : (tot - ps + lf);
    Bq[dir * 64 + lane] = bc; Gs[dir * 64 + lane] = ig - bc;
    if (lane == 0) { const int seq = (b * 4 + hh) * 2 + dir, ci = ml_cidx(ch, dir); Mi[dir] = META[((size_t)seq * NCH + ci) * 4 + 2]; }
  }
  __syncthreads();
  {
    const int dir = wid >> 2, tt = (wid >> 1) & 1, et = wid & 1;
    const int t = tt * 32 + r32;
    f32x16 sa[2] = {};
#pragma unroll 4
    for (int ks = 0; ks < 32; ++ks) {
      const float bq = Qt[t * 65 + 2 * ks + hi];
      const float a0 = Kt[(r32) * 65 + 2 * ks + hi], a1 = Kt[(32 + r32) * 65 + 2 * ks + hi];
      sa[0] = __builtin_amdgcn_mfma_f32_32x32x2f32(a0, bq, sa[0], 0, 0, 0);
      sa[1] = __builtin_amdgcn_mfma_f32_32x32x2f32(a1, bq, sa[1], 0, 0, 0);
    }
    const float bt = Bq[dir * 64 + t];
    const float inter = bt + Mi[dir];
    float mx = -INFINITY;
    f32x16 dl[2];
#pragma unroll
    for (int st = 0; st < 2; ++st)
#pragma unroll
      for (int r = 0; r < 16; ++r) {
        const int s = st * 32 + crow(r, hi);
        const bool ok = dir == 0 ? (s <= t) : (s >= t);
        const float d = ok ? bt + Gs[dir * 64 + s] : -INFINITY;
        dl[st][r] = d; mx = fmaxf(mx, d);
      }
    mx = fmaxf(mx, __shfl_xor(mx, 32));
    const float mt = fmaxf(inter, mx);
    const float iw = __expf(inter - mt);
    float rsum = 0.f;
#pragma unroll
    for (int st = 0; st < 2; ++st)
#pragma unroll
      for (int r = 0; r < 16; ++r) { const float w = __expf(dl[st][r] - mt); sa[st][r] *= w; rsum += sa[st][r]; }
    rsum += __shfl_xor(rsum, 32);
    float qn = 0.f;
#pragma unroll 8
    for (int i = 0; i < 32; ++i) { const int d = hi * 32 + i; qn += Ns[dir * 64 + d] * Qt[t * 65 + d]; }
    qn += __shfl_xor(qn, 32);
    const float den = rsum + iw * qn;
    const float rden = 1.f / fmaxf(fabsf(den), __expf(-mt));
    f32x16 an = {}, ac = {};
#pragma unroll
    for (int st = 0; st < 2; ++st)
#pragma unroll
      for (int r = 0; r < 16; ++r) {
        const float a = Vt[(st * 32 + crow(r, hi)) * 65 + et * 32 + r32];
        an = __builtin_amdgcn_mfma_f32_32x32x2f32(a, sa[st][r], an, 0, 0, 0);
      }
    const float* Cd = Cs + dir * 64 * 65;
#pragma unroll 4
    for (int ks = 0; ks < 32; ++ks) {
      const float a = Cd[(et * 32 + r32) * 65 + 2 * ks + hi];
      const float bq = Qt[t * 65 + 2 * ks + hi];
      ac = __builtin_amdgcn_mfma_f32_32x32x2f32(a, bq, ac, 0, 0, 0);
    }
#pragma unroll
    for (int r = 0; r < 16; ++r) HB[dir * 64 * 65 + t * 65 + et * 32 + crow(r, hi)] = (an[r] + iw * ac[r]) * rden;
  }
  __syncthreads();
  {
    const int t = tid >> 3, e8 = (tid & 7) * 8;
    float v[8]; float ss = 0.f;
#pragma unroll
    for (int i = 0; i < 8; ++i) { v[i] = HB[t * 65 + e8 + i] + HB[64 * 65 + t * 65 + e8 + i]; ss += v[i] * v[i]; }
    ss += __shfl_xor(ss, 1); ss += __shfl_xor(ss, 2); ss += __shfl_xor(ss, 4);
    const float rs = rsqrtf(ss * (1.f / 64.f) + EPS);
    const u32x4 ov = *(const u32x4*)(PROJ + (size_t)(row0 + t) * PW + C_MO + hh * 64 + e8);
    const float og[8] = {bflo(ov.x), bfhi(ov.x), bflo(ov.y), bfhi(ov.y), bflo(ov.z), bfhi(ov.z), bflo(ov.w), bfhi(ov.w)};
    const float* g = p.in[I_MNORMG] + l * 64 + e8;
    float o[8];
#pragma unroll
    for (int i = 0; i < 8; ++i) o[i] = (ABL & 2) ? 0.f : v[i] * rs * g[i] * sigmoidf_(og[i]);
    u32x4 w; w.x = cvtpk(o[0], o[1]); w.y = cvtpk(o[2], o[3]); w.z = cvtpk(o[4], o[5]); w.w = cvtpk(o[6], o[7]);
    *(u32x4*)(MIX + (size_t)(row0 + t) * DM + 256 + hh * 64 + e8) = w;
  }
  __syncthreads();
}


#define KSWZ(row, colB) ((row) * 256 + ((colB) ^ (((row) & 15) << 4)))
#define SBAR() __builtin_amdgcn_sched_barrier(0)
constexpr int ATT_SHM_V = 64 * 128 * 2, ATT_SHM_K = 64 * 128 * 2;
constexpr float ATT_THR = 11.541560327111707f;
__device__ __forceinline__ int v_st(int k, int c) { const int kk = (k & ~0xC) | ((k & 4) << 1) | ((k & 8) >> 1); return ((kk >> 3) * 4 + (c >> 5)) * 512 + ((kk & 7) * 32 + (c & 31)) * 2; }
__device__ __forceinline__ int v_rd_base(int lane) { return ((lane & 3) << 3) | (((lane >> 2) & 3) << 6) | (((lane >> 4) & 1) << 5) | (((lane >> 5) & 1) << 8); }
constexpr int v_rd_off(int d0, int ks, int half) { return d0 * 512 + ks * 4096 + half * 2048; }
template <int OFF> __device__ __forceinline__ s16x4 tr_read(int vb) {
  s16x4 r; asm volatile("ds_read_b64_tr_b16 %0, %1 offset:%2" : "=&v"(r) : "v"(vb), "i"(OFF) : "memory"); return r;
}
template <int D0> __device__ __forceinline__ void pv_one(f32x16& od, int vb, bf16x8 pa0, bf16x8 pa1, bf16x8 pa2, bf16x8 pa3) {
  const s16x4 l0 = tr_read<v_rd_off(D0, 0, 0)>(vb), h0 = tr_read<v_rd_off(D0, 0, 1)>(vb), l1 = tr_read<v_rd_off(D0, 1, 0)>(vb), h1 = tr_read<v_rd_off(D0, 1, 1)>(vb);
  const s16x4 l2 = tr_read<v_rd_off(D0, 2, 0)>(vb), h2 = tr_read<v_rd_off(D0, 2, 1)>(vb), l3 = tr_read<v_rd_off(D0, 3, 0)>(vb), h3 = tr_read<v_rd_off(D0, 3, 1)>(vb);
  asm volatile("s_waitcnt lgkmcnt(0)" ::: "memory"); SBAR();
#define PK(L, H) (bf16x8){L[0], L[1], L[2], L[3], H[0], H[1], H[2], H[3]}
  od = __builtin_amdgcn_mfma_f32_32x32x16_bf16(pa0, PK(l0, h0), od, 0, 0, 0);
  od = __builtin_amdgcn_mfma_f32_32x32x16_bf16(pa1, PK(l1, h1), od, 0, 0, 0);
  od = __builtin_amdgcn_mfma_f32_32x32x16_bf16(pa2, PK(l2, h2), od, 0, 0, 0);
  od = __builtin_amdgcn_mfma_f32_32x32x16_bf16(pa3, PK(l3, h3), od, 0, 0, 0);
#undef PK
}
__device__ __forceinline__ void att_qkt(f32x16& p0, f32x16& p1, const unsigned char* Ks, const unsigned char* Qs, int qrow, int comp, int r32, int hi) {
  p0 = f32x16{}; p1 = f32x16{};
#pragma unroll
  for (int d0 = 0; d0 < 4; ++d0) {
    const int cb = ((comp * 4 + d0) * 16 + hi * 8) * 2;
    const bf16x8 b0 = *(const bf16x8*)(Ks + KSWZ(r32, cb));
    const bf16x8 b1 = *(const bf16x8*)(Ks + KSWZ(32 + r32, cb));
    const bf16x8 q = *(const bf16x8*)(Qs + KSWZ(qrow, cb));
    p0 = __builtin_amdgcn_mfma_f32_32x32x16_bf16(b0, q, p0, 0, 0, 0);
    p1 = __builtin_amdgcn_mfma_f32_32x32x16_bf16(b1, q, p1, 0, 0, 0);
  }
}
__device__ __forceinline__ void att_softmax(f32x16& p0, f32x16& p1, float& m_reg, float& l_reg, float& alpha, bf16x8& pa0, bf16x8& pa1, bf16x8& pa2, bf16x8& pa3) {
  float pmax = p0[0];
#pragma unroll
  for (int r = 1; r < 16; ++r) pmax = fmaxf(pmax, p0[r]);
#pragma unroll
  for (int r = 0; r < 16; ++r) pmax = fmaxf(pmax, p1[r]);
  { auto rr = __builtin_amdgcn_permlane32_swap(__float_as_uint(pmax), __float_as_uint(pmax), false, false);
    pmax = fmaxf(__uint_as_float(rr[0]), __uint_as_float(rr[1])); }
  float mn;
  if (__builtin_expect(__all(pmax - m_reg <= ATT_THR), 1)) { mn = m_reg; alpha = 1.f; }
  else { mn = fmaxf(m_reg, pmax); alpha = __builtin_amdgcn_exp2f(m_reg - mn); m_reg = mn; }
#pragma unroll
  for (int r = 0; r < 16; ++r) { p0[r] = __builtin_amdgcn_exp2f(p0[r] - mn); p1[r] = __builtin_amdgcn_exp2f(p1[r] - mn); }
  float ps = 0.f;
#pragma unroll
  for (int r = 0; r < 16; ++r) ps += p0[r];
#pragma unroll
  for (int r = 0; r < 16; ++r) ps += p1[r];
  { auto rr = __builtin_amdgcn_permlane32_swap(__float_as_uint(ps), __float_as_uint(ps), false, false);
    ps = __uint_as_float(rr[0]) + __uint_as_float(rr[1]); }
  l_reg = l_reg * alpha + ps;
#define PK4(P, BASE, OUT) do { unsigned a0 = cvtpk(P[BASE + 0], P[BASE + 1]), a1 = cvtpk(P[BASE + 2], P[BASE + 3]);   \
    unsigned b0 = cvtpk(P[BASE + 4], P[BASE + 5]), b1 = cvtpk(P[BASE + 6], P[BASE + 7]);                              \
    auto r0 = __builtin_amdgcn_permlane32_swap(a0, b0, false, false); auto r1 = __builtin_amdgcn_permlane32_swap(a1, b1, false, false); \
    u32x4 w = {r0[0], r1[0], r0[1], r1[1]}; OUT = *reinterpret_cast<bf16x8*>(&w); } while (0)
  PK4(p0, 0, pa0); PK4(p0, 8, pa1); PK4(p1, 0, pa2); PK4(p1, 8, pa3);
#undef PK4
}
__device__ __forceinline__ void att_unit(const bf16_t* __restrict__ Qb, const bf16_t* __restrict__ Kh, const bf16_t* __restrict__ Vh, bf16_t* __restrict__ Ob,
                                         int nkeys, float lam, const float* __restrict__ ng, float oscale, unsigned char* lds) {
  int tid_ = threadIdx.x; asm volatile("" : "+v"(tid_)); const int tid = tid_, wid = tid >> 6, lane = tid & 63, r32 = lane & 31, hi = lane >> 5;
  unsigned char* V_lds = lds; unsigned char* K_lds = lds + 2 * ATT_SHM_V;
  float* wsl = (float*)(lds + 2 * ATT_SHM_V + 2 * ATT_SHM_K) + wid * 64; float* li_l = wsl; float* al_l = wsl + 32;
  float m0 = -1e30f, l0 = 0.f, m1 = -1e30f, l1 = 0.f;
  f32x16 o0[4] = {}, o1[4] = {};
  unsigned char* Q_lds = lds + 2 * ATT_SHM_V + 2 * ATT_SHM_K + 2048;
#pragma unroll
  for (int i = 0; i < 8; ++i) { const int id = tid + 512 * i, qrw = id >> 4, ch = id & 15;
    *(bf16x8*)(Q_lds + KSWZ(qrw, ch * 16)) = *(const bf16x8*)(Qb + (size_t)qrw * PW + ch * 8); }
  const int qrow = wid * 32 + r32;
  const int sr = tid >> 4, sc = (tid & 15) * 8, vst0 = v_st(sr, sc), vst1 = v_st(32 + sr, sc);
  const int vb0 = (int)(uintptr_t)V_lds + v_rd_base(lane);
  bf16x8 vs0, vs1, ks0, ks1;
#define SLOAD(k0) do { vs0 = *(const bf16x8*)(Vh + (size_t)((k0) + sr) * PW + sc); vs1 = *(const bf16x8*)(Vh + (size_t)((k0) + 32 + sr) * PW + sc); \
    ks0 = *(const bf16x8*)(Kh + (size_t)((k0) + sr) * PW + sc); ks1 = *(const bf16x8*)(Kh + (size_t)((k0) + 32 + sr) * PW + sc); } while (0)
#define SWRITE(b) do { *(bf16x8*)(V_lds + (b) * ATT_SHM_V + vst0) = vs0; *(bf16x8*)(V_lds + (b) * ATT_SHM_V + vst1) = vs1; const int kc = sc * 2; \
    *(bf16x8*)(K_lds + (b) * ATT_SHM_K + KSWZ(sr, kc)) = ks0; *(bf16x8*)(K_lds + (b) * ATT_SHM_K + KSWZ(32 + sr, kc)) = ks1; } while (0)
#define RESC(o, a) do { if (__any((a) < 1.f)) { if (hi == 0) al_l[r32] = (a); asm volatile("s_waitcnt lgkmcnt(0)" ::: "memory"); \
    _Pragma("unroll") for (int d = 0; d < 4; ++d) _Pragma("unroll") for (int r = 0; r < 16; ++r) o[d][r] *= al_l[crow(r, hi)]; } } while (0)
  const int NT = nkeys / 64;
  SLOAD(0); SWRITE(0); __syncthreads();
  for (int j = 0; j < NT; ++j) {
    const int cur = j & 1;
    if (j + 1 < NT) SLOAD((j + 1) * 64);
    const unsigned char* Kc = K_lds + cur * ATT_SHM_K; const int vb = vb0 + cur * ATT_SHM_V;
    f32x16 p0, p1; float alpha; bf16x8 pa0, pa1, pa2, pa3;
    att_qkt(p0, p1, Kc, Q_lds, qrow, 0, r32, hi);
    att_softmax(p0, p1, m0, l0, alpha, pa0, pa1, pa2, pa3);
    RESC(o0, alpha);
    pv_one<0>(o0[0], vb, pa0, pa1, pa2, pa3); pv_one<1>(o0[1], vb, pa0, pa1, pa2, pa3); pv_one<2>(o0[2], vb, pa0, pa1, pa2, pa3); pv_one<3>(o0[3], vb, pa0, pa1, pa2, pa3);
    att_qkt(p0, p1, Kc, Q_lds, qrow, 1, r32, hi);
    att_softmax(p0, p1, m1, l1, alpha, pa0, pa1, pa2, pa3);
    RESC(o1, alpha);
    pv_one<0>(o1[0], vb, pa0, pa1, pa2, pa3); pv_one<1>(o1[1], vb, pa0, pa1, pa2, pa3); pv_one<2>(o1[2], vb, pa0, pa1, pa2, pa3); pv_one<3>(o1[3], vb, pa0, pa1, pa2, pa3);
    if (j + 1 < NT) SWRITE(cur ^ 1);
    __syncthreads();
  }
  if (hi == 0) { li_l[r32] = 1.f / l0; al_l[r32] = lam / l1; }
  asm volatile("s_waitcnt lgkmcnt(0)" ::: "memory");
  float ss[16];
#pragma unroll
  for (int r = 0; r < 16; ++r) {
    const float a = li_l[crow(r, hi)], bq = al_l[crow(r, hi)];
    float s = 0.f;
#pragma unroll
    for (int d = 0; d < 4; ++d) { const float v = o0[d][r] * a - o1[d][r] * bq; o0[d][r] = v; s += v * v; }
    s += __shfl_xor(s, 1); s += __shfl_xor(s, 2); s += __shfl_xor(s, 4); s += __shfl_xor(s, 8); s += __shfl_xor(s, 16);
    ss[r] = rsqrtf(s * (1.f / 128.f) + EPS) * oscale;
  }
  bf16_t* Ow = Ob + (size_t)(wid * 32) * DM;
#pragma unroll
  for (int d = 0; d < 4; ++d) {
    const float g = ng[d * 32 + r32];
#pragma unroll
    for (int r = 0; r < 16; ++r) Ow[(size_t)crow(r, hi) * DM + d * 32 + r32] = (ABL & 4) ? (bf16_t)0 : (bf16_t)(cvtpk(o0[d][r] * ss[r] * g, 0.f) & 0xffffu);
  }
  __syncthreads();
#undef SLOAD
#undef SWRITE
#undef RESC
}

__device__ __forceinline__ float ins16(float (&a)[16], float x) {
#pragma unroll
  for (int i = 0; i < 16; ++i) { const float h = fmaxf(a[i], x); x = fminf(a[i], x); a[i] = h; }
  return x;
}
__device__ __forceinline__ float gelu_erf(float x) { return 0.5f * x * (1.f + erff(x * 0.70710678118654752440f)); }
__device__ __forceinline__ void peer_unit(const Params& p, int l, int unit, unsigned char* lds) {
  int tid_ = threadIdx.x; asm volatile("" : "+v"(tid_)); const int tid = tid_, lane = tid & 63, wid = tid >> 6, r32 = lane & 31, hi = lane >> 5;
  int* EID = (int*)lds;
  float* GW = (float*)(lds + 16384);
  unsigned char* IDX = lds + 32768;
  const int row0 = unit * 32;
  const bf16_t* QP = (const bf16_t*)(p.ws + WS_PROJ);
  const bf16_t* KEYS = (const bf16_t*)(p.ws + WS_KEYS) + (size_t)l * 131072;
  {
    const int h = wid;
    float top[2][16];
#pragma unroll
    for (int pp = 0; pp < 2; ++pp) {
      const bf16_t* qrow = QP + (size_t)(row0 + r32) * DM + h * 128 + pp * 64 + hi * 8;
      const bf16_t* kb = KEYS + ((size_t)(h * 2 + pp) * 128 + r32) * 64 + hi * 8;
      bf16x8 bq[4];
#pragma unroll
      for (int ks = 0; ks < 4; ++ks) bq[ks] = *(const bf16x8*)(qrow + ks * 16);
      float (&lst)[16] = top[pp];
#pragma unroll
      for (int i = 0; i < 16; ++i) lst[i] = -INFINITY;
#pragma unroll
      for (int nt = 0; nt < 4; ++nt) {
        f32x16 acc = {};
#pragma unroll
        for (int ks = 0; ks < 4; ++ks) {
          const bf16x8 ak = *(const bf16x8*)(kb + (size_t)nt * 32 * 64 + ks * 16);
          acc = __builtin_amdgcn_mfma_f32_32x32x16_bf16(ak, bq[ks], acc, 0, 0, 0);
        }
#pragma unroll
        for (int r = 0; r < 16; ++r) {
          const unsigned key = (__float_as_uint(acc[r]) & ~0x7Fu) | (unsigned)(nt * 32 + crow(r, hi));
          ins16(lst, __uint_as_float(key));
        }
        SBAR();
      }
      float oth[16];
#pragma unroll
      for (int i = 0; i < 16; ++i) oth[i] = __shfl_xor(lst[i], 32);
#pragma unroll
      for (int i = 0; i < 16; ++i) ins16(lst, oth[i]);
      if (hi == 0) {
        unsigned w[4];
#pragma unroll
        for (int i = 0; i < 4; ++i)
          w[i] = (__float_as_uint(lst[4 * i]) & 0x7Fu) | ((__float_as_uint(lst[4 * i + 1]) & 0x7Fu) << 8) | ((__float_as_uint(lst[4 * i + 2]) & 0x7Fu) << 16) | ((__float_as_uint(lst[4 * i + 3]) & 0x7Fu) << 24);
        *(u32x4*)(IDX + ((r32 * 8 + h) * 2 + pp) * 16) = (u32x4){w[0], w[1], w[2], w[3]};
      }
    }
    float best[16];
#pragma unroll
    for (int i = 0; i < 16; ++i) best[i] = -INFINITY;
#pragma unroll
    for (int i = 0; i < 16; ++i)
#pragma unroll
      for (int j = 0; j < 16; ++j)
        if ((i + 1) * (j + 1) <= 16) {
          const float s = __uint_as_float(__float_as_uint(top[0][i]) & ~0x7Fu) + __uint_as_float(__float_as_uint(top[1][j]) & ~0x7Fu);
          ins16(best, __uint_as_float((__float_as_uint(s) & ~0xFFu) | (unsigned)(i * 16 + j)));
        }
    asm volatile("s_waitcnt lgkmcnt(0)" ::: "memory");
    if (hi == 0) {
      const unsigned char* ib = IDX + ((r32 * 8 + h) * 2) * 16;
      const float mx = __uint_as_float(__float_as_uint(best[0]) & ~0xFFu);
      float w[16]; float sum = 0.f;
#pragma unroll
      for (int k = 0; k < 16; ++k) { w[k] = __expf(__uint_as_float(__float_as_uint(best[k]) & ~0xFFu) - mx); sum += w[k]; }
      const float rsum = 1.f / sum;
#pragma unroll
      for (int k = 0; k < 16; ++k) {
        const unsigned ij = __float_as_uint(best[k]) & 0xFFu;
        const int e = (int)ib[ij >> 4] * 128 + (int)ib[16 + (ij & 15)];
        EID[r32 * 128 + h * 16 + k] = e; GW[r32 * 128 + h * 16 + k] = w[k] * rsum;
      }
    }
  }
  __syncthreads();
  const bf16_t* H = (const bf16_t*)(p.ws + WS_H);
  const bf16_t* PU = (const bf16_t*)(p.ws + WS_PU) + (size_t)l * NEXP * DM;
  const bf16_t* PVt = (const bf16_t*)(p.ws + WS_PV) + (size_t)l * NEXP * DM;
  float* XC = (float*)(p.ws + WS_XCUR);
  const float* MOD = (const float*)(p.ws + WS_MOD);
  for (int tt = 0; tt < 4; ++tt) {
    const int t = wid * 4 + tt, row = row0 + t;
    const u32x4 hA = *(const u32x4*)(H + (size_t)row * DM + lane * 8), hB = *(const u32x4*)(H + (size_t)row * DM + 512 + lane * 8);
    float acc[16];
#pragma unroll
    for (int i = 0; i < 16; ++i) acc[i] = 0.f;
    for (int g8 = 0; g8 < 16; ++g8) {
      u32x4 ua[8], ub[8]; int eid[8]; float gwt[8];
#pragma unroll
      for (int i = 0; i < 8; ++i) {
        eid[i] = __builtin_amdgcn_readfirstlane(EID[t * 128 + g8 * 8 + i]);
        gwt[i] = __uint_as_float(__builtin_amdgcn_readfirstlane(__float_as_uint(GW[t * 128 + g8 * 8 + i])));
        const bf16_t* ur = PU + (size_t)eid[i] * DM + lane * 8;
        ua[i] = *(const u32x4*)ur; ub[i] = *(const u32x4*)(ur + 512);
      }
      float dts[8];
#pragma unroll
      for (int i = 0; i < 8; ++i) {
        float d = 0.f;
#define DOT2(U, Hh) d += bflo(U) * bflo(Hh) + bfhi(U) * bfhi(Hh)
        DOT2(ua[i].x, hA.x); DOT2(ua[i].y, hA.y); DOT2(ua[i].z, hA.z); DOT2(ua[i].w, hA.w);
        DOT2(ub[i].x, hB.x); DOT2(ub[i].y, hB.y); DOT2(ub[i].z, hB.z); DOT2(ub[i].w, hB.w);
#undef DOT2
        dts[i] = d;
      }
#pragma unroll
      for (int i = 0; i < 8; ++i) {
        const bf16_t* vr = PVt + (size_t)eid[i] * DM + lane * 8;
        ua[i] = *(const u32x4*)vr; ub[i] = *(const u32x4*)(vr + 512);
      }
#pragma unroll
      for (int i = 0; i < 8; ++i) dts[i] = gwt[i] * gelu_erf(wave_sum(dts[i]));
#pragma unroll
      for (int i = 0; i < 8; ++i) {
        const float c = dts[i];
        acc[0] += c * bflo(ua[i].x); acc[1] += c * bfhi(ua[i].x); acc[2] += c * bflo(ua[i].y); acc[3] += c * bfhi(ua[i].y);
        acc[4] += c * bflo(ua[i].z); acc[5] += c * bfhi(ua[i].z); acc[6] += c * bflo(ua[i].w); acc[7] += c * bfhi(ua[i].w);
        acc[8] += c * bflo(ub[i].x); acc[9] += c * bfhi(ub[i].x); acc[10] += c * bflo(ub[i].y); acc[11] += c * bfhi(ub[i].y);
        acc[12] += c * bflo(ub[i].z); acc[13] += c * bfhi(ub[i].z); acc[14] += c * bflo(ub[i].w); acc[15] += c * bfhi(ub[i].w);
      }
    }
    const int mr = mod_row(row);
    const float* g2 = MOD + ((size_t)l * 5 + mr) * 6144 + 5 * 1024;
    float* xr = XC + (size_t)row * DM;
    float xn[16]; float ssq = 0.f;
    if (ABL & 8) {
#pragma unroll
      for (int i = 0; i < 16; ++i) acc[i] = 0.f;
    }
#pragma unroll
    for (int hh = 0; hh < 2; ++hh)
#pragma unroll
      for (int v4 = 0; v4 < 2; ++v4) {
        const int c = hh * 512 + lane * 8 + v4 * 4;
        const f32x4 xo = *(const f32x4*)(xr + c), gg = *(const f32x4*)(g2 + c);
        f32x4 o;
        o.x = xo.x + gg.x * acc[hh * 8 + v4 * 4 + 0]; o.y = xo.y + gg.y * acc[hh * 8 + v4 * 4 + 1];
        o.z = xo.z + gg.z * acc[hh * 8 + v4 * 4 + 2]; o.w = xo.w + gg.w * acc[hh * 8 + v4 * 4 + 3];
        xn[hh * 8 + v4 * 4 + 0] = o.x; xn[hh * 8 + v4 * 4 + 1] = o.y; xn[hh * 8 + v4 * 4 + 2] = o.z; xn[hh * 8 + v4 * 4 + 3] = o.w;
        ssq += (o.x * o.x + o.y * o.y) + (o.z * o.z + o.w * o.w);
        if (l < DEPTH - 1) *(f32x4*)(xr + c) = o;
      }
    const float rs = rsqrtf(wave_sum(ssq) * (1.f / DM) + EPS);
    if (l == DEPTH - 1) {
      const int b = row / SEGL, s = row - b * SEGL;
      float* orow = p.out + ((size_t)(b * SEQ + (s - CTXL))) * DM;
      const float* fg = p.in[I_FINALG];
#pragma unroll
      for (int hh = 0; hh < 2; ++hh)
#pragma unroll
        for (int v4 = 0; v4 < 2; ++v4) {
          const int c = hh * 512 + lane * 8 + v4 * 4;
          const f32x4 gg = *(const f32x4*)(fg + c);
          f32x4 o; o.x = xn[hh * 8 + v4 * 4 + 0] * rs * gg.x; o.y = xn[hh * 8 + v4 * 4 + 1] * rs * gg.y; o.z = xn[hh * 8 + v4 * 4 + 2] * rs * gg.z; o.w = xn[hh * 8 + v4 * 4 + 3] * rs * gg.w;
          *(f32x4*)(orow + c) = o;
        }
    } else {
      const float* m = MOD + ((size_t)(l + 1) * 5 + mr) * 6144;
      const float* ng = p.in[I_N1G] + (l + 1) * DM;
      bf16_t* hrow = (bf16_t*)(p.ws + WS_H) + (size_t)row * DM;
#pragma unroll
      for (int hh = 0; hh < 2; ++hh) {
        float y[8];
#pragma unroll
        for (int i = 0; i < 8; ++i) { const int c = hh * 512 + lane * 8 + i; y[i] = xn[hh * 8 + i] * rs * ng[c] * (1.f + m[1024 + c]) + m[c]; }
        u32x4 w; w.x = cvtpk(y[0], y[1]); w.y = cvtpk(y[2], y[3]); w.z = cvtpk(y[4], y[5]); w.w = cvtpk(y[6], y[7]);
        *(u32x4*)(hrow + hh * 512 + lane * 8) = w;
      }
    }
  }
  __syncthreads();
}

__device__ __forceinline__ void phase_c1(const Params& p, int l, unsigned char* lds) {
  constexpr int NLOC = NBATCH * 4 * NCH, NCONV = T / 32;
  for (int u = blockIdx.x; u < NLOC + NCONV; u += gridDim.x) {
    if (u < NLOC) ml_local_unit(p, l, u, lds);
    else {
      const int cu = u - NLOC;
      if (l == DEPTH - 1 && (cu % (SEGL / 32)) < (CTXL / 32)) continue;
      conv_unit(p, l, cu, lds);
    }
  }
}
__device__ __forceinline__ void phase_c2(const Params& p, int l, unsigned char* lds) {
  ml_scan(p);
  const float* lp = p.in[I_DLAM] + l * 256;
  float s01 = 0.f, s23 = 0.f;
  for (int i = 0; i < 64; ++i) { s01 += lp[i] * lp[64 + i]; s23 += lp[128 + i] * lp[192 + i]; }
  const float lam_init = 0.8f - 0.6f * expf(-0.3f * (float)l);
  const float lam = expf(s01) - expf(s23) + lam_init;
  const bf16_t* PROJ = (const bf16_t*)(p.ws + WS_PROJ);
  bf16_t* MIX = (bf16_t*)(p.ws + WS_MIX);
  const float* ng = p.in[I_DNORMG] + l * 128;
  const int nun = 512 + (l < DEPTH - 1 ? 16 : 0);
  for (int u = blockIdx.x; u < nun; u += gridDim.x) {
    int bh, qrow, nkeys;
    if (u < 512) { const int xcd = u & 7, i = (u >> 3) & 31, rnd = u >> 8; bh = 2 * xcd + rnd; qrow = CTXL + i * 256; nkeys = SEGL; }
    else { bh = u - 512; qrow = 0; nkeys = CTXL; }
    const int b = bh >> 2, h = bh & 3;
    const size_t tok0 = (size_t)b * SEGL;
    att_unit(PROJ + (tok0 + qrow) * PW + C_DQ + h * 128, PROJ + tok0 * PW + C_DK + h * 128, PROJ + tok0 * PW + C_DV + h * 128,
             MIX + (tok0 + qrow) * DM + 512 + h * 128, nkeys, lam, ng, 1.f - lam_init, lds);
  }
}
__device__ __forceinline__ void phase_c3(const Params& p, int l, unsigned char* lds) {
  constexpr int NU = NBATCH * 4 * NCH;
  for (int u = blockIdx.x; u < NU; u += gridDim.x) {
    if (l == DEPTH - 1 && (u % NCH) < 4) continue;
    ml_out_unit(p, l, u, lds);
  }
}
__device__ __forceinline__ void phase_peer(const Params& p, int l, unsigned char* lds) {
  constexpr int NU = T / 32;
  for (int u = blockIdx.x; u < NU; u += gridDim.x) {
    if (l == DEPTH - 1 && (u % (SEGL / 32)) < (CTXL / 32)) continue;
    peer_unit(p, l, u, lds);
  }
}

__global__ void __launch_bounds__(512, 2) mk_fwd(Params p) {
  cg::grid_group grid = cg::this_grid();
  extern __shared__ __attribute__((aligned(16))) unsigned char lds[];
  const int lo = p.ph_lo, hi = p.ph_hi;
#define IN(k) (lo <= (k) && (k) < hi)
#ifndef PHASEMASK
#define PHASEMASK 0xFFFF
#endif
#define PH(i) ((PHASEMASK >> (i)) & 1)
#define SEAM(k) do { if (IN(k) && IN((k) + 1)) grid.sync(); } while (0)
  if (PH(0) && IN(0)) { p0_mod(p, lds, (float*)(p.ws + WS_MOD)); p0_convert(p, lds); }
  SEAM(0);
  if (PH(1) && IN(1)) phase_norm(p, 0, 0, true, false);
  SEAM(1);
#pragma unroll 1
  for (int l_ = 0; l_ < DEPTH; ++l_) {
    int l = l_; asm volatile("" : "+s"(l));
    const int b = 2 + 8 * l;
    if (PH(2) && IN(b + 0)) phase_inproj(p, l, lds);
    SEAM(b + 0);
    if (PH(3) && IN(b + 1)) phase_c1(p, l, lds);
    SEAM(b + 1);
    if (PH(4) && IN(b + 2)) phase_c2(p, l, lds);
    SEAM(b + 2);
    if (PH(5) && IN(b + 3)) phase_c3(p, l, lds);
    SEAM(b + 3);
    if (PH(6) && IN(b + 4)) phase_outproj(p, l, lds);
    SEAM(b + 4);
    if (PH(7) && IN(b + 5)) phase_norm(p, l, 1, false, l == DEPTH - 1);
    SEAM(b + 5);
    if (PH(8) && IN(b + 6)) phase_peerq(p, l, lds);
    SEAM(b + 6);
    if (PH(9) && IN(b + 7)) phase_peer(p, l, lds);
    SEAM(b + 7);
  }
#undef IN
#undef SEAM
}

extern "C" void kernel_launch(void* const* d_in, const int* in_sizes, int n_in, void* d_out, int out_size,
                              void* d_ws, size_t ws_size, hipStream_t stream) {
  static int grid = 0;
  if (grid == 0) {
    int dev = 0, cus = 0, per_cu = 0;
    (void)hipGetDevice(&dev);
    (void)hipDeviceGetAttribute(&cus, hipDeviceAttributeMultiprocessorCount, dev);
    (void)hipFuncSetAttribute((const void*)mk_fwd, hipFuncAttributeMaxDynamicSharedMemorySize, LDS_BYTES);
    (void)hipOccupancyMaxActiveBlocksPerMultiprocessor(&per_cu, (const void*)mk_fwd, 512, LDS_BYTES);
    fprintf(stderr, "kernel_launch: cus %d per_cu %d ws %zu (need %zu) n_in %d\n", cus, per_cu, ws_size, (size_t)WS_END, n_in);
    if (ws_size < WS_END || n_in != 23 || per_cu < 1) { fprintf(stderr, "kernel_launch: bad configuration, nothing launched\n"); grid = -1; return; }
    grid = cus;
  }
  if (grid < 0) return;
  Params p{};
  for (int i = 0; i < 23; ++i) p.in[i] = (const float*)d_in[i];
  p.out = (float*)d_out; p.ws = (unsigned char*)d_ws; p.ph_lo = 0; p.ph_hi = 34;
  void* args[] = {&p};
  hipError_t e = hipLaunchCooperativeKernel((const void*)mk_fwd, dim3(grid), dim3(512), args, LDS_BYTES, stream);
  if (e != hipSuccess) fprintf(stderr, "cooperative launch failed: %s (grid %d)\n", hipGetErrorString(e), grid);
}
```

```cpp
#include <hip/hip_runtime.h>
#include <hip/hip_cooperative_groups.h>
#include <cstdio>
#include <cstdint>
namespace cg = cooperative_groups;

constexpr int DM = 1024, NBATCH = 4, SEQ = 8192, CTXL = 256, SEGL = CTXL + SEQ, T = NBATCH * SEGL, DEPTH = 4;
constexpr int IN_W = 3088, PW = 3072;
constexpr int C_A = 0, C_MQ = 512, C_MK = 768, C_MV = 1024, C_MO = 1280, C_DQ = 1536, C_DK = 2048, C_DV = 2560;
constexpr int NCH = SEGL / 64;
constexpr int NEXP = 16384;
constexpr float EPS = 1e-6f;
#ifndef ABL
#define ABL 0
#endif
#ifndef REP_ATT
#define REP_ATT 1
#endif
#ifndef REP_PEER
#define REP_PEER 1
#endif
#ifndef REP_GEMM
#define REP_GEMM 1
#endif
constexpr float QSCALE = 0.125f * 1.4426950408889634f;

constexpr size_t MiB = 1u << 20;
constexpr size_t WS_CTL = 0, WS_MOD = 1 * MiB, WS_ROPE = 2 * MiB, WS_WG = 4 * MiB, WS_KEYS = 5 * MiB, WS_MLMETA = 6 * MiB,
                 WS_GATES = 7 * MiB, WS_WIN = 10 * MiB, WS_WOUT = 34 * MiB, WS_WQ = 42 * MiB, WS_PU = 50 * MiB, WS_PV = 114 * MiB, WS_PSC = 178 * MiB  ,
                 WS_XCUR = 306 * MiB, WS_H = 438 * MiB, WS_MIX = 504 * MiB, WS_PROJ = 570 * MiB, WS_ULOC = 768 * MiB, WS_END = 836 * MiB;
constexpr int USTRIDE = 4160;

constexpr int LDS_BYTES = 139264;

typedef unsigned short bf16_t;
typedef short bf16x8 __attribute__((ext_vector_type(8)));
typedef short s16x4 __attribute__((ext_vector_type(4)));
typedef float f32x4 __attribute__((ext_vector_type(4)));
typedef float f32x16 __attribute__((ext_vector_type(16)));
typedef unsigned u32x4 __attribute__((ext_vector_type(4)));
typedef unsigned u32x2 __attribute__((ext_vector_type(2)));
typedef __bf16 bf16x2v __attribute__((ext_vector_type(2)));
typedef float f32x2 __attribute__((ext_vector_type(2)));

struct Params {
  const float* in[23];
  float* out;
  unsigned char* ws;
  int ph_lo, ph_hi;
};
enum { I_X = 0, I_C, I_CTX, I_CCTX, I_ADAW, I_ADAB, I_N1G, I_N2G, I_WIN, I_CONVW, I_CONVB, I_CLNG, I_CLNB, I_GATEB, I_MNORMG, I_DLAM, I_DNORMG,
       I_WOUT, I_PWQ, I_PKEYS, I_PU, I_PV, I_FINALG };

__device__ __forceinline__ unsigned cvtpk(float lo, float hi) { unsigned r; asm volatile("v_cvt_pk_bf16_f32 %0, %1, %2" : "=v"(r) : "v"(lo), "v"(hi)); return r; }
__device__ __forceinline__ float bflo(unsigned u) { return __uint_as_float(u << 16); }
__device__ __forceinline__ float bfhi(unsigned u) { return __uint_as_float(u & 0xffff0000u); }
__device__ __forceinline__ float bf1(bf16_t u) { return __uint_as_float(((unsigned)u) << 16); }
__device__ __forceinline__ int crow(int r, int hi) { return (r & 3) + 8 * (r >> 2) + 4 * hi; }
__device__ __forceinline__ float wave_sum(float v) {
#pragma unroll
  for (int o = 1; o < 64; o <<= 1) v += __shfl_xor(v, o);
  return v;
}
__device__ __forceinline__ float wave_max(float v) {
#pragma unroll
  for (int o = 1; o < 64; o <<= 1) v = fmaxf(v, __shfl_xor(v, o));
  return v;
}
__device__ __forceinline__ float sigmoidf_(float x) { return 1.f / (1.f + __expf(-x)); }
__device__ __forceinline__ float logsigmoidf_(float x) { return fminf(x, 0.f) - log1pf(__expf(-fabsf(x))); }
__device__ __forceinline__ const float* in_row(const float* x, const float* ctx, int row) {
  const int b = row / SEGL, s = row - b * SEGL;
  return s < CTXL ? ctx + ((size_t)(b * CTXL + s)) * DM : x + ((size_t)(b * SEQ + (s - CTXL))) * DM;
}
__device__ __forceinline__ int mod_row(int row) { const int b = row / SEGL, s = row - b * SEGL; return s < CTXL ? 4 : b; }

__device__ __forceinline__ void p0_mod(const Params& p, unsigned char* lds, float* MOD) {
  float* sil = (float*)lds;
  float* red = (float*)(lds + 20480);
  int tid_ = threadIdx.x; asm volatile("" : "+v"(tid_)); const int tid = tid_, lane = tid & 63, wid = tid >> 6;
  for (int i = tid; i < 5 * 1024; i += 512) {
    const float v = i < 4096 ? p.in[I_C][i] : p.in[I_CCTX][i - 4096];
    sil[i] = v / (1.f + __expf(-v));
  }
  __syncthreads();
  for (int item = blockIdx.x; item < DEPTH * 96; item += gridDim.x) {
    const int l = item / 96, j0 = (item % 96) * 64;
    const float* W = p.in[I_ADAW] + (size_t)l * DM * 6144 + j0 + lane;
    float a0 = 0.f, a1 = 0.f, a2 = 0.f, a3 = 0.f, a4 = 0.f;
    const int k0 = wid * 128;
#pragma unroll 8
    for (int k = k0; k < k0 + 128; ++k) {
      const float w = W[(size_t)k * 6144];
      a0 += sil[k] * w; a1 += sil[1024 + k] * w; a2 += sil[2048 + k] * w; a3 += sil[3072 + k] * w; a4 += sil[4096 + k] * w;
    }
    red[(wid * 5 + 0) * 64 + lane] = a0; red[(wid * 5 + 1) * 64 + lane] = a1; red[(wid * 5 + 2) * 64 + lane] = a2;
    red[(wid * 5 + 3) * 64 + lane] = a3; red[(wid * 5 + 4) * 64 + lane] = a4;
    __syncthreads();
    if (tid < 320) {
      const int r = tid >> 6;
      float s = 0.f;
#pragma unroll
      for (int w = 0; w < 8; ++w) s += red[(w * 5 + r) * 64 + lane];
      MOD[((size_t)l * 5 + r) * 6144 + j0 + lane] = s + p.in[I_ADAB][l * 6144 + j0 + lane];
    }
    __syncthreads();
  }
}
__device__ __forceinline__ void transpose_item(const float* W, int ldw, int srccol0, bf16_t* WT, int K, int n0, int k0, float* scr, int lane) {
#pragma unroll 8
  for (int i = 0; i < 32; ++i) { const int kk = 2 * i + (lane >> 5); scr[kk * 33 + (lane & 31)] = W[(size_t)(k0 + kk) * ldw + srccol0 + (lane & 31)]; }
  asm volatile("s_waitcnt lgkmcnt(0)" ::: "memory");
  const int c = lane & 7;
#pragma unroll
  for (int j = 0; j < 4; ++j) {
    const int n = (lane >> 3) + 8 * j; const float* s = scr + (8 * c) * 33 + n;
    u32x4 o; o.x = cvtpk(s[0], s[33]); o.y = cvtpk(s[66], s[99]); o.z = cvtpk(s[132], s[165]); o.w = cvtpk(s[198], s[231]);
    *(u32x4*)(WT + (size_t)(n0 + n) * K + k0 + 8 * c) = o;
  }
  asm volatile("s_waitcnt lgkmcnt(0)" ::: "memory");
}
__device__ __forceinline__ void p0_convert(const Params& p, unsigned char* lds) {
  int tid_ = threadIdx.x; asm volatile("" : "+v"(tid_)); const int tid = tid_, lane = tid & 63, wid = tid >> 6;
  const int gw = blockIdx.x * 8 + wid, NGW = gridDim.x * 8;
  const size_t gt = (size_t)blockIdx.x * 512 + tid, NGT = (size_t)gridDim.x * 512;
  float* scr = (float*)(lds + 32768) + wid * (64 * 33);
  bf16_t* WIN = (bf16_t*)(p.ws + WS_WIN); bf16_t* WOUT = (bf16_t*)(p.ws + WS_WOUT); bf16_t* WQ = (bf16_t*)(p.ws + WS_WQ);
  constexpr int I_IN = 16 * 96, I_O = 16 * 32, PER_L = I_IN + 2 * I_O;
  for (int it = gw; it < DEPTH * PER_L; it += NGW) {
    const int l = it / PER_L; int r = it % PER_L;
    if (r < I_IN) { const int kb = r / 96, nb = r % 96, n0 = nb * 32; const int src = n0 < 1536 ? n0 : n0 + 16;
      transpose_item(p.in[I_WIN] + (size_t)l * DM * IN_W, IN_W, src, WIN + (size_t)l * PW * DM, DM, n0, kb * 64, scr, lane); continue; }
    r -= I_IN;
    if (r < I_O) { const int kb = r / 32, nb = r % 32;
      transpose_item(p.in[I_WOUT] + (size_t)l * DM * DM, DM, nb * 32, WOUT + (size_t)l * DM * DM, DM, nb * 32, kb * 64, scr, lane); continue; }
    r -= I_O;
    { const int kb = r / 32, nb = r % 32;
      transpose_item(p.in[I_PWQ] + (size_t)l * DM * DM, DM, nb * 32, WQ + (size_t)l * DM * DM, DM, nb * 32, kb * 64, scr, lane); }
  }
  bf16_t* WG = (bf16_t*)(p.ws + WS_WG);
  for (size_t i = gt; i < (size_t)DEPTH * 16 * DM; i += NGT) {
    const int l = (int)(i / (16 * DM)), g = (int)((i / DM) % 16), k = (int)(i % DM);
    WG[i] = (bf16_t)(cvtpk(p.in[I_WIN][(size_t)l * DM * IN_W + (size_t)k * IN_W + 1536 + g], 0.f) & 0xffffu);
  }
  bf16_t* KEYS = (bf16_t*)(p.ws + WS_KEYS);
  for (size_t i = gt; i < (size_t)DEPTH * 131072 / 8; i += NGT) {
    const f32x4 a = ((const f32x4*)p.in[I_PKEYS])[2 * i], b = ((const f32x4*)p.in[I_PKEYS])[2 * i + 1];
    u32x4 o; o.x = cvtpk(a.x, a.y); o.y = cvtpk(a.z, a.w); o.z = cvtpk(b.x, b.y); o.w = cvtpk(b.z, b.w);
    ((u32x4*)KEYS)[i] = o;
  }
  {
    unsigned char* PUq = p.ws + WS_PU; unsigned char* PVq = p.ws + WS_PV; float* PSC = (float*)(p.ws + WS_PSC);
    const int nrows = DEPTH * NEXP;
    for (int r = gw; r < 2 * nrows; r += NGW) {
      const int tb = r >= nrows, rr = tb ? r - nrows : r;
      const f32x4* srow = (const f32x4*)((tb ? p.in[I_PV] : p.in[I_PU]) + (size_t)rr * DM) + lane * 4;
      f32x4 v[4]; float mx = 0.f;
#pragma unroll
      for (int j = 0; j < 4; ++j) { v[j] = __builtin_nontemporal_load(srow + j); mx = fmaxf(mx, fmaxf(fmaxf(fabsf(v[j].x), fabsf(v[j].y)), fmaxf(fabsf(v[j].z), fabsf(v[j].w)))); }
      mx = wave_max(mx);
      const int eb = (int)((__float_as_uint(mx) >> 23) & 0xFFu);
      int sb = 261 - eb; sb = sb < 1 ? 1 : (sb > 253 ? 253 : sb);
      const float sc = __uint_as_float((unsigned)sb << 23), isc = __uint_as_float((unsigned)(254 - sb) << 23);
      u32x4 o;
      int w;
#define CV4(V, OUT) w = 0; w = __builtin_amdgcn_cvt_pk_fp8_f32(V.x * sc, V.y * sc, w, false); w = __builtin_amdgcn_cvt_pk_fp8_f32(V.z * sc, V.w * sc, w, true); OUT = (unsigned)w
      CV4(v[0], o.x); CV4(v[1], o.y); CV4(v[2], o.z); CV4(v[3], o.w);
#undef CV4
      *(u32x4*)((tb ? PVq : PUq) + (size_t)rr * DM + lane * 16) = o;
      if (lane == 0) PSC[(size_t)tb * nrows + rr] = isc;
    }
  }
  {
    float* RC = (float*)(p.ws + WS_ROPE); float* RS = RC + SEQ * 32;
    for (size_t i = gt; i < (size_t)SEQ * 32; i += NGT) {
      const int pos = (int)(i >> 5), j = (int)(i & 31);
      const int rr = pos >> 6, cc = pos & 63;
      const int jj = j & 15;
      const double e = -(double)jj * 0.83048202372184058696;
      const double fl = __builtin_floor(e); const double f = e - fl;
      const double z = f * 0.69314718055994530942;
      double ez = 1.0 + z * (1.0 + z * (0.5 + z * (1.0 / 6 + z * (1.0 / 24 + z * (1.0 / 120 + z * (1.0 / 720 + z * (1.0 / 5040 + z * (1.0 / 40320 + z * (1.0 / 362880 + z * (1.0 / 3628800 + z * (1.0 / 39916800 + z * (1.0 / 479001600))))))))))));
      const double inv = __builtin_ldexp(ez, (int)fl);
      const float invf = (float)inv;
      const float angf = (float)(j < 16 ? rr : cc) * invf;
      const double ang = (double)angf;
      const double kq = __builtin_rint(ang * 0.63661977236758134308);
      double r = __builtin_fma(-kq, 1.57079632679489655800e+00, ang);
      r = __builtin_fma(-kq, 6.12323399573676603587e-17, r);
      const double r2 = r * r;
      const double sn = r * (1.0 + r2 * (-1.0 / 6 + r2 * (1.0 / 120 + r2 * (-1.0 / 5040 + r2 * (1.0 / 362880 + r2 * (-1.0 / 39916800 + r2 * (1.0 / 6227020800.0)))))));
      const double cs = 1.0 + r2 * (-0.5 + r2 * (1.0 / 24 + r2 * (-1.0 / 720 + r2 * (1.0 / 40320 + r2 * (-1.0 / 3628800 + r2 * (1.0 / 479001600 + r2 * (-1.0 / 87178291200.0)))))));
      const int q = ((int)kq) & 3;
      double co, si;
      if (q == 0) { co = cs; si = sn; } else if (q == 1) { co = -sn; si = cs; } else if (q == 2) { co = -cs; si = -sn; } else { co = sn; si = -cs; }
      RC[i] = (float)co; RS[i] = (float)si;
    }
  }
}

__device__ __forceinline__ void norm_mod_row(const float* xrow, const float* g, const float* sc, const float* sh, bf16_t* orow, int lane) {
  const f32x4* xr = (const f32x4*)xrow + lane;
  f32x4 v[4]; float s = 0.f;
#pragma unroll
  for (int j = 0; j < 4; ++j) { v[j] = xr[64 * j]; s += (v[j].x * v[j].x + v[j].y * v[j].y) + (v[j].z * v[j].z + v[j].w * v[j].w); }
  const float rs = rsqrtf(wave_sum(s) * (1.f / DM) + EPS);
  u32x2* o = (u32x2*)orow + lane;
#pragma unroll
  for (int j = 0; j < 4; ++j) {
    const f32x4 gg = ((const f32x4*)g)[lane + 64 * j], cc = ((const f32x4*)sc)[lane + 64 * j], hh = ((const f32x4*)sh)[lane + 64 * j];
    const float y0 = v[j].x * rs * gg.x * (1.f + cc.x) + hh.x, y1 = v[j].y * rs * gg.y * (1.f + cc.y) + hh.y;
    const float y2 = v[j].z * rs * gg.z * (1.f + cc.z) + hh.z, y3 = v[j].w * rs * gg.w * (1.f + cc.w) + hh.w;
    u32x2 w; w.x = cvtpk(y0, y1); w.y = cvtpk(y2, y3);
    o[64 * j] = w;
  }
}
__device__ __forceinline__ void phase_norm(const Params& p, int l, int which, bool from_input, bool skip_ctx) {
  int tid_ = threadIdx.x; asm volatile("" : "+v"(tid_));
  const int lane = tid_ & 63, wid = tid_ >> 6;
  const int gw = blockIdx.x * 8 + wid, NGW = gridDim.x * 8;
  const float* MOD = (const float*)(p.ws + WS_MOD);
  const float* XC = (const float*)(p.ws + WS_XCUR);
  bf16_t* H = (bf16_t*)(p.ws + WS_H);
  const float* g = p.in[which ? I_N2G : I_N1G] + l * DM;
  for (int row = gw; row < T; row += NGW) {
    const int mr = mod_row(row);
    if (skip_ctx && mr == 4) continue;
    const float* m = MOD + ((size_t)l * 5 + mr) * 6144 + which * 3072;
    const float* xr = from_input ? in_row(p.in[I_X], p.in[I_CTX], row) : XC + (size_t)row * DM;
    norm_mod_row(xr, g, m + 1024, m, H + (size_t)row * DM, lane);
  }
}

__device__ __forceinline__ int gswz(int row, int chunk) { return row * 128 + ((chunk ^ ((row >> 1) & 7)) << 4); }
__device__ __forceinline__ void gemm_tile(const bf16_t* __restrict__ A, int lda, const bf16_t* __restrict__ Bt, int ldb, int K,
                                          int row0, int col0, unsigned char* lds, f32x16 (&acc)[2][2]) {
  int tid_ = threadIdx.x; asm volatile("" : "+v"(tid_)); const int tid = tid_, lane = tid & 63, wid = tid >> 6, wm = wid >> 1, wn = wid & 1, r32 = lane & 31, hi = lane >> 5;
  unsigned char* As = lds; unsigned char* Bs = lds + 65536;
#pragma unroll
  for (int i = 0; i < 2; ++i)
#pragma unroll
    for (int j = 0; j < 2; ++j) acc[i][j] = f32x16{};
  const int lrow = tid >> 3, lc = tid & 7;
  const bf16_t* Ag = A + (size_t)(row0 + lrow) * lda + lc * 8;
  const bf16_t* Bg = Bt + (size_t)(col0 + lrow) * ldb + lc * 8;
  u32x4 ra[4], rb[2];
#pragma unroll
  for (int i = 0; i < 4; ++i) ra[i] = *(const u32x4*)(Ag + (size_t)(64 * i) * lda);
#pragma unroll
  for (int i = 0; i < 2; ++i) rb[i] = *(const u32x4*)(Bg + (size_t)(64 * i) * ldb);
#pragma unroll
  for (int i = 0; i < 4; ++i) *(u32x4*)(As + gswz(lrow + 64 * i, lc)) = ra[i];
#pragma unroll
  for (int i = 0; i < 2; ++i) *(u32x4*)(Bs + gswz(lrow + 64 * i, lc)) = rb[i];
  __syncthreads();
  const int nk = K / 64;
  for (int kt = 0; kt < nk; ++kt) {
    const int cur = kt & 1;
    if (kt + 1 < nk) {
#pragma unroll
      for (int i = 0; i < 4; ++i) ra[i] = *(const u32x4*)(Ag + (size_t)(64 * i) * lda + (kt + 1) * 64);
#pragma unroll
      for (int i = 0; i < 2; ++i) rb[i] = *(const u32x4*)(Bg + (size_t)(64 * i) * ldb + (kt + 1) * 64);
    }
    const unsigned char* Ac = As + cur * 32768; const unsigned char* Bc = Bs + cur * 16384;
#pragma unroll
    for (int kk = 0; kk < 4; ++kk) {
      bf16x8 af[2], bfr[2];
#pragma unroll
      for (int i = 0; i < 2; ++i) af[i] = *(const bf16x8*)(Ac + gswz(wm * 64 + i * 32 + r32, 2 * kk + hi));
#pragma unroll
      for (int j = 0; j < 2; ++j) bfr[j] = *(const bf16x8*)(Bc + gswz(wn * 64 + j * 32 + r32, 2 * kk + hi));
#pragma unroll
      for (int i = 0; i < 2; ++i)
#pragma unroll
        for (int j = 0; j < 2; ++j) acc[i][j] = __builtin_amdgcn_mfma_f32_32x32x16_bf16(af[i], bfr[j], acc[i][j], 0, 0, 0);
    }
    if (kt + 1 < nk) {
      unsigned char* An = As + (cur ^ 1) * 32768; unsigned char* Bn = Bs + (cur ^ 1) * 16384;
#pragma unroll
      for (int i = 0; i < 4; ++i) *(u32x4*)(An + gswz(lrow + 64 * i, lc)) = ra[i];
#pragma unroll
      for (int i = 0; i < 2; ++i) *(u32x4*)(Bn + gswz(lrow + 64 * i, lc)) = rb[i];
    }
    __syncthreads();
  }
}
__device__ __forceinline__ void pair_xchg(float v0, float v1, int lane, float& lo, float& hi2) {
  const bool odd = lane & 1;
  const float send = odd ? v0 : v1;
  const float recv = __shfl_xor(send, 1);
  lo = odd ? recv : v0; hi2 = odd ? v1 : recv;
}

__device__ __forceinline__ void phase_inproj(const Params& p, int l, unsigned char* lds) {
  int tid_ = threadIdx.x; asm volatile("" : "+v"(tid_)); const int tid = tid_, lane = tid & 63, wid = tid >> 6, wm = wid >> 1, wn = wid & 1, r32 = lane & 31, hi = lane >> 5;
  const bf16_t* H = (const bf16_t*)(p.ws + WS_H);
  const bf16_t* W = (const bf16_t*)(p.ws + WS_WIN) + (size_t)l * PW * DM;
  bf16_t* PROJ = (bf16_t*)(p.ws + WS_PROJ);
  const float* RC = (const float*)(p.ws + WS_ROPE); const float* RS = RC + SEQ * 32;
  constexpr int NM = T / 256, NN = PW / 128, NU = NM * NN;
  for (int u = blockIdx.x; u < NU + NM; u += gridDim.x) {
    if (u < NU) {
      const int pn = u / NM, pm = u % NM;
      const int row0 = pm * 256, col0 = pn * 128;
      f32x16 acc[2][2];
      gemm_tile(H, DM, W, DM, DM, row0, col0, lds, acc);
      const bool rope = (col0 >= C_DQ && col0 < C_DV);
      const float scl = (col0 >= C_MK && col0 < C_MV) ? 0.125f : ((col0 >= C_DQ && col0 < C_DK) ? QSCALE : 1.f);
#pragma unroll
      for (int i = 0; i < 2; ++i)
#pragma unroll
        for (int j = 0; j < 2; ++j)
#pragma unroll
          for (int q = 0; q < 8; ++q) {
            float lo, hi2; pair_xchg(acc[i][j][2 * q], acc[i][j][2 * q + 1], lane, lo, hi2);
            const int row = row0 + wm * 64 + i * 32 + crow(2 * q, hi) + (lane & 1);
            const int col = col0 + wn * 64 + j * 32 + (r32 & ~1);
            if (rope) {
              const int s = row % SEGL;
              if (s >= CTXL) {
                const int idx = (s - CTXL) * 32 + ((col & 63) >> 1);
                const float c = RC[idx], sn = RS[idx];
                const float t1 = lo, t2 = hi2; lo = t1 * c - t2 * sn; hi2 = t1 * sn + t2 * c;
              }
            }
            *(unsigned*)(PROJ + (size_t)row * PW + col) = cvtpk(lo * scl, hi2 * scl);
          }
    } else {
      const int pm = u - NU, rowb = pm * 256 + wid * 32;
      const bf16_t* WG = (const bf16_t*)(p.ws + WS_WG) + (size_t)l * 16 * DM;
      float* GT = (float*)(p.ws + WS_GATES);
      const int r16 = lane & 15, q4 = lane >> 4;
      f32x4 c0 = {0.f, 0.f, 0.f, 0.f}, c1 = {0.f, 0.f, 0.f, 0.f};
      const bf16_t* a0p = H + (size_t)(rowb + r16) * DM + q4 * 8;
      const bf16_t* a1p = a0p + (size_t)16 * DM;
      const bf16_t* bp = WG + (size_t)r16 * DM + q4 * 8;
#pragma unroll 4
      for (int ks = 0; ks < 32; ++ks) {
        const bf16x8 a0 = *(const bf16x8*)(a0p + ks * 32), a1 = *(const bf16x8*)(a1p + ks * 32), b = *(const bf16x8*)(bp + ks * 32);
        c0 = __builtin_amdgcn_mfma_f32_16x16x32_bf16(a0, b, c0, 0, 0, 0);
        c1 = __builtin_amdgcn_mfma_f32_16x16x32_bf16(a1, b, c1, 0, 0, 0);
      }
      const float gb = p.in[I_GATEB][l * 16 + r16];
#pragma unroll
      for (int j = 0; j < 4; ++j) {
        GT[(size_t)(rowb + q4 * 4 + j) * 16 + r16] = c0[j] + gb;
        GT[(size_t)(rowb + 16 + q4 * 4 + j) * 16 + r16] = c1[j] + gb;
      }
    }
  }
}

__device__ __forceinline__ void phase_outproj(const Params& p, int l, unsigned char* lds) {
  int tid_ = threadIdx.x; asm volatile("" : "+v"(tid_)); const int tid = tid_, lane = tid & 63, wid = tid >> 6, wm = wid >> 1, wn = wid & 1, r32 = lane & 31, hi = lane >> 5;
  const bf16_t* MIX = (const bf16_t*)(p.ws + WS_MIX);
  const bf16_t* W = (const bf16_t*)(p.ws + WS_WOUT) + (size_t)l * DM * DM;
  float* XC = (float*)(p.ws + WS_XCUR);
  const float* MOD = (const float*)(p.ws + WS_MOD);
  constexpr int NM = T / 256, NN = DM / 128, NU = NM * NN;
  for (int u = blockIdx.x; u < NU; u += gridDim.x) {
    const int pm = u / NN, pn = u % NN;
    if (l == DEPTH - 1 && (pm % 33) == 0) continue;
    const int row0 = pm * 256, col0 = pn * 128;
    f32x16 acc[2][2];
    gemm_tile(MIX, DM, W, DM, DM, row0, col0, lds, acc);
    const int mr = (pm % 33) == 0 ? 4 : pm / 33;
    const float* g1 = MOD + ((size_t)l * 5 + mr) * 6144 + 2048;
#pragma unroll
    for (int i = 0; i < 2; ++i)
#pragma unroll
      for (int j = 0; j < 2; ++j) {
        const int col = col0 + wn * 64 + j * 32 + r32;
        const float gg = g1[col];
#pragma unroll
        for (int r = 0; r < 16; ++r) {
          const int row = row0 + wm * 64 + i * 32 + crow(r, hi);
          const float xo = (l == 0) ? in_row(p.in[I_X], p.in[I_CTX], row)[col] : XC[(size_t)row * DM + col];
          XC[(size_t)row * DM + col] = xo + gg * acc[i][j][r];
        }
      }
  }
}
__device__ __forceinline__ void phase_peerq(const Params& p, int l, unsigned char* lds) {
  int tid_ = threadIdx.x; asm volatile("" : "+v"(tid_)); const int tid = tid_, lane = tid & 63, wid = tid >> 6, wm = wid >> 1, wn = wid & 1, r32 = lane & 31, hi = lane >> 5;
  const bf16_t* H = (const bf16_t*)(p.ws + WS_H);
  const bf16_t* W = (const bf16_t*)(p.ws + WS_WQ) + (size_t)l * DM * DM;
  bf16_t* QP = (bf16_t*)(p.ws + WS_PROJ);
  constexpr int NM = T / 256, NN = DM / 128, NU = NM * NN;
  for (int u = blockIdx.x; u < NU; u += gridDim.x) {
    const int pm = u / NN, pn = u % NN;
    if (l == DEPTH - 1 && (pm % 33) == 0) continue;
    const int row0 = pm * 256, col0 = pn * 128;
    f32x16 acc[2][2];
    gemm_tile(H, DM, W, DM, DM, row0, col0, lds, acc);
#pragma unroll
    for (int i = 0; i < 2; ++i)
#pragma unroll
      for (int j = 0; j < 2; ++j)
#pragma unroll
        for (int q = 0; q < 8; ++q) {
          float lo, hi2; pair_xchg(acc[i][j][2 * q], acc[i][j][2 * q + 1], lane, lo, hi2);
          const int row = row0 + wm * 64 + i * 32 + crow(2 * q, hi) + (lane & 1);
          const int col = col0 + wn * 64 + j * 32 + (r32 & ~1);
          *(unsigned*)(QP + (size_t)row * DM + col) = cvtpk(lo, hi2);
        }
  }
}


__device__ __forceinline__ void conv_unit(const Params& p, int l, int unit, unsigned char* lds) {
  int tid_ = threadIdx.x; asm volatile("" : "+v"(tid_)); const int tid = tid_, lane = tid & 63, wid = tid >> 6;
  float* U = (float*)lds;
  const bf16_t* PROJ = (const bf16_t*)(p.ws + WS_PROJ);
  bf16_t* MIX = (bf16_t*)(p.ws + WS_MIX);
  const int row0 = unit * 32, b = row0 / SEGL, s0 = row0 - b * SEGL;
  const int seglo = s0 < CTXL ? 0 : CTXL, seghi = s0 < CTXL ? CTXL : SEGL;
  for (int rr = tid >> 5; rr < 62; rr += 16) {
    const int s = s0 - 15 + rr, c8 = (tid & 31) * 8;
    f32x4 u0 = {0.f, 0.f, 0.f, 0.f}, u1 = {0.f, 0.f, 0.f, 0.f};
    if (s >= seglo && s < seghi) {
      const bf16_t* pr = PROJ + (size_t)(b * SEGL + s) * PW + c8;
      const u32x4 a1 = *(const u32x4*)pr, a2 = *(const u32x4*)(pr + 256);
      u0.x = bflo(a1.x) * sigmoidf_(bflo(a2.x)); u0.y = bfhi(a1.x) * sigmoidf_(bfhi(a2.x));
      u0.z = bflo(a1.y) * sigmoidf_(bflo(a2.y)); u0.w = bfhi(a1.y) * sigmoidf_(bfhi(a2.y));
      u1.x = bflo(a1.z) * sigmoidf_(bflo(a2.z)); u1.y = bfhi(a1.z) * sigmoidf_(bfhi(a2.z));
      u1.z = bflo(a1.w) * sigmoidf_(bflo(a2.w)); u1.w = bfhi(a1.w) * sigmoidf_(bfhi(a2.w));
    }
    *(f32x4*)(U + rr * 256 + c8) = u0; *(f32x4*)(U + rr * 256 + c8 + 4) = u1;
  }
  __syncthreads();
  float* Y = U + 62 * 256;
  const float* cw = p.in[I_CONVW] + (size_t)l * 31 * 256;
#pragma unroll 1
  for (int q = 0; q < 4; ++q) {
    const int c = lane + 64 * q;
    float w[31];
#pragma unroll
    for (int j = 0; j < 31; ++j) w[j] = cw[j * 256 + c];
    const float bias = p.in[I_CONVB][l * 256 + c];
#pragma unroll
    for (int tt = 0; tt < 4; ++tt) {
      const int t = wid * 4 + tt;
      float a = bias;
#pragma unroll
      for (int j = 0; j < 31; ++j) a += U[(t + j) * 256 + c] * w[j];
      Y[t * 256 + c] = a;
    }
  }
  asm volatile("s_waitcnt lgkmcnt(0)" ::: "memory");
  float y[4][4];
#pragma unroll
  for (int tt = 0; tt < 4; ++tt)
#pragma unroll
    for (int q = 0; q < 4; ++q) y[tt][q] = Y[(wid * 4 + tt) * 256 + lane + 64 * q];
#pragma unroll
  for (int tt = 0; tt < 4; ++tt) {
    const int t = wid * 4 + tt;
    const float mean = wave_sum((y[tt][0] + y[tt][1]) + (y[tt][2] + y[tt][3])) * (1.f / 256.f);
    float v = 0.f;
#pragma unroll
    for (int q = 0; q < 4; ++q) { const float d = y[tt][q] - mean; v += d * d; }
    const float rs = rsqrtf(wave_sum(v) * (1.f / 256.f) + EPS);
#pragma unroll
    for (int q = 0; q < 4; ++q) {
      const int c = lane + 64 * q;
      const float z = (y[tt][q] - mean) * rs * p.in[I_CLNG][l * 256 + c] + p.in[I_CLNB][l * 256 + c];
      const float o = (ABL & 1) ? 0.f : z * sigmoidf_(z);
      MIX[(size_t)(row0 + t) * DM + c] = (bf16_t)(cvtpk(o, 0.f) & 0xffffu);
    }
  }
  __syncthreads();
}

__device__ __forceinline__ int ml_cidx(int ch, int dir) { return dir == 0 ? ch : (ch < 4 ? 3 - ch : 135 - ch); }
__device__ __forceinline__ void ml_load_tile(const bf16_t* src, float* dst, int tid) {
  const int r = tid >> 3, c8 = (tid & 7) * 8;
  const u32x4 a = *(const u32x4*)(src + (size_t)r * PW + c8);
  float* d = dst + r * 65 + c8;
  d[0] = bflo(a.x); d[1] = bfhi(a.x); d[2] = bflo(a.y); d[3] = bfhi(a.y); d[4] = bflo(a.z); d[5] = bfhi(a.z); d[6] = bflo(a.w); d[7] = bfhi(a.w);
}
__device__ __forceinline__ void ml_local_unit(const Params& p, int l, int unit, unsigned char* lds) {
  int tid_ = threadIdx.x; asm volatile("" : "+v"(tid_)); const int tid = tid_, lane = tid & 63, wid = tid >> 6, r32 = lane & 31, hi = lane >> 5;
  float* Kt = (float*)lds; float* Vt = Kt + 64 * 65; float* WK = Vt + 64 * 65;
  const bf16_t* PROJ = (const bf16_t*)(p.ws + WS_PROJ);
  const float* GT = (const float*)(p.ws + WS_GATES);
  float* UL = (float*)(p.ws + WS_ULOC); float* META = (float*)(p.ws + WS_MLMETA);
  const int b = unit / (4 * NCH), hh = (unit / NCH) & 3, ch = unit % NCH;
  const int row0 = b * SEGL + ch * 64;
  ml_load_tile(PROJ + (size_t)row0 * PW + C_MK + hh * 64, Kt, tid);
  ml_load_tile(PROJ + (size_t)row0 * PW + C_MV + hh * 64, Vt, tid);
  if (wid < 2) {
    const int dir = wid;
    const float ig = GT[(size_t)(row0 + lane) * 16 + (2 * dir) * 4 + hh];
    const float lf = logsigmoidf_(GT[(size_t)(row0 + lane) * 16 + (2 * dir + 1) * 4 + hh]);
    float ps = lf;
#pragma unroll
    for (int o = 1; o < 64; o <<= 1) { const float t = __shfl_up(ps, o); if (lane >= o) ps += t; }
    const float tot = __shfl(ps, 63);
    const float wlog = dir == 0 ? (tot - ps + ig) : (ps - lf + ig);
    const float mloc = wave_max(wlog);
    WK[dir * 64 + lane] = __expf(wlog - mloc);
    if (lane == 0) {
      const int seq = (b * 4 + hh) * 2 + dir, ci = ml_cidx(ch, dir);
      META[((size_t)seq * NCH + ci) * 4 + 0] = tot; META[((size_t)seq * NCH + ci) * 4 + 1] = mloc;
    }
  }
  __syncthreads();
  {
    const int dir = wid >> 2, et = (wid >> 1) & 1, dt = wid & 1;
    const int seq = (b * 4 + hh) * 2 + dir, ci = ml_cidx(ch, dir);
    float* slot = UL + ((size_t)seq * NCH + ci) * USTRIDE;
    f32x16 acc = {};
#pragma unroll 8
    for (int ks = 0; ks < 32; ++ks) {
      const int s = 2 * ks + hi;
      const float a = WK[dir * 64 + s] * Vt[s * 65 + et * 32 + r32];
      const float bb = Kt[s * 65 + dt * 32 + r32];
      acc = __builtin_amdgcn_mfma_f32_32x32x2f32(a, bb, acc, 0, 0, 0);
    }
#pragma unroll
    for (int r = 0; r < 16; ++r) slot[(et * 32 + crow(r, hi)) * 64 + dt * 32 + r32] = acc[r];
    if (et == 0) {
      float n = 0.f;
#pragma unroll 8
      for (int i = 0; i < 32; ++i) { const int s = hi * 32 + i; n += WK[dir * 64 + s] * Kt[s * 65 + dt * 32 + r32]; }
      n += __shfl_xor(n, 32);
      if (hi == 0) slot[4096 + dt * 32 + r32] = n;
    }
  }
  __syncthreads();
}
__device__ __forceinline__ void ml_scan(const Params& p) {
  float* UL = (float*)(p.ws + WS_ULOC); float* META = (float*)(p.ws + WS_MLMETA);
  int tid_ = threadIdx.x; asm volatile("" : "+v"(tid_));
  const int gt = blockIdx.x * 512 + tid_, NGT = gridDim.x * 512;
  for (int idx = gt; idx < 32 * USTRIDE; idx += NGT) {
    const int seq = idx / USTRIDE, e = idx - seq * USTRIDE;
    float* base = UL + (size_t)seq * NCH * USTRIDE + e;
    float* mt = META + (size_t)seq * NCH * 4;
    float m = 0.f, C = 0.f;
    for (int c = 0; c < NCH; ++c) {
      const float bl = mt[c * 4 + 0], mloc = mt[c * 4 + 1];
      const float u = base[(size_t)c * USTRIDE];
      base[(size_t)c * USTRIDE] = C;
      const float mn = fmaxf(bl + m, mloc);
      C = __expf(bl + m - mn) * C + __expf(mloc - mn) * u;
      if (e == 0) mt[c * 4 + 2] = m;
      m = mn;
    }
  }
}
__device__ __forceinline__ void ml_out_unit(const Params& p, int l, int unit, unsigned char* lds) {
  int tid_ = threadIdx.x; asm volatile("" : "+v"(tid_)); const int tid = tid_, lane = tid & 63, wid = tid >> 6, r32 = lane & 31, hi = lane >> 5;
  float* Qt = (float*)lds; float* Kt = Qt + 64 * 65; float* Vt = Kt + 64 * 65;
  float* Cs = Vt + 64 * 65;
  float* Ns = Cs + 2 * 64 * 65;
  float* Bq = Ns + 128;
  float* Gs = Bq + 128;
  float* Mi = Gs + 128;
  float* HB = Mi + 64;
  const bf16_t* PROJ = (const bf16_t*)(p.ws + WS_PROJ);
  const float* GT = (const float*)(p.ws + WS_GATES);
  const float* UL = (const float*)(p.ws + WS_ULOC); const float* META = (const float*)(p.ws + WS_MLMETA);
  bf16_t* MIX = (bf16_t*)(p.ws + WS_MIX);
  const int b = unit / (4 * NCH), hh = (unit / NCH) & 3, ch = unit % NCH;
  const int row0 = b * SEGL + ch * 64;
  ml_load_tile(PROJ + (size_t)row0 * PW + C_MQ + hh * 64, Qt, tid);
  ml_load_tile(PROJ + (size_t)row0 * PW + C_MK + hh * 64, Kt, tid);
  ml_load_tile(PROJ + (size_t)row0 * PW + C_MV + hh * 64, Vt, tid);
  for (int i = tid; i < 2 * USTRIDE; i += 512) {
    const int dir = i / USTRIDE, e = i - dir * USTRIDE;
    const int seq = (b * 4 + hh) * 2 + dir, ci = ml_cidx(ch, dir);
    const float v = UL[((size_t)seq * NCH + ci) * USTRIDE + e];
    if (e < 4096) Cs[dir * 64 * 65 + (e >> 6) * 65 + (e & 63)] = v; else Ns[dir * 64 + (e - 4096)] = v;
  }
  if (wid < 2) {
    const int dir = wid;
    const float ig = GT[(size_t)(row0 + lane) * 16 + (2 * dir) * 4 + hh];
    const float lf = logsigmoidf_(GT[(size_t)(row0 + lane) * 16 + (2 * dir + 1) * 4 + hh]);
    float ps = lf;
#pragma unroll
    for (int o = 1; o < 64; o <<= 1) { const float t = __shfl_up(ps, o); if (lane >= o) ps += t; }
    const float tot = __shfl(ps, 63);
    const float bc = dir == 0 ? ps : (tot - ps + lf);
    Bq[dir * 64 + lane] = bc; Gs[dir * 64 + lane] = ig - bc;
    if (lane == 0) { const int seq = (b * 4 + hh) * 2 + dir, ci = ml_cidx(ch, dir); Mi[dir] = META[((size_t)seq * NCH + ci) * 4 + 2]; }
  }
  __syncthreads();
  {
    const int dir = wid >> 2, tt = (wid >> 1) & 1, et = wid & 1;
    const int t = tt * 32 + r32;
    f32x16 sa[2] = {};
#pragma unroll 4
    for (int ks = 0; ks < 32; ++ks) {
      const float bq = Qt[t * 65 + 2 * ks + hi];
      const float a0 = Kt[(r32) * 65 + 2 * ks + hi], a1 = Kt[(32 + r32) * 65 + 2 * ks + hi];
      sa[0] = __builtin_amdgcn_mfma_f32_32x32x2f32(a0, bq, sa[0], 0, 0, 0);
      sa[1] = __builtin_amdgcn_mfma_f32_32x32x2f32(a1, bq, sa[1], 0, 0, 0);
    }
    const float bt = Bq[dir * 64 + t];
    const float inter = bt + Mi[dir];
    float mx = -INFINITY;
    f32x16 dl[2];
#pragma unroll
    for (int st = 0; st < 2; ++st)
#pragma unroll
      for (int r = 0; r < 16; ++r) {
        const int s = st * 32 + crow(r, hi);
        const bool ok = dir == 0 ? (s <= t) : (s >= t);
        const float d = ok ? bt + Gs[dir * 64 + s] : -INFINITY;
        dl[st][r] = d; mx = fmaxf(mx, d);
      }
    mx = fmaxf(mx, __shfl_xor(mx, 32));
    const float mt = fmaxf(inter, mx);
    const float iw = __expf(inter - mt);
    float rsum = 0.f;
#pragma unroll
    for (int st = 0; st < 2; ++st)
#pragma unroll
      for (int r = 0; r < 16; ++r) { const float w = __expf(dl[st][r] - mt); sa[st][r] *= w; rsum += sa[st][r]; }
    rsum += __shfl_xor(rsum, 32);
    float qn = 0.f;
#pragma unroll 8
    for (int i = 0; i < 32; ++i) { const int d = hi * 32 + i; qn += Ns[dir * 64 + d] * Qt[t * 65 + d]; }
    qn += __shfl_xor(qn, 32);
    const float den = rsum + iw * qn;
    const float rden = 1.f / fmaxf(fabsf(den), __expf(-mt));
    f32x16 an = {}, ac = {};
#pragma unroll
    for (int st = 0; st < 2; ++st)
#pragma unroll
      for (int r = 0; r < 16; ++r) {
        const float a = Vt[(st * 32 + crow(r, hi)) * 65 + et * 32 + r32];
        an = __builtin_amdgcn_mfma_f32_32x32x2f32(a, sa[st][r], an, 0, 0, 0);
      }
    const float* Cd = Cs + dir * 64 * 65;
#pragma unroll 4
    for (int ks = 0; ks < 32; ++ks) {
      const float a = Cd[(et * 32 + r32) * 65 + 2 * ks + hi];
      const float bq = Qt[t * 65 + 2 * ks + hi];
      ac = __builtin_amdgcn_mfma_f32_32x32x2f32(a, bq, ac, 0, 0, 0);
    }
#pragma unroll
    for (int r = 0; r < 16; ++r) HB[dir * 64 * 65 + t * 65 + et * 32 + crow(r, hi)] = (an[r] + iw * ac[r]) * rden;
  }
  __syncthreads();
  {
    const int t = tid >> 3, e8 = (tid & 7) * 8;
    float v[8]; float ss = 0.f;
#pragma unroll
    for (int i = 0; i < 8; ++i) { v[i] = HB[t * 65 + e8 + i] + HB[64 * 65 + t * 65 + e8 + i]; ss += v[i] * v[i]; }
    ss += __shfl_xor(ss, 1); ss += __shfl_xor(ss, 2); ss += __shfl_xor(ss, 4);
    const float rs = rsqrtf(ss * (1.f / 64.f) + EPS);
    const u32x4 ov = *(const u32x4*)(PROJ + (size_t)(row0 + t) * PW + C_MO + hh * 64 + e8);
    const float og[8] = {bflo(ov.x), bfhi(ov.x), bflo(ov.y), bfhi(ov.y), bflo(ov.z), bfhi(ov.z), bflo(ov.w), bfhi(ov.w)};
    const float* g = p.in[I_MNORMG] + l * 64 + e8;
    float o[8];
#pragma unroll
    for (int i = 0; i < 8; ++i) o[i] = (ABL & 2) ? 0.f : v[i] * rs * g[i] * sigmoidf_(og[i]);
    u32x4 w; w.x = cvtpk(o[0], o[1]); w.y = cvtpk(o[2], o[3]); w.z = cvtpk(o[4], o[5]); w.w = cvtpk(o[6], o[7]);
    *(u32x4*)(MIX + (size_t)(row0 + t) * DM + 256 + hh * 64 + e8) = w;
  }
  __syncthreads();
}


#define KSWZ(row, colB) ((row) * 256 + ((colB) ^ (((row) & 15) << 4)))
#define SBAR() __builtin_amdgcn_sched_barrier(0)
constexpr int ATT_SHM_V = 64 * 128 * 2, ATT_SHM_K = 64 * 128 * 2;
constexpr float ATT_THR = 11.541560327111707f;
__device__ __forceinline__ int v_st(int k, int c) { const int kk = (k & ~0xC) | ((k & 4) << 1) | ((k & 8) >> 1); return ((kk >> 3) * 4 + (c >> 5)) * 512 + ((kk & 7) * 32 + (c & 31)) * 2; }
__device__ __forceinline__ int v_rd_base(int lane) { return ((lane & 3) << 3) | (((lane >> 2) & 3) << 6) | (((lane >> 4) & 1) << 5) | (((lane >> 5) & 1) << 8); }
constexpr int v_rd_off(int d0, int ks, int half) { return d0 * 512 + ks * 4096 + half * 2048; }
template <int OFF> __device__ __forceinline__ s16x4 tr_read(int vb) {
  s16x4 r; asm volatile("ds_read_b64_tr_b16 %0, %1 offset:%2" : "=&v"(r) : "v"(vb), "i"(OFF) : "memory"); return r;
}
template <int D0> __device__ __forceinline__ void pv_one(f32x16& od, int vb, bf16x8 pa0, bf16x8 pa1, bf16x8 pa2, bf16x8 pa3) {
  const s16x4 l0 = tr_read<v_rd_off(D0, 0, 0)>(vb), h0 = tr_read<v_rd_off(D0, 0, 1)>(vb), l1 = tr_read<v_rd_off(D0, 1, 0)>(vb), h1 = tr_read<v_rd_off(D0, 1, 1)>(vb);
  const s16x4 l2 = tr_read<v_rd_off(D0, 2, 0)>(vb), h2 = tr_read<v_rd_off(D0, 2, 1)>(vb), l3 = tr_read<v_rd_off(D0, 3, 0)>(vb), h3 = tr_read<v_rd_off(D0, 3, 1)>(vb);
  asm volatile("s_waitcnt lgkmcnt(0)" ::: "memory"); SBAR();
#define PK(L, H) (bf16x8){L[0], L[1], L[2], L[3], H[0], H[1], H[2], H[3]}
  od = __builtin_amdgcn_mfma_f32_32x32x16_bf16(pa0, PK(l0, h0), od, 0, 0, 0);
  od = __builtin_amdgcn_mfma_f32_32x32x16_bf16(pa1, PK(l1, h1), od, 0, 0, 0);
  od = __builtin_amdgcn_mfma_f32_32x32x16_bf16(pa2, PK(l2, h2), od, 0, 0, 0);
  od = __builtin_amdgcn_mfma_f32_32x32x16_bf16(pa3, PK(l3, h3), od, 0, 0, 0);
#undef PK
}
__device__ __forceinline__ void att_qkt(f32x16& p0, f32x16& p1, const unsigned char* Ks, const unsigned char* Qs, int qrow, int comp, int r32, int hi) {
  p0 = f32x16{}; p1 = f32x16{};
#pragma unroll
  for (int d0 = 0; d0 < 4; ++d0) {
    const int cb = ((comp * 4 + d0) * 16 + hi * 8) * 2;
    const bf16x8 b0 = *(const bf16x8*)(Ks + KSWZ(r32, cb));
    const bf16x8 b1 = *(const bf16x8*)(Ks + KSWZ(32 + r32, cb));
    const bf16x8 q = *(const bf16x8*)(Qs + KSWZ(qrow, cb));
    p0 = __builtin_amdgcn_mfma_f32_32x32x16_bf16(b0, q, p0, 0, 0, 0);
    p1 = __builtin_amdgcn_mfma_f32_32x32x16_bf16(b1, q, p1, 0, 0, 0);
  }
}
__device__ __forceinline__ void att_softmax(f32x16& p0, f32x16& p1, float& m_reg, float& l_reg, float& alpha, bf16x8& pa0, bf16x8& pa1, bf16x8& pa2, bf16x8& pa3) {
  float pmax = p0[0];
#pragma unroll
  for (int r = 1; r < 16; ++r) pmax = fmaxf(pmax, p0[r]);
#pragma unroll
  for (int r = 0; r < 16; ++r) pmax = fmaxf(pmax, p1[r]);
  { auto rr = __builtin_amdgcn_permlane32_swap(__float_as_uint(pmax), __float_as_uint(pmax), false, false);
    pmax = fmaxf(__uint_as_float(rr[0]), __uint_as_float(rr[1])); }
  float mn;
  if (__builtin_expect(__all(pmax - m_reg <= ATT_THR), 1)) { mn = m_reg; alpha = 1.f; }
  else { mn = fmaxf(m_reg, pmax); alpha = __builtin_amdgcn_exp2f(m_reg - mn); m_reg = mn; }
#pragma unroll
  for (int r = 0; r < 16; ++r) { p0[r] = __builtin_amdgcn_exp2f(p0[r] - mn); p1[r] = __builtin_amdgcn_exp2f(p1[r] - mn); }
  float ps = 0.f;
#pragma unroll
  for (int r = 0; r < 16; ++r) ps += p0[r];
#pragma unroll
  for (int r = 0; r < 16; ++r) ps += p1[r];
  { auto rr = __builtin_amdgcn_permlane32_swap(__float_as_uint(ps), __float_as_uint(ps), false, false);
    ps = __uint_as_float(rr[0]) + __uint_as_float(rr[1]); }
  l_reg = l_reg * alpha + ps;
#define PK4(P, BASE, OUT) do { unsigned a0 = cvtpk(P[BASE + 0], P[BASE + 1]), a1 = cvtpk(P[BASE + 2], P[BASE + 3]);   \
    unsigned b0 = cvtpk(P[BASE + 4], P[BASE + 5]), b1 = cvtpk(P[BASE + 6], P[BASE + 7]);                              \
    auto r0 = __builtin_amdgcn_permlane32_swap(a0, b0, false, false); auto r1 = __builtin_amdgcn_permlane32_swap(a1, b1, false, false); \
    u32x4 w = {r0[0], r1[0], r0[1], r1[1]}; OUT = *reinterpret_cast<bf16x8*>(&w); } while (0)
  PK4(p0, 0, pa0); PK4(p0, 8, pa1); PK4(p1, 0, pa2); PK4(p1, 8, pa3);
#undef PK4
}
__device__ __forceinline__ void att_unit(const bf16_t* __restrict__ Qb, const bf16_t* __restrict__ Kh, const bf16_t* __restrict__ Vh, bf16_t* __restrict__ Ob,
                                         int nkeys, float lam, const float* __restrict__ ng, float oscale, unsigned char* lds) {
  int tid_ = threadIdx.x; asm volatile("" : "+v"(tid_)); const int tid = tid_, wid = tid >> 6, lane = tid & 63, r32 = lane & 31, hi = lane >> 5;
  unsigned char* V_lds = lds; unsigned char* K_lds = lds + 2 * ATT_SHM_V;
  float* wsl = (float*)(lds + 2 * ATT_SHM_V + 2 * ATT_SHM_K) + wid * 64; float* li_l = wsl; float* al_l = wsl + 32;
  float m0 = -1e30f, l0 = 0.f, m1 = -1e30f, l1 = 0.f;
  f32x16 o0[4] = {}, o1[4] = {};
  unsigned char* Q_lds = lds + 2 * ATT_SHM_V + 2 * ATT_SHM_K + 2048;
#pragma unroll
  for (int i = 0; i < 8; ++i) { const int id = tid + 512 * i, qrw = id >> 4, ch = id & 15;
    *(bf16x8*)(Q_lds + KSWZ(qrw, ch * 16)) = *(const bf16x8*)(Qb + (size_t)qrw * PW + ch * 8); }
  const int qrow = wid * 32 + r32;
  const int sr = tid >> 4, sc = (tid & 15) * 8, vst0 = v_st(sr, sc), vst1 = v_st(32 + sr, sc);
  const int vb0 = (int)(uintptr_t)V_lds + v_rd_base(lane);
  bf16x8 vs0, vs1, ks0, ks1;
#define SLOAD(k0) do { vs0 = *(const bf16x8*)(Vh + (size_t)((k0) + sr) * PW + sc); vs1 = *(const bf16x8*)(Vh + (size_t)((k0) + 32 + sr) * PW + sc); \
    ks0 = *(const bf16x8*)(Kh + (size_t)((k0) + sr) * PW + sc); ks1 = *(const bf16x8*)(Kh + (size_t)((k0) + 32 + sr) * PW + sc); } while (0)
#define SWRITE(b) do { *(bf16x8*)(V_lds + (b) * ATT_SHM_V + vst0) = vs0; *(bf16x8*)(V_lds + (b) * ATT_SHM_V + vst1) = vs1; const int kc = sc * 2; \
    *(bf16x8*)(K_lds + (b) * ATT_SHM_K + KSWZ(sr, kc)) = ks0; *(bf16x8*)(K_lds + (b) * ATT_SHM_K + KSWZ(32 + sr, kc)) = ks1; } while (0)
#define RESC(o, a) do { if (__any((a) < 1.f)) { if (hi == 0) al_l[r32] = (a); asm volatile("s_waitcnt lgkmcnt(0)" ::: "memory"); \
    _Pragma("unroll") for (int d = 0; d < 4; ++d) _Pragma("unroll") for (int r = 0; r < 16; ++r) o[d][r] *= al_l[crow(r, hi)]; } } while (0)
  const int NT = nkeys / 64;
  SLOAD(0); SWRITE(0); __syncthreads();
  for (int j = 0; j < NT; ++j) {
    const int cur = j & 1;
    if (j + 1 < NT) SLOAD((j + 1) * 64);
    const unsigned char* Kc = K_lds + cur * ATT_SHM_K; const int vb = vb0 + cur * ATT_SHM_V;
    f32x16 p0, p1; float alpha; bf16x8 pa0, pa1, pa2, pa3;
    att_qkt(p0, p1, Kc, Q_lds, qrow, 0, r32, hi);
    att_softmax(p0, p1, m0, l0, alpha, pa0, pa1, pa2, pa3);
    RESC(o0, alpha);
    pv_one<0>(o0[0], vb, pa0, pa1, pa2, pa3); pv_one<1>(o0[1], vb, pa0, pa1, pa2, pa3); pv_one<2>(o0[2], vb, pa0, pa1, pa2, pa3); pv_one<3>(o0[3], vb, pa0, pa1, pa2, pa3);
    att_qkt(p0, p1, Kc, Q_lds, qrow, 1, r32, hi);
    att_softmax(p0, p1, m1, l1, alpha, pa0, pa1, pa2, pa3);
    RESC(o1, alpha);
    pv_one<0>(o1[0], vb, pa0, pa1, pa2, pa3); pv_one<1>(o1[1], vb, pa0, pa1, pa2, pa3); pv_one<2>(o1[2], vb, pa0, pa1, pa2, pa3); pv_one<3>(o1[3], vb, pa0, pa1, pa2, pa3);
    if (j + 1 < NT) SWRITE(cur ^ 1);
    __syncthreads();
  }
  if (hi == 0) { li_l[r32] = 1.f / l0; al_l[r32] = lam / l1; }
  asm volatile("s_waitcnt lgkmcnt(0)" ::: "memory");
  float ss[16];
#pragma unroll
  for (int r = 0; r < 16; ++r) {
    const float a = li_l[crow(r, hi)], bq = al_l[crow(r, hi)];
    float s = 0.f;
#pragma unroll
    for (int d = 0; d < 4; ++d) { const float v = o0[d][r] * a - o1[d][r] * bq; o0[d][r] = v; s += v * v; }
    s += __shfl_xor(s, 1); s += __shfl_xor(s, 2); s += __shfl_xor(s, 4); s += __shfl_xor(s, 8); s += __shfl_xor(s, 16);
    ss[r] = rsqrtf(s * (1.f / 128.f) + EPS) * oscale;
  }
  bf16_t* Ow = Ob + (size_t)(wid * 32) * DM;
#pragma unroll
  for (int d = 0; d < 4; ++d) {
    const float g = ng[d * 32 + r32];
#pragma unroll
    for (int r = 0; r < 16; ++r) Ow[(size_t)crow(r, hi) * DM + d * 32 + r32] = (ABL & 4) ? (bf16_t)0 : (bf16_t)(cvtpk(o0[d][r] * ss[r] * g, 0.f) & 0xffffu);
  }
  __syncthreads();
#undef SLOAD
#undef SWRITE
#undef RESC
}

__device__ __forceinline__ float ins16(float (&a)[16], float x) {
#pragma unroll
  for (int i = 0; i < 16; ++i) { const float h = fmaxf(a[i], x); x = fminf(a[i], x); a[i] = h; }
  return x;
}
__device__ __forceinline__ float gelu_erf(float x) { return 0.5f * x * (1.f + erff(x * 0.70710678118654752440f)); }
__device__ __forceinline__ void peer_unit(const Params& p, int l, int unit, unsigned char* lds) {
  int tid_ = threadIdx.x; asm volatile("" : "+v"(tid_)); const int tid = tid_, lane = tid & 63, wid = tid >> 6, r32 = lane & 31, hi = lane >> 5;
  int* EID = (int*)lds;
  float* GW = (float*)(lds + 16384);
  float* SUQ = (float*)(lds + 32768);
  unsigned char* IDX = lds + 49152;
  const float* PSC = (const float*)(p.ws + WS_PSC);
  const int row0 = unit * 32;
  const bf16_t* QP = (const bf16_t*)(p.ws + WS_PROJ);
  const bf16_t* KEYS = (const bf16_t*)(p.ws + WS_KEYS) + (size_t)l * 131072;
  {
    const int h = wid;
    float top[2][16];
#pragma unroll
    for (int pp = 0; pp < 2; ++pp) {
      const bf16_t* qrow = QP + (size_t)(row0 + r32) * DM + h * 128 + pp * 64 + hi * 8;
      const bf16_t* kb = KEYS + ((size_t)(h * 2 + pp) * 128 + r32) * 64 + hi * 8;
      bf16x8 bq[4];
#pragma unroll
      for (int ks = 0; ks < 4; ++ks) bq[ks] = *(const bf16x8*)(qrow + ks * 16);
      float (&lst)[16] = top[pp];
#pragma unroll
      for (int i = 0; i < 16; ++i) lst[i] = -INFINITY;
#pragma unroll
      for (int nt = 0; nt < 4; ++nt) {
        f32x16 acc = {};
#pragma unroll
        for (int ks = 0; ks < 4; ++ks) {
          const bf16x8 ak = *(const bf16x8*)(kb + (size_t)nt * 32 * 64 + ks * 16);
          acc = __builtin_amdgcn_mfma_f32_32x32x16_bf16(ak, bq[ks], acc, 0, 0, 0);
        }
#pragma unroll
        for (int r = 0; r < 16; ++r) {
          const unsigned key = (__float_as_uint(acc[r]) & ~0x7Fu) | (unsigned)(nt * 32 + crow(r, hi));
          ins16(lst, __uint_as_float(key));
        }
        SBAR();
      }
      float oth[16];
#pragma unroll
      for (int i = 0; i < 16; ++i) oth[i] = __shfl_xor(lst[i], 32);
#pragma unroll
      for (int i = 0; i < 16; ++i) ins16(lst, oth[i]);
      if (hi == 0) {
        unsigned w[4];
#pragma unroll
        for (int i = 0; i < 4; ++i)
          w[i] = (__float_as_uint(lst[4 * i]) & 0x7Fu) | ((__float_as_uint(lst[4 * i + 1]) & 0x7Fu) << 8) | ((__float_as_uint(lst[4 * i + 2]) & 0x7Fu) << 16) | ((__float_as_uint(lst[4 * i + 3]) & 0x7Fu) << 24);
        *(u32x4*)(IDX + ((r32 * 8 + h) * 2 + pp) * 16) = (u32x4){w[0], w[1], w[2], w[3]};
      }
    }
    float best[16];
#pragma unroll
    for (int i = 0; i < 16; ++i) best[i] = -INFINITY;
#pragma unroll
    for (int i = 0; i < 16; ++i)
#pragma unroll
      for (int j = 0; j < 16; ++j)
        if ((i + 1) * (j + 1) <= 16) {
          const float s = __uint_as_float(__float_as_uint(top[0][i]) & ~0x7Fu) + __uint_as_float(__float_as_uint(top[1][j]) & ~0x7Fu);
          ins16(best, __uint_as_float((__float_as_uint(s) & ~0xFFu) | (unsigned)(i * 16 + j)));
        }
    asm volatile("s_waitcnt lgkmcnt(0)" ::: "memory");
    if (hi == 0) {
      const unsigned char* ib = IDX + ((r32 * 8 + h) * 2) * 16;
      const float mx = __uint_as_float(__float_as_uint(best[0]) & ~0xFFu);
      float w[16]; float sum = 0.f;
#pragma unroll
      for (int k = 0; k < 16; ++k) { w[k] = __expf(__uint_as_float(__float_as_uint(best[k]) & ~0xFFu) - mx); sum += w[k]; }
      const float rsum = 1.f / sum;
#pragma unroll
      for (int k = 0; k < 16; ++k) {
        const unsigned ij = __float_as_uint(best[k]) & 0xFFu;
        const int e = (int)ib[ij >> 4] * 128 + (int)ib[16 + (ij & 15)];
        EID[r32 * 128 + h * 16 + k] = e; GW[r32 * 128 + h * 16 + k] = w[k] * rsum * PSC[(size_t)(DEPTH + l) * NEXP + e];
        SUQ[r32 * 128 + h * 16 + k] = PSC[(size_t)l * NEXP + e];
      }
    }
  }
  __syncthreads();
  const bf16_t* H = (const bf16_t*)(p.ws + WS_H);
  const unsigned char* PUq = p.ws + WS_PU + (size_t)l * NEXP * DM;
  const unsigned char* PVq = p.ws + WS_PV + (size_t)l * NEXP * DM;
  float* XC = (float*)(p.ws + WS_XCUR);
  const float* MOD = (const float*)(p.ws + WS_MOD);
  for (int tt = 0; tt < 4; ++tt) {
    const int t = wid * 4 + tt, row = row0 + t;
    float hf[16];
    {
      const u32x4 hA = *(const u32x4*)(H + (size_t)row * DM + lane * 16), hB = *(const u32x4*)(H + (size_t)row * DM + lane * 16 + 8);
      hf[0] = bflo(hA.x); hf[1] = bfhi(hA.x); hf[2] = bflo(hA.y); hf[3] = bfhi(hA.y); hf[4] = bflo(hA.z); hf[5] = bfhi(hA.z); hf[6] = bflo(hA.w); hf[7] = bfhi(hA.w);
      hf[8] = bflo(hB.x); hf[9] = bfhi(hB.x); hf[10] = bflo(hB.y); hf[11] = bfhi(hB.y); hf[12] = bflo(hB.z); hf[13] = bfhi(hB.z); hf[14] = bflo(hB.w); hf[15] = bfhi(hB.w);
    }
    float acc[16];
    for (int rep = 0; rep < REP_PEER; ++rep) {
#pragma unroll
    for (int i = 0; i < 16; ++i) acc[i] = 0.f;
    u32x4 uq[8];
#pragma unroll
    for (int i = 0; i < 8; ++i) { const int e0 = __builtin_amdgcn_readfirstlane(EID[t * 128 + i]); uq[i] = *(const u32x4*)(PUq + (size_t)e0 * DM + lane * 16); }
    for (int g8 = 0; g8 < 16; ++g8) {
      int eid[8]; float gwt[8]; u32x4 vq[8];
#pragma unroll
      for (int i = 0; i < 8; ++i) {
        eid[i] = __builtin_amdgcn_readfirstlane(EID[t * 128 + g8 * 8 + i]);
        gwt[i] = __uint_as_float(__builtin_amdgcn_readfirstlane(__float_as_uint(GW[t * 128 + g8 * 8 + i])));
        vq[i] = *(const u32x4*)(PVq + (size_t)eid[i] * DM + lane * 16);
      }
      float d[8];
#pragma unroll
      for (int i = 0; i < 8; ++i) {
        const float su = __uint_as_float(__builtin_amdgcn_readfirstlane(__float_as_uint(SUQ[t * 128 + g8 * 8 + i])));
        float a0 = 0.f, a1 = 0.f;
#define DQ(W, K) { const f32x2 lo_ = __builtin_amdgcn_cvt_pk_f32_fp8((int)(W), false), hi_ = __builtin_amdgcn_cvt_pk_f32_fp8((int)(W), true); \
          a0 += lo_.x * hf[K]; a1 += lo_.y * hf[K + 1]; a0 += hi_.x * hf[K + 2]; a1 += hi_.y * hf[K + 3]; }
        DQ(uq[i].x, 0) DQ(uq[i].y, 4) DQ(uq[i].z, 8) DQ(uq[i].w, 12)
#undef DQ
        d[i] = (a0 + a1) * su;
      }
      if (g8 < 15) {
#pragma unroll
        for (int i = 0; i < 8; ++i) { const int e0 = __builtin_amdgcn_readfirstlane(EID[t * 128 + (g8 + 1) * 8 + i]); uq[i] = *(const u32x4*)(PUq + (size_t)e0 * DM + lane * 16); }
      }
      float tot;
      {
        auto s01 = __builtin_amdgcn_permlane32_swap(__float_as_uint(d[0]), __float_as_uint(d[1]), false, false);
        auto s23 = __builtin_amdgcn_permlane32_swap(__float_as_uint(d[2]), __float_as_uint(d[3]), false, false);
        auto s45 = __builtin_amdgcn_permlane32_swap(__float_as_uint(d[4]), __float_as_uint(d[5]), false, false);
        auto s67 = __builtin_amdgcn_permlane32_swap(__float_as_uint(d[6]), __float_as_uint(d[7]), false, false);
        const float q01 = __uint_as_float(s01[0]) + __uint_as_float(s01[1]), q23 = __uint_as_float(s23[0]) + __uint_as_float(s23[1]);
        const float q45 = __uint_as_float(s45[0]) + __uint_as_float(s45[1]), q67 = __uint_as_float(s67[0]) + __uint_as_float(s67[1]);
        auto ta = __builtin_amdgcn_permlane16_swap(__float_as_uint(q01), __float_as_uint(q23), false, false);
        auto tb = __builtin_amdgcn_permlane16_swap(__float_as_uint(q45), __float_as_uint(q67), false, false);
        const float r0123 = __uint_as_float(ta[0]) + __uint_as_float(ta[1]);
        const float r4567 = __uint_as_float(tb[0]) + __uint_as_float(tb[1]);
        const bool b3 = (lane & 8) != 0;
        const float keep = b3 ? r4567 : r0123, send = b3 ? r0123 : r4567;
        float x = keep + __shfl_xor(send, 8);
        x += __shfl_xor(x, 4); x += __shfl_xor(x, 2); x += __shfl_xor(x, 1);
        tot = x;
      }
      float ge;
      {
        const float v = tot, av = fabsf(v), tq = __builtin_amdgcn_rcpf(av * 0.2316418882f + 1.0f);
        float q = tq * 0.5307027145f + (-0.7265760135f); q = q * tq + 0.7107068705f; q = q * tq + (-0.142248368f); q = q * tq + 0.127414796f; q = q * tq;
        const float ex = __builtin_amdgcn_exp2f(v * v * (-0.72134752044f));
        const float m = v * (q * ex), r = v - m;
        ge = v < 0.f ? m : r;
      }
      float c[8];
      c[0] = __uint_as_float(__builtin_amdgcn_readlane(__float_as_uint(ge), 0)) * gwt[0];  c[4] = __uint_as_float(__builtin_amdgcn_readlane(__float_as_uint(ge), 8)) * gwt[4];
      c[2] = __uint_as_float(__builtin_amdgcn_readlane(__float_as_uint(ge), 16)) * gwt[2]; c[6] = __uint_as_float(__builtin_amdgcn_readlane(__float_as_uint(ge), 24)) * gwt[6];
      c[1] = __uint_as_float(__builtin_amdgcn_readlane(__float_as_uint(ge), 32)) * gwt[1]; c[5] = __uint_as_float(__builtin_amdgcn_readlane(__float_as_uint(ge), 40)) * gwt[5];
      c[3] = __uint_as_float(__builtin_amdgcn_readlane(__float_as_uint(ge), 48)) * gwt[3]; c[7] = __uint_as_float(__builtin_amdgcn_readlane(__float_as_uint(ge), 56)) * gwt[7];
#pragma unroll
      for (int i = 0; i < 8; ++i) {
#define AQ(W, K) { const f32x2 lo_ = __builtin_amdgcn_cvt_pk_f32_fp8((int)(W), false), hi_ = __builtin_amdgcn_cvt_pk_f32_fp8((int)(W), true); \
          acc[K] += c[i] * lo_.x; acc[K + 1] += c[i] * lo_.y; acc[K + 2] += c[i] * hi_.x; acc[K + 3] += c[i] * hi_.y; }
        AQ(vq[i].x, 0) AQ(vq[i].y, 4) AQ(vq[i].z, 8) AQ(vq[i].w, 12)
#undef AQ
      }
    }
    }
    const int mr = mod_row(row);
    const float* g2 = MOD + ((size_t)l * 5 + mr) * 6144 + 5 * 1024;
    float* xr = XC + (size_t)row * DM;
    float xn[16]; float ssq = 0.f;
    if (ABL & 8) {
#pragma unroll
      for (int i = 0; i < 16; ++i) acc[i] = 0.f;
    }
#pragma unroll
    for (int v4 = 0; v4 < 4; ++v4) {
      const int c = lane * 16 + v4 * 4;
      const f32x4 xo = *(const f32x4*)(xr + c), gg = *(const f32x4*)(g2 + c);
      f32x4 o;
      o.x = xo.x + gg.x * acc[v4 * 4 + 0]; o.y = xo.y + gg.y * acc[v4 * 4 + 1]; o.z = xo.z + gg.z * acc[v4 * 4 + 2]; o.w = xo.w + gg.w * acc[v4 * 4 + 3];
      xn[v4 * 4 + 0] = o.x; xn[v4 * 4 + 1] = o.y; xn[v4 * 4 + 2] = o.z; xn[v4 * 4 + 3] = o.w;
      ssq += (o.x * o.x + o.y * o.y) + (o.z * o.z + o.w * o.w);
      if (l < DEPTH - 1) *(f32x4*)(xr + c) = o;
    }
    const float rs = rsqrtf(wave_sum(ssq) * (1.f / DM) + EPS);
    if (l == DEPTH - 1) {
      const int b = row / SEGL, s = row - b * SEGL;
      float* orow = p.out + ((size_t)(b * SEQ + (s - CTXL))) * DM;
      const float* fg = p.in[I_FINALG];
#pragma unroll
      for (int v4 = 0; v4 < 4; ++v4) {
        const int c = lane * 16 + v4 * 4;
        const f32x4 gg = *(const f32x4*)(fg + c);
        f32x4 o; o.x = xn[v4 * 4 + 0] * rs * gg.x; o.y = xn[v4 * 4 + 1] * rs * gg.y; o.z = xn[v4 * 4 + 2] * rs * gg.z; o.w = xn[v4 * 4 + 3] * rs * gg.w;
        *(f32x4*)(orow + c) = o;
      }
    } else {
      const float* m = MOD + ((size_t)(l + 1) * 5 + mr) * 6144;
      const float* ng = p.in[I_N1G] + (l + 1) * DM;
      bf16_t* hrow = (bf16_t*)(p.ws + WS_H) + (size_t)row * DM;
#pragma unroll
      for (int hh = 0; hh < 2; ++hh) {
        float y[8];
#pragma unroll
        for (int i = 0; i < 8; ++i) { const int c = lane * 16 + hh * 8 + i; y[i] = xn[hh * 8 + i] * rs * ng[c] * (1.f + m[1024 + c]) + m[c]; }
        u32x4 w; w.x = cvtpk(y[0], y[1]); w.y = cvtpk(y[2], y[3]); w.z = cvtpk(y[4], y[5]); w.w = cvtpk(y[6], y[7]);
        *(u32x4*)(hrow + lane * 16 + hh * 8) = w;
      }
    }
  }
  __syncthreads();
}

__device__ __forceinline__ void phase_c1(const Params& p, int l, unsigned char* lds) {
  constexpr int NLOC = NBATCH * 4 * NCH, NCONV = T / 32;
  for (int u = blockIdx.x; u < NLOC + NCONV; u += gridDim.x) {
    if (u < NLOC) ml_local_unit(p, l, u, lds);
    else {
      const int cu = u - NLOC;
      if (l == DEPTH - 1 && (cu % (SEGL / 32)) < (CTXL / 32)) continue;
      conv_unit(p, l, cu, lds);
    }
  }
}
__device__ __forceinline__ void phase_c2(const Params& p, int l, unsigned char* lds) {
  ml_scan(p);
  const float* lp = p.in[I_DLAM] + l * 256;
  float s01 = 0.f, s23 = 0.f;
  for (int i = 0; i < 64; ++i) { s01 += lp[i] * lp[64 + i]; s23 += lp[128 + i] * lp[192 + i]; }
  const float lam_init = 0.8f - 0.6f * expf(-0.3f * (float)l);
  const float lam = expf(s01) - expf(s23) + lam_init;
  const bf16_t* PROJ = (const bf16_t*)(p.ws + WS_PROJ);
  bf16_t* MIX = (bf16_t*)(p.ws + WS_MIX);
  const float* ng = p.in[I_DNORMG] + l * 128;
  const int nun = 512 + (l < DEPTH - 1 ? 16 : 0);
  for (int u = blockIdx.x; u < nun; u += gridDim.x) {
    int bh, qrow, nkeys;
    if (u < 512) { const int xcd = u & 7, i = (u >> 3) & 31, rnd = u >> 8; bh = 2 * xcd + rnd; qrow = CTXL + i * 256; nkeys = SEGL; }
    else { bh = u - 512; qrow = 0; nkeys = CTXL; }
    const int b = bh >> 2, h = bh & 3;
    const size_t tok0 = (size_t)b * SEGL;
    for (int rep = 0; rep < REP_ATT; ++rep)
    att_unit(PROJ + (tok0 + qrow) * PW + C_DQ + h * 128, PROJ + tok0 * PW + C_DK + h * 128, PROJ + tok0 * PW + C_DV + h * 128,
             MIX + (tok0 + qrow) * DM + 512 + h * 128, nkeys, lam, ng, 1.f - lam_init, lds);
  }
}
__device__ __forceinline__ void phase_c3(const Params& p, int l, unsigned char* lds) {
  constexpr int NU = NBATCH * 4 * NCH;
  for (int u = blockIdx.x; u < NU; u += gridDim.x) {
    if (l == DEPTH - 1 && (u % NCH) < 4) continue;
    ml_out_unit(p, l, u, lds);
  }
}
__device__ __forceinline__ void phase_peer(const Params& p, int l, unsigned char* lds) {
  constexpr int NU = T / 32;
  for (int u = blockIdx.x; u < NU; u += gridDim.x) {
    if (l == DEPTH - 1 && (u % (SEGL / 32)) < (CTXL / 32)) continue;
    peer_unit(p, l, u, lds);
  }
}

__global__ void __launch_bounds__(512, 2) mk_fwd(Params p) {
  cg::grid_group grid = cg::this_grid();
  extern __shared__ __attribute__((aligned(16))) unsigned char lds[];
  const int lo = p.ph_lo, hi = p.ph_hi;
#define IN(k) (lo <= (k) && (k) < hi)
#ifndef PHASEMASK
#define PHASEMASK 0xFFFF
#endif
#define PH(i) ((PHASEMASK >> (i)) & 1)
#define SEAM(k) do { if (IN(k) && IN((k) + 1)) grid.sync(); } while (0)
  if (PH(0) && IN(0)) { p0_mod(p, lds, (float*)(p.ws + WS_MOD)); p0_convert(p, lds); }
  SEAM(0);
  if (PH(1) && IN(1)) phase_norm(p, 0, 0, true, false);
  SEAM(1);
#pragma unroll 1
  for (int l_ = 0; l_ < DEPTH; ++l_) {
    int l = l_; asm volatile("" : "+s"(l));
    const int b = 2 + 8 * l;
    if (PH(2) && IN(b + 0)) for (int rep = 0; rep < REP_GEMM; ++rep) phase_inproj(p, l, lds);
    SEAM(b + 0);
    if (PH(3) && IN(b + 1)) phase_c1(p, l, lds);
    SEAM(b + 1);
    if (PH(4) && IN(b + 2)) phase_c2(p, l, lds);
    SEAM(b + 2);
    if (PH(5) && IN(b + 3)) phase_c3(p, l, lds);
    SEAM(b + 3);
    if (PH(6) && IN(b + 4)) phase_outproj(p, l, lds);
    SEAM(b + 4);
    if (PH(7) && IN(b + 5)) phase_norm(p, l, 1, false, l == DEPTH - 1);
    SEAM(b + 5);
    if (PH(8) && IN(b + 6)) for (int rep = 0; rep < REP_GEMM; ++rep) phase_peerq(p, l, lds);
    SEAM(b + 6);
    if (PH(9) && IN(b + 7)) phase_peer(p, l, lds);
    SEAM(b + 7);
  }
#undef IN
#undef SEAM
}

extern "C" void kernel_launch(void* const* d_in, const int* in_sizes, int n_in, void* d_out, int out_size,
                              void* d_ws, size_t ws_size, hipStream_t stream) {
  static int grid = 0;
  if (grid == 0) {
    int dev = 0, cus = 0, per_cu = 0;
    (void)hipGetDevice(&dev);
    (void)hipDeviceGetAttribute(&cus, hipDeviceAttributeMultiprocessorCount, dev);
    (void)hipFuncSetAttribute((const void*)mk_fwd, hipFuncAttributeMaxDynamicSharedMemorySize, LDS_BYTES);
    (void)hipOccupancyMaxActiveBlocksPerMultiprocessor(&per_cu, (const void*)mk_fwd, 512, LDS_BYTES);
    fprintf(stderr, "kernel_launch: cus %d per_cu %d ws %zu (need %zu) n_in %d\n", cus, per_cu, ws_size, (size_t)WS_END, n_in);
    if (ws_size < WS_END || n_in != 23 || per_cu < 1) { fprintf(stderr, "kernel_launch: bad configuration, nothing launched\n"); grid = -1; return; }
    grid = cus;
  }
  if (grid < 0) return;
  Params p{};
  for (int i = 0; i < 23; ++i) p.in[i] = (const float*)d_in[i];
  p.out = (float*)d_out; p.ws = (unsigned char*)d_ws; p.ph_lo = 0; p.ph_hi = 34;
  void* args[] = {&p};
  hipError_t e = hipLaunchCooperativeKernel((const void*)mk_fwd, dim3(grid), dim3(512), args, LDS_BYTES, stream);
  if (e != hipSuccess) fprintf(stderr, "cooperative launch failed: %s (grid %d)\n", hipGetErrorString(e), grid);
}
```

```cpp
#include <hip/hip_runtime.h>
#include <hip/hip_cooperative_groups.h>
#include <cstdio>
#include <cstdint>
namespace cg = cooperative_groups;

constexpr int DM = 1024, NBATCH = 4, SEQ = 8192, CTXL = 256, SEGL = CTXL + SEQ, T = NBATCH * SEGL, DEPTH = 4;
constexpr int IN_W = 3088, PW = 3072;
constexpr int C_A = 0, C_MQ = 512, C_MK = 768, C_MV = 1024, C_MO = 1280, C_DQ = 1536, C_DK = 2048, C_DV = 2560;
constexpr int NCH = SEGL / 64;
constexpr int NEXP = 16384;
constexpr float EPS = 1e-6f;
#ifndef ABL
#define ABL 0
#endif
#ifndef REP_ATT
#define REP_ATT 1
#endif
#ifndef REP_PEER
#define REP_PEER 1
#endif
#ifndef REP_GEMM
#define REP_GEMM 1
#endif
#ifndef REP_ROUTE
#define REP_ROUTE 1
#endif
#ifndef REP_OUTP
#define REP_OUTP 1
#endif
#ifndef REP_ML
#define REP_ML 1
#endif
#ifndef REP_MISC
#define REP_MISC 1
#endif
constexpr float QSCALE = 0.125f * 1.4426950408889634f;

constexpr size_t MiB = 1u << 20;
constexpr size_t WS_CTL = 0, WS_MOD = 1 * MiB, WS_ROPE = 2 * MiB, WS_WG = 4 * MiB, WS_KEYS = 5 * MiB, WS_MLMETA = 6 * MiB,
                 WS_GATES = 7 * MiB, WS_WIN = 10 * MiB, WS_WOUT = 34 * MiB, WS_WQ = 42 * MiB, WS_PU = 50 * MiB, WS_PV = 114 * MiB, WS_PSC = 178 * MiB  ,
                 WS_XCUR = 306 * MiB, WS_H = 438 * MiB, WS_MIX = 504 * MiB, WS_PROJ = 570 * MiB, WS_ULOC = 768 * MiB, WS_END = 836 * MiB;
constexpr int USTRIDE = 4160;

constexpr int LDS_BYTES = 139264;

typedef unsigned short bf16_t;
typedef short bf16x8 __attribute__((ext_vector_type(8)));
typedef short s16x4 __attribute__((ext_vector_type(4)));
typedef float f32x4 __attribute__((ext_vector_type(4)));
typedef float f32x16 __attribute__((ext_vector_type(16)));
typedef unsigned u32x4 __attribute__((ext_vector_type(4)));
typedef unsigned u32x2 __attribute__((ext_vector_type(2)));
typedef __bf16 bf16x2v __attribute__((ext_vector_type(2)));
typedef float f32x2 __attribute__((ext_vector_type(2)));

struct Params {
  const float* in[23];
  float* out;
  unsigned char* ws;
  int ph_lo, ph_hi;
};
enum { I_X = 0, I_C, I_CTX, I_CCTX, I_ADAW, I_ADAB, I_N1G, I_N2G, I_WIN, I_CONVW, I_CONVB, I_CLNG, I_CLNB, I_GATEB, I_MNORMG, I_DLAM, I_DNORMG,
       I_WOUT, I_PWQ, I_PKEYS, I_PU, I_PV, I_FINALG };

__device__ __forceinline__ unsigned cvtpk(float lo, float hi) { unsigned r; asm volatile("v_cvt_pk_bf16_f32 %0, %1, %2" : "=v"(r) : "v"(lo), "v"(hi)); return r; }
__device__ __forceinline__ float bflo(unsigned u) { return __uint_as_float(u << 16); }
__device__ __forceinline__ float bfhi(unsigned u) { return __uint_as_float(u & 0xffff0000u); }
__device__ __forceinline__ float bf1(bf16_t u) { return __uint_as_float(((unsigned)u) << 16); }
__device__ __forceinline__ int crow(int r, int hi) { return (r & 3) + 8 * (r >> 2) + 4 * hi; }
__device__ __forceinline__ float wave_sum(float v) {
#pragma unroll
  for (int o = 1; o < 64; o <<= 1) v += __shfl_xor(v, o);
  return v;
}
__device__ __forceinline__ float wave_max(float v) {
#pragma unroll
  for (int o = 1; o < 64; o <<= 1) v = fmaxf(v, __shfl_xor(v, o));
  return v;
}
__device__ __forceinline__ float sigmoidf_(float x) { return 1.f / (1.f + __expf(-x)); }
__device__ __forceinline__ float logsigmoidf_(float x) { return fminf(x, 0.f) - log1pf(__expf(-fabsf(x))); }
__device__ __forceinline__ const float* in_row(const float* x, const float* ctx, int row) {
  const int b = row / SEGL, s = row - b * SEGL;
  return s < CTXL ? ctx + ((size_t)(b * CTXL + s)) * DM : x + ((size_t)(b * SEQ + (s - CTXL))) * DM;
}
__device__ __forceinline__ int mod_row(int row) { const int b = row / SEGL, s = row - b * SEGL; return s < CTXL ? 4 : b; }

__device__ __forceinline__ void p0_mod(const Params& p, unsigned char* lds, float* MOD) {
  float* sil = (float*)lds;
  float* red = (float*)(lds + 20480);
  int tid_ = threadIdx.x; asm volatile("" : "+v"(tid_)); const int tid = tid_, lane = tid & 63, wid = tid >> 6;
  for (int i = tid; i < 5 * 1024; i += 512) {
    const float v = i < 4096 ? p.in[I_C][i] : p.in[I_CCTX][i - 4096];
    sil[i] = v / (1.f + __expf(-v));
  }
  __syncthreads();
  for (int item = blockIdx.x; item < DEPTH * 96; item += gridDim.x) {
    const int l = item / 96, j0 = (item % 96) * 64;
    const float* W = p.in[I_ADAW] + (size_t)l * DM * 6144 + j0 + lane;
    float a0 = 0.f, a1 = 0.f, a2 = 0.f, a3 = 0.f, a4 = 0.f;
    const int k0 = wid * 128;
#pragma unroll 8
    for (int k = k0; k < k0 + 128; ++k) {
      const float w = W[(size_t)k * 6144];
      a0 += sil[k] * w; a1 += sil[1024 + k] * w; a2 += sil[2048 + k] * w; a3 += sil[3072 + k] * w; a4 += sil[4096 + k] * w;
    }
    red[(wid * 5 + 0) * 64 + lane] = a0; red[(wid * 5 + 1) * 64 + lane] = a1; red[(wid * 5 + 2) * 64 + lane] = a2;
    red[(wid * 5 + 3) * 64 + lane] = a3; red[(wid * 5 + 4) * 64 + lane] = a4;
    __syncthreads();
    if (tid < 320) {
      const int r = tid >> 6;
      float s = 0.f;
#pragma unroll
      for (int w = 0; w < 8; ++w) s += red[(w * 5 + r) * 64 + lane];
      MOD[((size_t)l * 5 + r) * 6144 + j0 + lane] = s + p.in[I_ADAB][l * 6144 + j0 + lane];
    }
    __syncthreads();
  }
}
__device__ __forceinline__ void transpose_item(const float* W, int ldw, int srccol0, bf16_t* WT, int K, int n0, int k0, float* scr, int lane) {
#pragma unroll 8
  for (int i = 0; i < 32; ++i) { const int kk = 2 * i + (lane >> 5); scr[kk * 33 + (lane & 31)] = W[(size_t)(k0 + kk) * ldw + srccol0 + (lane & 31)]; }
  asm volatile("s_waitcnt lgkmcnt(0)" ::: "memory");
  const int c = lane & 7;
#pragma unroll
  for (int j = 0; j < 4; ++j) {
    const int n = (lane >> 3) + 8 * j; const float* s = scr + (8 * c) * 33 + n;
    u32x4 o; o.x = cvtpk(s[0], s[33]); o.y = cvtpk(s[66], s[99]); o.z = cvtpk(s[132], s[165]); o.w = cvtpk(s[198], s[231]);
    *(u32x4*)(WT + (size_t)(n0 + n) * K + k0 + 8 * c) = o;
  }
  asm volatile("s_waitcnt lgkmcnt(0)" ::: "memory");
}
__device__ __forceinline__ void p0_convert(const Params& p, unsigned char* lds) {
  int tid_ = threadIdx.x; asm volatile("" : "+v"(tid_)); const int tid = tid_, lane = tid & 63, wid = tid >> 6;
  const int gw = blockIdx.x * 8 + wid, NGW = gridDim.x * 8;
  const size_t gt = (size_t)blockIdx.x * 512 + tid, NGT = (size_t)gridDim.x * 512;
  float* scr = (float*)(lds + 32768) + wid * (64 * 33);
  bf16_t* WIN = (bf16_t*)(p.ws + WS_WIN); bf16_t* WOUT = (bf16_t*)(p.ws + WS_WOUT); bf16_t* WQ = (bf16_t*)(p.ws + WS_WQ);
  constexpr int I_IN = 16 * 96, I_O = 16 * 32, PER_L = I_IN + 2 * I_O;
  for (int it = gw; it < DEPTH * PER_L; it += NGW) {
    const int l = it / PER_L; int r = it % PER_L;
    if (r < I_IN) { const int kb = r / 96, nb = r % 96, n0 = nb * 32; const int src = n0 < 1536 ? n0 : n0 + 16;
      transpose_item(p.in[I_WIN] + (size_t)l * DM * IN_W, IN_W, src, WIN + (size_t)l * PW * DM, DM, n0, kb * 64, scr, lane); continue; }
    r -= I_IN;
    if (r < I_O) { const int kb = r / 32, nb = r % 32;
      transpose_item(p.in[I_WOUT] + (size_t)l * DM * DM, DM, nb * 32, WOUT + (size_t)l * DM * DM, DM, nb * 32, kb * 64, scr, lane); continue; }
    r -= I_O;
    { const int kb = r / 32, nb = r % 32;
      transpose_item(p.in[I_PWQ] + (size_t)l * DM * DM, DM, nb * 32, WQ + (size_t)l * DM * DM, DM, nb * 32, kb * 64, scr, lane); }
  }
  bf16_t* WG = (bf16_t*)(p.ws + WS_WG);
  for (size_t i = gt; i < (size_t)DEPTH * 16 * DM; i += NGT) {
    const int l = (int)(i / (16 * DM)), g = (int)((i / DM) % 16), k = (int)(i % DM);
    WG[i] = (bf16_t)(cvtpk(p.in[I_WIN][(size_t)l * DM * IN_W + (size_t)k * IN_W + 1536 + g], 0.f) & 0xffffu);
  }
  bf16_t* KEYS = (bf16_t*)(p.ws + WS_KEYS);
  for (size_t i = gt; i < (size_t)DEPTH * 131072 / 8; i += NGT) {
    const f32x4 a = ((const f32x4*)p.in[I_PKEYS])[2 * i], b = ((const f32x4*)p.in[I_PKEYS])[2 * i + 1];
    u32x4 o; o.x = cvtpk(a.x, a.y); o.y = cvtpk(a.z, a.w); o.z = cvtpk(b.x, b.y); o.w = cvtpk(b.z, b.w);
    ((u32x4*)KEYS)[i] = o;
  }
  {
    unsigned char* PUq = p.ws + WS_PU; unsigned char* PVq = p.ws + WS_PV; float* PSC = (float*)(p.ws + WS_PSC);
    const int nrows = DEPTH * NEXP;
    for (int r = gw; r < 2 * nrows; r += NGW) {
      const int tb = r >= nrows, rr = tb ? r - nrows : r;
      const f32x4* srow = (const f32x4*)((tb ? p.in[I_PV] : p.in[I_PU]) + (size_t)rr * DM) + lane * 4;
      f32x4 v[4]; float mx = 0.f;
#pragma unroll
      for (int j = 0; j < 4; ++j) { v[j] = __builtin_nontemporal_load(srow + j); mx = fmaxf(mx, fmaxf(fmaxf(fabsf(v[j].x), fabsf(v[j].y)), fmaxf(fabsf(v[j].z), fabsf(v[j].w)))); }
      mx = wave_max(mx);
      const int eb = (int)((__float_as_uint(mx) >> 23) & 0xFFu);
      int sb = 261 - eb; sb = sb < 1 ? 1 : (sb > 253 ? 253 : sb);
      const float sc = __uint_as_float((unsigned)sb << 23), isc = __uint_as_float((unsigned)(254 - sb) << 23);
      u32x4 o;
      int w;
#define CV4(V, OUT) w = 0; w = __builtin_amdgcn_cvt_pk_fp8_f32(V.x * sc, V.y * sc, w, false); w = __builtin_amdgcn_cvt_pk_fp8_f32(V.z * sc, V.w * sc, w, true); OUT = (unsigned)w
      CV4(v[0], o.x); CV4(v[1], o.y); CV4(v[2], o.z); CV4(v[3], o.w);
#undef CV4
      *(u32x4*)((tb ? PVq : PUq) + (size_t)rr * DM + lane * 16) = o;
      if (lane == 0) PSC[(size_t)tb * nrows + rr] = isc;
    }
  }
  {
    float* RC = (float*)(p.ws + WS_ROPE); float* RS = RC + SEQ * 32;
    for (size_t i = gt; i < (size_t)SEQ * 32; i += NGT) {
      const int pos = (int)(i >> 5), j = (int)(i & 31);
      const int rr = pos >> 6, cc = pos & 63;
      const int jj = j & 15;
      const double e = -(double)jj * 0.83048202372184058696;
      const double fl = __builtin_floor(e); const double f = e - fl;
      const double z = f * 0.69314718055994530942;
      double ez = 1.0 + z * (1.0 + z * (0.5 + z * (1.0 / 6 + z * (1.0 / 24 + z * (1.0 / 120 + z * (1.0 / 720 + z * (1.0 / 5040 + z * (1.0 / 40320 + z * (1.0 / 362880 + z * (1.0 / 3628800 + z * (1.0 / 39916800 + z * (1.0 / 479001600))))))))))));
      const double inv = __builtin_ldexp(ez, (int)fl);
      const float invf = (float)inv;
      const float angf = (float)(j < 16 ? rr : cc) * invf;
      const double ang = (double)angf;
      const double kq = __builtin_rint(ang * 0.63661977236758134308);
      double r = __builtin_fma(-kq, 1.57079632679489655800e+00, ang);
      r = __builtin_fma(-kq, 6.12323399573676603587e-17, r);
      const double r2 = r * r;
      const double sn = r * (1.0 + r2 * (-1.0 / 6 + r2 * (1.0 / 120 + r2 * (-1.0 / 5040 + r2 * (1.0 / 362880 + r2 * (-1.0 / 39916800 + r2 * (1.0 / 6227020800.0)))))));
      const double cs = 1.0 + r2 * (-0.5 + r2 * (1.0 / 24 + r2 * (-1.0 / 720 + r2 * (1.0 / 40320 + r2 * (-1.0 / 3628800 + r2 * (1.0 / 479001600 + r2 * (-1.0 / 87178291200.0)))))));
      const int q = ((int)kq) & 3;
      double co, si;
      if (q == 0) { co = cs; si = sn; } else if (q == 1) { co = -sn; si = cs; } else if (q == 2) { co = -cs; si = -sn; } else { co = sn; si = -cs; }
      RC[i] = (float)co; RS[i] = (float)si;
    }
  }
}

__device__ __forceinline__ void norm_mod_row(const float* xrow, const float* g, const float* sc, const float* sh, bf16_t* orow, int lane) {
  const f32x4* xr = (const f32x4*)xrow + lane;
  f32x4 v[4]; float s = 0.f;
#pragma unroll
  for (int j = 0; j < 4; ++j) { v[j] = xr[64 * j]; s += (v[j].x * v[j].x + v[j].y * v[j].y) + (v[j].z * v[j].z + v[j].w * v[j].w); }
  const float rs = rsqrtf(wave_sum(s) * (1.f / DM) + EPS);
  u32x2* o = (u32x2*)orow + lane;
#pragma unroll
  for (int j = 0; j < 4; ++j) {
    const f32x4 gg = ((const f32x4*)g)[lane + 64 * j], cc = ((const f32x4*)sc)[lane + 64 * j], hh = ((const f32x4*)sh)[lane + 64 * j];
    const float y0 = v[j].x * rs * gg.x * (1.f + cc.x) + hh.x, y1 = v[j].y * rs * gg.y * (1.f + cc.y) + hh.y;
    const float y2 = v[j].z * rs * gg.z * (1.f + cc.z) + hh.z, y3 = v[j].w * rs * gg.w * (1.f + cc.w) + hh.w;
    u32x2 w; w.x = cvtpk(y0, y1); w.y = cvtpk(y2, y3);
    o[64 * j] = w;
  }
}
__device__ __forceinline__ void phase_norm(const Params& p, int l, int which, bool from_input, bool skip_ctx) {
  int tid_ = threadIdx.x; asm volatile("" : "+v"(tid_));
  const int lane = tid_ & 63, wid = tid_ >> 6;
  const int gw = blockIdx.x * 8 + wid, NGW = gridDim.x * 8;
  const float* MOD = (const float*)(p.ws + WS_MOD);
  const float* XC = (const float*)(p.ws + WS_XCUR);
  bf16_t* H = (bf16_t*)(p.ws + WS_H);
  const float* g = p.in[which ? I_N2G : I_N1G] + l * DM;
  for (int row = gw; row < T; row += NGW) {
    const int mr = mod_row(row);
    if (skip_ctx && mr == 4) continue;
    const float* m = MOD + ((size_t)l * 5 + mr) * 6144 + which * 3072;
    const float* xr = from_input ? in_row(p.in[I_X], p.in[I_CTX], row) : XC + (size_t)row * DM;
    norm_mod_row(xr, g, m + 1024, m, H + (size_t)row * DM, lane);
  }
}

__device__ __forceinline__ int gswz(int row, int chunk) { return row * 128 + ((chunk ^ ((row >> 1) & 7)) << 4); }
__device__ __forceinline__ void gemm_tile(const bf16_t* __restrict__ A, int lda, const bf16_t* __restrict__ Bt, int ldb, int K,
                                          int row0, int col0, unsigned char* lds, f32x16 (&acc)[2][2]) {
  int tid_ = threadIdx.x; asm volatile("" : "+v"(tid_)); const int tid = tid_, lane = tid & 63, wid = tid >> 6, wm = wid >> 1, wn = wid & 1, r32 = lane & 31, hi = lane >> 5;
  unsigned char* As = lds; unsigned char* Bs = lds + 65536;
#pragma unroll
  for (int i = 0; i < 2; ++i)
#pragma unroll
    for (int j = 0; j < 2; ++j) acc[i][j] = f32x16{};
  const int lrow = tid >> 3, lc = tid & 7;
  const bf16_t* Ag = A + (size_t)(row0 + lrow) * lda + lc * 8;
  const bf16_t* Bg = Bt + (size_t)(col0 + lrow) * ldb + lc * 8;
  u32x4 ra[4], rb[2];
#pragma unroll
  for (int i = 0; i < 4; ++i) ra[i] = *(const u32x4*)(Ag + (size_t)(64 * i) * lda);
#pragma unroll
  for (int i = 0; i < 2; ++i) rb[i] = *(const u32x4*)(Bg + (size_t)(64 * i) * ldb);
#pragma unroll
  for (int i = 0; i < 4; ++i) *(u32x4*)(As + gswz(lrow + 64 * i, lc)) = ra[i];
#pragma unroll
  for (int i = 0; i < 2; ++i) *(u32x4*)(Bs + gswz(lrow + 64 * i, lc)) = rb[i];
  __syncthreads();
  const int nk = K / 64;
  for (int kt = 0; kt < nk; ++kt) {
    const int cur = kt & 1;
    if (kt + 1 < nk) {
#pragma unroll
      for (int i = 0; i < 4; ++i) ra[i] = *(const u32x4*)(Ag + (size_t)(64 * i) * lda + (kt + 1) * 64);
#pragma unroll
      for (int i = 0; i < 2; ++i) rb[i] = *(const u32x4*)(Bg + (size_t)(64 * i) * ldb + (kt + 1) * 64);
    }
    const unsigned char* Ac = As + cur * 32768; const unsigned char* Bc = Bs + cur * 16384;
#pragma unroll
    for (int kk = 0; kk < 4; ++kk) {
      bf16x8 af[2], bfr[2];
#pragma unroll
      for (int i = 0; i < 2; ++i) af[i] = *(const bf16x8*)(Ac + gswz(wm * 64 + i * 32 + r32, 2 * kk + hi));
#pragma unroll
      for (int j = 0; j < 2; ++j) bfr[j] = *(const bf16x8*)(Bc + gswz(wn * 64 + j * 32 + r32, 2 * kk + hi));
#pragma unroll
      for (int i = 0; i < 2; ++i)
#pragma unroll
        for (int j = 0; j < 2; ++j) acc[i][j] = __builtin_amdgcn_mfma_f32_32x32x16_bf16(af[i], bfr[j], acc[i][j], 0, 0, 0);
    }
    if (kt + 1 < nk) {
      unsigned char* An = As + (cur ^ 1) * 32768; unsigned char* Bn = Bs + (cur ^ 1) * 16384;
#pragma unroll
      for (int i = 0; i < 4; ++i) *(u32x4*)(An + gswz(lrow + 64 * i, lc)) = ra[i];
#pragma unroll
      for (int i = 0; i < 2; ++i) *(u32x4*)(Bn + gswz(lrow + 64 * i, lc)) = rb[i];
    }
    __syncthreads();
  }
}
__device__ __forceinline__ void pair_xchg(float v0, float v1, int lane, float& lo, float& hi2) {
  const bool odd = lane & 1;
  const float send = odd ? v0 : v1;
  const float recv = __shfl_xor(send, 1);
  lo = odd ? recv : v0; hi2 = odd ? v1 : recv;
}

__device__ __forceinline__ void phase_inproj(const Params& p, int l, unsigned char* lds) {
  int tid_ = threadIdx.x; asm volatile("" : "+v"(tid_)); const int tid = tid_, lane = tid & 63, wid = tid >> 6, wm = wid >> 1, wn = wid & 1, r32 = lane & 31, hi = lane >> 5;
  const bf16_t* H = (const bf16_t*)(p.ws + WS_H);
  const bf16_t* W = (const bf16_t*)(p.ws + WS_WIN) + (size_t)l * PW * DM;
  bf16_t* PROJ = (bf16_t*)(p.ws + WS_PROJ);
  const float* RC = (const float*)(p.ws + WS_ROPE); const float* RS = RC + SEQ * 32;
  constexpr int NM = T / 256, NN = PW / 128, NU = NM * NN;
  for (int u = blockIdx.x; u < NU + NM; u += gridDim.x) {
    if (u < NU) {
      const int pn = u / NM, pm = u % NM;
      const int row0 = pm * 256, col0 = pn * 128;
      f32x16 acc[2][2];
      gemm_tile(H, DM, W, DM, DM, row0, col0, lds, acc);
      const bool rope = (col0 >= C_DQ && col0 < C_DV);
      const float scl = (col0 >= C_MK && col0 < C_MV) ? 0.125f : ((col0 >= C_DQ && col0 < C_DK) ? QSCALE : 1.f);
#pragma unroll
      for (int i = 0; i < 2; ++i)
#pragma unroll
        for (int j = 0; j < 2; ++j)
#pragma unroll
          for (int q = 0; q < 8; ++q) {
            float lo, hi2; pair_xchg(acc[i][j][2 * q], acc[i][j][2 * q + 1], lane, lo, hi2);
            const int row = row0 + wm * 64 + i * 32 + crow(2 * q, hi) + (lane & 1);
            const int col = col0 + wn * 64 + j * 32 + (r32 & ~1);
            if (rope) {
              const int s = row % SEGL;
              if (s >= CTXL) {
                const int idx = (s - CTXL) * 32 + ((col & 63) >> 1);
                const float c = RC[idx], sn = RS[idx];
                const float t1 = lo, t2 = hi2; lo = t1 * c - t2 * sn; hi2 = t1 * sn + t2 * c;
              }
            }
            *(unsigned*)(PROJ + (size_t)row * PW + col) = cvtpk(lo * scl, hi2 * scl);
          }
    } else {
      const int pm = u - NU, rowb = pm * 256 + wid * 32;
      const bf16_t* WG = (const bf16_t*)(p.ws + WS_WG) + (size_t)l * 16 * DM;
      float* GT = (float*)(p.ws + WS_GATES);
      const int r16 = lane & 15, q4 = lane >> 4;
      f32x4 c0 = {0.f, 0.f, 0.f, 0.f}, c1 = {0.f, 0.f, 0.f, 0.f};
      const bf16_t* a0p = H + (size_t)(rowb + r16) * DM + q4 * 8;
      const bf16_t* a1p = a0p + (size_t)16 * DM;
      const bf16_t* bp = WG + (size_t)r16 * DM + q4 * 8;
#pragma unroll 4
      for (int ks = 0; ks < 32; ++ks) {
        const bf16x8 a0 = *(const bf16x8*)(a0p + ks * 32), a1 = *(const bf16x8*)(a1p + ks * 32), b = *(const bf16x8*)(bp + ks * 32);
        c0 = __builtin_amdgcn_mfma_f32_16x16x32_bf16(a0, b, c0, 0, 0, 0);
        c1 = __builtin_amdgcn_mfma_f32_16x16x32_bf16(a1, b, c1, 0, 0, 0);
      }
      const float gb = p.in[I_GATEB][l * 16 + r16];
#pragma unroll
      for (int j = 0; j < 4; ++j) {
        GT[(size_t)(rowb + q4 * 4 + j) * 16 + r16] = c0[j] + gb;
        GT[(size_t)(rowb + 16 + q4 * 4 + j) * 16 + r16] = c1[j] + gb;
      }
    }
  }
}

__device__ __forceinline__ void phase_outproj(const Params& p, int l, unsigned char* lds) {
  int tid_ = threadIdx.x; asm volatile("" : "+v"(tid_)); const int tid = tid_, lane = tid & 63, wid = tid >> 6, wm = wid >> 1, wn = wid & 1, r32 = lane & 31, hi = lane >> 5;
  const bf16_t* MIX = (const bf16_t*)(p.ws + WS_MIX);
  const bf16_t* W = (const bf16_t*)(p.ws + WS_WOUT) + (size_t)l * DM * DM;
  float* XC = (float*)(p.ws + WS_XCUR);
  const float* MOD = (const float*)(p.ws + WS_MOD);
  constexpr int NM = T / 256, NN = DM / 128, NU = NM * NN;
  for (int u = blockIdx.x; u < NU; u += gridDim.x) {
    const int pm = u / NN, pn = u % NN;
    if (l == DEPTH - 1 && (pm % 33) == 0) continue;
    const int row0 = pm * 256, col0 = pn * 128;
    for (int rep = 0; rep < REP_OUTP; ++rep) {
    f32x16 acc[2][2];
    gemm_tile(MIX, DM, W, DM, DM, row0, col0, lds, acc);
    const int mr = (pm % 33) == 0 ? 4 : pm / 33;
    const float* g1 = MOD + ((size_t)l * 5 + mr) * 6144 + 2048;
#pragma unroll
    for (int i = 0; i < 2; ++i)
#pragma unroll
      for (int j = 0; j < 2; ++j) {
        const int col = col0 + wn * 64 + j * 32 + r32;
        const float gg = (rep == REP_OUTP - 1) ? g1[col] : 0.f;
#pragma unroll
        for (int r = 0; r < 16; ++r) {
          const int row = row0 + wm * 64 + i * 32 + crow(r, hi);
          const float xo = (l == 0) ? in_row(p.in[I_X], p.in[I_CTX], row)[col] : XC[(size_t)row * DM + col];
          XC[(size_t)row * DM + col] = xo + gg * acc[i][j][r];
        }
      }
    }
  }
}
__device__ __forceinline__ void phase_peerq(const Params& p, int l, unsigned char* lds) {
  int tid_ = threadIdx.x; asm volatile("" : "+v"(tid_)); const int tid = tid_, lane = tid & 63, wid = tid >> 6, wm = wid >> 1, wn = wid & 1, r32 = lane & 31, hi = lane >> 5;
  const bf16_t* H = (const bf16_t*)(p.ws + WS_H);
  const bf16_t* W = (const bf16_t*)(p.ws + WS_WQ) + (size_t)l * DM * DM;
  bf16_t* QP = (bf16_t*)(p.ws + WS_PROJ);
  constexpr int NM = T / 256, NN = DM / 128, NU = NM * NN;
  for (int u = blockIdx.x; u < NU; u += gridDim.x) {
    const int pm = u / NN, pn = u % NN;
    if (l == DEPTH - 1 && (pm % 33) == 0) continue;
    const int row0 = pm * 256, col0 = pn * 128;
    f32x16 acc[2][2];
    gemm_tile(H, DM, W, DM, DM, row0, col0, lds, acc);
#pragma unroll
    for (int i = 0; i < 2; ++i)
#pragma unroll
      for (int j = 0; j < 2; ++j)
#pragma unroll
        for (int q = 0; q < 8; ++q) {
          float lo, hi2; pair_xchg(acc[i][j][2 * q], acc[i][j][2 * q + 1], lane, lo, hi2);
          const int row = row0 + wm * 64 + i * 32 + crow(2 * q, hi) + (lane & 1);
          const int col = col0 + wn * 64 + j * 32 + (r32 & ~1);
          *(unsigned*)(QP + (size_t)row * DM + col) = cvtpk(lo, hi2);
        }
  }
}


__device__ __forceinline__ void conv_unit(const Params& p, int l, int unit, unsigned char* lds) {
  int tid_ = threadIdx.x; asm volatile("" : "+v"(tid_)); const int tid = tid_, lane = tid & 63, wid = tid >> 6;
  float* U = (float*)lds;
  const bf16_t* PROJ = (const bf16_t*)(p.ws + WS_PROJ);
  bf16_t* MIX = (bf16_t*)(p.ws + WS_MIX);
  const int row0 = unit * 32, b = row0 / SEGL, s0 = row0 - b * SEGL;
  const int seglo = s0 < CTXL ? 0 : CTXL, seghi = s0 < CTXL ? CTXL : SEGL;
  for (int rr = tid >> 5; rr < 62; rr += 16) {
    const int s = s0 - 15 + rr, c8 = (tid & 31) * 8;
    f32x4 u0 = {0.f, 0.f, 0.f, 0.f}, u1 = {0.f, 0.f, 0.f, 0.f};
    if (s >= seglo && s < seghi) {
      const bf16_t* pr = PROJ + (size_t)(b * SEGL + s) * PW + c8;
      const u32x4 a1 = *(const u32x4*)pr, a2 = *(const u32x4*)(pr + 256);
      u0.x = bflo(a1.x) * sigmoidf_(bflo(a2.x)); u0.y = bfhi(a1.x) * sigmoidf_(bfhi(a2.x));
      u0.z = bflo(a1.y) * sigmoidf_(bflo(a2.y)); u0.w = bfhi(a1.y) * sigmoidf_(bfhi(a2.y));
      u1.x = bflo(a1.z) * sigmoidf_(bflo(a2.z)); u1.y = bfhi(a1.z) * sigmoidf_(bfhi(a2.z));
      u1.z = bflo(a1.w) * sigmoidf_(bflo(a2.w)); u1.w = bfhi(a1.w) * sigmoidf_(bfhi(a2.w));
    }
    *(f32x4*)(U + rr * 256 + c8) = u0; *(f32x4*)(U + rr * 256 + c8 + 4) = u1;
  }
  __syncthreads();
  float* Y = U + 62 * 256;
  const float* cw = p.in[I_CONVW] + (size_t)l * 31 * 256;
#pragma unroll 1
  for (int q = 0; q < 4; ++q) {
    const int c = lane + 64 * q;
    float w[31];
#pragma unroll
    for (int j = 0; j < 31; ++j) w[j] = cw[j * 256 + c];
    const float bias = p.in[I_CONVB][l * 256 + c];
#pragma unroll
    for (int tt = 0; tt < 4; ++tt) {
      const int t = wid * 4 + tt;
      float a = bias;
#pragma unroll
      for (int j = 0; j < 31; ++j) a += U[(t + j) * 256 + c] * w[j];
      Y[t * 256 + c] = a;
    }
  }
  asm volatile("s_waitcnt lgkmcnt(0)" ::: "memory");
  float y[4][4];
#pragma unroll
  for (int tt = 0; tt < 4; ++tt)
#pragma unroll
    for (int q = 0; q < 4; ++q) y[tt][q] = Y[(wid * 4 + tt) * 256 + lane + 64 * q];
#pragma unroll
  for (int tt = 0; tt < 4; ++tt) {
    const int t = wid * 4 + tt;
    const float mean = wave_sum((y[tt][0] + y[tt][1]) + (y[tt][2] + y[tt][3])) * (1.f / 256.f);
    float v = 0.f;
#pragma unroll
    for (int q = 0; q < 4; ++q) { const float d = y[tt][q] - mean; v += d * d; }
    const float rs = rsqrtf(wave_sum(v) * (1.f / 256.f) + EPS);
#pragma unroll
    for (int q = 0; q < 4; ++q) {
      const int c = lane + 64 * q;
      const float z = (y[tt][q] - mean) * rs * p.in[I_CLNG][l * 256 + c] + p.in[I_CLNB][l * 256 + c];
      const float o = (ABL & 1) ? 0.f : z * sigmoidf_(z);
      MIX[(size_t)(row0 + t) * DM + c] = (bf16_t)(cvtpk(o, 0.f) & 0xffffu);
    }
  }
  __syncthreads();
}

__device__ __forceinline__ int ml_cidx(int ch, int dir) { return dir == 0 ? ch : (ch < 4 ? 3 - ch : 135 - ch); }
__device__ __forceinline__ void ml_load_tile(const bf16_t* src, float* dst, int tid) {
  const int r = tid >> 3, c8 = (tid & 7) * 8;
  const u32x4 a = *(const u32x4*)(src + (size_t)r * PW + c8);
  float* d = dst + r * 65 + c8;
  d[0] = bflo(a.x); d[1] = bfhi(a.x); d[2] = bflo(a.y); d[3] = bfhi(a.y); d[4] = bflo(a.z); d[5] = bfhi(a.z); d[6] = bflo(a.w); d[7] = bfhi(a.w);
}
__device__ __forceinline__ void ml_local_unit(const Params& p, int l, int unit, unsigned char* lds) {
  int tid_ = threadIdx.x; asm volatile("" : "+v"(tid_)); const int tid = tid_, lane = tid & 63, wid = tid >> 6, r32 = lane & 31, hi = lane >> 5;
  float* Kt = (float*)lds; float* Vt = Kt + 64 * 65; float* WK = Vt + 64 * 65;
  const bf16_t* PROJ = (const bf16_t*)(p.ws + WS_PROJ);
  const float* GT = (const float*)(p.ws + WS_GATES);
  float* UL = (float*)(p.ws + WS_ULOC); float* META = (float*)(p.ws + WS_MLMETA);
  const int b = unit / (4 * NCH), hh = (unit / NCH) & 3, ch = unit % NCH;
  const int row0 = b * SEGL + ch * 64;
  ml_load_tile(PROJ + (size_t)row0 * PW + C_MK + hh * 64, Kt, tid);
  ml_load_tile(PROJ + (size_t)row0 * PW + C_MV + hh * 64, Vt, tid);
  if (wid < 2) {
    const int dir = wid;
    const float ig = GT[(size_t)(row0 + lane) * 16 + (2 * dir) * 4 + hh];
    const float lf = logsigmoidf_(GT[(size_t)(row0 + lane) * 16 + (2 * dir + 1) * 4 + hh]);
    float ps = lf;
#pragma unroll
    for (int o = 1; o < 64; o <<= 1) { const float t = __shfl_up(ps, o); if (lane >= o) ps += t; }
    const float tot = __shfl(ps, 63);
    const float wlog = dir == 0 ? (tot - ps + ig) : (ps - lf + ig);
    const float mloc = wave_max(wlog);
    WK[dir * 64 + lane] = __expf(wlog - mloc);
    if (lane == 0) {
      const int seq = (b * 4 + hh) * 2 + dir, ci = ml_cidx(ch, dir);
      META[((size_t)seq * NCH + ci) * 4 + 0] = tot; META[((size_t)seq * NCH + ci) * 4 + 1] = mloc;
    }
  }
  __syncthreads();
  {
    const int dir = wid >> 2, et = (wid >> 1) & 1, dt = wid & 1;
    const int seq = (b * 4 + hh) * 2 + dir, ci = ml_cidx(ch, dir);
    float* slot = UL + ((size_t)seq * NCH + ci) * USTRIDE;
    f32x16 acc = {};
#pragma unroll 8
    for (int ks = 0; ks < 32; ++ks) {
      const int s = 2 * ks + hi;
      const float a = WK[dir * 64 + s] * Vt[s * 65 + et * 32 + r32];
      const float bb = Kt[s * 65 + dt * 32 + r32];
      acc = __builtin_amdgcn_mfma_f32_32x32x2f32(a, bb, acc, 0, 0, 0);
    }
#pragma unroll
    for (int r = 0; r < 16; ++r) slot[(et * 32 + crow(r, hi)) * 64 + dt * 32 + r32] = acc[r];
    if (et == 0) {
      float n = 0.f;
#pragma unroll 8
      for (int i = 0; i < 32; ++i) { const int s = hi * 32 + i; n += WK[dir * 64 + s] * Kt[s * 65 + dt * 32 + r32]; }
      n += __shfl_xor(n, 32);
      if (hi == 0) slot[4096 + dt * 32 + r32] = n;
    }
  }
  __syncthreads();
}
__device__ __forceinline__ void ml_scan(const Params& p, unsigned char* lds) {
  float* UL = (float*)(p.ws + WS_ULOC); float* META = (float*)(p.ws + WS_MLMETA);
  int tid_ = threadIdx.x; asm volatile("" : "+v"(tid_));
  const int tid = tid_, lane = tid & 63, wid = tid >> 6;
  float* DEC = (float*)lds;
  float* SCL = DEC + 2 * NCH;
  float* TMP = SCL + 2 * NCH;
  for (int base0 = blockIdx.x * 512; base0 < 32 * USTRIDE; base0 += gridDim.x * 512) {
    const int seq0 = base0 / USTRIDE;
    if (wid < 2) {
      const int seq = seq0 + wid;
      if (seq < 32) {
        float* mt = META + (size_t)seq * NCH * 4;
        for (int c = lane; c < NCH; c += 64) { TMP[(wid * 2 + 0) * NCH + c] = mt[c * 4 + 0]; TMP[(wid * 2 + 1) * NCH + c] = mt[c * 4 + 1]; }
        asm volatile("s_waitcnt lgkmcnt(0)" ::: "memory");
        if (lane == 0) {
          float m = 0.f;
          for (int c = 0; c < NCH; ++c) {
            const float bl = TMP[(wid * 2 + 0) * NCH + c], mloc = TMP[(wid * 2 + 1) * NCH + c];
            const float mn = fmaxf(bl + m, mloc);
            DEC[wid * NCH + c] = __expf(bl + m - mn); SCL[wid * NCH + c] = __expf(mloc - mn);
            mt[c * 4 + 2] = m;
            m = mn;
          }
        }
      }
    }
    __syncthreads();
    const int idx = base0 + tid;
    if (idx < 32 * USTRIDE) {
      const int seq = idx / USTRIDE, e = idx - seq * USTRIDE, sl = seq - seq0;
      float* bp = UL + (size_t)seq * NCH * USTRIDE + e;
      const float* dec = DEC + sl * NCH; const float* scl = SCL + sl * NCH;
      float C = 0.f;
#pragma unroll 1
      for (int c0 = 0; c0 < NCH; c0 += 12) {
        float u[12];
#pragma unroll
        for (int j = 0; j < 12; ++j) u[j] = bp[(size_t)(c0 + j) * USTRIDE];
#pragma unroll
        for (int j = 0; j < 12; ++j) { bp[(size_t)(c0 + j) * USTRIDE] = C; C = dec[c0 + j] * C + scl[c0 + j] * u[j]; }
      }
    }
    __syncthreads();
  }
}
__device__ __forceinline__ void ml_out_unit(const Params& p, int l, int unit, unsigned char* lds) {
  int tid_ = threadIdx.x; asm volatile("" : "+v"(tid_)); const int tid = tid_, lane = tid & 63, wid = tid >> 6, r32 = lane & 31, hi = lane >> 5;
  float* Qt = (float*)lds; float* Kt = Qt + 64 * 65; float* Vt = Kt + 64 * 65;
  float* Cs = Vt + 64 * 65;
  float* Ns = Cs + 2 * 64 * 65;
  float* Bq = Ns + 128;
  float* Gs = Bq + 128;
  float* Mi = Gs + 128;
  float* HB = Mi + 64;
  const bf16_t* PROJ = (const bf16_t*)(p.ws + WS_PROJ);
  const float* GT = (const float*)(p.ws + WS_GATES);
  const float* UL = (const float*)(p.ws + WS_ULOC); const float* META = (const float*)(p.ws + WS_MLMETA);
  bf16_t* MIX = (bf16_t*)(p.ws + WS_MIX);
  const int b = unit / (4 * NCH), hh = (unit / NCH) & 3, ch = unit % NCH;
  const int row0 = b * SEGL + ch * 64;
  ml_load_tile(PROJ + (size_t)row0 * PW + C_MQ + hh * 64, Qt, tid);
  ml_load_tile(PROJ + (size_t)row0 * PW + C_MK + hh * 64, Kt, tid);
  ml_load_tile(PROJ + (size_t)row0 * PW + C_MV + hh * 64, Vt, tid);
  for (int i = tid; i < 2 * USTRIDE; i += 512) {
    const int dir = i / USTRIDE, e = i - dir * USTRIDE;
    const int seq = (b * 4 + hh) * 2 + dir, ci = ml_cidx(ch, dir);
    const float v = UL[((size_t)seq * NCH + ci) * USTRIDE + e];
    if (e < 4096) Cs[dir * 64 * 65 + (e >> 6) * 65 + (e & 63)] = v; else Ns[dir * 64 + (e - 4096)] = v;
  }
  if (wid < 2) {
    const int dir = wid;
    const float ig = GT[(size_t)(row0 + lane) * 16 + (2 * dir) * 4 + hh];
    const float lf = logsigmoidf_(GT[(size_t)(row0 + lane) * 16 + (2 * dir + 1) * 4 + hh]);
    float ps = lf;
#pragma unroll
    for (int o = 1; o < 64; o <<= 1) { const float t = __shfl_up(ps, o); if (lane >= o) ps += t; }
    const float tot = __shfl(ps, 63);
    const float bc = dir == 0 ? ps : (tot - ps + lf);
    Bq[dir * 64 + lane] = bc; Gs[dir * 64 + lane] = ig - bc;
    if (lane == 0) { const int seq = (b * 4 + hh) * 2 + dir, ci = ml_cidx(ch, dir); Mi[dir] = META[((size_t)seq * NCH + ci) * 4 + 2]; }
  }
  __syncthreads();
  {
    const int dir = wid >> 2, tt = (wid >> 1) & 1, et = wid & 1;
    const int t = tt * 32 + r32;
    f32x16 sa[2] = {};
#pragma unroll 4
    for (int ks = 0; ks < 32; ++ks) {
      const float bq = Qt[t * 65 + 2 * ks + hi];
      const float a0 = Kt[(r32) * 65 + 2 * ks + hi], a1 = Kt[(32 + r32) * 65 + 2 * ks + hi];
      sa[0] = __builtin_amdgcn_mfma_f32_32x32x2f32(a0, bq, sa[0], 0, 0, 0);
      sa[1] = __builtin_amdgcn_mfma_f32_32x32x2f32(a1, bq, sa[1], 0, 0, 0);
    }
    const float bt = Bq[dir * 64 + t];
    const float inter = bt + Mi[dir];
    float mx = -INFINITY;
    f32x16 dl[2];
#pragma unroll
    for (int st = 0; st < 2; ++st)
#pragma unroll
      for (int r = 0; r < 16; ++r) {
        const int s = st * 32 + crow(r, hi);
        const bool ok = dir == 0 ? (s <= t) : (s >= t);
        const float d = ok ? bt + Gs[dir * 64 + s] : -INFINITY;
        dl[st][r] = d; mx = fmaxf(mx, d);
      }
    mx = fmaxf(mx, __shfl_xor(mx, 32));
    const float mt = fmaxf(inter, mx);
    const float iw = __expf(inter - mt);
    float rsum = 0.f;
#pragma unroll
    for (int st = 0; st < 2; ++st)
#pragma unroll
      for (int r = 0; r < 16; ++r) { const float w = __expf(dl[st][r] - mt); sa[st][r] *= w; rsum += sa[st][r]; }
    rsum += __shfl_xor(rsum, 32);
    float qn = 0.f;
#pragma unroll 8
    for (int i = 0; i < 32; ++i) { const int d = hi * 32 + i; qn += Ns[dir * 64 + d] * Qt[t * 65 + d]; }
    qn += __shfl_xor(qn, 32);
    const float den = rsum + iw * qn;
    const float rden = 1.f / fmaxf(fabsf(den), __expf(-mt));
    f32x16 an = {}, ac = {};
#pragma unroll
    for (int st = 0; st < 2; ++st)
#pragma unroll
      for (int r = 0; r < 16; ++r) {
        const float a = Vt[(st * 32 + crow(r, hi)) * 65 + et * 32 + r32];
        an = __builtin_amdgcn_mfma_f32_32x32x2f32(a, sa[st][r], an, 0, 0, 0);
      }
    const float* Cd = Cs + dir * 64 * 65;
#pragma unroll 4
    for (int ks = 0; ks < 32; ++ks) {
      const float a = Cd[(et * 32 + r32) * 65 + 2 * ks + hi];
      const float bq = Qt[t * 65 + 2 * ks + hi];
      ac = __builtin_amdgcn_mfma_f32_32x32x2f32(a, bq, ac, 0, 0, 0);
    }
#pragma unroll
    for (int r = 0; r < 16; ++r) HB[dir * 64 * 65 + t * 65 + et * 32 + crow(r, hi)] = (an[r] + iw * ac[r]) * rden;
  }
  __syncthreads();
  {
    const int t = tid >> 3, e8 = (tid & 7) * 8;
    float v[8]; float ss = 0.f;
#pragma unroll
    for (int i = 0; i < 8; ++i) { v[i] = HB[t * 65 + e8 + i] + HB[64 * 65 + t * 65 + e8 + i]; ss += v[i] * v[i]; }
    ss += __shfl_xor(ss, 1); ss += __shfl_xor(ss, 2); ss += __shfl_xor(ss, 4);
    const float rs = rsqrtf(ss * (1.f / 64.f) + EPS);
    const u32x4 ov = *(const u32x4*)(PROJ + (size_t)(row0 + t) * PW + C_MO + hh * 64 + e8);
    const float og[8] = {bflo(ov.x), bfhi(ov.x), bflo(ov.y), bfhi(ov.y), bflo(ov.z), bfhi(ov.z), bflo(ov.w), bfhi(ov.w)};
    const float* g = p.in[I_MNORMG] + l * 64 + e8;
    float o[8];
#pragma unroll
    for (int i = 0; i < 8; ++i) o[i] = (ABL & 2) ? 0.f : v[i] * rs * g[i] * sigmoidf_(og[i]);
    u32x4 w; w.x = cvtpk(o[0], o[1]); w.y = cvtpk(o[2], o[3]); w.z = cvtpk(o[4], o[5]); w.w = cvtpk(o[6], o[7]);
    *(u32x4*)(MIX + (size_t)(row0 + t) * DM + 256 + hh * 64 + e8) = w;
  }
  __syncthreads();
}


#define KSWZ(row, colB) ((row) * 256 + ((colB) ^ (((row) & 15) << 4)))
#define SBAR() __builtin_amdgcn_sched_barrier(0)
constexpr int ATT_SHM_V = 64 * 128 * 2, ATT_SHM_K = 64 * 128 * 2;
constexpr float ATT_THR = 11.541560327111707f;
__device__ __forceinline__ int v_st(int k, int c) { const int kk = (k & ~0xC) | ((k & 4) << 1) | ((k & 8) >> 1); return ((kk >> 3) * 4 + (c >> 5)) * 512 + ((kk & 7) * 32 + (c & 31)) * 2; }
__device__ __forceinline__ int v_rd_base(int lane) { return ((lane & 3) << 3) | (((lane >> 2) & 3) << 6) | (((lane >> 4) & 1) << 5) | (((lane >> 5) & 1) << 8); }
constexpr int v_rd_off(int d0, int ks, int half) { return d0 * 512 + ks * 4096 + half * 2048; }
template <int OFF> __device__ __forceinline__ s16x4 tr_read(int vb) {
  s16x4 r; asm volatile("ds_read_b64_tr_b16 %0, %1 offset:%2" : "=&v"(r) : "v"(vb), "i"(OFF) : "memory"); return r;
}
template <int D0> __device__ __forceinline__ void pv_one(f32x16& od, int vb, bf16x8 pa0, bf16x8 pa1, bf16x8 pa2, bf16x8 pa3) {
  const s16x4 l0 = tr_read<v_rd_off(D0, 0, 0)>(vb), h0 = tr_read<v_rd_off(D0, 0, 1)>(vb), l1 = tr_read<v_rd_off(D0, 1, 0)>(vb), h1 = tr_read<v_rd_off(D0, 1, 1)>(vb);
  const s16x4 l2 = tr_read<v_rd_off(D0, 2, 0)>(vb), h2 = tr_read<v_rd_off(D0, 2, 1)>(vb), l3 = tr_read<v_rd_off(D0, 3, 0)>(vb), h3 = tr_read<v_rd_off(D0, 3, 1)>(vb);
  asm volatile("s_waitcnt lgkmcnt(0)" ::: "memory"); SBAR();
#define PK(L, H) (bf16x8){L[0], L[1], L[2], L[3], H[0], H[1], H[2], H[3]}
  od = __builtin_amdgcn_mfma_f32_32x32x16_bf16(pa0, PK(l0, h0), od, 0, 0, 0);
  od = __builtin_amdgcn_mfma_f32_32x32x16_bf16(pa1, PK(l1, h1), od, 0, 0, 0);
  od = __builtin_amdgcn_mfma_f32_32x32x16_bf16(pa2, PK(l2, h2), od, 0, 0, 0);
  od = __builtin_amdgcn_mfma_f32_32x32x16_bf16(pa3, PK(l3, h3), od, 0, 0, 0);
#undef PK
}
__device__ __forceinline__ void att_qkt(f32x16& p0, f32x16& p1, const unsigned char* Ks, const unsigned char* Qs, int qrow, int comp, int r32, int hi) {
  p0 = f32x16{}; p1 = f32x16{};
#pragma unroll
  for (int d0 = 0; d0 < 4; ++d0) {
    const int cb = ((comp * 4 + d0) * 16 + hi * 8) * 2;
    const bf16x8 b0 = *(const bf16x8*)(Ks + KSWZ(r32, cb));
    const bf16x8 b1 = *(const bf16x8*)(Ks + KSWZ(32 + r32, cb));
    const bf16x8 q = *(const bf16x8*)(Qs + KSWZ(qrow, cb));
    p0 = __builtin_amdgcn_mfma_f32_32x32x16_bf16(b0, q, p0, 0, 0, 0);
    p1 = __builtin_amdgcn_mfma_f32_32x32x16_bf16(b1, q, p1, 0, 0, 0);
  }
}
__device__ __forceinline__ void att_softmax(f32x16& p0, f32x16& p1, float& m_reg, float& l_reg, float& alpha, bf16x8& pa0, bf16x8& pa1, bf16x8& pa2, bf16x8& pa3) {
  float pmax = p0[0];
#pragma unroll
  for (int r = 1; r < 16; ++r) pmax = fmaxf(pmax, p0[r]);
#pragma unroll
  for (int r = 0; r < 16; ++r) pmax = fmaxf(pmax, p1[r]);
  { auto rr = __builtin_amdgcn_permlane32_swap(__float_as_uint(pmax), __float_as_uint(pmax), false, false);
    pmax = fmaxf(__uint_as_float(rr[0]), __uint_as_float(rr[1])); }
  float mn;
  if (__builtin_expect(__all(pmax - m_reg <= ATT_THR), 1)) { mn = m_reg; alpha = 1.f; }
  else { mn = fmaxf(m_reg, pmax); alpha = __builtin_amdgcn_exp2f(m_reg - mn); m_reg = mn; }
#pragma unroll
  for (int r = 0; r < 16; ++r) { p0[r] = __builtin_amdgcn_exp2f(p0[r] - mn); p1[r] = __builtin_amdgcn_exp2f(p1[r] - mn); }
  float ps = 0.f;
#pragma unroll
  for (int r = 0; r < 16; ++r) ps += p0[r];
#pragma unroll
  for (int r = 0; r < 16; ++r) ps += p1[r];
  { auto rr = __builtin_amdgcn_permlane32_swap(__float_as_uint(ps), __float_as_uint(ps), false, false);
    ps = __uint_as_float(rr[0]) + __uint_as_float(rr[1]); }
  l_reg = l_reg * alpha + ps;
#define PK4(P, BASE, OUT) do { unsigned a0 = cvtpk(P[BASE + 0], P[BASE + 1]), a1 = cvtpk(P[BASE + 2], P[BASE + 3]);   \
    unsigned b0 = cvtpk(P[BASE + 4], P[BASE + 5]), b1 = cvtpk(P[BASE + 6], P[BASE + 7]);                              \
    auto r0 = __builtin_amdgcn_permlane32_swap(a0, b0, false, false); auto r1 = __builtin_amdgcn_permlane32_swap(a1, b1, false, false); \
    u32x4 w = {r0[0], r1[0], r0[1], r1[1]}; OUT = *reinterpret_cast<bf16x8*>(&w); } while (0)
  PK4(p0, 0, pa0); PK4(p0, 8, pa1); PK4(p1, 0, pa2); PK4(p1, 8, pa3);
#undef PK4
}
__device__ __forceinline__ void att_unit(const bf16_t* __restrict__ Qb, const bf16_t* __restrict__ Kh, const bf16_t* __restrict__ Vh, bf16_t* __restrict__ Ob,
                                         int nkeys, float lam, const float* __restrict__ ng, float oscale, unsigned char* lds) {
  int tid_ = threadIdx.x; asm volatile("" : "+v"(tid_)); const int tid = tid_, wid = tid >> 6, lane = tid & 63, r32 = lane & 31, hi = lane >> 5;
  unsigned char* V_lds = lds; unsigned char* K_lds = lds + 2 * ATT_SHM_V;
  float* wsl = (float*)(lds + 2 * ATT_SHM_V + 2 * ATT_SHM_K) + wid * 64; float* li_l = wsl; float* al_l = wsl + 32;
  float m0 = -1e30f, l0 = 0.f, m1 = -1e30f, l1 = 0.f;
  f32x16 o0[4] = {}, o1[4] = {};
  unsigned char* Q_lds = lds + 2 * ATT_SHM_V + 2 * ATT_SHM_K + 2048;
#pragma unroll
  for (int i = 0; i < 8; ++i) { const int id = tid + 512 * i, qrw = id >> 4, ch = id & 15;
    *(bf16x8*)(Q_lds + KSWZ(qrw, ch * 16)) = *(const bf16x8*)(Qb + (size_t)qrw * PW + ch * 8); }
  const int qrow = wid * 32 + r32;
  const int sr = tid >> 4, sc = (tid & 15) * 8, vst0 = v_st(sr, sc), vst1 = v_st(32 + sr, sc);
  const int vb0 = (int)(uintptr_t)V_lds + v_rd_base(lane);
  bf16x8 vs0, vs1, ks0, ks1;
#define SLOAD(k0) do { vs0 = *(const bf16x8*)(Vh + (size_t)((k0) + sr) * PW + sc); vs1 = *(const bf16x8*)(Vh + (size_t)((k0) + 32 + sr) * PW + sc); \
    ks0 = *(const bf16x8*)(Kh + (size_t)((k0) + sr) * PW + sc); ks1 = *(const bf16x8*)(Kh + (size_t)((k0) + 32 + sr) * PW + sc); } while (0)
#define SWRITE(b) do { *(bf16x8*)(V_lds + (b) * ATT_SHM_V + vst0) = vs0; *(bf16x8*)(V_lds + (b) * ATT_SHM_V + vst1) = vs1; const int kc = sc * 2; \
    *(bf16x8*)(K_lds + (b) * ATT_SHM_K + KSWZ(sr, kc)) = ks0; *(bf16x8*)(K_lds + (b) * ATT_SHM_K + KSWZ(32 + sr, kc)) = ks1; } while (0)
#define RESC(o, a) do { if (__any((a) < 1.f)) { if (hi == 0) al_l[r32] = (a); asm volatile("s_waitcnt lgkmcnt(0)" ::: "memory"); \
    _Pragma("unroll") for (int d = 0; d < 4; ++d) _Pragma("unroll") for (int r = 0; r < 16; ++r) o[d][r] *= al_l[crow(r, hi)]; } } while (0)
  const int NT = nkeys / 64;
  SLOAD(0); SWRITE(0); __syncthreads();
  for (int j = 0; j < NT; ++j) {
    const int cur = j & 1;
    if (j + 1 < NT) SLOAD((j + 1) * 64);
    const unsigned char* Kc = K_lds + cur * ATT_SHM_K; const int vb = vb0 + cur * ATT_SHM_V;
    f32x16 p0, p1; float alpha; bf16x8 pa0, pa1, pa2, pa3;
    att_qkt(p0, p1, Kc, Q_lds, qrow, 0, r32, hi);
    att_softmax(p0, p1, m0, l0, alpha, pa0, pa1, pa2, pa3);
    RESC(o0, alpha);
    pv_one<0>(o0[0], vb, pa0, pa1, pa2, pa3); pv_one<1>(o0[1], vb, pa0, pa1, pa2, pa3); pv_one<2>(o0[2], vb, pa0, pa1, pa2, pa3); pv_one<3>(o0[3], vb, pa0, pa1, pa2, pa3);
    att_qkt(p0, p1, Kc, Q_lds, qrow, 1, r32, hi);
    att_softmax(p0, p1, m1, l1, alpha, pa0, pa1, pa2, pa3);
    RESC(o1, alpha);
    pv_one<0>(o1[0], vb, pa0, pa1, pa2, pa3); pv_one<1>(o1[1], vb, pa0, pa1, pa2, pa3); pv_one<2>(o1[2], vb, pa0, pa1, pa2, pa3); pv_one<3>(o1[3], vb, pa0, pa1, pa2, pa3);
    if (j + 1 < NT) SWRITE(cur ^ 1);
    __syncthreads();
  }
  if (hi == 0) { li_l[r32] = 1.f / l0; al_l[r32] = lam / l1; }
  asm volatile("s_waitcnt lgkmcnt(0)" ::: "memory");
  float ss[16];
#pragma unroll
  for (int r = 0; r < 16; ++r) {
    const float a = li_l[crow(r, hi)], bq = al_l[crow(r, hi)];
    float s = 0.f;
#pragma unroll
    for (int d = 0; d < 4; ++d) { const float v = o0[d][r] * a - o1[d][r] * bq; o0[d][r] = v; s += v * v; }
    s += __shfl_xor(s, 1); s += __shfl_xor(s, 2); s += __shfl_xor(s, 4); s += __shfl_xor(s, 8); s += __shfl_xor(s, 16);
    ss[r] = rsqrtf(s * (1.f / 128.f) + EPS) * oscale;
  }
  bf16_t* Ow = Ob + (size_t)(wid * 32) * DM;
#pragma unroll
  for (int d = 0; d < 4; ++d) {
    const float g = ng[d * 32 + r32];
#pragma unroll
    for (int r = 0; r < 16; ++r) Ow[(size_t)crow(r, hi) * DM + d * 32 + r32] = (ABL & 4) ? (bf16_t)0 : (bf16_t)(cvtpk(o0[d][r] * ss[r] * g, 0.f) & 0xffffu);
  }
  __syncthreads();
#undef SLOAD
#undef SWRITE
#undef RESC
}

__device__ __forceinline__ float ins16(float (&a)[16], float x) {
#pragma unroll
  for (int i = 0; i < 16; ++i) { const float h = fmaxf(a[i], x); x = fminf(a[i], x); a[i] = h; }
  return x;
}
__device__ __forceinline__ float gelu_erf(float x) { return 0.5f * x * (1.f + erff(x * 0.70710678118654752440f)); }
__device__ __forceinline__ void peer_unit(const Params& p, int l, int unit, unsigned char* lds) {
  int tid_ = threadIdx.x; asm volatile("" : "+v"(tid_)); const int tid = tid_, lane = tid & 63, wid = tid >> 6, r32 = lane & 31, hi = lane >> 5;
  int* EID = (int*)lds;
  float* GW = (float*)(lds + 16384);
  float* SUQ = (float*)(lds + 32768);
  unsigned char* IDX = lds + 49152;
  const float* PSC = (const float*)(p.ws + WS_PSC);
  const int row0 = unit * 32;
  const bf16_t* QP = (const bf16_t*)(p.ws + WS_PROJ);
  const bf16_t* KEYS = (const bf16_t*)(p.ws + WS_KEYS) + (size_t)l * 131072;
  for (int rrep = 0; rrep < REP_ROUTE; ++rrep) {
    const int h = wid;
    float top[2][16];
#pragma unroll
    for (int pp = 0; pp < 2; ++pp) {
      const bf16_t* qrow = QP + (size_t)(row0 + r32) * DM + h * 128 + pp * 64 + hi * 8;
      const bf16_t* kb = KEYS + ((size_t)(h * 2 + pp) * 128 + r32) * 64 + hi * 8;
      bf16x8 bq[4];
#pragma unroll
      for (int ks = 0; ks < 4; ++ks) bq[ks] = *(const bf16x8*)(qrow + ks * 16);
      float (&lst)[16] = top[pp];
#pragma unroll
      for (int i = 0; i < 16; ++i) lst[i] = -INFINITY;
#pragma unroll
      for (int nt = 0; nt < 4; ++nt) {
        f32x16 acc = {};
#pragma unroll
        for (int ks = 0; ks < 4; ++ks) {
          const bf16x8 ak = *(const bf16x8*)(kb + (size_t)nt * 32 * 64 + ks * 16);
          acc = __builtin_amdgcn_mfma_f32_32x32x16_bf16(ak, bq[ks], acc, 0, 0, 0);
        }
#pragma unroll
        for (int r = 0; r < 16; ++r) {
          const unsigned key = (__float_as_uint(acc[r]) & ~0x7Fu) | (unsigned)(nt * 32 + crow(r, hi));
          ins16(lst, __uint_as_float(key));
        }
        SBAR();
      }
      float oth[16];
#pragma unroll
      for (int i = 0; i < 16; ++i) oth[i] = __shfl_xor(lst[i], 32);
#pragma unroll
      for (int i = 0; i < 16; ++i) ins16(lst, oth[i]);
      if (hi == 0) {
        unsigned w[4];
#pragma unroll
        for (int i = 0; i < 4; ++i)
          w[i] = (__float_as_uint(lst[4 * i]) & 0x7Fu) | ((__float_as_uint(lst[4 * i + 1]) & 0x7Fu) << 8) | ((__float_as_uint(lst[4 * i + 2]) & 0x7Fu) << 16) | ((__float_as_uint(lst[4 * i + 3]) & 0x7Fu) << 24);
        *(u32x4*)(IDX + ((r32 * 8 + h) * 2 + pp) * 16) = (u32x4){w[0], w[1], w[2], w[3]};
      }
    }
    float best[16];
#pragma unroll
    for (int i = 0; i < 16; ++i) best[i] = -INFINITY;
#pragma unroll
    for (int i = 0; i < 16; ++i)
#pragma unroll
      for (int j = 0; j < 16; ++j)
        if ((i + 1) * (j + 1) <= 16) {
          const float s = __uint_as_float(__float_as_uint(top[0][i]) & ~0x7Fu) + __uint_as_float(__float_as_uint(top[1][j]) & ~0x7Fu);
          ins16(best, __uint_as_float((__float_as_uint(s) & ~0xFFu) | (unsigned)(i * 16 + j)));
        }
    asm volatile("s_waitcnt lgkmcnt(0)" ::: "memory");
    if (hi == 0) {
      const unsigned char* ib = IDX + ((r32 * 8 + h) * 2) * 16;
      const float mx = __uint_as_float(__float_as_uint(best[0]) & ~0xFFu);
      float w[16]; float sum = 0.f;
#pragma unroll
      for (int k = 0; k < 16; ++k) { w[k] = __expf(__uint_as_float(__float_as_uint(best[k]) & ~0xFFu) - mx); sum += w[k]; }
      const float rsum = 1.f / sum;
#pragma unroll
      for (int k = 0; k < 16; ++k) {
        const unsigned ij = __float_as_uint(best[k]) & 0xFFu;
        const int e = (int)ib[ij >> 4] * 128 + (int)ib[16 + (ij & 15)];
        EID[r32 * 128 + h * 16 + k] = e; GW[r32 * 128 + h * 16 + k] = w[k] * rsum * PSC[(size_t)(DEPTH + l) * NEXP + e];
        SUQ[r32 * 128 + h * 16 + k] = PSC[(size_t)l * NEXP + e];
      }
    }
  }
  __syncthreads();
  const bf16_t* H = (const bf16_t*)(p.ws + WS_H);
  const unsigned char* PUq = p.ws + WS_PU + (size_t)l * NEXP * DM;
  const unsigned char* PVq = p.ws + WS_PV + (size_t)l * NEXP * DM;
  float* XC = (float*)(p.ws + WS_XCUR);
  const float* MOD = (const float*)(p.ws + WS_MOD);
  for (int tt = 0; tt < 4; ++tt) {
    const int t = wid * 4 + tt, row = row0 + t;
    float hf[16];
    {
      const u32x4 hA = *(const u32x4*)(H + (size_t)row * DM + lane * 16), hB = *(const u32x4*)(H + (size_t)row * DM + lane * 16 + 8);
      hf[0] = bflo(hA.x); hf[1] = bfhi(hA.x); hf[2] = bflo(hA.y); hf[3] = bfhi(hA.y); hf[4] = bflo(hA.z); hf[5] = bfhi(hA.z); hf[6] = bflo(hA.w); hf[7] = bfhi(hA.w);
      hf[8] = bflo(hB.x); hf[9] = bfhi(hB.x); hf[10] = bflo(hB.y); hf[11] = bfhi(hB.y); hf[12] = bflo(hB.z); hf[13] = bfhi(hB.z); hf[14] = bflo(hB.w); hf[15] = bfhi(hB.w);
    }
    float acc[16];
    for (int rep = 0; rep < REP_PEER; ++rep) {
#pragma unroll
    for (int i = 0; i < 16; ++i) acc[i] = 0.f;
    u32x4 uq[8];
#pragma unroll
    for (int i = 0; i < 8; ++i) { const int e0 = __builtin_amdgcn_readfirstlane(EID[t * 128 + i]); uq[i] = *(const u32x4*)(PUq + (size_t)e0 * DM + lane * 16); }
    for (int g8 = 0; g8 < 16; ++g8) {
      int eid[8]; float gwt[8]; u32x4 vq[8];
#pragma unroll
      for (int i = 0; i < 8; ++i) {
        eid[i] = __builtin_amdgcn_readfirstlane(EID[t * 128 + g8 * 8 + i]);
        gwt[i] = __uint_as_float(__builtin_amdgcn_readfirstlane(__float_as_uint(GW[t * 128 + g8 * 8 + i])));
        vq[i] = *(const u32x4*)(PVq + (size_t)eid[i] * DM + lane * 16);
      }
      float d[8];
#pragma unroll
      for (int i = 0; i < 8; ++i) {
        const float su = __uint_as_float(__builtin_amdgcn_readfirstlane(__float_as_uint(SUQ[t * 128 + g8 * 8 + i])));
        float a0 = 0.f, a1 = 0.f;
#define DQ(W, K) { const f32x2 lo_ = __builtin_amdgcn_cvt_pk_f32_fp8((int)(W), false), hi_ = __builtin_amdgcn_cvt_pk_f32_fp8((int)(W), true); \
          a0 += lo_.x * hf[K]; a1 += lo_.y * hf[K + 1]; a0 += hi_.x * hf[K + 2]; a1 += hi_.y * hf[K + 3]; }
        DQ(uq[i].x, 0) DQ(uq[i].y, 4) DQ(uq[i].z, 8) DQ(uq[i].w, 12)
#undef DQ
        d[i] = (a0 + a1) * su;
      }
      if (g8 < 15) {
#pragma unroll
        for (int i = 0; i < 8; ++i) { const int e0 = __builtin_amdgcn_readfirstlane(EID[t * 128 + (g8 + 1) * 8 + i]); uq[i] = *(const u32x4*)(PUq + (size_t)e0 * DM + lane * 16); }
      }
      float tot;
      {
        auto s01 = __builtin_amdgcn_permlane32_swap(__float_as_uint(d[0]), __float_as_uint(d[1]), false, false);
        auto s23 = __builtin_amdgcn_permlane32_swap(__float_as_uint(d[2]), __float_as_uint(d[3]), false, false);
        auto s45 = __builtin_amdgcn_permlane32_swap(__float_as_uint(d[4]), __float_as_uint(d[5]), false, false);
        auto s67 = __builtin_amdgcn_permlane32_swap(__float_as_uint(d[6]), __float_as_uint(d[7]), false, false);
        const float q01 = __uint_as_float(s01[0]) + __uint_as_float(s01[1]), q23 = __uint_as_float(s23[0]) + __uint_as_float(s23[1]);
        const float q45 = __uint_as_float(s45[0]) + __uint_as_float(s45[1]), q67 = __uint_as_float(s67[0]) + __uint_as_float(s67[1]);
        auto ta = __builtin_amdgcn_permlane16_swap(__float_as_uint(q01), __float_as_uint(q23), false, false);
        auto tb = __builtin_amdgcn_permlane16_swap(__float_as_uint(q45), __float_as_uint(q67), false, false);
        const float r0123 = __uint_as_float(ta[0]) + __uint_as_float(ta[1]);
        const float r4567 = __uint_as_float(tb[0]) + __uint_as_float(tb[1]);
        const bool b3 = (lane & 8) != 0;
        const float keep = b3 ? r4567 : r0123, send = b3 ? r0123 : r4567;
        float x = keep + __shfl_xor(send, 8);
        x += __shfl_xor(x, 4); x += __shfl_xor(x, 2); x += __shfl_xor(x, 1);
        tot = x;
      }
      float ge;
      {
        const float v = tot, av = fabsf(v), tq = __builtin_amdgcn_rcpf(av * 0.2316418882f + 1.0f);
        float q = tq * 0.5307027145f + (-0.7265760135f); q = q * tq + 0.7107068705f; q = q * tq + (-0.142248368f); q = q * tq + 0.127414796f; q = q * tq;
        const float ex = __builtin_amdgcn_exp2f(v * v * (-0.72134752044f));
        const float m = v * (q * ex), r = v - m;
        ge = v < 0.f ? m : r;
      }
      float c[8];
      c[0] = __uint_as_float(__builtin_amdgcn_readlane(__float_as_uint(ge), 0)) * gwt[0];  c[4] = __uint_as_float(__builtin_amdgcn_readlane(__float_as_uint(ge), 8)) * gwt[4];
      c[2] = __uint_as_float(__builtin_amdgcn_readlane(__float_as_uint(ge), 16)) * gwt[2]; c[6] = __uint_as_float(__builtin_amdgcn_readlane(__float_as_uint(ge), 24)) * gwt[6];
      c[1] = __uint_as_float(__builtin_amdgcn_readlane(__float_as_uint(ge), 32)) * gwt[1]; c[5] = __uint_as_float(__builtin_amdgcn_readlane(__float_as_uint(ge), 40)) * gwt[5];
      c[3] = __uint_as_float(__builtin_amdgcn_readlane(__float_as_uint(ge), 48)) * gwt[3]; c[7] = __uint_as_float(__builtin_amdgcn_readlane(__float_as_uint(ge), 56)) * gwt[7];
#pragma unroll
      for (int i = 0; i < 8; ++i) {
#define AQ(W, K) { const f32x2 lo_ = __builtin_amdgcn_cvt_pk_f32_fp8((int)(W), false), hi_ = __builtin_amdgcn_cvt_pk_f32_fp8((int)(W), true); \
          acc[K] += c[i] * lo_.x; acc[K + 1] += c[i] * lo_.y; acc[K + 2] += c[i] * hi_.x; acc[K + 3] += c[i] * hi_.y; }
        AQ(vq[i].x, 0) AQ(vq[i].y, 4) AQ(vq[i].z, 8) AQ(vq[i].w, 12)
#undef AQ
      }
    }
    }
    const int mr = mod_row(row);
    const float* g2 = MOD + ((size_t)l * 5 + mr) * 6144 + 5 * 1024;
    float* xr = XC + (size_t)row * DM;
    float xn[16]; float ssq = 0.f;
    if (ABL & 8) {
#pragma unroll
      for (int i = 0; i < 16; ++i) acc[i] = 0.f;
    }
#pragma unroll
    for (int v4 = 0; v4 < 4; ++v4) {
      const int c = lane * 16 + v4 * 4;
      const f32x4 xo = *(const f32x4*)(xr + c), gg = *(const f32x4*)(g2 + c);
      f32x4 o;
      o.x = xo.x + gg.x * acc[v4 * 4 + 0]; o.y = xo.y + gg.y * acc[v4 * 4 + 1]; o.z = xo.z + gg.z * acc[v4 * 4 + 2]; o.w = xo.w + gg.w * acc[v4 * 4 + 3];
      xn[v4 * 4 + 0] = o.x; xn[v4 * 4 + 1] = o.y; xn[v4 * 4 + 2] = o.z; xn[v4 * 4 + 3] = o.w;
      ssq += (o.x * o.x + o.y * o.y) + (o.z * o.z + o.w * o.w);
      if (l < DEPTH - 1) *(f32x4*)(xr + c) = o;
    }
    const float rs = rsqrtf(wave_sum(ssq) * (1.f / DM) + EPS);
    if (l == DEPTH - 1) {
      const int b = row / SEGL, s = row - b * SEGL;
      float* orow = p.out + ((size_t)(b * SEQ + (s - CTXL))) * DM;
      const float* fg = p.in[I_FINALG];
#pragma unroll
      for (int v4 = 0; v4 < 4; ++v4) {
        const int c = lane * 16 + v4 * 4;
        const f32x4 gg = *(const f32x4*)(fg + c);
        f32x4 o; o.x = xn[v4 * 4 + 0] * rs * gg.x; o.y = xn[v4 * 4 + 1] * rs * gg.y; o.z = xn[v4 * 4 + 2] * rs * gg.z; o.w = xn[v4 * 4 + 3] * rs * gg.w;
        *(f32x4*)(orow + c) = o;
      }
    } else {
      const float* m = MOD + ((size_t)(l + 1) * 5 + mr) * 6144;
      const float* ng = p.in[I_N1G] + (l + 1) * DM;
      bf16_t* hrow = (bf16_t*)(p.ws + WS_H) + (size_t)row * DM;
#pragma unroll
      for (int hh = 0; hh < 2; ++hh) {
        float y[8];
#pragma unroll
        for (int i = 0; i < 8; ++i) { const int c = lane * 16 + hh * 8 + i; y[i] = xn[hh * 8 + i] * rs * ng[c] * (1.f + m[1024 + c]) + m[c]; }
        u32x4 w; w.x = cvtpk(y[0], y[1]); w.y = cvtpk(y[2], y[3]); w.z = cvtpk(y[4], y[5]); w.w = cvtpk(y[6], y[7]);
        *(u32x4*)(hrow + lane * 16 + hh * 8) = w;
      }
    }
  }
  __syncthreads();
}

#define LAS __attribute__((address_space(3)))
#define XB_TMO      128
#define XB_XCNT(j)  (256  + 64 * (j))
#define XB_XSUB(j)  (1280 + 64 * (j))
#define XB_XGEN(j)  (2304 + 64 * (j))
#define XB_TOP      3328
#define XB_TOPGEN   3392
#define XCD_BAR_WORDS 3456
#define XB_SPIN_CAP (1u << 22)
__device__ __forceinline__ unsigned xb_ld(unsigned* p)              { return __hip_atomic_load(p, __ATOMIC_RELAXED, __HIP_MEMORY_SCOPE_AGENT); }
__device__ __forceinline__ unsigned xb_add(unsigned* p, unsigned v) { return __hip_atomic_fetch_add(p, v, __ATOMIC_RELAXED, __HIP_MEMORY_SCOPE_AGENT); }
__device__ __forceinline__ unsigned xb_xcc_id() { return (unsigned)__builtin_amdgcn_s_getreg((3 << 11) | 20) & 0xFu; }
#define XB_SPIN(cond, bar) do { unsigned _sp = 0; while (cond) { __builtin_amdgcn_s_sleep(1); \
    if ((++_sp & 255u) == 0u) { if (xb_ld(&(bar)[XB_TMO])) break; if (_sp > XB_SPIN_CAP) { atomicAdd(&(bar)[XB_TMO], 1u); break; } } } } while (0)
struct XcdBarrier { unsigned* bar; unsigned x; volatile LAS unsigned* st; };
__device__ __forceinline__ XcdBarrier xcd_barrier_post(unsigned* bar, volatile LAS unsigned* st) {
  XcdBarrier b; b.bar = bar; b.x = xb_xcc_id(); b.st = st;
  if (threadIdx.x == 0) (void)xb_add(&bar[XB_XCNT(b.x)], 1u);
  return b;
}
__device__ __forceinline__ void xcd_barrier_complete(unsigned* bar, unsigned x, unsigned& nloc, unsigned& nx) {
  const unsigned G = gridDim.x * gridDim.y * gridDim.z;
  unsigned sum, cnt, mine, sp = 0u;
  for (;;) {
    sum = 0u; cnt = 0u; mine = 0u;
#pragma unroll
    for (unsigned j = 0; j < 16; ++j) { const unsigned c = xb_ld(&bar[XB_XCNT(j)]); sum += c; cnt += (c > 0u) ? 1u : 0u; mine = (j == x) ? c : mine; }
    if (sum == G) break;
    __builtin_amdgcn_s_sleep(1);
    if ((++sp & 255u) == 0u) { if (xb_ld(&bar[XB_TMO])) break; if (sp > XB_SPIN_CAP) { atomicAdd(&bar[XB_TMO], 1u); break; } }
  }
  nloc = mine > 0u ? mine : 1u; nx = cnt > 0u ? cnt : 1u;
}
__device__ __forceinline__ void xcd_barrier(const XcdBarrier& b) {
  asm volatile("s_waitcnt vmcnt(0)" ::: "memory");
  __syncthreads();
  if (threadIdx.x == 0) {
    unsigned* bar = b.bar;
    __builtin_amdgcn_s_waitcnt(0);
    unsigned nloc = b.st[0], nx = b.st[1];
    if (nloc == 0u) { xcd_barrier_complete(bar, b.x, nloc, nx); b.st[0] = nloc; b.st[1] = nx; }
    const unsigned old = xb_add(&bar[XB_XSUB(b.x)], 1u);
    const unsigned gen = old / nloc;
    if (old + 1u == (gen + 1u) * nloc) {
      __builtin_amdgcn_fence(__ATOMIC_RELEASE, "agent");
      asm volatile("s_waitcnt vmcnt(0)" ::: "memory");
      const unsigned og = xb_add(&bar[XB_TOP], 1u);
      const unsigned tg = og / nx;
      if (og + 1u == (tg + 1u) * nx) xb_add(&bar[XB_TOPGEN], 1u);
      else XB_SPIN(xb_ld(&bar[XB_TOPGEN]) == tg, bar);
      __builtin_amdgcn_fence(__ATOMIC_ACQUIRE, "agent");
      xb_add(&bar[XB_XGEN(b.x)], 1u);
      asm volatile("s_waitcnt vmcnt(0)" ::: "memory");
    } else {
      XB_SPIN(xb_ld(&bar[XB_XGEN(b.x)]) == gen, bar);
      __builtin_amdgcn_fence(__ATOMIC_ACQUIRE, "agent");
      asm volatile("s_waitcnt vmcnt(0)" ::: "memory");
    }
  }
  __syncthreads();
}

__device__ __forceinline__ void phase_c1(const Params& p, int l, unsigned char* lds) {
  constexpr int NLOC = NBATCH * 4 * NCH, NCONV = T / 32;
  for (int u = blockIdx.x; u < NLOC + NCONV; u += gridDim.x) {
    if (u < NLOC) ml_local_unit(p, l, u, lds);
    else {
      const int cu = u - NLOC;
      if (l == DEPTH - 1 && (cu % (SEGL / 32)) < (CTXL / 32)) continue;
      conv_unit(p, l, cu, lds);
    }
  }
}
__device__ __forceinline__ void phase_c2(const Params& p, int l, unsigned char* lds) {
  ml_scan(p, lds);
  const float* lp = p.in[I_DLAM] + l * 256;
  float s01 = 0.f, s23 = 0.f;
  for (int i = 0; i < 64; ++i) { s01 += lp[i] * lp[64 + i]; s23 += lp[128 + i] * lp[192 + i]; }
  const float lam_init = 0.8f - 0.6f * expf(-0.3f * (float)l);
  const float lam = expf(s01) - expf(s23) + lam_init;
  const bf16_t* PROJ = (const bf16_t*)(p.ws + WS_PROJ);
  bf16_t* MIX = (bf16_t*)(p.ws + WS_MIX);
  const float* ng = p.in[I_DNORMG] + l * 128;
  const int nun = 512 + (l < DEPTH - 1 ? 16 : 0);
  for (int u = blockIdx.x; u < nun; u += gridDim.x) {
    int bh, qrow, nkeys;
    if (u < 512) { const int xcd = u & 7, i = (u >> 3) & 31, rnd = u >> 8; bh = 2 * xcd + rnd; qrow = CTXL + i * 256; nkeys = SEGL; }
    else { bh = u - 512; qrow = 0; nkeys = CTXL; }
    const int b = bh >> 2, h = bh & 3;
    const size_t tok0 = (size_t)b * SEGL;
    for (int rep = 0; rep < REP_ATT; ++rep)
    att_unit(PROJ + (tok0 + qrow) * PW + C_DQ + h * 128, PROJ + tok0 * PW + C_DK + h * 128, PROJ + tok0 * PW + C_DV + h * 128,
             MIX + (tok0 + qrow) * DM + 512 + h * 128, nkeys, lam, ng, 1.f - lam_init, lds);
  }
}
__device__ __forceinline__ void phase_c3(const Params& p, int l, unsigned char* lds) {
  constexpr int NU = NBATCH * 4 * NCH;
  for (int u = blockIdx.x; u < NU; u += gridDim.x) {
    if (l == DEPTH - 1 && (u % NCH) < 4) continue;
    ml_out_unit(p, l, u, lds);
  }
}
__device__ __forceinline__ void phase_peer(const Params& p, int l, unsigned char* lds) {
  constexpr int NU = T / 32;
  for (int u = blockIdx.x; u < NU; u += gridDim.x) {
    if (l == DEPTH - 1 && (u % (SEGL / 32)) < (CTXL / 32)) continue;
    peer_unit(p, l, u, lds);
  }
}

__global__ void __launch_bounds__(512, 2) mk_fwd(Params p) {
  cg::grid_group grid = cg::this_grid();
  extern __shared__ __attribute__((aligned(16))) unsigned char lds[];
  const int lo = p.ph_lo, hi = p.ph_hi;
#define IN(k) (lo <= (k) && (k) < hi)
#ifndef PHASEMASK
#define PHASEMASK 0xFFFF
#endif
#define PH(i) ((PHASEMASK >> (i)) & 1)
#define SEAM(k) do { if (IN(k) && IN((k) + 1)) { if ((k) == 0) grid.sync(); else xcd_barrier(xbar); } } while (0)
  volatile LAS unsigned* xst = (volatile LAS unsigned*)((LAS unsigned char*)lds + (LDS_BYTES - 64));
  if (threadIdx.x < 2) xst[threadIdx.x] = 0u;
  __syncthreads();
  XcdBarrier xbar = xcd_barrier_post((unsigned*)(p.ws + WS_CTL) + 4096, xst);
  if (PH(0) && IN(0)) for (int rep = 0; rep < REP_MISC; ++rep) { p0_mod(p, lds, (float*)(p.ws + WS_MOD)); p0_convert(p, lds); }
  SEAM(0);
  if (PH(1) && IN(1)) phase_norm(p, 0, 0, true, false);
  SEAM(1);
#pragma unroll 1
  for (int l_ = 0; l_ < DEPTH; ++l_) {
    int l = l_; asm volatile("" : "+s"(l));
    const int b = 2 + 8 * l;
    if (PH(2) && IN(b + 0)) for (int rep = 0; rep < REP_GEMM; ++rep) phase_inproj(p, l, lds);
    SEAM(b + 0);
    if (PH(3) && IN(b + 1)) for (int rep = 0; rep < REP_ML; ++rep) phase_c1(p, l, lds);
    SEAM(b + 1);
    if (PH(4) && IN(b + 2)) phase_c2(p, l, lds);
    SEAM(b + 2);
    if (PH(5) && IN(b + 3)) for (int rep = 0; rep < REP_ML; ++rep) phase_c3(p, l, lds);
    SEAM(b + 3);
    if (PH(6) && IN(b + 4)) phase_outproj(p, l, lds);
    SEAM(b + 4);
    if (PH(7) && IN(b + 5)) for (int rep = 0; rep < REP_MISC; ++rep) phase_norm(p, l, 1, false, l == DEPTH - 1);
    SEAM(b + 5);
    if (PH(8) && IN(b + 6)) for (int rep = 0; rep < REP_GEMM; ++rep) phase_peerq(p, l, lds);
    SEAM(b + 6);
    if (PH(9) && IN(b + 7)) phase_peer(p, l, lds);
    SEAM(b + 7);
  }
#undef IN
#undef SEAM
}

extern "C" void kernel_launch(void* const* d_in, const int* in_sizes, int n_in, void* d_out, int out_size,
                              void* d_ws, size_t ws_size, hipStream_t stream) {
  static int grid = 0;
  if (grid == 0) {
    int dev = 0, cus = 0, per_cu = 0;
    (void)hipGetDevice(&dev);
    (void)hipDeviceGetAttribute(&cus, hipDeviceAttributeMultiprocessorCount, dev);
    (void)hipFuncSetAttribute((const void*)mk_fwd, hipFuncAttributeMaxDynamicSharedMemorySize, LDS_BYTES);
    (void)hipOccupancyMaxActiveBlocksPerMultiprocessor(&per_cu, (const void*)mk_fwd, 512, LDS_BYTES);
    fprintf(stderr, "kernel_launch: cus %d per_cu %d ws %zu (need %zu) n_in %d\n", cus, per_cu, ws_size, (size_t)WS_END, n_in);
    if (ws_size < WS_END || n_in != 23 || per_cu < 1) { fprintf(stderr, "kernel_launch: bad configuration, nothing launched\n"); grid = -1; return; }
    grid = cus;
  }
  if (grid < 0) return;
  (void)hipMemsetAsync((char*)d_ws + WS_CTL, 0, 65536, stream);
  Params p{};
  for (int i = 0; i < 23; ++i) p.in[i] = (const float*)d_in[i];
  p.out = (float*)d_out; p.ws = (unsigned char*)d_ws; p.ph_lo = 0; p.ph_hi = 34;
  void* args[] = {&p};
  hipError_t e = hipLaunchCooperativeKernel((const void*)mk_fwd, dim3(grid), dim3(512), args, LDS_BYTES, stream);
  if (e != hipSuccess) fprintf(stderr, "cooperative launch failed: %s (grid %d)\n", hipGetErrorString(e), grid);
}
```

```cpp
#include <hip/hip_runtime.h>
#include <hip/hip_cooperative_groups.h>
#include <cstdio>
#include <cstdint>
namespace cg = cooperative_groups;

constexpr int DM = 1024, NBATCH = 4, SEQ = 8192, CTXL = 256, SEGL = CTXL + SEQ, T = NBATCH * SEGL, DEPTH = 4;
constexpr int IN_W = 3088, PW = 3072;
constexpr int C_A = 0, C_MQ = 512, C_MK = 768, C_MV = 1024, C_MO = 1280, C_DQ = 1536, C_DK = 2048, C_DV = 2560;
constexpr int NCH = SEGL / 64;
constexpr int NEXP = 16384;
constexpr float EPS = 1e-6f;
#ifndef ABL
#define ABL 0
#endif
#ifndef REP_ATT
#define REP_ATT 1
#endif
#ifndef REP_PEER
#define REP_PEER 1
#endif
#ifndef REP_GEMM
#define REP_GEMM 1
#endif
#ifndef REP_ROUTE
#define REP_ROUTE 1
#endif
#ifndef REP_OUTP
#define REP_OUTP 1
#endif
#ifndef REP_ML
#define REP_ML 1
#endif
#ifndef REP_MISC
#define REP_MISC 1
#endif
constexpr float QSCALE = 0.125f * 1.4426950408889634f;

constexpr size_t MiB = 1u << 20;
constexpr size_t WS_CTL = 0, WS_MOD = 1 * MiB, WS_ROPE = 2 * MiB, WS_WG = 4 * MiB, WS_KEYS = 5 * MiB, WS_MLMETA = 6 * MiB,
                 WS_GATES = 7 * MiB, WS_WIN = 10 * MiB, WS_WOUT = 34 * MiB, WS_WQ = 42 * MiB, WS_PU = 50 * MiB, WS_PV = 114 * MiB, WS_PSC = 178 * MiB  ,
                 WS_XCUR = 306 * MiB, WS_H = 438 * MiB, WS_MIX = 504 * MiB, WS_PROJ = 570 * MiB, WS_ULOC = 768 * MiB, WS_END = 836 * MiB;
constexpr int USTRIDE = 4160;

constexpr int LDS_BYTES = 139264;

typedef unsigned short bf16_t;
typedef short bf16x8 __attribute__((ext_vector_type(8)));
typedef short s16x4 __attribute__((ext_vector_type(4)));
typedef float f32x4 __attribute__((ext_vector_type(4)));
typedef float f32x16 __attribute__((ext_vector_type(16)));
typedef unsigned u32x4 __attribute__((ext_vector_type(4)));
typedef unsigned u32x2 __attribute__((ext_vector_type(2)));
typedef __bf16 bf16x2v __attribute__((ext_vector_type(2)));
typedef float f32x2 __attribute__((ext_vector_type(2)));

struct Params {
  const float* in[23];
  float* out;
  unsigned char* ws;
  int ph_lo, ph_hi;
};
enum { I_X = 0, I_C, I_CTX, I_CCTX, I_ADAW, I_ADAB, I_N1G, I_N2G, I_WIN, I_CONVW, I_CONVB, I_CLNG, I_CLNB, I_GATEB, I_MNORMG, I_DLAM, I_DNORMG,
       I_WOUT, I_PWQ, I_PKEYS, I_PU, I_PV, I_FINALG };

__device__ __forceinline__ unsigned cvtpk(float lo, float hi) { unsigned r; asm volatile("v_cvt_pk_bf16_f32 %0, %1, %2" : "=v"(r) : "v"(lo), "v"(hi)); return r; }
__device__ __forceinline__ float bflo(unsigned u) { return __uint_as_float(u << 16); }
__device__ __forceinline__ float bfhi(unsigned u) { return __uint_as_float(u & 0xffff0000u); }
__device__ __forceinline__ float bf1(bf16_t u) { return __uint_as_float(((unsigned)u) << 16); }
__device__ __forceinline__ int crow(int r, int hi) { return (r & 3) + 8 * (r >> 2) + 4 * hi; }
__device__ __forceinline__ float wave_sum(float v) {
#pragma unroll
  for (int o = 1; o < 64; o <<= 1) v += __shfl_xor(v, o);
  return v;
}
__device__ __forceinline__ float wave_max(float v) {
#pragma unroll
  for (int o = 1; o < 64; o <<= 1) v = fmaxf(v, __shfl_xor(v, o));
  return v;
}
__device__ __forceinline__ float sigmoidf_(float x) { return 1.f / (1.f + __expf(-x)); }
__device__ __forceinline__ float logsigmoidf_(float x) { return fminf(x, 0.f) - log1pf(__expf(-fabsf(x))); }
__device__ __forceinline__ const float* in_row(const float* x, const float* ctx, int row) {
  const int b = row / SEGL, s = row - b * SEGL;
  return s < CTXL ? ctx + ((size_t)(b * CTXL + s)) * DM : x + ((size_t)(b * SEQ + (s - CTXL))) * DM;
}
__device__ __forceinline__ int mod_row(int row) { const int b = row / SEGL, s = row - b * SEGL; return s < CTXL ? 4 : b; }

__device__ __forceinline__ void p0_mod(const Params& p, unsigned char* lds, float* MOD) {
  float* sil = (float*)lds;
  float* red = (float*)(lds + 20480);
  int tid_ = threadIdx.x; asm volatile("" : "+v"(tid_)); const int tid = tid_, lane = tid & 63, wid = tid >> 6;
  for (int i = tid; i < 5 * 1024; i += 512) {
    const float v = i < 4096 ? p.in[I_C][i] : p.in[I_CCTX][i - 4096];
    sil[i] = v / (1.f + __expf(-v));
  }
  __syncthreads();
  for (int item = blockIdx.x; item < DEPTH * 96; item += gridDim.x) {
    const int l = item / 96, j0 = (item % 96) * 64;
    const float* W = p.in[I_ADAW] + (size_t)l * DM * 6144 + j0 + lane;
    float a0 = 0.f, a1 = 0.f, a2 = 0.f, a3 = 0.f, a4 = 0.f;
    const int k0 = wid * 128;
#pragma unroll 8
    for (int k = k0; k < k0 + 128; ++k) {
      const float w = W[(size_t)k * 6144];
      a0 += sil[k] * w; a1 += sil[1024 + k] * w; a2 += sil[2048 + k] * w; a3 += sil[3072 + k] * w; a4 += sil[4096 + k] * w;
    }
    red[(wid * 5 + 0) * 64 + lane] = a0; red[(wid * 5 + 1) * 64 + lane] = a1; red[(wid * 5 + 2) * 64 + lane] = a2;
    red[(wid * 5 + 3) * 64 + lane] = a3; red[(wid * 5 + 4) * 64 + lane] = a4;
    __syncthreads();
    if (tid < 320) {
      const int r = tid >> 6;
      float s = 0.f;
#pragma unroll
      for (int w = 0; w < 8; ++w) s += red[(w * 5 + r) * 64 + lane];
      MOD[((size_t)l * 5 + r) * 6144 + j0 + lane] = s + p.in[I_ADAB][l * 6144 + j0 + lane];
    }
    __syncthreads();
  }
}
__device__ __forceinline__ void transpose_item(const float* W, int ldw, int srccol0, bf16_t* WT, int K, int n0, int k0, float* scr, int lane) {
#pragma unroll 8
  for (int i = 0; i < 32; ++i) { const int kk = 2 * i + (lane >> 5); scr[kk * 33 + (lane & 31)] = W[(size_t)(k0 + kk) * ldw + srccol0 + (lane & 31)]; }
  asm volatile("s_waitcnt lgkmcnt(0)" ::: "memory");
  const int c = lane & 7;
#pragma unroll
  for (int j = 0; j < 4; ++j) {
    const int n = (lane >> 3) + 8 * j; const float* s = scr + (8 * c) * 33 + n;
    u32x4 o; o.x = cvtpk(s[0], s[33]); o.y = cvtpk(s[66], s[99]); o.z = cvtpk(s[132], s[165]); o.w = cvtpk(s[198], s[231]);
    *(u32x4*)(WT + (size_t)(n0 + n) * K + k0 + 8 * c) = o;
  }
  asm volatile("s_waitcnt lgkmcnt(0)" ::: "memory");
}
__device__ __forceinline__ void p0_convert(const Params& p, unsigned char* lds) {
  int tid_ = threadIdx.x; asm volatile("" : "+v"(tid_)); const int tid = tid_, lane = tid & 63, wid = tid >> 6;
  const int gw = blockIdx.x * 8 + wid, NGW = gridDim.x * 8;
  const size_t gt = (size_t)blockIdx.x * 512 + tid, NGT = (size_t)gridDim.x * 512;
  float* scr = (float*)(lds + 32768) + wid * (64 * 33);
  bf16_t* WIN = (bf16_t*)(p.ws + WS_WIN); bf16_t* WOUT = (bf16_t*)(p.ws + WS_WOUT); bf16_t* WQ = (bf16_t*)(p.ws + WS_WQ);
  constexpr int I_IN = 16 * 96, I_O = 16 * 32, PER_L = I_IN + 2 * I_O;
  for (int it = gw; it < DEPTH * PER_L; it += NGW) {
    const int l = it / PER_L; int r = it % PER_L;
    if (r < I_IN) { const int kb = r / 96, nb = r % 96, n0 = nb * 32; const int src = n0 < 1536 ? n0 : n0 + 16;
      transpose_item(p.in[I_WIN] + (size_t)l * DM * IN_W, IN_W, src, WIN + (size_t)l * PW * DM, DM, n0, kb * 64, scr, lane); continue; }
    r -= I_IN;
    if (r < I_O) { const int kb = r / 32, nb = r % 32;
      transpose_item(p.in[I_WOUT] + (size_t)l * DM * DM, DM, nb * 32, WOUT + (size_t)l * DM * DM, DM, nb * 32, kb * 64, scr, lane); continue; }
    r -= I_O;
    { const int kb = r / 32, nb = r % 32;
      transpose_item(p.in[I_PWQ] + (size_t)l * DM * DM, DM, nb * 32, WQ + (size_t)l * DM * DM, DM, nb * 32, kb * 64, scr, lane); }
  }
  bf16_t* WG = (bf16_t*)(p.ws + WS_WG);
  for (size_t i = gt; i < (size_t)DEPTH * 16 * DM; i += NGT) {
    const int l = (int)(i / (16 * DM)), g = (int)((i / DM) % 16), k = (int)(i % DM);
    WG[i] = (bf16_t)(cvtpk(p.in[I_WIN][(size_t)l * DM * IN_W + (size_t)k * IN_W + 1536 + g], 0.f) & 0xffffu);
  }
  bf16_t* KEYS = (bf16_t*)(p.ws + WS_KEYS);
  for (size_t i = gt; i < (size_t)DEPTH * 131072 / 8; i += NGT) {
    const f32x4 a = ((const f32x4*)p.in[I_PKEYS])[2 * i], b = ((const f32x4*)p.in[I_PKEYS])[2 * i + 1];
    u32x4 o; o.x = cvtpk(a.x, a.y); o.y = cvtpk(a.z, a.w); o.z = cvtpk(b.x, b.y); o.w = cvtpk(b.z, b.w);
    ((u32x4*)KEYS)[i] = o;
  }
  {
    unsigned char* PUq = p.ws + WS_PU; unsigned char* PVq = p.ws + WS_PV; float* PSC = (float*)(p.ws + WS_PSC);
    const int nrows = DEPTH * NEXP;
    for (int r = gw; r < 2 * nrows; r += NGW) {
      const int tb = r >= nrows, rr = tb ? r - nrows : r;
      const f32x4* srow = (const f32x4*)((tb ? p.in[I_PV] : p.in[I_PU]) + (size_t)rr * DM) + lane * 4;
      f32x4 v[4]; float mx = 0.f;
#pragma unroll
      for (int j = 0; j < 4; ++j) { v[j] = __builtin_nontemporal_load(srow + j); mx = fmaxf(mx, fmaxf(fmaxf(fabsf(v[j].x), fabsf(v[j].y)), fmaxf(fabsf(v[j].z), fabsf(v[j].w)))); }
      mx = wave_max(mx);
      const int eb = (int)((__float_as_uint(mx) >> 23) & 0xFFu);
      int sb = 261 - eb; sb = sb < 1 ? 1 : (sb > 253 ? 253 : sb);
      const float sc = __uint_as_float((unsigned)sb << 23), isc = __uint_as_float((unsigned)(254 - sb) << 23);
      u32x4 o;
      int w;
#define CV4(V, OUT) w = 0; w = __builtin_amdgcn_cvt_pk_fp8_f32(V.x * sc, V.y * sc, w, false); w = __builtin_amdgcn_cvt_pk_fp8_f32(V.z * sc, V.w * sc, w, true); OUT = (unsigned)w
      CV4(v[0], o.x); CV4(v[1], o.y); CV4(v[2], o.z); CV4(v[3], o.w);
#undef CV4
      *(u32x4*)((tb ? PVq : PUq) + (size_t)rr * DM + lane * 16) = o;
      if (lane == 0) PSC[(size_t)tb * nrows + rr] = isc;
    }
  }
  {
    float* RC = (float*)(p.ws + WS_ROPE); float* RS = RC + SEQ * 32;
    for (size_t i = gt; i < (size_t)SEQ * 32; i += NGT) {
      const int pos = (int)(i >> 5), j = (int)(i & 31);
      const int rr = pos >> 6, cc = pos & 63;
      const int jj = j & 15;
      const double e = -(double)jj * 0.83048202372184058696;
      const double fl = __builtin_floor(e); const double f = e - fl;
      const double z = f * 0.69314718055994530942;
      double ez = 1.0 + z * (1.0 + z * (0.5 + z * (1.0 / 6 + z * (1.0 / 24 + z * (1.0 / 120 + z * (1.0 / 720 + z * (1.0 / 5040 + z * (1.0 / 40320 + z * (1.0 / 362880 + z * (1.0 / 3628800 + z * (1.0 / 39916800 + z * (1.0 / 479001600))))))))))));
      const double inv = __builtin_ldexp(ez, (int)fl);
      const float invf = (float)inv;
      const float angf = (float)(j < 16 ? rr : cc) * invf;
      const double ang = (double)angf;
      const double kq = __builtin_rint(ang * 0.63661977236758134308);
      double r = __builtin_fma(-kq, 1.57079632679489655800e+00, ang);
      r = __builtin_fma(-kq, 6.12323399573676603587e-17, r);
      const double r2 = r * r;
      const double sn = r * (1.0 + r2 * (-1.0 / 6 + r2 * (1.0 / 120 + r2 * (-1.0 / 5040 + r2 * (1.0 / 362880 + r2 * (-1.0 / 39916800 + r2 * (1.0 / 6227020800.0)))))));
      const double cs = 1.0 + r2 * (-0.5 + r2 * (1.0 / 24 + r2 * (-1.0 / 720 + r2 * (1.0 / 40320 + r2 * (-1.0 / 3628800 + r2 * (1.0 / 479001600 + r2 * (-1.0 / 87178291200.0)))))));
      const int q = ((int)kq) & 3;
      double co, si;
      if (q == 0) { co = cs; si = sn; } else if (q == 1) { co = -sn; si = cs; } else if (q == 2) { co = -cs; si = -sn; } else { co = sn; si = -cs; }
      RC[i] = (float)co; RS[i] = (float)si;
    }
  }
}

__device__ __forceinline__ void norm_mod_row(const float* xrow, const float* g, const float* sc, const float* sh, bf16_t* orow, int lane) {
  const f32x4* xr = (const f32x4*)xrow + lane;
  f32x4 v[4]; float s = 0.f;
#pragma unroll
  for (int j = 0; j < 4; ++j) { v[j] = xr[64 * j]; s += (v[j].x * v[j].x + v[j].y * v[j].y) + (v[j].z * v[j].z + v[j].w * v[j].w); }
  const float rs = rsqrtf(wave_sum(s) * (1.f / DM) + EPS);
  u32x2* o = (u32x2*)orow + lane;
#pragma unroll
  for (int j = 0; j < 4; ++j) {
    const f32x4 gg = ((const f32x4*)g)[lane + 64 * j], cc = ((const f32x4*)sc)[lane + 64 * j], hh = ((const f32x4*)sh)[lane + 64 * j];
    const float y0 = v[j].x * rs * gg.x * (1.f + cc.x) + hh.x, y1 = v[j].y * rs * gg.y * (1.f + cc.y) + hh.y;
    const float y2 = v[j].z * rs * gg.z * (1.f + cc.z) + hh.z, y3 = v[j].w * rs * gg.w * (1.f + cc.w) + hh.w;
    u32x2 w; w.x = cvtpk(y0, y1); w.y = cvtpk(y2, y3);
    o[64 * j] = w;
  }
}
__device__ __forceinline__ void phase_norm(const Params& p, int l, int which, bool from_input, bool skip_ctx) {
  int tid_ = threadIdx.x; asm volatile("" : "+v"(tid_));
  const int lane = tid_ & 63, wid = tid_ >> 6;
  const int gw = blockIdx.x * 8 + wid, NGW = gridDim.x * 8;
  const float* MOD = (const float*)(p.ws + WS_MOD);
  const float* XC = (const float*)(p.ws + WS_XCUR);
  bf16_t* H = (bf16_t*)(p.ws + WS_H);
  const float* g = p.in[which ? I_N2G : I_N1G] + l * DM;
  for (int row = gw; row < T; row += NGW) {
    const int mr = mod_row(row);
    if (skip_ctx && mr == 4) continue;
    const float* m = MOD + ((size_t)l * 5 + mr) * 6144 + which * 3072;
    const float* xr = from_input ? in_row(p.in[I_X], p.in[I_CTX], row) : XC + (size_t)row * DM;
    norm_mod_row(xr, g, m + 1024, m, H + (size_t)row * DM, lane);
  }
}

namespace pg8 {
#define PG8_LAS __attribute__((address_space(3)))
typedef unsigned short bf16_t;
typedef short bf16x8 __attribute__((ext_vector_type(8)));
typedef float f32x4 __attribute__((ext_vector_type(4)));
typedef unsigned u32x4 __attribute__((ext_vector_type(4)));
constexpr int BM = 256, BK = 64, HALF = 128, HTB = HALF * BK * 2  , STAGE_BYTES = 8 * HTB, NXCD = 8, WGM = 8;

__host__ __device__ __forceinline__ int lds_byte(int r, int c) { const int st = (r >> 4) * 2 + (c >> 5), rr = r & 15, cc = c & 31, ob = rr * 64 + cc * 2; return st * 1024 + (ob ^ (((ob >> 9) & 1) << 5)); }
__host__ __device__ __forceinline__ void stage_rc(int b, int& R, int& C) { const int st = b / 1024, sb = b % 1024, swz = sb ^ (((sb >> 9) & 1) << 5); R = (st >> 1) * 16 + swz / 64; C = (st & 1) * 32 + (swz % 64) / 2; }
__host__ __device__ __forceinline__ int perm32(int rho) { const int n = rho >> 4, i = rho & 15; return 8 * (i >> 2) + 4 * n + (i & 3); }

struct Unit { int pm, pn; };
struct Gemm { const bf16_t* A; const bf16_t* Bt; int M, N, K; };

struct StaticOrder {
    int nM, nN, nwg, G, c;
    __host__ __device__ void init(int M, int N, int G_, int c_) { nM = M / BM; nN = N / BM; nwg = nM * nN; G = G_; c = c_; }
    __host__ __device__ bool next(int i, Unit& u) const {
        const long L = (long)i * G + c; if (L >= nwg) return false;
        int wgid = (int)L; { const int q = nwg / NXCD, r = nwg % NXCD, xcd = wgid % NXCD, off = wgid / NXCD; wgid = (xcd < r ? xcd * (q + 1) : r * (q + 1) + (xcd - r) * q) + off; }
        const int nig = WGM * nN, gid = wgid / nig, fm = gid * WGM, gsz = (nM - fm) < WGM ? (nM - fm) : WGM;
        u.pm = fm + ((wgid % nig) % gsz); u.pn = (wgid % nig) / gsz; return true;
    }
    __device__ __forceinline__ void a_ready(const Unit&) const {}
    __device__ __forceinline__ void done(const Unit&) const {}
};
__device__ __forceinline__ unsigned cvt_pk_bf16(float lo, float hi) { unsigned r; asm volatile("v_cvt_pk_bf16_f32 %0, %1, %2" : "=v"(r) : "v"(lo), "v"(hi)); return r; }
template <class Epi, class Sched, bool ALIGN_EPI = false, bool SP2 = false>
__device__ __forceinline__ void gemm_phase(PG8_LAS unsigned char* lds, const Gemm g, const Sched& S, const Epi& E) {
    const int tid = threadIdx.x, wid = __builtin_amdgcn_readfirstlane(tid >> 6), lane = tid & 63, wr = wid >> 2, wc = wid & 3, fr = lane & 15, fq = lane >> 4;
    const int K = g.K, nt = K / BK;
    unsigned voffA[2], voffB[2];
#pragma unroll
    for (int i = 0; i < 2; ++i) { int R, C; stage_rc(tid * 16 + i * 8192, R, C); const int Rb = Epi::PERM ? ((R & ~31) + perm32(R & 31)) : R;
        voffA[i] = (unsigned)(R * K + C) * 2u; voffB[i] = (unsigned)(Rb * K + C) * 2u; }
    const size_t kstep = (size_t)(BK * 2);
    const size_t hstep = (size_t)HALF * K * 2;
    const size_t tstep = 2 * hstep;
    const unsigned ldsw = (unsigned)wid * 1024u;
    const int aoff = lds_byte(wr * 64 + fr, fq * 8), boff = lds_byte(wc * 32 + fr, fq * 8);
#define PG8_SA(b, h) (((b) * 2 + (h)) * HTB)
#define PG8_SB(b, h) ((4 + (b) * 2 + (h)) * HTB)
#define PG8_STAGE(bufoff, gbase, voff) do { _Pragma("unroll") for (int _i = 0; _i < 2; ++_i) \
        __builtin_amdgcn_global_load_lds((const unsigned*)((const char*)(gbase) + (voff)[_i]), (PG8_LAS unsigned*)(lds + (bufoff) + ldsw + _i * 8192), 16, 0, 0); } while (0)
#define PG8_LDA(dst, b, h) do { _Pragma("unroll") for (int m = 0; m < 4; ++m) _Pragma("unroll") for (int k = 0; k < 2; ++k) dst[m][k] = *(const PG8_LAS bf16x8*)(lds + PG8_SA(b, h) + aoff + m * 2048 + k * 1024); } while (0)
#define PG8_LDB(dst, b, h) do { _Pragma("unroll") for (int n = 0; n < 2; ++n) _Pragma("unroll") for (int k = 0; k < 2; ++k) dst[n][k] = *(const PG8_LAS bf16x8*)(lds + PG8_SB(b, h) + boff + n * 2048 + k * 1024); } while (0)
#define PG8_MMA(ai, bj, At, Bt) do { __builtin_amdgcn_s_setprio(1); _Pragma("unroll") for (int m = 0; m < 4; ++m) _Pragma("unroll") for (int n = 0; n < 2; ++n) _Pragma("unroll") for (int k = 0; k < 2; ++k) \
        acc[ai][bj][m][n] = __builtin_amdgcn_mfma_f32_16x16x32_bf16(Bt[n][k], At[m][k], acc[ai][bj][m][n], 0, 0, 0); __builtin_amdgcn_s_setprio(0); } while (0)
#define PG8_WAIT_V(n) asm volatile("s_waitcnt vmcnt(" #n ")" ::: "memory")
#define PG8_WAIT_L(n) asm volatile("s_waitcnt lgkmcnt(" #n ")" ::: "memory")
#define PG8_BAR __builtin_amdgcn_s_barrier()
#define PG8_SCHED __builtin_amdgcn_sched_barrier(0)
    Unit cur, nxt; int ui = 0;
    if (!S.next(0, cur)) return;
    f32x4 acc[2][2][4][2];
#pragma unroll
    for (int a = 0; a < 2; ++a)
#pragma unroll
        for (int b = 0; b < 2; ++b)
#pragma unroll
            for (int m = 0; m < 4; ++m)
#pragma unroll
                for (int n = 0; n < 2; ++n) acc[a][b][m][n] = (f32x4){0.f, 0.f, 0.f, 0.f};
    bf16x8 At[4][2], B0[2][2], B1[2][2];
    const char* cA = (const char*)g.A + (size_t)cur.pm * tstep; const char* cB = (const char*)g.Bt + (size_t)cur.pn * tstep;
    S.a_ready(cur);
    if constexpr (SP2) {
        PG8_STAGE(PG8_SB(0, 0), cB, voffB); PG8_STAGE(PG8_SB(0, 1), cB + hstep, voffB); PG8_STAGE(PG8_SA(0, 0), cA, voffA); PG8_STAGE(PG8_SA(0, 1), cA + hstep, voffA);
        if (wr == 1) PG8_BAR;
        PG8_WAIT_V(2); PG8_BAR;
        PG8_STAGE(PG8_SB(1, 0), cB + kstep, voffB); PG8_STAGE(PG8_SA(1, 0), cA + kstep, voffA); PG8_STAGE(PG8_SB(1, 1), cB + hstep + kstep, voffB);
        PG8_WAIT_V(6); PG8_BAR;
    } else {
        PG8_STAGE(PG8_SB(0, 0), cB, voffB); PG8_STAGE(PG8_SA(0, 0), cA, voffA); PG8_STAGE(PG8_SB(0, 1), cB + hstep, voffB); PG8_STAGE(PG8_SA(0, 1), cA + hstep, voffA);
        if (wr == 1) PG8_BAR;
        PG8_WAIT_V(4); PG8_BAR;
        PG8_STAGE(PG8_SB(1, 0), cB + kstep, voffB); PG8_STAGE(PG8_SA(1, 0), cA + kstep, voffA); PG8_STAGE(PG8_SB(1, 1), cB + hstep + kstep, voffB);
        PG8_WAIT_V(6); PG8_BAR;
    }
    for (;;) {
        const bool has_next = S.next(ui + 1, nxt);
        const char* nA = has_next ? (const char*)g.A + (size_t)nxt.pm * tstep : cA; const char* nB = has_next ? (const char*)g.Bt + (size_t)nxt.pn * tstep : cB;
        for (int t = 0; t < nt; t += 2) {
            const bool last = (t == nt - 2);
            const char* a1 = cA + (size_t)(t + 1) * kstep;
            const char* a2 = last ? nA : cA + (size_t)(t + 2) * kstep; const char* b2 = last ? nB : cB + (size_t)(t + 2) * kstep;
            const char* a3 = a2 + kstep; const char* b3 = b2 + kstep;
            if (last && has_next) S.a_ready(nxt);
            if constexpr (SP2) {
            PG8_LDB(B0, 0, 0); PG8_LDB(B1, 0, 1); PG8_SCHED; PG8_LDA(At, 0, 0); PG8_STAGE(PG8_SA(1, 1), a1 + hstep, voffA);
            PG8_WAIT_V(8); PG8_WAIT_L(0); PG8_BAR; PG8_MMA(0, 0, At, B0); PG8_MMA(0, 1, At, B1); PG8_BAR; PG8_SCHED;
            PG8_LDA(At, 0, 1); PG8_STAGE(PG8_SB(0, 0), b2, voffB); PG8_STAGE(PG8_SB(0, 1), b2 + hstep, voffB); PG8_STAGE(PG8_SA(0, 0), a2, voffA);
            PG8_WAIT_V(8); PG8_WAIT_L(0); PG8_BAR; PG8_MMA(1, 0, At, B0); PG8_MMA(1, 1, At, B1); PG8_BAR; PG8_SCHED;
            PG8_LDB(B0, 1, 0); PG8_LDB(B1, 1, 1); PG8_SCHED; PG8_LDA(At, 1, 0); PG8_STAGE(PG8_SA(0, 1), a2 + hstep, voffA);
            PG8_WAIT_V(8); PG8_WAIT_L(0); PG8_BAR; PG8_MMA(0, 0, At, B0); PG8_MMA(0, 1, At, B1); PG8_BAR; PG8_SCHED;
            PG8_LDA(At, 1, 1); PG8_STAGE(PG8_SB(1, 0), b3, voffB); PG8_STAGE(PG8_SB(1, 1), b3 + hstep, voffB); PG8_STAGE(PG8_SA(1, 0), a3, voffA);
            PG8_WAIT_V(8); PG8_WAIT_L(0); PG8_BAR; PG8_MMA(1, 0, At, B0); PG8_MMA(1, 1, At, B1); PG8_BAR; PG8_SCHED;
            } else {
            PG8_LDB(B0, 0, 0); PG8_SCHED; PG8_LDA(At, 0, 0); PG8_STAGE(PG8_SA(1, 1), a1 + hstep, voffA);
            PG8_WAIT_L(8); PG8_BAR; PG8_WAIT_L(0); PG8_MMA(0, 0, At, B0); PG8_BAR; PG8_SCHED;
            PG8_LDB(B1, 0, 1); PG8_STAGE(PG8_SB(0, 0), b2, voffB);
            PG8_BAR; PG8_WAIT_L(0); PG8_MMA(0, 1, At, B1); PG8_BAR;
            PG8_LDA(At, 0, 1); PG8_STAGE(PG8_SA(0, 0), a2, voffA);
            PG8_BAR; PG8_WAIT_L(0); PG8_MMA(1, 0, At, B0); PG8_BAR; PG8_SCHED;
            PG8_STAGE(PG8_SB(0, 1), b2 + hstep, voffB);
            PG8_WAIT_V(6); PG8_BAR; PG8_MMA(1, 1, At, B1); PG8_BAR;
            PG8_LDB(B0, 1, 0); PG8_SCHED; PG8_LDA(At, 1, 0); PG8_STAGE(PG8_SA(0, 1), a2 + hstep, voffA);
            PG8_WAIT_L(8); PG8_BAR; PG8_WAIT_L(0); PG8_MMA(0, 0, At, B0); PG8_BAR; PG8_SCHED;
            PG8_LDB(B1, 1, 1); PG8_STAGE(PG8_SB(1, 0), b3, voffB);
            PG8_BAR; PG8_WAIT_L(0); PG8_MMA(0, 1, At, B1); PG8_BAR;
            PG8_LDA(At, 1, 1); PG8_STAGE(PG8_SA(1, 0), a3, voffA);
            PG8_BAR; PG8_WAIT_L(0); PG8_MMA(1, 0, At, B0); PG8_BAR; PG8_SCHED;
            PG8_STAGE(PG8_SB(1, 1), b3 + hstep, voffB);
            PG8_WAIT_V(6); PG8_BAR; PG8_MMA(1, 1, At, B1); PG8_BAR;
            }
        }
        if constexpr (ALIGN_EPI) { if (wr == 0) PG8_BAR; }
        if constexpr (!Epi::AFTER_DRAIN) { E(acc, cur, wr, wc, fr, fq); S.done(cur); }
        if (!has_next) break;
#pragma unroll
        for (int a = 0; a < 2; ++a)
#pragma unroll
            for (int b = 0; b < 2; ++b)
#pragma unroll
                for (int m = 0; m < 4; ++m)
#pragma unroll
                    for (int n = 0; n < 2; ++n) acc[a][b][m][n] = (f32x4){0.f, 0.f, 0.f, 0.f};
        cur = nxt; cA = nA; cB = nB; ++ui;
        if constexpr (ALIGN_EPI) { if (wr == 1) PG8_BAR; }
    }
    PG8_WAIT_V(0);
    if constexpr (!ALIGN_EPI) { if (wr == 0) PG8_BAR; }
    PG8_BAR;
    if constexpr (Epi::AFTER_DRAIN) { E.fused(acc, cur, wr, wc, fr, fq, lds, wid, lane); S.done(cur); }
#undef PG8_SA
#undef PG8_SB
#undef PG8_STAGE
#undef PG8_LDA
#undef PG8_LDB
#undef PG8_MMA
#undef PG8_WAIT_V
#undef PG8_WAIT_L
#undef PG8_BAR
#undef PG8_SCHED
}
}

__device__ __forceinline__ int gswz(int row, int chunk) { return row * 128 + ((chunk ^ ((row >> 1) & 7)) << 4); }
__device__ __forceinline__ void gemm_tile(const bf16_t* __restrict__ A, int lda, const bf16_t* __restrict__ Bt, int ldb, int K,
                                          int row0, int col0, unsigned char* lds, f32x16 (&acc)[2][2]) {
  int tid_ = threadIdx.x; asm volatile("" : "+v"(tid_)); const int tid = tid_, lane = tid & 63, wid = tid >> 6, wm = wid >> 1, wn = wid & 1, r32 = lane & 31, hi = lane >> 5;
  unsigned char* As = lds; unsigned char* Bs = lds + 65536;
#pragma unroll
  for (int i = 0; i < 2; ++i)
#pragma unroll
    for (int j = 0; j < 2; ++j) acc[i][j] = f32x16{};
  const int lrow = tid >> 3, lc = tid & 7;
  const bf16_t* Ag = A + (size_t)(row0 + lrow) * lda + lc * 8;
  const bf16_t* Bg = Bt + (size_t)(col0 + lrow) * ldb + lc * 8;
  u32x4 ra[4], rb[2];
#pragma unroll
  for (int i = 0; i < 4; ++i) ra[i] = *(const u32x4*)(Ag + (size_t)(64 * i) * lda);
#pragma unroll
  for (int i = 0; i < 2; ++i) rb[i] = *(const u32x4*)(Bg + (size_t)(64 * i) * ldb);
#pragma unroll
  for (int i = 0; i < 4; ++i) *(u32x4*)(As + gswz(lrow + 64 * i, lc)) = ra[i];
#pragma unroll
  for (int i = 0; i < 2; ++i) *(u32x4*)(Bs + gswz(lrow + 64 * i, lc)) = rb[i];
  __syncthreads();
  const int nk = K / 64;
  for (int kt = 0; kt < nk; ++kt) {
    const int cur = kt & 1;
    if (kt + 1 < nk) {
#pragma unroll
      for (int i = 0; i < 4; ++i) ra[i] = *(const u32x4*)(Ag + (size_t)(64 * i) * lda + (kt + 1) * 64);
#pragma unroll
      for (int i = 0; i < 2; ++i) rb[i] = *(const u32x4*)(Bg + (size_t)(64 * i) * ldb + (kt + 1) * 64);
    }
    const unsigned char* Ac = As + cur * 32768; const unsigned char* Bc = Bs + cur * 16384;
#pragma unroll
    for (int kk = 0; kk < 4; ++kk) {
      bf16x8 af[2], bfr[2];
#pragma unroll
      for (int i = 0; i < 2; ++i) af[i] = *(const bf16x8*)(Ac + gswz(wm * 64 + i * 32 + r32, 2 * kk + hi));
#pragma unroll
      for (int j = 0; j < 2; ++j) bfr[j] = *(const bf16x8*)(Bc + gswz(wn * 64 + j * 32 + r32, 2 * kk + hi));
#pragma unroll
      for (int i = 0; i < 2; ++i)
#pragma unroll
        for (int j = 0; j < 2; ++j) acc[i][j] = __builtin_amdgcn_mfma_f32_32x32x16_bf16(af[i], bfr[j], acc[i][j], 0, 0, 0);
    }
    if (kt + 1 < nk) {
      unsigned char* An = As + (cur ^ 1) * 32768; unsigned char* Bn = Bs + (cur ^ 1) * 16384;
#pragma unroll
      for (int i = 0; i < 4; ++i) *(u32x4*)(An + gswz(lrow + 64 * i, lc)) = ra[i];
#pragma unroll
      for (int i = 0; i < 2; ++i) *(u32x4*)(Bn + gswz(lrow + 64 * i, lc)) = rb[i];
    }
    __syncthreads();
  }
}
__device__ __forceinline__ void pair_xchg(float v0, float v1, int lane, float& lo, float& hi2) {
  const bool odd = lane & 1;
  const float send = odd ? v0 : v1;
  const float recv = __shfl_xor(send, 1);
  lo = odd ? recv : v0; hi2 = odd ? v1 : recv;
}

__device__ __forceinline__ void phase_inproj(const Params& p, int l, unsigned char* lds) {
  int tid_ = threadIdx.x; asm volatile("" : "+v"(tid_)); const int tid = tid_, lane = tid & 63, wid = tid >> 6, wm = wid >> 1, wn = wid & 1, r32 = lane & 31, hi = lane >> 5;
  const bf16_t* H = (const bf16_t*)(p.ws + WS_H);
  const bf16_t* W = (const bf16_t*)(p.ws + WS_WIN) + (size_t)l * PW * DM;
  bf16_t* PROJ = (bf16_t*)(p.ws + WS_PROJ);
  const float* RC = (const float*)(p.ws + WS_ROPE); const float* RS = RC + SEQ * 32;
  constexpr int NM = T / 256, NN = PW / 128, NU = NM * NN;
  for (int u = blockIdx.x; u < NU + NM; u += gridDim.x) {
    if (u < NU) {
      const int pn = u / NM, pm = u % NM;
      const int row0 = pm * 256, col0 = pn * 128;
      f32x16 acc[2][2];
      gemm_tile(H, DM, W, DM, DM, row0, col0, lds, acc);
      const bool rope = (col0 >= C_DQ && col0 < C_DV);
      const float scl = (col0 >= C_MK && col0 < C_MV) ? 0.125f : ((col0 >= C_DQ && col0 < C_DK) ? QSCALE : 1.f);
#pragma unroll
      for (int i = 0; i < 2; ++i)
#pragma unroll
        for (int j = 0; j < 2; ++j)
#pragma unroll
          for (int q = 0; q < 8; ++q) {
            float lo, hi2; pair_xchg(acc[i][j][2 * q], acc[i][j][2 * q + 1], lane, lo, hi2);
            const int row = row0 + wm * 64 + i * 32 + crow(2 * q, hi) + (lane & 1);
            const int col = col0 + wn * 64 + j * 32 + (r32 & ~1);
            if (rope) {
              const int s = row % SEGL;
              if (s >= CTXL) {
                const int idx = (s - CTXL) * 32 + ((col & 63) >> 1);
                const float c = RC[idx], sn = RS[idx];
                const float t1 = lo, t2 = hi2; lo = t1 * c - t2 * sn; hi2 = t1 * sn + t2 * c;
              }
            }
            *(unsigned*)(PROJ + (size_t)row * PW + col) = cvtpk(lo * scl, hi2 * scl);
          }
    } else {
      const int pm = u - NU, rowb = pm * 256 + wid * 32;
      const bf16_t* WG = (const bf16_t*)(p.ws + WS_WG) + (size_t)l * 16 * DM;
      float* GT = (float*)(p.ws + WS_GATES);
      const int r16 = lane & 15, q4 = lane >> 4;
      f32x4 c0 = {0.f, 0.f, 0.f, 0.f}, c1 = {0.f, 0.f, 0.f, 0.f};
      const bf16_t* a0p = H + (size_t)(rowb + r16) * DM + q4 * 8;
      const bf16_t* a1p = a0p + (size_t)16 * DM;
      const bf16_t* bp = WG + (size_t)r16 * DM + q4 * 8;
#pragma unroll 4
      for (int ks = 0; ks < 32; ++ks) {
        const bf16x8 a0 = *(const bf16x8*)(a0p + ks * 32), a1 = *(const bf16x8*)(a1p + ks * 32), b = *(const bf16x8*)(bp + ks * 32);
        c0 = __builtin_amdgcn_mfma_f32_16x16x32_bf16(a0, b, c0, 0, 0, 0);
        c1 = __builtin_amdgcn_mfma_f32_16x16x32_bf16(a1, b, c1, 0, 0, 0);
      }
      const float gb = p.in[I_GATEB][l * 16 + r16];
#pragma unroll
      for (int j = 0; j < 4; ++j) {
        GT[(size_t)(rowb + q4 * 4 + j) * 16 + r16] = c0[j] + gb;
        GT[(size_t)(rowb + 16 + q4 * 4 + j) * 16 + r16] = c1[j] + gb;
      }
    }
  }
}

__device__ __forceinline__ void phase_outproj(const Params& p, int l, unsigned char* lds) {
  int tid_ = threadIdx.x; asm volatile("" : "+v"(tid_)); const int tid = tid_, lane = tid & 63, wid = tid >> 6, wm = wid >> 1, wn = wid & 1, r32 = lane & 31, hi = lane >> 5;
  const bf16_t* MIX = (const bf16_t*)(p.ws + WS_MIX);
  const bf16_t* W = (const bf16_t*)(p.ws + WS_WOUT) + (size_t)l * DM * DM;
  float* XC = (float*)(p.ws + WS_XCUR);
  const float* MOD = (const float*)(p.ws + WS_MOD);
  constexpr int NM = T / 256, NN = DM / 128, NU = NM * NN;
  for (int u = blockIdx.x; u < NU; u += gridDim.x) {
    const int pm = u / NN, pn = u % NN;
    if (l == DEPTH - 1 && (pm % 33) == 0) continue;
    const int row0 = pm * 256, col0 = pn * 128;
    for (int rep = 0; rep < REP_OUTP; ++rep) {
    f32x16 acc[2][2];
    gemm_tile(MIX, DM, W, DM, DM, row0, col0, lds, acc);
    const int mr = (pm % 33) == 0 ? 4 : pm / 33;
    const float* g1 = MOD + ((size_t)l * 5 + mr) * 6144 + 2048;
#pragma unroll
    for (int i = 0; i < 2; ++i)
#pragma unroll
      for (int j = 0; j < 2; ++j) {
        const int col = col0 + wn * 64 + j * 32 + r32;
        const float gg = (rep == REP_OUTP - 1) ? g1[col] : 0.f;
#pragma unroll
        for (int r = 0; r < 16; ++r) {
          const int row = row0 + wm * 64 + i * 32 + crow(r, hi);
          const float xo = (l == 0) ? in_row(p.in[I_X], p.in[I_CTX], row)[col] : XC[(size_t)row * DM + col];
          XC[(size_t)row * DM + col] = xo + gg * acc[i][j][r];
        }
      }
    }
  }
}
__device__ __forceinline__ void phase_peerq(const Params& p, int l, unsigned char* lds) {
  int tid_ = threadIdx.x; asm volatile("" : "+v"(tid_)); const int tid = tid_, lane = tid & 63, wid = tid >> 6, wm = wid >> 1, wn = wid & 1, r32 = lane & 31, hi = lane >> 5;
  const bf16_t* H = (const bf16_t*)(p.ws + WS_H);
  const bf16_t* W = (const bf16_t*)(p.ws + WS_WQ) + (size_t)l * DM * DM;
  bf16_t* QP = (bf16_t*)(p.ws + WS_PROJ);
  constexpr int NM = T / 256, NN = DM / 128, NU = NM * NN;
  for (int u = blockIdx.x; u < NU; u += gridDim.x) {
    const int pm = u / NN, pn = u % NN;
    if (l == DEPTH - 1 && (pm % 33) == 0) continue;
    const int row0 = pm * 256, col0 = pn * 128;
    f32x16 acc[2][2];
    gemm_tile(H, DM, W, DM, DM, row0, col0, lds, acc);
#pragma unroll
    for (int i = 0; i < 2; ++i)
#pragma unroll
      for (int j = 0; j < 2; ++j)
#pragma unroll
        for (int q = 0; q < 8; ++q) {
          float lo, hi2; pair_xchg(acc[i][j][2 * q], acc[i][j][2 * q + 1], lane, lo, hi2);
          const int row = row0 + wm * 64 + i * 32 + crow(2 * q, hi) + (lane & 1);
          const int col = col0 + wn * 64 + j * 32 + (r32 & ~1);
          *(unsigned*)(QP + (size_t)row * DM + col) = cvtpk(lo, hi2);
        }
  }
}


struct EpiInproj {
  static constexpr bool PERM = true, AFTER_DRAIN = false;
  bf16_t* PROJ; const float* RC; const float* RS;
  __device__ __forceinline__ void operator()(const pg8::f32x4 (&acc)[2][2][4][2], const pg8::Unit& u, int wr, int wc, int fr, int fq) const {
#pragma unroll
    for (int bj = 0; bj < 2; ++bj) {
      const int colt = u.pn * 256 + bj * 128;
      const bool rope = (colt >= C_DQ && colt < C_DV);
      const float scl = (colt >= C_MK && colt < C_MV) ? 0.125f : ((colt >= C_DQ && colt < C_DK) ? QSCALE : 1.f);
      const int col8 = colt + wc * 32 + 8 * fq;
#pragma unroll
      for (int ai = 0; ai < 2; ++ai)
#pragma unroll
        for (int m = 0; m < 4; ++m) {
          const int row = u.pm * 256 + ai * 128 + wr * 64 + m * 16 + fr;
          f32x4 v0 = acc[ai][bj][m][0], v1 = acc[ai][bj][m][1];
          if (rope) {
            const int s = row % SEGL;
            if (s >= CTXL) {
              const int idx = (s - CTXL) * 32 + ((col8 & 63) >> 1);
              const f32x4 c = *(const f32x4*)(RC + idx), sn = *(const f32x4*)(RS + idx);
              f32x4 a, b;
              a[0] = v0[0] * c[0] - v0[1] * sn[0]; a[1] = v0[0] * sn[0] + v0[1] * c[0]; a[2] = v0[2] * c[1] - v0[3] * sn[1]; a[3] = v0[2] * sn[1] + v0[3] * c[1];
              b[0] = v1[0] * c[2] - v1[1] * sn[2]; b[1] = v1[0] * sn[2] + v1[1] * c[2]; b[2] = v1[2] * c[3] - v1[3] * sn[3]; b[3] = v1[2] * sn[3] + v1[3] * c[3];
              v0 = a; v1 = b;
            }
          }
          u32x4 w; w.x = cvtpk(v0[0] * scl, v0[1] * scl); w.y = cvtpk(v0[2] * scl, v0[3] * scl); w.z = cvtpk(v1[0] * scl, v1[1] * scl); w.w = cvtpk(v1[2] * scl, v1[3] * scl);
          *(u32x4*)(PROJ + (size_t)row * PW + col8) = w;
        }
    }
  }
};
struct EpiOutproj {
  static constexpr bool PERM = true, AFTER_DRAIN = false;
  float* XC; const float* MODL; const float* xin; const float* ctxin; int first;
  __device__ __forceinline__ void operator()(const pg8::f32x4 (&acc)[2][2][4][2], const pg8::Unit& u, int wr, int wc, int fr, int fq) const {
    const int mr = (u.pm % 33) == 0 ? 4 : u.pm / 33;
    const float* g1 = MODL + (size_t)mr * 6144 + 2048;
#pragma unroll
    for (int bj = 0; bj < 2; ++bj) {
      const int col8 = u.pn * 256 + bj * 128 + wc * 32 + 8 * fq;
      const f32x4 ga = *(const f32x4*)(g1 + col8), gb = *(const f32x4*)(g1 + col8 + 4);
#pragma unroll
      for (int ai = 0; ai < 2; ++ai)
#pragma unroll
        for (int m = 0; m < 4; ++m) {
          const int row = u.pm * 256 + ai * 128 + wr * 64 + m * 16 + fr;
          const float* xo = first ? in_row(xin, ctxin, row) + col8 : XC + (size_t)row * DM + col8;
          const f32x4 xa = *(const f32x4*)xo, xb = *(const f32x4*)(xo + 4);
          *(f32x4*)(XC + (size_t)row * DM + col8) = xa + ga * acc[ai][bj][m][0];
          *(f32x4*)(XC + (size_t)row * DM + col8 + 4) = xb + gb * acc[ai][bj][m][1];
        }
    }
  }
};
struct EpiPeerq {
  static constexpr bool PERM = true, AFTER_DRAIN = false;
  bf16_t* QP;
  __device__ __forceinline__ void operator()(const pg8::f32x4 (&acc)[2][2][4][2], const pg8::Unit& u, int wr, int wc, int fr, int fq) const {
#pragma unroll
    for (int bj = 0; bj < 2; ++bj) {
      const int col8 = u.pn * 256 + bj * 128 + wc * 32 + 8 * fq;
#pragma unroll
      for (int ai = 0; ai < 2; ++ai)
#pragma unroll
        for (int m = 0; m < 4; ++m) {
          const int row = u.pm * 256 + ai * 128 + wr * 64 + m * 16 + fr;
          const f32x4 v0 = acc[ai][bj][m][0], v1 = acc[ai][bj][m][1];
          u32x4 w; w.x = cvtpk(v0[0], v0[1]); w.y = cvtpk(v0[2], v0[3]); w.z = cvtpk(v1[0], v1[1]); w.w = cvtpk(v1[2], v1[3]);
          *(u32x4*)(QP + (size_t)row * DM + col8) = w;
        }
    }
  }
};
__device__ __forceinline__ void phase_inproj2(const Params& p, int l, unsigned char* lds) {
  {
    pg8::Gemm g{(const bf16_t*)(p.ws + WS_H), (const bf16_t*)(p.ws + WS_WIN) + (size_t)l * PW * DM, T, PW, DM};
    pg8::StaticOrder S; S.init(T, PW, (int)gridDim.x, (int)blockIdx.x);
    EpiInproj E{(bf16_t*)(p.ws + WS_PROJ), (const float*)(p.ws + WS_ROPE), (const float*)(p.ws + WS_ROPE) + SEQ * 32};
    pg8::gemm_phase<EpiInproj, pg8::StaticOrder, true, true>((PG8_LAS unsigned char*)lds, g, S, E);
  }
  int tid_ = threadIdx.x; asm volatile("" : "+v"(tid_)); const int tid = tid_, lane = tid & 63, wid = tid >> 6;
  const bf16_t* H = (const bf16_t*)(p.ws + WS_H);
  for (int pm = blockIdx.x; pm < T / 256; pm += gridDim.x) {
    const int rowb = pm * 256 + wid * 32;
    const bf16_t* WG = (const bf16_t*)(p.ws + WS_WG) + (size_t)l * 16 * DM;
    float* GT = (float*)(p.ws + WS_GATES);
    const int r16 = lane & 15, q4 = lane >> 4;
    f32x4 c0 = {0.f, 0.f, 0.f, 0.f}, c1 = {0.f, 0.f, 0.f, 0.f};
    const bf16_t* a0p = H + (size_t)(rowb + r16) * DM + q4 * 8;
    const bf16_t* a1p = a0p + (size_t)16 * DM;
    const bf16_t* bp = WG + (size_t)r16 * DM + q4 * 8;
#pragma unroll 4
    for (int ks = 0; ks < 32; ++ks) {
      const bf16x8 a0 = *(const bf16x8*)(a0p + ks * 32), a1 = *(const bf16x8*)(a1p + ks * 32), b = *(const bf16x8*)(bp + ks * 32);
      c0 = __builtin_amdgcn_mfma_f32_16x16x32_bf16(a0, b, c0, 0, 0, 0);
      c1 = __builtin_amdgcn_mfma_f32_16x16x32_bf16(a1, b, c1, 0, 0, 0);
    }
    const float gb = p.in[I_GATEB][l * 16 + r16];
#pragma unroll
    for (int j = 0; j < 4; ++j) {
      GT[(size_t)(rowb + q4 * 4 + j) * 16 + r16] = c0[j] + gb;
      GT[(size_t)(rowb + 16 + q4 * 4 + j) * 16 + r16] = c1[j] + gb;
    }
  }
}
__device__ __forceinline__ void phase_outproj2(const Params& p, int l, unsigned char* lds) {
  pg8::Gemm g{(const bf16_t*)(p.ws + WS_MIX), (const bf16_t*)(p.ws + WS_WOUT) + (size_t)l * DM * DM, T, DM, DM};
  pg8::StaticOrder S; S.init(T, DM, (int)gridDim.x, (int)blockIdx.x);
  EpiOutproj E{(float*)(p.ws + WS_XCUR), (const float*)(p.ws + WS_MOD) + (size_t)l * 5 * 6144, p.in[I_X], p.in[I_CTX], l == 0};
  pg8::gemm_phase<EpiOutproj, pg8::StaticOrder, true, true>((PG8_LAS unsigned char*)lds, g, S, E);
}
__device__ __forceinline__ void phase_peerq2(const Params& p, int l, unsigned char* lds) {
  pg8::Gemm g{(const bf16_t*)(p.ws + WS_H), (const bf16_t*)(p.ws + WS_WQ) + (size_t)l * DM * DM, T, DM, DM};
  pg8::StaticOrder S; S.init(T, DM, (int)gridDim.x, (int)blockIdx.x);
  EpiPeerq E{(bf16_t*)(p.ws + WS_PROJ)};
  pg8::gemm_phase<EpiPeerq, pg8::StaticOrder, true, true>((PG8_LAS unsigned char*)lds, g, S, E);
}

__device__ __forceinline__ void conv_unit(const Params& p, int l, int unit, unsigned char* lds) {
  int tid_ = threadIdx.x; asm volatile("" : "+v"(tid_)); const int tid = tid_, lane = tid & 63, wid = tid >> 6;
  float* U = (float*)lds;
  const bf16_t* PROJ = (const bf16_t*)(p.ws + WS_PROJ);
  bf16_t* MIX = (bf16_t*)(p.ws + WS_MIX);
  const int row0 = unit * 32, b = row0 / SEGL, s0 = row0 - b * SEGL;
  const int seglo = s0 < CTXL ? 0 : CTXL, seghi = s0 < CTXL ? CTXL : SEGL;
  for (int rr = tid >> 5; rr < 62; rr += 16) {
    const int s = s0 - 15 + rr, c8 = (tid & 31) * 8;
    f32x4 u0 = {0.f, 0.f, 0.f, 0.f}, u1 = {0.f, 0.f, 0.f, 0.f};
    if (s >= seglo && s < seghi) {
      const bf16_t* pr = PROJ + (size_t)(b * SEGL + s) * PW + c8;
      const u32x4 a1 = *(const u32x4*)pr, a2 = *(const u32x4*)(pr + 256);
      u0.x = bflo(a1.x) * sigmoidf_(bflo(a2.x)); u0.y = bfhi(a1.x) * sigmoidf_(bfhi(a2.x));
      u0.z = bflo(a1.y) * sigmoidf_(bflo(a2.y)); u0.w = bfhi(a1.y) * sigmoidf_(bfhi(a2.y));
      u1.x = bflo(a1.z) * sigmoidf_(bflo(a2.z)); u1.y = bfhi(a1.z) * sigmoidf_(bfhi(a2.z));
      u1.z = bflo(a1.w) * sigmoidf_(bflo(a2.w)); u1.w = bfhi(a1.w) * sigmoidf_(bfhi(a2.w));
    }
    *(f32x4*)(U + rr * 256 + c8) = u0; *(f32x4*)(U + rr * 256 + c8 + 4) = u1;
  }
  __syncthreads();
  float* Y = U + 62 * 256;
  const float* cw = p.in[I_CONVW] + (size_t)l * 31 * 256;
#pragma unroll 1
  for (int q = 0; q < 4; ++q) {
    const int c = lane + 64 * q;
    float w[31];
#pragma unroll
    for (int j = 0; j < 31; ++j) w[j] = cw[j * 256 + c];
    const float bias = p.in[I_CONVB][l * 256 + c];
#pragma unroll
    for (int tt = 0; tt < 4; ++tt) {
      const int t = wid * 4 + tt;
      float a = bias;
#pragma unroll
      for (int j = 0; j < 31; ++j) a += U[(t + j) * 256 + c] * w[j];
      Y[t * 256 + c] = a;
    }
  }
  asm volatile("s_waitcnt lgkmcnt(0)" ::: "memory");
  float y[4][4];
#pragma unroll
  for (int tt = 0; tt < 4; ++tt)
#pragma unroll
    for (int q = 0; q < 4; ++q) y[tt][q] = Y[(wid * 4 + tt) * 256 + lane + 64 * q];
#pragma unroll
  for (int tt = 0; tt < 4; ++tt) {
    const int t = wid * 4 + tt;
    const float mean = wave_sum((y[tt][0] + y[tt][1]) + (y[tt][2] + y[tt][3])) * (1.f / 256.f);
    float v = 0.f;
#pragma unroll
    for (int q = 0; q < 4; ++q) { const float d = y[tt][q] - mean; v += d * d; }
    const float rs = rsqrtf(wave_sum(v) * (1.f / 256.f) + EPS);
#pragma unroll
    for (int q = 0; q < 4; ++q) {
      const int c = lane + 64 * q;
      const float z = (y[tt][q] - mean) * rs * p.in[I_CLNG][l * 256 + c] + p.in[I_CLNB][l * 256 + c];
      const float o = (ABL & 1) ? 0.f : z * sigmoidf_(z);
      MIX[(size_t)(row0 + t) * DM + c] = (bf16_t)(cvtpk(o, 0.f) & 0xffffu);
    }
  }
  __syncthreads();
}

__device__ __forceinline__ int ml_cidx(int ch, int dir) { return dir == 0 ? ch : (ch < 4 ? 3 - ch : 135 - ch); }
__device__ __forceinline__ void ml_load_tile(const bf16_t* src, float* dst, int tid) {
  const int r = tid >> 3, c8 = (tid & 7) * 8;
  const u32x4 a = *(const u32x4*)(src + (size_t)r * PW + c8);
  float* d = dst + r * 65 + c8;
  d[0] = bflo(a.x); d[1] = bfhi(a.x); d[2] = bflo(a.y); d[3] = bfhi(a.y); d[4] = bflo(a.z); d[5] = bfhi(a.z); d[6] = bflo(a.w); d[7] = bfhi(a.w);
}
__device__ __forceinline__ void ml_local_unit(const Params& p, int l, int unit, unsigned char* lds) {
  int tid_ = threadIdx.x; asm volatile("" : "+v"(tid_)); const int tid = tid_, lane = tid & 63, wid = tid >> 6, r32 = lane & 31, hi = lane >> 5;
  float* Kt = (float*)lds; float* Vt = Kt + 64 * 65; float* WK = Vt + 64 * 65;
  const bf16_t* PROJ = (const bf16_t*)(p.ws + WS_PROJ);
  const float* GT = (const float*)(p.ws + WS_GATES);
  float* UL = (float*)(p.ws + WS_ULOC); float* META = (float*)(p.ws + WS_MLMETA);
  const int b = unit / (4 * NCH), hh = (unit / NCH) & 3, ch = unit % NCH;
  const int row0 = b * SEGL + ch * 64;
  ml_load_tile(PROJ + (size_t)row0 * PW + C_MK + hh * 64, Kt, tid);
  ml_load_tile(PROJ + (size_t)row0 * PW + C_MV + hh * 64, Vt, tid);
  if (wid < 2) {
    const int dir = wid;
    const float ig = GT[(size_t)(row0 + lane) * 16 + (2 * dir) * 4 + hh];
    const float lf = logsigmoidf_(GT[(size_t)(row0 + lane) * 16 + (2 * dir + 1) * 4 + hh]);
    float ps = lf;
#pragma unroll
    for (int o = 1; o < 64; o <<= 1) { const float t = __shfl_up(ps, o); if (lane >= o) ps += t; }
    const float tot = __shfl(ps, 63);
    const float wlog = dir == 0 ? (tot - ps + ig) : (ps - lf + ig);
    const float mloc = wave_max(wlog);
    WK[dir * 64 + lane] = __expf(wlog - mloc);
    if (lane == 0) {
      const int seq = (b * 4 + hh) * 2 + dir, ci = ml_cidx(ch, dir);
      META[((size_t)seq * NCH + ci) * 4 + 0] = tot; META[((size_t)seq * NCH + ci) * 4 + 1] = mloc;
    }
  }
  __syncthreads();
  {
    const int dir = wid >> 2, et = (wid >> 1) & 1, dt = wid & 1;
    const int seq = (b * 4 + hh) * 2 + dir, ci = ml_cidx(ch, dir);
    float* slot = UL + ((size_t)seq * NCH + ci) * USTRIDE;
    f32x16 acc = {};
#pragma unroll 8
    for (int ks = 0; ks < 32; ++ks) {
      const int s = 2 * ks + hi;
      const float a = WK[dir * 64 + s] * Vt[s * 65 + et * 32 + r32];
      const float bb = Kt[s * 65 + dt * 32 + r32];
      acc = __builtin_amdgcn_mfma_f32_32x32x2f32(a, bb, acc, 0, 0, 0);
    }
#pragma unroll
    for (int r = 0; r < 16; ++r) slot[(et * 32 + crow(r, hi)) * 64 + dt * 32 + r32] = acc[r];
    if (et == 0) {
      float n = 0.f;
#pragma unroll 8
      for (int i = 0; i < 32; ++i) { const int s = hi * 32 + i; n += WK[dir * 64 + s] * Kt[s * 65 + dt * 32 + r32]; }
      n += __shfl_xor(n, 32);
      if (hi == 0) slot[4096 + dt * 32 + r32] = n;
    }
  }
  __syncthreads();
}
__device__ __forceinline__ void ml_scan(const Params& p, unsigned char* lds) {
  float* UL = (float*)(p.ws + WS_ULOC); float* META = (float*)(p.ws + WS_MLMETA);
  int tid_ = threadIdx.x; asm volatile("" : "+v"(tid_));
  const int tid = tid_, lane = tid & 63, wid = tid >> 6;
  float* DEC = (float*)lds;
  float* SCL = DEC + 2 * NCH;
  float* TMP = SCL + 2 * NCH;
  for (int base0 = blockIdx.x * 512; base0 < 32 * USTRIDE; base0 += gridDim.x * 512) {
    const int seq0 = base0 / USTRIDE;
    if (wid < 2) {
      const int seq = seq0 + wid;
      if (seq < 32) {
        float* mt = META + (size_t)seq * NCH * 4;
        for (int c = lane; c < NCH; c += 64) { TMP[(wid * 2 + 0) * NCH + c] = mt[c * 4 + 0]; TMP[(wid * 2 + 1) * NCH + c] = mt[c * 4 + 1]; }
        asm volatile("s_waitcnt lgkmcnt(0)" ::: "memory");
        if (lane == 0) {
          float m = 0.f;
          for (int c = 0; c < NCH; ++c) {
            const float bl = TMP[(wid * 2 + 0) * NCH + c], mloc = TMP[(wid * 2 + 1) * NCH + c];
            const float mn = fmaxf(bl + m, mloc);
            DEC[wid * NCH + c] = __expf(bl + m - mn); SCL[wid * NCH + c] = __expf(mloc - mn);
            mt[c * 4 + 2] = m;
            m = mn;
          }
        }
      }
    }
    __syncthreads();
    const int idx = base0 + tid;
    if (idx < 32 * USTRIDE) {
      const int seq = idx / USTRIDE, e = idx - seq * USTRIDE, sl = seq - seq0;
      float* bp = UL + (size_t)seq * NCH * USTRIDE + e;
      const float* dec = DEC + sl * NCH; const float* scl = SCL + sl * NCH;
      float C = 0.f;
#pragma unroll 1
      for (int c0 = 0; c0 < NCH; c0 += 12) {
        float u[12];
#pragma unroll
        for (int j = 0; j < 12; ++j) u[j] = bp[(size_t)(c0 + j) * USTRIDE];
#pragma unroll
        for (int j = 0; j < 12; ++j) { bp[(size_t)(c0 + j) * USTRIDE] = C; C = dec[c0 + j] * C + scl[c0 + j] * u[j]; }
      }
    }
    __syncthreads();
  }
}
__device__ __forceinline__ void ml_out_unit(const Params& p, int l, int unit, unsigned char* lds) {
  int tid_ = threadIdx.x; asm volatile("" : "+v"(tid_)); const int tid = tid_, lane = tid & 63, wid = tid >> 6, r32 = lane & 31, hi = lane >> 5;
  float* Qt = (float*)lds; float* Kt = Qt + 64 * 65; float* Vt = Kt + 64 * 65;
  float* Cs = Vt + 64 * 65;
  float* Ns = Cs + 2 * 64 * 65;
  float* Bq = Ns + 128;
  float* Gs = Bq + 128;
  float* Mi = Gs + 128;
  float* HB = Mi + 64;
  const bf16_t* PROJ = (const bf16_t*)(p.ws + WS_PROJ);
  const float* GT = (const float*)(p.ws + WS_GATES);
  const float* UL = (const float*)(p.ws + WS_ULOC); const float* META = (const float*)(p.ws + WS_MLMETA);
  bf16_t* MIX = (bf16_t*)(p.ws + WS_MIX);
  const int b = unit / (4 * NCH), hh = (unit / NCH) & 3, ch = unit % NCH;
  const int row0 = b * SEGL + ch * 64;
  ml_load_tile(PROJ + (size_t)row0 * PW + C_MQ + hh * 64, Qt, tid);
  ml_load_tile(PROJ + (size_t)row0 * PW + C_MK + hh * 64, Kt, tid);
  ml_load_tile(PROJ + (size_t)row0 * PW + C_MV + hh * 64, Vt, tid);
  for (int i = tid; i < 2 * USTRIDE; i += 512) {
    const int dir = i / USTRIDE, e = i - dir * USTRIDE;
    const int seq = (b * 4 + hh) * 2 + dir, ci = ml_cidx(ch, dir);
    const float v = UL[((size_t)seq * NCH + ci) * USTRIDE + e];
    if (e < 4096) Cs[dir * 64 * 65 + (e >> 6) * 65 + (e & 63)] = v; else Ns[dir * 64 + (e - 4096)] = v;
  }
  if (wid < 2) {
    const int dir = wid;
    const float ig = GT[(size_t)(row0 + lane) * 16 + (2 * dir) * 4 + hh];
    const float lf = logsigmoidf_(GT[(size_t)(row0 + lane) * 16 + (2 * dir + 1) * 4 + hh]);
    float ps = lf;
#pragma unroll
    for (int o = 1; o < 64; o <<= 1) { const float t = __shfl_up(ps, o); if (lane >= o) ps += t; }
    const float tot = __shfl(ps, 63);
    const float bc = dir == 0 ? ps : (tot - ps + lf);
    Bq[dir * 64 + lane] = bc; Gs[dir * 64 + lane] = ig - bc;
    if (lane == 0) { const int seq = (b * 4 + hh) * 2 + dir, ci = ml_cidx(ch, dir); Mi[dir] = META[((size_t)seq * NCH + ci) * 4 + 2]; }
  }
  __syncthreads();
  {
    const int dir = wid >> 2, tt = (wid >> 1) & 1, et = wid & 1;
    const int t = tt * 32 + r32;
    f32x16 sa[2] = {};
#pragma unroll 4
    for (int ks = 0; ks < 32; ++ks) {
      const float bq = Qt[t * 65 + 2 * ks + hi];
      const float a0 = Kt[(r32) * 65 + 2 * ks + hi], a1 = Kt[(32 + r32) * 65 + 2 * ks + hi];
      sa[0] = __builtin_amdgcn_mfma_f32_32x32x2f32(a0, bq, sa[0], 0, 0, 0);
      sa[1] = __builtin_amdgcn_mfma_f32_32x32x2f32(a1, bq, sa[1], 0, 0, 0);
    }
    const float bt = Bq[dir * 64 + t];
    const float inter = bt + Mi[dir];
    float mx = -INFINITY;
    f32x16 dl[2];
#pragma unroll
    for (int st = 0; st < 2; ++st)
#pragma unroll
      for (int r = 0; r < 16; ++r) {
        const int s = st * 32 + crow(r, hi);
        const bool ok = dir == 0 ? (s <= t) : (s >= t);
        const float d = ok ? bt + Gs[dir * 64 + s] : -INFINITY;
        dl[st][r] = d; mx = fmaxf(mx, d);
      }
    mx = fmaxf(mx, __shfl_xor(mx, 32));
    const float mt = fmaxf(inter, mx);
    const float iw = __expf(inter - mt);
    float rsum = 0.f;
#pragma unroll
    for (int st = 0; st < 2; ++st)
#pragma unroll
      for (int r = 0; r < 16; ++r) { const float w = __expf(dl[st][r] - mt); sa[st][r] *= w; rsum += sa[st][r]; }
    rsum += __shfl_xor(rsum, 32);
    float qn = 0.f;
#pragma unroll 8
    for (int i = 0; i < 32; ++i) { const int d = hi * 32 + i; qn += Ns[dir * 64 + d] * Qt[t * 65 + d]; }
    qn += __shfl_xor(qn, 32);
    const float den = rsum + iw * qn;
    const float rden = 1.f / fmaxf(fabsf(den), __expf(-mt));
    f32x16 an = {}, ac = {};
#pragma unroll
    for (int st = 0; st < 2; ++st)
#pragma unroll
      for (int r = 0; r < 16; ++r) {
        const float a = Vt[(st * 32 + crow(r, hi)) * 65 + et * 32 + r32];
        an = __builtin_amdgcn_mfma_f32_32x32x2f32(a, sa[st][r], an, 0, 0, 0);
      }
    const float* Cd = Cs + dir * 64 * 65;
#pragma unroll 4
    for (int ks = 0; ks < 32; ++ks) {
      const float a = Cd[(et * 32 + r32) * 65 + 2 * ks + hi];
      const float bq = Qt[t * 65 + 2 * ks + hi];
      ac = __builtin_amdgcn_mfma_f32_32x32x2f32(a, bq, ac, 0, 0, 0);
    }
#pragma unroll
    for (int r = 0; r < 16; ++r) HB[dir * 64 * 65 + t * 65 + et * 32 + crow(r, hi)] = (an[r] + iw * ac[r]) * rden;
  }
  __syncthreads();
  {
    const int t = tid >> 3, e8 = (tid & 7) * 8;
    float v[8]; float ss = 0.f;
#pragma unroll
    for (int i = 0; i < 8; ++i) { v[i] = HB[t * 65 + e8 + i] + HB[64 * 65 + t * 65 + e8 + i]; ss += v[i] * v[i]; }
    ss += __shfl_xor(ss, 1); ss += __shfl_xor(ss, 2); ss += __shfl_xor(ss, 4);
    const float rs = rsqrtf(ss * (1.f / 64.f) + EPS);
    const u32x4 ov = *(const u32x4*)(PROJ + (size_t)(row0 + t) * PW + C_MO + hh * 64 + e8);
    const float og[8] = {bflo(ov.x), bfhi(ov.x), bflo(ov.y), bfhi(ov.y), bflo(ov.z), bfhi(ov.z), bflo(ov.w), bfhi(ov.w)};
    const float* g = p.in[I_MNORMG] + l * 64 + e8;
    float o[8];
#pragma unroll
    for (int i = 0; i < 8; ++i) o[i] = (ABL & 2) ? 0.f : v[i] * rs * g[i] * sigmoidf_(og[i]);
    u32x4 w; w.x = cvtpk(o[0], o[1]); w.y = cvtpk(o[2], o[3]); w.z = cvtpk(o[4], o[5]); w.w = cvtpk(o[6], o[7]);
    *(u32x4*)(MIX + (size_t)(row0 + t) * DM + 256 + hh * 64 + e8) = w;
  }
  __syncthreads();
}


#define KSWZ(row, colB) ((row) * 256 + ((colB) ^ (((row) & 15) << 4)))
#define SBAR() __builtin_amdgcn_sched_barrier(0)
constexpr int ATT_SHM_V = 64 * 128 * 2, ATT_SHM_K = 64 * 128 * 2;
constexpr float ATT_THR = 11.541560327111707f;
__device__ __forceinline__ int v_st(int k, int c) { const int kk = (k & ~0xC) | ((k & 4) << 1) | ((k & 8) >> 1); return ((kk >> 3) * 4 + (c >> 5)) * 512 + ((kk & 7) * 32 + (c & 31)) * 2; }
__device__ __forceinline__ int v_rd_base(int lane) { return ((lane & 3) << 3) | (((lane >> 2) & 3) << 6) | (((lane >> 4) & 1) << 5) | (((lane >> 5) & 1) << 8); }
constexpr int v_rd_off(int d0, int ks, int half) { return d0 * 512 + ks * 4096 + half * 2048; }
template <int OFF> __device__ __forceinline__ s16x4 tr_read(int vb) {
  s16x4 r; asm volatile("ds_read_b64_tr_b16 %0, %1 offset:%2" : "=&v"(r) : "v"(vb), "i"(OFF) : "memory"); return r;
}
template <int D0> __device__ __forceinline__ void pv_one(f32x16& od, int vb, bf16x8 pa0, bf16x8 pa1, bf16x8 pa2, bf16x8 pa3) {
  const s16x4 l0 = tr_read<v_rd_off(D0, 0, 0)>(vb), h0 = tr_read<v_rd_off(D0, 0, 1)>(vb), l1 = tr_read<v_rd_off(D0, 1, 0)>(vb), h1 = tr_read<v_rd_off(D0, 1, 1)>(vb);
  const s16x4 l2 = tr_read<v_rd_off(D0, 2, 0)>(vb), h2 = tr_read<v_rd_off(D0, 2, 1)>(vb), l3 = tr_read<v_rd_off(D0, 3, 0)>(vb), h3 = tr_read<v_rd_off(D0, 3, 1)>(vb);
  asm volatile("s_waitcnt lgkmcnt(0)" ::: "memory"); SBAR();
#define PK(L, H) (bf16x8){L[0], L[1], L[2], L[3], H[0], H[1], H[2], H[3]}
  od = __builtin_amdgcn_mfma_f32_32x32x16_bf16(pa0, PK(l0, h0), od, 0, 0, 0);
  od = __builtin_amdgcn_mfma_f32_32x32x16_bf16(pa1, PK(l1, h1), od, 0, 0, 0);
  od = __builtin_amdgcn_mfma_f32_32x32x16_bf16(pa2, PK(l2, h2), od, 0, 0, 0);
  od = __builtin_amdgcn_mfma_f32_32x32x16_bf16(pa3, PK(l3, h3), od, 0, 0, 0);
#undef PK
}
__device__ __forceinline__ void att_qkt(f32x16& p0, f32x16& p1, const unsigned char* Ks, const unsigned char* Qs, int qrow, int comp, int r32, int hi) {
  p0 = f32x16{}; p1 = f32x16{};
#pragma unroll
  for (int d0 = 0; d0 < 4; ++d0) {
    const int cb = ((comp * 4 + d0) * 16 + hi * 8) * 2;
    const bf16x8 b0 = *(const bf16x8*)(Ks + KSWZ(r32, cb));
    const bf16x8 b1 = *(const bf16x8*)(Ks + KSWZ(32 + r32, cb));
    const bf16x8 q = *(const bf16x8*)(Qs + KSWZ(qrow, cb));
    p0 = __builtin_amdgcn_mfma_f32_32x32x16_bf16(b0, q, p0, 0, 0, 0);
    p1 = __builtin_amdgcn_mfma_f32_32x32x16_bf16(b1, q, p1, 0, 0, 0);
  }
}
__device__ __forceinline__ void att_softmax(f32x16& p0, f32x16& p1, float& m_reg, float& l_reg, float& alpha, bf16x8& pa0, bf16x8& pa1, bf16x8& pa2, bf16x8& pa3) {
  float pmax = p0[0];
#pragma unroll
  for (int r = 1; r < 16; ++r) pmax = fmaxf(pmax, p0[r]);
#pragma unroll
  for (int r = 0; r < 16; ++r) pmax = fmaxf(pmax, p1[r]);
  { auto rr = __builtin_amdgcn_permlane32_swap(__float_as_uint(pmax), __float_as_uint(pmax), false, false);
    pmax = fmaxf(__uint_as_float(rr[0]), __uint_as_float(rr[1])); }
  float mn;
  if (__builtin_expect(__all(pmax - m_reg <= ATT_THR), 1)) { mn = m_reg; alpha = 1.f; }
  else { mn = fmaxf(m_reg, pmax); alpha = __builtin_amdgcn_exp2f(m_reg - mn); m_reg = mn; }
#pragma unroll
  for (int r = 0; r < 16; ++r) { p0[r] = __builtin_amdgcn_exp2f(p0[r] - mn); p1[r] = __builtin_amdgcn_exp2f(p1[r] - mn); }
  float ps = 0.f;
#pragma unroll
  for (int r = 0; r < 16; ++r) ps += p0[r];
#pragma unroll
  for (int r = 0; r < 16; ++r) ps += p1[r];
  { auto rr = __builtin_amdgcn_permlane32_swap(__float_as_uint(ps), __float_as_uint(ps), false, false);
    ps = __uint_as_float(rr[0]) + __uint_as_float(rr[1]); }
  l_reg = l_reg * alpha + ps;
#define PK4(P, BASE, OUT) do { unsigned a0 = cvtpk(P[BASE + 0], P[BASE + 1]), a1 = cvtpk(P[BASE + 2], P[BASE + 3]);   \
    unsigned b0 = cvtpk(P[BASE + 4], P[BASE + 5]), b1 = cvtpk(P[BASE + 6], P[BASE + 7]);                              \
    auto r0 = __builtin_amdgcn_permlane32_swap(a0, b0, false, false); auto r1 = __builtin_amdgcn_permlane32_swap(a1, b1, false, false); \
    u32x4 w = {r0[0], r1[0], r0[1], r1[1]}; OUT = *reinterpret_cast<bf16x8*>(&w); } while (0)
  PK4(p0, 0, pa0); PK4(p0, 8, pa1); PK4(p1, 0, pa2); PK4(p1, 8, pa3);
#undef PK4
}
__device__ __forceinline__ void att_unit(const bf16_t* __restrict__ Qb, const bf16_t* __restrict__ Kh, const bf16_t* __restrict__ Vh, bf16_t* __restrict__ Ob,
                                         int nkeys, float lam, const float* __restrict__ ng, float oscale, unsigned char* lds) {
  int tid_ = threadIdx.x; asm volatile("" : "+v"(tid_)); const int tid = tid_, wid = tid >> 6, lane = tid & 63, r32 = lane & 31, hi = lane >> 5;
  unsigned char* V_lds = lds; unsigned char* K_lds = lds + 2 * ATT_SHM_V;
  float* wsl = (float*)(lds + 2 * ATT_SHM_V + 2 * ATT_SHM_K) + wid * 64; float* li_l = wsl; float* al_l = wsl + 32;
  float m0 = -1e30f, l0 = 0.f, m1 = -1e30f, l1 = 0.f;
  f32x16 o0[4] = {}, o1[4] = {};
  unsigned char* Q_lds = lds + 2 * ATT_SHM_V + 2 * ATT_SHM_K + 2048;
#pragma unroll
  for (int i = 0; i < 8; ++i) { const int id = tid + 512 * i, qrw = id >> 4, ch = id & 15;
    *(bf16x8*)(Q_lds + KSWZ(qrw, ch * 16)) = *(const bf16x8*)(Qb + (size_t)qrw * PW + ch * 8); }
  const int qrow = wid * 32 + r32;
  const int sr = tid >> 4, sc = (tid & 15) * 8, vst0 = v_st(sr, sc), vst1 = v_st(32 + sr, sc);
  const int vb0 = (int)(uintptr_t)V_lds + v_rd_base(lane);
  bf16x8 vs0, vs1, ks0, ks1;
#define SLOAD(k0) do { vs0 = *(const bf16x8*)(Vh + (size_t)((k0) + sr) * PW + sc); vs1 = *(const bf16x8*)(Vh + (size_t)((k0) + 32 + sr) * PW + sc); \
    ks0 = *(const bf16x8*)(Kh + (size_t)((k0) + sr) * PW + sc); ks1 = *(const bf16x8*)(Kh + (size_t)((k0) + 32 + sr) * PW + sc); } while (0)
#define SWRITE(b) do { *(bf16x8*)(V_lds + (b) * ATT_SHM_V + vst0) = vs0; *(bf16x8*)(V_lds + (b) * ATT_SHM_V + vst1) = vs1; const int kc = sc * 2; \
    *(bf16x8*)(K_lds + (b) * ATT_SHM_K + KSWZ(sr, kc)) = ks0; *(bf16x8*)(K_lds + (b) * ATT_SHM_K + KSWZ(32 + sr, kc)) = ks1; } while (0)
#define RESC(o, a) do { if (__any((a) < 1.f)) { if (hi == 0) al_l[r32] = (a); asm volatile("s_waitcnt lgkmcnt(0)" ::: "memory"); \
    _Pragma("unroll") for (int d = 0; d < 4; ++d) _Pragma("unroll") for (int r = 0; r < 16; ++r) o[d][r] *= al_l[crow(r, hi)]; } } while (0)
  const int NT = nkeys / 64;
  SLOAD(0); SWRITE(0); __syncthreads();
  for (int j = 0; j < NT; ++j) {
    const int cur = j & 1;
    if (j + 1 < NT) SLOAD((j + 1) * 64);
    const unsigned char* Kc = K_lds + cur * ATT_SHM_K; const int vb = vb0 + cur * ATT_SHM_V;
    f32x16 p0, p1; float alpha; bf16x8 pa0, pa1, pa2, pa3;
    att_qkt(p0, p1, Kc, Q_lds, qrow, 0, r32, hi);
    att_softmax(p0, p1, m0, l0, alpha, pa0, pa1, pa2, pa3);
    RESC(o0, alpha);
    pv_one<0>(o0[0], vb, pa0, pa1, pa2, pa3); pv_one<1>(o0[1], vb, pa0, pa1, pa2, pa3); pv_one<2>(o0[2], vb, pa0, pa1, pa2, pa3); pv_one<3>(o0[3], vb, pa0, pa1, pa2, pa3);
    att_qkt(p0, p1, Kc, Q_lds, qrow, 1, r32, hi);
    att_softmax(p0, p1, m1, l1, alpha, pa0, pa1, pa2, pa3);
    RESC(o1, alpha);
    pv_one<0>(o1[0], vb, pa0, pa1, pa2, pa3); pv_one<1>(o1[1], vb, pa0, pa1, pa2, pa3); pv_one<2>(o1[2], vb, pa0, pa1, pa2, pa3); pv_one<3>(o1[3], vb, pa0, pa1, pa2, pa3);
    if (j + 1 < NT) SWRITE(cur ^ 1);
    __syncthreads();
  }
  if (hi == 0) { li_l[r32] = 1.f / l0; al_l[r32] = lam / l1; }
  asm volatile("s_waitcnt lgkmcnt(0)" ::: "memory");
  float ss[16];
#pragma unroll
  for (int r = 0; r < 16; ++r) {
    const float a = li_l[crow(r, hi)], bq = al_l[crow(r, hi)];
    float s = 0.f;
#pragma unroll
    for (int d = 0; d < 4; ++d) { const float v = o0[d][r] * a - o1[d][r] * bq; o0[d][r] = v; s += v * v; }
    s += __shfl_xor(s, 1); s += __shfl_xor(s, 2); s += __shfl_xor(s, 4); s += __shfl_xor(s, 8); s += __shfl_xor(s, 16);
    ss[r] = rsqrtf(s * (1.f / 128.f) + EPS) * oscale;
  }
  bf16_t* Ow = Ob + (size_t)(wid * 32) * DM;
#pragma unroll
  for (int d = 0; d < 4; ++d) {
    const float g = ng[d * 32 + r32];
#pragma unroll
    for (int r = 0; r < 16; ++r) Ow[(size_t)crow(r, hi) * DM + d * 32 + r32] = (ABL & 4) ? (bf16_t)0 : (bf16_t)(cvtpk(o0[d][r] * ss[r] * g, 0.f) & 0xffffu);
  }
  __syncthreads();
#undef SLOAD
#undef SWRITE
#undef RESC
}

__device__ __forceinline__ float ins16(float (&a)[16], float x) {
#pragma unroll
  for (int i = 0; i < 16; ++i) { const float h = fmaxf(a[i], x); x = fminf(a[i], x); a[i] = h; }
  return x;
}
__device__ __forceinline__ float gelu_erf(float x) { return 0.5f * x * (1.f + erff(x * 0.70710678118654752440f)); }
__device__ __forceinline__ void peer_unit(const Params& p, int l, int unit, unsigned char* lds) {
  int tid_ = threadIdx.x; asm volatile("" : "+v"(tid_)); const int tid = tid_, lane = tid & 63, wid = tid >> 6, r32 = lane & 31, hi = lane >> 5;
  int* EID = (int*)lds;
  float* GW = (float*)(lds + 16384);
  float* SUQ = (float*)(lds + 32768);
  unsigned char* IDX = lds + 49152;
  const float* PSC = (const float*)(p.ws + WS_PSC);
  const int row0 = unit * 32;
  const bf16_t* QP = (const bf16_t*)(p.ws + WS_PROJ);
  const bf16_t* KEYS = (const bf16_t*)(p.ws + WS_KEYS) + (size_t)l * 131072;
  for (int rrep = 0; rrep < REP_ROUTE; ++rrep) {
    const int h = wid;
    float top[2][16];
#pragma unroll
    for (int pp = 0; pp < 2; ++pp) {
      const bf16_t* qrow = QP + (size_t)(row0 + r32) * DM + h * 128 + pp * 64 + hi * 8;
      const bf16_t* kb = KEYS + ((size_t)(h * 2 + pp) * 128 + r32) * 64 + hi * 8;
      bf16x8 bq[4];
#pragma unroll
      for (int ks = 0; ks < 4; ++ks) bq[ks] = *(const bf16x8*)(qrow + ks * 16);
      float (&lst)[16] = top[pp];
#pragma unroll
      for (int i = 0; i < 16; ++i) lst[i] = -INFINITY;
#pragma unroll
      for (int nt = 0; nt < 4; ++nt) {
        f32x16 acc = {};
#pragma unroll
        for (int ks = 0; ks < 4; ++ks) {
          const bf16x8 ak = *(const bf16x8*)(kb + (size_t)nt * 32 * 64 + ks * 16);
          acc = __builtin_amdgcn_mfma_f32_32x32x16_bf16(ak, bq[ks], acc, 0, 0, 0);
        }
#pragma unroll
        for (int r = 0; r < 16; ++r) {
          const unsigned key = (__float_as_uint(acc[r]) & ~0x7Fu) | (unsigned)(nt * 32 + crow(r, hi));
          ins16(lst, __uint_as_float(key));
        }
        SBAR();
      }
      float oth[16];
#pragma unroll
      for (int i = 0; i < 16; ++i) oth[i] = __shfl_xor(lst[i], 32);
#pragma unroll
      for (int i = 0; i < 16; ++i) ins16(lst, oth[i]);
      if (hi == 0) {
        unsigned w[4];
#pragma unroll
        for (int i = 0; i < 4; ++i)
          w[i] = (__float_as_uint(lst[4 * i]) & 0x7Fu) | ((__float_as_uint(lst[4 * i + 1]) & 0x7Fu) << 8) | ((__float_as_uint(lst[4 * i + 2]) & 0x7Fu) << 16) | ((__float_as_uint(lst[4 * i + 3]) & 0x7Fu) << 24);
        *(u32x4*)(IDX + ((r32 * 8 + h) * 2 + pp) * 16) = (u32x4){w[0], w[1], w[2], w[3]};
      }
    }
    float best[16];
#pragma unroll
    for (int i = 0; i < 16; ++i) best[i] = -INFINITY;
#pragma unroll
    for (int i = 0; i < 16; ++i)
#pragma unroll
      for (int j = 0; j < 16; ++j)
        if ((i + 1) * (j + 1) <= 16) {
          const float s = __uint_as_float(__float_as_uint(top[0][i]) & ~0x7Fu) + __uint_as_float(__float_as_uint(top[1][j]) & ~0x7Fu);
          ins16(best, __uint_as_float((__float_as_uint(s) & ~0xFFu) | (unsigned)(i * 16 + j)));
        }
    asm volatile("s_waitcnt lgkmcnt(0)" ::: "memory");
    if (hi == 0) {
      const unsigned char* ib = IDX + ((r32 * 8 + h) * 2) * 16;
      const float mx = __uint_as_float(__float_as_uint(best[0]) & ~0xFFu);
      float w[16]; float sum = 0.f;
#pragma unroll
      for (int k = 0; k < 16; ++k) { w[k] = __expf(__uint_as_float(__float_as_uint(best[k]) & ~0xFFu) - mx); sum += w[k]; }
      const float rsum = 1.f / sum;
#pragma unroll
      for (int k = 0; k < 16; ++k) {
        const unsigned ij = __float_as_uint(best[k]) & 0xFFu;
        const int e = (int)ib[ij >> 4] * 128 + (int)ib[16 + (ij & 15)];
        EID[r32 * 128 + h * 16 + k] = e; GW[r32 * 128 + h * 16 + k] = w[k] * rsum * PSC[(size_t)(DEPTH + l) * NEXP + e];
        SUQ[r32 * 128 + h * 16 + k] = PSC[(size_t)l * NEXP + e];
      }
    }
  }
  __syncthreads();
  const bf16_t* H = (const bf16_t*)(p.ws + WS_H);
  const unsigned char* PUq = p.ws + WS_PU + (size_t)l * NEXP * DM;
  const unsigned char* PVq = p.ws + WS_PV + (size_t)l * NEXP * DM;
  float* XC = (float*)(p.ws + WS_XCUR);
  const float* MOD = (const float*)(p.ws + WS_MOD);
  for (int tt = 0; tt < 4; ++tt) {
    const int t = wid * 4 + tt, row = row0 + t;
    float hf[16];
    {
      const u32x4 hA = *(const u32x4*)(H + (size_t)row * DM + lane * 16), hB = *(const u32x4*)(H + (size_t)row * DM + lane * 16 + 8);
      hf[0] = bflo(hA.x); hf[1] = bfhi(hA.x); hf[2] = bflo(hA.y); hf[3] = bfhi(hA.y); hf[4] = bflo(hA.z); hf[5] = bfhi(hA.z); hf[6] = bflo(hA.w); hf[7] = bfhi(hA.w);
      hf[8] = bflo(hB.x); hf[9] = bfhi(hB.x); hf[10] = bflo(hB.y); hf[11] = bfhi(hB.y); hf[12] = bflo(hB.z); hf[13] = bfhi(hB.z); hf[14] = bflo(hB.w); hf[15] = bfhi(hB.w);
    }
    float acc[16];
    for (int rep = 0; rep < REP_PEER; ++rep) {
#pragma unroll
    for (int i = 0; i < 16; ++i) acc[i] = 0.f;
    u32x4 uq[8];
#pragma unroll
    for (int i = 0; i < 8; ++i) { const int e0 = __builtin_amdgcn_readfirstlane(EID[t * 128 + i]); uq[i] = *(const u32x4*)(PUq + (size_t)e0 * DM + lane * 16); }
    for (int g8 = 0; g8 < 16; ++g8) {
      int eid[8]; float gwt[8]; u32x4 vq[8];
#pragma unroll
      for (int i = 0; i < 8; ++i) {
        eid[i] = __builtin_amdgcn_readfirstlane(EID[t * 128 + g8 * 8 + i]);
        gwt[i] = __uint_as_float(__builtin_amdgcn_readfirstlane(__float_as_uint(GW[t * 128 + g8 * 8 + i])));
        vq[i] = *(const u32x4*)(PVq + (size_t)eid[i] * DM + lane * 16);
      }
      float d[8];
#pragma unroll
      for (int i = 0; i < 8; ++i) {
        const float su = __uint_as_float(__builtin_amdgcn_readfirstlane(__float_as_uint(SUQ[t * 128 + g8 * 8 + i])));
        float a0 = 0.f, a1 = 0.f;
#define DQ(W, K) { const f32x2 lo_ = __builtin_amdgcn_cvt_pk_f32_fp8((int)(W), false), hi_ = __builtin_amdgcn_cvt_pk_f32_fp8((int)(W), true); \
          a0 += lo_.x * hf[K]; a1 += lo_.y * hf[K + 1]; a0 += hi_.x * hf[K + 2]; a1 += hi_.y * hf[K + 3]; }
        DQ(uq[i].x, 0) DQ(uq[i].y, 4) DQ(uq[i].z, 8) DQ(uq[i].w, 12)
#undef DQ
        d[i] = (a0 + a1) * su;
      }
      if (g8 < 15) {
#pragma unroll
        for (int i = 0; i < 8; ++i) { const int e0 = __builtin_amdgcn_readfirstlane(EID[t * 128 + (g8 + 1) * 8 + i]); uq[i] = *(const u32x4*)(PUq + (size_t)e0 * DM + lane * 16); }
      }
      float tot;
      {
        auto s01 = __builtin_amdgcn_permlane32_swap(__float_as_uint(d[0]), __float_as_uint(d[1]), false, false);
        auto s23 = __builtin_amdgcn_permlane32_swap(__float_as_uint(d[2]), __float_as_uint(d[3]), false, false);
        auto s45 = __builtin_amdgcn_permlane32_swap(__float_as_uint(d[4]), __float_as_uint(d[5]), false, false);
        auto s67 = __builtin_amdgcn_permlane32_swap(__float_as_uint(d[6]), __float_as_uint(d[7]), false, false);
        const float q01 = __uint_as_float(s01[0]) + __uint_as_float(s01[1]), q23 = __uint_as_float(s23[0]) + __uint_as_float(s23[1]);
        const float q45 = __uint_as_float(s45[0]) + __uint_as_float(s45[1]), q67 = __uint_as_float(s67[0]) + __uint_as_float(s67[1]);
        auto ta = __builtin_amdgcn_permlane16_swap(__float_as_uint(q01), __float_as_uint(q23), false, false);
        auto tb = __builtin_amdgcn_permlane16_swap(__float_as_uint(q45), __float_as_uint(q67), false, false);
        const float r0123 = __uint_as_float(ta[0]) + __uint_as_float(ta[1]);
        const float r4567 = __uint_as_float(tb[0]) + __uint_as_float(tb[1]);
        const bool b3 = (lane & 8) != 0;
        const float keep = b3 ? r4567 : r0123, send = b3 ? r0123 : r4567;
        float x = keep + __shfl_xor(send, 8);
        x += __shfl_xor(x, 4); x += __shfl_xor(x, 2); x += __shfl_xor(x, 1);
        tot = x;
      }
      float ge;
      {
        const float v = tot, av = fabsf(v), tq = __builtin_amdgcn_rcpf(av * 0.2316418882f + 1.0f);
        float q = tq * 0.5307027145f + (-0.7265760135f); q = q * tq + 0.7107068705f; q = q * tq + (-0.142248368f); q = q * tq + 0.127414796f; q = q * tq;
        const float ex = __builtin_amdgcn_exp2f(v * v * (-0.72134752044f));
        const float m = v * (q * ex), r = v - m;
        ge = v < 0.f ? m : r;
      }
      float c[8];
      c[0] = __uint_as_float(__builtin_amdgcn_readlane(__float_as_uint(ge), 0)) * gwt[0];  c[4] = __uint_as_float(__builtin_amdgcn_readlane(__float_as_uint(ge), 8)) * gwt[4];
      c[2] = __uint_as_float(__builtin_amdgcn_readlane(__float_as_uint(ge), 16)) * gwt[2]; c[6] = __uint_as_float(__builtin_amdgcn_readlane(__float_as_uint(ge), 24)) * gwt[6];
      c[1] = __uint_as_float(__builtin_amdgcn_readlane(__float_as_uint(ge), 32)) * gwt[1]; c[5] = __uint_as_float(__builtin_amdgcn_readlane(__float_as_uint(ge), 40)) * gwt[5];
      c[3] = __uint_as_float(__builtin_amdgcn_readlane(__float_as_uint(ge), 48)) * gwt[3]; c[7] = __uint_as_float(__builtin_amdgcn_readlane(__float_as_uint(ge), 56)) * gwt[7];
#pragma unroll
      for (int i = 0; i < 8; ++i) {
#define AQ(W, K) { const f32x2 lo_ = __builtin_amdgcn_cvt_pk_f32_fp8((int)(W), false), hi_ = __builtin_amdgcn_cvt_pk_f32_fp8((int)(W), true); \
          acc[K] += c[i] * lo_.x; acc[K + 1] += c[i] * lo_.y; acc[K + 2] += c[i] * hi_.x; acc[K + 3] += c[i] * hi_.y; }
        AQ(vq[i].x, 0) AQ(vq[i].y, 4) AQ(vq[i].z, 8) AQ(vq[i].w, 12)
#undef AQ
      }
    }
    }
    const int mr = mod_row(row);
    const float* g2 = MOD + ((size_t)l * 5 + mr) * 6144 + 5 * 1024;
    float* xr = XC + (size_t)row * DM;
    float xn[16]; float ssq = 0.f;
    if (ABL & 8) {
#pragma unroll
      for (int i = 0; i < 16; ++i) acc[i] = 0.f;
    }
#pragma unroll
    for (int v4 = 0; v4 < 4; ++v4) {
      const int c = lane * 16 + v4 * 4;
      const f32x4 xo = *(const f32x4*)(xr + c), gg = *(const f32x4*)(g2 + c);
      f32x4 o;
      o.x = xo.x + gg.x * acc[v4 * 4 + 0]; o.y = xo.y + gg.y * acc[v4 * 4 + 1]; o.z = xo.z + gg.z * acc[v4 * 4 + 2]; o.w = xo.w + gg.w * acc[v4 * 4 + 3];
      xn[v4 * 4 + 0] = o.x; xn[v4 * 4 + 1] = o.y; xn[v4 * 4 + 2] = o.z; xn[v4 * 4 + 3] = o.w;
      ssq += (o.x * o.x + o.y * o.y) + (o.z * o.z + o.w * o.w);
      if (l < DEPTH - 1) *(f32x4*)(xr + c) = o;
    }
    const float rs = rsqrtf(wave_sum(ssq) * (1.f / DM) + EPS);
    if (l == DEPTH - 1) {
      const int b = row / SEGL, s = row - b * SEGL;
      float* orow = p.out + ((size_t)(b * SEQ + (s - CTXL))) * DM;
      const float* fg = p.in[I_FINALG];
#pragma unroll
      for (int v4 = 0; v4 < 4; ++v4) {
        const int c = lane * 16 + v4 * 4;
        const f32x4 gg = *(const f32x4*)(fg + c);
        f32x4 o; o.x = xn[v4 * 4 + 0] * rs * gg.x; o.y = xn[v4 * 4 + 1] * rs * gg.y; o.z = xn[v4 * 4 + 2] * rs * gg.z; o.w = xn[v4 * 4 + 3] * rs * gg.w;
        *(f32x4*)(orow + c) = o;
      }
    } else {
      const float* m = MOD + ((size_t)(l + 1) * 5 + mr) * 6144;
      const float* ng = p.in[I_N1G] + (l + 1) * DM;
      bf16_t* hrow = (bf16_t*)(p.ws + WS_H) + (size_t)row * DM;
#pragma unroll
      for (int hh = 0; hh < 2; ++hh) {
        float y[8];
#pragma unroll
        for (int i = 0; i < 8; ++i) { const int c = lane * 16 + hh * 8 + i; y[i] = xn[hh * 8 + i] * rs * ng[c] * (1.f + m[1024 + c]) + m[c]; }
        u32x4 w; w.x = cvtpk(y[0], y[1]); w.y = cvtpk(y[2], y[3]); w.z = cvtpk(y[4], y[5]); w.w = cvtpk(y[6], y[7]);
        *(u32x4*)(hrow + lane * 16 + hh * 8) = w;
      }
    }
  }
  __syncthreads();
}

#define LAS __attribute__((address_space(3)))
#define XB_TMO      128
#define XB_XCNT(j)  (256  + 64 * (j))
#define XB_XSUB(j)  (1280 + 64 * (j))
#define XB_XGEN(j)  (2304 + 64 * (j))
#define XB_TOP      3328
#define XB_TOPGEN   3392
#define XCD_BAR_WORDS 3456
#define XB_SPIN_CAP (1u << 22)
__device__ __forceinline__ unsigned xb_ld(unsigned* p)              { return __hip_atomic_load(p, __ATOMIC_RELAXED, __HIP_MEMORY_SCOPE_AGENT); }
__device__ __forceinline__ unsigned xb_add(unsigned* p, unsigned v) { return __hip_atomic_fetch_add(p, v, __ATOMIC_RELAXED, __HIP_MEMORY_SCOPE_AGENT); }
__device__ __forceinline__ unsigned xb_xcc_id() { return (unsigned)__builtin_amdgcn_s_getreg((3 << 11) | 20) & 0xFu; }
#define XB_SPIN(cond, bar) do { unsigned _sp = 0; while (cond) { __builtin_amdgcn_s_sleep(1); \
    if ((++_sp & 255u) == 0u) { if (xb_ld(&(bar)[XB_TMO])) break; if (_sp > XB_SPIN_CAP) { atomicAdd(&(bar)[XB_TMO], 1u); break; } } } } while (0)
struct XcdBarrier { unsigned* bar; unsigned x; volatile LAS unsigned* st; };
__device__ __forceinline__ XcdBarrier xcd_barrier_post(unsigned* bar, volatile LAS unsigned* st) {
  XcdBarrier b; b.bar = bar; b.x = xb_xcc_id(); b.st = st;
  if (threadIdx.x == 0) (void)xb_add(&bar[XB_XCNT(b.x)], 1u);
  return b;
}
__device__ __forceinline__ void xcd_barrier_complete(unsigned* bar, unsigned x, unsigned& nloc, unsigned& nx) {
  const unsigned G = gridDim.x * gridDim.y * gridDim.z;
  unsigned sum, cnt, mine, sp = 0u;
  for (;;) {
    sum = 0u; cnt = 0u; mine = 0u;
#pragma unroll
    for (unsigned j = 0; j < 16; ++j) { const unsigned c = xb_ld(&bar[XB_XCNT(j)]); sum += c; cnt += (c > 0u) ? 1u : 0u; mine = (j == x) ? c : mine; }
    if (sum == G) break;
    __builtin_amdgcn_s_sleep(1);
    if ((++sp & 255u) == 0u) { if (xb_ld(&bar[XB_TMO])) break; if (sp > XB_SPIN_CAP) { atomicAdd(&bar[XB_TMO], 1u); break; } }
  }
  nloc = mine > 0u ? mine : 1u; nx = cnt > 0u ? cnt : 1u;
}
__device__ __forceinline__ void xcd_barrier(const XcdBarrier& b) {
  asm volatile("s_waitcnt vmcnt(0)" ::: "memory");
  __syncthreads();
  if (threadIdx.x == 0) {
    unsigned* bar = b.bar;
    __builtin_amdgcn_s_waitcnt(0);
    unsigned nloc = b.st[0], nx = b.st[1];
    if (nloc == 0u) { xcd_barrier_complete(bar, b.x, nloc, nx); b.st[0] = nloc; b.st[1] = nx; }
    const unsigned old = xb_add(&bar[XB_XSUB(b.x)], 1u);
    const unsigned gen = old / nloc;
    if (old + 1u == (gen + 1u) * nloc) {
      __builtin_amdgcn_fence(__ATOMIC_RELEASE, "agent");
      asm volatile("s_waitcnt vmcnt(0)" ::: "memory");
      const unsigned og = xb_add(&bar[XB_TOP], 1u);
      const unsigned tg = og / nx;
      if (og + 1u == (tg + 1u) * nx) xb_add(&bar[XB_TOPGEN], 1u);
      else XB_SPIN(xb_ld(&bar[XB_TOPGEN]) == tg, bar);
      __builtin_amdgcn_fence(__ATOMIC_ACQUIRE, "agent");
      xb_add(&bar[XB_XGEN(b.x)], 1u);
      asm volatile("s_waitcnt vmcnt(0)" ::: "memory");
    } else {
      XB_SPIN(xb_ld(&bar[XB_XGEN(b.x)]) == gen, bar);
      __builtin_amdgcn_fence(__ATOMIC_ACQUIRE, "agent");
      asm volatile("s_waitcnt vmcnt(0)" ::: "memory");
    }
  }
  __syncthreads();
}

__device__ __forceinline__ void phase_c1(const Params& p, int l, unsigned char* lds) {
  constexpr int NLOC = NBATCH * 4 * NCH, NCONV = T / 32;
  for (int u = blockIdx.x; u < NLOC + NCONV; u += gridDim.x) {
    if (u < NLOC) ml_local_unit(p, l, u, lds);
    else {
      const int cu = u - NLOC;
      if (l == DEPTH - 1 && (cu % (SEGL / 32)) < (CTXL / 32)) continue;
      conv_unit(p, l, cu, lds);
    }
  }
}
__device__ __forceinline__ void phase_c2(const Params& p, int l, unsigned char* lds) {
  ml_scan(p, lds);
  const float* lp = p.in[I_DLAM] + l * 256;
  float s01 = 0.f, s23 = 0.f;
  for (int i = 0; i < 64; ++i) { s01 += lp[i] * lp[64 + i]; s23 += lp[128 + i] * lp[192 + i]; }
  const float lam_init = 0.8f - 0.6f * expf(-0.3f * (float)l);
  const float lam = expf(s01) - expf(s23) + lam_init;
  const bf16_t* PROJ = (const bf16_t*)(p.ws + WS_PROJ);
  bf16_t* MIX = (bf16_t*)(p.ws + WS_MIX);
  const float* ng = p.in[I_DNORMG] + l * 128;
  const int nun = 512 + (l < DEPTH - 1 ? 16 : 0);
  for (int u = blockIdx.x; u < nun; u += gridDim.x) {
    int bh, qrow, nkeys;
    if (u < 512) { const int xcd = u & 7, i = (u >> 3) & 31, rnd = u >> 8; bh = 2 * xcd + rnd; qrow = CTXL + i * 256; nkeys = SEGL; }
    else { bh = u - 512; qrow = 0; nkeys = CTXL; }
    const int b = bh >> 2, h = bh & 3;
    const size_t tok0 = (size_t)b * SEGL;
    for (int rep = 0; rep < REP_ATT; ++rep)
    att_unit(PROJ + (tok0 + qrow) * PW + C_DQ + h * 128, PROJ + tok0 * PW + C_DK + h * 128, PROJ + tok0 * PW + C_DV + h * 128,
             MIX + (tok0 + qrow) * DM + 512 + h * 128, nkeys, lam, ng, 1.f - lam_init, lds);
  }
}
__device__ __forceinline__ void phase_c3(const Params& p, int l, unsigned char* lds) {
  constexpr int NU = NBATCH * 4 * NCH;
  for (int u = blockIdx.x; u < NU; u += gridDim.x) {
    if (l == DEPTH - 1 && (u % NCH) < 4) continue;
    ml_out_unit(p, l, u, lds);
  }
}
__device__ __forceinline__ void phase_peer(const Params& p, int l, unsigned char* lds) {
  constexpr int NU = T / 32;
  for (int u = blockIdx.x; u < NU; u += gridDim.x) {
    if (l == DEPTH - 1 && (u % (SEGL / 32)) < (CTXL / 32)) continue;
    peer_unit(p, l, u, lds);
  }
}

__global__ void __launch_bounds__(512, 2) mk_fwd(Params p) {
  cg::grid_group grid = cg::this_grid();
  extern __shared__ __attribute__((aligned(16))) unsigned char lds[];
  const int lo = p.ph_lo, hi = p.ph_hi;
#define IN(k) (lo <= (k) && (k) < hi)
#ifndef PHASEMASK
#define PHASEMASK 0xFFFF
#endif
#define PH(i) ((PHASEMASK >> (i)) & 1)
#define SEAM(k) do { if (IN(k) && IN((k) + 1)) { if ((k) == 0) grid.sync(); else { XcdBarrier xb_ = xbar; unsigned* bp_ = xb_.bar; asm volatile("" : "+s"(bp_)); xb_.bar = bp_; xcd_barrier(xb_); } } } while (0)
  volatile LAS unsigned* xst = (volatile LAS unsigned*)((LAS unsigned char*)lds + (LDS_BYTES - 64));
  if (threadIdx.x < 2) xst[threadIdx.x] = 0u;
  __syncthreads();
  XcdBarrier xbar = xcd_barrier_post((unsigned*)(p.ws + WS_CTL) + 4096, xst);
  if (PH(0) && IN(0)) for (int rep = 0; rep < REP_MISC; ++rep) { p0_mod(p, lds, (float*)(p.ws + WS_MOD)); p0_convert(p, lds); }
  SEAM(0);
  if (PH(1) && IN(1)) phase_norm(p, 0, 0, true, false);
  SEAM(1);
#pragma unroll 1
  for (int l_ = 0; l_ < DEPTH; ++l_) {
    int l = l_; asm volatile("" : "+s"(l));
    const int b = 2 + 8 * l;
    unsigned char* wsl = p.ws; asm volatile("" : "+s"(wsl));
    Params q = p; q.ws = wsl;
    if (PH(2) && IN(b + 0)) for (int rep = 0; rep < REP_GEMM; ++rep) phase_inproj2(q, l, lds);
    SEAM(b + 0);
    if (PH(3) && IN(b + 1)) for (int rep = 0; rep < REP_ML; ++rep) phase_c1(q, l, lds);
    SEAM(b + 1);
    if (PH(4) && IN(b + 2)) phase_c2(q, l, lds);
    SEAM(b + 2);
    if (PH(5) && IN(b + 3)) for (int rep = 0; rep < REP_ML; ++rep) phase_c3(q, l, lds);
    SEAM(b + 3);
    if (PH(6) && IN(b + 4)) phase_outproj2(q, l, lds);
    SEAM(b + 4);
    if (PH(7) && IN(b + 5)) for (int rep = 0; rep < REP_MISC; ++rep) phase_norm(q, l, 1, false, l == DEPTH - 1);
    SEAM(b + 5);
    if (PH(8) && IN(b + 6)) for (int rep = 0; rep < REP_GEMM; ++rep) phase_peerq2(q, l, lds);
    SEAM(b + 6);
    if (PH(9) && IN(b + 7)) phase_peer(q, l, lds);
    SEAM(b + 7);
  }
#undef IN
#undef SEAM
}

extern "C" void kernel_launch(void* const* d_in, const int* in_sizes, int n_in, void* d_out, int out_size,
                              void* d_ws, size_t ws_size, hipStream_t stream) {
  static int grid = 0;
  if (grid == 0) {
    int dev = 0, cus = 0, per_cu = 0;
    (void)hipGetDevice(&dev);
    (void)hipDeviceGetAttribute(&cus, hipDeviceAttributeMultiprocessorCount, dev);
    (void)hipFuncSetAttribute((const void*)mk_fwd, hipFuncAttributeMaxDynamicSharedMemorySize, LDS_BYTES);
    (void)hipOccupancyMaxActiveBlocksPerMultiprocessor(&per_cu, (const void*)mk_fwd, 512, LDS_BYTES);
    fprintf(stderr, "kernel_launch: cus %d per_cu %d ws %zu (need %zu) n_in %d\n", cus, per_cu, ws_size, (size_t)WS_END, n_in);
    if (ws_size < WS_END || n_in != 23 || per_cu < 1) { fprintf(stderr, "kernel_launch: bad configuration, nothing launched\n"); grid = -1; return; }
    grid = cus;
  }
  if (grid < 0) return;
  (void)hipMemsetAsync((char*)d_ws + WS_CTL, 0, 65536, stream);
  Params p{};
  for (int i = 0; i < 23; ++i) p.in[i] = (const float*)d_in[i];
  p.out = (float*)d_out; p.ws = (unsigned char*)d_ws; p.ph_lo = 0; p.ph_hi = 34;
  void* args[] = {&p};
  hipError_t e = hipLaunchCooperativeKernel((const void*)mk_fwd, dim3(grid), dim3(512), args, LDS_BYTES, stream);
  if (e != hipSuccess) fprintf(stderr, "cooperative launch failed: %s (grid %d)\n", hipGetErrorString(e), grid);
}
```

```cpp
#include <hip/hip_runtime.h>
#include <hip/hip_cooperative_groups.h>
#include <cstdio>
#include <cstdint>
namespace cg = cooperative_groups;

constexpr int DM = 1024, NBATCH = 4, SEQ = 8192, CTXL = 256, SEGL = CTXL + SEQ, T = NBATCH * SEGL, DEPTH = 4;
constexpr int IN_W = 3088, PW = 3072;
constexpr int C_A = 0, C_MQ = 512, C_MK = 768, C_MV = 1024, C_MO = 1280, C_DQ = 1536, C_DK = 2048, C_DV = 2560;
constexpr int NCH = SEGL / 64;
constexpr int NEXP = 16384;
constexpr float EPS = 1e-6f;
#ifndef ABL
#define ABL 0
#endif
#ifndef GATHER_SYNC
#define GATHER_SYNC 0
#endif
#ifndef REP_ATT
#define REP_ATT 1
#endif
#ifndef REP_PEER
#define REP_PEER 1
#endif
#ifndef REP_GEMM
#define REP_GEMM 1
#endif
#ifndef REP_ROUTE
#define REP_ROUTE 1
#endif
#ifndef REP_OUTP
#define REP_OUTP 1
#endif
#ifndef REP_ML
#define REP_ML 1
#endif
#ifndef REP_MISC
#define REP_MISC 1
#endif
constexpr float QSCALE = 0.125f * 1.4426950408889634f;

constexpr size_t MiB = 1u << 20;
constexpr size_t WS_CTL = 0, WS_MOD = 1 * MiB, WS_ROPE = 2 * MiB, WS_WG = 4 * MiB, WS_KEYS = 5 * MiB, WS_MLMETA = 6 * MiB,
                 WS_GATES = 7 * MiB, WS_WIN = 10 * MiB, WS_WOUT = 34 * MiB, WS_WQ = 42 * MiB, WS_PU = 50 * MiB, WS_PV = 114 * MiB, WS_PSC = 178 * MiB  ,
                 WS_XCUR = 306 * MiB, WS_H = 438 * MiB, WS_MIX = 504 * MiB, WS_PROJ = 570 * MiB, WS_ULOC = 768 * MiB, WS_END = 836 * MiB;
constexpr int USTRIDE = 4160;

constexpr int LDS_BYTES = 139264;

#define LAS __attribute__((address_space(3)))
typedef unsigned short bf16_t;
typedef short bf16x8 __attribute__((ext_vector_type(8)));
typedef short s16x4 __attribute__((ext_vector_type(4)));
typedef float f32x4 __attribute__((ext_vector_type(4)));
typedef float f32x16 __attribute__((ext_vector_type(16)));
typedef unsigned u32x4 __attribute__((ext_vector_type(4)));
typedef unsigned u32x2 __attribute__((ext_vector_type(2)));
typedef __bf16 bf16x2v __attribute__((ext_vector_type(2)));
typedef float f32x2 __attribute__((ext_vector_type(2)));

struct KArgs {
  const float* in[23];
  float* out;
  unsigned char* ws;
  int ph_lo, ph_hi;
};
typedef const float* const __attribute__((address_space(4))) * InTab;
struct Params {
  InTab in;
  float* out;
  unsigned char* ws;
  int ph_lo, ph_hi;
  int bx, gx;
  unsigned* xbar_words; unsigned xbar_x; unsigned lds_st_off;
};
enum { I_X = 0, I_C, I_CTX, I_CCTX, I_ADAW, I_ADAB, I_N1G, I_N2G, I_WIN, I_CONVW, I_CONVB, I_CLNG, I_CLNB, I_GATEB, I_MNORMG, I_DLAM, I_DNORMG,
       I_WOUT, I_PWQ, I_PKEYS, I_PU, I_PV, I_FINALG };

__device__ __forceinline__ unsigned cvtpk(float lo, float hi) { unsigned r; asm volatile("v_cvt_pk_bf16_f32 %0, %1, %2" : "=v"(r) : "v"(lo), "v"(hi)); return r; }
__device__ __forceinline__ float bflo(unsigned u) { return __uint_as_float(u << 16); }
__device__ __forceinline__ float bfhi(unsigned u) { return __uint_as_float(u & 0xffff0000u); }
__device__ __forceinline__ float bf1(bf16_t u) { return __uint_as_float(((unsigned)u) << 16); }
__device__ __forceinline__ int crow(int r, int hi) { return (r & 3) + 8 * (r >> 2) + 4 * hi; }
__device__ __forceinline__ float wave_sum(float v) {
#pragma unroll
  for (int o = 1; o < 64; o <<= 1) v += __shfl_xor(v, o);
  return v;
}
__device__ __forceinline__ float wave_max(float v) {
#pragma unroll
  for (int o = 1; o < 64; o <<= 1) v = fmaxf(v, __shfl_xor(v, o));
  return v;
}
__device__ __forceinline__ float sigmoidf_(float x) { return 1.f / (1.f + __expf(-x)); }
__device__ __forceinline__ float logsigmoidf_(float x) { return fminf(x, 0.f) - log1pf(__expf(-fabsf(x))); }
__device__ __forceinline__ const float* in_row(const float* x, const float* ctx, int row) {
  const int b = row / SEGL, s = row - b * SEGL;
  return s < CTXL ? ctx + ((size_t)(b * CTXL + s)) * DM : x + ((size_t)(b * SEQ + (s - CTXL))) * DM;
}
__device__ __forceinline__ int mod_row(int row) { const int b = row / SEGL, s = row - b * SEGL; return s < CTXL ? 4 : b; }

__device__ __forceinline__ void p0_mod(const Params& p, unsigned char* lds, float* MOD) {
  float* sil = (float*)lds;
  float* red = (float*)(lds + 20480);
  int tid_ = threadIdx.x; asm volatile("" : "+v"(tid_)); const int tid = tid_, lane = tid & 63, wid = tid >> 6;
  for (int i = tid; i < 5 * 1024; i += 512) {
    const float v = i < 4096 ? p.in[I_C][i] : p.in[I_CCTX][i - 4096];
    sil[i] = v / (1.f + __expf(-v));
  }
  __syncthreads();
  for (int item = p.bx; item < DEPTH * 96; item += p.gx) {
    const int l = item / 96, j0 = (item % 96) * 64;
    const float* W = p.in[I_ADAW] + (size_t)l * DM * 6144 + j0 + lane;
    float a0 = 0.f, a1 = 0.f, a2 = 0.f, a3 = 0.f, a4 = 0.f;
    const int k0 = wid * 128;
#pragma unroll 8
    for (int k = k0; k < k0 + 128; ++k) {
      const float w = W[(size_t)k * 6144];
      a0 += sil[k] * w; a1 += sil[1024 + k] * w; a2 += sil[2048 + k] * w; a3 += sil[3072 + k] * w; a4 += sil[4096 + k] * w;
    }
    red[(wid * 5 + 0) * 64 + lane] = a0; red[(wid * 5 + 1) * 64 + lane] = a1; red[(wid * 5 + 2) * 64 + lane] = a2;
    red[(wid * 5 + 3) * 64 + lane] = a3; red[(wid * 5 + 4) * 64 + lane] = a4;
    __syncthreads();
    if (tid < 320) {
      const int r = tid >> 6;
      float s = 0.f;
#pragma unroll
      for (int w = 0; w < 8; ++w) s += red[(w * 5 + r) * 64 + lane];
      MOD[((size_t)l * 5 + r) * 6144 + j0 + lane] = s + p.in[I_ADAB][l * 6144 + j0 + lane];
    }
    __syncthreads();
  }
}
__device__ __forceinline__ void transpose_item(const float* W, int ldw, int srccol0, bf16_t* WT, int K, int n0, int k0, float* scr, int lane) {
#pragma unroll 8
  for (int i = 0; i < 32; ++i) { const int kk = 2 * i + (lane >> 5); scr[kk * 33 + (lane & 31)] = W[(size_t)(k0 + kk) * ldw + srccol0 + (lane & 31)]; }
  asm volatile("s_waitcnt lgkmcnt(0)" ::: "memory");
  const int c = lane & 7;
#pragma unroll
  for (int j = 0; j < 4; ++j) {
    const int n = (lane >> 3) + 8 * j; const float* s = scr + (8 * c) * 33 + n;
    u32x4 o; o.x = cvtpk(s[0], s[33]); o.y = cvtpk(s[66], s[99]); o.z = cvtpk(s[132], s[165]); o.w = cvtpk(s[198], s[231]);
    *(u32x4*)(WT + (size_t)(n0 + n) * K + k0 + 8 * c) = o;
  }
  asm volatile("s_waitcnt lgkmcnt(0)" ::: "memory");
}
__device__ __forceinline__ void p0_convert(const Params& p, unsigned char* lds) {
  int tid_ = threadIdx.x; asm volatile("" : "+v"(tid_)); const int tid = tid_, lane = tid & 63, wid = tid >> 6;
  const int gw = p.bx * 8 + wid, NGW = p.gx * 8;
  const size_t gt = (size_t)p.bx * 512 + tid, NGT = (size_t)p.gx * 512;
  float* scr = (float*)(lds + 32768) + wid * (64 * 33);
  bf16_t* WIN = (bf16_t*)(p.ws + WS_WIN); bf16_t* WOUT = (bf16_t*)(p.ws + WS_WOUT); bf16_t* WQ = (bf16_t*)(p.ws + WS_WQ);
  constexpr int I_IN = 16 * 96, I_O = 16 * 32, PER_L = I_IN + 2 * I_O;
  for (int it = gw; it < DEPTH * PER_L; it += NGW) {
    const int l = it / PER_L; int r = it % PER_L;
    if (r < I_IN) { const int kb = r / 96, nb = r % 96, n0 = nb * 32; const int src = n0 < 1536 ? n0 : n0 + 16;
      transpose_item(p.in[I_WIN] + (size_t)l * DM * IN_W, IN_W, src, WIN + (size_t)l * PW * DM, DM, n0, kb * 64, scr, lane); continue; }
    r -= I_IN;
    if (r < I_O) { const int kb = r / 32, nb = r % 32;
      transpose_item(p.in[I_WOUT] + (size_t)l * DM * DM, DM, nb * 32, WOUT + (size_t)l * DM * DM, DM, nb * 32, kb * 64, scr, lane); continue; }
    r -= I_O;
    { const int kb = r / 32, nb = r % 32;
      transpose_item(p.in[I_PWQ] + (size_t)l * DM * DM, DM, nb * 32, WQ + (size_t)l * DM * DM, DM, nb * 32, kb * 64, scr, lane); }
  }
  bf16_t* WG = (bf16_t*)(p.ws + WS_WG);
  for (size_t i = gt; i < (size_t)DEPTH * 16 * DM; i += NGT) {
    const int l = (int)(i / (16 * DM)), g = (int)((i / DM) % 16), k = (int)(i % DM);
    WG[i] = (bf16_t)(cvtpk(p.in[I_WIN][(size_t)l * DM * IN_W + (size_t)k * IN_W + 1536 + g], 0.f) & 0xffffu);
  }
  bf16_t* KEYS = (bf16_t*)(p.ws + WS_KEYS);
  for (size_t i = gt; i < (size_t)DEPTH * 131072 / 8; i += NGT) {
    const f32x4 a = ((const f32x4*)p.in[I_PKEYS])[2 * i], b = ((const f32x4*)p.in[I_PKEYS])[2 * i + 1];
    u32x4 o; o.x = cvtpk(a.x, a.y); o.y = cvtpk(a.z, a.w); o.z = cvtpk(b.x, b.y); o.w = cvtpk(b.z, b.w);
    ((u32x4*)KEYS)[i] = o;
  }
  {
    unsigned char* PUq = p.ws + WS_PU; unsigned char* PVq = p.ws + WS_PV; float* PSC = (float*)(p.ws + WS_PSC);
    const int nrows = DEPTH * NEXP;
    for (int r = gw; r < 2 * nrows; r += NGW) {
      const int tb = r >= nrows, rr = tb ? r - nrows : r;
      const f32x4* srow = (const f32x4*)((tb ? p.in[I_PV] : p.in[I_PU]) + (size_t)rr * DM) + lane * 4;
      f32x4 v[4]; float mx = 0.f;
#pragma unroll
      for (int j = 0; j < 4; ++j) { v[j] = __builtin_nontemporal_load(srow + j); mx = fmaxf(mx, fmaxf(fmaxf(fabsf(v[j].x), fabsf(v[j].y)), fmaxf(fabsf(v[j].z), fabsf(v[j].w)))); }
      mx = wave_max(mx);
      const int eb = (int)((__float_as_uint(mx) >> 23) & 0xFFu);
      int sb = 261 - eb; sb = sb < 1 ? 1 : (sb > 253 ? 253 : sb);
      const float sc = __uint_as_float((unsigned)sb << 23), isc = __uint_as_float((unsigned)(254 - sb) << 23);
      u32x4 o;
      int w;
#define CV4(V, OUT) w = 0; w = __builtin_amdgcn_cvt_pk_fp8_f32(V.x * sc, V.y * sc, w, false); w = __builtin_amdgcn_cvt_pk_fp8_f32(V.z * sc, V.w * sc, w, true); OUT = (unsigned)w
      CV4(v[0], o.x); CV4(v[1], o.y); CV4(v[2], o.z); CV4(v[3], o.w);
#undef CV4
      *(u32x4*)((tb ? PVq : PUq) + (size_t)rr * DM + lane * 16) = o;
      if (lane == 0) PSC[(size_t)tb * nrows + rr] = isc;
    }
  }
  {
    float* RC = (float*)(p.ws + WS_ROPE); float* RS = RC + SEQ * 32;
    for (size_t i = gt; i < (size_t)SEQ * 32; i += NGT) {
      const int pos = (int)(i >> 5), j = (int)(i & 31);
      const int rr = pos >> 6, cc = pos & 63;
      const int jj = j & 15;
      const double e = -(double)jj * 0.83048202372184058696;
      const double fl = __builtin_floor(e); const double f = e - fl;
      const double z = f * 0.69314718055994530942;
      double ez = 1.0 + z * (1.0 + z * (0.5 + z * (1.0 / 6 + z * (1.0 / 24 + z * (1.0 / 120 + z * (1.0 / 720 + z * (1.0 / 5040 + z * (1.0 / 40320 + z * (1.0 / 362880 + z * (1.0 / 3628800 + z * (1.0 / 39916800 + z * (1.0 / 479001600))))))))))));
      const double inv = __builtin_ldexp(ez, (int)fl);
      const float invf = (float)inv;
      const float angf = (float)(j < 16 ? rr : cc) * invf;
      const double ang = (double)angf;
      const double kq = __builtin_rint(ang * 0.63661977236758134308);
      double r = __builtin_fma(-kq, 1.57079632679489655800e+00, ang);
      r = __builtin_fma(-kq, 6.12323399573676603587e-17, r);
      const double r2 = r * r;
      const double sn = r * (1.0 + r2 * (-1.0 / 6 + r2 * (1.0 / 120 + r2 * (-1.0 / 5040 + r2 * (1.0 / 362880 + r2 * (-1.0 / 39916800 + r2 * (1.0 / 6227020800.0)))))));
      const double cs = 1.0 + r2 * (-0.5 + r2 * (1.0 / 24 + r2 * (-1.0 / 720 + r2 * (1.0 / 40320 + r2 * (-1.0 / 3628800 + r2 * (1.0 / 479001600 + r2 * (-1.0 / 87178291200.0)))))));
      const int q = ((int)kq) & 3;
      double co, si;
      if (q == 0) { co = cs; si = sn; } else if (q == 1) { co = -sn; si = cs; } else if (q == 2) { co = -cs; si = -sn; } else { co = sn; si = -cs; }
      RC[i] = (float)co; RS[i] = (float)si;
    }
  }
}

__device__ __forceinline__ void norm_mod_row(const float* xrow, const float* g, const float* sc, const float* sh, bf16_t* orow, int lane) {
  const f32x4* xr = (const f32x4*)xrow + lane;
  f32x4 v[4]; float s = 0.f;
#pragma unroll
  for (int j = 0; j < 4; ++j) { v[j] = xr[64 * j]; s += (v[j].x * v[j].x + v[j].y * v[j].y) + (v[j].z * v[j].z + v[j].w * v[j].w); }
  const float rs = rsqrtf(wave_sum(s) * (1.f / DM) + EPS);
  u32x2* o = (u32x2*)orow + lane;
#pragma unroll
  for (int j = 0; j < 4; ++j) {
    const f32x4 gg = ((const f32x4*)g)[lane + 64 * j], cc = ((const f32x4*)sc)[lane + 64 * j], hh = ((const f32x4*)sh)[lane + 64 * j];
    const float y0 = v[j].x * rs * gg.x * (1.f + cc.x) + hh.x, y1 = v[j].y * rs * gg.y * (1.f + cc.y) + hh.y;
    const float y2 = v[j].z * rs * gg.z * (1.f + cc.z) + hh.z, y3 = v[j].w * rs * gg.w * (1.f + cc.w) + hh.w;
    u32x2 w; w.x = cvtpk(y0, y1); w.y = cvtpk(y2, y3);
    o[64 * j] = w;
  }
}
__device__ __forceinline__ void phase_norm(const Params& p, int l, int which, bool from_input, bool skip_ctx) {
  int tid_ = threadIdx.x; asm volatile("" : "+v"(tid_));
  const int lane = tid_ & 63, wid = tid_ >> 6;
  const int gw = p.bx * 8 + wid, NGW = p.gx * 8;
  const float* MOD = (const float*)(p.ws + WS_MOD);
  const float* XC = (const float*)(p.ws + WS_XCUR);
  bf16_t* H = (bf16_t*)(p.ws + WS_H);
  const float* g = p.in[which ? I_N2G : I_N1G] + l * DM;
  for (int row = gw; row < T; row += NGW) {
    const int mr = mod_row(row);
    if (skip_ctx && mr == 4) continue;
    const float* m = MOD + ((size_t)l * 5 + mr) * 6144 + which * 3072;
    const float* xr = from_input ? in_row(p.in[I_X], p.in[I_CTX], row) : XC + (size_t)row * DM;
    norm_mod_row(xr, g, m + 1024, m, H + (size_t)row * DM, lane);
  }
}

namespace pg8 {
#define PG8_LAS __attribute__((address_space(3)))
typedef unsigned short bf16_t;
typedef short bf16x8 __attribute__((ext_vector_type(8)));
typedef float f32x4 __attribute__((ext_vector_type(4)));
typedef unsigned u32x4 __attribute__((ext_vector_type(4)));
constexpr int BM = 256, BK = 64, HALF = 128, HTB = HALF * BK * 2  , STAGE_BYTES = 8 * HTB, NXCD = 8, WGM = 8;

__host__ __device__ __forceinline__ int lds_byte(int r, int c) { const int st = (r >> 4) * 2 + (c >> 5), rr = r & 15, cc = c & 31, ob = rr * 64 + cc * 2; return st * 1024 + (ob ^ (((ob >> 9) & 1) << 5)); }
__host__ __device__ __forceinline__ void stage_rc(int b, int& R, int& C) { const int st = b / 1024, sb = b % 1024, swz = sb ^ (((sb >> 9) & 1) << 5); R = (st >> 1) * 16 + swz / 64; C = (st & 1) * 32 + (swz % 64) / 2; }
__host__ __device__ __forceinline__ int perm32(int rho) { const int n = rho >> 4, i = rho & 15; return 8 * (i >> 2) + 4 * n + (i & 3); }

struct Unit { int pm, pn; };
struct Gemm { const bf16_t* A; const bf16_t* Bt; int M, N, K; };

struct StaticOrder {
    int nM, nN, nwg, G, c;
    __host__ __device__ void init(int M, int N, int G_, int c_) { nM = M / BM; nN = N / BM; nwg = nM * nN; G = G_; c = c_; }
    __host__ __device__ bool next(int i, Unit& u) const {
        const long L = (long)i * G + c; if (L >= nwg) return false;
        int wgid = (int)L; { const int q = nwg / NXCD, r = nwg % NXCD, xcd = wgid % NXCD, off = wgid / NXCD; wgid = (xcd < r ? xcd * (q + 1) : r * (q + 1) + (xcd - r) * q) + off; }
        const int nig = WGM * nN, gid = wgid / nig, fm = gid * WGM, gsz = (nM - fm) < WGM ? (nM - fm) : WGM;
        u.pm = fm + ((wgid % nig) % gsz); u.pn = (wgid % nig) / gsz; return true;
    }
    __device__ __forceinline__ void a_ready(const Unit&) const {}
    __device__ __forceinline__ void done(const Unit&) const {}
};
__device__ __forceinline__ unsigned cvt_pk_bf16(float lo, float hi) { unsigned r; asm volatile("v_cvt_pk_bf16_f32 %0, %1, %2" : "=v"(r) : "v"(lo), "v"(hi)); return r; }
template <class Epi, class Sched, bool ALIGN_EPI = false, bool SP2 = false>
__device__ __forceinline__ void gemm_phase(PG8_LAS unsigned char* lds, const Gemm g, const Sched& S, const Epi& E) {
    const int tid = threadIdx.x, wid = __builtin_amdgcn_readfirstlane(tid >> 6), lane = tid & 63, wr = wid >> 2, wc = wid & 3, fr = lane & 15, fq = lane >> 4;
    const int K = g.K, nt = K / BK;
    unsigned voffA[2], voffB[2];
#pragma unroll
    for (int i = 0; i < 2; ++i) { int R, C; stage_rc(tid * 16 + i * 8192, R, C); const int Rb = Epi::PERM ? ((R & ~31) + perm32(R & 31)) : R;
        voffA[i] = (unsigned)(R * K + C) * 2u; voffB[i] = (unsigned)(Rb * K + C) * 2u; }
    const size_t kstep = (size_t)(BK * 2);
    const size_t hstep = (size_t)HALF * K * 2;
    const size_t tstep = 2 * hstep;
    const unsigned ldsw = (unsigned)wid * 1024u;
    const int aoff = lds_byte(wr * 64 + fr, fq * 8), boff = lds_byte(wc * 32 + fr, fq * 8);
#define PG8_SA(b, h) (((b) * 2 + (h)) * HTB)
#define PG8_SB(b, h) ((4 + (b) * 2 + (h)) * HTB)
#define PG8_STAGE(bufoff, gbase, voff) do { _Pragma("unroll") for (int _i = 0; _i < 2; ++_i) \
        __builtin_amdgcn_global_load_lds((const unsigned*)((const char*)(gbase) + (voff)[_i]), (PG8_LAS unsigned*)(lds + (bufoff) + ldsw + _i * 8192), 16, 0, 0); } while (0)
#define PG8_LDA(dst, b, h) do { _Pragma("unroll") for (int m = 0; m < 4; ++m) _Pragma("unroll") for (int k = 0; k < 2; ++k) dst[m][k] = *(const PG8_LAS bf16x8*)(lds + PG8_SA(b, h) + aoff + m * 2048 + k * 1024); } while (0)
#define PG8_LDB(dst, b, h) do { _Pragma("unroll") for (int n = 0; n < 2; ++n) _Pragma("unroll") for (int k = 0; k < 2; ++k) dst[n][k] = *(const PG8_LAS bf16x8*)(lds + PG8_SB(b, h) + boff + n * 2048 + k * 1024); } while (0)
#define PG8_MMA(ai, bj, At, Bt) do { __builtin_amdgcn_s_setprio(1); _Pragma("unroll") for (int m = 0; m < 4; ++m) _Pragma("unroll") for (int n = 0; n < 2; ++n) _Pragma("unroll") for (int k = 0; k < 2; ++k) \
        acc[ai][bj][m][n] = __builtin_amdgcn_mfma_f32_16x16x32_bf16(Bt[n][k], At[m][k], acc[ai][bj][m][n], 0, 0, 0); __builtin_amdgcn_s_setprio(0); } while (0)
#define PG8_WAIT_V(n) asm volatile("s_waitcnt vmcnt(" #n ")" ::: "memory")
#define PG8_WAIT_L(n) asm volatile("s_waitcnt lgkmcnt(" #n ")" ::: "memory")
#define PG8_BAR __builtin_amdgcn_s_barrier()
#define PG8_SCHED __builtin_amdgcn_sched_barrier(0)
    Unit cur, nxt; int ui = 0;
    if (!S.next(0, cur)) return;
    f32x4 acc[2][2][4][2];
#pragma unroll
    for (int a = 0; a < 2; ++a)
#pragma unroll
        for (int b = 0; b < 2; ++b)
#pragma unroll
            for (int m = 0; m < 4; ++m)
#pragma unroll
                for (int n = 0; n < 2; ++n) acc[a][b][m][n] = (f32x4){0.f, 0.f, 0.f, 0.f};
    bf16x8 At[4][2], B0[2][2], B1[2][2];
    const char* cA = (const char*)g.A + (size_t)cur.pm * tstep; const char* cB = (const char*)g.Bt + (size_t)cur.pn * tstep;
    S.a_ready(cur);
    if constexpr (SP2) {
        PG8_STAGE(PG8_SB(0, 0), cB, voffB); PG8_STAGE(PG8_SB(0, 1), cB + hstep, voffB); PG8_STAGE(PG8_SA(0, 0), cA, voffA); PG8_STAGE(PG8_SA(0, 1), cA + hstep, voffA);
        if (wr == 1) PG8_BAR;
        PG8_WAIT_V(2); PG8_BAR;
        PG8_STAGE(PG8_SB(1, 0), cB + kstep, voffB); PG8_STAGE(PG8_SA(1, 0), cA + kstep, voffA); PG8_STAGE(PG8_SB(1, 1), cB + hstep + kstep, voffB);
        PG8_WAIT_V(6); PG8_BAR;
    } else {
        PG8_STAGE(PG8_SB(0, 0), cB, voffB); PG8_STAGE(PG8_SA(0, 0), cA, voffA); PG8_STAGE(PG8_SB(0, 1), cB + hstep, voffB); PG8_STAGE(PG8_SA(0, 1), cA + hstep, voffA);
        if (wr == 1) PG8_BAR;
        PG8_WAIT_V(4); PG8_BAR;
        PG8_STAGE(PG8_SB(1, 0), cB + kstep, voffB); PG8_STAGE(PG8_SA(1, 0), cA + kstep, voffA); PG8_STAGE(PG8_SB(1, 1), cB + hstep + kstep, voffB);
        PG8_WAIT_V(6); PG8_BAR;
    }
    for (;;) {
        const bool has_next = S.next(ui + 1, nxt);
        const char* nA = has_next ? (const char*)g.A + (size_t)nxt.pm * tstep : cA; const char* nB = has_next ? (const char*)g.Bt + (size_t)nxt.pn * tstep : cB;
        for (int t = 0; t < nt; t += 2) {
            const bool last = (t == nt - 2);
            const char* a1 = cA + (size_t)(t + 1) * kstep;
            const char* a2 = last ? nA : cA + (size_t)(t + 2) * kstep; const char* b2 = last ? nB : cB + (size_t)(t + 2) * kstep;
            const char* a3 = a2 + kstep; const char* b3 = b2 + kstep;
            if (last && has_next) S.a_ready(nxt);
            if constexpr (SP2) {
            PG8_LDB(B0, 0, 0); PG8_LDB(B1, 0, 1); PG8_SCHED; PG8_LDA(At, 0, 0); PG8_STAGE(PG8_SA(1, 1), a1 + hstep, voffA);
            PG8_WAIT_V(8); PG8_WAIT_L(0); PG8_BAR; PG8_MMA(0, 0, At, B0); PG8_MMA(0, 1, At, B1); PG8_BAR; PG8_SCHED;
            PG8_LDA(At, 0, 1); PG8_STAGE(PG8_SB(0, 0), b2, voffB); PG8_STAGE(PG8_SB(0, 1), b2 + hstep, voffB); PG8_STAGE(PG8_SA(0, 0), a2, voffA);
            PG8_WAIT_V(8); PG8_WAIT_L(0); PG8_BAR; PG8_MMA(1, 0, At, B0); PG8_MMA(1, 1, At, B1); PG8_BAR; PG8_SCHED;
            PG8_LDB(B0, 1, 0); PG8_LDB(B1, 1, 1); PG8_SCHED; PG8_LDA(At, 1, 0); PG8_STAGE(PG8_SA(0, 1), a2 + hstep, voffA);
            PG8_WAIT_V(8); PG8_WAIT_L(0); PG8_BAR; PG8_MMA(0, 0, At, B0); PG8_MMA(0, 1, At, B1); PG8_BAR; PG8_SCHED;
            PG8_LDA(At, 1, 1); PG8_STAGE(PG8_SB(1, 0), b3, voffB); PG8_STAGE(PG8_SB(1, 1), b3 + hstep, voffB); PG8_STAGE(PG8_SA(1, 0), a3, voffA);
            PG8_WAIT_V(8); PG8_WAIT_L(0); PG8_BAR; PG8_MMA(1, 0, At, B0); PG8_MMA(1, 1, At, B1); PG8_BAR; PG8_SCHED;
            } else {
            PG8_LDB(B0, 0, 0); PG8_SCHED; PG8_LDA(At, 0, 0); PG8_STAGE(PG8_SA(1, 1), a1 + hstep, voffA);
            PG8_WAIT_L(8); PG8_BAR; PG8_WAIT_L(0); PG8_MMA(0, 0, At, B0); PG8_BAR; PG8_SCHED;
            PG8_LDB(B1, 0, 1); PG8_STAGE(PG8_SB(0, 0), b2, voffB);
            PG8_BAR; PG8_WAIT_L(0); PG8_MMA(0, 1, At, B1); PG8_BAR;
            PG8_LDA(At, 0, 1); PG8_STAGE(PG8_SA(0, 0), a2, voffA);
            PG8_BAR; PG8_WAIT_L(0); PG8_MMA(1, 0, At, B0); PG8_BAR; PG8_SCHED;
            PG8_STAGE(PG8_SB(0, 1), b2 + hstep, voffB);
            PG8_WAIT_V(6); PG8_BAR; PG8_MMA(1, 1, At, B1); PG8_BAR;
            PG8_LDB(B0, 1, 0); PG8_SCHED; PG8_LDA(At, 1, 0); PG8_STAGE(PG8_SA(0, 1), a2 + hstep, voffA);
            PG8_WAIT_L(8); PG8_BAR; PG8_WAIT_L(0); PG8_MMA(0, 0, At, B0); PG8_BAR; PG8_SCHED;
            PG8_LDB(B1, 1, 1); PG8_STAGE(PG8_SB(1, 0), b3, voffB);
            PG8_BAR; PG8_WAIT_L(0); PG8_MMA(0, 1, At, B1); PG8_BAR;
            PG8_LDA(At, 1, 1); PG8_STAGE(PG8_SA(1, 0), a3, voffA);
            PG8_BAR; PG8_WAIT_L(0); PG8_MMA(1, 0, At, B0); PG8_BAR; PG8_SCHED;
            PG8_STAGE(PG8_SB(1, 1), b3 + hstep, voffB);
            PG8_WAIT_V(6); PG8_BAR; PG8_MMA(1, 1, At, B1); PG8_BAR;
            }
        }
        if constexpr (ALIGN_EPI) { if (wr == 0) PG8_BAR; }
        if constexpr (!Epi::AFTER_DRAIN) { E(acc, cur, wr, wc, fr, fq); S.done(cur); }
        if (!has_next) break;
#pragma unroll
        for (int a = 0; a < 2; ++a)
#pragma unroll
            for (int b = 0; b < 2; ++b)
#pragma unroll
                for (int m = 0; m < 4; ++m)
#pragma unroll
                    for (int n = 0; n < 2; ++n) acc[a][b][m][n] = (f32x4){0.f, 0.f, 0.f, 0.f};
        cur = nxt; cA = nA; cB = nB; ++ui;
        if constexpr (ALIGN_EPI) { if (wr == 1) PG8_BAR; }
    }
    PG8_WAIT_V(0);
    if constexpr (!ALIGN_EPI) { if (wr == 0) PG8_BAR; }
    PG8_BAR;
    if constexpr (Epi::AFTER_DRAIN) { E.fused(acc, cur, wr, wc, fr, fq, lds, wid, lane); S.done(cur); }
#undef PG8_SA
#undef PG8_SB
#undef PG8_STAGE
#undef PG8_LDA
#undef PG8_LDB
#undef PG8_MMA
#undef PG8_WAIT_V
#undef PG8_WAIT_L
#undef PG8_BAR
#undef PG8_SCHED
}
}

__device__ __forceinline__ int gswz(int row, int chunk) { return row * 128 + ((chunk ^ ((row >> 1) & 7)) << 4); }
__device__ __forceinline__ void gemm_tile(const bf16_t* __restrict__ A, int lda, const bf16_t* __restrict__ Bt, int ldb, int K,
                                          int row0, int col0, unsigned char* lds, f32x16 (&acc)[2][2]) {
  int tid_ = threadIdx.x; asm volatile("" : "+v"(tid_)); const int tid = tid_, lane = tid & 63, wid = tid >> 6, wm = wid >> 1, wn = wid & 1, r32 = lane & 31, hi = lane >> 5;
  unsigned char* As = lds; unsigned char* Bs = lds + 65536;
#pragma unroll
  for (int i = 0; i < 2; ++i)
#pragma unroll
    for (int j = 0; j < 2; ++j) acc[i][j] = f32x16{};
  const int lrow = tid >> 3, lc = tid & 7;
  const bf16_t* Ag = A + (size_t)(row0 + lrow) * lda + lc * 8;
  const bf16_t* Bg = Bt + (size_t)(col0 + lrow) * ldb + lc * 8;
  u32x4 ra[4], rb[2];
#pragma unroll
  for (int i = 0; i < 4; ++i) ra[i] = *(const u32x4*)(Ag + (size_t)(64 * i) * lda);
#pragma unroll
  for (int i = 0; i < 2; ++i) rb[i] = *(const u32x4*)(Bg + (size_t)(64 * i) * ldb);
#pragma unroll
  for (int i = 0; i < 4; ++i) *(u32x4*)(As + gswz(lrow + 64 * i, lc)) = ra[i];
#pragma unroll
  for (int i = 0; i < 2; ++i) *(u32x4*)(Bs + gswz(lrow + 64 * i, lc)) = rb[i];
  __syncthreads();
  const int nk = K / 64;
  for (int kt = 0; kt < nk; ++kt) {
    const int cur = kt & 1;
    if (kt + 1 < nk) {
#pragma unroll
      for (int i = 0; i < 4; ++i) ra[i] = *(const u32x4*)(Ag + (size_t)(64 * i) * lda + (kt + 1) * 64);
#pragma unroll
      for (int i = 0; i < 2; ++i) rb[i] = *(const u32x4*)(Bg + (size_t)(64 * i) * ldb + (kt + 1) * 64);
    }
    const unsigned char* Ac = As + cur * 32768; const unsigned char* Bc = Bs + cur * 16384;
#pragma unroll
    for (int kk = 0; kk < 4; ++kk) {
      bf16x8 af[2], bfr[2];
#pragma unroll
      for (int i = 0; i < 2; ++i) af[i] = *(const bf16x8*)(Ac + gswz(wm * 64 + i * 32 + r32, 2 * kk + hi));
#pragma unroll
      for (int j = 0; j < 2; ++j) bfr[j] = *(const bf16x8*)(Bc + gswz(wn * 64 + j * 32 + r32, 2 * kk + hi));
#pragma unroll
      for (int i = 0; i < 2; ++i)
#pragma unroll
        for (int j = 0; j < 2; ++j) acc[i][j] = __builtin_amdgcn_mfma_f32_32x32x16_bf16(af[i], bfr[j], acc[i][j], 0, 0, 0);
    }
    if (kt + 1 < nk) {
      unsigned char* An = As + (cur ^ 1) * 32768; unsigned char* Bn = Bs + (cur ^ 1) * 16384;
#pragma unroll
      for (int i = 0; i < 4; ++i) *(u32x4*)(An + gswz(lrow + 64 * i, lc)) = ra[i];
#pragma unroll
      for (int i = 0; i < 2; ++i) *(u32x4*)(Bn + gswz(lrow + 64 * i, lc)) = rb[i];
    }
    __syncthreads();
  }
}
__device__ __forceinline__ void pair_xchg(float v0, float v1, int lane, float& lo, float& hi2) {
  const bool odd = lane & 1;
  const float send = odd ? v0 : v1;
  const float recv = __shfl_xor(send, 1);
  lo = odd ? recv : v0; hi2 = odd ? v1 : recv;
}

__device__ __forceinline__ void phase_inproj(const Params& p, int l, unsigned char* lds) {
  int tid_ = threadIdx.x; asm volatile("" : "+v"(tid_)); const int tid = tid_, lane = tid & 63, wid = tid >> 6, wm = wid >> 1, wn = wid & 1, r32 = lane & 31, hi = lane >> 5;
  const bf16_t* H = (const bf16_t*)(p.ws + WS_H);
  const bf16_t* W = (const bf16_t*)(p.ws + WS_WIN) + (size_t)l * PW * DM;
  bf16_t* PROJ = (bf16_t*)(p.ws + WS_PROJ);
  const float* RC = (const float*)(p.ws + WS_ROPE); const float* RS = RC + SEQ * 32;
  constexpr int NM = T / 256, NN = PW / 128, NU = NM * NN;
  for (int u = p.bx; u < NU + NM; u += p.gx) {
    if (u < NU) {
      const int pn = u / NM, pm = u % NM;
      const int row0 = pm * 256, col0 = pn * 128;
      f32x16 acc[2][2];
      gemm_tile(H, DM, W, DM, DM, row0, col0, lds, acc);
      const bool rope = (col0 >= C_DQ && col0 < C_DV);
      const float scl = (col0 >= C_MK && col0 < C_MV) ? 0.125f : ((col0 >= C_DQ && col0 < C_DK) ? QSCALE : 1.f);
#pragma unroll
      for (int i = 0; i < 2; ++i)
#pragma unroll
        for (int j = 0; j < 2; ++j)
#pragma unroll
          for (int q = 0; q < 8; ++q) {
            float lo, hi2; pair_xchg(acc[i][j][2 * q], acc[i][j][2 * q + 1], lane, lo, hi2);
            const int row = row0 + wm * 64 + i * 32 + crow(2 * q, hi) + (lane & 1);
            const int col = col0 + wn * 64 + j * 32 + (r32 & ~1);
            if (rope) {
              const int s = row % SEGL;
              if (s >= CTXL) {
                const int idx = (s - CTXL) * 32 + ((col & 63) >> 1);
                const float c = RC[idx], sn = RS[idx];
                const float t1 = lo, t2 = hi2; lo = t1 * c - t2 * sn; hi2 = t1 * sn + t2 * c;
              }
            }
            *(unsigned*)(PROJ + (size_t)row * PW + col) = cvtpk(lo * scl, hi2 * scl);
          }
    } else {
      const int pm = u - NU, rowb = pm * 256 + wid * 32;
      const bf16_t* WG = (const bf16_t*)(p.ws + WS_WG) + (size_t)l * 16 * DM;
      float* GT = (float*)(p.ws + WS_GATES);
      const int r16 = lane & 15, q4 = lane >> 4;
      f32x4 c0 = {0.f, 0.f, 0.f, 0.f}, c1 = {0.f, 0.f, 0.f, 0.f};
      const bf16_t* a0p = H + (size_t)(rowb + r16) * DM + q4 * 8;
      const bf16_t* a1p = a0p + (size_t)16 * DM;
      const bf16_t* bp = WG + (size_t)r16 * DM + q4 * 8;
#pragma unroll 4
      for (int ks = 0; ks < 32; ++ks) {
        const bf16x8 a0 = *(const bf16x8*)(a0p + ks * 32), a1 = *(const bf16x8*)(a1p + ks * 32), b = *(const bf16x8*)(bp + ks * 32);
        c0 = __builtin_amdgcn_mfma_f32_16x16x32_bf16(a0, b, c0, 0, 0, 0);
        c1 = __builtin_amdgcn_mfma_f32_16x16x32_bf16(a1, b, c1, 0, 0, 0);
      }
      const float gb = p.in[I_GATEB][l * 16 + r16];
#pragma unroll
      for (int j = 0; j < 4; ++j) {
        GT[(size_t)(rowb + q4 * 4 + j) * 16 + r16] = c0[j] + gb;
        GT[(size_t)(rowb + 16 + q4 * 4 + j) * 16 + r16] = c1[j] + gb;
      }
    }
  }
}

__device__ __forceinline__ void phase_outproj(const Params& p, int l, unsigned char* lds) {
  int tid_ = threadIdx.x; asm volatile("" : "+v"(tid_)); const int tid = tid_, lane = tid & 63, wid = tid >> 6, wm = wid >> 1, wn = wid & 1, r32 = lane & 31, hi = lane >> 5;
  const bf16_t* MIX = (const bf16_t*)(p.ws + WS_MIX);
  const bf16_t* W = (const bf16_t*)(p.ws + WS_WOUT) + (size_t)l * DM * DM;
  float* XC = (float*)(p.ws + WS_XCUR);
  const float* MOD = (const float*)(p.ws + WS_MOD);
  constexpr int NM = T / 256, NN = DM / 128, NU = NM * NN;
  for (int u = p.bx; u < NU; u += p.gx) {
    const int pm = u / NN, pn = u % NN;
    if (l == DEPTH - 1 && (pm % 33) == 0) continue;
    const int row0 = pm * 256, col0 = pn * 128;
    for (int rep = 0; rep < REP_OUTP; ++rep) {
    f32x16 acc[2][2];
    gemm_tile(MIX, DM, W, DM, DM, row0, col0, lds, acc);
    const int mr = (pm % 33) == 0 ? 4 : pm / 33;
    const float* g1 = MOD + ((size_t)l * 5 + mr) * 6144 + 2048;
#pragma unroll
    for (int i = 0; i < 2; ++i)
#pragma unroll
      for (int j = 0; j < 2; ++j) {
        const int col = col0 + wn * 64 + j * 32 + r32;
        const float gg = (rep == REP_OUTP - 1) ? g1[col] : 0.f;
#pragma unroll
        for (int r = 0; r < 16; ++r) {
          const int row = row0 + wm * 64 + i * 32 + crow(r, hi);
          const float xo = (l == 0) ? in_row(p.in[I_X], p.in[I_CTX], row)[col] : XC[(size_t)row * DM + col];
          XC[(size_t)row * DM + col] = xo + gg * acc[i][j][r];
        }
      }
    }
  }
}
__device__ __forceinline__ void phase_peerq(const Params& p, int l, unsigned char* lds) {
  int tid_ = threadIdx.x; asm volatile("" : "+v"(tid_)); const int tid = tid_, lane = tid & 63, wid = tid >> 6, wm = wid >> 1, wn = wid & 1, r32 = lane & 31, hi = lane >> 5;
  const bf16_t* H = (const bf16_t*)(p.ws + WS_H);
  const bf16_t* W = (const bf16_t*)(p.ws + WS_WQ) + (size_t)l * DM * DM;
  bf16_t* QP = (bf16_t*)(p.ws + WS_PROJ);
  constexpr int NM = T / 256, NN = DM / 128, NU = NM * NN;
  for (int u = p.bx; u < NU; u += p.gx) {
    const int pm = u / NN, pn = u % NN;
    if (l == DEPTH - 1 && (pm % 33) == 0) continue;
    const int row0 = pm * 256, col0 = pn * 128;
    f32x16 acc[2][2];
    gemm_tile(H, DM, W, DM, DM, row0, col0, lds, acc);
#pragma unroll
    for (int i = 0; i < 2; ++i)
#pragma unroll
      for (int j = 0; j < 2; ++j)
#pragma unroll
        for (int q = 0; q < 8; ++q) {
          float lo, hi2; pair_xchg(acc[i][j][2 * q], acc[i][j][2 * q + 1], lane, lo, hi2);
          const int row = row0 + wm * 64 + i * 32 + crow(2 * q, hi) + (lane & 1);
          const int col = col0 + wn * 64 + j * 32 + (r32 & ~1);
          *(unsigned*)(QP + (size_t)row * DM + col) = cvtpk(lo, hi2);
        }
  }
}


struct EpiInproj {
  static constexpr bool PERM = true, AFTER_DRAIN = false;
  bf16_t* PROJ; const float* RC; const float* RS;
  __device__ __forceinline__ void operator()(const pg8::f32x4 (&acc)[2][2][4][2], const pg8::Unit& u, int wr, int wc, int fr, int fq) const {
#pragma unroll
    for (int bj = 0; bj < 2; ++bj) {
      const int colt = u.pn * 256 + bj * 128;
      const bool rope = (colt >= C_DQ && colt < C_DV);
      const float scl = (colt >= C_MK && colt < C_MV) ? 0.125f : ((colt >= C_DQ && colt < C_DK) ? QSCALE : 1.f);
      const int col8 = colt + wc * 32 + 8 * fq;
#pragma unroll
      for (int ai = 0; ai < 2; ++ai)
#pragma unroll
        for (int m = 0; m < 4; ++m) {
          const int row = u.pm * 256 + ai * 128 + wr * 64 + m * 16 + fr;
          f32x4 v0 = acc[ai][bj][m][0], v1 = acc[ai][bj][m][1];
          if (rope) {
            const int s = row % SEGL;
            if (s >= CTXL) {
              const int idx = (s - CTXL) * 32 + ((col8 & 63) >> 1);
              const f32x4 c = *(const f32x4*)(RC + idx), sn = *(const f32x4*)(RS + idx);
              f32x4 a, b;
              a[0] = v0[0] * c[0] - v0[1] * sn[0]; a[1] = v0[0] * sn[0] + v0[1] * c[0]; a[2] = v0[2] * c[1] - v0[3] * sn[1]; a[3] = v0[2] * sn[1] + v0[3] * c[1];
              b[0] = v1[0] * c[2] - v1[1] * sn[2]; b[1] = v1[0] * sn[2] + v1[1] * c[2]; b[2] = v1[2] * c[3] - v1[3] * sn[3]; b[3] = v1[2] * sn[3] + v1[3] * c[3];
              v0 = a; v1 = b;
            }
          }
          u32x4 w; w.x = cvtpk(v0[0] * scl, v0[1] * scl); w.y = cvtpk(v0[2] * scl, v0[3] * scl); w.z = cvtpk(v1[0] * scl, v1[1] * scl); w.w = cvtpk(v1[2] * scl, v1[3] * scl);
          *(u32x4*)(PROJ + (size_t)row * PW + col8) = w;
        }
    }
  }
};
struct EpiOutproj {
  static constexpr bool PERM = true, AFTER_DRAIN = false;
  float* XC; const float* MODL; const float* xin; const float* ctxin; int first; float gsc;
  __device__ __forceinline__ void operator()(const pg8::f32x4 (&acc)[2][2][4][2], const pg8::Unit& u, int wr, int wc, int fr, int fq) const {
    const int mr = (u.pm % 33) == 0 ? 4 : u.pm / 33;
    const float* g1 = MODL + (size_t)mr * 6144 + 2048;
#pragma unroll
    for (int bj = 0; bj < 2; ++bj) {
      const int col8 = u.pn * 256 + bj * 128 + wc * 32 + 8 * fq;
      const f32x4 ga = *(const f32x4*)(g1 + col8) * gsc, gb = *(const f32x4*)(g1 + col8 + 4) * gsc;
#pragma unroll
      for (int ai = 0; ai < 2; ++ai)
#pragma unroll
        for (int m = 0; m < 4; ++m) {
          const int row = u.pm * 256 + ai * 128 + wr * 64 + m * 16 + fr;
          const float* xo = first ? in_row(xin, ctxin, row) + col8 : XC + (size_t)row * DM + col8;
          const f32x4 xa = *(const f32x4*)xo, xb = *(const f32x4*)(xo + 4);
          *(f32x4*)(XC + (size_t)row * DM + col8) = xa + ga * acc[ai][bj][m][0];
          *(f32x4*)(XC + (size_t)row * DM + col8 + 4) = xb + gb * acc[ai][bj][m][1];
        }
    }
  }
};
struct EpiPeerq {
  static constexpr bool PERM = true, AFTER_DRAIN = false;
  bf16_t* QP;
  __device__ __forceinline__ void operator()(const pg8::f32x4 (&acc)[2][2][4][2], const pg8::Unit& u, int wr, int wc, int fr, int fq) const {
#pragma unroll
    for (int bj = 0; bj < 2; ++bj) {
      const int col8 = u.pn * 256 + bj * 128 + wc * 32 + 8 * fq;
#pragma unroll
      for (int ai = 0; ai < 2; ++ai)
#pragma unroll
        for (int m = 0; m < 4; ++m) {
          const int row = u.pm * 256 + ai * 128 + wr * 64 + m * 16 + fr;
          const f32x4 v0 = acc[ai][bj][m][0], v1 = acc[ai][bj][m][1];
          u32x4 w; w.x = cvtpk(v0[0], v0[1]); w.y = cvtpk(v0[2], v0[3]); w.z = cvtpk(v1[0], v1[1]); w.w = cvtpk(v1[2], v1[3]);
          *(u32x4*)(QP + (size_t)row * DM + col8) = w;
        }
    }
  }
};
__device__ __forceinline__ void phase_inproj2(const Params& p, int l, unsigned char* lds) {
  {
    pg8::Gemm g{(const bf16_t*)(p.ws + WS_H), (const bf16_t*)(p.ws + WS_WIN) + (size_t)l * PW * DM, T, PW, DM};
    pg8::StaticOrder S; S.init(T, PW, p.gx, p.bx);
    EpiInproj E{(bf16_t*)(p.ws + WS_PROJ), (const float*)(p.ws + WS_ROPE), (const float*)(p.ws + WS_ROPE) + SEQ * 32};
    pg8::gemm_phase<EpiInproj, pg8::StaticOrder, true, true>((PG8_LAS unsigned char*)lds, g, S, E);
  }
  int tid_ = threadIdx.x; asm volatile("" : "+v"(tid_)); const int tid = tid_, lane = tid & 63, wid = tid >> 6;
  const bf16_t* H = (const bf16_t*)(p.ws + WS_H);
  for (int pm = p.bx; pm < T / 256; pm += p.gx) {
    const int rowb = pm * 256 + wid * 32;
    const bf16_t* WG = (const bf16_t*)(p.ws + WS_WG) + (size_t)l * 16 * DM;
    float* GT = (float*)(p.ws + WS_GATES);
    const int r16 = lane & 15, q4 = lane >> 4;
    f32x4 c0 = {0.f, 0.f, 0.f, 0.f}, c1 = {0.f, 0.f, 0.f, 0.f};
    const bf16_t* a0p = H + (size_t)(rowb + r16) * DM + q4 * 8;
    const bf16_t* a1p = a0p + (size_t)16 * DM;
    const bf16_t* bp = WG + (size_t)r16 * DM + q4 * 8;
#pragma unroll 4
    for (int ks = 0; ks < 32; ++ks) {
      const bf16x8 a0 = *(const bf16x8*)(a0p + ks * 32), a1 = *(const bf16x8*)(a1p + ks * 32), b = *(const bf16x8*)(bp + ks * 32);
      c0 = __builtin_amdgcn_mfma_f32_16x16x32_bf16(a0, b, c0, 0, 0, 0);
      c1 = __builtin_amdgcn_mfma_f32_16x16x32_bf16(a1, b, c1, 0, 0, 0);
    }
    const float gb = p.in[I_GATEB][l * 16 + r16];
#pragma unroll
    for (int j = 0; j < 4; ++j) {
      GT[(size_t)(rowb + q4 * 4 + j) * 16 + r16] = c0[j] + gb;
      GT[(size_t)(rowb + 16 + q4 * 4 + j) * 16 + r16] = c1[j] + gb;
    }
  }
}
__device__ __forceinline__ void phase_outproj2(const Params& p, int l, unsigned char* lds) {
  pg8::Gemm g{(const bf16_t*)(p.ws + WS_MIX), (const bf16_t*)(p.ws + WS_WOUT) + (size_t)l * DM * DM, T, DM, DM};
  pg8::StaticOrder S; S.init(T, DM, p.gx, p.bx);
  for (int rep = 0; rep < REP_OUTP; ++rep) {
  EpiOutproj E{(float*)(p.ws + WS_XCUR), (const float*)(p.ws + WS_MOD) + (size_t)l * 5 * 6144, p.in[I_X], p.in[I_CTX], l == 0, (rep == REP_OUTP - 1) ? 1.f : 0.f};
  pg8::gemm_phase<EpiOutproj, pg8::StaticOrder, true, true>((PG8_LAS unsigned char*)lds, g, S, E);
  }
}
__device__ __forceinline__ void phase_peerq2(const Params& p, int l, unsigned char* lds) {
  pg8::Gemm g{(const bf16_t*)(p.ws + WS_H), (const bf16_t*)(p.ws + WS_WQ) + (size_t)l * DM * DM, T, DM, DM};
  pg8::StaticOrder S; S.init(T, DM, p.gx, p.bx);
  EpiPeerq E{(bf16_t*)(p.ws + WS_PROJ)};
  pg8::gemm_phase<EpiPeerq, pg8::StaticOrder, true, true>((PG8_LAS unsigned char*)lds, g, S, E);
}

__device__ __forceinline__ void conv_unit(const Params& p, int l, int unit, unsigned char* lds) {
  int tid_ = threadIdx.x; asm volatile("" : "+v"(tid_)); const int tid = tid_, lane = tid & 63, wid = tid >> 6;
  float* U = (float*)lds;
  const bf16_t* PROJ = (const bf16_t*)(p.ws + WS_PROJ);
  bf16_t* MIX = (bf16_t*)(p.ws + WS_MIX);
  const int row0 = unit * 32, b = row0 / SEGL, s0 = row0 - b * SEGL;
  const int seglo = s0 < CTXL ? 0 : CTXL, seghi = s0 < CTXL ? CTXL : SEGL;
  for (int rr = tid >> 5; rr < 62; rr += 16) {
    const int s = s0 - 15 + rr, c8 = (tid & 31) * 8;
    f32x4 u0 = {0.f, 0.f, 0.f, 0.f}, u1 = {0.f, 0.f, 0.f, 0.f};
    if (s >= seglo && s < seghi) {
      const bf16_t* pr = PROJ + (size_t)(b * SEGL + s) * PW + c8;
      const u32x4 a1 = *(const u32x4*)pr, a2 = *(const u32x4*)(pr + 256);
      u0.x = bflo(a1.x) * sigmoidf_(bflo(a2.x)); u0.y = bfhi(a1.x) * sigmoidf_(bfhi(a2.x));
      u0.z = bflo(a1.y) * sigmoidf_(bflo(a2.y)); u0.w = bfhi(a1.y) * sigmoidf_(bfhi(a2.y));
      u1.x = bflo(a1.z) * sigmoidf_(bflo(a2.z)); u1.y = bfhi(a1.z) * sigmoidf_(bfhi(a2.z));
      u1.z = bflo(a1.w) * sigmoidf_(bflo(a2.w)); u1.w = bfhi(a1.w) * sigmoidf_(bfhi(a2.w));
    }
    *(f32x4*)(U + rr * 256 + c8) = u0; *(f32x4*)(U + rr * 256 + c8 + 4) = u1;
  }
  __syncthreads();
  float* Y = U + 62 * 256;
  const float* cw = p.in[I_CONVW] + (size_t)l * 31 * 256;
#pragma unroll 1
  for (int q = 0; q < 4; ++q) {
    const int c = lane + 64 * q;
    float w[31];
#pragma unroll
    for (int j = 0; j < 31; ++j) w[j] = cw[j * 256 + c];
    const float bias = p.in[I_CONVB][l * 256 + c];
#pragma unroll
    for (int tt = 0; tt < 4; ++tt) {
      const int t = wid * 4 + tt;
      float a = bias;
#pragma unroll
      for (int j = 0; j < 31; ++j) a += U[(t + j) * 256 + c] * w[j];
      Y[t * 256 + c] = a;
    }
  }
  asm volatile("s_waitcnt lgkmcnt(0)" ::: "memory");
  float y[4][4];
#pragma unroll
  for (int tt = 0; tt < 4; ++tt)
#pragma unroll
    for (int q = 0; q < 4; ++q) y[tt][q] = Y[(wid * 4 + tt) * 256 + lane + 64 * q];
#pragma unroll
  for (int tt = 0; tt < 4; ++tt) {
    const int t = wid * 4 + tt;
    const float mean = wave_sum((y[tt][0] + y[tt][1]) + (y[tt][2] + y[tt][3])) * (1.f / 256.f);
    float v = 0.f;
#pragma unroll
    for (int q = 0; q < 4; ++q) { const float d = y[tt][q] - mean; v += d * d; }
    const float rs = rsqrtf(wave_sum(v) * (1.f / 256.f) + EPS);
#pragma unroll
    for (int q = 0; q < 4; ++q) {
      const int c = lane + 64 * q;
      const float z = (y[tt][q] - mean) * rs * p.in[I_CLNG][l * 256 + c] + p.in[I_CLNB][l * 256 + c];
      const float o = (ABL & 1) ? 0.f : z * sigmoidf_(z);
      MIX[(size_t)(row0 + t) * DM + c] = (bf16_t)(cvtpk(o, 0.f) & 0xffffu);
    }
  }
  __syncthreads();
}

__device__ __forceinline__ int ml_cidx(int ch, int dir) { return dir == 0 ? ch : (ch < 4 ? 3 - ch : 135 - ch); }
__device__ __forceinline__ void ml_load_tile(const bf16_t* src, float* dst, int tid) {
  const int r = tid >> 3, c8 = (tid & 7) * 8;
  const u32x4 a = *(const u32x4*)(src + (size_t)r * PW + c8);
  float* d = dst + r * 65 + c8;
  d[0] = bflo(a.x); d[1] = bfhi(a.x); d[2] = bflo(a.y); d[3] = bfhi(a.y); d[4] = bflo(a.z); d[5] = bfhi(a.z); d[6] = bflo(a.w); d[7] = bfhi(a.w);
}
__device__ __forceinline__ void ml_local_unit(const Params& p, int l, int unit, unsigned char* lds) {
  int tid_ = threadIdx.x; asm volatile("" : "+v"(tid_)); const int tid = tid_, lane = tid & 63, wid = tid >> 6, r32 = lane & 31, hi = lane >> 5;
  float* Kt = (float*)lds; float* Vt = Kt + 64 * 65; float* WK = Vt + 64 * 65;
  const bf16_t* PROJ = (const bf16_t*)(p.ws + WS_PROJ);
  const float* GT = (const float*)(p.ws + WS_GATES);
  float* UL = (float*)(p.ws + WS_ULOC); float* META = (float*)(p.ws + WS_MLMETA);
  const int b = unit / (4 * NCH), hh = (unit / NCH) & 3, ch = unit % NCH;
  const int row0 = b * SEGL + ch * 64;
  ml_load_tile(PROJ + (size_t)row0 * PW + C_MK + hh * 64, Kt, tid);
  ml_load_tile(PROJ + (size_t)row0 * PW + C_MV + hh * 64, Vt, tid);
  if (wid < 2) {
    const int dir = wid;
    const float ig = GT[(size_t)(row0 + lane) * 16 + (2 * dir) * 4 + hh];
    const float lf = logsigmoidf_(GT[(size_t)(row0 + lane) * 16 + (2 * dir + 1) * 4 + hh]);
    float ps = lf;
#pragma unroll
    for (int o = 1; o < 64; o <<= 1) { const float t = __shfl_up(ps, o); if (lane >= o) ps += t; }
    const float tot = __shfl(ps, 63);
    const float wlog = dir == 0 ? (tot - ps + ig) : (ps - lf + ig);
    const float mloc = wave_max(wlog);
    WK[dir * 64 + lane] = __expf(wlog - mloc);
    if (lane == 0) {
      const int seq = (b * 4 + hh) * 2 + dir, ci = ml_cidx(ch, dir);
      META[((size_t)seq * NCH + ci) * 4 + 0] = tot; META[((size_t)seq * NCH + ci) * 4 + 1] = mloc;
    }
  }
  __syncthreads();
  {
    const int dir = wid >> 2, et = (wid >> 1) & 1, dt = wid & 1;
    const int seq = (b * 4 + hh) * 2 + dir, ci = ml_cidx(ch, dir);
    float* slot = UL + ((size_t)seq * NCH + ci) * USTRIDE;
    f32x16 acc = {};
#pragma unroll 8
    for (int ks = 0; ks < 32; ++ks) {
      const int s = 2 * ks + hi;
      const float a = WK[dir * 64 + s] * Vt[s * 65 + et * 32 + r32];
      const float bb = Kt[s * 65 + dt * 32 + r32];
      acc = __builtin_amdgcn_mfma_f32_32x32x2f32(a, bb, acc, 0, 0, 0);
    }
#pragma unroll
    for (int r = 0; r < 16; ++r) slot[(et * 32 + crow(r, hi)) * 64 + dt * 32 + r32] = acc[r];
    if (et == 0) {
      float n = 0.f;
#pragma unroll 8
      for (int i = 0; i < 32; ++i) { const int s = hi * 32 + i; n += WK[dir * 64 + s] * Kt[s * 65 + dt * 32 + r32]; }
      n += __shfl_xor(n, 32);
      if (hi == 0) slot[4096 + dt * 32 + r32] = n;
    }
  }
  __syncthreads();
}
__device__ __forceinline__ void ml_scan(const Params& p, unsigned char* lds) {
  float* UL = (float*)(p.ws + WS_ULOC); float* META = (float*)(p.ws + WS_MLMETA);
  int tid_ = threadIdx.x; asm volatile("" : "+v"(tid_));
  const int tid = tid_, lane = tid & 63, wid = tid >> 6;
  float* DEC = (float*)lds;
  float* SCL = DEC + 2 * NCH;
  float* TMP = SCL + 2 * NCH;
  for (int base0 = p.bx * 512; base0 < 32 * USTRIDE; base0 += p.gx * 512) {
    const int seq0 = base0 / USTRIDE;
    if (wid < 2) {
      const int seq = seq0 + wid;
      if (seq < 32) {
        float* mt = META + (size_t)seq * NCH * 4;
        for (int c = lane; c < NCH; c += 64) { TMP[(wid * 2 + 0) * NCH + c] = mt[c * 4 + 0]; TMP[(wid * 2 + 1) * NCH + c] = mt[c * 4 + 1]; }
        asm volatile("s_waitcnt lgkmcnt(0)" ::: "memory");
        if (lane == 0) {
          float m = 0.f;
          for (int c = 0; c < NCH; ++c) {
            const float bl = TMP[(wid * 2 + 0) * NCH + c], mloc = TMP[(wid * 2 + 1) * NCH + c];
            const float mn = fmaxf(bl + m, mloc);
            DEC[wid * NCH + c] = __expf(bl + m - mn); SCL[wid * NCH + c] = __expf(mloc - mn);
            mt[c * 4 + 2] = m;
            m = mn;
          }
        }
      }
    }
    __syncthreads();
    const int idx = base0 + tid;
    if (idx < 32 * USTRIDE) {
      const int seq = idx / USTRIDE, e = idx - seq * USTRIDE, sl = seq - seq0;
      float* bp = UL + (size_t)seq * NCH * USTRIDE + e;
      const float* dec = DEC + sl * NCH; const float* scl = SCL + sl * NCH;
      float C = 0.f;
#pragma unroll 1
      for (int c0 = 0; c0 < NCH; c0 += 12) {
        float u[12];
#pragma unroll
        for (int j = 0; j < 12; ++j) u[j] = bp[(size_t)(c0 + j) * USTRIDE];
#pragma unroll
        for (int j = 0; j < 12; ++j) { bp[(size_t)(c0 + j) * USTRIDE] = C; C = dec[c0 + j] * C + scl[c0 + j] * u[j]; }
      }
    }
    __syncthreads();
  }
}
__device__ __forceinline__ void ml_out_unit(const Params& p, int l, int unit, unsigned char* lds) {
  int tid_ = threadIdx.x; asm volatile("" : "+v"(tid_)); const int tid = tid_, lane = tid & 63, wid = tid >> 6, r32 = lane & 31, hi = lane >> 5;
  float* Qt = (float*)lds; float* Kt = Qt + 64 * 65; float* Vt = Kt + 64 * 65;
  float* Cs = Vt + 64 * 65;
  float* Ns = Cs + 2 * 64 * 65;
  float* Bq = Ns + 128;
  float* Gs = Bq + 128;
  float* Mi = Gs + 128;
  float* HB = Mi + 64;
  const bf16_t* PROJ = (const bf16_t*)(p.ws + WS_PROJ);
  const float* GT = (const float*)(p.ws + WS_GATES);
  const float* UL = (const float*)(p.ws + WS_ULOC); const float* META = (const float*)(p.ws + WS_MLMETA);
  bf16_t* MIX = (bf16_t*)(p.ws + WS_MIX);
  const int b = unit / (4 * NCH), hh = (unit / NCH) & 3, ch = unit % NCH;
  const int row0 = b * SEGL + ch * 64;
  ml_load_tile(PROJ + (size_t)row0 * PW + C_MQ + hh * 64, Qt, tid);
  ml_load_tile(PROJ + (size_t)row0 * PW + C_MK + hh * 64, Kt, tid);
  ml_load_tile(PROJ + (size_t)row0 * PW + C_MV + hh * 64, Vt, tid);
  for (int i = tid; i < 2 * USTRIDE; i += 512) {
    const int dir = i / USTRIDE, e = i - dir * USTRIDE;
    const int seq = (b * 4 + hh) * 2 + dir, ci = ml_cidx(ch, dir);
    const float v = UL[((size_t)seq * NCH + ci) * USTRIDE + e];
    if (e < 4096) Cs[dir * 64 * 65 + (e >> 6) * 65 + (e & 63)] = v; else Ns[dir * 64 + (e - 4096)] = v;
  }
  if (wid < 2) {
    const int dir = wid;
    const float ig = GT[(size_t)(row0 + lane) * 16 + (2 * dir) * 4 + hh];
    const float lf = logsigmoidf_(GT[(size_t)(row0 + lane) * 16 + (2 * dir + 1) * 4 + hh]);
    float ps = lf;
#pragma unroll
    for (int o = 1; o < 64; o <<= 1) { const float t = __shfl_up(ps, o); if (lane >= o) ps += t; }
    const float tot = __shfl(ps, 63);
    const float bc = dir == 0 ? ps : (tot - ps + lf);
    Bq[dir * 64 + lane] = bc; Gs[dir * 64 + lane] = ig - bc;
    if (lane == 0) { const int seq = (b * 4 + hh) * 2 + dir, ci = ml_cidx(ch, dir); Mi[dir] = META[((size_t)seq * NCH + ci) * 4 + 2]; }
  }
  __syncthreads();
  {
    const int dir = wid >> 2, tt = (wid >> 1) & 1, et = wid & 1;
    const int t = tt * 32 + r32;
    f32x16 sa[2] = {};
#pragma unroll 4
    for (int ks = 0; ks < 32; ++ks) {
      const float bq = Qt[t * 65 + 2 * ks + hi];
      const float a0 = Kt[(r32) * 65 + 2 * ks + hi], a1 = Kt[(32 + r32) * 65 + 2 * ks + hi];
      sa[0] = __builtin_amdgcn_mfma_f32_32x32x2f32(a0, bq, sa[0], 0, 0, 0);
      sa[1] = __builtin_amdgcn_mfma_f32_32x32x2f32(a1, bq, sa[1], 0, 0, 0);
    }
    const float bt = Bq[dir * 64 + t];
    const float inter = bt + Mi[dir];
    float mx = -INFINITY;
    f32x16 dl[2];
#pragma unroll
    for (int st = 0; st < 2; ++st)
#pragma unroll
      for (int r = 0; r < 16; ++r) {
        const int s = st * 32 + crow(r, hi);
        const bool ok = dir == 0 ? (s <= t) : (s >= t);
        const float d = ok ? bt + Gs[dir * 64 + s] : -INFINITY;
        dl[st][r] = d; mx = fmaxf(mx, d);
      }
    mx = fmaxf(mx, __shfl_xor(mx, 32));
    const float mt = fmaxf(inter, mx);
    const float iw = __expf(inter - mt);
    float rsum = 0.f;
#pragma unroll
    for (int st = 0; st < 2; ++st)
#pragma unroll
      for (int r = 0; r < 16; ++r) { const float w = __expf(dl[st][r] - mt); sa[st][r] *= w; rsum += sa[st][r]; }
    rsum += __shfl_xor(rsum, 32);
    float qn = 0.f;
#pragma unroll 8
    for (int i = 0; i < 32; ++i) { const int d = hi * 32 + i; qn += Ns[dir * 64 + d] * Qt[t * 65 + d]; }
    qn += __shfl_xor(qn, 32);
    const float den = rsum + iw * qn;
    const float rden = 1.f / fmaxf(fabsf(den), __expf(-mt));
    f32x16 an = {}, ac = {};
#pragma unroll
    for (int st = 0; st < 2; ++st)
#pragma unroll
      for (int r = 0; r < 16; ++r) {
        const float a = Vt[(st * 32 + crow(r, hi)) * 65 + et * 32 + r32];
        an = __builtin_amdgcn_mfma_f32_32x32x2f32(a, sa[st][r], an, 0, 0, 0);
      }
    const float* Cd = Cs + dir * 64 * 65;
#pragma unroll 4
    for (int ks = 0; ks < 32; ++ks) {
      const float a = Cd[(et * 32 + r32) * 65 + 2 * ks + hi];
      const float bq = Qt[t * 65 + 2 * ks + hi];
      ac = __builtin_amdgcn_mfma_f32_32x32x2f32(a, bq, ac, 0, 0, 0);
    }
#pragma unroll
    for (int r = 0; r < 16; ++r) HB[dir * 64 * 65 + t * 65 + et * 32 + crow(r, hi)] = (an[r] + iw * ac[r]) * rden;
  }
  __syncthreads();
  {
    const int t = tid >> 3, e8 = (tid & 7) * 8;
    float v[8]; float ss = 0.f;
#pragma unroll
    for (int i = 0; i < 8; ++i) { v[i] = HB[t * 65 + e8 + i] + HB[64 * 65 + t * 65 + e8 + i]; ss += v[i] * v[i]; }
    ss += __shfl_xor(ss, 1); ss += __shfl_xor(ss, 2); ss += __shfl_xor(ss, 4);
    const float rs = rsqrtf(ss * (1.f / 64.f) + EPS);
    const u32x4 ov = *(const u32x4*)(PROJ + (size_t)(row0 + t) * PW + C_MO + hh * 64 + e8);
    const float og[8] = {bflo(ov.x), bfhi(ov.x), bflo(ov.y), bfhi(ov.y), bflo(ov.z), bfhi(ov.z), bflo(ov.w), bfhi(ov.w)};
    const float* g = p.in[I_MNORMG] + l * 64 + e8;
    float o[8];
#pragma unroll
    for (int i = 0; i < 8; ++i) o[i] = (ABL & 2) ? 0.f : v[i] * rs * g[i] * sigmoidf_(og[i]);
    u32x4 w; w.x = cvtpk(o[0], o[1]); w.y = cvtpk(o[2], o[3]); w.z = cvtpk(o[4], o[5]); w.w = cvtpk(o[6], o[7]);
    *(u32x4*)(MIX + (size_t)(row0 + t) * DM + 256 + hh * 64 + e8) = w;
  }
  __syncthreads();
}


#define KSWZ(row, colB) ((row) * 256 + ((colB) ^ (((row) & 15) << 4)))
#define SBAR() __builtin_amdgcn_sched_barrier(0)
constexpr int ATT_SHM_V = 64 * 128 * 2, ATT_SHM_K = 64 * 128 * 2;
constexpr float ATT_THR = 11.541560327111707f;
__device__ __forceinline__ int v_st(int k, int c) { const int kk = (k & ~0xC) | ((k & 4) << 1) | ((k & 8) >> 1); return ((kk >> 3) * 4 + (c >> 5)) * 512 + ((kk & 7) * 32 + (c & 31)) * 2; }
__device__ __forceinline__ int v_rd_base(int lane) { return ((lane & 3) << 3) | (((lane >> 2) & 3) << 6) | (((lane >> 4) & 1) << 5) | (((lane >> 5) & 1) << 8); }
constexpr int v_rd_off(int d0, int ks, int half) { return d0 * 512 + ks * 4096 + half * 2048; }
template <int OFF> __device__ __forceinline__ s16x4 tr_read(int vb) {
  s16x4 r; asm volatile("ds_read_b64_tr_b16 %0, %1 offset:%2" : "=&v"(r) : "v"(vb), "i"(OFF) : "memory"); return r;
}
template <int D0> __device__ __forceinline__ void pv_one(f32x16& od, int vb, bf16x8 pa0, bf16x8 pa1, bf16x8 pa2, bf16x8 pa3) {
  const s16x4 l0 = tr_read<v_rd_off(D0, 0, 0)>(vb), h0 = tr_read<v_rd_off(D0, 0, 1)>(vb), l1 = tr_read<v_rd_off(D0, 1, 0)>(vb), h1 = tr_read<v_rd_off(D0, 1, 1)>(vb);
  const s16x4 l2 = tr_read<v_rd_off(D0, 2, 0)>(vb), h2 = tr_read<v_rd_off(D0, 2, 1)>(vb), l3 = tr_read<v_rd_off(D0, 3, 0)>(vb), h3 = tr_read<v_rd_off(D0, 3, 1)>(vb);
  asm volatile("s_waitcnt lgkmcnt(0)" ::: "memory"); SBAR();
#define PK(L, H) (bf16x8){L[0], L[1], L[2], L[3], H[0], H[1], H[2], H[3]}
  od = __builtin_amdgcn_mfma_f32_32x32x16_bf16(pa0, PK(l0, h0), od, 0, 0, 0);
  od = __builtin_amdgcn_mfma_f32_32x32x16_bf16(pa1, PK(l1, h1), od, 0, 0, 0);
  od = __builtin_amdgcn_mfma_f32_32x32x16_bf16(pa2, PK(l2, h2), od, 0, 0, 0);
  od = __builtin_amdgcn_mfma_f32_32x32x16_bf16(pa3, PK(l3, h3), od, 0, 0, 0);
#undef PK
}
template <int D0> __device__ __forceinline__ void pv_two(f32x16& oa, f32x16& ob, int vb, bf16x8 a0, bf16x8 a1, bf16x8 a2, bf16x8 a3, bf16x8 b0, bf16x8 b1, bf16x8 b2, bf16x8 b3) {
  const s16x4 l0 = tr_read<v_rd_off(D0, 0, 0)>(vb), h0 = tr_read<v_rd_off(D0, 0, 1)>(vb), l1 = tr_read<v_rd_off(D0, 1, 0)>(vb), h1 = tr_read<v_rd_off(D0, 1, 1)>(vb);
  const s16x4 l2 = tr_read<v_rd_off(D0, 2, 0)>(vb), h2 = tr_read<v_rd_off(D0, 2, 1)>(vb), l3 = tr_read<v_rd_off(D0, 3, 0)>(vb), h3 = tr_read<v_rd_off(D0, 3, 1)>(vb);
  asm volatile("s_waitcnt lgkmcnt(0)" ::: "memory"); SBAR();
#define PK(L, H) (bf16x8){L[0], L[1], L[2], L[3], H[0], H[1], H[2], H[3]}
  const bf16x8 v0 = PK(l0, h0), v1 = PK(l1, h1), v2 = PK(l2, h2), v3 = PK(l3, h3);
  oa = __builtin_amdgcn_mfma_f32_32x32x16_bf16(a0, v0, oa, 0, 0, 0);
  ob = __builtin_amdgcn_mfma_f32_32x32x16_bf16(b0, v0, ob, 0, 0, 0);
  oa = __builtin_amdgcn_mfma_f32_32x32x16_bf16(a1, v1, oa, 0, 0, 0);
  ob = __builtin_amdgcn_mfma_f32_32x32x16_bf16(b1, v1, ob, 0, 0, 0);
  oa = __builtin_amdgcn_mfma_f32_32x32x16_bf16(a2, v2, oa, 0, 0, 0);
  ob = __builtin_amdgcn_mfma_f32_32x32x16_bf16(b2, v2, ob, 0, 0, 0);
  oa = __builtin_amdgcn_mfma_f32_32x32x16_bf16(a3, v3, oa, 0, 0, 0);
  ob = __builtin_amdgcn_mfma_f32_32x32x16_bf16(b3, v3, ob, 0, 0, 0);
#undef PK
}
__device__ __forceinline__ void att_qkt(f32x16& p0, f32x16& p1, const unsigned char* Ks, const unsigned char* Qs, int qrow, int comp, int r32, int hi, float init) {
#pragma unroll
  for (int r = 0; r < 16; ++r) { p0[r] = init; p1[r] = init; }
#pragma unroll
  for (int d0 = 0; d0 < 4; ++d0) {
    const int cb = ((comp * 4 + d0) * 16 + hi * 8) * 2;
    const bf16x8 b0 = *(const bf16x8*)(Ks + KSWZ(r32, cb));
    const bf16x8 b1 = *(const bf16x8*)(Ks + KSWZ(32 + r32, cb));
    const bf16x8 q = *(const bf16x8*)(Qs + KSWZ(qrow, cb));
    p0 = __builtin_amdgcn_mfma_f32_32x32x16_bf16(b0, q, p0, 0, 0, 0);
    p1 = __builtin_amdgcn_mfma_f32_32x32x16_bf16(b1, q, p1, 0, 0, 0);
  }
}
__device__ __forceinline__ void att_softmax(f32x16& p0, f32x16& p1, float& m_reg, float& l_reg, float& alpha, bool first, bf16x8& pa0, bf16x8& pa1, bf16x8& pa2, bf16x8& pa3) {
  float pmax = p0[0];
#pragma unroll
  for (int r = 1; r < 16; ++r) pmax = fmaxf(pmax, p0[r]);
#pragma unroll
  for (int r = 0; r < 16; ++r) pmax = fmaxf(pmax, p1[r]);
  { auto rr = __builtin_amdgcn_permlane32_swap(__float_as_uint(pmax), __float_as_uint(pmax), false, false);
    pmax = fmaxf(__uint_as_float(rr[0]), __uint_as_float(rr[1])); }
  alpha = 1.f;
  if (__builtin_expect(first || !__all(pmax <= ATT_THR), 0)) {
    const float delta = first ? pmax : fmaxf(pmax, 0.f);
    alpha = first ? 0.f : __builtin_amdgcn_exp2f(-delta);
    m_reg = (first ? 0.f : m_reg) + delta;
#pragma unroll
    for (int r = 0; r < 16; ++r) { p0[r] -= delta; p1[r] -= delta; }
  }
#pragma unroll
  for (int r = 0; r < 16; ++r) { p0[r] = __builtin_amdgcn_exp2f(p0[r]); p1[r] = __builtin_amdgcn_exp2f(p1[r]); }
  float ps = 0.f;
#pragma unroll
  for (int r = 0; r < 16; ++r) ps += p0[r];
#pragma unroll
  for (int r = 0; r < 16; ++r) ps += p1[r];
  { auto rr = __builtin_amdgcn_permlane32_swap(__float_as_uint(ps), __float_as_uint(ps), false, false);
    ps = __uint_as_float(rr[0]) + __uint_as_float(rr[1]); }
  l_reg = l_reg * alpha + ps;
#define PK4(P, BASE, OUT) do { unsigned a0 = cvtpk(P[BASE + 0], P[BASE + 1]), a1 = cvtpk(P[BASE + 2], P[BASE + 3]);   \
    unsigned b0 = cvtpk(P[BASE + 4], P[BASE + 5]), b1 = cvtpk(P[BASE + 6], P[BASE + 7]);                              \
    auto r0 = __builtin_amdgcn_permlane32_swap(a0, b0, false, false); auto r1 = __builtin_amdgcn_permlane32_swap(a1, b1, false, false); \
    u32x4 w = {r0[0], r1[0], r0[1], r1[1]}; OUT = *reinterpret_cast<bf16x8*>(&w); } while (0)
  PK4(p0, 0, pa0); PK4(p0, 8, pa1); PK4(p1, 0, pa2); PK4(p1, 8, pa3);
#undef PK4
}
__device__ __forceinline__ void att_unit(const bf16_t* __restrict__ Qb, const bf16_t* __restrict__ Kh, const bf16_t* __restrict__ Vh, bf16_t* __restrict__ Ob,
                                         int nkeys, float lam, const float* __restrict__ ng, float oscale, unsigned char* lds) {
  int tid_ = threadIdx.x; asm volatile("" : "+v"(tid_)); const int tid = tid_, wid = tid >> 6, lane = tid & 63, r32 = lane & 31, hi = lane >> 5;
  unsigned char* V_lds = lds; unsigned char* K_lds = lds + 2 * ATT_SHM_V;
  float* wsl = (float*)(lds + 2 * ATT_SHM_V + 2 * ATT_SHM_K) + wid * 64; float* li_l = wsl; float* al_l = wsl + 32;
  float m0 = 0.f, l0 = 0.f, m1 = 0.f, l1 = 0.f;
  f32x16 o0[4] = {}, o1[4] = {};
  unsigned char* Q_lds = lds + 2 * ATT_SHM_V + 2 * ATT_SHM_K + 2048;
#pragma unroll
  for (int i = 0; i < 8; ++i) { const int id = tid + 512 * i, qrw = id >> 4, ch = id & 15;
    *(bf16x8*)(Q_lds + KSWZ(qrw, ch * 16)) = *(const bf16x8*)(Qb + (size_t)qrw * PW + ch * 8); }
  const int qrow = wid * 32 + r32;
  const int vb0 = (int)(uintptr_t)V_lds + v_rd_base(lane);
  int kso[2], vso[2];
#pragma unroll
  for (int i = 0; i < 2; ++i) {
    const int o16 = tid + 512 * i;
    { const int row = o16 >> 4, cs = (o16 & 15) ^ (row & 15); kso[i] = row * PW + cs * 8; }
    { const int sub = o16 >> 5, r16 = o16 & 31, kk = (sub >> 2) * 8 + (r16 >> 2), k = (kk & ~0xC) | ((kk & 4) << 1) | ((kk & 8) >> 1), c = (sub & 3) * 32 + (r16 & 3) * 8; vso[i] = k * PW + c; }
  }
  const unsigned ldsw = (unsigned)__builtin_amdgcn_readfirstlane(wid) * 1024u;
#define GSTAGE(b, k0) do { _Pragma("unroll") for (int i_ = 0; i_ < 2; ++i_) { \
    __builtin_amdgcn_global_load_lds((const unsigned*)(Vh + (size_t)(k0) * PW + vso[i_]), (LAS unsigned*)(V_lds + (b) * ATT_SHM_V + ldsw + i_ * 8192), 16, 0, 0); \
    __builtin_amdgcn_global_load_lds((const unsigned*)(Kh + (size_t)(k0) * PW + kso[i_]), (LAS unsigned*)(K_lds + (b) * ATT_SHM_K + ldsw + i_ * 8192), 16, 0, 0); } } while (0)
#define RESC(o, a) do { if (__any((a) < 1.f)) { if (hi == 0) al_l[r32] = (a); asm volatile("s_waitcnt lgkmcnt(0)" ::: "memory"); \
    _Pragma("unroll") for (int d = 0; d < 4; ++d) _Pragma("unroll") for (int r = 0; r < 16; ++r) o[d][r] *= al_l[crow(r, hi)]; } } while (0)
  const int NT = nkeys / 64;
  GSTAGE(0, 0); asm volatile("s_waitcnt vmcnt(0)" ::: "memory"); __syncthreads();
  for (int j = 0; j < NT; ++j) {
    const int cur = j & 1;
    if (j + 1 < NT) GSTAGE(cur ^ 1, (j + 1) * 64);
    const unsigned char* Kc = K_lds + cur * ATT_SHM_K; const int vb = vb0 + cur * ATT_SHM_V;
    f32x16 p0, p1, q0, q1; float alphaA, alphaB; bf16x8 pa0, pa1, pa2, pa3, pb0, pb1, pb2, pb3;
    const bool first = (j == 0);
    att_qkt(p0, p1, Kc, Q_lds, qrow, 0, r32, hi, first ? 0.f : -m0);
    att_qkt(q0, q1, Kc, Q_lds, qrow, 1, r32, hi, first ? 0.f : -m1);
    att_softmax(p0, p1, m0, l0, alphaA, first, pa0, pa1, pa2, pa3);
    att_softmax(q0, q1, m1, l1, alphaB, first, pb0, pb1, pb2, pb3);
    RESC(o0, alphaA);
    RESC(o1, alphaB);
    pv_two<0>(o0[0], o1[0], vb, pa0, pa1, pa2, pa3, pb0, pb1, pb2, pb3); pv_two<1>(o0[1], o1[1], vb, pa0, pa1, pa2, pa3, pb0, pb1, pb2, pb3);
    pv_two<2>(o0[2], o1[2], vb, pa0, pa1, pa2, pa3, pb0, pb1, pb2, pb3); pv_two<3>(o0[3], o1[3], vb, pa0, pa1, pa2, pa3, pb0, pb1, pb2, pb3);
    asm volatile("s_waitcnt vmcnt(0)" ::: "memory");
    __syncthreads();
  }
  if (hi == 0) { li_l[r32] = 1.f / l0; al_l[r32] = lam / l1; }
  asm volatile("s_waitcnt lgkmcnt(0)" ::: "memory");
  float ss[16];
#pragma unroll
  for (int r = 0; r < 16; ++r) {
    const float a = li_l[crow(r, hi)], bq = al_l[crow(r, hi)];
    float s = 0.f;
#pragma unroll
    for (int d = 0; d < 4; ++d) { const float v = o0[d][r] * a - o1[d][r] * bq; o0[d][r] = v; s += v * v; }
    s += __shfl_xor(s, 1); s += __shfl_xor(s, 2); s += __shfl_xor(s, 4); s += __shfl_xor(s, 8); s += __shfl_xor(s, 16);
    ss[r] = rsqrtf(s * (1.f / 128.f) + EPS) * oscale;
  }
  bf16_t* Ow = Ob + (size_t)(wid * 32) * DM;
#pragma unroll
  for (int d = 0; d < 4; ++d) {
    const float g = ng[d * 32 + r32];
#pragma unroll
    for (int r = 0; r < 16; ++r) Ow[(size_t)crow(r, hi) * DM + d * 32 + r32] = (ABL & 4) ? (bf16_t)0 : (bf16_t)(cvtpk(o0[d][r] * ss[r] * g, 0.f) & 0xffffu);
  }
  __syncthreads();
#undef GSTAGE
#undef RESC
}

__device__ __forceinline__ float ins16(float (&a)[16], float x) {
#pragma unroll
  for (int i = 0; i < 16; ++i) { const float h = fmaxf(a[i], x); x = fminf(a[i], x); a[i] = h; }
  return x;
}
__device__ __forceinline__ float gelu_erf(float x) { return 0.5f * x * (1.f + erff(x * 0.70710678118654752440f)); }
#define XB_TMO      128
#define XB_XCNT(j)  (256  + 64 * (j))
#define XB_XSUB(j)  (1280 + 64 * (j))
#define XB_XGEN(j)  (2304 + 64 * (j))
#define XB_TOP      3328
#define XB_TOPGEN   3392
#define XCD_BAR_WORDS 3456
#define XB_SPIN_CAP (1u << 22)
__device__ __forceinline__ unsigned xb_ld(unsigned* p)              { return __hip_atomic_load(p, __ATOMIC_RELAXED, __HIP_MEMORY_SCOPE_AGENT); }
__device__ __forceinline__ unsigned xb_add(unsigned* p, unsigned v) { return __hip_atomic_fetch_add(p, v, __ATOMIC_RELAXED, __HIP_MEMORY_SCOPE_AGENT); }
__device__ __forceinline__ unsigned xb_xcc_id() { return (unsigned)__builtin_amdgcn_s_getreg((3 << 11) | 20) & 0xFu; }
#define XB_SPIN(cond, bar) do { unsigned _sp = 0; while (cond) { __builtin_amdgcn_s_sleep(1); \
    if ((++_sp & 255u) == 0u) { if (xb_ld(&(bar)[XB_TMO])) break; if (_sp > XB_SPIN_CAP) { atomicAdd(&(bar)[XB_TMO], 1u); break; } } } } while (0)
struct XcdBarrier { unsigned* bar; unsigned x; volatile LAS unsigned* st; };
__device__ __forceinline__ XcdBarrier xcd_barrier_post(unsigned* bar, volatile LAS unsigned* st) {
  XcdBarrier b; b.bar = bar; b.x = xb_xcc_id(); b.st = st;
  if (threadIdx.x == 0) (void)xb_add(&bar[XB_XCNT(b.x)], 1u);
  return b;
}
__device__ __forceinline__ void xcd_barrier_complete(unsigned* bar, unsigned x, unsigned& nloc, unsigned& nx) {
  const unsigned G = gridDim.x * gridDim.y * gridDim.z;
  unsigned sum, cnt, mine, sp = 0u;
  for (;;) {
    sum = 0u; cnt = 0u; mine = 0u;
#pragma unroll
    for (unsigned j = 0; j < 16; ++j) { const unsigned c = xb_ld(&bar[XB_XCNT(j)]); sum += c; cnt += (c > 0u) ? 1u : 0u; mine = (j == x) ? c : mine; }
    if (sum == G) break;
    __builtin_amdgcn_s_sleep(1);
    if ((++sp & 255u) == 0u) { if (xb_ld(&bar[XB_TMO])) break; if (sp > XB_SPIN_CAP) { atomicAdd(&bar[XB_TMO], 1u); break; } }
  }
  nloc = mine > 0u ? mine : 1u; nx = cnt > 0u ? cnt : 1u;
}
__device__ __forceinline__ void xcd_barrier(const XcdBarrier& b) {
  asm volatile("s_waitcnt vmcnt(0)" ::: "memory");
  __syncthreads();
  if (threadIdx.x == 0) {
    unsigned* bar = b.bar;
    __builtin_amdgcn_s_waitcnt(0);
    unsigned nloc = b.st[0], nx = b.st[1];
    if (nloc == 0u) { xcd_barrier_complete(bar, b.x, nloc, nx); b.st[0] = nloc; b.st[1] = nx; }
    const unsigned old = xb_add(&bar[XB_XSUB(b.x)], 1u);
    const unsigned gen = old / nloc;
    if (old + 1u == (gen + 1u) * nloc) {
      __builtin_amdgcn_fence(__ATOMIC_RELEASE, "agent");
      asm volatile("s_waitcnt vmcnt(0)" ::: "memory");
      const unsigned og = xb_add(&bar[XB_TOP], 1u);
      const unsigned tg = og / nx;
      if (og + 1u == (tg + 1u) * nx) xb_add(&bar[XB_TOPGEN], 1u);
      else XB_SPIN(xb_ld(&bar[XB_TOPGEN]) == tg, bar);
      __builtin_amdgcn_fence(__ATOMIC_ACQUIRE, "agent");
      xb_add(&bar[XB_XGEN(b.x)], 1u);
      asm volatile("s_waitcnt vmcnt(0)" ::: "memory");
    } else {
      XB_SPIN(xb_ld(&bar[XB_XGEN(b.x)]) == gen, bar);
      __builtin_amdgcn_fence(__ATOMIC_ACQUIRE, "agent");
      asm volatile("s_waitcnt vmcnt(0)" ::: "memory");
    }
  }
  __syncthreads();
}

constexpr size_t RT_STRIDE = (size_t)T * 128 * 4;
__device__ __forceinline__ void route_unit(const Params& p, int l, int unit, unsigned char* lds) {
  int tid_ = threadIdx.x; asm volatile("" : "+v"(tid_)); const int tid = tid_, lane = tid & 63, wid = tid >> 6, r32 = lane & 31, hi = lane >> 5;
  unsigned char* IDX = lds;
  int* UE = (int*)(lds + 8192); float* UG = (float*)(lds + 8192 + 16384); float* US = (float*)(lds + 8192 + 32768);
  int* EIDG = (int*)(p.ws + WS_ULOC); float* GWG = (float*)(p.ws + WS_ULOC + RT_STRIDE); float* SUG = (float*)(p.ws + WS_ULOC + 2 * RT_STRIDE);
  const float* PSC = (const float*)(p.ws + WS_PSC);
  const int row0 = unit * 32;
  const bf16_t* QP = (const bf16_t*)(p.ws + WS_PROJ);
  const bf16_t* KEYS = (const bf16_t*)(p.ws + WS_KEYS) + (size_t)l * 131072;
  for (int rrep = 0; rrep < REP_ROUTE; ++rrep) {
    const int h = wid;
    float top[2][16];
#pragma unroll
    for (int pp = 0; pp < 2; ++pp) {
      const bf16_t* qrow = QP + (size_t)(row0 + r32) * DM + h * 128 + pp * 64 + hi * 8;
      const bf16_t* kb = KEYS + ((size_t)(h * 2 + pp) * 128 + r32) * 64 + hi * 8;
      bf16x8 bq[4];
#pragma unroll
      for (int ks = 0; ks < 4; ++ks) bq[ks] = *(const bf16x8*)(qrow + ks * 16);
      float (&lst)[16] = top[pp];
#pragma unroll
      for (int i = 0; i < 16; ++i) lst[i] = -INFINITY;
#pragma unroll
      for (int nt = 0; nt < 4; ++nt) {
        f32x16 acc = {};
#pragma unroll
        for (int ks = 0; ks < 4; ++ks) {
          const bf16x8 ak = *(const bf16x8*)(kb + (size_t)nt * 32 * 64 + ks * 16);
          acc = __builtin_amdgcn_mfma_f32_32x32x16_bf16(ak, bq[ks], acc, 0, 0, 0);
        }
#pragma unroll
        for (int r = 0; r < 16; ++r) {
          const unsigned key = (__float_as_uint(acc[r]) & ~0x7Fu) | (unsigned)(nt * 32 + crow(r, hi));
          ins16(lst, __uint_as_float(key));
        }
        SBAR();
      }
      float oth[16];
#pragma unroll
      for (int i = 0; i < 16; ++i) oth[i] = __shfl_xor(lst[i], 32);
#pragma unroll
      for (int i = 0; i < 16; ++i) ins16(lst, oth[i]);
      if (hi == 0) {
        unsigned w[4];
#pragma unroll
        for (int i = 0; i < 4; ++i)
          w[i] = (__float_as_uint(lst[4 * i]) & 0x7Fu) | ((__float_as_uint(lst[4 * i + 1]) & 0x7Fu) << 8) | ((__float_as_uint(lst[4 * i + 2]) & 0x7Fu) << 16) | ((__float_as_uint(lst[4 * i + 3]) & 0x7Fu) << 24);
        *(u32x4*)(IDX + ((r32 * 8 + h) * 2 + pp) * 16) = (u32x4){w[0], w[1], w[2], w[3]};
      }
    }
    float best[16];
#pragma unroll
    for (int i = 0; i < 16; ++i) best[i] = -INFINITY;
#pragma unroll
    for (int i = 0; i < 16; ++i)
#pragma unroll
      for (int j = 0; j < 16; ++j)
        if ((i + 1) * (j + 1) <= 16) {
          const float s = __uint_as_float(__float_as_uint(top[0][i]) & ~0x7Fu) + __uint_as_float(__float_as_uint(top[1][j]) & ~0x7Fu);
          ins16(best, __uint_as_float((__float_as_uint(s) & ~0xFFu) | (unsigned)(i * 16 + j)));
        }
    asm volatile("s_waitcnt lgkmcnt(0)" ::: "memory");
    if (hi == 0) {
      const unsigned char* ib = IDX + ((r32 * 8 + h) * 2) * 16;
      const float mx = __uint_as_float(__float_as_uint(best[0]) & ~0xFFu);
      float w[16]; float sum = 0.f;
#pragma unroll
      for (int k = 0; k < 16; ++k) { w[k] = __expf(__uint_as_float(__float_as_uint(best[k]) & ~0xFFu) - mx); sum += w[k]; }
      const float rsum = 1.f / sum;
      int ee[16]; float su_[16], sv_[16];
#pragma unroll
      for (int k = 0; k < 16; ++k) {
        const unsigned ij = __float_as_uint(best[k]) & 0xFFu;
        ee[k] = (int)ib[ij >> 4] * 128 + (int)ib[16 + (ij & 15)];
      }
#pragma unroll
      for (int k = 0; k < 16; ++k) { su_[k] = PSC[(size_t)l * NEXP + ee[k]]; sv_[k] = PSC[(size_t)(DEPTH + l) * NEXP + ee[k]]; }
#pragma unroll
      for (int k = 0; k < 16; ++k) {
        UE[r32 * 128 + h * 16 + k] = ee[k]; UG[r32 * 128 + h * 16 + k] = w[k] * rsum * sv_[k];
        US[r32 * 128 + h * 16 + k] = su_[k];
      }
    }
  }
  __syncthreads();
#pragma unroll 1
  for (int tt = 0; tt < 4; ++tt) {
    const int t = wid * 4 + tt;
    const int k0 = UE[t * 128 + lane], k1 = UE[t * 128 + 64 + lane];
    const float g0 = UG[t * 128 + lane], g1 = UG[t * 128 + 64 + lane], s0 = US[t * 128 + lane], s1 = US[t * 128 + 64 + lane];
    const int b0 = k0 >> 10, b1 = k1 >> 10;
    int base = 0, pos0 = 0, pos1 = 0;
#pragma unroll
    for (int b = 0; b < 16; ++b) {
      const unsigned long long m0 = __ballot(b0 == b), m1 = __ballot(b1 == b);
      const int c0 = __popcll(m0), c1 = __popcll(m1);
      const unsigned long long lt = (1ull << lane) - 1ull;
      if (b0 == b) pos0 = base + __popcll(m0 & lt);
      if (b1 == b) pos1 = base + c0 + __popcll(m1 & lt);
      base += c0 + c1;
    }
    const size_t ro = (size_t)(row0 + t) * 128;
    EIDG[ro + pos0] = k0; GWG[ro + pos0] = g0; SUG[ro + pos0] = s0;
    EIDG[ro + pos1] = k1; GWG[ro + pos1] = g1; SUG[ro + pos1] = s1;
  }
}
struct TokPref { int e0, e1; float g0, g1, s0, s1; u32x4 hA, hB; };
__device__ __forceinline__ void tok_prefetch(const Params& p, int row, int lane, TokPref& t) {
  const int* EIDG = (const int*)(p.ws + WS_ULOC) + (size_t)row * 128; const float* GWG = (const float*)(p.ws + WS_ULOC + RT_STRIDE) + (size_t)row * 128;
  const float* SUG = (const float*)(p.ws + WS_ULOC + 2 * RT_STRIDE) + (size_t)row * 128;
  const bf16_t* H = (const bf16_t*)(p.ws + WS_H);
  t.e0 = EIDG[lane]; t.e1 = EIDG[64 + lane]; t.g0 = GWG[lane]; t.g1 = GWG[64 + lane]; t.s0 = SUG[lane]; t.s1 = SUG[64 + lane];
  t.hA = *(const u32x4*)(H + (size_t)row * DM + lane * 16); t.hB = *(const u32x4*)(H + (size_t)row * DM + lane * 16 + 8);
}
__device__ __forceinline__ void gather_token(const Params& p, int l, int row, int nextrow, TokPref& tp, unsigned char* lds, int lane, int wid) {
  int* EW = (int*)(lds + wid * 2048); float* GWl = (float*)(lds + wid * 2048 + 512); float* SWl = (float*)(lds + wid * 2048 + 1024);
  const bf16_t* H = (const bf16_t*)(p.ws + WS_H);
  const unsigned char* PUq = p.ws + WS_PU + (size_t)l * NEXP * DM;
  const unsigned char* PVq = p.ws + WS_PV + (size_t)l * NEXP * DM;
  float* XC = (float*)(p.ws + WS_XCUR);
  const float* MOD = (const float*)(p.ws + WS_MOD);
  EW[lane] = tp.e0; EW[64 + lane] = tp.e1; GWl[lane] = tp.g0; GWl[64 + lane] = tp.g1; SWl[lane] = tp.s0; SWl[64 + lane] = tp.s1;
  asm volatile("s_waitcnt lgkmcnt(0)" ::: "memory");
  {
    float hf[16];
    {
      const u32x4 hA = tp.hA, hB = tp.hB;
      hf[0] = bflo(hA.x); hf[1] = bfhi(hA.x); hf[2] = bflo(hA.y); hf[3] = bfhi(hA.y); hf[4] = bflo(hA.z); hf[5] = bfhi(hA.z); hf[6] = bflo(hA.w); hf[7] = bfhi(hA.w);
      hf[8] = bflo(hB.x); hf[9] = bfhi(hB.x); hf[10] = bflo(hB.y); hf[11] = bfhi(hB.y); hf[12] = bflo(hB.z); hf[13] = bfhi(hB.z); hf[14] = bflo(hB.w); hf[15] = bfhi(hB.w);
    }
    if (nextrow >= 0) tok_prefetch(p, nextrow, lane, tp);
    f32x4 xpre[4];
    { const float* xr_ = XC + (size_t)row * DM + lane * 16;
#pragma unroll
      for (int v4 = 0; v4 < 4; ++v4) xpre[v4] = *(const f32x4*)(xr_ + v4 * 4); }
    float acc[16];
    for (int rep = 0; rep < REP_PEER; ++rep) {
#pragma unroll
    for (int i = 0; i < 16; ++i) acc[i] = 0.f;
    u32x4 uq[8];
#pragma unroll
    for (int i = 0; i < 8; ++i) { const int e0 = __builtin_amdgcn_readfirstlane(EW[i]); uq[i] = *(const u32x4*)(PUq + (size_t)e0 * DM + lane * 16); }
    for (int g8 = 0; g8 < 16; ++g8) {
      int eid[8]; float gwt[8]; u32x4 vq[8];
#pragma unroll
      for (int i = 0; i < 8; ++i) {
        eid[i] = __builtin_amdgcn_readfirstlane(EW[g8 * 8 + i]);
        gwt[i] = __uint_as_float(__builtin_amdgcn_readfirstlane(__float_as_uint(GWl[g8 * 8 + i])));
        vq[i] = *(const u32x4*)(PVq + (size_t)eid[i] * DM + lane * 16);
      }
      float d[8];
#pragma unroll
      for (int i = 0; i < 8; ++i) {
        const float su = __uint_as_float(__builtin_amdgcn_readfirstlane(__float_as_uint(SWl[g8 * 8 + i])));
        float a0 = 0.f, a1 = 0.f;
#define DQ(W, K) { const f32x2 lo_ = __builtin_amdgcn_cvt_pk_f32_fp8((int)(W), false), hi_ = __builtin_amdgcn_cvt_pk_f32_fp8((int)(W), true); \
          a0 += lo_.x * hf[K]; a1 += lo_.y * hf[K + 1]; a0 += hi_.x * hf[K + 2]; a1 += hi_.y * hf[K + 3]; }
        DQ(uq[i].x, 0) DQ(uq[i].y, 4) DQ(uq[i].z, 8) DQ(uq[i].w, 12)
#undef DQ
        d[i] = (a0 + a1) * su;
      }
      if (g8 < 15) {
#pragma unroll
        for (int i = 0; i < 8; ++i) { const int e0 = __builtin_amdgcn_readfirstlane(EW[(g8 + 1) * 8 + i]); uq[i] = *(const u32x4*)(PUq + (size_t)e0 * DM + lane * 16); }
      }
      float tot;
      {
        auto s01 = __builtin_amdgcn_permlane32_swap(__float_as_uint(d[0]), __float_as_uint(d[1]), false, false);
        auto s23 = __builtin_amdgcn_permlane32_swap(__float_as_uint(d[2]), __float_as_uint(d[3]), false, false);
        auto s45 = __builtin_amdgcn_permlane32_swap(__float_as_uint(d[4]), __float_as_uint(d[5]), false, false);
        auto s67 = __builtin_amdgcn_permlane32_swap(__float_as_uint(d[6]), __float_as_uint(d[7]), false, false);
        const float q01 = __uint_as_float(s01[0]) + __uint_as_float(s01[1]), q23 = __uint_as_float(s23[0]) + __uint_as_float(s23[1]);
        const float q45 = __uint_as_float(s45[0]) + __uint_as_float(s45[1]), q67 = __uint_as_float(s67[0]) + __uint_as_float(s67[1]);
        auto ta = __builtin_amdgcn_permlane16_swap(__float_as_uint(q01), __float_as_uint(q23), false, false);
        auto tb = __builtin_amdgcn_permlane16_swap(__float_as_uint(q45), __float_as_uint(q67), false, false);
        const float r0123 = __uint_as_float(ta[0]) + __uint_as_float(ta[1]);
        const float r4567 = __uint_as_float(tb[0]) + __uint_as_float(tb[1]);
        const bool b3 = (lane & 8) != 0;
        const float keep = b3 ? r4567 : r0123, send = b3 ? r0123 : r4567;
        float x = keep + __shfl_xor(send, 8);
        x += __shfl_xor(x, 4); x += __shfl_xor(x, 2); x += __shfl_xor(x, 1);
        tot = x;
      }
      float ge;
      {
        const float v = tot, av = fabsf(v), tq = __builtin_amdgcn_rcpf(av * 0.2316418882f + 1.0f);
        float q = tq * 0.5307027145f + (-0.7265760135f); q = q * tq + 0.7107068705f; q = q * tq + (-0.142248368f); q = q * tq + 0.127414796f; q = q * tq;
        const float ex = __builtin_amdgcn_exp2f(v * v * (-0.72134752044f));
        const float m = v * (q * ex), r = v - m;
        ge = v < 0.f ? m : r;
      }
      float c[8];
      c[0] = __uint_as_float(__builtin_amdgcn_readlane(__float_as_uint(ge), 0)) * gwt[0];  c[4] = __uint_as_float(__builtin_amdgcn_readlane(__float_as_uint(ge), 8)) * gwt[4];
      c[2] = __uint_as_float(__builtin_amdgcn_readlane(__float_as_uint(ge), 16)) * gwt[2]; c[6] = __uint_as_float(__builtin_amdgcn_readlane(__float_as_uint(ge), 24)) * gwt[6];
      c[1] = __uint_as_float(__builtin_amdgcn_readlane(__float_as_uint(ge), 32)) * gwt[1]; c[5] = __uint_as_float(__builtin_amdgcn_readlane(__float_as_uint(ge), 40)) * gwt[5];
      c[3] = __uint_as_float(__builtin_amdgcn_readlane(__float_as_uint(ge), 48)) * gwt[3]; c[7] = __uint_as_float(__builtin_amdgcn_readlane(__float_as_uint(ge), 56)) * gwt[7];
#pragma unroll
      for (int i = 0; i < 8; ++i) {
#define AQ(W, K) { const f32x2 lo_ = __builtin_amdgcn_cvt_pk_f32_fp8((int)(W), false), hi_ = __builtin_amdgcn_cvt_pk_f32_fp8((int)(W), true); \
          acc[K] += c[i] * lo_.x; acc[K + 1] += c[i] * lo_.y; acc[K + 2] += c[i] * hi_.x; acc[K + 3] += c[i] * hi_.y; }
        AQ(vq[i].x, 0) AQ(vq[i].y, 4) AQ(vq[i].z, 8) AQ(vq[i].w, 12)
#undef AQ
      }
    }
    }
    SBAR();
    const int mr = mod_row(row);
    const float* g2 = MOD + ((size_t)l * 5 + mr) * 6144 + 5 * 1024;
    float* xr = XC + (size_t)row * DM;
    float xn[16]; float ssq = 0.f;
    if (ABL & 8) {
#pragma unroll
      for (int i = 0; i < 16; ++i) acc[i] = 0.f;
    }
#pragma unroll
    for (int v4 = 0; v4 < 4; ++v4) {
      const int c = lane * 16 + v4 * 4;
      const f32x4 xo = xpre[v4], gg = *(const f32x4*)(g2 + c);
      f32x4 o;
      o.x = xo.x + gg.x * acc[v4 * 4 + 0]; o.y = xo.y + gg.y * acc[v4 * 4 + 1]; o.z = xo.z + gg.z * acc[v4 * 4 + 2]; o.w = xo.w + gg.w * acc[v4 * 4 + 3];
      xn[v4 * 4 + 0] = o.x; xn[v4 * 4 + 1] = o.y; xn[v4 * 4 + 2] = o.z; xn[v4 * 4 + 3] = o.w;
      ssq += (o.x * o.x + o.y * o.y) + (o.z * o.z + o.w * o.w);
      if (l < DEPTH - 1) *(f32x4*)(xr + c) = o;
    }
    const float rs = rsqrtf(wave_sum(ssq) * (1.f / DM) + EPS);
    if (l == DEPTH - 1) {
      const int b = row / SEGL, s = row - b * SEGL;
      float* orow = p.out + ((size_t)(b * SEQ + (s - CTXL))) * DM;
      const float* fg = p.in[I_FINALG];
#pragma unroll
      for (int v4 = 0; v4 < 4; ++v4) {
        const int c = lane * 16 + v4 * 4;
        const f32x4 gg = *(const f32x4*)(fg + c);
        f32x4 o; o.x = xn[v4 * 4 + 0] * rs * gg.x; o.y = xn[v4 * 4 + 1] * rs * gg.y; o.z = xn[v4 * 4 + 2] * rs * gg.z; o.w = xn[v4 * 4 + 3] * rs * gg.w;
        *(f32x4*)(orow + c) = o;
      }
    } else {
      const float* m = MOD + ((size_t)(l + 1) * 5 + mr) * 6144;
      const float* ng = p.in[I_N1G] + (l + 1) * DM;
      bf16_t* hrow = (bf16_t*)(p.ws + WS_H) + (size_t)row * DM;
#pragma unroll
      for (int hh = 0; hh < 2; ++hh) {
        float y[8];
#pragma unroll
        for (int i = 0; i < 8; ++i) { const int c = lane * 16 + hh * 8 + i; y[i] = xn[hh * 8 + i] * rs * ng[c] * (1.f + m[1024 + c]) + m[c]; }
        u32x4 w; w.x = cvtpk(y[0], y[1]); w.y = cvtpk(y[2], y[3]); w.z = cvtpk(y[4], y[5]); w.w = cvtpk(y[6], y[7]);
        *(u32x4*)(hrow + lane * 16 + hh * 8) = w;
      }
    }
  }
}

__device__ __forceinline__ void phase_c1(const Params& p, int l, unsigned char* lds) {
  constexpr int NLOC = NBATCH * 4 * NCH, NCONV = T / 32;
  for (int u = p.bx; u < NLOC + NCONV; u += p.gx) {
    if (u < NLOC) ml_local_unit(p, l, u, lds);
    else {
      const int cu = u - NLOC;
      if (l == DEPTH - 1 && (cu % (SEGL / 32)) < (CTXL / 32)) continue;
      conv_unit(p, l, cu, lds);
    }
  }
}
__device__ __forceinline__ void phase_c2(const Params& p, int l, unsigned char* lds) {
  ml_scan(p, lds);
  const float* lp = p.in[I_DLAM] + l * 256;
  float s01 = 0.f, s23 = 0.f;
  for (int i = 0; i < 64; ++i) { s01 += lp[i] * lp[64 + i]; s23 += lp[128 + i] * lp[192 + i]; }
  const float lam_init = 0.8f - 0.6f * expf(-0.3f * (float)l);
  const float lam = expf(s01) - expf(s23) + lam_init;
  const bf16_t* PROJ = (const bf16_t*)(p.ws + WS_PROJ);
  bf16_t* MIX = (bf16_t*)(p.ws + WS_MIX);
  const float* ng = p.in[I_DNORMG] + l * 128;
  const int nun = 512 + (l < DEPTH - 1 ? 16 : 0);
  for (int u = p.bx; u < nun; u += p.gx) {
    int bh, qrow, nkeys;
    if (u < 512) { const int xcd = u & 7, i = (u >> 3) & 31, rnd = u >> 8; bh = 2 * xcd + rnd; qrow = CTXL + i * 256; nkeys = SEGL; }
    else { bh = u - 512; qrow = 0; nkeys = CTXL; }
    const int b = bh >> 2, h = bh & 3;
    const size_t tok0 = (size_t)b * SEGL;
    for (int rep = 0; rep < REP_ATT; ++rep)
    att_unit(PROJ + (tok0 + qrow) * PW + C_DQ + h * 128, PROJ + tok0 * PW + C_DK + h * 128, PROJ + tok0 * PW + C_DV + h * 128,
             MIX + (tok0 + qrow) * DM + 512 + h * 128, nkeys, lam, ng, 1.f - lam_init, lds);
  }
}
__device__ __forceinline__ void phase_c3(const Params& p, int l, unsigned char* lds) {
  constexpr int NU = NBATCH * 4 * NCH;
  for (int u = p.bx; u < NU; u += p.gx) {
    if (l == DEPTH - 1 && (u % NCH) < 4) continue;
    ml_out_unit(p, l, u, lds);
  }
}
__device__ __forceinline__ void phase_route(const Params& p, int l, unsigned char* lds) {
  constexpr int NU = T / 32;
  for (int u = p.bx; u < NU; u += p.gx) {
    if (l == DEPTH - 1 && (u % (SEGL / 32)) < (CTXL / 32)) continue;
    route_unit(p, l, u, lds);
    __syncthreads();
  }
}
__device__ __forceinline__ void phase_gather(const Params& p, int l, unsigned char* lds) {
  int tid_ = threadIdx.x; asm volatile("" : "+v"(tid_)); const int lane = tid_ & 63, wid = tid_ >> 6;
  const int gw = p.bx * 8 + wid, NGW = p.gx * 8;
  const int ntok = (l == DEPTH - 1) ? NBATCH * SEQ : T;
#define TOKROW(ti_) ((l == DEPTH - 1) ? ((ti_) / SEQ) * SEGL + CTXL + ((ti_) % SEQ) : (ti_))
  TokPref tp;
  if (gw < ntok) tok_prefetch(p, TOKROW(gw), lane, tp);
  XcdBarrier xb; xb.bar = p.xbar_words; xb.x = p.xbar_x; xb.st = (volatile LAS unsigned*)((LAS unsigned char*)lds + p.lds_st_off);
  const int nrounds = (ntok + NGW - 1) / NGW;
  for (int r = 0; r < nrounds; ++r) {
    const int ti = gw + r * NGW;
    if (ti < ntok) {
      const int row = TOKROW(ti);
      const int nxt = ti + NGW < ntok ? TOKROW(ti + NGW) : -1;
      gather_token(p, l, row, nxt, tp, lds, lane, wid);
    }
#if GATHER_SYNC
    if (r + 1 < nrounds) { XcdBarrier xb2 = xb; size_t zb_ = 0; asm volatile("" : "+s"(zb_)); xb2.bar = xb.bar + zb_; xb2.x = xb.x + (unsigned)zb_; xcd_barrier(xb2); }
#endif
  }
#undef TOKROW
}

__global__ void __launch_bounds__(512, 2) mk_fwd(KArgs ka) {
  cg::grid_group grid = cg::this_grid();
  extern __shared__ __attribute__((aligned(16))) unsigned char lds[];
  const int lo = ka.ph_lo, hi = ka.ph_hi;
#define IN(k) (lo <= (k) && (k) < hi)
#ifndef PHASEMASK
#define PHASEMASK 0xFFFF
#endif
#define PH(i) ((PHASEMASK >> (i)) & 1)
#define MKP(q) Params q; { size_t z_ = 0; asm volatile("" : "+s"(z_)); \
    q.in = (InTab)((const __attribute__((address_space(4))) char*)__builtin_amdgcn_kernarg_segment_ptr() + z_); \
    q.out = ka.out + z_; q.ws = ka.ws + z_; q.ph_lo = lo; q.ph_hi = hi; q.bx = (int)blockIdx.x + (int)z_; q.gx = (int)gridDim.x + (int)z_; q.xbar_words = xbar.bar + z_; q.xbar_x = xbar.x + (unsigned)z_; q.lds_st_off = (unsigned)(LDS_BYTES - 64); }
#define SEAM(k) do { if (IN(k) && IN((k) + 1)) { if ((k) == 0) grid.sync(); else { XcdBarrier xb_ = xbar; size_t zb_ = 0; asm volatile("" : "+s"(zb_)); xb_.bar = xbar.bar + zb_; xb_.x = xbar.x + (unsigned)zb_; xcd_barrier(xb_); } } } while (0)
  volatile LAS unsigned* xst = (volatile LAS unsigned*)((LAS unsigned char*)lds + (LDS_BYTES - 64));
  if (threadIdx.x < 2) xst[threadIdx.x] = 0u;
  __syncthreads();
  XcdBarrier xbar = xcd_barrier_post((unsigned*)(ka.ws + WS_CTL) + 4096, xst);
  { MKP(p)
    if (PH(0) && IN(0)) for (int rep = 0; rep < REP_MISC; ++rep) { p0_mod(p, lds, (float*)(p.ws + WS_MOD)); p0_convert(p, lds); }
  }
  SEAM(0);
  { MKP(p)
    if (PH(1) && IN(1)) phase_norm(p, 0, 0, true, false);
  }
  SEAM(1);
#define LAYER(LL) { \
    int l = (LL); asm volatile("" : "+s"(l)); \
    const int b = 2 + 9 * (LL); \
    { MKP(q) if (PH(2) && IN(b + 0)) for (int rep = 0; rep < REP_GEMM; ++rep) phase_inproj2(q, l, lds); } \
    SEAM(b + 0); \
    { MKP(q) if (PH(3) && IN(b + 1)) for (int rep = 0; rep < REP_ML; ++rep) phase_c1(q, l, lds); } \
    SEAM(b + 1); \
    { MKP(q) if (PH(4) && IN(b + 2)) phase_c2(q, l, lds); } \
    SEAM(b + 2); \
    { MKP(q) if (PH(5) && IN(b + 3)) for (int rep = 0; rep < REP_ML; ++rep) phase_c3(q, l, lds); } \
    SEAM(b + 3); \
    { MKP(q) if (PH(6) && IN(b + 4)) phase_outproj2(q, l, lds); } \
    SEAM(b + 4); \
    { MKP(q) if (PH(7) && IN(b + 5)) for (int rep = 0; rep < REP_MISC; ++rep) phase_norm(q, l, 1, false, (LL) == DEPTH - 1); } \
    SEAM(b + 5); \
    { MKP(q) if (PH(8) && IN(b + 6)) for (int rep = 0; rep < REP_GEMM; ++rep) phase_peerq2(q, l, lds); } \
    SEAM(b + 6); \
    { MKP(q) if (PH(9) && IN(b + 7)) phase_route(q, l, lds); } \
    SEAM(b + 7); \
    { MKP(q) if (PH(9) && IN(b + 8)) phase_gather(q, l, lds); } \
    SEAM(b + 8); }
  LAYER(0) LAYER(1) LAYER(2) LAYER(3)
#undef LAYER
#undef IN
#undef SEAM
#undef MKP
}

extern "C" void kernel_launch(void* const* d_in, const int* in_sizes, int n_in, void* d_out, int out_size,
                              void* d_ws, size_t ws_size, hipStream_t stream) {
  static int grid = 0;
  if (grid == 0) {
    int dev = 0, cus = 0, per_cu = 0;
    (void)hipGetDevice(&dev);
    (void)hipDeviceGetAttribute(&cus, hipDeviceAttributeMultiprocessorCount, dev);
    (void)hipFuncSetAttribute((const void*)mk_fwd, hipFuncAttributeMaxDynamicSharedMemorySize, LDS_BYTES);
    (void)hipOccupancyMaxActiveBlocksPerMultiprocessor(&per_cu, (const void*)mk_fwd, 512, LDS_BYTES);
    fprintf(stderr, "kernel_launch: cus %d per_cu %d ws %zu (need %zu) n_in %d\n", cus, per_cu, ws_size, (size_t)WS_END, n_in);
    if (ws_size < WS_END || n_in != 23 || per_cu < 1) { fprintf(stderr, "kernel_launch: bad configuration, nothing launched\n"); grid = -1; return; }
    grid = cus;
  }
  if (grid < 0) return;
  (void)hipMemsetAsync((char*)d_ws + WS_CTL, 0, 65536, stream);
  KArgs p{};
  for (int i = 0; i < 23; ++i) p.in[i] = (const float*)d_in[i];
  p.out = (float*)d_out; p.ws = (unsigned char*)d_ws; p.ph_lo = 0; p.ph_hi = 38;
  void* args[] = {&p};
  hipError_t e = hipLaunchCooperativeKernel((const void*)mk_fwd, dim3(grid), dim3(512), args, LDS_BYTES, stream);
  if (e != hipSuccess) fprintf(stderr, "cooperative launch failed: %s (grid %d)\n", hipGetErrorString(e), grid);
}
```

```cpp
#include <hip/hip_runtime.h>
#include <hip/hip_cooperative_groups.h>
#include <cstdio>
#include <cstdint>
namespace cg = cooperative_groups;

constexpr int DM = 1024, NBATCH = 4, SEQ = 8192, CTXL = 256, SEGL = CTXL + SEQ, T = NBATCH * SEGL, DEPTH = 4;
constexpr int IN_W = 3088, PW = 3072;
constexpr int C_A = 0, C_MQ = 512, C_MK = 768, C_MV = 1024, C_MO = 1280, C_DQ = 1536, C_DK = 2048, C_DV = 2560;
constexpr int NCH = SEGL / 64;
constexpr int NEXP = 16384;
constexpr float EPS = 1e-6f;
#ifndef ABL
#define ABL 0
#endif
#ifndef GATHER_SYNC
#define GATHER_SYNC 0
#endif
#ifndef REP_ATT
#define REP_ATT 1
#endif
#ifndef REP_PEER
#define REP_PEER 1
#endif
#ifndef REP_GEMM
#define REP_GEMM 1
#endif
#ifndef REP_ROUTE
#define REP_ROUTE 1
#endif
#ifndef REP_OUTP
#define REP_OUTP 1
#endif
#ifndef REP_ML
#define REP_ML 1
#endif
#ifndef REP_MISC
#define REP_MISC 1
#endif
constexpr float QSCALE = 0.125f * 1.4426950408889634f;

constexpr size_t MiB = 1u << 20;
constexpr size_t WS_CTL = 0, WS_MOD = 1 * MiB, WS_ROPE = 2 * MiB, WS_WG = 4 * MiB, WS_KEYS = 5 * MiB, WS_MLMETA = 6 * MiB,
                 WS_GATES = 7 * MiB, WS_WIN = 10 * MiB, WS_WOUT = 34 * MiB, WS_WQ = 42 * MiB, WS_PU = 50 * MiB, WS_PV = 114 * MiB, WS_PSC = 178 * MiB  ,
                 WS_XCUR = 306 * MiB, WS_H = 438 * MiB, WS_MIX = 504 * MiB, WS_PROJ = 570 * MiB, WS_ULOC = 768 * MiB, WS_END = 836 * MiB;
constexpr int USTRIDE = 4160;

constexpr int LDS_BYTES = 139264;

#define LAS __attribute__((address_space(3)))
typedef unsigned short bf16_t;
typedef short bf16x8 __attribute__((ext_vector_type(8)));
typedef short s16x4 __attribute__((ext_vector_type(4)));
typedef float f32x4 __attribute__((ext_vector_type(4)));
typedef float f32x16 __attribute__((ext_vector_type(16)));
typedef unsigned u32x4 __attribute__((ext_vector_type(4)));
typedef unsigned u32x2 __attribute__((ext_vector_type(2)));
typedef __bf16 bf16x2v __attribute__((ext_vector_type(2)));
typedef float f32x2 __attribute__((ext_vector_type(2)));

struct KArgs {
  const float* in[23];
  float* out;
  unsigned char* ws;
  int ph_lo, ph_hi;
};
typedef const float* const __attribute__((address_space(4))) * InTab;
struct Params {
  InTab in;
  float* out;
  unsigned char* ws;
  int ph_lo, ph_hi;
  int bx, gx;
  unsigned* xbar_words; unsigned xbar_x; unsigned lds_st_off;
};
enum { I_X = 0, I_C, I_CTX, I_CCTX, I_ADAW, I_ADAB, I_N1G, I_N2G, I_WIN, I_CONVW, I_CONVB, I_CLNG, I_CLNB, I_GATEB, I_MNORMG, I_DLAM, I_DNORMG,
       I_WOUT, I_PWQ, I_PKEYS, I_PU, I_PV, I_FINALG };

__device__ __forceinline__ unsigned cvtpk(float lo, float hi) { unsigned r; asm volatile("v_cvt_pk_bf16_f32 %0, %1, %2" : "=v"(r) : "v"(lo), "v"(hi)); return r; }
__device__ __forceinline__ float bflo(unsigned u) { return __uint_as_float(u << 16); }
__device__ __forceinline__ float bfhi(unsigned u) { return __uint_as_float(u & 0xffff0000u); }
__device__ __forceinline__ float bf1(bf16_t u) { return __uint_as_float(((unsigned)u) << 16); }
__device__ __forceinline__ int crow(int r, int hi) { return (r & 3) + 8 * (r >> 2) + 4 * hi; }
__device__ __forceinline__ float wave_sum(float v) {
#pragma unroll
  for (int o = 1; o < 64; o <<= 1) v += __shfl_xor(v, o);
  return v;
}
__device__ __forceinline__ float wave_max(float v) {
#pragma unroll
  for (int o = 1; o < 64; o <<= 1) v = fmaxf(v, __shfl_xor(v, o));
  return v;
}
__device__ __forceinline__ float sigmoidf_(float x) { return 1.f / (1.f + __expf(-x)); }
__device__ __forceinline__ float logsigmoidf_(float x) { return fminf(x, 0.f) - log1pf(__expf(-fabsf(x))); }
__device__ __forceinline__ const float* in_row(const float* x, const float* ctx, int row) {
  const int b = row / SEGL, s = row - b * SEGL;
  return s < CTXL ? ctx + ((size_t)(b * CTXL + s)) * DM : x + ((size_t)(b * SEQ + (s - CTXL))) * DM;
}
__device__ __forceinline__ int mod_row(int row) { const int b = row / SEGL, s = row - b * SEGL; return s < CTXL ? 4 : b; }

__device__ __forceinline__ void p0_mod(const Params& p, unsigned char* lds, float* MOD) {
  float* sil = (float*)lds;
  float* red = (float*)(lds + 20480);
  int tid_ = threadIdx.x; asm volatile("" : "+v"(tid_)); const int tid = tid_, lane = tid & 63, wid = tid >> 6;
  for (int i = tid; i < 5 * 1024; i += 512) {
    const float v = i < 4096 ? p.in[I_C][i] : p.in[I_CCTX][i - 4096];
    sil[i] = v / (1.f + __expf(-v));
  }
  __syncthreads();
  for (int item = p.bx; item < DEPTH * 96; item += p.gx) {
    const int l = item / 96, j0 = (item % 96) * 64;
    const float* W = p.in[I_ADAW] + (size_t)l * DM * 6144 + j0 + lane;
    float a0 = 0.f, a1 = 0.f, a2 = 0.f, a3 = 0.f, a4 = 0.f;
    const int k0 = wid * 128;
#pragma unroll 8
    for (int k = k0; k < k0 + 128; ++k) {
      const float w = W[(size_t)k * 6144];
      a0 += sil[k] * w; a1 += sil[1024 + k] * w; a2 += sil[2048 + k] * w; a3 += sil[3072 + k] * w; a4 += sil[4096 + k] * w;
    }
    red[(wid * 5 + 0) * 64 + lane] = a0; red[(wid * 5 + 1) * 64 + lane] = a1; red[(wid * 5 + 2) * 64 + lane] = a2;
    red[(wid * 5 + 3) * 64 + lane] = a3; red[(wid * 5 + 4) * 64 + lane] = a4;
    __syncthreads();
    if (tid < 320) {
      const int r = tid >> 6;
      float s = 0.f;
#pragma unroll
      for (int w = 0; w < 8; ++w) s += red[(w * 5 + r) * 64 + lane];
      MOD[((size_t)l * 5 + r) * 6144 + j0 + lane] = s + p.in[I_ADAB][l * 6144 + j0 + lane];
    }
    __syncthreads();
  }
}
__device__ __forceinline__ void transpose_item(const float* W, int ldw, int srccol0, bf16_t* WT, int K, int n0, int k0, float* scr, int lane) {
#pragma unroll 8
  for (int i = 0; i < 32; ++i) { const int kk = 2 * i + (lane >> 5); scr[kk * 33 + (lane & 31)] = W[(size_t)(k0 + kk) * ldw + srccol0 + (lane & 31)]; }
  asm volatile("s_waitcnt lgkmcnt(0)" ::: "memory");
  const int c = lane & 7;
#pragma unroll
  for (int j = 0; j < 4; ++j) {
    const int n = (lane >> 3) + 8 * j; const float* s = scr + (8 * c) * 33 + n;
    u32x4 o; o.x = cvtpk(s[0], s[33]); o.y = cvtpk(s[66], s[99]); o.z = cvtpk(s[132], s[165]); o.w = cvtpk(s[198], s[231]);
    *(u32x4*)(WT + (size_t)(n0 + n) * K + k0 + 8 * c) = o;
  }
  asm volatile("s_waitcnt lgkmcnt(0)" ::: "memory");
}
__device__ __forceinline__ void p0_convert(const Params& p, unsigned char* lds) {
  int tid_ = threadIdx.x; asm volatile("" : "+v"(tid_)); const int tid = tid_, lane = tid & 63, wid = tid >> 6;
  const int gw = p.bx * 8 + wid, NGW = p.gx * 8;
  const size_t gt = (size_t)p.bx * 512 + tid, NGT = (size_t)p.gx * 512;
  float* scr = (float*)(lds + 32768) + wid * (64 * 33);
  bf16_t* WIN = (bf16_t*)(p.ws + WS_WIN); bf16_t* WOUT = (bf16_t*)(p.ws + WS_WOUT); bf16_t* WQ = (bf16_t*)(p.ws + WS_WQ);
  constexpr int I_IN = 16 * 96, I_O = 16 * 32, PER_L = I_IN + 2 * I_O;
  for (int it = gw; it < DEPTH * PER_L; it += NGW) {
    const int l = it / PER_L; int r = it % PER_L;
    if (r < I_IN) { const int kb = r / 96, nb = r % 96, n0 = nb * 32; const int src = n0 < 1536 ? n0 : n0 + 16;
      transpose_item(p.in[I_WIN] + (size_t)l * DM * IN_W, IN_W, src, WIN + (size_t)l * PW * DM, DM, n0, kb * 64, scr, lane); continue; }
    r -= I_IN;
    if (r < I_O) { const int kb = r / 32, nb = r % 32;
      transpose_item(p.in[I_WOUT] + (size_t)l * DM * DM, DM, nb * 32, WOUT + (size_t)l * DM * DM, DM, nb * 32, kb * 64, scr, lane); continue; }
    r -= I_O;
    { const int kb = r / 32, nb = r % 32;
      transpose_item(p.in[I_PWQ] + (size_t)l * DM * DM, DM, nb * 32, WQ + (size_t)l * DM * DM, DM, nb * 32, kb * 64, scr, lane); }
  }
  bf16_t* WG = (bf16_t*)(p.ws + WS_WG);
  for (size_t i = gt; i < (size_t)DEPTH * 16 * DM; i += NGT) {
    const int l = (int)(i / (16 * DM)), g = (int)((i / DM) % 16), k = (int)(i % DM);
    WG[i] = (bf16_t)(cvtpk(p.in[I_WIN][(size_t)l * DM * IN_W + (size_t)k * IN_W + 1536 + g], 0.f) & 0xffffu);
  }
  bf16_t* KEYS = (bf16_t*)(p.ws + WS_KEYS);
  for (size_t i = gt; i < (size_t)DEPTH * 131072 / 8; i += NGT) {
    const f32x4 a = ((const f32x4*)p.in[I_PKEYS])[2 * i], b = ((const f32x4*)p.in[I_PKEYS])[2 * i + 1];
    u32x4 o; o.x = cvtpk(a.x, a.y); o.y = cvtpk(a.z, a.w); o.z = cvtpk(b.x, b.y); o.w = cvtpk(b.z, b.w);
    ((u32x4*)KEYS)[i] = o;
  }
  {
    unsigned char* PUq = p.ws + WS_PU; unsigned char* PVq = p.ws + WS_PV; float* PSC = (float*)(p.ws + WS_PSC);
    const int nrows = DEPTH * NEXP;
    for (int r = gw; r < 2 * nrows; r += NGW) {
      const int tb = r >= nrows, rr = tb ? r - nrows : r;
      const f32x4* srow = (const f32x4*)((tb ? p.in[I_PV] : p.in[I_PU]) + (size_t)rr * DM) + lane * 4;
      f32x4 v[4]; float mx = 0.f;
#pragma unroll
      for (int j = 0; j < 4; ++j) { v[j] = __builtin_nontemporal_load(srow + j); mx = fmaxf(mx, fmaxf(fmaxf(fabsf(v[j].x), fabsf(v[j].y)), fmaxf(fabsf(v[j].z), fabsf(v[j].w)))); }
      mx = wave_max(mx);
      const int eb = (int)((__float_as_uint(mx) >> 23) & 0xFFu);
      int sb = 261 - eb; sb = sb < 1 ? 1 : (sb > 253 ? 253 : sb);
      const float sc = __uint_as_float((unsigned)sb << 23), isc = __uint_as_float((unsigned)(254 - sb) << 23);
      u32x4 o;
      int w;
#define CV4(V, OUT) w = 0; w = __builtin_amdgcn_cvt_pk_fp8_f32(V.x * sc, V.y * sc, w, false); w = __builtin_amdgcn_cvt_pk_fp8_f32(V.z * sc, V.w * sc, w, true); OUT = (unsigned)w
      CV4(v[0], o.x); CV4(v[1], o.y); CV4(v[2], o.z); CV4(v[3], o.w);
#undef CV4
      *(u32x4*)((tb ? PVq : PUq) + (size_t)rr * DM + lane * 16) = o;
      if (lane == 0) PSC[(size_t)tb * nrows + rr] = isc;
    }
  }
  {
    float* RC = (float*)(p.ws + WS_ROPE); float* RS = RC + SEQ * 32;
    for (size_t i = gt; i < (size_t)SEQ * 32; i += NGT) {
      const int pos = (int)(i >> 5), j = (int)(i & 31);
      const int rr = pos >> 6, cc = pos & 63;
      const int jj = j & 15;
      const double e = -(double)jj * 0.83048202372184058696;
      const double fl = __builtin_floor(e); const double f = e - fl;
      const double z = f * 0.69314718055994530942;
      double ez = 1.0 + z * (1.0 + z * (0.5 + z * (1.0 / 6 + z * (1.0 / 24 + z * (1.0 / 120 + z * (1.0 / 720 + z * (1.0 / 5040 + z * (1.0 / 40320 + z * (1.0 / 362880 + z * (1.0 / 3628800 + z * (1.0 / 39916800 + z * (1.0 / 479001600))))))))))));
      const double inv = __builtin_ldexp(ez, (int)fl);
      const float invf = (float)inv;
      const float angf = (float)(j < 16 ? rr : cc) * invf;
      const double ang = (double)angf;
      const double kq = __builtin_rint(ang * 0.63661977236758134308);
      double r = __builtin_fma(-kq, 1.57079632679489655800e+00, ang);
      r = __builtin_fma(-kq, 6.12323399573676603587e-17, r);
      const double r2 = r * r;
      const double sn = r * (1.0 + r2 * (-1.0 / 6 + r2 * (1.0 / 120 + r2 * (-1.0 / 5040 + r2 * (1.0 / 362880 + r2 * (-1.0 / 39916800 + r2 * (1.0 / 6227020800.0)))))));
      const double cs = 1.0 + r2 * (-0.5 + r2 * (1.0 / 24 + r2 * (-1.0 / 720 + r2 * (1.0 / 40320 + r2 * (-1.0 / 3628800 + r2 * (1.0 / 479001600 + r2 * (-1.0 / 87178291200.0)))))));
      const int q = ((int)kq) & 3;
      double co, si;
      if (q == 0) { co = cs; si = sn; } else if (q == 1) { co = -sn; si = cs; } else if (q == 2) { co = -cs; si = -sn; } else { co = sn; si = -cs; }
      RC[i] = (float)co; RS[i] = (float)si;
    }
  }
}

__device__ __forceinline__ void norm_mod_row(const float* xrow, const float* g, const float* sc, const float* sh, bf16_t* orow, int lane) {
  const f32x4* xr = (const f32x4*)xrow + lane;
  f32x4 v[4]; float s = 0.f;
#pragma unroll
  for (int j = 0; j < 4; ++j) { v[j] = xr[64 * j]; s += (v[j].x * v[j].x + v[j].y * v[j].y) + (v[j].z * v[j].z + v[j].w * v[j].w); }
  const float rs = rsqrtf(wave_sum(s) * (1.f / DM) + EPS);
  u32x2* o = (u32x2*)orow + lane;
#pragma unroll
  for (int j = 0; j < 4; ++j) {
    const f32x4 gg = ((const f32x4*)g)[lane + 64 * j], cc = ((const f32x4*)sc)[lane + 64 * j], hh = ((const f32x4*)sh)[lane + 64 * j];
    const float y0 = v[j].x * rs * gg.x * (1.f + cc.x) + hh.x, y1 = v[j].y * rs * gg.y * (1.f + cc.y) + hh.y;
    const float y2 = v[j].z * rs * gg.z * (1.f + cc.z) + hh.z, y3 = v[j].w * rs * gg.w * (1.f + cc.w) + hh.w;
    u32x2 w; w.x = cvtpk(y0, y1); w.y = cvtpk(y2, y3);
    o[64 * j] = w;
  }
}
__device__ __forceinline__ void phase_norm(const Params& p, int l, int which, bool from_input, bool skip_ctx) {
  int tid_ = threadIdx.x; asm volatile("" : "+v"(tid_));
  const int lane = tid_ & 63, wid = tid_ >> 6;
  const int gw = p.bx * 8 + wid, NGW = p.gx * 8;
  const float* MOD = (const float*)(p.ws + WS_MOD);
  const float* XC = (const float*)(p.ws + WS_XCUR);
  bf16_t* H = (bf16_t*)(p.ws + WS_H);
  const float* g = p.in[which ? I_N2G : I_N1G] + l * DM;
  for (int row = gw; row < T; row += NGW) {
    const int mr = mod_row(row);
    if (skip_ctx && mr == 4) continue;
    const float* m = MOD + ((size_t)l * 5 + mr) * 6144 + which * 3072;
    const float* xr = from_input ? in_row(p.in[I_X], p.in[I_CTX], row) : XC + (size_t)row * DM;
    norm_mod_row(xr, g, m + 1024, m, H + (size_t)row * DM, lane);
  }
}

namespace pg8 {
#define PG8_LAS __attribute__((address_space(3)))
typedef unsigned short bf16_t;
typedef short bf16x8 __attribute__((ext_vector_type(8)));
typedef float f32x4 __attribute__((ext_vector_type(4)));
typedef unsigned u32x4 __attribute__((ext_vector_type(4)));
constexpr int BM = 256, BK = 64, HALF = 128, HTB = HALF * BK * 2  , STAGE_BYTES = 8 * HTB, NXCD = 8, WGM = 8;

__host__ __device__ __forceinline__ int lds_byte(int r, int c) { const int st = (r >> 4) * 2 + (c >> 5), rr = r & 15, cc = c & 31, ob = rr * 64 + cc * 2; return st * 1024 + (ob ^ (((ob >> 9) & 1) << 5)); }
__host__ __device__ __forceinline__ void stage_rc(int b, int& R, int& C) { const int st = b / 1024, sb = b % 1024, swz = sb ^ (((sb >> 9) & 1) << 5); R = (st >> 1) * 16 + swz / 64; C = (st & 1) * 32 + (swz % 64) / 2; }
__host__ __device__ __forceinline__ int perm32(int rho) { const int n = rho >> 4, i = rho & 15; return 8 * (i >> 2) + 4 * n + (i & 3); }

struct Unit { int pm, pn; };
struct Gemm { const bf16_t* A; const bf16_t* Bt; int M, N, K; };

struct StaticOrder {
    int nM, nN, nwg, G, c;
    __host__ __device__ void init(int M, int N, int G_, int c_) { nM = M / BM; nN = N / BM; nwg = nM * nN; G = G_; c = c_; }
    __host__ __device__ bool next(int i, Unit& u) const {
        const long L = (long)i * G + c; if (L >= nwg) return false;
        int wgid = (int)L; { const int q = nwg / NXCD, r = nwg % NXCD, xcd = wgid % NXCD, off = wgid / NXCD; wgid = (xcd < r ? xcd * (q + 1) : r * (q + 1) + (xcd - r) * q) + off; }
        const int nig = WGM * nN, gid = wgid / nig, fm = gid * WGM, gsz = (nM - fm) < WGM ? (nM - fm) : WGM;
        u.pm = fm + ((wgid % nig) % gsz); u.pn = (wgid % nig) / gsz; return true;
    }
    __device__ __forceinline__ void a_ready(const Unit&) const {}
    __device__ __forceinline__ void done(const Unit&) const {}
};
__device__ __forceinline__ unsigned cvt_pk_bf16(float lo, float hi) { unsigned r; asm volatile("v_cvt_pk_bf16_f32 %0, %1, %2" : "=v"(r) : "v"(lo), "v"(hi)); return r; }
template <class Epi, class Sched, bool ALIGN_EPI = false, bool SP2 = false>
__device__ __forceinline__ void gemm_phase(PG8_LAS unsigned char* lds, const Gemm g, const Sched& S, const Epi& E) {
    const int tid = threadIdx.x, wid = __builtin_amdgcn_readfirstlane(tid >> 6), lane = tid & 63, wr = wid >> 2, wc = wid & 3, fr = lane & 15, fq = lane >> 4;
    const int K = g.K, nt = K / BK;
    unsigned voffA[2], voffB[2];
#pragma unroll
    for (int i = 0; i < 2; ++i) { int R, C; stage_rc(tid * 16 + i * 8192, R, C); const int Rb = Epi::PERM ? ((R & ~31) + perm32(R & 31)) : R;
        voffA[i] = (unsigned)(R * K + C) * 2u; voffB[i] = (unsigned)(Rb * K + C) * 2u; }
    const size_t kstep = (size_t)(BK * 2);
    const size_t hstep = (size_t)HALF * K * 2;
    const size_t tstep = 2 * hstep;
    const unsigned ldsw = (unsigned)wid * 1024u;
    const int aoff = lds_byte(wr * 64 + fr, fq * 8), boff = lds_byte(wc * 32 + fr, fq * 8);
#define PG8_SA(b, h) (((b) * 2 + (h)) * HTB)
#define PG8_SB(b, h) ((4 + (b) * 2 + (h)) * HTB)
#define PG8_STAGE(bufoff, gbase, voff) do { _Pragma("unroll") for (int _i = 0; _i < 2; ++_i) \
        __builtin_amdgcn_global_load_lds((const unsigned*)((const char*)(gbase) + (voff)[_i]), (PG8_LAS unsigned*)(lds + (bufoff) + ldsw + _i * 8192), 16, 0, 0); } while (0)
#define PG8_LDA(dst, b, h) do { _Pragma("unroll") for (int m = 0; m < 4; ++m) _Pragma("unroll") for (int k = 0; k < 2; ++k) dst[m][k] = *(const PG8_LAS bf16x8*)(lds + PG8_SA(b, h) + aoff + m * 2048 + k * 1024); } while (0)
#define PG8_LDB(dst, b, h) do { _Pragma("unroll") for (int n = 0; n < 2; ++n) _Pragma("unroll") for (int k = 0; k < 2; ++k) dst[n][k] = *(const PG8_LAS bf16x8*)(lds + PG8_SB(b, h) + boff + n * 2048 + k * 1024); } while (0)
#define PG8_MMA(ai, bj, At, Bt) do { __builtin_amdgcn_s_setprio(1); _Pragma("unroll") for (int m = 0; m < 4; ++m) _Pragma("unroll") for (int n = 0; n < 2; ++n) _Pragma("unroll") for (int k = 0; k < 2; ++k) \
        acc[ai][bj][m][n] = __builtin_amdgcn_mfma_f32_16x16x32_bf16(Bt[n][k], At[m][k], acc[ai][bj][m][n], 0, 0, 0); __builtin_amdgcn_s_setprio(0); } while (0)
#define PG8_WAIT_V(n) asm volatile("s_waitcnt vmcnt(" #n ")" ::: "memory")
#define PG8_WAIT_L(n) asm volatile("s_waitcnt lgkmcnt(" #n ")" ::: "memory")
#define PG8_BAR __builtin_amdgcn_s_barrier()
#define PG8_SCHED __builtin_amdgcn_sched_barrier(0)
    Unit cur, nxt; int ui = 0;
    if (!S.next(0, cur)) return;
    f32x4 acc[2][2][4][2];
#pragma unroll
    for (int a = 0; a < 2; ++a)
#pragma unroll
        for (int b = 0; b < 2; ++b)
#pragma unroll
            for (int m = 0; m < 4; ++m)
#pragma unroll
                for (int n = 0; n < 2; ++n) acc[a][b][m][n] = (f32x4){0.f, 0.f, 0.f, 0.f};
    bf16x8 At[4][2], B0[2][2], B1[2][2];
    const char* cA = (const char*)g.A + (size_t)cur.pm * tstep; const char* cB = (const char*)g.Bt + (size_t)cur.pn * tstep;
    S.a_ready(cur);
    if constexpr (SP2) {
        PG8_STAGE(PG8_SB(0, 0), cB, voffB); PG8_STAGE(PG8_SB(0, 1), cB + hstep, voffB); PG8_STAGE(PG8_SA(0, 0), cA, voffA); PG8_STAGE(PG8_SA(0, 1), cA + hstep, voffA);
        if (wr == 1) PG8_BAR;
        PG8_WAIT_V(2); PG8_BAR;
        PG8_STAGE(PG8_SB(1, 0), cB + kstep, voffB); PG8_STAGE(PG8_SA(1, 0), cA + kstep, voffA); PG8_STAGE(PG8_SB(1, 1), cB + hstep + kstep, voffB);
        PG8_WAIT_V(6); PG8_BAR;
    } else {
        PG8_STAGE(PG8_SB(0, 0), cB, voffB); PG8_STAGE(PG8_SA(0, 0), cA, voffA); PG8_STAGE(PG8_SB(0, 1), cB + hstep, voffB); PG8_STAGE(PG8_SA(0, 1), cA + hstep, voffA);
        if (wr == 1) PG8_BAR;
        PG8_WAIT_V(4); PG8_BAR;
        PG8_STAGE(PG8_SB(1, 0), cB + kstep, voffB); PG8_STAGE(PG8_SA(1, 0), cA + kstep, voffA); PG8_STAGE(PG8_SB(1, 1), cB + hstep + kstep, voffB);
        PG8_WAIT_V(6); PG8_BAR;
    }
    for (;;) {
        const bool has_next = S.next(ui + 1, nxt);
        const char* nA = has_next ? (const char*)g.A + (size_t)nxt.pm * tstep : cA; const char* nB = has_next ? (const char*)g.Bt + (size_t)nxt.pn * tstep : cB;
        for (int t = 0; t < nt; t += 2) {
            const bool last = (t == nt - 2);
            const char* a1 = cA + (size_t)(t + 1) * kstep;
            const char* a2 = last ? nA : cA + (size_t)(t + 2) * kstep; const char* b2 = last ? nB : cB + (size_t)(t + 2) * kstep;
            const char* a3 = a2 + kstep; const char* b3 = b2 + kstep;
            if (last && has_next) S.a_ready(nxt);
            if constexpr (SP2) {
            PG8_LDB(B0, 0, 0); PG8_LDB(B1, 0, 1); PG8_SCHED; PG8_LDA(At, 0, 0); PG8_STAGE(PG8_SA(1, 1), a1 + hstep, voffA);
            PG8_WAIT_V(8); PG8_WAIT_L(0); PG8_BAR; PG8_MMA(0, 0, At, B0); PG8_MMA(0, 1, At, B1); PG8_BAR; PG8_SCHED;
            PG8_LDA(At, 0, 1); PG8_STAGE(PG8_SB(0, 0), b2, voffB); PG8_STAGE(PG8_SB(0, 1), b2 + hstep, voffB); PG8_STAGE(PG8_SA(0, 0), a2, voffA);
            PG8_WAIT_V(8); PG8_WAIT_L(0); PG8_BAR; PG8_MMA(1, 0, At, B0); PG8_MMA(1, 1, At, B1); PG8_BAR; PG8_SCHED;
            PG8_LDB(B0, 1, 0); PG8_LDB(B1, 1, 1); PG8_SCHED; PG8_LDA(At, 1, 0); PG8_STAGE(PG8_SA(0, 1), a2 + hstep, voffA);
            PG8_WAIT_V(8); PG8_WAIT_L(0); PG8_BAR; PG8_MMA(0, 0, At, B0); PG8_MMA(0, 1, At, B1); PG8_BAR; PG8_SCHED;
            PG8_LDA(At, 1, 1); PG8_STAGE(PG8_SB(1, 0), b3, voffB); PG8_STAGE(PG8_SB(1, 1), b3 + hstep, voffB); PG8_STAGE(PG8_SA(1, 0), a3, voffA);
            PG8_WAIT_V(8); PG8_WAIT_L(0); PG8_BAR; PG8_MMA(1, 0, At, B0); PG8_MMA(1, 1, At, B1); PG8_BAR; PG8_SCHED;
            } else {
            PG8_LDB(B0, 0, 0); PG8_SCHED; PG8_LDA(At, 0, 0); PG8_STAGE(PG8_SA(1, 1), a1 + hstep, voffA);
            PG8_WAIT_L(8); PG8_BAR; PG8_WAIT_L(0); PG8_MMA(0, 0, At, B0); PG8_BAR; PG8_SCHED;
            PG8_LDB(B1, 0, 1); PG8_STAGE(PG8_SB(0, 0), b2, voffB);
            PG8_BAR; PG8_WAIT_L(0); PG8_MMA(0, 1, At, B1); PG8_BAR;
            PG8_LDA(At, 0, 1); PG8_STAGE(PG8_SA(0, 0), a2, voffA);
            PG8_BAR; PG8_WAIT_L(0); PG8_MMA(1, 0, At, B0); PG8_BAR; PG8_SCHED;
            PG8_STAGE(PG8_SB(0, 1), b2 + hstep, voffB);
            PG8_WAIT_V(6); PG8_BAR; PG8_MMA(1, 1, At, B1); PG8_BAR;
            PG8_LDB(B0, 1, 0); PG8_SCHED; PG8_LDA(At, 1, 0); PG8_STAGE(PG8_SA(0, 1), a2 + hstep, voffA);
            PG8_WAIT_L(8); PG8_BAR; PG8_WAIT_L(0); PG8_MMA(0, 0, At, B0); PG8_BAR; PG8_SCHED;
            PG8_LDB(B1, 1, 1); PG8_STAGE(PG8_SB(1, 0), b3, voffB);
            PG8_BAR; PG8_WAIT_L(0); PG8_MMA(0, 1, At, B1); PG8_BAR;
            PG8_LDA(At, 1, 1); PG8_STAGE(PG8_SA(1, 0), a3, voffA);
            PG8_BAR; PG8_WAIT_L(0); PG8_MMA(1, 0, At, B0); PG8_BAR; PG8_SCHED;
            PG8_STAGE(PG8_SB(1, 1), b3 + hstep, voffB);
            PG8_WAIT_V(6); PG8_BAR; PG8_MMA(1, 1, At, B1); PG8_BAR;
            }
        }
        if constexpr (ALIGN_EPI) { if (wr == 0) PG8_BAR; }
        if constexpr (!Epi::AFTER_DRAIN) { E(acc, cur, wr, wc, fr, fq); S.done(cur); }
        if (!has_next) break;
#pragma unroll
        for (int a = 0; a < 2; ++a)
#pragma unroll
            for (int b = 0; b < 2; ++b)
#pragma unroll
                for (int m = 0; m < 4; ++m)
#pragma unroll
                    for (int n = 0; n < 2; ++n) acc[a][b][m][n] = (f32x4){0.f, 0.f, 0.f, 0.f};
        cur = nxt; cA = nA; cB = nB; ++ui;
        if constexpr (ALIGN_EPI) { if (wr == 1) PG8_BAR; }
    }
    PG8_WAIT_V(0);
    if constexpr (!ALIGN_EPI) { if (wr == 0) PG8_BAR; }
    PG8_BAR;
    if constexpr (Epi::AFTER_DRAIN) { E.fused(acc, cur, wr, wc, fr, fq, lds, wid, lane); S.done(cur); }
#undef PG8_SA
#undef PG8_SB
#undef PG8_STAGE
#undef PG8_LDA
#undef PG8_LDB
#undef PG8_MMA
#undef PG8_WAIT_V
#undef PG8_WAIT_L
#undef PG8_BAR
#undef PG8_SCHED
}
}

__device__ __forceinline__ int gswz(int row, int chunk) { return row * 128 + ((chunk ^ ((row >> 1) & 7)) << 4); }
__device__ __forceinline__ void gemm_tile(const bf16_t* __restrict__ A, int lda, const bf16_t* __restrict__ Bt, int ldb, int K,
                                          int row0, int col0, unsigned char* lds, f32x16 (&acc)[2][2]) {
  int tid_ = threadIdx.x; asm volatile("" : "+v"(tid_)); const int tid = tid_, lane = tid & 63, wid = tid >> 6, wm = wid >> 1, wn = wid & 1, r32 = lane & 31, hi = lane >> 5;
  unsigned char* As = lds; unsigned char* Bs = lds + 65536;
#pragma unroll
  for (int i = 0; i < 2; ++i)
#pragma unroll
    for (int j = 0; j < 2; ++j) acc[i][j] = f32x16{};
  const int lrow = tid >> 3, lc = tid & 7;
  const bf16_t* Ag = A + (size_t)(row0 + lrow) * lda + lc * 8;
  const bf16_t* Bg = Bt + (size_t)(col0 + lrow) * ldb + lc * 8;
  u32x4 ra[4], rb[2];
#pragma unroll
  for (int i = 0; i < 4; ++i) ra[i] = *(const u32x4*)(Ag + (size_t)(64 * i) * lda);
#pragma unroll
  for (int i = 0; i < 2; ++i) rb[i] = *(const u32x4*)(Bg + (size_t)(64 * i) * ldb);
#pragma unroll
  for (int i = 0; i < 4; ++i) *(u32x4*)(As + gswz(lrow + 64 * i, lc)) = ra[i];
#pragma unroll
  for (int i = 0; i < 2; ++i) *(u32x4*)(Bs + gswz(lrow + 64 * i, lc)) = rb[i];
  __syncthreads();
  const int nk = K / 64;
  for (int kt = 0; kt < nk; ++kt) {
    const int cur = kt & 1;
    if (kt + 1 < nk) {
#pragma unroll
      for (int i = 0; i < 4; ++i) ra[i] = *(const u32x4*)(Ag + (size_t)(64 * i) * lda + (kt + 1) * 64);
#pragma unroll
      for (int i = 0; i < 2; ++i) rb[i] = *(const u32x4*)(Bg + (size_t)(64 * i) * ldb + (kt + 1) * 64);
    }
    const unsigned char* Ac = As + cur * 32768; const unsigned char* Bc = Bs + cur * 16384;
#pragma unroll
    for (int kk = 0; kk < 4; ++kk) {
      bf16x8 af[2], bfr[2];
#pragma unroll
      for (int i = 0; i < 2; ++i) af[i] = *(const bf16x8*)(Ac + gswz(wm * 64 + i * 32 + r32, 2 * kk + hi));
#pragma unroll
      for (int j = 0; j < 2; ++j) bfr[j] = *(const bf16x8*)(Bc + gswz(wn * 64 + j * 32 + r32, 2 * kk + hi));
#pragma unroll
      for (int i = 0; i < 2; ++i)
#pragma unroll
        for (int j = 0; j < 2; ++j) acc[i][j] = __builtin_amdgcn_mfma_f32_32x32x16_bf16(af[i], bfr[j], acc[i][j], 0, 0, 0);
    }
    if (kt + 1 < nk) {
      unsigned char* An = As + (cur ^ 1) * 32768; unsigned char* Bn = Bs + (cur ^ 1) * 16384;
#pragma unroll
      for (int i = 0; i < 4; ++i) *(u32x4*)(An + gswz(lrow + 64 * i, lc)) = ra[i];
#pragma unroll
      for (int i = 0; i < 2; ++i) *(u32x4*)(Bn + gswz(lrow + 64 * i, lc)) = rb[i];
    }
    __syncthreads();
  }
}
__device__ __forceinline__ void pair_xchg(float v0, float v1, int lane, float& lo, float& hi2) {
  const bool odd = lane & 1;
  const float send = odd ? v0 : v1;
  const float recv = __shfl_xor(send, 1);
  lo = odd ? recv : v0; hi2 = odd ? v1 : recv;
}

__device__ __forceinline__ void phase_inproj(const Params& p, int l, unsigned char* lds) {
  int tid_ = threadIdx.x; asm volatile("" : "+v"(tid_)); const int tid = tid_, lane = tid & 63, wid = tid >> 6, wm = wid >> 1, wn = wid & 1, r32 = lane & 31, hi = lane >> 5;
  const bf16_t* H = (const bf16_t*)(p.ws + WS_H);
  const bf16_t* W = (const bf16_t*)(p.ws + WS_WIN) + (size_t)l * PW * DM;
  bf16_t* PROJ = (bf16_t*)(p.ws + WS_PROJ);
  const float* RC = (const float*)(p.ws + WS_ROPE); const float* RS = RC + SEQ * 32;
  constexpr int NM = T / 256, NN = PW / 128, NU = NM * NN;
  for (int u = p.bx; u < NU + NM; u += p.gx) {
    if (u < NU) {
      const int pn = u / NM, pm = u % NM;
      const int row0 = pm * 256, col0 = pn * 128;
      f32x16 acc[2][2];
      gemm_tile(H, DM, W, DM, DM, row0, col0, lds, acc);
      const bool rope = (col0 >= C_DQ && col0 < C_DV);
      const float scl = (col0 >= C_MK && col0 < C_MV) ? 0.125f : ((col0 >= C_DQ && col0 < C_DK) ? QSCALE : 1.f);
#pragma unroll
      for (int i = 0; i < 2; ++i)
#pragma unroll
        for (int j = 0; j < 2; ++j)
#pragma unroll
          for (int q = 0; q < 8; ++q) {
            float lo, hi2; pair_xchg(acc[i][j][2 * q], acc[i][j][2 * q + 1], lane, lo, hi2);
            const int row = row0 + wm * 64 + i * 32 + crow(2 * q, hi) + (lane & 1);
            const int col = col0 + wn * 64 + j * 32 + (r32 & ~1);
            if (rope) {
              const int s = row % SEGL;
              if (s >= CTXL) {
                const int idx = (s - CTXL) * 32 + ((col & 63) >> 1);
                const float c = RC[idx], sn = RS[idx];
                const float t1 = lo, t2 = hi2; lo = t1 * c - t2 * sn; hi2 = t1 * sn + t2 * c;
              }
            }
            *(unsigned*)(PROJ + (size_t)row * PW + col) = cvtpk(lo * scl, hi2 * scl);
          }
    } else {
      const int pm = u - NU, rowb = pm * 256 + wid * 32;
      const bf16_t* WG = (const bf16_t*)(p.ws + WS_WG) + (size_t)l * 16 * DM;
      float* GT = (float*)(p.ws + WS_GATES);
      const int r16 = lane & 15, q4 = lane >> 4;
      f32x4 c0 = {0.f, 0.f, 0.f, 0.f}, c1 = {0.f, 0.f, 0.f, 0.f};
      const bf16_t* a0p = H + (size_t)(rowb + r16) * DM + q4 * 8;
      const bf16_t* a1p = a0p + (size_t)16 * DM;
      const bf16_t* bp = WG + (size_t)r16 * DM + q4 * 8;
#pragma unroll 4
      for (int ks = 0; ks < 32; ++ks) {
        const bf16x8 a0 = *(const bf16x8*)(a0p + ks * 32), a1 = *(const bf16x8*)(a1p + ks * 32), b = *(const bf16x8*)(bp + ks * 32);
        c0 = __builtin_amdgcn_mfma_f32_16x16x32_bf16(a0, b, c0, 0, 0, 0);
        c1 = __builtin_amdgcn_mfma_f32_16x16x32_bf16(a1, b, c1, 0, 0, 0);
      }
      const float gb = p.in[I_GATEB][l * 16 + r16];
#pragma unroll
      for (int j = 0; j < 4; ++j) {
        GT[(size_t)(rowb + q4 * 4 + j) * 16 + r16] = c0[j] + gb;
        GT[(size_t)(rowb + 16 + q4 * 4 + j) * 16 + r16] = c1[j] + gb;
      }
    }
  }
}

__device__ __forceinline__ void phase_outproj(const Params& p, int l, unsigned char* lds) {
  int tid_ = threadIdx.x; asm volatile("" : "+v"(tid_)); const int tid = tid_, lane = tid & 63, wid = tid >> 6, wm = wid >> 1, wn = wid & 1, r32 = lane & 31, hi = lane >> 5;
  const bf16_t* MIX = (const bf16_t*)(p.ws + WS_MIX);
  const bf16_t* W = (const bf16_t*)(p.ws + WS_WOUT) + (size_t)l * DM * DM;
  float* XC = (float*)(p.ws + WS_XCUR);
  const float* MOD = (const float*)(p.ws + WS_MOD);
  constexpr int NM = T / 256, NN = DM / 128, NU = NM * NN;
  for (int u = p.bx; u < NU; u += p.gx) {
    const int pm = u / NN, pn = u % NN;
    if (l == DEPTH - 1 && (pm % 33) == 0) continue;
    const int row0 = pm * 256, col0 = pn * 128;
    for (int rep = 0; rep < REP_OUTP; ++rep) {
    f32x16 acc[2][2];
    gemm_tile(MIX, DM, W, DM, DM, row0, col0, lds, acc);
    const int mr = (pm % 33) == 0 ? 4 : pm / 33;
    const float* g1 = MOD + ((size_t)l * 5 + mr) * 6144 + 2048;
#pragma unroll
    for (int i = 0; i < 2; ++i)
#pragma unroll
      for (int j = 0; j < 2; ++j) {
        const int col = col0 + wn * 64 + j * 32 + r32;
        const float gg = (rep == REP_OUTP - 1) ? g1[col] : 0.f;
#pragma unroll
        for (int r = 0; r < 16; ++r) {
          const int row = row0 + wm * 64 + i * 32 + crow(r, hi);
          const float xo = (l == 0) ? in_row(p.in[I_X], p.in[I_CTX], row)[col] : XC[(size_t)row * DM + col];
          XC[(size_t)row * DM + col] = xo + gg * acc[i][j][r];
        }
      }
    }
  }
}
__device__ __forceinline__ void phase_peerq(const Params& p, int l, unsigned char* lds) {
  int tid_ = threadIdx.x; asm volatile("" : "+v"(tid_)); const int tid = tid_, lane = tid & 63, wid = tid >> 6, wm = wid >> 1, wn = wid & 1, r32 = lane & 31, hi = lane >> 5;
  const bf16_t* H = (const bf16_t*)(p.ws + WS_H);
  const bf16_t* W = (const bf16_t*)(p.ws + WS_WQ) + (size_t)l * DM * DM;
  bf16_t* QP = (bf16_t*)(p.ws + WS_PROJ);
  constexpr int NM = T / 256, NN = DM / 128, NU = NM * NN;
  for (int u = p.bx; u < NU; u += p.gx) {
    const int pm = u / NN, pn = u % NN;
    if (l == DEPTH - 1 && (pm % 33) == 0) continue;
    const int row0 = pm * 256, col0 = pn * 128;
    f32x16 acc[2][2];
    gemm_tile(H, DM, W, DM, DM, row0, col0, lds, acc);
#pragma unroll
    for (int i = 0; i < 2; ++i)
#pragma unroll
      for (int j = 0; j < 2; ++j)
#pragma unroll
        for (int q = 0; q < 8; ++q) {
          float lo, hi2; pair_xchg(acc[i][j][2 * q], acc[i][j][2 * q + 1], lane, lo, hi2);
          const int row = row0 + wm * 64 + i * 32 + crow(2 * q, hi) + (lane & 1);
          const int col = col0 + wn * 64 + j * 32 + (r32 & ~1);
          *(unsigned*)(QP + (size_t)row * DM + col) = cvtpk(lo, hi2);
        }
  }
}


struct EpiInproj {
  static constexpr bool PERM = true, AFTER_DRAIN = false;
  bf16_t* PROJ; const float* RC; const float* RS;
  __device__ __forceinline__ void operator()(const pg8::f32x4 (&acc)[2][2][4][2], const pg8::Unit& u, int wr, int wc, int fr, int fq) const {
#pragma unroll
    for (int bj = 0; bj < 2; ++bj) {
      const int colt = u.pn * 256 + bj * 128;
      const bool rope = (colt >= C_DQ && colt < C_DV);
      const float scl = (colt >= C_MK && colt < C_MV) ? 0.125f : ((colt >= C_DQ && colt < C_DK) ? QSCALE : 1.f);
      const int col8 = colt + wc * 32 + 8 * fq;
#pragma unroll
      for (int ai = 0; ai < 2; ++ai)
#pragma unroll
        for (int m = 0; m < 4; ++m) {
          const int row = u.pm * 256 + ai * 128 + wr * 64 + m * 16 + fr;
          f32x4 v0 = acc[ai][bj][m][0], v1 = acc[ai][bj][m][1];
          if (rope) {
            const int s = row % SEGL;
            if (s >= CTXL) {
              const int idx = (s - CTXL) * 32 + ((col8 & 63) >> 1);
              const f32x4 c = *(const f32x4*)(RC + idx), sn = *(const f32x4*)(RS + idx);
              f32x4 a, b;
              a[0] = v0[0] * c[0] - v0[1] * sn[0]; a[1] = v0[0] * sn[0] + v0[1] * c[0]; a[2] = v0[2] * c[1] - v0[3] * sn[1]; a[3] = v0[2] * sn[1] + v0[3] * c[1];
              b[0] = v1[0] * c[2] - v1[1] * sn[2]; b[1] = v1[0] * sn[2] + v1[1] * c[2]; b[2] = v1[2] * c[3] - v1[3] * sn[3]; b[3] = v1[2] * sn[3] + v1[3] * c[3];
              v0 = a; v1 = b;
            }
          }
          u32x4 w; w.x = cvtpk(v0[0] * scl, v0[1] * scl); w.y = cvtpk(v0[2] * scl, v0[3] * scl); w.z = cvtpk(v1[0] * scl, v1[1] * scl); w.w = cvtpk(v1[2] * scl, v1[3] * scl);
          *(u32x4*)(PROJ + (size_t)row * PW + col8) = w;
        }
    }
  }
};
struct EpiOutproj {
  static constexpr bool PERM = true, AFTER_DRAIN = false;
  float* XC; const float* MODL; const float* xin; const float* ctxin; int first; float gsc;
  __device__ __forceinline__ void operator()(const pg8::f32x4 (&acc)[2][2][4][2], const pg8::Unit& u, int wr, int wc, int fr, int fq) const {
    const int mr = (u.pm % 33) == 0 ? 4 : u.pm / 33;
    const float* g1 = MODL + (size_t)mr * 6144 + 2048;
#pragma unroll
    for (int bj = 0; bj < 2; ++bj) {
      const int col8 = u.pn * 256 + bj * 128 + wc * 32 + 8 * fq;
      const f32x4 ga = *(const f32x4*)(g1 + col8) * gsc, gb = *(const f32x4*)(g1 + col8 + 4) * gsc;
#pragma unroll
      for (int ai = 0; ai < 2; ++ai)
#pragma unroll
        for (int m = 0; m < 4; ++m) {
          const int row = u.pm * 256 + ai * 128 + wr * 64 + m * 16 + fr;
          const float* xo = first ? in_row(xin, ctxin, row) + col8 : XC + (size_t)row * DM + col8;
          const f32x4 xa = *(const f32x4*)xo, xb = *(const f32x4*)(xo + 4);
          *(f32x4*)(XC + (size_t)row * DM + col8) = xa + ga * acc[ai][bj][m][0];
          *(f32x4*)(XC + (size_t)row * DM + col8 + 4) = xb + gb * acc[ai][bj][m][1];
        }
    }
  }
};
struct EpiPeerq {
  static constexpr bool PERM = true, AFTER_DRAIN = false;
  bf16_t* QP;
  __device__ __forceinline__ void operator()(const pg8::f32x4 (&acc)[2][2][4][2], const pg8::Unit& u, int wr, int wc, int fr, int fq) const {
#pragma unroll
    for (int bj = 0; bj < 2; ++bj) {
      const int col8 = u.pn * 256 + bj * 128 + wc * 32 + 8 * fq;
#pragma unroll
      for (int ai = 0; ai < 2; ++ai)
#pragma unroll
        for (int m = 0; m < 4; ++m) {
          const int row = u.pm * 256 + ai * 128 + wr * 64 + m * 16 + fr;
          const f32x4 v0 = acc[ai][bj][m][0], v1 = acc[ai][bj][m][1];
          u32x4 w; w.x = cvtpk(v0[0], v0[1]); w.y = cvtpk(v0[2], v0[3]); w.z = cvtpk(v1[0], v1[1]); w.w = cvtpk(v1[2], v1[3]);
          *(u32x4*)(QP + (size_t)row * DM + col8) = w;
        }
    }
  }
};
__device__ __forceinline__ void phase_inproj2(const Params& p, int l, unsigned char* lds) {
  {
    pg8::Gemm g{(const bf16_t*)(p.ws + WS_H), (const bf16_t*)(p.ws + WS_WIN) + (size_t)l * PW * DM, T, PW, DM};
    pg8::StaticOrder S; S.init(T, PW, p.gx, p.bx);
    EpiInproj E{(bf16_t*)(p.ws + WS_PROJ), (const float*)(p.ws + WS_ROPE), (const float*)(p.ws + WS_ROPE) + SEQ * 32};
    pg8::gemm_phase<EpiInproj, pg8::StaticOrder, true, true>((PG8_LAS unsigned char*)lds, g, S, E);
  }
  int tid_ = threadIdx.x; asm volatile("" : "+v"(tid_)); const int tid = tid_, lane = tid & 63, wid = tid >> 6;
  const bf16_t* H = (const bf16_t*)(p.ws + WS_H);
  for (int pm = p.bx; pm < T / 256; pm += p.gx) {
    const int rowb = pm * 256 + wid * 32;
    const bf16_t* WG = (const bf16_t*)(p.ws + WS_WG) + (size_t)l * 16 * DM;
    float* GT = (float*)(p.ws + WS_GATES);
    const int r16 = lane & 15, q4 = lane >> 4;
    f32x4 c0 = {0.f, 0.f, 0.f, 0.f}, c1 = {0.f, 0.f, 0.f, 0.f};
    const bf16_t* a0p = H + (size_t)(rowb + r16) * DM + q4 * 8;
    const bf16_t* a1p = a0p + (size_t)16 * DM;
    const bf16_t* bp = WG + (size_t)r16 * DM + q4 * 8;
#pragma unroll 4
    for (int ks = 0; ks < 32; ++ks) {
      const bf16x8 a0 = *(const bf16x8*)(a0p + ks * 32), a1 = *(const bf16x8*)(a1p + ks * 32), b = *(const bf16x8*)(bp + ks * 32);
      c0 = __builtin_amdgcn_mfma_f32_16x16x32_bf16(a0, b, c0, 0, 0, 0);
      c1 = __builtin_amdgcn_mfma_f32_16x16x32_bf16(a1, b, c1, 0, 0, 0);
    }
    const float gb = p.in[I_GATEB][l * 16 + r16];
#pragma unroll
    for (int j = 0; j < 4; ++j) {
      GT[(size_t)(rowb + q4 * 4 + j) * 16 + r16] = c0[j] + gb;
      GT[(size_t)(rowb + 16 + q4 * 4 + j) * 16 + r16] = c1[j] + gb;
    }
  }
}
__device__ __forceinline__ void phase_outproj2(const Params& p, int l, unsigned char* lds) {
  pg8::Gemm g{(const bf16_t*)(p.ws + WS_MIX), (const bf16_t*)(p.ws + WS_WOUT) + (size_t)l * DM * DM, T, DM, DM};
  pg8::StaticOrder S; S.init(T, DM, p.gx, p.bx);
  for (int rep = 0; rep < REP_OUTP; ++rep) {
  EpiOutproj E{(float*)(p.ws + WS_XCUR), (const float*)(p.ws + WS_MOD) + (size_t)l * 5 * 6144, p.in[I_X], p.in[I_CTX], l == 0, (rep == REP_OUTP - 1) ? 1.f : 0.f};
  pg8::gemm_phase<EpiOutproj, pg8::StaticOrder, true, true>((PG8_LAS unsigned char*)lds, g, S, E);
  }
}
__device__ __forceinline__ void phase_peerq2(const Params& p, int l, unsigned char* lds) {
  pg8::Gemm g{(const bf16_t*)(p.ws + WS_H), (const bf16_t*)(p.ws + WS_WQ) + (size_t)l * DM * DM, T, DM, DM};
  pg8::StaticOrder S; S.init(T, DM, p.gx, p.bx);
  EpiPeerq E{(bf16_t*)(p.ws + WS_PROJ)};
  pg8::gemm_phase<EpiPeerq, pg8::StaticOrder, true, true>((PG8_LAS unsigned char*)lds, g, S, E);
}

__device__ __forceinline__ void conv_unit(const Params& p, int l, int unit, unsigned char* lds) {
  int tid_ = threadIdx.x; asm volatile("" : "+v"(tid_)); const int tid = tid_, lane = tid & 63, wid = tid >> 6;
  float* U = (float*)lds;
  const bf16_t* PROJ = (const bf16_t*)(p.ws + WS_PROJ);
  bf16_t* MIX = (bf16_t*)(p.ws + WS_MIX);
  const int row0 = unit * 32, b = row0 / SEGL, s0 = row0 - b * SEGL;
  const int seglo = s0 < CTXL ? 0 : CTXL, seghi = s0 < CTXL ? CTXL : SEGL;
  for (int rr = tid >> 5; rr < 62; rr += 16) {
    const int s = s0 - 15 + rr, c8 = (tid & 31) * 8;
    f32x4 u0 = {0.f, 0.f, 0.f, 0.f}, u1 = {0.f, 0.f, 0.f, 0.f};
    if (s >= seglo && s < seghi) {
      const bf16_t* pr = PROJ + (size_t)(b * SEGL + s) * PW + c8;
      const u32x4 a1 = *(const u32x4*)pr, a2 = *(const u32x4*)(pr + 256);
      u0.x = bflo(a1.x) * sigmoidf_(bflo(a2.x)); u0.y = bfhi(a1.x) * sigmoidf_(bfhi(a2.x));
      u0.z = bflo(a1.y) * sigmoidf_(bflo(a2.y)); u0.w = bfhi(a1.y) * sigmoidf_(bfhi(a2.y));
      u1.x = bflo(a1.z) * sigmoidf_(bflo(a2.z)); u1.y = bfhi(a1.z) * sigmoidf_(bfhi(a2.z));
      u1.z = bflo(a1.w) * sigmoidf_(bflo(a2.w)); u1.w = bfhi(a1.w) * sigmoidf_(bfhi(a2.w));
    }
    *(f32x4*)(U + rr * 256 + c8) = u0; *(f32x4*)(U + rr * 256 + c8 + 4) = u1;
  }
  __syncthreads();
  float* Y = U + 62 * 256;
  const float* cw = p.in[I_CONVW] + (size_t)l * 31 * 256;
#pragma unroll 1
  for (int q = 0; q < 4; ++q) {
    const int c = lane + 64 * q;
    float w[31];
#pragma unroll
    for (int j = 0; j < 31; ++j) w[j] = cw[j * 256 + c];
    const float bias = p.in[I_CONVB][l * 256 + c];
#pragma unroll
    for (int tt = 0; tt < 4; ++tt) {
      const int t = wid * 4 + tt;
      float a = bias;
#pragma unroll
      for (int j = 0; j < 31; ++j) a += U[(t + j) * 256 + c] * w[j];
      Y[t * 256 + c] = a;
    }
  }
  asm volatile("s_waitcnt lgkmcnt(0)" ::: "memory");
  float y[4][4];
#pragma unroll
  for (int tt = 0; tt < 4; ++tt)
#pragma unroll
    for (int q = 0; q < 4; ++q) y[tt][q] = Y[(wid * 4 + tt) * 256 + lane + 64 * q];
#pragma unroll
  for (int tt = 0; tt < 4; ++tt) {
    const int t = wid * 4 + tt;
    const float mean = wave_sum((y[tt][0] + y[tt][1]) + (y[tt][2] + y[tt][3])) * (1.f / 256.f);
    float v = 0.f;
#pragma unroll
    for (int q = 0; q < 4; ++q) { const float d = y[tt][q] - mean; v += d * d; }
    const float rs = rsqrtf(wave_sum(v) * (1.f / 256.f) + EPS);
#pragma unroll
    for (int q = 0; q < 4; ++q) {
      const int c = lane + 64 * q;
      const float z = (y[tt][q] - mean) * rs * p.in[I_CLNG][l * 256 + c] + p.in[I_CLNB][l * 256 + c];
      const float o = (ABL & 1) ? 0.f : z * sigmoidf_(z);
      MIX[(size_t)(row0 + t) * DM + c] = (bf16_t)(cvtpk(o, 0.f) & 0xffffu);
    }
  }
  __syncthreads();
}

__device__ __forceinline__ int ml_cidx(int ch, int dir) { return dir == 0 ? ch : (ch < 4 ? 3 - ch : 135 - ch); }
__device__ __forceinline__ void ml_load_tile(const bf16_t* src, float* dst, int tid) {
  const int r = tid >> 3, c8 = (tid & 7) * 8;
  const u32x4 a = *(const u32x4*)(src + (size_t)r * PW + c8);
  float* d = dst + r * 65 + c8;
  d[0] = bflo(a.x); d[1] = bfhi(a.x); d[2] = bflo(a.y); d[3] = bfhi(a.y); d[4] = bflo(a.z); d[5] = bfhi(a.z); d[6] = bflo(a.w); d[7] = bfhi(a.w);
}
__device__ __forceinline__ void ml_local_unit(const Params& p, int l, int unit, unsigned char* lds) {
  int tid_ = threadIdx.x; asm volatile("" : "+v"(tid_)); const int tid = tid_, lane = tid & 63, wid = tid >> 6, r32 = lane & 31, hi = lane >> 5;
  float* Kt = (float*)lds; float* Vt = Kt + 64 * 65; float* WK = Vt + 64 * 65;
  const bf16_t* PROJ = (const bf16_t*)(p.ws + WS_PROJ);
  const float* GT = (const float*)(p.ws + WS_GATES);
  float* UL = (float*)(p.ws + WS_ULOC); float* META = (float*)(p.ws + WS_MLMETA);
  const int b = unit / (4 * NCH), hh = (unit / NCH) & 3, ch = unit % NCH;
  const int row0 = b * SEGL + ch * 64;
  ml_load_tile(PROJ + (size_t)row0 * PW + C_MK + hh * 64, Kt, tid);
  ml_load_tile(PROJ + (size_t)row0 * PW + C_MV + hh * 64, Vt, tid);
  if (wid < 2) {
    const int dir = wid;
    const float ig = GT[(size_t)(row0 + lane) * 16 + (2 * dir) * 4 + hh];
    const float lf = logsigmoidf_(GT[(size_t)(row0 + lane) * 16 + (2 * dir + 1) * 4 + hh]);
    float ps = lf;
#pragma unroll
    for (int o = 1; o < 64; o <<= 1) { const float t = __shfl_up(ps, o); if (lane >= o) ps += t; }
    const float tot = __shfl(ps, 63);
    const float wlog = dir == 0 ? (tot - ps + ig) : (ps - lf + ig);
    const float mloc = wave_max(wlog);
    WK[dir * 64 + lane] = __expf(wlog - mloc);
    if (lane == 0) {
      const int seq = (b * 4 + hh) * 2 + dir, ci = ml_cidx(ch, dir);
      META[((size_t)seq * NCH + ci) * 4 + 0] = tot; META[((size_t)seq * NCH + ci) * 4 + 1] = mloc;
    }
  }
  __syncthreads();
  {
    const int dir = wid >> 2, et = (wid >> 1) & 1, dt = wid & 1;
    const int seq = (b * 4 + hh) * 2 + dir, ci = ml_cidx(ch, dir);
    float* slot = UL + ((size_t)seq * NCH + ci) * USTRIDE;
    f32x16 acc = {};
#pragma unroll 8
    for (int ks = 0; ks < 32; ++ks) {
      const int s = 2 * ks + hi;
      const float a = WK[dir * 64 + s] * Vt[s * 65 + et * 32 + r32];
      const float bb = Kt[s * 65 + dt * 32 + r32];
      acc = __builtin_amdgcn_mfma_f32_32x32x2f32(a, bb, acc, 0, 0, 0);
    }
#pragma unroll
    for (int r = 0; r < 16; ++r) slot[(et * 32 + crow(r, hi)) * 64 + dt * 32 + r32] = acc[r];
    if (et == 0) {
      float n = 0.f;
#pragma unroll 8
      for (int i = 0; i < 32; ++i) { const int s = hi * 32 + i; n += WK[dir * 64 + s] * Kt[s * 65 + dt * 32 + r32]; }
      n += __shfl_xor(n, 32);
      if (hi == 0) slot[4096 + dt * 32 + r32] = n;
    }
  }
  __syncthreads();
}
constexpr int MLP = 144;
constexpr size_t WS_CST = WS_H;
constexpr size_t WS_NST = WS_H + (size_t)32 * NCH * 4096 * 2;
__device__ __forceinline__ void ml_stage_rm(const bf16_t* src, size_t ld, unsigned char* dst, int tid) {
  const int r = tid >> 3, c8 = (tid & 7) * 8;
  *(u32x4*)(dst + r * MLP + c8 * 2) = *(const u32x4*)(src + (size_t)r * ld + c8);
}
__device__ __forceinline__ void ml_stage_tr(const bf16_t* src, size_t ld, unsigned char* dst, int tid) {
  const int r = tid >> 3, c8 = (tid & 7) * 8;
  const u32x4 a = *(const u32x4*)(src + (size_t)r * ld + c8);
  bf16_t* d = (bf16_t*)dst;
  d[(c8 + 0) * 72 + r] = (bf16_t)(a.x & 0xffffu); d[(c8 + 1) * 72 + r] = (bf16_t)(a.x >> 16);
  d[(c8 + 2) * 72 + r] = (bf16_t)(a.y & 0xffffu); d[(c8 + 3) * 72 + r] = (bf16_t)(a.y >> 16);
  d[(c8 + 4) * 72 + r] = (bf16_t)(a.z & 0xffffu); d[(c8 + 5) * 72 + r] = (bf16_t)(a.z >> 16);
  d[(c8 + 6) * 72 + r] = (bf16_t)(a.w & 0xffffu); d[(c8 + 7) * 72 + r] = (bf16_t)(a.w >> 16);
}
__device__ __forceinline__ void ml_local_unit2(const Params& p, int l, int unit, unsigned char* lds) {
  int tid_ = threadIdx.x; asm volatile("" : "+v"(tid_)); const int tid = tid_, lane = tid & 63, wid = tid >> 6, r32 = lane & 31, hi = lane >> 5;
  unsigned char* KT = lds; unsigned char* VT = lds + 64 * MLP; float* WK = (float*)(lds + 2 * 64 * MLP);
  const bf16_t* PROJ = (const bf16_t*)(p.ws + WS_PROJ);
  const float* GT = (const float*)(p.ws + WS_GATES);
  float* UL = (float*)(p.ws + WS_ULOC); float* META = (float*)(p.ws + WS_MLMETA);
  const int b = unit / (4 * NCH), hh = (unit / NCH) & 3, ch = unit % NCH;
  const int row0 = b * SEGL + ch * 64;
  ml_stage_tr(PROJ + (size_t)row0 * PW + C_MK + hh * 64, PW, KT, tid);
  ml_stage_tr(PROJ + (size_t)row0 * PW + C_MV + hh * 64, PW, VT, tid);
  if (wid < 2) {
    const int dir = wid;
    const float ig = GT[(size_t)(row0 + lane) * 16 + (2 * dir) * 4 + hh];
    const float lf = logsigmoidf_(GT[(size_t)(row0 + lane) * 16 + (2 * dir + 1) * 4 + hh]);
    float ps = lf;
#pragma unroll
    for (int o = 1; o < 64; o <<= 1) { const float t = __shfl_up(ps, o); if (lane >= o) ps += t; }
    const float tot = __shfl(ps, 63);
    const float wlog = dir == 0 ? (tot - ps + ig) : (ps - lf + ig);
    const float mloc = wave_max(wlog);
    WK[dir * 64 + lane] = __expf(wlog - mloc);
    if (lane == 0) {
      const int seq = (b * 4 + hh) * 2 + dir, ci = ml_cidx(ch, dir);
      META[((size_t)seq * NCH + ci) * 4 + 0] = tot; META[((size_t)seq * NCH + ci) * 4 + 1] = mloc;
    }
  }
  __syncthreads();
  {
    const int dir = wid >> 2, et = (wid >> 1) & 1, dt = wid & 1;
    const int seq = (b * 4 + hh) * 2 + dir, ci = ml_cidx(ch, dir);
    float* slot = UL + ((size_t)seq * NCH + ci) * USTRIDE;
    f32x16 acc = {};
#pragma unroll
    for (int ks = 0; ks < 4; ++ks) {
      const int s0 = ks * 16 + hi * 8;
      const u32x4 va = *(const u32x4*)(VT + (et * 32 + r32) * MLP + s0 * 2);
      const bf16x8 kb = *(const bf16x8*)(KT + (dt * 32 + r32) * MLP + s0 * 2);
      const f32x4 w0 = *(const f32x4*)(WK + dir * 64 + s0), w1 = *(const f32x4*)(WK + dir * 64 + s0 + 4);
      u32x4 sa; sa.x = cvtpk(bflo(va.x) * w0.x, bfhi(va.x) * w0.y); sa.y = cvtpk(bflo(va.y) * w0.z, bfhi(va.y) * w0.w);
      sa.z = cvtpk(bflo(va.z) * w1.x, bfhi(va.z) * w1.y); sa.w = cvtpk(bflo(va.w) * w1.z, bfhi(va.w) * w1.w);
      acc = __builtin_amdgcn_mfma_f32_32x32x16_bf16(*(const bf16x8*)&sa, kb, acc, 0, 0, 0);
    }
#pragma unroll
    for (int r = 0; r < 16; ++r) slot[(et * 32 + crow(r, hi)) * 64 + dt * 32 + r32] = acc[r];
    if (et == 0) {
      float n = 0.f;
#pragma unroll
      for (int i = 0; i < 4; ++i) {
        const int s0 = hi * 32 + i * 8;
        const u32x4 ka = *(const u32x4*)(KT + (dt * 32 + r32) * MLP + s0 * 2);
        const f32x4 w0 = *(const f32x4*)(WK + dir * 64 + s0), w1 = *(const f32x4*)(WK + dir * 64 + s0 + 4);
        n += bflo(ka.x) * w0.x + bfhi(ka.x) * w0.y + bflo(ka.y) * w0.z + bfhi(ka.y) * w0.w + bflo(ka.z) * w1.x + bfhi(ka.z) * w1.y + bflo(ka.w) * w1.z + bfhi(ka.w) * w1.w;
      }
      n += __shfl_xor(n, 32);
      if (hi == 0) slot[4096 + dt * 32 + r32] = n;
    }
  }
  __syncthreads();
}
__device__ __forceinline__ void ml_scan(const Params& p, unsigned char* lds) {
  float* UL = (float*)(p.ws + WS_ULOC); float* META = (float*)(p.ws + WS_MLMETA);
  int tid_ = threadIdx.x; asm volatile("" : "+v"(tid_));
  const int tid = tid_, lane = tid & 63, wid = tid >> 6;
  float* DEC = (float*)lds;
  float* SCL = DEC + 2 * NCH;
  float* TMP = SCL + 2 * NCH;
  for (int base0 = p.bx * 512; base0 < 32 * USTRIDE; base0 += p.gx * 512) {
    const int seq0 = base0 / USTRIDE;
    if (wid < 2) {
      const int seq = seq0 + wid;
      if (seq < 32) {
        float* mt = META + (size_t)seq * NCH * 4;
        for (int c = lane; c < NCH; c += 64) { TMP[(wid * 2 + 0) * NCH + c] = mt[c * 4 + 0]; TMP[(wid * 2 + 1) * NCH + c] = mt[c * 4 + 1]; }
        asm volatile("s_waitcnt lgkmcnt(0)" ::: "memory");
        if (lane == 0) {
          float m = 0.f;
          for (int c = 0; c < NCH; ++c) {
            const float bl = TMP[(wid * 2 + 0) * NCH + c], mloc = TMP[(wid * 2 + 1) * NCH + c];
            const float mn = fmaxf(bl + m, mloc);
            DEC[wid * NCH + c] = __expf(bl + m - mn); SCL[wid * NCH + c] = __expf(mloc - mn);
            mt[c * 4 + 2] = m;
            m = mn;
          }
        }
      }
    }
    __syncthreads();
    const int idx = base0 + tid;
    if (idx < 32 * USTRIDE) {
      const int seq = idx / USTRIDE, e = idx - seq * USTRIDE, sl = seq - seq0;
      float* bp = UL + (size_t)seq * NCH * USTRIDE + e;
      bf16_t* CSTp = (bf16_t*)(p.ws + WS_CST) + (size_t)seq * NCH * 4096 + (e < 4096 ? e : 0);
      float* NSTp = (float*)(p.ws + WS_NST) + (size_t)seq * NCH * 64 + (e < 4096 ? 0 : e - 4096);
      const float* dec = DEC + sl * NCH; const float* scl = SCL + sl * NCH;
      float C = 0.f;
#pragma unroll 1
      for (int c0 = 0; c0 < NCH; c0 += 12) {
        float u[12];
#pragma unroll
        for (int j = 0; j < 12; ++j) u[j] = bp[(size_t)(c0 + j) * USTRIDE];
#pragma unroll
        for (int j = 0; j < 12; ++j) {
          if (e < 4096) CSTp[(size_t)(c0 + j) * 4096] = (bf16_t)(cvtpk(C, 0.f) & 0xffffu); else NSTp[(size_t)(c0 + j) * 64] = C;
          C = dec[c0 + j] * C + scl[c0 + j] * u[j]; }
      }
    }
    __syncthreads();
  }
}
__device__ __forceinline__ void ml_out_unit(const Params& p, int l, int unit, unsigned char* lds) {
  int tid_ = threadIdx.x; asm volatile("" : "+v"(tid_)); const int tid = tid_, lane = tid & 63, wid = tid >> 6, r32 = lane & 31, hi = lane >> 5;
  float* Qt = (float*)lds; float* Kt = Qt + 64 * 65; float* Vt = Kt + 64 * 65;
  float* Cs = Vt + 64 * 65;
  float* Ns = Cs + 2 * 64 * 65;
  float* Bq = Ns + 128;
  float* Gs = Bq + 128;
  float* Mi = Gs + 128;
  float* HB = Mi + 64;
  const bf16_t* PROJ = (const bf16_t*)(p.ws + WS_PROJ);
  const float* GT = (const float*)(p.ws + WS_GATES);
  const float* UL = (const float*)(p.ws + WS_ULOC); const float* META = (const float*)(p.ws + WS_MLMETA);
  bf16_t* MIX = (bf16_t*)(p.ws + WS_MIX);
  const int b = unit / (4 * NCH), hh = (unit / NCH) & 3, ch = unit % NCH;
  const int row0 = b * SEGL + ch * 64;
  ml_load_tile(PROJ + (size_t)row0 * PW + C_MQ + hh * 64, Qt, tid);
  ml_load_tile(PROJ + (size_t)row0 * PW + C_MK + hh * 64, Kt, tid);
  ml_load_tile(PROJ + (size_t)row0 * PW + C_MV + hh * 64, Vt, tid);
  for (int i = tid; i < 2 * USTRIDE; i += 512) {
    const int dir = i / USTRIDE, e = i - dir * USTRIDE;
    const int seq = (b * 4 + hh) * 2 + dir, ci = ml_cidx(ch, dir);
    const float v = UL[((size_t)seq * NCH + ci) * USTRIDE + e];
    if (e < 4096) Cs[dir * 64 * 65 + (e >> 6) * 65 + (e & 63)] = v; else Ns[dir * 64 + (e - 4096)] = v;
  }
  if (wid < 2) {
    const int dir = wid;
    const float ig = GT[(size_t)(row0 + lane) * 16 + (2 * dir) * 4 + hh];
    const float lf = logsigmoidf_(GT[(size_t)(row0 + lane) * 16 + (2 * dir + 1) * 4 + hh]);
    float ps = lf;
#pragma unroll
    for (int o = 1; o < 64; o <<= 1) { const float t = __shfl_up(ps, o); if (lane >= o) ps += t; }
    const float tot = __shfl(ps, 63);
    const float bc = dir == 0 ? ps : (tot - ps + lf);
    Bq[dir * 64 + lane] = bc; Gs[dir * 64 + lane] = ig - bc;
    if (lane == 0) { const int seq = (b * 4 + hh) * 2 + dir, ci = ml_cidx(ch, dir); Mi[dir] = META[((size_t)seq * NCH + ci) * 4 + 2]; }
  }
  __syncthreads();
  {
    const int dir = wid >> 2, tt = (wid >> 1) & 1, et = wid & 1;
    const int t = tt * 32 + r32;
    f32x16 sa[2] = {};
#pragma unroll 4
    for (int ks = 0; ks < 32; ++ks) {
      const float bq = Qt[t * 65 + 2 * ks + hi];
      const float a0 = Kt[(r32) * 65 + 2 * ks + hi], a1 = Kt[(32 + r32) * 65 + 2 * ks + hi];
      sa[0] = __builtin_amdgcn_mfma_f32_32x32x2f32(a0, bq, sa[0], 0, 0, 0);
      sa[1] = __builtin_amdgcn_mfma_f32_32x32x2f32(a1, bq, sa[1], 0, 0, 0);
    }
    const float bt = Bq[dir * 64 + t];
    const float inter = bt + Mi[dir];
    float mx = -INFINITY;
    f32x16 dl[2];
#pragma unroll
    for (int st = 0; st < 2; ++st)
#pragma unroll
      for (int r = 0; r < 16; ++r) {
        const int s = st * 32 + crow(r, hi);
        const bool ok = dir == 0 ? (s <= t) : (s >= t);
        const float d = ok ? bt + Gs[dir * 64 + s] : -INFINITY;
        dl[st][r] = d; mx = fmaxf(mx, d);
      }
    mx = fmaxf(mx, __shfl_xor(mx, 32));
    const float mt = fmaxf(inter, mx);
    const float iw = __expf(inter - mt);
    float rsum = 0.f;
#pragma unroll
    for (int st = 0; st < 2; ++st)
#pragma unroll
      for (int r = 0; r < 16; ++r) { const float w = __expf(dl[st][r] - mt); sa[st][r] *= w; rsum += sa[st][r]; }
    rsum += __shfl_xor(rsum, 32);
    float qn = 0.f;
#pragma unroll 8
    for (int i = 0; i < 32; ++i) { const int d = hi * 32 + i; qn += Ns[dir * 64 + d] * Qt[t * 65 + d]; }
    qn += __shfl_xor(qn, 32);
    const float den = rsum + iw * qn;
    const float rden = 1.f / fmaxf(fabsf(den), __expf(-mt));
    f32x16 an = {}, ac = {};
#pragma unroll
    for (int st = 0; st < 2; ++st)
#pragma unroll
      for (int r = 0; r < 16; ++r) {
        const float a = Vt[(st * 32 + crow(r, hi)) * 65 + et * 32 + r32];
        an = __builtin_amdgcn_mfma_f32_32x32x2f32(a, sa[st][r], an, 0, 0, 0);
      }
    const float* Cd = Cs + dir * 64 * 65;
#pragma unroll 4
    for (int ks = 0; ks < 32; ++ks) {
      const float a = Cd[(et * 32 + r32) * 65 + 2 * ks + hi];
      const float bq = Qt[t * 65 + 2 * ks + hi];
      ac = __builtin_amdgcn_mfma_f32_32x32x2f32(a, bq, ac, 0, 0, 0);
    }
#pragma unroll
    for (int r = 0; r < 16; ++r) HB[dir * 64 * 65 + t * 65 + et * 32 + crow(r, hi)] = (an[r] + iw * ac[r]) * rden;
  }
  __syncthreads();
  {
    const int t = tid >> 3, e8 = (tid & 7) * 8;
    float v[8]; float ss = 0.f;
#pragma unroll
    for (int i = 0; i < 8; ++i) { v[i] = HB[t * 65 + e8 + i] + HB[64 * 65 + t * 65 + e8 + i]; ss += v[i] * v[i]; }
    ss += __shfl_xor(ss, 1); ss += __shfl_xor(ss, 2); ss += __shfl_xor(ss, 4);
    const float rs = rsqrtf(ss * (1.f / 64.f) + EPS);
    const u32x4 ov = *(const u32x4*)(PROJ + (size_t)(row0 + t) * PW + C_MO + hh * 64 + e8);
    const float og[8] = {bflo(ov.x), bfhi(ov.x), bflo(ov.y), bfhi(ov.y), bflo(ov.z), bfhi(ov.z), bflo(ov.w), bfhi(ov.w)};
    const float* g = p.in[I_MNORMG] + l * 64 + e8;
    float o[8];
#pragma unroll
    for (int i = 0; i < 8; ++i) o[i] = (ABL & 2) ? 0.f : v[i] * rs * g[i] * sigmoidf_(og[i]);
    u32x4 w; w.x = cvtpk(o[0], o[1]); w.y = cvtpk(o[2], o[3]); w.z = cvtpk(o[4], o[5]); w.w = cvtpk(o[6], o[7]);
    *(u32x4*)(MIX + (size_t)(row0 + t) * DM + 256 + hh * 64 + e8) = w;
  }
  __syncthreads();
}


__device__ __forceinline__ void ml_out_unit2(const Params& p, int l, int unit, unsigned char* lds) {
  int tid_ = threadIdx.x; asm volatile("" : "+v"(tid_)); const int tid = tid_, lane = tid & 63, wid = tid >> 6, r32 = lane & 31, hi = lane >> 5;
  unsigned char* Qs = lds; unsigned char* Ks = lds + 64 * MLP; unsigned char* VT = lds + 2 * 64 * MLP; unsigned char* Cs = lds + 3 * 64 * MLP;
  float* Ns = (float*)(lds + 5 * 64 * MLP);
  float* Bq = Ns + 128;
  float* Gs = Bq + 128;
  float* Mi = Gs + 128;
  float* HB = Mi + 64;
  const bf16_t* PROJ = (const bf16_t*)(p.ws + WS_PROJ);
  const float* GT = (const float*)(p.ws + WS_GATES);
  const bf16_t* CST = (const bf16_t*)(p.ws + WS_CST); const float* NST = (const float*)(p.ws + WS_NST); const float* META = (const float*)(p.ws + WS_MLMETA);
  bf16_t* MIX = (bf16_t*)(p.ws + WS_MIX);
  const int b = unit / (4 * NCH), hh = (unit / NCH) & 3, ch = unit % NCH;
  const int row0 = b * SEGL + ch * 64;
  ml_stage_rm(PROJ + (size_t)row0 * PW + C_MQ + hh * 64, PW, Qs, tid);
  ml_stage_rm(PROJ + (size_t)row0 * PW + C_MK + hh * 64, PW, Ks, tid);
  ml_stage_tr(PROJ + (size_t)row0 * PW + C_MV + hh * 64, PW, VT, tid);
#pragma unroll
  for (int dir = 0; dir < 2; ++dir) {
    const int seq = (b * 4 + hh) * 2 + dir, ci = ml_cidx(ch, dir);
    ml_stage_rm(CST + ((size_t)seq * NCH + ci) * 4096, 64, Cs + dir * 64 * MLP, tid);
    if (tid < 64) Ns[dir * 64 + tid] = NST[((size_t)seq * NCH + ci) * 64 + tid];
  }
  if (wid < 2) {
    const int dir = wid;
    const float ig = GT[(size_t)(row0 + lane) * 16 + (2 * dir) * 4 + hh];
    const float lf = logsigmoidf_(GT[(size_t)(row0 + lane) * 16 + (2 * dir + 1) * 4 + hh]);
    float ps = lf;
#pragma unroll
    for (int o = 1; o < 64; o <<= 1) { const float t = __shfl_up(ps, o); if (lane >= o) ps += t; }
    const float tot = __shfl(ps, 63);
    const float bc = dir == 0 ? ps : (tot - ps + lf);
    Bq[dir * 64 + lane] = bc; Gs[dir * 64 + lane] = ig - bc;
    if (lane == 0) { const int seq = (b * 4 + hh) * 2 + dir, ci = ml_cidx(ch, dir); Mi[dir] = META[((size_t)seq * NCH + ci) * 4 + 2]; }
  }
  __syncthreads();
  {
    const int dir = wid >> 2, tt = (wid >> 1) & 1, et = wid & 1;
    const int t = tt * 32 + r32;
    f32x16 sa[2] = {};
    bf16x8 bq[4];
#pragma unroll
    for (int ks = 0; ks < 4; ++ks) {
      bq[ks] = *(const bf16x8*)(Qs + t * MLP + (ks * 16 + hi * 8) * 2);
      const bf16x8 a0 = *(const bf16x8*)(Ks + r32 * MLP + (ks * 16 + hi * 8) * 2), a1 = *(const bf16x8*)(Ks + (32 + r32) * MLP + (ks * 16 + hi * 8) * 2);
      sa[0] = __builtin_amdgcn_mfma_f32_32x32x16_bf16(a0, bq[ks], sa[0], 0, 0, 0);
      sa[1] = __builtin_amdgcn_mfma_f32_32x32x16_bf16(a1, bq[ks], sa[1], 0, 0, 0);
    }
    const float bt = Bq[dir * 64 + t];
    const float inter = bt + Mi[dir];
    float mx = -INFINITY;
    f32x16 dl[2];
#pragma unroll
    for (int st = 0; st < 2; ++st)
#pragma unroll
      for (int r = 0; r < 16; ++r) {
        const int s = st * 32 + crow(r, hi);
        const bool ok = dir == 0 ? (s <= t) : (s >= t);
        const float d = ok ? bt + Gs[dir * 64 + s] : -INFINITY;
        dl[st][r] = d; mx = fmaxf(mx, d);
      }
    mx = fmaxf(mx, __shfl_xor(mx, 32));
    const float mt = fmaxf(inter, mx);
    const float iw = __expf(inter - mt);
    float rsum = 0.f;
#pragma unroll
    for (int st = 0; st < 2; ++st)
#pragma unroll
      for (int r = 0; r < 16; ++r) { const float w = __expf(dl[st][r] - mt); sa[st][r] *= w; rsum += sa[st][r]; }
    rsum += __shfl_xor(rsum, 32);
    float qn = 0.f;
#pragma unroll
    for (int i = 0; i < 4; ++i) {
      const int d0 = hi * 32 + i * 8;
      const u32x4 qa = *(const u32x4*)(Qs + t * MLP + d0 * 2);
      const f32x4 n0 = *(const f32x4*)(Ns + dir * 64 + d0), n1 = *(const f32x4*)(Ns + dir * 64 + d0 + 4);
      qn += bflo(qa.x) * n0.x + bfhi(qa.x) * n0.y + bflo(qa.y) * n0.z + bfhi(qa.y) * n0.w + bflo(qa.z) * n1.x + bfhi(qa.z) * n1.y + bflo(qa.w) * n1.z + bfhi(qa.w) * n1.w;
    }
    qn += __shfl_xor(qn, 32);
    const float den = rsum + iw * qn;
    const float rden = 1.f / fmaxf(fabsf(den), __expf(-mt));
    f32x16 an = {}, ac = {};
#pragma unroll
    for (int st = 0; st < 2; ++st)
#pragma unroll
      for (int k2 = 0; k2 < 2; ++k2) {
        u32x4 bx; bx.x = cvtpk(sa[st][8 * k2 + 0], sa[st][8 * k2 + 1]); bx.y = cvtpk(sa[st][8 * k2 + 2], sa[st][8 * k2 + 3]);
        bx.z = cvtpk(sa[st][8 * k2 + 4], sa[st][8 * k2 + 5]); bx.w = cvtpk(sa[st][8 * k2 + 6], sa[st][8 * k2 + 7]);
        const unsigned char* vrow = VT + (et * 32 + r32) * MLP + (st * 32 + 16 * k2 + 4 * hi) * 2;
        const u32x2 v0 = *(const u32x2*)vrow, v1 = *(const u32x2*)(vrow + 16);
        u32x4 ax; ax.x = v0.x; ax.y = v0.y; ax.z = v1.x; ax.w = v1.y;
        an = __builtin_amdgcn_mfma_f32_32x32x16_bf16(*(const bf16x8*)&ax, *(const bf16x8*)&bx, an, 0, 0, 0);
      }
    const unsigned char* Cd = Cs + dir * 64 * MLP;
#pragma unroll
    for (int ks = 0; ks < 4; ++ks) {
      const bf16x8 a = *(const bf16x8*)(Cd + (et * 32 + r32) * MLP + (ks * 16 + hi * 8) * 2);
      ac = __builtin_amdgcn_mfma_f32_32x32x16_bf16(a, bq[ks], ac, 0, 0, 0);
    }
#pragma unroll
    for (int r = 0; r < 16; ++r) HB[dir * 64 * 65 + t * 65 + et * 32 + crow(r, hi)] = (an[r] + iw * ac[r]) * rden;
  }
  __syncthreads();
  {
    const int t = tid >> 3, e8 = (tid & 7) * 8;
    float v[8]; float ss = 0.f;
#pragma unroll
    for (int i = 0; i < 8; ++i) { v[i] = HB[t * 65 + e8 + i] + HB[64 * 65 + t * 65 + e8 + i]; ss += v[i] * v[i]; }
    ss += __shfl_xor(ss, 1); ss += __shfl_xor(ss, 2); ss += __shfl_xor(ss, 4);
    const float rs = rsqrtf(ss * (1.f / 64.f) + EPS);
    const u32x4 ov = *(const u32x4*)(PROJ + (size_t)(row0 + t) * PW + C_MO + hh * 64 + e8);
    const float og[8] = {bflo(ov.x), bfhi(ov.x), bflo(ov.y), bfhi(ov.y), bflo(ov.z), bfhi(ov.z), bflo(ov.w), bfhi(ov.w)};
    const float* g = p.in[I_MNORMG] + l * 64 + e8;
    float o[8];
#pragma unroll
    for (int i = 0; i < 8; ++i) o[i] = (ABL & 2) ? 0.f : v[i] * rs * g[i] * sigmoidf_(og[i]);
    u32x4 w; w.x = cvtpk(o[0], o[1]); w.y = cvtpk(o[2], o[3]); w.z = cvtpk(o[4], o[5]); w.w = cvtpk(o[6], o[7]);
    *(u32x4*)(MIX + (size_t)(row0 + t) * DM + 256 + hh * 64 + e8) = w;
  }
  __syncthreads();
}

#define KSWZ(row, colB) ((row) * 256 + ((colB) ^ (((row) & 15) << 4)))
#define SBAR() __builtin_amdgcn_sched_barrier(0)
constexpr int ATT_SHM_V = 64 * 128 * 2, ATT_SHM_K = 64 * 128 * 2;
constexpr float ATT_THR = 11.541560327111707f;
__device__ __forceinline__ int v_st(int k, int c) { const int kk = (k & ~0xC) | ((k & 4) << 1) | ((k & 8) >> 1); return ((kk >> 3) * 4 + (c >> 5)) * 512 + ((kk & 7) * 32 + (c & 31)) * 2; }
__device__ __forceinline__ int v_rd_base(int lane) { return ((lane & 3) << 3) | (((lane >> 2) & 3) << 6) | (((lane >> 4) & 1) << 5) | (((lane >> 5) & 1) << 8); }
constexpr int v_rd_off(int d0, int ks, int half) { return d0 * 512 + ks * 4096 + half * 2048; }
template <int OFF> __device__ __forceinline__ s16x4 tr_read(int vb) {
  s16x4 r; asm volatile("ds_read_b64_tr_b16 %0, %1 offset:%2" : "=&v"(r) : "v"(vb), "i"(OFF) : "memory"); return r;
}
template <int D0> __device__ __forceinline__ void pv_one(f32x16& od, int vb, bf16x8 pa0, bf16x8 pa1, bf16x8 pa2, bf16x8 pa3) {
  const s16x4 l0 = tr_read<v_rd_off(D0, 0, 0)>(vb), h0 = tr_read<v_rd_off(D0, 0, 1)>(vb), l1 = tr_read<v_rd_off(D0, 1, 0)>(vb), h1 = tr_read<v_rd_off(D0, 1, 1)>(vb);
  const s16x4 l2 = tr_read<v_rd_off(D0, 2, 0)>(vb), h2 = tr_read<v_rd_off(D0, 2, 1)>(vb), l3 = tr_read<v_rd_off(D0, 3, 0)>(vb), h3 = tr_read<v_rd_off(D0, 3, 1)>(vb);
  asm volatile("s_waitcnt lgkmcnt(0)" ::: "memory"); SBAR();
#define PK(L, H) (bf16x8){L[0], L[1], L[2], L[3], H[0], H[1], H[2], H[3]}
  od = __builtin_amdgcn_mfma_f32_32x32x16_bf16(pa0, PK(l0, h0), od, 0, 0, 0);
  od = __builtin_amdgcn_mfma_f32_32x32x16_bf16(pa1, PK(l1, h1), od, 0, 0, 0);
  od = __builtin_amdgcn_mfma_f32_32x32x16_bf16(pa2, PK(l2, h2), od, 0, 0, 0);
  od = __builtin_amdgcn_mfma_f32_32x32x16_bf16(pa3, PK(l3, h3), od, 0, 0, 0);
#undef PK
}
template <int D0> __device__ __forceinline__ void pv_two(f32x16& oa, f32x16& ob, int vb, bf16x8 a0, bf16x8 a1, bf16x8 a2, bf16x8 a3, bf16x8 b0, bf16x8 b1, bf16x8 b2, bf16x8 b3) {
  const s16x4 l0 = tr_read<v_rd_off(D0, 0, 0)>(vb), h0 = tr_read<v_rd_off(D0, 0, 1)>(vb), l1 = tr_read<v_rd_off(D0, 1, 0)>(vb), h1 = tr_read<v_rd_off(D0, 1, 1)>(vb);
  const s16x4 l2 = tr_read<v_rd_off(D0, 2, 0)>(vb), h2 = tr_read<v_rd_off(D0, 2, 1)>(vb), l3 = tr_read<v_rd_off(D0, 3, 0)>(vb), h3 = tr_read<v_rd_off(D0, 3, 1)>(vb);
  asm volatile("s_waitcnt lgkmcnt(0)" ::: "memory"); SBAR();
#define PK(L, H) (bf16x8){L[0], L[1], L[2], L[3], H[0], H[1], H[2], H[3]}
  const bf16x8 v0 = PK(l0, h0), v1 = PK(l1, h1), v2 = PK(l2, h2), v3 = PK(l3, h3);
  oa = __builtin_amdgcn_mfma_f32_32x32x16_bf16(a0, v0, oa, 0, 0, 0);
  ob = __builtin_amdgcn_mfma_f32_32x32x16_bf16(b0, v0, ob, 0, 0, 0);
  oa = __builtin_amdgcn_mfma_f32_32x32x16_bf16(a1, v1, oa, 0, 0, 0);
  ob = __builtin_amdgcn_mfma_f32_32x32x16_bf16(b1, v1, ob, 0, 0, 0);
  oa = __builtin_amdgcn_mfma_f32_32x32x16_bf16(a2, v2, oa, 0, 0, 0);
  ob = __builtin_amdgcn_mfma_f32_32x32x16_bf16(b2, v2, ob, 0, 0, 0);
  oa = __builtin_amdgcn_mfma_f32_32x32x16_bf16(a3, v3, oa, 0, 0, 0);
  ob = __builtin_amdgcn_mfma_f32_32x32x16_bf16(b3, v3, ob, 0, 0, 0);
#undef PK
}
__device__ __forceinline__ void att_qkt(f32x16& p0, f32x16& p1, const unsigned char* Ks, const unsigned char* Qs, int qrow, int comp, int r32, int hi, float init) {
#pragma unroll
  for (int r = 0; r < 16; ++r) { p0[r] = init; p1[r] = init; }
#pragma unroll
  for (int d0 = 0; d0 < 4; ++d0) {
    const int cb = ((comp * 4 + d0) * 16 + hi * 8) * 2;
    const bf16x8 b0 = *(const bf16x8*)(Ks + KSWZ(r32, cb));
    const bf16x8 b1 = *(const bf16x8*)(Ks + KSWZ(32 + r32, cb));
    const bf16x8 q = *(const bf16x8*)(Qs + KSWZ(qrow, cb));
    p0 = __builtin_amdgcn_mfma_f32_32x32x16_bf16(b0, q, p0, 0, 0, 0);
    p1 = __builtin_amdgcn_mfma_f32_32x32x16_bf16(b1, q, p1, 0, 0, 0);
  }
}
__device__ __forceinline__ void att_softmax(f32x16& p0, f32x16& p1, float& m_reg, float& l_reg, float& alpha, bool first, bf16x8& pa0, bf16x8& pa1, bf16x8& pa2, bf16x8& pa3) {
  float pmax = p0[0];
#pragma unroll
  for (int r = 1; r < 16; ++r) pmax = fmaxf(pmax, p0[r]);
#pragma unroll
  for (int r = 0; r < 16; ++r) pmax = fmaxf(pmax, p1[r]);
  { auto rr = __builtin_amdgcn_permlane32_swap(__float_as_uint(pmax), __float_as_uint(pmax), false, false);
    pmax = fmaxf(__uint_as_float(rr[0]), __uint_as_float(rr[1])); }
  alpha = 1.f;
  if (__builtin_expect(first || !__all(pmax <= ATT_THR), 0)) {
    const float delta = first ? pmax : fmaxf(pmax, 0.f);
    alpha = first ? 0.f : __builtin_amdgcn_exp2f(-delta);
    m_reg = (first ? 0.f : m_reg) + delta;
#pragma unroll
    for (int r = 0; r < 16; ++r) { p0[r] -= delta; p1[r] -= delta; }
  }
#pragma unroll
  for (int r = 0; r < 16; ++r) { p0[r] = __builtin_amdgcn_exp2f(p0[r]); p1[r] = __builtin_amdgcn_exp2f(p1[r]); }
  float ps = 0.f;
#pragma unroll
  for (int r = 0; r < 16; ++r) ps += p0[r];
#pragma unroll
  for (int r = 0; r < 16; ++r) ps += p1[r];
  { auto rr = __builtin_amdgcn_permlane32_swap(__float_as_uint(ps), __float_as_uint(ps), false, false);
    ps = __uint_as_float(rr[0]) + __uint_as_float(rr[1]); }
  l_reg = l_reg * alpha + ps;
#define PK4(P, BASE, OUT) do { unsigned a0 = cvtpk(P[BASE + 0], P[BASE + 1]), a1 = cvtpk(P[BASE + 2], P[BASE + 3]);   \
    unsigned b0 = cvtpk(P[BASE + 4], P[BASE + 5]), b1 = cvtpk(P[BASE + 6], P[BASE + 7]);                              \
    auto r0 = __builtin_amdgcn_permlane32_swap(a0, b0, false, false); auto r1 = __builtin_amdgcn_permlane32_swap(a1, b1, false, false); \
    u32x4 w = {r0[0], r1[0], r0[1], r1[1]}; OUT = *reinterpret_cast<bf16x8*>(&w); } while (0)
  PK4(p0, 0, pa0); PK4(p0, 8, pa1); PK4(p1, 0, pa2); PK4(p1, 8, pa3);
#undef PK4
}
__device__ __forceinline__ void att_unit(const bf16_t* __restrict__ Qb, const bf16_t* __restrict__ Kh, const bf16_t* __restrict__ Vh, bf16_t* __restrict__ Ob,
                                         int nkeys, float lam, const float* __restrict__ ng, float oscale, unsigned char* lds) {
  int tid_ = threadIdx.x; asm volatile("" : "+v"(tid_)); const int tid = tid_, wid = tid >> 6, lane = tid & 63, r32 = lane & 31, hi = lane >> 5;
  unsigned char* V_lds = lds; unsigned char* K_lds = lds + 2 * ATT_SHM_V;
  float* wsl = (float*)(lds + 2 * ATT_SHM_V + 2 * ATT_SHM_K) + wid * 64; float* li_l = wsl; float* al_l = wsl + 32;
  float m0 = 0.f, l0 = 0.f, m1 = 0.f, l1 = 0.f;
  f32x16 o0[4] = {}, o1[4] = {};
  unsigned char* Q_lds = lds + 2 * ATT_SHM_V + 2 * ATT_SHM_K + 2048;
#pragma unroll
  for (int i = 0; i < 8; ++i) { const int id = tid + 512 * i, qrw = id >> 4, ch = id & 15;
    *(bf16x8*)(Q_lds + KSWZ(qrw, ch * 16)) = *(const bf16x8*)(Qb + (size_t)qrw * PW + ch * 8); }
  const int qrow = wid * 32 + r32;
  const int vb0 = (int)(uintptr_t)V_lds + v_rd_base(lane);
  int kso[2], vso[2];
#pragma unroll
  for (int i = 0; i < 2; ++i) {
    const int o16 = tid + 512 * i;
    { const int row = o16 >> 4, cs = (o16 & 15) ^ (row & 15); kso[i] = row * PW + cs * 8; }
    { const int sub = o16 >> 5, r16 = o16 & 31, kk = (sub >> 2) * 8 + (r16 >> 2), k = (kk & ~0xC) | ((kk & 4) << 1) | ((kk & 8) >> 1), c = (sub & 3) * 32 + (r16 & 3) * 8; vso[i] = k * PW + c; }
  }
  const unsigned ldsw = (unsigned)__builtin_amdgcn_readfirstlane(wid) * 1024u;
#define GSTAGE(b, k0) do { _Pragma("unroll") for (int i_ = 0; i_ < 2; ++i_) { \
    __builtin_amdgcn_global_load_lds((const unsigned*)(Vh + (size_t)(k0) * PW + vso[i_]), (LAS unsigned*)(V_lds + (b) * ATT_SHM_V + ldsw + i_ * 8192), 16, 0, 0); \
    __builtin_amdgcn_global_load_lds((const unsigned*)(Kh + (size_t)(k0) * PW + kso[i_]), (LAS unsigned*)(K_lds + (b) * ATT_SHM_K + ldsw + i_ * 8192), 16, 0, 0); } } while (0)
#define RESC(o, a) do { if (__any((a) < 1.f)) { if (hi == 0) al_l[r32] = (a); asm volatile("s_waitcnt lgkmcnt(0)" ::: "memory"); \
    _Pragma("unroll") for (int d = 0; d < 4; ++d) _Pragma("unroll") for (int r = 0; r < 16; ++r) o[d][r] *= al_l[crow(r, hi)]; } } while (0)
  const int NT = nkeys / 64;
  GSTAGE(0, 0); asm volatile("s_waitcnt vmcnt(0)" ::: "memory"); __syncthreads();
  for (int j = 0; j < NT; ++j) {
    const int cur = j & 1;
    if (j + 1 < NT) GSTAGE(cur ^ 1, (j + 1) * 64);
    const unsigned char* Kc = K_lds + cur * ATT_SHM_K; const int vb = vb0 + cur * ATT_SHM_V;
    f32x16 p0, p1, q0, q1; float alphaA, alphaB; bf16x8 pa0, pa1, pa2, pa3, pb0, pb1, pb2, pb3;
    const bool first = (j == 0);
    att_qkt(p0, p1, Kc, Q_lds, qrow, 0, r32, hi, first ? 0.f : -m0);
    att_qkt(q0, q1, Kc, Q_lds, qrow, 1, r32, hi, first ? 0.f : -m1);
    att_softmax(p0, p1, m0, l0, alphaA, first, pa0, pa1, pa2, pa3);
    att_softmax(q0, q1, m1, l1, alphaB, first, pb0, pb1, pb2, pb3);
    RESC(o0, alphaA);
    RESC(o1, alphaB);
    pv_two<0>(o0[0], o1[0], vb, pa0, pa1, pa2, pa3, pb0, pb1, pb2, pb3); pv_two<1>(o0[1], o1[1], vb, pa0, pa1, pa2, pa3, pb0, pb1, pb2, pb3);
    pv_two<2>(o0[2], o1[2], vb, pa0, pa1, pa2, pa3, pb0, pb1, pb2, pb3); pv_two<3>(o0[3], o1[3], vb, pa0, pa1, pa2, pa3, pb0, pb1, pb2, pb3);
    asm volatile("s_waitcnt vmcnt(0)" ::: "memory");
    __syncthreads();
  }
  if (hi == 0) { li_l[r32] = 1.f / l0; al_l[r32] = lam / l1; }
  asm volatile("s_waitcnt lgkmcnt(0)" ::: "memory");
  float ss[16];
#pragma unroll
  for (int r = 0; r < 16; ++r) {
    const float a = li_l[crow(r, hi)], bq = al_l[crow(r, hi)];
    float s = 0.f;
#pragma unroll
    for (int d = 0; d < 4; ++d) { const float v = o0[d][r] * a - o1[d][r] * bq; o0[d][r] = v; s += v * v; }
    s += __shfl_xor(s, 1); s += __shfl_xor(s, 2); s += __shfl_xor(s, 4); s += __shfl_xor(s, 8); s += __shfl_xor(s, 16);
    ss[r] = rsqrtf(s * (1.f / 128.f) + EPS) * oscale;
  }
  bf16_t* Ow = Ob + (size_t)(wid * 32) * DM;
#pragma unroll
  for (int d = 0; d < 4; ++d) {
    const float g = ng[d * 32 + r32];
#pragma unroll
    for (int r = 0; r < 16; ++r) Ow[(size_t)crow(r, hi) * DM + d * 32 + r32] = (ABL & 4) ? (bf16_t)0 : (bf16_t)(cvtpk(o0[d][r] * ss[r] * g, 0.f) & 0xffffu);
  }
  __syncthreads();
#undef GSTAGE
#undef RESC
}

__device__ __forceinline__ float ins16(float (&a)[16], float x) {
#pragma unroll
  for (int i = 0; i < 16; ++i) { const float h = fmaxf(a[i], x); x = fminf(a[i], x); a[i] = h; }
  return x;
}
__device__ __forceinline__ void bsort16(float (&a)[16]) {
#pragma unroll
  for (int k = 2; k <= 16; k <<= 1)
#pragma unroll
    for (int j = k >> 1; j > 0; j >>= 1)
#pragma unroll
      for (int i = 0; i < 16; ++i) {
        const int q = i ^ j;
        if (q > i) {
          const bool desc = ((i & k) == 0);
          const float hi_ = fmaxf(a[i], a[q]), lo_ = fminf(a[i], a[q]);
          a[i] = desc ? hi_ : lo_; a[q] = desc ? lo_ : hi_;
        }
      }
}
__device__ __forceinline__ void bmerge16(float (&a)[16], const float (&b)[16]) {
#pragma unroll
  for (int i = 0; i < 16; ++i) a[i] = fmaxf(a[i], b[15 - i]);
#pragma unroll
  for (int j = 8; j > 0; j >>= 1)
#pragma unroll
    for (int i = 0; i < 16; ++i) {
      const int q = i ^ j;
      if (q > i) { const float hi_ = fmaxf(a[i], a[q]), lo_ = fminf(a[i], a[q]); a[i] = hi_; a[q] = lo_; }
    }
}
__device__ __forceinline__ float gelu_erf(float x) { return 0.5f * x * (1.f + erff(x * 0.70710678118654752440f)); }
#define XB_TMO      128
#define XB_XCNT(j)  (256  + 64 * (j))
#define XB_XSUB(j)  (1280 + 64 * (j))
#define XB_XGEN(j)  (2304 + 64 * (j))
#define XB_TOP      3328
#define XB_TOPGEN   3392
#define XCD_BAR_WORDS 3456
#define XB_SPIN_CAP (1u << 22)
__device__ __forceinline__ unsigned xb_ld(unsigned* p)              { return __hip_atomic_load(p, __ATOMIC_RELAXED, __HIP_MEMORY_SCOPE_AGENT); }
__device__ __forceinline__ unsigned xb_add(unsigned* p, unsigned v) { return __hip_atomic_fetch_add(p, v, __ATOMIC_RELAXED, __HIP_MEMORY_SCOPE_AGENT); }
__device__ __forceinline__ unsigned xb_xcc_id() { return (unsigned)__builtin_amdgcn_s_getreg((3 << 11) | 20) & 0xFu; }
#define XB_SPIN(cond, bar) do { unsigned _sp = 0; while (cond) { __builtin_amdgcn_s_sleep(1); \
    if ((++_sp & 255u) == 0u) { if (xb_ld(&(bar)[XB_TMO])) break; if (_sp > XB_SPIN_CAP) { atomicAdd(&(bar)[XB_TMO], 1u); break; } } } } while (0)
struct XcdBarrier { unsigned* bar; unsigned x; volatile LAS unsigned* st; };
__device__ __forceinline__ XcdBarrier xcd_barrier_post(unsigned* bar, volatile LAS unsigned* st) {
  XcdBarrier b; b.bar = bar; b.x = xb_xcc_id(); b.st = st;
  if (threadIdx.x == 0) (void)xb_add(&bar[XB_XCNT(b.x)], 1u);
  return b;
}
__device__ __forceinline__ void xcd_barrier_complete(unsigned* bar, unsigned x, unsigned& nloc, unsigned& nx) {
  const unsigned G = gridDim.x * gridDim.y * gridDim.z;
  unsigned sum, cnt, mine, sp = 0u;
  for (;;) {
    sum = 0u; cnt = 0u; mine = 0u;
#pragma unroll
    for (unsigned j = 0; j < 16; ++j) { const unsigned c = xb_ld(&bar[XB_XCNT(j)]); sum += c; cnt += (c > 0u) ? 1u : 0u; mine = (j == x) ? c : mine; }
    if (sum == G) break;
    __builtin_amdgcn_s_sleep(1);
    if ((++sp & 255u) == 0u) { if (xb_ld(&bar[XB_TMO])) break; if (sp > XB_SPIN_CAP) { atomicAdd(&bar[XB_TMO], 1u); break; } }
  }
  nloc = mine > 0u ? mine : 1u; nx = cnt > 0u ? cnt : 1u;
}
__device__ __forceinline__ void xcd_barrier(const XcdBarrier& b) {
  asm volatile("s_waitcnt vmcnt(0)" ::: "memory");
  __syncthreads();
  if (threadIdx.x == 0) {
    unsigned* bar = b.bar;
    __builtin_amdgcn_s_waitcnt(0);
    unsigned nloc = b.st[0], nx = b.st[1];
    if (nloc == 0u) { xcd_barrier_complete(bar, b.x, nloc, nx); b.st[0] = nloc; b.st[1] = nx; }
    const unsigned old = xb_add(&bar[XB_XSUB(b.x)], 1u);
    const unsigned gen = old / nloc;
    if (old + 1u == (gen + 1u) * nloc) {
      __builtin_amdgcn_fence(__ATOMIC_RELEASE, "agent");
      asm volatile("s_waitcnt vmcnt(0)" ::: "memory");
      const unsigned og = xb_add(&bar[XB_TOP], 1u);
      const unsigned tg = og / nx;
      if (og + 1u == (tg + 1u) * nx) xb_add(&bar[XB_TOPGEN], 1u);
      else XB_SPIN(xb_ld(&bar[XB_TOPGEN]) == tg, bar);
      __builtin_amdgcn_fence(__ATOMIC_ACQUIRE, "agent");
      xb_add(&bar[XB_XGEN(b.x)], 1u);
      asm volatile("s_waitcnt vmcnt(0)" ::: "memory");
    } else {
      XB_SPIN(xb_ld(&bar[XB_XGEN(b.x)]) == gen, bar);
      __builtin_amdgcn_fence(__ATOMIC_ACQUIRE, "agent");
      asm volatile("s_waitcnt vmcnt(0)" ::: "memory");
    }
  }
  __syncthreads();
}

constexpr size_t RT_STRIDE = (size_t)T * 128 * 4;
__device__ __forceinline__ void route_unit(const Params& p, int l, int unit, unsigned char* lds) {
  int tid_ = threadIdx.x; asm volatile("" : "+v"(tid_)); const int tid = tid_, lane = tid & 63, wid = tid >> 6, r32 = lane & 31, hi = lane >> 5;
  unsigned char* IDX = lds;
  int* UE = (int*)(lds + 8192); float* UG = (float*)(lds + 8192 + 16384); float* US = (float*)(lds + 8192 + 32768);
  int* EIDG = (int*)(p.ws + WS_ULOC); float* GWG = (float*)(p.ws + WS_ULOC + RT_STRIDE); float* SUG = (float*)(p.ws + WS_ULOC + 2 * RT_STRIDE);
  const float* PSC = (const float*)(p.ws + WS_PSC);
  const int row0 = unit * 32;
  const bf16_t* QP = (const bf16_t*)(p.ws + WS_PROJ);
  const bf16_t* KEYS = (const bf16_t*)(p.ws + WS_KEYS) + (size_t)l * 131072;
  for (int rrep = 0; rrep < REP_ROUTE; ++rrep) {
    const int h = wid;
    float top[2][16];
#pragma unroll
    for (int pp = 0; pp < 2; ++pp) {
      const bf16_t* qrow = QP + (size_t)(row0 + r32) * DM + h * 128 + pp * 64 + hi * 8;
      const bf16_t* kb = KEYS + ((size_t)(h * 2 + pp) * 128 + r32) * 64 + hi * 8;
      bf16x8 bq[4];
#pragma unroll
      for (int ks = 0; ks < 4; ++ks) bq[ks] = *(const bf16x8*)(qrow + ks * 16);
      float (&lst)[16] = top[pp];
#pragma unroll
      for (int i = 0; i < 16; ++i) lst[i] = -INFINITY;
#pragma unroll
      for (int nt = 0; nt < 4; ++nt) {
        f32x16 acc = {};
#pragma unroll
        for (int ks = 0; ks < 4; ++ks) {
          const bf16x8 ak = *(const bf16x8*)(kb + (size_t)nt * 32 * 64 + ks * 16);
          acc = __builtin_amdgcn_mfma_f32_32x32x16_bf16(ak, bq[ks], acc, 0, 0, 0);
        }
        float grp[16];
#pragma unroll
        for (int r = 0; r < 16; ++r) grp[r] = __uint_as_float((__float_as_uint(acc[r]) & ~0x7Fu) | (unsigned)(nt * 32 + crow(r, hi)));
        bsort16(grp);
        if (nt == 0) {
#pragma unroll
          for (int i = 0; i < 16; ++i) lst[i] = grp[i];
        } else bmerge16(lst, grp);
        SBAR();
      }
      float oth[16];
#pragma unroll
      for (int i = 0; i < 16; ++i) oth[i] = __shfl_xor(lst[i], 32);
      bmerge16(lst, oth);
      if (hi == 0) {
        unsigned w[4];
#pragma unroll
        for (int i = 0; i < 4; ++i)
          w[i] = (__float_as_uint(lst[4 * i]) & 0x7Fu) | ((__float_as_uint(lst[4 * i + 1]) & 0x7Fu) << 8) | ((__float_as_uint(lst[4 * i + 2]) & 0x7Fu) << 16) | ((__float_as_uint(lst[4 * i + 3]) & 0x7Fu) << 24);
        *(u32x4*)(IDX + ((r32 * 8 + h) * 2 + pp) * 16) = (u32x4){w[0], w[1], w[2], w[3]};
      }
    }
    float best[16];
#define CAND(i, j) __uint_as_float((__float_as_uint(__uint_as_float(__float_as_uint(top[0][i]) & ~0x7Fu) + __uint_as_float(__float_as_uint(top[1][j]) & ~0x7Fu)) & ~0xFFu) | (unsigned)((i) * 16 + (j)))
    {
#pragma unroll
      for (int j = 0; j < 16; ++j) best[j] = CAND(0, j);
      float y[16];
#pragma unroll
      for (int j = 0; j < 8; ++j) { y[j] = CAND(1, j); y[8 + j] = CAND(15 - j, 0); }
#pragma unroll
      for (int jj = 8; jj > 0; jj >>= 1)
#pragma unroll
        for (int i = 0; i < 16; ++i) { const int q = i ^ jj; if (q > i) { const float hi_ = fmaxf(y[i], y[q]), lo_ = fminf(y[i], y[q]); y[i] = hi_; y[q] = lo_; } }
      bmerge16(best, y);
      float x[16];
      x[0] = CAND(2, 0); x[1] = CAND(2, 1); x[2] = CAND(2, 2); x[3] = CAND(2, 3); x[4] = CAND(2, 4);
      x[5] = CAND(3, 0); x[6] = CAND(3, 1); x[7] = CAND(3, 2); x[8] = CAND(3, 3);
      x[9] = CAND(4, 0); x[10] = CAND(4, 1); x[11] = CAND(4, 2);
      x[12] = CAND(5, 0); x[13] = CAND(5, 1); x[14] = CAND(6, 0); x[15] = CAND(6, 1);
      bsort16(x);
      bmerge16(best, x);
      ins16(best, CAND(7, 0)); ins16(best, CAND(7, 1));
    }
#undef CAND
    asm volatile("s_waitcnt lgkmcnt(0)" ::: "memory");
    if (hi == 0) {
      const unsigned char* ib = IDX + ((r32 * 8 + h) * 2) * 16;
      const float mx = __uint_as_float(__float_as_uint(best[0]) & ~0xFFu);
      float w[16]; float sum = 0.f;
#pragma unroll
      for (int k = 0; k < 16; ++k) { w[k] = __expf(__uint_as_float(__float_as_uint(best[k]) & ~0xFFu) - mx); sum += w[k]; }
      const float rsum = 1.f / sum;
      int ee[16]; float su_[16], sv_[16];
#pragma unroll
      for (int k = 0; k < 16; ++k) {
        const unsigned ij = __float_as_uint(best[k]) & 0xFFu;
        ee[k] = (int)ib[ij >> 4] * 128 + (int)ib[16 + (ij & 15)];
      }
#pragma unroll
      for (int k = 0; k < 16; ++k) { su_[k] = PSC[(size_t)l * NEXP + ee[k]]; sv_[k] = PSC[(size_t)(DEPTH + l) * NEXP + ee[k]]; }
#pragma unroll
      for (int k = 0; k < 16; ++k) {
        UE[r32 * 128 + h * 16 + k] = ee[k]; UG[r32 * 128 + h * 16 + k] = w[k] * rsum * sv_[k];
        US[r32 * 128 + h * 16 + k] = su_[k];
      }
    }
  }
  __syncthreads();
#pragma unroll 1
  for (int tt = 0; tt < 4; ++tt) {
    const int t = wid * 4 + tt;
    const int k0 = UE[t * 128 + lane], k1 = UE[t * 128 + 64 + lane];
    const float g0 = UG[t * 128 + lane], g1 = UG[t * 128 + 64 + lane], s0 = US[t * 128 + lane], s1 = US[t * 128 + 64 + lane];
    const int b0 = k0 >> 10, b1 = k1 >> 10;
    int base = 0, pos0 = 0, pos1 = 0;
#pragma unroll
    for (int b = 0; b < 16; ++b) {
      const unsigned long long m0 = __ballot(b0 == b), m1 = __ballot(b1 == b);
      const int c0 = __popcll(m0), c1 = __popcll(m1);
      const unsigned long long lt = (1ull << lane) - 1ull;
      if (b0 == b) pos0 = base + __popcll(m0 & lt);
      if (b1 == b) pos1 = base + c0 + __popcll(m1 & lt);
      base += c0 + c1;
    }
    const size_t ro = (size_t)(row0 + t) * 128;
    EIDG[ro + pos0] = k0; GWG[ro + pos0] = g0; SUG[ro + pos0] = s0;
    EIDG[ro + pos1] = k1; GWG[ro + pos1] = g1; SUG[ro + pos1] = s1;
  }
}
struct TokPref { int e0, e1; float g0, g1, s0, s1; u32x4 hA, hB; };
__device__ __forceinline__ void tok_prefetch(const Params& p, int row, int lane, TokPref& t) {
  const int* EIDG = (const int*)(p.ws + WS_ULOC) + (size_t)row * 128; const float* GWG = (const float*)(p.ws + WS_ULOC + RT_STRIDE) + (size_t)row * 128;
  const float* SUG = (const float*)(p.ws + WS_ULOC + 2 * RT_STRIDE) + (size_t)row * 128;
  const bf16_t* H = (const bf16_t*)(p.ws + WS_H);
  t.e0 = EIDG[lane]; t.e1 = EIDG[64 + lane]; t.g0 = GWG[lane]; t.g1 = GWG[64 + lane]; t.s0 = SUG[lane]; t.s1 = SUG[64 + lane];
  t.hA = *(const u32x4*)(H + (size_t)row * DM + lane * 16); t.hB = *(const u32x4*)(H + (size_t)row * DM + lane * 16 + 8);
}
__device__ __forceinline__ void gather_token(const Params& p, int l, int row, int nextrow, TokPref& tp, unsigned char* lds, int lane, int wid) {
  int* EW = (int*)(lds + wid * 2048); float* GWl = (float*)(lds + wid * 2048 + 512); float* SWl = (float*)(lds + wid * 2048 + 1024);
  const bf16_t* H = (const bf16_t*)(p.ws + WS_H);
  const unsigned char* PUq = p.ws + WS_PU + (size_t)l * NEXP * DM;
  const unsigned char* PVq = p.ws + WS_PV + (size_t)l * NEXP * DM;
  float* XC = (float*)(p.ws + WS_XCUR);
  const float* MOD = (const float*)(p.ws + WS_MOD);
  EW[lane] = tp.e0; EW[64 + lane] = tp.e1; GWl[lane] = tp.g0; GWl[64 + lane] = tp.g1; SWl[lane] = tp.s0; SWl[64 + lane] = tp.s1;
  asm volatile("s_waitcnt lgkmcnt(0)" ::: "memory");
  {
    float hf[16];
    {
      const u32x4 hA = tp.hA, hB = tp.hB;
      hf[0] = bflo(hA.x); hf[1] = bfhi(hA.x); hf[2] = bflo(hA.y); hf[3] = bfhi(hA.y); hf[4] = bflo(hA.z); hf[5] = bfhi(hA.z); hf[6] = bflo(hA.w); hf[7] = bfhi(hA.w);
      hf[8] = bflo(hB.x); hf[9] = bfhi(hB.x); hf[10] = bflo(hB.y); hf[11] = bfhi(hB.y); hf[12] = bflo(hB.z); hf[13] = bfhi(hB.z); hf[14] = bflo(hB.w); hf[15] = bfhi(hB.w);
    }
    if (nextrow >= 0) tok_prefetch(p, nextrow, lane, tp);
    f32x4 xpre[4];
    { const float* xr_ = XC + (size_t)row * DM + lane * 16;
#pragma unroll
      for (int v4 = 0; v4 < 4; ++v4) xpre[v4] = *(const f32x4*)(xr_ + v4 * 4); }
    float acc[16];
    for (int rep = 0; rep < REP_PEER; ++rep) {
#pragma unroll
    for (int i = 0; i < 16; ++i) acc[i] = 0.f;
    u32x4 uq[8];
#pragma unroll
    for (int i = 0; i < 8; ++i) { const int e0 = __builtin_amdgcn_readfirstlane(EW[i]); uq[i] = *(const u32x4*)(PUq + (size_t)e0 * DM + lane * 16); }
    for (int g8 = 0; g8 < 16; ++g8) {
      int eid[8]; float gwt[8]; u32x4 vq[8];
#pragma unroll
      for (int i = 0; i < 8; ++i) {
        eid[i] = __builtin_amdgcn_readfirstlane(EW[g8 * 8 + i]);
        gwt[i] = __uint_as_float(__builtin_amdgcn_readfirstlane(__float_as_uint(GWl[g8 * 8 + i])));
        vq[i] = *(const u32x4*)(PVq + (size_t)eid[i] * DM + lane * 16);
      }
      float d[8];
#pragma unroll
      for (int i = 0; i < 8; ++i) {
        const float su = __uint_as_float(__builtin_amdgcn_readfirstlane(__float_as_uint(SWl[g8 * 8 + i])));
        float a0 = 0.f, a1 = 0.f;
#define DQ(W, K) { const f32x2 lo_ = __builtin_amdgcn_cvt_pk_f32_fp8((int)(W), false), hi_ = __builtin_amdgcn_cvt_pk_f32_fp8((int)(W), true); \
          a0 += lo_.x * hf[K]; a1 += lo_.y * hf[K + 1]; a0 += hi_.x * hf[K + 2]; a1 += hi_.y * hf[K + 3]; }
        DQ(uq[i].x, 0) DQ(uq[i].y, 4) DQ(uq[i].z, 8) DQ(uq[i].w, 12)
#undef DQ
        d[i] = (a0 + a1) * su;
      }
      if (g8 < 15) {
#pragma unroll
        for (int i = 0; i < 8; ++i) { const int e0 = __builtin_amdgcn_readfirstlane(EW[(g8 + 1) * 8 + i]); uq[i] = *(const u32x4*)(PUq + (size_t)e0 * DM + lane * 16); }
      }
      float tot;
      {
        auto s01 = __builtin_amdgcn_permlane32_swap(__float_as_uint(d[0]), __float_as_uint(d[1]), false, false);
        auto s23 = __builtin_amdgcn_permlane32_swap(__float_as_uint(d[2]), __float_as_uint(d[3]), false, false);
        auto s45 = __builtin_amdgcn_permlane32_swap(__float_as_uint(d[4]), __float_as_uint(d[5]), false, false);
        auto s67 = __builtin_amdgcn_permlane32_swap(__float_as_uint(d[6]), __float_as_uint(d[7]), false, false);
        const float q01 = __uint_as_float(s01[0]) + __uint_as_float(s01[1]), q23 = __uint_as_float(s23[0]) + __uint_as_float(s23[1]);
        const float q45 = __uint_as_float(s45[0]) + __uint_as_float(s45[1]), q67 = __uint_as_float(s67[0]) + __uint_as_float(s67[1]);
        auto ta = __builtin_amdgcn_permlane16_swap(__float_as_uint(q01), __float_as_uint(q23), false, false);
        auto tb = __builtin_amdgcn_permlane16_swap(__float_as_uint(q45), __float_as_uint(q67), false, false);
        const float r0123 = __uint_as_float(ta[0]) + __uint_as_float(ta[1]);
        const float r4567 = __uint_as_float(tb[0]) + __uint_as_float(tb[1]);
        const bool b3 = (lane & 8) != 0;
        const float keep = b3 ? r4567 : r0123, send = b3 ? r0123 : r4567;
        float x = keep + __shfl_xor(send, 8);
        x += __shfl_xor(x, 4); x += __shfl_xor(x, 2); x += __shfl_xor(x, 1);
        tot = x;
      }
      float ge;
      {
        const float v = tot, av = fabsf(v), tq = __builtin_amdgcn_rcpf(av * 0.2316418882f + 1.0f);
        float q = tq * 0.5307027145f + (-0.7265760135f); q = q * tq + 0.7107068705f; q = q * tq + (-0.142248368f); q = q * tq + 0.127414796f; q = q * tq;
        const float ex = __builtin_amdgcn_exp2f(v * v * (-0.72134752044f));
        const float m = v * (q * ex), r = v - m;
        ge = v < 0.f ? m : r;
      }
      float c[8];
      c[0] = __uint_as_float(__builtin_amdgcn_readlane(__float_as_uint(ge), 0)) * gwt[0];  c[4] = __uint_as_float(__builtin_amdgcn_readlane(__float_as_uint(ge), 8)) * gwt[4];
      c[2] = __uint_as_float(__builtin_amdgcn_readlane(__float_as_uint(ge), 16)) * gwt[2]; c[6] = __uint_as_float(__builtin_amdgcn_readlane(__float_as_uint(ge), 24)) * gwt[6];
      c[1] = __uint_as_float(__builtin_amdgcn_readlane(__float_as_uint(ge), 32)) * gwt[1]; c[5] = __uint_as_float(__builtin_amdgcn_readlane(__float_as_uint(ge), 40)) * gwt[5];
      c[3] = __uint_as_float(__builtin_amdgcn_readlane(__float_as_uint(ge), 48)) * gwt[3]; c[7] = __uint_as_float(__builtin_amdgcn_readlane(__float_as_uint(ge), 56)) * gwt[7];
#pragma unroll
      for (int i = 0; i < 8; ++i) {
#define AQ(W, K) { const f32x2 lo_ = __builtin_amdgcn_cvt_pk_f32_fp8((int)(W), false), hi_ = __builtin_amdgcn_cvt_pk_f32_fp8((int)(W), true); \
          acc[K] += c[i] * lo_.x; acc[K + 1] += c[i] * lo_.y; acc[K + 2] += c[i] * hi_.x; acc[K + 3] += c[i] * hi_.y; }
        AQ(vq[i].x, 0) AQ(vq[i].y, 4) AQ(vq[i].z, 8) AQ(vq[i].w, 12)
#undef AQ
      }
    }
    }
    SBAR();
    const int mr = mod_row(row);
    const float* g2 = MOD + ((size_t)l * 5 + mr) * 6144 + 5 * 1024;
    float* xr = XC + (size_t)row * DM;
    float xn[16]; float ssq = 0.f;
    if (ABL & 8) {
#pragma unroll
      for (int i = 0; i < 16; ++i) acc[i] = 0.f;
    }
#pragma unroll
    for (int v4 = 0; v4 < 4; ++v4) {
      const int c = lane * 16 + v4 * 4;
      const f32x4 xo = xpre[v4], gg = *(const f32x4*)(g2 + c);
      f32x4 o;
      o.x = xo.x + gg.x * acc[v4 * 4 + 0]; o.y = xo.y + gg.y * acc[v4 * 4 + 1]; o.z = xo.z + gg.z * acc[v4 * 4 + 2]; o.w = xo.w + gg.w * acc[v4 * 4 + 3];
      xn[v4 * 4 + 0] = o.x; xn[v4 * 4 + 1] = o.y; xn[v4 * 4 + 2] = o.z; xn[v4 * 4 + 3] = o.w;
      ssq += (o.x * o.x + o.y * o.y) + (o.z * o.z + o.w * o.w);
      if (l < DEPTH - 1) *(f32x4*)(xr + c) = o;
    }
    const float rs = rsqrtf(wave_sum(ssq) * (1.f / DM) + EPS);
    if (l == DEPTH - 1) {
      const int b = row / SEGL, s = row - b * SEGL;
      float* orow = p.out + ((size_t)(b * SEQ + (s - CTXL))) * DM;
      const float* fg = p.in[I_FINALG];
#pragma unroll
      for (int v4 = 0; v4 < 4; ++v4) {
        const int c = lane * 16 + v4 * 4;
        const f32x4 gg = *(const f32x4*)(fg + c);
        f32x4 o; o.x = xn[v4 * 4 + 0] * rs * gg.x; o.y = xn[v4 * 4 + 1] * rs * gg.y; o.z = xn[v4 * 4 + 2] * rs * gg.z; o.w = xn[v4 * 4 + 3] * rs * gg.w;
        *(f32x4*)(orow + c) = o;
      }
    } else {
      const float* m = MOD + ((size_t)(l + 1) * 5 + mr) * 6144;
      const float* ng = p.in[I_N1G] + (l + 1) * DM;
      bf16_t* hrow = (bf16_t*)(p.ws + WS_H) + (size_t)row * DM;
#pragma unroll
      for (int hh = 0; hh < 2; ++hh) {
        float y[8];
#pragma unroll
        for (int i = 0; i < 8; ++i) { const int c = lane * 16 + hh * 8 + i; y[i] = xn[hh * 8 + i] * rs * ng[c] * (1.f + m[1024 + c]) + m[c]; }
        u32x4 w; w.x = cvtpk(y[0], y[1]); w.y = cvtpk(y[2], y[3]); w.z = cvtpk(y[4], y[5]); w.w = cvtpk(y[6], y[7]);
        *(u32x4*)(hrow + lane * 16 + hh * 8) = w;
      }
    }
  }
}

__device__ __forceinline__ void phase_c1(const Params& p, int l, unsigned char* lds) {
  constexpr int NLOC = NBATCH * 4 * NCH, NCONV = T / 32;
  for (int u = p.bx; u < NLOC + NCONV; u += p.gx) {
    if (u < NLOC) ml_local_unit2(p, l, u, lds);
    else {
      const int cu = u - NLOC;
      if (l == DEPTH - 1 && (cu % (SEGL / 32)) < (CTXL / 32)) continue;
      conv_unit(p, l, cu, lds);
    }
  }
}
__device__ __forceinline__ void phase_c2(const Params& p, int l, unsigned char* lds) {
  ml_scan(p, lds);
  const float* lp = p.in[I_DLAM] + l * 256;
  float s01 = 0.f, s23 = 0.f;
  for (int i = 0; i < 64; ++i) { s01 += lp[i] * lp[64 + i]; s23 += lp[128 + i] * lp[192 + i]; }
  const float lam_init = 0.8f - 0.6f * expf(-0.3f * (float)l);
  const float lam = expf(s01) - expf(s23) + lam_init;
  const bf16_t* PROJ = (const bf16_t*)(p.ws + WS_PROJ);
  bf16_t* MIX = (bf16_t*)(p.ws + WS_MIX);
  const float* ng = p.in[I_DNORMG] + l * 128;
  const int nun = 512 + (l < DEPTH - 1 ? 16 : 0);
  for (int u = p.bx; u < nun; u += p.gx) {
    int bh, qrow, nkeys;
    if (u < 512) { const int xcd = u & 7, i = (u >> 3) & 31, rnd = u >> 8; bh = 2 * xcd + rnd; qrow = CTXL + i * 256; nkeys = SEGL; }
    else { bh = u - 512; qrow = 0; nkeys = CTXL; }
    const int b = bh >> 2, h = bh & 3;
    const size_t tok0 = (size_t)b * SEGL;
    for (int rep = 0; rep < REP_ATT; ++rep)
    att_unit(PROJ + (tok0 + qrow) * PW + C_DQ + h * 128, PROJ + tok0 * PW + C_DK + h * 128, PROJ + tok0 * PW + C_DV + h * 128,
             MIX + (tok0 + qrow) * DM + 512 + h * 128, nkeys, lam, ng, 1.f - lam_init, lds);
  }
}
__device__ __forceinline__ void phase_c3(const Params& p, int l, unsigned char* lds) {
  constexpr int NU = NBATCH * 4 * NCH;
  for (int u = p.bx; u < NU; u += p.gx) {
    if (l == DEPTH - 1 && (u % NCH) < 4) continue;
    ml_out_unit2(p, l, u, lds);
  }
}
__device__ __forceinline__ void phase_route(const Params& p, int l, unsigned char* lds) {
  constexpr int NU = T / 32;
  for (int u = p.bx; u < NU; u += p.gx) {
    if (l == DEPTH - 1 && (u % (SEGL / 32)) < (CTXL / 32)) continue;
    route_unit(p, l, u, lds);
    __syncthreads();
  }
}
__device__ __forceinline__ void phase_gather(const Params& p, int l, unsigned char* lds) {
  int tid_ = threadIdx.x; asm volatile("" : "+v"(tid_)); const int lane = tid_ & 63, wid = tid_ >> 6;
  const int gw = p.bx * 8 + wid, NGW = p.gx * 8;
  const int ntok = (l == DEPTH - 1) ? NBATCH * SEQ : T;
#define TOKROW(ti_) ((l == DEPTH - 1) ? ((ti_) / SEQ) * SEGL + CTXL + ((ti_) % SEQ) : (ti_))
  TokPref tp;
  if (gw < ntok) tok_prefetch(p, TOKROW(gw), lane, tp);
  XcdBarrier xb; xb.bar = p.xbar_words; xb.x = p.xbar_x; xb.st = (volatile LAS unsigned*)((LAS unsigned char*)lds + p.lds_st_off);
  const int nrounds = (ntok + NGW - 1) / NGW;
  for (int r = 0; r < nrounds; ++r) {
    const int ti = gw + r * NGW;
    if (ti < ntok) {
      const int row = TOKROW(ti);
      const int nxt = ti + NGW < ntok ? TOKROW(ti + NGW) : -1;
      gather_token(p, l, row, nxt, tp, lds, lane, wid);
    }
#if GATHER_SYNC
    if (r + 1 < nrounds) { XcdBarrier xb2 = xb; size_t zb_ = 0; asm volatile("" : "+s"(zb_)); xb2.bar = xb.bar + zb_; xb2.x = xb.x + (unsigned)zb_; xcd_barrier(xb2); }
#endif
  }
#undef TOKROW
}

__global__ void __launch_bounds__(512, 2) mk_fwd(KArgs ka) {
  cg::grid_group grid = cg::this_grid();
  extern __shared__ __attribute__((aligned(16))) unsigned char lds[];
  const int lo = ka.ph_lo, hi = ka.ph_hi;
#define IN(k) (lo <= (k) && (k) < hi)
#ifndef PHASEMASK
#define PHASEMASK 0xFFFF
#endif
#define PH(i) ((PHASEMASK >> (i)) & 1)
#define MKP(q) Params q; { size_t z_ = 0; asm volatile("" : "+s"(z_)); \
    q.in = (InTab)((const __attribute__((address_space(4))) char*)__builtin_amdgcn_kernarg_segment_ptr() + z_); \
    q.out = ka.out + z_; q.ws = ka.ws + z_; q.ph_lo = lo; q.ph_hi = hi; q.bx = (int)blockIdx.x + (int)z_; q.gx = (int)gridDim.x + (int)z_; q.xbar_words = xbar.bar + z_; q.xbar_x = xbar.x + (unsigned)z_; q.lds_st_off = (unsigned)(LDS_BYTES - 64); }
#define SEAM(k) do { if (IN(k) && IN((k) + 1)) { if ((k) == 0) grid.sync(); else { XcdBarrier xb_ = xbar; size_t zb_ = 0; asm volatile("" : "+s"(zb_)); xb_.bar = xbar.bar + zb_; xb_.x = xbar.x + (unsigned)zb_; xcd_barrier(xb_); } } } while (0)
  volatile LAS unsigned* xst = (volatile LAS unsigned*)((LAS unsigned char*)lds + (LDS_BYTES - 64));
  if (threadIdx.x < 2) xst[threadIdx.x] = 0u;
  __syncthreads();
  XcdBarrier xbar = xcd_barrier_post((unsigned*)(ka.ws + WS_CTL) + 4096, xst);
  { MKP(p)
    if (PH(0) && IN(0)) for (int rep = 0; rep < REP_MISC; ++rep) { p0_mod(p, lds, (float*)(p.ws + WS_MOD)); p0_convert(p, lds); }
  }
  SEAM(0);
  { MKP(p)
    if (PH(1) && IN(1)) phase_norm(p, 0, 0, true, false);
  }
  SEAM(1);
#define LAYER(LL) { \
    int l = (LL); asm volatile("" : "+s"(l)); \
    const int b = 2 + 9 * (LL); \
    { MKP(q) if (PH(2) && IN(b + 0)) for (int rep = 0; rep < REP_GEMM; ++rep) phase_inproj2(q, l, lds); } \
    SEAM(b + 0); \
    { MKP(q) if (PH(3) && IN(b + 1)) for (int rep = 0; rep < REP_ML; ++rep) phase_c1(q, l, lds); } \
    SEAM(b + 1); \
    { MKP(q) if (PH(4) && IN(b + 2)) phase_c2(q, l, lds); } \
    SEAM(b + 2); \
    { MKP(q) if (PH(5) && IN(b + 3)) for (int rep = 0; rep < REP_ML; ++rep) phase_c3(q, l, lds); } \
    SEAM(b + 3); \
    { MKP(q) if (PH(6) && IN(b + 4)) phase_outproj2(q, l, lds); } \
    SEAM(b + 4); \
    { MKP(q) if (PH(7) && IN(b + 5)) for (int rep = 0; rep < REP_MISC; ++rep) phase_norm(q, l, 1, false, (LL) == DEPTH - 1); } \
    SEAM(b + 5); \
    { MKP(q) if (PH(8) && IN(b + 6)) for (int rep = 0; rep < REP_GEMM; ++rep) phase_peerq2(q, l, lds); } \
    SEAM(b + 6); \
    { MKP(q) if (PH(9) && IN(b + 7)) phase_route(q, l, lds); } \
    SEAM(b + 7); \
    { MKP(q) if (PH(9) && IN(b + 8)) phase_gather(q, l, lds); } \
    SEAM(b + 8); }
  LAYER(0) LAYER(1) LAYER(2) LAYER(3)
#undef LAYER
#undef IN
#undef SEAM
#undef MKP
}

extern "C" void kernel_launch(void* const* d_in, const int* in_sizes, int n_in, void* d_out, int out_size,
                              void* d_ws, size_t ws_size, hipStream_t stream) {
  static int grid = 0;
  if (grid == 0) {
    int dev = 0, cus = 0, per_cu = 0;
    (void)hipGetDevice(&dev);
    (void)hipDeviceGetAttribute(&cus, hipDeviceAttributeMultiprocessorCount, dev);
    (void)hipFuncSetAttribute((const void*)mk_fwd, hipFuncAttributeMaxDynamicSharedMemorySize, LDS_BYTES);
    (void)hipOccupancyMaxActiveBlocksPerMultiprocessor(&per_cu, (const void*)mk_fwd, 512, LDS_BYTES);
    fprintf(stderr, "kernel_launch: cus %d per_cu %d ws %zu (need %zu) n_in %d\n", cus, per_cu, ws_size, (size_t)WS_END, n_in);
    if (ws_size < WS_END || n_in != 23 || per_cu < 1) { fprintf(stderr, "kernel_launch: bad configuration, nothing launched\n"); grid = -1; return; }
    grid = cus;
  }
  if (grid < 0) return;
  (void)hipMemsetAsync((char*)d_ws + WS_CTL, 0, 65536, stream);
  KArgs p{};
  for (int i = 0; i < 23; ++i) p.in[i] = (const float*)d_in[i];
  p.out = (float*)d_out; p.ws = (unsigned char*)d_ws; p.ph_lo = 0; p.ph_hi = 38;
  void* args[] = {&p};
  hipError_t e = hipLaunchCooperativeKernel((const void*)mk_fwd, dim3(grid), dim3(512), args, LDS_BYTES, stream);
  if (e != hipSuccess) fprintf(stderr, "cooperative launch failed: %s (grid %d)\n", hipGetErrorString(e), grid);
}
```

```cpp
#include <hip/hip_runtime.h>
#include <hip/hip_cooperative_groups.h>
#include <cstdio>
#include <cstdint>
namespace cg = cooperative_groups;

constexpr int DM = 1024, NBATCH = 4, SEQ = 8192, CTXL = 256, SEGL = CTXL + SEQ, T = NBATCH * SEGL, DEPTH = 4;
constexpr int IN_W = 3088, PW = 3072;
constexpr int C_A = 0, C_MQ = 512, C_MK = 768, C_MV = 1024, C_MO = 1280, C_DQ = 1536, C_DK = 2048, C_DV = 2560;
constexpr int NCH = SEGL / 64;
constexpr int NEXP = 16384;
constexpr float EPS = 1e-6f;
#ifndef ABL
#define ABL 0
#endif
#ifndef GATHER_SYNC
#define GATHER_SYNC 0
#endif
#ifndef REP_ATT
#define REP_ATT 1
#endif
#ifndef REP_PEER
#define REP_PEER 1
#endif
#ifndef REP_GEMM
#define REP_GEMM 1
#endif
#ifndef REP_ROUTE
#define REP_ROUTE 1
#endif
#ifndef REP_OUTP
#define REP_OUTP 1
#endif
#ifndef REP_ML
#define REP_ML 1
#endif
#ifndef REP_MISC
#define REP_MISC 1
#endif
constexpr float QSCALE = 0.125f * 1.4426950408889634f;

constexpr size_t MiB = 1u << 20;
constexpr size_t WS_CTL = 0, WS_MOD = 1 * MiB, WS_ROPE = 2 * MiB, WS_WG = 4 * MiB, WS_KEYS = 5 * MiB, WS_MLMETA = 6 * MiB,
                 WS_GATES = 7 * MiB, WS_WIN = 10 * MiB, WS_WOUT = 34 * MiB, WS_WQ = 42 * MiB, WS_PU = 50 * MiB, WS_PV = 114 * MiB, WS_PSC = 178 * MiB  ,
                 WS_XCUR = 306 * MiB, WS_H = 438 * MiB, WS_MIX = 504 * MiB, WS_PROJ = 570 * MiB, WS_ULOC = 768 * MiB, WS_END = 836 * MiB;
constexpr int USTRIDE = 4160;

constexpr int LDS_BYTES = 139264;

#define LAS __attribute__((address_space(3)))
typedef unsigned short bf16_t;
typedef short bf16x8 __attribute__((ext_vector_type(8)));
typedef short s16x4 __attribute__((ext_vector_type(4)));
typedef float f32x4 __attribute__((ext_vector_type(4)));
typedef float f32x16 __attribute__((ext_vector_type(16)));
typedef unsigned u32x4 __attribute__((ext_vector_type(4)));
typedef unsigned u32x2 __attribute__((ext_vector_type(2)));
typedef __bf16 bf16x2v __attribute__((ext_vector_type(2)));
typedef float f32x2 __attribute__((ext_vector_type(2)));

struct KArgs {
  const float* in[23];
  float* out;
  unsigned char* ws;
  int ph_lo, ph_hi;
};
typedef const float* const __attribute__((address_space(4))) * InTab;
struct Params {
  InTab in;
  float* out;
  unsigned char* ws;
  int ph_lo, ph_hi;
  int bx, gx;
  unsigned* xbar_words; unsigned xbar_x; unsigned lds_st_off;
};
enum { I_X = 0, I_C, I_CTX, I_CCTX, I_ADAW, I_ADAB, I_N1G, I_N2G, I_WIN, I_CONVW, I_CONVB, I_CLNG, I_CLNB, I_GATEB, I_MNORMG, I_DLAM, I_DNORMG,
       I_WOUT, I_PWQ, I_PKEYS, I_PU, I_PV, I_FINALG };

__device__ __forceinline__ unsigned cvtpk(float lo, float hi) { unsigned r; asm volatile("v_cvt_pk_bf16_f32 %0, %1, %2" : "=v"(r) : "v"(lo), "v"(hi)); return r; }
__device__ __forceinline__ float bflo(unsigned u) { return __uint_as_float(u << 16); }
__device__ __forceinline__ float bfhi(unsigned u) { return __uint_as_float(u & 0xffff0000u); }
__device__ __forceinline__ float bf1(bf16_t u) { return __uint_as_float(((unsigned)u) << 16); }
__device__ __forceinline__ int crow(int r, int hi) { return (r & 3) + 8 * (r >> 2) + 4 * hi; }
__device__ __forceinline__ float wave_sum(float v) {
#pragma unroll
  for (int o = 1; o < 64; o <<= 1) v += __shfl_xor(v, o);
  return v;
}
__device__ __forceinline__ float wave_max(float v) {
#pragma unroll
  for (int o = 1; o < 64; o <<= 1) v = fmaxf(v, __shfl_xor(v, o));
  return v;
}
__device__ __forceinline__ float sigmoidf_(float x) { return 1.f / (1.f + __expf(-x)); }
__device__ __forceinline__ float logsigmoidf_(float x) { return fminf(x, 0.f) - log1pf(__expf(-fabsf(x))); }
__device__ __forceinline__ const float* in_row(const float* x, const float* ctx, int row) {
  const int b = row / SEGL, s = row - b * SEGL;
  return s < CTXL ? ctx + ((size_t)(b * CTXL + s)) * DM : x + ((size_t)(b * SEQ + (s - CTXL))) * DM;
}
__device__ __forceinline__ int mod_row(int row) { const int b = row / SEGL, s = row - b * SEGL; return s < CTXL ? 4 : b; }

__device__ __forceinline__ void p0_mod(const Params& p, unsigned char* lds, float* MOD) {
  float* sil = (float*)lds;
  float* red = (float*)(lds + 20480);
  int tid_ = threadIdx.x; asm volatile("" : "+v"(tid_)); const int tid = tid_, lane = tid & 63, wid = tid >> 6;
  for (int i = tid; i < 5 * 1024; i += 512) {
    const float v = i < 4096 ? p.in[I_C][i] : p.in[I_CCTX][i - 4096];
    sil[i] = v / (1.f + __expf(-v));
  }
  __syncthreads();
  for (int item = p.bx; item < DEPTH * 96; item += p.gx) {
    const int l = item / 96, j0 = (item % 96) * 64;
    const float* W = p.in[I_ADAW] + (size_t)l * DM * 6144 + j0 + lane;
    float a0 = 0.f, a1 = 0.f, a2 = 0.f, a3 = 0.f, a4 = 0.f;
    const int k0 = wid * 128;
#pragma unroll 8
    for (int k = k0; k < k0 + 128; ++k) {
      const float w = W[(size_t)k * 6144];
      a0 += sil[k] * w; a1 += sil[1024 + k] * w; a2 += sil[2048 + k] * w; a3 += sil[3072 + k] * w; a4 += sil[4096 + k] * w;
    }
    red[(wid * 5 + 0) * 64 + lane] = a0; red[(wid * 5 + 1) * 64 + lane] = a1; red[(wid * 5 + 2) * 64 + lane] = a2;
    red[(wid * 5 + 3) * 64 + lane] = a3; red[(wid * 5 + 4) * 64 + lane] = a4;
    __syncthreads();
    if (tid < 320) {
      const int r = tid >> 6;
      float s = 0.f;
#pragma unroll
      for (int w = 0; w < 8; ++w) s += red[(w * 5 + r) * 64 + lane];
      MOD[((size_t)l * 5 + r) * 6144 + j0 + lane] = s + p.in[I_ADAB][l * 6144 + j0 + lane];
    }
    __syncthreads();
  }
}
__device__ __forceinline__ void transpose_item(const float* W, int ldw, int srccol0, bf16_t* WT, int K, int n0, int k0, float* scr, int lane) {
#pragma unroll 8
  for (int i = 0; i < 32; ++i) { const int kk = 2 * i + (lane >> 5); scr[kk * 33 + (lane & 31)] = W[(size_t)(k0 + kk) * ldw + srccol0 + (lane & 31)]; }
  asm volatile("s_waitcnt lgkmcnt(0)" ::: "memory");
  const int c = lane & 7;
#pragma unroll
  for (int j = 0; j < 4; ++j) {
    const int n = (lane >> 3) + 8 * j; const float* s = scr + (8 * c) * 33 + n;
    u32x4 o; o.x = cvtpk(s[0], s[33]); o.y = cvtpk(s[66], s[99]); o.z = cvtpk(s[132], s[165]); o.w = cvtpk(s[198], s[231]);
    *(u32x4*)(WT + (size_t)(n0 + n) * K + k0 + 8 * c) = o;
  }
  asm volatile("s_waitcnt lgkmcnt(0)" ::: "memory");
}
__device__ __forceinline__ void convert_tables(const Params& p, int L, int wv, int nw, int lane) {
  unsigned char* PUq = p.ws + WS_PU; unsigned char* PVq = p.ws + WS_PV; float* PSC = (float*)(p.ws + WS_PSC);
  const int nrows = DEPTH * NEXP;
  for (int r = wv; r < 2 * NEXP; r += nw) {
    const int tb = r >= NEXP, rr = L * NEXP + (tb ? r - NEXP : r);
    const f32x4* srow = (const f32x4*)((tb ? p.in[I_PV] : p.in[I_PU]) + (size_t)rr * DM) + lane * 4;
    f32x4 v[4]; float mx = 0.f;
#pragma unroll
    for (int j = 0; j < 4; ++j) { v[j] = __builtin_nontemporal_load(srow + j); mx = fmaxf(mx, fmaxf(fmaxf(fabsf(v[j].x), fabsf(v[j].y)), fmaxf(fabsf(v[j].z), fabsf(v[j].w)))); }
    mx = wave_max(mx);
    const int eb = (int)((__float_as_uint(mx) >> 23) & 0xFFu);
    int sb = 261 - eb; sb = sb < 1 ? 1 : (sb > 253 ? 253 : sb);
    const float sc = __uint_as_float((unsigned)sb << 23), isc = __uint_as_float((unsigned)(254 - sb) << 23);
    u32x4 o;
    int w;
#define CV4(V, OUT) w = 0; w = __builtin_amdgcn_cvt_pk_fp8_f32(V.x * sc, V.y * sc, w, false); w = __builtin_amdgcn_cvt_pk_fp8_f32(V.z * sc, V.w * sc, w, true); OUT = (unsigned)w
    CV4(v[0], o.x); CV4(v[1], o.y); CV4(v[2], o.z); CV4(v[3], o.w);
#undef CV4
    *(u32x4*)((tb ? PVq : PUq) + (size_t)rr * DM + lane * 16) = o;
    if (lane == 0) PSC[(size_t)tb * nrows + rr] = isc;
  }
}
__device__ __forceinline__ void tail_filler_tables(const Params& p, int L, int nwg) {
  int tid_ = threadIdx.x; asm volatile("" : "+v"(tid_)); const int lane = tid_ & 63, wid = tid_ >> 6;
  const int nextra = nwg % p.gx, first = nextra, nidle = p.gx - nextra;
  if (p.bx < first) return;
  convert_tables(p, L, (p.bx - first) * 8 + wid, nidle * 8, lane);
}
__device__ __forceinline__ void p0_convert(const Params& p, unsigned char* lds) {
  int tid_ = threadIdx.x; asm volatile("" : "+v"(tid_)); const int tid = tid_, lane = tid & 63, wid = tid >> 6;
  const int gw = p.bx * 8 + wid, NGW = p.gx * 8;
  const size_t gt = (size_t)p.bx * 512 + tid, NGT = (size_t)p.gx * 512;
  float* scr = (float*)(lds + 32768) + wid * (64 * 33);
  bf16_t* WIN = (bf16_t*)(p.ws + WS_WIN); bf16_t* WOUT = (bf16_t*)(p.ws + WS_WOUT); bf16_t* WQ = (bf16_t*)(p.ws + WS_WQ);
  constexpr int I_IN = 16 * 96, I_O = 16 * 32, PER_L = I_IN + 2 * I_O;
  for (int it = gw; it < DEPTH * PER_L; it += NGW) {
    const int l = it / PER_L; int r = it % PER_L;
    if (r < I_IN) { const int kb = r / 96, nb = r % 96, n0 = nb * 32; const int src = n0 < 1536 ? n0 : n0 + 16;
      transpose_item(p.in[I_WIN] + (size_t)l * DM * IN_W, IN_W, src, WIN + (size_t)l * PW * DM, DM, n0, kb * 64, scr, lane); continue; }
    r -= I_IN;
    if (r < I_O) { const int kb = r / 32, nb = r % 32;
      transpose_item(p.in[I_WOUT] + (size_t)l * DM * DM, DM, nb * 32, WOUT + (size_t)l * DM * DM, DM, nb * 32, kb * 64, scr, lane); continue; }
    r -= I_O;
    { const int kb = r / 32, nb = r % 32;
      transpose_item(p.in[I_PWQ] + (size_t)l * DM * DM, DM, nb * 32, WQ + (size_t)l * DM * DM, DM, nb * 32, kb * 64, scr, lane); }
  }
  bf16_t* WG = (bf16_t*)(p.ws + WS_WG);
  for (size_t i = gt; i < (size_t)DEPTH * 16 * DM; i += NGT) {
    const int l = (int)(i / (16 * DM)), g = (int)((i / DM) % 16), k = (int)(i % DM);
    WG[i] = (bf16_t)(cvtpk(p.in[I_WIN][(size_t)l * DM * IN_W + (size_t)k * IN_W + 1536 + g], 0.f) & 0xffffu);
  }
  bf16_t* KEYS = (bf16_t*)(p.ws + WS_KEYS);
  for (size_t i = gt; i < (size_t)DEPTH * 131072 / 8; i += NGT) {
    const f32x4 a = ((const f32x4*)p.in[I_PKEYS])[2 * i], b = ((const f32x4*)p.in[I_PKEYS])[2 * i + 1];
    u32x4 o; o.x = cvtpk(a.x, a.y); o.y = cvtpk(a.z, a.w); o.z = cvtpk(b.x, b.y); o.w = cvtpk(b.z, b.w);
    ((u32x4*)KEYS)[i] = o;
  }
  {
    float* RC = (float*)(p.ws + WS_ROPE); float* RS = RC + SEQ * 32;
    for (size_t i = gt; i < (size_t)SEQ * 32; i += NGT) {
      const int pos = (int)(i >> 5), j = (int)(i & 31);
      const int rr = pos >> 6, cc = pos & 63;
      const int jj = j & 15;
      const double e = -(double)jj * 0.83048202372184058696;
      const double fl = __builtin_floor(e); const double f = e - fl;
      const double z = f * 0.69314718055994530942;
      double ez = 1.0 + z * (1.0 + z * (0.5 + z * (1.0 / 6 + z * (1.0 / 24 + z * (1.0 / 120 + z * (1.0 / 720 + z * (1.0 / 5040 + z * (1.0 / 40320 + z * (1.0 / 362880 + z * (1.0 / 3628800 + z * (1.0 / 39916800 + z * (1.0 / 479001600))))))))))));
      const double inv = __builtin_ldexp(ez, (int)fl);
      const float invf = (float)inv;
      const float angf = (float)(j < 16 ? rr : cc) * invf;
      const double ang = (double)angf;
      const double kq = __builtin_rint(ang * 0.63661977236758134308);
      double r = __builtin_fma(-kq, 1.57079632679489655800e+00, ang);
      r = __builtin_fma(-kq, 6.12323399573676603587e-17, r);
      const double r2 = r * r;
      const double sn = r * (1.0 + r2 * (-1.0 / 6 + r2 * (1.0 / 120 + r2 * (-1.0 / 5040 + r2 * (1.0 / 362880 + r2 * (-1.0 / 39916800 + r2 * (1.0 / 6227020800.0)))))));
      const double cs = 1.0 + r2 * (-0.5 + r2 * (1.0 / 24 + r2 * (-1.0 / 720 + r2 * (1.0 / 40320 + r2 * (-1.0 / 3628800 + r2 * (1.0 / 479001600 + r2 * (-1.0 / 87178291200.0)))))));
      const int q = ((int)kq) & 3;
      double co, si;
      if (q == 0) { co = cs; si = sn; } else if (q == 1) { co = -sn; si = cs; } else if (q == 2) { co = -cs; si = -sn; } else { co = sn; si = -cs; }
      RC[i] = (float)co; RS[i] = (float)si;
    }
  }
}

__device__ __forceinline__ void norm_mod_row(const float* xrow, const float* g, const float* sc, const float* sh, bf16_t* orow, int lane) {
  const f32x4* xr = (const f32x4*)xrow + lane;
  f32x4 v[4]; float s = 0.f;
#pragma unroll
  for (int j = 0; j < 4; ++j) { v[j] = xr[64 * j]; s += (v[j].x * v[j].x + v[j].y * v[j].y) + (v[j].z * v[j].z + v[j].w * v[j].w); }
  const float rs = rsqrtf(wave_sum(s) * (1.f / DM) + EPS);
  u32x2* o = (u32x2*)orow + lane;
#pragma unroll
  for (int j = 0; j < 4; ++j) {
    const f32x4 gg = ((const f32x4*)g)[lane + 64 * j], cc = ((const f32x4*)sc)[lane + 64 * j], hh = ((const f32x4*)sh)[lane + 64 * j];
    const float y0 = v[j].x * rs * gg.x * (1.f + cc.x) + hh.x, y1 = v[j].y * rs * gg.y * (1.f + cc.y) + hh.y;
    const float y2 = v[j].z * rs * gg.z * (1.f + cc.z) + hh.z, y3 = v[j].w * rs * gg.w * (1.f + cc.w) + hh.w;
    u32x2 w; w.x = cvtpk(y0, y1); w.y = cvtpk(y2, y3);
    o[64 * j] = w;
  }
}
__device__ __forceinline__ void phase_norm(const Params& p, int l, int which, bool from_input, bool skip_ctx) {
  int tid_ = threadIdx.x; asm volatile("" : "+v"(tid_));
  const int lane = tid_ & 63, wid = tid_ >> 6;
  const int gw = p.bx * 8 + wid, NGW = p.gx * 8;
  const float* MOD = (const float*)(p.ws + WS_MOD);
  const float* XC = (const float*)(p.ws + WS_XCUR);
  bf16_t* H = (bf16_t*)(p.ws + WS_H);
  const float* g = p.in[which ? I_N2G : I_N1G] + l * DM;
  for (int row = gw; row < T; row += NGW) {
    const int mr = mod_row(row);
    if (skip_ctx && mr == 4) continue;
    const float* m = MOD + ((size_t)l * 5 + mr) * 6144 + which * 3072;
    const float* xr = from_input ? in_row(p.in[I_X], p.in[I_CTX], row) : XC + (size_t)row * DM;
    norm_mod_row(xr, g, m + 1024, m, H + (size_t)row * DM, lane);
  }
}

namespace pg8 {
#define PG8_LAS __attribute__((address_space(3)))
typedef unsigned short bf16_t;
typedef short bf16x8 __attribute__((ext_vector_type(8)));
typedef float f32x4 __attribute__((ext_vector_type(4)));
typedef unsigned u32x4 __attribute__((ext_vector_type(4)));
constexpr int BM = 256, BK = 64, HALF = 128, HTB = HALF * BK * 2  , STAGE_BYTES = 8 * HTB, NXCD = 8, WGM = 8;

__host__ __device__ __forceinline__ int lds_byte(int r, int c) { const int st = (r >> 4) * 2 + (c >> 5), rr = r & 15, cc = c & 31, ob = rr * 64 + cc * 2; return st * 1024 + (ob ^ (((ob >> 9) & 1) << 5)); }
__host__ __device__ __forceinline__ void stage_rc(int b, int& R, int& C) { const int st = b / 1024, sb = b % 1024, swz = sb ^ (((sb >> 9) & 1) << 5); R = (st >> 1) * 16 + swz / 64; C = (st & 1) * 32 + (swz % 64) / 2; }
__host__ __device__ __forceinline__ int perm32(int rho) { const int n = rho >> 4, i = rho & 15; return 8 * (i >> 2) + 4 * n + (i & 3); }

struct Unit { int pm, pn; };
struct Gemm { const bf16_t* A; const bf16_t* Bt; int M, N, K; };

struct StaticOrder {
    int nM, nN, nwg, G, c;
    __host__ __device__ void init(int M, int N, int G_, int c_) { nM = M / BM; nN = N / BM; nwg = nM * nN; G = G_; c = c_; }
    __host__ __device__ bool next(int i, Unit& u) const {
        const long L = (long)i * G + c; if (L >= nwg) return false;
        int wgid = (int)L; { const int q = nwg / NXCD, r = nwg % NXCD, xcd = wgid % NXCD, off = wgid / NXCD; wgid = (xcd < r ? xcd * (q + 1) : r * (q + 1) + (xcd - r) * q) + off; }
        const int nig = WGM * nN, gid = wgid / nig, fm = gid * WGM, gsz = (nM - fm) < WGM ? (nM - fm) : WGM;
        u.pm = fm + ((wgid % nig) % gsz); u.pn = (wgid % nig) / gsz; return true;
    }
    __device__ __forceinline__ void a_ready(const Unit&) const {}
    __device__ __forceinline__ void done(const Unit&) const {}
};
__device__ __forceinline__ unsigned cvt_pk_bf16(float lo, float hi) { unsigned r; asm volatile("v_cvt_pk_bf16_f32 %0, %1, %2" : "=v"(r) : "v"(lo), "v"(hi)); return r; }
template <class Epi, class Sched, bool ALIGN_EPI = false, bool SP2 = false>
__device__ __forceinline__ void gemm_phase(PG8_LAS unsigned char* lds, const Gemm g, const Sched& S, const Epi& E) {
    const int tid = threadIdx.x, wid = __builtin_amdgcn_readfirstlane(tid >> 6), lane = tid & 63, wr = wid >> 2, wc = wid & 3, fr = lane & 15, fq = lane >> 4;
    const int K = g.K, nt = K / BK;
    unsigned voffA[2], voffB[2];
#pragma unroll
    for (int i = 0; i < 2; ++i) { int R, C; stage_rc(tid * 16 + i * 8192, R, C); const int Rb = Epi::PERM ? ((R & ~31) + perm32(R & 31)) : R;
        voffA[i] = (unsigned)(R * K + C) * 2u; voffB[i] = (unsigned)(Rb * K + C) * 2u; }
    const size_t kstep = (size_t)(BK * 2);
    const size_t hstep = (size_t)HALF * K * 2;
    const size_t tstep = 2 * hstep;
    const unsigned ldsw = (unsigned)wid * 1024u;
    const int aoff = lds_byte(wr * 64 + fr, fq * 8), boff = lds_byte(wc * 32 + fr, fq * 8);
#define PG8_SA(b, h) (((b) * 2 + (h)) * HTB)
#define PG8_SB(b, h) ((4 + (b) * 2 + (h)) * HTB)
#define PG8_STAGE(bufoff, gbase, voff) do { _Pragma("unroll") for (int _i = 0; _i < 2; ++_i) \
        __builtin_amdgcn_global_load_lds((const unsigned*)((const char*)(gbase) + (voff)[_i]), (PG8_LAS unsigned*)(lds + (bufoff) + ldsw + _i * 8192), 16, 0, 0); } while (0)
#define PG8_LDA(dst, b, h) do { _Pragma("unroll") for (int m = 0; m < 4; ++m) _Pragma("unroll") for (int k = 0; k < 2; ++k) dst[m][k] = *(const PG8_LAS bf16x8*)(lds + PG8_SA(b, h) + aoff + m * 2048 + k * 1024); } while (0)
#define PG8_LDB(dst, b, h) do { _Pragma("unroll") for (int n = 0; n < 2; ++n) _Pragma("unroll") for (int k = 0; k < 2; ++k) dst[n][k] = *(const PG8_LAS bf16x8*)(lds + PG8_SB(b, h) + boff + n * 2048 + k * 1024); } while (0)
#define PG8_MMA(ai, bj, At, Bt) do { __builtin_amdgcn_s_setprio(1); _Pragma("unroll") for (int m = 0; m < 4; ++m) _Pragma("unroll") for (int n = 0; n < 2; ++n) _Pragma("unroll") for (int k = 0; k < 2; ++k) \
        acc[ai][bj][m][n] = __builtin_amdgcn_mfma_f32_16x16x32_bf16(Bt[n][k], At[m][k], acc[ai][bj][m][n], 0, 0, 0); __builtin_amdgcn_s_setprio(0); } while (0)
#define PG8_WAIT_V(n) asm volatile("s_waitcnt vmcnt(" #n ")" ::: "memory")
#define PG8_WAIT_L(n) asm volatile("s_waitcnt lgkmcnt(" #n ")" ::: "memory")
#define PG8_BAR __builtin_amdgcn_s_barrier()
#define PG8_SCHED __builtin_amdgcn_sched_barrier(0)
    Unit cur, nxt; int ui = 0;
    if (!S.next(0, cur)) return;
    f32x4 acc[2][2][4][2];
#pragma unroll
    for (int a = 0; a < 2; ++a)
#pragma unroll
        for (int b = 0; b < 2; ++b)
#pragma unroll
            for (int m = 0; m < 4; ++m)
#pragma unroll
                for (int n = 0; n < 2; ++n) acc[a][b][m][n] = (f32x4){0.f, 0.f, 0.f, 0.f};
    bf16x8 At[4][2], B0[2][2], B1[2][2];
    const char* cA = (const char*)g.A + (size_t)cur.pm * tstep; const char* cB = (const char*)g.Bt + (size_t)cur.pn * tstep;
    S.a_ready(cur);
    if constexpr (SP2) {
        PG8_STAGE(PG8_SB(0, 0), cB, voffB); PG8_STAGE(PG8_SB(0, 1), cB + hstep, voffB); PG8_STAGE(PG8_SA(0, 0), cA, voffA); PG8_STAGE(PG8_SA(0, 1), cA + hstep, voffA);
        if (wr == 1) PG8_BAR;
        PG8_WAIT_V(2); PG8_BAR;
        PG8_STAGE(PG8_SB(1, 0), cB + kstep, voffB); PG8_STAGE(PG8_SA(1, 0), cA + kstep, voffA); PG8_STAGE(PG8_SB(1, 1), cB + hstep + kstep, voffB);
        PG8_WAIT_V(6); PG8_BAR;
    } else {
        PG8_STAGE(PG8_SB(0, 0), cB, voffB); PG8_STAGE(PG8_SA(0, 0), cA, voffA); PG8_STAGE(PG8_SB(0, 1), cB + hstep, voffB); PG8_STAGE(PG8_SA(0, 1), cA + hstep, voffA);
        if (wr == 1) PG8_BAR;
        PG8_WAIT_V(4); PG8_BAR;
        PG8_STAGE(PG8_SB(1, 0), cB + kstep, voffB); PG8_STAGE(PG8_SA(1, 0), cA + kstep, voffA); PG8_STAGE(PG8_SB(1, 1), cB + hstep + kstep, voffB);
        PG8_WAIT_V(6); PG8_BAR;
    }
    for (;;) {
        const bool has_next = S.next(ui + 1, nxt);
        const char* nA = has_next ? (const char*)g.A + (size_t)nxt.pm * tstep : cA; const char* nB = has_next ? (const char*)g.Bt + (size_t)nxt.pn * tstep : cB;
        for (int t = 0; t < nt; t += 2) {
            const bool last = (t == nt - 2);
            const char* a1 = cA + (size_t)(t + 1) * kstep;
            const char* a2 = last ? nA : cA + (size_t)(t + 2) * kstep; const char* b2 = last ? nB : cB + (size_t)(t + 2) * kstep;
            const char* a3 = a2 + kstep; const char* b3 = b2 + kstep;
            if (last && has_next) S.a_ready(nxt);
            if constexpr (SP2) {
            PG8_LDB(B0, 0, 0); PG8_LDB(B1, 0, 1); PG8_SCHED; PG8_LDA(At, 0, 0); PG8_STAGE(PG8_SA(1, 1), a1 + hstep, voffA);
            PG8_WAIT_V(8); PG8_WAIT_L(0); PG8_BAR; PG8_MMA(0, 0, At, B0); PG8_MMA(0, 1, At, B1); PG8_BAR; PG8_SCHED;
            PG8_LDA(At, 0, 1); PG8_STAGE(PG8_SB(0, 0), b2, voffB); PG8_STAGE(PG8_SB(0, 1), b2 + hstep, voffB); PG8_STAGE(PG8_SA(0, 0), a2, voffA);
            PG8_WAIT_V(8); PG8_WAIT_L(0); PG8_BAR; PG8_MMA(1, 0, At, B0); PG8_MMA(1, 1, At, B1); PG8_BAR; PG8_SCHED;
            PG8_LDB(B0, 1, 0); PG8_LDB(B1, 1, 1); PG8_SCHED; PG8_LDA(At, 1, 0); PG8_STAGE(PG8_SA(0, 1), a2 + hstep, voffA);
            PG8_WAIT_V(8); PG8_WAIT_L(0); PG8_BAR; PG8_MMA(0, 0, At, B0); PG8_MMA(0, 1, At, B1); PG8_BAR; PG8_SCHED;
            PG8_LDA(At, 1, 1); PG8_STAGE(PG8_SB(1, 0), b3, voffB); PG8_STAGE(PG8_SB(1, 1), b3 + hstep, voffB); PG8_STAGE(PG8_SA(1, 0), a3, voffA);
            PG8_WAIT_V(8); PG8_WAIT_L(0); PG8_BAR; PG8_MMA(1, 0, At, B0); PG8_MMA(1, 1, At, B1); PG8_BAR; PG8_SCHED;
            } else {
            PG8_LDB(B0, 0, 0); PG8_SCHED; PG8_LDA(At, 0, 0); PG8_STAGE(PG8_SA(1, 1), a1 + hstep, voffA);
            PG8_WAIT_L(8); PG8_BAR; PG8_WAIT_L(0); PG8_MMA(0, 0, At, B0); PG8_BAR; PG8_SCHED;
            PG8_LDB(B1, 0, 1); PG8_STAGE(PG8_SB(0, 0), b2, voffB);
            PG8_BAR; PG8_WAIT_L(0); PG8_MMA(0, 1, At, B1); PG8_BAR;
            PG8_LDA(At, 0, 1); PG8_STAGE(PG8_SA(0, 0), a2, voffA);
            PG8_BAR; PG8_WAIT_L(0); PG8_MMA(1, 0, At, B0); PG8_BAR; PG8_SCHED;
            PG8_STAGE(PG8_SB(0, 1), b2 + hstep, voffB);
            PG8_WAIT_V(6); PG8_BAR; PG8_MMA(1, 1, At, B1); PG8_BAR;
            PG8_LDB(B0, 1, 0); PG8_SCHED; PG8_LDA(At, 1, 0); PG8_STAGE(PG8_SA(0, 1), a2 + hstep, voffA);
            PG8_WAIT_L(8); PG8_BAR; PG8_WAIT_L(0); PG8_MMA(0, 0, At, B0); PG8_BAR; PG8_SCHED;
            PG8_LDB(B1, 1, 1); PG8_STAGE(PG8_SB(1, 0), b3, voffB);
            PG8_BAR; PG8_WAIT_L(0); PG8_MMA(0, 1, At, B1); PG8_BAR;
            PG8_LDA(At, 1, 1); PG8_STAGE(PG8_SA(1, 0), a3, voffA);
            PG8_BAR; PG8_WAIT_L(0); PG8_MMA(1, 0, At, B0); PG8_BAR; PG8_SCHED;
            PG8_STAGE(PG8_SB(1, 1), b3 + hstep, voffB);
            PG8_WAIT_V(6); PG8_BAR; PG8_MMA(1, 1, At, B1); PG8_BAR;
            }
        }
        if constexpr (ALIGN_EPI) { if (wr == 0) PG8_BAR; }
        if constexpr (!Epi::AFTER_DRAIN) { E(acc, cur, wr, wc, fr, fq); S.done(cur); }
        if (!has_next) break;
#pragma unroll
        for (int a = 0; a < 2; ++a)
#pragma unroll
            for (int b = 0; b < 2; ++b)
#pragma unroll
                for (int m = 0; m < 4; ++m)
#pragma unroll
                    for (int n = 0; n < 2; ++n) acc[a][b][m][n] = (f32x4){0.f, 0.f, 0.f, 0.f};
        cur = nxt; cA = nA; cB = nB; ++ui;
        if constexpr (ALIGN_EPI) { if (wr == 1) PG8_BAR; }
    }
    PG8_WAIT_V(0);
    if constexpr (!ALIGN_EPI) { if (wr == 0) PG8_BAR; }
    PG8_BAR;
    if constexpr (Epi::AFTER_DRAIN) { E.fused(acc, cur, wr, wc, fr, fq, lds, wid, lane); S.done(cur); }
#undef PG8_SA
#undef PG8_SB
#undef PG8_STAGE
#undef PG8_LDA
#undef PG8_LDB
#undef PG8_MMA
#undef PG8_WAIT_V
#undef PG8_WAIT_L
#undef PG8_BAR
#undef PG8_SCHED
}
}

__device__ __forceinline__ int gswz(int row, int chunk) { return row * 128 + ((chunk ^ ((row >> 1) & 7)) << 4); }
__device__ __forceinline__ void gemm_tile(const bf16_t* __restrict__ A, int lda, const bf16_t* __restrict__ Bt, int ldb, int K,
                                          int row0, int col0, unsigned char* lds, f32x16 (&acc)[2][2]) {
  int tid_ = threadIdx.x; asm volatile("" : "+v"(tid_)); const int tid = tid_, lane = tid & 63, wid = tid >> 6, wm = wid >> 1, wn = wid & 1, r32 = lane & 31, hi = lane >> 5;
  unsigned char* As = lds; unsigned char* Bs = lds + 65536;
#pragma unroll
  for (int i = 0; i < 2; ++i)
#pragma unroll
    for (int j = 0; j < 2; ++j) acc[i][j] = f32x16{};
  const int lrow = tid >> 3, lc = tid & 7;
  const bf16_t* Ag = A + (size_t)(row0 + lrow) * lda + lc * 8;
  const bf16_t* Bg = Bt + (size_t)(col0 + lrow) * ldb + lc * 8;
  u32x4 ra[4], rb[2];
#pragma unroll
  for (int i = 0; i < 4; ++i) ra[i] = *(const u32x4*)(Ag + (size_t)(64 * i) * lda);
#pragma unroll
  for (int i = 0; i < 2; ++i) rb[i] = *(const u32x4*)(Bg + (size_t)(64 * i) * ldb);
#pragma unroll
  for (int i = 0; i < 4; ++i) *(u32x4*)(As + gswz(lrow + 64 * i, lc)) = ra[i];
#pragma unroll
  for (int i = 0; i < 2; ++i) *(u32x4*)(Bs + gswz(lrow + 64 * i, lc)) = rb[i];
  __syncthreads();
  const int nk = K / 64;
  for (int kt = 0; kt < nk; ++kt) {
    const int cur = kt & 1;
    if (kt + 1 < nk) {
#pragma unroll
      for (int i = 0; i < 4; ++i) ra[i] = *(const u32x4*)(Ag + (size_t)(64 * i) * lda + (kt + 1) * 64);
#pragma unroll
      for (int i = 0; i < 2; ++i) rb[i] = *(const u32x4*)(Bg + (size_t)(64 * i) * ldb + (kt + 1) * 64);
    }
    const unsigned char* Ac = As + cur * 32768; const unsigned char* Bc = Bs + cur * 16384;
#pragma unroll
    for (int kk = 0; kk < 4; ++kk) {
      bf16x8 af[2], bfr[2];
#pragma unroll
      for (int i = 0; i < 2; ++i) af[i] = *(const bf16x8*)(Ac + gswz(wm * 64 + i * 32 + r32, 2 * kk + hi));
#pragma unroll
      for (int j = 0; j < 2; ++j) bfr[j] = *(const bf16x8*)(Bc + gswz(wn * 64 + j * 32 + r32, 2 * kk + hi));
#pragma unroll
      for (int i = 0; i < 2; ++i)
#pragma unroll
        for (int j = 0; j < 2; ++j) acc[i][j] = __builtin_amdgcn_mfma_f32_32x32x16_bf16(af[i], bfr[j], acc[i][j], 0, 0, 0);
    }
    if (kt + 1 < nk) {
      unsigned char* An = As + (cur ^ 1) * 32768; unsigned char* Bn = Bs + (cur ^ 1) * 16384;
#pragma unroll
      for (int i = 0; i < 4; ++i) *(u32x4*)(An + gswz(lrow + 64 * i, lc)) = ra[i];
#pragma unroll
      for (int i = 0; i < 2; ++i) *(u32x4*)(Bn + gswz(lrow + 64 * i, lc)) = rb[i];
    }
    __syncthreads();
  }
}
__device__ __forceinline__ void pair_xchg(float v0, float v1, int lane, float& lo, float& hi2) {
  const bool odd = lane & 1;
  const float send = odd ? v0 : v1;
  const float recv = __shfl_xor(send, 1);
  lo = odd ? recv : v0; hi2 = odd ? v1 : recv;
}

__device__ __forceinline__ void phase_inproj(const Params& p, int l, unsigned char* lds) {
  int tid_ = threadIdx.x; asm volatile("" : "+v"(tid_)); const int tid = tid_, lane = tid & 63, wid = tid >> 6, wm = wid >> 1, wn = wid & 1, r32 = lane & 31, hi = lane >> 5;
  const bf16_t* H = (const bf16_t*)(p.ws + WS_H);
  const bf16_t* W = (const bf16_t*)(p.ws + WS_WIN) + (size_t)l * PW * DM;
  bf16_t* PROJ = (bf16_t*)(p.ws + WS_PROJ);
  const float* RC = (const float*)(p.ws + WS_ROPE); const float* RS = RC + SEQ * 32;
  constexpr int NM = T / 256, NN = PW / 128, NU = NM * NN;
  for (int u = p.bx; u < NU + NM; u += p.gx) {
    if (u < NU) {
      const int pn = u / NM, pm = u % NM;
      const int row0 = pm * 256, col0 = pn * 128;
      f32x16 acc[2][2];
      gemm_tile(H, DM, W, DM, DM, row0, col0, lds, acc);
      const bool rope = (col0 >= C_DQ && col0 < C_DV);
      const float scl = (col0 >= C_MK && col0 < C_MV) ? 0.125f : ((col0 >= C_DQ && col0 < C_DK) ? QSCALE : 1.f);
#pragma unroll
      for (int i = 0; i < 2; ++i)
#pragma unroll
        for (int j = 0; j < 2; ++j)
#pragma unroll
          for (int q = 0; q < 8; ++q) {
            float lo, hi2; pair_xchg(acc[i][j][2 * q], acc[i][j][2 * q + 1], lane, lo, hi2);
            const int row = row0 + wm * 64 + i * 32 + crow(2 * q, hi) + (lane & 1);
            const int col = col0 + wn * 64 + j * 32 + (r32 & ~1);
            if (rope) {
              const int s = row % SEGL;
              if (s >= CTXL) {
                const int idx = (s - CTXL) * 32 + ((col & 63) >> 1);
                const float c = RC[idx], sn = RS[idx];
                const float t1 = lo, t2 = hi2; lo = t1 * c - t2 * sn; hi2 = t1 * sn + t2 * c;
              }
            }
            *(unsigned*)(PROJ + (size_t)row * PW + col) = cvtpk(lo * scl, hi2 * scl);
          }
    } else {
      const int pm = u - NU, rowb = pm * 256 + wid * 32;
      const bf16_t* WG = (const bf16_t*)(p.ws + WS_WG) + (size_t)l * 16 * DM;
      float* GT = (float*)(p.ws + WS_GATES);
      const int r16 = lane & 15, q4 = lane >> 4;
      f32x4 c0 = {0.f, 0.f, 0.f, 0.f}, c1 = {0.f, 0.f, 0.f, 0.f};
      const bf16_t* a0p = H + (size_t)(rowb + r16) * DM + q4 * 8;
      const bf16_t* a1p = a0p + (size_t)16 * DM;
      const bf16_t* bp = WG + (size_t)r16 * DM + q4 * 8;
#pragma unroll 4
      for (int ks = 0; ks < 32; ++ks) {
        const bf16x8 a0 = *(const bf16x8*)(a0p + ks * 32), a1 = *(const bf16x8*)(a1p + ks * 32), b = *(const bf16x8*)(bp + ks * 32);
        c0 = __builtin_amdgcn_mfma_f32_16x16x32_bf16(a0, b, c0, 0, 0, 0);
        c1 = __builtin_amdgcn_mfma_f32_16x16x32_bf16(a1, b, c1, 0, 0, 0);
      }
      const float gb = p.in[I_GATEB][l * 16 + r16];
#pragma unroll
      for (int j = 0; j < 4; ++j) {
        GT[(size_t)(rowb + q4 * 4 + j) * 16 + r16] = c0[j] + gb;
        GT[(size_t)(rowb + 16 + q4 * 4 + j) * 16 + r16] = c1[j] + gb;
      }
    }
  }
}

__device__ __forceinline__ void phase_outproj(const Params& p, int l, unsigned char* lds) {
  int tid_ = threadIdx.x; asm volatile("" : "+v"(tid_)); const int tid = tid_, lane = tid & 63, wid = tid >> 6, wm = wid >> 1, wn = wid & 1, r32 = lane & 31, hi = lane >> 5;
  const bf16_t* MIX = (const bf16_t*)(p.ws + WS_MIX);
  const bf16_t* W = (const bf16_t*)(p.ws + WS_WOUT) + (size_t)l * DM * DM;
  float* XC = (float*)(p.ws + WS_XCUR);
  const float* MOD = (const float*)(p.ws + WS_MOD);
  constexpr int NM = T / 256, NN = DM / 128, NU = NM * NN;
  for (int u = p.bx; u < NU; u += p.gx) {
    const int pm = u / NN, pn = u % NN;
    if (l == DEPTH - 1 && (pm % 33) == 0) continue;
    const int row0 = pm * 256, col0 = pn * 128;
    for (int rep = 0; rep < REP_OUTP; ++rep) {
    f32x16 acc[2][2];
    gemm_tile(MIX, DM, W, DM, DM, row0, col0, lds, acc);
    const int mr = (pm % 33) == 0 ? 4 : pm / 33;
    const float* g1 = MOD + ((size_t)l * 5 + mr) * 6144 + 2048;
#pragma unroll
    for (int i = 0; i < 2; ++i)
#pragma unroll
      for (int j = 0; j < 2; ++j) {
        const int col = col0 + wn * 64 + j * 32 + r32;
        const float gg = (rep == REP_OUTP - 1) ? g1[col] : 0.f;
#pragma unroll
        for (int r = 0; r < 16; ++r) {
          const int row = row0 + wm * 64 + i * 32 + crow(r, hi);
          const float xo = (l == 0) ? in_row(p.in[I_X], p.in[I_CTX], row)[col] : XC[(size_t)row * DM + col];
          XC[(size_t)row * DM + col] = xo + gg * acc[i][j][r];
        }
      }
    }
  }
}
__device__ __forceinline__ void phase_peerq(const Params& p, int l, unsigned char* lds) {
  int tid_ = threadIdx.x; asm volatile("" : "+v"(tid_)); const int tid = tid_, lane = tid & 63, wid = tid >> 6, wm = wid >> 1, wn = wid & 1, r32 = lane & 31, hi = lane >> 5;
  const bf16_t* H = (const bf16_t*)(p.ws + WS_H);
  const bf16_t* W = (const bf16_t*)(p.ws + WS_WQ) + (size_t)l * DM * DM;
  bf16_t* QP = (bf16_t*)(p.ws + WS_PROJ);
  constexpr int NM = T / 256, NN = DM / 128, NU = NM * NN;
  for (int u = p.bx; u < NU; u += p.gx) {
    const int pm = u / NN, pn = u % NN;
    if (l == DEPTH - 1 && (pm % 33) == 0) continue;
    const int row0 = pm * 256, col0 = pn * 128;
    f32x16 acc[2][2];
    gemm_tile(H, DM, W, DM, DM, row0, col0, lds, acc);
#pragma unroll
    for (int i = 0; i < 2; ++i)
#pragma unroll
      for (int j = 0; j < 2; ++j)
#pragma unroll
        for (int q = 0; q < 8; ++q) {
          float lo, hi2; pair_xchg(acc[i][j][2 * q], acc[i][j][2 * q + 1], lane, lo, hi2);
          const int row = row0 + wm * 64 + i * 32 + crow(2 * q, hi) + (lane & 1);
          const int col = col0 + wn * 64 + j * 32 + (r32 & ~1);
          *(unsigned*)(QP + (size_t)row * DM + col) = cvtpk(lo, hi2);
        }
  }
}


struct EpiInproj {
  static constexpr bool PERM = true, AFTER_DRAIN = false;
  bf16_t* PROJ; const float* RC; const float* RS;
  __device__ __forceinline__ void operator()(const pg8::f32x4 (&acc)[2][2][4][2], const pg8::Unit& u, int wr, int wc, int fr, int fq) const {
#pragma unroll
    for (int bj = 0; bj < 2; ++bj) {
      const int colt = u.pn * 256 + bj * 128;
      const bool rope = (colt >= C_DQ && colt < C_DV);
      const float scl = (colt >= C_MK && colt < C_MV) ? 0.125f : ((colt >= C_DQ && colt < C_DK) ? QSCALE : 1.f);
      const int col8 = colt + wc * 32 + 8 * fq;
#pragma unroll
      for (int ai = 0; ai < 2; ++ai)
#pragma unroll
        for (int m = 0; m < 4; ++m) {
          const int row = u.pm * 256 + ai * 128 + wr * 64 + m * 16 + fr;
          f32x4 v0 = acc[ai][bj][m][0], v1 = acc[ai][bj][m][1];
          if (rope) {
            const int s = row % SEGL;
            if (s >= CTXL) {
              const int idx = (s - CTXL) * 32 + ((col8 & 63) >> 1);
              const f32x4 c = *(const f32x4*)(RC + idx), sn = *(const f32x4*)(RS + idx);
              f32x4 a, b;
              a[0] = v0[0] * c[0] - v0[1] * sn[0]; a[1] = v0[0] * sn[0] + v0[1] * c[0]; a[2] = v0[2] * c[1] - v0[3] * sn[1]; a[3] = v0[2] * sn[1] + v0[3] * c[1];
              b[0] = v1[0] * c[2] - v1[1] * sn[2]; b[1] = v1[0] * sn[2] + v1[1] * c[2]; b[2] = v1[2] * c[3] - v1[3] * sn[3]; b[3] = v1[2] * sn[3] + v1[3] * c[3];
              v0 = a; v1 = b;
            }
          }
          u32x4 w; w.x = cvtpk(v0[0] * scl, v0[1] * scl); w.y = cvtpk(v0[2] * scl, v0[3] * scl); w.z = cvtpk(v1[0] * scl, v1[1] * scl); w.w = cvtpk(v1[2] * scl, v1[3] * scl);
          *(u32x4*)(PROJ + (size_t)row * PW + col8) = w;
        }
    }
  }
};
struct EpiOutproj {
  static constexpr bool PERM = true, AFTER_DRAIN = false;
  float* XC; const float* MODL; const float* xin; const float* ctxin; int first; float gsc;
  __device__ __forceinline__ void operator()(const pg8::f32x4 (&acc)[2][2][4][2], const pg8::Unit& u, int wr, int wc, int fr, int fq) const {
    const int mr = (u.pm % 33) == 0 ? 4 : u.pm / 33;
    const float* g1 = MODL + (size_t)mr * 6144 + 2048;
#pragma unroll
    for (int bj = 0; bj < 2; ++bj) {
      const int col8 = u.pn * 256 + bj * 128 + wc * 32 + 8 * fq;
      const f32x4 ga = *(const f32x4*)(g1 + col8) * gsc, gb = *(const f32x4*)(g1 + col8 + 4) * gsc;
#pragma unroll
      for (int ai = 0; ai < 2; ++ai)
#pragma unroll
        for (int m = 0; m < 4; ++m) {
          const int row = u.pm * 256 + ai * 128 + wr * 64 + m * 16 + fr;
          const float* xo = first ? in_row(xin, ctxin, row) + col8 : XC + (size_t)row * DM + col8;
          const f32x4 xa = *(const f32x4*)xo, xb = *(const f32x4*)(xo + 4);
          *(f32x4*)(XC + (size_t)row * DM + col8) = xa + ga * acc[ai][bj][m][0];
          *(f32x4*)(XC + (size_t)row * DM + col8 + 4) = xb + gb * acc[ai][bj][m][1];
        }
    }
  }
};
struct EpiPeerq {
  static constexpr bool PERM = true, AFTER_DRAIN = false;
  bf16_t* QP;
  __device__ __forceinline__ void operator()(const pg8::f32x4 (&acc)[2][2][4][2], const pg8::Unit& u, int wr, int wc, int fr, int fq) const {
#pragma unroll
    for (int bj = 0; bj < 2; ++bj) {
      const int col8 = u.pn * 256 + bj * 128 + wc * 32 + 8 * fq;
#pragma unroll
      for (int ai = 0; ai < 2; ++ai)
#pragma unroll
        for (int m = 0; m < 4; ++m) {
          const int row = u.pm * 256 + ai * 128 + wr * 64 + m * 16 + fr;
          const f32x4 v0 = acc[ai][bj][m][0], v1 = acc[ai][bj][m][1];
          u32x4 w; w.x = cvtpk(v0[0], v0[1]); w.y = cvtpk(v0[2], v0[3]); w.z = cvtpk(v1[0], v1[1]); w.w = cvtpk(v1[2], v1[3]);
          *(u32x4*)(QP + (size_t)row * DM + col8) = w;
        }
    }
  }
};
__device__ __forceinline__ void phase_inproj2(const Params& p, int l, unsigned char* lds) {
  {
    pg8::Gemm g{(const bf16_t*)(p.ws + WS_H), (const bf16_t*)(p.ws + WS_WIN) + (size_t)l * PW * DM, T, PW, DM};
    pg8::StaticOrder S; S.init(T, PW, p.gx, p.bx);
    EpiInproj E{(bf16_t*)(p.ws + WS_PROJ), (const float*)(p.ws + WS_ROPE), (const float*)(p.ws + WS_ROPE) + SEQ * 32};
    pg8::gemm_phase<EpiInproj, pg8::StaticOrder, true, true>((PG8_LAS unsigned char*)lds, g, S, E);
  }
  int tid_ = threadIdx.x; asm volatile("" : "+v"(tid_)); const int tid = tid_, lane = tid & 63, wid = tid >> 6;
  const bf16_t* H = (const bf16_t*)(p.ws + WS_H);
  for (int pm = p.bx; pm < T / 256; pm += p.gx) {
    const int rowb = pm * 256 + wid * 32;
    const bf16_t* WG = (const bf16_t*)(p.ws + WS_WG) + (size_t)l * 16 * DM;
    float* GT = (float*)(p.ws + WS_GATES);
    const int r16 = lane & 15, q4 = lane >> 4;
    f32x4 c0 = {0.f, 0.f, 0.f, 0.f}, c1 = {0.f, 0.f, 0.f, 0.f};
    const bf16_t* a0p = H + (size_t)(rowb + r16) * DM + q4 * 8;
    const bf16_t* a1p = a0p + (size_t)16 * DM;
    const bf16_t* bp = WG + (size_t)r16 * DM + q4 * 8;
#pragma unroll 4
    for (int ks = 0; ks < 32; ++ks) {
      const bf16x8 a0 = *(const bf16x8*)(a0p + ks * 32), a1 = *(const bf16x8*)(a1p + ks * 32), b = *(const bf16x8*)(bp + ks * 32);
      c0 = __builtin_amdgcn_mfma_f32_16x16x32_bf16(a0, b, c0, 0, 0, 0);
      c1 = __builtin_amdgcn_mfma_f32_16x16x32_bf16(a1, b, c1, 0, 0, 0);
    }
    const float gb = p.in[I_GATEB][l * 16 + r16];
#pragma unroll
    for (int j = 0; j < 4; ++j) {
      GT[(size_t)(rowb + q4 * 4 + j) * 16 + r16] = c0[j] + gb;
      GT[(size_t)(rowb + 16 + q4 * 4 + j) * 16 + r16] = c1[j] + gb;
    }
  }
}
__device__ __forceinline__ void phase_outproj2(const Params& p, int l, unsigned char* lds) {
  pg8::Gemm g{(const bf16_t*)(p.ws + WS_MIX), (const bf16_t*)(p.ws + WS_WOUT) + (size_t)l * DM * DM, T, DM, DM};
  pg8::StaticOrder S; S.init(T, DM, p.gx, p.bx);
  for (int rep = 0; rep < REP_OUTP; ++rep) {
  EpiOutproj E{(float*)(p.ws + WS_XCUR), (const float*)(p.ws + WS_MOD) + (size_t)l * 5 * 6144, p.in[I_X], p.in[I_CTX], l == 0, (rep == REP_OUTP - 1) ? 1.f : 0.f};
  pg8::gemm_phase<EpiOutproj, pg8::StaticOrder, true, true>((PG8_LAS unsigned char*)lds, g, S, E);
  }
  if (l < DEPTH - 1) tail_filler_tables(p, l, (T / 256) * (DM / 256));
}
__device__ __forceinline__ void phase_peerq2(const Params& p, int l, unsigned char* lds) {
  pg8::Gemm g{(const bf16_t*)(p.ws + WS_H), (const bf16_t*)(p.ws + WS_WQ) + (size_t)l * DM * DM, T, DM, DM};
  pg8::StaticOrder S; S.init(T, DM, p.gx, p.bx);
  EpiPeerq E{(bf16_t*)(p.ws + WS_PROJ)};
  pg8::gemm_phase<EpiPeerq, pg8::StaticOrder, true, true>((PG8_LAS unsigned char*)lds, g, S, E);
  if (l == DEPTH - 2) tail_filler_tables(p, DEPTH - 1, (T / 256) * (DM / 256));
}

__device__ __forceinline__ void conv_unit(const Params& p, int l, int unit, unsigned char* lds) {
  int tid_ = threadIdx.x; asm volatile("" : "+v"(tid_)); const int tid = tid_, lane = tid & 63, wid = tid >> 6;
  float* U = (float*)lds;
  const bf16_t* PROJ = (const bf16_t*)(p.ws + WS_PROJ);
  bf16_t* MIX = (bf16_t*)(p.ws + WS_MIX);
  const int row0 = unit * 32, b = row0 / SEGL, s0 = row0 - b * SEGL;
  const int seglo = s0 < CTXL ? 0 : CTXL, seghi = s0 < CTXL ? CTXL : SEGL;
  for (int rr = tid >> 5; rr < 62; rr += 16) {
    const int s = s0 - 15 + rr, c8 = (tid & 31) * 8;
    f32x4 u0 = {0.f, 0.f, 0.f, 0.f}, u1 = {0.f, 0.f, 0.f, 0.f};
    if (s >= seglo && s < seghi) {
      const bf16_t* pr = PROJ + (size_t)(b * SEGL + s) * PW + c8;
      const u32x4 a1 = *(const u32x4*)pr, a2 = *(const u32x4*)(pr + 256);
      u0.x = bflo(a1.x) * sigmoidf_(bflo(a2.x)); u0.y = bfhi(a1.x) * sigmoidf_(bfhi(a2.x));
      u0.z = bflo(a1.y) * sigmoidf_(bflo(a2.y)); u0.w = bfhi(a1.y) * sigmoidf_(bfhi(a2.y));
      u1.x = bflo(a1.z) * sigmoidf_(bflo(a2.z)); u1.y = bfhi(a1.z) * sigmoidf_(bfhi(a2.z));
      u1.z = bflo(a1.w) * sigmoidf_(bflo(a2.w)); u1.w = bfhi(a1.w) * sigmoidf_(bfhi(a2.w));
    }
    *(f32x4*)(U + rr * 256 + c8) = u0; *(f32x4*)(U + rr * 256 + c8 + 4) = u1;
  }
  __syncthreads();
  float* Y = U + 62 * 256;
  const float* cw = p.in[I_CONVW] + (size_t)l * 31 * 256;
#pragma unroll 1
  for (int q = 0; q < 4; ++q) {
    const int c = lane + 64 * q;
    float w[31];
#pragma unroll
    for (int j = 0; j < 31; ++j) w[j] = cw[j * 256 + c];
    const float bias = p.in[I_CONVB][l * 256 + c];
#pragma unroll
    for (int tt = 0; tt < 4; ++tt) {
      const int t = wid * 4 + tt;
      float a = bias;
#pragma unroll
      for (int j = 0; j < 31; ++j) a += U[(t + j) * 256 + c] * w[j];
      Y[t * 256 + c] = a;
    }
  }
  asm volatile("s_waitcnt lgkmcnt(0)" ::: "memory");
  float y[4][4];
#pragma unroll
  for (int tt = 0; tt < 4; ++tt)
#pragma unroll
    for (int q = 0; q < 4; ++q) y[tt][q] = Y[(wid * 4 + tt) * 256 + lane + 64 * q];
#pragma unroll
  for (int tt = 0; tt < 4; ++tt) {
    const int t = wid * 4 + tt;
    const float mean = wave_sum((y[tt][0] + y[tt][1]) + (y[tt][2] + y[tt][3])) * (1.f / 256.f);
    float v = 0.f;
#pragma unroll
    for (int q = 0; q < 4; ++q) { const float d = y[tt][q] - mean; v += d * d; }
    const float rs = rsqrtf(wave_sum(v) * (1.f / 256.f) + EPS);
#pragma unroll
    for (int q = 0; q < 4; ++q) {
      const int c = lane + 64 * q;
      const float z = (y[tt][q] - mean) * rs * p.in[I_CLNG][l * 256 + c] + p.in[I_CLNB][l * 256 + c];
      const float o = (ABL & 1) ? 0.f : z * sigmoidf_(z);
      MIX[(size_t)(row0 + t) * DM + c] = (bf16_t)(cvtpk(o, 0.f) & 0xffffu);
    }
  }
  __syncthreads();
}

__device__ __forceinline__ int ml_cidx(int ch, int dir) { return dir == 0 ? ch : (ch < 4 ? 3 - ch : 135 - ch); }
__device__ __forceinline__ void ml_load_tile(const bf16_t* src, float* dst, int tid) {
  const int r = tid >> 3, c8 = (tid & 7) * 8;
  const u32x4 a = *(const u32x4*)(src + (size_t)r * PW + c8);
  float* d = dst + r * 65 + c8;
  d[0] = bflo(a.x); d[1] = bfhi(a.x); d[2] = bflo(a.y); d[3] = bfhi(a.y); d[4] = bflo(a.z); d[5] = bfhi(a.z); d[6] = bflo(a.w); d[7] = bfhi(a.w);
}
__device__ __forceinline__ void ml_local_unit(const Params& p, int l, int unit, unsigned char* lds) {
  int tid_ = threadIdx.x; asm volatile("" : "+v"(tid_)); const int tid = tid_, lane = tid & 63, wid = tid >> 6, r32 = lane & 31, hi = lane >> 5;
  float* Kt = (float*)lds; float* Vt = Kt + 64 * 65; float* WK = Vt + 64 * 65;
  const bf16_t* PROJ = (const bf16_t*)(p.ws + WS_PROJ);
  const float* GT = (const float*)(p.ws + WS_GATES);
  float* UL = (float*)(p.ws + WS_ULOC); float* META = (float*)(p.ws + WS_MLMETA);
  const int b = unit / (4 * NCH), hh = (unit / NCH) & 3, ch = unit % NCH;
  const int row0 = b * SEGL + ch * 64;
  ml_load_tile(PROJ + (size_t)row0 * PW + C_MK + hh * 64, Kt, tid);
  ml_load_tile(PROJ + (size_t)row0 * PW + C_MV + hh * 64, Vt, tid);
  if (wid < 2) {
    const int dir = wid;
    const float ig = GT[(size_t)(row0 + lane) * 16 + (2 * dir) * 4 + hh];
    const float lf = logsigmoidf_(GT[(size_t)(row0 + lane) * 16 + (2 * dir + 1) * 4 + hh]);
    float ps = lf;
#pragma unroll
    for (int o = 1; o < 64; o <<= 1) { const float t = __shfl_up(ps, o); if (lane >= o) ps += t; }
    const float tot = __shfl(ps, 63);
    const float wlog = dir == 0 ? (tot - ps + ig) : (ps - lf + ig);
    const float mloc = wave_max(wlog);
    WK[dir * 64 + lane] = __expf(wlog - mloc);
    if (lane == 0) {
      const int seq = (b * 4 + hh) * 2 + dir, ci = ml_cidx(ch, dir);
      META[((size_t)seq * NCH + ci) * 4 + 0] = tot; META[((size_t)seq * NCH + ci) * 4 + 1] = mloc;
    }
  }
  __syncthreads();
  {
    const int dir = wid >> 2, et = (wid >> 1) & 1, dt = wid & 1;
    const int seq = (b * 4 + hh) * 2 + dir, ci = ml_cidx(ch, dir);
    float* slot = UL + ((size_t)seq * NCH + ci) * USTRIDE;
    f32x16 acc = {};
#pragma unroll 8
    for (int ks = 0; ks < 32; ++ks) {
      const int s = 2 * ks + hi;
      const float a = WK[dir * 64 + s] * Vt[s * 65 + et * 32 + r32];
      const float bb = Kt[s * 65 + dt * 32 + r32];
      acc = __builtin_amdgcn_mfma_f32_32x32x2f32(a, bb, acc, 0, 0, 0);
    }
#pragma unroll
    for (int r = 0; r < 16; ++r) slot[(et * 32 + crow(r, hi)) * 64 + dt * 32 + r32] = acc[r];
    if (et == 0) {
      float n = 0.f;
#pragma unroll 8
      for (int i = 0; i < 32; ++i) { const int s = hi * 32 + i; n += WK[dir * 64 + s] * Kt[s * 65 + dt * 32 + r32]; }
      n += __shfl_xor(n, 32);
      if (hi == 0) slot[4096 + dt * 32 + r32] = n;
    }
  }
  __syncthreads();
}
constexpr int MLP = 144;
constexpr size_t WS_CST = WS_H;
constexpr size_t WS_NST = WS_H + (size_t)32 * NCH * 4096 * 2;
__device__ __forceinline__ void ml_stage_rm(const bf16_t* src, size_t ld, unsigned char* dst, int tid) {
  const int r = tid >> 3, c8 = (tid & 7) * 8;
  *(u32x4*)(dst + r * MLP + c8 * 2) = *(const u32x4*)(src + (size_t)r * ld + c8);
}
__device__ __forceinline__ void ml_stage_tr(const bf16_t* src, size_t ld, unsigned char* dst, int tid) {
  const int r = tid >> 3, c8 = (tid & 7) * 8;
  const u32x4 a = *(const u32x4*)(src + (size_t)r * ld + c8);
  bf16_t* d = (bf16_t*)dst;
  d[(c8 + 0) * 72 + r] = (bf16_t)(a.x & 0xffffu); d[(c8 + 1) * 72 + r] = (bf16_t)(a.x >> 16);
  d[(c8 + 2) * 72 + r] = (bf16_t)(a.y & 0xffffu); d[(c8 + 3) * 72 + r] = (bf16_t)(a.y >> 16);
  d[(c8 + 4) * 72 + r] = (bf16_t)(a.z & 0xffffu); d[(c8 + 5) * 72 + r] = (bf16_t)(a.z >> 16);
  d[(c8 + 6) * 72 + r] = (bf16_t)(a.w & 0xffffu); d[(c8 + 7) * 72 + r] = (bf16_t)(a.w >> 16);
}
__device__ __forceinline__ void ml_local_unit2(const Params& p, int l, int unit, unsigned char* lds) {
  int tid_ = threadIdx.x; asm volatile("" : "+v"(tid_)); const int tid = tid_, lane = tid & 63, wid = tid >> 6, r32 = lane & 31, hi = lane >> 5;
  unsigned char* KT = lds; unsigned char* VT = lds + 64 * MLP; float* WK = (float*)(lds + 2 * 64 * MLP);
  const bf16_t* PROJ = (const bf16_t*)(p.ws + WS_PROJ);
  const float* GT = (const float*)(p.ws + WS_GATES);
  float* UL = (float*)(p.ws + WS_ULOC); float* META = (float*)(p.ws + WS_MLMETA);
  const int b = unit / (4 * NCH), hh = (unit / NCH) & 3, ch = unit % NCH;
  const int row0 = b * SEGL + ch * 64;
  ml_stage_tr(PROJ + (size_t)row0 * PW + C_MK + hh * 64, PW, KT, tid);
  ml_stage_tr(PROJ + (size_t)row0 * PW + C_MV + hh * 64, PW, VT, tid);
  if (wid < 2) {
    const int dir = wid;
    const float ig = GT[(size_t)(row0 + lane) * 16 + (2 * dir) * 4 + hh];
    const float lf = logsigmoidf_(GT[(size_t)(row0 + lane) * 16 + (2 * dir + 1) * 4 + hh]);
    float ps = lf;
#pragma unroll
    for (int o = 1; o < 64; o <<= 1) { const float t = __shfl_up(ps, o); if (lane >= o) ps += t; }
    const float tot = __shfl(ps, 63);
    const float wlog = dir == 0 ? (tot - ps + ig) : (ps - lf + ig);
    const float mloc = wave_max(wlog);
    WK[dir * 64 + lane] = __expf(wlog - mloc);
    if (lane == 0) {
      const int seq = (b * 4 + hh) * 2 + dir, ci = ml_cidx(ch, dir);
      META[((size_t)seq * NCH + ci) * 4 + 0] = tot; META[((size_t)seq * NCH + ci) * 4 + 1] = mloc;
    }
  }
  __syncthreads();
  {
    const int dir = wid >> 2, et = (wid >> 1) & 1, dt = wid & 1;
    const int seq = (b * 4 + hh) * 2 + dir, ci = ml_cidx(ch, dir);
    float* slot = UL + ((size_t)seq * NCH + ci) * USTRIDE;
    f32x16 acc = {};
#pragma unroll
    for (int ks = 0; ks < 4; ++ks) {
      const int s0 = ks * 16 + hi * 8;
      const u32x4 va = *(const u32x4*)(VT + (et * 32 + r32) * MLP + s0 * 2);
      const bf16x8 kb = *(const bf16x8*)(KT + (dt * 32 + r32) * MLP + s0 * 2);
      const f32x4 w0 = *(const f32x4*)(WK + dir * 64 + s0), w1 = *(const f32x4*)(WK + dir * 64 + s0 + 4);
      u32x4 sa; sa.x = cvtpk(bflo(va.x) * w0.x, bfhi(va.x) * w0.y); sa.y = cvtpk(bflo(va.y) * w0.z, bfhi(va.y) * w0.w);
      sa.z = cvtpk(bflo(va.z) * w1.x, bfhi(va.z) * w1.y); sa.w = cvtpk(bflo(va.w) * w1.z, bfhi(va.w) * w1.w);
      acc = __builtin_amdgcn_mfma_f32_32x32x16_bf16(*(const bf16x8*)&sa, kb, acc, 0, 0, 0);
    }
#pragma unroll
    for (int r = 0; r < 16; ++r) slot[(et * 32 + crow(r, hi)) * 64 + dt * 32 + r32] = acc[r];
    if (et == 0) {
      float n = 0.f;
#pragma unroll
      for (int i = 0; i < 4; ++i) {
        const int s0 = hi * 32 + i * 8;
        const u32x4 ka = *(const u32x4*)(KT + (dt * 32 + r32) * MLP + s0 * 2);
        const f32x4 w0 = *(const f32x4*)(WK + dir * 64 + s0), w1 = *(const f32x4*)(WK + dir * 64 + s0 + 4);
        n += bflo(ka.x) * w0.x + bfhi(ka.x) * w0.y + bflo(ka.y) * w0.z + bfhi(ka.y) * w0.w + bflo(ka.z) * w1.x + bfhi(ka.z) * w1.y + bflo(ka.w) * w1.z + bfhi(ka.w) * w1.w;
      }
      n += __shfl_xor(n, 32);
      if (hi == 0) slot[4096 + dt * 32 + r32] = n;
    }
  }
  __syncthreads();
}
__device__ __forceinline__ void ml_scan(const Params& p, unsigned char* lds) {
  float* UL = (float*)(p.ws + WS_ULOC); float* META = (float*)(p.ws + WS_MLMETA);
  int tid_ = threadIdx.x; asm volatile("" : "+v"(tid_));
  const int tid = tid_, lane = tid & 63, wid = tid >> 6;
  float* DEC = (float*)lds;
  float* SCL = DEC + 2 * NCH;
  float* TMP = SCL + 2 * NCH;
  for (int base0 = p.bx * 512; base0 < 32 * USTRIDE; base0 += p.gx * 512) {
    const int seq0 = base0 / USTRIDE;
    if (wid < 2) {
      const int seq = seq0 + wid;
      if (seq < 32) {
        float* mt = META + (size_t)seq * NCH * 4;
        for (int c = lane; c < NCH; c += 64) { TMP[(wid * 2 + 0) * NCH + c] = mt[c * 4 + 0]; TMP[(wid * 2 + 1) * NCH + c] = mt[c * 4 + 1]; }
        asm volatile("s_waitcnt lgkmcnt(0)" ::: "memory");
        if (lane == 0) {
          float m = 0.f;
          for (int c = 0; c < NCH; ++c) {
            const float bl = TMP[(wid * 2 + 0) * NCH + c], mloc = TMP[(wid * 2 + 1) * NCH + c];
            const float mn = fmaxf(bl + m, mloc);
            DEC[wid * NCH + c] = __expf(bl + m - mn); SCL[wid * NCH + c] = __expf(mloc - mn);
            mt[c * 4 + 2] = m;
            m = mn;
          }
        }
      }
    }
    __syncthreads();
    const int idx = base0 + tid;
    if (idx < 32 * USTRIDE) {
      const int seq = idx / USTRIDE, e = idx - seq * USTRIDE, sl = seq - seq0;
      float* bp = UL + (size_t)seq * NCH * USTRIDE + e;
      bf16_t* CSTp = (bf16_t*)(p.ws + WS_CST) + (size_t)seq * NCH * 4096 + (e < 4096 ? e : 0);
      float* NSTp = (float*)(p.ws + WS_NST) + (size_t)seq * NCH * 64 + (e < 4096 ? 0 : e - 4096);
      const float* dec = DEC + sl * NCH; const float* scl = SCL + sl * NCH;
      float C = 0.f;
#pragma unroll 1
      for (int c0 = 0; c0 < NCH; c0 += 12) {
        float u[12];
#pragma unroll
        for (int j = 0; j < 12; ++j) u[j] = bp[(size_t)(c0 + j) * USTRIDE];
#pragma unroll
        for (int j = 0; j < 12; ++j) {
          if (e < 4096) CSTp[(size_t)(c0 + j) * 4096] = (bf16_t)(cvtpk(C, 0.f) & 0xffffu); else NSTp[(size_t)(c0 + j) * 64] = C;
          C = dec[c0 + j] * C + scl[c0 + j] * u[j]; }
      }
    }
    __syncthreads();
  }
}
__device__ __forceinline__ void ml_out_unit(const Params& p, int l, int unit, unsigned char* lds) {
  int tid_ = threadIdx.x; asm volatile("" : "+v"(tid_)); const int tid = tid_, lane = tid & 63, wid = tid >> 6, r32 = lane & 31, hi = lane >> 5;
  float* Qt = (float*)lds; float* Kt = Qt + 64 * 65; float* Vt = Kt + 64 * 65;
  float* Cs = Vt + 64 * 65;
  float* Ns = Cs + 2 * 64 * 65;
  float* Bq = Ns + 128;
  float* Gs = Bq + 128;
  float* Mi = Gs + 128;
  float* HB = Mi + 64;
  const bf16_t* PROJ = (const bf16_t*)(p.ws + WS_PROJ);
  const float* GT = (const float*)(p.ws + WS_GATES);
  const float* UL = (const float*)(p.ws + WS_ULOC); const float* META = (const float*)(p.ws + WS_MLMETA);
  bf16_t* MIX = (bf16_t*)(p.ws + WS_MIX);
  const int b = unit / (4 * NCH), hh = (unit / NCH) & 3, ch = unit % NCH;
  const int row0 = b * SEGL + ch * 64;
  ml_load_tile(PROJ + (size_t)row0 * PW + C_MQ + hh * 64, Qt, tid);
  ml_load_tile(PROJ + (size_t)row0 * PW + C_MK + hh * 64, Kt, tid);
  ml_load_tile(PROJ + (size_t)row0 * PW + C_MV + hh * 64, Vt, tid);
  for (int i = tid; i < 2 * USTRIDE; i += 512) {
    const int dir = i / USTRIDE, e = i - dir * USTRIDE;
    const int seq = (b * 4 + hh) * 2 + dir, ci = ml_cidx(ch, dir);
    const float v = UL[((size_t)seq * NCH + ci) * USTRIDE + e];
    if (e < 4096) Cs[dir * 64 * 65 + (e >> 6) * 65 + (e & 63)] = v; else Ns[dir * 64 + (e - 4096)] = v;
  }
  if (wid < 2) {
    const int dir = wid;
    const float ig = GT[(size_t)(row0 + lane) * 16 + (2 * dir) * 4 + hh];
    const float lf = logsigmoidf_(GT[(size_t)(row0 + lane) * 16 + (2 * dir + 1) * 4 + hh]);
    float ps = lf;
#pragma unroll
    for (int o = 1; o < 64; o <<= 1) { const float t = __shfl_up(ps, o); if (lane >= o) ps += t; }
    const float tot = __shfl(ps, 63);
    const float bc = dir == 0 ? ps : (tot - ps + lf);
    Bq[dir * 64 + lane] = bc; Gs[dir * 64 + lane] = ig - bc;
    if (lane == 0) { const int seq = (b * 4 + hh) * 2 + dir, ci = ml_cidx(ch, dir); Mi[dir] = META[((size_t)seq * NCH + ci) * 4 + 2]; }
  }
  __syncthreads();
  {
    const int dir = wid >> 2, tt = (wid >> 1) & 1, et = wid & 1;
    const int t = tt * 32 + r32;
    f32x16 sa[2] = {};
#pragma unroll 4
    for (int ks = 0; ks < 32; ++ks) {
      const float bq = Qt[t * 65 + 2 * ks + hi];
      const float a0 = Kt[(r32) * 65 + 2 * ks + hi], a1 = Kt[(32 + r32) * 65 + 2 * ks + hi];
      sa[0] = __builtin_amdgcn_mfma_f32_32x32x2f32(a0, bq, sa[0], 0, 0, 0);
      sa[1] = __builtin_amdgcn_mfma_f32_32x32x2f32(a1, bq, sa[1], 0, 0, 0);
    }
    const float bt = Bq[dir * 64 + t];
    const float inter = bt + Mi[dir];
    float mx = -INFINITY;
    f32x16 dl[2];
#pragma unroll
    for (int st = 0; st < 2; ++st)
#pragma unroll
      for (int r = 0; r < 16; ++r) {
        const int s = st * 32 + crow(r, hi);
        const bool ok = dir == 0 ? (s <= t) : (s >= t);
        const float d = ok ? bt + Gs[dir * 64 + s] : -INFINITY;
        dl[st][r] = d; mx = fmaxf(mx, d);
      }
    mx = fmaxf(mx, __shfl_xor(mx, 32));
    const float mt = fmaxf(inter, mx);
    const float iw = __expf(inter - mt);
    float rsum = 0.f;
#pragma unroll
    for (int st = 0; st < 2; ++st)
#pragma unroll
      for (int r = 0; r < 16; ++r) { const float w = __expf(dl[st][r] - mt); sa[st][r] *= w; rsum += sa[st][r]; }
    rsum += __shfl_xor(rsum, 32);
    float qn = 0.f;
#pragma unroll 8
    for (int i = 0; i < 32; ++i) { const int d = hi * 32 + i; qn += Ns[dir * 64 + d] * Qt[t * 65 + d]; }
    qn += __shfl_xor(qn, 32);
    const float den = rsum + iw * qn;
    const float rden = 1.f / fmaxf(fabsf(den), __expf(-mt));
    f32x16 an = {}, ac = {};
#pragma unroll
    for (int st = 0; st < 2; ++st)
#pragma unroll
      for (int r = 0; r < 16; ++r) {
        const float a = Vt[(st * 32 + crow(r, hi)) * 65 + et * 32 + r32];
        an = __builtin_amdgcn_mfma_f32_32x32x2f32(a, sa[st][r], an, 0, 0, 0);
      }
    const float* Cd = Cs + dir * 64 * 65;
#pragma unroll 4
    for (int ks = 0; ks < 32; ++ks) {
      const float a = Cd[(et * 32 + r32) * 65 + 2 * ks + hi];
      const float bq = Qt[t * 65 + 2 * ks + hi];
      ac = __builtin_amdgcn_mfma_f32_32x32x2f32(a, bq, ac, 0, 0, 0);
    }
#pragma unroll
    for (int r = 0; r < 16; ++r) HB[dir * 64 * 65 + t * 65 + et * 32 + crow(r, hi)] = (an[r] + iw * ac[r]) * rden;
  }
  __syncthreads();
  {
    const int t = tid >> 3, e8 = (tid & 7) * 8;
    float v[8]; float ss = 0.f;
#pragma unroll
    for (int i = 0; i < 8; ++i) { v[i] = HB[t * 65 + e8 + i] + HB[64 * 65 + t * 65 + e8 + i]; ss += v[i] * v[i]; }
    ss += __shfl_xor(ss, 1); ss += __shfl_xor(ss, 2); ss += __shfl_xor(ss, 4);
    const float rs = rsqrtf(ss * (1.f / 64.f) + EPS);
    const u32x4 ov = *(const u32x4*)(PROJ + (size_t)(row0 + t) * PW + C_MO + hh * 64 + e8);
    const float og[8] = {bflo(ov.x), bfhi(ov.x), bflo(ov.y), bfhi(ov.y), bflo(ov.z), bfhi(ov.z), bflo(ov.w), bfhi(ov.w)};
    const float* g = p.in[I_MNORMG] + l * 64 + e8;
    float o[8];
#pragma unroll
    for (int i = 0; i < 8; ++i) o[i] = (ABL & 2) ? 0.f : v[i] * rs * g[i] * sigmoidf_(og[i]);
    u32x4 w; w.x = cvtpk(o[0], o[1]); w.y = cvtpk(o[2], o[3]); w.z = cvtpk(o[4], o[5]); w.w = cvtpk(o[6], o[7]);
    *(u32x4*)(MIX + (size_t)(row0 + t) * DM + 256 + hh * 64 + e8) = w;
  }
  __syncthreads();
}


__device__ __forceinline__ void ml_out_unit2(const Params& p, int l, int unit, unsigned char* lds) {
  int tid_ = threadIdx.x; asm volatile("" : "+v"(tid_)); const int tid = tid_, lane = tid & 63, wid = tid >> 6, r32 = lane & 31, hi = lane >> 5;
  unsigned char* Qs = lds; unsigned char* Ks = lds + 64 * MLP; unsigned char* VT = lds + 2 * 64 * MLP; unsigned char* Cs = lds + 3 * 64 * MLP;
  float* Ns = (float*)(lds + 5 * 64 * MLP);
  float* Bq = Ns + 128;
  float* Gs = Bq + 128;
  float* Mi = Gs + 128;
  float* HB = Mi + 64;
  const bf16_t* PROJ = (const bf16_t*)(p.ws + WS_PROJ);
  const float* GT = (const float*)(p.ws + WS_GATES);
  const bf16_t* CST = (const bf16_t*)(p.ws + WS_CST); const float* NST = (const float*)(p.ws + WS_NST); const float* META = (const float*)(p.ws + WS_MLMETA);
  bf16_t* MIX = (bf16_t*)(p.ws + WS_MIX);
  const int b = unit / (4 * NCH), hh = (unit / NCH) & 3, ch = unit % NCH;
  const int row0 = b * SEGL + ch * 64;
  ml_stage_rm(PROJ + (size_t)row0 * PW + C_MQ + hh * 64, PW, Qs, tid);
  ml_stage_rm(PROJ + (size_t)row0 * PW + C_MK + hh * 64, PW, Ks, tid);
  ml_stage_tr(PROJ + (size_t)row0 * PW + C_MV + hh * 64, PW, VT, tid);
#pragma unroll
  for (int dir = 0; dir < 2; ++dir) {
    const int seq = (b * 4 + hh) * 2 + dir, ci = ml_cidx(ch, dir);
    ml_stage_rm(CST + ((size_t)seq * NCH + ci) * 4096, 64, Cs + dir * 64 * MLP, tid);
    if (tid < 64) Ns[dir * 64 + tid] = NST[((size_t)seq * NCH + ci) * 64 + tid];
  }
  if (wid < 2) {
    const int dir = wid;
    const float ig = GT[(size_t)(row0 + lane) * 16 + (2 * dir) * 4 + hh];
    const float lf = logsigmoidf_(GT[(size_t)(row0 + lane) * 16 + (2 * dir + 1) * 4 + hh]);
    float ps = lf;
#pragma unroll
    for (int o = 1; o < 64; o <<= 1) { const float t = __shfl_up(ps, o); if (lane >= o) ps += t; }
    const float tot = __shfl(ps, 63);
    const float bc = dir == 0 ? ps : (tot - ps + lf);
    Bq[dir * 64 + lane] = bc; Gs[dir * 64 + lane] = ig - bc;
    if (lane == 0) { const int seq = (b * 4 + hh) * 2 + dir, ci = ml_cidx(ch, dir); Mi[dir] = META[((size_t)seq * NCH + ci) * 4 + 2]; }
  }
  __syncthreads();
  {
    const int dir = wid >> 2, tt = (wid >> 1) & 1, et = wid & 1;
    const int t = tt * 32 + r32;
    f32x16 sa[2] = {};
    bf16x8 bq[4];
#pragma unroll
    for (int ks = 0; ks < 4; ++ks) {
      bq[ks] = *(const bf16x8*)(Qs + t * MLP + (ks * 16 + hi * 8) * 2);
      const bf16x8 a0 = *(const bf16x8*)(Ks + r32 * MLP + (ks * 16 + hi * 8) * 2), a1 = *(const bf16x8*)(Ks + (32 + r32) * MLP + (ks * 16 + hi * 8) * 2);
      sa[0] = __builtin_amdgcn_mfma_f32_32x32x16_bf16(a0, bq[ks], sa[0], 0, 0, 0);
      sa[1] = __builtin_amdgcn_mfma_f32_32x32x16_bf16(a1, bq[ks], sa[1], 0, 0, 0);
    }
    const float bt = Bq[dir * 64 + t];
    const float inter = bt + Mi[dir];
    float mx = -INFINITY;
    f32x16 dl[2];
#pragma unroll
    for (int st = 0; st < 2; ++st)
#pragma unroll
      for (int r = 0; r < 16; ++r) {
        const int s = st * 32 + crow(r, hi);
        const bool ok = dir == 0 ? (s <= t) : (s >= t);
        const float d = ok ? bt + Gs[dir * 64 + s] : -INFINITY;
        dl[st][r] = d; mx = fmaxf(mx, d);
      }
    mx = fmaxf(mx, __shfl_xor(mx, 32));
    const float mt = fmaxf(inter, mx);
    const float iw = __expf(inter - mt);
    float rsum = 0.f;
#pragma unroll
    for (int st = 0; st < 2; ++st)
#pragma unroll
      for (int r = 0; r < 16; ++r) { const float w = __expf(dl[st][r] - mt); sa[st][r] *= w; rsum += sa[st][r]; }
    rsum += __shfl_xor(rsum, 32);
    float qn = 0.f;
#pragma unroll
    for (int i = 0; i < 4; ++i) {
      const int d0 = hi * 32 + i * 8;
      const u32x4 qa = *(const u32x4*)(Qs + t * MLP + d0 * 2);
      const f32x4 n0 = *(const f32x4*)(Ns + dir * 64 + d0), n1 = *(const f32x4*)(Ns + dir * 64 + d0 + 4);
      qn += bflo(qa.x) * n0.x + bfhi(qa.x) * n0.y + bflo(qa.y) * n0.z + bfhi(qa.y) * n0.w + bflo(qa.z) * n1.x + bfhi(qa.z) * n1.y + bflo(qa.w) * n1.z + bfhi(qa.w) * n1.w;
    }
    qn += __shfl_xor(qn, 32);
    const float den = rsum + iw * qn;
    const float rden = 1.f / fmaxf(fabsf(den), __expf(-mt));
    f32x16 an = {}, ac = {};
#pragma unroll
    for (int st = 0; st < 2; ++st)
#pragma unroll
      for (int k2 = 0; k2 < 2; ++k2) {
        u32x4 bx; bx.x = cvtpk(sa[st][8 * k2 + 0], sa[st][8 * k2 + 1]); bx.y = cvtpk(sa[st][8 * k2 + 2], sa[st][8 * k2 + 3]);
        bx.z = cvtpk(sa[st][8 * k2 + 4], sa[st][8 * k2 + 5]); bx.w = cvtpk(sa[st][8 * k2 + 6], sa[st][8 * k2 + 7]);
        const unsigned char* vrow = VT + (et * 32 + r32) * MLP + (st * 32 + 16 * k2 + 4 * hi) * 2;
        const u32x2 v0 = *(const u32x2*)vrow, v1 = *(const u32x2*)(vrow + 16);
        u32x4 ax; ax.x = v0.x; ax.y = v0.y; ax.z = v1.x; ax.w = v1.y;
        an = __builtin_amdgcn_mfma_f32_32x32x16_bf16(*(const bf16x8*)&ax, *(const bf16x8*)&bx, an, 0, 0, 0);
      }
    const unsigned char* Cd = Cs + dir * 64 * MLP;
#pragma unroll
    for (int ks = 0; ks < 4; ++ks) {
      const bf16x8 a = *(const bf16x8*)(Cd + (et * 32 + r32) * MLP + (ks * 16 + hi * 8) * 2);
      ac = __builtin_amdgcn_mfma_f32_32x32x16_bf16(a, bq[ks], ac, 0, 0, 0);
    }
#pragma unroll
    for (int r = 0; r < 16; ++r) HB[dir * 64 * 65 + t * 65 + et * 32 + crow(r, hi)] = (an[r] + iw * ac[r]) * rden;
  }
  __syncthreads();
  {
    const int t = tid >> 3, e8 = (tid & 7) * 8;
    float v[8]; float ss = 0.f;
#pragma unroll
    for (int i = 0; i < 8; ++i) { v[i] = HB[t * 65 + e8 + i] + HB[64 * 65 + t * 65 + e8 + i]; ss += v[i] * v[i]; }
    ss += __shfl_xor(ss, 1); ss += __shfl_xor(ss, 2); ss += __shfl_xor(ss, 4);
    const float rs = rsqrtf(ss * (1.f / 64.f) + EPS);
    const u32x4 ov = *(const u32x4*)(PROJ + (size_t)(row0 + t) * PW + C_MO + hh * 64 + e8);
    const float og[8] = {bflo(ov.x), bfhi(ov.x), bflo(ov.y), bfhi(ov.y), bflo(ov.z), bfhi(ov.z), bflo(ov.w), bfhi(ov.w)};
    const float* g = p.in[I_MNORMG] + l * 64 + e8;
    float o[8];
#pragma unroll
    for (int i = 0; i < 8; ++i) o[i] = (ABL & 2) ? 0.f : v[i] * rs * g[i] * sigmoidf_(og[i]);
    u32x4 w; w.x = cvtpk(o[0], o[1]); w.y = cvtpk(o[2], o[3]); w.z = cvtpk(o[4], o[5]); w.w = cvtpk(o[6], o[7]);
    *(u32x4*)(MIX + (size_t)(row0 + t) * DM + 256 + hh * 64 + e8) = w;
  }
  __syncthreads();
}

#define KSWZ(row, colB) ((row) * 256 + ((colB) ^ (((row) & 15) << 4)))
#define SBAR() __builtin_amdgcn_sched_barrier(0)
constexpr int ATT_SHM_V = 64 * 128 * 2, ATT_SHM_K = 64 * 128 * 2;
constexpr float ATT_THR = 11.541560327111707f;
__device__ __forceinline__ int v_st(int k, int c) { const int kk = (k & ~0xC) | ((k & 4) << 1) | ((k & 8) >> 1); return ((kk >> 3) * 4 + (c >> 5)) * 512 + ((kk & 7) * 32 + (c & 31)) * 2; }
__device__ __forceinline__ int v_rd_base(int lane) { return ((lane & 3) << 3) | (((lane >> 2) & 3) << 6) | (((lane >> 4) & 1) << 5) | (((lane >> 5) & 1) << 8); }
constexpr int v_rd_off(int d0, int ks, int half) { return d0 * 512 + ks * 4096 + half * 2048; }
template <int OFF> __device__ __forceinline__ s16x4 tr_read(int vb) {
  s16x4 r; asm volatile("ds_read_b64_tr_b16 %0, %1 offset:%2" : "=&v"(r) : "v"(vb), "i"(OFF) : "memory"); return r;
}
template <int D0> __device__ __forceinline__ void pv_one(f32x16& od, int vb, bf16x8 pa0, bf16x8 pa1, bf16x8 pa2, bf16x8 pa3) {
  const s16x4 l0 = tr_read<v_rd_off(D0, 0, 0)>(vb), h0 = tr_read<v_rd_off(D0, 0, 1)>(vb), l1 = tr_read<v_rd_off(D0, 1, 0)>(vb), h1 = tr_read<v_rd_off(D0, 1, 1)>(vb);
  const s16x4 l2 = tr_read<v_rd_off(D0, 2, 0)>(vb), h2 = tr_read<v_rd_off(D0, 2, 1)>(vb), l3 = tr_read<v_rd_off(D0, 3, 0)>(vb), h3 = tr_read<v_rd_off(D0, 3, 1)>(vb);
  asm volatile("s_waitcnt lgkmcnt(0)" ::: "memory"); SBAR();
#define PK(L, H) (bf16x8){L[0], L[1], L[2], L[3], H[0], H[1], H[2], H[3]}
  od = __builtin_amdgcn_mfma_f32_32x32x16_bf16(pa0, PK(l0, h0), od, 0, 0, 0);
  od = __builtin_amdgcn_mfma_f32_32x32x16_bf16(pa1, PK(l1, h1), od, 0, 0, 0);
  od = __builtin_amdgcn_mfma_f32_32x32x16_bf16(pa2, PK(l2, h2), od, 0, 0, 0);
  od = __builtin_amdgcn_mfma_f32_32x32x16_bf16(pa3, PK(l3, h3), od, 0, 0, 0);
#undef PK
}
template <int D0> __device__ __forceinline__ void pv_two(f32x16& oa, f32x16& ob, int vb, bf16x8 a0, bf16x8 a1, bf16x8 a2, bf16x8 a3, bf16x8 b0, bf16x8 b1, bf16x8 b2, bf16x8 b3) {
  const s16x4 l0 = tr_read<v_rd_off(D0, 0, 0)>(vb), h0 = tr_read<v_rd_off(D0, 0, 1)>(vb), l1 = tr_read<v_rd_off(D0, 1, 0)>(vb), h1 = tr_read<v_rd_off(D0, 1, 1)>(vb);
  const s16x4 l2 = tr_read<v_rd_off(D0, 2, 0)>(vb), h2 = tr_read<v_rd_off(D0, 2, 1)>(vb), l3 = tr_read<v_rd_off(D0, 3, 0)>(vb), h3 = tr_read<v_rd_off(D0, 3, 1)>(vb);
  asm volatile("s_waitcnt lgkmcnt(0)" ::: "memory"); SBAR();
#define PK(L, H) (bf16x8){L[0], L[1], L[2], L[3], H[0], H[1], H[2], H[3]}
  const bf16x8 v0 = PK(l0, h0), v1 = PK(l1, h1), v2 = PK(l2, h2), v3 = PK(l3, h3);
  oa = __builtin_amdgcn_mfma_f32_32x32x16_bf16(a0, v0, oa, 0, 0, 0);
  ob = __builtin_amdgcn_mfma_f32_32x32x16_bf16(b0, v0, ob, 0, 0, 0);
  oa = __builtin_amdgcn_mfma_f32_32x32x16_bf16(a1, v1, oa, 0, 0, 0);
  ob = __builtin_amdgcn_mfma_f32_32x32x16_bf16(b1, v1, ob, 0, 0, 0);
  oa = __builtin_amdgcn_mfma_f32_32x32x16_bf16(a2, v2, oa, 0, 0, 0);
  ob = __builtin_amdgcn_mfma_f32_32x32x16_bf16(b2, v2, ob, 0, 0, 0);
  oa = __builtin_amdgcn_mfma_f32_32x32x16_bf16(a3, v3, oa, 0, 0, 0);
  ob = __builtin_amdgcn_mfma_f32_32x32x16_bf16(b3, v3, ob, 0, 0, 0);
#undef PK
}
__device__ __forceinline__ void att_qkt(f32x16& p0, f32x16& p1, const unsigned char* Ks, const unsigned char* Qs, int qrow, int comp, int r32, int hi, float init) {
#pragma unroll
  for (int r = 0; r < 16; ++r) { p0[r] = init; p1[r] = init; }
#pragma unroll
  for (int d0 = 0; d0 < 4; ++d0) {
    const int cb = ((comp * 4 + d0) * 16 + hi * 8) * 2;
    const bf16x8 b0 = *(const bf16x8*)(Ks + KSWZ(r32, cb));
    const bf16x8 b1 = *(const bf16x8*)(Ks + KSWZ(32 + r32, cb));
    const bf16x8 q = *(const bf16x8*)(Qs + KSWZ(qrow, cb));
    p0 = __builtin_amdgcn_mfma_f32_32x32x16_bf16(b0, q, p0, 0, 0, 0);
    p1 = __builtin_amdgcn_mfma_f32_32x32x16_bf16(b1, q, p1, 0, 0, 0);
  }
}
__device__ __forceinline__ void att_softmax(f32x16& p0, f32x16& p1, float& m_reg, float& l_reg, float& alpha, bool first, bf16x8& pa0, bf16x8& pa1, bf16x8& pa2, bf16x8& pa3) {
  float pmax = p0[0];
#pragma unroll
  for (int r = 1; r < 16; ++r) pmax = fmaxf(pmax, p0[r]);
#pragma unroll
  for (int r = 0; r < 16; ++r) pmax = fmaxf(pmax, p1[r]);
  { auto rr = __builtin_amdgcn_permlane32_swap(__float_as_uint(pmax), __float_as_uint(pmax), false, false);
    pmax = fmaxf(__uint_as_float(rr[0]), __uint_as_float(rr[1])); }
  alpha = 1.f;
  if (__builtin_expect(first || !__all(pmax <= ATT_THR), 0)) {
    const float delta = first ? pmax : fmaxf(pmax, 0.f);
    alpha = first ? 0.f : __builtin_amdgcn_exp2f(-delta);
    m_reg = (first ? 0.f : m_reg) + delta;
#pragma unroll
    for (int r = 0; r < 16; ++r) { p0[r] -= delta; p1[r] -= delta; }
  }
#pragma unroll
  for (int r = 0; r < 16; ++r) { p0[r] = __builtin_amdgcn_exp2f(p0[r]); p1[r] = __builtin_amdgcn_exp2f(p1[r]); }
  float ps = 0.f;
#pragma unroll
  for (int r = 0; r < 16; ++r) ps += p0[r];
#pragma unroll
  for (int r = 0; r < 16; ++r) ps += p1[r];
  { auto rr = __builtin_amdgcn_permlane32_swap(__float_as_uint(ps), __float_as_uint(ps), false, false);
    ps = __uint_as_float(rr[0]) + __uint_as_float(rr[1]); }
  l_reg = l_reg * alpha + ps;
#define PK4(P, BASE, OUT) do { unsigned a0 = cvtpk(P[BASE + 0], P[BASE + 1]), a1 = cvtpk(P[BASE + 2], P[BASE + 3]);   \
    unsigned b0 = cvtpk(P[BASE + 4], P[BASE + 5]), b1 = cvtpk(P[BASE + 6], P[BASE + 7]);                              \
    auto r0 = __builtin_amdgcn_permlane32_swap(a0, b0, false, false); auto r1 = __builtin_amdgcn_permlane32_swap(a1, b1, false, false); \
    u32x4 w = {r0[0], r1[0], r0[1], r1[1]}; OUT = *reinterpret_cast<bf16x8*>(&w); } while (0)
  PK4(p0, 0, pa0); PK4(p0, 8, pa1); PK4(p1, 0, pa2); PK4(p1, 8, pa3);
#undef PK4
}
__device__ __forceinline__ void att_unit(const bf16_t* __restrict__ Qb, const bf16_t* __restrict__ Kh, const bf16_t* __restrict__ Vh, bf16_t* __restrict__ Ob,
                                         int nkeys, float lam, const float* __restrict__ ng, float oscale, unsigned char* lds) {
  int tid_ = threadIdx.x; asm volatile("" : "+v"(tid_)); const int tid = tid_, wid = tid >> 6, lane = tid & 63, r32 = lane & 31, hi = lane >> 5;
  unsigned char* V_lds = lds; unsigned char* K_lds = lds + 2 * ATT_SHM_V;
  float* wsl = (float*)(lds + 2 * ATT_SHM_V + 2 * ATT_SHM_K) + wid * 64; float* li_l = wsl; float* al_l = wsl + 32;
  float m0 = 0.f, l0 = 0.f, m1 = 0.f, l1 = 0.f;
  f32x16 o0[4] = {}, o1[4] = {};
  unsigned char* Q_lds = lds + 2 * ATT_SHM_V + 2 * ATT_SHM_K + 2048;
#pragma unroll
  for (int i = 0; i < 8; ++i) { const int id = tid + 512 * i, qrw = id >> 4, ch = id & 15;
    *(bf16x8*)(Q_lds + KSWZ(qrw, ch * 16)) = *(const bf16x8*)(Qb + (size_t)qrw * PW + ch * 8); }
  const int qrow = wid * 32 + r32;
  const int vb0 = (int)(uintptr_t)V_lds + v_rd_base(lane);
  int kso[2], vso[2];
#pragma unroll
  for (int i = 0; i < 2; ++i) {
    const int o16 = tid + 512 * i;
    { const int row = o16 >> 4, cs = (o16 & 15) ^ (row & 15); kso[i] = row * PW + cs * 8; }
    { const int sub = o16 >> 5, r16 = o16 & 31, kk = (sub >> 2) * 8 + (r16 >> 2), k = (kk & ~0xC) | ((kk & 4) << 1) | ((kk & 8) >> 1), c = (sub & 3) * 32 + (r16 & 3) * 8; vso[i] = k * PW + c; }
  }
  const unsigned ldsw = (unsigned)__builtin_amdgcn_readfirstlane(wid) * 1024u;
#define GSTAGE(b, k0) do { _Pragma("unroll") for (int i_ = 0; i_ < 2; ++i_) { \
    __builtin_amdgcn_global_load_lds((const unsigned*)(Vh + (size_t)(k0) * PW + vso[i_]), (LAS unsigned*)(V_lds + (b) * ATT_SHM_V + ldsw + i_ * 8192), 16, 0, 0); \
    __builtin_amdgcn_global_load_lds((const unsigned*)(Kh + (size_t)(k0) * PW + kso[i_]), (LAS unsigned*)(K_lds + (b) * ATT_SHM_K + ldsw + i_ * 8192), 16, 0, 0); } } while (0)
#define RESC(o, a) do { if (__any((a) < 1.f)) { if (hi == 0) al_l[r32] = (a); asm volatile("s_waitcnt lgkmcnt(0)" ::: "memory"); \
    _Pragma("unroll") for (int d = 0; d < 4; ++d) _Pragma("unroll") for (int r = 0; r < 16; ++r) o[d][r] *= al_l[crow(r, hi)]; } } while (0)
  const int NT = nkeys / 64;
  GSTAGE(0, 0); asm volatile("s_waitcnt vmcnt(0)" ::: "memory"); __syncthreads();
  for (int j = 0; j < NT; ++j) {
    const int cur = j & 1;
    if (j + 1 < NT) GSTAGE(cur ^ 1, (j + 1) * 64);
    const unsigned char* Kc = K_lds + cur * ATT_SHM_K; const int vb = vb0 + cur * ATT_SHM_V;
    f32x16 p0, p1, q0, q1; float alphaA, alphaB; bf16x8 pa0, pa1, pa2, pa3, pb0, pb1, pb2, pb3;
    const bool first = (j == 0);
    att_qkt(p0, p1, Kc, Q_lds, qrow, 0, r32, hi, first ? 0.f : -m0);
    att_qkt(q0, q1, Kc, Q_lds, qrow, 1, r32, hi, first ? 0.f : -m1);
    att_softmax(p0, p1, m0, l0, alphaA, first, pa0, pa1, pa2, pa3);
    att_softmax(q0, q1, m1, l1, alphaB, first, pb0, pb1, pb2, pb3);
    RESC(o0, alphaA);
    RESC(o1, alphaB);
    pv_two<0>(o0[0], o1[0], vb, pa0, pa1, pa2, pa3, pb0, pb1, pb2, pb3); pv_two<1>(o0[1], o1[1], vb, pa0, pa1, pa2, pa3, pb0, pb1, pb2, pb3);
    pv_two<2>(o0[2], o1[2], vb, pa0, pa1, pa2, pa3, pb0, pb1, pb2, pb3); pv_two<3>(o0[3], o1[3], vb, pa0, pa1, pa2, pa3, pb0, pb1, pb2, pb3);
    asm volatile("s_waitcnt vmcnt(0)" ::: "memory");
    __syncthreads();
  }
  if (hi == 0) { li_l[r32] = 1.f / l0; al_l[r32] = lam / l1; }
  asm volatile("s_waitcnt lgkmcnt(0)" ::: "memory");
  float ss[16];
#pragma unroll
  for (int r = 0; r < 16; ++r) {
    const float a = li_l[crow(r, hi)], bq = al_l[crow(r, hi)];
    float s = 0.f;
#pragma unroll
    for (int d = 0; d < 4; ++d) { const float v = o0[d][r] * a - o1[d][r] * bq; o0[d][r] = v; s += v * v; }
    s += __shfl_xor(s, 1); s += __shfl_xor(s, 2); s += __shfl_xor(s, 4); s += __shfl_xor(s, 8); s += __shfl_xor(s, 16);
    ss[r] = rsqrtf(s * (1.f / 128.f) + EPS) * oscale;
  }
  bf16_t* Ow = Ob + (size_t)(wid * 32) * DM;
#pragma unroll
  for (int d = 0; d < 4; ++d) {
    const float g = ng[d * 32 + r32];
#pragma unroll
    for (int r = 0; r < 16; ++r) Ow[(size_t)crow(r, hi) * DM + d * 32 + r32] = (ABL & 4) ? (bf16_t)0 : (bf16_t)(cvtpk(o0[d][r] * ss[r] * g, 0.f) & 0xffffu);
  }
  __syncthreads();
#undef GSTAGE
#undef RESC
}

__device__ __forceinline__ float ins16(float (&a)[16], float x) {
#pragma unroll
  for (int i = 0; i < 16; ++i) { const float h = fmaxf(a[i], x); x = fminf(a[i], x); a[i] = h; }
  return x;
}
__device__ __forceinline__ void bsort16(float (&a)[16]) {
#pragma unroll
  for (int k = 2; k <= 16; k <<= 1)
#pragma unroll
    for (int j = k >> 1; j > 0; j >>= 1)
#pragma unroll
      for (int i = 0; i < 16; ++i) {
        const int q = i ^ j;
        if (q > i) {
          const bool desc = ((i & k) == 0);
          const float hi_ = fmaxf(a[i], a[q]), lo_ = fminf(a[i], a[q]);
          a[i] = desc ? hi_ : lo_; a[q] = desc ? lo_ : hi_;
        }
      }
}
__device__ __forceinline__ void bmerge16(float (&a)[16], const float (&b)[16]) {
#pragma unroll
  for (int i = 0; i < 16; ++i) a[i] = fmaxf(a[i], b[15 - i]);
#pragma unroll
  for (int j = 8; j > 0; j >>= 1)
#pragma unroll
    for (int i = 0; i < 16; ++i) {
      const int q = i ^ j;
      if (q > i) { const float hi_ = fmaxf(a[i], a[q]), lo_ = fminf(a[i], a[q]); a[i] = hi_; a[q] = lo_; }
    }
}
__device__ __forceinline__ float gelu_erf(float x) { return 0.5f * x * (1.f + erff(x * 0.70710678118654752440f)); }
#define XB_TMO      128
#define XB_XCNT(j)  (256  + 64 * (j))
#define XB_XSUB(j)  (1280 + 64 * (j))
#define XB_XGEN(j)  (2304 + 64 * (j))
#define XB_TOP      3328
#define XB_TOPGEN   3392
#define XCD_BAR_WORDS 3456
#define XB_SPIN_CAP (1u << 22)
__device__ __forceinline__ unsigned xb_ld(unsigned* p)              { return __hip_atomic_load(p, __ATOMIC_RELAXED, __HIP_MEMORY_SCOPE_AGENT); }
__device__ __forceinline__ unsigned xb_add(unsigned* p, unsigned v) { return __hip_atomic_fetch_add(p, v, __ATOMIC_RELAXED, __HIP_MEMORY_SCOPE_AGENT); }
__device__ __forceinline__ unsigned xb_xcc_id() { return (unsigned)__builtin_amdgcn_s_getreg((3 << 11) | 20) & 0xFu; }
#define XB_SPIN(cond, bar) do { unsigned _sp = 0; while (cond) { __builtin_amdgcn_s_sleep(1); \
    if ((++_sp & 255u) == 0u) { if (xb_ld(&(bar)[XB_TMO])) break; if (_sp > XB_SPIN_CAP) { atomicAdd(&(bar)[XB_TMO], 1u); break; } } } } while (0)
struct XcdBarrier { unsigned* bar; unsigned x; volatile LAS unsigned* st; };
__device__ __forceinline__ XcdBarrier xcd_barrier_post(unsigned* bar, volatile LAS unsigned* st) {
  XcdBarrier b; b.bar = bar; b.x = xb_xcc_id(); b.st = st;
  if (threadIdx.x == 0) (void)xb_add(&bar[XB_XCNT(b.x)], 1u);
  return b;
}
__device__ __forceinline__ void xcd_barrier_complete(unsigned* bar, unsigned x, unsigned& nloc, unsigned& nx) {
  const unsigned G = gridDim.x * gridDim.y * gridDim.z;
  unsigned sum, cnt, mine, sp = 0u;
  for (;;) {
    sum = 0u; cnt = 0u; mine = 0u;
#pragma unroll
    for (unsigned j = 0; j < 16; ++j) { const unsigned c = xb_ld(&bar[XB_XCNT(j)]); sum += c; cnt += (c > 0u) ? 1u : 0u; mine = (j == x) ? c : mine; }
    if (sum == G) break;
    __builtin_amdgcn_s_sleep(1);
    if ((++sp & 255u) == 0u) { if (xb_ld(&bar[XB_TMO])) break; if (sp > XB_SPIN_CAP) { atomicAdd(&bar[XB_TMO], 1u); break; } }
  }
  nloc = mine > 0u ? mine : 1u; nx = cnt > 0u ? cnt : 1u;
}
__device__ __forceinline__ void xcd_barrier(const XcdBarrier& b) {
  asm volatile("s_waitcnt vmcnt(0)" ::: "memory");
  __syncthreads();
  if (threadIdx.x == 0) {
    unsigned* bar = b.bar;
    __builtin_amdgcn_s_waitcnt(0);
    unsigned nloc = b.st[0], nx = b.st[1];
    if (nloc == 0u) { xcd_barrier_complete(bar, b.x, nloc, nx); b.st[0] = nloc; b.st[1] = nx; }
    const unsigned old = xb_add(&bar[XB_XSUB(b.x)], 1u);
    const unsigned gen = old / nloc;
    if (old + 1u == (gen + 1u) * nloc) {
      __builtin_amdgcn_fence(__ATOMIC_RELEASE, "agent");
      asm volatile("s_waitcnt vmcnt(0)" ::: "memory");
      const unsigned og = xb_add(&bar[XB_TOP], 1u);
      const unsigned tg = og / nx;
      if (og + 1u == (tg + 1u) * nx) xb_add(&bar[XB_TOPGEN], 1u);
      else XB_SPIN(xb_ld(&bar[XB_TOPGEN]) == tg, bar);
      __builtin_amdgcn_fence(__ATOMIC_ACQUIRE, "agent");
      xb_add(&bar[XB_XGEN(b.x)], 1u);
      asm volatile("s_waitcnt vmcnt(0)" ::: "memory");
    } else {
      XB_SPIN(xb_ld(&bar[XB_XGEN(b.x)]) == gen, bar);
      __builtin_amdgcn_fence(__ATOMIC_ACQUIRE, "agent");
      asm volatile("s_waitcnt vmcnt(0)" ::: "memory");
    }
  }
  __syncthreads();
}

constexpr size_t RT_STRIDE = (size_t)T * 128 * 4;
__device__ __forceinline__ void route_unit(const Params& p, int l, int unit, unsigned char* lds) {
  int tid_ = threadIdx.x; asm volatile("" : "+v"(tid_)); const int tid = tid_, lane = tid & 63, wid = tid >> 6, r32 = lane & 31, hi = lane >> 5;
  unsigned char* IDX = lds;
  int* UE = (int*)(lds + 8192); float* UG = (float*)(lds + 8192 + 16384); float* US = (float*)(lds + 8192 + 32768);
  int* EIDG = (int*)(p.ws + WS_ULOC); float* GWG = (float*)(p.ws + WS_ULOC + RT_STRIDE); float* SUG = (float*)(p.ws + WS_ULOC + 2 * RT_STRIDE);
  const float* PSC = (const float*)(p.ws + WS_PSC);
  const int row0 = unit * 32;
  const bf16_t* QP = (const bf16_t*)(p.ws + WS_PROJ);
  const bf16_t* KEYS = (const bf16_t*)(p.ws + WS_KEYS) + (size_t)l * 131072;
  for (int rrep = 0; rrep < REP_ROUTE; ++rrep) {
    const int h = wid;
    float top[2][16];
#pragma unroll
    for (int pp = 0; pp < 2; ++pp) {
      const bf16_t* qrow = QP + (size_t)(row0 + r32) * DM + h * 128 + pp * 64 + hi * 8;
      const bf16_t* kb = KEYS + ((size_t)(h * 2 + pp) * 128 + r32) * 64 + hi * 8;
      bf16x8 bq[4];
#pragma unroll
      for (int ks = 0; ks < 4; ++ks) bq[ks] = *(const bf16x8*)(qrow + ks * 16);
      float (&lst)[16] = top[pp];
#pragma unroll
      for (int i = 0; i < 16; ++i) lst[i] = -INFINITY;
#pragma unroll
      for (int nt = 0; nt < 4; ++nt) {
        f32x16 acc = {};
#pragma unroll
        for (int ks = 0; ks < 4; ++ks) {
          const bf16x8 ak = *(const bf16x8*)(kb + (size_t)nt * 32 * 64 + ks * 16);
          acc = __builtin_amdgcn_mfma_f32_32x32x16_bf16(ak, bq[ks], acc, 0, 0, 0);
        }
        float grp[16];
#pragma unroll
        for (int r = 0; r < 16; ++r) grp[r] = __uint_as_float((__float_as_uint(acc[r]) & ~0x7Fu) | (unsigned)(nt * 32 + crow(r, hi)));
        bsort16(grp);
        if (nt == 0) {
#pragma unroll
          for (int i = 0; i < 16; ++i) lst[i] = grp[i];
        } else bmerge16(lst, grp);
        SBAR();
      }
      float oth[16];
#pragma unroll
      for (int i = 0; i < 16; ++i) oth[i] = __shfl_xor(lst[i], 32);
      bmerge16(lst, oth);
      if (hi == 0) {
        unsigned w[4];
#pragma unroll
        for (int i = 0; i < 4; ++i)
          w[i] = (__float_as_uint(lst[4 * i]) & 0x7Fu) | ((__float_as_uint(lst[4 * i + 1]) & 0x7Fu) << 8) | ((__float_as_uint(lst[4 * i + 2]) & 0x7Fu) << 16) | ((__float_as_uint(lst[4 * i + 3]) & 0x7Fu) << 24);
        *(u32x4*)(IDX + ((r32 * 8 + h) * 2 + pp) * 16) = (u32x4){w[0], w[1], w[2], w[3]};
      }
    }
    float best[16];
#define CAND(i, j) __uint_as_float((__float_as_uint(__uint_as_float(__float_as_uint(top[0][i]) & ~0x7Fu) + __uint_as_float(__float_as_uint(top[1][j]) & ~0x7Fu)) & ~0xFFu) | (unsigned)((i) * 16 + (j)))
    {
#pragma unroll
      for (int j = 0; j < 16; ++j) best[j] = CAND(0, j);
      float y[16];
#pragma unroll
      for (int j = 0; j < 8; ++j) { y[j] = CAND(1, j); y[8 + j] = CAND(15 - j, 0); }
#pragma unroll
      for (int jj = 8; jj > 0; jj >>= 1)
#pragma unroll
        for (int i = 0; i < 16; ++i) { const int q = i ^ jj; if (q > i) { const float hi_ = fmaxf(y[i], y[q]), lo_ = fminf(y[i], y[q]); y[i] = hi_; y[q] = lo_; } }
      bmerge16(best, y);
      float x[16];
      x[0] = CAND(2, 0); x[1] = CAND(2, 1); x[2] = CAND(2, 2); x[3] = CAND(2, 3); x[4] = CAND(2, 4);
      x[5] = CAND(3, 0); x[6] = CAND(3, 1); x[7] = CAND(3, 2); x[8] = CAND(3, 3);
      x[9] = CAND(4, 0); x[10] = CAND(4, 1); x[11] = CAND(4, 2);
      x[12] = CAND(5, 0); x[13] = CAND(5, 1); x[14] = CAND(6, 0); x[15] = CAND(6, 1);
      bsort16(x);
      bmerge16(best, x);
      ins16(best, CAND(7, 0)); ins16(best, CAND(7, 1));
    }
#undef CAND
    asm volatile("s_waitcnt lgkmcnt(0)" ::: "memory");
    if (hi == 0) {
      const unsigned char* ib = IDX + ((r32 * 8 + h) * 2) * 16;
      const float mx = __uint_as_float(__float_as_uint(best[0]) & ~0xFFu);
      float w[16]; float sum = 0.f;
#pragma unroll
      for (int k = 0; k < 16; ++k) { w[k] = __expf(__uint_as_float(__float_as_uint(best[k]) & ~0xFFu) - mx); sum += w[k]; }
      const float rsum = 1.f / sum;
      int ee[16]; float su_[16], sv_[16];
#pragma unroll
      for (int k = 0; k < 16; ++k) {
        const unsigned ij = __float_as_uint(best[k]) & 0xFFu;
        ee[k] = (int)ib[ij >> 4] * 128 + (int)ib[16 + (ij & 15)];
      }
#pragma unroll
      for (int k = 0; k < 16; ++k) { su_[k] = PSC[(size_t)l * NEXP + ee[k]]; sv_[k] = PSC[(size_t)(DEPTH + l) * NEXP + ee[k]]; }
#pragma unroll
      for (int k = 0; k < 16; ++k) {
        UE[r32 * 128 + h * 16 + k] = ee[k]; UG[r32 * 128 + h * 16 + k] = w[k] * rsum * sv_[k];
        US[r32 * 128 + h * 16 + k] = su_[k];
      }
    }
  }
  __syncthreads();
#pragma unroll 1
  for (int tt = 0; tt < 4; ++tt) {
    const int t = wid * 4 + tt;
    const int k0 = UE[t * 128 + lane], k1 = UE[t * 128 + 64 + lane];
    const float g0 = UG[t * 128 + lane], g1 = UG[t * 128 + 64 + lane], s0 = US[t * 128 + lane], s1 = US[t * 128 + 64 + lane];
    const int b0 = k0 >> 10, b1 = k1 >> 10;
    int base = 0, pos0 = 0, pos1 = 0;
#pragma unroll
    for (int b = 0; b < 16; ++b) {
      const unsigned long long m0 = __ballot(b0 == b), m1 = __ballot(b1 == b);
      const int c0 = __popcll(m0), c1 = __popcll(m1);
      const unsigned long long lt = (1ull << lane) - 1ull;
      if (b0 == b) pos0 = base + __popcll(m0 & lt);
      if (b1 == b) pos1 = base + c0 + __popcll(m1 & lt);
      base += c0 + c1;
    }
    const size_t ro = (size_t)(row0 + t) * 128;
    EIDG[ro + pos0] = k0; GWG[ro + pos0] = g0; SUG[ro + pos0] = s0;
    EIDG[ro + pos1] = k1; GWG[ro + pos1] = g1; SUG[ro + pos1] = s1;
  }
}
struct TokPref { int e0, e1; float g0, g1, s0, s1; u32x4 hA, hB; };
__device__ __forceinline__ void tok_prefetch(const Params& p, int row, int lane, TokPref& t) {
  const int* EIDG = (const int*)(p.ws + WS_ULOC) + (size_t)row * 128; const float* GWG = (const float*)(p.ws + WS_ULOC + RT_STRIDE) + (size_t)row * 128;
  const float* SUG = (const float*)(p.ws + WS_ULOC + 2 * RT_STRIDE) + (size_t)row * 128;
  const bf16_t* H = (const bf16_t*)(p.ws + WS_H);
  t.e0 = EIDG[lane]; t.e1 = EIDG[64 + lane]; t.g0 = GWG[lane]; t.g1 = GWG[64 + lane]; t.s0 = SUG[lane]; t.s1 = SUG[64 + lane];
  t.hA = *(const u32x4*)(H + (size_t)row * DM + lane * 16); t.hB = *(const u32x4*)(H + (size_t)row * DM + lane * 16 + 8);
}
__device__ __forceinline__ void gather_token(const Params& p, int l, int row, int nextrow, TokPref& tp, unsigned char* lds, int lane, int wid) {
  int* EW = (int*)(lds + wid * 2048); float* GWl = (float*)(lds + wid * 2048 + 512); float* SWl = (float*)(lds + wid * 2048 + 1024);
  const bf16_t* H = (const bf16_t*)(p.ws + WS_H);
  const unsigned char* PUq = p.ws + WS_PU + (size_t)l * NEXP * DM;
  const unsigned char* PVq = p.ws + WS_PV + (size_t)l * NEXP * DM;
  float* XC = (float*)(p.ws + WS_XCUR);
  const float* MOD = (const float*)(p.ws + WS_MOD);
  EW[lane] = tp.e0; EW[64 + lane] = tp.e1; GWl[lane] = tp.g0; GWl[64 + lane] = tp.g1; SWl[lane] = tp.s0; SWl[64 + lane] = tp.s1;
  asm volatile("s_waitcnt lgkmcnt(0)" ::: "memory");
  {
    float hf[16];
    {
      const u32x4 hA = tp.hA, hB = tp.hB;
      hf[0] = bflo(hA.x); hf[1] = bfhi(hA.x); hf[2] = bflo(hA.y); hf[3] = bfhi(hA.y); hf[4] = bflo(hA.z); hf[5] = bfhi(hA.z); hf[6] = bflo(hA.w); hf[7] = bfhi(hA.w);
      hf[8] = bflo(hB.x); hf[9] = bfhi(hB.x); hf[10] = bflo(hB.y); hf[11] = bfhi(hB.y); hf[12] = bflo(hB.z); hf[13] = bfhi(hB.z); hf[14] = bflo(hB.w); hf[15] = bfhi(hB.w);
    }
    if (nextrow >= 0) tok_prefetch(p, nextrow, lane, tp);
    f32x4 xpre[4];
    { const float* xr_ = XC + (size_t)row * DM + lane * 16;
#pragma unroll
      for (int v4 = 0; v4 < 4; ++v4) xpre[v4] = *(const f32x4*)(xr_ + v4 * 4); }
    float acc[16];
    for (int rep = 0; rep < REP_PEER; ++rep) {
#pragma unroll
    for (int i = 0; i < 16; ++i) acc[i] = 0.f;
    u32x4 uq[8];
#pragma unroll
    for (int i = 0; i < 8; ++i) { const int e0 = __builtin_amdgcn_readfirstlane(EW[i]); uq[i] = *(const u32x4*)(PUq + (size_t)e0 * DM + lane * 16); }
    for (int g8 = 0; g8 < 16; ++g8) {
      int eid[8]; float gwt[8]; u32x4 vq[8];
#pragma unroll
      for (int i = 0; i < 8; ++i) {
        eid[i] = __builtin_amdgcn_readfirstlane(EW[g8 * 8 + i]);
        gwt[i] = __uint_as_float(__builtin_amdgcn_readfirstlane(__float_as_uint(GWl[g8 * 8 + i])));
        vq[i] = *(const u32x4*)(PVq + (size_t)eid[i] * DM + lane * 16);
      }
      float d[8];
#pragma unroll
      for (int i = 0; i < 8; ++i) {
        const float su = __uint_as_float(__builtin_amdgcn_readfirstlane(__float_as_uint(SWl[g8 * 8 + i])));
        float a0 = 0.f, a1 = 0.f;
#define DQ(W, K) { const f32x2 lo_ = __builtin_amdgcn_cvt_pk_f32_fp8((int)(W), false), hi_ = __builtin_amdgcn_cvt_pk_f32_fp8((int)(W), true); \
          a0 += lo_.x * hf[K]; a1 += lo_.y * hf[K + 1]; a0 += hi_.x * hf[K + 2]; a1 += hi_.y * hf[K + 3]; }
        DQ(uq[i].x, 0) DQ(uq[i].y, 4) DQ(uq[i].z, 8) DQ(uq[i].w, 12)
#undef DQ
        d[i] = (a0 + a1) * su;
      }
      if (g8 < 15) {
#pragma unroll
        for (int i = 0; i < 8; ++i) { const int e0 = __builtin_amdgcn_readfirstlane(EW[(g8 + 1) * 8 + i]); uq[i] = *(const u32x4*)(PUq + (size_t)e0 * DM + lane * 16); }
      }
      float tot;
      {
        auto s01 = __builtin_amdgcn_permlane32_swap(__float_as_uint(d[0]), __float_as_uint(d[1]), false, false);
        auto s23 = __builtin_amdgcn_permlane32_swap(__float_as_uint(d[2]), __float_as_uint(d[3]), false, false);
        auto s45 = __builtin_amdgcn_permlane32_swap(__float_as_uint(d[4]), __float_as_uint(d[5]), false, false);
        auto s67 = __builtin_amdgcn_permlane32_swap(__float_as_uint(d[6]), __float_as_uint(d[7]), false, false);
        const float q01 = __uint_as_float(s01[0]) + __uint_as_float(s01[1]), q23 = __uint_as_float(s23[0]) + __uint_as_float(s23[1]);
        const float q45 = __uint_as_float(s45[0]) + __uint_as_float(s45[1]), q67 = __uint_as_float(s67[0]) + __uint_as_float(s67[1]);
        auto ta = __builtin_amdgcn_permlane16_swap(__float_as_uint(q01), __float_as_uint(q23), false, false);
        auto tb = __builtin_amdgcn_permlane16_swap(__float_as_uint(q45), __float_as_uint(q67), false, false);
        const float r0123 = __uint_as_float(ta[0]) + __uint_as_float(ta[1]);
        const float r4567 = __uint_as_float(tb[0]) + __uint_as_float(tb[1]);
        const bool b3 = (lane & 8) != 0;
        const float keep = b3 ? r4567 : r0123, send = b3 ? r0123 : r4567;
        float x = keep + __shfl_xor(send, 8);
        x += __shfl_xor(x, 4); x += __shfl_xor(x, 2); x += __shfl_xor(x, 1);
        tot = x;
      }
      float ge;
      {
        const float v = tot, av = fabsf(v), tq = __builtin_amdgcn_rcpf(av * 0.2316418882f + 1.0f);
        float q = tq * 0.5307027145f + (-0.7265760135f); q = q * tq + 0.7107068705f; q = q * tq + (-0.142248368f); q = q * tq + 0.127414796f; q = q * tq;
        const float ex = __builtin_amdgcn_exp2f(v * v * (-0.72134752044f));
        const float m = v * (q * ex), r = v - m;
        ge = v < 0.f ? m : r;
      }
      float c[8];
      c[0] = __uint_as_float(__builtin_amdgcn_readlane(__float_as_uint(ge), 0)) * gwt[0];  c[4] = __uint_as_float(__builtin_amdgcn_readlane(__float_as_uint(ge), 8)) * gwt[4];
      c[2] = __uint_as_float(__builtin_amdgcn_readlane(__float_as_uint(ge), 16)) * gwt[2]; c[6] = __uint_as_float(__builtin_amdgcn_readlane(__float_as_uint(ge), 24)) * gwt[6];
      c[1] = __uint_as_float(__builtin_amdgcn_readlane(__float_as_uint(ge), 32)) * gwt[1]; c[5] = __uint_as_float(__builtin_amdgcn_readlane(__float_as_uint(ge), 40)) * gwt[5];
      c[3] = __uint_as_float(__builtin_amdgcn_readlane(__float_as_uint(ge), 48)) * gwt[3]; c[7] = __uint_as_float(__builtin_amdgcn_readlane(__float_as_uint(ge), 56)) * gwt[7];
#pragma unroll
      for (int i = 0; i < 8; ++i) {
#define AQ(W, K) { const f32x2 lo_ = __builtin_amdgcn_cvt_pk_f32_fp8((int)(W), false), hi_ = __builtin_amdgcn_cvt_pk_f32_fp8((int)(W), true); \
          acc[K] += c[i] * lo_.x; acc[K + 1] += c[i] * lo_.y; acc[K + 2] += c[i] * hi_.x; acc[K + 3] += c[i] * hi_.y; }
        AQ(vq[i].x, 0) AQ(vq[i].y, 4) AQ(vq[i].z, 8) AQ(vq[i].w, 12)
#undef AQ
      }
    }
    }
    SBAR();
    const int mr = mod_row(row);
    const float* g2 = MOD + ((size_t)l * 5 + mr) * 6144 + 5 * 1024;
    float* xr = XC + (size_t)row * DM;
    float xn[16]; float ssq = 0.f;
    if (ABL & 8) {
#pragma unroll
      for (int i = 0; i < 16; ++i) acc[i] = 0.f;
    }
#pragma unroll
    for (int v4 = 0; v4 < 4; ++v4) {
      const int c = lane * 16 + v4 * 4;
      const f32x4 xo = xpre[v4], gg = *(const f32x4*)(g2 + c);
      f32x4 o;
      o.x = xo.x + gg.x * acc[v4 * 4 + 0]; o.y = xo.y + gg.y * acc[v4 * 4 + 1]; o.z = xo.z + gg.z * acc[v4 * 4 + 2]; o.w = xo.w + gg.w * acc[v4 * 4 + 3];
      xn[v4 * 4 + 0] = o.x; xn[v4 * 4 + 1] = o.y; xn[v4 * 4 + 2] = o.z; xn[v4 * 4 + 3] = o.w;
      ssq += (o.x * o.x + o.y * o.y) + (o.z * o.z + o.w * o.w);
      if (l < DEPTH - 1) *(f32x4*)(xr + c) = o;
    }
    const float rs = rsqrtf(wave_sum(ssq) * (1.f / DM) + EPS);
    if (l == DEPTH - 1) {
      const int b = row / SEGL, s = row - b * SEGL;
      float* orow = p.out + ((size_t)(b * SEQ + (s - CTXL))) * DM;
      const float* fg = p.in[I_FINALG];
#pragma unroll
      for (int v4 = 0; v4 < 4; ++v4) {
        const int c = lane * 16 + v4 * 4;
        const f32x4 gg = *(const f32x4*)(fg + c);
        f32x4 o; o.x = xn[v4 * 4 + 0] * rs * gg.x; o.y = xn[v4 * 4 + 1] * rs * gg.y; o.z = xn[v4 * 4 + 2] * rs * gg.z; o.w = xn[v4 * 4 + 3] * rs * gg.w;
        *(f32x4*)(orow + c) = o;
      }
    } else {
      const float* m = MOD + ((size_t)(l + 1) * 5 + mr) * 6144;
      const float* ng = p.in[I_N1G] + (l + 1) * DM;
      bf16_t* hrow = (bf16_t*)(p.ws + WS_H) + (size_t)row * DM;
#pragma unroll
      for (int hh = 0; hh < 2; ++hh) {
        float y[8];
#pragma unroll
        for (int i = 0; i < 8; ++i) { const int c = lane * 16 + hh * 8 + i; y[i] = xn[hh * 8 + i] * rs * ng[c] * (1.f + m[1024 + c]) + m[c]; }
        u32x4 w; w.x = cvtpk(y[0], y[1]); w.y = cvtpk(y[2], y[3]); w.z = cvtpk(y[4], y[5]); w.w = cvtpk(y[6], y[7]);
        *(u32x4*)(hrow + lane * 16 + hh * 8) = w;
      }
    }
  }
}

__device__ __forceinline__ void phase_c1(const Params& p, int l, unsigned char* lds) {
  constexpr int NLOC = NBATCH * 4 * NCH, NCONV = T / 32;
  for (int u = p.bx; u < NLOC + NCONV; u += p.gx) {
    if (u < NLOC) ml_local_unit2(p, l, u, lds);
    else {
      const int cu = u - NLOC;
      if (l == DEPTH - 1 && (cu % (SEGL / 32)) < (CTXL / 32)) continue;
      conv_unit(p, l, cu, lds);
    }
  }
}
__device__ __forceinline__ void phase_c2(const Params& p, int l, unsigned char* lds) {
  ml_scan(p, lds);
  const float* lp = p.in[I_DLAM] + l * 256;
  float s01 = 0.f, s23 = 0.f;
  for (int i = 0; i < 64; ++i) { s01 += lp[i] * lp[64 + i]; s23 += lp[128 + i] * lp[192 + i]; }
  const float lam_init = 0.8f - 0.6f * expf(-0.3f * (float)l);
  const float lam = expf(s01) - expf(s23) + lam_init;
  const bf16_t* PROJ = (const bf16_t*)(p.ws + WS_PROJ);
  bf16_t* MIX = (bf16_t*)(p.ws + WS_MIX);
  const float* ng = p.in[I_DNORMG] + l * 128;
  const int nun = 512 + (l < DEPTH - 1 ? 16 : 0);
  for (int u = p.bx; u < nun; u += p.gx) {
    int bh, qrow, nkeys;
    if (u < 512) { const int xcd = u & 7, i = (u >> 3) & 31, rnd = u >> 8; bh = 2 * xcd + rnd; qrow = CTXL + i * 256; nkeys = SEGL; }
    else { bh = u - 512; qrow = 0; nkeys = CTXL; }
    const int b = bh >> 2, h = bh & 3;
    const size_t tok0 = (size_t)b * SEGL;
    for (int rep = 0; rep < REP_ATT; ++rep)
    att_unit(PROJ + (tok0 + qrow) * PW + C_DQ + h * 128, PROJ + tok0 * PW + C_DK + h * 128, PROJ + tok0 * PW + C_DV + h * 128,
             MIX + (tok0 + qrow) * DM + 512 + h * 128, nkeys, lam, ng, 1.f - lam_init, lds);
  }
}
__device__ __forceinline__ void phase_c3(const Params& p, int l, unsigned char* lds) {
  constexpr int NU = NBATCH * 4 * NCH;
  for (int u = p.bx; u < NU; u += p.gx) {
    if (l == DEPTH - 1 && (u % NCH) < 4) continue;
    ml_out_unit2(p, l, u, lds);
  }
}
__device__ __forceinline__ void phase_route(const Params& p, int l, unsigned char* lds) {
  constexpr int NU = T / 32;
  for (int u = p.bx; u < NU; u += p.gx) {
    if (l == DEPTH - 1 && (u % (SEGL / 32)) < (CTXL / 32)) continue;
    route_unit(p, l, u, lds);
    __syncthreads();
  }
}
__device__ __forceinline__ void phase_gather(const Params& p, int l, unsigned char* lds) {
  int tid_ = threadIdx.x; asm volatile("" : "+v"(tid_)); const int lane = tid_ & 63, wid = tid_ >> 6;
  const int gw = p.bx * 8 + wid, NGW = p.gx * 8;
  const int ntok = (l == DEPTH - 1) ? NBATCH * SEQ : T;
#define TOKROW(ti_) ((l == DEPTH - 1) ? ((ti_) / SEQ) * SEGL + CTXL + ((ti_) % SEQ) : (ti_))
  TokPref tp;
  if (gw < ntok) tok_prefetch(p, TOKROW(gw), lane, tp);
  XcdBarrier xb; xb.bar = p.xbar_words; xb.x = p.xbar_x; xb.st = (volatile LAS unsigned*)((LAS unsigned char*)lds + p.lds_st_off);
  const int nrounds = (ntok + NGW - 1) / NGW;
  for (int r = 0; r < nrounds; ++r) {
    const int ti = gw + r * NGW;
    if (ti < ntok) {
      const int row = TOKROW(ti);
      const int nxt = ti + NGW < ntok ? TOKROW(ti + NGW) : -1;
      gather_token(p, l, row, nxt, tp, lds, lane, wid);
    }
#if GATHER_SYNC
    if (r + 1 < nrounds) { XcdBarrier xb2 = xb; size_t zb_ = 0; asm volatile("" : "+s"(zb_)); xb2.bar = xb.bar + zb_; xb2.x = xb.x + (unsigned)zb_; xcd_barrier(xb2); }
#endif
  }
#undef TOKROW
}

__global__ void __launch_bounds__(512, 2) mk_fwd(KArgs ka) {
  cg::grid_group grid = cg::this_grid();
  extern __shared__ __attribute__((aligned(16))) unsigned char lds[];
  const int lo = ka.ph_lo, hi = ka.ph_hi;
#define IN(k) (lo <= (k) && (k) < hi)
#ifndef PHASEMASK
#define PHASEMASK 0xFFFF
#endif
#define PH(i) ((PHASEMASK >> (i)) & 1)
#define MKP(q) Params q; { size_t z_ = 0; asm volatile("" : "+s"(z_)); \
    q.in = (InTab)((const __attribute__((address_space(4))) char*)__builtin_amdgcn_kernarg_segment_ptr() + z_); \
    q.out = ka.out + z_; q.ws = ka.ws + z_; q.ph_lo = lo; q.ph_hi = hi; q.bx = (int)blockIdx.x + (int)z_; q.gx = (int)gridDim.x + (int)z_; q.xbar_words = xbar.bar + z_; q.xbar_x = xbar.x + (unsigned)z_; q.lds_st_off = (unsigned)(LDS_BYTES - 64); }
#define SEAM(k) do { if (IN(k) && IN((k) + 1)) { if ((k) == 0) grid.sync(); else { XcdBarrier xb_ = xbar; size_t zb_ = 0; asm volatile("" : "+s"(zb_)); xb_.bar = xbar.bar + zb_; xb_.x = xbar.x + (unsigned)zb_; xcd_barrier(xb_); } } } while (0)
  volatile LAS unsigned* xst = (volatile LAS unsigned*)((LAS unsigned char*)lds + (LDS_BYTES - 64));
  if (threadIdx.x < 2) xst[threadIdx.x] = 0u;
  __syncthreads();
  XcdBarrier xbar = xcd_barrier_post((unsigned*)(ka.ws + WS_CTL) + 4096, xst);
  { MKP(p)
    if (PH(0) && IN(0)) for (int rep = 0; rep < REP_MISC; ++rep) { p0_mod(p, lds, (float*)(p.ws + WS_MOD)); p0_convert(p, lds); }
  }
  SEAM(0);
  { MKP(p)
    if (PH(1) && IN(1)) phase_norm(p, 0, 0, true, false);
  }
  SEAM(1);
#define LAYER(LL) { \
    int l = (LL); asm volatile("" : "+s"(l)); \
    const int b = 2 + 9 * (LL); \
    { MKP(q) if (PH(2) && IN(b + 0)) for (int rep = 0; rep < REP_GEMM; ++rep) phase_inproj2(q, l, lds); } \
    SEAM(b + 0); \
    { MKP(q) if (PH(3) && IN(b + 1)) for (int rep = 0; rep < REP_ML; ++rep) phase_c1(q, l, lds); } \
    SEAM(b + 1); \
    { MKP(q) if (PH(4) && IN(b + 2)) phase_c2(q, l, lds); } \
    SEAM(b + 2); \
    { MKP(q) if (PH(5) && IN(b + 3)) for (int rep = 0; rep < REP_ML; ++rep) phase_c3(q, l, lds); } \
    SEAM(b + 3); \
    { MKP(q) if (PH(6) && IN(b + 4)) phase_outproj2(q, l, lds); } \
    SEAM(b + 4); \
    { MKP(q) if (PH(7) && IN(b + 5)) for (int rep = 0; rep < REP_MISC; ++rep) phase_norm(q, l, 1, false, (LL) == DEPTH - 1); } \
    SEAM(b + 5); \
    { MKP(q) if (PH(8) && IN(b + 6)) for (int rep = 0; rep < REP_GEMM; ++rep) phase_peerq2(q, l, lds); } \
    SEAM(b + 6); \
    { MKP(q) if (PH(9) && IN(b + 7)) phase_route(q, l, lds); } \
    SEAM(b + 7); \
    { MKP(q) if (PH(9) && IN(b + 8)) phase_gather(q, l, lds); } \
    SEAM(b + 8); }
  LAYER(0) LAYER(1) LAYER(2) LAYER(3)
#undef LAYER
#undef IN
#undef SEAM
#undef MKP
}

extern "C" void kernel_launch(void* const* d_in, const int* in_sizes, int n_in, void* d_out, int out_size,
                              void* d_ws, size_t ws_size, hipStream_t stream) {
  static int grid = 0;
  if (grid == 0) {
    int dev = 0, cus = 0, per_cu = 0;
    (void)hipGetDevice(&dev);
    (void)hipDeviceGetAttribute(&cus, hipDeviceAttributeMultiprocessorCount, dev);
    (void)hipFuncSetAttribute((const void*)mk_fwd, hipFuncAttributeMaxDynamicSharedMemorySize, LDS_BYTES);
    (void)hipOccupancyMaxActiveBlocksPerMultiprocessor(&per_cu, (const void*)mk_fwd, 512, LDS_BYTES);
    fprintf(stderr, "kernel_launch: cus %d per_cu %d ws %zu (need %zu) n_in %d\n", cus, per_cu, ws_size, (size_t)WS_END, n_in);
    if (ws_size < WS_END || n_in != 23 || per_cu < 1) { fprintf(stderr, "kernel_launch: bad configuration, nothing launched\n"); grid = -1; return; }
    grid = cus;
  }
  if (grid < 0) return;
  (void)hipMemsetAsync((char*)d_ws + WS_CTL, 0, 65536, stream);
  KArgs p{};
  for (int i = 0; i < 23; ++i) p.in[i] = (const float*)d_in[i];
  p.out = (float*)d_out; p.ws = (unsigned char*)d_ws; p.ph_lo = 0; p.ph_hi = 38;
  void* args[] = {&p};
  hipError_t e = hipLaunchCooperativeKernel((const void*)mk_fwd, dim3(grid), dim3(512), args, LDS_BYTES, stream);
  if (e != hipSuccess) fprintf(stderr, "cooperative launch failed: %s (grid %d)\n", hipGetErrorString(e), grid);
}
```

```cpp
#include <hip/hip_runtime.h>
#include <hip/hip_cooperative_groups.h>
#include <cstdio>
#include <cstdint>
namespace cg = cooperative_groups;

constexpr int DM = 1024, NBATCH = 4, SEQ = 8192, CTXL = 256, SEGL = CTXL + SEQ, T = NBATCH * SEGL, DEPTH = 4;
constexpr int IN_W = 3088, PW = 3072;
constexpr int C_A = 0, C_MQ = 512, C_MK = 768, C_MV = 1024, C_MO = 1280, C_DQ = 1536, C_DK = 2048, C_DV = 2560;
constexpr int NCH = SEGL / 64;
constexpr int NEXP = 16384;
constexpr float EPS = 1e-6f;
#ifndef ABL
#define ABL 0
#endif
#ifndef GATHER_SYNC
#define GATHER_SYNC 0
#endif
#ifndef REP_ATT
#define REP_ATT 1
#endif
#ifndef REP_PEER
#define REP_PEER 1
#endif
#ifndef REP_GEMM
#define REP_GEMM 1
#endif
#ifndef REP_ROUTE
#define REP_ROUTE 1
#endif
#ifndef REP_OUTP
#define REP_OUTP 1
#endif
#ifndef REP_ML
#define REP_ML 1
#endif
#ifndef REP_MISC
#define REP_MISC 1
#endif
constexpr float QSCALE = 0.125f * 1.4426950408889634f;

constexpr size_t MiB = 1u << 20;
constexpr size_t WS_CTL = 0, WS_MOD = 1 * MiB, WS_ROPE = 2 * MiB, WS_WG = 4 * MiB, WS_KEYS = 5 * MiB, WS_MLMETA = 6 * MiB,
                 WS_GATES = 7 * MiB, WS_WIN = 10 * MiB, WS_WOUT = 34 * MiB, WS_WQ = 42 * MiB, WS_PU = 50 * MiB, WS_PV = 114 * MiB, WS_PSC = 178 * MiB  ,
                 WS_XCUR = 306 * MiB, WS_H = 438 * MiB, WS_MIX = 504 * MiB, WS_PROJ = 570 * MiB, WS_ULOC = 768 * MiB, WS_V8T = 836 * MiB  , WS_END = 858 * MiB;
constexpr int USTRIDE = 4160;

constexpr int LDS_BYTES = 139264;

#define LAS __attribute__((address_space(3)))
typedef unsigned short bf16_t;
typedef short bf16x8 __attribute__((ext_vector_type(8)));
typedef short s16x4 __attribute__((ext_vector_type(4)));
typedef float f32x4 __attribute__((ext_vector_type(4)));
typedef float f32x16 __attribute__((ext_vector_type(16)));
typedef unsigned u32x4 __attribute__((ext_vector_type(4)));
typedef unsigned u32x2 __attribute__((ext_vector_type(2)));
typedef __bf16 bf16x2v __attribute__((ext_vector_type(2)));
typedef int i32x8 __attribute__((ext_vector_type(8)));
typedef float f32x2 __attribute__((ext_vector_type(2)));

struct KArgs {
  const float* in[23];
  float* out;
  unsigned char* ws;
  int ph_lo, ph_hi;
};
typedef const float* const __attribute__((address_space(4))) * InTab;
struct Params {
  InTab in;
  float* out;
  unsigned char* ws;
  int ph_lo, ph_hi;
  int bx, gx;
  unsigned* xbar_words; unsigned xbar_x; unsigned lds_st_off;
};
enum { I_X = 0, I_C, I_CTX, I_CCTX, I_ADAW, I_ADAB, I_N1G, I_N2G, I_WIN, I_CONVW, I_CONVB, I_CLNG, I_CLNB, I_GATEB, I_MNORMG, I_DLAM, I_DNORMG,
       I_WOUT, I_PWQ, I_PKEYS, I_PU, I_PV, I_FINALG };

__device__ __forceinline__ unsigned cvtpk(float lo, float hi) { unsigned r; asm volatile("v_cvt_pk_bf16_f32 %0, %1, %2" : "=v"(r) : "v"(lo), "v"(hi)); return r; }
__device__ __forceinline__ float bflo(unsigned u) { return __uint_as_float(u << 16); }
__device__ __forceinline__ float bfhi(unsigned u) { return __uint_as_float(u & 0xffff0000u); }
__device__ __forceinline__ float bf1(bf16_t u) { return __uint_as_float(((unsigned)u) << 16); }
__device__ __forceinline__ int crow(int r, int hi) { return (r & 3) + 8 * (r >> 2) + 4 * hi; }
__device__ __forceinline__ float wave_sum(float v) {
#pragma unroll
  for (int o = 1; o < 64; o <<= 1) v += __shfl_xor(v, o);
  return v;
}
__device__ __forceinline__ float wave_max(float v) {
#pragma unroll
  for (int o = 1; o < 64; o <<= 1) v = fmaxf(v, __shfl_xor(v, o));
  return v;
}
__device__ __forceinline__ float sigmoidf_(float x) { return 1.f / (1.f + __expf(-x)); }
__device__ __forceinline__ float logsigmoidf_(float x) { return fminf(x, 0.f) - log1pf(__expf(-fabsf(x))); }
__device__ __forceinline__ const float* in_row(const float* x, const float* ctx, int row) {
  const int b = row / SEGL, s = row - b * SEGL;
  return s < CTXL ? ctx + ((size_t)(b * CTXL + s)) * DM : x + ((size_t)(b * SEQ + (s - CTXL))) * DM;
}
__device__ __forceinline__ int mod_row(int row) { const int b = row / SEGL, s = row - b * SEGL; return s < CTXL ? 4 : b; }

__device__ __forceinline__ void p0_mod(const Params& p, unsigned char* lds, float* MOD) {
  float* sil = (float*)lds;
  float* red = (float*)(lds + 20480);
  int tid_ = threadIdx.x; asm volatile("" : "+v"(tid_)); const int tid = tid_, lane = tid & 63, wid = tid >> 6;
  for (int i = tid; i < 5 * 1024; i += 512) {
    const float v = i < 4096 ? p.in[I_C][i] : p.in[I_CCTX][i - 4096];
    sil[i] = v / (1.f + __expf(-v));
  }
  __syncthreads();
  for (int item = p.bx; item < DEPTH * 96; item += p.gx) {
    const int l = item / 96, j0 = (item % 96) * 64;
    const float* W = p.in[I_ADAW] + (size_t)l * DM * 6144 + j0 + lane;
    float a0 = 0.f, a1 = 0.f, a2 = 0.f, a3 = 0.f, a4 = 0.f;
    const int k0 = wid * 128;
#pragma unroll 8
    for (int k = k0; k < k0 + 128; ++k) {
      const float w = W[(size_t)k * 6144];
      a0 += sil[k] * w; a1 += sil[1024 + k] * w; a2 += sil[2048 + k] * w; a3 += sil[3072 + k] * w; a4 += sil[4096 + k] * w;
    }
    red[(wid * 5 + 0) * 64 + lane] = a0; red[(wid * 5 + 1) * 64 + lane] = a1; red[(wid * 5 + 2) * 64 + lane] = a2;
    red[(wid * 5 + 3) * 64 + lane] = a3; red[(wid * 5 + 4) * 64 + lane] = a4;
    __syncthreads();
    if (tid < 320) {
      const int r = tid >> 6;
      float s = 0.f;
#pragma unroll
      for (int w = 0; w < 8; ++w) s += red[(w * 5 + r) * 64 + lane];
      MOD[((size_t)l * 5 + r) * 6144 + j0 + lane] = s + p.in[I_ADAB][l * 6144 + j0 + lane];
    }
    __syncthreads();
  }
}
__device__ __forceinline__ void transpose_item(const float* W, int ldw, int srccol0, bf16_t* WT, int K, int n0, int k0, float* scr, int lane) {
#pragma unroll 8
  for (int i = 0; i < 32; ++i) { const int kk = 2 * i + (lane >> 5); scr[kk * 33 + (lane & 31)] = W[(size_t)(k0 + kk) * ldw + srccol0 + (lane & 31)]; }
  asm volatile("s_waitcnt lgkmcnt(0)" ::: "memory");
  const int c = lane & 7;
#pragma unroll
  for (int j = 0; j < 4; ++j) {
    const int n = (lane >> 3) + 8 * j; const float* s = scr + (8 * c) * 33 + n;
    u32x4 o; o.x = cvtpk(s[0], s[33]); o.y = cvtpk(s[66], s[99]); o.z = cvtpk(s[132], s[165]); o.w = cvtpk(s[198], s[231]);
    *(u32x4*)(WT + (size_t)(n0 + n) * K + k0 + 8 * c) = o;
  }
  asm volatile("s_waitcnt lgkmcnt(0)" ::: "memory");
}
__device__ __forceinline__ void convert_tables(const Params& p, int L, int wv, int nw, int lane) {
  unsigned char* PUq = p.ws + WS_PU; unsigned char* PVq = p.ws + WS_PV; float* PSC = (float*)(p.ws + WS_PSC);
  const int nrows = DEPTH * NEXP;
  for (int r = wv; r < 2 * NEXP; r += nw) {
    const int tb = r >= NEXP, rr = L * NEXP + (tb ? r - NEXP : r);
    const f32x4* srow = (const f32x4*)((tb ? p.in[I_PV] : p.in[I_PU]) + (size_t)rr * DM) + lane * 4;
    f32x4 v[4]; float mx = 0.f;
#pragma unroll
    for (int j = 0; j < 4; ++j) { v[j] = __builtin_nontemporal_load(srow + j); mx = fmaxf(mx, fmaxf(fmaxf(fabsf(v[j].x), fabsf(v[j].y)), fmaxf(fabsf(v[j].z), fabsf(v[j].w)))); }
    mx = wave_max(mx);
    const int eb = (int)((__float_as_uint(mx) >> 23) & 0xFFu);
    int sb = 261 - eb; sb = sb < 1 ? 1 : (sb > 253 ? 253 : sb);
    const float sc = __uint_as_float((unsigned)sb << 23), isc = __uint_as_float((unsigned)(254 - sb) << 23);
    u32x4 o;
    int w;
#define CV4(V, OUT) w = 0; w = __builtin_amdgcn_cvt_pk_fp8_f32(V.x * sc, V.y * sc, w, false); w = __builtin_amdgcn_cvt_pk_fp8_f32(V.z * sc, V.w * sc, w, true); OUT = (unsigned)w
    CV4(v[0], o.x); CV4(v[1], o.y); CV4(v[2], o.z); CV4(v[3], o.w);
#undef CV4
    *(u32x4*)((tb ? PVq : PUq) + (size_t)rr * DM + lane * 16) = o;
    if (lane == 0) PSC[(size_t)tb * nrows + rr] = isc;
  }
}
__device__ __forceinline__ void tail_filler_tables(const Params& p, int L, int nwg) {
  int tid_ = threadIdx.x; asm volatile("" : "+v"(tid_)); const int lane = tid_ & 63, wid = tid_ >> 6;
  const int nextra = nwg % p.gx, first = nextra, nidle = p.gx - nextra;
  if (p.bx < first) return;
  convert_tables(p, L, (p.bx - first) * 8 + wid, nidle * 8, lane);
}
__device__ __forceinline__ void p0_convert(const Params& p, unsigned char* lds) {
  int tid_ = threadIdx.x; asm volatile("" : "+v"(tid_)); const int tid = tid_, lane = tid & 63, wid = tid >> 6;
  const int gw = p.bx * 8 + wid, NGW = p.gx * 8;
  const size_t gt = (size_t)p.bx * 512 + tid, NGT = (size_t)p.gx * 512;
  float* scr = (float*)(lds + 32768) + wid * (64 * 33);
  bf16_t* WIN = (bf16_t*)(p.ws + WS_WIN); bf16_t* WOUT = (bf16_t*)(p.ws + WS_WOUT); bf16_t* WQ = (bf16_t*)(p.ws + WS_WQ);
  constexpr int I_IN = 16 * 96, I_O = 16 * 32, PER_L = I_IN + 2 * I_O;
  for (int it = gw; it < DEPTH * PER_L; it += NGW) {
    const int l = it / PER_L; int r = it % PER_L;
    if (r < I_IN) { const int kb = r / 96, nb = r % 96, n0 = nb * 32; const int src = n0 < 1536 ? n0 : n0 + 16;
      transpose_item(p.in[I_WIN] + (size_t)l * DM * IN_W, IN_W, src, WIN + (size_t)l * PW * DM, DM, n0, kb * 64, scr, lane); continue; }
    r -= I_IN;
    if (r < I_O) { const int kb = r / 32, nb = r % 32;
      transpose_item(p.in[I_WOUT] + (size_t)l * DM * DM, DM, nb * 32, WOUT + (size_t)l * DM * DM, DM, nb * 32, kb * 64, scr, lane); continue; }
    r -= I_O;
    { const int kb = r / 32, nb = r % 32;
      transpose_item(p.in[I_PWQ] + (size_t)l * DM * DM, DM, nb * 32, WQ + (size_t)l * DM * DM, DM, nb * 32, kb * 64, scr, lane); }
  }
  bf16_t* WG = (bf16_t*)(p.ws + WS_WG);
  for (size_t i = gt; i < (size_t)DEPTH * 16 * DM; i += NGT) {
    const int l = (int)(i / (16 * DM)), g = (int)((i / DM) % 16), k = (int)(i % DM);
    WG[i] = (bf16_t)(cvtpk(p.in[I_WIN][(size_t)l * DM * IN_W + (size_t)k * IN_W + 1536 + g], 0.f) & 0xffffu);
  }
  bf16_t* KEYS = (bf16_t*)(p.ws + WS_KEYS);
  for (size_t i = gt; i < (size_t)DEPTH * 131072 / 8; i += NGT) {
    const f32x4 a = ((const f32x4*)p.in[I_PKEYS])[2 * i], b = ((const f32x4*)p.in[I_PKEYS])[2 * i + 1];
    u32x4 o; o.x = cvtpk(a.x, a.y); o.y = cvtpk(a.z, a.w); o.z = cvtpk(b.x, b.y); o.w = cvtpk(b.z, b.w);
    ((u32x4*)KEYS)[i] = o;
  }
  {
    float* RC = (float*)(p.ws + WS_ROPE); float* RS = RC + SEQ * 32;
    for (size_t i = gt; i < (size_t)SEQ * 32; i += NGT) {
      const int pos = (int)(i >> 5), j = (int)(i & 31);
      const int rr = pos >> 6, cc = pos & 63;
      const int jj = j & 15;
      const double e = -(double)jj * 0.83048202372184058696;
      const double fl = __builtin_floor(e); const double f = e - fl;
      const double z = f * 0.69314718055994530942;
      double ez = 1.0 + z * (1.0 + z * (0.5 + z * (1.0 / 6 + z * (1.0 / 24 + z * (1.0 / 120 + z * (1.0 / 720 + z * (1.0 / 5040 + z * (1.0 / 40320 + z * (1.0 / 362880 + z * (1.0 / 3628800 + z * (1.0 / 39916800 + z * (1.0 / 479001600))))))))))));
      const double inv = __builtin_ldexp(ez, (int)fl);
      const float invf = (float)inv;
      const float angf = (float)(j < 16 ? rr : cc) * invf;
      const double ang = (double)angf;
      const double kq = __builtin_rint(ang * 0.63661977236758134308);
      double r = __builtin_fma(-kq, 1.57079632679489655800e+00, ang);
      r = __builtin_fma(-kq, 6.12323399573676603587e-17, r);
      const double r2 = r * r;
      const double sn = r * (1.0 + r2 * (-1.0 / 6 + r2 * (1.0 / 120 + r2 * (-1.0 / 5040 + r2 * (1.0 / 362880 + r2 * (-1.0 / 39916800 + r2 * (1.0 / 6227020800.0)))))));
      const double cs = 1.0 + r2 * (-0.5 + r2 * (1.0 / 24 + r2 * (-1.0 / 720 + r2 * (1.0 / 40320 + r2 * (-1.0 / 3628800 + r2 * (1.0 / 479001600 + r2 * (-1.0 / 87178291200.0)))))));
      const int q = ((int)kq) & 3;
      double co, si;
      if (q == 0) { co = cs; si = sn; } else if (q == 1) { co = -sn; si = cs; } else if (q == 2) { co = -cs; si = -sn; } else { co = sn; si = -cs; }
      RC[i] = (float)co; RS[i] = (float)si;
    }
  }
}

__device__ __forceinline__ void norm_mod_row(const float* xrow, const float* g, const float* sc, const float* sh, bf16_t* orow, int lane) {
  const f32x4* xr = (const f32x4*)xrow + lane;
  f32x4 v[4]; float s = 0.f;
#pragma unroll
  for (int j = 0; j < 4; ++j) { v[j] = xr[64 * j]; s += (v[j].x * v[j].x + v[j].y * v[j].y) + (v[j].z * v[j].z + v[j].w * v[j].w); }
  const float rs = rsqrtf(wave_sum(s) * (1.f / DM) + EPS);
  u32x2* o = (u32x2*)orow + lane;
#pragma unroll
  for (int j = 0; j < 4; ++j) {
    const f32x4 gg = ((const f32x4*)g)[lane + 64 * j], cc = ((const f32x4*)sc)[lane + 64 * j], hh = ((const f32x4*)sh)[lane + 64 * j];
    const float y0 = v[j].x * rs * gg.x * (1.f + cc.x) + hh.x, y1 = v[j].y * rs * gg.y * (1.f + cc.y) + hh.y;
    const float y2 = v[j].z * rs * gg.z * (1.f + cc.z) + hh.z, y3 = v[j].w * rs * gg.w * (1.f + cc.w) + hh.w;
    u32x2 w; w.x = cvtpk(y0, y1); w.y = cvtpk(y2, y3);
    o[64 * j] = w;
  }
}
__device__ __forceinline__ void phase_norm(const Params& p, int l, int which, bool from_input, bool skip_ctx) {
  int tid_ = threadIdx.x; asm volatile("" : "+v"(tid_));
  const int lane = tid_ & 63, wid = tid_ >> 6;
  const int gw = p.bx * 8 + wid, NGW = p.gx * 8;
  const float* MOD = (const float*)(p.ws + WS_MOD);
  const float* XC = (const float*)(p.ws + WS_XCUR);
  bf16_t* H = (bf16_t*)(p.ws + WS_H);
  const float* g = p.in[which ? I_N2G : I_N1G] + l * DM;
  for (int row = gw; row < T; row += NGW) {
    const int mr = mod_row(row);
    if (skip_ctx && mr == 4) continue;
    const float* m = MOD + ((size_t)l * 5 + mr) * 6144 + which * 3072;
    const float* xr = from_input ? in_row(p.in[I_X], p.in[I_CTX], row) : XC + (size_t)row * DM;
    norm_mod_row(xr, g, m + 1024, m, H + (size_t)row * DM, lane);
  }
}

namespace pg8 {
#define PG8_LAS __attribute__((address_space(3)))
typedef unsigned short bf16_t;
typedef short bf16x8 __attribute__((ext_vector_type(8)));
typedef float f32x4 __attribute__((ext_vector_type(4)));
typedef unsigned u32x4 __attribute__((ext_vector_type(4)));
constexpr int BM = 256, BK = 64, HALF = 128, HTB = HALF * BK * 2  , STAGE_BYTES = 8 * HTB, NXCD = 8, WGM = 8;

__host__ __device__ __forceinline__ int lds_byte(int r, int c) { const int st = (r >> 4) * 2 + (c >> 5), rr = r & 15, cc = c & 31, ob = rr * 64 + cc * 2; return st * 1024 + (ob ^ (((ob >> 9) & 1) << 5)); }
__host__ __device__ __forceinline__ void stage_rc(int b, int& R, int& C) { const int st = b / 1024, sb = b % 1024, swz = sb ^ (((sb >> 9) & 1) << 5); R = (st >> 1) * 16 + swz / 64; C = (st & 1) * 32 + (swz % 64) / 2; }
__host__ __device__ __forceinline__ int perm32(int rho) { const int n = rho >> 4, i = rho & 15; return 8 * (i >> 2) + 4 * n + (i & 3); }

struct Unit { int pm, pn; };
struct Gemm { const bf16_t* A; const bf16_t* Bt; int M, N, K; };

struct StaticOrder {
    int nM, nN, nwg, G, c;
    __host__ __device__ void init(int M, int N, int G_, int c_) { nM = M / BM; nN = N / BM; nwg = nM * nN; G = G_; c = c_; }
    __host__ __device__ bool next(int i, Unit& u) const {
        const long L = (long)i * G + c; if (L >= nwg) return false;
        int wgid = (int)L; { const int q = nwg / NXCD, r = nwg % NXCD, xcd = wgid % NXCD, off = wgid / NXCD; wgid = (xcd < r ? xcd * (q + 1) : r * (q + 1) + (xcd - r) * q) + off; }
        const int nig = WGM * nN, gid = wgid / nig, fm = gid * WGM, gsz = (nM - fm) < WGM ? (nM - fm) : WGM;
        u.pm = fm + ((wgid % nig) % gsz); u.pn = (wgid % nig) / gsz; return true;
    }
    __device__ __forceinline__ void a_ready(const Unit&) const {}
    __device__ __forceinline__ void done(const Unit&) const {}
};
__device__ __forceinline__ unsigned cvt_pk_bf16(float lo, float hi) { unsigned r; asm volatile("v_cvt_pk_bf16_f32 %0, %1, %2" : "=v"(r) : "v"(lo), "v"(hi)); return r; }
template <class Epi, class Sched, bool ALIGN_EPI = false, bool SP2 = false>
__device__ __forceinline__ void gemm_phase(PG8_LAS unsigned char* lds, const Gemm g, const Sched& S, const Epi& E) {
    const int tid = threadIdx.x, wid = __builtin_amdgcn_readfirstlane(tid >> 6), lane = tid & 63, wr = wid >> 2, wc = wid & 3, fr = lane & 15, fq = lane >> 4;
    const int K = g.K, nt = K / BK;
    unsigned voffA[2], voffB[2];
#pragma unroll
    for (int i = 0; i < 2; ++i) { int R, C; stage_rc(tid * 16 + i * 8192, R, C); const int Rb = Epi::PERM ? ((R & ~31) + perm32(R & 31)) : R;
        voffA[i] = (unsigned)(R * K + C) * 2u; voffB[i] = (unsigned)(Rb * K + C) * 2u; }
    const size_t kstep = (size_t)(BK * 2);
    const size_t hstep = (size_t)HALF * K * 2;
    const size_t tstep = 2 * hstep;
    const unsigned ldsw = (unsigned)wid * 1024u;
    const int aoff = lds_byte(wr * 64 + fr, fq * 8), boff = lds_byte(wc * 32 + fr, fq * 8);
#define PG8_SA(b, h) (((b) * 2 + (h)) * HTB)
#define PG8_SB(b, h) ((4 + (b) * 2 + (h)) * HTB)
#define PG8_STAGE(bufoff, gbase, voff) do { _Pragma("unroll") for (int _i = 0; _i < 2; ++_i) \
        __builtin_amdgcn_global_load_lds((const unsigned*)((const char*)(gbase) + (voff)[_i]), (PG8_LAS unsigned*)(lds + (bufoff) + ldsw + _i * 8192), 16, 0, 0); } while (0)
#define PG8_LDA(dst, b, h) do { _Pragma("unroll") for (int m = 0; m < 4; ++m) _Pragma("unroll") for (int k = 0; k < 2; ++k) dst[m][k] = *(const PG8_LAS bf16x8*)(lds + PG8_SA(b, h) + aoff + m * 2048 + k * 1024); } while (0)
#define PG8_LDB(dst, b, h) do { _Pragma("unroll") for (int n = 0; n < 2; ++n) _Pragma("unroll") for (int k = 0; k < 2; ++k) dst[n][k] = *(const PG8_LAS bf16x8*)(lds + PG8_SB(b, h) + boff + n * 2048 + k * 1024); } while (0)
#define PG8_MMA(ai, bj, At, Bt) do { __builtin_amdgcn_s_setprio(1); _Pragma("unroll") for (int m = 0; m < 4; ++m) _Pragma("unroll") for (int n = 0; n < 2; ++n) _Pragma("unroll") for (int k = 0; k < 2; ++k) \
        acc[ai][bj][m][n] = __builtin_amdgcn_mfma_f32_16x16x32_bf16(Bt[n][k], At[m][k], acc[ai][bj][m][n], 0, 0, 0); __builtin_amdgcn_s_setprio(0); } while (0)
#define PG8_WAIT_V(n) asm volatile("s_waitcnt vmcnt(" #n ")" ::: "memory")
#define PG8_WAIT_L(n) asm volatile("s_waitcnt lgkmcnt(" #n ")" ::: "memory")
#define PG8_BAR __builtin_amdgcn_s_barrier()
#define PG8_SCHED __builtin_amdgcn_sched_barrier(0)
    Unit cur, nxt; int ui = 0;
    if (!S.next(0, cur)) return;
    f32x4 acc[2][2][4][2];
#pragma unroll
    for (int a = 0; a < 2; ++a)
#pragma unroll
        for (int b = 0; b < 2; ++b)
#pragma unroll
            for (int m = 0; m < 4; ++m)
#pragma unroll
                for (int n = 0; n < 2; ++n) acc[a][b][m][n] = (f32x4){0.f, 0.f, 0.f, 0.f};
    bf16x8 At[4][2], B0[2][2], B1[2][2];
    const char* cA = (const char*)g.A + (size_t)cur.pm * tstep; const char* cB = (const char*)g.Bt + (size_t)cur.pn * tstep;
    S.a_ready(cur);
    if constexpr (SP2) {
        PG8_STAGE(PG8_SB(0, 0), cB, voffB); PG8_STAGE(PG8_SB(0, 1), cB + hstep, voffB); PG8_STAGE(PG8_SA(0, 0), cA, voffA); PG8_STAGE(PG8_SA(0, 1), cA + hstep, voffA);
        if (wr == 1) PG8_BAR;
        PG8_WAIT_V(2); PG8_BAR;
        PG8_STAGE(PG8_SB(1, 0), cB + kstep, voffB); PG8_STAGE(PG8_SA(1, 0), cA + kstep, voffA); PG8_STAGE(PG8_SB(1, 1), cB + hstep + kstep, voffB);
        PG8_WAIT_V(6); PG8_BAR;
    } else {
        PG8_STAGE(PG8_SB(0, 0), cB, voffB); PG8_STAGE(PG8_SA(0, 0), cA, voffA); PG8_STAGE(PG8_SB(0, 1), cB + hstep, voffB); PG8_STAGE(PG8_SA(0, 1), cA + hstep, voffA);
        if (wr == 1) PG8_BAR;
        PG8_WAIT_V(4); PG8_BAR;
        PG8_STAGE(PG8_SB(1, 0), cB + kstep, voffB); PG8_STAGE(PG8_SA(1, 0), cA + kstep, voffA); PG8_STAGE(PG8_SB(1, 1), cB + hstep + kstep, voffB);
        PG8_WAIT_V(6); PG8_BAR;
    }
    for (;;) {
        const bool has_next = S.next(ui + 1, nxt);
        const char* nA = has_next ? (const char*)g.A + (size_t)nxt.pm * tstep : cA; const char* nB = has_next ? (const char*)g.Bt + (size_t)nxt.pn * tstep : cB;
        for (int t = 0; t < nt; t += 2) {
            const bool last = (t == nt - 2);
            const char* a1 = cA + (size_t)(t + 1) * kstep;
            const char* a2 = last ? nA : cA + (size_t)(t + 2) * kstep; const char* b2 = last ? nB : cB + (size_t)(t + 2) * kstep;
            const char* a3 = a2 + kstep; const char* b3 = b2 + kstep;
            if (last && has_next) S.a_ready(nxt);
            if constexpr (SP2) {
            PG8_LDB(B0, 0, 0); PG8_LDB(B1, 0, 1); PG8_SCHED; PG8_LDA(At, 0, 0); PG8_STAGE(PG8_SA(1, 1), a1 + hstep, voffA);
            PG8_WAIT_V(8); PG8_WAIT_L(0); PG8_BAR; PG8_MMA(0, 0, At, B0); PG8_MMA(0, 1, At, B1); PG8_BAR; PG8_SCHED;
            PG8_LDA(At, 0, 1); PG8_STAGE(PG8_SB(0, 0), b2, voffB); PG8_STAGE(PG8_SB(0, 1), b2 + hstep, voffB); PG8_STAGE(PG8_SA(0, 0), a2, voffA);
            PG8_WAIT_V(8); PG8_WAIT_L(0); PG8_BAR; PG8_MMA(1, 0, At, B0); PG8_MMA(1, 1, At, B1); PG8_BAR; PG8_SCHED;
            PG8_LDB(B0, 1, 0); PG8_LDB(B1, 1, 1); PG8_SCHED; PG8_LDA(At, 1, 0); PG8_STAGE(PG8_SA(0, 1), a2 + hstep, voffA);
            PG8_WAIT_V(8); PG8_WAIT_L(0); PG8_BAR; PG8_MMA(0, 0, At, B0); PG8_MMA(0, 1, At, B1); PG8_BAR; PG8_SCHED;
            PG8_LDA(At, 1, 1); PG8_STAGE(PG8_SB(1, 0), b3, voffB); PG8_STAGE(PG8_SB(1, 1), b3 + hstep, voffB); PG8_STAGE(PG8_SA(1, 0), a3, voffA);
            PG8_WAIT_V(8); PG8_WAIT_L(0); PG8_BAR; PG8_MMA(1, 0, At, B0); PG8_MMA(1, 1, At, B1); PG8_BAR; PG8_SCHED;
            } else {
            PG8_LDB(B0, 0, 0); PG8_SCHED; PG8_LDA(At, 0, 0); PG8_STAGE(PG8_SA(1, 1), a1 + hstep, voffA);
            PG8_WAIT_L(8); PG8_BAR; PG8_WAIT_L(0); PG8_MMA(0, 0, At, B0); PG8_BAR; PG8_SCHED;
            PG8_LDB(B1, 0, 1); PG8_STAGE(PG8_SB(0, 0), b2, voffB);
            PG8_BAR; PG8_WAIT_L(0); PG8_MMA(0, 1, At, B1); PG8_BAR;
            PG8_LDA(At, 0, 1); PG8_STAGE(PG8_SA(0, 0), a2, voffA);
            PG8_BAR; PG8_WAIT_L(0); PG8_MMA(1, 0, At, B0); PG8_BAR; PG8_SCHED;
            PG8_STAGE(PG8_SB(0, 1), b2 + hstep, voffB);
            PG8_WAIT_V(6); PG8_BAR; PG8_MMA(1, 1, At, B1); PG8_BAR;
            PG8_LDB(B0, 1, 0); PG8_SCHED; PG8_LDA(At, 1, 0); PG8_STAGE(PG8_SA(0, 1), a2 + hstep, voffA);
            PG8_WAIT_L(8); PG8_BAR; PG8_WAIT_L(0); PG8_MMA(0, 0, At, B0); PG8_BAR; PG8_SCHED;
            PG8_LDB(B1, 1, 1); PG8_STAGE(PG8_SB(1, 0), b3, voffB);
            PG8_BAR; PG8_WAIT_L(0); PG8_MMA(0, 1, At, B1); PG8_BAR;
            PG8_LDA(At, 1, 1); PG8_STAGE(PG8_SA(1, 0), a3, voffA);
            PG8_BAR; PG8_WAIT_L(0); PG8_MMA(1, 0, At, B0); PG8_BAR; PG8_SCHED;
            PG8_STAGE(PG8_SB(1, 1), b3 + hstep, voffB);
            PG8_WAIT_V(6); PG8_BAR; PG8_MMA(1, 1, At, B1); PG8_BAR;
            }
        }
        if constexpr (ALIGN_EPI) { if (wr == 0) PG8_BAR; }
        if constexpr (!Epi::AFTER_DRAIN) { E(acc, cur, wr, wc, fr, fq); S.done(cur); }
        if (!has_next) break;
#pragma unroll
        for (int a = 0; a < 2; ++a)
#pragma unroll
            for (int b = 0; b < 2; ++b)
#pragma unroll
                for (int m = 0; m < 4; ++m)
#pragma unroll
                    for (int n = 0; n < 2; ++n) acc[a][b][m][n] = (f32x4){0.f, 0.f, 0.f, 0.f};
        cur = nxt; cA = nA; cB = nB; ++ui;
        if constexpr (ALIGN_EPI) { if (wr == 1) PG8_BAR; }
    }
    PG8_WAIT_V(0);
    if constexpr (!ALIGN_EPI) { if (wr == 0) PG8_BAR; }
    PG8_BAR;
    if constexpr (Epi::AFTER_DRAIN) { E.fused(acc, cur, wr, wc, fr, fq, lds, wid, lane); S.done(cur); }
#undef PG8_SA
#undef PG8_SB
#undef PG8_STAGE
#undef PG8_LDA
#undef PG8_LDB
#undef PG8_MMA
#undef PG8_WAIT_V
#undef PG8_WAIT_L
#undef PG8_BAR
#undef PG8_SCHED
}
}

__device__ __forceinline__ int gswz(int row, int chunk) { return row * 128 + ((chunk ^ ((row >> 1) & 7)) << 4); }
__device__ __forceinline__ void gemm_tile(const bf16_t* __restrict__ A, int lda, const bf16_t* __restrict__ Bt, int ldb, int K,
                                          int row0, int col0, unsigned char* lds, f32x16 (&acc)[2][2]) {
  int tid_ = threadIdx.x; asm volatile("" : "+v"(tid_)); const int tid = tid_, lane = tid & 63, wid = tid >> 6, wm = wid >> 1, wn = wid & 1, r32 = lane & 31, hi = lane >> 5;
  unsigned char* As = lds; unsigned char* Bs = lds + 65536;
#pragma unroll
  for (int i = 0; i < 2; ++i)
#pragma unroll
    for (int j = 0; j < 2; ++j) acc[i][j] = f32x16{};
  const int lrow = tid >> 3, lc = tid & 7;
  const bf16_t* Ag = A + (size_t)(row0 + lrow) * lda + lc * 8;
  const bf16_t* Bg = Bt + (size_t)(col0 + lrow) * ldb + lc * 8;
  u32x4 ra[4], rb[2];
#pragma unroll
  for (int i = 0; i < 4; ++i) ra[i] = *(const u32x4*)(Ag + (size_t)(64 * i) * lda);
#pragma unroll
  for (int i = 0; i < 2; ++i) rb[i] = *(const u32x4*)(Bg + (size_t)(64 * i) * ldb);
#pragma unroll
  for (int i = 0; i < 4; ++i) *(u32x4*)(As + gswz(lrow + 64 * i, lc)) = ra[i];
#pragma unroll
  for (int i = 0; i < 2; ++i) *(u32x4*)(Bs + gswz(lrow + 64 * i, lc)) = rb[i];
  __syncthreads();
  const int nk = K / 64;
  for (int kt = 0; kt < nk; ++kt) {
    const int cur = kt & 1;
    if (kt + 1 < nk) {
#pragma unroll
      for (int i = 0; i < 4; ++i) ra[i] = *(const u32x4*)(Ag + (size_t)(64 * i) * lda + (kt + 1) * 64);
#pragma unroll
      for (int i = 0; i < 2; ++i) rb[i] = *(const u32x4*)(Bg + (size_t)(64 * i) * ldb + (kt + 1) * 64);
    }
    const unsigned char* Ac = As + cur * 32768; const unsigned char* Bc = Bs + cur * 16384;
#pragma unroll
    for (int kk = 0; kk < 4; ++kk) {
      bf16x8 af[2], bfr[2];
#pragma unroll
      for (int i = 0; i < 2; ++i) af[i] = *(const bf16x8*)(Ac + gswz(wm * 64 + i * 32 + r32, 2 * kk + hi));
#pragma unroll
      for (int j = 0; j < 2; ++j) bfr[j] = *(const bf16x8*)(Bc + gswz(wn * 64 + j * 32 + r32, 2 * kk + hi));
#pragma unroll
      for (int i = 0; i < 2; ++i)
#pragma unroll
        for (int j = 0; j < 2; ++j) acc[i][j] = __builtin_amdgcn_mfma_f32_32x32x16_bf16(af[i], bfr[j], acc[i][j], 0, 0, 0);
    }
    if (kt + 1 < nk) {
      unsigned char* An = As + (cur ^ 1) * 32768; unsigned char* Bn = Bs + (cur ^ 1) * 16384;
#pragma unroll
      for (int i = 0; i < 4; ++i) *(u32x4*)(An + gswz(lrow + 64 * i, lc)) = ra[i];
#pragma unroll
      for (int i = 0; i < 2; ++i) *(u32x4*)(Bn + gswz(lrow + 64 * i, lc)) = rb[i];
    }
    __syncthreads();
  }
}
__device__ __forceinline__ void pair_xchg(float v0, float v1, int lane, float& lo, float& hi2) {
  const bool odd = lane & 1;
  const float send = odd ? v0 : v1;
  const float recv = __shfl_xor(send, 1);
  lo = odd ? recv : v0; hi2 = odd ? v1 : recv;
}

__device__ __forceinline__ void phase_inproj(const Params& p, int l, unsigned char* lds) {
  int tid_ = threadIdx.x; asm volatile("" : "+v"(tid_)); const int tid = tid_, lane = tid & 63, wid = tid >> 6, wm = wid >> 1, wn = wid & 1, r32 = lane & 31, hi = lane >> 5;
  const bf16_t* H = (const bf16_t*)(p.ws + WS_H);
  const bf16_t* W = (const bf16_t*)(p.ws + WS_WIN) + (size_t)l * PW * DM;
  bf16_t* PROJ = (bf16_t*)(p.ws + WS_PROJ);
  const float* RC = (const float*)(p.ws + WS_ROPE); const float* RS = RC + SEQ * 32;
  constexpr int NM = T / 256, NN = PW / 128, NU = NM * NN;
  for (int u = p.bx; u < NU + NM; u += p.gx) {
    if (u < NU) {
      const int pn = u / NM, pm = u % NM;
      const int row0 = pm * 256, col0 = pn * 128;
      f32x16 acc[2][2];
      gemm_tile(H, DM, W, DM, DM, row0, col0, lds, acc);
      const bool rope = (col0 >= C_DQ && col0 < C_DV);
      const float scl = (col0 >= C_MK && col0 < C_MV) ? 0.125f : ((col0 >= C_DQ && col0 < C_DK) ? QSCALE : 1.f);
#pragma unroll
      for (int i = 0; i < 2; ++i)
#pragma unroll
        for (int j = 0; j < 2; ++j)
#pragma unroll
          for (int q = 0; q < 8; ++q) {
            float lo, hi2; pair_xchg(acc[i][j][2 * q], acc[i][j][2 * q + 1], lane, lo, hi2);
            const int row = row0 + wm * 64 + i * 32 + crow(2 * q, hi) + (lane & 1);
            const int col = col0 + wn * 64 + j * 32 + (r32 & ~1);
            if (rope) {
              const int s = row % SEGL;
              if (s >= CTXL) {
                const int idx = (s - CTXL) * 32 + ((col & 63) >> 1);
                const float c = RC[idx], sn = RS[idx];
                const float t1 = lo, t2 = hi2; lo = t1 * c - t2 * sn; hi2 = t1 * sn + t2 * c;
              }
            }
            *(unsigned*)(PROJ + (size_t)row * PW + col) = cvtpk(lo * scl, hi2 * scl);
          }
    } else {
      const int pm = u - NU, rowb = pm * 256 + wid * 32;
      const bf16_t* WG = (const bf16_t*)(p.ws + WS_WG) + (size_t)l * 16 * DM;
      float* GT = (float*)(p.ws + WS_GATES);
      const int r16 = lane & 15, q4 = lane >> 4;
      f32x4 c0 = {0.f, 0.f, 0.f, 0.f}, c1 = {0.f, 0.f, 0.f, 0.f};
      const bf16_t* a0p = H + (size_t)(rowb + r16) * DM + q4 * 8;
      const bf16_t* a1p = a0p + (size_t)16 * DM;
      const bf16_t* bp = WG + (size_t)r16 * DM + q4 * 8;
#pragma unroll 4
      for (int ks = 0; ks < 32; ++ks) {
        const bf16x8 a0 = *(const bf16x8*)(a0p + ks * 32), a1 = *(const bf16x8*)(a1p + ks * 32), b = *(const bf16x8*)(bp + ks * 32);
        c0 = __builtin_amdgcn_mfma_f32_16x16x32_bf16(a0, b, c0, 0, 0, 0);
        c1 = __builtin_amdgcn_mfma_f32_16x16x32_bf16(a1, b, c1, 0, 0, 0);
      }
      const float gb = p.in[I_GATEB][l * 16 + r16];
#pragma unroll
      for (int j = 0; j < 4; ++j) {
        GT[(size_t)(rowb + q4 * 4 + j) * 16 + r16] = c0[j] + gb;
        GT[(size_t)(rowb + 16 + q4 * 4 + j) * 16 + r16] = c1[j] + gb;
      }
    }
  }
}

__device__ __forceinline__ void phase_outproj(const Params& p, int l, unsigned char* lds) {
  int tid_ = threadIdx.x; asm volatile("" : "+v"(tid_)); const int tid = tid_, lane = tid & 63, wid = tid >> 6, wm = wid >> 1, wn = wid & 1, r32 = lane & 31, hi = lane >> 5;
  const bf16_t* MIX = (const bf16_t*)(p.ws + WS_MIX);
  const bf16_t* W = (const bf16_t*)(p.ws + WS_WOUT) + (size_t)l * DM * DM;
  float* XC = (float*)(p.ws + WS_XCUR);
  const float* MOD = (const float*)(p.ws + WS_MOD);
  constexpr int NM = T / 256, NN = DM / 128, NU = NM * NN;
  for (int u = p.bx; u < NU; u += p.gx) {
    const int pm = u / NN, pn = u % NN;
    if (l == DEPTH - 1 && (pm % 33) == 0) continue;
    const int row0 = pm * 256, col0 = pn * 128;
    for (int rep = 0; rep < REP_OUTP; ++rep) {
    f32x16 acc[2][2];
    gemm_tile(MIX, DM, W, DM, DM, row0, col0, lds, acc);
    const int mr = (pm % 33) == 0 ? 4 : pm / 33;
    const float* g1 = MOD + ((size_t)l * 5 + mr) * 6144 + 2048;
#pragma unroll
    for (int i = 0; i < 2; ++i)
#pragma unroll
      for (int j = 0; j < 2; ++j) {
        const int col = col0 + wn * 64 + j * 32 + r32;
        const float gg = (rep == REP_OUTP - 1) ? g1[col] : 0.f;
#pragma unroll
        for (int r = 0; r < 16; ++r) {
          const int row = row0 + wm * 64 + i * 32 + crow(r, hi);
          const float xo = (l == 0) ? in_row(p.in[I_X], p.in[I_CTX], row)[col] : XC[(size_t)row * DM + col];
          XC[(size_t)row * DM + col] = xo + gg * acc[i][j][r];
        }
      }
    }
  }
}
__device__ __forceinline__ void phase_peerq(const Params& p, int l, unsigned char* lds) {
  int tid_ = threadIdx.x; asm volatile("" : "+v"(tid_)); const int tid = tid_, lane = tid & 63, wid = tid >> 6, wm = wid >> 1, wn = wid & 1, r32 = lane & 31, hi = lane >> 5;
  const bf16_t* H = (const bf16_t*)(p.ws + WS_H);
  const bf16_t* W = (const bf16_t*)(p.ws + WS_WQ) + (size_t)l * DM * DM;
  bf16_t* QP = (bf16_t*)(p.ws + WS_PROJ);
  constexpr int NM = T / 256, NN = DM / 128, NU = NM * NN;
  for (int u = p.bx; u < NU; u += p.gx) {
    const int pm = u / NN, pn = u % NN;
    if (l == DEPTH - 1 && (pm % 33) == 0) continue;
    const int row0 = pm * 256, col0 = pn * 128;
    f32x16 acc[2][2];
    gemm_tile(H, DM, W, DM, DM, row0, col0, lds, acc);
#pragma unroll
    for (int i = 0; i < 2; ++i)
#pragma unroll
      for (int j = 0; j < 2; ++j)
#pragma unroll
        for (int q = 0; q < 8; ++q) {
          float lo, hi2; pair_xchg(acc[i][j][2 * q], acc[i][j][2 * q + 1], lane, lo, hi2);
          const int row = row0 + wm * 64 + i * 32 + crow(2 * q, hi) + (lane & 1);
          const int col = col0 + wn * 64 + j * 32 + (r32 & ~1);
          *(unsigned*)(QP + (size_t)row * DM + col) = cvtpk(lo, hi2);
        }
  }
}


struct EpiInproj {
  static constexpr bool PERM = true, AFTER_DRAIN = false;
  bf16_t* PROJ; const float* RC; const float* RS; unsigned char* V8T;
  __device__ __forceinline__ void operator()(const pg8::f32x4 (&acc)[2][2][4][2], const pg8::Unit& u, int wr, int wc, int fr, int fq) const {
#pragma unroll
    for (int bj = 0; bj < 2; ++bj) {
      const int colt = u.pn * 256 + bj * 128;
      const bool rope = (colt >= C_DQ && colt < C_DV);
      const float scl = (colt >= C_MK && colt < C_MV) ? 0.125f : ((colt >= C_DQ && colt < C_DK) ? QSCALE : 1.f);
      const int col8 = colt + wc * 32 + 8 * fq;
      if (colt >= C_DV) {
        const int hh = (col8 - C_DV) >> 7, e0 = (col8 - C_DV) & 127;
#pragma unroll
        for (int ai = 0; ai < 2; ++ai)
#pragma unroll
          for (int m = 0; m < 4; ++m) {
            const int row = u.pm * 256 + ai * 128 + wr * 64 + m * 16 + fr;
            const int b = row / SEGL, s = row - b * SEGL, t = s >> 6, kk = s & 63;
            const int slot = ((kk >> 2) & 1) * 32 + (kk & 3) + 4 * ((kk >> 3) & 3) + 16 * (kk >> 5);
            unsigned char* vp = V8T + ((size_t)((b * 4 + hh) * NCH + t) * 128 + e0) * 80 + slot;
            const f32x4 v0 = acc[ai][bj][m][0], v1 = acc[ai][bj][m][1];
            int w0 = 0, w1 = 0;
            w0 = __builtin_amdgcn_cvt_pk_fp8_f32(v0[0], v0[1], w0, false); w0 = __builtin_amdgcn_cvt_pk_fp8_f32(v0[2], v0[3], w0, true);
            w1 = __builtin_amdgcn_cvt_pk_fp8_f32(v1[0], v1[1], w1, false); w1 = __builtin_amdgcn_cvt_pk_fp8_f32(v1[2], v1[3], w1, true);
            vp[0] = (unsigned char)(w0 & 0xFF); vp[80] = (unsigned char)((w0 >> 8) & 0xFF); vp[160] = (unsigned char)((w0 >> 16) & 0xFF); vp[240] = (unsigned char)((w0 >> 24) & 0xFF);
            vp[320] = (unsigned char)(w1 & 0xFF); vp[400] = (unsigned char)((w1 >> 8) & 0xFF); vp[480] = (unsigned char)((w1 >> 16) & 0xFF); vp[560] = (unsigned char)((w1 >> 24) & 0xFF);
          }
        continue;
      }
#pragma unroll
      for (int ai = 0; ai < 2; ++ai)
#pragma unroll
        for (int m = 0; m < 4; ++m) {
          const int row = u.pm * 256 + ai * 128 + wr * 64 + m * 16 + fr;
          f32x4 v0 = acc[ai][bj][m][0], v1 = acc[ai][bj][m][1];
          if (rope) {
            const int s = row % SEGL;
            if (s >= CTXL) {
              const int idx = (s - CTXL) * 32 + ((col8 & 63) >> 1);
              const f32x4 c = *(const f32x4*)(RC + idx), sn = *(const f32x4*)(RS + idx);
              f32x4 a, b;
              a[0] = v0[0] * c[0] - v0[1] * sn[0]; a[1] = v0[0] * sn[0] + v0[1] * c[0]; a[2] = v0[2] * c[1] - v0[3] * sn[1]; a[3] = v0[2] * sn[1] + v0[3] * c[1];
              b[0] = v1[0] * c[2] - v1[1] * sn[2]; b[1] = v1[0] * sn[2] + v1[1] * c[2]; b[2] = v1[2] * c[3] - v1[3] * sn[3]; b[3] = v1[2] * sn[3] + v1[3] * c[3];
              v0 = a; v1 = b;
            }
          }
          u32x4 w; w.x = cvtpk(v0[0] * scl, v0[1] * scl); w.y = cvtpk(v0[2] * scl, v0[3] * scl); w.z = cvtpk(v1[0] * scl, v1[1] * scl); w.w = cvtpk(v1[2] * scl, v1[3] * scl);
          *(u32x4*)(PROJ + (size_t)row * PW + col8) = w;
        }
    }
  }
};
struct EpiOutproj {
  static constexpr bool PERM = true, AFTER_DRAIN = false;
  float* XC; const float* MODL; const float* xin; const float* ctxin; int first; float gsc;
  __device__ __forceinline__ void operator()(const pg8::f32x4 (&acc)[2][2][4][2], const pg8::Unit& u, int wr, int wc, int fr, int fq) const {
    const int mr = (u.pm % 33) == 0 ? 4 : u.pm / 33;
    const float* g1 = MODL + (size_t)mr * 6144 + 2048;
#pragma unroll
    for (int bj = 0; bj < 2; ++bj) {
      const int col8 = u.pn * 256 + bj * 128 + wc * 32 + 8 * fq;
      const f32x4 ga = *(const f32x4*)(g1 + col8) * gsc, gb = *(const f32x4*)(g1 + col8 + 4) * gsc;
#pragma unroll
      for (int ai = 0; ai < 2; ++ai)
#pragma unroll
        for (int m = 0; m < 4; ++m) {
          const int row = u.pm * 256 + ai * 128 + wr * 64 + m * 16 + fr;
          const float* xo = first ? in_row(xin, ctxin, row) + col8 : XC + (size_t)row * DM + col8;
          const f32x4 xa = *(const f32x4*)xo, xb = *(const f32x4*)(xo + 4);
          *(f32x4*)(XC + (size_t)row * DM + col8) = xa + ga * acc[ai][bj][m][0];
          *(f32x4*)(XC + (size_t)row * DM + col8 + 4) = xb + gb * acc[ai][bj][m][1];
        }
    }
  }
};
struct EpiPeerq {
  static constexpr bool PERM = true, AFTER_DRAIN = false;
  bf16_t* QP;
  __device__ __forceinline__ void operator()(const pg8::f32x4 (&acc)[2][2][4][2], const pg8::Unit& u, int wr, int wc, int fr, int fq) const {
#pragma unroll
    for (int bj = 0; bj < 2; ++bj) {
      const int col8 = u.pn * 256 + bj * 128 + wc * 32 + 8 * fq;
#pragma unroll
      for (int ai = 0; ai < 2; ++ai)
#pragma unroll
        for (int m = 0; m < 4; ++m) {
          const int row = u.pm * 256 + ai * 128 + wr * 64 + m * 16 + fr;
          const f32x4 v0 = acc[ai][bj][m][0], v1 = acc[ai][bj][m][1];
          u32x4 w; w.x = cvtpk(v0[0], v0[1]); w.y = cvtpk(v0[2], v0[3]); w.z = cvtpk(v1[0], v1[1]); w.w = cvtpk(v1[2], v1[3]);
          *(u32x4*)(QP + (size_t)row * DM + col8) = w;
        }
    }
  }
};
__device__ __forceinline__ void phase_inproj2(const Params& p, int l, unsigned char* lds) {
  {
    pg8::Gemm g{(const bf16_t*)(p.ws + WS_H), (const bf16_t*)(p.ws + WS_WIN) + (size_t)l * PW * DM, T, PW, DM};
    pg8::StaticOrder S; S.init(T, PW, p.gx, p.bx);
    EpiInproj E{(bf16_t*)(p.ws + WS_PROJ), (const float*)(p.ws + WS_ROPE), (const float*)(p.ws + WS_ROPE) + SEQ * 32, p.ws + WS_V8T};
    pg8::gemm_phase<EpiInproj, pg8::StaticOrder, true, true>((PG8_LAS unsigned char*)lds, g, S, E);
  }
  int tid_ = threadIdx.x; asm volatile("" : "+v"(tid_)); const int tid = tid_, lane = tid & 63, wid = tid >> 6;
  const bf16_t* H = (const bf16_t*)(p.ws + WS_H);
  for (int pm = p.bx; pm < T / 256; pm += p.gx) {
    const int rowb = pm * 256 + wid * 32;
    const bf16_t* WG = (const bf16_t*)(p.ws + WS_WG) + (size_t)l * 16 * DM;
    float* GT = (float*)(p.ws + WS_GATES);
    const int r16 = lane & 15, q4 = lane >> 4;
    f32x4 c0 = {0.f, 0.f, 0.f, 0.f}, c1 = {0.f, 0.f, 0.f, 0.f};
    const bf16_t* a0p = H + (size_t)(rowb + r16) * DM + q4 * 8;
    const bf16_t* a1p = a0p + (size_t)16 * DM;
    const bf16_t* bp = WG + (size_t)r16 * DM + q4 * 8;
#pragma unroll 4
    for (int ks = 0; ks < 32; ++ks) {
      const bf16x8 a0 = *(const bf16x8*)(a0p + ks * 32), a1 = *(const bf16x8*)(a1p + ks * 32), b = *(const bf16x8*)(bp + ks * 32);
      c0 = __builtin_amdgcn_mfma_f32_16x16x32_bf16(a0, b, c0, 0, 0, 0);
      c1 = __builtin_amdgcn_mfma_f32_16x16x32_bf16(a1, b, c1, 0, 0, 0);
    }
    const float gb = p.in[I_GATEB][l * 16 + r16];
#pragma unroll
    for (int j = 0; j < 4; ++j) {
      GT[(size_t)(rowb + q4 * 4 + j) * 16 + r16] = c0[j] + gb;
      GT[(size_t)(rowb + 16 + q4 * 4 + j) * 16 + r16] = c1[j] + gb;
    }
  }
}
__device__ __forceinline__ void phase_outproj2(const Params& p, int l, unsigned char* lds) {
  pg8::Gemm g{(const bf16_t*)(p.ws + WS_MIX), (const bf16_t*)(p.ws + WS_WOUT) + (size_t)l * DM * DM, T, DM, DM};
  pg8::StaticOrder S; S.init(T, DM, p.gx, p.bx);
  for (int rep = 0; rep < REP_OUTP; ++rep) {
  EpiOutproj E{(float*)(p.ws + WS_XCUR), (const float*)(p.ws + WS_MOD) + (size_t)l * 5 * 6144, p.in[I_X], p.in[I_CTX], l == 0, (rep == REP_OUTP - 1) ? 1.f : 0.f};
  pg8::gemm_phase<EpiOutproj, pg8::StaticOrder, true, true>((PG8_LAS unsigned char*)lds, g, S, E);
  }
  if (l < DEPTH - 1) tail_filler_tables(p, l, (T / 256) * (DM / 256));
}
__device__ __forceinline__ void phase_peerq2(const Params& p, int l, unsigned char* lds) {
  pg8::Gemm g{(const bf16_t*)(p.ws + WS_H), (const bf16_t*)(p.ws + WS_WQ) + (size_t)l * DM * DM, T, DM, DM};
  pg8::StaticOrder S; S.init(T, DM, p.gx, p.bx);
  EpiPeerq E{(bf16_t*)(p.ws + WS_PROJ)};
  pg8::gemm_phase<EpiPeerq, pg8::StaticOrder, true, true>((PG8_LAS unsigned char*)lds, g, S, E);
  if (l == DEPTH - 2) tail_filler_tables(p, DEPTH - 1, (T / 256) * (DM / 256));
}

__device__ __forceinline__ void conv_unit(const Params& p, int l, int unit, unsigned char* lds) {
  int tid_ = threadIdx.x; asm volatile("" : "+v"(tid_)); const int tid = tid_, lane = tid & 63, wid = tid >> 6;
  float* U = (float*)lds;
  const bf16_t* PROJ = (const bf16_t*)(p.ws + WS_PROJ);
  bf16_t* MIX = (bf16_t*)(p.ws + WS_MIX);
  const int row0 = unit * 32, b = row0 / SEGL, s0 = row0 - b * SEGL;
  const int seglo = s0 < CTXL ? 0 : CTXL, seghi = s0 < CTXL ? CTXL : SEGL;
  for (int rr = tid >> 5; rr < 62; rr += 16) {
    const int s = s0 - 15 + rr, c8 = (tid & 31) * 8;
    f32x4 u0 = {0.f, 0.f, 0.f, 0.f}, u1 = {0.f, 0.f, 0.f, 0.f};
    if (s >= seglo && s < seghi) {
      const bf16_t* pr = PROJ + (size_t)(b * SEGL + s) * PW + c8;
      const u32x4 a1 = *(const u32x4*)pr, a2 = *(const u32x4*)(pr + 256);
      u0.x = bflo(a1.x) * sigmoidf_(bflo(a2.x)); u0.y = bfhi(a1.x) * sigmoidf_(bfhi(a2.x));
      u0.z = bflo(a1.y) * sigmoidf_(bflo(a2.y)); u0.w = bfhi(a1.y) * sigmoidf_(bfhi(a2.y));
      u1.x = bflo(a1.z) * sigmoidf_(bflo(a2.z)); u1.y = bfhi(a1.z) * sigmoidf_(bfhi(a2.z));
      u1.z = bflo(a1.w) * sigmoidf_(bflo(a2.w)); u1.w = bfhi(a1.w) * sigmoidf_(bfhi(a2.w));
    }
    *(f32x4*)(U + rr * 256 + c8) = u0; *(f32x4*)(U + rr * 256 + c8 + 4) = u1;
  }
  __syncthreads();
  float* Y = U + 62 * 256;
  const float* cw = p.in[I_CONVW] + (size_t)l * 31 * 256;
#pragma unroll 1
  for (int q = 0; q < 4; ++q) {
    const int c = lane + 64 * q;
    float w[31];
#pragma unroll
    for (int j = 0; j < 31; ++j) w[j] = cw[j * 256 + c];
    const float bias = p.in[I_CONVB][l * 256 + c];
#pragma unroll
    for (int tt = 0; tt < 4; ++tt) {
      const int t = wid * 4 + tt;
      float a = bias;
#pragma unroll
      for (int j = 0; j < 31; ++j) a += U[(t + j) * 256 + c] * w[j];
      Y[t * 256 + c] = a;
    }
  }
  asm volatile("s_waitcnt lgkmcnt(0)" ::: "memory");
  float y[4][4];
#pragma unroll
  for (int tt = 0; tt < 4; ++tt)
#pragma unroll
    for (int q = 0; q < 4; ++q) y[tt][q] = Y[(wid * 4 + tt) * 256 + lane + 64 * q];
#pragma unroll
  for (int tt = 0; tt < 4; ++tt) {
    const int t = wid * 4 + tt;
    const float mean = wave_sum((y[tt][0] + y[tt][1]) + (y[tt][2] + y[tt][3])) * (1.f / 256.f);
    float v = 0.f;
#pragma unroll
    for (int q = 0; q < 4; ++q) { const float d = y[tt][q] - mean; v += d * d; }
    const float rs = rsqrtf(wave_sum(v) * (1.f / 256.f) + EPS);
#pragma unroll
    for (int q = 0; q < 4; ++q) {
      const int c = lane + 64 * q;
      const float z = (y[tt][q] - mean) * rs * p.in[I_CLNG][l * 256 + c] + p.in[I_CLNB][l * 256 + c];
      const float o = (ABL & 1) ? 0.f : z * sigmoidf_(z);
      MIX[(size_t)(row0 + t) * DM + c] = (bf16_t)(cvtpk(o, 0.f) & 0xffffu);
    }
  }
  __syncthreads();
}

__device__ __forceinline__ int ml_cidx(int ch, int dir) { return dir == 0 ? ch : (ch < 4 ? 3 - ch : 135 - ch); }
__device__ __forceinline__ void ml_load_tile(const bf16_t* src, float* dst, int tid) {
  const int r = tid >> 3, c8 = (tid & 7) * 8;
  const u32x4 a = *(const u32x4*)(src + (size_t)r * PW + c8);
  float* d = dst + r * 65 + c8;
  d[0] = bflo(a.x); d[1] = bfhi(a.x); d[2] = bflo(a.y); d[3] = bfhi(a.y); d[4] = bflo(a.z); d[5] = bfhi(a.z); d[6] = bflo(a.w); d[7] = bfhi(a.w);
}
__device__ __forceinline__ void ml_local_unit(const Params& p, int l, int unit, unsigned char* lds) {
  int tid_ = threadIdx.x; asm volatile("" : "+v"(tid_)); const int tid = tid_, lane = tid & 63, wid = tid >> 6, r32 = lane & 31, hi = lane >> 5;
  float* Kt = (float*)lds; float* Vt = Kt + 64 * 65; float* WK = Vt + 64 * 65;
  const bf16_t* PROJ = (const bf16_t*)(p.ws + WS_PROJ);
  const float* GT = (const float*)(p.ws + WS_GATES);
  float* UL = (float*)(p.ws + WS_ULOC); float* META = (float*)(p.ws + WS_MLMETA);
  const int b = unit / (4 * NCH), hh = (unit / NCH) & 3, ch = unit % NCH;
  const int row0 = b * SEGL + ch * 64;
  ml_load_tile(PROJ + (size_t)row0 * PW + C_MK + hh * 64, Kt, tid);
  ml_load_tile(PROJ + (size_t)row0 * PW + C_MV + hh * 64, Vt, tid);
  if (wid < 2) {
    const int dir = wid;
    const float ig = GT[(size_t)(row0 + lane) * 16 + (2 * dir) * 4 + hh];
    const float lf = logsigmoidf_(GT[(size_t)(row0 + lane) * 16 + (2 * dir + 1) * 4 + hh]);
    float ps = lf;
#pragma unroll
    for (int o = 1; o < 64; o <<= 1) { const float t = __shfl_up(ps, o); if (lane >= o) ps += t; }
    const float tot = __shfl(ps, 63);
    const float wlog = dir == 0 ? (tot - ps + ig) : (ps - lf + ig);
    const float mloc = wave_max(wlog);
    WK[dir * 64 + lane] = __expf(wlog - mloc);
    if (lane == 0) {
      const int seq = (b * 4 + hh) * 2 + dir, ci = ml_cidx(ch, dir);
      META[((size_t)seq * NCH + ci) * 4 + 0] = tot; META[((size_t)seq * NCH + ci) * 4 + 1] = mloc;
    }
  }
  __syncthreads();
  {
    const int dir = wid >> 2, et = (wid >> 1) & 1, dt = wid & 1;
    const int seq = (b * 4 + hh) * 2 + dir, ci = ml_cidx(ch, dir);
    float* slot = UL + ((size_t)seq * NCH + ci) * USTRIDE;
    f32x16 acc = {};
#pragma unroll 8
    for (int ks = 0; ks < 32; ++ks) {
      const int s = 2 * ks + hi;
      const float a = WK[dir * 64 + s] * Vt[s * 65 + et * 32 + r32];
      const float bb = Kt[s * 65 + dt * 32 + r32];
      acc = __builtin_amdgcn_mfma_f32_32x32x2f32(a, bb, acc, 0, 0, 0);
    }
#pragma unroll
    for (int r = 0; r < 16; ++r) slot[(et * 32 + crow(r, hi)) * 64 + dt * 32 + r32] = acc[r];
    if (et == 0) {
      float n = 0.f;
#pragma unroll 8
      for (int i = 0; i < 32; ++i) { const int s = hi * 32 + i; n += WK[dir * 64 + s] * Kt[s * 65 + dt * 32 + r32]; }
      n += __shfl_xor(n, 32);
      if (hi == 0) slot[4096 + dt * 32 + r32] = n;
    }
  }
  __syncthreads();
}
constexpr int MLP = 144;
constexpr size_t WS_CST = WS_H;
constexpr size_t WS_NST = WS_H + (size_t)32 * NCH * 4096 * 2;
__device__ __forceinline__ void ml_stage_rm(const bf16_t* src, size_t ld, unsigned char* dst, int tid) {
  const int r = tid >> 3, c8 = (tid & 7) * 8;
  *(u32x4*)(dst + r * MLP + c8 * 2) = *(const u32x4*)(src + (size_t)r * ld + c8);
}
__device__ __forceinline__ void ml_stage_tr(const bf16_t* src, size_t ld, unsigned char* dst, int tid) {
  const int r = tid >> 3, c8 = (tid & 7) * 8;
  const u32x4 a = *(const u32x4*)(src + (size_t)r * ld + c8);
  bf16_t* d = (bf16_t*)dst;
  d[(c8 + 0) * 72 + r] = (bf16_t)(a.x & 0xffffu); d[(c8 + 1) * 72 + r] = (bf16_t)(a.x >> 16);
  d[(c8 + 2) * 72 + r] = (bf16_t)(a.y & 0xffffu); d[(c8 + 3) * 72 + r] = (bf16_t)(a.y >> 16);
  d[(c8 + 4) * 72 + r] = (bf16_t)(a.z & 0xffffu); d[(c8 + 5) * 72 + r] = (bf16_t)(a.z >> 16);
  d[(c8 + 6) * 72 + r] = (bf16_t)(a.w & 0xffffu); d[(c8 + 7) * 72 + r] = (bf16_t)(a.w >> 16);
}
__device__ __forceinline__ void ml_local_unit2(const Params& p, int l, int unit, unsigned char* lds) {
  int tid_ = threadIdx.x; asm volatile("" : "+v"(tid_)); const int tid = tid_, lane = tid & 63, wid = tid >> 6, r32 = lane & 31, hi = lane >> 5;
  unsigned char* KT = lds; unsigned char* VT = lds + 64 * MLP; float* WK = (float*)(lds + 2 * 64 * MLP);
  const bf16_t* PROJ = (const bf16_t*)(p.ws + WS_PROJ);
  const float* GT = (const float*)(p.ws + WS_GATES);
  float* UL = (float*)(p.ws + WS_ULOC); float* META = (float*)(p.ws + WS_MLMETA);
  const int b = unit / (4 * NCH), hh = (unit / NCH) & 3, ch = unit % NCH;
  const int row0 = b * SEGL + ch * 64;
  ml_stage_tr(PROJ + (size_t)row0 * PW + C_MK + hh * 64, PW, KT, tid);
  ml_stage_tr(PROJ + (size_t)row0 * PW + C_MV + hh * 64, PW, VT, tid);
  if (wid < 2) {
    const int dir = wid;
    const float ig = GT[(size_t)(row0 + lane) * 16 + (2 * dir) * 4 + hh];
    const float lf = logsigmoidf_(GT[(size_t)(row0 + lane) * 16 + (2 * dir + 1) * 4 + hh]);
    float ps = lf;
#pragma unroll
    for (int o = 1; o < 64; o <<= 1) { const float t = __shfl_up(ps, o); if (lane >= o) ps += t; }
    const float tot = __shfl(ps, 63);
    const float wlog = dir == 0 ? (tot - ps + ig) : (ps - lf + ig);
    const float mloc = wave_max(wlog);
    WK[dir * 64 + lane] = __expf(wlog - mloc);
    if (lane == 0) {
      const int seq = (b * 4 + hh) * 2 + dir, ci = ml_cidx(ch, dir);
      META[((size_t)seq * NCH + ci) * 4 + 0] = tot; META[((size_t)seq * NCH + ci) * 4 + 1] = mloc;
    }
  }
  __syncthreads();
  {
    const int dir = wid >> 2, et = (wid >> 1) & 1, dt = wid & 1;
    const int seq = (b * 4 + hh) * 2 + dir, ci = ml_cidx(ch, dir);
    float* slot = UL + ((size_t)seq * NCH + ci) * USTRIDE;
    f32x16 acc = {};
#pragma unroll
    for (int ks = 0; ks < 4; ++ks) {
      const int s0 = ks * 16 + hi * 8;
      const u32x4 va = *(const u32x4*)(VT + (et * 32 + r32) * MLP + s0 * 2);
      const bf16x8 kb = *(const bf16x8*)(KT + (dt * 32 + r32) * MLP + s0 * 2);
      const f32x4 w0 = *(const f32x4*)(WK + dir * 64 + s0), w1 = *(const f32x4*)(WK + dir * 64 + s0 + 4);
      u32x4 sa; sa.x = cvtpk(bflo(va.x) * w0.x, bfhi(va.x) * w0.y); sa.y = cvtpk(bflo(va.y) * w0.z, bfhi(va.y) * w0.w);
      sa.z = cvtpk(bflo(va.z) * w1.x, bfhi(va.z) * w1.y); sa.w = cvtpk(bflo(va.w) * w1.z, bfhi(va.w) * w1.w);
      acc = __builtin_amdgcn_mfma_f32_32x32x16_bf16(*(const bf16x8*)&sa, kb, acc, 0, 0, 0);
    }
#pragma unroll
    for (int r = 0; r < 16; ++r) slot[(et * 32 + crow(r, hi)) * 64 + dt * 32 + r32] = acc[r];
    if (et == 0) {
      float n = 0.f;
#pragma unroll
      for (int i = 0; i < 4; ++i) {
        const int s0 = hi * 32 + i * 8;
        const u32x4 ka = *(const u32x4*)(KT + (dt * 32 + r32) * MLP + s0 * 2);
        const f32x4 w0 = *(const f32x4*)(WK + dir * 64 + s0), w1 = *(const f32x4*)(WK + dir * 64 + s0 + 4);
        n += bflo(ka.x) * w0.x + bfhi(ka.x) * w0.y + bflo(ka.y) * w0.z + bfhi(ka.y) * w0.w + bflo(ka.z) * w1.x + bfhi(ka.z) * w1.y + bflo(ka.w) * w1.z + bfhi(ka.w) * w1.w;
      }
      n += __shfl_xor(n, 32);
      if (hi == 0) slot[4096 + dt * 32 + r32] = n;
    }
  }
  __syncthreads();
}
__device__ __forceinline__ void ml_scan(const Params& p, unsigned char* lds) {
  float* UL = (float*)(p.ws + WS_ULOC); float* META = (float*)(p.ws + WS_MLMETA);
  int tid_ = threadIdx.x; asm volatile("" : "+v"(tid_));
  const int tid = tid_, lane = tid & 63, wid = tid >> 6;
  float* DEC = (float*)lds;
  float* SCL = DEC + 2 * NCH;
  float* TMP = SCL + 2 * NCH;
  for (int base0 = p.bx * 512; base0 < 32 * USTRIDE; base0 += p.gx * 512) {
    const int seq0 = base0 / USTRIDE;
    if (wid < 2) {
      const int seq = seq0 + wid;
      if (seq < 32) {
        float* mt = META + (size_t)seq * NCH * 4;
        for (int c = lane; c < NCH; c += 64) { TMP[(wid * 2 + 0) * NCH + c] = mt[c * 4 + 0]; TMP[(wid * 2 + 1) * NCH + c] = mt[c * 4 + 1]; }
        asm volatile("s_waitcnt lgkmcnt(0)" ::: "memory");
        if (lane == 0) {
          float m = 0.f;
          for (int c = 0; c < NCH; ++c) {
            const float bl = TMP[(wid * 2 + 0) * NCH + c], mloc = TMP[(wid * 2 + 1) * NCH + c];
            const float mn = fmaxf(bl + m, mloc);
            DEC[wid * NCH + c] = __expf(bl + m - mn); SCL[wid * NCH + c] = __expf(mloc - mn);
            mt[c * 4 + 2] = m;
            m = mn;
          }
        }
      }
    }
    __syncthreads();
    const int idx = base0 + tid;
    if (idx < 32 * USTRIDE) {
      const int seq = idx / USTRIDE, e = idx - seq * USTRIDE, sl = seq - seq0;
      float* bp = UL + (size_t)seq * NCH * USTRIDE + e;
      bf16_t* CSTp = (bf16_t*)(p.ws + WS_CST) + (size_t)seq * NCH * 4096 + (e < 4096 ? e : 0);
      float* NSTp = (float*)(p.ws + WS_NST) + (size_t)seq * NCH * 64 + (e < 4096 ? 0 : e - 4096);
      const float* dec = DEC + sl * NCH; const float* scl = SCL + sl * NCH;
      float C = 0.f;
#pragma unroll 1
      for (int c0 = 0; c0 < NCH; c0 += 12) {
        float u[12];
#pragma unroll
        for (int j = 0; j < 12; ++j) u[j] = bp[(size_t)(c0 + j) * USTRIDE];
#pragma unroll
        for (int j = 0; j < 12; ++j) {
          if (e < 4096) CSTp[(size_t)(c0 + j) * 4096] = (bf16_t)(cvtpk(C, 0.f) & 0xffffu); else NSTp[(size_t)(c0 + j) * 64] = C;
          C = dec[c0 + j] * C + scl[c0 + j] * u[j]; }
      }
    }
    __syncthreads();
  }
}
__device__ __forceinline__ void ml_out_unit(const Params& p, int l, int unit, unsigned char* lds) {
  int tid_ = threadIdx.x; asm volatile("" : "+v"(tid_)); const int tid = tid_, lane = tid & 63, wid = tid >> 6, r32 = lane & 31, hi = lane >> 5;
  float* Qt = (float*)lds; float* Kt = Qt + 64 * 65; float* Vt = Kt + 64 * 65;
  float* Cs = Vt + 64 * 65;
  float* Ns = Cs + 2 * 64 * 65;
  float* Bq = Ns + 128;
  float* Gs = Bq + 128;
  float* Mi = Gs + 128;
  float* HB = Mi + 64;
  const bf16_t* PROJ = (const bf16_t*)(p.ws + WS_PROJ);
  const float* GT = (const float*)(p.ws + WS_GATES);
  const float* UL = (const float*)(p.ws + WS_ULOC); const float* META = (const float*)(p.ws + WS_MLMETA);
  bf16_t* MIX = (bf16_t*)(p.ws + WS_MIX);
  const int b = unit / (4 * NCH), hh = (unit / NCH) & 3, ch = unit % NCH;
  const int row0 = b * SEGL + ch * 64;
  ml_load_tile(PROJ + (size_t)row0 * PW + C_MQ + hh * 64, Qt, tid);
  ml_load_tile(PROJ + (size_t)row0 * PW + C_MK + hh * 64, Kt, tid);
  ml_load_tile(PROJ + (size_t)row0 * PW + C_MV + hh * 64, Vt, tid);
  for (int i = tid; i < 2 * USTRIDE; i += 512) {
    const int dir = i / USTRIDE, e = i - dir * USTRIDE;
    const int seq = (b * 4 + hh) * 2 + dir, ci = ml_cidx(ch, dir);
    const float v = UL[((size_t)seq * NCH + ci) * USTRIDE + e];
    if (e < 4096) Cs[dir * 64 * 65 + (e >> 6) * 65 + (e & 63)] = v; else Ns[dir * 64 + (e - 4096)] = v;
  }
  if (wid < 2) {
    const int dir = wid;
    const float ig = GT[(size_t)(row0 + lane) * 16 + (2 * dir) * 4 + hh];
    const float lf = logsigmoidf_(GT[(size_t)(row0 + lane) * 16 + (2 * dir + 1) * 4 + hh]);
    float ps = lf;
#pragma unroll
    for (int o = 1; o < 64; o <<= 1) { const float t = __shfl_up(ps, o); if (lane >= o) ps += t; }
    const float tot = __shfl(ps, 63);
    const float bc = dir == 0 ? ps : (tot - ps + lf);
    Bq[dir * 64 + lane] = bc; Gs[dir * 64 + lane] = ig - bc;
    if (lane == 0) { const int seq = (b * 4 + hh) * 2 + dir, ci = ml_cidx(ch, dir); Mi[dir] = META[((size_t)seq * NCH + ci) * 4 + 2]; }
  }
  __syncthreads();
  {
    const int dir = wid >> 2, tt = (wid >> 1) & 1, et = wid & 1;
    const int t = tt * 32 + r32;
    f32x16 sa[2] = {};
#pragma unroll 4
    for (int ks = 0; ks < 32; ++ks) {
      const float bq = Qt[t * 65 + 2 * ks + hi];
      const float a0 = Kt[(r32) * 65 + 2 * ks + hi], a1 = Kt[(32 + r32) * 65 + 2 * ks + hi];
      sa[0] = __builtin_amdgcn_mfma_f32_32x32x2f32(a0, bq, sa[0], 0, 0, 0);
      sa[1] = __builtin_amdgcn_mfma_f32_32x32x2f32(a1, bq, sa[1], 0, 0, 0);
    }
    const float bt = Bq[dir * 64 + t];
    const float inter = bt + Mi[dir];
    float mx = -INFINITY;
    f32x16 dl[2];
#pragma unroll
    for (int st = 0; st < 2; ++st)
#pragma unroll
      for (int r = 0; r < 16; ++r) {
        const int s = st * 32 + crow(r, hi);
        const bool ok = dir == 0 ? (s <= t) : (s >= t);
        const float d = ok ? bt + Gs[dir * 64 + s] : -INFINITY;
        dl[st][r] = d; mx = fmaxf(mx, d);
      }
    mx = fmaxf(mx, __shfl_xor(mx, 32));
    const float mt = fmaxf(inter, mx);
    const float iw = __expf(inter - mt);
    float rsum = 0.f;
#pragma unroll
    for (int st = 0; st < 2; ++st)
#pragma unroll
      for (int r = 0; r < 16; ++r) { const float w = __expf(dl[st][r] - mt); sa[st][r] *= w; rsum += sa[st][r]; }
    rsum += __shfl_xor(rsum, 32);
    float qn = 0.f;
#pragma unroll 8
    for (int i = 0; i < 32; ++i) { const int d = hi * 32 + i; qn += Ns[dir * 64 + d] * Qt[t * 65 + d]; }
    qn += __shfl_xor(qn, 32);
    const float den = rsum + iw * qn;
    const float rden = 1.f / fmaxf(fabsf(den), __expf(-mt));
    f32x16 an = {}, ac = {};
#pragma unroll
    for (int st = 0; st < 2; ++st)
#pragma unroll
      for (int r = 0; r < 16; ++r) {
        const float a = Vt[(st * 32 + crow(r, hi)) * 65 + et * 32 + r32];
        an = __builtin_amdgcn_mfma_f32_32x32x2f32(a, sa[st][r], an, 0, 0, 0);
      }
    const float* Cd = Cs + dir * 64 * 65;
#pragma unroll 4
    for (int ks = 0; ks < 32; ++ks) {
      const float a = Cd[(et * 32 + r32) * 65 + 2 * ks + hi];
      const float bq = Qt[t * 65 + 2 * ks + hi];
      ac = __builtin_amdgcn_mfma_f32_32x32x2f32(a, bq, ac, 0, 0, 0);
    }
#pragma unroll
    for (int r = 0; r < 16; ++r) HB[dir * 64 * 65 + t * 65 + et * 32 + crow(r, hi)] = (an[r] + iw * ac[r]) * rden;
  }
  __syncthreads();
  {
    const int t = tid >> 3, e8 = (tid & 7) * 8;
    float v[8]; float ss = 0.f;
#pragma unroll
    for (int i = 0; i < 8; ++i) { v[i] = HB[t * 65 + e8 + i] + HB[64 * 65 + t * 65 + e8 + i]; ss += v[i] * v[i]; }
    ss += __shfl_xor(ss, 1); ss += __shfl_xor(ss, 2); ss += __shfl_xor(ss, 4);
    const float rs = rsqrtf(ss * (1.f / 64.f) + EPS);
    const u32x4 ov = *(const u32x4*)(PROJ + (size_t)(row0 + t) * PW + C_MO + hh * 64 + e8);
    const float og[8] = {bflo(ov.x), bfhi(ov.x), bflo(ov.y), bfhi(ov.y), bflo(ov.z), bfhi(ov.z), bflo(ov.w), bfhi(ov.w)};
    const float* g = p.in[I_MNORMG] + l * 64 + e8;
    float o[8];
#pragma unroll
    for (int i = 0; i < 8; ++i) o[i] = (ABL & 2) ? 0.f : v[i] * rs * g[i] * sigmoidf_(og[i]);
    u32x4 w; w.x = cvtpk(o[0], o[1]); w.y = cvtpk(o[2], o[3]); w.z = cvtpk(o[4], o[5]); w.w = cvtpk(o[6], o[7]);
    *(u32x4*)(MIX + (size_t)(row0 + t) * DM + 256 + hh * 64 + e8) = w;
  }
  __syncthreads();
}


__device__ __forceinline__ void ml_out_unit2(const Params& p, int l, int unit, unsigned char* lds) {
  int tid_ = threadIdx.x; asm volatile("" : "+v"(tid_)); const int tid = tid_, lane = tid & 63, wid = tid >> 6, r32 = lane & 31, hi = lane >> 5;
  unsigned char* Qs = lds; unsigned char* Ks = lds + 64 * MLP; unsigned char* VT = lds + 2 * 64 * MLP; unsigned char* Cs = lds + 3 * 64 * MLP;
  float* Ns = (float*)(lds + 5 * 64 * MLP);
  float* Bq = Ns + 128;
  float* Gs = Bq + 128;
  float* Mi = Gs + 128;
  float* HB = Mi + 64;
  const bf16_t* PROJ = (const bf16_t*)(p.ws + WS_PROJ);
  const float* GT = (const float*)(p.ws + WS_GATES);
  const bf16_t* CST = (const bf16_t*)(p.ws + WS_CST); const float* NST = (const float*)(p.ws + WS_NST); const float* META = (const float*)(p.ws + WS_MLMETA);
  bf16_t* MIX = (bf16_t*)(p.ws + WS_MIX);
  const int b = unit / (4 * NCH), hh = (unit / NCH) & 3, ch = unit % NCH;
  const int row0 = b * SEGL + ch * 64;
  ml_stage_rm(PROJ + (size_t)row0 * PW + C_MQ + hh * 64, PW, Qs, tid);
  ml_stage_rm(PROJ + (size_t)row0 * PW + C_MK + hh * 64, PW, Ks, tid);
  ml_stage_tr(PROJ + (size_t)row0 * PW + C_MV + hh * 64, PW, VT, tid);
#pragma unroll
  for (int dir = 0; dir < 2; ++dir) {
    const int seq = (b * 4 + hh) * 2 + dir, ci = ml_cidx(ch, dir);
    ml_stage_rm(CST + ((size_t)seq * NCH + ci) * 4096, 64, Cs + dir * 64 * MLP, tid);
    if (tid < 64) Ns[dir * 64 + tid] = NST[((size_t)seq * NCH + ci) * 64 + tid];
  }
  if (wid < 2) {
    const int dir = wid;
    const float ig = GT[(size_t)(row0 + lane) * 16 + (2 * dir) * 4 + hh];
    const float lf = logsigmoidf_(GT[(size_t)(row0 + lane) * 16 + (2 * dir + 1) * 4 + hh]);
    float ps = lf;
#pragma unroll
    for (int o = 1; o < 64; o <<= 1) { const float t = __shfl_up(ps, o); if (lane >= o) ps += t; }
    const float tot = __shfl(ps, 63);
    const float bc = dir == 0 ? ps : (tot - ps + lf);
    Bq[dir * 64 + lane] = bc; Gs[dir * 64 + lane] = ig - bc;
    if (lane == 0) { const int seq = (b * 4 + hh) * 2 + dir, ci = ml_cidx(ch, dir); Mi[dir] = META[((size_t)seq * NCH + ci) * 4 + 2]; }
  }
  __syncthreads();
  {
    const int dir = wid >> 2, tt = (wid >> 1) & 1, et = wid & 1;
    const int t = tt * 32 + r32;
    f32x16 sa[2] = {};
    bf16x8 bq[4];
#pragma unroll
    for (int ks = 0; ks < 4; ++ks) {
      bq[ks] = *(const bf16x8*)(Qs + t * MLP + (ks * 16 + hi * 8) * 2);
      const bf16x8 a0 = *(const bf16x8*)(Ks + r32 * MLP + (ks * 16 + hi * 8) * 2), a1 = *(const bf16x8*)(Ks + (32 + r32) * MLP + (ks * 16 + hi * 8) * 2);
      sa[0] = __builtin_amdgcn_mfma_f32_32x32x16_bf16(a0, bq[ks], sa[0], 0, 0, 0);
      sa[1] = __builtin_amdgcn_mfma_f32_32x32x16_bf16(a1, bq[ks], sa[1], 0, 0, 0);
    }
    const float bt = Bq[dir * 64 + t];
    const float inter = bt + Mi[dir];
    float mx = -INFINITY;
    f32x16 dl[2];
#pragma unroll
    for (int st = 0; st < 2; ++st)
#pragma unroll
      for (int r = 0; r < 16; ++r) {
        const int s = st * 32 + crow(r, hi);
        const bool ok = dir == 0 ? (s <= t) : (s >= t);
        const float d = ok ? bt + Gs[dir * 64 + s] : -INFINITY;
        dl[st][r] = d; mx = fmaxf(mx, d);
      }
    mx = fmaxf(mx, __shfl_xor(mx, 32));
    const float mt = fmaxf(inter, mx);
    const float iw = __expf(inter - mt);
    float rsum = 0.f;
#pragma unroll
    for (int st = 0; st < 2; ++st)
#pragma unroll
      for (int r = 0; r < 16; ++r) { const float w = __expf(dl[st][r] - mt); sa[st][r] *= w; rsum += sa[st][r]; }
    rsum += __shfl_xor(rsum, 32);
    float qn = 0.f;
#pragma unroll
    for (int i = 0; i < 4; ++i) {
      const int d0 = hi * 32 + i * 8;
      const u32x4 qa = *(const u32x4*)(Qs + t * MLP + d0 * 2);
      const f32x4 n0 = *(const f32x4*)(Ns + dir * 64 + d0), n1 = *(const f32x4*)(Ns + dir * 64 + d0 + 4);
      qn += bflo(qa.x) * n0.x + bfhi(qa.x) * n0.y + bflo(qa.y) * n0.z + bfhi(qa.y) * n0.w + bflo(qa.z) * n1.x + bfhi(qa.z) * n1.y + bflo(qa.w) * n1.z + bfhi(qa.w) * n1.w;
    }
    qn += __shfl_xor(qn, 32);
    const float den = rsum + iw * qn;
    const float rden = 1.f / fmaxf(fabsf(den), __expf(-mt));
    f32x16 an = {}, ac = {};
#pragma unroll
    for (int st = 0; st < 2; ++st)
#pragma unroll
      for (int k2 = 0; k2 < 2; ++k2) {
        u32x4 bx; bx.x = cvtpk(sa[st][8 * k2 + 0], sa[st][8 * k2 + 1]); bx.y = cvtpk(sa[st][8 * k2 + 2], sa[st][8 * k2 + 3]);
        bx.z = cvtpk(sa[st][8 * k2 + 4], sa[st][8 * k2 + 5]); bx.w = cvtpk(sa[st][8 * k2 + 6], sa[st][8 * k2 + 7]);
        const unsigned char* vrow = VT + (et * 32 + r32) * MLP + (st * 32 + 16 * k2 + 4 * hi) * 2;
        const u32x2 v0 = *(const u32x2*)vrow, v1 = *(const u32x2*)(vrow + 16);
        u32x4 ax; ax.x = v0.x; ax.y = v0.y; ax.z = v1.x; ax.w = v1.y;
        an = __builtin_amdgcn_mfma_f32_32x32x16_bf16(*(const bf16x8*)&ax, *(const bf16x8*)&bx, an, 0, 0, 0);
      }
    const unsigned char* Cd = Cs + dir * 64 * MLP;
#pragma unroll
    for (int ks = 0; ks < 4; ++ks) {
      const bf16x8 a = *(const bf16x8*)(Cd + (et * 32 + r32) * MLP + (ks * 16 + hi * 8) * 2);
      ac = __builtin_amdgcn_mfma_f32_32x32x16_bf16(a, bq[ks], ac, 0, 0, 0);
    }
#pragma unroll
    for (int r = 0; r < 16; ++r) HB[dir * 64 * 65 + t * 65 + et * 32 + crow(r, hi)] = (an[r] + iw * ac[r]) * rden;
  }
  __syncthreads();
  {
    const int t = tid >> 3, e8 = (tid & 7) * 8;
    float v[8]; float ss = 0.f;
#pragma unroll
    for (int i = 0; i < 8; ++i) { v[i] = HB[t * 65 + e8 + i] + HB[64 * 65 + t * 65 + e8 + i]; ss += v[i] * v[i]; }
    ss += __shfl_xor(ss, 1); ss += __shfl_xor(ss, 2); ss += __shfl_xor(ss, 4);
    const float rs = rsqrtf(ss * (1.f / 64.f) + EPS);
    const u32x4 ov = *(const u32x4*)(PROJ + (size_t)(row0 + t) * PW + C_MO + hh * 64 + e8);
    const float og[8] = {bflo(ov.x), bfhi(ov.x), bflo(ov.y), bfhi(ov.y), bflo(ov.z), bfhi(ov.z), bflo(ov.w), bfhi(ov.w)};
    const float* g = p.in[I_MNORMG] + l * 64 + e8;
    float o[8];
#pragma unroll
    for (int i = 0; i < 8; ++i) o[i] = (ABL & 2) ? 0.f : v[i] * rs * g[i] * sigmoidf_(og[i]);
    u32x4 w; w.x = cvtpk(o[0], o[1]); w.y = cvtpk(o[2], o[3]); w.z = cvtpk(o[4], o[5]); w.w = cvtpk(o[6], o[7]);
    *(u32x4*)(MIX + (size_t)(row0 + t) * DM + 256 + hh * 64 + e8) = w;
  }
  __syncthreads();
}

#define KSWZ(row, colB) ((row) * 256 + ((colB) ^ (((row) & 15) << 4)))
#define SBAR() __builtin_amdgcn_sched_barrier(0)
constexpr int ATT_SHM_V = 128 * 80, ATT_SHM_K = 64 * 128 * 2;
constexpr float ATT_THR = 8.0f;
__device__ __forceinline__ int v_st(int k, int c) { const int kk = (k & ~0xC) | ((k & 4) << 1) | ((k & 8) >> 1); return ((kk >> 3) * 4 + (c >> 5)) * 512 + ((kk & 7) * 32 + (c & 31)) * 2; }
__device__ __forceinline__ int v_rd_base(int lane) { return ((lane & 3) << 3) | (((lane >> 2) & 3) << 6) | (((lane >> 4) & 1) << 5) | (((lane >> 5) & 1) << 8); }
constexpr int v_rd_off(int d0, int ks, int half) { return d0 * 512 + ks * 4096 + half * 2048; }
template <int OFF> __device__ __forceinline__ s16x4 tr_read(int vb) {
  s16x4 r; asm volatile("ds_read_b64_tr_b16 %0, %1 offset:%2" : "=&v"(r) : "v"(vb), "i"(OFF) : "memory"); return r;
}
template <int D0> __device__ __forceinline__ void pv_one(f32x16& od, int vb, bf16x8 pa0, bf16x8 pa1, bf16x8 pa2, bf16x8 pa3) {
  const s16x4 l0 = tr_read<v_rd_off(D0, 0, 0)>(vb), h0 = tr_read<v_rd_off(D0, 0, 1)>(vb), l1 = tr_read<v_rd_off(D0, 1, 0)>(vb), h1 = tr_read<v_rd_off(D0, 1, 1)>(vb);
  const s16x4 l2 = tr_read<v_rd_off(D0, 2, 0)>(vb), h2 = tr_read<v_rd_off(D0, 2, 1)>(vb), l3 = tr_read<v_rd_off(D0, 3, 0)>(vb), h3 = tr_read<v_rd_off(D0, 3, 1)>(vb);
  asm volatile("s_waitcnt lgkmcnt(0)" ::: "memory"); SBAR();
#define PK(L, H) (bf16x8){L[0], L[1], L[2], L[3], H[0], H[1], H[2], H[3]}
  od = __builtin_amdgcn_mfma_f32_32x32x16_bf16(pa0, PK(l0, h0), od, 0, 0, 0);
  od = __builtin_amdgcn_mfma_f32_32x32x16_bf16(pa1, PK(l1, h1), od, 0, 0, 0);
  od = __builtin_amdgcn_mfma_f32_32x32x16_bf16(pa2, PK(l2, h2), od, 0, 0, 0);
  od = __builtin_amdgcn_mfma_f32_32x32x16_bf16(pa3, PK(l3, h3), od, 0, 0, 0);
#undef PK
}
template <int D0> __device__ __forceinline__ void pv_two(f32x16& oa, f32x16& ob, int vb, bf16x8 a0, bf16x8 a1, bf16x8 a2, bf16x8 a3, bf16x8 b0, bf16x8 b1, bf16x8 b2, bf16x8 b3) {
  const s16x4 l0 = tr_read<v_rd_off(D0, 0, 0)>(vb), h0 = tr_read<v_rd_off(D0, 0, 1)>(vb), l1 = tr_read<v_rd_off(D0, 1, 0)>(vb), h1 = tr_read<v_rd_off(D0, 1, 1)>(vb);
  const s16x4 l2 = tr_read<v_rd_off(D0, 2, 0)>(vb), h2 = tr_read<v_rd_off(D0, 2, 1)>(vb), l3 = tr_read<v_rd_off(D0, 3, 0)>(vb), h3 = tr_read<v_rd_off(D0, 3, 1)>(vb);
  asm volatile("s_waitcnt lgkmcnt(0)" ::: "memory"); SBAR();
#define PK(L, H) (bf16x8){L[0], L[1], L[2], L[3], H[0], H[1], H[2], H[3]}
  const bf16x8 v0 = PK(l0, h0), v1 = PK(l1, h1), v2 = PK(l2, h2), v3 = PK(l3, h3);
  oa = __builtin_amdgcn_mfma_f32_32x32x16_bf16(a0, v0, oa, 0, 0, 0);
  ob = __builtin_amdgcn_mfma_f32_32x32x16_bf16(b0, v0, ob, 0, 0, 0);
  oa = __builtin_amdgcn_mfma_f32_32x32x16_bf16(a1, v1, oa, 0, 0, 0);
  ob = __builtin_amdgcn_mfma_f32_32x32x16_bf16(b1, v1, ob, 0, 0, 0);
  oa = __builtin_amdgcn_mfma_f32_32x32x16_bf16(a2, v2, oa, 0, 0, 0);
  ob = __builtin_amdgcn_mfma_f32_32x32x16_bf16(b2, v2, ob, 0, 0, 0);
  oa = __builtin_amdgcn_mfma_f32_32x32x16_bf16(a3, v3, oa, 0, 0, 0);
  ob = __builtin_amdgcn_mfma_f32_32x32x16_bf16(b3, v3, ob, 0, 0, 0);
#undef PK
}
__device__ __forceinline__ void att_qkt(f32x16& p0, f32x16& p1, const unsigned char* Ks, const unsigned char* Qs, int qrow, int comp, int r32, int hi, float init) {
#pragma unroll
  for (int r = 0; r < 16; ++r) { p0[r] = init; p1[r] = init; }
#pragma unroll
  for (int d0 = 0; d0 < 4; ++d0) {
    const int cb = ((comp * 4 + d0) * 16 + hi * 8) * 2;
    const bf16x8 b0 = *(const bf16x8*)(Ks + KSWZ(r32, cb));
    const bf16x8 b1 = *(const bf16x8*)(Ks + KSWZ(32 + r32, cb));
    const bf16x8 q = *(const bf16x8*)(Qs + KSWZ(qrow, cb));
    p0 = __builtin_amdgcn_mfma_f32_32x32x16_bf16(b0, q, p0, 0, 0, 0);
    p1 = __builtin_amdgcn_mfma_f32_32x32x16_bf16(b1, q, p1, 0, 0, 0);
  }
}
__device__ __forceinline__ void att_softmax(f32x16& p0, f32x16& p1, float& m_reg, float& l_reg, float& alpha, bool first, i32x8& pa) {
  float pmax = p0[0];
#pragma unroll
  for (int r = 1; r < 16; ++r) pmax = fmaxf(pmax, p0[r]);
#pragma unroll
  for (int r = 0; r < 16; ++r) pmax = fmaxf(pmax, p1[r]);
  { auto rr = __builtin_amdgcn_permlane32_swap(__float_as_uint(pmax), __float_as_uint(pmax), false, false);
    pmax = fmaxf(__uint_as_float(rr[0]), __uint_as_float(rr[1])); }
  alpha = 1.f;
  if (__builtin_expect(first || !__all(pmax <= ATT_THR), 0)) {
    const float delta = first ? pmax : fmaxf(pmax, 0.f);
    alpha = first ? 0.f : __builtin_amdgcn_exp2f(-delta);
    m_reg = (first ? 0.f : m_reg) + delta;
#pragma unroll
    for (int r = 0; r < 16; ++r) { p0[r] -= delta; p1[r] -= delta; }
  }
#pragma unroll
  for (int r = 0; r < 16; ++r) { p0[r] = __builtin_amdgcn_exp2f(p0[r]); p1[r] = __builtin_amdgcn_exp2f(p1[r]); }
  float ps = 0.f;
#pragma unroll
  for (int r = 0; r < 16; ++r) ps += p0[r];
#pragma unroll
  for (int r = 0; r < 16; ++r) ps += p1[r];
  { auto rr = __builtin_amdgcn_permlane32_swap(__float_as_uint(ps), __float_as_uint(ps), false, false);
    ps = __uint_as_float(rr[0]) + __uint_as_float(rr[1]); }
  l_reg = l_reg * alpha + ps;
#pragma unroll
  for (int v = 0; v < 4; ++v) {
    int w0 = 0, w1 = 0;
    w0 = __builtin_amdgcn_cvt_pk_fp8_f32(p0[4 * v], p0[4 * v + 1], w0, false); w0 = __builtin_amdgcn_cvt_pk_fp8_f32(p0[4 * v + 2], p0[4 * v + 3], w0, true);
    w1 = __builtin_amdgcn_cvt_pk_fp8_f32(p1[4 * v], p1[4 * v + 1], w1, false); w1 = __builtin_amdgcn_cvt_pk_fp8_f32(p1[4 * v + 2], p1[4 * v + 3], w1, true);
    pa[v] = w0; pa[4 + v] = w1;
  }
}
__device__ __forceinline__ void att_unit(const bf16_t* __restrict__ Qb, const bf16_t* __restrict__ Kh, const unsigned char* __restrict__ V8, bf16_t* __restrict__ Ob,
                                         int nkeys, float lam, const float* __restrict__ ng, float oscale, unsigned char* lds) {
  int tid_ = threadIdx.x; asm volatile("" : "+v"(tid_)); const int tid = tid_, wid = tid >> 6, lane = tid & 63, r32 = lane & 31, hi = lane >> 5;
  unsigned char* V_lds = lds; unsigned char* K_lds = lds + 2 * ATT_SHM_V;
  float* wsl = (float*)(lds + 2 * ATT_SHM_V + 2 * ATT_SHM_K) + wid * 64; float* li_l = wsl; float* al_l = wsl + 32;
  float m0 = 0.f, l0 = 0.f, m1 = 0.f, l1 = 0.f;
  f32x16 o0[4] = {}, o1[4] = {};
  unsigned char* Q_lds = lds + 2 * ATT_SHM_V + 2 * ATT_SHM_K + 2048;
#pragma unroll
  for (int i = 0; i < 8; ++i) { const int id = tid + 512 * i, qrw = id >> 4, ch = id & 15;
    *(bf16x8*)(Q_lds + KSWZ(qrw, ch * 16)) = *(const bf16x8*)(Qb + (size_t)qrw * PW + ch * 8); }
  const int qrow = wid * 32 + r32;
  int kso[2];
#pragma unroll
  for (int i = 0; i < 2; ++i) {
    const int o16 = tid + 512 * i;
    { const int row = o16 >> 4, cs = (o16 & 15) ^ (row & 15); kso[i] = row * PW + cs * 8; }
  }
  const unsigned ldsw = (unsigned)__builtin_amdgcn_readfirstlane(wid) * 1024u;
#define GSTAGE(b, k0) do { _Pragma("unroll") for (int i_ = 0; i_ < 2; ++i_) \
    __builtin_amdgcn_global_load_lds((const unsigned*)(Kh + (size_t)(k0) * PW + kso[i_]), (LAS unsigned*)(K_lds + (b) * ATT_SHM_K + ldsw + i_ * 8192), 16, 0, 0); \
    { const unsigned char* vi_ = V8 + (size_t)((k0) >> 6) * ATT_SHM_V + tid * 16; \
      __builtin_amdgcn_global_load_lds((const unsigned*)vi_, (LAS unsigned*)(V_lds + (b) * ATT_SHM_V + ldsw), 16, 0, 0); \
      if (wid < 2) __builtin_amdgcn_global_load_lds((const unsigned*)(vi_ + 8192), (LAS unsigned*)(V_lds + (b) * ATT_SHM_V + 8192 + ldsw), 16, 0, 0); } } while (0)
#define RESC(o, a) do { if (__any((a) < 1.f)) { if (hi == 0) al_l[r32] = (a); asm volatile("s_waitcnt lgkmcnt(0)" ::: "memory"); \
    _Pragma("unroll") for (int d = 0; d < 4; ++d) _Pragma("unroll") for (int r = 0; r < 16; ++r) o[d][r] *= al_l[crow(r, hi)]; } } while (0)
  const int NT = nkeys / 64;
  GSTAGE(0, 0); asm volatile("s_waitcnt vmcnt(0)" ::: "memory"); __syncthreads();
  for (int j = 0; j < NT; ++j) {
    const int cur = j & 1;
    if (j + 1 < NT) GSTAGE(cur ^ 1, (j + 1) * 64);
    const unsigned char* Kc = K_lds + cur * ATT_SHM_K; const unsigned char* Vc = V_lds + cur * ATT_SHM_V;
    f32x16 p0, p1, q0, q1; float alphaA, alphaB; i32x8 pa, pb;
    const bool first = (j == 0);
    att_qkt(p0, p1, Kc, Q_lds, qrow, 0, r32, hi, first ? 0.f : -m0);
    att_qkt(q0, q1, Kc, Q_lds, qrow, 1, r32, hi, first ? 0.f : -m1);
    att_softmax(p0, p1, m0, l0, alphaA, first, pa);
    att_softmax(q0, q1, m1, l1, alphaB, first, pb);
    RESC(o0, alphaA);
    RESC(o1, alphaB);
#pragma unroll
    for (int d0 = 0; d0 < 4; ++d0) {
      const unsigned char* vrow = Vc + (d0 * 32 + r32) * 80 + hi * 32;
      const u32x4 v0 = *(const u32x4*)vrow, v1 = *(const u32x4*)(vrow + 16);
      i32x8 bv; bv[0] = (int)v0.x; bv[1] = (int)v0.y; bv[2] = (int)v0.z; bv[3] = (int)v0.w; bv[4] = (int)v1.x; bv[5] = (int)v1.y; bv[6] = (int)v1.z; bv[7] = (int)v1.w;
      o0[d0] = __builtin_amdgcn_mfma_scale_f32_32x32x64_f8f6f4(pa, bv, o0[d0], 0, 0, 0, 0x7F7F7F7F, 0, 0x7F7F7F7F);
      o1[d0] = __builtin_amdgcn_mfma_scale_f32_32x32x64_f8f6f4(pb, bv, o1[d0], 0, 0, 0, 0x7F7F7F7F, 0, 0x7F7F7F7F);
    }
    asm volatile("s_waitcnt vmcnt(0)" ::: "memory");
    __syncthreads();
  }
  if (hi == 0) { li_l[r32] = 1.f / l0; al_l[r32] = lam / l1; }
  asm volatile("s_waitcnt lgkmcnt(0)" ::: "memory");
  float ss[16];
#pragma unroll
  for (int r = 0; r < 16; ++r) {
    const float a = li_l[crow(r, hi)], bq = al_l[crow(r, hi)];
    float s = 0.f;
#pragma unroll
    for (int d = 0; d < 4; ++d) { const float v = o0[d][r] * a - o1[d][r] * bq; o0[d][r] = v; s += v * v; }
    s += __shfl_xor(s, 1); s += __shfl_xor(s, 2); s += __shfl_xor(s, 4); s += __shfl_xor(s, 8); s += __shfl_xor(s, 16);
    ss[r] = rsqrtf(s * (1.f / 128.f) + EPS) * oscale;
  }
  bf16_t* Ow = Ob + (size_t)(wid * 32) * DM;
#pragma unroll
  for (int d = 0; d < 4; ++d) {
    const float g = ng[d * 32 + r32];
#pragma unroll
    for (int r = 0; r < 16; ++r) Ow[(size_t)crow(r, hi) * DM + d * 32 + r32] = (ABL & 4) ? (bf16_t)0 : (bf16_t)(cvtpk(o0[d][r] * ss[r] * g, 0.f) & 0xffffu);
  }
  __syncthreads();
#undef GSTAGE
#undef RESC
}

__device__ __forceinline__ float ins16(float (&a)[16], float x) {
#pragma unroll
  for (int i = 0; i < 16; ++i) { const float h = fmaxf(a[i], x); x = fminf(a[i], x); a[i] = h; }
  return x;
}
__device__ __forceinline__ void bsort16(float (&a)[16]) {
#pragma unroll
  for (int k = 2; k <= 16; k <<= 1)
#pragma unroll
    for (int j = k >> 1; j > 0; j >>= 1)
#pragma unroll
      for (int i = 0; i < 16; ++i) {
        const int q = i ^ j;
        if (q > i) {
          const bool desc = ((i & k) == 0);
          const float hi_ = fmaxf(a[i], a[q]), lo_ = fminf(a[i], a[q]);
          a[i] = desc ? hi_ : lo_; a[q] = desc ? lo_ : hi_;
        }
      }
}
__device__ __forceinline__ void bmerge16(float (&a)[16], const float (&b)[16]) {
#pragma unroll
  for (int i = 0; i < 16; ++i) a[i] = fmaxf(a[i], b[15 - i]);
#pragma unroll
  for (int j = 8; j > 0; j >>= 1)
#pragma unroll
    for (int i = 0; i < 16; ++i) {
      const int q = i ^ j;
      if (q > i) { const float hi_ = fmaxf(a[i], a[q]), lo_ = fminf(a[i], a[q]); a[i] = hi_; a[q] = lo_; }
    }
}
__device__ __forceinline__ float gelu_erf(float x) { return 0.5f * x * (1.f + erff(x * 0.70710678118654752440f)); }
#define XB_TMO      128
#define XB_XCNT(j)  (256  + 64 * (j))
#define XB_XSUB(j)  (1280 + 64 * (j))
#define XB_XGEN(j)  (2304 + 64 * (j))
#define XB_TOP      3328
#define XB_TOPGEN   3392
#define XCD_BAR_WORDS 3456
#define XB_SPIN_CAP (1u << 22)
__device__ __forceinline__ unsigned xb_ld(unsigned* p)              { return __hip_atomic_load(p, __ATOMIC_RELAXED, __HIP_MEMORY_SCOPE_AGENT); }
__device__ __forceinline__ unsigned xb_add(unsigned* p, unsigned v) { return __hip_atomic_fetch_add(p, v, __ATOMIC_RELAXED, __HIP_MEMORY_SCOPE_AGENT); }
__device__ __forceinline__ unsigned xb_xcc_id() { return (unsigned)__builtin_amdgcn_s_getreg((3 << 11) | 20) & 0xFu; }
#define XB_SPIN(cond, bar) do { unsigned _sp = 0; while (cond) { __builtin_amdgcn_s_sleep(1); \
    if ((++_sp & 255u) == 0u) { if (xb_ld(&(bar)[XB_TMO])) break; if (_sp > XB_SPIN_CAP) { atomicAdd(&(bar)[XB_TMO], 1u); break; } } } } while (0)
struct XcdBarrier { unsigned* bar; unsigned x; volatile LAS unsigned* st; };
__device__ __forceinline__ XcdBarrier xcd_barrier_post(unsigned* bar, volatile LAS unsigned* st) {
  XcdBarrier b; b.bar = bar; b.x = xb_xcc_id(); b.st = st;
  if (threadIdx.x == 0) (void)xb_add(&bar[XB_XCNT(b.x)], 1u);
  return b;
}
__device__ __forceinline__ void xcd_barrier_complete(unsigned* bar, unsigned x, unsigned& nloc, unsigned& nx) {
  const unsigned G = gridDim.x * gridDim.y * gridDim.z;
  unsigned sum, cnt, mine, sp = 0u;
  for (;;) {
    sum = 0u; cnt = 0u; mine = 0u;
#pragma unroll
    for (unsigned j = 0; j < 16; ++j) { const unsigned c = xb_ld(&bar[XB_XCNT(j)]); sum += c; cnt += (c > 0u) ? 1u : 0u; mine = (j == x) ? c : mine; }
    if (sum == G) break;
    __builtin_amdgcn_s_sleep(1);
    if ((++sp & 255u) == 0u) { if (xb_ld(&bar[XB_TMO])) break; if (sp > XB_SPIN_CAP) { atomicAdd(&bar[XB_TMO], 1u); break; } }
  }
  nloc = mine > 0u ? mine : 1u; nx = cnt > 0u ? cnt : 1u;
}
__device__ __forceinline__ void xcd_barrier(const XcdBarrier& b) {
  asm volatile("s_waitcnt vmcnt(0)" ::: "memory");
  __syncthreads();
  if (threadIdx.x == 0) {
    unsigned* bar = b.bar;
    __builtin_amdgcn_s_waitcnt(0);
    unsigned nloc = b.st[0], nx = b.st[1];
    if (nloc == 0u) { xcd_barrier_complete(bar, b.x, nloc, nx); b.st[0] = nloc; b.st[1] = nx; }
    const unsigned old = xb_add(&bar[XB_XSUB(b.x)], 1u);
    const unsigned gen = old / nloc;
    if (old + 1u == (gen + 1u) * nloc) {
      __builtin_amdgcn_fence(__ATOMIC_RELEASE, "agent");
      asm volatile("s_waitcnt vmcnt(0)" ::: "memory");
      const unsigned og = xb_add(&bar[XB_TOP], 1u);
      const unsigned tg = og / nx;
      if (og + 1u == (tg + 1u) * nx) xb_add(&bar[XB_TOPGEN], 1u);
      else XB_SPIN(xb_ld(&bar[XB_TOPGEN]) == tg, bar);
      __builtin_amdgcn_fence(__ATOMIC_ACQUIRE, "agent");
      xb_add(&bar[XB_XGEN(b.x)], 1u);
      asm volatile("s_waitcnt vmcnt(0)" ::: "memory");
    } else {
      XB_SPIN(xb_ld(&bar[XB_XGEN(b.x)]) == gen, bar);
      __builtin_amdgcn_fence(__ATOMIC_ACQUIRE, "agent");
      asm volatile("s_waitcnt vmcnt(0)" ::: "memory");
    }
  }
  __syncthreads();
}

constexpr size_t RT_STRIDE = (size_t)T * 128 * 4;
__device__ __forceinline__ void route_unit(const Params& p, int l, int unit, unsigned char* lds) {
  int tid_ = threadIdx.x; asm volatile("" : "+v"(tid_)); const int tid = tid_, lane = tid & 63, wid = tid >> 6, r32 = lane & 31, hi = lane >> 5;
  unsigned char* IDX = lds;
  int* UE = (int*)(lds + 8192); float* UG = (float*)(lds + 8192 + 16384); float* US = (float*)(lds + 8192 + 32768);
  int* EIDG = (int*)(p.ws + WS_ULOC); float* GWG = (float*)(p.ws + WS_ULOC + RT_STRIDE); float* SUG = (float*)(p.ws + WS_ULOC + 2 * RT_STRIDE);
  const float* PSC = (const float*)(p.ws + WS_PSC);
  const int row0 = unit * 32;
  const bf16_t* QP = (const bf16_t*)(p.ws + WS_PROJ);
  const bf16_t* KEYS = (const bf16_t*)(p.ws + WS_KEYS) + (size_t)l * 131072;
  for (int rrep = 0; rrep < REP_ROUTE; ++rrep) {
    const int h = wid;
    float top[2][16];
#pragma unroll
    for (int pp = 0; pp < 2; ++pp) {
      const bf16_t* qrow = QP + (size_t)(row0 + r32) * DM + h * 128 + pp * 64 + hi * 8;
      const bf16_t* kb = KEYS + ((size_t)(h * 2 + pp) * 128 + r32) * 64 + hi * 8;
      bf16x8 bq[4];
#pragma unroll
      for (int ks = 0; ks < 4; ++ks) bq[ks] = *(const bf16x8*)(qrow + ks * 16);
      float (&lst)[16] = top[pp];
#pragma unroll
      for (int i = 0; i < 16; ++i) lst[i] = -INFINITY;
#pragma unroll
      for (int nt = 0; nt < 4; ++nt) {
        f32x16 acc = {};
#pragma unroll
        for (int ks = 0; ks < 4; ++ks) {
          const bf16x8 ak = *(const bf16x8*)(kb + (size_t)nt * 32 * 64 + ks * 16);
          acc = __builtin_amdgcn_mfma_f32_32x32x16_bf16(ak, bq[ks], acc, 0, 0, 0);
        }
        float grp[16];
#pragma unroll
        for (int r = 0; r < 16; ++r) grp[r] = __uint_as_float((__float_as_uint(acc[r]) & ~0x7Fu) | (unsigned)(nt * 32 + crow(r, hi)));
        bsort16(grp);
        if (nt == 0) {
#pragma unroll
          for (int i = 0; i < 16; ++i) lst[i] = grp[i];
        } else bmerge16(lst, grp);
        SBAR();
      }
      float oth[16];
#pragma unroll
      for (int i = 0; i < 16; ++i) oth[i] = __shfl_xor(lst[i], 32);
      bmerge16(lst, oth);
      if (hi == 0) {
        unsigned w[4];
#pragma unroll
        for (int i = 0; i < 4; ++i)
          w[i] = (__float_as_uint(lst[4 * i]) & 0x7Fu) | ((__float_as_uint(lst[4 * i + 1]) & 0x7Fu) << 8) | ((__float_as_uint(lst[4 * i + 2]) & 0x7Fu) << 16) | ((__float_as_uint(lst[4 * i + 3]) & 0x7Fu) << 24);
        *(u32x4*)(IDX + ((r32 * 8 + h) * 2 + pp) * 16) = (u32x4){w[0], w[1], w[2], w[3]};
      }
    }
    float best[16];
#define CAND(i, j) __uint_as_float((__float_as_uint(__uint_as_float(__float_as_uint(top[0][i]) & ~0x7Fu) + __uint_as_float(__float_as_uint(top[1][j]) & ~0x7Fu)) & ~0xFFu) | (unsigned)((i) * 16 + (j)))
    {
#pragma unroll
      for (int j = 0; j < 16; ++j) best[j] = CAND(0, j);
      float y[16];
#pragma unroll
      for (int j = 0; j < 8; ++j) { y[j] = CAND(1, j); y[8 + j] = CAND(15 - j, 0); }
#pragma unroll
      for (int jj = 8; jj > 0; jj >>= 1)
#pragma unroll
        for (int i = 0; i < 16; ++i) { const int q = i ^ jj; if (q > i) { const float hi_ = fmaxf(y[i], y[q]), lo_ = fminf(y[i], y[q]); y[i] = hi_; y[q] = lo_; } }
      bmerge16(best, y);
      float x[16];
      x[0] = CAND(2, 0); x[1] = CAND(2, 1); x[2] = CAND(2, 2); x[3] = CAND(2, 3); x[4] = CAND(2, 4);
      x[5] = CAND(3, 0); x[6] = CAND(3, 1); x[7] = CAND(3, 2); x[8] = CAND(3, 3);
      x[9] = CAND(4, 0); x[10] = CAND(4, 1); x[11] = CAND(4, 2);
      x[12] = CAND(5, 0); x[13] = CAND(5, 1); x[14] = CAND(6, 0); x[15] = CAND(6, 1);
      bsort16(x);
      bmerge16(best, x);
      ins16(best, CAND(7, 0)); ins16(best, CAND(7, 1));
    }
#undef CAND
    asm volatile("s_waitcnt lgkmcnt(0)" ::: "memory");
    if (hi == 0) {
      const unsigned char* ib = IDX + ((r32 * 8 + h) * 2) * 16;
      const float mx = __uint_as_float(__float_as_uint(best[0]) & ~0xFFu);
      float w[16]; float sum = 0.f;
#pragma unroll
      for (int k = 0; k < 16; ++k) { w[k] = __expf(__uint_as_float(__float_as_uint(best[k]) & ~0xFFu) - mx); sum += w[k]; }
      const float rsum = 1.f / sum;
      int ee[16]; float su_[16], sv_[16];
#pragma unroll
      for (int k = 0; k < 16; ++k) {
        const unsigned ij = __float_as_uint(best[k]) & 0xFFu;
        ee[k] = (int)ib[ij >> 4] * 128 + (int)ib[16 + (ij & 15)];
      }
#pragma unroll
      for (int k = 0; k < 16; ++k) { su_[k] = PSC[(size_t)l * NEXP + ee[k]]; sv_[k] = PSC[(size_t)(DEPTH + l) * NEXP + ee[k]]; }
#pragma unroll
      for (int k = 0; k < 16; ++k) {
        UE[r32 * 128 + h * 16 + k] = ee[k]; UG[r32 * 128 + h * 16 + k] = w[k] * rsum * sv_[k];
        US[r32 * 128 + h * 16 + k] = su_[k];
      }
    }
  }
  __syncthreads();
#pragma unroll 1
  for (int tt = 0; tt < 4; ++tt) {
    const int t = wid * 4 + tt;
    const int k0 = UE[t * 128 + lane], k1 = UE[t * 128 + 64 + lane];
    const float g0 = UG[t * 128 + lane], g1 = UG[t * 128 + 64 + lane], s0 = US[t * 128 + lane], s1 = US[t * 128 + 64 + lane];
    const int b0 = k0 >> 10, b1 = k1 >> 10;
    int base = 0, pos0 = 0, pos1 = 0;
#pragma unroll
    for (int b = 0; b < 16; ++b) {
      const unsigned long long m0 = __ballot(b0 == b), m1 = __ballot(b1 == b);
      const int c0 = __popcll(m0), c1 = __popcll(m1);
      const unsigned long long lt = (1ull << lane) - 1ull;
      if (b0 == b) pos0 = base + __popcll(m0 & lt);
      if (b1 == b) pos1 = base + c0 + __popcll(m1 & lt);
      base += c0 + c1;
    }
    const size_t ro = (size_t)(row0 + t) * 128;
    EIDG[ro + pos0] = k0; GWG[ro + pos0] = g0; SUG[ro + pos0] = s0;
    EIDG[ro + pos1] = k1; GWG[ro + pos1] = g1; SUG[ro + pos1] = s1;
  }
}
struct TokPref { int e0, e1; float g0, g1, s0, s1; u32x4 hA, hB; };
__device__ __forceinline__ void tok_prefetch(const Params& p, int row, int lane, TokPref& t) {
  const int* EIDG = (const int*)(p.ws + WS_ULOC) + (size_t)row * 128; const float* GWG = (const float*)(p.ws + WS_ULOC + RT_STRIDE) + (size_t)row * 128;
  const float* SUG = (const float*)(p.ws + WS_ULOC + 2 * RT_STRIDE) + (size_t)row * 128;
  const bf16_t* H = (const bf16_t*)(p.ws + WS_H);
  t.e0 = EIDG[lane]; t.e1 = EIDG[64 + lane]; t.g0 = GWG[lane]; t.g1 = GWG[64 + lane]; t.s0 = SUG[lane]; t.s1 = SUG[64 + lane];
  t.hA = *(const u32x4*)(H + (size_t)row * DM + lane * 16); t.hB = *(const u32x4*)(H + (size_t)row * DM + lane * 16 + 8);
}
__device__ __forceinline__ void gather_token(const Params& p, int l, int row, int nextrow, TokPref& tp, unsigned char* lds, int lane, int wid) {
  int* EW = (int*)(lds + wid * 2048); float* GWl = (float*)(lds + wid * 2048 + 512); float* SWl = (float*)(lds + wid * 2048 + 1024);
  const bf16_t* H = (const bf16_t*)(p.ws + WS_H);
  const unsigned char* PUq = p.ws + WS_PU + (size_t)l * NEXP * DM;
  const unsigned char* PVq = p.ws + WS_PV + (size_t)l * NEXP * DM;
  float* XC = (float*)(p.ws + WS_XCUR);
  const float* MOD = (const float*)(p.ws + WS_MOD);
  EW[lane] = tp.e0; EW[64 + lane] = tp.e1; GWl[lane] = tp.g0; GWl[64 + lane] = tp.g1; SWl[lane] = tp.s0; SWl[64 + lane] = tp.s1;
  asm volatile("s_waitcnt lgkmcnt(0)" ::: "memory");
  {
    float hf[16];
    {
      const u32x4 hA = tp.hA, hB = tp.hB;
      hf[0] = bflo(hA.x); hf[1] = bfhi(hA.x); hf[2] = bflo(hA.y); hf[3] = bfhi(hA.y); hf[4] = bflo(hA.z); hf[5] = bfhi(hA.z); hf[6] = bflo(hA.w); hf[7] = bfhi(hA.w);
      hf[8] = bflo(hB.x); hf[9] = bfhi(hB.x); hf[10] = bflo(hB.y); hf[11] = bfhi(hB.y); hf[12] = bflo(hB.z); hf[13] = bfhi(hB.z); hf[14] = bflo(hB.w); hf[15] = bfhi(hB.w);
    }
    if (nextrow >= 0) tok_prefetch(p, nextrow, lane, tp);
    f32x4 xpre[4];
    { const float* xr_ = XC + (size_t)row * DM + lane * 16;
#pragma unroll
      for (int v4 = 0; v4 < 4; ++v4) xpre[v4] = *(const f32x4*)(xr_ + v4 * 4); }
    float acc[16];
    for (int rep = 0; rep < REP_PEER; ++rep) {
#pragma unroll
    for (int i = 0; i < 16; ++i) acc[i] = 0.f;
    u32x4 uq[8];
#pragma unroll
    for (int i = 0; i < 8; ++i) { const int e0 = __builtin_amdgcn_readfirstlane(EW[i]); uq[i] = *(const u32x4*)(PUq + (size_t)e0 * DM + lane * 16); }
    for (int g8 = 0; g8 < 16; ++g8) {
      int eid[8]; float gwt[8]; u32x4 vq[8];
#pragma unroll
      for (int i = 0; i < 8; ++i) {
        eid[i] = __builtin_amdgcn_readfirstlane(EW[g8 * 8 + i]);
        gwt[i] = __uint_as_float(__builtin_amdgcn_readfirstlane(__float_as_uint(GWl[g8 * 8 + i])));
        vq[i] = *(const u32x4*)(PVq + (size_t)eid[i] * DM + lane * 16);
      }
      float d[8];
#pragma unroll
      for (int i = 0; i < 8; ++i) {
        const float su = __uint_as_float(__builtin_amdgcn_readfirstlane(__float_as_uint(SWl[g8 * 8 + i])));
        float a0 = 0.f, a1 = 0.f;
#define DQ(W, K) { const f32x2 lo_ = __builtin_amdgcn_cvt_pk_f32_fp8((int)(W), false), hi_ = __builtin_amdgcn_cvt_pk_f32_fp8((int)(W), true); \
          a0 += lo_.x * hf[K]; a1 += lo_.y * hf[K + 1]; a0 += hi_.x * hf[K + 2]; a1 += hi_.y * hf[K + 3]; }
        DQ(uq[i].x, 0) DQ(uq[i].y, 4) DQ(uq[i].z, 8) DQ(uq[i].w, 12)
#undef DQ
        d[i] = (a0 + a1) * su;
      }
      if (g8 < 15) {
#pragma unroll
        for (int i = 0; i < 8; ++i) { const int e0 = __builtin_amdgcn_readfirstlane(EW[(g8 + 1) * 8 + i]); uq[i] = *(const u32x4*)(PUq + (size_t)e0 * DM + lane * 16); }
      }
      float tot;
      {
        auto s01 = __builtin_amdgcn_permlane32_swap(__float_as_uint(d[0]), __float_as_uint(d[1]), false, false);
        auto s23 = __builtin_amdgcn_permlane32_swap(__float_as_uint(d[2]), __float_as_uint(d[3]), false, false);
        auto s45 = __builtin_amdgcn_permlane32_swap(__float_as_uint(d[4]), __float_as_uint(d[5]), false, false);
        auto s67 = __builtin_amdgcn_permlane32_swap(__float_as_uint(d[6]), __float_as_uint(d[7]), false, false);
        const float q01 = __uint_as_float(s01[0]) + __uint_as_float(s01[1]), q23 = __uint_as_float(s23[0]) + __uint_as_float(s23[1]);
        const float q45 = __uint_as_float(s45[0]) + __uint_as_float(s45[1]), q67 = __uint_as_float(s67[0]) + __uint_as_float(s67[1]);
        auto ta = __builtin_amdgcn_permlane16_swap(__float_as_uint(q01), __float_as_uint(q23), false, false);
        auto tb = __builtin_amdgcn_permlane16_swap(__float_as_uint(q45), __float_as_uint(q67), false, false);
        const float r0123 = __uint_as_float(ta[0]) + __uint_as_float(ta[1]);
        const float r4567 = __uint_as_float(tb[0]) + __uint_as_float(tb[1]);
        const bool b3 = (lane & 8) != 0;
        const float keep = b3 ? r4567 : r0123, send = b3 ? r0123 : r4567;
        float x = keep + __shfl_xor(send, 8);
        x += __shfl_xor(x, 4); x += __shfl_xor(x, 2); x += __shfl_xor(x, 1);
        tot = x;
      }
      float ge;
      {
        const float v = tot, av = fabsf(v), tq = __builtin_amdgcn_rcpf(av * 0.2316418882f + 1.0f);
        float q = tq * 0.5307027145f + (-0.7265760135f); q = q * tq + 0.7107068705f; q = q * tq + (-0.142248368f); q = q * tq + 0.127414796f; q = q * tq;
        const float ex = __builtin_amdgcn_exp2f(v * v * (-0.72134752044f));
        const float m = v * (q * ex), r = v - m;
        ge = v < 0.f ? m : r;
      }
      float c[8];
      c[0] = __uint_as_float(__builtin_amdgcn_readlane(__float_as_uint(ge), 0)) * gwt[0];  c[4] = __uint_as_float(__builtin_amdgcn_readlane(__float_as_uint(ge), 8)) * gwt[4];
      c[2] = __uint_as_float(__builtin_amdgcn_readlane(__float_as_uint(ge), 16)) * gwt[2]; c[6] = __uint_as_float(__builtin_amdgcn_readlane(__float_as_uint(ge), 24)) * gwt[6];
      c[1] = __uint_as_float(__builtin_amdgcn_readlane(__float_as_uint(ge), 32)) * gwt[1]; c[5] = __uint_as_float(__builtin_amdgcn_readlane(__float_as_uint(ge), 40)) * gwt[5];
      c[3] = __uint_as_float(__builtin_amdgcn_readlane(__float_as_uint(ge), 48)) * gwt[3]; c[7] = __uint_as_float(__builtin_amdgcn_readlane(__float_as_uint(ge), 56)) * gwt[7];
#pragma unroll
      for (int i = 0; i < 8; ++i) {
#define AQ(W, K) { const f32x2 lo_ = __builtin_amdgcn_cvt_pk_f32_fp8((int)(W), false), hi_ = __builtin_amdgcn_cvt_pk_f32_fp8((int)(W), true); \
          acc[K] += c[i] * lo_.x; acc[K + 1] += c[i] * lo_.y; acc[K + 2] += c[i] * hi_.x; acc[K + 3] += c[i] * hi_.y; }
        AQ(vq[i].x, 0) AQ(vq[i].y, 4) AQ(vq[i].z, 8) AQ(vq[i].w, 12)
#undef AQ
      }
    }
    }
    SBAR();
    const int mr = mod_row(row);
    const float* g2 = MOD + ((size_t)l * 5 + mr) * 6144 + 5 * 1024;
    float* xr = XC + (size_t)row * DM;
    float xn[16]; float ssq = 0.f;
    if (ABL & 8) {
#pragma unroll
      for (int i = 0; i < 16; ++i) acc[i] = 0.f;
    }
#pragma unroll
    for (int v4 = 0; v4 < 4; ++v4) {
      const int c = lane * 16 + v4 * 4;
      const f32x4 xo = xpre[v4], gg = *(const f32x4*)(g2 + c);
      f32x4 o;
      o.x = xo.x + gg.x * acc[v4 * 4 + 0]; o.y = xo.y + gg.y * acc[v4 * 4 + 1]; o.z = xo.z + gg.z * acc[v4 * 4 + 2]; o.w = xo.w + gg.w * acc[v4 * 4 + 3];
      xn[v4 * 4 + 0] = o.x; xn[v4 * 4 + 1] = o.y; xn[v4 * 4 + 2] = o.z; xn[v4 * 4 + 3] = o.w;
      ssq += (o.x * o.x + o.y * o.y) + (o.z * o.z + o.w * o.w);
      if (l < DEPTH - 1) *(f32x4*)(xr + c) = o;
    }
    const float rs = rsqrtf(wave_sum(ssq) * (1.f / DM) + EPS);
    if (l == DEPTH - 1) {
      const int b = row / SEGL, s = row - b * SEGL;
      float* orow = p.out + ((size_t)(b * SEQ + (s - CTXL))) * DM;
      const float* fg = p.in[I_FINALG];
#pragma unroll
      for (int v4 = 0; v4 < 4; ++v4) {
        const int c = lane * 16 + v4 * 4;
        const f32x4 gg = *(const f32x4*)(fg + c);
        f32x4 o; o.x = xn[v4 * 4 + 0] * rs * gg.x; o.y = xn[v4 * 4 + 1] * rs * gg.y; o.z = xn[v4 * 4 + 2] * rs * gg.z; o.w = xn[v4 * 4 + 3] * rs * gg.w;
        *(f32x4*)(orow + c) = o;
      }
    } else {
      const float* m = MOD + ((size_t)(l + 1) * 5 + mr) * 6144;
      const float* ng = p.in[I_N1G] + (l + 1) * DM;
      bf16_t* hrow = (bf16_t*)(p.ws + WS_H) + (size_t)row * DM;
#pragma unroll
      for (int hh = 0; hh < 2; ++hh) {
        float y[8];
#pragma unroll
        for (int i = 0; i < 8; ++i) { const int c = lane * 16 + hh * 8 + i; y[i] = xn[hh * 8 + i] * rs * ng[c] * (1.f + m[1024 + c]) + m[c]; }
        u32x4 w; w.x = cvtpk(y[0], y[1]); w.y = cvtpk(y[2], y[3]); w.z = cvtpk(y[4], y[5]); w.w = cvtpk(y[6], y[7]);
        *(u32x4*)(hrow + lane * 16 + hh * 8) = w;
      }
    }
  }
}

__device__ __forceinline__ void phase_c1(const Params& p, int l, unsigned char* lds) {
  constexpr int NLOC = NBATCH * 4 * NCH, NCONV = T / 32;
  for (int u = p.bx; u < NLOC + NCONV; u += p.gx) {
    if (u < NLOC) ml_local_unit2(p, l, u, lds);
    else {
      const int cu = u - NLOC;
      if (l == DEPTH - 1 && (cu % (SEGL / 32)) < (CTXL / 32)) continue;
      conv_unit(p, l, cu, lds);
    }
  }
}
__device__ __forceinline__ void phase_c2(const Params& p, int l, unsigned char* lds) {
  ml_scan(p, lds);
  const float* lp = p.in[I_DLAM] + l * 256;
  float s01 = 0.f, s23 = 0.f;
  for (int i = 0; i < 64; ++i) { s01 += lp[i] * lp[64 + i]; s23 += lp[128 + i] * lp[192 + i]; }
  const float lam_init = 0.8f - 0.6f * expf(-0.3f * (float)l);
  const float lam = expf(s01) - expf(s23) + lam_init;
  const bf16_t* PROJ = (const bf16_t*)(p.ws + WS_PROJ);
  bf16_t* MIX = (bf16_t*)(p.ws + WS_MIX);
  const float* ng = p.in[I_DNORMG] + l * 128;
  const int nun = 512 + (l < DEPTH - 1 ? 16 : 0);
  for (int u = p.bx; u < nun; u += p.gx) {
    int bh, qrow, nkeys;
    if (u < 512) { const int xcd = u & 7, i = (u >> 3) & 31, rnd = u >> 8; bh = 2 * xcd + rnd; qrow = CTXL + i * 256; nkeys = SEGL; }
    else { bh = u - 512; qrow = 0; nkeys = CTXL; }
    const int b = bh >> 2, h = bh & 3;
    const size_t tok0 = (size_t)b * SEGL;
    for (int rep = 0; rep < REP_ATT; ++rep)
    att_unit(PROJ + (tok0 + qrow) * PW + C_DQ + h * 128, PROJ + tok0 * PW + C_DK + h * 128, p.ws + WS_V8T + (size_t)bh * NCH * ATT_SHM_V,
             MIX + (tok0 + qrow) * DM + 512 + h * 128, nkeys, lam, ng, 1.f - lam_init, lds);
  }
}
__device__ __forceinline__ void phase_c3(const Params& p, int l, unsigned char* lds) {
  constexpr int NU = NBATCH * 4 * NCH;
  for (int u = p.bx; u < NU; u += p.gx) {
    if (l == DEPTH - 1 && (u % NCH) < 4) continue;
    ml_out_unit2(p, l, u, lds);
  }
}
__device__ __forceinline__ void phase_route(const Params& p, int l, unsigned char* lds) {
  constexpr int NU = T / 32;
  for (int u = p.bx; u < NU; u += p.gx) {
    if (l == DEPTH - 1 && (u % (SEGL / 32)) < (CTXL / 32)) continue;
    route_unit(p, l, u, lds);
    __syncthreads();
  }
}
__device__ __forceinline__ void phase_gather(const Params& p, int l, unsigned char* lds) {
  int tid_ = threadIdx.x; asm volatile("" : "+v"(tid_)); const int lane = tid_ & 63, wid = tid_ >> 6;
  const int gw = p.bx * 8 + wid, NGW = p.gx * 8;
  const int ntok = (l == DEPTH - 1) ? NBATCH * SEQ : T;
#define TOKROW(ti_) ((l == DEPTH - 1) ? ((ti_) / SEQ) * SEGL + CTXL + ((ti_) % SEQ) : (ti_))
  TokPref tp;
  if (gw < ntok) tok_prefetch(p, TOKROW(gw), lane, tp);
  XcdBarrier xb; xb.bar = p.xbar_words; xb.x = p.xbar_x; xb.st = (volatile LAS unsigned*)((LAS unsigned char*)lds + p.lds_st_off);
  const int nrounds = (ntok + NGW - 1) / NGW;
  for (int r = 0; r < nrounds; ++r) {
    const int ti = gw + r * NGW;
    if (ti < ntok) {
      const int row = TOKROW(ti);
      const int nxt = ti + NGW < ntok ? TOKROW(ti + NGW) : -1;
      gather_token(p, l, row, nxt, tp, lds, lane, wid);
    }
#if GATHER_SYNC
    if (r + 1 < nrounds) { XcdBarrier xb2 = xb; size_t zb_ = 0; asm volatile("" : "+s"(zb_)); xb2.bar = xb.bar + zb_; xb2.x = xb.x + (unsigned)zb_; xcd_barrier(xb2); }
#endif
  }
#undef TOKROW
}

__global__ void __launch_bounds__(512, 2) mk_fwd(KArgs ka) {
  cg::grid_group grid = cg::this_grid();
  extern __shared__ __attribute__((aligned(16))) unsigned char lds[];
  const int lo = ka.ph_lo, hi = ka.ph_hi;
#define IN(k) (lo <= (k) && (k) < hi)
#ifndef PHASEMASK
#define PHASEMASK 0xFFFF
#endif
#define PH(i) ((PHASEMASK >> (i)) & 1)
#define MKP(q) Params q; { size_t z_ = 0; asm volatile("" : "+s"(z_)); \
    q.in = (InTab)((const __attribute__((address_space(4))) char*)__builtin_amdgcn_kernarg_segment_ptr() + z_); \
    q.out = ka.out + z_; q.ws = ka.ws + z_; q.ph_lo = lo; q.ph_hi = hi; q.bx = (int)blockIdx.x + (int)z_; q.gx = (int)gridDim.x + (int)z_; q.xbar_words = xbar.bar + z_; q.xbar_x = xbar.x + (unsigned)z_; q.lds_st_off = (unsigned)(LDS_BYTES - 64); }
#define SEAM(k) do { if (IN(k) && IN((k) + 1)) { if ((k) == 0) grid.sync(); else { XcdBarrier xb_ = xbar; size_t zb_ = 0; asm volatile("" : "+s"(zb_)); xb_.bar = xbar.bar + zb_; xb_.x = xbar.x + (unsigned)zb_; xcd_barrier(xb_); } } } while (0)
  volatile LAS unsigned* xst = (volatile LAS unsigned*)((LAS unsigned char*)lds + (LDS_BYTES - 64));
  if (threadIdx.x < 2) xst[threadIdx.x] = 0u;
  __syncthreads();
  XcdBarrier xbar = xcd_barrier_post((unsigned*)(ka.ws + WS_CTL) + 4096, xst);
  { MKP(p)
    if (PH(0) && IN(0)) for (int rep = 0; rep < REP_MISC; ++rep) { p0_mod(p, lds, (float*)(p.ws + WS_MOD)); p0_convert(p, lds); }
  }
  SEAM(0);
  { MKP(p)
    if (PH(1) && IN(1)) phase_norm(p, 0, 0, true, false);
  }
  SEAM(1);
#define LAYER(LL) { \
    int l = (LL); asm volatile("" : "+s"(l)); \
    const int b = 2 + 9 * (LL); \
    { MKP(q) if (PH(2) && IN(b + 0)) for (int rep = 0; rep < REP_GEMM; ++rep) phase_inproj2(q, l, lds); } \
    SEAM(b + 0); \
    { MKP(q) if (PH(3) && IN(b + 1)) for (int rep = 0; rep < REP_ML; ++rep) phase_c1(q, l, lds); } \
    SEAM(b + 1); \
    { MKP(q) if (PH(4) && IN(b + 2)) phase_c2(q, l, lds); } \
    SEAM(b + 2); \
    { MKP(q) if (PH(5) && IN(b + 3)) for (int rep = 0; rep < REP_ML; ++rep) phase_c3(q, l, lds); } \
    SEAM(b + 3); \
    { MKP(q) if (PH(6) && IN(b + 4)) phase_outproj2(q, l, lds); } \
    SEAM(b + 4); \
    { MKP(q) if (PH(7) && IN(b + 5)) for (int rep = 0; rep < REP_MISC; ++rep) phase_norm(q, l, 1, false, (LL) == DEPTH - 1); } \
    SEAM(b + 5); \
    { MKP(q) if (PH(8) && IN(b + 6)) for (int rep = 0; rep < REP_GEMM; ++rep) phase_peerq2(q, l, lds); } \
    SEAM(b + 6); \
    { MKP(q) if (PH(9) && IN(b + 7)) phase_route(q, l, lds); } \
    SEAM(b + 7); \
    { MKP(q) if (PH(9) && IN(b + 8)) phase_gather(q, l, lds); } \
    SEAM(b + 8); }
  LAYER(0) LAYER(1) LAYER(2) LAYER(3)
#undef LAYER
#undef IN
#undef SEAM
#undef MKP
}

extern "C" void kernel_launch(void* const* d_in, const int* in_sizes, int n_in, void* d_out, int out_size,
                              void* d_ws, size_t ws_size, hipStream_t stream) {
  static int grid = 0;
  if (grid == 0) {
    int dev = 0, cus = 0, per_cu = 0;
    (void)hipGetDevice(&dev);
    (void)hipDeviceGetAttribute(&cus, hipDeviceAttributeMultiprocessorCount, dev);
    (void)hipFuncSetAttribute((const void*)mk_fwd, hipFuncAttributeMaxDynamicSharedMemorySize, LDS_BYTES);
    (void)hipOccupancyMaxActiveBlocksPerMultiprocessor(&per_cu, (const void*)mk_fwd, 512, LDS_BYTES);
    fprintf(stderr, "kernel_launch: cus %d per_cu %d ws %zu (need %zu) n_in %d\n", cus, per_cu, ws_size, (size_t)WS_END, n_in);
    if (ws_size < WS_END || n_in != 23 || per_cu < 1) { fprintf(stderr, "kernel_launch: bad configuration, nothing launched\n"); grid = -1; return; }
    grid = cus;
  }
  if (grid < 0) return;
  (void)hipMemsetAsync((char*)d_ws + WS_CTL, 0, 65536, stream);
  KArgs p{};
  for (int i = 0; i < 23; ++i) p.in[i] = (const float*)d_in[i];
  p.out = (float*)d_out; p.ws = (unsigned char*)d_ws; p.ph_lo = 0; p.ph_hi = 38;
  void* args[] = {&p};
  hipError_t e = hipLaunchCooperativeKernel((const void*)mk_fwd, dim3(grid), dim3(512), args, LDS_BYTES, stream);
  if (e != hipSuccess) fprintf(stderr, "cooperative launch failed: %s (grid %d)\n", hipGetErrorString(e), grid);
}
```

```cpp
#include <hip/hip_runtime.h>
#include <hip/hip_cooperative_groups.h>
#include <cstdio>
#include <cstdint>
namespace cg = cooperative_groups;

constexpr int DM = 1024, NBATCH = 4, SEQ = 8192, CTXL = 256, SEGL = CTXL + SEQ, T = NBATCH * SEGL, DEPTH = 4;
constexpr int IN_W = 3088, PW = 3072;
constexpr int C_A = 0, C_MQ = 512, C_MK = 768, C_MV = 1024, C_MO = 1280, C_DQ = 1536, C_DK = 2048, C_DV = 2560;
constexpr int NCH = SEGL / 64;
constexpr int NEXP = 16384;
constexpr float EPS = 1e-6f;
#ifndef ABL
#define ABL 0
#endif
#ifndef GATHER_SYNC
#define GATHER_SYNC 0
#endif
#ifndef REP_ATT
#define REP_ATT 1
#endif
#ifndef REP_PEER
#define REP_PEER 1
#endif
#ifndef REP_GEMM
#define REP_GEMM 1
#endif
#ifndef REP_ROUTE
#define REP_ROUTE 1
#endif
#ifndef REP_OUTP
#define REP_OUTP 1
#endif
#ifndef REP_ML
#define REP_ML 1
#endif
#ifndef REP_MISC
#define REP_MISC 1
#endif
constexpr float QSCALE = 0.125f * 1.4426950408889634f;

constexpr size_t MiB = 1u << 20;
constexpr size_t WS_CTL = 0, WS_MOD = 1 * MiB, WS_ROPE = 2 * MiB, WS_WG = 4 * MiB, WS_KEYS = 5 * MiB, WS_MLMETA = 6 * MiB,
                 WS_GATES = 7 * MiB, WS_WIN = 10 * MiB, WS_WOUT = 34 * MiB, WS_WQ = 42 * MiB, WS_PU = 50 * MiB, WS_PV = 114 * MiB, WS_PSC = 178 * MiB  ,
                 WS_XCUR = 306 * MiB, WS_H = 438 * MiB, WS_MIX = 504 * MiB, WS_PROJ = 570 * MiB, WS_ULOC = 768 * MiB, WS_V8T = 836 * MiB  , WS_END = 858 * MiB;
constexpr int USTRIDE = 4160;

constexpr int LDS_BYTES = 139264;

#define LAS __attribute__((address_space(3)))
typedef unsigned short bf16_t;
typedef short bf16x8 __attribute__((ext_vector_type(8)));
typedef short s16x4 __attribute__((ext_vector_type(4)));
typedef float f32x4 __attribute__((ext_vector_type(4)));
typedef float f32x16 __attribute__((ext_vector_type(16)));
typedef unsigned u32x4 __attribute__((ext_vector_type(4)));
typedef unsigned u32x2 __attribute__((ext_vector_type(2)));
typedef __bf16 bf16x2v __attribute__((ext_vector_type(2)));
typedef int i32x8 __attribute__((ext_vector_type(8)));
typedef float f32x2 __attribute__((ext_vector_type(2)));

struct KArgs {
  const float* in[23];
  float* out;
  unsigned char* ws;
  int ph_lo, ph_hi;
};
typedef const float* const __attribute__((address_space(4))) * InTab;
struct Params {
  InTab in;
  float* out;
  unsigned char* ws;
  int ph_lo, ph_hi;
  int bx, gx;
  unsigned* xbar_words; unsigned xbar_x; unsigned lds_st_off;
};
enum { I_X = 0, I_C, I_CTX, I_CCTX, I_ADAW, I_ADAB, I_N1G, I_N2G, I_WIN, I_CONVW, I_CONVB, I_CLNG, I_CLNB, I_GATEB, I_MNORMG, I_DLAM, I_DNORMG,
       I_WOUT, I_PWQ, I_PKEYS, I_PU, I_PV, I_FINALG };

__device__ __forceinline__ unsigned cvtpk(float lo, float hi) { unsigned r; asm volatile("v_cvt_pk_bf16_f32 %0, %1, %2" : "=v"(r) : "v"(lo), "v"(hi)); return r; }
__device__ __forceinline__ float bflo(unsigned u) { return __uint_as_float(u << 16); }
__device__ __forceinline__ float bfhi(unsigned u) { return __uint_as_float(u & 0xffff0000u); }
__device__ __forceinline__ float bf1(bf16_t u) { return __uint_as_float(((unsigned)u) << 16); }
__device__ __forceinline__ int crow(int r, int hi) { return (r & 3) + 8 * (r >> 2) + 4 * hi; }
__device__ __forceinline__ float wave_sum(float v) {
#pragma unroll
  for (int o = 1; o < 64; o <<= 1) v += __shfl_xor(v, o);
  return v;
}
__device__ __forceinline__ float wave_max(float v) {
#pragma unroll
  for (int o = 1; o < 64; o <<= 1) v = fmaxf(v, __shfl_xor(v, o));
  return v;
}
__device__ __forceinline__ float sigmoidf_(float x) { return 1.f / (1.f + __expf(-x)); }
__device__ __forceinline__ float logsigmoidf_(float x) { return fminf(x, 0.f) - log1pf(__expf(-fabsf(x))); }
__device__ __forceinline__ const float* in_row(const float* x, const float* ctx, int row) {
  const int b = row / SEGL, s = row - b * SEGL;
  return s < CTXL ? ctx + ((size_t)(b * CTXL + s)) * DM : x + ((size_t)(b * SEQ + (s - CTXL))) * DM;
}
__device__ __forceinline__ int mod_row(int row) { const int b = row / SEGL, s = row - b * SEGL; return s < CTXL ? 4 : b; }

__device__ __forceinline__ void p0_mod(const Params& p, unsigned char* lds, float* MOD) {
  float* sil = (float*)lds;
  float* red = (float*)(lds + 20480);
  int tid_ = threadIdx.x; asm volatile("" : "+v"(tid_)); const int tid = tid_, lane = tid & 63, wid = tid >> 6;
  for (int i = tid; i < 5 * 1024; i += 512) {
    const float v = i < 4096 ? p.in[I_C][i] : p.in[I_CCTX][i - 4096];
    sil[i] = v / (1.f + __expf(-v));
  }
  __syncthreads();
  for (int item = p.bx; item < DEPTH * 96; item += p.gx) {
    const int l = item / 96, j0 = (item % 96) * 64;
    const float* W = p.in[I_ADAW] + (size_t)l * DM * 6144 + j0 + lane;
    float a0 = 0.f, a1 = 0.f, a2 = 0.f, a3 = 0.f, a4 = 0.f;
    const int k0 = wid * 128;
#pragma unroll 8
    for (int k = k0; k < k0 + 128; ++k) {
      const float w = W[(size_t)k * 6144];
      a0 += sil[k] * w; a1 += sil[1024 + k] * w; a2 += sil[2048 + k] * w; a3 += sil[3072 + k] * w; a4 += sil[4096 + k] * w;
    }
    red[(wid * 5 + 0) * 64 + lane] = a0; red[(wid * 5 + 1) * 64 + lane] = a1; red[(wid * 5 + 2) * 64 + lane] = a2;
    red[(wid * 5 + 3) * 64 + lane] = a3; red[(wid * 5 + 4) * 64 + lane] = a4;
    __syncthreads();
    if (tid < 320) {
      const int r = tid >> 6;
      float s = 0.f;
#pragma unroll
      for (int w = 0; w < 8; ++w) s += red[(w * 5 + r) * 64 + lane];
      MOD[((size_t)l * 5 + r) * 6144 + j0 + lane] = s + p.in[I_ADAB][l * 6144 + j0 + lane];
    }
    __syncthreads();
  }
}
__device__ __forceinline__ void transpose_item(const float* W, int ldw, int srccol0, bf16_t* WT, int K, int n0, int k0, float* scr, int lane) {
#pragma unroll 8
  for (int i = 0; i < 32; ++i) { const int kk = 2 * i + (lane >> 5); scr[kk * 33 + (lane & 31)] = W[(size_t)(k0 + kk) * ldw + srccol0 + (lane & 31)]; }
  asm volatile("s_waitcnt lgkmcnt(0)" ::: "memory");
  const int c = lane & 7;
#pragma unroll
  for (int j = 0; j < 4; ++j) {
    const int n = (lane >> 3) + 8 * j; const float* s = scr + (8 * c) * 33 + n;
    u32x4 o; o.x = cvtpk(s[0], s[33]); o.y = cvtpk(s[66], s[99]); o.z = cvtpk(s[132], s[165]); o.w = cvtpk(s[198], s[231]);
    *(u32x4*)(WT + (size_t)(n0 + n) * K + k0 + 8 * c) = o;
  }
  asm volatile("s_waitcnt lgkmcnt(0)" ::: "memory");
}
__device__ __forceinline__ void convert_tables(const Params& p, int L, int wv, int nw, int lane) {
  unsigned char* PUq = p.ws + WS_PU; unsigned char* PVq = p.ws + WS_PV; float* PSC = (float*)(p.ws + WS_PSC);
  const int nrows = DEPTH * NEXP;
  for (int r = wv; r < 2 * NEXP; r += nw) {
    const int tb = r >= NEXP, rr = L * NEXP + (tb ? r - NEXP : r);
    const f32x4* srow = (const f32x4*)((tb ? p.in[I_PV] : p.in[I_PU]) + (size_t)rr * DM) + lane * 4;
    f32x4 v[4]; float mx = 0.f;
#pragma unroll
    for (int j = 0; j < 4; ++j) { v[j] = __builtin_nontemporal_load(srow + j); mx = fmaxf(mx, fmaxf(fmaxf(fabsf(v[j].x), fabsf(v[j].y)), fmaxf(fabsf(v[j].z), fabsf(v[j].w)))); }
    mx = wave_max(mx);
    const int eb = (int)((__float_as_uint(mx) >> 23) & 0xFFu);
    int sb = 261 - eb; sb = sb < 1 ? 1 : (sb > 253 ? 253 : sb);
    const float sc = __uint_as_float((unsigned)sb << 23), isc = __uint_as_float((unsigned)(254 - sb) << 23);
    u32x4 o;
    int w;
#define CV4(V, OUT) w = 0; w = __builtin_amdgcn_cvt_pk_fp8_f32(V.x * sc, V.y * sc, w, false); w = __builtin_amdgcn_cvt_pk_fp8_f32(V.z * sc, V.w * sc, w, true); OUT = (unsigned)w
    CV4(v[0], o.x); CV4(v[1], o.y); CV4(v[2], o.z); CV4(v[3], o.w);
#undef CV4
    *(u32x4*)((tb ? PVq : PUq) + (size_t)rr * DM + lane * 16) = o;
    if (lane == 0) PSC[(size_t)tb * nrows + rr] = isc;
  }
}
__device__ __forceinline__ void tail_filler_tables(const Params& p, int L, int nwg) {
  int tid_ = threadIdx.x; asm volatile("" : "+v"(tid_)); const int lane = tid_ & 63, wid = tid_ >> 6;
  const int nextra = nwg % p.gx, first = nextra, nidle = p.gx - nextra;
  if (p.bx < first) return;
  convert_tables(p, L, (p.bx - first) * 8 + wid, nidle * 8, lane);
}
__device__ __forceinline__ void p0_convert(const Params& p, unsigned char* lds) {
  int tid_ = threadIdx.x; asm volatile("" : "+v"(tid_)); const int tid = tid_, lane = tid & 63, wid = tid >> 6;
  const int gw = p.bx * 8 + wid, NGW = p.gx * 8;
  const size_t gt = (size_t)p.bx * 512 + tid, NGT = (size_t)p.gx * 512;
  float* scr = (float*)(lds + 32768) + wid * (64 * 33);
  bf16_t* WIN = (bf16_t*)(p.ws + WS_WIN); bf16_t* WOUT = (bf16_t*)(p.ws + WS_WOUT); bf16_t* WQ = (bf16_t*)(p.ws + WS_WQ);
  constexpr int I_IN = 16 * 96, I_O = 16 * 32, PER_L = I_IN + 2 * I_O;
  for (int it = gw; it < DEPTH * PER_L; it += NGW) {
    const int l = it / PER_L; int r = it % PER_L;
    if (r < I_IN) { const int kb = r / 96, nb = r % 96, n0 = nb * 32; const int src = n0 < 1536 ? n0 : n0 + 16;
      transpose_item(p.in[I_WIN] + (size_t)l * DM * IN_W, IN_W, src, WIN + (size_t)l * PW * DM, DM, n0, kb * 64, scr, lane); continue; }
    r -= I_IN;
    if (r < I_O) { const int kb = r / 32, nb = r % 32;
      transpose_item(p.in[I_WOUT] + (size_t)l * DM * DM, DM, nb * 32, WOUT + (size_t)l * DM * DM, DM, nb * 32, kb * 64, scr, lane); continue; }
    r -= I_O;
    { const int kb = r / 32, nb = r % 32;
      transpose_item(p.in[I_PWQ] + (size_t)l * DM * DM, DM, nb * 32, WQ + (size_t)l * DM * DM, DM, nb * 32, kb * 64, scr, lane); }
  }
  bf16_t* WG = (bf16_t*)(p.ws + WS_WG);
  for (size_t i = gt; i < (size_t)DEPTH * 16 * DM; i += NGT) {
    const int l = (int)(i / (16 * DM)), g = (int)((i / DM) % 16), k = (int)(i % DM);
    WG[i] = (bf16_t)(cvtpk(p.in[I_WIN][(size_t)l * DM * IN_W + (size_t)k * IN_W + 1536 + g], 0.f) & 0xffffu);
  }
  bf16_t* KEYS = (bf16_t*)(p.ws + WS_KEYS);
  for (size_t i = gt; i < (size_t)DEPTH * 131072 / 8; i += NGT) {
    const f32x4 a = ((const f32x4*)p.in[I_PKEYS])[2 * i], b = ((const f32x4*)p.in[I_PKEYS])[2 * i + 1];
    u32x4 o; o.x = cvtpk(a.x, a.y); o.y = cvtpk(a.z, a.w); o.z = cvtpk(b.x, b.y); o.w = cvtpk(b.z, b.w);
    ((u32x4*)KEYS)[i] = o;
  }
  {
    float* RC = (float*)(p.ws + WS_ROPE); float* RS = RC + SEQ * 32;
    for (size_t i = gt; i < (size_t)SEQ * 32; i += NGT) {
      const int pos = (int)(i >> 5), j = (int)(i & 31);
      const int rr = pos >> 6, cc = pos & 63;
      const int jj = j & 15;
      const double e = -(double)jj * 0.83048202372184058696;
      const double fl = __builtin_floor(e); const double f = e - fl;
      const double z = f * 0.69314718055994530942;
      double ez = 1.0 + z * (1.0 + z * (0.5 + z * (1.0 / 6 + z * (1.0 / 24 + z * (1.0 / 120 + z * (1.0 / 720 + z * (1.0 / 5040 + z * (1.0 / 40320 + z * (1.0 / 362880 + z * (1.0 / 3628800 + z * (1.0 / 39916800 + z * (1.0 / 479001600))))))))))));
      const double inv = __builtin_ldexp(ez, (int)fl);
      const float invf = (float)inv;
      const float angf = (float)(j < 16 ? rr : cc) * invf;
      const double ang = (double)angf;
      const double kq = __builtin_rint(ang * 0.63661977236758134308);
      double r = __builtin_fma(-kq, 1.57079632679489655800e+00, ang);
      r = __builtin_fma(-kq, 6.12323399573676603587e-17, r);
      const double r2 = r * r;
      const double sn = r * (1.0 + r2 * (-1.0 / 6 + r2 * (1.0 / 120 + r2 * (-1.0 / 5040 + r2 * (1.0 / 362880 + r2 * (-1.0 / 39916800 + r2 * (1.0 / 6227020800.0)))))));
      const double cs = 1.0 + r2 * (-0.5 + r2 * (1.0 / 24 + r2 * (-1.0 / 720 + r2 * (1.0 / 40320 + r2 * (-1.0 / 3628800 + r2 * (1.0 / 479001600 + r2 * (-1.0 / 87178291200.0)))))));
      const int q = ((int)kq) & 3;
      double co, si;
      if (q == 0) { co = cs; si = sn; } else if (q == 1) { co = -sn; si = cs; } else if (q == 2) { co = -cs; si = -sn; } else { co = sn; si = -cs; }
      RC[i] = (float)co; RS[i] = (float)si;
    }
  }
}

__device__ __forceinline__ void norm_mod_row(const float* xrow, const float* g, const float* sc, const float* sh, bf16_t* orow, int lane) {
  const f32x4* xr = (const f32x4*)xrow + lane;
  f32x4 v[4]; float s = 0.f;
#pragma unroll
  for (int j = 0; j < 4; ++j) { v[j] = xr[64 * j]; s += (v[j].x * v[j].x + v[j].y * v[j].y) + (v[j].z * v[j].z + v[j].w * v[j].w); }
  const float rs = rsqrtf(wave_sum(s) * (1.f / DM) + EPS);
  u32x2* o = (u32x2*)orow + lane;
#pragma unroll
  for (int j = 0; j < 4; ++j) {
    const f32x4 gg = ((const f32x4*)g)[lane + 64 * j], cc = ((const f32x4*)sc)[lane + 64 * j], hh = ((const f32x4*)sh)[lane + 64 * j];
    const float y0 = v[j].x * rs * gg.x * (1.f + cc.x) + hh.x, y1 = v[j].y * rs * gg.y * (1.f + cc.y) + hh.y;
    const float y2 = v[j].z * rs * gg.z * (1.f + cc.z) + hh.z, y3 = v[j].w * rs * gg.w * (1.f + cc.w) + hh.w;
    u32x2 w; w.x = cvtpk(y0, y1); w.y = cvtpk(y2, y3);
    o[64 * j] = w;
  }
}
__device__ __forceinline__ void phase_norm(const Params& p, int l, int which, bool from_input, bool skip_ctx) {
  int tid_ = threadIdx.x; asm volatile("" : "+v"(tid_));
  const int lane = tid_ & 63, wid = tid_ >> 6;
  const int gw = p.bx * 8 + wid, NGW = p.gx * 8;
  const float* MOD = (const float*)(p.ws + WS_MOD);
  const float* XC = (const float*)(p.ws + WS_XCUR);
  bf16_t* H = (bf16_t*)(p.ws + WS_H);
  const float* g = p.in[which ? I_N2G : I_N1G] + l * DM;
  for (int row = gw; row < T; row += NGW) {
    const int mr = mod_row(row);
    if (skip_ctx && mr == 4) continue;
    const float* m = MOD + ((size_t)l * 5 + mr) * 6144 + which * 3072;
    const float* xr = from_input ? in_row(p.in[I_X], p.in[I_CTX], row) : XC + (size_t)row * DM;
    norm_mod_row(xr, g, m + 1024, m, H + (size_t)row * DM, lane);
  }
}

namespace pg8 {
#define PG8_LAS __attribute__((address_space(3)))
typedef unsigned short bf16_t;
typedef short bf16x8 __attribute__((ext_vector_type(8)));
typedef float f32x4 __attribute__((ext_vector_type(4)));
typedef unsigned u32x4 __attribute__((ext_vector_type(4)));
constexpr int BM = 256, BK = 64, HALF = 128, HTB = HALF * BK * 2  , STAGE_BYTES = 8 * HTB, NXCD = 8, WGM = 8;

__host__ __device__ __forceinline__ int lds_byte(int r, int c) { const int st = (r >> 4) * 2 + (c >> 5), rr = r & 15, cc = c & 31, ob = rr * 64 + cc * 2; return st * 1024 + (ob ^ (((ob >> 9) & 1) << 5)); }
__host__ __device__ __forceinline__ void stage_rc(int b, int& R, int& C) { const int st = b / 1024, sb = b % 1024, swz = sb ^ (((sb >> 9) & 1) << 5); R = (st >> 1) * 16 + swz / 64; C = (st & 1) * 32 + (swz % 64) / 2; }
__host__ __device__ __forceinline__ int perm32(int rho) { const int n = rho >> 4, i = rho & 15; return 8 * (i >> 2) + 4 * n + (i & 3); }

struct Unit { int pm, pn; };
struct Gemm { const bf16_t* A; const bf16_t* Bt; int M, N, K; };

struct StaticOrder {
    int nM, nN, nwg, G, c;
    __host__ __device__ void init(int M, int N, int G_, int c_) { nM = M / BM; nN = N / BM; nwg = nM * nN; G = G_; c = c_; }
    __host__ __device__ bool next(int i, Unit& u) const {
        const long L = (long)i * G + c; if (L >= nwg) return false;
        int wgid = (int)L; { const int q = nwg / NXCD, r = nwg % NXCD, xcd = wgid % NXCD, off = wgid / NXCD; wgid = (xcd < r ? xcd * (q + 1) : r * (q + 1) + (xcd - r) * q) + off; }
        const int nig = WGM * nN, gid = wgid / nig, fm = gid * WGM, gsz = (nM - fm) < WGM ? (nM - fm) : WGM;
        u.pm = fm + ((wgid % nig) % gsz); u.pn = (wgid % nig) / gsz; return true;
    }
    __device__ __forceinline__ void a_ready(const Unit&) const {}
    __device__ __forceinline__ void done(const Unit&) const {}
};
__device__ __forceinline__ unsigned cvt_pk_bf16(float lo, float hi) { unsigned r; asm volatile("v_cvt_pk_bf16_f32 %0, %1, %2" : "=v"(r) : "v"(lo), "v"(hi)); return r; }
template <class Epi, class Sched, bool ALIGN_EPI = false, bool SP2 = false>
__device__ __forceinline__ void gemm_phase(PG8_LAS unsigned char* lds, const Gemm g, const Sched& S, const Epi& E) {
    const int tid = threadIdx.x, wid = __builtin_amdgcn_readfirstlane(tid >> 6), lane = tid & 63, wr = wid >> 2, wc = wid & 3, fr = lane & 15, fq = lane >> 4;
    const int K = g.K, nt = K / BK;
    unsigned voffA[2], voffB[2];
#pragma unroll
    for (int i = 0; i < 2; ++i) { int R, C; stage_rc(tid * 16 + i * 8192, R, C); const int Rb = Epi::PERM ? ((R & ~31) + perm32(R & 31)) : R;
        voffA[i] = (unsigned)(R * K + C) * 2u; voffB[i] = (unsigned)(Rb * K + C) * 2u; }
    const size_t kstep = (size_t)(BK * 2);
    const size_t hstep = (size_t)HALF * K * 2;
    const size_t tstep = 2 * hstep;
    const unsigned ldsw = (unsigned)wid * 1024u;
    const int aoff = lds_byte(wr * 64 + fr, fq * 8), boff = lds_byte(wc * 32 + fr, fq * 8);
#define PG8_SA(b, h) (((b) * 2 + (h)) * HTB)
#define PG8_SB(b, h) ((4 + (b) * 2 + (h)) * HTB)
#define PG8_STAGE(bufoff, gbase, voff) do { _Pragma("unroll") for (int _i = 0; _i < 2; ++_i) \
        __builtin_amdgcn_global_load_lds((const unsigned*)((const char*)(gbase) + (voff)[_i]), (PG8_LAS unsigned*)(lds + (bufoff) + ldsw + _i * 8192), 16, 0, 0); } while (0)
#define PG8_LDA(dst, b, h) do { _Pragma("unroll") for (int m = 0; m < 4; ++m) _Pragma("unroll") for (int k = 0; k < 2; ++k) dst[m][k] = *(const PG8_LAS bf16x8*)(lds + PG8_SA(b, h) + aoff + m * 2048 + k * 1024); } while (0)
#define PG8_LDB(dst, b, h) do { _Pragma("unroll") for (int n = 0; n < 2; ++n) _Pragma("unroll") for (int k = 0; k < 2; ++k) dst[n][k] = *(const PG8_LAS bf16x8*)(lds + PG8_SB(b, h) + boff + n * 2048 + k * 1024); } while (0)
#define PG8_MMA(ai, bj, At, Bt) do { __builtin_amdgcn_s_setprio(1); _Pragma("unroll") for (int m = 0; m < 4; ++m) _Pragma("unroll") for (int n = 0; n < 2; ++n) _Pragma("unroll") for (int k = 0; k < 2; ++k) \
        acc[ai][bj][m][n] = __builtin_amdgcn_mfma_f32_16x16x32_bf16(Bt[n][k], At[m][k], acc[ai][bj][m][n], 0, 0, 0); __builtin_amdgcn_s_setprio(0); } while (0)
#define PG8_WAIT_V(n) asm volatile("s_waitcnt vmcnt(" #n ")" ::: "memory")
#define PG8_WAIT_L(n) asm volatile("s_waitcnt lgkmcnt(" #n ")" ::: "memory")
#define PG8_BAR __builtin_amdgcn_s_barrier()
#define PG8_SCHED __builtin_amdgcn_sched_barrier(0)
    Unit cur, nxt; int ui = 0;
    if (!S.next(0, cur)) return;
    f32x4 acc[2][2][4][2];
#pragma unroll
    for (int a = 0; a < 2; ++a)
#pragma unroll
        for (int b = 0; b < 2; ++b)
#pragma unroll
            for (int m = 0; m < 4; ++m)
#pragma unroll
                for (int n = 0; n < 2; ++n) acc[a][b][m][n] = (f32x4){0.f, 0.f, 0.f, 0.f};
    bf16x8 At[4][2], B0[2][2], B1[2][2];
    const char* cA = (const char*)g.A + (size_t)cur.pm * tstep; const char* cB = (const char*)g.Bt + (size_t)cur.pn * tstep;
    S.a_ready(cur);
    if constexpr (SP2) {
        PG8_STAGE(PG8_SB(0, 0), cB, voffB); PG8_STAGE(PG8_SB(0, 1), cB + hstep, voffB); PG8_STAGE(PG8_SA(0, 0), cA, voffA); PG8_STAGE(PG8_SA(0, 1), cA + hstep, voffA);
        if (wr == 1) PG8_BAR;
        PG8_WAIT_V(2); PG8_BAR;
        PG8_STAGE(PG8_SB(1, 0), cB + kstep, voffB); PG8_STAGE(PG8_SA(1, 0), cA + kstep, voffA); PG8_STAGE(PG8_SB(1, 1), cB + hstep + kstep, voffB);
        PG8_WAIT_V(6); PG8_BAR;
    } else {
        PG8_STAGE(PG8_SB(0, 0), cB, voffB); PG8_STAGE(PG8_SA(0, 0), cA, voffA); PG8_STAGE(PG8_SB(0, 1), cB + hstep, voffB); PG8_STAGE(PG8_SA(0, 1), cA + hstep, voffA);
        if (wr == 1) PG8_BAR;
        PG8_WAIT_V(4); PG8_BAR;
        PG8_STAGE(PG8_SB(1, 0), cB + kstep, voffB); PG8_STAGE(PG8_SA(1, 0), cA + kstep, voffA); PG8_STAGE(PG8_SB(1, 1), cB + hstep + kstep, voffB);
        PG8_WAIT_V(6); PG8_BAR;
    }
    for (;;) {
        const bool has_next = S.next(ui + 1, nxt);
        const char* nA = has_next ? (const char*)g.A + (size_t)nxt.pm * tstep : cA; const char* nB = has_next ? (const char*)g.Bt + (size_t)nxt.pn * tstep : cB;
        for (int t = 0; t < nt; t += 2) {
            const bool last = (t == nt - 2);
            const char* a1 = cA + (size_t)(t + 1) * kstep;
            const char* a2 = last ? nA : cA + (size_t)(t + 2) * kstep; const char* b2 = last ? nB : cB + (size_t)(t + 2) * kstep;
            const char* a3 = a2 + kstep; const char* b3 = b2 + kstep;
            if (last && has_next) S.a_ready(nxt);
            if constexpr (SP2) {
            PG8_LDB(B0, 0, 0); PG8_LDB(B1, 0, 1); PG8_SCHED; PG8_LDA(At, 0, 0); PG8_STAGE(PG8_SA(1, 1), a1 + hstep, voffA);
            PG8_WAIT_V(8); PG8_WAIT_L(0); PG8_BAR; PG8_MMA(0, 0, At, B0); PG8_MMA(0, 1, At, B1); PG8_BAR; PG8_SCHED;
            PG8_LDA(At, 0, 1); PG8_STAGE(PG8_SB(0, 0), b2, voffB); PG8_STAGE(PG8_SB(0, 1), b2 + hstep, voffB); PG8_STAGE(PG8_SA(0, 0), a2, voffA);
            PG8_WAIT_V(8); PG8_WAIT_L(0); PG8_BAR; PG8_MMA(1, 0, At, B0); PG8_MMA(1, 1, At, B1); PG8_BAR; PG8_SCHED;
            PG8_LDB(B0, 1, 0); PG8_LDB(B1, 1, 1); PG8_SCHED; PG8_LDA(At, 1, 0); PG8_STAGE(PG8_SA(0, 1), a2 + hstep, voffA);
            PG8_WAIT_V(8); PG8_WAIT_L(0); PG8_BAR; PG8_MMA(0, 0, At, B0); PG8_MMA(0, 1, At, B1); PG8_BAR; PG8_SCHED;
            PG8_LDA(At, 1, 1); PG8_STAGE(PG8_SB(1, 0), b3, voffB); PG8_STAGE(PG8_SB(1, 1), b3 + hstep, voffB); PG8_STAGE(PG8_SA(1, 0), a3, voffA);
            PG8_WAIT_V(8); PG8_WAIT_L(0); PG8_BAR; PG8_MMA(1, 0, At, B0); PG8_MMA(1, 1, At, B1); PG8_BAR; PG8_SCHED;
            } else {
            PG8_LDB(B0, 0, 0); PG8_SCHED; PG8_LDA(At, 0, 0); PG8_STAGE(PG8_SA(1, 1), a1 + hstep, voffA);
            PG8_WAIT_L(8); PG8_BAR; PG8_WAIT_L(0); PG8_MMA(0, 0, At, B0); PG8_BAR; PG8_SCHED;
            PG8_LDB(B1, 0, 1); PG8_STAGE(PG8_SB(0, 0), b2, voffB);
            PG8_BAR; PG8_WAIT_L(0); PG8_MMA(0, 1, At, B1); PG8_BAR;
            PG8_LDA(At, 0, 1); PG8_STAGE(PG8_SA(0, 0), a2, voffA);
            PG8_BAR; PG8_WAIT_L(0); PG8_MMA(1, 0, At, B0); PG8_BAR; PG8_SCHED;
            PG8_STAGE(PG8_SB(0, 1), b2 + hstep, voffB);
            PG8_WAIT_V(6); PG8_BAR; PG8_MMA(1, 1, At, B1); PG8_BAR;
            PG8_LDB(B0, 1, 0); PG8_SCHED; PG8_LDA(At, 1, 0); PG8_STAGE(PG8_SA(0, 1), a2 + hstep, voffA);
            PG8_WAIT_L(8); PG8_BAR; PG8_WAIT_L(0); PG8_MMA(0, 0, At, B0); PG8_BAR; PG8_SCHED;
            PG8_LDB(B1, 1, 1); PG8_STAGE(PG8_SB(1, 0), b3, voffB);
            PG8_BAR; PG8_WAIT_L(0); PG8_MMA(0, 1, At, B1); PG8_BAR;
            PG8_LDA(At, 1, 1); PG8_STAGE(PG8_SA(1, 0), a3, voffA);
            PG8_BAR; PG8_WAIT_L(0); PG8_MMA(1, 0, At, B0); PG8_BAR; PG8_SCHED;
            PG8_STAGE(PG8_SB(1, 1), b3 + hstep, voffB);
            PG8_WAIT_V(6); PG8_BAR; PG8_MMA(1, 1, At, B1); PG8_BAR;
            }
        }
        if constexpr (ALIGN_EPI) { if (wr == 0) PG8_BAR; }
        if constexpr (!Epi::AFTER_DRAIN) { E(acc, cur, wr, wc, fr, fq); S.done(cur); }
        if (!has_next) break;
#pragma unroll
        for (int a = 0; a < 2; ++a)
#pragma unroll
            for (int b = 0; b < 2; ++b)
#pragma unroll
                for (int m = 0; m < 4; ++m)
#pragma unroll
                    for (int n = 0; n < 2; ++n) acc[a][b][m][n] = (f32x4){0.f, 0.f, 0.f, 0.f};
        cur = nxt; cA = nA; cB = nB; ++ui;
        if constexpr (ALIGN_EPI) { if (wr == 1) PG8_BAR; }
    }
    PG8_WAIT_V(0);
    if constexpr (!ALIGN_EPI) { if (wr == 0) PG8_BAR; }
    PG8_BAR;
    if constexpr (Epi::AFTER_DRAIN) { E.fused(acc, cur, wr, wc, fr, fq, lds, wid, lane); S.done(cur); }
#undef PG8_SA
#undef PG8_SB
#undef PG8_STAGE
#undef PG8_LDA
#undef PG8_LDB
#undef PG8_MMA
#undef PG8_WAIT_V
#undef PG8_WAIT_L
#undef PG8_BAR
#undef PG8_SCHED
}
}

__device__ __forceinline__ int gswz(int row, int chunk) { return row * 128 + ((chunk ^ ((row >> 1) & 7)) << 4); }
__device__ __forceinline__ void gemm_tile(const bf16_t* __restrict__ A, int lda, const bf16_t* __restrict__ Bt, int ldb, int K,
                                          int row0, int col0, unsigned char* lds, f32x16 (&acc)[2][2]) {
  int tid_ = threadIdx.x; asm volatile("" : "+v"(tid_)); const int tid = tid_, lane = tid & 63, wid = tid >> 6, wm = wid >> 1, wn = wid & 1, r32 = lane & 31, hi = lane >> 5;
  unsigned char* As = lds; unsigned char* Bs = lds + 65536;
#pragma unroll
  for (int i = 0; i < 2; ++i)
#pragma unroll
    for (int j = 0; j < 2; ++j) acc[i][j] = f32x16{};
  const int lrow = tid >> 3, lc = tid & 7;
  const bf16_t* Ag = A + (size_t)(row0 + lrow) * lda + lc * 8;
  const bf16_t* Bg = Bt + (size_t)(col0 + lrow) * ldb + lc * 8;
  u32x4 ra[4], rb[2];
#pragma unroll
  for (int i = 0; i < 4; ++i) ra[i] = *(const u32x4*)(Ag + (size_t)(64 * i) * lda);
#pragma unroll
  for (int i = 0; i < 2; ++i) rb[i] = *(const u32x4*)(Bg + (size_t)(64 * i) * ldb);
#pragma unroll
  for (int i = 0; i < 4; ++i) *(u32x4*)(As + gswz(lrow + 64 * i, lc)) = ra[i];
#pragma unroll
  for (int i = 0; i < 2; ++i) *(u32x4*)(Bs + gswz(lrow + 64 * i, lc)) = rb[i];
  __syncthreads();
  const int nk = K / 64;
  for (int kt = 0; kt < nk; ++kt) {
    const int cur = kt & 1;
    if (kt + 1 < nk) {
#pragma unroll
      for (int i = 0; i < 4; ++i) ra[i] = *(const u32x4*)(Ag + (size_t)(64 * i) * lda + (kt + 1) * 64);
#pragma unroll
      for (int i = 0; i < 2; ++i) rb[i] = *(const u32x4*)(Bg + (size_t)(64 * i) * ldb + (kt + 1) * 64);
    }
    const unsigned char* Ac = As + cur * 32768; const unsigned char* Bc = Bs + cur * 16384;
#pragma unroll
    for (int kk = 0; kk < 4; ++kk) {
      bf16x8 af[2], bfr[2];
#pragma unroll
      for (int i = 0; i < 2; ++i) af[i] = *(const bf16x8*)(Ac + gswz(wm * 64 + i * 32 + r32, 2 * kk + hi));
#pragma unroll
      for (int j = 0; j < 2; ++j) bfr[j] = *(const bf16x8*)(Bc + gswz(wn * 64 + j * 32 + r32, 2 * kk + hi));
#pragma unroll
      for (int i = 0; i < 2; ++i)
#pragma unroll
        for (int j = 0; j < 2; ++j) acc[i][j] = __builtin_amdgcn_mfma_f32_32x32x16_bf16(af[i], bfr[j], acc[i][j], 0, 0, 0);
    }
    if (kt + 1 < nk) {
      unsigned char* An = As + (cur ^ 1) * 32768; unsigned char* Bn = Bs + (cur ^ 1) * 16384;
#pragma unroll
      for (int i = 0; i < 4; ++i) *(u32x4*)(An + gswz(lrow + 64 * i, lc)) = ra[i];
#pragma unroll
      for (int i = 0; i < 2; ++i) *(u32x4*)(Bn + gswz(lrow + 64 * i, lc)) = rb[i];
    }
    __syncthreads();
  }
}
__device__ __forceinline__ void pair_xchg(float v0, float v1, int lane, float& lo, float& hi2) {
  const bool odd = lane & 1;
  const float send = odd ? v0 : v1;
  const float recv = __shfl_xor(send, 1);
  lo = odd ? recv : v0; hi2 = odd ? v1 : recv;
}

__device__ __forceinline__ void phase_inproj(const Params& p, int l, unsigned char* lds) {
  int tid_ = threadIdx.x; asm volatile("" : "+v"(tid_)); const int tid = tid_, lane = tid & 63, wid = tid >> 6, wm = wid >> 1, wn = wid & 1, r32 = lane & 31, hi = lane >> 5;
  const bf16_t* H = (const bf16_t*)(p.ws + WS_H);
  const bf16_t* W = (const bf16_t*)(p.ws + WS_WIN) + (size_t)l * PW * DM;
  bf16_t* PROJ = (bf16_t*)(p.ws + WS_PROJ);
  const float* RC = (const float*)(p.ws + WS_ROPE); const float* RS = RC + SEQ * 32;
  constexpr int NM = T / 256, NN = PW / 128, NU = NM * NN;
  for (int u = p.bx; u < NU + NM; u += p.gx) {
    if (u < NU) {
      const int pn = u / NM, pm = u % NM;
      const int row0 = pm * 256, col0 = pn * 128;
      f32x16 acc[2][2];
      gemm_tile(H, DM, W, DM, DM, row0, col0, lds, acc);
      const bool rope = (col0 >= C_DQ && col0 < C_DV);
      const float scl = (col0 >= C_MK && col0 < C_MV) ? 0.125f : ((col0 >= C_DQ && col0 < C_DK) ? QSCALE : 1.f);
#pragma unroll
      for (int i = 0; i < 2; ++i)
#pragma unroll
        for (int j = 0; j < 2; ++j)
#pragma unroll
          for (int q = 0; q < 8; ++q) {
            float lo, hi2; pair_xchg(acc[i][j][2 * q], acc[i][j][2 * q + 1], lane, lo, hi2);
            const int row = row0 + wm * 64 + i * 32 + crow(2 * q, hi) + (lane & 1);
            const int col = col0 + wn * 64 + j * 32 + (r32 & ~1);
            if (rope) {
              const int s = row % SEGL;
              if (s >= CTXL) {
                const int idx = (s - CTXL) * 32 + ((col & 63) >> 1);
                const float c = RC[idx], sn = RS[idx];
                const float t1 = lo, t2 = hi2; lo = t1 * c - t2 * sn; hi2 = t1 * sn + t2 * c;
              }
            }
            *(unsigned*)(PROJ + (size_t)row * PW + col) = cvtpk(lo * scl, hi2 * scl);
          }
    } else {
      const int pm = u - NU, rowb = pm * 256 + wid * 32;
      const bf16_t* WG = (const bf16_t*)(p.ws + WS_WG) + (size_t)l * 16 * DM;
      float* GT = (float*)(p.ws + WS_GATES);
      const int r16 = lane & 15, q4 = lane >> 4;
      f32x4 c0 = {0.f, 0.f, 0.f, 0.f}, c1 = {0.f, 0.f, 0.f, 0.f};
      const bf16_t* a0p = H + (size_t)(rowb + r16) * DM + q4 * 8;
      const bf16_t* a1p = a0p + (size_t)16 * DM;
      const bf16_t* bp = WG + (size_t)r16 * DM + q4 * 8;
#pragma unroll 4
      for (int ks = 0; ks < 32; ++ks) {
        const bf16x8 a0 = *(const bf16x8*)(a0p + ks * 32), a1 = *(const bf16x8*)(a1p + ks * 32), b = *(const bf16x8*)(bp + ks * 32);
        c0 = __builtin_amdgcn_mfma_f32_16x16x32_bf16(a0, b, c0, 0, 0, 0);
        c1 = __builtin_amdgcn_mfma_f32_16x16x32_bf16(a1, b, c1, 0, 0, 0);
      }
      const float gb = p.in[I_GATEB][l * 16 + r16];
#pragma unroll
      for (int j = 0; j < 4; ++j) {
        GT[(size_t)(rowb + q4 * 4 + j) * 16 + r16] = c0[j] + gb;
        GT[(size_t)(rowb + 16 + q4 * 4 + j) * 16 + r16] = c1[j] + gb;
      }
    }
  }
}

__device__ __forceinline__ void phase_outproj(const Params& p, int l, unsigned char* lds) {
  int tid_ = threadIdx.x; asm volatile("" : "+v"(tid_)); const int tid = tid_, lane = tid & 63, wid = tid >> 6, wm = wid >> 1, wn = wid & 1, r32 = lane & 31, hi = lane >> 5;
  const bf16_t* MIX = (const bf16_t*)(p.ws + WS_MIX);
  const bf16_t* W = (const bf16_t*)(p.ws + WS_WOUT) + (size_t)l * DM * DM;
  float* XC = (float*)(p.ws + WS_XCUR);
  const float* MOD = (const float*)(p.ws + WS_MOD);
  constexpr int NM = T / 256, NN = DM / 128, NU = NM * NN;
  for (int u = p.bx; u < NU; u += p.gx) {
    const int pm = u / NN, pn = u % NN;
    if (l == DEPTH - 1 && (pm % 33) == 0) continue;
    const int row0 = pm * 256, col0 = pn * 128;
    for (int rep = 0; rep < REP_OUTP; ++rep) {
    f32x16 acc[2][2];
    gemm_tile(MIX, DM, W, DM, DM, row0, col0, lds, acc);
    const int mr = (pm % 33) == 0 ? 4 : pm / 33;
    const float* g1 = MOD + ((size_t)l * 5 + mr) * 6144 + 2048;
#pragma unroll
    for (int i = 0; i < 2; ++i)
#pragma unroll
      for (int j = 0; j < 2; ++j) {
        const int col = col0 + wn * 64 + j * 32 + r32;
        const float gg = (rep == REP_OUTP - 1) ? g1[col] : 0.f;
#pragma unroll
        for (int r = 0; r < 16; ++r) {
          const int row = row0 + wm * 64 + i * 32 + crow(r, hi);
          const float xo = (l == 0) ? in_row(p.in[I_X], p.in[I_CTX], row)[col] : XC[(size_t)row * DM + col];
          XC[(size_t)row * DM + col] = xo + gg * acc[i][j][r];
        }
      }
    }
  }
}
__device__ __forceinline__ void phase_peerq(const Params& p, int l, unsigned char* lds) {
  int tid_ = threadIdx.x; asm volatile("" : "+v"(tid_)); const int tid = tid_, lane = tid & 63, wid = tid >> 6, wm = wid >> 1, wn = wid & 1, r32 = lane & 31, hi = lane >> 5;
  const bf16_t* H = (const bf16_t*)(p.ws + WS_H);
  const bf16_t* W = (const bf16_t*)(p.ws + WS_WQ) + (size_t)l * DM * DM;
  bf16_t* QP = (bf16_t*)(p.ws + WS_PROJ);
  constexpr int NM = T / 256, NN = DM / 128, NU = NM * NN;
  for (int u = p.bx; u < NU; u += p.gx) {
    const int pm = u / NN, pn = u % NN;
    if (l == DEPTH - 1 && (pm % 33) == 0) continue;
    const int row0 = pm * 256, col0 = pn * 128;
    f32x16 acc[2][2];
    gemm_tile(H, DM, W, DM, DM, row0, col0, lds, acc);
#pragma unroll
    for (int i = 0; i < 2; ++i)
#pragma unroll
      for (int j = 0; j < 2; ++j)
#pragma unroll
        for (int q = 0; q < 8; ++q) {
          float lo, hi2; pair_xchg(acc[i][j][2 * q], acc[i][j][2 * q + 1], lane, lo, hi2);
          const int row = row0 + wm * 64 + i * 32 + crow(2 * q, hi) + (lane & 1);
          const int col = col0 + wn * 64 + j * 32 + (r32 & ~1);
          *(unsigned*)(QP + (size_t)row * DM + col) = cvtpk(lo, hi2);
        }
  }
}


struct EpiInproj {
  static constexpr bool PERM = true, AFTER_DRAIN = false;
  bf16_t* PROJ; const float* RC; const float* RS; unsigned char* V8T;
  __device__ __forceinline__ void operator()(const pg8::f32x4 (&acc)[2][2][4][2], const pg8::Unit& u, int wr, int wc, int fr, int fq) const {
#pragma unroll
    for (int bj = 0; bj < 2; ++bj) {
      const int colt = u.pn * 256 + bj * 128;
      const bool rope = (colt >= C_DQ && colt < C_DV);
      const float scl = (colt >= C_MK && colt < C_MV) ? 0.125f : ((colt >= C_DQ && colt < C_DK) ? QSCALE : 1.f);
      const int col8 = colt + wc * 32 + 8 * fq;
      if (colt >= C_DV) {
        const int hh = (col8 - C_DV) >> 7, e0 = (col8 - C_DV) & 127;
#pragma unroll
        for (int ai = 0; ai < 2; ++ai)
#pragma unroll
          for (int m = 0; m < 4; ++m) {
            const int row = u.pm * 256 + ai * 128 + wr * 64 + m * 16 + fr;
            const int b = row / SEGL, s = row - b * SEGL, t = s >> 6, kk = s & 63;
            const int slot = ((kk >> 2) & 1) * 32 + (kk & 3) + 4 * ((kk >> 3) & 3) + 16 * (kk >> 5);
            unsigned char* vp = V8T + ((size_t)((b * 4 + hh) * NCH + t) * 128 + e0) * 80 + slot;
            const f32x4 v0 = acc[ai][bj][m][0], v1 = acc[ai][bj][m][1];
            int w0 = 0, w1 = 0;
            w0 = __builtin_amdgcn_cvt_pk_fp8_f32(v0[0], v0[1], w0, false); w0 = __builtin_amdgcn_cvt_pk_fp8_f32(v0[2], v0[3], w0, true);
            w1 = __builtin_amdgcn_cvt_pk_fp8_f32(v1[0], v1[1], w1, false); w1 = __builtin_amdgcn_cvt_pk_fp8_f32(v1[2], v1[3], w1, true);
            vp[0] = (unsigned char)(w0 & 0xFF); vp[80] = (unsigned char)((w0 >> 8) & 0xFF); vp[160] = (unsigned char)((w0 >> 16) & 0xFF); vp[240] = (unsigned char)((w0 >> 24) & 0xFF);
            vp[320] = (unsigned char)(w1 & 0xFF); vp[400] = (unsigned char)((w1 >> 8) & 0xFF); vp[480] = (unsigned char)((w1 >> 16) & 0xFF); vp[560] = (unsigned char)((w1 >> 24) & 0xFF);
          }
        continue;
      }
#pragma unroll
      for (int ai = 0; ai < 2; ++ai)
#pragma unroll
        for (int m = 0; m < 4; ++m) {
          const int row = u.pm * 256 + ai * 128 + wr * 64 + m * 16 + fr;
          f32x4 v0 = acc[ai][bj][m][0], v1 = acc[ai][bj][m][1];
          if (rope) {
            const int s = row % SEGL;
            if (s >= CTXL) {
              const int idx = (s - CTXL) * 32 + ((col8 & 63) >> 1);
              const f32x4 c = *(const f32x4*)(RC + idx), sn = *(const f32x4*)(RS + idx);
              f32x4 a, b;
              a[0] = v0[0] * c[0] - v0[1] * sn[0]; a[1] = v0[0] * sn[0] + v0[1] * c[0]; a[2] = v0[2] * c[1] - v0[3] * sn[1]; a[3] = v0[2] * sn[1] + v0[3] * c[1];
              b[0] = v1[0] * c[2] - v1[1] * sn[2]; b[1] = v1[0] * sn[2] + v1[1] * c[2]; b[2] = v1[2] * c[3] - v1[3] * sn[3]; b[3] = v1[2] * sn[3] + v1[3] * c[3];
              v0 = a; v1 = b;
            }
          }
          u32x4 w; w.x = cvtpk(v0[0] * scl, v0[1] * scl); w.y = cvtpk(v0[2] * scl, v0[3] * scl); w.z = cvtpk(v1[0] * scl, v1[1] * scl); w.w = cvtpk(v1[2] * scl, v1[3] * scl);
          *(u32x4*)(PROJ + (size_t)row * PW + col8) = w;
        }
    }
  }
};
struct EpiOutproj {
  static constexpr bool PERM = true, AFTER_DRAIN = false;
  float* XC; const float* MODL; const float* xin; const float* ctxin; int first; float gsc;
  __device__ __forceinline__ void operator()(const pg8::f32x4 (&acc)[2][2][4][2], const pg8::Unit& u, int wr, int wc, int fr, int fq) const {
    const int mr = (u.pm % 33) == 0 ? 4 : u.pm / 33;
    const float* g1 = MODL + (size_t)mr * 6144 + 2048;
#pragma unroll
    for (int bj = 0; bj < 2; ++bj) {
      const int col8 = u.pn * 256 + bj * 128 + wc * 32 + 8 * fq;
      const f32x4 ga = *(const f32x4*)(g1 + col8) * gsc, gb = *(const f32x4*)(g1 + col8 + 4) * gsc;
#pragma unroll
      for (int ai = 0; ai < 2; ++ai)
#pragma unroll
        for (int m = 0; m < 4; ++m) {
          const int row = u.pm * 256 + ai * 128 + wr * 64 + m * 16 + fr;
          const float* xo = first ? in_row(xin, ctxin, row) + col8 : XC + (size_t)row * DM + col8;
          const f32x4 xa = *(const f32x4*)xo, xb = *(const f32x4*)(xo + 4);
          *(f32x4*)(XC + (size_t)row * DM + col8) = xa + ga * acc[ai][bj][m][0];
          *(f32x4*)(XC + (size_t)row * DM + col8 + 4) = xb + gb * acc[ai][bj][m][1];
        }
    }
  }
};
struct EpiPeerq {
  static constexpr bool PERM = true, AFTER_DRAIN = false;
  bf16_t* QP;
  __device__ __forceinline__ void operator()(const pg8::f32x4 (&acc)[2][2][4][2], const pg8::Unit& u, int wr, int wc, int fr, int fq) const {
#pragma unroll
    for (int bj = 0; bj < 2; ++bj) {
      const int col8 = u.pn * 256 + bj * 128 + wc * 32 + 8 * fq;
#pragma unroll
      for (int ai = 0; ai < 2; ++ai)
#pragma unroll
        for (int m = 0; m < 4; ++m) {
          const int row = u.pm * 256 + ai * 128 + wr * 64 + m * 16 + fr;
          const f32x4 v0 = acc[ai][bj][m][0], v1 = acc[ai][bj][m][1];
          u32x4 w; w.x = cvtpk(v0[0], v0[1]); w.y = cvtpk(v0[2], v0[3]); w.z = cvtpk(v1[0], v1[1]); w.w = cvtpk(v1[2], v1[3]);
          *(u32x4*)(QP + (size_t)row * DM + col8) = w;
        }
    }
  }
};
__device__ __forceinline__ void phase_inproj2(const Params& p, int l, unsigned char* lds) {
  {
    pg8::Gemm g{(const bf16_t*)(p.ws + WS_H), (const bf16_t*)(p.ws + WS_WIN) + (size_t)l * PW * DM, T, PW, DM};
    pg8::StaticOrder S; S.init(T, PW, p.gx, p.bx);
    EpiInproj E{(bf16_t*)(p.ws + WS_PROJ), (const float*)(p.ws + WS_ROPE), (const float*)(p.ws + WS_ROPE) + SEQ * 32, p.ws + WS_V8T};
    pg8::gemm_phase<EpiInproj, pg8::StaticOrder, true, true>((PG8_LAS unsigned char*)lds, g, S, E);
  }
  int tid_ = threadIdx.x; asm volatile("" : "+v"(tid_)); const int tid = tid_, lane = tid & 63, wid = tid >> 6;
  const bf16_t* H = (const bf16_t*)(p.ws + WS_H);
  for (int pm = p.bx; pm < T / 256; pm += p.gx) {
    const int rowb = pm * 256 + wid * 32;
    const bf16_t* WG = (const bf16_t*)(p.ws + WS_WG) + (size_t)l * 16 * DM;
    float* GT = (float*)(p.ws + WS_GATES);
    const int r16 = lane & 15, q4 = lane >> 4;
    f32x4 c0 = {0.f, 0.f, 0.f, 0.f}, c1 = {0.f, 0.f, 0.f, 0.f};
    const bf16_t* a0p = H + (size_t)(rowb + r16) * DM + q4 * 8;
    const bf16_t* a1p = a0p + (size_t)16 * DM;
    const bf16_t* bp = WG + (size_t)r16 * DM + q4 * 8;
#pragma unroll 4
    for (int ks = 0; ks < 32; ++ks) {
      const bf16x8 a0 = *(const bf16x8*)(a0p + ks * 32), a1 = *(const bf16x8*)(a1p + ks * 32), b = *(const bf16x8*)(bp + ks * 32);
      c0 = __builtin_amdgcn_mfma_f32_16x16x32_bf16(a0, b, c0, 0, 0, 0);
      c1 = __builtin_amdgcn_mfma_f32_16x16x32_bf16(a1, b, c1, 0, 0, 0);
    }
    const float gb = p.in[I_GATEB][l * 16 + r16];
#pragma unroll
    for (int j = 0; j < 4; ++j) {
      GT[(size_t)(rowb + q4 * 4 + j) * 16 + r16] = c0[j] + gb;
      GT[(size_t)(rowb + 16 + q4 * 4 + j) * 16 + r16] = c1[j] + gb;
    }
  }
}
__device__ __forceinline__ void phase_outproj2(const Params& p, int l, unsigned char* lds) {
  pg8::Gemm g{(const bf16_t*)(p.ws + WS_MIX), (const bf16_t*)(p.ws + WS_WOUT) + (size_t)l * DM * DM, T, DM, DM};
  pg8::StaticOrder S; S.init(T, DM, p.gx, p.bx);
  for (int rep = 0; rep < REP_OUTP; ++rep) {
  EpiOutproj E{(float*)(p.ws + WS_XCUR), (const float*)(p.ws + WS_MOD) + (size_t)l * 5 * 6144, p.in[I_X], p.in[I_CTX], l == 0, (rep == REP_OUTP - 1) ? 1.f : 0.f};
  pg8::gemm_phase<EpiOutproj, pg8::StaticOrder, true, true>((PG8_LAS unsigned char*)lds, g, S, E);
  }
  if (l < DEPTH - 1) tail_filler_tables(p, l, (T / 256) * (DM / 256));
}
__device__ __forceinline__ void phase_peerq2(const Params& p, int l, unsigned char* lds) {
  pg8::Gemm g{(const bf16_t*)(p.ws + WS_H), (const bf16_t*)(p.ws + WS_WQ) + (size_t)l * DM * DM, T, DM, DM};
  pg8::StaticOrder S; S.init(T, DM, p.gx, p.bx);
  EpiPeerq E{(bf16_t*)(p.ws + WS_PROJ)};
  pg8::gemm_phase<EpiPeerq, pg8::StaticOrder, true, true>((PG8_LAS unsigned char*)lds, g, S, E);
  if (l == DEPTH - 2) tail_filler_tables(p, DEPTH - 1, (T / 256) * (DM / 256));
}

__device__ __forceinline__ void conv_unit(const Params& p, int l, int unit, unsigned char* lds) {
  int tid_ = threadIdx.x; asm volatile("" : "+v"(tid_)); const int tid = tid_, lane = tid & 63, wid = tid >> 6;
  float* U = (float*)lds;
  const bf16_t* PROJ = (const bf16_t*)(p.ws + WS_PROJ);
  bf16_t* MIX = (bf16_t*)(p.ws + WS_MIX);
  const int row0 = unit * 32, b = row0 / SEGL, s0 = row0 - b * SEGL;
  const int seglo = s0 < CTXL ? 0 : CTXL, seghi = s0 < CTXL ? CTXL : SEGL;
  for (int rr = tid >> 5; rr < 62; rr += 16) {
    const int s = s0 - 15 + rr, c8 = (tid & 31) * 8;
    f32x4 u0 = {0.f, 0.f, 0.f, 0.f}, u1 = {0.f, 0.f, 0.f, 0.f};
    if (s >= seglo && s < seghi) {
      const bf16_t* pr = PROJ + (size_t)(b * SEGL + s) * PW + c8;
      const u32x4 a1 = *(const u32x4*)pr, a2 = *(const u32x4*)(pr + 256);
      u0.x = bflo(a1.x) * sigmoidf_(bflo(a2.x)); u0.y = bfhi(a1.x) * sigmoidf_(bfhi(a2.x));
      u0.z = bflo(a1.y) * sigmoidf_(bflo(a2.y)); u0.w = bfhi(a1.y) * sigmoidf_(bfhi(a2.y));
      u1.x = bflo(a1.z) * sigmoidf_(bflo(a2.z)); u1.y = bfhi(a1.z) * sigmoidf_(bfhi(a2.z));
      u1.z = bflo(a1.w) * sigmoidf_(bflo(a2.w)); u1.w = bfhi(a1.w) * sigmoidf_(bfhi(a2.w));
    }
    *(f32x4*)(U + rr * 256 + c8) = u0; *(f32x4*)(U + rr * 256 + c8 + 4) = u1;
  }
  __syncthreads();
  float* Y = U + 62 * 256;
  const float* cw = p.in[I_CONVW] + (size_t)l * 31 * 256;
#pragma unroll 1
  for (int q = 0; q < 4; ++q) {
    const int c = lane + 64 * q;
    float w[31];
#pragma unroll
    for (int j = 0; j < 31; ++j) w[j] = cw[j * 256 + c];
    const float bias = p.in[I_CONVB][l * 256 + c];
#pragma unroll
    for (int tt = 0; tt < 4; ++tt) {
      const int t = wid * 4 + tt;
      float a = bias;
#pragma unroll
      for (int j = 0; j < 31; ++j) a += U[(t + j) * 256 + c] * w[j];
      Y[t * 256 + c] = a;
    }
  }
  asm volatile("s_waitcnt lgkmcnt(0)" ::: "memory");
  float y[4][4];
#pragma unroll
  for (int tt = 0; tt < 4; ++tt)
#pragma unroll
    for (int q = 0; q < 4; ++q) y[tt][q] = Y[(wid * 4 + tt) * 256 + lane + 64 * q];
#pragma unroll
  for (int tt = 0; tt < 4; ++tt) {
    const int t = wid * 4 + tt;
    const float mean = wave_sum((y[tt][0] + y[tt][1]) + (y[tt][2] + y[tt][3])) * (1.f / 256.f);
    float v = 0.f;
#pragma unroll
    for (int q = 0; q < 4; ++q) { const float d = y[tt][q] - mean; v += d * d; }
    const float rs = rsqrtf(wave_sum(v) * (1.f / 256.f) + EPS);
#pragma unroll
    for (int q = 0; q < 4; ++q) {
      const int c = lane + 64 * q;
      const float z = (y[tt][q] - mean) * rs * p.in[I_CLNG][l * 256 + c] + p.in[I_CLNB][l * 256 + c];
      const float o = (ABL & 1) ? 0.f : z * sigmoidf_(z);
      MIX[(size_t)(row0 + t) * DM + c] = (bf16_t)(cvtpk(o, 0.f) & 0xffffu);
    }
  }
  __syncthreads();
}

__device__ __forceinline__ int ml_cidx(int ch, int dir) { return dir == 0 ? ch : (ch < 4 ? 3 - ch : 135 - ch); }
__device__ __forceinline__ void ml_load_tile(const bf16_t* src, float* dst, int tid) {
  const int r = tid >> 3, c8 = (tid & 7) * 8;
  const u32x4 a = *(const u32x4*)(src + (size_t)r * PW + c8);
  float* d = dst + r * 65 + c8;
  d[0] = bflo(a.x); d[1] = bfhi(a.x); d[2] = bflo(a.y); d[3] = bfhi(a.y); d[4] = bflo(a.z); d[5] = bfhi(a.z); d[6] = bflo(a.w); d[7] = bfhi(a.w);
}
__device__ __forceinline__ void ml_local_unit(const Params& p, int l, int unit, unsigned char* lds) {
  int tid_ = threadIdx.x; asm volatile("" : "+v"(tid_)); const int tid = tid_, lane = tid & 63, wid = tid >> 6, r32 = lane & 31, hi = lane >> 5;
  float* Kt = (float*)lds; float* Vt = Kt + 64 * 65; float* WK = Vt + 64 * 65;
  const bf16_t* PROJ = (const bf16_t*)(p.ws + WS_PROJ);
  const float* GT = (const float*)(p.ws + WS_GATES);
  float* UL = (float*)(p.ws + WS_ULOC); float* META = (float*)(p.ws + WS_MLMETA);
  const int b = unit / (4 * NCH), hh = (unit / NCH) & 3, ch = unit % NCH;
  const int row0 = b * SEGL + ch * 64;
  ml_load_tile(PROJ + (size_t)row0 * PW + C_MK + hh * 64, Kt, tid);
  ml_load_tile(PROJ + (size_t)row0 * PW + C_MV + hh * 64, Vt, tid);
  if (wid < 2) {
    const int dir = wid;
    const float ig = GT[(size_t)(row0 + lane) * 16 + (2 * dir) * 4 + hh];
    const float lf = logsigmoidf_(GT[(size_t)(row0 + lane) * 16 + (2 * dir + 1) * 4 + hh]);
    float ps = lf;
#pragma unroll
    for (int o = 1; o < 64; o <<= 1) { const float t = __shfl_up(ps, o); if (lane >= o) ps += t; }
    const float tot = __shfl(ps, 63);
    const float wlog = dir == 0 ? (tot - ps + ig) : (ps - lf + ig);
    const float mloc = wave_max(wlog);
    WK[dir * 64 + lane] = __expf(wlog - mloc);
    if (lane == 0) {
      const int seq = (b * 4 + hh) * 2 + dir, ci = ml_cidx(ch, dir);
      META[((size_t)seq * NCH + ci) * 4 + 0] = tot; META[((size_t)seq * NCH + ci) * 4 + 1] = mloc;
    }
  }
  __syncthreads();
  {
    const int dir = wid >> 2, et = (wid >> 1) & 1, dt = wid & 1;
    const int seq = (b * 4 + hh) * 2 + dir, ci = ml_cidx(ch, dir);
    float* slot = UL + ((size_t)seq * NCH + ci) * USTRIDE;
    f32x16 acc = {};
#pragma unroll 8
    for (int ks = 0; ks < 32; ++ks) {
      const int s = 2 * ks + hi;
      const float a = WK[dir * 64 + s] * Vt[s * 65 + et * 32 + r32];
      const float bb = Kt[s * 65 + dt * 32 + r32];
      acc = __builtin_amdgcn_mfma_f32_32x32x2f32(a, bb, acc, 0, 0, 0);
    }
#pragma unroll
    for (int r = 0; r < 16; ++r) slot[(et * 32 + crow(r, hi)) * 64 + dt * 32 + r32] = acc[r];
    if (et == 0) {
      float n = 0.f;
#pragma unroll 8
      for (int i = 0; i < 32; ++i) { const int s = hi * 32 + i; n += WK[dir * 64 + s] * Kt[s * 65 + dt * 32 + r32]; }
      n += __shfl_xor(n, 32);
      if (hi == 0) slot[4096 + dt * 32 + r32] = n;
    }
  }
  __syncthreads();
}
constexpr int MLP = 144;
constexpr size_t WS_CST = WS_H;
constexpr size_t WS_NST = WS_H + (size_t)32 * NCH * 4096 * 2;
__device__ __forceinline__ void ml_stage_rm(const bf16_t* src, size_t ld, unsigned char* dst, int tid) {
  const int r = tid >> 3, c8 = (tid & 7) * 8;
  *(u32x4*)(dst + r * MLP + c8 * 2) = *(const u32x4*)(src + (size_t)r * ld + c8);
}
__device__ __forceinline__ void ml_stage_tr(const bf16_t* src, size_t ld, unsigned char* dst, int tid) {
  const int r = tid >> 3, c8 = (tid & 7) * 8;
  const u32x4 a = *(const u32x4*)(src + (size_t)r * ld + c8);
  bf16_t* d = (bf16_t*)dst;
  d[(c8 + 0) * 72 + r] = (bf16_t)(a.x & 0xffffu); d[(c8 + 1) * 72 + r] = (bf16_t)(a.x >> 16);
  d[(c8 + 2) * 72 + r] = (bf16_t)(a.y & 0xffffu); d[(c8 + 3) * 72 + r] = (bf16_t)(a.y >> 16);
  d[(c8 + 4) * 72 + r] = (bf16_t)(a.z & 0xffffu); d[(c8 + 5) * 72 + r] = (bf16_t)(a.z >> 16);
  d[(c8 + 6) * 72 + r] = (bf16_t)(a.w & 0xffffu); d[(c8 + 7) * 72 + r] = (bf16_t)(a.w >> 16);
}
__device__ __forceinline__ void ml_local_unit2(const Params& p, int l, int unit, unsigned char* lds) {
  int tid_ = threadIdx.x; asm volatile("" : "+v"(tid_)); const int tid = tid_, lane = tid & 63, wid = tid >> 6, r32 = lane & 31, hi = lane >> 5;
  unsigned char* KT = lds; unsigned char* VT = lds + 64 * MLP; float* WK = (float*)(lds + 2 * 64 * MLP);
  const bf16_t* PROJ = (const bf16_t*)(p.ws + WS_PROJ);
  const float* GT = (const float*)(p.ws + WS_GATES);
  float* UL = (float*)(p.ws + WS_ULOC); float* META = (float*)(p.ws + WS_MLMETA);
  const int b = unit / (4 * NCH), hh = (unit / NCH) & 3, ch = unit % NCH;
  const int row0 = b * SEGL + ch * 64;
  ml_stage_tr(PROJ + (size_t)row0 * PW + C_MK + hh * 64, PW, KT, tid);
  ml_stage_tr(PROJ + (size_t)row0 * PW + C_MV + hh * 64, PW, VT, tid);
  if (wid < 2) {
    const int dir = wid;
    const float ig = GT[(size_t)(row0 + lane) * 16 + (2 * dir) * 4 + hh];
    const float lf = logsigmoidf_(GT[(size_t)(row0 + lane) * 16 + (2 * dir + 1) * 4 + hh]);
    float ps = lf;
#pragma unroll
    for (int o = 1; o < 64; o <<= 1) { const float t = __shfl_up(ps, o); if (lane >= o) ps += t; }
    const float tot = __shfl(ps, 63);
    const float wlog = dir == 0 ? (tot - ps + ig) : (ps - lf + ig);
    const float mloc = wave_max(wlog);
    WK[dir * 64 + lane] = __expf(wlog - mloc);
    if (lane == 0) {
      const int seq = (b * 4 + hh) * 2 + dir, ci = ml_cidx(ch, dir);
      META[((size_t)seq * NCH + ci) * 4 + 0] = tot; META[((size_t)seq * NCH + ci) * 4 + 1] = mloc;
    }
  }
  __syncthreads();
  {
    const int dir = wid >> 2, et = (wid >> 1) & 1, dt = wid & 1;
    const int seq = (b * 4 + hh) * 2 + dir, ci = ml_cidx(ch, dir);
    float* slot = UL + ((size_t)seq * NCH + ci) * USTRIDE;
    f32x16 acc = {};
#pragma unroll
    for (int ks = 0; ks < 4; ++ks) {
      const int s0 = ks * 16 + hi * 8;
      const u32x4 va = *(const u32x4*)(VT + (et * 32 + r32) * MLP + s0 * 2);
      const bf16x8 kb = *(const bf16x8*)(KT + (dt * 32 + r32) * MLP + s0 * 2);
      const f32x4 w0 = *(const f32x4*)(WK + dir * 64 + s0), w1 = *(const f32x4*)(WK + dir * 64 + s0 + 4);
      u32x4 sa; sa.x = cvtpk(bflo(va.x) * w0.x, bfhi(va.x) * w0.y); sa.y = cvtpk(bflo(va.y) * w0.z, bfhi(va.y) * w0.w);
      sa.z = cvtpk(bflo(va.z) * w1.x, bfhi(va.z) * w1.y); sa.w = cvtpk(bflo(va.w) * w1.z, bfhi(va.w) * w1.w);
      acc = __builtin_amdgcn_mfma_f32_32x32x16_bf16(*(const bf16x8*)&sa, kb, acc, 0, 0, 0);
    }
#pragma unroll
    for (int r = 0; r < 16; ++r) slot[(et * 32 + crow(r, hi)) * 64 + dt * 32 + r32] = acc[r];
    if (et == 0) {
      float n = 0.f;
#pragma unroll
      for (int i = 0; i < 4; ++i) {
        const int s0 = hi * 32 + i * 8;
        const u32x4 ka = *(const u32x4*)(KT + (dt * 32 + r32) * MLP + s0 * 2);
        const f32x4 w0 = *(const f32x4*)(WK + dir * 64 + s0), w1 = *(const f32x4*)(WK + dir * 64 + s0 + 4);
        n += bflo(ka.x) * w0.x + bfhi(ka.x) * w0.y + bflo(ka.y) * w0.z + bfhi(ka.y) * w0.w + bflo(ka.z) * w1.x + bfhi(ka.z) * w1.y + bflo(ka.w) * w1.z + bfhi(ka.w) * w1.w;
      }
      n += __shfl_xor(n, 32);
      if (hi == 0) slot[4096 + dt * 32 + r32] = n;
    }
  }
  __syncthreads();
}
__device__ __forceinline__ void ml_scan(const Params& p, unsigned char* lds) {
  float* UL = (float*)(p.ws + WS_ULOC); float* META = (float*)(p.ws + WS_MLMETA);
  int tid_ = threadIdx.x; asm volatile("" : "+v"(tid_));
  const int tid = tid_, lane = tid & 63, wid = tid >> 6;
  float* DEC = (float*)lds;
  float* SCL = DEC + 2 * NCH;
  float* TMP = SCL + 2 * NCH;
  for (int base0 = p.bx * 512; base0 < 32 * USTRIDE; base0 += p.gx * 512) {
    const int seq0 = base0 / USTRIDE;
    if (wid < 2) {
      const int seq = seq0 + wid;
      if (seq < 32) {
        float* mt = META + (size_t)seq * NCH * 4;
        for (int c = lane; c < NCH; c += 64) { TMP[(wid * 2 + 0) * NCH + c] = mt[c * 4 + 0]; TMP[(wid * 2 + 1) * NCH + c] = mt[c * 4 + 1]; }
        asm volatile("s_waitcnt lgkmcnt(0)" ::: "memory");
        if (lane == 0) {
          float m = 0.f;
          for (int c = 0; c < NCH; ++c) {
            const float bl = TMP[(wid * 2 + 0) * NCH + c], mloc = TMP[(wid * 2 + 1) * NCH + c];
            const float mn = fmaxf(bl + m, mloc);
            DEC[wid * NCH + c] = __expf(bl + m - mn); SCL[wid * NCH + c] = __expf(mloc - mn);
            mt[c * 4 + 2] = m;
            m = mn;
          }
        }
      }
    }
    __syncthreads();
    const int idx = base0 + tid;
    if (idx < 32 * USTRIDE) {
      const int seq = idx / USTRIDE, e = idx - seq * USTRIDE, sl = seq - seq0;
      float* bp = UL + (size_t)seq * NCH * USTRIDE + e;
      bf16_t* CSTp = (bf16_t*)(p.ws + WS_CST) + (size_t)seq * NCH * 4096 + (e < 4096 ? e : 0);
      float* NSTp = (float*)(p.ws + WS_NST) + (size_t)seq * NCH * 64 + (e < 4096 ? 0 : e - 4096);
      const float* dec = DEC + sl * NCH; const float* scl = SCL + sl * NCH;
      float C = 0.f;
#pragma unroll 1
      for (int c0 = 0; c0 < NCH; c0 += 12) {
        float u[12];
#pragma unroll
        for (int j = 0; j < 12; ++j) u[j] = bp[(size_t)(c0 + j) * USTRIDE];
#pragma unroll
        for (int j = 0; j < 12; ++j) {
          if (e < 4096) CSTp[(size_t)(c0 + j) * 4096] = (bf16_t)(cvtpk(C, 0.f) & 0xffffu); else NSTp[(size_t)(c0 + j) * 64] = C;
          C = dec[c0 + j] * C + scl[c0 + j] * u[j]; }
      }
    }
    __syncthreads();
  }
}
__device__ __forceinline__ void ml_out_unit(const Params& p, int l, int unit, unsigned char* lds) {
  int tid_ = threadIdx.x; asm volatile("" : "+v"(tid_)); const int tid = tid_, lane = tid & 63, wid = tid >> 6, r32 = lane & 31, hi = lane >> 5;
  float* Qt = (float*)lds; float* Kt = Qt + 64 * 65; float* Vt = Kt + 64 * 65;
  float* Cs = Vt + 64 * 65;
  float* Ns = Cs + 2 * 64 * 65;
  float* Bq = Ns + 128;
  float* Gs = Bq + 128;
  float* Mi = Gs + 128;
  float* HB = Mi + 64;
  const bf16_t* PROJ = (const bf16_t*)(p.ws + WS_PROJ);
  const float* GT = (const float*)(p.ws + WS_GATES);
  const float* UL = (const float*)(p.ws + WS_ULOC); const float* META = (const float*)(p.ws + WS_MLMETA);
  bf16_t* MIX = (bf16_t*)(p.ws + WS_MIX);
  const int b = unit / (4 * NCH), hh = (unit / NCH) & 3, ch = unit % NCH;
  const int row0 = b * SEGL + ch * 64;
  ml_load_tile(PROJ + (size_t)row0 * PW + C_MQ + hh * 64, Qt, tid);
  ml_load_tile(PROJ + (size_t)row0 * PW + C_MK + hh * 64, Kt, tid);
  ml_load_tile(PROJ + (size_t)row0 * PW + C_MV + hh * 64, Vt, tid);
  for (int i = tid; i < 2 * USTRIDE; i += 512) {
    const int dir = i / USTRIDE, e = i - dir * USTRIDE;
    const int seq = (b * 4 + hh) * 2 + dir, ci = ml_cidx(ch, dir);
    const float v = UL[((size_t)seq * NCH + ci) * USTRIDE + e];
    if (e < 4096) Cs[dir * 64 * 65 + (e >> 6) * 65 + (e & 63)] = v; else Ns[dir * 64 + (e - 4096)] = v;
  }
  if (wid < 2) {
    const int dir = wid;
    const float ig = GT[(size_t)(row0 + lane) * 16 + (2 * dir) * 4 + hh];
    const float lf = logsigmoidf_(GT[(size_t)(row0 + lane) * 16 + (2 * dir + 1) * 4 + hh]);
    float ps = lf;
#pragma unroll
    for (int o = 1; o < 64; o <<= 1) { const float t = __shfl_up(ps, o); if (lane >= o) ps += t; }
    const float tot = __shfl(ps, 63);
    const float bc = dir == 0 ? ps : (tot - ps + lf);
    Bq[dir * 64 + lane] = bc; Gs[dir * 64 + lane] = ig - bc;
    if (lane == 0) { const int seq = (b * 4 + hh) * 2 + dir, ci = ml_cidx(ch, dir); Mi[dir] = META[((size_t)seq * NCH + ci) * 4 + 2]; }
  }
  __syncthreads();
  {
    const int dir = wid >> 2, tt = (wid >> 1) & 1, et = wid & 1;
    const int t = tt * 32 + r32;
    f32x16 sa[2] = {};
#pragma unroll 4
    for (int ks = 0; ks < 32; ++ks) {
      const float bq = Qt[t * 65 + 2 * ks + hi];
      const float a0 = Kt[(r32) * 65 + 2 * ks + hi], a1 = Kt[(32 + r32) * 65 + 2 * ks + hi];
      sa[0] = __builtin_amdgcn_mfma_f32_32x32x2f32(a0, bq, sa[0], 0, 0, 0);
      sa[1] = __builtin_amdgcn_mfma_f32_32x32x2f32(a1, bq, sa[1], 0, 0, 0);
    }
    const float bt = Bq[dir * 64 + t];
    const float inter = bt + Mi[dir];
    float mx = -INFINITY;
    f32x16 dl[2];
#pragma unroll
    for (int st = 0; st < 2; ++st)
#pragma unroll
      for (int r = 0; r < 16; ++r) {
        const int s = st * 32 + crow(r, hi);
        const bool ok = dir == 0 ? (s <= t) : (s >= t);
        const float d = ok ? bt + Gs[dir * 64 + s] : -INFINITY;
        dl[st][r] = d; mx = fmaxf(mx, d);
      }
    mx = fmaxf(mx, __shfl_xor(mx, 32));
    const float mt = fmaxf(inter, mx);
    const float iw = __expf(inter - mt);
    float rsum = 0.f;
#pragma unroll
    for (int st = 0; st < 2; ++st)
#pragma unroll
      for (int r = 0; r < 16; ++r) { const float w = __expf(dl[st][r] - mt); sa[st][r] *= w; rsum += sa[st][r]; }
    rsum += __shfl_xor(rsum, 32);
    float qn = 0.f;
#pragma unroll 8
    for (int i = 0; i < 32; ++i) { const int d = hi * 32 + i; qn += Ns[dir * 64 + d] * Qt[t * 65 + d]; }
    qn += __shfl_xor(qn, 32);
    const float den = rsum + iw * qn;
    const float rden = 1.f / fmaxf(fabsf(den), __expf(-mt));
    f32x16 an = {}, ac = {};
#pragma unroll
    for (int st = 0; st < 2; ++st)
#pragma unroll
      for (int r = 0; r < 16; ++r) {
        const float a = Vt[(st * 32 + crow(r, hi)) * 65 + et * 32 + r32];
        an = __builtin_amdgcn_mfma_f32_32x32x2f32(a, sa[st][r], an, 0, 0, 0);
      }
    const float* Cd = Cs + dir * 64 * 65;
#pragma unroll 4
    for (int ks = 0; ks < 32; ++ks) {
      const float a = Cd[(et * 32 + r32) * 65 + 2 * ks + hi];
      const float bq = Qt[t * 65 + 2 * ks + hi];
      ac = __builtin_amdgcn_mfma_f32_32x32x2f32(a, bq, ac, 0, 0, 0);
    }
#pragma unroll
    for (int r = 0; r < 16; ++r) HB[dir * 64 * 65 + t * 65 + et * 32 + crow(r, hi)] = (an[r] + iw * ac[r]) * rden;
  }
  __syncthreads();
  {
    const int t = tid >> 3, e8 = (tid & 7) * 8;
    float v[8]; float ss = 0.f;
#pragma unroll
    for (int i = 0; i < 8; ++i) { v[i] = HB[t * 65 + e8 + i] + HB[64 * 65 + t * 65 + e8 + i]; ss += v[i] * v[i]; }
    ss += __shfl_xor(ss, 1); ss += __shfl_xor(ss, 2); ss += __shfl_xor(ss, 4);
    const float rs = rsqrtf(ss * (1.f / 64.f) + EPS);
    const u32x4 ov = *(const u32x4*)(PROJ + (size_t)(row0 + t) * PW + C_MO + hh * 64 + e8);
    const float og[8] = {bflo(ov.x), bfhi(ov.x), bflo(ov.y), bfhi(ov.y), bflo(ov.z), bfhi(ov.z), bflo(ov.w), bfhi(ov.w)};
    const float* g = p.in[I_MNORMG] + l * 64 + e8;
    float o[8];
#pragma unroll
    for (int i = 0; i < 8; ++i) o[i] = (ABL & 2) ? 0.f : v[i] * rs * g[i] * sigmoidf_(og[i]);
    u32x4 w; w.x = cvtpk(o[0], o[1]); w.y = cvtpk(o[2], o[3]); w.z = cvtpk(o[4], o[5]); w.w = cvtpk(o[6], o[7]);
    *(u32x4*)(MIX + (size_t)(row0 + t) * DM + 256 + hh * 64 + e8) = w;
  }
  __syncthreads();
}


__device__ __forceinline__ void ml_out_unit2(const Params& p, int l, int unit, unsigned char* lds) {
  int tid_ = threadIdx.x; asm volatile("" : "+v"(tid_)); const int tid = tid_, lane = tid & 63, wid = tid >> 6, r32 = lane & 31, hi = lane >> 5;
  unsigned char* Qs = lds; unsigned char* Ks = lds + 64 * MLP; unsigned char* VT = lds + 2 * 64 * MLP; unsigned char* Cs = lds + 3 * 64 * MLP;
  float* Ns = (float*)(lds + 5 * 64 * MLP);
  float* Bq = Ns + 128;
  float* Gs = Bq + 128;
  float* Mi = Gs + 128;
  float* HB = Mi + 64;
  const bf16_t* PROJ = (const bf16_t*)(p.ws + WS_PROJ);
  const float* GT = (const float*)(p.ws + WS_GATES);
  const bf16_t* CST = (const bf16_t*)(p.ws + WS_CST); const float* NST = (const float*)(p.ws + WS_NST); const float* META = (const float*)(p.ws + WS_MLMETA);
  bf16_t* MIX = (bf16_t*)(p.ws + WS_MIX);
  const int b = unit / (4 * NCH), hh = (unit / NCH) & 3, ch = unit % NCH;
  const int row0 = b * SEGL + ch * 64;
  ml_stage_rm(PROJ + (size_t)row0 * PW + C_MQ + hh * 64, PW, Qs, tid);
  ml_stage_rm(PROJ + (size_t)row0 * PW + C_MK + hh * 64, PW, Ks, tid);
  ml_stage_tr(PROJ + (size_t)row0 * PW + C_MV + hh * 64, PW, VT, tid);
#pragma unroll
  for (int dir = 0; dir < 2; ++dir) {
    const int seq = (b * 4 + hh) * 2 + dir, ci = ml_cidx(ch, dir);
    ml_stage_rm(CST + ((size_t)seq * NCH + ci) * 4096, 64, Cs + dir * 64 * MLP, tid);
    if (tid < 64) Ns[dir * 64 + tid] = NST[((size_t)seq * NCH + ci) * 64 + tid];
  }
  if (wid < 2) {
    const int dir = wid;
    const float ig = GT[(size_t)(row0 + lane) * 16 + (2 * dir) * 4 + hh];
    const float lf = logsigmoidf_(GT[(size_t)(row0 + lane) * 16 + (2 * dir + 1) * 4 + hh]);
    float ps = lf;
#pragma unroll
    for (int o = 1; o < 64; o <<= 1) { const float t = __shfl_up(ps, o); if (lane >= o) ps += t; }
    const float tot = __shfl(ps, 63);
    const float bc = dir == 0 ? ps : (tot - ps + lf);
    Bq[dir * 64 + lane] = bc; Gs[dir * 64 + lane] = ig - bc;
    if (lane == 0) { const int seq = (b * 4 + hh) * 2 + dir, ci = ml_cidx(ch, dir); Mi[dir] = META[((size_t)seq * NCH + ci) * 4 + 2]; }
  }
  __syncthreads();
  {
    const int dir = wid >> 2, tt = (wid >> 1) & 1, et = wid & 1;
    const int t = tt * 32 + r32;
    f32x16 sa[2] = {};
    bf16x8 bq[4];
#pragma unroll
    for (int ks = 0; ks < 4; ++ks) {
      bq[ks] = *(const bf16x8*)(Qs + t * MLP + (ks * 16 + hi * 8) * 2);
      const bf16x8 a0 = *(const bf16x8*)(Ks + r32 * MLP + (ks * 16 + hi * 8) * 2), a1 = *(const bf16x8*)(Ks + (32 + r32) * MLP + (ks * 16 + hi * 8) * 2);
      sa[0] = __builtin_amdgcn_mfma_f32_32x32x16_bf16(a0, bq[ks], sa[0], 0, 0, 0);
      sa[1] = __builtin_amdgcn_mfma_f32_32x32x16_bf16(a1, bq[ks], sa[1], 0, 0, 0);
    }
    const float bt = Bq[dir * 64 + t];
    const float inter = bt + Mi[dir];
    float mx = -INFINITY;
    f32x16 dl[2];
#pragma unroll
    for (int st = 0; st < 2; ++st)
#pragma unroll
      for (int r = 0; r < 16; ++r) {
        const int s = st * 32 + crow(r, hi);
        const bool ok = dir == 0 ? (s <= t) : (s >= t);
        const float d = ok ? bt + Gs[dir * 64 + s] : -INFINITY;
        dl[st][r] = d; mx = fmaxf(mx, d);
      }
    mx = fmaxf(mx, __shfl_xor(mx, 32));
    const float mt = fmaxf(inter, mx);
    const float iw = __expf(inter - mt);
    float rsum = 0.f;
#pragma unroll
    for (int st = 0; st < 2; ++st)
#pragma unroll
      for (int r = 0; r < 16; ++r) { const float w = __expf(dl[st][r] - mt); sa[st][r] *= w; rsum += sa[st][r]; }
    rsum += __shfl_xor(rsum, 32);
    float qn = 0.f;
#pragma unroll
    for (int i = 0; i < 4; ++i) {
      const int d0 = hi * 32 + i * 8;
      const u32x4 qa = *(const u32x4*)(Qs + t * MLP + d0 * 2);
      const f32x4 n0 = *(const f32x4*)(Ns + dir * 64 + d0), n1 = *(const f32x4*)(Ns + dir * 64 + d0 + 4);
      qn += bflo(qa.x) * n0.x + bfhi(qa.x) * n0.y + bflo(qa.y) * n0.z + bfhi(qa.y) * n0.w + bflo(qa.z) * n1.x + bfhi(qa.z) * n1.y + bflo(qa.w) * n1.z + bfhi(qa.w) * n1.w;
    }
    qn += __shfl_xor(qn, 32);
    const float den = rsum + iw * qn;
    const float rden = 1.f / fmaxf(fabsf(den), __expf(-mt));
    f32x16 an = {}, ac = {};
#pragma unroll
    for (int st = 0; st < 2; ++st)
#pragma unroll
      for (int k2 = 0; k2 < 2; ++k2) {
        u32x4 bx; bx.x = cvtpk(sa[st][8 * k2 + 0], sa[st][8 * k2 + 1]); bx.y = cvtpk(sa[st][8 * k2 + 2], sa[st][8 * k2 + 3]);
        bx.z = cvtpk(sa[st][8 * k2 + 4], sa[st][8 * k2 + 5]); bx.w = cvtpk(sa[st][8 * k2 + 6], sa[st][8 * k2 + 7]);
        const unsigned char* vrow = VT + (et * 32 + r32) * MLP + (st * 32 + 16 * k2 + 4 * hi) * 2;
        const u32x2 v0 = *(const u32x2*)vrow, v1 = *(const u32x2*)(vrow + 16);
        u32x4 ax; ax.x = v0.x; ax.y = v0.y; ax.z = v1.x; ax.w = v1.y;
        an = __builtin_amdgcn_mfma_f32_32x32x16_bf16(*(const bf16x8*)&ax, *(const bf16x8*)&bx, an, 0, 0, 0);
      }
    const unsigned char* Cd = Cs + dir * 64 * MLP;
#pragma unroll
    for (int ks = 0; ks < 4; ++ks) {
      const bf16x8 a = *(const bf16x8*)(Cd + (et * 32 + r32) * MLP + (ks * 16 + hi * 8) * 2);
      ac = __builtin_amdgcn_mfma_f32_32x32x16_bf16(a, bq[ks], ac, 0, 0, 0);
    }
#pragma unroll
    for (int r = 0; r < 16; ++r) HB[dir * 64 * 65 + t * 65 + et * 32 + crow(r, hi)] = (an[r] + iw * ac[r]) * rden;
  }
  __syncthreads();
  {
    const int t = tid >> 3, e8 = (tid & 7) * 8;
    float v[8]; float ss = 0.f;
#pragma unroll
    for (int i = 0; i < 8; ++i) { v[i] = HB[t * 65 + e8 + i] + HB[64 * 65 + t * 65 + e8 + i]; ss += v[i] * v[i]; }
    ss += __shfl_xor(ss, 1); ss += __shfl_xor(ss, 2); ss += __shfl_xor(ss, 4);
    const float rs = rsqrtf(ss * (1.f / 64.f) + EPS);
    const u32x4 ov = *(const u32x4*)(PROJ + (size_t)(row0 + t) * PW + C_MO + hh * 64 + e8);
    const float og[8] = {bflo(ov.x), bfhi(ov.x), bflo(ov.y), bfhi(ov.y), bflo(ov.z), bfhi(ov.z), bflo(ov.w), bfhi(ov.w)};
    const float* g = p.in[I_MNORMG] + l * 64 + e8;
    float o[8];
#pragma unroll
    for (int i = 0; i < 8; ++i) o[i] = (ABL & 2) ? 0.f : v[i] * rs * g[i] * sigmoidf_(og[i]);
    u32x4 w; w.x = cvtpk(o[0], o[1]); w.y = cvtpk(o[2], o[3]); w.z = cvtpk(o[4], o[5]); w.w = cvtpk(o[6], o[7]);
    *(u32x4*)(MIX + (size_t)(row0 + t) * DM + 256 + hh * 64 + e8) = w;
  }
  __syncthreads();
}

#define KSWZ(row, colB) ((row) * 256 + ((colB) ^ (((row) & 15) << 4)))
#define SBAR() __builtin_amdgcn_sched_barrier(0)
constexpr int ATT_SHM_V = 128 * 80, ATT_SHM_K = 64 * 128 * 2;
constexpr float ATT_THR = 8.0f;
__device__ __forceinline__ int v_st(int k, int c) { const int kk = (k & ~0xC) | ((k & 4) << 1) | ((k & 8) >> 1); return ((kk >> 3) * 4 + (c >> 5)) * 512 + ((kk & 7) * 32 + (c & 31)) * 2; }
__device__ __forceinline__ int v_rd_base(int lane) { return ((lane & 3) << 3) | (((lane >> 2) & 3) << 6) | (((lane >> 4) & 1) << 5) | (((lane >> 5) & 1) << 8); }
constexpr int v_rd_off(int d0, int ks, int half) { return d0 * 512 + ks * 4096 + half * 2048; }
template <int OFF> __device__ __forceinline__ s16x4 tr_read(int vb) {
  s16x4 r; asm volatile("ds_read_b64_tr_b16 %0, %1 offset:%2" : "=&v"(r) : "v"(vb), "i"(OFF) : "memory"); return r;
}
template <int D0> __device__ __forceinline__ void pv_one(f32x16& od, int vb, bf16x8 pa0, bf16x8 pa1, bf16x8 pa2, bf16x8 pa3) {
  const s16x4 l0 = tr_read<v_rd_off(D0, 0, 0)>(vb), h0 = tr_read<v_rd_off(D0, 0, 1)>(vb), l1 = tr_read<v_rd_off(D0, 1, 0)>(vb), h1 = tr_read<v_rd_off(D0, 1, 1)>(vb);
  const s16x4 l2 = tr_read<v_rd_off(D0, 2, 0)>(vb), h2 = tr_read<v_rd_off(D0, 2, 1)>(vb), l3 = tr_read<v_rd_off(D0, 3, 0)>(vb), h3 = tr_read<v_rd_off(D0, 3, 1)>(vb);
  asm volatile("s_waitcnt lgkmcnt(0)" ::: "memory"); SBAR();
#define PK(L, H) (bf16x8){L[0], L[1], L[2], L[3], H[0], H[1], H[2], H[3]}
  od = __builtin_amdgcn_mfma_f32_32x32x16_bf16(pa0, PK(l0, h0), od, 0, 0, 0);
  od = __builtin_amdgcn_mfma_f32_32x32x16_bf16(pa1, PK(l1, h1), od, 0, 0, 0);
  od = __builtin_amdgcn_mfma_f32_32x32x16_bf16(pa2, PK(l2, h2), od, 0, 0, 0);
  od = __builtin_amdgcn_mfma_f32_32x32x16_bf16(pa3, PK(l3, h3), od, 0, 0, 0);
#undef PK
}
template <int D0> __device__ __forceinline__ void pv_two(f32x16& oa, f32x16& ob, int vb, bf16x8 a0, bf16x8 a1, bf16x8 a2, bf16x8 a3, bf16x8 b0, bf16x8 b1, bf16x8 b2, bf16x8 b3) {
  const s16x4 l0 = tr_read<v_rd_off(D0, 0, 0)>(vb), h0 = tr_read<v_rd_off(D0, 0, 1)>(vb), l1 = tr_read<v_rd_off(D0, 1, 0)>(vb), h1 = tr_read<v_rd_off(D0, 1, 1)>(vb);
  const s16x4 l2 = tr_read<v_rd_off(D0, 2, 0)>(vb), h2 = tr_read<v_rd_off(D0, 2, 1)>(vb), l3 = tr_read<v_rd_off(D0, 3, 0)>(vb), h3 = tr_read<v_rd_off(D0, 3, 1)>(vb);
  asm volatile("s_waitcnt lgkmcnt(0)" ::: "memory"); SBAR();
#define PK(L, H) (bf16x8){L[0], L[1], L[2], L[3], H[0], H[1], H[2], H[3]}
  const bf16x8 v0 = PK(l0, h0), v1 = PK(l1, h1), v2 = PK(l2, h2), v3 = PK(l3, h3);
  oa = __builtin_amdgcn_mfma_f32_32x32x16_bf16(a0, v0, oa, 0, 0, 0);
  ob = __builtin_amdgcn_mfma_f32_32x32x16_bf16(b0, v0, ob, 0, 0, 0);
  oa = __builtin_amdgcn_mfma_f32_32x32x16_bf16(a1, v1, oa, 0, 0, 0);
  ob = __builtin_amdgcn_mfma_f32_32x32x16_bf16(b1, v1, ob, 0, 0, 0);
  oa = __builtin_amdgcn_mfma_f32_32x32x16_bf16(a2, v2, oa, 0, 0, 0);
  ob = __builtin_amdgcn_mfma_f32_32x32x16_bf16(b2, v2, ob, 0, 0, 0);
  oa = __builtin_amdgcn_mfma_f32_32x32x16_bf16(a3, v3, oa, 0, 0, 0);
  ob = __builtin_amdgcn_mfma_f32_32x32x16_bf16(b3, v3, ob, 0, 0, 0);
#undef PK
}
__device__ __forceinline__ void att_qkt(f32x16& p0, f32x16& p1, const unsigned char* Ks, const unsigned char* Qs, int qrow, int comp, int r32, int hi, float init) {
#pragma unroll
  for (int r = 0; r < 16; ++r) { p0[r] = init; p1[r] = init; }
#pragma unroll
  for (int d0 = 0; d0 < 4; ++d0) {
    const int cb = ((comp * 4 + d0) * 16 + hi * 8) * 2;
    const bf16x8 b0 = *(const bf16x8*)(Ks + KSWZ(r32, cb));
    const bf16x8 b1 = *(const bf16x8*)(Ks + KSWZ(32 + r32, cb));
    const bf16x8 q = *(const bf16x8*)(Qs + KSWZ(qrow, cb));
    p0 = __builtin_amdgcn_mfma_f32_32x32x16_bf16(b0, q, p0, 0, 0, 0);
    p1 = __builtin_amdgcn_mfma_f32_32x32x16_bf16(b1, q, p1, 0, 0, 0);
  }
}
__device__ __forceinline__ void att_softmax(f32x16& p0, f32x16& p1, float& m_reg, float& l_reg, float& alpha, bool first, i32x8& pa) {
  alpha = 1.f;
  if (first) {
    float pmax = p0[0];
#pragma unroll
    for (int r = 1; r < 16; ++r) pmax = fmaxf(pmax, p0[r]);
#pragma unroll
    for (int r = 0; r < 16; ++r) pmax = fmaxf(pmax, p1[r]);
    { auto rr = __builtin_amdgcn_permlane32_swap(__float_as_uint(pmax), __float_as_uint(pmax), false, false);
      pmax = fmaxf(__uint_as_float(rr[0]), __uint_as_float(rr[1])); }
    alpha = 0.f; m_reg = pmax;
#pragma unroll
    for (int r = 0; r < 16; ++r) { p0[r] -= pmax; p1[r] -= pmax; }
  }
#pragma unroll
  for (int r = 0; r < 16; ++r) { p0[r] = __builtin_amdgcn_exp2f(p0[r]); p1[r] = __builtin_amdgcn_exp2f(p1[r]); }
  float ps = 0.f;
#pragma unroll
  for (int r = 0; r < 16; ++r) ps += p0[r];
#pragma unroll
  for (int r = 0; r < 16; ++r) ps += p1[r];
  { auto rr = __builtin_amdgcn_permlane32_swap(__float_as_uint(ps), __float_as_uint(ps), false, false);
    ps = __uint_as_float(rr[0]) + __uint_as_float(rr[1]); }
  if (__builtin_expect(!first && __any(ps > 256.f), 0)) {
    float emax = p0[0];
#pragma unroll
    for (int r = 1; r < 16; ++r) emax = fmaxf(emax, p0[r]);
#pragma unroll
    for (int r = 0; r < 16; ++r) emax = fmaxf(emax, p1[r]);
    { auto rr = __builtin_amdgcn_permlane32_swap(__float_as_uint(emax), __float_as_uint(emax), false, false);
      emax = fmaxf(__uint_as_float(rr[0]), __uint_as_float(rr[1])); }
    const float delta = fmaxf(__builtin_amdgcn_logf(emax), 0.f);
    alpha = __builtin_amdgcn_exp2f(-delta); m_reg += delta;
#pragma unroll
    for (int r = 0; r < 16; ++r) { p0[r] *= alpha; p1[r] *= alpha; }
    ps *= alpha;
  }
  l_reg = l_reg * alpha + ps;
#pragma unroll
  for (int v = 0; v < 4; ++v) {
    int w0 = 0, w1 = 0;
    w0 = __builtin_amdgcn_cvt_pk_fp8_f32(p0[4 * v], p0[4 * v + 1], w0, false); w0 = __builtin_amdgcn_cvt_pk_fp8_f32(p0[4 * v + 2], p0[4 * v + 3], w0, true);
    w1 = __builtin_amdgcn_cvt_pk_fp8_f32(p1[4 * v], p1[4 * v + 1], w1, false); w1 = __builtin_amdgcn_cvt_pk_fp8_f32(p1[4 * v + 2], p1[4 * v + 3], w1, true);
    pa[v] = w0; pa[4 + v] = w1;
  }
}
__device__ __forceinline__ void att_unit(const bf16_t* __restrict__ Qb, const bf16_t* __restrict__ Kh, const unsigned char* __restrict__ V8, bf16_t* __restrict__ Ob,
                                         int nkeys, float lam, const float* __restrict__ ng, float oscale, unsigned char* lds) {
  int tid_ = threadIdx.x; asm volatile("" : "+v"(tid_)); const int tid = tid_, wid = tid >> 6, lane = tid & 63, r32 = lane & 31, hi = lane >> 5;
  unsigned char* V_lds = lds; unsigned char* K_lds = lds + 2 * ATT_SHM_V;
  float* wsl = (float*)(lds + 2 * ATT_SHM_V + 2 * ATT_SHM_K) + wid * 64; float* li_l = wsl; float* al_l = wsl + 32;
  float m0 = 0.f, l0 = 0.f, m1 = 0.f, l1 = 0.f;
  f32x16 o0[4] = {}, o1[4] = {};
  unsigned char* Q_lds = lds + 2 * ATT_SHM_V + 2 * ATT_SHM_K + 2048;
#pragma unroll
  for (int i = 0; i < 8; ++i) { const int id = tid + 512 * i, qrw = id >> 4, ch = id & 15;
    *(bf16x8*)(Q_lds + KSWZ(qrw, ch * 16)) = *(const bf16x8*)(Qb + (size_t)qrw * PW + ch * 8); }
  const int qrow = wid * 32 + r32;
  int kso[2];
#pragma unroll
  for (int i = 0; i < 2; ++i) {
    const int o16 = tid + 512 * i;
    { const int row = o16 >> 4, cs = (o16 & 15) ^ (row & 15); kso[i] = row * PW + cs * 8; }
  }
  const unsigned ldsw = (unsigned)__builtin_amdgcn_readfirstlane(wid) * 1024u;
#define GSTAGE(b, k0) do { _Pragma("unroll") for (int i_ = 0; i_ < 2; ++i_) \
    __builtin_amdgcn_global_load_lds((const unsigned*)(Kh + (size_t)(k0) * PW + kso[i_]), (LAS unsigned*)(K_lds + (b) * ATT_SHM_K + ldsw + i_ * 8192), 16, 0, 0); \
    { const unsigned char* vi_ = V8 + (size_t)((k0) >> 6) * ATT_SHM_V + tid * 16; \
      __builtin_amdgcn_global_load_lds((const unsigned*)vi_, (LAS unsigned*)(V_lds + (b) * ATT_SHM_V + ldsw), 16, 0, 0); \
      if (wid < 2) __builtin_amdgcn_global_load_lds((const unsigned*)(vi_ + 8192), (LAS unsigned*)(V_lds + (b) * ATT_SHM_V + 8192 + ldsw), 16, 0, 0); } } while (0)
#define RESC(o, a) do { if (__any((a) < 1.f)) { if (hi == 0) al_l[r32] = (a); asm volatile("s_waitcnt lgkmcnt(0)" ::: "memory"); \
    _Pragma("unroll") for (int d = 0; d < 4; ++d) _Pragma("unroll") for (int r = 0; r < 16; ++r) o[d][r] *= al_l[crow(r, hi)]; } } while (0)
  const int NT = nkeys / 64;
  GSTAGE(0, 0); asm volatile("s_waitcnt vmcnt(0)" ::: "memory"); __syncthreads();
  for (int j = 0; j < NT; ++j) {
    const int cur = j & 1;
    if (j + 1 < NT) GSTAGE(cur ^ 1, (j + 1) * 64);
    const unsigned char* Kc = K_lds + cur * ATT_SHM_K; const unsigned char* Vc = V_lds + cur * ATT_SHM_V;
    f32x16 p0, p1, q0, q1; float alphaA, alphaB; i32x8 pa, pb;
    const bool first = (j == 0);
    att_qkt(p0, p1, Kc, Q_lds, qrow, 0, r32, hi, first ? 0.f : -m0);
    att_qkt(q0, q1, Kc, Q_lds, qrow, 1, r32, hi, first ? 0.f : -m1);
    att_softmax(p0, p1, m0, l0, alphaA, first, pa);
    att_softmax(q0, q1, m1, l1, alphaB, first, pb);
    RESC(o0, alphaA);
    RESC(o1, alphaB);
#pragma unroll
    for (int d0 = 0; d0 < 4; ++d0) {
      const unsigned char* vrow = Vc + (d0 * 32 + r32) * 80 + hi * 32;
      const u32x4 v0 = *(const u32x4*)vrow, v1 = *(const u32x4*)(vrow + 16);
      i32x8 bv; bv[0] = (int)v0.x; bv[1] = (int)v0.y; bv[2] = (int)v0.z; bv[3] = (int)v0.w; bv[4] = (int)v1.x; bv[5] = (int)v1.y; bv[6] = (int)v1.z; bv[7] = (int)v1.w;
      o0[d0] = __builtin_amdgcn_mfma_scale_f32_32x32x64_f8f6f4(pa, bv, o0[d0], 0, 0, 0, 0x7F7F7F7F, 0, 0x7F7F7F7F);
      o1[d0] = __builtin_amdgcn_mfma_scale_f32_32x32x64_f8f6f4(pb, bv, o1[d0], 0, 0, 0, 0x7F7F7F7F, 0, 0x7F7F7F7F);
    }
    asm volatile("s_waitcnt vmcnt(0)" ::: "memory");
    __syncthreads();
  }
  if (hi == 0) { li_l[r32] = 1.f / l0; al_l[r32] = lam / l1; }
  asm volatile("s_waitcnt lgkmcnt(0)" ::: "memory");
  float ss[16];
#pragma unroll
  for (int r = 0; r < 16; ++r) {
    const float a = li_l[crow(r, hi)], bq = al_l[crow(r, hi)];
    float s = 0.f;
#pragma unroll
    for (int d = 0; d < 4; ++d) { const float v = o0[d][r] * a - o1[d][r] * bq; o0[d][r] = v; s += v * v; }
    s += __shfl_xor(s, 1); s += __shfl_xor(s, 2); s += __shfl_xor(s, 4); s += __shfl_xor(s, 8); s += __shfl_xor(s, 16);
    ss[r] = rsqrtf(s * (1.f / 128.f) + EPS) * oscale;
  }
  bf16_t* Ow = Ob + (size_t)(wid * 32) * DM;
#pragma unroll
  for (int d = 0; d < 4; ++d) {
    const float g = ng[d * 32 + r32];
#pragma unroll
    for (int r = 0; r < 16; ++r) Ow[(size_t)crow(r, hi) * DM + d * 32 + r32] = (ABL & 4) ? (bf16_t)0 : (bf16_t)(cvtpk(o0[d][r] * ss[r] * g, 0.f) & 0xffffu);
  }
  __syncthreads();
#undef GSTAGE
#undef RESC
}

__device__ __forceinline__ float ins16(float (&a)[16], float x) {
#pragma unroll
  for (int i = 0; i < 16; ++i) { const float h = fmaxf(a[i], x); x = fminf(a[i], x); a[i] = h; }
  return x;
}
__device__ __forceinline__ void bsort16(float (&a)[16]) {
#pragma unroll
  for (int k = 2; k <= 16; k <<= 1)
#pragma unroll
    for (int j = k >> 1; j > 0; j >>= 1)
#pragma unroll
      for (int i = 0; i < 16; ++i) {
        const int q = i ^ j;
        if (q > i) {
          const bool desc = ((i & k) == 0);
          const float hi_ = fmaxf(a[i], a[q]), lo_ = fminf(a[i], a[q]);
          a[i] = desc ? hi_ : lo_; a[q] = desc ? lo_ : hi_;
        }
      }
}
__device__ __forceinline__ void bmerge16(float (&a)[16], const float (&b)[16]) {
#pragma unroll
  for (int i = 0; i < 16; ++i) a[i] = fmaxf(a[i], b[15 - i]);
#pragma unroll
  for (int j = 8; j > 0; j >>= 1)
#pragma unroll
    for (int i = 0; i < 16; ++i) {
      const int q = i ^ j;
      if (q > i) { const float hi_ = fmaxf(a[i], a[q]), lo_ = fminf(a[i], a[q]); a[i] = hi_; a[q] = lo_; }
    }
}
__device__ __forceinline__ float gelu_erf(float x) { return 0.5f * x * (1.f + erff(x * 0.70710678118654752440f)); }
#define XB_TMO      128
#define XB_XCNT(j)  (256  + 64 * (j))
#define XB_XSUB(j)  (1280 + 64 * (j))
#define XB_XGEN(j)  (2304 + 64 * (j))
#define XB_TOP      3328
#define XB_TOPGEN   3392
#define XCD_BAR_WORDS 3456
#define XB_SPIN_CAP (1u << 22)
__device__ __forceinline__ unsigned xb_ld(unsigned* p)              { return __hip_atomic_load(p, __ATOMIC_RELAXED, __HIP_MEMORY_SCOPE_AGENT); }
__device__ __forceinline__ unsigned xb_add(unsigned* p, unsigned v) { return __hip_atomic_fetch_add(p, v, __ATOMIC_RELAXED, __HIP_MEMORY_SCOPE_AGENT); }
__device__ __forceinline__ unsigned xb_xcc_id() { return (unsigned)__builtin_amdgcn_s_getreg((3 << 11) | 20) & 0xFu; }
#define XB_SPIN(cond, bar) do { unsigned _sp = 0; while (cond) { __builtin_amdgcn_s_sleep(1); \
    if ((++_sp & 255u) == 0u) { if (xb_ld(&(bar)[XB_TMO])) break; if (_sp > XB_SPIN_CAP) { atomicAdd(&(bar)[XB_TMO], 1u); break; } } } } while (0)
struct XcdBarrier { unsigned* bar; unsigned x; volatile LAS unsigned* st; };
__device__ __forceinline__ XcdBarrier xcd_barrier_post(unsigned* bar, volatile LAS unsigned* st) {
  XcdBarrier b; b.bar = bar; b.x = xb_xcc_id(); b.st = st;
  if (threadIdx.x == 0) (void)xb_add(&bar[XB_XCNT(b.x)], 1u);
  return b;
}
__device__ __forceinline__ void xcd_barrier_complete(unsigned* bar, unsigned x, unsigned& nloc, unsigned& nx) {
  const unsigned G = gridDim.x * gridDim.y * gridDim.z;
  unsigned sum, cnt, mine, sp = 0u;
  for (;;) {
    sum = 0u; cnt = 0u; mine = 0u;
#pragma unroll
    for (unsigned j = 0; j < 16; ++j) { const unsigned c = xb_ld(&bar[XB_XCNT(j)]); sum += c; cnt += (c > 0u) ? 1u : 0u; mine = (j == x) ? c : mine; }
    if (sum == G) break;
    __builtin_amdgcn_s_sleep(1);
    if ((++sp & 255u) == 0u) { if (xb_ld(&bar[XB_TMO])) break; if (sp > XB_SPIN_CAP) { atomicAdd(&bar[XB_TMO], 1u); break; } }
  }
  nloc = mine > 0u ? mine : 1u; nx = cnt > 0u ? cnt : 1u;
}
__device__ __forceinline__ void xcd_barrier(const XcdBarrier& b) {
  asm volatile("s_waitcnt vmcnt(0)" ::: "memory");
  __syncthreads();
  if (threadIdx.x == 0) {
    unsigned* bar = b.bar;
    __builtin_amdgcn_s_waitcnt(0);
    unsigned nloc = b.st[0], nx = b.st[1];
    if (nloc == 0u) { xcd_barrier_complete(bar, b.x, nloc, nx); b.st[0] = nloc; b.st[1] = nx; }
    const unsigned old = xb_add(&bar[XB_XSUB(b.x)], 1u);
    const unsigned gen = old / nloc;
    if (old + 1u == (gen + 1u) * nloc) {
      __builtin_amdgcn_fence(__ATOMIC_RELEASE, "agent");
      asm volatile("s_waitcnt vmcnt(0)" ::: "memory");
      const unsigned og = xb_add(&bar[XB_TOP], 1u);
      const unsigned tg = og / nx;
      if (og + 1u == (tg + 1u) * nx) xb_add(&bar[XB_TOPGEN], 1u);
      else XB_SPIN(xb_ld(&bar[XB_TOPGEN]) == tg, bar);
      __builtin_amdgcn_fence(__ATOMIC_ACQUIRE, "agent");
      xb_add(&bar[XB_XGEN(b.x)], 1u);
      asm volatile("s_waitcnt vmcnt(0)" ::: "memory");
    } else {
      XB_SPIN(xb_ld(&bar[XB_XGEN(b.x)]) == gen, bar);
      __builtin_amdgcn_fence(__ATOMIC_ACQUIRE, "agent");
      asm volatile("s_waitcnt vmcnt(0)" ::: "memory");
    }
  }
  __syncthreads();
}

constexpr size_t RT_STRIDE = (size_t)T * 128 * 4;
__device__ __forceinline__ void route_unit(const Params& p, int l, int unit, unsigned char* lds) {
  int tid_ = threadIdx.x; asm volatile("" : "+v"(tid_)); const int tid = tid_, lane = tid & 63, wid = tid >> 6, r32 = lane & 31, hi = lane >> 5;
  unsigned char* IDX = lds;
  int* UE = (int*)(lds + 8192); float* UG = (float*)(lds + 8192 + 16384); float* US = (float*)(lds + 8192 + 32768);
  int* EIDG = (int*)(p.ws + WS_ULOC); float* GWG = (float*)(p.ws + WS_ULOC + RT_STRIDE); float* SUG = (float*)(p.ws + WS_ULOC + 2 * RT_STRIDE);
  const float* PSC = (const float*)(p.ws + WS_PSC);
  const int row0 = unit * 32;
  const bf16_t* QP = (const bf16_t*)(p.ws + WS_PROJ);
  const bf16_t* KEYS = (const bf16_t*)(p.ws + WS_KEYS) + (size_t)l * 131072;
  for (int rrep = 0; rrep < REP_ROUTE; ++rrep) {
    const int h = wid;
    float top[2][16];
#pragma unroll
    for (int pp = 0; pp < 2; ++pp) {
      const bf16_t* qrow = QP + (size_t)(row0 + r32) * DM + h * 128 + pp * 64 + hi * 8;
      const bf16_t* kb = KEYS + ((size_t)(h * 2 + pp) * 128 + r32) * 64 + hi * 8;
      bf16x8 bq[4];
#pragma unroll
      for (int ks = 0; ks < 4; ++ks) bq[ks] = *(const bf16x8*)(qrow + ks * 16);
      float (&lst)[16] = top[pp];
#pragma unroll
      for (int i = 0; i < 16; ++i) lst[i] = -INFINITY;
#pragma unroll
      for (int nt = 0; nt < 4; ++nt) {
        f32x16 acc = {};
#pragma unroll
        for (int ks = 0; ks < 4; ++ks) {
          const bf16x8 ak = *(const bf16x8*)(kb + (size_t)nt * 32 * 64 + ks * 16);
          acc = __builtin_amdgcn_mfma_f32_32x32x16_bf16(ak, bq[ks], acc, 0, 0, 0);
        }
        float grp[16];
#pragma unroll
        for (int r = 0; r < 16; ++r) grp[r] = __uint_as_float((__float_as_uint(acc[r]) & ~0x7Fu) | (unsigned)(nt * 32 + crow(r, hi)));
        bsort16(grp);
        if (nt == 0) {
#pragma unroll
          for (int i = 0; i < 16; ++i) lst[i] = grp[i];
        } else bmerge16(lst, grp);
        SBAR();
      }
      float oth[16];
#pragma unroll
      for (int i = 0; i < 16; ++i) oth[i] = __shfl_xor(lst[i], 32);
      bmerge16(lst, oth);
      if (hi == 0) {
        unsigned w[4];
#pragma unroll
        for (int i = 0; i < 4; ++i)
          w[i] = (__float_as_uint(lst[4 * i]) & 0x7Fu) | ((__float_as_uint(lst[4 * i + 1]) & 0x7Fu) << 8) | ((__float_as_uint(lst[4 * i + 2]) & 0x7Fu) << 16) | ((__float_as_uint(lst[4 * i + 3]) & 0x7Fu) << 24);
        *(u32x4*)(IDX + ((r32 * 8 + h) * 2 + pp) * 16) = (u32x4){w[0], w[1], w[2], w[3]};
      }
    }
    float best[16];
#define CAND(i, j) __uint_as_float((__float_as_uint(__uint_as_float(__float_as_uint(top[0][i]) & ~0x7Fu) + __uint_as_float(__float_as_uint(top[1][j]) & ~0x7Fu)) & ~0xFFu) | (unsigned)((i) * 16 + (j)))
    {
#pragma unroll
      for (int j = 0; j < 16; ++j) best[j] = CAND(0, j);
      float y[16];
#pragma unroll
      for (int j = 0; j < 8; ++j) { y[j] = CAND(1, j); y[8 + j] = CAND(15 - j, 0); }
#pragma unroll
      for (int jj = 8; jj > 0; jj >>= 1)
#pragma unroll
        for (int i = 0; i < 16; ++i) { const int q = i ^ jj; if (q > i) { const float hi_ = fmaxf(y[i], y[q]), lo_ = fminf(y[i], y[q]); y[i] = hi_; y[q] = lo_; } }
      bmerge16(best, y);
      float x[16];
      x[0] = CAND(2, 0); x[1] = CAND(2, 1); x[2] = CAND(2, 2); x[3] = CAND(2, 3); x[4] = CAND(2, 4);
      x[5] = CAND(3, 0); x[6] = CAND(3, 1); x[7] = CAND(3, 2); x[8] = CAND(3, 3);
      x[9] = CAND(4, 0); x[10] = CAND(4, 1); x[11] = CAND(4, 2);
      x[12] = CAND(5, 0); x[13] = CAND(5, 1); x[14] = CAND(6, 0); x[15] = CAND(6, 1);
      bsort16(x);
      bmerge16(best, x);
      ins16(best, CAND(7, 0)); ins16(best, CAND(7, 1));
    }
#undef CAND
    asm volatile("s_waitcnt lgkmcnt(0)" ::: "memory");
    if (hi == 0) {
      const unsigned char* ib = IDX + ((r32 * 8 + h) * 2) * 16;
      const float mx = __uint_as_float(__float_as_uint(best[0]) & ~0xFFu);
      float w[16]; float sum = 0.f;
#pragma unroll
      for (int k = 0; k < 16; ++k) { w[k] = __expf(__uint_as_float(__float_as_uint(best[k]) & ~0xFFu) - mx); sum += w[k]; }
      const float rsum = 1.f / sum;
      int ee[16]; float su_[16], sv_[16];
#pragma unroll
      for (int k = 0; k < 16; ++k) {
        const unsigned ij = __float_as_uint(best[k]) & 0xFFu;
        ee[k] = (int)ib[ij >> 4] * 128 + (int)ib[16 + (ij & 15)];
      }
#pragma unroll
      for (int k = 0; k < 16; ++k) { su_[k] = PSC[(size_t)l * NEXP + ee[k]]; sv_[k] = PSC[(size_t)(DEPTH + l) * NEXP + ee[k]]; }
#pragma unroll
      for (int k = 0; k < 16; ++k) {
        UE[r32 * 128 + h * 16 + k] = ee[k]; UG[r32 * 128 + h * 16 + k] = w[k] * rsum * sv_[k];
        US[r32 * 128 + h * 16 + k] = su_[k];
      }
    }
  }
  __syncthreads();
#pragma unroll 1
  for (int tt = 0; tt < 4; ++tt) {
    const int t = wid * 4 + tt;
    const int k0 = UE[t * 128 + lane], k1 = UE[t * 128 + 64 + lane];
    const float g0 = UG[t * 128 + lane], g1 = UG[t * 128 + 64 + lane], s0 = US[t * 128 + lane], s1 = US[t * 128 + 64 + lane];
    const int b0 = k0 >> 10, b1 = k1 >> 10;
    int base = 0, pos0 = 0, pos1 = 0;
#pragma unroll
    for (int b = 0; b < 16; ++b) {
      const unsigned long long m0 = __ballot(b0 == b), m1 = __ballot(b1 == b);
      const int c0 = __popcll(m0), c1 = __popcll(m1);
      const unsigned long long lt = (1ull << lane) - 1ull;
      if (b0 == b) pos0 = base + __popcll(m0 & lt);
      if (b1 == b) pos1 = base + c0 + __popcll(m1 & lt);
      base += c0 + c1;
    }
    const size_t ro = (size_t)(row0 + t) * 128;
    EIDG[ro + pos0] = k0; GWG[ro + pos0] = g0; SUG[ro + pos0] = s0;
    EIDG[ro + pos1] = k1; GWG[ro + pos1] = g1; SUG[ro + pos1] = s1;
  }
}
struct TokPref { int e0, e1; float g0, g1, s0, s1; u32x4 hA, hB; };
__device__ __forceinline__ void tok_prefetch(const Params& p, int row, int lane, TokPref& t) {
  const int* EIDG = (const int*)(p.ws + WS_ULOC) + (size_t)row * 128; const float* GWG = (const float*)(p.ws + WS_ULOC + RT_STRIDE) + (size_t)row * 128;
  const float* SUG = (const float*)(p.ws + WS_ULOC + 2 * RT_STRIDE) + (size_t)row * 128;
  const bf16_t* H = (const bf16_t*)(p.ws + WS_H);
  t.e0 = EIDG[lane]; t.e1 = EIDG[64 + lane]; t.g0 = GWG[lane]; t.g1 = GWG[64 + lane]; t.s0 = SUG[lane]; t.s1 = SUG[64 + lane];
  t.hA = *(const u32x4*)(H + (size_t)row * DM + lane * 16); t.hB = *(const u32x4*)(H + (size_t)row * DM + lane * 16 + 8);
}
__device__ __forceinline__ void gather_token(const Params& p, int l, int row, int nextrow, TokPref& tp, unsigned char* lds, int lane, int wid) {
  int* EW = (int*)(lds + wid * 2048); float* GWl = (float*)(lds + wid * 2048 + 512); float* SWl = (float*)(lds + wid * 2048 + 1024);
  const bf16_t* H = (const bf16_t*)(p.ws + WS_H);
  const unsigned char* PUq = p.ws + WS_PU + (size_t)l * NEXP * DM;
  const unsigned char* PVq = p.ws + WS_PV + (size_t)l * NEXP * DM;
  float* XC = (float*)(p.ws + WS_XCUR);
  const float* MOD = (const float*)(p.ws + WS_MOD);
  EW[lane] = tp.e0; EW[64 + lane] = tp.e1; GWl[lane] = tp.g0; GWl[64 + lane] = tp.g1; SWl[lane] = tp.s0; SWl[64 + lane] = tp.s1;
  asm volatile("s_waitcnt lgkmcnt(0)" ::: "memory");
  {
    float hf[16];
    {
      const u32x4 hA = tp.hA, hB = tp.hB;
      hf[0] = bflo(hA.x); hf[1] = bfhi(hA.x); hf[2] = bflo(hA.y); hf[3] = bfhi(hA.y); hf[4] = bflo(hA.z); hf[5] = bfhi(hA.z); hf[6] = bflo(hA.w); hf[7] = bfhi(hA.w);
      hf[8] = bflo(hB.x); hf[9] = bfhi(hB.x); hf[10] = bflo(hB.y); hf[11] = bfhi(hB.y); hf[12] = bflo(hB.z); hf[13] = bfhi(hB.z); hf[14] = bflo(hB.w); hf[15] = bfhi(hB.w);
    }
    if (nextrow >= 0) tok_prefetch(p, nextrow, lane, tp);
    f32x4 xpre[4];
    { const float* xr_ = XC + (size_t)row * DM + lane * 16;
#pragma unroll
      for (int v4 = 0; v4 < 4; ++v4) xpre[v4] = *(const f32x4*)(xr_ + v4 * 4); }
    float acc[16];
    for (int rep = 0; rep < REP_PEER; ++rep) {
#pragma unroll
    for (int i = 0; i < 16; ++i) acc[i] = 0.f;
    u32x4 uq[8];
#pragma unroll
    for (int i = 0; i < 8; ++i) { const int e0 = __builtin_amdgcn_readfirstlane(EW[i]); uq[i] = *(const u32x4*)(PUq + (size_t)e0 * DM + lane * 16); }
    for (int g8 = 0; g8 < 16; ++g8) {
      int eid[8]; float gwt[8]; u32x4 vq[8];
#pragma unroll
      for (int i = 0; i < 8; ++i) {
        eid[i] = __builtin_amdgcn_readfirstlane(EW[g8 * 8 + i]);
        gwt[i] = __uint_as_float(__builtin_amdgcn_readfirstlane(__float_as_uint(GWl[g8 * 8 + i])));
        vq[i] = *(const u32x4*)(PVq + (size_t)eid[i] * DM + lane * 16);
      }
      float d[8];
#pragma unroll
      for (int i = 0; i < 8; ++i) {
        const float su = __uint_as_float(__builtin_amdgcn_readfirstlane(__float_as_uint(SWl[g8 * 8 + i])));
        float a0 = 0.f, a1 = 0.f;
#define DQ(W, K) { const f32x2 lo_ = __builtin_amdgcn_cvt_pk_f32_fp8((int)(W), false), hi_ = __builtin_amdgcn_cvt_pk_f32_fp8((int)(W), true); \
          a0 += lo_.x * hf[K]; a1 += lo_.y * hf[K + 1]; a0 += hi_.x * hf[K + 2]; a1 += hi_.y * hf[K + 3]; }
        DQ(uq[i].x, 0) DQ(uq[i].y, 4) DQ(uq[i].z, 8) DQ(uq[i].w, 12)
#undef DQ
        d[i] = (a0 + a1) * su;
      }
      if (g8 < 15) {
#pragma unroll
        for (int i = 0; i < 8; ++i) { const int e0 = __builtin_amdgcn_readfirstlane(EW[(g8 + 1) * 8 + i]); uq[i] = *(const u32x4*)(PUq + (size_t)e0 * DM + lane * 16); }
      }
      float tot;
      {
        auto s01 = __builtin_amdgcn_permlane32_swap(__float_as_uint(d[0]), __float_as_uint(d[1]), false, false);
        auto s23 = __builtin_amdgcn_permlane32_swap(__float_as_uint(d[2]), __float_as_uint(d[3]), false, false);
        auto s45 = __builtin_amdgcn_permlane32_swap(__float_as_uint(d[4]), __float_as_uint(d[5]), false, false);
        auto s67 = __builtin_amdgcn_permlane32_swap(__float_as_uint(d[6]), __float_as_uint(d[7]), false, false);
        const float q01 = __uint_as_float(s01[0]) + __uint_as_float(s01[1]), q23 = __uint_as_float(s23[0]) + __uint_as_float(s23[1]);
        const float q45 = __uint_as_float(s45[0]) + __uint_as_float(s45[1]), q67 = __uint_as_float(s67[0]) + __uint_as_float(s67[1]);
        auto ta = __builtin_amdgcn_permlane16_swap(__float_as_uint(q01), __float_as_uint(q23), false, false);
        auto tb = __builtin_amdgcn_permlane16_swap(__float_as_uint(q45), __float_as_uint(q67), false, false);
        const float r0123 = __uint_as_float(ta[0]) + __uint_as_float(ta[1]);
        const float r4567 = __uint_as_float(tb[0]) + __uint_as_float(tb[1]);
        const bool b3 = (lane & 8) != 0;
        const float keep = b3 ? r4567 : r0123, send = b3 ? r0123 : r4567;
        float x = keep + __shfl_xor(send, 8);
        x += __shfl_xor(x, 4); x += __shfl_xor(x, 2); x += __shfl_xor(x, 1);
        tot = x;
      }
      float ge;
      {
        const float v = tot, av = fabsf(v), tq = __builtin_amdgcn_rcpf(av * 0.2316418882f + 1.0f);
        float q = tq * 0.5307027145f + (-0.7265760135f); q = q * tq + 0.7107068705f; q = q * tq + (-0.142248368f); q = q * tq + 0.127414796f; q = q * tq;
        const float ex = __builtin_amdgcn_exp2f(v * v * (-0.72134752044f));
        const float m = v * (q * ex), r = v - m;
        ge = v < 0.f ? m : r;
      }
      float c[8];
      c[0] = __uint_as_float(__builtin_amdgcn_readlane(__float_as_uint(ge), 0)) * gwt[0];  c[4] = __uint_as_float(__builtin_amdgcn_readlane(__float_as_uint(ge), 8)) * gwt[4];
      c[2] = __uint_as_float(__builtin_amdgcn_readlane(__float_as_uint(ge), 16)) * gwt[2]; c[6] = __uint_as_float(__builtin_amdgcn_readlane(__float_as_uint(ge), 24)) * gwt[6];
      c[1] = __uint_as_float(__builtin_amdgcn_readlane(__float_as_uint(ge), 32)) * gwt[1]; c[5] = __uint_as_float(__builtin_amdgcn_readlane(__float_as_uint(ge), 40)) * gwt[5];
      c[3] = __uint_as_float(__builtin_amdgcn_readlane(__float_as_uint(ge), 48)) * gwt[3]; c[7] = __uint_as_float(__builtin_amdgcn_readlane(__float_as_uint(ge), 56)) * gwt[7];
#pragma unroll
      for (int i = 0; i < 8; ++i) {
#define AQ(W, K) { const f32x2 lo_ = __builtin_amdgcn_cvt_pk_f32_fp8((int)(W), false), hi_ = __builtin_amdgcn_cvt_pk_f32_fp8((int)(W), true); \
          acc[K] += c[i] * lo_.x; acc[K + 1] += c[i] * lo_.y; acc[K + 2] += c[i] * hi_.x; acc[K + 3] += c[i] * hi_.y; }
        AQ(vq[i].x, 0) AQ(vq[i].y, 4) AQ(vq[i].z, 8) AQ(vq[i].w, 12)
#undef AQ
      }
    }
    }
    SBAR();
    const int mr = mod_row(row);
    const float* g2 = MOD + ((size_t)l * 5 + mr) * 6144 + 5 * 1024;
    float* xr = XC + (size_t)row * DM;
    float xn[16]; float ssq = 0.f;
    if (ABL & 8) {
#pragma unroll
      for (int i = 0; i < 16; ++i) acc[i] = 0.f;
    }
#pragma unroll
    for (int v4 = 0; v4 < 4; ++v4) {
      const int c = lane * 16 + v4 * 4;
      const f32x4 xo = xpre[v4], gg = *(const f32x4*)(g2 + c);
      f32x4 o;
      o.x = xo.x + gg.x * acc[v4 * 4 + 0]; o.y = xo.y + gg.y * acc[v4 * 4 + 1]; o.z = xo.z + gg.z * acc[v4 * 4 + 2]; o.w = xo.w + gg.w * acc[v4 * 4 + 3];
      xn[v4 * 4 + 0] = o.x; xn[v4 * 4 + 1] = o.y; xn[v4 * 4 + 2] = o.z; xn[v4 * 4 + 3] = o.w;
      ssq += (o.x * o.x + o.y * o.y) + (o.z * o.z + o.w * o.w);
      if (l < DEPTH - 1) *(f32x4*)(xr + c) = o;
    }
    const float rs = rsqrtf(wave_sum(ssq) * (1.f / DM) + EPS);
    if (l == DEPTH - 1) {
      const int b = row / SEGL, s = row - b * SEGL;
      float* orow = p.out + ((size_t)(b * SEQ + (s - CTXL))) * DM;
      const float* fg = p.in[I_FINALG];
#pragma unroll
      for (int v4 = 0; v4 < 4; ++v4) {
        const int c = lane * 16 + v4 * 4;
        const f32x4 gg = *(const f32x4*)(fg + c);
        f32x4 o; o.x = xn[v4 * 4 + 0] * rs * gg.x; o.y = xn[v4 * 4 + 1] * rs * gg.y; o.z = xn[v4 * 4 + 2] * rs * gg.z; o.w = xn[v4 * 4 + 3] * rs * gg.w;
        *(f32x4*)(orow + c) = o;
      }
    } else {
      const float* m = MOD + ((size_t)(l + 1) * 5 + mr) * 6144;
      const float* ng = p.in[I_N1G] + (l + 1) * DM;
      bf16_t* hrow = (bf16_t*)(p.ws + WS_H) + (size_t)row * DM;
#pragma unroll
      for (int hh = 0; hh < 2; ++hh) {
        float y[8];
#pragma unroll
        for (int i = 0; i < 8; ++i) { const int c = lane * 16 + hh * 8 + i; y[i] = xn[hh * 8 + i] * rs * ng[c] * (1.f + m[1024 + c]) + m[c]; }
        u32x4 w; w.x = cvtpk(y[0], y[1]); w.y = cvtpk(y[2], y[3]); w.z = cvtpk(y[4], y[5]); w.w = cvtpk(y[6], y[7]);
        *(u32x4*)(hrow + lane * 16 + hh * 8) = w;
      }
    }
  }
}

__device__ __forceinline__ void phase_c1(const Params& p, int l, unsigned char* lds) {
  constexpr int NLOC = NBATCH * 4 * NCH, NCONV = T / 32;
  for (int u = p.bx; u < NLOC + NCONV; u += p.gx) {
    if (u < NLOC) ml_local_unit2(p, l, u, lds);
    else {
      const int cu = u - NLOC;
      if (l == DEPTH - 1 && (cu % (SEGL / 32)) < (CTXL / 32)) continue;
      conv_unit(p, l, cu, lds);
    }
  }
}
__device__ __forceinline__ void phase_c2(const Params& p, int l, unsigned char* lds) {
  ml_scan(p, lds);
  const float* lp = p.in[I_DLAM] + l * 256;
  float s01 = 0.f, s23 = 0.f;
  for (int i = 0; i < 64; ++i) { s01 += lp[i] * lp[64 + i]; s23 += lp[128 + i] * lp[192 + i]; }
  const float lam_init = 0.8f - 0.6f * expf(-0.3f * (float)l);
  const float lam = expf(s01) - expf(s23) + lam_init;
  const bf16_t* PROJ = (const bf16_t*)(p.ws + WS_PROJ);
  bf16_t* MIX = (bf16_t*)(p.ws + WS_MIX);
  const float* ng = p.in[I_DNORMG] + l * 128;
  const int nun = 512 + (l < DEPTH - 1 ? 16 : 0);
  for (int u = p.bx; u < nun; u += p.gx) {
    int bh, qrow, nkeys;
    if (u < 512) { const int xcd = u & 7, i = (u >> 3) & 31, rnd = u >> 8; bh = 2 * xcd + rnd; qrow = CTXL + i * 256; nkeys = SEGL; }
    else { bh = u - 512; qrow = 0; nkeys = CTXL; }
    const int b = bh >> 2, h = bh & 3;
    const size_t tok0 = (size_t)b * SEGL;
    for (int rep = 0; rep < REP_ATT; ++rep)
    att_unit(PROJ + (tok0 + qrow) * PW + C_DQ + h * 128, PROJ + tok0 * PW + C_DK + h * 128, p.ws + WS_V8T + (size_t)bh * NCH * ATT_SHM_V,
             MIX + (tok0 + qrow) * DM + 512 + h * 128, nkeys, lam, ng, 1.f - lam_init, lds);
  }
}
__device__ __forceinline__ void phase_c3(const Params& p, int l, unsigned char* lds) {
  constexpr int NU = NBATCH * 4 * NCH;
  for (int u = p.bx; u < NU; u += p.gx) {
    if (l == DEPTH - 1 && (u % NCH) < 4) continue;
    ml_out_unit2(p, l, u, lds);
  }
}
__device__ __forceinline__ void phase_route(const Params& p, int l, unsigned char* lds) {
  constexpr int NU = T / 32;
  for (int u = p.bx; u < NU; u += p.gx) {
    if (l == DEPTH - 1 && (u % (SEGL / 32)) < (CTXL / 32)) continue;
    route_unit(p, l, u, lds);
    __syncthreads();
  }
}
__device__ __forceinline__ void phase_gather(const Params& p, int l, unsigned char* lds) {
  int tid_ = threadIdx.x; asm volatile("" : "+v"(tid_)); const int lane = tid_ & 63, wid = tid_ >> 6;
  const int gw = p.bx * 8 + wid, NGW = p.gx * 8;
  const int ntok = (l == DEPTH - 1) ? NBATCH * SEQ : T;
#define TOKROW(ti_) ((l == DEPTH - 1) ? ((ti_) / SEQ) * SEGL + CTXL + ((ti_) % SEQ) : (ti_))
  TokPref tp;
  if (gw < ntok) tok_prefetch(p, TOKROW(gw), lane, tp);
  XcdBarrier xb; xb.bar = p.xbar_words; xb.x = p.xbar_x; xb.st = (volatile LAS unsigned*)((LAS unsigned char*)lds + p.lds_st_off);
  const int nrounds = (ntok + NGW - 1) / NGW;
  for (int r = 0; r < nrounds; ++r) {
    const int ti = gw + r * NGW;
    if (ti < ntok) {
      const int row = TOKROW(ti);
      const int nxt = ti + NGW < ntok ? TOKROW(ti + NGW) : -1;
      gather_token(p, l, row, nxt, tp, lds, lane, wid);
    }
#if GATHER_SYNC
    if (r + 1 < nrounds) { XcdBarrier xb2 = xb; size_t zb_ = 0; asm volatile("" : "+s"(zb_)); xb2.bar = xb.bar + zb_; xb2.x = xb.x + (unsigned)zb_; xcd_barrier(xb2); }
#endif
  }
#undef TOKROW
}

__global__ void __launch_bounds__(512, 2) mk_fwd(KArgs ka) {
  cg::grid_group grid = cg::this_grid();
  extern __shared__ __attribute__((aligned(16))) unsigned char lds[];
  const int lo = ka.ph_lo, hi = ka.ph_hi;
#define IN(k) (lo <= (k) && (k) < hi)
#ifndef PHASEMASK
#define PHASEMASK 0xFFFF
#endif
#define PH(i) ((PHASEMASK >> (i)) & 1)
#define MKP(q) Params q; { size_t z_ = 0; asm volatile("" : "+s"(z_)); \
    q.in = (InTab)((const __attribute__((address_space(4))) char*)__builtin_amdgcn_kernarg_segment_ptr() + z_); \
    q.out = ka.out + z_; q.ws = ka.ws + z_; q.ph_lo = lo; q.ph_hi = hi; q.bx = (int)blockIdx.x + (int)z_; q.gx = (int)gridDim.x + (int)z_; q.xbar_words = xbar.bar + z_; q.xbar_x = xbar.x + (unsigned)z_; q.lds_st_off = (unsigned)(LDS_BYTES - 64); }
#define SEAM(k) do { if (IN(k) && IN((k) + 1)) { if ((k) == 0) grid.sync(); else { XcdBarrier xb_ = xbar; size_t zb_ = 0; asm volatile("" : "+s"(zb_)); xb_.bar = xbar.bar + zb_; xb_.x = xbar.x + (unsigned)zb_; xcd_barrier(xb_); } } } while (0)
  volatile LAS unsigned* xst = (volatile LAS unsigned*)((LAS unsigned char*)lds + (LDS_BYTES - 64));
  if (threadIdx.x < 2) xst[threadIdx.x] = 0u;
  __syncthreads();
  XcdBarrier xbar = xcd_barrier_post((unsigned*)(ka.ws + WS_CTL) + 4096, xst);
  { MKP(p)
    if (PH(0) && IN(0)) for (int rep = 0; rep < REP_MISC; ++rep) { p0_mod(p, lds, (float*)(p.ws + WS_MOD)); p0_convert(p, lds); }
  }
  SEAM(0);
  { MKP(p)
    if (PH(1) && IN(1)) phase_norm(p, 0, 0, true, false);
  }
  SEAM(1);
#define LAYER(LL) { \
    int l = (LL); asm volatile("" : "+s"(l)); \
    const int b = 2 + 9 * (LL); \
    { MKP(q) if (PH(2) && IN(b + 0)) for (int rep = 0; rep < REP_GEMM; ++rep) phase_inproj2(q, l, lds); } \
    SEAM(b + 0); \
    { MKP(q) if (PH(3) && IN(b + 1)) for (int rep = 0; rep < REP_ML; ++rep) phase_c1(q, l, lds); } \
    SEAM(b + 1); \
    { MKP(q) if (PH(4) && IN(b + 2)) phase_c2(q, l, lds); } \
    SEAM(b + 2); \
    { MKP(q) if (PH(5) && IN(b + 3)) for (int rep = 0; rep < REP_ML; ++rep) phase_c3(q, l, lds); } \
    SEAM(b + 3); \
    { MKP(q) if (PH(6) && IN(b + 4)) phase_outproj2(q, l, lds); } \
    SEAM(b + 4); \
    { MKP(q) if (PH(7) && IN(b + 5)) for (int rep = 0; rep < REP_MISC; ++rep) phase_norm(q, l, 1, false, (LL) == DEPTH - 1); } \
    SEAM(b + 5); \
    { MKP(q) if (PH(8) && IN(b + 6)) for (int rep = 0; rep < REP_GEMM; ++rep) phase_peerq2(q, l, lds); } \
    SEAM(b + 6); \
    { MKP(q) if (PH(9) && IN(b + 7)) phase_route(q, l, lds); } \
    SEAM(b + 7); \
    { MKP(q) if (PH(9) && IN(b + 8)) phase_gather(q, l, lds); } \
    SEAM(b + 8); }
  LAYER(0) LAYER(1) LAYER(2) LAYER(3)
#undef LAYER
#undef IN
#undef SEAM
#undef MKP
}

extern "C" void kernel_launch(void* const* d_in, const int* in_sizes, int n_in, void* d_out, int out_size,
                              void* d_ws, size_t ws_size, hipStream_t stream) {
  static int grid = 0;
  if (grid == 0) {
    int dev = 0, cus = 0, per_cu = 0;
    (void)hipGetDevice(&dev);
    (void)hipDeviceGetAttribute(&cus, hipDeviceAttributeMultiprocessorCount, dev);
    (void)hipFuncSetAttribute((const void*)mk_fwd, hipFuncAttributeMaxDynamicSharedMemorySize, LDS_BYTES);
    (void)hipOccupancyMaxActiveBlocksPerMultiprocessor(&per_cu, (const void*)mk_fwd, 512, LDS_BYTES);
    fprintf(stderr, "kernel_launch: cus %d per_cu %d ws %zu (need %zu) n_in %d\n", cus, per_cu, ws_size, (size_t)WS_END, n_in);
    if (ws_size < WS_END || n_in != 23 || per_cu < 1) { fprintf(stderr, "kernel_launch: bad configuration, nothing launched\n"); grid = -1; return; }
    grid = cus;
  }
  if (grid < 0) return;
  (void)hipMemsetAsync((char*)d_ws + WS_CTL, 0, 65536, stream);
  KArgs p{};
  for (int i = 0; i < 23; ++i) p.in[i] = (const float*)d_in[i];
  p.out = (float*)d_out; p.ws = (unsigned char*)d_ws; p.ph_lo = 0; p.ph_hi = 38;
  void* args[] = {&p};
  hipError_t e = hipLaunchCooperativeKernel((const void*)mk_fwd, dim3(grid), dim3(512), args, LDS_BYTES, stream);
  if (e != hipSuccess) fprintf(stderr, "cooperative launch failed: %s (grid %d)\n", hipGetErrorString(e), grid);
}
```

```cpp
#include <hip/hip_runtime.h>
#include <hip/hip_cooperative_groups.h>
#include <cstdio>
#include <cstdint>
namespace cg = cooperative_groups;

constexpr int DM = 1024, NBATCH = 4, SEQ = 8192, CTXL = 256, SEGL = CTXL + SEQ, T = NBATCH * SEGL, DEPTH = 4;
constexpr int IN_W = 3088, PW = 3072;
constexpr int C_A = 0, C_MQ = 512, C_MK = 768, C_MV = 1024, C_MO = 1280, C_DQ = 1536, C_DK = 2048, C_DV = 2560;
constexpr int NCH = SEGL / 64;
constexpr int NEXP = 16384;
constexpr float EPS = 1e-6f;
#ifndef ABL
#define ABL 0
#endif
#ifndef GATHER_SYNC
#define GATHER_SYNC 0
#endif
#ifndef REP_ATT
#define REP_ATT 1
#endif
#ifndef REP_PEER
#define REP_PEER 1
#endif
#ifndef REP_GEMM
#define REP_GEMM 1
#endif
#ifndef REP_ROUTE
#define REP_ROUTE 1
#endif
#ifndef REP_OUTP
#define REP_OUTP 1
#endif
#ifndef REP_ML
#define REP_ML 1
#endif
#ifndef REP_MISC
#define REP_MISC 1
#endif
constexpr float QSCALE = 0.125f * 1.4426950408889634f;

constexpr size_t MiB = 1u << 20;
constexpr size_t WS_CTL = 0, WS_MOD = 1 * MiB, WS_ROPE = 2 * MiB, WS_WG = 4 * MiB, WS_KEYS = 5 * MiB, WS_MLMETA = 6 * MiB,
                 WS_GATES = 7 * MiB, WS_WIN = 10 * MiB, WS_WOUT = 34 * MiB, WS_WQ = 42 * MiB, WS_PU = 50 * MiB, WS_PV = 114 * MiB, WS_PSC = 178 * MiB  ,
                 WS_XCUR = 306 * MiB, WS_H = 438 * MiB, WS_MIX = 504 * MiB, WS_PROJ = 570 * MiB, WS_ULOC = 768 * MiB, WS_V8T = 836 * MiB  , WS_END = 858 * MiB;
constexpr int USTRIDE = 4160;

constexpr int LDS_BYTES = 139264;

#define LAS __attribute__((address_space(3)))
typedef unsigned short bf16_t;
typedef short bf16x8 __attribute__((ext_vector_type(8)));
typedef short s16x4 __attribute__((ext_vector_type(4)));
typedef float f32x4 __attribute__((ext_vector_type(4)));
typedef float f32x16 __attribute__((ext_vector_type(16)));
typedef unsigned u32x4 __attribute__((ext_vector_type(4)));
typedef unsigned u32x2 __attribute__((ext_vector_type(2)));
typedef __bf16 bf16x2v __attribute__((ext_vector_type(2)));
typedef int i32x8 __attribute__((ext_vector_type(8)));
typedef int i32x6 __attribute__((ext_vector_type(6)));
struct __attribute__((aligned(4))) u32x3 { unsigned x, y, z; };
typedef float f32x32 __attribute__((ext_vector_type(32)));
constexpr int PROW = 768;
typedef float f32x2 __attribute__((ext_vector_type(2)));

struct KArgs {
  const float* in[23];
  float* out;
  unsigned char* ws;
  int ph_lo, ph_hi;
};
typedef const float* const __attribute__((address_space(4))) * InTab;
struct Params {
  InTab in;
  float* out;
  unsigned char* ws;
  int ph_lo, ph_hi;
  int bx, gx;
  unsigned* xbar_words; unsigned xbar_x; unsigned lds_st_off;
};
enum { I_X = 0, I_C, I_CTX, I_CCTX, I_ADAW, I_ADAB, I_N1G, I_N2G, I_WIN, I_CONVW, I_CONVB, I_CLNG, I_CLNB, I_GATEB, I_MNORMG, I_DLAM, I_DNORMG,
       I_WOUT, I_PWQ, I_PKEYS, I_PU, I_PV, I_FINALG };

__device__ __forceinline__ unsigned cvtpk(float lo, float hi) { unsigned r; asm volatile("v_cvt_pk_bf16_f32 %0, %1, %2" : "=v"(r) : "v"(lo), "v"(hi)); return r; }
__device__ __forceinline__ float bflo(unsigned u) { return __uint_as_float(u << 16); }
__device__ __forceinline__ float bfhi(unsigned u) { return __uint_as_float(u & 0xffff0000u); }
__device__ __forceinline__ float bf1(bf16_t u) { return __uint_as_float(((unsigned)u) << 16); }
__device__ __forceinline__ int crow(int r, int hi) { return (r & 3) + 8 * (r >> 2) + 4 * hi; }
__device__ __forceinline__ float wave_sum(float v) {
#pragma unroll
  for (int o = 1; o < 64; o <<= 1) v += __shfl_xor(v, o);
  return v;
}
__device__ __forceinline__ float wave_max(float v) {
#pragma unroll
  for (int o = 1; o < 64; o <<= 1) v = fmaxf(v, __shfl_xor(v, o));
  return v;
}
__device__ __forceinline__ float sigmoidf_(float x) { return 1.f / (1.f + __expf(-x)); }
__device__ __forceinline__ float logsigmoidf_(float x) { return fminf(x, 0.f) - log1pf(__expf(-fabsf(x))); }
__device__ __forceinline__ const float* in_row(const float* x, const float* ctx, int row) {
  const int b = row / SEGL, s = row - b * SEGL;
  return s < CTXL ? ctx + ((size_t)(b * CTXL + s)) * DM : x + ((size_t)(b * SEQ + (s - CTXL))) * DM;
}
__device__ __forceinline__ int mod_row(int row) { const int b = row / SEGL, s = row - b * SEGL; return s < CTXL ? 4 : b; }

__device__ __forceinline__ void p0_mod(const Params& p, unsigned char* lds, float* MOD) {
  float* sil = (float*)lds;
  float* red = (float*)(lds + 20480);
  int tid_ = threadIdx.x; asm volatile("" : "+v"(tid_)); const int tid = tid_, lane = tid & 63, wid = tid >> 6;
  for (int i = tid; i < 5 * 1024; i += 512) {
    const float v = i < 4096 ? p.in[I_C][i] : p.in[I_CCTX][i - 4096];
    sil[i] = v / (1.f + __expf(-v));
  }
  __syncthreads();
  for (int item = p.bx; item < DEPTH * 96; item += p.gx) {
    const int l = item / 96, j0 = (item % 96) * 64;
    const float* W = p.in[I_ADAW] + (size_t)l * DM * 6144 + j0 + lane;
    float a0 = 0.f, a1 = 0.f, a2 = 0.f, a3 = 0.f, a4 = 0.f;
    const int k0 = wid * 128;
#pragma unroll 8
    for (int k = k0; k < k0 + 128; ++k) {
      const float w = W[(size_t)k * 6144];
      a0 += sil[k] * w; a1 += sil[1024 + k] * w; a2 += sil[2048 + k] * w; a3 += sil[3072 + k] * w; a4 += sil[4096 + k] * w;
    }
    red[(wid * 5 + 0) * 64 + lane] = a0; red[(wid * 5 + 1) * 64 + lane] = a1; red[(wid * 5 + 2) * 64 + lane] = a2;
    red[(wid * 5 + 3) * 64 + lane] = a3; red[(wid * 5 + 4) * 64 + lane] = a4;
    __syncthreads();
    if (tid < 320) {
      const int r = tid >> 6;
      float s = 0.f;
#pragma unroll
      for (int w = 0; w < 8; ++w) s += red[(w * 5 + r) * 64 + lane];
      MOD[((size_t)l * 5 + r) * 6144 + j0 + lane] = s + p.in[I_ADAB][l * 6144 + j0 + lane];
    }
    __syncthreads();
  }
}
__device__ __forceinline__ void transpose_item(const float* W, int ldw, int srccol0, bf16_t* WT, int K, int n0, int k0, float* scr, int lane) {
#pragma unroll 8
  for (int i = 0; i < 32; ++i) { const int kk = 2 * i + (lane >> 5); scr[kk * 33 + (lane & 31)] = W[(size_t)(k0 + kk) * ldw + srccol0 + (lane & 31)]; }
  asm volatile("s_waitcnt lgkmcnt(0)" ::: "memory");
  const int c = lane & 7;
#pragma unroll
  for (int j = 0; j < 4; ++j) {
    const int n = (lane >> 3) + 8 * j; const float* s = scr + (8 * c) * 33 + n;
    u32x4 o; o.x = cvtpk(s[0], s[33]); o.y = cvtpk(s[66], s[99]); o.z = cvtpk(s[132], s[165]); o.w = cvtpk(s[198], s[231]);
    *(u32x4*)(WT + (size_t)(n0 + n) * K + k0 + 8 * c) = o;
  }
  asm volatile("s_waitcnt lgkmcnt(0)" ::: "memory");
}
__device__ __forceinline__ void convert_tables(const Params& p, int L, int wv, int nw, int lane) {
  unsigned char* PUq = p.ws + WS_PU; unsigned char* PVq = p.ws + WS_PV; float* PSC = (float*)(p.ws + WS_PSC);
  const int nrows = DEPTH * NEXP;
  for (int r = wv; r < 2 * NEXP; r += nw) {
    const int tb = r >= NEXP, rr = L * NEXP + (tb ? r - NEXP : r);
    const f32x4* srow = (const f32x4*)((tb ? p.in[I_PV] : p.in[I_PU]) + (size_t)rr * DM) + lane * 4;
    f32x4 v[4]; float mx = 0.f;
#pragma unroll
    for (int j = 0; j < 4; ++j) { v[j] = __builtin_nontemporal_load(srow + j); mx = fmaxf(mx, fmaxf(fmaxf(fabsf(v[j].x), fabsf(v[j].y)), fmaxf(fabsf(v[j].z), fabsf(v[j].w)))); }
    mx = wave_max(mx);
    const unsigned mb = __float_as_uint(mx);
    const int eb = (int)((mb >> 23) & 0xFFu);
    int sb = ((mb & 0x7FFFFFu) <= 0x700000u ? 129 : 128) - eb + 127; sb = sb < 1 ? 1 : (sb > 253 ? 253 : sb);
    const float sc = __uint_as_float((unsigned)sb << 23), isc = __uint_as_float((unsigned)(254 - sb) << 23);
    const float xv[16] = {v[0].x, v[0].y, v[0].z, v[0].w, v[1].x, v[1].y, v[1].z, v[1].w, v[2].x, v[2].y, v[2].z, v[2].w, v[3].x, v[3].y, v[3].z, v[3].w};
    unsigned wq[3] = {0u, 0u, 0u};
#pragma unroll
    for (int i = 0; i < 16; ++i) {
      const float a = fabsf(xv[i]) * sc;
      unsigned code = a < 2.f ? (unsigned)__builtin_rintf(a * 8.f) : (a < 4.f ? 8u + (unsigned)__builtin_rintf(a * 4.f) : 16u + (unsigned)__builtin_rintf(a * 2.f));
      code = code > 31u ? 31u : code;
      code |= (xv[i] < 0.f) ? 32u : 0u;
      const int bp = 6 * i, dw = bp >> 5, off = bp & 31;
      wq[dw] |= code << off;
      if (off > 26) wq[dw + 1] |= code >> (32 - off);
    }
    u32x3 o; o.x = wq[0]; o.y = wq[1]; o.z = wq[2];
    *(u32x3*)((tb ? PVq : PUq) + (size_t)rr * PROW + lane * 12) = o;
    if (lane == 0) PSC[(size_t)tb * nrows + rr] = isc;
  }
}
__device__ __forceinline__ void tail_filler_tables(const Params& p, int L, int nwg) {
  int tid_ = threadIdx.x; asm volatile("" : "+v"(tid_)); const int lane = tid_ & 63, wid = tid_ >> 6;
  const int nextra = nwg % p.gx, first = nextra, nidle = p.gx - nextra;
  if (p.bx < first) return;
  convert_tables(p, L, (p.bx - first) * 8 + wid, nidle * 8, lane);
}
__device__ __forceinline__ void p0_convert(const Params& p, unsigned char* lds) {
  int tid_ = threadIdx.x; asm volatile("" : "+v"(tid_)); const int tid = tid_, lane = tid & 63, wid = tid >> 6;
  const int gw = p.bx * 8 + wid, NGW = p.gx * 8;
  const size_t gt = (size_t)p.bx * 512 + tid, NGT = (size_t)p.gx * 512;
  float* scr = (float*)(lds + 32768) + wid * (64 * 33);
  bf16_t* WIN = (bf16_t*)(p.ws + WS_WIN); bf16_t* WOUT = (bf16_t*)(p.ws + WS_WOUT); bf16_t* WQ = (bf16_t*)(p.ws + WS_WQ);
  constexpr int I_IN = 16 * 96, I_O = 16 * 32, PER_L = I_IN + 2 * I_O;
  for (int it = gw; it < DEPTH * PER_L; it += NGW) {
    const int l = it / PER_L; int r = it % PER_L;
    if (r < I_IN) { const int kb = r / 96, nb = r % 96, n0 = nb * 32; const int src = n0 < 1536 ? n0 : n0 + 16;
      transpose_item(p.in[I_WIN] + (size_t)l * DM * IN_W, IN_W, src, WIN + (size_t)l * PW * DM, DM, n0, kb * 64, scr, lane); continue; }
    r -= I_IN;
    if (r < I_O) { const int kb = r / 32, nb = r % 32;
      transpose_item(p.in[I_WOUT] + (size_t)l * DM * DM, DM, nb * 32, WOUT + (size_t)l * DM * DM, DM, nb * 32, kb * 64, scr, lane); continue; }
    r -= I_O;
    { const int kb = r / 32, nb = r % 32;
      transpose_item(p.in[I_PWQ] + (size_t)l * DM * DM, DM, nb * 32, WQ + (size_t)l * DM * DM, DM, nb * 32, kb * 64, scr, lane); }
  }
  bf16_t* WG = (bf16_t*)(p.ws + WS_WG);
  for (size_t i = gt; i < (size_t)DEPTH * 16 * DM; i += NGT) {
    const int l = (int)(i / (16 * DM)), g = (int)((i / DM) % 16), k = (int)(i % DM);
    WG[i] = (bf16_t)(cvtpk(p.in[I_WIN][(size_t)l * DM * IN_W + (size_t)k * IN_W + 1536 + g], 0.f) & 0xffffu);
  }
  bf16_t* KEYS = (bf16_t*)(p.ws + WS_KEYS);
  for (size_t i = gt; i < (size_t)DEPTH * 131072 / 8; i += NGT) {
    const f32x4 a = ((const f32x4*)p.in[I_PKEYS])[2 * i], b = ((const f32x4*)p.in[I_PKEYS])[2 * i + 1];
    u32x4 o; o.x = cvtpk(a.x, a.y); o.y = cvtpk(a.z, a.w); o.z = cvtpk(b.x, b.y); o.w = cvtpk(b.z, b.w);
    ((u32x4*)KEYS)[i] = o;
  }
  {
    float* RC = (float*)(p.ws + WS_ROPE); float* RS = RC + SEQ * 32;
    for (size_t i = gt; i < (size_t)SEQ * 32; i += NGT) {
      const int pos = (int)(i >> 5), j = (int)(i & 31);
      const int rr = pos >> 6, cc = pos & 63;
      const int jj = j & 15;
      const double e = -(double)jj * 0.83048202372184058696;
      const double fl = __builtin_floor(e); const double f = e - fl;
      const double z = f * 0.69314718055994530942;
      double ez = 1.0 + z * (1.0 + z * (0.5 + z * (1.0 / 6 + z * (1.0 / 24 + z * (1.0 / 120 + z * (1.0 / 720 + z * (1.0 / 5040 + z * (1.0 / 40320 + z * (1.0 / 362880 + z * (1.0 / 3628800 + z * (1.0 / 39916800 + z * (1.0 / 479001600))))))))))));
      const double inv = __builtin_ldexp(ez, (int)fl);
      const float invf = (float)inv;
      const float angf = (float)(j < 16 ? rr : cc) * invf;
      const double ang = (double)angf;
      const double kq = __builtin_rint(ang * 0.63661977236758134308);
      double r = __builtin_fma(-kq, 1.57079632679489655800e+00, ang);
      r = __builtin_fma(-kq, 6.12323399573676603587e-17, r);
      const double r2 = r * r;
      const double sn = r * (1.0 + r2 * (-1.0 / 6 + r2 * (1.0 / 120 + r2 * (-1.0 / 5040 + r2 * (1.0 / 362880 + r2 * (-1.0 / 39916800 + r2 * (1.0 / 6227020800.0)))))));
      const double cs = 1.0 + r2 * (-0.5 + r2 * (1.0 / 24 + r2 * (-1.0 / 720 + r2 * (1.0 / 40320 + r2 * (-1.0 / 3628800 + r2 * (1.0 / 479001600 + r2 * (-1.0 / 87178291200.0)))))));
      const int q = ((int)kq) & 3;
      double co, si;
      if (q == 0) { co = cs; si = sn; } else if (q == 1) { co = -sn; si = cs; } else if (q == 2) { co = -cs; si = -sn; } else { co = sn; si = -cs; }
      RC[i] = (float)co; RS[i] = (float)si;
    }
  }
}

__device__ __forceinline__ void norm_mod_row(const float* xrow, const float* g, const float* sc, const float* sh, bf16_t* orow, int lane) {
  const f32x4* xr = (const f32x4*)xrow + lane;
  f32x4 v[4]; float s = 0.f;
#pragma unroll
  for (int j = 0; j < 4; ++j) { v[j] = xr[64 * j]; s += (v[j].x * v[j].x + v[j].y * v[j].y) + (v[j].z * v[j].z + v[j].w * v[j].w); }
  const float rs = rsqrtf(wave_sum(s) * (1.f / DM) + EPS);
  u32x2* o = (u32x2*)orow + lane;
#pragma unroll
  for (int j = 0; j < 4; ++j) {
    const f32x4 gg = ((const f32x4*)g)[lane + 64 * j], cc = ((const f32x4*)sc)[lane + 64 * j], hh = ((const f32x4*)sh)[lane + 64 * j];
    const float y0 = v[j].x * rs * gg.x * (1.f + cc.x) + hh.x, y1 = v[j].y * rs * gg.y * (1.f + cc.y) + hh.y;
    const float y2 = v[j].z * rs * gg.z * (1.f + cc.z) + hh.z, y3 = v[j].w * rs * gg.w * (1.f + cc.w) + hh.w;
    u32x2 w; w.x = cvtpk(y0, y1); w.y = cvtpk(y2, y3);
    o[64 * j] = w;
  }
}
__device__ __forceinline__ void phase_norm(const Params& p, int l, int which, bool from_input, bool skip_ctx) {
  int tid_ = threadIdx.x; asm volatile("" : "+v"(tid_));
  const int lane = tid_ & 63, wid = tid_ >> 6;
  const int gw = p.bx * 8 + wid, NGW = p.gx * 8;
  const float* MOD = (const float*)(p.ws + WS_MOD);
  const float* XC = (const float*)(p.ws + WS_XCUR);
  bf16_t* H = (bf16_t*)(p.ws + WS_H);
  const float* g = p.in[which ? I_N2G : I_N1G] + l * DM;
  for (int row = gw; row < T; row += NGW) {
    const int mr = mod_row(row);
    if (skip_ctx && mr == 4) continue;
    const float* m = MOD + ((size_t)l * 5 + mr) * 6144 + which * 3072;
    const float* xr = from_input ? in_row(p.in[I_X], p.in[I_CTX], row) : XC + (size_t)row * DM;
    norm_mod_row(xr, g, m + 1024, m, H + (size_t)row * DM, lane);
  }
}

namespace pg8 {
#define PG8_LAS __attribute__((address_space(3)))
typedef unsigned short bf16_t;
typedef short bf16x8 __attribute__((ext_vector_type(8)));
typedef float f32x4 __attribute__((ext_vector_type(4)));
typedef unsigned u32x4 __attribute__((ext_vector_type(4)));
constexpr int BM = 256, BK = 64, HALF = 128, HTB = HALF * BK * 2  , STAGE_BYTES = 8 * HTB, NXCD = 8, WGM = 8;

__host__ __device__ __forceinline__ int lds_byte(int r, int c) { const int st = (r >> 4) * 2 + (c >> 5), rr = r & 15, cc = c & 31, ob = rr * 64 + cc * 2; return st * 1024 + (ob ^ (((ob >> 9) & 1) << 5)); }
__host__ __device__ __forceinline__ void stage_rc(int b, int& R, int& C) { const int st = b / 1024, sb = b % 1024, swz = sb ^ (((sb >> 9) & 1) << 5); R = (st >> 1) * 16 + swz / 64; C = (st & 1) * 32 + (swz % 64) / 2; }
__host__ __device__ __forceinline__ int perm32(int rho) { const int n = rho >> 4, i = rho & 15; return 8 * (i >> 2) + 4 * n + (i & 3); }

struct Unit { int pm, pn; };
struct Gemm { const bf16_t* A; const bf16_t* Bt; int M, N, K; };

struct StaticOrder {
    int nM, nN, nwg, G, c;
    __host__ __device__ void init(int M, int N, int G_, int c_) { nM = M / BM; nN = N / BM; nwg = nM * nN; G = G_; c = c_; }
    __host__ __device__ bool next(int i, Unit& u) const {
        const long L = (long)i * G + c; if (L >= nwg) return false;
        int wgid = (int)L; { const int q = nwg / NXCD, r = nwg % NXCD, xcd = wgid % NXCD, off = wgid / NXCD; wgid = (xcd < r ? xcd * (q + 1) : r * (q + 1) + (xcd - r) * q) + off; }
        const int nig = WGM * nN, gid = wgid / nig, fm = gid * WGM, gsz = (nM - fm) < WGM ? (nM - fm) : WGM;
        u.pm = fm + ((wgid % nig) % gsz); u.pn = (wgid % nig) / gsz; return true;
    }
    __device__ __forceinline__ void a_ready(const Unit&) const {}
    __device__ __forceinline__ void done(const Unit&) const {}
};
__device__ __forceinline__ unsigned cvt_pk_bf16(float lo, float hi) { unsigned r; asm volatile("v_cvt_pk_bf16_f32 %0, %1, %2" : "=v"(r) : "v"(lo), "v"(hi)); return r; }
template <class Epi, class Sched, bool ALIGN_EPI = false, bool SP2 = false>
__device__ __forceinline__ void gemm_phase(PG8_LAS unsigned char* lds, const Gemm g, const Sched& S, const Epi& E) {
    const int tid = threadIdx.x, wid = __builtin_amdgcn_readfirstlane(tid >> 6), lane = tid & 63, wr = wid >> 2, wc = wid & 3, fr = lane & 15, fq = lane >> 4;
    const int K = g.K, nt = K / BK;
    unsigned voffA[2], voffB[2];
#pragma unroll
    for (int i = 0; i < 2; ++i) { int R, C; stage_rc(tid * 16 + i * 8192, R, C); const int Rb = Epi::PERM ? ((R & ~31) + perm32(R & 31)) : R;
        voffA[i] = (unsigned)(R * K + C) * 2u; voffB[i] = (unsigned)(Rb * K + C) * 2u; }
    const size_t kstep = (size_t)(BK * 2);
    const size_t hstep = (size_t)HALF * K * 2;
    const size_t tstep = 2 * hstep;
    const unsigned ldsw = (unsigned)wid * 1024u;
    const int aoff = lds_byte(wr * 64 + fr, fq * 8), boff = lds_byte(wc * 32 + fr, fq * 8);
#define PG8_SA(b, h) (((b) * 2 + (h)) * HTB)
#define PG8_SB(b, h) ((4 + (b) * 2 + (h)) * HTB)
#define PG8_STAGE(bufoff, gbase, voff) do { _Pragma("unroll") for (int _i = 0; _i < 2; ++_i) \
        __builtin_amdgcn_global_load_lds((const unsigned*)((const char*)(gbase) + (voff)[_i]), (PG8_LAS unsigned*)(lds + (bufoff) + ldsw + _i * 8192), 16, 0, 0); } while (0)
#define PG8_LDA(dst, b, h) do { _Pragma("unroll") for (int m = 0; m < 4; ++m) _Pragma("unroll") for (int k = 0; k < 2; ++k) dst[m][k] = *(const PG8_LAS bf16x8*)(lds + PG8_SA(b, h) + aoff + m * 2048 + k * 1024); } while (0)
#define PG8_LDB(dst, b, h) do { _Pragma("unroll") for (int n = 0; n < 2; ++n) _Pragma("unroll") for (int k = 0; k < 2; ++k) dst[n][k] = *(const PG8_LAS bf16x8*)(lds + PG8_SB(b, h) + boff + n * 2048 + k * 1024); } while (0)
#define PG8_MMA(ai, bj, At, Bt) do { __builtin_amdgcn_s_setprio(1); _Pragma("unroll") for (int m = 0; m < 4; ++m) _Pragma("unroll") for (int n = 0; n < 2; ++n) _Pragma("unroll") for (int k = 0; k < 2; ++k) \
        acc[ai][bj][m][n] = __builtin_amdgcn_mfma_f32_16x16x32_bf16(Bt[n][k], At[m][k], acc[ai][bj][m][n], 0, 0, 0); __builtin_amdgcn_s_setprio(0); } while (0)
#define PG8_WAIT_V(n) asm volatile("s_waitcnt vmcnt(" #n ")" ::: "memory")
#define PG8_WAIT_L(n) asm volatile("s_waitcnt lgkmcnt(" #n ")" ::: "memory")
#define PG8_BAR __builtin_amdgcn_s_barrier()
#define PG8_SCHED __builtin_amdgcn_sched_barrier(0)
    Unit cur, nxt; int ui = 0;
    if (!S.next(0, cur)) return;
    f32x4 acc[2][2][4][2];
#pragma unroll
    for (int a = 0; a < 2; ++a)
#pragma unroll
        for (int b = 0; b < 2; ++b)
#pragma unroll
            for (int m = 0; m < 4; ++m)
#pragma unroll
                for (int n = 0; n < 2; ++n) acc[a][b][m][n] = (f32x4){0.f, 0.f, 0.f, 0.f};
    bf16x8 At[4][2], B0[2][2], B1[2][2];
    const char* cA = (const char*)g.A + (size_t)cur.pm * tstep; const char* cB = (const char*)g.Bt + (size_t)cur.pn * tstep;
    S.a_ready(cur);
    if constexpr (SP2) {
        PG8_STAGE(PG8_SB(0, 0), cB, voffB); PG8_STAGE(PG8_SB(0, 1), cB + hstep, voffB); PG8_STAGE(PG8_SA(0, 0), cA, voffA); PG8_STAGE(PG8_SA(0, 1), cA + hstep, voffA);
        if (wr == 1) PG8_BAR;
        PG8_WAIT_V(2); PG8_BAR;
        PG8_STAGE(PG8_SB(1, 0), cB + kstep, voffB); PG8_STAGE(PG8_SA(1, 0), cA + kstep, voffA); PG8_STAGE(PG8_SB(1, 1), cB + hstep + kstep, voffB);
        PG8_WAIT_V(6); PG8_BAR;
    } else {
        PG8_STAGE(PG8_SB(0, 0), cB, voffB); PG8_STAGE(PG8_SA(0, 0), cA, voffA); PG8_STAGE(PG8_SB(0, 1), cB + hstep, voffB); PG8_STAGE(PG8_SA(0, 1), cA + hstep, voffA);
        if (wr == 1) PG8_BAR;
        PG8_WAIT_V(4); PG8_BAR;
        PG8_STAGE(PG8_SB(1, 0), cB + kstep, voffB); PG8_STAGE(PG8_SA(1, 0), cA + kstep, voffA); PG8_STAGE(PG8_SB(1, 1), cB + hstep + kstep, voffB);
        PG8_WAIT_V(6); PG8_BAR;
    }
    for (;;) {
        const bool has_next = S.next(ui + 1, nxt);
        const char* nA = has_next ? (const char*)g.A + (size_t)nxt.pm * tstep : cA; const char* nB = has_next ? (const char*)g.Bt + (size_t)nxt.pn * tstep : cB;
        for (int t = 0; t < nt; t += 2) {
            const bool last = (t == nt - 2);
            const char* a1 = cA + (size_t)(t + 1) * kstep;
            const char* a2 = last ? nA : cA + (size_t)(t + 2) * kstep; const char* b2 = last ? nB : cB + (size_t)(t + 2) * kstep;
            const char* a3 = a2 + kstep; const char* b3 = b2 + kstep;
            if (last && has_next) S.a_ready(nxt);
            if constexpr (SP2) {
            PG8_LDB(B0, 0, 0); PG8_LDB(B1, 0, 1); PG8_SCHED; PG8_LDA(At, 0, 0); PG8_STAGE(PG8_SA(1, 1), a1 + hstep, voffA);
            PG8_WAIT_V(8); PG8_WAIT_L(0); PG8_BAR; PG8_MMA(0, 0, At, B0); PG8_MMA(0, 1, At, B1); PG8_BAR; PG8_SCHED;
            PG8_LDA(At, 0, 1); PG8_STAGE(PG8_SB(0, 0), b2, voffB); PG8_STAGE(PG8_SB(0, 1), b2 + hstep, voffB); PG8_STAGE(PG8_SA(0, 0), a2, voffA);
            PG8_WAIT_V(8); PG8_WAIT_L(0); PG8_BAR; PG8_MMA(1, 0, At, B0); PG8_MMA(1, 1, At, B1); PG8_BAR; PG8_SCHED;
            PG8_LDB(B0, 1, 0); PG8_LDB(B1, 1, 1); PG8_SCHED; PG8_LDA(At, 1, 0); PG8_STAGE(PG8_SA(0, 1), a2 + hstep, voffA);
            PG8_WAIT_V(8); PG8_WAIT_L(0); PG8_BAR; PG8_MMA(0, 0, At, B0); PG8_MMA(0, 1, At, B1); PG8_BAR; PG8_SCHED;
            PG8_LDA(At, 1, 1); PG8_STAGE(PG8_SB(1, 0), b3, voffB); PG8_STAGE(PG8_SB(1, 1), b3 + hstep, voffB); PG8_STAGE(PG8_SA(1, 0), a3, voffA);
            PG8_WAIT_V(8); PG8_WAIT_L(0); PG8_BAR; PG8_MMA(1, 0, At, B0); PG8_MMA(1, 1, At, B1); PG8_BAR; PG8_SCHED;
            } else {
            PG8_LDB(B0, 0, 0); PG8_SCHED; PG8_LDA(At, 0, 0); PG8_STAGE(PG8_SA(1, 1), a1 + hstep, voffA);
            PG8_WAIT_L(8); PG8_BAR; PG8_WAIT_L(0); PG8_MMA(0, 0, At, B0); PG8_BAR; PG8_SCHED;
            PG8_LDB(B1, 0, 1); PG8_STAGE(PG8_SB(0, 0), b2, voffB);
            PG8_BAR; PG8_WAIT_L(0); PG8_MMA(0, 1, At, B1); PG8_BAR;
            PG8_LDA(At, 0, 1); PG8_STAGE(PG8_SA(0, 0), a2, voffA);
            PG8_BAR; PG8_WAIT_L(0); PG8_MMA(1, 0, At, B0); PG8_BAR; PG8_SCHED;
            PG8_STAGE(PG8_SB(0, 1), b2 + hstep, voffB);
            PG8_WAIT_V(6); PG8_BAR; PG8_MMA(1, 1, At, B1); PG8_BAR;
            PG8_LDB(B0, 1, 0); PG8_SCHED; PG8_LDA(At, 1, 0); PG8_STAGE(PG8_SA(0, 1), a2 + hstep, voffA);
            PG8_WAIT_L(8); PG8_BAR; PG8_WAIT_L(0); PG8_MMA(0, 0, At, B0); PG8_BAR; PG8_SCHED;
            PG8_LDB(B1, 1, 1); PG8_STAGE(PG8_SB(1, 0), b3, voffB);
            PG8_BAR; PG8_WAIT_L(0); PG8_MMA(0, 1, At, B1); PG8_BAR;
            PG8_LDA(At, 1, 1); PG8_STAGE(PG8_SA(1, 0), a3, voffA);
            PG8_BAR; PG8_WAIT_L(0); PG8_MMA(1, 0, At, B0); PG8_BAR; PG8_SCHED;
            PG8_STAGE(PG8_SB(1, 1), b3 + hstep, voffB);
            PG8_WAIT_V(6); PG8_BAR; PG8_MMA(1, 1, At, B1); PG8_BAR;
            }
        }
        if constexpr (ALIGN_EPI) { if (wr == 0) PG8_BAR; }
        if constexpr (!Epi::AFTER_DRAIN) { E(acc, cur, wr, wc, fr, fq); S.done(cur); }
        if (!has_next) break;
#pragma unroll
        for (int a = 0; a < 2; ++a)
#pragma unroll
            for (int b = 0; b < 2; ++b)
#pragma unroll
                for (int m = 0; m < 4; ++m)
#pragma unroll
                    for (int n = 0; n < 2; ++n) acc[a][b][m][n] = (f32x4){0.f, 0.f, 0.f, 0.f};
        cur = nxt; cA = nA; cB = nB; ++ui;
        if constexpr (ALIGN_EPI) { if (wr == 1) PG8_BAR; }
    }
    PG8_WAIT_V(0);
    if constexpr (!ALIGN_EPI) { if (wr == 0) PG8_BAR; }
    PG8_BAR;
    if constexpr (Epi::AFTER_DRAIN) { E.fused(acc, cur, wr, wc, fr, fq, lds, wid, lane); S.done(cur); }
#undef PG8_SA
#undef PG8_SB
#undef PG8_STAGE
#undef PG8_LDA
#undef PG8_LDB
#undef PG8_MMA
#undef PG8_WAIT_V
#undef PG8_WAIT_L
#undef PG8_BAR
#undef PG8_SCHED
}
}

__device__ __forceinline__ int gswz(int row, int chunk) { return row * 128 + ((chunk ^ ((row >> 1) & 7)) << 4); }
__device__ __forceinline__ void gemm_tile(const bf16_t* __restrict__ A, int lda, const bf16_t* __restrict__ Bt, int ldb, int K,
                                          int row0, int col0, unsigned char* lds, f32x16 (&acc)[2][2]) {
  int tid_ = threadIdx.x; asm volatile("" : "+v"(tid_)); const int tid = tid_, lane = tid & 63, wid = tid >> 6, wm = wid >> 1, wn = wid & 1, r32 = lane & 31, hi = lane >> 5;
  unsigned char* As = lds; unsigned char* Bs = lds + 65536;
#pragma unroll
  for (int i = 0; i < 2; ++i)
#pragma unroll
    for (int j = 0; j < 2; ++j) acc[i][j] = f32x16{};
  const int lrow = tid >> 3, lc = tid & 7;
  const bf16_t* Ag = A + (size_t)(row0 + lrow) * lda + lc * 8;
  const bf16_t* Bg = Bt + (size_t)(col0 + lrow) * ldb + lc * 8;
  u32x4 ra[4], rb[2];
#pragma unroll
  for (int i = 0; i < 4; ++i) ra[i] = *(const u32x4*)(Ag + (size_t)(64 * i) * lda);
#pragma unroll
  for (int i = 0; i < 2; ++i) rb[i] = *(const u32x4*)(Bg + (size_t)(64 * i) * ldb);
#pragma unroll
  for (int i = 0; i < 4; ++i) *(u32x4*)(As + gswz(lrow + 64 * i, lc)) = ra[i];
#pragma unroll
  for (int i = 0; i < 2; ++i) *(u32x4*)(Bs + gswz(lrow + 64 * i, lc)) = rb[i];
  __syncthreads();
  const int nk = K / 64;
  for (int kt = 0; kt < nk; ++kt) {
    const int cur = kt & 1;
    if (kt + 1 < nk) {
#pragma unroll
      for (int i = 0; i < 4; ++i) ra[i] = *(const u32x4*)(Ag + (size_t)(64 * i) * lda + (kt + 1) * 64);
#pragma unroll
      for (int i = 0; i < 2; ++i) rb[i] = *(const u32x4*)(Bg + (size_t)(64 * i) * ldb + (kt + 1) * 64);
    }
    const unsigned char* Ac = As + cur * 32768; const unsigned char* Bc = Bs + cur * 16384;
#pragma unroll
    for (int kk = 0; kk < 4; ++kk) {
      bf16x8 af[2], bfr[2];
#pragma unroll
      for (int i = 0; i < 2; ++i) af[i] = *(const bf16x8*)(Ac + gswz(wm * 64 + i * 32 + r32, 2 * kk + hi));
#pragma unroll
      for (int j = 0; j < 2; ++j) bfr[j] = *(const bf16x8*)(Bc + gswz(wn * 64 + j * 32 + r32, 2 * kk + hi));
#pragma unroll
      for (int i = 0; i < 2; ++i)
#pragma unroll
        for (int j = 0; j < 2; ++j) acc[i][j] = __builtin_amdgcn_mfma_f32_32x32x16_bf16(af[i], bfr[j], acc[i][j], 0, 0, 0);
    }
    if (kt + 1 < nk) {
      unsigned char* An = As + (cur ^ 1) * 32768; unsigned char* Bn = Bs + (cur ^ 1) * 16384;
#pragma unroll
      for (int i = 0; i < 4; ++i) *(u32x4*)(An + gswz(lrow + 64 * i, lc)) = ra[i];
#pragma unroll
      for (int i = 0; i < 2; ++i) *(u32x4*)(Bn + gswz(lrow + 64 * i, lc)) = rb[i];
    }
    __syncthreads();
  }
}
__device__ __forceinline__ void pair_xchg(float v0, float v1, int lane, float& lo, float& hi2) {
  const bool odd = lane & 1;
  const float send = odd ? v0 : v1;
  const float recv = __shfl_xor(send, 1);
  lo = odd ? recv : v0; hi2 = odd ? v1 : recv;
}

__device__ __forceinline__ void phase_inproj(const Params& p, int l, unsigned char* lds) {
  int tid_ = threadIdx.x; asm volatile("" : "+v"(tid_)); const int tid = tid_, lane = tid & 63, wid = tid >> 6, wm = wid >> 1, wn = wid & 1, r32 = lane & 31, hi = lane >> 5;
  const bf16_t* H = (const bf16_t*)(p.ws + WS_H);
  const bf16_t* W = (const bf16_t*)(p.ws + WS_WIN) + (size_t)l * PW * DM;
  bf16_t* PROJ = (bf16_t*)(p.ws + WS_PROJ);
  const float* RC = (const float*)(p.ws + WS_ROPE); const float* RS = RC + SEQ * 32;
  constexpr int NM = T / 256, NN = PW / 128, NU = NM * NN;
  for (int u = p.bx; u < NU + NM; u += p.gx) {
    if (u < NU) {
      const int pn = u / NM, pm = u % NM;
      const int row0 = pm * 256, col0 = pn * 128;
      f32x16 acc[2][2];
      gemm_tile(H, DM, W, DM, DM, row0, col0, lds, acc);
      const bool rope = (col0 >= C_DQ && col0 < C_DV);
      const float scl = (col0 >= C_MK && col0 < C_MV) ? 0.125f : ((col0 >= C_DQ && col0 < C_DK) ? QSCALE : 1.f);
#pragma unroll
      for (int i = 0; i < 2; ++i)
#pragma unroll
        for (int j = 0; j < 2; ++j)
#pragma unroll
          for (int q = 0; q < 8; ++q) {
            float lo, hi2; pair_xchg(acc[i][j][2 * q], acc[i][j][2 * q + 1], lane, lo, hi2);
            const int row = row0 + wm * 64 + i * 32 + crow(2 * q, hi) + (lane & 1);
            const int col = col0 + wn * 64 + j * 32 + (r32 & ~1);
            if (rope) {
              const int s = row % SEGL;
              if (s >= CTXL) {
                const int idx = (s - CTXL) * 32 + ((col & 63) >> 1);
                const float c = RC[idx], sn = RS[idx];
                const float t1 = lo, t2 = hi2; lo = t1 * c - t2 * sn; hi2 = t1 * sn + t2 * c;
              }
            }
            *(unsigned*)(PROJ + (size_t)row * PW + col) = cvtpk(lo * scl, hi2 * scl);
          }
    } else {
      const int pm = u - NU, rowb = pm * 256 + wid * 32;
      const bf16_t* WG = (const bf16_t*)(p.ws + WS_WG) + (size_t)l * 16 * DM;
      float* GT = (float*)(p.ws + WS_GATES);
      const int r16 = lane & 15, q4 = lane >> 4;
      f32x4 c0 = {0.f, 0.f, 0.f, 0.f}, c1 = {0.f, 0.f, 0.f, 0.f};
      const bf16_t* a0p = H + (size_t)(rowb + r16) * DM + q4 * 8;
      const bf16_t* a1p = a0p + (size_t)16 * DM;
      const bf16_t* bp = WG + (size_t)r16 * DM + q4 * 8;
#pragma unroll 4
      for (int ks = 0; ks < 32; ++ks) {
        const bf16x8 a0 = *(const bf16x8*)(a0p + ks * 32), a1 = *(const bf16x8*)(a1p + ks * 32), b = *(const bf16x8*)(bp + ks * 32);
        c0 = __builtin_amdgcn_mfma_f32_16x16x32_bf16(a0, b, c0, 0, 0, 0);
        c1 = __builtin_amdgcn_mfma_f32_16x16x32_bf16(a1, b, c1, 0, 0, 0);
      }
      const float gb = p.in[I_GATEB][l * 16 + r16];
#pragma unroll
      for (int j = 0; j < 4; ++j) {
        GT[(size_t)(rowb + q4 * 4 + j) * 16 + r16] = c0[j] + gb;
        GT[(size_t)(rowb + 16 + q4 * 4 + j) * 16 + r16] = c1[j] + gb;
      }
    }
  }
}

__device__ __forceinline__ void phase_outproj(const Params& p, int l, unsigned char* lds) {
  int tid_ = threadIdx.x; asm volatile("" : "+v"(tid_)); const int tid = tid_, lane = tid & 63, wid = tid >> 6, wm = wid >> 1, wn = wid & 1, r32 = lane & 31, hi = lane >> 5;
  const bf16_t* MIX = (const bf16_t*)(p.ws + WS_MIX);
  const bf16_t* W = (const bf16_t*)(p.ws + WS_WOUT) + (size_t)l * DM * DM;
  float* XC = (float*)(p.ws + WS_XCUR);
  const float* MOD = (const float*)(p.ws + WS_MOD);
  constexpr int NM = T / 256, NN = DM / 128, NU = NM * NN;
  for (int u = p.bx; u < NU; u += p.gx) {
    const int pm = u / NN, pn = u % NN;
    if (l == DEPTH - 1 && (pm % 33) == 0) continue;
    const int row0 = pm * 256, col0 = pn * 128;
    for (int rep = 0; rep < REP_OUTP; ++rep) {
    f32x16 acc[2][2];
    gemm_tile(MIX, DM, W, DM, DM, row0, col0, lds, acc);
    const int mr = (pm % 33) == 0 ? 4 : pm / 33;
    const float* g1 = MOD + ((size_t)l * 5 + mr) * 6144 + 2048;
#pragma unroll
    for (int i = 0; i < 2; ++i)
#pragma unroll
      for (int j = 0; j < 2; ++j) {
        const int col = col0 + wn * 64 + j * 32 + r32;
        const float gg = (rep == REP_OUTP - 1) ? g1[col] : 0.f;
#pragma unroll
        for (int r = 0; r < 16; ++r) {
          const int row = row0 + wm * 64 + i * 32 + crow(r, hi);
          const float xo = (l == 0) ? in_row(p.in[I_X], p.in[I_CTX], row)[col] : XC[(size_t)row * DM + col];
          XC[(size_t)row * DM + col] = xo + gg * acc[i][j][r];
        }
      }
    }
  }
}
__device__ __forceinline__ void phase_peerq(const Params& p, int l, unsigned char* lds) {
  int tid_ = threadIdx.x; asm volatile("" : "+v"(tid_)); const int tid = tid_, lane = tid & 63, wid = tid >> 6, wm = wid >> 1, wn = wid & 1, r32 = lane & 31, hi = lane >> 5;
  const bf16_t* H = (const bf16_t*)(p.ws + WS_H);
  const bf16_t* W = (const bf16_t*)(p.ws + WS_WQ) + (size_t)l * DM * DM;
  bf16_t* QP = (bf16_t*)(p.ws + WS_PROJ);
  constexpr int NM = T / 256, NN = DM / 128, NU = NM * NN;
  for (int u = p.bx; u < NU; u += p.gx) {
    const int pm = u / NN, pn = u % NN;
    if (l == DEPTH - 1 && (pm % 33) == 0) continue;
    const int row0 = pm * 256, col0 = pn * 128;
    f32x16 acc[2][2];
    gemm_tile(H, DM, W, DM, DM, row0, col0, lds, acc);
#pragma unroll
    for (int i = 0; i < 2; ++i)
#pragma unroll
      for (int j = 0; j < 2; ++j)
#pragma unroll
        for (int q = 0; q < 8; ++q) {
          float lo, hi2; pair_xchg(acc[i][j][2 * q], acc[i][j][2 * q + 1], lane, lo, hi2);
          const int row = row0 + wm * 64 + i * 32 + crow(2 * q, hi) + (lane & 1);
          const int col = col0 + wn * 64 + j * 32 + (r32 & ~1);
          *(unsigned*)(QP + (size_t)row * DM + col) = cvtpk(lo, hi2);
        }
  }
}


struct EpiInproj {
  static constexpr bool PERM = true, AFTER_DRAIN = false;
  bf16_t* PROJ; const float* RC; const float* RS; unsigned char* V8T;
  __device__ __forceinline__ void operator()(const pg8::f32x4 (&acc)[2][2][4][2], const pg8::Unit& u, int wr, int wc, int fr, int fq) const {
#pragma unroll
    for (int bj = 0; bj < 2; ++bj) {
      const int colt = u.pn * 256 + bj * 128;
      const bool rope = (colt >= C_DQ && colt < C_DV);
      const float scl = (colt >= C_MK && colt < C_MV) ? 0.125f : ((colt >= C_DQ && colt < C_DK) ? QSCALE : 1.f);
      const int col8 = colt + wc * 32 + 8 * fq;
      if (colt >= C_DV) {
        const int hh = (col8 - C_DV) >> 7, e0 = (col8 - C_DV) & 127;
#pragma unroll
        for (int ai = 0; ai < 2; ++ai)
#pragma unroll
          for (int m = 0; m < 4; ++m) {
            const int row = u.pm * 256 + ai * 128 + wr * 64 + m * 16 + fr;
            const int b = row / SEGL, s = row - b * SEGL, t = s >> 6, kk = s & 63;
            const int slot = ((kk >> 2) & 1) * 32 + (kk & 3) + 4 * ((kk >> 3) & 3) + 16 * (kk >> 5);
            unsigned char* vp = V8T + ((size_t)((b * 4 + hh) * NCH + t) * 128 + e0) * 80 + slot;
            const f32x4 v0 = acc[ai][bj][m][0], v1 = acc[ai][bj][m][1];
            int w0 = 0, w1 = 0;
            w0 = __builtin_amdgcn_cvt_pk_fp8_f32(v0[0], v0[1], w0, false); w0 = __builtin_amdgcn_cvt_pk_fp8_f32(v0[2], v0[3], w0, true);
            w1 = __builtin_amdgcn_cvt_pk_fp8_f32(v1[0], v1[1], w1, false); w1 = __builtin_amdgcn_cvt_pk_fp8_f32(v1[2], v1[3], w1, true);
            vp[0] = (unsigned char)(w0 & 0xFF); vp[80] = (unsigned char)((w0 >> 8) & 0xFF); vp[160] = (unsigned char)((w0 >> 16) & 0xFF); vp[240] = (unsigned char)((w0 >> 24) & 0xFF);
            vp[320] = (unsigned char)(w1 & 0xFF); vp[400] = (unsigned char)((w1 >> 8) & 0xFF); vp[480] = (unsigned char)((w1 >> 16) & 0xFF); vp[560] = (unsigned char)((w1 >> 24) & 0xFF);
          }
        continue;
      }
#pragma unroll
      for (int ai = 0; ai < 2; ++ai)
#pragma unroll
        for (int m = 0; m < 4; ++m) {
          const int row = u.pm * 256 + ai * 128 + wr * 64 + m * 16 + fr;
          f32x4 v0 = acc[ai][bj][m][0], v1 = acc[ai][bj][m][1];
          if (rope) {
            const int s = row % SEGL;
            if (s >= CTXL) {
              const int idx = (s - CTXL) * 32 + ((col8 & 63) >> 1);
              const f32x4 c = *(const f32x4*)(RC + idx), sn = *(const f32x4*)(RS + idx);
              f32x4 a, b;
              a[0] = v0[0] * c[0] - v0[1] * sn[0]; a[1] = v0[0] * sn[0] + v0[1] * c[0]; a[2] = v0[2] * c[1] - v0[3] * sn[1]; a[3] = v0[2] * sn[1] + v0[3] * c[1];
              b[0] = v1[0] * c[2] - v1[1] * sn[2]; b[1] = v1[0] * sn[2] + v1[1] * c[2]; b[2] = v1[2] * c[3] - v1[3] * sn[3]; b[3] = v1[2] * sn[3] + v1[3] * c[3];
              v0 = a; v1 = b;
            }
          }
          u32x4 w; w.x = cvtpk(v0[0] * scl, v0[1] * scl); w.y = cvtpk(v0[2] * scl, v0[3] * scl); w.z = cvtpk(v1[0] * scl, v1[1] * scl); w.w = cvtpk(v1[2] * scl, v1[3] * scl);
          *(u32x4*)(PROJ + (size_t)row * PW + col8) = w;
        }
    }
  }
};
struct EpiOutproj {
  static constexpr bool PERM = true, AFTER_DRAIN = false;
  float* XC; const float* MODL; const float* xin; const float* ctxin; int first; float gsc;
  __device__ __forceinline__ void operator()(const pg8::f32x4 (&acc)[2][2][4][2], const pg8::Unit& u, int wr, int wc, int fr, int fq) const {
    const int mr = (u.pm % 33) == 0 ? 4 : u.pm / 33;
    const float* g1 = MODL + (size_t)mr * 6144 + 2048;
#pragma unroll
    for (int bj = 0; bj < 2; ++bj) {
      const int col8 = u.pn * 256 + bj * 128 + wc * 32 + 8 * fq;
      const f32x4 ga = *(const f32x4*)(g1 + col8) * gsc, gb = *(const f32x4*)(g1 + col8 + 4) * gsc;
#pragma unroll
      for (int ai = 0; ai < 2; ++ai)
#pragma unroll
        for (int m = 0; m < 4; ++m) {
          const int row = u.pm * 256 + ai * 128 + wr * 64 + m * 16 + fr;
          const float* xo = first ? in_row(xin, ctxin, row) + col8 : XC + (size_t)row * DM + col8;
          const f32x4 xa = *(const f32x4*)xo, xb = *(const f32x4*)(xo + 4);
          *(f32x4*)(XC + (size_t)row * DM + col8) = xa + ga * acc[ai][bj][m][0];
          *(f32x4*)(XC + (size_t)row * DM + col8 + 4) = xb + gb * acc[ai][bj][m][1];
        }
    }
  }
};
struct EpiPeerq {
  static constexpr bool PERM = true, AFTER_DRAIN = false;
  bf16_t* QP;
  __device__ __forceinline__ void operator()(const pg8::f32x4 (&acc)[2][2][4][2], const pg8::Unit& u, int wr, int wc, int fr, int fq) const {
#pragma unroll
    for (int bj = 0; bj < 2; ++bj) {
      const int col8 = u.pn * 256 + bj * 128 + wc * 32 + 8 * fq;
#pragma unroll
      for (int ai = 0; ai < 2; ++ai)
#pragma unroll
        for (int m = 0; m < 4; ++m) {
          const int row = u.pm * 256 + ai * 128 + wr * 64 + m * 16 + fr;
          const f32x4 v0 = acc[ai][bj][m][0], v1 = acc[ai][bj][m][1];
          u32x4 w; w.x = cvtpk(v0[0], v0[1]); w.y = cvtpk(v0[2], v0[3]); w.z = cvtpk(v1[0], v1[1]); w.w = cvtpk(v1[2], v1[3]);
          *(u32x4*)(QP + (size_t)row * DM + col8) = w;
        }
    }
  }
};
__device__ __forceinline__ void phase_inproj2(const Params& p, int l, unsigned char* lds) {
  {
    pg8::Gemm g{(const bf16_t*)(p.ws + WS_H), (const bf16_t*)(p.ws + WS_WIN) + (size_t)l * PW * DM, T, PW, DM};
    pg8::StaticOrder S; S.init(T, PW, p.gx, p.bx);
    EpiInproj E{(bf16_t*)(p.ws + WS_PROJ), (const float*)(p.ws + WS_ROPE), (const float*)(p.ws + WS_ROPE) + SEQ * 32, p.ws + WS_V8T};
    pg8::gemm_phase<EpiInproj, pg8::StaticOrder, true, true>((PG8_LAS unsigned char*)lds, g, S, E);
  }
  int tid_ = threadIdx.x; asm volatile("" : "+v"(tid_)); const int tid = tid_, lane = tid & 63, wid = tid >> 6;
  const bf16_t* H = (const bf16_t*)(p.ws + WS_H);
  for (int pm = p.bx; pm < T / 256; pm += p.gx) {
    const int rowb = pm * 256 + wid * 32;
    const bf16_t* WG = (const bf16_t*)(p.ws + WS_WG) + (size_t)l * 16 * DM;
    float* GT = (float*)(p.ws + WS_GATES);
    const int r16 = lane & 15, q4 = lane >> 4;
    f32x4 c0 = {0.f, 0.f, 0.f, 0.f}, c1 = {0.f, 0.f, 0.f, 0.f};
    const bf16_t* a0p = H + (size_t)(rowb + r16) * DM + q4 * 8;
    const bf16_t* a1p = a0p + (size_t)16 * DM;
    const bf16_t* bp = WG + (size_t)r16 * DM + q4 * 8;
#pragma unroll 4
    for (int ks = 0; ks < 32; ++ks) {
      const bf16x8 a0 = *(const bf16x8*)(a0p + ks * 32), a1 = *(const bf16x8*)(a1p + ks * 32), b = *(const bf16x8*)(bp + ks * 32);
      c0 = __builtin_amdgcn_mfma_f32_16x16x32_bf16(a0, b, c0, 0, 0, 0);
      c1 = __builtin_amdgcn_mfma_f32_16x16x32_bf16(a1, b, c1, 0, 0, 0);
    }
    const float gb = p.in[I_GATEB][l * 16 + r16];
#pragma unroll
    for (int j = 0; j < 4; ++j) {
      GT[(size_t)(rowb + q4 * 4 + j) * 16 + r16] = c0[j] + gb;
      GT[(size_t)(rowb + 16 + q4 * 4 + j) * 16 + r16] = c1[j] + gb;
    }
  }
}
__device__ __forceinline__ void phase_outproj2(const Params& p, int l, unsigned char* lds) {
  pg8::Gemm g{(const bf16_t*)(p.ws + WS_MIX), (const bf16_t*)(p.ws + WS_WOUT) + (size_t)l * DM * DM, T, DM, DM};
  pg8::StaticOrder S; S.init(T, DM, p.gx, p.bx);
  for (int rep = 0; rep < REP_OUTP; ++rep) {
  EpiOutproj E{(float*)(p.ws + WS_XCUR), (const float*)(p.ws + WS_MOD) + (size_t)l * 5 * 6144, p.in[I_X], p.in[I_CTX], l == 0, (rep == REP_OUTP - 1) ? 1.f : 0.f};
  pg8::gemm_phase<EpiOutproj, pg8::StaticOrder, true, true>((PG8_LAS unsigned char*)lds, g, S, E);
  }
  if (l < DEPTH - 1) tail_filler_tables(p, l, (T / 256) * (DM / 256));
}
__device__ __forceinline__ void phase_peerq2(const Params& p, int l, unsigned char* lds) {
  pg8::Gemm g{(const bf16_t*)(p.ws + WS_H), (const bf16_t*)(p.ws + WS_WQ) + (size_t)l * DM * DM, T, DM, DM};
  pg8::StaticOrder S; S.init(T, DM, p.gx, p.bx);
  EpiPeerq E{(bf16_t*)(p.ws + WS_PROJ)};
  pg8::gemm_phase<EpiPeerq, pg8::StaticOrder, true, true>((PG8_LAS unsigned char*)lds, g, S, E);
  if (l == DEPTH - 2) tail_filler_tables(p, DEPTH - 1, (T / 256) * (DM / 256));
}

__device__ __forceinline__ void conv_unit(const Params& p, int l, int unit, unsigned char* lds) {
  int tid_ = threadIdx.x; asm volatile("" : "+v"(tid_)); const int tid = tid_, lane = tid & 63, wid = tid >> 6;
  float* U = (float*)lds;
  const bf16_t* PROJ = (const bf16_t*)(p.ws + WS_PROJ);
  bf16_t* MIX = (bf16_t*)(p.ws + WS_MIX);
  const int row0 = unit * 32, b = row0 / SEGL, s0 = row0 - b * SEGL;
  const int seglo = s0 < CTXL ? 0 : CTXL, seghi = s0 < CTXL ? CTXL : SEGL;
  for (int rr = tid >> 5; rr < 62; rr += 16) {
    const int s = s0 - 15 + rr, c8 = (tid & 31) * 8;
    f32x4 u0 = {0.f, 0.f, 0.f, 0.f}, u1 = {0.f, 0.f, 0.f, 0.f};
    if (s >= seglo && s < seghi) {
      const bf16_t* pr = PROJ + (size_t)(b * SEGL + s) * PW + c8;
      const u32x4 a1 = *(const u32x4*)pr, a2 = *(const u32x4*)(pr + 256);
      u0.x = bflo(a1.x) * sigmoidf_(bflo(a2.x)); u0.y = bfhi(a1.x) * sigmoidf_(bfhi(a2.x));
      u0.z = bflo(a1.y) * sigmoidf_(bflo(a2.y)); u0.w = bfhi(a1.y) * sigmoidf_(bfhi(a2.y));
      u1.x = bflo(a1.z) * sigmoidf_(bflo(a2.z)); u1.y = bfhi(a1.z) * sigmoidf_(bfhi(a2.z));
      u1.z = bflo(a1.w) * sigmoidf_(bflo(a2.w)); u1.w = bfhi(a1.w) * sigmoidf_(bfhi(a2.w));
    }
    *(f32x4*)(U + rr * 256 + c8) = u0; *(f32x4*)(U + rr * 256 + c8 + 4) = u1;
  }
  __syncthreads();
  float* Y = U + 62 * 256;
  const float* cw = p.in[I_CONVW] + (size_t)l * 31 * 256;
#pragma unroll 1
  for (int q = 0; q < 4; ++q) {
    const int c = lane + 64 * q;
    float w[31];
#pragma unroll
    for (int j = 0; j < 31; ++j) w[j] = cw[j * 256 + c];
    const float bias = p.in[I_CONVB][l * 256 + c];
#pragma unroll
    for (int tt = 0; tt < 4; ++tt) {
      const int t = wid * 4 + tt;
      float a = bias;
#pragma unroll
      for (int j = 0; j < 31; ++j) a += U[(t + j) * 256 + c] * w[j];
      Y[t * 256 + c] = a;
    }
  }
  asm volatile("s_waitcnt lgkmcnt(0)" ::: "memory");
  float y[4][4];
#pragma unroll
  for (int tt = 0; tt < 4; ++tt)
#pragma unroll
    for (int q = 0; q < 4; ++q) y[tt][q] = Y[(wid * 4 + tt) * 256 + lane + 64 * q];
#pragma unroll
  for (int tt = 0; tt < 4; ++tt) {
    const int t = wid * 4 + tt;
    const float mean = wave_sum((y[tt][0] + y[tt][1]) + (y[tt][2] + y[tt][3])) * (1.f / 256.f);
    float v = 0.f;
#pragma unroll
    for (int q = 0; q < 4; ++q) { const float d = y[tt][q] - mean; v += d * d; }
    const float rs = rsqrtf(wave_sum(v) * (1.f / 256.f) + EPS);
#pragma unroll
    for (int q = 0; q < 4; ++q) {
      const int c = lane + 64 * q;
      const float z = (y[tt][q] - mean) * rs * p.in[I_CLNG][l * 256 + c] + p.in[I_CLNB][l * 256 + c];
      const float o = (ABL & 1) ? 0.f : z * sigmoidf_(z);
      MIX[(size_t)(row0 + t) * DM + c] = (bf16_t)(cvtpk(o, 0.f) & 0xffffu);
    }
  }
  __syncthreads();
}

__device__ __forceinline__ int ml_cidx(int ch, int dir) { return dir == 0 ? ch : (ch < 4 ? 3 - ch : 135 - ch); }
__device__ __forceinline__ void ml_load_tile(const bf16_t* src, float* dst, int tid) {
  const int r = tid >> 3, c8 = (tid & 7) * 8;
  const u32x4 a = *(const u32x4*)(src + (size_t)r * PW + c8);
  float* d = dst + r * 65 + c8;
  d[0] = bflo(a.x); d[1] = bfhi(a.x); d[2] = bflo(a.y); d[3] = bfhi(a.y); d[4] = bflo(a.z); d[5] = bfhi(a.z); d[6] = bflo(a.w); d[7] = bfhi(a.w);
}
__device__ __forceinline__ void ml_local_unit(const Params& p, int l, int unit, unsigned char* lds) {
  int tid_ = threadIdx.x; asm volatile("" : "+v"(tid_)); const int tid = tid_, lane = tid & 63, wid = tid >> 6, r32 = lane & 31, hi = lane >> 5;
  float* Kt = (float*)lds; float* Vt = Kt + 64 * 65; float* WK = Vt + 64 * 65;
  const bf16_t* PROJ = (const bf16_t*)(p.ws + WS_PROJ);
  const float* GT = (const float*)(p.ws + WS_GATES);
  float* UL = (float*)(p.ws + WS_ULOC); float* META = (float*)(p.ws + WS_MLMETA);
  const int b = unit / (4 * NCH), hh = (unit / NCH) & 3, ch = unit % NCH;
  const int row0 = b * SEGL + ch * 64;
  ml_load_tile(PROJ + (size_t)row0 * PW + C_MK + hh * 64, Kt, tid);
  ml_load_tile(PROJ + (size_t)row0 * PW + C_MV + hh * 64, Vt, tid);
  if (wid < 2) {
    const int dir = wid;
    const float ig = GT[(size_t)(row0 + lane) * 16 + (2 * dir) * 4 + hh];
    const float lf = logsigmoidf_(GT[(size_t)(row0 + lane) * 16 + (2 * dir + 1) * 4 + hh]);
    float ps = lf;
#pragma unroll
    for (int o = 1; o < 64; o <<= 1) { const float t = __shfl_up(ps, o); if (lane >= o) ps += t; }
    const float tot = __shfl(ps, 63);
    const float wlog = dir == 0 ? (tot - ps + ig) : (ps - lf + ig);
    const float mloc = wave_max(wlog);
    WK[dir * 64 + lane] = __expf(wlog - mloc);
    if (lane == 0) {
      const int seq = (b * 4 + hh) * 2 + dir, ci = ml_cidx(ch, dir);
      META[((size_t)seq * NCH + ci) * 4 + 0] = tot; META[((size_t)seq * NCH + ci) * 4 + 1] = mloc;
    }
  }
  __syncthreads();
  {
    const int dir = wid >> 2, et = (wid >> 1) & 1, dt = wid & 1;
    const int seq = (b * 4 + hh) * 2 + dir, ci = ml_cidx(ch, dir);
    float* slot = UL + ((size_t)seq * NCH + ci) * USTRIDE;
    f32x16 acc = {};
#pragma unroll 8
    for (int ks = 0; ks < 32; ++ks) {
      const int s = 2 * ks + hi;
      const float a = WK[dir * 64 + s] * Vt[s * 65 + et * 32 + r32];
      const float bb = Kt[s * 65 + dt * 32 + r32];
      acc = __builtin_amdgcn_mfma_f32_32x32x2f32(a, bb, acc, 0, 0, 0);
    }
#pragma unroll
    for (int r = 0; r < 16; ++r) slot[(et * 32 + crow(r, hi)) * 64 + dt * 32 + r32] = acc[r];
    if (et == 0) {
      float n = 0.f;
#pragma unroll 8
      for (int i = 0; i < 32; ++i) { const int s = hi * 32 + i; n += WK[dir * 64 + s] * Kt[s * 65 + dt * 32 + r32]; }
      n += __shfl_xor(n, 32);
      if (hi == 0) slot[4096 + dt * 32 + r32] = n;
    }
  }
  __syncthreads();
}
constexpr int MLP = 144;
constexpr size_t WS_CST = WS_H;
constexpr size_t WS_NST = WS_H + (size_t)32 * NCH * 4096 * 2;
__device__ __forceinline__ void ml_stage_rm(const bf16_t* src, size_t ld, unsigned char* dst, int tid) {
  const int r = tid >> 3, c8 = (tid & 7) * 8;
  *(u32x4*)(dst + r * MLP + c8 * 2) = *(const u32x4*)(src + (size_t)r * ld + c8);
}
__device__ __forceinline__ void ml_stage_tr(const bf16_t* src, size_t ld, unsigned char* dst, int tid) {
  const int r = tid >> 3, c8 = (tid & 7) * 8;
  const u32x4 a = *(const u32x4*)(src + (size_t)r * ld + c8);
  bf16_t* d = (bf16_t*)dst;
  d[(c8 + 0) * 72 + r] = (bf16_t)(a.x & 0xffffu); d[(c8 + 1) * 72 + r] = (bf16_t)(a.x >> 16);
  d[(c8 + 2) * 72 + r] = (bf16_t)(a.y & 0xffffu); d[(c8 + 3) * 72 + r] = (bf16_t)(a.y >> 16);
  d[(c8 + 4) * 72 + r] = (bf16_t)(a.z & 0xffffu); d[(c8 + 5) * 72 + r] = (bf16_t)(a.z >> 16);
  d[(c8 + 6) * 72 + r] = (bf16_t)(a.w & 0xffffu); d[(c8 + 7) * 72 + r] = (bf16_t)(a.w >> 16);
}
__device__ __forceinline__ void ml_local_unit2(const Params& p, int l, int unit, unsigned char* lds) {
  int tid_ = threadIdx.x; asm volatile("" : "+v"(tid_)); const int tid = tid_, lane = tid & 63, wid = tid >> 6, r32 = lane & 31, hi = lane >> 5;
  unsigned char* KT = lds; unsigned char* VT = lds + 64 * MLP; float* WK = (float*)(lds + 2 * 64 * MLP);
  const bf16_t* PROJ = (const bf16_t*)(p.ws + WS_PROJ);
  const float* GT = (const float*)(p.ws + WS_GATES);
  float* UL = (float*)(p.ws + WS_ULOC); float* META = (float*)(p.ws + WS_MLMETA);
  const int b = unit / (4 * NCH), hh = (unit / NCH) & 3, ch = unit % NCH;
  const int row0 = b * SEGL + ch * 64;
  ml_stage_tr(PROJ + (size_t)row0 * PW + C_MK + hh * 64, PW, KT, tid);
  ml_stage_tr(PROJ + (size_t)row0 * PW + C_MV + hh * 64, PW, VT, tid);
  if (wid < 2) {
    const int dir = wid;
    const float ig = GT[(size_t)(row0 + lane) * 16 + (2 * dir) * 4 + hh];
    const float lf = logsigmoidf_(GT[(size_t)(row0 + lane) * 16 + (2 * dir + 1) * 4 + hh]);
    float ps = lf;
#pragma unroll
    for (int o = 1; o < 64; o <<= 1) { const float t = __shfl_up(ps, o); if (lane >= o) ps += t; }
    const float tot = __shfl(ps, 63);
    const float wlog = dir == 0 ? (tot - ps + ig) : (ps - lf + ig);
    const float mloc = wave_max(wlog);
    WK[dir * 64 + lane] = __expf(wlog - mloc);
    if (lane == 0) {
      const int seq = (b * 4 + hh) * 2 + dir, ci = ml_cidx(ch, dir);
      META[((size_t)seq * NCH + ci) * 4 + 0] = tot; META[((size_t)seq * NCH + ci) * 4 + 1] = mloc;
    }
  }
  __syncthreads();
  {
    const int dir = wid >> 2, et = (wid >> 1) & 1, dt = wid & 1;
    const int seq = (b * 4 + hh) * 2 + dir, ci = ml_cidx(ch, dir);
    float* slot = UL + ((size_t)seq * NCH + ci) * USTRIDE;
    f32x16 acc = {};
#pragma unroll
    for (int ks = 0; ks < 4; ++ks) {
      const int s0 = ks * 16 + hi * 8;
      const u32x4 va = *(const u32x4*)(VT + (et * 32 + r32) * MLP + s0 * 2);
      const bf16x8 kb = *(const bf16x8*)(KT + (dt * 32 + r32) * MLP + s0 * 2);
      const f32x4 w0 = *(const f32x4*)(WK + dir * 64 + s0), w1 = *(const f32x4*)(WK + dir * 64 + s0 + 4);
      u32x4 sa; sa.x = cvtpk(bflo(va.x) * w0.x, bfhi(va.x) * w0.y); sa.y = cvtpk(bflo(va.y) * w0.z, bfhi(va.y) * w0.w);
      sa.z = cvtpk(bflo(va.z) * w1.x, bfhi(va.z) * w1.y); sa.w = cvtpk(bflo(va.w) * w1.z, bfhi(va.w) * w1.w);
      acc = __builtin_amdgcn_mfma_f32_32x32x16_bf16(*(const bf16x8*)&sa, kb, acc, 0, 0, 0);
    }
#pragma unroll
    for (int r = 0; r < 16; ++r) slot[(et * 32 + crow(r, hi)) * 64 + dt * 32 + r32] = acc[r];
    if (et == 0) {
      float n = 0.f;
#pragma unroll
      for (int i = 0; i < 4; ++i) {
        const int s0 = hi * 32 + i * 8;
        const u32x4 ka = *(const u32x4*)(KT + (dt * 32 + r32) * MLP + s0 * 2);
        const f32x4 w0 = *(const f32x4*)(WK + dir * 64 + s0), w1 = *(const f32x4*)(WK + dir * 64 + s0 + 4);
        n += bflo(ka.x) * w0.x + bfhi(ka.x) * w0.y + bflo(ka.y) * w0.z + bfhi(ka.y) * w0.w + bflo(ka.z) * w1.x + bfhi(ka.z) * w1.y + bflo(ka.w) * w1.z + bfhi(ka.w) * w1.w;
      }
      n += __shfl_xor(n, 32);
      if (hi == 0) slot[4096 + dt * 32 + r32] = n;
    }
  }
  __syncthreads();
}
__device__ __forceinline__ void ml_scan(const Params& p, unsigned char* lds) {
  float* UL = (float*)(p.ws + WS_ULOC); float* META = (float*)(p.ws + WS_MLMETA);
  int tid_ = threadIdx.x; asm volatile("" : "+v"(tid_));
  const int tid = tid_, lane = tid & 63, wid = tid >> 6;
  float* DEC = (float*)lds;
  float* SCL = DEC + 2 * NCH;
  float* TMP = SCL + 2 * NCH;
  for (int base0 = p.bx * 512; base0 < 32 * USTRIDE; base0 += p.gx * 512) {
    const int seq0 = base0 / USTRIDE;
    if (wid < 2) {
      const int seq = seq0 + wid;
      if (seq < 32) {
        float* mt = META + (size_t)seq * NCH * 4;
        for (int c = lane; c < NCH; c += 64) { TMP[(wid * 2 + 0) * NCH + c] = mt[c * 4 + 0]; TMP[(wid * 2 + 1) * NCH + c] = mt[c * 4 + 1]; }
        asm volatile("s_waitcnt lgkmcnt(0)" ::: "memory");
        if (lane == 0) {
          float m = 0.f;
          for (int c = 0; c < NCH; ++c) {
            const float bl = TMP[(wid * 2 + 0) * NCH + c], mloc = TMP[(wid * 2 + 1) * NCH + c];
            const float mn = fmaxf(bl + m, mloc);
            DEC[wid * NCH + c] = __expf(bl + m - mn); SCL[wid * NCH + c] = __expf(mloc - mn);
            mt[c * 4 + 2] = m;
            m = mn;
          }
        }
      }
    }
    __syncthreads();
    const int idx = base0 + tid;
    if (idx < 32 * USTRIDE) {
      const int seq = idx / USTRIDE, e = idx - seq * USTRIDE, sl = seq - seq0;
      float* bp = UL + (size_t)seq * NCH * USTRIDE + e;
      bf16_t* CSTp = (bf16_t*)(p.ws + WS_CST) + (size_t)seq * NCH * 4096 + (e < 4096 ? e : 0);
      float* NSTp = (float*)(p.ws + WS_NST) + (size_t)seq * NCH * 64 + (e < 4096 ? 0 : e - 4096);
      const float* dec = DEC + sl * NCH; const float* scl = SCL + sl * NCH;
      float C = 0.f;
#pragma unroll 1
      for (int c0 = 0; c0 < NCH; c0 += 12) {
        float u[12];
#pragma unroll
        for (int j = 0; j < 12; ++j) u[j] = bp[(size_t)(c0 + j) * USTRIDE];
#pragma unroll
        for (int j = 0; j < 12; ++j) {
          if (e < 4096) CSTp[(size_t)(c0 + j) * 4096] = (bf16_t)(cvtpk(C, 0.f) & 0xffffu); else NSTp[(size_t)(c0 + j) * 64] = C;
          C = dec[c0 + j] * C + scl[c0 + j] * u[j]; }
      }
    }
    __syncthreads();
  }
}
__device__ __forceinline__ void ml_out_unit(const Params& p, int l, int unit, unsigned char* lds) {
  int tid_ = threadIdx.x; asm volatile("" : "+v"(tid_)); const int tid = tid_, lane = tid & 63, wid = tid >> 6, r32 = lane & 31, hi = lane >> 5;
  float* Qt = (float*)lds; float* Kt = Qt + 64 * 65; float* Vt = Kt + 64 * 65;
  float* Cs = Vt + 64 * 65;
  float* Ns = Cs + 2 * 64 * 65;
  float* Bq = Ns + 128;
  float* Gs = Bq + 128;
  float* Mi = Gs + 128;
  float* HB = Mi + 64;
  const bf16_t* PROJ = (const bf16_t*)(p.ws + WS_PROJ);
  const float* GT = (const float*)(p.ws + WS_GATES);
  const float* UL = (const float*)(p.ws + WS_ULOC); const float* META = (const float*)(p.ws + WS_MLMETA);
  bf16_t* MIX = (bf16_t*)(p.ws + WS_MIX);
  const int b = unit / (4 * NCH), hh = (unit / NCH) & 3, ch = unit % NCH;
  const int row0 = b * SEGL + ch * 64;
  ml_load_tile(PROJ + (size_t)row0 * PW + C_MQ + hh * 64, Qt, tid);
  ml_load_tile(PROJ + (size_t)row0 * PW + C_MK + hh * 64, Kt, tid);
  ml_load_tile(PROJ + (size_t)row0 * PW + C_MV + hh * 64, Vt, tid);
  for (int i = tid; i < 2 * USTRIDE; i += 512) {
    const int dir = i / USTRIDE, e = i - dir * USTRIDE;
    const int seq = (b * 4 + hh) * 2 + dir, ci = ml_cidx(ch, dir);
    const float v = UL[((size_t)seq * NCH + ci) * USTRIDE + e];
    if (e < 4096) Cs[dir * 64 * 65 + (e >> 6) * 65 + (e & 63)] = v; else Ns[dir * 64 + (e - 4096)] = v;
  }
  if (wid < 2) {
    const int dir = wid;
    const float ig = GT[(size_t)(row0 + lane) * 16 + (2 * dir) * 4 + hh];
    const float lf = logsigmoidf_(GT[(size_t)(row0 + lane) * 16 + (2 * dir + 1) * 4 + hh]);
    float ps = lf;
#pragma unroll
    for (int o = 1; o < 64; o <<= 1) { const float t = __shfl_up(ps, o); if (lane >= o) ps += t; }
    const float tot = __shfl(ps, 63);
    const float bc = dir == 0 ? ps : (tot - ps + lf);
    Bq[dir * 64 + lane] = bc; Gs[dir * 64 + lane] = ig - bc;
    if (lane == 0) { const int seq = (b * 4 + hh) * 2 + dir, ci = ml_cidx(ch, dir); Mi[dir] = META[((size_t)seq * NCH + ci) * 4 + 2]; }
  }
  __syncthreads();
  {
    const int dir = wid >> 2, tt = (wid >> 1) & 1, et = wid & 1;
    const int t = tt * 32 + r32;
    f32x16 sa[2] = {};
#pragma unroll 4
    for (int ks = 0; ks < 32; ++ks) {
      const float bq = Qt[t * 65 + 2 * ks + hi];
      const float a0 = Kt[(r32) * 65 + 2 * ks + hi], a1 = Kt[(32 + r32) * 65 + 2 * ks + hi];
      sa[0] = __builtin_amdgcn_mfma_f32_32x32x2f32(a0, bq, sa[0], 0, 0, 0);
      sa[1] = __builtin_amdgcn_mfma_f32_32x32x2f32(a1, bq, sa[1], 0, 0, 0);
    }
    const float bt = Bq[dir * 64 + t];
    const float inter = bt + Mi[dir];
    float mx = -INFINITY;
    f32x16 dl[2];
#pragma unroll
    for (int st = 0; st < 2; ++st)
#pragma unroll
      for (int r = 0; r < 16; ++r) {
        const int s = st * 32 + crow(r, hi);
        const bool ok = dir == 0 ? (s <= t) : (s >= t);
        const float d = ok ? bt + Gs[dir * 64 + s] : -INFINITY;
        dl[st][r] = d; mx = fmaxf(mx, d);
      }
    mx = fmaxf(mx, __shfl_xor(mx, 32));
    const float mt = fmaxf(inter, mx);
    const float iw = __expf(inter - mt);
    float rsum = 0.f;
#pragma unroll
    for (int st = 0; st < 2; ++st)
#pragma unroll
      for (int r = 0; r < 16; ++r) { const float w = __expf(dl[st][r] - mt); sa[st][r] *= w; rsum += sa[st][r]; }
    rsum += __shfl_xor(rsum, 32);
    float qn = 0.f;
#pragma unroll 8
    for (int i = 0; i < 32; ++i) { const int d = hi * 32 + i; qn += Ns[dir * 64 + d] * Qt[t * 65 + d]; }
    qn += __shfl_xor(qn, 32);
    const float den = rsum + iw * qn;
    const float rden = 1.f / fmaxf(fabsf(den), __expf(-mt));
    f32x16 an = {}, ac = {};
#pragma unroll
    for (int st = 0; st < 2; ++st)
#pragma unroll
      for (int r = 0; r < 16; ++r) {
        const float a = Vt[(st * 32 + crow(r, hi)) * 65 + et * 32 + r32];
        an = __builtin_amdgcn_mfma_f32_32x32x2f32(a, sa[st][r], an, 0, 0, 0);
      }
    const float* Cd = Cs + dir * 64 * 65;
#pragma unroll 4
    for (int ks = 0; ks < 32; ++ks) {
      const float a = Cd[(et * 32 + r32) * 65 + 2 * ks + hi];
      const float bq = Qt[t * 65 + 2 * ks + hi];
      ac = __builtin_amdgcn_mfma_f32_32x32x2f32(a, bq, ac, 0, 0, 0);
    }
#pragma unroll
    for (int r = 0; r < 16; ++r) HB[dir * 64 * 65 + t * 65 + et * 32 + crow(r, hi)] = (an[r] + iw * ac[r]) * rden;
  }
  __syncthreads();
  {
    const int t = tid >> 3, e8 = (tid & 7) * 8;
    float v[8]; float ss = 0.f;
#pragma unroll
    for (int i = 0; i < 8; ++i) { v[i] = HB[t * 65 + e8 + i] + HB[64 * 65 + t * 65 + e8 + i]; ss += v[i] * v[i]; }
    ss += __shfl_xor(ss, 1); ss += __shfl_xor(ss, 2); ss += __shfl_xor(ss, 4);
    const float rs = rsqrtf(ss * (1.f / 64.f) + EPS);
    const u32x4 ov = *(const u32x4*)(PROJ + (size_t)(row0 + t) * PW + C_MO + hh * 64 + e8);
    const float og[8] = {bflo(ov.x), bfhi(ov.x), bflo(ov.y), bfhi(ov.y), bflo(ov.z), bfhi(ov.z), bflo(ov.w), bfhi(ov.w)};
    const float* g = p.in[I_MNORMG] + l * 64 + e8;
    float o[8];
#pragma unroll
    for (int i = 0; i < 8; ++i) o[i] = (ABL & 2) ? 0.f : v[i] * rs * g[i] * sigmoidf_(og[i]);
    u32x4 w; w.x = cvtpk(o[0], o[1]); w.y = cvtpk(o[2], o[3]); w.z = cvtpk(o[4], o[5]); w.w = cvtpk(o[6], o[7]);
    *(u32x4*)(MIX + (size_t)(row0 + t) * DM + 256 + hh * 64 + e8) = w;
  }
  __syncthreads();
}


__device__ __forceinline__ void ml_out_unit2(const Params& p, int l, int unit, unsigned char* lds) {
  int tid_ = threadIdx.x; asm volatile("" : "+v"(tid_)); const int tid = tid_, lane = tid & 63, wid = tid >> 6, r32 = lane & 31, hi = lane >> 5;
  unsigned char* Qs = lds; unsigned char* Ks = lds + 64 * MLP; unsigned char* VT = lds + 2 * 64 * MLP; unsigned char* Cs = lds + 3 * 64 * MLP;
  float* Ns = (float*)(lds + 5 * 64 * MLP);
  float* Bq = Ns + 128;
  float* Gs = Bq + 128;
  float* Mi = Gs + 128;
  float* HB = Mi + 64;
  const bf16_t* PROJ = (const bf16_t*)(p.ws + WS_PROJ);
  const float* GT = (const float*)(p.ws + WS_GATES);
  const bf16_t* CST = (const bf16_t*)(p.ws + WS_CST); const float* NST = (const float*)(p.ws + WS_NST); const float* META = (const float*)(p.ws + WS_MLMETA);
  bf16_t* MIX = (bf16_t*)(p.ws + WS_MIX);
  const int b = unit / (4 * NCH), hh = (unit / NCH) & 3, ch = unit % NCH;
  const int row0 = b * SEGL + ch * 64;
  ml_stage_rm(PROJ + (size_t)row0 * PW + C_MQ + hh * 64, PW, Qs, tid);
  ml_stage_rm(PROJ + (size_t)row0 * PW + C_MK + hh * 64, PW, Ks, tid);
  ml_stage_tr(PROJ + (size_t)row0 * PW + C_MV + hh * 64, PW, VT, tid);
#pragma unroll
  for (int dir = 0; dir < 2; ++dir) {
    const int seq = (b * 4 + hh) * 2 + dir, ci = ml_cidx(ch, dir);
    ml_stage_rm(CST + ((size_t)seq * NCH + ci) * 4096, 64, Cs + dir * 64 * MLP, tid);
    if (tid < 64) Ns[dir * 64 + tid] = NST[((size_t)seq * NCH + ci) * 64 + tid];
  }
  if (wid < 2) {
    const int dir = wid;
    const float ig = GT[(size_t)(row0 + lane) * 16 + (2 * dir) * 4 + hh];
    const float lf = logsigmoidf_(GT[(size_t)(row0 + lane) * 16 + (2 * dir + 1) * 4 + hh]);
    float ps = lf;
#pragma unroll
    for (int o = 1; o < 64; o <<= 1) { const float t = __shfl_up(ps, o); if (lane >= o) ps += t; }
    const float tot = __shfl(ps, 63);
    const float bc = dir == 0 ? ps : (tot - ps + lf);
    Bq[dir * 64 + lane] = bc; Gs[dir * 64 + lane] = ig - bc;
    if (lane == 0) { const int seq = (b * 4 + hh) * 2 + dir, ci = ml_cidx(ch, dir); Mi[dir] = META[((size_t)seq * NCH + ci) * 4 + 2]; }
  }
  __syncthreads();
  {
    const int dir = wid >> 2, tt = (wid >> 1) & 1, et = wid & 1;
    const int t = tt * 32 + r32;
    f32x16 sa[2] = {};
    bf16x8 bq[4];
#pragma unroll
    for (int ks = 0; ks < 4; ++ks) {
      bq[ks] = *(const bf16x8*)(Qs + t * MLP + (ks * 16 + hi * 8) * 2);
      const bf16x8 a0 = *(const bf16x8*)(Ks + r32 * MLP + (ks * 16 + hi * 8) * 2), a1 = *(const bf16x8*)(Ks + (32 + r32) * MLP + (ks * 16 + hi * 8) * 2);
      sa[0] = __builtin_amdgcn_mfma_f32_32x32x16_bf16(a0, bq[ks], sa[0], 0, 0, 0);
      sa[1] = __builtin_amdgcn_mfma_f32_32x32x16_bf16(a1, bq[ks], sa[1], 0, 0, 0);
    }
    const float bt = Bq[dir * 64 + t];
    const float inter = bt + Mi[dir];
    float mx = -INFINITY;
    f32x16 dl[2];
#pragma unroll
    for (int st = 0; st < 2; ++st)
#pragma unroll
      for (int r = 0; r < 16; ++r) {
        const int s = st * 32 + crow(r, hi);
        const bool ok = dir == 0 ? (s <= t) : (s >= t);
        const float d = ok ? bt + Gs[dir * 64 + s] : -INFINITY;
        dl[st][r] = d; mx = fmaxf(mx, d);
      }
    mx = fmaxf(mx, __shfl_xor(mx, 32));
    const float mt = fmaxf(inter, mx);
    const float iw = __expf(inter - mt);
    float rsum = 0.f;
#pragma unroll
    for (int st = 0; st < 2; ++st)
#pragma unroll
      for (int r = 0; r < 16; ++r) { const float w = __expf(dl[st][r] - mt); sa[st][r] *= w; rsum += sa[st][r]; }
    rsum += __shfl_xor(rsum, 32);
    float qn = 0.f;
#pragma unroll
    for (int i = 0; i < 4; ++i) {
      const int d0 = hi * 32 + i * 8;
      const u32x4 qa = *(const u32x4*)(Qs + t * MLP + d0 * 2);
      const f32x4 n0 = *(const f32x4*)(Ns + dir * 64 + d0), n1 = *(const f32x4*)(Ns + dir * 64 + d0 + 4);
      qn += bflo(qa.x) * n0.x + bfhi(qa.x) * n0.y + bflo(qa.y) * n0.z + bfhi(qa.y) * n0.w + bflo(qa.z) * n1.x + bfhi(qa.z) * n1.y + bflo(qa.w) * n1.z + bfhi(qa.w) * n1.w;
    }
    qn += __shfl_xor(qn, 32);
    const float den = rsum + iw * qn;
    const float rden = 1.f / fmaxf(fabsf(den), __expf(-mt));
    f32x16 an = {}, ac = {};
#pragma unroll
    for (int st = 0; st < 2; ++st)
#pragma unroll
      for (int k2 = 0; k2 < 2; ++k2) {
        u32x4 bx; bx.x = cvtpk(sa[st][8 * k2 + 0], sa[st][8 * k2 + 1]); bx.y = cvtpk(sa[st][8 * k2 + 2], sa[st][8 * k2 + 3]);
        bx.z = cvtpk(sa[st][8 * k2 + 4], sa[st][8 * k2 + 5]); bx.w = cvtpk(sa[st][8 * k2 + 6], sa[st][8 * k2 + 7]);
        const unsigned char* vrow = VT + (et * 32 + r32) * MLP + (st * 32 + 16 * k2 + 4 * hi) * 2;
        const u32x2 v0 = *(const u32x2*)vrow, v1 = *(const u32x2*)(vrow + 16);
        u32x4 ax; ax.x = v0.x; ax.y = v0.y; ax.z = v1.x; ax.w = v1.y;
        an = __builtin_amdgcn_mfma_f32_32x32x16_bf16(*(const bf16x8*)&ax, *(const bf16x8*)&bx, an, 0, 0, 0);
      }
    const unsigned char* Cd = Cs + dir * 64 * MLP;
#pragma unroll
    for (int ks = 0; ks < 4; ++ks) {
      const bf16x8 a = *(const bf16x8*)(Cd + (et * 32 + r32) * MLP + (ks * 16 + hi * 8) * 2);
      ac = __builtin_amdgcn_mfma_f32_32x32x16_bf16(a, bq[ks], ac, 0, 0, 0);
    }
#pragma unroll
    for (int r = 0; r < 16; ++r) HB[dir * 64 * 65 + t * 65 + et * 32 + crow(r, hi)] = (an[r] + iw * ac[r]) * rden;
  }
  __syncthreads();
  {
    const int t = tid >> 3, e8 = (tid & 7) * 8;
    float v[8]; float ss = 0.f;
#pragma unroll
    for (int i = 0; i < 8; ++i) { v[i] = HB[t * 65 + e8 + i] + HB[64 * 65 + t * 65 + e8 + i]; ss += v[i] * v[i]; }
    ss += __shfl_xor(ss, 1); ss += __shfl_xor(ss, 2); ss += __shfl_xor(ss, 4);
    const float rs = rsqrtf(ss * (1.f / 64.f) + EPS);
    const u32x4 ov = *(const u32x4*)(PROJ + (size_t)(row0 + t) * PW + C_MO + hh * 64 + e8);
    const float og[8] = {bflo(ov.x), bfhi(ov.x), bflo(ov.y), bfhi(ov.y), bflo(ov.z), bfhi(ov.z), bflo(ov.w), bfhi(ov.w)};
    const float* g = p.in[I_MNORMG] + l * 64 + e8;
    float o[8];
#pragma unroll
    for (int i = 0; i < 8; ++i) o[i] = (ABL & 2) ? 0.f : v[i] * rs * g[i] * sigmoidf_(og[i]);
    u32x4 w; w.x = cvtpk(o[0], o[1]); w.y = cvtpk(o[2], o[3]); w.z = cvtpk(o[4], o[5]); w.w = cvtpk(o[6], o[7]);
    *(u32x4*)(MIX + (size_t)(row0 + t) * DM + 256 + hh * 64 + e8) = w;
  }
  __syncthreads();
}

#define KSWZ(row, colB) ((row) * 256 + ((colB) ^ (((row) & 15) << 4)))
#define SBAR() __builtin_amdgcn_sched_barrier(0)
constexpr int ATT_SHM_V = 128 * 80, ATT_SHM_K = 64 * 128 * 2;
constexpr float ATT_THR = 8.0f;
__device__ __forceinline__ int v_st(int k, int c) { const int kk = (k & ~0xC) | ((k & 4) << 1) | ((k & 8) >> 1); return ((kk >> 3) * 4 + (c >> 5)) * 512 + ((kk & 7) * 32 + (c & 31)) * 2; }
__device__ __forceinline__ int v_rd_base(int lane) { return ((lane & 3) << 3) | (((lane >> 2) & 3) << 6) | (((lane >> 4) & 1) << 5) | (((lane >> 5) & 1) << 8); }
constexpr int v_rd_off(int d0, int ks, int half) { return d0 * 512 + ks * 4096 + half * 2048; }
template <int OFF> __device__ __forceinline__ s16x4 tr_read(int vb) {
  s16x4 r; asm volatile("ds_read_b64_tr_b16 %0, %1 offset:%2" : "=&v"(r) : "v"(vb), "i"(OFF) : "memory"); return r;
}
template <int D0> __device__ __forceinline__ void pv_one(f32x16& od, int vb, bf16x8 pa0, bf16x8 pa1, bf16x8 pa2, bf16x8 pa3) {
  const s16x4 l0 = tr_read<v_rd_off(D0, 0, 0)>(vb), h0 = tr_read<v_rd_off(D0, 0, 1)>(vb), l1 = tr_read<v_rd_off(D0, 1, 0)>(vb), h1 = tr_read<v_rd_off(D0, 1, 1)>(vb);
  const s16x4 l2 = tr_read<v_rd_off(D0, 2, 0)>(vb), h2 = tr_read<v_rd_off(D0, 2, 1)>(vb), l3 = tr_read<v_rd_off(D0, 3, 0)>(vb), h3 = tr_read<v_rd_off(D0, 3, 1)>(vb);
  asm volatile("s_waitcnt lgkmcnt(0)" ::: "memory"); SBAR();
#define PK(L, H) (bf16x8){L[0], L[1], L[2], L[3], H[0], H[1], H[2], H[3]}
  od = __builtin_amdgcn_mfma_f32_32x32x16_bf16(pa0, PK(l0, h0), od, 0, 0, 0);
  od = __builtin_amdgcn_mfma_f32_32x32x16_bf16(pa1, PK(l1, h1), od, 0, 0, 0);
  od = __builtin_amdgcn_mfma_f32_32x32x16_bf16(pa2, PK(l2, h2), od, 0, 0, 0);
  od = __builtin_amdgcn_mfma_f32_32x32x16_bf16(pa3, PK(l3, h3), od, 0, 0, 0);
#undef PK
}
template <int D0> __device__ __forceinline__ void pv_two(f32x16& oa, f32x16& ob, int vb, bf16x8 a0, bf16x8 a1, bf16x8 a2, bf16x8 a3, bf16x8 b0, bf16x8 b1, bf16x8 b2, bf16x8 b3) {
  const s16x4 l0 = tr_read<v_rd_off(D0, 0, 0)>(vb), h0 = tr_read<v_rd_off(D0, 0, 1)>(vb), l1 = tr_read<v_rd_off(D0, 1, 0)>(vb), h1 = tr_read<v_rd_off(D0, 1, 1)>(vb);
  const s16x4 l2 = tr_read<v_rd_off(D0, 2, 0)>(vb), h2 = tr_read<v_rd_off(D0, 2, 1)>(vb), l3 = tr_read<v_rd_off(D0, 3, 0)>(vb), h3 = tr_read<v_rd_off(D0, 3, 1)>(vb);
  asm volatile("s_waitcnt lgkmcnt(0)" ::: "memory"); SBAR();
#define PK(L, H) (bf16x8){L[0], L[1], L[2], L[3], H[0], H[1], H[2], H[3]}
  const bf16x8 v0 = PK(l0, h0), v1 = PK(l1, h1), v2 = PK(l2, h2), v3 = PK(l3, h3);
  oa = __builtin_amdgcn_mfma_f32_32x32x16_bf16(a0, v0, oa, 0, 0, 0);
  ob = __builtin_amdgcn_mfma_f32_32x32x16_bf16(b0, v0, ob, 0, 0, 0);
  oa = __builtin_amdgcn_mfma_f32_32x32x16_bf16(a1, v1, oa, 0, 0, 0);
  ob = __builtin_amdgcn_mfma_f32_32x32x16_bf16(b1, v1, ob, 0, 0, 0);
  oa = __builtin_amdgcn_mfma_f32_32x32x16_bf16(a2, v2, oa, 0, 0, 0);
  ob = __builtin_amdgcn_mfma_f32_32x32x16_bf16(b2, v2, ob, 0, 0, 0);
  oa = __builtin_amdgcn_mfma_f32_32x32x16_bf16(a3, v3, oa, 0, 0, 0);
  ob = __builtin_amdgcn_mfma_f32_32x32x16_bf16(b3, v3, ob, 0, 0, 0);
#undef PK
}
__device__ __forceinline__ void att_qkt(f32x16& p0, f32x16& p1, const unsigned char* Ks, const unsigned char* Qs, int qrow, int comp, int r32, int hi, float init) {
#pragma unroll
  for (int r = 0; r < 16; ++r) { p0[r] = init; p1[r] = init; }
#pragma unroll
  for (int d0 = 0; d0 < 4; ++d0) {
    const int cb = ((comp * 4 + d0) * 16 + hi * 8) * 2;
    const bf16x8 b0 = *(const bf16x8*)(Ks + KSWZ(r32, cb));
    const bf16x8 b1 = *(const bf16x8*)(Ks + KSWZ(32 + r32, cb));
    const bf16x8 q = *(const bf16x8*)(Qs + KSWZ(qrow, cb));
    p0 = __builtin_amdgcn_mfma_f32_32x32x16_bf16(b0, q, p0, 0, 0, 0);
    p1 = __builtin_amdgcn_mfma_f32_32x32x16_bf16(b1, q, p1, 0, 0, 0);
  }
}
__device__ __forceinline__ void att_softmax(f32x16& p0, f32x16& p1, float& m_reg, float& l_reg, float& alpha, bool first, i32x8& pa) {
  alpha = 1.f;
  if (first) {
    float pmax = p0[0];
#pragma unroll
    for (int r = 1; r < 16; ++r) pmax = fmaxf(pmax, p0[r]);
#pragma unroll
    for (int r = 0; r < 16; ++r) pmax = fmaxf(pmax, p1[r]);
    { auto rr = __builtin_amdgcn_permlane32_swap(__float_as_uint(pmax), __float_as_uint(pmax), false, false);
      pmax = fmaxf(__uint_as_float(rr[0]), __uint_as_float(rr[1])); }
    alpha = 0.f; m_reg = pmax;
#pragma unroll
    for (int r = 0; r < 16; ++r) { p0[r] -= pmax; p1[r] -= pmax; }
  }
#pragma unroll
  for (int r = 0; r < 16; ++r) { p0[r] = __builtin_amdgcn_exp2f(p0[r]); p1[r] = __builtin_amdgcn_exp2f(p1[r]); }
  float ps = 0.f;
#pragma unroll
  for (int r = 0; r < 16; ++r) ps += p0[r];
#pragma unroll
  for (int r = 0; r < 16; ++r) ps += p1[r];
  { auto rr = __builtin_amdgcn_permlane32_swap(__float_as_uint(ps), __float_as_uint(ps), false, false);
    ps = __uint_as_float(rr[0]) + __uint_as_float(rr[1]); }
  if (__builtin_expect(!first && __any(ps > 256.f), 0)) {
    float emax = p0[0];
#pragma unroll
    for (int r = 1; r < 16; ++r) emax = fmaxf(emax, p0[r]);
#pragma unroll
    for (int r = 0; r < 16; ++r) emax = fmaxf(emax, p1[r]);
    { auto rr = __builtin_amdgcn_permlane32_swap(__float_as_uint(emax), __float_as_uint(emax), false, false);
      emax = fmaxf(__uint_as_float(rr[0]), __uint_as_float(rr[1])); }
    const float delta = fmaxf(__builtin_amdgcn_logf(emax), 0.f);
    alpha = __builtin_amdgcn_exp2f(-delta); m_reg += delta;
#pragma unroll
    for (int r = 0; r < 16; ++r) { p0[r] *= alpha; p1[r] *= alpha; }
    ps *= alpha;
  }
  l_reg = l_reg * alpha + ps;
#pragma unroll
  for (int v = 0; v < 4; ++v) {
    int w0 = 0, w1 = 0;
    w0 = __builtin_amdgcn_cvt_pk_fp8_f32(p0[4 * v], p0[4 * v + 1], w0, false); w0 = __builtin_amdgcn_cvt_pk_fp8_f32(p0[4 * v + 2], p0[4 * v + 3], w0, true);
    w1 = __builtin_amdgcn_cvt_pk_fp8_f32(p1[4 * v], p1[4 * v + 1], w1, false); w1 = __builtin_amdgcn_cvt_pk_fp8_f32(p1[4 * v + 2], p1[4 * v + 3], w1, true);
    pa[v] = w0; pa[4 + v] = w1;
  }
}
__device__ __forceinline__ void att_unit(const bf16_t* __restrict__ Qb, const bf16_t* __restrict__ Kh, const unsigned char* __restrict__ V8, bf16_t* __restrict__ Ob,
                                         int nkeys, float lam, const float* __restrict__ ng, float oscale, unsigned char* lds) {
  int tid_ = threadIdx.x; asm volatile("" : "+v"(tid_)); const int tid = tid_, wid = tid >> 6, lane = tid & 63, r32 = lane & 31, hi = lane >> 5;
  unsigned char* V_lds = lds; unsigned char* K_lds = lds + 2 * ATT_SHM_V;
  float* wsl = (float*)(lds + 2 * ATT_SHM_V + 2 * ATT_SHM_K) + wid * 64; float* li_l = wsl; float* al_l = wsl + 32;
  float m0 = 0.f, l0 = 0.f, m1 = 0.f, l1 = 0.f;
  f32x16 o0[4] = {}, o1[4] = {};
  unsigned char* Q_lds = lds + 2 * ATT_SHM_V + 2 * ATT_SHM_K + 2048;
#pragma unroll
  for (int i = 0; i < 8; ++i) { const int id = tid + 512 * i, qrw = id >> 4, ch = id & 15;
    *(bf16x8*)(Q_lds + KSWZ(qrw, ch * 16)) = *(const bf16x8*)(Qb + (size_t)qrw * PW + ch * 8); }
  const int qrow = wid * 32 + r32;
  int kso[2];
#pragma unroll
  for (int i = 0; i < 2; ++i) {
    const int o16 = tid + 512 * i;
    { const int row = o16 >> 4, cs = (o16 & 15) ^ (row & 15); kso[i] = row * PW + cs * 8; }
  }
  const unsigned ldsw = (unsigned)__builtin_amdgcn_readfirstlane(wid) * 1024u;
#define GSTAGE(b, k0) do { _Pragma("unroll") for (int i_ = 0; i_ < 2; ++i_) \
    __builtin_amdgcn_global_load_lds((const unsigned*)(Kh + (size_t)(k0) * PW + kso[i_]), (LAS unsigned*)(K_lds + (b) * ATT_SHM_K + ldsw + i_ * 8192), 16, 0, 0); \
    { const unsigned char* vi_ = V8 + (size_t)((k0) >> 6) * ATT_SHM_V + tid * 16; \
      __builtin_amdgcn_global_load_lds((const unsigned*)vi_, (LAS unsigned*)(V_lds + (b) * ATT_SHM_V + ldsw), 16, 0, 0); \
      if (wid < 2) __builtin_amdgcn_global_load_lds((const unsigned*)(vi_ + 8192), (LAS unsigned*)(V_lds + (b) * ATT_SHM_V + 8192 + ldsw), 16, 0, 0); } } while (0)
#define RESC(o, a) do { if (__any((a) < 1.f)) { if (hi == 0) al_l[r32] = (a); asm volatile("s_waitcnt lgkmcnt(0)" ::: "memory"); \
    _Pragma("unroll") for (int d = 0; d < 4; ++d) _Pragma("unroll") for (int r = 0; r < 16; ++r) o[d][r] *= al_l[crow(r, hi)]; } } while (0)
  const int NT = nkeys / 64;
  GSTAGE(0, 0); asm volatile("s_waitcnt vmcnt(0)" ::: "memory"); __syncthreads();
  for (int j = 0; j < NT; ++j) {
    const int cur = j & 1;
    if (j + 1 < NT) GSTAGE(cur ^ 1, (j + 1) * 64);
    const unsigned char* Kc = K_lds + cur * ATT_SHM_K; const unsigned char* Vc = V_lds + cur * ATT_SHM_V;
    f32x16 p0, p1, q0, q1; float alphaA, alphaB; i32x8 pa, pb;
    const bool first = (j == 0);
    att_qkt(p0, p1, Kc, Q_lds, qrow, 0, r32, hi, first ? 0.f : -m0);
    att_qkt(q0, q1, Kc, Q_lds, qrow, 1, r32, hi, first ? 0.f : -m1);
    att_softmax(p0, p1, m0, l0, alphaA, first, pa);
    att_softmax(q0, q1, m1, l1, alphaB, first, pb);
    RESC(o0, alphaA);
    RESC(o1, alphaB);
#pragma unroll
    for (int d0 = 0; d0 < 4; ++d0) {
      const unsigned char* vrow = Vc + (d0 * 32 + r32) * 80 + hi * 32;
      const u32x4 v0 = *(const u32x4*)vrow, v1 = *(const u32x4*)(vrow + 16);
      i32x8 bv; bv[0] = (int)v0.x; bv[1] = (int)v0.y; bv[2] = (int)v0.z; bv[3] = (int)v0.w; bv[4] = (int)v1.x; bv[5] = (int)v1.y; bv[6] = (int)v1.z; bv[7] = (int)v1.w;
      o0[d0] = __builtin_amdgcn_mfma_scale_f32_32x32x64_f8f6f4(pa, bv, o0[d0], 0, 0, 0, 0x7F7F7F7F, 0, 0x7F7F7F7F);
      o1[d0] = __builtin_amdgcn_mfma_scale_f32_32x32x64_f8f6f4(pb, bv, o1[d0], 0, 0, 0, 0x7F7F7F7F, 0, 0x7F7F7F7F);
    }
    asm volatile("s_waitcnt vmcnt(0)" ::: "memory");
    __syncthreads();
  }
  if (hi == 0) { li_l[r32] = 1.f / l0; al_l[r32] = lam / l1; }
  asm volatile("s_waitcnt lgkmcnt(0)" ::: "memory");
  float ss[16];
#pragma unroll
  for (int r = 0; r < 16; ++r) {
    const float a = li_l[crow(r, hi)], bq = al_l[crow(r, hi)];
    float s = 0.f;
#pragma unroll
    for (int d = 0; d < 4; ++d) { const float v = o0[d][r] * a - o1[d][r] * bq; o0[d][r] = v; s += v * v; }
    s += __shfl_xor(s, 1); s += __shfl_xor(s, 2); s += __shfl_xor(s, 4); s += __shfl_xor(s, 8); s += __shfl_xor(s, 16);
    ss[r] = rsqrtf(s * (1.f / 128.f) + EPS) * oscale;
  }
  bf16_t* Ow = Ob + (size_t)(wid * 32) * DM;
#pragma unroll
  for (int d = 0; d < 4; ++d) {
    const float g = ng[d * 32 + r32];
#pragma unroll
    for (int r = 0; r < 16; ++r) Ow[(size_t)crow(r, hi) * DM + d * 32 + r32] = (ABL & 4) ? (bf16_t)0 : (bf16_t)(cvtpk(o0[d][r] * ss[r] * g, 0.f) & 0xffffu);
  }
  __syncthreads();
#undef GSTAGE
#undef RESC
}

__device__ __forceinline__ float ins16(float (&a)[16], float x) {
#pragma unroll
  for (int i = 0; i < 16; ++i) { const float h = fmaxf(a[i], x); x = fminf(a[i], x); a[i] = h; }
  return x;
}
__device__ __forceinline__ void bsort16(float (&a)[16]) {
#pragma unroll
  for (int k = 2; k <= 16; k <<= 1)
#pragma unroll
    for (int j = k >> 1; j > 0; j >>= 1)
#pragma unroll
      for (int i = 0; i < 16; ++i) {
        const int q = i ^ j;
        if (q > i) {
          const bool desc = ((i & k) == 0);
          const float hi_ = fmaxf(a[i], a[q]), lo_ = fminf(a[i], a[q]);
          a[i] = desc ? hi_ : lo_; a[q] = desc ? lo_ : hi_;
        }
      }
}
__device__ __forceinline__ void bmerge16(float (&a)[16], const float (&b)[16]) {
#pragma unroll
  for (int i = 0; i < 16; ++i) a[i] = fmaxf(a[i], b[15 - i]);
#pragma unroll
  for (int j = 8; j > 0; j >>= 1)
#pragma unroll
    for (int i = 0; i < 16; ++i) {
      const int q = i ^ j;
      if (q > i) { const float hi_ = fmaxf(a[i], a[q]), lo_ = fminf(a[i], a[q]); a[i] = hi_; a[q] = lo_; }
    }
}
__device__ __forceinline__ float gelu_erf(float x) { return 0.5f * x * (1.f + erff(x * 0.70710678118654752440f)); }
#define XB_TMO      128
#define XB_XCNT(j)  (256  + 64 * (j))
#define XB_XSUB(j)  (1280 + 64 * (j))
#define XB_XGEN(j)  (2304 + 64 * (j))
#define XB_TOP      3328
#define XB_TOPGEN   3392
#define XCD_BAR_WORDS 3456
#define XB_SPIN_CAP (1u << 22)
__device__ __forceinline__ unsigned xb_ld(unsigned* p)              { return __hip_atomic_load(p, __ATOMIC_RELAXED, __HIP_MEMORY_SCOPE_AGENT); }
__device__ __forceinline__ unsigned xb_add(unsigned* p, unsigned v) { return __hip_atomic_fetch_add(p, v, __ATOMIC_RELAXED, __HIP_MEMORY_SCOPE_AGENT); }
__device__ __forceinline__ unsigned xb_xcc_id() { return (unsigned)__builtin_amdgcn_s_getreg((3 << 11) | 20) & 0xFu; }
#define XB_SPIN(cond, bar) do { unsigned _sp = 0; while (cond) { __builtin_amdgcn_s_sleep(1); \
    if ((++_sp & 255u) == 0u) { if (xb_ld(&(bar)[XB_TMO])) break; if (_sp > XB_SPIN_CAP) { atomicAdd(&(bar)[XB_TMO], 1u); break; } } } } while (0)
struct XcdBarrier { unsigned* bar; unsigned x; volatile LAS unsigned* st; };
__device__ __forceinline__ XcdBarrier xcd_barrier_post(unsigned* bar, volatile LAS unsigned* st) {
  XcdBarrier b; b.bar = bar; b.x = xb_xcc_id(); b.st = st;
  if (threadIdx.x == 0) (void)xb_add(&bar[XB_XCNT(b.x)], 1u);
  return b;
}
__device__ __forceinline__ void xcd_barrier_complete(unsigned* bar, unsigned x, unsigned& nloc, unsigned& nx) {
  const unsigned G = gridDim.x * gridDim.y * gridDim.z;
  unsigned sum, cnt, mine, sp = 0u;
  for (;;) {
    sum = 0u; cnt = 0u; mine = 0u;
#pragma unroll
    for (unsigned j = 0; j < 16; ++j) { const unsigned c = xb_ld(&bar[XB_XCNT(j)]); sum += c; cnt += (c > 0u) ? 1u : 0u; mine = (j == x) ? c : mine; }
    if (sum == G) break;
    __builtin_amdgcn_s_sleep(1);
    if ((++sp & 255u) == 0u) { if (xb_ld(&bar[XB_TMO])) break; if (sp > XB_SPIN_CAP) { atomicAdd(&bar[XB_TMO], 1u); break; } }
  }
  nloc = mine > 0u ? mine : 1u; nx = cnt > 0u ? cnt : 1u;
}
__device__ __forceinline__ void xcd_barrier(const XcdBarrier& b) {
  asm volatile("s_waitcnt vmcnt(0)" ::: "memory");
  __syncthreads();
  if (threadIdx.x == 0) {
    unsigned* bar = b.bar;
    __builtin_amdgcn_s_waitcnt(0);
    unsigned nloc = b.st[0], nx = b.st[1];
    if (nloc == 0u) { xcd_barrier_complete(bar, b.x, nloc, nx); b.st[0] = nloc; b.st[1] = nx; }
    const unsigned old = xb_add(&bar[XB_XSUB(b.x)], 1u);
    const unsigned gen = old / nloc;
    if (old + 1u == (gen + 1u) * nloc) {
      __builtin_amdgcn_fence(__ATOMIC_RELEASE, "agent");
      asm volatile("s_waitcnt vmcnt(0)" ::: "memory");
      const unsigned og = xb_add(&bar[XB_TOP], 1u);
      const unsigned tg = og / nx;
      if (og + 1u == (tg + 1u) * nx) xb_add(&bar[XB_TOPGEN], 1u);
      else XB_SPIN(xb_ld(&bar[XB_TOPGEN]) == tg, bar);
      __builtin_amdgcn_fence(__ATOMIC_ACQUIRE, "agent");
      xb_add(&bar[XB_XGEN(b.x)], 1u);
      asm volatile("s_waitcnt vmcnt(0)" ::: "memory");
    } else {
      XB_SPIN(xb_ld(&bar[XB_XGEN(b.x)]) == gen, bar);
      __builtin_amdgcn_fence(__ATOMIC_ACQUIRE, "agent");
      asm volatile("s_waitcnt vmcnt(0)" ::: "memory");
    }
  }
  __syncthreads();
}

constexpr size_t RT_STRIDE = (size_t)T * 128 * 4;
__device__ __forceinline__ void route_unit(const Params& p, int l, int unit, unsigned char* lds) {
  int tid_ = threadIdx.x; asm volatile("" : "+v"(tid_)); const int tid = tid_, lane = tid & 63, wid = tid >> 6, r32 = lane & 31, hi = lane >> 5;
  unsigned char* IDX = lds;
  int* UE = (int*)(lds + 8192); float* UG = (float*)(lds + 8192 + 16384); float* US = (float*)(lds + 8192 + 32768);
  int* EIDG = (int*)(p.ws + WS_ULOC); float* GWG = (float*)(p.ws + WS_ULOC + RT_STRIDE); float* SUG = (float*)(p.ws + WS_ULOC + 2 * RT_STRIDE);
  const float* PSC = (const float*)(p.ws + WS_PSC);
  const int row0 = unit * 32;
  const bf16_t* QP = (const bf16_t*)(p.ws + WS_PROJ);
  const bf16_t* KEYS = (const bf16_t*)(p.ws + WS_KEYS) + (size_t)l * 131072;
  for (int rrep = 0; rrep < REP_ROUTE; ++rrep) {
    const int h = wid;
    float top[2][16];
#pragma unroll
    for (int pp = 0; pp < 2; ++pp) {
      const bf16_t* qrow = QP + (size_t)(row0 + r32) * DM + h * 128 + pp * 64 + hi * 8;
      const bf16_t* kb = KEYS + ((size_t)(h * 2 + pp) * 128 + r32) * 64 + hi * 8;
      bf16x8 bq[4];
#pragma unroll
      for (int ks = 0; ks < 4; ++ks) bq[ks] = *(const bf16x8*)(qrow + ks * 16);
      float (&lst)[16] = top[pp];
#pragma unroll
      for (int i = 0; i < 16; ++i) lst[i] = -INFINITY;
#pragma unroll
      for (int nt = 0; nt < 4; ++nt) {
        f32x16 acc = {};
#pragma unroll
        for (int ks = 0; ks < 4; ++ks) {
          const bf16x8 ak = *(const bf16x8*)(kb + (size_t)nt * 32 * 64 + ks * 16);
          acc = __builtin_amdgcn_mfma_f32_32x32x16_bf16(ak, bq[ks], acc, 0, 0, 0);
        }
        float grp[16];
#pragma unroll
        for (int r = 0; r < 16; ++r) grp[r] = __uint_as_float((__float_as_uint(acc[r]) & ~0x7Fu) | (unsigned)(nt * 32 + crow(r, hi)));
        bsort16(grp);
        if (nt == 0) {
#pragma unroll
          for (int i = 0; i < 16; ++i) lst[i] = grp[i];
        } else bmerge16(lst, grp);
        SBAR();
      }
      float oth[16];
#pragma unroll
      for (int i = 0; i < 16; ++i) oth[i] = __shfl_xor(lst[i], 32);
      bmerge16(lst, oth);
      if (hi == 0) {
        unsigned w[4];
#pragma unroll
        for (int i = 0; i < 4; ++i)
          w[i] = (__float_as_uint(lst[4 * i]) & 0x7Fu) | ((__float_as_uint(lst[4 * i + 1]) & 0x7Fu) << 8) | ((__float_as_uint(lst[4 * i + 2]) & 0x7Fu) << 16) | ((__float_as_uint(lst[4 * i + 3]) & 0x7Fu) << 24);
        *(u32x4*)(IDX + ((r32 * 8 + h) * 2 + pp) * 16) = (u32x4){w[0], w[1], w[2], w[3]};
      }
    }
    float best[16];
#define CAND(i, j) __uint_as_float((__float_as_uint(__uint_as_float(__float_as_uint(top[0][i]) & ~0x7Fu) + __uint_as_float(__float_as_uint(top[1][j]) & ~0x7Fu)) & ~0xFFu) | (unsigned)((i) * 16 + (j)))
    {
#pragma unroll
      for (int j = 0; j < 16; ++j) best[j] = CAND(0, j);
      float y[16];
#pragma unroll
      for (int j = 0; j < 8; ++j) { y[j] = CAND(1, j); y[8 + j] = CAND(15 - j, 0); }
#pragma unroll
      for (int jj = 8; jj > 0; jj >>= 1)
#pragma unroll
        for (int i = 0; i < 16; ++i) { const int q = i ^ jj; if (q > i) { const float hi_ = fmaxf(y[i], y[q]), lo_ = fminf(y[i], y[q]); y[i] = hi_; y[q] = lo_; } }
      bmerge16(best, y);
      float x[16];
      x[0] = CAND(2, 0); x[1] = CAND(2, 1); x[2] = CAND(2, 2); x[3] = CAND(2, 3); x[4] = CAND(2, 4);
      x[5] = CAND(3, 0); x[6] = CAND(3, 1); x[7] = CAND(3, 2); x[8] = CAND(3, 3);
      x[9] = CAND(4, 0); x[10] = CAND(4, 1); x[11] = CAND(4, 2);
      x[12] = CAND(5, 0); x[13] = CAND(5, 1); x[14] = CAND(6, 0); x[15] = CAND(6, 1);
      bsort16(x);
      bmerge16(best, x);
      ins16(best, CAND(7, 0)); ins16(best, CAND(7, 1));
    }
#undef CAND
    asm volatile("s_waitcnt lgkmcnt(0)" ::: "memory");
    if (hi == 0) {
      const unsigned char* ib = IDX + ((r32 * 8 + h) * 2) * 16;
      const float mx = __uint_as_float(__float_as_uint(best[0]) & ~0xFFu);
      float w[16]; float sum = 0.f;
#pragma unroll
      for (int k = 0; k < 16; ++k) { w[k] = __expf(__uint_as_float(__float_as_uint(best[k]) & ~0xFFu) - mx); sum += w[k]; }
      const float rsum = 1.f / sum;
      int ee[16]; float su_[16], sv_[16];
#pragma unroll
      for (int k = 0; k < 16; ++k) {
        const unsigned ij = __float_as_uint(best[k]) & 0xFFu;
        ee[k] = (int)ib[ij >> 4] * 128 + (int)ib[16 + (ij & 15)];
      }
#pragma unroll
      for (int k = 0; k < 16; ++k) { su_[k] = PSC[(size_t)l * NEXP + ee[k]]; sv_[k] = PSC[(size_t)(DEPTH + l) * NEXP + ee[k]]; }
#pragma unroll
      for (int k = 0; k < 16; ++k) {
        UE[r32 * 128 + h * 16 + k] = ee[k]; UG[r32 * 128 + h * 16 + k] = w[k] * rsum * sv_[k];
        US[r32 * 128 + h * 16 + k] = su_[k];
      }
    }
  }
  __syncthreads();
#pragma unroll 1
  for (int tt = 0; tt < 4; ++tt) {
    const int t = wid * 4 + tt;
    const int k0 = UE[t * 128 + lane], k1 = UE[t * 128 + 64 + lane];
    const float g0 = UG[t * 128 + lane], g1 = UG[t * 128 + 64 + lane], s0 = US[t * 128 + lane], s1 = US[t * 128 + 64 + lane];
    const int b0 = k0 >> 10, b1 = k1 >> 10;
    int base = 0, pos0 = 0, pos1 = 0;
#pragma unroll
    for (int b = 0; b < 16; ++b) {
      const unsigned long long m0 = __ballot(b0 == b), m1 = __ballot(b1 == b);
      const int c0 = __popcll(m0), c1 = __popcll(m1);
      const unsigned long long lt = (1ull << lane) - 1ull;
      if (b0 == b) pos0 = base + __popcll(m0 & lt);
      if (b1 == b) pos1 = base + c0 + __popcll(m1 & lt);
      base += c0 + c1;
    }
    const size_t ro = (size_t)(row0 + t) * 128;
    EIDG[ro + pos0] = k0; GWG[ro + pos0] = g0; SUG[ro + pos0] = s0;
    EIDG[ro + pos1] = k1; GWG[ro + pos1] = g1; SUG[ro + pos1] = s1;
  }
}
struct TokPref { int e0, e1; float g0, g1, s0, s1; u32x4 hA, hB; };
__device__ __forceinline__ void tok_prefetch(const Params& p, int row, int lane, TokPref& t) {
  const int* EIDG = (const int*)(p.ws + WS_ULOC) + (size_t)row * 128; const float* GWG = (const float*)(p.ws + WS_ULOC + RT_STRIDE) + (size_t)row * 128;
  const float* SUG = (const float*)(p.ws + WS_ULOC + 2 * RT_STRIDE) + (size_t)row * 128;
  const bf16_t* H = (const bf16_t*)(p.ws + WS_H);
  t.e0 = EIDG[lane]; t.e1 = EIDG[64 + lane]; t.g0 = GWG[lane]; t.g1 = GWG[64 + lane]; t.s0 = SUG[lane]; t.s1 = SUG[64 + lane];
  t.hA = *(const u32x4*)(H + (size_t)row * DM + lane * 16); t.hB = *(const u32x4*)(H + (size_t)row * DM + lane * 16 + 8);
}
__device__ __forceinline__ void gather_token(const Params& p, int l, int row, int nextrow, TokPref& tp, unsigned char* lds, int lane, int wid) {
  int* EW = (int*)(lds + wid * 2048); float* GWl = (float*)(lds + wid * 2048 + 512); float* SWl = (float*)(lds + wid * 2048 + 1024);
  const bf16_t* H = (const bf16_t*)(p.ws + WS_H);
  const unsigned char* PUq = p.ws + WS_PU + (size_t)l * NEXP * PROW;
  const unsigned char* PVq = p.ws + WS_PV + (size_t)l * NEXP * PROW;
  float* XC = (float*)(p.ws + WS_XCUR);
  const float* MOD = (const float*)(p.ws + WS_MOD);
  EW[lane] = tp.e0; EW[64 + lane] = tp.e1; GWl[lane] = tp.g0; GWl[64 + lane] = tp.g1; SWl[lane] = tp.s0; SWl[64 + lane] = tp.s1;
  asm volatile("s_waitcnt lgkmcnt(0)" ::: "memory");
  {
    float hf[16];
    {
      const u32x4 hA = tp.hA, hB = tp.hB;
      hf[0] = bflo(hA.x); hf[1] = bfhi(hA.x); hf[2] = bflo(hA.y); hf[3] = bfhi(hA.y); hf[4] = bflo(hA.z); hf[5] = bfhi(hA.z); hf[6] = bflo(hA.w); hf[7] = bfhi(hA.w);
      hf[8] = bflo(hB.x); hf[9] = bfhi(hB.x); hf[10] = bflo(hB.y); hf[11] = bfhi(hB.y); hf[12] = bflo(hB.z); hf[13] = bfhi(hB.z); hf[14] = bflo(hB.w); hf[15] = bfhi(hB.w);
    }
    if (nextrow >= 0) tok_prefetch(p, nextrow, lane, tp);
    f32x4 xpre[4];
    { const float* xr_ = XC + (size_t)row * DM + lane * 16;
#pragma unroll
      for (int v4 = 0; v4 < 4; ++v4) xpre[v4] = *(const f32x4*)(xr_ + v4 * 4); }
    float acc[16];
    for (int rep = 0; rep < REP_PEER; ++rep) {
#pragma unroll
    for (int i = 0; i < 16; ++i) acc[i] = 0.f;
    u32x3 uq[8];
#pragma unroll
    for (int i = 0; i < 8; ++i) { const int e0 = __builtin_amdgcn_readfirstlane(EW[i]); uq[i] = *(const u32x3*)(PUq + (size_t)e0 * PROW + lane * 12); }
    for (int g8 = 0; g8 < 16; ++g8) {
      int eid[8]; float gwt[8]; u32x3 vq[8];
#pragma unroll
      for (int i = 0; i < 8; ++i) {
        eid[i] = __builtin_amdgcn_readfirstlane(EW[g8 * 8 + i]);
        gwt[i] = __uint_as_float(__builtin_amdgcn_readfirstlane(__float_as_uint(GWl[g8 * 8 + i])));
        vq[i] = *(const u32x3*)(PVq + (size_t)eid[i] * PROW + lane * 12);
      }
      float d[8];
#pragma unroll
      for (int i2 = 0; i2 < 4; ++i2) {
        i32x6 w6; w6[0] = (int)uq[2 * i2].x; w6[1] = (int)uq[2 * i2].y; w6[2] = (int)uq[2 * i2].z; w6[3] = (int)uq[2 * i2 + 1].x; w6[4] = (int)uq[2 * i2 + 1].y; w6[5] = (int)uq[2 * i2 + 1].z;
        const f32x32 r = __builtin_amdgcn_cvt_scalef32_pk32_f32_fp6(w6, 1.0f);
        float a0 = 0.f, a1 = 0.f, b0 = 0.f, b1 = 0.f;
#pragma unroll
        for (int k = 0; k < 16; k += 2) { a0 += r[k] * hf[k]; a1 += r[k + 1] * hf[k + 1]; b0 += r[16 + k] * hf[k]; b1 += r[17 + k] * hf[k + 1]; }
        d[2 * i2] = (a0 + a1) * __uint_as_float(__builtin_amdgcn_readfirstlane(__float_as_uint(SWl[g8 * 8 + 2 * i2])));
        d[2 * i2 + 1] = (b0 + b1) * __uint_as_float(__builtin_amdgcn_readfirstlane(__float_as_uint(SWl[g8 * 8 + 2 * i2 + 1])));
        asm volatile("" : "+v"(d[2 * i2]), "+v"(d[2 * i2 + 1]));
      }
      if (g8 < 15) {
#pragma unroll
        for (int i = 0; i < 8; ++i) { const int e0 = __builtin_amdgcn_readfirstlane(EW[(g8 + 1) * 8 + i]); uq[i] = *(const u32x3*)(PUq + (size_t)e0 * PROW + lane * 12); }
      }
      float tot;
      {
        auto s01 = __builtin_amdgcn_permlane32_swap(__float_as_uint(d[0]), __float_as_uint(d[1]), false, false);
        auto s23 = __builtin_amdgcn_permlane32_swap(__float_as_uint(d[2]), __float_as_uint(d[3]), false, false);
        auto s45 = __builtin_amdgcn_permlane32_swap(__float_as_uint(d[4]), __float_as_uint(d[5]), false, false);
        auto s67 = __builtin_amdgcn_permlane32_swap(__float_as_uint(d[6]), __float_as_uint(d[7]), false, false);
        const float q01 = __uint_as_float(s01[0]) + __uint_as_float(s01[1]), q23 = __uint_as_float(s23[0]) + __uint_as_float(s23[1]);
        const float q45 = __uint_as_float(s45[0]) + __uint_as_float(s45[1]), q67 = __uint_as_float(s67[0]) + __uint_as_float(s67[1]);
        auto ta = __builtin_amdgcn_permlane16_swap(__float_as_uint(q01), __float_as_uint(q23), false, false);
        auto tb = __builtin_amdgcn_permlane16_swap(__float_as_uint(q45), __float_as_uint(q67), false, false);
        const float r0123 = __uint_as_float(ta[0]) + __uint_as_float(ta[1]);
        const float r4567 = __uint_as_float(tb[0]) + __uint_as_float(tb[1]);
        const bool b3 = (lane & 8) != 0;
        const float keep = b3 ? r4567 : r0123, send = b3 ? r0123 : r4567;
        float x = keep + __shfl_xor(send, 8);
        x += __shfl_xor(x, 4); x += __shfl_xor(x, 2); x += __shfl_xor(x, 1);
        tot = x;
      }
      float ge;
      {
        const float v = tot, av = fabsf(v), tq = __builtin_amdgcn_rcpf(av * 0.2316418882f + 1.0f);
        float q = tq * 0.5307027145f + (-0.7265760135f); q = q * tq + 0.7107068705f; q = q * tq + (-0.142248368f); q = q * tq + 0.127414796f; q = q * tq;
        const float ex = __builtin_amdgcn_exp2f(v * v * (-0.72134752044f));
        const float m = v * (q * ex), r = v - m;
        ge = v < 0.f ? m : r;
      }
      float c[8];
      c[0] = __uint_as_float(__builtin_amdgcn_readlane(__float_as_uint(ge), 0)) * gwt[0];  c[4] = __uint_as_float(__builtin_amdgcn_readlane(__float_as_uint(ge), 8)) * gwt[4];
      c[2] = __uint_as_float(__builtin_amdgcn_readlane(__float_as_uint(ge), 16)) * gwt[2]; c[6] = __uint_as_float(__builtin_amdgcn_readlane(__float_as_uint(ge), 24)) * gwt[6];
      c[1] = __uint_as_float(__builtin_amdgcn_readlane(__float_as_uint(ge), 32)) * gwt[1]; c[5] = __uint_as_float(__builtin_amdgcn_readlane(__float_as_uint(ge), 40)) * gwt[5];
      c[3] = __uint_as_float(__builtin_amdgcn_readlane(__float_as_uint(ge), 48)) * gwt[3]; c[7] = __uint_as_float(__builtin_amdgcn_readlane(__float_as_uint(ge), 56)) * gwt[7];
#pragma unroll
      for (int i2 = 0; i2 < 4; ++i2) {
        i32x6 w6; w6[0] = (int)vq[2 * i2].x; w6[1] = (int)vq[2 * i2].y; w6[2] = (int)vq[2 * i2].z; w6[3] = (int)vq[2 * i2 + 1].x; w6[4] = (int)vq[2 * i2 + 1].y; w6[5] = (int)vq[2 * i2 + 1].z;
        const f32x32 r = __builtin_amdgcn_cvt_scalef32_pk32_f32_fp6(w6, 1.0f);
#pragma unroll
        for (int k = 0; k < 16; ++k) acc[k] += c[2 * i2] * r[k] + c[2 * i2 + 1] * r[16 + k];
        asm volatile("" : "+v"(acc[0]), "+v"(acc[1]), "+v"(acc[2]), "+v"(acc[3]), "+v"(acc[4]), "+v"(acc[5]), "+v"(acc[6]), "+v"(acc[7]), "+v"(acc[8]), "+v"(acc[9]), "+v"(acc[10]), "+v"(acc[11]), "+v"(acc[12]), "+v"(acc[13]), "+v"(acc[14]), "+v"(acc[15]));
      }
    }
    }
    SBAR();
    const int mr = mod_row(row);
    const float* g2 = MOD + ((size_t)l * 5 + mr) * 6144 + 5 * 1024;
    float* xr = XC + (size_t)row * DM;
    float xn[16]; float ssq = 0.f;
    if (ABL & 8) {
#pragma unroll
      for (int i = 0; i < 16; ++i) acc[i] = 0.f;
    }
#pragma unroll
    for (int v4 = 0; v4 < 4; ++v4) {
      const int c = lane * 16 + v4 * 4;
      const f32x4 xo = xpre[v4], gg = *(const f32x4*)(g2 + c);
      f32x4 o;
      o.x = xo.x + gg.x * acc[v4 * 4 + 0]; o.y = xo.y + gg.y * acc[v4 * 4 + 1]; o.z = xo.z + gg.z * acc[v4 * 4 + 2]; o.w = xo.w + gg.w * acc[v4 * 4 + 3];
      xn[v4 * 4 + 0] = o.x; xn[v4 * 4 + 1] = o.y; xn[v4 * 4 + 2] = o.z; xn[v4 * 4 + 3] = o.w;
      ssq += (o.x * o.x + o.y * o.y) + (o.z * o.z + o.w * o.w);
      if (l < DEPTH - 1) *(f32x4*)(xr + c) = o;
    }
    const float rs = rsqrtf(wave_sum(ssq) * (1.f / DM) + EPS);
    if (l == DEPTH - 1) {
      const int b = row / SEGL, s = row - b * SEGL;
      float* orow = p.out + ((size_t)(b * SEQ + (s - CTXL))) * DM;
      const float* fg = p.in[I_FINALG];
#pragma unroll
      for (int v4 = 0; v4 < 4; ++v4) {
        const int c = lane * 16 + v4 * 4;
        const f32x4 gg = *(const f32x4*)(fg + c);
        f32x4 o; o.x = xn[v4 * 4 + 0] * rs * gg.x; o.y = xn[v4 * 4 + 1] * rs * gg.y; o.z = xn[v4 * 4 + 2] * rs * gg.z; o.w = xn[v4 * 4 + 3] * rs * gg.w;
        *(f32x4*)(orow + c) = o;
      }
    } else {
      const float* m = MOD + ((size_t)(l + 1) * 5 + mr) * 6144;
      const float* ng = p.in[I_N1G] + (l + 1) * DM;
      bf16_t* hrow = (bf16_t*)(p.ws + WS_H) + (size_t)row * DM;
#pragma unroll
      for (int hh = 0; hh < 2; ++hh) {
        float y[8];
#pragma unroll
        for (int i = 0; i < 8; ++i) { const int c = lane * 16 + hh * 8 + i; y[i] = xn[hh * 8 + i] * rs * ng[c] * (1.f + m[1024 + c]) + m[c]; }
        u32x4 w; w.x = cvtpk(y[0], y[1]); w.y = cvtpk(y[2], y[3]); w.z = cvtpk(y[4], y[5]); w.w = cvtpk(y[6], y[7]);
        *(u32x4*)(hrow + lane * 16 + hh * 8) = w;
      }
    }
  }
}

__device__ __forceinline__ void phase_c1(const Params& p, int l, unsigned char* lds) {
  constexpr int NLOC = NBATCH * 4 * NCH, NCONV = T / 32;
  for (int u = p.bx; u < NLOC + NCONV; u += p.gx) {
    if (u < NLOC) ml_local_unit2(p, l, u, lds);
    else {
      const int cu = u - NLOC;
      if (l == DEPTH - 1 && (cu % (SEGL / 32)) < (CTXL / 32)) continue;
      conv_unit(p, l, cu, lds);
    }
  }
}
__device__ __forceinline__ void phase_c2(const Params& p, int l, unsigned char* lds) {
  ml_scan(p, lds);
  const float* lp = p.in[I_DLAM] + l * 256;
  float s01 = 0.f, s23 = 0.f;
  for (int i = 0; i < 64; ++i) { s01 += lp[i] * lp[64 + i]; s23 += lp[128 + i] * lp[192 + i]; }
  const float lam_init = 0.8f - 0.6f * expf(-0.3f * (float)l);
  const float lam = expf(s01) - expf(s23) + lam_init;
  const bf16_t* PROJ = (const bf16_t*)(p.ws + WS_PROJ);
  bf16_t* MIX = (bf16_t*)(p.ws + WS_MIX);
  const float* ng = p.in[I_DNORMG] + l * 128;
  const int nun = 512 + (l < DEPTH - 1 ? 16 : 0);
  for (int u = p.bx; u < nun; u += p.gx) {
    int bh, qrow, nkeys;
    if (u < 512) { const int xcd = u & 7, i = (u >> 3) & 31, rnd = u >> 8; bh = 2 * xcd + rnd; qrow = CTXL + i * 256; nkeys = SEGL; }
    else { bh = u - 512; qrow = 0; nkeys = CTXL; }
    const int b = bh >> 2, h = bh & 3;
    const size_t tok0 = (size_t)b * SEGL;
    for (int rep = 0; rep < REP_ATT; ++rep)
    att_unit(PROJ + (tok0 + qrow) * PW + C_DQ + h * 128, PROJ + tok0 * PW + C_DK + h * 128, p.ws + WS_V8T + (size_t)bh * NCH * ATT_SHM_V,
             MIX + (tok0 + qrow) * DM + 512 + h * 128, nkeys, lam, ng, 1.f - lam_init, lds);
  }
}
__device__ __forceinline__ void phase_c3(const Params& p, int l, unsigned char* lds) {
  constexpr int NU = NBATCH * 4 * NCH;
  for (int u = p.bx; u < NU; u += p.gx) {
    if (l == DEPTH - 1 && (u % NCH) < 4) continue;
    ml_out_unit2(p, l, u, lds);
  }
}
__device__ __forceinline__ void phase_route(const Params& p, int l, unsigned char* lds) {
  constexpr int NU = T / 32;
  for (int u = p.bx; u < NU; u += p.gx) {
    if (l == DEPTH - 1 && (u % (SEGL / 32)) < (CTXL / 32)) continue;
    route_unit(p, l, u, lds);
    __syncthreads();
  }
}
__device__ __forceinline__ void phase_gather(const Params& p, int l, unsigned char* lds) {
  int tid_ = threadIdx.x; asm volatile("" : "+v"(tid_)); const int lane = tid_ & 63, wid = tid_ >> 6;
  const int gw = p.bx * 8 + wid, NGW = p.gx * 8;
  const int ntok = (l == DEPTH - 1) ? NBATCH * SEQ : T;
#define TOKROW(ti_) ((l == DEPTH - 1) ? ((ti_) / SEQ) * SEGL + CTXL + ((ti_) % SEQ) : (ti_))
  TokPref tp;
  if (gw < ntok) tok_prefetch(p, TOKROW(gw), lane, tp);
  XcdBarrier xb; xb.bar = p.xbar_words; xb.x = p.xbar_x; xb.st = (volatile LAS unsigned*)((LAS unsigned char*)lds + p.lds_st_off);
  const int nrounds = (ntok + NGW - 1) / NGW;
  for (int r = 0; r < nrounds; ++r) {
    const int ti = gw + r * NGW;
    if (ti < ntok) {
      const int row = TOKROW(ti);
      const int nxt = ti + NGW < ntok ? TOKROW(ti + NGW) : -1;
      gather_token(p, l, row, nxt, tp, lds, lane, wid);
    }
#if GATHER_SYNC
    if (r + 1 < nrounds) { XcdBarrier xb2 = xb; size_t zb_ = 0; asm volatile("" : "+s"(zb_)); xb2.bar = xb.bar + zb_; xb2.x = xb.x + (unsigned)zb_; xcd_barrier(xb2); }
#endif
  }
#undef TOKROW
}

__global__ void __launch_bounds__(512, 2) mk_fwd(KArgs ka) {
  cg::grid_group grid = cg::this_grid();
  extern __shared__ __attribute__((aligned(16))) unsigned char lds[];
  const int lo = ka.ph_lo, hi = ka.ph_hi;
#define IN(k) (lo <= (k) && (k) < hi)
#ifndef PHASEMASK
#define PHASEMASK 0xFFFF
#endif
#define PH(i) ((PHASEMASK >> (i)) & 1)
#define MKP(q) Params q; { size_t z_ = 0; asm volatile("" : "+s"(z_)); \
    q.in = (InTab)((const __attribute__((address_space(4))) char*)__builtin_amdgcn_kernarg_segment_ptr() + z_); \
    q.out = ka.out + z_; q.ws = ka.ws + z_; q.ph_lo = lo; q.ph_hi = hi; q.bx = (int)blockIdx.x + (int)z_; q.gx = (int)gridDim.x + (int)z_; q.xbar_words = xbar.bar + z_; q.xbar_x = xbar.x + (unsigned)z_; q.lds_st_off = (unsigned)(LDS_BYTES - 64); }
#define SEAM(k) do { if (IN(k) && IN((k) + 1)) { if ((k) == 0) grid.sync(); else { XcdBarrier xb_ = xbar; size_t zb_ = 0; asm volatile("" : "+s"(zb_)); xb_.bar = xbar.bar + zb_; xb_.x = xbar.x + (unsigned)zb_; xcd_barrier(xb_); } } } while (0)
  volatile LAS unsigned* xst = (volatile LAS unsigned*)((LAS unsigned char*)lds + (LDS_BYTES - 64));
  if (threadIdx.x < 2) xst[threadIdx.x] = 0u;
  __syncthreads();
  XcdBarrier xbar = xcd_barrier_post((unsigned*)(ka.ws + WS_CTL) + 4096, xst);
  { MKP(p)
    if (PH(0) && IN(0)) for (int rep = 0; rep < REP_MISC; ++rep) { p0_mod(p, lds, (float*)(p.ws + WS_MOD)); p0_convert(p, lds); }
  }
  SEAM(0);
  { MKP(p)
    if (PH(1) && IN(1)) phase_norm(p, 0, 0, true, false);
  }
  SEAM(1);
#define LAYER(LL) { \
    int l = (LL); asm volatile("" : "+s"(l)); \
    const int b = 2 + 9 * (LL); \
    { MKP(q) if (PH(2) && IN(b + 0)) for (int rep = 0; rep < REP_GEMM; ++rep) phase_inproj2(q, l, lds); } \
    SEAM(b + 0); \
    { MKP(q) if (PH(3) && IN(b + 1)) for (int rep = 0; rep < REP_ML; ++rep) phase_c1(q, l, lds); } \
    SEAM(b + 1); \
    { MKP(q) if (PH(4) && IN(b + 2)) phase_c2(q, l, lds); } \
    SEAM(b + 2); \
    { MKP(q) if (PH(5) && IN(b + 3)) for (int rep = 0; rep < REP_ML; ++rep) phase_c3(q, l, lds); } \
    SEAM(b + 3); \
    { MKP(q) if (PH(6) && IN(b + 4)) phase_outproj2(q, l, lds); } \
    SEAM(b + 4); \
    { MKP(q) if (PH(7) && IN(b + 5)) for (int rep = 0; rep < REP_MISC; ++rep) phase_norm(q, l, 1, false, (LL) == DEPTH - 1); } \
    SEAM(b + 5); \
    { MKP(q) if (PH(8) && IN(b + 6)) for (int rep = 0; rep < REP_GEMM; ++rep) phase_peerq2(q, l, lds); } \
    SEAM(b + 6); \
    { MKP(q) if (PH(9) && IN(b + 7)) phase_route(q, l, lds); } \
    SEAM(b + 7); \
    { MKP(q) if (PH(9) && IN(b + 8)) phase_gather(q, l, lds); } \
    SEAM(b + 8); }
  LAYER(0) LAYER(1) LAYER(2) LAYER(3)
#undef LAYER
#undef IN
#undef SEAM
#undef MKP
}

extern "C" void kernel_launch(void* const* d_in, const int* in_sizes, int n_in, void* d_out, int out_size,
                              void* d_ws, size_t ws_size, hipStream_t stream) {
  static int grid = 0;
  if (grid == 0) {
    int dev = 0, cus = 0, per_cu = 0;
    (void)hipGetDevice(&dev);
    (void)hipDeviceGetAttribute(&cus, hipDeviceAttributeMultiprocessorCount, dev);
    (void)hipFuncSetAttribute((const void*)mk_fwd, hipFuncAttributeMaxDynamicSharedMemorySize, LDS_BYTES);
    (void)hipOccupancyMaxActiveBlocksPerMultiprocessor(&per_cu, (const void*)mk_fwd, 512, LDS_BYTES);
    fprintf(stderr, "kernel_launch: cus %d per_cu %d ws %zu (need %zu) n_in %d\n", cus, per_cu, ws_size, (size_t)WS_END, n_in);
    if (ws_size < WS_END || n_in != 23 || per_cu < 1) { fprintf(stderr, "kernel_launch: bad configuration, nothing launched\n"); grid = -1; return; }
    grid = cus;
  }
  if (grid < 0) return;
  (void)hipMemsetAsync((char*)d_ws + WS_CTL, 0, 65536, stream);
  KArgs p{};
  for (int i = 0; i < 23; ++i) p.in[i] = (const float*)d_in[i];
  p.out = (float*)d_out; p.ws = (unsigned char*)d_ws; p.ph_lo = 0; p.ph_hi = 38;
  void* args[] = {&p};
  hipError_t e = hipLaunchCooperativeKernel((const void*)mk_fwd, dim3(grid), dim3(512), args, LDS_BYTES, stream);
  if (e != hipSuccess) fprintf(stderr, "cooperative launch failed: %s (grid %d)\n", hipGetErrorString(e), grid);
}
```

```cpp
#include <hip/hip_runtime.h>
#include <hip/hip_cooperative_groups.h>
#include <cstdio>
#include <cstdint>
namespace cg = cooperative_groups;

constexpr int DM = 1024, NBATCH = 4, SEQ = 8192, CTXL = 256, SEGL = CTXL + SEQ, T = NBATCH * SEGL, DEPTH = 4;
constexpr int IN_W = 3088, PW = 3072;
constexpr int C_A = 0, C_MQ = 512, C_MK = 768, C_MV = 1024, C_MO = 1280, C_DQ = 1536, C_DK = 2048, C_DV = 2560;
constexpr int NCH = SEGL / 64;
constexpr int NEXP = 16384;
constexpr float EPS = 1e-6f;
#ifndef ABL
#define ABL 0
#endif
#ifndef GATHER_SYNC
#define GATHER_SYNC 0
#endif
#ifndef REP_ATT
#define REP_ATT 1
#endif
#ifndef REP_PEER
#define REP_PEER 1
#endif
#ifndef REP_GEMM
#define REP_GEMM 1
#endif
#ifndef REP_ROUTE
#define REP_ROUTE 1
#endif
#ifndef REP_OUTP
#define REP_OUTP 1
#endif
#ifndef REP_ML
#define REP_ML 1
#endif
#ifndef REP_MISC
#define REP_MISC 1
#endif
constexpr float QSCALE = 0.125f * 1.4426950408889634f;

constexpr size_t MiB = 1u << 20;
constexpr size_t WS_CTL = 0, WS_MOD = 1 * MiB, WS_ROPE = 2 * MiB, WS_WG = 4 * MiB, WS_KEYS = 5 * MiB, WS_MLMETA = 6 * MiB,
                 WS_GATES = 7 * MiB, WS_WIN = 10 * MiB, WS_WOUT = 34 * MiB, WS_WQ = 42 * MiB, WS_PU = 50 * MiB, WS_PV = 114 * MiB, WS_PSC = 178 * MiB  ,
                 WS_XCUR = 306 * MiB, WS_H = 438 * MiB, WS_MIX = 504 * MiB, WS_PROJ = 570 * MiB, WS_ULOC = 768 * MiB, WS_V8T = 836 * MiB  , WS_END = 858 * MiB;
constexpr int USTRIDE = 4160;

constexpr int LDS_BYTES = 139264;

#define LAS __attribute__((address_space(3)))
typedef unsigned short bf16_t;
typedef short bf16x8 __attribute__((ext_vector_type(8)));
typedef short s16x4 __attribute__((ext_vector_type(4)));
typedef float f32x4 __attribute__((ext_vector_type(4)));
typedef float f32x16 __attribute__((ext_vector_type(16)));
typedef unsigned u32x4 __attribute__((ext_vector_type(4)));
typedef unsigned u32x2 __attribute__((ext_vector_type(2)));
typedef __bf16 bf16x2v __attribute__((ext_vector_type(2)));
typedef int i32x8 __attribute__((ext_vector_type(8)));
typedef int i32x6 __attribute__((ext_vector_type(6)));
struct __attribute__((aligned(4))) u32x3 { unsigned x, y, z; };
typedef float f32x32 __attribute__((ext_vector_type(32)));
constexpr int PROW = 768;
typedef float f32x2 __attribute__((ext_vector_type(2)));

struct KArgs {
  const float* in[23];
  float* out;
  unsigned char* ws;
  int ph_lo, ph_hi;
};
typedef const float* const __attribute__((address_space(4))) * InTab;
struct Params {
  InTab in;
  float* out;
  unsigned char* ws;
  int ph_lo, ph_hi;
  int bx, gx;
  unsigned* xbar_words; unsigned xbar_x; unsigned lds_st_off;
};
enum { I_X = 0, I_C, I_CTX, I_CCTX, I_ADAW, I_ADAB, I_N1G, I_N2G, I_WIN, I_CONVW, I_CONVB, I_CLNG, I_CLNB, I_GATEB, I_MNORMG, I_DLAM, I_DNORMG,
       I_WOUT, I_PWQ, I_PKEYS, I_PU, I_PV, I_FINALG };

__device__ __forceinline__ unsigned cvtpk(float lo, float hi) { unsigned r; asm volatile("v_cvt_pk_bf16_f32 %0, %1, %2" : "=v"(r) : "v"(lo), "v"(hi)); return r; }
__device__ __forceinline__ float bflo(unsigned u) { return __uint_as_float(u << 16); }
__device__ __forceinline__ float bfhi(unsigned u) { return __uint_as_float(u & 0xffff0000u); }
__device__ __forceinline__ float bf1(bf16_t u) { return __uint_as_float(((unsigned)u) << 16); }
__device__ __forceinline__ int crow(int r, int hi) { return (r & 3) + 8 * (r >> 2) + 4 * hi; }
template <int CTRL> __device__ __forceinline__ float dpp_mov(float v) {
  return __uint_as_float((unsigned)__builtin_amdgcn_update_dpp(0, (int)__float_as_uint(v), CTRL, 0xF, 0xF, true));
}
__device__ __forceinline__ float wave_sum(float v) {
#pragma unroll
  for (int o = 1; o < 64; o <<= 1) v += __shfl_xor(v, o);
  return v;
}
__device__ __forceinline__ float wave_max(float v) {
#pragma unroll
  for (int o = 1; o < 64; o <<= 1) v = fmaxf(v, __shfl_xor(v, o));
  return v;
}
__device__ __forceinline__ float sigmoidf_(float x) { return 1.f / (1.f + __expf(-x)); }
__device__ __forceinline__ float logsigmoidf_(float x) { return fminf(x, 0.f) - log1pf(__expf(-fabsf(x))); }
__device__ __forceinline__ const float* in_row(const float* x, const float* ctx, int row) {
  const int b = row / SEGL, s = row - b * SEGL;
  return s < CTXL ? ctx + ((size_t)(b * CTXL + s)) * DM : x + ((size_t)(b * SEQ + (s - CTXL))) * DM;
}
__device__ __forceinline__ int mod_row(int row) { const int b = row / SEGL, s = row - b * SEGL; return s < CTXL ? 4 : b; }

__device__ __forceinline__ void p0_mod(const Params& p, unsigned char* lds, float* MOD) {
  float* sil = (float*)lds;
  float* red = (float*)(lds + 20480);
  int tid_ = threadIdx.x; asm volatile("" : "+v"(tid_)); const int tid = tid_, lane = tid & 63, wid = tid >> 6;
  for (int i = tid; i < 5 * 1024; i += 512) {
    const float v = i < 4096 ? p.in[I_C][i] : p.in[I_CCTX][i - 4096];
    sil[i] = v / (1.f + __expf(-v));
  }
  __syncthreads();
  for (int item = p.bx; item < DEPTH * 96; item += p.gx) {
    const int l = item / 96, j0 = (item % 96) * 64;
    const float* W = p.in[I_ADAW] + (size_t)l * DM * 6144 + j0 + lane;
    float a0 = 0.f, a1 = 0.f, a2 = 0.f, a3 = 0.f, a4 = 0.f;
    const int k0 = wid * 128;
#pragma unroll 8
    for (int k = k0; k < k0 + 128; ++k) {
      const float w = W[(size_t)k * 6144];
      a0 += sil[k] * w; a1 += sil[1024 + k] * w; a2 += sil[2048 + k] * w; a3 += sil[3072 + k] * w; a4 += sil[4096 + k] * w;
    }
    red[(wid * 5 + 0) * 64 + lane] = a0; red[(wid * 5 + 1) * 64 + lane] = a1; red[(wid * 5 + 2) * 64 + lane] = a2;
    red[(wid * 5 + 3) * 64 + lane] = a3; red[(wid * 5 + 4) * 64 + lane] = a4;
    __syncthreads();
    if (tid < 320) {
      const int r = tid >> 6;
      float s = 0.f;
#pragma unroll
      for (int w = 0; w < 8; ++w) s += red[(w * 5 + r) * 64 + lane];
      MOD[((size_t)l * 5 + r) * 6144 + j0 + lane] = s + p.in[I_ADAB][l * 6144 + j0 + lane];
    }
    __syncthreads();
  }
}
__device__ __forceinline__ void transpose_item(const float* W, int ldw, int srccol0, bf16_t* WT, int K, int n0, int k0, float* scr, int lane) {
#pragma unroll 8
  for (int i = 0; i < 32; ++i) { const int kk = 2 * i + (lane >> 5); scr[kk * 33 + (lane & 31)] = W[(size_t)(k0 + kk) * ldw + srccol0 + (lane & 31)]; }
  asm volatile("s_waitcnt lgkmcnt(0)" ::: "memory");
  const int c = lane & 7;
#pragma unroll
  for (int j = 0; j < 4; ++j) {
    const int n = (lane >> 3) + 8 * j; const float* s = scr + (8 * c) * 33 + n;
    u32x4 o; o.x = cvtpk(s[0], s[33]); o.y = cvtpk(s[66], s[99]); o.z = cvtpk(s[132], s[165]); o.w = cvtpk(s[198], s[231]);
    *(u32x4*)(WT + (size_t)(n0 + n) * K + k0 + 8 * c) = o;
  }
  asm volatile("s_waitcnt lgkmcnt(0)" ::: "memory");
}
__device__ __forceinline__ void convert_tables(const Params& p, int L, int wv, int nw, int lane) {
  unsigned char* PUq = p.ws + WS_PU; unsigned char* PVq = p.ws + WS_PV; float* PSC = (float*)(p.ws + WS_PSC);
  const int nrows = DEPTH * NEXP;
  for (int r = wv; r < 2 * NEXP; r += nw) {
    const int tb = r >= NEXP, rr = L * NEXP + (tb ? r - NEXP : r);
    const f32x4* srow = (const f32x4*)((tb ? p.in[I_PV] : p.in[I_PU]) + (size_t)rr * DM) + lane * 4;
    f32x4 v[4]; float mx = 0.f;
#pragma unroll
    for (int j = 0; j < 4; ++j) { v[j] = __builtin_nontemporal_load(srow + j); mx = fmaxf(mx, fmaxf(fmaxf(fabsf(v[j].x), fabsf(v[j].y)), fmaxf(fabsf(v[j].z), fabsf(v[j].w)))); }
    mx = wave_max(mx);
    const unsigned mb = __float_as_uint(mx);
    const int eb = (int)((mb >> 23) & 0xFFu);
    int sb = ((mb & 0x7FFFFFu) <= 0x700000u ? 129 : 128) - eb + 127; sb = sb < 1 ? 1 : (sb > 253 ? 253 : sb);
    const float sc = __uint_as_float((unsigned)sb << 23), isc = __uint_as_float((unsigned)(254 - sb) << 23);
    const float xv[16] = {v[0].x, v[0].y, v[0].z, v[0].w, v[1].x, v[1].y, v[1].z, v[1].w, v[2].x, v[2].y, v[2].z, v[2].w, v[3].x, v[3].y, v[3].z, v[3].w};
    unsigned wq[3] = {0u, 0u, 0u};
#pragma unroll
    for (int i = 0; i < 16; ++i) {
      const float a = fabsf(xv[i]) * sc;
      unsigned code = a < 2.f ? (unsigned)__builtin_rintf(a * 8.f) : (a < 4.f ? 8u + (unsigned)__builtin_rintf(a * 4.f) : 16u + (unsigned)__builtin_rintf(a * 2.f));
      code = code > 31u ? 31u : code;
      code |= (xv[i] < 0.f) ? 32u : 0u;
      const int bp = 6 * i, dw = bp >> 5, off = bp & 31;
      wq[dw] |= code << off;
      if (off > 26) wq[dw + 1] |= code >> (32 - off);
    }
    u32x3 o; o.x = wq[0]; o.y = wq[1]; o.z = wq[2];
    *(u32x3*)((tb ? PVq : PUq) + (size_t)rr * PROW + lane * 12) = o;
    if (lane == 0) PSC[(size_t)tb * nrows + rr] = isc;
  }
}
__device__ __forceinline__ void tail_filler_tables(const Params& p, int L, int nwg) {
  int tid_ = threadIdx.x; asm volatile("" : "+v"(tid_)); const int lane = tid_ & 63, wid = tid_ >> 6;
  const int nextra = nwg % p.gx, first = nextra, nidle = p.gx - nextra;
  if (p.bx < first) return;
  convert_tables(p, L, (p.bx - first) * 8 + wid, nidle * 8, lane);
}
__device__ __forceinline__ void p0_convert(const Params& p, unsigned char* lds) {
  int tid_ = threadIdx.x; asm volatile("" : "+v"(tid_)); const int tid = tid_, lane = tid & 63, wid = tid >> 6;
  const int gw = p.bx * 8 + wid, NGW = p.gx * 8;
  const size_t gt = (size_t)p.bx * 512 + tid, NGT = (size_t)p.gx * 512;
  float* scr = (float*)(lds + 32768) + wid * (64 * 33);
  bf16_t* WIN = (bf16_t*)(p.ws + WS_WIN); bf16_t* WOUT = (bf16_t*)(p.ws + WS_WOUT); bf16_t* WQ = (bf16_t*)(p.ws + WS_WQ);
  constexpr int I_IN = 16 * 96, I_O = 16 * 32, PER_L = I_IN + 2 * I_O;
  for (int it = gw; it < DEPTH * PER_L; it += NGW) {
    const int l = it / PER_L; int r = it % PER_L;
    if (r < I_IN) { const int kb = r / 96, nb = r % 96, n0 = nb * 32; const int src = n0 < 1536 ? n0 : n0 + 16;
      transpose_item(p.in[I_WIN] + (size_t)l * DM * IN_W, IN_W, src, WIN + (size_t)l * PW * DM, DM, n0, kb * 64, scr, lane); continue; }
    r -= I_IN;
    if (r < I_O) { const int kb = r / 32, nb = r % 32;
      transpose_item(p.in[I_WOUT] + (size_t)l * DM * DM, DM, nb * 32, WOUT + (size_t)l * DM * DM, DM, nb * 32, kb * 64, scr, lane); continue; }
    r -= I_O;
    { const int kb = r / 32, nb = r % 32;
      transpose_item(p.in[I_PWQ] + (size_t)l * DM * DM, DM, nb * 32, WQ + (size_t)l * DM * DM, DM, nb * 32, kb * 64, scr, lane); }
  }
  bf16_t* WG = (bf16_t*)(p.ws + WS_WG);
  for (size_t i = gt; i < (size_t)DEPTH * 16 * DM; i += NGT) {
    const int l = (int)(i / (16 * DM)), g = (int)((i / DM) % 16), k = (int)(i % DM);
    WG[i] = (bf16_t)(cvtpk(p.in[I_WIN][(size_t)l * DM * IN_W + (size_t)k * IN_W + 1536 + g], 0.f) & 0xffffu);
  }
  bf16_t* KEYS = (bf16_t*)(p.ws + WS_KEYS);
  for (size_t i = gt; i < (size_t)DEPTH * 131072 / 8; i += NGT) {
    const f32x4 a = ((const f32x4*)p.in[I_PKEYS])[2 * i], b = ((const f32x4*)p.in[I_PKEYS])[2 * i + 1];
    u32x4 o; o.x = cvtpk(a.x, a.y); o.y = cvtpk(a.z, a.w); o.z = cvtpk(b.x, b.y); o.w = cvtpk(b.z, b.w);
    ((u32x4*)KEYS)[i] = o;
  }
  {
    float* RC = (float*)(p.ws + WS_ROPE); float* RS = RC + SEQ * 32;
    for (size_t i = gt; i < (size_t)SEQ * 32; i += NGT) {
      const int pos = (int)(i >> 5), j = (int)(i & 31);
      const int rr = pos >> 6, cc = pos & 63;
      const int jj = j & 15;
      const double e = -(double)jj * 0.83048202372184058696;
      const double fl = __builtin_floor(e); const double f = e - fl;
      const double z = f * 0.69314718055994530942;
      double ez = 1.0 + z * (1.0 + z * (0.5 + z * (1.0 / 6 + z * (1.0 / 24 + z * (1.0 / 120 + z * (1.0 / 720 + z * (1.0 / 5040 + z * (1.0 / 40320 + z * (1.0 / 362880 + z * (1.0 / 3628800 + z * (1.0 / 39916800 + z * (1.0 / 479001600))))))))))));
      const double inv = __builtin_ldexp(ez, (int)fl);
      const float invf = (float)inv;
      const float angf = (float)(j < 16 ? rr : cc) * invf;
      const double ang = (double)angf;
      const double kq = __builtin_rint(ang * 0.63661977236758134308);
      double r = __builtin_fma(-kq, 1.57079632679489655800e+00, ang);
      r = __builtin_fma(-kq, 6.12323399573676603587e-17, r);
      const double r2 = r * r;
      const double sn = r * (1.0 + r2 * (-1.0 / 6 + r2 * (1.0 / 120 + r2 * (-1.0 / 5040 + r2 * (1.0 / 362880 + r2 * (-1.0 / 39916800 + r2 * (1.0 / 6227020800.0)))))));
      const double cs = 1.0 + r2 * (-0.5 + r2 * (1.0 / 24 + r2 * (-1.0 / 720 + r2 * (1.0 / 40320 + r2 * (-1.0 / 3628800 + r2 * (1.0 / 479001600 + r2 * (-1.0 / 87178291200.0)))))));
      const int q = ((int)kq) & 3;
      double co, si;
      if (q == 0) { co = cs; si = sn; } else if (q == 1) { co = -sn; si = cs; } else if (q == 2) { co = -cs; si = -sn; } else { co = sn; si = -cs; }
      RC[i] = (float)co; RS[i] = (float)si;
    }
  }
}

__device__ __forceinline__ void norm_mod_row(const float* xrow, const float* g, const float* sc, const float* sh, bf16_t* orow, int lane) {
  const f32x4* xr = (const f32x4*)xrow + lane;
  f32x4 v[4]; float s = 0.f;
#pragma unroll
  for (int j = 0; j < 4; ++j) { v[j] = xr[64 * j]; s += (v[j].x * v[j].x + v[j].y * v[j].y) + (v[j].z * v[j].z + v[j].w * v[j].w); }
  const float rs = rsqrtf(wave_sum(s) * (1.f / DM) + EPS);
  u32x2* o = (u32x2*)orow + lane;
#pragma unroll
  for (int j = 0; j < 4; ++j) {
    const f32x4 gg = ((const f32x4*)g)[lane + 64 * j], cc = ((const f32x4*)sc)[lane + 64 * j], hh = ((const f32x4*)sh)[lane + 64 * j];
    const float y0 = v[j].x * rs * gg.x * (1.f + cc.x) + hh.x, y1 = v[j].y * rs * gg.y * (1.f + cc.y) + hh.y;
    const float y2 = v[j].z * rs * gg.z * (1.f + cc.z) + hh.z, y3 = v[j].w * rs * gg.w * (1.f + cc.w) + hh.w;
    u32x2 w; w.x = cvtpk(y0, y1); w.y = cvtpk(y2, y3);
    o[64 * j] = w;
  }
}
__device__ __forceinline__ void phase_norm(const Params& p, int l, int which, bool from_input, bool skip_ctx) {
  int tid_ = threadIdx.x; asm volatile("" : "+v"(tid_));
  const int lane = tid_ & 63, wid = tid_ >> 6;
  const int gw = p.bx * 8 + wid, NGW = p.gx * 8;
  const float* MOD = (const float*)(p.ws + WS_MOD);
  const float* XC = (const float*)(p.ws + WS_XCUR);
  bf16_t* H = (bf16_t*)(p.ws + WS_H);
  const float* g = p.in[which ? I_N2G : I_N1G] + l * DM;
  for (int row = gw; row < T; row += NGW) {
    const int mr = mod_row(row);
    if (skip_ctx && mr == 4) continue;
    const float* m = MOD + ((size_t)l * 5 + mr) * 6144 + which * 3072;
    const float* xr = from_input ? in_row(p.in[I_X], p.in[I_CTX], row) : XC + (size_t)row * DM;
    norm_mod_row(xr, g, m + 1024, m, H + (size_t)row * DM, lane);
  }
}

namespace pg8 {
#define PG8_LAS __attribute__((address_space(3)))
typedef unsigned short bf16_t;
typedef short bf16x8 __attribute__((ext_vector_type(8)));
typedef float f32x4 __attribute__((ext_vector_type(4)));
typedef unsigned u32x4 __attribute__((ext_vector_type(4)));
constexpr int BM = 256, BK = 64, HALF = 128, HTB = HALF * BK * 2  , STAGE_BYTES = 8 * HTB, NXCD = 8, WGM = 8;

__host__ __device__ __forceinline__ int lds_byte(int r, int c) { const int st = (r >> 4) * 2 + (c >> 5), rr = r & 15, cc = c & 31, ob = rr * 64 + cc * 2; return st * 1024 + (ob ^ (((ob >> 9) & 1) << 5)); }
__host__ __device__ __forceinline__ void stage_rc(int b, int& R, int& C) { const int st = b / 1024, sb = b % 1024, swz = sb ^ (((sb >> 9) & 1) << 5); R = (st >> 1) * 16 + swz / 64; C = (st & 1) * 32 + (swz % 64) / 2; }
__host__ __device__ __forceinline__ int perm32(int rho) { const int n = rho >> 4, i = rho & 15; return 8 * (i >> 2) + 4 * n + (i & 3); }

struct Unit { int pm, pn; };
struct Gemm { const bf16_t* A; const bf16_t* Bt; int M, N, K; };

struct StaticOrder {
    int nM, nN, nwg, G, c;
    __host__ __device__ void init(int M, int N, int G_, int c_) { nM = M / BM; nN = N / BM; nwg = nM * nN; G = G_; c = c_; }
    __host__ __device__ bool next(int i, Unit& u) const {
        const long L = (long)i * G + c; if (L >= nwg) return false;
        int wgid = (int)L; { const int q = nwg / NXCD, r = nwg % NXCD, xcd = wgid % NXCD, off = wgid / NXCD; wgid = (xcd < r ? xcd * (q + 1) : r * (q + 1) + (xcd - r) * q) + off; }
        const int nig = WGM * nN, gid = wgid / nig, fm = gid * WGM, gsz = (nM - fm) < WGM ? (nM - fm) : WGM;
        u.pm = fm + ((wgid % nig) % gsz); u.pn = (wgid % nig) / gsz; return true;
    }
    __device__ __forceinline__ void a_ready(const Unit&) const {}
    __device__ __forceinline__ void done(const Unit&) const {}
};
__device__ __forceinline__ unsigned cvt_pk_bf16(float lo, float hi) { unsigned r; asm volatile("v_cvt_pk_bf16_f32 %0, %1, %2" : "=v"(r) : "v"(lo), "v"(hi)); return r; }
template <class Epi, class Sched, bool ALIGN_EPI = false, bool SP2 = false>
__device__ __forceinline__ void gemm_phase(PG8_LAS unsigned char* lds, const Gemm g, const Sched& S, const Epi& E) {
    const int tid = threadIdx.x, wid = __builtin_amdgcn_readfirstlane(tid >> 6), lane = tid & 63, wr = wid >> 2, wc = wid & 3, fr = lane & 15, fq = lane >> 4;
    const int K = g.K, nt = K / BK;
    unsigned voffA[2], voffB[2];
#pragma unroll
    for (int i = 0; i < 2; ++i) { int R, C; stage_rc(tid * 16 + i * 8192, R, C); const int Rb = Epi::PERM ? ((R & ~31) + perm32(R & 31)) : R;
        voffA[i] = (unsigned)(R * K + C) * 2u; voffB[i] = (unsigned)(Rb * K + C) * 2u; }
    const size_t kstep = (size_t)(BK * 2);
    const size_t hstep = (size_t)HALF * K * 2;
    const size_t tstep = 2 * hstep;
    const unsigned ldsw = (unsigned)wid * 1024u;
    const int aoff = lds_byte(wr * 64 + fr, fq * 8), boff = lds_byte(wc * 32 + fr, fq * 8);
#define PG8_SA(b, h) (((b) * 2 + (h)) * HTB)
#define PG8_SB(b, h) ((4 + (b) * 2 + (h)) * HTB)
#define PG8_STAGE(bufoff, gbase, voff) do { _Pragma("unroll") for (int _i = 0; _i < 2; ++_i) \
        __builtin_amdgcn_global_load_lds((const unsigned*)((const char*)(gbase) + (voff)[_i]), (PG8_LAS unsigned*)(lds + (bufoff) + ldsw + _i * 8192), 16, 0, 0); } while (0)
#define PG8_LDA(dst, b, h) do { _Pragma("unroll") for (int m = 0; m < 4; ++m) _Pragma("unroll") for (int k = 0; k < 2; ++k) dst[m][k] = *(const PG8_LAS bf16x8*)(lds + PG8_SA(b, h) + aoff + m * 2048 + k * 1024); } while (0)
#define PG8_LDB(dst, b, h) do { _Pragma("unroll") for (int n = 0; n < 2; ++n) _Pragma("unroll") for (int k = 0; k < 2; ++k) dst[n][k] = *(const PG8_LAS bf16x8*)(lds + PG8_SB(b, h) + boff + n * 2048 + k * 1024); } while (0)
#define PG8_MMA(ai, bj, At, Bt) do { __builtin_amdgcn_s_setprio(1); _Pragma("unroll") for (int m = 0; m < 4; ++m) _Pragma("unroll") for (int n = 0; n < 2; ++n) _Pragma("unroll") for (int k = 0; k < 2; ++k) \
        acc[ai][bj][m][n] = __builtin_amdgcn_mfma_f32_16x16x32_bf16(Bt[n][k], At[m][k], acc[ai][bj][m][n], 0, 0, 0); __builtin_amdgcn_s_setprio(0); } while (0)
#define PG8_WAIT_V(n) asm volatile("s_waitcnt vmcnt(" #n ")" ::: "memory")
#define PG8_WAIT_L(n) asm volatile("s_waitcnt lgkmcnt(" #n ")" ::: "memory")
#define PG8_BAR __builtin_amdgcn_s_barrier()
#define PG8_SCHED __builtin_amdgcn_sched_barrier(0)
    Unit cur, nxt; int ui = 0;
    if (!S.next(0, cur)) return;
    f32x4 acc[2][2][4][2];
#pragma unroll
    for (int a = 0; a < 2; ++a)
#pragma unroll
        for (int b = 0; b < 2; ++b)
#pragma unroll
            for (int m = 0; m < 4; ++m)
#pragma unroll
                for (int n = 0; n < 2; ++n) acc[a][b][m][n] = (f32x4){0.f, 0.f, 0.f, 0.f};
    bf16x8 At[4][2], B0[2][2], B1[2][2];
    const char* cA = (const char*)g.A + (size_t)cur.pm * tstep; const char* cB = (const char*)g.Bt + (size_t)cur.pn * tstep;
    S.a_ready(cur);
    if constexpr (SP2) {
        PG8_STAGE(PG8_SB(0, 0), cB, voffB); PG8_STAGE(PG8_SB(0, 1), cB + hstep, voffB); PG8_STAGE(PG8_SA(0, 0), cA, voffA); PG8_STAGE(PG8_SA(0, 1), cA + hstep, voffA);
        if (wr == 1) PG8_BAR;
        PG8_WAIT_V(2); PG8_BAR;
        PG8_STAGE(PG8_SB(1, 0), cB + kstep, voffB); PG8_STAGE(PG8_SA(1, 0), cA + kstep, voffA); PG8_STAGE(PG8_SB(1, 1), cB + hstep + kstep, voffB);
        PG8_WAIT_V(6); PG8_BAR;
    } else {
        PG8_STAGE(PG8_SB(0, 0), cB, voffB); PG8_STAGE(PG8_SA(0, 0), cA, voffA); PG8_STAGE(PG8_SB(0, 1), cB + hstep, voffB); PG8_STAGE(PG8_SA(0, 1), cA + hstep, voffA);
        if (wr == 1) PG8_BAR;
        PG8_WAIT_V(4); PG8_BAR;
        PG8_STAGE(PG8_SB(1, 0), cB + kstep, voffB); PG8_STAGE(PG8_SA(1, 0), cA + kstep, voffA); PG8_STAGE(PG8_SB(1, 1), cB + hstep + kstep, voffB);
        PG8_WAIT_V(6); PG8_BAR;
    }
    for (;;) {
        const bool has_next = S.next(ui + 1, nxt);
        const char* nA = has_next ? (const char*)g.A + (size_t)nxt.pm * tstep : cA; const char* nB = has_next ? (const char*)g.Bt + (size_t)nxt.pn * tstep : cB;
        for (int t = 0; t < nt; t += 2) {
            const bool last = (t == nt - 2);
            const char* a1 = cA + (size_t)(t + 1) * kstep;
            const char* a2 = last ? nA : cA + (size_t)(t + 2) * kstep; const char* b2 = last ? nB : cB + (size_t)(t + 2) * kstep;
            const char* a3 = a2 + kstep; const char* b3 = b2 + kstep;
            if (last && has_next) S.a_ready(nxt);
            if constexpr (SP2) {
            PG8_LDB(B0, 0, 0); PG8_LDB(B1, 0, 1); PG8_SCHED; PG8_LDA(At, 0, 0); PG8_STAGE(PG8_SA(1, 1), a1 + hstep, voffA);
            PG8_WAIT_V(8); PG8_WAIT_L(0); PG8_BAR; PG8_MMA(0, 0, At, B0); PG8_MMA(0, 1, At, B1); PG8_BAR; PG8_SCHED;
            PG8_LDA(At, 0, 1); PG8_STAGE(PG8_SB(0, 0), b2, voffB); PG8_STAGE(PG8_SB(0, 1), b2 + hstep, voffB); PG8_STAGE(PG8_SA(0, 0), a2, voffA);
            PG8_WAIT_V(8); PG8_WAIT_L(0); PG8_BAR; PG8_MMA(1, 0, At, B0); PG8_MMA(1, 1, At, B1); PG8_BAR; PG8_SCHED;
            PG8_LDB(B0, 1, 0); PG8_LDB(B1, 1, 1); PG8_SCHED; PG8_LDA(At, 1, 0); PG8_STAGE(PG8_SA(0, 1), a2 + hstep, voffA);
            PG8_WAIT_V(8); PG8_WAIT_L(0); PG8_BAR; PG8_MMA(0, 0, At, B0); PG8_MMA(0, 1, At, B1); PG8_BAR; PG8_SCHED;
            PG8_LDA(At, 1, 1); PG8_STAGE(PG8_SB(1, 0), b3, voffB); PG8_STAGE(PG8_SB(1, 1), b3 + hstep, voffB); PG8_STAGE(PG8_SA(1, 0), a3, voffA);
            PG8_WAIT_V(8); PG8_WAIT_L(0); PG8_BAR; PG8_MMA(1, 0, At, B0); PG8_MMA(1, 1, At, B1); PG8_BAR; PG8_SCHED;
            } else {
            PG8_LDB(B0, 0, 0); PG8_SCHED; PG8_LDA(At, 0, 0); PG8_STAGE(PG8_SA(1, 1), a1 + hstep, voffA);
            PG8_WAIT_L(8); PG8_BAR; PG8_WAIT_L(0); PG8_MMA(0, 0, At, B0); PG8_BAR; PG8_SCHED;
            PG8_LDB(B1, 0, 1); PG8_STAGE(PG8_SB(0, 0), b2, voffB);
            PG8_BAR; PG8_WAIT_L(0); PG8_MMA(0, 1, At, B1); PG8_BAR;
            PG8_LDA(At, 0, 1); PG8_STAGE(PG8_SA(0, 0), a2, voffA);
            PG8_BAR; PG8_WAIT_L(0); PG8_MMA(1, 0, At, B0); PG8_BAR; PG8_SCHED;
            PG8_STAGE(PG8_SB(0, 1), b2 + hstep, voffB);
            PG8_WAIT_V(6); PG8_BAR; PG8_MMA(1, 1, At, B1); PG8_BAR;
            PG8_LDB(B0, 1, 0); PG8_SCHED; PG8_LDA(At, 1, 0); PG8_STAGE(PG8_SA(0, 1), a2 + hstep, voffA);
            PG8_WAIT_L(8); PG8_BAR; PG8_WAIT_L(0); PG8_MMA(0, 0, At, B0); PG8_BAR; PG8_SCHED;
            PG8_LDB(B1, 1, 1); PG8_STAGE(PG8_SB(1, 0), b3, voffB);
            PG8_BAR; PG8_WAIT_L(0); PG8_MMA(0, 1, At, B1); PG8_BAR;
            PG8_LDA(At, 1, 1); PG8_STAGE(PG8_SA(1, 0), a3, voffA);
            PG8_BAR; PG8_WAIT_L(0); PG8_MMA(1, 0, At, B0); PG8_BAR; PG8_SCHED;
            PG8_STAGE(PG8_SB(1, 1), b3 + hstep, voffB);
            PG8_WAIT_V(6); PG8_BAR; PG8_MMA(1, 1, At, B1); PG8_BAR;
            }
        }
        if constexpr (ALIGN_EPI) { if (wr == 0) PG8_BAR; }
        if constexpr (!Epi::AFTER_DRAIN) { E(acc, cur, wr, wc, fr, fq); S.done(cur); }
        if (!has_next) break;
#pragma unroll
        for (int a = 0; a < 2; ++a)
#pragma unroll
            for (int b = 0; b < 2; ++b)
#pragma unroll
                for (int m = 0; m < 4; ++m)
#pragma unroll
                    for (int n = 0; n < 2; ++n) acc[a][b][m][n] = (f32x4){0.f, 0.f, 0.f, 0.f};
        cur = nxt; cA = nA; cB = nB; ++ui;
        if constexpr (ALIGN_EPI) { if (wr == 1) PG8_BAR; }
    }
    PG8_WAIT_V(0);
    if constexpr (!ALIGN_EPI) { if (wr == 0) PG8_BAR; }
    PG8_BAR;
    if constexpr (Epi::AFTER_DRAIN) { E.fused(acc, cur, wr, wc, fr, fq, lds, wid, lane); S.done(cur); }
#undef PG8_SA
#undef PG8_SB
#undef PG8_STAGE
#undef PG8_LDA
#undef PG8_LDB
#undef PG8_MMA
#undef PG8_WAIT_V
#undef PG8_WAIT_L
#undef PG8_BAR
#undef PG8_SCHED
}
}

__device__ __forceinline__ int gswz(int row, int chunk) { return row * 128 + ((chunk ^ ((row >> 1) & 7)) << 4); }
__device__ __forceinline__ void gemm_tile(const bf16_t* __restrict__ A, int lda, const bf16_t* __restrict__ Bt, int ldb, int K,
                                          int row0, int col0, unsigned char* lds, f32x16 (&acc)[2][2]) {
  int tid_ = threadIdx.x; asm volatile("" : "+v"(tid_)); const int tid = tid_, lane = tid & 63, wid = tid >> 6, wm = wid >> 1, wn = wid & 1, r32 = lane & 31, hi = lane >> 5;
  unsigned char* As = lds; unsigned char* Bs = lds + 65536;
#pragma unroll
  for (int i = 0; i < 2; ++i)
#pragma unroll
    for (int j = 0; j < 2; ++j) acc[i][j] = f32x16{};
  const int lrow = tid >> 3, lc = tid & 7;
  const bf16_t* Ag = A + (size_t)(row0 + lrow) * lda + lc * 8;
  const bf16_t* Bg = Bt + (size_t)(col0 + lrow) * ldb + lc * 8;
  u32x4 ra[4], rb[2];
#pragma unroll
  for (int i = 0; i < 4; ++i) ra[i] = *(const u32x4*)(Ag + (size_t)(64 * i) * lda);
#pragma unroll
  for (int i = 0; i < 2; ++i) rb[i] = *(const u32x4*)(Bg + (size_t)(64 * i) * ldb);
#pragma unroll
  for (int i = 0; i < 4; ++i) *(u32x4*)(As + gswz(lrow + 64 * i, lc)) = ra[i];
#pragma unroll
  for (int i = 0; i < 2; ++i) *(u32x4*)(Bs + gswz(lrow + 64 * i, lc)) = rb[i];
  __syncthreads();
  const int nk = K / 64;
  for (int kt = 0; kt < nk; ++kt) {
    const int cur = kt & 1;
    if (kt + 1 < nk) {
#pragma unroll
      for (int i = 0; i < 4; ++i) ra[i] = *(const u32x4*)(Ag + (size_t)(64 * i) * lda + (kt + 1) * 64);
#pragma unroll
      for (int i = 0; i < 2; ++i) rb[i] = *(const u32x4*)(Bg + (size_t)(64 * i) * ldb + (kt + 1) * 64);
    }
    const unsigned char* Ac = As + cur * 32768; const unsigned char* Bc = Bs + cur * 16384;
#pragma unroll
    for (int kk = 0; kk < 4; ++kk) {
      bf16x8 af[2], bfr[2];
#pragma unroll
      for (int i = 0; i < 2; ++i) af[i] = *(const bf16x8*)(Ac + gswz(wm * 64 + i * 32 + r32, 2 * kk + hi));
#pragma unroll
      for (int j = 0; j < 2; ++j) bfr[j] = *(const bf16x8*)(Bc + gswz(wn * 64 + j * 32 + r32, 2 * kk + hi));
#pragma unroll
      for (int i = 0; i < 2; ++i)
#pragma unroll
        for (int j = 0; j < 2; ++j) acc[i][j] = __builtin_amdgcn_mfma_f32_32x32x16_bf16(af[i], bfr[j], acc[i][j], 0, 0, 0);
    }
    if (kt + 1 < nk) {
      unsigned char* An = As + (cur ^ 1) * 32768; unsigned char* Bn = Bs + (cur ^ 1) * 16384;
#pragma unroll
      for (int i = 0; i < 4; ++i) *(u32x4*)(An + gswz(lrow + 64 * i, lc)) = ra[i];
#pragma unroll
      for (int i = 0; i < 2; ++i) *(u32x4*)(Bn + gswz(lrow + 64 * i, lc)) = rb[i];
    }
    __syncthreads();
  }
}
__device__ __forceinline__ void pair_xchg(float v0, float v1, int lane, float& lo, float& hi2) {
  const bool odd = lane & 1;
  const float send = odd ? v0 : v1;
  const float recv = __shfl_xor(send, 1);
  lo = odd ? recv : v0; hi2 = odd ? v1 : recv;
}

__device__ __forceinline__ void phase_inproj(const Params& p, int l, unsigned char* lds) {
  int tid_ = threadIdx.x; asm volatile("" : "+v"(tid_)); const int tid = tid_, lane = tid & 63, wid = tid >> 6, wm = wid >> 1, wn = wid & 1, r32 = lane & 31, hi = lane >> 5;
  const bf16_t* H = (const bf16_t*)(p.ws + WS_H);
  const bf16_t* W = (const bf16_t*)(p.ws + WS_WIN) + (size_t)l * PW * DM;
  bf16_t* PROJ = (bf16_t*)(p.ws + WS_PROJ);
  const float* RC = (const float*)(p.ws + WS_ROPE); const float* RS = RC + SEQ * 32;
  constexpr int NM = T / 256, NN = PW / 128, NU = NM * NN;
  for (int u = p.bx; u < NU + NM; u += p.gx) {
    if (u < NU) {
      const int pn = u / NM, pm = u % NM;
      const int row0 = pm * 256, col0 = pn * 128;
      f32x16 acc[2][2];
      gemm_tile(H, DM, W, DM, DM, row0, col0, lds, acc);
      const bool rope = (col0 >= C_DQ && col0 < C_DV);
      const float scl = (col0 >= C_MK && col0 < C_MV) ? 0.125f : ((col0 >= C_DQ && col0 < C_DK) ? QSCALE : 1.f);
#pragma unroll
      for (int i = 0; i < 2; ++i)
#pragma unroll
        for (int j = 0; j < 2; ++j)
#pragma unroll
          for (int q = 0; q < 8; ++q) {
            float lo, hi2; pair_xchg(acc[i][j][2 * q], acc[i][j][2 * q + 1], lane, lo, hi2);
            const int row = row0 + wm * 64 + i * 32 + crow(2 * q, hi) + (lane & 1);
            const int col = col0 + wn * 64 + j * 32 + (r32 & ~1);
            if (rope) {
              const int s = row % SEGL;
              if (s >= CTXL) {
                const int idx = (s - CTXL) * 32 + ((col & 63) >> 1);
                const float c = RC[idx], sn = RS[idx];
                const float t1 = lo, t2 = hi2; lo = t1 * c - t2 * sn; hi2 = t1 * sn + t2 * c;
              }
            }
            *(unsigned*)(PROJ + (size_t)row * PW + col) = cvtpk(lo * scl, hi2 * scl);
          }
    } else {
      const int pm = u - NU, rowb = pm * 256 + wid * 32;
      const bf16_t* WG = (const bf16_t*)(p.ws + WS_WG) + (size_t)l * 16 * DM;
      float* GT = (float*)(p.ws + WS_GATES);
      const int r16 = lane & 15, q4 = lane >> 4;
      f32x4 c0 = {0.f, 0.f, 0.f, 0.f}, c1 = {0.f, 0.f, 0.f, 0.f};
      const bf16_t* a0p = H + (size_t)(rowb + r16) * DM + q4 * 8;
      const bf16_t* a1p = a0p + (size_t)16 * DM;
      const bf16_t* bp = WG + (size_t)r16 * DM + q4 * 8;
#pragma unroll 4
      for (int ks = 0; ks < 32; ++ks) {
        const bf16x8 a0 = *(const bf16x8*)(a0p + ks * 32), a1 = *(const bf16x8*)(a1p + ks * 32), b = *(const bf16x8*)(bp + ks * 32);
        c0 = __builtin_amdgcn_mfma_f32_16x16x32_bf16(a0, b, c0, 0, 0, 0);
        c1 = __builtin_amdgcn_mfma_f32_16x16x32_bf16(a1, b, c1, 0, 0, 0);
      }
      const float gb = p.in[I_GATEB][l * 16 + r16];
#pragma unroll
      for (int j = 0; j < 4; ++j) {
        GT[(size_t)(rowb + q4 * 4 + j) * 16 + r16] = c0[j] + gb;
        GT[(size_t)(rowb + 16 + q4 * 4 + j) * 16 + r16] = c1[j] + gb;
      }
    }
  }
}

__device__ __forceinline__ void phase_outproj(const Params& p, int l, unsigned char* lds) {
  int tid_ = threadIdx.x; asm volatile("" : "+v"(tid_)); const int tid = tid_, lane = tid & 63, wid = tid >> 6, wm = wid >> 1, wn = wid & 1, r32 = lane & 31, hi = lane >> 5;
  const bf16_t* MIX = (const bf16_t*)(p.ws + WS_MIX);
  const bf16_t* W = (const bf16_t*)(p.ws + WS_WOUT) + (size_t)l * DM * DM;
  float* XC = (float*)(p.ws + WS_XCUR);
  const float* MOD = (const float*)(p.ws + WS_MOD);
  constexpr int NM = T / 256, NN = DM / 128, NU = NM * NN;
  for (int u = p.bx; u < NU; u += p.gx) {
    const int pm = u / NN, pn = u % NN;
    if (l == DEPTH - 1 && (pm % 33) == 0) continue;
    const int row0 = pm * 256, col0 = pn * 128;
    for (int rep = 0; rep < REP_OUTP; ++rep) {
    f32x16 acc[2][2];
    gemm_tile(MIX, DM, W, DM, DM, row0, col0, lds, acc);
    const int mr = (pm % 33) == 0 ? 4 : pm / 33;
    const float* g1 = MOD + ((size_t)l * 5 + mr) * 6144 + 2048;
#pragma unroll
    for (int i = 0; i < 2; ++i)
#pragma unroll
      for (int j = 0; j < 2; ++j) {
        const int col = col0 + wn * 64 + j * 32 + r32;
        const float gg = (rep == REP_OUTP - 1) ? g1[col] : 0.f;
#pragma unroll
        for (int r = 0; r < 16; ++r) {
          const int row = row0 + wm * 64 + i * 32 + crow(r, hi);
          const float xo = (l == 0) ? in_row(p.in[I_X], p.in[I_CTX], row)[col] : XC[(size_t)row * DM + col];
          XC[(size_t)row * DM + col] = xo + gg * acc[i][j][r];
        }
      }
    }
  }
}
__device__ __forceinline__ void phase_peerq(const Params& p, int l, unsigned char* lds) {
  int tid_ = threadIdx.x; asm volatile("" : "+v"(tid_)); const int tid = tid_, lane = tid & 63, wid = tid >> 6, wm = wid >> 1, wn = wid & 1, r32 = lane & 31, hi = lane >> 5;
  const bf16_t* H = (const bf16_t*)(p.ws + WS_H);
  const bf16_t* W = (const bf16_t*)(p.ws + WS_WQ) + (size_t)l * DM * DM;
  bf16_t* QP = (bf16_t*)(p.ws + WS_PROJ);
  constexpr int NM = T / 256, NN = DM / 128, NU = NM * NN;
  for (int u = p.bx; u < NU; u += p.gx) {
    const int pm = u / NN, pn = u % NN;
    if (l == DEPTH - 1 && (pm % 33) == 0) continue;
    const int row0 = pm * 256, col0 = pn * 128;
    f32x16 acc[2][2];
    gemm_tile(H, DM, W, DM, DM, row0, col0, lds, acc);
#pragma unroll
    for (int i = 0; i < 2; ++i)
#pragma unroll
      for (int j = 0; j < 2; ++j)
#pragma unroll
        for (int q = 0; q < 8; ++q) {
          float lo, hi2; pair_xchg(acc[i][j][2 * q], acc[i][j][2 * q + 1], lane, lo, hi2);
          const int row = row0 + wm * 64 + i * 32 + crow(2 * q, hi) + (lane & 1);
          const int col = col0 + wn * 64 + j * 32 + (r32 & ~1);
          *(unsigned*)(QP + (size_t)row * DM + col) = cvtpk(lo, hi2);
        }
  }
}


struct EpiInproj {
  static constexpr bool PERM = true, AFTER_DRAIN = false;
  bf16_t* PROJ; const float* RC; const float* RS; unsigned char* V8T;
  __device__ __forceinline__ void operator()(const pg8::f32x4 (&acc)[2][2][4][2], const pg8::Unit& u, int wr, int wc, int fr, int fq) const {
#pragma unroll
    for (int bj = 0; bj < 2; ++bj) {
      const int colt = u.pn * 256 + bj * 128;
      const bool rope = (colt >= C_DQ && colt < C_DV);
      const float scl = (colt >= C_MK && colt < C_MV) ? 0.125f : ((colt >= C_DQ && colt < C_DK) ? QSCALE : 1.f);
      const int col8 = colt + wc * 32 + 8 * fq;
      if (colt >= C_DV) {
        const int hh = (col8 - C_DV) >> 7, e0 = (col8 - C_DV) & 127;
#pragma unroll
        for (int ai = 0; ai < 2; ++ai)
#pragma unroll
          for (int m = 0; m < 4; ++m) {
            const int row = u.pm * 256 + ai * 128 + wr * 64 + m * 16 + fr;
            const int b = row / SEGL, s = row - b * SEGL, t = s >> 6, kk = s & 63;
            const int slot = ((kk >> 2) & 1) * 32 + (kk & 3) + 4 * ((kk >> 3) & 3) + 16 * (kk >> 5);
            unsigned char* vp = V8T + ((size_t)((b * 4 + hh) * NCH + t) * 128 + e0) * 80 + slot;
            const f32x4 v0 = acc[ai][bj][m][0], v1 = acc[ai][bj][m][1];
            int w0 = 0, w1 = 0;
            w0 = __builtin_amdgcn_cvt_pk_fp8_f32(v0[0], v0[1], w0, false); w0 = __builtin_amdgcn_cvt_pk_fp8_f32(v0[2], v0[3], w0, true);
            w1 = __builtin_amdgcn_cvt_pk_fp8_f32(v1[0], v1[1], w1, false); w1 = __builtin_amdgcn_cvt_pk_fp8_f32(v1[2], v1[3], w1, true);
            vp[0] = (unsigned char)(w0 & 0xFF); vp[80] = (unsigned char)((w0 >> 8) & 0xFF); vp[160] = (unsigned char)((w0 >> 16) & 0xFF); vp[240] = (unsigned char)((w0 >> 24) & 0xFF);
            vp[320] = (unsigned char)(w1 & 0xFF); vp[400] = (unsigned char)((w1 >> 8) & 0xFF); vp[480] = (unsigned char)((w1 >> 16) & 0xFF); vp[560] = (unsigned char)((w1 >> 24) & 0xFF);
          }
        continue;
      }
#pragma unroll
      for (int ai = 0; ai < 2; ++ai)
#pragma unroll
        for (int m = 0; m < 4; ++m) {
          const int row = u.pm * 256 + ai * 128 + wr * 64 + m * 16 + fr;
          f32x4 v0 = acc[ai][bj][m][0], v1 = acc[ai][bj][m][1];
          if (rope) {
            const int s = row % SEGL;
            if (s >= CTXL) {
              const int idx = (s - CTXL) * 32 + ((col8 & 63) >> 1);
              const f32x4 c = *(const f32x4*)(RC + idx), sn = *(const f32x4*)(RS + idx);
              f32x4 a, b;
              a[0] = v0[0] * c[0] - v0[1] * sn[0]; a[1] = v0[0] * sn[0] + v0[1] * c[0]; a[2] = v0[2] * c[1] - v0[3] * sn[1]; a[3] = v0[2] * sn[1] + v0[3] * c[1];
              b[0] = v1[0] * c[2] - v1[1] * sn[2]; b[1] = v1[0] * sn[2] + v1[1] * c[2]; b[2] = v1[2] * c[3] - v1[3] * sn[3]; b[3] = v1[2] * sn[3] + v1[3] * c[3];
              v0 = a; v1 = b;
            }
          }
          u32x4 w; w.x = cvtpk(v0[0] * scl, v0[1] * scl); w.y = cvtpk(v0[2] * scl, v0[3] * scl); w.z = cvtpk(v1[0] * scl, v1[1] * scl); w.w = cvtpk(v1[2] * scl, v1[3] * scl);
          *(u32x4*)(PROJ + (size_t)row * PW + col8) = w;
        }
    }
  }
};
struct EpiOutproj {
  static constexpr bool PERM = true, AFTER_DRAIN = false;
  float* XC; const float* MODL; const float* xin; const float* ctxin; int first; float gsc;
  __device__ __forceinline__ void operator()(const pg8::f32x4 (&acc)[2][2][4][2], const pg8::Unit& u, int wr, int wc, int fr, int fq) const {
    const int mr = (u.pm % 33) == 0 ? 4 : u.pm / 33;
    const float* g1 = MODL + (size_t)mr * 6144 + 2048;
#pragma unroll
    for (int bj = 0; bj < 2; ++bj) {
      const int col8 = u.pn * 256 + bj * 128 + wc * 32 + 8 * fq;
      const f32x4 ga = *(const f32x4*)(g1 + col8) * gsc, gb = *(const f32x4*)(g1 + col8 + 4) * gsc;
#pragma unroll
      for (int ai = 0; ai < 2; ++ai)
#pragma unroll
        for (int m = 0; m < 4; ++m) {
          const int row = u.pm * 256 + ai * 128 + wr * 64 + m * 16 + fr;
          const float* xo = first ? in_row(xin, ctxin, row) + col8 : XC + (size_t)row * DM + col8;
          const f32x4 xa = *(const f32x4*)xo, xb = *(const f32x4*)(xo + 4);
          *(f32x4*)(XC + (size_t)row * DM + col8) = xa + ga * acc[ai][bj][m][0];
          *(f32x4*)(XC + (size_t)row * DM + col8 + 4) = xb + gb * acc[ai][bj][m][1];
        }
    }
  }
};
struct EpiPeerq {
  static constexpr bool PERM = true, AFTER_DRAIN = false;
  bf16_t* QP;
  __device__ __forceinline__ void operator()(const pg8::f32x4 (&acc)[2][2][4][2], const pg8::Unit& u, int wr, int wc, int fr, int fq) const {
#pragma unroll
    for (int bj = 0; bj < 2; ++bj) {
      const int col8 = u.pn * 256 + bj * 128 + wc * 32 + 8 * fq;
#pragma unroll
      for (int ai = 0; ai < 2; ++ai)
#pragma unroll
        for (int m = 0; m < 4; ++m) {
          const int row = u.pm * 256 + ai * 128 + wr * 64 + m * 16 + fr;
          const f32x4 v0 = acc[ai][bj][m][0], v1 = acc[ai][bj][m][1];
          u32x4 w; w.x = cvtpk(v0[0], v0[1]); w.y = cvtpk(v0[2], v0[3]); w.z = cvtpk(v1[0], v1[1]); w.w = cvtpk(v1[2], v1[3]);
          *(u32x4*)(QP + (size_t)row * DM + col8) = w;
        }
    }
  }
};
__device__ __forceinline__ void phase_inproj2(const Params& p, int l, unsigned char* lds) {
  {
    pg8::Gemm g{(const bf16_t*)(p.ws + WS_H), (const bf16_t*)(p.ws + WS_WIN) + (size_t)l * PW * DM, T, PW, DM};
    pg8::StaticOrder S; S.init(T, PW, p.gx, p.bx);
    EpiInproj E{(bf16_t*)(p.ws + WS_PROJ), (const float*)(p.ws + WS_ROPE), (const float*)(p.ws + WS_ROPE) + SEQ * 32, p.ws + WS_V8T};
    pg8::gemm_phase<EpiInproj, pg8::StaticOrder, true, true>((PG8_LAS unsigned char*)lds, g, S, E);
  }
  int tid_ = threadIdx.x; asm volatile("" : "+v"(tid_)); const int tid = tid_, lane = tid & 63, wid = tid >> 6;
  const bf16_t* H = (const bf16_t*)(p.ws + WS_H);
  for (int pm = p.bx; pm < T / 256; pm += p.gx) {
    const int rowb = pm * 256 + wid * 32;
    const bf16_t* WG = (const bf16_t*)(p.ws + WS_WG) + (size_t)l * 16 * DM;
    float* GT = (float*)(p.ws + WS_GATES);
    const int r16 = lane & 15, q4 = lane >> 4;
    f32x4 c0 = {0.f, 0.f, 0.f, 0.f}, c1 = {0.f, 0.f, 0.f, 0.f};
    const bf16_t* a0p = H + (size_t)(rowb + r16) * DM + q4 * 8;
    const bf16_t* a1p = a0p + (size_t)16 * DM;
    const bf16_t* bp = WG + (size_t)r16 * DM + q4 * 8;
#pragma unroll 4
    for (int ks = 0; ks < 32; ++ks) {
      const bf16x8 a0 = *(const bf16x8*)(a0p + ks * 32), a1 = *(const bf16x8*)(a1p + ks * 32), b = *(const bf16x8*)(bp + ks * 32);
      c0 = __builtin_amdgcn_mfma_f32_16x16x32_bf16(a0, b, c0, 0, 0, 0);
      c1 = __builtin_amdgcn_mfma_f32_16x16x32_bf16(a1, b, c1, 0, 0, 0);
    }
    const float gb = p.in[I_GATEB][l * 16 + r16];
#pragma unroll
    for (int j = 0; j < 4; ++j) {
      GT[(size_t)(rowb + q4 * 4 + j) * 16 + r16] = c0[j] + gb;
      GT[(size_t)(rowb + 16 + q4 * 4 + j) * 16 + r16] = c1[j] + gb;
    }
  }
}
__device__ __forceinline__ void phase_outproj2(const Params& p, int l, unsigned char* lds) {
  pg8::Gemm g{(const bf16_t*)(p.ws + WS_MIX), (const bf16_t*)(p.ws + WS_WOUT) + (size_t)l * DM * DM, T, DM, DM};
  pg8::StaticOrder S; S.init(T, DM, p.gx, p.bx);
  for (int rep = 0; rep < REP_OUTP; ++rep) {
  EpiOutproj E{(float*)(p.ws + WS_XCUR), (const float*)(p.ws + WS_MOD) + (size_t)l * 5 * 6144, p.in[I_X], p.in[I_CTX], l == 0, (rep == REP_OUTP - 1) ? 1.f : 0.f};
  pg8::gemm_phase<EpiOutproj, pg8::StaticOrder, true, true>((PG8_LAS unsigned char*)lds, g, S, E);
  }
  if (l < DEPTH - 1) tail_filler_tables(p, l, (T / 256) * (DM / 256));
}
__device__ __forceinline__ void phase_peerq2(const Params& p, int l, unsigned char* lds) {
  pg8::Gemm g{(const bf16_t*)(p.ws + WS_H), (const bf16_t*)(p.ws + WS_WQ) + (size_t)l * DM * DM, T, DM, DM};
  pg8::StaticOrder S; S.init(T, DM, p.gx, p.bx);
  EpiPeerq E{(bf16_t*)(p.ws + WS_PROJ)};
  pg8::gemm_phase<EpiPeerq, pg8::StaticOrder, true, true>((PG8_LAS unsigned char*)lds, g, S, E);
  if (l == DEPTH - 2) tail_filler_tables(p, DEPTH - 1, (T / 256) * (DM / 256));
}

__device__ __forceinline__ void conv_unit(const Params& p, int l, int unit, unsigned char* lds) {
  int tid_ = threadIdx.x; asm volatile("" : "+v"(tid_)); const int tid = tid_, lane = tid & 63, wid = tid >> 6;
  float* U = (float*)lds;
  const bf16_t* PROJ = (const bf16_t*)(p.ws + WS_PROJ);
  bf16_t* MIX = (bf16_t*)(p.ws + WS_MIX);
  const int row0 = unit * 32, b = row0 / SEGL, s0 = row0 - b * SEGL;
  const int seglo = s0 < CTXL ? 0 : CTXL, seghi = s0 < CTXL ? CTXL : SEGL;
  for (int rr = tid >> 5; rr < 62; rr += 16) {
    const int s = s0 - 15 + rr, c8 = (tid & 31) * 8;
    f32x4 u0 = {0.f, 0.f, 0.f, 0.f}, u1 = {0.f, 0.f, 0.f, 0.f};
    if (s >= seglo && s < seghi) {
      const bf16_t* pr = PROJ + (size_t)(b * SEGL + s) * PW + c8;
      const u32x4 a1 = *(const u32x4*)pr, a2 = *(const u32x4*)(pr + 256);
      u0.x = bflo(a1.x) * sigmoidf_(bflo(a2.x)); u0.y = bfhi(a1.x) * sigmoidf_(bfhi(a2.x));
      u0.z = bflo(a1.y) * sigmoidf_(bflo(a2.y)); u0.w = bfhi(a1.y) * sigmoidf_(bfhi(a2.y));
      u1.x = bflo(a1.z) * sigmoidf_(bflo(a2.z)); u1.y = bfhi(a1.z) * sigmoidf_(bfhi(a2.z));
      u1.z = bflo(a1.w) * sigmoidf_(bflo(a2.w)); u1.w = bfhi(a1.w) * sigmoidf_(bfhi(a2.w));
    }
    *(f32x4*)(U + rr * 256 + c8) = u0; *(f32x4*)(U + rr * 256 + c8 + 4) = u1;
  }
  __syncthreads();
  float* Y = U + 62 * 256;
  const float* cw = p.in[I_CONVW] + (size_t)l * 31 * 256;
#pragma unroll 1
  for (int q = 0; q < 4; ++q) {
    const int c = lane + 64 * q;
    float w[31];
#pragma unroll
    for (int j = 0; j < 31; ++j) w[j] = cw[j * 256 + c];
    const float bias = p.in[I_CONVB][l * 256 + c];
#pragma unroll
    for (int tt = 0; tt < 4; ++tt) {
      const int t = wid * 4 + tt;
      float a = bias;
#pragma unroll
      for (int j = 0; j < 31; ++j) a += U[(t + j) * 256 + c] * w[j];
      Y[t * 256 + c] = a;
    }
  }
  asm volatile("s_waitcnt lgkmcnt(0)" ::: "memory");
  float y[4][4];
#pragma unroll
  for (int tt = 0; tt < 4; ++tt)
#pragma unroll
    for (int q = 0; q < 4; ++q) y[tt][q] = Y[(wid * 4 + tt) * 256 + lane + 64 * q];
#pragma unroll
  for (int tt = 0; tt < 4; ++tt) {
    const int t = wid * 4 + tt;
    const float mean = wave_sum((y[tt][0] + y[tt][1]) + (y[tt][2] + y[tt][3])) * (1.f / 256.f);
    float v = 0.f;
#pragma unroll
    for (int q = 0; q < 4; ++q) { const float d = y[tt][q] - mean; v += d * d; }
    const float rs = rsqrtf(wave_sum(v) * (1.f / 256.f) + EPS);
#pragma unroll
    for (int q = 0; q < 4; ++q) {
      const int c = lane + 64 * q;
      const float z = (y[tt][q] - mean) * rs * p.in[I_CLNG][l * 256 + c] + p.in[I_CLNB][l * 256 + c];
      const float o = (ABL & 1) ? 0.f : z * sigmoidf_(z);
      MIX[(size_t)(row0 + t) * DM + c] = (bf16_t)(cvtpk(o, 0.f) & 0xffffu);
    }
  }
  __syncthreads();
}

__device__ __forceinline__ int ml_cidx(int ch, int dir) { return dir == 0 ? ch : (ch < 4 ? 3 - ch : 135 - ch); }
__device__ __forceinline__ void ml_load_tile(const bf16_t* src, float* dst, int tid) {
  const int r = tid >> 3, c8 = (tid & 7) * 8;
  const u32x4 a = *(const u32x4*)(src + (size_t)r * PW + c8);
  float* d = dst + r * 65 + c8;
  d[0] = bflo(a.x); d[1] = bfhi(a.x); d[2] = bflo(a.y); d[3] = bfhi(a.y); d[4] = bflo(a.z); d[5] = bfhi(a.z); d[6] = bflo(a.w); d[7] = bfhi(a.w);
}
__device__ __forceinline__ void ml_local_unit(const Params& p, int l, int unit, unsigned char* lds) {
  int tid_ = threadIdx.x; asm volatile("" : "+v"(tid_)); const int tid = tid_, lane = tid & 63, wid = tid >> 6, r32 = lane & 31, hi = lane >> 5;
  float* Kt = (float*)lds; float* Vt = Kt + 64 * 65; float* WK = Vt + 64 * 65;
  const bf16_t* PROJ = (const bf16_t*)(p.ws + WS_PROJ);
  const float* GT = (const float*)(p.ws + WS_GATES);
  float* UL = (float*)(p.ws + WS_ULOC); float* META = (float*)(p.ws + WS_MLMETA);
  const int b = unit / (4 * NCH), hh = (unit / NCH) & 3, ch = unit % NCH;
  const int row0 = b * SEGL + ch * 64;
  ml_load_tile(PROJ + (size_t)row0 * PW + C_MK + hh * 64, Kt, tid);
  ml_load_tile(PROJ + (size_t)row0 * PW + C_MV + hh * 64, Vt, tid);
  if (wid < 2) {
    const int dir = wid;
    const float ig = GT[(size_t)(row0 + lane) * 16 + (2 * dir) * 4 + hh];
    const float lf = logsigmoidf_(GT[(size_t)(row0 + lane) * 16 + (2 * dir + 1) * 4 + hh]);
    float ps = lf;
#pragma unroll
    for (int o = 1; o < 64; o <<= 1) { const float t = __shfl_up(ps, o); if (lane >= o) ps += t; }
    const float tot = __shfl(ps, 63);
    const float wlog = dir == 0 ? (tot - ps + ig) : (ps - lf + ig);
    const float mloc = wave_max(wlog);
    WK[dir * 64 + lane] = __expf(wlog - mloc);
    if (lane == 0) {
      const int seq = (b * 4 + hh) * 2 + dir, ci = ml_cidx(ch, dir);
      META[((size_t)seq * NCH + ci) * 4 + 0] = tot; META[((size_t)seq * NCH + ci) * 4 + 1] = mloc;
    }
  }
  __syncthreads();
  {
    const int dir = wid >> 2, et = (wid >> 1) & 1, dt = wid & 1;
    const int seq = (b * 4 + hh) * 2 + dir, ci = ml_cidx(ch, dir);
    float* slot = UL + ((size_t)seq * NCH + ci) * USTRIDE;
    f32x16 acc = {};
#pragma unroll 8
    for (int ks = 0; ks < 32; ++ks) {
      const int s = 2 * ks + hi;
      const float a = WK[dir * 64 + s] * Vt[s * 65 + et * 32 + r32];
      const float bb = Kt[s * 65 + dt * 32 + r32];
      acc = __builtin_amdgcn_mfma_f32_32x32x2f32(a, bb, acc, 0, 0, 0);
    }
#pragma unroll
    for (int r = 0; r < 16; ++r) slot[(et * 32 + crow(r, hi)) * 64 + dt * 32 + r32] = acc[r];
    if (et == 0) {
      float n = 0.f;
#pragma unroll 8
      for (int i = 0; i < 32; ++i) { const int s = hi * 32 + i; n += WK[dir * 64 + s] * Kt[s * 65 + dt * 32 + r32]; }
      n += __shfl_xor(n, 32);
      if (hi == 0) slot[4096 + dt * 32 + r32] = n;
    }
  }
  __syncthreads();
}
constexpr int MLP = 144;
constexpr size_t WS_CST = WS_H;
constexpr size_t WS_NST = WS_H + (size_t)32 * NCH * 4096 * 2;
__device__ __forceinline__ void ml_stage_rm(const bf16_t* src, size_t ld, unsigned char* dst, int tid) {
  const int r = tid >> 3, c8 = (tid & 7) * 8;
  *(u32x4*)(dst + r * MLP + c8 * 2) = *(const u32x4*)(src + (size_t)r * ld + c8);
}
__device__ __forceinline__ void ml_stage_tr(const bf16_t* src, size_t ld, unsigned char* dst, int tid) {
  const int r = tid >> 3, c8 = (tid & 7) * 8;
  const u32x4 a = *(const u32x4*)(src + (size_t)r * ld + c8);
  bf16_t* d = (bf16_t*)dst;
  d[(c8 + 0) * 72 + r] = (bf16_t)(a.x & 0xffffu); d[(c8 + 1) * 72 + r] = (bf16_t)(a.x >> 16);
  d[(c8 + 2) * 72 + r] = (bf16_t)(a.y & 0xffffu); d[(c8 + 3) * 72 + r] = (bf16_t)(a.y >> 16);
  d[(c8 + 4) * 72 + r] = (bf16_t)(a.z & 0xffffu); d[(c8 + 5) * 72 + r] = (bf16_t)(a.z >> 16);
  d[(c8 + 6) * 72 + r] = (bf16_t)(a.w & 0xffffu); d[(c8 + 7) * 72 + r] = (bf16_t)(a.w >> 16);
}
__device__ __forceinline__ void ml_local_unit2(const Params& p, int l, int unit, unsigned char* lds) {
  int tid_ = threadIdx.x; asm volatile("" : "+v"(tid_)); const int tid = tid_, lane = tid & 63, wid = tid >> 6, r32 = lane & 31, hi = lane >> 5;
  unsigned char* KT = lds; unsigned char* VT = lds + 64 * MLP; float* WK = (float*)(lds + 2 * 64 * MLP);
  const bf16_t* PROJ = (const bf16_t*)(p.ws + WS_PROJ);
  const float* GT = (const float*)(p.ws + WS_GATES);
  float* UL = (float*)(p.ws + WS_ULOC); float* META = (float*)(p.ws + WS_MLMETA);
  const int b = unit / (4 * NCH), hh = (unit / NCH) & 3, ch = unit % NCH;
  const int row0 = b * SEGL + ch * 64;
  ml_stage_tr(PROJ + (size_t)row0 * PW + C_MK + hh * 64, PW, KT, tid);
  ml_stage_tr(PROJ + (size_t)row0 * PW + C_MV + hh * 64, PW, VT, tid);
  if (wid < 2) {
    const int dir = wid;
    const float ig = GT[(size_t)(row0 + lane) * 16 + (2 * dir) * 4 + hh];
    const float lf = logsigmoidf_(GT[(size_t)(row0 + lane) * 16 + (2 * dir + 1) * 4 + hh]);
    float ps = lf;
#pragma unroll
    for (int o = 1; o < 64; o <<= 1) { const float t = __shfl_up(ps, o); if (lane >= o) ps += t; }
    const float tot = __shfl(ps, 63);
    const float wlog = dir == 0 ? (tot - ps + ig) : (ps - lf + ig);
    const float mloc = wave_max(wlog);
    WK[dir * 64 + lane] = __expf(wlog - mloc);
    if (lane == 0) {
      const int seq = (b * 4 + hh) * 2 + dir, ci = ml_cidx(ch, dir);
      META[((size_t)seq * NCH + ci) * 4 + 0] = tot; META[((size_t)seq * NCH + ci) * 4 + 1] = mloc;
    }
  }
  __syncthreads();
  {
    const int dir = wid >> 2, et = (wid >> 1) & 1, dt = wid & 1;
    const int seq = (b * 4 + hh) * 2 + dir, ci = ml_cidx(ch, dir);
    float* slot = UL + ((size_t)seq * NCH + ci) * USTRIDE;
    f32x16 acc = {};
#pragma unroll
    for (int ks = 0; ks < 4; ++ks) {
      const int s0 = ks * 16 + hi * 8;
      const u32x4 va = *(const u32x4*)(VT + (et * 32 + r32) * MLP + s0 * 2);
      const bf16x8 kb = *(const bf16x8*)(KT + (dt * 32 + r32) * MLP + s0 * 2);
      const f32x4 w0 = *(const f32x4*)(WK + dir * 64 + s0), w1 = *(const f32x4*)(WK + dir * 64 + s0 + 4);
      u32x4 sa; sa.x = cvtpk(bflo(va.x) * w0.x, bfhi(va.x) * w0.y); sa.y = cvtpk(bflo(va.y) * w0.z, bfhi(va.y) * w0.w);
      sa.z = cvtpk(bflo(va.z) * w1.x, bfhi(va.z) * w1.y); sa.w = cvtpk(bflo(va.w) * w1.z, bfhi(va.w) * w1.w);
      acc = __builtin_amdgcn_mfma_f32_32x32x16_bf16(*(const bf16x8*)&sa, kb, acc, 0, 0, 0);
    }
#pragma unroll
    for (int r = 0; r < 16; ++r) slot[(et * 32 + crow(r, hi)) * 64 + dt * 32 + r32] = acc[r];
    if (et == 0) {
      float n = 0.f;
#pragma unroll
      for (int i = 0; i < 4; ++i) {
        const int s0 = hi * 32 + i * 8;
        const u32x4 ka = *(const u32x4*)(KT + (dt * 32 + r32) * MLP + s0 * 2);
        const f32x4 w0 = *(const f32x4*)(WK + dir * 64 + s0), w1 = *(const f32x4*)(WK + dir * 64 + s0 + 4);
        n += bflo(ka.x) * w0.x + bfhi(ka.x) * w0.y + bflo(ka.y) * w0.z + bfhi(ka.y) * w0.w + bflo(ka.z) * w1.x + bfhi(ka.z) * w1.y + bflo(ka.w) * w1.z + bfhi(ka.w) * w1.w;
      }
      n += __shfl_xor(n, 32);
      if (hi == 0) slot[4096 + dt * 32 + r32] = n;
    }
  }
  __syncthreads();
}
__device__ __forceinline__ void ml_scan(const Params& p, unsigned char* lds) {
  float* UL = (float*)(p.ws + WS_ULOC); float* META = (float*)(p.ws + WS_MLMETA);
  int tid_ = threadIdx.x; asm volatile("" : "+v"(tid_));
  const int tid = tid_, lane = tid & 63, wid = tid >> 6;
  float* DEC = (float*)lds;
  float* SCL = DEC + 2 * NCH;
  float* TMP = SCL + 2 * NCH;
  for (int base0 = p.bx * 512; base0 < 32 * USTRIDE; base0 += p.gx * 512) {
    const int seq0 = base0 / USTRIDE;
    if (wid < 2) {
      const int seq = seq0 + wid;
      if (seq < 32) {
        float* mt = META + (size_t)seq * NCH * 4;
        for (int c = lane; c < NCH; c += 64) { TMP[(wid * 2 + 0) * NCH + c] = mt[c * 4 + 0]; TMP[(wid * 2 + 1) * NCH + c] = mt[c * 4 + 1]; }
        asm volatile("s_waitcnt lgkmcnt(0)" ::: "memory");
        if (lane == 0) {
          float m = 0.f;
          for (int c = 0; c < NCH; ++c) {
            const float bl = TMP[(wid * 2 + 0) * NCH + c], mloc = TMP[(wid * 2 + 1) * NCH + c];
            const float mn = fmaxf(bl + m, mloc);
            DEC[wid * NCH + c] = __expf(bl + m - mn); SCL[wid * NCH + c] = __expf(mloc - mn);
            mt[c * 4 + 2] = m;
            m = mn;
          }
        }
      }
    }
    __syncthreads();
    const int idx = base0 + tid;
    if (idx < 32 * USTRIDE) {
      const int seq = idx / USTRIDE, e = idx - seq * USTRIDE, sl = seq - seq0;
      float* bp = UL + (size_t)seq * NCH * USTRIDE + e;
      bf16_t* CSTp = (bf16_t*)(p.ws + WS_CST) + (size_t)seq * NCH * 4096 + (e < 4096 ? e : 0);
      float* NSTp = (float*)(p.ws + WS_NST) + (size_t)seq * NCH * 64 + (e < 4096 ? 0 : e - 4096);
      const float* dec = DEC + sl * NCH; const float* scl = SCL + sl * NCH;
      float C = 0.f;
#pragma unroll 1
      for (int c0 = 0; c0 < NCH; c0 += 12) {
        float u[12];
#pragma unroll
        for (int j = 0; j < 12; ++j) u[j] = bp[(size_t)(c0 + j) * USTRIDE];
#pragma unroll
        for (int j = 0; j < 12; ++j) {
          if (e < 4096) CSTp[(size_t)(c0 + j) * 4096] = (bf16_t)(cvtpk(C, 0.f) & 0xffffu); else NSTp[(size_t)(c0 + j) * 64] = C;
          C = dec[c0 + j] * C + scl[c0 + j] * u[j]; }
      }
    }
    __syncthreads();
  }
}
__device__ __forceinline__ void ml_out_unit(const Params& p, int l, int unit, unsigned char* lds) {
  int tid_ = threadIdx.x; asm volatile("" : "+v"(tid_)); const int tid = tid_, lane = tid & 63, wid = tid >> 6, r32 = lane & 31, hi = lane >> 5;
  float* Qt = (float*)lds; float* Kt = Qt + 64 * 65; float* Vt = Kt + 64 * 65;
  float* Cs = Vt + 64 * 65;
  float* Ns = Cs + 2 * 64 * 65;
  float* Bq = Ns + 128;
  float* Gs = Bq + 128;
  float* Mi = Gs + 128;
  float* HB = Mi + 64;
  const bf16_t* PROJ = (const bf16_t*)(p.ws + WS_PROJ);
  const float* GT = (const float*)(p.ws + WS_GATES);
  const float* UL = (const float*)(p.ws + WS_ULOC); const float* META = (const float*)(p.ws + WS_MLMETA);
  bf16_t* MIX = (bf16_t*)(p.ws + WS_MIX);
  const int b = unit / (4 * NCH), hh = (unit / NCH) & 3, ch = unit % NCH;
  const int row0 = b * SEGL + ch * 64;
  ml_load_tile(PROJ + (size_t)row0 * PW + C_MQ + hh * 64, Qt, tid);
  ml_load_tile(PROJ + (size_t)row0 * PW + C_MK + hh * 64, Kt, tid);
  ml_load_tile(PROJ + (size_t)row0 * PW + C_MV + hh * 64, Vt, tid);
  for (int i = tid; i < 2 * USTRIDE; i += 512) {
    const int dir = i / USTRIDE, e = i - dir * USTRIDE;
    const int seq = (b * 4 + hh) * 2 + dir, ci = ml_cidx(ch, dir);
    const float v = UL[((size_t)seq * NCH + ci) * USTRIDE + e];
    if (e < 4096) Cs[dir * 64 * 65 + (e >> 6) * 65 + (e & 63)] = v; else Ns[dir * 64 + (e - 4096)] = v;
  }
  if (wid < 2) {
    const int dir = wid;
    const float ig = GT[(size_t)(row0 + lane) * 16 + (2 * dir) * 4 + hh];
    const float lf = logsigmoidf_(GT[(size_t)(row0 + lane) * 16 + (2 * dir + 1) * 4 + hh]);
    float ps = lf;
#pragma unroll
    for (int o = 1; o < 64; o <<= 1) { const float t = __shfl_up(ps, o); if (lane >= o) ps += t; }
    const float tot = __shfl(ps, 63);
    const float bc = dir == 0 ? ps : (tot - ps + lf);
    Bq[dir * 64 + lane] = bc; Gs[dir * 64 + lane] = ig - bc;
    if (lane == 0) { const int seq = (b * 4 + hh) * 2 + dir, ci = ml_cidx(ch, dir); Mi[dir] = META[((size_t)seq * NCH + ci) * 4 + 2]; }
  }
  __syncthreads();
  {
    const int dir = wid >> 2, tt = (wid >> 1) & 1, et = wid & 1;
    const int t = tt * 32 + r32;
    f32x16 sa[2] = {};
#pragma unroll 4
    for (int ks = 0; ks < 32; ++ks) {
      const float bq = Qt[t * 65 + 2 * ks + hi];
      const float a0 = Kt[(r32) * 65 + 2 * ks + hi], a1 = Kt[(32 + r32) * 65 + 2 * ks + hi];
      sa[0] = __builtin_amdgcn_mfma_f32_32x32x2f32(a0, bq, sa[0], 0, 0, 0);
      sa[1] = __builtin_amdgcn_mfma_f32_32x32x2f32(a1, bq, sa[1], 0, 0, 0);
    }
    const float bt = Bq[dir * 64 + t];
    const float inter = bt + Mi[dir];
    float mx = -INFINITY;
    f32x16 dl[2];
#pragma unroll
    for (int st = 0; st < 2; ++st)
#pragma unroll
      for (int r = 0; r < 16; ++r) {
        const int s = st * 32 + crow(r, hi);
        const bool ok = dir == 0 ? (s <= t) : (s >= t);
        const float d = ok ? bt + Gs[dir * 64 + s] : -INFINITY;
        dl[st][r] = d; mx = fmaxf(mx, d);
      }
    mx = fmaxf(mx, __shfl_xor(mx, 32));
    const float mt = fmaxf(inter, mx);
    const float iw = __expf(inter - mt);
    float rsum = 0.f;
#pragma unroll
    for (int st = 0; st < 2; ++st)
#pragma unroll
      for (int r = 0; r < 16; ++r) { const float w = __expf(dl[st][r] - mt); sa[st][r] *= w; rsum += sa[st][r]; }
    rsum += __shfl_xor(rsum, 32);
    float qn = 0.f;
#pragma unroll 8
    for (int i = 0; i < 32; ++i) { const int d = hi * 32 + i; qn += Ns[dir * 64 + d] * Qt[t * 65 + d]; }
    qn += __shfl_xor(qn, 32);
    const float den = rsum + iw * qn;
    const float rden = 1.f / fmaxf(fabsf(den), __expf(-mt));
    f32x16 an = {}, ac = {};
#pragma unroll
    for (int st = 0; st < 2; ++st)
#pragma unroll
      for (int r = 0; r < 16; ++r) {
        const float a = Vt[(st * 32 + crow(r, hi)) * 65 + et * 32 + r32];
        an = __builtin_amdgcn_mfma_f32_32x32x2f32(a, sa[st][r], an, 0, 0, 0);
      }
    const float* Cd = Cs + dir * 64 * 65;
#pragma unroll 4
    for (int ks = 0; ks < 32; ++ks) {
      const float a = Cd[(et * 32 + r32) * 65 + 2 * ks + hi];
      const float bq = Qt[t * 65 + 2 * ks + hi];
      ac = __builtin_amdgcn_mfma_f32_32x32x2f32(a, bq, ac, 0, 0, 0);
    }
#pragma unroll
    for (int r = 0; r < 16; ++r) HB[dir * 64 * 65 + t * 65 + et * 32 + crow(r, hi)] = (an[r] + iw * ac[r]) * rden;
  }
  __syncthreads();
  {
    const int t = tid >> 3, e8 = (tid & 7) * 8;
    float v[8]; float ss = 0.f;
#pragma unroll
    for (int i = 0; i < 8; ++i) { v[i] = HB[t * 65 + e8 + i] + HB[64 * 65 + t * 65 + e8 + i]; ss += v[i] * v[i]; }
    ss += __shfl_xor(ss, 1); ss += __shfl_xor(ss, 2); ss += __shfl_xor(ss, 4);
    const float rs = rsqrtf(ss * (1.f / 64.f) + EPS);
    const u32x4 ov = *(const u32x4*)(PROJ + (size_t)(row0 + t) * PW + C_MO + hh * 64 + e8);
    const float og[8] = {bflo(ov.x), bfhi(ov.x), bflo(ov.y), bfhi(ov.y), bflo(ov.z), bfhi(ov.z), bflo(ov.w), bfhi(ov.w)};
    const float* g = p.in[I_MNORMG] + l * 64 + e8;
    float o[8];
#pragma unroll
    for (int i = 0; i < 8; ++i) o[i] = (ABL & 2) ? 0.f : v[i] * rs * g[i] * sigmoidf_(og[i]);
    u32x4 w; w.x = cvtpk(o[0], o[1]); w.y = cvtpk(o[2], o[3]); w.z = cvtpk(o[4], o[5]); w.w = cvtpk(o[6], o[7]);
    *(u32x4*)(MIX + (size_t)(row0 + t) * DM + 256 + hh * 64 + e8) = w;
  }
  __syncthreads();
}


__device__ __forceinline__ void ml_out_unit2(const Params& p, int l, int unit, unsigned char* lds) {
  int tid_ = threadIdx.x; asm volatile("" : "+v"(tid_)); const int tid = tid_, lane = tid & 63, wid = tid >> 6, r32 = lane & 31, hi = lane >> 5;
  unsigned char* Qs = lds; unsigned char* Ks = lds + 64 * MLP; unsigned char* VT = lds + 2 * 64 * MLP; unsigned char* Cs = lds + 3 * 64 * MLP;
  float* Ns = (float*)(lds + 5 * 64 * MLP);
  float* Bq = Ns + 128;
  float* Gs = Bq + 128;
  float* Mi = Gs + 128;
  float* HB = Mi + 64;
  const bf16_t* PROJ = (const bf16_t*)(p.ws + WS_PROJ);
  const float* GT = (const float*)(p.ws + WS_GATES);
  const bf16_t* CST = (const bf16_t*)(p.ws + WS_CST); const float* NST = (const float*)(p.ws + WS_NST); const float* META = (const float*)(p.ws + WS_MLMETA);
  bf16_t* MIX = (bf16_t*)(p.ws + WS_MIX);
  const int b = unit / (4 * NCH), hh = (unit / NCH) & 3, ch = unit % NCH;
  const int row0 = b * SEGL + ch * 64;
  ml_stage_rm(PROJ + (size_t)row0 * PW + C_MQ + hh * 64, PW, Qs, tid);
  ml_stage_rm(PROJ + (size_t)row0 * PW + C_MK + hh * 64, PW, Ks, tid);
  ml_stage_tr(PROJ + (size_t)row0 * PW + C_MV + hh * 64, PW, VT, tid);
#pragma unroll
  for (int dir = 0; dir < 2; ++dir) {
    const int seq = (b * 4 + hh) * 2 + dir, ci = ml_cidx(ch, dir);
    ml_stage_rm(CST + ((size_t)seq * NCH + ci) * 4096, 64, Cs + dir * 64 * MLP, tid);
    if (tid < 64) Ns[dir * 64 + tid] = NST[((size_t)seq * NCH + ci) * 64 + tid];
  }
  if (wid < 2) {
    const int dir = wid;
    const float ig = GT[(size_t)(row0 + lane) * 16 + (2 * dir) * 4 + hh];
    const float lf = logsigmoidf_(GT[(size_t)(row0 + lane) * 16 + (2 * dir + 1) * 4 + hh]);
    float ps = lf;
#pragma unroll
    for (int o = 1; o < 64; o <<= 1) { const float t = __shfl_up(ps, o); if (lane >= o) ps += t; }
    const float tot = __shfl(ps, 63);
    const float bc = dir == 0 ? ps : (tot - ps + lf);
    Bq[dir * 64 + lane] = bc; Gs[dir * 64 + lane] = ig - bc;
    if (lane == 0) { const int seq = (b * 4 + hh) * 2 + dir, ci = ml_cidx(ch, dir); Mi[dir] = META[((size_t)seq * NCH + ci) * 4 + 2]; }
  }
  __syncthreads();
  {
    const int dir = wid >> 2, tt = (wid >> 1) & 1, et = wid & 1;
    const int t = tt * 32 + r32;
    f32x16 sa[2] = {};
    bf16x8 bq[4];
#pragma unroll
    for (int ks = 0; ks < 4; ++ks) {
      bq[ks] = *(const bf16x8*)(Qs + t * MLP + (ks * 16 + hi * 8) * 2);
      const bf16x8 a0 = *(const bf16x8*)(Ks + r32 * MLP + (ks * 16 + hi * 8) * 2), a1 = *(const bf16x8*)(Ks + (32 + r32) * MLP + (ks * 16 + hi * 8) * 2);
      sa[0] = __builtin_amdgcn_mfma_f32_32x32x16_bf16(a0, bq[ks], sa[0], 0, 0, 0);
      sa[1] = __builtin_amdgcn_mfma_f32_32x32x16_bf16(a1, bq[ks], sa[1], 0, 0, 0);
    }
    const float bt = Bq[dir * 64 + t];
    const float inter = bt + Mi[dir];
    float mx = -INFINITY;
    f32x16 dl[2];
#pragma unroll
    for (int st = 0; st < 2; ++st)
#pragma unroll
      for (int r = 0; r < 16; ++r) {
        const int s = st * 32 + crow(r, hi);
        const bool ok = dir == 0 ? (s <= t) : (s >= t);
        const float d = ok ? bt + Gs[dir * 64 + s] : -INFINITY;
        dl[st][r] = d; mx = fmaxf(mx, d);
      }
    mx = fmaxf(mx, __shfl_xor(mx, 32));
    const float mt = fmaxf(inter, mx);
    const float iw = __expf(inter - mt);
    float rsum = 0.f;
#pragma unroll
    for (int st = 0; st < 2; ++st)
#pragma unroll
      for (int r = 0; r < 16; ++r) { const float w = __expf(dl[st][r] - mt); sa[st][r] *= w; rsum += sa[st][r]; }
    rsum += __shfl_xor(rsum, 32);
    float qn = 0.f;
#pragma unroll
    for (int i = 0; i < 4; ++i) {
      const int d0 = hi * 32 + i * 8;
      const u32x4 qa = *(const u32x4*)(Qs + t * MLP + d0 * 2);
      const f32x4 n0 = *(const f32x4*)(Ns + dir * 64 + d0), n1 = *(const f32x4*)(Ns + dir * 64 + d0 + 4);
      qn += bflo(qa.x) * n0.x + bfhi(qa.x) * n0.y + bflo(qa.y) * n0.z + bfhi(qa.y) * n0.w + bflo(qa.z) * n1.x + bfhi(qa.z) * n1.y + bflo(qa.w) * n1.z + bfhi(qa.w) * n1.w;
    }
    qn += __shfl_xor(qn, 32);
    const float den = rsum + iw * qn;
    const float rden = 1.f / fmaxf(fabsf(den), __expf(-mt));
    f32x16 an = {}, ac = {};
#pragma unroll
    for (int st = 0; st < 2; ++st)
#pragma unroll
      for (int k2 = 0; k2 < 2; ++k2) {
        u32x4 bx; bx.x = cvtpk(sa[st][8 * k2 + 0], sa[st][8 * k2 + 1]); bx.y = cvtpk(sa[st][8 * k2 + 2], sa[st][8 * k2 + 3]);
        bx.z = cvtpk(sa[st][8 * k2 + 4], sa[st][8 * k2 + 5]); bx.w = cvtpk(sa[st][8 * k2 + 6], sa[st][8 * k2 + 7]);
        const unsigned char* vrow = VT + (et * 32 + r32) * MLP + (st * 32 + 16 * k2 + 4 * hi) * 2;
        const u32x2 v0 = *(const u32x2*)vrow, v1 = *(const u32x2*)(vrow + 16);
        u32x4 ax; ax.x = v0.x; ax.y = v0.y; ax.z = v1.x; ax.w = v1.y;
        an = __builtin_amdgcn_mfma_f32_32x32x16_bf16(*(const bf16x8*)&ax, *(const bf16x8*)&bx, an, 0, 0, 0);
      }
    const unsigned char* Cd = Cs + dir * 64 * MLP;
#pragma unroll
    for (int ks = 0; ks < 4; ++ks) {
      const bf16x8 a = *(const bf16x8*)(Cd + (et * 32 + r32) * MLP + (ks * 16 + hi * 8) * 2);
      ac = __builtin_amdgcn_mfma_f32_32x32x16_bf16(a, bq[ks], ac, 0, 0, 0);
    }
#pragma unroll
    for (int r = 0; r < 16; ++r) HB[dir * 64 * 65 + t * 65 + et * 32 + crow(r, hi)] = (an[r] + iw * ac[r]) * rden;
  }
  __syncthreads();
  {
    const int t = tid >> 3, e8 = (tid & 7) * 8;
    float v[8]; float ss = 0.f;
#pragma unroll
    for (int i = 0; i < 8; ++i) { v[i] = HB[t * 65 + e8 + i] + HB[64 * 65 + t * 65 + e8 + i]; ss += v[i] * v[i]; }
    ss += __shfl_xor(ss, 1); ss += __shfl_xor(ss, 2); ss += __shfl_xor(ss, 4);
    const float rs = rsqrtf(ss * (1.f / 64.f) + EPS);
    const u32x4 ov = *(const u32x4*)(PROJ + (size_t)(row0 + t) * PW + C_MO + hh * 64 + e8);
    const float og[8] = {bflo(ov.x), bfhi(ov.x), bflo(ov.y), bfhi(ov.y), bflo(ov.z), bfhi(ov.z), bflo(ov.w), bfhi(ov.w)};
    const float* g = p.in[I_MNORMG] + l * 64 + e8;
    float o[8];
#pragma unroll
    for (int i = 0; i < 8; ++i) o[i] = (ABL & 2) ? 0.f : v[i] * rs * g[i] * sigmoidf_(og[i]);
    u32x4 w; w.x = cvtpk(o[0], o[1]); w.y = cvtpk(o[2], o[3]); w.z = cvtpk(o[4], o[5]); w.w = cvtpk(o[6], o[7]);
    *(u32x4*)(MIX + (size_t)(row0 + t) * DM + 256 + hh * 64 + e8) = w;
  }
  __syncthreads();
}

#define KSWZ(row, colB) ((row) * 256 + ((colB) ^ (((row) & 15) << 4)))
#define SBAR() __builtin_amdgcn_sched_barrier(0)
constexpr int ATT_SHM_V = 128 * 80, ATT_SHM_K = 64 * 128 * 2;
constexpr float ATT_THR = 8.0f;
__device__ __forceinline__ int v_st(int k, int c) { const int kk = (k & ~0xC) | ((k & 4) << 1) | ((k & 8) >> 1); return ((kk >> 3) * 4 + (c >> 5)) * 512 + ((kk & 7) * 32 + (c & 31)) * 2; }
__device__ __forceinline__ int v_rd_base(int lane) { return ((lane & 3) << 3) | (((lane >> 2) & 3) << 6) | (((lane >> 4) & 1) << 5) | (((lane >> 5) & 1) << 8); }
constexpr int v_rd_off(int d0, int ks, int half) { return d0 * 512 + ks * 4096 + half * 2048; }
template <int OFF> __device__ __forceinline__ s16x4 tr_read(int vb) {
  s16x4 r; asm volatile("ds_read_b64_tr_b16 %0, %1 offset:%2" : "=&v"(r) : "v"(vb), "i"(OFF) : "memory"); return r;
}
template <int D0> __device__ __forceinline__ void pv_one(f32x16& od, int vb, bf16x8 pa0, bf16x8 pa1, bf16x8 pa2, bf16x8 pa3) {
  const s16x4 l0 = tr_read<v_rd_off(D0, 0, 0)>(vb), h0 = tr_read<v_rd_off(D0, 0, 1)>(vb), l1 = tr_read<v_rd_off(D0, 1, 0)>(vb), h1 = tr_read<v_rd_off(D0, 1, 1)>(vb);
  const s16x4 l2 = tr_read<v_rd_off(D0, 2, 0)>(vb), h2 = tr_read<v_rd_off(D0, 2, 1)>(vb), l3 = tr_read<v_rd_off(D0, 3, 0)>(vb), h3 = tr_read<v_rd_off(D0, 3, 1)>(vb);
  asm volatile("s_waitcnt lgkmcnt(0)" ::: "memory"); SBAR();
#define PK(L, H) (bf16x8){L[0], L[1], L[2], L[3], H[0], H[1], H[2], H[3]}
  od = __builtin_amdgcn_mfma_f32_32x32x16_bf16(pa0, PK(l0, h0), od, 0, 0, 0);
  od = __builtin_amdgcn_mfma_f32_32x32x16_bf16(pa1, PK(l1, h1), od, 0, 0, 0);
  od = __builtin_amdgcn_mfma_f32_32x32x16_bf16(pa2, PK(l2, h2), od, 0, 0, 0);
  od = __builtin_amdgcn_mfma_f32_32x32x16_bf16(pa3, PK(l3, h3), od, 0, 0, 0);
#undef PK
}
template <int D0> __device__ __forceinline__ void pv_two(f32x16& oa, f32x16& ob, int vb, bf16x8 a0, bf16x8 a1, bf16x8 a2, bf16x8 a3, bf16x8 b0, bf16x8 b1, bf16x8 b2, bf16x8 b3) {
  const s16x4 l0 = tr_read<v_rd_off(D0, 0, 0)>(vb), h0 = tr_read<v_rd_off(D0, 0, 1)>(vb), l1 = tr_read<v_rd_off(D0, 1, 0)>(vb), h1 = tr_read<v_rd_off(D0, 1, 1)>(vb);
  const s16x4 l2 = tr_read<v_rd_off(D0, 2, 0)>(vb), h2 = tr_read<v_rd_off(D0, 2, 1)>(vb), l3 = tr_read<v_rd_off(D0, 3, 0)>(vb), h3 = tr_read<v_rd_off(D0, 3, 1)>(vb);
  asm volatile("s_waitcnt lgkmcnt(0)" ::: "memory"); SBAR();
#define PK(L, H) (bf16x8){L[0], L[1], L[2], L[3], H[0], H[1], H[2], H[3]}
  const bf16x8 v0 = PK(l0, h0), v1 = PK(l1, h1), v2 = PK(l2, h2), v3 = PK(l3, h3);
  oa = __builtin_amdgcn_mfma_f32_32x32x16_bf16(a0, v0, oa, 0, 0, 0);
  ob = __builtin_amdgcn_mfma_f32_32x32x16_bf16(b0, v0, ob, 0, 0, 0);
  oa = __builtin_amdgcn_mfma_f32_32x32x16_bf16(a1, v1, oa, 0, 0, 0);
  ob = __builtin_amdgcn_mfma_f32_32x32x16_bf16(b1, v1, ob, 0, 0, 0);
  oa = __builtin_amdgcn_mfma_f32_32x32x16_bf16(a2, v2, oa, 0, 0, 0);
  ob = __builtin_amdgcn_mfma_f32_32x32x16_bf16(b2, v2, ob, 0, 0, 0);
  oa = __builtin_amdgcn_mfma_f32_32x32x16_bf16(a3, v3, oa, 0, 0, 0);
  ob = __builtin_amdgcn_mfma_f32_32x32x16_bf16(b3, v3, ob, 0, 0, 0);
#undef PK
}
__device__ __forceinline__ void att_qkt(f32x16& p0, f32x16& p1, const unsigned char* Ks, const unsigned char* Qs, int qrow, int comp, int r32, int hi, float init) {
#pragma unroll
  for (int r = 0; r < 16; ++r) { p0[r] = init; p1[r] = init; }
#pragma unroll
  for (int d0 = 0; d0 < 4; ++d0) {
    const int cb = ((comp * 4 + d0) * 16 + hi * 8) * 2;
    const bf16x8 b0 = *(const bf16x8*)(Ks + KSWZ(r32, cb));
    const bf16x8 b1 = *(const bf16x8*)(Ks + KSWZ(32 + r32, cb));
    const bf16x8 q = *(const bf16x8*)(Qs + KSWZ(qrow, cb));
    p0 = __builtin_amdgcn_mfma_f32_32x32x16_bf16(b0, q, p0, 0, 0, 0);
    p1 = __builtin_amdgcn_mfma_f32_32x32x16_bf16(b1, q, p1, 0, 0, 0);
  }
}
__device__ __forceinline__ void att_softmax(f32x16& p0, f32x16& p1, float& m_reg, float& l_reg, float& alpha, bool first, i32x8& pa) {
  alpha = 1.f;
  if (first) {
    float pmax = p0[0];
#pragma unroll
    for (int r = 1; r < 16; ++r) pmax = fmaxf(pmax, p0[r]);
#pragma unroll
    for (int r = 0; r < 16; ++r) pmax = fmaxf(pmax, p1[r]);
    { auto rr = __builtin_amdgcn_permlane32_swap(__float_as_uint(pmax), __float_as_uint(pmax), false, false);
      pmax = fmaxf(__uint_as_float(rr[0]), __uint_as_float(rr[1])); }
    alpha = 0.f; m_reg = pmax;
#pragma unroll
    for (int r = 0; r < 16; ++r) { p0[r] -= pmax; p1[r] -= pmax; }
  }
#pragma unroll
  for (int r = 0; r < 16; ++r) { p0[r] = __builtin_amdgcn_exp2f(p0[r]); p1[r] = __builtin_amdgcn_exp2f(p1[r]); }
  float ps = 0.f;
#pragma unroll
  for (int r = 0; r < 16; ++r) ps += p0[r];
#pragma unroll
  for (int r = 0; r < 16; ++r) ps += p1[r];
  { auto rr = __builtin_amdgcn_permlane32_swap(__float_as_uint(ps), __float_as_uint(ps), false, false);
    ps = __uint_as_float(rr[0]) + __uint_as_float(rr[1]); }
  if (__builtin_expect(!first && __any(ps > 256.f), 0)) {
    float emax = p0[0];
#pragma unroll
    for (int r = 1; r < 16; ++r) emax = fmaxf(emax, p0[r]);
#pragma unroll
    for (int r = 0; r < 16; ++r) emax = fmaxf(emax, p1[r]);
    { auto rr = __builtin_amdgcn_permlane32_swap(__float_as_uint(emax), __float_as_uint(emax), false, false);
      emax = fmaxf(__uint_as_float(rr[0]), __uint_as_float(rr[1])); }
    const float delta = fmaxf(__builtin_amdgcn_logf(emax), 0.f);
    alpha = __builtin_amdgcn_exp2f(-delta); m_reg += delta;
#pragma unroll
    for (int r = 0; r < 16; ++r) { p0[r] *= alpha; p1[r] *= alpha; }
    ps *= alpha;
  }
  l_reg = l_reg * alpha + ps;
#pragma unroll
  for (int v = 0; v < 4; ++v) {
    int w0 = 0, w1 = 0;
    w0 = __builtin_amdgcn_cvt_pk_fp8_f32(p0[4 * v], p0[4 * v + 1], w0, false); w0 = __builtin_amdgcn_cvt_pk_fp8_f32(p0[4 * v + 2], p0[4 * v + 3], w0, true);
    w1 = __builtin_amdgcn_cvt_pk_fp8_f32(p1[4 * v], p1[4 * v + 1], w1, false); w1 = __builtin_amdgcn_cvt_pk_fp8_f32(p1[4 * v + 2], p1[4 * v + 3], w1, true);
    pa[v] = w0; pa[4 + v] = w1;
  }
}
__device__ __forceinline__ void att_unit(const bf16_t* __restrict__ Qb, const bf16_t* __restrict__ Kh, const unsigned char* __restrict__ V8, bf16_t* __restrict__ Ob,
                                         int nkeys, float lam, const float* __restrict__ ng, float oscale, unsigned char* lds) {
  int tid_ = threadIdx.x; asm volatile("" : "+v"(tid_)); const int tid = tid_, wid = tid >> 6, lane = tid & 63, r32 = lane & 31, hi = lane >> 5;
  unsigned char* V_lds = lds; unsigned char* K_lds = lds + 2 * ATT_SHM_V;
  float* wsl = (float*)(lds + 2 * ATT_SHM_V + 2 * ATT_SHM_K) + wid * 64; float* li_l = wsl; float* al_l = wsl + 32;
  float m0 = 0.f, l0 = 0.f, m1 = 0.f, l1 = 0.f;
  f32x16 o0[4] = {}, o1[4] = {};
  unsigned char* Q_lds = lds + 2 * ATT_SHM_V + 2 * ATT_SHM_K + 2048;
#pragma unroll
  for (int i = 0; i < 8; ++i) { const int id = tid + 512 * i, qrw = id >> 4, ch = id & 15;
    *(bf16x8*)(Q_lds + KSWZ(qrw, ch * 16)) = *(const bf16x8*)(Qb + (size_t)qrw * PW + ch * 8); }
  const int qrow = wid * 32 + r32;
  int kso[2];
#pragma unroll
  for (int i = 0; i < 2; ++i) {
    const int o16 = tid + 512 * i;
    { const int row = o16 >> 4, cs = (o16 & 15) ^ (row & 15); kso[i] = row * PW + cs * 8; }
  }
  const unsigned ldsw = (unsigned)__builtin_amdgcn_readfirstlane(wid) * 1024u;
#define GSTAGE(b, k0) do { _Pragma("unroll") for (int i_ = 0; i_ < 2; ++i_) \
    __builtin_amdgcn_global_load_lds((const unsigned*)(Kh + (size_t)(k0) * PW + kso[i_]), (LAS unsigned*)(K_lds + (b) * ATT_SHM_K + ldsw + i_ * 8192), 16, 0, 0); \
    { const unsigned char* vi_ = V8 + (size_t)((k0) >> 6) * ATT_SHM_V + tid * 16; \
      __builtin_amdgcn_global_load_lds((const unsigned*)vi_, (LAS unsigned*)(V_lds + (b) * ATT_SHM_V + ldsw), 16, 0, 0); \
      if (wid < 2) __builtin_amdgcn_global_load_lds((const unsigned*)(vi_ + 8192), (LAS unsigned*)(V_lds + (b) * ATT_SHM_V + 8192 + ldsw), 16, 0, 0); } } while (0)
#define RESC(o, a) do { if (__any((a) < 1.f)) { if (hi == 0) al_l[r32] = (a); asm volatile("s_waitcnt lgkmcnt(0)" ::: "memory"); \
    _Pragma("unroll") for (int d = 0; d < 4; ++d) _Pragma("unroll") for (int r = 0; r < 16; ++r) o[d][r] *= al_l[crow(r, hi)]; } } while (0)
  const int NT = nkeys / 64;
  GSTAGE(0, 0); asm volatile("s_waitcnt vmcnt(0)" ::: "memory"); __syncthreads();
  for (int j = 0; j < NT; ++j) {
    const int cur = j & 1;
    if (j + 1 < NT) GSTAGE(cur ^ 1, (j + 1) * 64);
    const unsigned char* Kc = K_lds + cur * ATT_SHM_K; const unsigned char* Vc = V_lds + cur * ATT_SHM_V;
    f32x16 p0, p1, q0, q1; float alphaA, alphaB; i32x8 pa, pb;
    const bool first = (j == 0);
    att_qkt(p0, p1, Kc, Q_lds, qrow, 0, r32, hi, first ? 0.f : -m0);
    att_qkt(q0, q1, Kc, Q_lds, qrow, 1, r32, hi, first ? 0.f : -m1);
    att_softmax(p0, p1, m0, l0, alphaA, first, pa);
    att_softmax(q0, q1, m1, l1, alphaB, first, pb);
    RESC(o0, alphaA);
    RESC(o1, alphaB);
#pragma unroll
    for (int d0 = 0; d0 < 4; ++d0) {
      const unsigned char* vrow = Vc + (d0 * 32 + r32) * 80 + hi * 32;
      const u32x4 v0 = *(const u32x4*)vrow, v1 = *(const u32x4*)(vrow + 16);
      i32x8 bv; bv[0] = (int)v0.x; bv[1] = (int)v0.y; bv[2] = (int)v0.z; bv[3] = (int)v0.w; bv[4] = (int)v1.x; bv[5] = (int)v1.y; bv[6] = (int)v1.z; bv[7] = (int)v1.w;
      o0[d0] = __builtin_amdgcn_mfma_scale_f32_32x32x64_f8f6f4(pa, bv, o0[d0], 0, 0, 0, 0x7F7F7F7F, 0, 0x7F7F7F7F);
      o1[d0] = __builtin_amdgcn_mfma_scale_f32_32x32x64_f8f6f4(pb, bv, o1[d0], 0, 0, 0, 0x7F7F7F7F, 0, 0x7F7F7F7F);
    }
    asm volatile("s_waitcnt vmcnt(0)" ::: "memory");
    __syncthreads();
  }
  if (hi == 0) { li_l[r32] = 1.f / l0; al_l[r32] = lam / l1; }
  asm volatile("s_waitcnt lgkmcnt(0)" ::: "memory");
  float ss[16];
#pragma unroll
  for (int r = 0; r < 16; ++r) {
    const float a = li_l[crow(r, hi)], bq = al_l[crow(r, hi)];
    float s = 0.f;
#pragma unroll
    for (int d = 0; d < 4; ++d) { const float v = o0[d][r] * a - o1[d][r] * bq; o0[d][r] = v; s += v * v; }
    s += __shfl_xor(s, 1); s += __shfl_xor(s, 2); s += __shfl_xor(s, 4); s += __shfl_xor(s, 8); s += __shfl_xor(s, 16);
    ss[r] = rsqrtf(s * (1.f / 128.f) + EPS) * oscale;
  }
  bf16_t* Ow = Ob + (size_t)(wid * 32) * DM;
#pragma unroll
  for (int d = 0; d < 4; ++d) {
    const float g = ng[d * 32 + r32];
#pragma unroll
    for (int r = 0; r < 16; ++r) Ow[(size_t)crow(r, hi) * DM + d * 32 + r32] = (ABL & 4) ? (bf16_t)0 : (bf16_t)(cvtpk(o0[d][r] * ss[r] * g, 0.f) & 0xffffu);
  }
  __syncthreads();
#undef GSTAGE
#undef RESC
}

__device__ __forceinline__ float ins16(float (&a)[16], float x) {
#pragma unroll
  for (int i = 0; i < 16; ++i) { const float h = fmaxf(a[i], x); x = fminf(a[i], x); a[i] = h; }
  return x;
}
__device__ __forceinline__ void bsort16(float (&a)[16]) {
#pragma unroll
  for (int k = 2; k <= 16; k <<= 1)
#pragma unroll
    for (int j = k >> 1; j > 0; j >>= 1)
#pragma unroll
      for (int i = 0; i < 16; ++i) {
        const int q = i ^ j;
        if (q > i) {
          const bool desc = ((i & k) == 0);
          const float hi_ = fmaxf(a[i], a[q]), lo_ = fminf(a[i], a[q]);
          a[i] = desc ? hi_ : lo_; a[q] = desc ? lo_ : hi_;
        }
      }
}
__device__ __forceinline__ void bmerge16(float (&a)[16], const float (&b)[16]) {
#pragma unroll
  for (int i = 0; i < 16; ++i) a[i] = fmaxf(a[i], b[15 - i]);
#pragma unroll
  for (int j = 8; j > 0; j >>= 1)
#pragma unroll
    for (int i = 0; i < 16; ++i) {
      const int q = i ^ j;
      if (q > i) { const float hi_ = fmaxf(a[i], a[q]), lo_ = fminf(a[i], a[q]); a[i] = hi_; a[q] = lo_; }
    }
}
__device__ __forceinline__ float gelu_erf(float x) { return 0.5f * x * (1.f + erff(x * 0.70710678118654752440f)); }
#define XB_TMO      128
#define XB_XCNT(j)  (256  + 64 * (j))
#define XB_XSUB(j)  (1280 + 64 * (j))
#define XB_XGEN(j)  (2304 + 64 * (j))
#define XB_TOP      3328
#define XB_TOPGEN   3392
#define XCD_BAR_WORDS 3456
#define XB_SPIN_CAP (1u << 22)
__device__ __forceinline__ unsigned xb_ld(unsigned* p)              { return __hip_atomic_load(p, __ATOMIC_RELAXED, __HIP_MEMORY_SCOPE_AGENT); }
__device__ __forceinline__ unsigned xb_add(unsigned* p, unsigned v) { return __hip_atomic_fetch_add(p, v, __ATOMIC_RELAXED, __HIP_MEMORY_SCOPE_AGENT); }
__device__ __forceinline__ unsigned xb_xcc_id() { return (unsigned)__builtin_amdgcn_s_getreg((3 << 11) | 20) & 0xFu; }
#define XB_SPIN(cond, bar) do { unsigned _sp = 0; while (cond) { __builtin_amdgcn_s_sleep(1); \
    if ((++_sp & 255u) == 0u) { if (xb_ld(&(bar)[XB_TMO])) break; if (_sp > XB_SPIN_CAP) { atomicAdd(&(bar)[XB_TMO], 1u); break; } } } } while (0)
struct XcdBarrier { unsigned* bar; unsigned x; volatile LAS unsigned* st; };
__device__ __forceinline__ XcdBarrier xcd_barrier_post(unsigned* bar, volatile LAS unsigned* st) {
  XcdBarrier b; b.bar = bar; b.x = xb_xcc_id(); b.st = st;
  if (threadIdx.x == 0) (void)xb_add(&bar[XB_XCNT(b.x)], 1u);
  return b;
}
__device__ __forceinline__ void xcd_barrier_complete(unsigned* bar, unsigned x, unsigned& nloc, unsigned& nx) {
  const unsigned G = gridDim.x * gridDim.y * gridDim.z;
  unsigned sum, cnt, mine, sp = 0u;
  for (;;) {
    sum = 0u; cnt = 0u; mine = 0u;
#pragma unroll
    for (unsigned j = 0; j < 16; ++j) { const unsigned c = xb_ld(&bar[XB_XCNT(j)]); sum += c; cnt += (c > 0u) ? 1u : 0u; mine = (j == x) ? c : mine; }
    if (sum == G) break;
    __builtin_amdgcn_s_sleep(1);
    if ((++sp & 255u) == 0u) { if (xb_ld(&bar[XB_TMO])) break; if (sp > XB_SPIN_CAP) { atomicAdd(&bar[XB_TMO], 1u); break; } }
  }
  nloc = mine > 0u ? mine : 1u; nx = cnt > 0u ? cnt : 1u;
}
__device__ __forceinline__ void xcd_barrier(const XcdBarrier& b) {
  asm volatile("s_waitcnt vmcnt(0)" ::: "memory");
  __syncthreads();
  if (threadIdx.x == 0) {
    unsigned* bar = b.bar;
    __builtin_amdgcn_s_waitcnt(0);
    unsigned nloc = b.st[0], nx = b.st[1];
    if (nloc == 0u) { xcd_barrier_complete(bar, b.x, nloc, nx); b.st[0] = nloc; b.st[1] = nx; }
    const unsigned old = xb_add(&bar[XB_XSUB(b.x)], 1u);
    const unsigned gen = old / nloc;
    if (old + 1u == (gen + 1u) * nloc) {
      __builtin_amdgcn_fence(__ATOMIC_RELEASE, "agent");
      asm volatile("s_waitcnt vmcnt(0)" ::: "memory");
      const unsigned og = xb_add(&bar[XB_TOP], 1u);
      const unsigned tg = og / nx;
      if (og + 1u == (tg + 1u) * nx) xb_add(&bar[XB_TOPGEN], 1u);
      else XB_SPIN(xb_ld(&bar[XB_TOPGEN]) == tg, bar);
      __builtin_amdgcn_fence(__ATOMIC_ACQUIRE, "agent");
      xb_add(&bar[XB_XGEN(b.x)], 1u);
      asm volatile("s_waitcnt vmcnt(0)" ::: "memory");
    } else {
      XB_SPIN(xb_ld(&bar[XB_XGEN(b.x)]) == gen, bar);
      __builtin_amdgcn_fence(__ATOMIC_ACQUIRE, "agent");
      asm volatile("s_waitcnt vmcnt(0)" ::: "memory");
    }
  }
  __syncthreads();
}

constexpr size_t RT_STRIDE = (size_t)T * 128 * 4;
__device__ __forceinline__ void route_unit(const Params& p, int l, int unit, unsigned char* lds) {
  int tid_ = threadIdx.x; asm volatile("" : "+v"(tid_)); const int tid = tid_, lane = tid & 63, wid = tid >> 6, r32 = lane & 31, hi = lane >> 5;
  unsigned char* IDX = lds;
  int* UE = (int*)(lds + 8192); float* UG = (float*)(lds + 8192 + 16384); float* US = (float*)(lds + 8192 + 32768);
  int* EIDG = (int*)(p.ws + WS_ULOC); float* GWG = (float*)(p.ws + WS_ULOC + RT_STRIDE); float* SUG = (float*)(p.ws + WS_ULOC + 2 * RT_STRIDE);
  const float* PSC = (const float*)(p.ws + WS_PSC);
  const int row0 = unit * 32;
  const bf16_t* QP = (const bf16_t*)(p.ws + WS_PROJ);
  const bf16_t* KEYS = (const bf16_t*)(p.ws + WS_KEYS) + (size_t)l * 131072;
  for (int rrep = 0; rrep < REP_ROUTE; ++rrep) {
    const int h = wid;
    float top[2][16];
#pragma unroll
    for (int pp = 0; pp < 2; ++pp) {
      const bf16_t* qrow = QP + (size_t)(row0 + r32) * DM + h * 128 + pp * 64 + hi * 8;
      const bf16_t* kb = KEYS + ((size_t)(h * 2 + pp) * 128 + r32) * 64 + hi * 8;
      bf16x8 bq[4];
#pragma unroll
      for (int ks = 0; ks < 4; ++ks) bq[ks] = *(const bf16x8*)(qrow + ks * 16);
      float (&lst)[16] = top[pp];
#pragma unroll
      for (int i = 0; i < 16; ++i) lst[i] = -INFINITY;
#pragma unroll
      for (int nt = 0; nt < 4; ++nt) {
        f32x16 acc = {};
#pragma unroll
        for (int ks = 0; ks < 4; ++ks) {
          const bf16x8 ak = *(const bf16x8*)(kb + (size_t)nt * 32 * 64 + ks * 16);
          acc = __builtin_amdgcn_mfma_f32_32x32x16_bf16(ak, bq[ks], acc, 0, 0, 0);
        }
        float grp[16];
#pragma unroll
        for (int r = 0; r < 16; ++r) grp[r] = __uint_as_float((__float_as_uint(acc[r]) & ~0x7Fu) | (unsigned)(nt * 32 + crow(r, hi)));
        bsort16(grp);
        if (nt == 0) {
#pragma unroll
          for (int i = 0; i < 16; ++i) lst[i] = grp[i];
        } else bmerge16(lst, grp);
        SBAR();
      }
      float oth[16];
#pragma unroll
      for (int i = 0; i < 16; ++i) oth[i] = __shfl_xor(lst[i], 32);
      bmerge16(lst, oth);
      if (hi == 0) {
        unsigned w[4];
#pragma unroll
        for (int i = 0; i < 4; ++i)
          w[i] = (__float_as_uint(lst[4 * i]) & 0x7Fu) | ((__float_as_uint(lst[4 * i + 1]) & 0x7Fu) << 8) | ((__float_as_uint(lst[4 * i + 2]) & 0x7Fu) << 16) | ((__float_as_uint(lst[4 * i + 3]) & 0x7Fu) << 24);
        *(u32x4*)(IDX + ((r32 * 8 + h) * 2 + pp) * 16) = (u32x4){w[0], w[1], w[2], w[3]};
      }
    }
    float best[16];
#define CAND(i, j) __uint_as_float((__float_as_uint(__uint_as_float(__float_as_uint(top[0][i]) & ~0x7Fu) + __uint_as_float(__float_as_uint(top[1][j]) & ~0x7Fu)) & ~0xFFu) | (unsigned)((i) * 16 + (j)))
    {
#pragma unroll
      for (int j = 0; j < 16; ++j) best[j] = CAND(0, j);
      float y[16];
#pragma unroll
      for (int j = 0; j < 8; ++j) { y[j] = CAND(1, j); y[8 + j] = CAND(15 - j, 0); }
#pragma unroll
      for (int jj = 8; jj > 0; jj >>= 1)
#pragma unroll
        for (int i = 0; i < 16; ++i) { const int q = i ^ jj; if (q > i) { const float hi_ = fmaxf(y[i], y[q]), lo_ = fminf(y[i], y[q]); y[i] = hi_; y[q] = lo_; } }
      bmerge16(best, y);
      float x[16];
      x[0] = CAND(2, 0); x[1] = CAND(2, 1); x[2] = CAND(2, 2); x[3] = CAND(2, 3); x[4] = CAND(2, 4);
      x[5] = CAND(3, 0); x[6] = CAND(3, 1); x[7] = CAND(3, 2); x[8] = CAND(3, 3);
      x[9] = CAND(4, 0); x[10] = CAND(4, 1); x[11] = CAND(4, 2);
      x[12] = CAND(5, 0); x[13] = CAND(5, 1); x[14] = CAND(6, 0); x[15] = CAND(6, 1);
      bsort16(x);
      bmerge16(best, x);
      ins16(best, CAND(7, 0)); ins16(best, CAND(7, 1));
    }
#undef CAND
    asm volatile("s_waitcnt lgkmcnt(0)" ::: "memory");
    if (hi == 0) {
      const unsigned char* ib = IDX + ((r32 * 8 + h) * 2) * 16;
      const float mx = __uint_as_float(__float_as_uint(best[0]) & ~0xFFu);
      float w[16]; float sum = 0.f;
#pragma unroll
      for (int k = 0; k < 16; ++k) { w[k] = __expf(__uint_as_float(__float_as_uint(best[k]) & ~0xFFu) - mx); sum += w[k]; }
      const float rsum = 1.f / sum;
      int ee[16]; float su_[16], sv_[16];
#pragma unroll
      for (int k = 0; k < 16; ++k) {
        const unsigned ij = __float_as_uint(best[k]) & 0xFFu;
        ee[k] = (int)ib[ij >> 4] * 128 + (int)ib[16 + (ij & 15)];
      }
#pragma unroll
      for (int k = 0; k < 16; ++k) { su_[k] = PSC[(size_t)l * NEXP + ee[k]]; sv_[k] = PSC[(size_t)(DEPTH + l) * NEXP + ee[k]]; }
#pragma unroll
      for (int k = 0; k < 16; ++k) {
        UE[r32 * 128 + h * 16 + k] = ee[k]; UG[r32 * 128 + h * 16 + k] = w[k] * rsum * sv_[k];
        US[r32 * 128 + h * 16 + k] = su_[k];
      }
    }
  }
  __syncthreads();
#pragma unroll 1
  for (int tt = 0; tt < 4; ++tt) {
    const int t = wid * 4 + tt;
    const int k0 = UE[t * 128 + lane], k1 = UE[t * 128 + 64 + lane];
    const float g0 = UG[t * 128 + lane], g1 = UG[t * 128 + 64 + lane], s0 = US[t * 128 + lane], s1 = US[t * 128 + 64 + lane];
    const int b0 = k0 >> 10, b1 = k1 >> 10;
    int base = 0, pos0 = 0, pos1 = 0;
#pragma unroll
    for (int b = 0; b < 16; ++b) {
      const unsigned long long m0 = __ballot(b0 == b), m1 = __ballot(b1 == b);
      const int c0 = __popcll(m0), c1 = __popcll(m1);
      const unsigned long long lt = (1ull << lane) - 1ull;
      if (b0 == b) pos0 = base + __popcll(m0 & lt);
      if (b1 == b) pos1 = base + c0 + __popcll(m1 & lt);
      base += c0 + c1;
    }
    const size_t ro = (size_t)(row0 + t) * 128;
    EIDG[ro + pos0] = k0; GWG[ro + pos0] = g0; SUG[ro + pos0] = s0;
    EIDG[ro + pos1] = k1; GWG[ro + pos1] = g1; SUG[ro + pos1] = s1;
  }
}
struct TokPref { int e0, e1; float g0, g1, s0, s1; u32x4 hA, hB; };
__device__ __forceinline__ void tok_prefetch(const Params& p, int row, int lane, TokPref& t) {
  const int* EIDG = (const int*)(p.ws + WS_ULOC) + (size_t)row * 128; const float* GWG = (const float*)(p.ws + WS_ULOC + RT_STRIDE) + (size_t)row * 128;
  const float* SUG = (const float*)(p.ws + WS_ULOC + 2 * RT_STRIDE) + (size_t)row * 128;
  const bf16_t* H = (const bf16_t*)(p.ws + WS_H);
  t.e0 = EIDG[lane]; t.e1 = EIDG[64 + lane]; t.g0 = GWG[lane]; t.g1 = GWG[64 + lane]; t.s0 = SUG[lane]; t.s1 = SUG[64 + lane];
  t.hA = *(const u32x4*)(H + (size_t)row * DM + lane * 16); t.hB = *(const u32x4*)(H + (size_t)row * DM + lane * 16 + 8);
}
__device__ __forceinline__ void gather_token(const Params& p, int l, int row, int nextrow, TokPref& tp, unsigned char* lds, int lane, int wid) {
  int* EW = (int*)(lds + wid * 2048); float* GWl = (float*)(lds + wid * 2048 + 512); float* SWl = (float*)(lds + wid * 2048 + 1024);
  const bf16_t* H = (const bf16_t*)(p.ws + WS_H);
  const unsigned char* PUq = p.ws + WS_PU + (size_t)l * NEXP * PROW;
  const unsigned char* PVq = p.ws + WS_PV + (size_t)l * NEXP * PROW;
  float* XC = (float*)(p.ws + WS_XCUR);
  const float* MOD = (const float*)(p.ws + WS_MOD);
  EW[lane] = tp.e0; EW[64 + lane] = tp.e1; GWl[lane] = tp.g0; GWl[64 + lane] = tp.g1; SWl[lane] = tp.s0; SWl[64 + lane] = tp.s1;
  asm volatile("s_waitcnt lgkmcnt(0)" ::: "memory");
  {
    f32x2 hf2[8];
    {
      const u32x4 hA = tp.hA, hB = tp.hB;
      hf2[0] = f32x2{bflo(hA.x), bfhi(hA.x)}; hf2[1] = f32x2{bflo(hA.y), bfhi(hA.y)}; hf2[2] = f32x2{bflo(hA.z), bfhi(hA.z)}; hf2[3] = f32x2{bflo(hA.w), bfhi(hA.w)};
      hf2[4] = f32x2{bflo(hB.x), bfhi(hB.x)}; hf2[5] = f32x2{bflo(hB.y), bfhi(hB.y)}; hf2[6] = f32x2{bflo(hB.z), bfhi(hB.z)}; hf2[7] = f32x2{bflo(hB.w), bfhi(hB.w)};
    }
    if (nextrow >= 0) tok_prefetch(p, nextrow, lane, tp);
    f32x4 xpre[4];
    { const float* xr_ = XC + (size_t)row * DM + lane * 16;
#pragma unroll
      for (int v4 = 0; v4 < 4; ++v4) xpre[v4] = *(const f32x4*)(xr_ + v4 * 4); }
    f32x2 acc2[8];
    for (int rep = 0; rep < REP_PEER; ++rep) {
#pragma unroll
    for (int i = 0; i < 8; ++i) acc2[i] = f32x2{0.f, 0.f};
    u32x3 uq[8];
#pragma unroll
    for (int i = 0; i < 8; ++i) { const int e0 = __builtin_amdgcn_readfirstlane(EW[i]); uq[i] = *(const u32x3*)(PUq + (size_t)e0 * PROW + lane * 12); }
    for (int g8 = 0; g8 < 16; ++g8) {
      int eid[8]; float gwt[8]; u32x3 vq[8];
#pragma unroll
      for (int i = 0; i < 8; ++i) {
        eid[i] = __builtin_amdgcn_readfirstlane(EW[g8 * 8 + i]);
        gwt[i] = __uint_as_float(__builtin_amdgcn_readfirstlane(__float_as_uint(GWl[g8 * 8 + i])));
        vq[i] = *(const u32x3*)(PVq + (size_t)eid[i] * PROW + lane * 12);
      }
      float d[8];
#pragma unroll
      for (int i2 = 0; i2 < 4; ++i2) {
        i32x6 w6; w6[0] = (int)uq[2 * i2].x; w6[1] = (int)uq[2 * i2].y; w6[2] = (int)uq[2 * i2].z; w6[3] = (int)uq[2 * i2 + 1].x; w6[4] = (int)uq[2 * i2 + 1].y; w6[5] = (int)uq[2 * i2 + 1].z;
        const f32x32 r = __builtin_amdgcn_cvt_scalef32_pk32_f32_fp6(w6, 1.0f);
        f32x2 a2 = __builtin_shufflevector(r, r, 0, 1) * hf2[0], b2 = __builtin_shufflevector(r, r, 16, 17) * hf2[0];
#define UDOT(k_) a2 = __builtin_shufflevector(r, r, 2 * (k_), 2 * (k_) + 1) * hf2[k_] + a2; b2 = __builtin_shufflevector(r, r, 16 + 2 * (k_), 17 + 2 * (k_)) * hf2[k_] + b2;
        UDOT(1) UDOT(2) UDOT(3) UDOT(4) UDOT(5) UDOT(6) UDOT(7)
#undef UDOT
        d[2 * i2] = (a2.x + a2.y) * __uint_as_float(__builtin_amdgcn_readfirstlane(__float_as_uint(SWl[g8 * 8 + 2 * i2])));
        d[2 * i2 + 1] = (b2.x + b2.y) * __uint_as_float(__builtin_amdgcn_readfirstlane(__float_as_uint(SWl[g8 * 8 + 2 * i2 + 1])));
        asm volatile("" : "+v"(d[2 * i2]), "+v"(d[2 * i2 + 1]));
      }
      if (g8 < 15) {
#pragma unroll
        for (int i = 0; i < 8; ++i) { const int e0 = __builtin_amdgcn_readfirstlane(EW[(g8 + 1) * 8 + i]); uq[i] = *(const u32x3*)(PUq + (size_t)e0 * PROW + lane * 12); }
      }
      float tot;
      {
        auto s01 = __builtin_amdgcn_permlane32_swap(__float_as_uint(d[0]), __float_as_uint(d[1]), false, false);
        auto s23 = __builtin_amdgcn_permlane32_swap(__float_as_uint(d[2]), __float_as_uint(d[3]), false, false);
        auto s45 = __builtin_amdgcn_permlane32_swap(__float_as_uint(d[4]), __float_as_uint(d[5]), false, false);
        auto s67 = __builtin_amdgcn_permlane32_swap(__float_as_uint(d[6]), __float_as_uint(d[7]), false, false);
        const float q01 = __uint_as_float(s01[0]) + __uint_as_float(s01[1]), q23 = __uint_as_float(s23[0]) + __uint_as_float(s23[1]);
        const float q45 = __uint_as_float(s45[0]) + __uint_as_float(s45[1]), q67 = __uint_as_float(s67[0]) + __uint_as_float(s67[1]);
        auto ta = __builtin_amdgcn_permlane16_swap(__float_as_uint(q01), __float_as_uint(q23), false, false);
        auto tb = __builtin_amdgcn_permlane16_swap(__float_as_uint(q45), __float_as_uint(q67), false, false);
        const float r0123 = __uint_as_float(ta[0]) + __uint_as_float(ta[1]);
        const float r4567 = __uint_as_float(tb[0]) + __uint_as_float(tb[1]);
        const bool b3 = (lane & 8) != 0;
        const float keep = b3 ? r4567 : r0123, send = b3 ? r0123 : r4567;
        float x = keep + dpp_mov<0x140>(send);
        x += dpp_mov<0xB1>(x); x += dpp_mov<0x4E>(x); x += dpp_mov<0x141>(x);
        tot = x;
      }
      float ge;
      {
        const float v = tot, av = fabsf(v), tq = __builtin_amdgcn_rcpf(av * 0.2316418882f + 1.0f);
        float q = tq * 0.5307027145f + (-0.7265760135f); q = q * tq + 0.7107068705f; q = q * tq + (-0.142248368f); q = q * tq + 0.127414796f; q = q * tq;
        const float ex = __builtin_amdgcn_exp2f(v * v * (-0.72134752044f));
        const float m = v * (q * ex), r = v - m;
        ge = v < 0.f ? m : r;
      }
      float c[8];
      c[0] = __uint_as_float(__builtin_amdgcn_readlane(__float_as_uint(ge), 0)) * gwt[0];  c[4] = __uint_as_float(__builtin_amdgcn_readlane(__float_as_uint(ge), 8)) * gwt[4];
      c[2] = __uint_as_float(__builtin_amdgcn_readlane(__float_as_uint(ge), 16)) * gwt[2]; c[6] = __uint_as_float(__builtin_amdgcn_readlane(__float_as_uint(ge), 24)) * gwt[6];
      c[1] = __uint_as_float(__builtin_amdgcn_readlane(__float_as_uint(ge), 32)) * gwt[1]; c[5] = __uint_as_float(__builtin_amdgcn_readlane(__float_as_uint(ge), 40)) * gwt[5];
      c[3] = __uint_as_float(__builtin_amdgcn_readlane(__float_as_uint(ge), 48)) * gwt[3]; c[7] = __uint_as_float(__builtin_amdgcn_readlane(__float_as_uint(ge), 56)) * gwt[7];
#pragma unroll
      for (int i2 = 0; i2 < 4; ++i2) {
        i32x6 w6; w6[0] = (int)vq[2 * i2].x; w6[1] = (int)vq[2 * i2].y; w6[2] = (int)vq[2 * i2].z; w6[3] = (int)vq[2 * i2 + 1].x; w6[4] = (int)vq[2 * i2 + 1].y; w6[5] = (int)vq[2 * i2 + 1].z;
        const f32x32 r = __builtin_amdgcn_cvt_scalef32_pk32_f32_fp6(w6, 1.0f);
        const f32x2 ca = {c[2 * i2], c[2 * i2]}, cb = {c[2 * i2 + 1], c[2 * i2 + 1]};
#define VAXPY(k_) acc2[k_] = ca * __builtin_shufflevector(r, r, 2 * (k_), 2 * (k_) + 1) + acc2[k_]; acc2[k_] = cb * __builtin_shufflevector(r, r, 16 + 2 * (k_), 17 + 2 * (k_)) + acc2[k_];
        VAXPY(0) VAXPY(1) VAXPY(2) VAXPY(3) VAXPY(4) VAXPY(5) VAXPY(6) VAXPY(7)
#undef VAXPY
        asm volatile("" : "+v"(acc2[0]), "+v"(acc2[1]), "+v"(acc2[2]), "+v"(acc2[3]), "+v"(acc2[4]), "+v"(acc2[5]), "+v"(acc2[6]), "+v"(acc2[7]));
      }
    }
    }
    SBAR();
    float acc[16];
#pragma unroll
    for (int i = 0; i < 8; ++i) { acc[2 * i] = acc2[i].x; acc[2 * i + 1] = acc2[i].y; }
    const int mr = mod_row(row);
    const float* g2 = MOD + ((size_t)l * 5 + mr) * 6144 + 5 * 1024;
    float* xr = XC + (size_t)row * DM;
    float xn[16]; float ssq = 0.f;
    if (ABL & 8) {
#pragma unroll
      for (int i = 0; i < 16; ++i) acc[i] = 0.f;
    }
#pragma unroll
    for (int v4 = 0; v4 < 4; ++v4) {
      const int c = lane * 16 + v4 * 4;
      const f32x4 xo = xpre[v4], gg = *(const f32x4*)(g2 + c);
      f32x4 o;
      o.x = xo.x + gg.x * acc[v4 * 4 + 0]; o.y = xo.y + gg.y * acc[v4 * 4 + 1]; o.z = xo.z + gg.z * acc[v4 * 4 + 2]; o.w = xo.w + gg.w * acc[v4 * 4 + 3];
      xn[v4 * 4 + 0] = o.x; xn[v4 * 4 + 1] = o.y; xn[v4 * 4 + 2] = o.z; xn[v4 * 4 + 3] = o.w;
      ssq += (o.x * o.x + o.y * o.y) + (o.z * o.z + o.w * o.w);
      if (l < DEPTH - 1) *(f32x4*)(xr + c) = o;
    }
    const float rs = rsqrtf(wave_sum(ssq) * (1.f / DM) + EPS);
    if (l == DEPTH - 1) {
      const int b = row / SEGL, s = row - b * SEGL;
      float* orow = p.out + ((size_t)(b * SEQ + (s - CTXL))) * DM;
      const float* fg = p.in[I_FINALG];
#pragma unroll
      for (int v4 = 0; v4 < 4; ++v4) {
        const int c = lane * 16 + v4 * 4;
        const f32x4 gg = *(const f32x4*)(fg + c);
        f32x4 o; o.x = xn[v4 * 4 + 0] * rs * gg.x; o.y = xn[v4 * 4 + 1] * rs * gg.y; o.z = xn[v4 * 4 + 2] * rs * gg.z; o.w = xn[v4 * 4 + 3] * rs * gg.w;
        *(f32x4*)(orow + c) = o;
      }
    } else {
      const float* m = MOD + ((size_t)(l + 1) * 5 + mr) * 6144;
      const float* ng = p.in[I_N1G] + (l + 1) * DM;
      bf16_t* hrow = (bf16_t*)(p.ws + WS_H) + (size_t)row * DM;
#pragma unroll
      for (int hh = 0; hh < 2; ++hh) {
        float y[8];
#pragma unroll
        for (int i = 0; i < 8; ++i) { const int c = lane * 16 + hh * 8 + i; y[i] = xn[hh * 8 + i] * rs * ng[c] * (1.f + m[1024 + c]) + m[c]; }
        u32x4 w; w.x = cvtpk(y[0], y[1]); w.y = cvtpk(y[2], y[3]); w.z = cvtpk(y[4], y[5]); w.w = cvtpk(y[6], y[7]);
        *(u32x4*)(hrow + lane * 16 + hh * 8) = w;
      }
    }
  }
}

__device__ __forceinline__ void phase_c1(const Params& p, int l, unsigned char* lds) {
  constexpr int NLOC = NBATCH * 4 * NCH, NCONV = T / 32;
  for (int u = p.bx; u < NLOC + NCONV; u += p.gx) {
    if (u < NLOC) ml_local_unit2(p, l, u, lds);
    else {
      const int cu = u - NLOC;
      if (l == DEPTH - 1 && (cu % (SEGL / 32)) < (CTXL / 32)) continue;
      conv_unit(p, l, cu, lds);
    }
  }
}
__device__ __forceinline__ void phase_c2(const Params& p, int l, unsigned char* lds) {
  ml_scan(p, lds);
  const float* lp = p.in[I_DLAM] + l * 256;
  float s01 = 0.f, s23 = 0.f;
  for (int i = 0; i < 64; ++i) { s01 += lp[i] * lp[64 + i]; s23 += lp[128 + i] * lp[192 + i]; }
  const float lam_init = 0.8f - 0.6f * expf(-0.3f * (float)l);
  const float lam = expf(s01) - expf(s23) + lam_init;
  const bf16_t* PROJ = (const bf16_t*)(p.ws + WS_PROJ);
  bf16_t* MIX = (bf16_t*)(p.ws + WS_MIX);
  const float* ng = p.in[I_DNORMG] + l * 128;
  const int nun = 512 + (l < DEPTH - 1 ? 16 : 0);
  for (int u = p.bx; u < nun; u += p.gx) {
    int bh, qrow, nkeys;
    if (u < 512) { const int xcd = u & 7, i = (u >> 3) & 31, rnd = u >> 8; bh = 2 * xcd + rnd; qrow = CTXL + i * 256; nkeys = SEGL; }
    else { bh = u - 512; qrow = 0; nkeys = CTXL; }
    const int b = bh >> 2, h = bh & 3;
    const size_t tok0 = (size_t)b * SEGL;
    for (int rep = 0; rep < REP_ATT; ++rep)
    att_unit(PROJ + (tok0 + qrow) * PW + C_DQ + h * 128, PROJ + tok0 * PW + C_DK + h * 128, p.ws + WS_V8T + (size_t)bh * NCH * ATT_SHM_V,
             MIX + (tok0 + qrow) * DM + 512 + h * 128, nkeys, lam, ng, 1.f - lam_init, lds);
  }
}
__device__ __forceinline__ void phase_c3(const Params& p, int l, unsigned char* lds) {
  constexpr int NU = NBATCH * 4 * NCH;
  for (int u = p.bx; u < NU; u += p.gx) {
    if (l == DEPTH - 1 && (u % NCH) < 4) continue;
    ml_out_unit2(p, l, u, lds);
  }
}
__device__ __forceinline__ void phase_route(const Params& p, int l, unsigned char* lds) {
  constexpr int NU = T / 32;
  for (int u = p.bx; u < NU; u += p.gx) {
    if (l == DEPTH - 1 && (u % (SEGL / 32)) < (CTXL / 32)) continue;
    route_unit(p, l, u, lds);
    __syncthreads();
  }
}
__device__ __forceinline__ void phase_gather(const Params& p, int l, unsigned char* lds) {
  int tid_ = threadIdx.x; asm volatile("" : "+v"(tid_)); const int lane = tid_ & 63, wid = tid_ >> 6;
  const int gw = p.bx * 8 + wid, NGW = p.gx * 8;
  const int ntok = (l == DEPTH - 1) ? NBATCH * SEQ : T;
#define TOKROW(ti_) ((l == DEPTH - 1) ? ((ti_) / SEQ) * SEGL + CTXL + ((ti_) % SEQ) : (ti_))
  TokPref tp;
  if (gw < ntok) tok_prefetch(p, TOKROW(gw), lane, tp);
  XcdBarrier xb; xb.bar = p.xbar_words; xb.x = p.xbar_x; xb.st = (volatile LAS unsigned*)((LAS unsigned char*)lds + p.lds_st_off);
  const int nrounds = (ntok + NGW - 1) / NGW;
  for (int r = 0; r < nrounds; ++r) {
    const int ti = gw + r * NGW;
    if (ti < ntok) {
      const int row = TOKROW(ti);
      const int nxt = ti + NGW < ntok ? TOKROW(ti + NGW) : -1;
      gather_token(p, l, row, nxt, tp, lds, lane, wid);
    }
#if GATHER_SYNC
    if (r + 1 < nrounds) { XcdBarrier xb2 = xb; size_t zb_ = 0; asm volatile("" : "+s"(zb_)); xb2.bar = xb.bar + zb_; xb2.x = xb.x + (unsigned)zb_; xcd_barrier(xb2); }
#endif
  }
#undef TOKROW
}

__global__ void __launch_bounds__(512, 2) mk_fwd(KArgs ka) {
  cg::grid_group grid = cg::this_grid();
  extern __shared__ __attribute__((aligned(16))) unsigned char lds[];
  const int lo = ka.ph_lo, hi = ka.ph_hi;
#define IN(k) (lo <= (k) && (k) < hi)
#ifndef PHASEMASK
#define PHASEMASK 0xFFFF
#endif
#define PH(i) ((PHASEMASK >> (i)) & 1)
#define MKP(q) Params q; { size_t z_ = 0; asm volatile("" : "+s"(z_)); \
    q.in = (InTab)((const __attribute__((address_space(4))) char*)__builtin_amdgcn_kernarg_segment_ptr() + z_); \
    q.out = ka.out + z_; q.ws = ka.ws + z_; q.ph_lo = lo; q.ph_hi = hi; q.bx = (int)blockIdx.x + (int)z_; q.gx = (int)gridDim.x + (int)z_; q.xbar_words = xbar.bar + z_; q.xbar_x = xbar.x + (unsigned)z_; q.lds_st_off = (unsigned)(LDS_BYTES - 64); }
#define SEAM(k) do { if (IN(k) && IN((k) + 1)) { if ((k) == 0) grid.sync(); else { XcdBarrier xb_ = xbar; size_t zb_ = 0; asm volatile("" : "+s"(zb_)); xb_.bar = xbar.bar + zb_; xb_.x = xbar.x + (unsigned)zb_; xcd_barrier(xb_); } } } while (0)
  volatile LAS unsigned* xst = (volatile LAS unsigned*)((LAS unsigned char*)lds + (LDS_BYTES - 64));
  if (threadIdx.x < 2) xst[threadIdx.x] = 0u;
  __syncthreads();
  XcdBarrier xbar = xcd_barrier_post((unsigned*)(ka.ws + WS_CTL) + 4096, xst);
  { MKP(p)
    if (PH(0) && IN(0)) for (int rep = 0; rep < REP_MISC; ++rep) { p0_mod(p, lds, (float*)(p.ws + WS_MOD)); p0_convert(p, lds); }
  }
  SEAM(0);
  { MKP(p)
    if (PH(1) && IN(1)) phase_norm(p, 0, 0, true, false);
  }
  SEAM(1);
#define LAYER(LL) { \
    int l = (LL); asm volatile("" : "+s"(l)); \
    const int b = 2 + 9 * (LL); \
    { MKP(q) if (PH(2) && IN(b + 0)) for (int rep = 0; rep < REP_GEMM; ++rep) phase_inproj2(q, l, lds); } \
    SEAM(b + 0); \
    { MKP(q) if (PH(3) && IN(b + 1)) for (int rep = 0; rep < REP_ML; ++rep) phase_c1(q, l, lds); } \
    SEAM(b + 1); \
    { MKP(q) if (PH(4) && IN(b + 2)) phase_c2(q, l, lds); } \
    SEAM(b + 2); \
    { MKP(q) if (PH(5) && IN(b + 3)) for (int rep = 0; rep < REP_ML; ++rep) phase_c3(q, l, lds); } \
    SEAM(b + 3); \
    { MKP(q) if (PH(6) && IN(b + 4)) phase_outproj2(q, l, lds); } \
    SEAM(b + 4); \
    { MKP(q) if (PH(7) && IN(b + 5)) for (int rep = 0; rep < REP_MISC; ++rep) phase_norm(q, l, 1, false, (LL) == DEPTH - 1); } \
    SEAM(b + 5); \
    { MKP(q) if (PH(8) && IN(b + 6)) for (int rep = 0; rep < REP_GEMM; ++rep) phase_peerq2(q, l, lds); } \
    SEAM(b + 6); \
    { MKP(q) if (PH(9) && IN(b + 7)) phase_route(q, l, lds); } \
    SEAM(b + 7); \
    { MKP(q) if (PH(9) && IN(b + 8)) phase_gather(q, l, lds); } \
    SEAM(b + 8); }
  LAYER(0) LAYER(1) LAYER(2) LAYER(3)
#undef LAYER
#undef IN
#undef SEAM
#undef MKP
}

extern "C" void kernel_launch(void* const* d_in, const int* in_sizes, int n_in, void* d_out, int out_size,
                              void* d_ws, size_t ws_size, hipStream_t stream) {
  static int grid = 0;
  if (grid == 0) {
    int dev = 0, cus = 0, per_cu = 0;
    (void)hipGetDevice(&dev);
    (void)hipDeviceGetAttribute(&cus, hipDeviceAttributeMultiprocessorCount, dev);
    (void)hipFuncSetAttribute((const void*)mk_fwd, hipFuncAttributeMaxDynamicSharedMemorySize, LDS_BYTES);
    (void)hipOccupancyMaxActiveBlocksPerMultiprocessor(&per_cu, (const void*)mk_fwd, 512, LDS_BYTES);
    fprintf(stderr, "kernel_launch: cus %d per_cu %d ws %zu (need %zu) n_in %d\n", cus, per_cu, ws_size, (size_t)WS_END, n_in);
    if (ws_size < WS_END || n_in != 23 || per_cu < 1) { fprintf(stderr, "kernel_launch: bad configuration, nothing launched\n"); grid = -1; return; }
    grid = cus;
  }
  if (grid < 0) return;
  (void)hipMemsetAsync((char*)d_ws + WS_CTL, 0, 65536, stream);
  KArgs p{};
  for (int i = 0; i < 23; ++i) p.in[i] = (const float*)d_in[i];
  p.out = (float*)d_out; p.ws = (unsigned char*)d_ws; p.ph_lo = 0; p.ph_hi = 38;
  void* args[] = {&p};
  hipError_t e = hipLaunchCooperativeKernel((const void*)mk_fwd, dim3(grid), dim3(512), args, LDS_BYTES, stream);
  if (e != hipSuccess) fprintf(stderr, "cooperative launch failed: %s (grid %d)\n", hipGetErrorString(e), grid);
}
```

```cpp
#include <hip/hip_runtime.h>
#include <hip/hip_cooperative_groups.h>
#include <cstdio>
#include <cstdint>
namespace cg = cooperative_groups;

constexpr int DM = 1024, NBATCH = 4, SEQ = 8192, CTXL = 256, SEGL = CTXL + SEQ, T = NBATCH * SEGL, DEPTH = 4;
constexpr int IN_W = 3088, PW = 3072;
constexpr int C_A = 0, C_MQ = 512, C_MK = 768, C_MV = 1024, C_MO = 1280, C_DQ = 1536, C_DK = 2048, C_DV = 2560;
constexpr int NCH = SEGL / 64;
constexpr int NEXP = 16384;
constexpr float EPS = 1e-6f;
#ifndef ABL
#define ABL 0
#endif
#ifndef GATHER_SYNC
#define GATHER_SYNC 0
#endif
#ifndef REP_ATT
#define REP_ATT 1
#endif
#ifndef GP_MASK
#define GP_MASK 0x3FFF
#endif
#ifndef REP_PEER
#define REP_PEER 1
#endif
#ifndef REP_GEMM
#define REP_GEMM 1
#endif
#ifndef REP_ROUTE
#define REP_ROUTE 1
#endif
#ifndef REP_OUTP
#define REP_OUTP 1
#endif
#ifndef REP_ML
#define REP_ML 1
#endif
#ifndef REP_MISC
#define REP_MISC 1
#endif
constexpr float QSCALE = 0.125f * 1.4426950408889634f;

constexpr size_t MiB = 1u << 20;
constexpr size_t WS_CTL = 0, WS_MOD = 1 * MiB, WS_ROPE = 2 * MiB, WS_WG = 4 * MiB, WS_KEYS = 5 * MiB, WS_MLMETA = 6 * MiB,
                 WS_GATES = 7 * MiB, WS_WIN = 10 * MiB, WS_WOUT = 34 * MiB, WS_WQ = 42 * MiB, WS_PU = 50 * MiB, WS_PV = 114 * MiB, WS_PSC = 178 * MiB  ,
                 WS_XCUR = 306 * MiB, WS_H = 438 * MiB, WS_MIX = 504 * MiB, WS_PROJ = 570 * MiB, WS_ULOC = 768 * MiB, WS_V8T = 836 * MiB  , WS_EID = 858 * MiB  , WS_END = 924 * MiB;
constexpr int USTRIDE = 4160;

constexpr int LDS_BYTES = 139264;

#define LAS __attribute__((address_space(3)))
typedef unsigned short bf16_t;
typedef short bf16x8 __attribute__((ext_vector_type(8)));
typedef short s16x4 __attribute__((ext_vector_type(4)));
typedef float f32x4 __attribute__((ext_vector_type(4)));
typedef float f32x16 __attribute__((ext_vector_type(16)));
typedef unsigned u32x4 __attribute__((ext_vector_type(4)));
typedef unsigned u32x2 __attribute__((ext_vector_type(2)));
typedef __bf16 bf16x2v __attribute__((ext_vector_type(2)));
typedef int i32x8 __attribute__((ext_vector_type(8)));
typedef int i32x6 __attribute__((ext_vector_type(6)));
struct __attribute__((aligned(4))) u32x3 { unsigned x, y, z; };
typedef float f32x32 __attribute__((ext_vector_type(32)));
constexpr int PROW = 768;
typedef float f32x2 __attribute__((ext_vector_type(2)));
typedef unsigned u32x3v __attribute__((ext_vector_type(3)));
typedef unsigned u32x2v __attribute__((ext_vector_type(2)));

struct KArgs {
  const float* in[23];
  float* out;
  unsigned char* ws;
  int ph_lo, ph_hi;
};
typedef const float* const __attribute__((address_space(4))) * InTab;
struct Params {
  InTab in;
  float* out;
  unsigned char* ws;
  int ph_lo, ph_hi;
  int bx, gx;
  unsigned* xbar_words; unsigned xbar_x; unsigned lds_st_off;
};
enum { I_X = 0, I_C, I_CTX, I_CCTX, I_ADAW, I_ADAB, I_N1G, I_N2G, I_WIN, I_CONVW, I_CONVB, I_CLNG, I_CLNB, I_GATEB, I_MNORMG, I_DLAM, I_DNORMG,
       I_WOUT, I_PWQ, I_PKEYS, I_PU, I_PV, I_FINALG };

__device__ __forceinline__ unsigned cvtpk(float lo, float hi) { unsigned r; asm volatile("v_cvt_pk_bf16_f32 %0, %1, %2" : "=v"(r) : "v"(lo), "v"(hi)); return r; }
__device__ __forceinline__ float bflo(unsigned u) { return __uint_as_float(u << 16); }
__device__ __forceinline__ float bfhi(unsigned u) { return __uint_as_float(u & 0xffff0000u); }
__device__ __forceinline__ float bf1(bf16_t u) { return __uint_as_float(((unsigned)u) << 16); }
__device__ __forceinline__ int crow(int r, int hi) { return (r & 3) + 8 * (r >> 2) + 4 * hi; }
template <int CTRL> __device__ __forceinline__ float dpp_mov(float v) {
  return __uint_as_float((unsigned)__builtin_amdgcn_update_dpp(0, (int)__float_as_uint(v), CTRL, 0xF, 0xF, true));
}
__device__ __forceinline__ float wave_sum(float v) {
#pragma unroll
  for (int o = 1; o < 64; o <<= 1) v += __shfl_xor(v, o);
  return v;
}
__device__ __forceinline__ float wave_max(float v) {
#pragma unroll
  for (int o = 1; o < 64; o <<= 1) v = fmaxf(v, __shfl_xor(v, o));
  return v;
}
__device__ __forceinline__ float sigmoidf_(float x) { return 1.f / (1.f + __expf(-x)); }
__device__ __forceinline__ float logsigmoidf_(float x) { return fminf(x, 0.f) - log1pf(__expf(-fabsf(x))); }
__device__ __forceinline__ const float* in_row(const float* x, const float* ctx, int row) {
  const int b = row / SEGL, s = row - b * SEGL;
  return s < CTXL ? ctx + ((size_t)(b * CTXL + s)) * DM : x + ((size_t)(b * SEQ + (s - CTXL))) * DM;
}
__device__ __forceinline__ int mod_row(int row) { const int b = row / SEGL, s = row - b * SEGL; return s < CTXL ? 4 : b; }

__device__ __forceinline__ void p0_mod(const Params& p, unsigned char* lds, float* MOD) {
  float* sil = (float*)lds;
  float* red = (float*)(lds + 20480);
  int tid_ = threadIdx.x; asm volatile("" : "+v"(tid_)); const int tid = tid_, lane = tid & 63, wid = tid >> 6;
  for (int i = tid; i < 5 * 1024; i += 512) {
    const float v = i < 4096 ? p.in[I_C][i] : p.in[I_CCTX][i - 4096];
    sil[i] = v / (1.f + __expf(-v));
  }
  __syncthreads();
  for (int item = p.bx; item < DEPTH * 96; item += p.gx) {
    const int l = item / 96, j0 = (item % 96) * 64;
    const float* W = p.in[I_ADAW] + (size_t)l * DM * 6144 + j0 + lane;
    float a0 = 0.f, a1 = 0.f, a2 = 0.f, a3 = 0.f, a4 = 0.f;
    const int k0 = wid * 128;
#pragma unroll 8
    for (int k = k0; k < k0 + 128; ++k) {
      const float w = W[(size_t)k * 6144];
      a0 += sil[k] * w; a1 += sil[1024 + k] * w; a2 += sil[2048 + k] * w; a3 += sil[3072 + k] * w; a4 += sil[4096 + k] * w;
    }
    red[(wid * 5 + 0) * 64 + lane] = a0; red[(wid * 5 + 1) * 64 + lane] = a1; red[(wid * 5 + 2) * 64 + lane] = a2;
    red[(wid * 5 + 3) * 64 + lane] = a3; red[(wid * 5 + 4) * 64 + lane] = a4;
    __syncthreads();
    if (tid < 320) {
      const int r = tid >> 6;
      float s = 0.f;
#pragma unroll
      for (int w = 0; w < 8; ++w) s += red[(w * 5 + r) * 64 + lane];
      MOD[((size_t)l * 5 + r) * 6144 + j0 + lane] = s + p.in[I_ADAB][l * 6144 + j0 + lane];
    }
    __syncthreads();
  }
}
__device__ __forceinline__ void transpose_item(const float* W, int ldw, int srccol0, bf16_t* WT, int K, int n0, int k0, float* scr, int lane) {
#pragma unroll 8
  for (int i = 0; i < 32; ++i) { const int kk = 2 * i + (lane >> 5); scr[kk * 33 + (lane & 31)] = W[(size_t)(k0 + kk) * ldw + srccol0 + (lane & 31)]; }
  asm volatile("s_waitcnt lgkmcnt(0)" ::: "memory");
  const int c = lane & 7;
#pragma unroll
  for (int j = 0; j < 4; ++j) {
    const int n = (lane >> 3) + 8 * j; const float* s = scr + (8 * c) * 33 + n;
    u32x4 o; o.x = cvtpk(s[0], s[33]); o.y = cvtpk(s[66], s[99]); o.z = cvtpk(s[132], s[165]); o.w = cvtpk(s[198], s[231]);
    *(u32x4*)(WT + (size_t)(n0 + n) * K + k0 + 8 * c) = o;
  }
  asm volatile("s_waitcnt lgkmcnt(0)" ::: "memory");
}
__device__ __forceinline__ void convert_tables(const Params& p, int L, int wv, int nw, int lane) {
  unsigned char* PUq = p.ws + WS_PU; unsigned char* PVq = p.ws + WS_PV; float* PSC = (float*)(p.ws + WS_PSC);
  const int nrows = DEPTH * NEXP;
  for (int r = wv; r < 2 * NEXP; r += nw) {
    const int tb = r >= NEXP, rr = L * NEXP + (tb ? r - NEXP : r);
    const f32x4* srow = (const f32x4*)((tb ? p.in[I_PV] : p.in[I_PU]) + (size_t)rr * DM) + lane * 4;
    f32x4 v[4]; float mx = 0.f;
#pragma unroll
    for (int j = 0; j < 4; ++j) { v[j] = __builtin_nontemporal_load(srow + j); mx = fmaxf(mx, fmaxf(fmaxf(fabsf(v[j].x), fabsf(v[j].y)), fmaxf(fabsf(v[j].z), fabsf(v[j].w)))); }
    mx = wave_max(mx);
    const unsigned mb = __float_as_uint(mx);
    const int eb = (int)((mb >> 23) & 0xFFu);
    int sb = ((mb & 0x7FFFFFu) <= 0x700000u ? 129 : 128) - eb + 127; sb = sb < 1 ? 1 : (sb > 253 ? 253 : sb);
    const float sc = __uint_as_float((unsigned)sb << 23), isc = __uint_as_float((unsigned)(254 - sb) << 23);
    const float xv[16] = {v[0].x, v[0].y, v[0].z, v[0].w, v[1].x, v[1].y, v[1].z, v[1].w, v[2].x, v[2].y, v[2].z, v[2].w, v[3].x, v[3].y, v[3].z, v[3].w};
    unsigned wq[3] = {0u, 0u, 0u};
#pragma unroll
    for (int i = 0; i < 16; ++i) {
      const float a = fabsf(xv[i]) * sc;
      unsigned code = a < 2.f ? (unsigned)__builtin_rintf(a * 8.f) : (a < 4.f ? 8u + (unsigned)__builtin_rintf(a * 4.f) : 16u + (unsigned)__builtin_rintf(a * 2.f));
      code = code > 31u ? 31u : code;
      code |= (xv[i] < 0.f) ? 32u : 0u;
      const int bp = 6 * i, dw = bp >> 5, off = bp & 31;
      wq[dw] |= code << off;
      if (off > 26) wq[dw + 1] |= code >> (32 - off);
    }
    u32x3 o; o.x = wq[0]; o.y = wq[1]; o.z = wq[2];
    *(u32x3*)((tb ? PVq : PUq) + (size_t)rr * PROW + lane * 12) = o;
    if (lane == 0) PSC[(size_t)tb * nrows + rr] = isc;
  }
}
__device__ __forceinline__ void tail_filler_tables(const Params& p, int L, int nwg) {
  int tid_ = threadIdx.x; asm volatile("" : "+v"(tid_)); const int lane = tid_ & 63, wid = tid_ >> 6;
  const int nextra = nwg % p.gx, first = nextra, nidle = p.gx - nextra;
  if (p.bx < first) return;
  convert_tables(p, L, (p.bx - first) * 8 + wid, nidle * 8, lane);
}
__device__ __forceinline__ void p0_convert(const Params& p, unsigned char* lds) {
  int tid_ = threadIdx.x; asm volatile("" : "+v"(tid_)); const int tid = tid_, lane = tid & 63, wid = tid >> 6;
  const int gw = p.bx * 8 + wid, NGW = p.gx * 8;
  const size_t gt = (size_t)p.bx * 512 + tid, NGT = (size_t)p.gx * 512;
  float* scr = (float*)(lds + 32768) + wid * (64 * 33);
  bf16_t* WIN = (bf16_t*)(p.ws + WS_WIN); bf16_t* WOUT = (bf16_t*)(p.ws + WS_WOUT); bf16_t* WQ = (bf16_t*)(p.ws + WS_WQ);
  constexpr int I_IN = 16 * 96, I_O = 16 * 32, PER_L = I_IN + 2 * I_O;
  for (int it = gw; it < DEPTH * PER_L; it += NGW) {
    const int l = it / PER_L; int r = it % PER_L;
    if (r < I_IN) { const int kb = r / 96, nb = r % 96, n0 = nb * 32; const int src = n0 < 1536 ? n0 : n0 + 16;
      transpose_item(p.in[I_WIN] + (size_t)l * DM * IN_W, IN_W, src, WIN + (size_t)l * PW * DM, DM, n0, kb * 64, scr, lane); continue; }
    r -= I_IN;
    if (r < I_O) { const int kb = r / 32, nb = r % 32;
      transpose_item(p.in[I_WOUT] + (size_t)l * DM * DM, DM, nb * 32, WOUT + (size_t)l * DM * DM, DM, nb * 32, kb * 64, scr, lane); continue; }
    r -= I_O;
    { const int kb = r / 32, nb = r % 32;
      transpose_item(p.in[I_PWQ] + (size_t)l * DM * DM, DM, nb * 32, WQ + (size_t)l * DM * DM, DM, nb * 32, kb * 64, scr, lane); }
  }
  bf16_t* WG = (bf16_t*)(p.ws + WS_WG);
  for (size_t i = gt; i < (size_t)DEPTH * 16 * DM; i += NGT) {
    const int l = (int)(i / (16 * DM)), g = (int)((i / DM) % 16), k = (int)(i % DM);
    WG[i] = (bf16_t)(cvtpk(p.in[I_WIN][(size_t)l * DM * IN_W + (size_t)k * IN_W + 1536 + g], 0.f) & 0xffffu);
  }
  bf16_t* KEYS = (bf16_t*)(p.ws + WS_KEYS);
  for (size_t i = gt; i < (size_t)DEPTH * 131072 / 8; i += NGT) {
    const f32x4 a = ((const f32x4*)p.in[I_PKEYS])[2 * i], b = ((const f32x4*)p.in[I_PKEYS])[2 * i + 1];
    u32x4 o; o.x = cvtpk(a.x, a.y); o.y = cvtpk(a.z, a.w); o.z = cvtpk(b.x, b.y); o.w = cvtpk(b.z, b.w);
    ((u32x4*)KEYS)[i] = o;
  }
  {
    float* RC = (float*)(p.ws + WS_ROPE); float* RS = RC + SEQ * 32;
    for (size_t i = gt; i < (size_t)SEQ * 32; i += NGT) {
      const int pos = (int)(i >> 5), j = (int)(i & 31);
      const int rr = pos >> 6, cc = pos & 63;
      const int jj = j & 15;
      const double e = -(double)jj * 0.83048202372184058696;
      const double fl = __builtin_floor(e); const double f = e - fl;
      const double z = f * 0.69314718055994530942;
      double ez = 1.0 + z * (1.0 + z * (0.5 + z * (1.0 / 6 + z * (1.0 / 24 + z * (1.0 / 120 + z * (1.0 / 720 + z * (1.0 / 5040 + z * (1.0 / 40320 + z * (1.0 / 362880 + z * (1.0 / 3628800 + z * (1.0 / 39916800 + z * (1.0 / 479001600))))))))))));
      const double inv = __builtin_ldexp(ez, (int)fl);
      const float invf = (float)inv;
      const float angf = (float)(j < 16 ? rr : cc) * invf;
      const double ang = (double)angf;
      const double kq = __builtin_rint(ang * 0.63661977236758134308);
      double r = __builtin_fma(-kq, 1.57079632679489655800e+00, ang);
      r = __builtin_fma(-kq, 6.12323399573676603587e-17, r);
      const double r2 = r * r;
      const double sn = r * (1.0 + r2 * (-1.0 / 6 + r2 * (1.0 / 120 + r2 * (-1.0 / 5040 + r2 * (1.0 / 362880 + r2 * (-1.0 / 39916800 + r2 * (1.0 / 6227020800.0)))))));
      const double cs = 1.0 + r2 * (-0.5 + r2 * (1.0 / 24 + r2 * (-1.0 / 720 + r2 * (1.0 / 40320 + r2 * (-1.0 / 3628800 + r2 * (1.0 / 479001600 + r2 * (-1.0 / 87178291200.0)))))));
      const int q = ((int)kq) & 3;
      double co, si;
      if (q == 0) { co = cs; si = sn; } else if (q == 1) { co = -sn; si = cs; } else if (q == 2) { co = -cs; si = -sn; } else { co = sn; si = -cs; }
      RC[i] = (float)co; RS[i] = (float)si;
    }
  }
}

__device__ __forceinline__ void norm_mod_row(const float* xrow, const float* g, const float* sc, const float* sh, bf16_t* orow, int lane) {
  const f32x4* xr = (const f32x4*)xrow + lane;
  f32x4 v[4]; float s = 0.f;
#pragma unroll
  for (int j = 0; j < 4; ++j) { v[j] = xr[64 * j]; s += (v[j].x * v[j].x + v[j].y * v[j].y) + (v[j].z * v[j].z + v[j].w * v[j].w); }
  const float rs = rsqrtf(wave_sum(s) * (1.f / DM) + EPS);
  u32x2* o = (u32x2*)orow + lane;
#pragma unroll
  for (int j = 0; j < 4; ++j) {
    const f32x4 gg = ((const f32x4*)g)[lane + 64 * j], cc = ((const f32x4*)sc)[lane + 64 * j], hh = ((const f32x4*)sh)[lane + 64 * j];
    const float y0 = v[j].x * rs * gg.x * (1.f + cc.x) + hh.x, y1 = v[j].y * rs * gg.y * (1.f + cc.y) + hh.y;
    const float y2 = v[j].z * rs * gg.z * (1.f + cc.z) + hh.z, y3 = v[j].w * rs * gg.w * (1.f + cc.w) + hh.w;
    u32x2 w; w.x = cvtpk(y0, y1); w.y = cvtpk(y2, y3);
    o[64 * j] = w;
  }
}
__device__ __forceinline__ void phase_norm(const Params& p, int l, int which, bool from_input, bool skip_ctx) {
  int tid_ = threadIdx.x; asm volatile("" : "+v"(tid_));
  const int lane = tid_ & 63, wid = tid_ >> 6;
  const int gw = p.bx * 8 + wid, NGW = p.gx * 8;
  const float* MOD = (const float*)(p.ws + WS_MOD);
  const float* XC = (const float*)(p.ws + WS_XCUR);
  bf16_t* H = (bf16_t*)(p.ws + WS_H);
  const float* g = p.in[which ? I_N2G : I_N1G] + l * DM;
  for (int row = gw; row < T; row += NGW) {
    const int mr = mod_row(row);
    if (skip_ctx && mr == 4) continue;
    const float* m = MOD + ((size_t)l * 5 + mr) * 6144 + which * 3072;
    const float* xr = from_input ? in_row(p.in[I_X], p.in[I_CTX], row) : XC + (size_t)row * DM;
    norm_mod_row(xr, g, m + 1024, m, H + (size_t)row * DM, lane);
  }
}

namespace pg8 {
#define PG8_LAS __attribute__((address_space(3)))
typedef unsigned short bf16_t;
typedef short bf16x8 __attribute__((ext_vector_type(8)));
typedef float f32x4 __attribute__((ext_vector_type(4)));
typedef unsigned u32x4 __attribute__((ext_vector_type(4)));
constexpr int BM = 256, BK = 64, HALF = 128, HTB = HALF * BK * 2  , STAGE_BYTES = 8 * HTB, NXCD = 8, WGM = 8;

__host__ __device__ __forceinline__ int lds_byte(int r, int c) { const int st = (r >> 4) * 2 + (c >> 5), rr = r & 15, cc = c & 31, ob = rr * 64 + cc * 2; return st * 1024 + (ob ^ (((ob >> 9) & 1) << 5)); }
__host__ __device__ __forceinline__ void stage_rc(int b, int& R, int& C) { const int st = b / 1024, sb = b % 1024, swz = sb ^ (((sb >> 9) & 1) << 5); R = (st >> 1) * 16 + swz / 64; C = (st & 1) * 32 + (swz % 64) / 2; }
__host__ __device__ __forceinline__ int perm32(int rho) { const int n = rho >> 4, i = rho & 15; return 8 * (i >> 2) + 4 * n + (i & 3); }

struct Unit { int pm, pn; };
struct Gemm { const bf16_t* A; const bf16_t* Bt; int M, N, K; };

struct StaticOrder {
    int nM, nN, nwg, G, c;
    __host__ __device__ void init(int M, int N, int G_, int c_) { nM = M / BM; nN = N / BM; nwg = nM * nN; G = G_; c = c_; }
    __host__ __device__ bool next(int i, Unit& u) const {
        const long L = (long)i * G + c; if (L >= nwg) return false;
        int wgid = (int)L; { const int q = nwg / NXCD, r = nwg % NXCD, xcd = wgid % NXCD, off = wgid / NXCD; wgid = (xcd < r ? xcd * (q + 1) : r * (q + 1) + (xcd - r) * q) + off; }
        const int nig = WGM * nN, gid = wgid / nig, fm = gid * WGM, gsz = (nM - fm) < WGM ? (nM - fm) : WGM;
        u.pm = fm + ((wgid % nig) % gsz); u.pn = (wgid % nig) / gsz; return true;
    }
    __device__ __forceinline__ void a_ready(const Unit&) const {}
    __device__ __forceinline__ void done(const Unit&) const {}
};
__device__ __forceinline__ unsigned cvt_pk_bf16(float lo, float hi) { unsigned r; asm volatile("v_cvt_pk_bf16_f32 %0, %1, %2" : "=v"(r) : "v"(lo), "v"(hi)); return r; }
template <class Epi, class Sched, bool ALIGN_EPI = false, bool SP2 = false>
__device__ __forceinline__ void gemm_phase(PG8_LAS unsigned char* lds, const Gemm g, const Sched& S, const Epi& E) {
    const int tid = threadIdx.x, wid = __builtin_amdgcn_readfirstlane(tid >> 6), lane = tid & 63, wr = wid >> 2, wc = wid & 3, fr = lane & 15, fq = lane >> 4;
    const int K = g.K, nt = K / BK;
    unsigned voffA[2], voffB[2];
#pragma unroll
    for (int i = 0; i < 2; ++i) { int R, C; stage_rc(tid * 16 + i * 8192, R, C); const int Rb = Epi::PERM ? ((R & ~31) + perm32(R & 31)) : R;
        voffA[i] = (unsigned)(R * K + C) * 2u; voffB[i] = (unsigned)(Rb * K + C) * 2u; }
    const size_t kstep = (size_t)(BK * 2);
    const size_t hstep = (size_t)HALF * K * 2;
    const size_t tstep = 2 * hstep;
    const unsigned ldsw = (unsigned)wid * 1024u;
    const int aoff = lds_byte(wr * 64 + fr, fq * 8), boff = lds_byte(wc * 32 + fr, fq * 8);
#define PG8_SA(b, h) (((b) * 2 + (h)) * HTB)
#define PG8_SB(b, h) ((4 + (b) * 2 + (h)) * HTB)
#define PG8_STAGE(bufoff, gbase, voff) do { _Pragma("unroll") for (int _i = 0; _i < 2; ++_i) \
        __builtin_amdgcn_global_load_lds((const unsigned*)((const char*)(gbase) + (voff)[_i]), (PG8_LAS unsigned*)(lds + (bufoff) + ldsw + _i * 8192), 16, 0, 0); } while (0)
#define PG8_LDA(dst, b, h) do { _Pragma("unroll") for (int m = 0; m < 4; ++m) _Pragma("unroll") for (int k = 0; k < 2; ++k) dst[m][k] = *(const PG8_LAS bf16x8*)(lds + PG8_SA(b, h) + aoff + m * 2048 + k * 1024); } while (0)
#define PG8_LDB(dst, b, h) do { _Pragma("unroll") for (int n = 0; n < 2; ++n) _Pragma("unroll") for (int k = 0; k < 2; ++k) dst[n][k] = *(const PG8_LAS bf16x8*)(lds + PG8_SB(b, h) + boff + n * 2048 + k * 1024); } while (0)
#define PG8_MMA(ai, bj, At, Bt) do { __builtin_amdgcn_s_setprio(1); _Pragma("unroll") for (int m = 0; m < 4; ++m) _Pragma("unroll") for (int n = 0; n < 2; ++n) _Pragma("unroll") for (int k = 0; k < 2; ++k) \
        acc[ai][bj][m][n] = __builtin_amdgcn_mfma_f32_16x16x32_bf16(Bt[n][k], At[m][k], acc[ai][bj][m][n], 0, 0, 0); __builtin_amdgcn_s_setprio(0); } while (0)
#define PG8_WAIT_V(n) asm volatile("s_waitcnt vmcnt(" #n ")" ::: "memory")
#define PG8_WAIT_L(n) asm volatile("s_waitcnt lgkmcnt(" #n ")" ::: "memory")
#define PG8_BAR __builtin_amdgcn_s_barrier()
#define PG8_SCHED __builtin_amdgcn_sched_barrier(0)
    Unit cur, nxt; int ui = 0;
    if (!S.next(0, cur)) return;
    f32x4 acc[2][2][4][2];
#pragma unroll
    for (int a = 0; a < 2; ++a)
#pragma unroll
        for (int b = 0; b < 2; ++b)
#pragma unroll
            for (int m = 0; m < 4; ++m)
#pragma unroll
                for (int n = 0; n < 2; ++n) acc[a][b][m][n] = (f32x4){0.f, 0.f, 0.f, 0.f};
    bf16x8 At[4][2], B0[2][2], B1[2][2];
    const char* cA = (const char*)g.A + (size_t)cur.pm * tstep; const char* cB = (const char*)g.Bt + (size_t)cur.pn * tstep;
    S.a_ready(cur);
    if constexpr (SP2) {
        PG8_STAGE(PG8_SB(0, 0), cB, voffB); PG8_STAGE(PG8_SB(0, 1), cB + hstep, voffB); PG8_STAGE(PG8_SA(0, 0), cA, voffA); PG8_STAGE(PG8_SA(0, 1), cA + hstep, voffA);
        if (wr == 1) PG8_BAR;
        PG8_WAIT_V(2); PG8_BAR;
        PG8_STAGE(PG8_SB(1, 0), cB + kstep, voffB); PG8_STAGE(PG8_SA(1, 0), cA + kstep, voffA); PG8_STAGE(PG8_SB(1, 1), cB + hstep + kstep, voffB);
        PG8_WAIT_V(6); PG8_BAR;
    } else {
        PG8_STAGE(PG8_SB(0, 0), cB, voffB); PG8_STAGE(PG8_SA(0, 0), cA, voffA); PG8_STAGE(PG8_SB(0, 1), cB + hstep, voffB); PG8_STAGE(PG8_SA(0, 1), cA + hstep, voffA);
        if (wr == 1) PG8_BAR;
        PG8_WAIT_V(4); PG8_BAR;
        PG8_STAGE(PG8_SB(1, 0), cB + kstep, voffB); PG8_STAGE(PG8_SA(1, 0), cA + kstep, voffA); PG8_STAGE(PG8_SB(1, 1), cB + hstep + kstep, voffB);
        PG8_WAIT_V(6); PG8_BAR;
    }
    for (;;) {
        const bool has_next = S.next(ui + 1, nxt);
        const char* nA = has_next ? (const char*)g.A + (size_t)nxt.pm * tstep : cA; const char* nB = has_next ? (const char*)g.Bt + (size_t)nxt.pn * tstep : cB;
        for (int t = 0; t < nt; t += 2) {
            const bool last = (t == nt - 2);
            const char* a1 = cA + (size_t)(t + 1) * kstep;
            const char* a2 = last ? nA : cA + (size_t)(t + 2) * kstep; const char* b2 = last ? nB : cB + (size_t)(t + 2) * kstep;
            const char* a3 = a2 + kstep; const char* b3 = b2 + kstep;
            if (last && has_next) S.a_ready(nxt);
            if constexpr (SP2) {
            PG8_LDB(B0, 0, 0); PG8_LDB(B1, 0, 1); PG8_SCHED; PG8_LDA(At, 0, 0); PG8_STAGE(PG8_SA(1, 1), a1 + hstep, voffA);
            PG8_WAIT_V(8); PG8_WAIT_L(0); PG8_BAR; PG8_MMA(0, 0, At, B0); PG8_MMA(0, 1, At, B1); PG8_BAR; PG8_SCHED;
            PG8_LDA(At, 0, 1); PG8_STAGE(PG8_SB(0, 0), b2, voffB); PG8_STAGE(PG8_SB(0, 1), b2 + hstep, voffB); PG8_STAGE(PG8_SA(0, 0), a2, voffA);
            PG8_WAIT_V(8); PG8_WAIT_L(0); PG8_BAR; PG8_MMA(1, 0, At, B0); PG8_MMA(1, 1, At, B1); PG8_BAR; PG8_SCHED;
            PG8_LDB(B0, 1, 0); PG8_LDB(B1, 1, 1); PG8_SCHED; PG8_LDA(At, 1, 0); PG8_STAGE(PG8_SA(0, 1), a2 + hstep, voffA);
            PG8_WAIT_V(8); PG8_WAIT_L(0); PG8_BAR; PG8_MMA(0, 0, At, B0); PG8_MMA(0, 1, At, B1); PG8_BAR; PG8_SCHED;
            PG8_LDA(At, 1, 1); PG8_STAGE(PG8_SB(1, 0), b3, voffB); PG8_STAGE(PG8_SB(1, 1), b3 + hstep, voffB); PG8_STAGE(PG8_SA(1, 0), a3, voffA);
            PG8_WAIT_V(8); PG8_WAIT_L(0); PG8_BAR; PG8_MMA(1, 0, At, B0); PG8_MMA(1, 1, At, B1); PG8_BAR; PG8_SCHED;
            } else {
            PG8_LDB(B0, 0, 0); PG8_SCHED; PG8_LDA(At, 0, 0); PG8_STAGE(PG8_SA(1, 1), a1 + hstep, voffA);
            PG8_WAIT_L(8); PG8_BAR; PG8_WAIT_L(0); PG8_MMA(0, 0, At, B0); PG8_BAR; PG8_SCHED;
            PG8_LDB(B1, 0, 1); PG8_STAGE(PG8_SB(0, 0), b2, voffB);
            PG8_BAR; PG8_WAIT_L(0); PG8_MMA(0, 1, At, B1); PG8_BAR;
            PG8_LDA(At, 0, 1); PG8_STAGE(PG8_SA(0, 0), a2, voffA);
            PG8_BAR; PG8_WAIT_L(0); PG8_MMA(1, 0, At, B0); PG8_BAR; PG8_SCHED;
            PG8_STAGE(PG8_SB(0, 1), b2 + hstep, voffB);
            PG8_WAIT_V(6); PG8_BAR; PG8_MMA(1, 1, At, B1); PG8_BAR;
            PG8_LDB(B0, 1, 0); PG8_SCHED; PG8_LDA(At, 1, 0); PG8_STAGE(PG8_SA(0, 1), a2 + hstep, voffA);
            PG8_WAIT_L(8); PG8_BAR; PG8_WAIT_L(0); PG8_MMA(0, 0, At, B0); PG8_BAR; PG8_SCHED;
            PG8_LDB(B1, 1, 1); PG8_STAGE(PG8_SB(1, 0), b3, voffB);
            PG8_BAR; PG8_WAIT_L(0); PG8_MMA(0, 1, At, B1); PG8_BAR;
            PG8_LDA(At, 1, 1); PG8_STAGE(PG8_SA(1, 0), a3, voffA);
            PG8_BAR; PG8_WAIT_L(0); PG8_MMA(1, 0, At, B0); PG8_BAR; PG8_SCHED;
            PG8_STAGE(PG8_SB(1, 1), b3 + hstep, voffB);
            PG8_WAIT_V(6); PG8_BAR; PG8_MMA(1, 1, At, B1); PG8_BAR;
            }
        }
        if constexpr (ALIGN_EPI) { if (wr == 0) PG8_BAR; }
        if constexpr (!Epi::AFTER_DRAIN) { E(acc, cur, wr, wc, fr, fq); S.done(cur); }
        if (!has_next) break;
#pragma unroll
        for (int a = 0; a < 2; ++a)
#pragma unroll
            for (int b = 0; b < 2; ++b)
#pragma unroll
                for (int m = 0; m < 4; ++m)
#pragma unroll
                    for (int n = 0; n < 2; ++n) acc[a][b][m][n] = (f32x4){0.f, 0.f, 0.f, 0.f};
        cur = nxt; cA = nA; cB = nB; ++ui;
        if constexpr (ALIGN_EPI) { if (wr == 1) PG8_BAR; }
    }
    PG8_WAIT_V(0);
    if constexpr (!ALIGN_EPI) { if (wr == 0) PG8_BAR; }
    PG8_BAR;
    if constexpr (Epi::AFTER_DRAIN) { E.fused(acc, cur, wr, wc, fr, fq, lds, wid, lane); S.done(cur); }
#undef PG8_SA
#undef PG8_SB
#undef PG8_STAGE
#undef PG8_LDA
#undef PG8_LDB
#undef PG8_MMA
#undef PG8_WAIT_V
#undef PG8_WAIT_L
#undef PG8_BAR
#undef PG8_SCHED
}
}

__device__ __forceinline__ int gswz(int row, int chunk) { return row * 128 + ((chunk ^ ((row >> 1) & 7)) << 4); }
__device__ __forceinline__ void gemm_tile(const bf16_t* __restrict__ A, int lda, const bf16_t* __restrict__ Bt, int ldb, int K,
                                          int row0, int col0, unsigned char* lds, f32x16 (&acc)[2][2]) {
  int tid_ = threadIdx.x; asm volatile("" : "+v"(tid_)); const int tid = tid_, lane = tid & 63, wid = tid >> 6, wm = wid >> 1, wn = wid & 1, r32 = lane & 31, hi = lane >> 5;
  unsigned char* As = lds; unsigned char* Bs = lds + 65536;
#pragma unroll
  for (int i = 0; i < 2; ++i)
#pragma unroll
    for (int j = 0; j < 2; ++j) acc[i][j] = f32x16{};
  const int lrow = tid >> 3, lc = tid & 7;
  const bf16_t* Ag = A + (size_t)(row0 + lrow) * lda + lc * 8;
  const bf16_t* Bg = Bt + (size_t)(col0 + lrow) * ldb + lc * 8;
  u32x4 ra[4], rb[2];
#pragma unroll
  for (int i = 0; i < 4; ++i) ra[i] = *(const u32x4*)(Ag + (size_t)(64 * i) * lda);
#pragma unroll
  for (int i = 0; i < 2; ++i) rb[i] = *(const u32x4*)(Bg + (size_t)(64 * i) * ldb);
#pragma unroll
  for (int i = 0; i < 4; ++i) *(u32x4*)(As + gswz(lrow + 64 * i, lc)) = ra[i];
#pragma unroll
  for (int i = 0; i < 2; ++i) *(u32x4*)(Bs + gswz(lrow + 64 * i, lc)) = rb[i];
  __syncthreads();
  const int nk = K / 64;
  for (int kt = 0; kt < nk; ++kt) {
    const int cur = kt & 1;
    if (kt + 1 < nk) {
#pragma unroll
      for (int i = 0; i < 4; ++i) ra[i] = *(const u32x4*)(Ag + (size_t)(64 * i) * lda + (kt + 1) * 64);
#pragma unroll
      for (int i = 0; i < 2; ++i) rb[i] = *(const u32x4*)(Bg + (size_t)(64 * i) * ldb + (kt + 1) * 64);
    }
    const unsigned char* Ac = As + cur * 32768; const unsigned char* Bc = Bs + cur * 16384;
#pragma unroll
    for (int kk = 0; kk < 4; ++kk) {
      bf16x8 af[2], bfr[2];
#pragma unroll
      for (int i = 0; i < 2; ++i) af[i] = *(const bf16x8*)(Ac + gswz(wm * 64 + i * 32 + r32, 2 * kk + hi));
#pragma unroll
      for (int j = 0; j < 2; ++j) bfr[j] = *(const bf16x8*)(Bc + gswz(wn * 64 + j * 32 + r32, 2 * kk + hi));
#pragma unroll
      for (int i = 0; i < 2; ++i)
#pragma unroll
        for (int j = 0; j < 2; ++j) acc[i][j] = __builtin_amdgcn_mfma_f32_32x32x16_bf16(af[i], bfr[j], acc[i][j], 0, 0, 0);
    }
    if (kt + 1 < nk) {
      unsigned char* An = As + (cur ^ 1) * 32768; unsigned char* Bn = Bs + (cur ^ 1) * 16384;
#pragma unroll
      for (int i = 0; i < 4; ++i) *(u32x4*)(An + gswz(lrow + 64 * i, lc)) = ra[i];
#pragma unroll
      for (int i = 0; i < 2; ++i) *(u32x4*)(Bn + gswz(lrow + 64 * i, lc)) = rb[i];
    }
    __syncthreads();
  }
}
__device__ __forceinline__ void pair_xchg(float v0, float v1, int lane, float& lo, float& hi2) {
  const bool odd = lane & 1;
  const float send = odd ? v0 : v1;
  const float recv = __shfl_xor(send, 1);
  lo = odd ? recv : v0; hi2 = odd ? v1 : recv;
}

__device__ __forceinline__ void phase_inproj(const Params& p, int l, unsigned char* lds) {
  int tid_ = threadIdx.x; asm volatile("" : "+v"(tid_)); const int tid = tid_, lane = tid & 63, wid = tid >> 6, wm = wid >> 1, wn = wid & 1, r32 = lane & 31, hi = lane >> 5;
  const bf16_t* H = (const bf16_t*)(p.ws + WS_H);
  const bf16_t* W = (const bf16_t*)(p.ws + WS_WIN) + (size_t)l * PW * DM;
  bf16_t* PROJ = (bf16_t*)(p.ws + WS_PROJ);
  const float* RC = (const float*)(p.ws + WS_ROPE); const float* RS = RC + SEQ * 32;
  constexpr int NM = T / 256, NN = PW / 128, NU = NM * NN;
  for (int u = p.bx; u < NU + NM; u += p.gx) {
    if (u < NU) {
      const int pn = u / NM, pm = u % NM;
      const int row0 = pm * 256, col0 = pn * 128;
      f32x16 acc[2][2];
      gemm_tile(H, DM, W, DM, DM, row0, col0, lds, acc);
      const bool rope = (col0 >= C_DQ && col0 < C_DV);
      const float scl = (col0 >= C_MK && col0 < C_MV) ? 0.125f : ((col0 >= C_DQ && col0 < C_DK) ? QSCALE : 1.f);
#pragma unroll
      for (int i = 0; i < 2; ++i)
#pragma unroll
        for (int j = 0; j < 2; ++j)
#pragma unroll
          for (int q = 0; q < 8; ++q) {
            float lo, hi2; pair_xchg(acc[i][j][2 * q], acc[i][j][2 * q + 1], lane, lo, hi2);
            const int row = row0 + wm * 64 + i * 32 + crow(2 * q, hi) + (lane & 1);
            const int col = col0 + wn * 64 + j * 32 + (r32 & ~1);
            if (rope) {
              const int s = row % SEGL;
              if (s >= CTXL) {
                const int idx = (s - CTXL) * 32 + ((col & 63) >> 1);
                const float c = RC[idx], sn = RS[idx];
                const float t1 = lo, t2 = hi2; lo = t1 * c - t2 * sn; hi2 = t1 * sn + t2 * c;
              }
            }
            *(unsigned*)(PROJ + (size_t)row * PW + col) = cvtpk(lo * scl, hi2 * scl);
          }
    } else {
      const int pm = u - NU, rowb = pm * 256 + wid * 32;
      const bf16_t* WG = (const bf16_t*)(p.ws + WS_WG) + (size_t)l * 16 * DM;
      float* GT = (float*)(p.ws + WS_GATES);
      const int r16 = lane & 15, q4 = lane >> 4;
      f32x4 c0 = {0.f, 0.f, 0.f, 0.f}, c1 = {0.f, 0.f, 0.f, 0.f};
      const bf16_t* a0p = H + (size_t)(rowb + r16) * DM + q4 * 8;
      const bf16_t* a1p = a0p + (size_t)16 * DM;
      const bf16_t* bp = WG + (size_t)r16 * DM + q4 * 8;
#pragma unroll 4
      for (int ks = 0; ks < 32; ++ks) {
        const bf16x8 a0 = *(const bf16x8*)(a0p + ks * 32), a1 = *(const bf16x8*)(a1p + ks * 32), b = *(const bf16x8*)(bp + ks * 32);
        c0 = __builtin_amdgcn_mfma_f32_16x16x32_bf16(a0, b, c0, 0, 0, 0);
        c1 = __builtin_amdgcn_mfma_f32_16x16x32_bf16(a1, b, c1, 0, 0, 0);
      }
      const float gb = p.in[I_GATEB][l * 16 + r16];
#pragma unroll
      for (int j = 0; j < 4; ++j) {
        GT[(size_t)(rowb + q4 * 4 + j) * 16 + r16] = c0[j] + gb;
        GT[(size_t)(rowb + 16 + q4 * 4 + j) * 16 + r16] = c1[j] + gb;
      }
    }
  }
}

__device__ __forceinline__ void phase_outproj(const Params& p, int l, unsigned char* lds) {
  int tid_ = threadIdx.x; asm volatile("" : "+v"(tid_)); const int tid = tid_, lane = tid & 63, wid = tid >> 6, wm = wid >> 1, wn = wid & 1, r32 = lane & 31, hi = lane >> 5;
  const bf16_t* MIX = (const bf16_t*)(p.ws + WS_MIX);
  const bf16_t* W = (const bf16_t*)(p.ws + WS_WOUT) + (size_t)l * DM * DM;
  float* XC = (float*)(p.ws + WS_XCUR);
  const float* MOD = (const float*)(p.ws + WS_MOD);
  constexpr int NM = T / 256, NN = DM / 128, NU = NM * NN;
  for (int u = p.bx; u < NU; u += p.gx) {
    const int pm = u / NN, pn = u % NN;
    if (l == DEPTH - 1 && (pm % 33) == 0) continue;
    const int row0 = pm * 256, col0 = pn * 128;
    for (int rep = 0; rep < REP_OUTP; ++rep) {
    f32x16 acc[2][2];
    gemm_tile(MIX, DM, W, DM, DM, row0, col0, lds, acc);
    const int mr = (pm % 33) == 0 ? 4 : pm / 33;
    const float* g1 = MOD + ((size_t)l * 5 + mr) * 6144 + 2048;
#pragma unroll
    for (int i = 0; i < 2; ++i)
#pragma unroll
      for (int j = 0; j < 2; ++j) {
        const int col = col0 + wn * 64 + j * 32 + r32;
        const float gg = (rep == REP_OUTP - 1) ? g1[col] : 0.f;
#pragma unroll
        for (int r = 0; r < 16; ++r) {
          const int row = row0 + wm * 64 + i * 32 + crow(r, hi);
          const float xo = (l == 0) ? in_row(p.in[I_X], p.in[I_CTX], row)[col] : XC[(size_t)row * DM + col];
          XC[(size_t)row * DM + col] = xo + gg * acc[i][j][r];
        }
      }
    }
  }
}
__device__ __forceinline__ void phase_peerq(const Params& p, int l, unsigned char* lds) {
  int tid_ = threadIdx.x; asm volatile("" : "+v"(tid_)); const int tid = tid_, lane = tid & 63, wid = tid >> 6, wm = wid >> 1, wn = wid & 1, r32 = lane & 31, hi = lane >> 5;
  const bf16_t* H = (const bf16_t*)(p.ws + WS_H);
  const bf16_t* W = (const bf16_t*)(p.ws + WS_WQ) + (size_t)l * DM * DM;
  bf16_t* QP = (bf16_t*)(p.ws + WS_PROJ);
  constexpr int NM = T / 256, NN = DM / 128, NU = NM * NN;
  for (int u = p.bx; u < NU; u += p.gx) {
    const int pm = u / NN, pn = u % NN;
    if (l == DEPTH - 1 && (pm % 33) == 0) continue;
    const int row0 = pm * 256, col0 = pn * 128;
    f32x16 acc[2][2];
    gemm_tile(H, DM, W, DM, DM, row0, col0, lds, acc);
#pragma unroll
    for (int i = 0; i < 2; ++i)
#pragma unroll
      for (int j = 0; j < 2; ++j)
#pragma unroll
        for (int q = 0; q < 8; ++q) {
          float lo, hi2; pair_xchg(acc[i][j][2 * q], acc[i][j][2 * q + 1], lane, lo, hi2);
          const int row = row0 + wm * 64 + i * 32 + crow(2 * q, hi) + (lane & 1);
          const int col = col0 + wn * 64 + j * 32 + (r32 & ~1);
          *(unsigned*)(QP + (size_t)row * DM + col) = cvtpk(lo, hi2);
        }
  }
}


struct EpiInproj {
  static constexpr bool PERM = true, AFTER_DRAIN = false;
  bf16_t* PROJ; const float* RC; const float* RS; unsigned char* V8T;
  __device__ __forceinline__ void operator()(const pg8::f32x4 (&acc)[2][2][4][2], const pg8::Unit& u, int wr, int wc, int fr, int fq) const {
#pragma unroll
    for (int bj = 0; bj < 2; ++bj) {
      const int colt = u.pn * 256 + bj * 128;
      const bool rope = (colt >= C_DQ && colt < C_DV);
      const float scl = (colt >= C_MK && colt < C_MV) ? 0.125f : ((colt >= C_DQ && colt < C_DK) ? QSCALE : 1.f);
      const int col8 = colt + wc * 32 + 8 * fq;
      if (colt >= C_DV) {
        const int hh = (col8 - C_DV) >> 7, e0 = (col8 - C_DV) & 127;
#pragma unroll
        for (int ai = 0; ai < 2; ++ai)
#pragma unroll
          for (int m = 0; m < 4; ++m) {
            const int row = u.pm * 256 + ai * 128 + wr * 64 + m * 16 + fr;
            const int b = row / SEGL, s = row - b * SEGL, t = s >> 6, kk = s & 63;
            const int slot = ((kk >> 2) & 1) * 32 + (kk & 3) + 4 * ((kk >> 3) & 3) + 16 * (kk >> 5);
            unsigned char* vp = V8T + ((size_t)((b * 4 + hh) * NCH + t) * 128 + e0) * 80 + slot;
            const f32x4 v0 = acc[ai][bj][m][0], v1 = acc[ai][bj][m][1];
            int w0 = 0, w1 = 0;
            w0 = __builtin_amdgcn_cvt_pk_fp8_f32(v0[0], v0[1], w0, false); w0 = __builtin_amdgcn_cvt_pk_fp8_f32(v0[2], v0[3], w0, true);
            w1 = __builtin_amdgcn_cvt_pk_fp8_f32(v1[0], v1[1], w1, false); w1 = __builtin_amdgcn_cvt_pk_fp8_f32(v1[2], v1[3], w1, true);
            vp[0] = (unsigned char)(w0 & 0xFF); vp[80] = (unsigned char)((w0 >> 8) & 0xFF); vp[160] = (unsigned char)((w0 >> 16) & 0xFF); vp[240] = (unsigned char)((w0 >> 24) & 0xFF);
            vp[320] = (unsigned char)(w1 & 0xFF); vp[400] = (unsigned char)((w1 >> 8) & 0xFF); vp[480] = (unsigned char)((w1 >> 16) & 0xFF); vp[560] = (unsigned char)((w1 >> 24) & 0xFF);
          }
        continue;
      }
#pragma unroll
      for (int ai = 0; ai < 2; ++ai)
#pragma unroll
        for (int m = 0; m < 4; ++m) {
          const int row = u.pm * 256 + ai * 128 + wr * 64 + m * 16 + fr;
          f32x4 v0 = acc[ai][bj][m][0], v1 = acc[ai][bj][m][1];
          if (rope) {
            const int s = row % SEGL;
            if (s >= CTXL) {
              const int idx = (s - CTXL) * 32 + ((col8 & 63) >> 1);
              const f32x4 c = *(const f32x4*)(RC + idx), sn = *(const f32x4*)(RS + idx);
              f32x4 a, b;
              a[0] = v0[0] * c[0] - v0[1] * sn[0]; a[1] = v0[0] * sn[0] + v0[1] * c[0]; a[2] = v0[2] * c[1] - v0[3] * sn[1]; a[3] = v0[2] * sn[1] + v0[3] * c[1];
              b[0] = v1[0] * c[2] - v1[1] * sn[2]; b[1] = v1[0] * sn[2] + v1[1] * c[2]; b[2] = v1[2] * c[3] - v1[3] * sn[3]; b[3] = v1[2] * sn[3] + v1[3] * c[3];
              v0 = a; v1 = b;
            }
          }
          u32x4 w; w.x = cvtpk(v0[0] * scl, v0[1] * scl); w.y = cvtpk(v0[2] * scl, v0[3] * scl); w.z = cvtpk(v1[0] * scl, v1[1] * scl); w.w = cvtpk(v1[2] * scl, v1[3] * scl);
          *(u32x4*)(PROJ + (size_t)row * PW + col8) = w;
        }
    }
  }
};
struct EpiOutproj {
  static constexpr bool PERM = true, AFTER_DRAIN = false;
  float* XC; const float* MODL; const float* xin; const float* ctxin; int first; float gsc;
  __device__ __forceinline__ void operator()(const pg8::f32x4 (&acc)[2][2][4][2], const pg8::Unit& u, int wr, int wc, int fr, int fq) const {
    const int mr = (u.pm % 33) == 0 ? 4 : u.pm / 33;
    const float* g1 = MODL + (size_t)mr * 6144 + 2048;
#pragma unroll
    for (int bj = 0; bj < 2; ++bj) {
      const int col8 = u.pn * 256 + bj * 128 + wc * 32 + 8 * fq;
      const f32x4 ga = *(const f32x4*)(g1 + col8) * gsc, gb = *(const f32x4*)(g1 + col8 + 4) * gsc;
#pragma unroll
      for (int ai = 0; ai < 2; ++ai)
#pragma unroll
        for (int m = 0; m < 4; ++m) {
          const int row = u.pm * 256 + ai * 128 + wr * 64 + m * 16 + fr;
          const float* xo = first ? in_row(xin, ctxin, row) + col8 : XC + (size_t)row * DM + col8;
          const f32x4 xa = *(const f32x4*)xo, xb = *(const f32x4*)(xo + 4);
          *(f32x4*)(XC + (size_t)row * DM + col8) = xa + ga * acc[ai][bj][m][0];
          *(f32x4*)(XC + (size_t)row * DM + col8 + 4) = xb + gb * acc[ai][bj][m][1];
        }
    }
  }
};
struct EpiPeerq {
  static constexpr bool PERM = true, AFTER_DRAIN = false;
  bf16_t* QP;
  __device__ __forceinline__ void operator()(const pg8::f32x4 (&acc)[2][2][4][2], const pg8::Unit& u, int wr, int wc, int fr, int fq) const {
#pragma unroll
    for (int bj = 0; bj < 2; ++bj) {
      const int col8 = u.pn * 256 + bj * 128 + wc * 32 + 8 * fq;
#pragma unroll
      for (int ai = 0; ai < 2; ++ai)
#pragma unroll
        for (int m = 0; m < 4; ++m) {
          const int row = u.pm * 256 + ai * 128 + wr * 64 + m * 16 + fr;
          const f32x4 v0 = acc[ai][bj][m][0], v1 = acc[ai][bj][m][1];
          u32x4 w; w.x = cvtpk(v0[0], v0[1]); w.y = cvtpk(v0[2], v0[3]); w.z = cvtpk(v1[0], v1[1]); w.w = cvtpk(v1[2], v1[3]);
          *(u32x4*)(QP + (size_t)row * DM + col8) = w;
        }
    }
  }
};
__device__ __forceinline__ void phase_inproj2(const Params& p, int l, unsigned char* lds) {
  {
    pg8::Gemm g{(const bf16_t*)(p.ws + WS_H), (const bf16_t*)(p.ws + WS_WIN) + (size_t)l * PW * DM, T, PW, DM};
    pg8::StaticOrder S; S.init(T, PW, p.gx, p.bx);
    EpiInproj E{(bf16_t*)(p.ws + WS_PROJ), (const float*)(p.ws + WS_ROPE), (const float*)(p.ws + WS_ROPE) + SEQ * 32, p.ws + WS_V8T};
    pg8::gemm_phase<EpiInproj, pg8::StaticOrder, true, true>((PG8_LAS unsigned char*)lds, g, S, E);
  }
  int tid_ = threadIdx.x; asm volatile("" : "+v"(tid_)); const int tid = tid_, lane = tid & 63, wid = tid >> 6;
  const bf16_t* H = (const bf16_t*)(p.ws + WS_H);
  for (int pm = p.bx; pm < T / 256; pm += p.gx) {
    const int rowb = pm * 256 + wid * 32;
    const bf16_t* WG = (const bf16_t*)(p.ws + WS_WG) + (size_t)l * 16 * DM;
    float* GT = (float*)(p.ws + WS_GATES);
    const int r16 = lane & 15, q4 = lane >> 4;
    f32x4 c0 = {0.f, 0.f, 0.f, 0.f}, c1 = {0.f, 0.f, 0.f, 0.f};
    const bf16_t* a0p = H + (size_t)(rowb + r16) * DM + q4 * 8;
    const bf16_t* a1p = a0p + (size_t)16 * DM;
    const bf16_t* bp = WG + (size_t)r16 * DM + q4 * 8;
#pragma unroll 4
    for (int ks = 0; ks < 32; ++ks) {
      const bf16x8 a0 = *(const bf16x8*)(a0p + ks * 32), a1 = *(const bf16x8*)(a1p + ks * 32), b = *(const bf16x8*)(bp + ks * 32);
      c0 = __builtin_amdgcn_mfma_f32_16x16x32_bf16(a0, b, c0, 0, 0, 0);
      c1 = __builtin_amdgcn_mfma_f32_16x16x32_bf16(a1, b, c1, 0, 0, 0);
    }
    const float gb = p.in[I_GATEB][l * 16 + r16];
#pragma unroll
    for (int j = 0; j < 4; ++j) {
      GT[(size_t)(rowb + q4 * 4 + j) * 16 + r16] = c0[j] + gb;
      GT[(size_t)(rowb + 16 + q4 * 4 + j) * 16 + r16] = c1[j] + gb;
    }
  }
}
__device__ __forceinline__ void phase_outproj2(const Params& p, int l, unsigned char* lds) {
  pg8::Gemm g{(const bf16_t*)(p.ws + WS_MIX), (const bf16_t*)(p.ws + WS_WOUT) + (size_t)l * DM * DM, T, DM, DM};
  pg8::StaticOrder S; S.init(T, DM, p.gx, p.bx);
  for (int rep = 0; rep < REP_OUTP; ++rep) {
  EpiOutproj E{(float*)(p.ws + WS_XCUR), (const float*)(p.ws + WS_MOD) + (size_t)l * 5 * 6144, p.in[I_X], p.in[I_CTX], l == 0, (rep == REP_OUTP - 1) ? 1.f : 0.f};
  pg8::gemm_phase<EpiOutproj, pg8::StaticOrder, true, true>((PG8_LAS unsigned char*)lds, g, S, E);
  }
  if (l < DEPTH - 1) tail_filler_tables(p, l, (T / 256) * (DM / 256));
}
__device__ __forceinline__ void phase_peerq2(const Params& p, int l, unsigned char* lds) {
  pg8::Gemm g{(const bf16_t*)(p.ws + WS_H), (const bf16_t*)(p.ws + WS_WQ) + (size_t)l * DM * DM, T, DM, DM};
  pg8::StaticOrder S; S.init(T, DM, p.gx, p.bx);
  EpiPeerq E{(bf16_t*)(p.ws + WS_PROJ)};
  pg8::gemm_phase<EpiPeerq, pg8::StaticOrder, true, true>((PG8_LAS unsigned char*)lds, g, S, E);
  if (l == DEPTH - 2) tail_filler_tables(p, DEPTH - 1, (T / 256) * (DM / 256));
}

__device__ __forceinline__ void conv_unit(const Params& p, int l, int unit, unsigned char* lds) {
  int tid_ = threadIdx.x; asm volatile("" : "+v"(tid_)); const int tid = tid_, lane = tid & 63, wid = tid >> 6;
  float* U = (float*)lds;
  const bf16_t* PROJ = (const bf16_t*)(p.ws + WS_PROJ);
  bf16_t* MIX = (bf16_t*)(p.ws + WS_MIX);
  const int row0 = unit * 32, b = row0 / SEGL, s0 = row0 - b * SEGL;
  const int seglo = s0 < CTXL ? 0 : CTXL, seghi = s0 < CTXL ? CTXL : SEGL;
  for (int rr = tid >> 5; rr < 62; rr += 16) {
    const int s = s0 - 15 + rr, c8 = (tid & 31) * 8;
    f32x4 u0 = {0.f, 0.f, 0.f, 0.f}, u1 = {0.f, 0.f, 0.f, 0.f};
    if (s >= seglo && s < seghi) {
      const bf16_t* pr = PROJ + (size_t)(b * SEGL + s) * PW + c8;
      const u32x4 a1 = *(const u32x4*)pr, a2 = *(const u32x4*)(pr + 256);
      u0.x = bflo(a1.x) * sigmoidf_(bflo(a2.x)); u0.y = bfhi(a1.x) * sigmoidf_(bfhi(a2.x));
      u0.z = bflo(a1.y) * sigmoidf_(bflo(a2.y)); u0.w = bfhi(a1.y) * sigmoidf_(bfhi(a2.y));
      u1.x = bflo(a1.z) * sigmoidf_(bflo(a2.z)); u1.y = bfhi(a1.z) * sigmoidf_(bfhi(a2.z));
      u1.z = bflo(a1.w) * sigmoidf_(bflo(a2.w)); u1.w = bfhi(a1.w) * sigmoidf_(bfhi(a2.w));
    }
    *(f32x4*)(U + rr * 256 + c8) = u0; *(f32x4*)(U + rr * 256 + c8 + 4) = u1;
  }
  __syncthreads();
  float* Y = U + 62 * 256;
  const float* cw = p.in[I_CONVW] + (size_t)l * 31 * 256;
#pragma unroll 1
  for (int q = 0; q < 4; ++q) {
    const int c = lane + 64 * q;
    float w[31];
#pragma unroll
    for (int j = 0; j < 31; ++j) w[j] = cw[j * 256 + c];
    const float bias = p.in[I_CONVB][l * 256 + c];
#pragma unroll
    for (int tt = 0; tt < 4; ++tt) {
      const int t = wid * 4 + tt;
      float a = bias;
#pragma unroll
      for (int j = 0; j < 31; ++j) a += U[(t + j) * 256 + c] * w[j];
      Y[t * 256 + c] = a;
    }
  }
  asm volatile("s_waitcnt lgkmcnt(0)" ::: "memory");
  float y[4][4];
#pragma unroll
  for (int tt = 0; tt < 4; ++tt)
#pragma unroll
    for (int q = 0; q < 4; ++q) y[tt][q] = Y[(wid * 4 + tt) * 256 + lane + 64 * q];
#pragma unroll
  for (int tt = 0; tt < 4; ++tt) {
    const int t = wid * 4 + tt;
    const float mean = wave_sum((y[tt][0] + y[tt][1]) + (y[tt][2] + y[tt][3])) * (1.f / 256.f);
    float v = 0.f;
#pragma unroll
    for (int q = 0; q < 4; ++q) { const float d = y[tt][q] - mean; v += d * d; }
    const float rs = rsqrtf(wave_sum(v) * (1.f / 256.f) + EPS);
#pragma unroll
    for (int q = 0; q < 4; ++q) {
      const int c = lane + 64 * q;
      const float z = (y[tt][q] - mean) * rs * p.in[I_CLNG][l * 256 + c] + p.in[I_CLNB][l * 256 + c];
      const float o = (ABL & 1) ? 0.f : z * sigmoidf_(z);
      MIX[(size_t)(row0 + t) * DM + c] = (bf16_t)(cvtpk(o, 0.f) & 0xffffu);
    }
  }
  __syncthreads();
}

__device__ __forceinline__ int ml_cidx(int ch, int dir) { return dir == 0 ? ch : (ch < 4 ? 3 - ch : 135 - ch); }
__device__ __forceinline__ void ml_load_tile(const bf16_t* src, float* dst, int tid) {
  const int r = tid >> 3, c8 = (tid & 7) * 8;
  const u32x4 a = *(const u32x4*)(src + (size_t)r * PW + c8);
  float* d = dst + r * 65 + c8;
  d[0] = bflo(a.x); d[1] = bfhi(a.x); d[2] = bflo(a.y); d[3] = bfhi(a.y); d[4] = bflo(a.z); d[5] = bfhi(a.z); d[6] = bflo(a.w); d[7] = bfhi(a.w);
}
__device__ __forceinline__ void ml_local_unit(const Params& p, int l, int unit, unsigned char* lds) {
  int tid_ = threadIdx.x; asm volatile("" : "+v"(tid_)); const int tid = tid_, lane = tid & 63, wid = tid >> 6, r32 = lane & 31, hi = lane >> 5;
  float* Kt = (float*)lds; float* Vt = Kt + 64 * 65; float* WK = Vt + 64 * 65;
  const bf16_t* PROJ = (const bf16_t*)(p.ws + WS_PROJ);
  const float* GT = (const float*)(p.ws + WS_GATES);
  float* UL = (float*)(p.ws + WS_ULOC); float* META = (float*)(p.ws + WS_MLMETA);
  const int b = unit / (4 * NCH), hh = (unit / NCH) & 3, ch = unit % NCH;
  const int row0 = b * SEGL + ch * 64;
  ml_load_tile(PROJ + (size_t)row0 * PW + C_MK + hh * 64, Kt, tid);
  ml_load_tile(PROJ + (size_t)row0 * PW + C_MV + hh * 64, Vt, tid);
  if (wid < 2) {
    const int dir = wid;
    const float ig = GT[(size_t)(row0 + lane) * 16 + (2 * dir) * 4 + hh];
    const float lf = logsigmoidf_(GT[(size_t)(row0 + lane) * 16 + (2 * dir + 1) * 4 + hh]);
    float ps = lf;
#pragma unroll
    for (int o = 1; o < 64; o <<= 1) { const float t = __shfl_up(ps, o); if (lane >= o) ps += t; }
    const float tot = __shfl(ps, 63);
    const float wlog = dir == 0 ? (tot - ps + ig) : (ps - lf + ig);
    const float mloc = wave_max(wlog);
    WK[dir * 64 + lane] = __expf(wlog - mloc);
    if (lane == 0) {
      const int seq = (b * 4 + hh) * 2 + dir, ci = ml_cidx(ch, dir);
      META[((size_t)seq * NCH + ci) * 4 + 0] = tot; META[((size_t)seq * NCH + ci) * 4 + 1] = mloc;
    }
  }
  __syncthreads();
  {
    const int dir = wid >> 2, et = (wid >> 1) & 1, dt = wid & 1;
    const int seq = (b * 4 + hh) * 2 + dir, ci = ml_cidx(ch, dir);
    float* slot = UL + ((size_t)seq * NCH + ci) * USTRIDE;
    f32x16 acc = {};
#pragma unroll 8
    for (int ks = 0; ks < 32; ++ks) {
      const int s = 2 * ks + hi;
      const float a = WK[dir * 64 + s] * Vt[s * 65 + et * 32 + r32];
      const float bb = Kt[s * 65 + dt * 32 + r32];
      acc = __builtin_amdgcn_mfma_f32_32x32x2f32(a, bb, acc, 0, 0, 0);
    }
#pragma unroll
    for (int r = 0; r < 16; ++r) slot[(et * 32 + crow(r, hi)) * 64 + dt * 32 + r32] = acc[r];
    if (et == 0) {
      float n = 0.f;
#pragma unroll 8
      for (int i = 0; i < 32; ++i) { const int s = hi * 32 + i; n += WK[dir * 64 + s] * Kt[s * 65 + dt * 32 + r32]; }
      n += __shfl_xor(n, 32);
      if (hi == 0) slot[4096 + dt * 32 + r32] = n;
    }
  }
  __syncthreads();
}
constexpr int MLP = 144;
constexpr size_t WS_CST = WS_H;
constexpr size_t WS_NST = WS_H + (size_t)32 * NCH * 4096 * 2;
__device__ __forceinline__ void ml_stage_rm(const bf16_t* src, size_t ld, unsigned char* dst, int tid) {
  const int r = tid >> 3, c8 = (tid & 7) * 8;
  *(u32x4*)(dst + r * MLP + c8 * 2) = *(const u32x4*)(src + (size_t)r * ld + c8);
}
__device__ __forceinline__ void ml_stage_tr(const bf16_t* src, size_t ld, unsigned char* dst, int tid) {
  const int r = tid >> 3, c8 = (tid & 7) * 8;
  const u32x4 a = *(const u32x4*)(src + (size_t)r * ld + c8);
  bf16_t* d = (bf16_t*)dst;
  d[(c8 + 0) * 72 + r] = (bf16_t)(a.x & 0xffffu); d[(c8 + 1) * 72 + r] = (bf16_t)(a.x >> 16);
  d[(c8 + 2) * 72 + r] = (bf16_t)(a.y & 0xffffu); d[(c8 + 3) * 72 + r] = (bf16_t)(a.y >> 16);
  d[(c8 + 4) * 72 + r] = (bf16_t)(a.z & 0xffffu); d[(c8 + 5) * 72 + r] = (bf16_t)(a.z >> 16);
  d[(c8 + 6) * 72 + r] = (bf16_t)(a.w & 0xffffu); d[(c8 + 7) * 72 + r] = (bf16_t)(a.w >> 16);
}
__device__ __forceinline__ void ml_local_unit2(const Params& p, int l, int unit, unsigned char* lds) {
  int tid_ = threadIdx.x; asm volatile("" : "+v"(tid_)); const int tid = tid_, lane = tid & 63, wid = tid >> 6, r32 = lane & 31, hi = lane >> 5;
  unsigned char* KT = lds; unsigned char* VT = lds + 64 * MLP; float* WK = (float*)(lds + 2 * 64 * MLP);
  const bf16_t* PROJ = (const bf16_t*)(p.ws + WS_PROJ);
  const float* GT = (const float*)(p.ws + WS_GATES);
  float* UL = (float*)(p.ws + WS_ULOC); float* META = (float*)(p.ws + WS_MLMETA);
  const int b = unit / (4 * NCH), hh = (unit / NCH) & 3, ch = unit % NCH;
  const int row0 = b * SEGL + ch * 64;
  ml_stage_tr(PROJ + (size_t)row0 * PW + C_MK + hh * 64, PW, KT, tid);
  ml_stage_tr(PROJ + (size_t)row0 * PW + C_MV + hh * 64, PW, VT, tid);
  if (wid < 2) {
    const int dir = wid;
    const float ig = GT[(size_t)(row0 + lane) * 16 + (2 * dir) * 4 + hh];
    const float lf = logsigmoidf_(GT[(size_t)(row0 + lane) * 16 + (2 * dir + 1) * 4 + hh]);
    float ps = lf;
#pragma unroll
    for (int o = 1; o < 64; o <<= 1) { const float t = __shfl_up(ps, o); if (lane >= o) ps += t; }
    const float tot = __shfl(ps, 63);
    const float wlog = dir == 0 ? (tot - ps + ig) : (ps - lf + ig);
    const float mloc = wave_max(wlog);
    WK[dir * 64 + lane] = __expf(wlog - mloc);
    if (lane == 0) {
      const int seq = (b * 4 + hh) * 2 + dir, ci = ml_cidx(ch, dir);
      META[((size_t)seq * NCH + ci) * 4 + 0] = tot; META[((size_t)seq * NCH + ci) * 4 + 1] = mloc;
    }
  }
  __syncthreads();
  {
    const int dir = wid >> 2, et = (wid >> 1) & 1, dt = wid & 1;
    const int seq = (b * 4 + hh) * 2 + dir, ci = ml_cidx(ch, dir);
    float* slot = UL + ((size_t)seq * NCH + ci) * USTRIDE;
    f32x16 acc = {};
#pragma unroll
    for (int ks = 0; ks < 4; ++ks) {
      const int s0 = ks * 16 + hi * 8;
      const u32x4 va = *(const u32x4*)(VT + (et * 32 + r32) * MLP + s0 * 2);
      const bf16x8 kb = *(const bf16x8*)(KT + (dt * 32 + r32) * MLP + s0 * 2);
      const f32x4 w0 = *(const f32x4*)(WK + dir * 64 + s0), w1 = *(const f32x4*)(WK + dir * 64 + s0 + 4);
      u32x4 sa; sa.x = cvtpk(bflo(va.x) * w0.x, bfhi(va.x) * w0.y); sa.y = cvtpk(bflo(va.y) * w0.z, bfhi(va.y) * w0.w);
      sa.z = cvtpk(bflo(va.z) * w1.x, bfhi(va.z) * w1.y); sa.w = cvtpk(bflo(va.w) * w1.z, bfhi(va.w) * w1.w);
      acc = __builtin_amdgcn_mfma_f32_32x32x16_bf16(*(const bf16x8*)&sa, kb, acc, 0, 0, 0);
    }
#pragma unroll
    for (int r = 0; r < 16; ++r) slot[(et * 32 + crow(r, hi)) * 64 + dt * 32 + r32] = acc[r];
    if (et == 0) {
      float n = 0.f;
#pragma unroll
      for (int i = 0; i < 4; ++i) {
        const int s0 = hi * 32 + i * 8;
        const u32x4 ka = *(const u32x4*)(KT + (dt * 32 + r32) * MLP + s0 * 2);
        const f32x4 w0 = *(const f32x4*)(WK + dir * 64 + s0), w1 = *(const f32x4*)(WK + dir * 64 + s0 + 4);
        n += bflo(ka.x) * w0.x + bfhi(ka.x) * w0.y + bflo(ka.y) * w0.z + bfhi(ka.y) * w0.w + bflo(ka.z) * w1.x + bfhi(ka.z) * w1.y + bflo(ka.w) * w1.z + bfhi(ka.w) * w1.w;
      }
      n += __shfl_xor(n, 32);
      if (hi == 0) slot[4096 + dt * 32 + r32] = n;
    }
  }
  __syncthreads();
}
__device__ __forceinline__ void ml_scan(const Params& p, unsigned char* lds) {
  float* UL = (float*)(p.ws + WS_ULOC); float* META = (float*)(p.ws + WS_MLMETA);
  int tid_ = threadIdx.x; asm volatile("" : "+v"(tid_));
  const int tid = tid_, lane = tid & 63, wid = tid >> 6;
  float* DEC = (float*)lds;
  float* SCL = DEC + 2 * NCH;
  float* TMP = SCL + 2 * NCH;
  for (int base0 = p.bx * 512; base0 < 32 * USTRIDE; base0 += p.gx * 512) {
    const int seq0 = base0 / USTRIDE;
    if (wid < 2) {
      const int seq = seq0 + wid;
      if (seq < 32) {
        float* mt = META + (size_t)seq * NCH * 4;
        for (int c = lane; c < NCH; c += 64) { TMP[(wid * 2 + 0) * NCH + c] = mt[c * 4 + 0]; TMP[(wid * 2 + 1) * NCH + c] = mt[c * 4 + 1]; }
        asm volatile("s_waitcnt lgkmcnt(0)" ::: "memory");
        if (lane == 0) {
          float m = 0.f;
          for (int c = 0; c < NCH; ++c) {
            const float bl = TMP[(wid * 2 + 0) * NCH + c], mloc = TMP[(wid * 2 + 1) * NCH + c];
            const float mn = fmaxf(bl + m, mloc);
            DEC[wid * NCH + c] = __expf(bl + m - mn); SCL[wid * NCH + c] = __expf(mloc - mn);
            mt[c * 4 + 2] = m;
            m = mn;
          }
        }
      }
    }
    __syncthreads();
    const int idx = base0 + tid;
    if (idx < 32 * USTRIDE) {
      const int seq = idx / USTRIDE, e = idx - seq * USTRIDE, sl = seq - seq0;
      float* bp = UL + (size_t)seq * NCH * USTRIDE + e;
      bf16_t* CSTp = (bf16_t*)(p.ws + WS_CST) + (size_t)seq * NCH * 4096 + (e < 4096 ? e : 0);
      float* NSTp = (float*)(p.ws + WS_NST) + (size_t)seq * NCH * 64 + (e < 4096 ? 0 : e - 4096);
      const float* dec = DEC + sl * NCH; const float* scl = SCL + sl * NCH;
      float C = 0.f;
#pragma unroll 1
      for (int c0 = 0; c0 < NCH; c0 += 12) {
        float u[12];
#pragma unroll
        for (int j = 0; j < 12; ++j) u[j] = bp[(size_t)(c0 + j) * USTRIDE];
#pragma unroll
        for (int j = 0; j < 12; ++j) {
          if (e < 4096) CSTp[(size_t)(c0 + j) * 4096] = (bf16_t)(cvtpk(C, 0.f) & 0xffffu); else NSTp[(size_t)(c0 + j) * 64] = C;
          C = dec[c0 + j] * C + scl[c0 + j] * u[j]; }
      }
    }
    __syncthreads();
  }
}
__device__ __forceinline__ void ml_out_unit(const Params& p, int l, int unit, unsigned char* lds) {
  int tid_ = threadIdx.x; asm volatile("" : "+v"(tid_)); const int tid = tid_, lane = tid & 63, wid = tid >> 6, r32 = lane & 31, hi = lane >> 5;
  float* Qt = (float*)lds; float* Kt = Qt + 64 * 65; float* Vt = Kt + 64 * 65;
  float* Cs = Vt + 64 * 65;
  float* Ns = Cs + 2 * 64 * 65;
  float* Bq = Ns + 128;
  float* Gs = Bq + 128;
  float* Mi = Gs + 128;
  float* HB = Mi + 64;
  const bf16_t* PROJ = (const bf16_t*)(p.ws + WS_PROJ);
  const float* GT = (const float*)(p.ws + WS_GATES);
  const float* UL = (const float*)(p.ws + WS_ULOC); const float* META = (const float*)(p.ws + WS_MLMETA);
  bf16_t* MIX = (bf16_t*)(p.ws + WS_MIX);
  const int b = unit / (4 * NCH), hh = (unit / NCH) & 3, ch = unit % NCH;
  const int row0 = b * SEGL + ch * 64;
  ml_load_tile(PROJ + (size_t)row0 * PW + C_MQ + hh * 64, Qt, tid);
  ml_load_tile(PROJ + (size_t)row0 * PW + C_MK + hh * 64, Kt, tid);
  ml_load_tile(PROJ + (size_t)row0 * PW + C_MV + hh * 64, Vt, tid);
  for (int i = tid; i < 2 * USTRIDE; i += 512) {
    const int dir = i / USTRIDE, e = i - dir * USTRIDE;
    const int seq = (b * 4 + hh) * 2 + dir, ci = ml_cidx(ch, dir);
    const float v = UL[((size_t)seq * NCH + ci) * USTRIDE + e];
    if (e < 4096) Cs[dir * 64 * 65 + (e >> 6) * 65 + (e & 63)] = v; else Ns[dir * 64 + (e - 4096)] = v;
  }
  if (wid < 2) {
    const int dir = wid;
    const float ig = GT[(size_t)(row0 + lane) * 16 + (2 * dir) * 4 + hh];
    const float lf = logsigmoidf_(GT[(size_t)(row0 + lane) * 16 + (2 * dir + 1) * 4 + hh]);
    float ps = lf;
#pragma unroll
    for (int o = 1; o < 64; o <<= 1) { const float t = __shfl_up(ps, o); if (lane >= o) ps += t; }
    const float tot = __shfl(ps, 63);
    const float bc = dir == 0 ? ps : (tot - ps + lf);
    Bq[dir * 64 + lane] = bc; Gs[dir * 64 + lane] = ig - bc;
    if (lane == 0) { const int seq = (b * 4 + hh) * 2 + dir, ci = ml_cidx(ch, dir); Mi[dir] = META[((size_t)seq * NCH + ci) * 4 + 2]; }
  }
  __syncthreads();
  {
    const int dir = wid >> 2, tt = (wid >> 1) & 1, et = wid & 1;
    const int t = tt * 32 + r32;
    f32x16 sa[2] = {};
#pragma unroll 4
    for (int ks = 0; ks < 32; ++ks) {
      const float bq = Qt[t * 65 + 2 * ks + hi];
      const float a0 = Kt[(r32) * 65 + 2 * ks + hi], a1 = Kt[(32 + r32) * 65 + 2 * ks + hi];
      sa[0] = __builtin_amdgcn_mfma_f32_32x32x2f32(a0, bq, sa[0], 0, 0, 0);
      sa[1] = __builtin_amdgcn_mfma_f32_32x32x2f32(a1, bq, sa[1], 0, 0, 0);
    }
    const float bt = Bq[dir * 64 + t];
    const float inter = bt + Mi[dir];
    float mx = -INFINITY;
    f32x16 dl[2];
#pragma unroll
    for (int st = 0; st < 2; ++st)
#pragma unroll
      for (int r = 0; r < 16; ++r) {
        const int s = st * 32 + crow(r, hi);
        const bool ok = dir == 0 ? (s <= t) : (s >= t);
        const float d = ok ? bt + Gs[dir * 64 + s] : -INFINITY;
        dl[st][r] = d; mx = fmaxf(mx, d);
      }
    mx = fmaxf(mx, __shfl_xor(mx, 32));
    const float mt = fmaxf(inter, mx);
    const float iw = __expf(inter - mt);
    float rsum = 0.f;
#pragma unroll
    for (int st = 0; st < 2; ++st)
#pragma unroll
      for (int r = 0; r < 16; ++r) { const float w = __expf(dl[st][r] - mt); sa[st][r] *= w; rsum += sa[st][r]; }
    rsum += __shfl_xor(rsum, 32);
    float qn = 0.f;
#pragma unroll 8
    for (int i = 0; i < 32; ++i) { const int d = hi * 32 + i; qn += Ns[dir * 64 + d] * Qt[t * 65 + d]; }
    qn += __shfl_xor(qn, 32);
    const float den = rsum + iw * qn;
    const float rden = 1.f / fmaxf(fabsf(den), __expf(-mt));
    f32x16 an = {}, ac = {};
#pragma unroll
    for (int st = 0; st < 2; ++st)
#pragma unroll
      for (int r = 0; r < 16; ++r) {
        const float a = Vt[(st * 32 + crow(r, hi)) * 65 + et * 32 + r32];
        an = __builtin_amdgcn_mfma_f32_32x32x2f32(a, sa[st][r], an, 0, 0, 0);
      }
    const float* Cd = Cs + dir * 64 * 65;
#pragma unroll 4
    for (int ks = 0; ks < 32; ++ks) {
      const float a = Cd[(et * 32 + r32) * 65 + 2 * ks + hi];
      const float bq = Qt[t * 65 + 2 * ks + hi];
      ac = __builtin_amdgcn_mfma_f32_32x32x2f32(a, bq, ac, 0, 0, 0);
    }
#pragma unroll
    for (int r = 0; r < 16; ++r) HB[dir * 64 * 65 + t * 65 + et * 32 + crow(r, hi)] = (an[r] + iw * ac[r]) * rden;
  }
  __syncthreads();
  {
    const int t = tid >> 3, e8 = (tid & 7) * 8;
    float v[8]; float ss = 0.f;
#pragma unroll
    for (int i = 0; i < 8; ++i) { v[i] = HB[t * 65 + e8 + i] + HB[64 * 65 + t * 65 + e8 + i]; ss += v[i] * v[i]; }
    ss += __shfl_xor(ss, 1); ss += __shfl_xor(ss, 2); ss += __shfl_xor(ss, 4);
    const float rs = rsqrtf(ss * (1.f / 64.f) + EPS);
    const u32x4 ov = *(const u32x4*)(PROJ + (size_t)(row0 + t) * PW + C_MO + hh * 64 + e8);
    const float og[8] = {bflo(ov.x), bfhi(ov.x), bflo(ov.y), bfhi(ov.y), bflo(ov.z), bfhi(ov.z), bflo(ov.w), bfhi(ov.w)};
    const float* g = p.in[I_MNORMG] + l * 64 + e8;
    float o[8];
#pragma unroll
    for (int i = 0; i < 8; ++i) o[i] = (ABL & 2) ? 0.f : v[i] * rs * g[i] * sigmoidf_(og[i]);
    u32x4 w; w.x = cvtpk(o[0], o[1]); w.y = cvtpk(o[2], o[3]); w.z = cvtpk(o[4], o[5]); w.w = cvtpk(o[6], o[7]);
    *(u32x4*)(MIX + (size_t)(row0 + t) * DM + 256 + hh * 64 + e8) = w;
  }
  __syncthreads();
}


__device__ __forceinline__ void ml_out_unit2(const Params& p, int l, int unit, unsigned char* lds) {
  int tid_ = threadIdx.x; asm volatile("" : "+v"(tid_)); const int tid = tid_, lane = tid & 63, wid = tid >> 6, r32 = lane & 31, hi = lane >> 5;
  unsigned char* Qs = lds; unsigned char* Ks = lds + 64 * MLP; unsigned char* VT = lds + 2 * 64 * MLP; unsigned char* Cs = lds + 3 * 64 * MLP;
  float* Ns = (float*)(lds + 5 * 64 * MLP);
  float* Bq = Ns + 128;
  float* Gs = Bq + 128;
  float* Mi = Gs + 128;
  float* HB = Mi + 64;
  const bf16_t* PROJ = (const bf16_t*)(p.ws + WS_PROJ);
  const float* GT = (const float*)(p.ws + WS_GATES);
  const bf16_t* CST = (const bf16_t*)(p.ws + WS_CST); const float* NST = (const float*)(p.ws + WS_NST); const float* META = (const float*)(p.ws + WS_MLMETA);
  bf16_t* MIX = (bf16_t*)(p.ws + WS_MIX);
  const int b = unit / (4 * NCH), hh = (unit / NCH) & 3, ch = unit % NCH;
  const int row0 = b * SEGL + ch * 64;
  ml_stage_rm(PROJ + (size_t)row0 * PW + C_MQ + hh * 64, PW, Qs, tid);
  ml_stage_rm(PROJ + (size_t)row0 * PW + C_MK + hh * 64, PW, Ks, tid);
  ml_stage_tr(PROJ + (size_t)row0 * PW + C_MV + hh * 64, PW, VT, tid);
#pragma unroll
  for (int dir = 0; dir < 2; ++dir) {
    const int seq = (b * 4 + hh) * 2 + dir, ci = ml_cidx(ch, dir);
    ml_stage_rm(CST + ((size_t)seq * NCH + ci) * 4096, 64, Cs + dir * 64 * MLP, tid);
    if (tid < 64) Ns[dir * 64 + tid] = NST[((size_t)seq * NCH + ci) * 64 + tid];
  }
  if (wid < 2) {
    const int dir = wid;
    const float ig = GT[(size_t)(row0 + lane) * 16 + (2 * dir) * 4 + hh];
    const float lf = logsigmoidf_(GT[(size_t)(row0 + lane) * 16 + (2 * dir + 1) * 4 + hh]);
    float ps = lf;
#pragma unroll
    for (int o = 1; o < 64; o <<= 1) { const float t = __shfl_up(ps, o); if (lane >= o) ps += t; }
    const float tot = __shfl(ps, 63);
    const float bc = dir == 0 ? ps : (tot - ps + lf);
    Bq[dir * 64 + lane] = bc; Gs[dir * 64 + lane] = ig - bc;
    if (lane == 0) { const int seq = (b * 4 + hh) * 2 + dir, ci = ml_cidx(ch, dir); Mi[dir] = META[((size_t)seq * NCH + ci) * 4 + 2]; }
  }
  __syncthreads();
  {
    const int dir = wid >> 2, tt = (wid >> 1) & 1, et = wid & 1;
    const int t = tt * 32 + r32;
    f32x16 sa[2] = {};
    bf16x8 bq[4];
#pragma unroll
    for (int ks = 0; ks < 4; ++ks) {
      bq[ks] = *(const bf16x8*)(Qs + t * MLP + (ks * 16 + hi * 8) * 2);
      const bf16x8 a0 = *(const bf16x8*)(Ks + r32 * MLP + (ks * 16 + hi * 8) * 2), a1 = *(const bf16x8*)(Ks + (32 + r32) * MLP + (ks * 16 + hi * 8) * 2);
      sa[0] = __builtin_amdgcn_mfma_f32_32x32x16_bf16(a0, bq[ks], sa[0], 0, 0, 0);
      sa[1] = __builtin_amdgcn_mfma_f32_32x32x16_bf16(a1, bq[ks], sa[1], 0, 0, 0);
    }
    const float bt = Bq[dir * 64 + t];
    const float inter = bt + Mi[dir];
    float mx = -INFINITY;
    f32x16 dl[2];
#pragma unroll
    for (int st = 0; st < 2; ++st)
#pragma unroll
      for (int r = 0; r < 16; ++r) {
        const int s = st * 32 + crow(r, hi);
        const bool ok = dir == 0 ? (s <= t) : (s >= t);
        const float d = ok ? bt + Gs[dir * 64 + s] : -INFINITY;
        dl[st][r] = d; mx = fmaxf(mx, d);
      }
    mx = fmaxf(mx, __shfl_xor(mx, 32));
    const float mt = fmaxf(inter, mx);
    const float iw = __expf(inter - mt);
    float rsum = 0.f;
#pragma unroll
    for (int st = 0; st < 2; ++st)
#pragma unroll
      for (int r = 0; r < 16; ++r) { const float w = __expf(dl[st][r] - mt); sa[st][r] *= w; rsum += sa[st][r]; }
    rsum += __shfl_xor(rsum, 32);
    float qn = 0.f;
#pragma unroll
    for (int i = 0; i < 4; ++i) {
      const int d0 = hi * 32 + i * 8;
      const u32x4 qa = *(const u32x4*)(Qs + t * MLP + d0 * 2);
      const f32x4 n0 = *(const f32x4*)(Ns + dir * 64 + d0), n1 = *(const f32x4*)(Ns + dir * 64 + d0 + 4);
      qn += bflo(qa.x) * n0.x + bfhi(qa.x) * n0.y + bflo(qa.y) * n0.z + bfhi(qa.y) * n0.w + bflo(qa.z) * n1.x + bfhi(qa.z) * n1.y + bflo(qa.w) * n1.z + bfhi(qa.w) * n1.w;
    }
    qn += __shfl_xor(qn, 32);
    const float den = rsum + iw * qn;
    const float rden = 1.f / fmaxf(fabsf(den), __expf(-mt));
    f32x16 an = {}, ac = {};
#pragma unroll
    for (int st = 0; st < 2; ++st)
#pragma unroll
      for (int k2 = 0; k2 < 2; ++k2) {
        u32x4 bx; bx.x = cvtpk(sa[st][8 * k2 + 0], sa[st][8 * k2 + 1]); bx.y = cvtpk(sa[st][8 * k2 + 2], sa[st][8 * k2 + 3]);
        bx.z = cvtpk(sa[st][8 * k2 + 4], sa[st][8 * k2 + 5]); bx.w = cvtpk(sa[st][8 * k2 + 6], sa[st][8 * k2 + 7]);
        const unsigned char* vrow = VT + (et * 32 + r32) * MLP + (st * 32 + 16 * k2 + 4 * hi) * 2;
        const u32x2 v0 = *(const u32x2*)vrow, v1 = *(const u32x2*)(vrow + 16);
        u32x4 ax; ax.x = v0.x; ax.y = v0.y; ax.z = v1.x; ax.w = v1.y;
        an = __builtin_amdgcn_mfma_f32_32x32x16_bf16(*(const bf16x8*)&ax, *(const bf16x8*)&bx, an, 0, 0, 0);
      }
    const unsigned char* Cd = Cs + dir * 64 * MLP;
#pragma unroll
    for (int ks = 0; ks < 4; ++ks) {
      const bf16x8 a = *(const bf16x8*)(Cd + (et * 32 + r32) * MLP + (ks * 16 + hi * 8) * 2);
      ac = __builtin_amdgcn_mfma_f32_32x32x16_bf16(a, bq[ks], ac, 0, 0, 0);
    }
#pragma unroll
    for (int r = 0; r < 16; ++r) HB[dir * 64 * 65 + t * 65 + et * 32 + crow(r, hi)] = (an[r] + iw * ac[r]) * rden;
  }
  __syncthreads();
  {
    const int t = tid >> 3, e8 = (tid & 7) * 8;
    float v[8]; float ss = 0.f;
#pragma unroll
    for (int i = 0; i < 8; ++i) { v[i] = HB[t * 65 + e8 + i] + HB[64 * 65 + t * 65 + e8 + i]; ss += v[i] * v[i]; }
    ss += __shfl_xor(ss, 1); ss += __shfl_xor(ss, 2); ss += __shfl_xor(ss, 4);
    const float rs = rsqrtf(ss * (1.f / 64.f) + EPS);
    const u32x4 ov = *(const u32x4*)(PROJ + (size_t)(row0 + t) * PW + C_MO + hh * 64 + e8);
    const float og[8] = {bflo(ov.x), bfhi(ov.x), bflo(ov.y), bfhi(ov.y), bflo(ov.z), bfhi(ov.z), bflo(ov.w), bfhi(ov.w)};
    const float* g = p.in[I_MNORMG] + l * 64 + e8;
    float o[8];
#pragma unroll
    for (int i = 0; i < 8; ++i) o[i] = (ABL & 2) ? 0.f : v[i] * rs * g[i] * sigmoidf_(og[i]);
    u32x4 w; w.x = cvtpk(o[0], o[1]); w.y = cvtpk(o[2], o[3]); w.z = cvtpk(o[4], o[5]); w.w = cvtpk(o[6], o[7]);
    *(u32x4*)(MIX + (size_t)(row0 + t) * DM + 256 + hh * 64 + e8) = w;
  }
  __syncthreads();
}

#define KSWZ(row, colB) ((row) * 256 + ((colB) ^ (((row) & 15) << 4)))
#define SBAR() __builtin_amdgcn_sched_barrier(0)
constexpr int ATT_SHM_V = 128 * 80, ATT_SHM_K = 64 * 128 * 2;
constexpr float ATT_THR = 8.0f;
__device__ __forceinline__ int v_st(int k, int c) { const int kk = (k & ~0xC) | ((k & 4) << 1) | ((k & 8) >> 1); return ((kk >> 3) * 4 + (c >> 5)) * 512 + ((kk & 7) * 32 + (c & 31)) * 2; }
__device__ __forceinline__ int v_rd_base(int lane) { return ((lane & 3) << 3) | (((lane >> 2) & 3) << 6) | (((lane >> 4) & 1) << 5) | (((lane >> 5) & 1) << 8); }
constexpr int v_rd_off(int d0, int ks, int half) { return d0 * 512 + ks * 4096 + half * 2048; }
template <int OFF> __device__ __forceinline__ s16x4 tr_read(int vb) {
  s16x4 r; asm volatile("ds_read_b64_tr_b16 %0, %1 offset:%2" : "=&v"(r) : "v"(vb), "i"(OFF) : "memory"); return r;
}
template <int D0> __device__ __forceinline__ void pv_one(f32x16& od, int vb, bf16x8 pa0, bf16x8 pa1, bf16x8 pa2, bf16x8 pa3) {
  const s16x4 l0 = tr_read<v_rd_off(D0, 0, 0)>(vb), h0 = tr_read<v_rd_off(D0, 0, 1)>(vb), l1 = tr_read<v_rd_off(D0, 1, 0)>(vb), h1 = tr_read<v_rd_off(D0, 1, 1)>(vb);
  const s16x4 l2 = tr_read<v_rd_off(D0, 2, 0)>(vb), h2 = tr_read<v_rd_off(D0, 2, 1)>(vb), l3 = tr_read<v_rd_off(D0, 3, 0)>(vb), h3 = tr_read<v_rd_off(D0, 3, 1)>(vb);
  asm volatile("s_waitcnt lgkmcnt(0)" ::: "memory"); SBAR();
#define PK(L, H) (bf16x8){L[0], L[1], L[2], L[3], H[0], H[1], H[2], H[3]}
  od = __builtin_amdgcn_mfma_f32_32x32x16_bf16(pa0, PK(l0, h0), od, 0, 0, 0);
  od = __builtin_amdgcn_mfma_f32_32x32x16_bf16(pa1, PK(l1, h1), od, 0, 0, 0);
  od = __builtin_amdgcn_mfma_f32_32x32x16_bf16(pa2, PK(l2, h2), od, 0, 0, 0);
  od = __builtin_amdgcn_mfma_f32_32x32x16_bf16(pa3, PK(l3, h3), od, 0, 0, 0);
#undef PK
}
template <int D0> __device__ __forceinline__ void pv_two(f32x16& oa, f32x16& ob, int vb, bf16x8 a0, bf16x8 a1, bf16x8 a2, bf16x8 a3, bf16x8 b0, bf16x8 b1, bf16x8 b2, bf16x8 b3) {
  const s16x4 l0 = tr_read<v_rd_off(D0, 0, 0)>(vb), h0 = tr_read<v_rd_off(D0, 0, 1)>(vb), l1 = tr_read<v_rd_off(D0, 1, 0)>(vb), h1 = tr_read<v_rd_off(D0, 1, 1)>(vb);
  const s16x4 l2 = tr_read<v_rd_off(D0, 2, 0)>(vb), h2 = tr_read<v_rd_off(D0, 2, 1)>(vb), l3 = tr_read<v_rd_off(D0, 3, 0)>(vb), h3 = tr_read<v_rd_off(D0, 3, 1)>(vb);
  asm volatile("s_waitcnt lgkmcnt(0)" ::: "memory"); SBAR();
#define PK(L, H) (bf16x8){L[0], L[1], L[2], L[3], H[0], H[1], H[2], H[3]}
  const bf16x8 v0 = PK(l0, h0), v1 = PK(l1, h1), v2 = PK(l2, h2), v3 = PK(l3, h3);
  oa = __builtin_amdgcn_mfma_f32_32x32x16_bf16(a0, v0, oa, 0, 0, 0);
  ob = __builtin_amdgcn_mfma_f32_32x32x16_bf16(b0, v0, ob, 0, 0, 0);
  oa = __builtin_amdgcn_mfma_f32_32x32x16_bf16(a1, v1, oa, 0, 0, 0);
  ob = __builtin_amdgcn_mfma_f32_32x32x16_bf16(b1, v1, ob, 0, 0, 0);
  oa = __builtin_amdgcn_mfma_f32_32x32x16_bf16(a2, v2, oa, 0, 0, 0);
  ob = __builtin_amdgcn_mfma_f32_32x32x16_bf16(b2, v2, ob, 0, 0, 0);
  oa = __builtin_amdgcn_mfma_f32_32x32x16_bf16(a3, v3, oa, 0, 0, 0);
  ob = __builtin_amdgcn_mfma_f32_32x32x16_bf16(b3, v3, ob, 0, 0, 0);
#undef PK
}
__device__ __forceinline__ void att_qkt(f32x16& p0, f32x16& p1, const unsigned char* Ks, const unsigned char* Qs, int qrow, int comp, int r32, int hi, float init) {
#pragma unroll
  for (int r = 0; r < 16; ++r) { p0[r] = init; p1[r] = init; }
#pragma unroll
  for (int d0 = 0; d0 < 4; ++d0) {
    const int cb = ((comp * 4 + d0) * 16 + hi * 8) * 2;
    const bf16x8 b0 = *(const bf16x8*)(Ks + KSWZ(r32, cb));
    const bf16x8 b1 = *(const bf16x8*)(Ks + KSWZ(32 + r32, cb));
    const bf16x8 q = *(const bf16x8*)(Qs + KSWZ(qrow, cb));
    p0 = __builtin_amdgcn_mfma_f32_32x32x16_bf16(b0, q, p0, 0, 0, 0);
    p1 = __builtin_amdgcn_mfma_f32_32x32x16_bf16(b1, q, p1, 0, 0, 0);
  }
}
__device__ __forceinline__ void att_softmax(f32x16& p0, f32x16& p1, float& m_reg, float& l_reg, float& alpha, bool first, i32x8& pa) {
  alpha = 1.f;
  if (first) {
    float pmax = p0[0];
#pragma unroll
    for (int r = 1; r < 16; ++r) pmax = fmaxf(pmax, p0[r]);
#pragma unroll
    for (int r = 0; r < 16; ++r) pmax = fmaxf(pmax, p1[r]);
    { auto rr = __builtin_amdgcn_permlane32_swap(__float_as_uint(pmax), __float_as_uint(pmax), false, false);
      pmax = fmaxf(__uint_as_float(rr[0]), __uint_as_float(rr[1])); }
    alpha = 0.f; m_reg = pmax;
#pragma unroll
    for (int r = 0; r < 16; ++r) { p0[r] -= pmax; p1[r] -= pmax; }
  }
#pragma unroll
  for (int r = 0; r < 16; ++r) { p0[r] = __builtin_amdgcn_exp2f(p0[r]); p1[r] = __builtin_amdgcn_exp2f(p1[r]); }
  float ps = 0.f;
#pragma unroll
  for (int r = 0; r < 16; ++r) ps += p0[r];
#pragma unroll
  for (int r = 0; r < 16; ++r) ps += p1[r];
  { auto rr = __builtin_amdgcn_permlane32_swap(__float_as_uint(ps), __float_as_uint(ps), false, false);
    ps = __uint_as_float(rr[0]) + __uint_as_float(rr[1]); }
  if (__builtin_expect(!first && __any(ps > 256.f), 0)) {
    float emax = p0[0];
#pragma unroll
    for (int r = 1; r < 16; ++r) emax = fmaxf(emax, p0[r]);
#pragma unroll
    for (int r = 0; r < 16; ++r) emax = fmaxf(emax, p1[r]);
    { auto rr = __builtin_amdgcn_permlane32_swap(__float_as_uint(emax), __float_as_uint(emax), false, false);
      emax = fmaxf(__uint_as_float(rr[0]), __uint_as_float(rr[1])); }
    const float delta = fmaxf(__builtin_amdgcn_logf(emax), 0.f);
    alpha = __builtin_amdgcn_exp2f(-delta); m_reg += delta;
#pragma unroll
    for (int r = 0; r < 16; ++r) { p0[r] *= alpha; p1[r] *= alpha; }
    ps *= alpha;
  }
  l_reg = l_reg * alpha + ps;
#pragma unroll
  for (int v = 0; v < 4; ++v) {
    int w0 = 0, w1 = 0;
    w0 = __builtin_amdgcn_cvt_pk_fp8_f32(p0[4 * v], p0[4 * v + 1], w0, false); w0 = __builtin_amdgcn_cvt_pk_fp8_f32(p0[4 * v + 2], p0[4 * v + 3], w0, true);
    w1 = __builtin_amdgcn_cvt_pk_fp8_f32(p1[4 * v], p1[4 * v + 1], w1, false); w1 = __builtin_amdgcn_cvt_pk_fp8_f32(p1[4 * v + 2], p1[4 * v + 3], w1, true);
    pa[v] = w0; pa[4 + v] = w1;
  }
}
__device__ __forceinline__ void att_unit(const bf16_t* __restrict__ Qb, const bf16_t* __restrict__ Kh, const unsigned char* __restrict__ V8, bf16_t* __restrict__ Ob,
                                         int nkeys, float lam, const float* __restrict__ ng, float oscale, unsigned char* lds) {
  int tid_ = threadIdx.x; asm volatile("" : "+v"(tid_)); const int tid = tid_, wid = tid >> 6, lane = tid & 63, r32 = lane & 31, hi = lane >> 5;
  unsigned char* V_lds = lds; unsigned char* K_lds = lds + 2 * ATT_SHM_V;
  float* wsl = (float*)(lds + 2 * ATT_SHM_V + 2 * ATT_SHM_K) + wid * 64; float* li_l = wsl; float* al_l = wsl + 32;
  float m0 = 0.f, l0 = 0.f, m1 = 0.f, l1 = 0.f;
  f32x16 o0[4] = {}, o1[4] = {};
  unsigned char* Q_lds = lds + 2 * ATT_SHM_V + 2 * ATT_SHM_K + 2048;
#pragma unroll
  for (int i = 0; i < 8; ++i) { const int id = tid + 512 * i, qrw = id >> 4, ch = id & 15;
    *(bf16x8*)(Q_lds + KSWZ(qrw, ch * 16)) = *(const bf16x8*)(Qb + (size_t)qrw * PW + ch * 8); }
  const int qrow = wid * 32 + r32;
  int kso[2];
#pragma unroll
  for (int i = 0; i < 2; ++i) {
    const int o16 = tid + 512 * i;
    { const int row = o16 >> 4, cs = (o16 & 15) ^ (row & 15); kso[i] = row * PW + cs * 8; }
  }
  const unsigned ldsw = (unsigned)__builtin_amdgcn_readfirstlane(wid) * 1024u;
#define GSTAGE(b, k0) do { _Pragma("unroll") for (int i_ = 0; i_ < 2; ++i_) \
    __builtin_amdgcn_global_load_lds((const unsigned*)(Kh + (size_t)(k0) * PW + kso[i_]), (LAS unsigned*)(K_lds + (b) * ATT_SHM_K + ldsw + i_ * 8192), 16, 0, 0); \
    { const unsigned char* vi_ = V8 + (size_t)((k0) >> 6) * ATT_SHM_V + tid * 16; \
      __builtin_amdgcn_global_load_lds((const unsigned*)vi_, (LAS unsigned*)(V_lds + (b) * ATT_SHM_V + ldsw), 16, 0, 0); \
      if (wid < 2) __builtin_amdgcn_global_load_lds((const unsigned*)(vi_ + 8192), (LAS unsigned*)(V_lds + (b) * ATT_SHM_V + 8192 + ldsw), 16, 0, 0); } } while (0)
#define RESC(o, a) do { if (__any((a) < 1.f)) { if (hi == 0) al_l[r32] = (a); asm volatile("s_waitcnt lgkmcnt(0)" ::: "memory"); \
    _Pragma("unroll") for (int d = 0; d < 4; ++d) _Pragma("unroll") for (int r = 0; r < 16; ++r) o[d][r] *= al_l[crow(r, hi)]; } } while (0)
  const int NT = nkeys / 64;
  GSTAGE(0, 0); asm volatile("s_waitcnt vmcnt(0)" ::: "memory"); __syncthreads();
  for (int j = 0; j < NT; ++j) {
    const int cur = j & 1;
    if (j + 1 < NT) GSTAGE(cur ^ 1, (j + 1) * 64);
    const unsigned char* Kc = K_lds + cur * ATT_SHM_K; const unsigned char* Vc = V_lds + cur * ATT_SHM_V;
    f32x16 p0, p1, q0, q1; float alphaA, alphaB; i32x8 pa, pb;
    const bool first = (j == 0);
    att_qkt(p0, p1, Kc, Q_lds, qrow, 0, r32, hi, first ? 0.f : -m0);
    att_qkt(q0, q1, Kc, Q_lds, qrow, 1, r32, hi, first ? 0.f : -m1);
    att_softmax(p0, p1, m0, l0, alphaA, first, pa);
    att_softmax(q0, q1, m1, l1, alphaB, first, pb);
    RESC(o0, alphaA);
    RESC(o1, alphaB);
#pragma unroll
    for (int d0 = 0; d0 < 4; ++d0) {
      const unsigned char* vrow = Vc + (d0 * 32 + r32) * 80 + hi * 32;
      const u32x4 v0 = *(const u32x4*)vrow, v1 = *(const u32x4*)(vrow + 16);
      i32x8 bv; bv[0] = (int)v0.x; bv[1] = (int)v0.y; bv[2] = (int)v0.z; bv[3] = (int)v0.w; bv[4] = (int)v1.x; bv[5] = (int)v1.y; bv[6] = (int)v1.z; bv[7] = (int)v1.w;
      o0[d0] = __builtin_amdgcn_mfma_scale_f32_32x32x64_f8f6f4(pa, bv, o0[d0], 0, 0, 0, 0x7F7F7F7F, 0, 0x7F7F7F7F);
      o1[d0] = __builtin_amdgcn_mfma_scale_f32_32x32x64_f8f6f4(pb, bv, o1[d0], 0, 0, 0, 0x7F7F7F7F, 0, 0x7F7F7F7F);
    }
    asm volatile("s_waitcnt vmcnt(0)" ::: "memory");
    __syncthreads();
  }
  if (hi == 0) { li_l[r32] = 1.f / l0; al_l[r32] = lam / l1; }
  asm volatile("s_waitcnt lgkmcnt(0)" ::: "memory");
  float ss[16];
#pragma unroll
  for (int r = 0; r < 16; ++r) {
    const float a = li_l[crow(r, hi)], bq = al_l[crow(r, hi)];
    float s = 0.f;
#pragma unroll
    for (int d = 0; d < 4; ++d) { const float v = o0[d][r] * a - o1[d][r] * bq; o0[d][r] = v; s += v * v; }
    s += __shfl_xor(s, 1); s += __shfl_xor(s, 2); s += __shfl_xor(s, 4); s += __shfl_xor(s, 8); s += __shfl_xor(s, 16);
    ss[r] = rsqrtf(s * (1.f / 128.f) + EPS) * oscale;
  }
  bf16_t* Ow = Ob + (size_t)(wid * 32) * DM;
#pragma unroll
  for (int d = 0; d < 4; ++d) {
    const float g = ng[d * 32 + r32];
#pragma unroll
    for (int r = 0; r < 16; ++r) Ow[(size_t)crow(r, hi) * DM + d * 32 + r32] = (ABL & 4) ? (bf16_t)0 : (bf16_t)(cvtpk(o0[d][r] * ss[r] * g, 0.f) & 0xffffu);
  }
  __syncthreads();
#undef GSTAGE
#undef RESC
}

__device__ __forceinline__ float ins16(float (&a)[16], float x) {
#pragma unroll
  for (int i = 0; i < 16; ++i) { const float h = fmaxf(a[i], x); x = fminf(a[i], x); a[i] = h; }
  return x;
}
__device__ __forceinline__ void bsort16(float (&a)[16]) {
#pragma unroll
  for (int k = 2; k <= 16; k <<= 1)
#pragma unroll
    for (int j = k >> 1; j > 0; j >>= 1)
#pragma unroll
      for (int i = 0; i < 16; ++i) {
        const int q = i ^ j;
        if (q > i) {
          const bool desc = ((i & k) == 0);
          const float hi_ = fmaxf(a[i], a[q]), lo_ = fminf(a[i], a[q]);
          a[i] = desc ? hi_ : lo_; a[q] = desc ? lo_ : hi_;
        }
      }
}
__device__ __forceinline__ void bmerge16(float (&a)[16], const float (&b)[16]) {
#pragma unroll
  for (int i = 0; i < 16; ++i) a[i] = fmaxf(a[i], b[15 - i]);
#pragma unroll
  for (int j = 8; j > 0; j >>= 1)
#pragma unroll
    for (int i = 0; i < 16; ++i) {
      const int q = i ^ j;
      if (q > i) { const float hi_ = fmaxf(a[i], a[q]), lo_ = fminf(a[i], a[q]); a[i] = hi_; a[q] = lo_; }
    }
}
__device__ __forceinline__ float gelu_erf(float x) { return 0.5f * x * (1.f + erff(x * 0.70710678118654752440f)); }
#define XB_TMO      128
#define XB_XCNT(j)  (256  + 64 * (j))
#define XB_XSUB(j)  (1280 + 64 * (j))
#define XB_XGEN(j)  (2304 + 64 * (j))
#define XB_TOP      3328
#define XB_TOPGEN   3392
#define XCD_BAR_WORDS 3456
#define XB_SPIN_CAP (1u << 22)
__device__ __forceinline__ unsigned xb_ld(unsigned* p)              { return __hip_atomic_load(p, __ATOMIC_RELAXED, __HIP_MEMORY_SCOPE_AGENT); }
__device__ __forceinline__ unsigned xb_add(unsigned* p, unsigned v) { return __hip_atomic_fetch_add(p, v, __ATOMIC_RELAXED, __HIP_MEMORY_SCOPE_AGENT); }
__device__ __forceinline__ unsigned xb_xcc_id() { return (unsigned)__builtin_amdgcn_s_getreg((3 << 11) | 20) & 0xFu; }
#define XB_SPIN(cond, bar) do { unsigned _sp = 0; while (cond) { __builtin_amdgcn_s_sleep(1); \
    if ((++_sp & 255u) == 0u) { if (xb_ld(&(bar)[XB_TMO])) break; if (_sp > XB_SPIN_CAP) { atomicAdd(&(bar)[XB_TMO], 1u); break; } } } } while (0)
struct XcdBarrier { unsigned* bar; unsigned x; volatile LAS unsigned* st; };
__device__ __forceinline__ XcdBarrier xcd_barrier_post(unsigned* bar, volatile LAS unsigned* st) {
  XcdBarrier b; b.bar = bar; b.x = xb_xcc_id(); b.st = st;
  if (threadIdx.x == 0) (void)xb_add(&bar[XB_XCNT(b.x)], 1u);
  return b;
}
__device__ __forceinline__ void xcd_barrier_complete(unsigned* bar, unsigned x, unsigned& nloc, unsigned& nx) {
  const unsigned G = gridDim.x * gridDim.y * gridDim.z;
  unsigned sum, cnt, mine, sp = 0u;
  for (;;) {
    sum = 0u; cnt = 0u; mine = 0u;
#pragma unroll
    for (unsigned j = 0; j < 16; ++j) { const unsigned c = xb_ld(&bar[XB_XCNT(j)]); sum += c; cnt += (c > 0u) ? 1u : 0u; mine = (j == x) ? c : mine; }
    if (sum == G) break;
    __builtin_amdgcn_s_sleep(1);
    if ((++sp & 255u) == 0u) { if (xb_ld(&bar[XB_TMO])) break; if (sp > XB_SPIN_CAP) { atomicAdd(&bar[XB_TMO], 1u); break; } }
  }
  nloc = mine > 0u ? mine : 1u; nx = cnt > 0u ? cnt : 1u;
}
__device__ __forceinline__ void xcd_barrier(const XcdBarrier& b) {
  asm volatile("s_waitcnt vmcnt(0)" ::: "memory");
  __syncthreads();
  if (threadIdx.x == 0) {
    unsigned* bar = b.bar;
    __builtin_amdgcn_s_waitcnt(0);
    unsigned nloc = b.st[0], nx = b.st[1];
    if (nloc == 0u) { xcd_barrier_complete(bar, b.x, nloc, nx); b.st[0] = nloc; b.st[1] = nx; }
    const unsigned old = xb_add(&bar[XB_XSUB(b.x)], 1u);
    const unsigned gen = old / nloc;
    if (old + 1u == (gen + 1u) * nloc) {
      __builtin_amdgcn_fence(__ATOMIC_RELEASE, "agent");
      asm volatile("s_waitcnt vmcnt(0)" ::: "memory");
      const unsigned og = xb_add(&bar[XB_TOP], 1u);
      const unsigned tg = og / nx;
      if (og + 1u == (tg + 1u) * nx) xb_add(&bar[XB_TOPGEN], 1u);
      else XB_SPIN(xb_ld(&bar[XB_TOPGEN]) == tg, bar);
      __builtin_amdgcn_fence(__ATOMIC_ACQUIRE, "agent");
      xb_add(&bar[XB_XGEN(b.x)], 1u);
      asm volatile("s_waitcnt vmcnt(0)" ::: "memory");
    } else {
      XB_SPIN(xb_ld(&bar[XB_XGEN(b.x)]) == gen, bar);
      __builtin_amdgcn_fence(__ATOMIC_ACQUIRE, "agent");
      asm volatile("s_waitcnt vmcnt(0)" ::: "memory");
    }
  }
  __syncthreads();
}

constexpr size_t RT_STRIDE = (size_t)T * 128 * 4;
__device__ __forceinline__ void route_unit(const Params& p, int l, int unit, unsigned char* lds) {
  int tid_ = threadIdx.x; asm volatile("" : "+v"(tid_)); const int tid = tid_, lane = tid & 63, wid = tid >> 6, r32 = lane & 31, hi = lane >> 5;
  unsigned char* IDX = lds;
  int* UE = (int*)(lds + 8192); float* UG = (float*)(lds + 8192 + 16384); float* US = (float*)(lds + 8192 + 32768);
  int* EIDG = (int*)(p.ws + WS_EID + (size_t)l * RT_STRIDE); float* GWG = (float*)(p.ws + WS_ULOC + RT_STRIDE); float* SUG = (float*)(p.ws + WS_ULOC + 2 * RT_STRIDE);
  const float* PSC = (const float*)(p.ws + WS_PSC);
  const int row0 = unit * 32;
  const bf16_t* QP = (const bf16_t*)(p.ws + WS_PROJ);
  const bf16_t* KEYS = (const bf16_t*)(p.ws + WS_KEYS) + (size_t)l * 131072;
  for (int rrep = 0; rrep < REP_ROUTE; ++rrep) {
    const int h = wid;
    float top[2][16];
#pragma unroll
    for (int pp = 0; pp < 2; ++pp) {
      const bf16_t* qrow = QP + (size_t)(row0 + r32) * DM + h * 128 + pp * 64 + hi * 8;
      const bf16_t* kb = KEYS + ((size_t)(h * 2 + pp) * 128 + r32) * 64 + hi * 8;
      bf16x8 bq[4];
#pragma unroll
      for (int ks = 0; ks < 4; ++ks) bq[ks] = *(const bf16x8*)(qrow + ks * 16);
      float (&lst)[16] = top[pp];
#pragma unroll
      for (int i = 0; i < 16; ++i) lst[i] = -INFINITY;
#pragma unroll
      for (int nt = 0; nt < 4; ++nt) {
        f32x16 acc = {};
#pragma unroll
        for (int ks = 0; ks < 4; ++ks) {
          const bf16x8 ak = *(const bf16x8*)(kb + (size_t)nt * 32 * 64 + ks * 16);
          acc = __builtin_amdgcn_mfma_f32_32x32x16_bf16(ak, bq[ks], acc, 0, 0, 0);
        }
        float grp[16];
#pragma unroll
        for (int r = 0; r < 16; ++r) grp[r] = __uint_as_float((__float_as_uint(acc[r]) & ~0x7Fu) | (unsigned)(nt * 32 + crow(r, hi)));
        bsort16(grp);
        if (nt == 0) {
#pragma unroll
          for (int i = 0; i < 16; ++i) lst[i] = grp[i];
        } else bmerge16(lst, grp);
        SBAR();
      }
      float oth[16];
#pragma unroll
      for (int i = 0; i < 16; ++i) oth[i] = __shfl_xor(lst[i], 32);
      bmerge16(lst, oth);
      if (hi == 0) {
        unsigned w[4];
#pragma unroll
        for (int i = 0; i < 4; ++i)
          w[i] = (__float_as_uint(lst[4 * i]) & 0x7Fu) | ((__float_as_uint(lst[4 * i + 1]) & 0x7Fu) << 8) | ((__float_as_uint(lst[4 * i + 2]) & 0x7Fu) << 16) | ((__float_as_uint(lst[4 * i + 3]) & 0x7Fu) << 24);
        *(u32x4*)(IDX + ((r32 * 8 + h) * 2 + pp) * 16) = (u32x4){w[0], w[1], w[2], w[3]};
      }
    }
    float best[16];
#define CAND(i, j) __uint_as_float((__float_as_uint(__uint_as_float(__float_as_uint(top[0][i]) & ~0x7Fu) + __uint_as_float(__float_as_uint(top[1][j]) & ~0x7Fu)) & ~0xFFu) | (unsigned)((i) * 16 + (j)))
    {
#pragma unroll
      for (int j = 0; j < 16; ++j) best[j] = CAND(0, j);
      float y[16];
#pragma unroll
      for (int j = 0; j < 8; ++j) { y[j] = CAND(1, j); y[8 + j] = CAND(15 - j, 0); }
#pragma unroll
      for (int jj = 8; jj > 0; jj >>= 1)
#pragma unroll
        for (int i = 0; i < 16; ++i) { const int q = i ^ jj; if (q > i) { const float hi_ = fmaxf(y[i], y[q]), lo_ = fminf(y[i], y[q]); y[i] = hi_; y[q] = lo_; } }
      bmerge16(best, y);
      float x[16];
      x[0] = CAND(2, 0); x[1] = CAND(2, 1); x[2] = CAND(2, 2); x[3] = CAND(2, 3); x[4] = CAND(2, 4);
      x[5] = CAND(3, 0); x[6] = CAND(3, 1); x[7] = CAND(3, 2); x[8] = CAND(3, 3);
      x[9] = CAND(4, 0); x[10] = CAND(4, 1); x[11] = CAND(4, 2);
      x[12] = CAND(5, 0); x[13] = CAND(5, 1); x[14] = CAND(6, 0); x[15] = CAND(6, 1);
      bsort16(x);
      bmerge16(best, x);
      ins16(best, CAND(7, 0)); ins16(best, CAND(7, 1));
    }
#undef CAND
    asm volatile("s_waitcnt lgkmcnt(0)" ::: "memory");
    if (hi == 0) {
      const unsigned char* ib = IDX + ((r32 * 8 + h) * 2) * 16;
      const float mx = __uint_as_float(__float_as_uint(best[0]) & ~0xFFu);
      float w[16]; float sum = 0.f;
#pragma unroll
      for (int k = 0; k < 16; ++k) { w[k] = __expf(__uint_as_float(__float_as_uint(best[k]) & ~0xFFu) - mx); sum += w[k]; }
      const float rsum = 1.f / sum;
      int ee[16]; float su_[16], sv_[16];
#pragma unroll
      for (int k = 0; k < 16; ++k) {
        const unsigned ij = __float_as_uint(best[k]) & 0xFFu;
        ee[k] = (int)ib[ij >> 4] * 128 + (int)ib[16 + (ij & 15)];
      }
#pragma unroll
      for (int k = 0; k < 16; ++k) { su_[k] = PSC[(size_t)l * NEXP + ee[k]]; sv_[k] = PSC[(size_t)(DEPTH + l) * NEXP + ee[k]]; }
#pragma unroll
      for (int k = 0; k < 16; ++k) {
        UE[r32 * 128 + h * 16 + k] = ee[k]; UG[r32 * 128 + h * 16 + k] = w[k] * rsum * sv_[k];
        US[r32 * 128 + h * 16 + k] = su_[k];
      }
    }
  }
  __syncthreads();
#pragma unroll 1
  for (int tt = 0; tt < 4; ++tt) {
    const int t = wid * 4 + tt;
    const int k0 = UE[t * 128 + lane], k1 = UE[t * 128 + 64 + lane];
    const float g0 = UG[t * 128 + lane], g1 = UG[t * 128 + 64 + lane], s0 = US[t * 128 + lane], s1 = US[t * 128 + 64 + lane];
    const int b0 = k0 >> 10, b1 = k1 >> 10;
    int base = 0, pos0 = 0, pos1 = 0;
#pragma unroll
    for (int b = 0; b < 16; ++b) {
      const unsigned long long m0 = __ballot(b0 == b), m1 = __ballot(b1 == b);
      const int c0 = __popcll(m0), c1 = __popcll(m1);
      const unsigned long long lt = (1ull << lane) - 1ull;
      if (b0 == b) pos0 = base + __popcll(m0 & lt);
      if (b1 == b) pos1 = base + c0 + __popcll(m1 & lt);
      base += c0 + c1;
    }
    const size_t ro = (size_t)(row0 + t) * 128;
    EIDG[ro + pos0] = k0; GWG[ro + pos0] = g0; SUG[ro + pos0] = s0;
    EIDG[ro + pos1] = k1; GWG[ro + pos1] = g1; SUG[ro + pos1] = s1;
  }
}
#define CAS __attribute__((address_space(4)))
typedef int i32x8 __attribute__((ext_vector_type(8)));
struct TokPref { f32x2 gs0, gs1; u32x4 hA, hB; i32x8 E0; };
__device__ __forceinline__ const CAS i32x8* eid_row(const CAS unsigned char* eidg, int row) {
  return (const CAS i32x8*)(eidg + (size_t)(unsigned)__builtin_amdgcn_readfirstlane(row) * 512u);
}
__device__ __forceinline__ void tok_prefetch(const Params& p, int row, int lane, TokPref& t) {
  const float* GWG = (const float*)(p.ws + WS_ULOC + RT_STRIDE) + (size_t)row * 128;
  const float* SUG = (const float*)(p.ws + WS_ULOC + 2 * RT_STRIDE) + (size_t)row * 128;
  const bf16_t* H = (const bf16_t*)(p.ws + WS_H);
  t.gs0 = f32x2{GWG[lane], SUG[lane]}; t.gs1 = f32x2{GWG[64 + lane], SUG[64 + lane]};
  t.hA = *(const u32x4*)(H + (size_t)row * DM + lane * 16); t.hB = *(const u32x4*)(H + (size_t)row * DM + lane * 16 + 8);
}
__device__ __forceinline__ void tok_prefetch_e(const CAS unsigned char* eidg, int row, TokPref& t) {
  const CAS i32x8* EP = eid_row(eidg, row);
  t.E0 = EP[0];
}
__device__ __forceinline__ void gather_token(const Params& p, const CAS unsigned char* eidg, int l, int row, int nextrow, TokPref& tp, unsigned char* lds, int lane, int wid) {
  f32x2* GS = (f32x2*)(lds + wid * 2048);
  const __amdgpu_buffer_rsrc_t rsT = __builtin_amdgcn_make_buffer_rsrc((void*)(p.ws + WS_PU + (size_t)l * NEXP * PROW), 0, (int)(WS_PV - WS_PU) + NEXP * PROW, 0x00020000);
  constexpr int VOFS = (int)(WS_PV - WS_PU);
  float* XC = (float*)(p.ws + WS_XCUR);
  const float* MOD = (const float*)(p.ws + WS_MOD);
  const CAS i32x8* EP = eid_row(eidg, row);
  GS[lane] = tp.gs0; GS[64 + lane] = tp.gs1;
  asm volatile("s_waitcnt lgkmcnt(0)" ::: "memory");
  const int eofl = ((lane >> 5) & 1) + 2 * ((lane >> 4) & 1) + 4 * ((lane >> 3) & 1);
  {
    f32x2 hf2[8];
    {
      const u32x4 hA = tp.hA, hB = tp.hB;
      hf2[0] = f32x2{bflo(hA.x), bfhi(hA.x)}; hf2[1] = f32x2{bflo(hA.y), bfhi(hA.y)}; hf2[2] = f32x2{bflo(hA.z), bfhi(hA.z)}; hf2[3] = f32x2{bflo(hA.w), bfhi(hA.w)};
      hf2[4] = f32x2{bflo(hB.x), bfhi(hB.x)}; hf2[5] = f32x2{bflo(hB.y), bfhi(hB.y)}; hf2[6] = f32x2{bflo(hB.z), bfhi(hB.z)}; hf2[7] = f32x2{bflo(hB.w), bfhi(hB.w)};
    }
    i32x8 Ec = tp.E0;
    if (nextrow >= 0) tok_prefetch(p, nextrow, lane, tp);
    f32x4 xpre[4];
    { const float* xr_ = XC + (size_t)row * DM + lane * 16;
#pragma unroll
      for (int v4 = 0; v4 < 4; ++v4) xpre[v4] = *(const f32x4*)(xr_ + v4 * 4); }
    f32x2 acc2[8];
#pragma unroll
    for (int i = 0; i < 8; ++i) acc2[i] = f32x2{0.f, 0.f};
#if REP_PEER > 1
#pragma unroll 1
#endif
    for (int rep = 0; rep < REP_PEER; ++rep) {
#if REP_PEER > 1
    int emask = rep ? GP_MASK : 0x3FFF; asm volatile("" : "+v"(emask)); emask = __builtin_amdgcn_readfirstlane(emask);
    float gz = rep ? 0.f : 1.f; asm volatile("" : "+v"(gz));
    if (rep) Ec = EP[0];
#define EMASK(x_) ((x_) & emask)
#define GZ(x_) ((x_) * gz)
#else
#define EMASK(x_) (x_)
#define GZ(x_) (x_)
#endif
#define LOADPAIR(dst_, tofs_, ea_, eb_) do { const u32x3v a_ = __builtin_amdgcn_raw_buffer_load_b96(rsT, lane12, EMASK(ea_) * PROW + (tofs_), 0); const unsigned b0_ = __builtin_amdgcn_raw_buffer_load_b32(rsT, lane12, EMASK(eb_) * PROW + (tofs_), 0); \
      const u32x2v b1_ = __builtin_amdgcn_raw_buffer_load_b64(rsT, lane12 + 4, EMASK(eb_) * PROW + (tofs_), 0); \
      dst_[0] = (int)a_.x; dst_[1] = (int)a_.y; dst_[2] = (int)a_.z; dst_[3] = (int)b0_; dst_[4] = (int)b1_.x; dst_[5] = (int)b1_.y; } while (0)
    const int lane12 = lane * 12;
    i32x6 uq[4], vq[4];
    LOADPAIR(uq[0], 0, Ec[0], Ec[1]); LOADPAIR(uq[1], 0, Ec[2], Ec[3]); LOADPAIR(uq[2], 0, Ec[4], Ec[5]); LOADPAIR(uq[3], 0, Ec[6], Ec[7]);
    LOADPAIR(vq[0], VOFS, Ec[0], Ec[1]); LOADPAIR(vq[1], VOFS, Ec[2], Ec[3]); LOADPAIR(vq[2], VOFS, Ec[4], Ec[5]); LOADPAIR(vq[3], VOFS, Ec[6], Ec[7]);
    Ec = EP[1];
#pragma unroll 1
    for (int g8 = 0; g8 < 16; ++g8) {
      const f32x2 gs = GS[g8 * 8 + eofl];
      float d[8];
#pragma unroll
      for (int i2 = 0; i2 < 4; ++i2) {
        const f32x32 r = __builtin_amdgcn_cvt_scalef32_pk32_f32_fp6(uq[i2], 1.0f);
        f32x2 a2 = __builtin_shufflevector(r, r, 0, 1) * hf2[0], b2 = __builtin_shufflevector(r, r, 16, 17) * hf2[0];
#define UDOT(k_) a2 = __builtin_shufflevector(r, r, 2 * (k_), 2 * (k_) + 1) * hf2[k_] + a2; b2 = __builtin_shufflevector(r, r, 16 + 2 * (k_), 17 + 2 * (k_)) * hf2[k_] + b2;
        UDOT(1) UDOT(2) UDOT(3) UDOT(4) UDOT(5) UDOT(6) UDOT(7)
#undef UDOT
        d[2 * i2] = a2.x + a2.y;
        d[2 * i2 + 1] = b2.x + b2.y;
        asm volatile("" : "+v"(d[2 * i2]), "+v"(d[2 * i2 + 1]));
      }
      if (g8 < 15) { LOADPAIR(uq[0], 0, Ec[0], Ec[1]); LOADPAIR(uq[1], 0, Ec[2], Ec[3]); LOADPAIR(uq[2], 0, Ec[4], Ec[5]); LOADPAIR(uq[3], 0, Ec[6], Ec[7]); }
      float tot;
      {
        auto s01 = __builtin_amdgcn_permlane32_swap(__float_as_uint(d[0]), __float_as_uint(d[1]), false, false);
        auto s23 = __builtin_amdgcn_permlane32_swap(__float_as_uint(d[2]), __float_as_uint(d[3]), false, false);
        auto s45 = __builtin_amdgcn_permlane32_swap(__float_as_uint(d[4]), __float_as_uint(d[5]), false, false);
        auto s67 = __builtin_amdgcn_permlane32_swap(__float_as_uint(d[6]), __float_as_uint(d[7]), false, false);
        const float q01 = __uint_as_float(s01[0]) + __uint_as_float(s01[1]), q23 = __uint_as_float(s23[0]) + __uint_as_float(s23[1]);
        const float q45 = __uint_as_float(s45[0]) + __uint_as_float(s45[1]), q67 = __uint_as_float(s67[0]) + __uint_as_float(s67[1]);
        auto ta = __builtin_amdgcn_permlane16_swap(__float_as_uint(q01), __float_as_uint(q23), false, false);
        auto tb = __builtin_amdgcn_permlane16_swap(__float_as_uint(q45), __float_as_uint(q67), false, false);
        const float r0123 = __uint_as_float(ta[0]) + __uint_as_float(ta[1]);
        const float r4567 = __uint_as_float(tb[0]) + __uint_as_float(tb[1]);
        const bool b3 = (lane & 8) != 0;
        const float keep = b3 ? r4567 : r0123, send = b3 ? r0123 : r4567;
        float x = keep + dpp_mov<0x140>(send);
        x += dpp_mov<0xB1>(x); x += dpp_mov<0x4E>(x); x += dpp_mov<0x141>(x);
        tot = x * gs.y;
      }
      float ge;
      {
        const float v = tot, av = fabsf(v), tq = __builtin_amdgcn_rcpf(av * 0.2316418882f + 1.0f);
        float q = tq * 0.5307027145f + (-0.7265760135f); q = q * tq + 0.7107068705f; q = q * tq + (-0.142248368f); q = q * tq + 0.127414796f; q = q * tq;
        const float ex = __builtin_amdgcn_exp2f(v * v * (-0.72134752044f));
        const float m = v * (q * ex), r = v - m;
        ge = GZ((v < 0.f ? m : r) * gs.x);
      }
      float c[8];
      c[0] = __uint_as_float(__builtin_amdgcn_readlane(__float_as_uint(ge), 0));  c[4] = __uint_as_float(__builtin_amdgcn_readlane(__float_as_uint(ge), 8));
      c[2] = __uint_as_float(__builtin_amdgcn_readlane(__float_as_uint(ge), 16)); c[6] = __uint_as_float(__builtin_amdgcn_readlane(__float_as_uint(ge), 24));
      c[1] = __uint_as_float(__builtin_amdgcn_readlane(__float_as_uint(ge), 32)); c[5] = __uint_as_float(__builtin_amdgcn_readlane(__float_as_uint(ge), 40));
      c[3] = __uint_as_float(__builtin_amdgcn_readlane(__float_as_uint(ge), 48)); c[7] = __uint_as_float(__builtin_amdgcn_readlane(__float_as_uint(ge), 56));
#pragma unroll
      for (int i2 = 0; i2 < 4; ++i2) {
        const f32x32 r = __builtin_amdgcn_cvt_scalef32_pk32_f32_fp6(vq[i2], 1.0f);
        const f32x2 cc = {c[2 * i2], c[2 * i2 + 1]};
        const f32x2 ca = __builtin_shufflevector(cc, cc, 0, 0), cb = __builtin_shufflevector(cc, cc, 1, 1);
#define VAXL(k_) acc2[k_] = ca * __builtin_shufflevector(r, r, 2 * (k_), 2 * (k_) + 1) + acc2[k_];
#define VAXH(k_) acc2[k_] = cb * __builtin_shufflevector(r, r, 16 + 2 * (k_), 17 + 2 * (k_)) + acc2[k_];
        VAXL(0) VAXL(1) VAXL(2) VAXL(3) VAXL(4) VAXL(5) VAXL(6) VAXL(7)
        asm volatile("" : "+v"(acc2[0]), "+v"(acc2[1]), "+v"(acc2[2]), "+v"(acc2[3]), "+v"(acc2[4]), "+v"(acc2[5]), "+v"(acc2[6]), "+v"(acc2[7]));
        VAXH(0) VAXH(1) VAXH(2) VAXH(3) VAXH(4) VAXH(5) VAXH(6) VAXH(7)
#undef VAXL
#undef VAXH
        asm volatile("" : "+v"(acc2[0]), "+v"(acc2[1]), "+v"(acc2[2]), "+v"(acc2[3]), "+v"(acc2[4]), "+v"(acc2[5]), "+v"(acc2[6]), "+v"(acc2[7]));
      }
      if (g8 < 15) { LOADPAIR(vq[0], VOFS, Ec[0], Ec[1]); LOADPAIR(vq[1], VOFS, Ec[2], Ec[3]); LOADPAIR(vq[2], VOFS, Ec[4], Ec[5]); LOADPAIR(vq[3], VOFS, Ec[6], Ec[7]); }
      Ec = EP[g8 < 14 ? g8 + 2 : 15];
    }
    }
    if (nextrow >= 0) tok_prefetch_e(eidg, nextrow, tp);
    SBAR();
    float acc[16];
#pragma unroll
    for (int i = 0; i < 8; ++i) { acc[2 * i] = acc2[i].x; acc[2 * i + 1] = acc2[i].y; }
    const int mr = mod_row(row);
    const float* g2 = MOD + ((size_t)l * 5 + mr) * 6144 + 5 * 1024;
    float* xr = XC + (size_t)row * DM;
    float xn[16]; float ssq = 0.f;
    if (ABL & 8) {
#pragma unroll
      for (int i = 0; i < 16; ++i) acc[i] = 0.f;
    }
#pragma unroll
    for (int v4 = 0; v4 < 4; ++v4) {
      const int c = lane * 16 + v4 * 4;
      const f32x4 xo = xpre[v4], gg = *(const f32x4*)(g2 + c);
      f32x4 o;
      o.x = xo.x + gg.x * acc[v4 * 4 + 0]; o.y = xo.y + gg.y * acc[v4 * 4 + 1]; o.z = xo.z + gg.z * acc[v4 * 4 + 2]; o.w = xo.w + gg.w * acc[v4 * 4 + 3];
      xn[v4 * 4 + 0] = o.x; xn[v4 * 4 + 1] = o.y; xn[v4 * 4 + 2] = o.z; xn[v4 * 4 + 3] = o.w;
      ssq += (o.x * o.x + o.y * o.y) + (o.z * o.z + o.w * o.w);
      if (l < DEPTH - 1) *(f32x4*)(xr + c) = o;
    }
    const float rs = rsqrtf(wave_sum(ssq) * (1.f / DM) + EPS);
    if (l == DEPTH - 1) {
      const int b = row / SEGL, s = row - b * SEGL;
      float* orow = p.out + ((size_t)(b * SEQ + (s - CTXL))) * DM;
      const float* fg = p.in[I_FINALG];
#pragma unroll
      for (int v4 = 0; v4 < 4; ++v4) {
        const int c = lane * 16 + v4 * 4;
        const f32x4 gg = *(const f32x4*)(fg + c);
        f32x4 o; o.x = xn[v4 * 4 + 0] * rs * gg.x; o.y = xn[v4 * 4 + 1] * rs * gg.y; o.z = xn[v4 * 4 + 2] * rs * gg.z; o.w = xn[v4 * 4 + 3] * rs * gg.w;
        *(f32x4*)(orow + c) = o;
      }
    } else {
      const float* m = MOD + ((size_t)(l + 1) * 5 + mr) * 6144;
      const float* ng = p.in[I_N1G] + (l + 1) * DM;
      bf16_t* hrow = (bf16_t*)(p.ws + WS_H) + (size_t)row * DM;
#pragma unroll
      for (int hh = 0; hh < 2; ++hh) {
        float y[8];
#pragma unroll
        for (int i = 0; i < 8; ++i) { const int c = lane * 16 + hh * 8 + i; y[i] = xn[hh * 8 + i] * rs * ng[c] * (1.f + m[1024 + c]) + m[c]; }
        u32x4 w; w.x = cvtpk(y[0], y[1]); w.y = cvtpk(y[2], y[3]); w.z = cvtpk(y[4], y[5]); w.w = cvtpk(y[6], y[7]);
        *(u32x4*)(hrow + lane * 16 + hh * 8) = w;
      }
    }
  }
}

__device__ __forceinline__ void phase_c1(const Params& p, int l, unsigned char* lds) {
  constexpr int NLOC = NBATCH * 4 * NCH, NCONV = T / 32;
  for (int u = p.bx; u < NLOC + NCONV; u += p.gx) {
    if (u < NLOC) ml_local_unit2(p, l, u, lds);
    else {
      const int cu = u - NLOC;
      if (l == DEPTH - 1 && (cu % (SEGL / 32)) < (CTXL / 32)) continue;
      conv_unit(p, l, cu, lds);
    }
  }
}
__device__ __forceinline__ void phase_c2(const Params& p, int l, unsigned char* lds) {
  ml_scan(p, lds);
  const float* lp = p.in[I_DLAM] + l * 256;
  float s01 = 0.f, s23 = 0.f;
  for (int i = 0; i < 64; ++i) { s01 += lp[i] * lp[64 + i]; s23 += lp[128 + i] * lp[192 + i]; }
  const float lam_init = 0.8f - 0.6f * expf(-0.3f * (float)l);
  const float lam = expf(s01) - expf(s23) + lam_init;
  const bf16_t* PROJ = (const bf16_t*)(p.ws + WS_PROJ);
  bf16_t* MIX = (bf16_t*)(p.ws + WS_MIX);
  const float* ng = p.in[I_DNORMG] + l * 128;
  const int nun = 512 + (l < DEPTH - 1 ? 16 : 0);
  for (int u = p.bx; u < nun; u += p.gx) {
    int bh, qrow, nkeys;
    if (u < 512) { const int xcd = u & 7, i = (u >> 3) & 31, rnd = u >> 8; bh = 2 * xcd + rnd; qrow = CTXL + i * 256; nkeys = SEGL; }
    else { bh = u - 512; qrow = 0; nkeys = CTXL; }
    const int b = bh >> 2, h = bh & 3;
    const size_t tok0 = (size_t)b * SEGL;
    for (int rep = 0; rep < REP_ATT; ++rep)
    att_unit(PROJ + (tok0 + qrow) * PW + C_DQ + h * 128, PROJ + tok0 * PW + C_DK + h * 128, p.ws + WS_V8T + (size_t)bh * NCH * ATT_SHM_V,
             MIX + (tok0 + qrow) * DM + 512 + h * 128, nkeys, lam, ng, 1.f - lam_init, lds);
  }
}
__device__ __forceinline__ void phase_c3(const Params& p, int l, unsigned char* lds) {
  constexpr int NU = NBATCH * 4 * NCH;
  for (int u = p.bx; u < NU; u += p.gx) {
    if (l == DEPTH - 1 && (u % NCH) < 4) continue;
    ml_out_unit2(p, l, u, lds);
  }
}
__device__ __forceinline__ void phase_route(const Params& p, int l, unsigned char* lds) {
  constexpr int NU = T / 32;
  for (int u = p.bx; u < NU; u += p.gx) {
    if (l == DEPTH - 1 && (u % (SEGL / 32)) < (CTXL / 32)) continue;
    route_unit(p, l, u, lds);
    __syncthreads();
  }
}
__device__ __forceinline__ void phase_gather(const Params& p, int l, unsigned char* lds) {
  int tid_ = threadIdx.x; asm volatile("" : "+v"(tid_)); const int lane = tid_ & 63, wid = __builtin_amdgcn_readfirstlane(tid_ >> 6);
  const int gw = p.bx * 8 + wid, NGW = p.gx * 8;
  const int ntok = (l == DEPTH - 1) ? NBATCH * SEQ : T;
#define TOKROW(ti_) ((l == DEPTH - 1) ? ((ti_) / SEQ) * SEGL + CTXL + ((ti_) % SEQ) : (ti_))
  const CAS unsigned char* eidg = (const CAS unsigned char*)(p.ws + WS_EID + (size_t)l * RT_STRIDE);
  TokPref tp;
  if (gw < ntok) { tok_prefetch(p, TOKROW(gw), lane, tp); tok_prefetch_e(eidg, TOKROW(gw), tp); }
  XcdBarrier xb; xb.bar = p.xbar_words; xb.x = p.xbar_x; xb.st = (volatile LAS unsigned*)((LAS unsigned char*)lds + p.lds_st_off);
  const int nrounds = (ntok + NGW - 1) / NGW;
  for (int r = 0; r < nrounds; ++r) {
    const int ti = gw + r * NGW;
    if (ti < ntok) {
      const int row = TOKROW(ti);
      const int nxt = ti + NGW < ntok ? TOKROW(ti + NGW) : -1;
      gather_token(p, eidg, l, row, nxt, tp, lds, lane, wid);
    }
#if GATHER_SYNC
    if (r + 1 < nrounds) { XcdBarrier xb2 = xb; size_t zb_ = 0; asm volatile("" : "+s"(zb_)); xb2.bar = xb.bar + zb_; xb2.x = xb.x + (unsigned)zb_; xcd_barrier(xb2); }
#endif
  }
#undef TOKROW
}

__global__ void __launch_bounds__(512, 2) mk_fwd(KArgs ka) {
  cg::grid_group grid = cg::this_grid();
  extern __shared__ __attribute__((aligned(16))) unsigned char lds[];
  const int lo = ka.ph_lo, hi = ka.ph_hi;
#define IN(k) (lo <= (k) && (k) < hi)
#ifndef PHASEMASK
#define PHASEMASK 0xFFFF
#endif
#define PH(i) ((PHASEMASK >> (i)) & 1)
#define MKP(q) Params q; { size_t z_ = 0; asm volatile("" : "+s"(z_)); \
    q.in = (InTab)((const __attribute__((address_space(4))) char*)__builtin_amdgcn_kernarg_segment_ptr() + z_); \
    q.out = ka.out + z_; q.ws = ka.ws + z_; q.ph_lo = lo; q.ph_hi = hi; q.bx = (int)blockIdx.x + (int)z_; q.gx = (int)gridDim.x + (int)z_; q.xbar_words = xbar.bar + z_; q.xbar_x = xbar.x + (unsigned)z_; q.lds_st_off = (unsigned)(LDS_BYTES - 64); }
#define SEAM(k) do { if (IN(k) && IN((k) + 1)) { if ((k) == 0) grid.sync(); else { XcdBarrier xb_ = xbar; size_t zb_ = 0; asm volatile("" : "+s"(zb_)); xb_.bar = xbar.bar + zb_; xb_.x = xbar.x + (unsigned)zb_; xcd_barrier(xb_); } } } while (0)
  volatile LAS unsigned* xst = (volatile LAS unsigned*)((LAS unsigned char*)lds + (LDS_BYTES - 64));
  if (threadIdx.x < 2) xst[threadIdx.x] = 0u;
  __syncthreads();
  XcdBarrier xbar = xcd_barrier_post((unsigned*)(ka.ws + WS_CTL) + 4096, xst);
  { MKP(p)
    if (PH(0) && IN(0)) for (int rep = 0; rep < REP_MISC; ++rep) { p0_mod(p, lds, (float*)(p.ws + WS_MOD)); p0_convert(p, lds); }
  }
  SEAM(0);
  { MKP(p)
    if (PH(1) && IN(1)) phase_norm(p, 0, 0, true, false);
  }
  SEAM(1);
#define LAYER(LL) { \
    int l = (LL); asm volatile("" : "+s"(l)); \
    const int b = 2 + 9 * (LL); \
    { MKP(q) if (PH(2) && IN(b + 0)) for (int rep = 0; rep < REP_GEMM; ++rep) phase_inproj2(q, l, lds); } \
    SEAM(b + 0); \
    { MKP(q) if (PH(3) && IN(b + 1)) for (int rep = 0; rep < REP_ML; ++rep) phase_c1(q, l, lds); } \
    SEAM(b + 1); \
    { MKP(q) if (PH(4) && IN(b + 2)) phase_c2(q, l, lds); } \
    SEAM(b + 2); \
    { MKP(q) if (PH(5) && IN(b + 3)) for (int rep = 0; rep < REP_ML; ++rep) phase_c3(q, l, lds); } \
    SEAM(b + 3); \
    { MKP(q) if (PH(6) && IN(b + 4)) phase_outproj2(q, l, lds); } \
    SEAM(b + 4); \
    { MKP(q) if (PH(7) && IN(b + 5)) for (int rep = 0; rep < REP_MISC; ++rep) phase_norm(q, l, 1, false, (LL) == DEPTH - 1); } \
    SEAM(b + 5); \
    { MKP(q) if (PH(8) && IN(b + 6)) for (int rep = 0; rep < REP_GEMM; ++rep) phase_peerq2(q, l, lds); } \
    SEAM(b + 6); \
    { MKP(q) if (PH(9) && IN(b + 7)) phase_route(q, l, lds); } \
    SEAM(b + 7); \
    { MKP(q) if (PH(9) && IN(b + 8)) phase_gather(q, l, lds); } \
    SEAM(b + 8); }
  LAYER(0) LAYER(1) LAYER(2) LAYER(3)
#undef LAYER
#undef IN
#undef SEAM
#undef MKP
}

extern "C" void kernel_launch(void* const* d_in, const int* in_sizes, int n_in, void* d_out, int out_size,
                              void* d_ws, size_t ws_size, hipStream_t stream) {
  static int grid = 0;
  if (grid == 0) {
    int dev = 0, cus = 0, per_cu = 0;
    (void)hipGetDevice(&dev);
    (void)hipDeviceGetAttribute(&cus, hipDeviceAttributeMultiprocessorCount, dev);
    (void)hipFuncSetAttribute((const void*)mk_fwd, hipFuncAttributeMaxDynamicSharedMemorySize, LDS_BYTES);
    (void)hipOccupancyMaxActiveBlocksPerMultiprocessor(&per_cu, (const void*)mk_fwd, 512, LDS_BYTES);
    fprintf(stderr, "kernel_launch: cus %d per_cu %d ws %zu (need %zu) n_in %d\n", cus, per_cu, ws_size, (size_t)WS_END, n_in);
    if (ws_size < WS_END || n_in != 23 || per_cu < 1) { fprintf(stderr, "kernel_launch: bad configuration, nothing launched\n"); grid = -1; return; }
    grid = cus;
  }
  if (grid < 0) return;
  (void)hipMemsetAsync((char*)d_ws + WS_CTL, 0, 65536, stream);
  KArgs p{};
  for (int i = 0; i < 23; ++i) p.in[i] = (const float*)d_in[i];
  p.out = (float*)d_out; p.ws = (unsigned char*)d_ws; p.ph_lo = 0; p.ph_hi = 38;
  void* args[] = {&p};
  hipError_t e = hipLaunchCooperativeKernel((const void*)mk_fwd, dim3(grid), dim3(512), args, LDS_BYTES, stream);
  if (e != hipSuccess) fprintf(stderr, "cooperative launch failed: %s (grid %d)\n", hipGetErrorString(e), grid);
}
```

```cpp
#include <hip/hip_runtime.h>
#include <hip/hip_cooperative_groups.h>
#include <cstdio>
#include <cstdint>
namespace cg = cooperative_groups;

constexpr int DM = 1024, NBATCH = 4, SEQ = 8192, CTXL = 256, SEGL = CTXL + SEQ, T = NBATCH * SEGL, DEPTH = 4;
constexpr int IN_W = 3088, PW = 3072;
constexpr int C_A = 0, C_MQ = 512, C_MK = 768, C_MV = 1024, C_MO = 1280, C_DQ = 1536, C_DK = 2048, C_DV = 2560;
constexpr int NCH = SEGL / 64;
constexpr int NEXP = 16384;
constexpr float EPS = 1e-6f;
#ifndef ABL
#define ABL 0
#endif
#ifndef GATHER_SYNC
#define GATHER_SYNC 0
#endif
#ifndef REP_ATT
#define REP_ATT 1
#endif
#ifndef GP_MASK
#define GP_MASK 0x3FFF
#endif
#ifndef REP_PEER
#define REP_PEER 1
#endif
#ifndef REP_GEMM
#define REP_GEMM 1
#endif
#ifndef REP_ROUTE
#define REP_ROUTE 1
#endif
#ifndef REP_OUTP
#define REP_OUTP 1
#endif
#ifndef REP_ML
#define REP_ML 1
#endif
#ifndef REP_MISC
#define REP_MISC 1
#endif
constexpr float QSCALE = 0.125f * 1.4426950408889634f;

constexpr size_t MiB = 1u << 20;
constexpr size_t WS_CTL = 0, WS_MOD = 1 * MiB, WS_ROPE = 2 * MiB, WS_WG = 4 * MiB, WS_KEYS = 5 * MiB, WS_MLMETA = 6 * MiB,
                 WS_GATES = 7 * MiB, WS_WIN = 10 * MiB, WS_WOUT = 34 * MiB, WS_WQ = 42 * MiB, WS_PU = 50 * MiB, WS_PV = 114 * MiB, WS_PSC = 178 * MiB  ,
                 WS_XCUR = 306 * MiB, WS_H = 438 * MiB, WS_MIX = 504 * MiB, WS_PROJ = 570 * MiB, WS_ULOC = 768 * MiB, WS_V8T = 836 * MiB  , WS_EID = 858 * MiB  , WS_END = 924 * MiB;
constexpr int USTRIDE = 4160;

constexpr int LDS_BYTES = 139264 + 512;
constexpr int LDS_WTAB = LDS_BYTES - 64 - 256;

#define LAS __attribute__((address_space(3)))
__device__ __forceinline__ int hw_wave_key() { return (int)(__builtin_amdgcn_s_getreg((5 << 11) | 4) & 63u); }
__device__ __forceinline__ int tidx() {
  extern __shared__ __attribute__((aligned(16))) unsigned char lds_dyn_[];
  const int w = __builtin_amdgcn_readfirstlane(*(const volatile LAS int*)((LAS unsigned char*)lds_dyn_ + LDS_WTAB + 4 * hw_wave_key()));
  unsigned z_ = 0u; asm volatile("" : "+v"(z_));
  return (w << 6) | (int)__builtin_amdgcn_mbcnt_hi(~0u, __builtin_amdgcn_mbcnt_lo(~0u, z_));
}
typedef unsigned short bf16_t;
typedef short bf16x8 __attribute__((ext_vector_type(8)));
typedef short s16x4 __attribute__((ext_vector_type(4)));
typedef float f32x4 __attribute__((ext_vector_type(4)));
typedef float f32x16 __attribute__((ext_vector_type(16)));
typedef unsigned u32x4 __attribute__((ext_vector_type(4)));
typedef unsigned u32x2 __attribute__((ext_vector_type(2)));
typedef __bf16 bf16x2v __attribute__((ext_vector_type(2)));
typedef int i32x8 __attribute__((ext_vector_type(8)));
typedef int i32x6 __attribute__((ext_vector_type(6)));
struct __attribute__((aligned(4))) u32x3 { unsigned x, y, z; };
typedef float f32x32 __attribute__((ext_vector_type(32)));
constexpr int PROW = 768;
typedef float f32x2 __attribute__((ext_vector_type(2)));
typedef _Float16 h16x2 __attribute__((ext_vector_type(2)));
typedef _Float16 h16x32 __attribute__((ext_vector_type(32)));
typedef unsigned u32x3v __attribute__((ext_vector_type(3)));
typedef unsigned u32x2v __attribute__((ext_vector_type(2)));

struct KArgs {
  const float* in[23];
  float* out;
  unsigned char* ws;
  int ph_lo, ph_hi;
};
typedef const float* const __attribute__((address_space(4))) * InTab;
struct Params {
  InTab in;
  float* out;
  unsigned char* ws;
  int ph_lo, ph_hi;
  int bx, gx;
  unsigned* xbar_words; unsigned xbar_x; unsigned lds_st_off;
};
enum { I_X = 0, I_C, I_CTX, I_CCTX, I_ADAW, I_ADAB, I_N1G, I_N2G, I_WIN, I_CONVW, I_CONVB, I_CLNG, I_CLNB, I_GATEB, I_MNORMG, I_DLAM, I_DNORMG,
       I_WOUT, I_PWQ, I_PKEYS, I_PU, I_PV, I_FINALG };

__device__ __forceinline__ unsigned cvtpk(float lo, float hi) { unsigned r; asm volatile("v_cvt_pk_bf16_f32 %0, %1, %2" : "=v"(r) : "v"(lo), "v"(hi)); return r; }
__device__ __forceinline__ float bflo(unsigned u) { return __uint_as_float(u << 16); }
__device__ __forceinline__ float bfhi(unsigned u) { return __uint_as_float(u & 0xffff0000u); }
__device__ __forceinline__ float bf1(bf16_t u) { return __uint_as_float(((unsigned)u) << 16); }
__device__ __forceinline__ int crow(int r, int hi) { return (r & 3) + 8 * (r >> 2) + 4 * hi; }
template <int CTRL> __device__ __forceinline__ float dpp_mov(float v) {
  return __uint_as_float((unsigned)__builtin_amdgcn_update_dpp(0, (int)__float_as_uint(v), CTRL, 0xF, 0xF, true));
}
__device__ __forceinline__ float wave_sum_fast(float x) {
  x += dpp_mov<0xB1>(x); x += dpp_mov<0x4E>(x); x += dpp_mov<0x141>(x); x += dpp_mov<0x140>(x);
  { auto r = __builtin_amdgcn_permlane16_swap(__float_as_uint(x), __float_as_uint(x), false, false); x = __uint_as_float(r[0]) + __uint_as_float(r[1]); }
  { auto r = __builtin_amdgcn_permlane32_swap(__float_as_uint(x), __float_as_uint(x), false, false); x = __uint_as_float(r[0]) + __uint_as_float(r[1]); }
  return x;
}
__device__ __forceinline__ float wave_sum(float v) {
#pragma unroll
  for (int o = 1; o < 64; o <<= 1) v += __shfl_xor(v, o);
  return v;
}
__device__ __forceinline__ float wave_max(float v) {
#pragma unroll
  for (int o = 1; o < 64; o <<= 1) v = fmaxf(v, __shfl_xor(v, o));
  return v;
}
__device__ __forceinline__ float sigmoidf_(float x) { return 1.f / (1.f + __expf(-x)); }
__device__ __forceinline__ float logsigmoidf_(float x) { return fminf(x, 0.f) - log1pf(__expf(-fabsf(x))); }
__device__ __forceinline__ const float* in_row(const float* x, const float* ctx, int row) {
  const int b = row / SEGL, s = row - b * SEGL;
  return s < CTXL ? ctx + ((size_t)(b * CTXL + s)) * DM : x + ((size_t)(b * SEQ + (s - CTXL))) * DM;
}
__device__ __forceinline__ int mod_row(int row) { const int b = row / SEGL, s = row - b * SEGL; return s < CTXL ? 4 : b; }

__device__ __forceinline__ void p0_mod(const Params& p, unsigned char* lds, float* MOD) {
  float* sil = (float*)lds;
  float* red = (float*)(lds + 20480);
  int tid_ = tidx(); asm volatile("" : "+v"(tid_)); const int tid = tid_, lane = tid & 63, wid = tid >> 6;
  for (int i = tid; i < 5 * 1024; i += 512) {
    const float v = i < 4096 ? p.in[I_C][i] : p.in[I_CCTX][i - 4096];
    sil[i] = v / (1.f + __expf(-v));
  }
  __syncthreads();
  for (int item = p.bx; item < DEPTH * 96; item += p.gx) {
    const int l = item / 96, j0 = (item % 96) * 64;
    const float* W = p.in[I_ADAW] + (size_t)l * DM * 6144 + j0 + lane;
    float a0 = 0.f, a1 = 0.f, a2 = 0.f, a3 = 0.f, a4 = 0.f;
    const int k0 = wid * 128;
#pragma unroll 8
    for (int k = k0; k < k0 + 128; ++k) {
      const float w = W[(size_t)k * 6144];
      a0 += sil[k] * w; a1 += sil[1024 + k] * w; a2 += sil[2048 + k] * w; a3 += sil[3072 + k] * w; a4 += sil[4096 + k] * w;
    }
    red[(wid * 5 + 0) * 64 + lane] = a0; red[(wid * 5 + 1) * 64 + lane] = a1; red[(wid * 5 + 2) * 64 + lane] = a2;
    red[(wid * 5 + 3) * 64 + lane] = a3; red[(wid * 5 + 4) * 64 + lane] = a4;
    __syncthreads();
    if (tid < 320) {
      const int r = tid >> 6;
      float s = 0.f;
#pragma unroll
      for (int w = 0; w < 8; ++w) s += red[(w * 5 + r) * 64 + lane];
      MOD[((size_t)l * 5 + r) * 6144 + j0 + lane] = s + p.in[I_ADAB][l * 6144 + j0 + lane];
    }
    __syncthreads();
  }
}
__device__ __forceinline__ void transpose_item(const float* W, int ldw, int srccol0, bf16_t* WT, int K, int n0, int k0, float* scr, int lane) {
#pragma unroll 8
  for (int i = 0; i < 32; ++i) { const int kk = 2 * i + (lane >> 5); scr[kk * 33 + (lane & 31)] = W[(size_t)(k0 + kk) * ldw + srccol0 + (lane & 31)]; }
  asm volatile("s_waitcnt lgkmcnt(0)" ::: "memory");
  const int c = lane & 7;
#pragma unroll
  for (int j = 0; j < 4; ++j) {
    const int n = (lane >> 3) + 8 * j; const float* s = scr + (8 * c) * 33 + n;
    u32x4 o; o.x = cvtpk(s[0], s[33]); o.y = cvtpk(s[66], s[99]); o.z = cvtpk(s[132], s[165]); o.w = cvtpk(s[198], s[231]);
    *(u32x4*)(WT + (size_t)(n0 + n) * K + k0 + 8 * c) = o;
  }
  asm volatile("s_waitcnt lgkmcnt(0)" ::: "memory");
}
__device__ __forceinline__ void convert_tables(const Params& p, int L, int wv, int nw, int lane) {
  unsigned char* PUq = p.ws + WS_PU; unsigned char* PVq = p.ws + WS_PV; float* PSC = (float*)(p.ws + WS_PSC);
  const int nrows = DEPTH * NEXP;
  for (int r = wv; r < 2 * NEXP; r += nw) {
    const int tb = r >= NEXP, rr = L * NEXP + (tb ? r - NEXP : r);
    const f32x4* srow = (const f32x4*)((tb ? p.in[I_PV] : p.in[I_PU]) + (size_t)rr * DM) + lane * 4;
    f32x4 v[4]; float mx = 0.f;
#pragma unroll
    for (int j = 0; j < 4; ++j) { v[j] = __builtin_nontemporal_load(srow + j); mx = fmaxf(mx, fmaxf(fmaxf(fabsf(v[j].x), fabsf(v[j].y)), fmaxf(fabsf(v[j].z), fabsf(v[j].w)))); }
    mx = wave_max(mx);
    const unsigned mb = __float_as_uint(mx);
    const int eb = (int)((mb >> 23) & 0xFFu);
    int sb = ((mb & 0x7FFFFFu) <= 0x700000u ? 129 : 128) - eb + 127; sb = sb < 1 ? 1 : (sb > 253 ? 253 : sb);
    const float sc = __uint_as_float((unsigned)sb << 23), isc = __uint_as_float((unsigned)(254 - sb) << 23);
    const float xv[16] = {v[0].x, v[0].y, v[0].z, v[0].w, v[1].x, v[1].y, v[1].z, v[1].w, v[2].x, v[2].y, v[2].z, v[2].w, v[3].x, v[3].y, v[3].z, v[3].w};
    unsigned wq[3] = {0u, 0u, 0u};
#pragma unroll
    for (int i = 0; i < 16; ++i) {
      const float a = fabsf(xv[i]) * sc;
      unsigned code = a < 2.f ? (unsigned)__builtin_rintf(a * 8.f) : (a < 4.f ? 8u + (unsigned)__builtin_rintf(a * 4.f) : 16u + (unsigned)__builtin_rintf(a * 2.f));
      code = code > 31u ? 31u : code;
      code |= (xv[i] < 0.f) ? 32u : 0u;
      const int bp = 6 * i, dw = bp >> 5, off = bp & 31;
      wq[dw] |= code << off;
      if (off > 26) wq[dw + 1] |= code >> (32 - off);
    }
    u32x3 o; o.x = wq[0]; o.y = wq[1]; o.z = wq[2];
    *(u32x3*)((tb ? PVq : PUq) + (size_t)rr * PROW + lane * 12) = o;
    if (lane == 0) PSC[(size_t)tb * nrows + rr] = isc;
  }
}
__device__ __forceinline__ void tail_filler_tables(const Params& p, int L, int nwg) {
  int tid_ = tidx(); asm volatile("" : "+v"(tid_)); const int lane = tid_ & 63, wid = tid_ >> 6;
  const int nextra = nwg % p.gx, first = nextra, nidle = p.gx - nextra;
  if (p.bx < first) return;
  convert_tables(p, L, (p.bx - first) * 8 + wid, nidle * 8, lane);
}
__device__ __forceinline__ void p0_convert(const Params& p, unsigned char* lds) {
  int tid_ = tidx(); asm volatile("" : "+v"(tid_)); const int tid = tid_, lane = tid & 63, wid = tid >> 6;
  const int gw = p.bx * 8 + wid, NGW = p.gx * 8;
  const size_t gt = (size_t)p.bx * 512 + tid, NGT = (size_t)p.gx * 512;
  float* scr = (float*)(lds + 32768) + wid * (64 * 33);
  bf16_t* WIN = (bf16_t*)(p.ws + WS_WIN); bf16_t* WOUT = (bf16_t*)(p.ws + WS_WOUT); bf16_t* WQ = (bf16_t*)(p.ws + WS_WQ);
  constexpr int I_IN = 16 * 96, I_O = 16 * 32, PER_L = I_IN + 2 * I_O;
  for (int it = gw; it < DEPTH * PER_L; it += NGW) {
    const int l = it / PER_L; int r = it % PER_L;
    if (r < I_IN) { const int kb = r / 96, nb = r % 96, n0 = nb * 32; const int src = n0 < 1536 ? n0 : n0 + 16;
      transpose_item(p.in[I_WIN] + (size_t)l * DM * IN_W, IN_W, src, WIN + (size_t)l * PW * DM, DM, n0, kb * 64, scr, lane); continue; }
    r -= I_IN;
    if (r < I_O) { const int kb = r / 32, nb = r % 32;
      transpose_item(p.in[I_WOUT] + (size_t)l * DM * DM, DM, nb * 32, WOUT + (size_t)l * DM * DM, DM, nb * 32, kb * 64, scr, lane); continue; }
    r -= I_O;
    { const int kb = r / 32, nb = r % 32;
      transpose_item(p.in[I_PWQ] + (size_t)l * DM * DM, DM, nb * 32, WQ + (size_t)l * DM * DM, DM, nb * 32, kb * 64, scr, lane); }
  }
  bf16_t* WG = (bf16_t*)(p.ws + WS_WG);
  for (size_t i = gt; i < (size_t)DEPTH * 16 * DM; i += NGT) {
    const int l = (int)(i / (16 * DM)), g = (int)((i / DM) % 16), k = (int)(i % DM);
    WG[i] = (bf16_t)(cvtpk(p.in[I_WIN][(size_t)l * DM * IN_W + (size_t)k * IN_W + 1536 + g], 0.f) & 0xffffu);
  }
  bf16_t* KEYS = (bf16_t*)(p.ws + WS_KEYS);
  for (size_t i = gt; i < (size_t)DEPTH * 131072 / 8; i += NGT) {
    const f32x4 a = ((const f32x4*)p.in[I_PKEYS])[2 * i], b = ((const f32x4*)p.in[I_PKEYS])[2 * i + 1];
    u32x4 o; o.x = cvtpk(a.x, a.y); o.y = cvtpk(a.z, a.w); o.z = cvtpk(b.x, b.y); o.w = cvtpk(b.z, b.w);
    ((u32x4*)KEYS)[i] = o;
  }
  {
    float* RC = (float*)(p.ws + WS_ROPE); float* RS = RC + SEQ * 32;
    for (size_t i = gt; i < (size_t)SEQ * 32; i += NGT) {
      const int pos = (int)(i >> 5), j = (int)(i & 31);
      const int rr = pos >> 6, cc = pos & 63;
      const int jj = j & 15;
      const double e = -(double)jj * 0.83048202372184058696;
      const double fl = __builtin_floor(e); const double f = e - fl;
      const double z = f * 0.69314718055994530942;
      double ez = 1.0 + z * (1.0 + z * (0.5 + z * (1.0 / 6 + z * (1.0 / 24 + z * (1.0 / 120 + z * (1.0 / 720 + z * (1.0 / 5040 + z * (1.0 / 40320 + z * (1.0 / 362880 + z * (1.0 / 3628800 + z * (1.0 / 39916800 + z * (1.0 / 479001600))))))))))));
      const double inv = __builtin_ldexp(ez, (int)fl);
      const float invf = (float)inv;
      const float angf = (float)(j < 16 ? rr : cc) * invf;
      const double ang = (double)angf;
      const double kq = __builtin_rint(ang * 0.63661977236758134308);
      double r = __builtin_fma(-kq, 1.57079632679489655800e+00, ang);
      r = __builtin_fma(-kq, 6.12323399573676603587e-17, r);
      const double r2 = r * r;
      const double sn = r * (1.0 + r2 * (-1.0 / 6 + r2 * (1.0 / 120 + r2 * (-1.0 / 5040 + r2 * (1.0 / 362880 + r2 * (-1.0 / 39916800 + r2 * (1.0 / 6227020800.0)))))));
      const double cs = 1.0 + r2 * (-0.5 + r2 * (1.0 / 24 + r2 * (-1.0 / 720 + r2 * (1.0 / 40320 + r2 * (-1.0 / 3628800 + r2 * (1.0 / 479001600 + r2 * (-1.0 / 87178291200.0)))))));
      const int q = ((int)kq) & 3;
      double co, si;
      if (q == 0) { co = cs; si = sn; } else if (q == 1) { co = -sn; si = cs; } else if (q == 2) { co = -cs; si = -sn; } else { co = sn; si = -cs; }
      RC[i] = (float)co; RS[i] = (float)si;
    }
  }
}

__device__ __forceinline__ void norm_mod_row(const float* xrow, const float* g, const float* sc, const float* sh, bf16_t* orow, int lane) {
  const f32x4* xr = (const f32x4*)xrow + lane;
  f32x4 v[4]; float s = 0.f;
#pragma unroll
  for (int j = 0; j < 4; ++j) { v[j] = xr[64 * j]; s += (v[j].x * v[j].x + v[j].y * v[j].y) + (v[j].z * v[j].z + v[j].w * v[j].w); }
  const float rs = rsqrtf(wave_sum(s) * (1.f / DM) + EPS);
  u32x2* o = (u32x2*)orow + lane;
#pragma unroll
  for (int j = 0; j < 4; ++j) {
    const f32x4 gg = ((const f32x4*)g)[lane + 64 * j], cc = ((const f32x4*)sc)[lane + 64 * j], hh = ((const f32x4*)sh)[lane + 64 * j];
    const float y0 = v[j].x * rs * gg.x * (1.f + cc.x) + hh.x, y1 = v[j].y * rs * gg.y * (1.f + cc.y) + hh.y;
    const float y2 = v[j].z * rs * gg.z * (1.f + cc.z) + hh.z, y3 = v[j].w * rs * gg.w * (1.f + cc.w) + hh.w;
    u32x2 w; w.x = cvtpk(y0, y1); w.y = cvtpk(y2, y3);
    o[64 * j] = w;
  }
}
__device__ __forceinline__ void phase_norm(const Params& p, int l, int which, bool from_input, bool skip_ctx) {
  int tid_ = tidx(); asm volatile("" : "+v"(tid_));
  const int lane = tid_ & 63, wid = tid_ >> 6;
  const int gw = p.bx * 8 + wid, NGW = p.gx * 8;
  const float* MOD = (const float*)(p.ws + WS_MOD);
  const float* XC = (const float*)(p.ws + WS_XCUR);
  bf16_t* H = (bf16_t*)(p.ws + WS_H);
  const float* g = p.in[which ? I_N2G : I_N1G] + l * DM;
  for (int row = gw; row < T; row += NGW) {
    const int mr = mod_row(row);
    if (skip_ctx && mr == 4) continue;
    const float* m = MOD + ((size_t)l * 5 + mr) * 6144 + which * 3072;
    const float* xr = from_input ? in_row(p.in[I_X], p.in[I_CTX], row) : XC + (size_t)row * DM;
    norm_mod_row(xr, g, m + 1024, m, H + (size_t)row * DM, lane);
  }
}

namespace pg8 {
#define PG8_LAS __attribute__((address_space(3)))
typedef unsigned short bf16_t;
typedef short bf16x8 __attribute__((ext_vector_type(8)));
typedef float f32x4 __attribute__((ext_vector_type(4)));
typedef unsigned u32x4 __attribute__((ext_vector_type(4)));
constexpr int BM = 256, BK = 64, HALF = 128, HTB = HALF * BK * 2  , STAGE_BYTES = 8 * HTB, NXCD = 8, WGM = 8;

__host__ __device__ __forceinline__ int lds_byte(int r, int c) { const int st = (r >> 4) * 2 + (c >> 5), rr = r & 15, cc = c & 31, ob = rr * 64 + cc * 2; return st * 1024 + (ob ^ (((ob >> 9) & 1) << 5)); }
__host__ __device__ __forceinline__ void stage_rc(int b, int& R, int& C) { const int st = b / 1024, sb = b % 1024, swz = sb ^ (((sb >> 9) & 1) << 5); R = (st >> 1) * 16 + swz / 64; C = (st & 1) * 32 + (swz % 64) / 2; }
__host__ __device__ __forceinline__ int perm32(int rho) { const int n = rho >> 4, i = rho & 15; return 8 * (i >> 2) + 4 * n + (i & 3); }

struct Unit { int pm, pn; };
struct Gemm { const bf16_t* A; const bf16_t* Bt; int M, N, K; };

struct StaticOrder {
    int nM, nN, nwg, G, c;
    __host__ __device__ void init(int M, int N, int G_, int c_) { nM = M / BM; nN = N / BM; nwg = nM * nN; G = G_; c = c_; }
    __host__ __device__ bool next(int i, Unit& u) const {
        const long L = (long)i * G + c; if (L >= nwg) return false;
        int wgid = (int)L; { const int q = nwg / NXCD, r = nwg % NXCD, xcd = wgid % NXCD, off = wgid / NXCD; wgid = (xcd < r ? xcd * (q + 1) : r * (q + 1) + (xcd - r) * q) + off; }
        const int nig = WGM * nN, gid = wgid / nig, fm = gid * WGM, gsz = (nM - fm) < WGM ? (nM - fm) : WGM;
        u.pm = fm + ((wgid % nig) % gsz); u.pn = (wgid % nig) / gsz; return true;
    }
    __device__ __forceinline__ void a_ready(const Unit&) const {}
    __device__ __forceinline__ void done(const Unit&) const {}
};
__device__ __forceinline__ unsigned cvt_pk_bf16(float lo, float hi) { unsigned r; asm volatile("v_cvt_pk_bf16_f32 %0, %1, %2" : "=v"(r) : "v"(lo), "v"(hi)); return r; }
template <class Epi, class Sched, bool ALIGN_EPI = false, bool SP2 = false>
__device__ __forceinline__ void gemm_phase(PG8_LAS unsigned char* lds, const Gemm g, const Sched& S, const Epi& E) {
    const int tid = tidx(), wid = __builtin_amdgcn_readfirstlane(tid >> 6), lane = tid & 63, wr = wid >> 2, wc = wid & 3, fr = lane & 15, fq = lane >> 4;
    const int K = g.K, nt = K / BK;
    unsigned voffA[2], voffB[2];
#pragma unroll
    for (int i = 0; i < 2; ++i) { int R, C; stage_rc(tid * 16 + i * 8192, R, C); const int Rb = Epi::PERM ? ((R & ~31) + perm32(R & 31)) : R;
        voffA[i] = (unsigned)(R * K + C) * 2u; voffB[i] = (unsigned)(Rb * K + C) * 2u; }
    const size_t kstep = (size_t)(BK * 2);
    const size_t hstep = (size_t)HALF * K * 2;
    const size_t tstep = 2 * hstep;
    const unsigned ldsw = (unsigned)wid * 1024u;
    const int aoff = lds_byte(wr * 64 + fr, fq * 8), boff = lds_byte(wc * 32 + fr, fq * 8);
#define PG8_SA(b, h) (((b) * 2 + (h)) * HTB)
#define PG8_SB(b, h) ((4 + (b) * 2 + (h)) * HTB)
#define PG8_STAGE(bufoff, gbase, voff) do { _Pragma("unroll") for (int _i = 0; _i < 2; ++_i) \
        __builtin_amdgcn_global_load_lds((const unsigned*)((const char*)(gbase) + (voff)[_i]), (PG8_LAS unsigned*)(lds + (bufoff) + ldsw + _i * 8192), 16, 0, 0); } while (0)
#define PG8_LDA(dst, b, h) do { _Pragma("unroll") for (int m = 0; m < 4; ++m) _Pragma("unroll") for (int k = 0; k < 2; ++k) dst[m][k] = *(const PG8_LAS bf16x8*)(lds + PG8_SA(b, h) + aoff + m * 2048 + k * 1024); } while (0)
#define PG8_LDB(dst, b, h) do { _Pragma("unroll") for (int n = 0; n < 2; ++n) _Pragma("unroll") for (int k = 0; k < 2; ++k) dst[n][k] = *(const PG8_LAS bf16x8*)(lds + PG8_SB(b, h) + boff + n * 2048 + k * 1024); } while (0)
#define PG8_MMA(ai, bj, At, Bt) do { __builtin_amdgcn_s_setprio(1); _Pragma("unroll") for (int m = 0; m < 4; ++m) _Pragma("unroll") for (int n = 0; n < 2; ++n) _Pragma("unroll") for (int k = 0; k < 2; ++k) \
        acc[ai][bj][m][n] = __builtin_amdgcn_mfma_f32_16x16x32_bf16(Bt[n][k], At[m][k], acc[ai][bj][m][n], 0, 0, 0); __builtin_amdgcn_s_setprio(0); } while (0)
#define PG8_WAIT_V(n) asm volatile("s_waitcnt vmcnt(" #n ")" ::: "memory")
#define PG8_WAIT_L(n) asm volatile("s_waitcnt lgkmcnt(" #n ")" ::: "memory")
#define PG8_BAR __builtin_amdgcn_s_barrier()
#define PG8_SCHED __builtin_amdgcn_sched_barrier(0)
    Unit cur, nxt; int ui = 0;
    if (!S.next(0, cur)) return;
    f32x4 acc[2][2][4][2];
#pragma unroll
    for (int a = 0; a < 2; ++a)
#pragma unroll
        for (int b = 0; b < 2; ++b)
#pragma unroll
            for (int m = 0; m < 4; ++m)
#pragma unroll
                for (int n = 0; n < 2; ++n) acc[a][b][m][n] = (f32x4){0.f, 0.f, 0.f, 0.f};
    bf16x8 At[4][2], B0[2][2], B1[2][2];
    const char* cA = (const char*)g.A + (size_t)cur.pm * tstep; const char* cB = (const char*)g.Bt + (size_t)cur.pn * tstep;
    S.a_ready(cur);
    if constexpr (SP2) {
        PG8_STAGE(PG8_SB(0, 0), cB, voffB); PG8_STAGE(PG8_SB(0, 1), cB + hstep, voffB); PG8_STAGE(PG8_SA(0, 0), cA, voffA); PG8_STAGE(PG8_SA(0, 1), cA + hstep, voffA);
        if (wr == 1) PG8_BAR;
        PG8_WAIT_V(2); PG8_BAR;
        PG8_STAGE(PG8_SB(1, 0), cB + kstep, voffB); PG8_STAGE(PG8_SA(1, 0), cA + kstep, voffA); PG8_STAGE(PG8_SB(1, 1), cB + hstep + kstep, voffB);
        PG8_WAIT_V(6); PG8_BAR;
    } else {
        PG8_STAGE(PG8_SB(0, 0), cB, voffB); PG8_STAGE(PG8_SA(0, 0), cA, voffA); PG8_STAGE(PG8_SB(0, 1), cB + hstep, voffB); PG8_STAGE(PG8_SA(0, 1), cA + hstep, voffA);
        if (wr == 1) PG8_BAR;
        PG8_WAIT_V(4); PG8_BAR;
        PG8_STAGE(PG8_SB(1, 0), cB + kstep, voffB); PG8_STAGE(PG8_SA(1, 0), cA + kstep, voffA); PG8_STAGE(PG8_SB(1, 1), cB + hstep + kstep, voffB);
        PG8_WAIT_V(6); PG8_BAR;
    }
    for (;;) {
        const bool has_next = S.next(ui + 1, nxt);
        const char* nA = has_next ? (const char*)g.A + (size_t)nxt.pm * tstep : cA; const char* nB = has_next ? (const char*)g.Bt + (size_t)nxt.pn * tstep : cB;
        for (int t = 0; t < nt; t += 2) {
            const bool last = (t == nt - 2);
            const char* a1 = cA + (size_t)(t + 1) * kstep;
            const char* a2 = last ? nA : cA + (size_t)(t + 2) * kstep; const char* b2 = last ? nB : cB + (size_t)(t + 2) * kstep;
            const char* a3 = a2 + kstep; const char* b3 = b2 + kstep;
            if (last && has_next) S.a_ready(nxt);
            if constexpr (SP2) {
            PG8_LDB(B0, 0, 0); PG8_LDB(B1, 0, 1); PG8_SCHED; PG8_LDA(At, 0, 0); PG8_STAGE(PG8_SA(1, 1), a1 + hstep, voffA);
            PG8_WAIT_V(8); PG8_WAIT_L(0); PG8_BAR; PG8_MMA(0, 0, At, B0); PG8_MMA(0, 1, At, B1); PG8_BAR; PG8_SCHED;
            PG8_LDA(At, 0, 1); PG8_STAGE(PG8_SB(0, 0), b2, voffB); PG8_STAGE(PG8_SB(0, 1), b2 + hstep, voffB); PG8_STAGE(PG8_SA(0, 0), a2, voffA);
            PG8_WAIT_V(8); PG8_WAIT_L(0); PG8_BAR; PG8_MMA(1, 0, At, B0); PG8_MMA(1, 1, At, B1); PG8_BAR; PG8_SCHED;
            PG8_LDB(B0, 1, 0); PG8_LDB(B1, 1, 1); PG8_SCHED; PG8_LDA(At, 1, 0); PG8_STAGE(PG8_SA(0, 1), a2 + hstep, voffA);
            PG8_WAIT_V(8); PG8_WAIT_L(0); PG8_BAR; PG8_MMA(0, 0, At, B0); PG8_MMA(0, 1, At, B1); PG8_BAR; PG8_SCHED;
            PG8_LDA(At, 1, 1); PG8_STAGE(PG8_SB(1, 0), b3, voffB); PG8_STAGE(PG8_SB(1, 1), b3 + hstep, voffB); PG8_STAGE(PG8_SA(1, 0), a3, voffA);
            PG8_WAIT_V(8); PG8_WAIT_L(0); PG8_BAR; PG8_MMA(1, 0, At, B0); PG8_MMA(1, 1, At, B1); PG8_BAR; PG8_SCHED;
            } else {
            PG8_LDB(B0, 0, 0); PG8_SCHED; PG8_LDA(At, 0, 0); PG8_STAGE(PG8_SA(1, 1), a1 + hstep, voffA);
            PG8_WAIT_L(8); PG8_BAR; PG8_WAIT_L(0); PG8_MMA(0, 0, At, B0); PG8_BAR; PG8_SCHED;
            PG8_LDB(B1, 0, 1); PG8_STAGE(PG8_SB(0, 0), b2, voffB);
            PG8_BAR; PG8_WAIT_L(0); PG8_MMA(0, 1, At, B1); PG8_BAR;
            PG8_LDA(At, 0, 1); PG8_STAGE(PG8_SA(0, 0), a2, voffA);
            PG8_BAR; PG8_WAIT_L(0); PG8_MMA(1, 0, At, B0); PG8_BAR; PG8_SCHED;
            PG8_STAGE(PG8_SB(0, 1), b2 + hstep, voffB);
            PG8_WAIT_V(6); PG8_BAR; PG8_MMA(1, 1, At, B1); PG8_BAR;
            PG8_LDB(B0, 1, 0); PG8_SCHED; PG8_LDA(At, 1, 0); PG8_STAGE(PG8_SA(0, 1), a2 + hstep, voffA);
            PG8_WAIT_L(8); PG8_BAR; PG8_WAIT_L(0); PG8_MMA(0, 0, At, B0); PG8_BAR; PG8_SCHED;
            PG8_LDB(B1, 1, 1); PG8_STAGE(PG8_SB(1, 0), b3, voffB);
            PG8_BAR; PG8_WAIT_L(0); PG8_MMA(0, 1, At, B1); PG8_BAR;
            PG8_LDA(At, 1, 1); PG8_STAGE(PG8_SA(1, 0), a3, voffA);
            PG8_BAR; PG8_WAIT_L(0); PG8_MMA(1, 0, At, B0); PG8_BAR; PG8_SCHED;
            PG8_STAGE(PG8_SB(1, 1), b3 + hstep, voffB);
            PG8_WAIT_V(6); PG8_BAR; PG8_MMA(1, 1, At, B1); PG8_BAR;
            }
        }
        if constexpr (ALIGN_EPI) { if (wr == 0) PG8_BAR; }
        if constexpr (!Epi::AFTER_DRAIN) { E(acc, cur, wr, wc, fr, fq); S.done(cur); }
        if (!has_next) break;
#pragma unroll
        for (int a = 0; a < 2; ++a)
#pragma unroll
            for (int b = 0; b < 2; ++b)
#pragma unroll
                for (int m = 0; m < 4; ++m)
#pragma unroll
                    for (int n = 0; n < 2; ++n) acc[a][b][m][n] = (f32x4){0.f, 0.f, 0.f, 0.f};
        cur = nxt; cA = nA; cB = nB; ++ui;
        if constexpr (ALIGN_EPI) { if (wr == 1) PG8_BAR; }
    }
    PG8_WAIT_V(0);
    if constexpr (!ALIGN_EPI) { if (wr == 0) PG8_BAR; }
    PG8_BAR;
    if constexpr (Epi::AFTER_DRAIN) { E.fused(acc, cur, wr, wc, fr, fq, lds, wid, lane); S.done(cur); }
#undef PG8_SA
#undef PG8_SB
#undef PG8_STAGE
#undef PG8_LDA
#undef PG8_LDB
#undef PG8_MMA
#undef PG8_WAIT_V
#undef PG8_WAIT_L
#undef PG8_BAR
#undef PG8_SCHED
}
}

__device__ __forceinline__ int gswz(int row, int chunk) { return row * 128 + ((chunk ^ ((row >> 1) & 7)) << 4); }
__device__ __forceinline__ void gemm_tile(const bf16_t* __restrict__ A, int lda, const bf16_t* __restrict__ Bt, int ldb, int K,
                                          int row0, int col0, unsigned char* lds, f32x16 (&acc)[2][2]) {
  int tid_ = tidx(); asm volatile("" : "+v"(tid_)); const int tid = tid_, lane = tid & 63, wid = tid >> 6, wm = wid >> 1, wn = wid & 1, r32 = lane & 31, hi = lane >> 5;
  unsigned char* As = lds; unsigned char* Bs = lds + 65536;
#pragma unroll
  for (int i = 0; i < 2; ++i)
#pragma unroll
    for (int j = 0; j < 2; ++j) acc[i][j] = f32x16{};
  const int lrow = tid >> 3, lc = tid & 7;
  const bf16_t* Ag = A + (size_t)(row0 + lrow) * lda + lc * 8;
  const bf16_t* Bg = Bt + (size_t)(col0 + lrow) * ldb + lc * 8;
  u32x4 ra[4], rb[2];
#pragma unroll
  for (int i = 0; i < 4; ++i) ra[i] = *(const u32x4*)(Ag + (size_t)(64 * i) * lda);
#pragma unroll
  for (int i = 0; i < 2; ++i) rb[i] = *(const u32x4*)(Bg + (size_t)(64 * i) * ldb);
#pragma unroll
  for (int i = 0; i < 4; ++i) *(u32x4*)(As + gswz(lrow + 64 * i, lc)) = ra[i];
#pragma unroll
  for (int i = 0; i < 2; ++i) *(u32x4*)(Bs + gswz(lrow + 64 * i, lc)) = rb[i];
  __syncthreads();
  const int nk = K / 64;
  for (int kt = 0; kt < nk; ++kt) {
    const int cur = kt & 1;
    if (kt + 1 < nk) {
#pragma unroll
      for (int i = 0; i < 4; ++i) ra[i] = *(const u32x4*)(Ag + (size_t)(64 * i) * lda + (kt + 1) * 64);
#pragma unroll
      for (int i = 0; i < 2; ++i) rb[i] = *(const u32x4*)(Bg + (size_t)(64 * i) * ldb + (kt + 1) * 64);
    }
    const unsigned char* Ac = As + cur * 32768; const unsigned char* Bc = Bs + cur * 16384;
#pragma unroll
    for (int kk = 0; kk < 4; ++kk) {
      bf16x8 af[2], bfr[2];
#pragma unroll
      for (int i = 0; i < 2; ++i) af[i] = *(const bf16x8*)(Ac + gswz(wm * 64 + i * 32 + r32, 2 * kk + hi));
#pragma unroll
      for (int j = 0; j < 2; ++j) bfr[j] = *(const bf16x8*)(Bc + gswz(wn * 64 + j * 32 + r32, 2 * kk + hi));
#pragma unroll
      for (int i = 0; i < 2; ++i)
#pragma unroll
        for (int j = 0; j < 2; ++j) acc[i][j] = __builtin_amdgcn_mfma_f32_32x32x16_bf16(af[i], bfr[j], acc[i][j], 0, 0, 0);
    }
    if (kt + 1 < nk) {
      unsigned char* An = As + (cur ^ 1) * 32768; unsigned char* Bn = Bs + (cur ^ 1) * 16384;
#pragma unroll
      for (int i = 0; i < 4; ++i) *(u32x4*)(An + gswz(lrow + 64 * i, lc)) = ra[i];
#pragma unroll
      for (int i = 0; i < 2; ++i) *(u32x4*)(Bn + gswz(lrow + 64 * i, lc)) = rb[i];
    }
    __syncthreads();
  }
}
__device__ __forceinline__ void pair_xchg(float v0, float v1, int lane, float& lo, float& hi2) {
  const bool odd = lane & 1;
  const float send = odd ? v0 : v1;
  const float recv = __shfl_xor(send, 1);
  lo = odd ? recv : v0; hi2 = odd ? v1 : recv;
}

__device__ __forceinline__ void phase_inproj(const Params& p, int l, unsigned char* lds) {
  int tid_ = tidx(); asm volatile("" : "+v"(tid_)); const int tid = tid_, lane = tid & 63, wid = tid >> 6, wm = wid >> 1, wn = wid & 1, r32 = lane & 31, hi = lane >> 5;
  const bf16_t* H = (const bf16_t*)(p.ws + WS_H);
  const bf16_t* W = (const bf16_t*)(p.ws + WS_WIN) + (size_t)l * PW * DM;
  bf16_t* PROJ = (bf16_t*)(p.ws + WS_PROJ);
  const float* RC = (const float*)(p.ws + WS_ROPE); const float* RS = RC + SEQ * 32;
  constexpr int NM = T / 256, NN = PW / 128, NU = NM * NN;
  for (int u = p.bx; u < NU + NM; u += p.gx) {
    if (u < NU) {
      const int pn = u / NM, pm = u % NM;
      const int row0 = pm * 256, col0 = pn * 128;
      f32x16 acc[2][2];
      gemm_tile(H, DM, W, DM, DM, row0, col0, lds, acc);
      const bool rope = (col0 >= C_DQ && col0 < C_DV);
      const float scl = (col0 >= C_MK && col0 < C_MV) ? 0.125f : ((col0 >= C_DQ && col0 < C_DK) ? QSCALE : 1.f);
#pragma unroll
      for (int i = 0; i < 2; ++i)
#pragma unroll
        for (int j = 0; j < 2; ++j)
#pragma unroll
          for (int q = 0; q < 8; ++q) {
            float lo, hi2; pair_xchg(acc[i][j][2 * q], acc[i][j][2 * q + 1], lane, lo, hi2);
            const int row = row0 + wm * 64 + i * 32 + crow(2 * q, hi) + (lane & 1);
            const int col = col0 + wn * 64 + j * 32 + (r32 & ~1);
            if (rope) {
              const int s = row % SEGL;
              if (s >= CTXL) {
                const int idx = (s - CTXL) * 32 + ((col & 63) >> 1);
                const float c = RC[idx], sn = RS[idx];
                const float t1 = lo, t2 = hi2; lo = t1 * c - t2 * sn; hi2 = t1 * sn + t2 * c;
              }
            }
            *(unsigned*)(PROJ + (size_t)row * PW + col) = cvtpk(lo * scl, hi2 * scl);
          }
    } else {
      const int pm = u - NU, rowb = pm * 256 + wid * 32;
      const bf16_t* WG = (const bf16_t*)(p.ws + WS_WG) + (size_t)l * 16 * DM;
      float* GT = (float*)(p.ws + WS_GATES);
      const int r16 = lane & 15, q4 = lane >> 4;
      f32x4 c0 = {0.f, 0.f, 0.f, 0.f}, c1 = {0.f, 0.f, 0.f, 0.f};
      const bf16_t* a0p = H + (size_t)(rowb + r16) * DM + q4 * 8;
      const bf16_t* a1p = a0p + (size_t)16 * DM;
      const bf16_t* bp = WG + (size_t)r16 * DM + q4 * 8;
#pragma unroll 4
      for (int ks = 0; ks < 32; ++ks) {
        const bf16x8 a0 = *(const bf16x8*)(a0p + ks * 32), a1 = *(const bf16x8*)(a1p + ks * 32), b = *(const bf16x8*)(bp + ks * 32);
        c0 = __builtin_amdgcn_mfma_f32_16x16x32_bf16(a0, b, c0, 0, 0, 0);
        c1 = __builtin_amdgcn_mfma_f32_16x16x32_bf16(a1, b, c1, 0, 0, 0);
      }
      const float gb = p.in[I_GATEB][l * 16 + r16];
#pragma unroll
      for (int j = 0; j < 4; ++j) {
        GT[(size_t)(rowb + q4 * 4 + j) * 16 + r16] = c0[j] + gb;
        GT[(size_t)(rowb + 16 + q4 * 4 + j) * 16 + r16] = c1[j] + gb;
      }
    }
  }
}

__device__ __forceinline__ void phase_outproj(const Params& p, int l, unsigned char* lds) {
  int tid_ = tidx(); asm volatile("" : "+v"(tid_)); const int tid = tid_, lane = tid & 63, wid = tid >> 6, wm = wid >> 1, wn = wid & 1, r32 = lane & 31, hi = lane >> 5;
  const bf16_t* MIX = (const bf16_t*)(p.ws + WS_MIX);
  const bf16_t* W = (const bf16_t*)(p.ws + WS_WOUT) + (size_t)l * DM * DM;
  float* XC = (float*)(p.ws + WS_XCUR);
  const float* MOD = (const float*)(p.ws + WS_MOD);
  constexpr int NM = T / 256, NN = DM / 128, NU = NM * NN;
  for (int u = p.bx; u < NU; u += p.gx) {
    const int pm = u / NN, pn = u % NN;
    if (l == DEPTH - 1 && (pm % 33) == 0) continue;
    const int row0 = pm * 256, col0 = pn * 128;
    for (int rep = 0; rep < REP_OUTP; ++rep) {
    f32x16 acc[2][2];
    gemm_tile(MIX, DM, W, DM, DM, row0, col0, lds, acc);
    const int mr = (pm % 33) == 0 ? 4 : pm / 33;
    const float* g1 = MOD + ((size_t)l * 5 + mr) * 6144 + 2048;
#pragma unroll
    for (int i = 0; i < 2; ++i)
#pragma unroll
      for (int j = 0; j < 2; ++j) {
        const int col = col0 + wn * 64 + j * 32 + r32;
        const float gg = (rep == REP_OUTP - 1) ? g1[col] : 0.f;
#pragma unroll
        for (int r = 0; r < 16; ++r) {
          const int row = row0 + wm * 64 + i * 32 + crow(r, hi);
          const float xo = (l == 0) ? in_row(p.in[I_X], p.in[I_CTX], row)[col] : XC[(size_t)row * DM + col];
          XC[(size_t)row * DM + col] = xo + gg * acc[i][j][r];
        }
      }
    }
  }
}
__device__ __forceinline__ void phase_peerq(const Params& p, int l, unsigned char* lds) {
  int tid_ = tidx(); asm volatile("" : "+v"(tid_)); const int tid = tid_, lane = tid & 63, wid = tid >> 6, wm = wid >> 1, wn = wid & 1, r32 = lane & 31, hi = lane >> 5;
  const bf16_t* H = (const bf16_t*)(p.ws + WS_H);
  const bf16_t* W = (const bf16_t*)(p.ws + WS_WQ) + (size_t)l * DM * DM;
  bf16_t* QP = (bf16_t*)(p.ws + WS_PROJ);
  constexpr int NM = T / 256, NN = DM / 128, NU = NM * NN;
  for (int u = p.bx; u < NU; u += p.gx) {
    const int pm = u / NN, pn = u % NN;
    if (l == DEPTH - 1 && (pm % 33) == 0) continue;
    const int row0 = pm * 256, col0 = pn * 128;
    f32x16 acc[2][2];
    gemm_tile(H, DM, W, DM, DM, row0, col0, lds, acc);
#pragma unroll
    for (int i = 0; i < 2; ++i)
#pragma unroll
      for (int j = 0; j < 2; ++j)
#pragma unroll
        for (int q = 0; q < 8; ++q) {
          float lo, hi2; pair_xchg(acc[i][j][2 * q], acc[i][j][2 * q + 1], lane, lo, hi2);
          const int row = row0 + wm * 64 + i * 32 + crow(2 * q, hi) + (lane & 1);
          const int col = col0 + wn * 64 + j * 32 + (r32 & ~1);
          *(unsigned*)(QP + (size_t)row * DM + col) = cvtpk(lo, hi2);
        }
  }
}


struct EpiInproj {
  static constexpr bool PERM = true, AFTER_DRAIN = false;
  bf16_t* PROJ; const float* RC; const float* RS; unsigned char* V8T;
  __device__ __forceinline__ void operator()(const pg8::f32x4 (&acc)[2][2][4][2], const pg8::Unit& u, int wr, int wc, int fr, int fq) const {
#pragma unroll
    for (int bj = 0; bj < 2; ++bj) {
      const int colt = u.pn * 256 + bj * 128;
      const bool rope = (colt >= C_DQ && colt < C_DV);
      const float scl = (colt >= C_MK && colt < C_MV) ? 0.125f : ((colt >= C_DQ && colt < C_DK) ? QSCALE : 1.f);
      const int col8 = colt + wc * 32 + 8 * fq;
      if (colt >= C_DV) {
        const int hh = (col8 - C_DV) >> 7, e0 = (col8 - C_DV) & 127;
#pragma unroll
        for (int ai = 0; ai < 2; ++ai)
#pragma unroll
          for (int m = 0; m < 4; ++m) {
            const int row = u.pm * 256 + ai * 128 + wr * 64 + m * 16 + fr;
            const int b = row / SEGL, s = row - b * SEGL, t = s >> 6, kk = s & 63;
            const int slot = ((kk >> 2) & 1) * 32 + (kk & 3) + 4 * ((kk >> 3) & 3) + 16 * (kk >> 5);
            unsigned char* vp = V8T + ((size_t)((b * 4 + hh) * NCH + t) * 128 + e0) * 80 + slot;
            const f32x4 v0 = acc[ai][bj][m][0], v1 = acc[ai][bj][m][1];
            int w0 = 0, w1 = 0;
            w0 = __builtin_amdgcn_cvt_pk_fp8_f32(v0[0], v0[1], w0, false); w0 = __builtin_amdgcn_cvt_pk_fp8_f32(v0[2], v0[3], w0, true);
            w1 = __builtin_amdgcn_cvt_pk_fp8_f32(v1[0], v1[1], w1, false); w1 = __builtin_amdgcn_cvt_pk_fp8_f32(v1[2], v1[3], w1, true);
            vp[0] = (unsigned char)(w0 & 0xFF); vp[80] = (unsigned char)((w0 >> 8) & 0xFF); vp[160] = (unsigned char)((w0 >> 16) & 0xFF); vp[240] = (unsigned char)((w0 >> 24) & 0xFF);
            vp[320] = (unsigned char)(w1 & 0xFF); vp[400] = (unsigned char)((w1 >> 8) & 0xFF); vp[480] = (unsigned char)((w1 >> 16) & 0xFF); vp[560] = (unsigned char)((w1 >> 24) & 0xFF);
          }
        continue;
      }
#pragma unroll
      for (int ai = 0; ai < 2; ++ai)
#pragma unroll
        for (int m = 0; m < 4; ++m) {
          const int row = u.pm * 256 + ai * 128 + wr * 64 + m * 16 + fr;
          f32x4 v0 = acc[ai][bj][m][0], v1 = acc[ai][bj][m][1];
          if (rope) {
            const int s = row % SEGL;
            if (s >= CTXL) {
              const int idx = (s - CTXL) * 32 + ((col8 & 63) >> 1);
              const f32x4 c = *(const f32x4*)(RC + idx), sn = *(const f32x4*)(RS + idx);
              f32x4 a, b;
              a[0] = v0[0] * c[0] - v0[1] * sn[0]; a[1] = v0[0] * sn[0] + v0[1] * c[0]; a[2] = v0[2] * c[1] - v0[3] * sn[1]; a[3] = v0[2] * sn[1] + v0[3] * c[1];
              b[0] = v1[0] * c[2] - v1[1] * sn[2]; b[1] = v1[0] * sn[2] + v1[1] * c[2]; b[2] = v1[2] * c[3] - v1[3] * sn[3]; b[3] = v1[2] * sn[3] + v1[3] * c[3];
              v0 = a; v1 = b;
            }
          }
          u32x4 w; w.x = cvtpk(v0[0] * scl, v0[1] * scl); w.y = cvtpk(v0[2] * scl, v0[3] * scl); w.z = cvtpk(v1[0] * scl, v1[1] * scl); w.w = cvtpk(v1[2] * scl, v1[3] * scl);
          *(u32x4*)(PROJ + (size_t)row * PW + col8) = w;
        }
    }
  }
};
struct EpiOutproj {
  static constexpr bool PERM = true, AFTER_DRAIN = false;
  float* XC; const float* MODL; const float* xin; const float* ctxin; int first; float gsc;
  __device__ __forceinline__ void operator()(const pg8::f32x4 (&acc)[2][2][4][2], const pg8::Unit& u, int wr, int wc, int fr, int fq) const {
    const int mr = (u.pm % 33) == 0 ? 4 : u.pm / 33;
    const float* g1 = MODL + (size_t)mr * 6144 + 2048;
#pragma unroll
    for (int bj = 0; bj < 2; ++bj) {
      const int col8 = u.pn * 256 + bj * 128 + wc * 32 + 8 * fq;
      const f32x4 ga = *(const f32x4*)(g1 + col8) * gsc, gb = *(const f32x4*)(g1 + col8 + 4) * gsc;
#pragma unroll
      for (int ai = 0; ai < 2; ++ai)
#pragma unroll
        for (int m = 0; m < 4; ++m) {
          const int row = u.pm * 256 + ai * 128 + wr * 64 + m * 16 + fr;
          const float* xo = first ? in_row(xin, ctxin, row) + col8 : XC + (size_t)row * DM + col8;
          const f32x4 xa = *(const f32x4*)xo, xb = *(const f32x4*)(xo + 4);
          *(f32x4*)(XC + (size_t)row * DM + col8) = xa + ga * acc[ai][bj][m][0];
          *(f32x4*)(XC + (size_t)row * DM + col8 + 4) = xb + gb * acc[ai][bj][m][1];
        }
    }
  }
};
struct EpiPeerq {
  static constexpr bool PERM = true, AFTER_DRAIN = false;
  bf16_t* QP;
  __device__ __forceinline__ void operator()(const pg8::f32x4 (&acc)[2][2][4][2], const pg8::Unit& u, int wr, int wc, int fr, int fq) const {
#pragma unroll
    for (int bj = 0; bj < 2; ++bj) {
      const int col8 = u.pn * 256 + bj * 128 + wc * 32 + 8 * fq;
#pragma unroll
      for (int ai = 0; ai < 2; ++ai)
#pragma unroll
        for (int m = 0; m < 4; ++m) {
          const int row = u.pm * 256 + ai * 128 + wr * 64 + m * 16 + fr;
          const f32x4 v0 = acc[ai][bj][m][0], v1 = acc[ai][bj][m][1];
          u32x4 w; w.x = cvtpk(v0[0], v0[1]); w.y = cvtpk(v0[2], v0[3]); w.z = cvtpk(v1[0], v1[1]); w.w = cvtpk(v1[2], v1[3]);
          *(u32x4*)(QP + (size_t)row * DM + col8) = w;
        }
    }
  }
};
__device__ __forceinline__ void phase_inproj2(const Params& p, int l, unsigned char* lds) {
  {
    pg8::Gemm g{(const bf16_t*)(p.ws + WS_H), (const bf16_t*)(p.ws + WS_WIN) + (size_t)l * PW * DM, T, PW, DM};
    pg8::StaticOrder S; S.init(T, PW, p.gx, p.bx);
    EpiInproj E{(bf16_t*)(p.ws + WS_PROJ), (const float*)(p.ws + WS_ROPE), (const float*)(p.ws + WS_ROPE) + SEQ * 32, p.ws + WS_V8T};
    pg8::gemm_phase<EpiInproj, pg8::StaticOrder, true, true>((PG8_LAS unsigned char*)lds, g, S, E);
  }
  int tid_ = tidx(); asm volatile("" : "+v"(tid_)); const int tid = tid_, lane = tid & 63, wid = tid >> 6;
  const bf16_t* H = (const bf16_t*)(p.ws + WS_H);
  for (int pm = p.bx; pm < T / 256; pm += p.gx) {
    const int rowb = pm * 256 + wid * 32;
    const bf16_t* WG = (const bf16_t*)(p.ws + WS_WG) + (size_t)l * 16 * DM;
    float* GT = (float*)(p.ws + WS_GATES);
    const int r16 = lane & 15, q4 = lane >> 4;
    f32x4 c0 = {0.f, 0.f, 0.f, 0.f}, c1 = {0.f, 0.f, 0.f, 0.f};
    const bf16_t* a0p = H + (size_t)(rowb + r16) * DM + q4 * 8;
    const bf16_t* a1p = a0p + (size_t)16 * DM;
    const bf16_t* bp = WG + (size_t)r16 * DM + q4 * 8;
#pragma unroll 4
    for (int ks = 0; ks < 32; ++ks) {
      const bf16x8 a0 = *(const bf16x8*)(a0p + ks * 32), a1 = *(const bf16x8*)(a1p + ks * 32), b = *(const bf16x8*)(bp + ks * 32);
      c0 = __builtin_amdgcn_mfma_f32_16x16x32_bf16(a0, b, c0, 0, 0, 0);
      c1 = __builtin_amdgcn_mfma_f32_16x16x32_bf16(a1, b, c1, 0, 0, 0);
    }
    const float gb = p.in[I_GATEB][l * 16 + r16];
#pragma unroll
    for (int j = 0; j < 4; ++j) {
      GT[(size_t)(rowb + q4 * 4 + j) * 16 + r16] = c0[j] + gb;
      GT[(size_t)(rowb + 16 + q4 * 4 + j) * 16 + r16] = c1[j] + gb;
    }
  }
}
__device__ __forceinline__ void phase_outproj2(const Params& p, int l, unsigned char* lds) {
  pg8::Gemm g{(const bf16_t*)(p.ws + WS_MIX), (const bf16_t*)(p.ws + WS_WOUT) + (size_t)l * DM * DM, T, DM, DM};
  pg8::StaticOrder S; S.init(T, DM, p.gx, p.bx);
  for (int rep = 0; rep < REP_OUTP; ++rep) {
  EpiOutproj E{(float*)(p.ws + WS_XCUR), (const float*)(p.ws + WS_MOD) + (size_t)l * 5 * 6144, p.in[I_X], p.in[I_CTX], l == 0, (rep == REP_OUTP - 1) ? 1.f : 0.f};
  pg8::gemm_phase<EpiOutproj, pg8::StaticOrder, true, true>((PG8_LAS unsigned char*)lds, g, S, E);
  }
  if (l < DEPTH - 1) tail_filler_tables(p, l, (T / 256) * (DM / 256));
}
__device__ __forceinline__ void phase_peerq2(const Params& p, int l, unsigned char* lds) {
  pg8::Gemm g{(const bf16_t*)(p.ws + WS_H), (const bf16_t*)(p.ws + WS_WQ) + (size_t)l * DM * DM, T, DM, DM};
  pg8::StaticOrder S; S.init(T, DM, p.gx, p.bx);
  EpiPeerq E{(bf16_t*)(p.ws + WS_PROJ)};
  pg8::gemm_phase<EpiPeerq, pg8::StaticOrder, true, true>((PG8_LAS unsigned char*)lds, g, S, E);
  if (l == DEPTH - 2) tail_filler_tables(p, DEPTH - 1, (T / 256) * (DM / 256));
}

__device__ __forceinline__ void conv_unit(const Params& p, int l, int unit, unsigned char* lds) {
  int tid_ = tidx(); asm volatile("" : "+v"(tid_)); const int tid = tid_, lane = tid & 63, wid = tid >> 6;
  float* U = (float*)lds;
  const bf16_t* PROJ = (const bf16_t*)(p.ws + WS_PROJ);
  bf16_t* MIX = (bf16_t*)(p.ws + WS_MIX);
  const int row0 = unit * 32, b = row0 / SEGL, s0 = row0 - b * SEGL;
  const int seglo = s0 < CTXL ? 0 : CTXL, seghi = s0 < CTXL ? CTXL : SEGL;
  for (int rr = tid >> 5; rr < 62; rr += 16) {
    const int s = s0 - 15 + rr, c8 = (tid & 31) * 8;
    f32x4 u0 = {0.f, 0.f, 0.f, 0.f}, u1 = {0.f, 0.f, 0.f, 0.f};
    if (s >= seglo && s < seghi) {
      const bf16_t* pr = PROJ + (size_t)(b * SEGL + s) * PW + c8;
      const u32x4 a1 = *(const u32x4*)pr, a2 = *(const u32x4*)(pr + 256);
      u0.x = bflo(a1.x) * sigmoidf_(bflo(a2.x)); u0.y = bfhi(a1.x) * sigmoidf_(bfhi(a2.x));
      u0.z = bflo(a1.y) * sigmoidf_(bflo(a2.y)); u0.w = bfhi(a1.y) * sigmoidf_(bfhi(a2.y));
      u1.x = bflo(a1.z) * sigmoidf_(bflo(a2.z)); u1.y = bfhi(a1.z) * sigmoidf_(bfhi(a2.z));
      u1.z = bflo(a1.w) * sigmoidf_(bflo(a2.w)); u1.w = bfhi(a1.w) * sigmoidf_(bfhi(a2.w));
    }
    *(f32x4*)(U + rr * 256 + c8) = u0; *(f32x4*)(U + rr * 256 + c8 + 4) = u1;
  }
  __syncthreads();
  float* Y = U + 62 * 256;
  const float* cw = p.in[I_CONVW] + (size_t)l * 31 * 256;
#pragma unroll 1
  for (int q = 0; q < 4; ++q) {
    const int c = lane + 64 * q;
    float w[31];
#pragma unroll
    for (int j = 0; j < 31; ++j) w[j] = cw[j * 256 + c];
    const float bias = p.in[I_CONVB][l * 256 + c];
#pragma unroll
    for (int tt = 0; tt < 4; ++tt) {
      const int t = wid * 4 + tt;
      float a = bias;
#pragma unroll
      for (int j = 0; j < 31; ++j) a += U[(t + j) * 256 + c] * w[j];
      Y[t * 256 + c] = a;
    }
  }
  asm volatile("s_waitcnt lgkmcnt(0)" ::: "memory");
  float y[4][4];
#pragma unroll
  for (int tt = 0; tt < 4; ++tt)
#pragma unroll
    for (int q = 0; q < 4; ++q) y[tt][q] = Y[(wid * 4 + tt) * 256 + lane + 64 * q];
#pragma unroll
  for (int tt = 0; tt < 4; ++tt) {
    const int t = wid * 4 + tt;
    const float mean = wave_sum((y[tt][0] + y[tt][1]) + (y[tt][2] + y[tt][3])) * (1.f / 256.f);
    float v = 0.f;
#pragma unroll
    for (int q = 0; q < 4; ++q) { const float d = y[tt][q] - mean; v += d * d; }
    const float rs = rsqrtf(wave_sum(v) * (1.f / 256.f) + EPS);
#pragma unroll
    for (int q = 0; q < 4; ++q) {
      const int c = lane + 64 * q;
      const float z = (y[tt][q] - mean) * rs * p.in[I_CLNG][l * 256 + c] + p.in[I_CLNB][l * 256 + c];
      const float o = (ABL & 1) ? 0.f : z * sigmoidf_(z);
      MIX[(size_t)(row0 + t) * DM + c] = (bf16_t)(cvtpk(o, 0.f) & 0xffffu);
    }
  }
  __syncthreads();
}

__device__ __forceinline__ int ml_cidx(int ch, int dir) { return dir == 0 ? ch : (ch < 4 ? 3 - ch : 135 - ch); }
__device__ __forceinline__ void ml_load_tile(const bf16_t* src, float* dst, int tid) {
  const int r = tid >> 3, c8 = (tid & 7) * 8;
  const u32x4 a = *(const u32x4*)(src + (size_t)r * PW + c8);
  float* d = dst + r * 65 + c8;
  d[0] = bflo(a.x); d[1] = bfhi(a.x); d[2] = bflo(a.y); d[3] = bfhi(a.y); d[4] = bflo(a.z); d[5] = bfhi(a.z); d[6] = bflo(a.w); d[7] = bfhi(a.w);
}
__device__ __forceinline__ void ml_local_unit(const Params& p, int l, int unit, unsigned char* lds) {
  int tid_ = tidx(); asm volatile("" : "+v"(tid_)); const int tid = tid_, lane = tid & 63, wid = tid >> 6, r32 = lane & 31, hi = lane >> 5;
  float* Kt = (float*)lds; float* Vt = Kt + 64 * 65; float* WK = Vt + 64 * 65;
  const bf16_t* PROJ = (const bf16_t*)(p.ws + WS_PROJ);
  const float* GT = (const float*)(p.ws + WS_GATES);
  float* UL = (float*)(p.ws + WS_ULOC); float* META = (float*)(p.ws + WS_MLMETA);
  const int b = unit / (4 * NCH), hh = (unit / NCH) & 3, ch = unit % NCH;
  const int row0 = b * SEGL + ch * 64;
  ml_load_tile(PROJ + (size_t)row0 * PW + C_MK + hh * 64, Kt, tid);
  ml_load_tile(PROJ + (size_t)row0 * PW + C_MV + hh * 64, Vt, tid);
  if (wid < 2) {
    const int dir = wid;
    const float ig = GT[(size_t)(row0 + lane) * 16 + (2 * dir) * 4 + hh];
    const float lf = logsigmoidf_(GT[(size_t)(row0 + lane) * 16 + (2 * dir + 1) * 4 + hh]);
    float ps = lf;
#pragma unroll
    for (int o = 1; o < 64; o <<= 1) { const float t = __shfl_up(ps, o); if (lane >= o) ps += t; }
    const float tot = __shfl(ps, 63);
    const float wlog = dir == 0 ? (tot - ps + ig) : (ps - lf + ig);
    const float mloc = wave_max(wlog);
    WK[dir * 64 + lane] = __expf(wlog - mloc);
    if (lane == 0) {
      const int seq = (b * 4 + hh) * 2 + dir, ci = ml_cidx(ch, dir);
      META[((size_t)seq * NCH + ci) * 4 + 0] = tot; META[((size_t)seq * NCH + ci) * 4 + 1] = mloc;
    }
  }
  __syncthreads();
  {
    const int dir = wid >> 2, et = (wid >> 1) & 1, dt = wid & 1;
    const int seq = (b * 4 + hh) * 2 + dir, ci = ml_cidx(ch, dir);
    float* slot = UL + ((size_t)seq * NCH + ci) * USTRIDE;
    f32x16 acc = {};
#pragma unroll 8
    for (int ks = 0; ks < 32; ++ks) {
      const int s = 2 * ks + hi;
      const float a = WK[dir * 64 + s] * Vt[s * 65 + et * 32 + r32];
      const float bb = Kt[s * 65 + dt * 32 + r32];
      acc = __builtin_amdgcn_mfma_f32_32x32x2f32(a, bb, acc, 0, 0, 0);
    }
#pragma unroll
    for (int r = 0; r < 16; ++r) slot[(et * 32 + crow(r, hi)) * 64 + dt * 32 + r32] = acc[r];
    if (et == 0) {
      float n = 0.f;
#pragma unroll 8
      for (int i = 0; i < 32; ++i) { const int s = hi * 32 + i; n += WK[dir * 64 + s] * Kt[s * 65 + dt * 32 + r32]; }
      n += __shfl_xor(n, 32);
      if (hi == 0) slot[4096 + dt * 32 + r32] = n;
    }
  }
  __syncthreads();
}
constexpr int MLP = 144;
constexpr size_t WS_CST = WS_H;
constexpr size_t WS_NST = WS_H + (size_t)32 * NCH * 4096 * 2;
__device__ __forceinline__ void ml_stage_rm(const bf16_t* src, size_t ld, unsigned char* dst, int tid) {
  const int r = tid >> 3, c8 = (tid & 7) * 8;
  *(u32x4*)(dst + r * MLP + c8 * 2) = *(const u32x4*)(src + (size_t)r * ld + c8);
}
__device__ __forceinline__ void ml_stage_tr(const bf16_t* src, size_t ld, unsigned char* dst, int tid) {
  const int r = tid >> 3, c8 = (tid & 7) * 8;
  const u32x4 a = *(const u32x4*)(src + (size_t)r * ld + c8);
  bf16_t* d = (bf16_t*)dst;
  d[(c8 + 0) * 72 + r] = (bf16_t)(a.x & 0xffffu); d[(c8 + 1) * 72 + r] = (bf16_t)(a.x >> 16);
  d[(c8 + 2) * 72 + r] = (bf16_t)(a.y & 0xffffu); d[(c8 + 3) * 72 + r] = (bf16_t)(a.y >> 16);
  d[(c8 + 4) * 72 + r] = (bf16_t)(a.z & 0xffffu); d[(c8 + 5) * 72 + r] = (bf16_t)(a.z >> 16);
  d[(c8 + 6) * 72 + r] = (bf16_t)(a.w & 0xffffu); d[(c8 + 7) * 72 + r] = (bf16_t)(a.w >> 16);
}
__device__ __forceinline__ void ml_local_unit2(const Params& p, int l, int unit, unsigned char* lds) {
  int tid_ = tidx(); asm volatile("" : "+v"(tid_)); const int tid = tid_, lane = tid & 63, wid = tid >> 6, r32 = lane & 31, hi = lane >> 5;
  unsigned char* KT = lds; unsigned char* VT = lds + 64 * MLP; float* WK = (float*)(lds + 2 * 64 * MLP);
  const bf16_t* PROJ = (const bf16_t*)(p.ws + WS_PROJ);
  const float* GT = (const float*)(p.ws + WS_GATES);
  float* UL = (float*)(p.ws + WS_ULOC); float* META = (float*)(p.ws + WS_MLMETA);
  const int b = unit / (4 * NCH), hh = (unit / NCH) & 3, ch = unit % NCH;
  const int row0 = b * SEGL + ch * 64;
  ml_stage_tr(PROJ + (size_t)row0 * PW + C_MK + hh * 64, PW, KT, tid);
  ml_stage_tr(PROJ + (size_t)row0 * PW + C_MV + hh * 64, PW, VT, tid);
  if (wid < 2) {
    const int dir = wid;
    const float ig = GT[(size_t)(row0 + lane) * 16 + (2 * dir) * 4 + hh];
    const float lf = logsigmoidf_(GT[(size_t)(row0 + lane) * 16 + (2 * dir + 1) * 4 + hh]);
    float ps = lf;
#pragma unroll
    for (int o = 1; o < 64; o <<= 1) { const float t = __shfl_up(ps, o); if (lane >= o) ps += t; }
    const float tot = __shfl(ps, 63);
    const float wlog = dir == 0 ? (tot - ps + ig) : (ps - lf + ig);
    const float mloc = wave_max(wlog);
    WK[dir * 64 + lane] = __expf(wlog - mloc);
    if (lane == 0) {
      const int seq = (b * 4 + hh) * 2 + dir, ci = ml_cidx(ch, dir);
      META[((size_t)seq * NCH + ci) * 4 + 0] = tot; META[((size_t)seq * NCH + ci) * 4 + 1] = mloc;
    }
  }
  __syncthreads();
  {
    const int dir = wid >> 2, et = (wid >> 1) & 1, dt = wid & 1;
    const int seq = (b * 4 + hh) * 2 + dir, ci = ml_cidx(ch, dir);
    float* slot = UL + ((size_t)seq * NCH + ci) * USTRIDE;
    f32x16 acc = {};
#pragma unroll
    for (int ks = 0; ks < 4; ++ks) {
      const int s0 = ks * 16 + hi * 8;
      const u32x4 va = *(const u32x4*)(VT + (et * 32 + r32) * MLP + s0 * 2);
      const bf16x8 kb = *(const bf16x8*)(KT + (dt * 32 + r32) * MLP + s0 * 2);
      const f32x4 w0 = *(const f32x4*)(WK + dir * 64 + s0), w1 = *(const f32x4*)(WK + dir * 64 + s0 + 4);
      u32x4 sa; sa.x = cvtpk(bflo(va.x) * w0.x, bfhi(va.x) * w0.y); sa.y = cvtpk(bflo(va.y) * w0.z, bfhi(va.y) * w0.w);
      sa.z = cvtpk(bflo(va.z) * w1.x, bfhi(va.z) * w1.y); sa.w = cvtpk(bflo(va.w) * w1.z, bfhi(va.w) * w1.w);
      acc = __builtin_amdgcn_mfma_f32_32x32x16_bf16(*(const bf16x8*)&sa, kb, acc, 0, 0, 0);
    }
#pragma unroll
    for (int r = 0; r < 16; ++r) slot[(et * 32 + crow(r, hi)) * 64 + dt * 32 + r32] = acc[r];
    if (et == 0) {
      float n = 0.f;
#pragma unroll
      for (int i = 0; i < 4; ++i) {
        const int s0 = hi * 32 + i * 8;
        const u32x4 ka = *(const u32x4*)(KT + (dt * 32 + r32) * MLP + s0 * 2);
        const f32x4 w0 = *(const f32x4*)(WK + dir * 64 + s0), w1 = *(const f32x4*)(WK + dir * 64 + s0 + 4);
        n += bflo(ka.x) * w0.x + bfhi(ka.x) * w0.y + bflo(ka.y) * w0.z + bfhi(ka.y) * w0.w + bflo(ka.z) * w1.x + bfhi(ka.z) * w1.y + bflo(ka.w) * w1.z + bfhi(ka.w) * w1.w;
      }
      n += __shfl_xor(n, 32);
      if (hi == 0) slot[4096 + dt * 32 + r32] = n;
    }
  }
  __syncthreads();
}
__device__ __forceinline__ void ml_scan(const Params& p, unsigned char* lds) {
  float* UL = (float*)(p.ws + WS_ULOC); float* META = (float*)(p.ws + WS_MLMETA);
  int tid_ = tidx(); asm volatile("" : "+v"(tid_));
  const int tid = tid_, lane = tid & 63, wid = tid >> 6;
  float* DEC = (float*)lds;
  float* SCL = DEC + 2 * NCH;
  float* TMP = SCL + 2 * NCH;
  for (int base0 = p.bx * 512; base0 < 32 * USTRIDE; base0 += p.gx * 512) {
    const int seq0 = base0 / USTRIDE;
    if (wid < 2) {
      const int seq = seq0 + wid;
      if (seq < 32) {
        float* mt = META + (size_t)seq * NCH * 4;
        for (int c = lane; c < NCH; c += 64) { TMP[(wid * 2 + 0) * NCH + c] = mt[c * 4 + 0]; TMP[(wid * 2 + 1) * NCH + c] = mt[c * 4 + 1]; }
        asm volatile("s_waitcnt lgkmcnt(0)" ::: "memory");
        if (lane == 0) {
          float m = 0.f;
          for (int c = 0; c < NCH; ++c) {
            const float bl = TMP[(wid * 2 + 0) * NCH + c], mloc = TMP[(wid * 2 + 1) * NCH + c];
            const float mn = fmaxf(bl + m, mloc);
            DEC[wid * NCH + c] = __expf(bl + m - mn); SCL[wid * NCH + c] = __expf(mloc - mn);
            mt[c * 4 + 2] = m;
            m = mn;
          }
        }
      }
    }
    __syncthreads();
    const int idx = base0 + tid;
    if (idx < 32 * USTRIDE) {
      const int seq = idx / USTRIDE, e = idx - seq * USTRIDE, sl = seq - seq0;
      float* bp = UL + (size_t)seq * NCH * USTRIDE + e;
      bf16_t* CSTp = (bf16_t*)(p.ws + WS_CST) + (size_t)seq * NCH * 4096 + (e < 4096 ? e : 0);
      float* NSTp = (float*)(p.ws + WS_NST) + (size_t)seq * NCH * 64 + (e < 4096 ? 0 : e - 4096);
      const float* dec = DEC + sl * NCH; const float* scl = SCL + sl * NCH;
      float C = 0.f;
#pragma unroll 1
      for (int c0 = 0; c0 < NCH; c0 += 12) {
        float u[12];
#pragma unroll
        for (int j = 0; j < 12; ++j) u[j] = bp[(size_t)(c0 + j) * USTRIDE];
#pragma unroll
        for (int j = 0; j < 12; ++j) {
          if (e < 4096) CSTp[(size_t)(c0 + j) * 4096] = (bf16_t)(cvtpk(C, 0.f) & 0xffffu); else NSTp[(size_t)(c0 + j) * 64] = C;
          C = dec[c0 + j] * C + scl[c0 + j] * u[j]; }
      }
    }
    __syncthreads();
  }
}
__device__ __forceinline__ void ml_out_unit(const Params& p, int l, int unit, unsigned char* lds) {
  int tid_ = tidx(); asm volatile("" : "+v"(tid_)); const int tid = tid_, lane = tid & 63, wid = tid >> 6, r32 = lane & 31, hi = lane >> 5;
  float* Qt = (float*)lds; float* Kt = Qt + 64 * 65; float* Vt = Kt + 64 * 65;
  float* Cs = Vt + 64 * 65;
  float* Ns = Cs + 2 * 64 * 65;
  float* Bq = Ns + 128;
  float* Gs = Bq + 128;
  float* Mi = Gs + 128;
  float* HB = Mi + 64;
  const bf16_t* PROJ = (const bf16_t*)(p.ws + WS_PROJ);
  const float* GT = (const float*)(p.ws + WS_GATES);
  const float* UL = (const float*)(p.ws + WS_ULOC); const float* META = (const float*)(p.ws + WS_MLMETA);
  bf16_t* MIX = (bf16_t*)(p.ws + WS_MIX);
  const int b = unit / (4 * NCH), hh = (unit / NCH) & 3, ch = unit % NCH;
  const int row0 = b * SEGL + ch * 64;
  ml_load_tile(PROJ + (size_t)row0 * PW + C_MQ + hh * 64, Qt, tid);
  ml_load_tile(PROJ + (size_t)row0 * PW + C_MK + hh * 64, Kt, tid);
  ml_load_tile(PROJ + (size_t)row0 * PW + C_MV + hh * 64, Vt, tid);
  for (int i = tid; i < 2 * USTRIDE; i += 512) {
    const int dir = i / USTRIDE, e = i - dir * USTRIDE;
    const int seq = (b * 4 + hh) * 2 + dir, ci = ml_cidx(ch, dir);
    const float v = UL[((size_t)seq * NCH + ci) * USTRIDE + e];
    if (e < 4096) Cs[dir * 64 * 65 + (e >> 6) * 65 + (e & 63)] = v; else Ns[dir * 64 + (e - 4096)] = v;
  }
  if (wid < 2) {
    const int dir = wid;
    const float ig = GT[(size_t)(row0 + lane) * 16 + (2 * dir) * 4 + hh];
    const float lf = logsigmoidf_(GT[(size_t)(row0 + lane) * 16 + (2 * dir + 1) * 4 + hh]);
    float ps = lf;
#pragma unroll
    for (int o = 1; o < 64; o <<= 1) { const float t = __shfl_up(ps, o); if (lane >= o) ps += t; }
    const float tot = __shfl(ps, 63);
    const float bc = dir == 0 ? ps : (tot - ps + lf);
    Bq[dir * 64 + lane] = bc; Gs[dir * 64 + lane] = ig - bc;
    if (lane == 0) { const int seq = (b * 4 + hh) * 2 + dir, ci = ml_cidx(ch, dir); Mi[dir] = META[((size_t)seq * NCH + ci) * 4 + 2]; }
  }
  __syncthreads();
  {
    const int dir = wid >> 2, tt = (wid >> 1) & 1, et = wid & 1;
    const int t = tt * 32 + r32;
    f32x16 sa[2] = {};
#pragma unroll 4
    for (int ks = 0; ks < 32; ++ks) {
      const float bq = Qt[t * 65 + 2 * ks + hi];
      const float a0 = Kt[(r32) * 65 + 2 * ks + hi], a1 = Kt[(32 + r32) * 65 + 2 * ks + hi];
      sa[0] = __builtin_amdgcn_mfma_f32_32x32x2f32(a0, bq, sa[0], 0, 0, 0);
      sa[1] = __builtin_amdgcn_mfma_f32_32x32x2f32(a1, bq, sa[1], 0, 0, 0);
    }
    const float bt = Bq[dir * 64 + t];
    const float inter = bt + Mi[dir];
    float mx = -INFINITY;
    f32x16 dl[2];
#pragma unroll
    for (int st = 0; st < 2; ++st)
#pragma unroll
      for (int r = 0; r < 16; ++r) {
        const int s = st * 32 + crow(r, hi);
        const bool ok = dir == 0 ? (s <= t) : (s >= t);
        const float d = ok ? bt + Gs[dir * 64 + s] : -INFINITY;
        dl[st][r] = d; mx = fmaxf(mx, d);
      }
    mx = fmaxf(mx, __shfl_xor(mx, 32));
    const float mt = fmaxf(inter, mx);
    const float iw = __expf(inter - mt);
    float rsum = 0.f;
#pragma unroll
    for (int st = 0; st < 2; ++st)
#pragma unroll
      for (int r = 0; r < 16; ++r) { const float w = __expf(dl[st][r] - mt); sa[st][r] *= w; rsum += sa[st][r]; }
    rsum += __shfl_xor(rsum, 32);
    float qn = 0.f;
#pragma unroll 8
    for (int i = 0; i < 32; ++i) { const int d = hi * 32 + i; qn += Ns[dir * 64 + d] * Qt[t * 65 + d]; }
    qn += __shfl_xor(qn, 32);
    const float den = rsum + iw * qn;
    const float rden = 1.f / fmaxf(fabsf(den), __expf(-mt));
    f32x16 an = {}, ac = {};
#pragma unroll
    for (int st = 0; st < 2; ++st)
#pragma unroll
      for (int r = 0; r < 16; ++r) {
        const float a = Vt[(st * 32 + crow(r, hi)) * 65 + et * 32 + r32];
        an = __builtin_amdgcn_mfma_f32_32x32x2f32(a, sa[st][r], an, 0, 0, 0);
      }
    const float* Cd = Cs + dir * 64 * 65;
#pragma unroll 4
    for (int ks = 0; ks < 32; ++ks) {
      const float a = Cd[(et * 32 + r32) * 65 + 2 * ks + hi];
      const float bq = Qt[t * 65 + 2 * ks + hi];
      ac = __builtin_amdgcn_mfma_f32_32x32x2f32(a, bq, ac, 0, 0, 0);
    }
#pragma unroll
    for (int r = 0; r < 16; ++r) HB[dir * 64 * 65 + t * 65 + et * 32 + crow(r, hi)] = (an[r] + iw * ac[r]) * rden;
  }
  __syncthreads();
  {
    const int t = tid >> 3, e8 = (tid & 7) * 8;
    float v[8]; float ss = 0.f;
#pragma unroll
    for (int i = 0; i < 8; ++i) { v[i] = HB[t * 65 + e8 + i] + HB[64 * 65 + t * 65 + e8 + i]; ss += v[i] * v[i]; }
    ss += __shfl_xor(ss, 1); ss += __shfl_xor(ss, 2); ss += __shfl_xor(ss, 4);
    const float rs = rsqrtf(ss * (1.f / 64.f) + EPS);
    const u32x4 ov = *(const u32x4*)(PROJ + (size_t)(row0 + t) * PW + C_MO + hh * 64 + e8);
    const float og[8] = {bflo(ov.x), bfhi(ov.x), bflo(ov.y), bfhi(ov.y), bflo(ov.z), bfhi(ov.z), bflo(ov.w), bfhi(ov.w)};
    const float* g = p.in[I_MNORMG] + l * 64 + e8;
    float o[8];
#pragma unroll
    for (int i = 0; i < 8; ++i) o[i] = (ABL & 2) ? 0.f : v[i] * rs * g[i] * sigmoidf_(og[i]);
    u32x4 w; w.x = cvtpk(o[0], o[1]); w.y = cvtpk(o[2], o[3]); w.z = cvtpk(o[4], o[5]); w.w = cvtpk(o[6], o[7]);
    *(u32x4*)(MIX + (size_t)(row0 + t) * DM + 256 + hh * 64 + e8) = w;
  }
  __syncthreads();
}


__device__ __forceinline__ void ml_out_unit2(const Params& p, int l, int unit, unsigned char* lds) {
  int tid_ = tidx(); asm volatile("" : "+v"(tid_)); const int tid = tid_, lane = tid & 63, wid = tid >> 6, r32 = lane & 31, hi = lane >> 5;
  unsigned char* Qs = lds; unsigned char* Ks = lds + 64 * MLP; unsigned char* VT = lds + 2 * 64 * MLP; unsigned char* Cs = lds + 3 * 64 * MLP;
  float* Ns = (float*)(lds + 5 * 64 * MLP);
  float* Bq = Ns + 128;
  float* Gs = Bq + 128;
  float* Mi = Gs + 128;
  float* HB = Mi + 64;
  const bf16_t* PROJ = (const bf16_t*)(p.ws + WS_PROJ);
  const float* GT = (const float*)(p.ws + WS_GATES);
  const bf16_t* CST = (const bf16_t*)(p.ws + WS_CST); const float* NST = (const float*)(p.ws + WS_NST); const float* META = (const float*)(p.ws + WS_MLMETA);
  bf16_t* MIX = (bf16_t*)(p.ws + WS_MIX);
  const int b = unit / (4 * NCH), hh = (unit / NCH) & 3, ch = unit % NCH;
  const int row0 = b * SEGL + ch * 64;
  ml_stage_rm(PROJ + (size_t)row0 * PW + C_MQ + hh * 64, PW, Qs, tid);
  ml_stage_rm(PROJ + (size_t)row0 * PW + C_MK + hh * 64, PW, Ks, tid);
  ml_stage_tr(PROJ + (size_t)row0 * PW + C_MV + hh * 64, PW, VT, tid);
#pragma unroll
  for (int dir = 0; dir < 2; ++dir) {
    const int seq = (b * 4 + hh) * 2 + dir, ci = ml_cidx(ch, dir);
    ml_stage_rm(CST + ((size_t)seq * NCH + ci) * 4096, 64, Cs + dir * 64 * MLP, tid);
    if (tid < 64) Ns[dir * 64 + tid] = NST[((size_t)seq * NCH + ci) * 64 + tid];
  }
  if (wid < 2) {
    const int dir = wid;
    const float ig = GT[(size_t)(row0 + lane) * 16 + (2 * dir) * 4 + hh];
    const float lf = logsigmoidf_(GT[(size_t)(row0 + lane) * 16 + (2 * dir + 1) * 4 + hh]);
    float ps = lf;
#pragma unroll
    for (int o = 1; o < 64; o <<= 1) { const float t = __shfl_up(ps, o); if (lane >= o) ps += t; }
    const float tot = __shfl(ps, 63);
    const float bc = dir == 0 ? ps : (tot - ps + lf);
    Bq[dir * 64 + lane] = bc; Gs[dir * 64 + lane] = ig - bc;
    if (lane == 0) { const int seq = (b * 4 + hh) * 2 + dir, ci = ml_cidx(ch, dir); Mi[dir] = META[((size_t)seq * NCH + ci) * 4 + 2]; }
  }
  __syncthreads();
  {
    const int dir = wid >> 2, tt = (wid >> 1) & 1, et = wid & 1;
    const int t = tt * 32 + r32;
    f32x16 sa[2] = {};
    bf16x8 bq[4];
#pragma unroll
    for (int ks = 0; ks < 4; ++ks) {
      bq[ks] = *(const bf16x8*)(Qs + t * MLP + (ks * 16 + hi * 8) * 2);
      const bf16x8 a0 = *(const bf16x8*)(Ks + r32 * MLP + (ks * 16 + hi * 8) * 2), a1 = *(const bf16x8*)(Ks + (32 + r32) * MLP + (ks * 16 + hi * 8) * 2);
      sa[0] = __builtin_amdgcn_mfma_f32_32x32x16_bf16(a0, bq[ks], sa[0], 0, 0, 0);
      sa[1] = __builtin_amdgcn_mfma_f32_32x32x16_bf16(a1, bq[ks], sa[1], 0, 0, 0);
    }
    const float bt = Bq[dir * 64 + t];
    const float inter = bt + Mi[dir];
    float mx = -INFINITY;
    f32x16 dl[2];
#pragma unroll
    for (int st = 0; st < 2; ++st)
#pragma unroll
      for (int r = 0; r < 16; ++r) {
        const int s = st * 32 + crow(r, hi);
        const bool ok = dir == 0 ? (s <= t) : (s >= t);
        const float d = ok ? bt + Gs[dir * 64 + s] : -INFINITY;
        dl[st][r] = d; mx = fmaxf(mx, d);
      }
    mx = fmaxf(mx, __shfl_xor(mx, 32));
    const float mt = fmaxf(inter, mx);
    const float iw = __expf(inter - mt);
    float rsum = 0.f;
#pragma unroll
    for (int st = 0; st < 2; ++st)
#pragma unroll
      for (int r = 0; r < 16; ++r) { const float w = __expf(dl[st][r] - mt); sa[st][r] *= w; rsum += sa[st][r]; }
    rsum += __shfl_xor(rsum, 32);
    float qn = 0.f;
#pragma unroll
    for (int i = 0; i < 4; ++i) {
      const int d0 = hi * 32 + i * 8;
      const u32x4 qa = *(const u32x4*)(Qs + t * MLP + d0 * 2);
      const f32x4 n0 = *(const f32x4*)(Ns + dir * 64 + d0), n1 = *(const f32x4*)(Ns + dir * 64 + d0 + 4);
      qn += bflo(qa.x) * n0.x + bfhi(qa.x) * n0.y + bflo(qa.y) * n0.z + bfhi(qa.y) * n0.w + bflo(qa.z) * n1.x + bfhi(qa.z) * n1.y + bflo(qa.w) * n1.z + bfhi(qa.w) * n1.w;
    }
    qn += __shfl_xor(qn, 32);
    const float den = rsum + iw * qn;
    const float rden = 1.f / fmaxf(fabsf(den), __expf(-mt));
    f32x16 an = {}, ac = {};
#pragma unroll
    for (int st = 0; st < 2; ++st)
#pragma unroll
      for (int k2 = 0; k2 < 2; ++k2) {
        u32x4 bx; bx.x = cvtpk(sa[st][8 * k2 + 0], sa[st][8 * k2 + 1]); bx.y = cvtpk(sa[st][8 * k2 + 2], sa[st][8 * k2 + 3]);
        bx.z = cvtpk(sa[st][8 * k2 + 4], sa[st][8 * k2 + 5]); bx.w = cvtpk(sa[st][8 * k2 + 6], sa[st][8 * k2 + 7]);
        const unsigned char* vrow = VT + (et * 32 + r32) * MLP + (st * 32 + 16 * k2 + 4 * hi) * 2;
        const u32x2 v0 = *(const u32x2*)vrow, v1 = *(const u32x2*)(vrow + 16);
        u32x4 ax; ax.x = v0.x; ax.y = v0.y; ax.z = v1.x; ax.w = v1.y;
        an = __builtin_amdgcn_mfma_f32_32x32x16_bf16(*(const bf16x8*)&ax, *(const bf16x8*)&bx, an, 0, 0, 0);
      }
    const unsigned char* Cd = Cs + dir * 64 * MLP;
#pragma unroll
    for (int ks = 0; ks < 4; ++ks) {
      const bf16x8 a = *(const bf16x8*)(Cd + (et * 32 + r32) * MLP + (ks * 16 + hi * 8) * 2);
      ac = __builtin_amdgcn_mfma_f32_32x32x16_bf16(a, bq[ks], ac, 0, 0, 0);
    }
#pragma unroll
    for (int r = 0; r < 16; ++r) HB[dir * 64 * 65 + t * 65 + et * 32 + crow(r, hi)] = (an[r] + iw * ac[r]) * rden;
  }
  __syncthreads();
  {
    const int t = tid >> 3, e8 = (tid & 7) * 8;
    float v[8]; float ss = 0.f;
#pragma unroll
    for (int i = 0; i < 8; ++i) { v[i] = HB[t * 65 + e8 + i] + HB[64 * 65 + t * 65 + e8 + i]; ss += v[i] * v[i]; }
    ss += __shfl_xor(ss, 1); ss += __shfl_xor(ss, 2); ss += __shfl_xor(ss, 4);
    const float rs = rsqrtf(ss * (1.f / 64.f) + EPS);
    const u32x4 ov = *(const u32x4*)(PROJ + (size_t)(row0 + t) * PW + C_MO + hh * 64 + e8);
    const float og[8] = {bflo(ov.x), bfhi(ov.x), bflo(ov.y), bfhi(ov.y), bflo(ov.z), bfhi(ov.z), bflo(ov.w), bfhi(ov.w)};
    const float* g = p.in[I_MNORMG] + l * 64 + e8;
    float o[8];
#pragma unroll
    for (int i = 0; i < 8; ++i) o[i] = (ABL & 2) ? 0.f : v[i] * rs * g[i] * sigmoidf_(og[i]);
    u32x4 w; w.x = cvtpk(o[0], o[1]); w.y = cvtpk(o[2], o[3]); w.z = cvtpk(o[4], o[5]); w.w = cvtpk(o[6], o[7]);
    *(u32x4*)(MIX + (size_t)(row0 + t) * DM + 256 + hh * 64 + e8) = w;
  }
  __syncthreads();
}

#define KSWZ(row, colB) ((row) * 256 + ((colB) ^ (((row) & 15) << 4)))
#define SBAR() __builtin_amdgcn_sched_barrier(0)
constexpr int ATT_SHM_V = 128 * 80, ATT_SHM_K = 64 * 128 * 2;
constexpr float ATT_THR = 8.0f;
__device__ __forceinline__ int v_st(int k, int c) { const int kk = (k & ~0xC) | ((k & 4) << 1) | ((k & 8) >> 1); return ((kk >> 3) * 4 + (c >> 5)) * 512 + ((kk & 7) * 32 + (c & 31)) * 2; }
__device__ __forceinline__ int v_rd_base(int lane) { return ((lane & 3) << 3) | (((lane >> 2) & 3) << 6) | (((lane >> 4) & 1) << 5) | (((lane >> 5) & 1) << 8); }
constexpr int v_rd_off(int d0, int ks, int half) { return d0 * 512 + ks * 4096 + half * 2048; }
template <int OFF> __device__ __forceinline__ s16x4 tr_read(int vb) {
  s16x4 r; asm volatile("ds_read_b64_tr_b16 %0, %1 offset:%2" : "=&v"(r) : "v"(vb), "i"(OFF) : "memory"); return r;
}
template <int D0> __device__ __forceinline__ void pv_one(f32x16& od, int vb, bf16x8 pa0, bf16x8 pa1, bf16x8 pa2, bf16x8 pa3) {
  const s16x4 l0 = tr_read<v_rd_off(D0, 0, 0)>(vb), h0 = tr_read<v_rd_off(D0, 0, 1)>(vb), l1 = tr_read<v_rd_off(D0, 1, 0)>(vb), h1 = tr_read<v_rd_off(D0, 1, 1)>(vb);
  const s16x4 l2 = tr_read<v_rd_off(D0, 2, 0)>(vb), h2 = tr_read<v_rd_off(D0, 2, 1)>(vb), l3 = tr_read<v_rd_off(D0, 3, 0)>(vb), h3 = tr_read<v_rd_off(D0, 3, 1)>(vb);
  asm volatile("s_waitcnt lgkmcnt(0)" ::: "memory"); SBAR();
#define PK(L, H) (bf16x8){L[0], L[1], L[2], L[3], H[0], H[1], H[2], H[3]}
  od = __builtin_amdgcn_mfma_f32_32x32x16_bf16(pa0, PK(l0, h0), od, 0, 0, 0);
  od = __builtin_amdgcn_mfma_f32_32x32x16_bf16(pa1, PK(l1, h1), od, 0, 0, 0);
  od = __builtin_amdgcn_mfma_f32_32x32x16_bf16(pa2, PK(l2, h2), od, 0, 0, 0);
  od = __builtin_amdgcn_mfma_f32_32x32x16_bf16(pa3, PK(l3, h3), od, 0, 0, 0);
#undef PK
}
template <int D0> __device__ __forceinline__ void pv_two(f32x16& oa, f32x16& ob, int vb, bf16x8 a0, bf16x8 a1, bf16x8 a2, bf16x8 a3, bf16x8 b0, bf16x8 b1, bf16x8 b2, bf16x8 b3) {
  const s16x4 l0 = tr_read<v_rd_off(D0, 0, 0)>(vb), h0 = tr_read<v_rd_off(D0, 0, 1)>(vb), l1 = tr_read<v_rd_off(D0, 1, 0)>(vb), h1 = tr_read<v_rd_off(D0, 1, 1)>(vb);
  const s16x4 l2 = tr_read<v_rd_off(D0, 2, 0)>(vb), h2 = tr_read<v_rd_off(D0, 2, 1)>(vb), l3 = tr_read<v_rd_off(D0, 3, 0)>(vb), h3 = tr_read<v_rd_off(D0, 3, 1)>(vb);
  asm volatile("s_waitcnt lgkmcnt(0)" ::: "memory"); SBAR();
#define PK(L, H) (bf16x8){L[0], L[1], L[2], L[3], H[0], H[1], H[2], H[3]}
  const bf16x8 v0 = PK(l0, h0), v1 = PK(l1, h1), v2 = PK(l2, h2), v3 = PK(l3, h3);
  oa = __builtin_amdgcn_mfma_f32_32x32x16_bf16(a0, v0, oa, 0, 0, 0);
  ob = __builtin_amdgcn_mfma_f32_32x32x16_bf16(b0, v0, ob, 0, 0, 0);
  oa = __builtin_amdgcn_mfma_f32_32x32x16_bf16(a1, v1, oa, 0, 0, 0);
  ob = __builtin_amdgcn_mfma_f32_32x32x16_bf16(b1, v1, ob, 0, 0, 0);
  oa = __builtin_amdgcn_mfma_f32_32x32x16_bf16(a2, v2, oa, 0, 0, 0);
  ob = __builtin_amdgcn_mfma_f32_32x32x16_bf16(b2, v2, ob, 0, 0, 0);
  oa = __builtin_amdgcn_mfma_f32_32x32x16_bf16(a3, v3, oa, 0, 0, 0);
  ob = __builtin_amdgcn_mfma_f32_32x32x16_bf16(b3, v3, ob, 0, 0, 0);
#undef PK
}
struct KQFrag { bf16x8 b0, b1, q; };
__device__ __forceinline__ void att_ldkq(KQFrag& f, const LAS unsigned char* l3, int ak, int kofs, int qofs) {
  const LAS unsigned char* kp = l3 + (ak + kofs);
  f.b0 = *(const LAS bf16x8*)kp; f.b1 = *(const LAS bf16x8*)(kp + 8192); f.q = *(const LAS bf16x8*)(l3 + (ak + qofs));
}
#define ATT_MF(pa_, pb_, f_) do { pa_ = __builtin_amdgcn_mfma_f32_32x32x16_bf16(f_.b0, f_.q, pa_, 0, 0, 0); pb_ = __builtin_amdgcn_mfma_f32_32x32x16_bf16(f_.b1, f_.q, pb_, 0, 0, 0); } while (0)
__device__ __forceinline__ void att_qk_all(f32x16& p0, f32x16& p1, f32x16& q0, f32x16& q1, KQFrag& f0, const LAS unsigned char* l3, int ak0, int kofs, int qofs, float ia, float ib) {
  KQFrag f1;
#pragma unroll
  for (int r = 0; r < 16; ++r) { p0[r] = ia; p1[r] = ia; q0[r] = ib; q1[r] = ib; }
  att_ldkq(f1, l3, ak0 ^ (1 << 5), kofs, qofs); ATT_MF(p0, p1, f0); SBAR();
  att_ldkq(f0, l3, ak0 ^ (2 << 5), kofs, qofs); ATT_MF(p0, p1, f1); SBAR();
  att_ldkq(f1, l3, ak0 ^ (3 << 5), kofs, qofs); ATT_MF(p0, p1, f0); SBAR();
  att_ldkq(f0, l3, ak0 ^ (4 << 5), kofs, qofs); ATT_MF(p0, p1, f1); SBAR();
  att_ldkq(f1, l3, ak0 ^ (5 << 5), kofs, qofs); ATT_MF(q0, q1, f0); SBAR();
  att_ldkq(f0, l3, ak0 ^ (6 << 5), kofs, qofs); ATT_MF(q0, q1, f1); SBAR();
  att_ldkq(f1, l3, ak0 ^ (7 << 5), kofs, qofs); ATT_MF(q0, q1, f0); SBAR();
  ATT_MF(q0, q1, f1); SBAR();
}
__device__ __forceinline__ void att_softmax(f32x16& p0, f32x16& p1, float& m_reg, float& l_reg, float& alpha, bool first, i32x8& pa) {
  alpha = 1.f;
  if (first) {
    float pmax = p0[0];
#pragma unroll
    for (int r = 1; r < 16; ++r) pmax = fmaxf(pmax, p0[r]);
#pragma unroll
    for (int r = 0; r < 16; ++r) pmax = fmaxf(pmax, p1[r]);
    { auto rr = __builtin_amdgcn_permlane32_swap(__float_as_uint(pmax), __float_as_uint(pmax), false, false);
      pmax = fmaxf(__uint_as_float(rr[0]), __uint_as_float(rr[1])); }
    alpha = 0.f; m_reg = pmax;
#pragma unroll
    for (int r = 0; r < 16; ++r) { p0[r] -= pmax; p1[r] -= pmax; }
  }
#pragma unroll
  for (int r = 0; r < 16; ++r) { p0[r] = __builtin_amdgcn_exp2f(p0[r]); p1[r] = __builtin_amdgcn_exp2f(p1[r]); }
  float ps;
  {
    f32x2 s0 = __builtin_shufflevector(p0, p0, 0, 1) + __builtin_shufflevector(p0, p0, 2, 3), s1 = __builtin_shufflevector(p0, p0, 4, 5) + __builtin_shufflevector(p0, p0, 6, 7);
    f32x2 s2 = __builtin_shufflevector(p1, p1, 0, 1) + __builtin_shufflevector(p1, p1, 2, 3), s3 = __builtin_shufflevector(p1, p1, 4, 5) + __builtin_shufflevector(p1, p1, 6, 7);
    s0 += __builtin_shufflevector(p0, p0, 8, 9); s1 += __builtin_shufflevector(p0, p0, 10, 11); s2 += __builtin_shufflevector(p1, p1, 8, 9); s3 += __builtin_shufflevector(p1, p1, 10, 11);
    s0 += __builtin_shufflevector(p0, p0, 12, 13); s1 += __builtin_shufflevector(p0, p0, 14, 15); s2 += __builtin_shufflevector(p1, p1, 12, 13); s3 += __builtin_shufflevector(p1, p1, 14, 15);
    s0 += s1; s2 += s3; s0 += s2;
    ps = s0.x + s0.y;
  }
  { auto rr = __builtin_amdgcn_permlane32_swap(__float_as_uint(ps), __float_as_uint(ps), false, false);
    ps = __uint_as_float(rr[0]) + __uint_as_float(rr[1]); }
  if (__builtin_expect(!first && __any(ps > 256.f), 0)) {
    float emax = p0[0];
#pragma unroll
    for (int r = 1; r < 16; ++r) emax = fmaxf(emax, p0[r]);
#pragma unroll
    for (int r = 0; r < 16; ++r) emax = fmaxf(emax, p1[r]);
    { auto rr = __builtin_amdgcn_permlane32_swap(__float_as_uint(emax), __float_as_uint(emax), false, false);
      emax = fmaxf(__uint_as_float(rr[0]), __uint_as_float(rr[1])); }
    const float delta = fmaxf(__builtin_amdgcn_logf(emax), 0.f);
    alpha = __builtin_amdgcn_exp2f(-delta); m_reg += delta;
#pragma unroll
    for (int r = 0; r < 16; ++r) { p0[r] *= alpha; p1[r] *= alpha; }
    ps *= alpha;
  }
  l_reg = l_reg * alpha + ps;
#pragma unroll
  for (int v = 0; v < 4; ++v) {
    int w0, w1; asm volatile("" : "=v"(w0), "=v"(w1));
    w0 = __builtin_amdgcn_cvt_pk_fp8_f32(p0[4 * v], p0[4 * v + 1], w0, false); w0 = __builtin_amdgcn_cvt_pk_fp8_f32(p0[4 * v + 2], p0[4 * v + 3], w0, true);
    w1 = __builtin_amdgcn_cvt_pk_fp8_f32(p1[4 * v], p1[4 * v + 1], w1, false); w1 = __builtin_amdgcn_cvt_pk_fp8_f32(p1[4 * v + 2], p1[4 * v + 3], w1, true);
    pa[v] = w0; pa[4 + v] = w1;
  }
}
__device__ __forceinline__ void att_unit(const bf16_t* __restrict__ Qb, const bf16_t* __restrict__ Kh, const unsigned char* __restrict__ V8, bf16_t* __restrict__ Ob,
                                         int nkeys, float lam, const float* __restrict__ ng, float oscale, unsigned char* lds) {
  int tid_ = tidx(); asm volatile("" : "+v"(tid_)); const int tid = tid_, wid = tid >> 6, lane = tid & 63, r32 = lane & 31, hi = lane >> 5;
  const int grp = __builtin_amdgcn_readfirstlane(wid >> 2);
  unsigned char* V_lds = lds; unsigned char* K_lds = lds + 2 * ATT_SHM_V;
  float* wsl = (float*)(lds + 2 * ATT_SHM_V + 2 * ATT_SHM_K) + wid * 64; float* li_l = wsl; float* al_l = wsl + 32;
  float m0 = 0.f, l0 = 0.f, m1 = 0.f, l1 = 0.f;
  f32x16 o0[4] = {}, o1[4] = {};
  unsigned char* Q_lds = lds + 2 * ATT_SHM_V + 2 * ATT_SHM_K + 2048;
#pragma unroll
  for (int i = 0; i < 8; ++i) { const int id = tid + 512 * i, qrw = id >> 4, ch = id & 15;
    *(bf16x8*)(Q_lds + KSWZ(qrw, ch * 16)) = *(const bf16x8*)(Qb + (size_t)qrw * PW + ch * 8); }
  const int qrow = wid * 32 + r32;
  int kso[2];
#pragma unroll
  for (int i = 0; i < 2; ++i) {
    const int o16 = tid + 512 * i;
    { const int row = o16 >> 4, cs = (o16 & 15) ^ (row & 15); kso[i] = row * PW + cs * 8; }
  }
  const unsigned ldsw = (unsigned)__builtin_amdgcn_readfirstlane(wid) * 1024u;
#define GSTAGE_K(b, k0) do { _Pragma("unroll") for (int i_ = 0; i_ < 2; ++i_) \
    __builtin_amdgcn_global_load_lds((const unsigned*)(Kh + (size_t)(k0) * PW + kso[i_]), (LAS unsigned*)(K_lds + (b) * ATT_SHM_K + ldsw + i_ * 8192), 16, 0, 0); } while (0)
#define GSTAGE_V(b, k0) do { const unsigned char* vi_ = V8 + (size_t)((k0) >> 6) * ATT_SHM_V + tid * 16; \
      __builtin_amdgcn_global_load_lds((const unsigned*)vi_, (LAS unsigned*)(V_lds + (b) * ATT_SHM_V + ldsw), 16, 0, 0); \
      if (wid < 2) __builtin_amdgcn_global_load_lds((const unsigned*)(vi_ + 8192), (LAS unsigned*)(V_lds + (b) * ATT_SHM_V + 8192 + ldsw), 16, 0, 0); } while (0)
#define STAGE_PAIR(jj) do { GSTAGE_V((jj) & 1, (jj) * 64); if ((jj) + 1 < NT) GSTAGE_K((jj) & 1, ((jj) + 1) * 64); } while (0)
#define RESC(o, a) do { if (__any((a) < 1.f)) { if (hi == 0) al_l[r32] = (a); asm volatile("s_waitcnt lgkmcnt(0)" ::: "memory"); \
    _Pragma("unroll") for (int d = 0; d < 4; ++d) _Pragma("unroll") for (int r = 0; r < 16; ++r) o[d][r] *= al_l[crow(r, hi)]; } } while (0)
#define ATT_BAR() do { asm volatile("s_waitcnt lgkmcnt(0)" ::: "memory"); __builtin_amdgcn_s_barrier(); asm volatile("" ::: "memory"); } while (0)
  const int NT = nkeys / 64;
  GSTAGE_K(1, 0); STAGE_PAIR(0);
  asm volatile("s_waitcnt vmcnt(0)" ::: "memory"); __syncthreads();
  f32x16 p0, p1, q0, q1; i32x8 pa, pb;
  const LAS unsigned char* l3 = (const LAS unsigned char*)lds;
  const int ak0 = r32 * 256 + ((hi * 16) ^ ((r32 & 15) << 4));
  const int kofs0 = 2 * ATT_SHM_V, qofs0 = 2 * ATT_SHM_V + 2 * ATT_SHM_K + 2048 + __builtin_amdgcn_readfirstlane(wid) * 8192;
  { KQFrag f0; att_ldkq(f0, l3, ak0, kofs0 + ATT_SHM_K, qofs0);
    att_qk_all(p0, p1, q0, q1, f0, l3, ak0, kofs0 + ATT_SHM_K, qofs0, 0.f, 0.f); }
  if (grp) ATT_BAR();
#pragma unroll 1
  for (int j = 0; j < NT; ++j) {
    const int cur = j & 1;
    const bool more = (j + 1 < NT);
    if (grp && more) STAGE_PAIR(j + 1);
    { float alphaA, alphaB;
      const bool first = (j == 0);
      att_softmax(p0, p1, m0, l0, alphaA, first, pa); SBAR();
      att_softmax(q0, q1, m1, l1, alphaB, first, pb); SBAR();
      RESC(o0, alphaA);
      RESC(o1, alphaB); }
    asm volatile("" : "+v"(pa), "+v"(pb), "+v"(m0), "+v"(l0), "+v"(m1), "+v"(l1));
    asm volatile("" : "+v"(o0[0]), "+v"(o0[1]), "+v"(o0[2]), "+v"(o0[3]), "+v"(o1[0]), "+v"(o1[1]), "+v"(o1[2]), "+v"(o1[3]));
    if (!grp) asm volatile("s_waitcnt vmcnt(0)" ::: "memory");
    ATT_BAR();
    if (!grp && more) STAGE_PAIR(j + 1);
    __builtin_amdgcn_s_setprio(1);
    {
      int kofs = kofs0 + cur * ATT_SHM_K, qofs = qofs0, ak = ak0; asm volatile("" : "+s"(kofs), "+s"(qofs), "+v"(ak));
      const LAS unsigned char* vrow = l3 + (r32 * 80 + hi * 32 + cur * ATT_SHM_V);
      u32x4 va0 = *(const LAS u32x4*)vrow, va1 = *(const LAS u32x4*)(vrow + 16), vb0, vb1;
      KQFrag f0;
#define ATT_PV(d0_, x0_, x1_) do { i32x8 bv; bv[0] = (int)x0_.x; bv[1] = (int)x0_.y; bv[2] = (int)x0_.z; bv[3] = (int)x0_.w; bv[4] = (int)x1_.x; bv[5] = (int)x1_.y; bv[6] = (int)x1_.z; bv[7] = (int)x1_.w; \
        o0[d0_] = __builtin_amdgcn_mfma_scale_f32_32x32x64_f8f6f4(pa, bv, o0[d0_], 0, 0, 0, 0x7F7F7F7F, 0, 0x7F7F7F7F); \
        o1[d0_] = __builtin_amdgcn_mfma_scale_f32_32x32x64_f8f6f4(pb, bv, o1[d0_], 0, 0, 0, 0x7F7F7F7F, 0, 0x7F7F7F7F); } while (0)
      vb0 = *(const LAS u32x4*)(vrow + 32 * 80); vb1 = *(const LAS u32x4*)(vrow + 32 * 80 + 16); ATT_PV(0, va0, va1); SBAR();
      va0 = *(const LAS u32x4*)(vrow + 64 * 80); va1 = *(const LAS u32x4*)(vrow + 64 * 80 + 16); ATT_PV(1, vb0, vb1); SBAR();
      vb0 = *(const LAS u32x4*)(vrow + 96 * 80); vb1 = *(const LAS u32x4*)(vrow + 96 * 80 + 16); ATT_PV(2, va0, va1); SBAR();
      att_ldkq(f0, l3, ak, kofs, qofs);
      ATT_PV(3, vb0, vb1); SBAR();
#undef ATT_PV
      asm volatile("" : "+v"(o0[0]), "+v"(o0[1]), "+v"(o0[2]), "+v"(o0[3]), "+v"(o1[0]), "+v"(o1[1]), "+v"(o1[2]), "+v"(o1[3]));
      att_qk_all(p0, p1, q0, q1, f0, l3, ak, kofs, qofs, -m0, -m1);
      asm volatile("" : "+v"(p0), "+v"(p1), "+v"(q0), "+v"(q1));
    }
    __builtin_amdgcn_s_setprio(0);
    if (grp) asm volatile("s_waitcnt vmcnt(0)" ::: "memory");
    ATT_BAR();
  }
  if (!grp) ATT_BAR();
  if (hi == 0) { li_l[r32] = 1.f / l0; al_l[r32] = lam / l1; }
  asm volatile("s_waitcnt lgkmcnt(0)" ::: "memory");
  float ss[16];
#pragma unroll
  for (int r = 0; r < 16; ++r) {
    const float a = li_l[crow(r, hi)], bq = al_l[crow(r, hi)];
    float s = 0.f;
#pragma unroll
    for (int d = 0; d < 4; ++d) { const float v = o0[d][r] * a - o1[d][r] * bq; o0[d][r] = v; s += v * v; }
    s += __shfl_xor(s, 1); s += __shfl_xor(s, 2); s += __shfl_xor(s, 4); s += __shfl_xor(s, 8); s += __shfl_xor(s, 16);
    ss[r] = rsqrtf(s * (1.f / 128.f) + EPS) * oscale;
  }
  bf16_t* Ow = Ob + (size_t)(wid * 32) * DM;
#pragma unroll
  for (int d = 0; d < 4; ++d) {
    const float g = ng[d * 32 + r32];
#pragma unroll
    for (int r = 0; r < 16; ++r) Ow[(size_t)crow(r, hi) * DM + d * 32 + r32] = (ABL & 4) ? (bf16_t)0 : (bf16_t)(cvtpk(o0[d][r] * ss[r] * g, 0.f) & 0xffffu);
  }
  __syncthreads();
#undef GSTAGE_K
#undef GSTAGE_V
#undef STAGE_PAIR
#undef RESC
#undef ATT_BAR
}

__device__ __forceinline__ float ins16(float (&a)[16], float x) {
#pragma unroll
  for (int i = 0; i < 16; ++i) { const float h = fmaxf(a[i], x); x = fminf(a[i], x); a[i] = h; }
  return x;
}
__device__ __forceinline__ void bsort16(float (&a)[16]) {
#pragma unroll
  for (int k = 2; k <= 16; k <<= 1)
#pragma unroll
    for (int j = k >> 1; j > 0; j >>= 1)
#pragma unroll
      for (int i = 0; i < 16; ++i) {
        const int q = i ^ j;
        if (q > i) {
          const bool desc = ((i & k) == 0);
          const float hi_ = fmaxf(a[i], a[q]), lo_ = fminf(a[i], a[q]);
          a[i] = desc ? hi_ : lo_; a[q] = desc ? lo_ : hi_;
        }
      }
}
__device__ __forceinline__ void bmerge16(float (&a)[16], const float (&b)[16]) {
#pragma unroll
  for (int i = 0; i < 16; ++i) a[i] = fmaxf(a[i], b[15 - i]);
#pragma unroll
  for (int j = 8; j > 0; j >>= 1)
#pragma unroll
    for (int i = 0; i < 16; ++i) {
      const int q = i ^ j;
      if (q > i) { const float hi_ = fmaxf(a[i], a[q]), lo_ = fminf(a[i], a[q]); a[i] = hi_; a[q] = lo_; }
    }
}
__device__ __forceinline__ float gelu_erf(float x) { return 0.5f * x * (1.f + erff(x * 0.70710678118654752440f)); }
#define XB_TMO      128
#define XB_XCNT(j)  (256  + 64 * (j))
#define XB_XSUB(j)  (1280 + 64 * (j))
#define XB_XGEN(j)  (2304 + 64 * (j))
#define XB_TOP      3328
#define XB_TOPGEN   3392
#define XCD_BAR_WORDS 3456
#define XB_SPIN_CAP (1u << 22)
__device__ __forceinline__ unsigned xb_ld(unsigned* p)              { return __hip_atomic_load(p, __ATOMIC_RELAXED, __HIP_MEMORY_SCOPE_AGENT); }
__device__ __forceinline__ unsigned xb_add(unsigned* p, unsigned v) { return __hip_atomic_fetch_add(p, v, __ATOMIC_RELAXED, __HIP_MEMORY_SCOPE_AGENT); }
__device__ __forceinline__ unsigned xb_xcc_id() { return (unsigned)__builtin_amdgcn_s_getreg((3 << 11) | 20) & 0xFu; }
#define XB_SPIN(cond, bar) do { unsigned _sp = 0; while (cond) { __builtin_amdgcn_s_sleep(1); \
    if ((++_sp & 255u) == 0u) { if (xb_ld(&(bar)[XB_TMO])) break; if (_sp > XB_SPIN_CAP) { atomicAdd(&(bar)[XB_TMO], 1u); break; } } } } while (0)
struct XcdBarrier { unsigned* bar; unsigned x; volatile LAS unsigned* st; };
__device__ __forceinline__ XcdBarrier xcd_barrier_post(unsigned* bar, volatile LAS unsigned* st) {
  XcdBarrier b; b.bar = bar; b.x = xb_xcc_id(); b.st = st;
  if (tidx() == 0) (void)xb_add(&bar[XB_XCNT(b.x)], 1u);
  return b;
}
__device__ __forceinline__ void xcd_barrier_complete(unsigned* bar, unsigned x, unsigned& nloc, unsigned& nx) {
  const unsigned G = gridDim.x * gridDim.y * gridDim.z;
  unsigned sum, cnt, mine, sp = 0u;
  for (;;) {
    sum = 0u; cnt = 0u; mine = 0u;
#pragma unroll
    for (unsigned j = 0; j < 16; ++j) { const unsigned c = xb_ld(&bar[XB_XCNT(j)]); sum += c; cnt += (c > 0u) ? 1u : 0u; mine = (j == x) ? c : mine; }
    if (sum == G) break;
    __builtin_amdgcn_s_sleep(1);
    if ((++sp & 255u) == 0u) { if (xb_ld(&bar[XB_TMO])) break; if (sp > XB_SPIN_CAP) { atomicAdd(&bar[XB_TMO], 1u); break; } }
  }
  nloc = mine > 0u ? mine : 1u; nx = cnt > 0u ? cnt : 1u;
}
__device__ __forceinline__ void xcd_barrier(const XcdBarrier& b) {
  asm volatile("s_waitcnt vmcnt(0)" ::: "memory");
  __syncthreads();
  if (tidx() == 0) {
    unsigned* bar = b.bar;
    __builtin_amdgcn_s_waitcnt(0);
    unsigned nloc = b.st[0], nx = b.st[1];
    if (nloc == 0u) { xcd_barrier_complete(bar, b.x, nloc, nx); b.st[0] = nloc; b.st[1] = nx; }
    const unsigned old = xb_add(&bar[XB_XSUB(b.x)], 1u);
    const unsigned gen = old / nloc;
    if (old + 1u == (gen + 1u) * nloc) {
      __builtin_amdgcn_fence(__ATOMIC_RELEASE, "agent");
      asm volatile("s_waitcnt vmcnt(0)" ::: "memory");
      const unsigned og = xb_add(&bar[XB_TOP], 1u);
      const unsigned tg = og / nx;
      if (og + 1u == (tg + 1u) * nx) xb_add(&bar[XB_TOPGEN], 1u);
      else XB_SPIN(xb_ld(&bar[XB_TOPGEN]) == tg, bar);
      __builtin_amdgcn_fence(__ATOMIC_ACQUIRE, "agent");
      xb_add(&bar[XB_XGEN(b.x)], 1u);
      asm volatile("s_waitcnt vmcnt(0)" ::: "memory");
    } else {
      XB_SPIN(xb_ld(&bar[XB_XGEN(b.x)]) == gen, bar);
      __builtin_amdgcn_fence(__ATOMIC_ACQUIRE, "agent");
      asm volatile("s_waitcnt vmcnt(0)" ::: "memory");
    }
  }
  __syncthreads();
}

constexpr size_t RT_STRIDE = (size_t)T * 128 * 4;
__device__ __forceinline__ void route_unit(const Params& p, int l, int unit, unsigned char* lds) {
  int tid_ = tidx(); asm volatile("" : "+v"(tid_)); const int tid = tid_, lane = tid & 63, wid = tid >> 6, r32 = lane & 31, hi = lane >> 5;
  unsigned char* IDX = lds;
  int* UE = (int*)(lds + 8192); float* UG = (float*)(lds + 8192 + 16384); float* US = (float*)(lds + 8192 + 32768);
  int* EIDG = (int*)(p.ws + WS_EID + (size_t)l * RT_STRIDE); float* GWG = (float*)(p.ws + WS_ULOC + RT_STRIDE); float* SUG = (float*)(p.ws + WS_ULOC + 2 * RT_STRIDE);
  const float* PSC = (const float*)(p.ws + WS_PSC);
  const int row0 = unit * 32;
  const bf16_t* QP = (const bf16_t*)(p.ws + WS_PROJ);
  const bf16_t* KEYS = (const bf16_t*)(p.ws + WS_KEYS) + (size_t)l * 131072;
  for (int rrep = 0; rrep < REP_ROUTE; ++rrep) {
    const int h = wid;
    float top[2][16];
#pragma unroll
    for (int pp = 0; pp < 2; ++pp) {
      const bf16_t* qrow = QP + (size_t)(row0 + r32) * DM + h * 128 + pp * 64 + hi * 8;
      const bf16_t* kb = KEYS + ((size_t)(h * 2 + pp) * 128 + r32) * 64 + hi * 8;
      bf16x8 bq[4];
#pragma unroll
      for (int ks = 0; ks < 4; ++ks) bq[ks] = *(const bf16x8*)(qrow + ks * 16);
      float (&lst)[16] = top[pp];
#pragma unroll
      for (int i = 0; i < 16; ++i) lst[i] = -INFINITY;
#pragma unroll
      for (int nt = 0; nt < 4; ++nt) {
        f32x16 acc = {};
#pragma unroll
        for (int ks = 0; ks < 4; ++ks) {
          const bf16x8 ak = *(const bf16x8*)(kb + (size_t)nt * 32 * 64 + ks * 16);
          acc = __builtin_amdgcn_mfma_f32_32x32x16_bf16(ak, bq[ks], acc, 0, 0, 0);
        }
        float grp[16];
#pragma unroll
        for (int r = 0; r < 16; ++r) grp[r] = __uint_as_float((__float_as_uint(acc[r]) & ~0x7Fu) | (unsigned)(nt * 32 + crow(r, hi)));
        bsort16(grp);
        if (nt == 0) {
#pragma unroll
          for (int i = 0; i < 16; ++i) lst[i] = grp[i];
        } else bmerge16(lst, grp);
        SBAR();
      }
      float oth[16];
#pragma unroll
      for (int i = 0; i < 16; ++i) oth[i] = __shfl_xor(lst[i], 32);
      bmerge16(lst, oth);
      if (hi == 0) {
        unsigned w[4];
#pragma unroll
        for (int i = 0; i < 4; ++i)
          w[i] = (__float_as_uint(lst[4 * i]) & 0x7Fu) | ((__float_as_uint(lst[4 * i + 1]) & 0x7Fu) << 8) | ((__float_as_uint(lst[4 * i + 2]) & 0x7Fu) << 16) | ((__float_as_uint(lst[4 * i + 3]) & 0x7Fu) << 24);
        *(u32x4*)(IDX + ((r32 * 8 + h) * 2 + pp) * 16) = (u32x4){w[0], w[1], w[2], w[3]};
      }
    }
    float best[16];
#define CAND(i, j) __uint_as_float((__float_as_uint(__uint_as_float(__float_as_uint(top[0][i]) & ~0x7Fu) + __uint_as_float(__float_as_uint(top[1][j]) & ~0x7Fu)) & ~0xFFu) | (unsigned)((i) * 16 + (j)))
    {
#pragma unroll
      for (int j = 0; j < 16; ++j) best[j] = CAND(0, j);
      float y[16];
#pragma unroll
      for (int j = 0; j < 8; ++j) { y[j] = CAND(1, j); y[8 + j] = CAND(15 - j, 0); }
#pragma unroll
      for (int jj = 8; jj > 0; jj >>= 1)
#pragma unroll
        for (int i = 0; i < 16; ++i) { const int q = i ^ jj; if (q > i) { const float hi_ = fmaxf(y[i], y[q]), lo_ = fminf(y[i], y[q]); y[i] = hi_; y[q] = lo_; } }
      bmerge16(best, y);
      float x[16];
      x[0] = CAND(2, 0); x[1] = CAND(2, 1); x[2] = CAND(2, 2); x[3] = CAND(2, 3); x[4] = CAND(2, 4);
      x[5] = CAND(3, 0); x[6] = CAND(3, 1); x[7] = CAND(3, 2); x[8] = CAND(3, 3);
      x[9] = CAND(4, 0); x[10] = CAND(4, 1); x[11] = CAND(4, 2);
      x[12] = CAND(5, 0); x[13] = CAND(5, 1); x[14] = CAND(6, 0); x[15] = CAND(6, 1);
      bsort16(x);
      bmerge16(best, x);
      ins16(best, CAND(7, 0)); ins16(best, CAND(7, 1));
    }
#undef CAND
    asm volatile("s_waitcnt lgkmcnt(0)" ::: "memory");
    if (hi == 0) {
      const unsigned char* ib = IDX + ((r32 * 8 + h) * 2) * 16;
      const float mx = __uint_as_float(__float_as_uint(best[0]) & ~0xFFu);
      float w[16]; float sum = 0.f;
#pragma unroll
      for (int k = 0; k < 16; ++k) { w[k] = __expf(__uint_as_float(__float_as_uint(best[k]) & ~0xFFu) - mx); sum += w[k]; }
      const float rsum = 1.f / sum;
      int ee[16]; float su_[16], sv_[16];
#pragma unroll
      for (int k = 0; k < 16; ++k) {
        const unsigned ij = __float_as_uint(best[k]) & 0xFFu;
        ee[k] = (int)ib[ij >> 4] * 128 + (int)ib[16 + (ij & 15)];
      }
#pragma unroll
      for (int k = 0; k < 16; ++k) { su_[k] = PSC[(size_t)l * NEXP + ee[k]]; sv_[k] = PSC[(size_t)(DEPTH + l) * NEXP + ee[k]]; }
#pragma unroll
      for (int k = 0; k < 16; ++k) {
        UE[r32 * 128 + h * 16 + k] = ee[k]; UG[r32 * 128 + h * 16 + k] = w[k] * rsum * sv_[k];
        US[r32 * 128 + h * 16 + k] = su_[k];
      }
    }
  }
  __syncthreads();
#pragma unroll 1
  for (int tt = 0; tt < 4; ++tt) {
    const int t = wid * 4 + tt;
    const int k0 = UE[t * 128 + lane], k1 = UE[t * 128 + 64 + lane];
    const float g0 = UG[t * 128 + lane], g1 = UG[t * 128 + 64 + lane], s0 = US[t * 128 + lane], s1 = US[t * 128 + 64 + lane];
    const int b0 = k0 >> 10, b1 = k1 >> 10;
    int base = 0, pos0 = 0, pos1 = 0;
#pragma unroll
    for (int b = 0; b < 16; ++b) {
      const unsigned long long m0 = __ballot(b0 == b), m1 = __ballot(b1 == b);
      const int c0 = __popcll(m0), c1 = __popcll(m1);
      const unsigned long long lt = (1ull << lane) - 1ull;
      if (b0 == b) pos0 = base + __popcll(m0 & lt);
      if (b1 == b) pos1 = base + c0 + __popcll(m1 & lt);
      base += c0 + c1;
    }
    const size_t ro = (size_t)(row0 + t) * 128;
    EIDG[ro + pos0] = k0; GWG[ro + pos0] = g0; SUG[ro + pos0] = s0;
    EIDG[ro + pos1] = k1; GWG[ro + pos1] = g1; SUG[ro + pos1] = s1;
  }
}
#define CAS __attribute__((address_space(4)))
typedef int i32x8 __attribute__((ext_vector_type(8)));
struct TokPref { f32x2 gs0, gs1; u32x4 hA, hB; };
struct RowPipe { i32x6 uq[4], vq[4]; i32x8 Ec; };
__device__ __forceinline__ const CAS i32x8* eid_row(const CAS unsigned char* eidg, int row) {
  return (const CAS i32x8*)(eidg + (size_t)(unsigned)__builtin_amdgcn_readfirstlane(row) * 512u);
}
__device__ __forceinline__ void tok_prefetch(const Params& p, int row, int lane, TokPref& t) {
  const float* GWG = (const float*)(p.ws + WS_ULOC + RT_STRIDE) + (size_t)row * 128;
  const float* SUG = (const float*)(p.ws + WS_ULOC + 2 * RT_STRIDE) + (size_t)row * 128;
  const bf16_t* H = (const bf16_t*)(p.ws + WS_H);
  t.gs0 = f32x2{GWG[lane], SUG[lane]}; t.gs1 = f32x2{GWG[64 + lane], SUG[64 + lane]};
  t.hA = *(const u32x4*)(H + (size_t)row * DM + lane * 16); t.hB = *(const u32x4*)(H + (size_t)row * DM + lane * 16 + 8);
}
#define LOADPAIR(dst_, tofs_, ea_, eb_) do { const u32x3v a_ = __builtin_amdgcn_raw_buffer_load_b96(rsT, lane12, (ea_) * PROW + (tofs_), 0); const unsigned b0_ = __builtin_amdgcn_raw_buffer_load_b32(rsT, lane12, (eb_) * PROW + (tofs_), 0); \
      const u32x2v b1_ = __builtin_amdgcn_raw_buffer_load_b64(rsT, lane12 + 4, (eb_) * PROW + (tofs_), 0); \
      dst_[0] = (int)a_.x; dst_[1] = (int)a_.y; dst_[2] = (int)a_.z; dst_[3] = (int)b0_; dst_[4] = (int)b1_.x; dst_[5] = (int)b1_.y; } while (0)
#define LOADGROUP(q_, tofs_, E_) do { LOADPAIR(q_[0], tofs_, E_[0], E_[1]); LOADPAIR(q_[1], tofs_, E_[2], E_[3]); LOADPAIR(q_[2], tofs_, E_[4], E_[5]); LOADPAIR(q_[3], tofs_, E_[6], E_[7]); } while (0)
constexpr int VOFS = (int)(WS_PV - WS_PU);
__device__ __forceinline__ void gather_token(const Params& p, const CAS unsigned char* eidg, const __amdgpu_buffer_rsrc_t rsT, int l, int row, int nextrow, TokPref& tp, RowPipe& rp, unsigned char* lds, int lane, int wid) {
  f32x2* GS = (f32x2*)(lds + wid * 2048);
  float* XC = (float*)(p.ws + WS_XCUR);
  const float* MOD = (const float*)(p.ws + WS_MOD);
  const CAS i32x8* EP = eid_row(eidg, row);
  const bool hasnext = nextrow >= 0;
  const CAS i32x8* EPn = eid_row(eidg, hasnext ? nextrow : row);
  GS[lane] = tp.gs0; GS[64 + lane] = tp.gs1;
  asm volatile("s_waitcnt lgkmcnt(0)" ::: "memory");
  const int eofl = ((lane >> 5) & 1) + 2 * ((lane >> 4) & 1) + 4 * ((lane >> 3) & 1);
  const int lane12 = lane * 12;
  {
    h16x2 hh[8];
    {
      const u32x4 hA = tp.hA, hB = tp.hB;
      hh[0] = __builtin_bit_cast(h16x2, __builtin_amdgcn_cvt_pkrtz(bflo(hA.x), bfhi(hA.x))); hh[1] = __builtin_bit_cast(h16x2, __builtin_amdgcn_cvt_pkrtz(bflo(hA.y), bfhi(hA.y))); hh[2] = __builtin_bit_cast(h16x2, __builtin_amdgcn_cvt_pkrtz(bflo(hA.z), bfhi(hA.z))); hh[3] = __builtin_bit_cast(h16x2, __builtin_amdgcn_cvt_pkrtz(bflo(hA.w), bfhi(hA.w)));
      hh[4] = __builtin_bit_cast(h16x2, __builtin_amdgcn_cvt_pkrtz(bflo(hB.x), bfhi(hB.x))); hh[5] = __builtin_bit_cast(h16x2, __builtin_amdgcn_cvt_pkrtz(bflo(hB.y), bfhi(hB.y))); hh[6] = __builtin_bit_cast(h16x2, __builtin_amdgcn_cvt_pkrtz(bflo(hB.z), bfhi(hB.z))); hh[7] = __builtin_bit_cast(h16x2, __builtin_amdgcn_cvt_pkrtz(bflo(hB.w), bfhi(hB.w)));
    }
    if (hasnext) tok_prefetch(p, nextrow, lane, tp);
    f32x4 xpre[4];
    { const float* xr_ = XC + (size_t)row * DM + lane * 16;
#pragma unroll
      for (int v4 = 0; v4 < 4; ++v4) xpre[v4] = *(const f32x4*)(xr_ + v4 * 4); }
    f32x2 acc2[8];
#pragma unroll
    for (int i = 0; i < 8; ++i) acc2[i] = f32x2{0.f, 0.f};
#pragma unroll 1
    for (int g8 = 0; g8 < 16; ++g8) {
      const bool pf = (g8 < 15) || hasnext;
      const f32x2 gs = GS[g8 * 8 + eofl];
      float d[8];
#pragma unroll
      for (int i2 = 0; i2 < 4; ++i2) {
        const h16x32 r = __builtin_amdgcn_cvt_scalef32_pk32_f16_fp6(rp.uq[i2], 1.0f);
        float a0 = 0.f, a1 = 0.f, b0 = 0.f, b1 = 0.f;
#define UDOT(k_) a0 = __builtin_amdgcn_fdot2(__builtin_shufflevector(r, r, 4 * (k_), 4 * (k_) + 1), hh[2 * (k_)], a0, false); b0 = __builtin_amdgcn_fdot2(__builtin_shufflevector(r, r, 16 + 4 * (k_), 17 + 4 * (k_)), hh[2 * (k_)], b0, false); \
        a1 = __builtin_amdgcn_fdot2(__builtin_shufflevector(r, r, 4 * (k_) + 2, 4 * (k_) + 3), hh[2 * (k_) + 1], a1, false); b1 = __builtin_amdgcn_fdot2(__builtin_shufflevector(r, r, 18 + 4 * (k_), 19 + 4 * (k_)), hh[2 * (k_) + 1], b1, false);
        UDOT(0) UDOT(1) UDOT(2) UDOT(3)
#undef UDOT
        d[2 * i2] = a0 + a1;
        d[2 * i2 + 1] = b0 + b1;
        asm volatile("" : "+v"(d[2 * i2]), "+v"(d[2 * i2 + 1]));
      }
      if (pf) LOADGROUP(rp.uq, 0, rp.Ec);
      float tot;
      {
        auto s01 = __builtin_amdgcn_permlane32_swap(__float_as_uint(d[0]), __float_as_uint(d[1]), false, false);
        auto s23 = __builtin_amdgcn_permlane32_swap(__float_as_uint(d[2]), __float_as_uint(d[3]), false, false);
        auto s45 = __builtin_amdgcn_permlane32_swap(__float_as_uint(d[4]), __float_as_uint(d[5]), false, false);
        auto s67 = __builtin_amdgcn_permlane32_swap(__float_as_uint(d[6]), __float_as_uint(d[7]), false, false);
        const float q01 = __uint_as_float(s01[0]) + __uint_as_float(s01[1]), q23 = __uint_as_float(s23[0]) + __uint_as_float(s23[1]);
        const float q45 = __uint_as_float(s45[0]) + __uint_as_float(s45[1]), q67 = __uint_as_float(s67[0]) + __uint_as_float(s67[1]);
        auto ta = __builtin_amdgcn_permlane16_swap(__float_as_uint(q01), __float_as_uint(q23), false, false);
        auto tb = __builtin_amdgcn_permlane16_swap(__float_as_uint(q45), __float_as_uint(q67), false, false);
        const float r0123 = __uint_as_float(ta[0]) + __uint_as_float(ta[1]);
        const float r4567 = __uint_as_float(tb[0]) + __uint_as_float(tb[1]);
        const bool b3 = (lane & 8) != 0;
        const float keep = b3 ? r4567 : r0123, send = b3 ? r0123 : r4567;
        float x = keep + dpp_mov<0x140>(send);
        x += dpp_mov<0xB1>(x); x += dpp_mov<0x4E>(x); x += dpp_mov<0x141>(x);
        tot = x * gs.y;
      }
      float ge;
      {
        const float v = tot, av = fabsf(v), tq = __builtin_amdgcn_rcpf(av * 0.2316418882f + 1.0f);
        float q = tq * 0.5307027145f + (-0.7265760135f); q = q * tq + 0.7107068705f; q = q * tq + (-0.142248368f); q = q * tq + 0.127414796f; q = q * tq;
        const float ex = __builtin_amdgcn_exp2f(v * v * (-0.72134752044f));
        const float m = v * (q * ex), r = v - m;
        ge = (v < 0.f ? m : r) * gs.x;
      }
      float c[8];
      c[0] = __uint_as_float(__builtin_amdgcn_readlane(__float_as_uint(ge), 0));  c[4] = __uint_as_float(__builtin_amdgcn_readlane(__float_as_uint(ge), 8));
      c[2] = __uint_as_float(__builtin_amdgcn_readlane(__float_as_uint(ge), 16)); c[6] = __uint_as_float(__builtin_amdgcn_readlane(__float_as_uint(ge), 24));
      c[1] = __uint_as_float(__builtin_amdgcn_readlane(__float_as_uint(ge), 32)); c[5] = __uint_as_float(__builtin_amdgcn_readlane(__float_as_uint(ge), 40));
      c[3] = __uint_as_float(__builtin_amdgcn_readlane(__float_as_uint(ge), 48)); c[7] = __uint_as_float(__builtin_amdgcn_readlane(__float_as_uint(ge), 56));
#pragma unroll
      for (int i2 = 0; i2 < 4; ++i2) {
        const f32x32 r = __builtin_amdgcn_cvt_scalef32_pk32_f32_fp6(rp.vq[i2], 1.0f);
        const f32x2 cc = {c[2 * i2], c[2 * i2 + 1]};
        const f32x2 ca = __builtin_shufflevector(cc, cc, 0, 0), cb = __builtin_shufflevector(cc, cc, 1, 1);
#define VAXL(k_) acc2[k_] = ca * __builtin_shufflevector(r, r, 2 * (k_), 2 * (k_) + 1) + acc2[k_];
#define VAXH(k_) acc2[k_] = cb * __builtin_shufflevector(r, r, 16 + 2 * (k_), 17 + 2 * (k_)) + acc2[k_];
        VAXL(0) VAXL(1) VAXL(2) VAXL(3) VAXL(4) VAXL(5) VAXL(6) VAXL(7)
        asm volatile("" : "+v"(acc2[0]), "+v"(acc2[1]), "+v"(acc2[2]), "+v"(acc2[3]), "+v"(acc2[4]), "+v"(acc2[5]), "+v"(acc2[6]), "+v"(acc2[7]));
        VAXH(0) VAXH(1) VAXH(2) VAXH(3) VAXH(4) VAXH(5) VAXH(6) VAXH(7)
#undef VAXL
#undef VAXH
        asm volatile("" : "+v"(acc2[0]), "+v"(acc2[1]), "+v"(acc2[2]), "+v"(acc2[3]), "+v"(acc2[4]), "+v"(acc2[5]), "+v"(acc2[6]), "+v"(acc2[7]));
      }
      if (pf) LOADGROUP(rp.vq, VOFS, rp.Ec);
      { const CAS i32x8* src_ = g8 < 14 ? EP + (g8 + 2) : EPn + (g8 - 14); rp.Ec = *src_; }
    }
    SBAR();
    float acc[16];
#pragma unroll
    for (int i = 0; i < 8; ++i) { acc[2 * i] = acc2[i].x; acc[2 * i + 1] = acc2[i].y; }
    const int mr = mod_row(row);
    const float* g2 = MOD + ((size_t)l * 5 + mr) * 6144 + 5 * 1024;
    float* xr = XC + (size_t)row * DM;
    float xn[16]; float ssq = 0.f;
    if (ABL & 8) {
#pragma unroll
      for (int i = 0; i < 16; ++i) acc[i] = 0.f;
    }
#pragma unroll
    for (int v4 = 0; v4 < 4; ++v4) {
      const int c = lane * 16 + v4 * 4;
      const f32x4 xo = xpre[v4], gg = *(const f32x4*)(g2 + c);
      f32x4 o;
      o.x = xo.x + gg.x * acc[v4 * 4 + 0]; o.y = xo.y + gg.y * acc[v4 * 4 + 1]; o.z = xo.z + gg.z * acc[v4 * 4 + 2]; o.w = xo.w + gg.w * acc[v4 * 4 + 3];
      xn[v4 * 4 + 0] = o.x; xn[v4 * 4 + 1] = o.y; xn[v4 * 4 + 2] = o.z; xn[v4 * 4 + 3] = o.w;
      ssq += (o.x * o.x + o.y * o.y) + (o.z * o.z + o.w * o.w);
      if (l < DEPTH - 1) *(f32x4*)(xr + c) = o;
    }
    const float rs = rsqrtf(wave_sum_fast(ssq) * (1.f / DM) + EPS);
    if (l == DEPTH - 1) {
      const int b = row / SEGL, s = row - b * SEGL;
      float* orow = p.out + ((size_t)(b * SEQ + (s - CTXL))) * DM;
      const float* fg = p.in[I_FINALG];
#pragma unroll
      for (int v4 = 0; v4 < 4; ++v4) {
        const int c = lane * 16 + v4 * 4;
        const f32x4 gg = *(const f32x4*)(fg + c);
        f32x4 o; o.x = xn[v4 * 4 + 0] * rs * gg.x; o.y = xn[v4 * 4 + 1] * rs * gg.y; o.z = xn[v4 * 4 + 2] * rs * gg.z; o.w = xn[v4 * 4 + 3] * rs * gg.w;
        *(f32x4*)(orow + c) = o;
      }
    } else {
      const float* m = MOD + ((size_t)(l + 1) * 5 + mr) * 6144;
      const float* ng = p.in[I_N1G] + (l + 1) * DM;
      bf16_t* hrow = (bf16_t*)(p.ws + WS_H) + (size_t)row * DM;
#pragma unroll
      for (int hh = 0; hh < 2; ++hh) {
        float y[8];
#pragma unroll
        for (int i = 0; i < 8; ++i) { const int c = lane * 16 + hh * 8 + i; y[i] = xn[hh * 8 + i] * rs * ng[c] * (1.f + m[1024 + c]) + m[c]; }
        u32x4 w; w.x = cvtpk(y[0], y[1]); w.y = cvtpk(y[2], y[3]); w.z = cvtpk(y[4], y[5]); w.w = cvtpk(y[6], y[7]);
        *(u32x4*)(hrow + lane * 16 + hh * 8) = w;
      }
    }
  }
}

__device__ __forceinline__ void phase_c1(const Params& p, int l, unsigned char* lds) {
  constexpr int NLOC = NBATCH * 4 * NCH, NCONV = T / 32;
  for (int u = p.bx; u < NLOC + NCONV; u += p.gx) {
    if (u < NLOC) ml_local_unit2(p, l, u, lds);
    else {
      const int cu = u - NLOC;
      if (l == DEPTH - 1 && (cu % (SEGL / 32)) < (CTXL / 32)) continue;
      conv_unit(p, l, cu, lds);
    }
  }
}
__device__ __forceinline__ void phase_c2(const Params& p, int l, unsigned char* lds) {
  ml_scan(p, lds);
  const float* lp = p.in[I_DLAM] + l * 256;
  float s01 = 0.f, s23 = 0.f;
  for (int i = 0; i < 64; ++i) { s01 += lp[i] * lp[64 + i]; s23 += lp[128 + i] * lp[192 + i]; }
  const float lam_init = 0.8f - 0.6f * expf(-0.3f * (float)l);
  const float lam = expf(s01) - expf(s23) + lam_init;
  const bf16_t* PROJ = (const bf16_t*)(p.ws + WS_PROJ);
  bf16_t* MIX = (bf16_t*)(p.ws + WS_MIX);
  const float* ng = p.in[I_DNORMG] + l * 128;
  const int nun = 512 + (l < DEPTH - 1 ? 16 : 0);
  for (int u = p.bx; u < nun; u += p.gx) {
    int bh, qrow, nkeys;
    if (u < 512) { const int xcd = u & 7, i = (u >> 3) & 31, rnd = u >> 8; bh = 2 * xcd + rnd; qrow = CTXL + i * 256; nkeys = SEGL; }
    else { bh = u - 512; qrow = 0; nkeys = CTXL; }
    const int b = bh >> 2, h = bh & 3;
    const size_t tok0 = (size_t)b * SEGL;
    for (int rep = 0; rep < REP_ATT; ++rep)
    att_unit(PROJ + (tok0 + qrow) * PW + C_DQ + h * 128, PROJ + tok0 * PW + C_DK + h * 128, p.ws + WS_V8T + (size_t)bh * NCH * ATT_SHM_V,
             MIX + (tok0 + qrow) * DM + 512 + h * 128, nkeys, lam, ng, 1.f - lam_init, lds);
  }
}
__device__ __forceinline__ void phase_c3(const Params& p, int l, unsigned char* lds) {
  constexpr int NU = NBATCH * 4 * NCH;
  for (int u = p.bx; u < NU; u += p.gx) {
    if (l == DEPTH - 1 && (u % NCH) < 4) continue;
    ml_out_unit2(p, l, u, lds);
  }
}
__device__ __forceinline__ void phase_route(const Params& p, int l, unsigned char* lds) {
  constexpr int NU = T / 32;
  for (int u = p.bx; u < NU; u += p.gx) {
    if (l == DEPTH - 1 && (u % (SEGL / 32)) < (CTXL / 32)) continue;
    route_unit(p, l, u, lds);
    __syncthreads();
  }
}
__device__ __forceinline__ void phase_gather(const Params& p, int l, unsigned char* lds) {
  int tid_ = tidx(); asm volatile("" : "+v"(tid_)); const int lane = tid_ & 63, wid = __builtin_amdgcn_readfirstlane(tid_ >> 6);
  const int gw = p.bx * 8 + wid, NGW = p.gx * 8;
  const int ntok = (l == DEPTH - 1) ? NBATCH * SEQ : T;
#define TOKROW(ti_) ((l == DEPTH - 1) ? ((ti_) / SEQ) * SEGL + CTXL + ((ti_) % SEQ) : (ti_))
  const CAS unsigned char* eidg = (const CAS unsigned char*)(p.ws + WS_EID + (size_t)l * RT_STRIDE);
  const __amdgpu_buffer_rsrc_t rsT = __builtin_amdgcn_make_buffer_rsrc((void*)(p.ws + WS_PU + (size_t)l * NEXP * PROW), 0, VOFS + NEXP * PROW, 0x00020000);
  TokPref tp; RowPipe rp;
  if (gw < ntok) {
    const int row0 = TOKROW(gw); const int lane12 = lane * 12;
    tok_prefetch(p, row0, lane, tp);
    const CAS i32x8* EP0 = eid_row(eidg, row0);
    rp.Ec = EP0[0];
    LOADGROUP(rp.uq, 0, rp.Ec); LOADGROUP(rp.vq, VOFS, rp.Ec);
    rp.Ec = EP0[1];
  }
  XcdBarrier xb; xb.bar = p.xbar_words; xb.x = p.xbar_x; xb.st = (volatile LAS unsigned*)((LAS unsigned char*)lds + p.lds_st_off);
  const int nrounds = (ntok + NGW - 1) / NGW;
  for (int r = 0; r < nrounds; ++r) {
    const int ti = gw + r * NGW;
    if (ti < ntok) {
      const int row = TOKROW(ti);
      const int nxt = ti + NGW < ntok ? TOKROW(ti + NGW) : -1;
      gather_token(p, eidg, rsT, l, row, nxt, tp, rp, lds, lane, wid);
    }
#if GATHER_SYNC
    if (r + 1 < nrounds) { XcdBarrier xb2 = xb; size_t zb_ = 0; asm volatile("" : "+s"(zb_)); xb2.bar = xb.bar + zb_; xb2.x = xb.x + (unsigned)zb_; xcd_barrier(xb2); }
#endif
  }
#undef TOKROW
}

__global__ void __launch_bounds__(512, 2) mk_fwd(KArgs ka) {
  cg::grid_group grid = cg::this_grid();
  extern __shared__ __attribute__((aligned(16))) unsigned char lds[];
  const int lo = ka.ph_lo, hi = ka.ph_hi;
#define IN(k) (lo <= (k) && (k) < hi)
#ifndef PHASEMASK
#define PHASEMASK 0xFFFF
#endif
#define PH(i) ((PHASEMASK >> (i)) & 1)
#define MKP(q) Params q; { size_t z_ = 0; asm volatile("" : "+s"(z_)); \
    q.in = (InTab)((const __attribute__((address_space(4))) char*)__builtin_amdgcn_kernarg_segment_ptr() + z_); \
    q.out = ka.out + z_; q.ws = ka.ws + z_; q.ph_lo = lo; q.ph_hi = hi; q.bx = (int)blockIdx.x + (int)z_; q.gx = (int)gridDim.x + (int)z_; q.xbar_words = xbar.bar + z_; q.xbar_x = xbar.x + (unsigned)z_; q.lds_st_off = (unsigned)(LDS_BYTES - 64); }
#define SEAM(k) do { if (IN(k) && IN((k) + 1)) { if ((k) == 0) grid.sync(); else { XcdBarrier xb_ = xbar; size_t zb_ = 0; asm volatile("" : "+s"(zb_)); xb_.bar = xbar.bar + zb_; xb_.x = xbar.x + (unsigned)zb_; xcd_barrier(xb_); } } } while (0)
  volatile LAS unsigned* xst = (volatile LAS unsigned*)((LAS unsigned char*)lds + (LDS_BYTES - 64));
  { const int t0_ = threadIdx.x;
    if (t0_ < 2) xst[t0_] = 0u;
    if ((t0_ & 63) == 0) *(volatile LAS int*)((LAS unsigned char*)lds + LDS_WTAB + 4 * hw_wave_key()) = t0_ >> 6; }
  __syncthreads();
  XcdBarrier xbar = xcd_barrier_post((unsigned*)(ka.ws + WS_CTL) + 4096, xst);
  { MKP(p)
    if (PH(0) && IN(0)) for (int rep = 0; rep < REP_MISC; ++rep) { p0_mod(p, lds, (float*)(p.ws + WS_MOD)); p0_convert(p, lds); }
  }
  SEAM(0);
  { MKP(p)
    if (PH(1) && IN(1)) phase_norm(p, 0, 0, true, false);
  }
  SEAM(1);
#define LAYER(LL) { \
    int l = (LL); asm volatile("" : "+s"(l)); \
    const int b = 2 + 9 * (LL); \
    { MKP(q) if (PH(2) && IN(b + 0)) for (int rep = 0; rep < REP_GEMM; ++rep) phase_inproj2(q, l, lds); } \
    SEAM(b + 0); \
    { MKP(q) if (PH(3) && IN(b + 1)) for (int rep = 0; rep < REP_ML; ++rep) phase_c1(q, l, lds); } \
    SEAM(b + 1); \
    { MKP(q) if (PH(4) && IN(b + 2)) phase_c2(q, l, lds); } \
    SEAM(b + 2); \
    { MKP(q) if (PH(5) && IN(b + 3)) for (int rep = 0; rep < REP_ML; ++rep) phase_c3(q, l, lds); } \
    SEAM(b + 3); \
    { MKP(q) if (PH(6) && IN(b + 4)) phase_outproj2(q, l, lds); } \
    SEAM(b + 4); \
    { MKP(q) if (PH(7) && IN(b + 5)) for (int rep = 0; rep < REP_MISC; ++rep) phase_norm(q, l, 1, false, (LL) == DEPTH - 1); } \
    SEAM(b + 5); \
    { MKP(q) if (PH(8) && IN(b + 6)) for (int rep = 0; rep < REP_GEMM; ++rep) phase_peerq2(q, l, lds); } \
    SEAM(b + 6); \
    { MKP(q) if (PH(9) && IN(b + 7)) phase_route(q, l, lds); } \
    SEAM(b + 7); \
    { MKP(q) if (PH(9) && IN(b + 8)) phase_gather(q, l, lds); } \
    SEAM(b + 8); }
  LAYER(0) LAYER(1) LAYER(2) LAYER(3)
#undef LAYER
#undef IN
#undef SEAM
#undef MKP
}

extern "C" void kernel_launch(void* const* d_in, const int* in_sizes, int n_in, void* d_out, int out_size,
                              void* d_ws, size_t ws_size, hipStream_t stream) {
  static int grid = 0;
  if (grid == 0) {
    int dev = 0, cus = 0, per_cu = 0;
    (void)hipGetDevice(&dev);
    (void)hipDeviceGetAttribute(&cus, hipDeviceAttributeMultiprocessorCount, dev);
    (void)hipFuncSetAttribute((const void*)mk_fwd, hipFuncAttributeMaxDynamicSharedMemorySize, LDS_BYTES);
    (void)hipOccupancyMaxActiveBlocksPerMultiprocessor(&per_cu, (const void*)mk_fwd, 512, LDS_BYTES);
    fprintf(stderr, "kernel_launch: cus %d per_cu %d ws %zu (need %zu) n_in %d\n", cus, per_cu, ws_size, (size_t)WS_END, n_in);
    if (ws_size < WS_END || n_in != 23 || per_cu < 1) { fprintf(stderr, "kernel_launch: bad configuration, nothing launched\n"); grid = -1; return; }
    grid = cus;
  }
  if (grid < 0) return;
  (void)hipMemsetAsync((char*)d_ws + WS_CTL, 0, 65536, stream);
  KArgs p{};
  for (int i = 0; i < 23; ++i) p.in[i] = (const float*)d_in[i];
  p.out = (float*)d_out; p.ws = (unsigned char*)d_ws; p.ph_lo = 0; p.ph_hi = 38;
  void* args[] = {&p};
  hipError_t e = hipLaunchCooperativeKernel((const void*)mk_fwd, dim3(grid), dim3(512), args, LDS_BYTES, stream);
  if (e != hipSuccess) fprintf(stderr, "cooperative launch failed: %s (grid %d)\n", hipGetErrorString(e), grid);
}
```

```cpp
#include <hip/hip_runtime.h>
#include <hip/hip_cooperative_groups.h>
#include <cstdio>
#include <cstdint>
namespace cg = cooperative_groups;

constexpr int DM = 1024, NBATCH = 4, SEQ = 8192, CTXL = 256, SEGL = CTXL + SEQ, T = NBATCH * SEGL, DEPTH = 4;
constexpr int IN_W = 3088, PW = 3072;
constexpr int C_A = 0, C_MQ = 512, C_MK = 768, C_MV = 1024, C_MO = 1280, C_DQ = 1536, C_DK = 2048, C_DV = 2560;
constexpr int NCH = SEGL / 64;
constexpr int NEXP = 16384;
constexpr float EPS = 1e-6f;
#ifndef ABL
#define ABL 0
#endif
#ifndef GATHER_SYNC
#define GATHER_SYNC 0
#endif
#ifndef REP_ATT
#define REP_ATT 1
#endif
#ifndef GP_MASK
#define GP_MASK 0x3FFF
#endif
#ifndef REP_PEER
#define REP_PEER 1
#endif
#ifndef REP_GEMM
#define REP_GEMM 1
#endif
#ifndef REP_ROUTE
#define REP_ROUTE 1
#endif
#ifndef REP_OUTP
#define REP_OUTP 1
#endif
#ifndef REP_ML
#define REP_ML 1
#endif
#ifndef REP_MISC
#define REP_MISC 1
#endif
constexpr float QSCALE = 0.125f * 1.4426950408889634f;

constexpr size_t MiB = 1u << 20;
constexpr size_t WS_CTL = 0, WS_MOD = 1 * MiB, WS_ROPE = 2 * MiB, WS_WG = 4 * MiB, WS_KEYS = 5 * MiB, WS_MLMETA = 6 * MiB,
                 WS_GATES = 7 * MiB, WS_WIN = 10 * MiB, WS_WOUT = 34 * MiB, WS_WQ = 42 * MiB, WS_PU = 50 * MiB, WS_PV = 114 * MiB, WS_PSC = 178 * MiB  ,
                 WS_XCUR = 306 * MiB, WS_H = 438 * MiB, WS_MIX = 504 * MiB, WS_PROJ = 570 * MiB, WS_ULOC = 768 * MiB, WS_V8T = 836 * MiB  , WS_EID = 858 * MiB  , WS_END = 924 * MiB;
constexpr int USTRIDE = 4160;

constexpr int LDS_BYTES = 139264 + 512;
constexpr int LDS_WTAB = LDS_BYTES - 64 - 256;

#define LAS __attribute__((address_space(3)))
__device__ __forceinline__ int hw_wave_key() { return (int)(__builtin_amdgcn_s_getreg((5 << 11) | 4) & 63u); }
__device__ __forceinline__ int tidx() {
  extern __shared__ __attribute__((aligned(16))) unsigned char lds_dyn_[];
  const int w = __builtin_amdgcn_readfirstlane(*(const volatile LAS int*)((LAS unsigned char*)lds_dyn_ + LDS_WTAB + 4 * hw_wave_key()));
  unsigned z_ = 0u; asm volatile("" : "+v"(z_));
  return (w << 6) | (int)__builtin_amdgcn_mbcnt_hi(~0u, __builtin_amdgcn_mbcnt_lo(~0u, z_));
}
typedef unsigned short bf16_t;
typedef short bf16x8 __attribute__((ext_vector_type(8)));
typedef short s16x4 __attribute__((ext_vector_type(4)));
typedef float f32x4 __attribute__((ext_vector_type(4)));
typedef float f32x16 __attribute__((ext_vector_type(16)));
typedef unsigned u32x4 __attribute__((ext_vector_type(4)));
typedef unsigned u32x2 __attribute__((ext_vector_type(2)));
typedef __bf16 bf16x2v __attribute__((ext_vector_type(2)));
typedef int i32x8 __attribute__((ext_vector_type(8)));
typedef int i32x6 __attribute__((ext_vector_type(6)));
struct __attribute__((aligned(4))) u32x3 { unsigned x, y, z; };
typedef float f32x32 __attribute__((ext_vector_type(32)));
constexpr int PROW = 768;
typedef float f32x2 __attribute__((ext_vector_type(2)));
typedef _Float16 h16x2 __attribute__((ext_vector_type(2)));
typedef _Float16 h16x32 __attribute__((ext_vector_type(32)));
typedef unsigned u32x3v __attribute__((ext_vector_type(3)));
typedef unsigned u32x2v __attribute__((ext_vector_type(2)));

struct KArgs {
  const float* in[23];
  float* out;
  unsigned char* ws;
  int ph_lo, ph_hi;
};
typedef const float* const __attribute__((address_space(4))) * InTab;
struct Params {
  InTab in;
  float* out;
  unsigned char* ws;
  int ph_lo, ph_hi;
  int bx, gx;
  unsigned* xbar_words; unsigned xbar_x; unsigned lds_st_off;
};
enum { I_X = 0, I_C, I_CTX, I_CCTX, I_ADAW, I_ADAB, I_N1G, I_N2G, I_WIN, I_CONVW, I_CONVB, I_CLNG, I_CLNB, I_GATEB, I_MNORMG, I_DLAM, I_DNORMG,
       I_WOUT, I_PWQ, I_PKEYS, I_PU, I_PV, I_FINALG };

__device__ __forceinline__ unsigned cvtpk(float lo, float hi) { unsigned r; asm volatile("v_cvt_pk_bf16_f32 %0, %1, %2" : "=v"(r) : "v"(lo), "v"(hi)); return r; }
__device__ __forceinline__ float bflo(unsigned u) { return __uint_as_float(u << 16); }
__device__ __forceinline__ float bfhi(unsigned u) { return __uint_as_float(u & 0xffff0000u); }
__device__ __forceinline__ float bf1(bf16_t u) { return __uint_as_float(((unsigned)u) << 16); }
__device__ __forceinline__ int crow(int r, int hi) { return (r & 3) + 8 * (r >> 2) + 4 * hi; }
template <int CTRL> __device__ __forceinline__ float dpp_mov(float v) {
  return __uint_as_float((unsigned)__builtin_amdgcn_update_dpp(0, (int)__float_as_uint(v), CTRL, 0xF, 0xF, true));
}
__device__ __forceinline__ float wave_sum_fast(float x) {
  x += dpp_mov<0xB1>(x); x += dpp_mov<0x4E>(x); x += dpp_mov<0x141>(x); x += dpp_mov<0x140>(x);
  { auto r = __builtin_amdgcn_permlane16_swap(__float_as_uint(x), __float_as_uint(x), false, false); x = __uint_as_float(r[0]) + __uint_as_float(r[1]); }
  { auto r = __builtin_amdgcn_permlane32_swap(__float_as_uint(x), __float_as_uint(x), false, false); x = __uint_as_float(r[0]) + __uint_as_float(r[1]); }
  return x;
}
__device__ __forceinline__ float wave_sum(float v) {
#pragma unroll
  for (int o = 1; o < 64; o <<= 1) v += __shfl_xor(v, o);
  return v;
}
__device__ __forceinline__ float wave_max(float v) {
#pragma unroll
  for (int o = 1; o < 64; o <<= 1) v = fmaxf(v, __shfl_xor(v, o));
  return v;
}
__device__ __forceinline__ float sigmoidf_(float x) { return 1.f / (1.f + __expf(-x)); }
__device__ __forceinline__ float logsigmoidf_(float x) { return fminf(x, 0.f) - log1pf(__expf(-fabsf(x))); }
__device__ __forceinline__ const float* in_row(const float* x, const float* ctx, int row) {
  const int b = row / SEGL, s = row - b * SEGL;
  return s < CTXL ? ctx + ((size_t)(b * CTXL + s)) * DM : x + ((size_t)(b * SEQ + (s - CTXL))) * DM;
}
__device__ __forceinline__ int mod_row(int row) { const int b = row / SEGL, s = row - b * SEGL; return s < CTXL ? 4 : b; }

__device__ __forceinline__ void p0_mod(const Params& p, unsigned char* lds, float* MOD) {
  float* sil = (float*)lds;
  float* red = (float*)(lds + 20480);
  int tid_ = tidx(); asm volatile("" : "+v"(tid_)); const int tid = tid_, lane = tid & 63, wid = tid >> 6;
  for (int i = tid; i < 5 * 1024; i += 512) {
    const float v = i < 4096 ? p.in[I_C][i] : p.in[I_CCTX][i - 4096];
    sil[i] = v / (1.f + __expf(-v));
  }
  __syncthreads();
  for (int item = p.bx; item < DEPTH * 96; item += p.gx) {
    const int l = item / 96, j0 = (item % 96) * 64;
    const float* W = p.in[I_ADAW] + (size_t)l * DM * 6144 + j0 + lane;
    float a0 = 0.f, a1 = 0.f, a2 = 0.f, a3 = 0.f, a4 = 0.f;
    const int k0 = wid * 128;
#pragma unroll 8
    for (int k = k0; k < k0 + 128; ++k) {
      const float w = W[(size_t)k * 6144];
      a0 += sil[k] * w; a1 += sil[1024 + k] * w; a2 += sil[2048 + k] * w; a3 += sil[3072 + k] * w; a4 += sil[4096 + k] * w;
    }
    red[(wid * 5 + 0) * 64 + lane] = a0; red[(wid * 5 + 1) * 64 + lane] = a1; red[(wid * 5 + 2) * 64 + lane] = a2;
    red[(wid * 5 + 3) * 64 + lane] = a3; red[(wid * 5 + 4) * 64 + lane] = a4;
    __syncthreads();
    if (tid < 320) {
      const int r = tid >> 6;
      float s = 0.f;
#pragma unroll
      for (int w = 0; w < 8; ++w) s += red[(w * 5 + r) * 64 + lane];
      MOD[((size_t)l * 5 + r) * 6144 + j0 + lane] = s + p.in[I_ADAB][l * 6144 + j0 + lane];
    }
    __syncthreads();
  }
}
__device__ __forceinline__ void transpose_item(const float* W, int ldw, int srccol0, bf16_t* WT, int K, int n0, int k0, float* scr, int lane) {
#pragma unroll 8
  for (int i = 0; i < 32; ++i) { const int kk = 2 * i + (lane >> 5); scr[kk * 33 + (lane & 31)] = W[(size_t)(k0 + kk) * ldw + srccol0 + (lane & 31)]; }
  asm volatile("s_waitcnt lgkmcnt(0)" ::: "memory");
  const int c = lane & 7;
#pragma unroll
  for (int j = 0; j < 4; ++j) {
    const int n = (lane >> 3) + 8 * j; const float* s = scr + (8 * c) * 33 + n;
    u32x4 o; o.x = cvtpk(s[0], s[33]); o.y = cvtpk(s[66], s[99]); o.z = cvtpk(s[132], s[165]); o.w = cvtpk(s[198], s[231]);
    *(u32x4*)(WT + (size_t)(n0 + n) * K + k0 + 8 * c) = o;
  }
  asm volatile("s_waitcnt lgkmcnt(0)" ::: "memory");
}
__device__ __forceinline__ void convert_tables(const Params& p, int L, int wv, int nw, int lane) {
  unsigned char* PUq = p.ws + WS_PU; unsigned char* PVq = p.ws + WS_PV; float* PSC = (float*)(p.ws + WS_PSC);
  const int nrows = DEPTH * NEXP;
  for (int r = wv; r < 2 * NEXP; r += nw) {
    const int tb = r >= NEXP, rr = L * NEXP + (tb ? r - NEXP : r);
    const f32x4* srow = (const f32x4*)((tb ? p.in[I_PV] : p.in[I_PU]) + (size_t)rr * DM) + lane * 4;
    f32x4 v[4]; float mx = 0.f;
#pragma unroll
    for (int j = 0; j < 4; ++j) { v[j] = __builtin_nontemporal_load(srow + j); mx = fmaxf(mx, fmaxf(fmaxf(fabsf(v[j].x), fabsf(v[j].y)), fmaxf(fabsf(v[j].z), fabsf(v[j].w)))); }
    mx = wave_max(mx);
    const unsigned mb = __float_as_uint(mx);
    const int eb = (int)((mb >> 23) & 0xFFu);
    int sb = ((mb & 0x7FFFFFu) <= 0x700000u ? 129 : 128) - eb + 127; sb = sb < 1 ? 1 : (sb > 253 ? 253 : sb);
    const float sc = __uint_as_float((unsigned)sb << 23), isc = __uint_as_float((unsigned)(254 - sb) << 23);
    const float xv[16] = {v[0].x, v[0].y, v[0].z, v[0].w, v[1].x, v[1].y, v[1].z, v[1].w, v[2].x, v[2].y, v[2].z, v[2].w, v[3].x, v[3].y, v[3].z, v[3].w};
    unsigned wq[3] = {0u, 0u, 0u};
#pragma unroll
    for (int i = 0; i < 16; ++i) {
      const float a = fabsf(xv[i]) * sc;
      unsigned code = a < 2.f ? (unsigned)__builtin_rintf(a * 8.f) : (a < 4.f ? 8u + (unsigned)__builtin_rintf(a * 4.f) : 16u + (unsigned)__builtin_rintf(a * 2.f));
      code = code > 31u ? 31u : code;
      code |= (xv[i] < 0.f) ? 32u : 0u;
      const int bp = 6 * i, dw = bp >> 5, off = bp & 31;
      wq[dw] |= code << off;
      if (off > 26) wq[dw + 1] |= code >> (32 - off);
    }
    u32x3 o; o.x = wq[0]; o.y = wq[1]; o.z = wq[2];
    *(u32x3*)((tb ? PVq : PUq) + (size_t)rr * PROW + lane * 12) = o;
    if (lane == 0) PSC[(size_t)tb * nrows + rr] = isc;
  }
}
__device__ __forceinline__ void tail_filler_tables(const Params& p, int L, int nwg) {
  int tid_ = tidx(); asm volatile("" : "+v"(tid_)); const int lane = tid_ & 63, wid = tid_ >> 6;
  const int nextra = nwg % p.gx, first = nextra, nidle = p.gx - nextra;
  if (p.bx < first) return;
  convert_tables(p, L, (p.bx - first) * 8 + wid, nidle * 8, lane);
}
__device__ __forceinline__ void p0_convert(const Params& p, unsigned char* lds) {
  int tid_ = tidx(); asm volatile("" : "+v"(tid_)); const int tid = tid_, lane = tid & 63, wid = tid >> 6;
  const int gw = p.bx * 8 + wid, NGW = p.gx * 8;
  const size_t gt = (size_t)p.bx * 512 + tid, NGT = (size_t)p.gx * 512;
  float* scr = (float*)(lds + 32768) + wid * (64 * 33);
  bf16_t* WIN = (bf16_t*)(p.ws + WS_WIN); bf16_t* WOUT = (bf16_t*)(p.ws + WS_WOUT); bf16_t* WQ = (bf16_t*)(p.ws + WS_WQ);
  constexpr int I_IN = 16 * 96, I_O = 16 * 32, PER_L = I_IN + 2 * I_O;
  for (int it = gw; it < DEPTH * PER_L; it += NGW) {
    const int l = it / PER_L; int r = it % PER_L;
    if (r < I_IN) { const int kb = r / 96, nb = r % 96, n0 = nb * 32; const int src = n0 < 1536 ? n0 : n0 + 16;
      transpose_item(p.in[I_WIN] + (size_t)l * DM * IN_W, IN_W, src, WIN + (size_t)l * PW * DM, DM, n0, kb * 64, scr, lane); continue; }
    r -= I_IN;
    if (r < I_O) { const int kb = r / 32, nb = r % 32;
      transpose_item(p.in[I_WOUT] + (size_t)l * DM * DM, DM, nb * 32, WOUT + (size_t)l * DM * DM, DM, nb * 32, kb * 64, scr, lane); continue; }
    r -= I_O;
    { const int kb = r / 32, nb = r % 32;
      transpose_item(p.in[I_PWQ] + (size_t)l * DM * DM, DM, nb * 32, WQ + (size_t)l * DM * DM, DM, nb * 32, kb * 64, scr, lane); }
  }
  bf16_t* WG = (bf16_t*)(p.ws + WS_WG);
  for (size_t i = gt; i < (size_t)DEPTH * 16 * DM; i += NGT) {
    const int l = (int)(i / (16 * DM)), g = (int)((i / DM) % 16), k = (int)(i % DM);
    WG[i] = (bf16_t)(cvtpk(p.in[I_WIN][(size_t)l * DM * IN_W + (size_t)k * IN_W + 1536 + g], 0.f) & 0xffffu);
  }
  bf16_t* KEYS = (bf16_t*)(p.ws + WS_KEYS);
  for (size_t i = gt; i < (size_t)DEPTH * 131072 / 8; i += NGT) {
    const f32x4 a = ((const f32x4*)p.in[I_PKEYS])[2 * i], b = ((const f32x4*)p.in[I_PKEYS])[2 * i + 1];
    u32x4 o; o.x = cvtpk(a.x, a.y); o.y = cvtpk(a.z, a.w); o.z = cvtpk(b.x, b.y); o.w = cvtpk(b.z, b.w);
    ((u32x4*)KEYS)[i] = o;
  }
  {
    float* RC = (float*)(p.ws + WS_ROPE); float* RS = RC + SEQ * 32;
    for (size_t i = gt; i < (size_t)SEQ * 32; i += NGT) {
      const int pos = (int)(i >> 5), j = (int)(i & 31);
      const int rr = pos >> 6, cc = pos & 63;
      const int jj = j & 15;
      const double e = -(double)jj * 0.83048202372184058696;
      const double fl = __builtin_floor(e); const double f = e - fl;
      const double z = f * 0.69314718055994530942;
      double ez = 1.0 + z * (1.0 + z * (0.5 + z * (1.0 / 6 + z * (1.0 / 24 + z * (1.0 / 120 + z * (1.0 / 720 + z * (1.0 / 5040 + z * (1.0 / 40320 + z * (1.0 / 362880 + z * (1.0 / 3628800 + z * (1.0 / 39916800 + z * (1.0 / 479001600))))))))))));
      const double inv = __builtin_ldexp(ez, (int)fl);
      const float invf = (float)inv;
      const float angf = (float)(j < 16 ? rr : cc) * invf;
      const double ang = (double)angf;
      const double kq = __builtin_rint(ang * 0.63661977236758134308);
      double r = __builtin_fma(-kq, 1.57079632679489655800e+00, ang);
      r = __builtin_fma(-kq, 6.12323399573676603587e-17, r);
      const double r2 = r * r;
      const double sn = r * (1.0 + r2 * (-1.0 / 6 + r2 * (1.0 / 120 + r2 * (-1.0 / 5040 + r2 * (1.0 / 362880 + r2 * (-1.0 / 39916800 + r2 * (1.0 / 6227020800.0)))))));
      const double cs = 1.0 + r2 * (-0.5 + r2 * (1.0 / 24 + r2 * (-1.0 / 720 + r2 * (1.0 / 40320 + r2 * (-1.0 / 3628800 + r2 * (1.0 / 479001600 + r2 * (-1.0 / 87178291200.0)))))));
      const int q = ((int)kq) & 3;
      double co, si;
      if (q == 0) { co = cs; si = sn; } else if (q == 1) { co = -sn; si = cs; } else if (q == 2) { co = -cs; si = -sn; } else { co = sn; si = -cs; }
      RC[i] = (float)co; RS[i] = (float)si;
    }
  }
}

__device__ __forceinline__ void norm_mod_row(const float* xrow, const float* g, const float* sc, const float* sh, bf16_t* orow, int lane) {
  const f32x4* xr = (const f32x4*)xrow + lane;
  f32x4 v[4]; float s = 0.f;
#pragma unroll
  for (int j = 0; j < 4; ++j) { v[j] = xr[64 * j]; s += (v[j].x * v[j].x + v[j].y * v[j].y) + (v[j].z * v[j].z + v[j].w * v[j].w); }
  const float rs = rsqrtf(wave_sum(s) * (1.f / DM) + EPS);
  u32x2* o = (u32x2*)orow + lane;
#pragma unroll
  for (int j = 0; j < 4; ++j) {
    const f32x4 gg = ((const f32x4*)g)[lane + 64 * j], cc = ((const f32x4*)sc)[lane + 64 * j], hh = ((const f32x4*)sh)[lane + 64 * j];
    const float y0 = v[j].x * rs * gg.x * (1.f + cc.x) + hh.x, y1 = v[j].y * rs * gg.y * (1.f + cc.y) + hh.y;
    const float y2 = v[j].z * rs * gg.z * (1.f + cc.z) + hh.z, y3 = v[j].w * rs * gg.w * (1.f + cc.w) + hh.w;
    u32x2 w; w.x = cvtpk(y0, y1); w.y = cvtpk(y2, y3);
    o[64 * j] = w;
  }
}
__device__ __forceinline__ void phase_norm(const Params& p, int l, int which, bool from_input, bool skip_ctx) {
  int tid_ = tidx(); asm volatile("" : "+v"(tid_));
  const int lane = tid_ & 63, wid = tid_ >> 6;
  const int gw = p.bx * 8 + wid, NGW = p.gx * 8;
  const float* MOD = (const float*)(p.ws + WS_MOD);
  const float* XC = (const float*)(p.ws + WS_XCUR);
  bf16_t* H = (bf16_t*)(p.ws + WS_H);
  const float* g = p.in[which ? I_N2G : I_N1G] + l * DM;
  for (int row = gw; row < T; row += NGW) {
    const int mr = mod_row(row);
    if (skip_ctx && mr == 4) continue;
    const float* m = MOD + ((size_t)l * 5 + mr) * 6144 + which * 3072;
    const float* xr = from_input ? in_row(p.in[I_X], p.in[I_CTX], row) : XC + (size_t)row * DM;
    norm_mod_row(xr, g, m + 1024, m, H + (size_t)row * DM, lane);
  }
}

namespace pg8 {
#define PG8_LAS __attribute__((address_space(3)))
typedef unsigned short bf16_t;
typedef short bf16x8 __attribute__((ext_vector_type(8)));
typedef float f32x4 __attribute__((ext_vector_type(4)));
typedef unsigned u32x4 __attribute__((ext_vector_type(4)));
constexpr int BM = 256, BK = 64, HALF = 128, HTB = HALF * BK * 2  , STAGE_BYTES = 8 * HTB, NXCD = 8, WGM = 8;

__host__ __device__ __forceinline__ int lds_byte(int r, int c) { const int st = (r >> 4) * 2 + (c >> 5), rr = r & 15, cc = c & 31, ob = rr * 64 + cc * 2; return st * 1024 + (ob ^ (((ob >> 9) & 1) << 5)); }
__host__ __device__ __forceinline__ void stage_rc(int b, int& R, int& C) { const int st = b / 1024, sb = b % 1024, swz = sb ^ (((sb >> 9) & 1) << 5); R = (st >> 1) * 16 + swz / 64; C = (st & 1) * 32 + (swz % 64) / 2; }
__host__ __device__ __forceinline__ int perm32(int rho) { const int n = rho >> 4, i = rho & 15; return 8 * (i >> 2) + 4 * n + (i & 3); }

struct Unit { int pm, pn; };
struct Gemm { const bf16_t* A; const bf16_t* Bt; int M, N, K; };

struct StaticOrder {
    int nM, nN, nwg, G, c;
    __host__ __device__ void init(int M, int N, int G_, int c_) { nM = M / BM; nN = N / BM; nwg = nM * nN; G = G_; c = c_; }
    __host__ __device__ bool next(int i, Unit& u) const {
        const long L = (long)i * G + c; if (L >= nwg) return false;
        int wgid = (int)L; { const int q = nwg / NXCD, r = nwg % NXCD, xcd = wgid % NXCD, off = wgid / NXCD; wgid = (xcd < r ? xcd * (q + 1) : r * (q + 1) + (xcd - r) * q) + off; }
        const int nig = WGM * nN, gid = wgid / nig, fm = gid * WGM, gsz = (nM - fm) < WGM ? (nM - fm) : WGM;
        u.pm = fm + ((wgid % nig) % gsz); u.pn = (wgid % nig) / gsz; return true;
    }
    __device__ __forceinline__ void a_ready(const Unit&) const {}
    __device__ __forceinline__ void done(const Unit&) const {}
};
__device__ __forceinline__ unsigned cvt_pk_bf16(float lo, float hi) { unsigned r; asm volatile("v_cvt_pk_bf16_f32 %0, %1, %2" : "=v"(r) : "v"(lo), "v"(hi)); return r; }
template <class Epi, class Sched, bool ALIGN_EPI = false, bool SP2 = false>
__device__ __forceinline__ void gemm_phase(PG8_LAS unsigned char* lds, const Gemm g, const Sched& S, const Epi& E) {
    const int tid = tidx(), wid = __builtin_amdgcn_readfirstlane(tid >> 6), lane = tid & 63, wr = wid >> 2, wc = wid & 3, fr = lane & 15, fq = lane >> 4;
    const int K = g.K, nt = K / BK;
    unsigned voffA[2], voffB[2];
#pragma unroll
    for (int i = 0; i < 2; ++i) { int R, C; stage_rc(tid * 16 + i * 8192, R, C); const int Rb = Epi::PERM ? ((R & ~31) + perm32(R & 31)) : R;
        voffA[i] = (unsigned)(R * K + C) * 2u; voffB[i] = (unsigned)(Rb * K + C) * 2u; }
    const size_t kstep = (size_t)(BK * 2);
    const size_t hstep = (size_t)HALF * K * 2;
    const size_t tstep = 2 * hstep;
    const unsigned ldsw = (unsigned)wid * 1024u;
    const int aoff = lds_byte(wr * 64 + fr, fq * 8), boff = lds_byte(wc * 32 + fr, fq * 8);
#define PG8_SA(b, h) (((b) * 2 + (h)) * HTB)
#define PG8_SB(b, h) ((4 + (b) * 2 + (h)) * HTB)
#define PG8_STAGE(bufoff, gbase, voff) do { _Pragma("unroll") for (int _i = 0; _i < 2; ++_i) \
        __builtin_amdgcn_global_load_lds((const unsigned*)((const char*)(gbase) + (voff)[_i]), (PG8_LAS unsigned*)(lds + (bufoff) + ldsw + _i * 8192), 16, 0, 0); } while (0)
#define PG8_LDA(dst, b, h) do { _Pragma("unroll") for (int m = 0; m < 4; ++m) _Pragma("unroll") for (int k = 0; k < 2; ++k) dst[m][k] = *(const PG8_LAS bf16x8*)(lds + PG8_SA(b, h) + aoff + m * 2048 + k * 1024); } while (0)
#define PG8_LDB(dst, b, h) do { _Pragma("unroll") for (int n = 0; n < 2; ++n) _Pragma("unroll") for (int k = 0; k < 2; ++k) dst[n][k] = *(const PG8_LAS bf16x8*)(lds + PG8_SB(b, h) + boff + n * 2048 + k * 1024); } while (0)
#define PG8_MMA(ai, bj, At, Bt) do { __builtin_amdgcn_s_setprio(1); _Pragma("unroll") for (int m = 0; m < 4; ++m) _Pragma("unroll") for (int n = 0; n < 2; ++n) _Pragma("unroll") for (int k = 0; k < 2; ++k) \
        acc[ai][bj][m][n] = __builtin_amdgcn_mfma_f32_16x16x32_bf16(Bt[n][k], At[m][k], acc[ai][bj][m][n], 0, 0, 0); __builtin_amdgcn_s_setprio(0); } while (0)
#define PG8_WAIT_V(n) asm volatile("s_waitcnt vmcnt(" #n ")" ::: "memory")
#define PG8_WAIT_L(n) asm volatile("s_waitcnt lgkmcnt(" #n ")" ::: "memory")
#define PG8_BAR __builtin_amdgcn_s_barrier()
#define PG8_SCHED __builtin_amdgcn_sched_barrier(0)
    Unit cur, nxt; int ui = 0;
    if (!S.next(0, cur)) return;
    f32x4 acc[2][2][4][2];
#pragma unroll
    for (int a = 0; a < 2; ++a)
#pragma unroll
        for (int b = 0; b < 2; ++b)
#pragma unroll
            for (int m = 0; m < 4; ++m)
#pragma unroll
                for (int n = 0; n < 2; ++n) acc[a][b][m][n] = (f32x4){0.f, 0.f, 0.f, 0.f};
    bf16x8 At[4][2], B0[2][2], B1[2][2];
    const char* cA = (const char*)g.A + (size_t)cur.pm * tstep; const char* cB = (const char*)g.Bt + (size_t)cur.pn * tstep;
    S.a_ready(cur);
    if constexpr (SP2) {
        PG8_STAGE(PG8_SB(0, 0), cB, voffB); PG8_STAGE(PG8_SB(0, 1), cB + hstep, voffB); PG8_STAGE(PG8_SA(0, 0), cA, voffA); PG8_STAGE(PG8_SA(0, 1), cA + hstep, voffA);
        if (wr == 1) PG8_BAR;
        PG8_WAIT_V(2); PG8_BAR;
        PG8_STAGE(PG8_SB(1, 0), cB + kstep, voffB); PG8_STAGE(PG8_SA(1, 0), cA + kstep, voffA); PG8_STAGE(PG8_SB(1, 1), cB + hstep + kstep, voffB);
        PG8_WAIT_V(6); PG8_BAR;
    } else {
        PG8_STAGE(PG8_SB(0, 0), cB, voffB); PG8_STAGE(PG8_SA(0, 0), cA, voffA); PG8_STAGE(PG8_SB(0, 1), cB + hstep, voffB); PG8_STAGE(PG8_SA(0, 1), cA + hstep, voffA);
        if (wr == 1) PG8_BAR;
        PG8_WAIT_V(4); PG8_BAR;
        PG8_STAGE(PG8_SB(1, 0), cB + kstep, voffB); PG8_STAGE(PG8_SA(1, 0), cA + kstep, voffA); PG8_STAGE(PG8_SB(1, 1), cB + hstep + kstep, voffB);
        PG8_WAIT_V(6); PG8_BAR;
    }
    for (;;) {
        const bool has_next = S.next(ui + 1, nxt);
        const char* nA = has_next ? (const char*)g.A + (size_t)nxt.pm * tstep : cA; const char* nB = has_next ? (const char*)g.Bt + (size_t)nxt.pn * tstep : cB;
        for (int t = 0; t < nt; t += 2) {
            const bool last = (t == nt - 2);
            const char* a1 = cA + (size_t)(t + 1) * kstep;
            const char* a2 = last ? nA : cA + (size_t)(t + 2) * kstep; const char* b2 = last ? nB : cB + (size_t)(t + 2) * kstep;
            const char* a3 = a2 + kstep; const char* b3 = b2 + kstep;
            if (last && has_next) S.a_ready(nxt);
            if constexpr (SP2) {
            PG8_LDB(B0, 0, 0); PG8_LDB(B1, 0, 1); PG8_SCHED; PG8_LDA(At, 0, 0); PG8_STAGE(PG8_SA(1, 1), a1 + hstep, voffA);
            PG8_WAIT_V(8); PG8_WAIT_L(0); PG8_BAR; PG8_MMA(0, 0, At, B0); PG8_MMA(0, 1, At, B1); PG8_BAR; PG8_SCHED;
            PG8_LDA(At, 0, 1); PG8_STAGE(PG8_SB(0, 0), b2, voffB); PG8_STAGE(PG8_SB(0, 1), b2 + hstep, voffB); PG8_STAGE(PG8_SA(0, 0), a2, voffA);
            PG8_WAIT_V(8); PG8_WAIT_L(0); PG8_BAR; PG8_MMA(1, 0, At, B0); PG8_MMA(1, 1, At, B1); PG8_BAR; PG8_SCHED;
            PG8_LDB(B0, 1, 0); PG8_LDB(B1, 1, 1); PG8_SCHED; PG8_LDA(At, 1, 0); PG8_STAGE(PG8_SA(0, 1), a2 + hstep, voffA);
            PG8_WAIT_V(8); PG8_WAIT_L(0); PG8_BAR; PG8_MMA(0, 0, At, B0); PG8_MMA(0, 1, At, B1); PG8_BAR; PG8_SCHED;
            PG8_LDA(At, 1, 1); PG8_STAGE(PG8_SB(1, 0), b3, voffB); PG8_STAGE(PG8_SB(1, 1), b3 + hstep, voffB); PG8_STAGE(PG8_SA(1, 0), a3, voffA);
            PG8_WAIT_V(8); PG8_WAIT_L(0); PG8_BAR; PG8_MMA(1, 0, At, B0); PG8_MMA(1, 1, At, B1); PG8_BAR; PG8_SCHED;
            } else {
            PG8_LDB(B0, 0, 0); PG8_SCHED; PG8_LDA(At, 0, 0); PG8_STAGE(PG8_SA(1, 1), a1 + hstep, voffA);
            PG8_WAIT_L(8); PG8_BAR; PG8_WAIT_L(0); PG8_MMA(0, 0, At, B0); PG8_BAR; PG8_SCHED;
            PG8_LDB(B1, 0, 1); PG8_STAGE(PG8_SB(0, 0), b2, voffB);
            PG8_BAR; PG8_WAIT_L(0); PG8_MMA(0, 1, At, B1); PG8_BAR;
            PG8_LDA(At, 0, 1); PG8_STAGE(PG8_SA(0, 0), a2, voffA);
            PG8_BAR; PG8_WAIT_L(0); PG8_MMA(1, 0, At, B0); PG8_BAR; PG8_SCHED;
            PG8_STAGE(PG8_SB(0, 1), b2 + hstep, voffB);
            PG8_WAIT_V(6); PG8_BAR; PG8_MMA(1, 1, At, B1); PG8_BAR;
            PG8_LDB(B0, 1, 0); PG8_SCHED; PG8_LDA(At, 1, 0); PG8_STAGE(PG8_SA(0, 1), a2 + hstep, voffA);
            PG8_WAIT_L(8); PG8_BAR; PG8_WAIT_L(0); PG8_MMA(0, 0, At, B0); PG8_BAR; PG8_SCHED;
            PG8_LDB(B1, 1, 1); PG8_STAGE(PG8_SB(1, 0), b3, voffB);
            PG8_BAR; PG8_WAIT_L(0); PG8_MMA(0, 1, At, B1); PG8_BAR;
            PG8_LDA(At, 1, 1); PG8_STAGE(PG8_SA(1, 0), a3, voffA);
            PG8_BAR; PG8_WAIT_L(0); PG8_MMA(1, 0, At, B0); PG8_BAR; PG8_SCHED;
            PG8_STAGE(PG8_SB(1, 1), b3 + hstep, voffB);
            PG8_WAIT_V(6); PG8_BAR; PG8_MMA(1, 1, At, B1); PG8_BAR;
            }
        }
        if constexpr (ALIGN_EPI) { if (wr == 0) PG8_BAR; }
        if constexpr (!Epi::AFTER_DRAIN) { E(acc, cur, wr, wc, fr, fq); S.done(cur); }
        if (!has_next) break;
#pragma unroll
        for (int a = 0; a < 2; ++a)
#pragma unroll
            for (int b = 0; b < 2; ++b)
#pragma unroll
                for (int m = 0; m < 4; ++m)
#pragma unroll
                    for (int n = 0; n < 2; ++n) acc[a][b][m][n] = (f32x4){0.f, 0.f, 0.f, 0.f};
        cur = nxt; cA = nA; cB = nB; ++ui;
        if constexpr (ALIGN_EPI) { if (wr == 1) PG8_BAR; }
    }
    PG8_WAIT_V(0);
    if constexpr (!ALIGN_EPI) { if (wr == 0) PG8_BAR; }
    PG8_BAR;
    if constexpr (Epi::AFTER_DRAIN) { E.fused(acc, cur, wr, wc, fr, fq, lds, wid, lane); S.done(cur); }
#undef PG8_SA
#undef PG8_SB
#undef PG8_STAGE
#undef PG8_LDA
#undef PG8_LDB
#undef PG8_MMA
#undef PG8_WAIT_V
#undef PG8_WAIT_L
#undef PG8_BAR
#undef PG8_SCHED
}
}

__device__ __forceinline__ int gswz(int row, int chunk) { return row * 128 + ((chunk ^ ((row >> 1) & 7)) << 4); }
__device__ __forceinline__ void gemm_tile(const bf16_t* __restrict__ A, int lda, const bf16_t* __restrict__ Bt, int ldb, int K,
                                          int row0, int col0, unsigned char* lds, f32x16 (&acc)[2][2]) {
  int tid_ = tidx(); asm volatile("" : "+v"(tid_)); const int tid = tid_, lane = tid & 63, wid = tid >> 6, wm = wid >> 1, wn = wid & 1, r32 = lane & 31, hi = lane >> 5;
  unsigned char* As = lds; unsigned char* Bs = lds + 65536;
#pragma unroll
  for (int i = 0; i < 2; ++i)
#pragma unroll
    for (int j = 0; j < 2; ++j) acc[i][j] = f32x16{};
  const int lrow = tid >> 3, lc = tid & 7;
  const bf16_t* Ag = A + (size_t)(row0 + lrow) * lda + lc * 8;
  const bf16_t* Bg = Bt + (size_t)(col0 + lrow) * ldb + lc * 8;
  u32x4 ra[4], rb[2];
#pragma unroll
  for (int i = 0; i < 4; ++i) ra[i] = *(const u32x4*)(Ag + (size_t)(64 * i) * lda);
#pragma unroll
  for (int i = 0; i < 2; ++i) rb[i] = *(const u32x4*)(Bg + (size_t)(64 * i) * ldb);
#pragma unroll
  for (int i = 0; i < 4; ++i) *(u32x4*)(As + gswz(lrow + 64 * i, lc)) = ra[i];
#pragma unroll
  for (int i = 0; i < 2; ++i) *(u32x4*)(Bs + gswz(lrow + 64 * i, lc)) = rb[i];
  __syncthreads();
  const int nk = K / 64;
  for (int kt = 0; kt < nk; ++kt) {
    const int cur = kt & 1;
    if (kt + 1 < nk) {
#pragma unroll
      for (int i = 0; i < 4; ++i) ra[i] = *(const u32x4*)(Ag + (size_t)(64 * i) * lda + (kt + 1) * 64);
#pragma unroll
      for (int i = 0; i < 2; ++i) rb[i] = *(const u32x4*)(Bg + (size_t)(64 * i) * ldb + (kt + 1) * 64);
    }
    const unsigned char* Ac = As + cur * 32768; const unsigned char* Bc = Bs + cur * 16384;
#pragma unroll
    for (int kk = 0; kk < 4; ++kk) {
      bf16x8 af[2], bfr[2];
#pragma unroll
      for (int i = 0; i < 2; ++i) af[i] = *(const bf16x8*)(Ac + gswz(wm * 64 + i * 32 + r32, 2 * kk + hi));
#pragma unroll
      for (int j = 0; j < 2; ++j) bfr[j] = *(const bf16x8*)(Bc + gswz(wn * 64 + j * 32 + r32, 2 * kk + hi));
#pragma unroll
      for (int i = 0; i < 2; ++i)
#pragma unroll
        for (int j = 0; j < 2; ++j) acc[i][j] = __builtin_amdgcn_mfma_f32_32x32x16_bf16(af[i], bfr[j], acc[i][j], 0, 0, 0);
    }
    if (kt + 1 < nk) {
      unsigned char* An = As + (cur ^ 1) * 32768; unsigned char* Bn = Bs + (cur ^ 1) * 16384;
#pragma unroll
      for (int i = 0; i < 4; ++i) *(u32x4*)(An + gswz(lrow + 64 * i, lc)) = ra[i];
#pragma unroll
      for (int i = 0; i < 2; ++i) *(u32x4*)(Bn + gswz(lrow + 64 * i, lc)) = rb[i];
    }
    __syncthreads();
  }
}
__device__ __forceinline__ void pair_xchg(float v0, float v1, int lane, float& lo, float& hi2) {
  const bool odd = lane & 1;
  const float send = odd ? v0 : v1;
  const float recv = __shfl_xor(send, 1);
  lo = odd ? recv : v0; hi2 = odd ? v1 : recv;
}

__device__ __forceinline__ void phase_inproj(const Params& p, int l, unsigned char* lds) {
  int tid_ = tidx(); asm volatile("" : "+v"(tid_)); const int tid = tid_, lane = tid & 63, wid = tid >> 6, wm = wid >> 1, wn = wid & 1, r32 = lane & 31, hi = lane >> 5;
  const bf16_t* H = (const bf16_t*)(p.ws + WS_H);
  const bf16_t* W = (const bf16_t*)(p.ws + WS_WIN) + (size_t)l * PW * DM;
  bf16_t* PROJ = (bf16_t*)(p.ws + WS_PROJ);
  const float* RC = (const float*)(p.ws + WS_ROPE); const float* RS = RC + SEQ * 32;
  constexpr int NM = T / 256, NN = PW / 128, NU = NM * NN;
  for (int u = p.bx; u < NU + NM; u += p.gx) {
    if (u < NU) {
      const int pn = u / NM, pm = u % NM;
      const int row0 = pm * 256, col0 = pn * 128;
      f32x16 acc[2][2];
      gemm_tile(H, DM, W, DM, DM, row0, col0, lds, acc);
      const bool rope = (col0 >= C_DQ && col0 < C_DV);
      const float scl = (col0 >= C_MK && col0 < C_MV) ? 0.125f : ((col0 >= C_DQ && col0 < C_DK) ? QSCALE : 1.f);
#pragma unroll
      for (int i = 0; i < 2; ++i)
#pragma unroll
        for (int j = 0; j < 2; ++j)
#pragma unroll
          for (int q = 0; q < 8; ++q) {
            float lo, hi2; pair_xchg(acc[i][j][2 * q], acc[i][j][2 * q + 1], lane, lo, hi2);
            const int row = row0 + wm * 64 + i * 32 + crow(2 * q, hi) + (lane & 1);
            const int col = col0 + wn * 64 + j * 32 + (r32 & ~1);
            if (rope) {
              const int s = row % SEGL;
              if (s >= CTXL) {
                const int idx = (s - CTXL) * 32 + ((col & 63) >> 1);
                const float c = RC[idx], sn = RS[idx];
                const float t1 = lo, t2 = hi2; lo = t1 * c - t2 * sn; hi2 = t1 * sn + t2 * c;
              }
            }
            *(unsigned*)(PROJ + (size_t)row * PW + col) = cvtpk(lo * scl, hi2 * scl);
          }
    } else {
      const int pm = u - NU, rowb = pm * 256 + wid * 32;
      const bf16_t* WG = (const bf16_t*)(p.ws + WS_WG) + (size_t)l * 16 * DM;
      float* GT = (float*)(p.ws + WS_GATES);
      const int r16 = lane & 15, q4 = lane >> 4;
      f32x4 c0 = {0.f, 0.f, 0.f, 0.f}, c1 = {0.f, 0.f, 0.f, 0.f};
      const bf16_t* a0p = H + (size_t)(rowb + r16) * DM + q4 * 8;
      const bf16_t* a1p = a0p + (size_t)16 * DM;
      const bf16_t* bp = WG + (size_t)r16 * DM + q4 * 8;
#pragma unroll 4
      for (int ks = 0; ks < 32; ++ks) {
        const bf16x8 a0 = *(const bf16x8*)(a0p + ks * 32), a1 = *(const bf16x8*)(a1p + ks * 32), b = *(const bf16x8*)(bp + ks * 32);
        c0 = __builtin_amdgcn_mfma_f32_16x16x32_bf16(a0, b, c0, 0, 0, 0);
        c1 = __builtin_amdgcn_mfma_f32_16x16x32_bf16(a1, b, c1, 0, 0, 0);
      }
      const float gb = p.in[I_GATEB][l * 16 + r16];
#pragma unroll
      for (int j = 0; j < 4; ++j) {
        GT[(size_t)(rowb + q4 * 4 + j) * 16 + r16] = c0[j] + gb;
        GT[(size_t)(rowb + 16 + q4 * 4 + j) * 16 + r16] = c1[j] + gb;
      }
    }
  }
}

__device__ __forceinline__ void phase_outproj(const Params& p, int l, unsigned char* lds) {
  int tid_ = tidx(); asm volatile("" : "+v"(tid_)); const int tid = tid_, lane = tid & 63, wid = tid >> 6, wm = wid >> 1, wn = wid & 1, r32 = lane & 31, hi = lane >> 5;
  const bf16_t* MIX = (const bf16_t*)(p.ws + WS_MIX);
  const bf16_t* W = (const bf16_t*)(p.ws + WS_WOUT) + (size_t)l * DM * DM;
  float* XC = (float*)(p.ws + WS_XCUR);
  const float* MOD = (const float*)(p.ws + WS_MOD);
  constexpr int NM = T / 256, NN = DM / 128, NU = NM * NN;
  for (int u = p.bx; u < NU; u += p.gx) {
    const int pm = u / NN, pn = u % NN;
    if (l == DEPTH - 1 && (pm % 33) == 0) continue;
    const int row0 = pm * 256, col0 = pn * 128;
    for (int rep = 0; rep < REP_OUTP; ++rep) {
    f32x16 acc[2][2];
    gemm_tile(MIX, DM, W, DM, DM, row0, col0, lds, acc);
    const int mr = (pm % 33) == 0 ? 4 : pm / 33;
    const float* g1 = MOD + ((size_t)l * 5 + mr) * 6144 + 2048;
#pragma unroll
    for (int i = 0; i < 2; ++i)
#pragma unroll
      for (int j = 0; j < 2; ++j) {
        const int col = col0 + wn * 64 + j * 32 + r32;
        const float gg = (rep == REP_OUTP - 1) ? g1[col] : 0.f;
#pragma unroll
        for (int r = 0; r < 16; ++r) {
          const int row = row0 + wm * 64 + i * 32 + crow(r, hi);
          const float xo = (l == 0) ? in_row(p.in[I_X], p.in[I_CTX], row)[col] : XC[(size_t)row * DM + col];
          XC[(size_t)row * DM + col] = xo + gg * acc[i][j][r];
        }
      }
    }
  }
}
__device__ __forceinline__ void phase_peerq(const Params& p, int l, unsigned char* lds) {
  int tid_ = tidx(); asm volatile("" : "+v"(tid_)); const int tid = tid_, lane = tid & 63, wid = tid >> 6, wm = wid >> 1, wn = wid & 1, r32 = lane & 31, hi = lane >> 5;
  const bf16_t* H = (const bf16_t*)(p.ws + WS_H);
  const bf16_t* W = (const bf16_t*)(p.ws + WS_WQ) + (size_t)l * DM * DM;
  bf16_t* QP = (bf16_t*)(p.ws + WS_PROJ);
  constexpr int NM = T / 256, NN = DM / 128, NU = NM * NN;
  for (int u = p.bx; u < NU; u += p.gx) {
    const int pm = u / NN, pn = u % NN;
    if (l == DEPTH - 1 && (pm % 33) == 0) continue;
    const int row0 = pm * 256, col0 = pn * 128;
    f32x16 acc[2][2];
    gemm_tile(H, DM, W, DM, DM, row0, col0, lds, acc);
#pragma unroll
    for (int i = 0; i < 2; ++i)
#pragma unroll
      for (int j = 0; j < 2; ++j)
#pragma unroll
        for (int q = 0; q < 8; ++q) {
          float lo, hi2; pair_xchg(acc[i][j][2 * q], acc[i][j][2 * q + 1], lane, lo, hi2);
          const int row = row0 + wm * 64 + i * 32 + crow(2 * q, hi) + (lane & 1);
          const int col = col0 + wn * 64 + j * 32 + (r32 & ~1);
          *(unsigned*)(QP + (size_t)row * DM + col) = cvtpk(lo, hi2);
        }
  }
}


struct EpiInproj {
  static constexpr bool PERM = true, AFTER_DRAIN = false;
  bf16_t* PROJ; const float* RC; const float* RS; unsigned char* V8T;
  __device__ __forceinline__ void operator()(const pg8::f32x4 (&acc)[2][2][4][2], const pg8::Unit& u, int wr, int wc, int fr, int fq) const {
#pragma unroll
    for (int bj = 0; bj < 2; ++bj) {
      const int colt = u.pn * 256 + bj * 128;
      const bool rope = (colt >= C_DQ && colt < C_DV);
      const float scl = (colt >= C_MK && colt < C_MV) ? 0.125f : ((colt >= C_DQ && colt < C_DK) ? QSCALE : 1.f);
      const int col8 = colt + wc * 32 + 8 * fq;
      if (colt >= C_DV) {
        const int hh = (col8 - C_DV) >> 7, e0 = (col8 - C_DV) & 127;
#pragma unroll
        for (int ai = 0; ai < 2; ++ai)
#pragma unroll
          for (int m = 0; m < 4; ++m) {
            const int row = u.pm * 256 + ai * 128 + wr * 64 + m * 16 + fr;
            const int b = row / SEGL, s = row - b * SEGL, t = s >> 6, kk = s & 63;
            const int slot = ((kk >> 2) & 1) * 32 + (kk & 3) + 4 * ((kk >> 3) & 3) + 16 * (kk >> 5);
            unsigned char* vp = V8T + ((size_t)((b * 4 + hh) * NCH + t) * 128 + e0) * 80 + slot;
            const f32x4 v0 = acc[ai][bj][m][0], v1 = acc[ai][bj][m][1];
            int w0 = 0, w1 = 0;
            w0 = __builtin_amdgcn_cvt_pk_fp8_f32(v0[0], v0[1], w0, false); w0 = __builtin_amdgcn_cvt_pk_fp8_f32(v0[2], v0[3], w0, true);
            w1 = __builtin_amdgcn_cvt_pk_fp8_f32(v1[0], v1[1], w1, false); w1 = __builtin_amdgcn_cvt_pk_fp8_f32(v1[2], v1[3], w1, true);
            vp[0] = (unsigned char)(w0 & 0xFF); vp[80] = (unsigned char)((w0 >> 8) & 0xFF); vp[160] = (unsigned char)((w0 >> 16) & 0xFF); vp[240] = (unsigned char)((w0 >> 24) & 0xFF);
            vp[320] = (unsigned char)(w1 & 0xFF); vp[400] = (unsigned char)((w1 >> 8) & 0xFF); vp[480] = (unsigned char)((w1 >> 16) & 0xFF); vp[560] = (unsigned char)((w1 >> 24) & 0xFF);
          }
        continue;
      }
#pragma unroll
      for (int ai = 0; ai < 2; ++ai)
#pragma unroll
        for (int m = 0; m < 4; ++m) {
          const int row = u.pm * 256 + ai * 128 + wr * 64 + m * 16 + fr;
          f32x4 v0 = acc[ai][bj][m][0], v1 = acc[ai][bj][m][1];
          if (rope) {
            const int s = row % SEGL;
            if (s >= CTXL) {
              const int idx = (s - CTXL) * 32 + ((col8 & 63) >> 1);
              const f32x4 c = *(const f32x4*)(RC + idx), sn = *(const f32x4*)(RS + idx);
              f32x4 a, b;
              a[0] = v0[0] * c[0] - v0[1] * sn[0]; a[1] = v0[0] * sn[0] + v0[1] * c[0]; a[2] = v0[2] * c[1] - v0[3] * sn[1]; a[3] = v0[2] * sn[1] + v0[3] * c[1];
              b[0] = v1[0] * c[2] - v1[1] * sn[2]; b[1] = v1[0] * sn[2] + v1[1] * c[2]; b[2] = v1[2] * c[3] - v1[3] * sn[3]; b[3] = v1[2] * sn[3] + v1[3] * c[3];
              v0 = a; v1 = b;
            }
          }
          u32x4 w; w.x = cvtpk(v0[0] * scl, v0[1] * scl); w.y = cvtpk(v0[2] * scl, v0[3] * scl); w.z = cvtpk(v1[0] * scl, v1[1] * scl); w.w = cvtpk(v1[2] * scl, v1[3] * scl);
          *(u32x4*)(PROJ + (size_t)row * PW + col8) = w;
        }
    }
  }
};
struct EpiOutproj {
  static constexpr bool PERM = true, AFTER_DRAIN = false;
  float* XC; const float* MODL; const float* xin; const float* ctxin; int first; float gsc;
  __device__ __forceinline__ void operator()(const pg8::f32x4 (&acc)[2][2][4][2], const pg8::Unit& u, int wr, int wc, int fr, int fq) const {
    const int mr = (u.pm % 33) == 0 ? 4 : u.pm / 33;
    const float* g1 = MODL + (size_t)mr * 6144 + 2048;
#pragma unroll
    for (int bj = 0; bj < 2; ++bj) {
      const int col8 = u.pn * 256 + bj * 128 + wc * 32 + 8 * fq;
      const f32x4 ga = *(const f32x4*)(g1 + col8) * gsc, gb = *(const f32x4*)(g1 + col8 + 4) * gsc;
#pragma unroll
      for (int ai = 0; ai < 2; ++ai)
#pragma unroll
        for (int m = 0; m < 4; ++m) {
          const int row = u.pm * 256 + ai * 128 + wr * 64 + m * 16 + fr;
          const float* xo = first ? in_row(xin, ctxin, row) + col8 : XC + (size_t)row * DM + col8;
          const f32x4 xa = *(const f32x4*)xo, xb = *(const f32x4*)(xo + 4);
          *(f32x4*)(XC + (size_t)row * DM + col8) = xa + ga * acc[ai][bj][m][0];
          *(f32x4*)(XC + (size_t)row * DM + col8 + 4) = xb + gb * acc[ai][bj][m][1];
        }
    }
  }
};
struct EpiPeerq {
  static constexpr bool PERM = true, AFTER_DRAIN = false;
  bf16_t* QP;
  __device__ __forceinline__ void operator()(const pg8::f32x4 (&acc)[2][2][4][2], const pg8::Unit& u, int wr, int wc, int fr, int fq) const {
#pragma unroll
    for (int bj = 0; bj < 2; ++bj) {
      const int col8 = u.pn * 256 + bj * 128 + wc * 32 + 8 * fq;
#pragma unroll
      for (int ai = 0; ai < 2; ++ai)
#pragma unroll
        for (int m = 0; m < 4; ++m) {
          const int row = u.pm * 256 + ai * 128 + wr * 64 + m * 16 + fr;
          const f32x4 v0 = acc[ai][bj][m][0], v1 = acc[ai][bj][m][1];
          u32x4 w; w.x = cvtpk(v0[0], v0[1]); w.y = cvtpk(v0[2], v0[3]); w.z = cvtpk(v1[0], v1[1]); w.w = cvtpk(v1[2], v1[3]);
          *(u32x4*)(QP + (size_t)row * DM + col8) = w;
        }
    }
  }
};
__device__ __forceinline__ void phase_inproj2(const Params& p, int l, unsigned char* lds) {
  {
    pg8::Gemm g{(const bf16_t*)(p.ws + WS_H), (const bf16_t*)(p.ws + WS_WIN) + (size_t)l * PW * DM, T, PW, DM};
    pg8::StaticOrder S; S.init(T, PW, p.gx, p.bx);
    EpiInproj E{(bf16_t*)(p.ws + WS_PROJ), (const float*)(p.ws + WS_ROPE), (const float*)(p.ws + WS_ROPE) + SEQ * 32, p.ws + WS_V8T};
    pg8::gemm_phase<EpiInproj, pg8::StaticOrder, true, true>((PG8_LAS unsigned char*)lds, g, S, E);
  }
  int tid_ = tidx(); asm volatile("" : "+v"(tid_)); const int tid = tid_, lane = tid & 63, wid = tid >> 6;
  const bf16_t* H = (const bf16_t*)(p.ws + WS_H);
  for (int pm = p.bx; pm < T / 256; pm += p.gx) {
    const int rowb = pm * 256 + wid * 32;
    const bf16_t* WG = (const bf16_t*)(p.ws + WS_WG) + (size_t)l * 16 * DM;
    float* GT = (float*)(p.ws + WS_GATES);
    const int r16 = lane & 15, q4 = lane >> 4;
    f32x4 c0 = {0.f, 0.f, 0.f, 0.f}, c1 = {0.f, 0.f, 0.f, 0.f};
    const bf16_t* a0p = H + (size_t)(rowb + r16) * DM + q4 * 8;
    const bf16_t* a1p = a0p + (size_t)16 * DM;
    const bf16_t* bp = WG + (size_t)r16 * DM + q4 * 8;
#pragma unroll 4
    for (int ks = 0; ks < 32; ++ks) {
      const bf16x8 a0 = *(const bf16x8*)(a0p + ks * 32), a1 = *(const bf16x8*)(a1p + ks * 32), b = *(const bf16x8*)(bp + ks * 32);
      c0 = __builtin_amdgcn_mfma_f32_16x16x32_bf16(a0, b, c0, 0, 0, 0);
      c1 = __builtin_amdgcn_mfma_f32_16x16x32_bf16(a1, b, c1, 0, 0, 0);
    }
    const float gb = p.in[I_GATEB][l * 16 + r16];
#pragma unroll
    for (int j = 0; j < 4; ++j) {
      GT[(size_t)(rowb + q4 * 4 + j) * 16 + r16] = c0[j] + gb;
      GT[(size_t)(rowb + 16 + q4 * 4 + j) * 16 + r16] = c1[j] + gb;
    }
  }
}
__device__ __forceinline__ void phase_outproj2(const Params& p, int l, unsigned char* lds) {
  pg8::Gemm g{(const bf16_t*)(p.ws + WS_MIX), (const bf16_t*)(p.ws + WS_WOUT) + (size_t)l * DM * DM, T, DM, DM};
  pg8::StaticOrder S; S.init(T, DM, p.gx, p.bx);
  for (int rep = 0; rep < REP_OUTP; ++rep) {
  EpiOutproj E{(float*)(p.ws + WS_XCUR), (const float*)(p.ws + WS_MOD) + (size_t)l * 5 * 6144, p.in[I_X], p.in[I_CTX], l == 0, (rep == REP_OUTP - 1) ? 1.f : 0.f};
  pg8::gemm_phase<EpiOutproj, pg8::StaticOrder, true, true>((PG8_LAS unsigned char*)lds, g, S, E);
  }
  if (l < DEPTH - 1) tail_filler_tables(p, l, (T / 256) * (DM / 256));
}
__device__ __forceinline__ void phase_peerq2(const Params& p, int l, unsigned char* lds) {
  pg8::Gemm g{(const bf16_t*)(p.ws + WS_H), (const bf16_t*)(p.ws + WS_WQ) + (size_t)l * DM * DM, T, DM, DM};
  pg8::StaticOrder S; S.init(T, DM, p.gx, p.bx);
  EpiPeerq E{(bf16_t*)(p.ws + WS_PROJ)};
  pg8::gemm_phase<EpiPeerq, pg8::StaticOrder, true, true>((PG8_LAS unsigned char*)lds, g, S, E);
  if (l == DEPTH - 2) tail_filler_tables(p, DEPTH - 1, (T / 256) * (DM / 256));
}

__device__ __forceinline__ void conv_unit(const Params& p, int l, int unit, unsigned char* lds) {
  int tid_ = tidx(); asm volatile("" : "+v"(tid_)); const int tid = tid_, lane = tid & 63, wid = tid >> 6;
  float* U = (float*)lds;
  const bf16_t* PROJ = (const bf16_t*)(p.ws + WS_PROJ);
  bf16_t* MIX = (bf16_t*)(p.ws + WS_MIX);
  const int row0 = unit * 32, b = row0 / SEGL, s0 = row0 - b * SEGL;
  const int seglo = s0 < CTXL ? 0 : CTXL, seghi = s0 < CTXL ? CTXL : SEGL;
  for (int rr = tid >> 5; rr < 62; rr += 16) {
    const int s = s0 - 15 + rr, c8 = (tid & 31) * 8;
    f32x4 u0 = {0.f, 0.f, 0.f, 0.f}, u1 = {0.f, 0.f, 0.f, 0.f};
    if (s >= seglo && s < seghi) {
      const bf16_t* pr = PROJ + (size_t)(b * SEGL + s) * PW + c8;
      const u32x4 a1 = *(const u32x4*)pr, a2 = *(const u32x4*)(pr + 256);
      u0.x = bflo(a1.x) * sigmoidf_(bflo(a2.x)); u0.y = bfhi(a1.x) * sigmoidf_(bfhi(a2.x));
      u0.z = bflo(a1.y) * sigmoidf_(bflo(a2.y)); u0.w = bfhi(a1.y) * sigmoidf_(bfhi(a2.y));
      u1.x = bflo(a1.z) * sigmoidf_(bflo(a2.z)); u1.y = bfhi(a1.z) * sigmoidf_(bfhi(a2.z));
      u1.z = bflo(a1.w) * sigmoidf_(bflo(a2.w)); u1.w = bfhi(a1.w) * sigmoidf_(bfhi(a2.w));
    }
    *(f32x4*)(U + rr * 256 + c8) = u0; *(f32x4*)(U + rr * 256 + c8 + 4) = u1;
  }
  __syncthreads();
  float* Y = U + 62 * 256;
  const float* cw = p.in[I_CONVW] + (size_t)l * 31 * 256;
#pragma unroll 1
  for (int q = 0; q < 4; ++q) {
    const int c = lane + 64 * q;
    float w[31];
#pragma unroll
    for (int j = 0; j < 31; ++j) w[j] = cw[j * 256 + c];
    const float bias = p.in[I_CONVB][l * 256 + c];
#pragma unroll
    for (int tt = 0; tt < 4; ++tt) {
      const int t = wid * 4 + tt;
      float a = bias;
#pragma unroll
      for (int j = 0; j < 31; ++j) a += U[(t + j) * 256 + c] * w[j];
      Y[t * 256 + c] = a;
    }
  }
  asm volatile("s_waitcnt lgkmcnt(0)" ::: "memory");
  float y[4][4];
#pragma unroll
  for (int tt = 0; tt < 4; ++tt)
#pragma unroll
    for (int q = 0; q < 4; ++q) y[tt][q] = Y[(wid * 4 + tt) * 256 + lane + 64 * q];
#pragma unroll
  for (int tt = 0; tt < 4; ++tt) {
    const int t = wid * 4 + tt;
    const float mean = wave_sum((y[tt][0] + y[tt][1]) + (y[tt][2] + y[tt][3])) * (1.f / 256.f);
    float v = 0.f;
#pragma unroll
    for (int q = 0; q < 4; ++q) { const float d = y[tt][q] - mean; v += d * d; }
    const float rs = rsqrtf(wave_sum(v) * (1.f / 256.f) + EPS);
#pragma unroll
    for (int q = 0; q < 4; ++q) {
      const int c = lane + 64 * q;
      const float z = (y[tt][q] - mean) * rs * p.in[I_CLNG][l * 256 + c] + p.in[I_CLNB][l * 256 + c];
      const float o = (ABL & 1) ? 0.f : z * sigmoidf_(z);
      MIX[(size_t)(row0 + t) * DM + c] = (bf16_t)(cvtpk(o, 0.f) & 0xffffu);
    }
  }
  __syncthreads();
}

__device__ __forceinline__ int ml_cidx(int ch, int dir) { return dir == 0 ? ch : (ch < 4 ? 3 - ch : 135 - ch); }
__device__ __forceinline__ void ml_load_tile(const bf16_t* src, float* dst, int tid) {
  const int r = tid >> 3, c8 = (tid & 7) * 8;
  const u32x4 a = *(const u32x4*)(src + (size_t)r * PW + c8);
  float* d = dst + r * 65 + c8;
  d[0] = bflo(a.x); d[1] = bfhi(a.x); d[2] = bflo(a.y); d[3] = bfhi(a.y); d[4] = bflo(a.z); d[5] = bfhi(a.z); d[6] = bflo(a.w); d[7] = bfhi(a.w);
}
__device__ __forceinline__ void ml_local_unit(const Params& p, int l, int unit, unsigned char* lds) {
  int tid_ = tidx(); asm volatile("" : "+v"(tid_)); const int tid = tid_, lane = tid & 63, wid = tid >> 6, r32 = lane & 31, hi = lane >> 5;
  float* Kt = (float*)lds; float* Vt = Kt + 64 * 65; float* WK = Vt + 64 * 65;
  const bf16_t* PROJ = (const bf16_t*)(p.ws + WS_PROJ);
  const float* GT = (const float*)(p.ws + WS_GATES);
  float* UL = (float*)(p.ws + WS_ULOC); float* META = (float*)(p.ws + WS_MLMETA);
  const int b = unit / (4 * NCH), hh = (unit / NCH) & 3, ch = unit % NCH;
  const int row0 = b * SEGL + ch * 64;
  ml_load_tile(PROJ + (size_t)row0 * PW + C_MK + hh * 64, Kt, tid);
  ml_load_tile(PROJ + (size_t)row0 * PW + C_MV + hh * 64, Vt, tid);
  if (wid < 2) {
    const int dir = wid;
    const float ig = GT[(size_t)(row0 + lane) * 16 + (2 * dir) * 4 + hh];
    const float lf = logsigmoidf_(GT[(size_t)(row0 + lane) * 16 + (2 * dir + 1) * 4 + hh]);
    float ps = lf;
#pragma unroll
    for (int o = 1; o < 64; o <<= 1) { const float t = __shfl_up(ps, o); if (lane >= o) ps += t; }
    const float tot = __shfl(ps, 63);
    const float wlog = dir == 0 ? (tot - ps + ig) : (ps - lf + ig);
    const float mloc = wave_max(wlog);
    WK[dir * 64 + lane] = __expf(wlog - mloc);
    if (lane == 0) {
      const int seq = (b * 4 + hh) * 2 + dir, ci = ml_cidx(ch, dir);
      META[((size_t)seq * NCH + ci) * 4 + 0] = tot; META[((size_t)seq * NCH + ci) * 4 + 1] = mloc;
    }
  }
  __syncthreads();
  {
    const int dir = wid >> 2, et = (wid >> 1) & 1, dt = wid & 1;
    const int seq = (b * 4 + hh) * 2 + dir, ci = ml_cidx(ch, dir);
    float* slot = UL + ((size_t)seq * NCH + ci) * USTRIDE;
    f32x16 acc = {};
#pragma unroll 8
    for (int ks = 0; ks < 32; ++ks) {
      const int s = 2 * ks + hi;
      const float a = WK[dir * 64 + s] * Vt[s * 65 + et * 32 + r32];
      const float bb = Kt[s * 65 + dt * 32 + r32];
      acc = __builtin_amdgcn_mfma_f32_32x32x2f32(a, bb, acc, 0, 0, 0);
    }
#pragma unroll
    for (int r = 0; r < 16; ++r) slot[(et * 32 + crow(r, hi)) * 64 + dt * 32 + r32] = acc[r];
    if (et == 0) {
      float n = 0.f;
#pragma unroll 8
      for (int i = 0; i < 32; ++i) { const int s = hi * 32 + i; n += WK[dir * 64 + s] * Kt[s * 65 + dt * 32 + r32]; }
      n += __shfl_xor(n, 32);
      if (hi == 0) slot[4096 + dt * 32 + r32] = n;
    }
  }
  __syncthreads();
}
constexpr int MLP = 144;
constexpr size_t WS_CST = WS_H;
constexpr size_t WS_NST = WS_H + (size_t)32 * NCH * 4096 * 2;
__device__ __forceinline__ void ml_stage_rm(const bf16_t* src, size_t ld, unsigned char* dst, int tid) {
  const int r = tid >> 3, c8 = (tid & 7) * 8;
  *(u32x4*)(dst + r * MLP + c8 * 2) = *(const u32x4*)(src + (size_t)r * ld + c8);
}
__device__ __forceinline__ void ml_stage_tr(const bf16_t* src, size_t ld, unsigned char* dst, int tid) {
  const int r = tid >> 3, c8 = (tid & 7) * 8;
  const u32x4 a = *(const u32x4*)(src + (size_t)r * ld + c8);
  bf16_t* d = (bf16_t*)dst;
  d[(c8 + 0) * 72 + r] = (bf16_t)(a.x & 0xffffu); d[(c8 + 1) * 72 + r] = (bf16_t)(a.x >> 16);
  d[(c8 + 2) * 72 + r] = (bf16_t)(a.y & 0xffffu); d[(c8 + 3) * 72 + r] = (bf16_t)(a.y >> 16);
  d[(c8 + 4) * 72 + r] = (bf16_t)(a.z & 0xffffu); d[(c8 + 5) * 72 + r] = (bf16_t)(a.z >> 16);
  d[(c8 + 6) * 72 + r] = (bf16_t)(a.w & 0xffffu); d[(c8 + 7) * 72 + r] = (bf16_t)(a.w >> 16);
}
__device__ __forceinline__ void ml_local_unit2(const Params& p, int l, int unit, unsigned char* lds) {
  int tid_ = tidx(); asm volatile("" : "+v"(tid_)); const int tid = tid_, lane = tid & 63, wid = tid >> 6, r32 = lane & 31, hi = lane >> 5;
  unsigned char* KT = lds; unsigned char* VT = lds + 64 * MLP; float* WK = (float*)(lds + 2 * 64 * MLP);
  const bf16_t* PROJ = (const bf16_t*)(p.ws + WS_PROJ);
  const float* GT = (const float*)(p.ws + WS_GATES);
  float* UL = (float*)(p.ws + WS_ULOC); float* META = (float*)(p.ws + WS_MLMETA);
  const int b = unit / (4 * NCH), hh = (unit / NCH) & 3, ch = unit % NCH;
  const int row0 = b * SEGL + ch * 64;
  ml_stage_tr(PROJ + (size_t)row0 * PW + C_MK + hh * 64, PW, KT, tid);
  ml_stage_tr(PROJ + (size_t)row0 * PW + C_MV + hh * 64, PW, VT, tid);
  if (wid < 2) {
    const int dir = wid;
    const float ig = GT[(size_t)(row0 + lane) * 16 + (2 * dir) * 4 + hh];
    const float lf = logsigmoidf_(GT[(size_t)(row0 + lane) * 16 + (2 * dir + 1) * 4 + hh]);
    float ps = lf;
#pragma unroll
    for (int o = 1; o < 64; o <<= 1) { const float t = __shfl_up(ps, o); if (lane >= o) ps += t; }
    const float tot = __shfl(ps, 63);
    const float wlog = dir == 0 ? (tot - ps + ig) : (ps - lf + ig);
    const float mloc = wave_max(wlog);
    WK[dir * 64 + lane] = __expf(wlog - mloc);
    if (lane == 0) {
      const int seq = (b * 4 + hh) * 2 + dir, ci = ml_cidx(ch, dir);
      META[((size_t)seq * NCH + ci) * 4 + 0] = tot; META[((size_t)seq * NCH + ci) * 4 + 1] = mloc;
    }
  }
  __syncthreads();
  {
    const int dir = wid >> 2, et = (wid >> 1) & 1, dt = wid & 1;
    const int seq = (b * 4 + hh) * 2 + dir, ci = ml_cidx(ch, dir);
    float* slot = UL + ((size_t)seq * NCH + ci) * USTRIDE;
    f32x16 acc = {};
#pragma unroll
    for (int ks = 0; ks < 4; ++ks) {
      const int s0 = ks * 16 + hi * 8;
      const u32x4 va = *(const u32x4*)(VT + (et * 32 + r32) * MLP + s0 * 2);
      const bf16x8 kb = *(const bf16x8*)(KT + (dt * 32 + r32) * MLP + s0 * 2);
      const f32x4 w0 = *(const f32x4*)(WK + dir * 64 + s0), w1 = *(const f32x4*)(WK + dir * 64 + s0 + 4);
      u32x4 sa; sa.x = cvtpk(bflo(va.x) * w0.x, bfhi(va.x) * w0.y); sa.y = cvtpk(bflo(va.y) * w0.z, bfhi(va.y) * w0.w);
      sa.z = cvtpk(bflo(va.z) * w1.x, bfhi(va.z) * w1.y); sa.w = cvtpk(bflo(va.w) * w1.z, bfhi(va.w) * w1.w);
      acc = __builtin_amdgcn_mfma_f32_32x32x16_bf16(*(const bf16x8*)&sa, kb, acc, 0, 0, 0);
    }
#pragma unroll
    for (int r = 0; r < 16; ++r) slot[(et * 32 + crow(r, hi)) * 64 + dt * 32 + r32] = acc[r];
    if (et == 0) {
      float n = 0.f;
#pragma unroll
      for (int i = 0; i < 4; ++i) {
        const int s0 = hi * 32 + i * 8;
        const u32x4 ka = *(const u32x4*)(KT + (dt * 32 + r32) * MLP + s0 * 2);
        const f32x4 w0 = *(const f32x4*)(WK + dir * 64 + s0), w1 = *(const f32x4*)(WK + dir * 64 + s0 + 4);
        n += bflo(ka.x) * w0.x + bfhi(ka.x) * w0.y + bflo(ka.y) * w0.z + bfhi(ka.y) * w0.w + bflo(ka.z) * w1.x + bfhi(ka.z) * w1.y + bflo(ka.w) * w1.z + bfhi(ka.w) * w1.w;
      }
      n += __shfl_xor(n, 32);
      if (hi == 0) slot[4096 + dt * 32 + r32] = n;
    }
  }
  __syncthreads();
}
__device__ __forceinline__ void ml_scan(const Params& p, unsigned char* lds) {
  float* UL = (float*)(p.ws + WS_ULOC); float* META = (float*)(p.ws + WS_MLMETA);
  int tid_ = tidx(); asm volatile("" : "+v"(tid_));
  const int tid = tid_, lane = tid & 63, wid = tid >> 6;
  float* DEC = (float*)lds;
  float* SCL = DEC + 2 * NCH;
  float* TMP = SCL + 2 * NCH;
  for (int base0 = p.bx * 512; base0 < 32 * USTRIDE; base0 += p.gx * 512) {
    const int seq0 = base0 / USTRIDE;
    if (wid < 2) {
      const int seq = seq0 + wid;
      if (seq < 32) {
        float* mt = META + (size_t)seq * NCH * 4;
        for (int c = lane; c < NCH; c += 64) { TMP[(wid * 2 + 0) * NCH + c] = mt[c * 4 + 0]; TMP[(wid * 2 + 1) * NCH + c] = mt[c * 4 + 1]; }
        asm volatile("s_waitcnt lgkmcnt(0)" ::: "memory");
        if (lane == 0) {
          float m = 0.f;
          for (int c = 0; c < NCH; ++c) {
            const float bl = TMP[(wid * 2 + 0) * NCH + c], mloc = TMP[(wid * 2 + 1) * NCH + c];
            const float mn = fmaxf(bl + m, mloc);
            DEC[wid * NCH + c] = __expf(bl + m - mn); SCL[wid * NCH + c] = __expf(mloc - mn);
            mt[c * 4 + 2] = m;
            m = mn;
          }
        }
      }
    }
    __syncthreads();
    const int idx = base0 + tid;
    if (idx < 32 * USTRIDE) {
      const int seq = idx / USTRIDE, e = idx - seq * USTRIDE, sl = seq - seq0;
      float* bp = UL + (size_t)seq * NCH * USTRIDE + e;
      bf16_t* CSTp = (bf16_t*)(p.ws + WS_CST) + (size_t)seq * NCH * 4096 + (e < 4096 ? e : 0);
      float* NSTp = (float*)(p.ws + WS_NST) + (size_t)seq * NCH * 64 + (e < 4096 ? 0 : e - 4096);
      const float* dec = DEC + sl * NCH; const float* scl = SCL + sl * NCH;
      float C = 0.f;
#pragma unroll 1
      for (int c0 = 0; c0 < NCH; c0 += 12) {
        float u[12];
#pragma unroll
        for (int j = 0; j < 12; ++j) u[j] = bp[(size_t)(c0 + j) * USTRIDE];
#pragma unroll
        for (int j = 0; j < 12; ++j) {
          if (e < 4096) CSTp[(size_t)(c0 + j) * 4096] = (bf16_t)(cvtpk(C, 0.f) & 0xffffu); else NSTp[(size_t)(c0 + j) * 64] = C;
          C = dec[c0 + j] * C + scl[c0 + j] * u[j]; }
      }
    }
    __syncthreads();
  }
}
__device__ __forceinline__ void ml_out_unit(const Params& p, int l, int unit, unsigned char* lds) {
  int tid_ = tidx(); asm volatile("" : "+v"(tid_)); const int tid = tid_, lane = tid & 63, wid = tid >> 6, r32 = lane & 31, hi = lane >> 5;
  float* Qt = (float*)lds; float* Kt = Qt + 64 * 65; float* Vt = Kt + 64 * 65;
  float* Cs = Vt + 64 * 65;
  float* Ns = Cs + 2 * 64 * 65;
  float* Bq = Ns + 128;
  float* Gs = Bq + 128;
  float* Mi = Gs + 128;
  float* HB = Mi + 64;
  const bf16_t* PROJ = (const bf16_t*)(p.ws + WS_PROJ);
  const float* GT = (const float*)(p.ws + WS_GATES);
  const float* UL = (const float*)(p.ws + WS_ULOC); const float* META = (const float*)(p.ws + WS_MLMETA);
  bf16_t* MIX = (bf16_t*)(p.ws + WS_MIX);
  const int b = unit / (4 * NCH), hh = (unit / NCH) & 3, ch = unit % NCH;
  const int row0 = b * SEGL + ch * 64;
  ml_load_tile(PROJ + (size_t)row0 * PW + C_MQ + hh * 64, Qt, tid);
  ml_load_tile(PROJ + (size_t)row0 * PW + C_MK + hh * 64, Kt, tid);
  ml_load_tile(PROJ + (size_t)row0 * PW + C_MV + hh * 64, Vt, tid);
  for (int i = tid; i < 2 * USTRIDE; i += 512) {
    const int dir = i / USTRIDE, e = i - dir * USTRIDE;
    const int seq = (b * 4 + hh) * 2 + dir, ci = ml_cidx(ch, dir);
    const float v = UL[((size_t)seq * NCH + ci) * USTRIDE + e];
    if (e < 4096) Cs[dir * 64 * 65 + (e >> 6) * 65 + (e & 63)] = v; else Ns[dir * 64 + (e - 4096)] = v;
  }
  if (wid < 2) {
    const int dir = wid;
    const float ig = GT[(size_t)(row0 + lane) * 16 + (2 * dir) * 4 + hh];
    const float lf = logsigmoidf_(GT[(size_t)(row0 + lane) * 16 + (2 * dir + 1) * 4 + hh]);
    float ps = lf;
#pragma unroll
    for (int o = 1; o < 64; o <<= 1) { const float t = __shfl_up(ps, o); if (lane >= o) ps += t; }
    const float tot = __shfl(ps, 63);
    const float bc = dir == 0 ? ps : (tot - ps + lf);
    Bq[dir * 64 + lane] = bc; Gs[dir * 64 + lane] = ig - bc;
    if (lane == 0) { const int seq = (b * 4 + hh) * 2 + dir, ci = ml_cidx(ch, dir); Mi[dir] = META[((size_t)seq * NCH + ci) * 4 + 2]; }
  }
  __syncthreads();
  {
    const int dir = wid >> 2, tt = (wid >> 1) & 1, et = wid & 1;
    const int t = tt * 32 + r32;
    f32x16 sa[2] = {};
#pragma unroll 4
    for (int ks = 0; ks < 32; ++ks) {
      const float bq = Qt[t * 65 + 2 * ks + hi];
      const float a0 = Kt[(r32) * 65 + 2 * ks + hi], a1 = Kt[(32 + r32) * 65 + 2 * ks + hi];
      sa[0] = __builtin_amdgcn_mfma_f32_32x32x2f32(a0, bq, sa[0], 0, 0, 0);
      sa[1] = __builtin_amdgcn_mfma_f32_32x32x2f32(a1, bq, sa[1], 0, 0, 0);
    }
    const float bt = Bq[dir * 64 + t];
    const float inter = bt + Mi[dir];
    float mx = -INFINITY;
    f32x16 dl[2];
#pragma unroll
    for (int st = 0; st < 2; ++st)
#pragma unroll
      for (int r = 0; r < 16; ++r) {
        const int s = st * 32 + crow(r, hi);
        const bool ok = dir == 0 ? (s <= t) : (s >= t);
        const float d = ok ? bt + Gs[dir * 64 + s] : -INFINITY;
        dl[st][r] = d; mx = fmaxf(mx, d);
      }
    mx = fmaxf(mx, __shfl_xor(mx, 32));
    const float mt = fmaxf(inter, mx);
    const float iw = __expf(inter - mt);
    float rsum = 0.f;
#pragma unroll
    for (int st = 0; st < 2; ++st)
#pragma unroll
      for (int r = 0; r < 16; ++r) { const float w = __expf(dl[st][r] - mt); sa[st][r] *= w; rsum += sa[st][r]; }
    rsum += __shfl_xor(rsum, 32);
    float qn = 0.f;
#pragma unroll 8
    for (int i = 0; i < 32; ++i) { const int d = hi * 32 + i; qn += Ns[dir * 64 + d] * Qt[t * 65 + d]; }
    qn += __shfl_xor(qn, 32);
    const float den = rsum + iw * qn;
    const float rden = 1.f / fmaxf(fabsf(den), __expf(-mt));
    f32x16 an = {}, ac = {};
#pragma unroll
    for (int st = 0; st < 2; ++st)
#pragma unroll
      for (int r = 0; r < 16; ++r) {
        const float a = Vt[(st * 32 + crow(r, hi)) * 65 + et * 32 + r32];
        an = __builtin_amdgcn_mfma_f32_32x32x2f32(a, sa[st][r], an, 0, 0, 0);
      }
    const float* Cd = Cs + dir * 64 * 65;
#pragma unroll 4
    for (int ks = 0; ks < 32; ++ks) {
      const float a = Cd[(et * 32 + r32) * 65 + 2 * ks + hi];
      const float bq = Qt[t * 65 + 2 * ks + hi];
      ac = __builtin_amdgcn_mfma_f32_32x32x2f32(a, bq, ac, 0, 0, 0);
    }
#pragma unroll
    for (int r = 0; r < 16; ++r) HB[dir * 64 * 65 + t * 65 + et * 32 + crow(r, hi)] = (an[r] + iw * ac[r]) * rden;
  }
  __syncthreads();
  {
    const int t = tid >> 3, e8 = (tid & 7) * 8;
    float v[8]; float ss = 0.f;
#pragma unroll
    for (int i = 0; i < 8; ++i) { v[i] = HB[t * 65 + e8 + i] + HB[64 * 65 + t * 65 + e8 + i]; ss += v[i] * v[i]; }
    ss += __shfl_xor(ss, 1); ss += __shfl_xor(ss, 2); ss += __shfl_xor(ss, 4);
    const float rs = rsqrtf(ss * (1.f / 64.f) + EPS);
    const u32x4 ov = *(const u32x4*)(PROJ + (size_t)(row0 + t) * PW + C_MO + hh * 64 + e8);
    const float og[8] = {bflo(ov.x), bfhi(ov.x), bflo(ov.y), bfhi(ov.y), bflo(ov.z), bfhi(ov.z), bflo(ov.w), bfhi(ov.w)};
    const float* g = p.in[I_MNORMG] + l * 64 + e8;
    float o[8];
#pragma unroll
    for (int i = 0; i < 8; ++i) o[i] = (ABL & 2) ? 0.f : v[i] * rs * g[i] * sigmoidf_(og[i]);
    u32x4 w; w.x = cvtpk(o[0], o[1]); w.y = cvtpk(o[2], o[3]); w.z = cvtpk(o[4], o[5]); w.w = cvtpk(o[6], o[7]);
    *(u32x4*)(MIX + (size_t)(row0 + t) * DM + 256 + hh * 64 + e8) = w;
  }
  __syncthreads();
}


__device__ __forceinline__ void ml_out_unit2(const Params& p, int l, int unit, unsigned char* lds) {
  int tid_ = tidx(); asm volatile("" : "+v"(tid_)); const int tid = tid_, lane = tid & 63, wid = tid >> 6, r32 = lane & 31, hi = lane >> 5;
  unsigned char* Qs = lds; unsigned char* Ks = lds + 64 * MLP; unsigned char* VT = lds + 2 * 64 * MLP; unsigned char* Cs = lds + 3 * 64 * MLP;
  float* Ns = (float*)(lds + 5 * 64 * MLP);
  float* Bq = Ns + 128;
  float* Gs = Bq + 128;
  float* Mi = Gs + 128;
  float* HB = Mi + 64;
  const bf16_t* PROJ = (const bf16_t*)(p.ws + WS_PROJ);
  const float* GT = (const float*)(p.ws + WS_GATES);
  const bf16_t* CST = (const bf16_t*)(p.ws + WS_CST); const float* NST = (const float*)(p.ws + WS_NST); const float* META = (const float*)(p.ws + WS_MLMETA);
  bf16_t* MIX = (bf16_t*)(p.ws + WS_MIX);
  const int b = unit / (4 * NCH), hh = (unit / NCH) & 3, ch = unit % NCH;
  const int row0 = b * SEGL + ch * 64;
  ml_stage_rm(PROJ + (size_t)row0 * PW + C_MQ + hh * 64, PW, Qs, tid);
  ml_stage_rm(PROJ + (size_t)row0 * PW + C_MK + hh * 64, PW, Ks, tid);
  ml_stage_tr(PROJ + (size_t)row0 * PW + C_MV + hh * 64, PW, VT, tid);
#pragma unroll
  for (int dir = 0; dir < 2; ++dir) {
    const int seq = (b * 4 + hh) * 2 + dir, ci = ml_cidx(ch, dir);
    ml_stage_rm(CST + ((size_t)seq * NCH + ci) * 4096, 64, Cs + dir * 64 * MLP, tid);
    if (tid < 64) Ns[dir * 64 + tid] = NST[((size_t)seq * NCH + ci) * 64 + tid];
  }
  if (wid < 2) {
    const int dir = wid;
    const float ig = GT[(size_t)(row0 + lane) * 16 + (2 * dir) * 4 + hh];
    const float lf = logsigmoidf_(GT[(size_t)(row0 + lane) * 16 + (2 * dir + 1) * 4 + hh]);
    float ps = lf;
#pragma unroll
    for (int o = 1; o < 64; o <<= 1) { const float t = __shfl_up(ps, o); if (lane >= o) ps += t; }
    const float tot = __shfl(ps, 63);
    const float bc = dir == 0 ? ps : (tot - ps + lf);
    Bq[dir * 64 + lane] = bc; Gs[dir * 64 + lane] = ig - bc;
    if (lane == 0) { const int seq = (b * 4 + hh) * 2 + dir, ci = ml_cidx(ch, dir); Mi[dir] = META[((size_t)seq * NCH + ci) * 4 + 2]; }
  }
  __syncthreads();
  {
    const int dir = wid >> 2, tt = (wid >> 1) & 1, et = wid & 1;
    const int t = tt * 32 + r32;
    f32x16 sa[2] = {};
    bf16x8 bq[4];
#pragma unroll
    for (int ks = 0; ks < 4; ++ks) {
      bq[ks] = *(const bf16x8*)(Qs + t * MLP + (ks * 16 + hi * 8) * 2);
      const bf16x8 a0 = *(const bf16x8*)(Ks + r32 * MLP + (ks * 16 + hi * 8) * 2), a1 = *(const bf16x8*)(Ks + (32 + r32) * MLP + (ks * 16 + hi * 8) * 2);
      sa[0] = __builtin_amdgcn_mfma_f32_32x32x16_bf16(a0, bq[ks], sa[0], 0, 0, 0);
      sa[1] = __builtin_amdgcn_mfma_f32_32x32x16_bf16(a1, bq[ks], sa[1], 0, 0, 0);
    }
    const float bt = Bq[dir * 64 + t];
    const float inter = bt + Mi[dir];
    float mx = -INFINITY;
    f32x16 dl[2];
#pragma unroll
    for (int st = 0; st < 2; ++st)
#pragma unroll
      for (int r = 0; r < 16; ++r) {
        const int s = st * 32 + crow(r, hi);
        const bool ok = dir == 0 ? (s <= t) : (s >= t);
        const float d = ok ? bt + Gs[dir * 64 + s] : -INFINITY;
        dl[st][r] = d; mx = fmaxf(mx, d);
      }
    mx = fmaxf(mx, __shfl_xor(mx, 32));
    const float mt = fmaxf(inter, mx);
    const float iw = __expf(inter - mt);
    float rsum = 0.f;
#pragma unroll
    for (int st = 0; st < 2; ++st)
#pragma unroll
      for (int r = 0; r < 16; ++r) { const float w = __expf(dl[st][r] - mt); sa[st][r] *= w; rsum += sa[st][r]; }
    rsum += __shfl_xor(rsum, 32);
    float qn = 0.f;
#pragma unroll
    for (int i = 0; i < 4; ++i) {
      const int d0 = hi * 32 + i * 8;
      const u32x4 qa = *(const u32x4*)(Qs + t * MLP + d0 * 2);
      const f32x4 n0 = *(const f32x4*)(Ns + dir * 64 + d0), n1 = *(const f32x4*)(Ns + dir * 64 + d0 + 4);
      qn += bflo(qa.x) * n0.x + bfhi(qa.x) * n0.y + bflo(qa.y) * n0.z + bfhi(qa.y) * n0.w + bflo(qa.z) * n1.x + bfhi(qa.z) * n1.y + bflo(qa.w) * n1.z + bfhi(qa.w) * n1.w;
    }
    qn += __shfl_xor(qn, 32);
    const float den = rsum + iw * qn;
    const float rden = 1.f / fmaxf(fabsf(den), __expf(-mt));
    f32x16 an = {}, ac = {};
#pragma unroll
    for (int st = 0; st < 2; ++st)
#pragma unroll
      for (int k2 = 0; k2 < 2; ++k2) {
        u32x4 bx; bx.x = cvtpk(sa[st][8 * k2 + 0], sa[st][8 * k2 + 1]); bx.y = cvtpk(sa[st][8 * k2 + 2], sa[st][8 * k2 + 3]);
        bx.z = cvtpk(sa[st][8 * k2 + 4], sa[st][8 * k2 + 5]); bx.w = cvtpk(sa[st][8 * k2 + 6], sa[st][8 * k2 + 7]);
        const unsigned char* vrow = VT + (et * 32 + r32) * MLP + (st * 32 + 16 * k2 + 4 * hi) * 2;
        const u32x2 v0 = *(const u32x2*)vrow, v1 = *(const u32x2*)(vrow + 16);
        u32x4 ax; ax.x = v0.x; ax.y = v0.y; ax.z = v1.x; ax.w = v1.y;
        an = __builtin_amdgcn_mfma_f32_32x32x16_bf16(*(const bf16x8*)&ax, *(const bf16x8*)&bx, an, 0, 0, 0);
      }
    const unsigned char* Cd = Cs + dir * 64 * MLP;
#pragma unroll
    for (int ks = 0; ks < 4; ++ks) {
      const bf16x8 a = *(const bf16x8*)(Cd + (et * 32 + r32) * MLP + (ks * 16 + hi * 8) * 2);
      ac = __builtin_amdgcn_mfma_f32_32x32x16_bf16(a, bq[ks], ac, 0, 0, 0);
    }
#pragma unroll
    for (int r = 0; r < 16; ++r) HB[dir * 64 * 65 + t * 65 + et * 32 + crow(r, hi)] = (an[r] + iw * ac[r]) * rden;
  }
  __syncthreads();
  {
    const int t = tid >> 3, e8 = (tid & 7) * 8;
    float v[8]; float ss = 0.f;
#pragma unroll
    for (int i = 0; i < 8; ++i) { v[i] = HB[t * 65 + e8 + i] + HB[64 * 65 + t * 65 + e8 + i]; ss += v[i] * v[i]; }
    ss += __shfl_xor(ss, 1); ss += __shfl_xor(ss, 2); ss += __shfl_xor(ss, 4);
    const float rs = rsqrtf(ss * (1.f / 64.f) + EPS);
    const u32x4 ov = *(const u32x4*)(PROJ + (size_t)(row0 + t) * PW + C_MO + hh * 64 + e8);
    const float og[8] = {bflo(ov.x), bfhi(ov.x), bflo(ov.y), bfhi(ov.y), bflo(ov.z), bfhi(ov.z), bflo(ov.w), bfhi(ov.w)};
    const float* g = p.in[I_MNORMG] + l * 64 + e8;
    float o[8];
#pragma unroll
    for (int i = 0; i < 8; ++i) o[i] = (ABL & 2) ? 0.f : v[i] * rs * g[i] * sigmoidf_(og[i]);
    u32x4 w; w.x = cvtpk(o[0], o[1]); w.y = cvtpk(o[2], o[3]); w.z = cvtpk(o[4], o[5]); w.w = cvtpk(o[6], o[7]);
    *(u32x4*)(MIX + (size_t)(row0 + t) * DM + 256 + hh * 64 + e8) = w;
  }
  __syncthreads();
}

#define KSWZ(row, colB) ((row) * 256 + ((colB) ^ (((row) & 15) << 4)))
#define SBAR() __builtin_amdgcn_sched_barrier(0)
constexpr int ATT_SHM_V = 128 * 80, ATT_SHM_K = 64 * 128 * 2;
constexpr float ATT_THR = 8.0f;
__device__ __forceinline__ int v_st(int k, int c) { const int kk = (k & ~0xC) | ((k & 4) << 1) | ((k & 8) >> 1); return ((kk >> 3) * 4 + (c >> 5)) * 512 + ((kk & 7) * 32 + (c & 31)) * 2; }
__device__ __forceinline__ int v_rd_base(int lane) { return ((lane & 3) << 3) | (((lane >> 2) & 3) << 6) | (((lane >> 4) & 1) << 5) | (((lane >> 5) & 1) << 8); }
constexpr int v_rd_off(int d0, int ks, int half) { return d0 * 512 + ks * 4096 + half * 2048; }
template <int OFF> __device__ __forceinline__ s16x4 tr_read(int vb) {
  s16x4 r; asm volatile("ds_read_b64_tr_b16 %0, %1 offset:%2" : "=&v"(r) : "v"(vb), "i"(OFF) : "memory"); return r;
}
template <int D0> __device__ __forceinline__ void pv_one(f32x16& od, int vb, bf16x8 pa0, bf16x8 pa1, bf16x8 pa2, bf16x8 pa3) {
  const s16x4 l0 = tr_read<v_rd_off(D0, 0, 0)>(vb), h0 = tr_read<v_rd_off(D0, 0, 1)>(vb), l1 = tr_read<v_rd_off(D0, 1, 0)>(vb), h1 = tr_read<v_rd_off(D0, 1, 1)>(vb);
  const s16x4 l2 = tr_read<v_rd_off(D0, 2, 0)>(vb), h2 = tr_read<v_rd_off(D0, 2, 1)>(vb), l3 = tr_read<v_rd_off(D0, 3, 0)>(vb), h3 = tr_read<v_rd_off(D0, 3, 1)>(vb);
  asm volatile("s_waitcnt lgkmcnt(0)" ::: "memory"); SBAR();
#define PK(L, H) (bf16x8){L[0], L[1], L[2], L[3], H[0], H[1], H[2], H[3]}
  od = __builtin_amdgcn_mfma_f32_32x32x16_bf16(pa0, PK(l0, h0), od, 0, 0, 0);
  od = __builtin_amdgcn_mfma_f32_32x32x16_bf16(pa1, PK(l1, h1), od, 0, 0, 0);
  od = __builtin_amdgcn_mfma_f32_32x32x16_bf16(pa2, PK(l2, h2), od, 0, 0, 0);
  od = __builtin_amdgcn_mfma_f32_32x32x16_bf16(pa3, PK(l3, h3), od, 0, 0, 0);
#undef PK
}
template <int D0> __device__ __forceinline__ void pv_two(f32x16& oa, f32x16& ob, int vb, bf16x8 a0, bf16x8 a1, bf16x8 a2, bf16x8 a3, bf16x8 b0, bf16x8 b1, bf16x8 b2, bf16x8 b3) {
  const s16x4 l0 = tr_read<v_rd_off(D0, 0, 0)>(vb), h0 = tr_read<v_rd_off(D0, 0, 1)>(vb), l1 = tr_read<v_rd_off(D0, 1, 0)>(vb), h1 = tr_read<v_rd_off(D0, 1, 1)>(vb);
  const s16x4 l2 = tr_read<v_rd_off(D0, 2, 0)>(vb), h2 = tr_read<v_rd_off(D0, 2, 1)>(vb), l3 = tr_read<v_rd_off(D0, 3, 0)>(vb), h3 = tr_read<v_rd_off(D0, 3, 1)>(vb);
  asm volatile("s_waitcnt lgkmcnt(0)" ::: "memory"); SBAR();
#define PK(L, H) (bf16x8){L[0], L[1], L[2], L[3], H[0], H[1], H[2], H[3]}
  const bf16x8 v0 = PK(l0, h0), v1 = PK(l1, h1), v2 = PK(l2, h2), v3 = PK(l3, h3);
  oa = __builtin_amdgcn_mfma_f32_32x32x16_bf16(a0, v0, oa, 0, 0, 0);
  ob = __builtin_amdgcn_mfma_f32_32x32x16_bf16(b0, v0, ob, 0, 0, 0);
  oa = __builtin_amdgcn_mfma_f32_32x32x16_bf16(a1, v1, oa, 0, 0, 0);
  ob = __builtin_amdgcn_mfma_f32_32x32x16_bf16(b1, v1, ob, 0, 0, 0);
  oa = __builtin_amdgcn_mfma_f32_32x32x16_bf16(a2, v2, oa, 0, 0, 0);
  ob = __builtin_amdgcn_mfma_f32_32x32x16_bf16(b2, v2, ob, 0, 0, 0);
  oa = __builtin_amdgcn_mfma_f32_32x32x16_bf16(a3, v3, oa, 0, 0, 0);
  ob = __builtin_amdgcn_mfma_f32_32x32x16_bf16(b3, v3, ob, 0, 0, 0);
#undef PK
}
struct KQFrag { bf16x8 b0, b1, q; };
__device__ __forceinline__ void att_ldkq(KQFrag& f, const LAS unsigned char* l3, int ak, int kofs, int qofs) {
  const LAS unsigned char* kp = l3 + (ak + kofs);
  f.b0 = *(const LAS bf16x8*)kp; f.b1 = *(const LAS bf16x8*)(kp + 8192); f.q = *(const LAS bf16x8*)(l3 + (ak + qofs));
}
#define ATT_MF(pa_, pb_, f_) do { pa_ = __builtin_amdgcn_mfma_f32_32x32x16_bf16(f_.b0, f_.q, pa_, 0, 0, 0); pb_ = __builtin_amdgcn_mfma_f32_32x32x16_bf16(f_.b1, f_.q, pb_, 0, 0, 0); } while (0)
__device__ __forceinline__ void att_qk_all(f32x16& p0, f32x16& p1, f32x16& q0, f32x16& q1, KQFrag& f0, const LAS unsigned char* l3, int ak0, int kofs, int qofs, float ia, float ib) {
  KQFrag f1;
#pragma unroll
  for (int r = 0; r < 16; ++r) { p0[r] = ia; p1[r] = ia; q0[r] = ib; q1[r] = ib; }
  att_ldkq(f1, l3, ak0 ^ (1 << 5), kofs, qofs); ATT_MF(p0, p1, f0); SBAR();
  att_ldkq(f0, l3, ak0 ^ (2 << 5), kofs, qofs); ATT_MF(p0, p1, f1); SBAR();
  att_ldkq(f1, l3, ak0 ^ (3 << 5), kofs, qofs); ATT_MF(p0, p1, f0); SBAR();
  att_ldkq(f0, l3, ak0 ^ (4 << 5), kofs, qofs); ATT_MF(p0, p1, f1); SBAR();
  att_ldkq(f1, l3, ak0 ^ (5 << 5), kofs, qofs); ATT_MF(q0, q1, f0); SBAR();
  att_ldkq(f0, l3, ak0 ^ (6 << 5), kofs, qofs); ATT_MF(q0, q1, f1); SBAR();
  att_ldkq(f1, l3, ak0 ^ (7 << 5), kofs, qofs); ATT_MF(q0, q1, f0); SBAR();
  ATT_MF(q0, q1, f1); SBAR();
}
__device__ __forceinline__ void att_softmax(f32x16& p0, f32x16& p1, float& m_reg, float& l_reg, float& alpha, bool first, i32x8& pa) {
  alpha = 1.f;
  if (first) {
    float pmax = p0[0];
#pragma unroll
    for (int r = 1; r < 16; ++r) pmax = fmaxf(pmax, p0[r]);
#pragma unroll
    for (int r = 0; r < 16; ++r) pmax = fmaxf(pmax, p1[r]);
    { auto rr = __builtin_amdgcn_permlane32_swap(__float_as_uint(pmax), __float_as_uint(pmax), false, false);
      pmax = fmaxf(__uint_as_float(rr[0]), __uint_as_float(rr[1])); }
    alpha = 0.f; m_reg = pmax;
#pragma unroll
    for (int r = 0; r < 16; ++r) { p0[r] -= pmax; p1[r] -= pmax; }
  }
#pragma unroll
  for (int r = 0; r < 16; ++r) { p0[r] = __builtin_amdgcn_exp2f(p0[r]); p1[r] = __builtin_amdgcn_exp2f(p1[r]); }
  float ps;
  {
#define VADD(d_, a_, b_) asm("v_add_f32_e32 %0, %1, %2" : "=v"(d_) : "v"(a_), "v"(b_))
    float s0, s1, s2, s3;
    VADD(s0, p0[0], p0[1]); VADD(s1, p0[8], p0[9]); VADD(s2, p1[0], p1[1]); VADD(s3, p1[8], p1[9]);
#pragma unroll
    for (int r = 2; r < 8; ++r) { VADD(s0, s0, p0[r]); VADD(s1, s1, p0[8 + r]); VADD(s2, s2, p1[r]); VADD(s3, s3, p1[8 + r]); }
    VADD(s0, s0, s1); VADD(s2, s2, s3); VADD(ps, s0, s2);
#undef VADD
  }
  { auto rr = __builtin_amdgcn_permlane32_swap(__float_as_uint(ps), __float_as_uint(ps), false, false);
    ps = __uint_as_float(rr[0]) + __uint_as_float(rr[1]); }
  if (__builtin_expect(!first && __any(ps > 256.f), 0)) {
    float emax = p0[0];
#pragma unroll
    for (int r = 1; r < 16; ++r) emax = fmaxf(emax, p0[r]);
#pragma unroll
    for (int r = 0; r < 16; ++r) emax = fmaxf(emax, p1[r]);
    { auto rr = __builtin_amdgcn_permlane32_swap(__float_as_uint(emax), __float_as_uint(emax), false, false);
      emax = fmaxf(__uint_as_float(rr[0]), __uint_as_float(rr[1])); }
    const float delta = fmaxf(__builtin_amdgcn_logf(emax), 0.f);
    alpha = __builtin_amdgcn_exp2f(-delta); m_reg += delta;
#pragma unroll
    for (int r = 0; r < 16; ++r) { p0[r] *= alpha; p1[r] *= alpha; }
    ps *= alpha;
  }
  l_reg = l_reg * alpha + ps;
#pragma unroll
  for (int v = 0; v < 4; ++v) {
    int w0, w1; asm volatile("" : "=v"(w0), "=v"(w1));
    w0 = __builtin_amdgcn_cvt_pk_fp8_f32(p0[4 * v], p0[4 * v + 1], w0, false); w0 = __builtin_amdgcn_cvt_pk_fp8_f32(p0[4 * v + 2], p0[4 * v + 3], w0, true);
    w1 = __builtin_amdgcn_cvt_pk_fp8_f32(p1[4 * v], p1[4 * v + 1], w1, false); w1 = __builtin_amdgcn_cvt_pk_fp8_f32(p1[4 * v + 2], p1[4 * v + 3], w1, true);
    pa[v] = w0; pa[4 + v] = w1;
  }
}
__device__ __forceinline__ void att_unit(const bf16_t* __restrict__ Qb, const bf16_t* __restrict__ Kh, const unsigned char* __restrict__ V8, bf16_t* __restrict__ Ob,
                                         int nkeys, float lam, const float* __restrict__ ng, float oscale, unsigned char* lds) {
  int tid_ = tidx(); asm volatile("" : "+v"(tid_)); const int tid = tid_, wid = tid >> 6, lane = tid & 63, r32 = lane & 31, hi = lane >> 5;
  const int grp = __builtin_amdgcn_readfirstlane(wid >> 2);
  unsigned char* V_lds = lds; unsigned char* K_lds = lds + 2 * ATT_SHM_V;
  float* wsl = (float*)(lds + 2 * ATT_SHM_V + 2 * ATT_SHM_K) + wid * 64; float* li_l = wsl; float* al_l = wsl + 32;
  float m0 = 0.f, l0 = 0.f, m1 = 0.f, l1 = 0.f;
  f32x16 o0[4] = {}, o1[4] = {};
  unsigned char* Q_lds = lds + 2 * ATT_SHM_V + 2 * ATT_SHM_K + 2048;
#pragma unroll
  for (int i = 0; i < 8; ++i) { const int id = tid + 512 * i, qrw = id >> 4, ch = id & 15;
    *(bf16x8*)(Q_lds + KSWZ(qrw, ch * 16)) = *(const bf16x8*)(Qb + (size_t)qrw * PW + ch * 8); }
  const int qrow = wid * 32 + r32;
  int kso[2];
#pragma unroll
  for (int i = 0; i < 2; ++i) {
    const int o16 = tid + 512 * i;
    { const int row = o16 >> 4, cs = (o16 & 15) ^ (row & 15); kso[i] = row * PW + cs * 8; }
  }
  const unsigned ldsw = (unsigned)__builtin_amdgcn_readfirstlane(wid) * 1024u;
#define GSTAGE_K(b, k0) do { _Pragma("unroll") for (int i_ = 0; i_ < 2; ++i_) \
    __builtin_amdgcn_global_load_lds((const unsigned*)(Kh + (size_t)(k0) * PW + kso[i_]), (LAS unsigned*)(K_lds + (b) * ATT_SHM_K + ldsw + i_ * 8192), 16, 0, 0); } while (0)
#define GSTAGE_V(b, k0) do { const unsigned char* vi_ = V8 + (size_t)((k0) >> 6) * ATT_SHM_V + tid * 16; \
      __builtin_amdgcn_global_load_lds((const unsigned*)vi_, (LAS unsigned*)(V_lds + (b) * ATT_SHM_V + ldsw), 16, 0, 0); \
      if (wid < 2) __builtin_amdgcn_global_load_lds((const unsigned*)(vi_ + 8192), (LAS unsigned*)(V_lds + (b) * ATT_SHM_V + 8192 + ldsw), 16, 0, 0); } while (0)
#define STAGE_PAIR(jj) do { GSTAGE_V((jj) & 1, (jj) * 64); if ((jj) + 1 < NT) GSTAGE_K((jj) & 1, ((jj) + 1) * 64); } while (0)
#define RESC(o, a) do { if (__any((a) < 1.f)) { if (hi == 0) al_l[r32] = (a); asm volatile("s_waitcnt lgkmcnt(0)" ::: "memory"); \
    _Pragma("unroll") for (int d = 0; d < 4; ++d) _Pragma("unroll") for (int r = 0; r < 16; ++r) o[d][r] *= al_l[crow(r, hi)]; } } while (0)
#define ATT_BAR() do { asm volatile("s_waitcnt lgkmcnt(0)" ::: "memory"); __builtin_amdgcn_s_barrier(); asm volatile("" ::: "memory"); } while (0)
  const int NT = nkeys / 64;
  GSTAGE_K(1, 0); STAGE_PAIR(0);
  asm volatile("s_waitcnt vmcnt(0)" ::: "memory"); __syncthreads();
  f32x16 p0, p1, q0, q1; i32x8 pa, pb;
  const LAS unsigned char* l3 = (const LAS unsigned char*)lds;
  const int ak0 = r32 * 256 + ((hi * 16) ^ ((r32 & 15) << 4));
  const int kofs0 = 2 * ATT_SHM_V, qofs0 = 2 * ATT_SHM_V + 2 * ATT_SHM_K + 2048 + __builtin_amdgcn_readfirstlane(wid) * 8192;
  { KQFrag f0; att_ldkq(f0, l3, ak0, kofs0 + ATT_SHM_K, qofs0);
    att_qk_all(p0, p1, q0, q1, f0, l3, ak0, kofs0 + ATT_SHM_K, qofs0, 0.f, 0.f); }
  if (grp) ATT_BAR();
#pragma unroll 1
  for (int j = 0; j < NT; ++j) {
    const int cur = j & 1;
    const bool more = (j + 1 < NT);
    if (grp && more) STAGE_PAIR(j + 1);
    { float alphaA, alphaB;
      const bool first = (j == 0);
      att_softmax(p0, p1, m0, l0, alphaA, first, pa); SBAR();
      att_softmax(q0, q1, m1, l1, alphaB, first, pb); SBAR();
      RESC(o0, alphaA);
      RESC(o1, alphaB); }
    asm volatile("" : "+v"(pa), "+v"(pb), "+v"(m0), "+v"(l0), "+v"(m1), "+v"(l1));
    asm volatile("" : "+v"(o0[0]), "+v"(o0[1]), "+v"(o0[2]), "+v"(o0[3]), "+v"(o1[0]), "+v"(o1[1]), "+v"(o1[2]), "+v"(o1[3]));
    if (!grp) asm volatile("s_waitcnt vmcnt(0)" ::: "memory");
    ATT_BAR();
    if (!grp && more) STAGE_PAIR(j + 1);
    __builtin_amdgcn_s_setprio(1);
    {
      int kofs = kofs0 + cur * ATT_SHM_K, qofs = qofs0, ak = ak0; asm volatile("" : "+s"(kofs), "+s"(qofs), "+v"(ak));
      const LAS unsigned char* vrow = l3 + (r32 * 80 + hi * 32 + cur * ATT_SHM_V);
      u32x4 va0 = *(const LAS u32x4*)vrow, va1 = *(const LAS u32x4*)(vrow + 16), vb0, vb1;
      KQFrag f0;
#define ATT_PV(d0_, x0_, x1_) do { i32x8 bv; bv[0] = (int)x0_.x; bv[1] = (int)x0_.y; bv[2] = (int)x0_.z; bv[3] = (int)x0_.w; bv[4] = (int)x1_.x; bv[5] = (int)x1_.y; bv[6] = (int)x1_.z; bv[7] = (int)x1_.w; \
        o0[d0_] = __builtin_amdgcn_mfma_scale_f32_32x32x64_f8f6f4(pa, bv, o0[d0_], 0, 0, 0, 0x7F7F7F7F, 0, 0x7F7F7F7F); \
        o1[d0_] = __builtin_amdgcn_mfma_scale_f32_32x32x64_f8f6f4(pb, bv, o1[d0_], 0, 0, 0, 0x7F7F7F7F, 0, 0x7F7F7F7F); } while (0)
      vb0 = *(const LAS u32x4*)(vrow + 32 * 80); vb1 = *(const LAS u32x4*)(vrow + 32 * 80 + 16); ATT_PV(0, va0, va1); SBAR();
      va0 = *(const LAS u32x4*)(vrow + 64 * 80); va1 = *(const LAS u32x4*)(vrow + 64 * 80 + 16); ATT_PV(1, vb0, vb1); SBAR();
      vb0 = *(const LAS u32x4*)(vrow + 96 * 80); vb1 = *(const LAS u32x4*)(vrow + 96 * 80 + 16); ATT_PV(2, va0, va1); SBAR();
      att_ldkq(f0, l3, ak, kofs, qofs);
      ATT_PV(3, vb0, vb1); SBAR();
#undef ATT_PV
      asm volatile("" : "+v"(o0[0]), "+v"(o0[1]), "+v"(o0[2]), "+v"(o0[3]), "+v"(o1[0]), "+v"(o1[1]), "+v"(o1[2]), "+v"(o1[3]));
      att_qk_all(p0, p1, q0, q1, f0, l3, ak, kofs, qofs, -m0, -m1);
      asm volatile("" : "+v"(p0), "+v"(p1), "+v"(q0), "+v"(q1));
    }
    __builtin_amdgcn_s_setprio(0);
    if (grp) asm volatile("s_waitcnt vmcnt(0)" ::: "memory");
    ATT_BAR();
  }
  if (!grp) ATT_BAR();
  if (hi == 0) { li_l[r32] = 1.f / l0; al_l[r32] = lam / l1; }
  asm volatile("s_waitcnt lgkmcnt(0)" ::: "memory");
  float ss[16];
#pragma unroll
  for (int r = 0; r < 16; ++r) {
    const float a = li_l[crow(r, hi)], bq = al_l[crow(r, hi)];
    float s = 0.f;
#pragma unroll
    for (int d = 0; d < 4; ++d) { const float v = o0[d][r] * a - o1[d][r] * bq; o0[d][r] = v; s += v * v; }
    s += __shfl_xor(s, 1); s += __shfl_xor(s, 2); s += __shfl_xor(s, 4); s += __shfl_xor(s, 8); s += __shfl_xor(s, 16);
    ss[r] = rsqrtf(s * (1.f / 128.f) + EPS) * oscale;
  }
  bf16_t* Ow = Ob + (size_t)(wid * 32) * DM;
#pragma unroll
  for (int d = 0; d < 4; ++d) {
    const float g = ng[d * 32 + r32];
#pragma unroll
    for (int r = 0; r < 16; ++r) Ow[(size_t)crow(r, hi) * DM + d * 32 + r32] = (ABL & 4) ? (bf16_t)0 : (bf16_t)(cvtpk(o0[d][r] * ss[r] * g, 0.f) & 0xffffu);
  }
  __syncthreads();
#undef GSTAGE_K
#undef GSTAGE_V
#undef STAGE_PAIR
#undef RESC
#undef ATT_BAR
}

__device__ __forceinline__ float ins16(float (&a)[16], float x) {
#pragma unroll
  for (int i = 0; i < 16; ++i) { const float h = fmaxf(a[i], x); x = fminf(a[i], x); a[i] = h; }
  return x;
}
__device__ __forceinline__ void bsort16(float (&a)[16]) {
#pragma unroll
  for (int k = 2; k <= 16; k <<= 1)
#pragma unroll
    for (int j = k >> 1; j > 0; j >>= 1)
#pragma unroll
      for (int i = 0; i < 16; ++i) {
        const int q = i ^ j;
        if (q > i) {
          const bool desc = ((i & k) == 0);
          const float hi_ = fmaxf(a[i], a[q]), lo_ = fminf(a[i], a[q]);
          a[i] = desc ? hi_ : lo_; a[q] = desc ? lo_ : hi_;
        }
      }
}
__device__ __forceinline__ void bmerge16(float (&a)[16], const float (&b)[16]) {
#pragma unroll
  for (int i = 0; i < 16; ++i) a[i] = fmaxf(a[i], b[15 - i]);
#pragma unroll
  for (int j = 8; j > 0; j >>= 1)
#pragma unroll
    for (int i = 0; i < 16; ++i) {
      const int q = i ^ j;
      if (q > i) { const float hi_ = fmaxf(a[i], a[q]), lo_ = fminf(a[i], a[q]); a[i] = hi_; a[q] = lo_; }
    }
}
__device__ __forceinline__ float gelu_erf(float x) { return 0.5f * x * (1.f + erff(x * 0.70710678118654752440f)); }
#define XB_TMO      128
#define XB_XCNT(j)  (256  + 64 * (j))
#define XB_XSUB(j)  (1280 + 64 * (j))
#define XB_XGEN(j)  (2304 + 64 * (j))
#define XB_TOP      3328
#define XB_TOPGEN   3392
#define XCD_BAR_WORDS 3456
#define XB_SPIN_CAP (1u << 22)
__device__ __forceinline__ unsigned xb_ld(unsigned* p)              { return __hip_atomic_load(p, __ATOMIC_RELAXED, __HIP_MEMORY_SCOPE_AGENT); }
__device__ __forceinline__ unsigned xb_add(unsigned* p, unsigned v) { return __hip_atomic_fetch_add(p, v, __ATOMIC_RELAXED, __HIP_MEMORY_SCOPE_AGENT); }
__device__ __forceinline__ unsigned xb_xcc_id() { return (unsigned)__builtin_amdgcn_s_getreg((3 << 11) | 20) & 0xFu; }
#define XB_SPIN(cond, bar) do { unsigned _sp = 0; while (cond) { __builtin_amdgcn_s_sleep(1); \
    if ((++_sp & 255u) == 0u) { if (xb_ld(&(bar)[XB_TMO])) break; if (_sp > XB_SPIN_CAP) { atomicAdd(&(bar)[XB_TMO], 1u); break; } } } } while (0)
struct XcdBarrier { unsigned* bar; unsigned x; volatile LAS unsigned* st; };
__device__ __forceinline__ XcdBarrier xcd_barrier_post(unsigned* bar, volatile LAS unsigned* st) {
  XcdBarrier b; b.bar = bar; b.x = xb_xcc_id(); b.st = st;
  if (tidx() == 0) (void)xb_add(&bar[XB_XCNT(b.x)], 1u);
  return b;
}
__device__ __forceinline__ void xcd_barrier_complete(unsigned* bar, unsigned x, unsigned& nloc, unsigned& nx) {
  const unsigned G = gridDim.x * gridDim.y * gridDim.z;
  unsigned sum, cnt, mine, sp = 0u;
  for (;;) {
    sum = 0u; cnt = 0u; mine = 0u;
#pragma unroll
    for (unsigned j = 0; j < 16; ++j) { const unsigned c = xb_ld(&bar[XB_XCNT(j)]); sum += c; cnt += (c > 0u) ? 1u : 0u; mine = (j == x) ? c : mine; }
    if (sum == G) break;
    __builtin_amdgcn_s_sleep(1);
    if ((++sp & 255u) == 0u) { if (xb_ld(&bar[XB_TMO])) break; if (sp > XB_SPIN_CAP) { atomicAdd(&bar[XB_TMO], 1u); break; } }
  }
  nloc = mine > 0u ? mine : 1u; nx = cnt > 0u ? cnt : 1u;
}
__device__ __forceinline__ void xcd_barrier(const XcdBarrier& b) {
  asm volatile("s_waitcnt vmcnt(0)" ::: "memory");
  __syncthreads();
  if (tidx() == 0) {
    unsigned* bar = b.bar;
    __builtin_amdgcn_s_waitcnt(0);
    unsigned nloc = b.st[0], nx = b.st[1];
    if (nloc == 0u) { xcd_barrier_complete(bar, b.x, nloc, nx); b.st[0] = nloc; b.st[1] = nx; }
    const unsigned old = xb_add(&bar[XB_XSUB(b.x)], 1u);
    const unsigned gen = old / nloc;
    if (old + 1u == (gen + 1u) * nloc) {
      __builtin_amdgcn_fence(__ATOMIC_RELEASE, "agent");
      asm volatile("s_waitcnt vmcnt(0)" ::: "memory");
      const unsigned og = xb_add(&bar[XB_TOP], 1u);
      const unsigned tg = og / nx;
      if (og + 1u == (tg + 1u) * nx) xb_add(&bar[XB_TOPGEN], 1u);
      else XB_SPIN(xb_ld(&bar[XB_TOPGEN]) == tg, bar);
      __builtin_amdgcn_fence(__ATOMIC_ACQUIRE, "agent");
      xb_add(&bar[XB_XGEN(b.x)], 1u);
      asm volatile("s_waitcnt vmcnt(0)" ::: "memory");
    } else {
      XB_SPIN(xb_ld(&bar[XB_XGEN(b.x)]) == gen, bar);
      __builtin_amdgcn_fence(__ATOMIC_ACQUIRE, "agent");
      asm volatile("s_waitcnt vmcnt(0)" ::: "memory");
    }
  }
  __syncthreads();
}

constexpr size_t RT_STRIDE = (size_t)T * 128 * 4;
__device__ __forceinline__ void route_unit(const Params& p, int l, int unit, unsigned char* lds) {
  int tid_ = tidx(); asm volatile("" : "+v"(tid_)); const int tid = tid_, lane = tid & 63, wid = tid >> 6, r32 = lane & 31, hi = lane >> 5;
  unsigned char* IDX = lds;
  int* UE = (int*)(lds + 8192); float* UG = (float*)(lds + 8192 + 16384); float* US = (float*)(lds + 8192 + 32768);
  int* EIDG = (int*)(p.ws + WS_EID + (size_t)l * RT_STRIDE); float* GWG = (float*)(p.ws + WS_ULOC + RT_STRIDE); float* SUG = (float*)(p.ws + WS_ULOC + 2 * RT_STRIDE);
  const float* PSC = (const float*)(p.ws + WS_PSC);
  const int row0 = unit * 32;
  const bf16_t* QP = (const bf16_t*)(p.ws + WS_PROJ);
  const bf16_t* KEYS = (const bf16_t*)(p.ws + WS_KEYS) + (size_t)l * 131072;
  for (int rrep = 0; rrep < REP_ROUTE; ++rrep) {
    const int h = wid;
    float top[2][16];
#pragma unroll
    for (int pp = 0; pp < 2; ++pp) {
      const bf16_t* qrow = QP + (size_t)(row0 + r32) * DM + h * 128 + pp * 64 + hi * 8;
      const bf16_t* kb = KEYS + ((size_t)(h * 2 + pp) * 128 + r32) * 64 + hi * 8;
      bf16x8 bq[4];
#pragma unroll
      for (int ks = 0; ks < 4; ++ks) bq[ks] = *(const bf16x8*)(qrow + ks * 16);
      float (&lst)[16] = top[pp];
#pragma unroll
      for (int i = 0; i < 16; ++i) lst[i] = -INFINITY;
#pragma unroll
      for (int nt = 0; nt < 4; ++nt) {
        f32x16 acc = {};
#pragma unroll
        for (int ks = 0; ks < 4; ++ks) {
          const bf16x8 ak = *(const bf16x8*)(kb + (size_t)nt * 32 * 64 + ks * 16);
          acc = __builtin_amdgcn_mfma_f32_32x32x16_bf16(ak, bq[ks], acc, 0, 0, 0);
        }
        float grp[16];
#pragma unroll
        for (int r = 0; r < 16; ++r) grp[r] = __uint_as_float((__float_as_uint(acc[r]) & ~0x7Fu) | (unsigned)(nt * 32 + crow(r, hi)));
        bsort16(grp);
        if (nt == 0) {
#pragma unroll
          for (int i = 0; i < 16; ++i) lst[i] = grp[i];
        } else bmerge16(lst, grp);
        SBAR();
      }
      float oth[16];
#pragma unroll
      for (int i = 0; i < 16; ++i) oth[i] = __shfl_xor(lst[i], 32);
      bmerge16(lst, oth);
      if (hi == 0) {
        unsigned w[4];
#pragma unroll
        for (int i = 0; i < 4; ++i)
          w[i] = (__float_as_uint(lst[4 * i]) & 0x7Fu) | ((__float_as_uint(lst[4 * i + 1]) & 0x7Fu) << 8) | ((__float_as_uint(lst[4 * i + 2]) & 0x7Fu) << 16) | ((__float_as_uint(lst[4 * i + 3]) & 0x7Fu) << 24);
        *(u32x4*)(IDX + ((r32 * 8 + h) * 2 + pp) * 16) = (u32x4){w[0], w[1], w[2], w[3]};
      }
    }
    float best[16];
#define CAND(i, j) __uint_as_float((__float_as_uint(__uint_as_float(__float_as_uint(top[0][i]) & ~0x7Fu) + __uint_as_float(__float_as_uint(top[1][j]) & ~0x7Fu)) & ~0xFFu) | (unsigned)((i) * 16 + (j)))
    {
#pragma unroll
      for (int j = 0; j < 16; ++j) best[j] = CAND(0, j);
      float y[16];
#pragma unroll
      for (int j = 0; j < 8; ++j) { y[j] = CAND(1, j); y[8 + j] = CAND(15 - j, 0); }
#pragma unroll
      for (int jj = 8; jj > 0; jj >>= 1)
#pragma unroll
        for (int i = 0; i < 16; ++i) { const int q = i ^ jj; if (q > i) { const float hi_ = fmaxf(y[i], y[q]), lo_ = fminf(y[i], y[q]); y[i] = hi_; y[q] = lo_; } }
      bmerge16(best, y);
      float x[16];
      x[0] = CAND(2, 0); x[1] = CAND(2, 1); x[2] = CAND(2, 2); x[3] = CAND(2, 3); x[4] = CAND(2, 4);
      x[5] = CAND(3, 0); x[6] = CAND(3, 1); x[7] = CAND(3, 2); x[8] = CAND(3, 3);
      x[9] = CAND(4, 0); x[10] = CAND(4, 1); x[11] = CAND(4, 2);
      x[12] = CAND(5, 0); x[13] = CAND(5, 1); x[14] = CAND(6, 0); x[15] = CAND(6, 1);
      bsort16(x);
      bmerge16(best, x);
      ins16(best, CAND(7, 0)); ins16(best, CAND(7, 1));
    }
#undef CAND
    asm volatile("s_waitcnt lgkmcnt(0)" ::: "memory");
    if (hi == 0) {
      const unsigned char* ib = IDX + ((r32 * 8 + h) * 2) * 16;
      const float mx = __uint_as_float(__float_as_uint(best[0]) & ~0xFFu);
      float w[16]; float sum = 0.f;
#pragma unroll
      for (int k = 0; k < 16; ++k) { w[k] = __expf(__uint_as_float(__float_as_uint(best[k]) & ~0xFFu) - mx); sum += w[k]; }
      const float rsum = 1.f / sum;
      int ee[16]; float su_[16], sv_[16];
#pragma unroll
      for (int k = 0; k < 16; ++k) {
        const unsigned ij = __float_as_uint(best[k]) & 0xFFu;
        ee[k] = (int)ib[ij >> 4] * 128 + (int)ib[16 + (ij & 15)];
      }
#pragma unroll
      for (int k = 0; k < 16; ++k) { su_[k] = PSC[(size_t)l * NEXP + ee[k]]; sv_[k] = PSC[(size_t)(DEPTH + l) * NEXP + ee[k]]; }
#pragma unroll
      for (int k = 0; k < 16; ++k) {
        UE[r32 * 128 + h * 16 + k] = ee[k]; UG[r32 * 128 + h * 16 + k] = w[k] * rsum * sv_[k];
        US[r32 * 128 + h * 16 + k] = su_[k];
      }
    }
  }
  __syncthreads();
#pragma unroll 1
  for (int tt = 0; tt < 4; ++tt) {
    const int t = wid * 4 + tt;
    const int k0 = UE[t * 128 + lane], k1 = UE[t * 128 + 64 + lane];
    const float g0 = UG[t * 128 + lane], g1 = UG[t * 128 + 64 + lane], s0 = US[t * 128 + lane], s1 = US[t * 128 + 64 + lane];
    const int b0 = k0 >> 10, b1 = k1 >> 10;
    int base = 0, pos0 = 0, pos1 = 0;
#pragma unroll
    for (int b = 0; b < 16; ++b) {
      const unsigned long long m0 = __ballot(b0 == b), m1 = __ballot(b1 == b);
      const int c0 = __popcll(m0), c1 = __popcll(m1);
      const unsigned long long lt = (1ull << lane) - 1ull;
      if (b0 == b) pos0 = base + __popcll(m0 & lt);
      if (b1 == b) pos1 = base + c0 + __popcll(m1 & lt);
      base += c0 + c1;
    }
    const size_t ro = (size_t)(row0 + t) * 128;
    EIDG[ro + pos0] = k0; GWG[ro + pos0] = g0; SUG[ro + pos0] = s0;
    EIDG[ro + pos1] = k1; GWG[ro + pos1] = g1; SUG[ro + pos1] = s1;
  }
}
#define CAS __attribute__((address_space(4)))
typedef int i32x8 __attribute__((ext_vector_type(8)));
struct TokPref { f32x2 gs0, gs1; u32x4 hA, hB; };
struct RowPipe { i32x6 uq[4], vq[4]; i32x8 Ec; };
__device__ __forceinline__ const CAS i32x8* eid_row(const CAS unsigned char* eidg, int row) {
  return (const CAS i32x8*)(eidg + (size_t)(unsigned)__builtin_amdgcn_readfirstlane(row) * 512u);
}
__device__ __forceinline__ void tok_prefetch(const Params& p, int row, int lane, TokPref& t) {
  const float* GWG = (const float*)(p.ws + WS_ULOC + RT_STRIDE) + (size_t)row * 128;
  const float* SUG = (const float*)(p.ws + WS_ULOC + 2 * RT_STRIDE) + (size_t)row * 128;
  const bf16_t* H = (const bf16_t*)(p.ws + WS_H);
  t.gs0 = f32x2{GWG[lane], SUG[lane]}; t.gs1 = f32x2{GWG[64 + lane], SUG[64 + lane]};
  t.hA = *(const u32x4*)(H + (size_t)row * DM + lane * 16); t.hB = *(const u32x4*)(H + (size_t)row * DM + lane * 16 + 8);
}
#define LOADPAIR(dst_, tofs_, ea_, eb_) do { const u32x3v a_ = __builtin_amdgcn_raw_buffer_load_b96(rsT, lane12, (ea_) * PROW + (tofs_), 0); const unsigned b0_ = __builtin_amdgcn_raw_buffer_load_b32(rsT, lane12, (eb_) * PROW + (tofs_), 0); \
      const u32x2v b1_ = __builtin_amdgcn_raw_buffer_load_b64(rsT, lane12 + 4, (eb_) * PROW + (tofs_), 0); \
      dst_[0] = (int)a_.x; dst_[1] = (int)a_.y; dst_[2] = (int)a_.z; dst_[3] = (int)b0_; dst_[4] = (int)b1_.x; dst_[5] = (int)b1_.y; } while (0)
#define LOADGROUP(q_, tofs_, E_) do { LOADPAIR(q_[0], tofs_, E_[0], E_[1]); LOADPAIR(q_[1], tofs_, E_[2], E_[3]); LOADPAIR(q_[2], tofs_, E_[4], E_[5]); LOADPAIR(q_[3], tofs_, E_[6], E_[7]); } while (0)
constexpr int VOFS = (int)(WS_PV - WS_PU);
__device__ __forceinline__ void gather_token(const Params& p, const CAS unsigned char* eidg, const __amdgpu_buffer_rsrc_t rsT, int l, int row, int nextrow, TokPref& tp, RowPipe& rp, unsigned char* lds, int lane, int wid) {
  f32x2* GS = (f32x2*)(lds + wid * 2048);
  float* XC = (float*)(p.ws + WS_XCUR);
  const float* MOD = (const float*)(p.ws + WS_MOD);
  const CAS i32x8* EP = eid_row(eidg, row);
  const bool hasnext = nextrow >= 0;
  const CAS i32x8* EPn = eid_row(eidg, hasnext ? nextrow : row);
  GS[lane] = tp.gs0; GS[64 + lane] = tp.gs1;
  asm volatile("s_waitcnt lgkmcnt(0)" ::: "memory");
  const int eofl = ((lane >> 5) & 1) + 2 * ((lane >> 4) & 1) + 4 * ((lane >> 3) & 1);
  const int lane12 = lane * 12;
  {
    h16x2 hh[8];
    {
      const u32x4 hA = tp.hA, hB = tp.hB;
      hh[0] = __builtin_bit_cast(h16x2, __builtin_amdgcn_cvt_pkrtz(bflo(hA.x), bfhi(hA.x))); hh[1] = __builtin_bit_cast(h16x2, __builtin_amdgcn_cvt_pkrtz(bflo(hA.y), bfhi(hA.y))); hh[2] = __builtin_bit_cast(h16x2, __builtin_amdgcn_cvt_pkrtz(bflo(hA.z), bfhi(hA.z))); hh[3] = __builtin_bit_cast(h16x2, __builtin_amdgcn_cvt_pkrtz(bflo(hA.w), bfhi(hA.w)));
      hh[4] = __builtin_bit_cast(h16x2, __builtin_amdgcn_cvt_pkrtz(bflo(hB.x), bfhi(hB.x))); hh[5] = __builtin_bit_cast(h16x2, __builtin_amdgcn_cvt_pkrtz(bflo(hB.y), bfhi(hB.y))); hh[6] = __builtin_bit_cast(h16x2, __builtin_amdgcn_cvt_pkrtz(bflo(hB.z), bfhi(hB.z))); hh[7] = __builtin_bit_cast(h16x2, __builtin_amdgcn_cvt_pkrtz(bflo(hB.w), bfhi(hB.w)));
    }
    if (hasnext) tok_prefetch(p, nextrow, lane, tp);
    f32x4 xpre[4];
    { const float* xr_ = XC + (size_t)row * DM + lane * 16;
#pragma unroll
      for (int v4 = 0; v4 < 4; ++v4) xpre[v4] = *(const f32x4*)(xr_ + v4 * 4); }
    f32x2 acc2[8];
#pragma unroll
    for (int i = 0; i < 8; ++i) acc2[i] = f32x2{0.f, 0.f};
#pragma unroll 1
    for (int g8 = 0; g8 < 16; ++g8) {
      const bool pf = (g8 < 15) || hasnext;
      const f32x2 gs = GS[g8 * 8 + eofl];
      float d[8];
#pragma unroll
      for (int i2 = 0; i2 < 4; ++i2) {
        const h16x32 r = __builtin_amdgcn_cvt_scalef32_pk32_f16_fp6(rp.uq[i2], 1.0f);
        float a0 = 0.f, a1 = 0.f, b0 = 0.f, b1 = 0.f;
#define UDOT(k_) a0 = __builtin_amdgcn_fdot2(__builtin_shufflevector(r, r, 4 * (k_), 4 * (k_) + 1), hh[2 * (k_)], a0, false); b0 = __builtin_amdgcn_fdot2(__builtin_shufflevector(r, r, 16 + 4 * (k_), 17 + 4 * (k_)), hh[2 * (k_)], b0, false); \
        a1 = __builtin_amdgcn_fdot2(__builtin_shufflevector(r, r, 4 * (k_) + 2, 4 * (k_) + 3), hh[2 * (k_) + 1], a1, false); b1 = __builtin_amdgcn_fdot2(__builtin_shufflevector(r, r, 18 + 4 * (k_), 19 + 4 * (k_)), hh[2 * (k_) + 1], b1, false);
        UDOT(0) UDOT(1) UDOT(2) UDOT(3)
#undef UDOT
        d[2 * i2] = a0 + a1;
        d[2 * i2 + 1] = b0 + b1;
        asm volatile("" : "+v"(d[2 * i2]), "+v"(d[2 * i2 + 1]));
      }
      if (pf) LOADGROUP(rp.uq, 0, rp.Ec);
      float tot;
      {
        auto s01 = __builtin_amdgcn_permlane32_swap(__float_as_uint(d[0]), __float_as_uint(d[1]), false, false);
        auto s23 = __builtin_amdgcn_permlane32_swap(__float_as_uint(d[2]), __float_as_uint(d[3]), false, false);
        auto s45 = __builtin_amdgcn_permlane32_swap(__float_as_uint(d[4]), __float_as_uint(d[5]), false, false);
        auto s67 = __builtin_amdgcn_permlane32_swap(__float_as_uint(d[6]), __float_as_uint(d[7]), false, false);
        const float q01 = __uint_as_float(s01[0]) + __uint_as_float(s01[1]), q23 = __uint_as_float(s23[0]) + __uint_as_float(s23[1]);
        const float q45 = __uint_as_float(s45[0]) + __uint_as_float(s45[1]), q67 = __uint_as_float(s67[0]) + __uint_as_float(s67[1]);
        auto ta = __builtin_amdgcn_permlane16_swap(__float_as_uint(q01), __float_as_uint(q23), false, false);
        auto tb = __builtin_amdgcn_permlane16_swap(__float_as_uint(q45), __float_as_uint(q67), false, false);
        const float r0123 = __uint_as_float(ta[0]) + __uint_as_float(ta[1]);
        const float r4567 = __uint_as_float(tb[0]) + __uint_as_float(tb[1]);
        const bool b3 = (lane & 8) != 0;
        const float keep = b3 ? r4567 : r0123, send = b3 ? r0123 : r4567;
        float x = keep + dpp_mov<0x140>(send);
        x += dpp_mov<0xB1>(x); x += dpp_mov<0x4E>(x); x += dpp_mov<0x141>(x);
        tot = x * gs.y;
      }
      float ge;
      {
        const float v = tot, av = fabsf(v), tq = __builtin_amdgcn_rcpf(av * 0.2316418882f + 1.0f);
        float q = tq * 0.5307027145f + (-0.7265760135f); q = q * tq + 0.7107068705f; q = q * tq + (-0.142248368f); q = q * tq + 0.127414796f; q = q * tq;
        const float ex = __builtin_amdgcn_exp2f(v * v * (-0.72134752044f));
        const float m = v * (q * ex), r = v - m;
        ge = (v < 0.f ? m : r) * gs.x;
      }
      unsigned cw[8];
      { const unsigned gp = __builtin_bit_cast(unsigned, __builtin_amdgcn_cvt_pkrtz(ge * 1024.f, ge * 1024.f));
        cw[0] = (unsigned)__builtin_amdgcn_readlane((int)gp, 0);  cw[4] = (unsigned)__builtin_amdgcn_readlane((int)gp, 8);
        cw[2] = (unsigned)__builtin_amdgcn_readlane((int)gp, 16); cw[6] = (unsigned)__builtin_amdgcn_readlane((int)gp, 24);
        cw[1] = (unsigned)__builtin_amdgcn_readlane((int)gp, 32); cw[5] = (unsigned)__builtin_amdgcn_readlane((int)gp, 40);
        cw[3] = (unsigned)__builtin_amdgcn_readlane((int)gp, 48); cw[7] = (unsigned)__builtin_amdgcn_readlane((int)gp, 56); }
      h16x2 a16[8];
#pragma unroll
      for (int i2 = 0; i2 < 4; ++i2) {
        const h16x32 r = __builtin_amdgcn_cvt_scalef32_pk32_f16_fp6(rp.vq[i2], 1.0f);
        const h16x2 ca = __builtin_bit_cast(h16x2, cw[2 * i2]), cb = __builtin_bit_cast(h16x2, cw[2 * i2 + 1]);
#define VAXL(k_) a16[k_] = (i2 == 0) ? ca * __builtin_shufflevector(r, r, 2 * (k_), 2 * (k_) + 1) : ca * __builtin_shufflevector(r, r, 2 * (k_), 2 * (k_) + 1) + a16[k_];
#define VAXH(k_) a16[k_] = cb * __builtin_shufflevector(r, r, 16 + 2 * (k_), 17 + 2 * (k_)) + a16[k_];
        VAXL(0) VAXL(1) VAXL(2) VAXL(3) VAXL(4) VAXL(5) VAXL(6) VAXL(7)
        asm volatile("" : "+v"(a16[0]), "+v"(a16[1]), "+v"(a16[2]), "+v"(a16[3]), "+v"(a16[4]), "+v"(a16[5]), "+v"(a16[6]), "+v"(a16[7]));
        VAXH(0) VAXH(1) VAXH(2) VAXH(3) VAXH(4) VAXH(5) VAXH(6) VAXH(7)
#undef VAXL
#undef VAXH
        asm volatile("" : "+v"(a16[0]), "+v"(a16[1]), "+v"(a16[2]), "+v"(a16[3]), "+v"(a16[4]), "+v"(a16[5]), "+v"(a16[6]), "+v"(a16[7]));
      }
#pragma unroll
      for (int k = 0; k < 8; ++k) acc2[k] = f32x2{(float)a16[k].x, (float)a16[k].y} * f32x2{1.f / 1024.f, 1.f / 1024.f} + acc2[k];
      if (pf) LOADGROUP(rp.vq, VOFS, rp.Ec);
      { const CAS i32x8* src_ = g8 < 14 ? EP + (g8 + 2) : EPn + (g8 - 14); rp.Ec = *src_; }
    }
    SBAR();
    float acc[16];
#pragma unroll
    for (int i = 0; i < 8; ++i) { acc[2 * i] = acc2[i].x; acc[2 * i + 1] = acc2[i].y; }
    const int mr = mod_row(row);
    const float* g2 = MOD + ((size_t)l * 5 + mr) * 6144 + 5 * 1024;
    float* xr = XC + (size_t)row * DM;
    float xn[16]; float ssq = 0.f;
    if (ABL & 8) {
#pragma unroll
      for (int i = 0; i < 16; ++i) acc[i] = 0.f;
    }
#pragma unroll
    for (int v4 = 0; v4 < 4; ++v4) {
      const int c = lane * 16 + v4 * 4;
      const f32x4 xo = xpre[v4], gg = *(const f32x4*)(g2 + c);
      f32x4 o;
      o.x = xo.x + gg.x * acc[v4 * 4 + 0]; o.y = xo.y + gg.y * acc[v4 * 4 + 1]; o.z = xo.z + gg.z * acc[v4 * 4 + 2]; o.w = xo.w + gg.w * acc[v4 * 4 + 3];
      xn[v4 * 4 + 0] = o.x; xn[v4 * 4 + 1] = o.y; xn[v4 * 4 + 2] = o.z; xn[v4 * 4 + 3] = o.w;
      ssq += (o.x * o.x + o.y * o.y) + (o.z * o.z + o.w * o.w);
      if (l < DEPTH - 1) *(f32x4*)(xr + c) = o;
    }
    const float rs = rsqrtf(wave_sum_fast(ssq) * (1.f / DM) + EPS);
    if (l == DEPTH - 1) {
      const int b = row / SEGL, s = row - b * SEGL;
      float* orow = p.out + ((size_t)(b * SEQ + (s - CTXL))) * DM;
      const float* fg = p.in[I_FINALG];
#pragma unroll
      for (int v4 = 0; v4 < 4; ++v4) {
        const int c = lane * 16 + v4 * 4;
        const f32x4 gg = *(const f32x4*)(fg + c);
        f32x4 o; o.x = xn[v4 * 4 + 0] * rs * gg.x; o.y = xn[v4 * 4 + 1] * rs * gg.y; o.z = xn[v4 * 4 + 2] * rs * gg.z; o.w = xn[v4 * 4 + 3] * rs * gg.w;
        *(f32x4*)(orow + c) = o;
      }
    } else {
      const float* m = MOD + ((size_t)(l + 1) * 5 + mr) * 6144;
      const float* ng = p.in[I_N1G] + (l + 1) * DM;
      bf16_t* hrow = (bf16_t*)(p.ws + WS_H) + (size_t)row * DM;
#pragma unroll
      for (int hh = 0; hh < 2; ++hh) {
        float y[8];
#pragma unroll
        for (int i = 0; i < 8; ++i) { const int c = lane * 16 + hh * 8 + i; y[i] = xn[hh * 8 + i] * rs * ng[c] * (1.f + m[1024 + c]) + m[c]; }
        u32x4 w; w.x = cvtpk(y[0], y[1]); w.y = cvtpk(y[2], y[3]); w.z = cvtpk(y[4], y[5]); w.w = cvtpk(y[6], y[7]);
        *(u32x4*)(hrow + lane * 16 + hh * 8) = w;
      }
    }
  }
}

__device__ __forceinline__ void phase_c1(const Params& p, int l, unsigned char* lds) {
  constexpr int NLOC = NBATCH * 4 * NCH, NCONV = T / 32;
  for (int u = p.bx; u < NLOC + NCONV; u += p.gx) {
    if (u < NLOC) ml_local_unit2(p, l, u, lds);
    else {
      const int cu = u - NLOC;
      if (l == DEPTH - 1 && (cu % (SEGL / 32)) < (CTXL / 32)) continue;
      conv_unit(p, l, cu, lds);
    }
  }
}
__device__ __forceinline__ void phase_c2(const Params& p, int l, unsigned char* lds) {
  ml_scan(p, lds);
  const float* lp = p.in[I_DLAM] + l * 256;
  float s01 = 0.f, s23 = 0.f;
  for (int i = 0; i < 64; ++i) { s01 += lp[i] * lp[64 + i]; s23 += lp[128 + i] * lp[192 + i]; }
  const float lam_init = 0.8f - 0.6f * expf(-0.3f * (float)l);
  const float lam = expf(s01) - expf(s23) + lam_init;
  const bf16_t* PROJ = (const bf16_t*)(p.ws + WS_PROJ);
  bf16_t* MIX = (bf16_t*)(p.ws + WS_MIX);
  const float* ng = p.in[I_DNORMG] + l * 128;
  const int nun = 512 + (l < DEPTH - 1 ? 16 : 0);
  for (int u = p.bx; u < nun; u += p.gx) {
    int bh, qrow, nkeys;
    if (u < 512) { const int xcd = u & 7, i = (u >> 3) & 31, rnd = u >> 8; bh = 2 * xcd + rnd; qrow = CTXL + i * 256; nkeys = SEGL; }
    else { bh = u - 512; qrow = 0; nkeys = CTXL; }
    const int b = bh >> 2, h = bh & 3;
    const size_t tok0 = (size_t)b * SEGL;
    for (int rep = 0; rep < REP_ATT; ++rep)
    att_unit(PROJ + (tok0 + qrow) * PW + C_DQ + h * 128, PROJ + tok0 * PW + C_DK + h * 128, p.ws + WS_V8T + (size_t)bh * NCH * ATT_SHM_V,
             MIX + (tok0 + qrow) * DM + 512 + h * 128, nkeys, lam, ng, 1.f - lam_init, lds);
  }
}
__device__ __forceinline__ void phase_c3(const Params& p, int l, unsigned char* lds) {
  constexpr int NU = NBATCH * 4 * NCH;
  for (int u = p.bx; u < NU; u += p.gx) {
    if (l == DEPTH - 1 && (u % NCH) < 4) continue;
    ml_out_unit2(p, l, u, lds);
  }
}
__device__ __forceinline__ void phase_route(const Params& p, int l, unsigned char* lds) {
  constexpr int NU = T / 32;
  for (int u = p.bx; u < NU; u += p.gx) {
    if (l == DEPTH - 1 && (u % (SEGL / 32)) < (CTXL / 32)) continue;
    route_unit(p, l, u, lds);
    __syncthreads();
  }
}
__device__ __forceinline__ void phase_gather(const Params& p, int l, unsigned char* lds) {
  int tid_ = tidx(); asm volatile("" : "+v"(tid_)); const int lane = tid_ & 63, wid = __builtin_amdgcn_readfirstlane(tid_ >> 6);
  const int gw = p.bx * 8 + wid, NGW = p.gx * 8;
  const int ntok = (l == DEPTH - 1) ? NBATCH * SEQ : T;
#define TOKROW(ti_) ((l == DEPTH - 1) ? ((ti_) / SEQ) * SEGL + CTXL + ((ti_) % SEQ) : (ti_))
  const CAS unsigned char* eidg = (const CAS unsigned char*)(p.ws + WS_EID + (size_t)l * RT_STRIDE);
  const __amdgpu_buffer_rsrc_t rsT = __builtin_amdgcn_make_buffer_rsrc((void*)(p.ws + WS_PU + (size_t)l * NEXP * PROW), 0, VOFS + NEXP * PROW, 0x00020000);
  TokPref tp; RowPipe rp;
  if (gw < ntok) {
    const int row0 = TOKROW(gw); const int lane12 = lane * 12;
    tok_prefetch(p, row0, lane, tp);
    const CAS i32x8* EP0 = eid_row(eidg, row0);
    rp.Ec = EP0[0];
    LOADGROUP(rp.uq, 0, rp.Ec); LOADGROUP(rp.vq, VOFS, rp.Ec);
    rp.Ec = EP0[1];
  }
  XcdBarrier xb; xb.bar = p.xbar_words; xb.x = p.xbar_x; xb.st = (volatile LAS unsigned*)((LAS unsigned char*)lds + p.lds_st_off);
  const int nrounds = (ntok + NGW - 1) / NGW;
  for (int r = 0; r < nrounds; ++r) {
    const int ti = gw + r * NGW;
    if (ti < ntok) {
      const int row = TOKROW(ti);
      const int nxt = ti + NGW < ntok ? TOKROW(ti + NGW) : -1;
      gather_token(p, eidg, rsT, l, row, nxt, tp, rp, lds, lane, wid);
    }
#if GATHER_SYNC
    if (r + 1 < nrounds) { XcdBarrier xb2 = xb; size_t zb_ = 0; asm volatile("" : "+s"(zb_)); xb2.bar = xb.bar + zb_; xb2.x = xb.x + (unsigned)zb_; xcd_barrier(xb2); }
#endif
  }
#undef TOKROW
}

__global__ void __launch_bounds__(512, 2) mk_fwd(KArgs ka) {
  cg::grid_group grid = cg::this_grid();
  extern __shared__ __attribute__((aligned(16))) unsigned char lds[];
  const int lo = ka.ph_lo, hi = ka.ph_hi;
#define IN(k) (lo <= (k) && (k) < hi)
#ifndef PHASEMASK
#define PHASEMASK 0xFFFF
#endif
#define PH(i) ((PHASEMASK >> (i)) & 1)
#define MKP(q) Params q; { size_t z_ = 0; asm volatile("" : "+s"(z_)); \
    q.in = (InTab)((const __attribute__((address_space(4))) char*)__builtin_amdgcn_kernarg_segment_ptr() + z_); \
    q.out = ka.out + z_; q.ws = ka.ws + z_; q.ph_lo = lo; q.ph_hi = hi; q.bx = (int)blockIdx.x + (int)z_; q.gx = (int)gridDim.x + (int)z_; q.xbar_words = xbar.bar + z_; q.xbar_x = xbar.x + (unsigned)z_; q.lds_st_off = (unsigned)(LDS_BYTES - 64); }
#define SEAM(k) do { if (IN(k) && IN((k) + 1)) { if ((k) == 0) grid.sync(); else { XcdBarrier xb_ = xbar; size_t zb_ = 0; asm volatile("" : "+s"(zb_)); xb_.bar = xbar.bar + zb_; xb_.x = xbar.x + (unsigned)zb_; xcd_barrier(xb_); } } } while (0)
  volatile LAS unsigned* xst = (volatile LAS unsigned*)((LAS unsigned char*)lds + (LDS_BYTES - 64));
  { const int t0_ = threadIdx.x;
    if (t0_ < 2) xst[t0_] = 0u;
    if ((t0_ & 63) == 0) *(volatile LAS int*)((LAS unsigned char*)lds + LDS_WTAB + 4 * hw_wave_key()) = t0_ >> 6; }
  __syncthreads();
  XcdBarrier xbar = xcd_barrier_post((unsigned*)(ka.ws + WS_CTL) + 4096, xst);
  { MKP(p)
    if (PH(0) && IN(0)) for (int rep = 0; rep < REP_MISC; ++rep) { p0_mod(p, lds, (float*)(p.ws + WS_MOD)); p0_convert(p, lds); }
  }
  SEAM(0);
  { MKP(p)
    if (PH(1) && IN(1)) phase_norm(p, 0, 0, true, false);
  }
  SEAM(1);
#define LAYER(LL) { \
    int l = (LL); asm volatile("" : "+s"(l)); \
    const int b = 2 + 9 * (LL); \
    { MKP(q) if (PH(2) && IN(b + 0)) for (int rep = 0; rep < REP_GEMM; ++rep) phase_inproj2(q, l, lds); } \
    SEAM(b + 0); \
    { MKP(q) if (PH(3) && IN(b + 1)) for (int rep = 0; rep < REP_ML; ++rep) phase_c1(q, l, lds); } \
    SEAM(b + 1); \
    { MKP(q) if (PH(4) && IN(b + 2)) phase_c2(q, l, lds); } \
    SEAM(b + 2); \
    { MKP(q) if (PH(5) && IN(b + 3)) for (int rep = 0; rep < REP_ML; ++rep) phase_c3(q, l, lds); } \
    SEAM(b + 3); \
    { MKP(q) if (PH(6) && IN(b + 4)) phase_outproj2(q, l, lds); } \
    SEAM(b + 4); \
    { MKP(q) if (PH(7) && IN(b + 5)) for (int rep = 0; rep < REP_MISC; ++rep) phase_norm(q, l, 1, false, (LL) == DEPTH - 1); } \
    SEAM(b + 5); \
    { MKP(q) if (PH(8) && IN(b + 6)) for (int rep = 0; rep < REP_GEMM; ++rep) phase_peerq2(q, l, lds); } \
    SEAM(b + 6); \
    { MKP(q) if (PH(9) && IN(b + 7)) phase_route(q, l, lds); } \
    SEAM(b + 7); \
    { MKP(q) if (PH(9) && IN(b + 8)) phase_gather(q, l, lds); } \
    SEAM(b + 8); }
  LAYER(0) LAYER(1) LAYER(2) LAYER(3)
#undef LAYER
#undef IN
#undef SEAM
#undef MKP
}

extern "C" void kernel_launch(void* const* d_in, const int* in_sizes, int n_in, void* d_out, int out_size,
                              void* d_ws, size_t ws_size, hipStream_t stream) {
  static int grid = 0;
  if (grid == 0) {
    int dev = 0, cus = 0, per_cu = 0;
    (void)hipGetDevice(&dev);
    (void)hipDeviceGetAttribute(&cus, hipDeviceAttributeMultiprocessorCount, dev);
    (void)hipFuncSetAttribute((const void*)mk_fwd, hipFuncAttributeMaxDynamicSharedMemorySize, LDS_BYTES);
    (void)hipOccupancyMaxActiveBlocksPerMultiprocessor(&per_cu, (const void*)mk_fwd, 512, LDS_BYTES);
    fprintf(stderr, "kernel_launch: cus %d per_cu %d ws %zu (need %zu) n_in %d\n", cus, per_cu, ws_size, (size_t)WS_END, n_in);
    if (ws_size < WS_END || n_in != 23 || per_cu < 1) { fprintf(stderr, "kernel_launch: bad configuration, nothing launched\n"); grid = -1; return; }
    grid = cus;
  }
  if (grid < 0) return;
  (void)hipMemsetAsync((char*)d_ws + WS_CTL, 0, 65536, stream);
  KArgs p{};
  for (int i = 0; i < 23; ++i) p.in[i] = (const float*)d_in[i];
  p.out = (float*)d_out; p.ws = (unsigned char*)d_ws; p.ph_lo = 0; p.ph_hi = 38;
  void* args[] = {&p};
  hipError_t e = hipLaunchCooperativeKernel((const void*)mk_fwd, dim3(grid), dim3(512), args, LDS_BYTES, stream);
  if (e != hipSuccess) fprintf(stderr, "cooperative launch failed: %s (grid %d)\n", hipGetErrorString(e), grid);
}
```

```cpp
#include <hip/hip_runtime.h>
#include <hip/hip_cooperative_groups.h>
#include <cstdio>
#include <cstdint>
namespace cg = cooperative_groups;

constexpr int DM = 1024, NBATCH = 4, SEQ = 8192, CTXL = 256, SEGL = CTXL + SEQ, T = NBATCH * SEGL, DEPTH = 4;
constexpr int IN_W = 3088, PW = 3072;
constexpr int C_A = 0, C_MQ = 512, C_MK = 768, C_MV = 1024, C_MO = 1280, C_DQ = 1536, C_DK = 2048, C_DV = 2560;
constexpr int NCH = SEGL / 64;
constexpr int NEXP = 16384;
constexpr float EPS = 1e-6f;
#ifndef ABL
#define ABL 0
#endif
#ifndef GATHER_SYNC
#define GATHER_SYNC 0
#endif
#ifndef REP_ATT
#define REP_ATT 1
#endif
#ifndef GP_MASK
#define GP_MASK 0x3FFF
#endif
#ifndef REP_PEER
#define REP_PEER 1
#endif
#ifndef REP_GEMM
#define REP_GEMM 1
#endif
#ifndef REP_ROUTE
#define REP_ROUTE 1
#endif
#ifndef REP_OUTP
#define REP_OUTP 1
#endif
#ifndef REP_ML
#define REP_ML 1
#endif
#ifndef REP_MISC
#define REP_MISC 1
#endif
constexpr float QSCALE = 0.125f * 1.4426950408889634f;

constexpr size_t MiB = 1u << 20;
constexpr size_t WS_CTL = 0, WS_MOD = 1 * MiB, WS_ROPE = 2 * MiB, WS_WG = 4 * MiB, WS_KEYS = 5 * MiB, WS_MLMETA = 6 * MiB,
                 WS_GATES = 7 * MiB, WS_WIN = 10 * MiB, WS_WOUT = 34 * MiB, WS_WQ = 42 * MiB, WS_PU = 50 * MiB, WS_PV = 114 * MiB, WS_PSC = 178 * MiB  ,
                 WS_XCUR = 306 * MiB, WS_H = 438 * MiB, WS_MIX = 504 * MiB, WS_PROJ = 570 * MiB, WS_ULOC = 768 * MiB, WS_V8T = 836 * MiB  , WS_EID = 858 * MiB  , WS_END = 924 * MiB;
constexpr int USTRIDE = 4160;

constexpr int LDS_BYTES = 139264 + 512;
constexpr int LDS_WTAB = LDS_BYTES - 64 - 256;

#define LAS __attribute__((address_space(3)))
__device__ __forceinline__ int hw_wave_key() { return (int)(__builtin_amdgcn_s_getreg((5 << 11) | 4) & 63u); }
__device__ __forceinline__ int tidx() {
  extern __shared__ __attribute__((aligned(16))) unsigned char lds_dyn_[];
  const int w = __builtin_amdgcn_readfirstlane(*(const volatile LAS int*)((LAS unsigned char*)lds_dyn_ + LDS_WTAB + 4 * hw_wave_key()));
  unsigned z_ = 0u; asm volatile("" : "+v"(z_));
  return (w << 6) | (int)__builtin_amdgcn_mbcnt_hi(~0u, __builtin_amdgcn_mbcnt_lo(~0u, z_));
}
typedef unsigned short bf16_t;
typedef short bf16x8 __attribute__((ext_vector_type(8)));
typedef short s16x4 __attribute__((ext_vector_type(4)));
typedef float f32x4 __attribute__((ext_vector_type(4)));
typedef float f32x16 __attribute__((ext_vector_type(16)));
typedef unsigned u32x4 __attribute__((ext_vector_type(4)));
typedef unsigned u32x2 __attribute__((ext_vector_type(2)));
typedef __bf16 bf16x2v __attribute__((ext_vector_type(2)));
typedef int i32x8 __attribute__((ext_vector_type(8)));
typedef int i32x6 __attribute__((ext_vector_type(6)));
struct __attribute__((aligned(4))) u32x3 { unsigned x, y, z; };
typedef float f32x32 __attribute__((ext_vector_type(32)));
constexpr int PROW = 768;
typedef float f32x2 __attribute__((ext_vector_type(2)));
typedef _Float16 h16x2 __attribute__((ext_vector_type(2)));
typedef _Float16 h16x32 __attribute__((ext_vector_type(32)));
typedef unsigned u32x3v __attribute__((ext_vector_type(3)));
typedef unsigned u32x2v __attribute__((ext_vector_type(2)));

struct KArgs {
  const float* in[23];
  float* out;
  unsigned char* ws;
  int ph_lo, ph_hi;
};
typedef const float* const __attribute__((address_space(4))) * InTab;
struct Params {
  InTab in;
  float* out;
  unsigned char* ws;
  int ph_lo, ph_hi;
  int bx, gx;
  unsigned* xbar_words; unsigned xbar_x; unsigned lds_st_off;
};
enum { I_X = 0, I_C, I_CTX, I_CCTX, I_ADAW, I_ADAB, I_N1G, I_N2G, I_WIN, I_CONVW, I_CONVB, I_CLNG, I_CLNB, I_GATEB, I_MNORMG, I_DLAM, I_DNORMG,
       I_WOUT, I_PWQ, I_PKEYS, I_PU, I_PV, I_FINALG };

__device__ __forceinline__ unsigned cvtpk(float lo, float hi) { unsigned r; asm volatile("v_cvt_pk_bf16_f32 %0, %1, %2" : "=v"(r) : "v"(lo), "v"(hi)); return r; }
__device__ __forceinline__ float bflo(unsigned u) { return __uint_as_float(u << 16); }
__device__ __forceinline__ float bfhi(unsigned u) { return __uint_as_float(u & 0xffff0000u); }
__device__ __forceinline__ float bf1(bf16_t u) { return __uint_as_float(((unsigned)u) << 16); }
__device__ __forceinline__ int crow(int r, int hi) { return (r & 3) + 8 * (r >> 2) + 4 * hi; }
template <int CTRL> __device__ __forceinline__ float dpp_mov(float v) {
  return __uint_as_float((unsigned)__builtin_amdgcn_update_dpp(0, (int)__float_as_uint(v), CTRL, 0xF, 0xF, true));
}
__device__ __forceinline__ float wave_sum_fast(float x) {
  x += dpp_mov<0xB1>(x); x += dpp_mov<0x4E>(x); x += dpp_mov<0x141>(x); x += dpp_mov<0x140>(x);
  { auto r = __builtin_amdgcn_permlane16_swap(__float_as_uint(x), __float_as_uint(x), false, false); x = __uint_as_float(r[0]) + __uint_as_float(r[1]); }
  { auto r = __builtin_amdgcn_permlane32_swap(__float_as_uint(x), __float_as_uint(x), false, false); x = __uint_as_float(r[0]) + __uint_as_float(r[1]); }
  return x;
}
__device__ __forceinline__ float wave_max_fast(float x) {
  x = fmaxf(x, dpp_mov<0xB1>(x)); x = fmaxf(x, dpp_mov<0x4E>(x)); x = fmaxf(x, dpp_mov<0x141>(x)); x = fmaxf(x, dpp_mov<0x140>(x));
  { auto r = __builtin_amdgcn_permlane16_swap(__float_as_uint(x), __float_as_uint(x), false, false); x = fmaxf(__uint_as_float(r[0]), __uint_as_float(r[1])); }
  { auto r = __builtin_amdgcn_permlane32_swap(__float_as_uint(x), __float_as_uint(x), false, false); x = fmaxf(__uint_as_float(r[0]), __uint_as_float(r[1])); }
  return x;
}
__device__ __forceinline__ float wave_sum(float v) {
#pragma unroll
  for (int o = 1; o < 64; o <<= 1) v += __shfl_xor(v, o);
  return v;
}
__device__ __forceinline__ float wave_max(float v) {
#pragma unroll
  for (int o = 1; o < 64; o <<= 1) v = fmaxf(v, __shfl_xor(v, o));
  return v;
}
__device__ __forceinline__ float sigmoidf_(float x) { return 1.f / (1.f + __expf(-x)); }
__device__ __forceinline__ float logsigmoidf_(float x) { return fminf(x, 0.f) - log1pf(__expf(-fabsf(x))); }
__device__ __forceinline__ const float* in_row(const float* x, const float* ctx, int row) {
  const int b = row / SEGL, s = row - b * SEGL;
  return s < CTXL ? ctx + ((size_t)(b * CTXL + s)) * DM : x + ((size_t)(b * SEQ + (s - CTXL))) * DM;
}
__device__ __forceinline__ int mod_row(int row) { const int b = row / SEGL, s = row - b * SEGL; return s < CTXL ? 4 : b; }

__device__ __forceinline__ void p0_mod(const Params& p, unsigned char* lds, float* MOD) {
  float* sil = (float*)lds;
  float* red = (float*)(lds + 20480);
  int tid_ = tidx(); asm volatile("" : "+v"(tid_)); const int tid = tid_, lane = tid & 63, wid = tid >> 6;
  for (int i = tid; i < 5 * 1024; i += 512) {
    const float v = i < 4096 ? p.in[I_C][i] : p.in[I_CCTX][i - 4096];
    sil[i] = v / (1.f + __expf(-v));
  }
  __syncthreads();
  for (int item = p.bx; item < DEPTH * 96; item += p.gx) {
    const int l = item / 96, j0 = (item % 96) * 64;
    const float* W = p.in[I_ADAW] + (size_t)l * DM * 6144 + j0 + lane;
    float a0 = 0.f, a1 = 0.f, a2 = 0.f, a3 = 0.f, a4 = 0.f;
    const int k0 = wid * 128;
#pragma unroll 8
    for (int k = k0; k < k0 + 128; ++k) {
      const float w = W[(size_t)k * 6144];
      a0 += sil[k] * w; a1 += sil[1024 + k] * w; a2 += sil[2048 + k] * w; a3 += sil[3072 + k] * w; a4 += sil[4096 + k] * w;
    }
    red[(wid * 5 + 0) * 64 + lane] = a0; red[(wid * 5 + 1) * 64 + lane] = a1; red[(wid * 5 + 2) * 64 + lane] = a2;
    red[(wid * 5 + 3) * 64 + lane] = a3; red[(wid * 5 + 4) * 64 + lane] = a4;
    __syncthreads();
    if (tid < 320) {
      const int r = tid >> 6;
      float s = 0.f;
#pragma unroll
      for (int w = 0; w < 8; ++w) s += red[(w * 5 + r) * 64 + lane];
      MOD[((size_t)l * 5 + r) * 6144 + j0 + lane] = s + p.in[I_ADAB][l * 6144 + j0 + lane];
    }
    __syncthreads();
  }
}
__device__ __forceinline__ void transpose_item(const float* W, int ldw, int srccol0, bf16_t* WT, int K, int n0, int k0, float* scr, int lane) {
#pragma unroll 8
  for (int i = 0; i < 32; ++i) { const int kk = 2 * i + (lane >> 5); scr[kk * 33 + (lane & 31)] = W[(size_t)(k0 + kk) * ldw + srccol0 + (lane & 31)]; }
  asm volatile("s_waitcnt lgkmcnt(0)" ::: "memory");
  const int c = lane & 7;
#pragma unroll
  for (int j = 0; j < 4; ++j) {
    const int n = (lane >> 3) + 8 * j; const float* s = scr + (8 * c) * 33 + n;
    u32x4 o; o.x = cvtpk(s[0], s[33]); o.y = cvtpk(s[66], s[99]); o.z = cvtpk(s[132], s[165]); o.w = cvtpk(s[198], s[231]);
    *(u32x4*)(WT + (size_t)(n0 + n) * K + k0 + 8 * c) = o;
  }
  asm volatile("s_waitcnt lgkmcnt(0)" ::: "memory");
}
__device__ __forceinline__ void convert_tables(const Params& p, int L, int wv, int nw, int lane) {
  unsigned char* PUq = p.ws + WS_PU; unsigned char* PVq = p.ws + WS_PV; float* PSC = (float*)(p.ws + WS_PSC);
  const int nrows = DEPTH * NEXP;
#define TAB_SROW(r_) ((const f32x4*)(((r_) >= NEXP ? p.in[I_PV] : p.in[I_PU]) + (size_t)(L * NEXP + ((r_) >= NEXP ? (r_) - NEXP : (r_))) * DM) + lane * 4)
  f32x4 vn[4];
  if (wv < 2 * NEXP) { const f32x4* s0_ = TAB_SROW(wv);
#pragma unroll
    for (int j = 0; j < 4; ++j) vn[j] = __builtin_nontemporal_load(s0_ + j); }
  for (int r = wv; r < 2 * NEXP; r += nw) {
    const int tb = r >= NEXP, rr = L * NEXP + (tb ? r - NEXP : r);
    f32x4 v[4]; float mx = 0.f;
#pragma unroll
    for (int j = 0; j < 4; ++j) { v[j] = vn[j]; mx = fmaxf(mx, fmaxf(fmaxf(fabsf(v[j].x), fabsf(v[j].y)), fmaxf(fabsf(v[j].z), fabsf(v[j].w)))); }
    if (r + nw < 2 * NEXP) { const f32x4* sn_ = TAB_SROW(r + nw);
#pragma unroll
      for (int j = 0; j < 4; ++j) vn[j] = __builtin_nontemporal_load(sn_ + j); }
    mx = wave_max_fast(mx);
    const unsigned mb = __float_as_uint(mx);
    const int eb = (int)((mb >> 23) & 0xFFu);
    int sb = ((mb & 0x7FFFFFu) <= 0x700000u ? 129 : 128) - eb + 127; sb = sb < 1 ? 1 : (sb > 253 ? 253 : sb);
    const float sc = __uint_as_float((unsigned)sb << 23), isc = __uint_as_float((unsigned)(254 - sb) << 23);
    const float xv[16] = {v[0].x, v[0].y, v[0].z, v[0].w, v[1].x, v[1].y, v[1].z, v[1].w, v[2].x, v[2].y, v[2].z, v[2].w, v[3].x, v[3].y, v[3].z, v[3].w};
    unsigned wq[3] = {0u, 0u, 0u};
#pragma unroll
    for (int i = 0; i < 16; ++i) {
      const float a = fabsf(xv[i]) * sc;
      unsigned code = a < 2.f ? (unsigned)__builtin_rintf(a * 8.f) : (a < 4.f ? 8u + (unsigned)__builtin_rintf(a * 4.f) : 16u + (unsigned)__builtin_rintf(a * 2.f));
      code = code > 31u ? 31u : code;
      code |= (xv[i] < 0.f) ? 32u : 0u;
      const int bp = 6 * i, dw = bp >> 5, off = bp & 31;
      wq[dw] |= code << off;
      if (off > 26) wq[dw + 1] |= code >> (32 - off);
    }
    u32x3 o; o.x = wq[0]; o.y = wq[1]; o.z = wq[2];
    *(u32x3*)((tb ? PVq : PUq) + (size_t)rr * PROW + lane * 12) = o;
    if (lane == 0) PSC[(size_t)tb * nrows + rr] = isc;
  }
#undef TAB_SROW
}
__device__ __forceinline__ void tail_filler_tables(const Params& p, int L, int nwg) {
  int tid_ = tidx(); asm volatile("" : "+v"(tid_)); const int lane = tid_ & 63, wid = tid_ >> 6;
  const int nextra = nwg % p.gx, first = nextra, nidle = p.gx - nextra;
  if (p.bx < first) return;
  convert_tables(p, L, (p.bx - first) * 8 + wid, nidle * 8, lane);
}
__device__ __forceinline__ void p0_convert(const Params& p, unsigned char* lds) {
  int tid_ = tidx(); asm volatile("" : "+v"(tid_)); const int tid = tid_, lane = tid & 63, wid = tid >> 6;
  const int gw = p.bx * 8 + wid, NGW = p.gx * 8;
  const size_t gt = (size_t)p.bx * 512 + tid, NGT = (size_t)p.gx * 512;
  float* scr = (float*)(lds + 32768) + wid * (64 * 33);
  bf16_t* WIN = (bf16_t*)(p.ws + WS_WIN); bf16_t* WOUT = (bf16_t*)(p.ws + WS_WOUT); bf16_t* WQ = (bf16_t*)(p.ws + WS_WQ);
  constexpr int I_IN = 16 * 96, I_O = 16 * 32, PER_L = I_IN + 2 * I_O;
  for (int it = gw; it < DEPTH * PER_L; it += NGW) {
    const int l = it / PER_L; int r = it % PER_L;
    if (r < I_IN) { const int kb = r / 96, nb = r % 96, n0 = nb * 32; const int src = n0 < 1536 ? n0 : n0 + 16;
      transpose_item(p.in[I_WIN] + (size_t)l * DM * IN_W, IN_W, src, WIN + (size_t)l * PW * DM, DM, n0, kb * 64, scr, lane); continue; }
    r -= I_IN;
    if (r < I_O) { const int kb = r / 32, nb = r % 32;
      transpose_item(p.in[I_WOUT] + (size_t)l * DM * DM, DM, nb * 32, WOUT + (size_t)l * DM * DM, DM, nb * 32, kb * 64, scr, lane); continue; }
    r -= I_O;
    { const int kb = r / 32, nb = r % 32;
      transpose_item(p.in[I_PWQ] + (size_t)l * DM * DM, DM, nb * 32, WQ + (size_t)l * DM * DM, DM, nb * 32, kb * 64, scr, lane); }
  }
  bf16_t* WG = (bf16_t*)(p.ws + WS_WG);
  for (size_t i = gt; i < (size_t)DEPTH * 16 * DM; i += NGT) {
    const int l = (int)(i / (16 * DM)), g = (int)((i / DM) % 16), k = (int)(i % DM);
    WG[i] = (bf16_t)(cvtpk(p.in[I_WIN][(size_t)l * DM * IN_W + (size_t)k * IN_W + 1536 + g], 0.f) & 0xffffu);
  }
  bf16_t* KEYS = (bf16_t*)(p.ws + WS_KEYS);
  for (size_t i = gt; i < (size_t)DEPTH * 131072 / 8; i += NGT) {
    const f32x4 a = ((const f32x4*)p.in[I_PKEYS])[2 * i], b = ((const f32x4*)p.in[I_PKEYS])[2 * i + 1];
    u32x4 o; o.x = cvtpk(a.x, a.y); o.y = cvtpk(a.z, a.w); o.z = cvtpk(b.x, b.y); o.w = cvtpk(b.z, b.w);
    ((u32x4*)KEYS)[i] = o;
  }
  {
    float* RC = (float*)(p.ws + WS_ROPE); float* RS = RC + SEQ * 32;
    for (size_t i = gt; i < (size_t)SEQ * 32; i += NGT) {
      const int pos = (int)(i >> 5), j = (int)(i & 31);
      const int rr = pos >> 6, cc = pos & 63;
      const int jj = j & 15;
      const double e = -(double)jj * 0.83048202372184058696;
      const double fl = __builtin_floor(e); const double f = e - fl;
      const double z = f * 0.69314718055994530942;
      double ez = 1.0 + z * (1.0 + z * (0.5 + z * (1.0 / 6 + z * (1.0 / 24 + z * (1.0 / 120 + z * (1.0 / 720 + z * (1.0 / 5040 + z * (1.0 / 40320 + z * (1.0 / 362880 + z * (1.0 / 3628800 + z * (1.0 / 39916800 + z * (1.0 / 479001600))))))))))));
      const double inv = __builtin_ldexp(ez, (int)fl);
      const float invf = (float)inv;
      const float angf = (float)(j < 16 ? rr : cc) * invf;
      const double ang = (double)angf;
      const double kq = __builtin_rint(ang * 0.63661977236758134308);
      double r = __builtin_fma(-kq, 1.57079632679489655800e+00, ang);
      r = __builtin_fma(-kq, 6.12323399573676603587e-17, r);
      const double r2 = r * r;
      const double sn = r * (1.0 + r2 * (-1.0 / 6 + r2 * (1.0 / 120 + r2 * (-1.0 / 5040 + r2 * (1.0 / 362880 + r2 * (-1.0 / 39916800 + r2 * (1.0 / 6227020800.0)))))));
      const double cs = 1.0 + r2 * (-0.5 + r2 * (1.0 / 24 + r2 * (-1.0 / 720 + r2 * (1.0 / 40320 + r2 * (-1.0 / 3628800 + r2 * (1.0 / 479001600 + r2 * (-1.0 / 87178291200.0)))))));
      const int q = ((int)kq) & 3;
      double co, si;
      if (q == 0) { co = cs; si = sn; } else if (q == 1) { co = -sn; si = cs; } else if (q == 2) { co = -cs; si = -sn; } else { co = sn; si = -cs; }
      RC[i] = (float)co; RS[i] = (float)si;
    }
  }
}

__device__ __forceinline__ void norm_mod_row(const float* xrow, const float* g, const float* sc, const float* sh, bf16_t* orow, int lane) {
  const f32x4* xr = (const f32x4*)xrow + lane;
  f32x4 v[4]; float s = 0.f;
#pragma unroll
  for (int j = 0; j < 4; ++j) { v[j] = xr[64 * j]; s += (v[j].x * v[j].x + v[j].y * v[j].y) + (v[j].z * v[j].z + v[j].w * v[j].w); }
  const float rs = rsqrtf(wave_sum(s) * (1.f / DM) + EPS);
  u32x2* o = (u32x2*)orow + lane;
#pragma unroll
  for (int j = 0; j < 4; ++j) {
    const f32x4 gg = ((const f32x4*)g)[lane + 64 * j], cc = ((const f32x4*)sc)[lane + 64 * j], hh = ((const f32x4*)sh)[lane + 64 * j];
    const float y0 = v[j].x * rs * gg.x * (1.f + cc.x) + hh.x, y1 = v[j].y * rs * gg.y * (1.f + cc.y) + hh.y;
    const float y2 = v[j].z * rs * gg.z * (1.f + cc.z) + hh.z, y3 = v[j].w * rs * gg.w * (1.f + cc.w) + hh.w;
    u32x2 w; w.x = cvtpk(y0, y1); w.y = cvtpk(y2, y3);
    o[64 * j] = w;
  }
}
__device__ __forceinline__ void phase_norm(const Params& p, int l, int which, bool from_input, bool skip_ctx) {
  int tid_ = tidx(); asm volatile("" : "+v"(tid_));
  const int lane = tid_ & 63, wid = tid_ >> 6;
  const int gw = p.bx * 8 + wid, NGW = p.gx * 8;
  const float* MOD = (const float*)(p.ws + WS_MOD);
  const float* XC = (const float*)(p.ws + WS_XCUR);
  bf16_t* H = (bf16_t*)(p.ws + WS_H);
  const float* g = p.in[which ? I_N2G : I_N1G] + l * DM;
  for (int row = gw; row < T; row += NGW) {
    const int mr = mod_row(row);
    if (skip_ctx && mr == 4) continue;
    const float* m = MOD + ((size_t)l * 5 + mr) * 6144 + which * 3072;
    const float* xr = from_input ? in_row(p.in[I_X], p.in[I_CTX], row) : XC + (size_t)row * DM;
    norm_mod_row(xr, g, m + 1024, m, H + (size_t)row * DM, lane);
  }
}

namespace pg8 {
#define PG8_LAS __attribute__((address_space(3)))
typedef unsigned short bf16_t;
typedef short bf16x8 __attribute__((ext_vector_type(8)));
typedef float f32x4 __attribute__((ext_vector_type(4)));
typedef unsigned u32x4 __attribute__((ext_vector_type(4)));
constexpr int BM = 256, BK = 64, HALF = 128, HTB = HALF * BK * 2  , STAGE_BYTES = 8 * HTB, NXCD = 8, WGM = 8;

__host__ __device__ __forceinline__ int lds_byte(int r, int c) { const int st = (r >> 4) * 2 + (c >> 5), rr = r & 15, cc = c & 31, ob = rr * 64 + cc * 2; return st * 1024 + (ob ^ (((ob >> 9) & 1) << 5)); }
__host__ __device__ __forceinline__ void stage_rc(int b, int& R, int& C) { const int st = b / 1024, sb = b % 1024, swz = sb ^ (((sb >> 9) & 1) << 5); R = (st >> 1) * 16 + swz / 64; C = (st & 1) * 32 + (swz % 64) / 2; }
__host__ __device__ __forceinline__ int perm32(int rho) { const int n = rho >> 4, i = rho & 15; return 8 * (i >> 2) + 4 * n + (i & 3); }

struct Unit { int pm, pn; };
struct Gemm { const bf16_t* A; const bf16_t* Bt; int M, N, K; };

struct StaticOrder {
    int nM, nN, nwg, G, c;
    __host__ __device__ void init(int M, int N, int G_, int c_) { nM = M / BM; nN = N / BM; nwg = nM * nN; G = G_; c = c_; }
    __host__ __device__ bool next(int i, Unit& u) const {
        const long L = (long)i * G + c; if (L >= nwg) return false;
        int wgid = (int)L; { const int q = nwg / NXCD, r = nwg % NXCD, xcd = wgid % NXCD, off = wgid / NXCD; wgid = (xcd < r ? xcd * (q + 1) : r * (q + 1) + (xcd - r) * q) + off; }
        const int nig = WGM * nN, gid = wgid / nig, fm = gid * WGM, gsz = (nM - fm) < WGM ? (nM - fm) : WGM;
        u.pm = fm + ((wgid % nig) % gsz); u.pn = (wgid % nig) / gsz; return true;
    }
    __device__ __forceinline__ void a_ready(const Unit&) const {}
    __device__ __forceinline__ void done(const Unit&) const {}
};
__device__ __forceinline__ unsigned cvt_pk_bf16(float lo, float hi) { unsigned r; asm volatile("v_cvt_pk_bf16_f32 %0, %1, %2" : "=v"(r) : "v"(lo), "v"(hi)); return r; }
template <class Epi, class Sched, bool ALIGN_EPI = false, bool SP2 = false>
__device__ __forceinline__ void gemm_phase(PG8_LAS unsigned char* lds, const Gemm g, const Sched& S, const Epi& E) {
    const int tid = tidx(), wid = __builtin_amdgcn_readfirstlane(tid >> 6), lane = tid & 63, wr = wid >> 2, wc = wid & 3, fr = lane & 15, fq = lane >> 4;
    const int K = g.K, nt = K / BK;
    unsigned voffA[2], voffB[2];
#pragma unroll
    for (int i = 0; i < 2; ++i) { int R, C; stage_rc(tid * 16 + i * 8192, R, C); const int Rb = Epi::PERM ? ((R & ~31) + perm32(R & 31)) : R;
        voffA[i] = (unsigned)(R * K + C) * 2u; voffB[i] = (unsigned)(Rb * K + C) * 2u; }
    const size_t kstep = (size_t)(BK * 2);
    const size_t hstep = (size_t)HALF * K * 2;
    const size_t tstep = 2 * hstep;
    const unsigned ldsw = (unsigned)wid * 1024u;
    const int aoff = lds_byte(wr * 64 + fr, fq * 8), boff = lds_byte(wc * 32 + fr, fq * 8);
#define PG8_SA(b, h) (((b) * 2 + (h)) * HTB)
#define PG8_SB(b, h) ((4 + (b) * 2 + (h)) * HTB)
#define PG8_STAGE(bufoff, gbase, voff) do { _Pragma("unroll") for (int _i = 0; _i < 2; ++_i) \
        __builtin_amdgcn_global_load_lds((const unsigned*)((const char*)(gbase) + (voff)[_i]), (PG8_LAS unsigned*)(lds + (bufoff) + ldsw + _i * 8192), 16, 0, 0); } while (0)
#define PG8_LDA(dst, b, h) do { _Pragma("unroll") for (int m = 0; m < 4; ++m) _Pragma("unroll") for (int k = 0; k < 2; ++k) dst[m][k] = *(const PG8_LAS bf16x8*)(lds + PG8_SA(b, h) + aoff + m * 2048 + k * 1024); } while (0)
#define PG8_LDB(dst, b, h) do { _Pragma("unroll") for (int n = 0; n < 2; ++n) _Pragma("unroll") for (int k = 0; k < 2; ++k) dst[n][k] = *(const PG8_LAS bf16x8*)(lds + PG8_SB(b, h) + boff + n * 2048 + k * 1024); } while (0)
#define PG8_MMA(ai, bj, At, Bt) do { __builtin_amdgcn_s_setprio(1); _Pragma("unroll") for (int m = 0; m < 4; ++m) _Pragma("unroll") for (int n = 0; n < 2; ++n) _Pragma("unroll") for (int k = 0; k < 2; ++k) \
        acc[ai][bj][m][n] = __builtin_amdgcn_mfma_f32_16x16x32_bf16(Bt[n][k], At[m][k], acc[ai][bj][m][n], 0, 0, 0); __builtin_amdgcn_s_setprio(0); } while (0)
#define PG8_WAIT_V(n) asm volatile("s_waitcnt vmcnt(" #n ")" ::: "memory")
#define PG8_WAIT_L(n) asm volatile("s_waitcnt lgkmcnt(" #n ")" ::: "memory")
#define PG8_BAR __builtin_amdgcn_s_barrier()
#define PG8_SCHED __builtin_amdgcn_sched_barrier(0)
    Unit cur, nxt; int ui = 0;
    if (!S.next(0, cur)) return;
    f32x4 acc[2][2][4][2];
#pragma unroll
    for (int a = 0; a < 2; ++a)
#pragma unroll
        for (int b = 0; b < 2; ++b)
#pragma unroll
            for (int m = 0; m < 4; ++m)
#pragma unroll
                for (int n = 0; n < 2; ++n) acc[a][b][m][n] = (f32x4){0.f, 0.f, 0.f, 0.f};
    bf16x8 At[4][2], B0[2][2], B1[2][2];
    const char* cA = (const char*)g.A + (size_t)cur.pm * tstep; const char* cB = (const char*)g.Bt + (size_t)cur.pn * tstep;
    S.a_ready(cur);
    if constexpr (SP2) {
        PG8_STAGE(PG8_SB(0, 0), cB, voffB); PG8_STAGE(PG8_SB(0, 1), cB + hstep, voffB); PG8_STAGE(PG8_SA(0, 0), cA, voffA); PG8_STAGE(PG8_SA(0, 1), cA + hstep, voffA);
        if (wr == 1) PG8_BAR;
        PG8_WAIT_V(2); PG8_BAR;
        PG8_STAGE(PG8_SB(1, 0), cB + kstep, voffB); PG8_STAGE(PG8_SA(1, 0), cA + kstep, voffA); PG8_STAGE(PG8_SB(1, 1), cB + hstep + kstep, voffB);
        PG8_WAIT_V(6); PG8_BAR;
    } else {
        PG8_STAGE(PG8_SB(0, 0), cB, voffB); PG8_STAGE(PG8_SA(0, 0), cA, voffA); PG8_STAGE(PG8_SB(0, 1), cB + hstep, voffB); PG8_STAGE(PG8_SA(0, 1), cA + hstep, voffA);
        if (wr == 1) PG8_BAR;
        PG8_WAIT_V(4); PG8_BAR;
        PG8_STAGE(PG8_SB(1, 0), cB + kstep, voffB); PG8_STAGE(PG8_SA(1, 0), cA + kstep, voffA); PG8_STAGE(PG8_SB(1, 1), cB + hstep + kstep, voffB);
        PG8_WAIT_V(6); PG8_BAR;
    }
    for (;;) {
        const bool has_next = S.next(ui + 1, nxt);
        const char* nA = has_next ? (const char*)g.A + (size_t)nxt.pm * tstep : cA; const char* nB = has_next ? (const char*)g.Bt + (size_t)nxt.pn * tstep : cB;
        for (int t = 0; t < nt; t += 2) {
            const bool last = (t == nt - 2);
            const char* a1 = cA + (size_t)(t + 1) * kstep;
            const char* a2 = last ? nA : cA + (size_t)(t + 2) * kstep; const char* b2 = last ? nB : cB + (size_t)(t + 2) * kstep;
            const char* a3 = a2 + kstep; const char* b3 = b2 + kstep;
            if (last && has_next) S.a_ready(nxt);
            if constexpr (SP2) {
            PG8_LDB(B0, 0, 0); PG8_LDB(B1, 0, 1); PG8_SCHED; PG8_LDA(At, 0, 0); PG8_STAGE(PG8_SA(1, 1), a1 + hstep, voffA);
            PG8_WAIT_V(8); PG8_WAIT_L(0); PG8_BAR; PG8_MMA(0, 0, At, B0); PG8_MMA(0, 1, At, B1); PG8_BAR; PG8_SCHED;
            PG8_LDA(At, 0, 1); PG8_STAGE(PG8_SB(0, 0), b2, voffB); PG8_STAGE(PG8_SB(0, 1), b2 + hstep, voffB); PG8_STAGE(PG8_SA(0, 0), a2, voffA);
            PG8_WAIT_V(8); PG8_WAIT_L(0); PG8_BAR; PG8_MMA(1, 0, At, B0); PG8_MMA(1, 1, At, B1); PG8_BAR; PG8_SCHED;
            PG8_LDB(B0, 1, 0); PG8_LDB(B1, 1, 1); PG8_SCHED; PG8_LDA(At, 1, 0); PG8_STAGE(PG8_SA(0, 1), a2 + hstep, voffA);
            PG8_WAIT_V(8); PG8_WAIT_L(0); PG8_BAR; PG8_MMA(0, 0, At, B0); PG8_MMA(0, 1, At, B1); PG8_BAR; PG8_SCHED;
            PG8_LDA(At, 1, 1); PG8_STAGE(PG8_SB(1, 0), b3, voffB); PG8_STAGE(PG8_SB(1, 1), b3 + hstep, voffB); PG8_STAGE(PG8_SA(1, 0), a3, voffA);
            PG8_WAIT_V(8); PG8_WAIT_L(0); PG8_BAR; PG8_MMA(1, 0, At, B0); PG8_MMA(1, 1, At, B1); PG8_BAR; PG8_SCHED;
            } else {
            PG8_LDB(B0, 0, 0); PG8_SCHED; PG8_LDA(At, 0, 0); PG8_STAGE(PG8_SA(1, 1), a1 + hstep, voffA);
            PG8_WAIT_L(8); PG8_BAR; PG8_WAIT_L(0); PG8_MMA(0, 0, At, B0); PG8_BAR; PG8_SCHED;
            PG8_LDB(B1, 0, 1); PG8_STAGE(PG8_SB(0, 0), b2, voffB);
            PG8_BAR; PG8_WAIT_L(0); PG8_MMA(0, 1, At, B1); PG8_BAR;
            PG8_LDA(At, 0, 1); PG8_STAGE(PG8_SA(0, 0), a2, voffA);
            PG8_BAR; PG8_WAIT_L(0); PG8_MMA(1, 0, At, B0); PG8_BAR; PG8_SCHED;
            PG8_STAGE(PG8_SB(0, 1), b2 + hstep, voffB);
            PG8_WAIT_V(6); PG8_BAR; PG8_MMA(1, 1, At, B1); PG8_BAR;
            PG8_LDB(B0, 1, 0); PG8_SCHED; PG8_LDA(At, 1, 0); PG8_STAGE(PG8_SA(0, 1), a2 + hstep, voffA);
            PG8_WAIT_L(8); PG8_BAR; PG8_WAIT_L(0); PG8_MMA(0, 0, At, B0); PG8_BAR; PG8_SCHED;
            PG8_LDB(B1, 1, 1); PG8_STAGE(PG8_SB(1, 0), b3, voffB);
            PG8_BAR; PG8_WAIT_L(0); PG8_MMA(0, 1, At, B1); PG8_BAR;
            PG8_LDA(At, 1, 1); PG8_STAGE(PG8_SA(1, 0), a3, voffA);
            PG8_BAR; PG8_WAIT_L(0); PG8_MMA(1, 0, At, B0); PG8_BAR; PG8_SCHED;
            PG8_STAGE(PG8_SB(1, 1), b3 + hstep, voffB);
            PG8_WAIT_V(6); PG8_BAR; PG8_MMA(1, 1, At, B1); PG8_BAR;
            }
        }
        if constexpr (ALIGN_EPI) { if (wr == 0) PG8_BAR; }
        if constexpr (!Epi::AFTER_DRAIN) { E(acc, cur, wr, wc, fr, fq); S.done(cur); }
        if (!has_next) break;
#pragma unroll
        for (int a = 0; a < 2; ++a)
#pragma unroll
            for (int b = 0; b < 2; ++b)
#pragma unroll
                for (int m = 0; m < 4; ++m)
#pragma unroll
                    for (int n = 0; n < 2; ++n) acc[a][b][m][n] = (f32x4){0.f, 0.f, 0.f, 0.f};
        cur = nxt; cA = nA; cB = nB; ++ui;
        if constexpr (ALIGN_EPI) { if (wr == 1) PG8_BAR; }
    }
    PG8_WAIT_V(0);
    if constexpr (!ALIGN_EPI) { if (wr == 0) PG8_BAR; }
    PG8_BAR;
    if constexpr (Epi::AFTER_DRAIN) { E.fused(acc, cur, wr, wc, fr, fq, lds, wid, lane); S.done(cur); }
#undef PG8_SA
#undef PG8_SB
#undef PG8_STAGE
#undef PG8_LDA
#undef PG8_LDB
#undef PG8_MMA
#undef PG8_WAIT_V
#undef PG8_WAIT_L
#undef PG8_BAR
#undef PG8_SCHED
}
}

__device__ __forceinline__ int gswz(int row, int chunk) { return row * 128 + ((chunk ^ ((row >> 1) & 7)) << 4); }
__device__ __forceinline__ void gemm_tile(const bf16_t* __restrict__ A, int lda, const bf16_t* __restrict__ Bt, int ldb, int K,
                                          int row0, int col0, unsigned char* lds, f32x16 (&acc)[2][2]) {
  int tid_ = tidx(); asm volatile("" : "+v"(tid_)); const int tid = tid_, lane = tid & 63, wid = tid >> 6, wm = wid >> 1, wn = wid & 1, r32 = lane & 31, hi = lane >> 5;
  unsigned char* As = lds; unsigned char* Bs = lds + 65536;
#pragma unroll
  for (int i = 0; i < 2; ++i)
#pragma unroll
    for (int j = 0; j < 2; ++j) acc[i][j] = f32x16{};
  const int lrow = tid >> 3, lc = tid & 7;
  const bf16_t* Ag = A + (size_t)(row0 + lrow) * lda + lc * 8;
  const bf16_t* Bg = Bt + (size_t)(col0 + lrow) * ldb + lc * 8;
  u32x4 ra[4], rb[2];
#pragma unroll
  for (int i = 0; i < 4; ++i) ra[i] = *(const u32x4*)(Ag + (size_t)(64 * i) * lda);
#pragma unroll
  for (int i = 0; i < 2; ++i) rb[i] = *(const u32x4*)(Bg + (size_t)(64 * i) * ldb);
#pragma unroll
  for (int i = 0; i < 4; ++i) *(u32x4*)(As + gswz(lrow + 64 * i, lc)) = ra[i];
#pragma unroll
  for (int i = 0; i < 2; ++i) *(u32x4*)(Bs + gswz(lrow + 64 * i, lc)) = rb[i];
  __syncthreads();
  const int nk = K / 64;
  for (int kt = 0; kt < nk; ++kt) {
    const int cur = kt & 1;
    if (kt + 1 < nk) {
#pragma unroll
      for (int i = 0; i < 4; ++i) ra[i] = *(const u32x4*)(Ag + (size_t)(64 * i) * lda + (kt + 1) * 64);
#pragma unroll
      for (int i = 0; i < 2; ++i) rb[i] = *(const u32x4*)(Bg + (size_t)(64 * i) * ldb + (kt + 1) * 64);
    }
    const unsigned char* Ac = As + cur * 32768; const unsigned char* Bc = Bs + cur * 16384;
#pragma unroll
    for (int kk = 0; kk < 4; ++kk) {
      bf16x8 af[2], bfr[2];
#pragma unroll
      for (int i = 0; i < 2; ++i) af[i] = *(const bf16x8*)(Ac + gswz(wm * 64 + i * 32 + r32, 2 * kk + hi));
#pragma unroll
      for (int j = 0; j < 2; ++j) bfr[j] = *(const bf16x8*)(Bc + gswz(wn * 64 + j * 32 + r32, 2 * kk + hi));
#pragma unroll
      for (int i = 0; i < 2; ++i)
#pragma unroll
        for (int j = 0; j < 2; ++j) acc[i][j] = __builtin_amdgcn_mfma_f32_32x32x16_bf16(af[i], bfr[j], acc[i][j], 0, 0, 0);
    }
    if (kt + 1 < nk) {
      unsigned char* An = As + (cur ^ 1) * 32768; unsigned char* Bn = Bs + (cur ^ 1) * 16384;
#pragma unroll
      for (int i = 0; i < 4; ++i) *(u32x4*)(An + gswz(lrow + 64 * i, lc)) = ra[i];
#pragma unroll
      for (int i = 0; i < 2; ++i) *(u32x4*)(Bn + gswz(lrow + 64 * i, lc)) = rb[i];
    }
    __syncthreads();
  }
}
__device__ __forceinline__ void pair_xchg(float v0, float v1, int lane, float& lo, float& hi2) {
  const bool odd = lane & 1;
  const float send = odd ? v0 : v1;
  const float recv = __shfl_xor(send, 1);
  lo = odd ? recv : v0; hi2 = odd ? v1 : recv;
}

__device__ __forceinline__ void phase_inproj(const Params& p, int l, unsigned char* lds) {
  int tid_ = tidx(); asm volatile("" : "+v"(tid_)); const int tid = tid_, lane = tid & 63, wid = tid >> 6, wm = wid >> 1, wn = wid & 1, r32 = lane & 31, hi = lane >> 5;
  const bf16_t* H = (const bf16_t*)(p.ws + WS_H);
  const bf16_t* W = (const bf16_t*)(p.ws + WS_WIN) + (size_t)l * PW * DM;
  bf16_t* PROJ = (bf16_t*)(p.ws + WS_PROJ);
  const float* RC = (const float*)(p.ws + WS_ROPE); const float* RS = RC + SEQ * 32;
  constexpr int NM = T / 256, NN = PW / 128, NU = NM * NN;
  for (int u = p.bx; u < NU + NM; u += p.gx) {
    if (u < NU) {
      const int pn = u / NM, pm = u % NM;
      const int row0 = pm * 256, col0 = pn * 128;
      f32x16 acc[2][2];
      gemm_tile(H, DM, W, DM, DM, row0, col0, lds, acc);
      const bool rope = (col0 >= C_DQ && col0 < C_DV);
      const float scl = (col0 >= C_MK && col0 < C_MV) ? 0.125f : ((col0 >= C_DQ && col0 < C_DK) ? QSCALE : 1.f);
#pragma unroll
      for (int i = 0; i < 2; ++i)
#pragma unroll
        for (int j = 0; j < 2; ++j)
#pragma unroll
          for (int q = 0; q < 8; ++q) {
            float lo, hi2; pair_xchg(acc[i][j][2 * q], acc[i][j][2 * q + 1], lane, lo, hi2);
            const int row = row0 + wm * 64 + i * 32 + crow(2 * q, hi) + (lane & 1);
            const int col = col0 + wn * 64 + j * 32 + (r32 & ~1);
            if (rope) {
              const int s = row % SEGL;
              if (s >= CTXL) {
                const int idx = (s - CTXL) * 32 + ((col & 63) >> 1);
                const float c = RC[idx], sn = RS[idx];
                const float t1 = lo, t2 = hi2; lo = t1 * c - t2 * sn; hi2 = t1 * sn + t2 * c;
              }
            }
            *(unsigned*)(PROJ + (size_t)row * PW + col) = cvtpk(lo * scl, hi2 * scl);
          }
    } else {
      const int pm = u - NU, rowb = pm * 256 + wid * 32;
      const bf16_t* WG = (const bf16_t*)(p.ws + WS_WG) + (size_t)l * 16 * DM;
      float* GT = (float*)(p.ws + WS_GATES);
      const int r16 = lane & 15, q4 = lane >> 4;
      f32x4 c0 = {0.f, 0.f, 0.f, 0.f}, c1 = {0.f, 0.f, 0.f, 0.f};
      const bf16_t* a0p = H + (size_t)(rowb + r16) * DM + q4 * 8;
      const bf16_t* a1p = a0p + (size_t)16 * DM;
      const bf16_t* bp = WG + (size_t)r16 * DM + q4 * 8;
#pragma unroll 4
      for (int ks = 0; ks < 32; ++ks) {
        const bf16x8 a0 = *(const bf16x8*)(a0p + ks * 32), a1 = *(const bf16x8*)(a1p + ks * 32), b = *(const bf16x8*)(bp + ks * 32);
        c0 = __builtin_amdgcn_mfma_f32_16x16x32_bf16(a0, b, c0, 0, 0, 0);
        c1 = __builtin_amdgcn_mfma_f32_16x16x32_bf16(a1, b, c1, 0, 0, 0);
      }
      const float gb = p.in[I_GATEB][l * 16 + r16];
#pragma unroll
      for (int j = 0; j < 4; ++j) {
        GT[(size_t)(rowb + q4 * 4 + j) * 16 + r16] = c0[j] + gb;
        GT[(size_t)(rowb + 16 + q4 * 4 + j) * 16 + r16] = c1[j] + gb;
      }
    }
  }
}

__device__ __forceinline__ void phase_outproj(const Params& p, int l, unsigned char* lds) {
  int tid_ = tidx(); asm volatile("" : "+v"(tid_)); const int tid = tid_, lane = tid & 63, wid = tid >> 6, wm = wid >> 1, wn = wid & 1, r32 = lane & 31, hi = lane >> 5;
  const bf16_t* MIX = (const bf16_t*)(p.ws + WS_MIX);
  const bf16_t* W = (const bf16_t*)(p.ws + WS_WOUT) + (size_t)l * DM * DM;
  float* XC = (float*)(p.ws + WS_XCUR);
  const float* MOD = (const float*)(p.ws + WS_MOD);
  constexpr int NM = T / 256, NN = DM / 128, NU = NM * NN;
  for (int u = p.bx; u < NU; u += p.gx) {
    const int pm = u / NN, pn = u % NN;
    if (l == DEPTH - 1 && (pm % 33) == 0) continue;
    const int row0 = pm * 256, col0 = pn * 128;
    for (int rep = 0; rep < REP_OUTP; ++rep) {
    f32x16 acc[2][2];
    gemm_tile(MIX, DM, W, DM, DM, row0, col0, lds, acc);
    const int mr = (pm % 33) == 0 ? 4 : pm / 33;
    const float* g1 = MOD + ((size_t)l * 5 + mr) * 6144 + 2048;
#pragma unroll
    for (int i = 0; i < 2; ++i)
#pragma unroll
      for (int j = 0; j < 2; ++j) {
        const int col = col0 + wn * 64 + j * 32 + r32;
        const float gg = (rep == REP_OUTP - 1) ? g1[col] : 0.f;
#pragma unroll
        for (int r = 0; r < 16; ++r) {
          const int row = row0 + wm * 64 + i * 32 + crow(r, hi);
          const float xo = (l == 0) ? in_row(p.in[I_X], p.in[I_CTX], row)[col] : XC[(size_t)row * DM + col];
          XC[(size_t)row * DM + col] = xo + gg * acc[i][j][r];
        }
      }
    }
  }
}
__device__ __forceinline__ void phase_peerq(const Params& p, int l, unsigned char* lds) {
  int tid_ = tidx(); asm volatile("" : "+v"(tid_)); const int tid = tid_, lane = tid & 63, wid = tid >> 6, wm = wid >> 1, wn = wid & 1, r32 = lane & 31, hi = lane >> 5;
  const bf16_t* H = (const bf16_t*)(p.ws + WS_H);
  const bf16_t* W = (const bf16_t*)(p.ws + WS_WQ) + (size_t)l * DM * DM;
  bf16_t* QP = (bf16_t*)(p.ws + WS_PROJ);
  constexpr int NM = T / 256, NN = DM / 128, NU = NM * NN;
  for (int u = p.bx; u < NU; u += p.gx) {
    const int pm = u / NN, pn = u % NN;
    if (l == DEPTH - 1 && (pm % 33) == 0) continue;
    const int row0 = pm * 256, col0 = pn * 128;
    f32x16 acc[2][2];
    gemm_tile(H, DM, W, DM, DM, row0, col0, lds, acc);
#pragma unroll
    for (int i = 0; i < 2; ++i)
#pragma unroll
      for (int j = 0; j < 2; ++j)
#pragma unroll
        for (int q = 0; q < 8; ++q) {
          float lo, hi2; pair_xchg(acc[i][j][2 * q], acc[i][j][2 * q + 1], lane, lo, hi2);
          const int row = row0 + wm * 64 + i * 32 + crow(2 * q, hi) + (lane & 1);
          const int col = col0 + wn * 64 + j * 32 + (r32 & ~1);
          *(unsigned*)(QP + (size_t)row * DM + col) = cvtpk(lo, hi2);
        }
  }
}


struct EpiInproj {
  static constexpr bool PERM = true, AFTER_DRAIN = false;
  bf16_t* PROJ; const float* RC; const float* RS; unsigned char* V8T;
  __device__ __forceinline__ void operator()(const pg8::f32x4 (&acc)[2][2][4][2], const pg8::Unit& u, int wr, int wc, int fr, int fq) const {
#pragma unroll
    for (int bj = 0; bj < 2; ++bj) {
      const int colt = u.pn * 256 + bj * 128;
      const bool rope = (colt >= C_DQ && colt < C_DV);
      const float scl = (colt >= C_MK && colt < C_MV) ? 0.125f : ((colt >= C_DQ && colt < C_DK) ? QSCALE : 1.f);
      const int col8 = colt + wc * 32 + 8 * fq;
      if (colt >= C_DV) {
        const int hh = (col8 - C_DV) >> 7, e0 = (col8 - C_DV) & 127;
#pragma unroll
        for (int ai = 0; ai < 2; ++ai)
#pragma unroll
          for (int m = 0; m < 4; ++m) {
            const int row = u.pm * 256 + ai * 128 + wr * 64 + m * 16 + fr;
            const int b = row / SEGL, s = row - b * SEGL, t = s >> 6, kk = s & 63;
            const int slot = ((kk >> 2) & 1) * 32 + (kk & 3) + 4 * ((kk >> 3) & 3) + 16 * (kk >> 5);
            unsigned char* vp = V8T + ((size_t)((b * 4 + hh) * NCH + t) * 128 + e0) * 80 + slot;
            const f32x4 v0 = acc[ai][bj][m][0], v1 = acc[ai][bj][m][1];
            int w0 = 0, w1 = 0;
            w0 = __builtin_amdgcn_cvt_pk_fp8_f32(v0[0], v0[1], w0, false); w0 = __builtin_amdgcn_cvt_pk_fp8_f32(v0[2], v0[3], w0, true);
            w1 = __builtin_amdgcn_cvt_pk_fp8_f32(v1[0], v1[1], w1, false); w1 = __builtin_amdgcn_cvt_pk_fp8_f32(v1[2], v1[3], w1, true);
            vp[0] = (unsigned char)(w0 & 0xFF); vp[80] = (unsigned char)((w0 >> 8) & 0xFF); vp[160] = (unsigned char)((w0 >> 16) & 0xFF); vp[240] = (unsigned char)((w0 >> 24) & 0xFF);
            vp[320] = (unsigned char)(w1 & 0xFF); vp[400] = (unsigned char)((w1 >> 8) & 0xFF); vp[480] = (unsigned char)((w1 >> 16) & 0xFF); vp[560] = (unsigned char)((w1 >> 24) & 0xFF);
          }
        continue;
      }
#pragma unroll
      for (int ai = 0; ai < 2; ++ai)
#pragma unroll
        for (int m = 0; m < 4; ++m) {
          const int row = u.pm * 256 + ai * 128 + wr * 64 + m * 16 + fr;
          f32x4 v0 = acc[ai][bj][m][0], v1 = acc[ai][bj][m][1];
          if (rope) {
            const int s = row % SEGL;
            if (s >= CTXL) {
              const int idx = (s - CTXL) * 32 + ((col8 & 63) >> 1);
              const f32x4 c = *(const f32x4*)(RC + idx), sn = *(const f32x4*)(RS + idx);
              f32x4 a, b;
              a[0] = v0[0] * c[0] - v0[1] * sn[0]; a[1] = v0[0] * sn[0] + v0[1] * c[0]; a[2] = v0[2] * c[1] - v0[3] * sn[1]; a[3] = v0[2] * sn[1] + v0[3] * c[1];
              b[0] = v1[0] * c[2] - v1[1] * sn[2]; b[1] = v1[0] * sn[2] + v1[1] * c[2]; b[2] = v1[2] * c[3] - v1[3] * sn[3]; b[3] = v1[2] * sn[3] + v1[3] * c[3];
              v0 = a; v1 = b;
            }
          }
          u32x4 w; w.x = cvtpk(v0[0] * scl, v0[1] * scl); w.y = cvtpk(v0[2] * scl, v0[3] * scl); w.z = cvtpk(v1[0] * scl, v1[1] * scl); w.w = cvtpk(v1[2] * scl, v1[3] * scl);
          *(u32x4*)(PROJ + (size_t)row * PW + col8) = w;
        }
    }
  }
};
struct EpiOutproj {
  static constexpr bool PERM = true, AFTER_DRAIN = false;
  float* XC; const float* MODL; const float* xin; const float* ctxin; int first; float gsc;
  __device__ __forceinline__ void operator()(const pg8::f32x4 (&acc)[2][2][4][2], const pg8::Unit& u, int wr, int wc, int fr, int fq) const {
    const int mr = (u.pm % 33) == 0 ? 4 : u.pm / 33;
    const float* g1 = MODL + (size_t)mr * 6144 + 2048;
#pragma unroll
    for (int bj = 0; bj < 2; ++bj) {
      const int col8 = u.pn * 256 + bj * 128 + wc * 32 + 8 * fq;
      const f32x4 ga = *(const f32x4*)(g1 + col8) * gsc, gb = *(const f32x4*)(g1 + col8 + 4) * gsc;
#pragma unroll
      for (int ai = 0; ai < 2; ++ai)
#pragma unroll
        for (int m = 0; m < 4; ++m) {
          const int row = u.pm * 256 + ai * 128 + wr * 64 + m * 16 + fr;
          const float* xo = first ? in_row(xin, ctxin, row) + col8 : XC + (size_t)row * DM + col8;
          const f32x4 xa = *(const f32x4*)xo, xb = *(const f32x4*)(xo + 4);
          *(f32x4*)(XC + (size_t)row * DM + col8) = xa + ga * acc[ai][bj][m][0];
          *(f32x4*)(XC + (size_t)row * DM + col8 + 4) = xb + gb * acc[ai][bj][m][1];
        }
    }
  }
};
struct EpiPeerq {
  static constexpr bool PERM = true, AFTER_DRAIN = false;
  bf16_t* QP;
  __device__ __forceinline__ void operator()(const pg8::f32x4 (&acc)[2][2][4][2], const pg8::Unit& u, int wr, int wc, int fr, int fq) const {
#pragma unroll
    for (int bj = 0; bj < 2; ++bj) {
      const int col8 = u.pn * 256 + bj * 128 + wc * 32 + 8 * fq;
#pragma unroll
      for (int ai = 0; ai < 2; ++ai)
#pragma unroll
        for (int m = 0; m < 4; ++m) {
          const int row = u.pm * 256 + ai * 128 + wr * 64 + m * 16 + fr;
          const f32x4 v0 = acc[ai][bj][m][0], v1 = acc[ai][bj][m][1];
          u32x4 w; w.x = cvtpk(v0[0], v0[1]); w.y = cvtpk(v0[2], v0[3]); w.z = cvtpk(v1[0], v1[1]); w.w = cvtpk(v1[2], v1[3]);
          *(u32x4*)(QP + (size_t)row * DM + col8) = w;
        }
    }
  }
};
__device__ __forceinline__ void phase_inproj2(const Params& p, int l, unsigned char* lds) {
  {
    pg8::Gemm g{(const bf16_t*)(p.ws + WS_H), (const bf16_t*)(p.ws + WS_WIN) + (size_t)l * PW * DM, T, PW, DM};
    pg8::StaticOrder S; S.init(T, PW, p.gx, p.bx);
    EpiInproj E{(bf16_t*)(p.ws + WS_PROJ), (const float*)(p.ws + WS_ROPE), (const float*)(p.ws + WS_ROPE) + SEQ * 32, p.ws + WS_V8T};
    pg8::gemm_phase<EpiInproj, pg8::StaticOrder, true, true>((PG8_LAS unsigned char*)lds, g, S, E);
  }
  int tid_ = tidx(); asm volatile("" : "+v"(tid_)); const int tid = tid_, lane = tid & 63, wid = tid >> 6;
  const bf16_t* H = (const bf16_t*)(p.ws + WS_H);
  for (int pm = p.bx; pm < T / 256; pm += p.gx) {
    const int rowb = pm * 256 + wid * 32;
    const bf16_t* WG = (const bf16_t*)(p.ws + WS_WG) + (size_t)l * 16 * DM;
    float* GT = (float*)(p.ws + WS_GATES);
    const int r16 = lane & 15, q4 = lane >> 4;
    f32x4 c0 = {0.f, 0.f, 0.f, 0.f}, c1 = {0.f, 0.f, 0.f, 0.f};
    const bf16_t* a0p = H + (size_t)(rowb + r16) * DM + q4 * 8;
    const bf16_t* a1p = a0p + (size_t)16 * DM;
    const bf16_t* bp = WG + (size_t)r16 * DM + q4 * 8;
#pragma unroll 4
    for (int ks = 0; ks < 32; ++ks) {
      const bf16x8 a0 = *(const bf16x8*)(a0p + ks * 32), a1 = *(const bf16x8*)(a1p + ks * 32), b = *(const bf16x8*)(bp + ks * 32);
      c0 = __builtin_amdgcn_mfma_f32_16x16x32_bf16(a0, b, c0, 0, 0, 0);
      c1 = __builtin_amdgcn_mfma_f32_16x16x32_bf16(a1, b, c1, 0, 0, 0);
    }
    const float gb = p.in[I_GATEB][l * 16 + r16];
#pragma unroll
    for (int j = 0; j < 4; ++j) {
      GT[(size_t)(rowb + q4 * 4 + j) * 16 + r16] = c0[j] + gb;
      GT[(size_t)(rowb + 16 + q4 * 4 + j) * 16 + r16] = c1[j] + gb;
    }
  }
}
__device__ __forceinline__ void phase_outproj2(const Params& p, int l, unsigned char* lds) {
  pg8::Gemm g{(const bf16_t*)(p.ws + WS_MIX), (const bf16_t*)(p.ws + WS_WOUT) + (size_t)l * DM * DM, T, DM, DM};
  pg8::StaticOrder S; S.init(T, DM, p.gx, p.bx);
  for (int rep = 0; rep < REP_OUTP; ++rep) {
  EpiOutproj E{(float*)(p.ws + WS_XCUR), (const float*)(p.ws + WS_MOD) + (size_t)l * 5 * 6144, p.in[I_X], p.in[I_CTX], l == 0, (rep == REP_OUTP - 1) ? 1.f : 0.f};
  pg8::gemm_phase<EpiOutproj, pg8::StaticOrder, true, true>((PG8_LAS unsigned char*)lds, g, S, E);
  }
  if (l < DEPTH - 1) tail_filler_tables(p, l, (T / 256) * (DM / 256));
}
__device__ __forceinline__ void phase_peerq2(const Params& p, int l, unsigned char* lds) {
  pg8::Gemm g{(const bf16_t*)(p.ws + WS_H), (const bf16_t*)(p.ws + WS_WQ) + (size_t)l * DM * DM, T, DM, DM};
  pg8::StaticOrder S; S.init(T, DM, p.gx, p.bx);
  EpiPeerq E{(bf16_t*)(p.ws + WS_PROJ)};
  pg8::gemm_phase<EpiPeerq, pg8::StaticOrder, true, true>((PG8_LAS unsigned char*)lds, g, S, E);
  if (l == DEPTH - 2) tail_filler_tables(p, DEPTH - 1, (T / 256) * (DM / 256));
}

__device__ __forceinline__ void conv_unit(const Params& p, int l, int unit, unsigned char* lds) {
  int tid_ = tidx(); asm volatile("" : "+v"(tid_)); const int tid = tid_, lane = tid & 63, wid = tid >> 6;
  float* U = (float*)lds;
  const bf16_t* PROJ = (const bf16_t*)(p.ws + WS_PROJ);
  bf16_t* MIX = (bf16_t*)(p.ws + WS_MIX);
  const int row0 = unit * 32, b = row0 / SEGL, s0 = row0 - b * SEGL;
  const int seglo = s0 < CTXL ? 0 : CTXL, seghi = s0 < CTXL ? CTXL : SEGL;
  for (int rr = tid >> 5; rr < 62; rr += 16) {
    const int s = s0 - 15 + rr, c8 = (tid & 31) * 8;
    f32x4 u0 = {0.f, 0.f, 0.f, 0.f}, u1 = {0.f, 0.f, 0.f, 0.f};
    if (s >= seglo && s < seghi) {
      const bf16_t* pr = PROJ + (size_t)(b * SEGL + s) * PW + c8;
      const u32x4 a1 = *(const u32x4*)pr, a2 = *(const u32x4*)(pr + 256);
      u0.x = bflo(a1.x) * sigmoidf_(bflo(a2.x)); u0.y = bfhi(a1.x) * sigmoidf_(bfhi(a2.x));
      u0.z = bflo(a1.y) * sigmoidf_(bflo(a2.y)); u0.w = bfhi(a1.y) * sigmoidf_(bfhi(a2.y));
      u1.x = bflo(a1.z) * sigmoidf_(bflo(a2.z)); u1.y = bfhi(a1.z) * sigmoidf_(bfhi(a2.z));
      u1.z = bflo(a1.w) * sigmoidf_(bflo(a2.w)); u1.w = bfhi(a1.w) * sigmoidf_(bfhi(a2.w));
    }
    *(f32x4*)(U + rr * 256 + c8) = u0; *(f32x4*)(U + rr * 256 + c8 + 4) = u1;
  }
  __syncthreads();
  float* Y = U + 62 * 256;
  const float* cw = p.in[I_CONVW] + (size_t)l * 31 * 256;
#pragma unroll 1
  for (int q = 0; q < 4; ++q) {
    const int c = lane + 64 * q;
    float w[31];
#pragma unroll
    for (int j = 0; j < 31; ++j) w[j] = cw[j * 256 + c];
    const float bias = p.in[I_CONVB][l * 256 + c];
#pragma unroll
    for (int tt = 0; tt < 4; ++tt) {
      const int t = wid * 4 + tt;
      float a = bias;
#pragma unroll
      for (int j = 0; j < 31; ++j) a += U[(t + j) * 256 + c] * w[j];
      Y[t * 256 + c] = a;
    }
  }
  asm volatile("s_waitcnt lgkmcnt(0)" ::: "memory");
  float y[4][4];
#pragma unroll
  for (int tt = 0; tt < 4; ++tt)
#pragma unroll
    for (int q = 0; q < 4; ++q) y[tt][q] = Y[(wid * 4 + tt) * 256 + lane + 64 * q];
#pragma unroll
  for (int tt = 0; tt < 4; ++tt) {
    const int t = wid * 4 + tt;
    const float mean = wave_sum((y[tt][0] + y[tt][1]) + (y[tt][2] + y[tt][3])) * (1.f / 256.f);
    float v = 0.f;
#pragma unroll
    for (int q = 0; q < 4; ++q) { const float d = y[tt][q] - mean; v += d * d; }
    const float rs = rsqrtf(wave_sum(v) * (1.f / 256.f) + EPS);
#pragma unroll
    for (int q = 0; q < 4; ++q) {
      const int c = lane + 64 * q;
      const float z = (y[tt][q] - mean) * rs * p.in[I_CLNG][l * 256 + c] + p.in[I_CLNB][l * 256 + c];
      const float o = (ABL & 1) ? 0.f : z * sigmoidf_(z);
      MIX[(size_t)(row0 + t) * DM + c] = (bf16_t)(cvtpk(o, 0.f) & 0xffffu);
    }
  }
  __syncthreads();
}

__device__ __forceinline__ int ml_cidx(int ch, int dir) { return dir == 0 ? ch : (ch < 4 ? 3 - ch : 135 - ch); }
__device__ __forceinline__ void ml_load_tile(const bf16_t* src, float* dst, int tid) {
  const int r = tid >> 3, c8 = (tid & 7) * 8;
  const u32x4 a = *(const u32x4*)(src + (size_t)r * PW + c8);
  float* d = dst + r * 65 + c8;
  d[0] = bflo(a.x); d[1] = bfhi(a.x); d[2] = bflo(a.y); d[3] = bfhi(a.y); d[4] = bflo(a.z); d[5] = bfhi(a.z); d[6] = bflo(a.w); d[7] = bfhi(a.w);
}
__device__ __forceinline__ void ml_local_unit(const Params& p, int l, int unit, unsigned char* lds) {
  int tid_ = tidx(); asm volatile("" : "+v"(tid_)); const int tid = tid_, lane = tid & 63, wid = tid >> 6, r32 = lane & 31, hi = lane >> 5;
  float* Kt = (float*)lds; float* Vt = Kt + 64 * 65; float* WK = Vt + 64 * 65;
  const bf16_t* PROJ = (const bf16_t*)(p.ws + WS_PROJ);
  const float* GT = (const float*)(p.ws + WS_GATES);
  float* UL = (float*)(p.ws + WS_ULOC); float* META = (float*)(p.ws + WS_MLMETA);
  const int b = unit / (4 * NCH), hh = (unit / NCH) & 3, ch = unit % NCH;
  const int row0 = b * SEGL + ch * 64;
  ml_load_tile(PROJ + (size_t)row0 * PW + C_MK + hh * 64, Kt, tid);
  ml_load_tile(PROJ + (size_t)row0 * PW + C_MV + hh * 64, Vt, tid);
  if (wid < 2) {
    const int dir = wid;
    const float ig = GT[(size_t)(row0 + lane) * 16 + (2 * dir) * 4 + hh];
    const float lf = logsigmoidf_(GT[(size_t)(row0 + lane) * 16 + (2 * dir + 1) * 4 + hh]);
    float ps = lf;
#pragma unroll
    for (int o = 1; o < 64; o <<= 1) { const float t = __shfl_up(ps, o); if (lane >= o) ps += t; }
    const float tot = __shfl(ps, 63);
    const float wlog = dir == 0 ? (tot - ps + ig) : (ps - lf + ig);
    const float mloc = wave_max(wlog);
    WK[dir * 64 + lane] = __expf(wlog - mloc);
    if (lane == 0) {
      const int seq = (b * 4 + hh) * 2 + dir, ci = ml_cidx(ch, dir);
      META[((size_t)seq * NCH + ci) * 4 + 0] = tot; META[((size_t)seq * NCH + ci) * 4 + 1] = mloc;
    }
  }
  __syncthreads();
  {
    const int dir = wid >> 2, et = (wid >> 1) & 1, dt = wid & 1;
    const int seq = (b * 4 + hh) * 2 + dir, ci = ml_cidx(ch, dir);
    float* slot = UL + ((size_t)seq * NCH + ci) * USTRIDE;
    f32x16 acc = {};
#pragma unroll 8
    for (int ks = 0; ks < 32; ++ks) {
      const int s = 2 * ks + hi;
      const float a = WK[dir * 64 + s] * Vt[s * 65 + et * 32 + r32];
      const float bb = Kt[s * 65 + dt * 32 + r32];
      acc = __builtin_amdgcn_mfma_f32_32x32x2f32(a, bb, acc, 0, 0, 0);
    }
#pragma unroll
    for (int r = 0; r < 16; ++r) slot[(et * 32 + crow(r, hi)) * 64 + dt * 32 + r32] = acc[r];
    if (et == 0) {
      float n = 0.f;
#pragma unroll 8
      for (int i = 0; i < 32; ++i) { const int s = hi * 32 + i; n += WK[dir * 64 + s] * Kt[s * 65 + dt * 32 + r32]; }
      n += __shfl_xor(n, 32);
      if (hi == 0) slot[4096 + dt * 32 + r32] = n;
    }
  }
  __syncthreads();
}
constexpr int MLP = 144;
constexpr size_t WS_CST = WS_H;
constexpr size_t WS_NST = WS_H + (size_t)32 * NCH * 4096 * 2;
__device__ __forceinline__ void ml_stage_rm(const bf16_t* src, size_t ld, unsigned char* dst, int tid) {
  const int r = tid >> 3, c8 = (tid & 7) * 8;
  *(u32x4*)(dst + r * MLP + c8 * 2) = *(const u32x4*)(src + (size_t)r * ld + c8);
}
__device__ __forceinline__ void ml_stage_tr(const bf16_t* src, size_t ld, unsigned char* dst, int tid) {
  const int r = tid >> 3, c8 = (tid & 7) * 8;
  const u32x4 a = *(const u32x4*)(src + (size_t)r * ld + c8);
  bf16_t* d = (bf16_t*)dst;
  d[(c8 + 0) * 72 + r] = (bf16_t)(a.x & 0xffffu); d[(c8 + 1) * 72 + r] = (bf16_t)(a.x >> 16);
  d[(c8 + 2) * 72 + r] = (bf16_t)(a.y & 0xffffu); d[(c8 + 3) * 72 + r] = (bf16_t)(a.y >> 16);
  d[(c8 + 4) * 72 + r] = (bf16_t)(a.z & 0xffffu); d[(c8 + 5) * 72 + r] = (bf16_t)(a.z >> 16);
  d[(c8 + 6) * 72 + r] = (bf16_t)(a.w & 0xffffu); d[(c8 + 7) * 72 + r] = (bf16_t)(a.w >> 16);
}
__device__ __forceinline__ void ml_local_unit2(const Params& p, int l, int unit, unsigned char* lds) {
  int tid_ = tidx(); asm volatile("" : "+v"(tid_)); const int tid = tid_, lane = tid & 63, wid = tid >> 6, r32 = lane & 31, hi = lane >> 5;
  unsigned char* KT = lds; unsigned char* VT = lds + 64 * MLP; float* WK = (float*)(lds + 2 * 64 * MLP);
  const bf16_t* PROJ = (const bf16_t*)(p.ws + WS_PROJ);
  const float* GT = (const float*)(p.ws + WS_GATES);
  float* UL = (float*)(p.ws + WS_ULOC); float* META = (float*)(p.ws + WS_MLMETA);
  const int b = unit / (4 * NCH), hh = (unit / NCH) & 3, ch = unit % NCH;
  const int row0 = b * SEGL + ch * 64;
  ml_stage_tr(PROJ + (size_t)row0 * PW + C_MK + hh * 64, PW, KT, tid);
  ml_stage_tr(PROJ + (size_t)row0 * PW + C_MV + hh * 64, PW, VT, tid);
  if (wid < 2) {
    const int dir = wid;
    const float ig = GT[(size_t)(row0 + lane) * 16 + (2 * dir) * 4 + hh];
    const float lf = logsigmoidf_(GT[(size_t)(row0 + lane) * 16 + (2 * dir + 1) * 4 + hh]);
    float ps = lf;
#pragma unroll
    for (int o = 1; o < 64; o <<= 1) { const float t = __shfl_up(ps, o); if (lane >= o) ps += t; }
    const float tot = __shfl(ps, 63);
    const float wlog = dir == 0 ? (tot - ps + ig) : (ps - lf + ig);
    const float mloc = wave_max(wlog);
    WK[dir * 64 + lane] = __expf(wlog - mloc);
    if (lane == 0) {
      const int seq = (b * 4 + hh) * 2 + dir, ci = ml_cidx(ch, dir);
      META[((size_t)seq * NCH + ci) * 4 + 0] = tot; META[((size_t)seq * NCH + ci) * 4 + 1] = mloc;
    }
  }
  __syncthreads();
  {
    const int dir = wid >> 2, et = (wid >> 1) & 1, dt = wid & 1;
    const int seq = (b * 4 + hh) * 2 + dir, ci = ml_cidx(ch, dir);
    float* slot = UL + ((size_t)seq * NCH + ci) * USTRIDE;
    f32x16 acc = {};
#pragma unroll
    for (int ks = 0; ks < 4; ++ks) {
      const int s0 = ks * 16 + hi * 8;
      const u32x4 va = *(const u32x4*)(VT + (et * 32 + r32) * MLP + s0 * 2);
      const bf16x8 kb = *(const bf16x8*)(KT + (dt * 32 + r32) * MLP + s0 * 2);
      const f32x4 w0 = *(const f32x4*)(WK + dir * 64 + s0), w1 = *(const f32x4*)(WK + dir * 64 + s0 + 4);
      u32x4 sa; sa.x = cvtpk(bflo(va.x) * w0.x, bfhi(va.x) * w0.y); sa.y = cvtpk(bflo(va.y) * w0.z, bfhi(va.y) * w0.w);
      sa.z = cvtpk(bflo(va.z) * w1.x, bfhi(va.z) * w1.y); sa.w = cvtpk(bflo(va.w) * w1.z, bfhi(va.w) * w1.w);
      acc = __builtin_amdgcn_mfma_f32_32x32x16_bf16(*(const bf16x8*)&sa, kb, acc, 0, 0, 0);
    }
#pragma unroll
    for (int r = 0; r < 16; ++r) slot[(et * 32 + crow(r, hi)) * 64 + dt * 32 + r32] = acc[r];
    if (et == 0) {
      float n = 0.f;
#pragma unroll
      for (int i = 0; i < 4; ++i) {
        const int s0 = hi * 32 + i * 8;
        const u32x4 ka = *(const u32x4*)(KT + (dt * 32 + r32) * MLP + s0 * 2);
        const f32x4 w0 = *(const f32x4*)(WK + dir * 64 + s0), w1 = *(const f32x4*)(WK + dir * 64 + s0 + 4);
        n += bflo(ka.x) * w0.x + bfhi(ka.x) * w0.y + bflo(ka.y) * w0.z + bfhi(ka.y) * w0.w + bflo(ka.z) * w1.x + bfhi(ka.z) * w1.y + bflo(ka.w) * w1.z + bfhi(ka.w) * w1.w;
      }
      n += __shfl_xor(n, 32);
      if (hi == 0) slot[4096 + dt * 32 + r32] = n;
    }
  }
  __syncthreads();
}
__device__ __forceinline__ void ml_scan(const Params& p, unsigned char* lds) {
  float* UL = (float*)(p.ws + WS_ULOC); float* META = (float*)(p.ws + WS_MLMETA);
  int tid_ = tidx(); asm volatile("" : "+v"(tid_));
  const int tid = tid_, lane = tid & 63, wid = tid >> 6;
  float* DEC = (float*)lds;
  float* SCL = DEC + 2 * NCH;
  float* TMP = SCL + 2 * NCH;
  constexpr int NSL = (32 * USTRIDE + 511) / 512;
  for (int rnd_ = 0, s_ = p.bx; s_ < NSL; ++rnd_, s_ = rnd_ * p.gx + ((rnd_ & 1) ? p.gx - 1 - p.bx : p.bx)) {
    const int base0 = s_ * 512;
    const int seq0 = base0 / USTRIDE;
    if (wid < 2) {
      const int seq = seq0 + wid;
      if (seq < 32) {
        float* mt = META + (size_t)seq * NCH * 4;
        for (int c = lane; c < NCH; c += 64) { TMP[(wid * 2 + 0) * NCH + c] = mt[c * 4 + 0]; TMP[(wid * 2 + 1) * NCH + c] = mt[c * 4 + 1]; }
        asm volatile("s_waitcnt lgkmcnt(0)" ::: "memory");
        if (lane == 0) {
          float m = 0.f;
          for (int c = 0; c < NCH; ++c) {
            const float bl = TMP[(wid * 2 + 0) * NCH + c], mloc = TMP[(wid * 2 + 1) * NCH + c];
            const float mn = fmaxf(bl + m, mloc);
            DEC[wid * NCH + c] = __expf(bl + m - mn); SCL[wid * NCH + c] = __expf(mloc - mn);
            mt[c * 4 + 2] = m;
            m = mn;
          }
        }
      }
    }
    __syncthreads();
    const int idx = base0 + tid;
    if (idx < 32 * USTRIDE) {
      const int seq = idx / USTRIDE, e = idx - seq * USTRIDE, sl = seq - seq0;
      float* bp = UL + (size_t)seq * NCH * USTRIDE + e;
      bf16_t* CSTp = (bf16_t*)(p.ws + WS_CST) + (size_t)seq * NCH * 4096 + (e < 4096 ? e : 0);
      float* NSTp = (float*)(p.ws + WS_NST) + (size_t)seq * NCH * 64 + (e < 4096 ? 0 : e - 4096);
      const float* dec = DEC + sl * NCH; const float* scl = SCL + sl * NCH;
      float C = 0.f;
      constexpr int BT = 33;
      static_assert(NCH == 4 * BT, "scan batches");
      float ua[BT], ub[BT];
#define SCAN_LD(u_, c0_) _Pragma("unroll") for (int j = 0; j < BT; ++j) u_[j] = bp[(size_t)((c0_) + j) * USTRIDE];
#define SCAN_DO(u_, c0_) _Pragma("unroll") for (int j = 0; j < BT; ++j) { \
          if (e < 4096) CSTp[(size_t)((c0_) + j) * 4096] = (bf16_t)(cvtpk(C, 0.f) & 0xffffu); else NSTp[(size_t)((c0_) + j) * 64] = C; \
          C = dec[(c0_) + j] * C + scl[(c0_) + j] * u_[j]; }
      SCAN_LD(ua, 0)
#pragma unroll 1
      for (int c0 = 0; c0 < NCH; c0 += 2 * BT) {
        SCAN_LD(ub, c0 + BT)
        SCAN_DO(ua, c0)
        if (c0 + 2 * BT < NCH) { SCAN_LD(ua, c0 + 2 * BT) }
        SCAN_DO(ub, c0 + BT)
      }
#undef SCAN_LD
#undef SCAN_DO
    }
    __syncthreads();
  }
}
__device__ __forceinline__ void ml_out_unit(const Params& p, int l, int unit, unsigned char* lds) {
  int tid_ = tidx(); asm volatile("" : "+v"(tid_)); const int tid = tid_, lane = tid & 63, wid = tid >> 6, r32 = lane & 31, hi = lane >> 5;
  float* Qt = (float*)lds; float* Kt = Qt + 64 * 65; float* Vt = Kt + 64 * 65;
  float* Cs = Vt + 64 * 65;
  float* Ns = Cs + 2 * 64 * 65;
  float* Bq = Ns + 128;
  float* Gs = Bq + 128;
  float* Mi = Gs + 128;
  float* HB = Mi + 64;
  const bf16_t* PROJ = (const bf16_t*)(p.ws + WS_PROJ);
  const float* GT = (const float*)(p.ws + WS_GATES);
  const float* UL = (const float*)(p.ws + WS_ULOC); const float* META = (const float*)(p.ws + WS_MLMETA);
  bf16_t* MIX = (bf16_t*)(p.ws + WS_MIX);
  const int b = unit / (4 * NCH), hh = (unit / NCH) & 3, ch = unit % NCH;
  const int row0 = b * SEGL + ch * 64;
  ml_load_tile(PROJ + (size_t)row0 * PW + C_MQ + hh * 64, Qt, tid);
  ml_load_tile(PROJ + (size_t)row0 * PW + C_MK + hh * 64, Kt, tid);
  ml_load_tile(PROJ + (size_t)row0 * PW + C_MV + hh * 64, Vt, tid);
  for (int i = tid; i < 2 * USTRIDE; i += 512) {
    const int dir = i / USTRIDE, e = i - dir * USTRIDE;
    const int seq = (b * 4 + hh) * 2 + dir, ci = ml_cidx(ch, dir);
    const float v = UL[((size_t)seq * NCH + ci) * USTRIDE + e];
    if (e < 4096) Cs[dir * 64 * 65 + (e >> 6) * 65 + (e & 63)] = v; else Ns[dir * 64 + (e - 4096)] = v;
  }
  if (wid < 2) {
    const int dir = wid;
    const float ig = GT[(size_t)(row0 + lane) * 16 + (2 * dir) * 4 + hh];
    const float lf = logsigmoidf_(GT[(size_t)(row0 + lane) * 16 + (2 * dir + 1) * 4 + hh]);
    float ps = lf;
#pragma unroll
    for (int o = 1; o < 64; o <<= 1) { const float t = __shfl_up(ps, o); if (lane >= o) ps += t; }
    const float tot = __shfl(ps, 63);
    const float bc = dir == 0 ? ps : (tot - ps + lf);
    Bq[dir * 64 + lane] = bc; Gs[dir * 64 + lane] = ig - bc;
    if (lane == 0) { const int seq = (b * 4 + hh) * 2 + dir, ci = ml_cidx(ch, dir); Mi[dir] = META[((size_t)seq * NCH + ci) * 4 + 2]; }
  }
  __syncthreads();
  {
    const int dir = wid >> 2, tt = (wid >> 1) & 1, et = wid & 1;
    const int t = tt * 32 + r32;
    f32x16 sa[2] = {};
#pragma unroll 4
    for (int ks = 0; ks < 32; ++ks) {
      const float bq = Qt[t * 65 + 2 * ks + hi];
      const float a0 = Kt[(r32) * 65 + 2 * ks + hi], a1 = Kt[(32 + r32) * 65 + 2 * ks + hi];
      sa[0] = __builtin_amdgcn_mfma_f32_32x32x2f32(a0, bq, sa[0], 0, 0, 0);
      sa[1] = __builtin_amdgcn_mfma_f32_32x32x2f32(a1, bq, sa[1], 0, 0, 0);
    }
    const float bt = Bq[dir * 64 + t];
    const float inter = bt + Mi[dir];
    float mx = -INFINITY;
    f32x16 dl[2];
#pragma unroll
    for (int st = 0; st < 2; ++st)
#pragma unroll
      for (int r = 0; r < 16; ++r) {
        const int s = st * 32 + crow(r, hi);
        const bool ok = dir == 0 ? (s <= t) : (s >= t);
        const float d = ok ? bt + Gs[dir * 64 + s] : -INFINITY;
        dl[st][r] = d; mx = fmaxf(mx, d);
      }
    mx = fmaxf(mx, __shfl_xor(mx, 32));
    const float mt = fmaxf(inter, mx);
    const float iw = __expf(inter - mt);
    float rsum = 0.f;
#pragma unroll
    for (int st = 0; st < 2; ++st)
#pragma unroll
      for (int r = 0; r < 16; ++r) { const float w = __expf(dl[st][r] - mt); sa[st][r] *= w; rsum += sa[st][r]; }
    rsum += __shfl_xor(rsum, 32);
    float qn = 0.f;
#pragma unroll 8
    for (int i = 0; i < 32; ++i) { const int d = hi * 32 + i; qn += Ns[dir * 64 + d] * Qt[t * 65 + d]; }
    qn += __shfl_xor(qn, 32);
    const float den = rsum + iw * qn;
    const float rden = 1.f / fmaxf(fabsf(den), __expf(-mt));
    f32x16 an = {}, ac = {};
#pragma unroll
    for (int st = 0; st < 2; ++st)
#pragma unroll
      for (int r = 0; r < 16; ++r) {
        const float a = Vt[(st * 32 + crow(r, hi)) * 65 + et * 32 + r32];
        an = __builtin_amdgcn_mfma_f32_32x32x2f32(a, sa[st][r], an, 0, 0, 0);
      }
    const float* Cd = Cs + dir * 64 * 65;
#pragma unroll 4
    for (int ks = 0; ks < 32; ++ks) {
      const float a = Cd[(et * 32 + r32) * 65 + 2 * ks + hi];
      const float bq = Qt[t * 65 + 2 * ks + hi];
      ac = __builtin_amdgcn_mfma_f32_32x32x2f32(a, bq, ac, 0, 0, 0);
    }
#pragma unroll
    for (int r = 0; r < 16; ++r) HB[dir * 64 * 65 + t * 65 + et * 32 + crow(r, hi)] = (an[r] + iw * ac[r]) * rden;
  }
  __syncthreads();
  {
    const int t = tid >> 3, e8 = (tid & 7) * 8;
    float v[8]; float ss = 0.f;
#pragma unroll
    for (int i = 0; i < 8; ++i) { v[i] = HB[t * 65 + e8 + i] + HB[64 * 65 + t * 65 + e8 + i]; ss += v[i] * v[i]; }
    ss += __shfl_xor(ss, 1); ss += __shfl_xor(ss, 2); ss += __shfl_xor(ss, 4);
    const float rs = rsqrtf(ss * (1.f / 64.f) + EPS);
    const u32x4 ov = *(const u32x4*)(PROJ + (size_t)(row0 + t) * PW + C_MO + hh * 64 + e8);
    const float og[8] = {bflo(ov.x), bfhi(ov.x), bflo(ov.y), bfhi(ov.y), bflo(ov.z), bfhi(ov.z), bflo(ov.w), bfhi(ov.w)};
    const float* g = p.in[I_MNORMG] + l * 64 + e8;
    float o[8];
#pragma unroll
    for (int i = 0; i < 8; ++i) o[i] = (ABL & 2) ? 0.f : v[i] * rs * g[i] * sigmoidf_(og[i]);
    u32x4 w; w.x = cvtpk(o[0], o[1]); w.y = cvtpk(o[2], o[3]); w.z = cvtpk(o[4], o[5]); w.w = cvtpk(o[6], o[7]);
    *(u32x4*)(MIX + (size_t)(row0 + t) * DM + 256 + hh * 64 + e8) = w;
  }
  __syncthreads();
}


__device__ __forceinline__ void ml_out_unit2(const Params& p, int l, int unit, unsigned char* lds) {
  int tid_ = tidx(); asm volatile("" : "+v"(tid_)); const int tid = tid_, lane = tid & 63, wid = tid >> 6, r32 = lane & 31, hi = lane >> 5;
  unsigned char* Qs = lds; unsigned char* Ks = lds + 64 * MLP; unsigned char* VT = lds + 2 * 64 * MLP; unsigned char* Cs = lds + 3 * 64 * MLP;
  float* Ns = (float*)(lds + 5 * 64 * MLP);
  float* Bq = Ns + 128;
  float* Gs = Bq + 128;
  float* Mi = Gs + 128;
  float* HB = Mi + 64;
  const bf16_t* PROJ = (const bf16_t*)(p.ws + WS_PROJ);
  const float* GT = (const float*)(p.ws + WS_GATES);
  const bf16_t* CST = (const bf16_t*)(p.ws + WS_CST); const float* NST = (const float*)(p.ws + WS_NST); const float* META = (const float*)(p.ws + WS_MLMETA);
  bf16_t* MIX = (bf16_t*)(p.ws + WS_MIX);
  const int b = unit / (4 * NCH), hh = (unit / NCH) & 3, ch = unit % NCH;
  const int row0 = b * SEGL + ch * 64;
  ml_stage_rm(PROJ + (size_t)row0 * PW + C_MQ + hh * 64, PW, Qs, tid);
  ml_stage_rm(PROJ + (size_t)row0 * PW + C_MK + hh * 64, PW, Ks, tid);
  ml_stage_tr(PROJ + (size_t)row0 * PW + C_MV + hh * 64, PW, VT, tid);
#pragma unroll
  for (int dir = 0; dir < 2; ++dir) {
    const int seq = (b * 4 + hh) * 2 + dir, ci = ml_cidx(ch, dir);
    ml_stage_rm(CST + ((size_t)seq * NCH + ci) * 4096, 64, Cs + dir * 64 * MLP, tid);
    if (tid < 64) Ns[dir * 64 + tid] = NST[((size_t)seq * NCH + ci) * 64 + tid];
  }
  if (wid < 2) {
    const int dir = wid;
    const float ig = GT[(size_t)(row0 + lane) * 16 + (2 * dir) * 4 + hh];
    const float lf = logsigmoidf_(GT[(size_t)(row0 + lane) * 16 + (2 * dir + 1) * 4 + hh]);
    float ps = lf;
#pragma unroll
    for (int o = 1; o < 64; o <<= 1) { const float t = __shfl_up(ps, o); if (lane >= o) ps += t; }
    const float tot = __shfl(ps, 63);
    const float bc = dir == 0 ? ps : (tot - ps + lf);
    Bq[dir * 64 + lane] = bc; Gs[dir * 64 + lane] = ig - bc;
    if (lane == 0) { const int seq = (b * 4 + hh) * 2 + dir, ci = ml_cidx(ch, dir); Mi[dir] = META[((size_t)seq * NCH + ci) * 4 + 2]; }
  }
  __syncthreads();
  {
    const int dir = wid >> 2, tt = (wid >> 1) & 1, et = wid & 1;
    const int t = tt * 32 + r32;
    f32x16 sa[2] = {};
    bf16x8 bq[4];
#pragma unroll
    for (int ks = 0; ks < 4; ++ks) {
      bq[ks] = *(const bf16x8*)(Qs + t * MLP + (ks * 16 + hi * 8) * 2);
      const bf16x8 a0 = *(const bf16x8*)(Ks + r32 * MLP + (ks * 16 + hi * 8) * 2), a1 = *(const bf16x8*)(Ks + (32 + r32) * MLP + (ks * 16 + hi * 8) * 2);
      sa[0] = __builtin_amdgcn_mfma_f32_32x32x16_bf16(a0, bq[ks], sa[0], 0, 0, 0);
      sa[1] = __builtin_amdgcn_mfma_f32_32x32x16_bf16(a1, bq[ks], sa[1], 0, 0, 0);
    }
    const float bt = Bq[dir * 64 + t];
    const float inter = bt + Mi[dir];
    float mx = -INFINITY;
    f32x16 dl[2];
#pragma unroll
    for (int st = 0; st < 2; ++st)
#pragma unroll
      for (int r = 0; r < 16; ++r) {
        const int s = st * 32 + crow(r, hi);
        const bool ok = dir == 0 ? (s <= t) : (s >= t);
        const float d = ok ? bt + Gs[dir * 64 + s] : -INFINITY;
        dl[st][r] = d; mx = fmaxf(mx, d);
      }
    mx = fmaxf(mx, __shfl_xor(mx, 32));
    const float mt = fmaxf(inter, mx);
    const float iw = __expf(inter - mt);
    float rsum = 0.f;
#pragma unroll
    for (int st = 0; st < 2; ++st)
#pragma unroll
      for (int r = 0; r < 16; ++r) { const float w = __expf(dl[st][r] - mt); sa[st][r] *= w; rsum += sa[st][r]; }
    rsum += __shfl_xor(rsum, 32);
    float qn = 0.f;
#pragma unroll
    for (int i = 0; i < 4; ++i) {
      const int d0 = hi * 32 + i * 8;
      const u32x4 qa = *(const u32x4*)(Qs + t * MLP + d0 * 2);
      const f32x4 n0 = *(const f32x4*)(Ns + dir * 64 + d0), n1 = *(const f32x4*)(Ns + dir * 64 + d0 + 4);
      qn += bflo(qa.x) * n0.x + bfhi(qa.x) * n0.y + bflo(qa.y) * n0.z + bfhi(qa.y) * n0.w + bflo(qa.z) * n1.x + bfhi(qa.z) * n1.y + bflo(qa.w) * n1.z + bfhi(qa.w) * n1.w;
    }
    qn += __shfl_xor(qn, 32);
    const float den = rsum + iw * qn;
    const float rden = 1.f / fmaxf(fabsf(den), __expf(-mt));
    f32x16 an = {}, ac = {};
#pragma unroll
    for (int st = 0; st < 2; ++st)
#pragma unroll
      for (int k2 = 0; k2 < 2; ++k2) {
        u32x4 bx; bx.x = cvtpk(sa[st][8 * k2 + 0], sa[st][8 * k2 + 1]); bx.y = cvtpk(sa[st][8 * k2 + 2], sa[st][8 * k2 + 3]);
        bx.z = cvtpk(sa[st][8 * k2 + 4], sa[st][8 * k2 + 5]); bx.w = cvtpk(sa[st][8 * k2 + 6], sa[st][8 * k2 + 7]);
        const unsigned char* vrow = VT + (et * 32 + r32) * MLP + (st * 32 + 16 * k2 + 4 * hi) * 2;
        const u32x2 v0 = *(const u32x2*)vrow, v1 = *(const u32x2*)(vrow + 16);
        u32x4 ax; ax.x = v0.x; ax.y = v0.y; ax.z = v1.x; ax.w = v1.y;
        an = __builtin_amdgcn_mfma_f32_32x32x16_bf16(*(const bf16x8*)&ax, *(const bf16x8*)&bx, an, 0, 0, 0);
      }
    const unsigned char* Cd = Cs + dir * 64 * MLP;
#pragma unroll
    for (int ks = 0; ks < 4; ++ks) {
      const bf16x8 a = *(const bf16x8*)(Cd + (et * 32 + r32) * MLP + (ks * 16 + hi * 8) * 2);
      ac = __builtin_amdgcn_mfma_f32_32x32x16_bf16(a, bq[ks], ac, 0, 0, 0);
    }
#pragma unroll
    for (int r = 0; r < 16; ++r) HB[dir * 64 * 65 + t * 65 + et * 32 + crow(r, hi)] = (an[r] + iw * ac[r]) * rden;
  }
  __syncthreads();
  {
    const int t = tid >> 3, e8 = (tid & 7) * 8;
    float v[8]; float ss = 0.f;
#pragma unroll
    for (int i = 0; i < 8; ++i) { v[i] = HB[t * 65 + e8 + i] + HB[64 * 65 + t * 65 + e8 + i]; ss += v[i] * v[i]; }
    ss += __shfl_xor(ss, 1); ss += __shfl_xor(ss, 2); ss += __shfl_xor(ss, 4);
    const float rs = rsqrtf(ss * (1.f / 64.f) + EPS);
    const u32x4 ov = *(const u32x4*)(PROJ + (size_t)(row0 + t) * PW + C_MO + hh * 64 + e8);
    const float og[8] = {bflo(ov.x), bfhi(ov.x), bflo(ov.y), bfhi(ov.y), bflo(ov.z), bfhi(ov.z), bflo(ov.w), bfhi(ov.w)};
    const float* g = p.in[I_MNORMG] + l * 64 + e8;
    float o[8];
#pragma unroll
    for (int i = 0; i < 8; ++i) o[i] = (ABL & 2) ? 0.f : v[i] * rs * g[i] * sigmoidf_(og[i]);
    u32x4 w; w.x = cvtpk(o[0], o[1]); w.y = cvtpk(o[2], o[3]); w.z = cvtpk(o[4], o[5]); w.w = cvtpk(o[6], o[7]);
    *(u32x4*)(MIX + (size_t)(row0 + t) * DM + 256 + hh * 64 + e8) = w;
  }
  __syncthreads();
}

#define KSWZ(row, colB) ((row) * 256 + ((colB) ^ (((row) & 15) << 4)))
#define SBAR() __builtin_amdgcn_sched_barrier(0)
constexpr int ATT_SHM_V = 128 * 80, ATT_SHM_K = 64 * 128 * 2;
constexpr float ATT_THR = 8.0f;
__device__ __forceinline__ int v_st(int k, int c) { const int kk = (k & ~0xC) | ((k & 4) << 1) | ((k & 8) >> 1); return ((kk >> 3) * 4 + (c >> 5)) * 512 + ((kk & 7) * 32 + (c & 31)) * 2; }
__device__ __forceinline__ int v_rd_base(int lane) { return ((lane & 3) << 3) | (((lane >> 2) & 3) << 6) | (((lane >> 4) & 1) << 5) | (((lane >> 5) & 1) << 8); }
constexpr int v_rd_off(int d0, int ks, int half) { return d0 * 512 + ks * 4096 + half * 2048; }
template <int OFF> __device__ __forceinline__ s16x4 tr_read(int vb) {
  s16x4 r; asm volatile("ds_read_b64_tr_b16 %0, %1 offset:%2" : "=&v"(r) : "v"(vb), "i"(OFF) : "memory"); return r;
}
template <int D0> __device__ __forceinline__ void pv_one(f32x16& od, int vb, bf16x8 pa0, bf16x8 pa1, bf16x8 pa2, bf16x8 pa3) {
  const s16x4 l0 = tr_read<v_rd_off(D0, 0, 0)>(vb), h0 = tr_read<v_rd_off(D0, 0, 1)>(vb), l1 = tr_read<v_rd_off(D0, 1, 0)>(vb), h1 = tr_read<v_rd_off(D0, 1, 1)>(vb);
  const s16x4 l2 = tr_read<v_rd_off(D0, 2, 0)>(vb), h2 = tr_read<v_rd_off(D0, 2, 1)>(vb), l3 = tr_read<v_rd_off(D0, 3, 0)>(vb), h3 = tr_read<v_rd_off(D0, 3, 1)>(vb);
  asm volatile("s_waitcnt lgkmcnt(0)" ::: "memory"); SBAR();
#define PK(L, H) (bf16x8){L[0], L[1], L[2], L[3], H[0], H[1], H[2], H[3]}
  od = __builtin_amdgcn_mfma_f32_32x32x16_bf16(pa0, PK(l0, h0), od, 0, 0, 0);
  od = __builtin_amdgcn_mfma_f32_32x32x16_bf16(pa1, PK(l1, h1), od, 0, 0, 0);
  od = __builtin_amdgcn_mfma_f32_32x32x16_bf16(pa2, PK(l2, h2), od, 0, 0, 0);
  od = __builtin_amdgcn_mfma_f32_32x32x16_bf16(pa3, PK(l3, h3), od, 0, 0, 0);
#undef PK
}
template <int D0> __device__ __forceinline__ void pv_two(f32x16& oa, f32x16& ob, int vb, bf16x8 a0, bf16x8 a1, bf16x8 a2, bf16x8 a3, bf16x8 b0, bf16x8 b1, bf16x8 b2, bf16x8 b3) {
  const s16x4 l0 = tr_read<v_rd_off(D0, 0, 0)>(vb), h0 = tr_read<v_rd_off(D0, 0, 1)>(vb), l1 = tr_read<v_rd_off(D0, 1, 0)>(vb), h1 = tr_read<v_rd_off(D0, 1, 1)>(vb);
  const s16x4 l2 = tr_read<v_rd_off(D0, 2, 0)>(vb), h2 = tr_read<v_rd_off(D0, 2, 1)>(vb), l3 = tr_read<v_rd_off(D0, 3, 0)>(vb), h3 = tr_read<v_rd_off(D0, 3, 1)>(vb);
  asm volatile("s_waitcnt lgkmcnt(0)" ::: "memory"); SBAR();
#define PK(L, H) (bf16x8){L[0], L[1], L[2], L[3], H[0], H[1], H[2], H[3]}
  const bf16x8 v0 = PK(l0, h0), v1 = PK(l1, h1), v2 = PK(l2, h2), v3 = PK(l3, h3);
  oa = __builtin_amdgcn_mfma_f32_32x32x16_bf16(a0, v0, oa, 0, 0, 0);
  ob = __builtin_amdgcn_mfma_f32_32x32x16_bf16(b0, v0, ob, 0, 0, 0);
  oa = __builtin_amdgcn_mfma_f32_32x32x16_bf16(a1, v1, oa, 0, 0, 0);
  ob = __builtin_amdgcn_mfma_f32_32x32x16_bf16(b1, v1, ob, 0, 0, 0);
  oa = __builtin_amdgcn_mfma_f32_32x32x16_bf16(a2, v2, oa, 0, 0, 0);
  ob = __builtin_amdgcn_mfma_f32_32x32x16_bf16(b2, v2, ob, 0, 0, 0);
  oa = __builtin_amdgcn_mfma_f32_32x32x16_bf16(a3, v3, oa, 0, 0, 0);
  ob = __builtin_amdgcn_mfma_f32_32x32x16_bf16(b3, v3, ob, 0, 0, 0);
#undef PK
}
struct KQFrag { bf16x8 b0, b1, q; };
__device__ __forceinline__ void att_ldkq(KQFrag& f, const LAS unsigned char* l3, int ak, int kofs, int qofs) {
  const LAS unsigned char* kp = l3 + (ak + kofs);
  f.b0 = *(const LAS bf16x8*)kp; f.b1 = *(const LAS bf16x8*)(kp + 8192); f.q = *(const LAS bf16x8*)(l3 + (ak + qofs));
}
#define ATT_MF(pa_, pb_, f_) do { pa_ = __builtin_amdgcn_mfma_f32_32x32x16_bf16(f_.b0, f_.q, pa_, 0, 0, 0); pb_ = __builtin_amdgcn_mfma_f32_32x32x16_bf16(f_.b1, f_.q, pb_, 0, 0, 0); } while (0)
__device__ __forceinline__ void att_qk_all(f32x16& p0, f32x16& p1, f32x16& q0, f32x16& q1, KQFrag& f0, const LAS unsigned char* l3, int ak0, int kofs, int qofs, float ia, float ib) {
  KQFrag f1;
#pragma unroll
  for (int r = 0; r < 16; ++r) { p0[r] = ia; p1[r] = ia; q0[r] = ib; q1[r] = ib; }
  att_ldkq(f1, l3, ak0 ^ (1 << 5), kofs, qofs); ATT_MF(p0, p1, f0); SBAR();
  att_ldkq(f0, l3, ak0 ^ (2 << 5), kofs, qofs); ATT_MF(p0, p1, f1); SBAR();
  att_ldkq(f1, l3, ak0 ^ (3 << 5), kofs, qofs); ATT_MF(p0, p1, f0); SBAR();
  att_ldkq(f0, l3, ak0 ^ (4 << 5), kofs, qofs); ATT_MF(p0, p1, f1); SBAR();
  att_ldkq(f1, l3, ak0 ^ (5 << 5), kofs, qofs); ATT_MF(q0, q1, f0); SBAR();
  att_ldkq(f0, l3, ak0 ^ (6 << 5), kofs, qofs); ATT_MF(q0, q1, f1); SBAR();
  att_ldkq(f1, l3, ak0 ^ (7 << 5), kofs, qofs); ATT_MF(q0, q1, f0); SBAR();
  ATT_MF(q0, q1, f1); SBAR();
}
__device__ __forceinline__ void att_softmax(f32x16& p0, f32x16& p1, float& m_reg, float& l_reg, float& alpha, bool first, i32x8& pa) {
  alpha = 1.f;
  if (first) {
    float pmax = p0[0];
#pragma unroll
    for (int r = 1; r < 16; ++r) pmax = fmaxf(pmax, p0[r]);
#pragma unroll
    for (int r = 0; r < 16; ++r) pmax = fmaxf(pmax, p1[r]);
    { auto rr = __builtin_amdgcn_permlane32_swap(__float_as_uint(pmax), __float_as_uint(pmax), false, false);
      pmax = fmaxf(__uint_as_float(rr[0]), __uint_as_float(rr[1])); }
    alpha = 0.f; m_reg = pmax;
#pragma unroll
    for (int r = 0; r < 16; ++r) { p0[r] -= pmax; p1[r] -= pmax; }
  }
#pragma unroll
  for (int r = 0; r < 16; ++r) { p0[r] = __builtin_amdgcn_exp2f(p0[r]); p1[r] = __builtin_amdgcn_exp2f(p1[r]); }
  float ps;
  {
#define VADD(d_, a_, b_) asm("v_add_f32_e32 %0, %1, %2" : "=v"(d_) : "v"(a_), "v"(b_))
    float s0, s1, s2, s3;
    VADD(s0, p0[0], p0[1]); VADD(s1, p0[8], p0[9]); VADD(s2, p1[0], p1[1]); VADD(s3, p1[8], p1[9]);
#pragma unroll
    for (int r = 2; r < 8; ++r) { VADD(s0, s0, p0[r]); VADD(s1, s1, p0[8 + r]); VADD(s2, s2, p1[r]); VADD(s3, s3, p1[8 + r]); }
    VADD(s0, s0, s1); VADD(s2, s2, s3); VADD(ps, s0, s2);
#undef VADD
  }
  { auto rr = __builtin_amdgcn_permlane32_swap(__float_as_uint(ps), __float_as_uint(ps), false, false);
    ps = __uint_as_float(rr[0]) + __uint_as_float(rr[1]); }
  if (__builtin_expect(!first && __any(ps > 256.f), 0)) {
    float emax = p0[0];
#pragma unroll
    for (int r = 1; r < 16; ++r) emax = fmaxf(emax, p0[r]);
#pragma unroll
    for (int r = 0; r < 16; ++r) emax = fmaxf(emax, p1[r]);
    { auto rr = __builtin_amdgcn_permlane32_swap(__float_as_uint(emax), __float_as_uint(emax), false, false);
      emax = fmaxf(__uint_as_float(rr[0]), __uint_as_float(rr[1])); }
    const float delta = fmaxf(__builtin_amdgcn_logf(emax), 0.f);
    alpha = __builtin_amdgcn_exp2f(-delta); m_reg += delta;
#pragma unroll
    for (int r = 0; r < 16; ++r) { p0[r] *= alpha; p1[r] *= alpha; }
    ps *= alpha;
  }
  l_reg = l_reg * alpha + ps;
#pragma unroll
  for (int v = 0; v < 4; ++v) {
    int w0, w1; asm volatile("" : "=v"(w0), "=v"(w1));
    w0 = __builtin_amdgcn_cvt_pk_fp8_f32(p0[4 * v], p0[4 * v + 1], w0, false); w0 = __builtin_amdgcn_cvt_pk_fp8_f32(p0[4 * v + 2], p0[4 * v + 3], w0, true);
    w1 = __builtin_amdgcn_cvt_pk_fp8_f32(p1[4 * v], p1[4 * v + 1], w1, false); w1 = __builtin_amdgcn_cvt_pk_fp8_f32(p1[4 * v + 2], p1[4 * v + 3], w1, true);
    pa[v] = w0; pa[4 + v] = w1;
  }
}
__device__ __forceinline__ void att_unit(const bf16_t* __restrict__ Qb, const bf16_t* __restrict__ Kh, const unsigned char* __restrict__ V8, bf16_t* __restrict__ Ob,
                                         int nkeys, float lam, const float* __restrict__ ng, float oscale, unsigned char* lds) {
  int tid_ = tidx(); asm volatile("" : "+v"(tid_)); const int tid = tid_, wid = tid >> 6, lane = tid & 63, r32 = lane & 31, hi = lane >> 5;
  const int grp = __builtin_amdgcn_readfirstlane(wid >> 2);
  unsigned char* V_lds = lds; unsigned char* K_lds = lds + 2 * ATT_SHM_V;
  float* wsl = (float*)(lds + 2 * ATT_SHM_V + 2 * ATT_SHM_K) + wid * 64; float* li_l = wsl; float* al_l = wsl + 32;
  float m0 = 0.f, l0 = 0.f, m1 = 0.f, l1 = 0.f;
  f32x16 o0[4] = {}, o1[4] = {};
  unsigned char* Q_lds = lds + 2 * ATT_SHM_V + 2 * ATT_SHM_K + 2048;
#pragma unroll
  for (int i = 0; i < 8; ++i) { const int id = tid + 512 * i, qrw = id >> 4, ch = id & 15;
    *(bf16x8*)(Q_lds + KSWZ(qrw, ch * 16)) = *(const bf16x8*)(Qb + (size_t)qrw * PW + ch * 8); }
  const int qrow = wid * 32 + r32;
  int kso[2];
#pragma unroll
  for (int i = 0; i < 2; ++i) {
    const int o16 = tid + 512 * i;
    { const int row = o16 >> 4, cs = (o16 & 15) ^ (row & 15); kso[i] = row * PW + cs * 8; }
  }
  const unsigned ldsw = (unsigned)__builtin_amdgcn_readfirstlane(wid) * 1024u;
#define GSTAGE_K(b, k0) do { _Pragma("unroll") for (int i_ = 0; i_ < 2; ++i_) \
    __builtin_amdgcn_global_load_lds((const unsigned*)(Kh + (size_t)(k0) * PW + kso[i_]), (LAS unsigned*)(K_lds + (b) * ATT_SHM_K + ldsw + i_ * 8192), 16, 0, 0); } while (0)
#define GSTAGE_V(b, k0) do { const unsigned char* vi_ = V8 + (size_t)((k0) >> 6) * ATT_SHM_V + tid * 16; \
      __builtin_amdgcn_global_load_lds((const unsigned*)vi_, (LAS unsigned*)(V_lds + (b) * ATT_SHM_V + ldsw), 16, 0, 0); \
      if (wid < 2) __builtin_amdgcn_global_load_lds((const unsigned*)(vi_ + 8192), (LAS unsigned*)(V_lds + (b) * ATT_SHM_V + 8192 + ldsw), 16, 0, 0); } while (0)
#define STAGE_PAIR(jj) do { GSTAGE_V((jj) & 1, (jj) * 64); if ((jj) + 1 < NT) GSTAGE_K((jj) & 1, ((jj) + 1) * 64); } while (0)
#define RESC(o, a) do { if (__any((a) < 1.f)) { if (hi == 0) al_l[r32] = (a); asm volatile("s_waitcnt lgkmcnt(0)" ::: "memory"); \
    _Pragma("unroll") for (int d = 0; d < 4; ++d) _Pragma("unroll") for (int r = 0; r < 16; ++r) o[d][r] *= al_l[crow(r, hi)]; } } while (0)
#define ATT_BAR() do { asm volatile("s_waitcnt lgkmcnt(0)" ::: "memory"); __builtin_amdgcn_s_barrier(); asm volatile("" ::: "memory"); } while (0)
  const int NT = nkeys / 64;
  GSTAGE_K(1, 0); STAGE_PAIR(0);
  asm volatile("s_waitcnt vmcnt(0)" ::: "memory"); __syncthreads();
  f32x16 p0, p1, q0, q1; i32x8 pa, pb;
  const LAS unsigned char* l3 = (const LAS unsigned char*)lds;
  const int ak0 = r32 * 256 + ((hi * 16) ^ ((r32 & 15) << 4));
  const int kofs0 = 2 * ATT_SHM_V, qofs0 = 2 * ATT_SHM_V + 2 * ATT_SHM_K + 2048 + __builtin_amdgcn_readfirstlane(wid) * 8192;
  { KQFrag f0; att_ldkq(f0, l3, ak0, kofs0 + ATT_SHM_K, qofs0);
    att_qk_all(p0, p1, q0, q1, f0, l3, ak0, kofs0 + ATT_SHM_K, qofs0, 0.f, 0.f); }
  if (grp) ATT_BAR();
#pragma unroll 1
  for (int j = 0; j < NT; ++j) {
    const int cur = j & 1;
    const bool more = (j + 1 < NT);
    if (grp && more) STAGE_PAIR(j + 1);
    { float alphaA, alphaB;
      const bool first = (j == 0);
      att_softmax(p0, p1, m0, l0, alphaA, first, pa); SBAR();
      att_softmax(q0, q1, m1, l1, alphaB, first, pb); SBAR();
      RESC(o0, alphaA);
      RESC(o1, alphaB); }
    asm volatile("" : "+v"(pa), "+v"(pb), "+v"(m0), "+v"(l0), "+v"(m1), "+v"(l1));
    asm volatile("" : "+v"(o0[0]), "+v"(o0[1]), "+v"(o0[2]), "+v"(o0[3]), "+v"(o1[0]), "+v"(o1[1]), "+v"(o1[2]), "+v"(o1[3]));
    if (!grp) asm volatile("s_waitcnt vmcnt(0)" ::: "memory");
    ATT_BAR();
    if (!grp && more) STAGE_PAIR(j + 1);
    __builtin_amdgcn_s_setprio(1);
    {
      int kofs = kofs0 + cur * ATT_SHM_K, qofs = qofs0, ak = ak0; asm volatile("" : "+s"(kofs), "+s"(qofs), "+v"(ak));
      const LAS unsigned char* vrow = l3 + (r32 * 80 + hi * 32 + cur * ATT_SHM_V);
      u32x4 va0 = *(const LAS u32x4*)vrow, va1 = *(const LAS u32x4*)(vrow + 16), vb0, vb1;
      KQFrag f0;
#define ATT_PV(d0_, x0_, x1_) do { i32x8 bv; bv[0] = (int)x0_.x; bv[1] = (int)x0_.y; bv[2] = (int)x0_.z; bv[3] = (int)x0_.w; bv[4] = (int)x1_.x; bv[5] = (int)x1_.y; bv[6] = (int)x1_.z; bv[7] = (int)x1_.w; \
        o0[d0_] = __builtin_amdgcn_mfma_scale_f32_32x32x64_f8f6f4(pa, bv, o0[d0_], 0, 0, 0, 0x7F7F7F7F, 0, 0x7F7F7F7F); \
        o1[d0_] = __builtin_amdgcn_mfma_scale_f32_32x32x64_f8f6f4(pb, bv, o1[d0_], 0, 0, 0, 0x7F7F7F7F, 0, 0x7F7F7F7F); } while (0)
      vb0 = *(const LAS u32x4*)(vrow + 32 * 80); vb1 = *(const LAS u32x4*)(vrow + 32 * 80 + 16); ATT_PV(0, va0, va1); SBAR();
      va0 = *(const LAS u32x4*)(vrow + 64 * 80); va1 = *(const LAS u32x4*)(vrow + 64 * 80 + 16); ATT_PV(1, vb0, vb1); SBAR();
      vb0 = *(const LAS u32x4*)(vrow + 96 * 80); vb1 = *(const LAS u32x4*)(vrow + 96 * 80 + 16); ATT_PV(2, va0, va1); SBAR();
      att_ldkq(f0, l3, ak, kofs, qofs);
      ATT_PV(3, vb0, vb1); SBAR();
#undef ATT_PV
      asm volatile("" : "+v"(o0[0]), "+v"(o0[1]), "+v"(o0[2]), "+v"(o0[3]), "+v"(o1[0]), "+v"(o1[1]), "+v"(o1[2]), "+v"(o1[3]));
      att_qk_all(p0, p1, q0, q1, f0, l3, ak, kofs, qofs, -m0, -m1);
      asm volatile("" : "+v"(p0), "+v"(p1), "+v"(q0), "+v"(q1));
    }
    __builtin_amdgcn_s_setprio(0);
    if (grp) asm volatile("s_waitcnt vmcnt(0)" ::: "memory");
    ATT_BAR();
  }
  if (!grp) ATT_BAR();
  if (hi == 0) { li_l[r32] = 1.f / l0; al_l[r32] = lam / l1; }
  asm volatile("s_waitcnt lgkmcnt(0)" ::: "memory");
  float ss[16];
#pragma unroll
  for (int r = 0; r < 16; ++r) {
    const float a = li_l[crow(r, hi)], bq = al_l[crow(r, hi)];
    float s = 0.f;
#pragma unroll
    for (int d = 0; d < 4; ++d) { const float v = o0[d][r] * a - o1[d][r] * bq; o0[d][r] = v; s += v * v; }
    s += dpp_mov<0xB1>(s); s += dpp_mov<0x4E>(s); s += dpp_mov<0x141>(s); s += dpp_mov<0x140>(s);
    { auto rr_ = __builtin_amdgcn_permlane16_swap(__float_as_uint(s), __float_as_uint(s), false, false); s = __uint_as_float(rr_[0]) + __uint_as_float(rr_[1]); }
    ss[r] = rsqrtf(s * (1.f / 128.f) + EPS) * oscale;
  }
  bf16_t* Ow = Ob + (size_t)(wid * 32) * DM;
#pragma unroll
  for (int d = 0; d < 4; ++d) {
    const float g = ng[d * 32 + r32];
#pragma unroll
    for (int r = 0; r < 16; ++r) Ow[(size_t)crow(r, hi) * DM + d * 32 + r32] = (ABL & 4) ? (bf16_t)0 : (bf16_t)(cvtpk(o0[d][r] * ss[r] * g, 0.f) & 0xffffu);
  }
  __syncthreads();
#undef GSTAGE_K
#undef GSTAGE_V
#undef STAGE_PAIR
#undef RESC
#undef ATT_BAR
}

__device__ __forceinline__ float ins16(float (&a)[16], float x) {
#pragma unroll
  for (int i = 0; i < 16; ++i) { const float h = fmaxf(a[i], x); x = fminf(a[i], x); a[i] = h; }
  return x;
}
__device__ __forceinline__ void bsort16(float (&a)[16]) {
#pragma unroll
  for (int k = 2; k <= 16; k <<= 1)
#pragma unroll
    for (int j = k >> 1; j > 0; j >>= 1)
#pragma unroll
      for (int i = 0; i < 16; ++i) {
        const int q = i ^ j;
        if (q > i) {
          const bool desc = ((i & k) == 0);
          const float hi_ = fmaxf(a[i], a[q]), lo_ = fminf(a[i], a[q]);
          a[i] = desc ? hi_ : lo_; a[q] = desc ? lo_ : hi_;
        }
      }
}
__device__ __forceinline__ void bmerge16(float (&a)[16], const float (&b)[16]) {
#pragma unroll
  for (int i = 0; i < 16; ++i) a[i] = fmaxf(a[i], b[15 - i]);
#pragma unroll
  for (int j = 8; j > 0; j >>= 1)
#pragma unroll
    for (int i = 0; i < 16; ++i) {
      const int q = i ^ j;
      if (q > i) { const float hi_ = fmaxf(a[i], a[q]), lo_ = fminf(a[i], a[q]); a[i] = hi_; a[q] = lo_; }
    }
}
__device__ __forceinline__ float gelu_erf(float x) { return 0.5f * x * (1.f + erff(x * 0.70710678118654752440f)); }
#define XB_TMO      128
#define XB_XCNT(j)  (256  + 64 * (j))
#define XB_XSUB(j)  (1280 + 64 * (j))
#define XB_XGEN(j)  (2304 + 64 * (j))
#define XB_TOP      3328
#define XB_TOPGEN   3392
#define XCD_BAR_WORDS 3456
#define XB_SPIN_CAP (1u << 22)
__device__ __forceinline__ unsigned xb_ld(unsigned* p)              { return __hip_atomic_load(p, __ATOMIC_RELAXED, __HIP_MEMORY_SCOPE_AGENT); }
__device__ __forceinline__ unsigned xb_add(unsigned* p, unsigned v) { return __hip_atomic_fetch_add(p, v, __ATOMIC_RELAXED, __HIP_MEMORY_SCOPE_AGENT); }
__device__ __forceinline__ unsigned xb_xcc_id() { return (unsigned)__builtin_amdgcn_s_getreg((3 << 11) | 20) & 0xFu; }
#define XB_SPIN(cond, bar) do { unsigned _sp = 0; while (cond) { __builtin_amdgcn_s_sleep(1); \
    if ((++_sp & 255u) == 0u) { if (xb_ld(&(bar)[XB_TMO])) break; if (_sp > XB_SPIN_CAP) { atomicAdd(&(bar)[XB_TMO], 1u); break; } } } } while (0)
struct XcdBarrier { unsigned* bar; unsigned x; volatile LAS unsigned* st; };
__device__ __forceinline__ XcdBarrier xcd_barrier_post(unsigned* bar, volatile LAS unsigned* st) {
  XcdBarrier b; b.bar = bar; b.x = xb_xcc_id(); b.st = st;
  if (tidx() == 0) (void)xb_add(&bar[XB_XCNT(b.x)], 1u);
  return b;
}
__device__ __forceinline__ void xcd_barrier_complete(unsigned* bar, unsigned x, unsigned& nloc, unsigned& nx) {
  const unsigned G = gridDim.x * gridDim.y * gridDim.z;
  unsigned sum, cnt, mine, sp = 0u;
  for (;;) {
    sum = 0u; cnt = 0u; mine = 0u;
#pragma unroll
    for (unsigned j = 0; j < 16; ++j) { const unsigned c = xb_ld(&bar[XB_XCNT(j)]); sum += c; cnt += (c > 0u) ? 1u : 0u; mine = (j == x) ? c : mine; }
    if (sum == G) break;
    __builtin_amdgcn_s_sleep(1);
    if ((++sp & 255u) == 0u) { if (xb_ld(&bar[XB_TMO])) break; if (sp > XB_SPIN_CAP) { atomicAdd(&bar[XB_TMO], 1u); break; } }
  }
  nloc = mine > 0u ? mine : 1u; nx = cnt > 0u ? cnt : 1u;
}
__device__ __forceinline__ void xcd_barrier(const XcdBarrier& b) {
  asm volatile("s_waitcnt vmcnt(0)" ::: "memory");
  __syncthreads();
  if (tidx() == 0) {
    unsigned* bar = b.bar;
    __builtin_amdgcn_s_waitcnt(0);
    unsigned nloc = b.st[0], nx = b.st[1];
    if (nloc == 0u) { xcd_barrier_complete(bar, b.x, nloc, nx); b.st[0] = nloc; b.st[1] = nx; }
    const unsigned old = xb_add(&bar[XB_XSUB(b.x)], 1u);
    const unsigned gen = old / nloc;
    if (old + 1u == (gen + 1u) * nloc) {
      __builtin_amdgcn_fence(__ATOMIC_RELEASE, "agent");
      asm volatile("s_waitcnt vmcnt(0)" ::: "memory");
      const unsigned og = xb_add(&bar[XB_TOP], 1u);
      const unsigned tg = og / nx;
      if (og + 1u == (tg + 1u) * nx) xb_add(&bar[XB_TOPGEN], 1u);
      else XB_SPIN(xb_ld(&bar[XB_TOPGEN]) == tg, bar);
      __builtin_amdgcn_fence(__ATOMIC_ACQUIRE, "agent");
      xb_add(&bar[XB_XGEN(b.x)], 1u);
      asm volatile("s_waitcnt vmcnt(0)" ::: "memory");
    } else {
      XB_SPIN(xb_ld(&bar[XB_XGEN(b.x)]) == gen, bar);
      __builtin_amdgcn_fence(__ATOMIC_ACQUIRE, "agent");
      asm volatile("s_waitcnt vmcnt(0)" ::: "memory");
    }
  }
  __syncthreads();
}

constexpr size_t RT_STRIDE = (size_t)T * 128 * 4;
__device__ __forceinline__ void route_unit(const Params& p, int l, int unit, unsigned char* lds) {
  int tid_ = tidx(); asm volatile("" : "+v"(tid_)); const int tid = tid_, lane = tid & 63, wid = tid >> 6, r32 = lane & 31, hi = lane >> 5;
  unsigned char* IDX = lds;
  int* UE = (int*)(lds + 8192); float* UG = (float*)(lds + 8192 + 16384); float* US = (float*)(lds + 8192 + 32768);
  int* EIDG = (int*)(p.ws + WS_EID + (size_t)l * RT_STRIDE); float* GWG = (float*)(p.ws + WS_ULOC + RT_STRIDE); float* SUG = (float*)(p.ws + WS_ULOC + 2 * RT_STRIDE);
  const float* PSC = (const float*)(p.ws + WS_PSC);
  const int row0 = unit * 32;
  const bf16_t* QP = (const bf16_t*)(p.ws + WS_PROJ);
  const bf16_t* KEYS = (const bf16_t*)(p.ws + WS_KEYS) + (size_t)l * 131072;
  for (int rrep = 0; rrep < REP_ROUTE; ++rrep) {
    const int h = wid;
    float top[2][16];
#pragma unroll
    for (int pp = 0; pp < 2; ++pp) {
      const bf16_t* qrow = QP + (size_t)(row0 + r32) * DM + h * 128 + pp * 64 + hi * 8;
      const bf16_t* kb = KEYS + ((size_t)(h * 2 + pp) * 128 + r32) * 64 + hi * 8;
      bf16x8 bq[4];
#pragma unroll
      for (int ks = 0; ks < 4; ++ks) bq[ks] = *(const bf16x8*)(qrow + ks * 16);
      float (&lst)[16] = top[pp];
#pragma unroll
      for (int i = 0; i < 16; ++i) lst[i] = -INFINITY;
#pragma unroll
      for (int nt = 0; nt < 4; ++nt) {
        f32x16 acc = {};
#pragma unroll
        for (int ks = 0; ks < 4; ++ks) {
          const bf16x8 ak = *(const bf16x8*)(kb + (size_t)nt * 32 * 64 + ks * 16);
          acc = __builtin_amdgcn_mfma_f32_32x32x16_bf16(ak, bq[ks], acc, 0, 0, 0);
        }
        float grp[16];
#pragma unroll
        for (int r = 0; r < 16; ++r) grp[r] = __uint_as_float((__float_as_uint(acc[r]) & ~0x7Fu) | (unsigned)(nt * 32 + crow(r, hi)));
        bsort16(grp);
        if (nt == 0) {
#pragma unroll
          for (int i = 0; i < 16; ++i) lst[i] = grp[i];
        } else bmerge16(lst, grp);
        SBAR();
      }
      float oth[16];
#pragma unroll
      for (int i = 0; i < 16; ++i) oth[i] = __shfl_xor(lst[i], 32);
      bmerge16(lst, oth);
      if (hi == 0) {
        unsigned w[4];
#pragma unroll
        for (int i = 0; i < 4; ++i)
          w[i] = (__float_as_uint(lst[4 * i]) & 0x7Fu) | ((__float_as_uint(lst[4 * i + 1]) & 0x7Fu) << 8) | ((__float_as_uint(lst[4 * i + 2]) & 0x7Fu) << 16) | ((__float_as_uint(lst[4 * i + 3]) & 0x7Fu) << 24);
        *(u32x4*)(IDX + ((r32 * 8 + h) * 2 + pp) * 16) = (u32x4){w[0], w[1], w[2], w[3]};
      }
    }
    float best[16];
#define CAND(i, j) __uint_as_float((__float_as_uint(__uint_as_float(__float_as_uint(top[0][i]) & ~0x7Fu) + __uint_as_float(__float_as_uint(top[1][j]) & ~0x7Fu)) & ~0xFFu) | (unsigned)((i) * 16 + (j)))
    {
#pragma unroll
      for (int j = 0; j < 16; ++j) best[j] = CAND(0, j);
      float y[16];
#pragma unroll
      for (int j = 0; j < 8; ++j) { y[j] = CAND(1, j); y[8 + j] = CAND(15 - j, 0); }
#pragma unroll
      for (int jj = 8; jj > 0; jj >>= 1)
#pragma unroll
        for (int i = 0; i < 16; ++i) { const int q = i ^ jj; if (q > i) { const float hi_ = fmaxf(y[i], y[q]), lo_ = fminf(y[i], y[q]); y[i] = hi_; y[q] = lo_; } }
      bmerge16(best, y);
      float x[16];
      x[0] = CAND(2, 0); x[1] = CAND(2, 1); x[2] = CAND(2, 2); x[3] = CAND(2, 3); x[4] = CAND(2, 4);
      x[5] = CAND(3, 0); x[6] = CAND(3, 1); x[7] = CAND(3, 2); x[8] = CAND(3, 3);
      x[9] = CAND(4, 0); x[10] = CAND(4, 1); x[11] = CAND(4, 2);
      x[12] = CAND(5, 0); x[13] = CAND(5, 1); x[14] = CAND(6, 0); x[15] = CAND(6, 1);
      bsort16(x);
      bmerge16(best, x);
      ins16(best, CAND(7, 0)); ins16(best, CAND(7, 1));
    }
#undef CAND
    asm volatile("s_waitcnt lgkmcnt(0)" ::: "memory");
    if (hi == 0) {
      const unsigned char* ib = IDX + ((r32 * 8 + h) * 2) * 16;
      const float mx = __uint_as_float(__float_as_uint(best[0]) & ~0xFFu);
      float w[16]; float sum = 0.f;
#pragma unroll
      for (int k = 0; k < 16; ++k) { w[k] = __expf(__uint_as_float(__float_as_uint(best[k]) & ~0xFFu) - mx); sum += w[k]; }
      const float rsum = 1.f / sum;
      int ee[16]; float su_[16], sv_[16];
#pragma unroll
      for (int k = 0; k < 16; ++k) {
        const unsigned ij = __float_as_uint(best[k]) & 0xFFu;
        ee[k] = (int)ib[ij >> 4] * 128 + (int)ib[16 + (ij & 15)];
      }
#pragma unroll
      for (int k = 0; k < 16; ++k) { su_[k] = PSC[(size_t)l * NEXP + ee[k]]; sv_[k] = PSC[(size_t)(DEPTH + l) * NEXP + ee[k]]; }
#pragma unroll
      for (int k = 0; k < 16; ++k) {
        UE[r32 * 128 + h * 16 + k] = ee[k]; UG[r32 * 128 + h * 16 + k] = w[k] * rsum * sv_[k];
        US[r32 * 128 + h * 16 + k] = su_[k];
      }
    }
  }
  __syncthreads();
#pragma unroll 1
  for (int tt = 0; tt < 4; ++tt) {
    const int t = wid * 4 + tt;
    const int k0 = UE[t * 128 + lane], k1 = UE[t * 128 + 64 + lane];
    const float g0 = UG[t * 128 + lane], g1 = UG[t * 128 + 64 + lane], s0 = US[t * 128 + lane], s1 = US[t * 128 + 64 + lane];
    const int b0 = k0 >> 10, b1 = k1 >> 10;
    int base = 0, pos0 = 0, pos1 = 0;
#pragma unroll
    for (int b = 0; b < 16; ++b) {
      const unsigned long long m0 = __ballot(b0 == b), m1 = __ballot(b1 == b);
      const int c0 = __popcll(m0), c1 = __popcll(m1);
      const unsigned long long lt = (1ull << lane) - 1ull;
      if (b0 == b) pos0 = base + __popcll(m0 & lt);
      if (b1 == b) pos1 = base + c0 + __popcll(m1 & lt);
      base += c0 + c1;
    }
    const size_t ro = (size_t)(row0 + t) * 128;
    EIDG[ro + pos0] = k0; GWG[ro + pos0] = g0; SUG[ro + pos0] = s0;
    EIDG[ro + pos1] = k1; GWG[ro + pos1] = g1; SUG[ro + pos1] = s1;
  }
}
#define CAS __attribute__((address_space(4)))
typedef int i32x8 __attribute__((ext_vector_type(8)));
struct TokPref { f32x2 gs0, gs1; u32x4 hA, hB; };
struct RowPipe { i32x6 uq[4], vq[4]; i32x8 Ec; };
__device__ __forceinline__ const CAS i32x8* eid_row(const CAS unsigned char* eidg, int row) {
  return (const CAS i32x8*)(eidg + (size_t)(unsigned)__builtin_amdgcn_readfirstlane(row) * 512u);
}
__device__ __forceinline__ void tok_prefetch(const Params& p, int row, int lane, TokPref& t) {
  const float* GWG = (const float*)(p.ws + WS_ULOC + RT_STRIDE) + (size_t)row * 128;
  const float* SUG = (const float*)(p.ws + WS_ULOC + 2 * RT_STRIDE) + (size_t)row * 128;
  const bf16_t* H = (const bf16_t*)(p.ws + WS_H);
  t.gs0 = f32x2{GWG[lane], SUG[lane]}; t.gs1 = f32x2{GWG[64 + lane], SUG[64 + lane]};
  t.hA = *(const u32x4*)(H + (size_t)row * DM + lane * 16); t.hB = *(const u32x4*)(H + (size_t)row * DM + lane * 16 + 8);
}
#define LOADPAIR(dst_, tofs_, ea_, eb_) do { const u32x3v a_ = __builtin_amdgcn_raw_buffer_load_b96(rsT, lane12, (ea_) * PROW + (tofs_), 0); const unsigned b0_ = __builtin_amdgcn_raw_buffer_load_b32(rsT, lane12, (eb_) * PROW + (tofs_), 0); \
      const u32x2v b1_ = __builtin_amdgcn_raw_buffer_load_b64(rsT, lane12 + 4, (eb_) * PROW + (tofs_), 0); \
      dst_[0] = (int)a_.x; dst_[1] = (int)a_.y; dst_[2] = (int)a_.z; dst_[3] = (int)b0_; dst_[4] = (int)b1_.x; dst_[5] = (int)b1_.y; } while (0)
#define LOADGROUP(q_, tofs_, E_) do { LOADPAIR(q_[0], tofs_, E_[0], E_[1]); LOADPAIR(q_[1], tofs_, E_[2], E_[3]); LOADPAIR(q_[2], tofs_, E_[4], E_[5]); LOADPAIR(q_[3], tofs_, E_[6], E_[7]); } while (0)
constexpr int VOFS = (int)(WS_PV - WS_PU);
__device__ __forceinline__ void gather_token(const Params& p, const CAS unsigned char* eidg, const __amdgpu_buffer_rsrc_t rsT, int l, int row, int nextrow, TokPref& tp, RowPipe& rp, unsigned char* lds, int lane, int wid) {
  f32x2* GS = (f32x2*)(lds + wid * 2048);
  float* XC = (float*)(p.ws + WS_XCUR);
  const float* MOD = (const float*)(p.ws + WS_MOD);
  const CAS i32x8* EP = eid_row(eidg, row);
  const bool hasnext = nextrow >= 0;
  const CAS i32x8* EPn = eid_row(eidg, hasnext ? nextrow : row);
  GS[lane] = tp.gs0; GS[64 + lane] = tp.gs1;
  asm volatile("s_waitcnt lgkmcnt(0)" ::: "memory");
  const int eofl = ((lane >> 5) & 1) + 2 * ((lane >> 4) & 1) + 4 * ((lane >> 3) & 1);
  const int lane12 = lane * 12;
  {
    h16x2 hh[8];
    {
      const u32x4 hA = tp.hA, hB = tp.hB;
      hh[0] = __builtin_bit_cast(h16x2, __builtin_amdgcn_cvt_pkrtz(bflo(hA.x), bfhi(hA.x))); hh[1] = __builtin_bit_cast(h16x2, __builtin_amdgcn_cvt_pkrtz(bflo(hA.y), bfhi(hA.y))); hh[2] = __builtin_bit_cast(h16x2, __builtin_amdgcn_cvt_pkrtz(bflo(hA.z), bfhi(hA.z))); hh[3] = __builtin_bit_cast(h16x2, __builtin_amdgcn_cvt_pkrtz(bflo(hA.w), bfhi(hA.w)));
      hh[4] = __builtin_bit_cast(h16x2, __builtin_amdgcn_cvt_pkrtz(bflo(hB.x), bfhi(hB.x))); hh[5] = __builtin_bit_cast(h16x2, __builtin_amdgcn_cvt_pkrtz(bflo(hB.y), bfhi(hB.y))); hh[6] = __builtin_bit_cast(h16x2, __builtin_amdgcn_cvt_pkrtz(bflo(hB.z), bfhi(hB.z))); hh[7] = __builtin_bit_cast(h16x2, __builtin_amdgcn_cvt_pkrtz(bflo(hB.w), bfhi(hB.w)));
    }
    if (hasnext) tok_prefetch(p, nextrow, lane, tp);
    f32x4 xpre[4];
    { const float* xr_ = XC + (size_t)row * DM + lane * 16;
#pragma unroll
      for (int v4 = 0; v4 < 4; ++v4) xpre[v4] = *(const f32x4*)(xr_ + v4 * 4); }
    f32x2 acc2[8];
#pragma unroll
    for (int i = 0; i < 8; ++i) acc2[i] = f32x2{0.f, 0.f};
#pragma unroll 1
    for (int g8 = 0; g8 < 16; ++g8) {
      const bool pf = (g8 < 15) || hasnext;
      const f32x2 gs = GS[g8 * 8 + eofl];
      float d[8];
#pragma unroll
      for (int i2 = 0; i2 < 4; ++i2) {
        const h16x32 r = __builtin_amdgcn_cvt_scalef32_pk32_f16_fp6(rp.uq[i2], 1.0f);
        float a0 = 0.f, a1 = 0.f, b0 = 0.f, b1 = 0.f;
#define UDOT(k_) a0 = __builtin_amdgcn_fdot2(__builtin_shufflevector(r, r, 4 * (k_), 4 * (k_) + 1), hh[2 * (k_)], a0, false); b0 = __builtin_amdgcn_fdot2(__builtin_shufflevector(r, r, 16 + 4 * (k_), 17 + 4 * (k_)), hh[2 * (k_)], b0, false); \
        a1 = __builtin_amdgcn_fdot2(__builtin_shufflevector(r, r, 4 * (k_) + 2, 4 * (k_) + 3), hh[2 * (k_) + 1], a1, false); b1 = __builtin_amdgcn_fdot2(__builtin_shufflevector(r, r, 18 + 4 * (k_), 19 + 4 * (k_)), hh[2 * (k_) + 1], b1, false);
        UDOT(0) UDOT(1) UDOT(2) UDOT(3)
#undef UDOT
        d[2 * i2] = a0 + a1;
        d[2 * i2 + 1] = b0 + b1;
        asm volatile("" : "+v"(d[2 * i2]), "+v"(d[2 * i2 + 1]));
      }
      if (pf) LOADGROUP(rp.uq, 0, rp.Ec);
      float tot;
      {
        auto s01 = __builtin_amdgcn_permlane32_swap(__float_as_uint(d[0]), __float_as_uint(d[1]), false, false);
        auto s23 = __builtin_amdgcn_permlane32_swap(__float_as_uint(d[2]), __float_as_uint(d[3]), false, false);
        auto s45 = __builtin_amdgcn_permlane32_swap(__float_as_uint(d[4]), __float_as_uint(d[5]), false, false);
        auto s67 = __builtin_amdgcn_permlane32_swap(__float_as_uint(d[6]), __float_as_uint(d[7]), false, false);
        const float q01 = __uint_as_float(s01[0]) + __uint_as_float(s01[1]), q23 = __uint_as_float(s23[0]) + __uint_as_float(s23[1]);
        const float q45 = __uint_as_float(s45[0]) + __uint_as_float(s45[1]), q67 = __uint_as_float(s67[0]) + __uint_as_float(s67[1]);
        auto ta = __builtin_amdgcn_permlane16_swap(__float_as_uint(q01), __float_as_uint(q23), false, false);
        auto tb = __builtin_amdgcn_permlane16_swap(__float_as_uint(q45), __float_as_uint(q67), false, false);
        const float r0123 = __uint_as_float(ta[0]) + __uint_as_float(ta[1]);
        const float r4567 = __uint_as_float(tb[0]) + __uint_as_float(tb[1]);
        const bool b3 = (lane & 8) != 0;
        const float keep = b3 ? r4567 : r0123, send = b3 ? r0123 : r4567;
        float x = keep + dpp_mov<0x140>(send);
        x += dpp_mov<0xB1>(x); x += dpp_mov<0x4E>(x); x += dpp_mov<0x141>(x);
        tot = x * gs.y;
      }
      float ge;
      {
        const float v = tot, av = fabsf(v), tq = __builtin_amdgcn_rcpf(av * 0.2316418882f + 1.0f);
        float q = tq * 0.5307027145f + (-0.7265760135f); q = q * tq + 0.7107068705f; q = q * tq + (-0.142248368f); q = q * tq + 0.127414796f; q = q * tq;
        const float ex = __builtin_amdgcn_exp2f(v * v * (-0.72134752044f));
        const float m = v * (q * ex), r = v - m;
        ge = (v < 0.f ? m : r) * gs.x;
      }
      unsigned cw[8];
      { const unsigned gp = __builtin_bit_cast(unsigned, __builtin_amdgcn_cvt_pkrtz(ge * 1024.f, ge * 1024.f));
        cw[0] = (unsigned)__builtin_amdgcn_readlane((int)gp, 0);  cw[4] = (unsigned)__builtin_amdgcn_readlane((int)gp, 8);
        cw[2] = (unsigned)__builtin_amdgcn_readlane((int)gp, 16); cw[6] = (unsigned)__builtin_amdgcn_readlane((int)gp, 24);
        cw[1] = (unsigned)__builtin_amdgcn_readlane((int)gp, 32); cw[5] = (unsigned)__builtin_amdgcn_readlane((int)gp, 40);
        cw[3] = (unsigned)__builtin_amdgcn_readlane((int)gp, 48); cw[7] = (unsigned)__builtin_amdgcn_readlane((int)gp, 56); }
      h16x2 a16[8];
#pragma unroll
      for (int i2 = 0; i2 < 4; ++i2) {
        const h16x32 r = __builtin_amdgcn_cvt_scalef32_pk32_f16_fp6(rp.vq[i2], 1.0f);
        const h16x2 ca = __builtin_bit_cast(h16x2, cw[2 * i2]), cb = __builtin_bit_cast(h16x2, cw[2 * i2 + 1]);
#define VAXL(k_) a16[k_] = (i2 == 0) ? ca * __builtin_shufflevector(r, r, 2 * (k_), 2 * (k_) + 1) : ca * __builtin_shufflevector(r, r, 2 * (k_), 2 * (k_) + 1) + a16[k_];
#define VAXH(k_) a16[k_] = cb * __builtin_shufflevector(r, r, 16 + 2 * (k_), 17 + 2 * (k_)) + a16[k_];
        VAXL(0) VAXL(1) VAXL(2) VAXL(3) VAXL(4) VAXL(5) VAXL(6) VAXL(7)
        asm volatile("" : "+v"(a16[0]), "+v"(a16[1]), "+v"(a16[2]), "+v"(a16[3]), "+v"(a16[4]), "+v"(a16[5]), "+v"(a16[6]), "+v"(a16[7]));
        VAXH(0) VAXH(1) VAXH(2) VAXH(3) VAXH(4) VAXH(5) VAXH(6) VAXH(7)
#undef VAXL
#undef VAXH
        asm volatile("" : "+v"(a16[0]), "+v"(a16[1]), "+v"(a16[2]), "+v"(a16[3]), "+v"(a16[4]), "+v"(a16[5]), "+v"(a16[6]), "+v"(a16[7]));
      }
#pragma unroll
      for (int k = 0; k < 8; ++k) acc2[k] = f32x2{(float)a16[k].x, (float)a16[k].y} * f32x2{1.f / 1024.f, 1.f / 1024.f} + acc2[k];
      if (pf) LOADGROUP(rp.vq, VOFS, rp.Ec);
      { const CAS i32x8* src_ = g8 < 14 ? EP + (g8 + 2) : EPn + (g8 - 14); rp.Ec = *src_; }
    }
    SBAR();
    float acc[16];
#pragma unroll
    for (int i = 0; i < 8; ++i) { acc[2 * i] = acc2[i].x; acc[2 * i + 1] = acc2[i].y; }
    const int mr = mod_row(row);
    const float* g2 = MOD + ((size_t)l * 5 + mr) * 6144 + 5 * 1024;
    float* xr = XC + (size_t)row * DM;
    float xn[16]; float ssq = 0.f;
    if (ABL & 8) {
#pragma unroll
      for (int i = 0; i < 16; ++i) acc[i] = 0.f;
    }
#pragma unroll
    for (int v4 = 0; v4 < 4; ++v4) {
      const int c = lane * 16 + v4 * 4;
      const f32x4 xo = xpre[v4], gg = *(const f32x4*)(g2 + c);
      f32x4 o;
      o.x = xo.x + gg.x * acc[v4 * 4 + 0]; o.y = xo.y + gg.y * acc[v4 * 4 + 1]; o.z = xo.z + gg.z * acc[v4 * 4 + 2]; o.w = xo.w + gg.w * acc[v4 * 4 + 3];
      xn[v4 * 4 + 0] = o.x; xn[v4 * 4 + 1] = o.y; xn[v4 * 4 + 2] = o.z; xn[v4 * 4 + 3] = o.w;
      ssq += (o.x * o.x + o.y * o.y) + (o.z * o.z + o.w * o.w);
      if (l < DEPTH - 1) *(f32x4*)(xr + c) = o;
    }
    const float rs = rsqrtf(wave_sum_fast(ssq) * (1.f / DM) + EPS);
    if (l == DEPTH - 1) {
      const int b = row / SEGL, s = row - b * SEGL;
      float* orow = p.out + ((size_t)(b * SEQ + (s - CTXL))) * DM;
      const float* fg = p.in[I_FINALG];
#pragma unroll
      for (int v4 = 0; v4 < 4; ++v4) {
        const int c = lane * 16 + v4 * 4;
        const f32x4 gg = *(const f32x4*)(fg + c);
        f32x4 o; o.x = xn[v4 * 4 + 0] * rs * gg.x; o.y = xn[v4 * 4 + 1] * rs * gg.y; o.z = xn[v4 * 4 + 2] * rs * gg.z; o.w = xn[v4 * 4 + 3] * rs * gg.w;
        *(f32x4*)(orow + c) = o;
      }
    } else {
      const float* m = MOD + ((size_t)(l + 1) * 5 + mr) * 6144;
      const float* ng = p.in[I_N1G] + (l + 1) * DM;
      bf16_t* hrow = (bf16_t*)(p.ws + WS_H) + (size_t)row * DM;
#pragma unroll
      for (int hh = 0; hh < 2; ++hh) {
        float y[8];
#pragma unroll
        for (int i = 0; i < 8; ++i) { const int c = lane * 16 + hh * 8 + i; y[i] = xn[hh * 8 + i] * rs * ng[c] * (1.f + m[1024 + c]) + m[c]; }
        u32x4 w; w.x = cvtpk(y[0], y[1]); w.y = cvtpk(y[2], y[3]); w.z = cvtpk(y[4], y[5]); w.w = cvtpk(y[6], y[7]);
        *(u32x4*)(hrow + lane * 16 + hh * 8) = w;
      }
    }
  }
}

__device__ __forceinline__ void phase_c1(const Params& p, int l, unsigned char* lds) {
  constexpr int NLOC = NBATCH * 4 * NCH, NCONV = T / 32;
  for (int u = p.bx; u < NLOC + NCONV; u += p.gx) {
    if (u < NLOC) ml_local_unit2(p, l, u, lds);
    else {
      const int cu = u - NLOC;
      if (l == DEPTH - 1 && (cu % (SEGL / 32)) < (CTXL / 32)) continue;
      conv_unit(p, l, cu, lds);
    }
  }
}
__device__ __forceinline__ void phase_c2(const Params& p, int l, unsigned char* lds) {
  ml_scan(p, lds);
  const float* lp = p.in[I_DLAM] + l * 256;
  float s01 = 0.f, s23 = 0.f;
  for (int i = 0; i < 64; ++i) { s01 += lp[i] * lp[64 + i]; s23 += lp[128 + i] * lp[192 + i]; }
  const float lam_init = 0.8f - 0.6f * expf(-0.3f * (float)l);
  const float lam = expf(s01) - expf(s23) + lam_init;
  const bf16_t* PROJ = (const bf16_t*)(p.ws + WS_PROJ);
  bf16_t* MIX = (bf16_t*)(p.ws + WS_MIX);
  const float* ng = p.in[I_DNORMG] + l * 128;
  const int nun = 512 + (l < DEPTH - 1 ? 16 : 0);
  for (int u = p.bx; u < nun; u += p.gx) {
    int bh, qrow, nkeys;
    if (u < 512) { const int xcd = u & 7, i = (u >> 3) & 31, rnd = u >> 8; bh = 2 * xcd + rnd; qrow = CTXL + i * 256; nkeys = SEGL; }
    else { bh = u - 512; qrow = 0; nkeys = CTXL; }
    const int b = bh >> 2, h = bh & 3;
    const size_t tok0 = (size_t)b * SEGL;
    for (int rep = 0; rep < REP_ATT; ++rep)
    att_unit(PROJ + (tok0 + qrow) * PW + C_DQ + h * 128, PROJ + tok0 * PW + C_DK + h * 128, p.ws + WS_V8T + (size_t)bh * NCH * ATT_SHM_V,
             MIX + (tok0 + qrow) * DM + 512 + h * 128, nkeys, lam, ng, 1.f - lam_init, lds);
  }
}
__device__ __forceinline__ void phase_c3(const Params& p, int l, unsigned char* lds) {
  constexpr int NU = NBATCH * 4 * NCH;
  for (int u = p.bx; u < NU; u += p.gx) {
    if (l == DEPTH - 1 && (u % NCH) < 4) continue;
    ml_out_unit2(p, l, u, lds);
  }
}
__device__ __forceinline__ void phase_route(const Params& p, int l, unsigned char* lds) {
  constexpr int NU = T / 32;
  for (int u = p.bx; u < NU; u += p.gx) {
    if (l == DEPTH - 1 && (u % (SEGL / 32)) < (CTXL / 32)) continue;
    route_unit(p, l, u, lds);
    __syncthreads();
  }
}
__device__ __forceinline__ void phase_gather(const Params& p, int l, unsigned char* lds) {
  int tid_ = tidx(); asm volatile("" : "+v"(tid_)); const int lane = tid_ & 63, wid = __builtin_amdgcn_readfirstlane(tid_ >> 6);
  const int gw = p.bx * 8 + wid, NGW = p.gx * 8;
  const int ntok = (l == DEPTH - 1) ? NBATCH * SEQ : T;
#define TOKROW(ti_) ((l == DEPTH - 1) ? ((ti_) / SEQ) * SEGL + CTXL + ((ti_) % SEQ) : (ti_))
  const CAS unsigned char* eidg = (const CAS unsigned char*)(p.ws + WS_EID + (size_t)l * RT_STRIDE);
  const __amdgpu_buffer_rsrc_t rsT = __builtin_amdgcn_make_buffer_rsrc((void*)(p.ws + WS_PU + (size_t)l * NEXP * PROW), 0, VOFS + NEXP * PROW, 0x00020000);
  TokPref tp; RowPipe rp;
  if (gw < ntok) {
    const int row0 = TOKROW(gw); const int lane12 = lane * 12;
    tok_prefetch(p, row0, lane, tp);
    const CAS i32x8* EP0 = eid_row(eidg, row0);
    rp.Ec = EP0[0];
    LOADGROUP(rp.uq, 0, rp.Ec); LOADGROUP(rp.vq, VOFS, rp.Ec);
    rp.Ec = EP0[1];
  }
  XcdBarrier xb; xb.bar = p.xbar_words; xb.x = p.xbar_x; xb.st = (volatile LAS unsigned*)((LAS unsigned char*)lds + p.lds_st_off);
  const int nrounds = (ntok + NGW - 1) / NGW;
  for (int r = 0; r < nrounds; ++r) {
    const int ti = gw + r * NGW;
    if (ti < ntok) {
      const int row = TOKROW(ti);
      const int nxt = ti + NGW < ntok ? TOKROW(ti + NGW) : -1;
      gather_token(p, eidg, rsT, l, row, nxt, tp, rp, lds, lane, wid);
    }
#if GATHER_SYNC
    if (r + 1 < nrounds) { XcdBarrier xb2 = xb; size_t zb_ = 0; asm volatile("" : "+s"(zb_)); xb2.bar = xb.bar + zb_; xb2.x = xb.x + (unsigned)zb_; xcd_barrier(xb2); }
#endif
  }
#undef TOKROW
}

__global__ void __launch_bounds__(512, 2) mk_fwd(KArgs ka) {
  cg::grid_group grid = cg::this_grid();
  extern __shared__ __attribute__((aligned(16))) unsigned char lds[];
  const int lo = ka.ph_lo, hi = ka.ph_hi;
#define IN(k) (lo <= (k) && (k) < hi)
#ifndef PHASEMASK
#define PHASEMASK 0xFFFF
#endif
#define PH(i) ((PHASEMASK >> (i)) & 1)
#define MKP(q) Params q; { size_t z_ = 0; asm volatile("" : "+s"(z_)); \
    q.in = (InTab)((const __attribute__((address_space(4))) char*)__builtin_amdgcn_kernarg_segment_ptr() + z_); \
    q.out = ka.out + z_; q.ws = ka.ws + z_; q.ph_lo = lo; q.ph_hi = hi; q.bx = (int)blockIdx.x + (int)z_; q.gx = (int)gridDim.x + (int)z_; q.xbar_words = xbar.bar + z_; q.xbar_x = xbar.x + (unsigned)z_; q.lds_st_off = (unsigned)(LDS_BYTES - 64); }
#define SEAM(k) do { if (IN(k) && IN((k) + 1)) { if ((k) == 0) grid.sync(); else { XcdBarrier xb_ = xbar; size_t zb_ = 0; asm volatile("" : "+s"(zb_)); xb_.bar = xbar.bar + zb_; xb_.x = xbar.x + (unsigned)zb_; xcd_barrier(xb_); } } } while (0)
  volatile LAS unsigned* xst = (volatile LAS unsigned*)((LAS unsigned char*)lds + (LDS_BYTES - 64));
  { const int t0_ = threadIdx.x;
    if (t0_ < 2) xst[t0_] = 0u;
    if ((t0_ & 63) == 0) *(volatile LAS int*)((LAS unsigned char*)lds + LDS_WTAB + 4 * hw_wave_key()) = t0_ >> 6; }
  __syncthreads();
  XcdBarrier xbar = xcd_barrier_post((unsigned*)(ka.ws + WS_CTL) + 4096, xst);
  { MKP(p)
    if (PH(0) && IN(0)) for (int rep = 0; rep < REP_MISC; ++rep) { p0_mod(p, lds, (float*)(p.ws + WS_MOD)); p0_convert(p, lds); }
  }
  SEAM(0);
  { MKP(p)
    if (PH(1) && IN(1)) phase_norm(p, 0, 0, true, false);
  }
  SEAM(1);
#define LAYER(LL) { \
    int l = (LL); asm volatile("" : "+s"(l)); \
    const int b = 2 + 9 * (LL); \
    { MKP(q) if (PH(2) && IN(b + 0)) for (int rep = 0; rep < REP_GEMM; ++rep) phase_inproj2(q, l, lds); } \
    SEAM(b + 0); \
    { MKP(q) if (PH(3) && IN(b + 1)) for (int rep = 0; rep < REP_ML; ++rep) phase_c1(q, l, lds); } \
    SEAM(b + 1); \
    { MKP(q) if (PH(4) && IN(b + 2)) phase_c2(q, l, lds); } \
    SEAM(b + 2); \
    { MKP(q) if (PH(5) && IN(b + 3)) for (int rep = 0; rep < REP_ML; ++rep) phase_c3(q, l, lds); } \
    SEAM(b + 3); \
    { MKP(q) if (PH(6) && IN(b + 4)) phase_outproj2(q, l, lds); } \
    SEAM(b + 4); \
    { MKP(q) if (PH(7) && IN(b + 5)) for (int rep = 0; rep < REP_MISC; ++rep) phase_norm(q, l, 1, false, (LL) == DEPTH - 1); } \
    SEAM(b + 5); \
    { MKP(q) if (PH(8) && IN(b + 6)) for (int rep = 0; rep < REP_GEMM; ++rep) phase_peerq2(q, l, lds); } \
    SEAM(b + 6); \
    { MKP(q) if (PH(9) && IN(b + 7)) phase_route(q, l, lds); } \
    SEAM(b + 7); \
    { MKP(q) if (PH(9) && IN(b + 8)) phase_gather(q, l, lds); } \
    SEAM(b + 8); }
  LAYER(0) LAYER(1) LAYER(2) LAYER(3)
#undef LAYER
#undef IN
#undef SEAM
#undef MKP
}

extern "C" void kernel_launch(void* const* d_in, const int* in_sizes, int n_in, void* d_out, int out_size,
                              void* d_ws, size_t ws_size, hipStream_t stream) {
  static int grid = 0;
  if (grid == 0) {
    int dev = 0, cus = 0, per_cu = 0;
    (void)hipGetDevice(&dev);
    (void)hipDeviceGetAttribute(&cus, hipDeviceAttributeMultiprocessorCount, dev);
    (void)hipFuncSetAttribute((const void*)mk_fwd, hipFuncAttributeMaxDynamicSharedMemorySize, LDS_BYTES);
    (void)hipOccupancyMaxActiveBlocksPerMultiprocessor(&per_cu, (const void*)mk_fwd, 512, LDS_BYTES);
    fprintf(stderr, "kernel_launch: cus %d per_cu %d ws %zu (need %zu) n_in %d\n", cus, per_cu, ws_size, (size_t)WS_END, n_in);
    if (ws_size < WS_END || n_in != 23 || per_cu < 1) { fprintf(stderr, "kernel_launch: bad configuration, nothing launched\n"); grid = -1; return; }
    grid = cus;
  }
  if (grid < 0) return;
  (void)hipMemsetAsync((char*)d_ws + WS_CTL, 0, 65536, stream);
  KArgs p{};
  for (int i = 0; i < 23; ++i) p.in[i] = (const float*)d_in[i];
  p.out = (float*)d_out; p.ws = (unsigned char*)d_ws; p.ph_lo = 0; p.ph_hi = 38;
  void* args[] = {&p};
  hipError_t e = hipLaunchCooperativeKernel((const void*)mk_fwd, dim3(grid), dim3(512), args, LDS_BYTES, stream);
  if (e != hipSuccess) fprintf(stderr, "cooperative launch failed: %s (grid %d)\n", hipGetErrorString(e), grid);
}
```

```cpp
#include <hip/hip_runtime.h>
#include <hip/hip_cooperative_groups.h>
#include <cstdio>
#include <cstdint>
namespace cg = cooperative_groups;

constexpr int DM = 1024, NBATCH = 4, SEQ = 8192, CTXL = 256, SEGL = CTXL + SEQ, T = NBATCH * SEGL, DEPTH = 4;
constexpr int IN_W = 3088, PW = 3072;
constexpr int C_A = 0, C_MQ = 512, C_MK = 768, C_MV = 1024, C_MO = 1280, C_DQ = 1536, C_DK = 2048, C_DV = 2560;
constexpr int NCH = SEGL / 64;
constexpr int NEXP = 16384;
constexpr float EPS = 1e-6f;
#ifndef ABL
#define ABL 0
#endif
#ifndef GATHER_SYNC
#define GATHER_SYNC 0
#endif
#ifndef REP_ATT
#define REP_ATT 1
#endif
#ifndef GP_MASK
#define GP_MASK 0x3FFF
#endif
#ifndef REP_PEER
#define REP_PEER 1
#endif
#ifndef REP_GEMM
#define REP_GEMM 1
#endif
#ifndef REP_ROUTE
#define REP_ROUTE 1
#endif
#ifndef REP_OUTP
#define REP_OUTP 1
#endif
#ifndef REP_ML
#define REP_ML 1
#endif
#ifndef REP_MISC
#define REP_MISC 1
#endif
constexpr float QSCALE = 0.125f * 1.4426950408889634f;

constexpr size_t MiB = 1u << 20;
constexpr size_t WS_CTL = 0, WS_MOD = 1 * MiB, WS_ROPE = 2 * MiB, WS_WG = 4 * MiB, WS_KEYS = 5 * MiB, WS_MLMETA = 6 * MiB,
                 WS_GATES = 7 * MiB, WS_WIN = 10 * MiB, WS_WOUT = 34 * MiB, WS_WQ = 42 * MiB, WS_PU = 50 * MiB, WS_PV = 114 * MiB, WS_PSC = 178 * MiB  ,
                 WS_XCUR = 306 * MiB, WS_H = 438 * MiB, WS_MIX = 504 * MiB, WS_PROJ = 570 * MiB, WS_ULOC = 768 * MiB, WS_V8T = 836 * MiB  , WS_EID = 858 * MiB  , WS_END = 924 * MiB;
constexpr int USTRIDE = 4160;

constexpr int LDS_BYTES = 139264 + 512;
constexpr int LDS_WTAB = LDS_BYTES - 64 - 256;

#define LAS __attribute__((address_space(3)))
__device__ __forceinline__ int hw_wave_key() { return (int)(__builtin_amdgcn_s_getreg((5 << 11) | 4) & 63u); }
__device__ __forceinline__ int tidx() {
  extern __shared__ __attribute__((aligned(16))) unsigned char lds_dyn_[];
  const int w = __builtin_amdgcn_readfirstlane(*(const volatile LAS int*)((LAS unsigned char*)lds_dyn_ + LDS_WTAB + 4 * hw_wave_key()));
  unsigned z_ = 0u; asm volatile("" : "+v"(z_));
  return (w << 6) | (int)__builtin_amdgcn_mbcnt_hi(~0u, __builtin_amdgcn_mbcnt_lo(~0u, z_));
}
typedef unsigned short bf16_t;
typedef short bf16x8 __attribute__((ext_vector_type(8)));
typedef short s16x4 __attribute__((ext_vector_type(4)));
typedef float f32x4 __attribute__((ext_vector_type(4)));
typedef float f32x16 __attribute__((ext_vector_type(16)));
typedef unsigned u32x4 __attribute__((ext_vector_type(4)));
typedef unsigned u32x2 __attribute__((ext_vector_type(2)));
typedef __bf16 bf16x2v __attribute__((ext_vector_type(2)));
typedef int i32x8 __attribute__((ext_vector_type(8)));
typedef int i32x6 __attribute__((ext_vector_type(6)));
struct __attribute__((aligned(4))) u32x3 { unsigned x, y, z; };
typedef float f32x32 __attribute__((ext_vector_type(32)));
constexpr int PROW = 768;
typedef float f32x2 __attribute__((ext_vector_type(2)));
typedef _Float16 h16x2 __attribute__((ext_vector_type(2)));
typedef _Float16 h16x32 __attribute__((ext_vector_type(32)));
typedef unsigned u32x3v __attribute__((ext_vector_type(3)));
typedef unsigned u32x2v __attribute__((ext_vector_type(2)));

struct KArgs {
  const float* in[23];
  float* out;
  unsigned char* ws;
  int ph_lo, ph_hi;
};
typedef const float* const __attribute__((address_space(4))) * InTab;
struct Params {
  InTab in;
  float* out;
  unsigned char* ws;
  int ph_lo, ph_hi;
  int bx, gx;
  unsigned* xbar_words; unsigned xbar_x; unsigned lds_st_off;
};
enum { I_X = 0, I_C, I_CTX, I_CCTX, I_ADAW, I_ADAB, I_N1G, I_N2G, I_WIN, I_CONVW, I_CONVB, I_CLNG, I_CLNB, I_GATEB, I_MNORMG, I_DLAM, I_DNORMG,
       I_WOUT, I_PWQ, I_PKEYS, I_PU, I_PV, I_FINALG };

__device__ __forceinline__ unsigned cvtpk(float lo, float hi) { unsigned r; asm volatile("v_cvt_pk_bf16_f32 %0, %1, %2" : "=v"(r) : "v"(lo), "v"(hi)); return r; }
__device__ __forceinline__ float bflo(unsigned u) { return __uint_as_float(u << 16); }
__device__ __forceinline__ float bfhi(unsigned u) { return __uint_as_float(u & 0xffff0000u); }
__device__ __forceinline__ float bf1(bf16_t u) { return __uint_as_float(((unsigned)u) << 16); }
__device__ __forceinline__ int crow(int r, int hi) { return (r & 3) + 8 * (r >> 2) + 4 * hi; }
template <int CTRL> __device__ __forceinline__ float dpp_mov(float v) {
  return __uint_as_float((unsigned)__builtin_amdgcn_update_dpp(0, (int)__float_as_uint(v), CTRL, 0xF, 0xF, true));
}
__device__ __forceinline__ float wave_sum_fast(float x) {
  x += dpp_mov<0xB1>(x); x += dpp_mov<0x4E>(x); x += dpp_mov<0x141>(x); x += dpp_mov<0x140>(x);
  { auto r = __builtin_amdgcn_permlane16_swap(__float_as_uint(x), __float_as_uint(x), false, false); x = __uint_as_float(r[0]) + __uint_as_float(r[1]); }
  { auto r = __builtin_amdgcn_permlane32_swap(__float_as_uint(x), __float_as_uint(x), false, false); x = __uint_as_float(r[0]) + __uint_as_float(r[1]); }
  return x;
}
__device__ __forceinline__ float wave_max_fast(float x) {
  x = fmaxf(x, dpp_mov<0xB1>(x)); x = fmaxf(x, dpp_mov<0x4E>(x)); x = fmaxf(x, dpp_mov<0x141>(x)); x = fmaxf(x, dpp_mov<0x140>(x));
  { auto r = __builtin_amdgcn_permlane16_swap(__float_as_uint(x), __float_as_uint(x), false, false); x = fmaxf(__uint_as_float(r[0]), __uint_as_float(r[1])); }
  { auto r = __builtin_amdgcn_permlane32_swap(__float_as_uint(x), __float_as_uint(x), false, false); x = fmaxf(__uint_as_float(r[0]), __uint_as_float(r[1])); }
  return x;
}
template <int CTRL, int ROWMASK> __device__ __forceinline__ float dpp_mov_rm(float v) {
  return __uint_as_float((unsigned)__builtin_amdgcn_update_dpp(0, (int)__float_as_uint(v), CTRL, ROWMASK, 0xF, true));
}
__device__ __forceinline__ float wave_incl_scan(float x) {
  x += dpp_mov<0x111>(x); x += dpp_mov<0x112>(x); x += dpp_mov<0x114>(x); x += dpp_mov<0x118>(x);
  x += dpp_mov_rm<0x142, 0xA>(x);
  x += dpp_mov_rm<0x143, 0xC>(x);
  return x;
}
__device__ __forceinline__ float wave_sum(float v) { return wave_sum_fast(v); }
__device__ __forceinline__ float sum_xor32(float x) { auto r = __builtin_amdgcn_permlane32_swap(__float_as_uint(x), __float_as_uint(x), false, false); return __uint_as_float(r[0]) + __uint_as_float(r[1]); }
__device__ __forceinline__ float max_xor32(float x) { auto r = __builtin_amdgcn_permlane32_swap(__float_as_uint(x), __float_as_uint(x), false, false); return fmaxf(__uint_as_float(r[0]), __uint_as_float(r[1])); }
__device__ __forceinline__ float wave_max(float v) { return wave_max_fast(v); }
__device__ __forceinline__ float sigmoidf_(float x) { return 1.f / (1.f + __expf(-x)); }
__device__ __forceinline__ float logsigmoidf_(float x) { return fminf(x, 0.f) - log1pf(__expf(-fabsf(x))); }
__device__ __forceinline__ const float* in_row(const float* x, const float* ctx, int row) {
  const int b = row / SEGL, s = row - b * SEGL;
  return s < CTXL ? ctx + ((size_t)(b * CTXL + s)) * DM : x + ((size_t)(b * SEQ + (s - CTXL))) * DM;
}
__device__ __forceinline__ int mod_row(int row) { const int b = row / SEGL, s = row - b * SEGL; return s < CTXL ? 4 : b; }

__device__ __forceinline__ void p0_mod(const Params& p, unsigned char* lds, float* MOD) {
  float* sil = (float*)lds;
  float* red = (float*)(lds + 20480);
  int tid_ = tidx(); asm volatile("" : "+v"(tid_)); const int tid = tid_, lane = tid & 63, wid = tid >> 6;
  for (int i = tid; i < 5 * 1024; i += 512) {
    const float v = i < 4096 ? p.in[I_C][i] : p.in[I_CCTX][i - 4096];
    sil[i] = v / (1.f + __expf(-v));
  }
  __syncthreads();
  for (int item = p.bx; item < DEPTH * 96; item += p.gx) {
    const int l = item / 96, j0 = (item % 96) * 64;
    const float* W = p.in[I_ADAW] + (size_t)l * DM * 6144 + j0 + lane;
    float a0 = 0.f, a1 = 0.f, a2 = 0.f, a3 = 0.f, a4 = 0.f;
    const int k0 = wid * 128;
#pragma unroll 8
    for (int k = k0; k < k0 + 128; ++k) {
      const float w = W[(size_t)k * 6144];
      a0 += sil[k] * w; a1 += sil[1024 + k] * w; a2 += sil[2048 + k] * w; a3 += sil[3072 + k] * w; a4 += sil[4096 + k] * w;
    }
    red[(wid * 5 + 0) * 64 + lane] = a0; red[(wid * 5 + 1) * 64 + lane] = a1; red[(wid * 5 + 2) * 64 + lane] = a2;
    red[(wid * 5 + 3) * 64 + lane] = a3; red[(wid * 5 + 4) * 64 + lane] = a4;
    __syncthreads();
    if (tid < 320) {
      const int r = tid >> 6;
      float s = 0.f;
#pragma unroll
      for (int w = 0; w < 8; ++w) s += red[(w * 5 + r) * 64 + lane];
      MOD[((size_t)l * 5 + r) * 6144 + j0 + lane] = s + p.in[I_ADAB][l * 6144 + j0 + lane];
    }
    __syncthreads();
  }
}
__device__ __forceinline__ void transpose_item(const float* W, int ldw, int srccol0, bf16_t* WT, int K, int n0, int k0, float* scr, int lane) {
#pragma unroll 8
  for (int i = 0; i < 32; ++i) { const int kk = 2 * i + (lane >> 5); scr[kk * 33 + (lane & 31)] = W[(size_t)(k0 + kk) * ldw + srccol0 + (lane & 31)]; }
  asm volatile("s_waitcnt lgkmcnt(0)" ::: "memory");
  const int c = lane & 7;
#pragma unroll
  for (int j = 0; j < 4; ++j) {
    const int n = (lane >> 3) + 8 * j; const float* s = scr + (8 * c) * 33 + n;
    u32x4 o; o.x = cvtpk(s[0], s[33]); o.y = cvtpk(s[66], s[99]); o.z = cvtpk(s[132], s[165]); o.w = cvtpk(s[198], s[231]);
    *(u32x4*)(WT + (size_t)(n0 + n) * K + k0 + 8 * c) = o;
  }
  asm volatile("s_waitcnt lgkmcnt(0)" ::: "memory");
}
__device__ __forceinline__ void convert_tables(const Params& p, int L, int wv, int nw, int lane, int r_lo, int r_hi) {
  unsigned char* PUq = p.ws + WS_PU; unsigned char* PVq = p.ws + WS_PV; float* PSC = (float*)(p.ws + WS_PSC);
  const int nrows = DEPTH * NEXP;
#define TAB_SROW(r_) ((const f32x4*)(((r_) >= NEXP ? p.in[I_PV] : p.in[I_PU]) + (size_t)(L * NEXP + ((r_) >= NEXP ? (r_) - NEXP : (r_))) * DM) + lane * 4)
#define TAB_LOAD(v_, r_) do { if ((r_) < r_hi) { const f32x4* s_ = TAB_SROW(r_); _Pragma("unroll") for (int j = 0; j < 4; ++j) v_[j] = __builtin_nontemporal_load(s_ + j); } } while (0)
  auto encode_row = [&](const f32x4 (&v)[4], int r) {
    const int tb = r >= NEXP, rr = L * NEXP + (tb ? r - NEXP : r);
    float mx = 0.f;
#pragma unroll
    for (int j = 0; j < 4; ++j) mx = fmaxf(mx, fmaxf(fmaxf(fabsf(v[j].x), fabsf(v[j].y)), fmaxf(fabsf(v[j].z), fabsf(v[j].w))));
    mx = wave_max_fast(mx);
    const unsigned mb = __float_as_uint(mx);
    const int eb = (int)((mb >> 23) & 0xFFu);
    int sb = ((mb & 0x7FFFFFu) <= 0x700000u ? 129 : 128) - eb + 127; sb = sb < 1 ? 1 : (sb > 253 ? 253 : sb);
    const float sc = __uint_as_float((unsigned)sb << 23), isc = __uint_as_float((unsigned)(254 - sb) << 23);
    const float xv[16] = {v[0].x, v[0].y, v[0].z, v[0].w, v[1].x, v[1].y, v[1].z, v[1].w, v[2].x, v[2].y, v[2].z, v[2].w, v[3].x, v[3].y, v[3].z, v[3].w};
    unsigned wq[3] = {0u, 0u, 0u};
#pragma unroll
    for (int i = 0; i < 16; ++i) {
      const float a = fabsf(xv[i]) * sc;
      unsigned code = a < 2.f ? (unsigned)__builtin_rintf(a * 8.f) : (a < 4.f ? 8u + (unsigned)__builtin_rintf(a * 4.f) : 16u + (unsigned)__builtin_rintf(a * 2.f));
      code = code > 31u ? 31u : code;
      code |= (xv[i] < 0.f) ? 32u : 0u;
      const int bp = 6 * i, dw = bp >> 5, off = bp & 31;
      wq[dw] |= code << off;
      if (off > 26) wq[dw + 1] |= code >> (32 - off);
    }
    u32x3 o; o.x = wq[0]; o.y = wq[1]; o.z = wq[2];
    *(u32x3*)((tb ? PVq : PUq) + (size_t)rr * PROW + lane * 12) = o;
    if (lane == 0) PSC[(size_t)tb * nrows + rr] = isc;
  };
  f32x4 v0[4], v1[4], v2[4];
  TAB_LOAD(v0, r_lo + wv); TAB_LOAD(v1, r_lo + wv + nw);
#pragma unroll 1
  for (int r = r_lo + wv; r < r_hi; r += 3 * nw) {
    TAB_LOAD(v2, r + 2 * nw); encode_row(v0, r);
    if (r + nw < r_hi) { TAB_LOAD(v0, r + 3 * nw); encode_row(v1, r + nw); }
    if (r + 2 * nw < r_hi) { TAB_LOAD(v1, r + 4 * nw); encode_row(v2, r + 2 * nw); }
  }
#undef TAB_LOAD
#undef TAB_SROW
}
__device__ __forceinline__ void tail_filler_tables(const Params& p, int L, int nwg, int r_lo, int r_hi) {
  int tid_ = tidx(); asm volatile("" : "+v"(tid_)); const int lane = tid_ & 63, wid = tid_ >> 6;
  const int nextra = nwg % p.gx, first = nextra, nidle = p.gx - nextra;
  if (p.bx < first) return;
  convert_tables(p, L, (p.bx - first) * 8 + wid, nidle * 8, lane, r_lo, r_hi);
}
__device__ __forceinline__ void p0_convert(const Params& p, unsigned char* lds) {
  int tid_ = tidx(); asm volatile("" : "+v"(tid_)); const int tid = tid_, lane = tid & 63, wid = tid >> 6;
  const int gw = p.bx * 8 + wid, NGW = p.gx * 8;
  const size_t gt = (size_t)p.bx * 512 + tid, NGT = (size_t)p.gx * 512;
  float* scr = (float*)(lds + 32768) + wid * (64 * 33);
  bf16_t* WIN = (bf16_t*)(p.ws + WS_WIN); bf16_t* WOUT = (bf16_t*)(p.ws + WS_WOUT); bf16_t* WQ = (bf16_t*)(p.ws + WS_WQ);
  constexpr int I_IN = 16 * 96, I_O = 16 * 32, PER_L = I_IN + 2 * I_O;
  for (int it = gw; it < DEPTH * PER_L; it += NGW) {
    const int l = it / PER_L; int r = it % PER_L;
    if (r < I_IN) { const int kb = r / 96, nb = r % 96, n0 = nb * 32; const int src = n0 < 1536 ? n0 : n0 + 16;
      transpose_item(p.in[I_WIN] + (size_t)l * DM * IN_W, IN_W, src, WIN + (size_t)l * PW * DM, DM, n0, kb * 64, scr, lane); continue; }
    r -= I_IN;
    if (r < I_O) { const int kb = r / 32, nb = r % 32;
      transpose_item(p.in[I_WOUT] + (size_t)l * DM * DM, DM, nb * 32, WOUT + (size_t)l * DM * DM, DM, nb * 32, kb * 64, scr, lane); continue; }
    r -= I_O;
    { const int kb = r / 32, nb = r % 32;
      transpose_item(p.in[I_PWQ] + (size_t)l * DM * DM, DM, nb * 32, WQ + (size_t)l * DM * DM, DM, nb * 32, kb * 64, scr, lane); }
  }
  bf16_t* WG = (bf16_t*)(p.ws + WS_WG);
  for (size_t i = gt; i < (size_t)DEPTH * 16 * DM; i += NGT) {
    const int l = (int)(i / (16 * DM)), g = (int)((i / DM) % 16), k = (int)(i % DM);
    WG[i] = (bf16_t)(cvtpk(p.in[I_WIN][(size_t)l * DM * IN_W + (size_t)k * IN_W + 1536 + g], 0.f) & 0xffffu);
  }
  bf16_t* KEYS = (bf16_t*)(p.ws + WS_KEYS);
  for (size_t i = gt; i < (size_t)DEPTH * 131072 / 8; i += NGT) {
    const f32x4 a = ((const f32x4*)p.in[I_PKEYS])[2 * i], b = ((const f32x4*)p.in[I_PKEYS])[2 * i + 1];
    u32x4 o; o.x = cvtpk(a.x, a.y); o.y = cvtpk(a.z, a.w); o.z = cvtpk(b.x, b.y); o.w = cvtpk(b.z, b.w);
    ((u32x4*)KEYS)[i] = o;
  }
  {
    float* RC = (float*)(p.ws + WS_ROPE); float* RS = RC + SEQ * 32;
    for (size_t i = gt; i < (size_t)SEQ * 32; i += NGT) {
      const int pos = (int)(i >> 5), j = (int)(i & 31);
      const int rr = pos >> 6, cc = pos & 63;
      const int jj = j & 15;
      const double e = -(double)jj * 0.83048202372184058696;
      const double fl = __builtin_floor(e); const double f = e - fl;
      const double z = f * 0.69314718055994530942;
      double ez = 1.0 + z * (1.0 + z * (0.5 + z * (1.0 / 6 + z * (1.0 / 24 + z * (1.0 / 120 + z * (1.0 / 720 + z * (1.0 / 5040 + z * (1.0 / 40320 + z * (1.0 / 362880 + z * (1.0 / 3628800 + z * (1.0 / 39916800 + z * (1.0 / 479001600))))))))))));
      const double inv = __builtin_ldexp(ez, (int)fl);
      const float invf = (float)inv;
      const float angf = (float)(j < 16 ? rr : cc) * invf;
      const double ang = (double)angf;
      const double kq = __builtin_rint(ang * 0.63661977236758134308);
      double r = __builtin_fma(-kq, 1.57079632679489655800e+00, ang);
      r = __builtin_fma(-kq, 6.12323399573676603587e-17, r);
      const double r2 = r * r;
      const double sn = r * (1.0 + r2 * (-1.0 / 6 + r2 * (1.0 / 120 + r2 * (-1.0 / 5040 + r2 * (1.0 / 362880 + r2 * (-1.0 / 39916800 + r2 * (1.0 / 6227020800.0)))))));
      const double cs = 1.0 + r2 * (-0.5 + r2 * (1.0 / 24 + r2 * (-1.0 / 720 + r2 * (1.0 / 40320 + r2 * (-1.0 / 3628800 + r2 * (1.0 / 479001600 + r2 * (-1.0 / 87178291200.0)))))));
      const int q = ((int)kq) & 3;
      double co, si;
      if (q == 0) { co = cs; si = sn; } else if (q == 1) { co = -sn; si = cs; } else if (q == 2) { co = -cs; si = -sn; } else { co = sn; si = -cs; }
      RC[i] = (float)co; RS[i] = (float)si;
    }
  }
}

__device__ __forceinline__ void norm_mod_row(const float* xrow, const float* g, const float* sc, const float* sh, bf16_t* orow, int lane) {
  const f32x4* xr = (const f32x4*)xrow + lane;
  f32x4 v[4]; float s = 0.f;
#pragma unroll
  for (int j = 0; j < 4; ++j) { v[j] = xr[64 * j]; s += (v[j].x * v[j].x + v[j].y * v[j].y) + (v[j].z * v[j].z + v[j].w * v[j].w); }
  const float rs = rsqrtf(wave_sum(s) * (1.f / DM) + EPS);
  u32x2* o = (u32x2*)orow + lane;
#pragma unroll
  for (int j = 0; j < 4; ++j) {
    const f32x4 gg = ((const f32x4*)g)[lane + 64 * j], cc = ((const f32x4*)sc)[lane + 64 * j], hh = ((const f32x4*)sh)[lane + 64 * j];
    const float y0 = v[j].x * rs * gg.x * (1.f + cc.x) + hh.x, y1 = v[j].y * rs * gg.y * (1.f + cc.y) + hh.y;
    const float y2 = v[j].z * rs * gg.z * (1.f + cc.z) + hh.z, y3 = v[j].w * rs * gg.w * (1.f + cc.w) + hh.w;
    u32x2 w; w.x = cvtpk(y0, y1); w.y = cvtpk(y2, y3);
    o[64 * j] = w;
  }
}
__device__ __forceinline__ void phase_norm(const Params& p, int l, int which, bool from_input, bool skip_ctx) {
  int tid_ = tidx(); asm volatile("" : "+v"(tid_));
  const int lane = tid_ & 63, wid = tid_ >> 6;
  const int gw = p.bx * 8 + wid, NGW = p.gx * 8;
  const float* MOD = (const float*)(p.ws + WS_MOD);
  const float* XC = (const float*)(p.ws + WS_XCUR);
  bf16_t* H = (bf16_t*)(p.ws + WS_H);
  const float* g = p.in[which ? I_N2G : I_N1G] + l * DM;
  for (int row = gw; row < T; row += NGW) {
    const int mr = mod_row(row);
    if (skip_ctx && mr == 4) continue;
    const float* m = MOD + ((size_t)l * 5 + mr) * 6144 + which * 3072;
    const float* xr = from_input ? in_row(p.in[I_X], p.in[I_CTX], row) : XC + (size_t)row * DM;
    norm_mod_row(xr, g, m + 1024, m, H + (size_t)row * DM, lane);
  }
}

namespace pg8 {
#define PG8_LAS __attribute__((address_space(3)))
typedef unsigned short bf16_t;
typedef short bf16x8 __attribute__((ext_vector_type(8)));
typedef float f32x4 __attribute__((ext_vector_type(4)));
typedef unsigned u32x4 __attribute__((ext_vector_type(4)));
constexpr int BM = 256, BK = 64, HALF = 128, HTB = HALF * BK * 2  , STAGE_BYTES = 8 * HTB, NXCD = 8, WGM = 8;

__host__ __device__ __forceinline__ int lds_byte(int r, int c) { const int st = (r >> 4) * 2 + (c >> 5), rr = r & 15, cc = c & 31, ob = rr * 64 + cc * 2; return st * 1024 + (ob ^ (((ob >> 9) & 1) << 5)); }
__host__ __device__ __forceinline__ void stage_rc(int b, int& R, int& C) { const int st = b / 1024, sb = b % 1024, swz = sb ^ (((sb >> 9) & 1) << 5); R = (st >> 1) * 16 + swz / 64; C = (st & 1) * 32 + (swz % 64) / 2; }
__host__ __device__ __forceinline__ int perm32(int rho) { const int n = rho >> 4, i = rho & 15; return 8 * (i >> 2) + 4 * n + (i & 3); }

struct Unit { int pm, pn; };
struct Gemm { const bf16_t* A; const bf16_t* Bt; int M, N, K; };

struct StaticOrder {
    int nM, nN, nwg, G, c;
    __host__ __device__ void init(int M, int N, int G_, int c_) { nM = M / BM; nN = N / BM; nwg = nM * nN; G = G_; c = c_; }
    __host__ __device__ bool next(int i, Unit& u) const {
        const long L = (long)i * G + c; if (L >= nwg) return false;
        int wgid = (int)L; { const int q = nwg / NXCD, r = nwg % NXCD, xcd = wgid % NXCD, off = wgid / NXCD; wgid = (xcd < r ? xcd * (q + 1) : r * (q + 1) + (xcd - r) * q) + off; }
        const int nig = WGM * nN, gid = wgid / nig, fm = gid * WGM, gsz = (nM - fm) < WGM ? (nM - fm) : WGM;
        u.pm = fm + ((wgid % nig) % gsz); u.pn = (wgid % nig) / gsz; return true;
    }
    __device__ __forceinline__ void a_ready(const Unit&) const {}
    __device__ __forceinline__ void done(const Unit&) const {}
};
__device__ __forceinline__ unsigned cvt_pk_bf16(float lo, float hi) { unsigned r; asm volatile("v_cvt_pk_bf16_f32 %0, %1, %2" : "=v"(r) : "v"(lo), "v"(hi)); return r; }
template <class Epi, class Sched, bool ALIGN_EPI = false, bool SP2 = false>
__device__ __forceinline__ void gemm_phase(PG8_LAS unsigned char* lds, const Gemm g, const Sched& S, const Epi& E) {
    const int tid = tidx(), wid = __builtin_amdgcn_readfirstlane(tid >> 6), lane = tid & 63, wr = wid >> 2, wc = wid & 3, fr = lane & 15, fq = lane >> 4;
    const int K = g.K, nt = K / BK;
    unsigned voffA[2], voffB[2];
#pragma unroll
    for (int i = 0; i < 2; ++i) { int R, C; stage_rc(tid * 16 + i * 8192, R, C); const int Rb = Epi::PERM ? ((R & ~31) + perm32(R & 31)) : R;
        voffA[i] = (unsigned)(R * K + C) * 2u; voffB[i] = (unsigned)(Rb * K + C) * 2u; }
    const size_t kstep = (size_t)(BK * 2);
    const size_t hstep = (size_t)HALF * K * 2;
    const size_t tstep = 2 * hstep;
    const unsigned ldsw = (unsigned)wid * 1024u;
    const int aoff = lds_byte(wr * 64 + fr, fq * 8), boff = lds_byte(wc * 32 + fr, fq * 8);
#define PG8_SA(b, h) (((b) * 2 + (h)) * HTB)
#define PG8_SB(b, h) ((4 + (b) * 2 + (h)) * HTB)
#define PG8_STAGE(bufoff, gbase, voff) do { _Pragma("unroll") for (int _i = 0; _i < 2; ++_i) \
        __builtin_amdgcn_global_load_lds((const unsigned*)((const char*)(gbase) + (voff)[_i]), (PG8_LAS unsigned*)(lds + (bufoff) + ldsw + _i * 8192), 16, 0, 0); } while (0)
#define PG8_LDA(dst, b, h) do { _Pragma("unroll") for (int m = 0; m < 4; ++m) _Pragma("unroll") for (int k = 0; k < 2; ++k) dst[m][k] = *(const PG8_LAS bf16x8*)(lds + PG8_SA(b, h) + aoff + m * 2048 + k * 1024); } while (0)
#define PG8_LDB(dst, b, h) do { _Pragma("unroll") for (int n = 0; n < 2; ++n) _Pragma("unroll") for (int k = 0; k < 2; ++k) dst[n][k] = *(const PG8_LAS bf16x8*)(lds + PG8_SB(b, h) + boff + n * 2048 + k * 1024); } while (0)
#define PG8_MMA(ai, bj, At, Bt) do { __builtin_amdgcn_s_setprio(1); _Pragma("unroll") for (int m = 0; m < 4; ++m) _Pragma("unroll") for (int n = 0; n < 2; ++n) _Pragma("unroll") for (int k = 0; k < 2; ++k) \
        acc[ai][bj][m][n] = __builtin_amdgcn_mfma_f32_16x16x32_bf16(Bt[n][k], At[m][k], acc[ai][bj][m][n], 0, 0, 0); __builtin_amdgcn_s_setprio(0); } while (0)
#define PG8_WAIT_V(n) asm volatile("s_waitcnt vmcnt(" #n ")" ::: "memory")
#define PG8_WAIT_L(n) asm volatile("s_waitcnt lgkmcnt(" #n ")" ::: "memory")
#define PG8_BAR __builtin_amdgcn_s_barrier()
#define PG8_SCHED __builtin_amdgcn_sched_barrier(0)
    Unit cur, nxt; int ui = 0;
    if (!S.next(0, cur)) return;
    f32x4 acc[2][2][4][2];
#pragma unroll
    for (int a = 0; a < 2; ++a)
#pragma unroll
        for (int b = 0; b < 2; ++b)
#pragma unroll
            for (int m = 0; m < 4; ++m)
#pragma unroll
                for (int n = 0; n < 2; ++n) acc[a][b][m][n] = (f32x4){0.f, 0.f, 0.f, 0.f};
    bf16x8 At[4][2], B0[2][2], B1[2][2];
    const char* cA = (const char*)g.A + (size_t)cur.pm * tstep; const char* cB = (const char*)g.Bt + (size_t)cur.pn * tstep;
    S.a_ready(cur);
    if constexpr (SP2) {
        PG8_STAGE(PG8_SB(0, 0), cB, voffB); PG8_STAGE(PG8_SB(0, 1), cB + hstep, voffB); PG8_STAGE(PG8_SA(0, 0), cA, voffA); PG8_STAGE(PG8_SA(0, 1), cA + hstep, voffA);
        if (wr == 1) PG8_BAR;
        PG8_WAIT_V(2); PG8_BAR;
        PG8_STAGE(PG8_SB(1, 0), cB + kstep, voffB); PG8_STAGE(PG8_SA(1, 0), cA + kstep, voffA); PG8_STAGE(PG8_SB(1, 1), cB + hstep + kstep, voffB);
        PG8_WAIT_V(6); PG8_BAR;
    } else {
        PG8_STAGE(PG8_SB(0, 0), cB, voffB); PG8_STAGE(PG8_SA(0, 0), cA, voffA); PG8_STAGE(PG8_SB(0, 1), cB + hstep, voffB); PG8_STAGE(PG8_SA(0, 1), cA + hstep, voffA);
        if (wr == 1) PG8_BAR;
        PG8_WAIT_V(4); PG8_BAR;
        PG8_STAGE(PG8_SB(1, 0), cB + kstep, voffB); PG8_STAGE(PG8_SA(1, 0), cA + kstep, voffA); PG8_STAGE(PG8_SB(1, 1), cB + hstep + kstep, voffB);
        PG8_WAIT_V(6); PG8_BAR;
    }
    for (;;) {
        const bool has_next = S.next(ui + 1, nxt);
        const char* nA = has_next ? (const char*)g.A + (size_t)nxt.pm * tstep : cA; const char* nB = has_next ? (const char*)g.Bt + (size_t)nxt.pn * tstep : cB;
        for (int t = 0; t < nt; t += 2) {
            const bool last = (t == nt - 2);
            const char* a1 = cA + (size_t)(t + 1) * kstep;
            const char* a2 = last ? nA : cA + (size_t)(t + 2) * kstep; const char* b2 = last ? nB : cB + (size_t)(t + 2) * kstep;
            const char* a3 = a2 + kstep; const char* b3 = b2 + kstep;
            if (last && has_next) S.a_ready(nxt);
            if constexpr (SP2) {
            PG8_LDB(B0, 0, 0); PG8_LDB(B1, 0, 1); PG8_SCHED; PG8_LDA(At, 0, 0); PG8_STAGE(PG8_SA(1, 1), a1 + hstep, voffA);
            PG8_WAIT_V(8); PG8_WAIT_L(0); PG8_BAR; PG8_MMA(0, 0, At, B0); PG8_MMA(0, 1, At, B1); PG8_BAR; PG8_SCHED;
            PG8_LDA(At, 0, 1); PG8_STAGE(PG8_SB(0, 0), b2, voffB); PG8_STAGE(PG8_SB(0, 1), b2 + hstep, voffB); PG8_STAGE(PG8_SA(0, 0), a2, voffA);
            PG8_WAIT_V(8); PG8_WAIT_L(0); PG8_BAR; PG8_MMA(1, 0, At, B0); PG8_MMA(1, 1, At, B1); PG8_BAR; PG8_SCHED;
            PG8_LDB(B0, 1, 0); PG8_LDB(B1, 1, 1); PG8_SCHED; PG8_LDA(At, 1, 0); PG8_STAGE(PG8_SA(0, 1), a2 + hstep, voffA);
            PG8_WAIT_V(8); PG8_WAIT_L(0); PG8_BAR; PG8_MMA(0, 0, At, B0); PG8_MMA(0, 1, At, B1); PG8_BAR; PG8_SCHED;
            PG8_LDA(At, 1, 1); PG8_STAGE(PG8_SB(1, 0), b3, voffB); PG8_STAGE(PG8_SB(1, 1), b3 + hstep, voffB); PG8_STAGE(PG8_SA(1, 0), a3, voffA);
            PG8_WAIT_V(8); PG8_WAIT_L(0); PG8_BAR; PG8_MMA(1, 0, At, B0); PG8_MMA(1, 1, At, B1); PG8_BAR; PG8_SCHED;
            } else {
            PG8_LDB(B0, 0, 0); PG8_SCHED; PG8_LDA(At, 0, 0); PG8_STAGE(PG8_SA(1, 1), a1 + hstep, voffA);
            PG8_WAIT_L(8); PG8_BAR; PG8_WAIT_L(0); PG8_MMA(0, 0, At, B0); PG8_BAR; PG8_SCHED;
            PG8_LDB(B1, 0, 1); PG8_STAGE(PG8_SB(0, 0), b2, voffB);
            PG8_BAR; PG8_WAIT_L(0); PG8_MMA(0, 1, At, B1); PG8_BAR;
            PG8_LDA(At, 0, 1); PG8_STAGE(PG8_SA(0, 0), a2, voffA);
            PG8_BAR; PG8_WAIT_L(0); PG8_MMA(1, 0, At, B0); PG8_BAR; PG8_SCHED;
            PG8_STAGE(PG8_SB(0, 1), b2 + hstep, voffB);
            PG8_WAIT_V(6); PG8_BAR; PG8_MMA(1, 1, At, B1); PG8_BAR;
            PG8_LDB(B0, 1, 0); PG8_SCHED; PG8_LDA(At, 1, 0); PG8_STAGE(PG8_SA(0, 1), a2 + hstep, voffA);
            PG8_WAIT_L(8); PG8_BAR; PG8_WAIT_L(0); PG8_MMA(0, 0, At, B0); PG8_BAR; PG8_SCHED;
            PG8_LDB(B1, 1, 1); PG8_STAGE(PG8_SB(1, 0), b3, voffB);
            PG8_BAR; PG8_WAIT_L(0); PG8_MMA(0, 1, At, B1); PG8_BAR;
            PG8_LDA(At, 1, 1); PG8_STAGE(PG8_SA(1, 0), a3, voffA);
            PG8_BAR; PG8_WAIT_L(0); PG8_MMA(1, 0, At, B0); PG8_BAR; PG8_SCHED;
            PG8_STAGE(PG8_SB(1, 1), b3 + hstep, voffB);
            PG8_WAIT_V(6); PG8_BAR; PG8_MMA(1, 1, At, B1); PG8_BAR;
            }
        }
        if constexpr (ALIGN_EPI) { if (wr == 0) PG8_BAR; }
        if constexpr (!Epi::AFTER_DRAIN) { E(acc, cur, wr, wc, fr, fq); S.done(cur); }
        if (!has_next) break;
#pragma unroll
        for (int a = 0; a < 2; ++a)
#pragma unroll
            for (int b = 0; b < 2; ++b)
#pragma unroll
                for (int m = 0; m < 4; ++m)
#pragma unroll
                    for (int n = 0; n < 2; ++n) acc[a][b][m][n] = (f32x4){0.f, 0.f, 0.f, 0.f};
        cur = nxt; cA = nA; cB = nB; ++ui;
        if constexpr (ALIGN_EPI) { if (wr == 1) PG8_BAR; }
    }
    PG8_WAIT_V(0);
    if constexpr (!ALIGN_EPI) { if (wr == 0) PG8_BAR; }
    PG8_BAR;
    if constexpr (Epi::AFTER_DRAIN) { E.fused(acc, cur, wr, wc, fr, fq, lds, wid, lane); S.done(cur); }
#undef PG8_SA
#undef PG8_SB
#undef PG8_STAGE
#undef PG8_LDA
#undef PG8_LDB
#undef PG8_MMA
#undef PG8_WAIT_V
#undef PG8_WAIT_L
#undef PG8_BAR
#undef PG8_SCHED
}
}

__device__ __forceinline__ int gswz(int row, int chunk) { return row * 128 + ((chunk ^ ((row >> 1) & 7)) << 4); }
__device__ __forceinline__ void gemm_tile(const bf16_t* __restrict__ A, int lda, const bf16_t* __restrict__ Bt, int ldb, int K,
                                          int row0, int col0, unsigned char* lds, f32x16 (&acc)[2][2]) {
  int tid_ = tidx(); asm volatile("" : "+v"(tid_)); const int tid = tid_, lane = tid & 63, wid = tid >> 6, wm = wid >> 1, wn = wid & 1, r32 = lane & 31, hi = lane >> 5;
  unsigned char* As = lds; unsigned char* Bs = lds + 65536;
#pragma unroll
  for (int i = 0; i < 2; ++i)
#pragma unroll
    for (int j = 0; j < 2; ++j) acc[i][j] = f32x16{};
  const int lrow = tid >> 3, lc = tid & 7;
  const bf16_t* Ag = A + (size_t)(row0 + lrow) * lda + lc * 8;
  const bf16_t* Bg = Bt + (size_t)(col0 + lrow) * ldb + lc * 8;
  u32x4 ra[4], rb[2];
#pragma unroll
  for (int i = 0; i < 4; ++i) ra[i] = *(const u32x4*)(Ag + (size_t)(64 * i) * lda);
#pragma unroll
  for (int i = 0; i < 2; ++i) rb[i] = *(const u32x4*)(Bg + (size_t)(64 * i) * ldb);
#pragma unroll
  for (int i = 0; i < 4; ++i) *(u32x4*)(As + gswz(lrow + 64 * i, lc)) = ra[i];
#pragma unroll
  for (int i = 0; i < 2; ++i) *(u32x4*)(Bs + gswz(lrow + 64 * i, lc)) = rb[i];
  __syncthreads();
  const int nk = K / 64;
  for (int kt = 0; kt < nk; ++kt) {
    const int cur = kt & 1;
    if (kt + 1 < nk) {
#pragma unroll
      for (int i = 0; i < 4; ++i) ra[i] = *(const u32x4*)(Ag + (size_t)(64 * i) * lda + (kt + 1) * 64);
#pragma unroll
      for (int i = 0; i < 2; ++i) rb[i] = *(const u32x4*)(Bg + (size_t)(64 * i) * ldb + (kt + 1) * 64);
    }
    const unsigned char* Ac = As + cur * 32768; const unsigned char* Bc = Bs + cur * 16384;
#pragma unroll
    for (int kk = 0; kk < 4; ++kk) {
      bf16x8 af[2], bfr[2];
#pragma unroll
      for (int i = 0; i < 2; ++i) af[i] = *(const bf16x8*)(Ac + gswz(wm * 64 + i * 32 + r32, 2 * kk + hi));
#pragma unroll
      for (int j = 0; j < 2; ++j) bfr[j] = *(const bf16x8*)(Bc + gswz(wn * 64 + j * 32 + r32, 2 * kk + hi));
#pragma unroll
      for (int i = 0; i < 2; ++i)
#pragma unroll
        for (int j = 0; j < 2; ++j) acc[i][j] = __builtin_amdgcn_mfma_f32_32x32x16_bf16(af[i], bfr[j], acc[i][j], 0, 0, 0);
    }
    if (kt + 1 < nk) {
      unsigned char* An = As + (cur ^ 1) * 32768; unsigned char* Bn = Bs + (cur ^ 1) * 16384;
#pragma unroll
      for (int i = 0; i < 4; ++i) *(u32x4*)(An + gswz(lrow + 64 * i, lc)) = ra[i];
#pragma unroll
      for (int i = 0; i < 2; ++i) *(u32x4*)(Bn + gswz(lrow + 64 * i, lc)) = rb[i];
    }
    __syncthreads();
  }
}
__device__ __forceinline__ void pair_xchg(float v0, float v1, int lane, float& lo, float& hi2) {
  const bool odd = lane & 1;
  const float send = odd ? v0 : v1;
  const float recv = dpp_mov<0xB1>(send);
  lo = odd ? recv : v0; hi2 = odd ? v1 : recv;
}

__device__ __forceinline__ void phase_inproj(const Params& p, int l, unsigned char* lds) {
  int tid_ = tidx(); asm volatile("" : "+v"(tid_)); const int tid = tid_, lane = tid & 63, wid = tid >> 6, wm = wid >> 1, wn = wid & 1, r32 = lane & 31, hi = lane >> 5;
  const bf16_t* H = (const bf16_t*)(p.ws + WS_H);
  const bf16_t* W = (const bf16_t*)(p.ws + WS_WIN) + (size_t)l * PW * DM;
  bf16_t* PROJ = (bf16_t*)(p.ws + WS_PROJ);
  const float* RC = (const float*)(p.ws + WS_ROPE); const float* RS = RC + SEQ * 32;
  constexpr int NM = T / 256, NN = PW / 128, NU = NM * NN;
  for (int u = p.bx; u < NU + NM; u += p.gx) {
    if (u < NU) {
      const int pn = u / NM, pm = u % NM;
      const int row0 = pm * 256, col0 = pn * 128;
      f32x16 acc[2][2];
      gemm_tile(H, DM, W, DM, DM, row0, col0, lds, acc);
      const bool rope = (col0 >= C_DQ && col0 < C_DV);
      const float scl = (col0 >= C_MK && col0 < C_MV) ? 0.125f : ((col0 >= C_DQ && col0 < C_DK) ? QSCALE : 1.f);
#pragma unroll
      for (int i = 0; i < 2; ++i)
#pragma unroll
        for (int j = 0; j < 2; ++j)
#pragma unroll
          for (int q = 0; q < 8; ++q) {
            float lo, hi2; pair_xchg(acc[i][j][2 * q], acc[i][j][2 * q + 1], lane, lo, hi2);
            const int row = row0 + wm * 64 + i * 32 + crow(2 * q, hi) + (lane & 1);
            const int col = col0 + wn * 64 + j * 32 + (r32 & ~1);
            if (rope) {
              const int s = row % SEGL;
              if (s >= CTXL) {
                const int idx = (s - CTXL) * 32 + ((col & 63) >> 1);
                const float c = RC[idx], sn = RS[idx];
                const float t1 = lo, t2 = hi2; lo = t1 * c - t2 * sn; hi2 = t1 * sn + t2 * c;
              }
            }
            *(unsigned*)(PROJ + (size_t)row * PW + col) = cvtpk(lo * scl, hi2 * scl);
          }
    } else {
      const int pm = u - NU, rowb = pm * 256 + wid * 32;
      const bf16_t* WG = (const bf16_t*)(p.ws + WS_WG) + (size_t)l * 16 * DM;
      float* GT = (float*)(p.ws + WS_GATES);
      const int r16 = lane & 15, q4 = lane >> 4;
      f32x4 c0 = {0.f, 0.f, 0.f, 0.f}, c1 = {0.f, 0.f, 0.f, 0.f};
      const bf16_t* a0p = H + (size_t)(rowb + r16) * DM + q4 * 8;
      const bf16_t* a1p = a0p + (size_t)16 * DM;
      const bf16_t* bp = WG + (size_t)r16 * DM + q4 * 8;
#pragma unroll 4
      for (int ks = 0; ks < 32; ++ks) {
        const bf16x8 a0 = *(const bf16x8*)(a0p + ks * 32), a1 = *(const bf16x8*)(a1p + ks * 32), b = *(const bf16x8*)(bp + ks * 32);
        c0 = __builtin_amdgcn_mfma_f32_16x16x32_bf16(a0, b, c0, 0, 0, 0);
        c1 = __builtin_amdgcn_mfma_f32_16x16x32_bf16(a1, b, c1, 0, 0, 0);
      }
      const float gb = p.in[I_GATEB][l * 16 + r16];
#pragma unroll
      for (int j = 0; j < 4; ++j) {
        GT[(size_t)(rowb + q4 * 4 + j) * 16 + r16] = c0[j] + gb;
        GT[(size_t)(rowb + 16 + q4 * 4 + j) * 16 + r16] = c1[j] + gb;
      }
    }
  }
}

__device__ __forceinline__ void phase_outproj(const Params& p, int l, unsigned char* lds) {
  int tid_ = tidx(); asm volatile("" : "+v"(tid_)); const int tid = tid_, lane = tid & 63, wid = tid >> 6, wm = wid >> 1, wn = wid & 1, r32 = lane & 31, hi = lane >> 5;
  const bf16_t* MIX = (const bf16_t*)(p.ws + WS_MIX);
  const bf16_t* W = (const bf16_t*)(p.ws + WS_WOUT) + (size_t)l * DM * DM;
  float* XC = (float*)(p.ws + WS_XCUR);
  const float* MOD = (const float*)(p.ws + WS_MOD);
  constexpr int NM = T / 256, NN = DM / 128, NU = NM * NN;
  for (int u = p.bx; u < NU; u += p.gx) {
    const int pm = u / NN, pn = u % NN;
    if (l == DEPTH - 1 && (pm % 33) == 0) continue;
    const int row0 = pm * 256, col0 = pn * 128;
    for (int rep = 0; rep < REP_OUTP; ++rep) {
    f32x16 acc[2][2];
    gemm_tile(MIX, DM, W, DM, DM, row0, col0, lds, acc);
    const int mr = (pm % 33) == 0 ? 4 : pm / 33;
    const float* g1 = MOD + ((size_t)l * 5 + mr) * 6144 + 2048;
#pragma unroll
    for (int i = 0; i < 2; ++i)
#pragma unroll
      for (int j = 0; j < 2; ++j) {
        const int col = col0 + wn * 64 + j * 32 + r32;
        const float gg = (rep == REP_OUTP - 1) ? g1[col] : 0.f;
#pragma unroll
        for (int r = 0; r < 16; ++r) {
          const int row = row0 + wm * 64 + i * 32 + crow(r, hi);
          const float xo = (l == 0) ? in_row(p.in[I_X], p.in[I_CTX], row)[col] : XC[(size_t)row * DM + col];
          XC[(size_t)row * DM + col] = xo + gg * acc[i][j][r];
        }
      }
    }
  }
}
__device__ __forceinline__ void phase_peerq(const Params& p, int l, unsigned char* lds) {
  int tid_ = tidx(); asm volatile("" : "+v"(tid_)); const int tid = tid_, lane = tid & 63, wid = tid >> 6, wm = wid >> 1, wn = wid & 1, r32 = lane & 31, hi = lane >> 5;
  const bf16_t* H = (const bf16_t*)(p.ws + WS_H);
  const bf16_t* W = (const bf16_t*)(p.ws + WS_WQ) + (size_t)l * DM * DM;
  bf16_t* QP = (bf16_t*)(p.ws + WS_PROJ);
  constexpr int NM = T / 256, NN = DM / 128, NU = NM * NN;
  for (int u = p.bx; u < NU; u += p.gx) {
    const int pm = u / NN, pn = u % NN;
    if (l == DEPTH - 1 && (pm % 33) == 0) continue;
    const int row0 = pm * 256, col0 = pn * 128;
    f32x16 acc[2][2];
    gemm_tile(H, DM, W, DM, DM, row0, col0, lds, acc);
#pragma unroll
    for (int i = 0; i < 2; ++i)
#pragma unroll
      for (int j = 0; j < 2; ++j)
#pragma unroll
        for (int q = 0; q < 8; ++q) {
          float lo, hi2; pair_xchg(acc[i][j][2 * q], acc[i][j][2 * q + 1], lane, lo, hi2);
          const int row = row0 + wm * 64 + i * 32 + crow(2 * q, hi) + (lane & 1);
          const int col = col0 + wn * 64 + j * 32 + (r32 & ~1);
          *(unsigned*)(QP + (size_t)row * DM + col) = cvtpk(lo, hi2);
        }
  }
}


struct EpiInproj {
  static constexpr bool PERM = true, AFTER_DRAIN = false;
  bf16_t* PROJ; const float* RC; const float* RS; unsigned char* V8T;
  __device__ __forceinline__ void operator()(const pg8::f32x4 (&acc)[2][2][4][2], const pg8::Unit& u, int wr, int wc, int fr, int fq) const {
#pragma unroll
    for (int bj = 0; bj < 2; ++bj) {
      const int colt = u.pn * 256 + bj * 128;
      const bool rope = (colt >= C_DQ && colt < C_DV);
      const float scl = (colt >= C_MK && colt < C_MV) ? 0.125f : ((colt >= C_DQ && colt < C_DK) ? QSCALE : 1.f);
      const int col8 = colt + wc * 32 + 8 * fq;
      if (colt >= C_DV) {
        const int hh = (col8 - C_DV) >> 7, e0 = (col8 - C_DV) & 127;
#pragma unroll
        for (int ai = 0; ai < 2; ++ai)
#pragma unroll
          for (int m = 0; m < 4; ++m) {
            const int row = u.pm * 256 + ai * 128 + wr * 64 + m * 16 + fr;
            const int b = row / SEGL, s = row - b * SEGL, t = s >> 6, kk = s & 63;
            const int slot = ((kk >> 2) & 1) * 32 + (kk & 3) + 4 * ((kk >> 3) & 3) + 16 * (kk >> 5);
            unsigned char* vp = V8T + ((size_t)((b * 4 + hh) * NCH + t) * 128 + e0) * 80 + slot;
            const f32x4 v0 = acc[ai][bj][m][0], v1 = acc[ai][bj][m][1];
            int w0 = 0, w1 = 0;
            w0 = __builtin_amdgcn_cvt_pk_fp8_f32(v0[0], v0[1], w0, false); w0 = __builtin_amdgcn_cvt_pk_fp8_f32(v0[2], v0[3], w0, true);
            w1 = __builtin_amdgcn_cvt_pk_fp8_f32(v1[0], v1[1], w1, false); w1 = __builtin_amdgcn_cvt_pk_fp8_f32(v1[2], v1[3], w1, true);
            vp[0] = (unsigned char)(w0 & 0xFF); vp[80] = (unsigned char)((w0 >> 8) & 0xFF); vp[160] = (unsigned char)((w0 >> 16) & 0xFF); vp[240] = (unsigned char)((w0 >> 24) & 0xFF);
            vp[320] = (unsigned char)(w1 & 0xFF); vp[400] = (unsigned char)((w1 >> 8) & 0xFF); vp[480] = (unsigned char)((w1 >> 16) & 0xFF); vp[560] = (unsigned char)((w1 >> 24) & 0xFF);
          }
        continue;
      }
#pragma unroll
      for (int ai = 0; ai < 2; ++ai)
#pragma unroll
        for (int m = 0; m < 4; ++m) {
          const int row = u.pm * 256 + ai * 128 + wr * 64 + m * 16 + fr;
          f32x4 v0 = acc[ai][bj][m][0], v1 = acc[ai][bj][m][1];
          if (rope) {
            const int s = row % SEGL;
            if (s >= CTXL) {
              const int idx = (s - CTXL) * 32 + ((col8 & 63) >> 1);
              const f32x4 c = *(const f32x4*)(RC + idx), sn = *(const f32x4*)(RS + idx);
              f32x4 a, b;
              a[0] = v0[0] * c[0] - v0[1] * sn[0]; a[1] = v0[0] * sn[0] + v0[1] * c[0]; a[2] = v0[2] * c[1] - v0[3] * sn[1]; a[3] = v0[2] * sn[1] + v0[3] * c[1];
              b[0] = v1[0] * c[2] - v1[1] * sn[2]; b[1] = v1[0] * sn[2] + v1[1] * c[2]; b[2] = v1[2] * c[3] - v1[3] * sn[3]; b[3] = v1[2] * sn[3] + v1[3] * c[3];
              v0 = a; v1 = b;
            }
          }
          u32x4 w; w.x = cvtpk(v0[0] * scl, v0[1] * scl); w.y = cvtpk(v0[2] * scl, v0[3] * scl); w.z = cvtpk(v1[0] * scl, v1[1] * scl); w.w = cvtpk(v1[2] * scl, v1[3] * scl);
          *(u32x4*)(PROJ + (size_t)row * PW + col8) = w;
        }
    }
  }
};
struct EpiOutproj {
  static constexpr bool PERM = true, AFTER_DRAIN = false;
  float* XC; const float* MODL; const float* xin; const float* ctxin; int first; float gsc;
  __device__ __forceinline__ void operator()(const pg8::f32x4 (&acc)[2][2][4][2], const pg8::Unit& u, int wr, int wc, int fr, int fq) const {
    const int mr = (u.pm % 33) == 0 ? 4 : u.pm / 33;
    const float* g1 = MODL + (size_t)mr * 6144 + 2048;
#pragma unroll
    for (int bj = 0; bj < 2; ++bj) {
      const int col8 = u.pn * 256 + bj * 128 + wc * 32 + 8 * fq;
      const f32x4 ga = *(const f32x4*)(g1 + col8) * gsc, gb = *(const f32x4*)(g1 + col8 + 4) * gsc;
#pragma unroll
      for (int ai = 0; ai < 2; ++ai)
#pragma unroll
        for (int m = 0; m < 4; ++m) {
          const int row = u.pm * 256 + ai * 128 + wr * 64 + m * 16 + fr;
          const float* xo = first ? in_row(xin, ctxin, row) + col8 : XC + (size_t)row * DM + col8;
          const f32x4 xa = *(const f32x4*)xo, xb = *(const f32x4*)(xo + 4);
          *(f32x4*)(XC + (size_t)row * DM + col8) = xa + ga * acc[ai][bj][m][0];
          *(f32x4*)(XC + (size_t)row * DM + col8 + 4) = xb + gb * acc[ai][bj][m][1];
        }
    }
  }
};
struct EpiPeerq {
  static constexpr bool PERM = true, AFTER_DRAIN = false;
  bf16_t* QP;
  __device__ __forceinline__ void operator()(const pg8::f32x4 (&acc)[2][2][4][2], const pg8::Unit& u, int wr, int wc, int fr, int fq) const {
#pragma unroll
    for (int bj = 0; bj < 2; ++bj) {
      const int col8 = u.pn * 256 + bj * 128 + wc * 32 + 8 * fq;
#pragma unroll
      for (int ai = 0; ai < 2; ++ai)
#pragma unroll
        for (int m = 0; m < 4; ++m) {
          const int row = u.pm * 256 + ai * 128 + wr * 64 + m * 16 + fr;
          const f32x4 v0 = acc[ai][bj][m][0], v1 = acc[ai][bj][m][1];
          u32x4 w; w.x = cvtpk(v0[0], v0[1]); w.y = cvtpk(v0[2], v0[3]); w.z = cvtpk(v1[0], v1[1]); w.w = cvtpk(v1[2], v1[3]);
          *(u32x4*)(QP + (size_t)row * DM + col8) = w;
        }
    }
  }
};
__device__ __forceinline__ void phase_inproj2(const Params& p, int l, unsigned char* lds) {
  {
    pg8::Gemm g{(const bf16_t*)(p.ws + WS_H), (const bf16_t*)(p.ws + WS_WIN) + (size_t)l * PW * DM, T, PW, DM};
    pg8::StaticOrder S; S.init(T, PW, p.gx, p.bx);
    EpiInproj E{(bf16_t*)(p.ws + WS_PROJ), (const float*)(p.ws + WS_ROPE), (const float*)(p.ws + WS_ROPE) + SEQ * 32, p.ws + WS_V8T};
    pg8::gemm_phase<EpiInproj, pg8::StaticOrder, true, true>((PG8_LAS unsigned char*)lds, g, S, E);
  }
  int tid_ = tidx(); asm volatile("" : "+v"(tid_)); const int tid = tid_, lane = tid & 63, wid = tid >> 6;
  const bf16_t* H = (const bf16_t*)(p.ws + WS_H);
  for (int pm = p.gx - 1 - p.bx; pm < T / 256; pm += p.gx) {
    const int rowb = pm * 256 + wid * 32;
    const bf16_t* WG = (const bf16_t*)(p.ws + WS_WG) + (size_t)l * 16 * DM;
    float* GT = (float*)(p.ws + WS_GATES);
    const int r16 = lane & 15, q4 = lane >> 4;
    f32x4 c0 = {0.f, 0.f, 0.f, 0.f}, c1 = {0.f, 0.f, 0.f, 0.f};
    const bf16_t* a0p = H + (size_t)(rowb + r16) * DM + q4 * 8;
    const bf16_t* a1p = a0p + (size_t)16 * DM;
    const bf16_t* bp = WG + (size_t)r16 * DM + q4 * 8;
#pragma unroll 4
    for (int ks = 0; ks < 32; ++ks) {
      const bf16x8 a0 = *(const bf16x8*)(a0p + ks * 32), a1 = *(const bf16x8*)(a1p + ks * 32), b = *(const bf16x8*)(bp + ks * 32);
      c0 = __builtin_amdgcn_mfma_f32_16x16x32_bf16(a0, b, c0, 0, 0, 0);
      c1 = __builtin_amdgcn_mfma_f32_16x16x32_bf16(a1, b, c1, 0, 0, 0);
    }
    const float gb = p.in[I_GATEB][l * 16 + r16];
#pragma unroll
    for (int j = 0; j < 4; ++j) {
      GT[(size_t)(rowb + q4 * 4 + j) * 16 + r16] = c0[j] + gb;
      GT[(size_t)(rowb + 16 + q4 * 4 + j) * 16 + r16] = c1[j] + gb;
    }
  }
}
__device__ __forceinline__ void phase_outproj2(const Params& p, int l, unsigned char* lds) {
  pg8::Gemm g{(const bf16_t*)(p.ws + WS_MIX), (const bf16_t*)(p.ws + WS_WOUT) + (size_t)l * DM * DM, T, DM, DM};
  pg8::StaticOrder S; S.init(T, DM, p.gx, p.bx);
  for (int rep = 0; rep < REP_OUTP; ++rep) {
  EpiOutproj E{(float*)(p.ws + WS_XCUR), (const float*)(p.ws + WS_MOD) + (size_t)l * 5 * 6144, p.in[I_X], p.in[I_CTX], l == 0, (rep == REP_OUTP - 1) ? 1.f : 0.f};
  pg8::gemm_phase<EpiOutproj, pg8::StaticOrder, true, true>((PG8_LAS unsigned char*)lds, g, S, E);
  }
  tail_filler_tables(p, l, (T / 256) * (DM / 256), l == 0 ? 0 : NEXP, 2 * NEXP);
}
__device__ __forceinline__ void phase_peerq2(const Params& p, int l, unsigned char* lds) {
  pg8::Gemm g{(const bf16_t*)(p.ws + WS_H), (const bf16_t*)(p.ws + WS_WQ) + (size_t)l * DM * DM, T, DM, DM};
  pg8::StaticOrder S; S.init(T, DM, p.gx, p.bx);
  EpiPeerq E{(bf16_t*)(p.ws + WS_PROJ)};
  pg8::gemm_phase<EpiPeerq, pg8::StaticOrder, true, true>((PG8_LAS unsigned char*)lds, g, S, E);
  if (l < DEPTH - 1) tail_filler_tables(p, l + 1, (T / 256) * (DM / 256), 0, NEXP);
}

__device__ __forceinline__ void conv_unit(const Params& p, int l, int unit, unsigned char* lds) {
  int tid_ = tidx(); asm volatile("" : "+v"(tid_)); const int tid = tid_, lane = tid & 63, wid = tid >> 6;
  float* U = (float*)lds;
  const bf16_t* PROJ = (const bf16_t*)(p.ws + WS_PROJ);
  bf16_t* MIX = (bf16_t*)(p.ws + WS_MIX);
  const int row0 = unit * 32, b = row0 / SEGL, s0 = row0 - b * SEGL;
  const int seglo = s0 < CTXL ? 0 : CTXL, seghi = s0 < CTXL ? CTXL : SEGL;
  for (int rr = tid >> 5; rr < 62; rr += 16) {
    const int s = s0 - 15 + rr, c8 = (tid & 31) * 8;
    f32x4 u0 = {0.f, 0.f, 0.f, 0.f}, u1 = {0.f, 0.f, 0.f, 0.f};
    if (s >= seglo && s < seghi) {
      const bf16_t* pr = PROJ + (size_t)(b * SEGL + s) * PW + c8;
      const u32x4 a1 = *(const u32x4*)pr, a2 = *(const u32x4*)(pr + 256);
      u0.x = bflo(a1.x) * sigmoidf_(bflo(a2.x)); u0.y = bfhi(a1.x) * sigmoidf_(bfhi(a2.x));
      u0.z = bflo(a1.y) * sigmoidf_(bflo(a2.y)); u0.w = bfhi(a1.y) * sigmoidf_(bfhi(a2.y));
      u1.x = bflo(a1.z) * sigmoidf_(bflo(a2.z)); u1.y = bfhi(a1.z) * sigmoidf_(bfhi(a2.z));
      u1.z = bflo(a1.w) * sigmoidf_(bflo(a2.w)); u1.w = bfhi(a1.w) * sigmoidf_(bfhi(a2.w));
    }
    *(f32x4*)(U + rr * 256 + c8) = u0; *(f32x4*)(U + rr * 256 + c8 + 4) = u1;
  }
  __syncthreads();
  float* Y = U + 62 * 256;
  const float* cw = p.in[I_CONVW] + (size_t)l * 31 * 256;
#pragma unroll 1
  for (int q = 0; q < 4; ++q) {
    const int c = lane + 64 * q;
    float w[31];
#pragma unroll
    for (int j = 0; j < 31; ++j) w[j] = cw[j * 256 + c];
    const float bias = p.in[I_CONVB][l * 256 + c];
#pragma unroll
    for (int tt = 0; tt < 4; ++tt) {
      const int t = wid * 4 + tt;
      float a = bias;
#pragma unroll
      for (int j = 0; j < 31; ++j) a += U[(t + j) * 256 + c] * w[j];
      Y[t * 256 + c] = a;
    }
  }
  asm volatile("s_waitcnt lgkmcnt(0)" ::: "memory");
  float y[4][4];
#pragma unroll
  for (int tt = 0; tt < 4; ++tt)
#pragma unroll
    for (int q = 0; q < 4; ++q) y[tt][q] = Y[(wid * 4 + tt) * 256 + lane + 64 * q];
#pragma unroll
  for (int tt = 0; tt < 4; ++tt) {
    const int t = wid * 4 + tt;
    const float mean = wave_sum((y[tt][0] + y[tt][1]) + (y[tt][2] + y[tt][3])) * (1.f / 256.f);
    float v = 0.f;
#pragma unroll
    for (int q = 0; q < 4; ++q) { const float d = y[tt][q] - mean; v += d * d; }
    const float rs = rsqrtf(wave_sum(v) * (1.f / 256.f) + EPS);
#pragma unroll
    for (int q = 0; q < 4; ++q) {
      const int c = lane + 64 * q;
      const float z = (y[tt][q] - mean) * rs * p.in[I_CLNG][l * 256 + c] + p.in[I_CLNB][l * 256 + c];
      const float o = (ABL & 1) ? 0.f : z * sigmoidf_(z);
      MIX[(size_t)(row0 + t) * DM + c] = (bf16_t)(cvtpk(o, 0.f) & 0xffffu);
    }
  }
  __syncthreads();
}

__device__ __forceinline__ int ml_cidx(int ch, int dir) { return dir == 0 ? ch : (ch < 4 ? 3 - ch : 135 - ch); }
__device__ __forceinline__ void ml_load_tile(const bf16_t* src, float* dst, int tid) {
  const int r = tid >> 3, c8 = (tid & 7) * 8;
  const u32x4 a = *(const u32x4*)(src + (size_t)r * PW + c8);
  float* d = dst + r * 65 + c8;
  d[0] = bflo(a.x); d[1] = bfhi(a.x); d[2] = bflo(a.y); d[3] = bfhi(a.y); d[4] = bflo(a.z); d[5] = bfhi(a.z); d[6] = bflo(a.w); d[7] = bfhi(a.w);
}
__device__ __forceinline__ void ml_local_unit(const Params& p, int l, int unit, unsigned char* lds) {
  int tid_ = tidx(); asm volatile("" : "+v"(tid_)); const int tid = tid_, lane = tid & 63, wid = tid >> 6, r32 = lane & 31, hi = lane >> 5;
  float* Kt = (float*)lds; float* Vt = Kt + 64 * 65; float* WK = Vt + 64 * 65;
  const bf16_t* PROJ = (const bf16_t*)(p.ws + WS_PROJ);
  const float* GT = (const float*)(p.ws + WS_GATES);
  float* UL = (float*)(p.ws + WS_ULOC); float* META = (float*)(p.ws + WS_MLMETA);
  const int b = unit / (4 * NCH), hh = (unit / NCH) & 3, ch = unit % NCH;
  const int row0 = b * SEGL + ch * 64;
  ml_load_tile(PROJ + (size_t)row0 * PW + C_MK + hh * 64, Kt, tid);
  ml_load_tile(PROJ + (size_t)row0 * PW + C_MV + hh * 64, Vt, tid);
  if (wid < 2) {
    const int dir = wid;
    const float ig = GT[(size_t)(row0 + lane) * 16 + (2 * dir) * 4 + hh];
    const float lf = logsigmoidf_(GT[(size_t)(row0 + lane) * 16 + (2 * dir + 1) * 4 + hh]);
    float ps = lf;
    ps = wave_incl_scan(ps);
    const float tot = __uint_as_float((unsigned)__builtin_amdgcn_readlane((int)__float_as_uint(ps), 63));
    const float wlog = dir == 0 ? (tot - ps + ig) : (ps - lf + ig);
    const float mloc = wave_max(wlog);
    WK[dir * 64 + lane] = __expf(wlog - mloc);
    if (lane == 0) {
      const int seq = (b * 4 + hh) * 2 + dir, ci = ml_cidx(ch, dir);
      META[((size_t)seq * NCH + ci) * 4 + 0] = tot; META[((size_t)seq * NCH + ci) * 4 + 1] = mloc;
    }
  }
  __syncthreads();
  {
    const int dir = wid >> 2, et = (wid >> 1) & 1, dt = wid & 1;
    const int seq = (b * 4 + hh) * 2 + dir, ci = ml_cidx(ch, dir);
    float* slot = UL + ((size_t)seq * NCH + ci) * USTRIDE;
    f32x16 acc = {};
#pragma unroll 8
    for (int ks = 0; ks < 32; ++ks) {
      const int s = 2 * ks + hi;
      const float a = WK[dir * 64 + s] * Vt[s * 65 + et * 32 + r32];
      const float bb = Kt[s * 65 + dt * 32 + r32];
      acc = __builtin_amdgcn_mfma_f32_32x32x2f32(a, bb, acc, 0, 0, 0);
    }
#pragma unroll
    for (int r = 0; r < 16; ++r) slot[(et * 32 + crow(r, hi)) * 64 + dt * 32 + r32] = acc[r];
    if (et == 0) {
      float n = 0.f;
#pragma unroll 8
      for (int i = 0; i < 32; ++i) { const int s = hi * 32 + i; n += WK[dir * 64 + s] * Kt[s * 65 + dt * 32 + r32]; }
      n = sum_xor32(n);
      if (hi == 0) slot[4096 + dt * 32 + r32] = n;
    }
  }
  __syncthreads();
}
constexpr int MLP = 144;
constexpr size_t WS_CST = WS_H;
constexpr size_t WS_NST = WS_H + (size_t)32 * NCH * 4096 * 2;
__device__ __forceinline__ void ml_stage_rm(const bf16_t* src, size_t ld, unsigned char* dst, int tid) {
  const int r = tid >> 3, c8 = (tid & 7) * 8;
  *(u32x4*)(dst + r * MLP + c8 * 2) = *(const u32x4*)(src + (size_t)r * ld + c8);
}
__device__ __forceinline__ void ml_stage_tr(const bf16_t* src, size_t ld, unsigned char* dst, int tid) {
  const int r = tid >> 3, c8 = (tid & 7) * 8;
  const u32x4 a = *(const u32x4*)(src + (size_t)r * ld + c8);
  bf16_t* d = (bf16_t*)dst;
  d[(c8 + 0) * 72 + r] = (bf16_t)(a.x & 0xffffu); d[(c8 + 1) * 72 + r] = (bf16_t)(a.x >> 16);
  d[(c8 + 2) * 72 + r] = (bf16_t)(a.y & 0xffffu); d[(c8 + 3) * 72 + r] = (bf16_t)(a.y >> 16);
  d[(c8 + 4) * 72 + r] = (bf16_t)(a.z & 0xffffu); d[(c8 + 5) * 72 + r] = (bf16_t)(a.z >> 16);
  d[(c8 + 6) * 72 + r] = (bf16_t)(a.w & 0xffffu); d[(c8 + 7) * 72 + r] = (bf16_t)(a.w >> 16);
}
__device__ __forceinline__ void ml_local_unit2(const Params& p, int l, int unit, unsigned char* lds) {
  int tid_ = tidx(); asm volatile("" : "+v"(tid_)); const int tid = tid_, lane = tid & 63, wid = tid >> 6, r32 = lane & 31, hi = lane >> 5;
  unsigned char* KT = lds; unsigned char* VT = lds + 64 * MLP; float* WK = (float*)(lds + 2 * 64 * MLP);
  const bf16_t* PROJ = (const bf16_t*)(p.ws + WS_PROJ);
  const float* GT = (const float*)(p.ws + WS_GATES);
  float* UL = (float*)(p.ws + WS_ULOC); float* META = (float*)(p.ws + WS_MLMETA);
  const int b = unit / (4 * NCH), hh = (unit / NCH) & 3, ch = unit % NCH;
  const int row0 = b * SEGL + ch * 64;
  ml_stage_tr(PROJ + (size_t)row0 * PW + C_MK + hh * 64, PW, KT, tid);
  ml_stage_tr(PROJ + (size_t)row0 * PW + C_MV + hh * 64, PW, VT, tid);
  if (wid < 2) {
    const int dir = wid;
    const float ig = GT[(size_t)(row0 + lane) * 16 + (2 * dir) * 4 + hh];
    const float lf = logsigmoidf_(GT[(size_t)(row0 + lane) * 16 + (2 * dir + 1) * 4 + hh]);
    float ps = lf;
    ps = wave_incl_scan(ps);
    const float tot = __uint_as_float((unsigned)__builtin_amdgcn_readlane((int)__float_as_uint(ps), 63));
    const float wlog = dir == 0 ? (tot - ps + ig) : (ps - lf + ig);
    const float mloc = wave_max(wlog);
    WK[dir * 64 + lane] = __expf(wlog - mloc);
    if (lane == 0) {
      const int seq = (b * 4 + hh) * 2 + dir, ci = ml_cidx(ch, dir);
      META[((size_t)seq * NCH + ci) * 4 + 0] = tot; META[((size_t)seq * NCH + ci) * 4 + 1] = mloc;
    }
  }
  __syncthreads();
  {
    const int dir = wid >> 2, et = (wid >> 1) & 1, dt = wid & 1;
    const int seq = (b * 4 + hh) * 2 + dir, ci = ml_cidx(ch, dir);
    float* slot = UL + ((size_t)seq * NCH + ci) * USTRIDE;
    f32x16 acc = {};
#pragma unroll
    for (int ks = 0; ks < 4; ++ks) {
      const int s0 = ks * 16 + hi * 8;
      const u32x4 va = *(const u32x4*)(VT + (et * 32 + r32) * MLP + s0 * 2);
      const bf16x8 kb = *(const bf16x8*)(KT + (dt * 32 + r32) * MLP + s0 * 2);
      const f32x4 w0 = *(const f32x4*)(WK + dir * 64 + s0), w1 = *(const f32x4*)(WK + dir * 64 + s0 + 4);
      u32x4 sa; sa.x = cvtpk(bflo(va.x) * w0.x, bfhi(va.x) * w0.y); sa.y = cvtpk(bflo(va.y) * w0.z, bfhi(va.y) * w0.w);
      sa.z = cvtpk(bflo(va.z) * w1.x, bfhi(va.z) * w1.y); sa.w = cvtpk(bflo(va.w) * w1.z, bfhi(va.w) * w1.w);
      acc = __builtin_amdgcn_mfma_f32_32x32x16_bf16(*(const bf16x8*)&sa, kb, acc, 0, 0, 0);
    }
#pragma unroll
    for (int r = 0; r < 16; ++r) slot[(et * 32 + crow(r, hi)) * 64 + dt * 32 + r32] = acc[r];
    if (et == 0) {
      float n = 0.f;
#pragma unroll
      for (int i = 0; i < 4; ++i) {
        const int s0 = hi * 32 + i * 8;
        const u32x4 ka = *(const u32x4*)(KT + (dt * 32 + r32) * MLP + s0 * 2);
        const f32x4 w0 = *(const f32x4*)(WK + dir * 64 + s0), w1 = *(const f32x4*)(WK + dir * 64 + s0 + 4);
        n += bflo(ka.x) * w0.x + bfhi(ka.x) * w0.y + bflo(ka.y) * w0.z + bfhi(ka.y) * w0.w + bflo(ka.z) * w1.x + bfhi(ka.z) * w1.y + bflo(ka.w) * w1.z + bfhi(ka.w) * w1.w;
      }
      n = sum_xor32(n);
      if (hi == 0) slot[4096 + dt * 32 + r32] = n;
    }
  }
  __syncthreads();
}
__device__ __forceinline__ void ml_scan(const Params& p, unsigned char* lds) {
  float* UL = (float*)(p.ws + WS_ULOC); float* META = (float*)(p.ws + WS_MLMETA);
  int tid_ = tidx(); asm volatile("" : "+v"(tid_));
  const int tid = tid_, lane = tid & 63, wid = tid >> 6;
  float* DEC = (float*)lds;
  float* SCL = DEC + 2 * NCH;
  float* TMP = SCL + 2 * NCH;
  constexpr int NSL = (32 * USTRIDE + 511) / 512;
  const int first_ = p.gx > 64 ? 16 : 0, nb_ = p.gx - first_;
  for (int k_ = 0; k_ < 2 + (NSL + nb_ - 1) / nb_; ++k_) {
    int s_;
    if (k_ == 0) s_ = p.bx >= first_ ? p.bx - first_ : -1;
    else s_ = k_ * nb_ + (p.gx - 1 - p.bx);
    if (k_ > 0 && p.gx - 1 - p.bx >= nb_) s_ = -1;
    if (s_ < 0 || s_ >= NSL) continue;
    const int base0 = s_ * 512;
    const int seq0 = base0 / USTRIDE;
    if (wid < 2) {
      const int seq = seq0 + wid;
      if (seq < 32) {
        float* mt = META + (size_t)seq * NCH * 4;
        for (int c = lane; c < NCH; c += 64) { TMP[(wid * 2 + 0) * NCH + c] = mt[c * 4 + 0]; TMP[(wid * 2 + 1) * NCH + c] = mt[c * 4 + 1]; }
        asm volatile("s_waitcnt lgkmcnt(0)" ::: "memory");
        if (lane == 0) {
          float m = 0.f;
          for (int c = 0; c < NCH; ++c) {
            const float bl = TMP[(wid * 2 + 0) * NCH + c], mloc = TMP[(wid * 2 + 1) * NCH + c];
            const float mn = fmaxf(bl + m, mloc);
            DEC[wid * NCH + c] = __expf(bl + m - mn); SCL[wid * NCH + c] = __expf(mloc - mn);
            mt[c * 4 + 2] = m;
            m = mn;
          }
        }
      }
    }
    __syncthreads();
    const int idx = base0 + tid;
    if (idx < 32 * USTRIDE) {
      const int seq = idx / USTRIDE, e = idx - seq * USTRIDE, sl = seq - seq0;
      float* bp = UL + (size_t)seq * NCH * USTRIDE + e;
      bf16_t* CSTp = (bf16_t*)(p.ws + WS_CST) + (size_t)seq * NCH * 4096 + (e < 4096 ? e : 0);
      float* NSTp = (float*)(p.ws + WS_NST) + (size_t)seq * NCH * 64 + (e < 4096 ? 0 : e - 4096);
      const float* dec = DEC + sl * NCH; const float* scl = SCL + sl * NCH;
      float C = 0.f;
      constexpr int BT = 33;
      static_assert(NCH == 4 * BT, "scan batches");
      float ua[BT], ub[BT];
#define SCAN_LD(u_, c0_) _Pragma("unroll") for (int j = 0; j < BT; ++j) u_[j] = bp[(size_t)((c0_) + j) * USTRIDE];
#define SCAN_DO(u_, c0_) _Pragma("unroll") for (int j = 0; j < BT; ++j) { \
          if (e < 4096) CSTp[(size_t)((c0_) + j) * 4096] = (bf16_t)(cvtpk(C, 0.f) & 0xffffu); else NSTp[(size_t)((c0_) + j) * 64] = C; \
          C = dec[(c0_) + j] * C + scl[(c0_) + j] * u_[j]; }
      SCAN_LD(ua, 0)
#pragma unroll 1
      for (int c0 = 0; c0 < NCH; c0 += 2 * BT) {
        SCAN_LD(ub, c0 + BT)
        SCAN_DO(ua, c0)
        if (c0 + 2 * BT < NCH) { SCAN_LD(ua, c0 + 2 * BT) }
        SCAN_DO(ub, c0 + BT)
      }
#undef SCAN_LD
#undef SCAN_DO
    }
    __syncthreads();
  }
}
__device__ __forceinline__ void ml_out_unit(const Params& p, int l, int unit, unsigned char* lds) {
  int tid_ = tidx(); asm volatile("" : "+v"(tid_)); const int tid = tid_, lane = tid & 63, wid = tid >> 6, r32 = lane & 31, hi = lane >> 5;
  float* Qt = (float*)lds; float* Kt = Qt + 64 * 65; float* Vt = Kt + 64 * 65;
  float* Cs = Vt + 64 * 65;
  float* Ns = Cs + 2 * 64 * 65;
  float* Bq = Ns + 128;
  float* Gs = Bq + 128;
  float* Mi = Gs + 128;
  float* HB = Mi + 64;
  const bf16_t* PROJ = (const bf16_t*)(p.ws + WS_PROJ);
  const float* GT = (const float*)(p.ws + WS_GATES);
  const float* UL = (const float*)(p.ws + WS_ULOC); const float* META = (const float*)(p.ws + WS_MLMETA);
  bf16_t* MIX = (bf16_t*)(p.ws + WS_MIX);
  const int b = unit / (4 * NCH), hh = (unit / NCH) & 3, ch = unit % NCH;
  const int row0 = b * SEGL + ch * 64;
  ml_load_tile(PROJ + (size_t)row0 * PW + C_MQ + hh * 64, Qt, tid);
  ml_load_tile(PROJ + (size_t)row0 * PW + C_MK + hh * 64, Kt, tid);
  ml_load_tile(PROJ + (size_t)row0 * PW + C_MV + hh * 64, Vt, tid);
  for (int i = tid; i < 2 * USTRIDE; i += 512) {
    const int dir = i / USTRIDE, e = i - dir * USTRIDE;
    const int seq = (b * 4 + hh) * 2 + dir, ci = ml_cidx(ch, dir);
    const float v = UL[((size_t)seq * NCH + ci) * USTRIDE + e];
    if (e < 4096) Cs[dir * 64 * 65 + (e >> 6) * 65 + (e & 63)] = v; else Ns[dir * 64 + (e - 4096)] = v;
  }
  if (wid < 2) {
    const int dir = wid;
    const float ig = GT[(size_t)(row0 + lane) * 16 + (2 * dir) * 4 + hh];
    const float lf = logsigmoidf_(GT[(size_t)(row0 + lane) * 16 + (2 * dir + 1) * 4 + hh]);
    float ps = lf;
    ps = wave_incl_scan(ps);
    const float tot = __uint_as_float((unsigned)__builtin_amdgcn_readlane((int)__float_as_uint(ps), 63));
    const float bc = dir == 0 ? ps : (tot - ps + lf);
    Bq[dir * 64 + lane] = bc; Gs[dir * 64 + lane] = ig - bc;
    if (lane == 0) { const int seq = (b * 4 + hh) * 2 + dir, ci = ml_cidx(ch, dir); Mi[dir] = META[((size_t)seq * NCH + ci) * 4 + 2]; }
  }
  __syncthreads();
  {
    const int dir = wid >> 2, tt = (wid >> 1) & 1, et = wid & 1;
    const int t = tt * 32 + r32;
    f32x16 sa[2] = {};
#pragma unroll 4
    for (int ks = 0; ks < 32; ++ks) {
      const float bq = Qt[t * 65 + 2 * ks + hi];
      const float a0 = Kt[(r32) * 65 + 2 * ks + hi], a1 = Kt[(32 + r32) * 65 + 2 * ks + hi];
      sa[0] = __builtin_amdgcn_mfma_f32_32x32x2f32(a0, bq, sa[0], 0, 0, 0);
      sa[1] = __builtin_amdgcn_mfma_f32_32x32x2f32(a1, bq, sa[1], 0, 0, 0);
    }
    const float bt = Bq[dir * 64 + t];
    const float inter = bt + Mi[dir];
    float mx = -INFINITY;
    f32x16 dl[2];
#pragma unroll
    for (int st = 0; st < 2; ++st)
#pragma unroll
      for (int r = 0; r < 16; ++r) {
        const int s = st * 32 + crow(r, hi);
        const bool ok = dir == 0 ? (s <= t) : (s >= t);
        const float d = ok ? bt + Gs[dir * 64 + s] : -INFINITY;
        dl[st][r] = d; mx = fmaxf(mx, d);
      }
    mx = max_xor32(mx);
    const float mt = fmaxf(inter, mx);
    const float iw = __expf(inter - mt);
    float rsum = 0.f;
#pragma unroll
    for (int st = 0; st < 2; ++st)
#pragma unroll
      for (int r = 0; r < 16; ++r) { const float w = __expf(dl[st][r] - mt); sa[st][r] *= w; rsum += sa[st][r]; }
    rsum = sum_xor32(rsum);
    float qn = 0.f;
#pragma unroll 8
    for (int i = 0; i < 32; ++i) { const int d = hi * 32 + i; qn += Ns[dir * 64 + d] * Qt[t * 65 + d]; }
    qn = sum_xor32(qn);
    const float den = rsum + iw * qn;
    const float rden = 1.f / fmaxf(fabsf(den), __expf(-mt));
    f32x16 an = {}, ac = {};
#pragma unroll
    for (int st = 0; st < 2; ++st)
#pragma unroll
      for (int r = 0; r < 16; ++r) {
        const float a = Vt[(st * 32 + crow(r, hi)) * 65 + et * 32 + r32];
        an = __builtin_amdgcn_mfma_f32_32x32x2f32(a, sa[st][r], an, 0, 0, 0);
      }
    const float* Cd = Cs + dir * 64 * 65;
#pragma unroll 4
    for (int ks = 0; ks < 32; ++ks) {
      const float a = Cd[(et * 32 + r32) * 65 + 2 * ks + hi];
      const float bq = Qt[t * 65 + 2 * ks + hi];
      ac = __builtin_amdgcn_mfma_f32_32x32x2f32(a, bq, ac, 0, 0, 0);
    }
#pragma unroll
    for (int r = 0; r < 16; ++r) HB[dir * 64 * 65 + t * 65 + et * 32 + crow(r, hi)] = (an[r] + iw * ac[r]) * rden;
  }
  __syncthreads();
  {
    const int t = tid >> 3, e8 = (tid & 7) * 8;
    float v[8]; float ss = 0.f;
#pragma unroll
    for (int i = 0; i < 8; ++i) { v[i] = HB[t * 65 + e8 + i] + HB[64 * 65 + t * 65 + e8 + i]; ss += v[i] * v[i]; }
    ss += dpp_mov<0xB1>(ss); ss += dpp_mov<0x4E>(ss); ss += dpp_mov<0x141>(ss);
    const float rs = rsqrtf(ss * (1.f / 64.f) + EPS);
    const u32x4 ov = *(const u32x4*)(PROJ + (size_t)(row0 + t) * PW + C_MO + hh * 64 + e8);
    const float og[8] = {bflo(ov.x), bfhi(ov.x), bflo(ov.y), bfhi(ov.y), bflo(ov.z), bfhi(ov.z), bflo(ov.w), bfhi(ov.w)};
    const float* g = p.in[I_MNORMG] + l * 64 + e8;
    float o[8];
#pragma unroll
    for (int i = 0; i < 8; ++i) o[i] = (ABL & 2) ? 0.f : v[i] * rs * g[i] * sigmoidf_(og[i]);
    u32x4 w; w.x = cvtpk(o[0], o[1]); w.y = cvtpk(o[2], o[3]); w.z = cvtpk(o[4], o[5]); w.w = cvtpk(o[6], o[7]);
    *(u32x4*)(MIX + (size_t)(row0 + t) * DM + 256 + hh * 64 + e8) = w;
  }
  __syncthreads();
}


__device__ __forceinline__ void ml_out_unit2(const Params& p, int l, int unit, unsigned char* lds) {
  int tid_ = tidx(); asm volatile("" : "+v"(tid_)); const int tid = tid_, lane = tid & 63, wid = tid >> 6, r32 = lane & 31, hi = lane >> 5;
  unsigned char* Qs = lds; unsigned char* Ks = lds + 64 * MLP; unsigned char* VT = lds + 2 * 64 * MLP; unsigned char* Cs = lds + 3 * 64 * MLP;
  float* Ns = (float*)(lds + 5 * 64 * MLP);
  float* Bq = Ns + 128;
  float* Gs = Bq + 128;
  float* Mi = Gs + 128;
  float* HB = Mi + 64;
  const bf16_t* PROJ = (const bf16_t*)(p.ws + WS_PROJ);
  const float* GT = (const float*)(p.ws + WS_GATES);
  const bf16_t* CST = (const bf16_t*)(p.ws + WS_CST); const float* NST = (const float*)(p.ws + WS_NST); const float* META = (const float*)(p.ws + WS_MLMETA);
  bf16_t* MIX = (bf16_t*)(p.ws + WS_MIX);
  const int b = unit / (4 * NCH), hh = (unit / NCH) & 3, ch = unit % NCH;
  const int row0 = b * SEGL + ch * 64;
  ml_stage_rm(PROJ + (size_t)row0 * PW + C_MQ + hh * 64, PW, Qs, tid);
  ml_stage_rm(PROJ + (size_t)row0 * PW + C_MK + hh * 64, PW, Ks, tid);
  ml_stage_tr(PROJ + (size_t)row0 * PW + C_MV + hh * 64, PW, VT, tid);
#pragma unroll
  for (int dir = 0; dir < 2; ++dir) {
    const int seq = (b * 4 + hh) * 2 + dir, ci = ml_cidx(ch, dir);
    ml_stage_rm(CST + ((size_t)seq * NCH + ci) * 4096, 64, Cs + dir * 64 * MLP, tid);
    if (tid < 64) Ns[dir * 64 + tid] = NST[((size_t)seq * NCH + ci) * 64 + tid];
  }
  if (wid < 2) {
    const int dir = wid;
    const float ig = GT[(size_t)(row0 + lane) * 16 + (2 * dir) * 4 + hh];
    const float lf = logsigmoidf_(GT[(size_t)(row0 + lane) * 16 + (2 * dir + 1) * 4 + hh]);
    float ps = lf;
    ps = wave_incl_scan(ps);
    const float tot = __uint_as_float((unsigned)__builtin_amdgcn_readlane((int)__float_as_uint(ps), 63));
    const float bc = dir == 0 ? ps : (tot - ps + lf);
    Bq[dir * 64 + lane] = bc; Gs[dir * 64 + lane] = ig - bc;
    if (lane == 0) { const int seq = (b * 4 + hh) * 2 + dir, ci = ml_cidx(ch, dir); Mi[dir] = META[((size_t)seq * NCH + ci) * 4 + 2]; }
  }
  __syncthreads();
  {
    const int dir = wid >> 2, tt = (wid >> 1) & 1, et = wid & 1;
    const int t = tt * 32 + r32;
    f32x16 sa[2] = {};
    bf16x8 bq[4];
#pragma unroll
    for (int ks = 0; ks < 4; ++ks) {
      bq[ks] = *(const bf16x8*)(Qs + t * MLP + (ks * 16 + hi * 8) * 2);
      const bf16x8 a0 = *(const bf16x8*)(Ks + r32 * MLP + (ks * 16 + hi * 8) * 2), a1 = *(const bf16x8*)(Ks + (32 + r32) * MLP + (ks * 16 + hi * 8) * 2);
      sa[0] = __builtin_amdgcn_mfma_f32_32x32x16_bf16(a0, bq[ks], sa[0], 0, 0, 0);
      sa[1] = __builtin_amdgcn_mfma_f32_32x32x16_bf16(a1, bq[ks], sa[1], 0, 0, 0);
    }
    const float bt = Bq[dir * 64 + t];
    const float inter = bt + Mi[dir];
    float mx = -INFINITY;
    f32x16 dl[2];
#pragma unroll
    for (int st = 0; st < 2; ++st)
#pragma unroll
      for (int r = 0; r < 16; ++r) {
        const int s = st * 32 + crow(r, hi);
        const bool ok = dir == 0 ? (s <= t) : (s >= t);
        const float d = ok ? bt + Gs[dir * 64 + s] : -INFINITY;
        dl[st][r] = d; mx = fmaxf(mx, d);
      }
    mx = max_xor32(mx);
    const float mt = fmaxf(inter, mx);
    const float iw = __expf(inter - mt);
    float rsum = 0.f;
#pragma unroll
    for (int st = 0; st < 2; ++st)
#pragma unroll
      for (int r = 0; r < 16; ++r) { const float w = __expf(dl[st][r] - mt); sa[st][r] *= w; rsum += sa[st][r]; }
    rsum = sum_xor32(rsum);
    float qn = 0.f;
#pragma unroll
    for (int i = 0; i < 4; ++i) {
      const int d0 = hi * 32 + i * 8;
      const u32x4 qa = *(const u32x4*)(Qs + t * MLP + d0 * 2);
      const f32x4 n0 = *(const f32x4*)(Ns + dir * 64 + d0), n1 = *(const f32x4*)(Ns + dir * 64 + d0 + 4);
      qn += bflo(qa.x) * n0.x + bfhi(qa.x) * n0.y + bflo(qa.y) * n0.z + bfhi(qa.y) * n0.w + bflo(qa.z) * n1.x + bfhi(qa.z) * n1.y + bflo(qa.w) * n1.z + bfhi(qa.w) * n1.w;
    }
    qn = sum_xor32(qn);
    const float den = rsum + iw * qn;
    const float rden = 1.f / fmaxf(fabsf(den), __expf(-mt));
    f32x16 an = {}, ac = {};
#pragma unroll
    for (int st = 0; st < 2; ++st)
#pragma unroll
      for (int k2 = 0; k2 < 2; ++k2) {
        u32x4 bx; bx.x = cvtpk(sa[st][8 * k2 + 0], sa[st][8 * k2 + 1]); bx.y = cvtpk(sa[st][8 * k2 + 2], sa[st][8 * k2 + 3]);
        bx.z = cvtpk(sa[st][8 * k2 + 4], sa[st][8 * k2 + 5]); bx.w = cvtpk(sa[st][8 * k2 + 6], sa[st][8 * k2 + 7]);
        const unsigned char* vrow = VT + (et * 32 + r32) * MLP + (st * 32 + 16 * k2 + 4 * hi) * 2;
        const u32x2 v0 = *(const u32x2*)vrow, v1 = *(const u32x2*)(vrow + 16);
        u32x4 ax; ax.x = v0.x; ax.y = v0.y; ax.z = v1.x; ax.w = v1.y;
        an = __builtin_amdgcn_mfma_f32_32x32x16_bf16(*(const bf16x8*)&ax, *(const bf16x8*)&bx, an, 0, 0, 0);
      }
    const unsigned char* Cd = Cs + dir * 64 * MLP;
#pragma unroll
    for (int ks = 0; ks < 4; ++ks) {
      const bf16x8 a = *(const bf16x8*)(Cd + (et * 32 + r32) * MLP + (ks * 16 + hi * 8) * 2);
      ac = __builtin_amdgcn_mfma_f32_32x32x16_bf16(a, bq[ks], ac, 0, 0, 0);
    }
#pragma unroll
    for (int r = 0; r < 16; ++r) HB[dir * 64 * 65 + t * 65 + et * 32 + crow(r, hi)] = (an[r] + iw * ac[r]) * rden;
  }
  __syncthreads();
  {
    const int t = tid >> 3, e8 = (tid & 7) * 8;
    float v[8]; float ss = 0.f;
#pragma unroll
    for (int i = 0; i < 8; ++i) { v[i] = HB[t * 65 + e8 + i] + HB[64 * 65 + t * 65 + e8 + i]; ss += v[i] * v[i]; }
    ss += dpp_mov<0xB1>(ss); ss += dpp_mov<0x4E>(ss); ss += dpp_mov<0x141>(ss);
    const float rs = rsqrtf(ss * (1.f / 64.f) + EPS);
    const u32x4 ov = *(const u32x4*)(PROJ + (size_t)(row0 + t) * PW + C_MO + hh * 64 + e8);
    const float og[8] = {bflo(ov.x), bfhi(ov.x), bflo(ov.y), bfhi(ov.y), bflo(ov.z), bfhi(ov.z), bflo(ov.w), bfhi(ov.w)};
    const float* g = p.in[I_MNORMG] + l * 64 + e8;
    float o[8];
#pragma unroll
    for (int i = 0; i < 8; ++i) o[i] = (ABL & 2) ? 0.f : v[i] * rs * g[i] * sigmoidf_(og[i]);
    u32x4 w; w.x = cvtpk(o[0], o[1]); w.y = cvtpk(o[2], o[3]); w.z = cvtpk(o[4], o[5]); w.w = cvtpk(o[6], o[7]);
    *(u32x4*)(MIX + (size_t)(row0 + t) * DM + 256 + hh * 64 + e8) = w;
  }
  __syncthreads();
}

#define KSWZ(row, colB) ((row) * 256 + ((colB) ^ (((row) & 15) << 4)))
#define SBAR() __builtin_amdgcn_sched_barrier(0)
constexpr int ATT_SHM_V = 128 * 80, ATT_SHM_K = 64 * 128 * 2;
constexpr float ATT_THR = 8.0f;
__device__ __forceinline__ int v_st(int k, int c) { const int kk = (k & ~0xC) | ((k & 4) << 1) | ((k & 8) >> 1); return ((kk >> 3) * 4 + (c >> 5)) * 512 + ((kk & 7) * 32 + (c & 31)) * 2; }
__device__ __forceinline__ int v_rd_base(int lane) { return ((lane & 3) << 3) | (((lane >> 2) & 3) << 6) | (((lane >> 4) & 1) << 5) | (((lane >> 5) & 1) << 8); }
constexpr int v_rd_off(int d0, int ks, int half) { return d0 * 512 + ks * 4096 + half * 2048; }
template <int OFF> __device__ __forceinline__ s16x4 tr_read(int vb) {
  s16x4 r; asm volatile("ds_read_b64_tr_b16 %0, %1 offset:%2" : "=&v"(r) : "v"(vb), "i"(OFF) : "memory"); return r;
}
template <int D0> __device__ __forceinline__ void pv_one(f32x16& od, int vb, bf16x8 pa0, bf16x8 pa1, bf16x8 pa2, bf16x8 pa3) {
  const s16x4 l0 = tr_read<v_rd_off(D0, 0, 0)>(vb), h0 = tr_read<v_rd_off(D0, 0, 1)>(vb), l1 = tr_read<v_rd_off(D0, 1, 0)>(vb), h1 = tr_read<v_rd_off(D0, 1, 1)>(vb);
  const s16x4 l2 = tr_read<v_rd_off(D0, 2, 0)>(vb), h2 = tr_read<v_rd_off(D0, 2, 1)>(vb), l3 = tr_read<v_rd_off(D0, 3, 0)>(vb), h3 = tr_read<v_rd_off(D0, 3, 1)>(vb);
  asm volatile("s_waitcnt lgkmcnt(0)" ::: "memory"); SBAR();
#define PK(L, H) (bf16x8){L[0], L[1], L[2], L[3], H[0], H[1], H[2], H[3]}
  od = __builtin_amdgcn_mfma_f32_32x32x16_bf16(pa0, PK(l0, h0), od, 0, 0, 0);
  od = __builtin_amdgcn_mfma_f32_32x32x16_bf16(pa1, PK(l1, h1), od, 0, 0, 0);
  od = __builtin_amdgcn_mfma_f32_32x32x16_bf16(pa2, PK(l2, h2), od, 0, 0, 0);
  od = __builtin_amdgcn_mfma_f32_32x32x16_bf16(pa3, PK(l3, h3), od, 0, 0, 0);
#undef PK
}
template <int D0> __device__ __forceinline__ void pv_two(f32x16& oa, f32x16& ob, int vb, bf16x8 a0, bf16x8 a1, bf16x8 a2, bf16x8 a3, bf16x8 b0, bf16x8 b1, bf16x8 b2, bf16x8 b3) {
  const s16x4 l0 = tr_read<v_rd_off(D0, 0, 0)>(vb), h0 = tr_read<v_rd_off(D0, 0, 1)>(vb), l1 = tr_read<v_rd_off(D0, 1, 0)>(vb), h1 = tr_read<v_rd_off(D0, 1, 1)>(vb);
  const s16x4 l2 = tr_read<v_rd_off(D0, 2, 0)>(vb), h2 = tr_read<v_rd_off(D0, 2, 1)>(vb), l3 = tr_read<v_rd_off(D0, 3, 0)>(vb), h3 = tr_read<v_rd_off(D0, 3, 1)>(vb);
  asm volatile("s_waitcnt lgkmcnt(0)" ::: "memory"); SBAR();
#define PK(L, H) (bf16x8){L[0], L[1], L[2], L[3], H[0], H[1], H[2], H[3]}
  const bf16x8 v0 = PK(l0, h0), v1 = PK(l1, h1), v2 = PK(l2, h2), v3 = PK(l3, h3);
  oa = __builtin_amdgcn_mfma_f32_32x32x16_bf16(a0, v0, oa, 0, 0, 0);
  ob = __builtin_amdgcn_mfma_f32_32x32x16_bf16(b0, v0, ob, 0, 0, 0);
  oa = __builtin_amdgcn_mfma_f32_32x32x16_bf16(a1, v1, oa, 0, 0, 0);
  ob = __builtin_amdgcn_mfma_f32_32x32x16_bf16(b1, v1, ob, 0, 0, 0);
  oa = __builtin_amdgcn_mfma_f32_32x32x16_bf16(a2, v2, oa, 0, 0, 0);
  ob = __builtin_amdgcn_mfma_f32_32x32x16_bf16(b2, v2, ob, 0, 0, 0);
  oa = __builtin_amdgcn_mfma_f32_32x32x16_bf16(a3, v3, oa, 0, 0, 0);
  ob = __builtin_amdgcn_mfma_f32_32x32x16_bf16(b3, v3, ob, 0, 0, 0);
#undef PK
}
struct KQFrag { bf16x8 b0, b1, q; };
__device__ __forceinline__ void att_ldkq(KQFrag& f, const LAS unsigned char* l3, int ak, int kofs, int qofs) {
  const LAS unsigned char* kp = l3 + (ak + kofs);
  f.b0 = *(const LAS bf16x8*)kp; f.b1 = *(const LAS bf16x8*)(kp + 8192); f.q = *(const LAS bf16x8*)(l3 + (ak + qofs));
}
#define ATT_MF(pa_, pb_, f_) do { pa_ = __builtin_amdgcn_mfma_f32_32x32x16_bf16(f_.b0, f_.q, pa_, 0, 0, 0); pb_ = __builtin_amdgcn_mfma_f32_32x32x16_bf16(f_.b1, f_.q, pb_, 0, 0, 0); } while (0)
__device__ __forceinline__ void att_qk_all(f32x16& p0, f32x16& p1, f32x16& q0, f32x16& q1, KQFrag& f0, const LAS unsigned char* l3, int ak0, int kofs, int qofs, float ia, float ib) {
  KQFrag f1;
#pragma unroll
  for (int r = 0; r < 16; ++r) { p0[r] = ia; p1[r] = ia; q0[r] = ib; q1[r] = ib; }
  att_ldkq(f1, l3, ak0 ^ (1 << 5), kofs, qofs); ATT_MF(p0, p1, f0); SBAR();
  att_ldkq(f0, l3, ak0 ^ (2 << 5), kofs, qofs); ATT_MF(p0, p1, f1); SBAR();
  att_ldkq(f1, l3, ak0 ^ (3 << 5), kofs, qofs); ATT_MF(p0, p1, f0); SBAR();
  att_ldkq(f0, l3, ak0 ^ (4 << 5), kofs, qofs); ATT_MF(p0, p1, f1); SBAR();
  att_ldkq(f1, l3, ak0 ^ (5 << 5), kofs, qofs); ATT_MF(q0, q1, f0); SBAR();
  att_ldkq(f0, l3, ak0 ^ (6 << 5), kofs, qofs); ATT_MF(q0, q1, f1); SBAR();
  att_ldkq(f1, l3, ak0 ^ (7 << 5), kofs, qofs); ATT_MF(q0, q1, f0); SBAR();
  ATT_MF(q0, q1, f1); SBAR();
}
__device__ __forceinline__ void att_softmax(f32x16& p0, f32x16& p1, float& m_reg, float& l_reg, float& alpha, bool first, i32x8& pa) {
  alpha = 1.f;
  if (first) {
    float pmax = p0[0];
#pragma unroll
    for (int r = 1; r < 16; ++r) pmax = fmaxf(pmax, p0[r]);
#pragma unroll
    for (int r = 0; r < 16; ++r) pmax = fmaxf(pmax, p1[r]);
    { auto rr = __builtin_amdgcn_permlane32_swap(__float_as_uint(pmax), __float_as_uint(pmax), false, false);
      pmax = fmaxf(__uint_as_float(rr[0]), __uint_as_float(rr[1])); }
    alpha = 0.f; m_reg = pmax;
#pragma unroll
    for (int r = 0; r < 16; ++r) { p0[r] -= pmax; p1[r] -= pmax; }
  }
#pragma unroll
  for (int r = 0; r < 16; ++r) { p0[r] = __builtin_amdgcn_exp2f(p0[r]); p1[r] = __builtin_amdgcn_exp2f(p1[r]); }
  float ps;
  {
#define VADD(d_, a_, b_) asm("v_add_f32_e32 %0, %1, %2" : "=v"(d_) : "v"(a_), "v"(b_))
    float s0, s1, s2, s3;
    VADD(s0, p0[0], p0[1]); VADD(s1, p0[8], p0[9]); VADD(s2, p1[0], p1[1]); VADD(s3, p1[8], p1[9]);
#pragma unroll
    for (int r = 2; r < 8; ++r) { VADD(s0, s0, p0[r]); VADD(s1, s1, p0[8 + r]); VADD(s2, s2, p1[r]); VADD(s3, s3, p1[8 + r]); }
    VADD(s0, s0, s1); VADD(s2, s2, s3); VADD(ps, s0, s2);
#undef VADD
  }
  { auto rr = __builtin_amdgcn_permlane32_swap(__float_as_uint(ps), __float_as_uint(ps), false, false);
    ps = __uint_as_float(rr[0]) + __uint_as_float(rr[1]); }
  if (__builtin_expect(!first && __any(ps > 256.f), 0)) {
    float emax = p0[0];
#pragma unroll
    for (int r = 1; r < 16; ++r) emax = fmaxf(emax, p0[r]);
#pragma unroll
    for (int r = 0; r < 16; ++r) emax = fmaxf(emax, p1[r]);
    { auto rr = __builtin_amdgcn_permlane32_swap(__float_as_uint(emax), __float_as_uint(emax), false, false);
      emax = fmaxf(__uint_as_float(rr[0]), __uint_as_float(rr[1])); }
    const float delta = fmaxf(__builtin_amdgcn_logf(emax), 0.f);
    alpha = __builtin_amdgcn_exp2f(-delta); m_reg += delta;
#pragma unroll
    for (int r = 0; r < 16; ++r) { p0[r] *= alpha; p1[r] *= alpha; }
    ps *= alpha;
  }
  l_reg = l_reg * alpha + ps;
#pragma unroll
  for (int v = 0; v < 4; ++v) {
    int w0, w1; asm volatile("" : "=v"(w0), "=v"(w1));
    w0 = __builtin_amdgcn_cvt_pk_fp8_f32(p0[4 * v], p0[4 * v + 1], w0, false); w0 = __builtin_amdgcn_cvt_pk_fp8_f32(p0[4 * v + 2], p0[4 * v + 3], w0, true);
    w1 = __builtin_amdgcn_cvt_pk_fp8_f32(p1[4 * v], p1[4 * v + 1], w1, false); w1 = __builtin_amdgcn_cvt_pk_fp8_f32(p1[4 * v + 2], p1[4 * v + 3], w1, true);
    pa[v] = w0; pa[4 + v] = w1;
  }
}
__device__ __forceinline__ void att_unit(const bf16_t* __restrict__ Qb, const bf16_t* __restrict__ Kh, const unsigned char* __restrict__ V8, bf16_t* __restrict__ Ob,
                                         int nkeys, float lam, const float* __restrict__ ng, float oscale, unsigned char* lds) {
  int tid_ = tidx(); asm volatile("" : "+v"(tid_)); const int tid = tid_, wid = tid >> 6, lane = tid & 63, r32 = lane & 31, hi = lane >> 5;
  const int grp = __builtin_amdgcn_readfirstlane(wid >> 2);
  unsigned char* V_lds = lds; unsigned char* K_lds = lds + 2 * ATT_SHM_V;
  float* wsl = (float*)(lds + 2 * ATT_SHM_V + 2 * ATT_SHM_K) + wid * 64; float* li_l = wsl; float* al_l = wsl + 32;
  float m0 = 0.f, l0 = 0.f, m1 = 0.f, l1 = 0.f;
  f32x16 o0[4] = {}, o1[4] = {};
  unsigned char* Q_lds = lds + 2 * ATT_SHM_V + 2 * ATT_SHM_K + 2048;
#pragma unroll
  for (int i = 0; i < 8; ++i) { const int id = tid + 512 * i, qrw = id >> 4, ch = id & 15;
    *(bf16x8*)(Q_lds + KSWZ(qrw, ch * 16)) = *(const bf16x8*)(Qb + (size_t)qrw * PW + ch * 8); }
  const int qrow = wid * 32 + r32;
  int kso[2];
#pragma unroll
  for (int i = 0; i < 2; ++i) {
    const int o16 = tid + 512 * i;
    { const int row = o16 >> 4, cs = (o16 & 15) ^ (row & 15); kso[i] = row * PW + cs * 8; }
  }
  const unsigned ldsw = (unsigned)__builtin_amdgcn_readfirstlane(wid) * 1024u;
#define GSTAGE_K(b, k0) do { _Pragma("unroll") for (int i_ = 0; i_ < 2; ++i_) \
    __builtin_amdgcn_global_load_lds((const unsigned*)(Kh + (size_t)(k0) * PW + kso[i_]), (LAS unsigned*)(K_lds + (b) * ATT_SHM_K + ldsw + i_ * 8192), 16, 0, 0); } while (0)
#define GSTAGE_V(b, k0) do { const unsigned char* vi_ = V8 + (size_t)((k0) >> 6) * ATT_SHM_V + tid * 16; \
      __builtin_amdgcn_global_load_lds((const unsigned*)vi_, (LAS unsigned*)(V_lds + (b) * ATT_SHM_V + ldsw), 16, 0, 0); \
      if (wid < 2) __builtin_amdgcn_global_load_lds((const unsigned*)(vi_ + 8192), (LAS unsigned*)(V_lds + (b) * ATT_SHM_V + 8192 + ldsw), 16, 0, 0); } while (0)
#define STAGE_PAIR(jj) do { GSTAGE_V((jj) & 1, (jj) * 64); if ((jj) + 1 < NT) GSTAGE_K((jj) & 1, ((jj) + 1) * 64); } while (0)
#define RESC(o, a) do { if (__any((a) < 1.f)) { if (hi == 0) al_l[r32] = (a); asm volatile("s_waitcnt lgkmcnt(0)" ::: "memory"); \
    _Pragma("unroll") for (int d = 0; d < 4; ++d) _Pragma("unroll") for (int r = 0; r < 16; ++r) o[d][r] *= al_l[crow(r, hi)]; } } while (0)
#define ATT_BAR() do { asm volatile("s_waitcnt lgkmcnt(0)" ::: "memory"); __builtin_amdgcn_s_barrier(); asm volatile("" ::: "memory"); } while (0)
  const int NT = nkeys / 64;
  GSTAGE_K(1, 0); STAGE_PAIR(0);
  asm volatile("s_waitcnt vmcnt(0)" ::: "memory"); __syncthreads();
  f32x16 p0, p1, q0, q1; i32x8 pa, pb;
  const LAS unsigned char* l3 = (const LAS unsigned char*)lds;
  const int ak0 = r32 * 256 + ((hi * 16) ^ ((r32 & 15) << 4));
  const int kofs0 = 2 * ATT_SHM_V, qofs0 = 2 * ATT_SHM_V + 2 * ATT_SHM_K + 2048 + __builtin_amdgcn_readfirstlane(wid) * 8192;
  { KQFrag f0; att_ldkq(f0, l3, ak0, kofs0 + ATT_SHM_K, qofs0);
    att_qk_all(p0, p1, q0, q1, f0, l3, ak0, kofs0 + ATT_SHM_K, qofs0, 0.f, 0.f); }
  if (grp) ATT_BAR();
#pragma unroll 1
  for (int j = 0; j < NT; ++j) {
    const int cur = j & 1;
    const bool more = (j + 1 < NT);
    if (grp && more) STAGE_PAIR(j + 1);
    { float alphaA, alphaB;
      const bool first = (j == 0);
      att_softmax(p0, p1, m0, l0, alphaA, first, pa); SBAR();
      att_softmax(q0, q1, m1, l1, alphaB, first, pb); SBAR();
      RESC(o0, alphaA);
      RESC(o1, alphaB); }
    asm volatile("" : "+v"(pa), "+v"(pb), "+v"(m0), "+v"(l0), "+v"(m1), "+v"(l1));
    asm volatile("" : "+v"(o0[0]), "+v"(o0[1]), "+v"(o0[2]), "+v"(o0[3]), "+v"(o1[0]), "+v"(o1[1]), "+v"(o1[2]), "+v"(o1[3]));
    if (!grp) asm volatile("s_waitcnt vmcnt(0)" ::: "memory");
    ATT_BAR();
    if (!grp && more) STAGE_PAIR(j + 1);
    __builtin_amdgcn_s_setprio(1);
    {
      int kofs = kofs0 + cur * ATT_SHM_K, qofs = qofs0, ak = ak0; asm volatile("" : "+s"(kofs), "+s"(qofs), "+v"(ak));
      const LAS unsigned char* vrow = l3 + (r32 * 80 + hi * 32 + cur * ATT_SHM_V);
      u32x4 va0 = *(const LAS u32x4*)vrow, va1 = *(const LAS u32x4*)(vrow + 16), vb0, vb1;
      KQFrag f0;
#define ATT_PV(d0_, x0_, x1_) do { i32x8 bv; bv[0] = (int)x0_.x; bv[1] = (int)x0_.y; bv[2] = (int)x0_.z; bv[3] = (int)x0_.w; bv[4] = (int)x1_.x; bv[5] = (int)x1_.y; bv[6] = (int)x1_.z; bv[7] = (int)x1_.w; \
        o0[d0_] = __builtin_amdgcn_mfma_scale_f32_32x32x64_f8f6f4(pa, bv, o0[d0_], 0, 0, 0, 0x7F7F7F7F, 0, 0x7F7F7F7F); \
        o1[d0_] = __builtin_amdgcn_mfma_scale_f32_32x32x64_f8f6f4(pb, bv, o1[d0_], 0, 0, 0, 0x7F7F7F7F, 0, 0x7F7F7F7F); } while (0)
      vb0 = *(const LAS u32x4*)(vrow + 32 * 80); vb1 = *(const LAS u32x4*)(vrow + 32 * 80 + 16); ATT_PV(0, va0, va1); SBAR();
      va0 = *(const LAS u32x4*)(vrow + 64 * 80); va1 = *(const LAS u32x4*)(vrow + 64 * 80 + 16); ATT_PV(1, vb0, vb1); SBAR();
      vb0 = *(const LAS u32x4*)(vrow + 96 * 80); vb1 = *(const LAS u32x4*)(vrow + 96 * 80 + 16); ATT_PV(2, va0, va1); SBAR();
      att_ldkq(f0, l3, ak, kofs, qofs);
      ATT_PV(3, vb0, vb1); SBAR();
#undef ATT_PV
      asm volatile("" : "+v"(o0[0]), "+v"(o0[1]), "+v"(o0[2]), "+v"(o0[3]), "+v"(o1[0]), "+v"(o1[1]), "+v"(o1[2]), "+v"(o1[3]));
      att_qk_all(p0, p1, q0, q1, f0, l3, ak, kofs, qofs, -m0, -m1);
      asm volatile("" : "+v"(p0), "+v"(p1), "+v"(q0), "+v"(q1));
    }
    __builtin_amdgcn_s_setprio(0);
    if (grp) asm volatile("s_waitcnt vmcnt(0)" ::: "memory");
    ATT_BAR();
  }
  if (!grp) ATT_BAR();
  if (hi == 0) { li_l[r32] = 1.f / l0; al_l[r32] = lam / l1; }
  asm volatile("s_waitcnt lgkmcnt(0)" ::: "memory");
  float ss[16];
#pragma unroll
  for (int r = 0; r < 16; ++r) {
    const float a = li_l[crow(r, hi)], bq = al_l[crow(r, hi)];
    float s = 0.f;
#pragma unroll
    for (int d = 0; d < 4; ++d) { const float v = o0[d][r] * a - o1[d][r] * bq; o0[d][r] = v; s += v * v; }
    s += dpp_mov<0xB1>(s); s += dpp_mov<0x4E>(s); s += dpp_mov<0x141>(s); s += dpp_mov<0x140>(s);
    { auto rr_ = __builtin_amdgcn_permlane16_swap(__float_as_uint(s), __float_as_uint(s), false, false); s = __uint_as_float(rr_[0]) + __uint_as_float(rr_[1]); }
    ss[r] = rsqrtf(s * (1.f / 128.f) + EPS) * oscale;
  }
  bf16_t* Ow = Ob + (size_t)(wid * 32) * DM;
#pragma unroll
  for (int d = 0; d < 4; ++d) {
    const float g = ng[d * 32 + r32];
#pragma unroll
    for (int r = 0; r < 16; ++r) Ow[(size_t)crow(r, hi) * DM + d * 32 + r32] = (ABL & 4) ? (bf16_t)0 : (bf16_t)(cvtpk(o0[d][r] * ss[r] * g, 0.f) & 0xffffu);
  }
  __syncthreads();
#undef GSTAGE_K
#undef GSTAGE_V
#undef STAGE_PAIR
#undef RESC
#undef ATT_BAR
}

__device__ __forceinline__ float ins16(float (&a)[16], float x) {
#pragma unroll
  for (int i = 0; i < 16; ++i) { const float h = fmaxf(a[i], x); x = fminf(a[i], x); a[i] = h; }
  return x;
}
__device__ __forceinline__ void bsort16(float (&a)[16]) {
#pragma unroll
  for (int k = 2; k <= 16; k <<= 1)
#pragma unroll
    for (int j = k >> 1; j > 0; j >>= 1)
#pragma unroll
      for (int i = 0; i < 16; ++i) {
        const int q = i ^ j;
        if (q > i) {
          const bool desc = ((i & k) == 0);
          const float hi_ = fmaxf(a[i], a[q]), lo_ = fminf(a[i], a[q]);
          a[i] = desc ? hi_ : lo_; a[q] = desc ? lo_ : hi_;
        }
      }
}
__device__ __forceinline__ void bmerge16(float (&a)[16], const float (&b)[16]) {
#pragma unroll
  for (int i = 0; i < 16; ++i) a[i] = fmaxf(a[i], b[15 - i]);
#pragma unroll
  for (int j = 8; j > 0; j >>= 1)
#pragma unroll
    for (int i = 0; i < 16; ++i) {
      const int q = i ^ j;
      if (q > i) { const float hi_ = fmaxf(a[i], a[q]), lo_ = fminf(a[i], a[q]); a[i] = hi_; a[q] = lo_; }
    }
}
__device__ __forceinline__ float gelu_erf(float x) { return 0.5f * x * (1.f + erff(x * 0.70710678118654752440f)); }
#define XB_TMO      128
#define XB_XCNT(j)  (256  + 64 * (j))
#define XB_XSUB(j)  (1280 + 64 * (j))
#define XB_XGEN(j)  (2304 + 64 * (j))
#define XB_TOP      3328
#define XB_TOPGEN   3392
#define XCD_BAR_WORDS 3456
#define XB_SPIN_CAP (1u << 22)
__device__ __forceinline__ unsigned xb_ld(unsigned* p)              { return __hip_atomic_load(p, __ATOMIC_RELAXED, __HIP_MEMORY_SCOPE_AGENT); }
__device__ __forceinline__ unsigned xb_add(unsigned* p, unsigned v) { return __hip_atomic_fetch_add(p, v, __ATOMIC_RELAXED, __HIP_MEMORY_SCOPE_AGENT); }
__device__ __forceinline__ unsigned xb_xcc_id() { return (unsigned)__builtin_amdgcn_s_getreg((3 << 11) | 20) & 0xFu; }
#define XB_SPIN(cond, bar) do { unsigned _sp = 0; while (cond) { __builtin_amdgcn_s_sleep(1); \
    if ((++_sp & 255u) == 0u) { if (xb_ld(&(bar)[XB_TMO])) break; if (_sp > XB_SPIN_CAP) { atomicAdd(&(bar)[XB_TMO], 1u); break; } } } } while (0)
struct XcdBarrier { unsigned* bar; unsigned x; volatile LAS unsigned* st; };
__device__ __forceinline__ XcdBarrier xcd_barrier_post(unsigned* bar, volatile LAS unsigned* st) {
  XcdBarrier b; b.bar = bar; b.x = xb_xcc_id(); b.st = st;
  if (tidx() == 0) (void)xb_add(&bar[XB_XCNT(b.x)], 1u);
  return b;
}
__device__ __forceinline__ void xcd_barrier_complete(unsigned* bar, unsigned x, unsigned& nloc, unsigned& nx) {
  const unsigned G = gridDim.x * gridDim.y * gridDim.z;
  unsigned sum, cnt, mine, sp = 0u;
  for (;;) {
    sum = 0u; cnt = 0u; mine = 0u;
#pragma unroll
    for (unsigned j = 0; j < 16; ++j) { const unsigned c = xb_ld(&bar[XB_XCNT(j)]); sum += c; cnt += (c > 0u) ? 1u : 0u; mine = (j == x) ? c : mine; }
    if (sum == G) break;
    __builtin_amdgcn_s_sleep(1);
    if ((++sp & 255u) == 0u) { if (xb_ld(&bar[XB_TMO])) break; if (sp > XB_SPIN_CAP) { atomicAdd(&bar[XB_TMO], 1u); break; } }
  }
  nloc = mine > 0u ? mine : 1u; nx = cnt > 0u ? cnt : 1u;
}
__device__ __forceinline__ void xcd_barrier(const XcdBarrier& b) {
  asm volatile("s_waitcnt vmcnt(0)" ::: "memory");
  __syncthreads();
  if (tidx() == 0) {
    unsigned* bar = b.bar;
    __builtin_amdgcn_s_waitcnt(0);
    unsigned nloc = b.st[0], nx = b.st[1];
    if (nloc == 0u) { xcd_barrier_complete(bar, b.x, nloc, nx); b.st[0] = nloc; b.st[1] = nx; }
    const unsigned old = xb_add(&bar[XB_XSUB(b.x)], 1u);
    const unsigned gen = old / nloc;
    if (old + 1u == (gen + 1u) * nloc) {
      __builtin_amdgcn_fence(__ATOMIC_RELEASE, "agent");
      asm volatile("s_waitcnt vmcnt(0)" ::: "memory");
      const unsigned og = xb_add(&bar[XB_TOP], 1u);
      const unsigned tg = og / nx;
      if (og + 1u == (tg + 1u) * nx) xb_add(&bar[XB_TOPGEN], 1u);
      else XB_SPIN(xb_ld(&bar[XB_TOPGEN]) == tg, bar);
      __builtin_amdgcn_fence(__ATOMIC_ACQUIRE, "agent");
      xb_add(&bar[XB_XGEN(b.x)], 1u);
      asm volatile("s_waitcnt vmcnt(0)" ::: "memory");
    } else {
      XB_SPIN(xb_ld(&bar[XB_XGEN(b.x)]) == gen, bar);
      __builtin_amdgcn_fence(__ATOMIC_ACQUIRE, "agent");
      asm volatile("s_waitcnt vmcnt(0)" ::: "memory");
    }
  }
  __syncthreads();
}

constexpr size_t RT_STRIDE = (size_t)T * 128 * 4;
__device__ __forceinline__ void route_unit(const Params& p, int l, int unit, unsigned char* lds) {
  int tid_ = tidx(); asm volatile("" : "+v"(tid_)); const int tid = tid_, lane = tid & 63, wid = tid >> 6, r32 = lane & 31, hi = lane >> 5;
  unsigned char* IDX = lds;
  int* UE = (int*)(lds + 8192); float* UG = (float*)(lds + 8192 + 16384); float* US = (float*)(lds + 8192 + 32768);
  int* EIDG = (int*)(p.ws + WS_EID + (size_t)l * RT_STRIDE); float* GWG = (float*)(p.ws + WS_ULOC + RT_STRIDE); float* SUG = (float*)(p.ws + WS_ULOC + 2 * RT_STRIDE);
  const float* PSC = (const float*)(p.ws + WS_PSC);
  const int row0 = unit * 32;
  const bf16_t* QP = (const bf16_t*)(p.ws + WS_PROJ);
  const bf16_t* KEYS = (const bf16_t*)(p.ws + WS_KEYS) + (size_t)l * 131072;
  for (int rrep = 0; rrep < REP_ROUTE; ++rrep) {
    const int h = wid;
    float top[2][16];
#pragma unroll
    for (int pp = 0; pp < 2; ++pp) {
      const bf16_t* qrow = QP + (size_t)(row0 + r32) * DM + h * 128 + pp * 64 + hi * 8;
      const bf16_t* kb = KEYS + ((size_t)(h * 2 + pp) * 128 + r32) * 64 + hi * 8;
      bf16x8 bq[4];
#pragma unroll
      for (int ks = 0; ks < 4; ++ks) bq[ks] = *(const bf16x8*)(qrow + ks * 16);
      float (&lst)[16] = top[pp];
#pragma unroll
      for (int i = 0; i < 16; ++i) lst[i] = -INFINITY;
#pragma unroll
      for (int nt = 0; nt < 4; ++nt) {
        f32x16 acc = {};
#pragma unroll
        for (int ks = 0; ks < 4; ++ks) {
          const bf16x8 ak = *(const bf16x8*)(kb + (size_t)nt * 32 * 64 + ks * 16);
          acc = __builtin_amdgcn_mfma_f32_32x32x16_bf16(ak, bq[ks], acc, 0, 0, 0);
        }
        float grp[16];
#pragma unroll
        for (int r = 0; r < 16; ++r) grp[r] = __uint_as_float((__float_as_uint(acc[r]) & ~0x7Fu) | (unsigned)(nt * 32 + crow(r, hi)));
        bsort16(grp);
        if (nt == 0) {
#pragma unroll
          for (int i = 0; i < 16; ++i) lst[i] = grp[i];
        } else bmerge16(lst, grp);
        SBAR();
      }
      float oth[16];
#pragma unroll
      for (int i = 0; i < 16; ++i) { auto rr_ = __builtin_amdgcn_permlane32_swap(__float_as_uint(lst[i]), __float_as_uint(lst[i]), false, false); oth[i] = __uint_as_float(hi ? rr_[0] : rr_[1]); }
      bmerge16(lst, oth);
      if (hi == 0) {
        unsigned w[4];
#pragma unroll
        for (int i = 0; i < 4; ++i)
          w[i] = (__float_as_uint(lst[4 * i]) & 0x7Fu) | ((__float_as_uint(lst[4 * i + 1]) & 0x7Fu) << 8) | ((__float_as_uint(lst[4 * i + 2]) & 0x7Fu) << 16) | ((__float_as_uint(lst[4 * i + 3]) & 0x7Fu) << 24);
        *(u32x4*)(IDX + ((r32 * 8 + h) * 2 + pp) * 16) = (u32x4){w[0], w[1], w[2], w[3]};
      }
    }
    float best[16];
#define CAND(i, j) __uint_as_float((__float_as_uint(__uint_as_float(__float_as_uint(top[0][i]) & ~0x7Fu) + __uint_as_float(__float_as_uint(top[1][j]) & ~0x7Fu)) & ~0xFFu) | (unsigned)((i) * 16 + (j)))
    {
#pragma unroll
      for (int j = 0; j < 16; ++j) best[j] = CAND(0, j);
      float y[16];
#pragma unroll
      for (int j = 0; j < 8; ++j) { y[j] = CAND(1, j); y[8 + j] = CAND(15 - j, 0); }
#pragma unroll
      for (int jj = 8; jj > 0; jj >>= 1)
#pragma unroll
        for (int i = 0; i < 16; ++i) { const int q = i ^ jj; if (q > i) { const float hi_ = fmaxf(y[i], y[q]), lo_ = fminf(y[i], y[q]); y[i] = hi_; y[q] = lo_; } }
      bmerge16(best, y);
      float x[16];
      x[0] = CAND(2, 0); x[1] = CAND(2, 1); x[2] = CAND(2, 2); x[3] = CAND(2, 3); x[4] = CAND(2, 4);
      x[5] = CAND(3, 0); x[6] = CAND(3, 1); x[7] = CAND(3, 2); x[8] = CAND(3, 3);
      x[9] = CAND(4, 0); x[10] = CAND(4, 1); x[11] = CAND(4, 2);
      x[12] = CAND(5, 0); x[13] = CAND(5, 1); x[14] = CAND(6, 0); x[15] = CAND(6, 1);
      bsort16(x);
      bmerge16(best, x);
      ins16(best, CAND(7, 0)); ins16(best, CAND(7, 1));
    }
#undef CAND
    asm volatile("s_waitcnt lgkmcnt(0)" ::: "memory");
    if (hi == 0) {
      const unsigned char* ib = IDX + ((r32 * 8 + h) * 2) * 16;
      const float mx = __uint_as_float(__float_as_uint(best[0]) & ~0xFFu);
      float w[16]; float sum = 0.f;
#pragma unroll
      for (int k = 0; k < 16; ++k) { w[k] = __expf(__uint_as_float(__float_as_uint(best[k]) & ~0xFFu) - mx); sum += w[k]; }
      const float rsum = 1.f / sum;
      int ee[16]; float su_[16], sv_[16];
#pragma unroll
      for (int k = 0; k < 16; ++k) {
        const unsigned ij = __float_as_uint(best[k]) & 0xFFu;
        ee[k] = (int)ib[ij >> 4] * 128 + (int)ib[16 + (ij & 15)];
      }
#pragma unroll
      for (int k = 0; k < 16; ++k) { su_[k] = PSC[(size_t)l * NEXP + ee[k]]; sv_[k] = PSC[(size_t)(DEPTH + l) * NEXP + ee[k]]; }
#pragma unroll
      for (int k = 0; k < 16; ++k) {
        UE[r32 * 128 + h * 16 + k] = ee[k]; UG[r32 * 128 + h * 16 + k] = w[k] * rsum * sv_[k];
        US[r32 * 128 + h * 16 + k] = su_[k];
      }
    }
  }
  __syncthreads();
#pragma unroll 1
  for (int tt = 0; tt < 4; ++tt) {
    const int t = wid * 4 + tt;
    const int k0 = UE[t * 128 + lane], k1 = UE[t * 128 + 64 + lane];
    const float g0 = UG[t * 128 + lane], g1 = UG[t * 128 + 64 + lane], s0 = US[t * 128 + lane], s1 = US[t * 128 + 64 + lane];
    const int b0 = k0 >> 10, b1 = k1 >> 10;
    int base = 0, pos0 = 0, pos1 = 0;
#pragma unroll
    for (int b = 0; b < 16; ++b) {
      const unsigned long long m0 = __ballot(b0 == b), m1 = __ballot(b1 == b);
      const int c0 = __popcll(m0), c1 = __popcll(m1);
      const unsigned long long lt = (1ull << lane) - 1ull;
      if (b0 == b) pos0 = base + __popcll(m0 & lt);
      if (b1 == b) pos1 = base + c0 + __popcll(m1 & lt);
      base += c0 + c1;
    }
    const size_t ro = (size_t)(row0 + t) * 128;
    EIDG[ro + pos0] = k0; GWG[ro + pos0] = g0; SUG[ro + pos0] = s0;
    EIDG[ro + pos1] = k1; GWG[ro + pos1] = g1; SUG[ro + pos1] = s1;
  }
}
#define CAS __attribute__((address_space(4)))
typedef int i32x8 __attribute__((ext_vector_type(8)));
struct TokPref { f32x2 gs0, gs1; u32x4 hA, hB; };
struct RowPipe { i32x6 uq[4], vq[4]; i32x8 Ec; };
__device__ __forceinline__ const CAS i32x8* eid_row(const CAS unsigned char* eidg, int row) {
  return (const CAS i32x8*)(eidg + (size_t)(unsigned)__builtin_amdgcn_readfirstlane(row) * 512u);
}
__device__ __forceinline__ void tok_prefetch(const Params& p, int row, int lane, TokPref& t) {
  const float* GWG = (const float*)(p.ws + WS_ULOC + RT_STRIDE) + (size_t)row * 128;
  const float* SUG = (const float*)(p.ws + WS_ULOC + 2 * RT_STRIDE) + (size_t)row * 128;
  const bf16_t* H = (const bf16_t*)(p.ws + WS_H);
  t.gs0 = f32x2{GWG[lane], SUG[lane]}; t.gs1 = f32x2{GWG[64 + lane], SUG[64 + lane]};
  t.hA = *(const u32x4*)(H + (size_t)row * DM + lane * 16); t.hB = *(const u32x4*)(H + (size_t)row * DM + lane * 16 + 8);
}
#define LOADPAIR(dst_, tofs_, ea_, eb_) do { const u32x3v a_ = __builtin_amdgcn_raw_buffer_load_b96(rsT, lane12, (ea_) * PROW + (tofs_), 0); const unsigned b0_ = __builtin_amdgcn_raw_buffer_load_b32(rsT, lane12, (eb_) * PROW + (tofs_), 0); \
      const u32x2v b1_ = __builtin_amdgcn_raw_buffer_load_b64(rsT, lane12 + 4, (eb_) * PROW + (tofs_), 0); \
      dst_[0] = (int)a_.x; dst_[1] = (int)a_.y; dst_[2] = (int)a_.z; dst_[3] = (int)b0_; dst_[4] = (int)b1_.x; dst_[5] = (int)b1_.y; } while (0)
#define LOADGROUP(q_, tofs_, E_) do { LOADPAIR(q_[0], tofs_, E_[0], E_[1]); LOADPAIR(q_[1], tofs_, E_[2], E_[3]); LOADPAIR(q_[2], tofs_, E_[4], E_[5]); LOADPAIR(q_[3], tofs_, E_[6], E_[7]); } while (0)
constexpr int VOFS = (int)(WS_PV - WS_PU);
__device__ __forceinline__ void gather_token(const Params& p, const CAS unsigned char* eidg, const __amdgpu_buffer_rsrc_t rsT, int l, int row, int nextrow, TokPref& tp, RowPipe& rp, unsigned char* lds, int lane, int wid) {
  f32x2* GS = (f32x2*)(lds + wid * 2048);
  float* XC = (float*)(p.ws + WS_XCUR);
  const float* MOD = (const float*)(p.ws + WS_MOD);
  const CAS i32x8* EP = eid_row(eidg, row);
  const bool hasnext = nextrow >= 0;
  const CAS i32x8* EPn = eid_row(eidg, hasnext ? nextrow : row);
  GS[lane] = tp.gs0; GS[64 + lane] = tp.gs1;
  asm volatile("s_waitcnt lgkmcnt(0)" ::: "memory");
  const int eofl = ((lane >> 5) & 1) + 2 * ((lane >> 4) & 1) + 4 * ((lane >> 3) & 1);
  const int lane12 = lane * 12;
  {
    h16x2 hh[8];
    {
      const u32x4 hA = tp.hA, hB = tp.hB;
      hh[0] = __builtin_bit_cast(h16x2, __builtin_amdgcn_cvt_pkrtz(bflo(hA.x), bfhi(hA.x))); hh[1] = __builtin_bit_cast(h16x2, __builtin_amdgcn_cvt_pkrtz(bflo(hA.y), bfhi(hA.y))); hh[2] = __builtin_bit_cast(h16x2, __builtin_amdgcn_cvt_pkrtz(bflo(hA.z), bfhi(hA.z))); hh[3] = __builtin_bit_cast(h16x2, __builtin_amdgcn_cvt_pkrtz(bflo(hA.w), bfhi(hA.w)));
      hh[4] = __builtin_bit_cast(h16x2, __builtin_amdgcn_cvt_pkrtz(bflo(hB.x), bfhi(hB.x))); hh[5] = __builtin_bit_cast(h16x2, __builtin_amdgcn_cvt_pkrtz(bflo(hB.y), bfhi(hB.y))); hh[6] = __builtin_bit_cast(h16x2, __builtin_amdgcn_cvt_pkrtz(bflo(hB.z), bfhi(hB.z))); hh[7] = __builtin_bit_cast(h16x2, __builtin_amdgcn_cvt_pkrtz(bflo(hB.w), bfhi(hB.w)));
    }
    if (hasnext) tok_prefetch(p, nextrow, lane, tp);
    f32x4 xpre[4];
    { const float* xr_ = XC + (size_t)row * DM + lane * 16;
#pragma unroll
      for (int v4 = 0; v4 < 4; ++v4) xpre[v4] = *(const f32x4*)(xr_ + v4 * 4); }
    f32x2 acc2[8];
#pragma unroll
    for (int i = 0; i < 8; ++i) acc2[i] = f32x2{0.f, 0.f};
#pragma unroll 1
    for (int g8 = 0; g8 < 16; ++g8) {
      const bool pf = (g8 < 15) || hasnext;
      const f32x2 gs = GS[g8 * 8 + eofl];
      float d[8];
#pragma unroll
      for (int i2 = 0; i2 < 4; ++i2) {
        const h16x32 r = __builtin_amdgcn_cvt_scalef32_pk32_f16_fp6(rp.uq[i2], 1.0f);
        float a0 = 0.f, a1 = 0.f, b0 = 0.f, b1 = 0.f;
#define UDOT(k_) a0 = __builtin_amdgcn_fdot2(__builtin_shufflevector(r, r, 4 * (k_), 4 * (k_) + 1), hh[2 * (k_)], a0, false); b0 = __builtin_amdgcn_fdot2(__builtin_shufflevector(r, r, 16 + 4 * (k_), 17 + 4 * (k_)), hh[2 * (k_)], b0, false); \
        a1 = __builtin_amdgcn_fdot2(__builtin_shufflevector(r, r, 4 * (k_) + 2, 4 * (k_) + 3), hh[2 * (k_) + 1], a1, false); b1 = __builtin_amdgcn_fdot2(__builtin_shufflevector(r, r, 18 + 4 * (k_), 19 + 4 * (k_)), hh[2 * (k_) + 1], b1, false);
        UDOT(0) UDOT(1) UDOT(2) UDOT(3)
#undef UDOT
        d[2 * i2] = a0 + a1;
        d[2 * i2 + 1] = b0 + b1;
        asm volatile("" : "+v"(d[2 * i2]), "+v"(d[2 * i2 + 1]));
      }
      if (pf) LOADGROUP(rp.uq, 0, rp.Ec);
      float tot;
      {
        auto s01 = __builtin_amdgcn_permlane32_swap(__float_as_uint(d[0]), __float_as_uint(d[1]), false, false);
        auto s23 = __builtin_amdgcn_permlane32_swap(__float_as_uint(d[2]), __float_as_uint(d[3]), false, false);
        auto s45 = __builtin_amdgcn_permlane32_swap(__float_as_uint(d[4]), __float_as_uint(d[5]), false, false);
        auto s67 = __builtin_amdgcn_permlane32_swap(__float_as_uint(d[6]), __float_as_uint(d[7]), false, false);
        const float q01 = __uint_as_float(s01[0]) + __uint_as_float(s01[1]), q23 = __uint_as_float(s23[0]) + __uint_as_float(s23[1]);
        const float q45 = __uint_as_float(s45[0]) + __uint_as_float(s45[1]), q67 = __uint_as_float(s67[0]) + __uint_as_float(s67[1]);
        auto ta = __builtin_amdgcn_permlane16_swap(__float_as_uint(q01), __float_as_uint(q23), false, false);
        auto tb = __builtin_amdgcn_permlane16_swap(__float_as_uint(q45), __float_as_uint(q67), false, false);
        const float r0123 = __uint_as_float(ta[0]) + __uint_as_float(ta[1]);
        const float r4567 = __uint_as_float(tb[0]) + __uint_as_float(tb[1]);
        const bool b3 = (lane & 8) != 0;
        const float keep = b3 ? r4567 : r0123, send = b3 ? r0123 : r4567;
        float x = keep + dpp_mov<0x140>(send);
        x += dpp_mov<0xB1>(x); x += dpp_mov<0x4E>(x); x += dpp_mov<0x141>(x);
        tot = x * gs.y;
      }
      float ge;
      {
        const float v = tot, av = fabsf(v), tq = __builtin_amdgcn_rcpf(av * 0.2316418882f + 1.0f);
        float q = tq * 0.5307027145f + (-0.7265760135f); q = q * tq + 0.7107068705f; q = q * tq + (-0.142248368f); q = q * tq + 0.127414796f; q = q * tq;
        const float ex = __builtin_amdgcn_exp2f(v * v * (-0.72134752044f));
        const float m = v * (q * ex), r = v - m;
        ge = (v < 0.f ? m : r) * gs.x;
      }
      unsigned cw[8];
      { const unsigned gp = __builtin_bit_cast(unsigned, __builtin_amdgcn_cvt_pkrtz(ge * 1024.f, ge * 1024.f));
        cw[0] = (unsigned)__builtin_amdgcn_readlane((int)gp, 0);  cw[4] = (unsigned)__builtin_amdgcn_readlane((int)gp, 8);
        cw[2] = (unsigned)__builtin_amdgcn_readlane((int)gp, 16); cw[6] = (unsigned)__builtin_amdgcn_readlane((int)gp, 24);
        cw[1] = (unsigned)__builtin_amdgcn_readlane((int)gp, 32); cw[5] = (unsigned)__builtin_amdgcn_readlane((int)gp, 40);
        cw[3] = (unsigned)__builtin_amdgcn_readlane((int)gp, 48); cw[7] = (unsigned)__builtin_amdgcn_readlane((int)gp, 56); }
      h16x2 a16[8];
#pragma unroll
      for (int i2 = 0; i2 < 4; ++i2) {
        const h16x32 r = __builtin_amdgcn_cvt_scalef32_pk32_f16_fp6(rp.vq[i2], 1.0f);
        const h16x2 ca = __builtin_bit_cast(h16x2, cw[2 * i2]), cb = __builtin_bit_cast(h16x2, cw[2 * i2 + 1]);
#define VAXL(k_) a16[k_] = (i2 == 0) ? ca * __builtin_shufflevector(r, r, 2 * (k_), 2 * (k_) + 1) : ca * __builtin_shufflevector(r, r, 2 * (k_), 2 * (k_) + 1) + a16[k_];
#define VAXH(k_) a16[k_] = cb * __builtin_shufflevector(r, r, 16 + 2 * (k_), 17 + 2 * (k_)) + a16[k_];
        VAXL(0) VAXL(1) VAXL(2) VAXL(3) VAXL(4) VAXL(5) VAXL(6) VAXL(7)
        asm volatile("" : "+v"(a16[0]), "+v"(a16[1]), "+v"(a16[2]), "+v"(a16[3]), "+v"(a16[4]), "+v"(a16[5]), "+v"(a16[6]), "+v"(a16[7]));
        VAXH(0) VAXH(1) VAXH(2) VAXH(3) VAXH(4) VAXH(5) VAXH(6) VAXH(7)
#undef VAXL
#undef VAXH
        asm volatile("" : "+v"(a16[0]), "+v"(a16[1]), "+v"(a16[2]), "+v"(a16[3]), "+v"(a16[4]), "+v"(a16[5]), "+v"(a16[6]), "+v"(a16[7]));
      }
#pragma unroll
      for (int k = 0; k < 8; ++k) acc2[k] = f32x2{(float)a16[k].x, (float)a16[k].y} * f32x2{1.f / 1024.f, 1.f / 1024.f} + acc2[k];
      if (pf) LOADGROUP(rp.vq, VOFS, rp.Ec);
      { const CAS i32x8* src_ = g8 < 14 ? EP + (g8 + 2) : EPn + (g8 - 14); rp.Ec = *src_; }
    }
    SBAR();
    float acc[16];
#pragma unroll
    for (int i = 0; i < 8; ++i) { acc[2 * i] = acc2[i].x; acc[2 * i + 1] = acc2[i].y; }
    const int mr = mod_row(row);
    const float* g2 = MOD + ((size_t)l * 5 + mr) * 6144 + 5 * 1024;
    float* xr = XC + (size_t)row * DM;
    float xn[16]; float ssq = 0.f;
    if (ABL & 8) {
#pragma unroll
      for (int i = 0; i < 16; ++i) acc[i] = 0.f;
    }
#pragma unroll
    for (int v4 = 0; v4 < 4; ++v4) {
      const int c = lane * 16 + v4 * 4;
      const f32x4 xo = xpre[v4], gg = *(const f32x4*)(g2 + c);
      f32x4 o;
      o.x = xo.x + gg.x * acc[v4 * 4 + 0]; o.y = xo.y + gg.y * acc[v4 * 4 + 1]; o.z = xo.z + gg.z * acc[v4 * 4 + 2]; o.w = xo.w + gg.w * acc[v4 * 4 + 3];
      xn[v4 * 4 + 0] = o.x; xn[v4 * 4 + 1] = o.y; xn[v4 * 4 + 2] = o.z; xn[v4 * 4 + 3] = o.w;
      ssq += (o.x * o.x + o.y * o.y) + (o.z * o.z + o.w * o.w);
      if (l < DEPTH - 1) *(f32x4*)(xr + c) = o;
    }
    const float rs = rsqrtf(wave_sum_fast(ssq) * (1.f / DM) + EPS);
    if (l == DEPTH - 1) {
      const int b = row / SEGL, s = row - b * SEGL;
      float* orow = p.out + ((size_t)(b * SEQ + (s - CTXL))) * DM;
      const float* fg = p.in[I_FINALG];
#pragma unroll
      for (int v4 = 0; v4 < 4; ++v4) {
        const int c = lane * 16 + v4 * 4;
        const f32x4 gg = *(const f32x4*)(fg + c);
        f32x4 o; o.x = xn[v4 * 4 + 0] * rs * gg.x; o.y = xn[v4 * 4 + 1] * rs * gg.y; o.z = xn[v4 * 4 + 2] * rs * gg.z; o.w = xn[v4 * 4 + 3] * rs * gg.w;
        *(f32x4*)(orow + c) = o;
      }
    } else {
      const float* m = MOD + ((size_t)(l + 1) * 5 + mr) * 6144;
      const float* ng = p.in[I_N1G] + (l + 1) * DM;
      bf16_t* hrow = (bf16_t*)(p.ws + WS_H) + (size_t)row * DM;
#pragma unroll
      for (int hh = 0; hh < 2; ++hh) {
        float y[8];
#pragma unroll
        for (int i = 0; i < 8; ++i) { const int c = lane * 16 + hh * 8 + i; y[i] = xn[hh * 8 + i] * rs * ng[c] * (1.f + m[1024 + c]) + m[c]; }
        u32x4 w; w.x = cvtpk(y[0], y[1]); w.y = cvtpk(y[2], y[3]); w.z = cvtpk(y[4], y[5]); w.w = cvtpk(y[6], y[7]);
        *(u32x4*)(hrow + lane * 16 + hh * 8) = w;
      }
    }
  }
}

__device__ __forceinline__ void ev_signal(unsigned* ctr) {
  asm volatile("s_waitcnt vmcnt(0)" ::: "memory");
  __syncthreads();
  if (tidx() == 0) { __builtin_amdgcn_fence(__ATOMIC_RELEASE, "agent"); asm volatile("s_waitcnt vmcnt(0)" ::: "memory"); (void)xb_add(ctr, 1u); }
}
__device__ __forceinline__ void ev_wait(unsigned* ctr, unsigned n, unsigned* bar) {
  if (tidx() == 0) {
    XB_SPIN(xb_ld(ctr) < n, bar);
    __builtin_amdgcn_fence(__ATOMIC_ACQUIRE, "agent");
    asm volatile("s_waitcnt vmcnt(0)" ::: "memory");
  }
  __syncthreads();
}
constexpr int EV_WORD0 = 8192;
__device__ __forceinline__ void phase_c1(const Params& p, int l, unsigned char* lds) {
  constexpr int NLOC = NBATCH * 4 * NCH, NCONV = T / 32;
  for (int u = p.bx; u < NLOC + NCONV; u += p.gx) {
    if (u < NLOC) ml_local_unit2(p, l, u, lds);
    else {
      const int cu = u - NLOC;
      if (l == DEPTH - 1 && (cu % (SEGL / 32)) < (CTXL / 32)) continue;
      conv_unit(p, l, cu, lds);
    }
  }
}
__device__ __forceinline__ void phase_c3(const Params& p, int l, unsigned char* lds);
__device__ __forceinline__ void phase_c2(const Params& p, int l, unsigned char* lds) {
  unsigned* ev = (unsigned*)(p.ws + WS_CTL) + EV_WORD0 + 64 * l;
  ml_scan(p, lds);
  ev_signal(ev);
  const float* lp = p.in[I_DLAM] + l * 256;
  float s01 = 0.f, s23 = 0.f;
  for (int i = 0; i < 64; ++i) { s01 += lp[i] * lp[64 + i]; s23 += lp[128 + i] * lp[192 + i]; }
  const float lam_init = 0.8f - 0.6f * expf(-0.3f * (float)l);
  const float lam = expf(s01) - expf(s23) + lam_init;
  const bf16_t* PROJ = (const bf16_t*)(p.ws + WS_PROJ);
  bf16_t* MIX = (bf16_t*)(p.ws + WS_MIX);
  const float* ng = p.in[I_DNORMG] + l * 128;
  const int nun = 512 + (l < DEPTH - 1 ? 16 : 0);
  for (int u = p.bx; u < nun; u += p.gx) {
    int bh, qrow, nkeys;
    if (u < 512) { const int xcd = u & 7, i = (u >> 3) & 31, rnd = u >> 8; bh = 2 * xcd + rnd; qrow = CTXL + i * 256; nkeys = SEGL; }
    else { bh = u - 512; qrow = 0; nkeys = CTXL; }
    const int b = bh >> 2, h = bh & 3;
    const size_t tok0 = (size_t)b * SEGL;
    for (int rep = 0; rep < REP_ATT; ++rep)
    att_unit(PROJ + (tok0 + qrow) * PW + C_DQ + h * 128, PROJ + tok0 * PW + C_DK + h * 128, p.ws + WS_V8T + (size_t)bh * NCH * ATT_SHM_V,
             MIX + (tok0 + qrow) * DM + 512 + h * 128, nkeys, lam, ng, 1.f - lam_init, lds);
  }
  ev_wait(ev, (unsigned)p.gx, p.xbar_words);
  for (int rep = 0; rep < REP_ML; ++rep) phase_c3(p, l, lds);
}
__device__ __forceinline__ void phase_c3(const Params& p, int l, unsigned char* lds) {
  constexpr int NU = NBATCH * 4 * NCH;
  for (int u = p.bx; u < NU; u += p.gx) {
    if (l == DEPTH - 1 && (u % NCH) < 4) continue;
    ml_out_unit2(p, l, u, lds);
  }
}
__device__ __forceinline__ void phase_route(const Params& p, int l, unsigned char* lds) {
  constexpr int NU = T / 32;
  for (int u = p.bx; u < NU; u += p.gx) {
    if (l == DEPTH - 1 && (u % (SEGL / 32)) < (CTXL / 32)) continue;
    route_unit(p, l, u, lds);
    __syncthreads();
  }
}
__device__ __forceinline__ void phase_gather(const Params& p, int l, unsigned char* lds) {
  int tid_ = tidx(); asm volatile("" : "+v"(tid_)); const int lane = tid_ & 63, wid = __builtin_amdgcn_readfirstlane(tid_ >> 6);
  const int gw = p.bx * 8 + wid, NGW = p.gx * 8;
  const int ntok = (l == DEPTH - 1) ? NBATCH * SEQ : T;
#define TOKROW(ti_) ((l == DEPTH - 1) ? ((ti_) / SEQ) * SEGL + CTXL + ((ti_) % SEQ) : (ti_))
  const CAS unsigned char* eidg = (const CAS unsigned char*)(p.ws + WS_EID + (size_t)l * RT_STRIDE);
  const __amdgpu_buffer_rsrc_t rsT = __builtin_amdgcn_make_buffer_rsrc((void*)(p.ws + WS_PU + (size_t)l * NEXP * PROW), 0, VOFS + NEXP * PROW, 0x00020000);
  TokPref tp; RowPipe rp;
  if (gw < ntok) {
    const int row0 = TOKROW(gw); const int lane12 = lane * 12;
    tok_prefetch(p, row0, lane, tp);
    const CAS i32x8* EP0 = eid_row(eidg, row0);
    rp.Ec = EP0[0];
    LOADGROUP(rp.uq, 0, rp.Ec); LOADGROUP(rp.vq, VOFS, rp.Ec);
    rp.Ec = EP0[1];
  }
  XcdBarrier xb; xb.bar = p.xbar_words; xb.x = p.xbar_x; xb.st = (volatile LAS unsigned*)((LAS unsigned char*)lds + p.lds_st_off);
  const int nrounds = (ntok + NGW - 1) / NGW;
  for (int r = 0; r < nrounds; ++r) {
    const int ti = gw + r * NGW;
    if (ti < ntok) {
      const int row = TOKROW(ti);
      const int nxt = ti + NGW < ntok ? TOKROW(ti + NGW) : -1;
      gather_token(p, eidg, rsT, l, row, nxt, tp, rp, lds, lane, wid);
    }
#if GATHER_SYNC
    if (r + 1 < nrounds) { XcdBarrier xb2 = xb; size_t zb_ = 0; asm volatile("" : "+s"(zb_)); xb2.bar = xb.bar + zb_; xb2.x = xb.x + (unsigned)zb_; xcd_barrier(xb2); }
#endif
  }
#undef TOKROW
}

__global__ void __launch_bounds__(512, 2) mk_fwd(KArgs ka) {
  cg::grid_group grid = cg::this_grid();
  extern __shared__ __attribute__((aligned(16))) unsigned char lds[];
  const int lo = ka.ph_lo, hi = ka.ph_hi;
#define IN(k) (lo <= (k) && (k) < hi)
#ifndef PHASEMASK
#define PHASEMASK 0xFFFF
#endif
#define PH(i) ((PHASEMASK >> (i)) & 1)
#define MKP(q) Params q; { size_t z_ = 0; asm volatile("" : "+s"(z_)); \
    q.in = (InTab)((const __attribute__((address_space(4))) char*)__builtin_amdgcn_kernarg_segment_ptr() + z_); \
    q.out = ka.out + z_; q.ws = ka.ws + z_; q.ph_lo = lo; q.ph_hi = hi; q.bx = (int)blockIdx.x + (int)z_; q.gx = (int)gridDim.x + (int)z_; q.xbar_words = xbar.bar + z_; q.xbar_x = xbar.x + (unsigned)z_; q.lds_st_off = (unsigned)(LDS_BYTES - 64); }
#define SEAM(k) do { if (IN(k) && IN((k) + 1)) { if ((k) == 0) grid.sync(); else { XcdBarrier xb_ = xbar; size_t zb_ = 0; asm volatile("" : "+s"(zb_)); xb_.bar = xbar.bar + zb_; xb_.x = xbar.x + (unsigned)zb_; xcd_barrier(xb_); } } } while (0)
  volatile LAS unsigned* xst = (volatile LAS unsigned*)((LAS unsigned char*)lds + (LDS_BYTES - 64));
  { const int t0_ = threadIdx.x;
    if (t0_ < 2) xst[t0_] = 0u;
    if ((t0_ & 63) == 0) *(volatile LAS int*)((LAS unsigned char*)lds + LDS_WTAB + 4 * hw_wave_key()) = t0_ >> 6; }
  __syncthreads();
  XcdBarrier xbar = xcd_barrier_post((unsigned*)(ka.ws + WS_CTL) + 4096, xst);
  { MKP(p)
    if (PH(0) && IN(0)) for (int rep = 0; rep < REP_MISC; ++rep) { p0_mod(p, lds, (float*)(p.ws + WS_MOD)); p0_convert(p, lds); }
  }
  SEAM(0);
  { MKP(p)
    if (PH(1) && IN(1)) phase_norm(p, 0, 0, true, false);
  }
  SEAM(1);
#define LAYER(LL) { \
    int l = (LL); asm volatile("" : "+s"(l)); \
    const int b = 2 + 9 * (LL); \
    { MKP(q) if (PH(2) && IN(b + 0)) for (int rep = 0; rep < REP_GEMM; ++rep) phase_inproj2(q, l, lds); } \
    SEAM(b + 0); \
    { MKP(q) if (PH(3) && IN(b + 1)) for (int rep = 0; rep < REP_ML; ++rep) phase_c1(q, l, lds); } \
    SEAM(b + 1); \
    { MKP(q) if (PH(4) && IN(b + 2)) phase_c2(q, l, lds); } \
    SEAM(b + 3); \
    { MKP(q) if (PH(6) && IN(b + 4)) phase_outproj2(q, l, lds); } \
    SEAM(b + 4); \
    { MKP(q) if (PH(7) && IN(b + 5)) for (int rep = 0; rep < REP_MISC; ++rep) phase_norm(q, l, 1, false, (LL) == DEPTH - 1); } \
    SEAM(b + 5); \
    { MKP(q) if (PH(8) && IN(b + 6)) for (int rep = 0; rep < REP_GEMM; ++rep) phase_peerq2(q, l, lds); } \
    SEAM(b + 6); \
    { MKP(q) if (PH(9) && IN(b + 7)) phase_route(q, l, lds); } \
    SEAM(b + 7); \
    { MKP(q) if (PH(9) && IN(b + 8)) phase_gather(q, l, lds); } \
    SEAM(b + 8); }
  LAYER(0) LAYER(1) LAYER(2) LAYER(3)
#undef LAYER
#undef IN
#undef SEAM
#undef MKP
}

extern "C" void kernel_launch(void* const* d_in, const int* in_sizes, int n_in, void* d_out, int out_size,
                              void* d_ws, size_t ws_size, hipStream_t stream) {
  static int grid = 0;
  if (grid == 0) {
    int dev = 0, cus = 0, per_cu = 0;
    (void)hipGetDevice(&dev);
    (void)hipDeviceGetAttribute(&cus, hipDeviceAttributeMultiprocessorCount, dev);
    (void)hipFuncSetAttribute((const void*)mk_fwd, hipFuncAttributeMaxDynamicSharedMemorySize, LDS_BYTES);
    (void)hipOccupancyMaxActiveBlocksPerMultiprocessor(&per_cu, (const void*)mk_fwd, 512, LDS_BYTES);
    fprintf(stderr, "kernel_launch: cus %d per_cu %d ws %zu (need %zu) n_in %d\n", cus, per_cu, ws_size, (size_t)WS_END, n_in);
    if (ws_size < WS_END || n_in != 23 || per_cu < 1) { fprintf(stderr, "kernel_launch: bad configuration, nothing launched\n"); grid = -1; return; }
    grid = cus;
  }
  if (grid < 0) return;
  (void)hipMemsetAsync((char*)d_ws + WS_CTL, 0, 65536, stream);
  KArgs p{};
  for (int i = 0; i < 23; ++i) p.in[i] = (const float*)d_in[i];
  p.out = (float*)d_out; p.ws = (unsigned char*)d_ws; p.ph_lo = 0; p.ph_hi = 38;
  void* args[] = {&p};
  hipError_t e = hipLaunchCooperativeKernel((const void*)mk_fwd, dim3(grid), dim3(512), args, LDS_BYTES, stream);
  if (e != hipSuccess) fprintf(stderr, "cooperative launch failed: %s (grid %d)\n", hipGetErrorString(e), grid);
}
```

```cpp
#include <hip/hip_runtime.h>
#include <hip/hip_cooperative_groups.h>
#include <cstdio>
#include <cstdint>
namespace cg = cooperative_groups;

constexpr int DM = 1024, NBATCH = 4, SEQ = 8192, CTXL = 256, SEGL = CTXL + SEQ, T = NBATCH * SEGL, DEPTH = 4;
constexpr int IN_W = 3088, PW = 3072;
constexpr int C_A = 0, C_MQ = 512, C_MK = 768, C_MV = 1024, C_MO = 1280, C_DQ = 1536, C_DK = 2048, C_DV = 2560;
constexpr int NCH = SEGL / 64;
constexpr int NEXP = 16384;
constexpr float EPS = 1e-6f;
#ifndef ABL
#define ABL 0
#endif
#ifndef GATHER_SYNC
#define GATHER_SYNC 0
#endif
#ifndef REP_ATT
#define REP_ATT 1
#endif
#ifndef GP_MASK
#define GP_MASK 0x3FFF
#endif
#ifndef REP_PEER
#define REP_PEER 1
#endif
#ifndef REP_GEMM
#define REP_GEMM 1
#endif
#ifndef REP_ROUTE
#define REP_ROUTE 1
#endif
#ifndef REP_OUTP
#define REP_OUTP 1
#endif
#ifndef REP_ML
#define REP_ML 1
#endif
#ifndef REP_MISC
#define REP_MISC 1
#endif
constexpr float QSCALE = 0.125f * 1.4426950408889634f;

constexpr size_t MiB = 1u << 20;
constexpr size_t WS_CTL = 0, WS_MOD = 1 * MiB, WS_ROPE = 2 * MiB, WS_WG = 4 * MiB, WS_KEYS = 5 * MiB, WS_MLMETA = 6 * MiB,
                 WS_GATES = 7 * MiB, WS_WIN = 10 * MiB, WS_WOUT = 34 * MiB, WS_WQ = 42 * MiB, WS_PU = 50 * MiB, WS_PV = 114 * MiB, WS_PSC = 178 * MiB  ,
                 WS_XCUR = 306 * MiB, WS_H = 438 * MiB, WS_MIX = 504 * MiB, WS_PROJ = 570 * MiB, WS_ULOC = 768 * MiB, WS_V8T = 836 * MiB  , WS_EID = 858 * MiB  , WS_END = 924 * MiB;
constexpr int USTRIDE = 4160;

constexpr int LDS_BYTES = 139264 + 512;
constexpr int LDS_WTAB = LDS_BYTES - 64 - 256;

#define LAS __attribute__((address_space(3)))
__device__ __forceinline__ int hw_wave_key() { return (int)(__builtin_amdgcn_s_getreg((5 << 11) | 4) & 63u); }
__device__ __forceinline__ int tidx() {
  extern __shared__ __attribute__((aligned(16))) unsigned char lds_dyn_[];
  const int w = __builtin_amdgcn_readfirstlane(*(const volatile LAS int*)((LAS unsigned char*)lds_dyn_ + LDS_WTAB + 4 * hw_wave_key()));
  unsigned z_ = 0u; asm volatile("" : "+v"(z_));
  return (w << 6) | (int)__builtin_amdgcn_mbcnt_hi(~0u, __builtin_amdgcn_mbcnt_lo(~0u, z_));
}
typedef unsigned short bf16_t;
typedef short bf16x8 __attribute__((ext_vector_type(8)));
typedef short s16x4 __attribute__((ext_vector_type(4)));
typedef float f32x4 __attribute__((ext_vector_type(4)));
typedef float f32x16 __attribute__((ext_vector_type(16)));
typedef unsigned u32x4 __attribute__((ext_vector_type(4)));
typedef unsigned u32x2 __attribute__((ext_vector_type(2)));
typedef __bf16 bf16x2v __attribute__((ext_vector_type(2)));
typedef int i32x8 __attribute__((ext_vector_type(8)));
typedef int i32x6 __attribute__((ext_vector_type(6)));
struct __attribute__((aligned(4))) u32x3 { unsigned x, y, z; };
typedef float f32x32 __attribute__((ext_vector_type(32)));
constexpr int PROW = 768;
typedef float f32x2 __attribute__((ext_vector_type(2)));
typedef _Float16 h16x2 __attribute__((ext_vector_type(2)));
typedef _Float16 h16x32 __attribute__((ext_vector_type(32)));
typedef unsigned u32x3v __attribute__((ext_vector_type(3)));
typedef unsigned u32x2v __attribute__((ext_vector_type(2)));

struct KArgs {
  const float* in[23];
  float* out;
  unsigned char* ws;
  int ph_lo, ph_hi;
};
typedef const float* const __attribute__((address_space(4))) * InTab;
struct Params {
  InTab in;
  float* out;
  unsigned char* ws;
  int ph_lo, ph_hi;
  int bx, gx;
  unsigned* xbar_words; unsigned xbar_x; unsigned lds_st_off;
};
enum { I_X = 0, I_C, I_CTX, I_CCTX, I_ADAW, I_ADAB, I_N1G, I_N2G, I_WIN, I_CONVW, I_CONVB, I_CLNG, I_CLNB, I_GATEB, I_MNORMG, I_DLAM, I_DNORMG,
       I_WOUT, I_PWQ, I_PKEYS, I_PU, I_PV, I_FINALG };

__device__ __forceinline__ unsigned cvtpk(float lo, float hi) { unsigned r; asm volatile("v_cvt_pk_bf16_f32 %0, %1, %2" : "=v"(r) : "v"(lo), "v"(hi)); return r; }
__device__ __forceinline__ float bflo(unsigned u) { return __uint_as_float(u << 16); }
__device__ __forceinline__ float bfhi(unsigned u) { return __uint_as_float(u & 0xffff0000u); }
__device__ __forceinline__ float bf1(bf16_t u) { return __uint_as_float(((unsigned)u) << 16); }
__device__ __forceinline__ int crow(int r, int hi) { return (r & 3) + 8 * (r >> 2) + 4 * hi; }
template <int CTRL> __device__ __forceinline__ float dpp_mov(float v) {
  return __uint_as_float((unsigned)__builtin_amdgcn_update_dpp(0, (int)__float_as_uint(v), CTRL, 0xF, 0xF, true));
}
__device__ __forceinline__ float wave_sum_fast(float x) {
  x += dpp_mov<0xB1>(x); x += dpp_mov<0x4E>(x); x += dpp_mov<0x141>(x); x += dpp_mov<0x140>(x);
  { auto r = __builtin_amdgcn_permlane16_swap(__float_as_uint(x), __float_as_uint(x), false, false); x = __uint_as_float(r[0]) + __uint_as_float(r[1]); }
  { auto r = __builtin_amdgcn_permlane32_swap(__float_as_uint(x), __float_as_uint(x), false, false); x = __uint_as_float(r[0]) + __uint_as_float(r[1]); }
  return x;
}
__device__ __forceinline__ float wave_max_fast(float x) {
  x = fmaxf(x, dpp_mov<0xB1>(x)); x = fmaxf(x, dpp_mov<0x4E>(x)); x = fmaxf(x, dpp_mov<0x141>(x)); x = fmaxf(x, dpp_mov<0x140>(x));
  { auto r = __builtin_amdgcn_permlane16_swap(__float_as_uint(x), __float_as_uint(x), false, false); x = fmaxf(__uint_as_float(r[0]), __uint_as_float(r[1])); }
  { auto r = __builtin_amdgcn_permlane32_swap(__float_as_uint(x), __float_as_uint(x), false, false); x = fmaxf(__uint_as_float(r[0]), __uint_as_float(r[1])); }
  return x;
}
template <int CTRL, int ROWMASK> __device__ __forceinline__ float dpp_mov_rm(float v) {
  return __uint_as_float((unsigned)__builtin_amdgcn_update_dpp(0, (int)__float_as_uint(v), CTRL, ROWMASK, 0xF, true));
}
__device__ __forceinline__ float wave_incl_scan(float x) {
  x += dpp_mov<0x111>(x); x += dpp_mov<0x112>(x); x += dpp_mov<0x114>(x); x += dpp_mov<0x118>(x);
  x += dpp_mov_rm<0x142, 0xA>(x);
  x += dpp_mov_rm<0x143, 0xC>(x);
  return x;
}
__device__ __forceinline__ float wave_sum(float v) { return wave_sum_fast(v); }
__device__ __forceinline__ float sum_xor32(float x) { auto r = __builtin_amdgcn_permlane32_swap(__float_as_uint(x), __float_as_uint(x), false, false); return __uint_as_float(r[0]) + __uint_as_float(r[1]); }
__device__ __forceinline__ float max_xor32(float x) { auto r = __builtin_amdgcn_permlane32_swap(__float_as_uint(x), __float_as_uint(x), false, false); return fmaxf(__uint_as_float(r[0]), __uint_as_float(r[1])); }
__device__ __forceinline__ float wave_max(float v) { return wave_max_fast(v); }
__device__ __forceinline__ float sigmoidf_(float x) { return 1.f / (1.f + __expf(-x)); }
__device__ __forceinline__ float logsigmoidf_(float x) { return fminf(x, 0.f) - log1pf(__expf(-fabsf(x))); }
__device__ __forceinline__ const float* in_row(const float* x, const float* ctx, int row) {
  const int b = row / SEGL, s = row - b * SEGL;
  return s < CTXL ? ctx + ((size_t)(b * CTXL + s)) * DM : x + ((size_t)(b * SEQ + (s - CTXL))) * DM;
}
__device__ __forceinline__ int mod_row(int row) { const int b = row / SEGL, s = row - b * SEGL; return s < CTXL ? 4 : b; }

__device__ __forceinline__ void p0_mod(const Params& p, unsigned char* lds, float* MOD) {
  float* sil = (float*)lds;
  float* red = (float*)(lds + 20480);
  int tid_ = tidx(); asm volatile("" : "+v"(tid_)); const int tid = tid_, lane = tid & 63, wid = tid >> 6;
  for (int i = tid; i < 5 * 1024; i += 512) {
    const float v = i < 4096 ? p.in[I_C][i] : p.in[I_CCTX][i - 4096];
    sil[i] = v / (1.f + __expf(-v));
  }
  __syncthreads();
  for (int item = p.bx; item < DEPTH * 96; item += p.gx) {
    const int l = item / 96, j0 = (item % 96) * 64;
    const float* W = p.in[I_ADAW] + (size_t)l * DM * 6144 + j0 + lane;
    float a0 = 0.f, a1 = 0.f, a2 = 0.f, a3 = 0.f, a4 = 0.f;
    const int k0 = wid * 128;
#pragma unroll 8
    for (int k = k0; k < k0 + 128; ++k) {
      const float w = W[(size_t)k * 6144];
      a0 += sil[k] * w; a1 += sil[1024 + k] * w; a2 += sil[2048 + k] * w; a3 += sil[3072 + k] * w; a4 += sil[4096 + k] * w;
    }
    red[(wid * 5 + 0) * 64 + lane] = a0; red[(wid * 5 + 1) * 64 + lane] = a1; red[(wid * 5 + 2) * 64 + lane] = a2;
    red[(wid * 5 + 3) * 64 + lane] = a3; red[(wid * 5 + 4) * 64 + lane] = a4;
    __syncthreads();
    if (tid < 320) {
      const int r = tid >> 6;
      float s = 0.f;
#pragma unroll
      for (int w = 0; w < 8; ++w) s += red[(w * 5 + r) * 64 + lane];
      MOD[((size_t)l * 5 + r) * 6144 + j0 + lane] = s + p.in[I_ADAB][l * 6144 + j0 + lane];
    }
    __syncthreads();
  }
}
__device__ __forceinline__ void transpose_item(const float* W, int ldw, int srccol0, bf16_t* WT, int K, int n0, int k0, float* scr, int lane) {
#pragma unroll 8
  for (int i = 0; i < 32; ++i) { const int kk = 2 * i + (lane >> 5); scr[kk * 33 + (lane & 31)] = W[(size_t)(k0 + kk) * ldw + srccol0 + (lane & 31)]; }
  asm volatile("s_waitcnt lgkmcnt(0)" ::: "memory");
  const int c = lane & 7;
#pragma unroll
  for (int j = 0; j < 4; ++j) {
    const int n = (lane >> 3) + 8 * j; const float* s = scr + (8 * c) * 33 + n;
    u32x4 o; o.x = cvtpk(s[0], s[33]); o.y = cvtpk(s[66], s[99]); o.z = cvtpk(s[132], s[165]); o.w = cvtpk(s[198], s[231]);
    *(u32x4*)(WT + (size_t)(n0 + n) * K + k0 + 8 * c) = o;
  }
  asm volatile("s_waitcnt lgkmcnt(0)" ::: "memory");
}
__device__ __forceinline__ void convert_tables(const Params& p, int L, int wv, int nw, int lane, int r_lo, int r_hi) {
  unsigned char* PUq = p.ws + WS_PU; unsigned char* PVq = p.ws + WS_PV; float* PSC = (float*)(p.ws + WS_PSC);
  const int nrows = DEPTH * NEXP;
#define TAB_SROW(r_) ((const f32x4*)(((r_) >= NEXP ? p.in[I_PV] : p.in[I_PU]) + (size_t)(L * NEXP + ((r_) >= NEXP ? (r_) - NEXP : (r_))) * DM) + lane * 4)
#define TAB_LOAD(v_, r_) do { if ((r_) < r_hi) { const f32x4* s_ = TAB_SROW(r_); _Pragma("unroll") for (int j = 0; j < 4; ++j) v_[j] = __builtin_nontemporal_load(s_ + j); } } while (0)
  auto encode_row = [&](const f32x4 (&v)[4], int r) {
    const int tb = r >= NEXP, rr = L * NEXP + (tb ? r - NEXP : r);
    float mx = 0.f;
#pragma unroll
    for (int j = 0; j < 4; ++j) mx = fmaxf(mx, fmaxf(fmaxf(fabsf(v[j].x), fabsf(v[j].y)), fmaxf(fabsf(v[j].z), fabsf(v[j].w))));
    mx = wave_max_fast(mx);
    const unsigned mb = __float_as_uint(mx);
    const int eb = (int)((mb >> 23) & 0xFFu);
    int sb = ((mb & 0x7FFFFFu) <= 0x700000u ? 129 : 128) - eb + 127; sb = sb < 1 ? 1 : (sb > 253 ? 253 : sb);
    const float sc = __uint_as_float((unsigned)sb << 23), isc = __uint_as_float((unsigned)(254 - sb) << 23);
    const float xv[16] = {v[0].x, v[0].y, v[0].z, v[0].w, v[1].x, v[1].y, v[1].z, v[1].w, v[2].x, v[2].y, v[2].z, v[2].w, v[3].x, v[3].y, v[3].z, v[3].w};
    unsigned wq[3] = {0u, 0u, 0u};
#pragma unroll
    for (int i = 0; i < 16; ++i) {
      const float a = fabsf(xv[i]) * sc;
      unsigned code = a < 2.f ? (unsigned)__builtin_rintf(a * 8.f) : (a < 4.f ? 8u + (unsigned)__builtin_rintf(a * 4.f) : 16u + (unsigned)__builtin_rintf(a * 2.f));
      code = code > 31u ? 31u : code;
      code |= (xv[i] < 0.f) ? 32u : 0u;
      const int bp = 6 * i, dw = bp >> 5, off = bp & 31;
      wq[dw] |= code << off;
      if (off > 26) wq[dw + 1] |= code >> (32 - off);
    }
    u32x3 o; o.x = wq[0]; o.y = wq[1]; o.z = wq[2];
    *(u32x3*)((tb ? PVq : PUq) + (size_t)rr * PROW + lane * 12) = o;
    if (lane == 0) PSC[(size_t)tb * nrows + rr] = isc;
  };
  f32x4 v0[4], v1[4], v2[4];
  TAB_LOAD(v0, r_lo + wv); TAB_LOAD(v1, r_lo + wv + nw);
#pragma unroll 1
  for (int r = r_lo + wv; r < r_hi; r += 3 * nw) {
    TAB_LOAD(v2, r + 2 * nw); encode_row(v0, r);
    if (r + nw < r_hi) { TAB_LOAD(v0, r + 3 * nw); encode_row(v1, r + nw); }
    if (r + 2 * nw < r_hi) { TAB_LOAD(v1, r + 4 * nw); encode_row(v2, r + 2 * nw); }
  }
#undef TAB_LOAD
#undef TAB_SROW
}
__device__ __forceinline__ void tail_filler_tables(const Params& p, int L, int nwg, int r_lo, int r_hi) {
  int tid_ = tidx(); asm volatile("" : "+v"(tid_)); const int lane = tid_ & 63, wid = tid_ >> 6;
  const int nextra = nwg % p.gx, first = nextra, nidle = p.gx - nextra;
  if (p.bx < first) return;
  convert_tables(p, L, (p.bx - first) * 8 + wid, nidle * 8, lane, r_lo, r_hi);
}
__device__ __forceinline__ void p0_convert(const Params& p, unsigned char* lds) {
  int tid_ = tidx(); asm volatile("" : "+v"(tid_)); const int tid = tid_, lane = tid & 63, wid = tid >> 6;
  const int gw = p.bx * 8 + wid, NGW = p.gx * 8;
  const size_t gt = (size_t)p.bx * 512 + tid, NGT = (size_t)p.gx * 512;
  float* scr = (float*)(lds + 32768) + wid * (64 * 33);
  bf16_t* WIN = (bf16_t*)(p.ws + WS_WIN); bf16_t* WOUT = (bf16_t*)(p.ws + WS_WOUT); bf16_t* WQ = (bf16_t*)(p.ws + WS_WQ);
  constexpr int I_IN = 16 * 96, I_O = 16 * 32, PER_L = I_IN + 2 * I_O;
  for (int it = gw; it < DEPTH * PER_L; it += NGW) {
    const int l = it / PER_L; int r = it % PER_L;
    if (r < I_IN) { const int kb = r / 96, nb = r % 96, n0 = nb * 32; const int src = n0 < 1536 ? n0 : n0 + 16;
      transpose_item(p.in[I_WIN] + (size_t)l * DM * IN_W, IN_W, src, WIN + (size_t)l * PW * DM, DM, n0, kb * 64, scr, lane); continue; }
    r -= I_IN;
    if (r < I_O) { const int kb = r / 32, nb = r % 32;
      transpose_item(p.in[I_WOUT] + (size_t)l * DM * DM, DM, nb * 32, WOUT + (size_t)l * DM * DM, DM, nb * 32, kb * 64, scr, lane); continue; }
    r -= I_O;
    { const int kb = r / 32, nb = r % 32;
      transpose_item(p.in[I_PWQ] + (size_t)l * DM * DM, DM, nb * 32, WQ + (size_t)l * DM * DM, DM, nb * 32, kb * 64, scr, lane); }
  }
  bf16_t* WG = (bf16_t*)(p.ws + WS_WG);
  for (size_t i = gt; i < (size_t)DEPTH * 16 * DM; i += NGT) {
    const int l = (int)(i / (16 * DM)), g = (int)((i / DM) % 16), k = (int)(i % DM);
    WG[i] = (bf16_t)(cvtpk(p.in[I_WIN][(size_t)l * DM * IN_W + (size_t)k * IN_W + 1536 + g], 0.f) & 0xffffu);
  }
  bf16_t* KEYS = (bf16_t*)(p.ws + WS_KEYS);
  for (size_t i = gt; i < (size_t)DEPTH * 131072 / 8; i += NGT) {
    const f32x4 a = ((const f32x4*)p.in[I_PKEYS])[2 * i], b = ((const f32x4*)p.in[I_PKEYS])[2 * i + 1];
    u32x4 o; o.x = cvtpk(a.x, a.y); o.y = cvtpk(a.z, a.w); o.z = cvtpk(b.x, b.y); o.w = cvtpk(b.z, b.w);
    ((u32x4*)KEYS)[i] = o;
  }
  {
    float* RC = (float*)(p.ws + WS_ROPE); float* RS = RC + SEQ * 32;
    for (size_t i = gt; i < (size_t)SEQ * 32; i += NGT) {
      const int pos = (int)(i >> 5), j = (int)(i & 31);
      const int rr = pos >> 6, cc = pos & 63;
      const int jj = j & 15;
      const double e = -(double)jj * 0.83048202372184058696;
      const double fl = __builtin_floor(e); const double f = e - fl;
      const double z = f * 0.69314718055994530942;
      double ez = 1.0 + z * (1.0 + z * (0.5 + z * (1.0 / 6 + z * (1.0 / 24 + z * (1.0 / 120 + z * (1.0 / 720 + z * (1.0 / 5040 + z * (1.0 / 40320 + z * (1.0 / 362880 + z * (1.0 / 3628800 + z * (1.0 / 39916800 + z * (1.0 / 479001600))))))))))));
      const double inv = __builtin_ldexp(ez, (int)fl);
      const float invf = (float)inv;
      const float angf = (float)(j < 16 ? rr : cc) * invf;
      const double ang = (double)angf;
      const double kq = __builtin_rint(ang * 0.63661977236758134308);
      double r = __builtin_fma(-kq, 1.57079632679489655800e+00, ang);
      r = __builtin_fma(-kq, 6.12323399573676603587e-17, r);
      const double r2 = r * r;
      const double sn = r * (1.0 + r2 * (-1.0 / 6 + r2 * (1.0 / 120 + r2 * (-1.0 / 5040 + r2 * (1.0 / 362880 + r2 * (-1.0 / 39916800 + r2 * (1.0 / 6227020800.0)))))));
      const double cs = 1.0 + r2 * (-0.5 + r2 * (1.0 / 24 + r2 * (-1.0 / 720 + r2 * (1.0 / 40320 + r2 * (-1.0 / 3628800 + r2 * (1.0 / 479001600 + r2 * (-1.0 / 87178291200.0)))))));
      const int q = ((int)kq) & 3;
      double co, si;
      if (q == 0) { co = cs; si = sn; } else if (q == 1) { co = -sn; si = cs; } else if (q == 2) { co = -cs; si = -sn; } else { co = sn; si = -cs; }
      RC[i] = (float)co; RS[i] = (float)si;
    }
  }
}

__device__ __forceinline__ void norm_mod_row(const float* xrow, const float* g, const float* sc, const float* sh, bf16_t* orow, int lane) {
  const f32x4* xr = (const f32x4*)xrow + lane;
  f32x4 v[4]; float s = 0.f;
#pragma unroll
  for (int j = 0; j < 4; ++j) { v[j] = xr[64 * j]; s += (v[j].x * v[j].x + v[j].y * v[j].y) + (v[j].z * v[j].z + v[j].w * v[j].w); }
  const float rs = rsqrtf(wave_sum(s) * (1.f / DM) + EPS);
  u32x2* o = (u32x2*)orow + lane;
#pragma unroll
  for (int j = 0; j < 4; ++j) {
    const f32x4 gg = ((const f32x4*)g)[lane + 64 * j], cc = ((const f32x4*)sc)[lane + 64 * j], hh = ((const f32x4*)sh)[lane + 64 * j];
    const float y0 = v[j].x * rs * gg.x * (1.f + cc.x) + hh.x, y1 = v[j].y * rs * gg.y * (1.f + cc.y) + hh.y;
    const float y2 = v[j].z * rs * gg.z * (1.f + cc.z) + hh.z, y3 = v[j].w * rs * gg.w * (1.f + cc.w) + hh.w;
    u32x2 w; w.x = cvtpk(y0, y1); w.y = cvtpk(y2, y3);
    o[64 * j] = w;
  }
}
__device__ __forceinline__ void phase_norm(const Params& p, int l, int which, bool from_input, bool skip_ctx) {
  int tid_ = tidx(); asm volatile("" : "+v"(tid_));
  const int lane = tid_ & 63, wid = tid_ >> 6;
  const int gw = p.bx * 8 + wid, NGW = p.gx * 8;
  const float* MOD = (const float*)(p.ws + WS_MOD);
  const float* XC = (const float*)(p.ws + WS_XCUR);
  bf16_t* H = (bf16_t*)(p.ws + WS_H);
  const float* g = p.in[which ? I_N2G : I_N1G] + l * DM;
  for (int row = gw; row < T; row += NGW) {
    const int mr = mod_row(row);
    if (skip_ctx && mr == 4) continue;
    const float* m = MOD + ((size_t)l * 5 + mr) * 6144 + which * 3072;
    const float* xr = from_input ? in_row(p.in[I_X], p.in[I_CTX], row) : XC + (size_t)row * DM;
    norm_mod_row(xr, g, m + 1024, m, H + (size_t)row * DM, lane);
  }
}

namespace pg8 {
#define PG8_LAS __attribute__((address_space(3)))
typedef unsigned short bf16_t;
typedef short bf16x8 __attribute__((ext_vector_type(8)));
typedef float f32x4 __attribute__((ext_vector_type(4)));
typedef unsigned u32x4 __attribute__((ext_vector_type(4)));
constexpr int BM = 256, BK = 64, HALF = 128, HTB = HALF * BK * 2  , STAGE_BYTES = 8 * HTB, NXCD = 8, WGM = 8;

__host__ __device__ __forceinline__ int lds_byte(int r, int c) { const int st = (r >> 4) * 2 + (c >> 5), rr = r & 15, cc = c & 31, ob = rr * 64 + cc * 2; return st * 1024 + (ob ^ (((ob >> 9) & 1) << 5)); }
__host__ __device__ __forceinline__ void stage_rc(int b, int& R, int& C) { const int st = b / 1024, sb = b % 1024, swz = sb ^ (((sb >> 9) & 1) << 5); R = (st >> 1) * 16 + swz / 64; C = (st & 1) * 32 + (swz % 64) / 2; }
__host__ __device__ __forceinline__ int perm32(int rho) { const int n = rho >> 4, i = rho & 15; return 8 * (i >> 2) + 4 * n + (i & 3); }

struct Unit { int pm, pn; };
struct Gemm { const bf16_t* A; const bf16_t* Bt; int M, N, K; };

struct StaticOrder {
    int nM, nN, nwg, G, c;
    __host__ __device__ void init(int M, int N, int G_, int c_) { nM = M / BM; nN = N / BM; nwg = nM * nN; G = G_; c = c_; }
    __host__ __device__ bool next(int i, Unit& u) const {
        const long L = (long)i * G + c; if (L >= nwg) return false;
        int wgid = (int)L; { const int q = nwg / NXCD, r = nwg % NXCD, xcd = wgid % NXCD, off = wgid / NXCD; wgid = (xcd < r ? xcd * (q + 1) : r * (q + 1) + (xcd - r) * q) + off; }
        const int nig = WGM * nN, gid = wgid / nig, fm = gid * WGM, gsz = (nM - fm) < WGM ? (nM - fm) : WGM;
        u.pm = fm + ((wgid % nig) % gsz); u.pn = (wgid % nig) / gsz; return true;
    }
    __device__ __forceinline__ void a_ready(const Unit&) const {}
    __device__ __forceinline__ void done(const Unit&) const {}
};
__device__ __forceinline__ unsigned cvt_pk_bf16(float lo, float hi) { unsigned r; asm volatile("v_cvt_pk_bf16_f32 %0, %1, %2" : "=v"(r) : "v"(lo), "v"(hi)); return r; }
template <class Epi, class Sched, bool ALIGN_EPI = false, bool SP2 = false>
__device__ __forceinline__ void gemm_phase(PG8_LAS unsigned char* lds, const Gemm g, const Sched& S, const Epi& E) {
    const int tid = tidx(), wid = __builtin_amdgcn_readfirstlane(tid >> 6), lane = tid & 63, wr = wid >> 2, wc = wid & 3, fr = lane & 15, fq = lane >> 4;
    const int K = g.K, nt = K / BK;
    unsigned voffA[2], voffB[2];
#pragma unroll
    for (int i = 0; i < 2; ++i) { int R, C; stage_rc(tid * 16 + i * 8192, R, C); const int Rb = Epi::PERM ? ((R & ~31) + perm32(R & 31)) : R;
        voffA[i] = (unsigned)(R * K + C) * 2u; voffB[i] = (unsigned)(Rb * K + C) * 2u; }
    const size_t kstep = (size_t)(BK * 2);
    const size_t hstep = (size_t)HALF * K * 2;
    const size_t tstep = 2 * hstep;
    const unsigned ldsw = (unsigned)wid * 1024u;
    const int aoff = lds_byte(wr * 64 + fr, fq * 8), boff = lds_byte(wc * 32 + fr, fq * 8);
#define PG8_SA(b, h) (((b) * 2 + (h)) * HTB)
#define PG8_SB(b, h) ((4 + (b) * 2 + (h)) * HTB)
#define PG8_STAGE(bufoff, gbase, voff) do { _Pragma("unroll") for (int _i = 0; _i < 2; ++_i) \
        __builtin_amdgcn_global_load_lds((const unsigned*)((const char*)(gbase) + (voff)[_i]), (PG8_LAS unsigned*)(lds + (bufoff) + ldsw + _i * 8192), 16, 0, 0); } while (0)
#define PG8_LDA(dst, b, h) do { _Pragma("unroll") for (int m = 0; m < 4; ++m) _Pragma("unroll") for (int k = 0; k < 2; ++k) dst[m][k] = *(const PG8_LAS bf16x8*)(lds + PG8_SA(b, h) + aoff + m * 2048 + k * 1024); } while (0)
#define PG8_LDB(dst, b, h) do { _Pragma("unroll") for (int n = 0; n < 2; ++n) _Pragma("unroll") for (int k = 0; k < 2; ++k) dst[n][k] = *(const PG8_LAS bf16x8*)(lds + PG8_SB(b, h) + boff + n * 2048 + k * 1024); } while (0)
#define PG8_MMA(ai, bj, At, Bt) do { __builtin_amdgcn_s_setprio(1); _Pragma("unroll") for (int m = 0; m < 4; ++m) _Pragma("unroll") for (int n = 0; n < 2; ++n) _Pragma("unroll") for (int k = 0; k < 2; ++k) \
        acc[ai][bj][m][n] = __builtin_amdgcn_mfma_f32_16x16x32_bf16(Bt[n][k], At[m][k], acc[ai][bj][m][n], 0, 0, 0); __builtin_amdgcn_s_setprio(0); } while (0)
#define PG8_WAIT_V(n) asm volatile("s_waitcnt vmcnt(" #n ")" ::: "memory")
#define PG8_WAIT_L(n) asm volatile("s_waitcnt lgkmcnt(" #n ")" ::: "memory")
#define PG8_BAR __builtin_amdgcn_s_barrier()
#define PG8_SCHED __builtin_amdgcn_sched_barrier(0)
    Unit cur, nxt; int ui = 0;
    if (!S.next(0, cur)) return;
    f32x4 acc[2][2][4][2];
#pragma unroll
    for (int a = 0; a < 2; ++a)
#pragma unroll
        for (int b = 0; b < 2; ++b)
#pragma unroll
            for (int m = 0; m < 4; ++m)
#pragma unroll
                for (int n = 0; n < 2; ++n) acc[a][b][m][n] = (f32x4){0.f, 0.f, 0.f, 0.f};
    bf16x8 At[4][2], B0[2][2], B1[2][2];
    const char* cA = (const char*)g.A + (size_t)cur.pm * tstep; const char* cB = (const char*)g.Bt + (size_t)cur.pn * tstep;
    S.a_ready(cur);
    if constexpr (SP2) {
        PG8_STAGE(PG8_SB(0, 0), cB, voffB); PG8_STAGE(PG8_SB(0, 1), cB + hstep, voffB); PG8_STAGE(PG8_SA(0, 0), cA, voffA); PG8_STAGE(PG8_SA(0, 1), cA + hstep, voffA);
        if (wr == 1) PG8_BAR;
        PG8_WAIT_V(2); PG8_BAR;
        PG8_STAGE(PG8_SB(1, 0), cB + kstep, voffB); PG8_STAGE(PG8_SA(1, 0), cA + kstep, voffA); PG8_STAGE(PG8_SB(1, 1), cB + hstep + kstep, voffB);
        PG8_WAIT_V(6); PG8_BAR;
    } else {
        PG8_STAGE(PG8_SB(0, 0), cB, voffB); PG8_STAGE(PG8_SA(0, 0), cA, voffA); PG8_STAGE(PG8_SB(0, 1), cB + hstep, voffB); PG8_STAGE(PG8_SA(0, 1), cA + hstep, voffA);
        if (wr == 1) PG8_BAR;
        PG8_WAIT_V(4); PG8_BAR;
        PG8_STAGE(PG8_SB(1, 0), cB + kstep, voffB); PG8_STAGE(PG8_SA(1, 0), cA + kstep, voffA); PG8_STAGE(PG8_SB(1, 1), cB + hstep + kstep, voffB);
        PG8_WAIT_V(6); PG8_BAR;
    }
    for (;;) {
        const bool has_next = S.next(ui + 1, nxt);
        const char* nA = has_next ? (const char*)g.A + (size_t)nxt.pm * tstep : cA; const char* nB = has_next ? (const char*)g.Bt + (size_t)nxt.pn * tstep : cB;
        for (int t = 0; t < nt; t += 2) {
            const bool last = (t == nt - 2);
            const char* a1 = cA + (size_t)(t + 1) * kstep;
            const char* a2 = last ? nA : cA + (size_t)(t + 2) * kstep; const char* b2 = last ? nB : cB + (size_t)(t + 2) * kstep;
            const char* a3 = a2 + kstep; const char* b3 = b2 + kstep;
            if (last && has_next) S.a_ready(nxt);
            if constexpr (SP2) {
            PG8_LDB(B0, 0, 0); PG8_LDB(B1, 0, 1); PG8_SCHED; PG8_LDA(At, 0, 0); PG8_STAGE(PG8_SA(1, 1), a1 + hstep, voffA);
            PG8_WAIT_V(8); PG8_WAIT_L(0); PG8_BAR; PG8_MMA(0, 0, At, B0); PG8_MMA(0, 1, At, B1); PG8_BAR; PG8_SCHED;
            PG8_LDA(At, 0, 1); PG8_STAGE(PG8_SB(0, 0), b2, voffB); PG8_STAGE(PG8_SB(0, 1), b2 + hstep, voffB); PG8_STAGE(PG8_SA(0, 0), a2, voffA);
            PG8_WAIT_V(8); PG8_WAIT_L(0); PG8_BAR; PG8_MMA(1, 0, At, B0); PG8_MMA(1, 1, At, B1); PG8_BAR; PG8_SCHED;
            PG8_LDB(B0, 1, 0); PG8_LDB(B1, 1, 1); PG8_SCHED; PG8_LDA(At, 1, 0); PG8_STAGE(PG8_SA(0, 1), a2 + hstep, voffA);
            PG8_WAIT_V(8); PG8_WAIT_L(0); PG8_BAR; PG8_MMA(0, 0, At, B0); PG8_MMA(0, 1, At, B1); PG8_BAR; PG8_SCHED;
            PG8_LDA(At, 1, 1); PG8_STAGE(PG8_SB(1, 0), b3, voffB); PG8_STAGE(PG8_SB(1, 1), b3 + hstep, voffB); PG8_STAGE(PG8_SA(1, 0), a3, voffA);
            PG8_WAIT_V(8); PG8_WAIT_L(0); PG8_BAR; PG8_MMA(1, 0, At, B0); PG8_MMA(1, 1, At, B1); PG8_BAR; PG8_SCHED;
            } else {
            PG8_LDB(B0, 0, 0); PG8_SCHED; PG8_LDA(At, 0, 0); PG8_STAGE(PG8_SA(1, 1), a1 + hstep, voffA);
            PG8_WAIT_L(8); PG8_BAR; PG8_WAIT_L(0); PG8_MMA(0, 0, At, B0); PG8_BAR; PG8_SCHED;
            PG8_LDB(B1, 0, 1); PG8_STAGE(PG8_SB(0, 0), b2, voffB);
            PG8_BAR; PG8_WAIT_L(0); PG8_MMA(0, 1, At, B1); PG8_BAR;
            PG8_LDA(At, 0, 1); PG8_STAGE(PG8_SA(0, 0), a2, voffA);
            PG8_BAR; PG8_WAIT_L(0); PG8_MMA(1, 0, At, B0); PG8_BAR; PG8_SCHED;
            PG8_STAGE(PG8_SB(0, 1), b2 + hstep, voffB);
            PG8_WAIT_V(6); PG8_BAR; PG8_MMA(1, 1, At, B1); PG8_BAR;
            PG8_LDB(B0, 1, 0); PG8_SCHED; PG8_LDA(At, 1, 0); PG8_STAGE(PG8_SA(0, 1), a2 + hstep, voffA);
            PG8_WAIT_L(8); PG8_BAR; PG8_WAIT_L(0); PG8_MMA(0, 0, At, B0); PG8_BAR; PG8_SCHED;
            PG8_LDB(B1, 1, 1); PG8_STAGE(PG8_SB(1, 0), b3, voffB);
            PG8_BAR; PG8_WAIT_L(0); PG8_MMA(0, 1, At, B1); PG8_BAR;
            PG8_LDA(At, 1, 1); PG8_STAGE(PG8_SA(1, 0), a3, voffA);
            PG8_BAR; PG8_WAIT_L(0); PG8_MMA(1, 0, At, B0); PG8_BAR; PG8_SCHED;
            PG8_STAGE(PG8_SB(1, 1), b3 + hstep, voffB);
            PG8_WAIT_V(6); PG8_BAR; PG8_MMA(1, 1, At, B1); PG8_BAR;
            }
        }
        if constexpr (ALIGN_EPI) { if (wr == 0) PG8_BAR; }
        if constexpr (!Epi::AFTER_DRAIN) { E(acc, cur, wr, wc, fr, fq); S.done(cur); }
        if (!has_next) break;
#pragma unroll
        for (int a = 0; a < 2; ++a)
#pragma unroll
            for (int b = 0; b < 2; ++b)
#pragma unroll
                for (int m = 0; m < 4; ++m)
#pragma unroll
                    for (int n = 0; n < 2; ++n) acc[a][b][m][n] = (f32x4){0.f, 0.f, 0.f, 0.f};
        cur = nxt; cA = nA; cB = nB; ++ui;
        if constexpr (ALIGN_EPI) { if (wr == 1) PG8_BAR; }
    }
    PG8_WAIT_V(0);
    if constexpr (!ALIGN_EPI) { if (wr == 0) PG8_BAR; }
    PG8_BAR;
    if constexpr (Epi::AFTER_DRAIN) { E.fused(acc, cur, wr, wc, fr, fq, lds, wid, lane); S.done(cur); }
#undef PG8_SA
#undef PG8_SB
#undef PG8_STAGE
#undef PG8_LDA
#undef PG8_LDB
#undef PG8_MMA
#undef PG8_WAIT_V
#undef PG8_WAIT_L
#undef PG8_BAR
#undef PG8_SCHED
}
}

__device__ __forceinline__ int gswz(int row, int chunk) { return row * 128 + ((chunk ^ ((row >> 1) & 7)) << 4); }
__device__ __forceinline__ void gemm_tile(const bf16_t* __restrict__ A, int lda, const bf16_t* __restrict__ Bt, int ldb, int K,
                                          int row0, int col0, unsigned char* lds, f32x16 (&acc)[2][2]) {
  int tid_ = tidx(); asm volatile("" : "+v"(tid_)); const int tid = tid_, lane = tid & 63, wid = tid >> 6, wm = wid >> 1, wn = wid & 1, r32 = lane & 31, hi = lane >> 5;
  unsigned char* As = lds; unsigned char* Bs = lds + 65536;
#pragma unroll
  for (int i = 0; i < 2; ++i)
#pragma unroll
    for (int j = 0; j < 2; ++j) acc[i][j] = f32x16{};
  const int lrow = tid >> 3, lc = tid & 7;
  const bf16_t* Ag = A + (size_t)(row0 + lrow) * lda + lc * 8;
  const bf16_t* Bg = Bt + (size_t)(col0 + lrow) * ldb + lc * 8;
  u32x4 ra[4], rb[2];
#pragma unroll
  for (int i = 0; i < 4; ++i) ra[i] = *(const u32x4*)(Ag + (size_t)(64 * i) * lda);
#pragma unroll
  for (int i = 0; i < 2; ++i) rb[i] = *(const u32x4*)(Bg + (size_t)(64 * i) * ldb);
#pragma unroll
  for (int i = 0; i < 4; ++i) *(u32x4*)(As + gswz(lrow + 64 * i, lc)) = ra[i];
#pragma unroll
  for (int i = 0; i < 2; ++i) *(u32x4*)(Bs + gswz(lrow + 64 * i, lc)) = rb[i];
  __syncthreads();
  const int nk = K / 64;
  for (int kt = 0; kt < nk; ++kt) {
    const int cur = kt & 1;
    if (kt + 1 < nk) {
#pragma unroll
      for (int i = 0; i < 4; ++i) ra[i] = *(const u32x4*)(Ag + (size_t)(64 * i) * lda + (kt + 1) * 64);
#pragma unroll
      for (int i = 0; i < 2; ++i) rb[i] = *(const u32x4*)(Bg + (size_t)(64 * i) * ldb + (kt + 1) * 64);
    }
    const unsigned char* Ac = As + cur * 32768; const unsigned char* Bc = Bs + cur * 16384;
#pragma unroll
    for (int kk = 0; kk < 4; ++kk) {
      bf16x8 af[2], bfr[2];
#pragma unroll
      for (int i = 0; i < 2; ++i) af[i] = *(const bf16x8*)(Ac + gswz(wm * 64 + i * 32 + r32, 2 * kk + hi));
#pragma unroll
      for (int j = 0; j < 2; ++j) bfr[j] = *(const bf16x8*)(Bc + gswz(wn * 64 + j * 32 + r32, 2 * kk + hi));
#pragma unroll
      for (int i = 0; i < 2; ++i)
#pragma unroll
        for (int j = 0; j < 2; ++j) acc[i][j] = __builtin_amdgcn_mfma_f32_32x32x16_bf16(af[i], bfr[j], acc[i][j], 0, 0, 0);
    }
    if (kt + 1 < nk) {
      unsigned char* An = As + (cur ^ 1) * 32768; unsigned char* Bn = Bs + (cur ^ 1) * 16384;
#pragma unroll
      for (int i = 0; i < 4; ++i) *(u32x4*)(An + gswz(lrow + 64 * i, lc)) = ra[i];
#pragma unroll
      for (int i = 0; i < 2; ++i) *(u32x4*)(Bn + gswz(lrow + 64 * i, lc)) = rb[i];
    }
    __syncthreads();
  }
}
__device__ __forceinline__ void pair_xchg(float v0, float v1, int lane, float& lo, float& hi2) {
  const bool odd = lane & 1;
  const float send = odd ? v0 : v1;
  const float recv = dpp_mov<0xB1>(send);
  lo = odd ? recv : v0; hi2 = odd ? v1 : recv;
}

__device__ __forceinline__ void phase_inproj(const Params& p, int l, unsigned char* lds) {
  int tid_ = tidx(); asm volatile("" : "+v"(tid_)); const int tid = tid_, lane = tid & 63, wid = tid >> 6, wm = wid >> 1, wn = wid & 1, r32 = lane & 31, hi = lane >> 5;
  const bf16_t* H = (const bf16_t*)(p.ws + WS_H);
  const bf16_t* W = (const bf16_t*)(p.ws + WS_WIN) + (size_t)l * PW * DM;
  bf16_t* PROJ = (bf16_t*)(p.ws + WS_PROJ);
  const float* RC = (const float*)(p.ws + WS_ROPE); const float* RS = RC + SEQ * 32;
  constexpr int NM = T / 256, NN = PW / 128, NU = NM * NN;
  for (int u = p.bx; u < NU + NM; u += p.gx) {
    if (u < NU) {
      const int pn = u / NM, pm = u % NM;
      const int row0 = pm * 256, col0 = pn * 128;
      f32x16 acc[2][2];
      gemm_tile(H, DM, W, DM, DM, row0, col0, lds, acc);
      const bool rope = (col0 >= C_DQ && col0 < C_DV);
      const float scl = (col0 >= C_MK && col0 < C_MV) ? 0.125f : ((col0 >= C_DQ && col0 < C_DK) ? QSCALE : 1.f);
#pragma unroll
      for (int i = 0; i < 2; ++i)
#pragma unroll
        for (int j = 0; j < 2; ++j)
#pragma unroll
          for (int q = 0; q < 8; ++q) {
            float lo, hi2; pair_xchg(acc[i][j][2 * q], acc[i][j][2 * q + 1], lane, lo, hi2);
            const int row = row0 + wm * 64 + i * 32 + crow(2 * q, hi) + (lane & 1);
            const int col = col0 + wn * 64 + j * 32 + (r32 & ~1);
            if (rope) {
              const int s = row % SEGL;
              if (s >= CTXL) {
                const int idx = (s - CTXL) * 32 + ((col & 63) >> 1);
                const float c = RC[idx], sn = RS[idx];
                const float t1 = lo, t2 = hi2; lo = t1 * c - t2 * sn; hi2 = t1 * sn + t2 * c;
              }
            }
            *(unsigned*)(PROJ + (size_t)row * PW + col) = cvtpk(lo * scl, hi2 * scl);
          }
    } else {
      const int pm = u - NU, rowb = pm * 256 + wid * 32;
      const bf16_t* WG = (const bf16_t*)(p.ws + WS_WG) + (size_t)l * 16 * DM;
      float* GT = (float*)(p.ws + WS_GATES);
      const int r16 = lane & 15, q4 = lane >> 4;
      f32x4 c0 = {0.f, 0.f, 0.f, 0.f}, c1 = {0.f, 0.f, 0.f, 0.f};
      const bf16_t* a0p = H + (size_t)(rowb + r16) * DM + q4 * 8;
      const bf16_t* a1p = a0p + (size_t)16 * DM;
      const bf16_t* bp = WG + (size_t)r16 * DM + q4 * 8;
#pragma unroll 4
      for (int ks = 0; ks < 32; ++ks) {
        const bf16x8 a0 = *(const bf16x8*)(a0p + ks * 32), a1 = *(const bf16x8*)(a1p + ks * 32), b = *(const bf16x8*)(bp + ks * 32);
        c0 = __builtin_amdgcn_mfma_f32_16x16x32_bf16(a0, b, c0, 0, 0, 0);
        c1 = __builtin_amdgcn_mfma_f32_16x16x32_bf16(a1, b, c1, 0, 0, 0);
      }
      const float gb = p.in[I_GATEB][l * 16 + r16];
#pragma unroll
      for (int j = 0; j < 4; ++j) {
        GT[(size_t)(rowb + q4 * 4 + j) * 16 + r16] = c0[j] + gb;
        GT[(size_t)(rowb + 16 + q4 * 4 + j) * 16 + r16] = c1[j] + gb;
      }
    }
  }
}

__device__ __forceinline__ void phase_outproj(const Params& p, int l, unsigned char* lds) {
  int tid_ = tidx(); asm volatile("" : "+v"(tid_)); const int tid = tid_, lane = tid & 63, wid = tid >> 6, wm = wid >> 1, wn = wid & 1, r32 = lane & 31, hi = lane >> 5;
  const bf16_t* MIX = (const bf16_t*)(p.ws + WS_MIX);
  const bf16_t* W = (const bf16_t*)(p.ws + WS_WOUT) + (size_t)l * DM * DM;
  float* XC = (float*)(p.ws + WS_XCUR);
  const float* MOD = (const float*)(p.ws + WS_MOD);
  constexpr int NM = T / 256, NN = DM / 128, NU = NM * NN;
  for (int u = p.bx; u < NU; u += p.gx) {
    const int pm = u / NN, pn = u % NN;
    if (l == DEPTH - 1 && (pm % 33) == 0) continue;
    const int row0 = pm * 256, col0 = pn * 128;
    for (int rep = 0; rep < REP_OUTP; ++rep) {
    f32x16 acc[2][2];
    gemm_tile(MIX, DM, W, DM, DM, row0, col0, lds, acc);
    const int mr = (pm % 33) == 0 ? 4 : pm / 33;
    const float* g1 = MOD + ((size_t)l * 5 + mr) * 6144 + 2048;
#pragma unroll
    for (int i = 0; i < 2; ++i)
#pragma unroll
      for (int j = 0; j < 2; ++j) {
        const int col = col0 + wn * 64 + j * 32 + r32;
        const float gg = (rep == REP_OUTP - 1) ? g1[col] : 0.f;
#pragma unroll
        for (int r = 0; r < 16; ++r) {
          const int row = row0 + wm * 64 + i * 32 + crow(r, hi);
          const float xo = (l == 0) ? in_row(p.in[I_X], p.in[I_CTX], row)[col] : XC[(size_t)row * DM + col];
          XC[(size_t)row * DM + col] = xo + gg * acc[i][j][r];
        }
      }
    }
  }
}
__device__ __forceinline__ void phase_peerq(const Params& p, int l, unsigned char* lds) {
  int tid_ = tidx(); asm volatile("" : "+v"(tid_)); const int tid = tid_, lane = tid & 63, wid = tid >> 6, wm = wid >> 1, wn = wid & 1, r32 = lane & 31, hi = lane >> 5;
  const bf16_t* H = (const bf16_t*)(p.ws + WS_H);
  const bf16_t* W = (const bf16_t*)(p.ws + WS_WQ) + (size_t)l * DM * DM;
  bf16_t* QP = (bf16_t*)(p.ws + WS_PROJ);
  constexpr int NM = T / 256, NN = DM / 128, NU = NM * NN;
  for (int u = p.bx; u < NU; u += p.gx) {
    const int pm = u / NN, pn = u % NN;
    if (l == DEPTH - 1 && (pm % 33) == 0) continue;
    const int row0 = pm * 256, col0 = pn * 128;
    f32x16 acc[2][2];
    gemm_tile(H, DM, W, DM, DM, row0, col0, lds, acc);
#pragma unroll
    for (int i = 0; i < 2; ++i)
#pragma unroll
      for (int j = 0; j < 2; ++j)
#pragma unroll
        for (int q = 0; q < 8; ++q) {
          float lo, hi2; pair_xchg(acc[i][j][2 * q], acc[i][j][2 * q + 1], lane, lo, hi2);
          const int row = row0 + wm * 64 + i * 32 + crow(2 * q, hi) + (lane & 1);
          const int col = col0 + wn * 64 + j * 32 + (r32 & ~1);
          *(unsigned*)(QP + (size_t)row * DM + col) = cvtpk(lo, hi2);
        }
  }
}


struct EpiInproj {
  static constexpr bool PERM = true, AFTER_DRAIN = false;
  bf16_t* PROJ; const float* RC; const float* RS; unsigned char* V8T;
  __device__ __forceinline__ void operator()(const pg8::f32x4 (&acc)[2][2][4][2], const pg8::Unit& u, int wr, int wc, int fr, int fq) const {
#pragma unroll
    for (int bj = 0; bj < 2; ++bj) {
      const int colt = u.pn * 256 + bj * 128;
      const bool rope = (colt >= C_DQ && colt < C_DV);
      const float scl = (colt >= C_MK && colt < C_MV) ? 0.125f : ((colt >= C_DQ && colt < C_DK) ? QSCALE : 1.f);
      const int col8 = colt + wc * 32 + 8 * fq;
      if (colt >= C_DV) {
        const int hh = (col8 - C_DV) >> 7, e0 = (col8 - C_DV) & 127;
#pragma unroll
        for (int ai = 0; ai < 2; ++ai)
#pragma unroll
          for (int m = 0; m < 4; ++m) {
            const int row = u.pm * 256 + ai * 128 + wr * 64 + m * 16 + fr;
            const int b = row / SEGL, s = row - b * SEGL, t = s >> 6, kk = s & 63;
            const int slot = ((kk >> 2) & 1) * 32 + (kk & 3) + 4 * ((kk >> 3) & 3) + 16 * (kk >> 5);
            unsigned char* vp = V8T + ((size_t)((b * 4 + hh) * NCH + t) * 128 + e0) * 80 + slot;
            const f32x4 v0 = acc[ai][bj][m][0], v1 = acc[ai][bj][m][1];
            int w0 = 0, w1 = 0;
            w0 = __builtin_amdgcn_cvt_pk_fp8_f32(v0[0], v0[1], w0, false); w0 = __builtin_amdgcn_cvt_pk_fp8_f32(v0[2], v0[3], w0, true);
            w1 = __builtin_amdgcn_cvt_pk_fp8_f32(v1[0], v1[1], w1, false); w1 = __builtin_amdgcn_cvt_pk_fp8_f32(v1[2], v1[3], w1, true);
            vp[0] = (unsigned char)(w0 & 0xFF); vp[80] = (unsigned char)((w0 >> 8) & 0xFF); vp[160] = (unsigned char)((w0 >> 16) & 0xFF); vp[240] = (unsigned char)((w0 >> 24) & 0xFF);
            vp[320] = (unsigned char)(w1 & 0xFF); vp[400] = (unsigned char)((w1 >> 8) & 0xFF); vp[480] = (unsigned char)((w1 >> 16) & 0xFF); vp[560] = (unsigned char)((w1 >> 24) & 0xFF);
          }
        continue;
      }
#pragma unroll
      for (int ai = 0; ai < 2; ++ai)
#pragma unroll
        for (int m = 0; m < 4; ++m) {
          const int row = u.pm * 256 + ai * 128 + wr * 64 + m * 16 + fr;
          f32x4 v0 = acc[ai][bj][m][0], v1 = acc[ai][bj][m][1];
          if (rope) {
            const int s = row % SEGL;
            if (s >= CTXL) {
              const int idx = (s - CTXL) * 32 + ((col8 & 63) >> 1);
              const f32x4 c = *(const f32x4*)(RC + idx), sn = *(const f32x4*)(RS + idx);
              f32x4 a, b;
              a[0] = v0[0] * c[0] - v0[1] * sn[0]; a[1] = v0[0] * sn[0] + v0[1] * c[0]; a[2] = v0[2] * c[1] - v0[3] * sn[1]; a[3] = v0[2] * sn[1] + v0[3] * c[1];
              b[0] = v1[0] * c[2] - v1[1] * sn[2]; b[1] = v1[0] * sn[2] + v1[1] * c[2]; b[2] = v1[2] * c[3] - v1[3] * sn[3]; b[3] = v1[2] * sn[3] + v1[3] * c[3];
              v0 = a; v1 = b;
            }
          }
          u32x4 w; w.x = cvtpk(v0[0] * scl, v0[1] * scl); w.y = cvtpk(v0[2] * scl, v0[3] * scl); w.z = cvtpk(v1[0] * scl, v1[1] * scl); w.w = cvtpk(v1[2] * scl, v1[3] * scl);
          *(u32x4*)(PROJ + (size_t)row * PW + col8) = w;
        }
    }
  }
};
struct EpiOutproj {
  static constexpr bool PERM = true, AFTER_DRAIN = false;
  float* XC; const float* MODL; const float* xin; const float* ctxin; int first; float gsc;
  __device__ __forceinline__ void operator()(const pg8::f32x4 (&acc)[2][2][4][2], const pg8::Unit& u, int wr, int wc, int fr, int fq) const {
    const int mr = (u.pm % 33) == 0 ? 4 : u.pm / 33;
    const float* g1 = MODL + (size_t)mr * 6144 + 2048;
#pragma unroll
    for (int bj = 0; bj < 2; ++bj) {
      const int col8 = u.pn * 256 + bj * 128 + wc * 32 + 8 * fq;
      const f32x4 ga = *(const f32x4*)(g1 + col8) * gsc, gb = *(const f32x4*)(g1 + col8 + 4) * gsc;
#pragma unroll
      for (int ai = 0; ai < 2; ++ai)
#pragma unroll
        for (int m = 0; m < 4; ++m) {
          const int row = u.pm * 256 + ai * 128 + wr * 64 + m * 16 + fr;
          const float* xo = first ? in_row(xin, ctxin, row) + col8 : XC + (size_t)row * DM + col8;
          const f32x4 xa = *(const f32x4*)xo, xb = *(const f32x4*)(xo + 4);
          *(f32x4*)(XC + (size_t)row * DM + col8) = xa + ga * acc[ai][bj][m][0];
          *(f32x4*)(XC + (size_t)row * DM + col8 + 4) = xb + gb * acc[ai][bj][m][1];
        }
    }
  }
};
struct EpiPeerq {
  static constexpr bool PERM = true, AFTER_DRAIN = false;
  bf16_t* QP;
  __device__ __forceinline__ void operator()(const pg8::f32x4 (&acc)[2][2][4][2], const pg8::Unit& u, int wr, int wc, int fr, int fq) const {
#pragma unroll
    for (int bj = 0; bj < 2; ++bj) {
      const int col8 = u.pn * 256 + bj * 128 + wc * 32 + 8 * fq;
#pragma unroll
      for (int ai = 0; ai < 2; ++ai)
#pragma unroll
        for (int m = 0; m < 4; ++m) {
          const int row = u.pm * 256 + ai * 128 + wr * 64 + m * 16 + fr;
          const f32x4 v0 = acc[ai][bj][m][0], v1 = acc[ai][bj][m][1];
          u32x4 w; w.x = cvtpk(v0[0], v0[1]); w.y = cvtpk(v0[2], v0[3]); w.z = cvtpk(v1[0], v1[1]); w.w = cvtpk(v1[2], v1[3]);
          *(u32x4*)(QP + (size_t)row * DM + col8) = w;
        }
    }
  }
};
__device__ __forceinline__ void phase_inproj2(const Params& p, int l, unsigned char* lds) {
  {
    pg8::Gemm g{(const bf16_t*)(p.ws + WS_H), (const bf16_t*)(p.ws + WS_WIN) + (size_t)l * PW * DM, T, PW, DM};
    pg8::StaticOrder S; S.init(T, PW, p.gx, p.bx);
    EpiInproj E{(bf16_t*)(p.ws + WS_PROJ), (const float*)(p.ws + WS_ROPE), (const float*)(p.ws + WS_ROPE) + SEQ * 32, p.ws + WS_V8T};
    pg8::gemm_phase<EpiInproj, pg8::StaticOrder, true, true>((PG8_LAS unsigned char*)lds, g, S, E);
  }
  int tid_ = tidx(); asm volatile("" : "+v"(tid_)); const int tid = tid_, lane = tid & 63, wid = tid >> 6;
  const bf16_t* H = (const bf16_t*)(p.ws + WS_H);
  for (int pm = p.gx - 1 - p.bx; pm < T / 256; pm += p.gx) {
    const int rowb = pm * 256 + wid * 32;
    const bf16_t* WG = (const bf16_t*)(p.ws + WS_WG) + (size_t)l * 16 * DM;
    float* GT = (float*)(p.ws + WS_GATES);
    const int r16 = lane & 15, q4 = lane >> 4;
    f32x4 c0 = {0.f, 0.f, 0.f, 0.f}, c1 = {0.f, 0.f, 0.f, 0.f};
    const bf16_t* a0p = H + (size_t)(rowb + r16) * DM + q4 * 8;
    const bf16_t* a1p = a0p + (size_t)16 * DM;
    const bf16_t* bp = WG + (size_t)r16 * DM + q4 * 8;
#pragma unroll 4
    for (int ks = 0; ks < 32; ++ks) {
      const bf16x8 a0 = *(const bf16x8*)(a0p + ks * 32), a1 = *(const bf16x8*)(a1p + ks * 32), b = *(const bf16x8*)(bp + ks * 32);
      c0 = __builtin_amdgcn_mfma_f32_16x16x32_bf16(a0, b, c0, 0, 0, 0);
      c1 = __builtin_amdgcn_mfma_f32_16x16x32_bf16(a1, b, c1, 0, 0, 0);
    }
    const float gb = p.in[I_GATEB][l * 16 + r16];
#pragma unroll
    for (int j = 0; j < 4; ++j) {
      GT[(size_t)(rowb + q4 * 4 + j) * 16 + r16] = c0[j] + gb;
      GT[(size_t)(rowb + 16 + q4 * 4 + j) * 16 + r16] = c1[j] + gb;
    }
  }
}
__device__ __forceinline__ void phase_outproj2(const Params& p, int l, unsigned char* lds) {
  pg8::Gemm g{(const bf16_t*)(p.ws + WS_MIX), (const bf16_t*)(p.ws + WS_WOUT) + (size_t)l * DM * DM, T, DM, DM};
  pg8::StaticOrder S; S.init(T, DM, p.gx, p.bx);
  for (int rep = 0; rep < REP_OUTP; ++rep) {
  EpiOutproj E{(float*)(p.ws + WS_XCUR), (const float*)(p.ws + WS_MOD) + (size_t)l * 5 * 6144, p.in[I_X], p.in[I_CTX], l == 0, (rep == REP_OUTP - 1) ? 1.f : 0.f};
  pg8::gemm_phase<EpiOutproj, pg8::StaticOrder, true, true>((PG8_LAS unsigned char*)lds, g, S, E);
  }
  tail_filler_tables(p, l, (T / 256) * (DM / 256), l == 0 ? 0 : NEXP, 2 * NEXP);
}
__device__ __forceinline__ void phase_peerq2(const Params& p, int l, unsigned char* lds) {
  pg8::Gemm g{(const bf16_t*)(p.ws + WS_H), (const bf16_t*)(p.ws + WS_WQ) + (size_t)l * DM * DM, T, DM, DM};
  pg8::StaticOrder S; S.init(T, DM, p.gx, p.bx);
  EpiPeerq E{(bf16_t*)(p.ws + WS_PROJ)};
  pg8::gemm_phase<EpiPeerq, pg8::StaticOrder, true, true>((PG8_LAS unsigned char*)lds, g, S, E);
  if (l < DEPTH - 1) tail_filler_tables(p, l + 1, (T / 256) * (DM / 256), 0, NEXP);
}

__device__ __forceinline__ void conv_unit(const Params& p, int l, int unit, unsigned char* lds) {
  int tid_ = tidx(); asm volatile("" : "+v"(tid_)); const int tid = tid_, lane = tid & 63, wid = tid >> 6;
  float* U = (float*)lds;
  const bf16_t* PROJ = (const bf16_t*)(p.ws + WS_PROJ);
  bf16_t* MIX = (bf16_t*)(p.ws + WS_MIX);
  const int row0 = unit * 32, b = row0 / SEGL, s0 = row0 - b * SEGL;
  const int seglo = s0 < CTXL ? 0 : CTXL, seghi = s0 < CTXL ? CTXL : SEGL;
  for (int rr = tid >> 5; rr < 62; rr += 16) {
    const int s = s0 - 15 + rr, c8 = (tid & 31) * 8;
    f32x4 u0 = {0.f, 0.f, 0.f, 0.f}, u1 = {0.f, 0.f, 0.f, 0.f};
    if (s >= seglo && s < seghi) {
      const bf16_t* pr = PROJ + (size_t)(b * SEGL + s) * PW + c8;
      const u32x4 a1 = *(const u32x4*)pr, a2 = *(const u32x4*)(pr + 256);
      u0.x = bflo(a1.x) * sigmoidf_(bflo(a2.x)); u0.y = bfhi(a1.x) * sigmoidf_(bfhi(a2.x));
      u0.z = bflo(a1.y) * sigmoidf_(bflo(a2.y)); u0.w = bfhi(a1.y) * sigmoidf_(bfhi(a2.y));
      u1.x = bflo(a1.z) * sigmoidf_(bflo(a2.z)); u1.y = bfhi(a1.z) * sigmoidf_(bfhi(a2.z));
      u1.z = bflo(a1.w) * sigmoidf_(bflo(a2.w)); u1.w = bfhi(a1.w) * sigmoidf_(bfhi(a2.w));
    }
    *(f32x4*)(U + rr * 256 + c8) = u0; *(f32x4*)(U + rr * 256 + c8 + 4) = u1;
  }
  __syncthreads();
  float* Y = U + 62 * 256;
  const float* cw = p.in[I_CONVW] + (size_t)l * 31 * 256;
#pragma unroll 1
  for (int q = 0; q < 4; ++q) {
    const int c = lane + 64 * q;
    float w[31];
#pragma unroll
    for (int j = 0; j < 31; ++j) w[j] = cw[j * 256 + c];
    const float bias = p.in[I_CONVB][l * 256 + c];
#pragma unroll
    for (int tt = 0; tt < 4; ++tt) {
      const int t = wid * 4 + tt;
      float a = bias;
#pragma unroll
      for (int j = 0; j < 31; ++j) a += U[(t + j) * 256 + c] * w[j];
      Y[t * 256 + c] = a;
    }
  }
  asm volatile("s_waitcnt lgkmcnt(0)" ::: "memory");
  float y[4][4];
#pragma unroll
  for (int tt = 0; tt < 4; ++tt)
#pragma unroll
    for (int q = 0; q < 4; ++q) y[tt][q] = Y[(wid * 4 + tt) * 256 + lane + 64 * q];
#pragma unroll
  for (int tt = 0; tt < 4; ++tt) {
    const int t = wid * 4 + tt;
    const float mean = wave_sum((y[tt][0] + y[tt][1]) + (y[tt][2] + y[tt][3])) * (1.f / 256.f);
    float v = 0.f;
#pragma unroll
    for (int q = 0; q < 4; ++q) { const float d = y[tt][q] - mean; v += d * d; }
    const float rs = rsqrtf(wave_sum(v) * (1.f / 256.f) + EPS);
#pragma unroll
    for (int q = 0; q < 4; ++q) {
      const int c = lane + 64 * q;
      const float z = (y[tt][q] - mean) * rs * p.in[I_CLNG][l * 256 + c] + p.in[I_CLNB][l * 256 + c];
      const float o = (ABL & 1) ? 0.f : z * sigmoidf_(z);
      MIX[(size_t)(row0 + t) * DM + c] = (bf16_t)(cvtpk(o, 0.f) & 0xffffu);
    }
  }
  __syncthreads();
}

__device__ __forceinline__ int ml_cidx(int ch, int dir) { return dir == 0 ? ch : (ch < 4 ? 3 - ch : 135 - ch); }
__device__ __forceinline__ void ml_load_tile(const bf16_t* src, float* dst, int tid) {
  const int r = tid >> 3, c8 = (tid & 7) * 8;
  const u32x4 a = *(const u32x4*)(src + (size_t)r * PW + c8);
  float* d = dst + r * 65 + c8;
  d[0] = bflo(a.x); d[1] = bfhi(a.x); d[2] = bflo(a.y); d[3] = bfhi(a.y); d[4] = bflo(a.z); d[5] = bfhi(a.z); d[6] = bflo(a.w); d[7] = bfhi(a.w);
}
__device__ __forceinline__ void ml_local_unit(const Params& p, int l, int unit, unsigned char* lds) {
  int tid_ = tidx(); asm volatile("" : "+v"(tid_)); const int tid = tid_, lane = tid & 63, wid = tid >> 6, r32 = lane & 31, hi = lane >> 5;
  float* Kt = (float*)lds; float* Vt = Kt + 64 * 65; float* WK = Vt + 64 * 65;
  const bf16_t* PROJ = (const bf16_t*)(p.ws + WS_PROJ);
  const float* GT = (const float*)(p.ws + WS_GATES);
  float* UL = (float*)(p.ws + WS_ULOC); float* META = (float*)(p.ws + WS_MLMETA);
  const int b = unit / (4 * NCH), hh = (unit / NCH) & 3, ch = unit % NCH;
  const int row0 = b * SEGL + ch * 64;
  ml_load_tile(PROJ + (size_t)row0 * PW + C_MK + hh * 64, Kt, tid);
  ml_load_tile(PROJ + (size_t)row0 * PW + C_MV + hh * 64, Vt, tid);
  if (wid < 2) {
    const int dir = wid;
    const float ig = GT[(size_t)(row0 + lane) * 16 + (2 * dir) * 4 + hh];
    const float lf = logsigmoidf_(GT[(size_t)(row0 + lane) * 16 + (2 * dir + 1) * 4 + hh]);
    float ps = lf;
    ps = wave_incl_scan(ps);
    const float tot = __uint_as_float((unsigned)__builtin_amdgcn_readlane((int)__float_as_uint(ps), 63));
    const float wlog = dir == 0 ? (tot - ps + ig) : (ps - lf + ig);
    const float mloc = wave_max(wlog);
    WK[dir * 64 + lane] = __expf(wlog - mloc);
    if (lane == 0) {
      const int seq = (b * 4 + hh) * 2 + dir, ci = ml_cidx(ch, dir);
      META[((size_t)seq * NCH + ci) * 4 + 0] = tot; META[((size_t)seq * NCH + ci) * 4 + 1] = mloc;
    }
  }
  __syncthreads();
  {
    const int dir = wid >> 2, et = (wid >> 1) & 1, dt = wid & 1;
    const int seq = (b * 4 + hh) * 2 + dir, ci = ml_cidx(ch, dir);
    float* slot = UL + ((size_t)seq * NCH + ci) * USTRIDE;
    f32x16 acc = {};
#pragma unroll 8
    for (int ks = 0; ks < 32; ++ks) {
      const int s = 2 * ks + hi;
      const float a = WK[dir * 64 + s] * Vt[s * 65 + et * 32 + r32];
      const float bb = Kt[s * 65 + dt * 32 + r32];
      acc = __builtin_amdgcn_mfma_f32_32x32x2f32(a, bb, acc, 0, 0, 0);
    }
#pragma unroll
    for (int r = 0; r < 16; ++r) slot[(et * 32 + crow(r, hi)) * 64 + dt * 32 + r32] = acc[r];
    if (et == 0) {
      float n = 0.f;
#pragma unroll 8
      for (int i = 0; i < 32; ++i) { const int s = hi * 32 + i; n += WK[dir * 64 + s] * Kt[s * 65 + dt * 32 + r32]; }
      n = sum_xor32(n);
      if (hi == 0) slot[4096 + dt * 32 + r32] = n;
    }
  }
  __syncthreads();
}
constexpr int MLP = 144;
constexpr size_t WS_CST = WS_H;
constexpr size_t WS_NST = WS_H + (size_t)32 * NCH * 4096 * 2;
__device__ __forceinline__ void ml_stage_rm(const bf16_t* src, size_t ld, unsigned char* dst, int tid) {
  const int r = tid >> 3, c8 = (tid & 7) * 8;
  *(u32x4*)(dst + r * MLP + c8 * 2) = *(const u32x4*)(src + (size_t)r * ld + c8);
}
__device__ __forceinline__ void ml_stage_tr(const bf16_t* src, size_t ld, unsigned char* dst, int tid) {
  const int r = tid >> 3, c8 = (tid & 7) * 8;
  const u32x4 a = *(const u32x4*)(src + (size_t)r * ld + c8);
  bf16_t* d = (bf16_t*)dst;
  d[(c8 + 0) * 72 + r] = (bf16_t)(a.x & 0xffffu); d[(c8 + 1) * 72 + r] = (bf16_t)(a.x >> 16);
  d[(c8 + 2) * 72 + r] = (bf16_t)(a.y & 0xffffu); d[(c8 + 3) * 72 + r] = (bf16_t)(a.y >> 16);
  d[(c8 + 4) * 72 + r] = (bf16_t)(a.z & 0xffffu); d[(c8 + 5) * 72 + r] = (bf16_t)(a.z >> 16);
  d[(c8 + 6) * 72 + r] = (bf16_t)(a.w & 0xffffu); d[(c8 + 7) * 72 + r] = (bf16_t)(a.w >> 16);
}
__device__ __forceinline__ void ml_local_unit2(const Params& p, int l, int unit, unsigned char* lds) {
  int tid_ = tidx(); asm volatile("" : "+v"(tid_)); const int tid = tid_, lane = tid & 63, wid = tid >> 6, r32 = lane & 31, hi = lane >> 5;
  unsigned char* KT = lds; unsigned char* VT = lds + 64 * MLP; float* WK = (float*)(lds + 2 * 64 * MLP);
  const bf16_t* PROJ = (const bf16_t*)(p.ws + WS_PROJ);
  const float* GT = (const float*)(p.ws + WS_GATES);
  float* UL = (float*)(p.ws + WS_ULOC); float* META = (float*)(p.ws + WS_MLMETA);
  const int b = unit / (4 * NCH), hh = (unit / NCH) & 3, ch = unit % NCH;
  const int row0 = b * SEGL + ch * 64;
  ml_stage_tr(PROJ + (size_t)row0 * PW + C_MK + hh * 64, PW, KT, tid);
  ml_stage_tr(PROJ + (size_t)row0 * PW + C_MV + hh * 64, PW, VT, tid);
  if (wid < 2) {
    const int dir = wid;
    const float ig = GT[(size_t)(row0 + lane) * 16 + (2 * dir) * 4 + hh];
    const float lf = logsigmoidf_(GT[(size_t)(row0 + lane) * 16 + (2 * dir + 1) * 4 + hh]);
    float ps = lf;
    ps = wave_incl_scan(ps);
    const float tot = __uint_as_float((unsigned)__builtin_amdgcn_readlane((int)__float_as_uint(ps), 63));
    const float wlog = dir == 0 ? (tot - ps + ig) : (ps - lf + ig);
    const float mloc = wave_max(wlog);
    WK[dir * 64 + lane] = __expf(wlog - mloc);
    if (lane == 0) {
      const int seq = (b * 4 + hh) * 2 + dir, ci = ml_cidx(ch, dir);
      META[((size_t)seq * NCH + ci) * 4 + 0] = tot; META[((size_t)seq * NCH + ci) * 4 + 1] = mloc;
    }
  }
  __syncthreads();
  {
    const int dir = wid >> 2, et = (wid >> 1) & 1, dt = wid & 1;
    const int seq = (b * 4 + hh) * 2 + dir, ci = ml_cidx(ch, dir);
    float* slot = UL + ((size_t)seq * NCH + ci) * USTRIDE;
    f32x16 acc = {};
#pragma unroll
    for (int ks = 0; ks < 4; ++ks) {
      const int s0 = ks * 16 + hi * 8;
      const u32x4 va = *(const u32x4*)(VT + (et * 32 + r32) * MLP + s0 * 2);
      const bf16x8 kb = *(const bf16x8*)(KT + (dt * 32 + r32) * MLP + s0 * 2);
      const f32x4 w0 = *(const f32x4*)(WK + dir * 64 + s0), w1 = *(const f32x4*)(WK + dir * 64 + s0 + 4);
      u32x4 sa; sa.x = cvtpk(bflo(va.x) * w0.x, bfhi(va.x) * w0.y); sa.y = cvtpk(bflo(va.y) * w0.z, bfhi(va.y) * w0.w);
      sa.z = cvtpk(bflo(va.z) * w1.x, bfhi(va.z) * w1.y); sa.w = cvtpk(bflo(va.w) * w1.z, bfhi(va.w) * w1.w);
      acc = __builtin_amdgcn_mfma_f32_32x32x16_bf16(*(const bf16x8*)&sa, kb, acc, 0, 0, 0);
    }
#pragma unroll
    for (int r = 0; r < 16; ++r) slot[(et * 32 + crow(r, hi)) * 64 + dt * 32 + r32] = acc[r];
    if (et == 0) {
      float n = 0.f;
#pragma unroll
      for (int i = 0; i < 4; ++i) {
        const int s0 = hi * 32 + i * 8;
        const u32x4 ka = *(const u32x4*)(KT + (dt * 32 + r32) * MLP + s0 * 2);
        const f32x4 w0 = *(const f32x4*)(WK + dir * 64 + s0), w1 = *(const f32x4*)(WK + dir * 64 + s0 + 4);
        n += bflo(ka.x) * w0.x + bfhi(ka.x) * w0.y + bflo(ka.y) * w0.z + bfhi(ka.y) * w0.w + bflo(ka.z) * w1.x + bfhi(ka.z) * w1.y + bflo(ka.w) * w1.z + bfhi(ka.w) * w1.w;
      }
      n = sum_xor32(n);
      if (hi == 0) slot[4096 + dt * 32 + r32] = n;
    }
  }
  __syncthreads();
}
__device__ __forceinline__ void ml_scan(const Params& p, unsigned char* lds) {
  float* UL = (float*)(p.ws + WS_ULOC); float* META = (float*)(p.ws + WS_MLMETA);
  int tid_ = tidx(); asm volatile("" : "+v"(tid_));
  const int tid = tid_, lane = tid & 63, wid = tid >> 6;
  float* DEC = (float*)lds;
  float* SCL = DEC + 2 * NCH;
  float* TMP = SCL + 2 * NCH;
  constexpr int NSL = (32 * USTRIDE + 511) / 512;
  const int first_ = p.gx > 64 ? 16 : 0, nb_ = p.gx - first_;
  for (int k_ = 0; k_ < 2 + (NSL + nb_ - 1) / nb_; ++k_) {
    int s_;
    if (k_ == 0) s_ = p.bx >= first_ ? p.bx - first_ : -1;
    else s_ = k_ * nb_ + (p.gx - 1 - p.bx);
    if (k_ > 0 && p.gx - 1 - p.bx >= nb_) s_ = -1;
    if (s_ < 0 || s_ >= NSL) continue;
    const int base0 = s_ * 512;
    const int seq0 = base0 / USTRIDE;
    if (wid < 2) {
      const int seq = seq0 + wid;
      if (seq < 32) {
        float* mt = META + (size_t)seq * NCH * 4;
        for (int c = lane; c < NCH; c += 64) { TMP[(wid * 2 + 0) * NCH + c] = mt[c * 4 + 0]; TMP[(wid * 2 + 1) * NCH + c] = mt[c * 4 + 1]; }
        asm volatile("s_waitcnt lgkmcnt(0)" ::: "memory");
        if (lane == 0) {
          float m = 0.f;
          for (int c = 0; c < NCH; ++c) {
            const float bl = TMP[(wid * 2 + 0) * NCH + c], mloc = TMP[(wid * 2 + 1) * NCH + c];
            const float mn = fmaxf(bl + m, mloc);
            DEC[wid * NCH + c] = __expf(bl + m - mn); SCL[wid * NCH + c] = __expf(mloc - mn);
            mt[c * 4 + 2] = m;
            m = mn;
          }
        }
      }
    }
    __syncthreads();
    const int idx = base0 + tid;
    if (idx < 32 * USTRIDE) {
      const int seq = idx / USTRIDE, e = idx - seq * USTRIDE, sl = seq - seq0;
      float* bp = UL + (size_t)seq * NCH * USTRIDE + e;
      bf16_t* CSTp = (bf16_t*)(p.ws + WS_CST) + (size_t)seq * NCH * 4096 + (e < 4096 ? e : 0);
      float* NSTp = (float*)(p.ws + WS_NST) + (size_t)seq * NCH * 64 + (e < 4096 ? 0 : e - 4096);
      const float* dec = DEC + sl * NCH; const float* scl = SCL + sl * NCH;
      float C = 0.f;
      constexpr int BT = 33;
      static_assert(NCH == 4 * BT, "scan batches");
      float ua[BT], ub[BT];
#define SCAN_LD(u_, c0_) _Pragma("unroll") for (int j = 0; j < BT; ++j) u_[j] = bp[(size_t)((c0_) + j) * USTRIDE];
#define SCAN_DO(u_, c0_) _Pragma("unroll") for (int j = 0; j < BT; ++j) { \
          if (e < 4096) CSTp[(size_t)((c0_) + j) * 4096] = (bf16_t)(cvtpk(C, 0.f) & 0xffffu); else NSTp[(size_t)((c0_) + j) * 64] = C; \
          C = dec[(c0_) + j] * C + scl[(c0_) + j] * u_[j]; }
      SCAN_LD(ua, 0)
#pragma unroll 1
      for (int c0 = 0; c0 < NCH; c0 += 2 * BT) {
        SCAN_LD(ub, c0 + BT)
        SCAN_DO(ua, c0)
        if (c0 + 2 * BT < NCH) { SCAN_LD(ua, c0 + 2 * BT) }
        SCAN_DO(ub, c0 + BT)
      }
#undef SCAN_LD
#undef SCAN_DO
    }
    __syncthreads();
  }
}
__device__ __forceinline__ void ml_out_unit(const Params& p, int l, int unit, unsigned char* lds) {
  int tid_ = tidx(); asm volatile("" : "+v"(tid_)); const int tid = tid_, lane = tid & 63, wid = tid >> 6, r32 = lane & 31, hi = lane >> 5;
  float* Qt = (float*)lds; float* Kt = Qt + 64 * 65; float* Vt = Kt + 64 * 65;
  float* Cs = Vt + 64 * 65;
  float* Ns = Cs + 2 * 64 * 65;
  float* Bq = Ns + 128;
  float* Gs = Bq + 128;
  float* Mi = Gs + 128;
  float* HB = Mi + 64;
  const bf16_t* PROJ = (const bf16_t*)(p.ws + WS_PROJ);
  const float* GT = (const float*)(p.ws + WS_GATES);
  const float* UL = (const float*)(p.ws + WS_ULOC); const float* META = (const float*)(p.ws + WS_MLMETA);
  bf16_t* MIX = (bf16_t*)(p.ws + WS_MIX);
  const int b = unit / (4 * NCH), hh = (unit / NCH) & 3, ch = unit % NCH;
  const int row0 = b * SEGL + ch * 64;
  ml_load_tile(PROJ + (size_t)row0 * PW + C_MQ + hh * 64, Qt, tid);
  ml_load_tile(PROJ + (size_t)row0 * PW + C_MK + hh * 64, Kt, tid);
  ml_load_tile(PROJ + (size_t)row0 * PW + C_MV + hh * 64, Vt, tid);
  for (int i = tid; i < 2 * USTRIDE; i += 512) {
    const int dir = i / USTRIDE, e = i - dir * USTRIDE;
    const int seq = (b * 4 + hh) * 2 + dir, ci = ml_cidx(ch, dir);
    const float v = UL[((size_t)seq * NCH + ci) * USTRIDE + e];
    if (e < 4096) Cs[dir * 64 * 65 + (e >> 6) * 65 + (e & 63)] = v; else Ns[dir * 64 + (e - 4096)] = v;
  }
  if (wid < 2) {
    const int dir = wid;
    const float ig = GT[(size_t)(row0 + lane) * 16 + (2 * dir) * 4 + hh];
    const float lf = logsigmoidf_(GT[(size_t)(row0 + lane) * 16 + (2 * dir + 1) * 4 + hh]);
    float ps = lf;
    ps = wave_incl_scan(ps);
    const float tot = __uint_as_float((unsigned)__builtin_amdgcn_readlane((int)__float_as_uint(ps), 63));
    const float bc = dir == 0 ? ps : (tot - ps + lf);
    Bq[dir * 64 + lane] = bc; Gs[dir * 64 + lane] = ig - bc;
    if (lane == 0) { const int seq = (b * 4 + hh) * 2 + dir, ci = ml_cidx(ch, dir); Mi[dir] = META[((size_t)seq * NCH + ci) * 4 + 2]; }
  }
  __syncthreads();
  {
    const int dir = wid >> 2, tt = (wid >> 1) & 1, et = wid & 1;
    const int t = tt * 32 + r32;
    f32x16 sa[2] = {};
#pragma unroll 4
    for (int ks = 0; ks < 32; ++ks) {
      const float bq = Qt[t * 65 + 2 * ks + hi];
      const float a0 = Kt[(r32) * 65 + 2 * ks + hi], a1 = Kt[(32 + r32) * 65 + 2 * ks + hi];
      sa[0] = __builtin_amdgcn_mfma_f32_32x32x2f32(a0, bq, sa[0], 0, 0, 0);
      sa[1] = __builtin_amdgcn_mfma_f32_32x32x2f32(a1, bq, sa[1], 0, 0, 0);
    }
    const float bt = Bq[dir * 64 + t];
    const float inter = bt + Mi[dir];
    float mx = -INFINITY;
    f32x16 dl[2];
#pragma unroll
    for (int st = 0; st < 2; ++st)
#pragma unroll
      for (int r = 0; r < 16; ++r) {
        const int s = st * 32 + crow(r, hi);
        const bool ok = dir == 0 ? (s <= t) : (s >= t);
        const float d = ok ? bt + Gs[dir * 64 + s] : -INFINITY;
        dl[st][r] = d; mx = fmaxf(mx, d);
      }
    mx = max_xor32(mx);
    const float mt = fmaxf(inter, mx);
    const float iw = __expf(inter - mt);
    float rsum = 0.f;
#pragma unroll
    for (int st = 0; st < 2; ++st)
#pragma unroll
      for (int r = 0; r < 16; ++r) { const float w = __expf(dl[st][r] - mt); sa[st][r] *= w; rsum += sa[st][r]; }
    rsum = sum_xor32(rsum);
    float qn = 0.f;
#pragma unroll 8
    for (int i = 0; i < 32; ++i) { const int d = hi * 32 + i; qn += Ns[dir * 64 + d] * Qt[t * 65 + d]; }
    qn = sum_xor32(qn);
    const float den = rsum + iw * qn;
    const float rden = 1.f / fmaxf(fabsf(den), __expf(-mt));
    f32x16 an = {}, ac = {};
#pragma unroll
    for (int st = 0; st < 2; ++st)
#pragma unroll
      for (int r = 0; r < 16; ++r) {
        const float a = Vt[(st * 32 + crow(r, hi)) * 65 + et * 32 + r32];
        an = __builtin_amdgcn_mfma_f32_32x32x2f32(a, sa[st][r], an, 0, 0, 0);
      }
    const float* Cd = Cs + dir * 64 * 65;
#pragma unroll 4
    for (int ks = 0; ks < 32; ++ks) {
      const float a = Cd[(et * 32 + r32) * 65 + 2 * ks + hi];
      const float bq = Qt[t * 65 + 2 * ks + hi];
      ac = __builtin_amdgcn_mfma_f32_32x32x2f32(a, bq, ac, 0, 0, 0);
    }
#pragma unroll
    for (int r = 0; r < 16; ++r) HB[dir * 64 * 65 + t * 65 + et * 32 + crow(r, hi)] = (an[r] + iw * ac[r]) * rden;
  }
  __syncthreads();
  {
    const int t = tid >> 3, e8 = (tid & 7) * 8;
    float v[8]; float ss = 0.f;
#pragma unroll
    for (int i = 0; i < 8; ++i) { v[i] = HB[t * 65 + e8 + i] + HB[64 * 65 + t * 65 + e8 + i]; ss += v[i] * v[i]; }
    ss += dpp_mov<0xB1>(ss); ss += dpp_mov<0x4E>(ss); ss += dpp_mov<0x141>(ss);
    const float rs = rsqrtf(ss * (1.f / 64.f) + EPS);
    const u32x4 ov = *(const u32x4*)(PROJ + (size_t)(row0 + t) * PW + C_MO + hh * 64 + e8);
    const float og[8] = {bflo(ov.x), bfhi(ov.x), bflo(ov.y), bfhi(ov.y), bflo(ov.z), bfhi(ov.z), bflo(ov.w), bfhi(ov.w)};
    const float* g = p.in[I_MNORMG] + l * 64 + e8;
    float o[8];
#pragma unroll
    for (int i = 0; i < 8; ++i) o[i] = (ABL & 2) ? 0.f : v[i] * rs * g[i] * sigmoidf_(og[i]);
    u32x4 w; w.x = cvtpk(o[0], o[1]); w.y = cvtpk(o[2], o[3]); w.z = cvtpk(o[4], o[5]); w.w = cvtpk(o[6], o[7]);
    *(u32x4*)(MIX + (size_t)(row0 + t) * DM + 256 + hh * 64 + e8) = w;
  }
  __syncthreads();
}


__device__ __forceinline__ void ml_out_unit2(const Params& p, int l, int unit, unsigned char* lds) {
  int tid_ = tidx(); asm volatile("" : "+v"(tid_)); const int tid = tid_, lane = tid & 63, wid = tid >> 6, r32 = lane & 31, hi = lane >> 5;
  unsigned char* Qs = lds; unsigned char* Ks = lds + 64 * MLP; unsigned char* VT = lds + 2 * 64 * MLP; unsigned char* Cs = lds + 3 * 64 * MLP;
  float* Ns = (float*)(lds + 5 * 64 * MLP);
  float* Bq = Ns + 128;
  float* Gs = Bq + 128;
  float* Mi = Gs + 128;
  float* HB = Mi + 64;
  const bf16_t* PROJ = (const bf16_t*)(p.ws + WS_PROJ);
  const float* GT = (const float*)(p.ws + WS_GATES);
  const bf16_t* CST = (const bf16_t*)(p.ws + WS_CST); const float* NST = (const float*)(p.ws + WS_NST); const float* META = (const float*)(p.ws + WS_MLMETA);
  bf16_t* MIX = (bf16_t*)(p.ws + WS_MIX);
  const int b = unit / (4 * NCH), hh = (unit / NCH) & 3, ch = unit % NCH;
  const int row0 = b * SEGL + ch * 64;
  ml_stage_rm(PROJ + (size_t)row0 * PW + C_MQ + hh * 64, PW, Qs, tid);
  ml_stage_rm(PROJ + (size_t)row0 * PW + C_MK + hh * 64, PW, Ks, tid);
  ml_stage_tr(PROJ + (size_t)row0 * PW + C_MV + hh * 64, PW, VT, tid);
#pragma unroll
  for (int dir = 0; dir < 2; ++dir) {
    const int seq = (b * 4 + hh) * 2 + dir, ci = ml_cidx(ch, dir);
    ml_stage_rm(CST + ((size_t)seq * NCH + ci) * 4096, 64, Cs + dir * 64 * MLP, tid);
    if (tid < 64) Ns[dir * 64 + tid] = NST[((size_t)seq * NCH + ci) * 64 + tid];
  }
  if (wid < 2) {
    const int dir = wid;
    const float ig = GT[(size_t)(row0 + lane) * 16 + (2 * dir) * 4 + hh];
    const float lf = logsigmoidf_(GT[(size_t)(row0 + lane) * 16 + (2 * dir + 1) * 4 + hh]);
    float ps = lf;
    ps = wave_incl_scan(ps);
    const float tot = __uint_as_float((unsigned)__builtin_amdgcn_readlane((int)__float_as_uint(ps), 63));
    const float bc = dir == 0 ? ps : (tot - ps + lf);
    Bq[dir * 64 + lane] = bc; Gs[dir * 64 + lane] = ig - bc;
    if (lane == 0) { const int seq = (b * 4 + hh) * 2 + dir, ci = ml_cidx(ch, dir); Mi[dir] = META[((size_t)seq * NCH + ci) * 4 + 2]; }
  }
  __syncthreads();
  {
    const int dir = wid >> 2, tt = (wid >> 1) & 1, et = wid & 1;
    const int t = tt * 32 + r32;
    f32x16 sa[2] = {};
    bf16x8 bq[4];
#pragma unroll
    for (int ks = 0; ks < 4; ++ks) {
      bq[ks] = *(const bf16x8*)(Qs + t * MLP + (ks * 16 + hi * 8) * 2);
      const bf16x8 a0 = *(const bf16x8*)(Ks + r32 * MLP + (ks * 16 + hi * 8) * 2), a1 = *(const bf16x8*)(Ks + (32 + r32) * MLP + (ks * 16 + hi * 8) * 2);
      sa[0] = __builtin_amdgcn_mfma_f32_32x32x16_bf16(a0, bq[ks], sa[0], 0, 0, 0);
      sa[1] = __builtin_amdgcn_mfma_f32_32x32x16_bf16(a1, bq[ks], sa[1], 0, 0, 0);
    }
    const float bt = Bq[dir * 64 + t];
    const float inter = bt + Mi[dir];
    float mx = -INFINITY;
    f32x16 dl[2];
#pragma unroll
    for (int st = 0; st < 2; ++st)
#pragma unroll
      for (int r = 0; r < 16; ++r) {
        const int s = st * 32 + crow(r, hi);
        const bool ok = dir == 0 ? (s <= t) : (s >= t);
        const float d = ok ? bt + Gs[dir * 64 + s] : -INFINITY;
        dl[st][r] = d; mx = fmaxf(mx, d);
      }
    mx = max_xor32(mx);
    const float mt = fmaxf(inter, mx);
    const float iw = __expf(inter - mt);
    float rsum = 0.f;
#pragma unroll
    for (int st = 0; st < 2; ++st)
#pragma unroll
      for (int r = 0; r < 16; ++r) { const float w = __expf(dl[st][r] - mt); sa[st][r] *= w; rsum += sa[st][r]; }
    rsum = sum_xor32(rsum);
    float qn = 0.f;
#pragma unroll
    for (int i = 0; i < 4; ++i) {
      const int d0 = hi * 32 + i * 8;
      const u32x4 qa = *(const u32x4*)(Qs + t * MLP + d0 * 2);
      const f32x4 n0 = *(const f32x4*)(Ns + dir * 64 + d0), n1 = *(const f32x4*)(Ns + dir * 64 + d0 + 4);
      qn += bflo(qa.x) * n0.x + bfhi(qa.x) * n0.y + bflo(qa.y) * n0.z + bfhi(qa.y) * n0.w + bflo(qa.z) * n1.x + bfhi(qa.z) * n1.y + bflo(qa.w) * n1.z + bfhi(qa.w) * n1.w;
    }
    qn = sum_xor32(qn);
    const float den = rsum + iw * qn;
    const float rden = 1.f / fmaxf(fabsf(den), __expf(-mt));
    f32x16 an = {}, ac = {};
#pragma unroll
    for (int st = 0; st < 2; ++st)
#pragma unroll
      for (int k2 = 0; k2 < 2; ++k2) {
        u32x4 bx; bx.x = cvtpk(sa[st][8 * k2 + 0], sa[st][8 * k2 + 1]); bx.y = cvtpk(sa[st][8 * k2 + 2], sa[st][8 * k2 + 3]);
        bx.z = cvtpk(sa[st][8 * k2 + 4], sa[st][8 * k2 + 5]); bx.w = cvtpk(sa[st][8 * k2 + 6], sa[st][8 * k2 + 7]);
        const unsigned char* vrow = VT + (et * 32 + r32) * MLP + (st * 32 + 16 * k2 + 4 * hi) * 2;
        const u32x2 v0 = *(const u32x2*)vrow, v1 = *(const u32x2*)(vrow + 16);
        u32x4 ax; ax.x = v0.x; ax.y = v0.y; ax.z = v1.x; ax.w = v1.y;
        an = __builtin_amdgcn_mfma_f32_32x32x16_bf16(*(const bf16x8*)&ax, *(const bf16x8*)&bx, an, 0, 0, 0);
      }
    const unsigned char* Cd = Cs + dir * 64 * MLP;
#pragma unroll
    for (int ks = 0; ks < 4; ++ks) {
      const bf16x8 a = *(const bf16x8*)(Cd + (et * 32 + r32) * MLP + (ks * 16 + hi * 8) * 2);
      ac = __builtin_amdgcn_mfma_f32_32x32x16_bf16(a, bq[ks], ac, 0, 0, 0);
    }
#pragma unroll
    for (int r = 0; r < 16; ++r) HB[dir * 64 * 65 + t * 65 + et * 32 + crow(r, hi)] = (an[r] + iw * ac[r]) * rden;
  }
  __syncthreads();
  {
    const int t = tid >> 3, e8 = (tid & 7) * 8;
    float v[8]; float ss = 0.f;
#pragma unroll
    for (int i = 0; i < 8; ++i) { v[i] = HB[t * 65 + e8 + i] + HB[64 * 65 + t * 65 + e8 + i]; ss += v[i] * v[i]; }
    ss += dpp_mov<0xB1>(ss); ss += dpp_mov<0x4E>(ss); ss += dpp_mov<0x141>(ss);
    const float rs = rsqrtf(ss * (1.f / 64.f) + EPS);
    const u32x4 ov = *(const u32x4*)(PROJ + (size_t)(row0 + t) * PW + C_MO + hh * 64 + e8);
    const float og[8] = {bflo(ov.x), bfhi(ov.x), bflo(ov.y), bfhi(ov.y), bflo(ov.z), bfhi(ov.z), bflo(ov.w), bfhi(ov.w)};
    const float* g = p.in[I_MNORMG] + l * 64 + e8;
    float o[8];
#pragma unroll
    for (int i = 0; i < 8; ++i) o[i] = (ABL & 2) ? 0.f : v[i] * rs * g[i] * sigmoidf_(og[i]);
    u32x4 w; w.x = cvtpk(o[0], o[1]); w.y = cvtpk(o[2], o[3]); w.z = cvtpk(o[4], o[5]); w.w = cvtpk(o[6], o[7]);
    *(u32x4*)(MIX + (size_t)(row0 + t) * DM + 256 + hh * 64 + e8) = w;
  }
  __syncthreads();
}

#define KSWZ(row, colB) ((row) * 256 + ((colB) ^ (((row) & 15) << 4)))
#define SBAR() __builtin_amdgcn_sched_barrier(0)
constexpr int ATT_SHM_V = 128 * 80, ATT_SHM_K = 64 * 128 * 2;
constexpr float ATT_THR = 8.0f;
__device__ __forceinline__ int v_st(int k, int c) { const int kk = (k & ~0xC) | ((k & 4) << 1) | ((k & 8) >> 1); return ((kk >> 3) * 4 + (c >> 5)) * 512 + ((kk & 7) * 32 + (c & 31)) * 2; }
__device__ __forceinline__ int v_rd_base(int lane) { return ((lane & 3) << 3) | (((lane >> 2) & 3) << 6) | (((lane >> 4) & 1) << 5) | (((lane >> 5) & 1) << 8); }
constexpr int v_rd_off(int d0, int ks, int half) { return d0 * 512 + ks * 4096 + half * 2048; }
template <int OFF> __device__ __forceinline__ s16x4 tr_read(int vb) {
  s16x4 r; asm volatile("ds_read_b64_tr_b16 %0, %1 offset:%2" : "=&v"(r) : "v"(vb), "i"(OFF) : "memory"); return r;
}
template <int D0> __device__ __forceinline__ void pv_one(f32x16& od, int vb, bf16x8 pa0, bf16x8 pa1, bf16x8 pa2, bf16x8 pa3) {
  const s16x4 l0 = tr_read<v_rd_off(D0, 0, 0)>(vb), h0 = tr_read<v_rd_off(D0, 0, 1)>(vb), l1 = tr_read<v_rd_off(D0, 1, 0)>(vb), h1 = tr_read<v_rd_off(D0, 1, 1)>(vb);
  const s16x4 l2 = tr_read<v_rd_off(D0, 2, 0)>(vb), h2 = tr_read<v_rd_off(D0, 2, 1)>(vb), l3 = tr_read<v_rd_off(D0, 3, 0)>(vb), h3 = tr_read<v_rd_off(D0, 3, 1)>(vb);
  asm volatile("s_waitcnt lgkmcnt(0)" ::: "memory"); SBAR();
#define PK(L, H) (bf16x8){L[0], L[1], L[2], L[3], H[0], H[1], H[2], H[3]}
  od = __builtin_amdgcn_mfma_f32_32x32x16_bf16(pa0, PK(l0, h0), od, 0, 0, 0);
  od = __builtin_amdgcn_mfma_f32_32x32x16_bf16(pa1, PK(l1, h1), od, 0, 0, 0);
  od = __builtin_amdgcn_mfma_f32_32x32x16_bf16(pa2, PK(l2, h2), od, 0, 0, 0);
  od = __builtin_amdgcn_mfma_f32_32x32x16_bf16(pa3, PK(l3, h3), od, 0, 0, 0);
#undef PK
}
template <int D0> __device__ __forceinline__ void pv_two(f32x16& oa, f32x16& ob, int vb, bf16x8 a0, bf16x8 a1, bf16x8 a2, bf16x8 a3, bf16x8 b0, bf16x8 b1, bf16x8 b2, bf16x8 b3) {
  const s16x4 l0 = tr_read<v_rd_off(D0, 0, 0)>(vb), h0 = tr_read<v_rd_off(D0, 0, 1)>(vb), l1 = tr_read<v_rd_off(D0, 1, 0)>(vb), h1 = tr_read<v_rd_off(D0, 1, 1)>(vb);
  const s16x4 l2 = tr_read<v_rd_off(D0, 2, 0)>(vb), h2 = tr_read<v_rd_off(D0, 2, 1)>(vb), l3 = tr_read<v_rd_off(D0, 3, 0)>(vb), h3 = tr_read<v_rd_off(D0, 3, 1)>(vb);
  asm volatile("s_waitcnt lgkmcnt(0)" ::: "memory"); SBAR();
#define PK(L, H) (bf16x8){L[0], L[1], L[2], L[3], H[0], H[1], H[2], H[3]}
  const bf16x8 v0 = PK(l0, h0), v1 = PK(l1, h1), v2 = PK(l2, h2), v3 = PK(l3, h3);
  oa = __builtin_amdgcn_mfma_f32_32x32x16_bf16(a0, v0, oa, 0, 0, 0);
  ob = __builtin_amdgcn_mfma_f32_32x32x16_bf16(b0, v0, ob, 0, 0, 0);
  oa = __builtin_amdgcn_mfma_f32_32x32x16_bf16(a1, v1, oa, 0, 0, 0);
  ob = __builtin_amdgcn_mfma_f32_32x32x16_bf16(b1, v1, ob, 0, 0, 0);
  oa = __builtin_amdgcn_mfma_f32_32x32x16_bf16(a2, v2, oa, 0, 0, 0);
  ob = __builtin_amdgcn_mfma_f32_32x32x16_bf16(b2, v2, ob, 0, 0, 0);
  oa = __builtin_amdgcn_mfma_f32_32x32x16_bf16(a3, v3, oa, 0, 0, 0);
  ob = __builtin_amdgcn_mfma_f32_32x32x16_bf16(b3, v3, ob, 0, 0, 0);
#undef PK
}
struct KQFrag { bf16x8 b0, b1, q; };
__device__ __forceinline__ void att_ldkq(KQFrag& f, const LAS unsigned char* l3, int ak, int kofs, int qofs) {
  const LAS unsigned char* kp = l3 + (ak + kofs);
  f.b0 = *(const LAS bf16x8*)kp; f.b1 = *(const LAS bf16x8*)(kp + 8192); f.q = *(const LAS bf16x8*)(l3 + (ak + qofs));
}
#define ATT_MF(pa_, pb_, f_) do { pa_ = __builtin_amdgcn_mfma_f32_32x32x16_bf16(f_.b0, f_.q, pa_, 0, 0, 0); pb_ = __builtin_amdgcn_mfma_f32_32x32x16_bf16(f_.b1, f_.q, pb_, 0, 0, 0); } while (0)
__device__ __forceinline__ void att_qk_all(f32x16& p0, f32x16& p1, f32x16& q0, f32x16& q1, KQFrag& f0, const LAS unsigned char* l3, int ak0, int kofs, int qofs, float ia, float ib) {
  KQFrag f1;
#pragma unroll
  for (int r = 0; r < 16; ++r) { p0[r] = ia; p1[r] = ia; q0[r] = ib; q1[r] = ib; }
  att_ldkq(f1, l3, ak0 ^ (1 << 5), kofs, qofs); ATT_MF(p0, p1, f0); SBAR();
  att_ldkq(f0, l3, ak0 ^ (2 << 5), kofs, qofs); ATT_MF(p0, p1, f1); SBAR();
  att_ldkq(f1, l3, ak0 ^ (3 << 5), kofs, qofs); ATT_MF(p0, p1, f0); SBAR();
  att_ldkq(f0, l3, ak0 ^ (4 << 5), kofs, qofs); ATT_MF(p0, p1, f1); SBAR();
  att_ldkq(f1, l3, ak0 ^ (5 << 5), kofs, qofs); ATT_MF(q0, q1, f0); SBAR();
  att_ldkq(f0, l3, ak0 ^ (6 << 5), kofs, qofs); ATT_MF(q0, q1, f1); SBAR();
  att_ldkq(f1, l3, ak0 ^ (7 << 5), kofs, qofs); ATT_MF(q0, q1, f0); SBAR();
  ATT_MF(q0, q1, f1); SBAR();
}
__device__ __forceinline__ void att_softmax(f32x16& p0, f32x16& p1, float& m_reg, float& l_reg, float& alpha, bool first, i32x8& pa) {
  alpha = 1.f;
  if (first) {
    float pmax = p0[0];
#pragma unroll
    for (int r = 1; r < 16; ++r) pmax = fmaxf(pmax, p0[r]);
#pragma unroll
    for (int r = 0; r < 16; ++r) pmax = fmaxf(pmax, p1[r]);
    { auto rr = __builtin_amdgcn_permlane32_swap(__float_as_uint(pmax), __float_as_uint(pmax), false, false);
      pmax = fmaxf(__uint_as_float(rr[0]), __uint_as_float(rr[1])); }
    alpha = 0.f; m_reg = pmax;
#pragma unroll
    for (int r = 0; r < 16; ++r) { p0[r] -= pmax; p1[r] -= pmax; }
  }
#pragma unroll
  for (int r = 0; r < 16; ++r) { p0[r] = __builtin_amdgcn_exp2f(p0[r]); p1[r] = __builtin_amdgcn_exp2f(p1[r]); }
  float ps;
  {
#define VADD(d_, a_, b_) asm("v_add_f32_e32 %0, %1, %2" : "=v"(d_) : "v"(a_), "v"(b_))
    float s0, s1, s2, s3;
    VADD(s0, p0[0], p0[1]); VADD(s1, p0[8], p0[9]); VADD(s2, p1[0], p1[1]); VADD(s3, p1[8], p1[9]);
#pragma unroll
    for (int r = 2; r < 8; ++r) { VADD(s0, s0, p0[r]); VADD(s1, s1, p0[8 + r]); VADD(s2, s2, p1[r]); VADD(s3, s3, p1[8 + r]); }
    VADD(s0, s0, s1); VADD(s2, s2, s3); VADD(ps, s0, s2);
#undef VADD
  }
  { auto rr = __builtin_amdgcn_permlane32_swap(__float_as_uint(ps), __float_as_uint(ps), false, false);
    ps = __uint_as_float(rr[0]) + __uint_as_float(rr[1]); }
  if (__builtin_expect(!first && __any(ps > 256.f), 0)) {
    float emax = p0[0];
#pragma unroll
    for (int r = 1; r < 16; ++r) emax = fmaxf(emax, p0[r]);
#pragma unroll
    for (int r = 0; r < 16; ++r) emax = fmaxf(emax, p1[r]);
    { auto rr = __builtin_amdgcn_permlane32_swap(__float_as_uint(emax), __float_as_uint(emax), false, false);
      emax = fmaxf(__uint_as_float(rr[0]), __uint_as_float(rr[1])); }
    const float delta = fmaxf(__builtin_amdgcn_logf(emax), 0.f);
    alpha = __builtin_amdgcn_exp2f(-delta); m_reg += delta;
#pragma unroll
    for (int r = 0; r < 16; ++r) { p0[r] *= alpha; p1[r] *= alpha; }
    ps *= alpha;
  }
  l_reg = l_reg * alpha + ps;
#pragma unroll
  for (int v = 0; v < 4; ++v) {
    int w0, w1; asm volatile("" : "=v"(w0), "=v"(w1));
    w0 = __builtin_amdgcn_cvt_pk_fp8_f32(p0[4 * v], p0[4 * v + 1], w0, false); w0 = __builtin_amdgcn_cvt_pk_fp8_f32(p0[4 * v + 2], p0[4 * v + 3], w0, true);
    w1 = __builtin_amdgcn_cvt_pk_fp8_f32(p1[4 * v], p1[4 * v + 1], w1, false); w1 = __builtin_amdgcn_cvt_pk_fp8_f32(p1[4 * v + 2], p1[4 * v + 3], w1, true);
    pa[v] = w0; pa[4 + v] = w1;
  }
}
__device__ __forceinline__ void att_unit(const bf16_t* __restrict__ Qb, const bf16_t* __restrict__ Kh, const unsigned char* __restrict__ V8, bf16_t* __restrict__ Ob,
                                         int nkeys, float lam, const float* __restrict__ ng, float oscale, unsigned char* lds) {
  int tid_ = tidx(); asm volatile("" : "+v"(tid_)); const int tid = tid_, wid = tid >> 6, lane = tid & 63, r32 = lane & 31, hi = lane >> 5;
  const int grp = __builtin_amdgcn_readfirstlane(wid >> 2);
  unsigned char* V_lds = lds; unsigned char* K_lds = lds + 2 * ATT_SHM_V;
  float* wsl = (float*)(lds + 2 * ATT_SHM_V + 2 * ATT_SHM_K) + wid * 64; float* li_l = wsl; float* al_l = wsl + 32;
  float m0 = 0.f, l0 = 0.f, m1 = 0.f, l1 = 0.f;
  f32x16 o0[4] = {}, o1[4] = {};
  unsigned char* Q_lds = lds + 2 * ATT_SHM_V + 2 * ATT_SHM_K + 2048;
#pragma unroll
  for (int i = 0; i < 8; ++i) { const int id = tid + 512 * i, qrw = id >> 4, ch = id & 15;
    *(bf16x8*)(Q_lds + KSWZ(qrw, ch * 16)) = *(const bf16x8*)(Qb + (size_t)qrw * PW + ch * 8); }
  const int qrow = wid * 32 + r32;
  int kso[2];
#pragma unroll
  for (int i = 0; i < 2; ++i) {
    const int o16 = tid + 512 * i;
    { const int row = o16 >> 4, cs = (o16 & 15) ^ (row & 15); kso[i] = row * PW + cs * 8; }
  }
  const unsigned ldsw = (unsigned)__builtin_amdgcn_readfirstlane(wid) * 1024u;
#define GSTAGE_K(b, k0) do { _Pragma("unroll") for (int i_ = 0; i_ < 2; ++i_) \
    __builtin_amdgcn_global_load_lds((const unsigned*)(Kh + (size_t)(k0) * PW + kso[i_]), (LAS unsigned*)(K_lds + (b) * ATT_SHM_K + ldsw + i_ * 8192), 16, 0, 0); } while (0)
#define GSTAGE_V(b, k0) do { const unsigned char* vi_ = V8 + (size_t)((k0) >> 6) * ATT_SHM_V + tid * 16; \
      __builtin_amdgcn_global_load_lds((const unsigned*)vi_, (LAS unsigned*)(V_lds + (b) * ATT_SHM_V + ldsw), 16, 0, 0); \
      if (wid < 2) __builtin_amdgcn_global_load_lds((const unsigned*)(vi_ + 8192), (LAS unsigned*)(V_lds + (b) * ATT_SHM_V + 8192 + ldsw), 16, 0, 0); } while (0)
#define STAGE_PAIR(jj) do { GSTAGE_V((jj) & 1, (jj) * 64); if ((jj) + 1 < NT) GSTAGE_K((jj) & 1, ((jj) + 1) * 64); } while (0)
#define RESC(o, a) do { if (__any((a) < 1.f)) { if (hi == 0) al_l[r32] = (a); asm volatile("s_waitcnt lgkmcnt(0)" ::: "memory"); \
    _Pragma("unroll") for (int d = 0; d < 4; ++d) _Pragma("unroll") for (int r = 0; r < 16; ++r) o[d][r] *= al_l[crow(r, hi)]; } } while (0)
#define ATT_BAR() do { asm volatile("s_waitcnt lgkmcnt(0)" ::: "memory"); __builtin_amdgcn_s_barrier(); asm volatile("" ::: "memory"); } while (0)
  const int NT = nkeys / 64;
  GSTAGE_K(1, 0); STAGE_PAIR(0);
  asm volatile("s_waitcnt vmcnt(0)" ::: "memory"); __syncthreads();
  f32x16 p0, p1, q0, q1; i32x8 pa, pb;
  const LAS unsigned char* l3 = (const LAS unsigned char*)lds;
  const int ak0 = r32 * 256 + ((hi * 16) ^ ((r32 & 15) << 4));
  const int kofs0 = 2 * ATT_SHM_V, qofs0 = 2 * ATT_SHM_V + 2 * ATT_SHM_K + 2048 + __builtin_amdgcn_readfirstlane(wid) * 8192;
  { KQFrag f0; att_ldkq(f0, l3, ak0, kofs0 + ATT_SHM_K, qofs0);
    att_qk_all(p0, p1, q0, q1, f0, l3, ak0, kofs0 + ATT_SHM_K, qofs0, 0.f, 0.f); }
  if (grp) ATT_BAR();
#pragma unroll 1
  for (int j = 0; j < NT; ++j) {
    const int cur = j & 1;
    const bool more = (j + 1 < NT);
    if (grp && more) STAGE_PAIR(j + 1);
    { float alphaA, alphaB;
      const bool first = (j == 0);
      att_softmax(p0, p1, m0, l0, alphaA, first, pa); SBAR();
      att_softmax(q0, q1, m1, l1, alphaB, first, pb); SBAR();
      RESC(o0, alphaA);
      RESC(o1, alphaB); }
    asm volatile("" : "+v"(pa), "+v"(pb), "+v"(m0), "+v"(l0), "+v"(m1), "+v"(l1));
    asm volatile("" : "+v"(o0[0]), "+v"(o0[1]), "+v"(o0[2]), "+v"(o0[3]), "+v"(o1[0]), "+v"(o1[1]), "+v"(o1[2]), "+v"(o1[3]));
    if (!grp) asm volatile("s_waitcnt vmcnt(0)" ::: "memory");
    ATT_BAR();
    if (!grp && more) STAGE_PAIR(j + 1);
    __builtin_amdgcn_s_setprio(1);
    {
      int kofs = kofs0 + cur * ATT_SHM_K, qofs = qofs0, ak = ak0; asm volatile("" : "+s"(kofs), "+s"(qofs), "+v"(ak));
      const LAS unsigned char* vrow = l3 + (r32 * 80 + hi * 32 + cur * ATT_SHM_V);
      u32x4 va0 = *(const LAS u32x4*)vrow, va1 = *(const LAS u32x4*)(vrow + 16), vb0, vb1;
      KQFrag f0;
#define ATT_PV(d0_, x0_, x1_) do { i32x8 bv; bv[0] = (int)x0_.x; bv[1] = (int)x0_.y; bv[2] = (int)x0_.z; bv[3] = (int)x0_.w; bv[4] = (int)x1_.x; bv[5] = (int)x1_.y; bv[6] = (int)x1_.z; bv[7] = (int)x1_.w; \
        o0[d0_] = __builtin_amdgcn_mfma_scale_f32_32x32x64_f8f6f4(pa, bv, o0[d0_], 0, 0, 0, 0x7F7F7F7F, 0, 0x7F7F7F7F); \
        o1[d0_] = __builtin_amdgcn_mfma_scale_f32_32x32x64_f8f6f4(pb, bv, o1[d0_], 0, 0, 0, 0x7F7F7F7F, 0, 0x7F7F7F7F); } while (0)
      vb0 = *(const LAS u32x4*)(vrow + 32 * 80); vb1 = *(const LAS u32x4*)(vrow + 32 * 80 + 16); ATT_PV(0, va0, va1); SBAR();
      va0 = *(const LAS u32x4*)(vrow + 64 * 80); va1 = *(const LAS u32x4*)(vrow + 64 * 80 + 16); ATT_PV(1, vb0, vb1); SBAR();
      vb0 = *(const LAS u32x4*)(vrow + 96 * 80); vb1 = *(const LAS u32x4*)(vrow + 96 * 80 + 16); ATT_PV(2, va0, va1); SBAR();
      att_ldkq(f0, l3, ak, kofs, qofs);
      ATT_PV(3, vb0, vb1); SBAR();
#undef ATT_PV
      asm volatile("" : "+v"(o0[0]), "+v"(o0[1]), "+v"(o0[2]), "+v"(o0[3]), "+v"(o1[0]), "+v"(o1[1]), "+v"(o1[2]), "+v"(o1[3]));
      att_qk_all(p0, p1, q0, q1, f0, l3, ak, kofs, qofs, -m0, -m1);
      asm volatile("" : "+v"(p0), "+v"(p1), "+v"(q0), "+v"(q1));
    }
    __builtin_amdgcn_s_setprio(0);
    if (grp) asm volatile("s_waitcnt vmcnt(0)" ::: "memory");
    ATT_BAR();
  }
  if (!grp) ATT_BAR();
  if (hi == 0) { li_l[r32] = 1.f / l0; al_l[r32] = lam / l1; }
  asm volatile("s_waitcnt lgkmcnt(0)" ::: "memory");
  float ss[16];
#pragma unroll
  for (int r = 0; r < 16; ++r) {
    const float a = li_l[crow(r, hi)], bq = al_l[crow(r, hi)];
    float s = 0.f;
#pragma unroll
    for (int d = 0; d < 4; ++d) { const float v = o0[d][r] * a - o1[d][r] * bq; o0[d][r] = v; s += v * v; }
    s += dpp_mov<0xB1>(s); s += dpp_mov<0x4E>(s); s += dpp_mov<0x141>(s); s += dpp_mov<0x140>(s);
    { auto rr_ = __builtin_amdgcn_permlane16_swap(__float_as_uint(s), __float_as_uint(s), false, false); s = __uint_as_float(rr_[0]) + __uint_as_float(rr_[1]); }
    ss[r] = rsqrtf(s * (1.f / 128.f) + EPS) * oscale;
  }
  bf16_t* Ow = Ob + (size_t)(wid * 32) * DM;
#pragma unroll
  for (int d = 0; d < 4; ++d) {
    const float g = ng[d * 32 + r32];
#pragma unroll
    for (int r = 0; r < 16; ++r) Ow[(size_t)crow(r, hi) * DM + d * 32 + r32] = (ABL & 4) ? (bf16_t)0 : (bf16_t)(cvtpk(o0[d][r] * ss[r] * g, 0.f) & 0xffffu);
  }
  __syncthreads();
#undef GSTAGE_K
#undef GSTAGE_V
#undef STAGE_PAIR
#undef RESC
#undef ATT_BAR
}

__device__ __forceinline__ float ins16(float (&a)[16], float x) {
#pragma unroll
  for (int i = 0; i < 16; ++i) { const float h = fmaxf(a[i], x); x = fminf(a[i], x); a[i] = h; }
  return x;
}
__device__ __forceinline__ void bsort16(float (&a)[16]) {
#pragma unroll
  for (int k = 2; k <= 16; k <<= 1)
#pragma unroll
    for (int j = k >> 1; j > 0; j >>= 1)
#pragma unroll
      for (int i = 0; i < 16; ++i) {
        const int q = i ^ j;
        if (q > i) {
          const bool desc = ((i & k) == 0);
          const float hi_ = fmaxf(a[i], a[q]), lo_ = fminf(a[i], a[q]);
          a[i] = desc ? hi_ : lo_; a[q] = desc ? lo_ : hi_;
        }
      }
}
__device__ __forceinline__ void bmerge16(float (&a)[16], const float (&b)[16]) {
#pragma unroll
  for (int i = 0; i < 16; ++i) a[i] = fmaxf(a[i], b[15 - i]);
#pragma unroll
  for (int j = 8; j > 0; j >>= 1)
#pragma unroll
    for (int i = 0; i < 16; ++i) {
      const int q = i ^ j;
      if (q > i) { const float hi_ = fmaxf(a[i], a[q]), lo_ = fminf(a[i], a[q]); a[i] = hi_; a[q] = lo_; }
    }
}
__device__ __forceinline__ float gelu_erf(float x) { return 0.5f * x * (1.f + erff(x * 0.70710678118654752440f)); }
#define XB_TMO      128
#define XB_XCNT(j)  (256  + 64 * (j))
#define XB_XSUB(j)  (1280 + 64 * (j))
#define XB_XGEN(j)  (2304 + 64 * (j))
#define XB_TOP      3328
#define XB_TOPGEN   3392
#define XCD_BAR_WORDS 3456
#define XB_SPIN_CAP (1u << 22)
__device__ __forceinline__ unsigned xb_ld(unsigned* p)              { return __hip_atomic_load(p, __ATOMIC_RELAXED, __HIP_MEMORY_SCOPE_AGENT); }
__device__ __forceinline__ unsigned xb_add(unsigned* p, unsigned v) { return __hip_atomic_fetch_add(p, v, __ATOMIC_RELAXED, __HIP_MEMORY_SCOPE_AGENT); }
__device__ __forceinline__ unsigned xb_xcc_id() { return (unsigned)__builtin_amdgcn_s_getreg((3 << 11) | 20) & 0xFu; }
#define XB_SPIN(cond, bar) do { unsigned _sp = 0; while (cond) { __builtin_amdgcn_s_sleep(1); \
    if ((++_sp & 255u) == 0u) { if (xb_ld(&(bar)[XB_TMO])) break; if (_sp > XB_SPIN_CAP) { atomicAdd(&(bar)[XB_TMO], 1u); break; } } } } while (0)
struct XcdBarrier { unsigned* bar; unsigned x; volatile LAS unsigned* st; };
__device__ __forceinline__ XcdBarrier xcd_barrier_post(unsigned* bar, volatile LAS unsigned* st) {
  XcdBarrier b; b.bar = bar; b.x = xb_xcc_id(); b.st = st;
  if (tidx() == 0) (void)xb_add(&bar[XB_XCNT(b.x)], 1u);
  return b;
}
__device__ __forceinline__ void xcd_barrier_complete(unsigned* bar, unsigned x, unsigned& nloc, unsigned& nx) {
  const unsigned G = gridDim.x * gridDim.y * gridDim.z;
  unsigned sum, cnt, mine, sp = 0u;
  for (;;) {
    sum = 0u; cnt = 0u; mine = 0u;
#pragma unroll
    for (unsigned j = 0; j < 16; ++j) { const unsigned c = xb_ld(&bar[XB_XCNT(j)]); sum += c; cnt += (c > 0u) ? 1u : 0u; mine = (j == x) ? c : mine; }
    if (sum == G) break;
    __builtin_amdgcn_s_sleep(1);
    if ((++sp & 255u) == 0u) { if (xb_ld(&bar[XB_TMO])) break; if (sp > XB_SPIN_CAP) { atomicAdd(&bar[XB_TMO], 1u); break; } }
  }
  nloc = mine > 0u ? mine : 1u; nx = cnt > 0u ? cnt : 1u;
}
__device__ __forceinline__ void xcd_barrier(const XcdBarrier& b) {
  asm volatile("s_waitcnt vmcnt(0)" ::: "memory");
  __syncthreads();
  if (tidx() == 0) {
    unsigned* bar = b.bar;
    __builtin_amdgcn_s_waitcnt(0);
    unsigned nloc = b.st[0], nx = b.st[1];
    if (nloc == 0u) { xcd_barrier_complete(bar, b.x, nloc, nx); b.st[0] = nloc; b.st[1] = nx; }
    const unsigned old = xb_add(&bar[XB_XSUB(b.x)], 1u);
    const unsigned gen = old / nloc;
    if (old + 1u == (gen + 1u) * nloc) {
      __builtin_amdgcn_fence(__ATOMIC_RELEASE, "agent");
      asm volatile("s_waitcnt vmcnt(0)" ::: "memory");
      const unsigned og = xb_add(&bar[XB_TOP], 1u);
      const unsigned tg = og / nx;
      if (og + 1u == (tg + 1u) * nx) xb_add(&bar[XB_TOPGEN], 1u);
      else XB_SPIN(xb_ld(&bar[XB_TOPGEN]) == tg, bar);
      __builtin_amdgcn_fence(__ATOMIC_ACQUIRE, "agent");
      xb_add(&bar[XB_XGEN(b.x)], 1u);
      asm volatile("s_waitcnt vmcnt(0)" ::: "memory");
    } else {
      XB_SPIN(xb_ld(&bar[XB_XGEN(b.x)]) == gen, bar);
      __builtin_amdgcn_fence(__ATOMIC_ACQUIRE, "agent");
      asm volatile("s_waitcnt vmcnt(0)" ::: "memory");
    }
  }
  __syncthreads();
}

constexpr size_t RT_STRIDE = (size_t)T * 128 * 4;
__device__ __forceinline__ void route_unit(const Params& p, int l, int unit, unsigned char* lds) {
  int tid_ = tidx(); asm volatile("" : "+v"(tid_)); const int tid = tid_, lane = tid & 63, wid = tid >> 6, r32 = lane & 31, hi = lane >> 5;
  unsigned char* IDX = lds;
  int* UE = (int*)(lds + 8192); float* UG = (float*)(lds + 8192 + 16384); float* US = (float*)(lds + 8192 + 32768);
  int* EIDG = (int*)(p.ws + WS_EID + (size_t)l * RT_STRIDE); float* GWG = (float*)(p.ws + WS_ULOC + RT_STRIDE); float* SUG = (float*)(p.ws + WS_ULOC + 2 * RT_STRIDE);
  const float* PSC = (const float*)(p.ws + WS_PSC);
  const int row0 = unit * 32;
  const bf16_t* QP = (const bf16_t*)(p.ws + WS_PROJ);
  const bf16_t* KEYS = (const bf16_t*)(p.ws + WS_KEYS) + (size_t)l * 131072;
  for (int rrep = 0; rrep < REP_ROUTE; ++rrep) {
    const int h = wid;
    float top[2][16];
#pragma unroll
    for (int pp = 0; pp < 2; ++pp) {
      const bf16_t* qrow = QP + (size_t)(row0 + r32) * DM + h * 128 + pp * 64 + hi * 8;
      const bf16_t* kb = KEYS + ((size_t)(h * 2 + pp) * 128 + r32) * 64 + hi * 8;
      bf16x8 bq[4];
#pragma unroll
      for (int ks = 0; ks < 4; ++ks) bq[ks] = *(const bf16x8*)(qrow + ks * 16);
      float (&lst)[16] = top[pp];
#pragma unroll
      for (int i = 0; i < 16; ++i) lst[i] = -INFINITY;
#pragma unroll
      for (int nt = 0; nt < 4; ++nt) {
        f32x16 acc = {};
#pragma unroll
        for (int ks = 0; ks < 4; ++ks) {
          const bf16x8 ak = *(const bf16x8*)(kb + (size_t)nt * 32 * 64 + ks * 16);
          acc = __builtin_amdgcn_mfma_f32_32x32x16_bf16(ak, bq[ks], acc, 0, 0, 0);
        }
        float grp[16];
#pragma unroll
        for (int r = 0; r < 16; ++r) grp[r] = __uint_as_float((__float_as_uint(acc[r]) & ~0x7Fu) | (unsigned)(nt * 32 + crow(r, hi)));
        bsort16(grp);
        if (nt == 0) {
#pragma unroll
          for (int i = 0; i < 16; ++i) lst[i] = grp[i];
        } else bmerge16(lst, grp);
        SBAR();
      }
      float oth[16];
#pragma unroll
      for (int i = 0; i < 16; ++i) { auto rr_ = __builtin_amdgcn_permlane32_swap(__float_as_uint(lst[i]), __float_as_uint(lst[i]), false, false); oth[i] = __uint_as_float(hi ? rr_[0] : rr_[1]); }
      bmerge16(lst, oth);
      if (hi == 0) {
        unsigned w[4];
#pragma unroll
        for (int i = 0; i < 4; ++i)
          w[i] = (__float_as_uint(lst[4 * i]) & 0x7Fu) | ((__float_as_uint(lst[4 * i + 1]) & 0x7Fu) << 8) | ((__float_as_uint(lst[4 * i + 2]) & 0x7Fu) << 16) | ((__float_as_uint(lst[4 * i + 3]) & 0x7Fu) << 24);
        *(u32x4*)(IDX + ((r32 * 8 + h) * 2 + pp) * 16) = (u32x4){w[0], w[1], w[2], w[3]};
      }
    }
    float best[16];
#define CAND(i, j) __uint_as_float((__float_as_uint(__uint_as_float(__float_as_uint(top[0][i]) & ~0x7Fu) + __uint_as_float(__float_as_uint(top[1][j]) & ~0x7Fu)) & ~0xFFu) | (unsigned)((i) * 16 + (j)))
    {
#pragma unroll
      for (int j = 0; j < 16; ++j) best[j] = CAND(0, j);
      float y[16];
#pragma unroll
      for (int j = 0; j < 8; ++j) { y[j] = CAND(1, j); y[8 + j] = CAND(15 - j, 0); }
#pragma unroll
      for (int jj = 8; jj > 0; jj >>= 1)
#pragma unroll
        for (int i = 0; i < 16; ++i) { const int q = i ^ jj; if (q > i) { const float hi_ = fmaxf(y[i], y[q]), lo_ = fminf(y[i], y[q]); y[i] = hi_; y[q] = lo_; } }
      bmerge16(best, y);
      float x[16];
      x[0] = CAND(2, 0); x[1] = CAND(2, 1); x[2] = CAND(2, 2); x[3] = CAND(2, 3); x[4] = CAND(2, 4);
      x[5] = CAND(3, 0); x[6] = CAND(3, 1); x[7] = CAND(3, 2); x[8] = CAND(3, 3);
      x[9] = CAND(4, 0); x[10] = CAND(4, 1); x[11] = CAND(4, 2);
      x[12] = CAND(5, 0); x[13] = CAND(5, 1); x[14] = CAND(6, 0); x[15] = CAND(6, 1);
      bsort16(x);
      bmerge16(best, x);
      ins16(best, CAND(7, 0)); ins16(best, CAND(7, 1));
    }
#undef CAND
    asm volatile("s_waitcnt lgkmcnt(0)" ::: "memory");
    if (hi == 0) {
      const unsigned char* ib = IDX + ((r32 * 8 + h) * 2) * 16;
      const float mx = __uint_as_float(__float_as_uint(best[0]) & ~0xFFu);
      float w[16]; float sum = 0.f;
#pragma unroll
      for (int k = 0; k < 16; ++k) { w[k] = __expf(__uint_as_float(__float_as_uint(best[k]) & ~0xFFu) - mx); sum += w[k]; }
      const float rsum = 1.f / sum;
      int ee[16]; float su_[16], sv_[16];
#pragma unroll
      for (int k = 0; k < 16; ++k) {
        const unsigned ij = __float_as_uint(best[k]) & 0xFFu;
        ee[k] = (int)ib[ij >> 4] * 128 + (int)ib[16 + (ij & 15)];
      }
#pragma unroll
      for (int k = 0; k < 16; ++k) { su_[k] = PSC[(size_t)l * NEXP + ee[k]]; sv_[k] = PSC[(size_t)(DEPTH + l) * NEXP + ee[k]]; }
#pragma unroll
      for (int k = 0; k < 16; ++k) {
        UE[r32 * 128 + h * 16 + k] = ee[k]; UG[r32 * 128 + h * 16 + k] = w[k] * rsum * sv_[k];
        US[r32 * 128 + h * 16 + k] = su_[k];
      }
    }
  }
  __syncthreads();
#pragma unroll 1
  for (int tt = 0; tt < 4; ++tt) {
    const int t = wid * 4 + tt;
    const int k0 = UE[t * 128 + lane], k1 = UE[t * 128 + 64 + lane];
    const float g0 = UG[t * 128 + lane], g1 = UG[t * 128 + 64 + lane], s0 = US[t * 128 + lane], s1 = US[t * 128 + 64 + lane];
    const int b0 = k0 >> 10, b1 = k1 >> 10;
    int base = 0, pos0 = 0, pos1 = 0;
#pragma unroll
    for (int b = 0; b < 16; ++b) {
      const unsigned long long m0 = __ballot(b0 == b), m1 = __ballot(b1 == b);
      const int c0 = __popcll(m0), c1 = __popcll(m1);
      const unsigned long long lt = (1ull << lane) - 1ull;
      if (b0 == b) pos0 = base + __popcll(m0 & lt);
      if (b1 == b) pos1 = base + c0 + __popcll(m1 & lt);
      base += c0 + c1;
    }
    const size_t ro = (size_t)(row0 + t) * 128;
    EIDG[ro + pos0] = k0; GWG[ro + pos0] = g0; SUG[ro + pos0] = s0;
    EIDG[ro + pos1] = k1; GWG[ro + pos1] = g1; SUG[ro + pos1] = s1;
  }
}
#define CAS __attribute__((address_space(4)))
typedef int i32x8 __attribute__((ext_vector_type(8)));
struct TokPref { f32x2 gs0, gs1; u32x4 hA, hB; };
struct RowPipe { i32x6 uq[4], vq[4]; i32x8 Ec; };
__device__ __forceinline__ const CAS i32x8* eid_row(const CAS unsigned char* eidg, int row) {
  return (const CAS i32x8*)(eidg + (size_t)(unsigned)__builtin_amdgcn_readfirstlane(row) * 512u);
}
__device__ __forceinline__ void tok_prefetch(const Params& p, int row, int lane, TokPref& t) {
  const float* GWG = (const float*)(p.ws + WS_ULOC + RT_STRIDE) + (size_t)row * 128;
  const float* SUG = (const float*)(p.ws + WS_ULOC + 2 * RT_STRIDE) + (size_t)row * 128;
  const bf16_t* H = (const bf16_t*)(p.ws + WS_H);
  t.gs0 = f32x2{GWG[lane], SUG[lane]}; t.gs1 = f32x2{GWG[64 + lane], SUG[64 + lane]};
  t.hA = *(const u32x4*)(H + (size_t)row * DM + lane * 16); t.hB = *(const u32x4*)(H + (size_t)row * DM + lane * 16 + 8);
}
#define LOADPAIR(dst_, tofs_, ea_, eb_) do { const u32x3v a_ = __builtin_amdgcn_raw_buffer_load_b96(rsT, lane12, (ea_) * PROW + (tofs_), 0); const unsigned b0_ = __builtin_amdgcn_raw_buffer_load_b32(rsT, lane12, (eb_) * PROW + (tofs_), 0); \
      const u32x2v b1_ = __builtin_amdgcn_raw_buffer_load_b64(rsT, lane12 + 4, (eb_) * PROW + (tofs_), 0); \
      dst_[0] = (int)a_.x; dst_[1] = (int)a_.y; dst_[2] = (int)a_.z; dst_[3] = (int)b0_; dst_[4] = (int)b1_.x; dst_[5] = (int)b1_.y; } while (0)
#define LOADGROUP(q_, tofs_, E_) do { LOADPAIR(q_[0], tofs_, E_[0], E_[1]); LOADPAIR(q_[1], tofs_, E_[2], E_[3]); LOADPAIR(q_[2], tofs_, E_[4], E_[5]); LOADPAIR(q_[3], tofs_, E_[6], E_[7]); } while (0)
constexpr int VOFS = (int)(WS_PV - WS_PU);
__device__ __forceinline__ void gather_token(const Params& p, const CAS unsigned char* eidg, const __amdgpu_buffer_rsrc_t rsT, int l, int row, int nextrow, TokPref& tp, RowPipe& rp, unsigned char* lds, int lane, int wid) {
  f32x2* GS = (f32x2*)(lds + wid * 2048);
  float* XC = (float*)(p.ws + WS_XCUR);
  const float* MOD = (const float*)(p.ws + WS_MOD);
  const CAS i32x8* EP = eid_row(eidg, row);
  const bool hasnext = nextrow >= 0;
  const CAS i32x8* EPn = eid_row(eidg, hasnext ? nextrow : row);
  GS[lane] = tp.gs0; GS[64 + lane] = tp.gs1;
  asm volatile("s_waitcnt lgkmcnt(0)" ::: "memory");
  const int eofl = ((lane >> 5) & 1) + 2 * ((lane >> 4) & 1) + 4 * ((lane >> 3) & 1);
  const int lane12 = lane * 12;
  {
    h16x2 hh[8];
    {
      const u32x4 hA = tp.hA, hB = tp.hB;
      hh[0] = __builtin_bit_cast(h16x2, __builtin_amdgcn_cvt_pkrtz(bflo(hA.x), bfhi(hA.x))); hh[1] = __builtin_bit_cast(h16x2, __builtin_amdgcn_cvt_pkrtz(bflo(hA.y), bfhi(hA.y))); hh[2] = __builtin_bit_cast(h16x2, __builtin_amdgcn_cvt_pkrtz(bflo(hA.z), bfhi(hA.z))); hh[3] = __builtin_bit_cast(h16x2, __builtin_amdgcn_cvt_pkrtz(bflo(hA.w), bfhi(hA.w)));
      hh[4] = __builtin_bit_cast(h16x2, __builtin_amdgcn_cvt_pkrtz(bflo(hB.x), bfhi(hB.x))); hh[5] = __builtin_bit_cast(h16x2, __builtin_amdgcn_cvt_pkrtz(bflo(hB.y), bfhi(hB.y))); hh[6] = __builtin_bit_cast(h16x2, __builtin_amdgcn_cvt_pkrtz(bflo(hB.z), bfhi(hB.z))); hh[7] = __builtin_bit_cast(h16x2, __builtin_amdgcn_cvt_pkrtz(bflo(hB.w), bfhi(hB.w)));
    }
    if (hasnext) tok_prefetch(p, nextrow, lane, tp);
    f32x4 xpre[4];
    { const float* xr_ = XC + (size_t)row * DM + lane * 16;
#pragma unroll
      for (int v4 = 0; v4 < 4; ++v4) xpre[v4] = *(const f32x4*)(xr_ + v4 * 4); }
    f32x2 acc2[8];
#pragma unroll
    for (int i = 0; i < 8; ++i) acc2[i] = f32x2{0.f, 0.f};
#pragma unroll 1
    for (int g8 = 0; g8 < 16; ++g8) {
      const bool pf = (g8 < 15) || hasnext;
      const f32x2 gs = GS[g8 * 8 + eofl];
      float d[8];
#pragma unroll
      for (int i2 = 0; i2 < 4; ++i2) {
        const h16x32 r = __builtin_amdgcn_cvt_scalef32_pk32_f16_fp6(rp.uq[i2], 1.0f);
        float a0 = 0.f, a1 = 0.f, b0 = 0.f, b1 = 0.f;
#define UDOT(k_) a0 = __builtin_amdgcn_fdot2(__builtin_shufflevector(r, r, 4 * (k_), 4 * (k_) + 1), hh[2 * (k_)], a0, false); b0 = __builtin_amdgcn_fdot2(__builtin_shufflevector(r, r, 16 + 4 * (k_), 17 + 4 * (k_)), hh[2 * (k_)], b0, false); \
        a1 = __builtin_amdgcn_fdot2(__builtin_shufflevector(r, r, 4 * (k_) + 2, 4 * (k_) + 3), hh[2 * (k_) + 1], a1, false); b1 = __builtin_amdgcn_fdot2(__builtin_shufflevector(r, r, 18 + 4 * (k_), 19 + 4 * (k_)), hh[2 * (k_) + 1], b1, false);
        UDOT(0) UDOT(1) UDOT(2) UDOT(3)
#undef UDOT
        d[2 * i2] = a0 + a1;
        d[2 * i2 + 1] = b0 + b1;
        asm volatile("" : "+v"(d[2 * i2]), "+v"(d[2 * i2 + 1]));
      }
      if (pf) LOADGROUP(rp.uq, 0, rp.Ec);
      float tot;
      {
        auto s01 = __builtin_amdgcn_permlane32_swap(__float_as_uint(d[0]), __float_as_uint(d[1]), false, false);
        auto s23 = __builtin_amdgcn_permlane32_swap(__float_as_uint(d[2]), __float_as_uint(d[3]), false, false);
        auto s45 = __builtin_amdgcn_permlane32_swap(__float_as_uint(d[4]), __float_as_uint(d[5]), false, false);
        auto s67 = __builtin_amdgcn_permlane32_swap(__float_as_uint(d[6]), __float_as_uint(d[7]), false, false);
        const float q01 = __uint_as_float(s01[0]) + __uint_as_float(s01[1]), q23 = __uint_as_float(s23[0]) + __uint_as_float(s23[1]);
        const float q45 = __uint_as_float(s45[0]) + __uint_as_float(s45[1]), q67 = __uint_as_float(s67[0]) + __uint_as_float(s67[1]);
        auto ta = __builtin_amdgcn_permlane16_swap(__float_as_uint(q01), __float_as_uint(q23), false, false);
        auto tb = __builtin_amdgcn_permlane16_swap(__float_as_uint(q45), __float_as_uint(q67), false, false);
        const float r0123 = __uint_as_float(ta[0]) + __uint_as_float(ta[1]);
        const float r4567 = __uint_as_float(tb[0]) + __uint_as_float(tb[1]);
        const bool b3 = (lane & 8) != 0;
        const float keep = b3 ? r4567 : r0123, send = b3 ? r0123 : r4567;
        float x = keep + dpp_mov<0x140>(send);
        x += dpp_mov<0xB1>(x); x += dpp_mov<0x4E>(x); x += dpp_mov<0x141>(x);
        tot = x * gs.y;
      }
      float ge;
      {
        const float v = tot, av = fabsf(v), tq = __builtin_amdgcn_rcpf(av * 0.2316418882f + 1.0f);
        float q = tq * 0.5307027145f + (-0.7265760135f); q = q * tq + 0.7107068705f; q = q * tq + (-0.142248368f); q = q * tq + 0.127414796f; q = q * tq;
        const float ex = __builtin_amdgcn_exp2f(v * v * (-0.72134752044f));
        const float m = v * (q * ex), r = v - m;
        ge = (v < 0.f ? m : r) * gs.x;
      }
      unsigned cw[8];
      { const unsigned gp = __builtin_bit_cast(unsigned, __builtin_amdgcn_cvt_pkrtz(ge * 1024.f, ge * 1024.f));
        cw[0] = (unsigned)__builtin_amdgcn_readlane((int)gp, 0);  cw[4] = (unsigned)__builtin_amdgcn_readlane((int)gp, 8);
        cw[2] = (unsigned)__builtin_amdgcn_readlane((int)gp, 16); cw[6] = (unsigned)__builtin_amdgcn_readlane((int)gp, 24);
        cw[1] = (unsigned)__builtin_amdgcn_readlane((int)gp, 32); cw[5] = (unsigned)__builtin_amdgcn_readlane((int)gp, 40);
        cw[3] = (unsigned)__builtin_amdgcn_readlane((int)gp, 48); cw[7] = (unsigned)__builtin_amdgcn_readlane((int)gp, 56); }
      h16x2 a16[8];
#pragma unroll
      for (int i2 = 0; i2 < 4; ++i2) {
        const h16x32 r = __builtin_amdgcn_cvt_scalef32_pk32_f16_fp6(rp.vq[i2], 1.0f);
        const h16x2 ca = __builtin_bit_cast(h16x2, cw[2 * i2]), cb = __builtin_bit_cast(h16x2, cw[2 * i2 + 1]);
#define VAXL(k_) a16[k_] = (i2 == 0) ? ca * __builtin_shufflevector(r, r, 2 * (k_), 2 * (k_) + 1) : ca * __builtin_shufflevector(r, r, 2 * (k_), 2 * (k_) + 1) + a16[k_];
#define VAXH(k_) a16[k_] = cb * __builtin_shufflevector(r, r, 16 + 2 * (k_), 17 + 2 * (k_)) + a16[k_];
        VAXL(0) VAXL(1) VAXL(2) VAXL(3) VAXL(4) VAXL(5) VAXL(6) VAXL(7)
        asm volatile("" : "+v"(a16[0]), "+v"(a16[1]), "+v"(a16[2]), "+v"(a16[3]), "+v"(a16[4]), "+v"(a16[5]), "+v"(a16[6]), "+v"(a16[7]));
        VAXH(0) VAXH(1) VAXH(2) VAXH(3) VAXH(4) VAXH(5) VAXH(6) VAXH(7)
#undef VAXL
#undef VAXH
        asm volatile("" : "+v"(a16[0]), "+v"(a16[1]), "+v"(a16[2]), "+v"(a16[3]), "+v"(a16[4]), "+v"(a16[5]), "+v"(a16[6]), "+v"(a16[7]));
      }
#pragma unroll
      for (int k = 0; k < 8; ++k) acc2[k] = f32x2{(float)a16[k].x, (float)a16[k].y} * f32x2{1.f / 1024.f, 1.f / 1024.f} + acc2[k];
      if (pf) LOADGROUP(rp.vq, VOFS, rp.Ec);
      { const CAS i32x8* src_ = g8 < 14 ? EP + (g8 + 2) : EPn + (g8 - 14); rp.Ec = *src_; }
    }
    SBAR();
    float acc[16];
#pragma unroll
    for (int i = 0; i < 8; ++i) { acc[2 * i] = acc2[i].x; acc[2 * i + 1] = acc2[i].y; }
    const int mr = mod_row(row);
    const float* g2 = MOD + ((size_t)l * 5 + mr) * 6144 + 5 * 1024;
    float* xr = XC + (size_t)row * DM;
    float xn[16]; float ssq = 0.f;
    if (ABL & 8) {
#pragma unroll
      for (int i = 0; i < 16; ++i) acc[i] = 0.f;
    }
#pragma unroll
    for (int v4 = 0; v4 < 4; ++v4) {
      const int c = lane * 16 + v4 * 4;
      const f32x4 xo = xpre[v4], gg = *(const f32x4*)(g2 + c);
      f32x4 o;
      o.x = xo.x + gg.x * acc[v4 * 4 + 0]; o.y = xo.y + gg.y * acc[v4 * 4 + 1]; o.z = xo.z + gg.z * acc[v4 * 4 + 2]; o.w = xo.w + gg.w * acc[v4 * 4 + 3];
      xn[v4 * 4 + 0] = o.x; xn[v4 * 4 + 1] = o.y; xn[v4 * 4 + 2] = o.z; xn[v4 * 4 + 3] = o.w;
      ssq += (o.x * o.x + o.y * o.y) + (o.z * o.z + o.w * o.w);
      if (l < DEPTH - 1) *(f32x4*)(xr + c) = o;
    }
    const float rs = rsqrtf(wave_sum_fast(ssq) * (1.f / DM) + EPS);
    if (l == DEPTH - 1) {
      const int b = row / SEGL, s = row - b * SEGL;
      float* orow = p.out + ((size_t)(b * SEQ + (s - CTXL))) * DM;
      const float* fg = p.in[I_FINALG];
#pragma unroll
      for (int v4 = 0; v4 < 4; ++v4) {
        const int c = lane * 16 + v4 * 4;
        const f32x4 gg = *(const f32x4*)(fg + c);
        f32x4 o; o.x = xn[v4 * 4 + 0] * rs * gg.x; o.y = xn[v4 * 4 + 1] * rs * gg.y; o.z = xn[v4 * 4 + 2] * rs * gg.z; o.w = xn[v4 * 4 + 3] * rs * gg.w;
        *(f32x4*)(orow + c) = o;
      }
    } else {
      const float* m = MOD + ((size_t)(l + 1) * 5 + mr) * 6144;
      const float* ng = p.in[I_N1G] + (l + 1) * DM;
      bf16_t* hrow = (bf16_t*)(p.ws + WS_H) + (size_t)row * DM;
#pragma unroll
      for (int hh = 0; hh < 2; ++hh) {
        float y[8];
#pragma unroll
        for (int i = 0; i < 8; ++i) { const int c = lane * 16 + hh * 8 + i; y[i] = xn[hh * 8 + i] * rs * ng[c] * (1.f + m[1024 + c]) + m[c]; }
        u32x4 w; w.x = cvtpk(y[0], y[1]); w.y = cvtpk(y[2], y[3]); w.z = cvtpk(y[4], y[5]); w.w = cvtpk(y[6], y[7]);
        *(u32x4*)(hrow + lane * 16 + hh * 8) = w;
      }
    }
  }
}

__device__ __forceinline__ void ev_signal(unsigned* ctr) {
  asm volatile("s_waitcnt vmcnt(0)" ::: "memory");
  __syncthreads();
  if (tidx() == 0) { __builtin_amdgcn_fence(__ATOMIC_RELEASE, "agent"); asm volatile("s_waitcnt vmcnt(0)" ::: "memory"); (void)xb_add(ctr, 1u); }
}
__device__ __forceinline__ void ev_wait(unsigned* ctr, unsigned n, unsigned* bar) {
  if (tidx() == 0) {
    XB_SPIN(xb_ld(ctr) < n, bar);
    __builtin_amdgcn_fence(__ATOMIC_ACQUIRE, "agent");
    asm volatile("s_waitcnt vmcnt(0)" ::: "memory");
  }
  __syncthreads();
}
constexpr int EV_WORD0 = 8192;
__device__ __forceinline__ void phase_c1(const Params& p, int l, unsigned char* lds) {
  constexpr int NLOC = NBATCH * 4 * NCH, NCONV = T / 32;
  for (int u = p.bx; u < NLOC + NCONV; u += p.gx) {
    if (u < NLOC) ml_local_unit2(p, l, u, lds);
    else {
      const int cu = u - NLOC;
      if (l == DEPTH - 1 && (cu % (SEGL / 32)) < (CTXL / 32)) continue;
      conv_unit(p, l, cu, lds);
    }
  }
}
__device__ __forceinline__ void phase_c3(const Params& p, int l, unsigned char* lds);
__device__ __forceinline__ void phase_c2(const Params& p, int l, unsigned char* lds) {
  unsigned* ev = (unsigned*)(p.ws + WS_CTL) + EV_WORD0 + 64 * l;
  ml_scan(p, lds);
  ev_signal(ev);
  const float* lp = p.in[I_DLAM] + l * 256;
  float s01 = 0.f, s23 = 0.f;
  for (int i = 0; i < 64; ++i) { s01 += lp[i] * lp[64 + i]; s23 += lp[128 + i] * lp[192 + i]; }
  const float lam_init = 0.8f - 0.6f * expf(-0.3f * (float)l);
  const float lam = expf(s01) - expf(s23) + lam_init;
  const bf16_t* PROJ = (const bf16_t*)(p.ws + WS_PROJ);
  bf16_t* MIX = (bf16_t*)(p.ws + WS_MIX);
  const float* ng = p.in[I_DNORMG] + l * 128;
  const int nun = 512 + (l < DEPTH - 1 ? 16 : 0);
  for (int u = p.bx; u < nun; u += p.gx) {
    int bh, qrow, nkeys;
    if (u < 512) { const int xcd = u & 7, i = (u >> 3) & 31, rnd = u >> 8; bh = 2 * xcd + rnd; qrow = CTXL + i * 256; nkeys = SEGL; }
    else { bh = u - 512; qrow = 0; nkeys = CTXL; }
    const int b = bh >> 2, h = bh & 3;
    const size_t tok0 = (size_t)b * SEGL;
    for (int rep = 0; rep < REP_ATT; ++rep)
    att_unit(PROJ + (tok0 + qrow) * PW + C_DQ + h * 128, PROJ + tok0 * PW + C_DK + h * 128, p.ws + WS_V8T + (size_t)bh * NCH * ATT_SHM_V,
             MIX + (tok0 + qrow) * DM + 512 + h * 128, nkeys, lam, ng, 1.f - lam_init, lds);
  }
  ev_wait(ev, (unsigned)p.gx, p.xbar_words);
  for (int rep = 0; rep < REP_ML; ++rep) phase_c3(p, l, lds);
}
__device__ __forceinline__ void phase_c3(const Params& p, int l, unsigned char* lds) {
  constexpr int NU = NBATCH * 4 * NCH;
  const int nlow = (p.gx > 64 && l < DEPTH - 1) ? 16 : 0, ulow = nlow * 7;
  int u, step;
  if (p.bx < nlow) { u = p.bx; step = nlow; } else { u = ulow + (p.bx - nlow); step = p.gx - nlow; }
  const int uend = p.bx < nlow ? ulow : NU;
  for (; u < uend; u += step) {
    if (l == DEPTH - 1 && (u % NCH) < 4) continue;
    ml_out_unit2(p, l, u, lds);
  }
}
__device__ __forceinline__ void phase_route(const Params& p, int l, unsigned char* lds) {
  constexpr int NU = T / 32;
  for (int u = p.bx; u < NU; u += p.gx) {
    if (l == DEPTH - 1 && (u % (SEGL / 32)) < (CTXL / 32)) continue;
    route_unit(p, l, u, lds);
    __syncthreads();
  }
}
__device__ __forceinline__ void phase_gather(const Params& p, int l, unsigned char* lds) {
  int tid_ = tidx(); asm volatile("" : "+v"(tid_)); const int lane = tid_ & 63, wid = __builtin_amdgcn_readfirstlane(tid_ >> 6);
  const int gw = p.bx * 8 + wid, NGW = p.gx * 8;
  const int ntok = (l == DEPTH - 1) ? NBATCH * SEQ : T;
#define TOKROW(ti_) ((l == DEPTH - 1) ? ((ti_) / SEQ) * SEGL + CTXL + ((ti_) % SEQ) : (ti_))
  const CAS unsigned char* eidg = (const CAS unsigned char*)(p.ws + WS_EID + (size_t)l * RT_STRIDE);
  const __amdgpu_buffer_rsrc_t rsT = __builtin_amdgcn_make_buffer_rsrc((void*)(p.ws + WS_PU + (size_t)l * NEXP * PROW), 0, VOFS + NEXP * PROW, 0x00020000);
  const int nfull = ntok / NGW, rem = ntok - nfull * NGW, per = (rem % p.gx == 0) ? rem / p.gx : -1;
  auto tok_at = [&](int r) -> int {
    if (r < nfull) return gw + r * NGW;
    if (r > nfull || rem == 0) return -1;
    if (per >= 0) return wid < per ? nfull * NGW + p.bx * per + wid : -1;
    return gw + r * NGW < ntok ? gw + r * NGW : -1;
  };
  TokPref tp; RowPipe rp;
  const int ti0 = tok_at(0);
  if (ti0 >= 0) {
    const int row0 = TOKROW(ti0); const int lane12 = lane * 12;
    tok_prefetch(p, row0, lane, tp);
    const CAS i32x8* EP0 = eid_row(eidg, row0);
    rp.Ec = EP0[0];
    LOADGROUP(rp.uq, 0, rp.Ec); LOADGROUP(rp.vq, VOFS, rp.Ec);
    rp.Ec = EP0[1];
  }
  XcdBarrier xb; xb.bar = p.xbar_words; xb.x = p.xbar_x; xb.st = (volatile LAS unsigned*)((LAS unsigned char*)lds + p.lds_st_off);
  const int nrounds = (ntok + NGW - 1) / NGW;
  for (int r = 0; r < nrounds; ++r) {
    const int ti = tok_at(r);
    if (ti >= 0) {
      const int row = TOKROW(ti);
      const int tn = tok_at(r + 1);
      const int nxt = tn >= 0 ? TOKROW(tn) : -1;
      gather_token(p, eidg, rsT, l, row, nxt, tp, rp, lds, lane, wid);
    }
#if GATHER_SYNC
    if (r + 1 < nrounds) { XcdBarrier xb2 = xb; size_t zb_ = 0; asm volatile("" : "+s"(zb_)); xb2.bar = xb.bar + zb_; xb2.x = xb.x + (unsigned)zb_; xcd_barrier(xb2); }
#endif
  }
#undef TOKROW
}

__global__ void __launch_bounds__(512, 2) mk_fwd(KArgs ka) {
  cg::grid_group grid = cg::this_grid();
  extern __shared__ __attribute__((aligned(16))) unsigned char lds[];
  const int lo = ka.ph_lo, hi = ka.ph_hi;
#define IN(k) (lo <= (k) && (k) < hi)
#ifndef PHASEMASK
#define PHASEMASK 0xFFFF
#endif
#define PH(i) ((PHASEMASK >> (i)) & 1)
#define MKP(q) Params q; { size_t z_ = 0; asm volatile("" : "+s"(z_)); \
    q.in = (InTab)((const __attribute__((address_space(4))) char*)__builtin_amdgcn_kernarg_segment_ptr() + z_); \
    q.out = ka.out + z_; q.ws = ka.ws + z_; q.ph_lo = lo; q.ph_hi = hi; q.bx = (int)blockIdx.x + (int)z_; q.gx = (int)gridDim.x + (int)z_; q.xbar_words = xbar.bar + z_; q.xbar_x = xbar.x + (unsigned)z_; q.lds_st_off = (unsigned)(LDS_BYTES - 64); }
#define SEAM(k) do { if (IN(k) && IN((k) + 1)) { if ((k) == 0) grid.sync(); else { XcdBarrier xb_ = xbar; size_t zb_ = 0; asm volatile("" : "+s"(zb_)); xb_.bar = xbar.bar + zb_; xb_.x = xbar.x + (unsigned)zb_; xcd_barrier(xb_); } } } while (0)
  volatile LAS unsigned* xst = (volatile LAS unsigned*)((LAS unsigned char*)lds + (LDS_BYTES - 64));
  { const int t0_ = threadIdx.x;
    if (t0_ < 2) xst[t0_] = 0u;
    if ((t0_ & 63) == 0) *(volatile LAS int*)((LAS unsigned char*)lds + LDS_WTAB + 4 * hw_wave_key()) = t0_ >> 6; }
  __syncthreads();
  XcdBarrier xbar = xcd_barrier_post((unsigned*)(ka.ws + WS_CTL) + 4096, xst);
  { MKP(p)
    if (PH(0) && IN(0)) for (int rep = 0; rep < REP_MISC; ++rep) { p0_mod(p, lds, (float*)(p.ws + WS_MOD)); p0_convert(p, lds); }
  }
  SEAM(0);
  { MKP(p)
    if (PH(1) && IN(1)) phase_norm(p, 0, 0, true, false);
  }
  SEAM(1);
#define LAYER(LL) { \
    int l = (LL); asm volatile("" : "+s"(l)); \
    const int b = 2 + 9 * (LL); \
    { MKP(q) if (PH(2) && IN(b + 0)) for (int rep = 0; rep < REP_GEMM; ++rep) phase_inproj2(q, l, lds); } \
    SEAM(b + 0); \
    { MKP(q) if (PH(3) && IN(b + 1)) for (int rep = 0; rep < REP_ML; ++rep) phase_c1(q, l, lds); } \
    SEAM(b + 1); \
    { MKP(q) if (PH(4) && IN(b + 2)) phase_c2(q, l, lds); } \
    SEAM(b + 3); \
    { MKP(q) if (PH(6) && IN(b + 4)) phase_outproj2(q, l, lds); } \
    SEAM(b + 4); \
    { MKP(q) if (PH(7) && IN(b + 5)) for (int rep = 0; rep < REP_MISC; ++rep) phase_norm(q, l, 1, false, (LL) == DEPTH - 1); } \
    SEAM(b + 5); \
    { MKP(q) if (PH(8) && IN(b + 6)) for (int rep = 0; rep < REP_GEMM; ++rep) phase_peerq2(q, l, lds); } \
    SEAM(b + 6); \
    { MKP(q) if (PH(9) && IN(b + 7)) phase_route(q, l, lds); } \
    SEAM(b + 7); \
    { MKP(q) if (PH(9) && IN(b + 8)) phase_gather(q, l, lds); } \
    SEAM(b + 8); }
  LAYER(0) LAYER(1) LAYER(2) LAYER(3)
#undef LAYER
#undef IN
#undef SEAM
#undef MKP
}

extern "C" void kernel_launch(void* const* d_in, const int* in_sizes, int n_in, void* d_out, int out_size,
                              void* d_ws, size_t ws_size, hipStream_t stream) {
  static int grid = 0;
  if (grid == 0) {
    int dev = 0, cus = 0, per_cu = 0;
    (void)hipGetDevice(&dev);
    (void)hipDeviceGetAttribute(&cus, hipDeviceAttributeMultiprocessorCount, dev);
    (void)hipFuncSetAttribute((const void*)mk_fwd, hipFuncAttributeMaxDynamicSharedMemorySize, LDS_BYTES);
    (void)hipOccupancyMaxActiveBlocksPerMultiprocessor(&per_cu, (const void*)mk_fwd, 512, LDS_BYTES);
    fprintf(stderr, "kernel_launch: cus %d per_cu %d ws %zu (need %zu) n_in %d\n", cus, per_cu, ws_size, (size_t)WS_END, n_in);
    if (ws_size < WS_END || n_in != 23 || per_cu < 1) { fprintf(stderr, "kernel_launch: bad configuration, nothing launched\n"); grid = -1; return; }
    grid = cus;
  }
  if (grid < 0) return;
  (void)hipMemsetAsync((char*)d_ws + WS_CTL, 0, 65536, stream);
  KArgs p{};
  for (int i = 0; i < 23; ++i) p.in[i] = (const float*)d_in[i];
  p.out = (float*)d_out; p.ws = (unsigned char*)d_ws; p.ph_lo = 0; p.ph_hi = 38;
  void* args[] = {&p};
  hipError_t e = hipLaunchCooperativeKernel((const void*)mk_fwd, dim3(grid), dim3(512), args, LDS_BYTES, stream);
  if (e != hipSuccess) fprintf(stderr, "cooperative launch failed: %s (grid %d)\n", hipGetErrorString(e), grid);
}
```

```cpp
#include <hip/hip_runtime.h>
#include <hip/hip_cooperative_groups.h>
#include <cstdio>
#include <cstdint>
namespace cg = cooperative_groups;

constexpr int DM = 1024, NBATCH = 4, SEQ = 8192, CTXL = 256, SEGL = CTXL + SEQ, T = NBATCH * SEGL, DEPTH = 4;
constexpr int IN_W = 3088, PW = 3072;
constexpr int C_A = 0, C_MQ = 512, C_MK = 768, C_MV = 1024, C_MO = 1280, C_DQ = 1536, C_DK = 2048, C_DV = 2560;
constexpr int NCH = SEGL / 64;
constexpr int NEXP = 16384;
constexpr float EPS = 1e-6f;
#ifndef ABL
#define ABL 0
#endif
#ifndef GATHER_SYNC
#define GATHER_SYNC 0
#endif
#ifndef REP_ATT
#define REP_ATT 1
#endif
#ifndef GP_MASK
#define GP_MASK 0x3FFF
#endif
#ifndef REP_PEER
#define REP_PEER 1
#endif
#ifndef REP_GEMM
#define REP_GEMM 1
#endif
#ifndef REP_ROUTE
#define REP_ROUTE 1
#endif
#ifndef REP_OUTP
#define REP_OUTP 1
#endif
#ifndef REP_ML
#define REP_ML 1
#endif
#ifndef REP_MISC
#define REP_MISC 1
#endif
constexpr float QSCALE = 0.125f * 1.4426950408889634f;

constexpr size_t MiB = 1u << 20;
constexpr size_t WS_CTL = 0, WS_MOD = 1 * MiB, WS_ROPE = 2 * MiB, WS_WG = 4 * MiB, WS_KEYS = 5 * MiB, WS_MLMETA = 6 * MiB,
                 WS_GATES = 7 * MiB, WS_WIN = 10 * MiB, WS_WOUT = 34 * MiB, WS_WQ = 42 * MiB, WS_PU = 50 * MiB, WS_PV = 114 * MiB, WS_PSC = 178 * MiB  ,
                 WS_XCUR = 306 * MiB, WS_H = 438 * MiB, WS_MIX = 504 * MiB, WS_PROJ = 570 * MiB, WS_ULOC = 768 * MiB, WS_V8T = 836 * MiB  , WS_EID = 858 * MiB  , WS_END = 924 * MiB;
constexpr int USTRIDE = 4160;

constexpr int LDS_BYTES = 139264 + 512;
constexpr int LDS_WTAB = LDS_BYTES - 64 - 256;

#define LAS __attribute__((address_space(3)))
__device__ __forceinline__ int hw_wave_key() { return (int)(__builtin_amdgcn_s_getreg((5 << 11) | 4) & 63u); }
__device__ __forceinline__ int tidx() {
  extern __shared__ __attribute__((aligned(16))) unsigned char lds_dyn_[];
  const int w = __builtin_amdgcn_readfirstlane(*(const volatile LAS int*)((LAS unsigned char*)lds_dyn_ + LDS_WTAB + 4 * hw_wave_key()));
  unsigned z_ = 0u; asm volatile("" : "+v"(z_));
  return (w << 6) | (int)__builtin_amdgcn_mbcnt_hi(~0u, __builtin_amdgcn_mbcnt_lo(~0u, z_));
}
typedef unsigned short bf16_t;
typedef short bf16x8 __attribute__((ext_vector_type(8)));
typedef short s16x4 __attribute__((ext_vector_type(4)));
typedef float f32x4 __attribute__((ext_vector_type(4)));
typedef float f32x16 __attribute__((ext_vector_type(16)));
typedef unsigned u32x4 __attribute__((ext_vector_type(4)));
typedef unsigned u32x2 __attribute__((ext_vector_type(2)));
typedef __bf16 bf16x2v __attribute__((ext_vector_type(2)));
typedef int i32x8 __attribute__((ext_vector_type(8)));
typedef int i32x6 __attribute__((ext_vector_type(6)));
struct __attribute__((aligned(4))) u32x3 { unsigned x, y, z; };
typedef float f32x32 __attribute__((ext_vector_type(32)));
constexpr int PROW = 768;
typedef float f32x2 __attribute__((ext_vector_type(2)));
typedef _Float16 h16x2 __attribute__((ext_vector_type(2)));
typedef _Float16 h16x32 __attribute__((ext_vector_type(32)));
typedef unsigned u32x3v __attribute__((ext_vector_type(3)));
typedef unsigned u32x2v __attribute__((ext_vector_type(2)));

struct KArgs {
  const float* in[23];
  float* out;
  unsigned char* ws;
  int ph_lo, ph_hi;
};
typedef const float* const __attribute__((address_space(4))) * InTab;
struct Params {
  InTab in;
  float* out;
  unsigned char* ws;
  int ph_lo, ph_hi;
  int bx, gx;
  unsigned* xbar_words; unsigned xbar_x; unsigned lds_st_off;
};
enum { I_X = 0, I_C, I_CTX, I_CCTX, I_ADAW, I_ADAB, I_N1G, I_N2G, I_WIN, I_CONVW, I_CONVB, I_CLNG, I_CLNB, I_GATEB, I_MNORMG, I_DLAM, I_DNORMG,
       I_WOUT, I_PWQ, I_PKEYS, I_PU, I_PV, I_FINALG };

__device__ __forceinline__ unsigned cvtpk(float lo, float hi) { unsigned r; asm volatile("v_cvt_pk_bf16_f32 %0, %1, %2" : "=v"(r) : "v"(lo), "v"(hi)); return r; }
__device__ __forceinline__ float bflo(unsigned u) { return __uint_as_float(u << 16); }
__device__ __forceinline__ float bfhi(unsigned u) { return __uint_as_float(u & 0xffff0000u); }
__device__ __forceinline__ float bf1(bf16_t u) { return __uint_as_float(((unsigned)u) << 16); }
__device__ __forceinline__ int crow(int r, int hi) { return (r & 3) + 8 * (r >> 2) + 4 * hi; }
template <int CTRL> __device__ __forceinline__ float dpp_mov(float v) {
  return __uint_as_float((unsigned)__builtin_amdgcn_update_dpp(0, (int)__float_as_uint(v), CTRL, 0xF, 0xF, true));
}
__device__ __forceinline__ float wave_sum_fast(float x) {
  x += dpp_mov<0xB1>(x); x += dpp_mov<0x4E>(x); x += dpp_mov<0x141>(x); x += dpp_mov<0x140>(x);
  { auto r = __builtin_amdgcn_permlane16_swap(__float_as_uint(x), __float_as_uint(x), false, false); x = __uint_as_float(r[0]) + __uint_as_float(r[1]); }
  { auto r = __builtin_amdgcn_permlane32_swap(__float_as_uint(x), __float_as_uint(x), false, false); x = __uint_as_float(r[0]) + __uint_as_float(r[1]); }
  return x;
}
__device__ __forceinline__ float wave_max_fast(float x) {
  x = fmaxf(x, dpp_mov<0xB1>(x)); x = fmaxf(x, dpp_mov<0x4E>(x)); x = fmaxf(x, dpp_mov<0x141>(x)); x = fmaxf(x, dpp_mov<0x140>(x));
  { auto r = __builtin_amdgcn_permlane16_swap(__float_as_uint(x), __float_as_uint(x), false, false); x = fmaxf(__uint_as_float(r[0]), __uint_as_float(r[1])); }
  { auto r = __builtin_amdgcn_permlane32_swap(__float_as_uint(x), __float_as_uint(x), false, false); x = fmaxf(__uint_as_float(r[0]), __uint_as_float(r[1])); }
  return x;
}
template <int CTRL, int ROWMASK> __device__ __forceinline__ float dpp_mov_rm(float v) {
  return __uint_as_float((unsigned)__builtin_amdgcn_update_dpp(0, (int)__float_as_uint(v), CTRL, ROWMASK, 0xF, true));
}
__device__ __forceinline__ float wave_incl_scan(float x) {
  x += dpp_mov<0x111>(x); x += dpp_mov<0x112>(x); x += dpp_mov<0x114>(x); x += dpp_mov<0x118>(x);
  x += dpp_mov_rm<0x142, 0xA>(x);
  x += dpp_mov_rm<0x143, 0xC>(x);
  return x;
}
__device__ __forceinline__ float wave_sum(float v) { return wave_sum_fast(v); }
__device__ __forceinline__ float sum_xor32(float x) { auto r = __builtin_amdgcn_permlane32_swap(__float_as_uint(x), __float_as_uint(x), false, false); return __uint_as_float(r[0]) + __uint_as_float(r[1]); }
__device__ __forceinline__ float max_xor32(float x) { auto r = __builtin_amdgcn_permlane32_swap(__float_as_uint(x), __float_as_uint(x), false, false); return fmaxf(__uint_as_float(r[0]), __uint_as_float(r[1])); }
__device__ __forceinline__ float wave_max(float v) { return wave_max_fast(v); }
__device__ __forceinline__ float sigmoidf_(float x) { return 1.f / (1.f + __expf(-x)); }
__device__ __forceinline__ float logsigmoidf_(float x) { return fminf(x, 0.f) - log1pf(__expf(-fabsf(x))); }
__device__ __forceinline__ const float* in_row(const float* x, const float* ctx, int row) {
  const int b = row / SEGL, s = row - b * SEGL;
  return s < CTXL ? ctx + ((size_t)(b * CTXL + s)) * DM : x + ((size_t)(b * SEQ + (s - CTXL))) * DM;
}
__device__ __forceinline__ int mod_row(int row) { const int b = row / SEGL, s = row - b * SEGL; return s < CTXL ? 4 : b; }

__device__ __forceinline__ void p0_mod(const Params& p, unsigned char* lds, float* MOD) {
  float* sil = (float*)lds;
  float* red = (float*)(lds + 20480);
  int tid_ = tidx(); asm volatile("" : "+v"(tid_)); const int tid = tid_, lane = tid & 63, wid = tid >> 6;
  for (int i = tid; i < 5 * 1024; i += 512) {
    const float v = i < 4096 ? p.in[I_C][i] : p.in[I_CCTX][i - 4096];
    sil[i] = v / (1.f + __expf(-v));
  }
  __syncthreads();
  for (int item = p.bx; item < DEPTH * 96; item += p.gx) {
    const int l = item / 96, j0 = (item % 96) * 64;
    const float* W = p.in[I_ADAW] + (size_t)l * DM * 6144 + j0 + lane;
    float a0 = 0.f, a1 = 0.f, a2 = 0.f, a3 = 0.f, a4 = 0.f;
    const int k0 = wid * 128;
#pragma unroll 8
    for (int k = k0; k < k0 + 128; ++k) {
      const float w = W[(size_t)k * 6144];
      a0 += sil[k] * w; a1 += sil[1024 + k] * w; a2 += sil[2048 + k] * w; a3 += sil[3072 + k] * w; a4 += sil[4096 + k] * w;
    }
    red[(wid * 5 + 0) * 64 + lane] = a0; red[(wid * 5 + 1) * 64 + lane] = a1; red[(wid * 5 + 2) * 64 + lane] = a2;
    red[(wid * 5 + 3) * 64 + lane] = a3; red[(wid * 5 + 4) * 64 + lane] = a4;
    __syncthreads();
    if (tid < 320) {
      const int r = tid >> 6;
      float s = 0.f;
#pragma unroll
      for (int w = 0; w < 8; ++w) s += red[(w * 5 + r) * 64 + lane];
      MOD[((size_t)l * 5 + r) * 6144 + j0 + lane] = s + p.in[I_ADAB][l * 6144 + j0 + lane];
    }
    __syncthreads();
  }
}
__device__ __forceinline__ void transpose_item(const float* W, int ldw, int srccol0, bf16_t* WT, int K, int n0, int k0, float* scr, int lane) {
#pragma unroll 8
  for (int i = 0; i < 32; ++i) { const int kk = 2 * i + (lane >> 5); scr[kk * 33 + (lane & 31)] = W[(size_t)(k0 + kk) * ldw + srccol0 + (lane & 31)]; }
  asm volatile("s_waitcnt lgkmcnt(0)" ::: "memory");
  const int c = lane & 7;
#pragma unroll
  for (int j = 0; j < 4; ++j) {
    const int n = (lane >> 3) + 8 * j; const float* s = scr + (8 * c) * 33 + n;
    u32x4 o; o.x = cvtpk(s[0], s[33]); o.y = cvtpk(s[66], s[99]); o.z = cvtpk(s[132], s[165]); o.w = cvtpk(s[198], s[231]);
    *(u32x4*)(WT + (size_t)(n0 + n) * K + k0 + 8 * c) = o;
  }
  asm volatile("s_waitcnt lgkmcnt(0)" ::: "memory");
}
__device__ __forceinline__ void convert_tables(const Params& p, int L, int wv, int nw, int lane, int r_lo, int r_hi) {
  unsigned char* PUq = p.ws + WS_PU; unsigned char* PVq = p.ws + WS_PV; float* PSC = (float*)(p.ws + WS_PSC);
  const int nrows = DEPTH * NEXP;
#define TAB_SROW(r_) ((const f32x4*)(((r_) >= NEXP ? p.in[I_PV] : p.in[I_PU]) + (size_t)(L * NEXP + ((r_) >= NEXP ? (r_) - NEXP : (r_))) * DM) + lane * 4)
#define TAB_LOAD(v_, r_) do { if ((r_) < r_hi) { const f32x4* s_ = TAB_SROW(r_); _Pragma("unroll") for (int j = 0; j < 4; ++j) v_[j] = __builtin_nontemporal_load(s_ + j); } } while (0)
  auto encode_row = [&](const f32x4 (&v)[4], int r) {
    const int tb = r >= NEXP, rr = L * NEXP + (tb ? r - NEXP : r);
    float mx = 0.f;
#pragma unroll
    for (int j = 0; j < 4; ++j) mx = fmaxf(mx, fmaxf(fmaxf(fabsf(v[j].x), fabsf(v[j].y)), fmaxf(fabsf(v[j].z), fabsf(v[j].w))));
    mx = wave_max_fast(mx);
    const unsigned mb = __float_as_uint(mx);
    const int eb = (int)((mb >> 23) & 0xFFu);
    int sb = ((mb & 0x7FFFFFu) <= 0x700000u ? 129 : 128) - eb + 127; sb = sb < 1 ? 1 : (sb > 253 ? 253 : sb);
    const float sc = __uint_as_float((unsigned)sb << 23), isc = __uint_as_float((unsigned)(254 - sb) << 23);
    const float xv[16] = {v[0].x, v[0].y, v[0].z, v[0].w, v[1].x, v[1].y, v[1].z, v[1].w, v[2].x, v[2].y, v[2].z, v[2].w, v[3].x, v[3].y, v[3].z, v[3].w};
    unsigned wq[3] = {0u, 0u, 0u};
#pragma unroll
    for (int i = 0; i < 16; ++i) {
      const float a = fabsf(xv[i]) * sc;
      unsigned code = a < 2.f ? (unsigned)__builtin_rintf(a * 8.f) : (a < 4.f ? 8u + (unsigned)__builtin_rintf(a * 4.f) : 16u + (unsigned)__builtin_rintf(a * 2.f));
      code = code > 31u ? 31u : code;
      code |= (xv[i] < 0.f) ? 32u : 0u;
      const int bp = 6 * i, dw = bp >> 5, off = bp & 31;
      wq[dw] |= code << off;
      if (off > 26) wq[dw + 1] |= code >> (32 - off);
    }
    u32x3 o; o.x = wq[0]; o.y = wq[1]; o.z = wq[2];
    *(u32x3*)((tb ? PVq : PUq) + (size_t)rr * PROW + lane * 12) = o;
    if (lane == 0) PSC[(size_t)tb * nrows + rr] = isc;
  };
  f32x4 v0[4], v1[4], v2[4];
  TAB_LOAD(v0, r_lo + wv); TAB_LOAD(v1, r_lo + wv + nw);
#pragma unroll 1
  for (int r = r_lo + wv; r < r_hi; r += 3 * nw) {
    TAB_LOAD(v2, r + 2 * nw); encode_row(v0, r);
    if (r + nw < r_hi) { TAB_LOAD(v0, r + 3 * nw); encode_row(v1, r + nw); }
    if (r + 2 * nw < r_hi) { TAB_LOAD(v1, r + 4 * nw); encode_row(v2, r + 2 * nw); }
  }
#undef TAB_LOAD
#undef TAB_SROW
}
__device__ __forceinline__ void tail_filler_tables(const Params& p, int L, int nwg, int r_lo, int r_hi) {
  int tid_ = tidx(); asm volatile("" : "+v"(tid_)); const int lane = tid_ & 63, wid = tid_ >> 6;
  const int nextra = nwg % p.gx, first = nextra, nidle = p.gx - nextra;
  if (p.bx < first) return;
  convert_tables(p, L, (p.bx - first) * 8 + wid, nidle * 8, lane, r_lo, r_hi);
}
__device__ __forceinline__ void p0_convert(const Params& p, unsigned char* lds) {
  int tid_ = tidx(); asm volatile("" : "+v"(tid_)); const int tid = tid_, lane = tid & 63, wid = tid >> 6;
  const int gw = p.bx * 8 + wid, NGW = p.gx * 8;
  const size_t gt = (size_t)p.bx * 512 + tid, NGT = (size_t)p.gx * 512;
  float* scr = (float*)(lds + 32768) + wid * (64 * 33);
  bf16_t* WIN = (bf16_t*)(p.ws + WS_WIN); bf16_t* WOUT = (bf16_t*)(p.ws + WS_WOUT); bf16_t* WQ = (bf16_t*)(p.ws + WS_WQ);
  constexpr int I_IN = 16 * 96, I_O = 16 * 32, PER_L = I_IN + 2 * I_O;
  for (int it = gw; it < DEPTH * PER_L; it += NGW) {
    const int l = it / PER_L; int r = it % PER_L;
    if (r < I_IN) { const int kb = r / 96, nb = r % 96, n0 = nb * 32; const int src = n0 < 1536 ? n0 : n0 + 16;
      transpose_item(p.in[I_WIN] + (size_t)l * DM * IN_W, IN_W, src, WIN + (size_t)l * PW * DM, DM, n0, kb * 64, scr, lane); continue; }
    r -= I_IN;
    if (r < I_O) { const int kb = r / 32, nb = r % 32;
      transpose_item(p.in[I_WOUT] + (size_t)l * DM * DM, DM, nb * 32, WOUT + (size_t)l * DM * DM, DM, nb * 32, kb * 64, scr, lane); continue; }
    r -= I_O;
    { const int kb = r / 32, nb = r % 32;
      transpose_item(p.in[I_PWQ] + (size_t)l * DM * DM, DM, nb * 32, WQ + (size_t)l * DM * DM, DM, nb * 32, kb * 64, scr, lane); }
  }
  bf16_t* WG = (bf16_t*)(p.ws + WS_WG);
  for (size_t i = gt; i < (size_t)DEPTH * 16 * DM; i += NGT) {
    const int l = (int)(i / (16 * DM)), g = (int)((i / DM) % 16), k = (int)(i % DM);
    WG[i] = (bf16_t)(cvtpk(p.in[I_WIN][(size_t)l * DM * IN_W + (size_t)k * IN_W + 1536 + g], 0.f) & 0xffffu);
  }
  bf16_t* KEYS = (bf16_t*)(p.ws + WS_KEYS);
  for (size_t i = gt; i < (size_t)DEPTH * 131072 / 8; i += NGT) {
    const f32x4 a = ((const f32x4*)p.in[I_PKEYS])[2 * i], b = ((const f32x4*)p.in[I_PKEYS])[2 * i + 1];
    u32x4 o; o.x = cvtpk(a.x, a.y); o.y = cvtpk(a.z, a.w); o.z = cvtpk(b.x, b.y); o.w = cvtpk(b.z, b.w);
    ((u32x4*)KEYS)[i] = o;
  }
  {
    float* RC = (float*)(p.ws + WS_ROPE); float* RS = RC + SEQ * 32;
    for (size_t i = gt; i < (size_t)SEQ * 32; i += NGT) {
      const int pos = (int)(i >> 5), j = (int)(i & 31);
      const int rr = pos >> 6, cc = pos & 63;
      const int jj = j & 15;
      const double e = -(double)jj * 0.83048202372184058696;
      const double fl = __builtin_floor(e); const double f = e - fl;
      const double z = f * 0.69314718055994530942;
      double ez = 1.0 + z * (1.0 + z * (0.5 + z * (1.0 / 6 + z * (1.0 / 24 + z * (1.0 / 120 + z * (1.0 / 720 + z * (1.0 / 5040 + z * (1.0 / 40320 + z * (1.0 / 362880 + z * (1.0 / 3628800 + z * (1.0 / 39916800 + z * (1.0 / 479001600))))))))))));
      const double inv = __builtin_ldexp(ez, (int)fl);
      const float invf = (float)inv;
      const float angf = (float)(j < 16 ? rr : cc) * invf;
      const double ang = (double)angf;
      const double kq = __builtin_rint(ang * 0.63661977236758134308);
      double r = __builtin_fma(-kq, 1.57079632679489655800e+00, ang);
      r = __builtin_fma(-kq, 6.12323399573676603587e-17, r);
      const double r2 = r * r;
      const double sn = r * (1.0 + r2 * (-1.0 / 6 + r2 * (1.0 / 120 + r2 * (-1.0 / 5040 + r2 * (1.0 / 362880 + r2 * (-1.0 / 39916800 + r2 * (1.0 / 6227020800.0)))))));
      const double cs = 1.0 + r2 * (-0.5 + r2 * (1.0 / 24 + r2 * (-1.0 / 720 + r2 * (1.0 / 40320 + r2 * (-1.0 / 3628800 + r2 * (1.0 / 479001600 + r2 * (-1.0 / 87178291200.0)))))));
      const int q = ((int)kq) & 3;
      double co, si;
      if (q == 0) { co = cs; si = sn; } else if (q == 1) { co = -sn; si = cs; } else if (q == 2) { co = -cs; si = -sn; } else { co = sn; si = -cs; }
      RC[i] = (float)co; RS[i] = (float)si;
    }
  }
}

__device__ __forceinline__ void norm_mod_row(const float* xrow, const float* g, const float* sc, const float* sh, bf16_t* orow, int lane) {
  const f32x4* xr = (const f32x4*)xrow + lane;
  f32x4 v[4]; float s = 0.f;
#pragma unroll
  for (int j = 0; j < 4; ++j) { v[j] = xr[64 * j]; s += (v[j].x * v[j].x + v[j].y * v[j].y) + (v[j].z * v[j].z + v[j].w * v[j].w); }
  const float rs = rsqrtf(wave_sum(s) * (1.f / DM) + EPS);
  u32x2* o = (u32x2*)orow + lane;
#pragma unroll
  for (int j = 0; j < 4; ++j) {
    const f32x4 gg = ((const f32x4*)g)[lane + 64 * j], cc = ((const f32x4*)sc)[lane + 64 * j], hh = ((const f32x4*)sh)[lane + 64 * j];
    const float y0 = v[j].x * rs * gg.x * (1.f + cc.x) + hh.x, y1 = v[j].y * rs * gg.y * (1.f + cc.y) + hh.y;
    const float y2 = v[j].z * rs * gg.z * (1.f + cc.z) + hh.z, y3 = v[j].w * rs * gg.w * (1.f + cc.w) + hh.w;
    u32x2 w; w.x = cvtpk(y0, y1); w.y = cvtpk(y2, y3);
    o[64 * j] = w;
  }
}
__device__ __forceinline__ void phase_norm(const Params& p, int l, int which, bool from_input, bool skip_ctx) {
  int tid_ = tidx(); asm volatile("" : "+v"(tid_));
  const int lane = tid_ & 63, wid = tid_ >> 6;
  const int gw = p.bx * 8 + wid, NGW = p.gx * 8;
  const float* MOD = (const float*)(p.ws + WS_MOD);
  const float* XC = (const float*)(p.ws + WS_XCUR);
  bf16_t* H = (bf16_t*)(p.ws + WS_H);
  const float* g = p.in[which ? I_N2G : I_N1G] + l * DM;
  for (int row = gw; row < T; row += NGW) {
    const int mr = mod_row(row);
    if (skip_ctx && mr == 4) continue;
    const float* m = MOD + ((size_t)l * 5 + mr) * 6144 + which * 3072;
    const float* xr = from_input ? in_row(p.in[I_X], p.in[I_CTX], row) : XC + (size_t)row * DM;
    norm_mod_row(xr, g, m + 1024, m, H + (size_t)row * DM, lane);
  }
}

namespace pg8 {
#define PG8_LAS __attribute__((address_space(3)))
typedef unsigned short bf16_t;
typedef short bf16x8 __attribute__((ext_vector_type(8)));
typedef float f32x4 __attribute__((ext_vector_type(4)));
typedef unsigned u32x4 __attribute__((ext_vector_type(4)));
constexpr int BM = 256, BK = 64, HALF = 128, HTB = HALF * BK * 2  , STAGE_BYTES = 8 * HTB, NXCD = 8, WGM = 8;

__host__ __device__ __forceinline__ int lds_byte(int r, int c) { const int st = (r >> 4) * 2 + (c >> 5), rr = r & 15, cc = c & 31, ob = rr * 64 + cc * 2; return st * 1024 + (ob ^ (((ob >> 9) & 1) << 5)); }
__host__ __device__ __forceinline__ void stage_rc(int b, int& R, int& C) { const int st = b / 1024, sb = b % 1024, swz = sb ^ (((sb >> 9) & 1) << 5); R = (st >> 1) * 16 + swz / 64; C = (st & 1) * 32 + (swz % 64) / 2; }
__host__ __device__ __forceinline__ int perm32(int rho) { const int n = rho >> 4, i = rho & 15; return 8 * (i >> 2) + 4 * n + (i & 3); }

struct Unit { int pm, pn; };
struct Gemm { const bf16_t* A; const bf16_t* Bt; int M, N, K; };

struct StaticOrder {
    int nM, nN, nwg, G, c;
    __host__ __device__ void init(int M, int N, int G_, int c_) { nM = M / BM; nN = N / BM; nwg = nM * nN; G = G_; c = c_; }
    __host__ __device__ bool next(int i, Unit& u) const {
        const long L = (long)i * G + c; if (L >= nwg) return false;
        int wgid = (int)L; { const int q = nwg / NXCD, r = nwg % NXCD, xcd = wgid % NXCD, off = wgid / NXCD; wgid = (xcd < r ? xcd * (q + 1) : r * (q + 1) + (xcd - r) * q) + off; }
        const int nig = WGM * nN, gid = wgid / nig, fm = gid * WGM, gsz = (nM - fm) < WGM ? (nM - fm) : WGM;
        u.pm = fm + ((wgid % nig) % gsz); u.pn = (wgid % nig) / gsz; return true;
    }
    __device__ __forceinline__ void a_ready(const Unit&) const {}
    __device__ __forceinline__ void done(const Unit&) const {}
};
__device__ __forceinline__ unsigned cvt_pk_bf16(float lo, float hi) { unsigned r; asm volatile("v_cvt_pk_bf16_f32 %0, %1, %2" : "=v"(r) : "v"(lo), "v"(hi)); return r; }
template <class Epi, class Sched, bool ALIGN_EPI = false, bool SP2 = false>
__device__ __forceinline__ void gemm_phase(PG8_LAS unsigned char* lds, const Gemm g, const Sched& S, const Epi& E) {
    const int tid = tidx(), wid = __builtin_amdgcn_readfirstlane(tid >> 6), lane = tid & 63, wr = wid >> 2, wc = wid & 3, fr = lane & 15, fq = lane >> 4;
    const int K = g.K, nt = K / BK;
    unsigned voffA[2], voffB[2];
#pragma unroll
    for (int i = 0; i < 2; ++i) { int R, C; stage_rc(tid * 16 + i * 8192, R, C); const int Rb = Epi::PERM ? ((R & ~31) + perm32(R & 31)) : R;
        voffA[i] = (unsigned)(R * K + C) * 2u; voffB[i] = (unsigned)(Rb * K + C) * 2u; }
    const size_t kstep = (size_t)(BK * 2);
    const size_t hstep = (size_t)HALF * K * 2;
    const size_t tstep = 2 * hstep;
    const unsigned ldsw = (unsigned)wid * 1024u;
    const int aoff = lds_byte(wr * 64 + fr, fq * 8), boff = lds_byte(wc * 32 + fr, fq * 8);
#define PG8_SA(b, h) (((b) * 2 + (h)) * HTB)
#define PG8_SB(b, h) ((4 + (b) * 2 + (h)) * HTB)
#define PG8_STAGE(bufoff, gbase, voff) do { _Pragma("unroll") for (int _i = 0; _i < 2; ++_i) \
        __builtin_amdgcn_global_load_lds((const unsigned*)((const char*)(gbase) + (voff)[_i]), (PG8_LAS unsigned*)(lds + (bufoff) + ldsw + _i * 8192), 16, 0, 0); } while (0)
#define PG8_LDA(dst, b, h) do { _Pragma("unroll") for (int m = 0; m < 4; ++m) _Pragma("unroll") for (int k = 0; k < 2; ++k) dst[m][k] = *(const PG8_LAS bf16x8*)(lds + PG8_SA(b, h) + aoff + m * 2048 + k * 1024); } while (0)
#define PG8_LDB(dst, b, h) do { _Pragma("unroll") for (int n = 0; n < 2; ++n) _Pragma("unroll") for (int k = 0; k < 2; ++k) dst[n][k] = *(const PG8_LAS bf16x8*)(lds + PG8_SB(b, h) + boff + n * 2048 + k * 1024); } while (0)
#define PG8_MMA(ai, bj, At, Bt) do { __builtin_amdgcn_s_setprio(1); _Pragma("unroll") for (int m = 0; m < 4; ++m) _Pragma("unroll") for (int n = 0; n < 2; ++n) _Pragma("unroll") for (int k = 0; k < 2; ++k) \
        acc[ai][bj][m][n] = __builtin_amdgcn_mfma_f32_16x16x32_bf16(Bt[n][k], At[m][k], acc[ai][bj][m][n], 0, 0, 0); __builtin_amdgcn_s_setprio(0); } while (0)
#define PG8_WAIT_V(n) asm volatile("s_waitcnt vmcnt(" #n ")" ::: "memory")
#define PG8_WAIT_L(n) asm volatile("s_waitcnt lgkmcnt(" #n ")" ::: "memory")
#define PG8_BAR __builtin_amdgcn_s_barrier()
#define PG8_SCHED __builtin_amdgcn_sched_barrier(0)
    Unit cur, nxt; int ui = 0;
    if (!S.next(0, cur)) return;
    f32x4 acc[2][2][4][2];
#pragma unroll
    for (int a = 0; a < 2; ++a)
#pragma unroll
        for (int b = 0; b < 2; ++b)
#pragma unroll
            for (int m = 0; m < 4; ++m)
#pragma unroll
                for (int n = 0; n < 2; ++n) acc[a][b][m][n] = (f32x4){0.f, 0.f, 0.f, 0.f};
    bf16x8 At[4][2], B0[2][2], B1[2][2];
    const char* cA = (const char*)g.A + (size_t)cur.pm * tstep; const char* cB = (const char*)g.Bt + (size_t)cur.pn * tstep;
    S.a_ready(cur);
    if constexpr (SP2) {
        PG8_STAGE(PG8_SB(0, 0), cB, voffB); PG8_STAGE(PG8_SB(0, 1), cB + hstep, voffB); PG8_STAGE(PG8_SA(0, 0), cA, voffA); PG8_STAGE(PG8_SA(0, 1), cA + hstep, voffA);
        if (wr == 1) PG8_BAR;
        PG8_WAIT_V(2); PG8_BAR;
        PG8_STAGE(PG8_SB(1, 0), cB + kstep, voffB); PG8_STAGE(PG8_SA(1, 0), cA + kstep, voffA); PG8_STAGE(PG8_SB(1, 1), cB + hstep + kstep, voffB);
        PG8_WAIT_V(6); PG8_BAR;
    } else {
        PG8_STAGE(PG8_SB(0, 0), cB, voffB); PG8_STAGE(PG8_SA(0, 0), cA, voffA); PG8_STAGE(PG8_SB(0, 1), cB + hstep, voffB); PG8_STAGE(PG8_SA(0, 1), cA + hstep, voffA);
        if (wr == 1) PG8_BAR;
        PG8_WAIT_V(4); PG8_BAR;
        PG8_STAGE(PG8_SB(1, 0), cB + kstep, voffB); PG8_STAGE(PG8_SA(1, 0), cA + kstep, voffA); PG8_STAGE(PG8_SB(1, 1), cB + hstep + kstep, voffB);
        PG8_WAIT_V(6); PG8_BAR;
    }
    for (;;) {
        const bool has_next = S.next(ui + 1, nxt);
        const char* nA = has_next ? (const char*)g.A + (size_t)nxt.pm * tstep : cA; const char* nB = has_next ? (const char*)g.Bt + (size_t)nxt.pn * tstep : cB;
        for (int t = 0; t < nt; t += 2) {
            const bool last = (t == nt - 2);
            const char* a1 = cA + (size_t)(t + 1) * kstep;
            const char* a2 = last ? nA : cA + (size_t)(t + 2) * kstep; const char* b2 = last ? nB : cB + (size_t)(t + 2) * kstep;
            const char* a3 = a2 + kstep; const char* b3 = b2 + kstep;
            if (last && has_next) S.a_ready(nxt);
            if constexpr (SP2) {
            PG8_LDB(B0, 0, 0); PG8_LDB(B1, 0, 1); PG8_SCHED; PG8_LDA(At, 0, 0); PG8_STAGE(PG8_SA(1, 1), a1 + hstep, voffA);
            PG8_WAIT_V(8); PG8_WAIT_L(0); PG8_BAR; PG8_MMA(0, 0, At, B0); PG8_MMA(0, 1, At, B1); PG8_BAR; PG8_SCHED;
            PG8_LDA(At, 0, 1); PG8_STAGE(PG8_SB(0, 0), b2, voffB); PG8_STAGE(PG8_SB(0, 1), b2 + hstep, voffB); PG8_STAGE(PG8_SA(0, 0), a2, voffA);
            PG8_WAIT_V(8); PG8_WAIT_L(0); PG8_BAR; PG8_MMA(1, 0, At, B0); PG8_MMA(1, 1, At, B1); PG8_BAR; PG8_SCHED;
            PG8_LDB(B0, 1, 0); PG8_LDB(B1, 1, 1); PG8_SCHED; PG8_LDA(At, 1, 0); PG8_STAGE(PG8_SA(0, 1), a2 + hstep, voffA);
            PG8_WAIT_V(8); PG8_WAIT_L(0); PG8_BAR; PG8_MMA(0, 0, At, B0); PG8_MMA(0, 1, At, B1); PG8_BAR; PG8_SCHED;
            PG8_LDA(At, 1, 1); PG8_STAGE(PG8_SB(1, 0), b3, voffB); PG8_STAGE(PG8_SB(1, 1), b3 + hstep, voffB); PG8_STAGE(PG8_SA(1, 0), a3, voffA);
            PG8_WAIT_V(8); PG8_WAIT_L(0); PG8_BAR; PG8_MMA(1, 0, At, B0); PG8_MMA(1, 1, At, B1); PG8_BAR; PG8_SCHED;
            } else {
            PG8_LDB(B0, 0, 0); PG8_SCHED; PG8_LDA(At, 0, 0); PG8_STAGE(PG8_SA(1, 1), a1 + hstep, voffA);
            PG8_WAIT_L(8); PG8_BAR; PG8_WAIT_L(0); PG8_MMA(0, 0, At, B0); PG8_BAR; PG8_SCHED;
            PG8_LDB(B1, 0, 1); PG8_STAGE(PG8_SB(0, 0), b2, voffB);
            PG8_BAR; PG8_WAIT_L(0); PG8_MMA(0, 1, At, B1); PG8_BAR;
            PG8_LDA(At, 0, 1); PG8_STAGE(PG8_SA(0, 0), a2, voffA);
            PG8_BAR; PG8_WAIT_L(0); PG8_MMA(1, 0, At, B0); PG8_BAR; PG8_SCHED;
            PG8_STAGE(PG8_SB(0, 1), b2 + hstep, voffB);
            PG8_WAIT_V(6); PG8_BAR; PG8_MMA(1, 1, At, B1); PG8_BAR;
            PG8_LDB(B0, 1, 0); PG8_SCHED; PG8_LDA(At, 1, 0); PG8_STAGE(PG8_SA(0, 1), a2 + hstep, voffA);
            PG8_WAIT_L(8); PG8_BAR; PG8_WAIT_L(0); PG8_MMA(0, 0, At, B0); PG8_BAR; PG8_SCHED;
            PG8_LDB(B1, 1, 1); PG8_STAGE(PG8_SB(1, 0), b3, voffB);
            PG8_BAR; PG8_WAIT_L(0); PG8_MMA(0, 1, At, B1); PG8_BAR;
            PG8_LDA(At, 1, 1); PG8_STAGE(PG8_SA(1, 0), a3, voffA);
            PG8_BAR; PG8_WAIT_L(0); PG8_MMA(1, 0, At, B0); PG8_BAR; PG8_SCHED;
            PG8_STAGE(PG8_SB(1, 1), b3 + hstep, voffB);
            PG8_WAIT_V(6); PG8_BAR; PG8_MMA(1, 1, At, B1); PG8_BAR;
            }
        }
        if constexpr (ALIGN_EPI) { if (wr == 0) PG8_BAR; }
        if constexpr (!Epi::AFTER_DRAIN) { E(acc, cur, wr, wc, fr, fq); S.done(cur); }
        if (!has_next) break;
#pragma unroll
        for (int a = 0; a < 2; ++a)
#pragma unroll
            for (int b = 0; b < 2; ++b)
#pragma unroll
                for (int m = 0; m < 4; ++m)
#pragma unroll
                    for (int n = 0; n < 2; ++n) acc[a][b][m][n] = (f32x4){0.f, 0.f, 0.f, 0.f};
        cur = nxt; cA = nA; cB = nB; ++ui;
        if constexpr (ALIGN_EPI) { if (wr == 1) PG8_BAR; }
    }
    PG8_WAIT_V(0);
    if constexpr (!ALIGN_EPI) { if (wr == 0) PG8_BAR; }
    PG8_BAR;
    if constexpr (Epi::AFTER_DRAIN) { E.fused(acc, cur, wr, wc, fr, fq, lds, wid, lane); S.done(cur); }
#undef PG8_SA
#undef PG8_SB
#undef PG8_STAGE
#undef PG8_LDA
#undef PG8_LDB
#undef PG8_MMA
#undef PG8_WAIT_V
#undef PG8_WAIT_L
#undef PG8_BAR
#undef PG8_SCHED
}
}

__device__ __forceinline__ int gswz(int row, int chunk) { return row * 128 + ((chunk ^ ((row >> 1) & 7)) << 4); }
__device__ __forceinline__ void gemm_tile(const bf16_t* __restrict__ A, int lda, const bf16_t* __restrict__ Bt, int ldb, int K,
                                          int row0, int col0, unsigned char* lds, f32x16 (&acc)[2][2]) {
  int tid_ = tidx(); asm volatile("" : "+v"(tid_)); const int tid = tid_, lane = tid & 63, wid = tid >> 6, wm = wid >> 1, wn = wid & 1, r32 = lane & 31, hi = lane >> 5;
  unsigned char* As = lds; unsigned char* Bs = lds + 65536;
#pragma unroll
  for (int i = 0; i < 2; ++i)
#pragma unroll
    for (int j = 0; j < 2; ++j) acc[i][j] = f32x16{};
  const int lrow = tid >> 3, lc = tid & 7;
  const bf16_t* Ag = A + (size_t)(row0 + lrow) * lda + lc * 8;
  const bf16_t* Bg = Bt + (size_t)(col0 + lrow) * ldb + lc * 8;
  u32x4 ra[4], rb[2];
#pragma unroll
  for (int i = 0; i < 4; ++i) ra[i] = *(const u32x4*)(Ag + (size_t)(64 * i) * lda);
#pragma unroll
  for (int i = 0; i < 2; ++i) rb[i] = *(const u32x4*)(Bg + (size_t)(64 * i) * ldb);
#pragma unroll
  for (int i = 0; i < 4; ++i) *(u32x4*)(As + gswz(lrow + 64 * i, lc)) = ra[i];
#pragma unroll
  for (int i = 0; i < 2; ++i) *(u32x4*)(Bs + gswz(lrow + 64 * i, lc)) = rb[i];
  __syncthreads();
  const int nk = K / 64;
  for (int kt = 0; kt < nk; ++kt) {
    const int cur = kt & 1;
    if (kt + 1 < nk) {
#pragma unroll
      for (int i = 0; i < 4; ++i) ra[i] = *(const u32x4*)(Ag + (size_t)(64 * i) * lda + (kt + 1) * 64);
#pragma unroll
      for (int i = 0; i < 2; ++i) rb[i] = *(const u32x4*)(Bg + (size_t)(64 * i) * ldb + (kt + 1) * 64);
    }
    const unsigned char* Ac = As + cur * 32768; const unsigned char* Bc = Bs + cur * 16384;
#pragma unroll
    for (int kk = 0; kk < 4; ++kk) {
      bf16x8 af[2], bfr[2];
#pragma unroll
      for (int i = 0; i < 2; ++i) af[i] = *(const bf16x8*)(Ac + gswz(wm * 64 + i * 32 + r32, 2 * kk + hi));
#pragma unroll
      for (int j = 0; j < 2; ++j) bfr[j] = *(const bf16x8*)(Bc + gswz(wn * 64 + j * 32 + r32, 2 * kk + hi));
#pragma unroll
      for (int i = 0; i < 2; ++i)
#pragma unroll
        for (int j = 0; j < 2; ++j) acc[i][j] = __builtin_amdgcn_mfma_f32_32x32x16_bf16(af[i], bfr[j], acc[i][j], 0, 0, 0);
    }
    if (kt + 1 < nk) {
      unsigned char* An = As + (cur ^ 1) * 32768; unsigned char* Bn = Bs + (cur ^ 1) * 16384;
#pragma unroll
      for (int i = 0; i < 4; ++i) *(u32x4*)(An + gswz(lrow + 64 * i, lc)) = ra[i];
#pragma unroll
      for (int i = 0; i < 2; ++i) *(u32x4*)(Bn + gswz(lrow + 64 * i, lc)) = rb[i];
    }
    __syncthreads();
  }
}
__device__ __forceinline__ void pair_xchg(float v0, float v1, int lane, float& lo, float& hi2) {
  const bool odd = lane & 1;
  const float send = odd ? v0 : v1;
  const float recv = dpp_mov<0xB1>(send);
  lo = odd ? recv : v0; hi2 = odd ? v1 : recv;
}

__device__ __forceinline__ void phase_inproj(const Params& p, int l, unsigned char* lds) {
  int tid_ = tidx(); asm volatile("" : "+v"(tid_)); const int tid = tid_, lane = tid & 63, wid = tid >> 6, wm = wid >> 1, wn = wid & 1, r32 = lane & 31, hi = lane >> 5;
  const bf16_t* H = (const bf16_t*)(p.ws + WS_H);
  const bf16_t* W = (const bf16_t*)(p.ws + WS_WIN) + (size_t)l * PW * DM;
  bf16_t* PROJ = (bf16_t*)(p.ws + WS_PROJ);
  const float* RC = (const float*)(p.ws + WS_ROPE); const float* RS = RC + SEQ * 32;
  constexpr int NM = T / 256, NN = PW / 128, NU = NM * NN;
  for (int u = p.bx; u < NU + NM; u += p.gx) {
    if (u < NU) {
      const int pn = u / NM, pm = u % NM;
      const int row0 = pm * 256, col0 = pn * 128;
      f32x16 acc[2][2];
      gemm_tile(H, DM, W, DM, DM, row0, col0, lds, acc);
      const bool rope = (col0 >= C_DQ && col0 < C_DV);
      const float scl = (col0 >= C_MK && col0 < C_MV) ? 0.125f : ((col0 >= C_DQ && col0 < C_DK) ? QSCALE : 1.f);
#pragma unroll
      for (int i = 0; i < 2; ++i)
#pragma unroll
        for (int j = 0; j < 2; ++j)
#pragma unroll
          for (int q = 0; q < 8; ++q) {
            float lo, hi2; pair_xchg(acc[i][j][2 * q], acc[i][j][2 * q + 1], lane, lo, hi2);
            const int row = row0 + wm * 64 + i * 32 + crow(2 * q, hi) + (lane & 1);
            const int col = col0 + wn * 64 + j * 32 + (r32 & ~1);
            if (rope) {
              const int s = row % SEGL;
              if (s >= CTXL) {
                const int idx = (s - CTXL) * 32 + ((col & 63) >> 1);
                const float c = RC[idx], sn = RS[idx];
                const float t1 = lo, t2 = hi2; lo = t1 * c - t2 * sn; hi2 = t1 * sn + t2 * c;
              }
            }
            *(unsigned*)(PROJ + (size_t)row * PW + col) = cvtpk(lo * scl, hi2 * scl);
          }
    } else {
      const int pm = u - NU, rowb = pm * 256 + wid * 32;
      const bf16_t* WG = (const bf16_t*)(p.ws + WS_WG) + (size_t)l * 16 * DM;
      float* GT = (float*)(p.ws + WS_GATES);
      const int r16 = lane & 15, q4 = lane >> 4;
      f32x4 c0 = {0.f, 0.f, 0.f, 0.f}, c1 = {0.f, 0.f, 0.f, 0.f};
      const bf16_t* a0p = H + (size_t)(rowb + r16) * DM + q4 * 8;
      const bf16_t* a1p = a0p + (size_t)16 * DM;
      const bf16_t* bp = WG + (size_t)r16 * DM + q4 * 8;
#pragma unroll 4
      for (int ks = 0; ks < 32; ++ks) {
        const bf16x8 a0 = *(const bf16x8*)(a0p + ks * 32), a1 = *(const bf16x8*)(a1p + ks * 32), b = *(const bf16x8*)(bp + ks * 32);
        c0 = __builtin_amdgcn_mfma_f32_16x16x32_bf16(a0, b, c0, 0, 0, 0);
        c1 = __builtin_amdgcn_mfma_f32_16x16x32_bf16(a1, b, c1, 0, 0, 0);
      }
      const float gb = p.in[I_GATEB][l * 16 + r16];
#pragma unroll
      for (int j = 0; j < 4; ++j) {
        GT[(size_t)(rowb + q4 * 4 + j) * 16 + r16] = c0[j] + gb;
        GT[(size_t)(rowb + 16 + q4 * 4 + j) * 16 + r16] = c1[j] + gb;
      }
    }
  }
}

__device__ __forceinline__ void phase_outproj(const Params& p, int l, unsigned char* lds) {
  int tid_ = tidx(); asm volatile("" : "+v"(tid_)); const int tid = tid_, lane = tid & 63, wid = tid >> 6, wm = wid >> 1, wn = wid & 1, r32 = lane & 31, hi = lane >> 5;
  const bf16_t* MIX = (const bf16_t*)(p.ws + WS_MIX);
  const bf16_t* W = (const bf16_t*)(p.ws + WS_WOUT) + (size_t)l * DM * DM;
  float* XC = (float*)(p.ws + WS_XCUR);
  const float* MOD = (const float*)(p.ws + WS_MOD);
  constexpr int NM = T / 256, NN = DM / 128, NU = NM * NN;
  for (int u = p.bx; u < NU; u += p.gx) {
    const int pm = u / NN, pn = u % NN;
    if (l == DEPTH - 1 && (pm % 33) == 0) continue;
    const int row0 = pm * 256, col0 = pn * 128;
    for (int rep = 0; rep < REP_OUTP; ++rep) {
    f32x16 acc[2][2];
    gemm_tile(MIX, DM, W, DM, DM, row0, col0, lds, acc);
    const int mr = (pm % 33) == 0 ? 4 : pm / 33;
    const float* g1 = MOD + ((size_t)l * 5 + mr) * 6144 + 2048;
#pragma unroll
    for (int i = 0; i < 2; ++i)
#pragma unroll
      for (int j = 0; j < 2; ++j) {
        const int col = col0 + wn * 64 + j * 32 + r32;
        const float gg = (rep == REP_OUTP - 1) ? g1[col] : 0.f;
#pragma unroll
        for (int r = 0; r < 16; ++r) {
          const int row = row0 + wm * 64 + i * 32 + crow(r, hi);
          const float xo = (l == 0) ? in_row(p.in[I_X], p.in[I_CTX], row)[col] : XC[(size_t)row * DM + col];
          XC[(size_t)row * DM + col] = xo + gg * acc[i][j][r];
        }
      }
    }
  }
}
__device__ __forceinline__ void phase_peerq(const Params& p, int l, unsigned char* lds) {
  int tid_ = tidx(); asm volatile("" : "+v"(tid_)); const int tid = tid_, lane = tid & 63, wid = tid >> 6, wm = wid >> 1, wn = wid & 1, r32 = lane & 31, hi = lane >> 5;
  const bf16_t* H = (const bf16_t*)(p.ws + WS_H);
  const bf16_t* W = (const bf16_t*)(p.ws + WS_WQ) + (size_t)l * DM * DM;
  bf16_t* QP = (bf16_t*)(p.ws + WS_PROJ);
  constexpr int NM = T / 256, NN = DM / 128, NU = NM * NN;
  for (int u = p.bx; u < NU; u += p.gx) {
    const int pm = u / NN, pn = u % NN;
    if (l == DEPTH - 1 && (pm % 33) == 0) continue;
    const int row0 = pm * 256, col0 = pn * 128;
    f32x16 acc[2][2];
    gemm_tile(H, DM, W, DM, DM, row0, col0, lds, acc);
#pragma unroll
    for (int i = 0; i < 2; ++i)
#pragma unroll
      for (int j = 0; j < 2; ++j)
#pragma unroll
        for (int q = 0; q < 8; ++q) {
          float lo, hi2; pair_xchg(acc[i][j][2 * q], acc[i][j][2 * q + 1], lane, lo, hi2);
          const int row = row0 + wm * 64 + i * 32 + crow(2 * q, hi) + (lane & 1);
          const int col = col0 + wn * 64 + j * 32 + (r32 & ~1);
          *(unsigned*)(QP + (size_t)row * DM + col) = cvtpk(lo, hi2);
        }
  }
}


struct EpiInproj {
  static constexpr bool PERM = true, AFTER_DRAIN = false;
  bf16_t* PROJ; const float* RC; const float* RS; unsigned char* V8T;
  __device__ __forceinline__ void operator()(const pg8::f32x4 (&acc)[2][2][4][2], const pg8::Unit& u, int wr, int wc, int fr, int fq) const {
#pragma unroll
    for (int bj = 0; bj < 2; ++bj) {
      const int colt = u.pn * 256 + bj * 128;
      const bool rope = (colt >= C_DQ && colt < C_DV);
      const float scl = (colt >= C_MK && colt < C_MV) ? 0.125f : ((colt >= C_DQ && colt < C_DK) ? QSCALE : 1.f);
      const int col8 = colt + wc * 32 + 8 * fq;
      if (colt >= C_DV) {
        const int hh = (col8 - C_DV) >> 7, e0 = (col8 - C_DV) & 127;
#pragma unroll
        for (int ai = 0; ai < 2; ++ai)
#pragma unroll
          for (int m = 0; m < 4; ++m) {
            const int row = u.pm * 256 + ai * 128 + wr * 64 + m * 16 + fr;
            const int b = row / SEGL, s = row - b * SEGL, t = s >> 6, kk = s & 63;
            const int slot = ((kk >> 2) & 1) * 32 + (kk & 3) + 4 * ((kk >> 3) & 3) + 16 * (kk >> 5);
            unsigned char* vp = V8T + ((size_t)((b * 4 + hh) * NCH + t) * 128 + e0) * 80 + slot;
            const f32x4 v0 = acc[ai][bj][m][0], v1 = acc[ai][bj][m][1];
            int w0 = 0, w1 = 0;
            w0 = __builtin_amdgcn_cvt_pk_fp8_f32(v0[0], v0[1], w0, false); w0 = __builtin_amdgcn_cvt_pk_fp8_f32(v0[2], v0[3], w0, true);
            w1 = __builtin_amdgcn_cvt_pk_fp8_f32(v1[0], v1[1], w1, false); w1 = __builtin_amdgcn_cvt_pk_fp8_f32(v1[2], v1[3], w1, true);
            vp[0] = (unsigned char)(w0 & 0xFF); vp[80] = (unsigned char)((w0 >> 8) & 0xFF); vp[160] = (unsigned char)((w0 >> 16) & 0xFF); vp[240] = (unsigned char)((w0 >> 24) & 0xFF);
            vp[320] = (unsigned char)(w1 & 0xFF); vp[400] = (unsigned char)((w1 >> 8) & 0xFF); vp[480] = (unsigned char)((w1 >> 16) & 0xFF); vp[560] = (unsigned char)((w1 >> 24) & 0xFF);
          }
        continue;
      }
#pragma unroll
      for (int ai = 0; ai < 2; ++ai)
#pragma unroll
        for (int m = 0; m < 4; ++m) {
          const int row = u.pm * 256 + ai * 128 + wr * 64 + m * 16 + fr;
          f32x4 v0 = acc[ai][bj][m][0], v1 = acc[ai][bj][m][1];
          if (rope) {
            const int s = row % SEGL;
            if (s >= CTXL) {
              const int idx = (s - CTXL) * 32 + ((col8 & 63) >> 1);
              const f32x4 c = *(const f32x4*)(RC + idx), sn = *(const f32x4*)(RS + idx);
              f32x4 a, b;
              a[0] = v0[0] * c[0] - v0[1] * sn[0]; a[1] = v0[0] * sn[0] + v0[1] * c[0]; a[2] = v0[2] * c[1] - v0[3] * sn[1]; a[3] = v0[2] * sn[1] + v0[3] * c[1];
              b[0] = v1[0] * c[2] - v1[1] * sn[2]; b[1] = v1[0] * sn[2] + v1[1] * c[2]; b[2] = v1[2] * c[3] - v1[3] * sn[3]; b[3] = v1[2] * sn[3] + v1[3] * c[3];
              v0 = a; v1 = b;
            }
          }
          u32x4 w; w.x = cvtpk(v0[0] * scl, v0[1] * scl); w.y = cvtpk(v0[2] * scl, v0[3] * scl); w.z = cvtpk(v1[0] * scl, v1[1] * scl); w.w = cvtpk(v1[2] * scl, v1[3] * scl);
          *(u32x4*)(PROJ + (size_t)row * PW + col8) = w;
        }
    }
  }
};
struct EpiOutproj {
  static constexpr bool PERM = true, AFTER_DRAIN = false;
  float* XC; const float* MODL; const float* xin; const float* ctxin; int first; float gsc;
  __device__ __forceinline__ void operator()(const pg8::f32x4 (&acc)[2][2][4][2], const pg8::Unit& u, int wr, int wc, int fr, int fq) const {
    const int mr = (u.pm % 33) == 0 ? 4 : u.pm / 33;
    const float* g1 = MODL + (size_t)mr * 6144 + 2048;
#pragma unroll
    for (int bj = 0; bj < 2; ++bj) {
      const int col8 = u.pn * 256 + bj * 128 + wc * 32 + 8 * fq;
      const f32x4 ga = *(const f32x4*)(g1 + col8) * gsc, gb = *(const f32x4*)(g1 + col8 + 4) * gsc;
#pragma unroll
      for (int ai = 0; ai < 2; ++ai)
#pragma unroll
        for (int m = 0; m < 4; ++m) {
          const int row = u.pm * 256 + ai * 128 + wr * 64 + m * 16 + fr;
          const float* xo = first ? in_row(xin, ctxin, row) + col8 : XC + (size_t)row * DM + col8;
          const f32x4 xa = *(const f32x4*)xo, xb = *(const f32x4*)(xo + 4);
          *(f32x4*)(XC + (size_t)row * DM + col8) = xa + ga * acc[ai][bj][m][0];
          *(f32x4*)(XC + (size_t)row * DM + col8 + 4) = xb + gb * acc[ai][bj][m][1];
        }
    }
  }
};
struct EpiPeerq {
  static constexpr bool PERM = true, AFTER_DRAIN = false;
  bf16_t* QP;
  __device__ __forceinline__ void operator()(const pg8::f32x4 (&acc)[2][2][4][2], const pg8::Unit& u, int wr, int wc, int fr, int fq) const {
#pragma unroll
    for (int bj = 0; bj < 2; ++bj) {
      const int col8 = u.pn * 256 + bj * 128 + wc * 32 + 8 * fq;
#pragma unroll
      for (int ai = 0; ai < 2; ++ai)
#pragma unroll
        for (int m = 0; m < 4; ++m) {
          const int row = u.pm * 256 + ai * 128 + wr * 64 + m * 16 + fr;
          const f32x4 v0 = acc[ai][bj][m][0], v1 = acc[ai][bj][m][1];
          u32x4 w; w.x = cvtpk(v0[0], v0[1]); w.y = cvtpk(v0[2], v0[3]); w.z = cvtpk(v1[0], v1[1]); w.w = cvtpk(v1[2], v1[3]);
          *(u32x4*)(QP + (size_t)row * DM + col8) = w;
        }
    }
  }
};
__device__ __forceinline__ void phase_inproj2(const Params& p, int l, unsigned char* lds) {
  {
    pg8::Gemm g{(const bf16_t*)(p.ws + WS_H), (const bf16_t*)(p.ws + WS_WIN) + (size_t)l * PW * DM, T, PW, DM};
    pg8::StaticOrder S; S.init(T, PW, p.gx, p.bx);
    EpiInproj E{(bf16_t*)(p.ws + WS_PROJ), (const float*)(p.ws + WS_ROPE), (const float*)(p.ws + WS_ROPE) + SEQ * 32, p.ws + WS_V8T};
    pg8::gemm_phase<EpiInproj, pg8::StaticOrder, true, true>((PG8_LAS unsigned char*)lds, g, S, E);
  }
  int tid_ = tidx(); asm volatile("" : "+v"(tid_)); const int tid = tid_, lane = tid & 63, wid = tid >> 6;
  const bf16_t* H = (const bf16_t*)(p.ws + WS_H);
  for (int pm = p.gx - 1 - p.bx; pm < T / 256; pm += p.gx) {
    const int rowb = pm * 256 + wid * 32;
    const bf16_t* WG = (const bf16_t*)(p.ws + WS_WG) + (size_t)l * 16 * DM;
    float* GT = (float*)(p.ws + WS_GATES);
    const int r16 = lane & 15, q4 = lane >> 4;
    f32x4 c0 = {0.f, 0.f, 0.f, 0.f}, c1 = {0.f, 0.f, 0.f, 0.f};
    const bf16_t* a0p = H + (size_t)(rowb + r16) * DM + q4 * 8;
    const bf16_t* a1p = a0p + (size_t)16 * DM;
    const bf16_t* bp = WG + (size_t)r16 * DM + q4 * 8;
#pragma unroll 4
    for (int ks = 0; ks < 32; ++ks) {
      const bf16x8 a0 = *(const bf16x8*)(a0p + ks * 32), a1 = *(const bf16x8*)(a1p + ks * 32), b = *(const bf16x8*)(bp + ks * 32);
      c0 = __builtin_amdgcn_mfma_f32_16x16x32_bf16(a0, b, c0, 0, 0, 0);
      c1 = __builtin_amdgcn_mfma_f32_16x16x32_bf16(a1, b, c1, 0, 0, 0);
    }
    const float gb = p.in[I_GATEB][l * 16 + r16];
#pragma unroll
    for (int j = 0; j < 4; ++j) {
      GT[(size_t)(rowb + q4 * 4 + j) * 16 + r16] = c0[j] + gb;
      GT[(size_t)(rowb + 16 + q4 * 4 + j) * 16 + r16] = c1[j] + gb;
    }
  }
}
__device__ __forceinline__ void phase_outproj2(const Params& p, int l, unsigned char* lds) {
  pg8::Gemm g{(const bf16_t*)(p.ws + WS_MIX), (const bf16_t*)(p.ws + WS_WOUT) + (size_t)l * DM * DM, T, DM, DM};
  pg8::StaticOrder S; S.init(T, DM, p.gx, p.bx);
  for (int rep = 0; rep < REP_OUTP; ++rep) {
  EpiOutproj E{(float*)(p.ws + WS_XCUR), (const float*)(p.ws + WS_MOD) + (size_t)l * 5 * 6144, p.in[I_X], p.in[I_CTX], l == 0, (rep == REP_OUTP - 1) ? 1.f : 0.f};
  pg8::gemm_phase<EpiOutproj, pg8::StaticOrder, true, true>((PG8_LAS unsigned char*)lds, g, S, E);
  }
  tail_filler_tables(p, l, (T / 256) * (DM / 256), l == 0 ? 0 : NEXP, 2 * NEXP);
}
__device__ __forceinline__ void phase_peerq2(const Params& p, int l, unsigned char* lds) {
  pg8::Gemm g{(const bf16_t*)(p.ws + WS_H), (const bf16_t*)(p.ws + WS_WQ) + (size_t)l * DM * DM, T, DM, DM};
  pg8::StaticOrder S; S.init(T, DM, p.gx, p.bx);
  EpiPeerq E{(bf16_t*)(p.ws + WS_PROJ)};
  pg8::gemm_phase<EpiPeerq, pg8::StaticOrder, true, true>((PG8_LAS unsigned char*)lds, g, S, E);
  if (l < DEPTH - 1) tail_filler_tables(p, l + 1, (T / 256) * (DM / 256), 0, NEXP);
}

__device__ __forceinline__ void conv_unit(const Params& p, int l, int unit, unsigned char* lds) {
  int tid_ = tidx(); asm volatile("" : "+v"(tid_)); const int tid = tid_, lane = tid & 63, wid = tid >> 6;
  float* U = (float*)lds;
  const bf16_t* PROJ = (const bf16_t*)(p.ws + WS_PROJ);
  bf16_t* MIX = (bf16_t*)(p.ws + WS_MIX);
  const int row0 = unit * 32, b = row0 / SEGL, s0 = row0 - b * SEGL;
  const int seglo = s0 < CTXL ? 0 : CTXL, seghi = s0 < CTXL ? CTXL : SEGL;
  for (int rr = tid >> 5; rr < 62; rr += 16) {
    const int s = s0 - 15 + rr, c8 = (tid & 31) * 8;
    f32x4 u0 = {0.f, 0.f, 0.f, 0.f}, u1 = {0.f, 0.f, 0.f, 0.f};
    if (s >= seglo && s < seghi) {
      const bf16_t* pr = PROJ + (size_t)(b * SEGL + s) * PW + c8;
      const u32x4 a1 = *(const u32x4*)pr, a2 = *(const u32x4*)(pr + 256);
      u0.x = bflo(a1.x) * sigmoidf_(bflo(a2.x)); u0.y = bfhi(a1.x) * sigmoidf_(bfhi(a2.x));
      u0.z = bflo(a1.y) * sigmoidf_(bflo(a2.y)); u0.w = bfhi(a1.y) * sigmoidf_(bfhi(a2.y));
      u1.x = bflo(a1.z) * sigmoidf_(bflo(a2.z)); u1.y = bfhi(a1.z) * sigmoidf_(bfhi(a2.z));
      u1.z = bflo(a1.w) * sigmoidf_(bflo(a2.w)); u1.w = bfhi(a1.w) * sigmoidf_(bfhi(a2.w));
    }
    *(f32x4*)(U + rr * 256 + c8) = u0; *(f32x4*)(U + rr * 256 + c8 + 4) = u1;
  }
  __syncthreads();
  float* Y = U + 62 * 256;
  const float* cw = p.in[I_CONVW] + (size_t)l * 31 * 256;
#pragma unroll 1
  for (int q = 0; q < 4; ++q) {
    const int c = lane + 64 * q;
    float w[31];
#pragma unroll
    for (int j = 0; j < 31; ++j) w[j] = cw[j * 256 + c];
    const float bias = p.in[I_CONVB][l * 256 + c];
#pragma unroll
    for (int tt = 0; tt < 4; ++tt) {
      const int t = wid * 4 + tt;
      float a = bias;
#pragma unroll
      for (int j = 0; j < 31; ++j) a += U[(t + j) * 256 + c] * w[j];
      Y[t * 256 + c] = a;
    }
  }
  asm volatile("s_waitcnt lgkmcnt(0)" ::: "memory");
  float y[4][4];
#pragma unroll
  for (int tt = 0; tt < 4; ++tt)
#pragma unroll
    for (int q = 0; q < 4; ++q) y[tt][q] = Y[(wid * 4 + tt) * 256 + lane + 64 * q];
#pragma unroll
  for (int tt = 0; tt < 4; ++tt) {
    const int t = wid * 4 + tt;
    const float mean = wave_sum((y[tt][0] + y[tt][1]) + (y[tt][2] + y[tt][3])) * (1.f / 256.f);
    float v = 0.f;
#pragma unroll
    for (int q = 0; q < 4; ++q) { const float d = y[tt][q] - mean; v += d * d; }
    const float rs = rsqrtf(wave_sum(v) * (1.f / 256.f) + EPS);
#pragma unroll
    for (int q = 0; q < 4; ++q) {
      const int c = lane + 64 * q;
      const float z = (y[tt][q] - mean) * rs * p.in[I_CLNG][l * 256 + c] + p.in[I_CLNB][l * 256 + c];
      const float o = (ABL & 1) ? 0.f : z * sigmoidf_(z);
      MIX[(size_t)(row0 + t) * DM + c] = (bf16_t)(cvtpk(o, 0.f) & 0xffffu);
    }
  }
  __syncthreads();
}

__device__ __forceinline__ int ml_cidx(int ch, int dir) { return dir == 0 ? ch : (ch < 4 ? 3 - ch : 135 - ch); }
__device__ __forceinline__ void ml_load_tile(const bf16_t* src, float* dst, int tid) {
  const int r = tid >> 3, c8 = (tid & 7) * 8;
  const u32x4 a = *(const u32x4*)(src + (size_t)r * PW + c8);
  float* d = dst + r * 65 + c8;
  d[0] = bflo(a.x); d[1] = bfhi(a.x); d[2] = bflo(a.y); d[3] = bfhi(a.y); d[4] = bflo(a.z); d[5] = bfhi(a.z); d[6] = bflo(a.w); d[7] = bfhi(a.w);
}
__device__ __forceinline__ void ml_local_unit(const Params& p, int l, int unit, unsigned char* lds) {
  int tid_ = tidx(); asm volatile("" : "+v"(tid_)); const int tid = tid_, lane = tid & 63, wid = tid >> 6, r32 = lane & 31, hi = lane >> 5;
  float* Kt = (float*)lds; float* Vt = Kt + 64 * 65; float* WK = Vt + 64 * 65;
  const bf16_t* PROJ = (const bf16_t*)(p.ws + WS_PROJ);
  const float* GT = (const float*)(p.ws + WS_GATES);
  float* UL = (float*)(p.ws + WS_ULOC); float* META = (float*)(p.ws + WS_MLMETA);
  const int b = unit / (4 * NCH), hh = (unit / NCH) & 3, ch = unit % NCH;
  const int row0 = b * SEGL + ch * 64;
  ml_load_tile(PROJ + (size_t)row0 * PW + C_MK + hh * 64, Kt, tid);
  ml_load_tile(PROJ + (size_t)row0 * PW + C_MV + hh * 64, Vt, tid);
  if (wid < 2) {
    const int dir = wid;
    const float ig = GT[(size_t)(row0 + lane) * 16 + (2 * dir) * 4 + hh];
    const float lf = logsigmoidf_(GT[(size_t)(row0 + lane) * 16 + (2 * dir + 1) * 4 + hh]);
    float ps = lf;
    ps = wave_incl_scan(ps);
    const float tot = __uint_as_float((unsigned)__builtin_amdgcn_readlane((int)__float_as_uint(ps), 63));
    const float wlog = dir == 0 ? (tot - ps + ig) : (ps - lf + ig);
    const float mloc = wave_max(wlog);
    WK[dir * 64 + lane] = __expf(wlog - mloc);
    if (lane == 0) {
      const int seq = (b * 4 + hh) * 2 + dir, ci = ml_cidx(ch, dir);
      META[((size_t)seq * NCH + ci) * 4 + 0] = tot; META[((size_t)seq * NCH + ci) * 4 + 1] = mloc;
    }
  }
  __syncthreads();
  {
    const int dir = wid >> 2, et = (wid >> 1) & 1, dt = wid & 1;
    const int seq = (b * 4 + hh) * 2 + dir, ci = ml_cidx(ch, dir);
    float* slot = UL + ((size_t)seq * NCH + ci) * USTRIDE;
    f32x16 acc = {};
#pragma unroll 8
    for (int ks = 0; ks < 32; ++ks) {
      const int s = 2 * ks + hi;
      const float a = WK[dir * 64 + s] * Vt[s * 65 + et * 32 + r32];
      const float bb = Kt[s * 65 + dt * 32 + r32];
      acc = __builtin_amdgcn_mfma_f32_32x32x2f32(a, bb, acc, 0, 0, 0);
    }
#pragma unroll
    for (int r = 0; r < 16; ++r) slot[(et * 32 + crow(r, hi)) * 64 + dt * 32 + r32] = acc[r];
    if (et == 0) {
      float n = 0.f;
#pragma unroll 8
      for (int i = 0; i < 32; ++i) { const int s = hi * 32 + i; n += WK[dir * 64 + s] * Kt[s * 65 + dt * 32 + r32]; }
      n = sum_xor32(n);
      if (hi == 0) slot[4096 + dt * 32 + r32] = n;
    }
  }
  __syncthreads();
}
constexpr int MLP = 144;
constexpr size_t WS_CST = WS_H;
constexpr size_t WS_NST = WS_H + (size_t)32 * NCH * 4096 * 2;
__device__ __forceinline__ void ml_stage_rm(const bf16_t* src, size_t ld, unsigned char* dst, int tid) {
  const int r = tid >> 3, c8 = (tid & 7) * 8;
  *(u32x4*)(dst + r * MLP + c8 * 2) = *(const u32x4*)(src + (size_t)r * ld + c8);
}
__device__ __forceinline__ void ml_stage_tr(const bf16_t* src, size_t ld, unsigned char* dst, int tid) {
  const int r = tid >> 3, c8 = (tid & 7) * 8;
  const u32x4 a = *(const u32x4*)(src + (size_t)r * ld + c8);
  bf16_t* d = (bf16_t*)dst;
  d[(c8 + 0) * 72 + r] = (bf16_t)(a.x & 0xffffu); d[(c8 + 1) * 72 + r] = (bf16_t)(a.x >> 16);
  d[(c8 + 2) * 72 + r] = (bf16_t)(a.y & 0xffffu); d[(c8 + 3) * 72 + r] = (bf16_t)(a.y >> 16);
  d[(c8 + 4) * 72 + r] = (bf16_t)(a.z & 0xffffu); d[(c8 + 5) * 72 + r] = (bf16_t)(a.z >> 16);
  d[(c8 + 6) * 72 + r] = (bf16_t)(a.w & 0xffffu); d[(c8 + 7) * 72 + r] = (bf16_t)(a.w >> 16);
}
__device__ __forceinline__ void ml_local_unit2(const Params& p, int l, int unit, unsigned char* lds) {
  int tid_ = tidx(); asm volatile("" : "+v"(tid_)); const int tid = tid_, lane = tid & 63, wid = tid >> 6, r32 = lane & 31, hi = lane >> 5;
  unsigned char* KT = lds; unsigned char* VT = lds + 64 * MLP; float* WK = (float*)(lds + 2 * 64 * MLP);
  const bf16_t* PROJ = (const bf16_t*)(p.ws + WS_PROJ);
  const float* GT = (const float*)(p.ws + WS_GATES);
  float* UL = (float*)(p.ws + WS_ULOC); float* META = (float*)(p.ws + WS_MLMETA);
  const int b = unit / (4 * NCH), hh = (unit / NCH) & 3, ch = unit % NCH;
  const int row0 = b * SEGL + ch * 64;
  ml_stage_tr(PROJ + (size_t)row0 * PW + C_MK + hh * 64, PW, KT, tid);
  ml_stage_tr(PROJ + (size_t)row0 * PW + C_MV + hh * 64, PW, VT, tid);
  if (wid < 2) {
    const int dir = wid;
    const float ig = GT[(size_t)(row0 + lane) * 16 + (2 * dir) * 4 + hh];
    const float lf = logsigmoidf_(GT[(size_t)(row0 + lane) * 16 + (2 * dir + 1) * 4 + hh]);
    float ps = lf;
    ps = wave_incl_scan(ps);
    const float tot = __uint_as_float((unsigned)__builtin_amdgcn_readlane((int)__float_as_uint(ps), 63));
    const float wlog = dir == 0 ? (tot - ps + ig) : (ps - lf + ig);
    const float mloc = wave_max(wlog);
    WK[dir * 64 + lane] = __expf(wlog - mloc);
    if (lane == 0) {
      const int seq = (b * 4 + hh) * 2 + dir, ci = ml_cidx(ch, dir);
      META[((size_t)seq * NCH + ci) * 4 + 0] = tot; META[((size_t)seq * NCH + ci) * 4 + 1] = mloc;
    }
  }
  __syncthreads();
  {
    const int dir = wid >> 2, et = (wid >> 1) & 1, dt = wid & 1;
    const int seq = (b * 4 + hh) * 2 + dir, ci = ml_cidx(ch, dir);
    float* slot = UL + ((size_t)seq * NCH + ci) * USTRIDE;
    f32x16 acc = {};
#pragma unroll
    for (int ks = 0; ks < 4; ++ks) {
      const int s0 = ks * 16 + hi * 8;
      const u32x4 va = *(const u32x4*)(VT + (et * 32 + r32) * MLP + s0 * 2);
      const bf16x8 kb = *(const bf16x8*)(KT + (dt * 32 + r32) * MLP + s0 * 2);
      const f32x4 w0 = *(const f32x4*)(WK + dir * 64 + s0), w1 = *(const f32x4*)(WK + dir * 64 + s0 + 4);
      u32x4 sa; sa.x = cvtpk(bflo(va.x) * w0.x, bfhi(va.x) * w0.y); sa.y = cvtpk(bflo(va.y) * w0.z, bfhi(va.y) * w0.w);
      sa.z = cvtpk(bflo(va.z) * w1.x, bfhi(va.z) * w1.y); sa.w = cvtpk(bflo(va.w) * w1.z, bfhi(va.w) * w1.w);
      acc = __builtin_amdgcn_mfma_f32_32x32x16_bf16(*(const bf16x8*)&sa, kb, acc, 0, 0, 0);
    }
#pragma unroll
    for (int r = 0; r < 16; ++r) slot[(et * 32 + crow(r, hi)) * 64 + dt * 32 + r32] = acc[r];
    if (et == 0) {
      float n = 0.f;
#pragma unroll
      for (int i = 0; i < 4; ++i) {
        const int s0 = hi * 32 + i * 8;
        const u32x4 ka = *(const u32x4*)(KT + (dt * 32 + r32) * MLP + s0 * 2);
        const f32x4 w0 = *(const f32x4*)(WK + dir * 64 + s0), w1 = *(const f32x4*)(WK + dir * 64 + s0 + 4);
        n += bflo(ka.x) * w0.x + bfhi(ka.x) * w0.y + bflo(ka.y) * w0.z + bfhi(ka.y) * w0.w + bflo(ka.z) * w1.x + bfhi(ka.z) * w1.y + bflo(ka.w) * w1.z + bfhi(ka.w) * w1.w;
      }
      n = sum_xor32(n);
      if (hi == 0) slot[4096 + dt * 32 + r32] = n;
    }
  }
  __syncthreads();
}
__device__ __forceinline__ void ml_scan(const Params& p, unsigned char* lds) {
  float* UL = (float*)(p.ws + WS_ULOC); float* META = (float*)(p.ws + WS_MLMETA);
  int tid_ = tidx(); asm volatile("" : "+v"(tid_));
  const int tid = tid_, lane = tid & 63, wid = tid >> 6;
  float* DEC = (float*)lds;
  float* SCL = DEC + 2 * NCH;
  float* TMP = SCL + 2 * NCH;
  constexpr int NSL = (32 * USTRIDE + 511) / 512;
  const int first_ = p.gx > 64 ? 16 : 0, nb_ = p.gx - first_;
  for (int k_ = 0; k_ < 2 + (NSL + nb_ - 1) / nb_; ++k_) {
    int s_;
    if (k_ == 0) s_ = p.bx >= first_ ? p.bx - first_ : -1;
    else s_ = k_ * nb_ + (p.gx - 1 - p.bx);
    if (k_ > 0 && p.gx - 1 - p.bx >= nb_) s_ = -1;
    if (s_ < 0 || s_ >= NSL) continue;
    const int base0 = s_ * 512;
    const int seq0 = base0 / USTRIDE;
    if (wid < 2) {
      const int seq = seq0 + wid;
      if (seq < 32) {
        float* mt = META + (size_t)seq * NCH * 4;
        for (int c = lane; c < NCH; c += 64) { TMP[(wid * 2 + 0) * NCH + c] = mt[c * 4 + 0]; TMP[(wid * 2 + 1) * NCH + c] = mt[c * 4 + 1]; }
        asm volatile("s_waitcnt lgkmcnt(0)" ::: "memory");
        if (lane == 0) {
          float m = 0.f;
          for (int c = 0; c < NCH; ++c) {
            const float bl = TMP[(wid * 2 + 0) * NCH + c], mloc = TMP[(wid * 2 + 1) * NCH + c];
            const float mn = fmaxf(bl + m, mloc);
            DEC[wid * NCH + c] = __expf(bl + m - mn); SCL[wid * NCH + c] = __expf(mloc - mn);
            mt[c * 4 + 2] = m;
            m = mn;
          }
        }
      }
    }
    __syncthreads();
    const int idx = base0 + tid;
    if (idx < 32 * USTRIDE) {
      const int seq = idx / USTRIDE, e = idx - seq * USTRIDE, sl = seq - seq0;
      float* bp = UL + (size_t)seq * NCH * USTRIDE + e;
      bf16_t* CSTp = (bf16_t*)(p.ws + WS_CST) + (size_t)seq * NCH * 4096 + (e < 4096 ? e : 0);
      float* NSTp = (float*)(p.ws + WS_NST) + (size_t)seq * NCH * 64 + (e < 4096 ? 0 : e - 4096);
      const float* dec = DEC + sl * NCH; const float* scl = SCL + sl * NCH;
      float C = 0.f;
      constexpr int BT = 33;
      static_assert(NCH == 4 * BT, "scan batches");
      float ua[BT], ub[BT];
#define SCAN_LD(u_, c0_) _Pragma("unroll") for (int j = 0; j < BT; ++j) u_[j] = bp[(size_t)((c0_) + j) * USTRIDE];
#define SCAN_DO(u_, c0_) _Pragma("unroll") for (int j = 0; j < BT; ++j) { \
          if (e < 4096) CSTp[(size_t)((c0_) + j) * 4096] = (bf16_t)(cvtpk(C, 0.f) & 0xffffu); else NSTp[(size_t)((c0_) + j) * 64] = C; \
          C = dec[(c0_) + j] * C + scl[(c0_) + j] * u_[j]; }
      SCAN_LD(ua, 0)
#pragma unroll 1
      for (int c0 = 0; c0 < NCH; c0 += 2 * BT) {
        SCAN_LD(ub, c0 + BT)
        SCAN_DO(ua, c0)
        if (c0 + 2 * BT < NCH) { SCAN_LD(ua, c0 + 2 * BT) }
        SCAN_DO(ub, c0 + BT)
      }
#undef SCAN_LD
#undef SCAN_DO
    }
    __syncthreads();
  }
}
__device__ __forceinline__ void ml_out_unit(const Params& p, int l, int unit, unsigned char* lds) {
  int tid_ = tidx(); asm volatile("" : "+v"(tid_)); const int tid = tid_, lane = tid & 63, wid = tid >> 6, r32 = lane & 31, hi = lane >> 5;
  float* Qt = (float*)lds; float* Kt = Qt + 64 * 65; float* Vt = Kt + 64 * 65;
  float* Cs = Vt + 64 * 65;
  float* Ns = Cs + 2 * 64 * 65;
  float* Bq = Ns + 128;
  float* Gs = Bq + 128;
  float* Mi = Gs + 128;
  float* HB = Mi + 64;
  const bf16_t* PROJ = (const bf16_t*)(p.ws + WS_PROJ);
  const float* GT = (const float*)(p.ws + WS_GATES);
  const float* UL = (const float*)(p.ws + WS_ULOC); const float* META = (const float*)(p.ws + WS_MLMETA);
  bf16_t* MIX = (bf16_t*)(p.ws + WS_MIX);
  const int b = unit / (4 * NCH), hh = (unit / NCH) & 3, ch = unit % NCH;
  const int row0 = b * SEGL + ch * 64;
  ml_load_tile(PROJ + (size_t)row0 * PW + C_MQ + hh * 64, Qt, tid);
  ml_load_tile(PROJ + (size_t)row0 * PW + C_MK + hh * 64, Kt, tid);
  ml_load_tile(PROJ + (size_t)row0 * PW + C_MV + hh * 64, Vt, tid);
  for (int i = tid; i < 2 * USTRIDE; i += 512) {
    const int dir = i / USTRIDE, e = i - dir * USTRIDE;
    const int seq = (b * 4 + hh) * 2 + dir, ci = ml_cidx(ch, dir);
    const float v = UL[((size_t)seq * NCH + ci) * USTRIDE + e];
    if (e < 4096) Cs[dir * 64 * 65 + (e >> 6) * 65 + (e & 63)] = v; else Ns[dir * 64 + (e - 4096)] = v;
  }
  if (wid < 2) {
    const int dir = wid;
    const float ig = GT[(size_t)(row0 + lane) * 16 + (2 * dir) * 4 + hh];
    const float lf = logsigmoidf_(GT[(size_t)(row0 + lane) * 16 + (2 * dir + 1) * 4 + hh]);
    float ps = lf;
    ps = wave_incl_scan(ps);
    const float tot = __uint_as_float((unsigned)__builtin_amdgcn_readlane((int)__float_as_uint(ps), 63));
    const float bc = dir == 0 ? ps : (tot - ps + lf);
    Bq[dir * 64 + lane] = bc; Gs[dir * 64 + lane] = ig - bc;
    if (lane == 0) { const int seq = (b * 4 + hh) * 2 + dir, ci = ml_cidx(ch, dir); Mi[dir] = META[((size_t)seq * NCH + ci) * 4 + 2]; }
  }
  __syncthreads();
  {
    const int dir = wid >> 2, tt = (wid >> 1) & 1, et = wid & 1;
    const int t = tt * 32 + r32;
    f32x16 sa[2] = {};
#pragma unroll 4
    for (int ks = 0; ks < 32; ++ks) {
      const float bq = Qt[t * 65 + 2 * ks + hi];
      const float a0 = Kt[(r32) * 65 + 2 * ks + hi], a1 = Kt[(32 + r32) * 65 + 2 * ks + hi];
      sa[0] = __builtin_amdgcn_mfma_f32_32x32x2f32(a0, bq, sa[0], 0, 0, 0);
      sa[1] = __builtin_amdgcn_mfma_f32_32x32x2f32(a1, bq, sa[1], 0, 0, 0);
    }
    const float bt = Bq[dir * 64 + t];
    const float inter = bt + Mi[dir];
    float mx = -INFINITY;
    f32x16 dl[2];
#pragma unroll
    for (int st = 0; st < 2; ++st)
#pragma unroll
      for (int r = 0; r < 16; ++r) {
        const int s = st * 32 + crow(r, hi);
        const bool ok = dir == 0 ? (s <= t) : (s >= t);
        const float d = ok ? bt + Gs[dir * 64 + s] : -INFINITY;
        dl[st][r] = d; mx = fmaxf(mx, d);
      }
    mx = max_xor32(mx);
    const float mt = fmaxf(inter, mx);
    const float iw = __expf(inter - mt);
    float rsum = 0.f;
#pragma unroll
    for (int st = 0; st < 2; ++st)
#pragma unroll
      for (int r = 0; r < 16; ++r) { const float w = __expf(dl[st][r] - mt); sa[st][r] *= w; rsum += sa[st][r]; }
    rsum = sum_xor32(rsum);
    float qn = 0.f;
#pragma unroll 8
    for (int i = 0; i < 32; ++i) { const int d = hi * 32 + i; qn += Ns[dir * 64 + d] * Qt[t * 65 + d]; }
    qn = sum_xor32(qn);
    const float den = rsum + iw * qn;
    const float rden = 1.f / fmaxf(fabsf(den), __expf(-mt));
    f32x16 an = {}, ac = {};
#pragma unroll
    for (int st = 0; st < 2; ++st)
#pragma unroll
      for (int r = 0; r < 16; ++r) {
        const float a = Vt[(st * 32 + crow(r, hi)) * 65 + et * 32 + r32];
        an = __builtin_amdgcn_mfma_f32_32x32x2f32(a, sa[st][r], an, 0, 0, 0);
      }
    const float* Cd = Cs + dir * 64 * 65;
#pragma unroll 4
    for (int ks = 0; ks < 32; ++ks) {
      const float a = Cd[(et * 32 + r32) * 65 + 2 * ks + hi];
      const float bq = Qt[t * 65 + 2 * ks + hi];
      ac = __builtin_amdgcn_mfma_f32_32x32x2f32(a, bq, ac, 0, 0, 0);
    }
#pragma unroll
    for (int r = 0; r < 16; ++r) HB[dir * 64 * 65 + t * 65 + et * 32 + crow(r, hi)] = (an[r] + iw * ac[r]) * rden;
  }
  __syncthreads();
  {
    const int t = tid >> 3, e8 = (tid & 7) * 8;
    float v[8]; float ss = 0.f;
#pragma unroll
    for (int i = 0; i < 8; ++i) { v[i] = HB[t * 65 + e8 + i] + HB[64 * 65 + t * 65 + e8 + i]; ss += v[i] * v[i]; }
    ss += dpp_mov<0xB1>(ss); ss += dpp_mov<0x4E>(ss); ss += dpp_mov<0x141>(ss);
    const float rs = rsqrtf(ss * (1.f / 64.f) + EPS);
    const u32x4 ov = *(const u32x4*)(PROJ + (size_t)(row0 + t) * PW + C_MO + hh * 64 + e8);
    const float og[8] = {bflo(ov.x), bfhi(ov.x), bflo(ov.y), bfhi(ov.y), bflo(ov.z), bfhi(ov.z), bflo(ov.w), bfhi(ov.w)};
    const float* g = p.in[I_MNORMG] + l * 64 + e8;
    float o[8];
#pragma unroll
    for (int i = 0; i < 8; ++i) o[i] = (ABL & 2) ? 0.f : v[i] * rs * g[i] * sigmoidf_(og[i]);
    u32x4 w; w.x = cvtpk(o[0], o[1]); w.y = cvtpk(o[2], o[3]); w.z = cvtpk(o[4], o[5]); w.w = cvtpk(o[6], o[7]);
    *(u32x4*)(MIX + (size_t)(row0 + t) * DM + 256 + hh * 64 + e8) = w;
  }
  __syncthreads();
}


struct MlOutPf { u32x4 q, k, v, c0, c1, ov; float ns0, ns1, g_ig, g_lf, mi; };
__device__ __forceinline__ void ml_out_fetch(const Params& p, int unit, int tid, MlOutPf& f) {
  const int lane = tid & 63, wid = tid >> 6;
  const bf16_t* PROJ = (const bf16_t*)(p.ws + WS_PROJ);
  const float* GT = (const float*)(p.ws + WS_GATES);
  const bf16_t* CST = (const bf16_t*)(p.ws + WS_CST); const float* NST = (const float*)(p.ws + WS_NST); const float* META = (const float*)(p.ws + WS_MLMETA);
  const int b = unit / (4 * NCH), hh = (unit / NCH) & 3, ch = unit % NCH;
  const int row0 = b * SEGL + ch * 64;
  const int r = tid >> 3, c8 = (tid & 7) * 8;
  const bf16_t* prow = PROJ + (size_t)(row0 + r) * PW + hh * 64 + c8;
  f.q = *(const u32x4*)(prow + C_MQ); f.k = *(const u32x4*)(prow + C_MK); f.v = *(const u32x4*)(prow + C_MV); f.ov = *(const u32x4*)(prow + C_MO);
  const int seq0 = (b * 4 + hh) * 2, ci0 = ml_cidx(ch, 0), ci1 = ml_cidx(ch, 1);
  f.c0 = *(const u32x4*)(CST + ((size_t)seq0 * NCH + ci0) * 4096 + r * 64 + c8);
  f.c1 = *(const u32x4*)(CST + ((size_t)(seq0 + 1) * NCH + ci1) * 4096 + r * 64 + c8);
  f.ns0 = 0.f; f.ns1 = 0.f; f.g_ig = 0.f; f.g_lf = 0.f; f.mi = 0.f;
  if (tid < 64) { f.ns0 = NST[((size_t)seq0 * NCH + ci0) * 64 + tid]; f.ns1 = NST[((size_t)(seq0 + 1) * NCH + ci1) * 64 + tid]; }
  if (wid < 2) {
    const int dir = wid;
    f.g_ig = GT[(size_t)(row0 + lane) * 16 + (2 * dir) * 4 + hh];
    f.g_lf = GT[(size_t)(row0 + lane) * 16 + (2 * dir + 1) * 4 + hh];
    f.mi = META[((size_t)(seq0 + dir) * NCH + (dir ? ci1 : ci0)) * 4 + 2];
  }
}
__device__ __forceinline__ void ml_put_rm(const u32x4 a, unsigned char* dst, int tid) { const int r = tid >> 3, c8 = (tid & 7) * 8; *(u32x4*)(dst + r * MLP + c8 * 2) = a; }
__device__ __forceinline__ void ml_put_tr(const u32x4 a, unsigned char* dst, int tid) {
  const int r = tid >> 3, c8 = (tid & 7) * 8;
  bf16_t* d = (bf16_t*)dst;
  d[(c8 + 0) * 72 + r] = (bf16_t)(a.x & 0xffffu); d[(c8 + 1) * 72 + r] = (bf16_t)(a.x >> 16);
  d[(c8 + 2) * 72 + r] = (bf16_t)(a.y & 0xffffu); d[(c8 + 3) * 72 + r] = (bf16_t)(a.y >> 16);
  d[(c8 + 4) * 72 + r] = (bf16_t)(a.z & 0xffffu); d[(c8 + 5) * 72 + r] = (bf16_t)(a.z >> 16);
  d[(c8 + 6) * 72 + r] = (bf16_t)(a.w & 0xffffu); d[(c8 + 7) * 72 + r] = (bf16_t)(a.w >> 16);
}
__device__ __forceinline__ void ml_out_unit2(const Params& p, int l, int unit, unsigned char* lds, const MlOutPf& f, int next, MlOutPf& fn) {
  int tid_ = tidx(); asm volatile("" : "+v"(tid_)); const int tid = tid_, lane = tid & 63, wid = tid >> 6, r32 = lane & 31, hi = lane >> 5;
  unsigned char* Qs = lds; unsigned char* Ks = lds + 64 * MLP; unsigned char* VT = lds + 2 * 64 * MLP; unsigned char* Cs = lds + 3 * 64 * MLP;
  float* Ns = (float*)(lds + 5 * 64 * MLP);
  float* Bq = Ns + 128;
  float* Gs = Bq + 128;
  float* Mi = Gs + 128;
  float* HB = Mi + 64;
  const bf16_t* PROJ = (const bf16_t*)(p.ws + WS_PROJ);
  const float* GT = (const float*)(p.ws + WS_GATES);
  const bf16_t* CST = (const bf16_t*)(p.ws + WS_CST); const float* NST = (const float*)(p.ws + WS_NST); const float* META = (const float*)(p.ws + WS_MLMETA);
  bf16_t* MIX = (bf16_t*)(p.ws + WS_MIX);
  const int b = unit / (4 * NCH), hh = (unit / NCH) & 3, ch = unit % NCH;
  const int row0 = b * SEGL + ch * 64;
  ml_put_rm(f.q, Qs, tid); ml_put_rm(f.k, Ks, tid); ml_put_tr(f.v, VT, tid);
  ml_put_rm(f.c0, Cs, tid); ml_put_rm(f.c1, Cs + 64 * MLP, tid);
  if (tid < 64) { Ns[tid] = f.ns0; Ns[64 + tid] = f.ns1; }
  if (wid < 2) {
    const int dir = wid;
    const float ig = f.g_ig;
    const float lf = logsigmoidf_(f.g_lf);
    float ps = lf;
    ps = wave_incl_scan(ps);
    const float tot = __uint_as_float((unsigned)__builtin_amdgcn_readlane((int)__float_as_uint(ps), 63));
    const float bc = dir == 0 ? ps : (tot - ps + lf);
    Bq[dir * 64 + lane] = bc; Gs[dir * 64 + lane] = ig - bc;
    if (lane == 0) Mi[dir] = f.mi;
  }
  const u32x4 ov = f.ov;
  if (next >= 0) ml_out_fetch(p, next, tid, fn);
  __syncthreads();
  {
    const int dir = wid >> 2, tt = (wid >> 1) & 1, et = wid & 1;
    const int t = tt * 32 + r32;
    f32x16 sa[2] = {};
    bf16x8 bq[4];
#pragma unroll
    for (int ks = 0; ks < 4; ++ks) {
      bq[ks] = *(const bf16x8*)(Qs + t * MLP + (ks * 16 + hi * 8) * 2);
      const bf16x8 a0 = *(const bf16x8*)(Ks + r32 * MLP + (ks * 16 + hi * 8) * 2), a1 = *(const bf16x8*)(Ks + (32 + r32) * MLP + (ks * 16 + hi * 8) * 2);
      sa[0] = __builtin_amdgcn_mfma_f32_32x32x16_bf16(a0, bq[ks], sa[0], 0, 0, 0);
      sa[1] = __builtin_amdgcn_mfma_f32_32x32x16_bf16(a1, bq[ks], sa[1], 0, 0, 0);
    }
    const float bt = Bq[dir * 64 + t];
    const float inter = bt + Mi[dir];
    float mx = -INFINITY;
    f32x16 dl[2];
#pragma unroll
    for (int st = 0; st < 2; ++st)
#pragma unroll
      for (int r = 0; r < 16; ++r) {
        const int s = st * 32 + crow(r, hi);
        const bool ok = dir == 0 ? (s <= t) : (s >= t);
        const float d = ok ? bt + Gs[dir * 64 + s] : -INFINITY;
        dl[st][r] = d; mx = fmaxf(mx, d);
      }
    mx = max_xor32(mx);
    const float mt = fmaxf(inter, mx);
    const float iw = __expf(inter - mt);
    float rsum = 0.f;
#pragma unroll
    for (int st = 0; st < 2; ++st)
#pragma unroll
      for (int r = 0; r < 16; ++r) { const float w = __expf(dl[st][r] - mt); sa[st][r] *= w; rsum += sa[st][r]; }
    rsum = sum_xor32(rsum);
    float qn = 0.f;
#pragma unroll
    for (int i = 0; i < 4; ++i) {
      const int d0 = hi * 32 + i * 8;
      const u32x4 qa = *(const u32x4*)(Qs + t * MLP + d0 * 2);
      const f32x4 n0 = *(const f32x4*)(Ns + dir * 64 + d0), n1 = *(const f32x4*)(Ns + dir * 64 + d0 + 4);
      qn += bflo(qa.x) * n0.x + bfhi(qa.x) * n0.y + bflo(qa.y) * n0.z + bfhi(qa.y) * n0.w + bflo(qa.z) * n1.x + bfhi(qa.z) * n1.y + bflo(qa.w) * n1.z + bfhi(qa.w) * n1.w;
    }
    qn = sum_xor32(qn);
    const float den = rsum + iw * qn;
    const float rden = 1.f / fmaxf(fabsf(den), __expf(-mt));
    f32x16 an = {}, ac = {};
#pragma unroll
    for (int st = 0; st < 2; ++st)
#pragma unroll
      for (int k2 = 0; k2 < 2; ++k2) {
        u32x4 bx; bx.x = cvtpk(sa[st][8 * k2 + 0], sa[st][8 * k2 + 1]); bx.y = cvtpk(sa[st][8 * k2 + 2], sa[st][8 * k2 + 3]);
        bx.z = cvtpk(sa[st][8 * k2 + 4], sa[st][8 * k2 + 5]); bx.w = cvtpk(sa[st][8 * k2 + 6], sa[st][8 * k2 + 7]);
        const unsigned char* vrow = VT + (et * 32 + r32) * MLP + (st * 32 + 16 * k2 + 4 * hi) * 2;
        const u32x2 v0 = *(const u32x2*)vrow, v1 = *(const u32x2*)(vrow + 16);
        u32x4 ax; ax.x = v0.x; ax.y = v0.y; ax.z = v1.x; ax.w = v1.y;
        an = __builtin_amdgcn_mfma_f32_32x32x16_bf16(*(const bf16x8*)&ax, *(const bf16x8*)&bx, an, 0, 0, 0);
      }
    const unsigned char* Cd = Cs + dir * 64 * MLP;
#pragma unroll
    for (int ks = 0; ks < 4; ++ks) {
      const bf16x8 a = *(const bf16x8*)(Cd + (et * 32 + r32) * MLP + (ks * 16 + hi * 8) * 2);
      ac = __builtin_amdgcn_mfma_f32_32x32x16_bf16(a, bq[ks], ac, 0, 0, 0);
    }
#pragma unroll
    for (int r = 0; r < 16; ++r) HB[dir * 64 * 65 + t * 65 + et * 32 + crow(r, hi)] = (an[r] + iw * ac[r]) * rden;
  }
  __syncthreads();
  {
    const int t = tid >> 3, e8 = (tid & 7) * 8;
    float v[8]; float ss = 0.f;
#pragma unroll
    for (int i = 0; i < 8; ++i) { v[i] = HB[t * 65 + e8 + i] + HB[64 * 65 + t * 65 + e8 + i]; ss += v[i] * v[i]; }
    ss += dpp_mov<0xB1>(ss); ss += dpp_mov<0x4E>(ss); ss += dpp_mov<0x141>(ss);
    const float rs = rsqrtf(ss * (1.f / 64.f) + EPS);
    const float og[8] = {bflo(ov.x), bfhi(ov.x), bflo(ov.y), bfhi(ov.y), bflo(ov.z), bfhi(ov.z), bflo(ov.w), bfhi(ov.w)};
    const float* g = p.in[I_MNORMG] + l * 64 + e8;
    float o[8];
#pragma unroll
    for (int i = 0; i < 8; ++i) o[i] = (ABL & 2) ? 0.f : v[i] * rs * g[i] * sigmoidf_(og[i]);
    u32x4 w; w.x = cvtpk(o[0], o[1]); w.y = cvtpk(o[2], o[3]); w.z = cvtpk(o[4], o[5]); w.w = cvtpk(o[6], o[7]);
    *(u32x4*)(MIX + (size_t)(row0 + t) * DM + 256 + hh * 64 + e8) = w;
  }
  __syncthreads();
}

#define KSWZ(row, colB) ((row) * 256 + ((colB) ^ (((row) & 15) << 4)))
#define SBAR() __builtin_amdgcn_sched_barrier(0)
constexpr int ATT_SHM_V = 128 * 80, ATT_SHM_K = 64 * 128 * 2;
constexpr float ATT_THR = 8.0f;
__device__ __forceinline__ int v_st(int k, int c) { const int kk = (k & ~0xC) | ((k & 4) << 1) | ((k & 8) >> 1); return ((kk >> 3) * 4 + (c >> 5)) * 512 + ((kk & 7) * 32 + (c & 31)) * 2; }
__device__ __forceinline__ int v_rd_base(int lane) { return ((lane & 3) << 3) | (((lane >> 2) & 3) << 6) | (((lane >> 4) & 1) << 5) | (((lane >> 5) & 1) << 8); }
constexpr int v_rd_off(int d0, int ks, int half) { return d0 * 512 + ks * 4096 + half * 2048; }
template <int OFF> __device__ __forceinline__ s16x4 tr_read(int vb) {
  s16x4 r; asm volatile("ds_read_b64_tr_b16 %0, %1 offset:%2" : "=&v"(r) : "v"(vb), "i"(OFF) : "memory"); return r;
}
template <int D0> __device__ __forceinline__ void pv_one(f32x16& od, int vb, bf16x8 pa0, bf16x8 pa1, bf16x8 pa2, bf16x8 pa3) {
  const s16x4 l0 = tr_read<v_rd_off(D0, 0, 0)>(vb), h0 = tr_read<v_rd_off(D0, 0, 1)>(vb), l1 = tr_read<v_rd_off(D0, 1, 0)>(vb), h1 = tr_read<v_rd_off(D0, 1, 1)>(vb);
  const s16x4 l2 = tr_read<v_rd_off(D0, 2, 0)>(vb), h2 = tr_read<v_rd_off(D0, 2, 1)>(vb), l3 = tr_read<v_rd_off(D0, 3, 0)>(vb), h3 = tr_read<v_rd_off(D0, 3, 1)>(vb);
  asm volatile("s_waitcnt lgkmcnt(0)" ::: "memory"); SBAR();
#define PK(L, H) (bf16x8){L[0], L[1], L[2], L[3], H[0], H[1], H[2], H[3]}
  od = __builtin_amdgcn_mfma_f32_32x32x16_bf16(pa0, PK(l0, h0), od, 0, 0, 0);
  od = __builtin_amdgcn_mfma_f32_32x32x16_bf16(pa1, PK(l1, h1), od, 0, 0, 0);
  od = __builtin_amdgcn_mfma_f32_32x32x16_bf16(pa2, PK(l2, h2), od, 0, 0, 0);
  od = __builtin_amdgcn_mfma_f32_32x32x16_bf16(pa3, PK(l3, h3), od, 0, 0, 0);
#undef PK
}
template <int D0> __device__ __forceinline__ void pv_two(f32x16& oa, f32x16& ob, int vb, bf16x8 a0, bf16x8 a1, bf16x8 a2, bf16x8 a3, bf16x8 b0, bf16x8 b1, bf16x8 b2, bf16x8 b3) {
  const s16x4 l0 = tr_read<v_rd_off(D0, 0, 0)>(vb), h0 = tr_read<v_rd_off(D0, 0, 1)>(vb), l1 = tr_read<v_rd_off(D0, 1, 0)>(vb), h1 = tr_read<v_rd_off(D0, 1, 1)>(vb);
  const s16x4 l2 = tr_read<v_rd_off(D0, 2, 0)>(vb), h2 = tr_read<v_rd_off(D0, 2, 1)>(vb), l3 = tr_read<v_rd_off(D0, 3, 0)>(vb), h3 = tr_read<v_rd_off(D0, 3, 1)>(vb);
  asm volatile("s_waitcnt lgkmcnt(0)" ::: "memory"); SBAR();
#define PK(L, H) (bf16x8){L[0], L[1], L[2], L[3], H[0], H[1], H[2], H[3]}
  const bf16x8 v0 = PK(l0, h0), v1 = PK(l1, h1), v2 = PK(l2, h2), v3 = PK(l3, h3);
  oa = __builtin_amdgcn_mfma_f32_32x32x16_bf16(a0, v0, oa, 0, 0, 0);
  ob = __builtin_amdgcn_mfma_f32_32x32x16_bf16(b0, v0, ob, 0, 0, 0);
  oa = __builtin_amdgcn_mfma_f32_32x32x16_bf16(a1, v1, oa, 0, 0, 0);
  ob = __builtin_amdgcn_mfma_f32_32x32x16_bf16(b1, v1, ob, 0, 0, 0);
  oa = __builtin_amdgcn_mfma_f32_32x32x16_bf16(a2, v2, oa, 0, 0, 0);
  ob = __builtin_amdgcn_mfma_f32_32x32x16_bf16(b2, v2, ob, 0, 0, 0);
  oa = __builtin_amdgcn_mfma_f32_32x32x16_bf16(a3, v3, oa, 0, 0, 0);
  ob = __builtin_amdgcn_mfma_f32_32x32x16_bf16(b3, v3, ob, 0, 0, 0);
#undef PK
}
struct KQFrag { bf16x8 b0, b1, q; };
__device__ __forceinline__ void att_ldkq(KQFrag& f, const LAS unsigned char* l3, int akk, int akq) {
  const LAS unsigned char* kp = l3 + akk;
  f.b0 = *(const LAS bf16x8*)kp; f.b1 = *(const LAS bf16x8*)(kp + 8192); f.q = *(const LAS bf16x8*)(l3 + akq);
}
#define ATT_MF(pa_, pb_, f_) do { pa_ = __builtin_amdgcn_mfma_f32_32x32x16_bf16(f_.b0, f_.q, pa_, 0, 0, 0); pb_ = __builtin_amdgcn_mfma_f32_32x32x16_bf16(f_.b1, f_.q, pb_, 0, 0, 0); } while (0)
__device__ __forceinline__ void att_qk_all(f32x16& p0, f32x16& p1, f32x16& q0, f32x16& q1, KQFrag& f0, const LAS unsigned char* l3, int akk0, int akq0, float ia, float ib) {
  KQFrag f1;
#pragma unroll
  for (int r = 0; r < 16; ++r) { p0[r] = ia; p1[r] = ia; q0[r] = ib; q1[r] = ib; }
  att_ldkq(f1, l3, akk0 ^ (1 << 5), akq0 ^ (1 << 5)); ATT_MF(p0, p1, f0); SBAR();
  att_ldkq(f0, l3, akk0 ^ (2 << 5), akq0 ^ (2 << 5)); ATT_MF(p0, p1, f1); SBAR();
  att_ldkq(f1, l3, akk0 ^ (3 << 5), akq0 ^ (3 << 5)); ATT_MF(p0, p1, f0); SBAR();
  att_ldkq(f0, l3, akk0 ^ (4 << 5), akq0 ^ (4 << 5)); ATT_MF(p0, p1, f1); SBAR();
  att_ldkq(f1, l3, akk0 ^ (5 << 5), akq0 ^ (5 << 5)); ATT_MF(q0, q1, f0); SBAR();
  att_ldkq(f0, l3, akk0 ^ (6 << 5), akq0 ^ (6 << 5)); ATT_MF(q0, q1, f1); SBAR();
  att_ldkq(f1, l3, akk0 ^ (7 << 5), akq0 ^ (7 << 5)); ATT_MF(q0, q1, f0); SBAR();
  ATT_MF(q0, q1, f1); SBAR();
}
__device__ __forceinline__ void att_softmax(f32x16& p0, f32x16& p1, float& m_reg, float& l_reg, float& alpha, bool first, i32x8& pa) {
  alpha = 1.f;
  if (first) {
    float pmax = p0[0];
#pragma unroll
    for (int r = 1; r < 16; ++r) pmax = fmaxf(pmax, p0[r]);
#pragma unroll
    for (int r = 0; r < 16; ++r) pmax = fmaxf(pmax, p1[r]);
    { auto rr = __builtin_amdgcn_permlane32_swap(__float_as_uint(pmax), __float_as_uint(pmax), false, false);
      pmax = fmaxf(__uint_as_float(rr[0]), __uint_as_float(rr[1])); }
    alpha = 0.f; m_reg = pmax;
#pragma unroll
    for (int r = 0; r < 16; ++r) { p0[r] -= pmax; p1[r] -= pmax; }
  }
#pragma unroll
  for (int r = 0; r < 16; ++r) { p0[r] = __builtin_amdgcn_exp2f(p0[r]); p1[r] = __builtin_amdgcn_exp2f(p1[r]); }
  float ps;
  {
#define VADD(d_, a_, b_) asm("v_add_f32_e32 %0, %1, %2" : "=v"(d_) : "v"(a_), "v"(b_))
    float s0, s1, s2, s3;
    VADD(s0, p0[0], p0[1]); VADD(s1, p0[8], p0[9]); VADD(s2, p1[0], p1[1]); VADD(s3, p1[8], p1[9]);
#pragma unroll
    for (int r = 2; r < 8; ++r) { VADD(s0, s0, p0[r]); VADD(s1, s1, p0[8 + r]); VADD(s2, s2, p1[r]); VADD(s3, s3, p1[8 + r]); }
    VADD(s0, s0, s1); VADD(s2, s2, s3); VADD(ps, s0, s2);
#undef VADD
  }
  { auto rr = __builtin_amdgcn_permlane32_swap(__float_as_uint(ps), __float_as_uint(ps), false, false);
    ps = __uint_as_float(rr[0]) + __uint_as_float(rr[1]); }
  if (__builtin_expect(!first && __any(ps > 256.f), 0)) {
    float emax = p0[0];
#pragma unroll
    for (int r = 1; r < 16; ++r) emax = fmaxf(emax, p0[r]);
#pragma unroll
    for (int r = 0; r < 16; ++r) emax = fmaxf(emax, p1[r]);
    { auto rr = __builtin_amdgcn_permlane32_swap(__float_as_uint(emax), __float_as_uint(emax), false, false);
      emax = fmaxf(__uint_as_float(rr[0]), __uint_as_float(rr[1])); }
    const float delta = fmaxf(__builtin_amdgcn_logf(emax), 0.f);
    alpha = __builtin_amdgcn_exp2f(-delta); m_reg += delta;
#pragma unroll
    for (int r = 0; r < 16; ++r) { p0[r] *= alpha; p1[r] *= alpha; }
    ps *= alpha;
  }
  l_reg = l_reg * alpha + ps;
#pragma unroll
  for (int v = 0; v < 4; ++v) {
    int w0, w1; asm volatile("" : "=v"(w0), "=v"(w1));
    w0 = __builtin_amdgcn_cvt_pk_fp8_f32(p0[4 * v], p0[4 * v + 1], w0, false); w0 = __builtin_amdgcn_cvt_pk_fp8_f32(p0[4 * v + 2], p0[4 * v + 3], w0, true);
    w1 = __builtin_amdgcn_cvt_pk_fp8_f32(p1[4 * v], p1[4 * v + 1], w1, false); w1 = __builtin_amdgcn_cvt_pk_fp8_f32(p1[4 * v + 2], p1[4 * v + 3], w1, true);
    pa[v] = w0; pa[4 + v] = w1;
  }
}
__device__ __forceinline__ void att_unit(const bf16_t* __restrict__ Qb, const bf16_t* __restrict__ Kh, const unsigned char* __restrict__ V8, bf16_t* __restrict__ Ob,
                                         int nkeys, float lam, const float* __restrict__ ng, float oscale, unsigned char* lds) {
  int tid_ = tidx(); asm volatile("" : "+v"(tid_)); const int tid = tid_, wid = tid >> 6, lane = tid & 63, r32 = lane & 31, hi = lane >> 5;
  const int grp = __builtin_amdgcn_readfirstlane(wid >> 2);
  unsigned char* V_lds = lds; unsigned char* K_lds = lds + 2 * ATT_SHM_V;
  float* wsl = (float*)(lds + 2 * ATT_SHM_V + 2 * ATT_SHM_K) + wid * 64; float* li_l = wsl; float* al_l = wsl + 32;
  float m0 = 0.f, l0 = 0.f, m1 = 0.f, l1 = 0.f;
  f32x16 o0[4] = {}, o1[4] = {};
  unsigned char* Q_lds = lds + 2 * ATT_SHM_V + 2 * ATT_SHM_K + 2048;
#pragma unroll
  for (int i = 0; i < 8; ++i) { const int id = tid + 512 * i, qrw = id >> 4, ch = id & 15;
    *(bf16x8*)(Q_lds + KSWZ(qrw, ch * 16)) = *(const bf16x8*)(Qb + (size_t)qrw * PW + ch * 8); }
  const int qrow = wid * 32 + r32;
  int kso[2];
#pragma unroll
  for (int i = 0; i < 2; ++i) {
    const int o16 = tid + 512 * i;
    { const int row = o16 >> 4, cs = (o16 & 15) ^ (row & 15); kso[i] = row * PW + cs * 8; }
  }
  const unsigned ldsw = (unsigned)__builtin_amdgcn_readfirstlane(wid) * 1024u;
#define GSTAGE_K(b, k0) do { _Pragma("unroll") for (int i_ = 0; i_ < 2; ++i_) \
    __builtin_amdgcn_global_load_lds((const unsigned*)(Kh + (size_t)(k0) * PW + kso[i_]), (LAS unsigned*)(K_lds + (b) * ATT_SHM_K + ldsw + i_ * 8192), 16, 0, 0); } while (0)
#define GSTAGE_V(b, k0) do { const unsigned char* vi_ = V8 + (size_t)((k0) >> 6) * ATT_SHM_V + tid * 16; \
      __builtin_amdgcn_global_load_lds((const unsigned*)vi_, (LAS unsigned*)(V_lds + (b) * ATT_SHM_V + ldsw), 16, 0, 0); \
      if (wid < 2) __builtin_amdgcn_global_load_lds((const unsigned*)(vi_ + 8192), (LAS unsigned*)(V_lds + (b) * ATT_SHM_V + 8192 + ldsw), 16, 0, 0); } while (0)
#define STAGE_PAIR(jj) do { GSTAGE_V((jj) & 1, (jj) * 64); if ((jj) + 1 < NT) GSTAGE_K((jj) & 1, ((jj) + 1) * 64); } while (0)
#define RESC(o, a) do { if (__any((a) < 1.f)) { if (hi == 0) al_l[r32] = (a); asm volatile("s_waitcnt lgkmcnt(0)" ::: "memory"); \
    _Pragma("unroll") for (int d = 0; d < 4; ++d) _Pragma("unroll") for (int r = 0; r < 16; ++r) o[d][r] *= al_l[crow(r, hi)]; } } while (0)
#define ATT_BAR() do { asm volatile("s_waitcnt lgkmcnt(0)" ::: "memory"); __builtin_amdgcn_s_barrier(); asm volatile("" ::: "memory"); } while (0)
  const int NT = nkeys / 64;
  GSTAGE_K(1, 0); STAGE_PAIR(0);
  asm volatile("s_waitcnt vmcnt(0)" ::: "memory"); __syncthreads();
  f32x16 p0, p1, q0, q1; i32x8 pa, pb;
  const LAS unsigned char* l3 = (const LAS unsigned char*)lds;
  const int ak0 = r32 * 256 + ((hi * 16) ^ ((r32 & 15) << 4));
  const int kofs0 = 2 * ATT_SHM_V, qofs0 = 2 * ATT_SHM_V + 2 * ATT_SHM_K + 2048 + __builtin_amdgcn_readfirstlane(wid) * 8192;
  static_assert((2 * ATT_SHM_V) % 256 == 0 && ATT_SHM_K % 256 == 0 && (2 * ATT_SHM_V + 2 * ATT_SHM_K + 2048) % 256 == 0, "slot offsets must leave the low 8 address bits to the swizzle");
  { KQFrag f0; att_ldkq(f0, l3, ak0 + kofs0 + ATT_SHM_K, ak0 + qofs0);
    att_qk_all(p0, p1, q0, q1, f0, l3, ak0 + kofs0 + ATT_SHM_K, ak0 + qofs0, 0.f, 0.f); }
  if (grp) ATT_BAR();
#pragma unroll 1
  for (int j = 0; j < NT; ++j) {
    const int cur = j & 1;
    const bool more = (j + 1 < NT);
    if (grp && more) STAGE_PAIR(j + 1);
    { float alphaA, alphaB;
      const bool first = (j == 0);
      att_softmax(p0, p1, m0, l0, alphaA, first, pa); SBAR();
      att_softmax(q0, q1, m1, l1, alphaB, first, pb); SBAR();
      RESC(o0, alphaA);
      RESC(o1, alphaB); }
    asm volatile("" : "+v"(pa), "+v"(pb), "+v"(m0), "+v"(l0), "+v"(m1), "+v"(l1));
    asm volatile("" : "+v"(o0[0]), "+v"(o0[1]), "+v"(o0[2]), "+v"(o0[3]), "+v"(o1[0]), "+v"(o1[1]), "+v"(o1[2]), "+v"(o1[3]));
    if (!grp) asm volatile("s_waitcnt vmcnt(0)" ::: "memory");
    ATT_BAR();
    if (!grp && more) STAGE_PAIR(j + 1);
    __builtin_amdgcn_s_setprio(1);
    {
      int kofs = kofs0 + cur * ATT_SHM_K, qofs = qofs0, ak = ak0; asm volatile("" : "+s"(kofs), "+s"(qofs), "+v"(ak));
      const int akk = ak + kofs, akq = ak + qofs;
      const LAS unsigned char* vrow = l3 + (r32 * 80 + hi * 32 + cur * ATT_SHM_V);
      u32x4 va0 = *(const LAS u32x4*)vrow, va1 = *(const LAS u32x4*)(vrow + 16), vb0, vb1;
      KQFrag f0;
#define ATT_PV(d0_, x0_, x1_) do { i32x8 bv; bv[0] = (int)x0_.x; bv[1] = (int)x0_.y; bv[2] = (int)x0_.z; bv[3] = (int)x0_.w; bv[4] = (int)x1_.x; bv[5] = (int)x1_.y; bv[6] = (int)x1_.z; bv[7] = (int)x1_.w; \
        o0[d0_] = __builtin_amdgcn_mfma_scale_f32_32x32x64_f8f6f4(pa, bv, o0[d0_], 0, 0, 0, 0x7F7F7F7F, 0, 0x7F7F7F7F); \
        o1[d0_] = __builtin_amdgcn_mfma_scale_f32_32x32x64_f8f6f4(pb, bv, o1[d0_], 0, 0, 0, 0x7F7F7F7F, 0, 0x7F7F7F7F); } while (0)
      vb0 = *(const LAS u32x4*)(vrow + 32 * 80); vb1 = *(const LAS u32x4*)(vrow + 32 * 80 + 16); ATT_PV(0, va0, va1); SBAR();
      va0 = *(const LAS u32x4*)(vrow + 64 * 80); va1 = *(const LAS u32x4*)(vrow + 64 * 80 + 16); ATT_PV(1, vb0, vb1); SBAR();
      vb0 = *(const LAS u32x4*)(vrow + 96 * 80); vb1 = *(const LAS u32x4*)(vrow + 96 * 80 + 16); ATT_PV(2, va0, va1); SBAR();
      att_ldkq(f0, l3, akk, akq);
      ATT_PV(3, vb0, vb1); SBAR();
#undef ATT_PV
      asm volatile("" : "+v"(o0[0]), "+v"(o0[1]), "+v"(o0[2]), "+v"(o0[3]), "+v"(o1[0]), "+v"(o1[1]), "+v"(o1[2]), "+v"(o1[3]));
      att_qk_all(p0, p1, q0, q1, f0, l3, akk, akq, -m0, -m1);
      asm volatile("" : "+v"(p0), "+v"(p1), "+v"(q0), "+v"(q1));
    }
    __builtin_amdgcn_s_setprio(0);
    if (grp) asm volatile("s_waitcnt vmcnt(0)" ::: "memory");
    ATT_BAR();
  }
  if (!grp) ATT_BAR();
  if (hi == 0) { li_l[r32] = 1.f / l0; al_l[r32] = lam / l1; }
  asm volatile("s_waitcnt lgkmcnt(0)" ::: "memory");
  float ss[16];
#pragma unroll
  for (int r = 0; r < 16; ++r) {
    const float a = li_l[crow(r, hi)], bq = al_l[crow(r, hi)];
    float s = 0.f;
#pragma unroll
    for (int d = 0; d < 4; ++d) { const float v = o0[d][r] * a - o1[d][r] * bq; o0[d][r] = v; s += v * v; }
    s += dpp_mov<0xB1>(s); s += dpp_mov<0x4E>(s); s += dpp_mov<0x141>(s); s += dpp_mov<0x140>(s);
    { auto rr_ = __builtin_amdgcn_permlane16_swap(__float_as_uint(s), __float_as_uint(s), false, false); s = __uint_as_float(rr_[0]) + __uint_as_float(rr_[1]); }
    ss[r] = rsqrtf(s * (1.f / 128.f) + EPS) * oscale;
  }
  bf16_t* Ow = Ob + (size_t)(wid * 32) * DM;
#pragma unroll
  for (int d = 0; d < 4; ++d) {
    const float g = ng[d * 32 + r32];
#pragma unroll
    for (int r = 0; r < 16; ++r) Ow[(size_t)crow(r, hi) * DM + d * 32 + r32] = (ABL & 4) ? (bf16_t)0 : (bf16_t)(cvtpk(o0[d][r] * ss[r] * g, 0.f) & 0xffffu);
  }
  __syncthreads();
#undef GSTAGE_K
#undef GSTAGE_V
#undef STAGE_PAIR
#undef RESC
#undef ATT_BAR
}

__device__ __forceinline__ float ins16(float (&a)[16], float x) {
#pragma unroll
  for (int i = 0; i < 16; ++i) { const float h = fmaxf(a[i], x); x = fminf(a[i], x); a[i] = h; }
  return x;
}
__device__ __forceinline__ void bsort16(float (&a)[16]) {
#pragma unroll
  for (int k = 2; k <= 16; k <<= 1)
#pragma unroll
    for (int j = k >> 1; j > 0; j >>= 1)
#pragma unroll
      for (int i = 0; i < 16; ++i) {
        const int q = i ^ j;
        if (q > i) {
          const bool desc = ((i & k) == 0);
          const float hi_ = fmaxf(a[i], a[q]), lo_ = fminf(a[i], a[q]);
          a[i] = desc ? hi_ : lo_; a[q] = desc ? lo_ : hi_;
        }
      }
}
__device__ __forceinline__ void bmerge16(float (&a)[16], const float (&b)[16]) {
#pragma unroll
  for (int i = 0; i < 16; ++i) a[i] = fmaxf(a[i], b[15 - i]);
#pragma unroll
  for (int j = 8; j > 0; j >>= 1)
#pragma unroll
    for (int i = 0; i < 16; ++i) {
      const int q = i ^ j;
      if (q > i) { const float hi_ = fmaxf(a[i], a[q]), lo_ = fminf(a[i], a[q]); a[i] = hi_; a[q] = lo_; }
    }
}
__device__ __forceinline__ float gelu_erf(float x) { return 0.5f * x * (1.f + erff(x * 0.70710678118654752440f)); }
#define XB_TMO      128
#define XB_XCNT(j)  (256  + 64 * (j))
#define XB_XSUB(j)  (1280 + 64 * (j))
#define XB_XGEN(j)  (2304 + 64 * (j))
#define XB_TOP      3328
#define XB_TOPGEN   3392
#define XCD_BAR_WORDS 3456
#define XB_SPIN_CAP (1u << 22)
__device__ __forceinline__ unsigned xb_ld(unsigned* p)              { return __hip_atomic_load(p, __ATOMIC_RELAXED, __HIP_MEMORY_SCOPE_AGENT); }
__device__ __forceinline__ unsigned xb_add(unsigned* p, unsigned v) { return __hip_atomic_fetch_add(p, v, __ATOMIC_RELAXED, __HIP_MEMORY_SCOPE_AGENT); }
__device__ __forceinline__ unsigned xb_xcc_id() { return (unsigned)__builtin_amdgcn_s_getreg((3 << 11) | 20) & 0xFu; }
#define XB_SPIN(cond, bar) do { unsigned _sp = 0; while (cond) { __builtin_amdgcn_s_sleep(1); \
    if ((++_sp & 255u) == 0u) { if (xb_ld(&(bar)[XB_TMO])) break; if (_sp > XB_SPIN_CAP) { atomicAdd(&(bar)[XB_TMO], 1u); break; } } } } while (0)
struct XcdBarrier { unsigned* bar; unsigned x; volatile LAS unsigned* st; };
__device__ __forceinline__ XcdBarrier xcd_barrier_post(unsigned* bar, volatile LAS unsigned* st) {
  XcdBarrier b; b.bar = bar; b.x = xb_xcc_id(); b.st = st;
  if (tidx() == 0) (void)xb_add(&bar[XB_XCNT(b.x)], 1u);
  return b;
}
__device__ __forceinline__ void xcd_barrier_complete(unsigned* bar, unsigned x, unsigned& nloc, unsigned& nx) {
  const unsigned G = gridDim.x * gridDim.y * gridDim.z;
  unsigned sum, cnt, mine, sp = 0u;
  for (;;) {
    sum = 0u; cnt = 0u; mine = 0u;
#pragma unroll
    for (unsigned j = 0; j < 16; ++j) { const unsigned c = xb_ld(&bar[XB_XCNT(j)]); sum += c; cnt += (c > 0u) ? 1u : 0u; mine = (j == x) ? c : mine; }
    if (sum == G) break;
    __builtin_amdgcn_s_sleep(1);
    if ((++sp & 255u) == 0u) { if (xb_ld(&bar[XB_TMO])) break; if (sp > XB_SPIN_CAP) { atomicAdd(&bar[XB_TMO], 1u); break; } }
  }
  nloc = mine > 0u ? mine : 1u; nx = cnt > 0u ? cnt : 1u;
}
__device__ __forceinline__ void xcd_barrier(const XcdBarrier& b) {
  asm volatile("s_waitcnt vmcnt(0)" ::: "memory");
  __syncthreads();
  if (tidx() == 0) {
    unsigned* bar = b.bar;
    __builtin_amdgcn_s_waitcnt(0);
    unsigned nloc = b.st[0], nx = b.st[1];
    if (nloc == 0u) { xcd_barrier_complete(bar, b.x, nloc, nx); b.st[0] = nloc; b.st[1] = nx; }
    const unsigned old = xb_add(&bar[XB_XSUB(b.x)], 1u);
    const unsigned gen = old / nloc;
    if (old + 1u == (gen + 1u) * nloc) {
      __builtin_amdgcn_fence(__ATOMIC_RELEASE, "agent");
      asm volatile("s_waitcnt vmcnt(0)" ::: "memory");
      const unsigned og = xb_add(&bar[XB_TOP], 1u);
      const unsigned tg = og / nx;
      if (og + 1u == (tg + 1u) * nx) xb_add(&bar[XB_TOPGEN], 1u);
      else XB_SPIN(xb_ld(&bar[XB_TOPGEN]) == tg, bar);
      __builtin_amdgcn_fence(__ATOMIC_ACQUIRE, "agent");
      xb_add(&bar[XB_XGEN(b.x)], 1u);
      asm volatile("s_waitcnt vmcnt(0)" ::: "memory");
    } else {
      XB_SPIN(xb_ld(&bar[XB_XGEN(b.x)]) == gen, bar);
      __builtin_amdgcn_fence(__ATOMIC_ACQUIRE, "agent");
      asm volatile("s_waitcnt vmcnt(0)" ::: "memory");
    }
  }
  __syncthreads();
}

constexpr size_t RT_STRIDE = (size_t)T * 128 * 4;
__device__ __forceinline__ void route_unit(const Params& p, int l, int unit, unsigned char* lds) {
  int tid_ = tidx(); asm volatile("" : "+v"(tid_)); const int tid = tid_, lane = tid & 63, wid = tid >> 6, r32 = lane & 31, hi = lane >> 5;
  unsigned char* IDX = lds;
  int* UE = (int*)(lds + 8192); float* UG = (float*)(lds + 8192 + 16384); float* US = (float*)(lds + 8192 + 32768);
  int* EIDG = (int*)(p.ws + WS_EID + (size_t)l * RT_STRIDE); float* GWG = (float*)(p.ws + WS_ULOC + RT_STRIDE); float* SUG = (float*)(p.ws + WS_ULOC + 2 * RT_STRIDE);
  const float* PSC = (const float*)(p.ws + WS_PSC);
  const int row0 = unit * 32;
  const bf16_t* QP = (const bf16_t*)(p.ws + WS_PROJ);
  const bf16_t* KEYS = (const bf16_t*)(p.ws + WS_KEYS) + (size_t)l * 131072;
  for (int rrep = 0; rrep < REP_ROUTE; ++rrep) {
    const int h = wid;
    float top[2][16];
#pragma unroll
    for (int pp = 0; pp < 2; ++pp) {
      const bf16_t* qrow = QP + (size_t)(row0 + r32) * DM + h * 128 + pp * 64 + hi * 8;
      const bf16_t* kb = KEYS + ((size_t)(h * 2 + pp) * 128 + r32) * 64 + hi * 8;
      bf16x8 bq[4];
#pragma unroll
      for (int ks = 0; ks < 4; ++ks) bq[ks] = *(const bf16x8*)(qrow + ks * 16);
      float (&lst)[16] = top[pp];
#pragma unroll
      for (int i = 0; i < 16; ++i) lst[i] = -INFINITY;
#pragma unroll
      for (int nt = 0; nt < 4; ++nt) {
        f32x16 acc = {};
#pragma unroll
        for (int ks = 0; ks < 4; ++ks) {
          const bf16x8 ak = *(const bf16x8*)(kb + (size_t)nt * 32 * 64 + ks * 16);
          acc = __builtin_amdgcn_mfma_f32_32x32x16_bf16(ak, bq[ks], acc, 0, 0, 0);
        }
        float grp[16];
#pragma unroll
        for (int r = 0; r < 16; ++r) grp[r] = __uint_as_float((__float_as_uint(acc[r]) & ~0x7Fu) | (unsigned)(nt * 32 + crow(r, hi)));
        bsort16(grp);
        if (nt == 0) {
#pragma unroll
          for (int i = 0; i < 16; ++i) lst[i] = grp[i];
        } else bmerge16(lst, grp);
        SBAR();
      }
      float oth[16];
#pragma unroll
      for (int i = 0; i < 16; ++i) { auto rr_ = __builtin_amdgcn_permlane32_swap(__float_as_uint(lst[i]), __float_as_uint(lst[i]), false, false); oth[i] = __uint_as_float(hi ? rr_[0] : rr_[1]); }
      bmerge16(lst, oth);
      if (hi == 0) {
        unsigned w[4];
#pragma unroll
        for (int i = 0; i < 4; ++i)
          w[i] = (__float_as_uint(lst[4 * i]) & 0x7Fu) | ((__float_as_uint(lst[4 * i + 1]) & 0x7Fu) << 8) | ((__float_as_uint(lst[4 * i + 2]) & 0x7Fu) << 16) | ((__float_as_uint(lst[4 * i + 3]) & 0x7Fu) << 24);
        *(u32x4*)(IDX + ((r32 * 8 + h) * 2 + pp) * 16) = (u32x4){w[0], w[1], w[2], w[3]};
      }
    }
    float best[16];
#define CAND(i, j) __uint_as_float((__float_as_uint(__uint_as_float(__float_as_uint(top[0][i]) & ~0x7Fu) + __uint_as_float(__float_as_uint(top[1][j]) & ~0x7Fu)) & ~0xFFu) | (unsigned)((i) * 16 + (j)))
    {
#pragma unroll
      for (int j = 0; j < 16; ++j) best[j] = CAND(0, j);
      float y[16];
#pragma unroll
      for (int j = 0; j < 8; ++j) { y[j] = CAND(1, j); y[8 + j] = CAND(15 - j, 0); }
#pragma unroll
      for (int jj = 8; jj > 0; jj >>= 1)
#pragma unroll
        for (int i = 0; i < 16; ++i) { const int q = i ^ jj; if (q > i) { const float hi_ = fmaxf(y[i], y[q]), lo_ = fminf(y[i], y[q]); y[i] = hi_; y[q] = lo_; } }
      bmerge16(best, y);
      float x[16];
      x[0] = CAND(2, 0); x[1] = CAND(2, 1); x[2] = CAND(2, 2); x[3] = CAND(2, 3); x[4] = CAND(2, 4);
      x[5] = CAND(3, 0); x[6] = CAND(3, 1); x[7] = CAND(3, 2); x[8] = CAND(3, 3);
      x[9] = CAND(4, 0); x[10] = CAND(4, 1); x[11] = CAND(4, 2);
      x[12] = CAND(5, 0); x[13] = CAND(5, 1); x[14] = CAND(6, 0); x[15] = CAND(6, 1);
      bsort16(x);
      bmerge16(best, x);
      ins16(best, CAND(7, 0)); ins16(best, CAND(7, 1));
    }
#undef CAND
    asm volatile("s_waitcnt lgkmcnt(0)" ::: "memory");
    if (hi == 0) {
      const unsigned char* ib = IDX + ((r32 * 8 + h) * 2) * 16;
      const float mx = __uint_as_float(__float_as_uint(best[0]) & ~0xFFu);
      float w[16]; float sum = 0.f;
#pragma unroll
      for (int k = 0; k < 16; ++k) { w[k] = __expf(__uint_as_float(__float_as_uint(best[k]) & ~0xFFu) - mx); sum += w[k]; }
      const float rsum = 1.f / sum;
      int ee[16]; float su_[16], sv_[16];
#pragma unroll
      for (int k = 0; k < 16; ++k) {
        const unsigned ij = __float_as_uint(best[k]) & 0xFFu;
        ee[k] = (int)ib[ij >> 4] * 128 + (int)ib[16 + (ij & 15)];
      }
#pragma unroll
      for (int k = 0; k < 16; ++k) { su_[k] = PSC[(size_t)l * NEXP + ee[k]]; sv_[k] = PSC[(size_t)(DEPTH + l) * NEXP + ee[k]]; }
#pragma unroll
      for (int k = 0; k < 16; ++k) {
        UE[r32 * 128 + h * 16 + k] = ee[k]; UG[r32 * 128 + h * 16 + k] = w[k] * rsum * sv_[k];
        US[r32 * 128 + h * 16 + k] = su_[k];
      }
    }
  }
  __syncthreads();
#pragma unroll 1
  for (int tt = 0; tt < 4; ++tt) {
    const int t = wid * 4 + tt;
    const int k0 = UE[t * 128 + lane], k1 = UE[t * 128 + 64 + lane];
    const float g0 = UG[t * 128 + lane], g1 = UG[t * 128 + 64 + lane], s0 = US[t * 128 + lane], s1 = US[t * 128 + 64 + lane];
    const int b0 = k0 >> 10, b1 = k1 >> 10;
    int base = 0, pos0 = 0, pos1 = 0;
#pragma unroll
    for (int b = 0; b < 16; ++b) {
      const unsigned long long m0 = __ballot(b0 == b), m1 = __ballot(b1 == b);
      const int c0 = __popcll(m0), c1 = __popcll(m1);
      const unsigned long long lt = (1ull << lane) - 1ull;
      if (b0 == b) pos0 = base + __popcll(m0 & lt);
      if (b1 == b) pos1 = base + c0 + __popcll(m1 & lt);
      base += c0 + c1;
    }
    const size_t ro = (size_t)(row0 + t) * 128;
    EIDG[ro + pos0] = k0; GWG[ro + pos0] = g0; SUG[ro + pos0] = s0;
    EIDG[ro + pos1] = k1; GWG[ro + pos1] = g1; SUG[ro + pos1] = s1;
  }
}
#define CAS __attribute__((address_space(4)))
typedef int i32x8 __attribute__((ext_vector_type(8)));
struct TokPref { f32x2 gs0, gs1; u32x4 hA, hB; };
struct RowPipe { i32x6 uq[4], vq[4]; i32x8 Ec; };
__device__ __forceinline__ const CAS i32x8* eid_row(const CAS unsigned char* eidg, int row) {
  return (const CAS i32x8*)(eidg + (size_t)(unsigned)__builtin_amdgcn_readfirstlane(row) * 512u);
}
__device__ __forceinline__ void tok_prefetch(const Params& p, int row, int lane, TokPref& t) {
  const float* GWG = (const float*)(p.ws + WS_ULOC + RT_STRIDE) + (size_t)row * 128;
  const float* SUG = (const float*)(p.ws + WS_ULOC + 2 * RT_STRIDE) + (size_t)row * 128;
  const bf16_t* H = (const bf16_t*)(p.ws + WS_H);
  t.gs0 = f32x2{GWG[lane], SUG[lane]}; t.gs1 = f32x2{GWG[64 + lane], SUG[64 + lane]};
  t.hA = *(const u32x4*)(H + (size_t)row * DM + lane * 16); t.hB = *(const u32x4*)(H + (size_t)row * DM + lane * 16 + 8);
}
#define LOADPAIR(dst_, tofs_, ea_, eb_) do { const u32x3v a_ = __builtin_amdgcn_raw_buffer_load_b96(rsT, lane12, (ea_) * PROW + (tofs_), 0); const unsigned b0_ = __builtin_amdgcn_raw_buffer_load_b32(rsT, lane12, (eb_) * PROW + (tofs_), 0); \
      const u32x2v b1_ = __builtin_amdgcn_raw_buffer_load_b64(rsT, lane12 + 4, (eb_) * PROW + (tofs_), 0); \
      dst_[0] = (int)a_.x; dst_[1] = (int)a_.y; dst_[2] = (int)a_.z; dst_[3] = (int)b0_; dst_[4] = (int)b1_.x; dst_[5] = (int)b1_.y; } while (0)
#define LOADGROUP(q_, tofs_, E_) do { LOADPAIR(q_[0], tofs_, E_[0], E_[1]); LOADPAIR(q_[1], tofs_, E_[2], E_[3]); LOADPAIR(q_[2], tofs_, E_[4], E_[5]); LOADPAIR(q_[3], tofs_, E_[6], E_[7]); } while (0)
constexpr int VOFS = (int)(WS_PV - WS_PU);
__device__ __forceinline__ void gather_token(const Params& p, const CAS unsigned char* eidg, const __amdgpu_buffer_rsrc_t rsT, int l, int row, int nextrow, TokPref& tp, RowPipe& rp, unsigned char* lds, int lane, int wid) {
  f32x2* GS = (f32x2*)(lds + wid * 2048);
  float* XC = (float*)(p.ws + WS_XCUR);
  const float* MOD = (const float*)(p.ws + WS_MOD);
  const CAS i32x8* EP = eid_row(eidg, row);
  const bool hasnext = nextrow >= 0;
  const CAS i32x8* EPn = eid_row(eidg, hasnext ? nextrow : row);
  GS[lane] = tp.gs0; GS[64 + lane] = tp.gs1;
  asm volatile("s_waitcnt lgkmcnt(0)" ::: "memory");
  const int eofl = ((lane >> 5) & 1) + 2 * ((lane >> 4) & 1) + 4 * ((lane >> 3) & 1);
  const int lane12 = lane * 12;
  {
    h16x2 hh[8];
    {
      const u32x4 hA = tp.hA, hB = tp.hB;
      hh[0] = __builtin_bit_cast(h16x2, __builtin_amdgcn_cvt_pkrtz(bflo(hA.x), bfhi(hA.x))); hh[1] = __builtin_bit_cast(h16x2, __builtin_amdgcn_cvt_pkrtz(bflo(hA.y), bfhi(hA.y))); hh[2] = __builtin_bit_cast(h16x2, __builtin_amdgcn_cvt_pkrtz(bflo(hA.z), bfhi(hA.z))); hh[3] = __builtin_bit_cast(h16x2, __builtin_amdgcn_cvt_pkrtz(bflo(hA.w), bfhi(hA.w)));
      hh[4] = __builtin_bit_cast(h16x2, __builtin_amdgcn_cvt_pkrtz(bflo(hB.x), bfhi(hB.x))); hh[5] = __builtin_bit_cast(h16x2, __builtin_amdgcn_cvt_pkrtz(bflo(hB.y), bfhi(hB.y))); hh[6] = __builtin_bit_cast(h16x2, __builtin_amdgcn_cvt_pkrtz(bflo(hB.z), bfhi(hB.z))); hh[7] = __builtin_bit_cast(h16x2, __builtin_amdgcn_cvt_pkrtz(bflo(hB.w), bfhi(hB.w)));
    }
    if (hasnext) tok_prefetch(p, nextrow, lane, tp);
    f32x4 xpre[4];
    { const float* xr_ = XC + (size_t)row * DM + lane * 16;
#pragma unroll
      for (int v4 = 0; v4 < 4; ++v4) xpre[v4] = *(const f32x4*)(xr_ + v4 * 4); }
    f32x2 acc2[8];
#pragma unroll
    for (int i = 0; i < 8; ++i) acc2[i] = f32x2{0.f, 0.f};
#pragma unroll 1
    for (int g8 = 0; g8 < 16; ++g8) {
      const bool pf = (g8 < 15) || hasnext;
      const f32x2 gs = GS[g8 * 8 + eofl];
      float d[8];
#pragma unroll
      for (int i2 = 0; i2 < 4; ++i2) {
        const h16x32 r = __builtin_amdgcn_cvt_scalef32_pk32_f16_fp6(rp.uq[i2], 1.0f);
        float a0 = 0.f, a1 = 0.f, b0 = 0.f, b1 = 0.f;
#define UDOT(k_) a0 = __builtin_amdgcn_fdot2(__builtin_shufflevector(r, r, 4 * (k_), 4 * (k_) + 1), hh[2 * (k_)], a0, false); b0 = __builtin_amdgcn_fdot2(__builtin_shufflevector(r, r, 16 + 4 * (k_), 17 + 4 * (k_)), hh[2 * (k_)], b0, false); \
        a1 = __builtin_amdgcn_fdot2(__builtin_shufflevector(r, r, 4 * (k_) + 2, 4 * (k_) + 3), hh[2 * (k_) + 1], a1, false); b1 = __builtin_amdgcn_fdot2(__builtin_shufflevector(r, r, 18 + 4 * (k_), 19 + 4 * (k_)), hh[2 * (k_) + 1], b1, false);
        UDOT(0) UDOT(1) UDOT(2) UDOT(3)
#undef UDOT
        d[2 * i2] = a0 + a1;
        d[2 * i2 + 1] = b0 + b1;
        asm volatile("" : "+v"(d[2 * i2]), "+v"(d[2 * i2 + 1]));
      }
      if (pf) LOADGROUP(rp.uq, 0, rp.Ec);
      float tot;
      {
        auto s01 = __builtin_amdgcn_permlane32_swap(__float_as_uint(d[0]), __float_as_uint(d[1]), false, false);
        auto s23 = __builtin_amdgcn_permlane32_swap(__float_as_uint(d[2]), __float_as_uint(d[3]), false, false);
        auto s45 = __builtin_amdgcn_permlane32_swap(__float_as_uint(d[4]), __float_as_uint(d[5]), false, false);
        auto s67 = __builtin_amdgcn_permlane32_swap(__float_as_uint(d[6]), __float_as_uint(d[7]), false, false);
        const float q01 = __uint_as_float(s01[0]) + __uint_as_float(s01[1]), q23 = __uint_as_float(s23[0]) + __uint_as_float(s23[1]);
        const float q45 = __uint_as_float(s45[0]) + __uint_as_float(s45[1]), q67 = __uint_as_float(s67[0]) + __uint_as_float(s67[1]);
        auto ta = __builtin_amdgcn_permlane16_swap(__float_as_uint(q01), __float_as_uint(q23), false, false);
        auto tb = __builtin_amdgcn_permlane16_swap(__float_as_uint(q45), __float_as_uint(q67), false, false);
        const float r0123 = __uint_as_float(ta[0]) + __uint_as_float(ta[1]);
        const float r4567 = __uint_as_float(tb[0]) + __uint_as_float(tb[1]);
        const bool b3 = (lane & 8) != 0;
        const float keep = b3 ? r4567 : r0123, send = b3 ? r0123 : r4567;
        float x = keep + dpp_mov<0x140>(send);
        x += dpp_mov<0xB1>(x); x += dpp_mov<0x4E>(x); x += dpp_mov<0x141>(x);
        tot = x * gs.y;
      }
      float ge;
      {
        const float v = tot, av = fabsf(v), tq = __builtin_amdgcn_rcpf(av * 0.2316418882f + 1.0f);
        float q = tq * 0.5307027145f + (-0.7265760135f); q = q * tq + 0.7107068705f; q = q * tq + (-0.142248368f); q = q * tq + 0.127414796f; q = q * tq;
        const float ex = __builtin_amdgcn_exp2f(v * v * (-0.72134752044f));
        const float m = v * (q * ex), r = v - m;
        ge = (v < 0.f ? m : r) * gs.x;
      }
      unsigned cw[8];
      { const unsigned gp = __builtin_bit_cast(unsigned, __builtin_amdgcn_cvt_pkrtz(ge * 1024.f, ge * 1024.f));
        cw[0] = (unsigned)__builtin_amdgcn_readlane((int)gp, 0);  cw[4] = (unsigned)__builtin_amdgcn_readlane((int)gp, 8);
        cw[2] = (unsigned)__builtin_amdgcn_readlane((int)gp, 16); cw[6] = (unsigned)__builtin_amdgcn_readlane((int)gp, 24);
        cw[1] = (unsigned)__builtin_amdgcn_readlane((int)gp, 32); cw[5] = (unsigned)__builtin_amdgcn_readlane((int)gp, 40);
        cw[3] = (unsigned)__builtin_amdgcn_readlane((int)gp, 48); cw[7] = (unsigned)__builtin_amdgcn_readlane((int)gp, 56); }
      h16x2 a16[8];
#pragma unroll
      for (int i2 = 0; i2 < 4; ++i2) {
        const h16x32 r = __builtin_amdgcn_cvt_scalef32_pk32_f16_fp6(rp.vq[i2], 1.0f);
        const h16x2 ca = __builtin_bit_cast(h16x2, cw[2 * i2]), cb = __builtin_bit_cast(h16x2, cw[2 * i2 + 1]);
#define VAXL(k_) a16[k_] = (i2 == 0) ? ca * __builtin_shufflevector(r, r, 2 * (k_), 2 * (k_) + 1) : ca * __builtin_shufflevector(r, r, 2 * (k_), 2 * (k_) + 1) + a16[k_];
#define VAXH(k_) a16[k_] = cb * __builtin_shufflevector(r, r, 16 + 2 * (k_), 17 + 2 * (k_)) + a16[k_];
        VAXL(0) VAXL(1) VAXL(2) VAXL(3) VAXL(4) VAXL(5) VAXL(6) VAXL(7)
        asm volatile("" : "+v"(a16[0]), "+v"(a16[1]), "+v"(a16[2]), "+v"(a16[3]), "+v"(a16[4]), "+v"(a16[5]), "+v"(a16[6]), "+v"(a16[7]));
        VAXH(0) VAXH(1) VAXH(2) VAXH(3) VAXH(4) VAXH(5) VAXH(6) VAXH(7)
#undef VAXL
#undef VAXH
        asm volatile("" : "+v"(a16[0]), "+v"(a16[1]), "+v"(a16[2]), "+v"(a16[3]), "+v"(a16[4]), "+v"(a16[5]), "+v"(a16[6]), "+v"(a16[7]));
      }
#pragma unroll
      for (int k = 0; k < 8; ++k) acc2[k] = f32x2{(float)a16[k].x, (float)a16[k].y} * f32x2{1.f / 1024.f, 1.f / 1024.f} + acc2[k];
      if (pf) LOADGROUP(rp.vq, VOFS, rp.Ec);
      { const CAS i32x8* src_ = g8 < 14 ? EP + (g8 + 2) : EPn + (g8 - 14); rp.Ec = *src_; }
    }
    SBAR();
    float acc[16];
#pragma unroll
    for (int i = 0; i < 8; ++i) { acc[2 * i] = acc2[i].x; acc[2 * i + 1] = acc2[i].y; }
    const int mr = mod_row(row);
    const float* g2 = MOD + ((size_t)l * 5 + mr) * 6144 + 5 * 1024;
    float* xr = XC + (size_t)row * DM;
    float xn[16]; float ssq = 0.f;
    if (ABL & 8) {
#pragma unroll
      for (int i = 0; i < 16; ++i) acc[i] = 0.f;
    }
#pragma unroll
    for (int v4 = 0; v4 < 4; ++v4) {
      const int c = lane * 16 + v4 * 4;
      const f32x4 xo = xpre[v4], gg = *(const f32x4*)(g2 + c);
      f32x4 o;
      o.x = xo.x + gg.x * acc[v4 * 4 + 0]; o.y = xo.y + gg.y * acc[v4 * 4 + 1]; o.z = xo.z + gg.z * acc[v4 * 4 + 2]; o.w = xo.w + gg.w * acc[v4 * 4 + 3];
      xn[v4 * 4 + 0] = o.x; xn[v4 * 4 + 1] = o.y; xn[v4 * 4 + 2] = o.z; xn[v4 * 4 + 3] = o.w;
      ssq += (o.x * o.x + o.y * o.y) + (o.z * o.z + o.w * o.w);
      if (l < DEPTH - 1) *(f32x4*)(xr + c) = o;
    }
    const float rs = rsqrtf(wave_sum_fast(ssq) * (1.f / DM) + EPS);
    if (l == DEPTH - 1) {
      const int b = row / SEGL, s = row - b * SEGL;
      float* orow = p.out + ((size_t)(b * SEQ + (s - CTXL))) * DM;
      const float* fg = p.in[I_FINALG];
#pragma unroll
      for (int v4 = 0; v4 < 4; ++v4) {
        const int c = lane * 16 + v4 * 4;
        const f32x4 gg = *(const f32x4*)(fg + c);
        f32x4 o; o.x = xn[v4 * 4 + 0] * rs * gg.x; o.y = xn[v4 * 4 + 1] * rs * gg.y; o.z = xn[v4 * 4 + 2] * rs * gg.z; o.w = xn[v4 * 4 + 3] * rs * gg.w;
        *(f32x4*)(orow + c) = o;
      }
    } else {
      const float* m = MOD + ((size_t)(l + 1) * 5 + mr) * 6144;
      const float* ng = p.in[I_N1G] + (l + 1) * DM;
      bf16_t* hrow = (bf16_t*)(p.ws + WS_H) + (size_t)row * DM;
#pragma unroll
      for (int hh = 0; hh < 2; ++hh) {
        float y[8];
#pragma unroll
        for (int i = 0; i < 8; ++i) { const int c = lane * 16 + hh * 8 + i; y[i] = xn[hh * 8 + i] * rs * ng[c] * (1.f + m[1024 + c]) + m[c]; }
        u32x4 w; w.x = cvtpk(y[0], y[1]); w.y = cvtpk(y[2], y[3]); w.z = cvtpk(y[4], y[5]); w.w = cvtpk(y[6], y[7]);
        *(u32x4*)(hrow + lane * 16 + hh * 8) = w;
      }
    }
  }
}

__device__ __forceinline__ void ev_signal(unsigned* ctr) {
  asm volatile("s_waitcnt vmcnt(0)" ::: "memory");
  __syncthreads();
  if (tidx() == 0) { __builtin_amdgcn_fence(__ATOMIC_RELEASE, "agent"); asm volatile("s_waitcnt vmcnt(0)" ::: "memory"); (void)xb_add(ctr, 1u); }
}
__device__ __forceinline__ void ev_wait(unsigned* ctr, unsigned n, unsigned* bar) {
  if (tidx() == 0) {
    XB_SPIN(xb_ld(ctr) < n, bar);
    __builtin_amdgcn_fence(__ATOMIC_ACQUIRE, "agent");
    asm volatile("s_waitcnt vmcnt(0)" ::: "memory");
  }
  __syncthreads();
}
constexpr int EV_WORD0 = 8192;
__device__ __forceinline__ void phase_c1(const Params& p, int l, unsigned char* lds) {
  constexpr int NLOC = NBATCH * 4 * NCH, NCONV = T / 32;
  for (int u = p.bx; u < NLOC + NCONV; u += p.gx) {
    if (u < NLOC) ml_local_unit2(p, l, u, lds);
    else {
      const int cu = u - NLOC;
      if (l == DEPTH - 1 && (cu % (SEGL / 32)) < (CTXL / 32)) continue;
      conv_unit(p, l, cu, lds);
    }
  }
}
__device__ __forceinline__ void phase_c3(const Params& p, int l, unsigned char* lds);
__device__ __forceinline__ void phase_c2(const Params& p, int l, unsigned char* lds) {
  unsigned* ev = (unsigned*)(p.ws + WS_CTL) + EV_WORD0 + 64 * l;
  ml_scan(p, lds);
  ev_signal(ev);
  const float* lp = p.in[I_DLAM] + l * 256;
  float s01 = 0.f, s23 = 0.f;
  for (int i = 0; i < 64; ++i) { s01 += lp[i] * lp[64 + i]; s23 += lp[128 + i] * lp[192 + i]; }
  const float lam_init = 0.8f - 0.6f * expf(-0.3f * (float)l);
  const float lam = expf(s01) - expf(s23) + lam_init;
  const bf16_t* PROJ = (const bf16_t*)(p.ws + WS_PROJ);
  bf16_t* MIX = (bf16_t*)(p.ws + WS_MIX);
  const float* ng = p.in[I_DNORMG] + l * 128;
  const int nun = 512 + (l < DEPTH - 1 ? 16 : 0);
  for (int u = p.bx; u < nun; u += p.gx) {
    int bh, qrow, nkeys;
    if (u < 512) { const int xcd = u & 7, i = (u >> 3) & 31, rnd = u >> 8; bh = 2 * xcd + rnd; qrow = CTXL + i * 256; nkeys = SEGL; }
    else { bh = u - 512; qrow = 0; nkeys = CTXL; }
    const int b = bh >> 2, h = bh & 3;
    const size_t tok0 = (size_t)b * SEGL;
    for (int rep = 0; rep < REP_ATT; ++rep)
    att_unit(PROJ + (tok0 + qrow) * PW + C_DQ + h * 128, PROJ + tok0 * PW + C_DK + h * 128, p.ws + WS_V8T + (size_t)bh * NCH * ATT_SHM_V,
             MIX + (tok0 + qrow) * DM + 512 + h * 128, nkeys, lam, ng, 1.f - lam_init, lds);
  }
  ev_wait(ev, (unsigned)p.gx, p.xbar_words);
  for (int rep = 0; rep < REP_ML; ++rep) phase_c3(p, l, lds);
}
__device__ __forceinline__ void phase_c3(const Params& p, int l, unsigned char* lds) {
  constexpr int NU = NBATCH * 4 * NCH;
  const int nlow = (p.gx > 64 && l < DEPTH - 1) ? 16 : 0, ulow = nlow * 7;
  int u, step;
  if (p.bx < nlow) { u = p.bx; step = nlow; } else { u = ulow + (p.bx - nlow); step = p.gx - nlow; }
  const int uend = p.bx < nlow ? ulow : NU;
  int tid_ = tidx(); asm volatile("" : "+v"(tid_));
  auto valid_from = [&](int v) { while (v < uend && l == DEPTH - 1 && (v % NCH) < 4) v += step; return v < uend ? v : -1; };
  MlOutPf fa, fb;
  u = valid_from(u);
  if (u >= 0) ml_out_fetch(p, u, tid_, fa);
  while (u >= 0) {
    const int nx = valid_from(u + step);
    ml_out_unit2(p, l, u, lds, fa, nx, fb);
    fa = fb; u = nx;
  }
}
__device__ __forceinline__ void phase_route(const Params& p, int l, unsigned char* lds) {
  constexpr int NU = T / 32;
  for (int u = p.bx; u < NU; u += p.gx) {
    if (l == DEPTH - 1 && (u % (SEGL / 32)) < (CTXL / 32)) continue;
    route_unit(p, l, u, lds);
    __syncthreads();
  }
}
__device__ __forceinline__ void phase_gather(const Params& p, int l, unsigned char* lds) {
  int tid_ = tidx(); asm volatile("" : "+v"(tid_)); const int lane = tid_ & 63, wid = __builtin_amdgcn_readfirstlane(tid_ >> 6);
  const int gw = p.bx * 8 + wid, NGW = p.gx * 8;
  const int ntok = (l == DEPTH - 1) ? NBATCH * SEQ : T;
#define TOKROW(ti_) ((l == DEPTH - 1) ? ((ti_) / SEQ) * SEGL + CTXL + ((ti_) % SEQ) : (ti_))
  const CAS unsigned char* eidg = (const CAS unsigned char*)(p.ws + WS_EID + (size_t)l * RT_STRIDE);
  const __amdgpu_buffer_rsrc_t rsT = __builtin_amdgcn_make_buffer_rsrc((void*)(p.ws + WS_PU + (size_t)l * NEXP * PROW), 0, VOFS + NEXP * PROW, 0x00020000);
  const int nfull = ntok / NGW, rem = ntok - nfull * NGW, per = (rem % p.gx == 0) ? rem / p.gx : -1;
  auto tok_at = [&](int r) -> int {
    if (r < nfull) return gw + r * NGW;
    if (r > nfull || rem == 0) return -1;
    if (per >= 0) return wid < per ? nfull * NGW + p.bx * per + wid : -1;
    return gw + r * NGW < ntok ? gw + r * NGW : -1;
  };
  TokPref tp; RowPipe rp;
  const int ti0 = tok_at(0);
  if (ti0 >= 0) {
    const int row0 = TOKROW(ti0); const int lane12 = lane * 12;
    tok_prefetch(p, row0, lane, tp);
    const CAS i32x8* EP0 = eid_row(eidg, row0);
    rp.Ec = EP0[0];
    LOADGROUP(rp.uq, 0, rp.Ec); LOADGROUP(rp.vq, VOFS, rp.Ec);
    rp.Ec = EP0[1];
  }
  XcdBarrier xb; xb.bar = p.xbar_words; xb.x = p.xbar_x; xb.st = (volatile LAS unsigned*)((LAS unsigned char*)lds + p.lds_st_off);
  const int nrounds = (ntok + NGW - 1) / NGW;
  for (int r = 0; r < nrounds; ++r) {
    const int ti = tok_at(r);
    if (ti >= 0) {
      const int row = TOKROW(ti);
      const int tn = tok_at(r + 1);
      const int nxt = tn >= 0 ? TOKROW(tn) : -1;
      gather_token(p, eidg, rsT, l, row, nxt, tp, rp, lds, lane, wid);
    }
#if GATHER_SYNC
    if (r + 1 < nrounds) { XcdBarrier xb2 = xb; size_t zb_ = 0; asm volatile("" : "+s"(zb_)); xb2.bar = xb.bar + zb_; xb2.x = xb.x + (unsigned)zb_; xcd_barrier(xb2); }
#endif
  }
#undef TOKROW
}

__global__ void __launch_bounds__(512, 2) mk_fwd(KArgs ka) {
  cg::grid_group grid = cg::this_grid();
  extern __shared__ __attribute__((aligned(16))) unsigned char lds[];
  const int lo = ka.ph_lo, hi = ka.ph_hi;
#define IN(k) (lo <= (k) && (k) < hi)
#ifndef PHASEMASK
#define PHASEMASK 0xFFFF
#endif
#define PH(i) ((PHASEMASK >> (i)) & 1)
#define MKP(q) Params q; { size_t z_ = 0; asm volatile("" : "+s"(z_)); \
    q.in = (InTab)((const __attribute__((address_space(4))) char*)__builtin_amdgcn_kernarg_segment_ptr() + z_); \
    q.out = ka.out + z_; q.ws = ka.ws + z_; q.ph_lo = lo; q.ph_hi = hi; q.bx = (int)blockIdx.x + (int)z_; q.gx = (int)gridDim.x + (int)z_; q.xbar_words = xbar.bar + z_; q.xbar_x = xbar.x + (unsigned)z_; q.lds_st_off = (unsigned)(LDS_BYTES - 64); }
#define SEAM(k) do { if (IN(k) && IN((k) + 1)) { if ((k) == 0) grid.sync(); else { XcdBarrier xb_ = xbar; size_t zb_ = 0; asm volatile("" : "+s"(zb_)); xb_.bar = xbar.bar + zb_; xb_.x = xbar.x + (unsigned)zb_; xcd_barrier(xb_); } } } while (0)
  volatile LAS unsigned* xst = (volatile LAS unsigned*)((LAS unsigned char*)lds + (LDS_BYTES - 64));
  { const int t0_ = threadIdx.x;
    if (t0_ < 2) xst[t0_] = 0u;
    if ((t0_ & 63) == 0) *(volatile LAS int*)((LAS unsigned char*)lds + LDS_WTAB + 4 * hw_wave_key()) = t0_ >> 6; }
  __syncthreads();
  XcdBarrier xbar = xcd_barrier_post((unsigned*)(ka.ws + WS_CTL) + 4096, xst);
  { MKP(p)
    if (PH(0) && IN(0)) for (int rep = 0; rep < REP_MISC; ++rep) { p0_mod(p, lds, (float*)(p.ws + WS_MOD)); p0_convert(p, lds); }
  }
  SEAM(0);
  { MKP(p)
    if (PH(1) && IN(1)) phase_norm(p, 0, 0, true, false);
  }
  SEAM(1);
#define LAYER(LL) { \
    int l = (LL); asm volatile("" : "+s"(l)); \
    const int b = 2 + 9 * (LL); \
    { MKP(q) if (PH(2) && IN(b + 0)) for (int rep = 0; rep < REP_GEMM; ++rep) phase_inproj2(q, l, lds); } \
    SEAM(b + 0); \
    { MKP(q) if (PH(3) && IN(b + 1)) for (int rep = 0; rep < REP_ML; ++rep) phase_c1(q, l, lds); } \
    SEAM(b + 1); \
    { MKP(q) if (PH(4) && IN(b + 2)) phase_c2(q, l, lds); } \
    SEAM(b + 3); \
    { MKP(q) if (PH(6) && IN(b + 4)) phase_outproj2(q, l, lds); } \
    SEAM(b + 4); \
    { MKP(q) if (PH(7) && IN(b + 5)) for (int rep = 0; rep < REP_MISC; ++rep) phase_norm(q, l, 1, false, (LL) == DEPTH - 1); } \
    SEAM(b + 5); \
    { MKP(q) if (PH(8) && IN(b + 6)) for (int rep = 0; rep < REP_GEMM; ++rep) phase_peerq2(q, l, lds); } \
    SEAM(b + 6); \
    { MKP(q) if (PH(9) && IN(b + 7)) phase_route(q, l, lds); } \
    SEAM(b + 7); \
    { MKP(q) if (PH(9) && IN(b + 8)) phase_gather(q, l, lds); } \
    SEAM(b + 8); }
  LAYER(0) LAYER(1) LAYER(2) LAYER(3)
#undef LAYER
#undef IN
#undef SEAM
#undef MKP
}

extern "C" void kernel_launch(void* const* d_in, const int* in_sizes, int n_in, void* d_out, int out_size,
                              void* d_ws, size_t ws_size, hipStream_t stream) {
  static int grid = 0;
  if (grid == 0) {
    int dev = 0, cus = 0, per_cu = 0;
    (void)hipGetDevice(&dev);
    (void)hipDeviceGetAttribute(&cus, hipDeviceAttributeMultiprocessorCount, dev);
    (void)hipFuncSetAttribute((const void*)mk_fwd, hipFuncAttributeMaxDynamicSharedMemorySize, LDS_BYTES);
    (void)hipOccupancyMaxActiveBlocksPerMultiprocessor(&per_cu, (const void*)mk_fwd, 512, LDS_BYTES);
    fprintf(stderr, "kernel_launch: cus %d per_cu %d ws %zu (need %zu) n_in %d\n", cus, per_cu, ws_size, (size_t)WS_END, n_in);
    if (ws_size < WS_END || n_in != 23 || per_cu < 1) { fprintf(stderr, "kernel_launch: bad configuration, nothing launched\n"); grid = -1; return; }
    grid = cus;
  }
  if (grid < 0) return;
  (void)hipMemsetAsync((char*)d_ws + WS_CTL, 0, 65536, stream);
  KArgs p{};
  for (int i = 0; i < 23; ++i) p.in[i] = (const float*)d_in[i];
  p.out = (float*)d_out; p.ws = (unsigned char*)d_ws; p.ph_lo = 0; p.ph_hi = 38;
  void* args[] = {&p};
  hipError_t e = hipLaunchCooperativeKernel((const void*)mk_fwd, dim3(grid), dim3(512), args, LDS_BYTES, stream);
  if (e != hipSuccess) fprintf(stderr, "cooperative launch failed: %s (grid %d)\n", hipGetErrorString(e), grid);
}
```

```cpp
#include <hip/hip_runtime.h>
#include <hip/hip_cooperative_groups.h>
#include <cstdio>
#include <cstdint>
namespace cg = cooperative_groups;

constexpr int DM = 1024, NBATCH = 4, SEQ = 8192, CTXL = 256, SEGL = CTXL + SEQ, T = NBATCH * SEGL, DEPTH = 4;
constexpr int IN_W = 3088, PW = 3072;
constexpr int QK8_PITCH = 144; constexpr size_t QK8_IMG = (size_t)16 * SEGL * QK8_PITCH;
constexpr int C_A = 0, C_MQ = 512, C_MK = 768, C_MV = 1024, C_MO = 1280, C_DQ = 1536, C_DK = 2048, C_DV = 2560;
constexpr int NCH = SEGL / 64;
constexpr int NEXP = 16384;
constexpr float EPS = 1e-6f;
#ifndef ABL
#define ABL 0
#endif
#ifndef GATHER_SYNC
#define GATHER_SYNC 0
#endif
#ifndef REP_ATT
#define REP_ATT 1
#endif
#ifndef GP_MASK
#define GP_MASK 0x3FFF
#endif
#ifndef REP_PEER
#define REP_PEER 1
#endif
#ifndef REP_GEMM
#define REP_GEMM 1
#endif
#ifndef REP_ROUTE
#define REP_ROUTE 1
#endif
#ifndef REP_OUTP
#define REP_OUTP 1
#endif
#ifndef REP_ML
#define REP_ML 1
#endif
#ifndef REP_MISC
#define REP_MISC 1
#endif
constexpr float QSCALE = 0.125f * 1.4426950408889634f;

constexpr size_t MiB = 1u << 20;
constexpr size_t WS_CTL = 0, WS_MOD = 1 * MiB, WS_ROPE = 2 * MiB, WS_WG = 4 * MiB, WS_KEYS = 5 * MiB, WS_MLMETA = 6 * MiB,
                 WS_GATES = 7 * MiB, WS_WIN = 10 * MiB, WS_WOUT = 34 * MiB, WS_WQ = 42 * MiB, WS_PU = 50 * MiB, WS_PV = 114 * MiB, WS_PSC = 178 * MiB  ,
                 WS_XCUR = 306 * MiB, WS_H = 438 * MiB, WS_MIX = 504 * MiB, WS_PROJ = 570 * MiB, WS_ULOC = 768 * MiB, WS_V8T = 836 * MiB  , WS_EID = 858 * MiB  , WS_QK8 = 924 * MiB  , WS_END = 964 * MiB;
constexpr int USTRIDE = 4160;

constexpr int LDS_BYTES = 139264 + 512;
constexpr int LDS_WTAB = LDS_BYTES - 64 - 256;

#define LAS __attribute__((address_space(3)))
__device__ __forceinline__ int hw_wave_key() { return (int)(__builtin_amdgcn_s_getreg((5 << 11) | 4) & 63u); }
__device__ __forceinline__ int tidx() {
  extern __shared__ __attribute__((aligned(16))) unsigned char lds_dyn_[];
  const int w = __builtin_amdgcn_readfirstlane(*(const volatile LAS int*)((LAS unsigned char*)lds_dyn_ + LDS_WTAB + 4 * hw_wave_key()));
  unsigned z_ = 0u; asm volatile("" : "+v"(z_));
  return (w << 6) | (int)__builtin_amdgcn_mbcnt_hi(~0u, __builtin_amdgcn_mbcnt_lo(~0u, z_));
}
typedef unsigned short bf16_t;
typedef short bf16x8 __attribute__((ext_vector_type(8)));
typedef short s16x4 __attribute__((ext_vector_type(4)));
typedef float f32x4 __attribute__((ext_vector_type(4)));
typedef float f32x16 __attribute__((ext_vector_type(16)));
typedef unsigned u32x4 __attribute__((ext_vector_type(4)));
typedef unsigned u32x2 __attribute__((ext_vector_type(2)));
typedef __bf16 bf16x2v __attribute__((ext_vector_type(2)));
typedef int i32x8 __attribute__((ext_vector_type(8)));
typedef int i32x6 __attribute__((ext_vector_type(6)));
struct __attribute__((aligned(4))) u32x3 { unsigned x, y, z; };
typedef float f32x32 __attribute__((ext_vector_type(32)));
constexpr int PROW = 768;
typedef float f32x2 __attribute__((ext_vector_type(2)));
typedef _Float16 h16x2 __attribute__((ext_vector_type(2)));
typedef _Float16 h16x32 __attribute__((ext_vector_type(32)));
typedef unsigned u32x3v __attribute__((ext_vector_type(3)));
typedef unsigned u32x2v __attribute__((ext_vector_type(2)));

struct KArgs {
  const float* in[23];
  float* out;
  unsigned char* ws;
  int ph_lo, ph_hi;
};
typedef const float* const __attribute__((address_space(4))) * InTab;
struct Params {
  InTab in;
  float* out;
  unsigned char* ws;
  int ph_lo, ph_hi;
  int bx, gx;
  unsigned* xbar_words; unsigned xbar_x; unsigned lds_st_off;
};
enum { I_X = 0, I_C, I_CTX, I_CCTX, I_ADAW, I_ADAB, I_N1G, I_N2G, I_WIN, I_CONVW, I_CONVB, I_CLNG, I_CLNB, I_GATEB, I_MNORMG, I_DLAM, I_DNORMG,
       I_WOUT, I_PWQ, I_PKEYS, I_PU, I_PV, I_FINALG };

__device__ __forceinline__ unsigned cvtpk(float lo, float hi) { unsigned r; asm volatile("v_cvt_pk_bf16_f32 %0, %1, %2" : "=v"(r) : "v"(lo), "v"(hi)); return r; }
__device__ __forceinline__ float bflo(unsigned u) { return __uint_as_float(u << 16); }
__device__ __forceinline__ float bfhi(unsigned u) { return __uint_as_float(u & 0xffff0000u); }
__device__ __forceinline__ float bf1(bf16_t u) { return __uint_as_float(((unsigned)u) << 16); }
__device__ __forceinline__ int crow(int r, int hi) { return (r & 3) + 8 * (r >> 2) + 4 * hi; }
template <int CTRL> __device__ __forceinline__ float dpp_mov(float v) {
  return __uint_as_float((unsigned)__builtin_amdgcn_update_dpp(0, (int)__float_as_uint(v), CTRL, 0xF, 0xF, true));
}
__device__ __forceinline__ float wave_sum_fast(float x) {
  x += dpp_mov<0xB1>(x); x += dpp_mov<0x4E>(x); x += dpp_mov<0x141>(x); x += dpp_mov<0x140>(x);
  { auto r = __builtin_amdgcn_permlane16_swap(__float_as_uint(x), __float_as_uint(x), false, false); x = __uint_as_float(r[0]) + __uint_as_float(r[1]); }
  { auto r = __builtin_amdgcn_permlane32_swap(__float_as_uint(x), __float_as_uint(x), false, false); x = __uint_as_float(r[0]) + __uint_as_float(r[1]); }
  return x;
}
__device__ __forceinline__ float wave_max_fast(float x) {
  x = fmaxf(x, dpp_mov<0xB1>(x)); x = fmaxf(x, dpp_mov<0x4E>(x)); x = fmaxf(x, dpp_mov<0x141>(x)); x = fmaxf(x, dpp_mov<0x140>(x));
  { auto r = __builtin_amdgcn_permlane16_swap(__float_as_uint(x), __float_as_uint(x), false, false); x = fmaxf(__uint_as_float(r[0]), __uint_as_float(r[1])); }
  { auto r = __builtin_amdgcn_permlane32_swap(__float_as_uint(x), __float_as_uint(x), false, false); x = fmaxf(__uint_as_float(r[0]), __uint_as_float(r[1])); }
  return x;
}
template <int CTRL, int ROWMASK> __device__ __forceinline__ float dpp_mov_rm(float v) {
  return __uint_as_float((unsigned)__builtin_amdgcn_update_dpp(0, (int)__float_as_uint(v), CTRL, ROWMASK, 0xF, true));
}
__device__ __forceinline__ float wave_incl_scan(float x) {
  x += dpp_mov<0x111>(x); x += dpp_mov<0x112>(x); x += dpp_mov<0x114>(x); x += dpp_mov<0x118>(x);
  x += dpp_mov_rm<0x142, 0xA>(x);
  x += dpp_mov_rm<0x143, 0xC>(x);
  return x;
}
__device__ __forceinline__ float wave_sum(float v) { return wave_sum_fast(v); }
__device__ __forceinline__ float sum_xor32(float x) { auto r = __builtin_amdgcn_permlane32_swap(__float_as_uint(x), __float_as_uint(x), false, false); return __uint_as_float(r[0]) + __uint_as_float(r[1]); }
__device__ __forceinline__ float max_xor32(float x) { auto r = __builtin_amdgcn_permlane32_swap(__float_as_uint(x), __float_as_uint(x), false, false); return fmaxf(__uint_as_float(r[0]), __uint_as_float(r[1])); }
__device__ __forceinline__ float wave_max(float v) { return wave_max_fast(v); }
__device__ __forceinline__ float sigmoidf_(float x) { return 1.f / (1.f + __expf(-x)); }
__device__ __forceinline__ float logsigmoidf_(float x) { return fminf(x, 0.f) - log1pf(__expf(-fabsf(x))); }
__device__ __forceinline__ const float* in_row(const float* x, const float* ctx, int row) {
  const int b = row / SEGL, s = row - b * SEGL;
  return s < CTXL ? ctx + ((size_t)(b * CTXL + s)) * DM : x + ((size_t)(b * SEQ + (s - CTXL))) * DM;
}
__device__ __forceinline__ int mod_row(int row) { const int b = row / SEGL, s = row - b * SEGL; return s < CTXL ? 4 : b; }

__device__ __forceinline__ void p0_mod(const Params& p, unsigned char* lds, float* MOD) {
  float* sil = (float*)lds;
  float* red = (float*)(lds + 20480);
  int tid_ = tidx(); asm volatile("" : "+v"(tid_)); const int tid = tid_, lane = tid & 63, wid = tid >> 6;
  for (int i = tid; i < 5 * 1024; i += 512) {
    const float v = i < 4096 ? p.in[I_C][i] : p.in[I_CCTX][i - 4096];
    sil[i] = v / (1.f + __expf(-v));
  }
  __syncthreads();
  for (int item = p.bx; item < DEPTH * 96; item += p.gx) {
    const int l = item / 96, j0 = (item % 96) * 64;
    const float* W = p.in[I_ADAW] + (size_t)l * DM * 6144 + j0 + lane;
    float a0 = 0.f, a1 = 0.f, a2 = 0.f, a3 = 0.f, a4 = 0.f;
    const int k0 = wid * 128;
#pragma unroll 8
    for (int k = k0; k < k0 + 128; ++k) {
      const float w = W[(size_t)k * 6144];
      a0 += sil[k] * w; a1 += sil[1024 + k] * w; a2 += sil[2048 + k] * w; a3 += sil[3072 + k] * w; a4 += sil[4096 + k] * w;
    }
    red[(wid * 5 + 0) * 64 + lane] = a0; red[(wid * 5 + 1) * 64 + lane] = a1; red[(wid * 5 + 2) * 64 + lane] = a2;
    red[(wid * 5 + 3) * 64 + lane] = a3; red[(wid * 5 + 4) * 64 + lane] = a4;
    __syncthreads();
    if (tid < 320) {
      const int r = tid >> 6;
      float s = 0.f;
#pragma unroll
      for (int w = 0; w < 8; ++w) s += red[(w * 5 + r) * 64 + lane];
      MOD[((size_t)l * 5 + r) * 6144 + j0 + lane] = s + p.in[I_ADAB][l * 6144 + j0 + lane];
    }
    __syncthreads();
  }
}
__device__ __forceinline__ void transpose_item(const float* W, int ldw, int srccol0, bf16_t* WT, int K, int n0, int k0, float* scr, int lane) {
#pragma unroll 8
  for (int i = 0; i < 32; ++i) { const int kk = 2 * i + (lane >> 5); scr[kk * 33 + (lane & 31)] = W[(size_t)(k0 + kk) * ldw + srccol0 + (lane & 31)]; }
  asm volatile("s_waitcnt lgkmcnt(0)" ::: "memory");
  const int c = lane & 7;
#pragma unroll
  for (int j = 0; j < 4; ++j) {
    const int n = (lane >> 3) + 8 * j; const float* s = scr + (8 * c) * 33 + n;
    u32x4 o; o.x = cvtpk(s[0], s[33]); o.y = cvtpk(s[66], s[99]); o.z = cvtpk(s[132], s[165]); o.w = cvtpk(s[198], s[231]);
    *(u32x4*)(WT + (size_t)(n0 + n) * K + k0 + 8 * c) = o;
  }
  asm volatile("s_waitcnt lgkmcnt(0)" ::: "memory");
}
__device__ __forceinline__ void convert_tables(const Params& p, int L, int wv, int nw, int lane, int r_lo, int r_hi) {
  unsigned char* PUq = p.ws + WS_PU; unsigned char* PVq = p.ws + WS_PV; float* PSC = (float*)(p.ws + WS_PSC);
  const int nrows = DEPTH * NEXP;
#define TAB_SROW(r_) ((const f32x4*)(((r_) >= NEXP ? p.in[I_PV] : p.in[I_PU]) + (size_t)(L * NEXP + ((r_) >= NEXP ? (r_) - NEXP : (r_))) * DM) + lane * 4)
#define TAB_LOAD(v_, r_) do { if ((r_) < r_hi) { const f32x4* s_ = TAB_SROW(r_); _Pragma("unroll") for (int j = 0; j < 4; ++j) v_[j] = __builtin_nontemporal_load(s_ + j); } } while (0)
  auto encode_row = [&](const f32x4 (&v)[4], int r) {
    const int tb = r >= NEXP, rr = L * NEXP + (tb ? r - NEXP : r);
    float mx = 0.f;
#pragma unroll
    for (int j = 0; j < 4; ++j) mx = fmaxf(mx, fmaxf(fmaxf(fabsf(v[j].x), fabsf(v[j].y)), fmaxf(fabsf(v[j].z), fabsf(v[j].w))));
    mx = wave_max_fast(mx);
    const unsigned mb = __float_as_uint(mx);
    const int eb = (int)((mb >> 23) & 0xFFu);
    int sb = ((mb & 0x7FFFFFu) <= 0x700000u ? 129 : 128) - eb + 127; sb = sb < 1 ? 1 : (sb > 253 ? 253 : sb);
    const float sc = __uint_as_float((unsigned)sb << 23), isc = __uint_as_float((unsigned)(254 - sb) << 23);
    const float xv[16] = {v[0].x, v[0].y, v[0].z, v[0].w, v[1].x, v[1].y, v[1].z, v[1].w, v[2].x, v[2].y, v[2].z, v[2].w, v[3].x, v[3].y, v[3].z, v[3].w};
    unsigned wq[3] = {0u, 0u, 0u};
#pragma unroll
    for (int i = 0; i < 16; ++i) {
      const float a = fabsf(xv[i]) * sc;
      unsigned code = a < 2.f ? (unsigned)__builtin_rintf(a * 8.f) : (a < 4.f ? 8u + (unsigned)__builtin_rintf(a * 4.f) : 16u + (unsigned)__builtin_rintf(a * 2.f));
      code = code > 31u ? 31u : code;
      code |= (xv[i] < 0.f) ? 32u : 0u;
      const int bp = 6 * i, dw = bp >> 5, off = bp & 31;
      wq[dw] |= code << off;
      if (off > 26) wq[dw + 1] |= code >> (32 - off);
    }
    u32x3 o; o.x = wq[0]; o.y = wq[1]; o.z = wq[2];
    *(u32x3*)((tb ? PVq : PUq) + (size_t)rr * PROW + lane * 12) = o;
    if (lane == 0) PSC[(size_t)tb * nrows + rr] = isc;
  };
  f32x4 v0[4], v1[4], v2[4];
  TAB_LOAD(v0, r_lo + wv); TAB_LOAD(v1, r_lo + wv + nw);
#pragma unroll 1
  for (int r = r_lo + wv; r < r_hi; r += 3 * nw) {
    TAB_LOAD(v2, r + 2 * nw); encode_row(v0, r);
    if (r + nw < r_hi) { TAB_LOAD(v0, r + 3 * nw); encode_row(v1, r + nw); }
    if (r + 2 * nw < r_hi) { TAB_LOAD(v1, r + 4 * nw); encode_row(v2, r + 2 * nw); }
  }
#undef TAB_LOAD
#undef TAB_SROW
}
__device__ __forceinline__ void tail_filler_tables(const Params& p, int L, int nwg, int r_lo, int r_hi) {
  int tid_ = tidx(); asm volatile("" : "+v"(tid_)); const int lane = tid_ & 63, wid = tid_ >> 6;
  const int nextra = nwg % p.gx, first = nextra, nidle = p.gx - nextra;
  if (p.bx < first) return;
  convert_tables(p, L, (p.bx - first) * 8 + wid, nidle * 8, lane, r_lo, r_hi);
}
__device__ __forceinline__ void p0_convert(const Params& p, unsigned char* lds) {
  int tid_ = tidx(); asm volatile("" : "+v"(tid_)); const int tid = tid_, lane = tid & 63, wid = tid >> 6;
  const int gw = p.bx * 8 + wid, NGW = p.gx * 8;
  const size_t gt = (size_t)p.bx * 512 + tid, NGT = (size_t)p.gx * 512;
  float* scr = (float*)(lds + 32768) + wid * (64 * 33);
  bf16_t* WIN = (bf16_t*)(p.ws + WS_WIN); bf16_t* WOUT = (bf16_t*)(p.ws + WS_WOUT); bf16_t* WQ = (bf16_t*)(p.ws + WS_WQ);
  constexpr int I_IN = 16 * 96, I_O = 16 * 32, PER_L = I_IN + 2 * I_O;
  for (int it = gw; it < DEPTH * PER_L; it += NGW) {
    const int l = it / PER_L; int r = it % PER_L;
    if (r < I_IN) { const int kb = r / 96, nb = r % 96, n0 = nb * 32; const int src = n0 < 1536 ? n0 : n0 + 16;
      transpose_item(p.in[I_WIN] + (size_t)l * DM * IN_W, IN_W, src, WIN + (size_t)l * PW * DM, DM, n0, kb * 64, scr, lane); continue; }
    r -= I_IN;
    if (r < I_O) { const int kb = r / 32, nb = r % 32;
      transpose_item(p.in[I_WOUT] + (size_t)l * DM * DM, DM, nb * 32, WOUT + (size_t)l * DM * DM, DM, nb * 32, kb * 64, scr, lane); continue; }
    r -= I_O;
    { const int kb = r / 32, nb = r % 32;
      transpose_item(p.in[I_PWQ] + (size_t)l * DM * DM, DM, nb * 32, WQ + (size_t)l * DM * DM, DM, nb * 32, kb * 64, scr, lane); }
  }
  bf16_t* WG = (bf16_t*)(p.ws + WS_WG);
  for (size_t i = gt; i < (size_t)DEPTH * 16 * DM; i += NGT) {
    const int l = (int)(i / (16 * DM)), g = (int)((i / DM) % 16), k = (int)(i % DM);
    WG[i] = (bf16_t)(cvtpk(p.in[I_WIN][(size_t)l * DM * IN_W + (size_t)k * IN_W + 1536 + g], 0.f) & 0xffffu);
  }
  bf16_t* KEYS = (bf16_t*)(p.ws + WS_KEYS);
  for (size_t i = gt; i < (size_t)DEPTH * 131072 / 8; i += NGT) {
    const f32x4 a = ((const f32x4*)p.in[I_PKEYS])[2 * i], b = ((const f32x4*)p.in[I_PKEYS])[2 * i + 1];
    u32x4 o; o.x = cvtpk(a.x, a.y); o.y = cvtpk(a.z, a.w); o.z = cvtpk(b.x, b.y); o.w = cvtpk(b.z, b.w);
    ((u32x4*)KEYS)[i] = o;
  }
  {
    float* RC = (float*)(p.ws + WS_ROPE); float* RS = RC + SEQ * 32;
    for (size_t i = gt; i < (size_t)SEQ * 32; i += NGT) {
      const int pos = (int)(i >> 5), j = (int)(i & 31);
      const int rr = pos >> 6, cc = pos & 63;
      const int jj = j & 15;
      const double e = -(double)jj * 0.83048202372184058696;
      const double fl = __builtin_floor(e); const double f = e - fl;
      const double z = f * 0.69314718055994530942;
      double ez = 1.0 + z * (1.0 + z * (0.5 + z * (1.0 / 6 + z * (1.0 / 24 + z * (1.0 / 120 + z * (1.0 / 720 + z * (1.0 / 5040 + z * (1.0 / 40320 + z * (1.0 / 362880 + z * (1.0 / 3628800 + z * (1.0 / 39916800 + z * (1.0 / 479001600))))))))))));
      const double inv = __builtin_ldexp(ez, (int)fl);
      const float invf = (float)inv;
      const float angf = (float)(j < 16 ? rr : cc) * invf;
      const double ang = (double)angf;
      const double kq = __builtin_rint(ang * 0.63661977236758134308);
      double r = __builtin_fma(-kq, 1.57079632679489655800e+00, ang);
      r = __builtin_fma(-kq, 6.12323399573676603587e-17, r);
      const double r2 = r * r;
      const double sn = r * (1.0 + r2 * (-1.0 / 6 + r2 * (1.0 / 120 + r2 * (-1.0 / 5040 + r2 * (1.0 / 362880 + r2 * (-1.0 / 39916800 + r2 * (1.0 / 6227020800.0)))))));
      const double cs = 1.0 + r2 * (-0.5 + r2 * (1.0 / 24 + r2 * (-1.0 / 720 + r2 * (1.0 / 40320 + r2 * (-1.0 / 3628800 + r2 * (1.0 / 479001600 + r2 * (-1.0 / 87178291200.0)))))));
      const int q = ((int)kq) & 3;
      double co, si;
      if (q == 0) { co = cs; si = sn; } else if (q == 1) { co = -sn; si = cs; } else if (q == 2) { co = -cs; si = -sn; } else { co = sn; si = -cs; }
      RC[i] = (float)co; RS[i] = (float)si;
    }
  }
}

__device__ __forceinline__ void norm_mod_row(const float* xrow, const float* g, const float* sc, const float* sh, bf16_t* orow, int lane) {
  const f32x4* xr = (const f32x4*)xrow + lane;
  f32x4 v[4]; float s = 0.f;
#pragma unroll
  for (int j = 0; j < 4; ++j) { v[j] = xr[64 * j]; s += (v[j].x * v[j].x + v[j].y * v[j].y) + (v[j].z * v[j].z + v[j].w * v[j].w); }
  const float rs = rsqrtf(wave_sum(s) * (1.f / DM) + EPS);
  u32x2* o = (u32x2*)orow + lane;
#pragma unroll
  for (int j = 0; j < 4; ++j) {
    const f32x4 gg = ((const f32x4*)g)[lane + 64 * j], cc = ((const f32x4*)sc)[lane + 64 * j], hh = ((const f32x4*)sh)[lane + 64 * j];
    const float y0 = v[j].x * rs * gg.x * (1.f + cc.x) + hh.x, y1 = v[j].y * rs * gg.y * (1.f + cc.y) + hh.y;
    const float y2 = v[j].z * rs * gg.z * (1.f + cc.z) + hh.z, y3 = v[j].w * rs * gg.w * (1.f + cc.w) + hh.w;
    u32x2 w; w.x = cvtpk(y0, y1); w.y = cvtpk(y2, y3);
    o[64 * j] = w;
  }
}
__device__ __forceinline__ void phase_norm(const Params& p, int l, int which, bool from_input, bool skip_ctx) {
  int tid_ = tidx(); asm volatile("" : "+v"(tid_));
  const int lane = tid_ & 63, wid = tid_ >> 6;
  const int gw = p.bx * 8 + wid, NGW = p.gx * 8;
  const float* MOD = (const float*)(p.ws + WS_MOD);
  const float* XC = (const float*)(p.ws + WS_XCUR);
  bf16_t* H = (bf16_t*)(p.ws + WS_H);
  const float* g = p.in[which ? I_N2G : I_N1G] + l * DM;
  for (int row = gw; row < T; row += NGW) {
    const int mr = mod_row(row);
    if (skip_ctx && mr == 4) continue;
    const float* m = MOD + ((size_t)l * 5 + mr) * 6144 + which * 3072;
    const float* xr = from_input ? in_row(p.in[I_X], p.in[I_CTX], row) : XC + (size_t)row * DM;
    norm_mod_row(xr, g, m + 1024, m, H + (size_t)row * DM, lane);
  }
}

namespace pg8 {
#define PG8_LAS __attribute__((address_space(3)))
typedef unsigned short bf16_t;
typedef short bf16x8 __attribute__((ext_vector_type(8)));
typedef float f32x4 __attribute__((ext_vector_type(4)));
typedef unsigned u32x4 __attribute__((ext_vector_type(4)));
constexpr int BM = 256, BK = 64, HALF = 128, HTB = HALF * BK * 2  , STAGE_BYTES = 8 * HTB, NXCD = 8, WGM = 8;

__host__ __device__ __forceinline__ int lds_byte(int r, int c) { const int st = (r >> 4) * 2 + (c >> 5), rr = r & 15, cc = c & 31, ob = rr * 64 + cc * 2; return st * 1024 + (ob ^ (((ob >> 9) & 1) << 5)); }
__host__ __device__ __forceinline__ void stage_rc(int b, int& R, int& C) { const int st = b / 1024, sb = b % 1024, swz = sb ^ (((sb >> 9) & 1) << 5); R = (st >> 1) * 16 + swz / 64; C = (st & 1) * 32 + (swz % 64) / 2; }
__host__ __device__ __forceinline__ int perm32(int rho) { const int n = rho >> 4, i = rho & 15; return 8 * (i >> 2) + 4 * n + (i & 3); }

struct Unit { int pm, pn; };
struct Gemm { const bf16_t* A; const bf16_t* Bt; int M, N, K; };

struct StaticOrder {
    int nM, nN, nwg, G, c;
    __host__ __device__ void init(int M, int N, int G_, int c_) { nM = M / BM; nN = N / BM; nwg = nM * nN; G = G_; c = c_; }
    __host__ __device__ bool next(int i, Unit& u) const {
        const long L = (long)i * G + c; if (L >= nwg) return false;
        int wgid = (int)L; { const int q = nwg / NXCD, r = nwg % NXCD, xcd = wgid % NXCD, off = wgid / NXCD; wgid = (xcd < r ? xcd * (q + 1) : r * (q + 1) + (xcd - r) * q) + off; }
        const int nig = WGM * nN, gid = wgid / nig, fm = gid * WGM, gsz = (nM - fm) < WGM ? (nM - fm) : WGM;
        u.pm = fm + ((wgid % nig) % gsz); u.pn = (wgid % nig) / gsz; return true;
    }
    __device__ __forceinline__ void a_ready(const Unit&) const {}
    __device__ __forceinline__ void done(const Unit&) const {}
};
__device__ __forceinline__ unsigned cvt_pk_bf16(float lo, float hi) { unsigned r; asm volatile("v_cvt_pk_bf16_f32 %0, %1, %2" : "=v"(r) : "v"(lo), "v"(hi)); return r; }
template <class Epi, class Sched, bool ALIGN_EPI = false, bool SP2 = false>
__device__ __forceinline__ void gemm_phase(PG8_LAS unsigned char* lds, const Gemm g, const Sched& S, const Epi& E) {
    const int tid = tidx(), wid = __builtin_amdgcn_readfirstlane(tid >> 6), lane = tid & 63, wr = wid >> 2, wc = wid & 3, fr = lane & 15, fq = lane >> 4;
    const int K = g.K, nt = K / BK;
    unsigned voffA[2], voffB[2];
#pragma unroll
    for (int i = 0; i < 2; ++i) { int R, C; stage_rc(tid * 16 + i * 8192, R, C); const int Rb = Epi::PERM ? ((R & ~31) + perm32(R & 31)) : R;
        voffA[i] = (unsigned)(R * K + C) * 2u; voffB[i] = (unsigned)(Rb * K + C) * 2u; }
    const size_t kstep = (size_t)(BK * 2);
    const size_t hstep = (size_t)HALF * K * 2;
    const size_t tstep = 2 * hstep;
    const unsigned ldsw = (unsigned)wid * 1024u;
    const int aoff = lds_byte(wr * 64 + fr, fq * 8), boff = lds_byte(wc * 32 + fr, fq * 8);
#define PG8_SA(b, h) (((b) * 2 + (h)) * HTB)
#define PG8_SB(b, h) ((4 + (b) * 2 + (h)) * HTB)
#define PG8_STAGE(bufoff, gbase, voff) do { _Pragma("unroll") for (int _i = 0; _i < 2; ++_i) \
        __builtin_amdgcn_global_load_lds((const unsigned*)((const char*)(gbase) + (voff)[_i]), (PG8_LAS unsigned*)(lds + (bufoff) + ldsw + _i * 8192), 16, 0, 0); } while (0)
#define PG8_LDA(dst, b, h) do { _Pragma("unroll") for (int m = 0; m < 4; ++m) _Pragma("unroll") for (int k = 0; k < 2; ++k) dst[m][k] = *(const PG8_LAS bf16x8*)(lds + PG8_SA(b, h) + aoff + m * 2048 + k * 1024); } while (0)
#define PG8_LDB(dst, b, h) do { _Pragma("unroll") for (int n = 0; n < 2; ++n) _Pragma("unroll") for (int k = 0; k < 2; ++k) dst[n][k] = *(const PG8_LAS bf16x8*)(lds + PG8_SB(b, h) + boff + n * 2048 + k * 1024); } while (0)
#define PG8_MMA(ai, bj, At, Bt) do { __builtin_amdgcn_s_setprio(1); _Pragma("unroll") for (int m = 0; m < 4; ++m) _Pragma("unroll") for (int n = 0; n < 2; ++n) _Pragma("unroll") for (int k = 0; k < 2; ++k) \
        acc[ai][bj][m][n] = __builtin_amdgcn_mfma_f32_16x16x32_bf16(Bt[n][k], At[m][k], acc[ai][bj][m][n], 0, 0, 0); __builtin_amdgcn_s_setprio(0); } while (0)
#define PG8_WAIT_V(n) asm volatile("s_waitcnt vmcnt(" #n ")" ::: "memory")
#define PG8_WAIT_L(n) asm volatile("s_waitcnt lgkmcnt(" #n ")" ::: "memory")
#define PG8_BAR __builtin_amdgcn_s_barrier()
#define PG8_SCHED __builtin_amdgcn_sched_barrier(0)
    Unit cur, nxt; int ui = 0;
    if (!S.next(0, cur)) return;
    f32x4 acc[2][2][4][2];
#pragma unroll
    for (int a = 0; a < 2; ++a)
#pragma unroll
        for (int b = 0; b < 2; ++b)
#pragma unroll
            for (int m = 0; m < 4; ++m)
#pragma unroll
                for (int n = 0; n < 2; ++n) acc[a][b][m][n] = (f32x4){0.f, 0.f, 0.f, 0.f};
    bf16x8 At[4][2], B0[2][2], B1[2][2];
    const char* cA = (const char*)g.A + (size_t)cur.pm * tstep; const char* cB = (const char*)g.Bt + (size_t)cur.pn * tstep;
    S.a_ready(cur);
    if constexpr (SP2) {
        PG8_STAGE(PG8_SB(0, 0), cB, voffB); PG8_STAGE(PG8_SB(0, 1), cB + hstep, voffB); PG8_STAGE(PG8_SA(0, 0), cA, voffA); PG8_STAGE(PG8_SA(0, 1), cA + hstep, voffA);
        if (wr == 1) PG8_BAR;
        PG8_WAIT_V(2); PG8_BAR;
        PG8_STAGE(PG8_SB(1, 0), cB + kstep, voffB); PG8_STAGE(PG8_SA(1, 0), cA + kstep, voffA); PG8_STAGE(PG8_SB(1, 1), cB + hstep + kstep, voffB);
        PG8_WAIT_V(6); PG8_BAR;
    } else {
        PG8_STAGE(PG8_SB(0, 0), cB, voffB); PG8_STAGE(PG8_SA(0, 0), cA, voffA); PG8_STAGE(PG8_SB(0, 1), cB + hstep, voffB); PG8_STAGE(PG8_SA(0, 1), cA + hstep, voffA);
        if (wr == 1) PG8_BAR;
        PG8_WAIT_V(4); PG8_BAR;
        PG8_STAGE(PG8_SB(1, 0), cB + kstep, voffB); PG8_STAGE(PG8_SA(1, 0), cA + kstep, voffA); PG8_STAGE(PG8_SB(1, 1), cB + hstep + kstep, voffB);
        PG8_WAIT_V(6); PG8_BAR;
    }
    for (;;) {
        const bool has_next = S.next(ui + 1, nxt);
        const char* nA = has_next ? (const char*)g.A + (size_t)nxt.pm * tstep : cA; const char* nB = has_next ? (const char*)g.Bt + (size_t)nxt.pn * tstep : cB;
        for (int t = 0; t < nt; t += 2) {
            const bool last = (t == nt - 2);
            const char* a1 = cA + (size_t)(t + 1) * kstep;
            const char* a2 = last ? nA : cA + (size_t)(t + 2) * kstep; const char* b2 = last ? nB : cB + (size_t)(t + 2) * kstep;
            const char* a3 = a2 + kstep; const char* b3 = b2 + kstep;
            if (last && has_next) S.a_ready(nxt);
            if constexpr (SP2) {
            PG8_LDB(B0, 0, 0); PG8_LDB(B1, 0, 1); PG8_SCHED; PG8_LDA(At, 0, 0); PG8_STAGE(PG8_SA(1, 1), a1 + hstep, voffA);
            PG8_WAIT_V(8); PG8_WAIT_L(0); PG8_BAR; PG8_MMA(0, 0, At, B0); PG8_MMA(0, 1, At, B1); PG8_BAR; PG8_SCHED;
            PG8_LDA(At, 0, 1); PG8_STAGE(PG8_SB(0, 0), b2, voffB); PG8_STAGE(PG8_SB(0, 1), b2 + hstep, voffB); PG8_STAGE(PG8_SA(0, 0), a2, voffA);
            PG8_WAIT_V(8); PG8_WAIT_L(0); PG8_BAR; PG8_MMA(1, 0, At, B0); PG8_MMA(1, 1, At, B1); PG8_BAR; PG8_SCHED;
            PG8_LDB(B0, 1, 0); PG8_LDB(B1, 1, 1); PG8_SCHED; PG8_LDA(At, 1, 0); PG8_STAGE(PG8_SA(0, 1), a2 + hstep, voffA);
            PG8_WAIT_V(8); PG8_WAIT_L(0); PG8_BAR; PG8_MMA(0, 0, At, B0); PG8_MMA(0, 1, At, B1); PG8_BAR; PG8_SCHED;
            PG8_LDA(At, 1, 1); PG8_STAGE(PG8_SB(1, 0), b3, voffB); PG8_STAGE(PG8_SB(1, 1), b3 + hstep, voffB); PG8_STAGE(PG8_SA(1, 0), a3, voffA);
            PG8_WAIT_V(8); PG8_WAIT_L(0); PG8_BAR; PG8_MMA(1, 0, At, B0); PG8_MMA(1, 1, At, B1); PG8_BAR; PG8_SCHED;
            } else {
            PG8_LDB(B0, 0, 0); PG8_SCHED; PG8_LDA(At, 0, 0); PG8_STAGE(PG8_SA(1, 1), a1 + hstep, voffA);
            PG8_WAIT_L(8); PG8_BAR; PG8_WAIT_L(0); PG8_MMA(0, 0, At, B0); PG8_BAR; PG8_SCHED;
            PG8_LDB(B1, 0, 1); PG8_STAGE(PG8_SB(0, 0), b2, voffB);
            PG8_BAR; PG8_WAIT_L(0); PG8_MMA(0, 1, At, B1); PG8_BAR;
            PG8_LDA(At, 0, 1); PG8_STAGE(PG8_SA(0, 0), a2, voffA);
            PG8_BAR; PG8_WAIT_L(0); PG8_MMA(1, 0, At, B0); PG8_BAR; PG8_SCHED;
            PG8_STAGE(PG8_SB(0, 1), b2 + hstep, voffB);
            PG8_WAIT_V(6); PG8_BAR; PG8_MMA(1, 1, At, B1); PG8_BAR;
            PG8_LDB(B0, 1, 0); PG8_SCHED; PG8_LDA(At, 1, 0); PG8_STAGE(PG8_SA(0, 1), a2 + hstep, voffA);
            PG8_WAIT_L(8); PG8_BAR; PG8_WAIT_L(0); PG8_MMA(0, 0, At, B0); PG8_BAR; PG8_SCHED;
            PG8_LDB(B1, 1, 1); PG8_STAGE(PG8_SB(1, 0), b3, voffB);
            PG8_BAR; PG8_WAIT_L(0); PG8_MMA(0, 1, At, B1); PG8_BAR;
            PG8_LDA(At, 1, 1); PG8_STAGE(PG8_SA(1, 0), a3, voffA);
            PG8_BAR; PG8_WAIT_L(0); PG8_MMA(1, 0, At, B0); PG8_BAR; PG8_SCHED;
            PG8_STAGE(PG8_SB(1, 1), b3 + hstep, voffB);
            PG8_WAIT_V(6); PG8_BAR; PG8_MMA(1, 1, At, B1); PG8_BAR;
            }
        }
        if constexpr (ALIGN_EPI) { if (wr == 0) PG8_BAR; }
        if constexpr (!Epi::AFTER_DRAIN) { E(acc, cur, wr, wc, fr, fq); S.done(cur); }
        if (!has_next) break;
#pragma unroll
        for (int a = 0; a < 2; ++a)
#pragma unroll
            for (int b = 0; b < 2; ++b)
#pragma unroll
                for (int m = 0; m < 4; ++m)
#pragma unroll
                    for (int n = 0; n < 2; ++n) acc[a][b][m][n] = (f32x4){0.f, 0.f, 0.f, 0.f};
        cur = nxt; cA = nA; cB = nB; ++ui;
        if constexpr (ALIGN_EPI) { if (wr == 1) PG8_BAR; }
    }
    PG8_WAIT_V(0);
    if constexpr (!ALIGN_EPI) { if (wr == 0) PG8_BAR; }
    PG8_BAR;
    if constexpr (Epi::AFTER_DRAIN) { E.fused(acc, cur, wr, wc, fr, fq, lds, wid, lane); S.done(cur); }
#undef PG8_SA
#undef PG8_SB
#undef PG8_STAGE
#undef PG8_LDA
#undef PG8_LDB
#undef PG8_MMA
#undef PG8_WAIT_V
#undef PG8_WAIT_L
#undef PG8_BAR
#undef PG8_SCHED
}
}

__device__ __forceinline__ int gswz(int row, int chunk) { return row * 128 + ((chunk ^ ((row >> 1) & 7)) << 4); }
__device__ __forceinline__ void gemm_tile(const bf16_t* __restrict__ A, int lda, const bf16_t* __restrict__ Bt, int ldb, int K,
                                          int row0, int col0, unsigned char* lds, f32x16 (&acc)[2][2]) {
  int tid_ = tidx(); asm volatile("" : "+v"(tid_)); const int tid = tid_, lane = tid & 63, wid = tid >> 6, wm = wid >> 1, wn = wid & 1, r32 = lane & 31, hi = lane >> 5;
  unsigned char* As = lds; unsigned char* Bs = lds + 65536;
#pragma unroll
  for (int i = 0; i < 2; ++i)
#pragma unroll
    for (int j = 0; j < 2; ++j) acc[i][j] = f32x16{};
  const int lrow = tid >> 3, lc = tid & 7;
  const bf16_t* Ag = A + (size_t)(row0 + lrow) * lda + lc * 8;
  const bf16_t* Bg = Bt + (size_t)(col0 + lrow) * ldb + lc * 8;
  u32x4 ra[4], rb[2];
#pragma unroll
  for (int i = 0; i < 4; ++i) ra[i] = *(const u32x4*)(Ag + (size_t)(64 * i) * lda);
#pragma unroll
  for (int i = 0; i < 2; ++i) rb[i] = *(const u32x4*)(Bg + (size_t)(64 * i) * ldb);
#pragma unroll
  for (int i = 0; i < 4; ++i) *(u32x4*)(As + gswz(lrow + 64 * i, lc)) = ra[i];
#pragma unroll
  for (int i = 0; i < 2; ++i) *(u32x4*)(Bs + gswz(lrow + 64 * i, lc)) = rb[i];
  __syncthreads();
  const int nk = K / 64;
  for (int kt = 0; kt < nk; ++kt) {
    const int cur = kt & 1;
    if (kt + 1 < nk) {
#pragma unroll
      for (int i = 0; i < 4; ++i) ra[i] = *(const u32x4*)(Ag + (size_t)(64 * i) * lda + (kt + 1) * 64);
#pragma unroll
      for (int i = 0; i < 2; ++i) rb[i] = *(const u32x4*)(Bg + (size_t)(64 * i) * ldb + (kt + 1) * 64);
    }
    const unsigned char* Ac = As + cur * 32768; const unsigned char* Bc = Bs + cur * 16384;
#pragma unroll
    for (int kk = 0; kk < 4; ++kk) {
      bf16x8 af[2], bfr[2];
#pragma unroll
      for (int i = 0; i < 2; ++i) af[i] = *(const bf16x8*)(Ac + gswz(wm * 64 + i * 32 + r32, 2 * kk + hi));
#pragma unroll
      for (int j = 0; j < 2; ++j) bfr[j] = *(const bf16x8*)(Bc + gswz(wn * 64 + j * 32 + r32, 2 * kk + hi));
#pragma unroll
      for (int i = 0; i < 2; ++i)
#pragma unroll
        for (int j = 0; j < 2; ++j) acc[i][j] = __builtin_amdgcn_mfma_f32_32x32x16_bf16(af[i], bfr[j], acc[i][j], 0, 0, 0);
    }
    if (kt + 1 < nk) {
      unsigned char* An = As + (cur ^ 1) * 32768; unsigned char* Bn = Bs + (cur ^ 1) * 16384;
#pragma unroll
      for (int i = 0; i < 4; ++i) *(u32x4*)(An + gswz(lrow + 64 * i, lc)) = ra[i];
#pragma unroll
      for (int i = 0; i < 2; ++i) *(u32x4*)(Bn + gswz(lrow + 64 * i, lc)) = rb[i];
    }
    __syncthreads();
  }
}
__device__ __forceinline__ void pair_xchg(float v0, float v1, int lane, float& lo, float& hi2) {
  const bool odd = lane & 1;
  const float send = odd ? v0 : v1;
  const float recv = dpp_mov<0xB1>(send);
  lo = odd ? recv : v0; hi2 = odd ? v1 : recv;
}

__device__ __forceinline__ void phase_inproj(const Params& p, int l, unsigned char* lds) {
  int tid_ = tidx(); asm volatile("" : "+v"(tid_)); const int tid = tid_, lane = tid & 63, wid = tid >> 6, wm = wid >> 1, wn = wid & 1, r32 = lane & 31, hi = lane >> 5;
  const bf16_t* H = (const bf16_t*)(p.ws + WS_H);
  const bf16_t* W = (const bf16_t*)(p.ws + WS_WIN) + (size_t)l * PW * DM;
  bf16_t* PROJ = (bf16_t*)(p.ws + WS_PROJ);
  const float* RC = (const float*)(p.ws + WS_ROPE); const float* RS = RC + SEQ * 32;
  constexpr int NM = T / 256, NN = PW / 128, NU = NM * NN;
  for (int u = p.bx; u < NU + NM; u += p.gx) {
    if (u < NU) {
      const int pn = u / NM, pm = u % NM;
      const int row0 = pm * 256, col0 = pn * 128;
      f32x16 acc[2][2];
      gemm_tile(H, DM, W, DM, DM, row0, col0, lds, acc);
      const bool rope = (col0 >= C_DQ && col0 < C_DV);
      const float scl = (col0 >= C_MK && col0 < C_MV) ? 0.125f : ((col0 >= C_DQ && col0 < C_DK) ? QSCALE : 1.f);
#pragma unroll
      for (int i = 0; i < 2; ++i)
#pragma unroll
        for (int j = 0; j < 2; ++j)
#pragma unroll
          for (int q = 0; q < 8; ++q) {
            float lo, hi2; pair_xchg(acc[i][j][2 * q], acc[i][j][2 * q + 1], lane, lo, hi2);
            const int row = row0 + wm * 64 + i * 32 + crow(2 * q, hi) + (lane & 1);
            const int col = col0 + wn * 64 + j * 32 + (r32 & ~1);
            if (rope) {
              const int s = row % SEGL;
              if (s >= CTXL) {
                const int idx = (s - CTXL) * 32 + ((col & 63) >> 1);
                const float c = RC[idx], sn = RS[idx];
                const float t1 = lo, t2 = hi2; lo = t1 * c - t2 * sn; hi2 = t1 * sn + t2 * c;
              }
            }
            *(unsigned*)(PROJ + (size_t)row * PW + col) = cvtpk(lo * scl, hi2 * scl);
          }
    } else {
      const int pm = u - NU, rowb = pm * 256 + wid * 32;
      const bf16_t* WG = (const bf16_t*)(p.ws + WS_WG) + (size_t)l * 16 * DM;
      float* GT = (float*)(p.ws + WS_GATES);
      const int r16 = lane & 15, q4 = lane >> 4;
      f32x4 c0 = {0.f, 0.f, 0.f, 0.f}, c1 = {0.f, 0.f, 0.f, 0.f};
      const bf16_t* a0p = H + (size_t)(rowb + r16) * DM + q4 * 8;
      const bf16_t* a1p = a0p + (size_t)16 * DM;
      const bf16_t* bp = WG + (size_t)r16 * DM + q4 * 8;
#pragma unroll 4
      for (int ks = 0; ks < 32; ++ks) {
        const bf16x8 a0 = *(const bf16x8*)(a0p + ks * 32), a1 = *(const bf16x8*)(a1p + ks * 32), b = *(const bf16x8*)(bp + ks * 32);
        c0 = __builtin_amdgcn_mfma_f32_16x16x32_bf16(a0, b, c0, 0, 0, 0);
        c1 = __builtin_amdgcn_mfma_f32_16x16x32_bf16(a1, b, c1, 0, 0, 0);
      }
      const float gb = p.in[I_GATEB][l * 16 + r16];
#pragma unroll
      for (int j = 0; j < 4; ++j) {
        GT[(size_t)(rowb + q4 * 4 + j) * 16 + r16] = c0[j] + gb;
        GT[(size_t)(rowb + 16 + q4 * 4 + j) * 16 + r16] = c1[j] + gb;
      }
    }
  }
}

__device__ __forceinline__ void phase_outproj(const Params& p, int l, unsigned char* lds) {
  int tid_ = tidx(); asm volatile("" : "+v"(tid_)); const int tid = tid_, lane = tid & 63, wid = tid >> 6, wm = wid >> 1, wn = wid & 1, r32 = lane & 31, hi = lane >> 5;
  const bf16_t* MIX = (const bf16_t*)(p.ws + WS_MIX);
  const bf16_t* W = (const bf16_t*)(p.ws + WS_WOUT) + (size_t)l * DM * DM;
  float* XC = (float*)(p.ws + WS_XCUR);
  const float* MOD = (const float*)(p.ws + WS_MOD);
  constexpr int NM = T / 256, NN = DM / 128, NU = NM * NN;
  for (int u = p.bx; u < NU; u += p.gx) {
    const int pm = u / NN, pn = u % NN;
    if (l == DEPTH - 1 && (pm % 33) == 0) continue;
    const int row0 = pm * 256, col0 = pn * 128;
    for (int rep = 0; rep < REP_OUTP; ++rep) {
    f32x16 acc[2][2];
    gemm_tile(MIX, DM, W, DM, DM, row0, col0, lds, acc);
    const int mr = (pm % 33) == 0 ? 4 : pm / 33;
    const float* g1 = MOD + ((size_t)l * 5 + mr) * 6144 + 2048;
#pragma unroll
    for (int i = 0; i < 2; ++i)
#pragma unroll
      for (int j = 0; j < 2; ++j) {
        const int col = col0 + wn * 64 + j * 32 + r32;
        const float gg = (rep == REP_OUTP - 1) ? g1[col] : 0.f;
#pragma unroll
        for (int r = 0; r < 16; ++r) {
          const int row = row0 + wm * 64 + i * 32 + crow(r, hi);
          const float xo = (l == 0) ? in_row(p.in[I_X], p.in[I_CTX], row)[col] : XC[(size_t)row * DM + col];
          XC[(size_t)row * DM + col] = xo + gg * acc[i][j][r];
        }
      }
    }
  }
}
__device__ __forceinline__ void phase_peerq(const Params& p, int l, unsigned char* lds) {
  int tid_ = tidx(); asm volatile("" : "+v"(tid_)); const int tid = tid_, lane = tid & 63, wid = tid >> 6, wm = wid >> 1, wn = wid & 1, r32 = lane & 31, hi = lane >> 5;
  const bf16_t* H = (const bf16_t*)(p.ws + WS_H);
  const bf16_t* W = (const bf16_t*)(p.ws + WS_WQ) + (size_t)l * DM * DM;
  bf16_t* QP = (bf16_t*)(p.ws + WS_PROJ);
  constexpr int NM = T / 256, NN = DM / 128, NU = NM * NN;
  for (int u = p.bx; u < NU; u += p.gx) {
    const int pm = u / NN, pn = u % NN;
    if (l == DEPTH - 1 && (pm % 33) == 0) continue;
    const int row0 = pm * 256, col0 = pn * 128;
    f32x16 acc[2][2];
    gemm_tile(H, DM, W, DM, DM, row0, col0, lds, acc);
#pragma unroll
    for (int i = 0; i < 2; ++i)
#pragma unroll
      for (int j = 0; j < 2; ++j)
#pragma unroll
        for (int q = 0; q < 8; ++q) {
          float lo, hi2; pair_xchg(acc[i][j][2 * q], acc[i][j][2 * q + 1], lane, lo, hi2);
          const int row = row0 + wm * 64 + i * 32 + crow(2 * q, hi) + (lane & 1);
          const int col = col0 + wn * 64 + j * 32 + (r32 & ~1);
          *(unsigned*)(QP + (size_t)row * DM + col) = cvtpk(lo, hi2);
        }
  }
}


struct EpiInproj {
  static constexpr bool PERM = true, AFTER_DRAIN = false;
  bf16_t* PROJ; const float* RC; const float* RS; unsigned char* V8T;
  __device__ __forceinline__ void operator()(const pg8::f32x4 (&acc)[2][2][4][2], const pg8::Unit& u, int wr, int wc, int fr, int fq) const {
#pragma unroll
    for (int bj = 0; bj < 2; ++bj) {
      const int colt = u.pn * 256 + bj * 128;
      const bool rope = (colt >= C_DQ && colt < C_DV);
      const float scl = (colt >= C_MK && colt < C_MV) ? 0.125f : ((colt >= C_DQ && colt < C_DK) ? QSCALE : 1.f);
      const int col8 = colt + wc * 32 + 8 * fq;
      if (colt >= C_DV) {
        const int hh = (col8 - C_DV) >> 7, e0 = (col8 - C_DV) & 127;
#pragma unroll
        for (int ai = 0; ai < 2; ++ai)
#pragma unroll
          for (int m = 0; m < 4; ++m) {
            const int row = u.pm * 256 + ai * 128 + wr * 64 + m * 16 + fr;
            const int b = row / SEGL, s = row - b * SEGL, t = s >> 6, kk = s & 63;
            const int slot = ((kk >> 2) & 1) * 32 + (kk & 3) + 4 * ((kk >> 3) & 3) + 16 * (kk >> 5);
            unsigned char* vp = V8T + ((size_t)((b * 4 + hh) * NCH + t) * 128 + e0) * 80 + slot;
            const f32x4 v0 = acc[ai][bj][m][0], v1 = acc[ai][bj][m][1];
            int w0 = 0, w1 = 0;
            w0 = __builtin_amdgcn_cvt_pk_fp8_f32(v0[0], v0[1], w0, false); w0 = __builtin_amdgcn_cvt_pk_fp8_f32(v0[2], v0[3], w0, true);
            w1 = __builtin_amdgcn_cvt_pk_fp8_f32(v1[0], v1[1], w1, false); w1 = __builtin_amdgcn_cvt_pk_fp8_f32(v1[2], v1[3], w1, true);
            vp[0] = (unsigned char)(w0 & 0xFF); vp[80] = (unsigned char)((w0 >> 8) & 0xFF); vp[160] = (unsigned char)((w0 >> 16) & 0xFF); vp[240] = (unsigned char)((w0 >> 24) & 0xFF);
            vp[320] = (unsigned char)(w1 & 0xFF); vp[400] = (unsigned char)((w1 >> 8) & 0xFF); vp[480] = (unsigned char)((w1 >> 16) & 0xFF); vp[560] = (unsigned char)((w1 >> 24) & 0xFF);
          }
        continue;
      }
      unsigned char* qk8 = nullptr;
      if (rope) { const int isk = colt >= C_DK, cc = col8 - (isk ? C_DK : C_DQ); qk8 = V8T + (WS_QK8 - WS_V8T) + (size_t)isk * QK8_IMG + (size_t)(cc >> 7) * SEGL * QK8_PITCH + (cc & 127); }
#pragma unroll
      for (int ai = 0; ai < 2; ++ai)
#pragma unroll
        for (int m = 0; m < 4; ++m) {
          const int row = u.pm * 256 + ai * 128 + wr * 64 + m * 16 + fr;
          f32x4 v0 = acc[ai][bj][m][0], v1 = acc[ai][bj][m][1];
          if (rope) {
            const int s = row % SEGL;
            if (s >= CTXL) {
              const int idx = (s - CTXL) * 32 + ((col8 & 63) >> 1);
              const f32x4 c = *(const f32x4*)(RC + idx), sn = *(const f32x4*)(RS + idx);
              f32x4 a, b;
              a[0] = v0[0] * c[0] - v0[1] * sn[0]; a[1] = v0[0] * sn[0] + v0[1] * c[0]; a[2] = v0[2] * c[1] - v0[3] * sn[1]; a[3] = v0[2] * sn[1] + v0[3] * c[1];
              b[0] = v1[0] * c[2] - v1[1] * sn[2]; b[1] = v1[0] * sn[2] + v1[1] * c[2]; b[2] = v1[2] * c[3] - v1[3] * sn[3]; b[3] = v1[2] * sn[3] + v1[3] * c[3];
              v0 = a; v1 = b;
            }
          }
          if (rope) {
            const int b = row / SEGL, s = row - b * SEGL;
            int w0, w1; asm volatile("" : "=v"(w0), "=v"(w1));
            w0 = __builtin_amdgcn_cvt_pk_fp8_f32(v0[0] * scl, v0[1] * scl, w0, false); w0 = __builtin_amdgcn_cvt_pk_fp8_f32(v0[2] * scl, v0[3] * scl, w0, true);
            w1 = __builtin_amdgcn_cvt_pk_fp8_f32(v1[0] * scl, v1[1] * scl, w1, false); w1 = __builtin_amdgcn_cvt_pk_fp8_f32(v1[2] * scl, v1[3] * scl, w1, true);
            *(u32x2*)(qk8 + ((size_t)b * 4 * SEGL + s) * QK8_PITCH) = (u32x2){(unsigned)w0, (unsigned)w1};
            continue;
          }
          u32x4 w; w.x = cvtpk(v0[0] * scl, v0[1] * scl); w.y = cvtpk(v0[2] * scl, v0[3] * scl); w.z = cvtpk(v1[0] * scl, v1[1] * scl); w.w = cvtpk(v1[2] * scl, v1[3] * scl);
          *(u32x4*)(PROJ + (size_t)row * PW + col8) = w;
        }
    }
  }
};
struct EpiOutproj {
  static constexpr bool PERM = true, AFTER_DRAIN = false;
  float* XC; const float* MODL; const float* xin; const float* ctxin; int first; float gsc;
  __device__ __forceinline__ void operator()(const pg8::f32x4 (&acc)[2][2][4][2], const pg8::Unit& u, int wr, int wc, int fr, int fq) const {
    const int mr = (u.pm % 33) == 0 ? 4 : u.pm / 33;
    const float* g1 = MODL + (size_t)mr * 6144 + 2048;
#pragma unroll
    for (int bj = 0; bj < 2; ++bj) {
      const int col8 = u.pn * 256 + bj * 128 + wc * 32 + 8 * fq;
      const f32x4 ga = *(const f32x4*)(g1 + col8) * gsc, gb = *(const f32x4*)(g1 + col8 + 4) * gsc;
#pragma unroll
      for (int ai = 0; ai < 2; ++ai)
#pragma unroll
        for (int m = 0; m < 4; ++m) {
          const int row = u.pm * 256 + ai * 128 + wr * 64 + m * 16 + fr;
          const float* xo = first ? in_row(xin, ctxin, row) + col8 : XC + (size_t)row * DM + col8;
          const f32x4 xa = *(const f32x4*)xo, xb = *(const f32x4*)(xo + 4);
          *(f32x4*)(XC + (size_t)row * DM + col8) = xa + ga * acc[ai][bj][m][0];
          *(f32x4*)(XC + (size_t)row * DM + col8 + 4) = xb + gb * acc[ai][bj][m][1];
        }
    }
  }
};
struct EpiPeerq {
  static constexpr bool PERM = true, AFTER_DRAIN = false;
  bf16_t* QP;
  __device__ __forceinline__ void operator()(const pg8::f32x4 (&acc)[2][2][4][2], const pg8::Unit& u, int wr, int wc, int fr, int fq) const {
#pragma unroll
    for (int bj = 0; bj < 2; ++bj) {
      const int col8 = u.pn * 256 + bj * 128 + wc * 32 + 8 * fq;
#pragma unroll
      for (int ai = 0; ai < 2; ++ai)
#pragma unroll
        for (int m = 0; m < 4; ++m) {
          const int row = u.pm * 256 + ai * 128 + wr * 64 + m * 16 + fr;
          const f32x4 v0 = acc[ai][bj][m][0], v1 = acc[ai][bj][m][1];
          u32x4 w; w.x = cvtpk(v0[0], v0[1]); w.y = cvtpk(v0[2], v0[3]); w.z = cvtpk(v1[0], v1[1]); w.w = cvtpk(v1[2], v1[3]);
          *(u32x4*)(QP + (size_t)row * DM + col8) = w;
        }
    }
  }
};
__device__ __forceinline__ void phase_inproj2(const Params& p, int l, unsigned char* lds) {
  {
    pg8::Gemm g{(const bf16_t*)(p.ws + WS_H), (const bf16_t*)(p.ws + WS_WIN) + (size_t)l * PW * DM, T, PW, DM};
    pg8::StaticOrder S; S.init(T, PW, p.gx, p.bx);
    EpiInproj E{(bf16_t*)(p.ws + WS_PROJ), (const float*)(p.ws + WS_ROPE), (const float*)(p.ws + WS_ROPE) + SEQ * 32, p.ws + WS_V8T};
    pg8::gemm_phase<EpiInproj, pg8::StaticOrder, true, true>((PG8_LAS unsigned char*)lds, g, S, E);
  }
  int tid_ = tidx(); asm volatile("" : "+v"(tid_)); const int tid = tid_, lane = tid & 63, wid = tid >> 6;
  const bf16_t* H = (const bf16_t*)(p.ws + WS_H);
  for (int pm = p.gx - 1 - p.bx; pm < T / 256; pm += p.gx) {
    const int rowb = pm * 256 + wid * 32;
    const bf16_t* WG = (const bf16_t*)(p.ws + WS_WG) + (size_t)l * 16 * DM;
    float* GT = (float*)(p.ws + WS_GATES);
    const int r16 = lane & 15, q4 = lane >> 4;
    f32x4 c0 = {0.f, 0.f, 0.f, 0.f}, c1 = {0.f, 0.f, 0.f, 0.f};
    const bf16_t* a0p = H + (size_t)(rowb + r16) * DM + q4 * 8;
    const bf16_t* a1p = a0p + (size_t)16 * DM;
    const bf16_t* bp = WG + (size_t)r16 * DM + q4 * 8;
#pragma unroll 4
    for (int ks = 0; ks < 32; ++ks) {
      const bf16x8 a0 = *(const bf16x8*)(a0p + ks * 32), a1 = *(const bf16x8*)(a1p + ks * 32), b = *(const bf16x8*)(bp + ks * 32);
      c0 = __builtin_amdgcn_mfma_f32_16x16x32_bf16(a0, b, c0, 0, 0, 0);
      c1 = __builtin_amdgcn_mfma_f32_16x16x32_bf16(a1, b, c1, 0, 0, 0);
    }
    const float gb = p.in[I_GATEB][l * 16 + r16];
#pragma unroll
    for (int j = 0; j < 4; ++j) {
      GT[(size_t)(rowb + q4 * 4 + j) * 16 + r16] = c0[j] + gb;
      GT[(size_t)(rowb + 16 + q4 * 4 + j) * 16 + r16] = c1[j] + gb;
    }
  }
}
__device__ __forceinline__ void phase_outproj2(const Params& p, int l, unsigned char* lds) {
  pg8::Gemm g{(const bf16_t*)(p.ws + WS_MIX), (const bf16_t*)(p.ws + WS_WOUT) + (size_t)l * DM * DM, T, DM, DM};
  pg8::StaticOrder S; S.init(T, DM, p.gx, p.bx);
  for (int rep = 0; rep < REP_OUTP; ++rep) {
  EpiOutproj E{(float*)(p.ws + WS_XCUR), (const float*)(p.ws + WS_MOD) + (size_t)l * 5 * 6144, p.in[I_X], p.in[I_CTX], l == 0, (rep == REP_OUTP - 1) ? 1.f : 0.f};
  pg8::gemm_phase<EpiOutproj, pg8::StaticOrder, true, true>((PG8_LAS unsigned char*)lds, g, S, E);
  }
  tail_filler_tables(p, l, (T / 256) * (DM / 256), l == 0 ? 0 : NEXP, 2 * NEXP);
}
__device__ __forceinline__ void phase_peerq2(const Params& p, int l, unsigned char* lds) {
  pg8::Gemm g{(const bf16_t*)(p.ws + WS_H), (const bf16_t*)(p.ws + WS_WQ) + (size_t)l * DM * DM, T, DM, DM};
  pg8::StaticOrder S; S.init(T, DM, p.gx, p.bx);
  EpiPeerq E{(bf16_t*)(p.ws + WS_PROJ)};
  pg8::gemm_phase<EpiPeerq, pg8::StaticOrder, true, true>((PG8_LAS unsigned char*)lds, g, S, E);
  if (l < DEPTH - 1) tail_filler_tables(p, l + 1, (T / 256) * (DM / 256), 0, NEXP);
}

__device__ __forceinline__ void conv_unit(const Params& p, int l, int unit, unsigned char* lds) {
  int tid_ = tidx(); asm volatile("" : "+v"(tid_)); const int tid = tid_, lane = tid & 63, wid = tid >> 6;
  float* U = (float*)lds;
  const bf16_t* PROJ = (const bf16_t*)(p.ws + WS_PROJ);
  bf16_t* MIX = (bf16_t*)(p.ws + WS_MIX);
  const int row0 = unit * 32, b = row0 / SEGL, s0 = row0 - b * SEGL;
  const int seglo = s0 < CTXL ? 0 : CTXL, seghi = s0 < CTXL ? CTXL : SEGL;
  for (int rr = tid >> 5; rr < 62; rr += 16) {
    const int s = s0 - 15 + rr, c8 = (tid & 31) * 8;
    f32x4 u0 = {0.f, 0.f, 0.f, 0.f}, u1 = {0.f, 0.f, 0.f, 0.f};
    if (s >= seglo && s < seghi) {
      const bf16_t* pr = PROJ + (size_t)(b * SEGL + s) * PW + c8;
      const u32x4 a1 = *(const u32x4*)pr, a2 = *(const u32x4*)(pr + 256);
      u0.x = bflo(a1.x) * sigmoidf_(bflo(a2.x)); u0.y = bfhi(a1.x) * sigmoidf_(bfhi(a2.x));
      u0.z = bflo(a1.y) * sigmoidf_(bflo(a2.y)); u0.w = bfhi(a1.y) * sigmoidf_(bfhi(a2.y));
      u1.x = bflo(a1.z) * sigmoidf_(bflo(a2.z)); u1.y = bfhi(a1.z) * sigmoidf_(bfhi(a2.z));
      u1.z = bflo(a1.w) * sigmoidf_(bflo(a2.w)); u1.w = bfhi(a1.w) * sigmoidf_(bfhi(a2.w));
    }
    *(f32x4*)(U + rr * 256 + c8) = u0; *(f32x4*)(U + rr * 256 + c8 + 4) = u1;
  }
  __syncthreads();
  float* Y = U + 62 * 256;
  const float* cw = p.in[I_CONVW] + (size_t)l * 31 * 256;
#pragma unroll 1
  for (int q = 0; q < 4; ++q) {
    const int c = lane + 64 * q;
    float w[31];
#pragma unroll
    for (int j = 0; j < 31; ++j) w[j] = cw[j * 256 + c];
    const float bias = p.in[I_CONVB][l * 256 + c];
#pragma unroll
    for (int tt = 0; tt < 4; ++tt) {
      const int t = wid * 4 + tt;
      float a = bias;
#pragma unroll
      for (int j = 0; j < 31; ++j) a += U[(t + j) * 256 + c] * w[j];
      Y[t * 256 + c] = a;
    }
  }
  asm volatile("s_waitcnt lgkmcnt(0)" ::: "memory");
  float y[4][4];
#pragma unroll
  for (int tt = 0; tt < 4; ++tt)
#pragma unroll
    for (int q = 0; q < 4; ++q) y[tt][q] = Y[(wid * 4 + tt) * 256 + lane + 64 * q];
#pragma unroll
  for (int tt = 0; tt < 4; ++tt) {
    const int t = wid * 4 + tt;
    const float mean = wave_sum((y[tt][0] + y[tt][1]) + (y[tt][2] + y[tt][3])) * (1.f / 256.f);
    float v = 0.f;
#pragma unroll
    for (int q = 0; q < 4; ++q) { const float d = y[tt][q] - mean; v += d * d; }
    const float rs = rsqrtf(wave_sum(v) * (1.f / 256.f) + EPS);
#pragma unroll
    for (int q = 0; q < 4; ++q) {
      const int c = lane + 64 * q;
      const float z = (y[tt][q] - mean) * rs * p.in[I_CLNG][l * 256 + c] + p.in[I_CLNB][l * 256 + c];
      const float o = (ABL & 1) ? 0.f : z * sigmoidf_(z);
      MIX[(size_t)(row0 + t) * DM + c] = (bf16_t)(cvtpk(o, 0.f) & 0xffffu);
    }
  }
  __syncthreads();
}

__device__ __forceinline__ int ml_cidx(int ch, int dir) { return dir == 0 ? ch : (ch < 4 ? 3 - ch : 135 - ch); }
__device__ __forceinline__ void ml_load_tile(const bf16_t* src, float* dst, int tid) {
  const int r = tid >> 3, c8 = (tid & 7) * 8;
  const u32x4 a = *(const u32x4*)(src + (size_t)r * PW + c8);
  float* d = dst + r * 65 + c8;
  d[0] = bflo(a.x); d[1] = bfhi(a.x); d[2] = bflo(a.y); d[3] = bfhi(a.y); d[4] = bflo(a.z); d[5] = bfhi(a.z); d[6] = bflo(a.w); d[7] = bfhi(a.w);
}
__device__ __forceinline__ void ml_local_unit(const Params& p, int l, int unit, unsigned char* lds) {
  int tid_ = tidx(); asm volatile("" : "+v"(tid_)); const int tid = tid_, lane = tid & 63, wid = tid >> 6, r32 = lane & 31, hi = lane >> 5;
  float* Kt = (float*)lds; float* Vt = Kt + 64 * 65; float* WK = Vt + 64 * 65;
  const bf16_t* PROJ = (const bf16_t*)(p.ws + WS_PROJ);
  const float* GT = (const float*)(p.ws + WS_GATES);
  float* UL = (float*)(p.ws + WS_ULOC); float* META = (float*)(p.ws + WS_MLMETA);
  const int b = unit / (4 * NCH), hh = (unit / NCH) & 3, ch = unit % NCH;
  const int row0 = b * SEGL + ch * 64;
  ml_load_tile(PROJ + (size_t)row0 * PW + C_MK + hh * 64, Kt, tid);
  ml_load_tile(PROJ + (size_t)row0 * PW + C_MV + hh * 64, Vt, tid);
  if (wid < 2) {
    const int dir = wid;
    const float ig = GT[(size_t)(row0 + lane) * 16 + (2 * dir) * 4 + hh];
    const float lf = logsigmoidf_(GT[(size_t)(row0 + lane) * 16 + (2 * dir + 1) * 4 + hh]);
    float ps = lf;
    ps = wave_incl_scan(ps);
    const float tot = __uint_as_float((unsigned)__builtin_amdgcn_readlane((int)__float_as_uint(ps), 63));
    const float wlog = dir == 0 ? (tot - ps + ig) : (ps - lf + ig);
    const float mloc = wave_max(wlog);
    WK[dir * 64 + lane] = __expf(wlog - mloc);
    if (lane == 0) {
      const int seq = (b * 4 + hh) * 2 + dir, ci = ml_cidx(ch, dir);
      META[((size_t)seq * NCH + ci) * 4 + 0] = tot; META[((size_t)seq * NCH + ci) * 4 + 1] = mloc;
    }
  }
  __syncthreads();
  {
    const int dir = wid >> 2, et = (wid >> 1) & 1, dt = wid & 1;
    const int seq = (b * 4 + hh) * 2 + dir, ci = ml_cidx(ch, dir);
    float* slot = UL + ((size_t)seq * NCH + ci) * USTRIDE;
    f32x16 acc = {};
#pragma unroll 8
    for (int ks = 0; ks < 32; ++ks) {
      const int s = 2 * ks + hi;
      const float a = WK[dir * 64 + s] * Vt[s * 65 + et * 32 + r32];
      const float bb = Kt[s * 65 + dt * 32 + r32];
      acc = __builtin_amdgcn_mfma_f32_32x32x2f32(a, bb, acc, 0, 0, 0);
    }
#pragma unroll
    for (int r = 0; r < 16; ++r) slot[(et * 32 + crow(r, hi)) * 64 + dt * 32 + r32] = acc[r];
    if (et == 0) {
      float n = 0.f;
#pragma unroll 8
      for (int i = 0; i < 32; ++i) { const int s = hi * 32 + i; n += WK[dir * 64 + s] * Kt[s * 65 + dt * 32 + r32]; }
      n = sum_xor32(n);
      if (hi == 0) slot[4096 + dt * 32 + r32] = n;
    }
  }
  __syncthreads();
}
constexpr int MLP = 144;
constexpr size_t WS_CST = WS_H;
constexpr size_t WS_NST = WS_H + (size_t)32 * NCH * 4096 * 2;
__device__ __forceinline__ void ml_stage_rm(const bf16_t* src, size_t ld, unsigned char* dst, int tid) {
  const int r = tid >> 3, c8 = (tid & 7) * 8;
  *(u32x4*)(dst + r * MLP + c8 * 2) = *(const u32x4*)(src + (size_t)r * ld + c8);
}
__device__ __forceinline__ void ml_stage_tr(const bf16_t* src, size_t ld, unsigned char* dst, int tid) {
  const int r = tid >> 3, c8 = (tid & 7) * 8;
  const u32x4 a = *(const u32x4*)(src + (size_t)r * ld + c8);
  bf16_t* d = (bf16_t*)dst;
  d[(c8 + 0) * 72 + r] = (bf16_t)(a.x & 0xffffu); d[(c8 + 1) * 72 + r] = (bf16_t)(a.x >> 16);
  d[(c8 + 2) * 72 + r] = (bf16_t)(a.y & 0xffffu); d[(c8 + 3) * 72 + r] = (bf16_t)(a.y >> 16);
  d[(c8 + 4) * 72 + r] = (bf16_t)(a.z & 0xffffu); d[(c8 + 5) * 72 + r] = (bf16_t)(a.z >> 16);
  d[(c8 + 6) * 72 + r] = (bf16_t)(a.w & 0xffffu); d[(c8 + 7) * 72 + r] = (bf16_t)(a.w >> 16);
}
__device__ __forceinline__ void ml_local_unit2(const Params& p, int l, int unit, unsigned char* lds) {
  int tid_ = tidx(); asm volatile("" : "+v"(tid_)); const int tid = tid_, lane = tid & 63, wid = tid >> 6, r32 = lane & 31, hi = lane >> 5;
  unsigned char* KT = lds; unsigned char* VT = lds + 64 * MLP; float* WK = (float*)(lds + 2 * 64 * MLP);
  const bf16_t* PROJ = (const bf16_t*)(p.ws + WS_PROJ);
  const float* GT = (const float*)(p.ws + WS_GATES);
  float* UL = (float*)(p.ws + WS_ULOC); float* META = (float*)(p.ws + WS_MLMETA);
  const int b = unit / (4 * NCH), hh = (unit / NCH) & 3, ch = unit % NCH;
  const int row0 = b * SEGL + ch * 64;
  ml_stage_tr(PROJ + (size_t)row0 * PW + C_MK + hh * 64, PW, KT, tid);
  ml_stage_tr(PROJ + (size_t)row0 * PW + C_MV + hh * 64, PW, VT, tid);
  if (wid < 2) {
    const int dir = wid;
    const float ig = GT[(size_t)(row0 + lane) * 16 + (2 * dir) * 4 + hh];
    const float lf = logsigmoidf_(GT[(size_t)(row0 + lane) * 16 + (2 * dir + 1) * 4 + hh]);
    float ps = lf;
    ps = wave_incl_scan(ps);
    const float tot = __uint_as_float((unsigned)__builtin_amdgcn_readlane((int)__float_as_uint(ps), 63));
    const float wlog = dir == 0 ? (tot - ps + ig) : (ps - lf + ig);
    const float mloc = wave_max(wlog);
    WK[dir * 64 + lane] = __expf(wlog - mloc);
    if (lane == 0) {
      const int seq = (b * 4 + hh) * 2 + dir, ci = ml_cidx(ch, dir);
      META[((size_t)seq * NCH + ci) * 4 + 0] = tot; META[((size_t)seq * NCH + ci) * 4 + 1] = mloc;
    }
  }
  __syncthreads();
  {
    const int dir = wid >> 2, et = (wid >> 1) & 1, dt = wid & 1;
    const int seq = (b * 4 + hh) * 2 + dir, ci = ml_cidx(ch, dir);
    float* slot = UL + ((size_t)seq * NCH + ci) * USTRIDE;
    f32x16 acc = {};
#pragma unroll
    for (int ks = 0; ks < 4; ++ks) {
      const int s0 = ks * 16 + hi * 8;
      const u32x4 va = *(const u32x4*)(VT + (et * 32 + r32) * MLP + s0 * 2);
      const bf16x8 kb = *(const bf16x8*)(KT + (dt * 32 + r32) * MLP + s0 * 2);
      const f32x4 w0 = *(const f32x4*)(WK + dir * 64 + s0), w1 = *(const f32x4*)(WK + dir * 64 + s0 + 4);
      u32x4 sa; sa.x = cvtpk(bflo(va.x) * w0.x, bfhi(va.x) * w0.y); sa.y = cvtpk(bflo(va.y) * w0.z, bfhi(va.y) * w0.w);
      sa.z = cvtpk(bflo(va.z) * w1.x, bfhi(va.z) * w1.y); sa.w = cvtpk(bflo(va.w) * w1.z, bfhi(va.w) * w1.w);
      acc = __builtin_amdgcn_mfma_f32_32x32x16_bf16(*(const bf16x8*)&sa, kb, acc, 0, 0, 0);
    }
#pragma unroll
    for (int r = 0; r < 16; ++r) slot[(et * 32 + crow(r, hi)) * 64 + dt * 32 + r32] = acc[r];
    if (et == 0) {
      float n = 0.f;
#pragma unroll
      for (int i = 0; i < 4; ++i) {
        const int s0 = hi * 32 + i * 8;
        const u32x4 ka = *(const u32x4*)(KT + (dt * 32 + r32) * MLP + s0 * 2);
        const f32x4 w0 = *(const f32x4*)(WK + dir * 64 + s0), w1 = *(const f32x4*)(WK + dir * 64 + s0 + 4);
        n += bflo(ka.x) * w0.x + bfhi(ka.x) * w0.y + bflo(ka.y) * w0.z + bfhi(ka.y) * w0.w + bflo(ka.z) * w1.x + bfhi(ka.z) * w1.y + bflo(ka.w) * w1.z + bfhi(ka.w) * w1.w;
      }
      n = sum_xor32(n);
      if (hi == 0) slot[4096 + dt * 32 + r32] = n;
    }
  }
  __syncthreads();
}
__device__ __forceinline__ void ml_scan(const Params& p, unsigned char* lds) {
  float* UL = (float*)(p.ws + WS_ULOC); float* META = (float*)(p.ws + WS_MLMETA);
  int tid_ = tidx(); asm volatile("" : "+v"(tid_));
  const int tid = tid_, lane = tid & 63, wid = tid >> 6;
  float* DEC = (float*)lds;
  float* SCL = DEC + 2 * NCH;
  float* TMP = SCL + 2 * NCH;
  constexpr int NSL = (32 * USTRIDE + 511) / 512;
  const int first_ = p.gx > 64 ? 16 : 0, nb_ = p.gx - first_;
  for (int k_ = 0; k_ < 2 + (NSL + nb_ - 1) / nb_; ++k_) {
    int s_;
    if (k_ == 0) s_ = p.bx >= first_ ? p.bx - first_ : -1;
    else s_ = k_ * nb_ + (p.gx - 1 - p.bx);
    if (k_ > 0 && p.gx - 1 - p.bx >= nb_) s_ = -1;
    if (s_ < 0 || s_ >= NSL) continue;
    const int base0 = s_ * 512;
    const int seq0 = base0 / USTRIDE;
    if (wid < 2) {
      const int seq = seq0 + wid;
      if (seq < 32) {
        float* mt = META + (size_t)seq * NCH * 4;
        for (int c = lane; c < NCH; c += 64) { TMP[(wid * 2 + 0) * NCH + c] = mt[c * 4 + 0]; TMP[(wid * 2 + 1) * NCH + c] = mt[c * 4 + 1]; }
        asm volatile("s_waitcnt lgkmcnt(0)" ::: "memory");
        if (lane == 0) {
          float m = 0.f;
          for (int c = 0; c < NCH; ++c) {
            const float bl = TMP[(wid * 2 + 0) * NCH + c], mloc = TMP[(wid * 2 + 1) * NCH + c];
            const float mn = fmaxf(bl + m, mloc);
            DEC[wid * NCH + c] = __expf(bl + m - mn); SCL[wid * NCH + c] = __expf(mloc - mn);
            mt[c * 4 + 2] = m;
            m = mn;
          }
        }
      }
    }
    __syncthreads();
    const int idx = base0 + tid;
    if (idx < 32 * USTRIDE) {
      const int seq = idx / USTRIDE, e = idx - seq * USTRIDE, sl = seq - seq0;
      float* bp = UL + (size_t)seq * NCH * USTRIDE + e;
      bf16_t* CSTp = (bf16_t*)(p.ws + WS_CST) + (size_t)seq * NCH * 4096 + (e < 4096 ? e : 0);
      float* NSTp = (float*)(p.ws + WS_NST) + (size_t)seq * NCH * 64 + (e < 4096 ? 0 : e - 4096);
      const float* dec = DEC + sl * NCH; const float* scl = SCL + sl * NCH;
      float C = 0.f;
      constexpr int BT = 33;
      static_assert(NCH == 4 * BT, "scan batches");
      float ua[BT], ub[BT];
#define SCAN_LD(u_, c0_) _Pragma("unroll") for (int j = 0; j < BT; ++j) u_[j] = bp[(size_t)((c0_) + j) * USTRIDE];
#define SCAN_DO(u_, c0_) _Pragma("unroll") for (int j = 0; j < BT; ++j) { \
          if (e < 4096) CSTp[(size_t)((c0_) + j) * 4096] = (bf16_t)(cvtpk(C, 0.f) & 0xffffu); else NSTp[(size_t)((c0_) + j) * 64] = C; \
          C = dec[(c0_) + j] * C + scl[(c0_) + j] * u_[j]; }
      SCAN_LD(ua, 0)
#pragma unroll 1
      for (int c0 = 0; c0 < NCH; c0 += 2 * BT) {
        SCAN_LD(ub, c0 + BT)
        SCAN_DO(ua, c0)
        if (c0 + 2 * BT < NCH) { SCAN_LD(ua, c0 + 2 * BT) }
        SCAN_DO(ub, c0 + BT)
      }
#undef SCAN_LD
#undef SCAN_DO
    }
    __syncthreads();
  }
}
__device__ __forceinline__ void ml_out_unit(const Params& p, int l, int unit, unsigned char* lds) {
  int tid_ = tidx(); asm volatile("" : "+v"(tid_)); const int tid = tid_, lane = tid & 63, wid = tid >> 6, r32 = lane & 31, hi = lane >> 5;
  float* Qt = (float*)lds; float* Kt = Qt + 64 * 65; float* Vt = Kt + 64 * 65;
  float* Cs = Vt + 64 * 65;
  float* Ns = Cs + 2 * 64 * 65;
  float* Bq = Ns + 128;
  float* Gs = Bq + 128;
  float* Mi = Gs + 128;
  float* HB = Mi + 64;
  const bf16_t* PROJ = (const bf16_t*)(p.ws + WS_PROJ);
  const float* GT = (const float*)(p.ws + WS_GATES);
  const float* UL = (const float*)(p.ws + WS_ULOC); const float* META = (const float*)(p.ws + WS_MLMETA);
  bf16_t* MIX = (bf16_t*)(p.ws + WS_MIX);
  const int b = unit / (4 * NCH), hh = (unit / NCH) & 3, ch = unit % NCH;
  const int row0 = b * SEGL + ch * 64;
  ml_load_tile(PROJ + (size_t)row0 * PW + C_MQ + hh * 64, Qt, tid);
  ml_load_tile(PROJ + (size_t)row0 * PW + C_MK + hh * 64, Kt, tid);
  ml_load_tile(PROJ + (size_t)row0 * PW + C_MV + hh * 64, Vt, tid);
  for (int i = tid; i < 2 * USTRIDE; i += 512) {
    const int dir = i / USTRIDE, e = i - dir * USTRIDE;
    const int seq = (b * 4 + hh) * 2 + dir, ci = ml_cidx(ch, dir);
    const float v = UL[((size_t)seq * NCH + ci) * USTRIDE + e];
    if (e < 4096) Cs[dir * 64 * 65 + (e >> 6) * 65 + (e & 63)] = v; else Ns[dir * 64 + (e - 4096)] = v;
  }
  if (wid < 2) {
    const int dir = wid;
    const float ig = GT[(size_t)(row0 + lane) * 16 + (2 * dir) * 4 + hh];
    const float lf = logsigmoidf_(GT[(size_t)(row0 + lane) * 16 + (2 * dir + 1) * 4 + hh]);
    float ps = lf;
    ps = wave_incl_scan(ps);
    const float tot = __uint_as_float((unsigned)__builtin_amdgcn_readlane((int)__float_as_uint(ps), 63));
    const float bc = dir == 0 ? ps : (tot - ps + lf);
    Bq[dir * 64 + lane] = bc; Gs[dir * 64 + lane] = ig - bc;
    if (lane == 0) { const int seq = (b * 4 + hh) * 2 + dir, ci = ml_cidx(ch, dir); Mi[dir] = META[((size_t)seq * NCH + ci) * 4 + 2]; }
  }
  __syncthreads();
  {
    const int dir = wid >> 2, tt = (wid >> 1) & 1, et = wid & 1;
    const int t = tt * 32 + r32;
    f32x16 sa[2] = {};
#pragma unroll 4
    for (int ks = 0; ks < 32; ++ks) {
      const float bq = Qt[t * 65 + 2 * ks + hi];
      const float a0 = Kt[(r32) * 65 + 2 * ks + hi], a1 = Kt[(32 + r32) * 65 + 2 * ks + hi];
      sa[0] = __builtin_amdgcn_mfma_f32_32x32x2f32(a0, bq, sa[0], 0, 0, 0);
      sa[1] = __builtin_amdgcn_mfma_f32_32x32x2f32(a1, bq, sa[1], 0, 0, 0);
    }
    const float bt = Bq[dir * 64 + t];
    const float inter = bt + Mi[dir];
    float mx = -INFINITY;
    f32x16 dl[2];
#pragma unroll
    for (int st = 0; st < 2; ++st)
#pragma unroll
      for (int r = 0; r < 16; ++r) {
        const int s = st * 32 + crow(r, hi);
        const bool ok = dir == 0 ? (s <= t) : (s >= t);
        const float d = ok ? bt + Gs[dir * 64 + s] : -INFINITY;
        dl[st][r] = d; mx = fmaxf(mx, d);
      }
    mx = max_xor32(mx);
    const float mt = fmaxf(inter, mx);
    const float iw = __expf(inter - mt);
    float rsum = 0.f;
#pragma unroll
    for (int st = 0; st < 2; ++st)
#pragma unroll
      for (int r = 0; r < 16; ++r) { const float w = __expf(dl[st][r] - mt); sa[st][r] *= w; rsum += sa[st][r]; }
    rsum = sum_xor32(rsum);
    float qn = 0.f;
#pragma unroll 8
    for (int i = 0; i < 32; ++i) { const int d = hi * 32 + i; qn += Ns[dir * 64 + d] * Qt[t * 65 + d]; }
    qn = sum_xor32(qn);
    const float den = rsum + iw * qn;
    const float rden = 1.f / fmaxf(fabsf(den), __expf(-mt));
    f32x16 an = {}, ac = {};
#pragma unroll
    for (int st = 0; st < 2; ++st)
#pragma unroll
      for (int r = 0; r < 16; ++r) {
        const float a = Vt[(st * 32 + crow(r, hi)) * 65 + et * 32 + r32];
        an = __builtin_amdgcn_mfma_f32_32x32x2f32(a, sa[st][r], an, 0, 0, 0);
      }
    const float* Cd = Cs + dir * 64 * 65;
#pragma unroll 4
    for (int ks = 0; ks < 32; ++ks) {
      const float a = Cd[(et * 32 + r32) * 65 + 2 * ks + hi];
      const float bq = Qt[t * 65 + 2 * ks + hi];
      ac = __builtin_amdgcn_mfma_f32_32x32x2f32(a, bq, ac, 0, 0, 0);
    }
#pragma unroll
    for (int r = 0; r < 16; ++r) HB[dir * 64 * 65 + t * 65 + et * 32 + crow(r, hi)] = (an[r] + iw * ac[r]) * rden;
  }
  __syncthreads();
  {
    const int t = tid >> 3, e8 = (tid & 7) * 8;
    float v[8]; float ss = 0.f;
#pragma unroll
    for (int i = 0; i < 8; ++i) { v[i] = HB[t * 65 + e8 + i] + HB[64 * 65 + t * 65 + e8 + i]; ss += v[i] * v[i]; }
    ss += dpp_mov<0xB1>(ss); ss += dpp_mov<0x4E>(ss); ss += dpp_mov<0x141>(ss);
    const float rs = rsqrtf(ss * (1.f / 64.f) + EPS);
    const u32x4 ov = *(const u32x4*)(PROJ + (size_t)(row0 + t) * PW + C_MO + hh * 64 + e8);
    const float og[8] = {bflo(ov.x), bfhi(ov.x), bflo(ov.y), bfhi(ov.y), bflo(ov.z), bfhi(ov.z), bflo(ov.w), bfhi(ov.w)};
    const float* g = p.in[I_MNORMG] + l * 64 + e8;
    float o[8];
#pragma unroll
    for (int i = 0; i < 8; ++i) o[i] = (ABL & 2) ? 0.f : v[i] * rs * g[i] * sigmoidf_(og[i]);
    u32x4 w; w.x = cvtpk(o[0], o[1]); w.y = cvtpk(o[2], o[3]); w.z = cvtpk(o[4], o[5]); w.w = cvtpk(o[6], o[7]);
    *(u32x4*)(MIX + (size_t)(row0 + t) * DM + 256 + hh * 64 + e8) = w;
  }
  __syncthreads();
}


struct MlOutPf { u32x4 q, k, v, c0, c1, ov; float ns0, ns1, g_ig, g_lf, mi; };
__device__ __forceinline__ void ml_out_fetch(const Params& p, int unit, int tid, MlOutPf& f) {
  const int lane = tid & 63, wid = tid >> 6;
  const bf16_t* PROJ = (const bf16_t*)(p.ws + WS_PROJ);
  const float* GT = (const float*)(p.ws + WS_GATES);
  const bf16_t* CST = (const bf16_t*)(p.ws + WS_CST); const float* NST = (const float*)(p.ws + WS_NST); const float* META = (const float*)(p.ws + WS_MLMETA);
  const int b = unit / (4 * NCH), hh = (unit / NCH) & 3, ch = unit % NCH;
  const int row0 = b * SEGL + ch * 64;
  const int r = tid >> 3, c8 = (tid & 7) * 8;
  const bf16_t* prow = PROJ + (size_t)(row0 + r) * PW + hh * 64 + c8;
  f.q = *(const u32x4*)(prow + C_MQ); f.k = *(const u32x4*)(prow + C_MK); f.v = *(const u32x4*)(prow + C_MV); f.ov = *(const u32x4*)(prow + C_MO);
  const int seq0 = (b * 4 + hh) * 2, ci0 = ml_cidx(ch, 0), ci1 = ml_cidx(ch, 1);
  f.c0 = *(const u32x4*)(CST + ((size_t)seq0 * NCH + ci0) * 4096 + r * 64 + c8);
  f.c1 = *(const u32x4*)(CST + ((size_t)(seq0 + 1) * NCH + ci1) * 4096 + r * 64 + c8);
  f.ns0 = 0.f; f.ns1 = 0.f; f.g_ig = 0.f; f.g_lf = 0.f; f.mi = 0.f;
  if (tid < 64) { f.ns0 = NST[((size_t)seq0 * NCH + ci0) * 64 + tid]; f.ns1 = NST[((size_t)(seq0 + 1) * NCH + ci1) * 64 + tid]; }
  if (wid < 2) {
    const int dir = wid;
    f.g_ig = GT[(size_t)(row0 + lane) * 16 + (2 * dir) * 4 + hh];
    f.g_lf = GT[(size_t)(row0 + lane) * 16 + (2 * dir + 1) * 4 + hh];
    f.mi = META[((size_t)(seq0 + dir) * NCH + (dir ? ci1 : ci0)) * 4 + 2];
  }
}
__device__ __forceinline__ void ml_put_rm(const u32x4 a, unsigned char* dst, int tid) { const int r = tid >> 3, c8 = (tid & 7) * 8; *(u32x4*)(dst + r * MLP + c8 * 2) = a; }
__device__ __forceinline__ void ml_put_tr(const u32x4 a, unsigned char* dst, int tid) {
  const int r = tid >> 3, c8 = (tid & 7) * 8;
  bf16_t* d = (bf16_t*)dst;
  d[(c8 + 0) * 72 + r] = (bf16_t)(a.x & 0xffffu); d[(c8 + 1) * 72 + r] = (bf16_t)(a.x >> 16);
  d[(c8 + 2) * 72 + r] = (bf16_t)(a.y & 0xffffu); d[(c8 + 3) * 72 + r] = (bf16_t)(a.y >> 16);
  d[(c8 + 4) * 72 + r] = (bf16_t)(a.z & 0xffffu); d[(c8 + 5) * 72 + r] = (bf16_t)(a.z >> 16);
  d[(c8 + 6) * 72 + r] = (bf16_t)(a.w & 0xffffu); d[(c8 + 7) * 72 + r] = (bf16_t)(a.w >> 16);
}
__device__ __forceinline__ void ml_out_unit2(const Params& p, int l, int unit, unsigned char* lds, const MlOutPf& f, int next, MlOutPf& fn) {
  int tid_ = tidx(); asm volatile("" : "+v"(tid_)); const int tid = tid_, lane = tid & 63, wid = tid >> 6, r32 = lane & 31, hi = lane >> 5;
  unsigned char* Qs = lds; unsigned char* Ks = lds + 64 * MLP; unsigned char* VT = lds + 2 * 64 * MLP; unsigned char* Cs = lds + 3 * 64 * MLP;
  float* Ns = (float*)(lds + 5 * 64 * MLP);
  float* Bq = Ns + 128;
  float* Gs = Bq + 128;
  float* Mi = Gs + 128;
  float* HB = Mi + 64;
  const bf16_t* PROJ = (const bf16_t*)(p.ws + WS_PROJ);
  const float* GT = (const float*)(p.ws + WS_GATES);
  const bf16_t* CST = (const bf16_t*)(p.ws + WS_CST); const float* NST = (const float*)(p.ws + WS_NST); const float* META = (const float*)(p.ws + WS_MLMETA);
  bf16_t* MIX = (bf16_t*)(p.ws + WS_MIX);
  const int b = unit / (4 * NCH), hh = (unit / NCH) & 3, ch = unit % NCH;
  const int row0 = b * SEGL + ch * 64;
  ml_put_rm(f.q, Qs, tid); ml_put_rm(f.k, Ks, tid); ml_put_tr(f.v, VT, tid);
  ml_put_rm(f.c0, Cs, tid); ml_put_rm(f.c1, Cs + 64 * MLP, tid);
  if (tid < 64) { Ns[tid] = f.ns0; Ns[64 + tid] = f.ns1; }
  if (wid < 2) {
    const int dir = wid;
    const float ig = f.g_ig;
    const float lf = logsigmoidf_(f.g_lf);
    float ps = lf;
    ps = wave_incl_scan(ps);
    const float tot = __uint_as_float((unsigned)__builtin_amdgcn_readlane((int)__float_as_uint(ps), 63));
    const float bc = dir == 0 ? ps : (tot - ps + lf);
    Bq[dir * 64 + lane] = bc; Gs[dir * 64 + lane] = ig - bc;
    if (lane == 0) Mi[dir] = f.mi;
  }
  const u32x4 ov = f.ov;
  if (next >= 0) ml_out_fetch(p, next, tid, fn);
  __syncthreads();
  {
    const int dir = wid >> 2, tt = (wid >> 1) & 1, et = wid & 1;
    const int t = tt * 32 + r32;
    f32x16 sa[2] = {};
    bf16x8 bq[4];
#pragma unroll
    for (int ks = 0; ks < 4; ++ks) {
      bq[ks] = *(const bf16x8*)(Qs + t * MLP + (ks * 16 + hi * 8) * 2);
      const bf16x8 a0 = *(const bf16x8*)(Ks + r32 * MLP + (ks * 16 + hi * 8) * 2), a1 = *(const bf16x8*)(Ks + (32 + r32) * MLP + (ks * 16 + hi * 8) * 2);
      sa[0] = __builtin_amdgcn_mfma_f32_32x32x16_bf16(a0, bq[ks], sa[0], 0, 0, 0);
      sa[1] = __builtin_amdgcn_mfma_f32_32x32x16_bf16(a1, bq[ks], sa[1], 0, 0, 0);
    }
    const float bt = Bq[dir * 64 + t];
    const float inter = bt + Mi[dir];
    float mx = -INFINITY;
    f32x16 dl[2];
#pragma unroll
    for (int st = 0; st < 2; ++st)
#pragma unroll
      for (int r = 0; r < 16; ++r) {
        const int s = st * 32 + crow(r, hi);
        const bool ok = dir == 0 ? (s <= t) : (s >= t);
        const float d = ok ? bt + Gs[dir * 64 + s] : -INFINITY;
        dl[st][r] = d; mx = fmaxf(mx, d);
      }
    mx = max_xor32(mx);
    const float mt = fmaxf(inter, mx);
    const float iw = __expf(inter - mt);
    float rsum = 0.f;
#pragma unroll
    for (int st = 0; st < 2; ++st)
#pragma unroll
      for (int r = 0; r < 16; ++r) { const float w = __expf(dl[st][r] - mt); sa[st][r] *= w; rsum += sa[st][r]; }
    rsum = sum_xor32(rsum);
    float qn = 0.f;
#pragma unroll
    for (int i = 0; i < 4; ++i) {
      const int d0 = hi * 32 + i * 8;
      const u32x4 qa = *(const u32x4*)(Qs + t * MLP + d0 * 2);
      const f32x4 n0 = *(const f32x4*)(Ns + dir * 64 + d0), n1 = *(const f32x4*)(Ns + dir * 64 + d0 + 4);
      qn += bflo(qa.x) * n0.x + bfhi(qa.x) * n0.y + bflo(qa.y) * n0.z + bfhi(qa.y) * n0.w + bflo(qa.z) * n1.x + bfhi(qa.z) * n1.y + bflo(qa.w) * n1.z + bfhi(qa.w) * n1.w;
    }
    qn = sum_xor32(qn);
    const float den = rsum + iw * qn;
    const float rden = 1.f / fmaxf(fabsf(den), __expf(-mt));
    f32x16 an = {}, ac = {};
#pragma unroll
    for (int st = 0; st < 2; ++st)
#pragma unroll
      for (int k2 = 0; k2 < 2; ++k2) {
        u32x4 bx; bx.x = cvtpk(sa[st][8 * k2 + 0], sa[st][8 * k2 + 1]); bx.y = cvtpk(sa[st][8 * k2 + 2], sa[st][8 * k2 + 3]);
        bx.z = cvtpk(sa[st][8 * k2 + 4], sa[st][8 * k2 + 5]); bx.w = cvtpk(sa[st][8 * k2 + 6], sa[st][8 * k2 + 7]);
        const unsigned char* vrow = VT + (et * 32 + r32) * MLP + (st * 32 + 16 * k2 + 4 * hi) * 2;
        const u32x2 v0 = *(const u32x2*)vrow, v1 = *(const u32x2*)(vrow + 16);
        u32x4 ax; ax.x = v0.x; ax.y = v0.y; ax.z = v1.x; ax.w = v1.y;
        an = __builtin_amdgcn_mfma_f32_32x32x16_bf16(*(const bf16x8*)&ax, *(const bf16x8*)&bx, an, 0, 0, 0);
      }
    const unsigned char* Cd = Cs + dir * 64 * MLP;
#pragma unroll
    for (int ks = 0; ks < 4; ++ks) {
      const bf16x8 a = *(const bf16x8*)(Cd + (et * 32 + r32) * MLP + (ks * 16 + hi * 8) * 2);
      ac = __builtin_amdgcn_mfma_f32_32x32x16_bf16(a, bq[ks], ac, 0, 0, 0);
    }
#pragma unroll
    for (int r = 0; r < 16; ++r) HB[dir * 64 * 65 + t * 65 + et * 32 + crow(r, hi)] = (an[r] + iw * ac[r]) * rden;
  }
  __syncthreads();
  {
    const int t = tid >> 3, e8 = (tid & 7) * 8;
    float v[8]; float ss = 0.f;
#pragma unroll
    for (int i = 0; i < 8; ++i) { v[i] = HB[t * 65 + e8 + i] + HB[64 * 65 + t * 65 + e8 + i]; ss += v[i] * v[i]; }
    ss += dpp_mov<0xB1>(ss); ss += dpp_mov<0x4E>(ss); ss += dpp_mov<0x141>(ss);
    const float rs = rsqrtf(ss * (1.f / 64.f) + EPS);
    const float og[8] = {bflo(ov.x), bfhi(ov.x), bflo(ov.y), bfhi(ov.y), bflo(ov.z), bfhi(ov.z), bflo(ov.w), bfhi(ov.w)};
    const float* g = p.in[I_MNORMG] + l * 64 + e8;
    float o[8];
#pragma unroll
    for (int i = 0; i < 8; ++i) o[i] = (ABL & 2) ? 0.f : v[i] * rs * g[i] * sigmoidf_(og[i]);
    u32x4 w; w.x = cvtpk(o[0], o[1]); w.y = cvtpk(o[2], o[3]); w.z = cvtpk(o[4], o[5]); w.w = cvtpk(o[6], o[7]);
    *(u32x4*)(MIX + (size_t)(row0 + t) * DM + 256 + hh * 64 + e8) = w;
  }
  __syncthreads();
}

#define KSWZ(row, colB) ((row) * 256 + ((colB) ^ (((row) & 15) << 4)))
#define SBAR() __builtin_amdgcn_sched_barrier(0)
constexpr int ATT_SHM_V = 128 * 80, ATT_SHM_K = 64 * QK8_PITCH;
constexpr float ATT_THR = 8.0f;
__device__ __forceinline__ int v_st(int k, int c) { const int kk = (k & ~0xC) | ((k & 4) << 1) | ((k & 8) >> 1); return ((kk >> 3) * 4 + (c >> 5)) * 512 + ((kk & 7) * 32 + (c & 31)) * 2; }
__device__ __forceinline__ int v_rd_base(int lane) { return ((lane & 3) << 3) | (((lane >> 2) & 3) << 6) | (((lane >> 4) & 1) << 5) | (((lane >> 5) & 1) << 8); }
constexpr int v_rd_off(int d0, int ks, int half) { return d0 * 512 + ks * 4096 + half * 2048; }
template <int OFF> __device__ __forceinline__ s16x4 tr_read(int vb) {
  s16x4 r; asm volatile("ds_read_b64_tr_b16 %0, %1 offset:%2" : "=&v"(r) : "v"(vb), "i"(OFF) : "memory"); return r;
}
template <int D0> __device__ __forceinline__ void pv_one(f32x16& od, int vb, bf16x8 pa0, bf16x8 pa1, bf16x8 pa2, bf16x8 pa3) {
  const s16x4 l0 = tr_read<v_rd_off(D0, 0, 0)>(vb), h0 = tr_read<v_rd_off(D0, 0, 1)>(vb), l1 = tr_read<v_rd_off(D0, 1, 0)>(vb), h1 = tr_read<v_rd_off(D0, 1, 1)>(vb);
  const s16x4 l2 = tr_read<v_rd_off(D0, 2, 0)>(vb), h2 = tr_read<v_rd_off(D0, 2, 1)>(vb), l3 = tr_read<v_rd_off(D0, 3, 0)>(vb), h3 = tr_read<v_rd_off(D0, 3, 1)>(vb);
  asm volatile("s_waitcnt lgkmcnt(0)" ::: "memory"); SBAR();
#define PK(L, H) (bf16x8){L[0], L[1], L[2], L[3], H[0], H[1], H[2], H[3]}
  od = __builtin_amdgcn_mfma_f32_32x32x16_bf16(pa0, PK(l0, h0), od, 0, 0, 0);
  od = __builtin_amdgcn_mfma_f32_32x32x16_bf16(pa1, PK(l1, h1), od, 0, 0, 0);
  od = __builtin_amdgcn_mfma_f32_32x32x16_bf16(pa2, PK(l2, h2), od, 0, 0, 0);
  od = __builtin_amdgcn_mfma_f32_32x32x16_bf16(pa3, PK(l3, h3), od, 0, 0, 0);
#undef PK
}
template <int D0> __device__ __forceinline__ void pv_two(f32x16& oa, f32x16& ob, int vb, bf16x8 a0, bf16x8 a1, bf16x8 a2, bf16x8 a3, bf16x8 b0, bf16x8 b1, bf16x8 b2, bf16x8 b3) {
  const s16x4 l0 = tr_read<v_rd_off(D0, 0, 0)>(vb), h0 = tr_read<v_rd_off(D0, 0, 1)>(vb), l1 = tr_read<v_rd_off(D0, 1, 0)>(vb), h1 = tr_read<v_rd_off(D0, 1, 1)>(vb);
  const s16x4 l2 = tr_read<v_rd_off(D0, 2, 0)>(vb), h2 = tr_read<v_rd_off(D0, 2, 1)>(vb), l3 = tr_read<v_rd_off(D0, 3, 0)>(vb), h3 = tr_read<v_rd_off(D0, 3, 1)>(vb);
  asm volatile("s_waitcnt lgkmcnt(0)" ::: "memory"); SBAR();
#define PK(L, H) (bf16x8){L[0], L[1], L[2], L[3], H[0], H[1], H[2], H[3]}
  const bf16x8 v0 = PK(l0, h0), v1 = PK(l1, h1), v2 = PK(l2, h2), v3 = PK(l3, h3);
  oa = __builtin_amdgcn_mfma_f32_32x32x16_bf16(a0, v0, oa, 0, 0, 0);
  ob = __builtin_amdgcn_mfma_f32_32x32x16_bf16(b0, v0, ob, 0, 0, 0);
  oa = __builtin_amdgcn_mfma_f32_32x32x16_bf16(a1, v1, oa, 0, 0, 0);
  ob = __builtin_amdgcn_mfma_f32_32x32x16_bf16(b1, v1, ob, 0, 0, 0);
  oa = __builtin_amdgcn_mfma_f32_32x32x16_bf16(a2, v2, oa, 0, 0, 0);
  ob = __builtin_amdgcn_mfma_f32_32x32x16_bf16(b2, v2, ob, 0, 0, 0);
  oa = __builtin_amdgcn_mfma_f32_32x32x16_bf16(a3, v3, oa, 0, 0, 0);
  ob = __builtin_amdgcn_mfma_f32_32x32x16_bf16(b3, v3, ob, 0, 0, 0);
#undef PK
}
struct KQFrag { bf16x8 b0, b1, q; };
__device__ __forceinline__ void att_ldkq(KQFrag& f, const LAS unsigned char* l3, int akk, int akq) {
  const LAS unsigned char* kp = l3 + akk;
  f.b0 = *(const LAS bf16x8*)kp; f.b1 = *(const LAS bf16x8*)(kp + 8192); f.q = *(const LAS bf16x8*)(l3 + akq);
}
#define ATT_MF(pa_, pb_, f_) do { pa_ = __builtin_amdgcn_mfma_f32_32x32x16_bf16(f_.b0, f_.q, pa_, 0, 0, 0); pb_ = __builtin_amdgcn_mfma_f32_32x32x16_bf16(f_.b1, f_.q, pb_, 0, 0, 0); } while (0)
__device__ __forceinline__ void att_qk_all(f32x16& p0, f32x16& p1, f32x16& q0, f32x16& q1, KQFrag& f0, const LAS unsigned char* l3, int akk0, int akq0, float ia, float ib) {
  KQFrag f1;
#pragma unroll
  for (int r = 0; r < 16; ++r) { p0[r] = ia; p1[r] = ia; q0[r] = ib; q1[r] = ib; }
  att_ldkq(f1, l3, akk0 ^ (1 << 5), akq0 ^ (1 << 5)); ATT_MF(p0, p1, f0); SBAR();
  att_ldkq(f0, l3, akk0 ^ (2 << 5), akq0 ^ (2 << 5)); ATT_MF(p0, p1, f1); SBAR();
  att_ldkq(f1, l3, akk0 ^ (3 << 5), akq0 ^ (3 << 5)); ATT_MF(p0, p1, f0); SBAR();
  att_ldkq(f0, l3, akk0 ^ (4 << 5), akq0 ^ (4 << 5)); ATT_MF(p0, p1, f1); SBAR();
  att_ldkq(f1, l3, akk0 ^ (5 << 5), akq0 ^ (5 << 5)); ATT_MF(q0, q1, f0); SBAR();
  att_ldkq(f0, l3, akk0 ^ (6 << 5), akq0 ^ (6 << 5)); ATT_MF(q0, q1, f1); SBAR();
  att_ldkq(f1, l3, akk0 ^ (7 << 5), akq0 ^ (7 << 5)); ATT_MF(q0, q1, f0); SBAR();
  ATT_MF(q0, q1, f1); SBAR();
}
__device__ __forceinline__ void att_softmax(f32x16& p0, f32x16& p1, float& m_reg, float& l_reg, float& alpha, bool first, i32x8& pa) {
  alpha = 1.f;
  if (first) {
    float pmax = p0[0];
#pragma unroll
    for (int r = 1; r < 16; ++r) pmax = fmaxf(pmax, p0[r]);
#pragma unroll
    for (int r = 0; r < 16; ++r) pmax = fmaxf(pmax, p1[r]);
    { auto rr = __builtin_amdgcn_permlane32_swap(__float_as_uint(pmax), __float_as_uint(pmax), false, false);
      pmax = fmaxf(__uint_as_float(rr[0]), __uint_as_float(rr[1])); }
    alpha = 0.f; m_reg = pmax;
#pragma unroll
    for (int r = 0; r < 16; ++r) { p0[r] -= pmax; p1[r] -= pmax; }
  }
#pragma unroll
  for (int r = 0; r < 16; ++r) { p0[r] = __builtin_amdgcn_exp2f(p0[r]); p1[r] = __builtin_amdgcn_exp2f(p1[r]); }
  float ps;
  {
#define VADD(d_, a_, b_) asm("v_add_f32_e32 %0, %1, %2" : "=v"(d_) : "v"(a_), "v"(b_))
    float s0, s1, s2, s3;
    VADD(s0, p0[0], p0[1]); VADD(s1, p0[8], p0[9]); VADD(s2, p1[0], p1[1]); VADD(s3, p1[8], p1[9]);
#pragma unroll
    for (int r = 2; r < 8; ++r) { VADD(s0, s0, p0[r]); VADD(s1, s1, p0[8 + r]); VADD(s2, s2, p1[r]); VADD(s3, s3, p1[8 + r]); }
    VADD(s0, s0, s1); VADD(s2, s2, s3); VADD(ps, s0, s2);
#undef VADD
  }
  { auto rr = __builtin_amdgcn_permlane32_swap(__float_as_uint(ps), __float_as_uint(ps), false, false);
    ps = __uint_as_float(rr[0]) + __uint_as_float(rr[1]); }
  if (__builtin_expect(!first && __any(ps > 256.f), 0)) {
    float emax = p0[0];
#pragma unroll
    for (int r = 1; r < 16; ++r) emax = fmaxf(emax, p0[r]);
#pragma unroll
    for (int r = 0; r < 16; ++r) emax = fmaxf(emax, p1[r]);
    { auto rr = __builtin_amdgcn_permlane32_swap(__float_as_uint(emax), __float_as_uint(emax), false, false);
      emax = fmaxf(__uint_as_float(rr[0]), __uint_as_float(rr[1])); }
    const float delta = fmaxf(__builtin_amdgcn_logf(emax), 0.f);
    alpha = __builtin_amdgcn_exp2f(-delta); m_reg += delta;
#pragma unroll
    for (int r = 0; r < 16; ++r) { p0[r] *= alpha; p1[r] *= alpha; }
    ps *= alpha;
  }
  l_reg = l_reg * alpha + ps;
#pragma unroll
  for (int v = 0; v < 4; ++v) {
    int w0, w1; asm volatile("" : "=v"(w0), "=v"(w1));
    w0 = __builtin_amdgcn_cvt_pk_fp8_f32(p0[4 * v], p0[4 * v + 1], w0, false); w0 = __builtin_amdgcn_cvt_pk_fp8_f32(p0[4 * v + 2], p0[4 * v + 3], w0, true);
    w1 = __builtin_amdgcn_cvt_pk_fp8_f32(p1[4 * v], p1[4 * v + 1], w1, false); w1 = __builtin_amdgcn_cvt_pk_fp8_f32(p1[4 * v + 2], p1[4 * v + 3], w1, true);
    pa[v] = w0; pa[4 + v] = w1;
  }
}
__device__ __forceinline__ void att_unit(const unsigned char* __restrict__ Q8, const unsigned char* __restrict__ K8, const unsigned char* __restrict__ V8, bf16_t* __restrict__ Ob,
                                         int nkeys, float lam, const float* __restrict__ ng, float oscale, unsigned char* lds) {
  int tid_ = tidx(); asm volatile("" : "+v"(tid_)); const int tid = tid_, wid = tid >> 6, lane = tid & 63, r32 = lane & 31, hi = lane >> 5;
  const int grp = __builtin_amdgcn_readfirstlane(wid >> 2);
  unsigned char* V_lds = lds; unsigned char* K_lds = lds + 2 * ATT_SHM_V;
  float* wsl = (float*)(lds + 2 * ATT_SHM_V + 2 * ATT_SHM_K) + wid * 64; float* li_l = wsl; float* al_l = wsl + 32;
  float m0 = 0.f, l0 = 0.f, m1 = 0.f, l1 = 0.f;
  f32x16 o0[4] = {}, o1[4] = {};
  unsigned char* Q_lds = lds + 2 * ATT_SHM_V + 2 * ATT_SHM_K + 2048;
#pragma unroll
  for (int i = 0; i < 5; ++i) { const int piece = __builtin_amdgcn_readfirstlane(wid) + 8 * i;
    if (piece < 36) __builtin_amdgcn_global_load_lds((const unsigned*)(Q8 + piece * 1024 + lane * 16), (LAS unsigned*)(Q_lds + piece * 1024), 16, 0, 0); }
  const unsigned ldsw = (unsigned)__builtin_amdgcn_readfirstlane(wid) * 1024u;
#define GSTAGE_K(b, k0) do { const unsigned char* ki_ = K8 + (size_t)(k0) * QK8_PITCH + tid * 16; \
      __builtin_amdgcn_global_load_lds((const unsigned*)ki_, (LAS unsigned*)(K_lds + (b) * ATT_SHM_K + ldsw), 16, 0, 0); \
      if (wid < 1) __builtin_amdgcn_global_load_lds((const unsigned*)(ki_ + 8192), (LAS unsigned*)(K_lds + (b) * ATT_SHM_K + 8192 + ldsw), 16, 0, 0); } while (0)
#define GSTAGE_V(b, k0) do { const unsigned char* vi_ = V8 + (size_t)((k0) >> 6) * ATT_SHM_V + tid * 16; \
      __builtin_amdgcn_global_load_lds((const unsigned*)vi_, (LAS unsigned*)(V_lds + (b) * ATT_SHM_V + ldsw), 16, 0, 0); \
      if (wid < 2) __builtin_amdgcn_global_load_lds((const unsigned*)(vi_ + 8192), (LAS unsigned*)(V_lds + (b) * ATT_SHM_V + 8192 + ldsw), 16, 0, 0); } while (0)
#define STAGE_PAIR(jj) do { GSTAGE_V((jj) & 1, (jj) * 64); if ((jj) + 1 < NT) GSTAGE_K((jj) & 1, ((jj) + 1) * 64); } while (0)
#define RESC(o, a) do { if (__any((a) < 1.f)) { if (hi == 0) al_l[r32] = (a); asm volatile("s_waitcnt lgkmcnt(0)" ::: "memory"); \
    _Pragma("unroll") for (int d = 0; d < 4; ++d) _Pragma("unroll") for (int r = 0; r < 16; ++r) o[d][r] *= al_l[crow(r, hi)]; } } while (0)
#define ATT_BAR() do { asm volatile("s_waitcnt lgkmcnt(0)" ::: "memory"); __builtin_amdgcn_s_barrier(); asm volatile("" ::: "memory"); } while (0)
#define ATT_LDK(dst_, off_) do { const u32x4 x0_ = *(const LAS u32x4*)(kb_ + (off_)), x1_ = *(const LAS u32x4*)(kb_ + (off_) + 16); \
      dst_[0] = (int)x0_.x; dst_[1] = (int)x0_.y; dst_[2] = (int)x0_.z; dst_[3] = (int)x0_.w; dst_[4] = (int)x1_.x; dst_[5] = (int)x1_.y; dst_[6] = (int)x1_.z; dst_[7] = (int)x1_.w; } while (0)
#define ATT_SC(acc_, kf_, qf_) acc_ = __builtin_amdgcn_mfma_scale_f32_32x32x64_f8f6f4(kf_, qf_, acc_, 0, 0, 0, 0x7F7F7F7F, 0, 0x7F7F7F7F)
#define ATT_LDQ(dst_, off_) do { const u32x4 x0_ = *(const LAS u32x4*)(qb_ + (off_)), x1_ = *(const LAS u32x4*)(qb_ + (off_) + 16); \
      dst_[0] = (int)x0_.x; dst_[1] = (int)x0_.y; dst_[2] = (int)x0_.z; dst_[3] = (int)x0_.w; dst_[4] = (int)x1_.x; dst_[5] = (int)x1_.y; dst_[6] = (int)x1_.z; dst_[7] = (int)x1_.w; } while (0)
#define ATT_QK_ALL(ia_, ib_) do { _Pragma("unroll") for (int r = 0; r < 16; ++r) { p0[r] = (ia_); p1[r] = (ia_); q0[r] = (ib_); q1[r] = (ib_); } \
      ATT_SC(p0, kf0, qf); SBAR(); ATT_LDK(kf0, 32 * QK8_PITCH); SBAR(); \
      ATT_SC(p1, kf0, qf); SBAR(); ATT_LDK(kf0, 64); ATT_LDQ(qf, 64); SBAR(); \
      ATT_SC(q0, kf0, qf); SBAR(); ATT_LDK(kf0, 32 * QK8_PITCH + 64); SBAR(); \
      ATT_SC(q1, kf0, qf); SBAR(); } while (0)
  const int NT = nkeys / 64;
  GSTAGE_K(1, 0); STAGE_PAIR(0);
  asm volatile("s_waitcnt vmcnt(0)" ::: "memory"); __syncthreads();
  f32x16 p0, p1, q0, q1; i32x8 pa, pb;
  const LAS unsigned char* l3 = (const LAS unsigned char*)lds;
  const int kofs0 = 2 * ATT_SHM_V + r32 * QK8_PITCH + hi * 32;
  const int qofs0 = 2 * ATT_SHM_V + 2 * ATT_SHM_K + 2048 + (__builtin_amdgcn_readfirstlane(wid) * 32 + r32) * QK8_PITCH + hi * 32;
  { i32x8 kf0, qf; const LAS unsigned char* kb_ = l3 + (kofs0 + ATT_SHM_K); const LAS unsigned char* qb_ = l3 + qofs0;
    ATT_LDK(kf0, 0); ATT_LDQ(qf, 0);
    ATT_QK_ALL(0.f, 0.f); }
  if (grp) ATT_BAR();
#pragma unroll 1
  for (int j = 0; j < NT; ++j) {
    const int cur = j & 1;
    const bool more = (j + 1 < NT);
    if (grp && more) STAGE_PAIR(j + 1);
    { float alphaA, alphaB;
      const bool first = (j == 0);
      att_softmax(p0, p1, m0, l0, alphaA, first, pa); SBAR();
      att_softmax(q0, q1, m1, l1, alphaB, first, pb); SBAR();
      RESC(o0, alphaA);
      RESC(o1, alphaB); }
    asm volatile("" : "+v"(pa), "+v"(pb), "+v"(m0), "+v"(l0), "+v"(m1), "+v"(l1));
    asm volatile("" : "+v"(o0[0]), "+v"(o0[1]), "+v"(o0[2]), "+v"(o0[3]), "+v"(o1[0]), "+v"(o1[1]), "+v"(o1[2]), "+v"(o1[3]));
    if (!grp) asm volatile("s_waitcnt vmcnt(0)" ::: "memory");
    ATT_BAR();
    if (!grp && more) STAGE_PAIR(j + 1);
    __builtin_amdgcn_s_setprio(1);
    {
      int kofs = kofs0, qofs = qofs0; asm volatile("" : "+v"(kofs), "+v"(qofs));
      const LAS unsigned char* kb_ = l3 + (kofs + cur * ATT_SHM_K); const LAS unsigned char* qb_ = l3 + qofs;
      i32x8 kf0, qf;
      const LAS unsigned char* vrow = l3 + (r32 * 80 + hi * 32 + cur * ATT_SHM_V);
      u32x4 va0 = *(const LAS u32x4*)vrow, va1 = *(const LAS u32x4*)(vrow + 16), vb0, vb1;
#define ATT_PV(d0_, x0_, x1_) do { i32x8 bv; bv[0] = (int)x0_.x; bv[1] = (int)x0_.y; bv[2] = (int)x0_.z; bv[3] = (int)x0_.w; bv[4] = (int)x1_.x; bv[5] = (int)x1_.y; bv[6] = (int)x1_.z; bv[7] = (int)x1_.w; \
        o0[d0_] = __builtin_amdgcn_mfma_scale_f32_32x32x64_f8f6f4(pa, bv, o0[d0_], 0, 0, 0, 0x7F7F7F7F, 0, 0x7F7F7F7F); \
        o1[d0_] = __builtin_amdgcn_mfma_scale_f32_32x32x64_f8f6f4(pb, bv, o1[d0_], 0, 0, 0, 0x7F7F7F7F, 0, 0x7F7F7F7F); } while (0)
      vb0 = *(const LAS u32x4*)(vrow + 32 * 80); vb1 = *(const LAS u32x4*)(vrow + 32 * 80 + 16); ATT_PV(0, va0, va1); SBAR();
      va0 = *(const LAS u32x4*)(vrow + 64 * 80); va1 = *(const LAS u32x4*)(vrow + 64 * 80 + 16); ATT_PV(1, vb0, vb1); SBAR();
      vb0 = *(const LAS u32x4*)(vrow + 96 * 80); vb1 = *(const LAS u32x4*)(vrow + 96 * 80 + 16); ATT_PV(2, va0, va1); SBAR();
      ATT_LDK(kf0, 0); ATT_LDQ(qf, 0);
      ATT_PV(3, vb0, vb1); SBAR();
#undef ATT_PV
      asm volatile("" : "+v"(o0[0]), "+v"(o0[1]), "+v"(o0[2]), "+v"(o0[3]), "+v"(o1[0]), "+v"(o1[1]), "+v"(o1[2]), "+v"(o1[3]));
      ATT_QK_ALL(-m0, -m1);
      asm volatile("" : "+v"(p0), "+v"(p1), "+v"(q0), "+v"(q1));
    }
    __builtin_amdgcn_s_setprio(0);
    if (grp) asm volatile("s_waitcnt vmcnt(0)" ::: "memory");
    ATT_BAR();
  }
  if (!grp) ATT_BAR();
  if (hi == 0) { li_l[r32] = 1.f / l0; al_l[r32] = lam / l1; }
  asm volatile("s_waitcnt lgkmcnt(0)" ::: "memory");
  float ss[16];
#pragma unroll
  for (int r = 0; r < 16; ++r) {
    const float a = li_l[crow(r, hi)], bq = al_l[crow(r, hi)];
    float s = 0.f;
#pragma unroll
    for (int d = 0; d < 4; ++d) { const float v = o0[d][r] * a - o1[d][r] * bq; o0[d][r] = v; s += v * v; }
    s += dpp_mov<0xB1>(s); s += dpp_mov<0x4E>(s); s += dpp_mov<0x141>(s); s += dpp_mov<0x140>(s);
    { auto rr_ = __builtin_amdgcn_permlane16_swap(__float_as_uint(s), __float_as_uint(s), false, false); s = __uint_as_float(rr_[0]) + __uint_as_float(rr_[1]); }
    ss[r] = rsqrtf(s * (1.f / 128.f) + EPS) * oscale;
  }
  bf16_t* Ow = Ob + (size_t)(wid * 32) * DM;
#pragma unroll
  for (int d = 0; d < 4; ++d) {
    const float g = ng[d * 32 + r32];
#pragma unroll
    for (int r = 0; r < 16; ++r) Ow[(size_t)crow(r, hi) * DM + d * 32 + r32] = (ABL & 4) ? (bf16_t)0 : (bf16_t)(cvtpk(o0[d][r] * ss[r] * g, 0.f) & 0xffffu);
  }
  __syncthreads();
#undef ATT_LDK
#undef ATT_LDQ
#undef ATT_SC
#undef ATT_QK_ALL
#undef GSTAGE_K
#undef GSTAGE_V
#undef STAGE_PAIR
#undef RESC
#undef ATT_BAR
}

__device__ __forceinline__ float ins16(float (&a)[16], float x) {
#pragma unroll
  for (int i = 0; i < 16; ++i) { const float h = fmaxf(a[i], x); x = fminf(a[i], x); a[i] = h; }
  return x;
}
__device__ __forceinline__ void bsort16(float (&a)[16]) {
#pragma unroll
  for (int k = 2; k <= 16; k <<= 1)
#pragma unroll
    for (int j = k >> 1; j > 0; j >>= 1)
#pragma unroll
      for (int i = 0; i < 16; ++i) {
        const int q = i ^ j;
        if (q > i) {
          const bool desc = ((i & k) == 0);
          const float hi_ = fmaxf(a[i], a[q]), lo_ = fminf(a[i], a[q]);
          a[i] = desc ? hi_ : lo_; a[q] = desc ? lo_ : hi_;
        }
      }
}
__device__ __forceinline__ void bmerge16(float (&a)[16], const float (&b)[16]) {
#pragma unroll
  for (int i = 0; i < 16; ++i) a[i] = fmaxf(a[i], b[15 - i]);
#pragma unroll
  for (int j = 8; j > 0; j >>= 1)
#pragma unroll
    for (int i = 0; i < 16; ++i) {
      const int q = i ^ j;
      if (q > i) { const float hi_ = fmaxf(a[i], a[q]), lo_ = fminf(a[i], a[q]); a[i] = hi_; a[q] = lo_; }
    }
}
__device__ __forceinline__ float gelu_erf(float x) { return 0.5f * x * (1.f + erff(x * 0.70710678118654752440f)); }
#define XB_TMO      128
#define XB_XCNT(j)  (256  + 64 * (j))
#define XB_XSUB(j)  (1280 + 64 * (j))
#define XB_XGEN(j)  (2304 + 64 * (j))
#define XB_TOP      3328
#define XB_TOPGEN   3392
#define XCD_BAR_WORDS 3456
#define XB_SPIN_CAP (1u << 22)
__device__ __forceinline__ unsigned xb_ld(unsigned* p)              { return __hip_atomic_load(p, __ATOMIC_RELAXED, __HIP_MEMORY_SCOPE_AGENT); }
__device__ __forceinline__ unsigned xb_add(unsigned* p, unsigned v) { return __hip_atomic_fetch_add(p, v, __ATOMIC_RELAXED, __HIP_MEMORY_SCOPE_AGENT); }
__device__ __forceinline__ unsigned xb_xcc_id() { return (unsigned)__builtin_amdgcn_s_getreg((3 << 11) | 20) & 0xFu; }
#define XB_SPIN(cond, bar) do { unsigned _sp = 0; while (cond) { __builtin_amdgcn_s_sleep(1); \
    if ((++_sp & 255u) == 0u) { if (xb_ld(&(bar)[XB_TMO])) break; if (_sp > XB_SPIN_CAP) { atomicAdd(&(bar)[XB_TMO], 1u); break; } } } } while (0)
struct XcdBarrier { unsigned* bar; unsigned x; volatile LAS unsigned* st; };
__device__ __forceinline__ XcdBarrier xcd_barrier_post(unsigned* bar, volatile LAS unsigned* st) {
  XcdBarrier b; b.bar = bar; b.x = xb_xcc_id(); b.st = st;
  if (tidx() == 0) (void)xb_add(&bar[XB_XCNT(b.x)], 1u);
  return b;
}
__device__ __forceinline__ void xcd_barrier_complete(unsigned* bar, unsigned x, unsigned& nloc, unsigned& nx) {
  const unsigned G = gridDim.x * gridDim.y * gridDim.z;
  unsigned sum, cnt, mine, sp = 0u;
  for (;;) {
    sum = 0u; cnt = 0u; mine = 0u;
#pragma unroll
    for (unsigned j = 0; j < 16; ++j) { const unsigned c = xb_ld(&bar[XB_XCNT(j)]); sum += c; cnt += (c > 0u) ? 1u : 0u; mine = (j == x) ? c : mine; }
    if (sum == G) break;
    __builtin_amdgcn_s_sleep(1);
    if ((++sp & 255u) == 0u) { if (xb_ld(&bar[XB_TMO])) break; if (sp > XB_SPIN_CAP) { atomicAdd(&bar[XB_TMO], 1u); break; } }
  }
  nloc = mine > 0u ? mine : 1u; nx = cnt > 0u ? cnt : 1u;
}
__device__ __forceinline__ void xcd_barrier(const XcdBarrier& b) {
  asm volatile("s_waitcnt vmcnt(0)" ::: "memory");
  __syncthreads();
  if (tidx() == 0) {
    unsigned* bar = b.bar;
    __builtin_amdgcn_s_waitcnt(0);
    unsigned nloc = b.st[0], nx = b.st[1];
    if (nloc == 0u) { xcd_barrier_complete(bar, b.x, nloc, nx); b.st[0] = nloc; b.st[1] = nx; }
    const unsigned old = xb_add(&bar[XB_XSUB(b.x)], 1u);
    const unsigned gen = old / nloc;
    if (old + 1u == (gen + 1u) * nloc) {
      __builtin_amdgcn_fence(__ATOMIC_RELEASE, "agent");
      asm volatile("s_waitcnt vmcnt(0)" ::: "memory");
      const unsigned og = xb_add(&bar[XB_TOP], 1u);
      const unsigned tg = og / nx;
      if (og + 1u == (tg + 1u) * nx) xb_add(&bar[XB_TOPGEN], 1u);
      else XB_SPIN(xb_ld(&bar[XB_TOPGEN]) == tg, bar);
      __builtin_amdgcn_fence(__ATOMIC_ACQUIRE, "agent");
      xb_add(&bar[XB_XGEN(b.x)], 1u);
      asm volatile("s_waitcnt vmcnt(0)" ::: "memory");
    } else {
      XB_SPIN(xb_ld(&bar[XB_XGEN(b.x)]) == gen, bar);
      __builtin_amdgcn_fence(__ATOMIC_ACQUIRE, "agent");
      asm volatile("s_waitcnt vmcnt(0)" ::: "memory");
    }
  }
  __syncthreads();
}

constexpr size_t RT_STRIDE = (size_t)T * 128 * 4;
__device__ __forceinline__ void route_unit(const Params& p, int l, int unit, unsigned char* lds) {
  int tid_ = tidx(); asm volatile("" : "+v"(tid_)); const int tid = tid_, lane = tid & 63, wid = tid >> 6, r32 = lane & 31, hi = lane >> 5;
  unsigned char* IDX = lds;
  int* UE = (int*)(lds + 8192); float* UG = (float*)(lds + 8192 + 16384); float* US = (float*)(lds + 8192 + 32768);
  int* EIDG = (int*)(p.ws + WS_EID + (size_t)l * RT_STRIDE); float* GWG = (float*)(p.ws + WS_ULOC + RT_STRIDE); float* SUG = (float*)(p.ws + WS_ULOC + 2 * RT_STRIDE);
  const float* PSC = (const float*)(p.ws + WS_PSC);
  const int row0 = unit * 32;
  const bf16_t* QP = (const bf16_t*)(p.ws + WS_PROJ);
  const bf16_t* KEYS = (const bf16_t*)(p.ws + WS_KEYS) + (size_t)l * 131072;
  for (int rrep = 0; rrep < REP_ROUTE; ++rrep) {
    const int h = wid;
    float top[2][16];
#pragma unroll
    for (int pp = 0; pp < 2; ++pp) {
      const bf16_t* qrow = QP + (size_t)(row0 + r32) * DM + h * 128 + pp * 64 + hi * 8;
      const bf16_t* kb = KEYS + ((size_t)(h * 2 + pp) * 128 + r32) * 64 + hi * 8;
      bf16x8 bq[4];
#pragma unroll
      for (int ks = 0; ks < 4; ++ks) bq[ks] = *(const bf16x8*)(qrow + ks * 16);
      float (&lst)[16] = top[pp];
#pragma unroll
      for (int i = 0; i < 16; ++i) lst[i] = -INFINITY;
#pragma unroll
      for (int nt = 0; nt < 4; ++nt) {
        f32x16 acc = {};
#pragma unroll
        for (int ks = 0; ks < 4; ++ks) {
          const bf16x8 ak = *(const bf16x8*)(kb + (size_t)nt * 32 * 64 + ks * 16);
          acc = __builtin_amdgcn_mfma_f32_32x32x16_bf16(ak, bq[ks], acc, 0, 0, 0);
        }
        float grp[16];
#pragma unroll
        for (int r = 0; r < 16; ++r) grp[r] = __uint_as_float((__float_as_uint(acc[r]) & ~0x7Fu) | (unsigned)(nt * 32 + crow(r, hi)));
        bsort16(grp);
        if (nt == 0) {
#pragma unroll
          for (int i = 0; i < 16; ++i) lst[i] = grp[i];
        } else bmerge16(lst, grp);
        SBAR();
      }
      float oth[16];
#pragma unroll
      for (int i = 0; i < 16; ++i) { auto rr_ = __builtin_amdgcn_permlane32_swap(__float_as_uint(lst[i]), __float_as_uint(lst[i]), false, false); oth[i] = __uint_as_float(hi ? rr_[0] : rr_[1]); }
      bmerge16(lst, oth);
      if (hi == 0) {
        unsigned w[4];
#pragma unroll
        for (int i = 0; i < 4; ++i)
          w[i] = (__float_as_uint(lst[4 * i]) & 0x7Fu) | ((__float_as_uint(lst[4 * i + 1]) & 0x7Fu) << 8) | ((__float_as_uint(lst[4 * i + 2]) & 0x7Fu) << 16) | ((__float_as_uint(lst[4 * i + 3]) & 0x7Fu) << 24);
        *(u32x4*)(IDX + ((r32 * 8 + h) * 2 + pp) * 16) = (u32x4){w[0], w[1], w[2], w[3]};
      }
    }
    float best[16];
#define CAND(i, j) __uint_as_float((__float_as_uint(__uint_as_float(__float_as_uint(top[0][i]) & ~0x7Fu) + __uint_as_float(__float_as_uint(top[1][j]) & ~0x7Fu)) & ~0xFFu) | (unsigned)((i) * 16 + (j)))
    {
#pragma unroll
      for (int j = 0; j < 16; ++j) best[j] = CAND(0, j);
      float y[16];
#pragma unroll
      for (int j = 0; j < 8; ++j) { y[j] = CAND(1, j); y[8 + j] = CAND(15 - j, 0); }
#pragma unroll
      for (int jj = 8; jj > 0; jj >>= 1)
#pragma unroll
        for (int i = 0; i < 16; ++i) { const int q = i ^ jj; if (q > i) { const float hi_ = fmaxf(y[i], y[q]), lo_ = fminf(y[i], y[q]); y[i] = hi_; y[q] = lo_; } }
      bmerge16(best, y);
      float x[16];
      x[0] = CAND(2, 0); x[1] = CAND(2, 1); x[2] = CAND(2, 2); x[3] = CAND(2, 3); x[4] = CAND(2, 4);
      x[5] = CAND(3, 0); x[6] = CAND(3, 1); x[7] = CAND(3, 2); x[8] = CAND(3, 3);
      x[9] = CAND(4, 0); x[10] = CAND(4, 1); x[11] = CAND(4, 2);
      x[12] = CAND(5, 0); x[13] = CAND(5, 1); x[14] = CAND(6, 0); x[15] = CAND(6, 1);
      bsort16(x);
      bmerge16(best, x);
      ins16(best, CAND(7, 0)); ins16(best, CAND(7, 1));
    }
#undef CAND
    asm volatile("s_waitcnt lgkmcnt(0)" ::: "memory");
    if (hi == 0) {
      const unsigned char* ib = IDX + ((r32 * 8 + h) * 2) * 16;
      const float mx = __uint_as_float(__float_as_uint(best[0]) & ~0xFFu);
      float w[16]; float sum = 0.f;
#pragma unroll
      for (int k = 0; k < 16; ++k) { w[k] = __expf(__uint_as_float(__float_as_uint(best[k]) & ~0xFFu) - mx); sum += w[k]; }
      const float rsum = 1.f / sum;
      int ee[16]; float su_[16], sv_[16];
#pragma unroll
      for (int k = 0; k < 16; ++k) {
        const unsigned ij = __float_as_uint(best[k]) & 0xFFu;
        ee[k] = (int)ib[ij >> 4] * 128 + (int)ib[16 + (ij & 15)];
      }
#pragma unroll
      for (int k = 0; k < 16; ++k) { su_[k] = PSC[(size_t)l * NEXP + ee[k]]; sv_[k] = PSC[(size_t)(DEPTH + l) * NEXP + ee[k]]; }
#pragma unroll
      for (int k = 0; k < 16; ++k) {
        UE[r32 * 128 + h * 16 + k] = ee[k]; UG[r32 * 128 + h * 16 + k] = w[k] * rsum * sv_[k];
        US[r32 * 128 + h * 16 + k] = su_[k];
      }
    }
  }
  __syncthreads();
#pragma unroll 1
  for (int tt = 0; tt < 4; ++tt) {
    const int t = wid * 4 + tt;
    const int k0 = UE[t * 128 + lane], k1 = UE[t * 128 + 64 + lane];
    const float g0 = UG[t * 128 + lane], g1 = UG[t * 128 + 64 + lane], s0 = US[t * 128 + lane], s1 = US[t * 128 + 64 + lane];
    const int b0 = k0 >> 10, b1 = k1 >> 10;
    int base = 0, pos0 = 0, pos1 = 0;
#pragma unroll
    for (int b = 0; b < 16; ++b) {
      const unsigned long long m0 = __ballot(b0 == b), m1 = __ballot(b1 == b);
      const int c0 = __popcll(m0), c1 = __popcll(m1);
      const unsigned long long lt = (1ull << lane) - 1ull;
      if (b0 == b) pos0 = base + __popcll(m0 & lt);
      if (b1 == b) pos1 = base + c0 + __popcll(m1 & lt);
      base += c0 + c1;
    }
    const size_t ro = (size_t)(row0 + t) * 128;
    EIDG[ro + pos0] = k0; GWG[ro + pos0] = g0; SUG[ro + pos0] = s0;
    EIDG[ro + pos1] = k1; GWG[ro + pos1] = g1; SUG[ro + pos1] = s1;
  }
}
#define CAS __attribute__((address_space(4)))
typedef int i32x8 __attribute__((ext_vector_type(8)));
struct TokPref { f32x2 gs0, gs1; u32x4 hA, hB; };
struct RowPipe { i32x6 uq[4], vq[4]; i32x8 Ec; };
__device__ __forceinline__ const CAS i32x8* eid_row(const CAS unsigned char* eidg, int row) {
  return (const CAS i32x8*)(eidg + (size_t)(unsigned)__builtin_amdgcn_readfirstlane(row) * 512u);
}
__device__ __forceinline__ void tok_prefetch(const Params& p, int row, int lane, TokPref& t) {
  const float* GWG = (const float*)(p.ws + WS_ULOC + RT_STRIDE) + (size_t)row * 128;
  const float* SUG = (const float*)(p.ws + WS_ULOC + 2 * RT_STRIDE) + (size_t)row * 128;
  const bf16_t* H = (const bf16_t*)(p.ws + WS_H);
  t.gs0 = f32x2{GWG[lane], SUG[lane]}; t.gs1 = f32x2{GWG[64 + lane], SUG[64 + lane]};
  t.hA = *(const u32x4*)(H + (size_t)row * DM + lane * 16); t.hB = *(const u32x4*)(H + (size_t)row * DM + lane * 16 + 8);
}
#define LOADPAIR(dst_, tofs_, ea_, eb_) do { const u32x3v a_ = __builtin_amdgcn_raw_buffer_load_b96(rsT, lane12, (ea_) * PROW + (tofs_), 0); const unsigned b0_ = __builtin_amdgcn_raw_buffer_load_b32(rsT, lane12, (eb_) * PROW + (tofs_), 0); \
      const u32x2v b1_ = __builtin_amdgcn_raw_buffer_load_b64(rsT, lane12 + 4, (eb_) * PROW + (tofs_), 0); \
      dst_[0] = (int)a_.x; dst_[1] = (int)a_.y; dst_[2] = (int)a_.z; dst_[3] = (int)b0_; dst_[4] = (int)b1_.x; dst_[5] = (int)b1_.y; } while (0)
#define LOADGROUP(q_, tofs_, E_) do { LOADPAIR(q_[0], tofs_, E_[0], E_[1]); LOADPAIR(q_[1], tofs_, E_[2], E_[3]); LOADPAIR(q_[2], tofs_, E_[4], E_[5]); LOADPAIR(q_[3], tofs_, E_[6], E_[7]); } while (0)
constexpr int VOFS = (int)(WS_PV - WS_PU);
__device__ __forceinline__ void gather_token(const Params& p, const CAS unsigned char* eidg, const __amdgpu_buffer_rsrc_t rsT, int l, int row, int nextrow, TokPref& tp, RowPipe& rp, unsigned char* lds, int lane, int wid) {
  f32x2* GS = (f32x2*)(lds + wid * 2048);
  float* XC = (float*)(p.ws + WS_XCUR);
  const float* MOD = (const float*)(p.ws + WS_MOD);
  const CAS i32x8* EP = eid_row(eidg, row);
  const bool hasnext = nextrow >= 0;
  const CAS i32x8* EPn = eid_row(eidg, hasnext ? nextrow : row);
  GS[lane] = tp.gs0; GS[64 + lane] = tp.gs1;
  asm volatile("s_waitcnt lgkmcnt(0)" ::: "memory");
  const int eofl = ((lane >> 5) & 1) + 2 * ((lane >> 4) & 1) + 4 * ((lane >> 3) & 1);
  const int lane12 = lane * 12;
  {
    h16x2 hh[8];
    {
      const u32x4 hA = tp.hA, hB = tp.hB;
      hh[0] = __builtin_bit_cast(h16x2, __builtin_amdgcn_cvt_pkrtz(bflo(hA.x), bfhi(hA.x))); hh[1] = __builtin_bit_cast(h16x2, __builtin_amdgcn_cvt_pkrtz(bflo(hA.y), bfhi(hA.y))); hh[2] = __builtin_bit_cast(h16x2, __builtin_amdgcn_cvt_pkrtz(bflo(hA.z), bfhi(hA.z))); hh[3] = __builtin_bit_cast(h16x2, __builtin_amdgcn_cvt_pkrtz(bflo(hA.w), bfhi(hA.w)));
      hh[4] = __builtin_bit_cast(h16x2, __builtin_amdgcn_cvt_pkrtz(bflo(hB.x), bfhi(hB.x))); hh[5] = __builtin_bit_cast(h16x2, __builtin_amdgcn_cvt_pkrtz(bflo(hB.y), bfhi(hB.y))); hh[6] = __builtin_bit_cast(h16x2, __builtin_amdgcn_cvt_pkrtz(bflo(hB.z), bfhi(hB.z))); hh[7] = __builtin_bit_cast(h16x2, __builtin_amdgcn_cvt_pkrtz(bflo(hB.w), bfhi(hB.w)));
    }
    if (hasnext) tok_prefetch(p, nextrow, lane, tp);
    f32x4 xpre[4];
    { const float* xr_ = XC + (size_t)row * DM + lane * 16;
#pragma unroll
      for (int v4 = 0; v4 < 4; ++v4) xpre[v4] = *(const f32x4*)(xr_ + v4 * 4); }
    f32x2 acc2[8];
#pragma unroll
    for (int i = 0; i < 8; ++i) acc2[i] = f32x2{0.f, 0.f};
#pragma unroll 1
    for (int g8 = 0; g8 < 16; ++g8) {
      const bool pf = (g8 < 15) || hasnext;
      const f32x2 gs = GS[g8 * 8 + eofl];
      float d[8];
#pragma unroll
      for (int i2 = 0; i2 < 4; ++i2) {
        const h16x32 r = __builtin_amdgcn_cvt_scalef32_pk32_f16_fp6(rp.uq[i2], 1.0f);
        float a0 = 0.f, a1 = 0.f, b0 = 0.f, b1 = 0.f;
#define UDOT(k_) a0 = __builtin_amdgcn_fdot2(__builtin_shufflevector(r, r, 4 * (k_), 4 * (k_) + 1), hh[2 * (k_)], a0, false); b0 = __builtin_amdgcn_fdot2(__builtin_shufflevector(r, r, 16 + 4 * (k_), 17 + 4 * (k_)), hh[2 * (k_)], b0, false); \
        a1 = __builtin_amdgcn_fdot2(__builtin_shufflevector(r, r, 4 * (k_) + 2, 4 * (k_) + 3), hh[2 * (k_) + 1], a1, false); b1 = __builtin_amdgcn_fdot2(__builtin_shufflevector(r, r, 18 + 4 * (k_), 19 + 4 * (k_)), hh[2 * (k_) + 1], b1, false);
        UDOT(0) UDOT(1) UDOT(2) UDOT(3)
#undef UDOT
        d[2 * i2] = a0 + a1;
        d[2 * i2 + 1] = b0 + b1;
        asm volatile("" : "+v"(d[2 * i2]), "+v"(d[2 * i2 + 1]));
      }
      if (pf) LOADGROUP(rp.uq, 0, rp.Ec);
      float tot;
      {
        auto s01 = __builtin_amdgcn_permlane32_swap(__float_as_uint(d[0]), __float_as_uint(d[1]), false, false);
        auto s23 = __builtin_amdgcn_permlane32_swap(__float_as_uint(d[2]), __float_as_uint(d[3]), false, false);
        auto s45 = __builtin_amdgcn_permlane32_swap(__float_as_uint(d[4]), __float_as_uint(d[5]), false, false);
        auto s67 = __builtin_amdgcn_permlane32_swap(__float_as_uint(d[6]), __float_as_uint(d[7]), false, false);
        const float q01 = __uint_as_float(s01[0]) + __uint_as_float(s01[1]), q23 = __uint_as_float(s23[0]) + __uint_as_float(s23[1]);
        const float q45 = __uint_as_float(s45[0]) + __uint_as_float(s45[1]), q67 = __uint_as_float(s67[0]) + __uint_as_float(s67[1]);
        auto ta = __builtin_amdgcn_permlane16_swap(__float_as_uint(q01), __float_as_uint(q23), false, false);
        auto tb = __builtin_amdgcn_permlane16_swap(__float_as_uint(q45), __float_as_uint(q67), false, false);
        const float r0123 = __uint_as_float(ta[0]) + __uint_as_float(ta[1]);
        const float r4567 = __uint_as_float(tb[0]) + __uint_as_float(tb[1]);
        const bool b3 = (lane & 8) != 0;
        const float keep = b3 ? r4567 : r0123, send = b3 ? r0123 : r4567;
        float x = keep + dpp_mov<0x140>(send);
        x += dpp_mov<0xB1>(x); x += dpp_mov<0x4E>(x); x += dpp_mov<0x141>(x);
        tot = x * gs.y;
      }
      float ge;
      {
        const float v = tot, av = fabsf(v), tq = __builtin_amdgcn_rcpf(av * 0.2316418882f + 1.0f);
        float q = tq * 0.5307027145f + (-0.7265760135f); q = q * tq + 0.7107068705f; q = q * tq + (-0.142248368f); q = q * tq + 0.127414796f; q = q * tq;
        const float ex = __builtin_amdgcn_exp2f(v * v * (-0.72134752044f));
        const float m = v * (q * ex), r = v - m;
        ge = (v < 0.f ? m : r) * gs.x;
      }
      unsigned cw[8];
      { const unsigned gp = __builtin_bit_cast(unsigned, __builtin_amdgcn_cvt_pkrtz(ge * 1024.f, ge * 1024.f));
        cw[0] = (unsigned)__builtin_amdgcn_readlane((int)gp, 0);  cw[4] = (unsigned)__builtin_amdgcn_readlane((int)gp, 8);
        cw[2] = (unsigned)__builtin_amdgcn_readlane((int)gp, 16); cw[6] = (unsigned)__builtin_amdgcn_readlane((int)gp, 24);
        cw[1] = (unsigned)__builtin_amdgcn_readlane((int)gp, 32); cw[5] = (unsigned)__builtin_amdgcn_readlane((int)gp, 40);
        cw[3] = (unsigned)__builtin_amdgcn_readlane((int)gp, 48); cw[7] = (unsigned)__builtin_amdgcn_readlane((int)gp, 56); }
      h16x2 a16[8];
#pragma unroll
      for (int i2 = 0; i2 < 4; ++i2) {
        const h16x32 r = __builtin_amdgcn_cvt_scalef32_pk32_f16_fp6(rp.vq[i2], 1.0f);
        const h16x2 ca = __builtin_bit_cast(h16x2, cw[2 * i2]), cb = __builtin_bit_cast(h16x2, cw[2 * i2 + 1]);
#define VAXL(k_) a16[k_] = (i2 == 0) ? ca * __builtin_shufflevector(r, r, 2 * (k_), 2 * (k_) + 1) : ca * __builtin_shufflevector(r, r, 2 * (k_), 2 * (k_) + 1) + a16[k_];
#define VAXH(k_) a16[k_] = cb * __builtin_shufflevector(r, r, 16 + 2 * (k_), 17 + 2 * (k_)) + a16[k_];
        VAXL(0) VAXL(1) VAXL(2) VAXL(3) VAXL(4) VAXL(5) VAXL(6) VAXL(7)
        asm volatile("" : "+v"(a16[0]), "+v"(a16[1]), "+v"(a16[2]), "+v"(a16[3]), "+v"(a16[4]), "+v"(a16[5]), "+v"(a16[6]), "+v"(a16[7]));
        VAXH(0) VAXH(1) VAXH(2) VAXH(3) VAXH(4) VAXH(5) VAXH(6) VAXH(7)
#undef VAXL
#undef VAXH
        asm volatile("" : "+v"(a16[0]), "+v"(a16[1]), "+v"(a16[2]), "+v"(a16[3]), "+v"(a16[4]), "+v"(a16[5]), "+v"(a16[6]), "+v"(a16[7]));
      }
#pragma unroll
      for (int k = 0; k < 8; ++k) acc2[k] = f32x2{(float)a16[k].x, (float)a16[k].y} * f32x2{1.f / 1024.f, 1.f / 1024.f} + acc2[k];
      if (pf) LOADGROUP(rp.vq, VOFS, rp.Ec);
      { const CAS i32x8* src_ = g8 < 14 ? EP + (g8 + 2) : EPn + (g8 - 14); rp.Ec = *src_; }
    }
    SBAR();
    float acc[16];
#pragma unroll
    for (int i = 0; i < 8; ++i) { acc[2 * i] = acc2[i].x; acc[2 * i + 1] = acc2[i].y; }
    const int mr = mod_row(row);
    const float* g2 = MOD + ((size_t)l * 5 + mr) * 6144 + 5 * 1024;
    float* xr = XC + (size_t)row * DM;
    float xn[16]; float ssq = 0.f;
    if (ABL & 8) {
#pragma unroll
      for (int i = 0; i < 16; ++i) acc[i] = 0.f;
    }
#pragma unroll
    for (int v4 = 0; v4 < 4; ++v4) {
      const int c = lane * 16 + v4 * 4;
      const f32x4 xo = xpre[v4], gg = *(const f32x4*)(g2 + c);
      f32x4 o;
      o.x = xo.x + gg.x * acc[v4 * 4 + 0]; o.y = xo.y + gg.y * acc[v4 * 4 + 1]; o.z = xo.z + gg.z * acc[v4 * 4 + 2]; o.w = xo.w + gg.w * acc[v4 * 4 + 3];
      xn[v4 * 4 + 0] = o.x; xn[v4 * 4 + 1] = o.y; xn[v4 * 4 + 2] = o.z; xn[v4 * 4 + 3] = o.w;
      ssq += (o.x * o.x + o.y * o.y) + (o.z * o.z + o.w * o.w);
      if (l < DEPTH - 1) *(f32x4*)(xr + c) = o;
    }
    const float rs = rsqrtf(wave_sum_fast(ssq) * (1.f / DM) + EPS);
    if (l == DEPTH - 1) {
      const int b = row / SEGL, s = row - b * SEGL;
      float* orow = p.out + ((size_t)(b * SEQ + (s - CTXL))) * DM;
      const float* fg = p.in[I_FINALG];
#pragma unroll
      for (int v4 = 0; v4 < 4; ++v4) {
        const int c = lane * 16 + v4 * 4;
        const f32x4 gg = *(const f32x4*)(fg + c);
        f32x4 o; o.x = xn[v4 * 4 + 0] * rs * gg.x; o.y = xn[v4 * 4 + 1] * rs * gg.y; o.z = xn[v4 * 4 + 2] * rs * gg.z; o.w = xn[v4 * 4 + 3] * rs * gg.w;
        *(f32x4*)(orow + c) = o;
      }
    } else {
      const float* m = MOD + ((size_t)(l + 1) * 5 + mr) * 6144;
      const float* ng = p.in[I_N1G] + (l + 1) * DM;
      bf16_t* hrow = (bf16_t*)(p.ws + WS_H) + (size_t)row * DM;
#pragma unroll
      for (int hh = 0; hh < 2; ++hh) {
        float y[8];
#pragma unroll
        for (int i = 0; i < 8; ++i) { const int c = lane * 16 + hh * 8 + i; y[i] = xn[hh * 8 + i] * rs * ng[c] * (1.f + m[1024 + c]) + m[c]; }
        u32x4 w; w.x = cvtpk(y[0], y[1]); w.y = cvtpk(y[2], y[3]); w.z = cvtpk(y[4], y[5]); w.w = cvtpk(y[6], y[7]);
        *(u32x4*)(hrow + lane * 16 + hh * 8) = w;
      }
    }
  }
}

__device__ __forceinline__ void ev_signal(unsigned* ctr) {
  asm volatile("s_waitcnt vmcnt(0)" ::: "memory");
  __syncthreads();
  if (tidx() == 0) { __builtin_amdgcn_fence(__ATOMIC_RELEASE, "agent"); asm volatile("s_waitcnt vmcnt(0)" ::: "memory"); (void)xb_add(ctr, 1u); }
}
__device__ __forceinline__ void ev_wait(unsigned* ctr, unsigned n, unsigned* bar) {
  if (tidx() == 0) {
    XB_SPIN(xb_ld(ctr) < n, bar);
    __builtin_amdgcn_fence(__ATOMIC_ACQUIRE, "agent");
    asm volatile("s_waitcnt vmcnt(0)" ::: "memory");
  }
  __syncthreads();
}
constexpr int EV_WORD0 = 8192;
__device__ __forceinline__ void phase_c1(const Params& p, int l, unsigned char* lds) {
  constexpr int NLOC = NBATCH * 4 * NCH, NCONV = T / 32;
  for (int u = p.bx; u < NLOC + NCONV; u += p.gx) {
    if (u < NLOC) ml_local_unit2(p, l, u, lds);
    else {
      const int cu = u - NLOC;
      if (l == DEPTH - 1 && (cu % (SEGL / 32)) < (CTXL / 32)) continue;
      conv_unit(p, l, cu, lds);
    }
  }
}
__device__ __forceinline__ void phase_c3(const Params& p, int l, unsigned char* lds);
__device__ __forceinline__ void phase_c2(const Params& p, int l, unsigned char* lds) {
  unsigned* ev = (unsigned*)(p.ws + WS_CTL) + EV_WORD0 + 64 * l;
  ml_scan(p, lds);
  ev_signal(ev);
  const float* lp = p.in[I_DLAM] + l * 256;
  float s01 = 0.f, s23 = 0.f;
  for (int i = 0; i < 64; ++i) { s01 += lp[i] * lp[64 + i]; s23 += lp[128 + i] * lp[192 + i]; }
  const float lam_init = 0.8f - 0.6f * expf(-0.3f * (float)l);
  const float lam = expf(s01) - expf(s23) + lam_init;
  const bf16_t* PROJ = (const bf16_t*)(p.ws + WS_PROJ);
  bf16_t* MIX = (bf16_t*)(p.ws + WS_MIX);
  const float* ng = p.in[I_DNORMG] + l * 128;
  const int nun = 512 + (l < DEPTH - 1 ? 16 : 0);
  for (int u = p.bx; u < nun; u += p.gx) {
    int bh, qrow, nkeys;
    if (u < 512) { const int xcd = u & 7, i = (u >> 3) & 31, rnd = u >> 8; bh = 2 * xcd + rnd; qrow = CTXL + i * 256; nkeys = SEGL; }
    else { bh = u - 512; qrow = 0; nkeys = CTXL; }
    const int b = bh >> 2, h = bh & 3;
    const size_t tok0 = (size_t)b * SEGL;
    for (int rep = 0; rep < REP_ATT; ++rep)
    att_unit(p.ws + WS_QK8 + ((size_t)bh * SEGL + qrow) * QK8_PITCH, p.ws + WS_QK8 + QK8_IMG + (size_t)bh * SEGL * QK8_PITCH, p.ws + WS_V8T + (size_t)bh * NCH * ATT_SHM_V,
             MIX + (tok0 + qrow) * DM + 512 + h * 128, nkeys, lam, ng, 1.f - lam_init, lds);
  }
  ev_wait(ev, (unsigned)p.gx, p.xbar_words);
  for (int rep = 0; rep < REP_ML; ++rep) phase_c3(p, l, lds);
}
__device__ __forceinline__ void phase_c3(const Params& p, int l, unsigned char* lds) {
  constexpr int NU = NBATCH * 4 * NCH;
  const int nlow = (p.gx > 64 && l < DEPTH - 1) ? 16 : 0, ulow = nlow * 7;
  int u, step;
  if (p.bx < nlow) { u = p.bx; step = nlow; } else { u = ulow + (p.bx - nlow); step = p.gx - nlow; }
  const int uend = p.bx < nlow ? ulow : NU;
  int tid_ = tidx(); asm volatile("" : "+v"(tid_));
  auto valid_from = [&](int v) { while (v < uend && l == DEPTH - 1 && (v % NCH) < 4) v += step; return v < uend ? v : -1; };
  MlOutPf fa, fb;
  u = valid_from(u);
  if (u >= 0) ml_out_fetch(p, u, tid_, fa);
  while (u >= 0) {
    const int nx = valid_from(u + step);
    ml_out_unit2(p, l, u, lds, fa, nx, fb);
    fa = fb; u = nx;
  }
}
__device__ __forceinline__ void phase_route(const Params& p, int l, unsigned char* lds) {
  constexpr int NU = T / 32;
  for (int u = p.bx; u < NU; u += p.gx) {
    if (l == DEPTH - 1 && (u % (SEGL / 32)) < (CTXL / 32)) continue;
    route_unit(p, l, u, lds);
    __syncthreads();
  }
}
__device__ __forceinline__ void phase_gather(const Params& p, int l, unsigned char* lds) {
  int tid_ = tidx(); asm volatile("" : "+v"(tid_)); const int lane = tid_ & 63, wid = __builtin_amdgcn_readfirstlane(tid_ >> 6);
  const int gw = p.bx * 8 + wid, NGW = p.gx * 8;
  const int ntok = (l == DEPTH - 1) ? NBATCH * SEQ : T;
#define TOKROW(ti_) ((l == DEPTH - 1) ? ((ti_) / SEQ) * SEGL + CTXL + ((ti_) % SEQ) : (ti_))
  const CAS unsigned char* eidg = (const CAS unsigned char*)(p.ws + WS_EID + (size_t)l * RT_STRIDE);
  const __amdgpu_buffer_rsrc_t rsT = __builtin_amdgcn_make_buffer_rsrc((void*)(p.ws + WS_PU + (size_t)l * NEXP * PROW), 0, VOFS + NEXP * PROW, 0x00020000);
  const int nfull = ntok / NGW, rem = ntok - nfull * NGW, per = (rem % p.gx == 0) ? rem / p.gx : -1;
  auto tok_at = [&](int r) -> int {
    if (r < nfull) return gw + r * NGW;
    if (r > nfull || rem == 0) return -1;
    if (per >= 0) return wid < per ? nfull * NGW + p.bx * per + wid : -1;
    return gw + r * NGW < ntok ? gw + r * NGW : -1;
  };
  TokPref tp; RowPipe rp;
  const int ti0 = tok_at(0);
  if (ti0 >= 0) {
    const int row0 = TOKROW(ti0); const int lane12 = lane * 12;
    tok_prefetch(p, row0, lane, tp);
    const CAS i32x8* EP0 = eid_row(eidg, row0);
    rp.Ec = EP0[0];
    LOADGROUP(rp.uq, 0, rp.Ec); LOADGROUP(rp.vq, VOFS, rp.Ec);
    rp.Ec = EP0[1];
  }
  XcdBarrier xb; xb.bar = p.xbar_words; xb.x = p.xbar_x; xb.st = (volatile LAS unsigned*)((LAS unsigned char*)lds + p.lds_st_off);
  const int nrounds = (ntok + NGW - 1) / NGW;
  for (int r = 0; r < nrounds; ++r) {
    const int ti = tok_at(r);
    if (ti >= 0) {
      const int row = TOKROW(ti);
      const int tn = tok_at(r + 1);
      const int nxt = tn >= 0 ? TOKROW(tn) : -1;
      gather_token(p, eidg, rsT, l, row, nxt, tp, rp, lds, lane, wid);
    }
#if GATHER_SYNC
    if (r + 1 < nrounds) { XcdBarrier xb2 = xb; size_t zb_ = 0; asm volatile("" : "+s"(zb_)); xb2.bar = xb.bar + zb_; xb2.x = xb.x + (unsigned)zb_; xcd_barrier(xb2); }
#endif
  }
#undef TOKROW
}

__global__ void __launch_bounds__(512, 2) mk_fwd(KArgs ka) {
  cg::grid_group grid = cg::this_grid();
  extern __shared__ __attribute__((aligned(16))) unsigned char lds[];
  const int lo = ka.ph_lo, hi = ka.ph_hi;
#define IN(k) (lo <= (k) && (k) < hi)
#ifndef PHASEMASK
#define PHASEMASK 0xFFFF
#endif
#define PH(i) ((PHASEMASK >> (i)) & 1)
#define MKP(q) Params q; { size_t z_ = 0; asm volatile("" : "+s"(z_)); \
    q.in = (InTab)((const __attribute__((address_space(4))) char*)__builtin_amdgcn_kernarg_segment_ptr() + z_); \
    q.out = ka.out + z_; q.ws = ka.ws + z_; q.ph_lo = lo; q.ph_hi = hi; q.bx = (int)blockIdx.x + (int)z_; q.gx = (int)gridDim.x + (int)z_; q.xbar_words = xbar.bar + z_; q.xbar_x = xbar.x + (unsigned)z_; q.lds_st_off = (unsigned)(LDS_BYTES - 64); }
#define SEAM(k) do { if (IN(k) && IN((k) + 1)) { if ((k) == 0) grid.sync(); else { XcdBarrier xb_ = xbar; size_t zb_ = 0; asm volatile("" : "+s"(zb_)); xb_.bar = xbar.bar + zb_; xb_.x = xbar.x + (unsigned)zb_; xcd_barrier(xb_); } } } while (0)
  volatile LAS unsigned* xst = (volatile LAS unsigned*)((LAS unsigned char*)lds + (LDS_BYTES - 64));
  { const int t0_ = threadIdx.x;
    if (t0_ < 2) xst[t0_] = 0u;
    if ((t0_ & 63) == 0) *(volatile LAS int*)((LAS unsigned char*)lds + LDS_WTAB + 4 * hw_wave_key()) = t0_ >> 6; }
  __syncthreads();
  XcdBarrier xbar = xcd_barrier_post((unsigned*)(ka.ws + WS_CTL) + 4096, xst);
  { MKP(p)
    if (PH(0) && IN(0)) for (int rep = 0; rep < REP_MISC; ++rep) { p0_mod(p, lds, (float*)(p.ws + WS_MOD)); p0_convert(p, lds); }
  }
  SEAM(0);
  { MKP(p)
    if (PH(1) && IN(1)) phase_norm(p, 0, 0, true, false);
  }
  SEAM(1);
#define LAYER(LL) { \
    int l = (LL); asm volatile("" : "+s"(l)); \
    const int b = 2 + 9 * (LL); \
    { MKP(q) if (PH(2) && IN(b + 0)) for (int rep = 0; rep < REP_GEMM; ++rep) phase_inproj2(q, l, lds); } \
    SEAM(b + 0); \
    { MKP(q) if (PH(3) && IN(b + 1)) for (int rep = 0; rep < REP_ML; ++rep) phase_c1(q, l, lds); } \
    SEAM(b + 1); \
    { MKP(q) if (PH(4) && IN(b + 2)) phase_c2(q, l, lds); } \
    SEAM(b + 3); \
    { MKP(q) if (PH(6) && IN(b + 4)) phase_outproj2(q, l, lds); } \
    SEAM(b + 4); \
    { MKP(q) if (PH(7) && IN(b + 5)) for (int rep = 0; rep < REP_MISC; ++rep) phase_norm(q, l, 1, false, (LL) == DEPTH - 1); } \
    SEAM(b + 5); \
    { MKP(q) if (PH(8) && IN(b + 6)) for (int rep = 0; rep < REP_GEMM; ++rep) phase_peerq2(q, l, lds); } \
    SEAM(b + 6); \
    { MKP(q) if (PH(9) && IN(b + 7)) phase_route(q, l, lds); } \
    SEAM(b + 7); \
    { MKP(q) if (PH(9) && IN(b + 8)) phase_gather(q, l, lds); } \
    SEAM(b + 8); }
  LAYER(0) LAYER(1) LAYER(2) LAYER(3)
#undef LAYER
#undef IN
#undef SEAM
#undef MKP
}

extern "C" void kernel_launch(void* const* d_in, const int* in_sizes, int n_in, void* d_out, int out_size,
                              void* d_ws, size_t ws_size, hipStream_t stream) {
  static int grid = 0;
  if (grid == 0) {
    int dev = 0, cus = 0, per_cu = 0;
    (void)hipGetDevice(&dev);
    (void)hipDeviceGetAttribute(&cus, hipDeviceAttributeMultiprocessorCount, dev);
    (void)hipFuncSetAttribute((const void*)mk_fwd, hipFuncAttributeMaxDynamicSharedMemorySize, LDS_BYTES);
    (void)hipOccupancyMaxActiveBlocksPerMultiprocessor(&per_cu, (const void*)mk_fwd, 512, LDS_BYTES);
    fprintf(stderr, "kernel_launch: cus %d per_cu %d ws %zu (need %zu) n_in %d\n", cus, per_cu, ws_size, (size_t)WS_END, n_in);
    if (ws_size < WS_END || n_in != 23 || per_cu < 1) { fprintf(stderr, "kernel_launch: bad configuration, nothing launched\n"); grid = -1; return; }
    grid = cus;
  }
  if (grid < 0) return;
  (void)hipMemsetAsync((char*)d_ws + WS_CTL, 0, 65536, stream);
  KArgs p{};
  for (int i = 0; i < 23; ++i) p.in[i] = (const float*)d_in[i];
  p.out = (float*)d_out; p.ws = (unsigned char*)d_ws; p.ph_lo = 0; p.ph_hi = 38;
  void* args[] = {&p};
  hipError_t e = hipLaunchCooperativeKernel((const void*)mk_fwd, dim3(grid), dim3(512), args, LDS_BYTES, stream);
  if (e != hipSuccess) fprintf(stderr, "cooperative launch failed: %s (grid %d)\n", hipGetErrorString(e), grid);
}
```

```cpp
#include <hip/hip_runtime.h>
#include <hip/hip_cooperative_groups.h>
#include <cstdio>
#include <cstdint>
namespace cg = cooperative_groups;

constexpr int DM = 1024, NBATCH = 4, SEQ = 8192, CTXL = 256, SEGL = CTXL + SEQ, T = NBATCH * SEGL, DEPTH = 4;
constexpr int IN_W = 3088, PW = 3072;
constexpr int QK8_PITCH = 144; constexpr size_t QK8_IMG = (size_t)16 * SEGL * QK8_PITCH;
constexpr int C_A = 0, C_MQ = 512, C_MK = 768, C_MV = 1024, C_MO = 1280, C_DQ = 1536, C_DK = 2048, C_DV = 2560;
constexpr int NCH = SEGL / 64;
constexpr int NEXP = 16384;
constexpr float EPS = 1e-6f;
#ifndef ABL
#define ABL 0
#endif
#ifndef GATHER_SYNC
#define GATHER_SYNC 0
#endif
#ifndef REP_ATT
#define REP_ATT 1
#endif
#ifndef GP_MASK
#define GP_MASK 0x3FFF
#endif
#ifndef REP_PEER
#define REP_PEER 1
#endif
#ifndef REP_GEMM
#define REP_GEMM 1
#endif
#ifndef REP_ROUTE
#define REP_ROUTE 1
#endif
#ifndef REP_OUTP
#define REP_OUTP 1
#endif
#ifndef REP_ML
#define REP_ML 1
#endif
#ifndef REP_MISC
#define REP_MISC 1
#endif
constexpr float QSCALE = 0.125f * 1.4426950408889634f;

constexpr size_t MiB = 1u << 20;
constexpr size_t WS_CTL = 0, WS_MOD = 1 * MiB, WS_ROPE = 2 * MiB, WS_WG = 4 * MiB, WS_KEYS = 5 * MiB, WS_MLMETA = 6 * MiB,
                 WS_GATES = 7 * MiB, WS_WIN = 10 * MiB, WS_WOUT = 34 * MiB, WS_WQ = 42 * MiB, WS_PU = 50 * MiB, WS_PV = 114 * MiB, WS_PSC = 178 * MiB  ,
                 WS_XCUR = 306 * MiB, WS_H = 438 * MiB, WS_MIX = 504 * MiB, WS_PROJ = 570 * MiB, WS_ULOC = 768 * MiB, WS_V8T = 836 * MiB  , WS_EID = 858 * MiB  , WS_QK8 = 924 * MiB  , WS_END = 964 * MiB;
constexpr int USTRIDE = 4160;

constexpr int LDS_BYTES = 139264 + 512;
constexpr int LDS_WTAB = LDS_BYTES - 64 - 256;

#define LAS __attribute__((address_space(3)))
__device__ __forceinline__ int hw_wave_key() { return (int)(__builtin_amdgcn_s_getreg((5 << 11) | 4) & 63u); }
__device__ __forceinline__ int tidx() {
  extern __shared__ __attribute__((aligned(16))) unsigned char lds_dyn_[];
  const int w = __builtin_amdgcn_readfirstlane(*(const volatile LAS int*)((LAS unsigned char*)lds_dyn_ + LDS_WTAB + 4 * hw_wave_key()));
  unsigned z_ = 0u; asm volatile("" : "+v"(z_));
  return (w << 6) | (int)__builtin_amdgcn_mbcnt_hi(~0u, __builtin_amdgcn_mbcnt_lo(~0u, z_));
}
typedef unsigned short bf16_t;
typedef short bf16x8 __attribute__((ext_vector_type(8)));
typedef short s16x4 __attribute__((ext_vector_type(4)));
typedef float f32x4 __attribute__((ext_vector_type(4)));
typedef float f32x16 __attribute__((ext_vector_type(16)));
typedef unsigned u32x4 __attribute__((ext_vector_type(4)));
typedef unsigned u32x2 __attribute__((ext_vector_type(2)));
typedef __bf16 bf16x2v __attribute__((ext_vector_type(2)));
typedef int i32x8 __attribute__((ext_vector_type(8)));
typedef int i32x6 __attribute__((ext_vector_type(6)));
struct __attribute__((aligned(4))) u32x3 { unsigned x, y, z; };
typedef float f32x32 __attribute__((ext_vector_type(32)));
constexpr int PROW = 768;
typedef float f32x2 __attribute__((ext_vector_type(2)));
typedef _Float16 h16x2 __attribute__((ext_vector_type(2)));
typedef _Float16 h16x32 __attribute__((ext_vector_type(32)));
typedef unsigned u32x3v __attribute__((ext_vector_type(3)));
typedef unsigned u32x2v __attribute__((ext_vector_type(2)));

struct KArgs {
  const float* in[23];
  float* out;
  unsigned char* ws;
  int ph_lo, ph_hi;
};
typedef const float* const __attribute__((address_space(4))) * InTab;
struct Params {
  InTab in;
  float* out;
  unsigned char* ws;
  int ph_lo, ph_hi;
  int bx, gx;
  unsigned* xbar_words; unsigned xbar_x; unsigned lds_st_off;
};
enum { I_X = 0, I_C, I_CTX, I_CCTX, I_ADAW, I_ADAB, I_N1G, I_N2G, I_WIN, I_CONVW, I_CONVB, I_CLNG, I_CLNB, I_GATEB, I_MNORMG, I_DLAM, I_DNORMG,
       I_WOUT, I_PWQ, I_PKEYS, I_PU, I_PV, I_FINALG };

__device__ __forceinline__ unsigned cvtpk(float lo, float hi) { unsigned r; asm volatile("v_cvt_pk_bf16_f32 %0, %1, %2" : "=v"(r) : "v"(lo), "v"(hi)); return r; }
__device__ __forceinline__ float bflo(unsigned u) { return __uint_as_float(u << 16); }
__device__ __forceinline__ float bfhi(unsigned u) { return __uint_as_float(u & 0xffff0000u); }
__device__ __forceinline__ float bf1(bf16_t u) { return __uint_as_float(((unsigned)u) << 16); }
__device__ __forceinline__ int crow(int r, int hi) { return (r & 3) + 8 * (r >> 2) + 4 * hi; }
template <int CTRL> __device__ __forceinline__ float dpp_mov(float v) {
  return __uint_as_float((unsigned)__builtin_amdgcn_update_dpp(0, (int)__float_as_uint(v), CTRL, 0xF, 0xF, true));
}
__device__ __forceinline__ float wave_sum_fast(float x) {
  x += dpp_mov<0xB1>(x); x += dpp_mov<0x4E>(x); x += dpp_mov<0x141>(x); x += dpp_mov<0x140>(x);
  { auto r = __builtin_amdgcn_permlane16_swap(__float_as_uint(x), __float_as_uint(x), false, false); x = __uint_as_float(r[0]) + __uint_as_float(r[1]); }
  { auto r = __builtin_amdgcn_permlane32_swap(__float_as_uint(x), __float_as_uint(x), false, false); x = __uint_as_float(r[0]) + __uint_as_float(r[1]); }
  return x;
}
__device__ __forceinline__ float wave_max_fast(float x) {
  x = fmaxf(x, dpp_mov<0xB1>(x)); x = fmaxf(x, dpp_mov<0x4E>(x)); x = fmaxf(x, dpp_mov<0x141>(x)); x = fmaxf(x, dpp_mov<0x140>(x));
  { auto r = __builtin_amdgcn_permlane16_swap(__float_as_uint(x), __float_as_uint(x), false, false); x = fmaxf(__uint_as_float(r[0]), __uint_as_float(r[1])); }
  { auto r = __builtin_amdgcn_permlane32_swap(__float_as_uint(x), __float_as_uint(x), false, false); x = fmaxf(__uint_as_float(r[0]), __uint_as_float(r[1])); }
  return x;
}
template <int CTRL, int ROWMASK> __device__ __forceinline__ float dpp_mov_rm(float v) {
  return __uint_as_float((unsigned)__builtin_amdgcn_update_dpp(0, (int)__float_as_uint(v), CTRL, ROWMASK, 0xF, true));
}
__device__ __forceinline__ float wave_incl_scan(float x) {
  x += dpp_mov<0x111>(x); x += dpp_mov<0x112>(x); x += dpp_mov<0x114>(x); x += dpp_mov<0x118>(x);
  x += dpp_mov_rm<0x142, 0xA>(x);
  x += dpp_mov_rm<0x143, 0xC>(x);
  return x;
}
__device__ __forceinline__ float wave_sum(float v) { return wave_sum_fast(v); }
__device__ __forceinline__ float sum_xor32(float x) { auto r = __builtin_amdgcn_permlane32_swap(__float_as_uint(x), __float_as_uint(x), false, false); return __uint_as_float(r[0]) + __uint_as_float(r[1]); }
__device__ __forceinline__ float max_xor32(float x) { auto r = __builtin_amdgcn_permlane32_swap(__float_as_uint(x), __float_as_uint(x), false, false); return fmaxf(__uint_as_float(r[0]), __uint_as_float(r[1])); }
__device__ __forceinline__ float wave_max(float v) { return wave_max_fast(v); }
__device__ __forceinline__ float sigmoidf_(float x) { return 1.f / (1.f + __expf(-x)); }
__device__ __forceinline__ float logsigmoidf_(float x) { return fminf(x, 0.f) - log1pf(__expf(-fabsf(x))); }
__device__ __forceinline__ const float* in_row(const float* x, const float* ctx, int row) {
  const int b = row / SEGL, s = row - b * SEGL;
  return s < CTXL ? ctx + ((size_t)(b * CTXL + s)) * DM : x + ((size_t)(b * SEQ + (s - CTXL))) * DM;
}
__device__ __forceinline__ int mod_row(int row) { const int b = row / SEGL, s = row - b * SEGL; return s < CTXL ? 4 : b; }

__device__ __forceinline__ void p0_mod(const Params& p, unsigned char* lds, float* MOD) {
  float* sil = (float*)lds;
  float* red = (float*)(lds + 20480);
  int tid_ = tidx(); asm volatile("" : "+v"(tid_)); const int tid = tid_, lane = tid & 63, wid = tid >> 6;
  for (int i = tid; i < 5 * 1024; i += 512) {
    const float v = i < 4096 ? p.in[I_C][i] : p.in[I_CCTX][i - 4096];
    sil[i] = v / (1.f + __expf(-v));
  }
  __syncthreads();
  for (int item = p.bx; item < DEPTH * 96; item += p.gx) {
    const int l = item / 96, j0 = (item % 96) * 64;
    const float* W = p.in[I_ADAW] + (size_t)l * DM * 6144 + j0 + lane;
    float a0 = 0.f, a1 = 0.f, a2 = 0.f, a3 = 0.f, a4 = 0.f;
    const int k0 = wid * 128;
#pragma unroll 8
    for (int k = k0; k < k0 + 128; ++k) {
      const float w = W[(size_t)k * 6144];
      a0 += sil[k] * w; a1 += sil[1024 + k] * w; a2 += sil[2048 + k] * w; a3 += sil[3072 + k] * w; a4 += sil[4096 + k] * w;
    }
    red[(wid * 5 + 0) * 64 + lane] = a0; red[(wid * 5 + 1) * 64 + lane] = a1; red[(wid * 5 + 2) * 64 + lane] = a2;
    red[(wid * 5 + 3) * 64 + lane] = a3; red[(wid * 5 + 4) * 64 + lane] = a4;
    __syncthreads();
    if (tid < 320) {
      const int r = tid >> 6;
      float s = 0.f;
#pragma unroll
      for (int w = 0; w < 8; ++w) s += red[(w * 5 + r) * 64 + lane];
      MOD[((size_t)l * 5 + r) * 6144 + j0 + lane] = s + p.in[I_ADAB][l * 6144 + j0 + lane];
    }
    __syncthreads();
  }
}
__device__ __forceinline__ void transpose_item(const float* W, int ldw, int srccol0, bf16_t* WT, int K, int n0, int k0, float* scr, int lane) {
#pragma unroll 8
  for (int i = 0; i < 32; ++i) { const int kk = 2 * i + (lane >> 5); scr[kk * 33 + (lane & 31)] = W[(size_t)(k0 + kk) * ldw + srccol0 + (lane & 31)]; }
  asm volatile("s_waitcnt lgkmcnt(0)" ::: "memory");
  const int c = lane & 7;
#pragma unroll
  for (int j = 0; j < 4; ++j) {
    const int n = (lane >> 3) + 8 * j; const float* s = scr + (8 * c) * 33 + n;
    u32x4 o; o.x = cvtpk(s[0], s[33]); o.y = cvtpk(s[66], s[99]); o.z = cvtpk(s[132], s[165]); o.w = cvtpk(s[198], s[231]);
    *(u32x4*)(WT + (size_t)(n0 + n) * K + k0 + 8 * c) = o;
  }
  asm volatile("s_waitcnt lgkmcnt(0)" ::: "memory");
}
__device__ __forceinline__ void convert_tables(const Params& p, int L, int wv, int nw, int lane, int r_lo, int r_hi) {
  unsigned char* PUq = p.ws + WS_PU; unsigned char* PVq = p.ws + WS_PV; float* PSC = (float*)(p.ws + WS_PSC);
  const int nrows = DEPTH * NEXP;
#define TAB_SROW(r_) ((const f32x4*)(((r_) >= NEXP ? p.in[I_PV] : p.in[I_PU]) + (size_t)(L * NEXP + ((r_) >= NEXP ? (r_) - NEXP : (r_))) * DM) + lane * 4)
#define TAB_LOAD(v_, r_) do { if ((r_) < r_hi) { const f32x4* s_ = TAB_SROW(r_); _Pragma("unroll") for (int j = 0; j < 4; ++j) v_[j] = __builtin_nontemporal_load(s_ + j); } } while (0)
  auto encode_row = [&](const f32x4 (&v)[4], int r) {
    const int tb = r >= NEXP, rr = L * NEXP + (tb ? r - NEXP : r);
    float mx = 0.f;
#pragma unroll
    for (int j = 0; j < 4; ++j) mx = fmaxf(mx, fmaxf(fmaxf(fabsf(v[j].x), fabsf(v[j].y)), fmaxf(fabsf(v[j].z), fabsf(v[j].w))));
    mx = wave_max_fast(mx);
    const unsigned mb = __float_as_uint(mx);
    const int eb = (int)((mb >> 23) & 0xFFu);
    int sb = ((mb & 0x7FFFFFu) <= 0x700000u ? 129 : 128) - eb + 127; sb = sb < 1 ? 1 : (sb > 253 ? 253 : sb);
    const float sc = __uint_as_float((unsigned)sb << 23), isc = __uint_as_float((unsigned)(254 - sb) << 23);
    const float xv[16] = {v[0].x, v[0].y, v[0].z, v[0].w, v[1].x, v[1].y, v[1].z, v[1].w, v[2].x, v[2].y, v[2].z, v[2].w, v[3].x, v[3].y, v[3].z, v[3].w};
    unsigned wq[3] = {0u, 0u, 0u};
#pragma unroll
    for (int i = 0; i < 16; ++i) {
      const float a = fabsf(xv[i]) * sc;
      unsigned code = a < 2.f ? (unsigned)__builtin_rintf(a * 8.f) : (a < 4.f ? 8u + (unsigned)__builtin_rintf(a * 4.f) : 16u + (unsigned)__builtin_rintf(a * 2.f));
      code = code > 31u ? 31u : code;
      code |= (xv[i] < 0.f) ? 32u : 0u;
      const int bp = 6 * i, dw = bp >> 5, off = bp & 31;
      wq[dw] |= code << off;
      if (off > 26) wq[dw + 1] |= code >> (32 - off);
    }
    u32x3 o; o.x = wq[0]; o.y = wq[1]; o.z = wq[2];
    *(u32x3*)((tb ? PVq : PUq) + (size_t)rr * PROW + lane * 12) = o;
    if (lane == 0) PSC[(size_t)tb * nrows + rr] = isc;
  };
  f32x4 v0[4], v1[4], v2[4];
  TAB_LOAD(v0, r_lo + wv); TAB_LOAD(v1, r_lo + wv + nw);
#pragma unroll 1
  for (int r = r_lo + wv; r < r_hi; r += 3 * nw) {
    TAB_LOAD(v2, r + 2 * nw); encode_row(v0, r);
    if (r + nw < r_hi) { TAB_LOAD(v0, r + 3 * nw); encode_row(v1, r + nw); }
    if (r + 2 * nw < r_hi) { TAB_LOAD(v1, r + 4 * nw); encode_row(v2, r + 2 * nw); }
  }
#undef TAB_LOAD
#undef TAB_SROW
}
__device__ __forceinline__ void tail_filler_tables(const Params& p, int L, int nwg, int r_lo, int r_hi) {
  int tid_ = tidx(); asm volatile("" : "+v"(tid_)); const int lane = tid_ & 63, wid = tid_ >> 6;
  const int nextra = nwg % p.gx, first = nextra, nidle = p.gx - nextra;
  if (p.bx < first) return;
  convert_tables(p, L, (p.bx - first) * 8 + wid, nidle * 8, lane, r_lo, r_hi);
}
__device__ __forceinline__ void p0_convert(const Params& p, unsigned char* lds) {
  int tid_ = tidx(); asm volatile("" : "+v"(tid_)); const int tid = tid_, lane = tid & 63, wid = tid >> 6;
  const int gw = p.bx * 8 + wid, NGW = p.gx * 8;
  const size_t gt = (size_t)p.bx * 512 + tid, NGT = (size_t)p.gx * 512;
  float* scr = (float*)(lds + 32768) + wid * (64 * 33);
  bf16_t* WIN = (bf16_t*)(p.ws + WS_WIN); bf16_t* WOUT = (bf16_t*)(p.ws + WS_WOUT); bf16_t* WQ = (bf16_t*)(p.ws + WS_WQ);
  constexpr int I_IN = 16 * 96, I_O = 16 * 32, PER_L = I_IN + 2 * I_O;
  for (int it = gw; it < DEPTH * PER_L; it += NGW) {
    const int l = it / PER_L; int r = it % PER_L;
    if (r < I_IN) { const int kb = r / 96, nb = r % 96, n0 = nb * 32; const int src = n0 < 1536 ? n0 : n0 + 16;
      transpose_item(p.in[I_WIN] + (size_t)l * DM * IN_W, IN_W, src, WIN + (size_t)l * PW * DM, DM, n0, kb * 64, scr, lane); continue; }
    r -= I_IN;
    if (r < I_O) { const int kb = r / 32, nb = r % 32;
      transpose_item(p.in[I_WOUT] + (size_t)l * DM * DM, DM, nb * 32, WOUT + (size_t)l * DM * DM, DM, nb * 32, kb * 64, scr, lane); continue; }
    r -= I_O;
    { const int kb = r / 32, nb = r % 32;
      transpose_item(p.in[I_PWQ] + (size_t)l * DM * DM, DM, nb * 32, WQ + (size_t)l * DM * DM, DM, nb * 32, kb * 64, scr, lane); }
  }
  bf16_t* WG = (bf16_t*)(p.ws + WS_WG);
  for (size_t i = gt; i < (size_t)DEPTH * 16 * DM; i += NGT) {
    const int l = (int)(i / (16 * DM)), g = (int)((i / DM) % 16), k = (int)(i % DM);
    WG[i] = (bf16_t)(cvtpk(p.in[I_WIN][(size_t)l * DM * IN_W + (size_t)k * IN_W + 1536 + g], 0.f) & 0xffffu);
  }
  bf16_t* KEYS = (bf16_t*)(p.ws + WS_KEYS);
  for (size_t i = gt; i < (size_t)DEPTH * 131072 / 8; i += NGT) {
    const f32x4 a = ((const f32x4*)p.in[I_PKEYS])[2 * i], b = ((const f32x4*)p.in[I_PKEYS])[2 * i + 1];
    u32x4 o; o.x = cvtpk(a.x, a.y); o.y = cvtpk(a.z, a.w); o.z = cvtpk(b.x, b.y); o.w = cvtpk(b.z, b.w);
    ((u32x4*)KEYS)[i] = o;
  }
  {
    float* RC = (float*)(p.ws + WS_ROPE); float* RS = RC + SEQ * 32;
    for (size_t i = gt; i < (size_t)SEQ * 32; i += NGT) {
      const int pos = (int)(i >> 5), j = (int)(i & 31);
      const int rr = pos >> 6, cc = pos & 63;
      const int jj = j & 15;
      const double e = -(double)jj * 0.83048202372184058696;
      const double fl = __builtin_floor(e); const double f = e - fl;
      const double z = f * 0.69314718055994530942;
      double ez = 1.0 + z * (1.0 + z * (0.5 + z * (1.0 / 6 + z * (1.0 / 24 + z * (1.0 / 120 + z * (1.0 / 720 + z * (1.0 / 5040 + z * (1.0 / 40320 + z * (1.0 / 362880 + z * (1.0 / 3628800 + z * (1.0 / 39916800 + z * (1.0 / 479001600))))))))))));
      const double inv = __builtin_ldexp(ez, (int)fl);
      const float invf = (float)inv;
      const float angf = (float)(j < 16 ? rr : cc) * invf;
      const double ang = (double)angf;
      const double kq = __builtin_rint(ang * 0.63661977236758134308);
      double r = __builtin_fma(-kq, 1.57079632679489655800e+00, ang);
      r = __builtin_fma(-kq, 6.12323399573676603587e-17, r);
      const double r2 = r * r;
      const double sn = r * (1.0 + r2 * (-1.0 / 6 + r2 * (1.0 / 120 + r2 * (-1.0 / 5040 + r2 * (1.0 / 362880 + r2 * (-1.0 / 39916800 + r2 * (1.0 / 6227020800.0)))))));
      const double cs = 1.0 + r2 * (-0.5 + r2 * (1.0 / 24 + r2 * (-1.0 / 720 + r2 * (1.0 / 40320 + r2 * (-1.0 / 3628800 + r2 * (1.0 / 479001600 + r2 * (-1.0 / 87178291200.0)))))));
      const int q = ((int)kq) & 3;
      double co, si;
      if (q == 0) { co = cs; si = sn; } else if (q == 1) { co = -sn; si = cs; } else if (q == 2) { co = -cs; si = -sn; } else { co = sn; si = -cs; }
      RC[i] = (float)co; RS[i] = (float)si;
    }
  }
}

__device__ __forceinline__ void norm_mod_row(const float* xrow, const float* g, const float* sc, const float* sh, bf16_t* orow, int lane) {
  const f32x4* xr = (const f32x4*)xrow + lane;
  f32x4 v[4]; float s = 0.f;
#pragma unroll
  for (int j = 0; j < 4; ++j) { v[j] = xr[64 * j]; s += (v[j].x * v[j].x + v[j].y * v[j].y) + (v[j].z * v[j].z + v[j].w * v[j].w); }
  const float rs = rsqrtf(wave_sum(s) * (1.f / DM) + EPS);
  u32x2* o = (u32x2*)orow + lane;
#pragma unroll
  for (int j = 0; j < 4; ++j) {
    const f32x4 gg = ((const f32x4*)g)[lane + 64 * j], cc = ((const f32x4*)sc)[lane + 64 * j], hh = ((const f32x4*)sh)[lane + 64 * j];
    const float y0 = v[j].x * rs * gg.x * (1.f + cc.x) + hh.x, y1 = v[j].y * rs * gg.y * (1.f + cc.y) + hh.y;
    const float y2 = v[j].z * rs * gg.z * (1.f + cc.z) + hh.z, y3 = v[j].w * rs * gg.w * (1.f + cc.w) + hh.w;
    u32x2 w; w.x = cvtpk(y0, y1); w.y = cvtpk(y2, y3);
    o[64 * j] = w;
  }
}
__device__ __forceinline__ void phase_norm(const Params& p, int l, int which, bool from_input, bool skip_ctx) {
  int tid_ = tidx(); asm volatile("" : "+v"(tid_));
  const int lane = tid_ & 63, wid = tid_ >> 6;
  const int gw = p.bx * 8 + wid, NGW = p.gx * 8;
  const float* MOD = (const float*)(p.ws + WS_MOD);
  const float* XC = (const float*)(p.ws + WS_XCUR);
  bf16_t* H = (bf16_t*)(p.ws + WS_H);
  const float* g = p.in[which ? I_N2G : I_N1G] + l * DM;
  for (int row = gw; row < T; row += NGW) {
    const int mr = mod_row(row);
    if (skip_ctx && mr == 4) continue;
    const float* m = MOD + ((size_t)l * 5 + mr) * 6144 + which * 3072;
    const float* xr = from_input ? in_row(p.in[I_X], p.in[I_CTX], row) : XC + (size_t)row * DM;
    norm_mod_row(xr, g, m + 1024, m, H + (size_t)row * DM, lane);
  }
}

namespace pg8 {
#define PG8_LAS __attribute__((address_space(3)))
typedef unsigned short bf16_t;
typedef short bf16x8 __attribute__((ext_vector_type(8)));
typedef float f32x4 __attribute__((ext_vector_type(4)));
typedef unsigned u32x4 __attribute__((ext_vector_type(4)));
constexpr int BM = 256, BK = 64, HALF = 128, HTB = HALF * BK * 2  , STAGE_BYTES = 8 * HTB, NXCD = 8, WGM = 8;

__host__ __device__ __forceinline__ int lds_byte(int r, int c) { const int st = (r >> 4) * 2 + (c >> 5), rr = r & 15, cc = c & 31, ob = rr * 64 + cc * 2; return st * 1024 + (ob ^ (((ob >> 9) & 1) << 5)); }
__host__ __device__ __forceinline__ void stage_rc(int b, int& R, int& C) { const int st = b / 1024, sb = b % 1024, swz = sb ^ (((sb >> 9) & 1) << 5); R = (st >> 1) * 16 + swz / 64; C = (st & 1) * 32 + (swz % 64) / 2; }
__host__ __device__ __forceinline__ int perm32(int rho) { const int n = rho >> 4, i = rho & 15; return 8 * (i >> 2) + 4 * n + (i & 3); }

struct Unit { int pm, pn; };
struct Gemm { const bf16_t* A; const bf16_t* Bt; int M, N, K; };

struct StaticOrder {
    int nM, nN, nwg, G, c;
    __host__ __device__ void init(int M, int N, int G_, int c_) { nM = M / BM; nN = N / BM; nwg = nM * nN; G = G_; c = c_; }
    __host__ __device__ bool next(int i, Unit& u) const {
        const long L = (long)i * G + c; if (L >= nwg) return false;
        int wgid = (int)L; { const int q = nwg / NXCD, r = nwg % NXCD, xcd = wgid % NXCD, off = wgid / NXCD; wgid = (xcd < r ? xcd * (q + 1) : r * (q + 1) + (xcd - r) * q) + off; }
        const int nig = WGM * nN, gid = wgid / nig, fm = gid * WGM, gsz = (nM - fm) < WGM ? (nM - fm) : WGM;
        u.pm = fm + ((wgid % nig) % gsz); u.pn = (wgid % nig) / gsz; return true;
    }
    __device__ __forceinline__ void a_ready(const Unit&) const {}
    __device__ __forceinline__ void done(const Unit&) const {}
};
__device__ __forceinline__ unsigned cvt_pk_bf16(float lo, float hi) { unsigned r; asm volatile("v_cvt_pk_bf16_f32 %0, %1, %2" : "=v"(r) : "v"(lo), "v"(hi)); return r; }
template <class Epi, class Sched, bool ALIGN_EPI = false, bool SP2 = false>
__device__ __forceinline__ void gemm_phase(PG8_LAS unsigned char* lds, const Gemm g, const Sched& S, const Epi& E) {
    const int tid = tidx(), wid = __builtin_amdgcn_readfirstlane(tid >> 6), lane = tid & 63, wr = wid >> 2, wc = wid & 3, fr = lane & 15, fq = lane >> 4;
    const int K = g.K, nt = K / BK;
    unsigned voffA[2], voffB[2];
#pragma unroll
    for (int i = 0; i < 2; ++i) { int R, C; stage_rc(tid * 16 + i * 8192, R, C); const int Rb = Epi::PERM ? ((R & ~31) + perm32(R & 31)) : R;
        voffA[i] = (unsigned)(R * K + C) * 2u; voffB[i] = (unsigned)(Rb * K + C) * 2u; }
    const size_t kstep = (size_t)(BK * 2);
    const size_t hstep = (size_t)HALF * K * 2;
    const size_t tstep = 2 * hstep;
    const unsigned ldsw = (unsigned)wid * 1024u;
    const int aoff = lds_byte(wr * 64 + fr, fq * 8), boff = lds_byte(wc * 32 + fr, fq * 8);
#define PG8_SA(b, h) (((b) * 2 + (h)) * HTB)
#define PG8_SB(b, h) ((4 + (b) * 2 + (h)) * HTB)
#define PG8_STAGE(bufoff, gbase, voff) do { _Pragma("unroll") for (int _i = 0; _i < 2; ++_i) \
        __builtin_amdgcn_global_load_lds((const unsigned*)((const char*)(gbase) + (voff)[_i]), (PG8_LAS unsigned*)(lds + (bufoff) + ldsw + _i * 8192), 16, 0, 0); } while (0)
#define PG8_LDA(dst, b, h) do { _Pragma("unroll") for (int m = 0; m < 4; ++m) _Pragma("unroll") for (int k = 0; k < 2; ++k) dst[m][k] = *(const PG8_LAS bf16x8*)(lds + PG8_SA(b, h) + aoff + m * 2048 + k * 1024); } while (0)
#define PG8_LDB(dst, b, h) do { _Pragma("unroll") for (int n = 0; n < 2; ++n) _Pragma("unroll") for (int k = 0; k < 2; ++k) dst[n][k] = *(const PG8_LAS bf16x8*)(lds + PG8_SB(b, h) + boff + n * 2048 + k * 1024); } while (0)
#define PG8_MMA(ai, bj, At, Bt) do { __builtin_amdgcn_s_setprio(1); _Pragma("unroll") for (int m = 0; m < 4; ++m) _Pragma("unroll") for (int n = 0; n < 2; ++n) _Pragma("unroll") for (int k = 0; k < 2; ++k) \
        acc[ai][bj][m][n] = __builtin_amdgcn_mfma_f32_16x16x32_bf16(Bt[n][k], At[m][k], acc[ai][bj][m][n], 0, 0, 0); __builtin_amdgcn_s_setprio(0); } while (0)
#define PG8_WAIT_V(n) asm volatile("s_waitcnt vmcnt(" #n ")" ::: "memory")
#define PG8_WAIT_L(n) asm volatile("s_waitcnt lgkmcnt(" #n ")" ::: "memory")
#define PG8_BAR __builtin_amdgcn_s_barrier()
#define PG8_SCHED __builtin_amdgcn_sched_barrier(0)
    Unit cur, nxt; int ui = 0;
    if (!S.next(0, cur)) return;
    f32x4 acc[2][2][4][2];
#pragma unroll
    for (int a = 0; a < 2; ++a)
#pragma unroll
        for (int b = 0; b < 2; ++b)
#pragma unroll
            for (int m = 0; m < 4; ++m)
#pragma unroll
                for (int n = 0; n < 2; ++n) acc[a][b][m][n] = (f32x4){0.f, 0.f, 0.f, 0.f};
    bf16x8 At[4][2], B0[2][2], B1[2][2];
    const char* cA = (const char*)g.A + (size_t)cur.pm * tstep; const char* cB = (const char*)g.Bt + (size_t)cur.pn * tstep;
    S.a_ready(cur);
    if constexpr (SP2) {
        PG8_STAGE(PG8_SB(0, 0), cB, voffB); PG8_STAGE(PG8_SB(0, 1), cB + hstep, voffB); PG8_STAGE(PG8_SA(0, 0), cA, voffA); PG8_STAGE(PG8_SA(0, 1), cA + hstep, voffA);
        if (wr == 1) PG8_BAR;
        PG8_WAIT_V(2); PG8_BAR;
        PG8_STAGE(PG8_SB(1, 0), cB + kstep, voffB); PG8_STAGE(PG8_SA(1, 0), cA + kstep, voffA); PG8_STAGE(PG8_SB(1, 1), cB + hstep + kstep, voffB);
        PG8_WAIT_V(6); PG8_BAR;
    } else {
        PG8_STAGE(PG8_SB(0, 0), cB, voffB); PG8_STAGE(PG8_SA(0, 0), cA, voffA); PG8_STAGE(PG8_SB(0, 1), cB + hstep, voffB); PG8_STAGE(PG8_SA(0, 1), cA + hstep, voffA);
        if (wr == 1) PG8_BAR;
        PG8_WAIT_V(4); PG8_BAR;
        PG8_STAGE(PG8_SB(1, 0), cB + kstep, voffB); PG8_STAGE(PG8_SA(1, 0), cA + kstep, voffA); PG8_STAGE(PG8_SB(1, 1), cB + hstep + kstep, voffB);
        PG8_WAIT_V(6); PG8_BAR;
    }
    for (;;) {
        const bool has_next = S.next(ui + 1, nxt);
        const char* nA = has_next ? (const char*)g.A + (size_t)nxt.pm * tstep : cA; const char* nB = has_next ? (const char*)g.Bt + (size_t)nxt.pn * tstep : cB;
        for (int t = 0; t < nt; t += 2) {
            const bool last = (t == nt - 2);
            const char* a1 = cA + (size_t)(t + 1) * kstep;
            const char* a2 = last ? nA : cA + (size_t)(t + 2) * kstep; const char* b2 = last ? nB : cB + (size_t)(t + 2) * kstep;
            const char* a3 = a2 + kstep; const char* b3 = b2 + kstep;
            if (last && has_next) S.a_ready(nxt);
            if constexpr (SP2) {
            PG8_LDB(B0, 0, 0); PG8_LDB(B1, 0, 1); PG8_SCHED; PG8_LDA(At, 0, 0); PG8_STAGE(PG8_SA(1, 1), a1 + hstep, voffA);
            PG8_WAIT_V(8); PG8_WAIT_L(0); PG8_BAR; PG8_MMA(0, 0, At, B0); PG8_MMA(0, 1, At, B1); PG8_BAR; PG8_SCHED;
            PG8_LDA(At, 0, 1); PG8_STAGE(PG8_SB(0, 0), b2, voffB); PG8_STAGE(PG8_SB(0, 1), b2 + hstep, voffB); PG8_STAGE(PG8_SA(0, 0), a2, voffA);
            PG8_WAIT_V(8); PG8_WAIT_L(0); PG8_BAR; PG8_MMA(1, 0, At, B0); PG8_MMA(1, 1, At, B1); PG8_BAR; PG8_SCHED;
            PG8_LDB(B0, 1, 0); PG8_LDB(B1, 1, 1); PG8_SCHED; PG8_LDA(At, 1, 0); PG8_STAGE(PG8_SA(0, 1), a2 + hstep, voffA);
            PG8_WAIT_V(8); PG8_WAIT_L(0); PG8_BAR; PG8_MMA(0, 0, At, B0); PG8_MMA(0, 1, At, B1); PG8_BAR; PG8_SCHED;
            PG8_LDA(At, 1, 1); PG8_STAGE(PG8_SB(1, 0), b3, voffB); PG8_STAGE(PG8_SB(1, 1), b3 + hstep, voffB); PG8_STAGE(PG8_SA(1, 0), a3, voffA);
            PG8_WAIT_V(8); PG8_WAIT_L(0); PG8_BAR; PG8_MMA(1, 0, At, B0); PG8_MMA(1, 1, At, B1); PG8_BAR; PG8_SCHED;
            } else {
            PG8_LDB(B0, 0, 0); PG8_SCHED; PG8_LDA(At, 0, 0); PG8_STAGE(PG8_SA(1, 1), a1 + hstep, voffA);
            PG8_WAIT_L(8); PG8_BAR; PG8_WAIT_L(0); PG8_MMA(0, 0, At, B0); PG8_BAR; PG8_SCHED;
            PG8_LDB(B1, 0, 1); PG8_STAGE(PG8_SB(0, 0), b2, voffB);
            PG8_BAR; PG8_WAIT_L(0); PG8_MMA(0, 1, At, B1); PG8_BAR;
            PG8_LDA(At, 0, 1); PG8_STAGE(PG8_SA(0, 0), a2, voffA);
            PG8_BAR; PG8_WAIT_L(0); PG8_MMA(1, 0, At, B0); PG8_BAR; PG8_SCHED;
            PG8_STAGE(PG8_SB(0, 1), b2 + hstep, voffB);
            PG8_WAIT_V(6); PG8_BAR; PG8_MMA(1, 1, At, B1); PG8_BAR;
            PG8_LDB(B0, 1, 0); PG8_SCHED; PG8_LDA(At, 1, 0); PG8_STAGE(PG8_SA(0, 1), a2 + hstep, voffA);
            PG8_WAIT_L(8); PG8_BAR; PG8_WAIT_L(0); PG8_MMA(0, 0, At, B0); PG8_BAR; PG8_SCHED;
            PG8_LDB(B1, 1, 1); PG8_STAGE(PG8_SB(1, 0), b3, voffB);
            PG8_BAR; PG8_WAIT_L(0); PG8_MMA(0, 1, At, B1); PG8_BAR;
            PG8_LDA(At, 1, 1); PG8_STAGE(PG8_SA(1, 0), a3, voffA);
            PG8_BAR; PG8_WAIT_L(0); PG8_MMA(1, 0, At, B0); PG8_BAR; PG8_SCHED;
            PG8_STAGE(PG8_SB(1, 1), b3 + hstep, voffB);
            PG8_WAIT_V(6); PG8_BAR; PG8_MMA(1, 1, At, B1); PG8_BAR;
            }
        }
        if constexpr (ALIGN_EPI) { if (wr == 0) PG8_BAR; }
        if constexpr (!Epi::AFTER_DRAIN) { E(acc, cur, wr, wc, fr, fq); S.done(cur); }
        if (!has_next) break;
#pragma unroll
        for (int a = 0; a < 2; ++a)
#pragma unroll
            for (int b = 0; b < 2; ++b)
#pragma unroll
                for (int m = 0; m < 4; ++m)
#pragma unroll
                    for (int n = 0; n < 2; ++n) acc[a][b][m][n] = (f32x4){0.f, 0.f, 0.f, 0.f};
        cur = nxt; cA = nA; cB = nB; ++ui;
        if constexpr (ALIGN_EPI) { if (wr == 1) PG8_BAR; }
    }
    PG8_WAIT_V(0);
    if constexpr (!ALIGN_EPI) { if (wr == 0) PG8_BAR; }
    PG8_BAR;
    if constexpr (Epi::AFTER_DRAIN) { E.fused(acc, cur, wr, wc, fr, fq, lds, wid, lane); S.done(cur); }
#undef PG8_SA
#undef PG8_SB
#undef PG8_STAGE
#undef PG8_LDA
#undef PG8_LDB
#undef PG8_MMA
#undef PG8_WAIT_V
#undef PG8_WAIT_L
#undef PG8_BAR
#undef PG8_SCHED
}
}

__device__ __forceinline__ int gswz(int row, int chunk) { return row * 128 + ((chunk ^ ((row >> 1) & 7)) << 4); }
__device__ __forceinline__ void gemm_tile(const bf16_t* __restrict__ A, int lda, const bf16_t* __restrict__ Bt, int ldb, int K,
                                          int row0, int col0, unsigned char* lds, f32x16 (&acc)[2][2]) {
  int tid_ = tidx(); asm volatile("" : "+v"(tid_)); const int tid = tid_, lane = tid & 63, wid = tid >> 6, wm = wid >> 1, wn = wid & 1, r32 = lane & 31, hi = lane >> 5;
  unsigned char* As = lds; unsigned char* Bs = lds + 65536;
#pragma unroll
  for (int i = 0; i < 2; ++i)
#pragma unroll
    for (int j = 0; j < 2; ++j) acc[i][j] = f32x16{};
  const int lrow = tid >> 3, lc = tid & 7;
  const bf16_t* Ag = A + (size_t)(row0 + lrow) * lda + lc * 8;
  const bf16_t* Bg = Bt + (size_t)(col0 + lrow) * ldb + lc * 8;
  u32x4 ra[4], rb[2];
#pragma unroll
  for (int i = 0; i < 4; ++i) ra[i] = *(const u32x4*)(Ag + (size_t)(64 * i) * lda);
#pragma unroll
  for (int i = 0; i < 2; ++i) rb[i] = *(const u32x4*)(Bg + (size_t)(64 * i) * ldb);
#pragma unroll
  for (int i = 0; i < 4; ++i) *(u32x4*)(As + gswz(lrow + 64 * i, lc)) = ra[i];
#pragma unroll
  for (int i = 0; i < 2; ++i) *(u32x4*)(Bs + gswz(lrow + 64 * i, lc)) = rb[i];
  __syncthreads();
  const int nk = K / 64;
  for (int kt = 0; kt < nk; ++kt) {
    const int cur = kt & 1;
    if (kt + 1 < nk) {
#pragma unroll
      for (int i = 0; i < 4; ++i) ra[i] = *(const u32x4*)(Ag + (size_t)(64 * i) * lda + (kt + 1) * 64);
#pragma unroll
      for (int i = 0; i < 2; ++i) rb[i] = *(const u32x4*)(Bg + (size_t)(64 * i) * ldb + (kt + 1) * 64);
    }
    const unsigned char* Ac = As + cur * 32768; const unsigned char* Bc = Bs + cur * 16384;
#pragma unroll
    for (int kk = 0; kk < 4; ++kk) {
      bf16x8 af[2], bfr[2];
#pragma unroll
      for (int i = 0; i < 2; ++i) af[i] = *(const bf16x8*)(Ac + gswz(wm * 64 + i * 32 + r32, 2 * kk + hi));
#pragma unroll
      for (int j = 0; j < 2; ++j) bfr[j] = *(const bf16x8*)(Bc + gswz(wn * 64 + j * 32 + r32, 2 * kk + hi));
#pragma unroll
      for (int i = 0; i < 2; ++i)
#pragma unroll
        for (int j = 0; j < 2; ++j) acc[i][j] = __builtin_amdgcn_mfma_f32_32x32x16_bf16(af[i], bfr[j], acc[i][j], 0, 0, 0);
    }
    if (kt + 1 < nk) {
      unsigned char* An = As + (cur ^ 1) * 32768; unsigned char* Bn = Bs + (cur ^ 1) * 16384;
#pragma unroll
      for (int i = 0; i < 4; ++i) *(u32x4*)(An + gswz(lrow + 64 * i, lc)) = ra[i];
#pragma unroll
      for (int i = 0; i < 2; ++i) *(u32x4*)(Bn + gswz(lrow + 64 * i, lc)) = rb[i];
    }
    __syncthreads();
  }
}
__device__ __forceinline__ void pair_xchg(float v0, float v1, int lane, float& lo, float& hi2) {
  const bool odd = lane & 1;
  const float send = odd ? v0 : v1;
  const float recv = dpp_mov<0xB1>(send);
  lo = odd ? recv : v0; hi2 = odd ? v1 : recv;
}

__device__ __forceinline__ void phase_inproj(const Params& p, int l, unsigned char* lds) {
  int tid_ = tidx(); asm volatile("" : "+v"(tid_)); const int tid = tid_, lane = tid & 63, wid = tid >> 6, wm = wid >> 1, wn = wid & 1, r32 = lane & 31, hi = lane >> 5;
  const bf16_t* H = (const bf16_t*)(p.ws + WS_H);
  const bf16_t* W = (const bf16_t*)(p.ws + WS_WIN) + (size_t)l * PW * DM;
  bf16_t* PROJ = (bf16_t*)(p.ws + WS_PROJ);
  const float* RC = (const float*)(p.ws + WS_ROPE); const float* RS = RC + SEQ * 32;
  constexpr int NM = T / 256, NN = PW / 128, NU = NM * NN;
  for (int u = p.bx; u < NU + NM; u += p.gx) {
    if (u < NU) {
      const int pn = u / NM, pm = u % NM;
      const int row0 = pm * 256, col0 = pn * 128;
      f32x16 acc[2][2];
      gemm_tile(H, DM, W, DM, DM, row0, col0, lds, acc);
      const bool rope = (col0 >= C_DQ && col0 < C_DV);
      const float scl = (col0 >= C_MK && col0 < C_MV) ? 0.125f : ((col0 >= C_DQ && col0 < C_DK) ? QSCALE : 1.f);
#pragma unroll
      for (int i = 0; i < 2; ++i)
#pragma unroll
        for (int j = 0; j < 2; ++j)
#pragma unroll
          for (int q = 0; q < 8; ++q) {
            float lo, hi2; pair_xchg(acc[i][j][2 * q], acc[i][j][2 * q + 1], lane, lo, hi2);
            const int row = row0 + wm * 64 + i * 32 + crow(2 * q, hi) + (lane & 1);
            const int col = col0 + wn * 64 + j * 32 + (r32 & ~1);
            if (rope) {
              const int s = row % SEGL;
              if (s >= CTXL) {
                const int idx = (s - CTXL) * 32 + ((col & 63) >> 1);
                const float c = RC[idx], sn = RS[idx];
                const float t1 = lo, t2 = hi2; lo = t1 * c - t2 * sn; hi2 = t1 * sn + t2 * c;
              }
            }
            *(unsigned*)(PROJ + (size_t)row * PW + col) = cvtpk(lo * scl, hi2 * scl);
          }
    } else {
      const int pm = u - NU, rowb = pm * 256 + wid * 32;
      const bf16_t* WG = (const bf16_t*)(p.ws + WS_WG) + (size_t)l * 16 * DM;
      float* GT = (float*)(p.ws + WS_GATES);
      const int r16 = lane & 15, q4 = lane >> 4;
      f32x4 c0 = {0.f, 0.f, 0.f, 0.f}, c1 = {0.f, 0.f, 0.f, 0.f};
      const bf16_t* a0p = H + (size_t)(rowb + r16) * DM + q4 * 8;
      const bf16_t* a1p = a0p + (size_t)16 * DM;
      const bf16_t* bp = WG + (size_t)r16 * DM + q4 * 8;
#pragma unroll 4
      for (int ks = 0; ks < 32; ++ks) {
        const bf16x8 a0 = *(const bf16x8*)(a0p + ks * 32), a1 = *(const bf16x8*)(a1p + ks * 32), b = *(const bf16x8*)(bp + ks * 32);
        c0 = __builtin_amdgcn_mfma_f32_16x16x32_bf16(a0, b, c0, 0, 0, 0);
        c1 = __builtin_amdgcn_mfma_f32_16x16x32_bf16(a1, b, c1, 0, 0, 0);
      }
      const float gb = p.in[I_GATEB][l * 16 + r16];
#pragma unroll
      for (int j = 0; j < 4; ++j) {
        GT[(size_t)(rowb + q4 * 4 + j) * 16 + r16] = c0[j] + gb;
        GT[(size_t)(rowb + 16 + q4 * 4 + j) * 16 + r16] = c1[j] + gb;
      }
    }
  }
}

__device__ __forceinline__ void phase_outproj(const Params& p, int l, unsigned char* lds) {
  int tid_ = tidx(); asm volatile("" : "+v"(tid_)); const int tid = tid_, lane = tid & 63, wid = tid >> 6, wm = wid >> 1, wn = wid & 1, r32 = lane & 31, hi = lane >> 5;
  const bf16_t* MIX = (const bf16_t*)(p.ws + WS_MIX);
  const bf16_t* W = (const bf16_t*)(p.ws + WS_WOUT) + (size_t)l * DM * DM;
  float* XC = (float*)(p.ws + WS_XCUR);
  const float* MOD = (const float*)(p.ws + WS_MOD);
  constexpr int NM = T / 256, NN = DM / 128, NU = NM * NN;
  for (int u = p.bx; u < NU; u += p.gx) {
    const int pm = u / NN, pn = u % NN;
    if (l == DEPTH - 1 && (pm % 33) == 0) continue;
    const int row0 = pm * 256, col0 = pn * 128;
    for (int rep = 0; rep < REP_OUTP; ++rep) {
    f32x16 acc[2][2];
    gemm_tile(MIX, DM, W, DM, DM, row0, col0, lds, acc);
    const int mr = (pm % 33) == 0 ? 4 : pm / 33;
    const float* g1 = MOD + ((size_t)l * 5 + mr) * 6144 + 2048;
#pragma unroll
    for (int i = 0; i < 2; ++i)
#pragma unroll
      for (int j = 0; j < 2; ++j) {
        const int col = col0 + wn * 64 + j * 32 + r32;
        const float gg = (rep == REP_OUTP - 1) ? g1[col] : 0.f;
#pragma unroll
        for (int r = 0; r < 16; ++r) {
          const int row = row0 + wm * 64 + i * 32 + crow(r, hi);
          const float xo = (l == 0) ? in_row(p.in[I_X], p.in[I_CTX], row)[col] : XC[(size_t)row * DM + col];
          XC[(size_t)row * DM + col] = xo + gg * acc[i][j][r];
        }
      }
    }
  }
}
__device__ __forceinline__ void phase_peerq(const Params& p, int l, unsigned char* lds) {
  int tid_ = tidx(); asm volatile("" : "+v"(tid_)); const int tid = tid_, lane = tid & 63, wid = tid >> 6, wm = wid >> 1, wn = wid & 1, r32 = lane & 31, hi = lane >> 5;
  const bf16_t* H = (const bf16_t*)(p.ws + WS_H);
  const bf16_t* W = (const bf16_t*)(p.ws + WS_WQ) + (size_t)l * DM * DM;
  bf16_t* QP = (bf16_t*)(p.ws + WS_PROJ);
  constexpr int NM = T / 256, NN = DM / 128, NU = NM * NN;
  for (int u = p.bx; u < NU; u += p.gx) {
    const int pm = u / NN, pn = u % NN;
    if (l == DEPTH - 1 && (pm % 33) == 0) continue;
    const int row0 = pm * 256, col0 = pn * 128;
    f32x16 acc[2][2];
    gemm_tile(H, DM, W, DM, DM, row0, col0, lds, acc);
#pragma unroll
    for (int i = 0; i < 2; ++i)
#pragma unroll
      for (int j = 0; j < 2; ++j)
#pragma unroll
        for (int q = 0; q < 8; ++q) {
          float lo, hi2; pair_xchg(acc[i][j][2 * q], acc[i][j][2 * q + 1], lane, lo, hi2);
          const int row = row0 + wm * 64 + i * 32 + crow(2 * q, hi) + (lane & 1);
          const int col = col0 + wn * 64 + j * 32 + (r32 & ~1);
          *(unsigned*)(QP + (size_t)row * DM + col) = cvtpk(lo, hi2);
        }
  }
}


struct EpiInproj {
  static constexpr bool PERM = true, AFTER_DRAIN = false;
  bf16_t* PROJ; const float* RC; const float* RS; unsigned char* V8T;
  __device__ __forceinline__ void operator()(const pg8::f32x4 (&acc)[2][2][4][2], const pg8::Unit& u, int wr, int wc, int fr, int fq) const {
#pragma unroll
    for (int bj = 0; bj < 2; ++bj) {
      const int colt = u.pn * 256 + bj * 128;
      const bool rope = (colt >= C_DQ && colt < C_DV);
      const float scl = (colt >= C_MK && colt < C_MV) ? 0.125f : ((colt >= C_DQ && colt < C_DK) ? QSCALE : 1.f);
      const int col8 = colt + wc * 32 + 8 * fq;
      if (colt >= C_DV) {
        const int hh = (col8 - C_DV) >> 7, e0 = (col8 - C_DV) & 127;
#pragma unroll
        for (int ai = 0; ai < 2; ++ai)
#pragma unroll
          for (int m = 0; m < 4; ++m) {
            const int row = u.pm * 256 + ai * 128 + wr * 64 + m * 16 + fr;
            const int b = row / SEGL, s = row - b * SEGL, t = s >> 6, kk = s & 63;
            const int slot = ((kk >> 2) & 1) * 32 + (kk & 3) + 4 * ((kk >> 3) & 3) + 16 * (kk >> 5);
            unsigned char* vp = V8T + ((size_t)((b * 4 + hh) * NCH + t) * 128 + e0) * 80 + slot;
            const f32x4 v0 = acc[ai][bj][m][0], v1 = acc[ai][bj][m][1];
            int w0 = 0, w1 = 0;
            w0 = __builtin_amdgcn_cvt_pk_fp8_f32(v0[0], v0[1], w0, false); w0 = __builtin_amdgcn_cvt_pk_fp8_f32(v0[2], v0[3], w0, true);
            w1 = __builtin_amdgcn_cvt_pk_fp8_f32(v1[0], v1[1], w1, false); w1 = __builtin_amdgcn_cvt_pk_fp8_f32(v1[2], v1[3], w1, true);
            vp[0] = (unsigned char)(w0 & 0xFF); vp[80] = (unsigned char)((w0 >> 8) & 0xFF); vp[160] = (unsigned char)((w0 >> 16) & 0xFF); vp[240] = (unsigned char)((w0 >> 24) & 0xFF);
            vp[320] = (unsigned char)(w1 & 0xFF); vp[400] = (unsigned char)((w1 >> 8) & 0xFF); vp[480] = (unsigned char)((w1 >> 16) & 0xFF); vp[560] = (unsigned char)((w1 >> 24) & 0xFF);
          }
        continue;
      }
      unsigned char* qk8 = nullptr;
      if (rope) { const int isk = colt >= C_DK, cc = col8 - (isk ? C_DK : C_DQ); qk8 = V8T + (WS_QK8 - WS_V8T) + (size_t)isk * QK8_IMG + (size_t)(cc >> 7) * SEGL * QK8_PITCH + (cc & 127); }
#pragma unroll
      for (int ai = 0; ai < 2; ++ai)
#pragma unroll
        for (int m = 0; m < 4; ++m) {
          const int row = u.pm * 256 + ai * 128 + wr * 64 + m * 16 + fr;
          f32x4 v0 = acc[ai][bj][m][0], v1 = acc[ai][bj][m][1];
          if (rope) {
            const int s = row % SEGL;
            if (s >= CTXL) {
              const int idx = (s - CTXL) * 32 + ((col8 & 63) >> 1);
              const f32x4 c = *(const f32x4*)(RC + idx), sn = *(const f32x4*)(RS + idx);
              f32x4 a, b;
              a[0] = v0[0] * c[0] - v0[1] * sn[0]; a[1] = v0[0] * sn[0] + v0[1] * c[0]; a[2] = v0[2] * c[1] - v0[3] * sn[1]; a[3] = v0[2] * sn[1] + v0[3] * c[1];
              b[0] = v1[0] * c[2] - v1[1] * sn[2]; b[1] = v1[0] * sn[2] + v1[1] * c[2]; b[2] = v1[2] * c[3] - v1[3] * sn[3]; b[3] = v1[2] * sn[3] + v1[3] * c[3];
              v0 = a; v1 = b;
            }
          }
          if (rope) {
            const int b = row / SEGL, s = row - b * SEGL;
            int w0, w1; asm volatile("" : "=v"(w0), "=v"(w1));
            w0 = __builtin_amdgcn_cvt_pk_fp8_f32(v0[0] * scl, v0[1] * scl, w0, false); w0 = __builtin_amdgcn_cvt_pk_fp8_f32(v0[2] * scl, v0[3] * scl, w0, true);
            w1 = __builtin_amdgcn_cvt_pk_fp8_f32(v1[0] * scl, v1[1] * scl, w1, false); w1 = __builtin_amdgcn_cvt_pk_fp8_f32(v1[2] * scl, v1[3] * scl, w1, true);
            *(u32x2*)(qk8 + ((size_t)b * 4 * SEGL + s) * QK8_PITCH) = (u32x2){(unsigned)w0, (unsigned)w1};
            continue;
          }
          u32x4 w; w.x = cvtpk(v0[0] * scl, v0[1] * scl); w.y = cvtpk(v0[2] * scl, v0[3] * scl); w.z = cvtpk(v1[0] * scl, v1[1] * scl); w.w = cvtpk(v1[2] * scl, v1[3] * scl);
          *(u32x4*)(PROJ + (size_t)row * PW + col8) = w;
        }
    }
  }
};
struct EpiOutproj {
  static constexpr bool PERM = true, AFTER_DRAIN = false;
  float* XC; const float* MODL; const float* xin; const float* ctxin; int first; float gsc;
  __device__ __forceinline__ void operator()(const pg8::f32x4 (&acc)[2][2][4][2], const pg8::Unit& u, int wr, int wc, int fr, int fq) const {
    const int mr = (u.pm % 33) == 0 ? 4 : u.pm / 33;
    const float* g1 = MODL + (size_t)mr * 6144 + 2048;
#pragma unroll
    for (int bj = 0; bj < 2; ++bj) {
      const int col8 = u.pn * 256 + bj * 128 + wc * 32 + 8 * fq;
      const f32x4 ga = *(const f32x4*)(g1 + col8) * gsc, gb = *(const f32x4*)(g1 + col8 + 4) * gsc;
#pragma unroll
      for (int ai = 0; ai < 2; ++ai)
#pragma unroll
        for (int m = 0; m < 4; ++m) {
          const int row = u.pm * 256 + ai * 128 + wr * 64 + m * 16 + fr;
          const float* xo = first ? in_row(xin, ctxin, row) + col8 : XC + (size_t)row * DM + col8;
          const f32x4 xa = *(const f32x4*)xo, xb = *(const f32x4*)(xo + 4);
          *(f32x4*)(XC + (size_t)row * DM + col8) = xa + ga * acc[ai][bj][m][0];
          *(f32x4*)(XC + (size_t)row * DM + col8 + 4) = xb + gb * acc[ai][bj][m][1];
        }
    }
  }
};
struct EpiPeerq {
  static constexpr bool PERM = true, AFTER_DRAIN = false;
  bf16_t* QP;
  __device__ __forceinline__ void operator()(const pg8::f32x4 (&acc)[2][2][4][2], const pg8::Unit& u, int wr, int wc, int fr, int fq) const {
#pragma unroll
    for (int bj = 0; bj < 2; ++bj) {
      const int col8 = u.pn * 256 + bj * 128 + wc * 32 + 8 * fq;
#pragma unroll
      for (int ai = 0; ai < 2; ++ai)
#pragma unroll
        for (int m = 0; m < 4; ++m) {
          const int row = u.pm * 256 + ai * 128 + wr * 64 + m * 16 + fr;
          const f32x4 v0 = acc[ai][bj][m][0], v1 = acc[ai][bj][m][1];
          u32x4 w; w.x = cvtpk(v0[0], v0[1]); w.y = cvtpk(v0[2], v0[3]); w.z = cvtpk(v1[0], v1[1]); w.w = cvtpk(v1[2], v1[3]);
          *(u32x4*)(QP + (size_t)row * DM + col8) = w;
        }
    }
  }
};
__device__ __forceinline__ void phase_inproj2(const Params& p, int l, unsigned char* lds) {
  {
    pg8::Gemm g{(const bf16_t*)(p.ws + WS_H), (const bf16_t*)(p.ws + WS_WIN) + (size_t)l * PW * DM, T, PW, DM};
    pg8::StaticOrder S; S.init(T, PW, p.gx, p.bx);
    EpiInproj E{(bf16_t*)(p.ws + WS_PROJ), (const float*)(p.ws + WS_ROPE), (const float*)(p.ws + WS_ROPE) + SEQ * 32, p.ws + WS_V8T};
    pg8::gemm_phase<EpiInproj, pg8::StaticOrder, true, true>((PG8_LAS unsigned char*)lds, g, S, E);
  }
  int tid_ = tidx(); asm volatile("" : "+v"(tid_)); const int tid = tid_, lane = tid & 63, wid = tid >> 6;
  const bf16_t* H = (const bf16_t*)(p.ws + WS_H);
  for (int pm = p.gx - 1 - p.bx; pm < T / 256; pm += p.gx) {
    const int rowb = pm * 256 + wid * 32;
    const bf16_t* WG = (const bf16_t*)(p.ws + WS_WG) + (size_t)l * 16 * DM;
    float* GT = (float*)(p.ws + WS_GATES);
    const int r16 = lane & 15, q4 = lane >> 4;
    f32x4 c0 = {0.f, 0.f, 0.f, 0.f}, c1 = {0.f, 0.f, 0.f, 0.f};
    const bf16_t* a0p = H + (size_t)(rowb + r16) * DM + q4 * 8;
    const bf16_t* a1p = a0p + (size_t)16 * DM;
    const bf16_t* bp = WG + (size_t)r16 * DM + q4 * 8;
#pragma unroll 4
    for (int ks = 0; ks < 32; ++ks) {
      const bf16x8 a0 = *(const bf16x8*)(a0p + ks * 32), a1 = *(const bf16x8*)(a1p + ks * 32), b = *(const bf16x8*)(bp + ks * 32);
      c0 = __builtin_amdgcn_mfma_f32_16x16x32_bf16(a0, b, c0, 0, 0, 0);
      c1 = __builtin_amdgcn_mfma_f32_16x16x32_bf16(a1, b, c1, 0, 0, 0);
    }
    const float gb = p.in[I_GATEB][l * 16 + r16];
#pragma unroll
    for (int j = 0; j < 4; ++j) {
      GT[(size_t)(rowb + q4 * 4 + j) * 16 + r16] = c0[j] + gb;
      GT[(size_t)(rowb + 16 + q4 * 4 + j) * 16 + r16] = c1[j] + gb;
    }
  }
}
__device__ __forceinline__ void phase_outproj2(const Params& p, int l, unsigned char* lds) {
  pg8::Gemm g{(const bf16_t*)(p.ws + WS_MIX), (const bf16_t*)(p.ws + WS_WOUT) + (size_t)l * DM * DM, T, DM, DM};
  pg8::StaticOrder S; S.init(T, DM, p.gx, p.bx);
  for (int rep = 0; rep < REP_OUTP; ++rep) {
  EpiOutproj E{(float*)(p.ws + WS_XCUR), (const float*)(p.ws + WS_MOD) + (size_t)l * 5 * 6144, p.in[I_X], p.in[I_CTX], l == 0, (rep == REP_OUTP - 1) ? 1.f : 0.f};
  pg8::gemm_phase<EpiOutproj, pg8::StaticOrder, true, true>((PG8_LAS unsigned char*)lds, g, S, E);
  }
  tail_filler_tables(p, l, (T / 256) * (DM / 256), l == 0 ? 0 : NEXP, 2 * NEXP);
}
__device__ __forceinline__ void phase_peerq2(const Params& p, int l, unsigned char* lds) {
  pg8::Gemm g{(const bf16_t*)(p.ws + WS_H), (const bf16_t*)(p.ws + WS_WQ) + (size_t)l * DM * DM, T, DM, DM};
  pg8::StaticOrder S; S.init(T, DM, p.gx, p.bx);
  EpiPeerq E{(bf16_t*)(p.ws + WS_PROJ)};
  pg8::gemm_phase<EpiPeerq, pg8::StaticOrder, true, true>((PG8_LAS unsigned char*)lds, g, S, E);
  if (l < DEPTH - 1) tail_filler_tables(p, l + 1, (T / 256) * (DM / 256), 0, NEXP);
}

__device__ __forceinline__ void conv_unit(const Params& p, int l, int unit, unsigned char* lds) {
  int tid_ = tidx(); asm volatile("" : "+v"(tid_)); const int tid = tid_, lane = tid & 63, wid = tid >> 6;
  float* U = (float*)lds;
  const bf16_t* PROJ = (const bf16_t*)(p.ws + WS_PROJ);
  bf16_t* MIX = (bf16_t*)(p.ws + WS_MIX);
  const int row0 = unit * 32, b = row0 / SEGL, s0 = row0 - b * SEGL;
  const int seglo = s0 < CTXL ? 0 : CTXL, seghi = s0 < CTXL ? CTXL : SEGL;
  for (int rr = tid >> 5; rr < 62; rr += 16) {
    const int s = s0 - 15 + rr, c8 = (tid & 31) * 8;
    f32x4 u0 = {0.f, 0.f, 0.f, 0.f}, u1 = {0.f, 0.f, 0.f, 0.f};
    if (s >= seglo && s < seghi) {
      const bf16_t* pr = PROJ + (size_t)(b * SEGL + s) * PW + c8;
      const u32x4 a1 = *(const u32x4*)pr, a2 = *(const u32x4*)(pr + 256);
      u0.x = bflo(a1.x) * sigmoidf_(bflo(a2.x)); u0.y = bfhi(a1.x) * sigmoidf_(bfhi(a2.x));
      u0.z = bflo(a1.y) * sigmoidf_(bflo(a2.y)); u0.w = bfhi(a1.y) * sigmoidf_(bfhi(a2.y));
      u1.x = bflo(a1.z) * sigmoidf_(bflo(a2.z)); u1.y = bfhi(a1.z) * sigmoidf_(bfhi(a2.z));
      u1.z = bflo(a1.w) * sigmoidf_(bflo(a2.w)); u1.w = bfhi(a1.w) * sigmoidf_(bfhi(a2.w));
    }
    *(f32x4*)(U + rr * 256 + c8) = u0; *(f32x4*)(U + rr * 256 + c8 + 4) = u1;
  }
  __syncthreads();
  float* Y = U + 62 * 256;
  const float* cw = p.in[I_CONVW] + (size_t)l * 31 * 256;
#pragma unroll 1
  for (int q = 0; q < 4; ++q) {
    const int c = lane + 64 * q;
    float w[31];
#pragma unroll
    for (int j = 0; j < 31; ++j) w[j] = cw[j * 256 + c];
    const float bias = p.in[I_CONVB][l * 256 + c];
#pragma unroll
    for (int tt = 0; tt < 4; ++tt) {
      const int t = wid * 4 + tt;
      float a = bias;
#pragma unroll
      for (int j = 0; j < 31; ++j) a += U[(t + j) * 256 + c] * w[j];
      Y[t * 256 + c] = a;
    }
  }
  asm volatile("s_waitcnt lgkmcnt(0)" ::: "memory");
  float y[4][4];
#pragma unroll
  for (int tt = 0; tt < 4; ++tt)
#pragma unroll
    for (int q = 0; q < 4; ++q) y[tt][q] = Y[(wid * 4 + tt) * 256 + lane + 64 * q];
#pragma unroll
  for (int tt = 0; tt < 4; ++tt) {
    const int t = wid * 4 + tt;
    const float mean = wave_sum((y[tt][0] + y[tt][1]) + (y[tt][2] + y[tt][3])) * (1.f / 256.f);
    float v = 0.f;
#pragma unroll
    for (int q = 0; q < 4; ++q) { const float d = y[tt][q] - mean; v += d * d; }
    const float rs = rsqrtf(wave_sum(v) * (1.f / 256.f) + EPS);
#pragma unroll
    for (int q = 0; q < 4; ++q) {
      const int c = lane + 64 * q;
      const float z = (y[tt][q] - mean) * rs * p.in[I_CLNG][l * 256 + c] + p.in[I_CLNB][l * 256 + c];
      const float o = (ABL & 1) ? 0.f : z * sigmoidf_(z);
      MIX[(size_t)(row0 + t) * DM + c] = (bf16_t)(cvtpk(o, 0.f) & 0xffffu);
    }
  }
  __syncthreads();
}

__device__ __forceinline__ int ml_cidx(int ch, int dir) { return dir == 0 ? ch : (ch < 4 ? 3 - ch : 135 - ch); }
__device__ __forceinline__ void ml_load_tile(const bf16_t* src, float* dst, int tid) {
  const int r = tid >> 3, c8 = (tid & 7) * 8;
  const u32x4 a = *(const u32x4*)(src + (size_t)r * PW + c8);
  float* d = dst + r * 65 + c8;
  d[0] = bflo(a.x); d[1] = bfhi(a.x); d[2] = bflo(a.y); d[3] = bfhi(a.y); d[4] = bflo(a.z); d[5] = bfhi(a.z); d[6] = bflo(a.w); d[7] = bfhi(a.w);
}
__device__ __forceinline__ void ml_local_unit(const Params& p, int l, int unit, unsigned char* lds) {
  int tid_ = tidx(); asm volatile("" : "+v"(tid_)); const int tid = tid_, lane = tid & 63, wid = tid >> 6, r32 = lane & 31, hi = lane >> 5;
  float* Kt = (float*)lds; float* Vt = Kt + 64 * 65; float* WK = Vt + 64 * 65;
  const bf16_t* PROJ = (const bf16_t*)(p.ws + WS_PROJ);
  const float* GT = (const float*)(p.ws + WS_GATES);
  float* UL = (float*)(p.ws + WS_ULOC); float* META = (float*)(p.ws + WS_MLMETA);
  const int b = unit / (4 * NCH), hh = (unit / NCH) & 3, ch = unit % NCH;
  const int row0 = b * SEGL + ch * 64;
  ml_load_tile(PROJ + (size_t)row0 * PW + C_MK + hh * 64, Kt, tid);
  ml_load_tile(PROJ + (size_t)row0 * PW + C_MV + hh * 64, Vt, tid);
  if (wid < 2) {
    const int dir = wid;
    const float ig = GT[(size_t)(row0 + lane) * 16 + (2 * dir) * 4 + hh];
    const float lf = logsigmoidf_(GT[(size_t)(row0 + lane) * 16 + (2 * dir + 1) * 4 + hh]);
    float ps = lf;
    ps = wave_incl_scan(ps);
    const float tot = __uint_as_float((unsigned)__builtin_amdgcn_readlane((int)__float_as_uint(ps), 63));
    const float wlog = dir == 0 ? (tot - ps + ig) : (ps - lf + ig);
    const float mloc = wave_max(wlog);
    WK[dir * 64 + lane] = __expf(wlog - mloc);
    if (lane == 0) {
      const int seq = (b * 4 + hh) * 2 + dir, ci = ml_cidx(ch, dir);
      META[((size_t)seq * NCH + ci) * 4 + 0] = tot; META[((size_t)seq * NCH + ci) * 4 + 1] = mloc;
    }
  }
  __syncthreads();
  {
    const int dir = wid >> 2, et = (wid >> 1) & 1, dt = wid & 1;
    const int seq = (b * 4 + hh) * 2 + dir, ci = ml_cidx(ch, dir);
    float* slot = UL + ((size_t)seq * NCH + ci) * USTRIDE;
    f32x16 acc = {};
#pragma unroll 8
    for (int ks = 0; ks < 32; ++ks) {
      const int s = 2 * ks + hi;
      const float a = WK[dir * 64 + s] * Vt[s * 65 + et * 32 + r32];
      const float bb = Kt[s * 65 + dt * 32 + r32];
      acc = __builtin_amdgcn_mfma_f32_32x32x2f32(a, bb, acc, 0, 0, 0);
    }
#pragma unroll
    for (int r = 0; r < 16; ++r) slot[(et * 32 + crow(r, hi)) * 64 + dt * 32 + r32] = acc[r];
    if (et == 0) {
      float n = 0.f;
#pragma unroll 8
      for (int i = 0; i < 32; ++i) { const int s = hi * 32 + i; n += WK[dir * 64 + s] * Kt[s * 65 + dt * 32 + r32]; }
      n = sum_xor32(n);
      if (hi == 0) slot[4096 + dt * 32 + r32] = n;
    }
  }
  __syncthreads();
}
constexpr int MLP = 144;
constexpr size_t WS_CST = WS_H;
constexpr size_t WS_NST = WS_H + (size_t)32 * NCH * 4096 * 2;
__device__ __forceinline__ void ml_stage_rm(const bf16_t* src, size_t ld, unsigned char* dst, int tid) {
  const int r = tid >> 3, c8 = (tid & 7) * 8;
  *(u32x4*)(dst + r * MLP + c8 * 2) = *(const u32x4*)(src + (size_t)r * ld + c8);
}
__device__ __forceinline__ void ml_stage_tr(const bf16_t* src, size_t ld, unsigned char* dst, int tid) {
  const int r = tid >> 3, c8 = (tid & 7) * 8;
  const u32x4 a = *(const u32x4*)(src + (size_t)r * ld + c8);
  bf16_t* d = (bf16_t*)dst;
  d[(c8 + 0) * 72 + r] = (bf16_t)(a.x & 0xffffu); d[(c8 + 1) * 72 + r] = (bf16_t)(a.x >> 16);
  d[(c8 + 2) * 72 + r] = (bf16_t)(a.y & 0xffffu); d[(c8 + 3) * 72 + r] = (bf16_t)(a.y >> 16);
  d[(c8 + 4) * 72 + r] = (bf16_t)(a.z & 0xffffu); d[(c8 + 5) * 72 + r] = (bf16_t)(a.z >> 16);
  d[(c8 + 6) * 72 + r] = (bf16_t)(a.w & 0xffffu); d[(c8 + 7) * 72 + r] = (bf16_t)(a.w >> 16);
}
__device__ __forceinline__ void ml_local_unit2(const Params& p, int l, int unit, unsigned char* lds) {
  int tid_ = tidx(); asm volatile("" : "+v"(tid_)); const int tid = tid_, lane = tid & 63, wid = tid >> 6, r32 = lane & 31, hi = lane >> 5;
  unsigned char* KT = lds; unsigned char* VT = lds + 64 * MLP; float* WK = (float*)(lds + 2 * 64 * MLP);
  const bf16_t* PROJ = (const bf16_t*)(p.ws + WS_PROJ);
  const float* GT = (const float*)(p.ws + WS_GATES);
  float* UL = (float*)(p.ws + WS_ULOC); float* META = (float*)(p.ws + WS_MLMETA);
  const int b = unit / (4 * NCH), hh = (unit / NCH) & 3, ch = unit % NCH;
  const int row0 = b * SEGL + ch * 64;
  ml_stage_tr(PROJ + (size_t)row0 * PW + C_MK + hh * 64, PW, KT, tid);
  ml_stage_tr(PROJ + (size_t)row0 * PW + C_MV + hh * 64, PW, VT, tid);
  if (wid < 2) {
    const int dir = wid;
    const float ig = GT[(size_t)(row0 + lane) * 16 + (2 * dir) * 4 + hh];
    const float lf = logsigmoidf_(GT[(size_t)(row0 + lane) * 16 + (2 * dir + 1) * 4 + hh]);
    float ps = lf;
    ps = wave_incl_scan(ps);
    const float tot = __uint_as_float((unsigned)__builtin_amdgcn_readlane((int)__float_as_uint(ps), 63));
    const float wlog = dir == 0 ? (tot - ps + ig) : (ps - lf + ig);
    const float mloc = wave_max(wlog);
    WK[dir * 64 + lane] = __expf(wlog - mloc);
    if (lane == 0) {
      const int seq = (b * 4 + hh) * 2 + dir, ci = ml_cidx(ch, dir);
      META[((size_t)seq * NCH + ci) * 4 + 0] = tot; META[((size_t)seq * NCH + ci) * 4 + 1] = mloc;
    }
  }
  __syncthreads();
  {
    const int dir = wid >> 2, et = (wid >> 1) & 1, dt = wid & 1;
    const int seq = (b * 4 + hh) * 2 + dir, ci = ml_cidx(ch, dir);
    float* slot = UL + ((size_t)seq * NCH + ci) * USTRIDE;
    f32x16 acc = {};
#pragma unroll
    for (int ks = 0; ks < 4; ++ks) {
      const int s0 = ks * 16 + hi * 8;
      const u32x4 va = *(const u32x4*)(VT + (et * 32 + r32) * MLP + s0 * 2);
      const bf16x8 kb = *(const bf16x8*)(KT + (dt * 32 + r32) * MLP + s0 * 2);
      const f32x4 w0 = *(const f32x4*)(WK + dir * 64 + s0), w1 = *(const f32x4*)(WK + dir * 64 + s0 + 4);
      u32x4 sa; sa.x = cvtpk(bflo(va.x) * w0.x, bfhi(va.x) * w0.y); sa.y = cvtpk(bflo(va.y) * w0.z, bfhi(va.y) * w0.w);
      sa.z = cvtpk(bflo(va.z) * w1.x, bfhi(va.z) * w1.y); sa.w = cvtpk(bflo(va.w) * w1.z, bfhi(va.w) * w1.w);
      acc = __builtin_amdgcn_mfma_f32_32x32x16_bf16(*(const bf16x8*)&sa, kb, acc, 0, 0, 0);
    }
#pragma unroll
    for (int r = 0; r < 16; ++r) slot[(et * 32 + crow(r, hi)) * 64 + dt * 32 + r32] = acc[r];
    if (et == 0) {
      float n = 0.f;
#pragma unroll
      for (int i = 0; i < 4; ++i) {
        const int s0 = hi * 32 + i * 8;
        const u32x4 ka = *(const u32x4*)(KT + (dt * 32 + r32) * MLP + s0 * 2);
        const f32x4 w0 = *(const f32x4*)(WK + dir * 64 + s0), w1 = *(const f32x4*)(WK + dir * 64 + s0 + 4);
        n += bflo(ka.x) * w0.x + bfhi(ka.x) * w0.y + bflo(ka.y) * w0.z + bfhi(ka.y) * w0.w + bflo(ka.z) * w1.x + bfhi(ka.z) * w1.y + bflo(ka.w) * w1.z + bfhi(ka.w) * w1.w;
      }
      n = sum_xor32(n);
      if (hi == 0) slot[4096 + dt * 32 + r32] = n;
    }
  }
  __syncthreads();
}
__device__ __forceinline__ void ml_scan(const Params& p, unsigned char* lds) {
  float* UL = (float*)(p.ws + WS_ULOC); float* META = (float*)(p.ws + WS_MLMETA);
  int tid_ = tidx(); asm volatile("" : "+v"(tid_));
  const int tid = tid_, lane = tid & 63, wid = tid >> 6;
  float* DEC = (float*)lds;
  float* SCL = DEC + 2 * NCH;
  float* TMP = SCL + 2 * NCH;
  constexpr int NSL = (32 * USTRIDE + 511) / 512;
  const int first_ = p.gx > 64 ? 16 : 0, nb_ = p.gx - first_;
  for (int k_ = 0; k_ < 2 + (NSL + nb_ - 1) / nb_; ++k_) {
    int s_;
    if (k_ == 0) s_ = p.bx >= first_ ? p.bx - first_ : -1;
    else s_ = k_ * nb_ + (p.gx - 1 - p.bx);
    if (k_ > 0 && p.gx - 1 - p.bx >= nb_) s_ = -1;
    if (s_ < 0 || s_ >= NSL) continue;
    const int base0 = s_ * 512;
    const int seq0 = base0 / USTRIDE;
    if (wid < 2) {
      const int seq = seq0 + wid;
      if (seq < 32) {
        float* mt = META + (size_t)seq * NCH * 4;
        for (int c = lane; c < NCH; c += 64) { TMP[(wid * 2 + 0) * NCH + c] = mt[c * 4 + 0]; TMP[(wid * 2 + 1) * NCH + c] = mt[c * 4 + 1]; }
        asm volatile("s_waitcnt lgkmcnt(0)" ::: "memory");
        if (lane == 0) {
          float m = 0.f;
          for (int c = 0; c < NCH; ++c) {
            const float bl = TMP[(wid * 2 + 0) * NCH + c], mloc = TMP[(wid * 2 + 1) * NCH + c];
            const float mn = fmaxf(bl + m, mloc);
            DEC[wid * NCH + c] = __expf(bl + m - mn); SCL[wid * NCH + c] = __expf(mloc - mn);
            mt[c * 4 + 2] = m;
            m = mn;
          }
        }
      }
    }
    __syncthreads();
    const int idx = base0 + tid;
    if (idx < 32 * USTRIDE) {
      const int seq = idx / USTRIDE, e = idx - seq * USTRIDE, sl = seq - seq0;
      float* bp = UL + (size_t)seq * NCH * USTRIDE + e;
      bf16_t* CSTp = (bf16_t*)(p.ws + WS_CST) + (size_t)seq * NCH * 4096 + (e < 4096 ? e : 0);
      float* NSTp = (float*)(p.ws + WS_NST) + (size_t)seq * NCH * 64 + (e < 4096 ? 0 : e - 4096);
      const float* dec = DEC + sl * NCH; const float* scl = SCL + sl * NCH;
      float C = 0.f;
      constexpr int BT = 33;
      static_assert(NCH == 4 * BT, "scan batches");
      float ua[BT], ub[BT];
#define SCAN_LD(u_, c0_) _Pragma("unroll") for (int j = 0; j < BT; ++j) u_[j] = bp[(size_t)((c0_) + j) * USTRIDE];
#define SCAN_DO(u_, c0_) _Pragma("unroll") for (int j = 0; j < BT; ++j) { \
          if (e < 4096) CSTp[(size_t)((c0_) + j) * 4096] = (bf16_t)(cvtpk(C, 0.f) & 0xffffu); else NSTp[(size_t)((c0_) + j) * 64] = C; \
          C = dec[(c0_) + j] * C + scl[(c0_) + j] * u_[j]; }
      SCAN_LD(ua, 0)
#pragma unroll 1
      for (int c0 = 0; c0 < NCH; c0 += 2 * BT) {
        SCAN_LD(ub, c0 + BT)
        SCAN_DO(ua, c0)
        if (c0 + 2 * BT < NCH) { SCAN_LD(ua, c0 + 2 * BT) }
        SCAN_DO(ub, c0 + BT)
      }
#undef SCAN_LD
#undef SCAN_DO
    }
    __syncthreads();
  }
}
__device__ __forceinline__ void ml_out_unit(const Params& p, int l, int unit, unsigned char* lds) {
  int tid_ = tidx(); asm volatile("" : "+v"(tid_)); const int tid = tid_, lane = tid & 63, wid = tid >> 6, r32 = lane & 31, hi = lane >> 5;
  float* Qt = (float*)lds; float* Kt = Qt + 64 * 65; float* Vt = Kt + 64 * 65;
  float* Cs = Vt + 64 * 65;
  float* Ns = Cs + 2 * 64 * 65;
  float* Bq = Ns + 128;
  float* Gs = Bq + 128;
  float* Mi = Gs + 128;
  float* HB = Mi + 64;
  const bf16_t* PROJ = (const bf16_t*)(p.ws + WS_PROJ);
  const float* GT = (const float*)(p.ws + WS_GATES);
  const float* UL = (const float*)(p.ws + WS_ULOC); const float* META = (const float*)(p.ws + WS_MLMETA);
  bf16_t* MIX = (bf16_t*)(p.ws + WS_MIX);
  const int b = unit / (4 * NCH), hh = (unit / NCH) & 3, ch = unit % NCH;
  const int row0 = b * SEGL + ch * 64;
  ml_load_tile(PROJ + (size_t)row0 * PW + C_MQ + hh * 64, Qt, tid);
  ml_load_tile(PROJ + (size_t)row0 * PW + C_MK + hh * 64, Kt, tid);
  ml_load_tile(PROJ + (size_t)row0 * PW + C_MV + hh * 64, Vt, tid);
  for (int i = tid; i < 2 * USTRIDE; i += 512) {
    const int dir = i / USTRIDE, e = i - dir * USTRIDE;
    const int seq = (b * 4 + hh) * 2 + dir, ci = ml_cidx(ch, dir);
    const float v = UL[((size_t)seq * NCH + ci) * USTRIDE + e];
    if (e < 4096) Cs[dir * 64 * 65 + (e >> 6) * 65 + (e & 63)] = v; else Ns[dir * 64 + (e - 4096)] = v;
  }
  if (wid < 2) {
    const int dir = wid;
    const float ig = GT[(size_t)(row0 + lane) * 16 + (2 * dir) * 4 + hh];
    const float lf = logsigmoidf_(GT[(size_t)(row0 + lane) * 16 + (2 * dir + 1) * 4 + hh]);
    float ps = lf;
    ps = wave_incl_scan(ps);
    const float tot = __uint_as_float((unsigned)__builtin_amdgcn_readlane((int)__float_as_uint(ps), 63));
    const float bc = dir == 0 ? ps : (tot - ps + lf);
    Bq[dir * 64 + lane] = bc; Gs[dir * 64 + lane] = ig - bc;
    if (lane == 0) { const int seq = (b * 4 + hh) * 2 + dir, ci = ml_cidx(ch, dir); Mi[dir] = META[((size_t)seq * NCH + ci) * 4 + 2]; }
  }
  __syncthreads();
  {
    const int dir = wid >> 2, tt = (wid >> 1) & 1, et = wid & 1;
    const int t = tt * 32 + r32;
    f32x16 sa[2] = {};
#pragma unroll 4
    for (int ks = 0; ks < 32; ++ks) {
      const float bq = Qt[t * 65 + 2 * ks + hi];
      const float a0 = Kt[(r32) * 65 + 2 * ks + hi], a1 = Kt[(32 + r32) * 65 + 2 * ks + hi];
      sa[0] = __builtin_amdgcn_mfma_f32_32x32x2f32(a0, bq, sa[0], 0, 0, 0);
      sa[1] = __builtin_amdgcn_mfma_f32_32x32x2f32(a1, bq, sa[1], 0, 0, 0);
    }
    const float bt = Bq[dir * 64 + t];
    const float inter = bt + Mi[dir];
    float mx = -INFINITY;
    f32x16 dl[2];
#pragma unroll
    for (int st = 0; st < 2; ++st)
#pragma unroll
      for (int r = 0; r < 16; ++r) {
        const int s = st * 32 + crow(r, hi);
        const bool ok = dir == 0 ? (s <= t) : (s >= t);
        const float d = ok ? bt + Gs[dir * 64 + s] : -INFINITY;
        dl[st][r] = d; mx = fmaxf(mx, d);
      }
    mx = max_xor32(mx);
    const float mt = fmaxf(inter, mx);
    const float iw = __expf(inter - mt);
    float rsum = 0.f;
#pragma unroll
    for (int st = 0; st < 2; ++st)
#pragma unroll
      for (int r = 0; r < 16; ++r) { const float w = __expf(dl[st][r] - mt); sa[st][r] *= w; rsum += sa[st][r]; }
    rsum = sum_xor32(rsum);
    float qn = 0.f;
#pragma unroll 8
    for (int i = 0; i < 32; ++i) { const int d = hi * 32 + i; qn += Ns[dir * 64 + d] * Qt[t * 65 + d]; }
    qn = sum_xor32(qn);
    const float den = rsum + iw * qn;
    const float rden = 1.f / fmaxf(fabsf(den), __expf(-mt));
    f32x16 an = {}, ac = {};
#pragma unroll
    for (int st = 0; st < 2; ++st)
#pragma unroll
      for (int r = 0; r < 16; ++r) {
        const float a = Vt[(st * 32 + crow(r, hi)) * 65 + et * 32 + r32];
        an = __builtin_amdgcn_mfma_f32_32x32x2f32(a, sa[st][r], an, 0, 0, 0);
      }
    const float* Cd = Cs + dir * 64 * 65;
#pragma unroll 4
    for (int ks = 0; ks < 32; ++ks) {
      const float a = Cd[(et * 32 + r32) * 65 + 2 * ks + hi];
      const float bq = Qt[t * 65 + 2 * ks + hi];
      ac = __builtin_amdgcn_mfma_f32_32x32x2f32(a, bq, ac, 0, 0, 0);
    }
#pragma unroll
    for (int r = 0; r < 16; ++r) HB[dir * 64 * 65 + t * 65 + et * 32 + crow(r, hi)] = (an[r] + iw * ac[r]) * rden;
  }
  __syncthreads();
  {
    const int t = tid >> 3, e8 = (tid & 7) * 8;
    float v[8]; float ss = 0.f;
#pragma unroll
    for (int i = 0; i < 8; ++i) { v[i] = HB[t * 65 + e8 + i] + HB[64 * 65 + t * 65 + e8 + i]; ss += v[i] * v[i]; }
    ss += dpp_mov<0xB1>(ss); ss += dpp_mov<0x4E>(ss); ss += dpp_mov<0x141>(ss);
    const float rs = rsqrtf(ss * (1.f / 64.f) + EPS);
    const u32x4 ov = *(const u32x4*)(PROJ + (size_t)(row0 + t) * PW + C_MO + hh * 64 + e8);
    const float og[8] = {bflo(ov.x), bfhi(ov.x), bflo(ov.y), bfhi(ov.y), bflo(ov.z), bfhi(ov.z), bflo(ov.w), bfhi(ov.w)};
    const float* g = p.in[I_MNORMG] + l * 64 + e8;
    float o[8];
#pragma unroll
    for (int i = 0; i < 8; ++i) o[i] = (ABL & 2) ? 0.f : v[i] * rs * g[i] * sigmoidf_(og[i]);
    u32x4 w; w.x = cvtpk(o[0], o[1]); w.y = cvtpk(o[2], o[3]); w.z = cvtpk(o[4], o[5]); w.w = cvtpk(o[6], o[7]);
    *(u32x4*)(MIX + (size_t)(row0 + t) * DM + 256 + hh * 64 + e8) = w;
  }
  __syncthreads();
}


struct MlOutPf { u32x4 q, k, v, c0, c1, ov; float ns0, ns1, g_ig, g_lf, mi; };
__device__ __forceinline__ void ml_out_fetch(const Params& p, int unit, int tid, MlOutPf& f) {
  const int lane = tid & 63, wid = tid >> 6;
  const bf16_t* PROJ = (const bf16_t*)(p.ws + WS_PROJ);
  const float* GT = (const float*)(p.ws + WS_GATES);
  const bf16_t* CST = (const bf16_t*)(p.ws + WS_CST); const float* NST = (const float*)(p.ws + WS_NST); const float* META = (const float*)(p.ws + WS_MLMETA);
  const int b = unit / (4 * NCH), hh = (unit / NCH) & 3, ch = unit % NCH;
  const int row0 = b * SEGL + ch * 64;
  const int r = tid >> 3, c8 = (tid & 7) * 8;
  const bf16_t* prow = PROJ + (size_t)(row0 + r) * PW + hh * 64 + c8;
  f.q = *(const u32x4*)(prow + C_MQ); f.k = *(const u32x4*)(prow + C_MK); f.v = *(const u32x4*)(prow + C_MV); f.ov = *(const u32x4*)(prow + C_MO);
  const int seq0 = (b * 4 + hh) * 2, ci0 = ml_cidx(ch, 0), ci1 = ml_cidx(ch, 1);
  f.c0 = *(const u32x4*)(CST + ((size_t)seq0 * NCH + ci0) * 4096 + r * 64 + c8);
  f.c1 = *(const u32x4*)(CST + ((size_t)(seq0 + 1) * NCH + ci1) * 4096 + r * 64 + c8);
  f.ns0 = 0.f; f.ns1 = 0.f; f.g_ig = 0.f; f.g_lf = 0.f; f.mi = 0.f;
  if (tid < 64) { f.ns0 = NST[((size_t)seq0 * NCH + ci0) * 64 + tid]; f.ns1 = NST[((size_t)(seq0 + 1) * NCH + ci1) * 64 + tid]; }
  if (wid < 2) {
    const int dir = wid;
    f.g_ig = GT[(size_t)(row0 + lane) * 16 + (2 * dir) * 4 + hh];
    f.g_lf = GT[(size_t)(row0 + lane) * 16 + (2 * dir + 1) * 4 + hh];
    f.mi = META[((size_t)(seq0 + dir) * NCH + (dir ? ci1 : ci0)) * 4 + 2];
  }
}
__device__ __forceinline__ void ml_put_rm(const u32x4 a, unsigned char* dst, int tid) { const int r = tid >> 3, c8 = (tid & 7) * 8; *(u32x4*)(dst + r * MLP + c8 * 2) = a; }
__device__ __forceinline__ void ml_put_tr(const u32x4 a, unsigned char* dst, int tid) {
  const int r = tid >> 3, c8 = (tid & 7) * 8;
  bf16_t* d = (bf16_t*)dst;
  d[(c8 + 0) * 72 + r] = (bf16_t)(a.x & 0xffffu); d[(c8 + 1) * 72 + r] = (bf16_t)(a.x >> 16);
  d[(c8 + 2) * 72 + r] = (bf16_t)(a.y & 0xffffu); d[(c8 + 3) * 72 + r] = (bf16_t)(a.y >> 16);
  d[(c8 + 4) * 72 + r] = (bf16_t)(a.z & 0xffffu); d[(c8 + 5) * 72 + r] = (bf16_t)(a.z >> 16);
  d[(c8 + 6) * 72 + r] = (bf16_t)(a.w & 0xffffu); d[(c8 + 7) * 72 + r] = (bf16_t)(a.w >> 16);
}
__device__ __forceinline__ void ml_out_unit2(const Params& p, int l, int unit, unsigned char* lds, const MlOutPf& f, int next, MlOutPf& fn) {
  int tid_ = tidx(); asm volatile("" : "+v"(tid_)); const int tid = tid_, lane = tid & 63, wid = tid >> 6, r32 = lane & 31, hi = lane >> 5;
  unsigned char* Qs = lds; unsigned char* Ks = lds + 64 * MLP; unsigned char* VT = lds + 2 * 64 * MLP; unsigned char* Cs = lds + 3 * 64 * MLP;
  float* Ns = (float*)(lds + 5 * 64 * MLP);
  float* Bq = Ns + 128;
  float* Gs = Bq + 128;
  float* Mi = Gs + 128;
  float* HB = Mi + 64;
  const bf16_t* PROJ = (const bf16_t*)(p.ws + WS_PROJ);
  const float* GT = (const float*)(p.ws + WS_GATES);
  const bf16_t* CST = (const bf16_t*)(p.ws + WS_CST); const float* NST = (const float*)(p.ws + WS_NST); const float* META = (const float*)(p.ws + WS_MLMETA);
  bf16_t* MIX = (bf16_t*)(p.ws + WS_MIX);
  const int b = unit / (4 * NCH), hh = (unit / NCH) & 3, ch = unit % NCH;
  const int row0 = b * SEGL + ch * 64;
  ml_put_rm(f.q, Qs, tid); ml_put_rm(f.k, Ks, tid); ml_put_tr(f.v, VT, tid);
  ml_put_rm(f.c0, Cs, tid); ml_put_rm(f.c1, Cs + 64 * MLP, tid);
  if (tid < 64) { Ns[tid] = f.ns0; Ns[64 + tid] = f.ns1; }
  if (wid < 2) {
    const int dir = wid;
    const float ig = f.g_ig;
    const float lf = logsigmoidf_(f.g_lf);
    float ps = lf;
    ps = wave_incl_scan(ps);
    const float tot = __uint_as_float((unsigned)__builtin_amdgcn_readlane((int)__float_as_uint(ps), 63));
    const float bc = dir == 0 ? ps : (tot - ps + lf);
    Bq[dir * 64 + lane] = bc; Gs[dir * 64 + lane] = ig - bc;
    if (lane == 0) Mi[dir] = f.mi;
  }
  const u32x4 ov = f.ov;
  if (next >= 0) ml_out_fetch(p, next, tid, fn);
  __syncthreads();
  {
    const int dir = wid >> 2, tt = (wid >> 1) & 1, et = wid & 1;
    const int t = tt * 32 + r32;
    f32x16 sa[2] = {};
    bf16x8 bq[4];
#pragma unroll
    for (int ks = 0; ks < 4; ++ks) {
      bq[ks] = *(const bf16x8*)(Qs + t * MLP + (ks * 16 + hi * 8) * 2);
      const bf16x8 a0 = *(const bf16x8*)(Ks + r32 * MLP + (ks * 16 + hi * 8) * 2), a1 = *(const bf16x8*)(Ks + (32 + r32) * MLP + (ks * 16 + hi * 8) * 2);
      sa[0] = __builtin_amdgcn_mfma_f32_32x32x16_bf16(a0, bq[ks], sa[0], 0, 0, 0);
      sa[1] = __builtin_amdgcn_mfma_f32_32x32x16_bf16(a1, bq[ks], sa[1], 0, 0, 0);
    }
    const float bt = Bq[dir * 64 + t];
    const float inter = bt + Mi[dir];
    float mx = -INFINITY;
    f32x16 dl[2];
#pragma unroll
    for (int st = 0; st < 2; ++st)
#pragma unroll
      for (int r = 0; r < 16; ++r) {
        const int s = st * 32 + crow(r, hi);
        const bool ok = dir == 0 ? (s <= t) : (s >= t);
        const float d = ok ? bt + Gs[dir * 64 + s] : -INFINITY;
        dl[st][r] = d; mx = fmaxf(mx, d);
      }
    mx = max_xor32(mx);
    const float mt = fmaxf(inter, mx);
    const float iw = __expf(inter - mt);
    float rsum = 0.f;
#pragma unroll
    for (int st = 0; st < 2; ++st)
#pragma unroll
      for (int r = 0; r < 16; ++r) { const float w = __expf(dl[st][r] - mt); sa[st][r] *= w; rsum += sa[st][r]; }
    rsum = sum_xor32(rsum);
    float qn = 0.f;
#pragma unroll
    for (int i = 0; i < 4; ++i) {
      const int d0 = hi * 32 + i * 8;
      const u32x4 qa = *(const u32x4*)(Qs + t * MLP + d0 * 2);
      const f32x4 n0 = *(const f32x4*)(Ns + dir * 64 + d0), n1 = *(const f32x4*)(Ns + dir * 64 + d0 + 4);
      qn += bflo(qa.x) * n0.x + bfhi(qa.x) * n0.y + bflo(qa.y) * n0.z + bfhi(qa.y) * n0.w + bflo(qa.z) * n1.x + bfhi(qa.z) * n1.y + bflo(qa.w) * n1.z + bfhi(qa.w) * n1.w;
    }
    qn = sum_xor32(qn);
    const float den = rsum + iw * qn;
    const float rden = 1.f / fmaxf(fabsf(den), __expf(-mt));
    f32x16 an = {}, ac = {};
#pragma unroll
    for (int st = 0; st < 2; ++st)
#pragma unroll
      for (int k2 = 0; k2 < 2; ++k2) {
        u32x4 bx; bx.x = cvtpk(sa[st][8 * k2 + 0], sa[st][8 * k2 + 1]); bx.y = cvtpk(sa[st][8 * k2 + 2], sa[st][8 * k2 + 3]);
        bx.z = cvtpk(sa[st][8 * k2 + 4], sa[st][8 * k2 + 5]); bx.w = cvtpk(sa[st][8 * k2 + 6], sa[st][8 * k2 + 7]);
        const unsigned char* vrow = VT + (et * 32 + r32) * MLP + (st * 32 + 16 * k2 + 4 * hi) * 2;
        const u32x2 v0 = *(const u32x2*)vrow, v1 = *(const u32x2*)(vrow + 16);
        u32x4 ax; ax.x = v0.x; ax.y = v0.y; ax.z = v1.x; ax.w = v1.y;
        an = __builtin_amdgcn_mfma_f32_32x32x16_bf16(*(const bf16x8*)&ax, *(const bf16x8*)&bx, an, 0, 0, 0);
      }
    const unsigned char* Cd = Cs + dir * 64 * MLP;
#pragma unroll
    for (int ks = 0; ks < 4; ++ks) {
      const bf16x8 a = *(const bf16x8*)(Cd + (et * 32 + r32) * MLP + (ks * 16 + hi * 8) * 2);
      ac = __builtin_amdgcn_mfma_f32_32x32x16_bf16(a, bq[ks], ac, 0, 0, 0);
    }
#pragma unroll
    for (int r = 0; r < 16; ++r) HB[dir * 64 * 65 + t * 65 + et * 32 + crow(r, hi)] = (an[r] + iw * ac[r]) * rden;
  }
  __syncthreads();
  {
    const int t = tid >> 3, e8 = (tid & 7) * 8;
    float v[8]; float ss = 0.f;
#pragma unroll
    for (int i = 0; i < 8; ++i) { v[i] = HB[t * 65 + e8 + i] + HB[64 * 65 + t * 65 + e8 + i]; ss += v[i] * v[i]; }
    ss += dpp_mov<0xB1>(ss); ss += dpp_mov<0x4E>(ss); ss += dpp_mov<0x141>(ss);
    const float rs = rsqrtf(ss * (1.f / 64.f) + EPS);
    const float og[8] = {bflo(ov.x), bfhi(ov.x), bflo(ov.y), bfhi(ov.y), bflo(ov.z), bfhi(ov.z), bflo(ov.w), bfhi(ov.w)};
    const float* g = p.in[I_MNORMG] + l * 64 + e8;
    float o[8];
#pragma unroll
    for (int i = 0; i < 8; ++i) o[i] = (ABL & 2) ? 0.f : v[i] * rs * g[i] * sigmoidf_(og[i]);
    u32x4 w; w.x = cvtpk(o[0], o[1]); w.y = cvtpk(o[2], o[3]); w.z = cvtpk(o[4], o[5]); w.w = cvtpk(o[6], o[7]);
    *(u32x4*)(MIX + (size_t)(row0 + t) * DM + 256 + hh * 64 + e8) = w;
  }
  __syncthreads();
}

#define KSWZ(row, colB) ((row) * 256 + ((colB) ^ (((row) & 15) << 4)))
#define SBAR() __builtin_amdgcn_sched_barrier(0)
constexpr int ATT_SHM_V = 128 * 80, ATT_SHM_K = 64 * QK8_PITCH;
constexpr float ATT_THR = 8.0f;
__device__ __forceinline__ int v_st(int k, int c) { const int kk = (k & ~0xC) | ((k & 4) << 1) | ((k & 8) >> 1); return ((kk >> 3) * 4 + (c >> 5)) * 512 + ((kk & 7) * 32 + (c & 31)) * 2; }
__device__ __forceinline__ int v_rd_base(int lane) { return ((lane & 3) << 3) | (((lane >> 2) & 3) << 6) | (((lane >> 4) & 1) << 5) | (((lane >> 5) & 1) << 8); }
constexpr int v_rd_off(int d0, int ks, int half) { return d0 * 512 + ks * 4096 + half * 2048; }
template <int OFF> __device__ __forceinline__ s16x4 tr_read(int vb) {
  s16x4 r; asm volatile("ds_read_b64_tr_b16 %0, %1 offset:%2" : "=&v"(r) : "v"(vb), "i"(OFF) : "memory"); return r;
}
template <int D0> __device__ __forceinline__ void pv_one(f32x16& od, int vb, bf16x8 pa0, bf16x8 pa1, bf16x8 pa2, bf16x8 pa3) {
  const s16x4 l0 = tr_read<v_rd_off(D0, 0, 0)>(vb), h0 = tr_read<v_rd_off(D0, 0, 1)>(vb), l1 = tr_read<v_rd_off(D0, 1, 0)>(vb), h1 = tr_read<v_rd_off(D0, 1, 1)>(vb);
  const s16x4 l2 = tr_read<v_rd_off(D0, 2, 0)>(vb), h2 = tr_read<v_rd_off(D0, 2, 1)>(vb), l3 = tr_read<v_rd_off(D0, 3, 0)>(vb), h3 = tr_read<v_rd_off(D0, 3, 1)>(vb);
  asm volatile("s_waitcnt lgkmcnt(0)" ::: "memory"); SBAR();
#define PK(L, H) (bf16x8){L[0], L[1], L[2], L[3], H[0], H[1], H[2], H[3]}
  od = __builtin_amdgcn_mfma_f32_32x32x16_bf16(pa0, PK(l0, h0), od, 0, 0, 0);
  od = __builtin_amdgcn_mfma_f32_32x32x16_bf16(pa1, PK(l1, h1), od, 0, 0, 0);
  od = __builtin_amdgcn_mfma_f32_32x32x16_bf16(pa2, PK(l2, h2), od, 0, 0, 0);
  od = __builtin_amdgcn_mfma_f32_32x32x16_bf16(pa3, PK(l3, h3), od, 0, 0, 0);
#undef PK
}
template <int D0> __device__ __forceinline__ void pv_two(f32x16& oa, f32x16& ob, int vb, bf16x8 a0, bf16x8 a1, bf16x8 a2, bf16x8 a3, bf16x8 b0, bf16x8 b1, bf16x8 b2, bf16x8 b3) {
  const s16x4 l0 = tr_read<v_rd_off(D0, 0, 0)>(vb), h0 = tr_read<v_rd_off(D0, 0, 1)>(vb), l1 = tr_read<v_rd_off(D0, 1, 0)>(vb), h1 = tr_read<v_rd_off(D0, 1, 1)>(vb);
  const s16x4 l2 = tr_read<v_rd_off(D0, 2, 0)>(vb), h2 = tr_read<v_rd_off(D0, 2, 1)>(vb), l3 = tr_read<v_rd_off(D0, 3, 0)>(vb), h3 = tr_read<v_rd_off(D0, 3, 1)>(vb);
  asm volatile("s_waitcnt lgkmcnt(0)" ::: "memory"); SBAR();
#define PK(L, H) (bf16x8){L[0], L[1], L[2], L[3], H[0], H[1], H[2], H[3]}
  const bf16x8 v0 = PK(l0, h0), v1 = PK(l1, h1), v2 = PK(l2, h2), v3 = PK(l3, h3);
  oa = __builtin_amdgcn_mfma_f32_32x32x16_bf16(a0, v0, oa, 0, 0, 0);
  ob = __builtin_amdgcn_mfma_f32_32x32x16_bf16(b0, v0, ob, 0, 0, 0);
  oa = __builtin_amdgcn_mfma_f32_32x32x16_bf16(a1, v1, oa, 0, 0, 0);
  ob = __builtin_amdgcn_mfma_f32_32x32x16_bf16(b1, v1, ob, 0, 0, 0);
  oa = __builtin_amdgcn_mfma_f32_32x32x16_bf16(a2, v2, oa, 0, 0, 0);
  ob = __builtin_amdgcn_mfma_f32_32x32x16_bf16(b2, v2, ob, 0, 0, 0);
  oa = __builtin_amdgcn_mfma_f32_32x32x16_bf16(a3, v3, oa, 0, 0, 0);
  ob = __builtin_amdgcn_mfma_f32_32x32x16_bf16(b3, v3, ob, 0, 0, 0);
#undef PK
}
struct KQFrag { bf16x8 b0, b1, q; };
__device__ __forceinline__ void att_ldkq(KQFrag& f, const LAS unsigned char* l3, int akk, int akq) {
  const LAS unsigned char* kp = l3 + akk;
  f.b0 = *(const LAS bf16x8*)kp; f.b1 = *(const LAS bf16x8*)(kp + 8192); f.q = *(const LAS bf16x8*)(l3 + akq);
}
#define ATT_MF(pa_, pb_, f_) do { pa_ = __builtin_amdgcn_mfma_f32_32x32x16_bf16(f_.b0, f_.q, pa_, 0, 0, 0); pb_ = __builtin_amdgcn_mfma_f32_32x32x16_bf16(f_.b1, f_.q, pb_, 0, 0, 0); } while (0)
__device__ __forceinline__ void att_qk_all(f32x16& p0, f32x16& p1, f32x16& q0, f32x16& q1, KQFrag& f0, const LAS unsigned char* l3, int akk0, int akq0, float ia, float ib) {
  KQFrag f1;
#pragma unroll
  for (int r = 0; r < 16; ++r) { p0[r] = ia; p1[r] = ia; q0[r] = ib; q1[r] = ib; }
  att_ldkq(f1, l3, akk0 ^ (1 << 5), akq0 ^ (1 << 5)); ATT_MF(p0, p1, f0); SBAR();
  att_ldkq(f0, l3, akk0 ^ (2 << 5), akq0 ^ (2 << 5)); ATT_MF(p0, p1, f1); SBAR();
  att_ldkq(f1, l3, akk0 ^ (3 << 5), akq0 ^ (3 << 5)); ATT_MF(p0, p1, f0); SBAR();
  att_ldkq(f0, l3, akk0 ^ (4 << 5), akq0 ^ (4 << 5)); ATT_MF(p0, p1, f1); SBAR();
  att_ldkq(f1, l3, akk0 ^ (5 << 5), akq0 ^ (5 << 5)); ATT_MF(q0, q1, f0); SBAR();
  att_ldkq(f0, l3, akk0 ^ (6 << 5), akq0 ^ (6 << 5)); ATT_MF(q0, q1, f1); SBAR();
  att_ldkq(f1, l3, akk0 ^ (7 << 5), akq0 ^ (7 << 5)); ATT_MF(q0, q1, f0); SBAR();
  ATT_MF(q0, q1, f1); SBAR();
}
__device__ __forceinline__ void att_softmax(f32x16& p0, f32x16& p1, float& m_reg, float& l_reg, float& alpha, bool first, i32x8& pa) {
  alpha = 1.f;
  if (first) {
    float pmax = p0[0];
#pragma unroll
    for (int r = 1; r < 16; ++r) pmax = fmaxf(pmax, p0[r]);
#pragma unroll
    for (int r = 0; r < 16; ++r) pmax = fmaxf(pmax, p1[r]);
    { auto rr = __builtin_amdgcn_permlane32_swap(__float_as_uint(pmax), __float_as_uint(pmax), false, false);
      pmax = fmaxf(__uint_as_float(rr[0]), __uint_as_float(rr[1])); }
    alpha = 0.f; m_reg = pmax;
#pragma unroll
    for (int r = 0; r < 16; ++r) { p0[r] -= pmax; p1[r] -= pmax; }
  }
#pragma unroll
  for (int r = 0; r < 16; ++r) { p0[r] = __builtin_amdgcn_exp2f(p0[r]); p1[r] = __builtin_amdgcn_exp2f(p1[r]); }
  float ps;
  {
#define VADD(d_, a_, b_) asm("v_add_f32_e32 %0, %1, %2" : "=v"(d_) : "v"(a_), "v"(b_))
    float s0, s1, s2, s3;
    VADD(s0, p0[0], p0[1]); VADD(s1, p0[8], p0[9]); VADD(s2, p1[0], p1[1]); VADD(s3, p1[8], p1[9]);
#pragma unroll
    for (int r = 2; r < 8; ++r) { VADD(s0, s0, p0[r]); VADD(s1, s1, p0[8 + r]); VADD(s2, s2, p1[r]); VADD(s3, s3, p1[8 + r]); }
    VADD(s0, s0, s1); VADD(s2, s2, s3); VADD(ps, s0, s2);
#undef VADD
  }
  { auto rr = __builtin_amdgcn_permlane32_swap(__float_as_uint(ps), __float_as_uint(ps), false, false);
    ps = __uint_as_float(rr[0]) + __uint_as_float(rr[1]); }
  if (__builtin_expect(!first && __any(ps > 256.f), 0)) {
    float emax = p0[0];
#pragma unroll
    for (int r = 1; r < 16; ++r) emax = fmaxf(emax, p0[r]);
#pragma unroll
    for (int r = 0; r < 16; ++r) emax = fmaxf(emax, p1[r]);
    { auto rr = __builtin_amdgcn_permlane32_swap(__float_as_uint(emax), __float_as_uint(emax), false, false);
      emax = fmaxf(__uint_as_float(rr[0]), __uint_as_float(rr[1])); }
    const float delta = fmaxf(__builtin_amdgcn_logf(emax), 0.f);
    alpha = __builtin_amdgcn_exp2f(-delta); m_reg += delta;
#pragma unroll
    for (int r = 0; r < 16; ++r) { p0[r] *= alpha; p1[r] *= alpha; }
    ps *= alpha;
  }
  l_reg = l_reg * alpha + ps;
#pragma unroll
  for (int v = 0; v < 4; ++v) {
    int w0, w1; asm volatile("" : "=v"(w0), "=v"(w1));
    w0 = __builtin_amdgcn_cvt_pk_fp8_f32(p0[4 * v], p0[4 * v + 1], w0, false); w0 = __builtin_amdgcn_cvt_pk_fp8_f32(p0[4 * v + 2], p0[4 * v + 3], w0, true);
    w1 = __builtin_amdgcn_cvt_pk_fp8_f32(p1[4 * v], p1[4 * v + 1], w1, false); w1 = __builtin_amdgcn_cvt_pk_fp8_f32(p1[4 * v + 2], p1[4 * v + 3], w1, true);
    pa[v] = w0; pa[4 + v] = w1;
  }
}
__device__ __forceinline__ void att_unit(const unsigned char* __restrict__ Q8, const unsigned char* __restrict__ K8, const unsigned char* __restrict__ V8, bf16_t* __restrict__ Ob,
                                         int nkeys, float lam, const float* __restrict__ ng, float oscale, unsigned char* lds) {
  int tid_ = tidx(); asm volatile("" : "+v"(tid_)); const int tid = tid_, wid = tid >> 6, lane = tid & 63, r32 = lane & 31, hi = lane >> 5;
  const int grp = __builtin_amdgcn_readfirstlane(wid >> 2);
  unsigned char* V_lds = lds; unsigned char* K_lds = lds + 2 * ATT_SHM_V;
  float* wsl = (float*)(lds + 2 * ATT_SHM_V + 2 * ATT_SHM_K) + wid * 64; float* li_l = wsl; float* al_l = wsl + 32;
  float m0 = 0.f, l0 = 0.f, m1 = 0.f, l1 = 0.f;
  f32x16 o0[4] = {}, o1[4] = {};
  unsigned char* Q_lds = lds + 2 * ATT_SHM_V + 2 * ATT_SHM_K + 2048;
#pragma unroll
  for (int i = 0; i < 5; ++i) { const int piece = __builtin_amdgcn_readfirstlane(wid) + 8 * i;
    if (piece < 36) __builtin_amdgcn_global_load_lds((const unsigned*)(Q8 + piece * 1024 + lane * 16), (LAS unsigned*)(Q_lds + piece * 1024), 16, 0, 0); }
  const unsigned ldsw = (unsigned)__builtin_amdgcn_readfirstlane(wid) * 1024u;
#define GSTAGE_K(b, k0) do { const unsigned char* ki_ = K8 + (size_t)(k0) * QK8_PITCH + tid * 16; \
      __builtin_amdgcn_global_load_lds((const unsigned*)ki_, (LAS unsigned*)(K_lds + (b) * ATT_SHM_K + ldsw), 16, 0, 0); \
      if (wid < 1) __builtin_amdgcn_global_load_lds((const unsigned*)(ki_ + 8192), (LAS unsigned*)(K_lds + (b) * ATT_SHM_K + 8192 + ldsw), 16, 0, 0); } while (0)
#define GSTAGE_V(b, k0) do { const unsigned char* vi_ = V8 + (size_t)((k0) >> 6) * ATT_SHM_V + tid * 16; \
      __builtin_amdgcn_global_load_lds((const unsigned*)vi_, (LAS unsigned*)(V_lds + (b) * ATT_SHM_V + ldsw), 16, 0, 0); \
      if (wid < 2) __builtin_amdgcn_global_load_lds((const unsigned*)(vi_ + 8192), (LAS unsigned*)(V_lds + (b) * ATT_SHM_V + 8192 + ldsw), 16, 0, 0); } while (0)
#define STAGE_PAIR(jj) do { GSTAGE_V((jj) & 1, (jj) * 64); if ((jj) + 1 < NT) GSTAGE_K((jj) & 1, ((jj) + 1) * 64); } while (0)
#define RESC(o, a) do { if (__any((a) < 1.f)) { if (hi == 0) al_l[r32] = (a); asm volatile("s_waitcnt lgkmcnt(0)" ::: "memory"); \
    _Pragma("unroll") for (int d = 0; d < 4; ++d) _Pragma("unroll") for (int r = 0; r < 16; ++r) o[d][r] *= al_l[crow(r, hi)]; } } while (0)
#define ATT_BAR() do { asm volatile("s_waitcnt lgkmcnt(0)" ::: "memory"); __builtin_amdgcn_s_barrier(); asm volatile("" ::: "memory"); } while (0)
#define ATT_LDK(dst_, off_) do { const u32x4 x0_ = *(const LAS u32x4*)(kb_ + (off_)), x1_ = *(const LAS u32x4*)(kb_ + (off_) + 16); \
      dst_[0] = (int)x0_.x; dst_[1] = (int)x0_.y; dst_[2] = (int)x0_.z; dst_[3] = (int)x0_.w; dst_[4] = (int)x1_.x; dst_[5] = (int)x1_.y; dst_[6] = (int)x1_.z; dst_[7] = (int)x1_.w; } while (0)
#define ATT_SC(acc_, kf_, qf_) acc_ = __builtin_amdgcn_mfma_scale_f32_32x32x64_f8f6f4(kf_, qf_, acc_, 0, 0, 0, 0x7F7F7F7F, 0, 0x7F7F7F7F)
#define ATT_LDQ(dst_, off_) do { const u32x4 x0_ = *(const LAS u32x4*)(qb_ + (off_)), x1_ = *(const LAS u32x4*)(qb_ + (off_) + 16); \
      dst_[0] = (int)x0_.x; dst_[1] = (int)x0_.y; dst_[2] = (int)x0_.z; dst_[3] = (int)x0_.w; dst_[4] = (int)x1_.x; dst_[5] = (int)x1_.y; dst_[6] = (int)x1_.z; dst_[7] = (int)x1_.w; } while (0)
#define ATT_QK_ALL(ia_, ib_) do { _Pragma("unroll") for (int r = 0; r < 16; ++r) { p0[r] = (ia_); p1[r] = (ia_); q0[r] = (ib_); q1[r] = (ib_); } \
      ATT_SC(p0, kf0, qf); SBAR(); ATT_LDK(kf0, 32 * QK8_PITCH); SBAR(); \
      ATT_SC(p1, kf0, qf); SBAR(); ATT_LDK(kf0, 64); ATT_LDQ(qf, 64); SBAR(); \
      ATT_SC(q0, kf0, qf); SBAR(); ATT_LDK(kf0, 32 * QK8_PITCH + 64); SBAR(); \
      ATT_SC(q1, kf0, qf); SBAR(); } while (0)
  const int NT = nkeys / 64;
  GSTAGE_K(1, 0); STAGE_PAIR(0);
  asm volatile("s_waitcnt vmcnt(0)" ::: "memory"); __syncthreads();
  f32x16 p0, p1, q0, q1; i32x8 pa, pb;
  const LAS unsigned char* l3 = (const LAS unsigned char*)lds;
  const int kofs0 = 2 * ATT_SHM_V + r32 * QK8_PITCH + hi * 32;
  const int qofs0 = 2 * ATT_SHM_V + 2 * ATT_SHM_K + 2048 + (__builtin_amdgcn_readfirstlane(wid) * 32 + r32) * QK8_PITCH + hi * 32;
  { i32x8 kf0, qf; const LAS unsigned char* kb_ = l3 + (kofs0 + ATT_SHM_K); const LAS unsigned char* qb_ = l3 + qofs0;
    ATT_LDK(kf0, 0); ATT_LDQ(qf, 0);
    ATT_QK_ALL(0.f, 0.f); }
  if (grp) ATT_BAR();
#pragma unroll 1
  for (int j = 0; j < NT; ++j) {
    const int cur = j & 1;
    const bool more = (j + 1 < NT);
    if (grp && more) STAGE_PAIR(j + 1);
    { float alphaA, alphaB;
      const bool first = (j == 0);
      att_softmax(p0, p1, m0, l0, alphaA, first, pa); SBAR();
      att_softmax(q0, q1, m1, l1, alphaB, first, pb); SBAR();
      RESC(o0, alphaA);
      RESC(o1, alphaB); }
    asm volatile("" : "+v"(pa), "+v"(pb), "+v"(m0), "+v"(l0), "+v"(m1), "+v"(l1));
    asm volatile("" : "+v"(o0[0]), "+v"(o0[1]), "+v"(o0[2]), "+v"(o0[3]), "+v"(o1[0]), "+v"(o1[1]), "+v"(o1[2]), "+v"(o1[3]));
    if (!grp) asm volatile("s_waitcnt vmcnt(0)" ::: "memory");
    ATT_BAR();
    if (!grp && more) STAGE_PAIR(j + 1);
    __builtin_amdgcn_s_setprio(1);
    {
      int kofs = kofs0, qofs = qofs0; asm volatile("" : "+v"(kofs), "+v"(qofs));
      const LAS unsigned char* kb_ = l3 + (kofs + cur * ATT_SHM_K); const LAS unsigned char* qb_ = l3 + qofs;
      i32x8 kf0, qf;
      const LAS unsigned char* vrow = l3 + (r32 * 80 + hi * 32 + cur * ATT_SHM_V);
      u32x4 va0 = *(const LAS u32x4*)vrow, va1 = *(const LAS u32x4*)(vrow + 16), vb0, vb1;
#define ATT_PV(d0_, x0_, x1_) do { i32x8 bv; bv[0] = (int)x0_.x; bv[1] = (int)x0_.y; bv[2] = (int)x0_.z; bv[3] = (int)x0_.w; bv[4] = (int)x1_.x; bv[5] = (int)x1_.y; bv[6] = (int)x1_.z; bv[7] = (int)x1_.w; \
        o0[d0_] = __builtin_amdgcn_mfma_scale_f32_32x32x64_f8f6f4(pa, bv, o0[d0_], 0, 0, 0, 0x7F7F7F7F, 0, 0x7F7F7F7F); \
        o1[d0_] = __builtin_amdgcn_mfma_scale_f32_32x32x64_f8f6f4(pb, bv, o1[d0_], 0, 0, 0, 0x7F7F7F7F, 0, 0x7F7F7F7F); } while (0)
      vb0 = *(const LAS u32x4*)(vrow + 32 * 80); vb1 = *(const LAS u32x4*)(vrow + 32 * 80 + 16); ATT_PV(0, va0, va1); SBAR();
      va0 = *(const LAS u32x4*)(vrow + 64 * 80); va1 = *(const LAS u32x4*)(vrow + 64 * 80 + 16); ATT_PV(1, vb0, vb1); SBAR();
      vb0 = *(const LAS u32x4*)(vrow + 96 * 80); vb1 = *(const LAS u32x4*)(vrow + 96 * 80 + 16); ATT_PV(2, va0, va1); SBAR();
      ATT_LDK(kf0, 0); ATT_LDQ(qf, 0);
      ATT_PV(3, vb0, vb1); SBAR();
#undef ATT_PV
      asm volatile("" : "+v"(o0[0]), "+v"(o0[1]), "+v"(o0[2]), "+v"(o0[3]), "+v"(o1[0]), "+v"(o1[1]), "+v"(o1[2]), "+v"(o1[3]));
      ATT_QK_ALL(-m0, -m1);
      asm volatile("" : "+v"(p0), "+v"(p1), "+v"(q0), "+v"(q1));
    }
    __builtin_amdgcn_s_setprio(0);
    if (grp) asm volatile("s_waitcnt vmcnt(0)" ::: "memory");
    ATT_BAR();
  }
  if (!grp) ATT_BAR();
  if (hi == 0) { li_l[r32] = 1.f / l0; al_l[r32] = lam / l1; }
  asm volatile("s_waitcnt lgkmcnt(0)" ::: "memory");
  float ss[16];
#pragma unroll
  for (int r = 0; r < 16; ++r) {
    const float a = li_l[crow(r, hi)], bq = al_l[crow(r, hi)];
    float s = 0.f;
#pragma unroll
    for (int d = 0; d < 4; ++d) { const float v = o0[d][r] * a - o1[d][r] * bq; o0[d][r] = v; s += v * v; }
    s += dpp_mov<0xB1>(s); s += dpp_mov<0x4E>(s); s += dpp_mov<0x141>(s); s += dpp_mov<0x140>(s);
    { auto rr_ = __builtin_amdgcn_permlane16_swap(__float_as_uint(s), __float_as_uint(s), false, false); s = __uint_as_float(rr_[0]) + __uint_as_float(rr_[1]); }
    ss[r] = rsqrtf(s * (1.f / 128.f) + EPS) * oscale;
  }
  bf16_t* Ow = Ob + (size_t)(wid * 32) * DM;
  unsigned char* ost = lds + 2 * ATT_SHM_V + 2 * ATT_SHM_K + 2048 + wid * (32 * 272);
#pragma unroll
  for (int d = 0; d < 4; ++d) {
    const float g = ng[d * 32 + r32];
#pragma unroll
    for (int r = 0; r < 16; ++r) *(bf16_t*)(ost + crow(r, hi) * 272 + (d * 32 + r32) * 2) = (ABL & 4) ? (bf16_t)0 : (bf16_t)(cvtpk(o0[d][r] * ss[r] * g, 0.f) & 0xffffu);
  }
  asm volatile("s_waitcnt lgkmcnt(0)" ::: "memory");
#pragma unroll
  for (int i = 0; i < 8; ++i) {
    const int c = lane + 64 * i, row = c >> 4, cb = (c & 15) * 16;
    *(u32x4*)((unsigned char*)(Ow + (size_t)row * DM) + cb) = *(const u32x4*)(ost + row * 272 + cb);
  }
  __syncthreads();
#undef ATT_LDK
#undef ATT_LDQ
#undef ATT_SC
#undef ATT_QK_ALL
#undef GSTAGE_K
#undef GSTAGE_V
#undef STAGE_PAIR
#undef RESC
#undef ATT_BAR
}

__device__ __forceinline__ float ins16(float (&a)[16], float x) {
#pragma unroll
  for (int i = 0; i < 16; ++i) { const float h = fmaxf(a[i], x); x = fminf(a[i], x); a[i] = h; }
  return x;
}
__device__ __forceinline__ void bsort16(float (&a)[16]) {
#pragma unroll
  for (int k = 2; k <= 16; k <<= 1)
#pragma unroll
    for (int j = k >> 1; j > 0; j >>= 1)
#pragma unroll
      for (int i = 0; i < 16; ++i) {
        const int q = i ^ j;
        if (q > i) {
          const bool desc = ((i & k) == 0);
          const float hi_ = fmaxf(a[i], a[q]), lo_ = fminf(a[i], a[q]);
          a[i] = desc ? hi_ : lo_; a[q] = desc ? lo_ : hi_;
        }
      }
}
__device__ __forceinline__ void bmerge16(float (&a)[16], const float (&b)[16]) {
#pragma unroll
  for (int i = 0; i < 16; ++i) a[i] = fmaxf(a[i], b[15 - i]);
#pragma unroll
  for (int j = 8; j > 0; j >>= 1)
#pragma unroll
    for (int i = 0; i < 16; ++i) {
      const int q = i ^ j;
      if (q > i) { const float hi_ = fmaxf(a[i], a[q]), lo_ = fminf(a[i], a[q]); a[i] = hi_; a[q] = lo_; }
    }
}
__device__ __forceinline__ float gelu_erf(float x) { return 0.5f * x * (1.f + erff(x * 0.70710678118654752440f)); }
#define XB_TMO      128
#define XB_XCNT(j)  (256  + 64 * (j))
#define XB_XSUB(j)  (1280 + 64 * (j))
#define XB_XGEN(j)  (2304 + 64 * (j))
#define XB_TOP      3328
#define XB_TOPGEN   3392
#define XCD_BAR_WORDS 3456
#define XB_SPIN_CAP (1u << 22)
__device__ __forceinline__ unsigned xb_ld(unsigned* p)              { return __hip_atomic_load(p, __ATOMIC_RELAXED, __HIP_MEMORY_SCOPE_AGENT); }
__device__ __forceinline__ unsigned xb_add(unsigned* p, unsigned v) { return __hip_atomic_fetch_add(p, v, __ATOMIC_RELAXED, __HIP_MEMORY_SCOPE_AGENT); }
__device__ __forceinline__ unsigned xb_xcc_id() { return (unsigned)__builtin_amdgcn_s_getreg((3 << 11) | 20) & 0xFu; }
#define XB_SPIN(cond, bar) do { unsigned _sp = 0; while (cond) { __builtin_amdgcn_s_sleep(1); \
    if ((++_sp & 255u) == 0u) { if (xb_ld(&(bar)[XB_TMO])) break; if (_sp > XB_SPIN_CAP) { atomicAdd(&(bar)[XB_TMO], 1u); break; } } } } while (0)
struct XcdBarrier { unsigned* bar; unsigned x; volatile LAS unsigned* st; };
__device__ __forceinline__ XcdBarrier xcd_barrier_post(unsigned* bar, volatile LAS unsigned* st) {
  XcdBarrier b; b.bar = bar; b.x = xb_xcc_id(); b.st = st;
  if (tidx() == 0) (void)xb_add(&bar[XB_XCNT(b.x)], 1u);
  return b;
}
__device__ __forceinline__ void xcd_barrier_complete(unsigned* bar, unsigned x, unsigned& nloc, unsigned& nx) {
  const unsigned G = gridDim.x * gridDim.y * gridDim.z;
  unsigned sum, cnt, mine, sp = 0u;
  for (;;) {
    sum = 0u; cnt = 0u; mine = 0u;
#pragma unroll
    for (unsigned j = 0; j < 16; ++j) { const unsigned c = xb_ld(&bar[XB_XCNT(j)]); sum += c; cnt += (c > 0u) ? 1u : 0u; mine = (j == x) ? c : mine; }
    if (sum == G) break;
    __builtin_amdgcn_s_sleep(1);
    if ((++sp & 255u) == 0u) { if (xb_ld(&bar[XB_TMO])) break; if (sp > XB_SPIN_CAP) { atomicAdd(&bar[XB_TMO], 1u); break; } }
  }
  nloc = mine > 0u ? mine : 1u; nx = cnt > 0u ? cnt : 1u;
}
__device__ __forceinline__ void xcd_barrier(const XcdBarrier& b) {
  asm volatile("s_waitcnt vmcnt(0)" ::: "memory");
  __syncthreads();
  if (tidx() == 0) {
    unsigned* bar = b.bar;
    __builtin_amdgcn_s_waitcnt(0);
    unsigned nloc = b.st[0], nx = b.st[1];
    if (nloc == 0u) { xcd_barrier_complete(bar, b.x, nloc, nx); b.st[0] = nloc; b.st[1] = nx; }
    const unsigned old = xb_add(&bar[XB_XSUB(b.x)], 1u);
    const unsigned gen = old / nloc;
    if (old + 1u == (gen + 1u) * nloc) {
      __builtin_amdgcn_fence(__ATOMIC_RELEASE, "agent");
      asm volatile("s_waitcnt vmcnt(0)" ::: "memory");
      const unsigned og = xb_add(&bar[XB_TOP], 1u);
      const unsigned tg = og / nx;
      if (og + 1u == (tg + 1u) * nx) xb_add(&bar[XB_TOPGEN], 1u);
      else XB_SPIN(xb_ld(&bar[XB_TOPGEN]) == tg, bar);
      __builtin_amdgcn_fence(__ATOMIC_ACQUIRE, "agent");
      xb_add(&bar[XB_XGEN(b.x)], 1u);
      asm volatile("s_waitcnt vmcnt(0)" ::: "memory");
    } else {
      XB_SPIN(xb_ld(&bar[XB_XGEN(b.x)]) == gen, bar);
      __builtin_amdgcn_fence(__ATOMIC_ACQUIRE, "agent");
      asm volatile("s_waitcnt vmcnt(0)" ::: "memory");
    }
  }
  __syncthreads();
}

constexpr size_t RT_STRIDE = (size_t)T * 128 * 4;
__device__ __forceinline__ void route_unit(const Params& p, int l, int unit, unsigned char* lds) {
  int tid_ = tidx(); asm volatile("" : "+v"(tid_)); const int tid = tid_, lane = tid & 63, wid = tid >> 6, r32 = lane & 31, hi = lane >> 5;
  unsigned char* IDX = lds;
  int* UE = (int*)(lds + 8192); float* UG = (float*)(lds + 8192 + 16384); float* US = (float*)(lds + 8192 + 32768);
  int* EIDG = (int*)(p.ws + WS_EID + (size_t)l * RT_STRIDE); float* GWG = (float*)(p.ws + WS_ULOC + RT_STRIDE); float* SUG = (float*)(p.ws + WS_ULOC + 2 * RT_STRIDE);
  const float* PSC = (const float*)(p.ws + WS_PSC);
  const int row0 = unit * 32;
  const bf16_t* QP = (const bf16_t*)(p.ws + WS_PROJ);
  const bf16_t* KEYS = (const bf16_t*)(p.ws + WS_KEYS) + (size_t)l * 131072;
  for (int rrep = 0; rrep < REP_ROUTE; ++rrep) {
    const int h = wid;
    float top[2][16];
#pragma unroll
    for (int pp = 0; pp < 2; ++pp) {
      const bf16_t* qrow = QP + (size_t)(row0 + r32) * DM + h * 128 + pp * 64 + hi * 8;
      const bf16_t* kb = KEYS + ((size_t)(h * 2 + pp) * 128 + r32) * 64 + hi * 8;
      bf16x8 bq[4];
#pragma unroll
      for (int ks = 0; ks < 4; ++ks) bq[ks] = *(const bf16x8*)(qrow + ks * 16);
      float (&lst)[16] = top[pp];
#pragma unroll
      for (int i = 0; i < 16; ++i) lst[i] = -INFINITY;
#pragma unroll
      for (int nt = 0; nt < 4; ++nt) {
        f32x16 acc = {};
#pragma unroll
        for (int ks = 0; ks < 4; ++ks) {
          const bf16x8 ak = *(const bf16x8*)(kb + (size_t)nt * 32 * 64 + ks * 16);
          acc = __builtin_amdgcn_mfma_f32_32x32x16_bf16(ak, bq[ks], acc, 0, 0, 0);
        }
        float grp[16];
#pragma unroll
        for (int r = 0; r < 16; ++r) grp[r] = __uint_as_float((__float_as_uint(acc[r]) & ~0x7Fu) | (unsigned)(nt * 32 + crow(r, hi)));
        bsort16(grp);
        if (nt == 0) {
#pragma unroll
          for (int i = 0; i < 16; ++i) lst[i] = grp[i];
        } else bmerge16(lst, grp);
        SBAR();
      }
      float oth[16];
#pragma unroll
      for (int i = 0; i < 16; ++i) { auto rr_ = __builtin_amdgcn_permlane32_swap(__float_as_uint(lst[i]), __float_as_uint(lst[i]), false, false); oth[i] = __uint_as_float(hi ? rr_[0] : rr_[1]); }
      bmerge16(lst, oth);
      if (hi == 0) {
        unsigned w[4];
#pragma unroll
        for (int i = 0; i < 4; ++i)
          w[i] = (__float_as_uint(lst[4 * i]) & 0x7Fu) | ((__float_as_uint(lst[4 * i + 1]) & 0x7Fu) << 8) | ((__float_as_uint(lst[4 * i + 2]) & 0x7Fu) << 16) | ((__float_as_uint(lst[4 * i + 3]) & 0x7Fu) << 24);
        *(u32x4*)(IDX + ((r32 * 8 + h) * 2 + pp) * 16) = (u32x4){w[0], w[1], w[2], w[3]};
      }
    }
    float best[16];
#define CAND(i, j) __uint_as_float((__float_as_uint(__uint_as_float(__float_as_uint(top[0][i]) & ~0x7Fu) + __uint_as_float(__float_as_uint(top[1][j]) & ~0x7Fu)) & ~0xFFu) | (unsigned)((i) * 16 + (j)))
    {
#pragma unroll
      for (int j = 0; j < 16; ++j) best[j] = CAND(0, j);
      float y[16];
#pragma unroll
      for (int j = 0; j < 8; ++j) { y[j] = CAND(1, j); y[8 + j] = CAND(15 - j, 0); }
#pragma unroll
      for (int jj = 8; jj > 0; jj >>= 1)
#pragma unroll
        for (int i = 0; i < 16; ++i) { const int q = i ^ jj; if (q > i) { const float hi_ = fmaxf(y[i], y[q]), lo_ = fminf(y[i], y[q]); y[i] = hi_; y[q] = lo_; } }
      bmerge16(best, y);
      float x[16];
      x[0] = CAND(2, 0); x[1] = CAND(2, 1); x[2] = CAND(2, 2); x[3] = CAND(2, 3); x[4] = CAND(2, 4);
      x[5] = CAND(3, 0); x[6] = CAND(3, 1); x[7] = CAND(3, 2); x[8] = CAND(3, 3);
      x[9] = CAND(4, 0); x[10] = CAND(4, 1); x[11] = CAND(4, 2);
      x[12] = CAND(5, 0); x[13] = CAND(5, 1); x[14] = CAND(6, 0); x[15] = CAND(6, 1);
      bsort16(x);
      bmerge16(best, x);
      ins16(best, CAND(7, 0)); ins16(best, CAND(7, 1));
    }
#undef CAND
    asm volatile("s_waitcnt lgkmcnt(0)" ::: "memory");
    if (hi == 0) {
      const unsigned char* ib = IDX + ((r32 * 8 + h) * 2) * 16;
      const float mx = __uint_as_float(__float_as_uint(best[0]) & ~0xFFu);
      float w[16]; float sum = 0.f;
#pragma unroll
      for (int k = 0; k < 16; ++k) { w[k] = __expf(__uint_as_float(__float_as_uint(best[k]) & ~0xFFu) - mx); sum += w[k]; }
      const float rsum = 1.f / sum;
      int ee[16]; float su_[16], sv_[16];
#pragma unroll
      for (int k = 0; k < 16; ++k) {
        const unsigned ij = __float_as_uint(best[k]) & 0xFFu;
        ee[k] = (int)ib[ij >> 4] * 128 + (int)ib[16 + (ij & 15)];
      }
#pragma unroll
      for (int k = 0; k < 16; ++k) { su_[k] = PSC[(size_t)l * NEXP + ee[k]]; sv_[k] = PSC[(size_t)(DEPTH + l) * NEXP + ee[k]]; }
#pragma unroll
      for (int k = 0; k < 16; ++k) {
        UE[r32 * 128 + h * 16 + k] = ee[k]; UG[r32 * 128 + h * 16 + k] = w[k] * rsum * sv_[k];
        US[r32 * 128 + h * 16 + k] = su_[k];
      }
    }
  }
  __syncthreads();
#pragma unroll 1
  for (int tt = 0; tt < 4; ++tt) {
    const int t = wid * 4 + tt;
    const int k0 = UE[t * 128 + lane], k1 = UE[t * 128 + 64 + lane];
    const float g0 = UG[t * 128 + lane], g1 = UG[t * 128 + 64 + lane], s0 = US[t * 128 + lane], s1 = US[t * 128 + 64 + lane];
    const int b0 = k0 >> 10, b1 = k1 >> 10;
    int base = 0, pos0 = 0, pos1 = 0;
#pragma unroll
    for (int b = 0; b < 16; ++b) {
      const unsigned long long m0 = __ballot(b0 == b), m1 = __ballot(b1 == b);
      const int c0 = __popcll(m0), c1 = __popcll(m1);
      const unsigned long long lt = (1ull << lane) - 1ull;
      if (b0 == b) pos0 = base + __popcll(m0 & lt);
      if (b1 == b) pos1 = base + c0 + __popcll(m1 & lt);
      base += c0 + c1;
    }
    const size_t ro = (size_t)(row0 + t) * 128;
    EIDG[ro + pos0] = k0; GWG[ro + pos0] = g0; SUG[ro + pos0] = s0;
    EIDG[ro + pos1] = k1; GWG[ro + pos1] = g1; SUG[ro + pos1] = s1;
  }
}
#define CAS __attribute__((address_space(4)))
typedef int i32x8 __attribute__((ext_vector_type(8)));
struct TokPref { f32x2 gs0, gs1; u32x4 hA, hB; };
struct RowPipe { i32x6 uq[4], vq[4]; i32x8 Ec; };
__device__ __forceinline__ const CAS i32x8* eid_row(const CAS unsigned char* eidg, int row) {
  return (const CAS i32x8*)(eidg + (size_t)(unsigned)__builtin_amdgcn_readfirstlane(row) * 512u);
}
__device__ __forceinline__ void tok_prefetch(const Params& p, int row, int lane, TokPref& t) {
  const float* GWG = (const float*)(p.ws + WS_ULOC + RT_STRIDE) + (size_t)row * 128;
  const float* SUG = (const float*)(p.ws + WS_ULOC + 2 * RT_STRIDE) + (size_t)row * 128;
  const bf16_t* H = (const bf16_t*)(p.ws + WS_H);
  t.gs0 = f32x2{GWG[lane], SUG[lane]}; t.gs1 = f32x2{GWG[64 + lane], SUG[64 + lane]};
  t.hA = *(const u32x4*)(H + (size_t)row * DM + lane * 16); t.hB = *(const u32x4*)(H + (size_t)row * DM + lane * 16 + 8);
}
#define LOADPAIR(dst_, tofs_, ea_, eb_) do { const u32x3v a_ = __builtin_amdgcn_raw_buffer_load_b96(rsT, lane12, (ea_) * PROW + (tofs_), 0); const unsigned b0_ = __builtin_amdgcn_raw_buffer_load_b32(rsT, lane12, (eb_) * PROW + (tofs_), 0); \
      const u32x2v b1_ = __builtin_amdgcn_raw_buffer_load_b64(rsT, lane12 + 4, (eb_) * PROW + (tofs_), 0); \
      dst_[0] = (int)a_.x; dst_[1] = (int)a_.y; dst_[2] = (int)a_.z; dst_[3] = (int)b0_; dst_[4] = (int)b1_.x; dst_[5] = (int)b1_.y; } while (0)
#define LOADGROUP(q_, tofs_, E_) do { LOADPAIR(q_[0], tofs_, E_[0], E_[1]); LOADPAIR(q_[1], tofs_, E_[2], E_[3]); LOADPAIR(q_[2], tofs_, E_[4], E_[5]); LOADPAIR(q_[3], tofs_, E_[6], E_[7]); } while (0)
constexpr int VOFS = (int)(WS_PV - WS_PU);
__device__ __forceinline__ void gather_token(const Params& p, const CAS unsigned char* eidg, const __amdgpu_buffer_rsrc_t rsT, int l, int row, int nextrow, TokPref& tp, RowPipe& rp, unsigned char* lds, int lane, int wid) {
  f32x2* GS = (f32x2*)(lds + wid * 2048);
  float* XC = (float*)(p.ws + WS_XCUR);
  const float* MOD = (const float*)(p.ws + WS_MOD);
  const CAS i32x8* EP = eid_row(eidg, row);
  const bool hasnext = nextrow >= 0;
  const CAS i32x8* EPn = eid_row(eidg, hasnext ? nextrow : row);
  GS[lane] = tp.gs0; GS[64 + lane] = tp.gs1;
  asm volatile("s_waitcnt lgkmcnt(0)" ::: "memory");
  const int eofl = ((lane >> 5) & 1) + 2 * ((lane >> 4) & 1) + 4 * ((lane >> 3) & 1);
  const int lane12 = lane * 12;
  {
    h16x2 hh[8];
    {
      const u32x4 hA = tp.hA, hB = tp.hB;
      hh[0] = __builtin_bit_cast(h16x2, __builtin_amdgcn_cvt_pkrtz(bflo(hA.x), bfhi(hA.x))); hh[1] = __builtin_bit_cast(h16x2, __builtin_amdgcn_cvt_pkrtz(bflo(hA.y), bfhi(hA.y))); hh[2] = __builtin_bit_cast(h16x2, __builtin_amdgcn_cvt_pkrtz(bflo(hA.z), bfhi(hA.z))); hh[3] = __builtin_bit_cast(h16x2, __builtin_amdgcn_cvt_pkrtz(bflo(hA.w), bfhi(hA.w)));
      hh[4] = __builtin_bit_cast(h16x2, __builtin_amdgcn_cvt_pkrtz(bflo(hB.x), bfhi(hB.x))); hh[5] = __builtin_bit_cast(h16x2, __builtin_amdgcn_cvt_pkrtz(bflo(hB.y), bfhi(hB.y))); hh[6] = __builtin_bit_cast(h16x2, __builtin_amdgcn_cvt_pkrtz(bflo(hB.z), bfhi(hB.z))); hh[7] = __builtin_bit_cast(h16x2, __builtin_amdgcn_cvt_pkrtz(bflo(hB.w), bfhi(hB.w)));
    }
    if (hasnext) tok_prefetch(p, nextrow, lane, tp);
    f32x4 xpre[4];
    { const float* xr_ = XC + (size_t)row * DM + lane * 16;
#pragma unroll
      for (int v4 = 0; v4 < 4; ++v4) xpre[v4] = *(const f32x4*)(xr_ + v4 * 4); }
    f32x2 acc2[8];
#pragma unroll
    for (int i = 0; i < 8; ++i) acc2[i] = f32x2{0.f, 0.f};
#pragma unroll 1
    for (int g8 = 0; g8 < 16; ++g8) {
      const bool pf = (g8 < 15) || hasnext;
      const f32x2 gs = GS[g8 * 8 + eofl];
      float d[8];
#pragma unroll
      for (int i2 = 0; i2 < 4; ++i2) {
        const h16x32 r = __builtin_amdgcn_cvt_scalef32_pk32_f16_fp6(rp.uq[i2], 1.0f);
        float a0 = 0.f, a1 = 0.f, b0 = 0.f, b1 = 0.f;
#define UDOT(k_) a0 = __builtin_amdgcn_fdot2(__builtin_shufflevector(r, r, 4 * (k_), 4 * (k_) + 1), hh[2 * (k_)], a0, false); b0 = __builtin_amdgcn_fdot2(__builtin_shufflevector(r, r, 16 + 4 * (k_), 17 + 4 * (k_)), hh[2 * (k_)], b0, false); \
        a1 = __builtin_amdgcn_fdot2(__builtin_shufflevector(r, r, 4 * (k_) + 2, 4 * (k_) + 3), hh[2 * (k_) + 1], a1, false); b1 = __builtin_amdgcn_fdot2(__builtin_shufflevector(r, r, 18 + 4 * (k_), 19 + 4 * (k_)), hh[2 * (k_) + 1], b1, false);
        UDOT(0) UDOT(1) UDOT(2) UDOT(3)
#undef UDOT
        d[2 * i2] = a0 + a1;
        d[2 * i2 + 1] = b0 + b1;
        asm volatile("" : "+v"(d[2 * i2]), "+v"(d[2 * i2 + 1]));
      }
      if (pf) LOADGROUP(rp.uq, 0, rp.Ec);
      float tot;
      {
        auto s01 = __builtin_amdgcn_permlane32_swap(__float_as_uint(d[0]), __float_as_uint(d[1]), false, false);
        auto s23 = __builtin_amdgcn_permlane32_swap(__float_as_uint(d[2]), __float_as_uint(d[3]), false, false);
        auto s45 = __builtin_amdgcn_permlane32_swap(__float_as_uint(d[4]), __float_as_uint(d[5]), false, false);
        auto s67 = __builtin_amdgcn_permlane32_swap(__float_as_uint(d[6]), __float_as_uint(d[7]), false, false);
        const float q01 = __uint_as_float(s01[0]) + __uint_as_float(s01[1]), q23 = __uint_as_float(s23[0]) + __uint_as_float(s23[1]);
        const float q45 = __uint_as_float(s45[0]) + __uint_as_float(s45[1]), q67 = __uint_as_float(s67[0]) + __uint_as_float(s67[1]);
        auto ta = __builtin_amdgcn_permlane16_swap(__float_as_uint(q01), __float_as_uint(q23), false, false);
        auto tb = __builtin_amdgcn_permlane16_swap(__float_as_uint(q45), __float_as_uint(q67), false, false);
        const float r0123 = __uint_as_float(ta[0]) + __uint_as_float(ta[1]);
        const float r4567 = __uint_as_float(tb[0]) + __uint_as_float(tb[1]);
        const bool b3 = (lane & 8) != 0;
        const float keep = b3 ? r4567 : r0123, send = b3 ? r0123 : r4567;
        float x = keep + dpp_mov<0x140>(send);
        x += dpp_mov<0xB1>(x); x += dpp_mov<0x4E>(x); x += dpp_mov<0x141>(x);
        tot = x * gs.y;
      }
      float ge;
      {
        const float v = tot, av = fabsf(v), tq = __builtin_amdgcn_rcpf(av * 0.2316418882f + 1.0f);
        float q = tq * 0.5307027145f + (-0.7265760135f); q = q * tq + 0.7107068705f; q = q * tq + (-0.142248368f); q = q * tq + 0.127414796f; q = q * tq;
        const float ex = __builtin_amdgcn_exp2f(v * v * (-0.72134752044f));
        const float m = v * (q * ex), r = v - m;
        ge = (v < 0.f ? m : r) * gs.x;
      }
      unsigned cw[8];
      { const unsigned gp = __builtin_bit_cast(unsigned, __builtin_amdgcn_cvt_pkrtz(ge * 1024.f, ge * 1024.f));
        cw[0] = (unsigned)__builtin_amdgcn_readlane((int)gp, 0);  cw[4] = (unsigned)__builtin_amdgcn_readlane((int)gp, 8);
        cw[2] = (unsigned)__builtin_amdgcn_readlane((int)gp, 16); cw[6] = (unsigned)__builtin_amdgcn_readlane((int)gp, 24);
        cw[1] = (unsigned)__builtin_amdgcn_readlane((int)gp, 32); cw[5] = (unsigned)__builtin_amdgcn_readlane((int)gp, 40);
        cw[3] = (unsigned)__builtin_amdgcn_readlane((int)gp, 48); cw[7] = (unsigned)__builtin_amdgcn_readlane((int)gp, 56); }
      h16x2 a16[8];
#pragma unroll
      for (int i2 = 0; i2 < 4; ++i2) {
        const h16x32 r = __builtin_amdgcn_cvt_scalef32_pk32_f16_fp6(rp.vq[i2], 1.0f);
        const h16x2 ca = __builtin_bit_cast(h16x2, cw[2 * i2]), cb = __builtin_bit_cast(h16x2, cw[2 * i2 + 1]);
#define VAXL(k_) a16[k_] = (i2 == 0) ? ca * __builtin_shufflevector(r, r, 2 * (k_), 2 * (k_) + 1) : ca * __builtin_shufflevector(r, r, 2 * (k_), 2 * (k_) + 1) + a16[k_];
#define VAXH(k_) a16[k_] = cb * __builtin_shufflevector(r, r, 16 + 2 * (k_), 17 + 2 * (k_)) + a16[k_];
        VAXL(0) VAXL(1) VAXL(2) VAXL(3) VAXL(4) VAXL(5) VAXL(6) VAXL(7)
        asm volatile("" : "+v"(a16[0]), "+v"(a16[1]), "+v"(a16[2]), "+v"(a16[3]), "+v"(a16[4]), "+v"(a16[5]), "+v"(a16[6]), "+v"(a16[7]));
        VAXH(0) VAXH(1) VAXH(2) VAXH(3) VAXH(4) VAXH(5) VAXH(6) VAXH(7)
#undef VAXL
#undef VAXH
        asm volatile("" : "+v"(a16[0]), "+v"(a16[1]), "+v"(a16[2]), "+v"(a16[3]), "+v"(a16[4]), "+v"(a16[5]), "+v"(a16[6]), "+v"(a16[7]));
      }
#pragma unroll
      for (int k = 0; k < 8; ++k) acc2[k] = f32x2{(float)a16[k].x, (float)a16[k].y} * f32x2{1.f / 1024.f, 1.f / 1024.f} + acc2[k];
      if (pf) LOADGROUP(rp.vq, VOFS, rp.Ec);
      { const CAS i32x8* src_ = g8 < 14 ? EP + (g8 + 2) : EPn + (g8 - 14); rp.Ec = *src_; }
    }
    SBAR();
    float acc[16];
#pragma unroll
    for (int i = 0; i < 8; ++i) { acc[2 * i] = acc2[i].x; acc[2 * i + 1] = acc2[i].y; }
    const int mr = mod_row(row);
    const float* g2 = MOD + ((size_t)l * 5 + mr) * 6144 + 5 * 1024;
    float* xr = XC + (size_t)row * DM;
    float xn[16]; float ssq = 0.f;
    if (ABL & 8) {
#pragma unroll
      for (int i = 0; i < 16; ++i) acc[i] = 0.f;
    }
#pragma unroll
    for (int v4 = 0; v4 < 4; ++v4) {
      const int c = lane * 16 + v4 * 4;
      const f32x4 xo = xpre[v4], gg = *(const f32x4*)(g2 + c);
      f32x4 o;
      o.x = xo.x + gg.x * acc[v4 * 4 + 0]; o.y = xo.y + gg.y * acc[v4 * 4 + 1]; o.z = xo.z + gg.z * acc[v4 * 4 + 2]; o.w = xo.w + gg.w * acc[v4 * 4 + 3];
      xn[v4 * 4 + 0] = o.x; xn[v4 * 4 + 1] = o.y; xn[v4 * 4 + 2] = o.z; xn[v4 * 4 + 3] = o.w;
      ssq += (o.x * o.x + o.y * o.y) + (o.z * o.z + o.w * o.w);
      if (l < DEPTH - 1) *(f32x4*)(xr + c) = o;
    }
    const float rs = rsqrtf(wave_sum_fast(ssq) * (1.f / DM) + EPS);
    if (l == DEPTH - 1) {
      const int b = row / SEGL, s = row - b * SEGL;
      float* orow = p.out + ((size_t)(b * SEQ + (s - CTXL))) * DM;
      const float* fg = p.in[I_FINALG];
#pragma unroll
      for (int v4 = 0; v4 < 4; ++v4) {
        const int c = lane * 16 + v4 * 4;
        const f32x4 gg = *(const f32x4*)(fg + c);
        f32x4 o; o.x = xn[v4 * 4 + 0] * rs * gg.x; o.y = xn[v4 * 4 + 1] * rs * gg.y; o.z = xn[v4 * 4 + 2] * rs * gg.z; o.w = xn[v4 * 4 + 3] * rs * gg.w;
        *(f32x4*)(orow + c) = o;
      }
    } else {
      const float* m = MOD + ((size_t)(l + 1) * 5 + mr) * 6144;
      const float* ng = p.in[I_N1G] + (l + 1) * DM;
      bf16_t* hrow = (bf16_t*)(p.ws + WS_H) + (size_t)row * DM;
#pragma unroll
      for (int hh = 0; hh < 2; ++hh) {
        float y[8];
#pragma unroll
        for (int i = 0; i < 8; ++i) { const int c = lane * 16 + hh * 8 + i; y[i] = xn[hh * 8 + i] * rs * ng[c] * (1.f + m[1024 + c]) + m[c]; }
        u32x4 w; w.x = cvtpk(y[0], y[1]); w.y = cvtpk(y[2], y[3]); w.z = cvtpk(y[4], y[5]); w.w = cvtpk(y[6], y[7]);
        *(u32x4*)(hrow + lane * 16 + hh * 8) = w;
      }
    }
  }
}

__device__ __forceinline__ void ev_signal(unsigned* ctr) {
  asm volatile("s_waitcnt vmcnt(0)" ::: "memory");
  __syncthreads();
  if (tidx() == 0) { __builtin_amdgcn_fence(__ATOMIC_RELEASE, "agent"); asm volatile("s_waitcnt vmcnt(0)" ::: "memory"); (void)xb_add(ctr, 1u); }
}
__device__ __forceinline__ void ev_wait(unsigned* ctr, unsigned n, unsigned* bar) {
  if (tidx() == 0) {
    XB_SPIN(xb_ld(ctr) < n, bar);
    __builtin_amdgcn_fence(__ATOMIC_ACQUIRE, "agent");
    asm volatile("s_waitcnt vmcnt(0)" ::: "memory");
  }
  __syncthreads();
}
constexpr int EV_WORD0 = 8192;
__device__ __forceinline__ void phase_c1(const Params& p, int l, unsigned char* lds) {
  constexpr int NLOC = NBATCH * 4 * NCH, NCONV = T / 32;
  for (int u = p.bx; u < NLOC + NCONV; u += p.gx) {
    if (u < NLOC) ml_local_unit2(p, l, u, lds);
    else {
      const int cu = u - NLOC;
      if (l == DEPTH - 1 && (cu % (SEGL / 32)) < (CTXL / 32)) continue;
      conv_unit(p, l, cu, lds);
    }
  }
}
__device__ __forceinline__ void phase_c3(const Params& p, int l, unsigned char* lds);
__device__ __forceinline__ void phase_c2(const Params& p, int l, unsigned char* lds) {
  unsigned* ev = (unsigned*)(p.ws + WS_CTL) + EV_WORD0 + 64 * l;
  ml_scan(p, lds);
  ev_signal(ev);
  const float* lp = p.in[I_DLAM] + l * 256;
  float s01 = 0.f, s23 = 0.f;
  for (int i = 0; i < 64; ++i) { s01 += lp[i] * lp[64 + i]; s23 += lp[128 + i] * lp[192 + i]; }
  const float lam_init = 0.8f - 0.6f * expf(-0.3f * (float)l);
  const float lam = expf(s01) - expf(s23) + lam_init;
  const bf16_t* PROJ = (const bf16_t*)(p.ws + WS_PROJ);
  bf16_t* MIX = (bf16_t*)(p.ws + WS_MIX);
  const float* ng = p.in[I_DNORMG] + l * 128;
  const int nun = 512 + (l < DEPTH - 1 ? 16 : 0);
  for (int u = p.bx; u < nun; u += p.gx) {
    int bh, qrow, nkeys;
    if (u < 512) { const int xcd = u & 7, i = (u >> 3) & 31, rnd = u >> 8; bh = 2 * xcd + rnd; qrow = CTXL + i * 256; nkeys = SEGL; }
    else { bh = u - 512; qrow = 0; nkeys = CTXL; }
    const int b = bh >> 2, h = bh & 3;
    const size_t tok0 = (size_t)b * SEGL;
    for (int rep = 0; rep < REP_ATT; ++rep)
    att_unit(p.ws + WS_QK8 + ((size_t)bh * SEGL + qrow) * QK8_PITCH, p.ws + WS_QK8 + QK8_IMG + (size_t)bh * SEGL * QK8_PITCH, p.ws + WS_V8T + (size_t)bh * NCH * ATT_SHM_V,
             MIX + (tok0 + qrow) * DM + 512 + h * 128, nkeys, lam, ng, 1.f - lam_init, lds);
  }
  ev_wait(ev, (unsigned)p.gx, p.xbar_words);
  for (int rep = 0; rep < REP_ML; ++rep) phase_c3(p, l, lds);
}
__device__ __forceinline__ void phase_c3(const Params& p, int l, unsigned char* lds) {
  constexpr int NU = NBATCH * 4 * NCH;
  const int nlow = (p.gx > 64 && l < DEPTH - 1) ? 16 : 0, ulow = nlow * 7;
  int u, step;
  if (p.bx < nlow) { u = p.bx; step = nlow; } else { u = ulow + (p.bx - nlow); step = p.gx - nlow; }
  const int uend = p.bx < nlow ? ulow : NU;
  int tid_ = tidx(); asm volatile("" : "+v"(tid_));
  auto valid_from = [&](int v) { while (v < uend && l == DEPTH - 1 && (v % NCH) < 4) v += step; return v < uend ? v : -1; };
  MlOutPf fa, fb;
  u = valid_from(u);
  if (u >= 0) ml_out_fetch(p, u, tid_, fa);
  while (u >= 0) {
    const int nx = valid_from(u + step);
    ml_out_unit2(p, l, u, lds, fa, nx, fb);
    fa = fb; u = nx;
  }
}
__device__ __forceinline__ void phase_route(const Params& p, int l, unsigned char* lds) {
  constexpr int NU = T / 32;
  for (int u = p.bx; u < NU; u += p.gx) {
    if (l == DEPTH - 1 && (u % (SEGL / 32)) < (CTXL / 32)) continue;
    route_unit(p, l, u, lds);
    __syncthreads();
  }
}
__device__ __forceinline__ void phase_gather(const Params& p, int l, unsigned char* lds) {
  int tid_ = tidx(); asm volatile("" : "+v"(tid_)); const int lane = tid_ & 63, wid = __builtin_amdgcn_readfirstlane(tid_ >> 6);
  const int gw = p.bx * 8 + wid, NGW = p.gx * 8;
  const int ntok = (l == DEPTH - 1) ? NBATCH * SEQ : T;
#define TOKROW(ti_) ((l == DEPTH - 1) ? ((ti_) / SEQ) * SEGL + CTXL + ((ti_) % SEQ) : (ti_))
  const CAS unsigned char* eidg = (const CAS unsigned char*)(p.ws + WS_EID + (size_t)l * RT_STRIDE);
  const __amdgpu_buffer_rsrc_t rsT = __builtin_amdgcn_make_buffer_rsrc((void*)(p.ws + WS_PU + (size_t)l * NEXP * PROW), 0, VOFS + NEXP * PROW, 0x00020000);
  const int nfull = ntok / NGW, rem = ntok - nfull * NGW, per = (rem % p.gx == 0) ? rem / p.gx : -1;
  auto tok_at = [&](int r) -> int {
    if (r < nfull) return gw + r * NGW;
    if (r > nfull || rem == 0) return -1;
    if (per >= 0) return wid < per ? nfull * NGW + p.bx * per + wid : -1;
    return gw + r * NGW < ntok ? gw + r * NGW : -1;
  };
  TokPref tp; RowPipe rp;
  const int ti0 = tok_at(0);
  if (ti0 >= 0) {
    const int row0 = TOKROW(ti0); const int lane12 = lane * 12;
    tok_prefetch(p, row0, lane, tp);
    const CAS i32x8* EP0 = eid_row(eidg, row0);
    rp.Ec = EP0[0];
    LOADGROUP(rp.uq, 0, rp.Ec); LOADGROUP(rp.vq, VOFS, rp.Ec);
    rp.Ec = EP0[1];
  }
  XcdBarrier xb; xb.bar = p.xbar_words; xb.x = p.xbar_x; xb.st = (volatile LAS unsigned*)((LAS unsigned char*)lds + p.lds_st_off);
  const int nrounds = (ntok + NGW - 1) / NGW;
  for (int r = 0; r < nrounds; ++r) {
    const int ti = tok_at(r);
    if (ti >= 0) {
      const int row = TOKROW(ti);
      const int tn = tok_at(r + 1);
      const int nxt = tn >= 0 ? TOKROW(tn) : -1;
      gather_token(p, eidg, rsT, l, row, nxt, tp, rp, lds, lane, wid);
    }
#if GATHER_SYNC
    if (r + 1 < nrounds) { XcdBarrier xb2 = xb; size_t zb_ = 0; asm volatile("" : "+s"(zb_)); xb2.bar = xb.bar + zb_; xb2.x = xb.x + (unsigned)zb_; xcd_barrier(xb2); }
#endif
  }
#undef TOKROW
}

__global__ void __launch_bounds__(512, 2) mk_fwd(KArgs ka) {
  cg::grid_group grid = cg::this_grid();
  extern __shared__ __attribute__((aligned(16))) unsigned char lds[];
  const int lo = ka.ph_lo, hi = ka.ph_hi;
#define IN(k) (lo <= (k) && (k) < hi)
#ifndef PHASEMASK
#define PHASEMASK 0xFFFF
#endif
#define PH(i) ((PHASEMASK >> (i)) & 1)
#define MKP(q) Params q; { size_t z_ = 0; asm volatile("" : "+s"(z_)); \
    q.in = (InTab)((const __attribute__((address_space(4))) char*)__builtin_amdgcn_kernarg_segment_ptr() + z_); \
    q.out = ka.out + z_; q.ws = ka.ws + z_; q.ph_lo = lo; q.ph_hi = hi; q.bx = (int)blockIdx.x + (int)z_; q.gx = (int)gridDim.x + (int)z_; q.xbar_words = xbar.bar + z_; q.xbar_x = xbar.x + (unsigned)z_; q.lds_st_off = (unsigned)(LDS_BYTES - 64); }
#define SEAM(k) do { if (IN(k) && IN((k) + 1)) { if ((k) == 0) grid.sync(); else { XcdBarrier xb_ = xbar; size_t zb_ = 0; asm volatile("" : "+s"(zb_)); xb_.bar = xbar.bar + zb_; xb_.x = xbar.x + (unsigned)zb_; xcd_barrier(xb_); } } } while (0)
  volatile LAS unsigned* xst = (volatile LAS unsigned*)((LAS unsigned char*)lds + (LDS_BYTES - 64));
  { const int t0_ = threadIdx.x;
    if (t0_ < 2) xst[t0_] = 0u;
    if ((t0_ & 63) == 0) *(volatile LAS int*)((LAS unsigned char*)lds + LDS_WTAB + 4 * hw_wave_key()) = t0_ >> 6; }
  __syncthreads();
  XcdBarrier xbar = xcd_barrier_post((unsigned*)(ka.ws + WS_CTL) + 4096, xst);
  { MKP(p)
    if (PH(0) && IN(0)) for (int rep = 0; rep < REP_MISC; ++rep) { p0_mod(p, lds, (float*)(p.ws + WS_MOD)); p0_convert(p, lds); }
  }
  SEAM(0);
  { MKP(p)
    if (PH(1) && IN(1)) phase_norm(p, 0, 0, true, false);
  }
  SEAM(1);
#define LAYER(LL) { \
    int l = (LL); asm volatile("" : "+s"(l)); \
    const int b = 2 + 9 * (LL); \
    { MKP(q) if (PH(2) && IN(b + 0)) for (int rep = 0; rep < REP_GEMM; ++rep) phase_inproj2(q, l, lds); } \
    SEAM(b + 0); \
    { MKP(q) if (PH(3) && IN(b + 1)) for (int rep = 0; rep < REP_ML; ++rep) phase_c1(q, l, lds); } \
    SEAM(b + 1); \
    { MKP(q) if (PH(4) && IN(b + 2)) phase_c2(q, l, lds); } \
    SEAM(b + 3); \
    { MKP(q) if (PH(6) && IN(b + 4)) phase_outproj2(q, l, lds); } \
    SEAM(b + 4); \
    { MKP(q) if (PH(7) && IN(b + 5)) for (int rep = 0; rep < REP_MISC; ++rep) phase_norm(q, l, 1, false, (LL) == DEPTH - 1); } \
    SEAM(b + 5); \
    { MKP(q) if (PH(8) && IN(b + 6)) for (int rep = 0; rep < REP_GEMM; ++rep) phase_peerq2(q, l, lds); } \
    SEAM(b + 6); \
    { MKP(q) if (PH(9) && IN(b + 7)) phase_route(q, l, lds); } \
    SEAM(b + 7); \
    { MKP(q) if (PH(9) && IN(b + 8)) phase_gather(q, l, lds); } \
    SEAM(b + 8); }
  LAYER(0) LAYER(1) LAYER(2) LAYER(3)
#undef LAYER
#undef IN
#undef SEAM
#undef MKP
}

extern "C" void kernel_launch(void* const* d_in, const int* in_sizes, int n_in, void* d_out, int out_size,
                              void* d_ws, size_t ws_size, hipStream_t stream) {
  static int grid = 0;
  if (grid == 0) {
    int dev = 0, cus = 0, per_cu = 0;
    (void)hipGetDevice(&dev);
    (void)hipDeviceGetAttribute(&cus, hipDeviceAttributeMultiprocessorCount, dev);
    (void)hipFuncSetAttribute((const void*)mk_fwd, hipFuncAttributeMaxDynamicSharedMemorySize, LDS_BYTES);
    (void)hipOccupancyMaxActiveBlocksPerMultiprocessor(&per_cu, (const void*)mk_fwd, 512, LDS_BYTES);
    fprintf(stderr, "kernel_launch: cus %d per_cu %d ws %zu (need %zu) n_in %d\n", cus, per_cu, ws_size, (size_t)WS_END, n_in);
    if (ws_size < WS_END || n_in != 23 || per_cu < 1) { fprintf(stderr, "kernel_launch: bad configuration, nothing launched\n"); grid = -1; return; }
    grid = cus;
  }
  if (grid < 0) return;
  (void)hipMemsetAsync((char*)d_ws + WS_CTL, 0, 65536, stream);
  KArgs p{};
  for (int i = 0; i < 23; ++i) p.in[i] = (const float*)d_in[i];
  p.out = (float*)d_out; p.ws = (unsigned char*)d_ws; p.ph_lo = 0; p.ph_hi = 38;
  void* args[] = {&p};
  hipError_t e = hipLaunchCooperativeKernel((const void*)mk_fwd, dim3(grid), dim3(512), args, LDS_BYTES, stream);
  if (e != hipSuccess) fprintf(stderr, "cooperative launch failed: %s (grid %d)\n", hipGetErrorString(e), grid);
}
```

```cpp
#include <hip/hip_runtime.h>
#include <hip/hip_cooperative_groups.h>
#include <cstdio>
#include <cstdint>
namespace cg = cooperative_groups;

constexpr int DM = 1024, NBATCH = 4, SEQ = 8192, CTXL = 256, SEGL = CTXL + SEQ, T = NBATCH * SEGL, DEPTH = 4;
constexpr int IN_W = 3088, PW = 3072;
constexpr int QK8_PITCH = 144; constexpr size_t QK8_IMG = (size_t)16 * SEGL * QK8_PITCH;
constexpr int C_A = 0, C_MQ = 512, C_MK = 768, C_MV = 1024, C_MO = 1280, C_DQ = 1536, C_DK = 2048, C_DV = 2560;
constexpr int NCH = SEGL / 64;
constexpr int NEXP = 16384;
constexpr float EPS = 1e-6f;
#ifndef ABL
#define ABL 0
#endif
#ifndef GATHER_SYNC
#define GATHER_SYNC 0
#endif
#ifndef REP_ATT
#define REP_ATT 1
#endif
#ifndef GP_MASK
#define GP_MASK 0x3FFF
#endif
#ifndef REP_PEER
#define REP_PEER 1
#endif
#ifndef REP_GEMM
#define REP_GEMM 1
#endif
#ifndef REP_ROUTE
#define REP_ROUTE 1
#endif
#ifndef REP_OUTP
#define REP_OUTP 1
#endif
#ifndef REP_ML
#define REP_ML 1
#endif
#ifndef REP_MISC
#define REP_MISC 1
#endif
constexpr float QSCALE = 0.125f * 1.4426950408889634f;

constexpr size_t MiB = 1u << 20;
constexpr size_t WS_CTL = 0, WS_MOD = 1 * MiB, WS_ROPE = 2 * MiB, WS_WG = 4 * MiB, WS_KEYS = 5 * MiB, WS_MLMETA = 6 * MiB,
                 WS_GATES = 7 * MiB, WS_WIN = 10 * MiB, WS_WOUT = 34 * MiB, WS_WQ = 42 * MiB, WS_PU = 50 * MiB, WS_PV = 114 * MiB, WS_PSC = 178 * MiB  ,
                 WS_XCUR = 306 * MiB, WS_H = 438 * MiB, WS_MIX = 504 * MiB, WS_PROJ = 570 * MiB, WS_ULOC = 768 * MiB, WS_V8T = 836 * MiB  , WS_EID = 858 * MiB  , WS_QK8 = 924 * MiB  , WS_END = 964 * MiB;
constexpr int USTRIDE = 4160;

constexpr int LDS_BYTES = 139264 + 512;
constexpr int LDS_WTAB = LDS_BYTES - 64 - 256;

#define LAS __attribute__((address_space(3)))
__device__ __forceinline__ int hw_wave_key() { return (int)(__builtin_amdgcn_s_getreg((5 << 11) | 4) & 63u); }
__device__ __forceinline__ int tidx() {
  extern __shared__ __attribute__((aligned(16))) unsigned char lds_dyn_[];
  const int w = __builtin_amdgcn_readfirstlane(*(const volatile LAS int*)((LAS unsigned char*)lds_dyn_ + LDS_WTAB + 4 * hw_wave_key()));
  unsigned z_ = 0u; asm volatile("" : "+v"(z_));
  return (w << 6) | (int)__builtin_amdgcn_mbcnt_hi(~0u, __builtin_amdgcn_mbcnt_lo(~0u, z_));
}
typedef unsigned short bf16_t;
typedef short bf16x8 __attribute__((ext_vector_type(8)));
typedef short s16x4 __attribute__((ext_vector_type(4)));
typedef float f32x4 __attribute__((ext_vector_type(4)));
typedef float f32x16 __attribute__((ext_vector_type(16)));
typedef unsigned u32x4 __attribute__((ext_vector_type(4)));
typedef unsigned u32x2 __attribute__((ext_vector_type(2)));
typedef __bf16 bf16x2v __attribute__((ext_vector_type(2)));
typedef int i32x8 __attribute__((ext_vector_type(8)));
typedef int i32x6 __attribute__((ext_vector_type(6)));
struct __attribute__((aligned(4))) u32x3 { unsigned x, y, z; };
typedef float f32x32 __attribute__((ext_vector_type(32)));
constexpr int PROW = 768;
typedef float f32x2 __attribute__((ext_vector_type(2)));
typedef _Float16 h16x2 __attribute__((ext_vector_type(2)));
typedef _Float16 h16x32 __attribute__((ext_vector_type(32)));
typedef unsigned u32x3v __attribute__((ext_vector_type(3)));
typedef unsigned u32x2v __attribute__((ext_vector_type(2)));

struct KArgs {
  const float* in[23];
  float* out;
  unsigned char* ws;
  int ph_lo, ph_hi;
};
typedef const float* const __attribute__((address_space(4))) * InTab;
struct Params {
  InTab in;
  float* out;
  unsigned char* ws;
  int ph_lo, ph_hi;
  int bx, gx;
  unsigned* xbar_words; unsigned xbar_x; unsigned lds_st_off;
};
enum { I_X = 0, I_C, I_CTX, I_CCTX, I_ADAW, I_ADAB, I_N1G, I_N2G, I_WIN, I_CONVW, I_CONVB, I_CLNG, I_CLNB, I_GATEB, I_MNORMG, I_DLAM, I_DNORMG,
       I_WOUT, I_PWQ, I_PKEYS, I_PU, I_PV, I_FINALG };

__device__ __forceinline__ unsigned cvtpk(float lo, float hi) { unsigned r; asm volatile("v_cvt_pk_bf16_f32 %0, %1, %2" : "=v"(r) : "v"(lo), "v"(hi)); return r; }
__device__ __forceinline__ float bflo(unsigned u) { return __uint_as_float(u << 16); }
__device__ __forceinline__ float bfhi(unsigned u) { return __uint_as_float(u & 0xffff0000u); }
__device__ __forceinline__ float bf1(bf16_t u) { return __uint_as_float(((unsigned)u) << 16); }
__device__ __forceinline__ int crow(int r, int hi) { return (r & 3) + 8 * (r >> 2) + 4 * hi; }
template <int CTRL> __device__ __forceinline__ float dpp_mov(float v) {
  return __uint_as_float((unsigned)__builtin_amdgcn_update_dpp(0, (int)__float_as_uint(v), CTRL, 0xF, 0xF, true));
}
__device__ __forceinline__ float wave_sum_fast(float x) {
  x += dpp_mov<0xB1>(x); x += dpp_mov<0x4E>(x); x += dpp_mov<0x141>(x); x += dpp_mov<0x140>(x);
  { auto r = __builtin_amdgcn_permlane16_swap(__float_as_uint(x), __float_as_uint(x), false, false); x = __uint_as_float(r[0]) + __uint_as_float(r[1]); }
  { auto r = __builtin_amdgcn_permlane32_swap(__float_as_uint(x), __float_as_uint(x), false, false); x = __uint_as_float(r[0]) + __uint_as_float(r[1]); }
  return x;
}
__device__ __forceinline__ float wave_max_fast(float x) {
  x = fmaxf(x, dpp_mov<0xB1>(x)); x = fmaxf(x, dpp_mov<0x4E>(x)); x = fmaxf(x, dpp_mov<0x141>(x)); x = fmaxf(x, dpp_mov<0x140>(x));
  { auto r = __builtin_amdgcn_permlane16_swap(__float_as_uint(x), __float_as_uint(x), false, false); x = fmaxf(__uint_as_float(r[0]), __uint_as_float(r[1])); }
  { auto r = __builtin_amdgcn_permlane32_swap(__float_as_uint(x), __float_as_uint(x), false, false); x = fmaxf(__uint_as_float(r[0]), __uint_as_float(r[1])); }
  return x;
}
template <int CTRL, int ROWMASK> __device__ __forceinline__ float dpp_mov_rm(float v) {
  return __uint_as_float((unsigned)__builtin_amdgcn_update_dpp(0, (int)__float_as_uint(v), CTRL, ROWMASK, 0xF, true));
}
__device__ __forceinline__ float wave_incl_scan(float x) {
  x += dpp_mov<0x111>(x); x += dpp_mov<0x112>(x); x += dpp_mov<0x114>(x); x += dpp_mov<0x118>(x);
  x += dpp_mov_rm<0x142, 0xA>(x);
  x += dpp_mov_rm<0x143, 0xC>(x);
  return x;
}
__device__ __forceinline__ float wave_sum(float v) { return wave_sum_fast(v); }
__device__ __forceinline__ float sum_xor32(float x) { auto r = __builtin_amdgcn_permlane32_swap(__float_as_uint(x), __float_as_uint(x), false, false); return __uint_as_float(r[0]) + __uint_as_float(r[1]); }
__device__ __forceinline__ float max_xor32(float x) { auto r = __builtin_amdgcn_permlane32_swap(__float_as_uint(x), __float_as_uint(x), false, false); return fmaxf(__uint_as_float(r[0]), __uint_as_float(r[1])); }
__device__ __forceinline__ float wave_max(float v) { return wave_max_fast(v); }
__device__ __forceinline__ float sigmoidf_(float x) { return 1.f / (1.f + __expf(-x)); }
__device__ __forceinline__ float logsigmoidf_(float x) { return fminf(x, 0.f) - log1pf(__expf(-fabsf(x))); }
__device__ __forceinline__ const float* in_row(const float* x, const float* ctx, int row) {
  const int b = row / SEGL, s = row - b * SEGL;
  return s < CTXL ? ctx + ((size_t)(b * CTXL + s)) * DM : x + ((size_t)(b * SEQ + (s - CTXL))) * DM;
}
__device__ __forceinline__ int mod_row(int row) { const int b = row / SEGL, s = row - b * SEGL; return s < CTXL ? 4 : b; }

__device__ __forceinline__ void p0_mod(const Params& p, unsigned char* lds, float* MOD) {
  float* sil = (float*)lds;
  float* red = (float*)(lds + 20480);
  int tid_ = tidx(); asm volatile("" : "+v"(tid_)); const int tid = tid_, lane = tid & 63, wid = tid >> 6;
  for (int i = tid; i < 5 * 1024; i += 512) {
    const float v = i < 4096 ? p.in[I_C][i] : p.in[I_CCTX][i - 4096];
    sil[i] = v / (1.f + __expf(-v));
  }
  __syncthreads();
  for (int item = p.bx; item < DEPTH * 96; item += p.gx) {
    const int l = item / 96, j0 = (item % 96) * 64;
    const float* W = p.in[I_ADAW] + (size_t)l * DM * 6144 + j0 + lane;
    float a0 = 0.f, a1 = 0.f, a2 = 0.f, a3 = 0.f, a4 = 0.f;
    const int k0 = wid * 128;
#pragma unroll 8
    for (int k = k0; k < k0 + 128; ++k) {
      const float w = W[(size_t)k * 6144];
      a0 += sil[k] * w; a1 += sil[1024 + k] * w; a2 += sil[2048 + k] * w; a3 += sil[3072 + k] * w; a4 += sil[4096 + k] * w;
    }
    red[(wid * 5 + 0) * 64 + lane] = a0; red[(wid * 5 + 1) * 64 + lane] = a1; red[(wid * 5 + 2) * 64 + lane] = a2;
    red[(wid * 5 + 3) * 64 + lane] = a3; red[(wid * 5 + 4) * 64 + lane] = a4;
    __syncthreads();
    if (tid < 320) {
      const int r = tid >> 6;
      float s = 0.f;
#pragma unroll
      for (int w = 0; w < 8; ++w) s += red[(w * 5 + r) * 64 + lane];
      MOD[((size_t)l * 5 + r) * 6144 + j0 + lane] = s + p.in[I_ADAB][l * 6144 + j0 + lane];
    }
    __syncthreads();
  }
}
__device__ __forceinline__ void transpose_item(const float* W, int ldw, int srccol0, bf16_t* WT, int K, int n0, int k0, float* scr, int lane) {
#pragma unroll 8
  for (int i = 0; i < 32; ++i) { const int kk = 2 * i + (lane >> 5); scr[kk * 33 + (lane & 31)] = W[(size_t)(k0 + kk) * ldw + srccol0 + (lane & 31)]; }
  asm volatile("s_waitcnt lgkmcnt(0)" ::: "memory");
  const int c = lane & 7;
#pragma unroll
  for (int j = 0; j < 4; ++j) {
    const int n = (lane >> 3) + 8 * j; const float* s = scr + (8 * c) * 33 + n;
    u32x4 o; o.x = cvtpk(s[0], s[33]); o.y = cvtpk(s[66], s[99]); o.z = cvtpk(s[132], s[165]); o.w = cvtpk(s[198], s[231]);
    *(u32x4*)(WT + (size_t)(n0 + n) * K + k0 + 8 * c) = o;
  }
  asm volatile("s_waitcnt lgkmcnt(0)" ::: "memory");
}
__device__ __forceinline__ void convert_tables(const Params& p, int L, int wv, int nw, int lane, int r_lo, int r_hi) {
  unsigned char* PUq = p.ws + WS_PU; unsigned char* PVq = p.ws + WS_PV; float* PSC = (float*)(p.ws + WS_PSC);
  const int nrows = DEPTH * NEXP;
#define TAB_SROW(r_) ((const f32x4*)(((r_) >= NEXP ? p.in[I_PV] : p.in[I_PU]) + (size_t)(L * NEXP + ((r_) >= NEXP ? (r_) - NEXP : (r_))) * DM) + lane * 4)
#define TAB_LOAD(v_, r_) do { if ((r_) < r_hi) { const f32x4* s_ = TAB_SROW(r_); _Pragma("unroll") for (int j = 0; j < 4; ++j) v_[j] = __builtin_nontemporal_load(s_ + j); } } while (0)
  auto encode_row = [&](const f32x4 (&v)[4], int r) {
    const int tb = r >= NEXP, rr = L * NEXP + (tb ? r - NEXP : r);
    float mx = 0.f;
#pragma unroll
    for (int j = 0; j < 4; ++j) mx = fmaxf(mx, fmaxf(fmaxf(fabsf(v[j].x), fabsf(v[j].y)), fmaxf(fabsf(v[j].z), fabsf(v[j].w))));
    mx = wave_max_fast(mx);
    const unsigned mb = __float_as_uint(mx);
    const int eb = (int)((mb >> 23) & 0xFFu);
    int sb = ((mb & 0x7FFFFFu) <= 0x700000u ? 129 : 128) - eb + 127; sb = sb < 1 ? 1 : (sb > 253 ? 253 : sb);
    const float sc = __uint_as_float((unsigned)sb << 23), isc = __uint_as_float((unsigned)(254 - sb) << 23);
    const float xv[16] = {v[0].x, v[0].y, v[0].z, v[0].w, v[1].x, v[1].y, v[1].z, v[1].w, v[2].x, v[2].y, v[2].z, v[2].w, v[3].x, v[3].y, v[3].z, v[3].w};
    unsigned wq[3] = {0u, 0u, 0u};
#pragma unroll
    for (int i = 0; i < 16; ++i) {
      const float a = fabsf(xv[i]) * sc;
      unsigned code = a < 2.f ? (unsigned)__builtin_rintf(a * 8.f) : (a < 4.f ? 8u + (unsigned)__builtin_rintf(a * 4.f) : 16u + (unsigned)__builtin_rintf(a * 2.f));
      code = code > 31u ? 31u : code;
      code |= (xv[i] < 0.f) ? 32u : 0u;
      const int bp = 6 * i, dw = bp >> 5, off = bp & 31;
      wq[dw] |= code << off;
      if (off > 26) wq[dw + 1] |= code >> (32 - off);
    }
    u32x3 o; o.x = wq[0]; o.y = wq[1]; o.z = wq[2];
    *(u32x3*)((tb ? PVq : PUq) + (size_t)rr * PROW + lane * 12) = o;
    if (lane == 0) PSC[(size_t)tb * nrows + rr] = isc;
  };
  f32x4 v0[4], v1[4], v2[4];
  TAB_LOAD(v0, r_lo + wv); TAB_LOAD(v1, r_lo + wv + nw);
#pragma unroll 1
  for (int r = r_lo + wv; r < r_hi; r += 3 * nw) {
    TAB_LOAD(v2, r + 2 * nw); encode_row(v0, r);
    if (r + nw < r_hi) { TAB_LOAD(v0, r + 3 * nw); encode_row(v1, r + nw); }
    if (r + 2 * nw < r_hi) { TAB_LOAD(v1, r + 4 * nw); encode_row(v2, r + 2 * nw); }
  }
#undef TAB_LOAD
#undef TAB_SROW
}
__device__ __forceinline__ void tail_filler_tables(const Params& p, int L, int nwg, int r_lo, int r_hi) {
  int tid_ = tidx(); asm volatile("" : "+v"(tid_)); const int lane = tid_ & 63, wid = tid_ >> 6;
  const int nextra = nwg % p.gx, first = nextra, nidle = p.gx - nextra;
  if (p.bx < first) return;
  convert_tables(p, L, (p.bx - first) * 8 + wid, nidle * 8, lane, r_lo, r_hi);
}
__device__ __forceinline__ void p0_convert(const Params& p, unsigned char* lds) {
  int tid_ = tidx(); asm volatile("" : "+v"(tid_)); const int tid = tid_, lane = tid & 63, wid = tid >> 6;
  const int gw = p.bx * 8 + wid, NGW = p.gx * 8;
  const size_t gt = (size_t)p.bx * 512 + tid, NGT = (size_t)p.gx * 512;
  float* scr = (float*)(lds + 32768) + wid * (64 * 33);
  bf16_t* WIN = (bf16_t*)(p.ws + WS_WIN); bf16_t* WOUT = (bf16_t*)(p.ws + WS_WOUT); bf16_t* WQ = (bf16_t*)(p.ws + WS_WQ);
  constexpr int I_IN = 16 * 96, I_O = 16 * 32, PER_L = I_IN + 2 * I_O;
  for (int it = gw; it < DEPTH * PER_L; it += NGW) {
    const int l = it / PER_L; int r = it % PER_L;
    if (r < I_IN) { const int kb = r / 96, nb = r % 96, n0 = nb * 32; const int src = n0 < 1536 ? n0 : n0 + 16;
      transpose_item(p.in[I_WIN] + (size_t)l * DM * IN_W, IN_W, src, WIN + (size_t)l * PW * DM, DM, n0, kb * 64, scr, lane); continue; }
    r -= I_IN;
    if (r < I_O) { const int kb = r / 32, nb = r % 32;
      transpose_item(p.in[I_WOUT] + (size_t)l * DM * DM, DM, nb * 32, WOUT + (size_t)l * DM * DM, DM, nb * 32, kb * 64, scr, lane); continue; }
    r -= I_O;
    { const int kb = r / 32, nb = r % 32;
      transpose_item(p.in[I_PWQ] + (size_t)l * DM * DM, DM, nb * 32, WQ + (size_t)l * DM * DM, DM, nb * 32, kb * 64, scr, lane); }
  }
  bf16_t* WG = (bf16_t*)(p.ws + WS_WG);
  for (size_t i = gt; i < (size_t)DEPTH * 16 * DM; i += NGT) {
    const int l = (int)(i / (16 * DM)), g = (int)((i / DM) % 16), k = (int)(i % DM);
    WG[i] = (bf16_t)(cvtpk(p.in[I_WIN][(size_t)l * DM * IN_W + (size_t)k * IN_W + 1536 + g], 0.f) & 0xffffu);
  }
  bf16_t* KEYS = (bf16_t*)(p.ws + WS_KEYS);
  for (size_t i = gt; i < (size_t)DEPTH * 131072 / 8; i += NGT) {
    const f32x4 a = ((const f32x4*)p.in[I_PKEYS])[2 * i], b = ((const f32x4*)p.in[I_PKEYS])[2 * i + 1];
    u32x4 o; o.x = cvtpk(a.x, a.y); o.y = cvtpk(a.z, a.w); o.z = cvtpk(b.x, b.y); o.w = cvtpk(b.z, b.w);
    ((u32x4*)KEYS)[i] = o;
  }
  {
    float* RC = (float*)(p.ws + WS_ROPE); float* RS = RC + SEQ * 32;
    for (size_t i = gt; i < (size_t)SEQ * 32; i += NGT) {
      const int pos = (int)(i >> 5), j = (int)(i & 31);
      const int rr = pos >> 6, cc = pos & 63;
      const int jj = j & 15;
      const double e = -(double)jj * 0.83048202372184058696;
      const double fl = __builtin_floor(e); const double f = e - fl;
      const double z = f * 0.69314718055994530942;
      double ez = 1.0 + z * (1.0 + z * (0.5 + z * (1.0 / 6 + z * (1.0 / 24 + z * (1.0 / 120 + z * (1.0 / 720 + z * (1.0 / 5040 + z * (1.0 / 40320 + z * (1.0 / 362880 + z * (1.0 / 3628800 + z * (1.0 / 39916800 + z * (1.0 / 479001600))))))))))));
      const double inv = __builtin_ldexp(ez, (int)fl);
      const float invf = (float)inv;
      const float angf = (float)(j < 16 ? rr : cc) * invf;
      const double ang = (double)angf;
      const double kq = __builtin_rint(ang * 0.63661977236758134308);
      double r = __builtin_fma(-kq, 1.57079632679489655800e+00, ang);
      r = __builtin_fma(-kq, 6.12323399573676603587e-17, r);
      const double r2 = r * r;
      const double sn = r * (1.0 + r2 * (-1.0 / 6 + r2 * (1.0 / 120 + r2 * (-1.0 / 5040 + r2 * (1.0 / 362880 + r2 * (-1.0 / 39916800 + r2 * (1.0 / 6227020800.0)))))));
      const double cs = 1.0 + r2 * (-0.5 + r2 * (1.0 / 24 + r2 * (-1.0 / 720 + r2 * (1.0 / 40320 + r2 * (-1.0 / 3628800 + r2 * (1.0 / 479001600 + r2 * (-1.0 / 87178291200.0)))))));
      const int q = ((int)kq) & 3;
      double co, si;
      if (q == 0) { co = cs; si = sn; } else if (q == 1) { co = -sn; si = cs; } else if (q == 2) { co = -cs; si = -sn; } else { co = sn; si = -cs; }
      RC[i] = (float)co; RS[i] = (float)si;
    }
  }
}

__device__ __forceinline__ void norm_mod_row(const float* xrow, const float* g, const float* sc, const float* sh, bf16_t* orow, int lane) {
  const f32x4* xr = (const f32x4*)xrow + lane;
  f32x4 v[4]; float s = 0.f;
#pragma unroll
  for (int j = 0; j < 4; ++j) { v[j] = xr[64 * j]; s += (v[j].x * v[j].x + v[j].y * v[j].y) + (v[j].z * v[j].z + v[j].w * v[j].w); }
  const float rs = rsqrtf(wave_sum(s) * (1.f / DM) + EPS);
  u32x2* o = (u32x2*)orow + lane;
#pragma unroll
  for (int j = 0; j < 4; ++j) {
    const f32x4 gg = ((const f32x4*)g)[lane + 64 * j], cc = ((const f32x4*)sc)[lane + 64 * j], hh = ((const f32x4*)sh)[lane + 64 * j];
    const float y0 = v[j].x * rs * gg.x * (1.f + cc.x) + hh.x, y1 = v[j].y * rs * gg.y * (1.f + cc.y) + hh.y;
    const float y2 = v[j].z * rs * gg.z * (1.f + cc.z) + hh.z, y3 = v[j].w * rs * gg.w * (1.f + cc.w) + hh.w;
    u32x2 w; w.x = cvtpk(y0, y1); w.y = cvtpk(y2, y3);
    o[64 * j] = w;
  }
}
__device__ __forceinline__ void phase_norm(const Params& p, int l, int which, bool from_input, bool skip_ctx) {
  int tid_ = tidx(); asm volatile("" : "+v"(tid_));
  const int lane = tid_ & 63, wid = tid_ >> 6;
  const int gw = p.bx * 8 + wid, NGW = p.gx * 8;
  const float* MOD = (const float*)(p.ws + WS_MOD);
  const float* XC = (const float*)(p.ws + WS_XCUR);
  bf16_t* H = (bf16_t*)(p.ws + WS_H);
  const float* g = p.in[which ? I_N2G : I_N1G] + l * DM;
  auto next_row = [&](int r_) { while (r_ < T && skip_ctx && mod_row(r_) == 4) r_ += NGW; return r_; };
  auto xrow_of = [&](int r_) { return (const f32x4*)(from_input ? in_row(p.in[I_X], p.in[I_CTX], r_) : XC + (size_t)r_ * DM) + lane; };
  f32x4 gg[4], cc[4], hh[4], v[4], vn[4];
#pragma unroll
  for (int j = 0; j < 4; ++j) gg[j] = ((const f32x4*)g)[lane + 64 * j];
  int mr_cur = -1;
  int row = next_row(gw);
  if (row < T) { const f32x4* xr = xrow_of(row);
#pragma unroll
    for (int j = 0; j < 4; ++j) v[j] = xr[64 * j]; }
  while (row < T) {
    const int nrow = next_row(row + NGW);
    if (nrow < T) { const f32x4* xn = xrow_of(nrow);
#pragma unroll
      for (int j = 0; j < 4; ++j) vn[j] = xn[64 * j]; }
    const int mr = mod_row(row);
    if (mr != mr_cur) {
      const float* m = MOD + ((size_t)l * 5 + mr) * 6144 + which * 3072;
#pragma unroll
      for (int j = 0; j < 4; ++j) { cc[j] = ((const f32x4*)(m + 1024))[lane + 64 * j]; hh[j] = ((const f32x4*)m)[lane + 64 * j]; }
      mr_cur = mr;
    }
    float s = 0.f;
#pragma unroll
    for (int j = 0; j < 4; ++j) s += (v[j].x * v[j].x + v[j].y * v[j].y) + (v[j].z * v[j].z + v[j].w * v[j].w);
    const float rs = rsqrtf(wave_sum(s) * (1.f / DM) + EPS);
    u32x2* o = (u32x2*)(H + (size_t)row * DM) + lane;
#pragma unroll
    for (int j = 0; j < 4; ++j) {
      const float y0 = v[j].x * rs * gg[j].x * (1.f + cc[j].x) + hh[j].x, y1 = v[j].y * rs * gg[j].y * (1.f + cc[j].y) + hh[j].y;
      const float y2 = v[j].z * rs * gg[j].z * (1.f + cc[j].z) + hh[j].z, y3 = v[j].w * rs * gg[j].w * (1.f + cc[j].w) + hh[j].w;
      u32x2 w; w.x = cvtpk(y0, y1); w.y = cvtpk(y2, y3);
      o[64 * j] = w;
    }
#pragma unroll
    for (int j = 0; j < 4; ++j) v[j] = vn[j];
    row = nrow;
  }
}

namespace pg8 {
#define PG8_LAS __attribute__((address_space(3)))
typedef unsigned short bf16_t;
typedef short bf16x8 __attribute__((ext_vector_type(8)));
typedef float f32x4 __attribute__((ext_vector_type(4)));
typedef unsigned u32x4 __attribute__((ext_vector_type(4)));
constexpr int BM = 256, BK = 64, HALF = 128, HTB = HALF * BK * 2  , STAGE_BYTES = 8 * HTB, NXCD = 8, WGM = 8;

__host__ __device__ __forceinline__ int lds_byte(int r, int c) { const int st = (r >> 4) * 2 + (c >> 5), rr = r & 15, cc = c & 31, ob = rr * 64 + cc * 2; return st * 1024 + (ob ^ (((ob >> 9) & 1) << 5)); }
__host__ __device__ __forceinline__ void stage_rc(int b, int& R, int& C) { const int st = b / 1024, sb = b % 1024, swz = sb ^ (((sb >> 9) & 1) << 5); R = (st >> 1) * 16 + swz / 64; C = (st & 1) * 32 + (swz % 64) / 2; }
__host__ __device__ __forceinline__ int perm32(int rho) { const int n = rho >> 4, i = rho & 15; return 8 * (i >> 2) + 4 * n + (i & 3); }

struct Unit { int pm, pn; };
struct Gemm { const bf16_t* A; const bf16_t* Bt; int M, N, K; };

struct StaticOrder {
    int nM, nN, nwg, G, c;
    __host__ __device__ void init(int M, int N, int G_, int c_) { nM = M / BM; nN = N / BM; nwg = nM * nN; G = G_; c = c_; }
    __host__ __device__ bool next(int i, Unit& u) const {
        const long L = (long)i * G + c; if (L >= nwg) return false;
        int wgid = (int)L; { const int q = nwg / NXCD, r = nwg % NXCD, xcd = wgid % NXCD, off = wgid / NXCD; wgid = (xcd < r ? xcd * (q + 1) : r * (q + 1) + (xcd - r) * q) + off; }
        const int nig = WGM * nN, gid = wgid / nig, fm = gid * WGM, gsz = (nM - fm) < WGM ? (nM - fm) : WGM;
        u.pm = fm + ((wgid % nig) % gsz); u.pn = (wgid % nig) / gsz; return true;
    }
    __device__ __forceinline__ void a_ready(const Unit&) const {}
    __device__ __forceinline__ void done(const Unit&) const {}
};
__device__ __forceinline__ unsigned cvt_pk_bf16(float lo, float hi) { unsigned r; asm volatile("v_cvt_pk_bf16_f32 %0, %1, %2" : "=v"(r) : "v"(lo), "v"(hi)); return r; }
template <class Epi, class Sched, bool ALIGN_EPI = false, bool SP2 = false>
__device__ __forceinline__ void gemm_phase(PG8_LAS unsigned char* lds, const Gemm g, const Sched& S, const Epi& E) {
    const int tid = tidx(), wid = __builtin_amdgcn_readfirstlane(tid >> 6), lane = tid & 63, wr = wid >> 2, wc = wid & 3, fr = lane & 15, fq = lane >> 4;
    const int K = g.K, nt = K / BK;
    unsigned voffA[2], voffB[2];
#pragma unroll
    for (int i = 0; i < 2; ++i) { int R, C; stage_rc(tid * 16 + i * 8192, R, C); const int Rb = Epi::PERM ? ((R & ~31) + perm32(R & 31)) : R;
        voffA[i] = (unsigned)(R * K + C) * 2u; voffB[i] = (unsigned)(Rb * K + C) * 2u; }
    const size_t kstep = (size_t)(BK * 2);
    const size_t hstep = (size_t)HALF * K * 2;
    const size_t tstep = 2 * hstep;
    const unsigned ldsw = (unsigned)wid * 1024u;
    const int aoff = lds_byte(wr * 64 + fr, fq * 8), boff = lds_byte(wc * 32 + fr, fq * 8);
#define PG8_SA(b, h) (((b) * 2 + (h)) * HTB)
#define PG8_SB(b, h) ((4 + (b) * 2 + (h)) * HTB)
#define PG8_STAGE(bufoff, gbase, voff) do { _Pragma("unroll") for (int _i = 0; _i < 2; ++_i) \
        __builtin_amdgcn_global_load_lds((const unsigned*)((const char*)(gbase) + (voff)[_i]), (PG8_LAS unsigned*)(lds + (bufoff) + ldsw + _i * 8192), 16, 0, 0); } while (0)
#define PG8_LDA(dst, b, h) do { _Pragma("unroll") for (int m = 0; m < 4; ++m) _Pragma("unroll") for (int k = 0; k < 2; ++k) dst[m][k] = *(const PG8_LAS bf16x8*)(lds + PG8_SA(b, h) + aoff + m * 2048 + k * 1024); } while (0)
#define PG8_LDB(dst, b, h) do { _Pragma("unroll") for (int n = 0; n < 2; ++n) _Pragma("unroll") for (int k = 0; k < 2; ++k) dst[n][k] = *(const PG8_LAS bf16x8*)(lds + PG8_SB(b, h) + boff + n * 2048 + k * 1024); } while (0)
#define PG8_MMA(ai, bj, At, Bt) do { __builtin_amdgcn_s_setprio(1); _Pragma("unroll") for (int m = 0; m < 4; ++m) _Pragma("unroll") for (int n = 0; n < 2; ++n) _Pragma("unroll") for (int k = 0; k < 2; ++k) \
        acc[ai][bj][m][n] = __builtin_amdgcn_mfma_f32_16x16x32_bf16(Bt[n][k], At[m][k], acc[ai][bj][m][n], 0, 0, 0); __builtin_amdgcn_s_setprio(0); } while (0)
#define PG8_WAIT_V(n) asm volatile("s_waitcnt vmcnt(" #n ")" ::: "memory")
#define PG8_WAIT_L(n) asm volatile("s_waitcnt lgkmcnt(" #n ")" ::: "memory")
#define PG8_BAR __builtin_amdgcn_s_barrier()
#define PG8_SCHED __builtin_amdgcn_sched_barrier(0)
    Unit cur, nxt; int ui = 0;
    if (!S.next(0, cur)) return;
    f32x4 acc[2][2][4][2];
#pragma unroll
    for (int a = 0; a < 2; ++a)
#pragma unroll
        for (int b = 0; b < 2; ++b)
#pragma unroll
            for (int m = 0; m < 4; ++m)
#pragma unroll
                for (int n = 0; n < 2; ++n) acc[a][b][m][n] = (f32x4){0.f, 0.f, 0.f, 0.f};
    bf16x8 At[4][2], B0[2][2], B1[2][2];
    const char* cA = (const char*)g.A + (size_t)cur.pm * tstep; const char* cB = (const char*)g.Bt + (size_t)cur.pn * tstep;
    S.a_ready(cur);
    if constexpr (SP2) {
        PG8_STAGE(PG8_SB(0, 0), cB, voffB); PG8_STAGE(PG8_SB(0, 1), cB + hstep, voffB); PG8_STAGE(PG8_SA(0, 0), cA, voffA); PG8_STAGE(PG8_SA(0, 1), cA + hstep, voffA);
        if (wr == 1) PG8_BAR;
        PG8_WAIT_V(2); PG8_BAR;
        PG8_STAGE(PG8_SB(1, 0), cB + kstep, voffB); PG8_STAGE(PG8_SA(1, 0), cA + kstep, voffA); PG8_STAGE(PG8_SB(1, 1), cB + hstep + kstep, voffB);
        PG8_WAIT_V(6); PG8_BAR;
    } else {
        PG8_STAGE(PG8_SB(0, 0), cB, voffB); PG8_STAGE(PG8_SA(0, 0), cA, voffA); PG8_STAGE(PG8_SB(0, 1), cB + hstep, voffB); PG8_STAGE(PG8_SA(0, 1), cA + hstep, voffA);
        if (wr == 1) PG8_BAR;
        PG8_WAIT_V(4); PG8_BAR;
        PG8_STAGE(PG8_SB(1, 0), cB + kstep, voffB); PG8_STAGE(PG8_SA(1, 0), cA + kstep, voffA); PG8_STAGE(PG8_SB(1, 1), cB + hstep + kstep, voffB);
        PG8_WAIT_V(6); PG8_BAR;
    }
    for (;;) {
        const bool has_next = S.next(ui + 1, nxt);
        const char* nA = has_next ? (const char*)g.A + (size_t)nxt.pm * tstep : cA; const char* nB = has_next ? (const char*)g.Bt + (size_t)nxt.pn * tstep : cB;
        for (int t = 0; t < nt; t += 2) {
            const bool last = (t == nt - 2);
            const char* a1 = cA + (size_t)(t + 1) * kstep;
            const char* a2 = last ? nA : cA + (size_t)(t + 2) * kstep; const char* b2 = last ? nB : cB + (size_t)(t + 2) * kstep;
            const char* a3 = a2 + kstep; const char* b3 = b2 + kstep;
            if (last && has_next) S.a_ready(nxt);
            if constexpr (SP2) {
            PG8_LDB(B0, 0, 0); PG8_LDB(B1, 0, 1); PG8_SCHED; PG8_LDA(At, 0, 0); PG8_STAGE(PG8_SA(1, 1), a1 + hstep, voffA);
            PG8_WAIT_V(8); PG8_WAIT_L(0); PG8_BAR; PG8_MMA(0, 0, At, B0); PG8_MMA(0, 1, At, B1); PG8_BAR; PG8_SCHED;
            PG8_LDA(At, 0, 1); PG8_STAGE(PG8_SB(0, 0), b2, voffB); PG8_STAGE(PG8_SB(0, 1), b2 + hstep, voffB); PG8_STAGE(PG8_SA(0, 0), a2, voffA);
            PG8_WAIT_V(8); PG8_WAIT_L(0); PG8_BAR; PG8_MMA(1, 0, At, B0); PG8_MMA(1, 1, At, B1); PG8_BAR; PG8_SCHED;
            PG8_LDB(B0, 1, 0); PG8_LDB(B1, 1, 1); PG8_SCHED; PG8_LDA(At, 1, 0); PG8_STAGE(PG8_SA(0, 1), a2 + hstep, voffA);
            PG8_WAIT_V(8); PG8_WAIT_L(0); PG8_BAR; PG8_MMA(0, 0, At, B0); PG8_MMA(0, 1, At, B1); PG8_BAR; PG8_SCHED;
            PG8_LDA(At, 1, 1); PG8_STAGE(PG8_SB(1, 0), b3, voffB); PG8_STAGE(PG8_SB(1, 1), b3 + hstep, voffB); PG8_STAGE(PG8_SA(1, 0), a3, voffA);
            PG8_WAIT_V(8); PG8_WAIT_L(0); PG8_BAR; PG8_MMA(1, 0, At, B0); PG8_MMA(1, 1, At, B1); PG8_BAR; PG8_SCHED;
            } else {
            PG8_LDB(B0, 0, 0); PG8_SCHED; PG8_LDA(At, 0, 0); PG8_STAGE(PG8_SA(1, 1), a1 + hstep, voffA);
            PG8_WAIT_L(8); PG8_BAR; PG8_WAIT_L(0); PG8_MMA(0, 0, At, B0); PG8_BAR; PG8_SCHED;
            PG8_LDB(B1, 0, 1); PG8_STAGE(PG8_SB(0, 0), b2, voffB);
            PG8_BAR; PG8_WAIT_L(0); PG8_MMA(0, 1, At, B1); PG8_BAR;
            PG8_LDA(At, 0, 1); PG8_STAGE(PG8_SA(0, 0), a2, voffA);
            PG8_BAR; PG8_WAIT_L(0); PG8_MMA(1, 0, At, B0); PG8_BAR; PG8_SCHED;
            PG8_STAGE(PG8_SB(0, 1), b2 + hstep, voffB);
            PG8_WAIT_V(6); PG8_BAR; PG8_MMA(1, 1, At, B1); PG8_BAR;
            PG8_LDB(B0, 1, 0); PG8_SCHED; PG8_LDA(At, 1, 0); PG8_STAGE(PG8_SA(0, 1), a2 + hstep, voffA);
            PG8_WAIT_L(8); PG8_BAR; PG8_WAIT_L(0); PG8_MMA(0, 0, At, B0); PG8_BAR; PG8_SCHED;
            PG8_LDB(B1, 1, 1); PG8_STAGE(PG8_SB(1, 0), b3, voffB);
            PG8_BAR; PG8_WAIT_L(0); PG8_MMA(0, 1, At, B1); PG8_BAR;
            PG8_LDA(At, 1, 1); PG8_STAGE(PG8_SA(1, 0), a3, voffA);
            PG8_BAR; PG8_WAIT_L(0); PG8_MMA(1, 0, At, B0); PG8_BAR; PG8_SCHED;
            PG8_STAGE(PG8_SB(1, 1), b3 + hstep, voffB);
            PG8_WAIT_V(6); PG8_BAR; PG8_MMA(1, 1, At, B1); PG8_BAR;
            }
        }
        if constexpr (ALIGN_EPI) { if (wr == 0) PG8_BAR; }
        if constexpr (!Epi::AFTER_DRAIN) { E(acc, cur, wr, wc, fr, fq); S.done(cur); }
        if (!has_next) break;
#pragma unroll
        for (int a = 0; a < 2; ++a)
#pragma unroll
            for (int b = 0; b < 2; ++b)
#pragma unroll
                for (int m = 0; m < 4; ++m)
#pragma unroll
                    for (int n = 0; n < 2; ++n) acc[a][b][m][n] = (f32x4){0.f, 0.f, 0.f, 0.f};
        cur = nxt; cA = nA; cB = nB; ++ui;
        if constexpr (ALIGN_EPI) { if (wr == 1) PG8_BAR; }
    }
    PG8_WAIT_V(0);
    if constexpr (!ALIGN_EPI) { if (wr == 0) PG8_BAR; }
    PG8_BAR;
    if constexpr (Epi::AFTER_DRAIN) { E.fused(acc, cur, wr, wc, fr, fq, lds, wid, lane); S.done(cur); }
#undef PG8_SA
#undef PG8_SB
#undef PG8_STAGE
#undef PG8_LDA
#undef PG8_LDB
#undef PG8_MMA
#undef PG8_WAIT_V
#undef PG8_WAIT_L
#undef PG8_BAR
#undef PG8_SCHED
}
}

__device__ __forceinline__ int gswz(int row, int chunk) { return row * 128 + ((chunk ^ ((row >> 1) & 7)) << 4); }
__device__ __forceinline__ void gemm_tile(const bf16_t* __restrict__ A, int lda, const bf16_t* __restrict__ Bt, int ldb, int K,
                                          int row0, int col0, unsigned char* lds, f32x16 (&acc)[2][2]) {
  int tid_ = tidx(); asm volatile("" : "+v"(tid_)); const int tid = tid_, lane = tid & 63, wid = tid >> 6, wm = wid >> 1, wn = wid & 1, r32 = lane & 31, hi = lane >> 5;
  unsigned char* As = lds; unsigned char* Bs = lds + 65536;
#pragma unroll
  for (int i = 0; i < 2; ++i)
#pragma unroll
    for (int j = 0; j < 2; ++j) acc[i][j] = f32x16{};
  const int lrow = tid >> 3, lc = tid & 7;
  const bf16_t* Ag = A + (size_t)(row0 + lrow) * lda + lc * 8;
  const bf16_t* Bg = Bt + (size_t)(col0 + lrow) * ldb + lc * 8;
  u32x4 ra[4], rb[2];
#pragma unroll
  for (int i = 0; i < 4; ++i) ra[i] = *(const u32x4*)(Ag + (size_t)(64 * i) * lda);
#pragma unroll
  for (int i = 0; i < 2; ++i) rb[i] = *(const u32x4*)(Bg + (size_t)(64 * i) * ldb);
#pragma unroll
  for (int i = 0; i < 4; ++i) *(u32x4*)(As + gswz(lrow + 64 * i, lc)) = ra[i];
#pragma unroll
  for (int i = 0; i < 2; ++i) *(u32x4*)(Bs + gswz(lrow + 64 * i, lc)) = rb[i];
  __syncthreads();
  const int nk = K / 64;
  for (int kt = 0; kt < nk; ++kt) {
    const int cur = kt & 1;
    if (kt + 1 < nk) {
#pragma unroll
      for (int i = 0; i < 4; ++i) ra[i] = *(const u32x4*)(Ag + (size_t)(64 * i) * lda + (kt + 1) * 64);
#pragma unroll
      for (int i = 0; i < 2; ++i) rb[i] = *(const u32x4*)(Bg + (size_t)(64 * i) * ldb + (kt + 1) * 64);
    }
    const unsigned char* Ac = As + cur * 32768; const unsigned char* Bc = Bs + cur * 16384;
#pragma unroll
    for (int kk = 0; kk < 4; ++kk) {
      bf16x8 af[2], bfr[2];
#pragma unroll
      for (int i = 0; i < 2; ++i) af[i] = *(const bf16x8*)(Ac + gswz(wm * 64 + i * 32 + r32, 2 * kk + hi));
#pragma unroll
      for (int j = 0; j < 2; ++j) bfr[j] = *(const bf16x8*)(Bc + gswz(wn * 64 + j * 32 + r32, 2 * kk + hi));
#pragma unroll
      for (int i = 0; i < 2; ++i)
#pragma unroll
        for (int j = 0; j < 2; ++j) acc[i][j] = __builtin_amdgcn_mfma_f32_32x32x16_bf16(af[i], bfr[j], acc[i][j], 0, 0, 0);
    }
    if (kt + 1 < nk) {
      unsigned char* An = As + (cur ^ 1) * 32768; unsigned char* Bn = Bs + (cur ^ 1) * 16384;
#pragma unroll
      for (int i = 0; i < 4; ++i) *(u32x4*)(An + gswz(lrow + 64 * i, lc)) = ra[i];
#pragma unroll
      for (int i = 0; i < 2; ++i) *(u32x4*)(Bn + gswz(lrow + 64 * i, lc)) = rb[i];
    }
    __syncthreads();
  }
}
__device__ __forceinline__ void pair_xchg(float v0, float v1, int lane, float& lo, float& hi2) {
  const bool odd = lane & 1;
  const float send = odd ? v0 : v1;
  const float recv = dpp_mov<0xB1>(send);
  lo = odd ? recv : v0; hi2 = odd ? v1 : recv;
}

__device__ __forceinline__ void phase_inproj(const Params& p, int l, unsigned char* lds) {
  int tid_ = tidx(); asm volatile("" : "+v"(tid_)); const int tid = tid_, lane = tid & 63, wid = tid >> 6, wm = wid >> 1, wn = wid & 1, r32 = lane & 31, hi = lane >> 5;
  const bf16_t* H = (const bf16_t*)(p.ws + WS_H);
  const bf16_t* W = (const bf16_t*)(p.ws + WS_WIN) + (size_t)l * PW * DM;
  bf16_t* PROJ = (bf16_t*)(p.ws + WS_PROJ);
  const float* RC = (const float*)(p.ws + WS_ROPE); const float* RS = RC + SEQ * 32;
  constexpr int NM = T / 256, NN = PW / 128, NU = NM * NN;
  for (int u = p.bx; u < NU + NM; u += p.gx) {
    if (u < NU) {
      const int pn = u / NM, pm = u % NM;
      const int row0 = pm * 256, col0 = pn * 128;
      f32x16 acc[2][2];
      gemm_tile(H, DM, W, DM, DM, row0, col0, lds, acc);
      const bool rope = (col0 >= C_DQ && col0 < C_DV);
      const float scl = (col0 >= C_MK && col0 < C_MV) ? 0.125f : ((col0 >= C_DQ && col0 < C_DK) ? QSCALE : 1.f);
#pragma unroll
      for (int i = 0; i < 2; ++i)
#pragma unroll
        for (int j = 0; j < 2; ++j)
#pragma unroll
          for (int q = 0; q < 8; ++q) {
            float lo, hi2; pair_xchg(acc[i][j][2 * q], acc[i][j][2 * q + 1], lane, lo, hi2);
            const int row = row0 + wm * 64 + i * 32 + crow(2 * q, hi) + (lane & 1);
            const int col = col0 + wn * 64 + j * 32 + (r32 & ~1);
            if (rope) {
              const int s = row % SEGL;
              if (s >= CTXL) {
                const int idx = (s - CTXL) * 32 + ((col & 63) >> 1);
                const float c = RC[idx], sn = RS[idx];
                const float t1 = lo, t2 = hi2; lo = t1 * c - t2 * sn; hi2 = t1 * sn + t2 * c;
              }
            }
            *(unsigned*)(PROJ + (size_t)row * PW + col) = cvtpk(lo * scl, hi2 * scl);
          }
    } else {
      const int pm = u - NU, rowb = pm * 256 + wid * 32;
      const bf16_t* WG = (const bf16_t*)(p.ws + WS_WG) + (size_t)l * 16 * DM;
      float* GT = (float*)(p.ws + WS_GATES);
      const int r16 = lane & 15, q4 = lane >> 4;
      f32x4 c0 = {0.f, 0.f, 0.f, 0.f}, c1 = {0.f, 0.f, 0.f, 0.f};
      const bf16_t* a0p = H + (size_t)(rowb + r16) * DM + q4 * 8;
      const bf16_t* a1p = a0p + (size_t)16 * DM;
      const bf16_t* bp = WG + (size_t)r16 * DM + q4 * 8;
#pragma unroll 4
      for (int ks = 0; ks < 32; ++ks) {
        const bf16x8 a0 = *(const bf16x8*)(a0p + ks * 32), a1 = *(const bf16x8*)(a1p + ks * 32), b = *(const bf16x8*)(bp + ks * 32);
        c0 = __builtin_amdgcn_mfma_f32_16x16x32_bf16(a0, b, c0, 0, 0, 0);
        c1 = __builtin_amdgcn_mfma_f32_16x16x32_bf16(a1, b, c1, 0, 0, 0);
      }
      const float gb = p.in[I_GATEB][l * 16 + r16];
#pragma unroll
      for (int j = 0; j < 4; ++j) {
        GT[(size_t)(rowb + q4 * 4 + j) * 16 + r16] = c0[j] + gb;
        GT[(size_t)(rowb + 16 + q4 * 4 + j) * 16 + r16] = c1[j] + gb;
      }
    }
  }
}

__device__ __forceinline__ void phase_outproj(const Params& p, int l, unsigned char* lds) {
  int tid_ = tidx(); asm volatile("" : "+v"(tid_)); const int tid = tid_, lane = tid & 63, wid = tid >> 6, wm = wid >> 1, wn = wid & 1, r32 = lane & 31, hi = lane >> 5;
  const bf16_t* MIX = (const bf16_t*)(p.ws + WS_MIX);
  const bf16_t* W = (const bf16_t*)(p.ws + WS_WOUT) + (size_t)l * DM * DM;
  float* XC = (float*)(p.ws + WS_XCUR);
  const float* MOD = (const float*)(p.ws + WS_MOD);
  constexpr int NM = T / 256, NN = DM / 128, NU = NM * NN;
  for (int u = p.bx; u < NU; u += p.gx) {
    const int pm = u / NN, pn = u % NN;
    if (l == DEPTH - 1 && (pm % 33) == 0) continue;
    const int row0 = pm * 256, col0 = pn * 128;
    for (int rep = 0; rep < REP_OUTP; ++rep) {
    f32x16 acc[2][2];
    gemm_tile(MIX, DM, W, DM, DM, row0, col0, lds, acc);
    const int mr = (pm % 33) == 0 ? 4 : pm / 33;
    const float* g1 = MOD + ((size_t)l * 5 + mr) * 6144 + 2048;
#pragma unroll
    for (int i = 0; i < 2; ++i)
#pragma unroll
      for (int j = 0; j < 2; ++j) {
        const int col = col0 + wn * 64 + j * 32 + r32;
        const float gg = (rep == REP_OUTP - 1) ? g1[col] : 0.f;
#pragma unroll
        for (int r = 0; r < 16; ++r) {
          const int row = row0 + wm * 64 + i * 32 + crow(r, hi);
          const float xo = (l == 0) ? in_row(p.in[I_X], p.in[I_CTX], row)[col] : XC[(size_t)row * DM + col];
          XC[(size_t)row * DM + col] = xo + gg * acc[i][j][r];
        }
      }
    }
  }
}
__device__ __forceinline__ void phase_peerq(const Params& p, int l, unsigned char* lds) {
  int tid_ = tidx(); asm volatile("" : "+v"(tid_)); const int tid = tid_, lane = tid & 63, wid = tid >> 6, wm = wid >> 1, wn = wid & 1, r32 = lane & 31, hi = lane >> 5;
  const bf16_t* H = (const bf16_t*)(p.ws + WS_H);
  const bf16_t* W = (const bf16_t*)(p.ws + WS_WQ) + (size_t)l * DM * DM;
  bf16_t* QP = (bf16_t*)(p.ws + WS_PROJ);
  constexpr int NM = T / 256, NN = DM / 128, NU = NM * NN;
  for (int u = p.bx; u < NU; u += p.gx) {
    const int pm = u / NN, pn = u % NN;
    if (l == DEPTH - 1 && (pm % 33) == 0) continue;
    const int row0 = pm * 256, col0 = pn * 128;
    f32x16 acc[2][2];
    gemm_tile(H, DM, W, DM, DM, row0, col0, lds, acc);
#pragma unroll
    for (int i = 0; i < 2; ++i)
#pragma unroll
      for (int j = 0; j < 2; ++j)
#pragma unroll
        for (int q = 0; q < 8; ++q) {
          float lo, hi2; pair_xchg(acc[i][j][2 * q], acc[i][j][2 * q + 1], lane, lo, hi2);
          const int row = row0 + wm * 64 + i * 32 + crow(2 * q, hi) + (lane & 1);
          const int col = col0 + wn * 64 + j * 32 + (r32 & ~1);
          *(unsigned*)(QP + (size_t)row * DM + col) = cvtpk(lo, hi2);
        }
  }
}


struct EpiInproj {
  static constexpr bool PERM = true, AFTER_DRAIN = false;
  bf16_t* PROJ; const float* RC; const float* RS; unsigned char* V8T;
  __device__ __forceinline__ void operator()(const pg8::f32x4 (&acc)[2][2][4][2], const pg8::Unit& u, int wr, int wc, int fr, int fq) const {
#pragma unroll
    for (int bj = 0; bj < 2; ++bj) {
      const int colt = u.pn * 256 + bj * 128;
      const bool rope = (colt >= C_DQ && colt < C_DV);
      const float scl = (colt >= C_MK && colt < C_MV) ? 0.125f : ((colt >= C_DQ && colt < C_DK) ? QSCALE : 1.f);
      const int col8 = colt + wc * 32 + 8 * fq;
      if (colt >= C_DV) {
        const int hh = (col8 - C_DV) >> 7, e0 = (col8 - C_DV) & 127;
#pragma unroll
        for (int ai = 0; ai < 2; ++ai)
#pragma unroll
          for (int m = 0; m < 4; ++m) {
            const int row = u.pm * 256 + ai * 128 + wr * 64 + m * 16 + fr;
            const int b = row / SEGL, s = row - b * SEGL, t = s >> 6, kk = s & 63;
            const int slot = ((kk >> 2) & 1) * 32 + (kk & 3) + 4 * ((kk >> 3) & 3) + 16 * (kk >> 5);
            unsigned char* vp = V8T + ((size_t)((b * 4 + hh) * NCH + t) * 128 + e0) * 80 + slot;
            const f32x4 v0 = acc[ai][bj][m][0], v1 = acc[ai][bj][m][1];
            int w0 = 0, w1 = 0;
            w0 = __builtin_amdgcn_cvt_pk_fp8_f32(v0[0], v0[1], w0, false); w0 = __builtin_amdgcn_cvt_pk_fp8_f32(v0[2], v0[3], w0, true);
            w1 = __builtin_amdgcn_cvt_pk_fp8_f32(v1[0], v1[1], w1, false); w1 = __builtin_amdgcn_cvt_pk_fp8_f32(v1[2], v1[3], w1, true);
            vp[0] = (unsigned char)(w0 & 0xFF); vp[80] = (unsigned char)((w0 >> 8) & 0xFF); vp[160] = (unsigned char)((w0 >> 16) & 0xFF); vp[240] = (unsigned char)((w0 >> 24) & 0xFF);
            vp[320] = (unsigned char)(w1 & 0xFF); vp[400] = (unsigned char)((w1 >> 8) & 0xFF); vp[480] = (unsigned char)((w1 >> 16) & 0xFF); vp[560] = (unsigned char)((w1 >> 24) & 0xFF);
          }
        continue;
      }
      unsigned char* qk8 = nullptr;
      if (rope) { const int isk = colt >= C_DK, cc = col8 - (isk ? C_DK : C_DQ); qk8 = V8T + (WS_QK8 - WS_V8T) + (size_t)isk * QK8_IMG + (size_t)(cc >> 7) * SEGL * QK8_PITCH + (cc & 127); }
#pragma unroll
      for (int ai = 0; ai < 2; ++ai)
#pragma unroll
        for (int m = 0; m < 4; ++m) {
          const int row = u.pm * 256 + ai * 128 + wr * 64 + m * 16 + fr;
          f32x4 v0 = acc[ai][bj][m][0], v1 = acc[ai][bj][m][1];
          if (rope) {
            const int s = row % SEGL;
            if (s >= CTXL) {
              const int idx = (s - CTXL) * 32 + ((col8 & 63) >> 1);
              const f32x4 c = *(const f32x4*)(RC + idx), sn = *(const f32x4*)(RS + idx);
              f32x4 a, b;
              a[0] = v0[0] * c[0] - v0[1] * sn[0]; a[1] = v0[0] * sn[0] + v0[1] * c[0]; a[2] = v0[2] * c[1] - v0[3] * sn[1]; a[3] = v0[2] * sn[1] + v0[3] * c[1];
              b[0] = v1[0] * c[2] - v1[1] * sn[2]; b[1] = v1[0] * sn[2] + v1[1] * c[2]; b[2] = v1[2] * c[3] - v1[3] * sn[3]; b[3] = v1[2] * sn[3] + v1[3] * c[3];
              v0 = a; v1 = b;
            }
          }
          if (rope) {
            const int b = row / SEGL, s = row - b * SEGL;
            int w0, w1; asm volatile("" : "=v"(w0), "=v"(w1));
            w0 = __builtin_amdgcn_cvt_pk_fp8_f32(v0[0] * scl, v0[1] * scl, w0, false); w0 = __builtin_amdgcn_cvt_pk_fp8_f32(v0[2] * scl, v0[3] * scl, w0, true);
            w1 = __builtin_amdgcn_cvt_pk_fp8_f32(v1[0] * scl, v1[1] * scl, w1, false); w1 = __builtin_amdgcn_cvt_pk_fp8_f32(v1[2] * scl, v1[3] * scl, w1, true);
            *(u32x2*)(qk8 + ((size_t)b * 4 * SEGL + s) * QK8_PITCH) = (u32x2){(unsigned)w0, (unsigned)w1};
            continue;
          }
          u32x4 w; w.x = cvtpk(v0[0] * scl, v0[1] * scl); w.y = cvtpk(v0[2] * scl, v0[3] * scl); w.z = cvtpk(v1[0] * scl, v1[1] * scl); w.w = cvtpk(v1[2] * scl, v1[3] * scl);
          *(u32x4*)(PROJ + (size_t)row * PW + col8) = w;
        }
    }
  }
};
struct EpiOutproj {
  static constexpr bool PERM = true, AFTER_DRAIN = false;
  float* XC; const float* MODL; const float* xin; const float* ctxin; int first; float gsc;
  __device__ __forceinline__ void operator()(const pg8::f32x4 (&acc)[2][2][4][2], const pg8::Unit& u, int wr, int wc, int fr, int fq) const {
    const int mr = (u.pm % 33) == 0 ? 4 : u.pm / 33;
    const float* g1 = MODL + (size_t)mr * 6144 + 2048;
#pragma unroll
    for (int bj = 0; bj < 2; ++bj) {
      const int col8 = u.pn * 256 + bj * 128 + wc * 32 + 8 * fq;
      const f32x4 ga = *(const f32x4*)(g1 + col8) * gsc, gb = *(const f32x4*)(g1 + col8 + 4) * gsc;
#pragma unroll
      for (int ai = 0; ai < 2; ++ai)
#pragma unroll
        for (int m = 0; m < 4; ++m) {
          const int row = u.pm * 256 + ai * 128 + wr * 64 + m * 16 + fr;
          const float* xo = first ? in_row(xin, ctxin, row) + col8 : XC + (size_t)row * DM + col8;
          const f32x4 xa = *(const f32x4*)xo, xb = *(const f32x4*)(xo + 4);
          *(f32x4*)(XC + (size_t)row * DM + col8) = xa + ga * acc[ai][bj][m][0];
          *(f32x4*)(XC + (size_t)row * DM + col8 + 4) = xb + gb * acc[ai][bj][m][1];
        }
    }
  }
};
struct EpiPeerq {
  static constexpr bool PERM = true, AFTER_DRAIN = false;
  bf16_t* QP;
  __device__ __forceinline__ void operator()(const pg8::f32x4 (&acc)[2][2][4][2], const pg8::Unit& u, int wr, int wc, int fr, int fq) const {
#pragma unroll
    for (int bj = 0; bj < 2; ++bj) {
      const int col8 = u.pn * 256 + bj * 128 + wc * 32 + 8 * fq;
#pragma unroll
      for (int ai = 0; ai < 2; ++ai)
#pragma unroll
        for (int m = 0; m < 4; ++m) {
          const int row = u.pm * 256 + ai * 128 + wr * 64 + m * 16 + fr;
          const f32x4 v0 = acc[ai][bj][m][0], v1 = acc[ai][bj][m][1];
          u32x4 w; w.x = cvtpk(v0[0], v0[1]); w.y = cvtpk(v0[2], v0[3]); w.z = cvtpk(v1[0], v1[1]); w.w = cvtpk(v1[2], v1[3]);
          *(u32x4*)(QP + (size_t)row * DM + col8) = w;
        }
    }
  }
};
__device__ __forceinline__ void phase_inproj2(const Params& p, int l, unsigned char* lds) {
  {
    pg8::Gemm g{(const bf16_t*)(p.ws + WS_H), (const bf16_t*)(p.ws + WS_WIN) + (size_t)l * PW * DM, T, PW, DM};
    pg8::StaticOrder S; S.init(T, PW, p.gx, p.bx);
    EpiInproj E{(bf16_t*)(p.ws + WS_PROJ), (const float*)(p.ws + WS_ROPE), (const float*)(p.ws + WS_ROPE) + SEQ * 32, p.ws + WS_V8T};
    pg8::gemm_phase<EpiInproj, pg8::StaticOrder, true, true>((PG8_LAS unsigned char*)lds, g, S, E);
  }
  int tid_ = tidx(); asm volatile("" : "+v"(tid_)); const int tid = tid_, lane = tid & 63, wid = tid >> 6;
  const bf16_t* H = (const bf16_t*)(p.ws + WS_H);
  for (int pm = p.gx - 1 - p.bx; pm < T / 256; pm += p.gx) {
    const int rowb = pm * 256 + wid * 32;
    const bf16_t* WG = (const bf16_t*)(p.ws + WS_WG) + (size_t)l * 16 * DM;
    float* GT = (float*)(p.ws + WS_GATES);
    const int r16 = lane & 15, q4 = lane >> 4;
    f32x4 c0 = {0.f, 0.f, 0.f, 0.f}, c1 = {0.f, 0.f, 0.f, 0.f};
    const bf16_t* a0p = H + (size_t)(rowb + r16) * DM + q4 * 8;
    const bf16_t* a1p = a0p + (size_t)16 * DM;
    const bf16_t* bp = WG + (size_t)r16 * DM + q4 * 8;
#pragma unroll 4
    for (int ks = 0; ks < 32; ++ks) {
      const bf16x8 a0 = *(const bf16x8*)(a0p + ks * 32), a1 = *(const bf16x8*)(a1p + ks * 32), b = *(const bf16x8*)(bp + ks * 32);
      c0 = __builtin_amdgcn_mfma_f32_16x16x32_bf16(a0, b, c0, 0, 0, 0);
      c1 = __builtin_amdgcn_mfma_f32_16x16x32_bf16(a1, b, c1, 0, 0, 0);
    }
    const float gb = p.in[I_GATEB][l * 16 + r16];
#pragma unroll
    for (int j = 0; j < 4; ++j) {
      GT[(size_t)(rowb + q4 * 4 + j) * 16 + r16] = c0[j] + gb;
      GT[(size_t)(rowb + 16 + q4 * 4 + j) * 16 + r16] = c1[j] + gb;
    }
  }
}
__device__ __forceinline__ void phase_outproj2(const Params& p, int l, unsigned char* lds) {
  pg8::Gemm g{(const bf16_t*)(p.ws + WS_MIX), (const bf16_t*)(p.ws + WS_WOUT) + (size_t)l * DM * DM, T, DM, DM};
  pg8::StaticOrder S; S.init(T, DM, p.gx, p.bx);
  for (int rep = 0; rep < REP_OUTP; ++rep) {
  EpiOutproj E{(float*)(p.ws + WS_XCUR), (const float*)(p.ws + WS_MOD) + (size_t)l * 5 * 6144, p.in[I_X], p.in[I_CTX], l == 0, (rep == REP_OUTP - 1) ? 1.f : 0.f};
  pg8::gemm_phase<EpiOutproj, pg8::StaticOrder, true, true>((PG8_LAS unsigned char*)lds, g, S, E);
  }
  tail_filler_tables(p, l, (T / 256) * (DM / 256), l == 0 ? 0 : NEXP, 2 * NEXP);
}
__device__ __forceinline__ void phase_peerq2(const Params& p, int l, unsigned char* lds) {
  pg8::Gemm g{(const bf16_t*)(p.ws + WS_H), (const bf16_t*)(p.ws + WS_WQ) + (size_t)l * DM * DM, T, DM, DM};
  pg8::StaticOrder S; S.init(T, DM, p.gx, p.bx);
  EpiPeerq E{(bf16_t*)(p.ws + WS_PROJ)};
  pg8::gemm_phase<EpiPeerq, pg8::StaticOrder, true, true>((PG8_LAS unsigned char*)lds, g, S, E);
  if (l < DEPTH - 1) tail_filler_tables(p, l + 1, (T / 256) * (DM / 256), 0, NEXP);
}

__device__ __forceinline__ void conv_unit(const Params& p, int l, int unit, unsigned char* lds) {
  int tid_ = tidx(); asm volatile("" : "+v"(tid_)); const int tid = tid_, lane = tid & 63, wid = tid >> 6;
  float* U = (float*)lds;
  const bf16_t* PROJ = (const bf16_t*)(p.ws + WS_PROJ);
  bf16_t* MIX = (bf16_t*)(p.ws + WS_MIX);
  const int row0 = unit * 32, b = row0 / SEGL, s0 = row0 - b * SEGL;
  const int seglo = s0 < CTXL ? 0 : CTXL, seghi = s0 < CTXL ? CTXL : SEGL;
  for (int rr = tid >> 5; rr < 62; rr += 16) {
    const int s = s0 - 15 + rr, c8 = (tid & 31) * 8;
    f32x4 u0 = {0.f, 0.f, 0.f, 0.f}, u1 = {0.f, 0.f, 0.f, 0.f};
    if (s >= seglo && s < seghi) {
      const bf16_t* pr = PROJ + (size_t)(b * SEGL + s) * PW + c8;
      const u32x4 a1 = *(const u32x4*)pr, a2 = *(const u32x4*)(pr + 256);
      u0.x = bflo(a1.x) * sigmoidf_(bflo(a2.x)); u0.y = bfhi(a1.x) * sigmoidf_(bfhi(a2.x));
      u0.z = bflo(a1.y) * sigmoidf_(bflo(a2.y)); u0.w = bfhi(a1.y) * sigmoidf_(bfhi(a2.y));
      u1.x = bflo(a1.z) * sigmoidf_(bflo(a2.z)); u1.y = bfhi(a1.z) * sigmoidf_(bfhi(a2.z));
      u1.z = bflo(a1.w) * sigmoidf_(bflo(a2.w)); u1.w = bfhi(a1.w) * sigmoidf_(bfhi(a2.w));
    }
    *(f32x4*)(U + rr * 256 + c8) = u0; *(f32x4*)(U + rr * 256 + c8 + 4) = u1;
  }
  __syncthreads();
  float* Y = U + 62 * 256;
  const float* cw = p.in[I_CONVW] + (size_t)l * 31 * 256;
#pragma unroll 1
  for (int q = 0; q < 4; ++q) {
    const int c = lane + 64 * q;
    float w[31];
#pragma unroll
    for (int j = 0; j < 31; ++j) w[j] = cw[j * 256 + c];
    const float bias = p.in[I_CONVB][l * 256 + c];
#pragma unroll
    for (int tt = 0; tt < 4; ++tt) {
      const int t = wid * 4 + tt;
      float a = bias;
#pragma unroll
      for (int j = 0; j < 31; ++j) a += U[(t + j) * 256 + c] * w[j];
      Y[t * 256 + c] = a;
    }
  }
  asm volatile("s_waitcnt lgkmcnt(0)" ::: "memory");
  float y[4][4];
#pragma unroll
  for (int tt = 0; tt < 4; ++tt)
#pragma unroll
    for (int q = 0; q < 4; ++q) y[tt][q] = Y[(wid * 4 + tt) * 256 + lane + 64 * q];
#pragma unroll
  for (int tt = 0; tt < 4; ++tt) {
    const int t = wid * 4 + tt;
    const float mean = wave_sum((y[tt][0] + y[tt][1]) + (y[tt][2] + y[tt][3])) * (1.f / 256.f);
    float v = 0.f;
#pragma unroll
    for (int q = 0; q < 4; ++q) { const float d = y[tt][q] - mean; v += d * d; }
    const float rs = rsqrtf(wave_sum(v) * (1.f / 256.f) + EPS);
#pragma unroll
    for (int q = 0; q < 4; ++q) {
      const int c = lane + 64 * q;
      const float z = (y[tt][q] - mean) * rs * p.in[I_CLNG][l * 256 + c] + p.in[I_CLNB][l * 256 + c];
      const float o = (ABL & 1) ? 0.f : z * sigmoidf_(z);
      MIX[(size_t)(row0 + t) * DM + c] = (bf16_t)(cvtpk(o, 0.f) & 0xffffu);
    }
  }
  __syncthreads();
}

__device__ __forceinline__ int ml_cidx(int ch, int dir) { return dir == 0 ? ch : (ch < 4 ? 3 - ch : 135 - ch); }
__device__ __forceinline__ void ml_load_tile(const bf16_t* src, float* dst, int tid) {
  const int r = tid >> 3, c8 = (tid & 7) * 8;
  const u32x4 a = *(const u32x4*)(src + (size_t)r * PW + c8);
  float* d = dst + r * 65 + c8;
  d[0] = bflo(a.x); d[1] = bfhi(a.x); d[2] = bflo(a.y); d[3] = bfhi(a.y); d[4] = bflo(a.z); d[5] = bfhi(a.z); d[6] = bflo(a.w); d[7] = bfhi(a.w);
}
__device__ __forceinline__ void ml_local_unit(const Params& p, int l, int unit, unsigned char* lds) {
  int tid_ = tidx(); asm volatile("" : "+v"(tid_)); const int tid = tid_, lane = tid & 63, wid = tid >> 6, r32 = lane & 31, hi = lane >> 5;
  float* Kt = (float*)lds; float* Vt = Kt + 64 * 65; float* WK = Vt + 64 * 65;
  const bf16_t* PROJ = (const bf16_t*)(p.ws + WS_PROJ);
  const float* GT = (const float*)(p.ws + WS_GATES);
  float* UL = (float*)(p.ws + WS_ULOC); float* META = (float*)(p.ws + WS_MLMETA);
  const int b = unit / (4 * NCH), hh = (unit / NCH) & 3, ch = unit % NCH;
  const int row0 = b * SEGL + ch * 64;
  ml_load_tile(PROJ + (size_t)row0 * PW + C_MK + hh * 64, Kt, tid);
  ml_load_tile(PROJ + (size_t)row0 * PW + C_MV + hh * 64, Vt, tid);
  if (wid < 2) {
    const int dir = wid;
    const float ig = GT[(size_t)(row0 + lane) * 16 + (2 * dir) * 4 + hh];
    const float lf = logsigmoidf_(GT[(size_t)(row0 + lane) * 16 + (2 * dir + 1) * 4 + hh]);
    float ps = lf;
    ps = wave_incl_scan(ps);
    const float tot = __uint_as_float((unsigned)__builtin_amdgcn_readlane((int)__float_as_uint(ps), 63));
    const float wlog = dir == 0 ? (tot - ps + ig) : (ps - lf + ig);
    const float mloc = wave_max(wlog);
    WK[dir * 64 + lane] = __expf(wlog - mloc);
    if (lane == 0) {
      const int seq = (b * 4 + hh) * 2 + dir, ci = ml_cidx(ch, dir);
      META[((size_t)seq * NCH + ci) * 4 + 0] = tot; META[((size_t)seq * NCH + ci) * 4 + 1] = mloc;
    }
  }
  __syncthreads();
  {
    const int dir = wid >> 2, et = (wid >> 1) & 1, dt = wid & 1;
    const int seq = (b * 4 + hh) * 2 + dir, ci = ml_cidx(ch, dir);
    float* slot = UL + ((size_t)seq * NCH + ci) * USTRIDE;
    f32x16 acc = {};
#pragma unroll 8
    for (int ks = 0; ks < 32; ++ks) {
      const int s = 2 * ks + hi;
      const float a = WK[dir * 64 + s] * Vt[s * 65 + et * 32 + r32];
      const float bb = Kt[s * 65 + dt * 32 + r32];
      acc = __builtin_amdgcn_mfma_f32_32x32x2f32(a, bb, acc, 0, 0, 0);
    }
#pragma unroll
    for (int r = 0; r < 16; ++r) slot[(et * 32 + crow(r, hi)) * 64 + dt * 32 + r32] = acc[r];
    if (et == 0) {
      float n = 0.f;
#pragma unroll 8
      for (int i = 0; i < 32; ++i) { const int s = hi * 32 + i; n += WK[dir * 64 + s] * Kt[s * 65 + dt * 32 + r32]; }
      n = sum_xor32(n);
      if (hi == 0) slot[4096 + dt * 32 + r32] = n;
    }
  }
  __syncthreads();
}
constexpr int MLP = 144;
constexpr size_t WS_CST = WS_H;
constexpr size_t WS_NST = WS_H + (size_t)32 * NCH * 4096 * 2;
__device__ __forceinline__ void ml_stage_rm(const bf16_t* src, size_t ld, unsigned char* dst, int tid) {
  const int r = tid >> 3, c8 = (tid & 7) * 8;
  *(u32x4*)(dst + r * MLP + c8 * 2) = *(const u32x4*)(src + (size_t)r * ld + c8);
}
__device__ __forceinline__ void ml_stage_tr(const bf16_t* src, size_t ld, unsigned char* dst, int tid) {
  const int r = tid >> 3, c8 = (tid & 7) * 8;
  const u32x4 a = *(const u32x4*)(src + (size_t)r * ld + c8);
  bf16_t* d = (bf16_t*)dst;
  d[(c8 + 0) * 72 + r] = (bf16_t)(a.x & 0xffffu); d[(c8 + 1) * 72 + r] = (bf16_t)(a.x >> 16);
  d[(c8 + 2) * 72 + r] = (bf16_t)(a.y & 0xffffu); d[(c8 + 3) * 72 + r] = (bf16_t)(a.y >> 16);
  d[(c8 + 4) * 72 + r] = (bf16_t)(a.z & 0xffffu); d[(c8 + 5) * 72 + r] = (bf16_t)(a.z >> 16);
  d[(c8 + 6) * 72 + r] = (bf16_t)(a.w & 0xffffu); d[(c8 + 7) * 72 + r] = (bf16_t)(a.w >> 16);
}
__device__ __forceinline__ void ml_local_unit2(const Params& p, int l, int unit, unsigned char* lds) {
  int tid_ = tidx(); asm volatile("" : "+v"(tid_)); const int tid = tid_, lane = tid & 63, wid = tid >> 6, r32 = lane & 31, hi = lane >> 5;
  unsigned char* KT = lds; unsigned char* VT = lds + 64 * MLP; float* WK = (float*)(lds + 2 * 64 * MLP);
  const bf16_t* PROJ = (const bf16_t*)(p.ws + WS_PROJ);
  const float* GT = (const float*)(p.ws + WS_GATES);
  float* UL = (float*)(p.ws + WS_ULOC); float* META = (float*)(p.ws + WS_MLMETA);
  const int b = unit / (4 * NCH), hh = (unit / NCH) & 3, ch = unit % NCH;
  const int row0 = b * SEGL + ch * 64;
  ml_stage_tr(PROJ + (size_t)row0 * PW + C_MK + hh * 64, PW, KT, tid);
  ml_stage_tr(PROJ + (size_t)row0 * PW + C_MV + hh * 64, PW, VT, tid);
  if (wid < 2) {
    const int dir = wid;
    const float ig = GT[(size_t)(row0 + lane) * 16 + (2 * dir) * 4 + hh];
    const float lf = logsigmoidf_(GT[(size_t)(row0 + lane) * 16 + (2 * dir + 1) * 4 + hh]);
    float ps = lf;
    ps = wave_incl_scan(ps);
    const float tot = __uint_as_float((unsigned)__builtin_amdgcn_readlane((int)__float_as_uint(ps), 63));
    const float wlog = dir == 0 ? (tot - ps + ig) : (ps - lf + ig);
    const float mloc = wave_max(wlog);
    WK[dir * 64 + lane] = __expf(wlog - mloc);
    if (lane == 0) {
      const int seq = (b * 4 + hh) * 2 + dir, ci = ml_cidx(ch, dir);
      META[((size_t)seq * NCH + ci) * 4 + 0] = tot; META[((size_t)seq * NCH + ci) * 4 + 1] = mloc;
    }
  }
  __syncthreads();
  {
    const int dir = wid >> 2, et = (wid >> 1) & 1, dt = wid & 1;
    const int seq = (b * 4 + hh) * 2 + dir, ci = ml_cidx(ch, dir);
    float* slot = UL + ((size_t)seq * NCH + ci) * USTRIDE;
    f32x16 acc = {};
#pragma unroll
    for (int ks = 0; ks < 4; ++ks) {
      const int s0 = ks * 16 + hi * 8;
      const u32x4 va = *(const u32x4*)(VT + (et * 32 + r32) * MLP + s0 * 2);
      const bf16x8 kb = *(const bf16x8*)(KT + (dt * 32 + r32) * MLP + s0 * 2);
      const f32x4 w0 = *(const f32x4*)(WK + dir * 64 + s0), w1 = *(const f32x4*)(WK + dir * 64 + s0 + 4);
      u32x4 sa; sa.x = cvtpk(bflo(va.x) * w0.x, bfhi(va.x) * w0.y); sa.y = cvtpk(bflo(va.y) * w0.z, bfhi(va.y) * w0.w);
      sa.z = cvtpk(bflo(va.z) * w1.x, bfhi(va.z) * w1.y); sa.w = cvtpk(bflo(va.w) * w1.z, bfhi(va.w) * w1.w);
      acc = __builtin_amdgcn_mfma_f32_32x32x16_bf16(*(const bf16x8*)&sa, kb, acc, 0, 0, 0);
    }
#pragma unroll
    for (int r = 0; r < 16; ++r) slot[(et * 32 + crow(r, hi)) * 64 + dt * 32 + r32] = acc[r];
    if (et == 0) {
      float n = 0.f;
#pragma unroll
      for (int i = 0; i < 4; ++i) {
        const int s0 = hi * 32 + i * 8;
        const u32x4 ka = *(const u32x4*)(KT + (dt * 32 + r32) * MLP + s0 * 2);
        const f32x4 w0 = *(const f32x4*)(WK + dir * 64 + s0), w1 = *(const f32x4*)(WK + dir * 64 + s0 + 4);
        n += bflo(ka.x) * w0.x + bfhi(ka.x) * w0.y + bflo(ka.y) * w0.z + bfhi(ka.y) * w0.w + bflo(ka.z) * w1.x + bfhi(ka.z) * w1.y + bflo(ka.w) * w1.z + bfhi(ka.w) * w1.w;
      }
      n = sum_xor32(n);
      if (hi == 0) slot[4096 + dt * 32 + r32] = n;
    }
  }
  __syncthreads();
}
__device__ __forceinline__ void ml_scan(const Params& p, unsigned char* lds) {
  float* UL = (float*)(p.ws + WS_ULOC); float* META = (float*)(p.ws + WS_MLMETA);
  int tid_ = tidx(); asm volatile("" : "+v"(tid_));
  const int tid = tid_, lane = tid & 63, wid = tid >> 6;
  float* DEC = (float*)lds;
  float* SCL = DEC + 2 * NCH;
  float* TMP = SCL + 2 * NCH;
  constexpr int NSL = (32 * USTRIDE + 511) / 512;
  const int first_ = p.gx > 64 ? 16 : 0, nb_ = p.gx - first_;
  for (int k_ = 0; k_ < 2 + (NSL + nb_ - 1) / nb_; ++k_) {
    int s_;
    if (k_ == 0) s_ = p.bx >= first_ ? p.bx - first_ : -1;
    else s_ = k_ * nb_ + (p.gx - 1 - p.bx);
    if (k_ > 0 && p.gx - 1 - p.bx >= nb_) s_ = -1;
    if (s_ < 0 || s_ >= NSL) continue;
    const int base0 = s_ * 512;
    const int seq0 = base0 / USTRIDE;
    if (wid < 2) {
      const int seq = seq0 + wid;
      if (seq < 32) {
        float* mt = META + (size_t)seq * NCH * 4;
        for (int c = lane; c < NCH; c += 64) { TMP[(wid * 2 + 0) * NCH + c] = mt[c * 4 + 0]; TMP[(wid * 2 + 1) * NCH + c] = mt[c * 4 + 1]; }
        asm volatile("s_waitcnt lgkmcnt(0)" ::: "memory");
        if (lane == 0) {
          float m = 0.f;
          for (int c = 0; c < NCH; ++c) {
            const float bl = TMP[(wid * 2 + 0) * NCH + c], mloc = TMP[(wid * 2 + 1) * NCH + c];
            const float mn = fmaxf(bl + m, mloc);
            DEC[wid * NCH + c] = __expf(bl + m - mn); SCL[wid * NCH + c] = __expf(mloc - mn);
            mt[c * 4 + 2] = m;
            m = mn;
          }
        }
      }
    }
    __syncthreads();
    const int idx = base0 + tid;
    if (idx < 32 * USTRIDE) {
      const int seq = idx / USTRIDE, e = idx - seq * USTRIDE, sl = seq - seq0;
      float* bp = UL + (size_t)seq * NCH * USTRIDE + e;
      bf16_t* CSTp = (bf16_t*)(p.ws + WS_CST) + (size_t)seq * NCH * 4096 + (e < 4096 ? e : 0);
      float* NSTp = (float*)(p.ws + WS_NST) + (size_t)seq * NCH * 64 + (e < 4096 ? 0 : e - 4096);
      const float* dec = DEC + sl * NCH; const float* scl = SCL + sl * NCH;
      float C = 0.f;
      constexpr int BT = 33;
      static_assert(NCH == 4 * BT, "scan batches");
      float ua[BT], ub[BT];
#define SCAN_LD(u_, c0_) _Pragma("unroll") for (int j = 0; j < BT; ++j) u_[j] = bp[(size_t)((c0_) + j) * USTRIDE];
#define SCAN_DO(u_, c0_) _Pragma("unroll") for (int j = 0; j < BT; ++j) { \
          if (e < 4096) CSTp[(size_t)((c0_) + j) * 4096] = (bf16_t)(cvtpk(C, 0.f) & 0xffffu); else NSTp[(size_t)((c0_) + j) * 64] = C; \
          C = dec[(c0_) + j] * C + scl[(c0_) + j] * u_[j]; }
      SCAN_LD(ua, 0)
#pragma unroll 1
      for (int c0 = 0; c0 < NCH; c0 += 2 * BT) {
        SCAN_LD(ub, c0 + BT)
        SCAN_DO(ua, c0)
        if (c0 + 2 * BT < NCH) { SCAN_LD(ua, c0 + 2 * BT) }
        SCAN_DO(ub, c0 + BT)
      }
#undef SCAN_LD
#undef SCAN_DO
    }
    __syncthreads();
  }
}
__device__ __forceinline__ void ml_out_unit(const Params& p, int l, int unit, unsigned char* lds) {
  int tid_ = tidx(); asm volatile("" : "+v"(tid_)); const int tid = tid_, lane = tid & 63, wid = tid >> 6, r32 = lane & 31, hi = lane >> 5;
  float* Qt = (float*)lds; float* Kt = Qt + 64 * 65; float* Vt = Kt + 64 * 65;
  float* Cs = Vt + 64 * 65;
  float* Ns = Cs + 2 * 64 * 65;
  float* Bq = Ns + 128;
  float* Gs = Bq + 128;
  float* Mi = Gs + 128;
  float* HB = Mi + 64;
  const bf16_t* PROJ = (const bf16_t*)(p.ws + WS_PROJ);
  const float* GT = (const float*)(p.ws + WS_GATES);
  const float* UL = (const float*)(p.ws + WS_ULOC); const float* META = (const float*)(p.ws + WS_MLMETA);
  bf16_t* MIX = (bf16_t*)(p.ws + WS_MIX);
  const int b = unit / (4 * NCH), hh = (unit / NCH) & 3, ch = unit % NCH;
  const int row0 = b * SEGL + ch * 64;
  ml_load_tile(PROJ + (size_t)row0 * PW + C_MQ + hh * 64, Qt, tid);
  ml_load_tile(PROJ + (size_t)row0 * PW + C_MK + hh * 64, Kt, tid);
  ml_load_tile(PROJ + (size_t)row0 * PW + C_MV + hh * 64, Vt, tid);
  for (int i = tid; i < 2 * USTRIDE; i += 512) {
    const int dir = i / USTRIDE, e = i - dir * USTRIDE;
    const int seq = (b * 4 + hh) * 2 + dir, ci = ml_cidx(ch, dir);
    const float v = UL[((size_t)seq * NCH + ci) * USTRIDE + e];
    if (e < 4096) Cs[dir * 64 * 65 + (e >> 6) * 65 + (e & 63)] = v; else Ns[dir * 64 + (e - 4096)] = v;
  }
  if (wid < 2) {
    const int dir = wid;
    const float ig = GT[(size_t)(row0 + lane) * 16 + (2 * dir) * 4 + hh];
    const float lf = logsigmoidf_(GT[(size_t)(row0 + lane) * 16 + (2 * dir + 1) * 4 + hh]);
    float ps = lf;
    ps = wave_incl_scan(ps);
    const float tot = __uint_as_float((unsigned)__builtin_amdgcn_readlane((int)__float_as_uint(ps), 63));
    const float bc = dir == 0 ? ps : (tot - ps + lf);
    Bq[dir * 64 + lane] = bc; Gs[dir * 64 + lane] = ig - bc;
    if (lane == 0) { const int seq = (b * 4 + hh) * 2 + dir, ci = ml_cidx(ch, dir); Mi[dir] = META[((size_t)seq * NCH + ci) * 4 + 2]; }
  }
  __syncthreads();
  {
    const int dir = wid >> 2, tt = (wid >> 1) & 1, et = wid & 1;
    const int t = tt * 32 + r32;
    f32x16 sa[2] = {};
#pragma unroll 4
    for (int ks = 0; ks < 32; ++ks) {
      const float bq = Qt[t * 65 + 2 * ks + hi];
      const float a0 = Kt[(r32) * 65 + 2 * ks + hi], a1 = Kt[(32 + r32) * 65 + 2 * ks + hi];
      sa[0] = __builtin_amdgcn_mfma_f32_32x32x2f32(a0, bq, sa[0], 0, 0, 0);
      sa[1] = __builtin_amdgcn_mfma_f32_32x32x2f32(a1, bq, sa[1], 0, 0, 0);
    }
    const float bt = Bq[dir * 64 + t];
    const float inter = bt + Mi[dir];
    float mx = -INFINITY;
    f32x16 dl[2];
#pragma unroll
    for (int st = 0; st < 2; ++st)
#pragma unroll
      for (int r = 0; r < 16; ++r) {
        const int s = st * 32 + crow(r, hi);
        const bool ok = dir == 0 ? (s <= t) : (s >= t);
        const float d = ok ? bt + Gs[dir * 64 + s] : -INFINITY;
        dl[st][r] = d; mx = fmaxf(mx, d);
      }
    mx = max_xor32(mx);
    const float mt = fmaxf(inter, mx);
    const float iw = __expf(inter - mt);
    float rsum = 0.f;
#pragma unroll
    for (int st = 0; st < 2; ++st)
#pragma unroll
      for (int r = 0; r < 16; ++r) { const float w = __expf(dl[st][r] - mt); sa[st][r] *= w; rsum += sa[st][r]; }
    rsum = sum_xor32(rsum);
    float qn = 0.f;
#pragma unroll 8
    for (int i = 0; i < 32; ++i) { const int d = hi * 32 + i; qn += Ns[dir * 64 + d] * Qt[t * 65 + d]; }
    qn = sum_xor32(qn);
    const float den = rsum + iw * qn;
    const float rden = 1.f / fmaxf(fabsf(den), __expf(-mt));
    f32x16 an = {}, ac = {};
#pragma unroll
    for (int st = 0; st < 2; ++st)
#pragma unroll
      for (int r = 0; r < 16; ++r) {
        const float a = Vt[(st * 32 + crow(r, hi)) * 65 + et * 32 + r32];
        an = __builtin_amdgcn_mfma_f32_32x32x2f32(a, sa[st][r], an, 0, 0, 0);
      }
    const float* Cd = Cs + dir * 64 * 65;
#pragma unroll 4
    for (int ks = 0; ks < 32; ++ks) {
      const float a = Cd[(et * 32 + r32) * 65 + 2 * ks + hi];
      const float bq = Qt[t * 65 + 2 * ks + hi];
      ac = __builtin_amdgcn_mfma_f32_32x32x2f32(a, bq, ac, 0, 0, 0);
    }
#pragma unroll
    for (int r = 0; r < 16; ++r) HB[dir * 64 * 65 + t * 65 + et * 32 + crow(r, hi)] = (an[r] + iw * ac[r]) * rden;
  }
  __syncthreads();
  {
    const int t = tid >> 3, e8 = (tid & 7) * 8;
    float v[8]; float ss = 0.f;
#pragma unroll
    for (int i = 0; i < 8; ++i) { v[i] = HB[t * 65 + e8 + i] + HB[64 * 65 + t * 65 + e8 + i]; ss += v[i] * v[i]; }
    ss += dpp_mov<0xB1>(ss); ss += dpp_mov<0x4E>(ss); ss += dpp_mov<0x141>(ss);
    const float rs = rsqrtf(ss * (1.f / 64.f) + EPS);
    const u32x4 ov = *(const u32x4*)(PROJ + (size_t)(row0 + t) * PW + C_MO + hh * 64 + e8);
    const float og[8] = {bflo(ov.x), bfhi(ov.x), bflo(ov.y), bfhi(ov.y), bflo(ov.z), bfhi(ov.z), bflo(ov.w), bfhi(ov.w)};
    const float* g = p.in[I_MNORMG] + l * 64 + e8;
    float o[8];
#pragma unroll
    for (int i = 0; i < 8; ++i) o[i] = (ABL & 2) ? 0.f : v[i] * rs * g[i] * sigmoidf_(og[i]);
    u32x4 w; w.x = cvtpk(o[0], o[1]); w.y = cvtpk(o[2], o[3]); w.z = cvtpk(o[4], o[5]); w.w = cvtpk(o[6], o[7]);
    *(u32x4*)(MIX + (size_t)(row0 + t) * DM + 256 + hh * 64 + e8) = w;
  }
  __syncthreads();
}


struct MlOutPf { u32x4 q, k, v, c0, c1, ov; float ns0, ns1, g_ig, g_lf, mi; };
__device__ __forceinline__ void ml_out_fetch(const Params& p, int unit, int tid, MlOutPf& f) {
  const int lane = tid & 63, wid = tid >> 6;
  const bf16_t* PROJ = (const bf16_t*)(p.ws + WS_PROJ);
  const float* GT = (const float*)(p.ws + WS_GATES);
  const bf16_t* CST = (const bf16_t*)(p.ws + WS_CST); const float* NST = (const float*)(p.ws + WS_NST); const float* META = (const float*)(p.ws + WS_MLMETA);
  const int b = unit / (4 * NCH), hh = (unit / NCH) & 3, ch = unit % NCH;
  const int row0 = b * SEGL + ch * 64;
  const int r = tid >> 3, c8 = (tid & 7) * 8;
  const bf16_t* prow = PROJ + (size_t)(row0 + r) * PW + hh * 64 + c8;
  f.q = *(const u32x4*)(prow + C_MQ); f.k = *(const u32x4*)(prow + C_MK); f.v = *(const u32x4*)(prow + C_MV); f.ov = *(const u32x4*)(prow + C_MO);
  const int seq0 = (b * 4 + hh) * 2, ci0 = ml_cidx(ch, 0), ci1 = ml_cidx(ch, 1);
  f.c0 = *(const u32x4*)(CST + ((size_t)seq0 * NCH + ci0) * 4096 + r * 64 + c8);
  f.c1 = *(const u32x4*)(CST + ((size_t)(seq0 + 1) * NCH + ci1) * 4096 + r * 64 + c8);
  f.ns0 = 0.f; f.ns1 = 0.f; f.g_ig = 0.f; f.g_lf = 0.f; f.mi = 0.f;
  if (tid < 64) { f.ns0 = NST[((size_t)seq0 * NCH + ci0) * 64 + tid]; f.ns1 = NST[((size_t)(seq0 + 1) * NCH + ci1) * 64 + tid]; }
  if (wid < 2) {
    const int dir = wid;
    f.g_ig = GT[(size_t)(row0 + lane) * 16 + (2 * dir) * 4 + hh];
    f.g_lf = GT[(size_t)(row0 + lane) * 16 + (2 * dir + 1) * 4 + hh];
    f.mi = META[((size_t)(seq0 + dir) * NCH + (dir ? ci1 : ci0)) * 4 + 2];
  }
}
__device__ __forceinline__ void ml_put_rm(const u32x4 a, unsigned char* dst, int tid) { const int r = tid >> 3, c8 = (tid & 7) * 8; *(u32x4*)(dst + r * MLP + c8 * 2) = a; }
__device__ __forceinline__ void ml_put_tr(const u32x4 a, unsigned char* dst, int tid) {
  const int r = tid >> 3, c8 = (tid & 7) * 8;
  bf16_t* d = (bf16_t*)dst;
  d[(c8 + 0) * 72 + r] = (bf16_t)(a.x & 0xffffu); d[(c8 + 1) * 72 + r] = (bf16_t)(a.x >> 16);
  d[(c8 + 2) * 72 + r] = (bf16_t)(a.y & 0xffffu); d[(c8 + 3) * 72 + r] = (bf16_t)(a.y >> 16);
  d[(c8 + 4) * 72 + r] = (bf16_t)(a.z & 0xffffu); d[(c8 + 5) * 72 + r] = (bf16_t)(a.z >> 16);
  d[(c8 + 6) * 72 + r] = (bf16_t)(a.w & 0xffffu); d[(c8 + 7) * 72 + r] = (bf16_t)(a.w >> 16);
}
__device__ __forceinline__ void ml_out_unit2(const Params& p, int l, int unit, unsigned char* lds, const MlOutPf& f, int next, MlOutPf& fn) {
  int tid_ = tidx(); asm volatile("" : "+v"(tid_)); const int tid = tid_, lane = tid & 63, wid = tid >> 6, r32 = lane & 31, hi = lane >> 5;
  unsigned char* Qs = lds; unsigned char* Ks = lds + 64 * MLP; unsigned char* VT = lds + 2 * 64 * MLP; unsigned char* Cs = lds + 3 * 64 * MLP;
  float* Ns = (float*)(lds + 5 * 64 * MLP);
  float* Bq = Ns + 128;
  float* Gs = Bq + 128;
  float* Mi = Gs + 128;
  float* HB = Mi + 64;
  const bf16_t* PROJ = (const bf16_t*)(p.ws + WS_PROJ);
  const float* GT = (const float*)(p.ws + WS_GATES);
  const bf16_t* CST = (const bf16_t*)(p.ws + WS_CST); const float* NST = (const float*)(p.ws + WS_NST); const float* META = (const float*)(p.ws + WS_MLMETA);
  bf16_t* MIX = (bf16_t*)(p.ws + WS_MIX);
  const int b = unit / (4 * NCH), hh = (unit / NCH) & 3, ch = unit % NCH;
  const int row0 = b * SEGL + ch * 64;
  ml_put_rm(f.q, Qs, tid); ml_put_rm(f.k, Ks, tid); ml_put_tr(f.v, VT, tid);
  ml_put_rm(f.c0, Cs, tid); ml_put_rm(f.c1, Cs + 64 * MLP, tid);
  if (tid < 64) { Ns[tid] = f.ns0; Ns[64 + tid] = f.ns1; }
  if (wid < 2) {
    const int dir = wid;
    const float ig = f.g_ig;
    const float lf = logsigmoidf_(f.g_lf);
    float ps = lf;
    ps = wave_incl_scan(ps);
    const float tot = __uint_as_float((unsigned)__builtin_amdgcn_readlane((int)__float_as_uint(ps), 63));
    const float bc = dir == 0 ? ps : (tot - ps + lf);
    Bq[dir * 64 + lane] = bc; Gs[dir * 64 + lane] = ig - bc;
    if (lane == 0) Mi[dir] = f.mi;
  }
  const u32x4 ov = f.ov;
  if (next >= 0) ml_out_fetch(p, next, tid, fn);
  __syncthreads();
  {
    const int dir = wid >> 2, tt = (wid >> 1) & 1, et = wid & 1;
    const int t = tt * 32 + r32;
    f32x16 sa[2] = {};
    bf16x8 bq[4];
#pragma unroll
    for (int ks = 0; ks < 4; ++ks) {
      bq[ks] = *(const bf16x8*)(Qs + t * MLP + (ks * 16 + hi * 8) * 2);
      const bf16x8 a0 = *(const bf16x8*)(Ks + r32 * MLP + (ks * 16 + hi * 8) * 2), a1 = *(const bf16x8*)(Ks + (32 + r32) * MLP + (ks * 16 + hi * 8) * 2);
      sa[0] = __builtin_amdgcn_mfma_f32_32x32x16_bf16(a0, bq[ks], sa[0], 0, 0, 0);
      sa[1] = __builtin_amdgcn_mfma_f32_32x32x16_bf16(a1, bq[ks], sa[1], 0, 0, 0);
    }
    const float bt = Bq[dir * 64 + t];
    const float inter = bt + Mi[dir];
    float mx = -INFINITY;
    f32x16 dl[2];
#pragma unroll
    for (int st = 0; st < 2; ++st)
#pragma unroll
      for (int r = 0; r < 16; ++r) {
        const int s = st * 32 + crow(r, hi);
        const bool ok = dir == 0 ? (s <= t) : (s >= t);
        const float d = ok ? bt + Gs[dir * 64 + s] : -INFINITY;
        dl[st][r] = d; mx = fmaxf(mx, d);
      }
    mx = max_xor32(mx);
    const float mt = fmaxf(inter, mx);
    const float iw = __expf(inter - mt);
    float rsum = 0.f;
#pragma unroll
    for (int st = 0; st < 2; ++st)
#pragma unroll
      for (int r = 0; r < 16; ++r) { const float w = __expf(dl[st][r] - mt); sa[st][r] *= w; rsum += sa[st][r]; }
    rsum = sum_xor32(rsum);
    float qn = 0.f;
#pragma unroll
    for (int i = 0; i < 4; ++i) {
      const int d0 = hi * 32 + i * 8;
      const u32x4 qa = *(const u32x4*)(Qs + t * MLP + d0 * 2);
      const f32x4 n0 = *(const f32x4*)(Ns + dir * 64 + d0), n1 = *(const f32x4*)(Ns + dir * 64 + d0 + 4);
      qn += bflo(qa.x) * n0.x + bfhi(qa.x) * n0.y + bflo(qa.y) * n0.z + bfhi(qa.y) * n0.w + bflo(qa.z) * n1.x + bfhi(qa.z) * n1.y + bflo(qa.w) * n1.z + bfhi(qa.w) * n1.w;
    }
    qn = sum_xor32(qn);
    const float den = rsum + iw * qn;
    const float rden = 1.f / fmaxf(fabsf(den), __expf(-mt));
    f32x16 an = {}, ac = {};
#pragma unroll
    for (int st = 0; st < 2; ++st)
#pragma unroll
      for (int k2 = 0; k2 < 2; ++k2) {
        u32x4 bx; bx.x = cvtpk(sa[st][8 * k2 + 0], sa[st][8 * k2 + 1]); bx.y = cvtpk(sa[st][8 * k2 + 2], sa[st][8 * k2 + 3]);
        bx.z = cvtpk(sa[st][8 * k2 + 4], sa[st][8 * k2 + 5]); bx.w = cvtpk(sa[st][8 * k2 + 6], sa[st][8 * k2 + 7]);
        const unsigned char* vrow = VT + (et * 32 + r32) * MLP + (st * 32 + 16 * k2 + 4 * hi) * 2;
        const u32x2 v0 = *(const u32x2*)vrow, v1 = *(const u32x2*)(vrow + 16);
        u32x4 ax; ax.x = v0.x; ax.y = v0.y; ax.z = v1.x; ax.w = v1.y;
        an = __builtin_amdgcn_mfma_f32_32x32x16_bf16(*(const bf16x8*)&ax, *(const bf16x8*)&bx, an, 0, 0, 0);
      }
    const unsigned char* Cd = Cs + dir * 64 * MLP;
#pragma unroll
    for (int ks = 0; ks < 4; ++ks) {
      const bf16x8 a = *(const bf16x8*)(Cd + (et * 32 + r32) * MLP + (ks * 16 + hi * 8) * 2);
      ac = __builtin_amdgcn_mfma_f32_32x32x16_bf16(a, bq[ks], ac, 0, 0, 0);
    }
#pragma unroll
    for (int r = 0; r < 16; ++r) HB[dir * 64 * 65 + t * 65 + et * 32 + crow(r, hi)] = (an[r] + iw * ac[r]) * rden;
  }
  __syncthreads();
  {
    const int t = tid >> 3, e8 = (tid & 7) * 8;
    float v[8]; float ss = 0.f;
#pragma unroll
    for (int i = 0; i < 8; ++i) { v[i] = HB[t * 65 + e8 + i] + HB[64 * 65 + t * 65 + e8 + i]; ss += v[i] * v[i]; }
    ss += dpp_mov<0xB1>(ss); ss += dpp_mov<0x4E>(ss); ss += dpp_mov<0x141>(ss);
    const float rs = rsqrtf(ss * (1.f / 64.f) + EPS);
    const float og[8] = {bflo(ov.x), bfhi(ov.x), bflo(ov.y), bfhi(ov.y), bflo(ov.z), bfhi(ov.z), bflo(ov.w), bfhi(ov.w)};
    const float* g = p.in[I_MNORMG] + l * 64 + e8;
    float o[8];
#pragma unroll
    for (int i = 0; i < 8; ++i) o[i] = (ABL & 2) ? 0.f : v[i] * rs * g[i] * sigmoidf_(og[i]);
    u32x4 w; w.x = cvtpk(o[0], o[1]); w.y = cvtpk(o[2], o[3]); w.z = cvtpk(o[4], o[5]); w.w = cvtpk(o[6], o[7]);
    *(u32x4*)(MIX + (size_t)(row0 + t) * DM + 256 + hh * 64 + e8) = w;
  }
  __syncthreads();
}

#define KSWZ(row, colB) ((row) * 256 + ((colB) ^ (((row) & 15) << 4)))
#define SBAR() __builtin_amdgcn_sched_barrier(0)
constexpr int ATT_SHM_V = 128 * 80, ATT_SHM_K = 64 * QK8_PITCH;
constexpr float ATT_THR = 8.0f;
__device__ __forceinline__ int v_st(int k, int c) { const int kk = (k & ~0xC) | ((k & 4) << 1) | ((k & 8) >> 1); return ((kk >> 3) * 4 + (c >> 5)) * 512 + ((kk & 7) * 32 + (c & 31)) * 2; }
__device__ __forceinline__ int v_rd_base(int lane) { return ((lane & 3) << 3) | (((lane >> 2) & 3) << 6) | (((lane >> 4) & 1) << 5) | (((lane >> 5) & 1) << 8); }
constexpr int v_rd_off(int d0, int ks, int half) { return d0 * 512 + ks * 4096 + half * 2048; }
template <int OFF> __device__ __forceinline__ s16x4 tr_read(int vb) {
  s16x4 r; asm volatile("ds_read_b64_tr_b16 %0, %1 offset:%2" : "=&v"(r) : "v"(vb), "i"(OFF) : "memory"); return r;
}
template <int D0> __device__ __forceinline__ void pv_one(f32x16& od, int vb, bf16x8 pa0, bf16x8 pa1, bf16x8 pa2, bf16x8 pa3) {
  const s16x4 l0 = tr_read<v_rd_off(D0, 0, 0)>(vb), h0 = tr_read<v_rd_off(D0, 0, 1)>(vb), l1 = tr_read<v_rd_off(D0, 1, 0)>(vb), h1 = tr_read<v_rd_off(D0, 1, 1)>(vb);
  const s16x4 l2 = tr_read<v_rd_off(D0, 2, 0)>(vb), h2 = tr_read<v_rd_off(D0, 2, 1)>(vb), l3 = tr_read<v_rd_off(D0, 3, 0)>(vb), h3 = tr_read<v_rd_off(D0, 3, 1)>(vb);
  asm volatile("s_waitcnt lgkmcnt(0)" ::: "memory"); SBAR();
#define PK(L, H) (bf16x8){L[0], L[1], L[2], L[3], H[0], H[1], H[2], H[3]}
  od = __builtin_amdgcn_mfma_f32_32x32x16_bf16(pa0, PK(l0, h0), od, 0, 0, 0);
  od = __builtin_amdgcn_mfma_f32_32x32x16_bf16(pa1, PK(l1, h1), od, 0, 0, 0);
  od = __builtin_amdgcn_mfma_f32_32x32x16_bf16(pa2, PK(l2, h2), od, 0, 0, 0);
  od = __builtin_amdgcn_mfma_f32_32x32x16_bf16(pa3, PK(l3, h3), od, 0, 0, 0);
#undef PK
}
template <int D0> __device__ __forceinline__ void pv_two(f32x16& oa, f32x16& ob, int vb, bf16x8 a0, bf16x8 a1, bf16x8 a2, bf16x8 a3, bf16x8 b0, bf16x8 b1, bf16x8 b2, bf16x8 b3) {
  const s16x4 l0 = tr_read<v_rd_off(D0, 0, 0)>(vb), h0 = tr_read<v_rd_off(D0, 0, 1)>(vb), l1 = tr_read<v_rd_off(D0, 1, 0)>(vb), h1 = tr_read<v_rd_off(D0, 1, 1)>(vb);
  const s16x4 l2 = tr_read<v_rd_off(D0, 2, 0)>(vb), h2 = tr_read<v_rd_off(D0, 2, 1)>(vb), l3 = tr_read<v_rd_off(D0, 3, 0)>(vb), h3 = tr_read<v_rd_off(D0, 3, 1)>(vb);
  asm volatile("s_waitcnt lgkmcnt(0)" ::: "memory"); SBAR();
#define PK(L, H) (bf16x8){L[0], L[1], L[2], L[3], H[0], H[1], H[2], H[3]}
  const bf16x8 v0 = PK(l0, h0), v1 = PK(l1, h1), v2 = PK(l2, h2), v3 = PK(l3, h3);
  oa = __builtin_amdgcn_mfma_f32_32x32x16_bf16(a0, v0, oa, 0, 0, 0);
  ob = __builtin_amdgcn_mfma_f32_32x32x16_bf16(b0, v0, ob, 0, 0, 0);
  oa = __builtin_amdgcn_mfma_f32_32x32x16_bf16(a1, v1, oa, 0, 0, 0);
  ob = __builtin_amdgcn_mfma_f32_32x32x16_bf16(b1, v1, ob, 0, 0, 0);
  oa = __builtin_amdgcn_mfma_f32_32x32x16_bf16(a2, v2, oa, 0, 0, 0);
  ob = __builtin_amdgcn_mfma_f32_32x32x16_bf16(b2, v2, ob, 0, 0, 0);
  oa = __builtin_amdgcn_mfma_f32_32x32x16_bf16(a3, v3, oa, 0, 0, 0);
  ob = __builtin_amdgcn_mfma_f32_32x32x16_bf16(b3, v3, ob, 0, 0, 0);
#undef PK
}
struct KQFrag { bf16x8 b0, b1, q; };
__device__ __forceinline__ void att_ldkq(KQFrag& f, const LAS unsigned char* l3, int akk, int akq) {
  const LAS unsigned char* kp = l3 + akk;
  f.b0 = *(const LAS bf16x8*)kp; f.b1 = *(const LAS bf16x8*)(kp + 8192); f.q = *(const LAS bf16x8*)(l3 + akq);
}
#define ATT_MF(pa_, pb_, f_) do { pa_ = __builtin_amdgcn_mfma_f32_32x32x16_bf16(f_.b0, f_.q, pa_, 0, 0, 0); pb_ = __builtin_amdgcn_mfma_f32_32x32x16_bf16(f_.b1, f_.q, pb_, 0, 0, 0); } while (0)
__device__ __forceinline__ void att_qk_all(f32x16& p0, f32x16& p1, f32x16& q0, f32x16& q1, KQFrag& f0, const LAS unsigned char* l3, int akk0, int akq0, float ia, float ib) {
  KQFrag f1;
#pragma unroll
  for (int r = 0; r < 16; ++r) { p0[r] = ia; p1[r] = ia; q0[r] = ib; q1[r] = ib; }
  att_ldkq(f1, l3, akk0 ^ (1 << 5), akq0 ^ (1 << 5)); ATT_MF(p0, p1, f0); SBAR();
  att_ldkq(f0, l3, akk0 ^ (2 << 5), akq0 ^ (2 << 5)); ATT_MF(p0, p1, f1); SBAR();
  att_ldkq(f1, l3, akk0 ^ (3 << 5), akq0 ^ (3 << 5)); ATT_MF(p0, p1, f0); SBAR();
  att_ldkq(f0, l3, akk0 ^ (4 << 5), akq0 ^ (4 << 5)); ATT_MF(p0, p1, f1); SBAR();
  att_ldkq(f1, l3, akk0 ^ (5 << 5), akq0 ^ (5 << 5)); ATT_MF(q0, q1, f0); SBAR();
  att_ldkq(f0, l3, akk0 ^ (6 << 5), akq0 ^ (6 << 5)); ATT_MF(q0, q1, f1); SBAR();
  att_ldkq(f1, l3, akk0 ^ (7 << 5), akq0 ^ (7 << 5)); ATT_MF(q0, q1, f0); SBAR();
  ATT_MF(q0, q1, f1); SBAR();
}
__device__ __forceinline__ void att_softmax(f32x16& p0, f32x16& p1, float& m_reg, float& l_reg, float& alpha, bool first, i32x8& pa) {
  alpha = 1.f;
  if (first) {
    float pmax = p0[0];
#pragma unroll
    for (int r = 1; r < 16; ++r) pmax = fmaxf(pmax, p0[r]);
#pragma unroll
    for (int r = 0; r < 16; ++r) pmax = fmaxf(pmax, p1[r]);
    { auto rr = __builtin_amdgcn_permlane32_swap(__float_as_uint(pmax), __float_as_uint(pmax), false, false);
      pmax = fmaxf(__uint_as_float(rr[0]), __uint_as_float(rr[1])); }
    alpha = 0.f; m_reg = pmax;
#pragma unroll
    for (int r = 0; r < 16; ++r) { p0[r] -= pmax; p1[r] -= pmax; }
  }
#pragma unroll
  for (int r = 0; r < 16; ++r) { p0[r] = __builtin_amdgcn_exp2f(p0[r]); p1[r] = __builtin_amdgcn_exp2f(p1[r]); }
  float ps;
  {
#define VADD(d_, a_, b_) asm("v_add_f32_e32 %0, %1, %2" : "=v"(d_) : "v"(a_), "v"(b_))
    float s0, s1, s2, s3;
    VADD(s0, p0[0], p0[1]); VADD(s1, p0[8], p0[9]); VADD(s2, p1[0], p1[1]); VADD(s3, p1[8], p1[9]);
#pragma unroll
    for (int r = 2; r < 8; ++r) { VADD(s0, s0, p0[r]); VADD(s1, s1, p0[8 + r]); VADD(s2, s2, p1[r]); VADD(s3, s3, p1[8 + r]); }
    VADD(s0, s0, s1); VADD(s2, s2, s3); VADD(ps, s0, s2);
#undef VADD
  }
  { auto rr = __builtin_amdgcn_permlane32_swap(__float_as_uint(ps), __float_as_uint(ps), false, false);
    ps = __uint_as_float(rr[0]) + __uint_as_float(rr[1]); }
  if (__builtin_expect(!first && __any(ps > 256.f), 0)) {
    float emax = p0[0];
#pragma unroll
    for (int r = 1; r < 16; ++r) emax = fmaxf(emax, p0[r]);
#pragma unroll
    for (int r = 0; r < 16; ++r) emax = fmaxf(emax, p1[r]);
    { auto rr = __builtin_amdgcn_permlane32_swap(__float_as_uint(emax), __float_as_uint(emax), false, false);
      emax = fmaxf(__uint_as_float(rr[0]), __uint_as_float(rr[1])); }
    const float delta = fmaxf(__builtin_amdgcn_logf(emax), 0.f);
    alpha = __builtin_amdgcn_exp2f(-delta); m_reg += delta;
#pragma unroll
    for (int r = 0; r < 16; ++r) { p0[r] *= alpha; p1[r] *= alpha; }
    ps *= alpha;
  }
  l_reg = l_reg * alpha + ps;
#pragma unroll
  for (int v = 0; v < 4; ++v) {
    int w0, w1; asm volatile("" : "=v"(w0), "=v"(w1));
    w0 = __builtin_amdgcn_cvt_pk_fp8_f32(p0[4 * v], p0[4 * v + 1], w0, false); w0 = __builtin_amdgcn_cvt_pk_fp8_f32(p0[4 * v + 2], p0[4 * v + 3], w0, true);
    w1 = __builtin_amdgcn_cvt_pk_fp8_f32(p1[4 * v], p1[4 * v + 1], w1, false); w1 = __builtin_amdgcn_cvt_pk_fp8_f32(p1[4 * v + 2], p1[4 * v + 3], w1, true);
    pa[v] = w0; pa[4 + v] = w1;
  }
}
__device__ __forceinline__ void att_unit(const unsigned char* __restrict__ Q8, const unsigned char* __restrict__ K8, const unsigned char* __restrict__ V8, bf16_t* __restrict__ Ob,
                                         int nkeys, float lam, const float* __restrict__ ng, float oscale, unsigned char* lds) {
  int tid_ = tidx(); asm volatile("" : "+v"(tid_)); const int tid = tid_, wid = tid >> 6, lane = tid & 63, r32 = lane & 31, hi = lane >> 5;
  const int grp = __builtin_amdgcn_readfirstlane(wid >> 2);
  unsigned char* V_lds = lds; unsigned char* K_lds = lds + 2 * ATT_SHM_V;
  float* wsl = (float*)(lds + 2 * ATT_SHM_V + 2 * ATT_SHM_K) + wid * 64; float* li_l = wsl; float* al_l = wsl + 32;
  float m0 = 0.f, l0 = 0.f, m1 = 0.f, l1 = 0.f;
  f32x16 o0[4] = {}, o1[4] = {};
  unsigned char* Q_lds = lds + 2 * ATT_SHM_V + 2 * ATT_SHM_K + 2048;
#pragma unroll
  for (int i = 0; i < 5; ++i) { const int piece = __builtin_amdgcn_readfirstlane(wid) + 8 * i;
    if (piece < 36) __builtin_amdgcn_global_load_lds((const unsigned*)(Q8 + piece * 1024 + lane * 16), (LAS unsigned*)(Q_lds + piece * 1024), 16, 0, 0); }
  const unsigned ldsw = (unsigned)__builtin_amdgcn_readfirstlane(wid) * 1024u;
#define GSTAGE_K(b, k0) do { const unsigned char* ki_ = K8 + (size_t)(k0) * QK8_PITCH + tid * 16; \
      __builtin_amdgcn_global_load_lds((const unsigned*)ki_, (LAS unsigned*)(K_lds + (b) * ATT_SHM_K + ldsw), 16, 0, 0); \
      if (wid < 1) __builtin_amdgcn_global_load_lds((const unsigned*)(ki_ + 8192), (LAS unsigned*)(K_lds + (b) * ATT_SHM_K + 8192 + ldsw), 16, 0, 0); } while (0)
#define GSTAGE_V(b, k0) do { const unsigned char* vi_ = V8 + (size_t)((k0) >> 6) * ATT_SHM_V + tid * 16; \
      __builtin_amdgcn_global_load_lds((const unsigned*)vi_, (LAS unsigned*)(V_lds + (b) * ATT_SHM_V + ldsw), 16, 0, 0); \
      if (wid < 2) __builtin_amdgcn_global_load_lds((const unsigned*)(vi_ + 8192), (LAS unsigned*)(V_lds + (b) * ATT_SHM_V + 8192 + ldsw), 16, 0, 0); } while (0)
#define STAGE_PAIR(jj) do { GSTAGE_V((jj) & 1, (jj) * 64); if ((jj) + 1 < NT) GSTAGE_K((jj) & 1, ((jj) + 1) * 64); } while (0)
#define RESC(o, a) do { if (__any((a) < 1.f)) { if (hi == 0) al_l[r32] = (a); asm volatile("s_waitcnt lgkmcnt(0)" ::: "memory"); \
    _Pragma("unroll") for (int d = 0; d < 4; ++d) _Pragma("unroll") for (int r = 0; r < 16; ++r) o[d][r] *= al_l[crow(r, hi)]; } } while (0)
#define ATT_BAR() do { asm volatile("s_waitcnt lgkmcnt(0)" ::: "memory"); __builtin_amdgcn_s_barrier(); asm volatile("" ::: "memory"); } while (0)
#define ATT_LDK(dst_, off_) do { const u32x4 x0_ = *(const LAS u32x4*)(kb_ + (off_)), x1_ = *(const LAS u32x4*)(kb_ + (off_) + 16); \
      dst_[0] = (int)x0_.x; dst_[1] = (int)x0_.y; dst_[2] = (int)x0_.z; dst_[3] = (int)x0_.w; dst_[4] = (int)x1_.x; dst_[5] = (int)x1_.y; dst_[6] = (int)x1_.z; dst_[7] = (int)x1_.w; } while (0)
#define ATT_SC(acc_, kf_, qf_) acc_ = __builtin_amdgcn_mfma_scale_f32_32x32x64_f8f6f4(kf_, qf_, acc_, 0, 0, 0, 0x7F7F7F7F, 0, 0x7F7F7F7F)
#define ATT_LDQ(dst_, off_) do { const u32x4 x0_ = *(const LAS u32x4*)(qb_ + (off_)), x1_ = *(const LAS u32x4*)(qb_ + (off_) + 16); \
      dst_[0] = (int)x0_.x; dst_[1] = (int)x0_.y; dst_[2] = (int)x0_.z; dst_[3] = (int)x0_.w; dst_[4] = (int)x1_.x; dst_[5] = (int)x1_.y; dst_[6] = (int)x1_.z; dst_[7] = (int)x1_.w; } while (0)
#define ATT_QK_ALL(ia_, ib_) do { _Pragma("unroll") for (int r = 0; r < 16; ++r) { p0[r] = (ia_); p1[r] = (ia_); q0[r] = (ib_); q1[r] = (ib_); } \
      ATT_SC(p0, kf0, qf); SBAR(); ATT_LDK(kf0, 32 * QK8_PITCH); SBAR(); \
      ATT_SC(p1, kf0, qf); SBAR(); ATT_LDK(kf0, 64); ATT_LDQ(qf, 64); SBAR(); \
      ATT_SC(q0, kf0, qf); SBAR(); ATT_LDK(kf0, 32 * QK8_PITCH + 64); SBAR(); \
      ATT_SC(q1, kf0, qf); SBAR(); } while (0)
  const int NT = nkeys / 64;
  GSTAGE_K(1, 0); STAGE_PAIR(0);
  asm volatile("s_waitcnt vmcnt(0)" ::: "memory"); __syncthreads();
  f32x16 p0, p1, q0, q1; i32x8 pa, pb;
  const LAS unsigned char* l3 = (const LAS unsigned char*)lds;
  const int kofs0 = 2 * ATT_SHM_V + r32 * QK8_PITCH + hi * 32;
  const int qofs0 = 2 * ATT_SHM_V + 2 * ATT_SHM_K + 2048 + (__builtin_amdgcn_readfirstlane(wid) * 32 + r32) * QK8_PITCH + hi * 32;
  { i32x8 kf0, qf; const LAS unsigned char* kb_ = l3 + (kofs0 + ATT_SHM_K); const LAS unsigned char* qb_ = l3 + qofs0;
    ATT_LDK(kf0, 0); ATT_LDQ(qf, 0);
    ATT_QK_ALL(0.f, 0.f); }
  if (grp) ATT_BAR();
#pragma unroll 1
  for (int j = 0; j < NT; ++j) {
    const int cur = j & 1;
    const bool more = (j + 1 < NT);
    if (grp && more) STAGE_PAIR(j + 1);
    { float alphaA, alphaB;
      const bool first = (j == 0);
      att_softmax(p0, p1, m0, l0, alphaA, first, pa); SBAR();
      att_softmax(q0, q1, m1, l1, alphaB, first, pb); SBAR();
      RESC(o0, alphaA);
      RESC(o1, alphaB); }
    asm volatile("" : "+v"(pa), "+v"(pb), "+v"(m0), "+v"(l0), "+v"(m1), "+v"(l1));
    asm volatile("" : "+v"(o0[0]), "+v"(o0[1]), "+v"(o0[2]), "+v"(o0[3]), "+v"(o1[0]), "+v"(o1[1]), "+v"(o1[2]), "+v"(o1[3]));
    if (!grp) asm volatile("s_waitcnt vmcnt(0)" ::: "memory");
    ATT_BAR();
    if (!grp && more) STAGE_PAIR(j + 1);
    __builtin_amdgcn_s_setprio(1);
    {
      int kofs = kofs0, qofs = qofs0; asm volatile("" : "+v"(kofs), "+v"(qofs));
      const LAS unsigned char* kb_ = l3 + (kofs + cur * ATT_SHM_K); const LAS unsigned char* qb_ = l3 + qofs;
      i32x8 kf0, qf;
      const LAS unsigned char* vrow = l3 + (r32 * 80 + hi * 32 + cur * ATT_SHM_V);
      u32x4 va0 = *(const LAS u32x4*)vrow, va1 = *(const LAS u32x4*)(vrow + 16), vb0, vb1;
#define ATT_PV(d0_, x0_, x1_) do { i32x8 bv; bv[0] = (int)x0_.x; bv[1] = (int)x0_.y; bv[2] = (int)x0_.z; bv[3] = (int)x0_.w; bv[4] = (int)x1_.x; bv[5] = (int)x1_.y; bv[6] = (int)x1_.z; bv[7] = (int)x1_.w; \
        o0[d0_] = __builtin_amdgcn_mfma_scale_f32_32x32x64_f8f6f4(pa, bv, o0[d0_], 0, 0, 0, 0x7F7F7F7F, 0, 0x7F7F7F7F); \
        o1[d0_] = __builtin_amdgcn_mfma_scale_f32_32x32x64_f8f6f4(pb, bv, o1[d0_], 0, 0, 0, 0x7F7F7F7F, 0, 0x7F7F7F7F); } while (0)
      vb0 = *(const LAS u32x4*)(vrow + 32 * 80); vb1 = *(const LAS u32x4*)(vrow + 32 * 80 + 16); ATT_PV(0, va0, va1); SBAR();
      va0 = *(const LAS u32x4*)(vrow + 64 * 80); va1 = *(const LAS u32x4*)(vrow + 64 * 80 + 16); ATT_PV(1, vb0, vb1); SBAR();
      vb0 = *(const LAS u32x4*)(vrow + 96 * 80); vb1 = *(const LAS u32x4*)(vrow + 96 * 80 + 16); ATT_PV(2, va0, va1); SBAR();
      ATT_LDK(kf0, 0); ATT_LDQ(qf, 0);
      ATT_PV(3, vb0, vb1); SBAR();
#undef ATT_PV
      asm volatile("" : "+v"(o0[0]), "+v"(o0[1]), "+v"(o0[2]), "+v"(o0[3]), "+v"(o1[0]), "+v"(o1[1]), "+v"(o1[2]), "+v"(o1[3]));
      ATT_QK_ALL(-m0, -m1);
      asm volatile("" : "+v"(p0), "+v"(p1), "+v"(q0), "+v"(q1));
    }
    __builtin_amdgcn_s_setprio(0);
    if (grp) asm volatile("s_waitcnt vmcnt(0)" ::: "memory");
    ATT_BAR();
  }
  if (!grp) ATT_BAR();
  if (hi == 0) { li_l[r32] = 1.f / l0; al_l[r32] = lam / l1; }
  asm volatile("s_waitcnt lgkmcnt(0)" ::: "memory");
  float ss[16];
#pragma unroll
  for (int r = 0; r < 16; ++r) {
    const float a = li_l[crow(r, hi)], bq = al_l[crow(r, hi)];
    float s = 0.f;
#pragma unroll
    for (int d = 0; d < 4; ++d) { const float v = o0[d][r] * a - o1[d][r] * bq; o0[d][r] = v; s += v * v; }
    s += dpp_mov<0xB1>(s); s += dpp_mov<0x4E>(s); s += dpp_mov<0x141>(s); s += dpp_mov<0x140>(s);
    { auto rr_ = __builtin_amdgcn_permlane16_swap(__float_as_uint(s), __float_as_uint(s), false, false); s = __uint_as_float(rr_[0]) + __uint_as_float(rr_[1]); }
    ss[r] = rsqrtf(s * (1.f / 128.f) + EPS) * oscale;
  }
  bf16_t* Ow = Ob + (size_t)(wid * 32) * DM;
  unsigned char* ost = lds + 2 * ATT_SHM_V + 2 * ATT_SHM_K + 2048 + wid * (32 * 272);
#pragma unroll
  for (int d = 0; d < 4; ++d) {
    const float g = ng[d * 32 + r32];
#pragma unroll
    for (int r = 0; r < 16; ++r) *(bf16_t*)(ost + crow(r, hi) * 272 + (d * 32 + r32) * 2) = (ABL & 4) ? (bf16_t)0 : (bf16_t)(cvtpk(o0[d][r] * ss[r] * g, 0.f) & 0xffffu);
  }
  asm volatile("s_waitcnt lgkmcnt(0)" ::: "memory");
#pragma unroll
  for (int i = 0; i < 8; ++i) {
    const int c = lane + 64 * i, row = c >> 4, cb = (c & 15) * 16;
    *(u32x4*)((unsigned char*)(Ow + (size_t)row * DM) + cb) = *(const u32x4*)(ost + row * 272 + cb);
  }
  __syncthreads();
#undef ATT_LDK
#undef ATT_LDQ
#undef ATT_SC
#undef ATT_QK_ALL
#undef GSTAGE_K
#undef GSTAGE_V
#undef STAGE_PAIR
#undef RESC
#undef ATT_BAR
}

__device__ __forceinline__ float ins16(float (&a)[16], float x) {
#pragma unroll
  for (int i = 0; i < 16; ++i) { const float h = fmaxf(a[i], x); x = fminf(a[i], x); a[i] = h; }
  return x;
}
__device__ __forceinline__ void bsort16(float (&a)[16]) {
#pragma unroll
  for (int k = 2; k <= 16; k <<= 1)
#pragma unroll
    for (int j = k >> 1; j > 0; j >>= 1)
#pragma unroll
      for (int i = 0; i < 16; ++i) {
        const int q = i ^ j;
        if (q > i) {
          const bool desc = ((i & k) == 0);
          const float hi_ = fmaxf(a[i], a[q]), lo_ = fminf(a[i], a[q]);
          a[i] = desc ? hi_ : lo_; a[q] = desc ? lo_ : hi_;
        }
      }
}
__device__ __forceinline__ void bmerge16(float (&a)[16], const float (&b)[16]) {
#pragma unroll
  for (int i = 0; i < 16; ++i) a[i] = fmaxf(a[i], b[15 - i]);
#pragma unroll
  for (int j = 8; j > 0; j >>= 1)
#pragma unroll
    for (int i = 0; i < 16; ++i) {
      const int q = i ^ j;
      if (q > i) { const float hi_ = fmaxf(a[i], a[q]), lo_ = fminf(a[i], a[q]); a[i] = hi_; a[q] = lo_; }
    }
}
__device__ __forceinline__ float gelu_erf(float x) { return 0.5f * x * (1.f + erff(x * 0.70710678118654752440f)); }
#define XB_TMO      128
#define XB_XCNT(j)  (256  + 64 * (j))
#define XB_XSUB(j)  (1280 + 64 * (j))
#define XB_XGEN(j)  (2304 + 64 * (j))
#define XB_TOP      3328
#define XB_TOPGEN   3392
#define XCD_BAR_WORDS 3456
#define XB_SPIN_CAP (1u << 22)
__device__ __forceinline__ unsigned xb_ld(unsigned* p)              { return __hip_atomic_load(p, __ATOMIC_RELAXED, __HIP_MEMORY_SCOPE_AGENT); }
__device__ __forceinline__ unsigned xb_add(unsigned* p, unsigned v) { return __hip_atomic_fetch_add(p, v, __ATOMIC_RELAXED, __HIP_MEMORY_SCOPE_AGENT); }
__device__ __forceinline__ unsigned xb_xcc_id() { return (unsigned)__builtin_amdgcn_s_getreg((3 << 11) | 20) & 0xFu; }
#define XB_SPIN(cond, bar) do { unsigned _sp = 0; while (cond) { __builtin_amdgcn_s_sleep(1); \
    if ((++_sp & 255u) == 0u) { if (xb_ld(&(bar)[XB_TMO])) break; if (_sp > XB_SPIN_CAP) { atomicAdd(&(bar)[XB_TMO], 1u); break; } } } } while (0)
struct XcdBarrier { unsigned* bar; unsigned x; volatile LAS unsigned* st; };
__device__ __forceinline__ XcdBarrier xcd_barrier_post(unsigned* bar, volatile LAS unsigned* st) {
  XcdBarrier b; b.bar = bar; b.x = xb_xcc_id(); b.st = st;
  if (tidx() == 0) (void)xb_add(&bar[XB_XCNT(b.x)], 1u);
  return b;
}
__device__ __forceinline__ void xcd_barrier_complete(unsigned* bar, unsigned x, unsigned& nloc, unsigned& nx) {
  const unsigned G = gridDim.x * gridDim.y * gridDim.z;
  unsigned sum, cnt, mine, sp = 0u;
  for (;;) {
    sum = 0u; cnt = 0u; mine = 0u;
#pragma unroll
    for (unsigned j = 0; j < 16; ++j) { const unsigned c = xb_ld(&bar[XB_XCNT(j)]); sum += c; cnt += (c > 0u) ? 1u : 0u; mine = (j == x) ? c : mine; }
    if (sum == G) break;
    __builtin_amdgcn_s_sleep(1);
    if ((++sp & 255u) == 0u) { if (xb_ld(&bar[XB_TMO])) break; if (sp > XB_SPIN_CAP) { atomicAdd(&bar[XB_TMO], 1u); break; } }
  }
  nloc = mine > 0u ? mine : 1u; nx = cnt > 0u ? cnt : 1u;
}
__device__ __forceinline__ void xcd_barrier(const XcdBarrier& b) {
  asm volatile("s_waitcnt vmcnt(0)" ::: "memory");
  __syncthreads();
  if (tidx() == 0) {
    unsigned* bar = b.bar;
    __builtin_amdgcn_s_waitcnt(0);
    unsigned nloc = b.st[0], nx = b.st[1];
    if (nloc == 0u) { xcd_barrier_complete(bar, b.x, nloc, nx); b.st[0] = nloc; b.st[1] = nx; }
    const unsigned old = xb_add(&bar[XB_XSUB(b.x)], 1u);
    const unsigned gen = old / nloc;
    if (old + 1u == (gen + 1u) * nloc) {
      __builtin_amdgcn_fence(__ATOMIC_RELEASE, "agent");
      asm volatile("s_waitcnt vmcnt(0)" ::: "memory");
      const unsigned og = xb_add(&bar[XB_TOP], 1u);
      const unsigned tg = og / nx;
      if (og + 1u == (tg + 1u) * nx) xb_add(&bar[XB_TOPGEN], 1u);
      else XB_SPIN(xb_ld(&bar[XB_TOPGEN]) == tg, bar);
      __builtin_amdgcn_fence(__ATOMIC_ACQUIRE, "agent");
      xb_add(&bar[XB_XGEN(b.x)], 1u);
      asm volatile("s_waitcnt vmcnt(0)" ::: "memory");
    } else {
      XB_SPIN(xb_ld(&bar[XB_XGEN(b.x)]) == gen, bar);
      __builtin_amdgcn_fence(__ATOMIC_ACQUIRE, "agent");
      asm volatile("s_waitcnt vmcnt(0)" ::: "memory");
    }
  }
  __syncthreads();
}

constexpr size_t RT_STRIDE = (size_t)T * 128 * 4;
__device__ __forceinline__ void route_unit(const Params& p, int l, int unit, unsigned char* lds) {
  int tid_ = tidx(); asm volatile("" : "+v"(tid_)); const int tid = tid_, lane = tid & 63, wid = tid >> 6, r32 = lane & 31, hi = lane >> 5;
  unsigned char* IDX = lds;
  int* UE = (int*)(lds + 8192); float* UG = (float*)(lds + 8192 + 16384); float* US = (float*)(lds + 8192 + 32768);
  int* EIDG = (int*)(p.ws + WS_EID + (size_t)l * RT_STRIDE); float* GWG = (float*)(p.ws + WS_ULOC + RT_STRIDE); float* SUG = (float*)(p.ws + WS_ULOC + 2 * RT_STRIDE);
  const float* PSC = (const float*)(p.ws + WS_PSC);
  const int row0 = unit * 32;
  const bf16_t* QP = (const bf16_t*)(p.ws + WS_PROJ);
  const bf16_t* KEYS = (const bf16_t*)(p.ws + WS_KEYS) + (size_t)l * 131072;
  for (int rrep = 0; rrep < REP_ROUTE; ++rrep) {
    const int h = wid;
    float top[2][16];
#pragma unroll
    for (int pp = 0; pp < 2; ++pp) {
      const bf16_t* qrow = QP + (size_t)(row0 + r32) * DM + h * 128 + pp * 64 + hi * 8;
      const bf16_t* kb = KEYS + ((size_t)(h * 2 + pp) * 128 + r32) * 64 + hi * 8;
      bf16x8 bq[4];
#pragma unroll
      for (int ks = 0; ks < 4; ++ks) bq[ks] = *(const bf16x8*)(qrow + ks * 16);
      float (&lst)[16] = top[pp];
#pragma unroll
      for (int i = 0; i < 16; ++i) lst[i] = -INFINITY;
#pragma unroll
      for (int nt = 0; nt < 4; ++nt) {
        f32x16 acc = {};
#pragma unroll
        for (int ks = 0; ks < 4; ++ks) {
          const bf16x8 ak = *(const bf16x8*)(kb + (size_t)nt * 32 * 64 + ks * 16);
          acc = __builtin_amdgcn_mfma_f32_32x32x16_bf16(ak, bq[ks], acc, 0, 0, 0);
        }
        float grp[16];
#pragma unroll
        for (int r = 0; r < 16; ++r) grp[r] = __uint_as_float((__float_as_uint(acc[r]) & ~0x7Fu) | (unsigned)(nt * 32 + crow(r, hi)));
        bsort16(grp);
        if (nt == 0) {
#pragma unroll
          for (int i = 0; i < 16; ++i) lst[i] = grp[i];
        } else bmerge16(lst, grp);
        SBAR();
      }
      float oth[16];
#pragma unroll
      for (int i = 0; i < 16; ++i) { auto rr_ = __builtin_amdgcn_permlane32_swap(__float_as_uint(lst[i]), __float_as_uint(lst[i]), false, false); oth[i] = __uint_as_float(hi ? rr_[0] : rr_[1]); }
      bmerge16(lst, oth);
      if (hi == 0) {
        unsigned w[4];
#pragma unroll
        for (int i = 0; i < 4; ++i)
          w[i] = (__float_as_uint(lst[4 * i]) & 0x7Fu) | ((__float_as_uint(lst[4 * i + 1]) & 0x7Fu) << 8) | ((__float_as_uint(lst[4 * i + 2]) & 0x7Fu) << 16) | ((__float_as_uint(lst[4 * i + 3]) & 0x7Fu) << 24);
        *(u32x4*)(IDX + ((r32 * 8 + h) * 2 + pp) * 16) = (u32x4){w[0], w[1], w[2], w[3]};
      }
    }
    float best[16];
#define CAND(i, j) __uint_as_float((__float_as_uint(__uint_as_float(__float_as_uint(top[0][i]) & ~0x7Fu) + __uint_as_float(__float_as_uint(top[1][j]) & ~0x7Fu)) & ~0xFFu) | (unsigned)((i) * 16 + (j)))
    {
#pragma unroll
      for (int j = 0; j < 16; ++j) best[j] = CAND(0, j);
      float y[16];
#pragma unroll
      for (int j = 0; j < 8; ++j) { y[j] = CAND(1, j); y[8 + j] = CAND(15 - j, 0); }
#pragma unroll
      for (int jj = 8; jj > 0; jj >>= 1)
#pragma unroll
        for (int i = 0; i < 16; ++i) { const int q = i ^ jj; if (q > i) { const float hi_ = fmaxf(y[i], y[q]), lo_ = fminf(y[i], y[q]); y[i] = hi_; y[q] = lo_; } }
      bmerge16(best, y);
      float x[16];
      x[0] = CAND(2, 0); x[1] = CAND(2, 1); x[2] = CAND(2, 2); x[3] = CAND(2, 3); x[4] = CAND(2, 4);
      x[5] = CAND(3, 0); x[6] = CAND(3, 1); x[7] = CAND(3, 2); x[8] = CAND(3, 3);
      x[9] = CAND(4, 0); x[10] = CAND(4, 1); x[11] = CAND(4, 2);
      x[12] = CAND(5, 0); x[13] = CAND(5, 1); x[14] = CAND(6, 0); x[15] = CAND(6, 1);
      bsort16(x);
      bmerge16(best, x);
      ins16(best, CAND(7, 0)); ins16(best, CAND(7, 1));
    }
#undef CAND
    asm volatile("s_waitcnt lgkmcnt(0)" ::: "memory");
    if (hi == 0) {
      const unsigned char* ib = IDX + ((r32 * 8 + h) * 2) * 16;
      const float mx = __uint_as_float(__float_as_uint(best[0]) & ~0xFFu);
      float w[16]; float sum = 0.f;
#pragma unroll
      for (int k = 0; k < 16; ++k) { w[k] = __expf(__uint_as_float(__float_as_uint(best[k]) & ~0xFFu) - mx); sum += w[k]; }
      const float rsum = 1.f / sum;
      int ee[16]; float su_[16], sv_[16];
#pragma unroll
      for (int k = 0; k < 16; ++k) {
        const unsigned ij = __float_as_uint(best[k]) & 0xFFu;
        ee[k] = (int)ib[ij >> 4] * 128 + (int)ib[16 + (ij & 15)];
      }
#pragma unroll
      for (int k = 0; k < 16; ++k) { su_[k] = PSC[(size_t)l * NEXP + ee[k]]; sv_[k] = PSC[(size_t)(DEPTH + l) * NEXP + ee[k]]; }
#pragma unroll
      for (int k = 0; k < 16; ++k) {
        UE[r32 * 128 + h * 16 + k] = ee[k]; UG[r32 * 128 + h * 16 + k] = w[k] * rsum * sv_[k];
        US[r32 * 128 + h * 16 + k] = su_[k];
      }
    }
  }
  __syncthreads();
#pragma unroll 1
  for (int tt = 0; tt < 4; ++tt) {
    const int t = wid * 4 + tt;
    const int k0 = UE[t * 128 + lane], k1 = UE[t * 128 + 64 + lane];
    const float g0 = UG[t * 128 + lane], g1 = UG[t * 128 + 64 + lane], s0 = US[t * 128 + lane], s1 = US[t * 128 + 64 + lane];
    const int b0 = k0 >> 10, b1 = k1 >> 10;
    int base = 0, pos0 = 0, pos1 = 0;
#pragma unroll
    for (int b = 0; b < 16; ++b) {
      const unsigned long long m0 = __ballot(b0 == b), m1 = __ballot(b1 == b);
      const int c0 = __popcll(m0), c1 = __popcll(m1);
      const unsigned long long lt = (1ull << lane) - 1ull;
      if (b0 == b) pos0 = base + __popcll(m0 & lt);
      if (b1 == b) pos1 = base + c0 + __popcll(m1 & lt);
      base += c0 + c1;
    }
    const size_t ro = (size_t)(row0 + t) * 128;
    EIDG[ro + pos0] = k0; GWG[ro + pos0] = g0; SUG[ro + pos0] = s0;
    EIDG[ro + pos1] = k1; GWG[ro + pos1] = g1; SUG[ro + pos1] = s1;
  }
}
#define CAS __attribute__((address_space(4)))
typedef int i32x8 __attribute__((ext_vector_type(8)));
struct TokPref { f32x2 gs0, gs1; u32x4 hA, hB; };
struct RowPipe { i32x6 uq[4], vq[4]; i32x8 Ec; };
__device__ __forceinline__ const CAS i32x8* eid_row(const CAS unsigned char* eidg, int row) {
  return (const CAS i32x8*)(eidg + (size_t)(unsigned)__builtin_amdgcn_readfirstlane(row) * 512u);
}
__device__ __forceinline__ void tok_prefetch(const Params& p, int row, int lane, TokPref& t) {
  const float* GWG = (const float*)(p.ws + WS_ULOC + RT_STRIDE) + (size_t)row * 128;
  const float* SUG = (const float*)(p.ws + WS_ULOC + 2 * RT_STRIDE) + (size_t)row * 128;
  const bf16_t* H = (const bf16_t*)(p.ws + WS_H);
  t.gs0 = f32x2{GWG[lane], SUG[lane]}; t.gs1 = f32x2{GWG[64 + lane], SUG[64 + lane]};
  t.hA = *(const u32x4*)(H + (size_t)row * DM + lane * 16); t.hB = *(const u32x4*)(H + (size_t)row * DM + lane * 16 + 8);
}
#define LOADPAIR(dst_, tofs_, ea_, eb_) do { const u32x3v a_ = __builtin_amdgcn_raw_buffer_load_b96(rsT, lane12, (ea_) * PROW + (tofs_), 0); const unsigned b0_ = __builtin_amdgcn_raw_buffer_load_b32(rsT, lane12, (eb_) * PROW + (tofs_), 0); \
      const u32x2v b1_ = __builtin_amdgcn_raw_buffer_load_b64(rsT, lane12 + 4, (eb_) * PROW + (tofs_), 0); \
      dst_[0] = (int)a_.x; dst_[1] = (int)a_.y; dst_[2] = (int)a_.z; dst_[3] = (int)b0_; dst_[4] = (int)b1_.x; dst_[5] = (int)b1_.y; } while (0)
#define LOADGROUP(q_, tofs_, E_) do { LOADPAIR(q_[0], tofs_, E_[0], E_[1]); LOADPAIR(q_[1], tofs_, E_[2], E_[3]); LOADPAIR(q_[2], tofs_, E_[4], E_[5]); LOADPAIR(q_[3], tofs_, E_[6], E_[7]); } while (0)
constexpr int VOFS = (int)(WS_PV - WS_PU);
__device__ __forceinline__ void gather_token(const Params& p, const CAS unsigned char* eidg, const __amdgpu_buffer_rsrc_t rsT, int l, int row, int nextrow, TokPref& tp, RowPipe& rp, unsigned char* lds, int lane, int wid) {
  f32x2* GS = (f32x2*)(lds + wid * 2048);
  float* XC = (float*)(p.ws + WS_XCUR);
  const float* MOD = (const float*)(p.ws + WS_MOD);
  const CAS i32x8* EP = eid_row(eidg, row);
  const bool hasnext = nextrow >= 0;
  const CAS i32x8* EPn = eid_row(eidg, hasnext ? nextrow : row);
  GS[lane] = tp.gs0; GS[64 + lane] = tp.gs1;
  asm volatile("s_waitcnt lgkmcnt(0)" ::: "memory");
  const int eofl = ((lane >> 5) & 1) + 2 * ((lane >> 4) & 1) + 4 * ((lane >> 3) & 1);
  const int lane12 = lane * 12;
  {
    h16x2 hh[8];
    {
      const u32x4 hA = tp.hA, hB = tp.hB;
      hh[0] = __builtin_bit_cast(h16x2, __builtin_amdgcn_cvt_pkrtz(bflo(hA.x), bfhi(hA.x))); hh[1] = __builtin_bit_cast(h16x2, __builtin_amdgcn_cvt_pkrtz(bflo(hA.y), bfhi(hA.y))); hh[2] = __builtin_bit_cast(h16x2, __builtin_amdgcn_cvt_pkrtz(bflo(hA.z), bfhi(hA.z))); hh[3] = __builtin_bit_cast(h16x2, __builtin_amdgcn_cvt_pkrtz(bflo(hA.w), bfhi(hA.w)));
      hh[4] = __builtin_bit_cast(h16x2, __builtin_amdgcn_cvt_pkrtz(bflo(hB.x), bfhi(hB.x))); hh[5] = __builtin_bit_cast(h16x2, __builtin_amdgcn_cvt_pkrtz(bflo(hB.y), bfhi(hB.y))); hh[6] = __builtin_bit_cast(h16x2, __builtin_amdgcn_cvt_pkrtz(bflo(hB.z), bfhi(hB.z))); hh[7] = __builtin_bit_cast(h16x2, __builtin_amdgcn_cvt_pkrtz(bflo(hB.w), bfhi(hB.w)));
    }
    if (hasnext) tok_prefetch(p, nextrow, lane, tp);
    f32x4 xpre[4];
    { const float* xr_ = XC + (size_t)row * DM + lane * 16;
#pragma unroll
      for (int v4 = 0; v4 < 4; ++v4) xpre[v4] = *(const f32x4*)(xr_ + v4 * 4); }
    f32x2 acc2[8];
#pragma unroll
    for (int i = 0; i < 8; ++i) acc2[i] = f32x2{0.f, 0.f};
#pragma unroll 1
    for (int g8 = 0; g8 < 16; ++g8) {
      const bool pf = (g8 < 15) || hasnext;
      const f32x2 gs = GS[g8 * 8 + eofl];
      float d[8];
#pragma unroll
      for (int i2 = 0; i2 < 4; ++i2) {
        const h16x32 r = __builtin_amdgcn_cvt_scalef32_pk32_f16_fp6(rp.uq[i2], 1.0f);
        float a0 = 0.f, a1 = 0.f, b0 = 0.f, b1 = 0.f;
#define UDOT(k_) a0 = __builtin_amdgcn_fdot2(__builtin_shufflevector(r, r, 4 * (k_), 4 * (k_) + 1), hh[2 * (k_)], a0, false); b0 = __builtin_amdgcn_fdot2(__builtin_shufflevector(r, r, 16 + 4 * (k_), 17 + 4 * (k_)), hh[2 * (k_)], b0, false); \
        a1 = __builtin_amdgcn_fdot2(__builtin_shufflevector(r, r, 4 * (k_) + 2, 4 * (k_) + 3), hh[2 * (k_) + 1], a1, false); b1 = __builtin_amdgcn_fdot2(__builtin_shufflevector(r, r, 18 + 4 * (k_), 19 + 4 * (k_)), hh[2 * (k_) + 1], b1, false);
        UDOT(0) UDOT(1) UDOT(2) UDOT(3)
#undef UDOT
        d[2 * i2] = a0 + a1;
        d[2 * i2 + 1] = b0 + b1;
        asm volatile("" : "+v"(d[2 * i2]), "+v"(d[2 * i2 + 1]));
      }
      if (pf) LOADGROUP(rp.uq, 0, rp.Ec);
      float tot;
      {
        auto s01 = __builtin_amdgcn_permlane32_swap(__float_as_uint(d[0]), __float_as_uint(d[1]), false, false);
        auto s23 = __builtin_amdgcn_permlane32_swap(__float_as_uint(d[2]), __float_as_uint(d[3]), false, false);
        auto s45 = __builtin_amdgcn_permlane32_swap(__float_as_uint(d[4]), __float_as_uint(d[5]), false, false);
        auto s67 = __builtin_amdgcn_permlane32_swap(__float_as_uint(d[6]), __float_as_uint(d[7]), false, false);
        const float q01 = __uint_as_float(s01[0]) + __uint_as_float(s01[1]), q23 = __uint_as_float(s23[0]) + __uint_as_float(s23[1]);
        const float q45 = __uint_as_float(s45[0]) + __uint_as_float(s45[1]), q67 = __uint_as_float(s67[0]) + __uint_as_float(s67[1]);
        auto ta = __builtin_amdgcn_permlane16_swap(__float_as_uint(q01), __float_as_uint(q23), false, false);
        auto tb = __builtin_amdgcn_permlane16_swap(__float_as_uint(q45), __float_as_uint(q67), false, false);
        const float r0123 = __uint_as_float(ta[0]) + __uint_as_float(ta[1]);
        const float r4567 = __uint_as_float(tb[0]) + __uint_as_float(tb[1]);
        const bool b3 = (lane & 8) != 0;
        const float keep = b3 ? r4567 : r0123, send = b3 ? r0123 : r4567;
        float x = keep + dpp_mov<0x140>(send);
        x += dpp_mov<0xB1>(x); x += dpp_mov<0x4E>(x); x += dpp_mov<0x141>(x);
        tot = x * gs.y;
      }
      float ge;
      {
        const float v = tot, av = fabsf(v), tq = __builtin_amdgcn_rcpf(av * 0.2316418882f + 1.0f);
        float q = tq * 0.5307027145f + (-0.7265760135f); q = q * tq + 0.7107068705f; q = q * tq + (-0.142248368f); q = q * tq + 0.127414796f; q = q * tq;
        const float ex = __builtin_amdgcn_exp2f(v * v * (-0.72134752044f));
        const float m = v * (q * ex), r = v - m;
        ge = (v < 0.f ? m : r) * gs.x;
      }
      unsigned cw[8];
      { const unsigned gp = __builtin_bit_cast(unsigned, __builtin_amdgcn_cvt_pkrtz(ge * 1024.f, ge * 1024.f));
        cw[0] = (unsigned)__builtin_amdgcn_readlane((int)gp, 0);  cw[4] = (unsigned)__builtin_amdgcn_readlane((int)gp, 8);
        cw[2] = (unsigned)__builtin_amdgcn_readlane((int)gp, 16); cw[6] = (unsigned)__builtin_amdgcn_readlane((int)gp, 24);
        cw[1] = (unsigned)__builtin_amdgcn_readlane((int)gp, 32); cw[5] = (unsigned)__builtin_amdgcn_readlane((int)gp, 40);
        cw[3] = (unsigned)__builtin_amdgcn_readlane((int)gp, 48); cw[7] = (unsigned)__builtin_amdgcn_readlane((int)gp, 56); }
      h16x2 a16[8];
#pragma unroll
      for (int i2 = 0; i2 < 4; ++i2) {
        const h16x32 r = __builtin_amdgcn_cvt_scalef32_pk32_f16_fp6(rp.vq[i2], 1.0f);
        const h16x2 ca = __builtin_bit_cast(h16x2, cw[2 * i2]), cb = __builtin_bit_cast(h16x2, cw[2 * i2 + 1]);
#define VAXL(k_) a16[k_] = (i2 == 0) ? ca * __builtin_shufflevector(r, r, 2 * (k_), 2 * (k_) + 1) : ca * __builtin_shufflevector(r, r, 2 * (k_), 2 * (k_) + 1) + a16[k_];
#define VAXH(k_) a16[k_] = cb * __builtin_shufflevector(r, r, 16 + 2 * (k_), 17 + 2 * (k_)) + a16[k_];
        VAXL(0) VAXL(1) VAXL(2) VAXL(3) VAXL(4) VAXL(5) VAXL(6) VAXL(7)
        asm volatile("" : "+v"(a16[0]), "+v"(a16[1]), "+v"(a16[2]), "+v"(a16[3]), "+v"(a16[4]), "+v"(a16[5]), "+v"(a16[6]), "+v"(a16[7]));
        VAXH(0) VAXH(1) VAXH(2) VAXH(3) VAXH(4) VAXH(5) VAXH(6) VAXH(7)
#undef VAXL
#undef VAXH
        asm volatile("" : "+v"(a16[0]), "+v"(a16[1]), "+v"(a16[2]), "+v"(a16[3]), "+v"(a16[4]), "+v"(a16[5]), "+v"(a16[6]), "+v"(a16[7]));
      }
#pragma unroll
      for (int k = 0; k < 8; ++k) acc2[k] = f32x2{(float)a16[k].x, (float)a16[k].y} * f32x2{1.f / 1024.f, 1.f / 1024.f} + acc2[k];
      if (pf) LOADGROUP(rp.vq, VOFS, rp.Ec);
      { const CAS i32x8* src_ = g8 < 14 ? EP + (g8 + 2) : EPn + (g8 - 14); rp.Ec = *src_; }
    }
    SBAR();
    float acc[16];
#pragma unroll
    for (int i = 0; i < 8; ++i) { acc[2 * i] = acc2[i].x; acc[2 * i + 1] = acc2[i].y; }
    const int mr = mod_row(row);
    const float* g2 = MOD + ((size_t)l * 5 + mr) * 6144 + 5 * 1024;
    float* xr = XC + (size_t)row * DM;
    float xn[16]; float ssq = 0.f;
    if (ABL & 8) {
#pragma unroll
      for (int i = 0; i < 16; ++i) acc[i] = 0.f;
    }
#pragma unroll
    for (int v4 = 0; v4 < 4; ++v4) {
      const int c = lane * 16 + v4 * 4;
      const f32x4 xo = xpre[v4], gg = *(const f32x4*)(g2 + c);
      f32x4 o;
      o.x = xo.x + gg.x * acc[v4 * 4 + 0]; o.y = xo.y + gg.y * acc[v4 * 4 + 1]; o.z = xo.z + gg.z * acc[v4 * 4 + 2]; o.w = xo.w + gg.w * acc[v4 * 4 + 3];
      xn[v4 * 4 + 0] = o.x; xn[v4 * 4 + 1] = o.y; xn[v4 * 4 + 2] = o.z; xn[v4 * 4 + 3] = o.w;
      ssq += (o.x * o.x + o.y * o.y) + (o.z * o.z + o.w * o.w);
      if (l < DEPTH - 1) *(f32x4*)(xr + c) = o;
    }
    const float rs = rsqrtf(wave_sum_fast(ssq) * (1.f / DM) + EPS);
    if (l == DEPTH - 1) {
      const int b = row / SEGL, s = row - b * SEGL;
      float* orow = p.out + ((size_t)(b * SEQ + (s - CTXL))) * DM;
      const float* fg = p.in[I_FINALG];
#pragma unroll
      for (int v4 = 0; v4 < 4; ++v4) {
        const int c = lane * 16 + v4 * 4;
        const f32x4 gg = *(const f32x4*)(fg + c);
        f32x4 o; o.x = xn[v4 * 4 + 0] * rs * gg.x; o.y = xn[v4 * 4 + 1] * rs * gg.y; o.z = xn[v4 * 4 + 2] * rs * gg.z; o.w = xn[v4 * 4 + 3] * rs * gg.w;
        *(f32x4*)(orow + c) = o;
      }
    } else {
      const float* m = MOD + ((size_t)(l + 1) * 5 + mr) * 6144;
      const float* ng = p.in[I_N1G] + (l + 1) * DM;
      bf16_t* hrow = (bf16_t*)(p.ws + WS_H) + (size_t)row * DM;
#pragma unroll
      for (int hh = 0; hh < 2; ++hh) {
        float y[8];
#pragma unroll
        for (int i = 0; i < 8; ++i) { const int c = lane * 16 + hh * 8 + i; y[i] = xn[hh * 8 + i] * rs * ng[c] * (1.f + m[1024 + c]) + m[c]; }
        u32x4 w; w.x = cvtpk(y[0], y[1]); w.y = cvtpk(y[2], y[3]); w.z = cvtpk(y[4], y[5]); w.w = cvtpk(y[6], y[7]);
        *(u32x4*)(hrow + lane * 16 + hh * 8) = w;
      }
    }
  }
}

__device__ __forceinline__ void ev_signal(unsigned* ctr) {
  asm volatile("s_waitcnt vmcnt(0)" ::: "memory");
  __syncthreads();
  if (tidx() == 0) { __builtin_amdgcn_fence(__ATOMIC_RELEASE, "agent"); asm volatile("s_waitcnt vmcnt(0)" ::: "memory"); (void)xb_add(ctr, 1u); }
}
__device__ __forceinline__ void ev_wait(unsigned* ctr, unsigned n, unsigned* bar) {
  if (tidx() == 0) {
    XB_SPIN(xb_ld(ctr) < n, bar);
    __builtin_amdgcn_fence(__ATOMIC_ACQUIRE, "agent");
    asm volatile("s_waitcnt vmcnt(0)" ::: "memory");
  }
  __syncthreads();
}
constexpr int EV_WORD0 = 8192;
__device__ __forceinline__ void phase_c1(const Params& p, int l, unsigned char* lds) {
  constexpr int NLOC = NBATCH * 4 * NCH, NCONV = T / 32;
  for (int u = p.bx; u < NLOC + NCONV; u += p.gx) {
    if (u < NLOC) ml_local_unit2(p, l, u, lds);
    else {
      const int cu = u - NLOC;
      if (l == DEPTH - 1 && (cu % (SEGL / 32)) < (CTXL / 32)) continue;
      conv_unit(p, l, cu, lds);
    }
  }
}
__device__ __forceinline__ void phase_c3(const Params& p, int l, unsigned char* lds);
__device__ __forceinline__ void phase_c2(const Params& p, int l, unsigned char* lds) {
  unsigned* ev = (unsigned*)(p.ws + WS_CTL) + EV_WORD0 + 64 * l;
  ml_scan(p, lds);
  ev_signal(ev);
  const float* lp = p.in[I_DLAM] + l * 256;
  float s01 = 0.f, s23 = 0.f;
  for (int i = 0; i < 64; ++i) { s01 += lp[i] * lp[64 + i]; s23 += lp[128 + i] * lp[192 + i]; }
  const float lam_init = 0.8f - 0.6f * expf(-0.3f * (float)l);
  const float lam = expf(s01) - expf(s23) + lam_init;
  const bf16_t* PROJ = (const bf16_t*)(p.ws + WS_PROJ);
  bf16_t* MIX = (bf16_t*)(p.ws + WS_MIX);
  const float* ng = p.in[I_DNORMG] + l * 128;
  const int nun = 512 + (l < DEPTH - 1 ? 16 : 0);
  for (int u = p.bx; u < nun; u += p.gx) {
    int bh, qrow, nkeys;
    if (u < 512) { const int xcd = u & 7, i = (u >> 3) & 31, rnd = u >> 8; bh = 2 * xcd + rnd; qrow = CTXL + i * 256; nkeys = SEGL; }
    else { bh = u - 512; qrow = 0; nkeys = CTXL; }
    const int b = bh >> 2, h = bh & 3;
    const size_t tok0 = (size_t)b * SEGL;
    for (int rep = 0; rep < REP_ATT; ++rep)
    att_unit(p.ws + WS_QK8 + ((size_t)bh * SEGL + qrow) * QK8_PITCH, p.ws + WS_QK8 + QK8_IMG + (size_t)bh * SEGL * QK8_PITCH, p.ws + WS_V8T + (size_t)bh * NCH * ATT_SHM_V,
             MIX + (tok0 + qrow) * DM + 512 + h * 128, nkeys, lam, ng, 1.f - lam_init, lds);
  }
  ev_wait(ev, (unsigned)p.gx, p.xbar_words);
  for (int rep = 0; rep < REP_ML; ++rep) phase_c3(p, l, lds);
}
__device__ __forceinline__ void phase_c3(const Params& p, int l, unsigned char* lds) {
  constexpr int NU = NBATCH * 4 * NCH;
  const int nlow = (p.gx > 64 && l < DEPTH - 1) ? 16 : 0, ulow = nlow * 7;
  int u, step;
  if (p.bx < nlow) { u = p.bx; step = nlow; } else { u = ulow + (p.bx - nlow); step = p.gx - nlow; }
  const int uend = p.bx < nlow ? ulow : NU;
  int tid_ = tidx(); asm volatile("" : "+v"(tid_));
  auto valid_from = [&](int v) { while (v < uend && l == DEPTH - 1 && (v % NCH) < 4) v += step; return v < uend ? v : -1; };
  MlOutPf fa, fb;
  u = valid_from(u);
  if (u >= 0) ml_out_fetch(p, u, tid_, fa);
  while (u >= 0) {
    const int nx = valid_from(u + step);
    ml_out_unit2(p, l, u, lds, fa, nx, fb);
    fa = fb; u = nx;
  }
}
__device__ __forceinline__ void phase_route(const Params& p, int l, unsigned char* lds) {
  constexpr int NU = T / 32;
  for (int u = p.bx; u < NU; u += p.gx) {
    if (l == DEPTH - 1 && (u % (SEGL / 32)) < (CTXL / 32)) continue;
    route_unit(p, l, u, lds);
    __syncthreads();
  }
}
__device__ __forceinline__ void phase_gather(const Params& p, int l, unsigned char* lds) {
  int tid_ = tidx(); asm volatile("" : "+v"(tid_)); const int lane = tid_ & 63, wid = __builtin_amdgcn_readfirstlane(tid_ >> 6);
  const int gw = p.bx * 8 + wid, NGW = p.gx * 8;
  const int ntok = (l == DEPTH - 1) ? NBATCH * SEQ : T;
#define TOKROW(ti_) ((l == DEPTH - 1) ? ((ti_) / SEQ) * SEGL + CTXL + ((ti_) % SEQ) : (ti_))
  const CAS unsigned char* eidg = (const CAS unsigned char*)(p.ws + WS_EID + (size_t)l * RT_STRIDE);
  const __amdgpu_buffer_rsrc_t rsT = __builtin_amdgcn_make_buffer_rsrc((void*)(p.ws + WS_PU + (size_t)l * NEXP * PROW), 0, VOFS + NEXP * PROW, 0x00020000);
  const int nfull = ntok / NGW, rem = ntok - nfull * NGW, per = (rem % p.gx == 0) ? rem / p.gx : -1;
  auto tok_at = [&](int r) -> int {
    if (r < nfull) return gw + r * NGW;
    if (r > nfull || rem == 0) return -1;
    if (per >= 0) return wid < per ? nfull * NGW + p.bx * per + wid : -1;
    return gw + r * NGW < ntok ? gw + r * NGW : -1;
  };
  TokPref tp; RowPipe rp;
  const int ti0 = tok_at(0);
  if (ti0 >= 0) {
    const int row0 = TOKROW(ti0); const int lane12 = lane * 12;
    tok_prefetch(p, row0, lane, tp);
    const CAS i32x8* EP0 = eid_row(eidg, row0);
    rp.Ec = EP0[0];
    LOADGROUP(rp.uq, 0, rp.Ec); LOADGROUP(rp.vq, VOFS, rp.Ec);
    rp.Ec = EP0[1];
  }
  XcdBarrier xb; xb.bar = p.xbar_words; xb.x = p.xbar_x; xb.st = (volatile LAS unsigned*)((LAS unsigned char*)lds + p.lds_st_off);
  const int nrounds = (ntok + NGW - 1) / NGW;
  for (int r = 0; r < nrounds; ++r) {
    const int ti = tok_at(r);
    if (ti >= 0) {
      const int row = TOKROW(ti);
      const int tn = tok_at(r + 1);
      const int nxt = tn >= 0 ? TOKROW(tn) : -1;
      gather_token(p, eidg, rsT, l, row, nxt, tp, rp, lds, lane, wid);
    }
#if GATHER_SYNC
    if (r + 1 < nrounds) { XcdBarrier xb2 = xb; size_t zb_ = 0; asm volatile("" : "+s"(zb_)); xb2.bar = xb.bar + zb_; xb2.x = xb.x + (unsigned)zb_; xcd_barrier(xb2); }
#endif
  }
#undef TOKROW
}

__global__ void __launch_bounds__(512, 2) mk_fwd(KArgs ka) {
  cg::grid_group grid = cg::this_grid();
  extern __shared__ __attribute__((aligned(16))) unsigned char lds[];
  const int lo = ka.ph_lo, hi = ka.ph_hi;
#define IN(k) (lo <= (k) && (k) < hi)
#ifndef PHASEMASK
#define PHASEMASK 0xFFFF
#endif
#define PH(i) ((PHASEMASK >> (i)) & 1)
#define MKP(q) Params q; { size_t z_ = 0; asm volatile("" : "+s"(z_)); \
    q.in = (InTab)((const __attribute__((address_space(4))) char*)__builtin_amdgcn_kernarg_segment_ptr() + z_); \
    q.out = ka.out + z_; q.ws = ka.ws + z_; q.ph_lo = lo; q.ph_hi = hi; q.bx = (int)blockIdx.x + (int)z_; q.gx = (int)gridDim.x + (int)z_; q.xbar_words = xbar.bar + z_; q.xbar_x = xbar.x + (unsigned)z_; q.lds_st_off = (unsigned)(LDS_BYTES - 64); }
#define SEAM(k) do { if (IN(k) && IN((k) + 1)) { if ((k) == 0) grid.sync(); else { XcdBarrier xb_ = xbar; size_t zb_ = 0; asm volatile("" : "+s"(zb_)); xb_.bar = xbar.bar + zb_; xb_.x = xbar.x + (unsigned)zb_; xcd_barrier(xb_); } } } while (0)
  volatile LAS unsigned* xst = (volatile LAS unsigned*)((LAS unsigned char*)lds + (LDS_BYTES - 64));
  { const int t0_ = threadIdx.x;
    if (t0_ < 2) xst[t0_] = 0u;
    if ((t0_ & 63) == 0) *(volatile LAS int*)((LAS unsigned char*)lds + LDS_WTAB + 4 * hw_wave_key()) = t0_ >> 6; }
  __syncthreads();
  XcdBarrier xbar = xcd_barrier_post((unsigned*)(ka.ws + WS_CTL) + 4096, xst);
  { MKP(p)
    if (PH(0) && IN(0)) for (int rep = 0; rep < REP_MISC; ++rep) { p0_mod(p, lds, (float*)(p.ws + WS_MOD)); p0_convert(p, lds); }
  }
  SEAM(0);
  { MKP(p)
    if (PH(1) && IN(1)) phase_norm(p, 0, 0, true, false);
  }
  SEAM(1);
#define LAYER(LL) { \
    int l = (LL); asm volatile("" : "+s"(l)); \
    const int b = 2 + 9 * (LL); \
    { MKP(q) if (PH(2) && IN(b + 0)) for (int rep = 0; rep < REP_GEMM; ++rep) phase_inproj2(q, l, lds); } \
    SEAM(b + 0); \
    { MKP(q) if (PH(3) && IN(b + 1)) for (int rep = 0; rep < REP_ML; ++rep) phase_c1(q, l, lds); } \
    SEAM(b + 1); \
    { MKP(q) if (PH(4) && IN(b + 2)) phase_c2(q, l, lds); } \
    SEAM(b + 3); \
    { MKP(q) if (PH(6) && IN(b + 4)) phase_outproj2(q, l, lds); } \
    SEAM(b + 4); \
    { MKP(q) if (PH(7) && IN(b + 5)) for (int rep = 0; rep < REP_MISC; ++rep) phase_norm(q, l, 1, false, (LL) == DEPTH - 1); } \
    SEAM(b + 5); \
    { MKP(q) if (PH(8) && IN(b + 6)) for (int rep = 0; rep < REP_GEMM; ++rep) phase_peerq2(q, l, lds); } \
    SEAM(b + 6); \
    { MKP(q) if (PH(9) && IN(b + 7)) phase_route(q, l, lds); } \
    SEAM(b + 7); \
    { MKP(q) if (PH(9) && IN(b + 8)) phase_gather(q, l, lds); } \
    SEAM(b + 8); }
  LAYER(0) LAYER(1) LAYER(2) LAYER(3)
#undef LAYER
#undef IN
#undef SEAM
#undef MKP
}

extern "C" void kernel_launch(void* const* d_in, const int* in_sizes, int n_in, void* d_out, int out_size,
                              void* d_ws, size_t ws_size, hipStream_t stream) {
  static int grid = 0;
  if (grid == 0) {
    int dev = 0, cus = 0, per_cu = 0;
    (void)hipGetDevice(&dev);
    (void)hipDeviceGetAttribute(&cus, hipDeviceAttributeMultiprocessorCount, dev);
    (void)hipFuncSetAttribute((const void*)mk_fwd, hipFuncAttributeMaxDynamicSharedMemorySize, LDS_BYTES);
    (void)hipOccupancyMaxActiveBlocksPerMultiprocessor(&per_cu, (const void*)mk_fwd, 512, LDS_BYTES);
    fprintf(stderr, "kernel_launch: cus %d per_cu %d ws %zu (need %zu) n_in %d\n", cus, per_cu, ws_size, (size_t)WS_END, n_in);
    if (ws_size < WS_END || n_in != 23 || per_cu < 1) { fprintf(stderr, "kernel_launch: bad configuration, nothing launched\n"); grid = -1; return; }
    grid = cus;
  }
  if (grid < 0) return;
  (void)hipMemsetAsync((char*)d_ws + WS_CTL, 0, 65536, stream);
  KArgs p{};
  for (int i = 0; i < 23; ++i) p.in[i] = (const float*)d_in[i];
  p.out = (float*)d_out; p.ws = (unsigned char*)d_ws; p.ph_lo = 0; p.ph_hi = 38;
  void* args[] = {&p};
  hipError_t e = hipLaunchCooperativeKernel((const void*)mk_fwd, dim3(grid), dim3(512), args, LDS_BYTES, stream);
  if (e != hipSuccess) fprintf(stderr, "cooperative launch failed: %s (grid %d)\n", hipGetErrorString(e), grid);
}
```

```cpp
#include <hip/hip_runtime.h>
#include <hip/hip_cooperative_groups.h>
#include <cstdio>
#include <cstdint>
namespace cg = cooperative_groups;

constexpr int DM = 1024, NBATCH = 4, SEQ = 8192, CTXL = 256, SEGL = CTXL + SEQ, T = NBATCH * SEGL, DEPTH = 4;
constexpr int IN_W = 3088, PW = 3072;
constexpr int QK8_PITCH = 144; constexpr size_t QK8_IMG = (size_t)16 * SEGL * QK8_PITCH;
constexpr int C_A = 0, C_MQ = 512, C_MK = 768, C_MV = 1024, C_MO = 1280, C_DQ = 1536, C_DK = 2048, C_DV = 2560;
constexpr int NCH = SEGL / 64;
constexpr int NEXP = 16384;
constexpr float EPS = 1e-6f;
#ifndef ABL
#define ABL 0
#endif
#ifndef GATHER_SYNC
#define GATHER_SYNC 0
#endif
#ifndef REP_ATT
#define REP_ATT 1
#endif
#ifndef GP_MASK
#define GP_MASK 0x3FFF
#endif
#ifndef REP_PEER
#define REP_PEER 1
#endif
#ifndef REP_GEMM
#define REP_GEMM 1
#endif
#ifndef REP_ROUTE
#define REP_ROUTE 1
#endif
#ifndef REP_OUTP
#define REP_OUTP 1
#endif
#ifndef REP_ML
#define REP_ML 1
#endif
#ifndef REP_MISC
#define REP_MISC 1
#endif
constexpr float QSCALE = 0.125f * 1.4426950408889634f;

constexpr size_t MiB = 1u << 20;
constexpr size_t WS_CTL = 0, WS_MOD = 1 * MiB, WS_ROPE = 2 * MiB, WS_WG = 4 * MiB, WS_KEYS = 5 * MiB, WS_MLMETA = 6 * MiB,
                 WS_GATES = 7 * MiB, WS_WIN = 10 * MiB, WS_WOUT = 34 * MiB, WS_WQ = 42 * MiB, WS_PU = 50 * MiB, WS_PV = 114 * MiB, WS_PSC = 178 * MiB  ,
                 WS_XCUR = 306 * MiB, WS_H = 438 * MiB, WS_MIX = 504 * MiB, WS_PROJ = 570 * MiB, WS_ULOC = 768 * MiB, WS_V8T = 836 * MiB  , WS_EID = 858 * MiB  , WS_QK8 = 924 * MiB  , WS_END = 964 * MiB;
constexpr int USTRIDE = 4160;

constexpr int LDS_BYTES = 139264 + 512;
constexpr int LDS_WTAB = LDS_BYTES - 64 - 256;

#define LAS __attribute__((address_space(3)))
__device__ __forceinline__ int hw_wave_key() { return (int)(__builtin_amdgcn_s_getreg((5 << 11) | 4) & 63u); }
__device__ __forceinline__ int tidx() {
  extern __shared__ __attribute__((aligned(16))) unsigned char lds_dyn_[];
  const int w = __builtin_amdgcn_readfirstlane(*(const volatile LAS int*)((LAS unsigned char*)lds_dyn_ + LDS_WTAB + 4 * hw_wave_key()));
  unsigned z_ = 0u; asm volatile("" : "+v"(z_));
  return (w << 6) | (int)__builtin_amdgcn_mbcnt_hi(~0u, __builtin_amdgcn_mbcnt_lo(~0u, z_));
}
typedef unsigned short bf16_t;
typedef short bf16x8 __attribute__((ext_vector_type(8)));
typedef short s16x4 __attribute__((ext_vector_type(4)));
typedef float f32x4 __attribute__((ext_vector_type(4)));
typedef float f32x16 __attribute__((ext_vector_type(16)));
typedef unsigned u32x4 __attribute__((ext_vector_type(4)));
typedef unsigned u32x2 __attribute__((ext_vector_type(2)));
typedef __bf16 bf16x2v __attribute__((ext_vector_type(2)));
typedef int i32x8 __attribute__((ext_vector_type(8)));
typedef int i32x6 __attribute__((ext_vector_type(6)));
struct __attribute__((aligned(4))) u32x3 { unsigned x, y, z; };
typedef float f32x32 __attribute__((ext_vector_type(32)));
constexpr int PROW = 768;
typedef float f32x2 __attribute__((ext_vector_type(2)));
typedef _Float16 h16x2 __attribute__((ext_vector_type(2)));
typedef _Float16 h16x32 __attribute__((ext_vector_type(32)));
typedef unsigned u32x3v __attribute__((ext_vector_type(3)));
typedef unsigned u32x2v __attribute__((ext_vector_type(2)));

struct KArgs {
  const float* in[23];
  float* out;
  unsigned char* ws;
  int ph_lo, ph_hi;
};
typedef const float* const __attribute__((address_space(4))) * InTab;
struct Params {
  InTab in;
  float* out;
  unsigned char* ws;
  int ph_lo, ph_hi;
  int bx, gx;
  unsigned* xbar_words; unsigned xbar_x; unsigned lds_st_off;
};
enum { I_X = 0, I_C, I_CTX, I_CCTX, I_ADAW, I_ADAB, I_N1G, I_N2G, I_WIN, I_CONVW, I_CONVB, I_CLNG, I_CLNB, I_GATEB, I_MNORMG, I_DLAM, I_DNORMG,
       I_WOUT, I_PWQ, I_PKEYS, I_PU, I_PV, I_FINALG };

__device__ __forceinline__ unsigned cvtpk(float lo, float hi) { unsigned r; asm volatile("v_cvt_pk_bf16_f32 %0, %1, %2" : "=v"(r) : "v"(lo), "v"(hi)); return r; }
__device__ __forceinline__ float bflo(unsigned u) { return __uint_as_float(u << 16); }
__device__ __forceinline__ float bfhi(unsigned u) { return __uint_as_float(u & 0xffff0000u); }
__device__ __forceinline__ float bf1(bf16_t u) { return __uint_as_float(((unsigned)u) << 16); }
__device__ __forceinline__ int crow(int r, int hi) { return (r & 3) + 8 * (r >> 2) + 4 * hi; }
template <int CTRL> __device__ __forceinline__ float dpp_mov(float v) {
  return __uint_as_float((unsigned)__builtin_amdgcn_update_dpp(0, (int)__float_as_uint(v), CTRL, 0xF, 0xF, true));
}
__device__ __forceinline__ float wave_sum_fast(float x) {
  x += dpp_mov<0xB1>(x); x += dpp_mov<0x4E>(x); x += dpp_mov<0x141>(x); x += dpp_mov<0x140>(x);
  { auto r = __builtin_amdgcn_permlane16_swap(__float_as_uint(x), __float_as_uint(x), false, false); x = __uint_as_float(r[0]) + __uint_as_float(r[1]); }
  { auto r = __builtin_amdgcn_permlane32_swap(__float_as_uint(x), __float_as_uint(x), false, false); x = __uint_as_float(r[0]) + __uint_as_float(r[1]); }
  return x;
}
__device__ __forceinline__ float wave_max_fast(float x) {
  x = fmaxf(x, dpp_mov<0xB1>(x)); x = fmaxf(x, dpp_mov<0x4E>(x)); x = fmaxf(x, dpp_mov<0x141>(x)); x = fmaxf(x, dpp_mov<0x140>(x));
  { auto r = __builtin_amdgcn_permlane16_swap(__float_as_uint(x), __float_as_uint(x), false, false); x = fmaxf(__uint_as_float(r[0]), __uint_as_float(r[1])); }
  { auto r = __builtin_amdgcn_permlane32_swap(__float_as_uint(x), __float_as_uint(x), false, false); x = fmaxf(__uint_as_float(r[0]), __uint_as_float(r[1])); }
  return x;
}
template <int CTRL, int ROWMASK> __device__ __forceinline__ float dpp_mov_rm(float v) {
  return __uint_as_float((unsigned)__builtin_amdgcn_update_dpp(0, (int)__float_as_uint(v), CTRL, ROWMASK, 0xF, true));
}
__device__ __forceinline__ float wave_incl_scan(float x) {
  x += dpp_mov<0x111>(x); x += dpp_mov<0x112>(x); x += dpp_mov<0x114>(x); x += dpp_mov<0x118>(x);
  x += dpp_mov_rm<0x142, 0xA>(x);
  x += dpp_mov_rm<0x143, 0xC>(x);
  return x;
}
__device__ __forceinline__ float wave_sum(float v) { return wave_sum_fast(v); }
__device__ __forceinline__ float sum_xor32(float x) { auto r = __builtin_amdgcn_permlane32_swap(__float_as_uint(x), __float_as_uint(x), false, false); return __uint_as_float(r[0]) + __uint_as_float(r[1]); }
__device__ __forceinline__ float max_xor32(float x) { auto r = __builtin_amdgcn_permlane32_swap(__float_as_uint(x), __float_as_uint(x), false, false); return fmaxf(__uint_as_float(r[0]), __uint_as_float(r[1])); }
__device__ __forceinline__ float wave_max(float v) { return wave_max_fast(v); }
__device__ __forceinline__ float sigmoidf_(float x) { return 1.f / (1.f + __expf(-x)); }
__device__ __forceinline__ float logsigmoidf_(float x) { return fminf(x, 0.f) - log1pf(__expf(-fabsf(x))); }
__device__ __forceinline__ const float* in_row(const float* x, const float* ctx, int row) {
  const int b = row / SEGL, s = row - b * SEGL;
  return s < CTXL ? ctx + ((size_t)(b * CTXL + s)) * DM : x + ((size_t)(b * SEQ + (s - CTXL))) * DM;
}
__device__ __forceinline__ int mod_row(int row) { const int b = row / SEGL, s = row - b * SEGL; return s < CTXL ? 4 : b; }

__device__ __forceinline__ void p0_mod(const Params& p, unsigned char* lds, float* MOD) {
  float* sil = (float*)lds;
  float* red = (float*)(lds + 20480);
  int tid_ = tidx(); asm volatile("" : "+v"(tid_)); const int tid = tid_, lane = tid & 63, wid = tid >> 6;
  for (int i = tid; i < 5 * 1024; i += 512) {
    const float v = i < 4096 ? p.in[I_C][i] : p.in[I_CCTX][i - 4096];
    sil[i] = v / (1.f + __expf(-v));
  }
  __syncthreads();
  for (int item = p.bx; item < DEPTH * 96; item += p.gx) {
    const int l = item / 96, j0 = (item % 96) * 64;
    const float* W = p.in[I_ADAW] + (size_t)l * DM * 6144 + j0 + lane;
    float a0 = 0.f, a1 = 0.f, a2 = 0.f, a3 = 0.f, a4 = 0.f;
    const int k0 = wid * 128;
#pragma unroll 8
    for (int k = k0; k < k0 + 128; ++k) {
      const float w = W[(size_t)k * 6144];
      a0 += sil[k] * w; a1 += sil[1024 + k] * w; a2 += sil[2048 + k] * w; a3 += sil[3072 + k] * w; a4 += sil[4096 + k] * w;
    }
    red[(wid * 5 + 0) * 64 + lane] = a0; red[(wid * 5 + 1) * 64 + lane] = a1; red[(wid * 5 + 2) * 64 + lane] = a2;
    red[(wid * 5 + 3) * 64 + lane] = a3; red[(wid * 5 + 4) * 64 + lane] = a4;
    __syncthreads();
    if (tid < 320) {
      const int r = tid >> 6;
      float s = 0.f;
#pragma unroll
      for (int w = 0; w < 8; ++w) s += red[(w * 5 + r) * 64 + lane];
      MOD[((size_t)l * 5 + r) * 6144 + j0 + lane] = s + p.in[I_ADAB][l * 6144 + j0 + lane];
    }
    __syncthreads();
  }
}
__device__ __forceinline__ void transpose_item(const float* W, int ldw, int srccol0, bf16_t* WT, int K, int n0, int k0, float* scr, int lane) {
#pragma unroll 8
  for (int i = 0; i < 32; ++i) { const int kk = 2 * i + (lane >> 5); scr[kk * 33 + (lane & 31)] = W[(size_t)(k0 + kk) * ldw + srccol0 + (lane & 31)]; }
  asm volatile("s_waitcnt lgkmcnt(0)" ::: "memory");
  const int c = lane & 7;
#pragma unroll
  for (int j = 0; j < 4; ++j) {
    const int n = (lane >> 3) + 8 * j; const float* s = scr + (8 * c) * 33 + n;
    u32x4 o; o.x = cvtpk(s[0], s[33]); o.y = cvtpk(s[66], s[99]); o.z = cvtpk(s[132], s[165]); o.w = cvtpk(s[198], s[231]);
    *(u32x4*)(WT + (size_t)(n0 + n) * K + k0 + 8 * c) = o;
  }
  asm volatile("s_waitcnt lgkmcnt(0)" ::: "memory");
}
__device__ __forceinline__ void convert_tables(const Params& p, int L, int wv, int nw, int lane, int r_lo, int r_hi) {
  unsigned char* PUq = p.ws + WS_PU; unsigned char* PVq = p.ws + WS_PV; float* PSC = (float*)(p.ws + WS_PSC);
  const int nrows = DEPTH * NEXP;
#define TAB_SROW(r_) ((const f32x4*)(((r_) >= NEXP ? p.in[I_PV] : p.in[I_PU]) + (size_t)(L * NEXP + ((r_) >= NEXP ? (r_) - NEXP : (r_))) * DM) + lane * 4)
#define TAB_LOAD(v_, r_) do { if ((r_) < r_hi) { const f32x4* s_ = TAB_SROW(r_); _Pragma("unroll") for (int j = 0; j < 4; ++j) v_[j] = __builtin_nontemporal_load(s_ + j); } } while (0)
  auto encode_row = [&](const f32x4 (&v)[4], int r) {
    const int tb = r >= NEXP, rr = L * NEXP + (tb ? r - NEXP : r);
    float mx = 0.f;
#pragma unroll
    for (int j = 0; j < 4; ++j) mx = fmaxf(mx, fmaxf(fmaxf(fabsf(v[j].x), fabsf(v[j].y)), fmaxf(fabsf(v[j].z), fabsf(v[j].w))));
    mx = wave_max_fast(mx);
    const unsigned mb = __float_as_uint(mx);
    const int eb = (int)((mb >> 23) & 0xFFu);
    int sb = ((mb & 0x7FFFFFu) <= 0x700000u ? 129 : 128) - eb + 127; sb = sb < 1 ? 1 : (sb > 253 ? 253 : sb);
    const float sc = __uint_as_float((unsigned)sb << 23), isc = __uint_as_float((unsigned)(254 - sb) << 23);
    const float xv[16] = {v[0].x, v[0].y, v[0].z, v[0].w, v[1].x, v[1].y, v[1].z, v[1].w, v[2].x, v[2].y, v[2].z, v[2].w, v[3].x, v[3].y, v[3].z, v[3].w};
    unsigned wq[3] = {0u, 0u, 0u};
#pragma unroll
    for (int i = 0; i < 16; ++i) {
      const float a = fabsf(xv[i]) * sc;
      unsigned code = a < 2.f ? (unsigned)__builtin_rintf(a * 8.f) : (a < 4.f ? 8u + (unsigned)__builtin_rintf(a * 4.f) : 16u + (unsigned)__builtin_rintf(a * 2.f));
      code = code > 31u ? 31u : code;
      code |= (xv[i] < 0.f) ? 32u : 0u;
      const int bp = 6 * i, dw = bp >> 5, off = bp & 31;
      wq[dw] |= code << off;
      if (off > 26) wq[dw + 1] |= code >> (32 - off);
    }
    u32x3 o; o.x = wq[0]; o.y = wq[1]; o.z = wq[2];
    *(u32x3*)((tb ? PVq : PUq) + (size_t)rr * PROW + lane * 12) = o;
    if (lane == 0) PSC[(size_t)tb * nrows + rr] = isc;
  };
  f32x4 v0[4], v1[4], v2[4];
  TAB_LOAD(v0, r_lo + wv); TAB_LOAD(v1, r_lo + wv + nw);
#pragma unroll 1
  for (int r = r_lo + wv; r < r_hi; r += 3 * nw) {
    TAB_LOAD(v2, r + 2 * nw); encode_row(v0, r);
    if (r + nw < r_hi) { TAB_LOAD(v0, r + 3 * nw); encode_row(v1, r + nw); }
    if (r + 2 * nw < r_hi) { TAB_LOAD(v1, r + 4 * nw); encode_row(v2, r + 2 * nw); }
  }
#undef TAB_LOAD
#undef TAB_SROW
}
__device__ __forceinline__ void tail_filler_tables(const Params& p, int L, int nwg, int r_lo, int r_hi) {
  int tid_ = tidx(); asm volatile("" : "+v"(tid_)); const int lane = tid_ & 63, wid = tid_ >> 6;
  const int nextra = nwg % p.gx, first = nextra, nidle = p.gx - nextra;
  if (p.bx < first) return;
  convert_tables(p, L, (p.bx - first) * 8 + wid, nidle * 8, lane, r_lo, r_hi);
}
__device__ __forceinline__ void p0_convert(const Params& p, unsigned char* lds) {
  int tid_ = tidx(); asm volatile("" : "+v"(tid_)); const int tid = tid_, lane = tid & 63, wid = tid >> 6;
  const int gw = p.bx * 8 + wid, NGW = p.gx * 8;
  const size_t gt = (size_t)p.bx * 512 + tid, NGT = (size_t)p.gx * 512;
  float* scr = (float*)(lds + 32768) + wid * (64 * 33);
  bf16_t* WIN = (bf16_t*)(p.ws + WS_WIN); bf16_t* WOUT = (bf16_t*)(p.ws + WS_WOUT); bf16_t* WQ = (bf16_t*)(p.ws + WS_WQ);
  constexpr int I_IN = 16 * 96, I_O = 16 * 32, PER_L = I_IN + 2 * I_O;
  for (int it = gw; it < DEPTH * PER_L; it += NGW) {
    const int l = it / PER_L; int r = it % PER_L;
    if (r < I_IN) { const int kb = r / 96, nb = r % 96, n0 = nb * 32; const int src = n0 < 1536 ? n0 : n0 + 16;
      transpose_item(p.in[I_WIN] + (size_t)l * DM * IN_W, IN_W, src, WIN + (size_t)l * PW * DM, DM, n0, kb * 64, scr, lane); continue; }
    r -= I_IN;
    if (r < I_O) { const int kb = r / 32, nb = r % 32;
      transpose_item(p.in[I_WOUT] + (size_t)l * DM * DM, DM, nb * 32, WOUT + (size_t)l * DM * DM, DM, nb * 32, kb * 64, scr, lane); continue; }
    r -= I_O;
    { const int kb = r / 32, nb = r % 32;
      transpose_item(p.in[I_PWQ] + (size_t)l * DM * DM, DM, nb * 32, WQ + (size_t)l * DM * DM, DM, nb * 32, kb * 64, scr, lane); }
  }
  bf16_t* WG = (bf16_t*)(p.ws + WS_WG);
  for (size_t i = gt; i < (size_t)DEPTH * 16 * DM; i += NGT) {
    const int l = (int)(i / (16 * DM)), g = (int)((i / DM) % 16), k = (int)(i % DM);
    WG[i] = (bf16_t)(cvtpk(p.in[I_WIN][(size_t)l * DM * IN_W + (size_t)k * IN_W + 1536 + g], 0.f) & 0xffffu);
  }
  bf16_t* KEYS = (bf16_t*)(p.ws + WS_KEYS);
  for (size_t i = gt; i < (size_t)DEPTH * 131072 / 8; i += NGT) {
    const f32x4 a = ((const f32x4*)p.in[I_PKEYS])[2 * i], b = ((const f32x4*)p.in[I_PKEYS])[2 * i + 1];
    u32x4 o; o.x = cvtpk(a.x, a.y); o.y = cvtpk(a.z, a.w); o.z = cvtpk(b.x, b.y); o.w = cvtpk(b.z, b.w);
    ((u32x4*)KEYS)[i] = o;
  }
  {
    float* RC = (float*)(p.ws + WS_ROPE); float* RS = RC + SEQ * 32;
    for (size_t i = gt; i < (size_t)SEQ * 32; i += NGT) {
      const int pos = (int)(i >> 5), j = (int)(i & 31);
      const int rr = pos >> 6, cc = pos & 63;
      const int jj = j & 15;
      const double e = -(double)jj * 0.83048202372184058696;
      const double fl = __builtin_floor(e); const double f = e - fl;
      const double z = f * 0.69314718055994530942;
      double ez = 1.0 + z * (1.0 + z * (0.5 + z * (1.0 / 6 + z * (1.0 / 24 + z * (1.0 / 120 + z * (1.0 / 720 + z * (1.0 / 5040 + z * (1.0 / 40320 + z * (1.0 / 362880 + z * (1.0 / 3628800 + z * (1.0 / 39916800 + z * (1.0 / 479001600))))))))))));
      const double inv = __builtin_ldexp(ez, (int)fl);
      const float invf = (float)inv;
      const float angf = (float)(j < 16 ? rr : cc) * invf;
      const double ang = (double)angf;
      const double kq = __builtin_rint(ang * 0.63661977236758134308);
      double r = __builtin_fma(-kq, 1.57079632679489655800e+00, ang);
      r = __builtin_fma(-kq, 6.12323399573676603587e-17, r);
      const double r2 = r * r;
      const double sn = r * (1.0 + r2 * (-1.0 / 6 + r2 * (1.0 / 120 + r2 * (-1.0 / 5040 + r2 * (1.0 / 362880 + r2 * (-1.0 / 39916800 + r2 * (1.0 / 6227020800.0)))))));
      const double cs = 1.0 + r2 * (-0.5 + r2 * (1.0 / 24 + r2 * (-1.0 / 720 + r2 * (1.0 / 40320 + r2 * (-1.0 / 3628800 + r2 * (1.0 / 479001600 + r2 * (-1.0 / 87178291200.0)))))));
      const int q = ((int)kq) & 3;
      double co, si;
      if (q == 0) { co = cs; si = sn; } else if (q == 1) { co = -sn; si = cs; } else if (q == 2) { co = -cs; si = -sn; } else { co = sn; si = -cs; }
      RC[i] = (float)co; RS[i] = (float)si;
    }
  }
}

__device__ __forceinline__ void norm_mod_row(const float* xrow, const float* g, const float* sc, const float* sh, bf16_t* orow, int lane) {
  const f32x4* xr = (const f32x4*)xrow + lane;
  f32x4 v[4]; float s = 0.f;
#pragma unroll
  for (int j = 0; j < 4; ++j) { v[j] = xr[64 * j]; s += (v[j].x * v[j].x + v[j].y * v[j].y) + (v[j].z * v[j].z + v[j].w * v[j].w); }
  const float rs = rsqrtf(wave_sum(s) * (1.f / DM) + EPS);
  u32x2* o = (u32x2*)orow + lane;
#pragma unroll
  for (int j = 0; j < 4; ++j) {
    const f32x4 gg = ((const f32x4*)g)[lane + 64 * j], cc = ((const f32x4*)sc)[lane + 64 * j], hh = ((const f32x4*)sh)[lane + 64 * j];
    const float y0 = v[j].x * rs * gg.x * (1.f + cc.x) + hh.x, y1 = v[j].y * rs * gg.y * (1.f + cc.y) + hh.y;
    const float y2 = v[j].z * rs * gg.z * (1.f + cc.z) + hh.z, y3 = v[j].w * rs * gg.w * (1.f + cc.w) + hh.w;
    u32x2 w; w.x = cvtpk(y0, y1); w.y = cvtpk(y2, y3);
    o[64 * j] = w;
  }
}
__device__ __forceinline__ void phase_norm(const Params& p, int l, int which, bool from_input, bool skip_ctx) {
  int tid_ = tidx(); asm volatile("" : "+v"(tid_));
  const int lane = tid_ & 63, wid = tid_ >> 6;
  const int gw = p.bx * 8 + wid, NGW = p.gx * 8;
  const float* MOD = (const float*)(p.ws + WS_MOD);
  const float* XC = (const float*)(p.ws + WS_XCUR);
  bf16_t* H = (bf16_t*)(p.ws + WS_H);
  const float* g = p.in[which ? I_N2G : I_N1G] + l * DM;
  auto next_row = [&](int r_) { while (r_ < T && skip_ctx && mod_row(r_) == 4) r_ += NGW; return r_; };
  auto xrow_of = [&](int r_) { return (const f32x4*)(from_input ? in_row(p.in[I_X], p.in[I_CTX], r_) : XC + (size_t)r_ * DM) + lane; };
  f32x4 gg[4], cc[4], hh[4], v[4], vn[4];
#pragma unroll
  for (int j = 0; j < 4; ++j) gg[j] = ((const f32x4*)g)[lane + 64 * j];
  int mr_cur = -1;
  int row = next_row(gw);
  if (row < T) { const f32x4* xr = xrow_of(row);
#pragma unroll
    for (int j = 0; j < 4; ++j) v[j] = xr[64 * j]; }
  while (row < T) {
    const int nrow = next_row(row + NGW);
    if (nrow < T) { const f32x4* xn = xrow_of(nrow);
#pragma unroll
      for (int j = 0; j < 4; ++j) vn[j] = xn[64 * j]; }
    const int mr = mod_row(row);
    if (mr != mr_cur) {
      const float* m = MOD + ((size_t)l * 5 + mr) * 6144 + which * 3072;
#pragma unroll
      for (int j = 0; j < 4; ++j) { cc[j] = ((const f32x4*)(m + 1024))[lane + 64 * j]; hh[j] = ((const f32x4*)m)[lane + 64 * j]; }
      mr_cur = mr;
    }
    float s = 0.f;
#pragma unroll
    for (int j = 0; j < 4; ++j) s += (v[j].x * v[j].x + v[j].y * v[j].y) + (v[j].z * v[j].z + v[j].w * v[j].w);
    const float rs = rsqrtf(wave_sum(s) * (1.f / DM) + EPS);
    u32x2* o = (u32x2*)(H + (size_t)row * DM) + lane;
#pragma unroll
    for (int j = 0; j < 4; ++j) {
      const float y0 = v[j].x * rs * gg[j].x * (1.f + cc[j].x) + hh[j].x, y1 = v[j].y * rs * gg[j].y * (1.f + cc[j].y) + hh[j].y;
      const float y2 = v[j].z * rs * gg[j].z * (1.f + cc[j].z) + hh[j].z, y3 = v[j].w * rs * gg[j].w * (1.f + cc[j].w) + hh[j].w;
      u32x2 w; w.x = cvtpk(y0, y1); w.y = cvtpk(y2, y3);
      o[64 * j] = w;
    }
#pragma unroll
    for (int j = 0; j < 4; ++j) v[j] = vn[j];
    row = nrow;
  }
}

namespace pg8 {
#define PG8_LAS __attribute__((address_space(3)))
typedef unsigned short bf16_t;
typedef short bf16x8 __attribute__((ext_vector_type(8)));
typedef float f32x4 __attribute__((ext_vector_type(4)));
typedef unsigned u32x4 __attribute__((ext_vector_type(4)));
constexpr int BM = 256, BK = 64, HALF = 128, HTB = HALF * BK * 2  , STAGE_BYTES = 8 * HTB, NXCD = 8, WGM = 8;

__host__ __device__ __forceinline__ int lds_byte(int r, int c) { const int st = (r >> 4) * 2 + (c >> 5), rr = r & 15, cc = c & 31, ob = rr * 64 + cc * 2; return st * 1024 + (ob ^ (((ob >> 9) & 1) << 5)); }
__host__ __device__ __forceinline__ void stage_rc(int b, int& R, int& C) { const int st = b / 1024, sb = b % 1024, swz = sb ^ (((sb >> 9) & 1) << 5); R = (st >> 1) * 16 + swz / 64; C = (st & 1) * 32 + (swz % 64) / 2; }
__host__ __device__ __forceinline__ int perm32(int rho) { const int n = rho >> 4, i = rho & 15; return 8 * (i >> 2) + 4 * n + (i & 3); }

struct Unit { int pm, pn; };
struct Gemm { const bf16_t* A; const bf16_t* Bt; int M, N, K; };

struct StaticOrder {
    int nM, nN, nwg, G, c;
    __host__ __device__ void init(int M, int N, int G_, int c_) { nM = M / BM; nN = N / BM; nwg = nM * nN; G = G_; c = c_; }
    __host__ __device__ bool next(int i, Unit& u) const {
        const long L = (long)i * G + c; if (L >= nwg) return false;
        int wgid = (int)L; { const int q = nwg / NXCD, r = nwg % NXCD, xcd = wgid % NXCD, off = wgid / NXCD; wgid = (xcd < r ? xcd * (q + 1) : r * (q + 1) + (xcd - r) * q) + off; }
        const int nig = WGM * nN, gid = wgid / nig, fm = gid * WGM, gsz = (nM - fm) < WGM ? (nM - fm) : WGM;
        u.pm = fm + ((wgid % nig) % gsz); u.pn = (wgid % nig) / gsz; return true;
    }
    __device__ __forceinline__ void a_ready(const Unit&) const {}
    __device__ __forceinline__ void done(const Unit&) const {}
};
__device__ __forceinline__ unsigned cvt_pk_bf16(float lo, float hi) { unsigned r; asm volatile("v_cvt_pk_bf16_f32 %0, %1, %2" : "=v"(r) : "v"(lo), "v"(hi)); return r; }
template <class Epi, class Sched, bool ALIGN_EPI = false, bool SP2 = false>
__device__ __forceinline__ void gemm_phase(PG8_LAS unsigned char* lds, const Gemm g, const Sched& S, const Epi& E) {
    const int tid = tidx(), wid = __builtin_amdgcn_readfirstlane(tid >> 6), lane = tid & 63, wr = wid >> 2, wc = wid & 3, fr = lane & 15, fq = lane >> 4;
    const int K = g.K, nt = K / BK;
    unsigned voffA[2], voffB[2];
#pragma unroll
    for (int i = 0; i < 2; ++i) { int R, C; stage_rc(tid * 16 + i * 8192, R, C); const int Rb = Epi::PERM ? ((R & ~31) + perm32(R & 31)) : R;
        voffA[i] = (unsigned)(R * K + C) * 2u; voffB[i] = (unsigned)(Rb * K + C) * 2u; }
    const size_t kstep = (size_t)(BK * 2);
    const size_t hstep = (size_t)HALF * K * 2;
    const size_t tstep = 2 * hstep;
    const unsigned ldsw = (unsigned)wid * 1024u;
    const int aoff = lds_byte(wr * 64 + fr, fq * 8), boff = lds_byte(wc * 32 + fr, fq * 8);
#define PG8_SA(b, h) (((b) * 2 + (h)) * HTB)
#define PG8_SB(b, h) ((4 + (b) * 2 + (h)) * HTB)
#define PG8_STAGE(bufoff, gbase, voff) do { _Pragma("unroll") for (int _i = 0; _i < 2; ++_i) \
        __builtin_amdgcn_global_load_lds((const unsigned*)((const char*)(gbase) + (voff)[_i]), (PG8_LAS unsigned*)(lds + (bufoff) + ldsw + _i * 8192), 16, 0, 0); } while (0)
#define PG8_LDA(dst, b, h) do { _Pragma("unroll") for (int m = 0; m < 4; ++m) _Pragma("unroll") for (int k = 0; k < 2; ++k) dst[m][k] = *(const PG8_LAS bf16x8*)(lds + PG8_SA(b, h) + aoff + m * 2048 + k * 1024); } while (0)
#define PG8_LDB(dst, b, h) do { _Pragma("unroll") for (int n = 0; n < 2; ++n) _Pragma("unroll") for (int k = 0; k < 2; ++k) dst[n][k] = *(const PG8_LAS bf16x8*)(lds + PG8_SB(b, h) + boff + n * 2048 + k * 1024); } while (0)
#define PG8_MMA(ai, bj, At, Bt) do { __builtin_amdgcn_s_setprio(1); _Pragma("unroll") for (int m = 0; m < 4; ++m) _Pragma("unroll") for (int n = 0; n < 2; ++n) _Pragma("unroll") for (int k = 0; k < 2; ++k) \
        acc[ai][bj][m][n] = __builtin_amdgcn_mfma_f32_16x16x32_bf16(Bt[n][k], At[m][k], acc[ai][bj][m][n], 0, 0, 0); __builtin_amdgcn_s_setprio(0); } while (0)
#define PG8_WAIT_V(n) asm volatile("s_waitcnt vmcnt(" #n ")" ::: "memory")
#define PG8_WAIT_L(n) asm volatile("s_waitcnt lgkmcnt(" #n ")" ::: "memory")
#define PG8_BAR __builtin_amdgcn_s_barrier()
#define PG8_SCHED __builtin_amdgcn_sched_barrier(0)
    Unit cur, nxt; int ui = 0;
    if (!S.next(0, cur)) return;
    f32x4 acc[2][2][4][2];
#pragma unroll
    for (int a = 0; a < 2; ++a)
#pragma unroll
        for (int b = 0; b < 2; ++b)
#pragma unroll
            for (int m = 0; m < 4; ++m)
#pragma unroll
                for (int n = 0; n < 2; ++n) acc[a][b][m][n] = (f32x4){0.f, 0.f, 0.f, 0.f};
    bf16x8 At[4][2], B0[2][2], B1[2][2];
    const char* cA = (const char*)g.A + (size_t)cur.pm * tstep; const char* cB = (const char*)g.Bt + (size_t)cur.pn * tstep;
    S.a_ready(cur);
    if constexpr (SP2) {
        PG8_STAGE(PG8_SB(0, 0), cB, voffB); PG8_STAGE(PG8_SB(0, 1), cB + hstep, voffB); PG8_STAGE(PG8_SA(0, 0), cA, voffA); PG8_STAGE(PG8_SA(0, 1), cA + hstep, voffA);
        if (wr == 1) PG8_BAR;
        PG8_WAIT_V(2); PG8_BAR;
        PG8_STAGE(PG8_SB(1, 0), cB + kstep, voffB); PG8_STAGE(PG8_SA(1, 0), cA + kstep, voffA); PG8_STAGE(PG8_SB(1, 1), cB + hstep + kstep, voffB);
        PG8_WAIT_V(6); PG8_BAR;
    } else {
        PG8_STAGE(PG8_SB(0, 0), cB, voffB); PG8_STAGE(PG8_SA(0, 0), cA, voffA); PG8_STAGE(PG8_SB(0, 1), cB + hstep, voffB); PG8_STAGE(PG8_SA(0, 1), cA + hstep, voffA);
        if (wr == 1) PG8_BAR;
        PG8_WAIT_V(4); PG8_BAR;
        PG8_STAGE(PG8_SB(1, 0), cB + kstep, voffB); PG8_STAGE(PG8_SA(1, 0), cA + kstep, voffA); PG8_STAGE(PG8_SB(1, 1), cB + hstep + kstep, voffB);
        PG8_WAIT_V(6); PG8_BAR;
    }
    for (;;) {
        const bool has_next = S.next(ui + 1, nxt);
        const char* nA = has_next ? (const char*)g.A + (size_t)nxt.pm * tstep : cA; const char* nB = has_next ? (const char*)g.Bt + (size_t)nxt.pn * tstep : cB;
        for (int t = 0; t < nt; t += 2) {
            const bool last = (t == nt - 2);
            const char* a1 = cA + (size_t)(t + 1) * kstep;
            const char* a2 = last ? nA : cA + (size_t)(t + 2) * kstep; const char* b2 = last ? nB : cB + (size_t)(t + 2) * kstep;
            const char* a3 = a2 + kstep; const char* b3 = b2 + kstep;
            if (last && has_next) S.a_ready(nxt);
            if constexpr (SP2) {
            PG8_LDB(B0, 0, 0); PG8_LDB(B1, 0, 1); PG8_SCHED; PG8_LDA(At, 0, 0); PG8_STAGE(PG8_SA(1, 1), a1 + hstep, voffA);
            PG8_WAIT_V(8); PG8_WAIT_L(0); PG8_BAR; PG8_MMA(0, 0, At, B0); PG8_MMA(0, 1, At, B1); PG8_BAR; PG8_SCHED;
            PG8_LDA(At, 0, 1); PG8_STAGE(PG8_SB(0, 0), b2, voffB); PG8_STAGE(PG8_SB(0, 1), b2 + hstep, voffB); PG8_STAGE(PG8_SA(0, 0), a2, voffA);
            PG8_WAIT_V(8); PG8_WAIT_L(0); PG8_BAR; PG8_MMA(1, 0, At, B0); PG8_MMA(1, 1, At, B1); PG8_BAR; PG8_SCHED;
            PG8_LDB(B0, 1, 0); PG8_LDB(B1, 1, 1); PG8_SCHED; PG8_LDA(At, 1, 0); PG8_STAGE(PG8_SA(0, 1), a2 + hstep, voffA);
            PG8_WAIT_V(8); PG8_WAIT_L(0); PG8_BAR; PG8_MMA(0, 0, At, B0); PG8_MMA(0, 1, At, B1); PG8_BAR; PG8_SCHED;
            PG8_LDA(At, 1, 1); PG8_STAGE(PG8_SB(1, 0), b3, voffB); PG8_STAGE(PG8_SB(1, 1), b3 + hstep, voffB); PG8_STAGE(PG8_SA(1, 0), a3, voffA);
            PG8_WAIT_V(8); PG8_WAIT_L(0); PG8_BAR; PG8_MMA(1, 0, At, B0); PG8_MMA(1, 1, At, B1); PG8_BAR; PG8_SCHED;
            } else {
            PG8_LDB(B0, 0, 0); PG8_SCHED; PG8_LDA(At, 0, 0); PG8_STAGE(PG8_SA(1, 1), a1 + hstep, voffA);
            PG8_WAIT_L(8); PG8_BAR; PG8_WAIT_L(0); PG8_MMA(0, 0, At, B0); PG8_BAR; PG8_SCHED;
            PG8_LDB(B1, 0, 1); PG8_STAGE(PG8_SB(0, 0), b2, voffB);
            PG8_BAR; PG8_WAIT_L(0); PG8_MMA(0, 1, At, B1); PG8_BAR;
            PG8_LDA(At, 0, 1); PG8_STAGE(PG8_SA(0, 0), a2, voffA);
            PG8_BAR; PG8_WAIT_L(0); PG8_MMA(1, 0, At, B0); PG8_BAR; PG8_SCHED;
            PG8_STAGE(PG8_SB(0, 1), b2 + hstep, voffB);
            PG8_WAIT_V(6); PG8_BAR; PG8_MMA(1, 1, At, B1); PG8_BAR;
            PG8_LDB(B0, 1, 0); PG8_SCHED; PG8_LDA(At, 1, 0); PG8_STAGE(PG8_SA(0, 1), a2 + hstep, voffA);
            PG8_WAIT_L(8); PG8_BAR; PG8_WAIT_L(0); PG8_MMA(0, 0, At, B0); PG8_BAR; PG8_SCHED;
            PG8_LDB(B1, 1, 1); PG8_STAGE(PG8_SB(1, 0), b3, voffB);
            PG8_BAR; PG8_WAIT_L(0); PG8_MMA(0, 1, At, B1); PG8_BAR;
            PG8_LDA(At, 1, 1); PG8_STAGE(PG8_SA(1, 0), a3, voffA);
            PG8_BAR; PG8_WAIT_L(0); PG8_MMA(1, 0, At, B0); PG8_BAR; PG8_SCHED;
            PG8_STAGE(PG8_SB(1, 1), b3 + hstep, voffB);
            PG8_WAIT_V(6); PG8_BAR; PG8_MMA(1, 1, At, B1); PG8_BAR;
            }
        }
        if constexpr (ALIGN_EPI) { if (wr == 0) PG8_BAR; }
        if constexpr (!Epi::AFTER_DRAIN) { E(acc, cur, wr, wc, fr, fq); S.done(cur); }
        if (!has_next) break;
#pragma unroll
        for (int a = 0; a < 2; ++a)
#pragma unroll
            for (int b = 0; b < 2; ++b)
#pragma unroll
                for (int m = 0; m < 4; ++m)
#pragma unroll
                    for (int n = 0; n < 2; ++n) acc[a][b][m][n] = (f32x4){0.f, 0.f, 0.f, 0.f};
        cur = nxt; cA = nA; cB = nB; ++ui;
        if constexpr (ALIGN_EPI) { if (wr == 1) PG8_BAR; }
    }
    PG8_WAIT_V(0);
    if constexpr (!ALIGN_EPI) { if (wr == 0) PG8_BAR; }
    PG8_BAR;
    if constexpr (Epi::AFTER_DRAIN) { E.fused(acc, cur, wr, wc, fr, fq, lds, wid, lane); S.done(cur); }
#undef PG8_SA
#undef PG8_SB
#undef PG8_STAGE
#undef PG8_LDA
#undef PG8_LDB
#undef PG8_MMA
#undef PG8_WAIT_V
#undef PG8_WAIT_L
#undef PG8_BAR
#undef PG8_SCHED
}
}

__device__ __forceinline__ int gswz(int row, int chunk) { return row * 128 + ((chunk ^ ((row >> 1) & 7)) << 4); }
__device__ __forceinline__ void gemm_tile(const bf16_t* __restrict__ A, int lda, const bf16_t* __restrict__ Bt, int ldb, int K,
                                          int row0, int col0, unsigned char* lds, f32x16 (&acc)[2][2]) {
  int tid_ = tidx(); asm volatile("" : "+v"(tid_)); const int tid = tid_, lane = tid & 63, wid = tid >> 6, wm = wid >> 1, wn = wid & 1, r32 = lane & 31, hi = lane >> 5;
  unsigned char* As = lds; unsigned char* Bs = lds + 65536;
#pragma unroll
  for (int i = 0; i < 2; ++i)
#pragma unroll
    for (int j = 0; j < 2; ++j) acc[i][j] = f32x16{};
  const int lrow = tid >> 3, lc = tid & 7;
  const bf16_t* Ag = A + (size_t)(row0 + lrow) * lda + lc * 8;
  const bf16_t* Bg = Bt + (size_t)(col0 + lrow) * ldb + lc * 8;
  u32x4 ra[4], rb[2];
#pragma unroll
  for (int i = 0; i < 4; ++i) ra[i] = *(const u32x4*)(Ag + (size_t)(64 * i) * lda);
#pragma unroll
  for (int i = 0; i < 2; ++i) rb[i] = *(const u32x4*)(Bg + (size_t)(64 * i) * ldb);
#pragma unroll
  for (int i = 0; i < 4; ++i) *(u32x4*)(As + gswz(lrow + 64 * i, lc)) = ra[i];
#pragma unroll
  for (int i = 0; i < 2; ++i) *(u32x4*)(Bs + gswz(lrow + 64 * i, lc)) = rb[i];
  __syncthreads();
  const int nk = K / 64;
  for (int kt = 0; kt < nk; ++kt) {
    const int cur = kt & 1;
    if (kt + 1 < nk) {
#pragma unroll
      for (int i = 0; i < 4; ++i) ra[i] = *(const u32x4*)(Ag + (size_t)(64 * i) * lda + (kt + 1) * 64);
#pragma unroll
      for (int i = 0; i < 2; ++i) rb[i] = *(const u32x4*)(Bg + (size_t)(64 * i) * ldb + (kt + 1) * 64);
    }
    const unsigned char* Ac = As + cur * 32768; const unsigned char* Bc = Bs + cur * 16384;
#pragma unroll
    for (int kk = 0; kk < 4; ++kk) {
      bf16x8 af[2], bfr[2];
#pragma unroll
      for (int i = 0; i < 2; ++i) af[i] = *(const bf16x8*)(Ac + gswz(wm * 64 + i * 32 + r32, 2 * kk + hi));
#pragma unroll
      for (int j = 0; j < 2; ++j) bfr[j] = *(const bf16x8*)(Bc + gswz(wn * 64 + j * 32 + r32, 2 * kk + hi));
#pragma unroll
      for (int i = 0; i < 2; ++i)
#pragma unroll
        for (int j = 0; j < 2; ++j) acc[i][j] = __builtin_amdgcn_mfma_f32_32x32x16_bf16(af[i], bfr[j], acc[i][j], 0, 0, 0);
    }
    if (kt + 1 < nk) {
      unsigned char* An = As + (cur ^ 1) * 32768; unsigned char* Bn = Bs + (cur ^ 1) * 16384;
#pragma unroll
      for (int i = 0; i < 4; ++i) *(u32x4*)(An + gswz(lrow + 64 * i, lc)) = ra[i];
#pragma unroll
      for (int i = 0; i < 2; ++i) *(u32x4*)(Bn + gswz(lrow + 64 * i, lc)) = rb[i];
    }
    __syncthreads();
  }
}
__device__ __forceinline__ void pair_xchg(float v0, float v1, int lane, float& lo, float& hi2) {
  const bool odd = lane & 1;
  const float send = odd ? v0 : v1;
  const float recv = dpp_mov<0xB1>(send);
  lo = odd ? recv : v0; hi2 = odd ? v1 : recv;
}

__device__ __forceinline__ void phase_inproj(const Params& p, int l, unsigned char* lds) {
  int tid_ = tidx(); asm volatile("" : "+v"(tid_)); const int tid = tid_, lane = tid & 63, wid = tid >> 6, wm = wid >> 1, wn = wid & 1, r32 = lane & 31, hi = lane >> 5;
  const bf16_t* H = (const bf16_t*)(p.ws + WS_H);
  const bf16_t* W = (const bf16_t*)(p.ws + WS_WIN) + (size_t)l * PW * DM;
  bf16_t* PROJ = (bf16_t*)(p.ws + WS_PROJ);
  const float* RC = (const float*)(p.ws + WS_ROPE); const float* RS = RC + SEQ * 32;
  constexpr int NM = T / 256, NN = PW / 128, NU = NM * NN;
  for (int u = p.bx; u < NU + NM; u += p.gx) {
    if (u < NU) {
      const int pn = u / NM, pm = u % NM;
      const int row0 = pm * 256, col0 = pn * 128;
      f32x16 acc[2][2];
      gemm_tile(H, DM, W, DM, DM, row0, col0, lds, acc);
      const bool rope = (col0 >= C_DQ && col0 < C_DV);
      const float scl = (col0 >= C_MK && col0 < C_MV) ? 0.125f : ((col0 >= C_DQ && col0 < C_DK) ? QSCALE : 1.f);
#pragma unroll
      for (int i = 0; i < 2; ++i)
#pragma unroll
        for (int j = 0; j < 2; ++j)
#pragma unroll
          for (int q = 0; q < 8; ++q) {
            float lo, hi2; pair_xchg(acc[i][j][2 * q], acc[i][j][2 * q + 1], lane, lo, hi2);
            const int row = row0 + wm * 64 + i * 32 + crow(2 * q, hi) + (lane & 1);
            const int col = col0 + wn * 64 + j * 32 + (r32 & ~1);
            if (rope) {
              const int s = row % SEGL;
              if (s >= CTXL) {
                const int idx = (s - CTXL) * 32 + ((col & 63) >> 1);
                const float c = RC[idx], sn = RS[idx];
                const float t1 = lo, t2 = hi2; lo = t1 * c - t2 * sn; hi2 = t1 * sn + t2 * c;
              }
            }
            *(unsigned*)(PROJ + (size_t)row * PW + col) = cvtpk(lo * scl, hi2 * scl);
          }
    } else {
      const int pm = u - NU, rowb = pm * 256 + wid * 32;
      const bf16_t* WG = (const bf16_t*)(p.ws + WS_WG) + (size_t)l * 16 * DM;
      float* GT = (float*)(p.ws + WS_GATES);
      const int r16 = lane & 15, q4 = lane >> 4;
      f32x4 c0 = {0.f, 0.f, 0.f, 0.f}, c1 = {0.f, 0.f, 0.f, 0.f};
      const bf16_t* a0p = H + (size_t)(rowb + r16) * DM + q4 * 8;
      const bf16_t* a1p = a0p + (size_t)16 * DM;
      const bf16_t* bp = WG + (size_t)r16 * DM + q4 * 8;
#pragma unroll 4
      for (int ks = 0; ks < 32; ++ks) {
        const bf16x8 a0 = *(const bf16x8*)(a0p + ks * 32), a1 = *(const bf16x8*)(a1p + ks * 32), b = *(const bf16x8*)(bp + ks * 32);
        c0 = __builtin_amdgcn_mfma_f32_16x16x32_bf16(a0, b, c0, 0, 0, 0);
        c1 = __builtin_amdgcn_mfma_f32_16x16x32_bf16(a1, b, c1, 0, 0, 0);
      }
      const float gb = p.in[I_GATEB][l * 16 + r16];
#pragma unroll
      for (int j = 0; j < 4; ++j) {
        GT[(size_t)(rowb + q4 * 4 + j) * 16 + r16] = c0[j] + gb;
        GT[(size_t)(rowb + 16 + q4 * 4 + j) * 16 + r16] = c1[j] + gb;
      }
    }
  }
}

__device__ __forceinline__ void phase_outproj(const Params& p, int l, unsigned char* lds) {
  int tid_ = tidx(); asm volatile("" : "+v"(tid_)); const int tid = tid_, lane = tid & 63, wid = tid >> 6, wm = wid >> 1, wn = wid & 1, r32 = lane & 31, hi = lane >> 5;
  const bf16_t* MIX = (const bf16_t*)(p.ws + WS_MIX);
  const bf16_t* W = (const bf16_t*)(p.ws + WS_WOUT) + (size_t)l * DM * DM;
  float* XC = (float*)(p.ws + WS_XCUR);
  const float* MOD = (const float*)(p.ws + WS_MOD);
  constexpr int NM = T / 256, NN = DM / 128, NU = NM * NN;
  for (int u = p.bx; u < NU; u += p.gx) {
    const int pm = u / NN, pn = u % NN;
    if (l == DEPTH - 1 && (pm % 33) == 0) continue;
    const int row0 = pm * 256, col0 = pn * 128;
    for (int rep = 0; rep < REP_OUTP; ++rep) {
    f32x16 acc[2][2];
    gemm_tile(MIX, DM, W, DM, DM, row0, col0, lds, acc);
    const int mr = (pm % 33) == 0 ? 4 : pm / 33;
    const float* g1 = MOD + ((size_t)l * 5 + mr) * 6144 + 2048;
#pragma unroll
    for (int i = 0; i < 2; ++i)
#pragma unroll
      for (int j = 0; j < 2; ++j) {
        const int col = col0 + wn * 64 + j * 32 + r32;
        const float gg = (rep == REP_OUTP - 1) ? g1[col] : 0.f;
#pragma unroll
        for (int r = 0; r < 16; ++r) {
          const int row = row0 + wm * 64 + i * 32 + crow(r, hi);
          const float xo = (l == 0) ? in_row(p.in[I_X], p.in[I_CTX], row)[col] : XC[(size_t)row * DM + col];
          XC[(size_t)row * DM + col] = xo + gg * acc[i][j][r];
        }
      }
    }
  }
}
__device__ __forceinline__ void phase_peerq(const Params& p, int l, unsigned char* lds) {
  int tid_ = tidx(); asm volatile("" : "+v"(tid_)); const int tid = tid_, lane = tid & 63, wid = tid >> 6, wm = wid >> 1, wn = wid & 1, r32 = lane & 31, hi = lane >> 5;
  const bf16_t* H = (const bf16_t*)(p.ws + WS_H);
  const bf16_t* W = (const bf16_t*)(p.ws + WS_WQ) + (size_t)l * DM * DM;
  bf16_t* QP = (bf16_t*)(p.ws + WS_PROJ);
  constexpr int NM = T / 256, NN = DM / 128, NU = NM * NN;
  for (int u = p.bx; u < NU; u += p.gx) {
    const int pm = u / NN, pn = u % NN;
    if (l == DEPTH - 1 && (pm % 33) == 0) continue;
    const int row0 = pm * 256, col0 = pn * 128;
    f32x16 acc[2][2];
    gemm_tile(H, DM, W, DM, DM, row0, col0, lds, acc);
#pragma unroll
    for (int i = 0; i < 2; ++i)
#pragma unroll
      for (int j = 0; j < 2; ++j)
#pragma unroll
        for (int q = 0; q < 8; ++q) {
          float lo, hi2; pair_xchg(acc[i][j][2 * q], acc[i][j][2 * q + 1], lane, lo, hi2);
          const int row = row0 + wm * 64 + i * 32 + crow(2 * q, hi) + (lane & 1);
          const int col = col0 + wn * 64 + j * 32 + (r32 & ~1);
          *(unsigned*)(QP + (size_t)row * DM + col) = cvtpk(lo, hi2);
        }
  }
}


struct EpiInproj {
  static constexpr bool PERM = true, AFTER_DRAIN = false;
  bf16_t* PROJ; const float* RC; const float* RS; unsigned char* V8T;
  __device__ __forceinline__ void operator()(const pg8::f32x4 (&acc)[2][2][4][2], const pg8::Unit& u, int wr, int wc, int fr, int fq) const {
#pragma unroll
    for (int bj = 0; bj < 2; ++bj) {
      const int colt = u.pn * 256 + bj * 128;
      const bool rope = (colt >= C_DQ && colt < C_DV);
      const float scl = (colt >= C_MK && colt < C_MV) ? 0.125f : ((colt >= C_DQ && colt < C_DK) ? QSCALE : 1.f);
      const int col8 = colt + wc * 32 + 8 * fq;
      if (colt >= C_DV) {
        const int hh = (col8 - C_DV) >> 7, e0 = (col8 - C_DV) & 127;
#pragma unroll
        for (int ai = 0; ai < 2; ++ai)
#pragma unroll
          for (int m = 0; m < 4; ++m) {
            const int row = u.pm * 256 + ai * 128 + wr * 64 + m * 16 + fr;
            const int b = row / SEGL, s = row - b * SEGL, t = s >> 6, kk = s & 63;
            const int slot = ((kk >> 2) & 1) * 32 + (kk & 3) + 4 * ((kk >> 3) & 3) + 16 * (kk >> 5);
            unsigned char* vp = V8T + ((size_t)((b * 4 + hh) * NCH + t) * 128 + e0) * 80 + slot;
            const f32x4 v0 = acc[ai][bj][m][0], v1 = acc[ai][bj][m][1];
            int w0 = 0, w1 = 0;
            w0 = __builtin_amdgcn_cvt_pk_fp8_f32(v0[0], v0[1], w0, false); w0 = __builtin_amdgcn_cvt_pk_fp8_f32(v0[2], v0[3], w0, true);
            w1 = __builtin_amdgcn_cvt_pk_fp8_f32(v1[0], v1[1], w1, false); w1 = __builtin_amdgcn_cvt_pk_fp8_f32(v1[2], v1[3], w1, true);
            vp[0] = (unsigned char)(w0 & 0xFF); vp[80] = (unsigned char)((w0 >> 8) & 0xFF); vp[160] = (unsigned char)((w0 >> 16) & 0xFF); vp[240] = (unsigned char)((w0 >> 24) & 0xFF);
            vp[320] = (unsigned char)(w1 & 0xFF); vp[400] = (unsigned char)((w1 >> 8) & 0xFF); vp[480] = (unsigned char)((w1 >> 16) & 0xFF); vp[560] = (unsigned char)((w1 >> 24) & 0xFF);
          }
        continue;
      }
      unsigned char* qk8 = nullptr;
      if (rope) { const int isk = colt >= C_DK, cc = col8 - (isk ? C_DK : C_DQ); qk8 = V8T + (WS_QK8 - WS_V8T) + (size_t)isk * QK8_IMG + (size_t)(cc >> 7) * SEGL * QK8_PITCH + (cc & 127); }
#pragma unroll
      for (int ai = 0; ai < 2; ++ai)
#pragma unroll
        for (int m = 0; m < 4; ++m) {
          const int row = u.pm * 256 + ai * 128 + wr * 64 + m * 16 + fr;
          f32x4 v0 = acc[ai][bj][m][0], v1 = acc[ai][bj][m][1];
          if (rope) {
            const int s = row % SEGL;
            if (s >= CTXL) {
              const int idx = (s - CTXL) * 32 + ((col8 & 63) >> 1);
              const f32x4 c = *(const f32x4*)(RC + idx), sn = *(const f32x4*)(RS + idx);
              f32x4 a, b;
              a[0] = v0[0] * c[0] - v0[1] * sn[0]; a[1] = v0[0] * sn[0] + v0[1] * c[0]; a[2] = v0[2] * c[1] - v0[3] * sn[1]; a[3] = v0[2] * sn[1] + v0[3] * c[1];
              b[0] = v1[0] * c[2] - v1[1] * sn[2]; b[1] = v1[0] * sn[2] + v1[1] * c[2]; b[2] = v1[2] * c[3] - v1[3] * sn[3]; b[3] = v1[2] * sn[3] + v1[3] * c[3];
              v0 = a; v1 = b;
            }
          }
          if (rope) {
            const int b = row / SEGL, s = row - b * SEGL;
            int w0, w1; asm volatile("" : "=v"(w0), "=v"(w1));
            w0 = __builtin_amdgcn_cvt_pk_fp8_f32(v0[0] * scl, v0[1] * scl, w0, false); w0 = __builtin_amdgcn_cvt_pk_fp8_f32(v0[2] * scl, v0[3] * scl, w0, true);
            w1 = __builtin_amdgcn_cvt_pk_fp8_f32(v1[0] * scl, v1[1] * scl, w1, false); w1 = __builtin_amdgcn_cvt_pk_fp8_f32(v1[2] * scl, v1[3] * scl, w1, true);
            *(u32x2*)(qk8 + ((size_t)b * 4 * SEGL + s) * QK8_PITCH) = (u32x2){(unsigned)w0, (unsigned)w1};
            continue;
          }
          u32x4 w; w.x = cvtpk(v0[0] * scl, v0[1] * scl); w.y = cvtpk(v0[2] * scl, v0[3] * scl); w.z = cvtpk(v1[0] * scl, v1[1] * scl); w.w = cvtpk(v1[2] * scl, v1[3] * scl);
          *(u32x4*)(PROJ + (size_t)row * PW + col8) = w;
        }
    }
  }
};
struct EpiOutproj {
  static constexpr bool PERM = true, AFTER_DRAIN = false;
  float* XC; const float* MODL; const float* xin; const float* ctxin; int first; float gsc;
  __device__ __forceinline__ void operator()(const pg8::f32x4 (&acc)[2][2][4][2], const pg8::Unit& u, int wr, int wc, int fr, int fq) const {
    const int mr = (u.pm % 33) == 0 ? 4 : u.pm / 33;
    const float* g1 = MODL + (size_t)mr * 6144 + 2048;
#pragma unroll
    for (int bj = 0; bj < 2; ++bj) {
      const int col8 = u.pn * 256 + bj * 128 + wc * 32 + 8 * fq;
      const f32x4 ga = *(const f32x4*)(g1 + col8) * gsc, gb = *(const f32x4*)(g1 + col8 + 4) * gsc;
#pragma unroll
      for (int ai = 0; ai < 2; ++ai)
#pragma unroll
        for (int m = 0; m < 4; ++m) {
          const int row = u.pm * 256 + ai * 128 + wr * 64 + m * 16 + fr;
          const float* xo = first ? in_row(xin, ctxin, row) + col8 : XC + (size_t)row * DM + col8;
          const f32x4 xa = *(const f32x4*)xo, xb = *(const f32x4*)(xo + 4);
          *(f32x4*)(XC + (size_t)row * DM + col8) = xa + ga * acc[ai][bj][m][0];
          *(f32x4*)(XC + (size_t)row * DM + col8 + 4) = xb + gb * acc[ai][bj][m][1];
        }
    }
  }
};
struct EpiPeerq {
  static constexpr bool PERM = true, AFTER_DRAIN = false;
  bf16_t* QP;
  __device__ __forceinline__ void operator()(const pg8::f32x4 (&acc)[2][2][4][2], const pg8::Unit& u, int wr, int wc, int fr, int fq) const {
#pragma unroll
    for (int bj = 0; bj < 2; ++bj) {
      const int col8 = u.pn * 256 + bj * 128 + wc * 32 + 8 * fq;
#pragma unroll
      for (int ai = 0; ai < 2; ++ai)
#pragma unroll
        for (int m = 0; m < 4; ++m) {
          const int row = u.pm * 256 + ai * 128 + wr * 64 + m * 16 + fr;
          const f32x4 v0 = acc[ai][bj][m][0], v1 = acc[ai][bj][m][1];
          u32x4 w; w.x = cvtpk(v0[0], v0[1]); w.y = cvtpk(v0[2], v0[3]); w.z = cvtpk(v1[0], v1[1]); w.w = cvtpk(v1[2], v1[3]);
          *(u32x4*)(QP + (size_t)row * DM + col8) = w;
        }
    }
  }
};
__device__ __forceinline__ void phase_inproj2(const Params& p, int l, unsigned char* lds) {
  {
    pg8::Gemm g{(const bf16_t*)(p.ws + WS_H), (const bf16_t*)(p.ws + WS_WIN) + (size_t)l * PW * DM, T, PW, DM};
    pg8::StaticOrder S; S.init(T, PW, p.gx, p.bx);
    EpiInproj E{(bf16_t*)(p.ws + WS_PROJ), (const float*)(p.ws + WS_ROPE), (const float*)(p.ws + WS_ROPE) + SEQ * 32, p.ws + WS_V8T};
    pg8::gemm_phase<EpiInproj, pg8::StaticOrder, true, true>((PG8_LAS unsigned char*)lds, g, S, E);
  }
  int tid_ = tidx(); asm volatile("" : "+v"(tid_)); const int tid = tid_, lane = tid & 63, wid = tid >> 6;
  const bf16_t* H = (const bf16_t*)(p.ws + WS_H);
  for (int pm = p.gx - 1 - p.bx; pm < T / 256; pm += p.gx) {
    const int rowb = pm * 256 + wid * 32;
    const bf16_t* WG = (const bf16_t*)(p.ws + WS_WG) + (size_t)l * 16 * DM;
    float* GT = (float*)(p.ws + WS_GATES);
    const int r16 = lane & 15, q4 = lane >> 4;
    f32x4 c0 = {0.f, 0.f, 0.f, 0.f}, c1 = {0.f, 0.f, 0.f, 0.f};
    const bf16_t* a0p = H + (size_t)(rowb + r16) * DM + q4 * 8;
    const bf16_t* a1p = a0p + (size_t)16 * DM;
    const bf16_t* bp = WG + (size_t)r16 * DM + q4 * 8;
#pragma unroll 4
    for (int ks = 0; ks < 32; ++ks) {
      const bf16x8 a0 = *(const bf16x8*)(a0p + ks * 32), a1 = *(const bf16x8*)(a1p + ks * 32), b = *(const bf16x8*)(bp + ks * 32);
      c0 = __builtin_amdgcn_mfma_f32_16x16x32_bf16(a0, b, c0, 0, 0, 0);
      c1 = __builtin_amdgcn_mfma_f32_16x16x32_bf16(a1, b, c1, 0, 0, 0);
    }
    const float gb = p.in[I_GATEB][l * 16 + r16];
#pragma unroll
    for (int j = 0; j < 4; ++j) {
      GT[(size_t)(rowb + q4 * 4 + j) * 16 + r16] = c0[j] + gb;
      GT[(size_t)(rowb + 16 + q4 * 4 + j) * 16 + r16] = c1[j] + gb;
    }
  }
}
__device__ __forceinline__ void phase_outproj2(const Params& p, int l, unsigned char* lds) {
  pg8::Gemm g{(const bf16_t*)(p.ws + WS_MIX), (const bf16_t*)(p.ws + WS_WOUT) + (size_t)l * DM * DM, T, DM, DM};
  pg8::StaticOrder S; S.init(T, DM, p.gx, p.bx);
  for (int rep = 0; rep < REP_OUTP; ++rep) {
  EpiOutproj E{(float*)(p.ws + WS_XCUR), (const float*)(p.ws + WS_MOD) + (size_t)l * 5 * 6144, p.in[I_X], p.in[I_CTX], l == 0, (rep == REP_OUTP - 1) ? 1.f : 0.f};
  pg8::gemm_phase<EpiOutproj, pg8::StaticOrder, true, true>((PG8_LAS unsigned char*)lds, g, S, E);
  }
  tail_filler_tables(p, l, (T / 256) * (DM / 256), l == 0 ? 0 : NEXP, 2 * NEXP);
}
__device__ __forceinline__ void phase_peerq2(const Params& p, int l, unsigned char* lds) {
  pg8::Gemm g{(const bf16_t*)(p.ws + WS_H), (const bf16_t*)(p.ws + WS_WQ) + (size_t)l * DM * DM, T, DM, DM};
  pg8::StaticOrder S; S.init(T, DM, p.gx, p.bx);
  EpiPeerq E{(bf16_t*)(p.ws + WS_PROJ)};
  pg8::gemm_phase<EpiPeerq, pg8::StaticOrder, true, true>((PG8_LAS unsigned char*)lds, g, S, E);
  if (l < DEPTH - 1) tail_filler_tables(p, l + 1, (T / 256) * (DM / 256), 0, NEXP);
}

__device__ __forceinline__ void conv_unit(const Params& p, int l, int unit, unsigned char* lds) {
  int tid_ = tidx(); asm volatile("" : "+v"(tid_)); const int tid = tid_, lane = tid & 63, wid = tid >> 6;
  float* U = (float*)lds;
  const bf16_t* PROJ = (const bf16_t*)(p.ws + WS_PROJ);
  bf16_t* MIX = (bf16_t*)(p.ws + WS_MIX);
  const int row0 = unit * 32, b = row0 / SEGL, s0 = row0 - b * SEGL;
  const int seglo = s0 < CTXL ? 0 : CTXL, seghi = s0 < CTXL ? CTXL : SEGL;
  for (int rr = tid >> 5; rr < 62; rr += 16) {
    const int s = s0 - 15 + rr, c8 = (tid & 31) * 8;
    f32x4 u0 = {0.f, 0.f, 0.f, 0.f}, u1 = {0.f, 0.f, 0.f, 0.f};
    if (s >= seglo && s < seghi) {
      const bf16_t* pr = PROJ + (size_t)(b * SEGL + s) * PW + c8;
      const u32x4 a1 = *(const u32x4*)pr, a2 = *(const u32x4*)(pr + 256);
      u0.x = bflo(a1.x) * sigmoidf_(bflo(a2.x)); u0.y = bfhi(a1.x) * sigmoidf_(bfhi(a2.x));
      u0.z = bflo(a1.y) * sigmoidf_(bflo(a2.y)); u0.w = bfhi(a1.y) * sigmoidf_(bfhi(a2.y));
      u1.x = bflo(a1.z) * sigmoidf_(bflo(a2.z)); u1.y = bfhi(a1.z) * sigmoidf_(bfhi(a2.z));
      u1.z = bflo(a1.w) * sigmoidf_(bflo(a2.w)); u1.w = bfhi(a1.w) * sigmoidf_(bfhi(a2.w));
    }
    *(f32x4*)(U + rr * 256 + c8) = u0; *(f32x4*)(U + rr * 256 + c8 + 4) = u1;
  }
  __syncthreads();
  float* Y = U + 62 * 256;
  const float* cw = p.in[I_CONVW] + (size_t)l * 31 * 256;
#pragma unroll 1
  for (int q = 0; q < 4; ++q) {
    const int c = lane + 64 * q;
    float w[31];
#pragma unroll
    for (int j = 0; j < 31; ++j) w[j] = cw[j * 256 + c];
    const float bias = p.in[I_CONVB][l * 256 + c];
#pragma unroll
    for (int tt = 0; tt < 4; ++tt) {
      const int t = wid * 4 + tt;
      float a = bias;
#pragma unroll
      for (int j = 0; j < 31; ++j) a += U[(t + j) * 256 + c] * w[j];
      Y[t * 256 + c] = a;
    }
  }
  asm volatile("s_waitcnt lgkmcnt(0)" ::: "memory");
  float y[4][4];
#pragma unroll
  for (int tt = 0; tt < 4; ++tt)
#pragma unroll
    for (int q = 0; q < 4; ++q) y[tt][q] = Y[(wid * 4 + tt) * 256 + lane + 64 * q];
#pragma unroll
  for (int tt = 0; tt < 4; ++tt) {
    const int t = wid * 4 + tt;
    const float mean = wave_sum((y[tt][0] + y[tt][1]) + (y[tt][2] + y[tt][3])) * (1.f / 256.f);
    float v = 0.f;
#pragma unroll
    for (int q = 0; q < 4; ++q) { const float d = y[tt][q] - mean; v += d * d; }
    const float rs = rsqrtf(wave_sum(v) * (1.f / 256.f) + EPS);
#pragma unroll
    for (int q = 0; q < 4; ++q) {
      const int c = lane + 64 * q;
      const float z = (y[tt][q] - mean) * rs * p.in[I_CLNG][l * 256 + c] + p.in[I_CLNB][l * 256 + c];
      const float o = (ABL & 1) ? 0.f : z * sigmoidf_(z);
      MIX[(size_t)(row0 + t) * DM + c] = (bf16_t)(cvtpk(o, 0.f) & 0xffffu);
    }
  }
  __syncthreads();
}

__device__ __forceinline__ int ml_cidx(int ch, int dir) { return dir == 0 ? ch : (ch < 4 ? 3 - ch : 135 - ch); }
__device__ __forceinline__ void ml_load_tile(const bf16_t* src, float* dst, int tid) {
  const int r = tid >> 3, c8 = (tid & 7) * 8;
  const u32x4 a = *(const u32x4*)(src + (size_t)r * PW + c8);
  float* d = dst + r * 65 + c8;
  d[0] = bflo(a.x); d[1] = bfhi(a.x); d[2] = bflo(a.y); d[3] = bfhi(a.y); d[4] = bflo(a.z); d[5] = bfhi(a.z); d[6] = bflo(a.w); d[7] = bfhi(a.w);
}
__device__ __forceinline__ void ml_local_unit(const Params& p, int l, int unit, unsigned char* lds) {
  int tid_ = tidx(); asm volatile("" : "+v"(tid_)); const int tid = tid_, lane = tid & 63, wid = tid >> 6, r32 = lane & 31, hi = lane >> 5;
  float* Kt = (float*)lds; float* Vt = Kt + 64 * 65; float* WK = Vt + 64 * 65;
  const bf16_t* PROJ = (const bf16_t*)(p.ws + WS_PROJ);
  const float* GT = (const float*)(p.ws + WS_GATES);
  float* UL = (float*)(p.ws + WS_ULOC); float* META = (float*)(p.ws + WS_MLMETA);
  const int b = unit / (4 * NCH), hh = (unit / NCH) & 3, ch = unit % NCH;
  const int row0 = b * SEGL + ch * 64;
  ml_load_tile(PROJ + (size_t)row0 * PW + C_MK + hh * 64, Kt, tid);
  ml_load_tile(PROJ + (size_t)row0 * PW + C_MV + hh * 64, Vt, tid);
  if (wid < 2) {
    const int dir = wid;
    const float ig = GT[(size_t)(row0 + lane) * 16 + (2 * dir) * 4 + hh];
    const float lf = logsigmoidf_(GT[(size_t)(row0 + lane) * 16 + (2 * dir + 1) * 4 + hh]);
    float ps = lf;
    ps = wave_incl_scan(ps);
    const float tot = __uint_as_float((unsigned)__builtin_amdgcn_readlane((int)__float_as_uint(ps), 63));
    const float wlog = dir == 0 ? (tot - ps + ig) : (ps - lf + ig);
    const float mloc = wave_max(wlog);
    WK[dir * 64 + lane] = __expf(wlog - mloc);
    if (lane == 0) {
      const int seq = (b * 4 + hh) * 2 + dir, ci = ml_cidx(ch, dir);
      META[((size_t)seq * NCH + ci) * 4 + 0] = tot; META[((size_t)seq * NCH + ci) * 4 + 1] = mloc;
    }
  }
  __syncthreads();
  {
    const int dir = wid >> 2, et = (wid >> 1) & 1, dt = wid & 1;
    const int seq = (b * 4 + hh) * 2 + dir, ci = ml_cidx(ch, dir);
    float* slot = UL + ((size_t)seq * NCH + ci) * USTRIDE;
    f32x16 acc = {};
#pragma unroll 8
    for (int ks = 0; ks < 32; ++ks) {
      const int s = 2 * ks + hi;
      const float a = WK[dir * 64 + s] * Vt[s * 65 + et * 32 + r32];
      const float bb = Kt[s * 65 + dt * 32 + r32];
      acc = __builtin_amdgcn_mfma_f32_32x32x2f32(a, bb, acc, 0, 0, 0);
    }
#pragma unroll
    for (int r = 0; r < 16; ++r) slot[(et * 32 + crow(r, hi)) * 64 + dt * 32 + r32] = acc[r];
    if (et == 0) {
      float n = 0.f;
#pragma unroll 8
      for (int i = 0; i < 32; ++i) { const int s = hi * 32 + i; n += WK[dir * 64 + s] * Kt[s * 65 + dt * 32 + r32]; }
      n = sum_xor32(n);
      if (hi == 0) slot[4096 + dt * 32 + r32] = n;
    }
  }
  __syncthreads();
}
constexpr int MLP = 144;
constexpr size_t WS_CST = WS_H;
constexpr size_t WS_NST = WS_H + (size_t)32 * NCH * 4096 * 2;
__device__ __forceinline__ void ml_stage_rm(const bf16_t* src, size_t ld, unsigned char* dst, int tid) {
  const int r = tid >> 3, c8 = (tid & 7) * 8;
  *(u32x4*)(dst + r * MLP + c8 * 2) = *(const u32x4*)(src + (size_t)r * ld + c8);
}
__device__ __forceinline__ void ml_stage_tr(const bf16_t* src, size_t ld, unsigned char* dst, int tid) {
  const int r = tid >> 3, c8 = (tid & 7) * 8;
  const u32x4 a = *(const u32x4*)(src + (size_t)r * ld + c8);
  bf16_t* d = (bf16_t*)dst;
  d[(c8 + 0) * 72 + r] = (bf16_t)(a.x & 0xffffu); d[(c8 + 1) * 72 + r] = (bf16_t)(a.x >> 16);
  d[(c8 + 2) * 72 + r] = (bf16_t)(a.y & 0xffffu); d[(c8 + 3) * 72 + r] = (bf16_t)(a.y >> 16);
  d[(c8 + 4) * 72 + r] = (bf16_t)(a.z & 0xffffu); d[(c8 + 5) * 72 + r] = (bf16_t)(a.z >> 16);
  d[(c8 + 6) * 72 + r] = (bf16_t)(a.w & 0xffffu); d[(c8 + 7) * 72 + r] = (bf16_t)(a.w >> 16);
}
__device__ __forceinline__ void ml_local_unit2(const Params& p, int l, int unit, unsigned char* lds) {
  int tid_ = tidx(); asm volatile("" : "+v"(tid_)); const int tid = tid_, lane = tid & 63, wid = tid >> 6, r32 = lane & 31, hi = lane >> 5;
  unsigned char* KT = lds; unsigned char* VT = lds + 64 * MLP; float* WK = (float*)(lds + 2 * 64 * MLP);
  const bf16_t* PROJ = (const bf16_t*)(p.ws + WS_PROJ);
  const float* GT = (const float*)(p.ws + WS_GATES);
  float* UL = (float*)(p.ws + WS_ULOC); float* META = (float*)(p.ws + WS_MLMETA);
  const int b = unit / (4 * NCH), hh = (unit / NCH) & 3, ch = unit % NCH;
  const int row0 = b * SEGL + ch * 64;
  ml_stage_tr(PROJ + (size_t)row0 * PW + C_MK + hh * 64, PW, KT, tid);
  ml_stage_tr(PROJ + (size_t)row0 * PW + C_MV + hh * 64, PW, VT, tid);
  if (wid < 2) {
    const int dir = wid;
    const float ig = GT[(size_t)(row0 + lane) * 16 + (2 * dir) * 4 + hh];
    const float lf = logsigmoidf_(GT[(size_t)(row0 + lane) * 16 + (2 * dir + 1) * 4 + hh]);
    float ps = lf;
    ps = wave_incl_scan(ps);
    const float tot = __uint_as_float((unsigned)__builtin_amdgcn_readlane((int)__float_as_uint(ps), 63));
    const float wlog = dir == 0 ? (tot - ps + ig) : (ps - lf + ig);
    const float mloc = wave_max(wlog);
    WK[dir * 64 + lane] = __expf(wlog - mloc);
    if (lane == 0) {
      const int seq = (b * 4 + hh) * 2 + dir, ci = ml_cidx(ch, dir);
      META[((size_t)seq * NCH + ci) * 4 + 0] = tot; META[((size_t)seq * NCH + ci) * 4 + 1] = mloc;
    }
  }
  __syncthreads();
  {
    const int dir = wid >> 2, et = (wid >> 1) & 1, dt = wid & 1;
    const int seq = (b * 4 + hh) * 2 + dir, ci = ml_cidx(ch, dir);
    float* slot = UL + ((size_t)seq * NCH + ci) * USTRIDE;
    f32x16 acc = {};
#pragma unroll
    for (int ks = 0; ks < 4; ++ks) {
      const int s0 = ks * 16 + hi * 8;
      const u32x4 va = *(const u32x4*)(VT + (et * 32 + r32) * MLP + s0 * 2);
      const bf16x8 kb = *(const bf16x8*)(KT + (dt * 32 + r32) * MLP + s0 * 2);
      const f32x4 w0 = *(const f32x4*)(WK + dir * 64 + s0), w1 = *(const f32x4*)(WK + dir * 64 + s0 + 4);
      u32x4 sa; sa.x = cvtpk(bflo(va.x) * w0.x, bfhi(va.x) * w0.y); sa.y = cvtpk(bflo(va.y) * w0.z, bfhi(va.y) * w0.w);
      sa.z = cvtpk(bflo(va.z) * w1.x, bfhi(va.z) * w1.y); sa.w = cvtpk(bflo(va.w) * w1.z, bfhi(va.w) * w1.w);
      acc = __builtin_amdgcn_mfma_f32_32x32x16_bf16(*(const bf16x8*)&sa, kb, acc, 0, 0, 0);
    }
#pragma unroll
    for (int r = 0; r < 16; ++r) slot[(et * 32 + crow(r, hi)) * 64 + dt * 32 + r32] = acc[r];
    if (et == 0) {
      float n = 0.f;
#pragma unroll
      for (int i = 0; i < 4; ++i) {
        const int s0 = hi * 32 + i * 8;
        const u32x4 ka = *(const u32x4*)(KT + (dt * 32 + r32) * MLP + s0 * 2);
        const f32x4 w0 = *(const f32x4*)(WK + dir * 64 + s0), w1 = *(const f32x4*)(WK + dir * 64 + s0 + 4);
        n += bflo(ka.x) * w0.x + bfhi(ka.x) * w0.y + bflo(ka.y) * w0.z + bfhi(ka.y) * w0.w + bflo(ka.z) * w1.x + bfhi(ka.z) * w1.y + bflo(ka.w) * w1.z + bfhi(ka.w) * w1.w;
      }
      n = sum_xor32(n);
      if (hi == 0) slot[4096 + dt * 32 + r32] = n;
    }
  }
  __syncthreads();
}
__device__ __forceinline__ void ml_scan(const Params& p, unsigned char* lds) {
  float* UL = (float*)(p.ws + WS_ULOC); float* META = (float*)(p.ws + WS_MLMETA);
  int tid_ = tidx(); asm volatile("" : "+v"(tid_));
  const int tid = tid_, lane = tid & 63, wid = tid >> 6;
  float* DEC = (float*)lds;
  float* SCL = DEC + 2 * NCH;
  float* TMP = SCL + 2 * NCH;
  constexpr int NSL = (32 * USTRIDE + 511) / 512;
  const int first_ = p.gx > 64 ? 16 : 0, nb_ = p.gx - first_;
  for (int k_ = 0; k_ < 2 + (NSL + nb_ - 1) / nb_; ++k_) {
    int s_;
    if (k_ == 0) s_ = p.bx >= first_ ? p.bx - first_ : -1;
    else s_ = k_ * nb_ + (p.gx - 1 - p.bx);
    if (k_ > 0 && p.gx - 1 - p.bx >= nb_) s_ = -1;
    if (s_ < 0 || s_ >= NSL) continue;
    const int base0 = s_ * 512;
    const int seq0 = base0 / USTRIDE;
    if (wid < 2) {
      const int seq = seq0 + wid;
      if (seq < 32) {
        float* mt = META + (size_t)seq * NCH * 4;
        for (int c = lane; c < NCH; c += 64) { TMP[(wid * 2 + 0) * NCH + c] = mt[c * 4 + 0]; TMP[(wid * 2 + 1) * NCH + c] = mt[c * 4 + 1]; }
        asm volatile("s_waitcnt lgkmcnt(0)" ::: "memory");
        if (lane == 0) {
          float m = 0.f;
          for (int c = 0; c < NCH; ++c) {
            const float bl = TMP[(wid * 2 + 0) * NCH + c], mloc = TMP[(wid * 2 + 1) * NCH + c];
            const float mn = fmaxf(bl + m, mloc);
            DEC[wid * NCH + c] = __expf(bl + m - mn); SCL[wid * NCH + c] = __expf(mloc - mn);
            mt[c * 4 + 2] = m;
            m = mn;
          }
        }
      }
    }
    __syncthreads();
    const int idx = base0 + tid;
    if (idx < 32 * USTRIDE) {
      const int seq = idx / USTRIDE, e = idx - seq * USTRIDE, sl = seq - seq0;
      float* bp = UL + (size_t)seq * NCH * USTRIDE + e;
      bf16_t* CSTp = (bf16_t*)(p.ws + WS_CST) + (size_t)seq * NCH * 4096 + (e < 4096 ? e : 0);
      float* NSTp = (float*)(p.ws + WS_NST) + (size_t)seq * NCH * 64 + (e < 4096 ? 0 : e - 4096);
      const float* dec = DEC + sl * NCH; const float* scl = SCL + sl * NCH;
      float C = 0.f;
      constexpr int BT = 33;
      static_assert(NCH == 4 * BT, "scan batches");
      float ua[BT], ub[BT];
#define SCAN_LD(u_, c0_) _Pragma("unroll") for (int j = 0; j < BT; ++j) u_[j] = bp[(size_t)((c0_) + j) * USTRIDE];
#define SCAN_DO(u_, c0_) _Pragma("unroll") for (int j = 0; j < BT; ++j) { \
          if (e < 4096) CSTp[(size_t)((c0_) + j) * 4096] = (bf16_t)(cvtpk(C, 0.f) & 0xffffu); else NSTp[(size_t)((c0_) + j) * 64] = C; \
          C = dec[(c0_) + j] * C + scl[(c0_) + j] * u_[j]; }
      SCAN_LD(ua, 0)
#pragma unroll 1
      for (int c0 = 0; c0 < NCH; c0 += 2 * BT) {
        SCAN_LD(ub, c0 + BT)
        SCAN_DO(ua, c0)
        if (c0 + 2 * BT < NCH) { SCAN_LD(ua, c0 + 2 * BT) }
        SCAN_DO(ub, c0 + BT)
      }
#undef SCAN_LD
#undef SCAN_DO
    }
    __syncthreads();
  }
}
__device__ __forceinline__ void ml_out_unit(const Params& p, int l, int unit, unsigned char* lds) {
  int tid_ = tidx(); asm volatile("" : "+v"(tid_)); const int tid = tid_, lane = tid & 63, wid = tid >> 6, r32 = lane & 31, hi = lane >> 5;
  float* Qt = (float*)lds; float* Kt = Qt + 64 * 65; float* Vt = Kt + 64 * 65;
  float* Cs = Vt + 64 * 65;
  float* Ns = Cs + 2 * 64 * 65;
  float* Bq = Ns + 128;
  float* Gs = Bq + 128;
  float* Mi = Gs + 128;
  float* HB = Mi + 64;
  const bf16_t* PROJ = (const bf16_t*)(p.ws + WS_PROJ);
  const float* GT = (const float*)(p.ws + WS_GATES);
  const float* UL = (const float*)(p.ws + WS_ULOC); const float* META = (const float*)(p.ws + WS_MLMETA);
  bf16_t* MIX = (bf16_t*)(p.ws + WS_MIX);
  const int b = unit / (4 * NCH), hh = (unit / NCH) & 3, ch = unit % NCH;
  const int row0 = b * SEGL + ch * 64;
  ml_load_tile(PROJ + (size_t)row0 * PW + C_MQ + hh * 64, Qt, tid);
  ml_load_tile(PROJ + (size_t)row0 * PW + C_MK + hh * 64, Kt, tid);
  ml_load_tile(PROJ + (size_t)row0 * PW + C_MV + hh * 64, Vt, tid);
  for (int i = tid; i < 2 * USTRIDE; i += 512) {
    const int dir = i / USTRIDE, e = i - dir * USTRIDE;
    const int seq = (b * 4 + hh) * 2 + dir, ci = ml_cidx(ch, dir);
    const float v = UL[((size_t)seq * NCH + ci) * USTRIDE + e];
    if (e < 4096) Cs[dir * 64 * 65 + (e >> 6) * 65 + (e & 63)] = v; else Ns[dir * 64 + (e - 4096)] = v;
  }
  if (wid < 2) {
    const int dir = wid;
    const float ig = GT[(size_t)(row0 + lane) * 16 + (2 * dir) * 4 + hh];
    const float lf = logsigmoidf_(GT[(size_t)(row0 + lane) * 16 + (2 * dir + 1) * 4 + hh]);
    float ps = lf;
    ps = wave_incl_scan(ps);
    const float tot = __uint_as_float((unsigned)__builtin_amdgcn_readlane((int)__float_as_uint(ps), 63));
    const float bc = dir == 0 ? ps : (tot - ps + lf);
    Bq[dir * 64 + lane] = bc; Gs[dir * 64 + lane] = ig - bc;
    if (lane == 0) { const int seq = (b * 4 + hh) * 2 + dir, ci = ml_cidx(ch, dir); Mi[dir] = META[((size_t)seq * NCH + ci) * 4 + 2]; }
  }
  __syncthreads();
  {
    const int dir = wid >> 2, tt = (wid >> 1) & 1, et = wid & 1;
    const int t = tt * 32 + r32;
    f32x16 sa[2] = {};
#pragma unroll 4
    for (int ks = 0; ks < 32; ++ks) {
      const float bq = Qt[t * 65 + 2 * ks + hi];
      const float a0 = Kt[(r32) * 65 + 2 * ks + hi], a1 = Kt[(32 + r32) * 65 + 2 * ks + hi];
      sa[0] = __builtin_amdgcn_mfma_f32_32x32x2f32(a0, bq, sa[0], 0, 0, 0);
      sa[1] = __builtin_amdgcn_mfma_f32_32x32x2f32(a1, bq, sa[1], 0, 0, 0);
    }
    const float bt = Bq[dir * 64 + t];
    const float inter = bt + Mi[dir];
    float mx = -INFINITY;
    f32x16 dl[2];
#pragma unroll
    for (int st = 0; st < 2; ++st)
#pragma unroll
      for (int r = 0; r < 16; ++r) {
        const int s = st * 32 + crow(r, hi);
        const bool ok = dir == 0 ? (s <= t) : (s >= t);
        const float d = ok ? bt + Gs[dir * 64 + s] : -INFINITY;
        dl[st][r] = d; mx = fmaxf(mx, d);
      }
    mx = max_xor32(mx);
    const float mt = fmaxf(inter, mx);
    const float iw = __expf(inter - mt);
    float rsum = 0.f;
#pragma unroll
    for (int st = 0; st < 2; ++st)
#pragma unroll
      for (int r = 0; r < 16; ++r) { const float w = __expf(dl[st][r] - mt); sa[st][r] *= w; rsum += sa[st][r]; }
    rsum = sum_xor32(rsum);
    float qn = 0.f;
#pragma unroll 8
    for (int i = 0; i < 32; ++i) { const int d = hi * 32 + i; qn += Ns[dir * 64 + d] * Qt[t * 65 + d]; }
    qn = sum_xor32(qn);
    const float den = rsum + iw * qn;
    const float rden = 1.f / fmaxf(fabsf(den), __expf(-mt));
    f32x16 an = {}, ac = {};
#pragma unroll
    for (int st = 0; st < 2; ++st)
#pragma unroll
      for (int r = 0; r < 16; ++r) {
        const float a = Vt[(st * 32 + crow(r, hi)) * 65 + et * 32 + r32];
        an = __builtin_amdgcn_mfma_f32_32x32x2f32(a, sa[st][r], an, 0, 0, 0);
      }
    const float* Cd = Cs + dir * 64 * 65;
#pragma unroll 4
    for (int ks = 0; ks < 32; ++ks) {
      const float a = Cd[(et * 32 + r32) * 65 + 2 * ks + hi];
      const float bq = Qt[t * 65 + 2 * ks + hi];
      ac = __builtin_amdgcn_mfma_f32_32x32x2f32(a, bq, ac, 0, 0, 0);
    }
#pragma unroll
    for (int r = 0; r < 16; ++r) HB[dir * 64 * 65 + t * 65 + et * 32 + crow(r, hi)] = (an[r] + iw * ac[r]) * rden;
  }
  __syncthreads();
  {
    const int t = tid >> 3, e8 = (tid & 7) * 8;
    float v[8]; float ss = 0.f;
#pragma unroll
    for (int i = 0; i < 8; ++i) { v[i] = HB[t * 65 + e8 + i] + HB[64 * 65 + t * 65 + e8 + i]; ss += v[i] * v[i]; }
    ss += dpp_mov<0xB1>(ss); ss += dpp_mov<0x4E>(ss); ss += dpp_mov<0x141>(ss);
    const float rs = rsqrtf(ss * (1.f / 64.f) + EPS);
    const u32x4 ov = *(const u32x4*)(PROJ + (size_t)(row0 + t) * PW + C_MO + hh * 64 + e8);
    const float og[8] = {bflo(ov.x), bfhi(ov.x), bflo(ov.y), bfhi(ov.y), bflo(ov.z), bfhi(ov.z), bflo(ov.w), bfhi(ov.w)};
    const float* g = p.in[I_MNORMG] + l * 64 + e8;
    float o[8];
#pragma unroll
    for (int i = 0; i < 8; ++i) o[i] = (ABL & 2) ? 0.f : v[i] * rs * g[i] * sigmoidf_(og[i]);
    u32x4 w; w.x = cvtpk(o[0], o[1]); w.y = cvtpk(o[2], o[3]); w.z = cvtpk(o[4], o[5]); w.w = cvtpk(o[6], o[7]);
    *(u32x4*)(MIX + (size_t)(row0 + t) * DM + 256 + hh * 64 + e8) = w;
  }
  __syncthreads();
}


struct MlOutPf { u32x4 q, k, v, c0, c1, ov; float ns0, ns1, g_ig, g_lf, mi; };
__device__ __forceinline__ void ml_out_fetch(const Params& p, int unit, int tid, MlOutPf& f) {
  const int lane = tid & 63, wid = tid >> 6;
  const bf16_t* PROJ = (const bf16_t*)(p.ws + WS_PROJ);
  const float* GT = (const float*)(p.ws + WS_GATES);
  const bf16_t* CST = (const bf16_t*)(p.ws + WS_CST); const float* NST = (const float*)(p.ws + WS_NST); const float* META = (const float*)(p.ws + WS_MLMETA);
  const int b = unit / (4 * NCH), hh = (unit / NCH) & 3, ch = unit % NCH;
  const int row0 = b * SEGL + ch * 64;
  const int r = tid >> 3, c8 = (tid & 7) * 8;
  const bf16_t* prow = PROJ + (size_t)(row0 + r) * PW + hh * 64 + c8;
  f.q = *(const u32x4*)(prow + C_MQ); f.k = *(const u32x4*)(prow + C_MK); f.v = *(const u32x4*)(prow + C_MV); f.ov = *(const u32x4*)(prow + C_MO);
  const int seq0 = (b * 4 + hh) * 2, ci0 = ml_cidx(ch, 0), ci1 = ml_cidx(ch, 1);
  f.c0 = *(const u32x4*)(CST + ((size_t)seq0 * NCH + ci0) * 4096 + r * 64 + c8);
  f.c1 = *(const u32x4*)(CST + ((size_t)(seq0 + 1) * NCH + ci1) * 4096 + r * 64 + c8);
  f.ns0 = 0.f; f.ns1 = 0.f; f.g_ig = 0.f; f.g_lf = 0.f; f.mi = 0.f;
  if (tid < 64) { f.ns0 = NST[((size_t)seq0 * NCH + ci0) * 64 + tid]; f.ns1 = NST[((size_t)(seq0 + 1) * NCH + ci1) * 64 + tid]; }
  if (wid < 2) {
    const int dir = wid;
    f.g_ig = GT[(size_t)(row0 + lane) * 16 + (2 * dir) * 4 + hh];
    f.g_lf = GT[(size_t)(row0 + lane) * 16 + (2 * dir + 1) * 4 + hh];
    f.mi = META[((size_t)(seq0 + dir) * NCH + (dir ? ci1 : ci0)) * 4 + 2];
  }
}
__device__ __forceinline__ void ml_put_rm(const u32x4 a, unsigned char* dst, int tid) { const int r = tid >> 3, c8 = (tid & 7) * 8; *(u32x4*)(dst + r * MLP + c8 * 2) = a; }
__device__ __forceinline__ void ml_put_tr(const u32x4 a, unsigned char* dst, int tid) {
  const int r = tid >> 3, c8 = (tid & 7) * 8;
  bf16_t* d = (bf16_t*)dst;
  d[(c8 + 0) * 72 + r] = (bf16_t)(a.x & 0xffffu); d[(c8 + 1) * 72 + r] = (bf16_t)(a.x >> 16);
  d[(c8 + 2) * 72 + r] = (bf16_t)(a.y & 0xffffu); d[(c8 + 3) * 72 + r] = (bf16_t)(a.y >> 16);
  d[(c8 + 4) * 72 + r] = (bf16_t)(a.z & 0xffffu); d[(c8 + 5) * 72 + r] = (bf16_t)(a.z >> 16);
  d[(c8 + 6) * 72 + r] = (bf16_t)(a.w & 0xffffu); d[(c8 + 7) * 72 + r] = (bf16_t)(a.w >> 16);
}
__device__ __forceinline__ void ml_out_unit2(const Params& p, int l, int unit, unsigned char* lds, const MlOutPf& f, int next, MlOutPf& fn) {
  int tid_ = tidx(); asm volatile("" : "+v"(tid_)); const int tid = tid_, lane = tid & 63, wid = tid >> 6, r32 = lane & 31, hi = lane >> 5;
  unsigned char* Qs = lds; unsigned char* Ks = lds + 64 * MLP; unsigned char* VT = lds + 2 * 64 * MLP; unsigned char* Cs = lds + 3 * 64 * MLP;
  float* Ns = (float*)(lds + 5 * 64 * MLP);
  float* Bq = Ns + 128;
  float* Gs = Bq + 128;
  float* Mi = Gs + 128;
  float* HB = Mi + 64;
  const bf16_t* PROJ = (const bf16_t*)(p.ws + WS_PROJ);
  const float* GT = (const float*)(p.ws + WS_GATES);
  const bf16_t* CST = (const bf16_t*)(p.ws + WS_CST); const float* NST = (const float*)(p.ws + WS_NST); const float* META = (const float*)(p.ws + WS_MLMETA);
  bf16_t* MIX = (bf16_t*)(p.ws + WS_MIX);
  const int b = unit / (4 * NCH), hh = (unit / NCH) & 3, ch = unit % NCH;
  const int row0 = b * SEGL + ch * 64;
  ml_put_rm(f.q, Qs, tid); ml_put_rm(f.k, Ks, tid); ml_put_tr(f.v, VT, tid);
  ml_put_rm(f.c0, Cs, tid); ml_put_rm(f.c1, Cs + 64 * MLP, tid);
  if (tid < 64) { Ns[tid] = f.ns0; Ns[64 + tid] = f.ns1; }
  if (wid < 2) {
    const int dir = wid;
    const float ig = f.g_ig;
    const float lf = logsigmoidf_(f.g_lf);
    float ps = lf;
    ps = wave_incl_scan(ps);
    const float tot = __uint_as_float((unsigned)__builtin_amdgcn_readlane((int)__float_as_uint(ps), 63));
    const float bc = dir == 0 ? ps : (tot - ps + lf);
    Bq[dir * 64 + lane] = bc; Gs[dir * 64 + lane] = ig - bc;
    if (lane == 0) Mi[dir] = f.mi;
  }
  const u32x4 ov = f.ov;
  if (next >= 0) ml_out_fetch(p, next, tid, fn);
  __syncthreads();
  {
    const int dir = wid >> 2, tt = (wid >> 1) & 1, et = wid & 1;
    const int t = tt * 32 + r32;
    f32x16 sa[2] = {};
    bf16x8 bq[4];
#pragma unroll
    for (int ks = 0; ks < 4; ++ks) {
      bq[ks] = *(const bf16x8*)(Qs + t * MLP + (ks * 16 + hi * 8) * 2);
      const bf16x8 a0 = *(const bf16x8*)(Ks + r32 * MLP + (ks * 16 + hi * 8) * 2), a1 = *(const bf16x8*)(Ks + (32 + r32) * MLP + (ks * 16 + hi * 8) * 2);
      sa[0] = __builtin_amdgcn_mfma_f32_32x32x16_bf16(a0, bq[ks], sa[0], 0, 0, 0);
      sa[1] = __builtin_amdgcn_mfma_f32_32x32x16_bf16(a1, bq[ks], sa[1], 0, 0, 0);
    }
    const float bt = Bq[dir * 64 + t];
    const float inter = bt + Mi[dir];
    float mx = -INFINITY;
    f32x16 dl[2];
#pragma unroll
    for (int st = 0; st < 2; ++st)
#pragma unroll
      for (int r = 0; r < 16; ++r) {
        const int s = st * 32 + crow(r, hi);
        const bool ok = dir == 0 ? (s <= t) : (s >= t);
        const float d = ok ? bt + Gs[dir * 64 + s] : -INFINITY;
        dl[st][r] = d; mx = fmaxf(mx, d);
      }
    mx = max_xor32(mx);
    const float mt = fmaxf(inter, mx);
    const float iw = __expf(inter - mt);
    float rsum = 0.f;
#pragma unroll
    for (int st = 0; st < 2; ++st)
#pragma unroll
      for (int r = 0; r < 16; ++r) { const float w = __expf(dl[st][r] - mt); sa[st][r] *= w; rsum += sa[st][r]; }
    rsum = sum_xor32(rsum);
    float qn = 0.f;
#pragma unroll
    for (int i = 0; i < 4; ++i) {
      const int d0 = hi * 32 + i * 8;
      const u32x4 qa = *(const u32x4*)(Qs + t * MLP + d0 * 2);
      const f32x4 n0 = *(const f32x4*)(Ns + dir * 64 + d0), n1 = *(const f32x4*)(Ns + dir * 64 + d0 + 4);
      qn += bflo(qa.x) * n0.x + bfhi(qa.x) * n0.y + bflo(qa.y) * n0.z + bfhi(qa.y) * n0.w + bflo(qa.z) * n1.x + bfhi(qa.z) * n1.y + bflo(qa.w) * n1.z + bfhi(qa.w) * n1.w;
    }
    qn = sum_xor32(qn);
    const float den = rsum + iw * qn;
    const float rden = 1.f / fmaxf(fabsf(den), __expf(-mt));
    f32x16 an = {}, ac = {};
#pragma unroll
    for (int st = 0; st < 2; ++st)
#pragma unroll
      for (int k2 = 0; k2 < 2; ++k2) {
        u32x4 bx; bx.x = cvtpk(sa[st][8 * k2 + 0], sa[st][8 * k2 + 1]); bx.y = cvtpk(sa[st][8 * k2 + 2], sa[st][8 * k2 + 3]);
        bx.z = cvtpk(sa[st][8 * k2 + 4], sa[st][8 * k2 + 5]); bx.w = cvtpk(sa[st][8 * k2 + 6], sa[st][8 * k2 + 7]);
        const unsigned char* vrow = VT + (et * 32 + r32) * MLP + (st * 32 + 16 * k2 + 4 * hi) * 2;
        const u32x2 v0 = *(const u32x2*)vrow, v1 = *(const u32x2*)(vrow + 16);
        u32x4 ax; ax.x = v0.x; ax.y = v0.y; ax.z = v1.x; ax.w = v1.y;
        an = __builtin_amdgcn_mfma_f32_32x32x16_bf16(*(const bf16x8*)&ax, *(const bf16x8*)&bx, an, 0, 0, 0);
      }
    const unsigned char* Cd = Cs + dir * 64 * MLP;
#pragma unroll
    for (int ks = 0; ks < 4; ++ks) {
      const bf16x8 a = *(const bf16x8*)(Cd + (et * 32 + r32) * MLP + (ks * 16 + hi * 8) * 2);
      ac = __builtin_amdgcn_mfma_f32_32x32x16_bf16(a, bq[ks], ac, 0, 0, 0);
    }
#pragma unroll
    for (int r = 0; r < 16; ++r) HB[dir * 64 * 65 + t * 65 + et * 32 + crow(r, hi)] = (an[r] + iw * ac[r]) * rden;
  }
  __syncthreads();
  {
    const int t = tid >> 3, e8 = (tid & 7) * 8;
    float v[8]; float ss = 0.f;
#pragma unroll
    for (int i = 0; i < 8; ++i) { v[i] = HB[t * 65 + e8 + i] + HB[64 * 65 + t * 65 + e8 + i]; ss += v[i] * v[i]; }
    ss += dpp_mov<0xB1>(ss); ss += dpp_mov<0x4E>(ss); ss += dpp_mov<0x141>(ss);
    const float rs = rsqrtf(ss * (1.f / 64.f) + EPS);
    const float og[8] = {bflo(ov.x), bfhi(ov.x), bflo(ov.y), bfhi(ov.y), bflo(ov.z), bfhi(ov.z), bflo(ov.w), bfhi(ov.w)};
    const float* g = p.in[I_MNORMG] + l * 64 + e8;
    float o[8];
#pragma unroll
    for (int i = 0; i < 8; ++i) o[i] = (ABL & 2) ? 0.f : v[i] * rs * g[i] * sigmoidf_(og[i]);
    u32x4 w; w.x = cvtpk(o[0], o[1]); w.y = cvtpk(o[2], o[3]); w.z = cvtpk(o[4], o[5]); w.w = cvtpk(o[6], o[7]);
    *(u32x4*)(MIX + (size_t)(row0 + t) * DM + 256 + hh * 64 + e8) = w;
  }
  __syncthreads();
}

#define KSWZ(row, colB) ((row) * 256 + ((colB) ^ (((row) & 15) << 4)))
#define SBAR() __builtin_amdgcn_sched_barrier(0)
constexpr int ATT_SHM_V = 128 * 80, ATT_SHM_K = 64 * QK8_PITCH;
constexpr float ATT_THR = 8.0f;
__device__ __forceinline__ int v_st(int k, int c) { const int kk = (k & ~0xC) | ((k & 4) << 1) | ((k & 8) >> 1); return ((kk >> 3) * 4 + (c >> 5)) * 512 + ((kk & 7) * 32 + (c & 31)) * 2; }
__device__ __forceinline__ int v_rd_base(int lane) { return ((lane & 3) << 3) | (((lane >> 2) & 3) << 6) | (((lane >> 4) & 1) << 5) | (((lane >> 5) & 1) << 8); }
constexpr int v_rd_off(int d0, int ks, int half) { return d0 * 512 + ks * 4096 + half * 2048; }
template <int OFF> __device__ __forceinline__ s16x4 tr_read(int vb) {
  s16x4 r; asm volatile("ds_read_b64_tr_b16 %0, %1 offset:%2" : "=&v"(r) : "v"(vb), "i"(OFF) : "memory"); return r;
}
template <int D0> __device__ __forceinline__ void pv_one(f32x16& od, int vb, bf16x8 pa0, bf16x8 pa1, bf16x8 pa2, bf16x8 pa3) {
  const s16x4 l0 = tr_read<v_rd_off(D0, 0, 0)>(vb), h0 = tr_read<v_rd_off(D0, 0, 1)>(vb), l1 = tr_read<v_rd_off(D0, 1, 0)>(vb), h1 = tr_read<v_rd_off(D0, 1, 1)>(vb);
  const s16x4 l2 = tr_read<v_rd_off(D0, 2, 0)>(vb), h2 = tr_read<v_rd_off(D0, 2, 1)>(vb), l3 = tr_read<v_rd_off(D0, 3, 0)>(vb), h3 = tr_read<v_rd_off(D0, 3, 1)>(vb);
  asm volatile("s_waitcnt lgkmcnt(0)" ::: "memory"); SBAR();
#define PK(L, H) (bf16x8){L[0], L[1], L[2], L[3], H[0], H[1], H[2], H[3]}
  od = __builtin_amdgcn_mfma_f32_32x32x16_bf16(pa0, PK(l0, h0), od, 0, 0, 0);
  od = __builtin_amdgcn_mfma_f32_32x32x16_bf16(pa1, PK(l1, h1), od, 0, 0, 0);
  od = __builtin_amdgcn_mfma_f32_32x32x16_bf16(pa2, PK(l2, h2), od, 0, 0, 0);
  od = __builtin_amdgcn_mfma_f32_32x32x16_bf16(pa3, PK(l3, h3), od, 0, 0, 0);
#undef PK
}
template <int D0> __device__ __forceinline__ void pv_two(f32x16& oa, f32x16& ob, int vb, bf16x8 a0, bf16x8 a1, bf16x8 a2, bf16x8 a3, bf16x8 b0, bf16x8 b1, bf16x8 b2, bf16x8 b3) {
  const s16x4 l0 = tr_read<v_rd_off(D0, 0, 0)>(vb), h0 = tr_read<v_rd_off(D0, 0, 1)>(vb), l1 = tr_read<v_rd_off(D0, 1, 0)>(vb), h1 = tr_read<v_rd_off(D0, 1, 1)>(vb);
  const s16x4 l2 = tr_read<v_rd_off(D0, 2, 0)>(vb), h2 = tr_read<v_rd_off(D0, 2, 1)>(vb), l3 = tr_read<v_rd_off(D0, 3, 0)>(vb), h3 = tr_read<v_rd_off(D0, 3, 1)>(vb);
  asm volatile("s_waitcnt lgkmcnt(0)" ::: "memory"); SBAR();
#define PK(L, H) (bf16x8){L[0], L[1], L[2], L[3], H[0], H[1], H[2], H[3]}
  const bf16x8 v0 = PK(l0, h0), v1 = PK(l1, h1), v2 = PK(l2, h2), v3 = PK(l3, h3);
  oa = __builtin_amdgcn_mfma_f32_32x32x16_bf16(a0, v0, oa, 0, 0, 0);
  ob = __builtin_amdgcn_mfma_f32_32x32x16_bf16(b0, v0, ob, 0, 0, 0);
  oa = __builtin_amdgcn_mfma_f32_32x32x16_bf16(a1, v1, oa, 0, 0, 0);
  ob = __builtin_amdgcn_mfma_f32_32x32x16_bf16(b1, v1, ob, 0, 0, 0);
  oa = __builtin_amdgcn_mfma_f32_32x32x16_bf16(a2, v2, oa, 0, 0, 0);
  ob = __builtin_amdgcn_mfma_f32_32x32x16_bf16(b2, v2, ob, 0, 0, 0);
  oa = __builtin_amdgcn_mfma_f32_32x32x16_bf16(a3, v3, oa, 0, 0, 0);
  ob = __builtin_amdgcn_mfma_f32_32x32x16_bf16(b3, v3, ob, 0, 0, 0);
#undef PK
}
struct KQFrag { bf16x8 b0, b1, q; };
__device__ __forceinline__ void att_ldkq(KQFrag& f, const LAS unsigned char* l3, int akk, int akq) {
  const LAS unsigned char* kp = l3 + akk;
  f.b0 = *(const LAS bf16x8*)kp; f.b1 = *(const LAS bf16x8*)(kp + 8192); f.q = *(const LAS bf16x8*)(l3 + akq);
}
#define ATT_MF(pa_, pb_, f_) do { pa_ = __builtin_amdgcn_mfma_f32_32x32x16_bf16(f_.b0, f_.q, pa_, 0, 0, 0); pb_ = __builtin_amdgcn_mfma_f32_32x32x16_bf16(f_.b1, f_.q, pb_, 0, 0, 0); } while (0)
__device__ __forceinline__ void att_qk_all(f32x16& p0, f32x16& p1, f32x16& q0, f32x16& q1, KQFrag& f0, const LAS unsigned char* l3, int akk0, int akq0, float ia, float ib) {
  KQFrag f1;
#pragma unroll
  for (int r = 0; r < 16; ++r) { p0[r] = ia; p1[r] = ia; q0[r] = ib; q1[r] = ib; }
  att_ldkq(f1, l3, akk0 ^ (1 << 5), akq0 ^ (1 << 5)); ATT_MF(p0, p1, f0); SBAR();
  att_ldkq(f0, l3, akk0 ^ (2 << 5), akq0 ^ (2 << 5)); ATT_MF(p0, p1, f1); SBAR();
  att_ldkq(f1, l3, akk0 ^ (3 << 5), akq0 ^ (3 << 5)); ATT_MF(p0, p1, f0); SBAR();
  att_ldkq(f0, l3, akk0 ^ (4 << 5), akq0 ^ (4 << 5)); ATT_MF(p0, p1, f1); SBAR();
  att_ldkq(f1, l3, akk0 ^ (5 << 5), akq0 ^ (5 << 5)); ATT_MF(q0, q1, f0); SBAR();
  att_ldkq(f0, l3, akk0 ^ (6 << 5), akq0 ^ (6 << 5)); ATT_MF(q0, q1, f1); SBAR();
  att_ldkq(f1, l3, akk0 ^ (7 << 5), akq0 ^ (7 << 5)); ATT_MF(q0, q1, f0); SBAR();
  ATT_MF(q0, q1, f1); SBAR();
}
__device__ __forceinline__ void att_softmax(f32x16& p0, f32x16& p1, float& m_reg, float& l_reg, float& alpha, bool first, i32x8& pa) {
  alpha = 1.f;
  if (first) {
    float pmax = p0[0];
#pragma unroll
    for (int r = 1; r < 16; ++r) pmax = fmaxf(pmax, p0[r]);
#pragma unroll
    for (int r = 0; r < 16; ++r) pmax = fmaxf(pmax, p1[r]);
    { auto rr = __builtin_amdgcn_permlane32_swap(__float_as_uint(pmax), __float_as_uint(pmax), false, false);
      pmax = fmaxf(__uint_as_float(rr[0]), __uint_as_float(rr[1])); }
    alpha = 0.f; m_reg = pmax;
#pragma unroll
    for (int r = 0; r < 16; ++r) { p0[r] -= pmax; p1[r] -= pmax; }
  }
#pragma unroll
  for (int r = 0; r < 16; ++r) { p0[r] = __builtin_amdgcn_exp2f(p0[r]); p1[r] = __builtin_amdgcn_exp2f(p1[r]); }
  float ps;
  {
#define VADD(d_, a_, b_) asm("v_add_f32_e32 %0, %1, %2" : "=v"(d_) : "v"(a_), "v"(b_))
    float s0, s1, s2, s3;
    VADD(s0, p0[0], p0[1]); VADD(s1, p0[8], p0[9]); VADD(s2, p1[0], p1[1]); VADD(s3, p1[8], p1[9]);
#pragma unroll
    for (int r = 2; r < 8; ++r) { VADD(s0, s0, p0[r]); VADD(s1, s1, p0[8 + r]); VADD(s2, s2, p1[r]); VADD(s3, s3, p1[8 + r]); }
    VADD(s0, s0, s1); VADD(s2, s2, s3); VADD(ps, s0, s2);
#undef VADD
  }
  { auto rr = __builtin_amdgcn_permlane32_swap(__float_as_uint(ps), __float_as_uint(ps), false, false);
    ps = __uint_as_float(rr[0]) + __uint_as_float(rr[1]); }
  if (__builtin_expect(!first && __any(ps > 256.f), 0)) {
    float emax = p0[0];
#pragma unroll
    for (int r = 1; r < 16; ++r) emax = fmaxf(emax, p0[r]);
#pragma unroll
    for (int r = 0; r < 16; ++r) emax = fmaxf(emax, p1[r]);
    { auto rr = __builtin_amdgcn_permlane32_swap(__float_as_uint(emax), __float_as_uint(emax), false, false);
      emax = fmaxf(__uint_as_float(rr[0]), __uint_as_float(rr[1])); }
    const float delta = fmaxf(__builtin_amdgcn_logf(emax), 0.f);
    alpha = __builtin_amdgcn_exp2f(-delta); m_reg += delta;
#pragma unroll
    for (int r = 0; r < 16; ++r) { p0[r] *= alpha; p1[r] *= alpha; }
    ps *= alpha;
  }
  l_reg = l_reg * alpha + ps;
#pragma unroll
  for (int v = 0; v < 4; ++v) {
    int w0, w1; asm volatile("" : "=v"(w0), "=v"(w1));
    w0 = __builtin_amdgcn_cvt_pk_fp8_f32(p0[4 * v], p0[4 * v + 1], w0, false); w0 = __builtin_amdgcn_cvt_pk_fp8_f32(p0[4 * v + 2], p0[4 * v + 3], w0, true);
    w1 = __builtin_amdgcn_cvt_pk_fp8_f32(p1[4 * v], p1[4 * v + 1], w1, false); w1 = __builtin_amdgcn_cvt_pk_fp8_f32(p1[4 * v + 2], p1[4 * v + 3], w1, true);
    pa[v] = w0; pa[4 + v] = w1;
  }
}
__device__ __forceinline__ void att_unit(const unsigned char* __restrict__ Q8, const unsigned char* __restrict__ K8, const unsigned char* __restrict__ V8, bf16_t* __restrict__ Ob,
                                         int nkeys, float lam, const float* __restrict__ ng, float oscale, unsigned char* lds) {
  int tid_ = tidx(); asm volatile("" : "+v"(tid_)); const int tid = tid_, wid = tid >> 6, lane = tid & 63, r32 = lane & 31, hi = lane >> 5;
  const int grp = __builtin_amdgcn_readfirstlane(wid >> 2);
  unsigned char* V_lds = lds; unsigned char* K_lds = lds + 2 * ATT_SHM_V;
  float* wsl = (float*)(lds + 2 * ATT_SHM_V + 2 * ATT_SHM_K) + wid * 64; float* li_l = wsl; float* al_l = wsl + 32;
  float m0 = 0.f, l0 = 0.f, m1 = 0.f, l1 = 0.f;
  f32x16 o0[4] = {}, o1[4] = {};
  unsigned char* Q_lds = lds + 2 * ATT_SHM_V + 2 * ATT_SHM_K + 2048;
#pragma unroll
  for (int i = 0; i < 5; ++i) { const int piece = __builtin_amdgcn_readfirstlane(wid) + 8 * i;
    if (piece < 36) __builtin_amdgcn_global_load_lds((const unsigned*)(Q8 + piece * 1024 + lane * 16), (LAS unsigned*)(Q_lds + piece * 1024), 16, 0, 0); }
  const unsigned ldsw = (unsigned)__builtin_amdgcn_readfirstlane(wid) * 1024u;
#define GSTAGE_K(b, k0) do { const unsigned char* ki_ = K8 + (size_t)(k0) * QK8_PITCH + tid * 16; \
      __builtin_amdgcn_global_load_lds((const unsigned*)ki_, (LAS unsigned*)(K_lds + (b) * ATT_SHM_K + ldsw), 16, 0, 0); \
      if (wid < 1) __builtin_amdgcn_global_load_lds((const unsigned*)(ki_ + 8192), (LAS unsigned*)(K_lds + (b) * ATT_SHM_K + 8192 + ldsw), 16, 0, 0); } while (0)
#define GSTAGE_V(b, k0) do { const unsigned char* vi_ = V8 + (size_t)((k0) >> 6) * ATT_SHM_V + tid * 16; \
      __builtin_amdgcn_global_load_lds((const unsigned*)vi_, (LAS unsigned*)(V_lds + (b) * ATT_SHM_V + ldsw), 16, 0, 0); \
      if (wid < 2) __builtin_amdgcn_global_load_lds((const unsigned*)(vi_ + 8192), (LAS unsigned*)(V_lds + (b) * ATT_SHM_V + 8192 + ldsw), 16, 0, 0); } while (0)
#define STAGE_PAIR(jj) do { GSTAGE_V((jj) & 1, (jj) * 64); if ((jj) + 1 < NT) GSTAGE_K((jj) & 1, ((jj) + 1) * 64); } while (0)
#define RESC(o, a) do { if (__any((a) < 1.f)) { if (hi == 0) al_l[r32] = (a); asm volatile("s_waitcnt lgkmcnt(0)" ::: "memory"); \
    _Pragma("unroll") for (int d = 0; d < 4; ++d) _Pragma("unroll") for (int r = 0; r < 16; ++r) o[d][r] *= al_l[crow(r, hi)]; } } while (0)
#define ATT_BAR() do { asm volatile("s_waitcnt lgkmcnt(0)" ::: "memory"); __builtin_amdgcn_s_barrier(); asm volatile("" ::: "memory"); } while (0)
#define ATT_LDK(dst_, off_) do { const u32x4 x0_ = *(const LAS u32x4*)(kb_ + (off_)), x1_ = *(const LAS u32x4*)(kb_ + (off_) + 16); \
      dst_[0] = (int)x0_.x; dst_[1] = (int)x0_.y; dst_[2] = (int)x0_.z; dst_[3] = (int)x0_.w; dst_[4] = (int)x1_.x; dst_[5] = (int)x1_.y; dst_[6] = (int)x1_.z; dst_[7] = (int)x1_.w; } while (0)
#define ATT_SC(acc_, kf_, qf_) acc_ = __builtin_amdgcn_mfma_scale_f32_32x32x64_f8f6f4(kf_, qf_, acc_, 0, 0, 0, 0x7F7F7F7F, 0, 0x7F7F7F7F)
#define ATT_LDQ(dst_, off_) do { const u32x4 x0_ = *(const LAS u32x4*)(qb_ + (off_)), x1_ = *(const LAS u32x4*)(qb_ + (off_) + 16); \
      dst_[0] = (int)x0_.x; dst_[1] = (int)x0_.y; dst_[2] = (int)x0_.z; dst_[3] = (int)x0_.w; dst_[4] = (int)x1_.x; dst_[5] = (int)x1_.y; dst_[6] = (int)x1_.z; dst_[7] = (int)x1_.w; } while (0)
#define ATT_QK_ALL(ia_, ib_) do { _Pragma("unroll") for (int r = 0; r < 16; ++r) { p0[r] = (ia_); p1[r] = (ia_); q0[r] = (ib_); q1[r] = (ib_); } \
      ATT_SC(p0, kf0, qf); SBAR(); ATT_LDK(kf0, 32 * QK8_PITCH); SBAR(); \
      ATT_SC(p1, kf0, qf); SBAR(); ATT_LDK(kf0, 64); ATT_LDQ(qf, 64); SBAR(); \
      ATT_SC(q0, kf0, qf); SBAR(); ATT_LDK(kf0, 32 * QK8_PITCH + 64); SBAR(); \
      ATT_SC(q1, kf0, qf); SBAR(); } while (0)
  const int NT = nkeys / 64;
  GSTAGE_K(1, 0); STAGE_PAIR(0);
  asm volatile("s_waitcnt vmcnt(0)" ::: "memory"); __syncthreads();
  f32x16 p0, p1, q0, q1; i32x8 pa, pb;
  const LAS unsigned char* l3 = (const LAS unsigned char*)lds;
  const int kofs0 = 2 * ATT_SHM_V + r32 * QK8_PITCH + hi * 32;
  const int qofs0 = 2 * ATT_SHM_V + 2 * ATT_SHM_K + 2048 + (__builtin_amdgcn_readfirstlane(wid) * 32 + r32) * QK8_PITCH + hi * 32;
  { i32x8 kf0, qf; const LAS unsigned char* kb_ = l3 + (kofs0 + ATT_SHM_K); const LAS unsigned char* qb_ = l3 + qofs0;
    ATT_LDK(kf0, 0); ATT_LDQ(qf, 0);
    ATT_QK_ALL(0.f, 0.f); }
  if (grp) ATT_BAR();
#pragma unroll 1
  for (int j = 0; j < NT; ++j) {
    const int cur = j & 1;
    const bool more = (j + 1 < NT);
    if (grp && more) STAGE_PAIR(j + 1);
    { float alphaA, alphaB;
      const bool first = (j == 0);
      att_softmax(p0, p1, m0, l0, alphaA, first, pa); SBAR();
      att_softmax(q0, q1, m1, l1, alphaB, first, pb); SBAR();
      RESC(o0, alphaA);
      RESC(o1, alphaB); }
    asm volatile("" : "+v"(pa), "+v"(pb), "+v"(m0), "+v"(l0), "+v"(m1), "+v"(l1));
    asm volatile("" : "+v"(o0[0]), "+v"(o0[1]), "+v"(o0[2]), "+v"(o0[3]), "+v"(o1[0]), "+v"(o1[1]), "+v"(o1[2]), "+v"(o1[3]));
    if (!grp) asm volatile("s_waitcnt vmcnt(0)" ::: "memory");
    ATT_BAR();
    if (!grp && more) STAGE_PAIR(j + 1);
    __builtin_amdgcn_s_setprio(1);
    {
      int kofs = kofs0, qofs = qofs0; asm volatile("" : "+v"(kofs), "+v"(qofs));
      const LAS unsigned char* kb_ = l3 + (kofs + cur * ATT_SHM_K); const LAS unsigned char* qb_ = l3 + qofs;
      i32x8 kf0, qf;
      const LAS unsigned char* vrow = l3 + (r32 * 80 + hi * 32 + cur * ATT_SHM_V);
      u32x4 va0 = *(const LAS u32x4*)vrow, va1 = *(const LAS u32x4*)(vrow + 16), vb0, vb1;
#define ATT_PV(d0_, x0_, x1_) do { i32x8 bv; bv[0] = (int)x0_.x; bv[1] = (int)x0_.y; bv[2] = (int)x0_.z; bv[3] = (int)x0_.w; bv[4] = (int)x1_.x; bv[5] = (int)x1_.y; bv[6] = (int)x1_.z; bv[7] = (int)x1_.w; \
        o0[d0_] = __builtin_amdgcn_mfma_scale_f32_32x32x64_f8f6f4(pa, bv, o0[d0_], 0, 0, 0, 0x7F7F7F7F, 0, 0x7F7F7F7F); \
        o1[d0_] = __builtin_amdgcn_mfma_scale_f32_32x32x64_f8f6f4(pb, bv, o1[d0_], 0, 0, 0, 0x7F7F7F7F, 0, 0x7F7F7F7F); } while (0)
      vb0 = *(const LAS u32x4*)(vrow + 32 * 80); vb1 = *(const LAS u32x4*)(vrow + 32 * 80 + 16); ATT_PV(0, va0, va1); SBAR();
      va0 = *(const LAS u32x4*)(vrow + 64 * 80); va1 = *(const LAS u32x4*)(vrow + 64 * 80 + 16); ATT_PV(1, vb0, vb1); SBAR();
      vb0 = *(const LAS u32x4*)(vrow + 96 * 80); vb1 = *(const LAS u32x4*)(vrow + 96 * 80 + 16); ATT_PV(2, va0, va1); SBAR();
      ATT_LDK(kf0, 0); ATT_LDQ(qf, 0);
      ATT_PV(3, vb0, vb1); SBAR();
#undef ATT_PV
      asm volatile("" : "+v"(o0[0]), "+v"(o0[1]), "+v"(o0[2]), "+v"(o0[3]), "+v"(o1[0]), "+v"(o1[1]), "+v"(o1[2]), "+v"(o1[3]));
      ATT_QK_ALL(-m0, -m1);
      asm volatile("" : "+v"(p0), "+v"(p1), "+v"(q0), "+v"(q1));
    }
    __builtin_amdgcn_s_setprio(0);
    if (grp) asm volatile("s_waitcnt vmcnt(0)" ::: "memory");
    ATT_BAR();
  }
  if (!grp) ATT_BAR();
  if (hi == 0) { li_l[r32] = 1.f / l0; al_l[r32] = lam / l1; }
  asm volatile("s_waitcnt lgkmcnt(0)" ::: "memory");
  float ss[16];
#pragma unroll
  for (int r = 0; r < 16; ++r) {
    const float a = li_l[crow(r, hi)], bq = al_l[crow(r, hi)];
    float s = 0.f;
#pragma unroll
    for (int d = 0; d < 4; ++d) { const float v = o0[d][r] * a - o1[d][r] * bq; o0[d][r] = v; s += v * v; }
    s += dpp_mov<0xB1>(s); s += dpp_mov<0x4E>(s); s += dpp_mov<0x141>(s); s += dpp_mov<0x140>(s);
    { auto rr_ = __builtin_amdgcn_permlane16_swap(__float_as_uint(s), __float_as_uint(s), false, false); s = __uint_as_float(rr_[0]) + __uint_as_float(rr_[1]); }
    ss[r] = rsqrtf(s * (1.f / 128.f) + EPS) * oscale;
  }
  bf16_t* Ow = Ob + (size_t)(wid * 32) * DM;
  unsigned char* ost = lds + 2 * ATT_SHM_V + 2 * ATT_SHM_K + 2048 + wid * (32 * 272);
#pragma unroll
  for (int d = 0; d < 4; ++d) {
    const float g = ng[d * 32 + r32];
#pragma unroll
    for (int r = 0; r < 16; ++r) *(bf16_t*)(ost + crow(r, hi) * 272 + (d * 32 + r32) * 2) = (ABL & 4) ? (bf16_t)0 : (bf16_t)(cvtpk(o0[d][r] * ss[r] * g, 0.f) & 0xffffu);
  }
  asm volatile("s_waitcnt lgkmcnt(0)" ::: "memory");
#pragma unroll
  for (int i = 0; i < 8; ++i) {
    const int c = lane + 64 * i, row = c >> 4, cb = (c & 15) * 16;
    *(u32x4*)((unsigned char*)(Ow + (size_t)row * DM) + cb) = *(const u32x4*)(ost + row * 272 + cb);
  }
  __syncthreads();
#undef ATT_LDK
#undef ATT_LDQ
#undef ATT_SC
#undef ATT_QK_ALL
#undef GSTAGE_K
#undef GSTAGE_V
#undef STAGE_PAIR
#undef RESC
#undef ATT_BAR
}

__device__ __forceinline__ float ins16(float (&a)[16], float x) {
#pragma unroll
  for (int i = 0; i < 16; ++i) { const float h = fmaxf(a[i], x); x = fminf(a[i], x); a[i] = h; }
  return x;
}
__device__ __forceinline__ void bsort16(float (&a)[16]) {
#pragma unroll
  for (int k = 2; k <= 16; k <<= 1)
#pragma unroll
    for (int j = k >> 1; j > 0; j >>= 1)
#pragma unroll
      for (int i = 0; i < 16; ++i) {
        const int q = i ^ j;
        if (q > i) {
          const bool desc = ((i & k) == 0);
          const float hi_ = fmaxf(a[i], a[q]), lo_ = fminf(a[i], a[q]);
          a[i] = desc ? hi_ : lo_; a[q] = desc ? lo_ : hi_;
        }
      }
}
__device__ __forceinline__ void bmerge16(float (&a)[16], const float (&b)[16]) {
#pragma unroll
  for (int i = 0; i < 16; ++i) a[i] = fmaxf(a[i], b[15 - i]);
#pragma unroll
  for (int j = 8; j > 0; j >>= 1)
#pragma unroll
    for (int i = 0; i < 16; ++i) {
      const int q = i ^ j;
      if (q > i) { const float hi_ = fmaxf(a[i], a[q]), lo_ = fminf(a[i], a[q]); a[i] = hi_; a[q] = lo_; }
    }
}
__device__ __forceinline__ float gelu_erf(float x) { return 0.5f * x * (1.f + erff(x * 0.70710678118654752440f)); }
#define XB_TMO      128
#define XB_XCNT(j)  (256  + 64 * (j))
#define XB_XSUB(j)  (1280 + 64 * (j))
#define XB_XGEN(j)  (2304 + 64 * (j))
#define XB_TOP      3328
#define XB_TOPGEN   3392
#define XCD_BAR_WORDS 3456
#define XB_SPIN_CAP (1u << 22)
__device__ __forceinline__ unsigned xb_ld(unsigned* p)              { return __hip_atomic_load(p, __ATOMIC_RELAXED, __HIP_MEMORY_SCOPE_AGENT); }
__device__ __forceinline__ unsigned xb_add(unsigned* p, unsigned v) { return __hip_atomic_fetch_add(p, v, __ATOMIC_RELAXED, __HIP_MEMORY_SCOPE_AGENT); }
__device__ __forceinline__ unsigned xb_xcc_id() { return (unsigned)__builtin_amdgcn_s_getreg((3 << 11) | 20) & 0xFu; }
#define XB_SPIN(cond, bar) do { unsigned _sp = 0; while (cond) { __builtin_amdgcn_s_sleep(1); \
    if ((++_sp & 255u) == 0u) { if (xb_ld(&(bar)[XB_TMO])) break; if (_sp > XB_SPIN_CAP) { atomicAdd(&(bar)[XB_TMO], 1u); break; } } } } while (0)
struct XcdBarrier { unsigned* bar; unsigned x; volatile LAS unsigned* st; };
__device__ __forceinline__ XcdBarrier xcd_barrier_post(unsigned* bar, volatile LAS unsigned* st) {
  XcdBarrier b; b.bar = bar; b.x = xb_xcc_id(); b.st = st;
  if (tidx() == 0) (void)xb_add(&bar[XB_XCNT(b.x)], 1u);
  return b;
}
__device__ __forceinline__ void xcd_barrier_complete(unsigned* bar, unsigned x, unsigned& nloc, unsigned& nx) {
  const unsigned G = gridDim.x * gridDim.y * gridDim.z;
  unsigned sum, cnt, mine, sp = 0u;
  for (;;) {
    sum = 0u; cnt = 0u; mine = 0u;
#pragma unroll
    for (unsigned j = 0; j < 16; ++j) { const unsigned c = xb_ld(&bar[XB_XCNT(j)]); sum += c; cnt += (c > 0u) ? 1u : 0u; mine = (j == x) ? c : mine; }
    if (sum == G) break;
    __builtin_amdgcn_s_sleep(1);
    if ((++sp & 255u) == 0u) { if (xb_ld(&bar[XB_TMO])) break; if (sp > XB_SPIN_CAP) { atomicAdd(&bar[XB_TMO], 1u); break; } }
  }
  nloc = mine > 0u ? mine : 1u; nx = cnt > 0u ? cnt : 1u;
}
__device__ __forceinline__ void xcd_barrier(const XcdBarrier& b) {
  asm volatile("s_waitcnt vmcnt(0)" ::: "memory");
  __syncthreads();
  if (tidx() == 0) {
    unsigned* bar = b.bar;
    __builtin_amdgcn_s_waitcnt(0);
    unsigned nloc = b.st[0], nx = b.st[1];
    if (nloc == 0u) { xcd_barrier_complete(bar, b.x, nloc, nx); b.st[0] = nloc; b.st[1] = nx; }
    const unsigned old = xb_add(&bar[XB_XSUB(b.x)], 1u);
    const unsigned gen = old / nloc;
    if (old + 1u == (gen + 1u) * nloc) {
      __builtin_amdgcn_fence(__ATOMIC_RELEASE, "agent");
      asm volatile("s_waitcnt vmcnt(0)" ::: "memory");
      const unsigned og = xb_add(&bar[XB_TOP], 1u);
      const unsigned tg = og / nx;
      if (og + 1u == (tg + 1u) * nx) xb_add(&bar[XB_TOPGEN], 1u);
      else XB_SPIN(xb_ld(&bar[XB_TOPGEN]) == tg, bar);
      __builtin_amdgcn_fence(__ATOMIC_ACQUIRE, "agent");
      xb_add(&bar[XB_XGEN(b.x)], 1u);
      asm volatile("s_waitcnt vmcnt(0)" ::: "memory");
    } else {
      XB_SPIN(xb_ld(&bar[XB_XGEN(b.x)]) == gen, bar);
      __builtin_amdgcn_fence(__ATOMIC_ACQUIRE, "agent");
      asm volatile("s_waitcnt vmcnt(0)" ::: "memory");
    }
  }
  __syncthreads();
}

constexpr size_t RT_STRIDE = (size_t)T * 128 * 4;
__device__ __forceinline__ void route_unit(const Params& p, int l, int unit, unsigned char* lds) {
  int tid_ = tidx(); asm volatile("" : "+v"(tid_)); const int tid = tid_, lane = tid & 63, wid = tid >> 6, r32 = lane & 31, hi = lane >> 5;
  unsigned char* IDX = lds;
  int* UE = (int*)(lds + 8192); float* UG = (float*)(lds + 8192 + 16384); float* US = (float*)(lds + 8192 + 32768);
  int* EIDG = (int*)(p.ws + WS_EID + (size_t)l * RT_STRIDE); float* GWG = (float*)(p.ws + WS_ULOC + RT_STRIDE); float* SUG = (float*)(p.ws + WS_ULOC + 2 * RT_STRIDE);
  const float* PSC = (const float*)(p.ws + WS_PSC);
  const int row0 = unit * 32;
  const bf16_t* QP = (const bf16_t*)(p.ws + WS_PROJ);
  const bf16_t* KEYS = (const bf16_t*)(p.ws + WS_KEYS) + (size_t)l * 131072;
  for (int rrep = 0; rrep < REP_ROUTE; ++rrep) {
    const int h = wid;
    float top[2][16];
#pragma unroll
    for (int pp = 0; pp < 2; ++pp) {
      const bf16_t* qrow = QP + (size_t)(row0 + r32) * DM + h * 128 + pp * 64 + hi * 8;
      const bf16_t* kb = KEYS + ((size_t)(h * 2 + pp) * 128 + r32) * 64 + hi * 8;
      bf16x8 bq[4];
#pragma unroll
      for (int ks = 0; ks < 4; ++ks) bq[ks] = *(const bf16x8*)(qrow + ks * 16);
      float (&lst)[16] = top[pp];
#pragma unroll
      for (int i = 0; i < 16; ++i) lst[i] = -INFINITY;
#pragma unroll
      for (int nt = 0; nt < 4; ++nt) {
        f32x16 acc = {};
#pragma unroll
        for (int ks = 0; ks < 4; ++ks) {
          const bf16x8 ak = *(const bf16x8*)(kb + (size_t)nt * 32 * 64 + ks * 16);
          acc = __builtin_amdgcn_mfma_f32_32x32x16_bf16(ak, bq[ks], acc, 0, 0, 0);
        }
        float grp[16];
#pragma unroll
        for (int r = 0; r < 16; ++r) grp[r] = __uint_as_float((__float_as_uint(acc[r]) & ~0x7Fu) | (unsigned)(nt * 32 + crow(r, hi)));
        bsort16(grp);
        if (nt == 0) {
#pragma unroll
          for (int i = 0; i < 16; ++i) lst[i] = grp[i];
        } else bmerge16(lst, grp);
        SBAR();
      }
      float oth[16];
#pragma unroll
      for (int i = 0; i < 16; ++i) { auto rr_ = __builtin_amdgcn_permlane32_swap(__float_as_uint(lst[i]), __float_as_uint(lst[i]), false, false); oth[i] = __uint_as_float(hi ? rr_[0] : rr_[1]); }
      bmerge16(lst, oth);
      if (hi == 0) {
        unsigned w[4];
#pragma unroll
        for (int i = 0; i < 4; ++i)
          w[i] = (__float_as_uint(lst[4 * i]) & 0x7Fu) | ((__float_as_uint(lst[4 * i + 1]) & 0x7Fu) << 8) | ((__float_as_uint(lst[4 * i + 2]) & 0x7Fu) << 16) | ((__float_as_uint(lst[4 * i + 3]) & 0x7Fu) << 24);
        *(u32x4*)(IDX + ((r32 * 8 + h) * 2 + pp) * 16) = (u32x4){w[0], w[1], w[2], w[3]};
      }
    }
    float best[16];
#define CAND(i, j) __uint_as_float((__float_as_uint(__uint_as_float(__float_as_uint(top[0][i]) & ~0x7Fu) + __uint_as_float(__float_as_uint(top[1][j]) & ~0x7Fu)) & ~0xFFu) | (unsigned)((i) * 16 + (j)))
    {
#pragma unroll
      for (int j = 0; j < 16; ++j) best[j] = CAND(0, j);
      float y[16];
#pragma unroll
      for (int j = 0; j < 8; ++j) { y[j] = CAND(1, j); y[8 + j] = CAND(15 - j, 0); }
#pragma unroll
      for (int jj = 8; jj > 0; jj >>= 1)
#pragma unroll
        for (int i = 0; i < 16; ++i) { const int q = i ^ jj; if (q > i) { const float hi_ = fmaxf(y[i], y[q]), lo_ = fminf(y[i], y[q]); y[i] = hi_; y[q] = lo_; } }
      bmerge16(best, y);
      float x[16];
      x[0] = CAND(2, 0); x[1] = CAND(2, 1); x[2] = CAND(2, 2); x[3] = CAND(2, 3); x[4] = CAND(2, 4);
      x[5] = CAND(3, 0); x[6] = CAND(3, 1); x[7] = CAND(3, 2); x[8] = CAND(3, 3);
      x[9] = CAND(4, 0); x[10] = CAND(4, 1); x[11] = CAND(4, 2);
      x[12] = CAND(5, 0); x[13] = CAND(5, 1); x[14] = CAND(6, 0); x[15] = CAND(6, 1);
      bsort16(x);
      bmerge16(best, x);
      ins16(best, CAND(7, 0)); ins16(best, CAND(7, 1));
    }
#undef CAND
    asm volatile("s_waitcnt lgkmcnt(0)" ::: "memory");
    if (hi == 0) {
      const unsigned char* ib = IDX + ((r32 * 8 + h) * 2) * 16;
      const float mx = __uint_as_float(__float_as_uint(best[0]) & ~0xFFu);
      float w[16]; float sum = 0.f;
#pragma unroll
      for (int k = 0; k < 16; ++k) { w[k] = __expf(__uint_as_float(__float_as_uint(best[k]) & ~0xFFu) - mx); sum += w[k]; }
      const float rsum = 1.f / sum;
      int ee[16]; float su_[16], sv_[16];
#pragma unroll
      for (int k = 0; k < 16; ++k) {
        const unsigned ij = __float_as_uint(best[k]) & 0xFFu;
        ee[k] = (int)ib[ij >> 4] * 128 + (int)ib[16 + (ij & 15)];
      }
#pragma unroll
      for (int k = 0; k < 16; ++k) { su_[k] = PSC[(size_t)l * NEXP + ee[k]]; sv_[k] = PSC[(size_t)(DEPTH + l) * NEXP + ee[k]]; }
#pragma unroll
      for (int k = 0; k < 16; ++k) {
        UE[r32 * 128 + h * 16 + k] = ee[k]; UG[r32 * 128 + h * 16 + k] = w[k] * rsum * sv_[k];
        US[r32 * 128 + h * 16 + k] = su_[k];
      }
    }
  }
  __syncthreads();
#pragma unroll 1
  for (int tt = 0; tt < 4; ++tt) {
    const int t = wid * 4 + tt;
    const int k0 = UE[t * 128 + lane], k1 = UE[t * 128 + 64 + lane];
    const float g0 = UG[t * 128 + lane], g1 = UG[t * 128 + 64 + lane], s0 = US[t * 128 + lane], s1 = US[t * 128 + 64 + lane];
    const int b0 = k0 >> 10, b1 = k1 >> 10;
    int base = 0, pos0 = 0, pos1 = 0;
#pragma unroll
    for (int b = 0; b < 16; ++b) {
      const unsigned long long m0 = __ballot(b0 == b), m1 = __ballot(b1 == b);
      const int c0 = __popcll(m0), c1 = __popcll(m1);
      const unsigned long long lt = (1ull << lane) - 1ull;
      if (b0 == b) pos0 = base + __popcll(m0 & lt);
      if (b1 == b) pos1 = base + c0 + __popcll(m1 & lt);
      base += c0 + c1;
    }
    const size_t ro = (size_t)(row0 + t) * 128;
    EIDG[ro + pos0] = k0; GWG[ro + pos0] = g0; SUG[ro + pos0] = s0;
    EIDG[ro + pos1] = k1; GWG[ro + pos1] = g1; SUG[ro + pos1] = s1;
  }
}
#define CAS __attribute__((address_space(4)))
typedef int i32x8 __attribute__((ext_vector_type(8)));
struct TokPref { f32x2 gs0, gs1; u32x4 hA, hB; };
struct RowPipe { i32x6 uq[4], vq[4]; i32x8 Ec; };
struct EpiVec { f32x4 g2[4], ng[4], sc[4], sh[4]; int mr; };
__device__ __forceinline__ const CAS i32x8* eid_row(const CAS unsigned char* eidg, int row) {
  return (const CAS i32x8*)(eidg + (size_t)(unsigned)__builtin_amdgcn_readfirstlane(row) * 512u);
}
__device__ __forceinline__ void tok_prefetch(const Params& p, int row, int lane, TokPref& t) {
  const float* GWG = (const float*)(p.ws + WS_ULOC + RT_STRIDE) + (size_t)row * 128;
  const float* SUG = (const float*)(p.ws + WS_ULOC + 2 * RT_STRIDE) + (size_t)row * 128;
  const bf16_t* H = (const bf16_t*)(p.ws + WS_H);
  t.gs0 = f32x2{GWG[lane], SUG[lane]}; t.gs1 = f32x2{GWG[64 + lane], SUG[64 + lane]};
  t.hA = *(const u32x4*)(H + (size_t)row * DM + lane * 16); t.hB = *(const u32x4*)(H + (size_t)row * DM + lane * 16 + 8);
}
#define LOADPAIR(dst_, tofs_, ea_, eb_) do { const u32x3v a_ = __builtin_amdgcn_raw_buffer_load_b96(rsT, lane12, (ea_) * PROW + (tofs_), 0); const unsigned b0_ = __builtin_amdgcn_raw_buffer_load_b32(rsT, lane12, (eb_) * PROW + (tofs_), 0); \
      const u32x2v b1_ = __builtin_amdgcn_raw_buffer_load_b64(rsT, lane12 + 4, (eb_) * PROW + (tofs_), 0); \
      dst_[0] = (int)a_.x; dst_[1] = (int)a_.y; dst_[2] = (int)a_.z; dst_[3] = (int)b0_; dst_[4] = (int)b1_.x; dst_[5] = (int)b1_.y; } while (0)
#define LOADGROUP(q_, tofs_, E_) do { LOADPAIR(q_[0], tofs_, E_[0], E_[1]); LOADPAIR(q_[1], tofs_, E_[2], E_[3]); LOADPAIR(q_[2], tofs_, E_[4], E_[5]); LOADPAIR(q_[3], tofs_, E_[6], E_[7]); } while (0)
constexpr int VOFS = (int)(WS_PV - WS_PU);
__device__ __forceinline__ void gather_token(const Params& p, const CAS unsigned char* eidg, const __amdgpu_buffer_rsrc_t rsT, int l, int row, int nextrow, TokPref& tp, RowPipe& rp, EpiVec& ev, unsigned char* lds, int lane, int wid) {
  f32x2* GS = (f32x2*)(lds + wid * 2048);
  float* XC = (float*)(p.ws + WS_XCUR);
  const float* MOD = (const float*)(p.ws + WS_MOD);
  const CAS i32x8* EP = eid_row(eidg, row);
  const bool hasnext = nextrow >= 0;
  const CAS i32x8* EPn = eid_row(eidg, hasnext ? nextrow : row);
  GS[lane] = tp.gs0; GS[64 + lane] = tp.gs1;
  asm volatile("s_waitcnt lgkmcnt(0)" ::: "memory");
  const int eofl = ((lane >> 5) & 1) + 2 * ((lane >> 4) & 1) + 4 * ((lane >> 3) & 1);
  const int lane12 = lane * 12;
  {
    h16x2 hh[8];
    {
      const u32x4 hA = tp.hA, hB = tp.hB;
      hh[0] = __builtin_bit_cast(h16x2, __builtin_amdgcn_cvt_pkrtz(bflo(hA.x), bfhi(hA.x))); hh[1] = __builtin_bit_cast(h16x2, __builtin_amdgcn_cvt_pkrtz(bflo(hA.y), bfhi(hA.y))); hh[2] = __builtin_bit_cast(h16x2, __builtin_amdgcn_cvt_pkrtz(bflo(hA.z), bfhi(hA.z))); hh[3] = __builtin_bit_cast(h16x2, __builtin_amdgcn_cvt_pkrtz(bflo(hA.w), bfhi(hA.w)));
      hh[4] = __builtin_bit_cast(h16x2, __builtin_amdgcn_cvt_pkrtz(bflo(hB.x), bfhi(hB.x))); hh[5] = __builtin_bit_cast(h16x2, __builtin_amdgcn_cvt_pkrtz(bflo(hB.y), bfhi(hB.y))); hh[6] = __builtin_bit_cast(h16x2, __builtin_amdgcn_cvt_pkrtz(bflo(hB.z), bfhi(hB.z))); hh[7] = __builtin_bit_cast(h16x2, __builtin_amdgcn_cvt_pkrtz(bflo(hB.w), bfhi(hB.w)));
    }
    if (hasnext) tok_prefetch(p, nextrow, lane, tp);
    { const int mr_ = mod_row(row);
      if (mr_ != ev.mr) {
        const float* g2_ = MOD + ((size_t)l * 5 + mr_) * 6144 + 5 * 1024 + lane * 16;
        const float* ng_ = (l == DEPTH - 1 ? p.in[I_FINALG] : p.in[I_N1G] + (l + 1) * DM) + lane * 16;
        const float* m_ = MOD + ((size_t)(l == DEPTH - 1 ? l : l + 1) * 5 + mr_) * 6144 + lane * 16;
#pragma unroll
        for (int v4 = 0; v4 < 4; ++v4) { ev.g2[v4] = *(const f32x4*)(g2_ + v4 * 4); ev.ng[v4] = *(const f32x4*)(ng_ + v4 * 4); ev.sc[v4] = *(const f32x4*)(m_ + 1024 + v4 * 4); ev.sh[v4] = *(const f32x4*)(m_ + v4 * 4); }
        ev.mr = mr_;
      } }
    f32x4 xpre[4];
    { const float* xr_ = XC + (size_t)row * DM + lane * 16;
#pragma unroll
      for (int v4 = 0; v4 < 4; ++v4) xpre[v4] = *(const f32x4*)(xr_ + v4 * 4); }
    f32x2 acc2[8];
#pragma unroll
    for (int i = 0; i < 8; ++i) acc2[i] = f32x2{0.f, 0.f};
#pragma unroll 1
    for (int g8 = 0; g8 < 16; ++g8) {
      const bool pf = (g8 < 15) || hasnext;
      const f32x2 gs = GS[g8 * 8 + eofl];
      float d[8];
#pragma unroll
      for (int i2 = 0; i2 < 4; ++i2) {
        const h16x32 r = __builtin_amdgcn_cvt_scalef32_pk32_f16_fp6(rp.uq[i2], 1.0f);
        float a0 = 0.f, a1 = 0.f, b0 = 0.f, b1 = 0.f;
#define UDOT(k_) a0 = __builtin_amdgcn_fdot2(__builtin_shufflevector(r, r, 4 * (k_), 4 * (k_) + 1), hh[2 * (k_)], a0, false); b0 = __builtin_amdgcn_fdot2(__builtin_shufflevector(r, r, 16 + 4 * (k_), 17 + 4 * (k_)), hh[2 * (k_)], b0, false); \
        a1 = __builtin_amdgcn_fdot2(__builtin_shufflevector(r, r, 4 * (k_) + 2, 4 * (k_) + 3), hh[2 * (k_) + 1], a1, false); b1 = __builtin_amdgcn_fdot2(__builtin_shufflevector(r, r, 18 + 4 * (k_), 19 + 4 * (k_)), hh[2 * (k_) + 1], b1, false);
        UDOT(0) UDOT(1) UDOT(2) UDOT(3)
#undef UDOT
        d[2 * i2] = a0 + a1;
        d[2 * i2 + 1] = b0 + b1;
        asm volatile("" : "+v"(d[2 * i2]), "+v"(d[2 * i2 + 1]));
      }
      if (pf) LOADGROUP(rp.uq, 0, rp.Ec);
      float tot;
      {
        auto s01 = __builtin_amdgcn_permlane32_swap(__float_as_uint(d[0]), __float_as_uint(d[1]), false, false);
        auto s23 = __builtin_amdgcn_permlane32_swap(__float_as_uint(d[2]), __float_as_uint(d[3]), false, false);
        auto s45 = __builtin_amdgcn_permlane32_swap(__float_as_uint(d[4]), __float_as_uint(d[5]), false, false);
        auto s67 = __builtin_amdgcn_permlane32_swap(__float_as_uint(d[6]), __float_as_uint(d[7]), false, false);
        const float q01 = __uint_as_float(s01[0]) + __uint_as_float(s01[1]), q23 = __uint_as_float(s23[0]) + __uint_as_float(s23[1]);
        const float q45 = __uint_as_float(s45[0]) + __uint_as_float(s45[1]), q67 = __uint_as_float(s67[0]) + __uint_as_float(s67[1]);
        auto ta = __builtin_amdgcn_permlane16_swap(__float_as_uint(q01), __float_as_uint(q23), false, false);
        auto tb = __builtin_amdgcn_permlane16_swap(__float_as_uint(q45), __float_as_uint(q67), false, false);
        const float r0123 = __uint_as_float(ta[0]) + __uint_as_float(ta[1]);
        const float r4567 = __uint_as_float(tb[0]) + __uint_as_float(tb[1]);
        const bool b3 = (lane & 8) != 0;
        const float keep = b3 ? r4567 : r0123, send = b3 ? r0123 : r4567;
        float x = keep + dpp_mov<0x140>(send);
        x += dpp_mov<0xB1>(x); x += dpp_mov<0x4E>(x); x += dpp_mov<0x141>(x);
        tot = x * gs.y;
      }
      float ge;
      {
        const float v = tot, av = fabsf(v), tq = __builtin_amdgcn_rcpf(av * 0.2316418882f + 1.0f);
        float q = tq * 0.5307027145f + (-0.7265760135f); q = q * tq + 0.7107068705f; q = q * tq + (-0.142248368f); q = q * tq + 0.127414796f; q = q * tq;
        const float ex = __builtin_amdgcn_exp2f(v * v * (-0.72134752044f));
        const float m = v * (q * ex), r = v - m;
        ge = (v < 0.f ? m : r) * gs.x;
      }
      unsigned cw[8];
      { const unsigned gp = __builtin_bit_cast(unsigned, __builtin_amdgcn_cvt_pkrtz(ge * 1024.f, ge * 1024.f));
        cw[0] = (unsigned)__builtin_amdgcn_readlane((int)gp, 0);  cw[4] = (unsigned)__builtin_amdgcn_readlane((int)gp, 8);
        cw[2] = (unsigned)__builtin_amdgcn_readlane((int)gp, 16); cw[6] = (unsigned)__builtin_amdgcn_readlane((int)gp, 24);
        cw[1] = (unsigned)__builtin_amdgcn_readlane((int)gp, 32); cw[5] = (unsigned)__builtin_amdgcn_readlane((int)gp, 40);
        cw[3] = (unsigned)__builtin_amdgcn_readlane((int)gp, 48); cw[7] = (unsigned)__builtin_amdgcn_readlane((int)gp, 56); }
      h16x2 a16[8];
#pragma unroll
      for (int i2 = 0; i2 < 4; ++i2) {
        const h16x32 r = __builtin_amdgcn_cvt_scalef32_pk32_f16_fp6(rp.vq[i2], 1.0f);
        const h16x2 ca = __builtin_bit_cast(h16x2, cw[2 * i2]), cb = __builtin_bit_cast(h16x2, cw[2 * i2 + 1]);
#define VAXL(k_) a16[k_] = (i2 == 0) ? ca * __builtin_shufflevector(r, r, 2 * (k_), 2 * (k_) + 1) : ca * __builtin_shufflevector(r, r, 2 * (k_), 2 * (k_) + 1) + a16[k_];
#define VAXH(k_) a16[k_] = cb * __builtin_shufflevector(r, r, 16 + 2 * (k_), 17 + 2 * (k_)) + a16[k_];
        VAXL(0) VAXL(1) VAXL(2) VAXL(3) VAXL(4) VAXL(5) VAXL(6) VAXL(7)
        asm volatile("" : "+v"(a16[0]), "+v"(a16[1]), "+v"(a16[2]), "+v"(a16[3]), "+v"(a16[4]), "+v"(a16[5]), "+v"(a16[6]), "+v"(a16[7]));
        VAXH(0) VAXH(1) VAXH(2) VAXH(3) VAXH(4) VAXH(5) VAXH(6) VAXH(7)
#undef VAXL
#undef VAXH
        asm volatile("" : "+v"(a16[0]), "+v"(a16[1]), "+v"(a16[2]), "+v"(a16[3]), "+v"(a16[4]), "+v"(a16[5]), "+v"(a16[6]), "+v"(a16[7]));
      }
#pragma unroll
      for (int k = 0; k < 8; ++k) acc2[k] = f32x2{(float)a16[k].x, (float)a16[k].y} * f32x2{1.f / 1024.f, 1.f / 1024.f} + acc2[k];
      if (pf) LOADGROUP(rp.vq, VOFS, rp.Ec);
      { const CAS i32x8* src_ = g8 < 14 ? EP + (g8 + 2) : EPn + (g8 - 14); rp.Ec = *src_; }
    }
    SBAR();
    float acc[16];
#pragma unroll
    for (int i = 0; i < 8; ++i) { acc[2 * i] = acc2[i].x; acc[2 * i + 1] = acc2[i].y; }
    float* xr = XC + (size_t)row * DM;
    float xn[16]; float ssq = 0.f;
    if (ABL & 8) {
#pragma unroll
      for (int i = 0; i < 16; ++i) acc[i] = 0.f;
    }
#pragma unroll
    for (int v4 = 0; v4 < 4; ++v4) {
      const int c = lane * 16 + v4 * 4;
      const f32x4 xo = xpre[v4], gg = ev.g2[v4];
      f32x4 o;
      o.x = xo.x + gg.x * acc[v4 * 4 + 0]; o.y = xo.y + gg.y * acc[v4 * 4 + 1]; o.z = xo.z + gg.z * acc[v4 * 4 + 2]; o.w = xo.w + gg.w * acc[v4 * 4 + 3];
      xn[v4 * 4 + 0] = o.x; xn[v4 * 4 + 1] = o.y; xn[v4 * 4 + 2] = o.z; xn[v4 * 4 + 3] = o.w;
      ssq += (o.x * o.x + o.y * o.y) + (o.z * o.z + o.w * o.w);
      if (l < DEPTH - 1) *(f32x4*)(xr + c) = o;
    }
    const float rs = rsqrtf(wave_sum_fast(ssq) * (1.f / DM) + EPS);
    if (l == DEPTH - 1) {
      const int b = row / SEGL, s = row - b * SEGL;
      float* orow = p.out + ((size_t)(b * SEQ + (s - CTXL))) * DM;
#pragma unroll
      for (int v4 = 0; v4 < 4; ++v4) {
        const int c = lane * 16 + v4 * 4;
        const f32x4 gg = ev.ng[v4];
        f32x4 o; o.x = xn[v4 * 4 + 0] * rs * gg.x; o.y = xn[v4 * 4 + 1] * rs * gg.y; o.z = xn[v4 * 4 + 2] * rs * gg.z; o.w = xn[v4 * 4 + 3] * rs * gg.w;
        *(f32x4*)(orow + c) = o;
      }
    } else {
      bf16_t* hrow = (bf16_t*)(p.ws + WS_H) + (size_t)row * DM;
#pragma unroll
      for (int hh = 0; hh < 2; ++hh) {
        float y[8];
#pragma unroll
        for (int i = 0; i < 8; ++i) { const int q_ = hh * 2 + (i >> 2), e_ = i & 3; y[i] = xn[hh * 8 + i] * rs * ev.ng[q_][e_] * (1.f + ev.sc[q_][e_]) + ev.sh[q_][e_]; }
        u32x4 w; w.x = cvtpk(y[0], y[1]); w.y = cvtpk(y[2], y[3]); w.z = cvtpk(y[4], y[5]); w.w = cvtpk(y[6], y[7]);
        *(u32x4*)(hrow + lane * 16 + hh * 8) = w;
      }
    }
  }
}

__device__ __forceinline__ void ev_signal(unsigned* ctr) {
  asm volatile("s_waitcnt vmcnt(0)" ::: "memory");
  __syncthreads();
  if (tidx() == 0) { __builtin_amdgcn_fence(__ATOMIC_RELEASE, "agent"); asm volatile("s_waitcnt vmcnt(0)" ::: "memory"); (void)xb_add(ctr, 1u); }
}
__device__ __forceinline__ void ev_wait(unsigned* ctr, unsigned n, unsigned* bar) {
  if (tidx() == 0) {
    XB_SPIN(xb_ld(ctr) < n, bar);
    __builtin_amdgcn_fence(__ATOMIC_ACQUIRE, "agent");
    asm volatile("s_waitcnt vmcnt(0)" ::: "memory");
  }
  __syncthreads();
}
constexpr int EV_WORD0 = 8192;
__device__ __forceinline__ void phase_c1(const Params& p, int l, unsigned char* lds) {
  constexpr int NLOC = NBATCH * 4 * NCH, NCONV = T / 32;
  for (int u = p.bx; u < NLOC + NCONV; u += p.gx) {
    if (u < NLOC) ml_local_unit2(p, l, u, lds);
    else {
      const int cu = u - NLOC;
      if (l == DEPTH - 1 && (cu % (SEGL / 32)) < (CTXL / 32)) continue;
      conv_unit(p, l, cu, lds);
    }
  }
}
__device__ __forceinline__ void phase_c3(const Params& p, int l, unsigned char* lds);
__device__ __forceinline__ void phase_c2(const Params& p, int l, unsigned char* lds) {
  unsigned* ev = (unsigned*)(p.ws + WS_CTL) + EV_WORD0 + 64 * l;
  ml_scan(p, lds);
  ev_signal(ev);
  const float* lp = p.in[I_DLAM] + l * 256;
  float s01 = 0.f, s23 = 0.f;
  for (int i = 0; i < 64; ++i) { s01 += lp[i] * lp[64 + i]; s23 += lp[128 + i] * lp[192 + i]; }
  const float lam_init = 0.8f - 0.6f * expf(-0.3f * (float)l);
  const float lam = expf(s01) - expf(s23) + lam_init;
  const bf16_t* PROJ = (const bf16_t*)(p.ws + WS_PROJ);
  bf16_t* MIX = (bf16_t*)(p.ws + WS_MIX);
  const float* ng = p.in[I_DNORMG] + l * 128;
  const int nun = 512 + (l < DEPTH - 1 ? 16 : 0);
  for (int u = p.bx; u < nun; u += p.gx) {
    int bh, qrow, nkeys;
    if (u < 512) { const int xcd = u & 7, i = (u >> 3) & 31, rnd = u >> 8; bh = 2 * xcd + rnd; qrow = CTXL + i * 256; nkeys = SEGL; }
    else { bh = u - 512; qrow = 0; nkeys = CTXL; }
    const int b = bh >> 2, h = bh & 3;
    const size_t tok0 = (size_t)b * SEGL;
    for (int rep = 0; rep < REP_ATT; ++rep)
    att_unit(p.ws + WS_QK8 + ((size_t)bh * SEGL + qrow) * QK8_PITCH, p.ws + WS_QK8 + QK8_IMG + (size_t)bh * SEGL * QK8_PITCH, p.ws + WS_V8T + (size_t)bh * NCH * ATT_SHM_V,
             MIX + (tok0 + qrow) * DM + 512 + h * 128, nkeys, lam, ng, 1.f - lam_init, lds);
  }
  ev_wait(ev, (unsigned)p.gx, p.xbar_words);
  for (int rep = 0; rep < REP_ML; ++rep) phase_c3(p, l, lds);
}
__device__ __forceinline__ void phase_c3(const Params& p, int l, unsigned char* lds) {
  constexpr int NU = NBATCH * 4 * NCH;
  const int nlow = (p.gx > 64 && l < DEPTH - 1) ? 16 : 0, ulow = nlow * 7;
  int u, step;
  if (p.bx < nlow) { u = p.bx; step = nlow; } else { u = ulow + (p.bx - nlow); step = p.gx - nlow; }
  const int uend = p.bx < nlow ? ulow : NU;
  int tid_ = tidx(); asm volatile("" : "+v"(tid_));
  auto valid_from = [&](int v) { while (v < uend && l == DEPTH - 1 && (v % NCH) < 4) v += step; return v < uend ? v : -1; };
  MlOutPf fa, fb;
  u = valid_from(u);
  if (u >= 0) ml_out_fetch(p, u, tid_, fa);
  while (u >= 0) {
    const int nx = valid_from(u + step);
    ml_out_unit2(p, l, u, lds, fa, nx, fb);
    fa = fb; u = nx;
  }
}
__device__ __forceinline__ void phase_route(const Params& p, int l, unsigned char* lds) {
  constexpr int NU = T / 32;
  for (int u = p.bx; u < NU; u += p.gx) {
    if (l == DEPTH - 1 && (u % (SEGL / 32)) < (CTXL / 32)) continue;
    route_unit(p, l, u, lds);
    __syncthreads();
  }
}
__device__ __forceinline__ void phase_gather(const Params& p, int l, unsigned char* lds) {
  int tid_ = tidx(); asm volatile("" : "+v"(tid_)); const int lane = tid_ & 63, wid = __builtin_amdgcn_readfirstlane(tid_ >> 6);
  const int gw = p.bx * 8 + wid, NGW = p.gx * 8;
  const int ntok = (l == DEPTH - 1) ? NBATCH * SEQ : T;
#define TOKROW(ti_) ((l == DEPTH - 1) ? ((ti_) / SEQ) * SEGL + CTXL + ((ti_) % SEQ) : (ti_))
  const CAS unsigned char* eidg = (const CAS unsigned char*)(p.ws + WS_EID + (size_t)l * RT_STRIDE);
  const __amdgpu_buffer_rsrc_t rsT = __builtin_amdgcn_make_buffer_rsrc((void*)(p.ws + WS_PU + (size_t)l * NEXP * PROW), 0, VOFS + NEXP * PROW, 0x00020000);
  const int nfull = ntok / NGW, rem = ntok - nfull * NGW, per = (rem % p.gx == 0) ? rem / p.gx : -1;
  auto tok_at = [&](int r) -> int {
    if (r < nfull) return gw + r * NGW;
    if (r > nfull || rem == 0) return -1;
    if (per >= 0) return wid < per ? nfull * NGW + p.bx * per + wid : -1;
    return gw + r * NGW < ntok ? gw + r * NGW : -1;
  };
  TokPref tp; RowPipe rp; EpiVec ev; ev.mr = -1;
  const int ti0 = tok_at(0);
  if (ti0 >= 0) {
    const int row0 = TOKROW(ti0); const int lane12 = lane * 12;
    tok_prefetch(p, row0, lane, tp);
    const CAS i32x8* EP0 = eid_row(eidg, row0);
    rp.Ec = EP0[0];
    LOADGROUP(rp.uq, 0, rp.Ec); LOADGROUP(rp.vq, VOFS, rp.Ec);
    rp.Ec = EP0[1];
  }
  XcdBarrier xb; xb.bar = p.xbar_words; xb.x = p.xbar_x; xb.st = (volatile LAS unsigned*)((LAS unsigned char*)lds + p.lds_st_off);
  const int nrounds = (ntok + NGW - 1) / NGW;
  for (int r = 0; r < nrounds; ++r) {
    const int ti = tok_at(r);
    if (ti >= 0) {
      const int row = TOKROW(ti);
      const int tn = tok_at(r + 1);
      const int nxt = tn >= 0 ? TOKROW(tn) : -1;
      gather_token(p, eidg, rsT, l, row, nxt, tp, rp, ev, lds, lane, wid);
    }
#if GATHER_SYNC
    if (r + 1 < nrounds) { XcdBarrier xb2 = xb; size_t zb_ = 0; asm volatile("" : "+s"(zb_)); xb2.bar = xb.bar + zb_; xb2.x = xb.x + (unsigned)zb_; xcd_barrier(xb2); }
#endif
  }
#undef TOKROW
}

__global__ void __launch_bounds__(512, 2) mk_fwd(KArgs ka) {
  cg::grid_group grid = cg::this_grid();
  extern __shared__ __attribute__((aligned(16))) unsigned char lds[];
  const int lo = ka.ph_lo, hi = ka.ph_hi;
#define IN(k) (lo <= (k) && (k) < hi)
#ifndef PHASEMASK
#define PHASEMASK 0xFFFF
#endif
#define PH(i) ((PHASEMASK >> (i)) & 1)
#define MKP(q) Params q; { size_t z_ = 0; asm volatile("" : "+s"(z_)); \
    q.in = (InTab)((const __attribute__((address_space(4))) char*)__builtin_amdgcn_kernarg_segment_ptr() + z_); \
    q.out = ka.out + z_; q.ws = ka.ws + z_; q.ph_lo = lo; q.ph_hi = hi; q.bx = (int)blockIdx.x + (int)z_; q.gx = (int)gridDim.x + (int)z_; q.xbar_words = xbar.bar + z_; q.xbar_x = xbar.x + (unsigned)z_; q.lds_st_off = (unsigned)(LDS_BYTES - 64); }
#define SEAM(k) do { if (IN(k) && IN((k) + 1)) { if ((k) == 0) grid.sync(); else { XcdBarrier xb_ = xbar; size_t zb_ = 0; asm volatile("" : "+s"(zb_)); xb_.bar = xbar.bar + zb_; xb_.x = xbar.x + (unsigned)zb_; xcd_barrier(xb_); } } } while (0)
  volatile LAS unsigned* xst = (volatile LAS unsigned*)((LAS unsigned char*)lds + (LDS_BYTES - 64));
  { const int t0_ = threadIdx.x;
    if (t0_ < 2) xst[t0_] = 0u;
    if ((t0_ & 63) == 0) *(volatile LAS int*)((LAS unsigned char*)lds + LDS_WTAB + 4 * hw_wave_key()) = t0_ >> 6; }
  __syncthreads();
  XcdBarrier xbar = xcd_barrier_post((unsigned*)(ka.ws + WS_CTL) + 4096, xst);
  { MKP(p)
    if (PH(0) && IN(0)) for (int rep = 0; rep < REP_MISC; ++rep) { p0_mod(p, lds, (float*)(p.ws + WS_MOD)); p0_convert(p, lds); }
  }
  SEAM(0);
  { MKP(p)
    if (PH(1) && IN(1)) phase_norm(p, 0, 0, true, false);
  }
  SEAM(1);
#define LAYER(LL) { \
    int l = (LL); asm volatile("" : "+s"(l)); \
    const int b = 2 + 9 * (LL); \
    { MKP(q) if (PH(2) && IN(b + 0)) for (int rep = 0; rep < REP_GEMM; ++rep) phase_inproj2(q, l, lds); } \
    SEAM(b + 0); \
    { MKP(q) if (PH(3) && IN(b + 1)) for (int rep = 0; rep < REP_ML; ++rep) phase_c1(q, l, lds); } \
    SEAM(b + 1); \
    { MKP(q) if (PH(4) && IN(b + 2)) phase_c2(q, l, lds); } \
    SEAM(b + 3); \
    { MKP(q) if (PH(6) && IN(b + 4)) phase_outproj2(q, l, lds); } \
    SEAM(b + 4); \
    { MKP(q) if (PH(7) && IN(b + 5)) for (int rep = 0; rep < REP_MISC; ++rep) phase_norm(q, l, 1, false, (LL) == DEPTH - 1); } \
    SEAM(b + 5); \
    { MKP(q) if (PH(8) && IN(b + 6)) for (int rep = 0; rep < REP_GEMM; ++rep) phase_peerq2(q, l, lds); } \
    SEAM(b + 6); \
    { MKP(q) if (PH(9) && IN(b + 7)) phase_route(q, l, lds); } \
    SEAM(b + 7); \
    { MKP(q) if (PH(9) && IN(b + 8)) phase_gather(q, l, lds); } \
    SEAM(b + 8); }
  LAYER(0) LAYER(1) LAYER(2) LAYER(3)
#undef LAYER
#undef IN
#undef SEAM
#undef MKP
}

extern "C" void kernel_launch(void* const* d_in, const int* in_sizes, int n_in, void* d_out, int out_size,
                              void* d_ws, size_t ws_size, hipStream_t stream) {
  static int grid = 0;
  if (grid == 0) {
    int dev = 0, cus = 0, per_cu = 0;
    (void)hipGetDevice(&dev);
    (void)hipDeviceGetAttribute(&cus, hipDeviceAttributeMultiprocessorCount, dev);
    (void)hipFuncSetAttribute((const void*)mk_fwd, hipFuncAttributeMaxDynamicSharedMemorySize, LDS_BYTES);
    (void)hipOccupancyMaxActiveBlocksPerMultiprocessor(&per_cu, (const void*)mk_fwd, 512, LDS_BYTES);
    fprintf(stderr, "kernel_launch: cus %d per_cu %d ws %zu (need %zu) n_in %d\n", cus, per_cu, ws_size, (size_t)WS_END, n_in);
    if (ws_size < WS_END || n_in != 23 || per_cu < 1) { fprintf(stderr, "kernel_launch: bad configuration, nothing launched\n"); grid = -1; return; }
    grid = cus;
  }
  if (grid < 0) return;
  (void)hipMemsetAsync((char*)d_ws + WS_CTL, 0, 65536, stream);
  KArgs p{};
  for (int i = 0; i < 23; ++i) p.in[i] = (const float*)d_in[i];
  p.out = (float*)d_out; p.ws = (unsigned char*)d_ws; p.ph_lo = 0; p.ph_hi = 38;
  void* args[] = {&p};
  hipError_t e = hipLaunchCooperativeKernel((const void*)mk_fwd, dim3(grid), dim3(512), args, LDS_BYTES, stream);
  if (e != hipSuccess) fprintf(stderr, "cooperative launch failed: %s (grid %d)\n", hipGetErrorString(e), grid);
}
```

```cpp
#include <hip/hip_runtime.h>
#include <hip/hip_cooperative_groups.h>
#include <cstdio>
#include <cstdint>
namespace cg = cooperative_groups;

constexpr int DM = 1024, NBATCH = 4, SEQ = 8192, CTXL = 256, SEGL = CTXL + SEQ, T = NBATCH * SEGL, DEPTH = 4;
constexpr int IN_W = 3088, PW = 3072;
constexpr int QK8_PITCH = 144; constexpr size_t QK8_IMG = (size_t)16 * SEGL * QK8_PITCH;
constexpr int C_A = 0, C_MQ = 512, C_MK = 768, C_MV = 1024, C_MO = 1280, C_DQ = 1536, C_DK = 2048, C_DV = 2560;
constexpr int NCH = SEGL / 64;
constexpr int NEXP = 16384;
constexpr float EPS = 1e-6f;
#ifndef ABL
#define ABL 0
#endif
#ifndef GATHER_SYNC
#define GATHER_SYNC 0
#endif
#ifndef REP_ATT
#define REP_ATT 1
#endif
#ifndef GP_MASK
#define GP_MASK 0x3FFF
#endif
#ifndef REP_PEER
#define REP_PEER 1
#endif
#ifndef REP_GEMM
#define REP_GEMM 1
#endif
#ifndef REP_ROUTE
#define REP_ROUTE 1
#endif
#ifndef REP_OUTP
#define REP_OUTP 1
#endif
#ifndef REP_ML
#define REP_ML 1
#endif
#ifndef REP_MISC
#define REP_MISC 1
#endif
constexpr float QSCALE = 0.125f * 1.4426950408889634f;

constexpr size_t MiB = 1u << 20;
constexpr size_t WS_CTL = 0, WS_MOD = 1 * MiB, WS_ROPE = 2 * MiB, WS_WG = 4 * MiB, WS_KEYS = 5 * MiB, WS_MLMETA = 6 * MiB,
                 WS_GATES = 7 * MiB, WS_WIN = 10 * MiB, WS_WOUT = 34 * MiB, WS_WQ = 42 * MiB, WS_PU = 50 * MiB, WS_PV = 114 * MiB, WS_PSC = 178 * MiB  ,
                 WS_XCUR = 306 * MiB, WS_H = 438 * MiB, WS_MIX = 504 * MiB, WS_PROJ = 570 * MiB, WS_ULOC = 768 * MiB, WS_V8T = 836 * MiB  , WS_EID = 858 * MiB  , WS_QK8 = 924 * MiB  , WS_END = 964 * MiB;
constexpr int USTRIDE = 4160;

constexpr int LDS_BYTES = 139264 + 512;
constexpr int LDS_WTAB = LDS_BYTES - 64 - 256;

#define LAS __attribute__((address_space(3)))
__device__ __forceinline__ int hw_wave_key() { return (int)(__builtin_amdgcn_s_getreg((5 << 11) | 4) & 63u); }
__device__ __forceinline__ int tidx() {
  extern __shared__ __attribute__((aligned(16))) unsigned char lds_dyn_[];
  const int w = __builtin_amdgcn_readfirstlane(*(const volatile LAS int*)((LAS unsigned char*)lds_dyn_ + LDS_WTAB + 4 * hw_wave_key()));
  unsigned z_ = 0u; asm volatile("" : "+v"(z_));
  return (w << 6) | (int)__builtin_amdgcn_mbcnt_hi(~0u, __builtin_amdgcn_mbcnt_lo(~0u, z_));
}
typedef unsigned short bf16_t;
typedef short bf16x8 __attribute__((ext_vector_type(8)));
typedef short s16x4 __attribute__((ext_vector_type(4)));
typedef float f32x4 __attribute__((ext_vector_type(4)));
typedef float f32x16 __attribute__((ext_vector_type(16)));
typedef unsigned u32x4 __attribute__((ext_vector_type(4)));
typedef unsigned u32x2 __attribute__((ext_vector_type(2)));
typedef __bf16 bf16x2v __attribute__((ext_vector_type(2)));
typedef int i32x8 __attribute__((ext_vector_type(8)));
typedef int i32x6 __attribute__((ext_vector_type(6)));
struct __attribute__((aligned(4))) u32x3 { unsigned x, y, z; };
typedef float f32x32 __attribute__((ext_vector_type(32)));
constexpr int PROW = 768;
typedef float f32x2 __attribute__((ext_vector_type(2)));
typedef _Float16 h16x2 __attribute__((ext_vector_type(2)));
typedef _Float16 h16x32 __attribute__((ext_vector_type(32)));
typedef unsigned u32x3v __attribute__((ext_vector_type(3)));
typedef unsigned u32x2v __attribute__((ext_vector_type(2)));

struct KArgs {
  const float* in[23];
  float* out;
  unsigned char* ws;
  int ph_lo, ph_hi;
};
typedef const float* const __attribute__((address_space(4))) * InTab;
struct Params {
  InTab in;
  float* out;
  unsigned char* ws;
  int ph_lo, ph_hi;
  int bx, gx;
  unsigned* xbar_words; unsigned xbar_x; unsigned lds_st_off;
};
enum { I_X = 0, I_C, I_CTX, I_CCTX, I_ADAW, I_ADAB, I_N1G, I_N2G, I_WIN, I_CONVW, I_CONVB, I_CLNG, I_CLNB, I_GATEB, I_MNORMG, I_DLAM, I_DNORMG,
       I_WOUT, I_PWQ, I_PKEYS, I_PU, I_PV, I_FINALG };

__device__ __forceinline__ unsigned cvtpk(float lo, float hi) { unsigned r; asm volatile("v_cvt_pk_bf16_f32 %0, %1, %2" : "=v"(r) : "v"(lo), "v"(hi)); return r; }
__device__ __forceinline__ float bflo(unsigned u) { return __uint_as_float(u << 16); }
__device__ __forceinline__ float bfhi(unsigned u) { return __uint_as_float(u & 0xffff0000u); }
__device__ __forceinline__ float bf1(bf16_t u) { return __uint_as_float(((unsigned)u) << 16); }
__device__ __forceinline__ int crow(int r, int hi) { return (r & 3) + 8 * (r >> 2) + 4 * hi; }
template <int CTRL> __device__ __forceinline__ float dpp_mov(float v) {
  return __uint_as_float((unsigned)__builtin_amdgcn_update_dpp(0, (int)__float_as_uint(v), CTRL, 0xF, 0xF, true));
}
__device__ __forceinline__ float wave_sum_fast(float x) {
  x += dpp_mov<0xB1>(x); x += dpp_mov<0x4E>(x); x += dpp_mov<0x141>(x); x += dpp_mov<0x140>(x);
  { auto r = __builtin_amdgcn_permlane16_swap(__float_as_uint(x), __float_as_uint(x), false, false); x = __uint_as_float(r[0]) + __uint_as_float(r[1]); }
  { auto r = __builtin_amdgcn_permlane32_swap(__float_as_uint(x), __float_as_uint(x), false, false); x = __uint_as_float(r[0]) + __uint_as_float(r[1]); }
  return x;
}
__device__ __forceinline__ float wave_max_fast(float x) {
  x = fmaxf(x, dpp_mov<0xB1>(x)); x = fmaxf(x, dpp_mov<0x4E>(x)); x = fmaxf(x, dpp_mov<0x141>(x)); x = fmaxf(x, dpp_mov<0x140>(x));
  { auto r = __builtin_amdgcn_permlane16_swap(__float_as_uint(x), __float_as_uint(x), false, false); x = fmaxf(__uint_as_float(r[0]), __uint_as_float(r[1])); }
  { auto r = __builtin_amdgcn_permlane32_swap(__float_as_uint(x), __float_as_uint(x), false, false); x = fmaxf(__uint_as_float(r[0]), __uint_as_float(r[1])); }
  return x;
}
template <int CTRL, int ROWMASK> __device__ __forceinline__ float dpp_mov_rm(float v) {
  return __uint_as_float((unsigned)__builtin_amdgcn_update_dpp(0, (int)__float_as_uint(v), CTRL, ROWMASK, 0xF, true));
}
__device__ __forceinline__ float wave_incl_scan(float x) {
  x += dpp_mov<0x111>(x); x += dpp_mov<0x112>(x); x += dpp_mov<0x114>(x); x += dpp_mov<0x118>(x);
  x += dpp_mov_rm<0x142, 0xA>(x);
  x += dpp_mov_rm<0x143, 0xC>(x);
  return x;
}
__device__ __forceinline__ float wave_sum(float v) { return wave_sum_fast(v); }
__device__ __forceinline__ float sum_xor32(float x) { auto r = __builtin_amdgcn_permlane32_swap(__float_as_uint(x), __float_as_uint(x), false, false); return __uint_as_float(r[0]) + __uint_as_float(r[1]); }
__device__ __forceinline__ float max_xor32(float x) { auto r = __builtin_amdgcn_permlane32_swap(__float_as_uint(x), __float_as_uint(x), false, false); return fmaxf(__uint_as_float(r[0]), __uint_as_float(r[1])); }
__device__ __forceinline__ float wave_max(float v) { return wave_max_fast(v); }
__device__ __forceinline__ float sigmoidf_(float x) { return 1.f / (1.f + __expf(-x)); }
__device__ __forceinline__ float logsigmoidf_(float x) { return fminf(x, 0.f) - log1pf(__expf(-fabsf(x))); }
__device__ __forceinline__ const float* in_row(const float* x, const float* ctx, int row) {
  const int b = row / SEGL, s = row - b * SEGL;
  return s < CTXL ? ctx + ((size_t)(b * CTXL + s)) * DM : x + ((size_t)(b * SEQ + (s - CTXL))) * DM;
}
__device__ __forceinline__ int mod_row(int row) { const int b = row / SEGL, s = row - b * SEGL; return s < CTXL ? 4 : b; }

__device__ __forceinline__ void p0_mod(const Params& p, unsigned char* lds, float* MOD) {
  float* sil = (float*)lds;
  float* red = (float*)(lds + 20480);
  int tid_ = tidx(); asm volatile("" : "+v"(tid_)); const int tid = tid_, lane = tid & 63, wid = tid >> 6;
  for (int i = tid; i < 5 * 1024; i += 512) {
    const float v = i < 4096 ? p.in[I_C][i] : p.in[I_CCTX][i - 4096];
    sil[i] = v / (1.f + __expf(-v));
  }
  __syncthreads();
  for (int item = p.bx; item < DEPTH * 96; item += p.gx) {
    const int l = item / 96, j0 = (item % 96) * 64;
    const float* W = p.in[I_ADAW] + (size_t)l * DM * 6144 + j0 + lane;
    float a0 = 0.f, a1 = 0.f, a2 = 0.f, a3 = 0.f, a4 = 0.f;
    const int k0 = wid * 128;
#pragma unroll 8
    for (int k = k0; k < k0 + 128; ++k) {
      const float w = W[(size_t)k * 6144];
      a0 += sil[k] * w; a1 += sil[1024 + k] * w; a2 += sil[2048 + k] * w; a3 += sil[3072 + k] * w; a4 += sil[4096 + k] * w;
    }
    red[(wid * 5 + 0) * 64 + lane] = a0; red[(wid * 5 + 1) * 64 + lane] = a1; red[(wid * 5 + 2) * 64 + lane] = a2;
    red[(wid * 5 + 3) * 64 + lane] = a3; red[(wid * 5 + 4) * 64 + lane] = a4;
    __syncthreads();
    if (tid < 320) {
      const int r = tid >> 6;
      float s = 0.f;
#pragma unroll
      for (int w = 0; w < 8; ++w) s += red[(w * 5 + r) * 64 + lane];
      MOD[((size_t)l * 5 + r) * 6144 + j0 + lane] = s + p.in[I_ADAB][l * 6144 + j0 + lane];
    }
    __syncthreads();
  }
}
__device__ __forceinline__ void transpose_item(const float* W, int ldw, int srccol0, bf16_t* WT, int K, int n0, int k0, float* scr, int lane) {
#pragma unroll 8
  for (int i = 0; i < 32; ++i) { const int kk = 2 * i + (lane >> 5); scr[kk * 33 + (lane & 31)] = W[(size_t)(k0 + kk) * ldw + srccol0 + (lane & 31)]; }
  asm volatile("s_waitcnt lgkmcnt(0)" ::: "memory");
  const int c = lane & 7;
#pragma unroll
  for (int j = 0; j < 4; ++j) {
    const int n = (lane >> 3) + 8 * j; const float* s = scr + (8 * c) * 33 + n;
    u32x4 o; o.x = cvtpk(s[0], s[33]); o.y = cvtpk(s[66], s[99]); o.z = cvtpk(s[132], s[165]); o.w = cvtpk(s[198], s[231]);
    *(u32x4*)(WT + (size_t)(n0 + n) * K + k0 + 8 * c) = o;
  }
  asm volatile("s_waitcnt lgkmcnt(0)" ::: "memory");
}
__device__ __forceinline__ void convert_tables(const Params& p, int L, int wv, int nw, int lane, int r_lo, int r_hi) {
  unsigned char* PUq = p.ws + WS_PU; unsigned char* PVq = p.ws + WS_PV; float* PSC = (float*)(p.ws + WS_PSC);
  const int nrows = DEPTH * NEXP;
#define TAB_SROW(r_) ((const f32x4*)(((r_) >= NEXP ? p.in[I_PV] : p.in[I_PU]) + (size_t)(L * NEXP + ((r_) >= NEXP ? (r_) - NEXP : (r_))) * DM) + lane * 4)
#define TAB_LOAD(v_, r_) do { if ((r_) < r_hi) { const f32x4* s_ = TAB_SROW(r_); _Pragma("unroll") for (int j = 0; j < 4; ++j) v_[j] = __builtin_nontemporal_load(s_ + j); } } while (0)
  auto encode_row = [&](const f32x4 (&v)[4], int r) {
    const int tb = r >= NEXP, rr = L * NEXP + (tb ? r - NEXP : r);
    float mx = 0.f;
#pragma unroll
    for (int j = 0; j < 4; ++j) mx = fmaxf(mx, fmaxf(fmaxf(fabsf(v[j].x), fabsf(v[j].y)), fmaxf(fabsf(v[j].z), fabsf(v[j].w))));
    mx = wave_max_fast(mx);
    const unsigned mb = __float_as_uint(mx);
    const int eb = (int)((mb >> 23) & 0xFFu);
    int sb = ((mb & 0x7FFFFFu) <= 0x700000u ? 129 : 128) - eb + 127; sb = sb < 1 ? 1 : (sb > 253 ? 253 : sb);
    const float sc = __uint_as_float((unsigned)sb << 23), isc = __uint_as_float((unsigned)(254 - sb) << 23);
    const float xv[16] = {v[0].x, v[0].y, v[0].z, v[0].w, v[1].x, v[1].y, v[1].z, v[1].w, v[2].x, v[2].y, v[2].z, v[2].w, v[3].x, v[3].y, v[3].z, v[3].w};
    unsigned wq[3] = {0u, 0u, 0u};
#pragma unroll
    for (int i = 0; i < 16; ++i) {
      const float a = fabsf(xv[i]) * sc;
      unsigned code = a < 2.f ? (unsigned)__builtin_rintf(a * 8.f) : (a < 4.f ? 8u + (unsigned)__builtin_rintf(a * 4.f) : 16u + (unsigned)__builtin_rintf(a * 2.f));
      code = code > 31u ? 31u : code;
      code |= (xv[i] < 0.f) ? 32u : 0u;
      const int bp = 6 * i, dw = bp >> 5, off = bp & 31;
      wq[dw] |= code << off;
      if (off > 26) wq[dw + 1] |= code >> (32 - off);
    }
    u32x3 o; o.x = wq[0]; o.y = wq[1]; o.z = wq[2];
    *(u32x3*)((tb ? PVq : PUq) + (size_t)rr * PROW + lane * 12) = o;
    if (lane == 0) PSC[(size_t)tb * nrows + rr] = isc;
  };
  f32x4 v0[4], v1[4], v2[4];
  TAB_LOAD(v0, r_lo + wv); TAB_LOAD(v1, r_lo + wv + nw);
#pragma unroll 1
  for (int r = r_lo + wv; r < r_hi; r += 3 * nw) {
    TAB_LOAD(v2, r + 2 * nw); encode_row(v0, r);
    if (r + nw < r_hi) { TAB_LOAD(v0, r + 3 * nw); encode_row(v1, r + nw); }
    if (r + 2 * nw < r_hi) { TAB_LOAD(v1, r + 4 * nw); encode_row(v2, r + 2 * nw); }
  }
#undef TAB_LOAD
#undef TAB_SROW
}
__device__ __forceinline__ void tail_filler_tables(const Params& p, int L, int nwg, int r_lo, int r_hi) {
  int tid_ = tidx(); asm volatile("" : "+v"(tid_)); const int lane = tid_ & 63, wid = tid_ >> 6;
  const int nextra = nwg % p.gx, first = nextra, nidle = p.gx - nextra;
  if (p.bx < first) return;
  convert_tables(p, L, (p.bx - first) * 8 + wid, nidle * 8, lane, r_lo, r_hi);
}
__device__ __forceinline__ void p0_convert(const Params& p, unsigned char* lds) {
  int tid_ = tidx(); asm volatile("" : "+v"(tid_)); const int tid = tid_, lane = tid & 63, wid = tid >> 6;
  const int gw = p.bx * 8 + wid, NGW = p.gx * 8;
  const size_t gt = (size_t)p.bx * 512 + tid, NGT = (size_t)p.gx * 512;
  float* scr = (float*)(lds + 32768) + wid * (64 * 33);
  bf16_t* WIN = (bf16_t*)(p.ws + WS_WIN); bf16_t* WOUT = (bf16_t*)(p.ws + WS_WOUT); bf16_t* WQ = (bf16_t*)(p.ws + WS_WQ);
  constexpr int I_IN = 16 * 96, I_O = 16 * 32, PER_L = I_IN + 2 * I_O;
  for (int it = gw; it < DEPTH * PER_L; it += NGW) {
    const int l = it / PER_L; int r = it % PER_L;
    if (r < I_IN) { const int kb = r / 96, nb = r % 96, n0 = nb * 32; const int src = n0 < 1536 ? n0 : n0 + 16;
      transpose_item(p.in[I_WIN] + (size_t)l * DM * IN_W, IN_W, src, WIN + (size_t)l * PW * DM, DM, n0, kb * 64, scr, lane); continue; }
    r -= I_IN;
    if (r < I_O) { const int kb = r / 32, nb = r % 32;
      transpose_item(p.in[I_WOUT] + (size_t)l * DM * DM, DM, nb * 32, WOUT + (size_t)l * DM * DM, DM, nb * 32, kb * 64, scr, lane); continue; }
    r -= I_O;
    { const int kb = r / 32, nb = r % 32;
      transpose_item(p.in[I_PWQ] + (size_t)l * DM * DM, DM, nb * 32, WQ + (size_t)l * DM * DM, DM, nb * 32, kb * 64, scr, lane); }
  }
  bf16_t* WG = (bf16_t*)(p.ws + WS_WG);
  for (size_t i = gt; i < (size_t)DEPTH * 16 * DM; i += NGT) {
    const int l = (int)(i / (16 * DM)), g = (int)((i / DM) % 16), k = (int)(i % DM);
    WG[i] = (bf16_t)(cvtpk(p.in[I_WIN][(size_t)l * DM * IN_W + (size_t)k * IN_W + 1536 + g], 0.f) & 0xffffu);
  }
  bf16_t* KEYS = (bf16_t*)(p.ws + WS_KEYS);
  for (size_t i = gt; i < (size_t)DEPTH * 131072 / 8; i += NGT) {
    const f32x4 a = ((const f32x4*)p.in[I_PKEYS])[2 * i], b = ((const f32x4*)p.in[I_PKEYS])[2 * i + 1];
    u32x4 o; o.x = cvtpk(a.x, a.y); o.y = cvtpk(a.z, a.w); o.z = cvtpk(b.x, b.y); o.w = cvtpk(b.z, b.w);
    ((u32x4*)KEYS)[i] = o;
  }
  {
    float* RC = (float*)(p.ws + WS_ROPE); float* RS = RC + SEQ * 32;
    for (size_t i = gt; i < (size_t)SEQ * 32; i += NGT) {
      const int pos = (int)(i >> 5), j = (int)(i & 31);
      const int rr = pos >> 6, cc = pos & 63;
      const int jj = j & 15;
      const double e = -(double)jj * 0.83048202372184058696;
      const double fl = __builtin_floor(e); const double f = e - fl;
      const double z = f * 0.69314718055994530942;
      double ez = 1.0 + z * (1.0 + z * (0.5 + z * (1.0 / 6 + z * (1.0 / 24 + z * (1.0 / 120 + z * (1.0 / 720 + z * (1.0 / 5040 + z * (1.0 / 40320 + z * (1.0 / 362880 + z * (1.0 / 3628800 + z * (1.0 / 39916800 + z * (1.0 / 479001600))))))))))));
      const double inv = __builtin_ldexp(ez, (int)fl);
      const float invf = (float)inv;
      const float angf = (float)(j < 16 ? rr : cc) * invf;
      const double ang = (double)angf;
      const double kq = __builtin_rint(ang * 0.63661977236758134308);
      double r = __builtin_fma(-kq, 1.57079632679489655800e+00, ang);
      r = __builtin_fma(-kq, 6.12323399573676603587e-17, r);
      const double r2 = r * r;
      const double sn = r * (1.0 + r2 * (-1.0 / 6 + r2 * (1.0 / 120 + r2 * (-1.0 / 5040 + r2 * (1.0 / 362880 + r2 * (-1.0 / 39916800 + r2 * (1.0 / 6227020800.0)))))));
      const double cs = 1.0 + r2 * (-0.5 + r2 * (1.0 / 24 + r2 * (-1.0 / 720 + r2 * (1.0 / 40320 + r2 * (-1.0 / 3628800 + r2 * (1.0 / 479001600 + r2 * (-1.0 / 87178291200.0)))))));
      const int q = ((int)kq) & 3;
      double co, si;
      if (q == 0) { co = cs; si = sn; } else if (q == 1) { co = -sn; si = cs; } else if (q == 2) { co = -cs; si = -sn; } else { co = sn; si = -cs; }
      RC[i] = (float)co; RS[i] = (float)si;
    }
  }
}

__device__ __forceinline__ void norm_mod_row(const float* xrow, const float* g, const float* sc, const float* sh, bf16_t* orow, int lane) {
  const f32x4* xr = (const f32x4*)xrow + lane;
  f32x4 v[4]; float s = 0.f;
#pragma unroll
  for (int j = 0; j < 4; ++j) { v[j] = xr[64 * j]; s += (v[j].x * v[j].x + v[j].y * v[j].y) + (v[j].z * v[j].z + v[j].w * v[j].w); }
  const float rs = rsqrtf(wave_sum(s) * (1.f / DM) + EPS);
  u32x2* o = (u32x2*)orow + lane;
#pragma unroll
  for (int j = 0; j < 4; ++j) {
    const f32x4 gg = ((const f32x4*)g)[lane + 64 * j], cc = ((const f32x4*)sc)[lane + 64 * j], hh = ((const f32x4*)sh)[lane + 64 * j];
    const float y0 = v[j].x * rs * gg.x * (1.f + cc.x) + hh.x, y1 = v[j].y * rs * gg.y * (1.f + cc.y) + hh.y;
    const float y2 = v[j].z * rs * gg.z * (1.f + cc.z) + hh.z, y3 = v[j].w * rs * gg.w * (1.f + cc.w) + hh.w;
    u32x2 w; w.x = cvtpk(y0, y1); w.y = cvtpk(y2, y3);
    o[64 * j] = w;
  }
}
__device__ __forceinline__ void phase_norm(const Params& p, int l, int which, bool from_input, bool skip_ctx) {
  int tid_ = tidx(); asm volatile("" : "+v"(tid_));
  const int lane = tid_ & 63, wid = tid_ >> 6;
  const int gw = p.bx * 8 + wid, NGW = p.gx * 8;
  const float* MOD = (const float*)(p.ws + WS_MOD);
  const float* XC = (const float*)(p.ws + WS_XCUR);
  bf16_t* H = (bf16_t*)(p.ws + WS_H);
  const float* g = p.in[which ? I_N2G : I_N1G] + l * DM;
  auto next_row = [&](int r_) { while (r_ < T && skip_ctx && mod_row(r_) == 4) r_ += NGW; return r_; };
  auto xrow_of = [&](int r_) { return (const f32x4*)(from_input ? in_row(p.in[I_X], p.in[I_CTX], r_) : XC + (size_t)r_ * DM) + lane; };
  f32x4 gg[4], cc[4], hh[4], v[4], vn[4];
#pragma unroll
  for (int j = 0; j < 4; ++j) gg[j] = ((const f32x4*)g)[lane + 64 * j];
  int mr_cur = -1;
  int row = next_row(gw);
  if (row < T) { const f32x4* xr = xrow_of(row);
#pragma unroll
    for (int j = 0; j < 4; ++j) v[j] = xr[64 * j]; }
  while (row < T) {
    const int nrow = next_row(row + NGW);
    if (nrow < T) { const f32x4* xn = xrow_of(nrow);
#pragma unroll
      for (int j = 0; j < 4; ++j) vn[j] = xn[64 * j]; }
    const int mr = mod_row(row);
    if (mr != mr_cur) {
      const float* m = MOD + ((size_t)l * 5 + mr) * 6144 + which * 3072;
#pragma unroll
      for (int j = 0; j < 4; ++j) { cc[j] = ((const f32x4*)(m + 1024))[lane + 64 * j]; hh[j] = ((const f32x4*)m)[lane + 64 * j]; }
      mr_cur = mr;
    }
    float s = 0.f;
#pragma unroll
    for (int j = 0; j < 4; ++j) s += (v[j].x * v[j].x + v[j].y * v[j].y) + (v[j].z * v[j].z + v[j].w * v[j].w);
    const float rs = rsqrtf(wave_sum(s) * (1.f / DM) + EPS);
    u32x2* o = (u32x2*)(H + (size_t)row * DM) + lane;
#pragma unroll
    for (int j = 0; j < 4; ++j) {
      const float y0 = v[j].x * rs * gg[j].x * (1.f + cc[j].x) + hh[j].x, y1 = v[j].y * rs * gg[j].y * (1.f + cc[j].y) + hh[j].y;
      const float y2 = v[j].z * rs * gg[j].z * (1.f + cc[j].z) + hh[j].z, y3 = v[j].w * rs * gg[j].w * (1.f + cc[j].w) + hh[j].w;
      u32x2 w; w.x = cvtpk(y0, y1); w.y = cvtpk(y2, y3);
      o[64 * j] = w;
    }
#pragma unroll
    for (int j = 0; j < 4; ++j) v[j] = vn[j];
    row = nrow;
  }
}

namespace pg8 {
#define PG8_LAS __attribute__((address_space(3)))
typedef unsigned short bf16_t;
typedef short bf16x8 __attribute__((ext_vector_type(8)));
typedef float f32x4 __attribute__((ext_vector_type(4)));
typedef unsigned u32x4 __attribute__((ext_vector_type(4)));
constexpr int BM = 256, BK = 64, HALF = 128, HTB = HALF * BK * 2  , STAGE_BYTES = 8 * HTB, NXCD = 8, WGM = 8;

__host__ __device__ __forceinline__ int lds_byte(int r, int c) { const int st = (r >> 4) * 2 + (c >> 5), rr = r & 15, cc = c & 31, ob = rr * 64 + cc * 2; return st * 1024 + (ob ^ (((ob >> 9) & 1) << 5)); }
__host__ __device__ __forceinline__ void stage_rc(int b, int& R, int& C) { const int st = b / 1024, sb = b % 1024, swz = sb ^ (((sb >> 9) & 1) << 5); R = (st >> 1) * 16 + swz / 64; C = (st & 1) * 32 + (swz % 64) / 2; }
__host__ __device__ __forceinline__ int perm32(int rho) { const int n = rho >> 4, i = rho & 15; return 8 * (i >> 2) + 4 * n + (i & 3); }

struct Unit { int pm, pn; };
struct Gemm { const bf16_t* A; const bf16_t* Bt; int M, N, K; };

struct StaticOrder {
    int nM, nN, nwg, G, c;
    __host__ __device__ void init(int M, int N, int G_, int c_) { nM = M / BM; nN = N / BM; nwg = nM * nN; G = G_; c = c_; }
    __host__ __device__ bool next(int i, Unit& u) const {
        const long L = (long)i * G + c; if (L >= nwg) return false;
        int wgid = (int)L; { const int q = nwg / NXCD, r = nwg % NXCD, xcd = wgid % NXCD, off = wgid / NXCD; wgid = (xcd < r ? xcd * (q + 1) : r * (q + 1) + (xcd - r) * q) + off; }
        const int nig = WGM * nN, gid = wgid / nig, fm = gid * WGM, gsz = (nM - fm) < WGM ? (nM - fm) : WGM;
        u.pm = fm + ((wgid % nig) % gsz); u.pn = (wgid % nig) / gsz; return true;
    }
    __device__ __forceinline__ void a_ready(const Unit&) const {}
    __device__ __forceinline__ void done(const Unit&) const {}
};
__device__ __forceinline__ unsigned cvt_pk_bf16(float lo, float hi) { unsigned r; asm volatile("v_cvt_pk_bf16_f32 %0, %1, %2" : "=v"(r) : "v"(lo), "v"(hi)); return r; }
template <class Epi, class Sched, bool ALIGN_EPI = false, bool SP2 = false>
__device__ __forceinline__ void gemm_phase(PG8_LAS unsigned char* lds, const Gemm g, const Sched& S, const Epi& E) {
    const int tid = tidx(), wid = __builtin_amdgcn_readfirstlane(tid >> 6), lane = tid & 63, wr = wid >> 2, wc = wid & 3, fr = lane & 15, fq = lane >> 4;
    const int K = g.K, nt = K / BK;
    unsigned voffA[2], voffB[2];
#pragma unroll
    for (int i = 0; i < 2; ++i) { int R, C; stage_rc(tid * 16 + i * 8192, R, C); const int Rb = Epi::PERM ? ((R & ~31) + perm32(R & 31)) : R;
        voffA[i] = (unsigned)(R * K + C) * 2u; voffB[i] = (unsigned)(Rb * K + C) * 2u; }
    const size_t kstep = (size_t)(BK * 2);
    const size_t hstep = (size_t)HALF * K * 2;
    const size_t tstep = 2 * hstep;
    const unsigned ldsw = (unsigned)wid * 1024u;
    const int aoff = lds_byte(wr * 64 + fr, fq * 8), boff = lds_byte(wc * 32 + fr, fq * 8);
#define PG8_SA(b, h) (((b) * 2 + (h)) * HTB)
#define PG8_SB(b, h) ((4 + (b) * 2 + (h)) * HTB)
#define PG8_STAGE(bufoff, gbase, voff) do { _Pragma("unroll") for (int _i = 0; _i < 2; ++_i) \
        __builtin_amdgcn_global_load_lds((const unsigned*)((const char*)(gbase) + (voff)[_i]), (PG8_LAS unsigned*)(lds + (bufoff) + ldsw + _i * 8192), 16, 0, 0); } while (0)
#define PG8_LDA(dst, b, h) do { _Pragma("unroll") for (int m = 0; m < 4; ++m) _Pragma("unroll") for (int k = 0; k < 2; ++k) dst[m][k] = *(const PG8_LAS bf16x8*)(lds + PG8_SA(b, h) + aoff + m * 2048 + k * 1024); } while (0)
#define PG8_LDB(dst, b, h) do { _Pragma("unroll") for (int n = 0; n < 2; ++n) _Pragma("unroll") for (int k = 0; k < 2; ++k) dst[n][k] = *(const PG8_LAS bf16x8*)(lds + PG8_SB(b, h) + boff + n * 2048 + k * 1024); } while (0)
#define PG8_MMA(ai, bj, At, Bt) do { __builtin_amdgcn_s_setprio(1); _Pragma("unroll") for (int m = 0; m < 4; ++m) _Pragma("unroll") for (int n = 0; n < 2; ++n) _Pragma("unroll") for (int k = 0; k < 2; ++k) \
        acc[ai][bj][m][n] = __builtin_amdgcn_mfma_f32_16x16x32_bf16(Bt[n][k], At[m][k], acc[ai][bj][m][n], 0, 0, 0); __builtin_amdgcn_s_setprio(0); } while (0)
#define PG8_WAIT_V(n) asm volatile("s_waitcnt vmcnt(" #n ")" ::: "memory")
#define PG8_WAIT_L(n) asm volatile("s_waitcnt lgkmcnt(" #n ")" ::: "memory")
#define PG8_BAR __builtin_amdgcn_s_barrier()
#define PG8_SCHED __builtin_amdgcn_sched_barrier(0)
    Unit cur, nxt; int ui = 0;
    if (!S.next(0, cur)) return;
    f32x4 acc[2][2][4][2];
#pragma unroll
    for (int a = 0; a < 2; ++a)
#pragma unroll
        for (int b = 0; b < 2; ++b)
#pragma unroll
            for (int m = 0; m < 4; ++m)
#pragma unroll
                for (int n = 0; n < 2; ++n) acc[a][b][m][n] = (f32x4){0.f, 0.f, 0.f, 0.f};
    bf16x8 At[4][2], B0[2][2], B1[2][2];
    const char* cA = (const char*)g.A + (size_t)cur.pm * tstep; const char* cB = (const char*)g.Bt + (size_t)cur.pn * tstep;
    S.a_ready(cur);
    if constexpr (SP2) {
        PG8_STAGE(PG8_SB(0, 0), cB, voffB); PG8_STAGE(PG8_SB(0, 1), cB + hstep, voffB); PG8_STAGE(PG8_SA(0, 0), cA, voffA); PG8_STAGE(PG8_SA(0, 1), cA + hstep, voffA);
        if (wr == 1) PG8_BAR;
        PG8_WAIT_V(2); PG8_BAR;
        PG8_STAGE(PG8_SB(1, 0), cB + kstep, voffB); PG8_STAGE(PG8_SA(1, 0), cA + kstep, voffA); PG8_STAGE(PG8_SB(1, 1), cB + hstep + kstep, voffB);
        PG8_WAIT_V(6); PG8_BAR;
    } else {
        PG8_STAGE(PG8_SB(0, 0), cB, voffB); PG8_STAGE(PG8_SA(0, 0), cA, voffA); PG8_STAGE(PG8_SB(0, 1), cB + hstep, voffB); PG8_STAGE(PG8_SA(0, 1), cA + hstep, voffA);
        if (wr == 1) PG8_BAR;
        PG8_WAIT_V(4); PG8_BAR;
        PG8_STAGE(PG8_SB(1, 0), cB + kstep, voffB); PG8_STAGE(PG8_SA(1, 0), cA + kstep, voffA); PG8_STAGE(PG8_SB(1, 1), cB + hstep + kstep, voffB);
        PG8_WAIT_V(6); PG8_BAR;
    }
    for (;;) {
        const bool has_next = S.next(ui + 1, nxt);
        const char* nA = has_next ? (const char*)g.A + (size_t)nxt.pm * tstep : cA; const char* nB = has_next ? (const char*)g.Bt + (size_t)nxt.pn * tstep : cB;
        for (int t = 0; t < nt; t += 2) {
            const bool last = (t == nt - 2);
            const char* a1 = cA + (size_t)(t + 1) * kstep;
            const char* a2 = last ? nA : cA + (size_t)(t + 2) * kstep; const char* b2 = last ? nB : cB + (size_t)(t + 2) * kstep;
            const char* a3 = a2 + kstep; const char* b3 = b2 + kstep;
            if (last && has_next) S.a_ready(nxt);
            if constexpr (SP2) {
            PG8_LDB(B0, 0, 0); PG8_LDB(B1, 0, 1); PG8_SCHED; PG8_LDA(At, 0, 0); PG8_STAGE(PG8_SA(1, 1), a1 + hstep, voffA);
            PG8_WAIT_V(8); PG8_WAIT_L(0); PG8_BAR; PG8_MMA(0, 0, At, B0); PG8_MMA(0, 1, At, B1); PG8_BAR; PG8_SCHED;
            PG8_LDA(At, 0, 1); PG8_STAGE(PG8_SB(0, 0), b2, voffB); PG8_STAGE(PG8_SB(0, 1), b2 + hstep, voffB); PG8_STAGE(PG8_SA(0, 0), a2, voffA);
            PG8_WAIT_V(8); PG8_WAIT_L(0); PG8_BAR; PG8_MMA(1, 0, At, B0); PG8_MMA(1, 1, At, B1); PG8_BAR; PG8_SCHED;
            PG8_LDB(B0, 1, 0); PG8_LDB(B1, 1, 1); PG8_SCHED; PG8_LDA(At, 1, 0); PG8_STAGE(PG8_SA(0, 1), a2 + hstep, voffA);
            PG8_WAIT_V(8); PG8_WAIT_L(0); PG8_BAR; PG8_MMA(0, 0, At, B0); PG8_MMA(0, 1, At, B1); PG8_BAR; PG8_SCHED;
            PG8_LDA(At, 1, 1); PG8_STAGE(PG8_SB(1, 0), b3, voffB); PG8_STAGE(PG8_SB(1, 1), b3 + hstep, voffB); PG8_STAGE(PG8_SA(1, 0), a3, voffA);
            PG8_WAIT_V(8); PG8_WAIT_L(0); PG8_BAR; PG8_MMA(1, 0, At, B0); PG8_MMA(1, 1, At, B1); PG8_BAR; PG8_SCHED;
            } else {
            PG8_LDB(B0, 0, 0); PG8_SCHED; PG8_LDA(At, 0, 0); PG8_STAGE(PG8_SA(1, 1), a1 + hstep, voffA);
            PG8_WAIT_L(8); PG8_BAR; PG8_WAIT_L(0); PG8_MMA(0, 0, At, B0); PG8_BAR; PG8_SCHED;
            PG8_LDB(B1, 0, 1); PG8_STAGE(PG8_SB(0, 0), b2, voffB);
            PG8_BAR; PG8_WAIT_L(0); PG8_MMA(0, 1, At, B1); PG8_BAR;
            PG8_LDA(At, 0, 1); PG8_STAGE(PG8_SA(0, 0), a2, voffA);
            PG8_BAR; PG8_WAIT_L(0); PG8_MMA(1, 0, At, B0); PG8_BAR; PG8_SCHED;
            PG8_STAGE(PG8_SB(0, 1), b2 + hstep, voffB);
            PG8_WAIT_V(6); PG8_BAR; PG8_MMA(1, 1, At, B1); PG8_BAR;
            PG8_LDB(B0, 1, 0); PG8_SCHED; PG8_LDA(At, 1, 0); PG8_STAGE(PG8_SA(0, 1), a2 + hstep, voffA);
            PG8_WAIT_L(8); PG8_BAR; PG8_WAIT_L(0); PG8_MMA(0, 0, At, B0); PG8_BAR; PG8_SCHED;
            PG8_LDB(B1, 1, 1); PG8_STAGE(PG8_SB(1, 0), b3, voffB);
            PG8_BAR; PG8_WAIT_L(0); PG8_MMA(0, 1, At, B1); PG8_BAR;
            PG8_LDA(At, 1, 1); PG8_STAGE(PG8_SA(1, 0), a3, voffA);
            PG8_BAR; PG8_WAIT_L(0); PG8_MMA(1, 0, At, B0); PG8_BAR; PG8_SCHED;
            PG8_STAGE(PG8_SB(1, 1), b3 + hstep, voffB);
            PG8_WAIT_V(6); PG8_BAR; PG8_MMA(1, 1, At, B1); PG8_BAR;
            }
        }
        if constexpr (ALIGN_EPI) { if (wr == 0) PG8_BAR; }
        if constexpr (!Epi::AFTER_DRAIN) { E(acc, cur, wr, wc, fr, fq); S.done(cur); }
        if (!has_next) break;
#pragma unroll
        for (int a = 0; a < 2; ++a)
#pragma unroll
            for (int b = 0; b < 2; ++b)
#pragma unroll
                for (int m = 0; m < 4; ++m)
#pragma unroll
                    for (int n = 0; n < 2; ++n) acc[a][b][m][n] = (f32x4){0.f, 0.f, 0.f, 0.f};
        cur = nxt; cA = nA; cB = nB; ++ui;
        if constexpr (ALIGN_EPI) { if (wr == 1) PG8_BAR; }
    }
    PG8_WAIT_V(0);
    if constexpr (!ALIGN_EPI) { if (wr == 0) PG8_BAR; }
    PG8_BAR;
    if constexpr (Epi::AFTER_DRAIN) { E.fused(acc, cur, wr, wc, fr, fq, lds, wid, lane); S.done(cur); }
#undef PG8_SA
#undef PG8_SB
#undef PG8_STAGE
#undef PG8_LDA
#undef PG8_LDB
#undef PG8_MMA
#undef PG8_WAIT_V
#undef PG8_WAIT_L
#undef PG8_BAR
#undef PG8_SCHED
}
}

__device__ __forceinline__ int gswz(int row, int chunk) { return row * 128 + ((chunk ^ ((row >> 1) & 7)) << 4); }
__device__ __forceinline__ void gemm_tile(const bf16_t* __restrict__ A, int lda, const bf16_t* __restrict__ Bt, int ldb, int K,
                                          int row0, int col0, unsigned char* lds, f32x16 (&acc)[2][2]) {
  int tid_ = tidx(); asm volatile("" : "+v"(tid_)); const int tid = tid_, lane = tid & 63, wid = tid >> 6, wm = wid >> 1, wn = wid & 1, r32 = lane & 31, hi = lane >> 5;
  unsigned char* As = lds; unsigned char* Bs = lds + 65536;
#pragma unroll
  for (int i = 0; i < 2; ++i)
#pragma unroll
    for (int j = 0; j < 2; ++j) acc[i][j] = f32x16{};
  const int lrow = tid >> 3, lc = tid & 7;
  const bf16_t* Ag = A + (size_t)(row0 + lrow) * lda + lc * 8;
  const bf16_t* Bg = Bt + (size_t)(col0 + lrow) * ldb + lc * 8;
  u32x4 ra[4], rb[2];
#pragma unroll
  for (int i = 0; i < 4; ++i) ra[i] = *(const u32x4*)(Ag + (size_t)(64 * i) * lda);
#pragma unroll
  for (int i = 0; i < 2; ++i) rb[i] = *(const u32x4*)(Bg + (size_t)(64 * i) * ldb);
#pragma unroll
  for (int i = 0; i < 4; ++i) *(u32x4*)(As + gswz(lrow + 64 * i, lc)) = ra[i];
#pragma unroll
  for (int i = 0; i < 2; ++i) *(u32x4*)(Bs + gswz(lrow + 64 * i, lc)) = rb[i];
  __syncthreads();
  const int nk = K / 64;
  for (int kt = 0; kt < nk; ++kt) {
    const int cur = kt & 1;
    if (kt + 1 < nk) {
#pragma unroll
      for (int i = 0; i < 4; ++i) ra[i] = *(const u32x4*)(Ag + (size_t)(64 * i) * lda + (kt + 1) * 64);
#pragma unroll
      for (int i = 0; i < 2; ++i) rb[i] = *(const u32x4*)(Bg + (size_t)(64 * i) * ldb + (kt + 1) * 64);
    }
    const unsigned char* Ac = As + cur * 32768; const unsigned char* Bc = Bs + cur * 16384;
#pragma unroll
    for (int kk = 0; kk < 4; ++kk) {
      bf16x8 af[2], bfr[2];
#pragma unroll
      for (int i = 0; i < 2; ++i) af[i] = *(const bf16x8*)(Ac + gswz(wm * 64 + i * 32 + r32, 2 * kk + hi));
#pragma unroll
      for (int j = 0; j < 2; ++j) bfr[j] = *(const bf16x8*)(Bc + gswz(wn * 64 + j * 32 + r32, 2 * kk + hi));
#pragma unroll
      for (int i = 0; i < 2; ++i)
#pragma unroll
        for (int j = 0; j < 2; ++j) acc[i][j] = __builtin_amdgcn_mfma_f32_32x32x16_bf16(af[i], bfr[j], acc[i][j], 0, 0, 0);
    }
    if (kt + 1 < nk) {
      unsigned char* An = As + (cur ^ 1) * 32768; unsigned char* Bn = Bs + (cur ^ 1) * 16384;
#pragma unroll
      for (int i = 0; i < 4; ++i) *(u32x4*)(An + gswz(lrow + 64 * i, lc)) = ra[i];
#pragma unroll
      for (int i = 0; i < 2; ++i) *(u32x4*)(Bn + gswz(lrow + 64 * i, lc)) = rb[i];
    }
    __syncthreads();
  }
}
__device__ __forceinline__ void pair_xchg(float v0, float v1, int lane, float& lo, float& hi2) {
  const bool odd = lane & 1;
  const float send = odd ? v0 : v1;
  const float recv = dpp_mov<0xB1>(send);
  lo = odd ? recv : v0; hi2 = odd ? v1 : recv;
}

__device__ __forceinline__ void phase_inproj(const Params& p, int l, unsigned char* lds) {
  int tid_ = tidx(); asm volatile("" : "+v"(tid_)); const int tid = tid_, lane = tid & 63, wid = tid >> 6, wm = wid >> 1, wn = wid & 1, r32 = lane & 31, hi = lane >> 5;
  const bf16_t* H = (const bf16_t*)(p.ws + WS_H);
  const bf16_t* W = (const bf16_t*)(p.ws + WS_WIN) + (size_t)l * PW * DM;
  bf16_t* PROJ = (bf16_t*)(p.ws + WS_PROJ);
  const float* RC = (const float*)(p.ws + WS_ROPE); const float* RS = RC + SEQ * 32;
  constexpr int NM = T / 256, NN = PW / 128, NU = NM * NN;
  for (int u = p.bx; u < NU + NM; u += p.gx) {
    if (u < NU) {
      const int pn = u / NM, pm = u % NM;
      const int row0 = pm * 256, col0 = pn * 128;
      f32x16 acc[2][2];
      gemm_tile(H, DM, W, DM, DM, row0, col0, lds, acc);
      const bool rope = (col0 >= C_DQ && col0 < C_DV);
      const float scl = (col0 >= C_MK && col0 < C_MV) ? 0.125f : ((col0 >= C_DQ && col0 < C_DK) ? QSCALE : 1.f);
#pragma unroll
      for (int i = 0; i < 2; ++i)
#pragma unroll
        for (int j = 0; j < 2; ++j)
#pragma unroll
          for (int q = 0; q < 8; ++q) {
            float lo, hi2; pair_xchg(acc[i][j][2 * q], acc[i][j][2 * q + 1], lane, lo, hi2);
            const int row = row0 + wm * 64 + i * 32 + crow(2 * q, hi) + (lane & 1);
            const int col = col0 + wn * 64 + j * 32 + (r32 & ~1);
            if (rope) {
              const int s = row % SEGL;
              if (s >= CTXL) {
                const int idx = (s - CTXL) * 32 + ((col & 63) >> 1);
                const float c = RC[idx], sn = RS[idx];
                const float t1 = lo, t2 = hi2; lo = t1 * c - t2 * sn; hi2 = t1 * sn + t2 * c;
              }
            }
            *(unsigned*)(PROJ + (size_t)row * PW + col) = cvtpk(lo * scl, hi2 * scl);
          }
    } else {
      const int pm = u - NU, rowb = pm * 256 + wid * 32;
      const bf16_t* WG = (const bf16_t*)(p.ws + WS_WG) + (size_t)l * 16 * DM;
      float* GT = (float*)(p.ws + WS_GATES);
      const int r16 = lane & 15, q4 = lane >> 4;
      f32x4 c0 = {0.f, 0.f, 0.f, 0.f}, c1 = {0.f, 0.f, 0.f, 0.f};
      const bf16_t* a0p = H + (size_t)(rowb + r16) * DM + q4 * 8;
      const bf16_t* a1p = a0p + (size_t)16 * DM;
      const bf16_t* bp = WG + (size_t)r16 * DM + q4 * 8;
#pragma unroll 4
      for (int ks = 0; ks < 32; ++ks) {
        const bf16x8 a0 = *(const bf16x8*)(a0p + ks * 32), a1 = *(const bf16x8*)(a1p + ks * 32), b = *(const bf16x8*)(bp + ks * 32);
        c0 = __builtin_amdgcn_mfma_f32_16x16x32_bf16(a0, b, c0, 0, 0, 0);
        c1 = __builtin_amdgcn_mfma_f32_16x16x32_bf16(a1, b, c1, 0, 0, 0);
      }
      const float gb = p.in[I_GATEB][l * 16 + r16];
#pragma unroll
      for (int j = 0; j < 4; ++j) {
        GT[(size_t)(rowb + q4 * 4 + j) * 16 + r16] = c0[j] + gb;
        GT[(size_t)(rowb + 16 + q4 * 4 + j) * 16 + r16] = c1[j] + gb;
      }
    }
  }
}

__device__ __forceinline__ void phase_outproj(const Params& p, int l, unsigned char* lds) {
  int tid_ = tidx(); asm volatile("" : "+v"(tid_)); const int tid = tid_, lane = tid & 63, wid = tid >> 6, wm = wid >> 1, wn = wid & 1, r32 = lane & 31, hi = lane >> 5;
  const bf16_t* MIX = (const bf16_t*)(p.ws + WS_MIX);
  const bf16_t* W = (const bf16_t*)(p.ws + WS_WOUT) + (size_t)l * DM * DM;
  float* XC = (float*)(p.ws + WS_XCUR);
  const float* MOD = (const float*)(p.ws + WS_MOD);
  constexpr int NM = T / 256, NN = DM / 128, NU = NM * NN;
  for (int u = p.bx; u < NU; u += p.gx) {
    const int pm = u / NN, pn = u % NN;
    if (l == DEPTH - 1 && (pm % 33) == 0) continue;
    const int row0 = pm * 256, col0 = pn * 128;
    for (int rep = 0; rep < REP_OUTP; ++rep) {
    f32x16 acc[2][2];
    gemm_tile(MIX, DM, W, DM, DM, row0, col0, lds, acc);
    const int mr = (pm % 33) == 0 ? 4 : pm / 33;
    const float* g1 = MOD + ((size_t)l * 5 + mr) * 6144 + 2048;
#pragma unroll
    for (int i = 0; i < 2; ++i)
#pragma unroll
      for (int j = 0; j < 2; ++j) {
        const int col = col0 + wn * 64 + j * 32 + r32;
        const float gg = (rep == REP_OUTP - 1) ? g1[col] : 0.f;
#pragma unroll
        for (int r = 0; r < 16; ++r) {
          const int row = row0 + wm * 64 + i * 32 + crow(r, hi);
          const float xo = (l == 0) ? in_row(p.in[I_X], p.in[I_CTX], row)[col] : XC[(size_t)row * DM + col];
          XC[(size_t)row * DM + col] = xo + gg * acc[i][j][r];
        }
      }
    }
  }
}
__device__ __forceinline__ void phase_peerq(const Params& p, int l, unsigned char* lds) {
  int tid_ = tidx(); asm volatile("" : "+v"(tid_)); const int tid = tid_, lane = tid & 63, wid = tid >> 6, wm = wid >> 1, wn = wid & 1, r32 = lane & 31, hi = lane >> 5;
  const bf16_t* H = (const bf16_t*)(p.ws + WS_H);
  const bf16_t* W = (const bf16_t*)(p.ws + WS_WQ) + (size_t)l * DM * DM;
  bf16_t* QP = (bf16_t*)(p.ws + WS_PROJ);
  constexpr int NM = T / 256, NN = DM / 128, NU = NM * NN;
  for (int u = p.bx; u < NU; u += p.gx) {
    const int pm = u / NN, pn = u % NN;
    if (l == DEPTH - 1 && (pm % 33) == 0) continue;
    const int row0 = pm * 256, col0 = pn * 128;
    f32x16 acc[2][2];
    gemm_tile(H, DM, W, DM, DM, row0, col0, lds, acc);
#pragma unroll
    for (int i = 0; i < 2; ++i)
#pragma unroll
      for (int j = 0; j < 2; ++j)
#pragma unroll
        for (int q = 0; q < 8; ++q) {
          float lo, hi2; pair_xchg(acc[i][j][2 * q], acc[i][j][2 * q + 1], lane, lo, hi2);
          const int row = row0 + wm * 64 + i * 32 + crow(2 * q, hi) + (lane & 1);
          const int col = col0 + wn * 64 + j * 32 + (r32 & ~1);
          *(unsigned*)(QP + (size_t)row * DM + col) = cvtpk(lo, hi2);
        }
  }
}


struct EpiInproj {
  static constexpr bool PERM = true, AFTER_DRAIN = false;
  bf16_t* PROJ; const float* RC; const float* RS; unsigned char* V8T;
  __device__ __forceinline__ void operator()(const pg8::f32x4 (&acc)[2][2][4][2], const pg8::Unit& u, int wr, int wc, int fr, int fq) const {
#pragma unroll
    for (int bj = 0; bj < 2; ++bj) {
      const int colt = u.pn * 256 + bj * 128;
      const bool rope = (colt >= C_DQ && colt < C_DV);
      const float scl = (colt >= C_MK && colt < C_MV) ? 0.125f : ((colt >= C_DQ && colt < C_DK) ? QSCALE : 1.f);
      const int col8 = colt + wc * 32 + 8 * fq;
      if (colt >= C_DV) {
        const int hh = (col8 - C_DV) >> 7, e0 = (col8 - C_DV) & 127;
#pragma unroll
        for (int ai = 0; ai < 2; ++ai)
#pragma unroll
          for (int m = 0; m < 4; ++m) {
            const int row = u.pm * 256 + ai * 128 + wr * 64 + m * 16 + fr;
            const int b = row / SEGL, s = row - b * SEGL, t = s >> 6, kk = s & 63;
            const int slot = ((kk >> 2) & 1) * 32 + (kk & 3) + 4 * ((kk >> 3) & 3) + 16 * (kk >> 5);
            unsigned char* vp = V8T + ((size_t)((b * 4 + hh) * NCH + t) * 128 + e0) * 80 + slot;
            const f32x4 v0 = acc[ai][bj][m][0], v1 = acc[ai][bj][m][1];
            int w0 = 0, w1 = 0;
            w0 = __builtin_amdgcn_cvt_pk_fp8_f32(v0[0], v0[1], w0, false); w0 = __builtin_amdgcn_cvt_pk_fp8_f32(v0[2], v0[3], w0, true);
            w1 = __builtin_amdgcn_cvt_pk_fp8_f32(v1[0], v1[1], w1, false); w1 = __builtin_amdgcn_cvt_pk_fp8_f32(v1[2], v1[3], w1, true);
            vp[0] = (unsigned char)(w0 & 0xFF); vp[80] = (unsigned char)((w0 >> 8) & 0xFF); vp[160] = (unsigned char)((w0 >> 16) & 0xFF); vp[240] = (unsigned char)((w0 >> 24) & 0xFF);
            vp[320] = (unsigned char)(w1 & 0xFF); vp[400] = (unsigned char)((w1 >> 8) & 0xFF); vp[480] = (unsigned char)((w1 >> 16) & 0xFF); vp[560] = (unsigned char)((w1 >> 24) & 0xFF);
          }
        continue;
      }
      unsigned char* qk8 = nullptr;
      if (rope) { const int isk = colt >= C_DK, cc = col8 - (isk ? C_DK : C_DQ); qk8 = V8T + (WS_QK8 - WS_V8T) + (size_t)isk * QK8_IMG + (size_t)(cc >> 7) * SEGL * QK8_PITCH + (cc & 127); }
#pragma unroll
      for (int ai = 0; ai < 2; ++ai)
#pragma unroll
        for (int m = 0; m < 4; ++m) {
          const int row = u.pm * 256 + ai * 128 + wr * 64 + m * 16 + fr;
          f32x4 v0 = acc[ai][bj][m][0], v1 = acc[ai][bj][m][1];
          if (rope) {
            const int s = row % SEGL;
            if (s >= CTXL) {
              const int idx = (s - CTXL) * 32 + ((col8 & 63) >> 1);
              const f32x4 c = *(const f32x4*)(RC + idx), sn = *(const f32x4*)(RS + idx);
              f32x4 a, b;
              a[0] = v0[0] * c[0] - v0[1] * sn[0]; a[1] = v0[0] * sn[0] + v0[1] * c[0]; a[2] = v0[2] * c[1] - v0[3] * sn[1]; a[3] = v0[2] * sn[1] + v0[3] * c[1];
              b[0] = v1[0] * c[2] - v1[1] * sn[2]; b[1] = v1[0] * sn[2] + v1[1] * c[2]; b[2] = v1[2] * c[3] - v1[3] * sn[3]; b[3] = v1[2] * sn[3] + v1[3] * c[3];
              v0 = a; v1 = b;
            }
          }
          if (rope) {
            const int b = row / SEGL, s = row - b * SEGL;
            int w0, w1; asm volatile("" : "=v"(w0), "=v"(w1));
            w0 = __builtin_amdgcn_cvt_pk_fp8_f32(v0[0] * scl, v0[1] * scl, w0, false); w0 = __builtin_amdgcn_cvt_pk_fp8_f32(v0[2] * scl, v0[3] * scl, w0, true);
            w1 = __builtin_amdgcn_cvt_pk_fp8_f32(v1[0] * scl, v1[1] * scl, w1, false); w1 = __builtin_amdgcn_cvt_pk_fp8_f32(v1[2] * scl, v1[3] * scl, w1, true);
            *(u32x2*)(qk8 + ((size_t)b * 4 * SEGL + s) * QK8_PITCH) = (u32x2){(unsigned)w0, (unsigned)w1};
            continue;
          }
          u32x4 w; w.x = cvtpk(v0[0] * scl, v0[1] * scl); w.y = cvtpk(v0[2] * scl, v0[3] * scl); w.z = cvtpk(v1[0] * scl, v1[1] * scl); w.w = cvtpk(v1[2] * scl, v1[3] * scl);
          *(u32x4*)(PROJ + (size_t)row * PW + col8) = w;
        }
    }
  }
};
struct EpiOutproj {
  static constexpr bool PERM = true, AFTER_DRAIN = false;
  float* XC; const float* MODL; const float* xin; const float* ctxin; int first; float gsc;
  __device__ __forceinline__ void operator()(const pg8::f32x4 (&acc)[2][2][4][2], const pg8::Unit& u, int wr, int wc, int fr, int fq) const {
    const int mr = (u.pm % 33) == 0 ? 4 : u.pm / 33;
    const float* g1 = MODL + (size_t)mr * 6144 + 2048;
#pragma unroll
    for (int bj = 0; bj < 2; ++bj) {
      const int col8 = u.pn * 256 + bj * 128 + wc * 32 + 8 * fq;
      const f32x4 ga = *(const f32x4*)(g1 + col8) * gsc, gb = *(const f32x4*)(g1 + col8 + 4) * gsc;
#pragma unroll
      for (int ai = 0; ai < 2; ++ai)
#pragma unroll
        for (int m = 0; m < 4; ++m) {
          const int row = u.pm * 256 + ai * 128 + wr * 64 + m * 16 + fr;
          const float* xo = first ? in_row(xin, ctxin, row) + col8 : XC + (size_t)row * DM + col8;
          const f32x4 xa = *(const f32x4*)xo, xb = *(const f32x4*)(xo + 4);
          *(f32x4*)(XC + (size_t)row * DM + col8) = xa + ga * acc[ai][bj][m][0];
          *(f32x4*)(XC + (size_t)row * DM + col8 + 4) = xb + gb * acc[ai][bj][m][1];
        }
    }
  }
};
struct EpiPeerq {
  static constexpr bool PERM = true, AFTER_DRAIN = false;
  bf16_t* QP;
  __device__ __forceinline__ void operator()(const pg8::f32x4 (&acc)[2][2][4][2], const pg8::Unit& u, int wr, int wc, int fr, int fq) const {
#pragma unroll
    for (int bj = 0; bj < 2; ++bj) {
      const int col8 = u.pn * 256 + bj * 128 + wc * 32 + 8 * fq;
#pragma unroll
      for (int ai = 0; ai < 2; ++ai)
#pragma unroll
        for (int m = 0; m < 4; ++m) {
          const int row = u.pm * 256 + ai * 128 + wr * 64 + m * 16 + fr;
          const f32x4 v0 = acc[ai][bj][m][0], v1 = acc[ai][bj][m][1];
          u32x4 w; w.x = cvtpk(v0[0], v0[1]); w.y = cvtpk(v0[2], v0[3]); w.z = cvtpk(v1[0], v1[1]); w.w = cvtpk(v1[2], v1[3]);
          *(u32x4*)(QP + (size_t)row * DM + col8) = w;
        }
    }
  }
};
__device__ __forceinline__ void phase_inproj2(const Params& p, int l, unsigned char* lds) {
  {
    pg8::Gemm g{(const bf16_t*)(p.ws + WS_H), (const bf16_t*)(p.ws + WS_WIN) + (size_t)l * PW * DM, T, PW, DM};
    pg8::StaticOrder S; S.init(T, PW, p.gx, p.bx);
    EpiInproj E{(bf16_t*)(p.ws + WS_PROJ), (const float*)(p.ws + WS_ROPE), (const float*)(p.ws + WS_ROPE) + SEQ * 32, p.ws + WS_V8T};
    pg8::gemm_phase<EpiInproj, pg8::StaticOrder, true, true>((PG8_LAS unsigned char*)lds, g, S, E);
  }
  int tid_ = tidx(); asm volatile("" : "+v"(tid_)); const int tid = tid_, lane = tid & 63, wid = tid >> 6;
  const bf16_t* H = (const bf16_t*)(p.ws + WS_H);
  for (int pm = p.gx - 1 - p.bx; pm < T / 256; pm += p.gx) {
    const int rowb = pm * 256 + wid * 32;
    const bf16_t* WG = (const bf16_t*)(p.ws + WS_WG) + (size_t)l * 16 * DM;
    float* GT = (float*)(p.ws + WS_GATES);
    const int r16 = lane & 15, q4 = lane >> 4;
    f32x4 c0 = {0.f, 0.f, 0.f, 0.f}, c1 = {0.f, 0.f, 0.f, 0.f};
    const bf16_t* a0p = H + (size_t)(rowb + r16) * DM + q4 * 8;
    const bf16_t* a1p = a0p + (size_t)16 * DM;
    const bf16_t* bp = WG + (size_t)r16 * DM + q4 * 8;
#pragma unroll 4
    for (int ks = 0; ks < 32; ++ks) {
      const bf16x8 a0 = *(const bf16x8*)(a0p + ks * 32), a1 = *(const bf16x8*)(a1p + ks * 32), b = *(const bf16x8*)(bp + ks * 32);
      c0 = __builtin_amdgcn_mfma_f32_16x16x32_bf16(a0, b, c0, 0, 0, 0);
      c1 = __builtin_amdgcn_mfma_f32_16x16x32_bf16(a1, b, c1, 0, 0, 0);
    }
    const float gb = p.in[I_GATEB][l * 16 + r16];
#pragma unroll
    for (int j = 0; j < 4; ++j) {
      GT[(size_t)(rowb + q4 * 4 + j) * 16 + r16] = c0[j] + gb;
      GT[(size_t)(rowb + 16 + q4 * 4 + j) * 16 + r16] = c1[j] + gb;
    }
  }
}
__device__ __forceinline__ void phase_outproj2(const Params& p, int l, unsigned char* lds) {
  pg8::Gemm g{(const bf16_t*)(p.ws + WS_MIX), (const bf16_t*)(p.ws + WS_WOUT) + (size_t)l * DM * DM, T, DM, DM};
  pg8::StaticOrder S; S.init(T, DM, p.gx, p.bx);
  for (int rep = 0; rep < REP_OUTP; ++rep) {
  EpiOutproj E{(float*)(p.ws + WS_XCUR), (const float*)(p.ws + WS_MOD) + (size_t)l * 5 * 6144, p.in[I_X], p.in[I_CTX], l == 0, (rep == REP_OUTP - 1) ? 1.f : 0.f};
  pg8::gemm_phase<EpiOutproj, pg8::StaticOrder, true, true>((PG8_LAS unsigned char*)lds, g, S, E);
  }
  tail_filler_tables(p, l, (T / 256) * (DM / 256), l == 0 ? 0 : NEXP, 2 * NEXP);
}
__device__ __forceinline__ void phase_peerq2(const Params& p, int l, unsigned char* lds) {
  pg8::Gemm g{(const bf16_t*)(p.ws + WS_H), (const bf16_t*)(p.ws + WS_WQ) + (size_t)l * DM * DM, T, DM, DM};
  pg8::StaticOrder S; S.init(T, DM, p.gx, p.bx);
  EpiPeerq E{(bf16_t*)(p.ws + WS_PROJ)};
  pg8::gemm_phase<EpiPeerq, pg8::StaticOrder, true, true>((PG8_LAS unsigned char*)lds, g, S, E);
  if (l < DEPTH - 1) tail_filler_tables(p, l + 1, (T / 256) * (DM / 256), 0, NEXP);
}

__device__ __forceinline__ void conv_unit(const Params& p, int l, int unit, unsigned char* lds) {
  int tid_ = tidx(); asm volatile("" : "+v"(tid_)); const int tid = tid_, lane = tid & 63, wid = tid >> 6;
  float* U = (float*)lds;
  const bf16_t* PROJ = (const bf16_t*)(p.ws + WS_PROJ);
  bf16_t* MIX = (bf16_t*)(p.ws + WS_MIX);
  const int row0 = unit * 32, b = row0 / SEGL, s0 = row0 - b * SEGL;
  const int seglo = s0 < CTXL ? 0 : CTXL, seghi = s0 < CTXL ? CTXL : SEGL;
  for (int rr = tid >> 5; rr < 62; rr += 16) {
    const int s = s0 - 15 + rr, c8 = (tid & 31) * 8;
    f32x4 u0 = {0.f, 0.f, 0.f, 0.f}, u1 = {0.f, 0.f, 0.f, 0.f};
    if (s >= seglo && s < seghi) {
      const bf16_t* pr = PROJ + (size_t)(b * SEGL + s) * PW + c8;
      const u32x4 a1 = *(const u32x4*)pr, a2 = *(const u32x4*)(pr + 256);
      u0.x = bflo(a1.x) * sigmoidf_(bflo(a2.x)); u0.y = bfhi(a1.x) * sigmoidf_(bfhi(a2.x));
      u0.z = bflo(a1.y) * sigmoidf_(bflo(a2.y)); u0.w = bfhi(a1.y) * sigmoidf_(bfhi(a2.y));
      u1.x = bflo(a1.z) * sigmoidf_(bflo(a2.z)); u1.y = bfhi(a1.z) * sigmoidf_(bfhi(a2.z));
      u1.z = bflo(a1.w) * sigmoidf_(bflo(a2.w)); u1.w = bfhi(a1.w) * sigmoidf_(bfhi(a2.w));
    }
    *(f32x4*)(U + rr * 256 + c8) = u0; *(f32x4*)(U + rr * 256 + c8 + 4) = u1;
  }
  __syncthreads();
  float* Y = U + 62 * 256;
  const float* cw = p.in[I_CONVW] + (size_t)l * 31 * 256;
#pragma unroll 1
  for (int q = 0; q < 4; ++q) {
    const int c = lane + 64 * q;
    float w[31];
#pragma unroll
    for (int j = 0; j < 31; ++j) w[j] = cw[j * 256 + c];
    const float bias = p.in[I_CONVB][l * 256 + c];
#pragma unroll
    for (int tt = 0; tt < 4; ++tt) {
      const int t = wid * 4 + tt;
      float a = bias;
#pragma unroll
      for (int j = 0; j < 31; ++j) a += U[(t + j) * 256 + c] * w[j];
      Y[t * 256 + c] = a;
    }
  }
  asm volatile("s_waitcnt lgkmcnt(0)" ::: "memory");
  float y[4][4];
#pragma unroll
  for (int tt = 0; tt < 4; ++tt)
#pragma unroll
    for (int q = 0; q < 4; ++q) y[tt][q] = Y[(wid * 4 + tt) * 256 + lane + 64 * q];
#pragma unroll
  for (int tt = 0; tt < 4; ++tt) {
    const int t = wid * 4 + tt;
    const float mean = wave_sum((y[tt][0] + y[tt][1]) + (y[tt][2] + y[tt][3])) * (1.f / 256.f);
    float v = 0.f;
#pragma unroll
    for (int q = 0; q < 4; ++q) { const float d = y[tt][q] - mean; v += d * d; }
    const float rs = rsqrtf(wave_sum(v) * (1.f / 256.f) + EPS);
#pragma unroll
    for (int q = 0; q < 4; ++q) {
      const int c = lane + 64 * q;
      const float z = (y[tt][q] - mean) * rs * p.in[I_CLNG][l * 256 + c] + p.in[I_CLNB][l * 256 + c];
      const float o = (ABL & 1) ? 0.f : z * sigmoidf_(z);
      MIX[(size_t)(row0 + t) * DM + c] = (bf16_t)(cvtpk(o, 0.f) & 0xffffu);
    }
  }
  __syncthreads();
}

__device__ __forceinline__ int ml_cidx(int ch, int dir) { return dir == 0 ? ch : (ch < 4 ? 3 - ch : 135 - ch); }
__device__ __forceinline__ void ml_load_tile(const bf16_t* src, float* dst, int tid) {
  const int r = tid >> 3, c8 = (tid & 7) * 8;
  const u32x4 a = *(const u32x4*)(src + (size_t)r * PW + c8);
  float* d = dst + r * 65 + c8;
  d[0] = bflo(a.x); d[1] = bfhi(a.x); d[2] = bflo(a.y); d[3] = bfhi(a.y); d[4] = bflo(a.z); d[5] = bfhi(a.z); d[6] = bflo(a.w); d[7] = bfhi(a.w);
}
__device__ __forceinline__ void ml_local_unit(const Params& p, int l, int unit, unsigned char* lds) {
  int tid_ = tidx(); asm volatile("" : "+v"(tid_)); const int tid = tid_, lane = tid & 63, wid = tid >> 6, r32 = lane & 31, hi = lane >> 5;
  float* Kt = (float*)lds; float* Vt = Kt + 64 * 65; float* WK = Vt + 64 * 65;
  const bf16_t* PROJ = (const bf16_t*)(p.ws + WS_PROJ);
  const float* GT = (const float*)(p.ws + WS_GATES);
  float* UL = (float*)(p.ws + WS_ULOC); float* META = (float*)(p.ws + WS_MLMETA);
  const int b = unit / (4 * NCH), hh = (unit / NCH) & 3, ch = unit % NCH;
  const int row0 = b * SEGL + ch * 64;
  ml_load_tile(PROJ + (size_t)row0 * PW + C_MK + hh * 64, Kt, tid);
  ml_load_tile(PROJ + (size_t)row0 * PW + C_MV + hh * 64, Vt, tid);
  if (wid < 2) {
    const int dir = wid;
    const float ig = GT[(size_t)(row0 + lane) * 16 + (2 * dir) * 4 + hh];
    const float lf = logsigmoidf_(GT[(size_t)(row0 + lane) * 16 + (2 * dir + 1) * 4 + hh]);
    float ps = lf;
    ps = wave_incl_scan(ps);
    const float tot = __uint_as_float((unsigned)__builtin_amdgcn_readlane((int)__float_as_uint(ps), 63));
    const float wlog = dir == 0 ? (tot - ps + ig) : (ps - lf + ig);
    const float mloc = wave_max(wlog);
    WK[dir * 64 + lane] = __expf(wlog - mloc);
    if (lane == 0) {
      const int seq = (b * 4 + hh) * 2 + dir, ci = ml_cidx(ch, dir);
      META[((size_t)seq * NCH + ci) * 4 + 0] = tot; META[((size_t)seq * NCH + ci) * 4 + 1] = mloc;
    }
  }
  __syncthreads();
  {
    const int dir = wid >> 2, et = (wid >> 1) & 1, dt = wid & 1;
    const int seq = (b * 4 + hh) * 2 + dir, ci = ml_cidx(ch, dir);
    float* slot = UL + ((size_t)seq * NCH + ci) * USTRIDE;
    f32x16 acc = {};
#pragma unroll 8
    for (int ks = 0; ks < 32; ++ks) {
      const int s = 2 * ks + hi;
      const float a = WK[dir * 64 + s] * Vt[s * 65 + et * 32 + r32];
      const float bb = Kt[s * 65 + dt * 32 + r32];
      acc = __builtin_amdgcn_mfma_f32_32x32x2f32(a, bb, acc, 0, 0, 0);
    }
#pragma unroll
    for (int r = 0; r < 16; ++r) slot[(et * 32 + crow(r, hi)) * 64 + dt * 32 + r32] = acc[r];
    if (et == 0) {
      float n = 0.f;
#pragma unroll 8
      for (int i = 0; i < 32; ++i) { const int s = hi * 32 + i; n += WK[dir * 64 + s] * Kt[s * 65 + dt * 32 + r32]; }
      n = sum_xor32(n);
      if (hi == 0) slot[4096 + dt * 32 + r32] = n;
    }
  }
  __syncthreads();
}
constexpr int MLP = 144;
constexpr size_t WS_CST = WS_H;
constexpr size_t WS_NST = WS_H + (size_t)32 * NCH * 4096 * 2;
__device__ __forceinline__ void ml_stage_rm(const bf16_t* src, size_t ld, unsigned char* dst, int tid) {
  const int r = tid >> 3, c8 = (tid & 7) * 8;
  *(u32x4*)(dst + r * MLP + c8 * 2) = *(const u32x4*)(src + (size_t)r * ld + c8);
}
__device__ __forceinline__ void ml_stage_tr(const bf16_t* src, size_t ld, unsigned char* dst, int tid) {
  const int r = tid >> 3, c8 = (tid & 7) * 8;
  const u32x4 a = *(const u32x4*)(src + (size_t)r * ld + c8);
  bf16_t* d = (bf16_t*)dst;
  d[(c8 + 0) * 72 + r] = (bf16_t)(a.x & 0xffffu); d[(c8 + 1) * 72 + r] = (bf16_t)(a.x >> 16);
  d[(c8 + 2) * 72 + r] = (bf16_t)(a.y & 0xffffu); d[(c8 + 3) * 72 + r] = (bf16_t)(a.y >> 16);
  d[(c8 + 4) * 72 + r] = (bf16_t)(a.z & 0xffffu); d[(c8 + 5) * 72 + r] = (bf16_t)(a.z >> 16);
  d[(c8 + 6) * 72 + r] = (bf16_t)(a.w & 0xffffu); d[(c8 + 7) * 72 + r] = (bf16_t)(a.w >> 16);
}
__device__ __forceinline__ void ml_local_unit2(const Params& p, int l, int unit, unsigned char* lds) {
  int tid_ = tidx(); asm volatile("" : "+v"(tid_)); const int tid = tid_, lane = tid & 63, wid = tid >> 6, r32 = lane & 31, hi = lane >> 5;
  unsigned char* KT = lds; unsigned char* VT = lds + 64 * MLP; float* WK = (float*)(lds + 2 * 64 * MLP);
  const bf16_t* PROJ = (const bf16_t*)(p.ws + WS_PROJ);
  const float* GT = (const float*)(p.ws + WS_GATES);
  float* UL = (float*)(p.ws + WS_ULOC); float* META = (float*)(p.ws + WS_MLMETA);
  const int b = unit / (4 * NCH), hh = (unit / NCH) & 3, ch = unit % NCH;
  const int row0 = b * SEGL + ch * 64;
  ml_stage_tr(PROJ + (size_t)row0 * PW + C_MK + hh * 64, PW, KT, tid);
  ml_stage_tr(PROJ + (size_t)row0 * PW + C_MV + hh * 64, PW, VT, tid);
  if (wid < 2) {
    const int dir = wid;
    const float ig = GT[(size_t)(row0 + lane) * 16 + (2 * dir) * 4 + hh];
    const float lf = logsigmoidf_(GT[(size_t)(row0 + lane) * 16 + (2 * dir + 1) * 4 + hh]);
    float ps = lf;
    ps = wave_incl_scan(ps);
    const float tot = __uint_as_float((unsigned)__builtin_amdgcn_readlane((int)__float_as_uint(ps), 63));
    const float wlog = dir == 0 ? (tot - ps + ig) : (ps - lf + ig);
    const float mloc = wave_max(wlog);
    WK[dir * 64 + lane] = __expf(wlog - mloc);
    if (lane == 0) {
      const int seq = (b * 4 + hh) * 2 + dir, ci = ml_cidx(ch, dir);
      META[((size_t)seq * NCH + ci) * 4 + 0] = tot; META[((size_t)seq * NCH + ci) * 4 + 1] = mloc;
    }
  }
  __syncthreads();
  {
    const int dir = wid >> 2, et = (wid >> 1) & 1, dt = wid & 1;
    const int seq = (b * 4 + hh) * 2 + dir, ci = ml_cidx(ch, dir);
    float* slot = UL + ((size_t)seq * NCH + ci) * USTRIDE;
    f32x16 acc = {};
#pragma unroll
    for (int ks = 0; ks < 4; ++ks) {
      const int s0 = ks * 16 + hi * 8;
      const u32x4 va = *(const u32x4*)(VT + (et * 32 + r32) * MLP + s0 * 2);
      const bf16x8 kb = *(const bf16x8*)(KT + (dt * 32 + r32) * MLP + s0 * 2);
      const f32x4 w0 = *(const f32x4*)(WK + dir * 64 + s0), w1 = *(const f32x4*)(WK + dir * 64 + s0 + 4);
      u32x4 sa; sa.x = cvtpk(bflo(va.x) * w0.x, bfhi(va.x) * w0.y); sa.y = cvtpk(bflo(va.y) * w0.z, bfhi(va.y) * w0.w);
      sa.z = cvtpk(bflo(va.z) * w1.x, bfhi(va.z) * w1.y); sa.w = cvtpk(bflo(va.w) * w1.z, bfhi(va.w) * w1.w);
      acc = __builtin_amdgcn_mfma_f32_32x32x16_bf16(*(const bf16x8*)&sa, kb, acc, 0, 0, 0);
    }
#pragma unroll
    for (int r = 0; r < 16; ++r) slot[(et * 32 + crow(r, hi)) * 64 + dt * 32 + r32] = acc[r];
    if (et == 0) {
      float n = 0.f;
#pragma unroll
      for (int i = 0; i < 4; ++i) {
        const int s0 = hi * 32 + i * 8;
        const u32x4 ka = *(const u32x4*)(KT + (dt * 32 + r32) * MLP + s0 * 2);
        const f32x4 w0 = *(const f32x4*)(WK + dir * 64 + s0), w1 = *(const f32x4*)(WK + dir * 64 + s0 + 4);
        n += bflo(ka.x) * w0.x + bfhi(ka.x) * w0.y + bflo(ka.y) * w0.z + bfhi(ka.y) * w0.w + bflo(ka.z) * w1.x + bfhi(ka.z) * w1.y + bflo(ka.w) * w1.z + bfhi(ka.w) * w1.w;
      }
      n = sum_xor32(n);
      if (hi == 0) slot[4096 + dt * 32 + r32] = n;
    }
  }
  __syncthreads();
}
__device__ __forceinline__ void ml_scan(const Params& p, unsigned char* lds) {
  float* UL = (float*)(p.ws + WS_ULOC); float* META = (float*)(p.ws + WS_MLMETA);
  int tid_ = tidx(); asm volatile("" : "+v"(tid_));
  const int tid = tid_, lane = tid & 63, wid = tid >> 6;
  float* DEC = (float*)lds;
  float* SCL = DEC + 2 * NCH;
  float* TMP = SCL + 2 * NCH;
  constexpr int NSL = (32 * USTRIDE + 511) / 512;
  const int first_ = p.gx > 64 ? 16 : 0, nb_ = p.gx - first_;
  for (int k_ = 0; k_ < 2 + (NSL + nb_ - 1) / nb_; ++k_) {
    int s_;
    if (k_ == 0) s_ = p.bx >= first_ ? p.bx - first_ : -1;
    else s_ = k_ * nb_ + (p.gx - 1 - p.bx);
    if (k_ > 0 && p.gx - 1 - p.bx >= nb_) s_ = -1;
    if (s_ < 0 || s_ >= NSL) continue;
    const int base0 = s_ * 512;
    const int seq0 = base0 / USTRIDE;
    if (wid < 2) {
      const int seq = seq0 + wid;
      if (seq < 32) {
        float* mt = META + (size_t)seq * NCH * 4;
        for (int c = lane; c < NCH; c += 64) { TMP[(wid * 2 + 0) * NCH + c] = mt[c * 4 + 0]; TMP[(wid * 2 + 1) * NCH + c] = mt[c * 4 + 1]; }
        asm volatile("s_waitcnt lgkmcnt(0)" ::: "memory");
        if (lane == 0) {
          float m = 0.f;
          for (int c = 0; c < NCH; ++c) {
            const float bl = TMP[(wid * 2 + 0) * NCH + c], mloc = TMP[(wid * 2 + 1) * NCH + c];
            const float mn = fmaxf(bl + m, mloc);
            DEC[wid * NCH + c] = __expf(bl + m - mn); SCL[wid * NCH + c] = __expf(mloc - mn);
            mt[c * 4 + 2] = m;
            m = mn;
          }
        }
      }
    }
    __syncthreads();
    const int idx = base0 + tid;
    if (idx < 32 * USTRIDE) {
      const int seq = idx / USTRIDE, e = idx - seq * USTRIDE, sl = seq - seq0;
      float* bp = UL + (size_t)seq * NCH * USTRIDE + e;
      bf16_t* CSTp = (bf16_t*)(p.ws + WS_CST) + (size_t)seq * NCH * 4096 + (e < 4096 ? e : 0);
      float* NSTp = (float*)(p.ws + WS_NST) + (size_t)seq * NCH * 64 + (e < 4096 ? 0 : e - 4096);
      const float* dec = DEC + sl * NCH; const float* scl = SCL + sl * NCH;
      float C = 0.f;
      constexpr int BT = 33;
      static_assert(NCH == 4 * BT, "scan batches");
      float ua[BT], ub[BT];
#define SCAN_LD(u_, c0_) _Pragma("unroll") for (int j = 0; j < BT; ++j) u_[j] = bp[(size_t)((c0_) + j) * USTRIDE];
#define SCAN_DO(u_, c0_) _Pragma("unroll") for (int j = 0; j < BT; ++j) { \
          if (e < 4096) CSTp[(size_t)((c0_) + j) * 4096] = (bf16_t)(cvtpk(C, 0.f) & 0xffffu); else NSTp[(size_t)((c0_) + j) * 64] = C; \
          C = dec[(c0_) + j] * C + scl[(c0_) + j] * u_[j]; }
      SCAN_LD(ua, 0)
#pragma unroll 1
      for (int c0 = 0; c0 < NCH; c0 += 2 * BT) {
        SCAN_LD(ub, c0 + BT)
        SCAN_DO(ua, c0)
        if (c0 + 2 * BT < NCH) { SCAN_LD(ua, c0 + 2 * BT) }
        SCAN_DO(ub, c0 + BT)
      }
#undef SCAN_LD
#undef SCAN_DO
    }
    __syncthreads();
  }
}
__device__ __forceinline__ void ml_out_unit(const Params& p, int l, int unit, unsigned char* lds) {
  int tid_ = tidx(); asm volatile("" : "+v"(tid_)); const int tid = tid_, lane = tid & 63, wid = tid >> 6, r32 = lane & 31, hi = lane >> 5;
  float* Qt = (float*)lds; float* Kt = Qt + 64 * 65; float* Vt = Kt + 64 * 65;
  float* Cs = Vt + 64 * 65;
  float* Ns = Cs + 2 * 64 * 65;
  float* Bq = Ns + 128;
  float* Gs = Bq + 128;
  float* Mi = Gs + 128;
  float* HB = Mi + 64;
  const bf16_t* PROJ = (const bf16_t*)(p.ws + WS_PROJ);
  const float* GT = (const float*)(p.ws + WS_GATES);
  const float* UL = (const float*)(p.ws + WS_ULOC); const float* META = (const float*)(p.ws + WS_MLMETA);
  bf16_t* MIX = (bf16_t*)(p.ws + WS_MIX);
  const int b = unit / (4 * NCH), hh = (unit / NCH) & 3, ch = unit % NCH;
  const int row0 = b * SEGL + ch * 64;
  ml_load_tile(PROJ + (size_t)row0 * PW + C_MQ + hh * 64, Qt, tid);
  ml_load_tile(PROJ + (size_t)row0 * PW + C_MK + hh * 64, Kt, tid);
  ml_load_tile(PROJ + (size_t)row0 * PW + C_MV + hh * 64, Vt, tid);
  for (int i = tid; i < 2 * USTRIDE; i += 512) {
    const int dir = i / USTRIDE, e = i - dir * USTRIDE;
    const int seq = (b * 4 + hh) * 2 + dir, ci = ml_cidx(ch, dir);
    const float v = UL[((size_t)seq * NCH + ci) * USTRIDE + e];
    if (e < 4096) Cs[dir * 64 * 65 + (e >> 6) * 65 + (e & 63)] = v; else Ns[dir * 64 + (e - 4096)] = v;
  }
  if (wid < 2) {
    const int dir = wid;
    const float ig = GT[(size_t)(row0 + lane) * 16 + (2 * dir) * 4 + hh];
    const float lf = logsigmoidf_(GT[(size_t)(row0 + lane) * 16 + (2 * dir + 1) * 4 + hh]);
    float ps = lf;
    ps = wave_incl_scan(ps);
    const float tot = __uint_as_float((unsigned)__builtin_amdgcn_readlane((int)__float_as_uint(ps), 63));
    const float bc = dir == 0 ? ps : (tot - ps + lf);
    Bq[dir * 64 + lane] = bc; Gs[dir * 64 + lane] = ig - bc;
    if (lane == 0) { const int seq = (b * 4 + hh) * 2 + dir, ci = ml_cidx(ch, dir); Mi[dir] = META[((size_t)seq * NCH + ci) * 4 + 2]; }
  }
  __syncthreads();
  {
    const int dir = wid >> 2, tt = (wid >> 1) & 1, et = wid & 1;
    const int t = tt * 32 + r32;
    f32x16 sa[2] = {};
#pragma unroll 4
    for (int ks = 0; ks < 32; ++ks) {
      const float bq = Qt[t * 65 + 2 * ks + hi];
      const float a0 = Kt[(r32) * 65 + 2 * ks + hi], a1 = Kt[(32 + r32) * 65 + 2 * ks + hi];
      sa[0] = __builtin_amdgcn_mfma_f32_32x32x2f32(a0, bq, sa[0], 0, 0, 0);
      sa[1] = __builtin_amdgcn_mfma_f32_32x32x2f32(a1, bq, sa[1], 0, 0, 0);
    }
    const float bt = Bq[dir * 64 + t];
    const float inter = bt + Mi[dir];
    float mx = -INFINITY;
    f32x16 dl[2];
#pragma unroll
    for (int st = 0; st < 2; ++st)
#pragma unroll
      for (int r = 0; r < 16; ++r) {
        const int s = st * 32 + crow(r, hi);
        const bool ok = dir == 0 ? (s <= t) : (s >= t);
        const float d = ok ? bt + Gs[dir * 64 + s] : -INFINITY;
        dl[st][r] = d; mx = fmaxf(mx, d);
      }
    mx = max_xor32(mx);
    const float mt = fmaxf(inter, mx);
    const float iw = __expf(inter - mt);
    float rsum = 0.f;
#pragma unroll
    for (int st = 0; st < 2; ++st)
#pragma unroll
      for (int r = 0; r < 16; ++r) { const float w = __expf(dl[st][r] - mt); sa[st][r] *= w; rsum += sa[st][r]; }
    rsum = sum_xor32(rsum);
    float qn = 0.f;
#pragma unroll 8
    for (int i = 0; i < 32; ++i) { const int d = hi * 32 + i; qn += Ns[dir * 64 + d] * Qt[t * 65 + d]; }
    qn = sum_xor32(qn);
    const float den = rsum + iw * qn;
    const float rden = 1.f / fmaxf(fabsf(den), __expf(-mt));
    f32x16 an = {}, ac = {};
#pragma unroll
    for (int st = 0; st < 2; ++st)
#pragma unroll
      for (int r = 0; r < 16; ++r) {
        const float a = Vt[(st * 32 + crow(r, hi)) * 65 + et * 32 + r32];
        an = __builtin_amdgcn_mfma_f32_32x32x2f32(a, sa[st][r], an, 0, 0, 0);
      }
    const float* Cd = Cs + dir * 64 * 65;
#pragma unroll 4
    for (int ks = 0; ks < 32; ++ks) {
      const float a = Cd[(et * 32 + r32) * 65 + 2 * ks + hi];
      const float bq = Qt[t * 65 + 2 * ks + hi];
      ac = __builtin_amdgcn_mfma_f32_32x32x2f32(a, bq, ac, 0, 0, 0);
    }
#pragma unroll
    for (int r = 0; r < 16; ++r) HB[dir * 64 * 65 + t * 65 + et * 32 + crow(r, hi)] = (an[r] + iw * ac[r]) * rden;
  }
  __syncthreads();
  {
    const int t = tid >> 3, e8 = (tid & 7) * 8;
    float v[8]; float ss = 0.f;
#pragma unroll
    for (int i = 0; i < 8; ++i) { v[i] = HB[t * 65 + e8 + i] + HB[64 * 65 + t * 65 + e8 + i]; ss += v[i] * v[i]; }
    ss += dpp_mov<0xB1>(ss); ss += dpp_mov<0x4E>(ss); ss += dpp_mov<0x141>(ss);
    const float rs = rsqrtf(ss * (1.f / 64.f) + EPS);
    const u32x4 ov = *(const u32x4*)(PROJ + (size_t)(row0 + t) * PW + C_MO + hh * 64 + e8);
    const float og[8] = {bflo(ov.x), bfhi(ov.x), bflo(ov.y), bfhi(ov.y), bflo(ov.z), bfhi(ov.z), bflo(ov.w), bfhi(ov.w)};
    const float* g = p.in[I_MNORMG] + l * 64 + e8;
    float o[8];
#pragma unroll
    for (int i = 0; i < 8; ++i) o[i] = (ABL & 2) ? 0.f : v[i] * rs * g[i] * sigmoidf_(og[i]);
    u32x4 w; w.x = cvtpk(o[0], o[1]); w.y = cvtpk(o[2], o[3]); w.z = cvtpk(o[4], o[5]); w.w = cvtpk(o[6], o[7]);
    *(u32x4*)(MIX + (size_t)(row0 + t) * DM + 256 + hh * 64 + e8) = w;
  }
  __syncthreads();
}


struct MlOutPf { u32x4 q, k, v, c0, c1, ov; float ns0, ns1, g_ig, g_lf, mi; };
__device__ __forceinline__ void ml_out_fetch(const Params& p, int unit, int tid, MlOutPf& f) {
  const int lane = tid & 63, wid = tid >> 6;
  const bf16_t* PROJ = (const bf16_t*)(p.ws + WS_PROJ);
  const float* GT = (const float*)(p.ws + WS_GATES);
  const bf16_t* CST = (const bf16_t*)(p.ws + WS_CST); const float* NST = (const float*)(p.ws + WS_NST); const float* META = (const float*)(p.ws + WS_MLMETA);
  const int b = unit / (4 * NCH), hh = (unit / NCH) & 3, ch = unit % NCH;
  const int row0 = b * SEGL + ch * 64;
  const int r = tid >> 3, c8 = (tid & 7) * 8;
  const bf16_t* prow = PROJ + (size_t)(row0 + r) * PW + hh * 64 + c8;
  f.q = *(const u32x4*)(prow + C_MQ); f.k = *(const u32x4*)(prow + C_MK); f.v = *(const u32x4*)(prow + C_MV); f.ov = *(const u32x4*)(prow + C_MO);
  const int seq0 = (b * 4 + hh) * 2, ci0 = ml_cidx(ch, 0), ci1 = ml_cidx(ch, 1);
  f.c0 = *(const u32x4*)(CST + ((size_t)seq0 * NCH + ci0) * 4096 + r * 64 + c8);
  f.c1 = *(const u32x4*)(CST + ((size_t)(seq0 + 1) * NCH + ci1) * 4096 + r * 64 + c8);
  f.ns0 = 0.f; f.ns1 = 0.f; f.g_ig = 0.f; f.g_lf = 0.f; f.mi = 0.f;
  if (tid < 64) { f.ns0 = NST[((size_t)seq0 * NCH + ci0) * 64 + tid]; f.ns1 = NST[((size_t)(seq0 + 1) * NCH + ci1) * 64 + tid]; }
  if (wid < 2) {
    const int dir = wid;
    f.g_ig = GT[(size_t)(row0 + lane) * 16 + (2 * dir) * 4 + hh];
    f.g_lf = GT[(size_t)(row0 + lane) * 16 + (2 * dir + 1) * 4 + hh];
    f.mi = META[((size_t)(seq0 + dir) * NCH + (dir ? ci1 : ci0)) * 4 + 2];
  }
}
__device__ __forceinline__ void ml_put_rm(const u32x4 a, unsigned char* dst, int tid) { const int r = tid >> 3, c8 = (tid & 7) * 8; *(u32x4*)(dst + r * MLP + c8 * 2) = a; }
__device__ __forceinline__ void ml_put_tr(const u32x4 a, unsigned char* dst, int tid) {
  const int r = tid >> 3, c8 = (tid & 7) * 8;
  bf16_t* d = (bf16_t*)dst;
  d[(c8 + 0) * 72 + r] = (bf16_t)(a.x & 0xffffu); d[(c8 + 1) * 72 + r] = (bf16_t)(a.x >> 16);
  d[(c8 + 2) * 72 + r] = (bf16_t)(a.y & 0xffffu); d[(c8 + 3) * 72 + r] = (bf16_t)(a.y >> 16);
  d[(c8 + 4) * 72 + r] = (bf16_t)(a.z & 0xffffu); d[(c8 + 5) * 72 + r] = (bf16_t)(a.z >> 16);
  d[(c8 + 6) * 72 + r] = (bf16_t)(a.w & 0xffffu); d[(c8 + 7) * 72 + r] = (bf16_t)(a.w >> 16);
}
__device__ __forceinline__ void ml_out_unit2(const Params& p, int l, int unit, unsigned char* lds, const MlOutPf& f, int next, MlOutPf& fn) {
  int tid_ = tidx(); asm volatile("" : "+v"(tid_)); const int tid = tid_, lane = tid & 63, wid = tid >> 6, r32 = lane & 31, hi = lane >> 5;
  unsigned char* Qs = lds; unsigned char* Ks = lds + 64 * MLP; unsigned char* VT = lds + 2 * 64 * MLP; unsigned char* Cs = lds + 3 * 64 * MLP;
  float* Ns = (float*)(lds + 5 * 64 * MLP);
  float* Bq = Ns + 128;
  float* Gs = Bq + 128;
  float* Mi = Gs + 128;
  float* HB = Mi + 64;
  const bf16_t* PROJ = (const bf16_t*)(p.ws + WS_PROJ);
  const float* GT = (const float*)(p.ws + WS_GATES);
  const bf16_t* CST = (const bf16_t*)(p.ws + WS_CST); const float* NST = (const float*)(p.ws + WS_NST); const float* META = (const float*)(p.ws + WS_MLMETA);
  bf16_t* MIX = (bf16_t*)(p.ws + WS_MIX);
  const int b = unit / (4 * NCH), hh = (unit / NCH) & 3, ch = unit % NCH;
  const int row0 = b * SEGL + ch * 64;
  ml_put_rm(f.q, Qs, tid); ml_put_rm(f.k, Ks, tid); ml_put_tr(f.v, VT, tid);
  ml_put_rm(f.c0, Cs, tid); ml_put_rm(f.c1, Cs + 64 * MLP, tid);
  if (tid < 64) { Ns[tid] = f.ns0; Ns[64 + tid] = f.ns1; }
  if (wid < 2) {
    const int dir = wid;
    const float ig = f.g_ig;
    const float lf = logsigmoidf_(f.g_lf);
    float ps = lf;
    ps = wave_incl_scan(ps);
    const float tot = __uint_as_float((unsigned)__builtin_amdgcn_readlane((int)__float_as_uint(ps), 63));
    const float bc = dir == 0 ? ps : (tot - ps + lf);
    Bq[dir * 64 + lane] = bc; Gs[dir * 64 + lane] = ig - bc;
    if (lane == 0) Mi[dir] = f.mi;
  }
  const u32x4 ov = f.ov;
  if (next >= 0) ml_out_fetch(p, next, tid, fn);
  __syncthreads();
  {
    const int dir = wid >> 2, tt = (wid >> 1) & 1, et = wid & 1;
    const int t = tt * 32 + r32;
    f32x16 sa[2] = {};
    bf16x8 bq[4];
#pragma unroll
    for (int ks = 0; ks < 4; ++ks) {
      bq[ks] = *(const bf16x8*)(Qs + t * MLP + (ks * 16 + hi * 8) * 2);
      const bf16x8 a0 = *(const bf16x8*)(Ks + r32 * MLP + (ks * 16 + hi * 8) * 2), a1 = *(const bf16x8*)(Ks + (32 + r32) * MLP + (ks * 16 + hi * 8) * 2);
      sa[0] = __builtin_amdgcn_mfma_f32_32x32x16_bf16(a0, bq[ks], sa[0], 0, 0, 0);
      sa[1] = __builtin_amdgcn_mfma_f32_32x32x16_bf16(a1, bq[ks], sa[1], 0, 0, 0);
    }
    const float bt = Bq[dir * 64 + t];
    const float inter = bt + Mi[dir];
    float mx = -INFINITY;
    f32x16 dl[2];
#pragma unroll
    for (int st = 0; st < 2; ++st)
#pragma unroll
      for (int r = 0; r < 16; ++r) {
        const int s = st * 32 + crow(r, hi);
        const bool ok = dir == 0 ? (s <= t) : (s >= t);
        const float d = ok ? bt + Gs[dir * 64 + s] : -INFINITY;
        dl[st][r] = d; mx = fmaxf(mx, d);
      }
    mx = max_xor32(mx);
    const float mt = fmaxf(inter, mx);
    const float iw = __expf(inter - mt);
    float rsum = 0.f;
#pragma unroll
    for (int st = 0; st < 2; ++st)
#pragma unroll
      for (int r = 0; r < 16; ++r) { const float w = __expf(dl[st][r] - mt); sa[st][r] *= w; rsum += sa[st][r]; }
    rsum = sum_xor32(rsum);
    float qn = 0.f;
#pragma unroll
    for (int i = 0; i < 4; ++i) {
      const int d0 = hi * 32 + i * 8;
      const u32x4 qa = *(const u32x4*)(Qs + t * MLP + d0 * 2);
      const f32x4 n0 = *(const f32x4*)(Ns + dir * 64 + d0), n1 = *(const f32x4*)(Ns + dir * 64 + d0 + 4);
      qn += bflo(qa.x) * n0.x + bfhi(qa.x) * n0.y + bflo(qa.y) * n0.z + bfhi(qa.y) * n0.w + bflo(qa.z) * n1.x + bfhi(qa.z) * n1.y + bflo(qa.w) * n1.z + bfhi(qa.w) * n1.w;
    }
    qn = sum_xor32(qn);
    const float den = rsum + iw * qn;
    const float rden = 1.f / fmaxf(fabsf(den), __expf(-mt));
    f32x16 an = {}, ac = {};
#pragma unroll
    for (int st = 0; st < 2; ++st)
#pragma unroll
      for (int k2 = 0; k2 < 2; ++k2) {
        u32x4 bx; bx.x = cvtpk(sa[st][8 * k2 + 0], sa[st][8 * k2 + 1]); bx.y = cvtpk(sa[st][8 * k2 + 2], sa[st][8 * k2 + 3]);
        bx.z = cvtpk(sa[st][8 * k2 + 4], sa[st][8 * k2 + 5]); bx.w = cvtpk(sa[st][8 * k2 + 6], sa[st][8 * k2 + 7]);
        const unsigned char* vrow = VT + (et * 32 + r32) * MLP + (st * 32 + 16 * k2 + 4 * hi) * 2;
        const u32x2 v0 = *(const u32x2*)vrow, v1 = *(const u32x2*)(vrow + 16);
        u32x4 ax; ax.x = v0.x; ax.y = v0.y; ax.z = v1.x; ax.w = v1.y;
        an = __builtin_amdgcn_mfma_f32_32x32x16_bf16(*(const bf16x8*)&ax, *(const bf16x8*)&bx, an, 0, 0, 0);
      }
    const unsigned char* Cd = Cs + dir * 64 * MLP;
#pragma unroll
    for (int ks = 0; ks < 4; ++ks) {
      const bf16x8 a = *(const bf16x8*)(Cd + (et * 32 + r32) * MLP + (ks * 16 + hi * 8) * 2);
      ac = __builtin_amdgcn_mfma_f32_32x32x16_bf16(a, bq[ks], ac, 0, 0, 0);
    }
#pragma unroll
    for (int r = 0; r < 16; ++r) HB[dir * 64 * 65 + t * 65 + et * 32 + crow(r, hi)] = (an[r] + iw * ac[r]) * rden;
  }
  __syncthreads();
  {
    const int t = tid >> 3, e8 = (tid & 7) * 8;
    float v[8]; float ss = 0.f;
#pragma unroll
    for (int i = 0; i < 8; ++i) { v[i] = HB[t * 65 + e8 + i] + HB[64 * 65 + t * 65 + e8 + i]; ss += v[i] * v[i]; }
    ss += dpp_mov<0xB1>(ss); ss += dpp_mov<0x4E>(ss); ss += dpp_mov<0x141>(ss);
    const float rs = rsqrtf(ss * (1.f / 64.f) + EPS);
    const float og[8] = {bflo(ov.x), bfhi(ov.x), bflo(ov.y), bfhi(ov.y), bflo(ov.z), bfhi(ov.z), bflo(ov.w), bfhi(ov.w)};
    const float* g = p.in[I_MNORMG] + l * 64 + e8;
    float o[8];
#pragma unroll
    for (int i = 0; i < 8; ++i) o[i] = (ABL & 2) ? 0.f : v[i] * rs * g[i] * sigmoidf_(og[i]);
    u32x4 w; w.x = cvtpk(o[0], o[1]); w.y = cvtpk(o[2], o[3]); w.z = cvtpk(o[4], o[5]); w.w = cvtpk(o[6], o[7]);
    *(u32x4*)(MIX + (size_t)(row0 + t) * DM + 256 + hh * 64 + e8) = w;
  }
  __syncthreads();
}

#define KSWZ(row, colB) ((row) * 256 + ((colB) ^ (((row) & 15) << 4)))
#define SBAR() __builtin_amdgcn_sched_barrier(0)
constexpr int ATT_SHM_V = 128 * 80, ATT_SHM_K = 64 * QK8_PITCH;
constexpr float ATT_THR = 8.0f;
__device__ __forceinline__ int v_st(int k, int c) { const int kk = (k & ~0xC) | ((k & 4) << 1) | ((k & 8) >> 1); return ((kk >> 3) * 4 + (c >> 5)) * 512 + ((kk & 7) * 32 + (c & 31)) * 2; }
__device__ __forceinline__ int v_rd_base(int lane) { return ((lane & 3) << 3) | (((lane >> 2) & 3) << 6) | (((lane >> 4) & 1) << 5) | (((lane >> 5) & 1) << 8); }
constexpr int v_rd_off(int d0, int ks, int half) { return d0 * 512 + ks * 4096 + half * 2048; }
template <int OFF> __device__ __forceinline__ s16x4 tr_read(int vb) {
  s16x4 r; asm volatile("ds_read_b64_tr_b16 %0, %1 offset:%2" : "=&v"(r) : "v"(vb), "i"(OFF) : "memory"); return r;
}
template <int D0> __device__ __forceinline__ void pv_one(f32x16& od, int vb, bf16x8 pa0, bf16x8 pa1, bf16x8 pa2, bf16x8 pa3) {
  const s16x4 l0 = tr_read<v_rd_off(D0, 0, 0)>(vb), h0 = tr_read<v_rd_off(D0, 0, 1)>(vb), l1 = tr_read<v_rd_off(D0, 1, 0)>(vb), h1 = tr_read<v_rd_off(D0, 1, 1)>(vb);
  const s16x4 l2 = tr_read<v_rd_off(D0, 2, 0)>(vb), h2 = tr_read<v_rd_off(D0, 2, 1)>(vb), l3 = tr_read<v_rd_off(D0, 3, 0)>(vb), h3 = tr_read<v_rd_off(D0, 3, 1)>(vb);
  asm volatile("s_waitcnt lgkmcnt(0)" ::: "memory"); SBAR();
#define PK(L, H) (bf16x8){L[0], L[1], L[2], L[3], H[0], H[1], H[2], H[3]}
  od = __builtin_amdgcn_mfma_f32_32x32x16_bf16(pa0, PK(l0, h0), od, 0, 0, 0);
  od = __builtin_amdgcn_mfma_f32_32x32x16_bf16(pa1, PK(l1, h1), od, 0, 0, 0);
  od = __builtin_amdgcn_mfma_f32_32x32x16_bf16(pa2, PK(l2, h2), od, 0, 0, 0);
  od = __builtin_amdgcn_mfma_f32_32x32x16_bf16(pa3, PK(l3, h3), od, 0, 0, 0);
#undef PK
}
template <int D0> __device__ __forceinline__ void pv_two(f32x16& oa, f32x16& ob, int vb, bf16x8 a0, bf16x8 a1, bf16x8 a2, bf16x8 a3, bf16x8 b0, bf16x8 b1, bf16x8 b2, bf16x8 b3) {
  const s16x4 l0 = tr_read<v_rd_off(D0, 0, 0)>(vb), h0 = tr_read<v_rd_off(D0, 0, 1)>(vb), l1 = tr_read<v_rd_off(D0, 1, 0)>(vb), h1 = tr_read<v_rd_off(D0, 1, 1)>(vb);
  const s16x4 l2 = tr_read<v_rd_off(D0, 2, 0)>(vb), h2 = tr_read<v_rd_off(D0, 2, 1)>(vb), l3 = tr_read<v_rd_off(D0, 3, 0)>(vb), h3 = tr_read<v_rd_off(D0, 3, 1)>(vb);
  asm volatile("s_waitcnt lgkmcnt(0)" ::: "memory"); SBAR();
#define PK(L, H) (bf16x8){L[0], L[1], L[2], L[3], H[0], H[1], H[2], H[3]}
  const bf16x8 v0 = PK(l0, h0), v1 = PK(l1, h1), v2 = PK(l2, h2), v3 = PK(l3, h3);
  oa = __builtin_amdgcn_mfma_f32_32x32x16_bf16(a0, v0, oa, 0, 0, 0);
  ob = __builtin_amdgcn_mfma_f32_32x32x16_bf16(b0, v0, ob, 0, 0, 0);
  oa = __builtin_amdgcn_mfma_f32_32x32x16_bf16(a1, v1, oa, 0, 0, 0);
  ob = __builtin_amdgcn_mfma_f32_32x32x16_bf16(b1, v1, ob, 0, 0, 0);
  oa = __builtin_amdgcn_mfma_f32_32x32x16_bf16(a2, v2, oa, 0, 0, 0);
  ob = __builtin_amdgcn_mfma_f32_32x32x16_bf16(b2, v2, ob, 0, 0, 0);
  oa = __builtin_amdgcn_mfma_f32_32x32x16_bf16(a3, v3, oa, 0, 0, 0);
  ob = __builtin_amdgcn_mfma_f32_32x32x16_bf16(b3, v3, ob, 0, 0, 0);
#undef PK
}
struct KQFrag { bf16x8 b0, b1, q; };
__device__ __forceinline__ void att_ldkq(KQFrag& f, const LAS unsigned char* l3, int akk, int akq) {
  const LAS unsigned char* kp = l3 + akk;
  f.b0 = *(const LAS bf16x8*)kp; f.b1 = *(const LAS bf16x8*)(kp + 8192); f.q = *(const LAS bf16x8*)(l3 + akq);
}
#define ATT_MF(pa_, pb_, f_) do { pa_ = __builtin_amdgcn_mfma_f32_32x32x16_bf16(f_.b0, f_.q, pa_, 0, 0, 0); pb_ = __builtin_amdgcn_mfma_f32_32x32x16_bf16(f_.b1, f_.q, pb_, 0, 0, 0); } while (0)
__device__ __forceinline__ void att_qk_all(f32x16& p0, f32x16& p1, f32x16& q0, f32x16& q1, KQFrag& f0, const LAS unsigned char* l3, int akk0, int akq0, float ia, float ib) {
  KQFrag f1;
#pragma unroll
  for (int r = 0; r < 16; ++r) { p0[r] = ia; p1[r] = ia; q0[r] = ib; q1[r] = ib; }
  att_ldkq(f1, l3, akk0 ^ (1 << 5), akq0 ^ (1 << 5)); ATT_MF(p0, p1, f0); SBAR();
  att_ldkq(f0, l3, akk0 ^ (2 << 5), akq0 ^ (2 << 5)); ATT_MF(p0, p1, f1); SBAR();
  att_ldkq(f1, l3, akk0 ^ (3 << 5), akq0 ^ (3 << 5)); ATT_MF(p0, p1, f0); SBAR();
  att_ldkq(f0, l3, akk0 ^ (4 << 5), akq0 ^ (4 << 5)); ATT_MF(p0, p1, f1); SBAR();
  att_ldkq(f1, l3, akk0 ^ (5 << 5), akq0 ^ (5 << 5)); ATT_MF(q0, q1, f0); SBAR();
  att_ldkq(f0, l3, akk0 ^ (6 << 5), akq0 ^ (6 << 5)); ATT_MF(q0, q1, f1); SBAR();
  att_ldkq(f1, l3, akk0 ^ (7 << 5), akq0 ^ (7 << 5)); ATT_MF(q0, q1, f0); SBAR();
  ATT_MF(q0, q1, f1); SBAR();
}
__device__ __forceinline__ void att_softmax(f32x16& p0, f32x16& p1, float& m_reg, float& l_reg, float& alpha, bool first, i32x8& pa) {
  alpha = 1.f;
  if (first) {
    float pmax = p0[0];
#pragma unroll
    for (int r = 1; r < 16; ++r) pmax = fmaxf(pmax, p0[r]);
#pragma unroll
    for (int r = 0; r < 16; ++r) pmax = fmaxf(pmax, p1[r]);
    { auto rr = __builtin_amdgcn_permlane32_swap(__float_as_uint(pmax), __float_as_uint(pmax), false, false);
      pmax = fmaxf(__uint_as_float(rr[0]), __uint_as_float(rr[1])); }
    alpha = 0.f; m_reg = pmax;
#pragma unroll
    for (int r = 0; r < 16; ++r) { p0[r] -= pmax; p1[r] -= pmax; }
  }
#pragma unroll
  for (int r = 0; r < 16; ++r) { p0[r] = __builtin_amdgcn_exp2f(p0[r]); p1[r] = __builtin_amdgcn_exp2f(p1[r]); }
  float ps;
  {
#define VADD(d_, a_, b_) asm("v_add_f32_e32 %0, %1, %2" : "=v"(d_) : "v"(a_), "v"(b_))
    float s0, s1, s2, s3;
    VADD(s0, p0[0], p0[1]); VADD(s1, p0[8], p0[9]); VADD(s2, p1[0], p1[1]); VADD(s3, p1[8], p1[9]);
#pragma unroll
    for (int r = 2; r < 8; ++r) { VADD(s0, s0, p0[r]); VADD(s1, s1, p0[8 + r]); VADD(s2, s2, p1[r]); VADD(s3, s3, p1[8 + r]); }
    VADD(s0, s0, s1); VADD(s2, s2, s3); VADD(ps, s0, s2);
#undef VADD
  }
  { auto rr = __builtin_amdgcn_permlane32_swap(__float_as_uint(ps), __float_as_uint(ps), false, false);
    ps = __uint_as_float(rr[0]) + __uint_as_float(rr[1]); }
  if (__builtin_expect(!first && __any(ps > 256.f), 0)) {
    float emax = p0[0];
#pragma unroll
    for (int r = 1; r < 16; ++r) emax = fmaxf(emax, p0[r]);
#pragma unroll
    for (int r = 0; r < 16; ++r) emax = fmaxf(emax, p1[r]);
    { auto rr = __builtin_amdgcn_permlane32_swap(__float_as_uint(emax), __float_as_uint(emax), false, false);
      emax = fmaxf(__uint_as_float(rr[0]), __uint_as_float(rr[1])); }
    const float delta = fmaxf(__builtin_amdgcn_logf(emax), 0.f);
    alpha = __builtin_amdgcn_exp2f(-delta); m_reg += delta;
#pragma unroll
    for (int r = 0; r < 16; ++r) { p0[r] *= alpha; p1[r] *= alpha; }
    ps *= alpha;
  }
  l_reg = l_reg * alpha + ps;
#pragma unroll
  for (int v = 0; v < 4; ++v) {
    int w0, w1; asm volatile("" : "=v"(w0), "=v"(w1));
    w0 = __builtin_amdgcn_cvt_pk_fp8_f32(p0[4 * v], p0[4 * v + 1], w0, false); w0 = __builtin_amdgcn_cvt_pk_fp8_f32(p0[4 * v + 2], p0[4 * v + 3], w0, true);
    w1 = __builtin_amdgcn_cvt_pk_fp8_f32(p1[4 * v], p1[4 * v + 1], w1, false); w1 = __builtin_amdgcn_cvt_pk_fp8_f32(p1[4 * v + 2], p1[4 * v + 3], w1, true);
    pa[v] = w0; pa[4 + v] = w1;
  }
}
__device__ __forceinline__ void att_unit(const unsigned char* __restrict__ Q8, const unsigned char* __restrict__ K8, const unsigned char* __restrict__ V8, bf16_t* __restrict__ Ob,
                                         int nkeys, float lam, const float* __restrict__ ng, float oscale, unsigned char* lds) {
  int tid_ = tidx(); asm volatile("" : "+v"(tid_)); const int tid = tid_, wid = tid >> 6, lane = tid & 63, r32 = lane & 31, hi = lane >> 5;
  const int grp = __builtin_amdgcn_readfirstlane(wid >> 2);
  unsigned char* V_lds = lds; unsigned char* K_lds = lds + 2 * ATT_SHM_V;
  float* wsl = (float*)(lds + 2 * ATT_SHM_V + 2 * ATT_SHM_K) + wid * 64; float* li_l = wsl; float* al_l = wsl + 32;
  float m0 = 0.f, l0 = 0.f, m1 = 0.f, l1 = 0.f;
  f32x16 o0[4] = {}, o1[4] = {};
  unsigned char* Q_lds = lds + 2 * ATT_SHM_V + 2 * ATT_SHM_K + 2048;
#pragma unroll
  for (int i = 0; i < 5; ++i) { const int piece = __builtin_amdgcn_readfirstlane(wid) + 8 * i;
    if (piece < 36) __builtin_amdgcn_global_load_lds((const unsigned*)(Q8 + piece * 1024 + lane * 16), (LAS unsigned*)(Q_lds + piece * 1024), 16, 0, 0); }
  const unsigned ldsw = (unsigned)__builtin_amdgcn_readfirstlane(wid) * 1024u;
#define GSTAGE_K(b, k0) do { const unsigned char* ki_ = K8 + (size_t)(k0) * QK8_PITCH + tid * 16; \
      __builtin_amdgcn_global_load_lds((const unsigned*)ki_, (LAS unsigned*)(K_lds + (b) * ATT_SHM_K + ldsw), 16, 0, 0); \
      if (wid < 1) __builtin_amdgcn_global_load_lds((const unsigned*)(ki_ + 8192), (LAS unsigned*)(K_lds + (b) * ATT_SHM_K + 8192 + ldsw), 16, 0, 0); } while (0)
#define GSTAGE_V(b, k0) do { const unsigned char* vi_ = V8 + (size_t)((k0) >> 6) * ATT_SHM_V + tid * 16; \
      __builtin_amdgcn_global_load_lds((const unsigned*)vi_, (LAS unsigned*)(V_lds + (b) * ATT_SHM_V + ldsw), 16, 0, 0); \
      if (wid < 2) __builtin_amdgcn_global_load_lds((const unsigned*)(vi_ + 8192), (LAS unsigned*)(V_lds + (b) * ATT_SHM_V + 8192 + ldsw), 16, 0, 0); } while (0)
#define STAGE_PAIR(jj) do { GSTAGE_V((jj) & 1, (jj) * 64); if ((jj) + 1 < NT) GSTAGE_K((jj) & 1, ((jj) + 1) * 64); } while (0)
#define RESC(o, a) do { if (__any((a) < 1.f)) { if (hi == 0) al_l[r32] = (a); asm volatile("s_waitcnt lgkmcnt(0)" ::: "memory"); \
    _Pragma("unroll") for (int d = 0; d < 4; ++d) _Pragma("unroll") for (int r = 0; r < 16; ++r) o[d][r] *= al_l[crow(r, hi)]; } } while (0)
#define ATT_BAR() do { asm volatile("s_waitcnt lgkmcnt(0)" ::: "memory"); __builtin_amdgcn_s_barrier(); asm volatile("" ::: "memory"); } while (0)
#define ATT_LDK(dst_, off_) do { const u32x4 x0_ = *(const LAS u32x4*)(kb_ + (off_)), x1_ = *(const LAS u32x4*)(kb_ + (off_) + 16); \
      dst_[0] = (int)x0_.x; dst_[1] = (int)x0_.y; dst_[2] = (int)x0_.z; dst_[3] = (int)x0_.w; dst_[4] = (int)x1_.x; dst_[5] = (int)x1_.y; dst_[6] = (int)x1_.z; dst_[7] = (int)x1_.w; } while (0)
#define ATT_SC(acc_, kf_, qf_) acc_ = __builtin_amdgcn_mfma_scale_f32_32x32x64_f8f6f4(kf_, qf_, acc_, 0, 0, 0, 0x7F7F7F7F, 0, 0x7F7F7F7F)
#define ATT_LDQ(dst_, off_) do { const u32x4 x0_ = *(const LAS u32x4*)(qb_ + (off_)), x1_ = *(const LAS u32x4*)(qb_ + (off_) + 16); \
      dst_[0] = (int)x0_.x; dst_[1] = (int)x0_.y; dst_[2] = (int)x0_.z; dst_[3] = (int)x0_.w; dst_[4] = (int)x1_.x; dst_[5] = (int)x1_.y; dst_[6] = (int)x1_.z; dst_[7] = (int)x1_.w; } while (0)
#define ATT_QK_ALL(ia_, ib_) do { _Pragma("unroll") for (int r = 0; r < 16; ++r) { p0[r] = (ia_); p1[r] = (ia_); q0[r] = (ib_); q1[r] = (ib_); } \
      ATT_SC(p0, kf0, qf); SBAR(); ATT_LDK(kf0, 32 * QK8_PITCH); SBAR(); \
      ATT_SC(p1, kf0, qf); SBAR(); ATT_LDK(kf0, 64); ATT_LDQ(qf, 64); SBAR(); \
      ATT_SC(q0, kf0, qf); SBAR(); ATT_LDK(kf0, 32 * QK8_PITCH + 64); SBAR(); \
      ATT_SC(q1, kf0, qf); SBAR(); } while (0)
  const int NT = nkeys / 64;
  GSTAGE_K(1, 0); STAGE_PAIR(0);
  asm volatile("s_waitcnt vmcnt(0)" ::: "memory"); __syncthreads();
  f32x16 p0, p1, q0, q1; i32x8 pa, pb;
  const LAS unsigned char* l3 = (const LAS unsigned char*)lds;
  const int kofs0 = 2 * ATT_SHM_V + r32 * QK8_PITCH + hi * 32;
  const int qofs0 = 2 * ATT_SHM_V + 2 * ATT_SHM_K + 2048 + (__builtin_amdgcn_readfirstlane(wid) * 32 + r32) * QK8_PITCH + hi * 32;
  { i32x8 kf0, qf; const LAS unsigned char* kb_ = l3 + (kofs0 + ATT_SHM_K); const LAS unsigned char* qb_ = l3 + qofs0;
    ATT_LDK(kf0, 0); ATT_LDQ(qf, 0);
    ATT_QK_ALL(0.f, 0.f); }
  if (grp) ATT_BAR();
#pragma unroll 1
  for (int j = 0; j < NT; ++j) {
    const int cur = j & 1;
    const bool more = (j + 1 < NT);
    if (grp && more) STAGE_PAIR(j + 1);
    { float alphaA, alphaB;
      const bool first = (j == 0);
      att_softmax(p0, p1, m0, l0, alphaA, first, pa); SBAR();
      att_softmax(q0, q1, m1, l1, alphaB, first, pb); SBAR();
      RESC(o0, alphaA);
      RESC(o1, alphaB); }
    asm volatile("" : "+v"(pa), "+v"(pb), "+v"(m0), "+v"(l0), "+v"(m1), "+v"(l1));
    asm volatile("" : "+v"(o0[0]), "+v"(o0[1]), "+v"(o0[2]), "+v"(o0[3]), "+v"(o1[0]), "+v"(o1[1]), "+v"(o1[2]), "+v"(o1[3]));
    if (!grp) asm volatile("s_waitcnt vmcnt(0)" ::: "memory");
    ATT_BAR();
    if (!grp && more) STAGE_PAIR(j + 1);
    __builtin_amdgcn_s_setprio(1);
    {
      int kofs = kofs0, qofs = qofs0; asm volatile("" : "+v"(kofs), "+v"(qofs));
      const LAS unsigned char* kb_ = l3 + (kofs + cur * ATT_SHM_K); const LAS unsigned char* qb_ = l3 + qofs;
      i32x8 kf0, qf;
      const LAS unsigned char* vrow = l3 + (r32 * 80 + hi * 32 + cur * ATT_SHM_V);
      u32x4 va0 = *(const LAS u32x4*)vrow, va1 = *(const LAS u32x4*)(vrow + 16), vb0, vb1;
#define ATT_PV(d0_, x0_, x1_) do { i32x8 bv; bv[0] = (int)x0_.x; bv[1] = (int)x0_.y; bv[2] = (int)x0_.z; bv[3] = (int)x0_.w; bv[4] = (int)x1_.x; bv[5] = (int)x1_.y; bv[6] = (int)x1_.z; bv[7] = (int)x1_.w; \
        o0[d0_] = __builtin_amdgcn_mfma_scale_f32_32x32x64_f8f6f4(pa, bv, o0[d0_], 0, 0, 0, 0x7F7F7F7F, 0, 0x7F7F7F7F); \
        o1[d0_] = __builtin_amdgcn_mfma_scale_f32_32x32x64_f8f6f4(pb, bv, o1[d0_], 0, 0, 0, 0x7F7F7F7F, 0, 0x7F7F7F7F); } while (0)
      vb0 = *(const LAS u32x4*)(vrow + 32 * 80); vb1 = *(const LAS u32x4*)(vrow + 32 * 80 + 16); ATT_PV(0, va0, va1); SBAR();
      va0 = *(const LAS u32x4*)(vrow + 64 * 80); va1 = *(const LAS u32x4*)(vrow + 64 * 80 + 16); ATT_PV(1, vb0, vb1); SBAR();
      vb0 = *(const LAS u32x4*)(vrow + 96 * 80); vb1 = *(const LAS u32x4*)(vrow + 96 * 80 + 16); ATT_PV(2, va0, va1); SBAR();
      ATT_LDK(kf0, 0); ATT_LDQ(qf, 0);
      ATT_PV(3, vb0, vb1); SBAR();
#undef ATT_PV
      asm volatile("" : "+v"(o0[0]), "+v"(o0[1]), "+v"(o0[2]), "+v"(o0[3]), "+v"(o1[0]), "+v"(o1[1]), "+v"(o1[2]), "+v"(o1[3]));
      ATT_QK_ALL(-m0, -m1);
      asm volatile("" : "+v"(p0), "+v"(p1), "+v"(q0), "+v"(q1));
    }
    __builtin_amdgcn_s_setprio(0);
    if (grp) asm volatile("s_waitcnt vmcnt(0)" ::: "memory");
    ATT_BAR();
  }
  if (!grp) ATT_BAR();
  if (hi == 0) { li_l[r32] = 1.f / l0; al_l[r32] = lam / l1; }
  asm volatile("s_waitcnt lgkmcnt(0)" ::: "memory");
  float ss[16];
#pragma unroll
  for (int r = 0; r < 16; ++r) {
    const float a = li_l[crow(r, hi)], bq = al_l[crow(r, hi)];
    float s = 0.f;
#pragma unroll
    for (int d = 0; d < 4; ++d) { const float v = o0[d][r] * a - o1[d][r] * bq; o0[d][r] = v; s += v * v; }
    s += dpp_mov<0xB1>(s); s += dpp_mov<0x4E>(s); s += dpp_mov<0x141>(s); s += dpp_mov<0x140>(s);
    { auto rr_ = __builtin_amdgcn_permlane16_swap(__float_as_uint(s), __float_as_uint(s), false, false); s = __uint_as_float(rr_[0]) + __uint_as_float(rr_[1]); }
    ss[r] = rsqrtf(s * (1.f / 128.f) + EPS) * oscale;
  }
  bf16_t* Ow = Ob + (size_t)(wid * 32) * DM;
  unsigned char* ost = lds + 2 * ATT_SHM_V + 2 * ATT_SHM_K + 2048 + wid * (32 * 272);
#pragma unroll
  for (int d = 0; d < 4; ++d) {
    const float g = ng[d * 32 + r32];
#pragma unroll
    for (int r = 0; r < 16; ++r) *(bf16_t*)(ost + crow(r, hi) * 272 + (d * 32 + r32) * 2) = (ABL & 4) ? (bf16_t)0 : (bf16_t)(cvtpk(o0[d][r] * ss[r] * g, 0.f) & 0xffffu);
  }
  asm volatile("s_waitcnt lgkmcnt(0)" ::: "memory");
#pragma unroll
  for (int i = 0; i < 8; ++i) {
    const int c = lane + 64 * i, row = c >> 4, cb = (c & 15) * 16;
    *(u32x4*)((unsigned char*)(Ow + (size_t)row * DM) + cb) = *(const u32x4*)(ost + row * 272 + cb);
  }
  __syncthreads();
#undef ATT_LDK
#undef ATT_LDQ
#undef ATT_SC
#undef ATT_QK_ALL
#undef GSTAGE_K
#undef GSTAGE_V
#undef STAGE_PAIR
#undef RESC
#undef ATT_BAR
}

__device__ __forceinline__ float ins16(float (&a)[16], float x) {
#pragma unroll
  for (int i = 0; i < 16; ++i) { const float h = fmaxf(a[i], x); x = fminf(a[i], x); a[i] = h; }
  return x;
}
__device__ __forceinline__ void bsort16(float (&a)[16]) {
#pragma unroll
  for (int k = 2; k <= 16; k <<= 1)
#pragma unroll
    for (int j = k >> 1; j > 0; j >>= 1)
#pragma unroll
      for (int i = 0; i < 16; ++i) {
        const int q = i ^ j;
        if (q > i) {
          const bool desc = ((i & k) == 0);
          const float hi_ = fmaxf(a[i], a[q]), lo_ = fminf(a[i], a[q]);
          a[i] = desc ? hi_ : lo_; a[q] = desc ? lo_ : hi_;
        }
      }
}
__device__ __forceinline__ void bmerge16(float (&a)[16], const float (&b)[16]) {
#pragma unroll
  for (int i = 0; i < 16; ++i) a[i] = fmaxf(a[i], b[15 - i]);
#pragma unroll
  for (int j = 8; j > 0; j >>= 1)
#pragma unroll
    for (int i = 0; i < 16; ++i) {
      const int q = i ^ j;
      if (q > i) { const float hi_ = fmaxf(a[i], a[q]), lo_ = fminf(a[i], a[q]); a[i] = hi_; a[q] = lo_; }
    }
}
__device__ __forceinline__ float gelu_erf(float x) { return 0.5f * x * (1.f + erff(x * 0.70710678118654752440f)); }
#define XB_TMO      128
#define XB_XCNT(j)  (256  + 64 * (j))
#define XB_XSUB(j)  (1280 + 64 * (j))
#define XB_XGEN(j)  (2304 + 64 * (j))
#define XB_TOP      3328
#define XB_TOPGEN   3392
#define XCD_BAR_WORDS 3456
#define XB_SPIN_CAP (1u << 22)
__device__ __forceinline__ unsigned xb_ld(unsigned* p)              { return __hip_atomic_load(p, __ATOMIC_RELAXED, __HIP_MEMORY_SCOPE_AGENT); }
__device__ __forceinline__ unsigned xb_add(unsigned* p, unsigned v) { return __hip_atomic_fetch_add(p, v, __ATOMIC_RELAXED, __HIP_MEMORY_SCOPE_AGENT); }
__device__ __forceinline__ unsigned xb_xcc_id() { return (unsigned)__builtin_amdgcn_s_getreg((3 << 11) | 20) & 0xFu; }
#define XB_SPIN(cond, bar) do { unsigned _sp = 0; while (cond) { __builtin_amdgcn_s_sleep(1); \
    if ((++_sp & 255u) == 0u) { if (xb_ld(&(bar)[XB_TMO])) break; if (_sp > XB_SPIN_CAP) { atomicAdd(&(bar)[XB_TMO], 1u); break; } } } } while (0)
struct XcdBarrier { unsigned* bar; unsigned x; volatile LAS unsigned* st; };
__device__ __forceinline__ XcdBarrier xcd_barrier_post(unsigned* bar, volatile LAS unsigned* st) {
  XcdBarrier b; b.bar = bar; b.x = xb_xcc_id(); b.st = st;
  if (tidx() == 0) (void)xb_add(&bar[XB_XCNT(b.x)], 1u);
  return b;
}
__device__ __forceinline__ void xcd_barrier_complete(unsigned* bar, unsigned x, unsigned& nloc, unsigned& nx) {
  const unsigned G = gridDim.x * gridDim.y * gridDim.z;
  unsigned sum, cnt, mine, sp = 0u;
  for (;;) {
    sum = 0u; cnt = 0u; mine = 0u;
#pragma unroll
    for (unsigned j = 0; j < 16; ++j) { const unsigned c = xb_ld(&bar[XB_XCNT(j)]); sum += c; cnt += (c > 0u) ? 1u : 0u; mine = (j == x) ? c : mine; }
    if (sum == G) break;
    __builtin_amdgcn_s_sleep(1);
    if ((++sp & 255u) == 0u) { if (xb_ld(&bar[XB_TMO])) break; if (sp > XB_SPIN_CAP) { atomicAdd(&bar[XB_TMO], 1u); break; } }
  }
  nloc = mine > 0u ? mine : 1u; nx = cnt > 0u ? cnt : 1u;
}
__device__ __forceinline__ void xcd_barrier(const XcdBarrier& b) {
  asm volatile("s_waitcnt vmcnt(0)" ::: "memory");
  __syncthreads();
  if (tidx() == 0) {
    unsigned* bar = b.bar;
    __builtin_amdgcn_s_waitcnt(0);
    unsigned nloc = b.st[0], nx = b.st[1];
    if (nloc == 0u) { xcd_barrier_complete(bar, b.x, nloc, nx); b.st[0] = nloc; b.st[1] = nx; }
    const unsigned old = xb_add(&bar[XB_XSUB(b.x)], 1u);
    const unsigned gen = old / nloc;
    if (old + 1u == (gen + 1u) * nloc) {
      __builtin_amdgcn_fence(__ATOMIC_RELEASE, "agent");
      asm volatile("s_waitcnt vmcnt(0)" ::: "memory");
      const unsigned og = xb_add(&bar[XB_TOP], 1u);
      const unsigned tg = og / nx;
      if (og + 1u == (tg + 1u) * nx) xb_add(&bar[XB_TOPGEN], 1u);
      else XB_SPIN(xb_ld(&bar[XB_TOPGEN]) == tg, bar);
      __builtin_amdgcn_fence(__ATOMIC_ACQUIRE, "agent");
      xb_add(&bar[XB_XGEN(b.x)], 1u);
      asm volatile("s_waitcnt vmcnt(0)" ::: "memory");
    } else {
      XB_SPIN(xb_ld(&bar[XB_XGEN(b.x)]) == gen, bar);
      __builtin_amdgcn_fence(__ATOMIC_ACQUIRE, "agent");
      asm volatile("s_waitcnt vmcnt(0)" ::: "memory");
    }
  }
  __syncthreads();
}

constexpr size_t RT_STRIDE = (size_t)T * 128 * 4;
__device__ __forceinline__ void route_unit(const Params& p, int l, int unit, unsigned char* lds) {
  int tid_ = tidx(); asm volatile("" : "+v"(tid_)); const int tid = tid_, lane = tid & 63, wid = tid >> 6, r32 = lane & 31, hi = lane >> 5;
  unsigned char* IDX = lds;
  int* UE = (int*)(lds + 8192); float* UG = (float*)(lds + 8192 + 16384); float* US = (float*)(lds + 8192 + 32768);
  int* EIDG = (int*)(p.ws + WS_EID + (size_t)l * RT_STRIDE); float* GWG = (float*)(p.ws + WS_ULOC + RT_STRIDE); float* SUG = (float*)(p.ws + WS_ULOC + 2 * RT_STRIDE);
  const float* PSC = (const float*)(p.ws + WS_PSC);
  const int row0 = unit * 32;
  const bf16_t* QP = (const bf16_t*)(p.ws + WS_PROJ);
  const bf16_t* KEYS = (const bf16_t*)(p.ws + WS_KEYS) + (size_t)l * 131072;
  for (int rrep = 0; rrep < REP_ROUTE; ++rrep) {
    const int h = wid;
    float top[2][16];
    bf16x8 bq[4], bqn[4], akc[4], akn[4];
    {
      const bf16_t* qrow0 = QP + (size_t)(row0 + r32) * DM + h * 128 + hi * 8;
      const bf16_t* kb0 = KEYS + ((size_t)(h * 2) * 128 + r32) * 64 + hi * 8;
#pragma unroll
      for (int ks = 0; ks < 4; ++ks) { bq[ks] = *(const bf16x8*)(qrow0 + ks * 16); akc[ks] = *(const bf16x8*)(kb0 + ks * 16); }
    }
#pragma unroll
    for (int pp = 0; pp < 2; ++pp) {
      const bf16_t* kb = KEYS + ((size_t)(h * 2 + pp) * 128 + r32) * 64 + hi * 8;
      float (&lst)[16] = top[pp];
#pragma unroll
      for (int i = 0; i < 16; ++i) lst[i] = -INFINITY;
#pragma unroll
      for (int nt = 0; nt < 4; ++nt) {
        if (nt < 3) {
#pragma unroll
          for (int ks = 0; ks < 4; ++ks) akn[ks] = *(const bf16x8*)(kb + (size_t)(nt + 1) * 32 * 64 + ks * 16);
        } else if (pp == 0) {
          const bf16_t* qrow1 = QP + (size_t)(row0 + r32) * DM + h * 128 + 64 + hi * 8;
          const bf16_t* kb1 = KEYS + ((size_t)(h * 2 + 1) * 128 + r32) * 64 + hi * 8;
#pragma unroll
          for (int ks = 0; ks < 4; ++ks) { bqn[ks] = *(const bf16x8*)(qrow1 + ks * 16); akn[ks] = *(const bf16x8*)(kb1 + ks * 16); }
        }
        f32x16 acc = {};
#pragma unroll
        for (int ks = 0; ks < 4; ++ks) acc = __builtin_amdgcn_mfma_f32_32x32x16_bf16(akc[ks], bq[ks], acc, 0, 0, 0);
#pragma unroll
        for (int ks = 0; ks < 4; ++ks) { akc[ks] = akn[ks]; if (nt == 3) bq[ks] = bqn[ks]; }
        float grp[16];
#pragma unroll
        for (int r = 0; r < 16; ++r) grp[r] = __uint_as_float((__float_as_uint(acc[r]) & ~0x7Fu) | (unsigned)(nt * 32 + crow(r, hi)));
        bsort16(grp);
        if (nt == 0) {
#pragma unroll
          for (int i = 0; i < 16; ++i) lst[i] = grp[i];
        } else bmerge16(lst, grp);
        SBAR();
      }
      float oth[16];
#pragma unroll
      for (int i = 0; i < 16; ++i) { auto rr_ = __builtin_amdgcn_permlane32_swap(__float_as_uint(lst[i]), __float_as_uint(lst[i]), false, false); oth[i] = __uint_as_float(hi ? rr_[0] : rr_[1]); }
      bmerge16(lst, oth);
      if (hi == 0) {
        unsigned w[4];
#pragma unroll
        for (int i = 0; i < 4; ++i)
          w[i] = (__float_as_uint(lst[4 * i]) & 0x7Fu) | ((__float_as_uint(lst[4 * i + 1]) & 0x7Fu) << 8) | ((__float_as_uint(lst[4 * i + 2]) & 0x7Fu) << 16) | ((__float_as_uint(lst[4 * i + 3]) & 0x7Fu) << 24);
        *(u32x4*)(IDX + ((r32 * 8 + h) * 2 + pp) * 16) = (u32x4){w[0], w[1], w[2], w[3]};
      }
    }
    float best[16];
#define CAND(i, j) __uint_as_float((__float_as_uint(__uint_as_float(__float_as_uint(top[0][i]) & ~0x7Fu) + __uint_as_float(__float_as_uint(top[1][j]) & ~0x7Fu)) & ~0xFFu) | (unsigned)((i) * 16 + (j)))
    {
#pragma unroll
      for (int j = 0; j < 16; ++j) best[j] = CAND(0, j);
      float y[16];
#pragma unroll
      for (int j = 0; j < 8; ++j) { y[j] = CAND(1, j); y[8 + j] = CAND(15 - j, 0); }
#pragma unroll
      for (int jj = 8; jj > 0; jj >>= 1)
#pragma unroll
        for (int i = 0; i < 16; ++i) { const int q = i ^ jj; if (q > i) { const float hi_ = fmaxf(y[i], y[q]), lo_ = fminf(y[i], y[q]); y[i] = hi_; y[q] = lo_; } }
      bmerge16(best, y);
      float x[16];
      x[0] = CAND(2, 0); x[1] = CAND(2, 1); x[2] = CAND(2, 2); x[3] = CAND(2, 3); x[4] = CAND(2, 4);
      x[5] = CAND(3, 0); x[6] = CAND(3, 1); x[7] = CAND(3, 2); x[8] = CAND(3, 3);
      x[9] = CAND(4, 0); x[10] = CAND(4, 1); x[11] = CAND(4, 2);
      x[12] = CAND(5, 0); x[13] = CAND(5, 1); x[14] = CAND(6, 0); x[15] = CAND(6, 1);
      bsort16(x);
      bmerge16(best, x);
      ins16(best, CAND(7, 0)); ins16(best, CAND(7, 1));
    }
#undef CAND
    asm volatile("s_waitcnt lgkmcnt(0)" ::: "memory");
    if (hi == 0) {
      const unsigned char* ib = IDX + ((r32 * 8 + h) * 2) * 16;
      const float mx = __uint_as_float(__float_as_uint(best[0]) & ~0xFFu);
      float w[16]; float sum = 0.f;
#pragma unroll
      for (int k = 0; k < 16; ++k) { w[k] = __expf(__uint_as_float(__float_as_uint(best[k]) & ~0xFFu) - mx); sum += w[k]; }
      const float rsum = 1.f / sum;
      int ee[16]; float su_[16], sv_[16];
#pragma unroll
      for (int k = 0; k < 16; ++k) {
        const unsigned ij = __float_as_uint(best[k]) & 0xFFu;
        ee[k] = (int)ib[ij >> 4] * 128 + (int)ib[16 + (ij & 15)];
      }
#pragma unroll
      for (int k = 0; k < 16; ++k) { su_[k] = PSC[(size_t)l * NEXP + ee[k]]; sv_[k] = PSC[(size_t)(DEPTH + l) * NEXP + ee[k]]; }
#pragma unroll
      for (int k = 0; k < 16; ++k) {
        UE[r32 * 128 + h * 16 + k] = ee[k]; UG[r32 * 128 + h * 16 + k] = w[k] * rsum * sv_[k];
        US[r32 * 128 + h * 16 + k] = su_[k];
      }
    }
  }
  __syncthreads();
#pragma unroll 1
  for (int tt = 0; tt < 4; ++tt) {
    const int t = wid * 4 + tt;
    const int k0 = UE[t * 128 + lane], k1 = UE[t * 128 + 64 + lane];
    const float g0 = UG[t * 128 + lane], g1 = UG[t * 128 + 64 + lane], s0 = US[t * 128 + lane], s1 = US[t * 128 + 64 + lane];
    const int b0 = k0 >> 10, b1 = k1 >> 10;
    int base = 0, pos0 = 0, pos1 = 0;
#pragma unroll
    for (int b = 0; b < 16; ++b) {
      const unsigned long long m0 = __ballot(b0 == b), m1 = __ballot(b1 == b);
      const int c0 = __popcll(m0), c1 = __popcll(m1);
      const unsigned long long lt = (1ull << lane) - 1ull;
      if (b0 == b) pos0 = base + __popcll(m0 & lt);
      if (b1 == b) pos1 = base + c0 + __popcll(m1 & lt);
      base += c0 + c1;
    }
    const size_t ro = (size_t)(row0 + t) * 128;
    EIDG[ro + pos0] = k0; GWG[ro + pos0] = g0; SUG[ro + pos0] = s0;
    EIDG[ro + pos1] = k1; GWG[ro + pos1] = g1; SUG[ro + pos1] = s1;
  }
}
#define CAS __attribute__((address_space(4)))
typedef int i32x8 __attribute__((ext_vector_type(8)));
struct TokPref { f32x2 gs0, gs1; u32x4 hA, hB; };
struct RowPipe { i32x6 uq[4], vq[4]; i32x8 Ec; };
struct EpiVec { f32x4 g2[4], ng[4], sc[4], sh[4]; int mr; };
__device__ __forceinline__ const CAS i32x8* eid_row(const CAS unsigned char* eidg, int row) {
  return (const CAS i32x8*)(eidg + (size_t)(unsigned)__builtin_amdgcn_readfirstlane(row) * 512u);
}
__device__ __forceinline__ void tok_prefetch(const Params& p, int row, int lane, TokPref& t) {
  const float* GWG = (const float*)(p.ws + WS_ULOC + RT_STRIDE) + (size_t)row * 128;
  const float* SUG = (const float*)(p.ws + WS_ULOC + 2 * RT_STRIDE) + (size_t)row * 128;
  const bf16_t* H = (const bf16_t*)(p.ws + WS_H);
  t.gs0 = f32x2{GWG[lane], SUG[lane]}; t.gs1 = f32x2{GWG[64 + lane], SUG[64 + lane]};
  t.hA = *(const u32x4*)(H + (size_t)row * DM + lane * 16); t.hB = *(const u32x4*)(H + (size_t)row * DM + lane * 16 + 8);
}
#define LOADPAIR(dst_, tofs_, ea_, eb_) do { const u32x3v a_ = __builtin_amdgcn_raw_buffer_load_b96(rsT, lane12, (ea_) * PROW + (tofs_), 0); const unsigned b0_ = __builtin_amdgcn_raw_buffer_load_b32(rsT, lane12, (eb_) * PROW + (tofs_), 0); \
      const u32x2v b1_ = __builtin_amdgcn_raw_buffer_load_b64(rsT, lane12 + 4, (eb_) * PROW + (tofs_), 0); \
      dst_[0] = (int)a_.x; dst_[1] = (int)a_.y; dst_[2] = (int)a_.z; dst_[3] = (int)b0_; dst_[4] = (int)b1_.x; dst_[5] = (int)b1_.y; } while (0)
#define LOADGROUP(q_, tofs_, E_) do { LOADPAIR(q_[0], tofs_, E_[0], E_[1]); LOADPAIR(q_[1], tofs_, E_[2], E_[3]); LOADPAIR(q_[2], tofs_, E_[4], E_[5]); LOADPAIR(q_[3], tofs_, E_[6], E_[7]); } while (0)
constexpr int VOFS = (int)(WS_PV - WS_PU);
__device__ __forceinline__ void gather_token(const Params& p, const CAS unsigned char* eidg, const __amdgpu_buffer_rsrc_t rsT, int l, int row, int nextrow, TokPref& tp, RowPipe& rp, EpiVec& ev, unsigned char* lds, int lane, int wid) {
  f32x2* GS = (f32x2*)(lds + wid * 2048);
  float* XC = (float*)(p.ws + WS_XCUR);
  const float* MOD = (const float*)(p.ws + WS_MOD);
  const CAS i32x8* EP = eid_row(eidg, row);
  const bool hasnext = nextrow >= 0;
  const CAS i32x8* EPn = eid_row(eidg, hasnext ? nextrow : row);
  GS[lane] = tp.gs0; GS[64 + lane] = tp.gs1;
  asm volatile("s_waitcnt lgkmcnt(0)" ::: "memory");
  const int eofl = ((lane >> 5) & 1) + 2 * ((lane >> 4) & 1) + 4 * ((lane >> 3) & 1);
  const int lane12 = lane * 12;
  {
    h16x2 hh[8];
    {
      const u32x4 hA = tp.hA, hB = tp.hB;
      hh[0] = __builtin_bit_cast(h16x2, __builtin_amdgcn_cvt_pkrtz(bflo(hA.x), bfhi(hA.x))); hh[1] = __builtin_bit_cast(h16x2, __builtin_amdgcn_cvt_pkrtz(bflo(hA.y), bfhi(hA.y))); hh[2] = __builtin_bit_cast(h16x2, __builtin_amdgcn_cvt_pkrtz(bflo(hA.z), bfhi(hA.z))); hh[3] = __builtin_bit_cast(h16x2, __builtin_amdgcn_cvt_pkrtz(bflo(hA.w), bfhi(hA.w)));
      hh[4] = __builtin_bit_cast(h16x2, __builtin_amdgcn_cvt_pkrtz(bflo(hB.x), bfhi(hB.x))); hh[5] = __builtin_bit_cast(h16x2, __builtin_amdgcn_cvt_pkrtz(bflo(hB.y), bfhi(hB.y))); hh[6] = __builtin_bit_cast(h16x2, __builtin_amdgcn_cvt_pkrtz(bflo(hB.z), bfhi(hB.z))); hh[7] = __builtin_bit_cast(h16x2, __builtin_amdgcn_cvt_pkrtz(bflo(hB.w), bfhi(hB.w)));
    }
    if (hasnext) tok_prefetch(p, nextrow, lane, tp);
    { const int mr_ = mod_row(row);
      if (mr_ != ev.mr) {
        const float* g2_ = MOD + ((size_t)l * 5 + mr_) * 6144 + 5 * 1024 + lane * 16;
        const float* ng_ = (l == DEPTH - 1 ? p.in[I_FINALG] : p.in[I_N1G] + (l + 1) * DM) + lane * 16;
        const float* m_ = MOD + ((size_t)(l == DEPTH - 1 ? l : l + 1) * 5 + mr_) * 6144 + lane * 16;
#pragma unroll
        for (int v4 = 0; v4 < 4; ++v4) { ev.g2[v4] = *(const f32x4*)(g2_ + v4 * 4); ev.ng[v4] = *(const f32x4*)(ng_ + v4 * 4); ev.sc[v4] = *(const f32x4*)(m_ + 1024 + v4 * 4); ev.sh[v4] = *(const f32x4*)(m_ + v4 * 4); }
        ev.mr = mr_;
      } }
    f32x4 xpre[4];
    { const float* xr_ = XC + (size_t)row * DM + lane * 16;
#pragma unroll
      for (int v4 = 0; v4 < 4; ++v4) xpre[v4] = *(const f32x4*)(xr_ + v4 * 4); }
    f32x2 acc2[8];
#pragma unroll
    for (int i = 0; i < 8; ++i) acc2[i] = f32x2{0.f, 0.f};
#pragma unroll 1
    for (int g8 = 0; g8 < 16; ++g8) {
      const bool pf = (g8 < 15) || hasnext;
      const f32x2 gs = GS[g8 * 8 + eofl];
      float d[8];
#pragma unroll
      for (int i2 = 0; i2 < 4; ++i2) {
        const h16x32 r = __builtin_amdgcn_cvt_scalef32_pk32_f16_fp6(rp.uq[i2], 1.0f);
        float a0 = 0.f, a1 = 0.f, b0 = 0.f, b1 = 0.f;
#define UDOT(k_) a0 = __builtin_amdgcn_fdot2(__builtin_shufflevector(r, r, 4 * (k_), 4 * (k_) + 1), hh[2 * (k_)], a0, false); b0 = __builtin_amdgcn_fdot2(__builtin_shufflevector(r, r, 16 + 4 * (k_), 17 + 4 * (k_)), hh[2 * (k_)], b0, false); \
        a1 = __builtin_amdgcn_fdot2(__builtin_shufflevector(r, r, 4 * (k_) + 2, 4 * (k_) + 3), hh[2 * (k_) + 1], a1, false); b1 = __builtin_amdgcn_fdot2(__builtin_shufflevector(r, r, 18 + 4 * (k_), 19 + 4 * (k_)), hh[2 * (k_) + 1], b1, false);
        UDOT(0) UDOT(1) UDOT(2) UDOT(3)
#undef UDOT
        d[2 * i2] = a0 + a1;
        d[2 * i2 + 1] = b0 + b1;
        asm volatile("" : "+v"(d[2 * i2]), "+v"(d[2 * i2 + 1]));
      }
      if (pf) LOADGROUP(rp.uq, 0, rp.Ec);
      float tot;
      {
        auto s01 = __builtin_amdgcn_permlane32_swap(__float_as_uint(d[0]), __float_as_uint(d[1]), false, false);
        auto s23 = __builtin_amdgcn_permlane32_swap(__float_as_uint(d[2]), __float_as_uint(d[3]), false, false);
        auto s45 = __builtin_amdgcn_permlane32_swap(__float_as_uint(d[4]), __float_as_uint(d[5]), false, false);
        auto s67 = __builtin_amdgcn_permlane32_swap(__float_as_uint(d[6]), __float_as_uint(d[7]), false, false);
        const float q01 = __uint_as_float(s01[0]) + __uint_as_float(s01[1]), q23 = __uint_as_float(s23[0]) + __uint_as_float(s23[1]);
        const float q45 = __uint_as_float(s45[0]) + __uint_as_float(s45[1]), q67 = __uint_as_float(s67[0]) + __uint_as_float(s67[1]);
        auto ta = __builtin_amdgcn_permlane16_swap(__float_as_uint(q01), __float_as_uint(q23), false, false);
        auto tb = __builtin_amdgcn_permlane16_swap(__float_as_uint(q45), __float_as_uint(q67), false, false);
        const float r0123 = __uint_as_float(ta[0]) + __uint_as_float(ta[1]);
        const float r4567 = __uint_as_float(tb[0]) + __uint_as_float(tb[1]);
        const bool b3 = (lane & 8) != 0;
        const float keep = b3 ? r4567 : r0123, send = b3 ? r0123 : r4567;
        float x = keep + dpp_mov<0x140>(send);
        x += dpp_mov<0xB1>(x); x += dpp_mov<0x4E>(x); x += dpp_mov<0x141>(x);
        tot = x * gs.y;
      }
      float ge;
      {
        const float v = tot, av = fabsf(v), tq = __builtin_amdgcn_rcpf(av * 0.2316418882f + 1.0f);
        float q = tq * 0.5307027145f + (-0.7265760135f); q = q * tq + 0.7107068705f; q = q * tq + (-0.142248368f); q = q * tq + 0.127414796f; q = q * tq;
        const float ex = __builtin_amdgcn_exp2f(v * v * (-0.72134752044f));
        const float m = v * (q * ex), r = v - m;
        ge = (v < 0.f ? m : r) * gs.x;
      }
      unsigned cw[8];
      { const unsigned gp = __builtin_bit_cast(unsigned, __builtin_amdgcn_cvt_pkrtz(ge * 1024.f, ge * 1024.f));
        cw[0] = (unsigned)__builtin_amdgcn_readlane((int)gp, 0);  cw[4] = (unsigned)__builtin_amdgcn_readlane((int)gp, 8);
        cw[2] = (unsigned)__builtin_amdgcn_readlane((int)gp, 16); cw[6] = (unsigned)__builtin_amdgcn_readlane((int)gp, 24);
        cw[1] = (unsigned)__builtin_amdgcn_readlane((int)gp, 32); cw[5] = (unsigned)__builtin_amdgcn_readlane((int)gp, 40);
        cw[3] = (unsigned)__builtin_amdgcn_readlane((int)gp, 48); cw[7] = (unsigned)__builtin_amdgcn_readlane((int)gp, 56); }
      h16x2 a16[8];
#pragma unroll
      for (int i2 = 0; i2 < 4; ++i2) {
        const h16x32 r = __builtin_amdgcn_cvt_scalef32_pk32_f16_fp6(rp.vq[i2], 1.0f);
        const h16x2 ca = __builtin_bit_cast(h16x2, cw[2 * i2]), cb = __builtin_bit_cast(h16x2, cw[2 * i2 + 1]);
#define VAXL(k_) a16[k_] = (i2 == 0) ? ca * __builtin_shufflevector(r, r, 2 * (k_), 2 * (k_) + 1) : ca * __builtin_shufflevector(r, r, 2 * (k_), 2 * (k_) + 1) + a16[k_];
#define VAXH(k_) a16[k_] = cb * __builtin_shufflevector(r, r, 16 + 2 * (k_), 17 + 2 * (k_)) + a16[k_];
        VAXL(0) VAXL(1) VAXL(2) VAXL(3) VAXL(4) VAXL(5) VAXL(6) VAXL(7)
        asm volatile("" : "+v"(a16[0]), "+v"(a16[1]), "+v"(a16[2]), "+v"(a16[3]), "+v"(a16[4]), "+v"(a16[5]), "+v"(a16[6]), "+v"(a16[7]));
        VAXH(0) VAXH(1) VAXH(2) VAXH(3) VAXH(4) VAXH(5) VAXH(6) VAXH(7)
#undef VAXL
#undef VAXH
        asm volatile("" : "+v"(a16[0]), "+v"(a16[1]), "+v"(a16[2]), "+v"(a16[3]), "+v"(a16[4]), "+v"(a16[5]), "+v"(a16[6]), "+v"(a16[7]));
      }
#pragma unroll
      for (int k = 0; k < 8; ++k) acc2[k] = f32x2{(float)a16[k].x, (float)a16[k].y} * f32x2{1.f / 1024.f, 1.f / 1024.f} + acc2[k];
      if (pf) LOADGROUP(rp.vq, VOFS, rp.Ec);
      { const CAS i32x8* src_ = g8 < 14 ? EP + (g8 + 2) : EPn + (g8 - 14); rp.Ec = *src_; }
    }
    SBAR();
    float acc[16];
#pragma unroll
    for (int i = 0; i < 8; ++i) { acc[2 * i] = acc2[i].x; acc[2 * i + 1] = acc2[i].y; }
    float* xr = XC + (size_t)row * DM;
    float xn[16]; float ssq = 0.f;
    if (ABL & 8) {
#pragma unroll
      for (int i = 0; i < 16; ++i) acc[i] = 0.f;
    }
#pragma unroll
    for (int v4 = 0; v4 < 4; ++v4) {
      const int c = lane * 16 + v4 * 4;
      const f32x4 xo = xpre[v4], gg = ev.g2[v4];
      f32x4 o;
      o.x = xo.x + gg.x * acc[v4 * 4 + 0]; o.y = xo.y + gg.y * acc[v4 * 4 + 1]; o.z = xo.z + gg.z * acc[v4 * 4 + 2]; o.w = xo.w + gg.w * acc[v4 * 4 + 3];
      xn[v4 * 4 + 0] = o.x; xn[v4 * 4 + 1] = o.y; xn[v4 * 4 + 2] = o.z; xn[v4 * 4 + 3] = o.w;
      ssq += (o.x * o.x + o.y * o.y) + (o.z * o.z + o.w * o.w);
      if (l < DEPTH - 1) *(f32x4*)(xr + c) = o;
    }
    const float rs = rsqrtf(wave_sum_fast(ssq) * (1.f / DM) + EPS);
    if (l == DEPTH - 1) {
      const int b = row / SEGL, s = row - b * SEGL;
      float* orow = p.out + ((size_t)(b * SEQ + (s - CTXL))) * DM;
#pragma unroll
      for (int v4 = 0; v4 < 4; ++v4) {
        const int c = lane * 16 + v4 * 4;
        const f32x4 gg = ev.ng[v4];
        f32x4 o; o.x = xn[v4 * 4 + 0] * rs * gg.x; o.y = xn[v4 * 4 + 1] * rs * gg.y; o.z = xn[v4 * 4 + 2] * rs * gg.z; o.w = xn[v4 * 4 + 3] * rs * gg.w;
        *(f32x4*)(orow + c) = o;
      }
    } else {
      bf16_t* hrow = (bf16_t*)(p.ws + WS_H) + (size_t)row * DM;
#pragma unroll
      for (int hh = 0; hh < 2; ++hh) {
        float y[8];
#pragma unroll
        for (int i = 0; i < 8; ++i) { const int q_ = hh * 2 + (i >> 2), e_ = i & 3; y[i] = xn[hh * 8 + i] * rs * ev.ng[q_][e_] * (1.f + ev.sc[q_][e_]) + ev.sh[q_][e_]; }
        u32x4 w; w.x = cvtpk(y[0], y[1]); w.y = cvtpk(y[2], y[3]); w.z = cvtpk(y[4], y[5]); w.w = cvtpk(y[6], y[7]);
        *(u32x4*)(hrow + lane * 16 + hh * 8) = w;
      }
    }
  }
}

__device__ __forceinline__ void ev_signal(unsigned* ctr) {
  asm volatile("s_waitcnt vmcnt(0)" ::: "memory");
  __syncthreads();
  if (tidx() == 0) { __builtin_amdgcn_fence(__ATOMIC_RELEASE, "agent"); asm volatile("s_waitcnt vmcnt(0)" ::: "memory"); (void)xb_add(ctr, 1u); }
}
__device__ __forceinline__ void ev_wait(unsigned* ctr, unsigned n, unsigned* bar) {
  if (tidx() == 0) {
    XB_SPIN(xb_ld(ctr) < n, bar);
    __builtin_amdgcn_fence(__ATOMIC_ACQUIRE, "agent");
    asm volatile("s_waitcnt vmcnt(0)" ::: "memory");
  }
  __syncthreads();
}
constexpr int EV_WORD0 = 8192;
__device__ __forceinline__ void phase_c1(const Params& p, int l, unsigned char* lds) {
  constexpr int NLOC = NBATCH * 4 * NCH, NCONV = T / 32;
  for (int u = p.bx; u < NLOC + NCONV; u += p.gx) {
    if (u < NLOC) ml_local_unit2(p, l, u, lds);
    else {
      const int cu = u - NLOC;
      if (l == DEPTH - 1 && (cu % (SEGL / 32)) < (CTXL / 32)) continue;
      conv_unit(p, l, cu, lds);
    }
  }
}
__device__ __forceinline__ void phase_c3(const Params& p, int l, unsigned char* lds);
__device__ __forceinline__ void phase_c2(const Params& p, int l, unsigned char* lds) {
  unsigned* ev = (unsigned*)(p.ws + WS_CTL) + EV_WORD0 + 64 * l;
  ml_scan(p, lds);
  ev_signal(ev);
  const float* lp = p.in[I_DLAM] + l * 256;
  float s01 = 0.f, s23 = 0.f;
  for (int i = 0; i < 64; ++i) { s01 += lp[i] * lp[64 + i]; s23 += lp[128 + i] * lp[192 + i]; }
  const float lam_init = 0.8f - 0.6f * expf(-0.3f * (float)l);
  const float lam = expf(s01) - expf(s23) + lam_init;
  const bf16_t* PROJ = (const bf16_t*)(p.ws + WS_PROJ);
  bf16_t* MIX = (bf16_t*)(p.ws + WS_MIX);
  const float* ng = p.in[I_DNORMG] + l * 128;
  const int nun = 512 + (l < DEPTH - 1 ? 16 : 0);
  for (int u = p.bx; u < nun; u += p.gx) {
    int bh, qrow, nkeys;
    if (u < 512) { const int xcd = u & 7, i = (u >> 3) & 31, rnd = u >> 8; bh = 2 * xcd + rnd; qrow = CTXL + i * 256; nkeys = SEGL; }
    else { bh = u - 512; qrow = 0; nkeys = CTXL; }
    const int b = bh >> 2, h = bh & 3;
    const size_t tok0 = (size_t)b * SEGL;
    for (int rep = 0; rep < REP_ATT; ++rep)
    att_unit(p.ws + WS_QK8 + ((size_t)bh * SEGL + qrow) * QK8_PITCH, p.ws + WS_QK8 + QK8_IMG + (size_t)bh * SEGL * QK8_PITCH, p.ws + WS_V8T + (size_t)bh * NCH * ATT_SHM_V,
             MIX + (tok0 + qrow) * DM + 512 + h * 128, nkeys, lam, ng, 1.f - lam_init, lds);
  }
  ev_wait(ev, (unsigned)p.gx, p.xbar_words);
  for (int rep = 0; rep < REP_ML; ++rep) phase_c3(p, l, lds);
}
__device__ __forceinline__ void phase_c3(const Params& p, int l, unsigned char* lds) {
  constexpr int NU = NBATCH * 4 * NCH;
  const int nlow = (p.gx > 64 && l < DEPTH - 1) ? 16 : 0, ulow = nlow * 7;
  int u, step;
  if (p.bx < nlow) { u = p.bx; step = nlow; } else { u = ulow + (p.bx - nlow); step = p.gx - nlow; }
  const int uend = p.bx < nlow ? ulow : NU;
  int tid_ = tidx(); asm volatile("" : "+v"(tid_));
  auto valid_from = [&](int v) { while (v < uend && l == DEPTH - 1 && (v % NCH) < 4) v += step; return v < uend ? v : -1; };
  MlOutPf fa, fb;
  u = valid_from(u);
  if (u >= 0) ml_out_fetch(p, u, tid_, fa);
  while (u >= 0) {
    const int nx = valid_from(u + step);
    ml_out_unit2(p, l, u, lds, fa, nx, fb);
    fa = fb; u = nx;
  }
}
__device__ __forceinline__ void phase_route(const Params& p, int l, unsigned char* lds) {
  constexpr int NU = T / 32;
  for (int u = p.bx; u < NU; u += p.gx) {
    if (l == DEPTH - 1 && (u % (SEGL / 32)) < (CTXL / 32)) continue;
    route_unit(p, l, u, lds);
    __syncthreads();
  }
}
__device__ __forceinline__ void phase_gather(const Params& p, int l, unsigned char* lds) {
  int tid_ = tidx(); asm volatile("" : "+v"(tid_)); const int lane = tid_ & 63, wid = __builtin_amdgcn_readfirstlane(tid_ >> 6);
  const int gw = p.bx * 8 + wid, NGW = p.gx * 8;
  const int ntok = (l == DEPTH - 1) ? NBATCH * SEQ : T;
#define TOKROW(ti_) ((l == DEPTH - 1) ? ((ti_) / SEQ) * SEGL + CTXL + ((ti_) % SEQ) : (ti_))
  const CAS unsigned char* eidg = (const CAS unsigned char*)(p.ws + WS_EID + (size_t)l * RT_STRIDE);
  const __amdgpu_buffer_rsrc_t rsT = __builtin_amdgcn_make_buffer_rsrc((void*)(p.ws + WS_PU + (size_t)l * NEXP * PROW), 0, VOFS + NEXP * PROW, 0x00020000);
  const int nfull = ntok / NGW, rem = ntok - nfull * NGW, per = (rem % p.gx == 0) ? rem / p.gx : -1;
  auto tok_at = [&](int r) -> int {
    if (r < nfull) return gw + r * NGW;
    if (r > nfull || rem == 0) return -1;
    if (per >= 0) return wid < per ? nfull * NGW + p.bx * per + wid : -1;
    return gw + r * NGW < ntok ? gw + r * NGW : -1;
  };
  TokPref tp; RowPipe rp; EpiVec ev; ev.mr = -1;
  const int ti0 = tok_at(0);
  if (ti0 >= 0) {
    const int row0 = TOKROW(ti0); const int lane12 = lane * 12;
    tok_prefetch(p, row0, lane, tp);
    const CAS i32x8* EP0 = eid_row(eidg, row0);
    rp.Ec = EP0[0];
    LOADGROUP(rp.uq, 0, rp.Ec); LOADGROUP(rp.vq, VOFS, rp.Ec);
    rp.Ec = EP0[1];
  }
  XcdBarrier xb; xb.bar = p.xbar_words; xb.x = p.xbar_x; xb.st = (volatile LAS unsigned*)((LAS unsigned char*)lds + p.lds_st_off);
  const int nrounds = (ntok + NGW - 1) / NGW;
  for (int r = 0; r < nrounds; ++r) {
    const int ti = tok_at(r);
    if (ti >= 0) {
      const int row = TOKROW(ti);
      const int tn = tok_at(r + 1);
      const int nxt = tn >= 0 ? TOKROW(tn) : -1;
      gather_token(p, eidg, rsT, l, row, nxt, tp, rp, ev, lds, lane, wid);
    }
#if GATHER_SYNC
    if (r + 1 < nrounds) { XcdBarrier xb2 = xb; size_t zb_ = 0; asm volatile("" : "+s"(zb_)); xb2.bar = xb.bar + zb_; xb2.x = xb.x + (unsigned)zb_; xcd_barrier(xb2); }
#endif
  }
#undef TOKROW
}

__global__ void __launch_bounds__(512, 2) mk_fwd(KArgs ka) {
  cg::grid_group grid = cg::this_grid();
  extern __shared__ __attribute__((aligned(16))) unsigned char lds[];
  const int lo = ka.ph_lo, hi = ka.ph_hi;
#define IN(k) (lo <= (k) && (k) < hi)
#ifndef PHASEMASK
#define PHASEMASK 0xFFFF
#endif
#define PH(i) ((PHASEMASK >> (i)) & 1)
#define MKP(q) Params q; { size_t z_ = 0; asm volatile("" : "+s"(z_)); \
    q.in = (InTab)((const __attribute__((address_space(4))) char*)__builtin_amdgcn_kernarg_segment_ptr() + z_); \
    q.out = ka.out + z_; q.ws = ka.ws + z_; q.ph_lo = lo; q.ph_hi = hi; q.bx = (int)blockIdx.x + (int)z_; q.gx = (int)gridDim.x + (int)z_; q.xbar_words = xbar.bar + z_; q.xbar_x = xbar.x + (unsigned)z_; q.lds_st_off = (unsigned)(LDS_BYTES - 64); }
#define SEAM(k) do { if (IN(k) && IN((k) + 1)) { if ((k) == 0) grid.sync(); else { XcdBarrier xb_ = xbar; size_t zb_ = 0; asm volatile("" : "+s"(zb_)); xb_.bar = xbar.bar + zb_; xb_.x = xbar.x + (unsigned)zb_; xcd_barrier(xb_); } } } while (0)
  volatile LAS unsigned* xst = (volatile LAS unsigned*)((LAS unsigned char*)lds + (LDS_BYTES - 64));
  { const int t0_ = threadIdx.x;
    if (t0_ < 2) xst[t0_] = 0u;
    if ((t0_ & 63) == 0) *(volatile LAS int*)((LAS unsigned char*)lds + LDS_WTAB + 4 * hw_wave_key()) = t0_ >> 6; }
  __syncthreads();
  XcdBarrier xbar = xcd_barrier_post((unsigned*)(ka.ws + WS_CTL) + 4096, xst);
  { MKP(p)
    if (PH(0) && IN(0)) for (int rep = 0; rep < REP_MISC; ++rep) { p0_mod(p, lds, (float*)(p.ws + WS_MOD)); p0_convert(p, lds); }
  }
  SEAM(0);
  { MKP(p)
    if (PH(1) && IN(1)) phase_norm(p, 0, 0, true, false);
  }
  SEAM(1);
#define LAYER(LL) { \
    int l = (LL); asm volatile("" : "+s"(l)); \
    const int b = 2 + 9 * (LL); \
    { MKP(q) if (PH(2) && IN(b + 0)) for (int rep = 0; rep < REP_GEMM; ++rep) phase_inproj2(q, l, lds); } \
    SEAM(b + 0); \
    { MKP(q) if (PH(3) && IN(b + 1)) for (int rep = 0; rep < REP_ML; ++rep) phase_c1(q, l, lds); } \
    SEAM(b + 1); \
    { MKP(q) if (PH(4) && IN(b + 2)) phase_c2(q, l, lds); } \
    SEAM(b + 3); \
    { MKP(q) if (PH(6) && IN(b + 4)) phase_outproj2(q, l, lds); } \
    SEAM(b + 4); \
    { MKP(q) if (PH(7) && IN(b + 5)) for (int rep = 0; rep < REP_MISC; ++rep) phase_norm(q, l, 1, false, (LL) == DEPTH - 1); } \
    SEAM(b + 5); \
    { MKP(q) if (PH(8) && IN(b + 6)) for (int rep = 0; rep < REP_GEMM; ++rep) phase_peerq2(q, l, lds); } \
    SEAM(b + 6); \
    { MKP(q) if (PH(9) && IN(b + 7)) phase_route(q, l, lds); } \
    SEAM(b + 7); \
    { MKP(q) if (PH(9) && IN(b + 8)) phase_gather(q, l, lds); } \
    SEAM(b + 8); }
  LAYER(0) LAYER(1) LAYER(2) LAYER(3)
#undef LAYER
#undef IN
#undef SEAM
#undef MKP
}

extern "C" void kernel_launch(void* const* d_in, const int* in_sizes, int n_in, void* d_out, int out_size,
                              void* d_ws, size_t ws_size, hipStream_t stream) {
  static int grid = 0;
  if (grid == 0) {
    int dev = 0, cus = 0, per_cu = 0;
    (void)hipGetDevice(&dev);
    (void)hipDeviceGetAttribute(&cus, hipDeviceAttributeMultiprocessorCount, dev);
    (void)hipFuncSetAttribute((const void*)mk_fwd, hipFuncAttributeMaxDynamicSharedMemorySize, LDS_BYTES);
    (void)hipOccupancyMaxActiveBlocksPerMultiprocessor(&per_cu, (const void*)mk_fwd, 512, LDS_BYTES);
    fprintf(stderr, "kernel_launch: cus %d per_cu %d ws %zu (need %zu) n_in %d\n", cus, per_cu, ws_size, (size_t)WS_END, n_in);
    if (ws_size < WS_END || n_in != 23 || per_cu < 1) { fprintf(stderr, "kernel_launch: bad configuration, nothing launched\n"); grid = -1; return; }
    grid = cus;
  }
  if (grid < 0) return;
  (void)hipMemsetAsync((char*)d_ws + WS_CTL, 0, 65536, stream);
  KArgs p{};
  for (int i = 0; i < 23; ++i) p.in[i] = (const float*)d_in[i];
  p.out = (float*)d_out; p.ws = (unsigned char*)d_ws; p.ph_lo = 0; p.ph_hi = 38;
  void* args[] = {&p};
  hipError_t e = hipLaunchCooperativeKernel((const void*)mk_fwd, dim3(grid), dim3(512), args, LDS_BYTES, stream);
  if (e != hipSuccess) fprintf(stderr, "cooperative launch failed: %s (grid %d)\n", hipGetErrorString(e), grid);
}
```

```cpp
#include <hip/hip_runtime.h>
#include <hip/hip_cooperative_groups.h>
#include <cstdio>
#include <cstdint>
namespace cg = cooperative_groups;

constexpr int DM = 1024, NBATCH = 4, SEQ = 8192, CTXL = 256, SEGL = CTXL + SEQ, T = NBATCH * SEGL, DEPTH = 4;
constexpr int IN_W = 3088, PW = 3072;
constexpr int QK8_PITCH = 144; constexpr size_t QK8_IMG = (size_t)16 * SEGL * QK8_PITCH;
constexpr int C_A = 0, C_MQ = 512, C_MK = 768, C_MV = 1024, C_MO = 1280, C_DQ = 1536, C_DK = 2048, C_DV = 2560;
constexpr int NCH = SEGL / 64;
constexpr int NEXP = 16384;
constexpr float EPS = 1e-6f;
#ifndef ABL
#define ABL 0
#endif
#ifndef GATHER_SYNC
#define GATHER_SYNC 0
#endif
#ifndef REP_ATT
#define REP_ATT 1
#endif
#ifndef GP_MASK
#define GP_MASK 0x3FFF
#endif
#ifndef REP_PEER
#define REP_PEER 1
#endif
#ifndef REP_GEMM
#define REP_GEMM 1
#endif
#ifndef REP_ROUTE
#define REP_ROUTE 1
#endif
#ifndef REP_OUTP
#define REP_OUTP 1
#endif
#ifndef REP_ML
#define REP_ML 1
#endif
#ifndef REP_MISC
#define REP_MISC 1
#endif
constexpr float QSCALE = 0.125f * 1.4426950408889634f;

constexpr size_t MiB = 1u << 20;
constexpr size_t WS_CTL = 0, WS_MOD = 1 * MiB, WS_ROPE = 2 * MiB, WS_WG = 4 * MiB, WS_KEYS = 5 * MiB, WS_MLMETA = 6 * MiB,
                 WS_GATES = 7 * MiB, WS_WIN = 10 * MiB, WS_WOUT = 34 * MiB, WS_WQ = 42 * MiB, WS_PU = 50 * MiB, WS_PV = 114 * MiB, WS_PSC = 178 * MiB  ,
                 WS_XCUR = 306 * MiB, WS_H = 438 * MiB, WS_MIX = 504 * MiB, WS_PROJ = 570 * MiB, WS_ULOC = 768 * MiB, WS_V8T = 836 * MiB  , WS_EID = 858 * MiB  , WS_QK8 = 924 * MiB  , WS_END = 964 * MiB;
constexpr int USTRIDE = 4160;

constexpr int LDS_BYTES = 139264 + 512;
constexpr int LDS_WTAB = LDS_BYTES - 64 - 256;

#define LAS __attribute__((address_space(3)))
__device__ __forceinline__ int hw_wave_key() { return (int)(__builtin_amdgcn_s_getreg((5 << 11) | 4) & 63u); }
__device__ __forceinline__ int tidx() {
  extern __shared__ __attribute__((aligned(16))) unsigned char lds_dyn_[];
  const int w = __builtin_amdgcn_readfirstlane(*(const volatile LAS int*)((LAS unsigned char*)lds_dyn_ + LDS_WTAB + 4 * hw_wave_key()));
  unsigned z_ = 0u; asm volatile("" : "+v"(z_));
  return (w << 6) | (int)__builtin_amdgcn_mbcnt_hi(~0u, __builtin_amdgcn_mbcnt_lo(~0u, z_));
}
typedef unsigned short bf16_t;
typedef short bf16x8 __attribute__((ext_vector_type(8)));
typedef short s16x4 __attribute__((ext_vector_type(4)));
typedef float f32x4 __attribute__((ext_vector_type(4)));
typedef float f32x16 __attribute__((ext_vector_type(16)));
typedef unsigned u32x4 __attribute__((ext_vector_type(4)));
typedef unsigned u32x2 __attribute__((ext_vector_type(2)));
typedef __bf16 bf16x2v __attribute__((ext_vector_type(2)));
typedef int i32x8 __attribute__((ext_vector_type(8)));
typedef int i32x6 __attribute__((ext_vector_type(6)));
struct __attribute__((aligned(4))) u32x3 { unsigned x, y, z; };
typedef float f32x32 __attribute__((ext_vector_type(32)));
constexpr int PROW = 768;
typedef float f32x2 __attribute__((ext_vector_type(2)));
typedef _Float16 h16x2 __attribute__((ext_vector_type(2)));
typedef _Float16 h16x32 __attribute__((ext_vector_type(32)));
typedef unsigned u32x3v __attribute__((ext_vector_type(3)));
typedef unsigned u32x2v __attribute__((ext_vector_type(2)));

struct KArgs {
  const float* in[23];
  float* out;
  unsigned char* ws;
  int ph_lo, ph_hi;
};
typedef const float* const __attribute__((address_space(4))) * InTab;
struct Params {
  InTab in;
  float* out;
  unsigned char* ws;
  int ph_lo, ph_hi;
  int bx, gx;
  unsigned* xbar_words; unsigned xbar_x; unsigned lds_st_off;
};
enum { I_X = 0, I_C, I_CTX, I_CCTX, I_ADAW, I_ADAB, I_N1G, I_N2G, I_WIN, I_CONVW, I_CONVB, I_CLNG, I_CLNB, I_GATEB, I_MNORMG, I_DLAM, I_DNORMG,
       I_WOUT, I_PWQ, I_PKEYS, I_PU, I_PV, I_FINALG };

__device__ __forceinline__ unsigned cvtpk(float lo, float hi) { unsigned r; asm volatile("v_cvt_pk_bf16_f32 %0, %1, %2" : "=v"(r) : "v"(lo), "v"(hi)); return r; }
__device__ __forceinline__ float bflo(unsigned u) { return __uint_as_float(u << 16); }
__device__ __forceinline__ float bfhi(unsigned u) { return __uint_as_float(u & 0xffff0000u); }
__device__ __forceinline__ float bf1(bf16_t u) { return __uint_as_float(((unsigned)u) << 16); }
__device__ __forceinline__ int crow(int r, int hi) { return (r & 3) + 8 * (r >> 2) + 4 * hi; }
template <int CTRL> __device__ __forceinline__ float dpp_mov(float v) {
  return __uint_as_float((unsigned)__builtin_amdgcn_update_dpp(0, (int)__float_as_uint(v), CTRL, 0xF, 0xF, true));
}
__device__ __forceinline__ float wave_sum_fast(float x) {
  x += dpp_mov<0xB1>(x); x += dpp_mov<0x4E>(x); x += dpp_mov<0x141>(x); x += dpp_mov<0x140>(x);
  { auto r = __builtin_amdgcn_permlane16_swap(__float_as_uint(x), __float_as_uint(x), false, false); x = __uint_as_float(r[0]) + __uint_as_float(r[1]); }
  { auto r = __builtin_amdgcn_permlane32_swap(__float_as_uint(x), __float_as_uint(x), false, false); x = __uint_as_float(r[0]) + __uint_as_float(r[1]); }
  return x;
}
__device__ __forceinline__ float wave_max_fast(float x) {
  x = fmaxf(x, dpp_mov<0xB1>(x)); x = fmaxf(x, dpp_mov<0x4E>(x)); x = fmaxf(x, dpp_mov<0x141>(x)); x = fmaxf(x, dpp_mov<0x140>(x));
  { auto r = __builtin_amdgcn_permlane16_swap(__float_as_uint(x), __float_as_uint(x), false, false); x = fmaxf(__uint_as_float(r[0]), __uint_as_float(r[1])); }
  { auto r = __builtin_amdgcn_permlane32_swap(__float_as_uint(x), __float_as_uint(x), false, false); x = fmaxf(__uint_as_float(r[0]), __uint_as_float(r[1])); }
  return x;
}
template <int CTRL, int ROWMASK> __device__ __forceinline__ float dpp_mov_rm(float v) {
  return __uint_as_float((unsigned)__builtin_amdgcn_update_dpp(0, (int)__float_as_uint(v), CTRL, ROWMASK, 0xF, true));
}
__device__ __forceinline__ float wave_incl_scan(float x) {
  x += dpp_mov<0x111>(x); x += dpp_mov<0x112>(x); x += dpp_mov<0x114>(x); x += dpp_mov<0x118>(x);
  x += dpp_mov_rm<0x142, 0xA>(x);
  x += dpp_mov_rm<0x143, 0xC>(x);
  return x;
}
__device__ __forceinline__ float wave_sum(float v) { return wave_sum_fast(v); }
__device__ __forceinline__ float sum_xor32(float x) { auto r = __builtin_amdgcn_permlane32_swap(__float_as_uint(x), __float_as_uint(x), false, false); return __uint_as_float(r[0]) + __uint_as_float(r[1]); }
__device__ __forceinline__ float max_xor32(float x) { auto r = __builtin_amdgcn_permlane32_swap(__float_as_uint(x), __float_as_uint(x), false, false); return fmaxf(__uint_as_float(r[0]), __uint_as_float(r[1])); }
__device__ __forceinline__ float wave_max(float v) { return wave_max_fast(v); }
__device__ __forceinline__ float sigmoidf_(float x) { return 1.f / (1.f + __expf(-x)); }
__device__ __forceinline__ float logsigmoidf_(float x) { return fminf(x, 0.f) - log1pf(__expf(-fabsf(x))); }
__device__ __forceinline__ const float* in_row(const float* x, const float* ctx, int row) {
  const int b = row / SEGL, s = row - b * SEGL;
  return s < CTXL ? ctx + ((size_t)(b * CTXL + s)) * DM : x + ((size_t)(b * SEQ + (s - CTXL))) * DM;
}
__device__ __forceinline__ int mod_row(int row) { const int b = row / SEGL, s = row - b * SEGL; return s < CTXL ? 4 : b; }

__device__ __forceinline__ void p0_mod(const Params& p, unsigned char* lds, float* MOD) {
  float* sil = (float*)lds;
  float* red = (float*)(lds + 20480);
  int tid_ = tidx(); asm volatile("" : "+v"(tid_)); const int tid = tid_, lane = tid & 63, wid = tid >> 6;
  for (int i = tid; i < 5 * 1024; i += 512) {
    const float v = i < 4096 ? p.in[I_C][i] : p.in[I_CCTX][i - 4096];
    sil[i] = v / (1.f + __expf(-v));
  }
  __syncthreads();
  for (int item = p.bx; item < DEPTH * 96; item += p.gx) {
    const int l = item / 96, j0 = (item % 96) * 64;
    const float* W = p.in[I_ADAW] + (size_t)l * DM * 6144 + j0 + lane;
    float a0 = 0.f, a1 = 0.f, a2 = 0.f, a3 = 0.f, a4 = 0.f;
    const int k0 = wid * 128;
#pragma unroll 8
    for (int k = k0; k < k0 + 128; ++k) {
      const float w = W[(size_t)k * 6144];
      a0 += sil[k] * w; a1 += sil[1024 + k] * w; a2 += sil[2048 + k] * w; a3 += sil[3072 + k] * w; a4 += sil[4096 + k] * w;
    }
    red[(wid * 5 + 0) * 64 + lane] = a0; red[(wid * 5 + 1) * 64 + lane] = a1; red[(wid * 5 + 2) * 64 + lane] = a2;
    red[(wid * 5 + 3) * 64 + lane] = a3; red[(wid * 5 + 4) * 64 + lane] = a4;
    __syncthreads();
    if (tid < 320) {
      const int r = tid >> 6;
      float s = 0.f;
#pragma unroll
      for (int w = 0; w < 8; ++w) s += red[(w * 5 + r) * 64 + lane];
      MOD[((size_t)l * 5 + r) * 6144 + j0 + lane] = s + p.in[I_ADAB][l * 6144 + j0 + lane];
    }
    __syncthreads();
  }
}
__device__ __forceinline__ void transpose_item(const float* W, int ldw, int srccol0, bf16_t* WT, int K, int n0, int k0, float* scr, int lane) {
#pragma unroll 8
  for (int i = 0; i < 32; ++i) { const int kk = 2 * i + (lane >> 5); scr[kk * 33 + (lane & 31)] = W[(size_t)(k0 + kk) * ldw + srccol0 + (lane & 31)]; }
  asm volatile("s_waitcnt lgkmcnt(0)" ::: "memory");
  const int c = lane & 7;
#pragma unroll
  for (int j = 0; j < 4; ++j) {
    const int n = (lane >> 3) + 8 * j; const float* s = scr + (8 * c) * 33 + n;
    u32x4 o; o.x = cvtpk(s[0], s[33]); o.y = cvtpk(s[66], s[99]); o.z = cvtpk(s[132], s[165]); o.w = cvtpk(s[198], s[231]);
    *(u32x4*)(WT + (size_t)(n0 + n) * K + k0 + 8 * c) = o;
  }
  asm volatile("s_waitcnt lgkmcnt(0)" ::: "memory");
}
__device__ __forceinline__ void convert_tables(const Params& p, int L, int wv, int nw, int lane, int r_lo, int r_hi) {
  unsigned char* PUq = p.ws + WS_PU; unsigned char* PVq = p.ws + WS_PV; float* PSC = (float*)(p.ws + WS_PSC);
  const int nrows = DEPTH * NEXP;
#define TAB_SROW(r_) ((const f32x4*)(((r_) >= NEXP ? p.in[I_PV] : p.in[I_PU]) + (size_t)(L * NEXP + ((r_) >= NEXP ? (r_) - NEXP : (r_))) * DM) + lane * 4)
#define TAB_LOAD(v_, r_) do { if ((r_) < r_hi) { const f32x4* s_ = TAB_SROW(r_); _Pragma("unroll") for (int j = 0; j < 4; ++j) v_[j] = __builtin_nontemporal_load(s_ + j); } } while (0)
  auto encode_row = [&](const f32x4 (&v)[4], int r) {
    const int tb = r >= NEXP, rr = L * NEXP + (tb ? r - NEXP : r);
    float mx = 0.f;
#pragma unroll
    for (int j = 0; j < 4; ++j) mx = fmaxf(mx, fmaxf(fmaxf(fabsf(v[j].x), fabsf(v[j].y)), fmaxf(fabsf(v[j].z), fabsf(v[j].w))));
    mx = wave_max_fast(mx);
    const unsigned mb = __float_as_uint(mx);
    const int eb = (int)((mb >> 23) & 0xFFu);
    int sb = ((mb & 0x7FFFFFu) <= 0x700000u ? 129 : 128) - eb + 127; sb = sb < 1 ? 1 : (sb > 253 ? 253 : sb);
    const float sc = __uint_as_float((unsigned)sb << 23), isc = __uint_as_float((unsigned)(254 - sb) << 23);
    const float xv[16] = {v[0].x, v[0].y, v[0].z, v[0].w, v[1].x, v[1].y, v[1].z, v[1].w, v[2].x, v[2].y, v[2].z, v[2].w, v[3].x, v[3].y, v[3].z, v[3].w};
    unsigned wq[3] = {0u, 0u, 0u};
#pragma unroll
    for (int i = 0; i < 16; ++i) {
      const float a = fabsf(xv[i]) * sc;
      unsigned code = a < 2.f ? (unsigned)__builtin_rintf(a * 8.f) : (a < 4.f ? 8u + (unsigned)__builtin_rintf(a * 4.f) : 16u + (unsigned)__builtin_rintf(a * 2.f));
      code = code > 31u ? 31u : code;
      code |= (xv[i] < 0.f) ? 32u : 0u;
      const int bp = 6 * i, dw = bp >> 5, off = bp & 31;
      wq[dw] |= code << off;
      if (off > 26) wq[dw + 1] |= code >> (32 - off);
    }
    u32x3 o; o.x = wq[0]; o.y = wq[1]; o.z = wq[2];
    *(u32x3*)((tb ? PVq : PUq) + (size_t)rr * PROW + lane * 12) = o;
    if (lane == 0) PSC[(size_t)tb * nrows + rr] = isc;
  };
  f32x4 v0[4], v1[4], v2[4];
  TAB_LOAD(v0, r_lo + wv); TAB_LOAD(v1, r_lo + wv + nw);
#pragma unroll 1
  for (int r = r_lo + wv; r < r_hi; r += 3 * nw) {
    TAB_LOAD(v2, r + 2 * nw); encode_row(v0, r);
    if (r + nw < r_hi) { TAB_LOAD(v0, r + 3 * nw); encode_row(v1, r + nw); }
    if (r + 2 * nw < r_hi) { TAB_LOAD(v1, r + 4 * nw); encode_row(v2, r + 2 * nw); }
  }
#undef TAB_LOAD
#undef TAB_SROW
}
__device__ __forceinline__ void tail_filler_tables(const Params& p, int L, int nwg, int r_lo, int r_hi) {
  int tid_ = tidx(); asm volatile("" : "+v"(tid_)); const int lane = tid_ & 63, wid = tid_ >> 6;
  const int nextra = nwg % p.gx, first = nextra, nidle = p.gx - nextra;
  if (p.bx < first) return;
  convert_tables(p, L, (p.bx - first) * 8 + wid, nidle * 8, lane, r_lo, r_hi);
}
__device__ __forceinline__ void p0_convert(const Params& p, unsigned char* lds) {
  int tid_ = tidx(); asm volatile("" : "+v"(tid_)); const int tid = tid_, lane = tid & 63, wid = tid >> 6;
  const int gw = p.bx * 8 + wid, NGW = p.gx * 8;
  const size_t gt = (size_t)p.bx * 512 + tid, NGT = (size_t)p.gx * 512;
  float* scr = (float*)(lds + 32768) + wid * (64 * 33);
  bf16_t* WIN = (bf16_t*)(p.ws + WS_WIN); bf16_t* WOUT = (bf16_t*)(p.ws + WS_WOUT); bf16_t* WQ = (bf16_t*)(p.ws + WS_WQ);
  constexpr int I_IN = 16 * 96, I_O = 16 * 32, PER_L = I_IN + 2 * I_O;
  for (int it = gw; it < DEPTH * PER_L; it += NGW) {
    const int l = it / PER_L; int r = it % PER_L;
    if (r < I_IN) { const int kb = r / 96, nb = r % 96, n0 = nb * 32; const int src = n0 < 1536 ? n0 : n0 + 16;
      transpose_item(p.in[I_WIN] + (size_t)l * DM * IN_W, IN_W, src, WIN + (size_t)l * PW * DM, DM, n0, kb * 64, scr, lane); continue; }
    r -= I_IN;
    if (r < I_O) { const int kb = r / 32, nb = r % 32;
      transpose_item(p.in[I_WOUT] + (size_t)l * DM * DM, DM, nb * 32, WOUT + (size_t)l * DM * DM, DM, nb * 32, kb * 64, scr, lane); continue; }
    r -= I_O;
    { const int kb = r / 32, nb = r % 32;
      transpose_item(p.in[I_PWQ] + (size_t)l * DM * DM, DM, nb * 32, WQ + (size_t)l * DM * DM, DM, nb * 32, kb * 64, scr, lane); }
  }
  bf16_t* WG = (bf16_t*)(p.ws + WS_WG);
  for (size_t i = gt; i < (size_t)DEPTH * 16 * DM; i += NGT) {
    const int l = (int)(i / (16 * DM)), g = (int)((i / DM) % 16), k = (int)(i % DM);
    WG[i] = (bf16_t)(cvtpk(p.in[I_WIN][(size_t)l * DM * IN_W + (size_t)k * IN_W + 1536 + g], 0.f) & 0xffffu);
  }
  bf16_t* KEYS = (bf16_t*)(p.ws + WS_KEYS);
  for (size_t i = gt; i < (size_t)DEPTH * 131072 / 8; i += NGT) {
    const f32x4 a = ((const f32x4*)p.in[I_PKEYS])[2 * i], b = ((const f32x4*)p.in[I_PKEYS])[2 * i + 1];
    u32x4 o; o.x = cvtpk(a.x, a.y); o.y = cvtpk(a.z, a.w); o.z = cvtpk(b.x, b.y); o.w = cvtpk(b.z, b.w);
    ((u32x4*)KEYS)[i] = o;
  }
  {
    float* RC = (float*)(p.ws + WS_ROPE); float* RS = RC + SEQ * 32;
    for (size_t i = gt; i < (size_t)SEQ * 32; i += NGT) {
      const int pos = (int)(i >> 5), j = (int)(i & 31);
      const int rr = pos >> 6, cc = pos & 63;
      const int jj = j & 15;
      const double e = -(double)jj * 0.83048202372184058696;
      const double fl = __builtin_floor(e); const double f = e - fl;
      const double z = f * 0.69314718055994530942;
      double ez = 1.0 + z * (1.0 + z * (0.5 + z * (1.0 / 6 + z * (1.0 / 24 + z * (1.0 / 120 + z * (1.0 / 720 + z * (1.0 / 5040 + z * (1.0 / 40320 + z * (1.0 / 362880 + z * (1.0 / 3628800 + z * (1.0 / 39916800 + z * (1.0 / 479001600))))))))))));
      const double inv = __builtin_ldexp(ez, (int)fl);
      const float invf = (float)inv;
      const float angf = (float)(j < 16 ? rr : cc) * invf;
      const double ang = (double)angf;
      const double kq = __builtin_rint(ang * 0.63661977236758134308);
      double r = __builtin_fma(-kq, 1.57079632679489655800e+00, ang);
      r = __builtin_fma(-kq, 6.12323399573676603587e-17, r);
      const double r2 = r * r;
      const double sn = r * (1.0 + r2 * (-1.0 / 6 + r2 * (1.0 / 120 + r2 * (-1.0 / 5040 + r2 * (1.0 / 362880 + r2 * (-1.0 / 39916800 + r2 * (1.0 / 6227020800.0)))))));
      const double cs = 1.0 + r2 * (-0.5 + r2 * (1.0 / 24 + r2 * (-1.0 / 720 + r2 * (1.0 / 40320 + r2 * (-1.0 / 3628800 + r2 * (1.0 / 479001600 + r2 * (-1.0 / 87178291200.0)))))));
      const int q = ((int)kq) & 3;
      double co, si;
      if (q == 0) { co = cs; si = sn; } else if (q == 1) { co = -sn; si = cs; } else if (q == 2) { co = -cs; si = -sn; } else { co = sn; si = -cs; }
      RC[i] = (float)co; RS[i] = (float)si;
    }
  }
}

__device__ __forceinline__ void norm_mod_row(const float* xrow, const float* g, const float* sc, const float* sh, bf16_t* orow, int lane) {
  const f32x4* xr = (const f32x4*)xrow + lane;
  f32x4 v[4]; float s = 0.f;
#pragma unroll
  for (int j = 0; j < 4; ++j) { v[j] = xr[64 * j]; s += (v[j].x * v[j].x + v[j].y * v[j].y) + (v[j].z * v[j].z + v[j].w * v[j].w); }
  const float rs = rsqrtf(wave_sum(s) * (1.f / DM) + EPS);
  u32x2* o = (u32x2*)orow + lane;
#pragma unroll
  for (int j = 0; j < 4; ++j) {
    const f32x4 gg = ((const f32x4*)g)[lane + 64 * j], cc = ((const f32x4*)sc)[lane + 64 * j], hh = ((const f32x4*)sh)[lane + 64 * j];
    const float y0 = v[j].x * rs * gg.x * (1.f + cc.x) + hh.x, y1 = v[j].y * rs * gg.y * (1.f + cc.y) + hh.y;
    const float y2 = v[j].z * rs * gg.z * (1.f + cc.z) + hh.z, y3 = v[j].w * rs * gg.w * (1.f + cc.w) + hh.w;
    u32x2 w; w.x = cvtpk(y0, y1); w.y = cvtpk(y2, y3);
    o[64 * j] = w;
  }
}
__device__ __forceinline__ void phase_norm(const Params& p, int l, int which, bool from_input, bool skip_ctx) {
  int tid_ = tidx(); asm volatile("" : "+v"(tid_));
  const int lane = tid_ & 63, wid = tid_ >> 6;
  const int gw = p.bx * 8 + wid, NGW = p.gx * 8;
  const float* MOD = (const float*)(p.ws + WS_MOD);
  const float* XC = (const float*)(p.ws + WS_XCUR);
  bf16_t* H = (bf16_t*)(p.ws + WS_H);
  const float* g = p.in[which ? I_N2G : I_N1G] + l * DM;
  auto next_row = [&](int r_) { while (r_ < T && skip_ctx && mod_row(r_) == 4) r_ += NGW; return r_; };
  auto xrow_of = [&](int r_) { return (const f32x4*)(from_input ? in_row(p.in[I_X], p.in[I_CTX], r_) : XC + (size_t)r_ * DM) + lane; };
  f32x4 gg[4], cc[4], hh[4], v[4], vn[4];
#pragma unroll
  for (int j = 0; j < 4; ++j) gg[j] = ((const f32x4*)g)[lane + 64 * j];
  int mr_cur = -1;
  int row = next_row(gw);
  if (row < T) { const f32x4* xr = xrow_of(row);
#pragma unroll
    for (int j = 0; j < 4; ++j) v[j] = xr[64 * j]; }
  while (row < T) {
    const int nrow = next_row(row + NGW);
    if (nrow < T) { const f32x4* xn = xrow_of(nrow);
#pragma unroll
      for (int j = 0; j < 4; ++j) vn[j] = xn[64 * j]; }
    const int mr = mod_row(row);
    if (mr != mr_cur) {
      const float* m = MOD + ((size_t)l * 5 + mr) * 6144 + which * 3072;
#pragma unroll
      for (int j = 0; j < 4; ++j) { cc[j] = ((const f32x4*)(m + 1024))[lane + 64 * j]; hh[j] = ((const f32x4*)m)[lane + 64 * j]; }
      mr_cur = mr;
    }
    float s = 0.f;
#pragma unroll
    for (int j = 0; j < 4; ++j) s += (v[j].x * v[j].x + v[j].y * v[j].y) + (v[j].z * v[j].z + v[j].w * v[j].w);
    const float rs = rsqrtf(wave_sum(s) * (1.f / DM) + EPS);
    u32x2* o = (u32x2*)(H + (size_t)row * DM) + lane;
#pragma unroll
    for (int j = 0; j < 4; ++j) {
      const float y0 = v[j].x * rs * gg[j].x * (1.f + cc[j].x) + hh[j].x, y1 = v[j].y * rs * gg[j].y * (1.f + cc[j].y) + hh[j].y;
      const float y2 = v[j].z * rs * gg[j].z * (1.f + cc[j].z) + hh[j].z, y3 = v[j].w * rs * gg[j].w * (1.f + cc[j].w) + hh[j].w;
      u32x2 w; w.x = cvtpk(y0, y1); w.y = cvtpk(y2, y3);
      o[64 * j] = w;
    }
#pragma unroll
    for (int j = 0; j < 4; ++j) v[j] = vn[j];
    row = nrow;
  }
}

namespace pg8 {
#define PG8_LAS __attribute__((address_space(3)))
typedef unsigned short bf16_t;
typedef short bf16x8 __attribute__((ext_vector_type(8)));
typedef float f32x4 __attribute__((ext_vector_type(4)));
typedef unsigned u32x4 __attribute__((ext_vector_type(4)));
constexpr int BM = 256, BK = 64, HALF = 128, HTB = HALF * BK * 2  , STAGE_BYTES = 8 * HTB, NXCD = 8, WGM = 8;

__host__ __device__ __forceinline__ int lds_byte(int r, int c) { const int st = (r >> 4) * 2 + (c >> 5), rr = r & 15, cc = c & 31, ob = rr * 64 + cc * 2; return st * 1024 + (ob ^ (((ob >> 9) & 1) << 5)); }
__host__ __device__ __forceinline__ void stage_rc(int b, int& R, int& C) { const int st = b / 1024, sb = b % 1024, swz = sb ^ (((sb >> 9) & 1) << 5); R = (st >> 1) * 16 + swz / 64; C = (st & 1) * 32 + (swz % 64) / 2; }
__host__ __device__ __forceinline__ int perm32(int rho) { const int n = rho >> 4, i = rho & 15; return 8 * (i >> 2) + 4 * n + (i & 3); }

struct Unit { int pm, pn; };
struct Gemm { const bf16_t* A; const bf16_t* Bt; int M, N, K; };

struct StaticOrder {
    int nM, nN, nwg, G, c;
    __host__ __device__ void init(int M, int N, int G_, int c_) { nM = M / BM; nN = N / BM; nwg = nM * nN; G = G_; c = c_; }
    __host__ __device__ bool next(int i, Unit& u) const {
        const long L = (long)i * G + c; if (L >= nwg) return false;
        int wgid = (int)L; { const int q = nwg / NXCD, r = nwg % NXCD, xcd = wgid % NXCD, off = wgid / NXCD; wgid = (xcd < r ? xcd * (q + 1) : r * (q + 1) + (xcd - r) * q) + off; }
        const int nig = WGM * nN, gid = wgid / nig, fm = gid * WGM, gsz = (nM - fm) < WGM ? (nM - fm) : WGM;
        u.pm = fm + ((wgid % nig) % gsz); u.pn = (wgid % nig) / gsz; return true;
    }
    __device__ __forceinline__ void a_ready(const Unit&) const {}
    __device__ __forceinline__ void done(const Unit&) const {}
};
__device__ __forceinline__ unsigned cvt_pk_bf16(float lo, float hi) { unsigned r; asm volatile("v_cvt_pk_bf16_f32 %0, %1, %2" : "=v"(r) : "v"(lo), "v"(hi)); return r; }
template <class Epi, class Sched, bool ALIGN_EPI = false, bool SP2 = false>
__device__ __forceinline__ void gemm_phase(PG8_LAS unsigned char* lds, const Gemm g, const Sched& S, const Epi& E) {
    const int tid = tidx(), wid = __builtin_amdgcn_readfirstlane(tid >> 6), lane = tid & 63, wr = wid >> 2, wc = wid & 3, fr = lane & 15, fq = lane >> 4;
    const int K = g.K, nt = K / BK;
    unsigned voffA[2], voffB[2];
#pragma unroll
    for (int i = 0; i < 2; ++i) { int R, C; stage_rc(tid * 16 + i * 8192, R, C); const int Rb = Epi::PERM ? ((R & ~31) + perm32(R & 31)) : R;
        voffA[i] = (unsigned)(R * K + C) * 2u; voffB[i] = (unsigned)(Rb * K + C) * 2u; }
    const size_t kstep = (size_t)(BK * 2);
    const size_t hstep = (size_t)HALF * K * 2;
    const size_t tstep = 2 * hstep;
    const unsigned ldsw = (unsigned)wid * 1024u;
    const int aoff = lds_byte(wr * 64 + fr, fq * 8), boff = lds_byte(wc * 32 + fr, fq * 8);
#define PG8_SA(b, h) (((b) * 2 + (h)) * HTB)
#define PG8_SB(b, h) ((4 + (b) * 2 + (h)) * HTB)
#define PG8_STAGE(bufoff, gbase, voff) do { _Pragma("unroll") for (int _i = 0; _i < 2; ++_i) \
        __builtin_amdgcn_global_load_lds((const unsigned*)((const char*)(gbase) + (voff)[_i]), (PG8_LAS unsigned*)(lds + (bufoff) + ldsw + _i * 8192), 16, 0, 0); } while (0)
#define PG8_LDA(dst, b, h) do { _Pragma("unroll") for (int m = 0; m < 4; ++m) _Pragma("unroll") for (int k = 0; k < 2; ++k) dst[m][k] = *(const PG8_LAS bf16x8*)(lds + PG8_SA(b, h) + aoff + m * 2048 + k * 1024); } while (0)
#define PG8_LDB(dst, b, h) do { _Pragma("unroll") for (int n = 0; n < 2; ++n) _Pragma("unroll") for (int k = 0; k < 2; ++k) dst[n][k] = *(const PG8_LAS bf16x8*)(lds + PG8_SB(b, h) + boff + n * 2048 + k * 1024); } while (0)
#define PG8_MMA(ai, bj, At, Bt) do { __builtin_amdgcn_s_setprio(1); _Pragma("unroll") for (int m = 0; m < 4; ++m) _Pragma("unroll") for (int n = 0; n < 2; ++n) _Pragma("unroll") for (int k = 0; k < 2; ++k) \
        acc[ai][bj][m][n] = __builtin_amdgcn_mfma_f32_16x16x32_bf16(Bt[n][k], At[m][k], acc[ai][bj][m][n], 0, 0, 0); __builtin_amdgcn_s_setprio(0); } while (0)
#define PG8_WAIT_V(n) asm volatile("s_waitcnt vmcnt(" #n ")" ::: "memory")
#define PG8_WAIT_L(n) asm volatile("s_waitcnt lgkmcnt(" #n ")" ::: "memory")
#define PG8_BAR __builtin_amdgcn_s_barrier()
#define PG8_SCHED __builtin_amdgcn_sched_barrier(0)
    Unit cur, nxt; int ui = 0;
    if (!S.next(0, cur)) return;
    f32x4 acc[2][2][4][2];
#pragma unroll
    for (int a = 0; a < 2; ++a)
#pragma unroll
        for (int b = 0; b < 2; ++b)
#pragma unroll
            for (int m = 0; m < 4; ++m)
#pragma unroll
                for (int n = 0; n < 2; ++n) acc[a][b][m][n] = (f32x4){0.f, 0.f, 0.f, 0.f};
    bf16x8 At[4][2], B0[2][2], B1[2][2];
    const char* cA = (const char*)g.A + (size_t)cur.pm * tstep; const char* cB = (const char*)g.Bt + (size_t)cur.pn * tstep;
    S.a_ready(cur);
    if constexpr (SP2) {
        PG8_STAGE(PG8_SB(0, 0), cB, voffB); PG8_STAGE(PG8_SB(0, 1), cB + hstep, voffB); PG8_STAGE(PG8_SA(0, 0), cA, voffA); PG8_STAGE(PG8_SA(0, 1), cA + hstep, voffA);
        if (wr == 1) PG8_BAR;
        PG8_WAIT_V(2); PG8_BAR;
        PG8_STAGE(PG8_SB(1, 0), cB + kstep, voffB); PG8_STAGE(PG8_SA(1, 0), cA + kstep, voffA); PG8_STAGE(PG8_SB(1, 1), cB + hstep + kstep, voffB);
        PG8_WAIT_V(6); PG8_BAR;
    } else {
        PG8_STAGE(PG8_SB(0, 0), cB, voffB); PG8_STAGE(PG8_SA(0, 0), cA, voffA); PG8_STAGE(PG8_SB(0, 1), cB + hstep, voffB); PG8_STAGE(PG8_SA(0, 1), cA + hstep, voffA);
        if (wr == 1) PG8_BAR;
        PG8_WAIT_V(4); PG8_BAR;
        PG8_STAGE(PG8_SB(1, 0), cB + kstep, voffB); PG8_STAGE(PG8_SA(1, 0), cA + kstep, voffA); PG8_STAGE(PG8_SB(1, 1), cB + hstep + kstep, voffB);
        PG8_WAIT_V(6); PG8_BAR;
    }
    for (;;) {
        const bool has_next = S.next(ui + 1, nxt);
        const char* nA = has_next ? (const char*)g.A + (size_t)nxt.pm * tstep : cA; const char* nB = has_next ? (const char*)g.Bt + (size_t)nxt.pn * tstep : cB;
        for (int t = 0; t < nt; t += 2) {
            const bool last = (t == nt - 2);
            const char* a1 = cA + (size_t)(t + 1) * kstep;
            const char* a2 = last ? nA : cA + (size_t)(t + 2) * kstep; const char* b2 = last ? nB : cB + (size_t)(t + 2) * kstep;
            const char* a3 = a2 + kstep; const char* b3 = b2 + kstep;
            if (last && has_next) S.a_ready(nxt);
            if constexpr (SP2) {
            PG8_LDB(B0, 0, 0); PG8_LDB(B1, 0, 1); PG8_SCHED; PG8_LDA(At, 0, 0); PG8_STAGE(PG8_SA(1, 1), a1 + hstep, voffA);
            PG8_WAIT_V(8); PG8_WAIT_L(0); PG8_BAR; PG8_MMA(0, 0, At, B0); PG8_MMA(0, 1, At, B1); PG8_BAR; PG8_SCHED;
            PG8_LDA(At, 0, 1); PG8_STAGE(PG8_SB(0, 0), b2, voffB); PG8_STAGE(PG8_SB(0, 1), b2 + hstep, voffB); PG8_STAGE(PG8_SA(0, 0), a2, voffA);
            PG8_WAIT_V(8); PG8_WAIT_L(0); PG8_BAR; PG8_MMA(1, 0, At, B0); PG8_MMA(1, 1, At, B1); PG8_BAR; PG8_SCHED;
            PG8_LDB(B0, 1, 0); PG8_LDB(B1, 1, 1); PG8_SCHED; PG8_LDA(At, 1, 0); PG8_STAGE(PG8_SA(0, 1), a2 + hstep, voffA);
            PG8_WAIT_V(8); PG8_WAIT_L(0); PG8_BAR; PG8_MMA(0, 0, At, B0); PG8_MMA(0, 1, At, B1); PG8_BAR; PG8_SCHED;
            PG8_LDA(At, 1, 1); PG8_STAGE(PG8_SB(1, 0), b3, voffB); PG8_STAGE(PG8_SB(1, 1), b3 + hstep, voffB); PG8_STAGE(PG8_SA(1, 0), a3, voffA);
            PG8_WAIT_V(8); PG8_WAIT_L(0); PG8_BAR; PG8_MMA(1, 0, At, B0); PG8_MMA(1, 1, At, B1); PG8_BAR; PG8_SCHED;
            } else {
            PG8_LDB(B0, 0, 0); PG8_SCHED; PG8_LDA(At, 0, 0); PG8_STAGE(PG8_SA(1, 1), a1 + hstep, voffA);
            PG8_WAIT_L(8); PG8_BAR; PG8_WAIT_L(0); PG8_MMA(0, 0, At, B0); PG8_BAR; PG8_SCHED;
            PG8_LDB(B1, 0, 1); PG8_STAGE(PG8_SB(0, 0), b2, voffB);
            PG8_BAR; PG8_WAIT_L(0); PG8_MMA(0, 1, At, B1); PG8_BAR;
            PG8_LDA(At, 0, 1); PG8_STAGE(PG8_SA(0, 0), a2, voffA);
            PG8_BAR; PG8_WAIT_L(0); PG8_MMA(1, 0, At, B0); PG8_BAR; PG8_SCHED;
            PG8_STAGE(PG8_SB(0, 1), b2 + hstep, voffB);
            PG8_WAIT_V(6); PG8_BAR; PG8_MMA(1, 1, At, B1); PG8_BAR;
            PG8_LDB(B0, 1, 0); PG8_SCHED; PG8_LDA(At, 1, 0); PG8_STAGE(PG8_SA(0, 1), a2 + hstep, voffA);
            PG8_WAIT_L(8); PG8_BAR; PG8_WAIT_L(0); PG8_MMA(0, 0, At, B0); PG8_BAR; PG8_SCHED;
            PG8_LDB(B1, 1, 1); PG8_STAGE(PG8_SB(1, 0), b3, voffB);
            PG8_BAR; PG8_WAIT_L(0); PG8_MMA(0, 1, At, B1); PG8_BAR;
            PG8_LDA(At, 1, 1); PG8_STAGE(PG8_SA(1, 0), a3, voffA);
            PG8_BAR; PG8_WAIT_L(0); PG8_MMA(1, 0, At, B0); PG8_BAR; PG8_SCHED;
            PG8_STAGE(PG8_SB(1, 1), b3 + hstep, voffB);
            PG8_WAIT_V(6); PG8_BAR; PG8_MMA(1, 1, At, B1); PG8_BAR;
            }
        }
        if constexpr (ALIGN_EPI) { if (wr == 0) PG8_BAR; }
        if constexpr (!Epi::AFTER_DRAIN) { E(acc, cur, wr, wc, fr, fq); S.done(cur); }
        if (!has_next) break;
#pragma unroll
        for (int a = 0; a < 2; ++a)
#pragma unroll
            for (int b = 0; b < 2; ++b)
#pragma unroll
                for (int m = 0; m < 4; ++m)
#pragma unroll
                    for (int n = 0; n < 2; ++n) acc[a][b][m][n] = (f32x4){0.f, 0.f, 0.f, 0.f};
        cur = nxt; cA = nA; cB = nB; ++ui;
        if constexpr (ALIGN_EPI) { if (wr == 1) PG8_BAR; }
    }
    PG8_WAIT_V(0);
    if constexpr (!ALIGN_EPI) { if (wr == 0) PG8_BAR; }
    PG8_BAR;
    if constexpr (Epi::AFTER_DRAIN) { E.fused(acc, cur, wr, wc, fr, fq, lds, wid, lane); S.done(cur); }
#undef PG8_SA
#undef PG8_SB
#undef PG8_STAGE
#undef PG8_LDA
#undef PG8_LDB
#undef PG8_MMA
#undef PG8_WAIT_V
#undef PG8_WAIT_L
#undef PG8_BAR
#undef PG8_SCHED
}
}

__device__ __forceinline__ int gswz(int row, int chunk) { return row * 128 + ((chunk ^ ((row >> 1) & 7)) << 4); }
__device__ __forceinline__ void gemm_tile(const bf16_t* __restrict__ A, int lda, const bf16_t* __restrict__ Bt, int ldb, int K,
                                          int row0, int col0, unsigned char* lds, f32x16 (&acc)[2][2]) {
  int tid_ = tidx(); asm volatile("" : "+v"(tid_)); const int tid = tid_, lane = tid & 63, wid = tid >> 6, wm = wid >> 1, wn = wid & 1, r32 = lane & 31, hi = lane >> 5;
  unsigned char* As = lds; unsigned char* Bs = lds + 65536;
#pragma unroll
  for (int i = 0; i < 2; ++i)
#pragma unroll
    for (int j = 0; j < 2; ++j) acc[i][j] = f32x16{};
  const int lrow = tid >> 3, lc = tid & 7;
  const bf16_t* Ag = A + (size_t)(row0 + lrow) * lda + lc * 8;
  const bf16_t* Bg = Bt + (size_t)(col0 + lrow) * ldb + lc * 8;
  u32x4 ra[4], rb[2];
#pragma unroll
  for (int i = 0; i < 4; ++i) ra[i] = *(const u32x4*)(Ag + (size_t)(64 * i) * lda);
#pragma unroll
  for (int i = 0; i < 2; ++i) rb[i] = *(const u32x4*)(Bg + (size_t)(64 * i) * ldb);
#pragma unroll
  for (int i = 0; i < 4; ++i) *(u32x4*)(As + gswz(lrow + 64 * i, lc)) = ra[i];
#pragma unroll
  for (int i = 0; i < 2; ++i) *(u32x4*)(Bs + gswz(lrow + 64 * i, lc)) = rb[i];
  __syncthreads();
  const int nk = K / 64;
  for (int kt = 0; kt < nk; ++kt) {
    const int cur = kt & 1;
    if (kt + 1 < nk) {
#pragma unroll
      for (int i = 0; i < 4; ++i) ra[i] = *(const u32x4*)(Ag + (size_t)(64 * i) * lda + (kt + 1) * 64);
#pragma unroll
      for (int i = 0; i < 2; ++i) rb[i] = *(const u32x4*)(Bg + (size_t)(64 * i) * ldb + (kt + 1) * 64);
    }
    const unsigned char* Ac = As + cur * 32768; const unsigned char* Bc = Bs + cur * 16384;
#pragma unroll
    for (int kk = 0; kk < 4; ++kk) {
      bf16x8 af[2], bfr[2];
#pragma unroll
      for (int i = 0; i < 2; ++i) af[i] = *(const bf16x8*)(Ac + gswz(wm * 64 + i * 32 + r32, 2 * kk + hi));
#pragma unroll
      for (int j = 0; j < 2; ++j) bfr[j] = *(const bf16x8*)(Bc + gswz(wn * 64 + j * 32 + r32, 2 * kk + hi));
#pragma unroll
      for (int i = 0; i < 2; ++i)
#pragma unroll
        for (int j = 0; j < 2; ++j) acc[i][j] = __builtin_amdgcn_mfma_f32_32x32x16_bf16(af[i], bfr[j], acc[i][j], 0, 0, 0);
    }
    if (kt + 1 < nk) {
      unsigned char* An = As + (cur ^ 1) * 32768; unsigned char* Bn = Bs + (cur ^ 1) * 16384;
#pragma unroll
      for (int i = 0; i < 4; ++i) *(u32x4*)(An + gswz(lrow + 64 * i, lc)) = ra[i];
#pragma unroll
      for (int i = 0; i < 2; ++i) *(u32x4*)(Bn + gswz(lrow + 64 * i, lc)) = rb[i];
    }
    __syncthreads();
  }
}
__device__ __forceinline__ void pair_xchg(float v0, float v1, int lane, float& lo, float& hi2) {
  const bool odd = lane & 1;
  const float send = odd ? v0 : v1;
  const float recv = dpp_mov<0xB1>(send);
  lo = odd ? recv : v0; hi2 = odd ? v1 : recv;
}

__device__ __forceinline__ void phase_inproj(const Params& p, int l, unsigned char* lds) {
  int tid_ = tidx(); asm volatile("" : "+v"(tid_)); const int tid = tid_, lane = tid & 63, wid = tid >> 6, wm = wid >> 1, wn = wid & 1, r32 = lane & 31, hi = lane >> 5;
  const bf16_t* H = (const bf16_t*)(p.ws + WS_H);
  const bf16_t* W = (const bf16_t*)(p.ws + WS_WIN) + (size_t)l * PW * DM;
  bf16_t* PROJ = (bf16_t*)(p.ws + WS_PROJ);
  const float* RC = (const float*)(p.ws + WS_ROPE); const float* RS = RC + SEQ * 32;
  constexpr int NM = T / 256, NN = PW / 128, NU = NM * NN;
  for (int u = p.bx; u < NU + NM; u += p.gx) {
    if (u < NU) {
      const int pn = u / NM, pm = u % NM;
      const int row0 = pm * 256, col0 = pn * 128;
      f32x16 acc[2][2];
      gemm_tile(H, DM, W, DM, DM, row0, col0, lds, acc);
      const bool rope = (col0 >= C_DQ && col0 < C_DV);
      const float scl = (col0 >= C_MK && col0 < C_MV) ? 0.125f : ((col0 >= C_DQ && col0 < C_DK) ? QSCALE : 1.f);
#pragma unroll
      for (int i = 0; i < 2; ++i)
#pragma unroll
        for (int j = 0; j < 2; ++j)
#pragma unroll
          for (int q = 0; q < 8; ++q) {
            float lo, hi2; pair_xchg(acc[i][j][2 * q], acc[i][j][2 * q + 1], lane, lo, hi2);
            const int row = row0 + wm * 64 + i * 32 + crow(2 * q, hi) + (lane & 1);
            const int col = col0 + wn * 64 + j * 32 + (r32 & ~1);
            if (rope) {
              const int s = row % SEGL;
              if (s >= CTXL) {
                const int idx = (s - CTXL) * 32 + ((col & 63) >> 1);
                const float c = RC[idx], sn = RS[idx];
                const float t1 = lo, t2 = hi2; lo = t1 * c - t2 * sn; hi2 = t1 * sn + t2 * c;
              }
            }
            *(unsigned*)(PROJ + (size_t)row * PW + col) = cvtpk(lo * scl, hi2 * scl);
          }
    } else {
      const int pm = u - NU, rowb = pm * 256 + wid * 32;
      const bf16_t* WG = (const bf16_t*)(p.ws + WS_WG) + (size_t)l * 16 * DM;
      float* GT = (float*)(p.ws + WS_GATES);
      const int r16 = lane & 15, q4 = lane >> 4;
      f32x4 c0 = {0.f, 0.f, 0.f, 0.f}, c1 = {0.f, 0.f, 0.f, 0.f};
      const bf16_t* a0p = H + (size_t)(rowb + r16) * DM + q4 * 8;
      const bf16_t* a1p = a0p + (size_t)16 * DM;
      const bf16_t* bp = WG + (size_t)r16 * DM + q4 * 8;
#pragma unroll 4
      for (int ks = 0; ks < 32; ++ks) {
        const bf16x8 a0 = *(const bf16x8*)(a0p + ks * 32), a1 = *(const bf16x8*)(a1p + ks * 32), b = *(const bf16x8*)(bp + ks * 32);
        c0 = __builtin_amdgcn_mfma_f32_16x16x32_bf16(a0, b, c0, 0, 0, 0);
        c1 = __builtin_amdgcn_mfma_f32_16x16x32_bf16(a1, b, c1, 0, 0, 0);
      }
      const float gb = p.in[I_GATEB][l * 16 + r16];
#pragma unroll
      for (int j = 0; j < 4; ++j) {
        GT[(size_t)(rowb + q4 * 4 + j) * 16 + r16] = c0[j] + gb;
        GT[(size_t)(rowb + 16 + q4 * 4 + j) * 16 + r16] = c1[j] + gb;
      }
    }
  }
}

__device__ __forceinline__ void phase_outproj(const Params& p, int l, unsigned char* lds) {
  int tid_ = tidx(); asm volatile("" : "+v"(tid_)); const int tid = tid_, lane = tid & 63, wid = tid >> 6, wm = wid >> 1, wn = wid & 1, r32 = lane & 31, hi = lane >> 5;
  const bf16_t* MIX = (const bf16_t*)(p.ws + WS_MIX);
  const bf16_t* W = (const bf16_t*)(p.ws + WS_WOUT) + (size_t)l * DM * DM;
  float* XC = (float*)(p.ws + WS_XCUR);
  const float* MOD = (const float*)(p.ws + WS_MOD);
  constexpr int NM = T / 256, NN = DM / 128, NU = NM * NN;
  for (int u = p.bx; u < NU; u += p.gx) {
    const int pm = u / NN, pn = u % NN;
    if (l == DEPTH - 1 && (pm % 33) == 0) continue;
    const int row0 = pm * 256, col0 = pn * 128;
    for (int rep = 0; rep < REP_OUTP; ++rep) {
    f32x16 acc[2][2];
    gemm_tile(MIX, DM, W, DM, DM, row0, col0, lds, acc);
    const int mr = (pm % 33) == 0 ? 4 : pm / 33;
    const float* g1 = MOD + ((size_t)l * 5 + mr) * 6144 + 2048;
#pragma unroll
    for (int i = 0; i < 2; ++i)
#pragma unroll
      for (int j = 0; j < 2; ++j) {
        const int col = col0 + wn * 64 + j * 32 + r32;
        const float gg = (rep == REP_OUTP - 1) ? g1[col] : 0.f;
#pragma unroll
        for (int r = 0; r < 16; ++r) {
          const int row = row0 + wm * 64 + i * 32 + crow(r, hi);
          const float xo = (l == 0) ? in_row(p.in[I_X], p.in[I_CTX], row)[col] : XC[(size_t)row * DM + col];
          XC[(size_t)row * DM + col] = xo + gg * acc[i][j][r];
        }
      }
    }
  }
}
__device__ __forceinline__ void phase_peerq(const Params& p, int l, unsigned char* lds) {
  int tid_ = tidx(); asm volatile("" : "+v"(tid_)); const int tid = tid_, lane = tid & 63, wid = tid >> 6, wm = wid >> 1, wn = wid & 1, r32 = lane & 31, hi = lane >> 5;
  const bf16_t* H = (const bf16_t*)(p.ws + WS_H);
  const bf16_t* W = (const bf16_t*)(p.ws + WS_WQ) + (size_t)l * DM * DM;
  bf16_t* QP = (bf16_t*)(p.ws + WS_PROJ);
  constexpr int NM = T / 256, NN = DM / 128, NU = NM * NN;
  for (int u = p.bx; u < NU; u += p.gx) {
    const int pm = u / NN, pn = u % NN;
    if (l == DEPTH - 1 && (pm % 33) == 0) continue;
    const int row0 = pm * 256, col0 = pn * 128;
    f32x16 acc[2][2];
    gemm_tile(H, DM, W, DM, DM, row0, col0, lds, acc);
#pragma unroll
    for (int i = 0; i < 2; ++i)
#pragma unroll
      for (int j = 0; j < 2; ++j)
#pragma unroll
        for (int q = 0; q < 8; ++q) {
          float lo, hi2; pair_xchg(acc[i][j][2 * q], acc[i][j][2 * q + 1], lane, lo, hi2);
          const int row = row0 + wm * 64 + i * 32 + crow(2 * q, hi) + (lane & 1);
          const int col = col0 + wn * 64 + j * 32 + (r32 & ~1);
          *(unsigned*)(QP + (size_t)row * DM + col) = cvtpk(lo, hi2);
        }
  }
}


struct EpiInproj {
  static constexpr bool PERM = true, AFTER_DRAIN = false;
  bf16_t* PROJ; const float* RC; const float* RS; unsigned char* V8T;
  __device__ __forceinline__ void operator()(const pg8::f32x4 (&acc)[2][2][4][2], const pg8::Unit& u, int wr, int wc, int fr, int fq) const {
#pragma unroll
    for (int bj = 0; bj < 2; ++bj) {
      const int colt = u.pn * 256 + bj * 128;
      const bool rope = (colt >= C_DQ && colt < C_DV);
      const float scl = (colt >= C_MK && colt < C_MV) ? 0.125f : ((colt >= C_DQ && colt < C_DK) ? QSCALE : 1.f);
      const int col8 = colt + wc * 32 + 8 * fq;
      if (colt >= C_DV) {
        const int hh = (col8 - C_DV) >> 7, e0 = (col8 - C_DV) & 127;
#pragma unroll
        for (int ai = 0; ai < 2; ++ai)
#pragma unroll
          for (int m = 0; m < 4; ++m) {
            const int row = u.pm * 256 + ai * 128 + wr * 64 + m * 16 + fr;
            const int b = row / SEGL, s = row - b * SEGL, t = s >> 6, kk = s & 63;
            const int slot = ((kk >> 2) & 1) * 32 + (kk & 3) + 4 * ((kk >> 3) & 3) + 16 * (kk >> 5);
            unsigned char* vp = V8T + ((size_t)((b * 4 + hh) * NCH + t) * 128 + e0) * 80 + slot;
            const f32x4 v0 = acc[ai][bj][m][0], v1 = acc[ai][bj][m][1];
            int w0 = 0, w1 = 0;
            w0 = __builtin_amdgcn_cvt_pk_fp8_f32(v0[0], v0[1], w0, false); w0 = __builtin_amdgcn_cvt_pk_fp8_f32(v0[2], v0[3], w0, true);
            w1 = __builtin_amdgcn_cvt_pk_fp8_f32(v1[0], v1[1], w1, false); w1 = __builtin_amdgcn_cvt_pk_fp8_f32(v1[2], v1[3], w1, true);
            vp[0] = (unsigned char)(w0 & 0xFF); vp[80] = (unsigned char)((w0 >> 8) & 0xFF); vp[160] = (unsigned char)((w0 >> 16) & 0xFF); vp[240] = (unsigned char)((w0 >> 24) & 0xFF);
            vp[320] = (unsigned char)(w1 & 0xFF); vp[400] = (unsigned char)((w1 >> 8) & 0xFF); vp[480] = (unsigned char)((w1 >> 16) & 0xFF); vp[560] = (unsigned char)((w1 >> 24) & 0xFF);
          }
        continue;
      }
      unsigned char* qk8 = nullptr;
      if (rope) { const int isk = colt >= C_DK, cc = col8 - (isk ? C_DK : C_DQ); qk8 = V8T + (WS_QK8 - WS_V8T) + (size_t)isk * QK8_IMG + (size_t)(cc >> 7) * SEGL * QK8_PITCH + (cc & 127); }
#pragma unroll
      for (int ai = 0; ai < 2; ++ai)
#pragma unroll
        for (int m = 0; m < 4; ++m) {
          const int row = u.pm * 256 + ai * 128 + wr * 64 + m * 16 + fr;
          f32x4 v0 = acc[ai][bj][m][0], v1 = acc[ai][bj][m][1];
          if (rope) {
            const int s = row % SEGL;
            if (s >= CTXL) {
              const int idx = (s - CTXL) * 32 + ((col8 & 63) >> 1);
              const f32x4 c = *(const f32x4*)(RC + idx), sn = *(const f32x4*)(RS + idx);
              f32x4 a, b;
              a[0] = v0[0] * c[0] - v0[1] * sn[0]; a[1] = v0[0] * sn[0] + v0[1] * c[0]; a[2] = v0[2] * c[1] - v0[3] * sn[1]; a[3] = v0[2] * sn[1] + v0[3] * c[1];
              b[0] = v1[0] * c[2] - v1[1] * sn[2]; b[1] = v1[0] * sn[2] + v1[1] * c[2]; b[2] = v1[2] * c[3] - v1[3] * sn[3]; b[3] = v1[2] * sn[3] + v1[3] * c[3];
              v0 = a; v1 = b;
            }
          }
          if (rope) {
            const int b = row / SEGL, s = row - b * SEGL;
            int w0, w1; asm volatile("" : "=v"(w0), "=v"(w1));
            w0 = __builtin_amdgcn_cvt_pk_fp8_f32(v0[0] * scl, v0[1] * scl, w0, false); w0 = __builtin_amdgcn_cvt_pk_fp8_f32(v0[2] * scl, v0[3] * scl, w0, true);
            w1 = __builtin_amdgcn_cvt_pk_fp8_f32(v1[0] * scl, v1[1] * scl, w1, false); w1 = __builtin_amdgcn_cvt_pk_fp8_f32(v1[2] * scl, v1[3] * scl, w1, true);
            *(u32x2*)(qk8 + ((size_t)b * 4 * SEGL + s) * QK8_PITCH) = (u32x2){(unsigned)w0, (unsigned)w1};
            continue;
          }
          u32x4 w; w.x = cvtpk(v0[0] * scl, v0[1] * scl); w.y = cvtpk(v0[2] * scl, v0[3] * scl); w.z = cvtpk(v1[0] * scl, v1[1] * scl); w.w = cvtpk(v1[2] * scl, v1[3] * scl);
          *(u32x4*)(PROJ + (size_t)row * PW + col8) = w;
        }
    }
  }
};
struct EpiOutproj {
  static constexpr bool PERM = true, AFTER_DRAIN = false;
  float* XC; const float* MODL; const float* xin; const float* ctxin; int first; float gsc;
  __device__ __forceinline__ void operator()(const pg8::f32x4 (&acc)[2][2][4][2], const pg8::Unit& u, int wr, int wc, int fr, int fq) const {
    const int mr = (u.pm % 33) == 0 ? 4 : u.pm / 33;
    const float* g1 = MODL + (size_t)mr * 6144 + 2048;
#pragma unroll
    for (int bj = 0; bj < 2; ++bj) {
      const int col8 = u.pn * 256 + bj * 128 + wc * 32 + 8 * fq;
      const f32x4 ga = *(const f32x4*)(g1 + col8) * gsc, gb = *(const f32x4*)(g1 + col8 + 4) * gsc;
#pragma unroll
      for (int ai = 0; ai < 2; ++ai)
#pragma unroll
        for (int m = 0; m < 4; ++m) {
          const int row = u.pm * 256 + ai * 128 + wr * 64 + m * 16 + fr;
          const float* xo = first ? in_row(xin, ctxin, row) + col8 : XC + (size_t)row * DM + col8;
          const f32x4 xa = *(const f32x4*)xo, xb = *(const f32x4*)(xo + 4);
          *(f32x4*)(XC + (size_t)row * DM + col8) = xa + ga * acc[ai][bj][m][0];
          *(f32x4*)(XC + (size_t)row * DM + col8 + 4) = xb + gb * acc[ai][bj][m][1];
        }
    }
  }
};
struct EpiPeerq {
  static constexpr bool PERM = true, AFTER_DRAIN = false;
  bf16_t* QP;
  __device__ __forceinline__ void operator()(const pg8::f32x4 (&acc)[2][2][4][2], const pg8::Unit& u, int wr, int wc, int fr, int fq) const {
#pragma unroll
    for (int bj = 0; bj < 2; ++bj) {
      const int col8 = u.pn * 256 + bj * 128 + wc * 32 + 8 * fq;
#pragma unroll
      for (int ai = 0; ai < 2; ++ai)
#pragma unroll
        for (int m = 0; m < 4; ++m) {
          const int row = u.pm * 256 + ai * 128 + wr * 64 + m * 16 + fr;
          const f32x4 v0 = acc[ai][bj][m][0], v1 = acc[ai][bj][m][1];
          u32x4 w; w.x = cvtpk(v0[0], v0[1]); w.y = cvtpk(v0[2], v0[3]); w.z = cvtpk(v1[0], v1[1]); w.w = cvtpk(v1[2], v1[3]);
          *(u32x4*)(QP + (size_t)row * DM + col8) = w;
        }
    }
  }
};
__device__ __forceinline__ void phase_inproj2(const Params& p, int l, unsigned char* lds) {
  {
    pg8::Gemm g{(const bf16_t*)(p.ws + WS_H), (const bf16_t*)(p.ws + WS_WIN) + (size_t)l * PW * DM, T, PW, DM};
    pg8::StaticOrder S; S.init(T, PW, p.gx, p.bx);
    EpiInproj E{(bf16_t*)(p.ws + WS_PROJ), (const float*)(p.ws + WS_ROPE), (const float*)(p.ws + WS_ROPE) + SEQ * 32, p.ws + WS_V8T};
    pg8::gemm_phase<EpiInproj, pg8::StaticOrder, true, true>((PG8_LAS unsigned char*)lds, g, S, E);
  }
  int tid_ = tidx(); asm volatile("" : "+v"(tid_)); const int tid = tid_, lane = tid & 63, wid = tid >> 6;
  const bf16_t* H = (const bf16_t*)(p.ws + WS_H);
  for (int pm = p.gx - 1 - p.bx; pm < T / 256; pm += p.gx) {
    const int rowb = pm * 256 + wid * 32;
    const bf16_t* WG = (const bf16_t*)(p.ws + WS_WG) + (size_t)l * 16 * DM;
    float* GT = (float*)(p.ws + WS_GATES);
    const int r16 = lane & 15, q4 = lane >> 4;
    f32x4 c0 = {0.f, 0.f, 0.f, 0.f}, c1 = {0.f, 0.f, 0.f, 0.f};
    const bf16_t* a0p = H + (size_t)(rowb + r16) * DM + q4 * 8;
    const bf16_t* a1p = a0p + (size_t)16 * DM;
    const bf16_t* bp = WG + (size_t)r16 * DM + q4 * 8;
#pragma unroll 4
    for (int ks = 0; ks < 32; ++ks) {
      const bf16x8 a0 = *(const bf16x8*)(a0p + ks * 32), a1 = *(const bf16x8*)(a1p + ks * 32), b = *(const bf16x8*)(bp + ks * 32);
      c0 = __builtin_amdgcn_mfma_f32_16x16x32_bf16(a0, b, c0, 0, 0, 0);
      c1 = __builtin_amdgcn_mfma_f32_16x16x32_bf16(a1, b, c1, 0, 0, 0);
    }
    const float gb = p.in[I_GATEB][l * 16 + r16];
#pragma unroll
    for (int j = 0; j < 4; ++j) {
      GT[(size_t)(rowb + q4 * 4 + j) * 16 + r16] = c0[j] + gb;
      GT[(size_t)(rowb + 16 + q4 * 4 + j) * 16 + r16] = c1[j] + gb;
    }
  }
}
__device__ __forceinline__ void phase_outproj2(const Params& p, int l, unsigned char* lds) {
  pg8::Gemm g{(const bf16_t*)(p.ws + WS_MIX), (const bf16_t*)(p.ws + WS_WOUT) + (size_t)l * DM * DM, T, DM, DM};
  pg8::StaticOrder S; S.init(T, DM, p.gx, p.bx);
  for (int rep = 0; rep < REP_OUTP; ++rep) {
  EpiOutproj E{(float*)(p.ws + WS_XCUR), (const float*)(p.ws + WS_MOD) + (size_t)l * 5 * 6144, p.in[I_X], p.in[I_CTX], l == 0, (rep == REP_OUTP - 1) ? 1.f : 0.f};
  pg8::gemm_phase<EpiOutproj, pg8::StaticOrder, true, true>((PG8_LAS unsigned char*)lds, g, S, E);
  }
  tail_filler_tables(p, l, (T / 256) * (DM / 256), l == 0 ? 0 : NEXP, 2 * NEXP);
}
__device__ __forceinline__ void phase_peerq2(const Params& p, int l, unsigned char* lds) {
  pg8::Gemm g{(const bf16_t*)(p.ws + WS_H), (const bf16_t*)(p.ws + WS_WQ) + (size_t)l * DM * DM, T, DM, DM};
  pg8::StaticOrder S; S.init(T, DM, p.gx, p.bx);
  EpiPeerq E{(bf16_t*)(p.ws + WS_PROJ)};
  pg8::gemm_phase<EpiPeerq, pg8::StaticOrder, true, true>((PG8_LAS unsigned char*)lds, g, S, E);
  if (l < DEPTH - 1) tail_filler_tables(p, l + 1, (T / 256) * (DM / 256), 0, NEXP);
}

__device__ __forceinline__ void conv_unit(const Params& p, int l, int unit, unsigned char* lds) {
  int tid_ = tidx(); asm volatile("" : "+v"(tid_)); const int tid = tid_, lane = tid & 63, wid = tid >> 6;
  float* U = (float*)lds;
  const bf16_t* PROJ = (const bf16_t*)(p.ws + WS_PROJ);
  bf16_t* MIX = (bf16_t*)(p.ws + WS_MIX);
  const int row0 = unit * 32, b = row0 / SEGL, s0 = row0 - b * SEGL;
  const int seglo = s0 < CTXL ? 0 : CTXL, seghi = s0 < CTXL ? CTXL : SEGL;
  for (int rr = tid >> 5; rr < 62; rr += 16) {
    const int s = s0 - 15 + rr, c8 = (tid & 31) * 8;
    f32x4 u0 = {0.f, 0.f, 0.f, 0.f}, u1 = {0.f, 0.f, 0.f, 0.f};
    if (s >= seglo && s < seghi) {
      const bf16_t* pr = PROJ + (size_t)(b * SEGL + s) * PW + c8;
      const u32x4 a1 = *(const u32x4*)pr, a2 = *(const u32x4*)(pr + 256);
      u0.x = bflo(a1.x) * sigmoidf_(bflo(a2.x)); u0.y = bfhi(a1.x) * sigmoidf_(bfhi(a2.x));
      u0.z = bflo(a1.y) * sigmoidf_(bflo(a2.y)); u0.w = bfhi(a1.y) * sigmoidf_(bfhi(a2.y));
      u1.x = bflo(a1.z) * sigmoidf_(bflo(a2.z)); u1.y = bfhi(a1.z) * sigmoidf_(bfhi(a2.z));
      u1.z = bflo(a1.w) * sigmoidf_(bflo(a2.w)); u1.w = bfhi(a1.w) * sigmoidf_(bfhi(a2.w));
    }
    *(f32x4*)(U + rr * 256 + c8) = u0; *(f32x4*)(U + rr * 256 + c8 + 4) = u1;
  }
  __syncthreads();
  float* Y = U + 62 * 256;
  const float* cw = p.in[I_CONVW] + (size_t)l * 31 * 256;
#pragma unroll 1
  for (int q = 0; q < 4; ++q) {
    const int c = lane + 64 * q;
    float w[31];
#pragma unroll
    for (int j = 0; j < 31; ++j) w[j] = cw[j * 256 + c];
    const float bias = p.in[I_CONVB][l * 256 + c];
#pragma unroll
    for (int tt = 0; tt < 4; ++tt) {
      const int t = wid * 4 + tt;
      float a = bias;
#pragma unroll
      for (int j = 0; j < 31; ++j) a += U[(t + j) * 256 + c] * w[j];
      Y[t * 256 + c] = a;
    }
  }
  asm volatile("s_waitcnt lgkmcnt(0)" ::: "memory");
  float y[4][4];
#pragma unroll
  for (int tt = 0; tt < 4; ++tt)
#pragma unroll
    for (int q = 0; q < 4; ++q) y[tt][q] = Y[(wid * 4 + tt) * 256 + lane + 64 * q];
#pragma unroll
  for (int tt = 0; tt < 4; ++tt) {
    const int t = wid * 4 + tt;
    const float mean = wave_sum((y[tt][0] + y[tt][1]) + (y[tt][2] + y[tt][3])) * (1.f / 256.f);
    float v = 0.f;
#pragma unroll
    for (int q = 0; q < 4; ++q) { const float d = y[tt][q] - mean; v += d * d; }
    const float rs = rsqrtf(wave_sum(v) * (1.f / 256.f) + EPS);
#pragma unroll
    for (int q = 0; q < 4; ++q) {
      const int c = lane + 64 * q;
      const float z = (y[tt][q] - mean) * rs * p.in[I_CLNG][l * 256 + c] + p.in[I_CLNB][l * 256 + c];
      const float o = (ABL & 1) ? 0.f : z * sigmoidf_(z);
      MIX[(size_t)(row0 + t) * DM + c] = (bf16_t)(cvtpk(o, 0.f) & 0xffffu);
    }
  }
  __syncthreads();
}

__device__ __forceinline__ int ml_cidx(int ch, int dir) { return dir == 0 ? ch : (ch < 4 ? 3 - ch : 135 - ch); }
__device__ __forceinline__ void ml_load_tile(const bf16_t* src, float* dst, int tid) {
  const int r = tid >> 3, c8 = (tid & 7) * 8;
  const u32x4 a = *(const u32x4*)(src + (size_t)r * PW + c8);
  float* d = dst + r * 65 + c8;
  d[0] = bflo(a.x); d[1] = bfhi(a.x); d[2] = bflo(a.y); d[3] = bfhi(a.y); d[4] = bflo(a.z); d[5] = bfhi(a.z); d[6] = bflo(a.w); d[7] = bfhi(a.w);
}
__device__ __forceinline__ void ml_local_unit(const Params& p, int l, int unit, unsigned char* lds) {
  int tid_ = tidx(); asm volatile("" : "+v"(tid_)); const int tid = tid_, lane = tid & 63, wid = tid >> 6, r32 = lane & 31, hi = lane >> 5;
  float* Kt = (float*)lds; float* Vt = Kt + 64 * 65; float* WK = Vt + 64 * 65;
  const bf16_t* PROJ = (const bf16_t*)(p.ws + WS_PROJ);
  const float* GT = (const float*)(p.ws + WS_GATES);
  float* UL = (float*)(p.ws + WS_ULOC); float* META = (float*)(p.ws + WS_MLMETA);
  const int b = unit / (4 * NCH), hh = (unit / NCH) & 3, ch = unit % NCH;
  const int row0 = b * SEGL + ch * 64;
  ml_load_tile(PROJ + (size_t)row0 * PW + C_MK + hh * 64, Kt, tid);
  ml_load_tile(PROJ + (size_t)row0 * PW + C_MV + hh * 64, Vt, tid);
  if (wid < 2) {
    const int dir = wid;
    const float ig = GT[(size_t)(row0 + lane) * 16 + (2 * dir) * 4 + hh];
    const float lf = logsigmoidf_(GT[(size_t)(row0 + lane) * 16 + (2 * dir + 1) * 4 + hh]);
    float ps = lf;
    ps = wave_incl_scan(ps);
    const float tot = __uint_as_float((unsigned)__builtin_amdgcn_readlane((int)__float_as_uint(ps), 63));
    const float wlog = dir == 0 ? (tot - ps + ig) : (ps - lf + ig);
    const float mloc = wave_max(wlog);
    WK[dir * 64 + lane] = __expf(wlog - mloc);
    if (lane == 0) {
      const int seq = (b * 4 + hh) * 2 + dir, ci = ml_cidx(ch, dir);
      META[((size_t)seq * NCH + ci) * 4 + 0] = tot; META[((size_t)seq * NCH + ci) * 4 + 1] = mloc;
    }
  }
  __syncthreads();
  {
    const int dir = wid >> 2, et = (wid >> 1) & 1, dt = wid & 1;
    const int seq = (b * 4 + hh) * 2 + dir, ci = ml_cidx(ch, dir);
    float* slot = UL + ((size_t)seq * NCH + ci) * USTRIDE;
    f32x16 acc = {};
#pragma unroll 8
    for (int ks = 0; ks < 32; ++ks) {
      const int s = 2 * ks + hi;
      const float a = WK[dir * 64 + s] * Vt[s * 65 + et * 32 + r32];
      const float bb = Kt[s * 65 + dt * 32 + r32];
      acc = __builtin_amdgcn_mfma_f32_32x32x2f32(a, bb, acc, 0, 0, 0);
    }
#pragma unroll
    for (int r = 0; r < 16; ++r) slot[(et * 32 + crow(r, hi)) * 64 + dt * 32 + r32] = acc[r];
    if (et == 0) {
      float n = 0.f;
#pragma unroll 8
      for (int i = 0; i < 32; ++i) { const int s = hi * 32 + i; n += WK[dir * 64 + s] * Kt[s * 65 + dt * 32 + r32]; }
      n = sum_xor32(n);
      if (hi == 0) slot[4096 + dt * 32 + r32] = n;
    }
  }
  __syncthreads();
}
constexpr int MLP = 144;
constexpr size_t WS_CST = WS_H;
constexpr size_t WS_NST = WS_H + (size_t)32 * NCH * 4096 * 2;
__device__ __forceinline__ void ml_stage_rm(const bf16_t* src, size_t ld, unsigned char* dst, int tid) {
  const int r = tid >> 3, c8 = (tid & 7) * 8;
  *(u32x4*)(dst + r * MLP + c8 * 2) = *(const u32x4*)(src + (size_t)r * ld + c8);
}
__device__ __forceinline__ void ml_stage_tr(const bf16_t* src, size_t ld, unsigned char* dst, int tid) {
  const int r = tid >> 3, c8 = (tid & 7) * 8;
  const u32x4 a = *(const u32x4*)(src + (size_t)r * ld + c8);
  bf16_t* d = (bf16_t*)dst;
  d[(c8 + 0) * 72 + r] = (bf16_t)(a.x & 0xffffu); d[(c8 + 1) * 72 + r] = (bf16_t)(a.x >> 16);
  d[(c8 + 2) * 72 + r] = (bf16_t)(a.y & 0xffffu); d[(c8 + 3) * 72 + r] = (bf16_t)(a.y >> 16);
  d[(c8 + 4) * 72 + r] = (bf16_t)(a.z & 0xffffu); d[(c8 + 5) * 72 + r] = (bf16_t)(a.z >> 16);
  d[(c8 + 6) * 72 + r] = (bf16_t)(a.w & 0xffffu); d[(c8 + 7) * 72 + r] = (bf16_t)(a.w >> 16);
}
__device__ __forceinline__ void ml_local_unit2(const Params& p, int l, int unit, unsigned char* lds) {
  int tid_ = tidx(); asm volatile("" : "+v"(tid_)); const int tid = tid_, lane = tid & 63, wid = tid >> 6, r32 = lane & 31, hi = lane >> 5;
  unsigned char* KT = lds; unsigned char* VT = lds + 64 * MLP; float* WK = (float*)(lds + 2 * 64 * MLP);
  const bf16_t* PROJ = (const bf16_t*)(p.ws + WS_PROJ);
  const float* GT = (const float*)(p.ws + WS_GATES);
  float* UL = (float*)(p.ws + WS_ULOC); float* META = (float*)(p.ws + WS_MLMETA);
  const int b = unit / (4 * NCH), hh = (unit / NCH) & 3, ch = unit % NCH;
  const int row0 = b * SEGL + ch * 64;
  ml_stage_tr(PROJ + (size_t)row0 * PW + C_MK + hh * 64, PW, KT, tid);
  ml_stage_tr(PROJ + (size_t)row0 * PW + C_MV + hh * 64, PW, VT, tid);
  if (wid < 2) {
    const int dir = wid;
    const float ig = GT[(size_t)(row0 + lane) * 16 + (2 * dir) * 4 + hh];
    const float lf = logsigmoidf_(GT[(size_t)(row0 + lane) * 16 + (2 * dir + 1) * 4 + hh]);
    float ps = lf;
    ps = wave_incl_scan(ps);
    const float tot = __uint_as_float((unsigned)__builtin_amdgcn_readlane((int)__float_as_uint(ps), 63));
    const float wlog = dir == 0 ? (tot - ps + ig) : (ps - lf + ig);
    const float mloc = wave_max(wlog);
    WK[dir * 64 + lane] = __expf(wlog - mloc);
    if (lane == 0) {
      const int seq = (b * 4 + hh) * 2 + dir, ci = ml_cidx(ch, dir);
      META[((size_t)seq * NCH + ci) * 4 + 0] = tot; META[((size_t)seq * NCH + ci) * 4 + 1] = mloc;
    }
  }
  __syncthreads();
  {
    const int dir = wid >> 2, et = (wid >> 1) & 1, dt = wid & 1;
    const int seq = (b * 4 + hh) * 2 + dir, ci = ml_cidx(ch, dir);
    float* slot = UL + ((size_t)seq * NCH + ci) * USTRIDE;
    f32x16 acc = {};
#pragma unroll
    for (int ks = 0; ks < 4; ++ks) {
      const int s0 = ks * 16 + hi * 8;
      const u32x4 va = *(const u32x4*)(VT + (et * 32 + r32) * MLP + s0 * 2);
      const bf16x8 kb = *(const bf16x8*)(KT + (dt * 32 + r32) * MLP + s0 * 2);
      const f32x4 w0 = *(const f32x4*)(WK + dir * 64 + s0), w1 = *(const f32x4*)(WK + dir * 64 + s0 + 4);
      u32x4 sa; sa.x = cvtpk(bflo(va.x) * w0.x, bfhi(va.x) * w0.y); sa.y = cvtpk(bflo(va.y) * w0.z, bfhi(va.y) * w0.w);
      sa.z = cvtpk(bflo(va.z) * w1.x, bfhi(va.z) * w1.y); sa.w = cvtpk(bflo(va.w) * w1.z, bfhi(va.w) * w1.w);
      acc = __builtin_amdgcn_mfma_f32_32x32x16_bf16(*(const bf16x8*)&sa, kb, acc, 0, 0, 0);
    }
#pragma unroll
    for (int r = 0; r < 16; ++r) slot[(et * 32 + crow(r, hi)) * 64 + dt * 32 + r32] = acc[r];
    if (et == 0) {
      float n = 0.f;
#pragma unroll
      for (int i = 0; i < 4; ++i) {
        const int s0 = hi * 32 + i * 8;
        const u32x4 ka = *(const u32x4*)(KT + (dt * 32 + r32) * MLP + s0 * 2);
        const f32x4 w0 = *(const f32x4*)(WK + dir * 64 + s0), w1 = *(const f32x4*)(WK + dir * 64 + s0 + 4);
        n += bflo(ka.x) * w0.x + bfhi(ka.x) * w0.y + bflo(ka.y) * w0.z + bfhi(ka.y) * w0.w + bflo(ka.z) * w1.x + bfhi(ka.z) * w1.y + bflo(ka.w) * w1.z + bfhi(ka.w) * w1.w;
      }
      n = sum_xor32(n);
      if (hi == 0) slot[4096 + dt * 32 + r32] = n;
    }
  }
  __syncthreads();
}
__device__ __forceinline__ void ml_scan(const Params& p, unsigned char* lds) {
  float* UL = (float*)(p.ws + WS_ULOC); float* META = (float*)(p.ws + WS_MLMETA);
  int tid_ = tidx(); asm volatile("" : "+v"(tid_));
  const int tid = tid_, lane = tid & 63, wid = tid >> 6;
  float* DEC = (float*)lds;
  float* SCL = DEC + 2 * NCH;
  float* TMP = SCL + 2 * NCH;
  constexpr int NSL = (32 * USTRIDE + 511) / 512;
  const int first_ = p.gx > 64 ? 16 : 0, nb_ = p.gx - first_;
  for (int k_ = 0; k_ < 2 + (NSL + nb_ - 1) / nb_; ++k_) {
    int s_;
    if (k_ == 0) s_ = p.bx >= first_ ? p.bx - first_ : -1;
    else s_ = k_ * nb_ + (p.gx - 1 - p.bx);
    if (k_ > 0 && p.gx - 1 - p.bx >= nb_) s_ = -1;
    if (s_ < 0 || s_ >= NSL) continue;
    const int base0 = s_ * 512;
    const int seq0 = base0 / USTRIDE;
    if (wid < 2) {
      const int seq = seq0 + wid;
      if (seq < 32) {
        float* mt = META + (size_t)seq * NCH * 4;
        for (int c = lane; c < NCH; c += 64) { TMP[(wid * 2 + 0) * NCH + c] = mt[c * 4 + 0]; TMP[(wid * 2 + 1) * NCH + c] = mt[c * 4 + 1]; }
        asm volatile("s_waitcnt lgkmcnt(0)" ::: "memory");
        if (lane == 0) {
          float m = 0.f;
          for (int c = 0; c < NCH; ++c) {
            const float bl = TMP[(wid * 2 + 0) * NCH + c], mloc = TMP[(wid * 2 + 1) * NCH + c];
            const float mn = fmaxf(bl + m, mloc);
            DEC[wid * NCH + c] = __expf(bl + m - mn); SCL[wid * NCH + c] = __expf(mloc - mn);
            mt[c * 4 + 2] = m;
            m = mn;
          }
        }
      }
    }
    __syncthreads();
    const int idx = base0 + tid;
    if (idx < 32 * USTRIDE) {
      const int seq = idx / USTRIDE, e = idx - seq * USTRIDE, sl = seq - seq0;
      float* bp = UL + (size_t)seq * NCH * USTRIDE + e;
      bf16_t* CSTp = (bf16_t*)(p.ws + WS_CST) + (size_t)seq * NCH * 4096 + (e < 4096 ? e : 0);
      float* NSTp = (float*)(p.ws + WS_NST) + (size_t)seq * NCH * 64 + (e < 4096 ? 0 : e - 4096);
      const float* dec = DEC + sl * NCH; const float* scl = SCL + sl * NCH;
      float C = 0.f;
      constexpr int BT = 33;
      static_assert(NCH == 4 * BT, "scan batches");
      float ua[BT], ub[BT];
#define SCAN_LD(u_, c0_) _Pragma("unroll") for (int j = 0; j < BT; ++j) u_[j] = bp[(size_t)((c0_) + j) * USTRIDE];
#define SCAN_DO(u_, c0_) _Pragma("unroll") for (int j = 0; j < BT; ++j) { \
          if (e < 4096) CSTp[(size_t)((c0_) + j) * 4096] = (bf16_t)(cvtpk(C, 0.f) & 0xffffu); else NSTp[(size_t)((c0_) + j) * 64] = C; \
          C = dec[(c0_) + j] * C + scl[(c0_) + j] * u_[j]; }
      SCAN_LD(ua, 0)
#pragma unroll 1
      for (int c0 = 0; c0 < NCH; c0 += 2 * BT) {
        SCAN_LD(ub, c0 + BT)
        SCAN_DO(ua, c0)
        if (c0 + 2 * BT < NCH) { SCAN_LD(ua, c0 + 2 * BT) }
        SCAN_DO(ub, c0 + BT)
      }
#undef SCAN_LD
#undef SCAN_DO
    }
    __syncthreads();
  }
}
__device__ __forceinline__ void ml_out_unit(const Params& p, int l, int unit, unsigned char* lds) {
  int tid_ = tidx(); asm volatile("" : "+v"(tid_)); const int tid = tid_, lane = tid & 63, wid = tid >> 6, r32 = lane & 31, hi = lane >> 5;
  float* Qt = (float*)lds; float* Kt = Qt + 64 * 65; float* Vt = Kt + 64 * 65;
  float* Cs = Vt + 64 * 65;
  float* Ns = Cs + 2 * 64 * 65;
  float* Bq = Ns + 128;
  float* Gs = Bq + 128;
  float* Mi = Gs + 128;
  float* HB = Mi + 64;
  const bf16_t* PROJ = (const bf16_t*)(p.ws + WS_PROJ);
  const float* GT = (const float*)(p.ws + WS_GATES);
  const float* UL = (const float*)(p.ws + WS_ULOC); const float* META = (const float*)(p.ws + WS_MLMETA);
  bf16_t* MIX = (bf16_t*)(p.ws + WS_MIX);
  const int b = unit / (4 * NCH), hh = (unit / NCH) & 3, ch = unit % NCH;
  const int row0 = b * SEGL + ch * 64;
  ml_load_tile(PROJ + (size_t)row0 * PW + C_MQ + hh * 64, Qt, tid);
  ml_load_tile(PROJ + (size_t)row0 * PW + C_MK + hh * 64, Kt, tid);
  ml_load_tile(PROJ + (size_t)row0 * PW + C_MV + hh * 64, Vt, tid);
  for (int i = tid; i < 2 * USTRIDE; i += 512) {
    const int dir = i / USTRIDE, e = i - dir * USTRIDE;
    const int seq = (b * 4 + hh) * 2 + dir, ci = ml_cidx(ch, dir);
    const float v = UL[((size_t)seq * NCH + ci) * USTRIDE + e];
    if (e < 4096) Cs[dir * 64 * 65 + (e >> 6) * 65 + (e & 63)] = v; else Ns[dir * 64 + (e - 4096)] = v;
  }
  if (wid < 2) {
    const int dir = wid;
    const float ig = GT[(size_t)(row0 + lane) * 16 + (2 * dir) * 4 + hh];
    const float lf = logsigmoidf_(GT[(size_t)(row0 + lane) * 16 + (2 * dir + 1) * 4 + hh]);
    float ps = lf;
    ps = wave_incl_scan(ps);
    const float tot = __uint_as_float((unsigned)__builtin_amdgcn_readlane((int)__float_as_uint(ps), 63));
    const float bc = dir == 0 ? ps : (tot - ps + lf);
    Bq[dir * 64 + lane] = bc; Gs[dir * 64 + lane] = ig - bc;
    if (lane == 0) { const int seq = (b * 4 + hh) * 2 + dir, ci = ml_cidx(ch, dir); Mi[dir] = META[((size_t)seq * NCH + ci) * 4 + 2]; }
  }
  __syncthreads();
  {
    const int dir = wid >> 2, tt = (wid >> 1) & 1, et = wid & 1;
    const int t = tt * 32 + r32;
    f32x16 sa[2] = {};
#pragma unroll 4
    for (int ks = 0; ks < 32; ++ks) {
      const float bq = Qt[t * 65 + 2 * ks + hi];
      const float a0 = Kt[(r32) * 65 + 2 * ks + hi], a1 = Kt[(32 + r32) * 65 + 2 * ks + hi];
      sa[0] = __builtin_amdgcn_mfma_f32_32x32x2f32(a0, bq, sa[0], 0, 0, 0);
      sa[1] = __builtin_amdgcn_mfma_f32_32x32x2f32(a1, bq, sa[1], 0, 0, 0);
    }
    const float bt = Bq[dir * 64 + t];
    const float inter = bt + Mi[dir];
    float mx = -INFINITY;
    f32x16 dl[2];
#pragma unroll
    for (int st = 0; st < 2; ++st)
#pragma unroll
      for (int r = 0; r < 16; ++r) {
        const int s = st * 32 + crow(r, hi);
        const bool ok = dir == 0 ? (s <= t) : (s >= t);
        const float d = ok ? bt + Gs[dir * 64 + s] : -INFINITY;
        dl[st][r] = d; mx = fmaxf(mx, d);
      }
    mx = max_xor32(mx);
    const float mt = fmaxf(inter, mx);
    const float iw = __expf(inter - mt);
    float rsum = 0.f;
#pragma unroll
    for (int st = 0; st < 2; ++st)
#pragma unroll
      for (int r = 0; r < 16; ++r) { const float w = __expf(dl[st][r] - mt); sa[st][r] *= w; rsum += sa[st][r]; }
    rsum = sum_xor32(rsum);
    float qn = 0.f;
#pragma unroll 8
    for (int i = 0; i < 32; ++i) { const int d = hi * 32 + i; qn += Ns[dir * 64 + d] * Qt[t * 65 + d]; }
    qn = sum_xor32(qn);
    const float den = rsum + iw * qn;
    const float rden = 1.f / fmaxf(fabsf(den), __expf(-mt));
    f32x16 an = {}, ac = {};
#pragma unroll
    for (int st = 0; st < 2; ++st)
#pragma unroll
      for (int r = 0; r < 16; ++r) {
        const float a = Vt[(st * 32 + crow(r, hi)) * 65 + et * 32 + r32];
        an = __builtin_amdgcn_mfma_f32_32x32x2f32(a, sa[st][r], an, 0, 0, 0);
      }
    const float* Cd = Cs + dir * 64 * 65;
#pragma unroll 4
    for (int ks = 0; ks < 32; ++ks) {
      const float a = Cd[(et * 32 + r32) * 65 + 2 * ks + hi];
      const float bq = Qt[t * 65 + 2 * ks + hi];
      ac = __builtin_amdgcn_mfma_f32_32x32x2f32(a, bq, ac, 0, 0, 0);
    }
#pragma unroll
    for (int r = 0; r < 16; ++r) HB[dir * 64 * 65 + t * 65 + et * 32 + crow(r, hi)] = (an[r] + iw * ac[r]) * rden;
  }
  __syncthreads();
  {
    const int t = tid >> 3, e8 = (tid & 7) * 8;
    float v[8]; float ss = 0.f;
#pragma unroll
    for (int i = 0; i < 8; ++i) { v[i] = HB[t * 65 + e8 + i] + HB[64 * 65 + t * 65 + e8 + i]; ss += v[i] * v[i]; }
    ss += dpp_mov<0xB1>(ss); ss += dpp_mov<0x4E>(ss); ss += dpp_mov<0x141>(ss);
    const float rs = rsqrtf(ss * (1.f / 64.f) + EPS);
    const u32x4 ov = *(const u32x4*)(PROJ + (size_t)(row0 + t) * PW + C_MO + hh * 64 + e8);
    const float og[8] = {bflo(ov.x), bfhi(ov.x), bflo(ov.y), bfhi(ov.y), bflo(ov.z), bfhi(ov.z), bflo(ov.w), bfhi(ov.w)};
    const float* g = p.in[I_MNORMG] + l * 64 + e8;
    float o[8];
#pragma unroll
    for (int i = 0; i < 8; ++i) o[i] = (ABL & 2) ? 0.f : v[i] * rs * g[i] * sigmoidf_(og[i]);
    u32x4 w; w.x = cvtpk(o[0], o[1]); w.y = cvtpk(o[2], o[3]); w.z = cvtpk(o[4], o[5]); w.w = cvtpk(o[6], o[7]);
    *(u32x4*)(MIX + (size_t)(row0 + t) * DM + 256 + hh * 64 + e8) = w;
  }
  __syncthreads();
}


struct MlOutPf { u32x4 q, k, v, c0, c1, ov; float ns0, ns1, g_ig, g_lf, mi; };
__device__ __forceinline__ void ml_out_fetch(const Params& p, int unit, int tid, MlOutPf& f) {
  const int lane = tid & 63, wid = tid >> 6;
  const bf16_t* PROJ = (const bf16_t*)(p.ws + WS_PROJ);
  const float* GT = (const float*)(p.ws + WS_GATES);
  const bf16_t* CST = (const bf16_t*)(p.ws + WS_CST); const float* NST = (const float*)(p.ws + WS_NST); const float* META = (const float*)(p.ws + WS_MLMETA);
  const int b = unit / (4 * NCH), hh = (unit / NCH) & 3, ch = unit % NCH;
  const int row0 = b * SEGL + ch * 64;
  const int r = tid >> 3, c8 = (tid & 7) * 8;
  const bf16_t* prow = PROJ + (size_t)(row0 + r) * PW + hh * 64 + c8;
  f.q = *(const u32x4*)(prow + C_MQ); f.k = *(const u32x4*)(prow + C_MK); f.v = *(const u32x4*)(prow + C_MV); f.ov = *(const u32x4*)(prow + C_MO);
  const int seq0 = (b * 4 + hh) * 2, ci0 = ml_cidx(ch, 0), ci1 = ml_cidx(ch, 1);
  f.c0 = *(const u32x4*)(CST + ((size_t)seq0 * NCH + ci0) * 4096 + r * 64 + c8);
  f.c1 = *(const u32x4*)(CST + ((size_t)(seq0 + 1) * NCH + ci1) * 4096 + r * 64 + c8);
  f.ns0 = 0.f; f.ns1 = 0.f; f.g_ig = 0.f; f.g_lf = 0.f; f.mi = 0.f;
  if (tid < 64) { f.ns0 = NST[((size_t)seq0 * NCH + ci0) * 64 + tid]; f.ns1 = NST[((size_t)(seq0 + 1) * NCH + ci1) * 64 + tid]; }
  if (wid < 2) {
    const int dir = wid;
    f.g_ig = GT[(size_t)(row0 + lane) * 16 + (2 * dir) * 4 + hh];
    f.g_lf = GT[(size_t)(row0 + lane) * 16 + (2 * dir + 1) * 4 + hh];
    f.mi = META[((size_t)(seq0 + dir) * NCH + (dir ? ci1 : ci0)) * 4 + 2];
  }
}
__device__ __forceinline__ void ml_put_rm(const u32x4 a, unsigned char* dst, int tid) { const int r = tid >> 3, c8 = (tid & 7) * 8; *(u32x4*)(dst + r * MLP + c8 * 2) = a; }
__device__ __forceinline__ void ml_put_tr(const u32x4 a, unsigned char* dst, int tid) {
  const int r = tid >> 3, c8 = (tid & 7) * 8;
  bf16_t* d = (bf16_t*)dst;
  d[(c8 + 0) * 72 + r] = (bf16_t)(a.x & 0xffffu); d[(c8 + 1) * 72 + r] = (bf16_t)(a.x >> 16);
  d[(c8 + 2) * 72 + r] = (bf16_t)(a.y & 0xffffu); d[(c8 + 3) * 72 + r] = (bf16_t)(a.y >> 16);
  d[(c8 + 4) * 72 + r] = (bf16_t)(a.z & 0xffffu); d[(c8 + 5) * 72 + r] = (bf16_t)(a.z >> 16);
  d[(c8 + 6) * 72 + r] = (bf16_t)(a.w & 0xffffu); d[(c8 + 7) * 72 + r] = (bf16_t)(a.w >> 16);
}
__device__ __forceinline__ void ml_out_unit2(const Params& p, int l, int unit, unsigned char* lds, const MlOutPf& f, int next, MlOutPf& fn) {
  int tid_ = tidx(); asm volatile("" : "+v"(tid_)); const int tid = tid_, lane = tid & 63, wid = tid >> 6, r32 = lane & 31, hi = lane >> 5;
  unsigned char* Qs = lds; unsigned char* Ks = lds + 64 * MLP; unsigned char* VT = lds + 2 * 64 * MLP; unsigned char* Cs = lds + 3 * 64 * MLP;
  float* Ns = (float*)(lds + 5 * 64 * MLP);
  float* Bq = Ns + 128;
  float* Gs = Bq + 128;
  float* Mi = Gs + 128;
  float* HB = Mi + 64;
  const bf16_t* PROJ = (const bf16_t*)(p.ws + WS_PROJ);
  const float* GT = (const float*)(p.ws + WS_GATES);
  const bf16_t* CST = (const bf16_t*)(p.ws + WS_CST); const float* NST = (const float*)(p.ws + WS_NST); const float* META = (const float*)(p.ws + WS_MLMETA);
  bf16_t* MIX = (bf16_t*)(p.ws + WS_MIX);
  const int b = unit / (4 * NCH), hh = (unit / NCH) & 3, ch = unit % NCH;
  const int row0 = b * SEGL + ch * 64;
  ml_put_rm(f.q, Qs, tid); ml_put_rm(f.k, Ks, tid); ml_put_tr(f.v, VT, tid);
  ml_put_rm(f.c0, Cs, tid); ml_put_rm(f.c1, Cs + 64 * MLP, tid);
  if (tid < 64) { Ns[tid] = f.ns0; Ns[64 + tid] = f.ns1; }
  if (wid < 2) {
    const int dir = wid;
    const float ig = f.g_ig;
    const float lf = logsigmoidf_(f.g_lf);
    float ps = lf;
    ps = wave_incl_scan(ps);
    const float tot = __uint_as_float((unsigned)__builtin_amdgcn_readlane((int)__float_as_uint(ps), 63));
    const float bc = dir == 0 ? ps : (tot - ps + lf);
    Bq[dir * 64 + lane] = bc; Gs[dir * 64 + lane] = ig - bc;
    if (lane == 0) Mi[dir] = f.mi;
  }
  const u32x4 ov = f.ov;
  if (next >= 0) ml_out_fetch(p, next, tid, fn);
  __syncthreads();
  {
    const int dir = wid >> 2, tt = (wid >> 1) & 1, et = wid & 1;
    const int t = tt * 32 + r32;
    f32x16 sa[2] = {};
    bf16x8 bq[4];
#pragma unroll
    for (int ks = 0; ks < 4; ++ks) {
      bq[ks] = *(const bf16x8*)(Qs + t * MLP + (ks * 16 + hi * 8) * 2);
      const bf16x8 a0 = *(const bf16x8*)(Ks + r32 * MLP + (ks * 16 + hi * 8) * 2), a1 = *(const bf16x8*)(Ks + (32 + r32) * MLP + (ks * 16 + hi * 8) * 2);
      sa[0] = __builtin_amdgcn_mfma_f32_32x32x16_bf16(a0, bq[ks], sa[0], 0, 0, 0);
      sa[1] = __builtin_amdgcn_mfma_f32_32x32x16_bf16(a1, bq[ks], sa[1], 0, 0, 0);
    }
    const float bt = Bq[dir * 64 + t];
    const float inter = bt + Mi[dir];
    float mx = -INFINITY;
    f32x16 dl[2];
#pragma unroll
    for (int st = 0; st < 2; ++st)
#pragma unroll
      for (int r = 0; r < 16; ++r) {
        const int s = st * 32 + crow(r, hi);
        const bool ok = dir == 0 ? (s <= t) : (s >= t);
        const float d = ok ? bt + Gs[dir * 64 + s] : -INFINITY;
        dl[st][r] = d; mx = fmaxf(mx, d);
      }
    mx = max_xor32(mx);
    const float mt = fmaxf(inter, mx);
    const float iw = __expf(inter - mt);
    float rsum = 0.f;
#pragma unroll
    for (int st = 0; st < 2; ++st)
#pragma unroll
      for (int r = 0; r < 16; ++r) { const float w = __expf(dl[st][r] - mt); sa[st][r] *= w; rsum += sa[st][r]; }
    rsum = sum_xor32(rsum);
    float qn = 0.f;
#pragma unroll
    for (int i = 0; i < 4; ++i) {
      const int d0 = hi * 32 + i * 8;
      const u32x4 qa = *(const u32x4*)(Qs + t * MLP + d0 * 2);
      const f32x4 n0 = *(const f32x4*)(Ns + dir * 64 + d0), n1 = *(const f32x4*)(Ns + dir * 64 + d0 + 4);
      qn += bflo(qa.x) * n0.x + bfhi(qa.x) * n0.y + bflo(qa.y) * n0.z + bfhi(qa.y) * n0.w + bflo(qa.z) * n1.x + bfhi(qa.z) * n1.y + bflo(qa.w) * n1.z + bfhi(qa.w) * n1.w;
    }
    qn = sum_xor32(qn);
    const float den = rsum + iw * qn;
    const float rden = 1.f / fmaxf(fabsf(den), __expf(-mt));
    f32x16 an = {}, ac = {};
#pragma unroll
    for (int st = 0; st < 2; ++st)
#pragma unroll
      for (int k2 = 0; k2 < 2; ++k2) {
        u32x4 bx; bx.x = cvtpk(sa[st][8 * k2 + 0], sa[st][8 * k2 + 1]); bx.y = cvtpk(sa[st][8 * k2 + 2], sa[st][8 * k2 + 3]);
        bx.z = cvtpk(sa[st][8 * k2 + 4], sa[st][8 * k2 + 5]); bx.w = cvtpk(sa[st][8 * k2 + 6], sa[st][8 * k2 + 7]);
        const unsigned char* vrow = VT + (et * 32 + r32) * MLP + (st * 32 + 16 * k2 + 4 * hi) * 2;
        const u32x2 v0 = *(const u32x2*)vrow, v1 = *(const u32x2*)(vrow + 16);
        u32x4 ax; ax.x = v0.x; ax.y = v0.y; ax.z = v1.x; ax.w = v1.y;
        an = __builtin_amdgcn_mfma_f32_32x32x16_bf16(*(const bf16x8*)&ax, *(const bf16x8*)&bx, an, 0, 0, 0);
      }
    const unsigned char* Cd = Cs + dir * 64 * MLP;
#pragma unroll
    for (int ks = 0; ks < 4; ++ks) {
      const bf16x8 a = *(const bf16x8*)(Cd + (et * 32 + r32) * MLP + (ks * 16 + hi * 8) * 2);
      ac = __builtin_amdgcn_mfma_f32_32x32x16_bf16(a, bq[ks], ac, 0, 0, 0);
    }
#pragma unroll
    for (int r = 0; r < 16; ++r) HB[dir * 64 * 65 + t * 65 + et * 32 + crow(r, hi)] = (an[r] + iw * ac[r]) * rden;
  }
  __syncthreads();
  {
    const int t = tid >> 3, e8 = (tid & 7) * 8;
    float v[8]; float ss = 0.f;
#pragma unroll
    for (int i = 0; i < 8; ++i) { v[i] = HB[t * 65 + e8 + i] + HB[64 * 65 + t * 65 + e8 + i]; ss += v[i] * v[i]; }
    ss += dpp_mov<0xB1>(ss); ss += dpp_mov<0x4E>(ss); ss += dpp_mov<0x141>(ss);
    const float rs = rsqrtf(ss * (1.f / 64.f) + EPS);
    const float og[8] = {bflo(ov.x), bfhi(ov.x), bflo(ov.y), bfhi(ov.y), bflo(ov.z), bfhi(ov.z), bflo(ov.w), bfhi(ov.w)};
    const float* g = p.in[I_MNORMG] + l * 64 + e8;
    float o[8];
#pragma unroll
    for (int i = 0; i < 8; ++i) o[i] = (ABL & 2) ? 0.f : v[i] * rs * g[i] * sigmoidf_(og[i]);
    u32x4 w; w.x = cvtpk(o[0], o[1]); w.y = cvtpk(o[2], o[3]); w.z = cvtpk(o[4], o[5]); w.w = cvtpk(o[6], o[7]);
    *(u32x4*)(MIX + (size_t)(row0 + t) * DM + 256 + hh * 64 + e8) = w;
  }
  __syncthreads();
}

#define KSWZ(row, colB) ((row) * 256 + ((colB) ^ (((row) & 15) << 4)))
#define SBAR() __builtin_amdgcn_sched_barrier(0)
constexpr int ATT_SHM_V = 128 * 80, ATT_SHM_K = 64 * QK8_PITCH;
constexpr float ATT_THR = 8.0f;
__device__ __forceinline__ int v_st(int k, int c) { const int kk = (k & ~0xC) | ((k & 4) << 1) | ((k & 8) >> 1); return ((kk >> 3) * 4 + (c >> 5)) * 512 + ((kk & 7) * 32 + (c & 31)) * 2; }
__device__ __forceinline__ int v_rd_base(int lane) { return ((lane & 3) << 3) | (((lane >> 2) & 3) << 6) | (((lane >> 4) & 1) << 5) | (((lane >> 5) & 1) << 8); }
constexpr int v_rd_off(int d0, int ks, int half) { return d0 * 512 + ks * 4096 + half * 2048; }
template <int OFF> __device__ __forceinline__ s16x4 tr_read(int vb) {
  s16x4 r; asm volatile("ds_read_b64_tr_b16 %0, %1 offset:%2" : "=&v"(r) : "v"(vb), "i"(OFF) : "memory"); return r;
}
template <int D0> __device__ __forceinline__ void pv_one(f32x16& od, int vb, bf16x8 pa0, bf16x8 pa1, bf16x8 pa2, bf16x8 pa3) {
  const s16x4 l0 = tr_read<v_rd_off(D0, 0, 0)>(vb), h0 = tr_read<v_rd_off(D0, 0, 1)>(vb), l1 = tr_read<v_rd_off(D0, 1, 0)>(vb), h1 = tr_read<v_rd_off(D0, 1, 1)>(vb);
  const s16x4 l2 = tr_read<v_rd_off(D0, 2, 0)>(vb), h2 = tr_read<v_rd_off(D0, 2, 1)>(vb), l3 = tr_read<v_rd_off(D0, 3, 0)>(vb), h3 = tr_read<v_rd_off(D0, 3, 1)>(vb);
  asm volatile("s_waitcnt lgkmcnt(0)" ::: "memory"); SBAR();
#define PK(L, H) (bf16x8){L[0], L[1], L[2], L[3], H[0], H[1], H[2], H[3]}
  od = __builtin_amdgcn_mfma_f32_32x32x16_bf16(pa0, PK(l0, h0), od, 0, 0, 0);
  od = __builtin_amdgcn_mfma_f32_32x32x16_bf16(pa1, PK(l1, h1), od, 0, 0, 0);
  od = __builtin_amdgcn_mfma_f32_32x32x16_bf16(pa2, PK(l2, h2), od, 0, 0, 0);
  od = __builtin_amdgcn_mfma_f32_32x32x16_bf16(pa3, PK(l3, h3), od, 0, 0, 0);
#undef PK
}
template <int D0> __device__ __forceinline__ void pv_two(f32x16& oa, f32x16& ob, int vb, bf16x8 a0, bf16x8 a1, bf16x8 a2, bf16x8 a3, bf16x8 b0, bf16x8 b1, bf16x8 b2, bf16x8 b3) {
  const s16x4 l0 = tr_read<v_rd_off(D0, 0, 0)>(vb), h0 = tr_read<v_rd_off(D0, 0, 1)>(vb), l1 = tr_read<v_rd_off(D0, 1, 0)>(vb), h1 = tr_read<v_rd_off(D0, 1, 1)>(vb);
  const s16x4 l2 = tr_read<v_rd_off(D0, 2, 0)>(vb), h2 = tr_read<v_rd_off(D0, 2, 1)>(vb), l3 = tr_read<v_rd_off(D0, 3, 0)>(vb), h3 = tr_read<v_rd_off(D0, 3, 1)>(vb);
  asm volatile("s_waitcnt lgkmcnt(0)" ::: "memory"); SBAR();
#define PK(L, H) (bf16x8){L[0], L[1], L[2], L[3], H[0], H[1], H[2], H[3]}
  const bf16x8 v0 = PK(l0, h0), v1 = PK(l1, h1), v2 = PK(l2, h2), v3 = PK(l3, h3);
  oa = __builtin_amdgcn_mfma_f32_32x32x16_bf16(a0, v0, oa, 0, 0, 0);
  ob = __builtin_amdgcn_mfma_f32_32x32x16_bf16(b0, v0, ob, 0, 0, 0);
  oa = __builtin_amdgcn_mfma_f32_32x32x16_bf16(a1, v1, oa, 0, 0, 0);
  ob = __builtin_amdgcn_mfma_f32_32x32x16_bf16(b1, v1, ob, 0, 0, 0);
  oa = __builtin_amdgcn_mfma_f32_32x32x16_bf16(a2, v2, oa, 0, 0, 0);
  ob = __builtin_amdgcn_mfma_f32_32x32x16_bf16(b2, v2, ob, 0, 0, 0);
  oa = __builtin_amdgcn_mfma_f32_32x32x16_bf16(a3, v3, oa, 0, 0, 0);
  ob = __builtin_amdgcn_mfma_f32_32x32x16_bf16(b3, v3, ob, 0, 0, 0);
#undef PK
}
struct KQFrag { bf16x8 b0, b1, q; };
__device__ __forceinline__ void att_ldkq(KQFrag& f, const LAS unsigned char* l3, int akk, int akq) {
  const LAS unsigned char* kp = l3 + akk;
  f.b0 = *(const LAS bf16x8*)kp; f.b1 = *(const LAS bf16x8*)(kp + 8192); f.q = *(const LAS bf16x8*)(l3 + akq);
}
#define ATT_MF(pa_, pb_, f_) do { pa_ = __builtin_amdgcn_mfma_f32_32x32x16_bf16(f_.b0, f_.q, pa_, 0, 0, 0); pb_ = __builtin_amdgcn_mfma_f32_32x32x16_bf16(f_.b1, f_.q, pb_, 0, 0, 0); } while (0)
__device__ __forceinline__ void att_qk_all(f32x16& p0, f32x16& p1, f32x16& q0, f32x16& q1, KQFrag& f0, const LAS unsigned char* l3, int akk0, int akq0, float ia, float ib) {
  KQFrag f1;
#pragma unroll
  for (int r = 0; r < 16; ++r) { p0[r] = ia; p1[r] = ia; q0[r] = ib; q1[r] = ib; }
  att_ldkq(f1, l3, akk0 ^ (1 << 5), akq0 ^ (1 << 5)); ATT_MF(p0, p1, f0); SBAR();
  att_ldkq(f0, l3, akk0 ^ (2 << 5), akq0 ^ (2 << 5)); ATT_MF(p0, p1, f1); SBAR();
  att_ldkq(f1, l3, akk0 ^ (3 << 5), akq0 ^ (3 << 5)); ATT_MF(p0, p1, f0); SBAR();
  att_ldkq(f0, l3, akk0 ^ (4 << 5), akq0 ^ (4 << 5)); ATT_MF(p0, p1, f1); SBAR();
  att_ldkq(f1, l3, akk0 ^ (5 << 5), akq0 ^ (5 << 5)); ATT_MF(q0, q1, f0); SBAR();
  att_ldkq(f0, l3, akk0 ^ (6 << 5), akq0 ^ (6 << 5)); ATT_MF(q0, q1, f1); SBAR();
  att_ldkq(f1, l3, akk0 ^ (7 << 5), akq0 ^ (7 << 5)); ATT_MF(q0, q1, f0); SBAR();
  ATT_MF(q0, q1, f1); SBAR();
}
__device__ __forceinline__ float bf16_near(float x) { return __uint_as_float((__float_as_uint(x) + 0x8000u) & 0xFFFF0000u); }
__device__ __forceinline__ void att_softmax(f32x16& p0, f32x16& p1, float& m_reg, float& l_reg, float& alpha, bool first, i32x8& pa) {
  alpha = 1.f;
  if (first) {
    float pmax = p0[0];
#pragma unroll
    for (int r = 1; r < 16; ++r) pmax = fmaxf(pmax, p0[r]);
#pragma unroll
    for (int r = 0; r < 16; ++r) pmax = fmaxf(pmax, p1[r]);
    { auto rr = __builtin_amdgcn_permlane32_swap(__float_as_uint(pmax), __float_as_uint(pmax), false, false);
      pmax = fmaxf(__uint_as_float(rr[0]), __uint_as_float(rr[1])); }
    pmax = bf16_near(pmax);
    alpha = 0.f; m_reg = pmax;
#pragma unroll
    for (int r = 0; r < 16; ++r) { p0[r] -= pmax; p1[r] -= pmax; }
  }
#pragma unroll
  for (int r = 0; r < 16; ++r) { p0[r] = __builtin_amdgcn_exp2f(p0[r]); p1[r] = __builtin_amdgcn_exp2f(p1[r]); }
  float ps;
  {
#define VADD(d_, a_, b_) asm("v_add_f32_e32 %0, %1, %2" : "=v"(d_) : "v"(a_), "v"(b_))
    float s0, s1, s2, s3;
    VADD(s0, p0[0], p0[1]); VADD(s1, p0[8], p0[9]); VADD(s2, p1[0], p1[1]); VADD(s3, p1[8], p1[9]);
#pragma unroll
    for (int r = 2; r < 8; ++r) { VADD(s0, s0, p0[r]); VADD(s1, s1, p0[8 + r]); VADD(s2, s2, p1[r]); VADD(s3, s3, p1[8 + r]); }
    VADD(s0, s0, s1); VADD(s2, s2, s3); VADD(ps, s0, s2);
#undef VADD
  }
  { auto rr = __builtin_amdgcn_permlane32_swap(__float_as_uint(ps), __float_as_uint(ps), false, false);
    ps = __uint_as_float(rr[0]) + __uint_as_float(rr[1]); }
  if (__builtin_expect(!first && __any(ps > 256.f), 0)) {
    float emax = p0[0];
#pragma unroll
    for (int r = 1; r < 16; ++r) emax = fmaxf(emax, p0[r]);
#pragma unroll
    for (int r = 0; r < 16; ++r) emax = fmaxf(emax, p1[r]);
    { auto rr = __builtin_amdgcn_permlane32_swap(__float_as_uint(emax), __float_as_uint(emax), false, false);
      emax = fmaxf(__uint_as_float(rr[0]), __uint_as_float(rr[1])); }
    const float m_new = bf16_near(m_reg + fmaxf(__builtin_amdgcn_logf(emax), 0.f));
    const float delta = m_new - m_reg;
    alpha = __builtin_amdgcn_exp2f(-delta); m_reg = m_new;
#pragma unroll
    for (int r = 0; r < 16; ++r) { p0[r] *= alpha; p1[r] *= alpha; }
    ps *= alpha;
  }
  l_reg = l_reg * alpha + ps;
#pragma unroll
  for (int v = 0; v < 4; ++v) {
    int w0, w1; asm volatile("" : "=v"(w0), "=v"(w1));
    w0 = __builtin_amdgcn_cvt_pk_fp8_f32(p0[4 * v], p0[4 * v + 1], w0, false); w0 = __builtin_amdgcn_cvt_pk_fp8_f32(p0[4 * v + 2], p0[4 * v + 3], w0, true);
    w1 = __builtin_amdgcn_cvt_pk_fp8_f32(p1[4 * v], p1[4 * v + 1], w1, false); w1 = __builtin_amdgcn_cvt_pk_fp8_f32(p1[4 * v + 2], p1[4 * v + 3], w1, true);
    pa[v] = w0; pa[4 + v] = w1;
  }
}
__device__ __forceinline__ void att_unit(const unsigned char* __restrict__ Q8, const unsigned char* __restrict__ K8, const unsigned char* __restrict__ V8, bf16_t* __restrict__ Ob,
                                         int nkeys, float lam, const float* __restrict__ ng, float oscale, unsigned char* lds) {
  int tid_ = tidx(); asm volatile("" : "+v"(tid_)); const int tid = tid_, wid = tid >> 6, lane = tid & 63, r32 = lane & 31, hi = lane >> 5;
  const int grp = __builtin_amdgcn_readfirstlane(wid >> 2);
  unsigned char* V_lds = lds; unsigned char* K_lds = lds + 2 * ATT_SHM_V;
  float* wsl = (float*)(lds + 2 * ATT_SHM_V + 2 * ATT_SHM_K) + wid * 64; float* li_l = wsl; float* al_l = wsl + 32;
  float m0 = 0.f, l0 = 0.f, m1 = 0.f, l1 = 0.f;
  f32x16 o0[4] = {}, o1[4] = {};
  unsigned char* Q_lds = lds + 2 * ATT_SHM_V + 2 * ATT_SHM_K + 2048;
#pragma unroll
  for (int i = 0; i < 5; ++i) { const int piece = __builtin_amdgcn_readfirstlane(wid) + 8 * i;
    if (piece < 36) __builtin_amdgcn_global_load_lds((const unsigned*)(Q8 + piece * 1024 + lane * 16), (LAS unsigned*)(Q_lds + piece * 1024), 16, 0, 0); }
  const unsigned ldsw = (unsigned)__builtin_amdgcn_readfirstlane(wid) * 1024u;
#define GSTAGE_K(b, k0) do { const unsigned char* ki_ = K8 + (size_t)(k0) * QK8_PITCH + tid * 16; \
      __builtin_amdgcn_global_load_lds((const unsigned*)ki_, (LAS unsigned*)(K_lds + (b) * ATT_SHM_K + ldsw), 16, 0, 0); \
      if (wid < 1) __builtin_amdgcn_global_load_lds((const unsigned*)(ki_ + 8192), (LAS unsigned*)(K_lds + (b) * ATT_SHM_K + 8192 + ldsw), 16, 0, 0); } while (0)
#define GSTAGE_V(b, k0) do { const unsigned char* vi_ = V8 + (size_t)((k0) >> 6) * ATT_SHM_V + tid * 16; \
      __builtin_amdgcn_global_load_lds((const unsigned*)vi_, (LAS unsigned*)(V_lds + (b) * ATT_SHM_V + ldsw), 16, 0, 0); \
      if (wid < 2) __builtin_amdgcn_global_load_lds((const unsigned*)(vi_ + 8192), (LAS unsigned*)(V_lds + (b) * ATT_SHM_V + 8192 + ldsw), 16, 0, 0); } while (0)
#define STAGE_PAIR(jj) do { GSTAGE_V((jj) & 1, (jj) * 64); if ((jj) + 1 < NT) GSTAGE_K((jj) & 1, ((jj) + 1) * 64); } while (0)
#define RESC(o, a) do { if (__any((a) < 1.f)) { if (hi == 0) al_l[r32] = (a); asm volatile("s_waitcnt lgkmcnt(0)" ::: "memory"); \
    _Pragma("unroll") for (int d = 0; d < 4; ++d) _Pragma("unroll") for (int r = 0; r < 16; ++r) o[d][r] *= al_l[crow(r, hi)]; } } while (0)
#define ATT_BAR() do { asm volatile("s_waitcnt lgkmcnt(0)" ::: "memory"); __builtin_amdgcn_s_barrier(); asm volatile("" ::: "memory"); } while (0)
#define ATT_LDK(dst_, off_) do { const u32x4 x0_ = *(const LAS u32x4*)(kb_ + (off_)), x1_ = *(const LAS u32x4*)(kb_ + (off_) + 16); \
      dst_[0] = (int)x0_.x; dst_[1] = (int)x0_.y; dst_[2] = (int)x0_.z; dst_[3] = (int)x0_.w; dst_[4] = (int)x1_.x; dst_[5] = (int)x1_.y; dst_[6] = (int)x1_.z; dst_[7] = (int)x1_.w; } while (0)
#define ATT_SC(acc_, kf_, qf_) acc_ = __builtin_amdgcn_mfma_scale_f32_32x32x64_f8f6f4(kf_, qf_, acc_, 0, 0, 0, 0x7F7F7F7F, 0, 0x7F7F7F7F)
#define ATT_LDQ(dst_, off_) do { const u32x4 x0_ = *(const LAS u32x4*)(qb_ + (off_)), x1_ = *(const LAS u32x4*)(qb_ + (off_) + 16); \
      dst_[0] = (int)x0_.x; dst_[1] = (int)x0_.y; dst_[2] = (int)x0_.z; dst_[3] = (int)x0_.w; dst_[4] = (int)x1_.x; dst_[5] = (int)x1_.y; dst_[6] = (int)x1_.z; dst_[7] = (int)x1_.w; } while (0)
#define ATT_INIT2(pa_, pb_, negm_) do { u32x4 oa_, ob_; unsigned z_ = 0u; asm volatile("" : "+v"(z_)); \
      oa_.x = hi ? z_ : 0x3F80u; oa_.y = z_; oa_.z = z_; oa_.w = z_; ob_.x = hi ? z_ : (__float_as_uint(negm_) >> 16); ob_.y = z_; ob_.z = z_; ob_.w = z_; \
      const f32x16 zz_ = {}; \
      pa_ = __builtin_amdgcn_mfma_f32_32x32x16_bf16(*(const bf16x8*)&oa_, *(const bf16x8*)&ob_, zz_, 0, 0, 0); \
      pb_ = __builtin_amdgcn_mfma_f32_32x32x16_bf16(*(const bf16x8*)&oa_, *(const bf16x8*)&ob_, zz_, 0, 0, 0); } while (0)
#define ATT_QK_ALL(ia_, ib_) do { ATT_INIT2(p0, p1, ia_); ATT_INIT2(q0, q1, ib_); SBAR(); \
      ATT_SC(p0, kf0, qf); SBAR(); ATT_LDK(kf0, 32 * QK8_PITCH); SBAR(); \
      ATT_SC(p1, kf0, qf); SBAR(); ATT_LDK(kf0, 64); ATT_LDQ(qf, 64); SBAR(); \
      ATT_SC(q0, kf0, qf); SBAR(); ATT_LDK(kf0, 32 * QK8_PITCH + 64); SBAR(); \
      ATT_SC(q1, kf0, qf); SBAR(); } while (0)
  const int NT = nkeys / 64;
  GSTAGE_K(1, 0); STAGE_PAIR(0);
  asm volatile("s_waitcnt vmcnt(0)" ::: "memory"); __syncthreads();
  f32x16 p0, p1, q0, q1; i32x8 pa, pb;
  const LAS unsigned char* l3 = (const LAS unsigned char*)lds;
  const int kofs0 = 2 * ATT_SHM_V + r32 * QK8_PITCH + hi * 32;
  const int qofs0 = 2 * ATT_SHM_V + 2 * ATT_SHM_K + 2048 + (__builtin_amdgcn_readfirstlane(wid) * 32 + r32) * QK8_PITCH + hi * 32;
  { i32x8 kf0, qf; const LAS unsigned char* kb_ = l3 + (kofs0 + ATT_SHM_K); const LAS unsigned char* qb_ = l3 + qofs0;
    ATT_LDK(kf0, 0); ATT_LDQ(qf, 0);
    ATT_QK_ALL(0.f, 0.f); }
  if (grp) ATT_BAR();
#pragma unroll 1
  for (int j = 0; j < NT; ++j) {
    const int cur = j & 1;
    const bool more = (j + 1 < NT);
    if (grp && more) STAGE_PAIR(j + 1);
    { float alphaA, alphaB;
      const bool first = (j == 0);
      att_softmax(p0, p1, m0, l0, alphaA, first, pa); SBAR();
      att_softmax(q0, q1, m1, l1, alphaB, first, pb); SBAR();
      RESC(o0, alphaA);
      RESC(o1, alphaB); }
    asm volatile("" : "+v"(pa), "+v"(pb), "+v"(m0), "+v"(l0), "+v"(m1), "+v"(l1));
    asm volatile("" : "+v"(o0[0]), "+v"(o0[1]), "+v"(o0[2]), "+v"(o0[3]), "+v"(o1[0]), "+v"(o1[1]), "+v"(o1[2]), "+v"(o1[3]));
    if (!grp) asm volatile("s_waitcnt vmcnt(0)" ::: "memory");
    ATT_BAR();
    if (!grp && more) STAGE_PAIR(j + 1);
    __builtin_amdgcn_s_setprio(1);
    {
      int kofs = kofs0, qofs = qofs0; asm volatile("" : "+v"(kofs), "+v"(qofs));
      const LAS unsigned char* kb_ = l3 + (kofs + cur * ATT_SHM_K); const LAS unsigned char* qb_ = l3 + qofs;
      i32x8 kf0, qf;
      const LAS unsigned char* vrow = l3 + (r32 * 80 + hi * 32 + cur * ATT_SHM_V);
      u32x4 va0 = *(const LAS u32x4*)vrow, va1 = *(const LAS u32x4*)(vrow + 16), vb0, vb1;
#define ATT_PV(d0_, x0_, x1_) do { i32x8 bv; bv[0] = (int)x0_.x; bv[1] = (int)x0_.y; bv[2] = (int)x0_.z; bv[3] = (int)x0_.w; bv[4] = (int)x1_.x; bv[5] = (int)x1_.y; bv[6] = (int)x1_.z; bv[7] = (int)x1_.w; \
        o0[d0_] = __builtin_amdgcn_mfma_scale_f32_32x32x64_f8f6f4(pa, bv, o0[d0_], 0, 0, 0, 0x7F7F7F7F, 0, 0x7F7F7F7F); \
        o1[d0_] = __builtin_amdgcn_mfma_scale_f32_32x32x64_f8f6f4(pb, bv, o1[d0_], 0, 0, 0, 0x7F7F7F7F, 0, 0x7F7F7F7F); } while (0)
      vb0 = *(const LAS u32x4*)(vrow + 32 * 80); vb1 = *(const LAS u32x4*)(vrow + 32 * 80 + 16); ATT_PV(0, va0, va1); SBAR();
      va0 = *(const LAS u32x4*)(vrow + 64 * 80); va1 = *(const LAS u32x4*)(vrow + 64 * 80 + 16); ATT_PV(1, vb0, vb1); SBAR();
      vb0 = *(const LAS u32x4*)(vrow + 96 * 80); vb1 = *(const LAS u32x4*)(vrow + 96 * 80 + 16); ATT_PV(2, va0, va1); SBAR();
      ATT_LDK(kf0, 0); ATT_LDQ(qf, 0);
      ATT_PV(3, vb0, vb1); SBAR();
#undef ATT_PV
      asm volatile("" : "+v"(o0[0]), "+v"(o0[1]), "+v"(o0[2]), "+v"(o0[3]), "+v"(o1[0]), "+v"(o1[1]), "+v"(o1[2]), "+v"(o1[3]));
      ATT_QK_ALL(-m0, -m1);
      asm volatile("" : "+v"(p0), "+v"(p1), "+v"(q0), "+v"(q1));
    }
    __builtin_amdgcn_s_setprio(0);
    if (grp) asm volatile("s_waitcnt vmcnt(0)" ::: "memory");
    ATT_BAR();
  }
  if (!grp) ATT_BAR();
  if (hi == 0) { li_l[r32] = 1.f / l0; al_l[r32] = lam / l1; }
  asm volatile("s_waitcnt lgkmcnt(0)" ::: "memory");
  float ss[16];
#pragma unroll
  for (int r = 0; r < 16; ++r) {
    const float a = li_l[crow(r, hi)], bq = al_l[crow(r, hi)];
    float s = 0.f;
#pragma unroll
    for (int d = 0; d < 4; ++d) { const float v = o0[d][r] * a - o1[d][r] * bq; o0[d][r] = v; s += v * v; }
    s += dpp_mov<0xB1>(s); s += dpp_mov<0x4E>(s); s += dpp_mov<0x141>(s); s += dpp_mov<0x140>(s);
    { auto rr_ = __builtin_amdgcn_permlane16_swap(__float_as_uint(s), __float_as_uint(s), false, false); s = __uint_as_float(rr_[0]) + __uint_as_float(rr_[1]); }
    ss[r] = rsqrtf(s * (1.f / 128.f) + EPS) * oscale;
  }
  bf16_t* Ow = Ob + (size_t)(wid * 32) * DM;
  unsigned char* ost = lds + 2 * ATT_SHM_V + 2 * ATT_SHM_K + 2048 + wid * (32 * 272);
#pragma unroll
  for (int d = 0; d < 4; ++d) {
    const float g = ng[d * 32 + r32];
#pragma unroll
    for (int r = 0; r < 16; ++r) *(bf16_t*)(ost + crow(r, hi) * 272 + (d * 32 + r32) * 2) = (ABL & 4) ? (bf16_t)0 : (bf16_t)(cvtpk(o0[d][r] * ss[r] * g, 0.f) & 0xffffu);
  }
  asm volatile("s_waitcnt lgkmcnt(0)" ::: "memory");
#pragma unroll
  for (int i = 0; i < 8; ++i) {
    const int c = lane + 64 * i, row = c >> 4, cb = (c & 15) * 16;
    *(u32x4*)((unsigned char*)(Ow + (size_t)row * DM) + cb) = *(const u32x4*)(ost + row * 272 + cb);
  }
  __syncthreads();
#undef ATT_INIT2
#undef ATT_LDK
#undef ATT_LDQ
#undef ATT_SC
#undef ATT_QK_ALL
#undef GSTAGE_K
#undef GSTAGE_V
#undef STAGE_PAIR
#undef RESC
#undef ATT_BAR
}

__device__ __forceinline__ float ins16(float (&a)[16], float x) {
#pragma unroll
  for (int i = 0; i < 16; ++i) { const float h = fmaxf(a[i], x); x = fminf(a[i], x); a[i] = h; }
  return x;
}
__device__ __forceinline__ void bsort16(float (&a)[16]) {
#pragma unroll
  for (int k = 2; k <= 16; k <<= 1)
#pragma unroll
    for (int j = k >> 1; j > 0; j >>= 1)
#pragma unroll
      for (int i = 0; i < 16; ++i) {
        const int q = i ^ j;
        if (q > i) {
          const bool desc = ((i & k) == 0);
          const float hi_ = fmaxf(a[i], a[q]), lo_ = fminf(a[i], a[q]);
          a[i] = desc ? hi_ : lo_; a[q] = desc ? lo_ : hi_;
        }
      }
}
__device__ __forceinline__ void bmerge16(float (&a)[16], const float (&b)[16]) {
#pragma unroll
  for (int i = 0; i < 16; ++i) a[i] = fmaxf(a[i], b[15 - i]);
#pragma unroll
  for (int j = 8; j > 0; j >>= 1)
#pragma unroll
    for (int i = 0; i < 16; ++i) {
      const int q = i ^ j;
      if (q > i) { const float hi_ = fmaxf(a[i], a[q]), lo_ = fminf(a[i], a[q]); a[i] = hi_; a[q] = lo_; }
    }
}
__device__ __forceinline__ float gelu_erf(float x) { return 0.5f * x * (1.f + erff(x * 0.70710678118654752440f)); }
#define XB_TMO      128
#define XB_XCNT(j)  (256  + 64 * (j))
#define XB_XSUB(j)  (1280 + 64 * (j))
#define XB_XGEN(j)  (2304 + 64 * (j))
#define XB_TOP      3328
#define XB_TOPGEN   3392
#define XCD_BAR_WORDS 3456
#define XB_SPIN_CAP (1u << 22)
__device__ __forceinline__ unsigned xb_ld(unsigned* p)              { return __hip_atomic_load(p, __ATOMIC_RELAXED, __HIP_MEMORY_SCOPE_AGENT); }
__device__ __forceinline__ unsigned xb_add(unsigned* p, unsigned v) { return __hip_atomic_fetch_add(p, v, __ATOMIC_RELAXED, __HIP_MEMORY_SCOPE_AGENT); }
__device__ __forceinline__ unsigned xb_xcc_id() { return (unsigned)__builtin_amdgcn_s_getreg((3 << 11) | 20) & 0xFu; }
#define XB_SPIN(cond, bar) do { unsigned _sp = 0; while (cond) { __builtin_amdgcn_s_sleep(1); \
    if ((++_sp & 255u) == 0u) { if (xb_ld(&(bar)[XB_TMO])) break; if (_sp > XB_SPIN_CAP) { atomicAdd(&(bar)[XB_TMO], 1u); break; } } } } while (0)
struct XcdBarrier { unsigned* bar; unsigned x; volatile LAS unsigned* st; };
__device__ __forceinline__ XcdBarrier xcd_barrier_post(unsigned* bar, volatile LAS unsigned* st) {
  XcdBarrier b; b.bar = bar; b.x = xb_xcc_id(); b.st = st;
  if (tidx() == 0) (void)xb_add(&bar[XB_XCNT(b.x)], 1u);
  return b;
}
__device__ __forceinline__ void xcd_barrier_complete(unsigned* bar, unsigned x, unsigned& nloc, unsigned& nx) {
  const unsigned G = gridDim.x * gridDim.y * gridDim.z;
  unsigned sum, cnt, mine, sp = 0u;
  for (;;) {
    sum = 0u; cnt = 0u; mine = 0u;
#pragma unroll
    for (unsigned j = 0; j < 16; ++j) { const unsigned c = xb_ld(&bar[XB_XCNT(j)]); sum += c; cnt += (c > 0u) ? 1u : 0u; mine = (j == x) ? c : mine; }
    if (sum == G) break;
    __builtin_amdgcn_s_sleep(1);
    if ((++sp & 255u) == 0u) { if (xb_ld(&bar[XB_TMO])) break; if (sp > XB_SPIN_CAP) { atomicAdd(&bar[XB_TMO], 1u); break; } }
  }
  nloc = mine > 0u ? mine : 1u; nx = cnt > 0u ? cnt : 1u;
}
__device__ __forceinline__ void xcd_barrier(const XcdBarrier& b) {
  asm volatile("s_waitcnt vmcnt(0)" ::: "memory");
  __syncthreads();
  if (tidx() == 0) {
    unsigned* bar = b.bar;
    __builtin_amdgcn_s_waitcnt(0);
    unsigned nloc = b.st[0], nx = b.st[1];
    if (nloc == 0u) { xcd_barrier_complete(bar, b.x, nloc, nx); b.st[0] = nloc; b.st[1] = nx; }
    const unsigned old = xb_add(&bar[XB_XSUB(b.x)], 1u);
    const unsigned gen = old / nloc;
    if (old + 1u == (gen + 1u) * nloc) {
      __builtin_amdgcn_fence(__ATOMIC_RELEASE, "agent");
      asm volatile("s_waitcnt vmcnt(0)" ::: "memory");
      const unsigned og = xb_add(&bar[XB_TOP], 1u);
      const unsigned tg = og / nx;
      if (og + 1u == (tg + 1u) * nx) xb_add(&bar[XB_TOPGEN], 1u);
      else XB_SPIN(xb_ld(&bar[XB_TOPGEN]) == tg, bar);
      __builtin_amdgcn_fence(__ATOMIC_ACQUIRE, "agent");
      xb_add(&bar[XB_XGEN(b.x)], 1u);
      asm volatile("s_waitcnt vmcnt(0)" ::: "memory");
    } else {
      XB_SPIN(xb_ld(&bar[XB_XGEN(b.x)]) == gen, bar);
      __builtin_amdgcn_fence(__ATOMIC_ACQUIRE, "agent");
      asm volatile("s_waitcnt vmcnt(0)" ::: "memory");
    }
  }
  __syncthreads();
}

constexpr size_t RT_STRIDE = (size_t)T * 128 * 4;
__device__ __forceinline__ void route_unit(const Params& p, int l, int unit, unsigned char* lds) {
  int tid_ = tidx(); asm volatile("" : "+v"(tid_)); const int tid = tid_, lane = tid & 63, wid = tid >> 6, r32 = lane & 31, hi = lane >> 5;
  unsigned char* IDX = lds;
  int* UE = (int*)(lds + 8192); float* UG = (float*)(lds + 8192 + 16384); float* US = (float*)(lds + 8192 + 32768);
  int* EIDG = (int*)(p.ws + WS_EID + (size_t)l * RT_STRIDE); float* GWG = (float*)(p.ws + WS_ULOC + RT_STRIDE); float* SUG = (float*)(p.ws + WS_ULOC + 2 * RT_STRIDE);
  const float* PSC = (const float*)(p.ws + WS_PSC);
  const int row0 = unit * 32;
  const bf16_t* QP = (const bf16_t*)(p.ws + WS_PROJ);
  const bf16_t* KEYS = (const bf16_t*)(p.ws + WS_KEYS) + (size_t)l * 131072;
  for (int rrep = 0; rrep < REP_ROUTE; ++rrep) {
    const int h = wid;
    float top[2][16];
    bf16x8 bq[4], bqn[4], akc[4], akn[4];
    {
      const bf16_t* qrow0 = QP + (size_t)(row0 + r32) * DM + h * 128 + hi * 8;
      const bf16_t* kb0 = KEYS + ((size_t)(h * 2) * 128 + r32) * 64 + hi * 8;
#pragma unroll
      for (int ks = 0; ks < 4; ++ks) { bq[ks] = *(const bf16x8*)(qrow0 + ks * 16); akc[ks] = *(const bf16x8*)(kb0 + ks * 16); }
    }
#pragma unroll
    for (int pp = 0; pp < 2; ++pp) {
      const bf16_t* kb = KEYS + ((size_t)(h * 2 + pp) * 128 + r32) * 64 + hi * 8;
      float (&lst)[16] = top[pp];
#pragma unroll
      for (int i = 0; i < 16; ++i) lst[i] = -INFINITY;
#pragma unroll
      for (int nt = 0; nt < 4; ++nt) {
        if (nt < 3) {
#pragma unroll
          for (int ks = 0; ks < 4; ++ks) akn[ks] = *(const bf16x8*)(kb + (size_t)(nt + 1) * 32 * 64 + ks * 16);
        } else if (pp == 0) {
          const bf16_t* qrow1 = QP + (size_t)(row0 + r32) * DM + h * 128 + 64 + hi * 8;
          const bf16_t* kb1 = KEYS + ((size_t)(h * 2 + 1) * 128 + r32) * 64 + hi * 8;
#pragma unroll
          for (int ks = 0; ks < 4; ++ks) { bqn[ks] = *(const bf16x8*)(qrow1 + ks * 16); akn[ks] = *(const bf16x8*)(kb1 + ks * 16); }
        }
        f32x16 acc = {};
#pragma unroll
        for (int ks = 0; ks < 4; ++ks) acc = __builtin_amdgcn_mfma_f32_32x32x16_bf16(akc[ks], bq[ks], acc, 0, 0, 0);
#pragma unroll
        for (int ks = 0; ks < 4; ++ks) { akc[ks] = akn[ks]; if (nt == 3) bq[ks] = bqn[ks]; }
        float grp[16];
#pragma unroll
        for (int r = 0; r < 16; ++r) grp[r] = __uint_as_float((__float_as_uint(acc[r]) & ~0x7Fu) | (unsigned)(nt * 32 + crow(r, hi)));
        bsort16(grp);
        if (nt == 0) {
#pragma unroll
          for (int i = 0; i < 16; ++i) lst[i] = grp[i];
        } else bmerge16(lst, grp);
        SBAR();
      }
      float oth[16];
#pragma unroll
      for (int i = 0; i < 16; ++i) { auto rr_ = __builtin_amdgcn_permlane32_swap(__float_as_uint(lst[i]), __float_as_uint(lst[i]), false, false); oth[i] = __uint_as_float(hi ? rr_[0] : rr_[1]); }
      bmerge16(lst, oth);
      if (hi == 0) {
        unsigned w[4];
#pragma unroll
        for (int i = 0; i < 4; ++i)
          w[i] = (__float_as_uint(lst[4 * i]) & 0x7Fu) | ((__float_as_uint(lst[4 * i + 1]) & 0x7Fu) << 8) | ((__float_as_uint(lst[4 * i + 2]) & 0x7Fu) << 16) | ((__float_as_uint(lst[4 * i + 3]) & 0x7Fu) << 24);
        *(u32x4*)(IDX + ((r32 * 8 + h) * 2 + pp) * 16) = (u32x4){w[0], w[1], w[2], w[3]};
      }
    }
    float best[16];
#define CAND(i, j) __uint_as_float((__float_as_uint(__uint_as_float(__float_as_uint(top[0][i]) & ~0x7Fu) + __uint_as_float(__float_as_uint(top[1][j]) & ~0x7Fu)) & ~0xFFu) | (unsigned)((i) * 16 + (j)))
    {
#pragma unroll
      for (int j = 0; j < 16; ++j) best[j] = CAND(0, j);
      float y[16];
#pragma unroll
      for (int j = 0; j < 8; ++j) { y[j] = CAND(1, j); y[8 + j] = CAND(15 - j, 0); }
#pragma unroll
      for (int jj = 8; jj > 0; jj >>= 1)
#pragma unroll
        for (int i = 0; i < 16; ++i) { const int q = i ^ jj; if (q > i) { const float hi_ = fmaxf(y[i], y[q]), lo_ = fminf(y[i], y[q]); y[i] = hi_; y[q] = lo_; } }
      bmerge16(best, y);
      float x[16];
      x[0] = CAND(2, 0); x[1] = CAND(2, 1); x[2] = CAND(2, 2); x[3] = CAND(2, 3); x[4] = CAND(2, 4);
      x[5] = CAND(3, 0); x[6] = CAND(3, 1); x[7] = CAND(3, 2); x[8] = CAND(3, 3);
      x[9] = CAND(4, 0); x[10] = CAND(4, 1); x[11] = CAND(4, 2);
      x[12] = CAND(5, 0); x[13] = CAND(5, 1); x[14] = CAND(6, 0); x[15] = CAND(6, 1);
      bsort16(x);
      bmerge16(best, x);
      ins16(best, CAND(7, 0)); ins16(best, CAND(7, 1));
    }
#undef CAND
    asm volatile("s_waitcnt lgkmcnt(0)" ::: "memory");
    if (hi == 0) {
      const unsigned char* ib = IDX + ((r32 * 8 + h) * 2) * 16;
      const float mx = __uint_as_float(__float_as_uint(best[0]) & ~0xFFu);
      float w[16]; float sum = 0.f;
#pragma unroll
      for (int k = 0; k < 16; ++k) { w[k] = __expf(__uint_as_float(__float_as_uint(best[k]) & ~0xFFu) - mx); sum += w[k]; }
      const float rsum = 1.f / sum;
      int ee[16]; float su_[16], sv_[16];
#pragma unroll
      for (int k = 0; k < 16; ++k) {
        const unsigned ij = __float_as_uint(best[k]) & 0xFFu;
        ee[k] = (int)ib[ij >> 4] * 128 + (int)ib[16 + (ij & 15)];
      }
#pragma unroll
      for (int k = 0; k < 16; ++k) { su_[k] = PSC[(size_t)l * NEXP + ee[k]]; sv_[k] = PSC[(size_t)(DEPTH + l) * NEXP + ee[k]]; }
#pragma unroll
      for (int k = 0; k < 16; ++k) {
        UE[r32 * 128 + h * 16 + k] = ee[k]; UG[r32 * 128 + h * 16 + k] = w[k] * rsum * sv_[k];
        US[r32 * 128 + h * 16 + k] = su_[k];
      }
    }
  }
  __syncthreads();
#pragma unroll 1
  for (int tt = 0; tt < 4; ++tt) {
    const int t = wid * 4 + tt;
    const int k0 = UE[t * 128 + lane], k1 = UE[t * 128 + 64 + lane];
    const float g0 = UG[t * 128 + lane], g1 = UG[t * 128 + 64 + lane], s0 = US[t * 128 + lane], s1 = US[t * 128 + 64 + lane];
    const int b0 = k0 >> 10, b1 = k1 >> 10;
    int base = 0, pos0 = 0, pos1 = 0;
#pragma unroll
    for (int b = 0; b < 16; ++b) {
      const unsigned long long m0 = __ballot(b0 == b), m1 = __ballot(b1 == b);
      const int c0 = __popcll(m0), c1 = __popcll(m1);
      const unsigned long long lt = (1ull << lane) - 1ull;
      if (b0 == b) pos0 = base + __popcll(m0 & lt);
      if (b1 == b) pos1 = base + c0 + __popcll(m1 & lt);
      base += c0 + c1;
    }
    const size_t ro = (size_t)(row0 + t) * 128;
    EIDG[ro + pos0] = k0; GWG[ro + pos0] = g0; SUG[ro + pos0] = s0;
    EIDG[ro + pos1] = k1; GWG[ro + pos1] = g1; SUG[ro + pos1] = s1;
  }
}
#define CAS __attribute__((address_space(4)))
typedef int i32x8 __attribute__((ext_vector_type(8)));
struct TokPref { f32x2 gs0, gs1; u32x4 hA, hB; };
struct RowPipe { i32x6 uq[4], vq[4]; i32x8 Ec; };
struct EpiVec { f32x4 g2[4], ng[4], sc[4], sh[4]; int mr; };
__device__ __forceinline__ const CAS i32x8* eid_row(const CAS unsigned char* eidg, int row) {
  return (const CAS i32x8*)(eidg + (size_t)(unsigned)__builtin_amdgcn_readfirstlane(row) * 512u);
}
__device__ __forceinline__ void tok_prefetch(const Params& p, int row, int lane, TokPref& t) {
  const float* GWG = (const float*)(p.ws + WS_ULOC + RT_STRIDE) + (size_t)row * 128;
  const float* SUG = (const float*)(p.ws + WS_ULOC + 2 * RT_STRIDE) + (size_t)row * 128;
  const bf16_t* H = (const bf16_t*)(p.ws + WS_H);
  t.gs0 = f32x2{GWG[lane], SUG[lane]}; t.gs1 = f32x2{GWG[64 + lane], SUG[64 + lane]};
  t.hA = *(const u32x4*)(H + (size_t)row * DM + lane * 16); t.hB = *(const u32x4*)(H + (size_t)row * DM + lane * 16 + 8);
}
#define LOADPAIR(dst_, tofs_, ea_, eb_) do { const u32x3v a_ = __builtin_amdgcn_raw_buffer_load_b96(rsT, lane12, (ea_) * PROW + (tofs_), 0); const unsigned b0_ = __builtin_amdgcn_raw_buffer_load_b32(rsT, lane12, (eb_) * PROW + (tofs_), 0); \
      const u32x2v b1_ = __builtin_amdgcn_raw_buffer_load_b64(rsT, lane12 + 4, (eb_) * PROW + (tofs_), 0); \
      dst_[0] = (int)a_.x; dst_[1] = (int)a_.y; dst_[2] = (int)a_.z; dst_[3] = (int)b0_; dst_[4] = (int)b1_.x; dst_[5] = (int)b1_.y; } while (0)
#define LOADGROUP(q_, tofs_, E_) do { LOADPAIR(q_[0], tofs_, E_[0], E_[1]); LOADPAIR(q_[1], tofs_, E_[2], E_[3]); LOADPAIR(q_[2], tofs_, E_[4], E_[5]); LOADPAIR(q_[3], tofs_, E_[6], E_[7]); } while (0)
constexpr int VOFS = (int)(WS_PV - WS_PU);
__device__ __forceinline__ void gather_token(const Params& p, const CAS unsigned char* eidg, const __amdgpu_buffer_rsrc_t rsT, int l, int row, int nextrow, TokPref& tp, RowPipe& rp, EpiVec& ev, unsigned char* lds, int lane, int wid) {
  f32x2* GS = (f32x2*)(lds + wid * 2048);
  float* XC = (float*)(p.ws + WS_XCUR);
  const float* MOD = (const float*)(p.ws + WS_MOD);
  const CAS i32x8* EP = eid_row(eidg, row);
  const bool hasnext = nextrow >= 0;
  const CAS i32x8* EPn = eid_row(eidg, hasnext ? nextrow : row);
  GS[lane] = tp.gs0; GS[64 + lane] = tp.gs1;
  asm volatile("s_waitcnt lgkmcnt(0)" ::: "memory");
  const int eofl = ((lane >> 5) & 1) + 2 * ((lane >> 4) & 1) + 4 * ((lane >> 3) & 1);
  const int lane12 = lane * 12;
  {
    h16x2 hh[8];
    {
      const u32x4 hA = tp.hA, hB = tp.hB;
      hh[0] = __builtin_bit_cast(h16x2, __builtin_amdgcn_cvt_pkrtz(bflo(hA.x), bfhi(hA.x))); hh[1] = __builtin_bit_cast(h16x2, __builtin_amdgcn_cvt_pkrtz(bflo(hA.y), bfhi(hA.y))); hh[2] = __builtin_bit_cast(h16x2, __builtin_amdgcn_cvt_pkrtz(bflo(hA.z), bfhi(hA.z))); hh[3] = __builtin_bit_cast(h16x2, __builtin_amdgcn_cvt_pkrtz(bflo(hA.w), bfhi(hA.w)));
      hh[4] = __builtin_bit_cast(h16x2, __builtin_amdgcn_cvt_pkrtz(bflo(hB.x), bfhi(hB.x))); hh[5] = __builtin_bit_cast(h16x2, __builtin_amdgcn_cvt_pkrtz(bflo(hB.y), bfhi(hB.y))); hh[6] = __builtin_bit_cast(h16x2, __builtin_amdgcn_cvt_pkrtz(bflo(hB.z), bfhi(hB.z))); hh[7] = __builtin_bit_cast(h16x2, __builtin_amdgcn_cvt_pkrtz(bflo(hB.w), bfhi(hB.w)));
    }
    if (hasnext) tok_prefetch(p, nextrow, lane, tp);
    { const int mr_ = mod_row(row);
      if (mr_ != ev.mr) {
        const float* g2_ = MOD + ((size_t)l * 5 + mr_) * 6144 + 5 * 1024 + lane * 16;
        const float* ng_ = (l == DEPTH - 1 ? p.in[I_FINALG] : p.in[I_N1G] + (l + 1) * DM) + lane * 16;
        const float* m_ = MOD + ((size_t)(l == DEPTH - 1 ? l : l + 1) * 5 + mr_) * 6144 + lane * 16;
#pragma unroll
        for (int v4 = 0; v4 < 4; ++v4) { ev.g2[v4] = *(const f32x4*)(g2_ + v4 * 4); ev.ng[v4] = *(const f32x4*)(ng_ + v4 * 4); ev.sc[v4] = *(const f32x4*)(m_ + 1024 + v4 * 4); ev.sh[v4] = *(const f32x4*)(m_ + v4 * 4); }
        ev.mr = mr_;
      } }
    f32x4 xpre[4];
    { const float* xr_ = XC + (size_t)row * DM + lane * 16;
#pragma unroll
      for (int v4 = 0; v4 < 4; ++v4) xpre[v4] = *(const f32x4*)(xr_ + v4 * 4); }
    f32x2 acc2[8];
#pragma unroll
    for (int i = 0; i < 8; ++i) acc2[i] = f32x2{0.f, 0.f};
#pragma unroll 1
    for (int g8 = 0; g8 < 16; ++g8) {
      const bool pf = (g8 < 15) || hasnext;
      const f32x2 gs = GS[g8 * 8 + eofl];
      float d[8];
#pragma unroll
      for (int i2 = 0; i2 < 4; ++i2) {
        const h16x32 r = __builtin_amdgcn_cvt_scalef32_pk32_f16_fp6(rp.uq[i2], 1.0f);
        float a0 = 0.f, a1 = 0.f, b0 = 0.f, b1 = 0.f;
#define UDOT(k_) a0 = __builtin_amdgcn_fdot2(__builtin_shufflevector(r, r, 4 * (k_), 4 * (k_) + 1), hh[2 * (k_)], a0, false); b0 = __builtin_amdgcn_fdot2(__builtin_shufflevector(r, r, 16 + 4 * (k_), 17 + 4 * (k_)), hh[2 * (k_)], b0, false); \
        a1 = __builtin_amdgcn_fdot2(__builtin_shufflevector(r, r, 4 * (k_) + 2, 4 * (k_) + 3), hh[2 * (k_) + 1], a1, false); b1 = __builtin_amdgcn_fdot2(__builtin_shufflevector(r, r, 18 + 4 * (k_), 19 + 4 * (k_)), hh[2 * (k_) + 1], b1, false);
        UDOT(0) UDOT(1) UDOT(2) UDOT(3)
#undef UDOT
        d[2 * i2] = a0 + a1;
        d[2 * i2 + 1] = b0 + b1;
        asm volatile("" : "+v"(d[2 * i2]), "+v"(d[2 * i2 + 1]));
      }
      if (pf) LOADGROUP(rp.uq, 0, rp.Ec);
      float tot;
      {
        auto s01 = __builtin_amdgcn_permlane32_swap(__float_as_uint(d[0]), __float_as_uint(d[1]), false, false);
        auto s23 = __builtin_amdgcn_permlane32_swap(__float_as_uint(d[2]), __float_as_uint(d[3]), false, false);
        auto s45 = __builtin_amdgcn_permlane32_swap(__float_as_uint(d[4]), __float_as_uint(d[5]), false, false);
        auto s67 = __builtin_amdgcn_permlane32_swap(__float_as_uint(d[6]), __float_as_uint(d[7]), false, false);
        const float q01 = __uint_as_float(s01[0]) + __uint_as_float(s01[1]), q23 = __uint_as_float(s23[0]) + __uint_as_float(s23[1]);
        const float q45 = __uint_as_float(s45[0]) + __uint_as_float(s45[1]), q67 = __uint_as_float(s67[0]) + __uint_as_float(s67[1]);
        auto ta = __builtin_amdgcn_permlane16_swap(__float_as_uint(q01), __float_as_uint(q23), false, false);
        auto tb = __builtin_amdgcn_permlane16_swap(__float_as_uint(q45), __float_as_uint(q67), false, false);
        const float r0123 = __uint_as_float(ta[0]) + __uint_as_float(ta[1]);
        const float r4567 = __uint_as_float(tb[0]) + __uint_as_float(tb[1]);
        const bool b3 = (lane & 8) != 0;
        const float keep = b3 ? r4567 : r0123, send = b3 ? r0123 : r4567;
        float x = keep + dpp_mov<0x140>(send);
        x += dpp_mov<0xB1>(x); x += dpp_mov<0x4E>(x); x += dpp_mov<0x141>(x);
        tot = x * gs.y;
      }
      float ge;
      {
        const float v = tot, av = fabsf(v), tq = __builtin_amdgcn_rcpf(av * 0.2316418882f + 1.0f);
        float q = tq * 0.5307027145f + (-0.7265760135f); q = q * tq + 0.7107068705f; q = q * tq + (-0.142248368f); q = q * tq + 0.127414796f; q = q * tq;
        const float ex = __builtin_amdgcn_exp2f(v * v * (-0.72134752044f));
        const float m = v * (q * ex), r = v - m;
        ge = (v < 0.f ? m : r) * gs.x;
      }
      unsigned cw[8];
      { const unsigned gp = __builtin_bit_cast(unsigned, __builtin_amdgcn_cvt_pkrtz(ge * 1024.f, ge * 1024.f));
        cw[0] = (unsigned)__builtin_amdgcn_readlane((int)gp, 0);  cw[4] = (unsigned)__builtin_amdgcn_readlane((int)gp, 8);
        cw[2] = (unsigned)__builtin_amdgcn_readlane((int)gp, 16); cw[6] = (unsigned)__builtin_amdgcn_readlane((int)gp, 24);
        cw[1] = (unsigned)__builtin_amdgcn_readlane((int)gp, 32); cw[5] = (unsigned)__builtin_amdgcn_readlane((int)gp, 40);
        cw[3] = (unsigned)__builtin_amdgcn_readlane((int)gp, 48); cw[7] = (unsigned)__builtin_amdgcn_readlane((int)gp, 56); }
      h16x2 a16[8];
#pragma unroll
      for (int i2 = 0; i2 < 4; ++i2) {
        const h16x32 r = __builtin_amdgcn_cvt_scalef32_pk32_f16_fp6(rp.vq[i2], 1.0f);
        const h16x2 ca = __builtin_bit_cast(h16x2, cw[2 * i2]), cb = __builtin_bit_cast(h16x2, cw[2 * i2 + 1]);
#define VAXL(k_) a16[k_] = (i2 == 0) ? ca * __builtin_shufflevector(r, r, 2 * (k_), 2 * (k_) + 1) : ca * __builtin_shufflevector(r, r, 2 * (k_), 2 * (k_) + 1) + a16[k_];
#define VAXH(k_) a16[k_] = cb * __builtin_shufflevector(r, r, 16 + 2 * (k_), 17 + 2 * (k_)) + a16[k_];
        VAXL(0) VAXL(1) VAXL(2) VAXL(3) VAXL(4) VAXL(5) VAXL(6) VAXL(7)
        asm volatile("" : "+v"(a16[0]), "+v"(a16[1]), "+v"(a16[2]), "+v"(a16[3]), "+v"(a16[4]), "+v"(a16[5]), "+v"(a16[6]), "+v"(a16[7]));
        VAXH(0) VAXH(1) VAXH(2) VAXH(3) VAXH(4) VAXH(5) VAXH(6) VAXH(7)
#undef VAXL
#undef VAXH
        asm volatile("" : "+v"(a16[0]), "+v"(a16[1]), "+v"(a16[2]), "+v"(a16[3]), "+v"(a16[4]), "+v"(a16[5]), "+v"(a16[6]), "+v"(a16[7]));
      }
#pragma unroll
      for (int k = 0; k < 8; ++k) acc2[k] = f32x2{(float)a16[k].x, (float)a16[k].y} * f32x2{1.f / 1024.f, 1.f / 1024.f} + acc2[k];
      if (pf) LOADGROUP(rp.vq, VOFS, rp.Ec);
      { const CAS i32x8* src_ = g8 < 14 ? EP + (g8 + 2) : EPn + (g8 - 14); rp.Ec = *src_; }
    }
    SBAR();
    float acc[16];
#pragma unroll
    for (int i = 0; i < 8; ++i) { acc[2 * i] = acc2[i].x; acc[2 * i + 1] = acc2[i].y; }
    float* xr = XC + (size_t)row * DM;
    float xn[16]; float ssq = 0.f;
    if (ABL & 8) {
#pragma unroll
      for (int i = 0; i < 16; ++i) acc[i] = 0.f;
    }
#pragma unroll
    for (int v4 = 0; v4 < 4; ++v4) {
      const int c = lane * 16 + v4 * 4;
      const f32x4 xo = xpre[v4], gg = ev.g2[v4];
      f32x4 o;
      o.x = xo.x + gg.x * acc[v4 * 4 + 0]; o.y = xo.y + gg.y * acc[v4 * 4 + 1]; o.z = xo.z + gg.z * acc[v4 * 4 + 2]; o.w = xo.w + gg.w * acc[v4 * 4 + 3];
      xn[v4 * 4 + 0] = o.x; xn[v4 * 4 + 1] = o.y; xn[v4 * 4 + 2] = o.z; xn[v4 * 4 + 3] = o.w;
      ssq += (o.x * o.x + o.y * o.y) + (o.z * o.z + o.w * o.w);
      if (l < DEPTH - 1) *(f32x4*)(xr + c) = o;
    }
    const float rs = rsqrtf(wave_sum_fast(ssq) * (1.f / DM) + EPS);
    if (l == DEPTH - 1) {
      const int b = row / SEGL, s = row - b * SEGL;
      float* orow = p.out + ((size_t)(b * SEQ + (s - CTXL))) * DM;
#pragma unroll
      for (int v4 = 0; v4 < 4; ++v4) {
        const int c = lane * 16 + v4 * 4;
        const f32x4 gg = ev.ng[v4];
        f32x4 o; o.x = xn[v4 * 4 + 0] * rs * gg.x; o.y = xn[v4 * 4 + 1] * rs * gg.y; o.z = xn[v4 * 4 + 2] * rs * gg.z; o.w = xn[v4 * 4 + 3] * rs * gg.w;
        *(f32x4*)(orow + c) = o;
      }
    } else {
      bf16_t* hrow = (bf16_t*)(p.ws + WS_H) + (size_t)row * DM;
#pragma unroll
      for (int hh = 0; hh < 2; ++hh) {
        float y[8];
#pragma unroll
        for (int i = 0; i < 8; ++i) { const int q_ = hh * 2 + (i >> 2), e_ = i & 3; y[i] = xn[hh * 8 + i] * rs * ev.ng[q_][e_] * (1.f + ev.sc[q_][e_]) + ev.sh[q_][e_]; }
        u32x4 w; w.x = cvtpk(y[0], y[1]); w.y = cvtpk(y[2], y[3]); w.z = cvtpk(y[4], y[5]); w.w = cvtpk(y[6], y[7]);
        *(u32x4*)(hrow + lane * 16 + hh * 8) = w;
      }
    }
  }
}

__device__ __forceinline__ void ev_signal(unsigned* ctr) {
  asm volatile("s_waitcnt vmcnt(0)" ::: "memory");
  __syncthreads();
  if (tidx() == 0) { __builtin_amdgcn_fence(__ATOMIC_RELEASE, "agent"); asm volatile("s_waitcnt vmcnt(0)" ::: "memory"); (void)xb_add(ctr, 1u); }
}
__device__ __forceinline__ void ev_wait(unsigned* ctr, unsigned n, unsigned* bar) {
  if (tidx() == 0) {
    XB_SPIN(xb_ld(ctr) < n, bar);
    __builtin_amdgcn_fence(__ATOMIC_ACQUIRE, "agent");
    asm volatile("s_waitcnt vmcnt(0)" ::: "memory");
  }
  __syncthreads();
}
constexpr int EV_WORD0 = 8192;
__device__ __forceinline__ void phase_c1(const Params& p, int l, unsigned char* lds) {
  constexpr int NLOC = NBATCH * 4 * NCH, NCONV = T / 32;
  for (int u = p.bx; u < NLOC + NCONV; u += p.gx) {
    if (u < NLOC) ml_local_unit2(p, l, u, lds);
    else {
      const int cu = u - NLOC;
      if (l == DEPTH - 1 && (cu % (SEGL / 32)) < (CTXL / 32)) continue;
      conv_unit(p, l, cu, lds);
    }
  }
}
__device__ __forceinline__ void phase_c3(const Params& p, int l, unsigned char* lds);
__device__ __forceinline__ void phase_c2(const Params& p, int l, unsigned char* lds) {
  unsigned* ev = (unsigned*)(p.ws + WS_CTL) + EV_WORD0 + 64 * l;
  ml_scan(p, lds);
  ev_signal(ev);
  const float* lp = p.in[I_DLAM] + l * 256;
  float s01 = 0.f, s23 = 0.f;
  for (int i = 0; i < 64; ++i) { s01 += lp[i] * lp[64 + i]; s23 += lp[128 + i] * lp[192 + i]; }
  const float lam_init = 0.8f - 0.6f * expf(-0.3f * (float)l);
  const float lam = __uint_as_float((unsigned)__builtin_amdgcn_readfirstlane((int)__float_as_uint(expf(s01) - expf(s23) + lam_init)));
  const bf16_t* PROJ = (const bf16_t*)(p.ws + WS_PROJ);
  bf16_t* MIX = (bf16_t*)(p.ws + WS_MIX);
  const float* ng = p.in[I_DNORMG] + l * 128;
  const int nun = 512 + (l < DEPTH - 1 ? 16 : 0);
  for (int u = p.bx; u < nun; u += p.gx) {
    int bh, qrow, nkeys;
    if (u < 512) { const int xcd = u & 7, i = (u >> 3) & 31, rnd = u >> 8; bh = 2 * xcd + rnd; qrow = CTXL + i * 256; nkeys = SEGL; }
    else { bh = u - 512; qrow = 0; nkeys = CTXL; }
    const int b = bh >> 2, h = bh & 3;
    const size_t tok0 = (size_t)b * SEGL;
    for (int rep = 0; rep < REP_ATT; ++rep)
    att_unit(p.ws + WS_QK8 + ((size_t)bh * SEGL + qrow) * QK8_PITCH, p.ws + WS_QK8 + QK8_IMG + (size_t)bh * SEGL * QK8_PITCH, p.ws + WS_V8T + (size_t)bh * NCH * ATT_SHM_V,
             MIX + (tok0 + qrow) * DM + 512 + h * 128, nkeys, lam, ng, 1.f - lam_init, lds);
  }
  ev_wait(ev, (unsigned)p.gx, p.xbar_words);
  for (int rep = 0; rep < REP_ML; ++rep) phase_c3(p, l, lds);
}
__device__ __forceinline__ void phase_c3(const Params& p, int l, unsigned char* lds) {
  constexpr int NU = NBATCH * 4 * NCH;
  const int nlow = (p.gx > 64 && l < DEPTH - 1) ? 16 : 0, ulow = nlow * 7;
  int u, step;
  if (p.bx < nlow) { u = p.bx; step = nlow; } else { u = ulow + (p.bx - nlow); step = p.gx - nlow; }
  const int uend = p.bx < nlow ? ulow : NU;
  int tid_ = tidx(); asm volatile("" : "+v"(tid_));
  auto valid_from = [&](int v) { while (v < uend && l == DEPTH - 1 && (v % NCH) < 4) v += step; return v < uend ? v : -1; };
  MlOutPf fa, fb;
  u = valid_from(u);
  if (u >= 0) ml_out_fetch(p, u, tid_, fa);
  while (u >= 0) {
    const int nx = valid_from(u + step);
    ml_out_unit2(p, l, u, lds, fa, nx, fb);
    fa = fb; u = nx;
  }
}
__device__ __forceinline__ void phase_route(const Params& p, int l, unsigned char* lds) {
  constexpr int NU = T / 32;
  for (int u = p.bx; u < NU; u += p.gx) {
    if (l == DEPTH - 1 && (u % (SEGL / 32)) < (CTXL / 32)) continue;
    route_unit(p, l, u, lds);
    __syncthreads();
  }
}
__device__ __forceinline__ void phase_gather(const Params& p, int l, unsigned char* lds) {
  int tid_ = tidx(); asm volatile("" : "+v"(tid_)); const int lane = tid_ & 63, wid = __builtin_amdgcn_readfirstlane(tid_ >> 6);
  const int gw = p.bx * 8 + wid, NGW = p.gx * 8;
  const int ntok = (l == DEPTH - 1) ? NBATCH * SEQ : T;
#define TOKROW(ti_) ((l == DEPTH - 1) ? ((ti_) / SEQ) * SEGL + CTXL + ((ti_) % SEQ) : (ti_))
  const CAS unsigned char* eidg = (const CAS unsigned char*)(p.ws + WS_EID + (size_t)l * RT_STRIDE);
  const __amdgpu_buffer_rsrc_t rsT = __builtin_amdgcn_make_buffer_rsrc((void*)(p.ws + WS_PU + (size_t)l * NEXP * PROW), 0, VOFS + NEXP * PROW, 0x00020000);
  const int nfull = ntok / NGW, rem = ntok - nfull * NGW, per = (rem % p.gx == 0) ? rem / p.gx : -1;
  auto tok_at = [&](int r) -> int {
    if (r < nfull) return gw + r * NGW;
    if (r > nfull || rem == 0) return -1;
    if (per >= 0) return wid < per ? nfull * NGW + p.bx * per + wid : -1;
    return gw + r * NGW < ntok ? gw + r * NGW : -1;
  };
  TokPref tp; RowPipe rp; EpiVec ev; ev.mr = -1;
  const int ti0 = tok_at(0);
  if (ti0 >= 0) {
    const int row0 = TOKROW(ti0); const int lane12 = lane * 12;
    tok_prefetch(p, row0, lane, tp);
    const CAS i32x8* EP0 = eid_row(eidg, row0);
    rp.Ec = EP0[0];
    LOADGROUP(rp.uq, 0, rp.Ec); LOADGROUP(rp.vq, VOFS, rp.Ec);
    rp.Ec = EP0[1];
  }
  XcdBarrier xb; xb.bar = p.xbar_words; xb.x = p.xbar_x; xb.st = (volatile LAS unsigned*)((LAS unsigned char*)lds + p.lds_st_off);
  const int nrounds = (ntok + NGW - 1) / NGW;
  for (int r = 0; r < nrounds; ++r) {
    const int ti = tok_at(r);
    if (ti >= 0) {
      const int row = TOKROW(ti);
      const int tn = tok_at(r + 1);
      const int nxt = tn >= 0 ? TOKROW(tn) : -1;
      gather_token(p, eidg, rsT, l, row, nxt, tp, rp, ev, lds, lane, wid);
    }
#if GATHER_SYNC
    if (r + 1 < nrounds) { XcdBarrier xb2 = xb; size_t zb_ = 0; asm volatile("" : "+s"(zb_)); xb2.bar = xb.bar + zb_; xb2.x = xb.x + (unsigned)zb_; xcd_barrier(xb2); }
#endif
  }
#undef TOKROW
}

__global__ void __launch_bounds__(512, 2) mk_fwd(KArgs ka) {
  cg::grid_group grid = cg::this_grid();
  extern __shared__ __attribute__((aligned(16))) unsigned char lds[];
  const int lo = ka.ph_lo, hi = ka.ph_hi;
#define IN(k) (lo <= (k) && (k) < hi)
#ifndef PHASEMASK
#define PHASEMASK 0xFFFF
#endif
#define PH(i) ((PHASEMASK >> (i)) & 1)
#define MKP(q) Params q; { size_t z_ = 0; asm volatile("" : "+s"(z_)); \
    q.in = (InTab)((const __attribute__((address_space(4))) char*)__builtin_amdgcn_kernarg_segment_ptr() + z_); \
    q.out = ka.out + z_; q.ws = ka.ws + z_; q.ph_lo = lo; q.ph_hi = hi; q.bx = (int)blockIdx.x + (int)z_; q.gx = (int)gridDim.x + (int)z_; q.xbar_words = xbar.bar + z_; q.xbar_x = xbar.x + (unsigned)z_; q.lds_st_off = (unsigned)(LDS_BYTES - 64); }
#define SEAM(k) do { if (IN(k) && IN((k) + 1)) { if ((k) == 0) grid.sync(); else { XcdBarrier xb_ = xbar; size_t zb_ = 0; asm volatile("" : "+s"(zb_)); xb_.bar = xbar.bar + zb_; xb_.x = xbar.x + (unsigned)zb_; xcd_barrier(xb_); } } } while (0)
  volatile LAS unsigned* xst = (volatile LAS unsigned*)((LAS unsigned char*)lds + (LDS_BYTES - 64));
  { const int t0_ = threadIdx.x;
    if (t0_ < 2) xst[t0_] = 0u;
    if ((t0_ & 63) == 0) *(volatile LAS int*)((LAS unsigned char*)lds + LDS_WTAB + 4 * hw_wave_key()) = t0_ >> 6; }
  __syncthreads();
  XcdBarrier xbar = xcd_barrier_post((unsigned*)(ka.ws + WS_CTL) + 4096, xst);
  { MKP(p)
    if (PH(0) && IN(0)) for (int rep = 0; rep < REP_MISC; ++rep) { p0_mod(p, lds, (float*)(p.ws + WS_MOD)); p0_convert(p, lds); }
  }
  SEAM(0);
  { MKP(p)
    if (PH(1) && IN(1)) phase_norm(p, 0, 0, true, false);
  }
  SEAM(1);
#define LAYER(LL) { \
    int l = (LL); asm volatile("" : "+s"(l)); \
    const int b = 2 + 9 * (LL); \
    { MKP(q) if (PH(2) && IN(b + 0)) for (int rep = 0; rep < REP_GEMM; ++rep) phase_inproj2(q, l, lds); } \
    SEAM(b + 0); \
    { MKP(q) if (PH(3) && IN(b + 1)) for (int rep = 0; rep < REP_ML; ++rep) phase_c1(q, l, lds); } \
    SEAM(b + 1); \
    { MKP(q) if (PH(4) && IN(b + 2)) phase_c2(q, l, lds); } \
    SEAM(b + 3); \
    { MKP(q) if (PH(6) && IN(b + 4)) phase_outproj2(q, l, lds); } \
    SEAM(b + 4); \
    { MKP(q) if (PH(7) && IN(b + 5)) for (int rep = 0; rep < REP_MISC; ++rep) phase_norm(q, l, 1, false, (LL) == DEPTH - 1); } \
    SEAM(b + 5); \
    { MKP(q) if (PH(8) && IN(b + 6)) for (int rep = 0; rep < REP_GEMM; ++rep) phase_peerq2(q, l, lds); } \
    SEAM(b + 6); \
    { MKP(q) if (PH(9) && IN(b + 7)) phase_route(q, l, lds); } \
    SEAM(b + 7); \
    { MKP(q) if (PH(9) && IN(b + 8)) phase_gather(q, l, lds); } \
    SEAM(b + 8); }
  LAYER(0) LAYER(1) LAYER(2) LAYER(3)
#undef LAYER
#undef IN
#undef SEAM
#undef MKP
}

extern "C" void kernel_launch(void* const* d_in, const int* in_sizes, int n_in, void* d_out, int out_size,
                              void* d_ws, size_t ws_size, hipStream_t stream) {
  static int grid = 0;
  if (grid == 0) {
    int dev = 0, cus = 0, per_cu = 0;
    (void)hipGetDevice(&dev);
    (void)hipDeviceGetAttribute(&cus, hipDeviceAttributeMultiprocessorCount, dev);
    (void)hipFuncSetAttribute((const void*)mk_fwd, hipFuncAttributeMaxDynamicSharedMemorySize, LDS_BYTES);
    (void)hipOccupancyMaxActiveBlocksPerMultiprocessor(&per_cu, (const void*)mk_fwd, 512, LDS_BYTES);
    fprintf(stderr, "kernel_launch: cus %d per_cu %d ws %zu (need %zu) n_in %d\n", cus, per_cu, ws_size, (size_t)WS_END, n_in);
    if (ws_size < WS_END || n_in != 23 || per_cu < 1) { fprintf(stderr, "kernel_launch: bad configuration, nothing launched\n"); grid = -1; return; }
    grid = cus;
  }
  if (grid < 0) return;
  (void)hipMemsetAsync((char*)d_ws + WS_CTL, 0, 65536, stream);
  KArgs p{};
  for (int i = 0; i < 23; ++i) p.in[i] = (const float*)d_in[i];
  p.out = (float*)d_out; p.ws = (unsigned char*)d_ws; p.ph_lo = 0; p.ph_hi = 38;
  void* args[] = {&p};
  hipError_t e = hipLaunchCooperativeKernel((const void*)mk_fwd, dim3(grid), dim3(512), args, LDS_BYTES, stream);
  if (e != hipSuccess) fprintf(stderr, "cooperative launch failed: %s (grid %d)\n", hipGetErrorString(e), grid);
}
```

```cpp
#include <hip/hip_runtime.h>
#include <hip/hip_cooperative_groups.h>
#include <cstdio>
#include <cstdint>
namespace cg = cooperative_groups;

constexpr int DM = 1024, NBATCH = 4, SEQ = 8192, CTXL = 256, SEGL = CTXL + SEQ, T = NBATCH * SEGL, DEPTH = 4;
constexpr int IN_W = 3088, PW = 3072;
constexpr int QK8_PITCH = 144; constexpr size_t QK8_IMG = (size_t)16 * SEGL * QK8_PITCH;
constexpr int C_A = 0, C_MQ = 512, C_MK = 768, C_MV = 1024, C_MO = 1280, C_DQ = 1536, C_DK = 2048, C_DV = 2560;
constexpr int NCH = SEGL / 64;
constexpr int NEXP = 16384;
constexpr float EPS = 1e-6f;
#ifndef ABL
#define ABL 0
#endif
#ifndef GATHER_SYNC
#define GATHER_SYNC 0
#endif
#ifndef REP_ATT
#define REP_ATT 1
#endif
#ifndef GP_MASK
#define GP_MASK 0x3FFF
#endif
#ifndef REP_PEER
#define REP_PEER 1
#endif
#ifndef REP_GEMM
#define REP_GEMM 1
#endif
#ifndef REP_ROUTE
#define REP_ROUTE 1
#endif
#ifndef REP_OUTP
#define REP_OUTP 1
#endif
#ifndef REP_ML
#define REP_ML 1
#endif
#ifndef REP_MISC
#define REP_MISC 1
#endif
constexpr float QSCALE = 0.125f * 1.4426950408889634f;

constexpr size_t MiB = 1u << 20;
constexpr size_t WS_CTL = 0, WS_MOD = 1 * MiB, WS_ROPE = 2 * MiB, WS_WG = 4 * MiB, WS_KEYS = 5 * MiB, WS_MLMETA = 6 * MiB,
                 WS_GATES = 7 * MiB, WS_WIN = 10 * MiB, WS_WOUT = 34 * MiB, WS_WQ = 42 * MiB, WS_PU = 50 * MiB, WS_PV = 114 * MiB, WS_PSC = 178 * MiB  ,
                 WS_XCUR = 306 * MiB, WS_H = 438 * MiB, WS_MIX = 504 * MiB, WS_PROJ = 570 * MiB, WS_ULOC = 768 * MiB, WS_V8T = 836 * MiB  , WS_EID = 858 * MiB  , WS_QK8 = 924 * MiB  , WS_END = 964 * MiB;
constexpr int USTRIDE = 4160;

constexpr int LDS_BYTES = 139264 + 512;
constexpr int LDS_WTAB = LDS_BYTES - 64 - 256;

#define LAS __attribute__((address_space(3)))
__device__ __forceinline__ int hw_wave_key() { return (int)(__builtin_amdgcn_s_getreg((5 << 11) | 4) & 63u); }
__device__ __forceinline__ int tidx() {
  extern __shared__ __attribute__((aligned(16))) unsigned char lds_dyn_[];
  const int w = __builtin_amdgcn_readfirstlane(*(const volatile LAS int*)((LAS unsigned char*)lds_dyn_ + LDS_WTAB + 4 * hw_wave_key()));
  unsigned z_ = 0u; asm volatile("" : "+v"(z_));
  return (w << 6) | (int)__builtin_amdgcn_mbcnt_hi(~0u, __builtin_amdgcn_mbcnt_lo(~0u, z_));
}
typedef unsigned short bf16_t;
typedef short bf16x8 __attribute__((ext_vector_type(8)));
typedef short s16x4 __attribute__((ext_vector_type(4)));
typedef float f32x4 __attribute__((ext_vector_type(4)));
typedef float f32x16 __attribute__((ext_vector_type(16)));
typedef unsigned u32x4 __attribute__((ext_vector_type(4)));
typedef unsigned u32x2 __attribute__((ext_vector_type(2)));
typedef __bf16 bf16x2v __attribute__((ext_vector_type(2)));
typedef int i32x8 __attribute__((ext_vector_type(8)));
typedef int i32x6 __attribute__((ext_vector_type(6)));
struct __attribute__((aligned(4))) u32x3 { unsigned x, y, z; };
typedef float f32x32 __attribute__((ext_vector_type(32)));
constexpr int PROW = 768;
typedef float f32x2 __attribute__((ext_vector_type(2)));
typedef _Float16 h16x2 __attribute__((ext_vector_type(2)));
typedef _Float16 h16x32 __attribute__((ext_vector_type(32)));
typedef unsigned u32x3v __attribute__((ext_vector_type(3)));
typedef unsigned u32x2v __attribute__((ext_vector_type(2)));

struct KArgs {
  const float* in[23];
  float* out;
  unsigned char* ws;
  int ph_lo, ph_hi;
};
typedef const float* const __attribute__((address_space(4))) * InTab;
struct Params {
  InTab in;
  float* out;
  unsigned char* ws;
  int ph_lo, ph_hi;
  int bx, gx;
  unsigned* xbar_words; unsigned xbar_x; unsigned lds_st_off;
};
enum { I_X = 0, I_C, I_CTX, I_CCTX, I_ADAW, I_ADAB, I_N1G, I_N2G, I_WIN, I_CONVW, I_CONVB, I_CLNG, I_CLNB, I_GATEB, I_MNORMG, I_DLAM, I_DNORMG,
       I_WOUT, I_PWQ, I_PKEYS, I_PU, I_PV, I_FINALG };

__device__ __forceinline__ unsigned cvtpk(float lo, float hi) { unsigned r; asm volatile("v_cvt_pk_bf16_f32 %0, %1, %2" : "=v"(r) : "v"(lo), "v"(hi)); return r; }
__device__ __forceinline__ float bflo(unsigned u) { return __uint_as_float(u << 16); }
__device__ __forceinline__ float bfhi(unsigned u) { return __uint_as_float(u & 0xffff0000u); }
__device__ __forceinline__ float bf1(bf16_t u) { return __uint_as_float(((unsigned)u) << 16); }
__device__ __forceinline__ int crow(int r, int hi) { return (r & 3) + 8 * (r >> 2) + 4 * hi; }
template <int CTRL> __device__ __forceinline__ float dpp_mov(float v) {
  return __uint_as_float((unsigned)__builtin_amdgcn_update_dpp(0, (int)__float_as_uint(v), CTRL, 0xF, 0xF, true));
}
__device__ __forceinline__ float wave_sum_fast(float x) {
  x += dpp_mov<0xB1>(x); x += dpp_mov<0x4E>(x); x += dpp_mov<0x141>(x); x += dpp_mov<0x140>(x);
  { auto r = __builtin_amdgcn_permlane16_swap(__float_as_uint(x), __float_as_uint(x), false, false); x = __uint_as_float(r[0]) + __uint_as_float(r[1]); }
  { auto r = __builtin_amdgcn_permlane32_swap(__float_as_uint(x), __float_as_uint(x), false, false); x = __uint_as_float(r[0]) + __uint_as_float(r[1]); }
  return x;
}
__device__ __forceinline__ float wave_max_fast(float x) {
  x = fmaxf(x, dpp_mov<0xB1>(x)); x = fmaxf(x, dpp_mov<0x4E>(x)); x = fmaxf(x, dpp_mov<0x141>(x)); x = fmaxf(x, dpp_mov<0x140>(x));
  { auto r = __builtin_amdgcn_permlane16_swap(__float_as_uint(x), __float_as_uint(x), false, false); x = fmaxf(__uint_as_float(r[0]), __uint_as_float(r[1])); }
  { auto r = __builtin_amdgcn_permlane32_swap(__float_as_uint(x), __float_as_uint(x), false, false); x = fmaxf(__uint_as_float(r[0]), __uint_as_float(r[1])); }
  return x;
}
template <int CTRL, int ROWMASK> __device__ __forceinline__ float dpp_mov_rm(float v) {
  return __uint_as_float((unsigned)__builtin_amdgcn_update_dpp(0, (int)__float_as_uint(v), CTRL, ROWMASK, 0xF, true));
}
__device__ __forceinline__ float wave_incl_scan(float x) {
  x += dpp_mov<0x111>(x); x += dpp_mov<0x112>(x); x += dpp_mov<0x114>(x); x += dpp_mov<0x118>(x);
  x += dpp_mov_rm<0x142, 0xA>(x);
  x += dpp_mov_rm<0x143, 0xC>(x);
  return x;
}
__device__ __forceinline__ float wave_sum(float v) { return wave_sum_fast(v); }
__device__ __forceinline__ float sum_xor32(float x) { auto r = __builtin_amdgcn_permlane32_swap(__float_as_uint(x), __float_as_uint(x), false, false); return __uint_as_float(r[0]) + __uint_as_float(r[1]); }
__device__ __forceinline__ float max_xor32(float x) { auto r = __builtin_amdgcn_permlane32_swap(__float_as_uint(x), __float_as_uint(x), false, false); return fmaxf(__uint_as_float(r[0]), __uint_as_float(r[1])); }
__device__ __forceinline__ float wave_max(float v) { return wave_max_fast(v); }
__device__ __forceinline__ float sigmoidf_(float x) { return 1.f / (1.f + __expf(-x)); }
__device__ __forceinline__ float logsigmoidf_(float x) { return fminf(x, 0.f) - log1pf(__expf(-fabsf(x))); }
__device__ __forceinline__ const float* in_row(const float* x, const float* ctx, int row) {
  const int b = row / SEGL, s = row - b * SEGL;
  return s < CTXL ? ctx + ((size_t)(b * CTXL + s)) * DM : x + ((size_t)(b * SEQ + (s - CTXL))) * DM;
}
__device__ __forceinline__ int mod_row(int row) { const int b = row / SEGL, s = row - b * SEGL; return s < CTXL ? 4 : b; }

__device__ __forceinline__ void p0_mod(const Params& p, unsigned char* lds, float* MOD) {
  float* sil = (float*)lds;
  float* red = (float*)(lds + 20480);
  int tid_ = tidx(); asm volatile("" : "+v"(tid_)); const int tid = tid_, lane = tid & 63, wid = tid >> 6;
  for (int i = tid; i < 5 * 1024; i += 512) {
    const float v = i < 4096 ? p.in[I_C][i] : p.in[I_CCTX][i - 4096];
    sil[i] = v / (1.f + __expf(-v));
  }
  __syncthreads();
  for (int item = p.bx; item < DEPTH * 96; item += p.gx) {
    const int l = item / 96, j0 = (item % 96) * 64;
    const float* W = p.in[I_ADAW] + (size_t)l * DM * 6144 + j0 + lane;
    float a0 = 0.f, a1 = 0.f, a2 = 0.f, a3 = 0.f, a4 = 0.f;
    const int k0 = wid * 128;
#pragma unroll 8
    for (int k = k0; k < k0 + 128; ++k) {
      const float w = W[(size_t)k * 6144];
      a0 += sil[k] * w; a1 += sil[1024 + k] * w; a2 += sil[2048 + k] * w; a3 += sil[3072 + k] * w; a4 += sil[4096 + k] * w;
    }
    red[(wid * 5 + 0) * 64 + lane] = a0; red[(wid * 5 + 1) * 64 + lane] = a1; red[(wid * 5 + 2) * 64 + lane] = a2;
    red[(wid * 5 + 3) * 64 + lane] = a3; red[(wid * 5 + 4) * 64 + lane] = a4;
    __syncthreads();
    if (tid < 320) {
      const int r = tid >> 6;
      float s = 0.f;
#pragma unroll
      for (int w = 0; w < 8; ++w) s += red[(w * 5 + r) * 64 + lane];
      MOD[((size_t)l * 5 + r) * 6144 + j0 + lane] = s + p.in[I_ADAB][l * 6144 + j0 + lane];
    }
    __syncthreads();
  }
}
__device__ __forceinline__ void transpose_item(const float* W, int ldw, int srccol0, bf16_t* WT, int K, int n0, int k0, float* scr, int lane) {
#pragma unroll 8
  for (int i = 0; i < 32; ++i) { const int kk = 2 * i + (lane >> 5); scr[kk * 33 + (lane & 31)] = W[(size_t)(k0 + kk) * ldw + srccol0 + (lane & 31)]; }
  asm volatile("s_waitcnt lgkmcnt(0)" ::: "memory");
  const int c = lane & 7;
#pragma unroll
  for (int j = 0; j < 4; ++j) {
    const int n = (lane >> 3) + 8 * j; const float* s = scr + (8 * c) * 33 + n;
    u32x4 o; o.x = cvtpk(s[0], s[33]); o.y = cvtpk(s[66], s[99]); o.z = cvtpk(s[132], s[165]); o.w = cvtpk(s[198], s[231]);
    *(u32x4*)(WT + (size_t)(n0 + n) * K + k0 + 8 * c) = o;
  }
  asm volatile("s_waitcnt lgkmcnt(0)" ::: "memory");
}
__device__ __forceinline__ void convert_tables(const Params& p, int L, int wv, int nw, int lane, int r_lo, int r_hi) {
  unsigned char* PUq = p.ws + WS_PU; unsigned char* PVq = p.ws + WS_PV; float* PSC = (float*)(p.ws + WS_PSC);
  const int nrows = DEPTH * NEXP;
#define TAB_SROW(r_) ((const f32x4*)(((r_) >= NEXP ? p.in[I_PV] : p.in[I_PU]) + (size_t)(L * NEXP + ((r_) >= NEXP ? (r_) - NEXP : (r_))) * DM) + lane * 4)
#define TAB_LOAD(v_, r_) do { if ((r_) < r_hi) { const f32x4* s_ = TAB_SROW(r_); _Pragma("unroll") for (int j = 0; j < 4; ++j) v_[j] = __builtin_nontemporal_load(s_ + j); } } while (0)
  auto encode_row = [&](const f32x4 (&v)[4], int r) {
    const int tb = r >= NEXP, rr = L * NEXP + (tb ? r - NEXP : r);
    float mx = 0.f;
#pragma unroll
    for (int j = 0; j < 4; ++j) mx = fmaxf(mx, fmaxf(fmaxf(fabsf(v[j].x), fabsf(v[j].y)), fmaxf(fabsf(v[j].z), fabsf(v[j].w))));
    mx = wave_max_fast(mx);
    const unsigned mb = __float_as_uint(mx);
    const int eb = (int)((mb >> 23) & 0xFFu);
    int sb = ((mb & 0x7FFFFFu) <= 0x700000u ? 129 : 128) - eb + 127; sb = sb < 1 ? 1 : (sb > 253 ? 253 : sb);
    const float sc = __uint_as_float((unsigned)sb << 23), isc = __uint_as_float((unsigned)(254 - sb) << 23);
    const float xv[16] = {v[0].x, v[0].y, v[0].z, v[0].w, v[1].x, v[1].y, v[1].z, v[1].w, v[2].x, v[2].y, v[2].z, v[2].w, v[3].x, v[3].y, v[3].z, v[3].w};
    unsigned wq[3] = {0u, 0u, 0u};
#pragma unroll
    for (int i = 0; i < 16; ++i) {
      const float a = fabsf(xv[i]) * sc;
      unsigned code = a < 2.f ? (unsigned)__builtin_rintf(a * 8.f) : (a < 4.f ? 8u + (unsigned)__builtin_rintf(a * 4.f) : 16u + (unsigned)__builtin_rintf(a * 2.f));
      code = code > 31u ? 31u : code;
      code |= (xv[i] < 0.f) ? 32u : 0u;
      const int bp = 6 * i, dw = bp >> 5, off = bp & 31;
      wq[dw] |= code << off;
      if (off > 26) wq[dw + 1] |= code >> (32 - off);
    }
    u32x3 o; o.x = wq[0]; o.y = wq[1]; o.z = wq[2];
    *(u32x3*)((tb ? PVq : PUq) + (size_t)rr * PROW + lane * 12) = o;
    if (lane == 0) PSC[(size_t)tb * nrows + rr] = isc;
  };
  f32x4 v0[4], v1[4], v2[4];
  TAB_LOAD(v0, r_lo + wv); TAB_LOAD(v1, r_lo + wv + nw);
#pragma unroll 1
  for (int r = r_lo + wv; r < r_hi; r += 3 * nw) {
    TAB_LOAD(v2, r + 2 * nw); encode_row(v0, r);
    if (r + nw < r_hi) { TAB_LOAD(v0, r + 3 * nw); encode_row(v1, r + nw); }
    if (r + 2 * nw < r_hi) { TAB_LOAD(v1, r + 4 * nw); encode_row(v2, r + 2 * nw); }
  }
#undef TAB_LOAD
#undef TAB_SROW
}
__device__ __forceinline__ void tail_filler_tables(const Params& p, int L, int nwg, int r_lo, int r_hi) {
  int tid_ = tidx(); asm volatile("" : "+v"(tid_)); const int lane = tid_ & 63, wid = tid_ >> 6;
  const int nextra = nwg % p.gx, first = nextra, nidle = p.gx - nextra;
  if (p.bx < first) return;
  convert_tables(p, L, (p.bx - first) * 8 + wid, nidle * 8, lane, r_lo, r_hi);
}
__device__ __forceinline__ void p0_convert(const Params& p, unsigned char* lds) {
  int tid_ = tidx(); asm volatile("" : "+v"(tid_)); const int tid = tid_, lane = tid & 63, wid = tid >> 6;
  const int gw = p.bx * 8 + wid, NGW = p.gx * 8;
  const size_t gt = (size_t)p.bx * 512 + tid, NGT = (size_t)p.gx * 512;
  float* scr = (float*)(lds + 32768) + wid * (64 * 33);
  bf16_t* WIN = (bf16_t*)(p.ws + WS_WIN); bf16_t* WOUT = (bf16_t*)(p.ws + WS_WOUT); bf16_t* WQ = (bf16_t*)(p.ws + WS_WQ);
  constexpr int I_IN = 16 * 96, I_O = 16 * 32, PER_L = I_IN + 2 * I_O;
  for (int it = gw; it < DEPTH * PER_L; it += NGW) {
    const int l = it / PER_L; int r = it % PER_L;
    if (r < I_IN) { const int kb = r / 96, nb = r % 96, n0 = nb * 32; const int src = n0 < 1536 ? n0 : n0 + 16;
      transpose_item(p.in[I_WIN] + (size_t)l * DM * IN_W, IN_W, src, WIN + (size_t)l * PW * DM, DM, n0, kb * 64, scr, lane); continue; }
    r -= I_IN;
    if (r < I_O) { const int kb = r / 32, nb = r % 32;
      transpose_item(p.in[I_WOUT] + (size_t)l * DM * DM, DM, nb * 32, WOUT + (size_t)l * DM * DM, DM, nb * 32, kb * 64, scr, lane); continue; }
    r -= I_O;
    { const int kb = r / 32, nb = r % 32;
      transpose_item(p.in[I_PWQ] + (size_t)l * DM * DM, DM, nb * 32, WQ + (size_t)l * DM * DM, DM, nb * 32, kb * 64, scr, lane); }
  }
  bf16_t* WG = (bf16_t*)(p.ws + WS_WG);
  for (size_t i = gt; i < (size_t)DEPTH * 16 * DM; i += NGT) {
    const int l = (int)(i / (16 * DM)), g = (int)((i / DM) % 16), k = (int)(i % DM);
    WG[i] = (bf16_t)(cvtpk(p.in[I_WIN][(size_t)l * DM * IN_W + (size_t)k * IN_W + 1536 + g], 0.f) & 0xffffu);
  }
  bf16_t* KEYS = (bf16_t*)(p.ws + WS_KEYS);
  for (size_t i = gt; i < (size_t)DEPTH * 131072 / 8; i += NGT) {
    const f32x4 a = ((const f32x4*)p.in[I_PKEYS])[2 * i], b = ((const f32x4*)p.in[I_PKEYS])[2 * i + 1];
    u32x4 o; o.x = cvtpk(a.x, a.y); o.y = cvtpk(a.z, a.w); o.z = cvtpk(b.x, b.y); o.w = cvtpk(b.z, b.w);
    ((u32x4*)KEYS)[i] = o;
  }
  {
    float* RC = (float*)(p.ws + WS_ROPE); float* RS = RC + SEQ * 32;
    for (size_t i = gt; i < (size_t)SEQ * 32; i += NGT) {
      const int pos = (int)(i >> 5), j = (int)(i & 31);
      const int rr = pos >> 6, cc = pos & 63;
      const int jj = j & 15;
      const double e = -(double)jj * 0.83048202372184058696;
      const double fl = __builtin_floor(e); const double f = e - fl;
      const double z = f * 0.69314718055994530942;
      double ez = 1.0 + z * (1.0 + z * (0.5 + z * (1.0 / 6 + z * (1.0 / 24 + z * (1.0 / 120 + z * (1.0 / 720 + z * (1.0 / 5040 + z * (1.0 / 40320 + z * (1.0 / 362880 + z * (1.0 / 3628800 + z * (1.0 / 39916800 + z * (1.0 / 479001600))))))))))));
      const double inv = __builtin_ldexp(ez, (int)fl);
      const float invf = (float)inv;
      const float angf = (float)(j < 16 ? rr : cc) * invf;
      const double ang = (double)angf;
      const double kq = __builtin_rint(ang * 0.63661977236758134308);
      double r = __builtin_fma(-kq, 1.57079632679489655800e+00, ang);
      r = __builtin_fma(-kq, 6.12323399573676603587e-17, r);
      const double r2 = r * r;
      const double sn = r * (1.0 + r2 * (-1.0 / 6 + r2 * (1.0 / 120 + r2 * (-1.0 / 5040 + r2 * (1.0 / 362880 + r2 * (-1.0 / 39916800 + r2 * (1.0 / 6227020800.0)))))));
      const double cs = 1.0 + r2 * (-0.5 + r2 * (1.0 / 24 + r2 * (-1.0 / 720 + r2 * (1.0 / 40320 + r2 * (-1.0 / 3628800 + r2 * (1.0 / 479001600 + r2 * (-1.0 / 87178291200.0)))))));
      const int q = ((int)kq) & 3;
      double co, si;
      if (q == 0) { co = cs; si = sn; } else if (q == 1) { co = -sn; si = cs; } else if (q == 2) { co = -cs; si = -sn; } else { co = sn; si = -cs; }
      RC[i] = (float)co; RS[i] = (float)si;
    }
  }
}

__device__ __forceinline__ void norm_mod_row(const float* xrow, const float* g, const float* sc, const float* sh, bf16_t* orow, int lane) {
  const f32x4* xr = (const f32x4*)xrow + lane;
  f32x4 v[4]; float s = 0.f;
#pragma unroll
  for (int j = 0; j < 4; ++j) { v[j] = xr[64 * j]; s += (v[j].x * v[j].x + v[j].y * v[j].y) + (v[j].z * v[j].z + v[j].w * v[j].w); }
  const float rs = rsqrtf(wave_sum(s) * (1.f / DM) + EPS);
  u32x2* o = (u32x2*)orow + lane;
#pragma unroll
  for (int j = 0; j < 4; ++j) {
    const f32x4 gg = ((const f32x4*)g)[lane + 64 * j], cc = ((const f32x4*)sc)[lane + 64 * j], hh = ((const f32x4*)sh)[lane + 64 * j];
    const float y0 = v[j].x * rs * gg.x * (1.f + cc.x) + hh.x, y1 = v[j].y * rs * gg.y * (1.f + cc.y) + hh.y;
    const float y2 = v[j].z * rs * gg.z * (1.f + cc.z) + hh.z, y3 = v[j].w * rs * gg.w * (1.f + cc.w) + hh.w;
    u32x2 w; w.x = cvtpk(y0, y1); w.y = cvtpk(y2, y3);
    o[64 * j] = w;
  }
}
__device__ __forceinline__ void phase_norm(const Params& p, int l, int which, bool from_input, bool skip_ctx) {
  int tid_ = tidx(); asm volatile("" : "+v"(tid_));
  const int lane = tid_ & 63, wid = tid_ >> 6;
  const int gw = p.bx * 8 + wid, NGW = p.gx * 8;
  const float* MOD = (const float*)(p.ws + WS_MOD);
  const float* XC = (const float*)(p.ws + WS_XCUR);
  bf16_t* H = (bf16_t*)(p.ws + WS_H);
  const float* g = p.in[which ? I_N2G : I_N1G] + l * DM;
  auto next_row = [&](int r_) { while (r_ < T && skip_ctx && mod_row(r_) == 4) r_ += NGW; return r_; };
  auto xrow_of = [&](int r_) { return (const f32x4*)(from_input ? in_row(p.in[I_X], p.in[I_CTX], r_) : XC + (size_t)r_ * DM) + lane; };
  f32x4 gg[4], cc[4], hh[4], v[4], vn[4];
#pragma unroll
  for (int j = 0; j < 4; ++j) gg[j] = ((const f32x4*)g)[lane + 64 * j];
  int mr_cur = -1;
  int row = next_row(gw);
  if (row < T) { const f32x4* xr = xrow_of(row);
#pragma unroll
    for (int j = 0; j < 4; ++j) v[j] = xr[64 * j]; }
  while (row < T) {
    const int nrow = next_row(row + NGW);
    if (nrow < T) { const f32x4* xn = xrow_of(nrow);
#pragma unroll
      for (int j = 0; j < 4; ++j) vn[j] = xn[64 * j]; }
    const int mr = mod_row(row);
    if (mr != mr_cur) {
      const float* m = MOD + ((size_t)l * 5 + mr) * 6144 + which * 3072;
#pragma unroll
      for (int j = 0; j < 4; ++j) { cc[j] = ((const f32x4*)(m + 1024))[lane + 64 * j]; hh[j] = ((const f32x4*)m)[lane + 64 * j]; }
      mr_cur = mr;
    }
    float s = 0.f;
#pragma unroll
    for (int j = 0; j < 4; ++j) s += (v[j].x * v[j].x + v[j].y * v[j].y) + (v[j].z * v[j].z + v[j].w * v[j].w);
    const float rs = rsqrtf(wave_sum(s) * (1.f / DM) + EPS);
    u32x2* o = (u32x2*)(H + (size_t)row * DM) + lane;
#pragma unroll
    for (int j = 0; j < 4; ++j) {
      const float y0 = v[j].x * rs * gg[j].x * (1.f + cc[j].x) + hh[j].x, y1 = v[j].y * rs * gg[j].y * (1.f + cc[j].y) + hh[j].y;
      const float y2 = v[j].z * rs * gg[j].z * (1.f + cc[j].z) + hh[j].z, y3 = v[j].w * rs * gg[j].w * (1.f + cc[j].w) + hh[j].w;
      u32x2 w; w.x = cvtpk(y0, y1); w.y = cvtpk(y2, y3);
      o[64 * j] = w;
    }
#pragma unroll
    for (int j = 0; j < 4; ++j) v[j] = vn[j];
    row = nrow;
  }
}

namespace pg8 {
#define PG8_LAS __attribute__((address_space(3)))
typedef unsigned short bf16_t;
typedef short bf16x8 __attribute__((ext_vector_type(8)));
typedef float f32x4 __attribute__((ext_vector_type(4)));
typedef unsigned u32x4 __attribute__((ext_vector_type(4)));
constexpr int BM = 256, BK = 64, HALF = 128, HTB = HALF * BK * 2  , STAGE_BYTES = 8 * HTB, NXCD = 8, WGM = 8;

__host__ __device__ __forceinline__ int lds_byte(int r, int c) { const int st = (r >> 4) * 2 + (c >> 5), rr = r & 15, cc = c & 31, ob = rr * 64 + cc * 2; return st * 1024 + (ob ^ (((ob >> 9) & 1) << 5)); }
__host__ __device__ __forceinline__ void stage_rc(int b, int& R, int& C) { const int st = b / 1024, sb = b % 1024, swz = sb ^ (((sb >> 9) & 1) << 5); R = (st >> 1) * 16 + swz / 64; C = (st & 1) * 32 + (swz % 64) / 2; }
__host__ __device__ __forceinline__ int perm32(int rho) { const int n = rho >> 4, i = rho & 15; return 8 * (i >> 2) + 4 * n + (i & 3); }

struct Unit { int pm, pn; };
struct Gemm { const bf16_t* A; const bf16_t* Bt; int M, N, K; };

struct StaticOrder {
    int nM, nN, nwg, G, c;
    __host__ __device__ void init(int M, int N, int G_, int c_) { nM = M / BM; nN = N / BM; nwg = nM * nN; G = G_; c = c_; }
    __host__ __device__ bool next(int i, Unit& u) const {
        const long L = (long)i * G + c; if (L >= nwg) return false;
        int wgid = (int)L; { const int q = nwg / NXCD, r = nwg % NXCD, xcd = wgid % NXCD, off = wgid / NXCD; wgid = (xcd < r ? xcd * (q + 1) : r * (q + 1) + (xcd - r) * q) + off; }
        const int nig = WGM * nN, gid = wgid / nig, fm = gid * WGM, gsz = (nM - fm) < WGM ? (nM - fm) : WGM;
        u.pm = fm + ((wgid % nig) % gsz); u.pn = (wgid % nig) / gsz; return true;
    }
    __device__ __forceinline__ void a_ready(const Unit&) const {}
    __device__ __forceinline__ void done(const Unit&) const {}
};
__device__ __forceinline__ unsigned cvt_pk_bf16(float lo, float hi) { unsigned r; asm volatile("v_cvt_pk_bf16_f32 %0, %1, %2" : "=v"(r) : "v"(lo), "v"(hi)); return r; }
template <class Epi, class Sched, bool ALIGN_EPI = false, bool SP2 = false>
__device__ __forceinline__ void gemm_phase(PG8_LAS unsigned char* lds, const Gemm g, const Sched& S, const Epi& E) {
    const int tid = tidx(), wid = __builtin_amdgcn_readfirstlane(tid >> 6), lane = tid & 63, wr = wid >> 2, wc = wid & 3, fr = lane & 15, fq = lane >> 4;
    const int K = g.K, nt = K / BK;
    unsigned voffA[2], voffB[2];
#pragma unroll
    for (int i = 0; i < 2; ++i) { int R, C; stage_rc(tid * 16 + i * 8192, R, C); const int Rb = Epi::PERM ? ((R & ~31) + perm32(R & 31)) : R;
        voffA[i] = (unsigned)(R * K + C) * 2u; voffB[i] = (unsigned)(Rb * K + C) * 2u; }
    const size_t kstep = (size_t)(BK * 2);
    const size_t hstep = (size_t)HALF * K * 2;
    const size_t tstep = 2 * hstep;
    const unsigned ldsw = (unsigned)wid * 1024u;
    const int aoff = lds_byte(wr * 64 + fr, fq * 8), boff = lds_byte(wc * 32 + fr, fq * 8);
#define PG8_SA(b, h) (((b) * 2 + (h)) * HTB)
#define PG8_SB(b, h) ((4 + (b) * 2 + (h)) * HTB)
#define PG8_STAGE(bufoff, gbase, voff) do { _Pragma("unroll") for (int _i = 0; _i < 2; ++_i) \
        __builtin_amdgcn_global_load_lds((const unsigned*)((const char*)(gbase) + (voff)[_i]), (PG8_LAS unsigned*)(lds + (bufoff) + ldsw + _i * 8192), 16, 0, 0); } while (0)
#define PG8_LDA(dst, b, h) do { _Pragma("unroll") for (int m = 0; m < 4; ++m) _Pragma("unroll") for (int k = 0; k < 2; ++k) dst[m][k] = *(const PG8_LAS bf16x8*)(lds + PG8_SA(b, h) + aoff + m * 2048 + k * 1024); } while (0)
#define PG8_LDB(dst, b, h) do { _Pragma("unroll") for (int n = 0; n < 2; ++n) _Pragma("unroll") for (int k = 0; k < 2; ++k) dst[n][k] = *(const PG8_LAS bf16x8*)(lds + PG8_SB(b, h) + boff + n * 2048 + k * 1024); } while (0)
#define PG8_MMA(ai, bj, At, Bt) do { __builtin_amdgcn_s_setprio(1); _Pragma("unroll") for (int m = 0; m < 4; ++m) _Pragma("unroll") for (int n = 0; n < 2; ++n) _Pragma("unroll") for (int k = 0; k < 2; ++k) \
        acc[ai][bj][m][n] = __builtin_amdgcn_mfma_f32_16x16x32_bf16(Bt[n][k], At[m][k], acc[ai][bj][m][n], 0, 0, 0); __builtin_amdgcn_s_setprio(0); } while (0)
#define PG8_WAIT_V(n) asm volatile("s_waitcnt vmcnt(" #n ")" ::: "memory")
#define PG8_WAIT_L(n) asm volatile("s_waitcnt lgkmcnt(" #n ")" ::: "memory")
#define PG8_BAR __builtin_amdgcn_s_barrier()
#define PG8_SCHED __builtin_amdgcn_sched_barrier(0)
    Unit cur, nxt; int ui = 0;
    if (!S.next(0, cur)) return;
    f32x4 acc[2][2][4][2];
#pragma unroll
    for (int a = 0; a < 2; ++a)
#pragma unroll
        for (int b = 0; b < 2; ++b)
#pragma unroll
            for (int m = 0; m < 4; ++m)
#pragma unroll
                for (int n = 0; n < 2; ++n) acc[a][b][m][n] = (f32x4){0.f, 0.f, 0.f, 0.f};
    bf16x8 At[4][2], B0[2][2], B1[2][2];
    const char* cA = (const char*)g.A + (size_t)cur.pm * tstep; const char* cB = (const char*)g.Bt + (size_t)cur.pn * tstep;
    S.a_ready(cur);
    if constexpr (SP2) {
        PG8_STAGE(PG8_SB(0, 0), cB, voffB); PG8_STAGE(PG8_SB(0, 1), cB + hstep, voffB); PG8_STAGE(PG8_SA(0, 0), cA, voffA); PG8_STAGE(PG8_SA(0, 1), cA + hstep, voffA);
        if (wr == 1) PG8_BAR;
        PG8_WAIT_V(2); PG8_BAR;
        PG8_STAGE(PG8_SB(1, 0), cB + kstep, voffB); PG8_STAGE(PG8_SA(1, 0), cA + kstep, voffA); PG8_STAGE(PG8_SB(1, 1), cB + hstep + kstep, voffB);
        PG8_WAIT_V(6); PG8_BAR;
    } else {
        PG8_STAGE(PG8_SB(0, 0), cB, voffB); PG8_STAGE(PG8_SA(0, 0), cA, voffA); PG8_STAGE(PG8_SB(0, 1), cB + hstep, voffB); PG8_STAGE(PG8_SA(0, 1), cA + hstep, voffA);
        if (wr == 1) PG8_BAR;
        PG8_WAIT_V(4); PG8_BAR;
        PG8_STAGE(PG8_SB(1, 0), cB + kstep, voffB); PG8_STAGE(PG8_SA(1, 0), cA + kstep, voffA); PG8_STAGE(PG8_SB(1, 1), cB + hstep + kstep, voffB);
        PG8_WAIT_V(6); PG8_BAR;
    }
    for (;;) {
        const bool has_next = S.next(ui + 1, nxt);
        const char* nA = has_next ? (const char*)g.A + (size_t)nxt.pm * tstep : cA; const char* nB = has_next ? (const char*)g.Bt + (size_t)nxt.pn * tstep : cB;
        for (int t = 0; t < nt; t += 2) {
            const bool last = (t == nt - 2);
            const char* a1 = cA + (size_t)(t + 1) * kstep;
            const char* a2 = last ? nA : cA + (size_t)(t + 2) * kstep; const char* b2 = last ? nB : cB + (size_t)(t + 2) * kstep;
            const char* a3 = a2 + kstep; const char* b3 = b2 + kstep;
            if (last && has_next) S.a_ready(nxt);
            if constexpr (SP2) {
            PG8_LDB(B0, 0, 0); PG8_LDB(B1, 0, 1); PG8_SCHED; PG8_LDA(At, 0, 0); PG8_STAGE(PG8_SA(1, 1), a1 + hstep, voffA);
            PG8_WAIT_V(8); PG8_WAIT_L(0); PG8_BAR; PG8_MMA(0, 0, At, B0); PG8_MMA(0, 1, At, B1); PG8_BAR; PG8_SCHED;
            PG8_LDA(At, 0, 1); PG8_STAGE(PG8_SB(0, 0), b2, voffB); PG8_STAGE(PG8_SB(0, 1), b2 + hstep, voffB); PG8_STAGE(PG8_SA(0, 0), a2, voffA);
            PG8_WAIT_V(8); PG8_WAIT_L(0); PG8_BAR; PG8_MMA(1, 0, At, B0); PG8_MMA(1, 1, At, B1); PG8_BAR; PG8_SCHED;
            PG8_LDB(B0, 1, 0); PG8_LDB(B1, 1, 1); PG8_SCHED; PG8_LDA(At, 1, 0); PG8_STAGE(PG8_SA(0, 1), a2 + hstep, voffA);
            PG8_WAIT_V(8); PG8_WAIT_L(0); PG8_BAR; PG8_MMA(0, 0, At, B0); PG8_MMA(0, 1, At, B1); PG8_BAR; PG8_SCHED;
            PG8_LDA(At, 1, 1); PG8_STAGE(PG8_SB(1, 0), b3, voffB); PG8_STAGE(PG8_SB(1, 1), b3 + hstep, voffB); PG8_STAGE(PG8_SA(1, 0), a3, voffA);
            PG8_WAIT_V(8); PG8_WAIT_L(0); PG8_BAR; PG8_MMA(1, 0, At, B0); PG8_MMA(1, 1, At, B1); PG8_BAR; PG8_SCHED;
            } else {
            PG8_LDB(B0, 0, 0); PG8_SCHED; PG8_LDA(At, 0, 0); PG8_STAGE(PG8_SA(1, 1), a1 + hstep, voffA);
            PG8_WAIT_L(8); PG8_BAR; PG8_WAIT_L(0); PG8_MMA(0, 0, At, B0); PG8_BAR; PG8_SCHED;
            PG8_LDB(B1, 0, 1); PG8_STAGE(PG8_SB(0, 0), b2, voffB);
            PG8_BAR; PG8_WAIT_L(0); PG8_MMA(0, 1, At, B1); PG8_BAR;
            PG8_LDA(At, 0, 1); PG8_STAGE(PG8_SA(0, 0), a2, voffA);
            PG8_BAR; PG8_WAIT_L(0); PG8_MMA(1, 0, At, B0); PG8_BAR; PG8_SCHED;
            PG8_STAGE(PG8_SB(0, 1), b2 + hstep, voffB);
            PG8_WAIT_V(6); PG8_BAR; PG8_MMA(1, 1, At, B1); PG8_BAR;
            PG8_LDB(B0, 1, 0); PG8_SCHED; PG8_LDA(At, 1, 0); PG8_STAGE(PG8_SA(0, 1), a2 + hstep, voffA);
            PG8_WAIT_L(8); PG8_BAR; PG8_WAIT_L(0); PG8_MMA(0, 0, At, B0); PG8_BAR; PG8_SCHED;
            PG8_LDB(B1, 1, 1); PG8_STAGE(PG8_SB(1, 0), b3, voffB);
            PG8_BAR; PG8_WAIT_L(0); PG8_MMA(0, 1, At, B1); PG8_BAR;
            PG8_LDA(At, 1, 1); PG8_STAGE(PG8_SA(1, 0), a3, voffA);
            PG8_BAR; PG8_WAIT_L(0); PG8_MMA(1, 0, At, B0); PG8_BAR; PG8_SCHED;
            PG8_STAGE(PG8_SB(1, 1), b3 + hstep, voffB);
            PG8_WAIT_V(6); PG8_BAR; PG8_MMA(1, 1, At, B1); PG8_BAR;
            }
        }
        if constexpr (ALIGN_EPI) { if (wr == 0) PG8_BAR; }
        if constexpr (!Epi::AFTER_DRAIN) { E(acc, cur, wr, wc, fr, fq); S.done(cur); }
        if (!has_next) break;
#pragma unroll
        for (int a = 0; a < 2; ++a)
#pragma unroll
            for (int b = 0; b < 2; ++b)
#pragma unroll
                for (int m = 0; m < 4; ++m)
#pragma unroll
                    for (int n = 0; n < 2; ++n) acc[a][b][m][n] = (f32x4){0.f, 0.f, 0.f, 0.f};
        cur = nxt; cA = nA; cB = nB; ++ui;
        if constexpr (ALIGN_EPI) { if (wr == 1) PG8_BAR; }
    }
    PG8_WAIT_V(0);
    if constexpr (!ALIGN_EPI) { if (wr == 0) PG8_BAR; }
    PG8_BAR;
    if constexpr (Epi::AFTER_DRAIN) { E.fused(acc, cur, wr, wc, fr, fq, lds, wid, lane); S.done(cur); }
#undef PG8_SA
#undef PG8_SB
#undef PG8_STAGE
#undef PG8_LDA
#undef PG8_LDB
#undef PG8_MMA
#undef PG8_WAIT_V
#undef PG8_WAIT_L
#undef PG8_BAR
#undef PG8_SCHED
}
}

__device__ __forceinline__ int gswz(int row, int chunk) { return row * 128 + ((chunk ^ ((row >> 1) & 7)) << 4); }
__device__ __forceinline__ void gemm_tile(const bf16_t* __restrict__ A, int lda, const bf16_t* __restrict__ Bt, int ldb, int K,
                                          int row0, int col0, unsigned char* lds, f32x16 (&acc)[2][2]) {
  int tid_ = tidx(); asm volatile("" : "+v"(tid_)); const int tid = tid_, lane = tid & 63, wid = tid >> 6, wm = wid >> 1, wn = wid & 1, r32 = lane & 31, hi = lane >> 5;
  unsigned char* As = lds; unsigned char* Bs = lds + 65536;
#pragma unroll
  for (int i = 0; i < 2; ++i)
#pragma unroll
    for (int j = 0; j < 2; ++j) acc[i][j] = f32x16{};
  const int lrow = tid >> 3, lc = tid & 7;
  const bf16_t* Ag = A + (size_t)(row0 + lrow) * lda + lc * 8;
  const bf16_t* Bg = Bt + (size_t)(col0 + lrow) * ldb + lc * 8;
  u32x4 ra[4], rb[2];
#pragma unroll
  for (int i = 0; i < 4; ++i) ra[i] = *(const u32x4*)(Ag + (size_t)(64 * i) * lda);
#pragma unroll
  for (int i = 0; i < 2; ++i) rb[i] = *(const u32x4*)(Bg + (size_t)(64 * i) * ldb);
#pragma unroll
  for (int i = 0; i < 4; ++i) *(u32x4*)(As + gswz(lrow + 64 * i, lc)) = ra[i];
#pragma unroll
  for (int i = 0; i < 2; ++i) *(u32x4*)(Bs + gswz(lrow + 64 * i, lc)) = rb[i];
  __syncthreads();
  const int nk = K / 64;
  for (int kt = 0; kt < nk; ++kt) {
    const int cur = kt & 1;
    if (kt + 1 < nk) {
#pragma unroll
      for (int i = 0; i < 4; ++i) ra[i] = *(const u32x4*)(Ag + (size_t)(64 * i) * lda + (kt + 1) * 64);
#pragma unroll
      for (int i = 0; i < 2; ++i) rb[i] = *(const u32x4*)(Bg + (size_t)(64 * i) * ldb + (kt + 1) * 64);
    }
    const unsigned char* Ac = As + cur * 32768; const unsigned char* Bc = Bs + cur * 16384;
#pragma unroll
    for (int kk = 0; kk < 4; ++kk) {
      bf16x8 af[2], bfr[2];
#pragma unroll
      for (int i = 0; i < 2; ++i) af[i] = *(const bf16x8*)(Ac + gswz(wm * 64 + i * 32 + r32, 2 * kk + hi));
#pragma unroll
      for (int j = 0; j < 2; ++j) bfr[j] = *(const bf16x8*)(Bc + gswz(wn * 64 + j * 32 + r32, 2 * kk + hi));
#pragma unroll
      for (int i = 0; i < 2; ++i)
#pragma unroll
        for (int j = 0; j < 2; ++j) acc[i][j] = __builtin_amdgcn_mfma_f32_32x32x16_bf16(af[i], bfr[j], acc[i][j], 0, 0, 0);
    }
    if (kt + 1 < nk) {
      unsigned char* An = As + (cur ^ 1) * 32768; unsigned char* Bn = Bs + (cur ^ 1) * 16384;
#pragma unroll
      for (int i = 0; i < 4; ++i) *(u32x4*)(An + gswz(lrow + 64 * i, lc)) = ra[i];
#pragma unroll
      for (int i = 0; i < 2; ++i) *(u32x4*)(Bn + gswz(lrow + 64 * i, lc)) = rb[i];
    }
    __syncthreads();
  }
}
__device__ __forceinline__ void pair_xchg(float v0, float v1, int lane, float& lo, float& hi2) {
  const bool odd = lane & 1;
  const float send = odd ? v0 : v1;
  const float recv = dpp_mov<0xB1>(send);
  lo = odd ? recv : v0; hi2 = odd ? v1 : recv;
}

__device__ __forceinline__ void phase_inproj(const Params& p, int l, unsigned char* lds) {
  int tid_ = tidx(); asm volatile("" : "+v"(tid_)); const int tid = tid_, lane = tid & 63, wid = tid >> 6, wm = wid >> 1, wn = wid & 1, r32 = lane & 31, hi = lane >> 5;
  const bf16_t* H = (const bf16_t*)(p.ws + WS_H);
  const bf16_t* W = (const bf16_t*)(p.ws + WS_WIN) + (size_t)l * PW * DM;
  bf16_t* PROJ = (bf16_t*)(p.ws + WS_PROJ);
  const float* RC = (const float*)(p.ws + WS_ROPE); const float* RS = RC + SEQ * 32;
  constexpr int NM = T / 256, NN = PW / 128, NU = NM * NN;
  for (int u = p.bx; u < NU + NM; u += p.gx) {
    if (u < NU) {
      const int pn = u / NM, pm = u % NM;
      const int row0 = pm * 256, col0 = pn * 128;
      f32x16 acc[2][2];
      gemm_tile(H, DM, W, DM, DM, row0, col0, lds, acc);
      const bool rope = (col0 >= C_DQ && col0 < C_DV);
      const float scl = (col0 >= C_MK && col0 < C_MV) ? 0.125f : ((col0 >= C_DQ && col0 < C_DK) ? QSCALE : 1.f);
#pragma unroll
      for (int i = 0; i < 2; ++i)
#pragma unroll
        for (int j = 0; j < 2; ++j)
#pragma unroll
          for (int q = 0; q < 8; ++q) {
            float lo, hi2; pair_xchg(acc[i][j][2 * q], acc[i][j][2 * q + 1], lane, lo, hi2);
            const int row = row0 + wm * 64 + i * 32 + crow(2 * q, hi) + (lane & 1);
            const int col = col0 + wn * 64 + j * 32 + (r32 & ~1);
            if (rope) {
              const int s = row % SEGL;
              if (s >= CTXL) {
                const int idx = (s - CTXL) * 32 + ((col & 63) >> 1);
                const float c = RC[idx], sn = RS[idx];
                const float t1 = lo, t2 = hi2; lo = t1 * c - t2 * sn; hi2 = t1 * sn + t2 * c;
              }
            }
            *(unsigned*)(PROJ + (size_t)row * PW + col) = cvtpk(lo * scl, hi2 * scl);
          }
    } else {
      const int pm = u - NU, rowb = pm * 256 + wid * 32;
      const bf16_t* WG = (const bf16_t*)(p.ws + WS_WG) + (size_t)l * 16 * DM;
      float* GT = (float*)(p.ws + WS_GATES);
      const int r16 = lane & 15, q4 = lane >> 4;
      f32x4 c0 = {0.f, 0.f, 0.f, 0.f}, c1 = {0.f, 0.f, 0.f, 0.f};
      const bf16_t* a0p = H + (size_t)(rowb + r16) * DM + q4 * 8;
      const bf16_t* a1p = a0p + (size_t)16 * DM;
      const bf16_t* bp = WG + (size_t)r16 * DM + q4 * 8;
#pragma unroll 4
      for (int ks = 0; ks < 32; ++ks) {
        const bf16x8 a0 = *(const bf16x8*)(a0p + ks * 32), a1 = *(const bf16x8*)(a1p + ks * 32), b = *(const bf16x8*)(bp + ks * 32);
        c0 = __builtin_amdgcn_mfma_f32_16x16x32_bf16(a0, b, c0, 0, 0, 0);
        c1 = __builtin_amdgcn_mfma_f32_16x16x32_bf16(a1, b, c1, 0, 0, 0);
      }
      const float gb = p.in[I_GATEB][l * 16 + r16];
#pragma unroll
      for (int j = 0; j < 4; ++j) {
        GT[(size_t)(rowb + q4 * 4 + j) * 16 + r16] = c0[j] + gb;
        GT[(size_t)(rowb + 16 + q4 * 4 + j) * 16 + r16] = c1[j] + gb;
      }
    }
  }
}

__device__ __forceinline__ void phase_outproj(const Params& p, int l, unsigned char* lds) {
  int tid_ = tidx(); asm volatile("" : "+v"(tid_)); const int tid = tid_, lane = tid & 63, wid = tid >> 6, wm = wid >> 1, wn = wid & 1, r32 = lane & 31, hi = lane >> 5;
  const bf16_t* MIX = (const bf16_t*)(p.ws + WS_MIX);
  const bf16_t* W = (const bf16_t*)(p.ws + WS_WOUT) + (size_t)l * DM * DM;
  float* XC = (float*)(p.ws + WS_XCUR);
  const float* MOD = (const float*)(p.ws + WS_MOD);
  constexpr int NM = T / 256, NN = DM / 128, NU = NM * NN;
  for (int u = p.bx; u < NU; u += p.gx) {
    const int pm = u / NN, pn = u % NN;
    if (l == DEPTH - 1 && (pm % 33) == 0) continue;
    const int row0 = pm * 256, col0 = pn * 128;
    for (int rep = 0; rep < REP_OUTP; ++rep) {
    f32x16 acc[2][2];
    gemm_tile(MIX, DM, W, DM, DM, row0, col0, lds, acc);
    const int mr = (pm % 33) == 0 ? 4 : pm / 33;
    const float* g1 = MOD + ((size_t)l * 5 + mr) * 6144 + 2048;
#pragma unroll
    for (int i = 0; i < 2; ++i)
#pragma unroll
      for (int j = 0; j < 2; ++j) {
        const int col = col0 + wn * 64 + j * 32 + r32;
        const float gg = (rep == REP_OUTP - 1) ? g1[col] : 0.f;
#pragma unroll
        for (int r = 0; r < 16; ++r) {
          const int row = row0 + wm * 64 + i * 32 + crow(r, hi);
          const float xo = (l == 0) ? in_row(p.in[I_X], p.in[I_CTX], row)[col] : XC[(size_t)row * DM + col];
          XC[(size_t)row * DM + col] = xo + gg * acc[i][j][r];
        }
      }
    }
  }
}
__device__ __forceinline__ void phase_peerq(const Params& p, int l, unsigned char* lds) {
  int tid_ = tidx(); asm volatile("" : "+v"(tid_)); const int tid = tid_, lane = tid & 63, wid = tid >> 6, wm = wid >> 1, wn = wid & 1, r32 = lane & 31, hi = lane >> 5;
  const bf16_t* H = (const bf16_t*)(p.ws + WS_H);
  const bf16_t* W = (const bf16_t*)(p.ws + WS_WQ) + (size_t)l * DM * DM;
  bf16_t* QP = (bf16_t*)(p.ws + WS_PROJ);
  constexpr int NM = T / 256, NN = DM / 128, NU = NM * NN;
  for (int u = p.bx; u < NU; u += p.gx) {
    const int pm = u / NN, pn = u % NN;
    if (l == DEPTH - 1 && (pm % 33) == 0) continue;
    const int row0 = pm * 256, col0 = pn * 128;
    f32x16 acc[2][2];
    gemm_tile(H, DM, W, DM, DM, row0, col0, lds, acc);
#pragma unroll
    for (int i = 0; i < 2; ++i)
#pragma unroll
      for (int j = 0; j < 2; ++j)
#pragma unroll
        for (int q = 0; q < 8; ++q) {
          float lo, hi2; pair_xchg(acc[i][j][2 * q], acc[i][j][2 * q + 1], lane, lo, hi2);
          const int row = row0 + wm * 64 + i * 32 + crow(2 * q, hi) + (lane & 1);
          const int col = col0 + wn * 64 + j * 32 + (r32 & ~1);
          *(unsigned*)(QP + (size_t)row * DM + col) = cvtpk(lo, hi2);
        }
  }
}


struct EpiInproj {
  static constexpr bool PERM = true, AFTER_DRAIN = false;
  bf16_t* PROJ; const float* RC; const float* RS; unsigned char* V8T;
  __device__ __forceinline__ void operator()(const pg8::f32x4 (&acc)[2][2][4][2], const pg8::Unit& u, int wr, int wc, int fr, int fq) const {
#pragma unroll
    for (int bj = 0; bj < 2; ++bj) {
      const int colt = u.pn * 256 + bj * 128;
      const bool rope = (colt >= C_DQ && colt < C_DV);
      const float scl = (colt >= C_MK && colt < C_MV) ? 0.125f : ((colt >= C_DQ && colt < C_DK) ? QSCALE : 1.f);
      const int col8 = colt + wc * 32 + 8 * fq;
      if (colt >= C_DV) {
        const int hh = (col8 - C_DV) >> 7, e0 = (col8 - C_DV) & 127;
#pragma unroll
        for (int ai = 0; ai < 2; ++ai)
#pragma unroll
          for (int m = 0; m < 4; ++m) {
            const int row = u.pm * 256 + ai * 128 + wr * 64 + m * 16 + fr;
            const int b = row / SEGL, s = row - b * SEGL, t = s >> 6, kk = s & 63;
            const int slot = ((kk >> 2) & 1) * 32 + (kk & 3) + 4 * ((kk >> 3) & 3) + 16 * (kk >> 5);
            unsigned char* vp = V8T + ((size_t)((b * 4 + hh) * NCH + t) * 128 + e0) * 80 + slot;
            const f32x4 v0 = acc[ai][bj][m][0], v1 = acc[ai][bj][m][1];
            int w0 = 0, w1 = 0;
            w0 = __builtin_amdgcn_cvt_pk_fp8_f32(v0[0], v0[1], w0, false); w0 = __builtin_amdgcn_cvt_pk_fp8_f32(v0[2], v0[3], w0, true);
            w1 = __builtin_amdgcn_cvt_pk_fp8_f32(v1[0], v1[1], w1, false); w1 = __builtin_amdgcn_cvt_pk_fp8_f32(v1[2], v1[3], w1, true);
            vp[0] = (unsigned char)(w0 & 0xFF); vp[80] = (unsigned char)((w0 >> 8) & 0xFF); vp[160] = (unsigned char)((w0 >> 16) & 0xFF); vp[240] = (unsigned char)((w0 >> 24) & 0xFF);
            vp[320] = (unsigned char)(w1 & 0xFF); vp[400] = (unsigned char)((w1 >> 8) & 0xFF); vp[480] = (unsigned char)((w1 >> 16) & 0xFF); vp[560] = (unsigned char)((w1 >> 24) & 0xFF);
          }
        continue;
      }
      unsigned char* qk8 = nullptr;
      if (rope) { const int isk = colt >= C_DK, cc = col8 - (isk ? C_DK : C_DQ); qk8 = V8T + (WS_QK8 - WS_V8T) + (size_t)isk * QK8_IMG + (size_t)(cc >> 7) * SEGL * QK8_PITCH + (cc & 127); }
#pragma unroll
      for (int ai = 0; ai < 2; ++ai)
#pragma unroll
        for (int m = 0; m < 4; ++m) {
          const int row = u.pm * 256 + ai * 128 + wr * 64 + m * 16 + fr;
          f32x4 v0 = acc[ai][bj][m][0], v1 = acc[ai][bj][m][1];
          if (rope) {
            const int s = row % SEGL;
            if (s >= CTXL) {
              const int idx = (s - CTXL) * 32 + ((col8 & 63) >> 1);
              const f32x4 c = *(const f32x4*)(RC + idx), sn = *(const f32x4*)(RS + idx);
              f32x4 a, b;
              a[0] = v0[0] * c[0] - v0[1] * sn[0]; a[1] = v0[0] * sn[0] + v0[1] * c[0]; a[2] = v0[2] * c[1] - v0[3] * sn[1]; a[3] = v0[2] * sn[1] + v0[3] * c[1];
              b[0] = v1[0] * c[2] - v1[1] * sn[2]; b[1] = v1[0] * sn[2] + v1[1] * c[2]; b[2] = v1[2] * c[3] - v1[3] * sn[3]; b[3] = v1[2] * sn[3] + v1[3] * c[3];
              v0 = a; v1 = b;
            }
          }
          if (rope) {
            const int b = row / SEGL, s = row - b * SEGL;
            int w0, w1; asm volatile("" : "=v"(w0), "=v"(w1));
            w0 = __builtin_amdgcn_cvt_pk_fp8_f32(v0[0] * scl, v0[1] * scl, w0, false); w0 = __builtin_amdgcn_cvt_pk_fp8_f32(v0[2] * scl, v0[3] * scl, w0, true);
            w1 = __builtin_amdgcn_cvt_pk_fp8_f32(v1[0] * scl, v1[1] * scl, w1, false); w1 = __builtin_amdgcn_cvt_pk_fp8_f32(v1[2] * scl, v1[3] * scl, w1, true);
            *(u32x2*)(qk8 + ((size_t)b * 4 * SEGL + s) * QK8_PITCH) = (u32x2){(unsigned)w0, (unsigned)w1};
            continue;
          }
          u32x4 w; w.x = cvtpk(v0[0] * scl, v0[1] * scl); w.y = cvtpk(v0[2] * scl, v0[3] * scl); w.z = cvtpk(v1[0] * scl, v1[1] * scl); w.w = cvtpk(v1[2] * scl, v1[3] * scl);
          *(u32x4*)(PROJ + (size_t)row * PW + col8) = w;
        }
    }
  }
};
struct EpiOutproj {
  static constexpr bool PERM = true, AFTER_DRAIN = false;
  float* XC; const float* MODL; const float* xin; const float* ctxin; int first; float gsc;
  __device__ __forceinline__ void operator()(const pg8::f32x4 (&acc)[2][2][4][2], const pg8::Unit& u, int wr, int wc, int fr, int fq) const {
    const int mr = (u.pm % 33) == 0 ? 4 : u.pm / 33;
    const float* g1 = MODL + (size_t)mr * 6144 + 2048;
#pragma unroll
    for (int bj = 0; bj < 2; ++bj) {
      const int col8 = u.pn * 256 + bj * 128 + wc * 32 + 8 * fq;
      const f32x4 ga = *(const f32x4*)(g1 + col8) * gsc, gb = *(const f32x4*)(g1 + col8 + 4) * gsc;
#pragma unroll
      for (int ai = 0; ai < 2; ++ai)
#pragma unroll
        for (int m = 0; m < 4; ++m) {
          const int row = u.pm * 256 + ai * 128 + wr * 64 + m * 16 + fr;
          const float* xo = first ? in_row(xin, ctxin, row) + col8 : XC + (size_t)row * DM + col8;
          const f32x4 xa = *(const f32x4*)xo, xb = *(const f32x4*)(xo + 4);
          *(f32x4*)(XC + (size_t)row * DM + col8) = xa + ga * acc[ai][bj][m][0];
          *(f32x4*)(XC + (size_t)row * DM + col8 + 4) = xb + gb * acc[ai][bj][m][1];
        }
    }
  }
};
struct EpiPeerq {
  static constexpr bool PERM = true, AFTER_DRAIN = false;
  bf16_t* QP;
  __device__ __forceinline__ void operator()(const pg8::f32x4 (&acc)[2][2][4][2], const pg8::Unit& u, int wr, int wc, int fr, int fq) const {
#pragma unroll
    for (int bj = 0; bj < 2; ++bj) {
      const int col8 = u.pn * 256 + bj * 128 + wc * 32 + 8 * fq;
#pragma unroll
      for (int ai = 0; ai < 2; ++ai)
#pragma unroll
        for (int m = 0; m < 4; ++m) {
          const int row = u.pm * 256 + ai * 128 + wr * 64 + m * 16 + fr;
          const f32x4 v0 = acc[ai][bj][m][0], v1 = acc[ai][bj][m][1];
          u32x4 w; w.x = cvtpk(v0[0], v0[1]); w.y = cvtpk(v0[2], v0[3]); w.z = cvtpk(v1[0], v1[1]); w.w = cvtpk(v1[2], v1[3]);
          *(u32x4*)(QP + (size_t)row * DM + col8) = w;
        }
    }
  }
};
__device__ __forceinline__ void phase_inproj2(const Params& p, int l, unsigned char* lds) {
  {
    pg8::Gemm g{(const bf16_t*)(p.ws + WS_H), (const bf16_t*)(p.ws + WS_WIN) + (size_t)l * PW * DM, T, PW, DM};
    pg8::StaticOrder S; S.init(T, PW, p.gx, p.bx);
    EpiInproj E{(bf16_t*)(p.ws + WS_PROJ), (const float*)(p.ws + WS_ROPE), (const float*)(p.ws + WS_ROPE) + SEQ * 32, p.ws + WS_V8T};
    pg8::gemm_phase<EpiInproj, pg8::StaticOrder, true, true>((PG8_LAS unsigned char*)lds, g, S, E);
  }
  int tid_ = tidx(); asm volatile("" : "+v"(tid_)); const int tid = tid_, lane = tid & 63, wid = tid >> 6;
  const bf16_t* H = (const bf16_t*)(p.ws + WS_H);
  for (int pm = p.gx - 1 - p.bx; pm < T / 256; pm += p.gx) {
    const int rowb = pm * 256 + wid * 32;
    const bf16_t* WG = (const bf16_t*)(p.ws + WS_WG) + (size_t)l * 16 * DM;
    float* GT = (float*)(p.ws + WS_GATES);
    const int r16 = lane & 15, q4 = lane >> 4;
    f32x4 c0 = {0.f, 0.f, 0.f, 0.f}, c1 = {0.f, 0.f, 0.f, 0.f};
    const bf16_t* a0p = H + (size_t)(rowb + r16) * DM + q4 * 8;
    const bf16_t* a1p = a0p + (size_t)16 * DM;
    const bf16_t* bp = WG + (size_t)r16 * DM + q4 * 8;
#pragma unroll 4
    for (int ks = 0; ks < 32; ++ks) {
      const bf16x8 a0 = *(const bf16x8*)(a0p + ks * 32), a1 = *(const bf16x8*)(a1p + ks * 32), b = *(const bf16x8*)(bp + ks * 32);
      c0 = __builtin_amdgcn_mfma_f32_16x16x32_bf16(a0, b, c0, 0, 0, 0);
      c1 = __builtin_amdgcn_mfma_f32_16x16x32_bf16(a1, b, c1, 0, 0, 0);
    }
    const float gb = p.in[I_GATEB][l * 16 + r16];
#pragma unroll
    for (int j = 0; j < 4; ++j) {
      GT[(size_t)(rowb + q4 * 4 + j) * 16 + r16] = c0[j] + gb;
      GT[(size_t)(rowb + 16 + q4 * 4 + j) * 16 + r16] = c1[j] + gb;
    }
  }
}
__device__ __forceinline__ void phase_outproj2(const Params& p, int l, unsigned char* lds) {
  pg8::Gemm g{(const bf16_t*)(p.ws + WS_MIX), (const bf16_t*)(p.ws + WS_WOUT) + (size_t)l * DM * DM, T, DM, DM};
  pg8::StaticOrder S; S.init(T, DM, p.gx, p.bx);
  for (int rep = 0; rep < REP_OUTP; ++rep) {
  EpiOutproj E{(float*)(p.ws + WS_XCUR), (const float*)(p.ws + WS_MOD) + (size_t)l * 5 * 6144, p.in[I_X], p.in[I_CTX], l == 0, (rep == REP_OUTP - 1) ? 1.f : 0.f};
  pg8::gemm_phase<EpiOutproj, pg8::StaticOrder, true, true>((PG8_LAS unsigned char*)lds, g, S, E);
  }
  tail_filler_tables(p, l, (T / 256) * (DM / 256), l == 0 ? 0 : NEXP, 2 * NEXP);
}
__device__ __forceinline__ void phase_peerq2(const Params& p, int l, unsigned char* lds) {
  pg8::Gemm g{(const bf16_t*)(p.ws + WS_H), (const bf16_t*)(p.ws + WS_WQ) + (size_t)l * DM * DM, T, DM, DM};
  pg8::StaticOrder S; S.init(T, DM, p.gx, p.bx);
  EpiPeerq E{(bf16_t*)(p.ws + WS_PROJ)};
  pg8::gemm_phase<EpiPeerq, pg8::StaticOrder, true, true>((PG8_LAS unsigned char*)lds, g, S, E);
  if (l < DEPTH - 1) tail_filler_tables(p, l + 1, (T / 256) * (DM / 256), 0, NEXP);
}

__device__ __forceinline__ void conv_unit(const Params& p, int l, int unit, unsigned char* lds) {
  int tid_ = tidx(); asm volatile("" : "+v"(tid_)); const int tid = tid_, lane = tid & 63, wid = tid >> 6;
  float* U = (float*)lds;
  const bf16_t* PROJ = (const bf16_t*)(p.ws + WS_PROJ);
  bf16_t* MIX = (bf16_t*)(p.ws + WS_MIX);
  const int row0 = unit * 32, b = row0 / SEGL, s0 = row0 - b * SEGL;
  const int seglo = s0 < CTXL ? 0 : CTXL, seghi = s0 < CTXL ? CTXL : SEGL;
  for (int rr = tid >> 5; rr < 62; rr += 16) {
    const int s = s0 - 15 + rr, c8 = (tid & 31) * 8;
    f32x4 u0 = {0.f, 0.f, 0.f, 0.f}, u1 = {0.f, 0.f, 0.f, 0.f};
    if (s >= seglo && s < seghi) {
      const bf16_t* pr = PROJ + (size_t)(b * SEGL + s) * PW + c8;
      const u32x4 a1 = *(const u32x4*)pr, a2 = *(const u32x4*)(pr + 256);
      u0.x = bflo(a1.x) * sigmoidf_(bflo(a2.x)); u0.y = bfhi(a1.x) * sigmoidf_(bfhi(a2.x));
      u0.z = bflo(a1.y) * sigmoidf_(bflo(a2.y)); u0.w = bfhi(a1.y) * sigmoidf_(bfhi(a2.y));
      u1.x = bflo(a1.z) * sigmoidf_(bflo(a2.z)); u1.y = bfhi(a1.z) * sigmoidf_(bfhi(a2.z));
      u1.z = bflo(a1.w) * sigmoidf_(bflo(a2.w)); u1.w = bfhi(a1.w) * sigmoidf_(bfhi(a2.w));
    }
    *(f32x4*)(U + rr * 256 + c8) = u0; *(f32x4*)(U + rr * 256 + c8 + 4) = u1;
  }
  __syncthreads();
  float* Y = U + 62 * 256;
  const float* cw = p.in[I_CONVW] + (size_t)l * 31 * 256;
#pragma unroll 1
  for (int q = 0; q < 4; ++q) {
    const int c = lane + 64 * q;
    float w[31];
#pragma unroll
    for (int j = 0; j < 31; ++j) w[j] = cw[j * 256 + c];
    const float bias = p.in[I_CONVB][l * 256 + c];
#pragma unroll
    for (int tt = 0; tt < 4; ++tt) {
      const int t = wid * 4 + tt;
      float a = bias;
#pragma unroll
      for (int j = 0; j < 31; ++j) a += U[(t + j) * 256 + c] * w[j];
      Y[t * 256 + c] = a;
    }
  }
  asm volatile("s_waitcnt lgkmcnt(0)" ::: "memory");
  float y[4][4];
#pragma unroll
  for (int tt = 0; tt < 4; ++tt)
#pragma unroll
    for (int q = 0; q < 4; ++q) y[tt][q] = Y[(wid * 4 + tt) * 256 + lane + 64 * q];
#pragma unroll
  for (int tt = 0; tt < 4; ++tt) {
    const int t = wid * 4 + tt;
    const float mean = wave_sum((y[tt][0] + y[tt][1]) + (y[tt][2] + y[tt][3])) * (1.f / 256.f);
    float v = 0.f;
#pragma unroll
    for (int q = 0; q < 4; ++q) { const float d = y[tt][q] - mean; v += d * d; }
    const float rs = rsqrtf(wave_sum(v) * (1.f / 256.f) + EPS);
#pragma unroll
    for (int q = 0; q < 4; ++q) {
      const int c = lane + 64 * q;
      const float z = (y[tt][q] - mean) * rs * p.in[I_CLNG][l * 256 + c] + p.in[I_CLNB][l * 256 + c];
      const float o = (ABL & 1) ? 0.f : z * sigmoidf_(z);
      MIX[(size_t)(row0 + t) * DM + c] = (bf16_t)(cvtpk(o, 0.f) & 0xffffu);
    }
  }
  __syncthreads();
}

__device__ __forceinline__ int ml_cidx(int ch, int dir) { return dir == 0 ? ch : (ch < 4 ? 3 - ch : 135 - ch); }
__device__ __forceinline__ void ml_load_tile(const bf16_t* src, float* dst, int tid) {
  const int r = tid >> 3, c8 = (tid & 7) * 8;
  const u32x4 a = *(const u32x4*)(src + (size_t)r * PW + c8);
  float* d = dst + r * 65 + c8;
  d[0] = bflo(a.x); d[1] = bfhi(a.x); d[2] = bflo(a.y); d[3] = bfhi(a.y); d[4] = bflo(a.z); d[5] = bfhi(a.z); d[6] = bflo(a.w); d[7] = bfhi(a.w);
}
__device__ __forceinline__ void ml_local_unit(const Params& p, int l, int unit, unsigned char* lds) {
  int tid_ = tidx(); asm volatile("" : "+v"(tid_)); const int tid = tid_, lane = tid & 63, wid = tid >> 6, r32 = lane & 31, hi = lane >> 5;
  float* Kt = (float*)lds; float* Vt = Kt + 64 * 65; float* WK = Vt + 64 * 65;
  const bf16_t* PROJ = (const bf16_t*)(p.ws + WS_PROJ);
  const float* GT = (const float*)(p.ws + WS_GATES);
  float* UL = (float*)(p.ws + WS_ULOC); float* META = (float*)(p.ws + WS_MLMETA);
  const int b = unit / (4 * NCH), hh = (unit / NCH) & 3, ch = unit % NCH;
  const int row0 = b * SEGL + ch * 64;
  ml_load_tile(PROJ + (size_t)row0 * PW + C_MK + hh * 64, Kt, tid);
  ml_load_tile(PROJ + (size_t)row0 * PW + C_MV + hh * 64, Vt, tid);
  if (wid < 2) {
    const int dir = wid;
    const float ig = GT[(size_t)(row0 + lane) * 16 + (2 * dir) * 4 + hh];
    const float lf = logsigmoidf_(GT[(size_t)(row0 + lane) * 16 + (2 * dir + 1) * 4 + hh]);
    float ps = lf;
    ps = wave_incl_scan(ps);
    const float tot = __uint_as_float((unsigned)__builtin_amdgcn_readlane((int)__float_as_uint(ps), 63));
    const float wlog = dir == 0 ? (tot - ps + ig) : (ps - lf + ig);
    const float mloc = wave_max(wlog);
    WK[dir * 64 + lane] = __expf(wlog - mloc);
    if (lane == 0) {
      const int seq = (b * 4 + hh) * 2 + dir, ci = ml_cidx(ch, dir);
      META[((size_t)seq * NCH + ci) * 4 + 0] = tot; META[((size_t)seq * NCH + ci) * 4 + 1] = mloc;
    }
  }
  __syncthreads();
  {
    const int dir = wid >> 2, et = (wid >> 1) & 1, dt = wid & 1;
    const int seq = (b * 4 + hh) * 2 + dir, ci = ml_cidx(ch, dir);
    float* slot = UL + ((size_t)seq * NCH + ci) * USTRIDE;
    f32x16 acc = {};
#pragma unroll 8
    for (int ks = 0; ks < 32; ++ks) {
      const int s = 2 * ks + hi;
      const float a = WK[dir * 64 + s] * Vt[s * 65 + et * 32 + r32];
      const float bb = Kt[s * 65 + dt * 32 + r32];
      acc = __builtin_amdgcn_mfma_f32_32x32x2f32(a, bb, acc, 0, 0, 0);
    }
#pragma unroll
    for (int r = 0; r < 16; ++r) slot[(et * 32 + crow(r, hi)) * 64 + dt * 32 + r32] = acc[r];
    if (et == 0) {
      float n = 0.f;
#pragma unroll 8
      for (int i = 0; i < 32; ++i) { const int s = hi * 32 + i; n += WK[dir * 64 + s] * Kt[s * 65 + dt * 32 + r32]; }
      n = sum_xor32(n);
      if (hi == 0) slot[4096 + dt * 32 + r32] = n;
    }
  }
  __syncthreads();
}
constexpr int MLP = 144;
constexpr size_t WS_CST = WS_H;
constexpr size_t WS_NST = WS_H + (size_t)32 * NCH * 4096 * 2;
__device__ __forceinline__ void ml_stage_rm(const bf16_t* src, size_t ld, unsigned char* dst, int tid) {
  const int r = tid >> 3, c8 = (tid & 7) * 8;
  *(u32x4*)(dst + r * MLP + c8 * 2) = *(const u32x4*)(src + (size_t)r * ld + c8);
}
__device__ __forceinline__ void ml_stage_tr(const bf16_t* src, size_t ld, unsigned char* dst, int tid) {
  const int r = tid >> 3, c8 = (tid & 7) * 8;
  const u32x4 a = *(const u32x4*)(src + (size_t)r * ld + c8);
  bf16_t* d = (bf16_t*)dst;
  d[(c8 + 0) * 72 + r] = (bf16_t)(a.x & 0xffffu); d[(c8 + 1) * 72 + r] = (bf16_t)(a.x >> 16);
  d[(c8 + 2) * 72 + r] = (bf16_t)(a.y & 0xffffu); d[(c8 + 3) * 72 + r] = (bf16_t)(a.y >> 16);
  d[(c8 + 4) * 72 + r] = (bf16_t)(a.z & 0xffffu); d[(c8 + 5) * 72 + r] = (bf16_t)(a.z >> 16);
  d[(c8 + 6) * 72 + r] = (bf16_t)(a.w & 0xffffu); d[(c8 + 7) * 72 + r] = (bf16_t)(a.w >> 16);
}
__device__ __forceinline__ void ml_local_unit2(const Params& p, int l, int unit, unsigned char* lds) {
  int tid_ = tidx(); asm volatile("" : "+v"(tid_)); const int tid = tid_, lane = tid & 63, wid = tid >> 6, r32 = lane & 31, hi = lane >> 5;
  unsigned char* KT = lds; unsigned char* VT = lds + 64 * MLP; float* WK = (float*)(lds + 2 * 64 * MLP);
  const bf16_t* PROJ = (const bf16_t*)(p.ws + WS_PROJ);
  const float* GT = (const float*)(p.ws + WS_GATES);
  float* UL = (float*)(p.ws + WS_ULOC); float* META = (float*)(p.ws + WS_MLMETA);
  const int b = unit / (4 * NCH), hh = (unit / NCH) & 3, ch = unit % NCH;
  const int row0 = b * SEGL + ch * 64;
  ml_stage_tr(PROJ + (size_t)row0 * PW + C_MK + hh * 64, PW, KT, tid);
  ml_stage_tr(PROJ + (size_t)row0 * PW + C_MV + hh * 64, PW, VT, tid);
  if (wid < 2) {
    const int dir = wid;
    const float ig = GT[(size_t)(row0 + lane) * 16 + (2 * dir) * 4 + hh];
    const float lf = logsigmoidf_(GT[(size_t)(row0 + lane) * 16 + (2 * dir + 1) * 4 + hh]);
    float ps = lf;
    ps = wave_incl_scan(ps);
    const float tot = __uint_as_float((unsigned)__builtin_amdgcn_readlane((int)__float_as_uint(ps), 63));
    const float wlog = dir == 0 ? (tot - ps + ig) : (ps - lf + ig);
    const float mloc = wave_max(wlog);
    WK[dir * 64 + lane] = __expf(wlog - mloc);
    if (lane == 0) {
      const int seq = (b * 4 + hh) * 2 + dir, ci = ml_cidx(ch, dir);
      META[((size_t)seq * NCH + ci) * 4 + 0] = tot; META[((size_t)seq * NCH + ci) * 4 + 1] = mloc;
    }
  }
  __syncthreads();
  {
    const int dir = wid >> 2, et = (wid >> 1) & 1, dt = wid & 1;
    const int seq = (b * 4 + hh) * 2 + dir, ci = ml_cidx(ch, dir);
    float* slot = UL + ((size_t)seq * NCH + ci) * USTRIDE;
    f32x16 acc = {};
#pragma unroll
    for (int ks = 0; ks < 4; ++ks) {
      const int s0 = ks * 16 + hi * 8;
      const u32x4 va = *(const u32x4*)(VT + (et * 32 + r32) * MLP + s0 * 2);
      const bf16x8 kb = *(const bf16x8*)(KT + (dt * 32 + r32) * MLP + s0 * 2);
      const f32x4 w0 = *(const f32x4*)(WK + dir * 64 + s0), w1 = *(const f32x4*)(WK + dir * 64 + s0 + 4);
      u32x4 sa; sa.x = cvtpk(bflo(va.x) * w0.x, bfhi(va.x) * w0.y); sa.y = cvtpk(bflo(va.y) * w0.z, bfhi(va.y) * w0.w);
      sa.z = cvtpk(bflo(va.z) * w1.x, bfhi(va.z) * w1.y); sa.w = cvtpk(bflo(va.w) * w1.z, bfhi(va.w) * w1.w);
      acc = __builtin_amdgcn_mfma_f32_32x32x16_bf16(*(const bf16x8*)&sa, kb, acc, 0, 0, 0);
    }
#pragma unroll
    for (int r = 0; r < 16; ++r) slot[(et * 32 + crow(r, hi)) * 64 + dt * 32 + r32] = acc[r];
    if (et == 0) {
      float n = 0.f;
#pragma unroll
      for (int i = 0; i < 4; ++i) {
        const int s0 = hi * 32 + i * 8;
        const u32x4 ka = *(const u32x4*)(KT + (dt * 32 + r32) * MLP + s0 * 2);
        const f32x4 w0 = *(const f32x4*)(WK + dir * 64 + s0), w1 = *(const f32x4*)(WK + dir * 64 + s0 + 4);
        n += bflo(ka.x) * w0.x + bfhi(ka.x) * w0.y + bflo(ka.y) * w0.z + bfhi(ka.y) * w0.w + bflo(ka.z) * w1.x + bfhi(ka.z) * w1.y + bflo(ka.w) * w1.z + bfhi(ka.w) * w1.w;
      }
      n = sum_xor32(n);
      if (hi == 0) slot[4096 + dt * 32 + r32] = n;
    }
  }
  __syncthreads();
}
__device__ __forceinline__ void ml_scan(const Params& p, unsigned char* lds) {
  float* UL = (float*)(p.ws + WS_ULOC); float* META = (float*)(p.ws + WS_MLMETA);
  int tid_ = tidx(); asm volatile("" : "+v"(tid_));
  const int tid = tid_, lane = tid & 63, wid = tid >> 6;
  float* DEC = (float*)lds;
  float* SCL = DEC + 2 * NCH;
  float* TMP = SCL + 2 * NCH;
  constexpr int NSL = (32 * USTRIDE + 511) / 512;
  const int first_ = p.gx > 64 ? 16 : 0, nb_ = p.gx - first_;
  for (int k_ = 0; k_ < 2 + (NSL + nb_ - 1) / nb_; ++k_) {
    int s_;
    if (k_ == 0) s_ = p.bx >= first_ ? p.bx - first_ : -1;
    else s_ = k_ * nb_ + (p.gx - 1 - p.bx);
    if (k_ > 0 && p.gx - 1 - p.bx >= nb_) s_ = -1;
    if (s_ < 0 || s_ >= NSL) continue;
    const int base0 = s_ * 512;
    const int seq0 = base0 / USTRIDE;
    if (wid < 2) {
      const int seq = seq0 + wid;
      if (seq < 32) {
        float* mt = META + (size_t)seq * NCH * 4;
        for (int c = lane; c < NCH; c += 64) { TMP[(wid * 2 + 0) * NCH + c] = mt[c * 4 + 0]; TMP[(wid * 2 + 1) * NCH + c] = mt[c * 4 + 1]; }
        asm volatile("s_waitcnt lgkmcnt(0)" ::: "memory");
        if (lane == 0) {
          float m = 0.f;
          for (int c = 0; c < NCH; ++c) {
            const float bl = TMP[(wid * 2 + 0) * NCH + c], mloc = TMP[(wid * 2 + 1) * NCH + c];
            const float mn = fmaxf(bl + m, mloc);
            DEC[wid * NCH + c] = __expf(bl + m - mn); SCL[wid * NCH + c] = __expf(mloc - mn);
            mt[c * 4 + 2] = m;
            m = mn;
          }
        }
      }
    }
    __syncthreads();
    const int idx = base0 + tid;
    if (idx < 32 * USTRIDE) {
      const int seq = idx / USTRIDE, e = idx - seq * USTRIDE, sl = seq - seq0;
      float* bp = UL + (size_t)seq * NCH * USTRIDE + e;
      bf16_t* CSTp = (bf16_t*)(p.ws + WS_CST) + (size_t)seq * NCH * 4096 + (e < 4096 ? e : 0);
      float* NSTp = (float*)(p.ws + WS_NST) + (size_t)seq * NCH * 64 + (e < 4096 ? 0 : e - 4096);
      const float* dec = DEC + sl * NCH; const float* scl = SCL + sl * NCH;
      float C = 0.f;
      constexpr int BT = 33;
      static_assert(NCH == 4 * BT, "scan batches");
      float ua[BT], ub[BT];
#define SCAN_LD(u_, c0_) _Pragma("unroll") for (int j = 0; j < BT; ++j) u_[j] = bp[(size_t)((c0_) + j) * USTRIDE];
#define SCAN_DO(u_, c0_) _Pragma("unroll") for (int j = 0; j < BT; ++j) { \
          if (e < 4096) CSTp[(size_t)((c0_) + j) * 4096] = (bf16_t)(cvtpk(C, 0.f) & 0xffffu); else NSTp[(size_t)((c0_) + j) * 64] = C; \
          C = dec[(c0_) + j] * C + scl[(c0_) + j] * u_[j]; }
      SCAN_LD(ua, 0)
#pragma unroll 1
      for (int c0 = 0; c0 < NCH; c0 += 2 * BT) {
        SCAN_LD(ub, c0 + BT)
        SCAN_DO(ua, c0)
        if (c0 + 2 * BT < NCH) { SCAN_LD(ua, c0 + 2 * BT) }
        SCAN_DO(ub, c0 + BT)
      }
#undef SCAN_LD
#undef SCAN_DO
    }
    __syncthreads();
  }
}
__device__ __forceinline__ void ml_out_unit(const Params& p, int l, int unit, unsigned char* lds) {
  int tid_ = tidx(); asm volatile("" : "+v"(tid_)); const int tid = tid_, lane = tid & 63, wid = tid >> 6, r32 = lane & 31, hi = lane >> 5;
  float* Qt = (float*)lds; float* Kt = Qt + 64 * 65; float* Vt = Kt + 64 * 65;
  float* Cs = Vt + 64 * 65;
  float* Ns = Cs + 2 * 64 * 65;
  float* Bq = Ns + 128;
  float* Gs = Bq + 128;
  float* Mi = Gs + 128;
  float* HB = Mi + 64;
  const bf16_t* PROJ = (const bf16_t*)(p.ws + WS_PROJ);
  const float* GT = (const float*)(p.ws + WS_GATES);
  const float* UL = (const float*)(p.ws + WS_ULOC); const float* META = (const float*)(p.ws + WS_MLMETA);
  bf16_t* MIX = (bf16_t*)(p.ws + WS_MIX);
  const int b = unit / (4 * NCH), hh = (unit / NCH) & 3, ch = unit % NCH;
  const int row0 = b * SEGL + ch * 64;
  ml_load_tile(PROJ + (size_t)row0 * PW + C_MQ + hh * 64, Qt, tid);
  ml_load_tile(PROJ + (size_t)row0 * PW + C_MK + hh * 64, Kt, tid);
  ml_load_tile(PROJ + (size_t)row0 * PW + C_MV + hh * 64, Vt, tid);
  for (int i = tid; i < 2 * USTRIDE; i += 512) {
    const int dir = i / USTRIDE, e = i - dir * USTRIDE;
    const int seq = (b * 4 + hh) * 2 + dir, ci = ml_cidx(ch, dir);
    const float v = UL[((size_t)seq * NCH + ci) * USTRIDE + e];
    if (e < 4096) Cs[dir * 64 * 65 + (e >> 6) * 65 + (e & 63)] = v; else Ns[dir * 64 + (e - 4096)] = v;
  }
  if (wid < 2) {
    const int dir = wid;
    const float ig = GT[(size_t)(row0 + lane) * 16 + (2 * dir) * 4 + hh];
    const float lf = logsigmoidf_(GT[(size_t)(row0 + lane) * 16 + (2 * dir + 1) * 4 + hh]);
    float ps = lf;
    ps = wave_incl_scan(ps);
    const float tot = __uint_as_float((unsigned)__builtin_amdgcn_readlane((int)__float_as_uint(ps), 63));
    const float bc = dir == 0 ? ps : (tot - ps + lf);
    Bq[dir * 64 + lane] = bc; Gs[dir * 64 + lane] = ig - bc;
    if (lane == 0) { const int seq = (b * 4 + hh) * 2 + dir, ci = ml_cidx(ch, dir); Mi[dir] = META[((size_t)seq * NCH + ci) * 4 + 2]; }
  }
  __syncthreads();
  {
    const int dir = wid >> 2, tt = (wid >> 1) & 1, et = wid & 1;
    const int t = tt * 32 + r32;
    f32x16 sa[2] = {};
#pragma unroll 4
    for (int ks = 0; ks < 32; ++ks) {
      const float bq = Qt[t * 65 + 2 * ks + hi];
      const float a0 = Kt[(r32) * 65 + 2 * ks + hi], a1 = Kt[(32 + r32) * 65 + 2 * ks + hi];
      sa[0] = __builtin_amdgcn_mfma_f32_32x32x2f32(a0, bq, sa[0], 0, 0, 0);
      sa[1] = __builtin_amdgcn_mfma_f32_32x32x2f32(a1, bq, sa[1], 0, 0, 0);
    }
    const float bt = Bq[dir * 64 + t];
    const float inter = bt + Mi[dir];
    float mx = -INFINITY;
    f32x16 dl[2];
#pragma unroll
    for (int st = 0; st < 2; ++st)
#pragma unroll
      for (int r = 0; r < 16; ++r) {
        const int s = st * 32 + crow(r, hi);
        const bool ok = dir == 0 ? (s <= t) : (s >= t);
        const float d = ok ? bt + Gs[dir * 64 + s] : -INFINITY;
        dl[st][r] = d; mx = fmaxf(mx, d);
      }
    mx = max_xor32(mx);
    const float mt = fmaxf(inter, mx);
    const float iw = __expf(inter - mt);
    float rsum = 0.f;
#pragma unroll
    for (int st = 0; st < 2; ++st)
#pragma unroll
      for (int r = 0; r < 16; ++r) { const float w = __expf(dl[st][r] - mt); sa[st][r] *= w; rsum += sa[st][r]; }
    rsum = sum_xor32(rsum);
    float qn = 0.f;
#pragma unroll 8
    for (int i = 0; i < 32; ++i) { const int d = hi * 32 + i; qn += Ns[dir * 64 + d] * Qt[t * 65 + d]; }
    qn = sum_xor32(qn);
    const float den = rsum + iw * qn;
    const float rden = 1.f / fmaxf(fabsf(den), __expf(-mt));
    f32x16 an = {}, ac = {};
#pragma unroll
    for (int st = 0; st < 2; ++st)
#pragma unroll
      for (int r = 0; r < 16; ++r) {
        const float a = Vt[(st * 32 + crow(r, hi)) * 65 + et * 32 + r32];
        an = __builtin_amdgcn_mfma_f32_32x32x2f32(a, sa[st][r], an, 0, 0, 0);
      }
    const float* Cd = Cs + dir * 64 * 65;
#pragma unroll 4
    for (int ks = 0; ks < 32; ++ks) {
      const float a = Cd[(et * 32 + r32) * 65 + 2 * ks + hi];
      const float bq = Qt[t * 65 + 2 * ks + hi];
      ac = __builtin_amdgcn_mfma_f32_32x32x2f32(a, bq, ac, 0, 0, 0);
    }
#pragma unroll
    for (int r = 0; r < 16; ++r) HB[dir * 64 * 65 + t * 65 + et * 32 + crow(r, hi)] = (an[r] + iw * ac[r]) * rden;
  }
  __syncthreads();
  {
    const int t = tid >> 3, e8 = (tid & 7) * 8;
    float v[8]; float ss = 0.f;
#pragma unroll
    for (int i = 0; i < 8; ++i) { v[i] = HB[t * 65 + e8 + i] + HB[64 * 65 + t * 65 + e8 + i]; ss += v[i] * v[i]; }
    ss += dpp_mov<0xB1>(ss); ss += dpp_mov<0x4E>(ss); ss += dpp_mov<0x141>(ss);
    const float rs = rsqrtf(ss * (1.f / 64.f) + EPS);
    const u32x4 ov = *(const u32x4*)(PROJ + (size_t)(row0 + t) * PW + C_MO + hh * 64 + e8);
    const float og[8] = {bflo(ov.x), bfhi(ov.x), bflo(ov.y), bfhi(ov.y), bflo(ov.z), bfhi(ov.z), bflo(ov.w), bfhi(ov.w)};
    const float* g = p.in[I_MNORMG] + l * 64 + e8;
    float o[8];
#pragma unroll
    for (int i = 0; i < 8; ++i) o[i] = (ABL & 2) ? 0.f : v[i] * rs * g[i] * sigmoidf_(og[i]);
    u32x4 w; w.x = cvtpk(o[0], o[1]); w.y = cvtpk(o[2], o[3]); w.z = cvtpk(o[4], o[5]); w.w = cvtpk(o[6], o[7]);
    *(u32x4*)(MIX + (size_t)(row0 + t) * DM + 256 + hh * 64 + e8) = w;
  }
  __syncthreads();
}


struct MlOutPf { u32x4 q, k, v, c0, c1, ov; float ns0, ns1, g_ig, g_lf, mi; };
__device__ __forceinline__ void ml_out_fetch(const Params& p, int unit, int tid, MlOutPf& f) {
  const int lane = tid & 63, wid = tid >> 6;
  const bf16_t* PROJ = (const bf16_t*)(p.ws + WS_PROJ);
  const float* GT = (const float*)(p.ws + WS_GATES);
  const bf16_t* CST = (const bf16_t*)(p.ws + WS_CST); const float* NST = (const float*)(p.ws + WS_NST); const float* META = (const float*)(p.ws + WS_MLMETA);
  const int b = unit / (4 * NCH), hh = (unit / NCH) & 3, ch = unit % NCH;
  const int row0 = b * SEGL + ch * 64;
  const int r = tid >> 3, c8 = (tid & 7) * 8;
  const bf16_t* prow = PROJ + (size_t)(row0 + r) * PW + hh * 64 + c8;
  f.q = *(const u32x4*)(prow + C_MQ); f.k = *(const u32x4*)(prow + C_MK); f.v = *(const u32x4*)(prow + C_MV); f.ov = *(const u32x4*)(prow + C_MO);
  const int seq0 = (b * 4 + hh) * 2, ci0 = ml_cidx(ch, 0), ci1 = ml_cidx(ch, 1);
  f.c0 = *(const u32x4*)(CST + ((size_t)seq0 * NCH + ci0) * 4096 + r * 64 + c8);
  f.c1 = *(const u32x4*)(CST + ((size_t)(seq0 + 1) * NCH + ci1) * 4096 + r * 64 + c8);
  f.ns0 = 0.f; f.ns1 = 0.f; f.g_ig = 0.f; f.g_lf = 0.f; f.mi = 0.f;
  if (tid < 64) { f.ns0 = NST[((size_t)seq0 * NCH + ci0) * 64 + tid]; f.ns1 = NST[((size_t)(seq0 + 1) * NCH + ci1) * 64 + tid]; }
  if (wid < 2) {
    const int dir = wid;
    f.g_ig = GT[(size_t)(row0 + lane) * 16 + (2 * dir) * 4 + hh];
    f.g_lf = GT[(size_t)(row0 + lane) * 16 + (2 * dir + 1) * 4 + hh];
    f.mi = META[((size_t)(seq0 + dir) * NCH + (dir ? ci1 : ci0)) * 4 + 2];
  }
}
__device__ __forceinline__ void ml_put_rm(const u32x4 a, unsigned char* dst, int tid) { const int r = tid >> 3, c8 = (tid & 7) * 8; *(u32x4*)(dst + r * MLP + c8 * 2) = a; }
__device__ __forceinline__ void ml_put_tr(const u32x4 a, unsigned char* dst, int tid) {
  const int r = tid >> 3, c8 = (tid & 7) * 8;
  bf16_t* d = (bf16_t*)dst;
  d[(c8 + 0) * 72 + r] = (bf16_t)(a.x & 0xffffu); d[(c8 + 1) * 72 + r] = (bf16_t)(a.x >> 16);
  d[(c8 + 2) * 72 + r] = (bf16_t)(a.y & 0xffffu); d[(c8 + 3) * 72 + r] = (bf16_t)(a.y >> 16);
  d[(c8 + 4) * 72 + r] = (bf16_t)(a.z & 0xffffu); d[(c8 + 5) * 72 + r] = (bf16_t)(a.z >> 16);
  d[(c8 + 6) * 72 + r] = (bf16_t)(a.w & 0xffffu); d[(c8 + 7) * 72 + r] = (bf16_t)(a.w >> 16);
}
__device__ __forceinline__ void ml_out_unit2(const Params& p, int l, int unit, unsigned char* lds, const MlOutPf& f, int next, MlOutPf& fn) {
  int tid_ = tidx(); asm volatile("" : "+v"(tid_)); const int tid = tid_, lane = tid & 63, wid = tid >> 6, r32 = lane & 31, hi = lane >> 5;
  unsigned char* Qs = lds; unsigned char* Ks = lds + 64 * MLP; unsigned char* VT = lds + 2 * 64 * MLP; unsigned char* Cs = lds + 3 * 64 * MLP;
  float* Ns = (float*)(lds + 5 * 64 * MLP);
  float* Bq = Ns + 128;
  float* Gs = Bq + 128;
  float* Mi = Gs + 128;
  float* HB = Mi + 64;
  const bf16_t* PROJ = (const bf16_t*)(p.ws + WS_PROJ);
  const float* GT = (const float*)(p.ws + WS_GATES);
  const bf16_t* CST = (const bf16_t*)(p.ws + WS_CST); const float* NST = (const float*)(p.ws + WS_NST); const float* META = (const float*)(p.ws + WS_MLMETA);
  bf16_t* MIX = (bf16_t*)(p.ws + WS_MIX);
  const int b = unit / (4 * NCH), hh = (unit / NCH) & 3, ch = unit % NCH;
  const int row0 = b * SEGL + ch * 64;
  ml_put_rm(f.q, Qs, tid); ml_put_rm(f.k, Ks, tid); ml_put_tr(f.v, VT, tid);
  ml_put_rm(f.c0, Cs, tid); ml_put_rm(f.c1, Cs + 64 * MLP, tid);
  if (tid < 64) { Ns[tid] = f.ns0; Ns[64 + tid] = f.ns1; }
  if (wid < 2) {
    const int dir = wid;
    const float ig = f.g_ig;
    const float lf = logsigmoidf_(f.g_lf);
    float ps = lf;
    ps = wave_incl_scan(ps);
    const float tot = __uint_as_float((unsigned)__builtin_amdgcn_readlane((int)__float_as_uint(ps), 63));
    const float bc = dir == 0 ? ps : (tot - ps + lf);
    Bq[dir * 64 + lane] = bc; Gs[dir * 64 + lane] = ig - bc;
    if (lane == 0) Mi[dir] = f.mi;
  }
  const u32x4 ov = f.ov;
  if (next >= 0) ml_out_fetch(p, next, tid, fn);
  __syncthreads();
  {
    const int dir = wid >> 2, tt = (wid >> 1) & 1, et = wid & 1;
    const int t = tt * 32 + r32;
    f32x16 sa[2] = {};
    bf16x8 bq[4];
#pragma unroll
    for (int ks = 0; ks < 4; ++ks) {
      bq[ks] = *(const bf16x8*)(Qs + t * MLP + (ks * 16 + hi * 8) * 2);
      const bf16x8 a0 = *(const bf16x8*)(Ks + r32 * MLP + (ks * 16 + hi * 8) * 2), a1 = *(const bf16x8*)(Ks + (32 + r32) * MLP + (ks * 16 + hi * 8) * 2);
      sa[0] = __builtin_amdgcn_mfma_f32_32x32x16_bf16(a0, bq[ks], sa[0], 0, 0, 0);
      sa[1] = __builtin_amdgcn_mfma_f32_32x32x16_bf16(a1, bq[ks], sa[1], 0, 0, 0);
    }
    const float bt = Bq[dir * 64 + t];
    const float inter = bt + Mi[dir];
    float mx = -INFINITY;
    f32x16 dl[2];
#pragma unroll
    for (int st = 0; st < 2; ++st)
#pragma unroll
      for (int r = 0; r < 16; ++r) {
        const int s = st * 32 + crow(r, hi);
        const bool ok = dir == 0 ? (s <= t) : (s >= t);
        const float d = ok ? bt + Gs[dir * 64 + s] : -INFINITY;
        dl[st][r] = d; mx = fmaxf(mx, d);
      }
    mx = max_xor32(mx);
    const float mt = fmaxf(inter, mx);
    const float iw = __expf(inter - mt);
    float rsum = 0.f;
#pragma unroll
    for (int st = 0; st < 2; ++st)
#pragma unroll
      for (int r = 0; r < 16; ++r) { const float w = __expf(dl[st][r] - mt); sa[st][r] *= w; rsum += sa[st][r]; }
    rsum = sum_xor32(rsum);
    float qn = 0.f;
#pragma unroll
    for (int i = 0; i < 4; ++i) {
      const int d0 = hi * 32 + i * 8;
      const u32x4 qa = *(const u32x4*)(Qs + t * MLP + d0 * 2);
      const f32x4 n0 = *(const f32x4*)(Ns + dir * 64 + d0), n1 = *(const f32x4*)(Ns + dir * 64 + d0 + 4);
      qn += bflo(qa.x) * n0.x + bfhi(qa.x) * n0.y + bflo(qa.y) * n0.z + bfhi(qa.y) * n0.w + bflo(qa.z) * n1.x + bfhi(qa.z) * n1.y + bflo(qa.w) * n1.z + bfhi(qa.w) * n1.w;
    }
    qn = sum_xor32(qn);
    const float den = rsum + iw * qn;
    const float rden = 1.f / fmaxf(fabsf(den), __expf(-mt));
    f32x16 an = {}, ac = {};
#pragma unroll
    for (int st = 0; st < 2; ++st)
#pragma unroll
      for (int k2 = 0; k2 < 2; ++k2) {
        u32x4 bx; bx.x = cvtpk(sa[st][8 * k2 + 0], sa[st][8 * k2 + 1]); bx.y = cvtpk(sa[st][8 * k2 + 2], sa[st][8 * k2 + 3]);
        bx.z = cvtpk(sa[st][8 * k2 + 4], sa[st][8 * k2 + 5]); bx.w = cvtpk(sa[st][8 * k2 + 6], sa[st][8 * k2 + 7]);
        const unsigned char* vrow = VT + (et * 32 + r32) * MLP + (st * 32 + 16 * k2 + 4 * hi) * 2;
        const u32x2 v0 = *(const u32x2*)vrow, v1 = *(const u32x2*)(vrow + 16);
        u32x4 ax; ax.x = v0.x; ax.y = v0.y; ax.z = v1.x; ax.w = v1.y;
        an = __builtin_amdgcn_mfma_f32_32x32x16_bf16(*(const bf16x8*)&ax, *(const bf16x8*)&bx, an, 0, 0, 0);
      }
    const unsigned char* Cd = Cs + dir * 64 * MLP;
#pragma unroll
    for (int ks = 0; ks < 4; ++ks) {
      const bf16x8 a = *(const bf16x8*)(Cd + (et * 32 + r32) * MLP + (ks * 16 + hi * 8) * 2);
      ac = __builtin_amdgcn_mfma_f32_32x32x16_bf16(a, bq[ks], ac, 0, 0, 0);
    }
#pragma unroll
    for (int r = 0; r < 16; ++r) HB[dir * 64 * 65 + t * 65 + et * 32 + crow(r, hi)] = (an[r] + iw * ac[r]) * rden;
  }
  __syncthreads();
  {
    const int t = tid >> 3, e8 = (tid & 7) * 8;
    float v[8]; float ss = 0.f;
#pragma unroll
    for (int i = 0; i < 8; ++i) { v[i] = HB[t * 65 + e8 + i] + HB[64 * 65 + t * 65 + e8 + i]; ss += v[i] * v[i]; }
    ss += dpp_mov<0xB1>(ss); ss += dpp_mov<0x4E>(ss); ss += dpp_mov<0x141>(ss);
    const float rs = rsqrtf(ss * (1.f / 64.f) + EPS);
    const float og[8] = {bflo(ov.x), bfhi(ov.x), bflo(ov.y), bfhi(ov.y), bflo(ov.z), bfhi(ov.z), bflo(ov.w), bfhi(ov.w)};
    const float* g = p.in[I_MNORMG] + l * 64 + e8;
    float o[8];
#pragma unroll
    for (int i = 0; i < 8; ++i) o[i] = (ABL & 2) ? 0.f : v[i] * rs * g[i] * sigmoidf_(og[i]);
    u32x4 w; w.x = cvtpk(o[0], o[1]); w.y = cvtpk(o[2], o[3]); w.z = cvtpk(o[4], o[5]); w.w = cvtpk(o[6], o[7]);
    *(u32x4*)(MIX + (size_t)(row0 + t) * DM + 256 + hh * 64 + e8) = w;
  }
  __syncthreads();
}

#define KSWZ(row, colB) ((row) * 256 + ((colB) ^ (((row) & 15) << 4)))
#define SBAR() __builtin_amdgcn_sched_barrier(0)
constexpr int ATT_SHM_V = 128 * 80, ATT_SHM_K = 64 * QK8_PITCH;
constexpr float ATT_THR = 8.0f;
__device__ __forceinline__ int v_st(int k, int c) { const int kk = (k & ~0xC) | ((k & 4) << 1) | ((k & 8) >> 1); return ((kk >> 3) * 4 + (c >> 5)) * 512 + ((kk & 7) * 32 + (c & 31)) * 2; }
__device__ __forceinline__ int v_rd_base(int lane) { return ((lane & 3) << 3) | (((lane >> 2) & 3) << 6) | (((lane >> 4) & 1) << 5) | (((lane >> 5) & 1) << 8); }
constexpr int v_rd_off(int d0, int ks, int half) { return d0 * 512 + ks * 4096 + half * 2048; }
template <int OFF> __device__ __forceinline__ s16x4 tr_read(int vb) {
  s16x4 r; asm volatile("ds_read_b64_tr_b16 %0, %1 offset:%2" : "=&v"(r) : "v"(vb), "i"(OFF) : "memory"); return r;
}
template <int D0> __device__ __forceinline__ void pv_one(f32x16& od, int vb, bf16x8 pa0, bf16x8 pa1, bf16x8 pa2, bf16x8 pa3) {
  const s16x4 l0 = tr_read<v_rd_off(D0, 0, 0)>(vb), h0 = tr_read<v_rd_off(D0, 0, 1)>(vb), l1 = tr_read<v_rd_off(D0, 1, 0)>(vb), h1 = tr_read<v_rd_off(D0, 1, 1)>(vb);
  const s16x4 l2 = tr_read<v_rd_off(D0, 2, 0)>(vb), h2 = tr_read<v_rd_off(D0, 2, 1)>(vb), l3 = tr_read<v_rd_off(D0, 3, 0)>(vb), h3 = tr_read<v_rd_off(D0, 3, 1)>(vb);
  asm volatile("s_waitcnt lgkmcnt(0)" ::: "memory"); SBAR();
#define PK(L, H) (bf16x8){L[0], L[1], L[2], L[3], H[0], H[1], H[2], H[3]}
  od = __builtin_amdgcn_mfma_f32_32x32x16_bf16(pa0, PK(l0, h0), od, 0, 0, 0);
  od = __builtin_amdgcn_mfma_f32_32x32x16_bf16(pa1, PK(l1, h1), od, 0, 0, 0);
  od = __builtin_amdgcn_mfma_f32_32x32x16_bf16(pa2, PK(l2, h2), od, 0, 0, 0);
  od = __builtin_amdgcn_mfma_f32_32x32x16_bf16(pa3, PK(l3, h3), od, 0, 0, 0);
#undef PK
}
template <int D0> __device__ __forceinline__ void pv_two(f32x16& oa, f32x16& ob, int vb, bf16x8 a0, bf16x8 a1, bf16x8 a2, bf16x8 a3, bf16x8 b0, bf16x8 b1, bf16x8 b2, bf16x8 b3) {
  const s16x4 l0 = tr_read<v_rd_off(D0, 0, 0)>(vb), h0 = tr_read<v_rd_off(D0, 0, 1)>(vb), l1 = tr_read<v_rd_off(D0, 1, 0)>(vb), h1 = tr_read<v_rd_off(D0, 1, 1)>(vb);
  const s16x4 l2 = tr_read<v_rd_off(D0, 2, 0)>(vb), h2 = tr_read<v_rd_off(D0, 2, 1)>(vb), l3 = tr_read<v_rd_off(D0, 3, 0)>(vb), h3 = tr_read<v_rd_off(D0, 3, 1)>(vb);
  asm volatile("s_waitcnt lgkmcnt(0)" ::: "memory"); SBAR();
#define PK(L, H) (bf16x8){L[0], L[1], L[2], L[3], H[0], H[1], H[2], H[3]}
  const bf16x8 v0 = PK(l0, h0), v1 = PK(l1, h1), v2 = PK(l2, h2), v3 = PK(l3, h3);
  oa = __builtin_amdgcn_mfma_f32_32x32x16_bf16(a0, v0, oa, 0, 0, 0);
  ob = __builtin_amdgcn_mfma_f32_32x32x16_bf16(b0, v0, ob, 0, 0, 0);
  oa = __builtin_amdgcn_mfma_f32_32x32x16_bf16(a1, v1, oa, 0, 0, 0);
  ob = __builtin_amdgcn_mfma_f32_32x32x16_bf16(b1, v1, ob, 0, 0, 0);
  oa = __builtin_amdgcn_mfma_f32_32x32x16_bf16(a2, v2, oa, 0, 0, 0);
  ob = __builtin_amdgcn_mfma_f32_32x32x16_bf16(b2, v2, ob, 0, 0, 0);
  oa = __builtin_amdgcn_mfma_f32_32x32x16_bf16(a3, v3, oa, 0, 0, 0);
  ob = __builtin_amdgcn_mfma_f32_32x32x16_bf16(b3, v3, ob, 0, 0, 0);
#undef PK
}
struct KQFrag { bf16x8 b0, b1, q; };
__device__ __forceinline__ void att_ldkq(KQFrag& f, const LAS unsigned char* l3, int akk, int akq) {
  const LAS unsigned char* kp = l3 + akk;
  f.b0 = *(const LAS bf16x8*)kp; f.b1 = *(const LAS bf16x8*)(kp + 8192); f.q = *(const LAS bf16x8*)(l3 + akq);
}
#define ATT_MF(pa_, pb_, f_) do { pa_ = __builtin_amdgcn_mfma_f32_32x32x16_bf16(f_.b0, f_.q, pa_, 0, 0, 0); pb_ = __builtin_amdgcn_mfma_f32_32x32x16_bf16(f_.b1, f_.q, pb_, 0, 0, 0); } while (0)
__device__ __forceinline__ void att_qk_all(f32x16& p0, f32x16& p1, f32x16& q0, f32x16& q1, KQFrag& f0, const LAS unsigned char* l3, int akk0, int akq0, float ia, float ib) {
  KQFrag f1;
#pragma unroll
  for (int r = 0; r < 16; ++r) { p0[r] = ia; p1[r] = ia; q0[r] = ib; q1[r] = ib; }
  att_ldkq(f1, l3, akk0 ^ (1 << 5), akq0 ^ (1 << 5)); ATT_MF(p0, p1, f0); SBAR();
  att_ldkq(f0, l3, akk0 ^ (2 << 5), akq0 ^ (2 << 5)); ATT_MF(p0, p1, f1); SBAR();
  att_ldkq(f1, l3, akk0 ^ (3 << 5), akq0 ^ (3 << 5)); ATT_MF(p0, p1, f0); SBAR();
  att_ldkq(f0, l3, akk0 ^ (4 << 5), akq0 ^ (4 << 5)); ATT_MF(p0, p1, f1); SBAR();
  att_ldkq(f1, l3, akk0 ^ (5 << 5), akq0 ^ (5 << 5)); ATT_MF(q0, q1, f0); SBAR();
  att_ldkq(f0, l3, akk0 ^ (6 << 5), akq0 ^ (6 << 5)); ATT_MF(q0, q1, f1); SBAR();
  att_ldkq(f1, l3, akk0 ^ (7 << 5), akq0 ^ (7 << 5)); ATT_MF(q0, q1, f0); SBAR();
  ATT_MF(q0, q1, f1); SBAR();
}
__device__ __forceinline__ float bf16_near(float x) { return __uint_as_float((__float_as_uint(x) + 0x8000u) & 0xFFFF0000u); }
__device__ __forceinline__ void att_softmax(f32x16& p0, f32x16& p1, float& m_reg, float& l_reg, float& alpha, bool first, i32x8& pa) {
  alpha = 1.f;
  if (first) {
    float pmax = p0[0];
#pragma unroll
    for (int r = 1; r < 16; ++r) pmax = fmaxf(pmax, p0[r]);
#pragma unroll
    for (int r = 0; r < 16; ++r) pmax = fmaxf(pmax, p1[r]);
    { auto rr = __builtin_amdgcn_permlane32_swap(__float_as_uint(pmax), __float_as_uint(pmax), false, false);
      pmax = fmaxf(__uint_as_float(rr[0]), __uint_as_float(rr[1])); }
    pmax = bf16_near(pmax);
    alpha = 0.f; m_reg = pmax;
#pragma unroll
    for (int r = 0; r < 16; ++r) { p0[r] -= pmax; p1[r] -= pmax; }
  }
#pragma unroll
  for (int r = 0; r < 16; ++r) { p0[r] = __builtin_amdgcn_exp2f(p0[r]); p1[r] = __builtin_amdgcn_exp2f(p1[r]); }
  float ps;
  {
#define VADD(d_, a_, b_) asm("v_add_f32_e32 %0, %1, %2" : "=v"(d_) : "v"(a_), "v"(b_))
    float s0, s1, s2, s3;
    VADD(s0, p0[0], p0[1]); VADD(s1, p0[8], p0[9]); VADD(s2, p1[0], p1[1]); VADD(s3, p1[8], p1[9]);
#pragma unroll
    for (int r = 2; r < 8; ++r) { VADD(s0, s0, p0[r]); VADD(s1, s1, p0[8 + r]); VADD(s2, s2, p1[r]); VADD(s3, s3, p1[8 + r]); }
    VADD(s0, s0, s1); VADD(s2, s2, s3); VADD(ps, s0, s2);
#undef VADD
  }
  { auto rr = __builtin_amdgcn_permlane32_swap(__float_as_uint(ps), __float_as_uint(ps), false, false);
    ps = __uint_as_float(rr[0]) + __uint_as_float(rr[1]); }
  if (__builtin_expect(!first && __any(ps > 256.f), 0)) {
    float emax = p0[0];
#pragma unroll
    for (int r = 1; r < 16; ++r) emax = fmaxf(emax, p0[r]);
#pragma unroll
    for (int r = 0; r < 16; ++r) emax = fmaxf(emax, p1[r]);
    { auto rr = __builtin_amdgcn_permlane32_swap(__float_as_uint(emax), __float_as_uint(emax), false, false);
      emax = fmaxf(__uint_as_float(rr[0]), __uint_as_float(rr[1])); }
    const float m_new = bf16_near(m_reg + fmaxf(__builtin_amdgcn_logf(emax), 0.f));
    const float delta = m_new - m_reg;
    alpha = __builtin_amdgcn_exp2f(-delta); m_reg = m_new;
#pragma unroll
    for (int r = 0; r < 16; ++r) { p0[r] *= alpha; p1[r] *= alpha; }
    ps *= alpha;
  }
  l_reg = l_reg * alpha + ps;
#pragma unroll
  for (int v = 0; v < 4; ++v) {
    int w0, w1; asm volatile("" : "=v"(w0), "=v"(w1));
    w0 = __builtin_amdgcn_cvt_pk_fp8_f32(p0[4 * v], p0[4 * v + 1], w0, false); w0 = __builtin_amdgcn_cvt_pk_fp8_f32(p0[4 * v + 2], p0[4 * v + 3], w0, true);
    w1 = __builtin_amdgcn_cvt_pk_fp8_f32(p1[4 * v], p1[4 * v + 1], w1, false); w1 = __builtin_amdgcn_cvt_pk_fp8_f32(p1[4 * v + 2], p1[4 * v + 3], w1, true);
    pa[v] = w0; pa[4 + v] = w1;
  }
}
__device__ __forceinline__ void att_unit(const unsigned char* __restrict__ Q8, const unsigned char* __restrict__ K8, const unsigned char* __restrict__ V8, bf16_t* __restrict__ Ob,
                                         int nkeys, float lam, const float* __restrict__ ng, float oscale, unsigned char* lds) {
  int tid_ = tidx(); asm volatile("" : "+v"(tid_)); const int tid = tid_, wid = tid >> 6, lane = tid & 63, r32 = lane & 31, hi = lane >> 5;
  const int grp = __builtin_amdgcn_readfirstlane(wid >> 2);
  unsigned char* V_lds = lds; unsigned char* K_lds = lds + 2 * ATT_SHM_V;
  float* wsl = (float*)(lds + 2 * ATT_SHM_V + 2 * ATT_SHM_K) + wid * 64; float* li_l = wsl; float* al_l = wsl + 32;
  float m0 = 0.f, l0 = 0.f, m1 = 0.f, l1 = 0.f;
  f32x16 o0[4] = {}, o1[4] = {};
  unsigned char* Q_lds = lds + 2 * ATT_SHM_V + 2 * ATT_SHM_K + 2048;
#pragma unroll
  for (int i = 0; i < 5; ++i) { const int piece = __builtin_amdgcn_readfirstlane(wid) + 8 * i;
    if (piece < 36) __builtin_amdgcn_global_load_lds((const unsigned*)(Q8 + piece * 1024 + lane * 16), (LAS unsigned*)(Q_lds + piece * 1024), 16, 0, 0); }
  const unsigned ldsw = (unsigned)__builtin_amdgcn_readfirstlane(wid) * 1024u;
#define GSTAGE_K(b, k0) do { const unsigned char* ki_ = K8 + (size_t)(k0) * QK8_PITCH + tid * 16; \
      __builtin_amdgcn_global_load_lds((const unsigned*)ki_, (LAS unsigned*)(K_lds + (b) * ATT_SHM_K + ldsw), 16, 0, 0); \
      if (wid < 1) __builtin_amdgcn_global_load_lds((const unsigned*)(ki_ + 8192), (LAS unsigned*)(K_lds + (b) * ATT_SHM_K + 8192 + ldsw), 16, 0, 0); } while (0)
#define GSTAGE_V(b, k0) do { const unsigned char* vi_ = V8 + (size_t)((k0) >> 6) * ATT_SHM_V + tid * 16; \
      __builtin_amdgcn_global_load_lds((const unsigned*)vi_, (LAS unsigned*)(V_lds + (b) * ATT_SHM_V + ldsw), 16, 0, 0); \
      if (wid < 2) __builtin_amdgcn_global_load_lds((const unsigned*)(vi_ + 8192), (LAS unsigned*)(V_lds + (b) * ATT_SHM_V + 8192 + ldsw), 16, 0, 0); } while (0)
#define STAGE_PAIR(jj) do { GSTAGE_V((jj) & 1, (jj) * 64); if ((jj) + 1 < NT) GSTAGE_K((jj) & 1, ((jj) + 1) * 64); } while (0)
#define RESC(o, a) do { if (__any((a) < 1.f)) { if (hi == 0) al_l[r32] = (a); asm volatile("s_waitcnt lgkmcnt(0)" ::: "memory"); \
    _Pragma("unroll") for (int d = 0; d < 4; ++d) _Pragma("unroll") for (int r = 0; r < 16; ++r) o[d][r] *= al_l[crow(r, hi)]; } } while (0)
#define ATT_BAR() do { asm volatile("s_waitcnt lgkmcnt(0)" ::: "memory"); __builtin_amdgcn_s_barrier(); asm volatile("" ::: "memory"); } while (0)
#define ATT_LDK(dst_, off_) do { const u32x4 x0_ = *(const LAS u32x4*)(kb_ + (off_)), x1_ = *(const LAS u32x4*)(kb_ + (off_) + 16); \
      dst_[0] = (int)x0_.x; dst_[1] = (int)x0_.y; dst_[2] = (int)x0_.z; dst_[3] = (int)x0_.w; dst_[4] = (int)x1_.x; dst_[5] = (int)x1_.y; dst_[6] = (int)x1_.z; dst_[7] = (int)x1_.w; } while (0)
#define ATT_SC(acc_, kf_, qf_) acc_ = __builtin_amdgcn_mfma_scale_f32_32x32x64_f8f6f4(kf_, qf_, acc_, 0, 0, 0, 0x7F7F7F7F, 0, 0x7F7F7F7F)
#define ATT_LDQ(dst_, off_) do { const u32x4 x0_ = *(const LAS u32x4*)(qb_ + (off_)), x1_ = *(const LAS u32x4*)(qb_ + (off_) + 16); \
      dst_[0] = (int)x0_.x; dst_[1] = (int)x0_.y; dst_[2] = (int)x0_.z; dst_[3] = (int)x0_.w; dst_[4] = (int)x1_.x; dst_[5] = (int)x1_.y; dst_[6] = (int)x1_.z; dst_[7] = (int)x1_.w; } while (0)
#define ATT_INIT2(pa_, pb_, negm_) do { u32x4 oa_, ob_; unsigned z_ = 0u; asm volatile("" : "+v"(z_)); \
      oa_.x = hi ? z_ : 0x3F80u; oa_.y = z_; oa_.z = z_; oa_.w = z_; ob_.x = hi ? z_ : (__float_as_uint(negm_) >> 16); ob_.y = z_; ob_.z = z_; ob_.w = z_; \
      const f32x16 zz_ = {}; \
      pa_ = __builtin_amdgcn_mfma_f32_32x32x16_bf16(*(const bf16x8*)&oa_, *(const bf16x8*)&ob_, zz_, 0, 0, 0); \
      pb_ = __builtin_amdgcn_mfma_f32_32x32x16_bf16(*(const bf16x8*)&oa_, *(const bf16x8*)&ob_, zz_, 0, 0, 0); } while (0)
#define ATT_QK_ALL(ia_, ib_) do { ATT_INIT2(p0, p1, ia_); ATT_INIT2(q0, q1, ib_); SBAR(); \
      ATT_SC(p0, kf0, qf); SBAR(); ATT_LDK(kf0, 32 * QK8_PITCH); SBAR(); \
      ATT_SC(p1, kf0, qf); SBAR(); ATT_LDK(kf0, 64); ATT_LDQ(qf, 64); SBAR(); \
      ATT_SC(q0, kf0, qf); SBAR(); ATT_LDK(kf0, 32 * QK8_PITCH + 64); SBAR(); \
      ATT_SC(q1, kf0, qf); SBAR(); } while (0)
  const int NT = nkeys / 64;
  GSTAGE_K(1, 0); STAGE_PAIR(0);
  asm volatile("s_waitcnt vmcnt(0)" ::: "memory"); __syncthreads();
  f32x16 p0, p1, q0, q1; i32x8 pa, pb;
  const LAS unsigned char* l3 = (const LAS unsigned char*)lds;
  const int kofs0 = 2 * ATT_SHM_V + r32 * QK8_PITCH + hi * 32;
  const int qofs0 = 2 * ATT_SHM_V + 2 * ATT_SHM_K + 2048 + (__builtin_amdgcn_readfirstlane(wid) * 32 + r32) * QK8_PITCH + hi * 32;
  { i32x8 kf0, qf; const LAS unsigned char* kb_ = l3 + (kofs0 + ATT_SHM_K); const LAS unsigned char* qb_ = l3 + qofs0;
    ATT_LDK(kf0, 0); ATT_LDQ(qf, 0);
    ATT_QK_ALL(0.f, 0.f); }
  if (grp) ATT_BAR();
#pragma unroll 1
  for (int j = 0; j < NT; ++j) {
    const int cur = j & 1;
    const bool more = (j + 1 < NT);
    if (grp && more) STAGE_PAIR(j + 1);
    { float alphaA, alphaB;
      const bool first = (j == 0);
      att_softmax(p0, p1, m0, l0, alphaA, first, pa); SBAR();
      att_softmax(q0, q1, m1, l1, alphaB, first, pb); SBAR();
      RESC(o0, alphaA);
      RESC(o1, alphaB); }
    asm volatile("" : "+v"(pa), "+v"(pb), "+v"(m0), "+v"(l0), "+v"(m1), "+v"(l1));
    asm volatile("" : "+v"(o0[0]), "+v"(o0[1]), "+v"(o0[2]), "+v"(o0[3]), "+v"(o1[0]), "+v"(o1[1]), "+v"(o1[2]), "+v"(o1[3]));
    if (!grp) asm volatile("s_waitcnt vmcnt(0)" ::: "memory");
    ATT_BAR();
    if (!grp && more) STAGE_PAIR(j + 1);
    __builtin_amdgcn_s_setprio(1);
    {
      int kofs = kofs0, qofs = qofs0; asm volatile("" : "+v"(kofs), "+v"(qofs));
      const LAS unsigned char* kb_ = l3 + (kofs + cur * ATT_SHM_K); const LAS unsigned char* qb_ = l3 + qofs;
      i32x8 kf0, qf;
      const LAS unsigned char* vrow = l3 + (r32 * 80 + hi * 32 + cur * ATT_SHM_V);
      u32x4 va0 = *(const LAS u32x4*)vrow, va1 = *(const LAS u32x4*)(vrow + 16), vb0, vb1;
#define ATT_PV(d0_, x0_, x1_) do { i32x8 bv; bv[0] = (int)x0_.x; bv[1] = (int)x0_.y; bv[2] = (int)x0_.z; bv[3] = (int)x0_.w; bv[4] = (int)x1_.x; bv[5] = (int)x1_.y; bv[6] = (int)x1_.z; bv[7] = (int)x1_.w; \
        o0[d0_] = __builtin_amdgcn_mfma_scale_f32_32x32x64_f8f6f4(pa, bv, o0[d0_], 0, 0, 0, 0x7F7F7F7F, 0, 0x7F7F7F7F); \
        o1[d0_] = __builtin_amdgcn_mfma_scale_f32_32x32x64_f8f6f4(pb, bv, o1[d0_], 0, 0, 0, 0x7F7F7F7F, 0, 0x7F7F7F7F); } while (0)
      vb0 = *(const LAS u32x4*)(vrow + 32 * 80); vb1 = *(const LAS u32x4*)(vrow + 32 * 80 + 16); ATT_PV(0, va0, va1); SBAR();
      va0 = *(const LAS u32x4*)(vrow + 64 * 80); va1 = *(const LAS u32x4*)(vrow + 64 * 80 + 16); ATT_PV(1, vb0, vb1); SBAR();
      vb0 = *(const LAS u32x4*)(vrow + 96 * 80); vb1 = *(const LAS u32x4*)(vrow + 96 * 80 + 16); ATT_PV(2, va0, va1); SBAR();
      ATT_LDK(kf0, 0); ATT_LDQ(qf, 0);
      ATT_PV(3, vb0, vb1); SBAR();
#undef ATT_PV
      asm volatile("" : "+v"(o0[0]), "+v"(o0[1]), "+v"(o0[2]), "+v"(o0[3]), "+v"(o1[0]), "+v"(o1[1]), "+v"(o1[2]), "+v"(o1[3]));
      ATT_QK_ALL(-m0, -m1);
      asm volatile("" : "+v"(p0), "+v"(p1), "+v"(q0), "+v"(q1));
    }
    __builtin_amdgcn_s_setprio(0);
    if (grp) asm volatile("s_waitcnt vmcnt(0)" ::: "memory");
    ATT_BAR();
  }
  if (!grp) ATT_BAR();
  if (hi == 0) { li_l[r32] = 1.f / l0; al_l[r32] = lam / l1; }
  asm volatile("s_waitcnt lgkmcnt(0)" ::: "memory");
  float ss[16];
#pragma unroll
  for (int r = 0; r < 16; ++r) {
    const float a = li_l[crow(r, hi)], bq = al_l[crow(r, hi)];
    float s = 0.f;
#pragma unroll
    for (int d = 0; d < 4; ++d) { const float v = o0[d][r] * a - o1[d][r] * bq; o0[d][r] = v; s += v * v; }
    s += dpp_mov<0xB1>(s); s += dpp_mov<0x4E>(s); s += dpp_mov<0x141>(s); s += dpp_mov<0x140>(s);
    { auto rr_ = __builtin_amdgcn_permlane16_swap(__float_as_uint(s), __float_as_uint(s), false, false); s = __uint_as_float(rr_[0]) + __uint_as_float(rr_[1]); }
    ss[r] = rsqrtf(s * (1.f / 128.f) + EPS) * oscale;
  }
  bf16_t* Ow = Ob + (size_t)(wid * 32) * DM;
  unsigned char* ost = lds + 2 * ATT_SHM_V + 2 * ATT_SHM_K + 2048 + wid * (32 * 272);
#pragma unroll
  for (int d = 0; d < 4; ++d) {
    const float g = ng[d * 32 + r32];
#pragma unroll
    for (int r = 0; r < 16; ++r) *(bf16_t*)(ost + crow(r, hi) * 272 + (d * 32 + r32) * 2) = (ABL & 4) ? (bf16_t)0 : (bf16_t)(cvtpk(o0[d][r] * ss[r] * g, 0.f) & 0xffffu);
  }
  asm volatile("s_waitcnt lgkmcnt(0)" ::: "memory");
#pragma unroll
  for (int i = 0; i < 8; ++i) {
    const int c = lane + 64 * i, row = c >> 4, cb = (c & 15) * 16;
    *(u32x4*)((unsigned char*)(Ow + (size_t)row * DM) + cb) = *(const u32x4*)(ost + row * 272 + cb);
  }
  __syncthreads();
#undef ATT_INIT2
#undef ATT_LDK
#undef ATT_LDQ
#undef ATT_SC
#undef ATT_QK_ALL
#undef GSTAGE_K
#undef GSTAGE_V
#undef STAGE_PAIR
#undef RESC
#undef ATT_BAR
}

__device__ __forceinline__ float ins16(float (&a)[16], float x) {
#pragma unroll
  for (int i = 0; i < 16; ++i) { const float h = fmaxf(a[i], x); x = fminf(a[i], x); a[i] = h; }
  return x;
}
__device__ __forceinline__ void bsort16(float (&a)[16]) {
#pragma unroll
  for (int k = 2; k <= 16; k <<= 1)
#pragma unroll
    for (int j = k >> 1; j > 0; j >>= 1)
#pragma unroll
      for (int i = 0; i < 16; ++i) {
        const int q = i ^ j;
        if (q > i) {
          const bool desc = ((i & k) == 0);
          const float hi_ = fmaxf(a[i], a[q]), lo_ = fminf(a[i], a[q]);
          a[i] = desc ? hi_ : lo_; a[q] = desc ? lo_ : hi_;
        }
      }
}
__device__ __forceinline__ void bmerge16(float (&a)[16], const float (&b)[16]) {
#pragma unroll
  for (int i = 0; i < 16; ++i) a[i] = fmaxf(a[i], b[15 - i]);
#pragma unroll
  for (int j = 8; j > 0; j >>= 1)
#pragma unroll
    for (int i = 0; i < 16; ++i) {
      const int q = i ^ j;
      if (q > i) { const float hi_ = fmaxf(a[i], a[q]), lo_ = fminf(a[i], a[q]); a[i] = hi_; a[q] = lo_; }
    }
}
__device__ __forceinline__ float gelu_erf(float x) { return 0.5f * x * (1.f + erff(x * 0.70710678118654752440f)); }
#define XB_TMO      128
#define XB_XCNT(j)  (256  + 64 * (j))
#define XB_XSUB(j)  (1280 + 64 * (j))
#define XB_XGEN(j)  (2304 + 64 * (j))
#define XB_TOP      3328
#define XB_TOPGEN   3392
#define XCD_BAR_WORDS 3456
#define XB_SPIN_CAP (1u << 22)
__device__ __forceinline__ unsigned xb_ld(unsigned* p)              { return __hip_atomic_load(p, __ATOMIC_RELAXED, __HIP_MEMORY_SCOPE_AGENT); }
__device__ __forceinline__ unsigned xb_add(unsigned* p, unsigned v) { return __hip_atomic_fetch_add(p, v, __ATOMIC_RELAXED, __HIP_MEMORY_SCOPE_AGENT); }
__device__ __forceinline__ unsigned xb_xcc_id() { return (unsigned)__builtin_amdgcn_s_getreg((3 << 11) | 20) & 0xFu; }
#define XB_SPIN(cond, bar) do { unsigned _sp = 0; while (cond) { __builtin_amdgcn_s_sleep(1); \
    if ((++_sp & 255u) == 0u) { if (xb_ld(&(bar)[XB_TMO])) break; if (_sp > XB_SPIN_CAP) { atomicAdd(&(bar)[XB_TMO], 1u); break; } } } } while (0)
struct XcdBarrier { unsigned* bar; unsigned x; volatile LAS unsigned* st; };
__device__ __forceinline__ XcdBarrier xcd_barrier_post(unsigned* bar, volatile LAS unsigned* st) {
  XcdBarrier b; b.bar = bar; b.x = xb_xcc_id(); b.st = st;
  if (tidx() == 0) (void)xb_add(&bar[XB_XCNT(b.x)], 1u);
  return b;
}
__device__ __forceinline__ void xcd_barrier_complete(unsigned* bar, unsigned x, unsigned& nloc, unsigned& nx) {
  const unsigned G = gridDim.x * gridDim.y * gridDim.z;
  unsigned sum, cnt, mine, sp = 0u;
  for (;;) {
    sum = 0u; cnt = 0u; mine = 0u;
#pragma unroll
    for (unsigned j = 0; j < 16; ++j) { const unsigned c = xb_ld(&bar[XB_XCNT(j)]); sum += c; cnt += (c > 0u) ? 1u : 0u; mine = (j == x) ? c : mine; }
    if (sum == G) break;
    __builtin_amdgcn_s_sleep(1);
    if ((++sp & 255u) == 0u) { if (xb_ld(&bar[XB_TMO])) break; if (sp > XB_SPIN_CAP) { atomicAdd(&bar[XB_TMO], 1u); break; } }
  }
  nloc = mine > 0u ? mine : 1u; nx = cnt > 0u ? cnt : 1u;
}
__device__ __forceinline__ void xcd_barrier(const XcdBarrier& b) {
  asm volatile("s_waitcnt vmcnt(0)" ::: "memory");
  __syncthreads();
  if (tidx() == 0) {
    unsigned* bar = b.bar;
    __builtin_amdgcn_s_waitcnt(0);
    unsigned nloc = b.st[0], nx = b.st[1];
    if (nloc == 0u) { xcd_barrier_complete(bar, b.x, nloc, nx); b.st[0] = nloc; b.st[1] = nx; }
    const unsigned old = xb_add(&bar[XB_XSUB(b.x)], 1u);
    const unsigned gen = old / nloc;
    if (old + 1u == (gen + 1u) * nloc) {
      __builtin_amdgcn_fence(__ATOMIC_RELEASE, "agent");
      asm volatile("s_waitcnt vmcnt(0)" ::: "memory");
      const unsigned og = xb_add(&bar[XB_TOP], 1u);
      const unsigned tg = og / nx;
      if (og + 1u == (tg + 1u) * nx) xb_add(&bar[XB_TOPGEN], 1u);
      else XB_SPIN(xb_ld(&bar[XB_TOPGEN]) == tg, bar);
      __builtin_amdgcn_fence(__ATOMIC_ACQUIRE, "agent");
      xb_add(&bar[XB_XGEN(b.x)], 1u);
      asm volatile("s_waitcnt vmcnt(0)" ::: "memory");
    } else {
      XB_SPIN(xb_ld(&bar[XB_XGEN(b.x)]) == gen, bar);
      __builtin_amdgcn_fence(__ATOMIC_ACQUIRE, "agent");
      asm volatile("s_waitcnt vmcnt(0)" ::: "memory");
    }
  }
  __syncthreads();
}

constexpr size_t RT_STRIDE = (size_t)T * 128 * 4;
__device__ __forceinline__ void route_unit(const Params& p, int l, int unit, unsigned char* lds) {
  int tid_ = tidx(); asm volatile("" : "+v"(tid_)); const int tid = tid_, lane = tid & 63, wid = tid >> 6, r32 = lane & 31, hi = lane >> 5;
  unsigned char* IDX = lds;
  int* UE = (int*)(lds + 8192); float* UG = (float*)(lds + 8192 + 16384); float* US = (float*)(lds + 8192 + 32768);
  int* EIDG = (int*)(p.ws + WS_EID + (size_t)l * RT_STRIDE); float* GWG = (float*)(p.ws + WS_ULOC + RT_STRIDE); float* SUG = (float*)(p.ws + WS_ULOC + 2 * RT_STRIDE);
  const float* PSC = (const float*)(p.ws + WS_PSC);
  const int row0 = unit * 32;
  const bf16_t* QP = (const bf16_t*)(p.ws + WS_PROJ);
  const bf16_t* KEYS = (const bf16_t*)(p.ws + WS_KEYS) + (size_t)l * 131072;
  for (int rrep = 0; rrep < REP_ROUTE; ++rrep) {
    const int h = wid;
    float top[2][16];
    bf16x8 bq[4], bqn[4], akc[4], akn[4];
    {
      const bf16_t* qrow0 = QP + (size_t)(row0 + r32) * DM + h * 128 + hi * 8;
      const bf16_t* kb0 = KEYS + ((size_t)(h * 2) * 128 + r32) * 64 + hi * 8;
#pragma unroll
      for (int ks = 0; ks < 4; ++ks) { bq[ks] = *(const bf16x8*)(qrow0 + ks * 16); akc[ks] = *(const bf16x8*)(kb0 + ks * 16); }
    }
#pragma unroll
    for (int pp = 0; pp < 2; ++pp) {
      const bf16_t* kb = KEYS + ((size_t)(h * 2 + pp) * 128 + r32) * 64 + hi * 8;
      float (&lst)[16] = top[pp];
#pragma unroll
      for (int i = 0; i < 16; ++i) lst[i] = -INFINITY;
#pragma unroll
      for (int nt = 0; nt < 4; ++nt) {
        if (nt < 3) {
#pragma unroll
          for (int ks = 0; ks < 4; ++ks) akn[ks] = *(const bf16x8*)(kb + (size_t)(nt + 1) * 32 * 64 + ks * 16);
        } else if (pp == 0) {
          const bf16_t* qrow1 = QP + (size_t)(row0 + r32) * DM + h * 128 + 64 + hi * 8;
          const bf16_t* kb1 = KEYS + ((size_t)(h * 2 + 1) * 128 + r32) * 64 + hi * 8;
#pragma unroll
          for (int ks = 0; ks < 4; ++ks) { bqn[ks] = *(const bf16x8*)(qrow1 + ks * 16); akn[ks] = *(const bf16x8*)(kb1 + ks * 16); }
        }
        f32x16 acc = {};
#pragma unroll
        for (int ks = 0; ks < 4; ++ks) acc = __builtin_amdgcn_mfma_f32_32x32x16_bf16(akc[ks], bq[ks], acc, 0, 0, 0);
#pragma unroll
        for (int ks = 0; ks < 4; ++ks) { akc[ks] = akn[ks]; if (nt == 3) bq[ks] = bqn[ks]; }
        float grp[16];
#pragma unroll
        for (int r = 0; r < 16; ++r) grp[r] = __uint_as_float((__float_as_uint(acc[r]) & ~0x7Fu) | (unsigned)(nt * 32 + crow(r, hi)));
        bsort16(grp);
        if (nt == 0) {
#pragma unroll
          for (int i = 0; i < 16; ++i) lst[i] = grp[i];
        } else bmerge16(lst, grp);
        SBAR();
      }
      float oth[16];
#pragma unroll
      for (int i = 0; i < 16; ++i) { auto rr_ = __builtin_amdgcn_permlane32_swap(__float_as_uint(lst[i]), __float_as_uint(lst[i]), false, false); oth[i] = __uint_as_float(hi ? rr_[0] : rr_[1]); }
      bmerge16(lst, oth);
      if (hi == 0) {
        unsigned w[4];
#pragma unroll
        for (int i = 0; i < 4; ++i)
          w[i] = (__float_as_uint(lst[4 * i]) & 0x7Fu) | ((__float_as_uint(lst[4 * i + 1]) & 0x7Fu) << 8) | ((__float_as_uint(lst[4 * i + 2]) & 0x7Fu) << 16) | ((__float_as_uint(lst[4 * i + 3]) & 0x7Fu) << 24);
        *(u32x4*)(IDX + ((r32 * 8 + h) * 2 + pp) * 16) = (u32x4){w[0], w[1], w[2], w[3]};
      }
    }
    float best[16];
#define CAND(i, j) __uint_as_float((__float_as_uint(__uint_as_float(__float_as_uint(top[0][i]) & ~0x7Fu) + __uint_as_float(__float_as_uint(top[1][j]) & ~0x7Fu)) & ~0xFFu) | (unsigned)((i) * 16 + (j)))
    {
#pragma unroll
      for (int j = 0; j < 16; ++j) best[j] = CAND(0, j);
      float y[16];
#pragma unroll
      for (int j = 0; j < 8; ++j) { y[j] = CAND(1, j); y[8 + j] = CAND(15 - j, 0); }
#pragma unroll
      for (int jj = 8; jj > 0; jj >>= 1)
#pragma unroll
        for (int i = 0; i < 16; ++i) { const int q = i ^ jj; if (q > i) { const float hi_ = fmaxf(y[i], y[q]), lo_ = fminf(y[i], y[q]); y[i] = hi_; y[q] = lo_; } }
      bmerge16(best, y);
      float x[16];
      x[0] = CAND(2, 0); x[1] = CAND(2, 1); x[2] = CAND(2, 2); x[3] = CAND(2, 3); x[4] = CAND(2, 4);
      x[5] = CAND(3, 0); x[6] = CAND(3, 1); x[7] = CAND(3, 2); x[8] = CAND(3, 3);
      x[9] = CAND(4, 0); x[10] = CAND(4, 1); x[11] = CAND(4, 2);
      x[12] = CAND(5, 0); x[13] = CAND(5, 1); x[14] = CAND(6, 0); x[15] = CAND(6, 1);
      bsort16(x);
      bmerge16(best, x);
      ins16(best, CAND(7, 0)); ins16(best, CAND(7, 1));
    }
#undef CAND
    asm volatile("s_waitcnt lgkmcnt(0)" ::: "memory");
    if (hi == 0) {
      const unsigned char* ib = IDX + ((r32 * 8 + h) * 2) * 16;
      const float mx = __uint_as_float(__float_as_uint(best[0]) & ~0xFFu);
      float w[16]; float sum = 0.f;
#pragma unroll
      for (int k = 0; k < 16; ++k) { w[k] = __expf(__uint_as_float(__float_as_uint(best[k]) & ~0xFFu) - mx); sum += w[k]; }
      const float rsum = 1.f / sum;
      int ee[16]; float su_[16], sv_[16];
#pragma unroll
      for (int k = 0; k < 16; ++k) {
        const unsigned ij = __float_as_uint(best[k]) & 0xFFu;
        ee[k] = (int)ib[ij >> 4] * 128 + (int)ib[16 + (ij & 15)];
      }
#pragma unroll
      for (int k = 0; k < 16; ++k) { su_[k] = PSC[(size_t)l * NEXP + ee[k]]; sv_[k] = PSC[(size_t)(DEPTH + l) * NEXP + ee[k]]; }
#pragma unroll
      for (int k = 0; k < 16; ++k) {
        UE[r32 * 128 + h * 16 + k] = ee[k]; UG[r32 * 128 + h * 16 + k] = w[k] * rsum * sv_[k];
        US[r32 * 128 + h * 16 + k] = su_[k];
      }
    }
  }
  __syncthreads();
#pragma unroll 1
  for (int tt = 0; tt < 4; ++tt) {
    const int t = wid * 4 + tt;
    const int k0 = UE[t * 128 + lane], k1 = UE[t * 128 + 64 + lane];
    const float g0 = UG[t * 128 + lane], g1 = UG[t * 128 + 64 + lane], s0 = US[t * 128 + lane], s1 = US[t * 128 + 64 + lane];
    const int b0 = k0 >> 11, b1 = k1 >> 11;
    int base = 0, pos0 = 0, pos1 = 0;
#pragma unroll
    for (int b = 0; b < 8; ++b) {
      const unsigned long long m0 = __ballot(b0 == b), m1 = __ballot(b1 == b);
      const int c0 = __popcll(m0), c1 = __popcll(m1);
      const unsigned long long lt = (1ull << lane) - 1ull;
      if (b0 == b) pos0 = base + __popcll(m0 & lt);
      if (b1 == b) pos1 = base + c0 + __popcll(m1 & lt);
      base += c0 + c1;
    }
    const size_t ro = (size_t)(row0 + t) * 128;
    EIDG[ro + pos0] = k0; GWG[ro + pos0] = g0; SUG[ro + pos0] = s0;
    EIDG[ro + pos1] = k1; GWG[ro + pos1] = g1; SUG[ro + pos1] = s1;
  }
}
#define CAS __attribute__((address_space(4)))
typedef int i32x8 __attribute__((ext_vector_type(8)));
struct TokPref { f32x2 gs0, gs1; u32x4 hA, hB; };
struct RowPipe { i32x6 uq[4], vq[4]; i32x8 Ec; };
struct EpiVec { f32x4 g2[4], ng[4], sc[4], sh[4]; int mr; };
__device__ __forceinline__ const CAS i32x8* eid_row(const CAS unsigned char* eidg, int row) {
  return (const CAS i32x8*)(eidg + (size_t)(unsigned)__builtin_amdgcn_readfirstlane(row) * 512u);
}
__device__ __forceinline__ void tok_prefetch(const Params& p, int row, int lane, TokPref& t) {
  const float* GWG = (const float*)(p.ws + WS_ULOC + RT_STRIDE) + (size_t)row * 128;
  const float* SUG = (const float*)(p.ws + WS_ULOC + 2 * RT_STRIDE) + (size_t)row * 128;
  const bf16_t* H = (const bf16_t*)(p.ws + WS_H);
  t.gs0 = f32x2{GWG[lane], SUG[lane]}; t.gs1 = f32x2{GWG[64 + lane], SUG[64 + lane]};
  t.hA = *(const u32x4*)(H + (size_t)row * DM + lane * 16); t.hB = *(const u32x4*)(H + (size_t)row * DM + lane * 16 + 8);
}
#define LOADPAIR(dst_, tofs_, ea_, eb_) do { const u32x3v a_ = __builtin_amdgcn_raw_buffer_load_b96(rsT, lane12, (ea_) * PROW + (tofs_), 0); const unsigned b0_ = __builtin_amdgcn_raw_buffer_load_b32(rsT, lane12, (eb_) * PROW + (tofs_), 0); \
      const u32x2v b1_ = __builtin_amdgcn_raw_buffer_load_b64(rsT, lane12 + 4, (eb_) * PROW + (tofs_), 0); \
      dst_[0] = (int)a_.x; dst_[1] = (int)a_.y; dst_[2] = (int)a_.z; dst_[3] = (int)b0_; dst_[4] = (int)b1_.x; dst_[5] = (int)b1_.y; } while (0)
#define LOADGROUP(q_, tofs_, E_) do { LOADPAIR(q_[0], tofs_, E_[0], E_[1]); LOADPAIR(q_[1], tofs_, E_[2], E_[3]); LOADPAIR(q_[2], tofs_, E_[4], E_[5]); LOADPAIR(q_[3], tofs_, E_[6], E_[7]); } while (0)
constexpr int VOFS = (int)(WS_PV - WS_PU);
__device__ __forceinline__ void gather_token(const Params& p, const CAS unsigned char* eidg, const __amdgpu_buffer_rsrc_t rsT, int l, int row, int nextrow, TokPref& tp, RowPipe& rp, EpiVec& ev, unsigned char* lds, int lane, int wid) {
  f32x2* GS = (f32x2*)(lds + wid * 2048);
  float* XC = (float*)(p.ws + WS_XCUR);
  const float* MOD = (const float*)(p.ws + WS_MOD);
  const CAS i32x8* EP = eid_row(eidg, row);
  const bool hasnext = nextrow >= 0;
  const CAS i32x8* EPn = eid_row(eidg, hasnext ? nextrow : row);
  GS[lane] = tp.gs0; GS[64 + lane] = tp.gs1;
  asm volatile("s_waitcnt lgkmcnt(0)" ::: "memory");
  const int eofl = ((lane >> 5) & 1) + 2 * ((lane >> 4) & 1) + 4 * ((lane >> 3) & 1);
  const int lane12 = lane * 12;
  {
    h16x2 hh[8];
    {
      const u32x4 hA = tp.hA, hB = tp.hB;
      hh[0] = __builtin_bit_cast(h16x2, __builtin_amdgcn_cvt_pkrtz(bflo(hA.x), bfhi(hA.x))); hh[1] = __builtin_bit_cast(h16x2, __builtin_amdgcn_cvt_pkrtz(bflo(hA.y), bfhi(hA.y))); hh[2] = __builtin_bit_cast(h16x2, __builtin_amdgcn_cvt_pkrtz(bflo(hA.z), bfhi(hA.z))); hh[3] = __builtin_bit_cast(h16x2, __builtin_amdgcn_cvt_pkrtz(bflo(hA.w), bfhi(hA.w)));
      hh[4] = __builtin_bit_cast(h16x2, __builtin_amdgcn_cvt_pkrtz(bflo(hB.x), bfhi(hB.x))); hh[5] = __builtin_bit_cast(h16x2, __builtin_amdgcn_cvt_pkrtz(bflo(hB.y), bfhi(hB.y))); hh[6] = __builtin_bit_cast(h16x2, __builtin_amdgcn_cvt_pkrtz(bflo(hB.z), bfhi(hB.z))); hh[7] = __builtin_bit_cast(h16x2, __builtin_amdgcn_cvt_pkrtz(bflo(hB.w), bfhi(hB.w)));
    }
    if (hasnext) tok_prefetch(p, nextrow, lane, tp);
    { const int mr_ = mod_row(row);
      if (mr_ != ev.mr) {
        const float* g2_ = MOD + ((size_t)l * 5 + mr_) * 6144 + 5 * 1024 + lane * 16;
        const float* ng_ = (l == DEPTH - 1 ? p.in[I_FINALG] : p.in[I_N1G] + (l + 1) * DM) + lane * 16;
        const float* m_ = MOD + ((size_t)(l == DEPTH - 1 ? l : l + 1) * 5 + mr_) * 6144 + lane * 16;
#pragma unroll
        for (int v4 = 0; v4 < 4; ++v4) { ev.g2[v4] = *(const f32x4*)(g2_ + v4 * 4); ev.ng[v4] = *(const f32x4*)(ng_ + v4 * 4); ev.sc[v4] = *(const f32x4*)(m_ + 1024 + v4 * 4); ev.sh[v4] = *(const f32x4*)(m_ + v4 * 4); }
        ev.mr = mr_;
      } }
    f32x4 xpre[4];
    { const float* xr_ = XC + (size_t)row * DM + lane * 16;
#pragma unroll
      for (int v4 = 0; v4 < 4; ++v4) xpre[v4] = *(const f32x4*)(xr_ + v4 * 4); }
    f32x2 acc2[8];
#pragma unroll
    for (int i = 0; i < 8; ++i) acc2[i] = f32x2{0.f, 0.f};
#pragma unroll 1
    for (int g8 = 0; g8 < 16; ++g8) {
      const bool pf = (g8 < 15) || hasnext;
      const f32x2 gs = GS[g8 * 8 + eofl];
      float d[8];
#pragma unroll
      for (int i2 = 0; i2 < 4; ++i2) {
        const h16x32 r = __builtin_amdgcn_cvt_scalef32_pk32_f16_fp6(rp.uq[i2], 1.0f);
        float a0 = 0.f, a1 = 0.f, b0 = 0.f, b1 = 0.f;
#define UDOT(k_) a0 = __builtin_amdgcn_fdot2(__builtin_shufflevector(r, r, 4 * (k_), 4 * (k_) + 1), hh[2 * (k_)], a0, false); b0 = __builtin_amdgcn_fdot2(__builtin_shufflevector(r, r, 16 + 4 * (k_), 17 + 4 * (k_)), hh[2 * (k_)], b0, false); \
        a1 = __builtin_amdgcn_fdot2(__builtin_shufflevector(r, r, 4 * (k_) + 2, 4 * (k_) + 3), hh[2 * (k_) + 1], a1, false); b1 = __builtin_amdgcn_fdot2(__builtin_shufflevector(r, r, 18 + 4 * (k_), 19 + 4 * (k_)), hh[2 * (k_) + 1], b1, false);
        UDOT(0) UDOT(1) UDOT(2) UDOT(3)
#undef UDOT
        d[2 * i2] = a0 + a1;
        d[2 * i2 + 1] = b0 + b1;
        asm volatile("" : "+v"(d[2 * i2]), "+v"(d[2 * i2 + 1]));
      }
      if (pf) LOADGROUP(rp.uq, 0, rp.Ec);
      float tot;
      {
        auto s01 = __builtin_amdgcn_permlane32_swap(__float_as_uint(d[0]), __float_as_uint(d[1]), false, false);
        auto s23 = __builtin_amdgcn_permlane32_swap(__float_as_uint(d[2]), __float_as_uint(d[3]), false, false);
        auto s45 = __builtin_amdgcn_permlane32_swap(__float_as_uint(d[4]), __float_as_uint(d[5]), false, false);
        auto s67 = __builtin_amdgcn_permlane32_swap(__float_as_uint(d[6]), __float_as_uint(d[7]), false, false);
        const float q01 = __uint_as_float(s01[0]) + __uint_as_float(s01[1]), q23 = __uint_as_float(s23[0]) + __uint_as_float(s23[1]);
        const float q45 = __uint_as_float(s45[0]) + __uint_as_float(s45[1]), q67 = __uint_as_float(s67[0]) + __uint_as_float(s67[1]);
        auto ta = __builtin_amdgcn_permlane16_swap(__float_as_uint(q01), __float_as_uint(q23), false, false);
        auto tb = __builtin_amdgcn_permlane16_swap(__float_as_uint(q45), __float_as_uint(q67), false, false);
        const float r0123 = __uint_as_float(ta[0]) + __uint_as_float(ta[1]);
        const float r4567 = __uint_as_float(tb[0]) + __uint_as_float(tb[1]);
        const bool b3 = (lane & 8) != 0;
        const float keep = b3 ? r4567 : r0123, send = b3 ? r0123 : r4567;
        float x = keep + dpp_mov<0x140>(send);
        x += dpp_mov<0xB1>(x); x += dpp_mov<0x4E>(x); x += dpp_mov<0x141>(x);
        tot = x * gs.y;
      }
      float ge;
      {
        const float v = tot, av = fabsf(v), tq = __builtin_amdgcn_rcpf(av * 0.2316418882f + 1.0f);
        float q = tq * 0.5307027145f + (-0.7265760135f); q = q * tq + 0.7107068705f; q = q * tq + (-0.142248368f); q = q * tq + 0.127414796f; q = q * tq;
        const float ex = __builtin_amdgcn_exp2f(v * v * (-0.72134752044f));
        const float m = v * (q * ex), r = v - m;
        ge = (v < 0.f ? m : r) * gs.x;
      }
      unsigned cw[8];
      { const unsigned gp = __builtin_bit_cast(unsigned, __builtin_amdgcn_cvt_pkrtz(ge * 1024.f, ge * 1024.f));
        cw[0] = (unsigned)__builtin_amdgcn_readlane((int)gp, 0);  cw[4] = (unsigned)__builtin_amdgcn_readlane((int)gp, 8);
        cw[2] = (unsigned)__builtin_amdgcn_readlane((int)gp, 16); cw[6] = (unsigned)__builtin_amdgcn_readlane((int)gp, 24);
        cw[1] = (unsigned)__builtin_amdgcn_readlane((int)gp, 32); cw[5] = (unsigned)__builtin_amdgcn_readlane((int)gp, 40);
        cw[3] = (unsigned)__builtin_amdgcn_readlane((int)gp, 48); cw[7] = (unsigned)__builtin_amdgcn_readlane((int)gp, 56); }
      h16x2 a16[8];
#pragma unroll
      for (int i2 = 0; i2 < 4; ++i2) {
        const h16x32 r = __builtin_amdgcn_cvt_scalef32_pk32_f16_fp6(rp.vq[i2], 1.0f);
        const h16x2 ca = __builtin_bit_cast(h16x2, cw[2 * i2]), cb = __builtin_bit_cast(h16x2, cw[2 * i2 + 1]);
#define VAXL(k_) a16[k_] = (i2 == 0) ? ca * __builtin_shufflevector(r, r, 2 * (k_), 2 * (k_) + 1) : ca * __builtin_shufflevector(r, r, 2 * (k_), 2 * (k_) + 1) + a16[k_];
#define VAXH(k_) a16[k_] = cb * __builtin_shufflevector(r, r, 16 + 2 * (k_), 17 + 2 * (k_)) + a16[k_];
        VAXL(0) VAXL(1) VAXL(2) VAXL(3) VAXL(4) VAXL(5) VAXL(6) VAXL(7)
        asm volatile("" : "+v"(a16[0]), "+v"(a16[1]), "+v"(a16[2]), "+v"(a16[3]), "+v"(a16[4]), "+v"(a16[5]), "+v"(a16[6]), "+v"(a16[7]));
        VAXH(0) VAXH(1) VAXH(2) VAXH(3) VAXH(4) VAXH(5) VAXH(6) VAXH(7)
#undef VAXL
#undef VAXH
        asm volatile("" : "+v"(a16[0]), "+v"(a16[1]), "+v"(a16[2]), "+v"(a16[3]), "+v"(a16[4]), "+v"(a16[5]), "+v"(a16[6]), "+v"(a16[7]));
      }
#pragma unroll
      for (int k = 0; k < 8; ++k) acc2[k] = f32x2{(float)a16[k].x, (float)a16[k].y} * f32x2{1.f / 1024.f, 1.f / 1024.f} + acc2[k];
      if (pf) LOADGROUP(rp.vq, VOFS, rp.Ec);
      { const CAS i32x8* src_ = g8 < 14 ? EP + (g8 + 2) : EPn + (g8 - 14); rp.Ec = *src_; }
    }
    SBAR();
    float acc[16];
#pragma unroll
    for (int i = 0; i < 8; ++i) { acc[2 * i] = acc2[i].x; acc[2 * i + 1] = acc2[i].y; }
    float* xr = XC + (size_t)row * DM;
    float xn[16]; float ssq = 0.f;
    if (ABL & 8) {
#pragma unroll
      for (int i = 0; i < 16; ++i) acc[i] = 0.f;
    }
#pragma unroll
    for (int v4 = 0; v4 < 4; ++v4) {
      const int c = lane * 16 + v4 * 4;
      const f32x4 xo = xpre[v4], gg = ev.g2[v4];
      f32x4 o;
      o.x = xo.x + gg.x * acc[v4 * 4 + 0]; o.y = xo.y + gg.y * acc[v4 * 4 + 1]; o.z = xo.z + gg.z * acc[v4 * 4 + 2]; o.w = xo.w + gg.w * acc[v4 * 4 + 3];
      xn[v4 * 4 + 0] = o.x; xn[v4 * 4 + 1] = o.y; xn[v4 * 4 + 2] = o.z; xn[v4 * 4 + 3] = o.w;
      ssq += (o.x * o.x + o.y * o.y) + (o.z * o.z + o.w * o.w);
      if (l < DEPTH - 1) *(f32x4*)(xr + c) = o;
    }
    const float rs = rsqrtf(wave_sum_fast(ssq) * (1.f / DM) + EPS);
    if (l == DEPTH - 1) {
      const int b = row / SEGL, s = row - b * SEGL;
      float* orow = p.out + ((size_t)(b * SEQ + (s - CTXL))) * DM;
#pragma unroll
      for (int v4 = 0; v4 < 4; ++v4) {
        const int c = lane * 16 + v4 * 4;
        const f32x4 gg = ev.ng[v4];
        f32x4 o; o.x = xn[v4 * 4 + 0] * rs * gg.x; o.y = xn[v4 * 4 + 1] * rs * gg.y; o.z = xn[v4 * 4 + 2] * rs * gg.z; o.w = xn[v4 * 4 + 3] * rs * gg.w;
        *(f32x4*)(orow + c) = o;
      }
    } else {
      bf16_t* hrow = (bf16_t*)(p.ws + WS_H) + (size_t)row * DM;
#pragma unroll
      for (int hh = 0; hh < 2; ++hh) {
        float y[8];
#pragma unroll
        for (int i = 0; i < 8; ++i) { const int q_ = hh * 2 + (i >> 2), e_ = i & 3; y[i] = xn[hh * 8 + i] * rs * ev.ng[q_][e_] * (1.f + ev.sc[q_][e_]) + ev.sh[q_][e_]; }
        u32x4 w; w.x = cvtpk(y[0], y[1]); w.y = cvtpk(y[2], y[3]); w.z = cvtpk(y[4], y[5]); w.w = cvtpk(y[6], y[7]);
        *(u32x4*)(hrow + lane * 16 + hh * 8) = w;
      }
    }
  }
}

__device__ __forceinline__ void ev_signal(unsigned* ctr) {
  asm volatile("s_waitcnt vmcnt(0)" ::: "memory");
  __syncthreads();
  if (tidx() == 0) { __builtin_amdgcn_fence(__ATOMIC_RELEASE, "agent"); asm volatile("s_waitcnt vmcnt(0)" ::: "memory"); (void)xb_add(ctr, 1u); }
}
__device__ __forceinline__ void ev_wait(unsigned* ctr, unsigned n, unsigned* bar) {
  if (tidx() == 0) {
    XB_SPIN(xb_ld(ctr) < n, bar);
    __builtin_amdgcn_fence(__ATOMIC_ACQUIRE, "agent");
    asm volatile("s_waitcnt vmcnt(0)" ::: "memory");
  }
  __syncthreads();
}
constexpr int EV_WORD0 = 8192;
__device__ __forceinline__ void phase_c1(const Params& p, int l, unsigned char* lds) {
  constexpr int NLOC = NBATCH * 4 * NCH, NCONV = T / 32;
  for (int u = p.bx; u < NLOC + NCONV; u += p.gx) {
    if (u < NLOC) ml_local_unit2(p, l, u, lds);
    else {
      const int cu = u - NLOC;
      if (l == DEPTH - 1 && (cu % (SEGL / 32)) < (CTXL / 32)) continue;
      conv_unit(p, l, cu, lds);
    }
  }
}
__device__ __forceinline__ void phase_c3(const Params& p, int l, unsigned char* lds);
__device__ __forceinline__ void phase_c2(const Params& p, int l, unsigned char* lds) {
  unsigned* ev = (unsigned*)(p.ws + WS_CTL) + EV_WORD0 + 64 * l;
  ml_scan(p, lds);
  ev_signal(ev);
  const float* lp = p.in[I_DLAM] + l * 256;
  float s01 = 0.f, s23 = 0.f;
  for (int i = 0; i < 64; ++i) { s01 += lp[i] * lp[64 + i]; s23 += lp[128 + i] * lp[192 + i]; }
  const float lam_init = 0.8f - 0.6f * expf(-0.3f * (float)l);
  const float lam = __uint_as_float((unsigned)__builtin_amdgcn_readfirstlane((int)__float_as_uint(expf(s01) - expf(s23) + lam_init)));
  const bf16_t* PROJ = (const bf16_t*)(p.ws + WS_PROJ);
  bf16_t* MIX = (bf16_t*)(p.ws + WS_MIX);
  const float* ng = p.in[I_DNORMG] + l * 128;
  const int nun = 512 + (l < DEPTH - 1 ? 16 : 0);
  for (int u = p.bx; u < nun; u += p.gx) {
    int bh, qrow, nkeys;
    if (u < 512) { const int xcd = u & 7, i = (u >> 3) & 31, rnd = u >> 8; bh = 2 * xcd + rnd; qrow = CTXL + i * 256; nkeys = SEGL; }
    else { bh = u - 512; qrow = 0; nkeys = CTXL; }
    const int b = bh >> 2, h = bh & 3;
    const size_t tok0 = (size_t)b * SEGL;
    for (int rep = 0; rep < REP_ATT; ++rep)
    att_unit(p.ws + WS_QK8 + ((size_t)bh * SEGL + qrow) * QK8_PITCH, p.ws + WS_QK8 + QK8_IMG + (size_t)bh * SEGL * QK8_PITCH, p.ws + WS_V8T + (size_t)bh * NCH * ATT_SHM_V,
             MIX + (tok0 + qrow) * DM + 512 + h * 128, nkeys, lam, ng, 1.f - lam_init, lds);
  }
  ev_wait(ev, (unsigned)p.gx, p.xbar_words);
  for (int rep = 0; rep < REP_ML; ++rep) phase_c3(p, l, lds);
}
__device__ __forceinline__ void phase_c3(const Params& p, int l, unsigned char* lds) {
  constexpr int NU = NBATCH * 4 * NCH;
  const int nlow = (p.gx > 64 && l < DEPTH - 1) ? 16 : 0, ulow = nlow * 7;
  int u, step;
  if (p.bx < nlow) { u = p.bx; step = nlow; } else { u = ulow + (p.bx - nlow); step = p.gx - nlow; }
  const int uend = p.bx < nlow ? ulow : NU;
  int tid_ = tidx(); asm volatile("" : "+v"(tid_));
  auto valid_from = [&](int v) { while (v < uend && l == DEPTH - 1 && (v % NCH) < 4) v += step; return v < uend ? v : -1; };
  MlOutPf fa, fb;
  u = valid_from(u);
  if (u >= 0) ml_out_fetch(p, u, tid_, fa);
  while (u >= 0) {
    const int nx = valid_from(u + step);
    ml_out_unit2(p, l, u, lds, fa, nx, fb);
    fa = fb; u = nx;
  }
}
__device__ __forceinline__ void phase_route(const Params& p, int l, unsigned char* lds) {
  constexpr int NU = T / 32;
  for (int u = p.bx; u < NU; u += p.gx) {
    if (l == DEPTH - 1 && (u % (SEGL / 32)) < (CTXL / 32)) continue;
    route_unit(p, l, u, lds);
    __syncthreads();
  }
}
__device__ __forceinline__ void phase_gather(const Params& p, int l, unsigned char* lds) {
  int tid_ = tidx(); asm volatile("" : "+v"(tid_)); const int lane = tid_ & 63, wid = __builtin_amdgcn_readfirstlane(tid_ >> 6);
  const int gw = p.bx * 8 + wid, NGW = p.gx * 8;
  const int ntok = (l == DEPTH - 1) ? NBATCH * SEQ : T;
#define TOKROW(ti_) ((l == DEPTH - 1) ? ((ti_) / SEQ) * SEGL + CTXL + ((ti_) % SEQ) : (ti_))
  const CAS unsigned char* eidg = (const CAS unsigned char*)(p.ws + WS_EID + (size_t)l * RT_STRIDE);
  const __amdgpu_buffer_rsrc_t rsT = __builtin_amdgcn_make_buffer_rsrc((void*)(p.ws + WS_PU + (size_t)l * NEXP * PROW), 0, VOFS + NEXP * PROW, 0x00020000);
  const int nfull = ntok / NGW, rem = ntok - nfull * NGW, per = (rem % p.gx == 0) ? rem / p.gx : -1;
  auto tok_at = [&](int r) -> int {
    if (r < nfull) return gw + r * NGW;
    if (r > nfull || rem == 0) return -1;
    if (per >= 0) return wid < per ? nfull * NGW + p.bx * per + wid : -1;
    return gw + r * NGW < ntok ? gw + r * NGW : -1;
  };
  TokPref tp; RowPipe rp; EpiVec ev; ev.mr = -1;
  const int ti0 = tok_at(0);
  if (ti0 >= 0) {
    const int row0 = TOKROW(ti0); const int lane12 = lane * 12;
    tok_prefetch(p, row0, lane, tp);
    const CAS i32x8* EP0 = eid_row(eidg, row0);
    rp.Ec = EP0[0];
    LOADGROUP(rp.uq, 0, rp.Ec); LOADGROUP(rp.vq, VOFS, rp.Ec);
    rp.Ec = EP0[1];
  }
  XcdBarrier xb; xb.bar = p.xbar_words; xb.x = p.xbar_x; xb.st = (volatile LAS unsigned*)((LAS unsigned char*)lds + p.lds_st_off);
  const int nrounds = (ntok + NGW - 1) / NGW;
  for (int r = 0; r < nrounds; ++r) {
    const int ti = tok_at(r);
    if (ti >= 0) {
      const int row = TOKROW(ti);
      const int tn = tok_at(r + 1);
      const int nxt = tn >= 0 ? TOKROW(tn) : -1;
      gather_token(p, eidg, rsT, l, row, nxt, tp, rp, ev, lds, lane, wid);
    }
#if GATHER_SYNC
    if (r + 1 < nrounds) { XcdBarrier xb2 = xb; size_t zb_ = 0; asm volatile("" : "+s"(zb_)); xb2.bar = xb.bar + zb_; xb2.x = xb.x + (unsigned)zb_; xcd_barrier(xb2); }
#endif
  }
#undef TOKROW
}

__global__ void __launch_bounds__(512, 2) mk_fwd(KArgs ka) {
  cg::grid_group grid = cg::this_grid();
  extern __shared__ __attribute__((aligned(16))) unsigned char lds[];
  const int lo = ka.ph_lo, hi = ka.ph_hi;
#define IN(k) (lo <= (k) && (k) < hi)
#ifndef PHASEMASK
#define PHASEMASK 0xFFFF
#endif
#define PH(i) ((PHASEMASK >> (i)) & 1)
#define MKP(q) Params q; { size_t z_ = 0; asm volatile("" : "+s"(z_)); \
    q.in = (InTab)((const __attribute__((address_space(4))) char*)__builtin_amdgcn_kernarg_segment_ptr() + z_); \
    q.out = ka.out + z_; q.ws = ka.ws + z_; q.ph_lo = lo; q.ph_hi = hi; q.bx = (int)blockIdx.x + (int)z_; q.gx = (int)gridDim.x + (int)z_; q.xbar_words = xbar.bar + z_; q.xbar_x = xbar.x + (unsigned)z_; q.lds_st_off = (unsigned)(LDS_BYTES - 64); }
#define SEAM(k) do { if (IN(k) && IN((k) + 1)) { if ((k) == 0) grid.sync(); else { XcdBarrier xb_ = xbar; size_t zb_ = 0; asm volatile("" : "+s"(zb_)); xb_.bar = xbar.bar + zb_; xb_.x = xbar.x + (unsigned)zb_; xcd_barrier(xb_); } } } while (0)
  volatile LAS unsigned* xst = (volatile LAS unsigned*)((LAS unsigned char*)lds + (LDS_BYTES - 64));
  { const int t0_ = threadIdx.x;
    if (t0_ < 2) xst[t0_] = 0u;
    if ((t0_ & 63) == 0) *(volatile LAS int*)((LAS unsigned char*)lds + LDS_WTAB + 4 * hw_wave_key()) = t0_ >> 6; }
  __syncthreads();
  XcdBarrier xbar = xcd_barrier_post((unsigned*)(ka.ws + WS_CTL) + 4096, xst);
  { MKP(p)
    if (PH(0) && IN(0)) for (int rep = 0; rep < REP_MISC; ++rep) { p0_mod(p, lds, (float*)(p.ws + WS_MOD)); p0_convert(p, lds); }
  }
  SEAM(0);
  { MKP(p)
    if (PH(1) && IN(1)) phase_norm(p, 0, 0, true, false);
  }
  SEAM(1);
#define LAYER(LL) { \
    int l = (LL); asm volatile("" : "+s"(l)); \
    const int b = 2 + 9 * (LL); \
    { MKP(q) if (PH(2) && IN(b + 0)) for (int rep = 0; rep < REP_GEMM; ++rep) phase_inproj2(q, l, lds); } \
    SEAM(b + 0); \
    { MKP(q) if (PH(3) && IN(b + 1)) for (int rep = 0; rep < REP_ML; ++rep) phase_c1(q, l, lds); } \
    SEAM(b + 1); \
    { MKP(q) if (PH(4) && IN(b + 2)) phase_c2(q, l, lds); } \
    SEAM(b + 3); \
    { MKP(q) if (PH(6) && IN(b + 4)) phase_outproj2(q, l, lds); } \
    SEAM(b + 4); \
    { MKP(q) if (PH(7) && IN(b + 5)) for (int rep = 0; rep < REP_MISC; ++rep) phase_norm(q, l, 1, false, (LL) == DEPTH - 1); } \
    SEAM(b + 5); \
    { MKP(q) if (PH(8) && IN(b + 6)) for (int rep = 0; rep < REP_GEMM; ++rep) phase_peerq2(q, l, lds); } \
    SEAM(b + 6); \
    { MKP(q) if (PH(9) && IN(b + 7)) phase_route(q, l, lds); } \
    SEAM(b + 7); \
    { MKP(q) if (PH(9) && IN(b + 8)) phase_gather(q, l, lds); } \
    SEAM(b + 8); }
  LAYER(0) LAYER(1) LAYER(2) LAYER(3)
#undef LAYER
#undef IN
#undef SEAM
#undef MKP
}

extern "C" void kernel_launch(void* const* d_in, const int* in_sizes, int n_in, void* d_out, int out_size,
                              void* d_ws, size_t ws_size, hipStream_t stream) {
  static int grid = 0;
  if (grid == 0) {
    int dev = 0, cus = 0, per_cu = 0;
    (void)hipGetDevice(&dev);
    (void)hipDeviceGetAttribute(&cus, hipDeviceAttributeMultiprocessorCount, dev);
    (void)hipFuncSetAttribute((const void*)mk_fwd, hipFuncAttributeMaxDynamicSharedMemorySize, LDS_BYTES);
    (void)hipOccupancyMaxActiveBlocksPerMultiprocessor(&per_cu, (const void*)mk_fwd, 512, LDS_BYTES);
    fprintf(stderr, "kernel_launch: cus %d per_cu %d ws %zu (need %zu) n_in %d\n", cus, per_cu, ws_size, (size_t)WS_END, n_in);
    if (ws_size < WS_END || n_in != 23 || per_cu < 1) { fprintf(stderr, "kernel_launch: bad configuration, nothing launched\n"); grid = -1; return; }
    grid = cus;
  }
  if (grid < 0) return;
  (void)hipMemsetAsync((char*)d_ws + WS_CTL, 0, 65536, stream);
  KArgs p{};
  for (int i = 0; i < 23; ++i) p.in[i] = (const float*)d_in[i];
  p.out = (float*)d_out; p.ws = (unsigned char*)d_ws; p.ph_lo = 0; p.ph_hi = 38;
  void* args[] = {&p};
  hipError_t e = hipLaunchCooperativeKernel((const void*)mk_fwd, dim3(grid), dim3(512), args, LDS_BYTES, stream);
  if (e != hipSuccess) fprintf(stderr, "cooperative launch failed: %s (grid %d)\n", hipGetErrorString(e), grid);
}
```

```cpp
#include <hip/hip_runtime.h>
#include <hip/hip_cooperative_groups.h>
#include <cstdio>
#include <cstdint>
namespace cg = cooperative_groups;

constexpr int DM = 1024, NBATCH = 4, SEQ = 8192, CTXL = 256, SEGL = CTXL + SEQ, T = NBATCH * SEGL, DEPTH = 4;
constexpr int IN_W = 3088, PW = 3072;
constexpr int QK8_PITCH = 144; constexpr size_t QK8_IMG = (size_t)16 * SEGL * QK8_PITCH;
constexpr int C_A = 0, C_MQ = 512, C_MK = 768, C_MV = 1024, C_MO = 1280, C_DQ = 1536, C_DK = 2048, C_DV = 2560;
constexpr int NCH = SEGL / 64;
constexpr int NEXP = 16384;
constexpr float EPS = 1e-6f;
#ifndef ABL
#define ABL 0
#endif
#ifndef GATHER_SYNC
#define GATHER_SYNC 0
#endif
#ifndef REP_ATT
#define REP_ATT 1
#endif
#ifndef GP_MASK
#define GP_MASK 0x3FFF
#endif
#ifndef REP_PEER
#define REP_PEER 1
#endif
#ifndef REP_GEMM
#define REP_GEMM 1
#endif
#ifndef REP_ROUTE
#define REP_ROUTE 1
#endif
#ifndef REP_OUTP
#define REP_OUTP 1
#endif
#ifndef REP_ML
#define REP_ML 1
#endif
#ifndef REP_MISC
#define REP_MISC 1
#endif
constexpr float QSCALE = 0.125f * 1.4426950408889634f;

constexpr size_t MiB = 1u << 20;
constexpr size_t WS_CTL = 0, WS_MOD = 1 * MiB, WS_ROPE = 2 * MiB, WS_WG = 4 * MiB, WS_KEYS = 5 * MiB, WS_MLMETA = 6 * MiB,
                 WS_GATES = 7 * MiB, WS_WIN = 10 * MiB, WS_WOUT = 34 * MiB, WS_WQ = 42 * MiB, WS_PU = 50 * MiB, WS_PV = 114 * MiB, WS_PSC = 178 * MiB  , WS_H8 = 180 * MiB  , WS_W8 = 216 * MiB  ,
                 WS_XCUR = 306 * MiB, WS_H = 438 * MiB, WS_MIX = 504 * MiB, WS_PROJ = 570 * MiB, WS_ULOC = 768 * MiB, WS_V8T = 836 * MiB  , WS_EID = 858 * MiB  , WS_QK8 = 924 * MiB  , WS_END = 964 * MiB;
constexpr int USTRIDE = 4160;

constexpr int LDS_BYTES = 139264 + 512;
constexpr int LDS_WTAB = LDS_BYTES - 64 - 256;

#define LAS __attribute__((address_space(3)))
__device__ __forceinline__ int hw_wave_key() { return (int)(__builtin_amdgcn_s_getreg((5 << 11) | 4) & 63u); }
__device__ __forceinline__ int tidx() {
  extern __shared__ __attribute__((aligned(16))) unsigned char lds_dyn_[];
  const int w = __builtin_amdgcn_readfirstlane(*(const volatile LAS int*)((LAS unsigned char*)lds_dyn_ + LDS_WTAB + 4 * hw_wave_key()));
  unsigned z_ = 0u; asm volatile("" : "+v"(z_));
  return (w << 6) | (int)__builtin_amdgcn_mbcnt_hi(~0u, __builtin_amdgcn_mbcnt_lo(~0u, z_));
}
typedef unsigned short bf16_t;
typedef short bf16x8 __attribute__((ext_vector_type(8)));
typedef short s16x4 __attribute__((ext_vector_type(4)));
typedef float f32x4 __attribute__((ext_vector_type(4)));
typedef float f32x16 __attribute__((ext_vector_type(16)));
typedef unsigned u32x4 __attribute__((ext_vector_type(4)));
typedef unsigned u32x2 __attribute__((ext_vector_type(2)));
typedef __bf16 bf16x2v __attribute__((ext_vector_type(2)));
typedef int i32x8 __attribute__((ext_vector_type(8)));
typedef int i32x6 __attribute__((ext_vector_type(6)));
struct __attribute__((aligned(4))) u32x3 { unsigned x, y, z; };
typedef float f32x32 __attribute__((ext_vector_type(32)));
constexpr int PROW = 768;
typedef float f32x2 __attribute__((ext_vector_type(2)));
typedef _Float16 h16x2 __attribute__((ext_vector_type(2)));
typedef _Float16 h16x32 __attribute__((ext_vector_type(32)));
typedef unsigned u32x3v __attribute__((ext_vector_type(3)));
typedef unsigned u32x2v __attribute__((ext_vector_type(2)));

struct KArgs {
  const float* in[23];
  float* out;
  unsigned char* ws;
  int ph_lo, ph_hi;
};
typedef const float* const __attribute__((address_space(4))) * InTab;
struct Params {
  InTab in;
  float* out;
  unsigned char* ws;
  int ph_lo, ph_hi;
  int bx, gx;
  unsigned* xbar_words; unsigned xbar_x; unsigned lds_st_off;
};
enum { I_X = 0, I_C, I_CTX, I_CCTX, I_ADAW, I_ADAB, I_N1G, I_N2G, I_WIN, I_CONVW, I_CONVB, I_CLNG, I_CLNB, I_GATEB, I_MNORMG, I_DLAM, I_DNORMG,
       I_WOUT, I_PWQ, I_PKEYS, I_PU, I_PV, I_FINALG };

__device__ __forceinline__ unsigned cvtpk(float lo, float hi) { unsigned r; asm volatile("v_cvt_pk_bf16_f32 %0, %1, %2" : "=v"(r) : "v"(lo), "v"(hi)); return r; }
__device__ __forceinline__ float bflo(unsigned u) { return __uint_as_float(u << 16); }
__device__ __forceinline__ float bfhi(unsigned u) { return __uint_as_float(u & 0xffff0000u); }
__device__ __forceinline__ float bf1(bf16_t u) { return __uint_as_float(((unsigned)u) << 16); }
__device__ __forceinline__ int crow(int r, int hi) { return (r & 3) + 8 * (r >> 2) + 4 * hi; }
template <int CTRL> __device__ __forceinline__ float dpp_mov(float v) {
  return __uint_as_float((unsigned)__builtin_amdgcn_update_dpp(0, (int)__float_as_uint(v), CTRL, 0xF, 0xF, true));
}
__device__ __forceinline__ float wave_sum_fast(float x) {
  x += dpp_mov<0xB1>(x); x += dpp_mov<0x4E>(x); x += dpp_mov<0x141>(x); x += dpp_mov<0x140>(x);
  { auto r = __builtin_amdgcn_permlane16_swap(__float_as_uint(x), __float_as_uint(x), false, false); x = __uint_as_float(r[0]) + __uint_as_float(r[1]); }
  { auto r = __builtin_amdgcn_permlane32_swap(__float_as_uint(x), __float_as_uint(x), false, false); x = __uint_as_float(r[0]) + __uint_as_float(r[1]); }
  return x;
}
__device__ __forceinline__ float wave_max_fast(float x) {
  x = fmaxf(x, dpp_mov<0xB1>(x)); x = fmaxf(x, dpp_mov<0x4E>(x)); x = fmaxf(x, dpp_mov<0x141>(x)); x = fmaxf(x, dpp_mov<0x140>(x));
  { auto r = __builtin_amdgcn_permlane16_swap(__float_as_uint(x), __float_as_uint(x), false, false); x = fmaxf(__uint_as_float(r[0]), __uint_as_float(r[1])); }
  { auto r = __builtin_amdgcn_permlane32_swap(__float_as_uint(x), __float_as_uint(x), false, false); x = fmaxf(__uint_as_float(r[0]), __uint_as_float(r[1])); }
  return x;
}
template <int CTRL, int ROWMASK> __device__ __forceinline__ float dpp_mov_rm(float v) {
  return __uint_as_float((unsigned)__builtin_amdgcn_update_dpp(0, (int)__float_as_uint(v), CTRL, ROWMASK, 0xF, true));
}
__device__ __forceinline__ float wave_incl_scan(float x) {
  x += dpp_mov<0x111>(x); x += dpp_mov<0x112>(x); x += dpp_mov<0x114>(x); x += dpp_mov<0x118>(x);
  x += dpp_mov_rm<0x142, 0xA>(x);
  x += dpp_mov_rm<0x143, 0xC>(x);
  return x;
}
__device__ __forceinline__ float wave_sum(float v) { return wave_sum_fast(v); }
__device__ __forceinline__ float sum_xor32(float x) { auto r = __builtin_amdgcn_permlane32_swap(__float_as_uint(x), __float_as_uint(x), false, false); return __uint_as_float(r[0]) + __uint_as_float(r[1]); }
__device__ __forceinline__ float max_xor32(float x) { auto r = __builtin_amdgcn_permlane32_swap(__float_as_uint(x), __float_as_uint(x), false, false); return fmaxf(__uint_as_float(r[0]), __uint_as_float(r[1])); }
__device__ __forceinline__ float wave_max(float v) { return wave_max_fast(v); }
__device__ __forceinline__ float sigmoidf_(float x) { return 1.f / (1.f + __expf(-x)); }
__device__ __forceinline__ float logsigmoidf_(float x) { return fminf(x, 0.f) - log1pf(__expf(-fabsf(x))); }
__device__ __forceinline__ const float* in_row(const float* x, const float* ctx, int row) {
  const int b = row / SEGL, s = row - b * SEGL;
  return s < CTXL ? ctx + ((size_t)(b * CTXL + s)) * DM : x + ((size_t)(b * SEQ + (s - CTXL))) * DM;
}
__device__ __forceinline__ int mod_row(int row) { const int b = row / SEGL, s = row - b * SEGL; return s < CTXL ? 4 : b; }

__device__ __forceinline__ void p0_mod(const Params& p, unsigned char* lds, float* MOD) {
  float* sil = (float*)lds;
  float* red = (float*)(lds + 20480);
  int tid_ = tidx(); asm volatile("" : "+v"(tid_)); const int tid = tid_, lane = tid & 63, wid = tid >> 6;
  for (int i = tid; i < 5 * 1024; i += 512) {
    const float v = i < 4096 ? p.in[I_C][i] : p.in[I_CCTX][i - 4096];
    sil[i] = v / (1.f + __expf(-v));
  }
  __syncthreads();
  for (int item = p.bx; item < DEPTH * 96; item += p.gx) {
    const int l = item / 96, j0 = (item % 96) * 64;
    const float* W = p.in[I_ADAW] + (size_t)l * DM * 6144 + j0 + lane;
    float a0 = 0.f, a1 = 0.f, a2 = 0.f, a3 = 0.f, a4 = 0.f;
    const int k0 = wid * 128;
#pragma unroll 8
    for (int k = k0; k < k0 + 128; ++k) {
      const float w = W[(size_t)k * 6144];
      a0 += sil[k] * w; a1 += sil[1024 + k] * w; a2 += sil[2048 + k] * w; a3 += sil[3072 + k] * w; a4 += sil[4096 + k] * w;
    }
    red[(wid * 5 + 0) * 64 + lane] = a0; red[(wid * 5 + 1) * 64 + lane] = a1; red[(wid * 5 + 2) * 64 + lane] = a2;
    red[(wid * 5 + 3) * 64 + lane] = a3; red[(wid * 5 + 4) * 64 + lane] = a4;
    __syncthreads();
    if (tid < 320) {
      const int r = tid >> 6;
      float s = 0.f;
#pragma unroll
      for (int w = 0; w < 8; ++w) s += red[(w * 5 + r) * 64 + lane];
      MOD[((size_t)l * 5 + r) * 6144 + j0 + lane] = s + p.in[I_ADAB][l * 6144 + j0 + lane];
    }
    __syncthreads();
  }
}
__device__ __forceinline__ void transpose_item(const float* W, int ldw, int srccol0, bf16_t* WT, int K, int n0, int k0, float* scr, int lane, unsigned char* W8 = nullptr) {
#pragma unroll 8
  for (int i = 0; i < 32; ++i) { const int kk = 2 * i + (lane >> 5); scr[kk * 33 + (lane & 31)] = W[(size_t)(k0 + kk) * ldw + srccol0 + (lane & 31)]; }
  asm volatile("s_waitcnt lgkmcnt(0)" ::: "memory");
  const int c = lane & 7;
#pragma unroll
  for (int j = 0; j < 4; ++j) {
    const int n = (lane >> 3) + 8 * j; const float* s = scr + (8 * c) * 33 + n;
    u32x4 o; o.x = cvtpk(s[0], s[33]); o.y = cvtpk(s[66], s[99]); o.z = cvtpk(s[132], s[165]); o.w = cvtpk(s[198], s[231]);
    *(u32x4*)(WT + (size_t)(n0 + n) * K + k0 + 8 * c) = o;
    if (W8) {
      int w0 = 0, w1 = 0;
      w0 = __builtin_amdgcn_cvt_pk_fp8_f32(s[0] * 32.f, s[33] * 32.f, w0, false); w0 = __builtin_amdgcn_cvt_pk_fp8_f32(s[66] * 32.f, s[99] * 32.f, w0, true);
      w1 = __builtin_amdgcn_cvt_pk_fp8_f32(s[132] * 32.f, s[165] * 32.f, w1, false); w1 = __builtin_amdgcn_cvt_pk_fp8_f32(s[198] * 32.f, s[231] * 32.f, w1, true);
      *(u32x2*)(W8 + (size_t)(n0 + n) * K + k0 + 8 * c) = (u32x2){(unsigned)w0, (unsigned)w1};
    }
  }
  asm volatile("s_waitcnt lgkmcnt(0)" ::: "memory");
}
__device__ __forceinline__ void convert_tables(const Params& p, int L, int wv, int nw, int lane, int r_lo, int r_hi) {
  unsigned char* PUq = p.ws + WS_PU; unsigned char* PVq = p.ws + WS_PV; float* PSC = (float*)(p.ws + WS_PSC);
  const int nrows = DEPTH * NEXP;
#define TAB_SROW(r_) ((const f32x4*)(((r_) >= NEXP ? p.in[I_PV] : p.in[I_PU]) + (size_t)(L * NEXP + ((r_) >= NEXP ? (r_) - NEXP : (r_))) * DM) + lane * 4)
#define TAB_LOAD(v_, r_) do { if ((r_) < r_hi) { const f32x4* s_ = TAB_SROW(r_); _Pragma("unroll") for (int j = 0; j < 4; ++j) v_[j] = __builtin_nontemporal_load(s_ + j); } } while (0)
  auto encode_row = [&](const f32x4 (&v)[4], int r) {
    const int tb = r >= NEXP, rr = L * NEXP + (tb ? r - NEXP : r);
    float mx = 0.f;
#pragma unroll
    for (int j = 0; j < 4; ++j) mx = fmaxf(mx, fmaxf(fmaxf(fabsf(v[j].x), fabsf(v[j].y)), fmaxf(fabsf(v[j].z), fabsf(v[j].w))));
    mx = wave_max_fast(mx);
    const unsigned mb = __float_as_uint(mx);
    const int eb = (int)((mb >> 23) & 0xFFu);
    int sb = ((mb & 0x7FFFFFu) <= 0x700000u ? 129 : 128) - eb + 127; sb = sb < 1 ? 1 : (sb > 253 ? 253 : sb);
    const float sc = __uint_as_float((unsigned)sb << 23), isc = __uint_as_float((unsigned)(254 - sb) << 23);
    const float xv[16] = {v[0].x, v[0].y, v[0].z, v[0].w, v[1].x, v[1].y, v[1].z, v[1].w, v[2].x, v[2].y, v[2].z, v[2].w, v[3].x, v[3].y, v[3].z, v[3].w};
    unsigned wq[3] = {0u, 0u, 0u};
#pragma unroll
    for (int i = 0; i < 16; ++i) {
      const float a = fabsf(xv[i]) * sc;
      unsigned code = a < 2.f ? (unsigned)__builtin_rintf(a * 8.f) : (a < 4.f ? 8u + (unsigned)__builtin_rintf(a * 4.f) : 16u + (unsigned)__builtin_rintf(a * 2.f));
      code = code > 31u ? 31u : code;
      code |= (xv[i] < 0.f) ? 32u : 0u;
      const int bp = 6 * i, dw = bp >> 5, off = bp & 31;
      wq[dw] |= code << off;
      if (off > 26) wq[dw + 1] |= code >> (32 - off);
    }
    u32x3 o; o.x = wq[0]; o.y = wq[1]; o.z = wq[2];
    *(u32x3*)((tb ? PVq : PUq) + (size_t)rr * PROW + lane * 12) = o;
    if (lane == 0) PSC[(size_t)tb * nrows + rr] = isc;
  };
  f32x4 v0[4], v1[4], v2[4];
  TAB_LOAD(v0, r_lo + wv); TAB_LOAD(v1, r_lo + wv + nw);
#pragma unroll 1
  for (int r = r_lo + wv; r < r_hi; r += 3 * nw) {
    TAB_LOAD(v2, r + 2 * nw); encode_row(v0, r);
    if (r + nw < r_hi) { TAB_LOAD(v0, r + 3 * nw); encode_row(v1, r + nw); }
    if (r + 2 * nw < r_hi) { TAB_LOAD(v1, r + 4 * nw); encode_row(v2, r + 2 * nw); }
  }
#undef TAB_LOAD
#undef TAB_SROW
}
__device__ __forceinline__ void tail_filler_tables(const Params& p, int L, int nwg, int r_lo, int r_hi) {
  int tid_ = tidx(); asm volatile("" : "+v"(tid_)); const int lane = tid_ & 63, wid = tid_ >> 6;
  const int nextra = nwg % p.gx, first = nextra, nidle = p.gx - nextra;
  if (p.bx < first) return;
  convert_tables(p, L, (p.bx - first) * 8 + wid, nidle * 8, lane, r_lo, r_hi);
}
__device__ __forceinline__ void p0_convert(const Params& p, unsigned char* lds) {
  int tid_ = tidx(); asm volatile("" : "+v"(tid_)); const int tid = tid_, lane = tid & 63, wid = tid >> 6;
  const int gw = p.bx * 8 + wid, NGW = p.gx * 8;
  const size_t gt = (size_t)p.bx * 512 + tid, NGT = (size_t)p.gx * 512;
  float* scr = (float*)(lds + 32768) + wid * (64 * 33);
  bf16_t* WIN = (bf16_t*)(p.ws + WS_WIN); bf16_t* WOUT = (bf16_t*)(p.ws + WS_WOUT); bf16_t* WQ = (bf16_t*)(p.ws + WS_WQ);
  constexpr int I_IN = 16 * 96, I_O = 16 * 32, PER_L = I_IN + 2 * I_O;
  for (int it = gw; it < DEPTH * PER_L; it += NGW) {
    const int l = it / PER_L; int r = it % PER_L;
    if (r < I_IN) { const int kb = r / 96, nb = r % 96, n0 = nb * 32; const int src = n0 < 1536 ? n0 : n0 + 16;
      transpose_item(p.in[I_WIN] + (size_t)l * DM * IN_W, IN_W, src, WIN + (size_t)l * PW * DM, DM, n0, kb * 64, scr, lane, n0 >= C_DQ ? p.ws + WS_W8 + (size_t)l * PW * DM : nullptr); continue; }
    r -= I_IN;
    if (r < I_O) { const int kb = r / 32, nb = r % 32;
      transpose_item(p.in[I_WOUT] + (size_t)l * DM * DM, DM, nb * 32, WOUT + (size_t)l * DM * DM, DM, nb * 32, kb * 64, scr, lane); continue; }
    r -= I_O;
    { const int kb = r / 32, nb = r % 32;
      transpose_item(p.in[I_PWQ] + (size_t)l * DM * DM, DM, nb * 32, WQ + (size_t)l * DM * DM, DM, nb * 32, kb * 64, scr, lane); }
  }
  bf16_t* WG = (bf16_t*)(p.ws + WS_WG);
  for (size_t i = gt; i < (size_t)DEPTH * 16 * DM; i += NGT) {
    const int l = (int)(i / (16 * DM)), g = (int)((i / DM) % 16), k = (int)(i % DM);
    WG[i] = (bf16_t)(cvtpk(p.in[I_WIN][(size_t)l * DM * IN_W + (size_t)k * IN_W + 1536 + g], 0.f) & 0xffffu);
  }
  bf16_t* KEYS = (bf16_t*)(p.ws + WS_KEYS);
  for (size_t i = gt; i < (size_t)DEPTH * 131072 / 8; i += NGT) {
    const f32x4 a = ((const f32x4*)p.in[I_PKEYS])[2 * i], b = ((const f32x4*)p.in[I_PKEYS])[2 * i + 1];
    u32x4 o; o.x = cvtpk(a.x, a.y); o.y = cvtpk(a.z, a.w); o.z = cvtpk(b.x, b.y); o.w = cvtpk(b.z, b.w);
    ((u32x4*)KEYS)[i] = o;
  }
  {
    float* RC = (float*)(p.ws + WS_ROPE); float* RS = RC + SEQ * 32;
    for (size_t i = gt; i < (size_t)SEQ * 32; i += NGT) {
      const int pos = (int)(i >> 5), j = (int)(i & 31);
      const int rr = pos >> 6, cc = pos & 63;
      const int jj = j & 15;
      const double e = -(double)jj * 0.83048202372184058696;
      const double fl = __builtin_floor(e); const double f = e - fl;
      const double z = f * 0.69314718055994530942;
      double ez = 1.0 + z * (1.0 + z * (0.5 + z * (1.0 / 6 + z * (1.0 / 24 + z * (1.0 / 120 + z * (1.0 / 720 + z * (1.0 / 5040 + z * (1.0 / 40320 + z * (1.0 / 362880 + z * (1.0 / 3628800 + z * (1.0 / 39916800 + z * (1.0 / 479001600))))))))))));
      const double inv = __builtin_ldexp(ez, (int)fl);
      const float invf = (float)inv;
      const float angf = (float)(j < 16 ? rr : cc) * invf;
      const double ang = (double)angf;
      const double kq = __builtin_rint(ang * 0.63661977236758134308);
      double r = __builtin_fma(-kq, 1.57079632679489655800e+00, ang);
      r = __builtin_fma(-kq, 6.12323399573676603587e-17, r);
      const double r2 = r * r;
      const double sn = r * (1.0 + r2 * (-1.0 / 6 + r2 * (1.0 / 120 + r2 * (-1.0 / 5040 + r2 * (1.0 / 362880 + r2 * (-1.0 / 39916800 + r2 * (1.0 / 6227020800.0)))))));
      const double cs = 1.0 + r2 * (-0.5 + r2 * (1.0 / 24 + r2 * (-1.0 / 720 + r2 * (1.0 / 40320 + r2 * (-1.0 / 3628800 + r2 * (1.0 / 479001600 + r2 * (-1.0 / 87178291200.0)))))));
      const int q = ((int)kq) & 3;
      double co, si;
      if (q == 0) { co = cs; si = sn; } else if (q == 1) { co = -sn; si = cs; } else if (q == 2) { co = -cs; si = -sn; } else { co = sn; si = -cs; }
      RC[i] = (float)co; RS[i] = (float)si;
    }
  }
}

__device__ __forceinline__ void norm_mod_row(const float* xrow, const float* g, const float* sc, const float* sh, bf16_t* orow, int lane) {
  const f32x4* xr = (const f32x4*)xrow + lane;
  f32x4 v[4]; float s = 0.f;
#pragma unroll
  for (int j = 0; j < 4; ++j) { v[j] = xr[64 * j]; s += (v[j].x * v[j].x + v[j].y * v[j].y) + (v[j].z * v[j].z + v[j].w * v[j].w); }
  const float rs = rsqrtf(wave_sum(s) * (1.f / DM) + EPS);
  u32x2* o = (u32x2*)orow + lane;
#pragma unroll
  for (int j = 0; j < 4; ++j) {
    const f32x4 gg = ((const f32x4*)g)[lane + 64 * j], cc = ((const f32x4*)sc)[lane + 64 * j], hh = ((const f32x4*)sh)[lane + 64 * j];
    const float y0 = v[j].x * rs * gg.x * (1.f + cc.x) + hh.x, y1 = v[j].y * rs * gg.y * (1.f + cc.y) + hh.y;
    const float y2 = v[j].z * rs * gg.z * (1.f + cc.z) + hh.z, y3 = v[j].w * rs * gg.w * (1.f + cc.w) + hh.w;
    u32x2 w; w.x = cvtpk(y0, y1); w.y = cvtpk(y2, y3);
    o[64 * j] = w;
  }
}
__device__ __forceinline__ void phase_norm(const Params& p, int l, int which, bool from_input, bool skip_ctx) {
  int tid_ = tidx(); asm volatile("" : "+v"(tid_));
  const int lane = tid_ & 63, wid = tid_ >> 6;
  const int gw = p.bx * 8 + wid, NGW = p.gx * 8;
  const float* MOD = (const float*)(p.ws + WS_MOD);
  const float* XC = (const float*)(p.ws + WS_XCUR);
  bf16_t* H = (bf16_t*)(p.ws + WS_H);
  const float* g = p.in[which ? I_N2G : I_N1G] + l * DM;
  auto next_row = [&](int r_) { while (r_ < T && skip_ctx && mod_row(r_) == 4) r_ += NGW; return r_; };
  auto xrow_of = [&](int r_) { return (const f32x4*)(from_input ? in_row(p.in[I_X], p.in[I_CTX], r_) : XC + (size_t)r_ * DM) + lane; };
  f32x4 gg[4], cc[4], hh[4], v[4], vn[4];
#pragma unroll
  for (int j = 0; j < 4; ++j) gg[j] = ((const f32x4*)g)[lane + 64 * j];
  int mr_cur = -1;
  int row = next_row(gw);
  if (row < T) { const f32x4* xr = xrow_of(row);
#pragma unroll
    for (int j = 0; j < 4; ++j) v[j] = xr[64 * j]; }
  while (row < T) {
    const int nrow = next_row(row + NGW);
    if (nrow < T) { const f32x4* xn = xrow_of(nrow);
#pragma unroll
      for (int j = 0; j < 4; ++j) vn[j] = xn[64 * j]; }
    const int mr = mod_row(row);
    if (mr != mr_cur) {
      const float* m = MOD + ((size_t)l * 5 + mr) * 6144 + which * 3072;
#pragma unroll
      for (int j = 0; j < 4; ++j) { cc[j] = ((const f32x4*)(m + 1024))[lane + 64 * j]; hh[j] = ((const f32x4*)m)[lane + 64 * j]; }
      mr_cur = mr;
    }
    float s = 0.f;
#pragma unroll
    for (int j = 0; j < 4; ++j) s += (v[j].x * v[j].x + v[j].y * v[j].y) + (v[j].z * v[j].z + v[j].w * v[j].w);
    const float rs = rsqrtf(wave_sum(s) * (1.f / DM) + EPS);
    u32x2* o = (u32x2*)(H + (size_t)row * DM) + lane;
#pragma unroll
    for (int j = 0; j < 4; ++j) {
      const float y0 = v[j].x * rs * gg[j].x * (1.f + cc[j].x) + hh[j].x, y1 = v[j].y * rs * gg[j].y * (1.f + cc[j].y) + hh[j].y;
      const float y2 = v[j].z * rs * gg[j].z * (1.f + cc[j].z) + hh[j].z, y3 = v[j].w * rs * gg[j].w * (1.f + cc[j].w) + hh[j].w;
      u32x2 w; w.x = cvtpk(y0, y1); w.y = cvtpk(y2, y3);
      o[64 * j] = w;
      if (which == 0) {
        int w8 = 0; w8 = __builtin_amdgcn_cvt_pk_fp8_f32(y0, y1, w8, false); w8 = __builtin_amdgcn_cvt_pk_fp8_f32(y2, y3, w8, true);
        ((int*)(p.ws + WS_H8 + (size_t)row * DM))[lane + 64 * j] = w8;
      }
    }
#pragma unroll
    for (int j = 0; j < 4; ++j) v[j] = vn[j];
    row = nrow;
  }
}

namespace pg8 {
#define PG8_LAS __attribute__((address_space(3)))
typedef unsigned short bf16_t;
typedef short bf16x8 __attribute__((ext_vector_type(8)));
typedef float f32x4 __attribute__((ext_vector_type(4)));
typedef unsigned u32x4 __attribute__((ext_vector_type(4)));
typedef int i32x4v __attribute__((ext_vector_type(4)));
typedef int i32x8v __attribute__((ext_vector_type(8)));
constexpr int BM = 256, BK = 64, HALF = 128, HTB = HALF * BK * 2  , STAGE_BYTES = 8 * HTB, NXCD = 8, WGM = 8;

__host__ __device__ __forceinline__ int lds_byte(int r, int c) { const int st = (r >> 4) * 2 + (c >> 5), rr = r & 15, cc = c & 31, ob = rr * 64 + cc * 2; return st * 1024 + (ob ^ (((ob >> 9) & 1) << 5)); }
__host__ __device__ __forceinline__ void stage_rc(int b, int& R, int& C) { const int st = b / 1024, sb = b % 1024, swz = sb ^ (((sb >> 9) & 1) << 5); R = (st >> 1) * 16 + swz / 64; C = (st & 1) * 32 + (swz % 64) / 2; }
__host__ __device__ __forceinline__ int perm32(int rho) { const int n = rho >> 4, i = rho & 15; return 8 * (i >> 2) + 4 * n + (i & 3); }

struct Unit { int pm, pn; };
struct Gemm { const bf16_t* A; const bf16_t* Bt; int M, N, K; };

struct StaticOrder {
    int nM, nN, nwg, G, c;
    __host__ __device__ void init(int M, int N, int G_, int c_) { nM = M / BM; nN = N / BM; nwg = nM * nN; G = G_; c = c_; }
    __host__ __device__ bool next(int i, Unit& u) const {
        const long L = (long)i * G + c; if (L >= nwg) return false;
        int wgid = (int)L; { const int q = nwg / NXCD, r = nwg % NXCD, xcd = wgid % NXCD, off = wgid / NXCD; wgid = (xcd < r ? xcd * (q + 1) : r * (q + 1) + (xcd - r) * q) + off; }
        const int nig = WGM * nN, gid = wgid / nig, fm = gid * WGM, gsz = (nM - fm) < WGM ? (nM - fm) : WGM;
        u.pm = fm + ((wgid % nig) % gsz); u.pn = (wgid % nig) / gsz; return true;
    }
    __device__ __forceinline__ void a_ready(const Unit&) const {}
    __device__ __forceinline__ void done(const Unit&) const {}
};
struct F8Order {
    int nM, G, c, heavy, nwg;
    __host__ __device__ void init(int M, int G_, int c_, int heavy_) { nM = M / BM; G = G_; c = c_; heavy = heavy_; nwg = nM * 6; }
    __host__ __device__ bool next(int i, Unit& u) const {
        int L;
        const int nl = G - heavy, tailbase = nwg - 2 * heavy;
        if (c >= heavy) { L = i * nl + (c - heavy); if (L >= tailbase) return false; }
        else { if (i > 1) return false; L = tailbase + 2 * c + i; }
        int wgid = L; { const int q = nwg / NXCD, r = nwg % NXCD, xcd = wgid % NXCD, off = wgid / NXCD; wgid = (xcd < r ? xcd * (q + 1) : r * (q + 1) + (xcd - r) * q) + off; }
        const int nig = WGM * 6, gid = wgid / nig, fm = gid * WGM, gsz = (nM - fm) < WGM ? (nM - fm) : WGM;
        u.pm = fm + ((wgid % nig) % gsz); u.pn = 6 + (wgid % nig) / gsz; return true;
    }
    __device__ __forceinline__ void a_ready(const Unit&) const {}
    __device__ __forceinline__ void done(const Unit&) const {}
};
__device__ __forceinline__ unsigned cvt_pk_bf16(float lo, float hi) { unsigned r; asm volatile("v_cvt_pk_bf16_f32 %0, %1, %2" : "=v"(r) : "v"(lo), "v"(hi)); return r; }
template <class Epi, class Sched, bool ALIGN_EPI = false, bool SP2 = false, bool F8 = false>
__device__ __forceinline__ void gemm_phase(PG8_LAS unsigned char* lds, const Gemm g, const Sched& S, const Epi& E) {
    const int tid = tidx(), wid = __builtin_amdgcn_readfirstlane(tid >> 6), lane = tid & 63, wr = wid >> 2, wc = wid & 3, fr = lane & 15, fq = lane >> 4;
    const int K = g.K, nt = K / BK;
    unsigned voffA, voffB;
    { int R, C; stage_rc(tid * 16, R, C); const int Rb = Epi::PERM ? ((R & ~31) + perm32(R & 31)) : R;
      voffA = (unsigned)(R * K + C) * 2u; voffB = (unsigned)(Rb * K + C) * 2u; }
    const size_t kstep = (size_t)(BK * 2);
    const size_t hstep = (size_t)HALF * K * 2;
    const size_t tstep = 2 * hstep;
    const unsigned ldsw = (unsigned)wid * 1024u;
    const int aoff = lds_byte(wr * 64 + fr, fq * 8), boff = lds_byte(wc * 32 + fr, fq * 8);
#define PG8_SA(b, h) (((b) * 2 + (h)) * HTB)
#define PG8_SB(b, h) ((4 + (b) * 2 + (h)) * HTB)
#define PG8_STAGE(bufoff, gbase, voff) do { _Pragma("unroll") for (int _i = 0; _i < 2; ++_i) \
        __builtin_amdgcn_global_load_lds((const unsigned*)((const char*)(gbase) + (size_t)_i * 128u * (unsigned)K + (voff)), (PG8_LAS unsigned*)(lds + (bufoff) + ldsw + _i * 8192), 16, 0, 0); } while (0)
#define PG8_LD32(d8_, addr_) do { const i32x4v x0_ = *(const PG8_LAS i32x4v*)(addr_), x1_ = *(const PG8_LAS i32x4v*)((addr_) + 1024); \
        d8_ = __builtin_shufflevector(x0_, x1_, 0, 1, 2, 3, 4, 5, 6, 7); } while (0)
#define PG8_LDA(dst, b, h) do { if constexpr (F8) { _Pragma("unroll") for (int m = 0; m < 4; ++m) PG8_LD32(dst##8[m], lds + PG8_SA(b, h) + aoff + m * 2048); } \
        else { _Pragma("unroll") for (int m = 0; m < 4; ++m) _Pragma("unroll") for (int k = 0; k < 2; ++k) dst[m][k] = *(const PG8_LAS bf16x8*)(lds + PG8_SA(b, h) + aoff + m * 2048 + k * 1024); } } while (0)
#define PG8_LDB(dst, b, h) do { if constexpr (F8) { _Pragma("unroll") for (int n = 0; n < 2; ++n) PG8_LD32(dst##8[n], lds + PG8_SB(b, h) + boff + n * 2048); } \
        else { _Pragma("unroll") for (int n = 0; n < 2; ++n) _Pragma("unroll") for (int k = 0; k < 2; ++k) dst[n][k] = *(const PG8_LAS bf16x8*)(lds + PG8_SB(b, h) + boff + n * 2048 + k * 1024); } } while (0)
#define PG8_MMA(ai, bj, At, Bt) do { __builtin_amdgcn_s_setprio(1); _Pragma("unroll") for (int m = 0; m < 4; ++m) _Pragma("unroll") for (int n = 0; n < 2; ++n) { \
        if constexpr (F8) acc[ai][bj][m][n] = __builtin_amdgcn_mfma_scale_f32_16x16x128_f8f6f4(Bt##8[n], At##8[m], acc[ai][bj][m][n], 0, 0, 0, 0x7F7F7F7F, 0, 0x7F7F7F7F); \
        else { _Pragma("unroll") for (int k = 0; k < 2; ++k) acc[ai][bj][m][n] = __builtin_amdgcn_mfma_f32_16x16x32_bf16(Bt[n][k], At[m][k], acc[ai][bj][m][n], 0, 0, 0); } } \
        __builtin_amdgcn_s_setprio(0); } while (0)
#define PG8_WAIT_V(n) asm volatile("s_waitcnt vmcnt(" #n ")" ::: "memory")
#define PG8_WAIT_L(n) asm volatile("s_waitcnt lgkmcnt(" #n ")" ::: "memory")
#define PG8_BAR __builtin_amdgcn_s_barrier()
#define PG8_SCHED __builtin_amdgcn_sched_barrier(0)
    Unit cur, nxt; int ui = 0;
    if (!S.next(0, cur)) return;
    f32x4 acc[2][2][4][2];
#pragma unroll
    for (int a = 0; a < 2; ++a)
#pragma unroll
        for (int b = 0; b < 2; ++b)
#pragma unroll
            for (int m = 0; m < 4; ++m)
#pragma unroll
                for (int n = 0; n < 2; ++n) acc[a][b][m][n] = (f32x4){0.f, 0.f, 0.f, 0.f};
    bf16x8 At[4][2], B0[2][2], B1[2][2];
    i32x8v At8[4], B08[2], B18[2];
    const char* cA = (const char*)g.A + (size_t)cur.pm * tstep; const char* cB = (const char*)g.Bt + (size_t)cur.pn * tstep;
    S.a_ready(cur);
    if constexpr (SP2) {
        PG8_STAGE(PG8_SB(0, 0), cB, voffB); PG8_STAGE(PG8_SB(0, 1), cB + hstep, voffB); PG8_STAGE(PG8_SA(0, 0), cA, voffA); PG8_STAGE(PG8_SA(0, 1), cA + hstep, voffA);
        if (wr == 1) PG8_BAR;
        PG8_WAIT_V(2); PG8_BAR;
        PG8_STAGE(PG8_SB(1, 0), cB + kstep, voffB); PG8_STAGE(PG8_SA(1, 0), cA + kstep, voffA); PG8_STAGE(PG8_SB(1, 1), cB + hstep + kstep, voffB);
        PG8_WAIT_V(6); PG8_BAR;
    } else {
        PG8_STAGE(PG8_SB(0, 0), cB, voffB); PG8_STAGE(PG8_SA(0, 0), cA, voffA); PG8_STAGE(PG8_SB(0, 1), cB + hstep, voffB); PG8_STAGE(PG8_SA(0, 1), cA + hstep, voffA);
        if (wr == 1) PG8_BAR;
        PG8_WAIT_V(4); PG8_BAR;
        PG8_STAGE(PG8_SB(1, 0), cB + kstep, voffB); PG8_STAGE(PG8_SA(1, 0), cA + kstep, voffA); PG8_STAGE(PG8_SB(1, 1), cB + hstep + kstep, voffB);
        PG8_WAIT_V(6); PG8_BAR;
    }
    for (;;) {
        const bool has_next = S.next(ui + 1, nxt);
        const char* nA = has_next ? (const char*)g.A + (size_t)nxt.pm * tstep : cA; const char* nB = has_next ? (const char*)g.Bt + (size_t)nxt.pn * tstep : cB;
#pragma unroll 1
        for (int t = 0; t < nt; t += 2) {
            const bool last = (t == nt - 2);
            const char* a1 = cA + (size_t)(t + 1) * kstep;
            const char* a2 = last ? nA : cA + (size_t)(t + 2) * kstep; const char* b2 = last ? nB : cB + (size_t)(t + 2) * kstep;
            const char* a3 = a2 + kstep; const char* b3 = b2 + kstep;
            if (last && has_next) S.a_ready(nxt);
            if constexpr (SP2) {
            PG8_LDB(B0, 0, 0); PG8_LDB(B1, 0, 1); PG8_SCHED; PG8_LDA(At, 0, 0); PG8_STAGE(PG8_SA(1, 1), a1 + hstep, voffA);
            PG8_WAIT_V(8); PG8_WAIT_L(0); PG8_BAR; PG8_MMA(0, 0, At, B0); PG8_MMA(0, 1, At, B1); PG8_BAR; PG8_SCHED;
            PG8_LDA(At, 0, 1); PG8_STAGE(PG8_SB(0, 0), b2, voffB); PG8_STAGE(PG8_SB(0, 1), b2 + hstep, voffB); PG8_STAGE(PG8_SA(0, 0), a2, voffA);
            PG8_WAIT_V(8); PG8_WAIT_L(0); PG8_BAR; PG8_MMA(1, 0, At, B0); PG8_MMA(1, 1, At, B1); PG8_BAR; PG8_SCHED;
            PG8_LDB(B0, 1, 0); PG8_LDB(B1, 1, 1); PG8_SCHED; PG8_LDA(At, 1, 0); PG8_STAGE(PG8_SA(0, 1), a2 + hstep, voffA);
            PG8_WAIT_V(8); PG8_WAIT_L(0); PG8_BAR; PG8_MMA(0, 0, At, B0); PG8_MMA(0, 1, At, B1); PG8_BAR; PG8_SCHED;
            PG8_LDA(At, 1, 1); PG8_STAGE(PG8_SB(1, 0), b3, voffB); PG8_STAGE(PG8_SB(1, 1), b3 + hstep, voffB); PG8_STAGE(PG8_SA(1, 0), a3, voffA);
            PG8_WAIT_V(8); PG8_WAIT_L(0); PG8_BAR; PG8_MMA(1, 0, At, B0); PG8_MMA(1, 1, At, B1); PG8_BAR; PG8_SCHED;
            } else {
            PG8_LDB(B0, 0, 0); PG8_SCHED; PG8_LDA(At, 0, 0); PG8_STAGE(PG8_SA(1, 1), a1 + hstep, voffA);
            PG8_WAIT_L(8); PG8_BAR; PG8_WAIT_L(0); PG8_MMA(0, 0, At, B0); PG8_BAR; PG8_SCHED;
            PG8_LDB(B1, 0, 1); PG8_STAGE(PG8_SB(0, 0), b2, voffB);
            PG8_BAR; PG8_WAIT_L(0); PG8_MMA(0, 1, At, B1); PG8_BAR;
            PG8_LDA(At, 0, 1); PG8_STAGE(PG8_SA(0, 0), a2, voffA);
            PG8_BAR; PG8_WAIT_L(0); PG8_MMA(1, 0, At, B0); PG8_BAR; PG8_SCHED;
            PG8_STAGE(PG8_SB(0, 1), b2 + hstep, voffB);
            PG8_WAIT_V(6); PG8_BAR; PG8_MMA(1, 1, At, B1); PG8_BAR;
            PG8_LDB(B0, 1, 0); PG8_SCHED; PG8_LDA(At, 1, 0); PG8_STAGE(PG8_SA(0, 1), a2 + hstep, voffA);
            PG8_WAIT_L(8); PG8_BAR; PG8_WAIT_L(0); PG8_MMA(0, 0, At, B0); PG8_BAR; PG8_SCHED;
            PG8_LDB(B1, 1, 1); PG8_STAGE(PG8_SB(1, 0), b3, voffB);
            PG8_BAR; PG8_WAIT_L(0); PG8_MMA(0, 1, At, B1); PG8_BAR;
            PG8_LDA(At, 1, 1); PG8_STAGE(PG8_SA(1, 0), a3, voffA);
            PG8_BAR; PG8_WAIT_L(0); PG8_MMA(1, 0, At, B0); PG8_BAR; PG8_SCHED;
            PG8_STAGE(PG8_SB(1, 1), b3 + hstep, voffB);
            PG8_WAIT_V(6); PG8_BAR; PG8_MMA(1, 1, At, B1); PG8_BAR;
            }
        }
        if constexpr (ALIGN_EPI) { if (wr == 0) PG8_BAR; }
        if constexpr (!Epi::AFTER_DRAIN) { int fr_ = fr, fq_ = fq; asm volatile("" : "+v"(fr_), "+v"(fq_));
          E(acc, cur, wr, wc, fr_, fq_); S.done(cur); }
        if (!has_next) break;
#pragma unroll
        for (int a = 0; a < 2; ++a)
#pragma unroll
            for (int b = 0; b < 2; ++b)
#pragma unroll
                for (int m = 0; m < 4; ++m)
#pragma unroll
                    for (int n = 0; n < 2; ++n) acc[a][b][m][n] = (f32x4){0.f, 0.f, 0.f, 0.f};
        cur = nxt; cA = nA; cB = nB; ++ui;
        if constexpr (ALIGN_EPI) { if (wr == 1) PG8_BAR; }
    }
    PG8_WAIT_V(0);
    if constexpr (!ALIGN_EPI) { if (wr == 0) PG8_BAR; }
    PG8_BAR;
    if constexpr (Epi::AFTER_DRAIN) { E.fused(acc, cur, wr, wc, fr, fq, lds, wid, lane); S.done(cur); }
#undef PG8_SA
#undef PG8_SB
#undef PG8_STAGE
#undef PG8_LDA
#undef PG8_LDB
#undef PG8_MMA
#undef PG8_WAIT_V
#undef PG8_WAIT_L
#undef PG8_BAR
#undef PG8_SCHED
}
}

__device__ __forceinline__ int gswz(int row, int chunk) { return row * 128 + ((chunk ^ ((row >> 1) & 7)) << 4); }
__device__ __forceinline__ void gemm_tile(const bf16_t* __restrict__ A, int lda, const bf16_t* __restrict__ Bt, int ldb, int K,
                                          int row0, int col0, unsigned char* lds, f32x16 (&acc)[2][2]) {
  int tid_ = tidx(); asm volatile("" : "+v"(tid_)); const int tid = tid_, lane = tid & 63, wid = tid >> 6, wm = wid >> 1, wn = wid & 1, r32 = lane & 31, hi = lane >> 5;
  unsigned char* As = lds; unsigned char* Bs = lds + 65536;
#pragma unroll
  for (int i = 0; i < 2; ++i)
#pragma unroll
    for (int j = 0; j < 2; ++j) acc[i][j] = f32x16{};
  const int lrow = tid >> 3, lc = tid & 7;
  const bf16_t* Ag = A + (size_t)(row0 + lrow) * lda + lc * 8;
  const bf16_t* Bg = Bt + (size_t)(col0 + lrow) * ldb + lc * 8;
  u32x4 ra[4], rb[2];
#pragma unroll
  for (int i = 0; i < 4; ++i) ra[i] = *(const u32x4*)(Ag + (size_t)(64 * i) * lda);
#pragma unroll
  for (int i = 0; i < 2; ++i) rb[i] = *(const u32x4*)(Bg + (size_t)(64 * i) * ldb);
#pragma unroll
  for (int i = 0; i < 4; ++i) *(u32x4*)(As + gswz(lrow + 64 * i, lc)) = ra[i];
#pragma unroll
  for (int i = 0; i < 2; ++i) *(u32x4*)(Bs + gswz(lrow + 64 * i, lc)) = rb[i];
  __syncthreads();
  const int nk = K / 64;
  for (int kt = 0; kt < nk; ++kt) {
    const int cur = kt & 1;
    if (kt + 1 < nk) {
#pragma unroll
      for (int i = 0; i < 4; ++i) ra[i] = *(const u32x4*)(Ag + (size_t)(64 * i) * lda + (kt + 1) * 64);
#pragma unroll
      for (int i = 0; i < 2; ++i) rb[i] = *(const u32x4*)(Bg + (size_t)(64 * i) * ldb + (kt + 1) * 64);
    }
    const unsigned char* Ac = As + cur * 32768; const unsigned char* Bc = Bs + cur * 16384;
#pragma unroll
    for (int kk = 0; kk < 4; ++kk) {
      bf16x8 af[2], bfr[2];
#pragma unroll
      for (int i = 0; i < 2; ++i) af[i] = *(const bf16x8*)(Ac + gswz(wm * 64 + i * 32 + r32, 2 * kk + hi));
#pragma unroll
      for (int j = 0; j < 2; ++j) bfr[j] = *(const bf16x8*)(Bc + gswz(wn * 64 + j * 32 + r32, 2 * kk + hi));
#pragma unroll
      for (int i = 0; i < 2; ++i)
#pragma unroll
        for (int j = 0; j < 2; ++j) acc[i][j] = __builtin_amdgcn_mfma_f32_32x32x16_bf16(af[i], bfr[j], acc[i][j], 0, 0, 0);
    }
    if (kt + 1 < nk) {
      unsigned char* An = As + (cur ^ 1) * 32768; unsigned char* Bn = Bs + (cur ^ 1) * 16384;
#pragma unroll
      for (int i = 0; i < 4; ++i) *(u32x4*)(An + gswz(lrow + 64 * i, lc)) = ra[i];
#pragma unroll
      for (int i = 0; i < 2; ++i) *(u32x4*)(Bn + gswz(lrow + 64 * i, lc)) = rb[i];
    }
    __syncthreads();
  }
}
__device__ __forceinline__ void pair_xchg(float v0, float v1, int lane, float& lo, float& hi2) {
  const bool odd = lane & 1;
  const float send = odd ? v0 : v1;
  const float recv = dpp_mov<0xB1>(send);
  lo = odd ? recv : v0; hi2 = odd ? v1 : recv;
}

__device__ __forceinline__ void phase_inproj(const Params& p, int l, unsigned char* lds) {
  int tid_ = tidx(); asm volatile("" : "+v"(tid_)); const int tid = tid_, lane = tid & 63, wid = tid >> 6, wm = wid >> 1, wn = wid & 1, r32 = lane & 31, hi = lane >> 5;
  const bf16_t* H = (const bf16_t*)(p.ws + WS_H);
  const bf16_t* W = (const bf16_t*)(p.ws + WS_WIN) + (size_t)l * PW * DM;
  bf16_t* PROJ = (bf16_t*)(p.ws + WS_PROJ);
  const float* RC = (const float*)(p.ws + WS_ROPE); const float* RS = RC + SEQ * 32;
  constexpr int NM = T / 256, NN = PW / 128, NU = NM * NN;
  for (int u = p.bx; u < NU + NM; u += p.gx) {
    if (u < NU) {
      const int pn = u / NM, pm = u % NM;
      const int row0 = pm * 256, col0 = pn * 128;
      f32x16 acc[2][2];
      gemm_tile(H, DM, W, DM, DM, row0, col0, lds, acc);
      const bool rope = (col0 >= C_DQ && col0 < C_DV);
      const float scl = (col0 >= C_MK && col0 < C_MV) ? 0.125f : ((col0 >= C_DQ && col0 < C_DK) ? QSCALE : 1.f);
#pragma unroll
      for (int i = 0; i < 2; ++i)
#pragma unroll
        for (int j = 0; j < 2; ++j)
#pragma unroll
          for (int q = 0; q < 8; ++q) {
            float lo, hi2; pair_xchg(acc[i][j][2 * q], acc[i][j][2 * q + 1], lane, lo, hi2);
            const int row = row0 + wm * 64 + i * 32 + crow(2 * q, hi) + (lane & 1);
            const int col = col0 + wn * 64 + j * 32 + (r32 & ~1);
            if (rope) {
              const int s = row % SEGL;
              if (s >= CTXL) {
                const int idx = (s - CTXL) * 32 + ((col & 63) >> 1);
                const float c = RC[idx], sn = RS[idx];
                const float t1 = lo, t2 = hi2; lo = t1 * c - t2 * sn; hi2 = t1 * sn + t2 * c;
              }
            }
            *(unsigned*)(PROJ + (size_t)row * PW + col) = cvtpk(lo * scl, hi2 * scl);
          }
    } else {
      const int pm = u - NU, rowb = pm * 256 + wid * 32;
      const bf16_t* WG = (const bf16_t*)(p.ws + WS_WG) + (size_t)l * 16 * DM;
      float* GT = (float*)(p.ws + WS_GATES);
      const int r16 = lane & 15, q4 = lane >> 4;
      f32x4 c0 = {0.f, 0.f, 0.f, 0.f}, c1 = {0.f, 0.f, 0.f, 0.f};
      const bf16_t* a0p = H + (size_t)(rowb + r16) * DM + q4 * 8;
      const bf16_t* a1p = a0p + (size_t)16 * DM;
      const bf16_t* bp = WG + (size_t)r16 * DM + q4 * 8;
#pragma unroll 4
      for (int ks = 0; ks < 32; ++ks) {
        const bf16x8 a0 = *(const bf16x8*)(a0p + ks * 32), a1 = *(const bf16x8*)(a1p + ks * 32), b = *(const bf16x8*)(bp + ks * 32);
        c0 = __builtin_amdgcn_mfma_f32_16x16x32_bf16(a0, b, c0, 0, 0, 0);
        c1 = __builtin_amdgcn_mfma_f32_16x16x32_bf16(a1, b, c1, 0, 0, 0);
      }
      const float gb = p.in[I_GATEB][l * 16 + r16];
#pragma unroll
      for (int j = 0; j < 4; ++j) {
        GT[(size_t)(rowb + q4 * 4 + j) * 16 + r16] = c0[j] + gb;
        GT[(size_t)(rowb + 16 + q4 * 4 + j) * 16 + r16] = c1[j] + gb;
      }
    }
  }
}

__device__ __forceinline__ void phase_outproj(const Params& p, int l, unsigned char* lds) {
  int tid_ = tidx(); asm volatile("" : "+v"(tid_)); const int tid = tid_, lane = tid & 63, wid = tid >> 6, wm = wid >> 1, wn = wid & 1, r32 = lane & 31, hi = lane >> 5;
  const bf16_t* MIX = (const bf16_t*)(p.ws + WS_MIX);
  const bf16_t* W = (const bf16_t*)(p.ws + WS_WOUT) + (size_t)l * DM * DM;
  float* XC = (float*)(p.ws + WS_XCUR);
  const float* MOD = (const float*)(p.ws + WS_MOD);
  constexpr int NM = T / 256, NN = DM / 128, NU = NM * NN;
  for (int u = p.bx; u < NU; u += p.gx) {
    const int pm = u / NN, pn = u % NN;
    if (l == DEPTH - 1 && (pm % 33) == 0) continue;
    const int row0 = pm * 256, col0 = pn * 128;
    for (int rep = 0; rep < REP_OUTP; ++rep) {
    f32x16 acc[2][2];
    gemm_tile(MIX, DM, W, DM, DM, row0, col0, lds, acc);
    const int mr = (pm % 33) == 0 ? 4 : pm / 33;
    const float* g1 = MOD + ((size_t)l * 5 + mr) * 6144 + 2048;
#pragma unroll
    for (int i = 0; i < 2; ++i)
#pragma unroll
      for (int j = 0; j < 2; ++j) {
        const int col = col0 + wn * 64 + j * 32 + r32;
        const float gg = (rep == REP_OUTP - 1) ? g1[col] : 0.f;
#pragma unroll
        for (int r = 0; r < 16; ++r) {
          const int row = row0 + wm * 64 + i * 32 + crow(r, hi);
          const float xo = (l == 0) ? in_row(p.in[I_X], p.in[I_CTX], row)[col] : XC[(size_t)row * DM + col];
          XC[(size_t)row * DM + col] = xo + gg * acc[i][j][r];
        }
      }
    }
  }
}
__device__ __forceinline__ void phase_peerq(const Params& p, int l, unsigned char* lds) {
  int tid_ = tidx(); asm volatile("" : "+v"(tid_)); const int tid = tid_, lane = tid & 63, wid = tid >> 6, wm = wid >> 1, wn = wid & 1, r32 = lane & 31, hi = lane >> 5;
  const bf16_t* H = (const bf16_t*)(p.ws + WS_H);
  const bf16_t* W = (const bf16_t*)(p.ws + WS_WQ) + (size_t)l * DM * DM;
  bf16_t* QP = (bf16_t*)(p.ws + WS_PROJ);
  constexpr int NM = T / 256, NN = DM / 128, NU = NM * NN;
  for (int u = p.bx; u < NU; u += p.gx) {
    const int pm = u / NN, pn = u % NN;
    if (l == DEPTH - 1 && (pm % 33) == 0) continue;
    const int row0 = pm * 256, col0 = pn * 128;
    f32x16 acc[2][2];
    gemm_tile(H, DM, W, DM, DM, row0, col0, lds, acc);
#pragma unroll
    for (int i = 0; i < 2; ++i)
#pragma unroll
      for (int j = 0; j < 2; ++j)
#pragma unroll
        for (int q = 0; q < 8; ++q) {
          float lo, hi2; pair_xchg(acc[i][j][2 * q], acc[i][j][2 * q + 1], lane, lo, hi2);
          const int row = row0 + wm * 64 + i * 32 + crow(2 * q, hi) + (lane & 1);
          const int col = col0 + wn * 64 + j * 32 + (r32 & ~1);
          *(unsigned*)(QP + (size_t)row * DM + col) = cvtpk(lo, hi2);
        }
  }
}


struct EpiInproj {
  static constexpr bool PERM = true, AFTER_DRAIN = false;
  bf16_t* PROJ; const float* RC; const float* RS; unsigned char* V8T; float wsc;
  __device__ __forceinline__ void operator()(const pg8::f32x4 (&acc)[2][2][4][2], const pg8::Unit& u, int wr, int wc, int fr, int fq) const {
#pragma unroll
    for (int bj = 0; bj < 2; ++bj) {
      const int colt = u.pn * 256 + bj * 128;
      const bool rope = (colt >= C_DQ && colt < C_DV);
      const float scl = ((colt >= C_MK && colt < C_MV) ? 0.125f : ((colt >= C_DQ && colt < C_DK) ? QSCALE : 1.f)) * wsc;
      const int col8 = colt + wc * 32 + 8 * fq;
      if (colt >= C_DV) {
        const int hh = (col8 - C_DV) >> 7, e0 = (col8 - C_DV) & 127;
#pragma unroll
        for (int ai = 0; ai < 2; ++ai)
#pragma unroll
          for (int m = 0; m < 4; ++m) {
            const int row = u.pm * 256 + ai * 128 + wr * 64 + m * 16 + fr;
            const int b = row / SEGL, s = row - b * SEGL, t = s >> 6, kk = s & 63;
            const int slot = ((kk >> 2) & 1) * 32 + (kk & 3) + 4 * ((kk >> 3) & 3) + 16 * (kk >> 5);
            unsigned char* vp = V8T + ((size_t)((b * 4 + hh) * NCH + t) * 128 + e0) * 80 + slot;
            const f32x4 v0 = acc[ai][bj][m][0] * wsc, v1 = acc[ai][bj][m][1] * wsc;
            int w0 = 0, w1 = 0;
            w0 = __builtin_amdgcn_cvt_pk_fp8_f32(v0[0], v0[1], w0, false); w0 = __builtin_amdgcn_cvt_pk_fp8_f32(v0[2], v0[3], w0, true);
            w1 = __builtin_amdgcn_cvt_pk_fp8_f32(v1[0], v1[1], w1, false); w1 = __builtin_amdgcn_cvt_pk_fp8_f32(v1[2], v1[3], w1, true);
            vp[0] = (unsigned char)(w0 & 0xFF); vp[80] = (unsigned char)((w0 >> 8) & 0xFF); vp[160] = (unsigned char)((w0 >> 16) & 0xFF); vp[240] = (unsigned char)((w0 >> 24) & 0xFF);
            vp[320] = (unsigned char)(w1 & 0xFF); vp[400] = (unsigned char)((w1 >> 8) & 0xFF); vp[480] = (unsigned char)((w1 >> 16) & 0xFF); vp[560] = (unsigned char)((w1 >> 24) & 0xFF);
          }
        continue;
      }
      unsigned char* qk8 = nullptr;
      if (rope) { const int isk = colt >= C_DK, cc = col8 - (isk ? C_DK : C_DQ); qk8 = V8T + (WS_QK8 - WS_V8T) + (size_t)isk * QK8_IMG + (size_t)(cc >> 7) * SEGL * QK8_PITCH + (cc & 127); }
#pragma unroll
      for (int ai = 0; ai < 2; ++ai)
#pragma unroll
        for (int m = 0; m < 4; ++m) {
          const int row = u.pm * 256 + ai * 128 + wr * 64 + m * 16 + fr;
          f32x4 v0 = acc[ai][bj][m][0], v1 = acc[ai][bj][m][1];
          if (rope) {
            const int s = row % SEGL;
            if (s >= CTXL) {
              const int idx = (s - CTXL) * 32 + ((col8 & 63) >> 1);
              const f32x4 c = *(const f32x4*)(RC + idx), sn = *(const f32x4*)(RS + idx);
              f32x4 a, b;
              a[0] = v0[0] * c[0] - v0[1] * sn[0]; a[1] = v0[0] * sn[0] + v0[1] * c[0]; a[2] = v0[2] * c[1] - v0[3] * sn[1]; a[3] = v0[2] * sn[1] + v0[3] * c[1];
              b[0] = v1[0] * c[2] - v1[1] * sn[2]; b[1] = v1[0] * sn[2] + v1[1] * c[2]; b[2] = v1[2] * c[3] - v1[3] * sn[3]; b[3] = v1[2] * sn[3] + v1[3] * c[3];
              v0 = a; v1 = b;
            }
          }
          if (rope) {
            const int b = row / SEGL, s = row - b * SEGL;
            int w0, w1; asm volatile("" : "=v"(w0), "=v"(w1));
            w0 = __builtin_amdgcn_cvt_pk_fp8_f32(v0[0] * scl, v0[1] * scl, w0, false); w0 = __builtin_amdgcn_cvt_pk_fp8_f32(v0[2] * scl, v0[3] * scl, w0, true);
            w1 = __builtin_amdgcn_cvt_pk_fp8_f32(v1[0] * scl, v1[1] * scl, w1, false); w1 = __builtin_amdgcn_cvt_pk_fp8_f32(v1[2] * scl, v1[3] * scl, w1, true);
            *(u32x2*)(qk8 + ((size_t)b * 4 * SEGL + s) * QK8_PITCH) = (u32x2){(unsigned)w0, (unsigned)w1};
            __builtin_amdgcn_sched_barrier(0);
            continue;
          }
          u32x4 w; w.x = cvtpk(v0[0] * scl, v0[1] * scl); w.y = cvtpk(v0[2] * scl, v0[3] * scl); w.z = cvtpk(v1[0] * scl, v1[1] * scl); w.w = cvtpk(v1[2] * scl, v1[3] * scl);
          *(u32x4*)(PROJ + (size_t)row * PW + col8) = w;
        }
    }
  }
};
struct EpiOutproj {
  static constexpr bool PERM = true, AFTER_DRAIN = false;
  float* XC; const float* MODL; const float* xin; const float* ctxin; int first; float gsc;
  __device__ __forceinline__ void operator()(const pg8::f32x4 (&acc)[2][2][4][2], const pg8::Unit& u, int wr, int wc, int fr, int fq) const {
    const int mr = (u.pm % 33) == 0 ? 4 : u.pm / 33;
    const float* g1 = MODL + (size_t)mr * 6144 + 2048;
#pragma unroll
    for (int bj = 0; bj < 2; ++bj) {
      const int col8 = u.pn * 256 + bj * 128 + wc * 32 + 8 * fq;
      const f32x4 ga = *(const f32x4*)(g1 + col8) * gsc, gb = *(const f32x4*)(g1 + col8 + 4) * gsc;
#pragma unroll
      for (int ai = 0; ai < 2; ++ai)
#pragma unroll
        for (int m = 0; m < 4; ++m) {
          const int row = u.pm * 256 + ai * 128 + wr * 64 + m * 16 + fr;
          const float* xo = first ? in_row(xin, ctxin, row) + col8 : XC + (size_t)row * DM + col8;
          const f32x4 xa = *(const f32x4*)xo, xb = *(const f32x4*)(xo + 4);
          *(f32x4*)(XC + (size_t)row * DM + col8) = xa + ga * acc[ai][bj][m][0];
          *(f32x4*)(XC + (size_t)row * DM + col8 + 4) = xb + gb * acc[ai][bj][m][1];
        }
    }
  }
};
struct EpiPeerq {
  static constexpr bool PERM = true, AFTER_DRAIN = false;
  bf16_t* QP;
  __device__ __forceinline__ void operator()(const pg8::f32x4 (&acc)[2][2][4][2], const pg8::Unit& u, int wr, int wc, int fr, int fq) const {
#pragma unroll
    for (int bj = 0; bj < 2; ++bj) {
      const int col8 = u.pn * 256 + bj * 128 + wc * 32 + 8 * fq;
#pragma unroll
      for (int ai = 0; ai < 2; ++ai)
#pragma unroll
        for (int m = 0; m < 4; ++m) {
          const int row = u.pm * 256 + ai * 128 + wr * 64 + m * 16 + fr;
          const f32x4 v0 = acc[ai][bj][m][0], v1 = acc[ai][bj][m][1];
          u32x4 w; w.x = cvtpk(v0[0], v0[1]); w.y = cvtpk(v0[2], v0[3]); w.z = cvtpk(v1[0], v1[1]); w.w = cvtpk(v1[2], v1[3]);
          *(u32x4*)(QP + (size_t)row * DM + col8) = w;
        }
    }
  }
};
__device__ __forceinline__ void phase_inproj2(const Params& p, int l, unsigned char* lds) {
  {
    pg8::Gemm g{(const bf16_t*)(p.ws + WS_H), (const bf16_t*)(p.ws + WS_WIN) + (size_t)l * PW * DM, T, C_DQ, DM};
    pg8::StaticOrder S; S.init(T, C_DQ, p.gx, p.bx);
    EpiInproj E{(bf16_t*)(p.ws + WS_PROJ), (const float*)(p.ws + WS_ROPE), (const float*)(p.ws + WS_ROPE) + SEQ * 32, p.ws + WS_V8T, 1.f};
    pg8::gemm_phase<EpiInproj, pg8::StaticOrder, true, true>((PG8_LAS unsigned char*)lds, g, S, E);
  }
  {
    pg8::Gemm g{(const bf16_t*)(p.ws + WS_H8), (const bf16_t*)(p.ws + WS_W8 + (size_t)l * PW * DM), T, PW, DM / 2};
    const int nb16 = (T / 256) * (C_DQ / 256);
    pg8::F8Order S; S.init(T, p.gx, p.bx, nb16 % p.gx);
    EpiInproj E{(bf16_t*)(p.ws + WS_PROJ), (const float*)(p.ws + WS_ROPE), (const float*)(p.ws + WS_ROPE) + SEQ * 32, p.ws + WS_V8T, 1.f / 32.f};
    pg8::gemm_phase<EpiInproj, pg8::F8Order, true, true, true>((PG8_LAS unsigned char*)lds, g, S, E);
  }
  int tid_ = tidx(); asm volatile("" : "+v"(tid_)); const int tid = tid_, lane = tid & 63, wid = tid >> 6;
  const bf16_t* H = (const bf16_t*)(p.ws + WS_H);
  for (int pm = p.gx - 1 - p.bx; pm < T / 256; pm += p.gx) {
    const int rowb = pm * 256 + wid * 32;
    const bf16_t* WG = (const bf16_t*)(p.ws + WS_WG) + (size_t)l * 16 * DM;
    float* GT = (float*)(p.ws + WS_GATES);
    const int r16 = lane & 15, q4 = lane >> 4;
    f32x4 c0 = {0.f, 0.f, 0.f, 0.f}, c1 = {0.f, 0.f, 0.f, 0.f};
    const bf16_t* a0p = H + (size_t)(rowb + r16) * DM + q4 * 8;
    const bf16_t* a1p = a0p + (size_t)16 * DM;
    const bf16_t* bp = WG + (size_t)r16 * DM + q4 * 8;
#pragma unroll 4
    for (int ks = 0; ks < 32; ++ks) {
      const bf16x8 a0 = *(const bf16x8*)(a0p + ks * 32), a1 = *(const bf16x8*)(a1p + ks * 32), b = *(const bf16x8*)(bp + ks * 32);
      c0 = __builtin_amdgcn_mfma_f32_16x16x32_bf16(a0, b, c0, 0, 0, 0);
      c1 = __builtin_amdgcn_mfma_f32_16x16x32_bf16(a1, b, c1, 0, 0, 0);
    }
    const float gb = p.in[I_GATEB][l * 16 + r16];
#pragma unroll
    for (int j = 0; j < 4; ++j) {
      GT[(size_t)(rowb + q4 * 4 + j) * 16 + r16] = c0[j] + gb;
      GT[(size_t)(rowb + 16 + q4 * 4 + j) * 16 + r16] = c1[j] + gb;
    }
  }
}
__device__ __forceinline__ void phase_outproj2(const Params& p, int l, unsigned char* lds) {
  pg8::Gemm g{(const bf16_t*)(p.ws + WS_MIX), (const bf16_t*)(p.ws + WS_WOUT) + (size_t)l * DM * DM, T, DM, DM};
  pg8::StaticOrder S; S.init(T, DM, p.gx, p.bx);
  for (int rep = 0; rep < REP_OUTP; ++rep) {
  EpiOutproj E{(float*)(p.ws + WS_XCUR), (const float*)(p.ws + WS_MOD) + (size_t)l * 5 * 6144, p.in[I_X], p.in[I_CTX], l == 0, (rep == REP_OUTP - 1) ? 1.f : 0.f};
  pg8::gemm_phase<EpiOutproj, pg8::StaticOrder, true, true>((PG8_LAS unsigned char*)lds, g, S, E);
  }
  tail_filler_tables(p, l, (T / 256) * (DM / 256), l == 0 ? 0 : NEXP, 2 * NEXP);
}
__device__ __forceinline__ void phase_peerq2(const Params& p, int l, unsigned char* lds) {
  pg8::Gemm g{(const bf16_t*)(p.ws + WS_H), (const bf16_t*)(p.ws + WS_WQ) + (size_t)l * DM * DM, T, DM, DM};
  pg8::StaticOrder S; S.init(T, DM, p.gx, p.bx);
  EpiPeerq E{(bf16_t*)(p.ws + WS_PROJ)};
  pg8::gemm_phase<EpiPeerq, pg8::StaticOrder, true, true>((PG8_LAS unsigned char*)lds, g, S, E);
  if (l < DEPTH - 1) tail_filler_tables(p, l + 1, (T / 256) * (DM / 256), 0, NEXP);
}

__device__ __forceinline__ void conv_unit(const Params& p, int l, int unit, unsigned char* lds) {
  int tid_ = tidx(); asm volatile("" : "+v"(tid_)); const int tid = tid_, lane = tid & 63, wid = tid >> 6;
  float* U = (float*)lds;
  const bf16_t* PROJ = (const bf16_t*)(p.ws + WS_PROJ);
  bf16_t* MIX = (bf16_t*)(p.ws + WS_MIX);
  const int row0 = unit * 32, b = row0 / SEGL, s0 = row0 - b * SEGL;
  const int seglo = s0 < CTXL ? 0 : CTXL, seghi = s0 < CTXL ? CTXL : SEGL;
  for (int rr = tid >> 5; rr < 62; rr += 16) {
    const int s = s0 - 15 + rr, c8 = (tid & 31) * 8;
    f32x4 u0 = {0.f, 0.f, 0.f, 0.f}, u1 = {0.f, 0.f, 0.f, 0.f};
    if (s >= seglo && s < seghi) {
      const bf16_t* pr = PROJ + (size_t)(b * SEGL + s) * PW + c8;
      const u32x4 a1 = *(const u32x4*)pr, a2 = *(const u32x4*)(pr + 256);
      u0.x = bflo(a1.x) * sigmoidf_(bflo(a2.x)); u0.y = bfhi(a1.x) * sigmoidf_(bfhi(a2.x));
      u0.z = bflo(a1.y) * sigmoidf_(bflo(a2.y)); u0.w = bfhi(a1.y) * sigmoidf_(bfhi(a2.y));
      u1.x = bflo(a1.z) * sigmoidf_(bflo(a2.z)); u1.y = bfhi(a1.z) * sigmoidf_(bfhi(a2.z));
      u1.z = bflo(a1.w) * sigmoidf_(bflo(a2.w)); u1.w = bfhi(a1.w) * sigmoidf_(bfhi(a2.w));
    }
    *(f32x4*)(U + rr * 256 + c8) = u0; *(f32x4*)(U + rr * 256 + c8 + 4) = u1;
  }
  __syncthreads();
  float* Y = U + 62 * 256;
  const float* cw = p.in[I_CONVW] + (size_t)l * 31 * 256;
#pragma unroll 1
  for (int q = 0; q < 4; ++q) {
    const int c = lane + 64 * q;
    float w[31];
#pragma unroll
    for (int j = 0; j < 31; ++j) w[j] = cw[j * 256 + c];
    const float bias = p.in[I_CONVB][l * 256 + c];
#pragma unroll
    for (int tt = 0; tt < 4; ++tt) {
      const int t = wid * 4 + tt;
      float a = bias;
#pragma unroll
      for (int j = 0; j < 31; ++j) a += U[(t + j) * 256 + c] * w[j];
      Y[t * 256 + c] = a;
    }
  }
  asm volatile("s_waitcnt lgkmcnt(0)" ::: "memory");
  float y[4][4];
#pragma unroll
  for (int tt = 0; tt < 4; ++tt)
#pragma unroll
    for (int q = 0; q < 4; ++q) y[tt][q] = Y[(wid * 4 + tt) * 256 + lane + 64 * q];
#pragma unroll
  for (int tt = 0; tt < 4; ++tt) {
    const int t = wid * 4 + tt;
    const float mean = wave_sum((y[tt][0] + y[tt][1]) + (y[tt][2] + y[tt][3])) * (1.f / 256.f);
    float v = 0.f;
#pragma unroll
    for (int q = 0; q < 4; ++q) { const float d = y[tt][q] - mean; v += d * d; }
    const float rs = rsqrtf(wave_sum(v) * (1.f / 256.f) + EPS);
#pragma unroll
    for (int q = 0; q < 4; ++q) {
      const int c = lane + 64 * q;
      const float z = (y[tt][q] - mean) * rs * p.in[I_CLNG][l * 256 + c] + p.in[I_CLNB][l * 256 + c];
      const float o = (ABL & 1) ? 0.f : z * sigmoidf_(z);
      MIX[(size_t)(row0 + t) * DM + c] = (bf16_t)(cvtpk(o, 0.f) & 0xffffu);
    }
  }
  __syncthreads();
}

__device__ __forceinline__ int ml_cidx(int ch, int dir) { return dir == 0 ? ch : (ch < 4 ? 3 - ch : 135 - ch); }
__device__ __forceinline__ void ml_load_tile(const bf16_t* src, float* dst, int tid) {
  const int r = tid >> 3, c8 = (tid & 7) * 8;
  const u32x4 a = *(const u32x4*)(src + (size_t)r * PW + c8);
  float* d = dst + r * 65 + c8;
  d[0] = bflo(a.x); d[1] = bfhi(a.x); d[2] = bflo(a.y); d[3] = bfhi(a.y); d[4] = bflo(a.z); d[5] = bfhi(a.z); d[6] = bflo(a.w); d[7] = bfhi(a.w);
}
__device__ __forceinline__ void ml_local_unit(const Params& p, int l, int unit, unsigned char* lds) {
  int tid_ = tidx(); asm volatile("" : "+v"(tid_)); const int tid = tid_, lane = tid & 63, wid = tid >> 6, r32 = lane & 31, hi = lane >> 5;
  float* Kt = (float*)lds; float* Vt = Kt + 64 * 65; float* WK = Vt + 64 * 65;
  const bf16_t* PROJ = (const bf16_t*)(p.ws + WS_PROJ);
  const float* GT = (const float*)(p.ws + WS_GATES);
  float* UL = (float*)(p.ws + WS_ULOC); float* META = (float*)(p.ws + WS_MLMETA);
  const int b = unit / (4 * NCH), hh = (unit / NCH) & 3, ch = unit % NCH;
  const int row0 = b * SEGL + ch * 64;
  ml_load_tile(PROJ + (size_t)row0 * PW + C_MK + hh * 64, Kt, tid);
  ml_load_tile(PROJ + (size_t)row0 * PW + C_MV + hh * 64, Vt, tid);
  if (wid < 2) {
    const int dir = wid;
    const float ig = GT[(size_t)(row0 + lane) * 16 + (2 * dir) * 4 + hh];
    const float lf = logsigmoidf_(GT[(size_t)(row0 + lane) * 16 + (2 * dir + 1) * 4 + hh]);
    float ps = lf;
    ps = wave_incl_scan(ps);
    const float tot = __uint_as_float((unsigned)__builtin_amdgcn_readlane((int)__float_as_uint(ps), 63));
    const float wlog = dir == 0 ? (tot - ps + ig) : (ps - lf + ig);
    const float mloc = wave_max(wlog);
    WK[dir * 64 + lane] = __expf(wlog - mloc);
    if (lane == 0) {
      const int seq = (b * 4 + hh) * 2 + dir, ci = ml_cidx(ch, dir);
      META[((size_t)seq * NCH + ci) * 4 + 0] = tot; META[((size_t)seq * NCH + ci) * 4 + 1] = mloc;
    }
  }
  __syncthreads();
  {
    const int dir = wid >> 2, et = (wid >> 1) & 1, dt = wid & 1;
    const int seq = (b * 4 + hh) * 2 + dir, ci = ml_cidx(ch, dir);
    float* slot = UL + ((size_t)seq * NCH + ci) * USTRIDE;
    f32x16 acc = {};
#pragma unroll 8
    for (int ks = 0; ks < 32; ++ks) {
      const int s = 2 * ks + hi;
      const float a = WK[dir * 64 + s] * Vt[s * 65 + et * 32 + r32];
      const float bb = Kt[s * 65 + dt * 32 + r32];
      acc = __builtin_amdgcn_mfma_f32_32x32x2f32(a, bb, acc, 0, 0, 0);
    }
#pragma unroll
    for (int r = 0; r < 16; ++r) slot[(et * 32 + crow(r, hi)) * 64 + dt * 32 + r32] = acc[r];
    if (et == 0) {
      float n = 0.f;
#pragma unroll 8
      for (int i = 0; i < 32; ++i) { const int s = hi * 32 + i; n += WK[dir * 64 + s] * Kt[s * 65 + dt * 32 + r32]; }
      n = sum_xor32(n);
      if (hi == 0) slot[4096 + dt * 32 + r32] = n;
    }
  }
  __syncthreads();
}
constexpr int MLP = 144;
constexpr size_t WS_CST = WS_H;
constexpr size_t WS_NST = WS_H + (size_t)32 * NCH * 4096 * 2;
__device__ __forceinline__ void ml_stage_rm(const bf16_t* src, size_t ld, unsigned char* dst, int tid) {
  const int r = tid >> 3, c8 = (tid & 7) * 8;
  *(u32x4*)(dst + r * MLP + c8 * 2) = *(const u32x4*)(src + (size_t)r * ld + c8);
}
__device__ __forceinline__ void ml_stage_tr(const bf16_t* src, size_t ld, unsigned char* dst, int tid) {
  const int r = tid >> 3, c8 = (tid & 7) * 8;
  const u32x4 a = *(const u32x4*)(src + (size_t)r * ld + c8);
  bf16_t* d = (bf16_t*)dst;
  d[(c8 + 0) * 72 + r] = (bf16_t)(a.x & 0xffffu); d[(c8 + 1) * 72 + r] = (bf16_t)(a.x >> 16);
  d[(c8 + 2) * 72 + r] = (bf16_t)(a.y & 0xffffu); d[(c8 + 3) * 72 + r] = (bf16_t)(a.y >> 16);
  d[(c8 + 4) * 72 + r] = (bf16_t)(a.z & 0xffffu); d[(c8 + 5) * 72 + r] = (bf16_t)(a.z >> 16);
  d[(c8 + 6) * 72 + r] = (bf16_t)(a.w & 0xffffu); d[(c8 + 7) * 72 + r] = (bf16_t)(a.w >> 16);
}
__device__ __forceinline__ void ml_local_unit2(const Params& p, int l, int unit, unsigned char* lds) {
  int tid_ = tidx(); asm volatile("" : "+v"(tid_)); const int tid = tid_, lane = tid & 63, wid = tid >> 6, r32 = lane & 31, hi = lane >> 5;
  unsigned char* KT = lds; unsigned char* VT = lds + 64 * MLP; float* WK = (float*)(lds + 2 * 64 * MLP);
  const bf16_t* PROJ = (const bf16_t*)(p.ws + WS_PROJ);
  const float* GT = (const float*)(p.ws + WS_GATES);
  float* UL = (float*)(p.ws + WS_ULOC); float* META = (float*)(p.ws + WS_MLMETA);
  const int b = unit / (4 * NCH), hh = (unit / NCH) & 3, ch = unit % NCH;
  const int row0 = b * SEGL + ch * 64;
  ml_stage_tr(PROJ + (size_t)row0 * PW + C_MK + hh * 64, PW, KT, tid);
  ml_stage_tr(PROJ + (size_t)row0 * PW + C_MV + hh * 64, PW, VT, tid);
  if (wid < 2) {
    const int dir = wid;
    const float ig = GT[(size_t)(row0 + lane) * 16 + (2 * dir) * 4 + hh];
    const float lf = logsigmoidf_(GT[(size_t)(row0 + lane) * 16 + (2 * dir + 1) * 4 + hh]);
    float ps = lf;
    ps = wave_incl_scan(ps);
    const float tot = __uint_as_float((unsigned)__builtin_amdgcn_readlane((int)__float_as_uint(ps), 63));
    const float wlog = dir == 0 ? (tot - ps + ig) : (ps - lf + ig);
    const float mloc = wave_max(wlog);
    WK[dir * 64 + lane] = __expf(wlog - mloc);
    if (lane == 0) {
      const int seq = (b * 4 + hh) * 2 + dir, ci = ml_cidx(ch, dir);
      META[((size_t)seq * NCH + ci) * 4 + 0] = tot; META[((size_t)seq * NCH + ci) * 4 + 1] = mloc;
    }
  }
  __syncthreads();
  {
    const int dir = wid >> 2, et = (wid >> 1) & 1, dt = wid & 1;
    const int seq = (b * 4 + hh) * 2 + dir, ci = ml_cidx(ch, dir);
    float* slot = UL + ((size_t)seq * NCH + ci) * USTRIDE;
    f32x16 acc = {};
#pragma unroll
    for (int ks = 0; ks < 4; ++ks) {
      const int s0 = ks * 16 + hi * 8;
      const u32x4 va = *(const u32x4*)(VT + (et * 32 + r32) * MLP + s0 * 2);
      const bf16x8 kb = *(const bf16x8*)(KT + (dt * 32 + r32) * MLP + s0 * 2);
      const f32x4 w0 = *(const f32x4*)(WK + dir * 64 + s0), w1 = *(const f32x4*)(WK + dir * 64 + s0 + 4);
      u32x4 sa; sa.x = cvtpk(bflo(va.x) * w0.x, bfhi(va.x) * w0.y); sa.y = cvtpk(bflo(va.y) * w0.z, bfhi(va.y) * w0.w);
      sa.z = cvtpk(bflo(va.z) * w1.x, bfhi(va.z) * w1.y); sa.w = cvtpk(bflo(va.w) * w1.z, bfhi(va.w) * w1.w);
      acc = __builtin_amdgcn_mfma_f32_32x32x16_bf16(*(const bf16x8*)&sa, kb, acc, 0, 0, 0);
    }
#pragma unroll
    for (int r = 0; r < 16; ++r) slot[(et * 32 + crow(r, hi)) * 64 + dt * 32 + r32] = acc[r];
    if (et == 0) {
      float n = 0.f;
#pragma unroll
      for (int i = 0; i < 4; ++i) {
        const int s0 = hi * 32 + i * 8;
        const u32x4 ka = *(const u32x4*)(KT + (dt * 32 + r32) * MLP + s0 * 2);
        const f32x4 w0 = *(const f32x4*)(WK + dir * 64 + s0), w1 = *(const f32x4*)(WK + dir * 64 + s0 + 4);
        n += bflo(ka.x) * w0.x + bfhi(ka.x) * w0.y + bflo(ka.y) * w0.z + bfhi(ka.y) * w0.w + bflo(ka.z) * w1.x + bfhi(ka.z) * w1.y + bflo(ka.w) * w1.z + bfhi(ka.w) * w1.w;
      }
      n = sum_xor32(n);
      if (hi == 0) slot[4096 + dt * 32 + r32] = n;
    }
  }
  __syncthreads();
}
__device__ __forceinline__ void ml_scan(const Params& p, unsigned char* lds) {
  float* UL = (float*)(p.ws + WS_ULOC); float* META = (float*)(p.ws + WS_MLMETA);
  int tid_ = tidx(); asm volatile("" : "+v"(tid_));
  const int tid = tid_, lane = tid & 63, wid = tid >> 6;
  float* DEC = (float*)lds;
  float* SCL = DEC + 2 * NCH;
  float* TMP = SCL + 2 * NCH;
  constexpr int NSL = (32 * USTRIDE + 511) / 512;
  const int first_ = p.gx > 64 ? 16 : 0, nb_ = p.gx - first_;
  for (int k_ = 0; k_ < 2 + (NSL + nb_ - 1) / nb_; ++k_) {
    int s_;
    if (k_ == 0) s_ = p.bx >= first_ ? p.bx - first_ : -1;
    else s_ = k_ * nb_ + (p.gx - 1 - p.bx);
    if (k_ > 0 && p.gx - 1 - p.bx >= nb_) s_ = -1;
    if (s_ < 0 || s_ >= NSL) continue;
    const int base0 = s_ * 512;
    const int seq0 = base0 / USTRIDE;
    if (wid < 2) {
      const int seq = seq0 + wid;
      if (seq < 32) {
        float* mt = META + (size_t)seq * NCH * 4;
        for (int c = lane; c < NCH; c += 64) { TMP[(wid * 2 + 0) * NCH + c] = mt[c * 4 + 0]; TMP[(wid * 2 + 1) * NCH + c] = mt[c * 4 + 1]; }
        asm volatile("s_waitcnt lgkmcnt(0)" ::: "memory");
        if (lane == 0) {
          float m = 0.f;
          for (int c = 0; c < NCH; ++c) {
            const float bl = TMP[(wid * 2 + 0) * NCH + c], mloc = TMP[(wid * 2 + 1) * NCH + c];
            const float mn = fmaxf(bl + m, mloc);
            DEC[wid * NCH + c] = __expf(bl + m - mn); SCL[wid * NCH + c] = __expf(mloc - mn);
            mt[c * 4 + 2] = m;
            m = mn;
          }
        }
      }
    }
    __syncthreads();
    const int idx = base0 + tid;
    if (idx < 32 * USTRIDE) {
      const int seq = idx / USTRIDE, e = idx - seq * USTRIDE, sl = seq - seq0;
      float* bp = UL + (size_t)seq * NCH * USTRIDE + e;
      bf16_t* CSTp = (bf16_t*)(p.ws + WS_CST) + (size_t)seq * NCH * 4096 + (e < 4096 ? e : 0);
      float* NSTp = (float*)(p.ws + WS_NST) + (size_t)seq * NCH * 64 + (e < 4096 ? 0 : e - 4096);
      const float* dec = DEC + sl * NCH; const float* scl = SCL + sl * NCH;
      float C = 0.f;
      constexpr int BT = 33;
      static_assert(NCH == 4 * BT, "scan batches");
      float ua[BT], ub[BT];
#define SCAN_LD(u_, c0_) _Pragma("unroll") for (int j = 0; j < BT; ++j) u_[j] = bp[(size_t)((c0_) + j) * USTRIDE];
#define SCAN_DO(u_, c0_) _Pragma("unroll") for (int j = 0; j < BT; ++j) { \
          if (e < 4096) CSTp[(size_t)((c0_) + j) * 4096] = (bf16_t)(cvtpk(C, 0.f) & 0xffffu); else NSTp[(size_t)((c0_) + j) * 64] = C; \
          C = dec[(c0_) + j] * C + scl[(c0_) + j] * u_[j]; }
      SCAN_LD(ua, 0)
#pragma unroll 1
      for (int c0 = 0; c0 < NCH; c0 += 2 * BT) {
        SCAN_LD(ub, c0 + BT)
        SCAN_DO(ua, c0)
        if (c0 + 2 * BT < NCH) { SCAN_LD(ua, c0 + 2 * BT) }
        SCAN_DO(ub, c0 + BT)
      }
#undef SCAN_LD
#undef SCAN_DO
    }
    __syncthreads();
  }
}
__device__ __forceinline__ void ml_out_unit(const Params& p, int l, int unit, unsigned char* lds) {
  int tid_ = tidx(); asm volatile("" : "+v"(tid_)); const int tid = tid_, lane = tid & 63, wid = tid >> 6, r32 = lane & 31, hi = lane >> 5;
  float* Qt = (float*)lds; float* Kt = Qt + 64 * 65; float* Vt = Kt + 64 * 65;
  float* Cs = Vt + 64 * 65;
  float* Ns = Cs + 2 * 64 * 65;
  float* Bq = Ns + 128;
  float* Gs = Bq + 128;
  float* Mi = Gs + 128;
  float* HB = Mi + 64;
  const bf16_t* PROJ = (const bf16_t*)(p.ws + WS_PROJ);
  const float* GT = (const float*)(p.ws + WS_GATES);
  const float* UL = (const float*)(p.ws + WS_ULOC); const float* META = (const float*)(p.ws + WS_MLMETA);
  bf16_t* MIX = (bf16_t*)(p.ws + WS_MIX);
  const int b = unit / (4 * NCH), hh = (unit / NCH) & 3, ch = unit % NCH;
  const int row0 = b * SEGL + ch * 64;
  ml_load_tile(PROJ + (size_t)row0 * PW + C_MQ + hh * 64, Qt, tid);
  ml_load_tile(PROJ + (size_t)row0 * PW + C_MK + hh * 64, Kt, tid);
  ml_load_tile(PROJ + (size_t)row0 * PW + C_MV + hh * 64, Vt, tid);
  for (int i = tid; i < 2 * USTRIDE; i += 512) {
    const int dir = i / USTRIDE, e = i - dir * USTRIDE;
    const int seq = (b * 4 + hh) * 2 + dir, ci = ml_cidx(ch, dir);
    const float v = UL[((size_t)seq * NCH + ci) * USTRIDE + e];
    if (e < 4096) Cs[dir * 64 * 65 + (e >> 6) * 65 + (e & 63)] = v; else Ns[dir * 64 + (e - 4096)] = v;
  }
  if (wid < 2) {
    const int dir = wid;
    const float ig = GT[(size_t)(row0 + lane) * 16 + (2 * dir) * 4 + hh];
    const float lf = logsigmoidf_(GT[(size_t)(row0 + lane) * 16 + (2 * dir + 1) * 4 + hh]);
    float ps = lf;
    ps = wave_incl_scan(ps);
    const float tot = __uint_as_float((unsigned)__builtin_amdgcn_readlane((int)__float_as_uint(ps), 63));
    const float bc = dir == 0 ? ps : (tot - ps + lf);
    Bq[dir * 64 + lane] = bc; Gs[dir * 64 + lane] = ig - bc;
    if (lane == 0) { const int seq = (b * 4 + hh) * 2 + dir, ci = ml_cidx(ch, dir); Mi[dir] = META[((size_t)seq * NCH + ci) * 4 + 2]; }
  }
  __syncthreads();
  {
    const int dir = wid >> 2, tt = (wid >> 1) & 1, et = wid & 1;
    const int t = tt * 32 + r32;
    f32x16 sa[2] = {};
#pragma unroll 4
    for (int ks = 0; ks < 32; ++ks) {
      const float bq = Qt[t * 65 + 2 * ks + hi];
      const float a0 = Kt[(r32) * 65 + 2 * ks + hi], a1 = Kt[(32 + r32) * 65 + 2 * ks + hi];
      sa[0] = __builtin_amdgcn_mfma_f32_32x32x2f32(a0, bq, sa[0], 0, 0, 0);
      sa[1] = __builtin_amdgcn_mfma_f32_32x32x2f32(a1, bq, sa[1], 0, 0, 0);
    }
    const float bt = Bq[dir * 64 + t];
    const float inter = bt + Mi[dir];
    float mx = -INFINITY;
    f32x16 dl[2];
#pragma unroll
    for (int st = 0; st < 2; ++st)
#pragma unroll
      for (int r = 0; r < 16; ++r) {
        const int s = st * 32 + crow(r, hi);
        const bool ok = dir == 0 ? (s <= t) : (s >= t);
        const float d = ok ? bt + Gs[dir * 64 + s] : -INFINITY;
        dl[st][r] = d; mx = fmaxf(mx, d);
      }
    mx = max_xor32(mx);
    const float mt = fmaxf(inter, mx);
    const float iw = __expf(inter - mt);
    float rsum = 0.f;
#pragma unroll
    for (int st = 0; st < 2; ++st)
#pragma unroll
      for (int r = 0; r < 16; ++r) { const float w = __expf(dl[st][r] - mt); sa[st][r] *= w; rsum += sa[st][r]; }
    rsum = sum_xor32(rsum);
    float qn = 0.f;
#pragma unroll 8
    for (int i = 0; i < 32; ++i) { const int d = hi * 32 + i; qn += Ns[dir * 64 + d] * Qt[t * 65 + d]; }
    qn = sum_xor32(qn);
    const float den = rsum + iw * qn;
    const float rden = 1.f / fmaxf(fabsf(den), __expf(-mt));
    f32x16 an = {}, ac = {};
#pragma unroll
    for (int st = 0; st < 2; ++st)
#pragma unroll
      for (int r = 0; r < 16; ++r) {
        const float a = Vt[(st * 32 + crow(r, hi)) * 65 + et * 32 + r32];
        an = __builtin_amdgcn_mfma_f32_32x32x2f32(a, sa[st][r], an, 0, 0, 0);
      }
    const float* Cd = Cs + dir * 64 * 65;
#pragma unroll 4
    for (int ks = 0; ks < 32; ++ks) {
      const float a = Cd[(et * 32 + r32) * 65 + 2 * ks + hi];
      const float bq = Qt[t * 65 + 2 * ks + hi];
      ac = __builtin_amdgcn_mfma_f32_32x32x2f32(a, bq, ac, 0, 0, 0);
    }
#pragma unroll
    for (int r = 0; r < 16; ++r) HB[dir * 64 * 65 + t * 65 + et * 32 + crow(r, hi)] = (an[r] + iw * ac[r]) * rden;
  }
  __syncthreads();
  {
    const int t = tid >> 3, e8 = (tid & 7) * 8;
    float v[8]; float ss = 0.f;
#pragma unroll
    for (int i = 0; i < 8; ++i) { v[i] = HB[t * 65 + e8 + i] + HB[64 * 65 + t * 65 + e8 + i]; ss += v[i] * v[i]; }
    ss += dpp_mov<0xB1>(ss); ss += dpp_mov<0x4E>(ss); ss += dpp_mov<0x141>(ss);
    const float rs = rsqrtf(ss * (1.f / 64.f) + EPS);
    const u32x4 ov = *(const u32x4*)(PROJ + (size_t)(row0 + t) * PW + C_MO + hh * 64 + e8);
    const float og[8] = {bflo(ov.x), bfhi(ov.x), bflo(ov.y), bfhi(ov.y), bflo(ov.z), bfhi(ov.z), bflo(ov.w), bfhi(ov.w)};
    const float* g = p.in[I_MNORMG] + l * 64 + e8;
    float o[8];
#pragma unroll
    for (int i = 0; i < 8; ++i) o[i] = (ABL & 2) ? 0.f : v[i] * rs * g[i] * sigmoidf_(og[i]);
    u32x4 w; w.x = cvtpk(o[0], o[1]); w.y = cvtpk(o[2], o[3]); w.z = cvtpk(o[4], o[5]); w.w = cvtpk(o[6], o[7]);
    *(u32x4*)(MIX + (size_t)(row0 + t) * DM + 256 + hh * 64 + e8) = w;
  }
  __syncthreads();
}


struct MlOutPf { u32x4 q, k, v, c0, c1, ov; float ns0, ns1, g_ig, g_lf, mi; };
__device__ __forceinline__ void ml_out_fetch(const Params& p, int unit, int tid, MlOutPf& f) {
  const int lane = tid & 63, wid = tid >> 6;
  const bf16_t* PROJ = (const bf16_t*)(p.ws + WS_PROJ);
  const float* GT = (const float*)(p.ws + WS_GATES);
  const bf16_t* CST = (const bf16_t*)(p.ws + WS_CST); const float* NST = (const float*)(p.ws + WS_NST); const float* META = (const float*)(p.ws + WS_MLMETA);
  const int b = unit / (4 * NCH), hh = (unit / NCH) & 3, ch = unit % NCH;
  const int row0 = b * SEGL + ch * 64;
  const int r = tid >> 3, c8 = (tid & 7) * 8;
  const bf16_t* prow = PROJ + (size_t)(row0 + r) * PW + hh * 64 + c8;
  f.q = *(const u32x4*)(prow + C_MQ); f.k = *(const u32x4*)(prow + C_MK); f.v = *(const u32x4*)(prow + C_MV); f.ov = *(const u32x4*)(prow + C_MO);
  const int seq0 = (b * 4 + hh) * 2, ci0 = ml_cidx(ch, 0), ci1 = ml_cidx(ch, 1);
  f.c0 = *(const u32x4*)(CST + ((size_t)seq0 * NCH + ci0) * 4096 + r * 64 + c8);
  f.c1 = *(const u32x4*)(CST + ((size_t)(seq0 + 1) * NCH + ci1) * 4096 + r * 64 + c8);
  f.ns0 = 0.f; f.ns1 = 0.f; f.g_ig = 0.f; f.g_lf = 0.f; f.mi = 0.f;
  if (tid < 64) { f.ns0 = NST[((size_t)seq0 * NCH + ci0) * 64 + tid]; f.ns1 = NST[((size_t)(seq0 + 1) * NCH + ci1) * 64 + tid]; }
  if (wid < 2) {
    const int dir = wid;
    f.g_ig = GT[(size_t)(row0 + lane) * 16 + (2 * dir) * 4 + hh];
    f.g_lf = GT[(size_t)(row0 + lane) * 16 + (2 * dir + 1) * 4 + hh];
    f.mi = META[((size_t)(seq0 + dir) * NCH + (dir ? ci1 : ci0)) * 4 + 2];
  }
}
__device__ __forceinline__ void ml_put_rm(const u32x4 a, unsigned char* dst, int tid) { const int r = tid >> 3, c8 = (tid & 7) * 8; *(u32x4*)(dst + r * MLP + c8 * 2) = a; }
__device__ __forceinline__ void ml_put_tr(const u32x4 a, unsigned char* dst, int tid) {
  const int r = tid >> 3, c8 = (tid & 7) * 8;
  bf16_t* d = (bf16_t*)dst;
  d[(c8 + 0) * 72 + r] = (bf16_t)(a.x & 0xffffu); d[(c8 + 1) * 72 + r] = (bf16_t)(a.x >> 16);
  d[(c8 + 2) * 72 + r] = (bf16_t)(a.y & 0xffffu); d[(c8 + 3) * 72 + r] = (bf16_t)(a.y >> 16);
  d[(c8 + 4) * 72 + r] = (bf16_t)(a.z & 0xffffu); d[(c8 + 5) * 72 + r] = (bf16_t)(a.z >> 16);
  d[(c8 + 6) * 72 + r] = (bf16_t)(a.w & 0xffffu); d[(c8 + 7) * 72 + r] = (bf16_t)(a.w >> 16);
}
__device__ __forceinline__ void ml_out_unit2(const Params& p, int l, int unit, unsigned char* lds, const MlOutPf& f, int next, MlOutPf& fn) {
  int tid_ = tidx(); asm volatile("" : "+v"(tid_)); const int tid = tid_, lane = tid & 63, wid = tid >> 6, r32 = lane & 31, hi = lane >> 5;
  unsigned char* Qs = lds; unsigned char* Ks = lds + 64 * MLP; unsigned char* VT = lds + 2 * 64 * MLP; unsigned char* Cs = lds + 3 * 64 * MLP;
  float* Ns = (float*)(lds + 5 * 64 * MLP);
  float* Bq = Ns + 128;
  float* Gs = Bq + 128;
  float* Mi = Gs + 128;
  float* HB = Mi + 64;
  const bf16_t* PROJ = (const bf16_t*)(p.ws + WS_PROJ);
  const float* GT = (const float*)(p.ws + WS_GATES);
  const bf16_t* CST = (const bf16_t*)(p.ws + WS_CST); const float* NST = (const float*)(p.ws + WS_NST); const float* META = (const float*)(p.ws + WS_MLMETA);
  bf16_t* MIX = (bf16_t*)(p.ws + WS_MIX);
  const int b = unit / (4 * NCH), hh = (unit / NCH) & 3, ch = unit % NCH;
  const int row0 = b * SEGL + ch * 64;
  ml_put_rm(f.q, Qs, tid); ml_put_rm(f.k, Ks, tid); ml_put_tr(f.v, VT, tid);
  ml_put_rm(f.c0, Cs, tid); ml_put_rm(f.c1, Cs + 64 * MLP, tid);
  if (tid < 64) { Ns[tid] = f.ns0; Ns[64 + tid] = f.ns1; }
  if (wid < 2) {
    const int dir = wid;
    const float ig = f.g_ig;
    const float lf = logsigmoidf_(f.g_lf);
    float ps = lf;
    ps = wave_incl_scan(ps);
    const float tot = __uint_as_float((unsigned)__builtin_amdgcn_readlane((int)__float_as_uint(ps), 63));
    const float bc = dir == 0 ? ps : (tot - ps + lf);
    Bq[dir * 64 + lane] = bc; Gs[dir * 64 + lane] = ig - bc;
    if (lane == 0) Mi[dir] = f.mi;
  }
  const u32x4 ov = f.ov;
  if (next >= 0) ml_out_fetch(p, next, tid, fn);
  __syncthreads();
  {
    const int dir = wid >> 2, tt = (wid >> 1) & 1, et = wid & 1;
    const int t = tt * 32 + r32;
    f32x16 sa[2] = {};
    bf16x8 bq[4];
#pragma unroll
    for (int ks = 0; ks < 4; ++ks) {
      bq[ks] = *(const bf16x8*)(Qs + t * MLP + (ks * 16 + hi * 8) * 2);
      const bf16x8 a0 = *(const bf16x8*)(Ks + r32 * MLP + (ks * 16 + hi * 8) * 2), a1 = *(const bf16x8*)(Ks + (32 + r32) * MLP + (ks * 16 + hi * 8) * 2);
      sa[0] = __builtin_amdgcn_mfma_f32_32x32x16_bf16(a0, bq[ks], sa[0], 0, 0, 0);
      sa[1] = __builtin_amdgcn_mfma_f32_32x32x16_bf16(a1, bq[ks], sa[1], 0, 0, 0);
    }
    const float bt = Bq[dir * 64 + t];
    const float inter = bt + Mi[dir];
    float mx = -INFINITY;
    f32x16 dl[2];
#pragma unroll
    for (int st = 0; st < 2; ++st)
#pragma unroll
      for (int r = 0; r < 16; ++r) {
        const int s = st * 32 + crow(r, hi);
        const bool ok = dir == 0 ? (s <= t) : (s >= t);
        const float d = ok ? bt + Gs[dir * 64 + s] : -INFINITY;
        dl[st][r] = d; mx = fmaxf(mx, d);
      }
    mx = max_xor32(mx);
    const float mt = fmaxf(inter, mx);
    const float iw = __expf(inter - mt);
    float rsum = 0.f;
#pragma unroll
    for (int st = 0; st < 2; ++st)
#pragma unroll
      for (int r = 0; r < 16; ++r) { const float w = __expf(dl[st][r] - mt); sa[st][r] *= w; rsum += sa[st][r]; }
    rsum = sum_xor32(rsum);
    float qn = 0.f;
#pragma unroll
    for (int i = 0; i < 4; ++i) {
      const int d0 = hi * 32 + i * 8;
      const u32x4 qa = *(const u32x4*)(Qs + t * MLP + d0 * 2);
      const f32x4 n0 = *(const f32x4*)(Ns + dir * 64 + d0), n1 = *(const f32x4*)(Ns + dir * 64 + d0 + 4);
      qn += bflo(qa.x) * n0.x + bfhi(qa.x) * n0.y + bflo(qa.y) * n0.z + bfhi(qa.y) * n0.w + bflo(qa.z) * n1.x + bfhi(qa.z) * n1.y + bflo(qa.w) * n1.z + bfhi(qa.w) * n1.w;
    }
    qn = sum_xor32(qn);
    const float den = rsum + iw * qn;
    const float rden = 1.f / fmaxf(fabsf(den), __expf(-mt));
    f32x16 an = {}, ac = {};
#pragma unroll
    for (int st = 0; st < 2; ++st)
#pragma unroll
      for (int k2 = 0; k2 < 2; ++k2) {
        u32x4 bx; bx.x = cvtpk(sa[st][8 * k2 + 0], sa[st][8 * k2 + 1]); bx.y = cvtpk(sa[st][8 * k2 + 2], sa[st][8 * k2 + 3]);
        bx.z = cvtpk(sa[st][8 * k2 + 4], sa[st][8 * k2 + 5]); bx.w = cvtpk(sa[st][8 * k2 + 6], sa[st][8 * k2 + 7]);
        const unsigned char* vrow = VT + (et * 32 + r32) * MLP + (st * 32 + 16 * k2 + 4 * hi) * 2;
        const u32x2 v0 = *(const u32x2*)vrow, v1 = *(const u32x2*)(vrow + 16);
        u32x4 ax; ax.x = v0.x; ax.y = v0.y; ax.z = v1.x; ax.w = v1.y;
        an = __builtin_amdgcn_mfma_f32_32x32x16_bf16(*(const bf16x8*)&ax, *(const bf16x8*)&bx, an, 0, 0, 0);
      }
    const unsigned char* Cd = Cs + dir * 64 * MLP;
#pragma unroll
    for (int ks = 0; ks < 4; ++ks) {
      const bf16x8 a = *(const bf16x8*)(Cd + (et * 32 + r32) * MLP + (ks * 16 + hi * 8) * 2);
      ac = __builtin_amdgcn_mfma_f32_32x32x16_bf16(a, bq[ks], ac, 0, 0, 0);
    }
#pragma unroll
    for (int r = 0; r < 16; ++r) HB[dir * 64 * 65 + t * 65 + et * 32 + crow(r, hi)] = (an[r] + iw * ac[r]) * rden;
  }
  __syncthreads();
  {
    const int t = tid >> 3, e8 = (tid & 7) * 8;
    float v[8]; float ss = 0.f;
#pragma unroll
    for (int i = 0; i < 8; ++i) { v[i] = HB[t * 65 + e8 + i] + HB[64 * 65 + t * 65 + e8 + i]; ss += v[i] * v[i]; }
    ss += dpp_mov<0xB1>(ss); ss += dpp_mov<0x4E>(ss); ss += dpp_mov<0x141>(ss);
    const float rs = rsqrtf(ss * (1.f / 64.f) + EPS);
    const float og[8] = {bflo(ov.x), bfhi(ov.x), bflo(ov.y), bfhi(ov.y), bflo(ov.z), bfhi(ov.z), bflo(ov.w), bfhi(ov.w)};
    const float* g = p.in[I_MNORMG] + l * 64 + e8;
    float o[8];
#pragma unroll
    for (int i = 0; i < 8; ++i) o[i] = (ABL & 2) ? 0.f : v[i] * rs * g[i] * sigmoidf_(og[i]);
    u32x4 w; w.x = cvtpk(o[0], o[1]); w.y = cvtpk(o[2], o[3]); w.z = cvtpk(o[4], o[5]); w.w = cvtpk(o[6], o[7]);
    *(u32x4*)(MIX + (size_t)(row0 + t) * DM + 256 + hh * 64 + e8) = w;
  }
  __syncthreads();
}

#define KSWZ(row, colB) ((row) * 256 + ((colB) ^ (((row) & 15) << 4)))
#define SBAR() __builtin_amdgcn_sched_barrier(0)
constexpr int ATT_SHM_V = 128 * 80, ATT_SHM_K = 64 * QK8_PITCH;
constexpr float ATT_THR = 8.0f;
__device__ __forceinline__ int v_st(int k, int c) { const int kk = (k & ~0xC) | ((k & 4) << 1) | ((k & 8) >> 1); return ((kk >> 3) * 4 + (c >> 5)) * 512 + ((kk & 7) * 32 + (c & 31)) * 2; }
__device__ __forceinline__ int v_rd_base(int lane) { return ((lane & 3) << 3) | (((lane >> 2) & 3) << 6) | (((lane >> 4) & 1) << 5) | (((lane >> 5) & 1) << 8); }
constexpr int v_rd_off(int d0, int ks, int half) { return d0 * 512 + ks * 4096 + half * 2048; }
template <int OFF> __device__ __forceinline__ s16x4 tr_read(int vb) {
  s16x4 r; asm volatile("ds_read_b64_tr_b16 %0, %1 offset:%2" : "=&v"(r) : "v"(vb), "i"(OFF) : "memory"); return r;
}
template <int D0> __device__ __forceinline__ void pv_one(f32x16& od, int vb, bf16x8 pa0, bf16x8 pa1, bf16x8 pa2, bf16x8 pa3) {
  const s16x4 l0 = tr_read<v_rd_off(D0, 0, 0)>(vb), h0 = tr_read<v_rd_off(D0, 0, 1)>(vb), l1 = tr_read<v_rd_off(D0, 1, 0)>(vb), h1 = tr_read<v_rd_off(D0, 1, 1)>(vb);
  const s16x4 l2 = tr_read<v_rd_off(D0, 2, 0)>(vb), h2 = tr_read<v_rd_off(D0, 2, 1)>(vb), l3 = tr_read<v_rd_off(D0, 3, 0)>(vb), h3 = tr_read<v_rd_off(D0, 3, 1)>(vb);
  asm volatile("s_waitcnt lgkmcnt(0)" ::: "memory"); SBAR();
#define PK(L, H) (bf16x8){L[0], L[1], L[2], L[3], H[0], H[1], H[2], H[3]}
  od = __builtin_amdgcn_mfma_f32_32x32x16_bf16(pa0, PK(l0, h0), od, 0, 0, 0);
  od = __builtin_amdgcn_mfma_f32_32x32x16_bf16(pa1, PK(l1, h1), od, 0, 0, 0);
  od = __builtin_amdgcn_mfma_f32_32x32x16_bf16(pa2, PK(l2, h2), od, 0, 0, 0);
  od = __builtin_amdgcn_mfma_f32_32x32x16_bf16(pa3, PK(l3, h3), od, 0, 0, 0);
#undef PK
}
template <int D0> __device__ __forceinline__ void pv_two(f32x16& oa, f32x16& ob, int vb, bf16x8 a0, bf16x8 a1, bf16x8 a2, bf16x8 a3, bf16x8 b0, bf16x8 b1, bf16x8 b2, bf16x8 b3) {
  const s16x4 l0 = tr_read<v_rd_off(D0, 0, 0)>(vb), h0 = tr_read<v_rd_off(D0, 0, 1)>(vb), l1 = tr_read<v_rd_off(D0, 1, 0)>(vb), h1 = tr_read<v_rd_off(D0, 1, 1)>(vb);
  const s16x4 l2 = tr_read<v_rd_off(D0, 2, 0)>(vb), h2 = tr_read<v_rd_off(D0, 2, 1)>(vb), l3 = tr_read<v_rd_off(D0, 3, 0)>(vb), h3 = tr_read<v_rd_off(D0, 3, 1)>(vb);
  asm volatile("s_waitcnt lgkmcnt(0)" ::: "memory"); SBAR();
#define PK(L, H) (bf16x8){L[0], L[1], L[2], L[3], H[0], H[1], H[2], H[3]}
  const bf16x8 v0 = PK(l0, h0), v1 = PK(l1, h1), v2 = PK(l2, h2), v3 = PK(l3, h3);
  oa = __builtin_amdgcn_mfma_f32_32x32x16_bf16(a0, v0, oa, 0, 0, 0);
  ob = __builtin_amdgcn_mfma_f32_32x32x16_bf16(b0, v0, ob, 0, 0, 0);
  oa = __builtin_amdgcn_mfma_f32_32x32x16_bf16(a1, v1, oa, 0, 0, 0);
  ob = __builtin_amdgcn_mfma_f32_32x32x16_bf16(b1, v1, ob, 0, 0, 0);
  oa = __builtin_amdgcn_mfma_f32_32x32x16_bf16(a2, v2, oa, 0, 0, 0);
  ob = __builtin_amdgcn_mfma_f32_32x32x16_bf16(b2, v2, ob, 0, 0, 0);
  oa = __builtin_amdgcn_mfma_f32_32x32x16_bf16(a3, v3, oa, 0, 0, 0);
  ob = __builtin_amdgcn_mfma_f32_32x32x16_bf16(b3, v3, ob, 0, 0, 0);
#undef PK
}
struct KQFrag { bf16x8 b0, b1, q; };
__device__ __forceinline__ void att_ldkq(KQFrag& f, const LAS unsigned char* l3, int akk, int akq) {
  const LAS unsigned char* kp = l3 + akk;
  f.b0 = *(const LAS bf16x8*)kp; f.b1 = *(const LAS bf16x8*)(kp + 8192); f.q = *(const LAS bf16x8*)(l3 + akq);
}
#define ATT_MF(pa_, pb_, f_) do { pa_ = __builtin_amdgcn_mfma_f32_32x32x16_bf16(f_.b0, f_.q, pa_, 0, 0, 0); pb_ = __builtin_amdgcn_mfma_f32_32x32x16_bf16(f_.b1, f_.q, pb_, 0, 0, 0); } while (0)
__device__ __forceinline__ void att_qk_all(f32x16& p0, f32x16& p1, f32x16& q0, f32x16& q1, KQFrag& f0, const LAS unsigned char* l3, int akk0, int akq0, float ia, float ib) {
  KQFrag f1;
#pragma unroll
  for (int r = 0; r < 16; ++r) { p0[r] = ia; p1[r] = ia; q0[r] = ib; q1[r] = ib; }
  att_ldkq(f1, l3, akk0 ^ (1 << 5), akq0 ^ (1 << 5)); ATT_MF(p0, p1, f0); SBAR();
  att_ldkq(f0, l3, akk0 ^ (2 << 5), akq0 ^ (2 << 5)); ATT_MF(p0, p1, f1); SBAR();
  att_ldkq(f1, l3, akk0 ^ (3 << 5), akq0 ^ (3 << 5)); ATT_MF(p0, p1, f0); SBAR();
  att_ldkq(f0, l3, akk0 ^ (4 << 5), akq0 ^ (4 << 5)); ATT_MF(p0, p1, f1); SBAR();
  att_ldkq(f1, l3, akk0 ^ (5 << 5), akq0 ^ (5 << 5)); ATT_MF(q0, q1, f0); SBAR();
  att_ldkq(f0, l3, akk0 ^ (6 << 5), akq0 ^ (6 << 5)); ATT_MF(q0, q1, f1); SBAR();
  att_ldkq(f1, l3, akk0 ^ (7 << 5), akq0 ^ (7 << 5)); ATT_MF(q0, q1, f0); SBAR();
  ATT_MF(q0, q1, f1); SBAR();
}
__device__ __forceinline__ float bf16_near(float x) { return __uint_as_float((__float_as_uint(x) + 0x8000u) & 0xFFFF0000u); }
__device__ __forceinline__ void att_softmax(f32x16& p0, f32x16& p1, float& m_reg, float& l_reg, float& alpha, bool first, i32x8& pa) {
  alpha = 1.f;
  if (first) {
    float pmax = p0[0];
#pragma unroll
    for (int r = 1; r < 16; ++r) pmax = fmaxf(pmax, p0[r]);
#pragma unroll
    for (int r = 0; r < 16; ++r) pmax = fmaxf(pmax, p1[r]);
    { auto rr = __builtin_amdgcn_permlane32_swap(__float_as_uint(pmax), __float_as_uint(pmax), false, false);
      pmax = fmaxf(__uint_as_float(rr[0]), __uint_as_float(rr[1])); }
    pmax = bf16_near(pmax);
    alpha = 0.f; m_reg = pmax;
#pragma unroll
    for (int r = 0; r < 16; ++r) { p0[r] -= pmax; p1[r] -= pmax; }
  }
#pragma unroll
  for (int r = 0; r < 16; ++r) { p0[r] = __builtin_amdgcn_exp2f(p0[r]); p1[r] = __builtin_amdgcn_exp2f(p1[r]); }
  float ps;
  {
#define VADD(d_, a_, b_) asm("v_add_f32_e32 %0, %1, %2" : "=v"(d_) : "v"(a_), "v"(b_))
    float s0, s1, s2, s3;
    VADD(s0, p0[0], p0[1]); VADD(s1, p0[8], p0[9]); VADD(s2, p1[0], p1[1]); VADD(s3, p1[8], p1[9]);
#pragma unroll
    for (int r = 2; r < 8; ++r) { VADD(s0, s0, p0[r]); VADD(s1, s1, p0[8 + r]); VADD(s2, s2, p1[r]); VADD(s3, s3, p1[8 + r]); }
    VADD(s0, s0, s1); VADD(s2, s2, s3); VADD(ps, s0, s2);
#undef VADD
  }
  { auto rr = __builtin_amdgcn_permlane32_swap(__float_as_uint(ps), __float_as_uint(ps), false, false);
    ps = __uint_as_float(rr[0]) + __uint_as_float(rr[1]); }
  if (__builtin_expect(!first && __any(ps > 256.f), 0)) {
    float emax = p0[0];
#pragma unroll
    for (int r = 1; r < 16; ++r) emax = fmaxf(emax, p0[r]);
#pragma unroll
    for (int r = 0; r < 16; ++r) emax = fmaxf(emax, p1[r]);
    { auto rr = __builtin_amdgcn_permlane32_swap(__float_as_uint(emax), __float_as_uint(emax), false, false);
      emax = fmaxf(__uint_as_float(rr[0]), __uint_as_float(rr[1])); }
    const float m_new = bf16_near(m_reg + fmaxf(__builtin_amdgcn_logf(emax), 0.f));
    const float delta = m_new - m_reg;
    alpha = __builtin_amdgcn_exp2f(-delta); m_reg = m_new;
#pragma unroll
    for (int r = 0; r < 16; ++r) { p0[r] *= alpha; p1[r] *= alpha; }
    ps *= alpha;
  }
  l_reg = l_reg * alpha + ps;
#pragma unroll
  for (int v = 0; v < 4; ++v) {
    int w0, w1; asm volatile("" : "=v"(w0), "=v"(w1));
    w0 = __builtin_amdgcn_cvt_pk_fp8_f32(p0[4 * v], p0[4 * v + 1], w0, false); w0 = __builtin_amdgcn_cvt_pk_fp8_f32(p0[4 * v + 2], p0[4 * v + 3], w0, true);
    w1 = __builtin_amdgcn_cvt_pk_fp8_f32(p1[4 * v], p1[4 * v + 1], w1, false); w1 = __builtin_amdgcn_cvt_pk_fp8_f32(p1[4 * v + 2], p1[4 * v + 3], w1, true);
    pa[v] = w0; pa[4 + v] = w1;
  }
}
__device__ __forceinline__ void att_unit(const unsigned char* __restrict__ Q8, const unsigned char* __restrict__ K8, const unsigned char* __restrict__ V8, bf16_t* __restrict__ Ob,
                                         int nkeys, float lam, const float* __restrict__ ng, float oscale, unsigned char* lds) {
  int tid_ = tidx(); asm volatile("" : "+v"(tid_)); const int tid = tid_, wid = tid >> 6, lane = tid & 63, r32 = lane & 31, hi = lane >> 5;
  const int grp = __builtin_amdgcn_readfirstlane(wid >> 2);
  unsigned char* V_lds = lds; unsigned char* K_lds = lds + 2 * ATT_SHM_V;
  float* wsl = (float*)(lds + 2 * ATT_SHM_V + 2 * ATT_SHM_K) + wid * 64; float* li_l = wsl; float* al_l = wsl + 32;
  float m0 = 0.f, l0 = 0.f, m1 = 0.f, l1 = 0.f;
  f32x16 o0[4] = {}, o1[4] = {};
  unsigned char* Q_lds = lds + 2 * ATT_SHM_V + 2 * ATT_SHM_K + 2048;
#pragma unroll
  for (int i = 0; i < 5; ++i) { const int piece = __builtin_amdgcn_readfirstlane(wid) + 8 * i;
    if (piece < 36) __builtin_amdgcn_global_load_lds((const unsigned*)(Q8 + piece * 1024 + lane * 16), (LAS unsigned*)(Q_lds + piece * 1024), 16, 0, 0); }
  const unsigned ldsw = (unsigned)__builtin_amdgcn_readfirstlane(wid) * 1024u;
#define GSTAGE_K(b, k0) do { const unsigned char* ki_ = K8 + (size_t)(k0) * QK8_PITCH + tid * 16; \
      __builtin_amdgcn_global_load_lds((const unsigned*)ki_, (LAS unsigned*)(K_lds + (b) * ATT_SHM_K + ldsw), 16, 0, 0); \
      if (wid < 1) __builtin_amdgcn_global_load_lds((const unsigned*)(ki_ + 8192), (LAS unsigned*)(K_lds + (b) * ATT_SHM_K + 8192 + ldsw), 16, 0, 0); } while (0)
#define GSTAGE_V(b, k0) do { const unsigned char* vi_ = V8 + (size_t)((k0) >> 6) * ATT_SHM_V + tid * 16; \
      __builtin_amdgcn_global_load_lds((const unsigned*)vi_, (LAS unsigned*)(V_lds + (b) * ATT_SHM_V + ldsw), 16, 0, 0); \
      if (wid < 2) __builtin_amdgcn_global_load_lds((const unsigned*)(vi_ + 8192), (LAS unsigned*)(V_lds + (b) * ATT_SHM_V + 8192 + ldsw), 16, 0, 0); } while (0)
#define STAGE_PAIR(jj) do { GSTAGE_V((jj) & 1, (jj) * 64); if ((jj) + 1 < NT) GSTAGE_K((jj) & 1, ((jj) + 1) * 64); } while (0)
#define RESC(o, a) do { if (__any((a) < 1.f)) { if (hi == 0) al_l[r32] = (a); asm volatile("s_waitcnt lgkmcnt(0)" ::: "memory"); \
    _Pragma("unroll") for (int d = 0; d < 4; ++d) _Pragma("unroll") for (int r = 0; r < 16; ++r) o[d][r] *= al_l[crow(r, hi)]; } } while (0)
#define ATT_BAR() do { asm volatile("s_waitcnt lgkmcnt(0)" ::: "memory"); __builtin_amdgcn_s_barrier(); asm volatile("" ::: "memory"); } while (0)
#define ATT_LDK(dst_, off_) do { const u32x4 x0_ = *(const LAS u32x4*)(kb_ + (off_)), x1_ = *(const LAS u32x4*)(kb_ + (off_) + 16); \
      dst_[0] = (int)x0_.x; dst_[1] = (int)x0_.y; dst_[2] = (int)x0_.z; dst_[3] = (int)x0_.w; dst_[4] = (int)x1_.x; dst_[5] = (int)x1_.y; dst_[6] = (int)x1_.z; dst_[7] = (int)x1_.w; } while (0)
#define ATT_SC(acc_, kf_, qf_) acc_ = __builtin_amdgcn_mfma_scale_f32_32x32x64_f8f6f4(kf_, qf_, acc_, 0, 0, 0, 0x7F7F7F7F, 0, 0x7F7F7F7F)
#define ATT_LDQ(dst_, off_) do { const u32x4 x0_ = *(const LAS u32x4*)(qb_ + (off_)), x1_ = *(const LAS u32x4*)(qb_ + (off_) + 16); \
      dst_[0] = (int)x0_.x; dst_[1] = (int)x0_.y; dst_[2] = (int)x0_.z; dst_[3] = (int)x0_.w; dst_[4] = (int)x1_.x; dst_[5] = (int)x1_.y; dst_[6] = (int)x1_.z; dst_[7] = (int)x1_.w; } while (0)
#define ATT_INIT2(pa_, pb_, negm_) do { u32x4 oa_, ob_; unsigned z_ = 0u; asm volatile("" : "+v"(z_)); \
      oa_.x = hi ? z_ : 0x3F80u; oa_.y = z_; oa_.z = z_; oa_.w = z_; ob_.x = hi ? z_ : (__float_as_uint(negm_) >> 16); ob_.y = z_; ob_.z = z_; ob_.w = z_; \
      const f32x16 zz_ = {}; \
      pa_ = __builtin_amdgcn_mfma_f32_32x32x16_bf16(*(const bf16x8*)&oa_, *(const bf16x8*)&ob_, zz_, 0, 0, 0); \
      pb_ = __builtin_amdgcn_mfma_f32_32x32x16_bf16(*(const bf16x8*)&oa_, *(const bf16x8*)&ob_, zz_, 0, 0, 0); } while (0)
#define ATT_QK_ALL(ia_, ib_) do { ATT_INIT2(p0, p1, ia_); ATT_INIT2(q0, q1, ib_); SBAR(); \
      ATT_SC(p0, kf0, qf); SBAR(); ATT_LDK(kf0, 32 * QK8_PITCH); SBAR(); \
      ATT_SC(p1, kf0, qf); SBAR(); ATT_LDK(kf0, 64); ATT_LDQ(qf, 64); SBAR(); \
      ATT_SC(q0, kf0, qf); SBAR(); ATT_LDK(kf0, 32 * QK8_PITCH + 64); SBAR(); \
      ATT_SC(q1, kf0, qf); SBAR(); } while (0)
  const int NT = nkeys / 64;
  GSTAGE_K(1, 0); STAGE_PAIR(0);
  asm volatile("s_waitcnt vmcnt(0)" ::: "memory"); __syncthreads();
  f32x16 p0, p1, q0, q1; i32x8 pa, pb;
  const LAS unsigned char* l3 = (const LAS unsigned char*)lds;
  const int kofs0 = 2 * ATT_SHM_V + r32 * QK8_PITCH + hi * 32;
  const int qofs0 = 2 * ATT_SHM_V + 2 * ATT_SHM_K + 2048 + (__builtin_amdgcn_readfirstlane(wid) * 32 + r32) * QK8_PITCH + hi * 32;
  { i32x8 kf0, qf; const LAS unsigned char* kb_ = l3 + (kofs0 + ATT_SHM_K); const LAS unsigned char* qb_ = l3 + qofs0;
    ATT_LDK(kf0, 0); ATT_LDQ(qf, 0);
    ATT_QK_ALL(0.f, 0.f); }
  if (grp) ATT_BAR();
#pragma unroll 1
  for (int j = 0; j < NT; ++j) {
    const int cur = j & 1;
    const bool more = (j + 1 < NT);
    if (grp && more) STAGE_PAIR(j + 1);
    { float alphaA, alphaB;
      const bool first = (j == 0);
      att_softmax(p0, p1, m0, l0, alphaA, first, pa); SBAR();
      att_softmax(q0, q1, m1, l1, alphaB, first, pb); SBAR();
      RESC(o0, alphaA);
      RESC(o1, alphaB); }
    asm volatile("" : "+v"(pa), "+v"(pb), "+v"(m0), "+v"(l0), "+v"(m1), "+v"(l1));
    asm volatile("" : "+v"(o0[0]), "+v"(o0[1]), "+v"(o0[2]), "+v"(o0[3]), "+v"(o1[0]), "+v"(o1[1]), "+v"(o1[2]), "+v"(o1[3]));
    if (!grp) asm volatile("s_waitcnt vmcnt(0)" ::: "memory");
    ATT_BAR();
    if (!grp && more) STAGE_PAIR(j + 1);
    __builtin_amdgcn_s_setprio(1);
    {
      int kofs = kofs0, qofs = qofs0; asm volatile("" : "+v"(kofs), "+v"(qofs));
      const LAS unsigned char* kb_ = l3 + (kofs + cur * ATT_SHM_K); const LAS unsigned char* qb_ = l3 + qofs;
      i32x8 kf0, qf;
      const LAS unsigned char* vrow = l3 + (r32 * 80 + hi * 32 + cur * ATT_SHM_V);
      u32x4 va0 = *(const LAS u32x4*)vrow, va1 = *(const LAS u32x4*)(vrow + 16), vb0, vb1;
#define ATT_PV(d0_, x0_, x1_) do { i32x8 bv; bv[0] = (int)x0_.x; bv[1] = (int)x0_.y; bv[2] = (int)x0_.z; bv[3] = (int)x0_.w; bv[4] = (int)x1_.x; bv[5] = (int)x1_.y; bv[6] = (int)x1_.z; bv[7] = (int)x1_.w; \
        o0[d0_] = __builtin_amdgcn_mfma_scale_f32_32x32x64_f8f6f4(pa, bv, o0[d0_], 0, 0, 0, 0x7F7F7F7F, 0, 0x7F7F7F7F); \
        o1[d0_] = __builtin_amdgcn_mfma_scale_f32_32x32x64_f8f6f4(pb, bv, o1[d0_], 0, 0, 0, 0x7F7F7F7F, 0, 0x7F7F7F7F); } while (0)
      vb0 = *(const LAS u32x4*)(vrow + 32 * 80); vb1 = *(const LAS u32x4*)(vrow + 32 * 80 + 16); ATT_PV(0, va0, va1); SBAR();
      va0 = *(const LAS u32x4*)(vrow + 64 * 80); va1 = *(const LAS u32x4*)(vrow + 64 * 80 + 16); ATT_PV(1, vb0, vb1); SBAR();
      vb0 = *(const LAS u32x4*)(vrow + 96 * 80); vb1 = *(const LAS u32x4*)(vrow + 96 * 80 + 16); ATT_PV(2, va0, va1); SBAR();
      ATT_LDK(kf0, 0); ATT_LDQ(qf, 0);
      ATT_PV(3, vb0, vb1); SBAR();
#undef ATT_PV
      asm volatile("" : "+v"(o0[0]), "+v"(o0[1]), "+v"(o0[2]), "+v"(o0[3]), "+v"(o1[0]), "+v"(o1[1]), "+v"(o1[2]), "+v"(o1[3]));
      ATT_QK_ALL(-m0, -m1);
      asm volatile("" : "+v"(p0), "+v"(p1), "+v"(q0), "+v"(q1));
    }
    __builtin_amdgcn_s_setprio(0);
    if (grp) asm volatile("s_waitcnt vmcnt(0)" ::: "memory");
    ATT_BAR();
  }
  if (!grp) ATT_BAR();
  if (hi == 0) { li_l[r32] = 1.f / l0; al_l[r32] = lam / l1; }
  asm volatile("s_waitcnt lgkmcnt(0)" ::: "memory");
  float ss[16];
#pragma unroll
  for (int r = 0; r < 16; ++r) {
    const float a = li_l[crow(r, hi)], bq = al_l[crow(r, hi)];
    float s = 0.f;
#pragma unroll
    for (int d = 0; d < 4; ++d) { const float v = o0[d][r] * a - o1[d][r] * bq; o0[d][r] = v; s += v * v; }
    s += dpp_mov<0xB1>(s); s += dpp_mov<0x4E>(s); s += dpp_mov<0x141>(s); s += dpp_mov<0x140>(s);
    { auto rr_ = __builtin_amdgcn_permlane16_swap(__float_as_uint(s), __float_as_uint(s), false, false); s = __uint_as_float(rr_[0]) + __uint_as_float(rr_[1]); }
    ss[r] = rsqrtf(s * (1.f / 128.f) + EPS) * oscale;
  }
  bf16_t* Ow = Ob + (size_t)(wid * 32) * DM;
  unsigned char* ost = lds + 2 * ATT_SHM_V + 2 * ATT_SHM_K + 2048 + wid * (32 * 272);
#pragma unroll
  for (int d = 0; d < 4; ++d) {
    const float g = ng[d * 32 + r32];
#pragma unroll
    for (int r = 0; r < 16; ++r) *(bf16_t*)(ost + crow(r, hi) * 272 + (d * 32 + r32) * 2) = (ABL & 4) ? (bf16_t)0 : (bf16_t)(cvtpk(o0[d][r] * ss[r] * g, 0.f) & 0xffffu);
  }
  asm volatile("s_waitcnt lgkmcnt(0)" ::: "memory");
#pragma unroll
  for (int i = 0; i < 8; ++i) {
    const int c = lane + 64 * i, row = c >> 4, cb = (c & 15) * 16;
    *(u32x4*)((unsigned char*)(Ow + (size_t)row * DM) + cb) = *(const u32x4*)(ost + row * 272 + cb);
  }
  __syncthreads();
#undef ATT_INIT2
#undef ATT_LDK
#undef ATT_LDQ
#undef ATT_SC
#undef ATT_QK_ALL
#undef GSTAGE_K
#undef GSTAGE_V
#undef STAGE_PAIR
#undef RESC
#undef ATT_BAR
}

__device__ __forceinline__ float ins16(float (&a)[16], float x) {
#pragma unroll
  for (int i = 0; i < 16; ++i) { const float h = fmaxf(a[i], x); x = fminf(a[i], x); a[i] = h; }
  return x;
}
__device__ __forceinline__ void bsort16(float (&a)[16]) {
#pragma unroll
  for (int k = 2; k <= 16; k <<= 1)
#pragma unroll
    for (int j = k >> 1; j > 0; j >>= 1)
#pragma unroll
      for (int i = 0; i < 16; ++i) {
        const int q = i ^ j;
        if (q > i) {
          const bool desc = ((i & k) == 0);
          const float hi_ = fmaxf(a[i], a[q]), lo_ = fminf(a[i], a[q]);
          a[i] = desc ? hi_ : lo_; a[q] = desc ? lo_ : hi_;
        }
      }
}
__device__ __forceinline__ void bmerge16(float (&a)[16], const float (&b)[16]) {
#pragma unroll
  for (int i = 0; i < 16; ++i) a[i] = fmaxf(a[i], b[15 - i]);
#pragma unroll
  for (int j = 8; j > 0; j >>= 1)
#pragma unroll
    for (int i = 0; i < 16; ++i) {
      const int q = i ^ j;
      if (q > i) { const float hi_ = fmaxf(a[i], a[q]), lo_ = fminf(a[i], a[q]); a[i] = hi_; a[q] = lo_; }
    }
}
__device__ __forceinline__ float gelu_erf(float x) { return 0.5f * x * (1.f + erff(x * 0.70710678118654752440f)); }
#define XB_TMO      128
#define XB_XCNT(j)  (256  + 64 * (j))
#define XB_XSUB(j)  (1280 + 64 * (j))
#define XB_XGEN(j)  (2304 + 64 * (j))
#define XB_TOP      3328
#define XB_TOPGEN   3392
#define XCD_BAR_WORDS 3456
#define XB_SPIN_CAP (1u << 22)
__device__ __forceinline__ unsigned xb_ld(unsigned* p)              { return __hip_atomic_load(p, __ATOMIC_RELAXED, __HIP_MEMORY_SCOPE_AGENT); }
__device__ __forceinline__ unsigned xb_add(unsigned* p, unsigned v) { return __hip_atomic_fetch_add(p, v, __ATOMIC_RELAXED, __HIP_MEMORY_SCOPE_AGENT); }
__device__ __forceinline__ unsigned xb_xcc_id() { return (unsigned)__builtin_amdgcn_s_getreg((3 << 11) | 20) & 0xFu; }
#define XB_SPIN(cond, bar) do { unsigned _sp = 0; while (cond) { __builtin_amdgcn_s_sleep(1); \
    if ((++_sp & 255u) == 0u) { if (xb_ld(&(bar)[XB_TMO])) break; if (_sp > XB_SPIN_CAP) { atomicAdd(&(bar)[XB_TMO], 1u); break; } } } } while (0)
struct XcdBarrier { unsigned* bar; unsigned x; volatile LAS unsigned* st; };
__device__ __forceinline__ XcdBarrier xcd_barrier_post(unsigned* bar, volatile LAS unsigned* st) {
  XcdBarrier b; b.bar = bar; b.x = xb_xcc_id(); b.st = st;
  if (tidx() == 0) (void)xb_add(&bar[XB_XCNT(b.x)], 1u);
  return b;
}
__device__ __forceinline__ void xcd_barrier_complete(unsigned* bar, unsigned x, unsigned& nloc, unsigned& nx) {
  const unsigned G = gridDim.x * gridDim.y * gridDim.z;
  unsigned sum, cnt, mine, sp = 0u;
  for (;;) {
    sum = 0u; cnt = 0u; mine = 0u;
#pragma unroll
    for (unsigned j = 0; j < 16; ++j) { const unsigned c = xb_ld(&bar[XB_XCNT(j)]); sum += c; cnt += (c > 0u) ? 1u : 0u; mine = (j == x) ? c : mine; }
    if (sum == G) break;
    __builtin_amdgcn_s_sleep(1);
    if ((++sp & 255u) == 0u) { if (xb_ld(&bar[XB_TMO])) break; if (sp > XB_SPIN_CAP) { atomicAdd(&bar[XB_TMO], 1u); break; } }
  }
  nloc = mine > 0u ? mine : 1u; nx = cnt > 0u ? cnt : 1u;
}
__device__ __forceinline__ void xcd_barrier(const XcdBarrier& b) {
  asm volatile("s_waitcnt vmcnt(0)" ::: "memory");
  __syncthreads();
  if (tidx() == 0) {
    unsigned* bar = b.bar;
    __builtin_amdgcn_s_waitcnt(0);
    unsigned nloc = b.st[0], nx = b.st[1];
    if (nloc == 0u) { xcd_barrier_complete(bar, b.x, nloc, nx); b.st[0] = nloc; b.st[1] = nx; }
    const unsigned old = xb_add(&bar[XB_XSUB(b.x)], 1u);
    const unsigned gen = old / nloc;
    if (old + 1u == (gen + 1u) * nloc) {
      __builtin_amdgcn_fence(__ATOMIC_RELEASE, "agent");
      asm volatile("s_waitcnt vmcnt(0)" ::: "memory");
      const unsigned og = xb_add(&bar[XB_TOP], 1u);
      const unsigned tg = og / nx;
      if (og + 1u == (tg + 1u) * nx) xb_add(&bar[XB_TOPGEN], 1u);
      else XB_SPIN(xb_ld(&bar[XB_TOPGEN]) == tg, bar);
      __builtin_amdgcn_fence(__ATOMIC_ACQUIRE, "agent");
      xb_add(&bar[XB_XGEN(b.x)], 1u);
      asm volatile("s_waitcnt vmcnt(0)" ::: "memory");
    } else {
      XB_SPIN(xb_ld(&bar[XB_XGEN(b.x)]) == gen, bar);
      __builtin_amdgcn_fence(__ATOMIC_ACQUIRE, "agent");
      asm volatile("s_waitcnt vmcnt(0)" ::: "memory");
    }
  }
  __syncthreads();
}

constexpr size_t RT_STRIDE = (size_t)T * 128 * 4;
__device__ __forceinline__ void route_unit(const Params& p, int l, int unit, unsigned char* lds) {
  int tid_ = tidx(); asm volatile("" : "+v"(tid_)); const int tid = tid_, lane = tid & 63, wid = tid >> 6, r32 = lane & 31, hi = lane >> 5;
  unsigned char* IDX = lds;
  int* UE = (int*)(lds + 8192); float* UG = (float*)(lds + 8192 + 16384); float* US = (float*)(lds + 8192 + 32768);
  int* EIDG = (int*)(p.ws + WS_EID + (size_t)l * RT_STRIDE); float* GWG = (float*)(p.ws + WS_ULOC + RT_STRIDE); float* SUG = (float*)(p.ws + WS_ULOC + 2 * RT_STRIDE);
  const float* PSC = (const float*)(p.ws + WS_PSC);
  const int row0 = unit * 32;
  const bf16_t* QP = (const bf16_t*)(p.ws + WS_PROJ);
  const bf16_t* KEYS = (const bf16_t*)(p.ws + WS_KEYS) + (size_t)l * 131072;
  for (int rrep = 0; rrep < REP_ROUTE; ++rrep) {
    const int h = wid;
    float top[2][16];
    bf16x8 bq[4], bqn[4], akc[4], akn[4];
    {
      const bf16_t* qrow0 = QP + (size_t)(row0 + r32) * DM + h * 128 + hi * 8;
      const bf16_t* kb0 = KEYS + ((size_t)(h * 2) * 128 + r32) * 64 + hi * 8;
#pragma unroll
      for (int ks = 0; ks < 4; ++ks) { bq[ks] = *(const bf16x8*)(qrow0 + ks * 16); akc[ks] = *(const bf16x8*)(kb0 + ks * 16); }
    }
#pragma unroll
    for (int pp = 0; pp < 2; ++pp) {
      const bf16_t* kb = KEYS + ((size_t)(h * 2 + pp) * 128 + r32) * 64 + hi * 8;
      float (&lst)[16] = top[pp];
#pragma unroll
      for (int i = 0; i < 16; ++i) lst[i] = -INFINITY;
#pragma unroll
      for (int nt = 0; nt < 4; ++nt) {
        if (nt < 3) {
#pragma unroll
          for (int ks = 0; ks < 4; ++ks) akn[ks] = *(const bf16x8*)(kb + (size_t)(nt + 1) * 32 * 64 + ks * 16);
        } else if (pp == 0) {
          const bf16_t* qrow1 = QP + (size_t)(row0 + r32) * DM + h * 128 + 64 + hi * 8;
          const bf16_t* kb1 = KEYS + ((size_t)(h * 2 + 1) * 128 + r32) * 64 + hi * 8;
#pragma unroll
          for (int ks = 0; ks < 4; ++ks) { bqn[ks] = *(const bf16x8*)(qrow1 + ks * 16); akn[ks] = *(const bf16x8*)(kb1 + ks * 16); }
        }
        f32x16 acc = {};
#pragma unroll
        for (int ks = 0; ks < 4; ++ks) acc = __builtin_amdgcn_mfma_f32_32x32x16_bf16(akc[ks], bq[ks], acc, 0, 0, 0);
#pragma unroll
        for (int ks = 0; ks < 4; ++ks) { akc[ks] = akn[ks]; if (nt == 3) bq[ks] = bqn[ks]; }
        float grp[16];
#pragma unroll
        for (int r = 0; r < 16; ++r) grp[r] = __uint_as_float((__float_as_uint(acc[r]) & ~0x7Fu) | (unsigned)(nt * 32 + crow(r, hi)));
        bsort16(grp);
        if (nt == 0) {
#pragma unroll
          for (int i = 0; i < 16; ++i) lst[i] = grp[i];
        } else bmerge16(lst, grp);
        SBAR();
      }
      float oth[16];
#pragma unroll
      for (int i = 0; i < 16; ++i) { auto rr_ = __builtin_amdgcn_permlane32_swap(__float_as_uint(lst[i]), __float_as_uint(lst[i]), false, false); oth[i] = __uint_as_float(hi ? rr_[0] : rr_[1]); }
      bmerge16(lst, oth);
      if (hi == 0) {
        unsigned w[4];
#pragma unroll
        for (int i = 0; i < 4; ++i)
          w[i] = (__float_as_uint(lst[4 * i]) & 0x7Fu) | ((__float_as_uint(lst[4 * i + 1]) & 0x7Fu) << 8) | ((__float_as_uint(lst[4 * i + 2]) & 0x7Fu) << 16) | ((__float_as_uint(lst[4 * i + 3]) & 0x7Fu) << 24);
        *(u32x4*)(IDX + ((r32 * 8 + h) * 2 + pp) * 16) = (u32x4){w[0], w[1], w[2], w[3]};
      }
    }
    float best[16];
#define CAND(i, j) __uint_as_float((__float_as_uint(__uint_as_float(__float_as_uint(top[0][i]) & ~0x7Fu) + __uint_as_float(__float_as_uint(top[1][j]) & ~0x7Fu)) & ~0xFFu) | (unsigned)((i) * 16 + (j)))
    {
#pragma unroll
      for (int j = 0; j < 16; ++j) best[j] = CAND(0, j);
      float y[16];
#pragma unroll
      for (int j = 0; j < 8; ++j) { y[j] = CAND(1, j); y[8 + j] = CAND(15 - j, 0); }
#pragma unroll
      for (int jj = 8; jj > 0; jj >>= 1)
#pragma unroll
        for (int i = 0; i < 16; ++i) { const int q = i ^ jj; if (q > i) { const float hi_ = fmaxf(y[i], y[q]), lo_ = fminf(y[i], y[q]); y[i] = hi_; y[q] = lo_; } }
      bmerge16(best, y);
      float x[16];
      x[0] = CAND(2, 0); x[1] = CAND(2, 1); x[2] = CAND(2, 2); x[3] = CAND(2, 3); x[4] = CAND(2, 4);
      x[5] = CAND(3, 0); x[6] = CAND(3, 1); x[7] = CAND(3, 2); x[8] = CAND(3, 3);
      x[9] = CAND(4, 0); x[10] = CAND(4, 1); x[11] = CAND(4, 2);
      x[12] = CAND(5, 0); x[13] = CAND(5, 1); x[14] = CAND(6, 0); x[15] = CAND(6, 1);
      bsort16(x);
      bmerge16(best, x);
      ins16(best, CAND(7, 0)); ins16(best, CAND(7, 1));
    }
#undef CAND
    asm volatile("s_waitcnt lgkmcnt(0)" ::: "memory");
    if (hi == 0) {
      const unsigned char* ib = IDX + ((r32 * 8 + h) * 2) * 16;
      const float mx = __uint_as_float(__float_as_uint(best[0]) & ~0xFFu);
      float w[16]; float sum = 0.f;
#pragma unroll
      for (int k = 0; k < 16; ++k) { w[k] = __expf(__uint_as_float(__float_as_uint(best[k]) & ~0xFFu) - mx); sum += w[k]; }
      const float rsum = 1.f / sum;
      int ee[16]; float su_[16], sv_[16];
#pragma unroll
      for (int k = 0; k < 16; ++k) {
        const unsigned ij = __float_as_uint(best[k]) & 0xFFu;
        ee[k] = (int)ib[ij >> 4] * 128 + (int)ib[16 + (ij & 15)];
      }
#pragma unroll
      for (int k = 0; k < 16; ++k) { su_[k] = PSC[(size_t)l * NEXP + ee[k]]; sv_[k] = PSC[(size_t)(DEPTH + l) * NEXP + ee[k]]; }
#pragma unroll
      for (int k = 0; k < 16; ++k) {
        UE[r32 * 128 + h * 16 + k] = ee[k]; UG[r32 * 128 + h * 16 + k] = w[k] * rsum * sv_[k];
        US[r32 * 128 + h * 16 + k] = su_[k];
      }
    }
  }
  __syncthreads();
#pragma unroll 1
  for (int tt = 0; tt < 4; ++tt) {
    const int t = wid * 4 + tt;
    const int k0 = UE[t * 128 + lane], k1 = UE[t * 128 + 64 + lane];
    const float g0 = UG[t * 128 + lane], g1 = UG[t * 128 + 64 + lane], s0 = US[t * 128 + lane], s1 = US[t * 128 + 64 + lane];
    const int b0 = k0 >> 11, b1 = k1 >> 11;
    int base = 0, pos0 = 0, pos1 = 0;
#pragma unroll
    for (int b = 0; b < 8; ++b) {
      const unsigned long long m0 = __ballot(b0 == b), m1 = __ballot(b1 == b);
      const int c0 = __popcll(m0), c1 = __popcll(m1);
      const unsigned long long lt = (1ull << lane) - 1ull;
      if (b0 == b) pos0 = base + __popcll(m0 & lt);
      if (b1 == b) pos1 = base + c0 + __popcll(m1 & lt);
      base += c0 + c1;
    }
    const size_t ro = (size_t)(row0 + t) * 128;
    EIDG[ro + pos0] = k0; GWG[ro + pos0] = g0; SUG[ro + pos0] = s0;
    EIDG[ro + pos1] = k1; GWG[ro + pos1] = g1; SUG[ro + pos1] = s1;
  }
}
#define CAS __attribute__((address_space(4)))
typedef int i32x8 __attribute__((ext_vector_type(8)));
struct TokPref { f32x2 gs0, gs1; u32x4 hA, hB; };
struct RowPipe { i32x6 uq[4], vq[4]; i32x8 Ec; };
struct EpiVec { f32x4 g2[4], ng[4], sc[4], sh[4]; int mr; };
__device__ __forceinline__ const CAS i32x8* eid_row(const CAS unsigned char* eidg, int row) {
  return (const CAS i32x8*)(eidg + (size_t)(unsigned)__builtin_amdgcn_readfirstlane(row) * 512u);
}
__device__ __forceinline__ void tok_prefetch(const Params& p, int row, int lane, TokPref& t) {
  const float* GWG = (const float*)(p.ws + WS_ULOC + RT_STRIDE) + (size_t)row * 128;
  const float* SUG = (const float*)(p.ws + WS_ULOC + 2 * RT_STRIDE) + (size_t)row * 128;
  const bf16_t* H = (const bf16_t*)(p.ws + WS_H);
  t.gs0 = f32x2{GWG[lane], SUG[lane]}; t.gs1 = f32x2{GWG[64 + lane], SUG[64 + lane]};
  t.hA = *(const u32x4*)(H + (size_t)row * DM + lane * 16); t.hB = *(const u32x4*)(H + (size_t)row * DM + lane * 16 + 8);
}
#define LOADPAIR(dst_, tofs_, ea_, eb_) do { const u32x3v a_ = __builtin_amdgcn_raw_buffer_load_b96(rsT, lane12, (ea_) * PROW + (tofs_), 0); const unsigned b0_ = __builtin_amdgcn_raw_buffer_load_b32(rsT, lane12, (eb_) * PROW + (tofs_), 0); \
      const u32x2v b1_ = __builtin_amdgcn_raw_buffer_load_b64(rsT, lane12 + 4, (eb_) * PROW + (tofs_), 0); \
      dst_[0] = (int)a_.x; dst_[1] = (int)a_.y; dst_[2] = (int)a_.z; dst_[3] = (int)b0_; dst_[4] = (int)b1_.x; dst_[5] = (int)b1_.y; } while (0)
#define LOADGROUP(q_, tofs_, E_) do { LOADPAIR(q_[0], tofs_, E_[0], E_[1]); LOADPAIR(q_[1], tofs_, E_[2], E_[3]); LOADPAIR(q_[2], tofs_, E_[4], E_[5]); LOADPAIR(q_[3], tofs_, E_[6], E_[7]); } while (0)
constexpr int VOFS = (int)(WS_PV - WS_PU);
__device__ __forceinline__ void gather_token(const Params& p, const CAS unsigned char* eidg, const __amdgpu_buffer_rsrc_t rsT, int l, int row, int nextrow, TokPref& tp, RowPipe& rp, EpiVec& ev, unsigned char* lds, int lane, int wid) {
  f32x2* GS = (f32x2*)(lds + wid * 2048);
  float* XC = (float*)(p.ws + WS_XCUR);
  const float* MOD = (const float*)(p.ws + WS_MOD);
  const CAS i32x8* EP = eid_row(eidg, row);
  const bool hasnext = nextrow >= 0;
  const CAS i32x8* EPn = eid_row(eidg, hasnext ? nextrow : row);
  GS[lane] = tp.gs0; GS[64 + lane] = tp.gs1;
  asm volatile("s_waitcnt lgkmcnt(0)" ::: "memory");
  const int eofl = ((lane >> 5) & 1) + 2 * ((lane >> 4) & 1) + 4 * ((lane >> 3) & 1);
  const int lane12 = lane * 12;
  {
    h16x2 hh[8];
    {
      const u32x4 hA = tp.hA, hB = tp.hB;
      hh[0] = __builtin_bit_cast(h16x2, __builtin_amdgcn_cvt_pkrtz(bflo(hA.x), bfhi(hA.x))); hh[1] = __builtin_bit_cast(h16x2, __builtin_amdgcn_cvt_pkrtz(bflo(hA.y), bfhi(hA.y))); hh[2] = __builtin_bit_cast(h16x2, __builtin_amdgcn_cvt_pkrtz(bflo(hA.z), bfhi(hA.z))); hh[3] = __builtin_bit_cast(h16x2, __builtin_amdgcn_cvt_pkrtz(bflo(hA.w), bfhi(hA.w)));
      hh[4] = __builtin_bit_cast(h16x2, __builtin_amdgcn_cvt_pkrtz(bflo(hB.x), bfhi(hB.x))); hh[5] = __builtin_bit_cast(h16x2, __builtin_amdgcn_cvt_pkrtz(bflo(hB.y), bfhi(hB.y))); hh[6] = __builtin_bit_cast(h16x2, __builtin_amdgcn_cvt_pkrtz(bflo(hB.z), bfhi(hB.z))); hh[7] = __builtin_bit_cast(h16x2, __builtin_amdgcn_cvt_pkrtz(bflo(hB.w), bfhi(hB.w)));
    }
    if (hasnext) tok_prefetch(p, nextrow, lane, tp);
    { const int mr_ = mod_row(row);
      if (mr_ != ev.mr) {
        const float* g2_ = MOD + ((size_t)l * 5 + mr_) * 6144 + 5 * 1024 + lane * 16;
        const float* ng_ = (l == DEPTH - 1 ? p.in[I_FINALG] : p.in[I_N1G] + (l + 1) * DM) + lane * 16;
        const float* m_ = MOD + ((size_t)(l == DEPTH - 1 ? l : l + 1) * 5 + mr_) * 6144 + lane * 16;
#pragma unroll
        for (int v4 = 0; v4 < 4; ++v4) { ev.g2[v4] = *(const f32x4*)(g2_ + v4 * 4); ev.ng[v4] = *(const f32x4*)(ng_ + v4 * 4); ev.sc[v4] = *(const f32x4*)(m_ + 1024 + v4 * 4); ev.sh[v4] = *(const f32x4*)(m_ + v4 * 4); }
        ev.mr = mr_;
      } }
    f32x4 xpre[4];
    { const float* xr_ = XC + (size_t)row * DM + lane * 16;
#pragma unroll
      for (int v4 = 0; v4 < 4; ++v4) xpre[v4] = *(const f32x4*)(xr_ + v4 * 4); }
    f32x2 acc2[8];
#pragma unroll
    for (int i = 0; i < 8; ++i) acc2[i] = f32x2{0.f, 0.f};
#pragma unroll 1
    for (int g8 = 0; g8 < 16; ++g8) {
      const bool pf = (g8 < 15) || hasnext;
      const f32x2 gs = GS[g8 * 8 + eofl];
      float d[8];
#pragma unroll
      for (int i2 = 0; i2 < 4; ++i2) {
        const h16x32 r = __builtin_amdgcn_cvt_scalef32_pk32_f16_fp6(rp.uq[i2], 1.0f);
        float a0 = 0.f, a1 = 0.f, b0 = 0.f, b1 = 0.f;
#define UDOT(k_) a0 = __builtin_amdgcn_fdot2(__builtin_shufflevector(r, r, 4 * (k_), 4 * (k_) + 1), hh[2 * (k_)], a0, false); b0 = __builtin_amdgcn_fdot2(__builtin_shufflevector(r, r, 16 + 4 * (k_), 17 + 4 * (k_)), hh[2 * (k_)], b0, false); \
        a1 = __builtin_amdgcn_fdot2(__builtin_shufflevector(r, r, 4 * (k_) + 2, 4 * (k_) + 3), hh[2 * (k_) + 1], a1, false); b1 = __builtin_amdgcn_fdot2(__builtin_shufflevector(r, r, 18 + 4 * (k_), 19 + 4 * (k_)), hh[2 * (k_) + 1], b1, false);
        UDOT(0) UDOT(1) UDOT(2) UDOT(3)
#undef UDOT
        d[2 * i2] = a0 + a1;
        d[2 * i2 + 1] = b0 + b1;
        asm volatile("" : "+v"(d[2 * i2]), "+v"(d[2 * i2 + 1]));
      }
      if (pf) LOADGROUP(rp.uq, 0, rp.Ec);
      float tot;
      {
        auto s01 = __builtin_amdgcn_permlane32_swap(__float_as_uint(d[0]), __float_as_uint(d[1]), false, false);
        auto s23 = __builtin_amdgcn_permlane32_swap(__float_as_uint(d[2]), __float_as_uint(d[3]), false, false);
        auto s45 = __builtin_amdgcn_permlane32_swap(__float_as_uint(d[4]), __float_as_uint(d[5]), false, false);
        auto s67 = __builtin_amdgcn_permlane32_swap(__float_as_uint(d[6]), __float_as_uint(d[7]), false, false);
        const float q01 = __uint_as_float(s01[0]) + __uint_as_float(s01[1]), q23 = __uint_as_float(s23[0]) + __uint_as_float(s23[1]);
        const float q45 = __uint_as_float(s45[0]) + __uint_as_float(s45[1]), q67 = __uint_as_float(s67[0]) + __uint_as_float(s67[1]);
        auto ta = __builtin_amdgcn_permlane16_swap(__float_as_uint(q01), __float_as_uint(q23), false, false);
        auto tb = __builtin_amdgcn_permlane16_swap(__float_as_uint(q45), __float_as_uint(q67), false, false);
        const float r0123 = __uint_as_float(ta[0]) + __uint_as_float(ta[1]);
        const float r4567 = __uint_as_float(tb[0]) + __uint_as_float(tb[1]);
        const bool b3 = (lane & 8) != 0;
        const float keep = b3 ? r4567 : r0123, send = b3 ? r0123 : r4567;
        float x = keep + dpp_mov<0x140>(send);
        x += dpp_mov<0xB1>(x); x += dpp_mov<0x4E>(x); x += dpp_mov<0x141>(x);
        tot = x * gs.y;
      }
      float ge;
      {
        const float v = tot, av = fabsf(v), tq = __builtin_amdgcn_rcpf(av * 0.2316418882f + 1.0f);
        float q = tq * 0.5307027145f + (-0.7265760135f); q = q * tq + 0.7107068705f; q = q * tq + (-0.142248368f); q = q * tq + 0.127414796f; q = q * tq;
        const float ex = __builtin_amdgcn_exp2f(v * v * (-0.72134752044f));
        const float m = v * (q * ex), r = v - m;
        ge = (v < 0.f ? m : r) * gs.x;
      }
      unsigned cw[8];
      { const unsigned gp = __builtin_bit_cast(unsigned, __builtin_amdgcn_cvt_pkrtz(ge * 1024.f, ge * 1024.f));
        cw[0] = (unsigned)__builtin_amdgcn_readlane((int)gp, 0);  cw[4] = (unsigned)__builtin_amdgcn_readlane((int)gp, 8);
        cw[2] = (unsigned)__builtin_amdgcn_readlane((int)gp, 16); cw[6] = (unsigned)__builtin_amdgcn_readlane((int)gp, 24);
        cw[1] = (unsigned)__builtin_amdgcn_readlane((int)gp, 32); cw[5] = (unsigned)__builtin_amdgcn_readlane((int)gp, 40);
        cw[3] = (unsigned)__builtin_amdgcn_readlane((int)gp, 48); cw[7] = (unsigned)__builtin_amdgcn_readlane((int)gp, 56); }
      h16x2 a16[8];
#pragma unroll
      for (int i2 = 0; i2 < 4; ++i2) {
        const h16x32 r = __builtin_amdgcn_cvt_scalef32_pk32_f16_fp6(rp.vq[i2], 1.0f);
        const h16x2 ca = __builtin_bit_cast(h16x2, cw[2 * i2]), cb = __builtin_bit_cast(h16x2, cw[2 * i2 + 1]);
#define VAXL(k_) a16[k_] = (i2 == 0) ? ca * __builtin_shufflevector(r, r, 2 * (k_), 2 * (k_) + 1) : ca * __builtin_shufflevector(r, r, 2 * (k_), 2 * (k_) + 1) + a16[k_];
#define VAXH(k_) a16[k_] = cb * __builtin_shufflevector(r, r, 16 + 2 * (k_), 17 + 2 * (k_)) + a16[k_];
        VAXL(0) VAXL(1) VAXL(2) VAXL(3) VAXL(4) VAXL(5) VAXL(6) VAXL(7)
        asm volatile("" : "+v"(a16[0]), "+v"(a16[1]), "+v"(a16[2]), "+v"(a16[3]), "+v"(a16[4]), "+v"(a16[5]), "+v"(a16[6]), "+v"(a16[7]));
        VAXH(0) VAXH(1) VAXH(2) VAXH(3) VAXH(4) VAXH(5) VAXH(6) VAXH(7)
#undef VAXL
#undef VAXH
        asm volatile("" : "+v"(a16[0]), "+v"(a16[1]), "+v"(a16[2]), "+v"(a16[3]), "+v"(a16[4]), "+v"(a16[5]), "+v"(a16[6]), "+v"(a16[7]));
      }
#pragma unroll
      for (int k = 0; k < 8; ++k) acc2[k] = f32x2{(float)a16[k].x, (float)a16[k].y} * f32x2{1.f / 1024.f, 1.f / 1024.f} + acc2[k];
      if (pf) LOADGROUP(rp.vq, VOFS, rp.Ec);
      { const CAS i32x8* src_ = g8 < 14 ? EP + (g8 + 2) : EPn + (g8 - 14); rp.Ec = *src_; }
    }
    SBAR();
    float acc[16];
#pragma unroll
    for (int i = 0; i < 8; ++i) { acc[2 * i] = acc2[i].x; acc[2 * i + 1] = acc2[i].y; }
    float* xr = XC + (size_t)row * DM;
    float xn[16]; float ssq = 0.f;
    if (ABL & 8) {
#pragma unroll
      for (int i = 0; i < 16; ++i) acc[i] = 0.f;
    }
#pragma unroll
    for (int v4 = 0; v4 < 4; ++v4) {
      const int c = lane * 16 + v4 * 4;
      const f32x4 xo = xpre[v4], gg = ev.g2[v4];
      f32x4 o;
      o.x = xo.x + gg.x * acc[v4 * 4 + 0]; o.y = xo.y + gg.y * acc[v4 * 4 + 1]; o.z = xo.z + gg.z * acc[v4 * 4 + 2]; o.w = xo.w + gg.w * acc[v4 * 4 + 3];
      xn[v4 * 4 + 0] = o.x; xn[v4 * 4 + 1] = o.y; xn[v4 * 4 + 2] = o.z; xn[v4 * 4 + 3] = o.w;
      ssq += (o.x * o.x + o.y * o.y) + (o.z * o.z + o.w * o.w);
      if (l < DEPTH - 1) *(f32x4*)(xr + c) = o;
    }
    const float rs = rsqrtf(wave_sum_fast(ssq) * (1.f / DM) + EPS);
    if (l == DEPTH - 1) {
      const int b = row / SEGL, s = row - b * SEGL;
      float* orow = p.out + ((size_t)(b * SEQ + (s - CTXL))) * DM;
#pragma unroll
      for (int v4 = 0; v4 < 4; ++v4) {
        const int c = lane * 16 + v4 * 4;
        const f32x4 gg = ev.ng[v4];
        f32x4 o; o.x = xn[v4 * 4 + 0] * rs * gg.x; o.y = xn[v4 * 4 + 1] * rs * gg.y; o.z = xn[v4 * 4 + 2] * rs * gg.z; o.w = xn[v4 * 4 + 3] * rs * gg.w;
        *(f32x4*)(orow + c) = o;
      }
    } else {
      bf16_t* hrow = (bf16_t*)(p.ws + WS_H) + (size_t)row * DM;
#pragma unroll
      for (int hh = 0; hh < 2; ++hh) {
        float y[8];
#pragma unroll
        for (int i = 0; i < 8; ++i) { const int q_ = hh * 2 + (i >> 2), e_ = i & 3; y[i] = xn[hh * 8 + i] * rs * ev.ng[q_][e_] * (1.f + ev.sc[q_][e_]) + ev.sh[q_][e_]; }
        u32x4 w; w.x = cvtpk(y[0], y[1]); w.y = cvtpk(y[2], y[3]); w.z = cvtpk(y[4], y[5]); w.w = cvtpk(y[6], y[7]);
        *(u32x4*)(hrow + lane * 16 + hh * 8) = w;
        int w0 = 0, w1 = 0;
        w0 = __builtin_amdgcn_cvt_pk_fp8_f32(y[0], y[1], w0, false); w0 = __builtin_amdgcn_cvt_pk_fp8_f32(y[2], y[3], w0, true);
        w1 = __builtin_amdgcn_cvt_pk_fp8_f32(y[4], y[5], w1, false); w1 = __builtin_amdgcn_cvt_pk_fp8_f32(y[6], y[7], w1, true);
        *(u32x2*)(p.ws + WS_H8 + (size_t)row * DM + lane * 16 + hh * 8) = (u32x2){(unsigned)w0, (unsigned)w1};
      }
    }
  }
}

__device__ __forceinline__ void ev_signal(unsigned* ctr) {
  asm volatile("s_waitcnt vmcnt(0)" ::: "memory");
  __syncthreads();
  if (tidx() == 0) { __builtin_amdgcn_fence(__ATOMIC_RELEASE, "agent"); asm volatile("s_waitcnt vmcnt(0)" ::: "memory"); (void)xb_add(ctr, 1u); }
}
__device__ __forceinline__ void ev_wait(unsigned* ctr, unsigned n, unsigned* bar) {
  if (tidx() == 0) {
    XB_SPIN(xb_ld(ctr) < n, bar);
    __builtin_amdgcn_fence(__ATOMIC_ACQUIRE, "agent");
    asm volatile("s_waitcnt vmcnt(0)" ::: "memory");
  }
  __syncthreads();
}
constexpr int EV_WORD0 = 8192;
__device__ __forceinline__ void phase_c1(const Params& p, int l, unsigned char* lds) {
  constexpr int NLOC = NBATCH * 4 * NCH, NCONV = T / 32;
  for (int u = p.bx; u < NLOC + NCONV; u += p.gx) {
    if (u < NLOC) ml_local_unit2(p, l, u, lds);
    else {
      const int cu = u - NLOC;
      if (l == DEPTH - 1 && (cu % (SEGL / 32)) < (CTXL / 32)) continue;
      conv_unit(p, l, cu, lds);
    }
  }
}
__device__ __forceinline__ void phase_c3(const Params& p, int l, unsigned char* lds);
__device__ __forceinline__ void phase_c2(const Params& p, int l, unsigned char* lds) {
  unsigned* ev = (unsigned*)(p.ws + WS_CTL) + EV_WORD0 + 64 * l;
  ml_scan(p, lds);
  ev_signal(ev);
  const float* lp = p.in[I_DLAM] + l * 256;
  float s01 = 0.f, s23 = 0.f;
  for (int i = 0; i < 64; ++i) { s01 += lp[i] * lp[64 + i]; s23 += lp[128 + i] * lp[192 + i]; }
  const float lam_init = 0.8f - 0.6f * expf(-0.3f * (float)l);
  const float lam = __uint_as_float((unsigned)__builtin_amdgcn_readfirstlane((int)__float_as_uint(expf(s01) - expf(s23) + lam_init)));
  const bf16_t* PROJ = (const bf16_t*)(p.ws + WS_PROJ);
  bf16_t* MIX = (bf16_t*)(p.ws + WS_MIX);
  const float* ng = p.in[I_DNORMG] + l * 128;
  const int nun = 512 + (l < DEPTH - 1 ? 16 : 0);
  for (int u = p.bx; u < nun; u += p.gx) {
    int bh, qrow, nkeys;
    if (u < 512) { const int xcd = u & 7, i = (u >> 3) & 31, rnd = u >> 8; bh = 2 * xcd + rnd; qrow = CTXL + i * 256; nkeys = SEGL; }
    else { bh = u - 512; qrow = 0; nkeys = CTXL; }
    const int b = bh >> 2, h = bh & 3;
    const size_t tok0 = (size_t)b * SEGL;
    for (int rep = 0; rep < REP_ATT; ++rep)
    att_unit(p.ws + WS_QK8 + ((size_t)bh * SEGL + qrow) * QK8_PITCH, p.ws + WS_QK8 + QK8_IMG + (size_t)bh * SEGL * QK8_PITCH, p.ws + WS_V8T + (size_t)bh * NCH * ATT_SHM_V,
             MIX + (tok0 + qrow) * DM + 512 + h * 128, nkeys, lam, ng, 1.f - lam_init, lds);
  }
  ev_wait(ev, (unsigned)p.gx, p.xbar_words);
  for (int rep = 0; rep < REP_ML; ++rep) phase_c3(p, l, lds);
}
__device__ __forceinline__ void phase_c3(const Params& p, int l, unsigned char* lds) {
  constexpr int NU = NBATCH * 4 * NCH;
  const int nlow = (p.gx > 64 && l < DEPTH - 1) ? 16 : 0, ulow = nlow * 7;
  int u, step;
  if (p.bx < nlow) { u = p.bx; step = nlow; } else { u = ulow + (p.bx - nlow); step = p.gx - nlow; }
  const int uend = p.bx < nlow ? ulow : NU;
  int tid_ = tidx(); asm volatile("" : "+v"(tid_));
  auto valid_from = [&](int v) { while (v < uend && l == DEPTH - 1 && (v % NCH) < 4) v += step; return v < uend ? v : -1; };
  MlOutPf fa, fb;
  u = valid_from(u);
  if (u >= 0) ml_out_fetch(p, u, tid_, fa);
  while (u >= 0) {
    const int nx = valid_from(u + step);
    ml_out_unit2(p, l, u, lds, fa, nx, fb);
    fa = fb; u = nx;
  }
}
__device__ __forceinline__ void phase_route(const Params& p, int l, unsigned char* lds) {
  constexpr int NU = T / 32;
  for (int u = p.bx; u < NU; u += p.gx) {
    if (l == DEPTH - 1 && (u % (SEGL / 32)) < (CTXL / 32)) continue;
    route_unit(p, l, u, lds);
    __syncthreads();
  }
}
__device__ __forceinline__ void phase_gather(const Params& p, int l, unsigned char* lds) {
  int tid_ = tidx(); asm volatile("" : "+v"(tid_)); const int lane = tid_ & 63, wid = __builtin_amdgcn_readfirstlane(tid_ >> 6);
  const int gw = p.bx * 8 + wid, NGW = p.gx * 8;
  const int ntok = (l == DEPTH - 1) ? NBATCH * SEQ : T;
#define TOKROW(ti_) ((l == DEPTH - 1) ? ((ti_) / SEQ) * SEGL + CTXL + ((ti_) % SEQ) : (ti_))
  const CAS unsigned char* eidg = (const CAS unsigned char*)(p.ws + WS_EID + (size_t)l * RT_STRIDE);
  const __amdgpu_buffer_rsrc_t rsT = __builtin_amdgcn_make_buffer_rsrc((void*)(p.ws + WS_PU + (size_t)l * NEXP * PROW), 0, VOFS + NEXP * PROW, 0x00020000);
  const int nfull = ntok / NGW, rem = ntok - nfull * NGW, per = (rem % p.gx == 0) ? rem / p.gx : -1;
  auto tok_at = [&](int r) -> int {
    if (r < nfull) return gw + r * NGW;
    if (r > nfull || rem == 0) return -1;
    if (per >= 0) return wid < per ? nfull * NGW + p.bx * per + wid : -1;
    return gw + r * NGW < ntok ? gw + r * NGW : -1;
  };
  TokPref tp; RowPipe rp; EpiVec ev; ev.mr = -1;
  const int ti0 = tok_at(0);
  if (ti0 >= 0) {
    const int row0 = TOKROW(ti0); const int lane12 = lane * 12;
    tok_prefetch(p, row0, lane, tp);
    const CAS i32x8* EP0 = eid_row(eidg, row0);
    rp.Ec = EP0[0];
    LOADGROUP(rp.uq, 0, rp.Ec); LOADGROUP(rp.vq, VOFS, rp.Ec);
    rp.Ec = EP0[1];
  }
  XcdBarrier xb; xb.bar = p.xbar_words; xb.x = p.xbar_x; xb.st = (volatile LAS unsigned*)((LAS unsigned char*)lds + p.lds_st_off);
  const int nrounds = (ntok + NGW - 1) / NGW;
  for (int r = 0; r < nrounds; ++r) {
    const int ti = tok_at(r);
    if (ti >= 0) {
      const int row = TOKROW(ti);
      const int tn = tok_at(r + 1);
      const int nxt = tn >= 0 ? TOKROW(tn) : -1;
      gather_token(p, eidg, rsT, l, row, nxt, tp, rp, ev, lds, lane, wid);
    }
#if GATHER_SYNC
    if (r + 1 < nrounds) { XcdBarrier xb2 = xb; size_t zb_ = 0; asm volatile("" : "+s"(zb_)); xb2.bar = xb.bar + zb_; xb2.x = xb.x + (unsigned)zb_; xcd_barrier(xb2); }
#endif
  }
#undef TOKROW
}

__global__ void __launch_bounds__(512, 2) mk_fwd(KArgs ka) {
  cg::grid_group grid = cg::this_grid();
  extern __shared__ __attribute__((aligned(16))) unsigned char lds[];
  const int lo = ka.ph_lo, hi = ka.ph_hi;
#define IN(k) (lo <= (k) && (k) < hi)
#ifndef PHASEMASK
#define PHASEMASK 0xFFFF
#endif
#define PH(i) ((PHASEMASK >> (i)) & 1)
#define MKP(q) Params q; { size_t z_ = 0; asm volatile("" : "+s"(z_)); \
    q.in = (InTab)((const __attribute__((address_space(4))) char*)__builtin_amdgcn_kernarg_segment_ptr() + z_); \
    q.out = ka.out + z_; q.ws = ka.ws + z_; q.ph_lo = lo; q.ph_hi = hi; q.bx = (int)blockIdx.x + (int)z_; q.gx = (int)gridDim.x + (int)z_; q.xbar_words = xbar.bar + z_; q.xbar_x = xbar.x + (unsigned)z_; q.lds_st_off = (unsigned)(LDS_BYTES - 64); }
#define SEAM(k) do { if (IN(k) && IN((k) + 1)) { if ((k) == 0) grid.sync(); else { XcdBarrier xb_ = xbar; size_t zb_ = 0; asm volatile("" : "+s"(zb_)); xb_.bar = xbar.bar + zb_; xb_.x = xbar.x + (unsigned)zb_; xcd_barrier(xb_); } } } while (0)
  volatile LAS unsigned* xst = (volatile LAS unsigned*)((LAS unsigned char*)lds + (LDS_BYTES - 64));
  { const int t0_ = threadIdx.x;
    if (t0_ < 2) xst[t0_] = 0u;
    if ((t0_ & 63) == 0) *(volatile LAS int*)((LAS unsigned char*)lds + LDS_WTAB + 4 * hw_wave_key()) = t0_ >> 6; }
  __syncthreads();
  XcdBarrier xbar = xcd_barrier_post((unsigned*)(ka.ws + WS_CTL) + 4096, xst);
  { MKP(p)
    if (PH(0) && IN(0)) for (int rep = 0; rep < REP_MISC; ++rep) { p0_mod(p, lds, (float*)(p.ws + WS_MOD)); p0_convert(p, lds); }
  }
  SEAM(0);
  { MKP(p)
    if (PH(1) && IN(1)) phase_norm(p, 0, 0, true, false);
  }
  SEAM(1);
#define LAYER(LL) { \
    int l = (LL); asm volatile("" : "+s"(l)); \
    const int b = 2 + 9 * (LL); \
    { MKP(q) if (PH(2) && IN(b + 0)) for (int rep = 0; rep < REP_GEMM; ++rep) phase_inproj2(q, l, lds); } \
    SEAM(b + 0); \
    { MKP(q) if (PH(3) && IN(b + 1)) for (int rep = 0; rep < REP_ML; ++rep) phase_c1(q, l, lds); } \
    SEAM(b + 1); \
    { MKP(q) if (PH(4) && IN(b + 2)) phase_c2(q, l, lds); } \
    SEAM(b + 3); \
    { MKP(q) if (PH(6) && IN(b + 4)) phase_outproj2(q, l, lds); } \
    SEAM(b + 4); \
    { MKP(q) if (PH(7) && IN(b + 5)) for (int rep = 0; rep < REP_MISC; ++rep) phase_norm(q, l, 1, false, (LL) == DEPTH - 1); } \
    SEAM(b + 5); \
    { MKP(q) if (PH(8) && IN(b + 6)) for (int rep = 0; rep < REP_GEMM; ++rep) phase_peerq2(q, l, lds); } \
    SEAM(b + 6); \
    { MKP(q) if (PH(9) && IN(b + 7)) phase_route(q, l, lds); } \
    SEAM(b + 7); \
    { MKP(q) if (PH(9) && IN(b + 8)) phase_gather(q, l, lds); } \
    SEAM(b + 8); }
  LAYER(0) LAYER(1) LAYER(2) LAYER(3)
#undef LAYER
#undef IN
#undef SEAM
#undef MKP
}

extern "C" void kernel_launch(void* const* d_in, const int* in_sizes, int n_in, void* d_out, int out_size,
                              void* d_ws, size_t ws_size, hipStream_t stream) {
  static int grid = 0;
  if (grid == 0) {
    int dev = 0, cus = 0, per_cu = 0;
    (void)hipGetDevice(&dev);
    (void)hipDeviceGetAttribute(&cus, hipDeviceAttributeMultiprocessorCount, dev);
    (void)hipFuncSetAttribute((const void*)mk_fwd, hipFuncAttributeMaxDynamicSharedMemorySize, LDS_BYTES);
    (void)hipOccupancyMaxActiveBlocksPerMultiprocessor(&per_cu, (const void*)mk_fwd, 512, LDS_BYTES);
    fprintf(stderr, "kernel_launch: cus %d per_cu %d ws %zu (need %zu) n_in %d\n", cus, per_cu, ws_size, (size_t)WS_END, n_in);
    if (ws_size < WS_END || n_in != 23 || per_cu < 1) { fprintf(stderr, "kernel_launch: bad configuration, nothing launched\n"); grid = -1; return; }
    grid = cus;
  }
  if (grid < 0) return;
  (void)hipMemsetAsync((char*)d_ws + WS_CTL, 0, 65536, stream);
  KArgs p{};
  for (int i = 0; i < 23; ++i) p.in[i] = (const float*)d_in[i];
  p.out = (float*)d_out; p.ws = (unsigned char*)d_ws; p.ph_lo = 0; p.ph_hi = 38;
  void* args[] = {&p};
  hipError_t e = hipLaunchCooperativeKernel((const void*)mk_fwd, dim3(grid), dim3(512), args, LDS_BYTES, stream);
  if (e != hipSuccess) fprintf(stderr, "cooperative launch failed: %s (grid %d)\n", hipGetErrorString(e), grid);
}
```

```cpp
#include <hip/hip_runtime.h>
#include <hip/hip_cooperative_groups.h>
#include <cstdio>
#include <cstdint>
namespace cg = cooperative_groups;

constexpr int DM = 1024, NBATCH = 4, SEQ = 8192, CTXL = 256, SEGL = CTXL + SEQ, T = NBATCH * SEGL, DEPTH = 4;
constexpr int IN_W = 3088, PW = 3072;
constexpr int QK8_PITCH = 144; constexpr size_t QK8_IMG = (size_t)16 * SEGL * QK8_PITCH;
constexpr int C_A = 0, C_MQ = 512, C_MK = 768, C_MV = 1024, C_MO = 1280, C_DQ = 1536, C_DK = 2048, C_DV = 2560;
constexpr int NCH = SEGL / 64;
constexpr int NEXP = 16384;
constexpr float EPS = 1e-6f;
#ifndef ABL
#define ABL 0
#endif
#ifndef GATHER_SYNC
#define GATHER_SYNC 0
#endif
#ifndef REP_ATT
#define REP_ATT 1
#endif
#ifndef GP_MASK
#define GP_MASK 0x3FFF
#endif
#ifndef REP_PEER
#define REP_PEER 1
#endif
#ifndef REP_GEMM
#define REP_GEMM 1
#endif
#ifndef REP_ROUTE
#define REP_ROUTE 1
#endif
#ifndef REP_OUTP
#define REP_OUTP 1
#endif
#ifndef REP_ML
#define REP_ML 1
#endif
#ifndef REP_MISC
#define REP_MISC 1
#endif
constexpr float QSCALE = 0.125f * 1.4426950408889634f;

constexpr size_t MiB = 1u << 20;
constexpr size_t WS_CTL = 0, WS_MOD = 1 * MiB, WS_ROPE = 2 * MiB, WS_WG = 4 * MiB, WS_KEYS = 5 * MiB, WS_MLMETA = 6 * MiB,
                 WS_GATES = 7 * MiB, WS_WIN = 10 * MiB, WS_WOUT = 34 * MiB, WS_WQ = 42 * MiB, WS_PU = 50 * MiB, WS_PV = 114 * MiB, WS_PSC = 178 * MiB  , WS_H8 = 180 * MiB  , WS_W8 = 216 * MiB  ,
                 WS_XCUR = 306 * MiB, WS_H = 438 * MiB, WS_MIX = 504 * MiB, WS_PROJ = 570 * MiB, WS_ULOC = 768 * MiB, WS_V8T = 836 * MiB  , WS_EID = 858 * MiB  , WS_QK8 = 924 * MiB  , WS_END = 964 * MiB;
constexpr int USTRIDE = 4160;

constexpr int LDS_BYTES = 139264 + 512;
constexpr int LDS_WTAB = LDS_BYTES - 64 - 256;

#define LAS __attribute__((address_space(3)))
__device__ __forceinline__ int hw_wave_key() { return (int)(__builtin_amdgcn_s_getreg((5 << 11) | 4) & 63u); }
__device__ __forceinline__ int tidx() {
  extern __shared__ __attribute__((aligned(16))) unsigned char lds_dyn_[];
  const int w = __builtin_amdgcn_readfirstlane(*(const volatile LAS int*)((LAS unsigned char*)lds_dyn_ + LDS_WTAB + 4 * hw_wave_key()));
  unsigned z_ = 0u; asm volatile("" : "+v"(z_));
  return (w << 6) | (int)__builtin_amdgcn_mbcnt_hi(~0u, __builtin_amdgcn_mbcnt_lo(~0u, z_));
}
typedef unsigned short bf16_t;
typedef short bf16x8 __attribute__((ext_vector_type(8)));
typedef short s16x4 __attribute__((ext_vector_type(4)));
typedef float f32x4 __attribute__((ext_vector_type(4)));
typedef float f32x16 __attribute__((ext_vector_type(16)));
typedef unsigned u32x4 __attribute__((ext_vector_type(4)));
typedef unsigned u32x2 __attribute__((ext_vector_type(2)));
typedef __bf16 bf16x2v __attribute__((ext_vector_type(2)));
typedef int i32x8 __attribute__((ext_vector_type(8)));
typedef int i32x6 __attribute__((ext_vector_type(6)));
struct __attribute__((aligned(4))) u32x3 { unsigned x, y, z; };
typedef float f32x32 __attribute__((ext_vector_type(32)));
constexpr int PROW = 768;
typedef float f32x2 __attribute__((ext_vector_type(2)));
typedef _Float16 h16x2 __attribute__((ext_vector_type(2)));
typedef _Float16 h16x32 __attribute__((ext_vector_type(32)));
typedef unsigned u32x3v __attribute__((ext_vector_type(3)));
typedef unsigned u32x2v __attribute__((ext_vector_type(2)));

struct KArgs {
  const float* in[23];
  float* out;
  unsigned char* ws;
  int ph_lo, ph_hi;
};
typedef const float* const __attribute__((address_space(4))) * InTab;
struct Params {
  InTab in;
  float* out;
  unsigned char* ws;
  int ph_lo, ph_hi;
  int bx, gx;
  unsigned* xbar_words; unsigned xbar_x; unsigned lds_st_off;
};
enum { I_X = 0, I_C, I_CTX, I_CCTX, I_ADAW, I_ADAB, I_N1G, I_N2G, I_WIN, I_CONVW, I_CONVB, I_CLNG, I_CLNB, I_GATEB, I_MNORMG, I_DLAM, I_DNORMG,
       I_WOUT, I_PWQ, I_PKEYS, I_PU, I_PV, I_FINALG };

__device__ __forceinline__ unsigned cvtpk(float lo, float hi) { unsigned r; asm volatile("v_cvt_pk_bf16_f32 %0, %1, %2" : "=v"(r) : "v"(lo), "v"(hi)); return r; }
__device__ __forceinline__ float bflo(unsigned u) { return __uint_as_float(u << 16); }
__device__ __forceinline__ float bfhi(unsigned u) { return __uint_as_float(u & 0xffff0000u); }
__device__ __forceinline__ float bf1(bf16_t u) { return __uint_as_float(((unsigned)u) << 16); }
__device__ __forceinline__ int crow(int r, int hi) { return (r & 3) + 8 * (r >> 2) + 4 * hi; }
template <int CTRL> __device__ __forceinline__ float dpp_mov(float v) {
  return __uint_as_float((unsigned)__builtin_amdgcn_update_dpp(0, (int)__float_as_uint(v), CTRL, 0xF, 0xF, true));
}
__device__ __forceinline__ float wave_sum_fast(float x) {
  x += dpp_mov<0xB1>(x); x += dpp_mov<0x4E>(x); x += dpp_mov<0x141>(x); x += dpp_mov<0x140>(x);
  { auto r = __builtin_amdgcn_permlane16_swap(__float_as_uint(x), __float_as_uint(x), false, false); x = __uint_as_float(r[0]) + __uint_as_float(r[1]); }
  { auto r = __builtin_amdgcn_permlane32_swap(__float_as_uint(x), __float_as_uint(x), false, false); x = __uint_as_float(r[0]) + __uint_as_float(r[1]); }
  return x;
}
__device__ __forceinline__ float wave_max_fast(float x) {
  x = fmaxf(x, dpp_mov<0xB1>(x)); x = fmaxf(x, dpp_mov<0x4E>(x)); x = fmaxf(x, dpp_mov<0x141>(x)); x = fmaxf(x, dpp_mov<0x140>(x));
  { auto r = __builtin_amdgcn_permlane16_swap(__float_as_uint(x), __float_as_uint(x), false, false); x = fmaxf(__uint_as_float(r[0]), __uint_as_float(r[1])); }
  { auto r = __builtin_amdgcn_permlane32_swap(__float_as_uint(x), __float_as_uint(x), false, false); x = fmaxf(__uint_as_float(r[0]), __uint_as_float(r[1])); }
  return x;
}
template <int CTRL, int ROWMASK> __device__ __forceinline__ float dpp_mov_rm(float v) {
  return __uint_as_float((unsigned)__builtin_amdgcn_update_dpp(0, (int)__float_as_uint(v), CTRL, ROWMASK, 0xF, true));
}
__device__ __forceinline__ float wave_incl_scan(float x) {
  x += dpp_mov<0x111>(x); x += dpp_mov<0x112>(x); x += dpp_mov<0x114>(x); x += dpp_mov<0x118>(x);
  x += dpp_mov_rm<0x142, 0xA>(x);
  x += dpp_mov_rm<0x143, 0xC>(x);
  return x;
}
__device__ __forceinline__ float wave_sum(float v) { return wave_sum_fast(v); }
__device__ __forceinline__ float sum_xor32(float x) { auto r = __builtin_amdgcn_permlane32_swap(__float_as_uint(x), __float_as_uint(x), false, false); return __uint_as_float(r[0]) + __uint_as_float(r[1]); }
__device__ __forceinline__ float max_xor32(float x) { auto r = __builtin_amdgcn_permlane32_swap(__float_as_uint(x), __float_as_uint(x), false, false); return fmaxf(__uint_as_float(r[0]), __uint_as_float(r[1])); }
__device__ __forceinline__ float wave_max(float v) { return wave_max_fast(v); }
__device__ __forceinline__ float sigmoidf_(float x) { return 1.f / (1.f + __expf(-x)); }
__device__ __forceinline__ float logsigmoidf_(float x) { return fminf(x, 0.f) - log1pf(__expf(-fabsf(x))); }
__device__ __forceinline__ const float* in_row(const float* x, const float* ctx, int row) {
  const int b = row / SEGL, s = row - b * SEGL;
  return s < CTXL ? ctx + ((size_t)(b * CTXL + s)) * DM : x + ((size_t)(b * SEQ + (s - CTXL))) * DM;
}
__device__ __forceinline__ int mod_row(int row) { const int b = row / SEGL, s = row - b * SEGL; return s < CTXL ? 4 : b; }

__device__ __forceinline__ void p0_mod(const Params& p, unsigned char* lds, float* MOD) {
  float* sil = (float*)lds;
  float* red = (float*)(lds + 20480);
  int tid_ = tidx(); asm volatile("" : "+v"(tid_)); const int tid = tid_, lane = tid & 63, wid = tid >> 6;
  for (int i = tid; i < 5 * 1024; i += 512) {
    const float v = i < 4096 ? p.in[I_C][i] : p.in[I_CCTX][i - 4096];
    sil[i] = v / (1.f + __expf(-v));
  }
  __syncthreads();
  for (int item = p.bx; item < DEPTH * 96; item += p.gx) {
    const int l = item / 96, j0 = (item % 96) * 64;
    const float* W = p.in[I_ADAW] + (size_t)l * DM * 6144 + j0 + lane;
    float a0 = 0.f, a1 = 0.f, a2 = 0.f, a3 = 0.f, a4 = 0.f;
    const int k0 = wid * 128;
#pragma unroll 8
    for (int k = k0; k < k0 + 128; ++k) {
      const float w = W[(size_t)k * 6144];
      a0 += sil[k] * w; a1 += sil[1024 + k] * w; a2 += sil[2048 + k] * w; a3 += sil[3072 + k] * w; a4 += sil[4096 + k] * w;
    }
    red[(wid * 5 + 0) * 64 + lane] = a0; red[(wid * 5 + 1) * 64 + lane] = a1; red[(wid * 5 + 2) * 64 + lane] = a2;
    red[(wid * 5 + 3) * 64 + lane] = a3; red[(wid * 5 + 4) * 64 + lane] = a4;
    __syncthreads();
    if (tid < 320) {
      const int r = tid >> 6;
      float s = 0.f;
#pragma unroll
      for (int w = 0; w < 8; ++w) s += red[(w * 5 + r) * 64 + lane];
      MOD[((size_t)l * 5 + r) * 6144 + j0 + lane] = s + p.in[I_ADAB][l * 6144 + j0 + lane];
    }
    __syncthreads();
  }
}
__device__ __forceinline__ void transpose_item(const float* W, int ldw, int srccol0, bf16_t* WT, int K, int n0, int k0, float* scr, int lane, unsigned char* W8 = nullptr) {
#pragma unroll 8
  for (int i = 0; i < 32; ++i) { const int kk = 2 * i + (lane >> 5); scr[kk * 33 + (lane & 31)] = W[(size_t)(k0 + kk) * ldw + srccol0 + (lane & 31)]; }
  asm volatile("s_waitcnt lgkmcnt(0)" ::: "memory");
  const int c = lane & 7;
#pragma unroll
  for (int j = 0; j < 4; ++j) {
    const int n = (lane >> 3) + 8 * j; const float* s = scr + (8 * c) * 33 + n;
    u32x4 o; o.x = cvtpk(s[0], s[33]); o.y = cvtpk(s[66], s[99]); o.z = cvtpk(s[132], s[165]); o.w = cvtpk(s[198], s[231]);
    *(u32x4*)(WT + (size_t)(n0 + n) * K + k0 + 8 * c) = o;
    if (W8) {
      int w0 = 0, w1 = 0;
      w0 = __builtin_amdgcn_cvt_pk_fp8_f32(s[0] * 32.f, s[33] * 32.f, w0, false); w0 = __builtin_amdgcn_cvt_pk_fp8_f32(s[66] * 32.f, s[99] * 32.f, w0, true);
      w1 = __builtin_amdgcn_cvt_pk_fp8_f32(s[132] * 32.f, s[165] * 32.f, w1, false); w1 = __builtin_amdgcn_cvt_pk_fp8_f32(s[198] * 32.f, s[231] * 32.f, w1, true);
      *(u32x2*)(W8 + (size_t)(n0 + n) * K + k0 + 8 * c) = (u32x2){(unsigned)w0, (unsigned)w1};
    }
  }
  asm volatile("s_waitcnt lgkmcnt(0)" ::: "memory");
}
__device__ __forceinline__ void convert_tables(const Params& p, int L, int wv, int nw, int lane, int r_lo, int r_hi) {
  unsigned char* PUq = p.ws + WS_PU; unsigned char* PVq = p.ws + WS_PV; float* PSC = (float*)(p.ws + WS_PSC);
  const int nrows = DEPTH * NEXP;
#define TAB_SROW(r_) ((const f32x4*)(((r_) >= NEXP ? p.in[I_PV] : p.in[I_PU]) + (size_t)(L * NEXP + ((r_) >= NEXP ? (r_) - NEXP : (r_))) * DM) + lane)
#define TAB_LOAD(v_, r_) do { if ((r_) < r_hi) { const f32x4* s_ = TAB_SROW(r_); _Pragma("unroll") for (int j = 0; j < 4; ++j) v_[j] = __builtin_nontemporal_load(s_ + 64 * j); } } while (0)
  auto encode_row = [&](const f32x4 (&v)[4], int r) {
    const int tb = r >= NEXP, rr = L * NEXP + (tb ? r - NEXP : r);
    float mx = 0.f;
#pragma unroll
    for (int j = 0; j < 4; ++j) mx = fmaxf(mx, fmaxf(fmaxf(fabsf(v[j].x), fabsf(v[j].y)), fmaxf(fabsf(v[j].z), fabsf(v[j].w))));
    mx = wave_max_fast(mx);
    const unsigned mb = __float_as_uint(mx);
    const int eb = (int)((mb >> 23) & 0xFFu);
    int sb = ((mb & 0x7FFFFFu) <= 0x700000u ? 129 : 128) - eb + 127; sb = sb < 1 ? 1 : (sb > 253 ? 253 : sb);
    const float sc = __uint_as_float((unsigned)sb << 23), isc = __uint_as_float((unsigned)(254 - sb) << 23);
    const float xv[16] = {v[0].x, v[0].y, v[0].z, v[0].w, v[1].x, v[1].y, v[1].z, v[1].w, v[2].x, v[2].y, v[2].z, v[2].w, v[3].x, v[3].y, v[3].z, v[3].w};
    unsigned wq[3] = {0u, 0u, 0u};
#pragma unroll
    for (int i = 0; i < 16; ++i) {
      const float a = fabsf(xv[i]) * sc;
      unsigned code = a < 2.f ? (unsigned)__builtin_rintf(a * 8.f) : (a < 4.f ? 8u + (unsigned)__builtin_rintf(a * 4.f) : 16u + (unsigned)__builtin_rintf(a * 2.f));
      code = code > 31u ? 31u : code;
      code |= (xv[i] < 0.f) ? 32u : 0u;
      const int bp = 6 * i, dw = bp >> 5, off = bp & 31;
      wq[dw] |= code << off;
      if (off > 26) wq[dw + 1] |= code >> (32 - off);
    }
    u32x3 o; o.x = wq[0]; o.y = wq[1]; o.z = wq[2];
    *(u32x3*)((tb ? PVq : PUq) + (size_t)rr * PROW + lane * 12) = o;
    if (lane == 0) PSC[(size_t)tb * nrows + rr] = isc;
  };
  f32x4 v0[4], v1[4], v2[4];
  TAB_LOAD(v0, r_lo + wv); TAB_LOAD(v1, r_lo + wv + nw);
#pragma unroll 1
  for (int r = r_lo + wv; r < r_hi; r += 3 * nw) {
    TAB_LOAD(v2, r + 2 * nw); encode_row(v0, r);
    if (r + nw < r_hi) { TAB_LOAD(v0, r + 3 * nw); encode_row(v1, r + nw); }
    if (r + 2 * nw < r_hi) { TAB_LOAD(v1, r + 4 * nw); encode_row(v2, r + 2 * nw); }
  }
#undef TAB_LOAD
#undef TAB_SROW
}
__device__ __forceinline__ void tail_filler_tables(const Params& p, int L, int nwg, int r_lo, int r_hi) {
  int tid_ = tidx(); asm volatile("" : "+v"(tid_)); const int lane = tid_ & 63, wid = tid_ >> 6;
  const int nextra = nwg % p.gx, first = nextra, nidle = p.gx - nextra;
  if (p.bx < first) return;
  convert_tables(p, L, (p.bx - first) * 8 + wid, nidle * 8, lane, r_lo, r_hi);
}
__device__ __forceinline__ void p0_convert(const Params& p, unsigned char* lds) {
  int tid_ = tidx(); asm volatile("" : "+v"(tid_)); const int tid = tid_, lane = tid & 63, wid = tid >> 6;
  const int gw = p.bx * 8 + wid, NGW = p.gx * 8;
  const size_t gt = (size_t)p.bx * 512 + tid, NGT = (size_t)p.gx * 512;
  float* scr = (float*)(lds + 32768) + wid * (64 * 33);
  bf16_t* WIN = (bf16_t*)(p.ws + WS_WIN); bf16_t* WOUT = (bf16_t*)(p.ws + WS_WOUT); bf16_t* WQ = (bf16_t*)(p.ws + WS_WQ);
  constexpr int I_IN = 16 * 96, I_O = 16 * 32, PER_L = I_IN + 2 * I_O;
  for (int it = gw; it < DEPTH * PER_L; it += NGW) {
    const int l = it / PER_L; int r = it % PER_L;
    if (r < I_IN) { const int kb = r / 96, nb = r % 96, n0 = nb * 32; const int src = n0 < 1536 ? n0 : n0 + 16;
      transpose_item(p.in[I_WIN] + (size_t)l * DM * IN_W, IN_W, src, WIN + (size_t)l * PW * DM, DM, n0, kb * 64, scr, lane, n0 >= C_DQ ? p.ws + WS_W8 + (size_t)l * PW * DM : nullptr); continue; }
    r -= I_IN;
    if (r < I_O) { const int kb = r / 32, nb = r % 32;
      transpose_item(p.in[I_WOUT] + (size_t)l * DM * DM, DM, nb * 32, WOUT + (size_t)l * DM * DM, DM, nb * 32, kb * 64, scr, lane); continue; }
    r -= I_O;
    { const int kb = r / 32, nb = r % 32;
      transpose_item(p.in[I_PWQ] + (size_t)l * DM * DM, DM, nb * 32, WQ + (size_t)l * DM * DM, DM, nb * 32, kb * 64, scr, lane); }
  }
  bf16_t* WG = (bf16_t*)(p.ws + WS_WG);
  for (size_t i = gt; i < (size_t)DEPTH * 16 * DM; i += NGT) {
    const int l = (int)(i / (16 * DM)), g = (int)((i / DM) % 16), k = (int)(i % DM);
    WG[i] = (bf16_t)(cvtpk(p.in[I_WIN][(size_t)l * DM * IN_W + (size_t)k * IN_W + 1536 + g], 0.f) & 0xffffu);
  }
  bf16_t* KEYS = (bf16_t*)(p.ws + WS_KEYS);
  for (size_t i = gt; i < (size_t)DEPTH * 131072 / 8; i += NGT) {
    const f32x4 a = ((const f32x4*)p.in[I_PKEYS])[2 * i], b = ((const f32x4*)p.in[I_PKEYS])[2 * i + 1];
    u32x4 o; o.x = cvtpk(a.x, a.y); o.y = cvtpk(a.z, a.w); o.z = cvtpk(b.x, b.y); o.w = cvtpk(b.z, b.w);
    ((u32x4*)KEYS)[i] = o;
  }
  {
    float* RC = (float*)(p.ws + WS_ROPE); float* RS = RC + SEQ * 32;
    for (size_t i = gt; i < (size_t)SEQ * 32; i += NGT) {
      const int pos = (int)(i >> 5), j = (int)(i & 31);
      const int rr = pos >> 6, cc = pos & 63;
      const int jj = j & 15;
      const double e = -(double)jj * 0.83048202372184058696;
      const double fl = __builtin_floor(e); const double f = e - fl;
      const double z = f * 0.69314718055994530942;
      double ez = 1.0 + z * (1.0 + z * (0.5 + z * (1.0 / 6 + z * (1.0 / 24 + z * (1.0 / 120 + z * (1.0 / 720 + z * (1.0 / 5040 + z * (1.0 / 40320 + z * (1.0 / 362880 + z * (1.0 / 3628800 + z * (1.0 / 39916800 + z * (1.0 / 479001600))))))))))));
      const double inv = __builtin_ldexp(ez, (int)fl);
      const float invf = (float)inv;
      const float angf = (float)(j < 16 ? rr : cc) * invf;
      const double ang = (double)angf;
      const double kq = __builtin_rint(ang * 0.63661977236758134308);
      double r = __builtin_fma(-kq, 1.57079632679489655800e+00, ang);
      r = __builtin_fma(-kq, 6.12323399573676603587e-17, r);
      const double r2 = r * r;
      const double sn = r * (1.0 + r2 * (-1.0 / 6 + r2 * (1.0 / 120 + r2 * (-1.0 / 5040 + r2 * (1.0 / 362880 + r2 * (-1.0 / 39916800 + r2 * (1.0 / 6227020800.0)))))));
      const double cs = 1.0 + r2 * (-0.5 + r2 * (1.0 / 24 + r2 * (-1.0 / 720 + r2 * (1.0 / 40320 + r2 * (-1.0 / 3628800 + r2 * (1.0 / 479001600 + r2 * (-1.0 / 87178291200.0)))))));
      const int q = ((int)kq) & 3;
      double co, si;
      if (q == 0) { co = cs; si = sn; } else if (q == 1) { co = -sn; si = cs; } else if (q == 2) { co = -cs; si = -sn; } else { co = sn; si = -cs; }
      RC[i] = (float)co; RS[i] = (float)si;
    }
  }
}

__device__ __forceinline__ void norm_mod_row(const float* xrow, const float* g, const float* sc, const float* sh, bf16_t* orow, int lane) {
  const f32x4* xr = (const f32x4*)xrow + lane;
  f32x4 v[4]; float s = 0.f;
#pragma unroll
  for (int j = 0; j < 4; ++j) { v[j] = xr[64 * j]; s += (v[j].x * v[j].x + v[j].y * v[j].y) + (v[j].z * v[j].z + v[j].w * v[j].w); }
  const float rs = rsqrtf(wave_sum(s) * (1.f / DM) + EPS);
  u32x2* o = (u32x2*)orow + lane;
#pragma unroll
  for (int j = 0; j < 4; ++j) {
    const f32x4 gg = ((const f32x4*)g)[lane + 64 * j], cc = ((const f32x4*)sc)[lane + 64 * j], hh = ((const f32x4*)sh)[lane + 64 * j];
    const float y0 = v[j].x * rs * gg.x * (1.f + cc.x) + hh.x, y1 = v[j].y * rs * gg.y * (1.f + cc.y) + hh.y;
    const float y2 = v[j].z * rs * gg.z * (1.f + cc.z) + hh.z, y3 = v[j].w * rs * gg.w * (1.f + cc.w) + hh.w;
    u32x2 w; w.x = cvtpk(y0, y1); w.y = cvtpk(y2, y3);
    o[64 * j] = w;
  }
}
__device__ __forceinline__ void phase_norm(const Params& p, int l, int which, bool from_input, bool skip_ctx) {
  int tid_ = tidx(); asm volatile("" : "+v"(tid_));
  const int lane = tid_ & 63, wid = tid_ >> 6;
  const int gw = p.bx * 8 + wid, NGW = p.gx * 8;
  const float* MOD = (const float*)(p.ws + WS_MOD);
  const float* XC = (const float*)(p.ws + WS_XCUR);
  bf16_t* H = (bf16_t*)(p.ws + WS_H);
  const float* g = p.in[which ? I_N2G : I_N1G] + l * DM;
  auto next_row = [&](int r_) { while (r_ < T && skip_ctx && mod_row(r_) == 4) r_ += NGW; return r_; };
  auto xrow_of = [&](int r_) { return (const f32x4*)(from_input ? in_row(p.in[I_X], p.in[I_CTX], r_) : XC + (size_t)r_ * DM) + lane; };
  f32x4 gg[4], cc[4], hh[4], v[4], vn[4];
#pragma unroll
  for (int j = 0; j < 4; ++j) gg[j] = ((const f32x4*)g)[lane + 64 * j];
  int mr_cur = -1;
  int row = next_row(gw);
  if (row < T) { const f32x4* xr = xrow_of(row);
#pragma unroll
    for (int j = 0; j < 4; ++j) v[j] = xr[64 * j]; }
  while (row < T) {
    const int nrow = next_row(row + NGW);
    if (nrow < T) { const f32x4* xn = xrow_of(nrow);
#pragma unroll
      for (int j = 0; j < 4; ++j) vn[j] = xn[64 * j]; }
    const int mr = mod_row(row);
    if (mr != mr_cur) {
      const float* m = MOD + ((size_t)l * 5 + mr) * 6144 + which * 3072;
#pragma unroll
      for (int j = 0; j < 4; ++j) { cc[j] = ((const f32x4*)(m + 1024))[lane + 64 * j]; hh[j] = ((const f32x4*)m)[lane + 64 * j]; }
      mr_cur = mr;
    }
    float s = 0.f;
#pragma unroll
    for (int j = 0; j < 4; ++j) s += (v[j].x * v[j].x + v[j].y * v[j].y) + (v[j].z * v[j].z + v[j].w * v[j].w);
    const float rs = rsqrtf(wave_sum(s) * (1.f / DM) + EPS);
    u32x2* o = (u32x2*)(H + (size_t)row * DM) + lane;
#pragma unroll
    for (int j = 0; j < 4; ++j) {
      const float y0 = v[j].x * rs * gg[j].x * (1.f + cc[j].x) + hh[j].x, y1 = v[j].y * rs * gg[j].y * (1.f + cc[j].y) + hh[j].y;
      const float y2 = v[j].z * rs * gg[j].z * (1.f + cc[j].z) + hh[j].z, y3 = v[j].w * rs * gg[j].w * (1.f + cc[j].w) + hh[j].w;
      u32x2 w; w.x = cvtpk(y0, y1); w.y = cvtpk(y2, y3);
      o[64 * j] = w;
      if (which == 0) {
        int w8 = 0; w8 = __builtin_amdgcn_cvt_pk_fp8_f32(y0, y1, w8, false); w8 = __builtin_amdgcn_cvt_pk_fp8_f32(y2, y3, w8, true);
        ((int*)(p.ws + WS_H8 + (size_t)row * DM))[lane + 64 * j] = w8;
      }
    }
#pragma unroll
    for (int j = 0; j < 4; ++j) v[j] = vn[j];
    row = nrow;
  }
}

namespace pg8 {
#define PG8_LAS __attribute__((address_space(3)))
typedef unsigned short bf16_t;
typedef short bf16x8 __attribute__((ext_vector_type(8)));
typedef float f32x4 __attribute__((ext_vector_type(4)));
typedef unsigned u32x4 __attribute__((ext_vector_type(4)));
typedef int i32x4v __attribute__((ext_vector_type(4)));
typedef int i32x8v __attribute__((ext_vector_type(8)));
constexpr int BM = 256, BK = 64, HALF = 128, HTB = HALF * BK * 2  , STAGE_BYTES = 8 * HTB, NXCD = 8, WGM = 8;

__host__ __device__ __forceinline__ int lds_byte(int r, int c) { const int st = (r >> 4) * 2 + (c >> 5), rr = r & 15, cc = c & 31, ob = rr * 64 + cc * 2; return st * 1024 + (ob ^ (((ob >> 9) & 1) << 5)); }
__host__ __device__ __forceinline__ void stage_rc(int b, int& R, int& C) { const int st = b / 1024, sb = b % 1024, swz = sb ^ (((sb >> 9) & 1) << 5); R = (st >> 1) * 16 + swz / 64; C = (st & 1) * 32 + (swz % 64) / 2; }
__host__ __device__ __forceinline__ int perm32(int rho) { const int n = rho >> 4, i = rho & 15; return 8 * (i >> 2) + 4 * n + (i & 3); }

struct Unit { int pm, pn; };
struct Gemm { const bf16_t* A; const bf16_t* Bt; int M, N, K; };

struct StaticOrder {
    int nM, nN, nwg, G, c;
    __host__ __device__ void init(int M, int N, int G_, int c_) { nM = M / BM; nN = N / BM; nwg = nM * nN; G = G_; c = c_; }
    __host__ __device__ bool next(int i, Unit& u) const {
        const long L = (long)i * G + c; if (L >= nwg) return false;
        int wgid = (int)L; { const int q = nwg / NXCD, r = nwg % NXCD, xcd = wgid % NXCD, off = wgid / NXCD; wgid = (xcd < r ? xcd * (q + 1) : r * (q + 1) + (xcd - r) * q) + off; }
        const int nig = WGM * nN, gid = wgid / nig, fm = gid * WGM, gsz = (nM - fm) < WGM ? (nM - fm) : WGM;
        u.pm = fm + ((wgid % nig) % gsz); u.pn = (wgid % nig) / gsz; return true;
    }
    __device__ __forceinline__ void a_ready(const Unit&) const {}
    __device__ __forceinline__ void done(const Unit&) const {}
};
struct F8Order {
    int nM, G, c, heavy, nwg;
    __host__ __device__ void init(int M, int G_, int c_, int heavy_) { nM = M / BM; G = G_; c = c_; heavy = heavy_; nwg = nM * 6; }
    __host__ __device__ bool next(int i, Unit& u) const {
        int L;
        const int nl = G - heavy, tailbase = nwg - 2 * heavy;
        if (c >= heavy) { L = i * nl + (c - heavy); if (L >= tailbase) return false; }
        else { if (i > 1) return false; L = tailbase + 2 * c + i; }
        int wgid = L; { const int q = nwg / NXCD, r = nwg % NXCD, xcd = wgid % NXCD, off = wgid / NXCD; wgid = (xcd < r ? xcd * (q + 1) : r * (q + 1) + (xcd - r) * q) + off; }
        const int nig = WGM * 6, gid = wgid / nig, fm = gid * WGM, gsz = (nM - fm) < WGM ? (nM - fm) : WGM;
        u.pm = fm + ((wgid % nig) % gsz); u.pn = 6 + (wgid % nig) / gsz; return true;
    }
    __device__ __forceinline__ void a_ready(const Unit&) const {}
    __device__ __forceinline__ void done(const Unit&) const {}
};
__device__ __forceinline__ unsigned cvt_pk_bf16(float lo, float hi) { unsigned r; asm volatile("v_cvt_pk_bf16_f32 %0, %1, %2" : "=v"(r) : "v"(lo), "v"(hi)); return r; }
template <class Epi, class Sched, bool ALIGN_EPI = false, bool SP2 = false, bool F8 = false>
__device__ __forceinline__ void gemm_phase(PG8_LAS unsigned char* lds, const Gemm g, const Sched& S, const Epi& E) {
    const int tid = tidx(), wid = __builtin_amdgcn_readfirstlane(tid >> 6), lane = tid & 63, wr = wid >> 2, wc = wid & 3, fr = lane & 15, fq = lane >> 4;
    const int K = g.K, nt = K / BK;
    unsigned voffA, voffB;
    { int R, C; stage_rc(tid * 16, R, C); const int Rb = Epi::PERM ? ((R & ~31) + perm32(R & 31)) : R;
      voffA = (unsigned)(R * K + C) * 2u; voffB = (unsigned)(Rb * K + C) * 2u; }
    const size_t kstep = (size_t)(BK * 2);
    const size_t hstep = (size_t)HALF * K * 2;
    const size_t tstep = 2 * hstep;
    const unsigned ldsw = (unsigned)wid * 1024u;
    const int aoff = lds_byte(wr * 64 + fr, fq * 8), boff = lds_byte(wc * 32 + fr, fq * 8);
#define PG8_SA(b, h) (((b) * 2 + (h)) * HTB)
#define PG8_SB(b, h) ((4 + (b) * 2 + (h)) * HTB)
#define PG8_STAGE(bufoff, gbase, voff) do { _Pragma("unroll") for (int _i = 0; _i < 2; ++_i) \
        __builtin_amdgcn_global_load_lds((const unsigned*)((const char*)(gbase) + (size_t)_i * 128u * (unsigned)K + (voff)), (PG8_LAS unsigned*)(lds + (bufoff) + ldsw + _i * 8192), 16, 0, 0); } while (0)
#define PG8_LD32(d8_, addr_) do { const i32x4v x0_ = *(const PG8_LAS i32x4v*)(addr_), x1_ = *(const PG8_LAS i32x4v*)((addr_) + 1024); \
        d8_ = __builtin_shufflevector(x0_, x1_, 0, 1, 2, 3, 4, 5, 6, 7); } while (0)
#define PG8_LDA(dst, b, h) do { if constexpr (F8) { _Pragma("unroll") for (int m = 0; m < 4; ++m) PG8_LD32(dst##8[m], lds + PG8_SA(b, h) + aoff + m * 2048); } \
        else { _Pragma("unroll") for (int m = 0; m < 4; ++m) _Pragma("unroll") for (int k = 0; k < 2; ++k) dst[m][k] = *(const PG8_LAS bf16x8*)(lds + PG8_SA(b, h) + aoff + m * 2048 + k * 1024); } } while (0)
#define PG8_LDB(dst, b, h) do { if constexpr (F8) { _Pragma("unroll") for (int n = 0; n < 2; ++n) PG8_LD32(dst##8[n], lds + PG8_SB(b, h) + boff + n * 2048); } \
        else { _Pragma("unroll") for (int n = 0; n < 2; ++n) _Pragma("unroll") for (int k = 0; k < 2; ++k) dst[n][k] = *(const PG8_LAS bf16x8*)(lds + PG8_SB(b, h) + boff + n * 2048 + k * 1024); } } while (0)
#define PG8_MMA(ai, bj, At, Bt) do { __builtin_amdgcn_s_setprio(1); _Pragma("unroll") for (int m = 0; m < 4; ++m) _Pragma("unroll") for (int n = 0; n < 2; ++n) { \
        if constexpr (F8) acc[ai][bj][m][n] = __builtin_amdgcn_mfma_scale_f32_16x16x128_f8f6f4(Bt##8[n], At##8[m], acc[ai][bj][m][n], 0, 0, 0, 0x7F7F7F7F, 0, 0x7F7F7F7F); \
        else { _Pragma("unroll") for (int k = 0; k < 2; ++k) acc[ai][bj][m][n] = __builtin_amdgcn_mfma_f32_16x16x32_bf16(Bt[n][k], At[m][k], acc[ai][bj][m][n], 0, 0, 0); } } \
        __builtin_amdgcn_s_setprio(0); } while (0)
#define PG8_WAIT_V(n) asm volatile("s_waitcnt vmcnt(" #n ")" ::: "memory")
#define PG8_WAIT_L(n) asm volatile("s_waitcnt lgkmcnt(" #n ")" ::: "memory")
#define PG8_BAR __builtin_amdgcn_s_barrier()
#define PG8_SCHED __builtin_amdgcn_sched_barrier(0)
    Unit cur, nxt; int ui = 0;
    if (!S.next(0, cur)) return;
    f32x4 acc[2][2][4][2];
#pragma unroll
    for (int a = 0; a < 2; ++a)
#pragma unroll
        for (int b = 0; b < 2; ++b)
#pragma unroll
            for (int m = 0; m < 4; ++m)
#pragma unroll
                for (int n = 0; n < 2; ++n) acc[a][b][m][n] = (f32x4){0.f, 0.f, 0.f, 0.f};
    bf16x8 At[4][2], B0[2][2], B1[2][2];
    i32x8v At8[4], B08[2], B18[2];
    const char* cA = (const char*)g.A + (size_t)cur.pm * tstep; const char* cB = (const char*)g.Bt + (size_t)cur.pn * tstep;
    S.a_ready(cur);
    if constexpr (SP2) {
        PG8_STAGE(PG8_SB(0, 0), cB, voffB); PG8_STAGE(PG8_SB(0, 1), cB + hstep, voffB); PG8_STAGE(PG8_SA(0, 0), cA, voffA); PG8_STAGE(PG8_SA(0, 1), cA + hstep, voffA);
        if (wr == 1) PG8_BAR;
        PG8_WAIT_V(2); PG8_BAR;
        PG8_STAGE(PG8_SB(1, 0), cB + kstep, voffB); PG8_STAGE(PG8_SA(1, 0), cA + kstep, voffA); PG8_STAGE(PG8_SB(1, 1), cB + hstep + kstep, voffB);
        PG8_WAIT_V(6); PG8_BAR;
    } else {
        PG8_STAGE(PG8_SB(0, 0), cB, voffB); PG8_STAGE(PG8_SA(0, 0), cA, voffA); PG8_STAGE(PG8_SB(0, 1), cB + hstep, voffB); PG8_STAGE(PG8_SA(0, 1), cA + hstep, voffA);
        if (wr == 1) PG8_BAR;
        PG8_WAIT_V(4); PG8_BAR;
        PG8_STAGE(PG8_SB(1, 0), cB + kstep, voffB); PG8_STAGE(PG8_SA(1, 0), cA + kstep, voffA); PG8_STAGE(PG8_SB(1, 1), cB + hstep + kstep, voffB);
        PG8_WAIT_V(6); PG8_BAR;
    }
    for (;;) {
        const bool has_next = S.next(ui + 1, nxt);
        const char* nA = has_next ? (const char*)g.A + (size_t)nxt.pm * tstep : cA; const char* nB = has_next ? (const char*)g.Bt + (size_t)nxt.pn * tstep : cB;
#pragma unroll 1
        for (int t = 0; t < nt; t += 2) {
            const bool last = (t == nt - 2);
            const char* a1 = cA + (size_t)(t + 1) * kstep;
            const char* a2 = last ? nA : cA + (size_t)(t + 2) * kstep; const char* b2 = last ? nB : cB + (size_t)(t + 2) * kstep;
            const char* a3 = a2 + kstep; const char* b3 = b2 + kstep;
            if (last && has_next) S.a_ready(nxt);
            if constexpr (SP2) {
            PG8_LDB(B0, 0, 0); PG8_LDB(B1, 0, 1); PG8_SCHED; PG8_LDA(At, 0, 0); PG8_STAGE(PG8_SA(1, 1), a1 + hstep, voffA);
            PG8_WAIT_V(8); PG8_WAIT_L(0); PG8_BAR; PG8_MMA(0, 0, At, B0); PG8_MMA(0, 1, At, B1); PG8_BAR; PG8_SCHED;
            PG8_LDA(At, 0, 1); PG8_STAGE(PG8_SB(0, 0), b2, voffB); PG8_STAGE(PG8_SB(0, 1), b2 + hstep, voffB); PG8_STAGE(PG8_SA(0, 0), a2, voffA);
            PG8_WAIT_V(8); PG8_WAIT_L(0); PG8_BAR; PG8_MMA(1, 0, At, B0); PG8_MMA(1, 1, At, B1); PG8_BAR; PG8_SCHED;
            PG8_LDB(B0, 1, 0); PG8_LDB(B1, 1, 1); PG8_SCHED; PG8_LDA(At, 1, 0); PG8_STAGE(PG8_SA(0, 1), a2 + hstep, voffA);
            PG8_WAIT_V(8); PG8_WAIT_L(0); PG8_BAR; PG8_MMA(0, 0, At, B0); PG8_MMA(0, 1, At, B1); PG8_BAR; PG8_SCHED;
            PG8_LDA(At, 1, 1); PG8_STAGE(PG8_SB(1, 0), b3, voffB); PG8_STAGE(PG8_SB(1, 1), b3 + hstep, voffB); PG8_STAGE(PG8_SA(1, 0), a3, voffA);
            PG8_WAIT_V(8); PG8_WAIT_L(0); PG8_BAR; PG8_MMA(1, 0, At, B0); PG8_MMA(1, 1, At, B1); PG8_BAR; PG8_SCHED;
            } else {
            PG8_LDB(B0, 0, 0); PG8_SCHED; PG8_LDA(At, 0, 0); PG8_STAGE(PG8_SA(1, 1), a1 + hstep, voffA);
            PG8_WAIT_L(8); PG8_BAR; PG8_WAIT_L(0); PG8_MMA(0, 0, At, B0); PG8_BAR; PG8_SCHED;
            PG8_LDB(B1, 0, 1); PG8_STAGE(PG8_SB(0, 0), b2, voffB);
            PG8_BAR; PG8_WAIT_L(0); PG8_MMA(0, 1, At, B1); PG8_BAR;
            PG8_LDA(At, 0, 1); PG8_STAGE(PG8_SA(0, 0), a2, voffA);
            PG8_BAR; PG8_WAIT_L(0); PG8_MMA(1, 0, At, B0); PG8_BAR; PG8_SCHED;
            PG8_STAGE(PG8_SB(0, 1), b2 + hstep, voffB);
            PG8_WAIT_V(6); PG8_BAR; PG8_MMA(1, 1, At, B1); PG8_BAR;
            PG8_LDB(B0, 1, 0); PG8_SCHED; PG8_LDA(At, 1, 0); PG8_STAGE(PG8_SA(0, 1), a2 + hstep, voffA);
            PG8_WAIT_L(8); PG8_BAR; PG8_WAIT_L(0); PG8_MMA(0, 0, At, B0); PG8_BAR; PG8_SCHED;
            PG8_LDB(B1, 1, 1); PG8_STAGE(PG8_SB(1, 0), b3, voffB);
            PG8_BAR; PG8_WAIT_L(0); PG8_MMA(0, 1, At, B1); PG8_BAR;
            PG8_LDA(At, 1, 1); PG8_STAGE(PG8_SA(1, 0), a3, voffA);
            PG8_BAR; PG8_WAIT_L(0); PG8_MMA(1, 0, At, B0); PG8_BAR; PG8_SCHED;
            PG8_STAGE(PG8_SB(1, 1), b3 + hstep, voffB);
            PG8_WAIT_V(6); PG8_BAR; PG8_MMA(1, 1, At, B1); PG8_BAR;
            }
        }
        if constexpr (ALIGN_EPI) { if (wr == 0) PG8_BAR; }
        if constexpr (!Epi::AFTER_DRAIN) { int fr_ = fr, fq_ = fq; asm volatile("" : "+v"(fr_), "+v"(fq_));
          E(acc, cur, wr, wc, fr_, fq_); S.done(cur); }
        if (!has_next) break;
#pragma unroll
        for (int a = 0; a < 2; ++a)
#pragma unroll
            for (int b = 0; b < 2; ++b)
#pragma unroll
                for (int m = 0; m < 4; ++m)
#pragma unroll
                    for (int n = 0; n < 2; ++n) acc[a][b][m][n] = (f32x4){0.f, 0.f, 0.f, 0.f};
        cur = nxt; cA = nA; cB = nB; ++ui;
        if constexpr (ALIGN_EPI) { if (wr == 1) PG8_BAR; }
    }
    PG8_WAIT_V(0);
    if constexpr (!ALIGN_EPI) { if (wr == 0) PG8_BAR; }
    PG8_BAR;
    if constexpr (Epi::AFTER_DRAIN) { E.fused(acc, cur, wr, wc, fr, fq, lds, wid, lane); S.done(cur); }
#undef PG8_SA
#undef PG8_SB
#undef PG8_STAGE
#undef PG8_LDA
#undef PG8_LDB
#undef PG8_MMA
#undef PG8_WAIT_V
#undef PG8_WAIT_L
#undef PG8_BAR
#undef PG8_SCHED
}
}

__device__ __forceinline__ int gswz(int row, int chunk) { return row * 128 + ((chunk ^ ((row >> 1) & 7)) << 4); }
__device__ __forceinline__ void gemm_tile(const bf16_t* __restrict__ A, int lda, const bf16_t* __restrict__ Bt, int ldb, int K,
                                          int row0, int col0, unsigned char* lds, f32x16 (&acc)[2][2]) {
  int tid_ = tidx(); asm volatile("" : "+v"(tid_)); const int tid = tid_, lane = tid & 63, wid = tid >> 6, wm = wid >> 1, wn = wid & 1, r32 = lane & 31, hi = lane >> 5;
  unsigned char* As = lds; unsigned char* Bs = lds + 65536;
#pragma unroll
  for (int i = 0; i < 2; ++i)
#pragma unroll
    for (int j = 0; j < 2; ++j) acc[i][j] = f32x16{};
  const int lrow = tid >> 3, lc = tid & 7;
  const bf16_t* Ag = A + (size_t)(row0 + lrow) * lda + lc * 8;
  const bf16_t* Bg = Bt + (size_t)(col0 + lrow) * ldb + lc * 8;
  u32x4 ra[4], rb[2];
#pragma unroll
  for (int i = 0; i < 4; ++i) ra[i] = *(const u32x4*)(Ag + (size_t)(64 * i) * lda);
#pragma unroll
  for (int i = 0; i < 2; ++i) rb[i] = *(const u32x4*)(Bg + (size_t)(64 * i) * ldb);
#pragma unroll
  for (int i = 0; i < 4; ++i) *(u32x4*)(As + gswz(lrow + 64 * i, lc)) = ra[i];
#pragma unroll
  for (int i = 0; i < 2; ++i) *(u32x4*)(Bs + gswz(lrow + 64 * i, lc)) = rb[i];
  __syncthreads();
  const int nk = K / 64;
  for (int kt = 0; kt < nk; ++kt) {
    const int cur = kt & 1;
    if (kt + 1 < nk) {
#pragma unroll
      for (int i = 0; i < 4; ++i) ra[i] = *(const u32x4*)(Ag + (size_t)(64 * i) * lda + (kt + 1) * 64);
#pragma unroll
      for (int i = 0; i < 2; ++i) rb[i] = *(const u32x4*)(Bg + (size_t)(64 * i) * ldb + (kt + 1) * 64);
    }
    const unsigned char* Ac = As + cur * 32768; const unsigned char* Bc = Bs + cur * 16384;
#pragma unroll
    for (int kk = 0; kk < 4; ++kk) {
      bf16x8 af[2], bfr[2];
#pragma unroll
      for (int i = 0; i < 2; ++i) af[i] = *(const bf16x8*)(Ac + gswz(wm * 64 + i * 32 + r32, 2 * kk + hi));
#pragma unroll
      for (int j = 0; j < 2; ++j) bfr[j] = *(const bf16x8*)(Bc + gswz(wn * 64 + j * 32 + r32, 2 * kk + hi));
#pragma unroll
      for (int i = 0; i < 2; ++i)
#pragma unroll
        for (int j = 0; j < 2; ++j) acc[i][j] = __builtin_amdgcn_mfma_f32_32x32x16_bf16(af[i], bfr[j], acc[i][j], 0, 0, 0);
    }
    if (kt + 1 < nk) {
      unsigned char* An = As + (cur ^ 1) * 32768; unsigned char* Bn = Bs + (cur ^ 1) * 16384;
#pragma unroll
      for (int i = 0; i < 4; ++i) *(u32x4*)(An + gswz(lrow + 64 * i, lc)) = ra[i];
#pragma unroll
      for (int i = 0; i < 2; ++i) *(u32x4*)(Bn + gswz(lrow + 64 * i, lc)) = rb[i];
    }
    __syncthreads();
  }
}
__device__ __forceinline__ void pair_xchg(float v0, float v1, int lane, float& lo, float& hi2) {
  const bool odd = lane & 1;
  const float send = odd ? v0 : v1;
  const float recv = dpp_mov<0xB1>(send);
  lo = odd ? recv : v0; hi2 = odd ? v1 : recv;
}

__device__ __forceinline__ void phase_inproj(const Params& p, int l, unsigned char* lds) {
  int tid_ = tidx(); asm volatile("" : "+v"(tid_)); const int tid = tid_, lane = tid & 63, wid = tid >> 6, wm = wid >> 1, wn = wid & 1, r32 = lane & 31, hi = lane >> 5;
  const bf16_t* H = (const bf16_t*)(p.ws + WS_H);
  const bf16_t* W = (const bf16_t*)(p.ws + WS_WIN) + (size_t)l * PW * DM;
  bf16_t* PROJ = (bf16_t*)(p.ws + WS_PROJ);
  const float* RC = (const float*)(p.ws + WS_ROPE); const float* RS = RC + SEQ * 32;
  constexpr int NM = T / 256, NN = PW / 128, NU = NM * NN;
  for (int u = p.bx; u < NU + NM; u += p.gx) {
    if (u < NU) {
      const int pn = u / NM, pm = u % NM;
      const int row0 = pm * 256, col0 = pn * 128;
      f32x16 acc[2][2];
      gemm_tile(H, DM, W, DM, DM, row0, col0, lds, acc);
      const bool rope = (col0 >= C_DQ && col0 < C_DV);
      const float scl = (col0 >= C_MK && col0 < C_MV) ? 0.125f : ((col0 >= C_DQ && col0 < C_DK) ? QSCALE : 1.f);
#pragma unroll
      for (int i = 0; i < 2; ++i)
#pragma unroll
        for (int j = 0; j < 2; ++j)
#pragma unroll
          for (int q = 0; q < 8; ++q) {
            float lo, hi2; pair_xchg(acc[i][j][2 * q], acc[i][j][2 * q + 1], lane, lo, hi2);
            const int row = row0 + wm * 64 + i * 32 + crow(2 * q, hi) + (lane & 1);
            const int col = col0 + wn * 64 + j * 32 + (r32 & ~1);
            if (rope) {
              const int s = row % SEGL;
              if (s >= CTXL) {
                const int idx = (s - CTXL) * 32 + ((col & 63) >> 1);
                const float c = RC[idx], sn = RS[idx];
                const float t1 = lo, t2 = hi2; lo = t1 * c - t2 * sn; hi2 = t1 * sn + t2 * c;
              }
            }
            *(unsigned*)(PROJ + (size_t)row * PW + col) = cvtpk(lo * scl, hi2 * scl);
          }
    } else {
      const int pm = u - NU, rowb = pm * 256 + wid * 32;
      const bf16_t* WG = (const bf16_t*)(p.ws + WS_WG) + (size_t)l * 16 * DM;
      float* GT = (float*)(p.ws + WS_GATES);
      const int r16 = lane & 15, q4 = lane >> 4;
      f32x4 c0 = {0.f, 0.f, 0.f, 0.f}, c1 = {0.f, 0.f, 0.f, 0.f};
      const bf16_t* a0p = H + (size_t)(rowb + r16) * DM + q4 * 8;
      const bf16_t* a1p = a0p + (size_t)16 * DM;
      const bf16_t* bp = WG + (size_t)r16 * DM + q4 * 8;
#pragma unroll 4
      for (int ks = 0; ks < 32; ++ks) {
        const bf16x8 a0 = *(const bf16x8*)(a0p + ks * 32), a1 = *(const bf16x8*)(a1p + ks * 32), b = *(const bf16x8*)(bp + ks * 32);
        c0 = __builtin_amdgcn_mfma_f32_16x16x32_bf16(a0, b, c0, 0, 0, 0);
        c1 = __builtin_amdgcn_mfma_f32_16x16x32_bf16(a1, b, c1, 0, 0, 0);
      }
      const float gb = p.in[I_GATEB][l * 16 + r16];
#pragma unroll
      for (int j = 0; j < 4; ++j) {
        GT[(size_t)(rowb + q4 * 4 + j) * 16 + r16] = c0[j] + gb;
        GT[(size_t)(rowb + 16 + q4 * 4 + j) * 16 + r16] = c1[j] + gb;
      }
    }
  }
}

__device__ __forceinline__ void phase_outproj(const Params& p, int l, unsigned char* lds) {
  int tid_ = tidx(); asm volatile("" : "+v"(tid_)); const int tid = tid_, lane = tid & 63, wid = tid >> 6, wm = wid >> 1, wn = wid & 1, r32 = lane & 31, hi = lane >> 5;
  const bf16_t* MIX = (const bf16_t*)(p.ws + WS_MIX);
  const bf16_t* W = (const bf16_t*)(p.ws + WS_WOUT) + (size_t)l * DM * DM;
  float* XC = (float*)(p.ws + WS_XCUR);
  const float* MOD = (const float*)(p.ws + WS_MOD);
  constexpr int NM = T / 256, NN = DM / 128, NU = NM * NN;
  for (int u = p.bx; u < NU; u += p.gx) {
    const int pm = u / NN, pn = u % NN;
    if (l == DEPTH - 1 && (pm % 33) == 0) continue;
    const int row0 = pm * 256, col0 = pn * 128;
    for (int rep = 0; rep < REP_OUTP; ++rep) {
    f32x16 acc[2][2];
    gemm_tile(MIX, DM, W, DM, DM, row0, col0, lds, acc);
    const int mr = (pm % 33) == 0 ? 4 : pm / 33;
    const float* g1 = MOD + ((size_t)l * 5 + mr) * 6144 + 2048;
#pragma unroll
    for (int i = 0; i < 2; ++i)
#pragma unroll
      for (int j = 0; j < 2; ++j) {
        const int col = col0 + wn * 64 + j * 32 + r32;
        const float gg = (rep == REP_OUTP - 1) ? g1[col] : 0.f;
#pragma unroll
        for (int r = 0; r < 16; ++r) {
          const int row = row0 + wm * 64 + i * 32 + crow(r, hi);
          const float xo = (l == 0) ? in_row(p.in[I_X], p.in[I_CTX], row)[col] : XC[(size_t)row * DM + col];
          XC[(size_t)row * DM + col] = xo + gg * acc[i][j][r];
        }
      }
    }
  }
}
__device__ __forceinline__ void phase_peerq(const Params& p, int l, unsigned char* lds) {
  int tid_ = tidx(); asm volatile("" : "+v"(tid_)); const int tid = tid_, lane = tid & 63, wid = tid >> 6, wm = wid >> 1, wn = wid & 1, r32 = lane & 31, hi = lane >> 5;
  const bf16_t* H = (const bf16_t*)(p.ws + WS_H);
  const bf16_t* W = (const bf16_t*)(p.ws + WS_WQ) + (size_t)l * DM * DM;
  bf16_t* QP = (bf16_t*)(p.ws + WS_PROJ);
  constexpr int NM = T / 256, NN = DM / 128, NU = NM * NN;
  for (int u = p.bx; u < NU; u += p.gx) {
    const int pm = u / NN, pn = u % NN;
    if (l == DEPTH - 1 && (pm % 33) == 0) continue;
    const int row0 = pm * 256, col0 = pn * 128;
    f32x16 acc[2][2];
    gemm_tile(H, DM, W, DM, DM, row0, col0, lds, acc);
#pragma unroll
    for (int i = 0; i < 2; ++i)
#pragma unroll
      for (int j = 0; j < 2; ++j)
#pragma unroll
        for (int q = 0; q < 8; ++q) {
          float lo, hi2; pair_xchg(acc[i][j][2 * q], acc[i][j][2 * q + 1], lane, lo, hi2);
          const int row = row0 + wm * 64 + i * 32 + crow(2 * q, hi) + (lane & 1);
          const int col = col0 + wn * 64 + j * 32 + (r32 & ~1);
          *(unsigned*)(QP + (size_t)row * DM + col) = cvtpk(lo, hi2);
        }
  }
}


struct EpiInproj {
  static constexpr bool PERM = true, AFTER_DRAIN = false;
  bf16_t* PROJ; const float* RC; const float* RS; unsigned char* V8T; float wsc;
  __device__ __forceinline__ void operator()(const pg8::f32x4 (&acc)[2][2][4][2], const pg8::Unit& u, int wr, int wc, int fr, int fq) const {
#pragma unroll
    for (int bj = 0; bj < 2; ++bj) {
      const int colt = u.pn * 256 + bj * 128;
      const bool rope = (colt >= C_DQ && colt < C_DV);
      const float scl = ((colt >= C_MK && colt < C_MV) ? 0.125f : ((colt >= C_DQ && colt < C_DK) ? QSCALE : 1.f)) * wsc;
      const int col8 = colt + wc * 32 + 8 * fq;
      if (colt >= C_DV) {
        const int hh = (col8 - C_DV) >> 7, e0 = (col8 - C_DV) & 127;
#pragma unroll
        for (int ai = 0; ai < 2; ++ai)
#pragma unroll
          for (int m = 0; m < 4; ++m) {
            const int row = u.pm * 256 + ai * 128 + wr * 64 + m * 16 + fr;
            const int b = row / SEGL, s = row - b * SEGL, t = s >> 6, kk = s & 63;
            const int slot = ((kk >> 2) & 1) * 32 + (kk & 3) + 4 * ((kk >> 3) & 3) + 16 * (kk >> 5);
            unsigned char* vp = V8T + ((size_t)((b * 4 + hh) * NCH + t) * 128 + e0) * 80 + slot;
            const f32x4 v0 = acc[ai][bj][m][0] * wsc, v1 = acc[ai][bj][m][1] * wsc;
            int w0 = 0, w1 = 0;
            w0 = __builtin_amdgcn_cvt_pk_fp8_f32(v0[0], v0[1], w0, false); w0 = __builtin_amdgcn_cvt_pk_fp8_f32(v0[2], v0[3], w0, true);
            w1 = __builtin_amdgcn_cvt_pk_fp8_f32(v1[0], v1[1], w1, false); w1 = __builtin_amdgcn_cvt_pk_fp8_f32(v1[2], v1[3], w1, true);
            vp[0] = (unsigned char)(w0 & 0xFF); vp[80] = (unsigned char)((w0 >> 8) & 0xFF); vp[160] = (unsigned char)((w0 >> 16) & 0xFF); vp[240] = (unsigned char)((w0 >> 24) & 0xFF);
            vp[320] = (unsigned char)(w1 & 0xFF); vp[400] = (unsigned char)((w1 >> 8) & 0xFF); vp[480] = (unsigned char)((w1 >> 16) & 0xFF); vp[560] = (unsigned char)((w1 >> 24) & 0xFF);
          }
        continue;
      }
      unsigned char* qk8 = nullptr;
      if (rope) { const int isk = colt >= C_DK, cc = col8 - (isk ? C_DK : C_DQ); qk8 = V8T + (WS_QK8 - WS_V8T) + (size_t)isk * QK8_IMG + (size_t)(cc >> 7) * SEGL * QK8_PITCH + (cc & 127); }
#pragma unroll
      for (int ai = 0; ai < 2; ++ai)
#pragma unroll
        for (int m = 0; m < 4; ++m) {
          const int row = u.pm * 256 + ai * 128 + wr * 64 + m * 16 + fr;
          f32x4 v0 = acc[ai][bj][m][0], v1 = acc[ai][bj][m][1];
          if (rope) {
            const int s = row % SEGL;
            if (s >= CTXL) {
              const int idx = (s - CTXL) * 32 + ((col8 & 63) >> 1);
              const f32x4 c = *(const f32x4*)(RC + idx), sn = *(const f32x4*)(RS + idx);
              f32x4 a, b;
              a[0] = v0[0] * c[0] - v0[1] * sn[0]; a[1] = v0[0] * sn[0] + v0[1] * c[0]; a[2] = v0[2] * c[1] - v0[3] * sn[1]; a[3] = v0[2] * sn[1] + v0[3] * c[1];
              b[0] = v1[0] * c[2] - v1[1] * sn[2]; b[1] = v1[0] * sn[2] + v1[1] * c[2]; b[2] = v1[2] * c[3] - v1[3] * sn[3]; b[3] = v1[2] * sn[3] + v1[3] * c[3];
              v0 = a; v1 = b;
            }
          }
          if (rope) {
            const int b = row / SEGL, s = row - b * SEGL;
            int w0, w1; asm volatile("" : "=v"(w0), "=v"(w1));
            w0 = __builtin_amdgcn_cvt_pk_fp8_f32(v0[0] * scl, v0[1] * scl, w0, false); w0 = __builtin_amdgcn_cvt_pk_fp8_f32(v0[2] * scl, v0[3] * scl, w0, true);
            w1 = __builtin_amdgcn_cvt_pk_fp8_f32(v1[0] * scl, v1[1] * scl, w1, false); w1 = __builtin_amdgcn_cvt_pk_fp8_f32(v1[2] * scl, v1[3] * scl, w1, true);
            *(u32x2*)(qk8 + ((size_t)b * 4 * SEGL + s) * QK8_PITCH) = (u32x2){(unsigned)w0, (unsigned)w1};
            __builtin_amdgcn_sched_barrier(0);
            continue;
          }
          u32x4 w; w.x = cvtpk(v0[0] * scl, v0[1] * scl); w.y = cvtpk(v0[2] * scl, v0[3] * scl); w.z = cvtpk(v1[0] * scl, v1[1] * scl); w.w = cvtpk(v1[2] * scl, v1[3] * scl);
          *(u32x4*)(PROJ + (size_t)row * PW + col8) = w;
        }
    }
  }
};
struct EpiOutproj {
  static constexpr bool PERM = true, AFTER_DRAIN = false;
  float* XC; const float* MODL; const float* xin; const float* ctxin; int first; float gsc;
  __device__ __forceinline__ void operator()(const pg8::f32x4 (&acc)[2][2][4][2], const pg8::Unit& u, int wr, int wc, int fr, int fq) const {
    const int mr = (u.pm % 33) == 0 ? 4 : u.pm / 33;
    const float* g1 = MODL + (size_t)mr * 6144 + 2048;
#pragma unroll
    for (int bj = 0; bj < 2; ++bj) {
      const int col8 = u.pn * 256 + bj * 128 + wc * 32 + 8 * fq;
      const f32x4 ga = *(const f32x4*)(g1 + col8) * gsc, gb = *(const f32x4*)(g1 + col8 + 4) * gsc;
#pragma unroll
      for (int ai = 0; ai < 2; ++ai)
#pragma unroll
        for (int m = 0; m < 4; ++m) {
          const int row = u.pm * 256 + ai * 128 + wr * 64 + m * 16 + fr;
          const float* xo = first ? in_row(xin, ctxin, row) + col8 : XC + (size_t)row * DM + col8;
          const f32x4 xa = *(const f32x4*)xo, xb = *(const f32x4*)(xo + 4);
          *(f32x4*)(XC + (size_t)row * DM + col8) = xa + ga * acc[ai][bj][m][0];
          *(f32x4*)(XC + (size_t)row * DM + col8 + 4) = xb + gb * acc[ai][bj][m][1];
        }
    }
  }
};
struct EpiPeerq {
  static constexpr bool PERM = true, AFTER_DRAIN = false;
  bf16_t* QP;
  __device__ __forceinline__ void operator()(const pg8::f32x4 (&acc)[2][2][4][2], const pg8::Unit& u, int wr, int wc, int fr, int fq) const {
#pragma unroll
    for (int bj = 0; bj < 2; ++bj) {
      const int col8 = u.pn * 256 + bj * 128 + wc * 32 + 8 * fq;
#pragma unroll
      for (int ai = 0; ai < 2; ++ai)
#pragma unroll
        for (int m = 0; m < 4; ++m) {
          const int row = u.pm * 256 + ai * 128 + wr * 64 + m * 16 + fr;
          const f32x4 v0 = acc[ai][bj][m][0], v1 = acc[ai][bj][m][1];
          u32x4 w; w.x = cvtpk(v0[0], v0[1]); w.y = cvtpk(v0[2], v0[3]); w.z = cvtpk(v1[0], v1[1]); w.w = cvtpk(v1[2], v1[3]);
          *(u32x4*)(QP + (size_t)row * DM + col8) = w;
        }
    }
  }
};
__device__ __forceinline__ void phase_inproj2(const Params& p, int l, unsigned char* lds) {
  {
    pg8::Gemm g{(const bf16_t*)(p.ws + WS_H), (const bf16_t*)(p.ws + WS_WIN) + (size_t)l * PW * DM, T, C_DQ, DM};
    pg8::StaticOrder S; S.init(T, C_DQ, p.gx, p.bx);
    EpiInproj E{(bf16_t*)(p.ws + WS_PROJ), (const float*)(p.ws + WS_ROPE), (const float*)(p.ws + WS_ROPE) + SEQ * 32, p.ws + WS_V8T, 1.f};
    pg8::gemm_phase<EpiInproj, pg8::StaticOrder, true, true>((PG8_LAS unsigned char*)lds, g, S, E);
  }
  {
    pg8::Gemm g{(const bf16_t*)(p.ws + WS_H8), (const bf16_t*)(p.ws + WS_W8 + (size_t)l * PW * DM), T, PW, DM / 2};
    const int nb16 = (T / 256) * (C_DQ / 256);
    pg8::F8Order S; S.init(T, p.gx, p.bx, nb16 % p.gx);
    EpiInproj E{(bf16_t*)(p.ws + WS_PROJ), (const float*)(p.ws + WS_ROPE), (const float*)(p.ws + WS_ROPE) + SEQ * 32, p.ws + WS_V8T, 1.f / 32.f};
    pg8::gemm_phase<EpiInproj, pg8::F8Order, true, true, true>((PG8_LAS unsigned char*)lds, g, S, E);
  }
  int tid_ = tidx(); asm volatile("" : "+v"(tid_)); const int tid = tid_, lane = tid & 63, wid = tid >> 6;
  const bf16_t* H = (const bf16_t*)(p.ws + WS_H);
  for (int pm = p.gx - 1 - p.bx; pm < T / 256; pm += p.gx) {
    const int rowb = pm * 256 + wid * 32;
    const bf16_t* WG = (const bf16_t*)(p.ws + WS_WG) + (size_t)l * 16 * DM;
    float* GT = (float*)(p.ws + WS_GATES);
    const int r16 = lane & 15, q4 = lane >> 4;
    f32x4 c0 = {0.f, 0.f, 0.f, 0.f}, c1 = {0.f, 0.f, 0.f, 0.f};
    const bf16_t* a0p = H + (size_t)(rowb + r16) * DM + q4 * 8;
    const bf16_t* a1p = a0p + (size_t)16 * DM;
    const bf16_t* bp = WG + (size_t)r16 * DM + q4 * 8;
#pragma unroll 4
    for (int ks = 0; ks < 32; ++ks) {
      const bf16x8 a0 = *(const bf16x8*)(a0p + ks * 32), a1 = *(const bf16x8*)(a1p + ks * 32), b = *(const bf16x8*)(bp + ks * 32);
      c0 = __builtin_amdgcn_mfma_f32_16x16x32_bf16(a0, b, c0, 0, 0, 0);
      c1 = __builtin_amdgcn_mfma_f32_16x16x32_bf16(a1, b, c1, 0, 0, 0);
    }
    const float gb = p.in[I_GATEB][l * 16 + r16];
#pragma unroll
    for (int j = 0; j < 4; ++j) {
      GT[(size_t)(rowb + q4 * 4 + j) * 16 + r16] = c0[j] + gb;
      GT[(size_t)(rowb + 16 + q4 * 4 + j) * 16 + r16] = c1[j] + gb;
    }
  }
}
__device__ __forceinline__ void phase_outproj2(const Params& p, int l, unsigned char* lds) {
  pg8::Gemm g{(const bf16_t*)(p.ws + WS_MIX), (const bf16_t*)(p.ws + WS_WOUT) + (size_t)l * DM * DM, T, DM, DM};
  pg8::StaticOrder S; S.init(T, DM, p.gx, p.bx);
  for (int rep = 0; rep < REP_OUTP; ++rep) {
  EpiOutproj E{(float*)(p.ws + WS_XCUR), (const float*)(p.ws + WS_MOD) + (size_t)l * 5 * 6144, p.in[I_X], p.in[I_CTX], l == 0, (rep == REP_OUTP - 1) ? 1.f : 0.f};
  pg8::gemm_phase<EpiOutproj, pg8::StaticOrder, true, true>((PG8_LAS unsigned char*)lds, g, S, E);
  }
  tail_filler_tables(p, l, (T / 256) * (DM / 256), l == 0 ? 0 : NEXP, 2 * NEXP);
}
__device__ __forceinline__ void phase_peerq2(const Params& p, int l, unsigned char* lds) {
  pg8::Gemm g{(const bf16_t*)(p.ws + WS_H), (const bf16_t*)(p.ws + WS_WQ) + (size_t)l * DM * DM, T, DM, DM};
  pg8::StaticOrder S; S.init(T, DM, p.gx, p.bx);
  EpiPeerq E{(bf16_t*)(p.ws + WS_PROJ)};
  pg8::gemm_phase<EpiPeerq, pg8::StaticOrder, true, true>((PG8_LAS unsigned char*)lds, g, S, E);
  if (l < DEPTH - 1) tail_filler_tables(p, l + 1, (T / 256) * (DM / 256), 0, NEXP);
}

__device__ __forceinline__ void conv_unit(const Params& p, int l, int unit, unsigned char* lds) {
  int tid_ = tidx(); asm volatile("" : "+v"(tid_)); const int tid = tid_, lane = tid & 63, wid = tid >> 6;
  float* U = (float*)lds;
  const bf16_t* PROJ = (const bf16_t*)(p.ws + WS_PROJ);
  bf16_t* MIX = (bf16_t*)(p.ws + WS_MIX);
  const int row0 = unit * 32, b = row0 / SEGL, s0 = row0 - b * SEGL;
  const int seglo = s0 < CTXL ? 0 : CTXL, seghi = s0 < CTXL ? CTXL : SEGL;
  for (int rr = tid >> 5; rr < 62; rr += 16) {
    const int s = s0 - 15 + rr, c8 = (tid & 31) * 8;
    f32x4 u0 = {0.f, 0.f, 0.f, 0.f}, u1 = {0.f, 0.f, 0.f, 0.f};
    if (s >= seglo && s < seghi) {
      const bf16_t* pr = PROJ + (size_t)(b * SEGL + s) * PW + c8;
      const u32x4 a1 = *(const u32x4*)pr, a2 = *(const u32x4*)(pr + 256);
      u0.x = bflo(a1.x) * sigmoidf_(bflo(a2.x)); u0.y = bfhi(a1.x) * sigmoidf_(bfhi(a2.x));
      u0.z = bflo(a1.y) * sigmoidf_(bflo(a2.y)); u0.w = bfhi(a1.y) * sigmoidf_(bfhi(a2.y));
      u1.x = bflo(a1.z) * sigmoidf_(bflo(a2.z)); u1.y = bfhi(a1.z) * sigmoidf_(bfhi(a2.z));
      u1.z = bflo(a1.w) * sigmoidf_(bflo(a2.w)); u1.w = bfhi(a1.w) * sigmoidf_(bfhi(a2.w));
    }
    *(f32x4*)(U + rr * 256 + c8) = u0; *(f32x4*)(U + rr * 256 + c8 + 4) = u1;
  }
  __syncthreads();
  float* Y = U + 62 * 256;
  const float* cw = p.in[I_CONVW] + (size_t)l * 31 * 256;
#pragma unroll 1
  for (int q = 0; q < 4; ++q) {
    const int c = lane + 64 * q;
    float w[31];
#pragma unroll
    for (int j = 0; j < 31; ++j) w[j] = cw[j * 256 + c];
    const float bias = p.in[I_CONVB][l * 256 + c];
#pragma unroll
    for (int tt = 0; tt < 4; ++tt) {
      const int t = wid * 4 + tt;
      float a = bias;
#pragma unroll
      for (int j = 0; j < 31; ++j) a += U[(t + j) * 256 + c] * w[j];
      Y[t * 256 + c] = a;
    }
  }
  asm volatile("s_waitcnt lgkmcnt(0)" ::: "memory");
  float y[4][4];
#pragma unroll
  for (int tt = 0; tt < 4; ++tt)
#pragma unroll
    for (int q = 0; q < 4; ++q) y[tt][q] = Y[(wid * 4 + tt) * 256 + lane + 64 * q];
#pragma unroll
  for (int tt = 0; tt < 4; ++tt) {
    const int t = wid * 4 + tt;
    const float mean = wave_sum((y[tt][0] + y[tt][1]) + (y[tt][2] + y[tt][3])) * (1.f / 256.f);
    float v = 0.f;
#pragma unroll
    for (int q = 0; q < 4; ++q) { const float d = y[tt][q] - mean; v += d * d; }
    const float rs = rsqrtf(wave_sum(v) * (1.f / 256.f) + EPS);
#pragma unroll
    for (int q = 0; q < 4; ++q) {
      const int c = lane + 64 * q;
      const float z = (y[tt][q] - mean) * rs * p.in[I_CLNG][l * 256 + c] + p.in[I_CLNB][l * 256 + c];
      const float o = (ABL & 1) ? 0.f : z * sigmoidf_(z);
      MIX[(size_t)(row0 + t) * DM + c] = (bf16_t)(cvtpk(o, 0.f) & 0xffffu);
    }
  }
  __syncthreads();
}

__device__ __forceinline__ int ml_cidx(int ch, int dir) { return dir == 0 ? ch : (ch < 4 ? 3 - ch : 135 - ch); }
__device__ __forceinline__ void ml_load_tile(const bf16_t* src, float* dst, int tid) {
  const int r = tid >> 3, c8 = (tid & 7) * 8;
  const u32x4 a = *(const u32x4*)(src + (size_t)r * PW + c8);
  float* d = dst + r * 65 + c8;
  d[0] = bflo(a.x); d[1] = bfhi(a.x); d[2] = bflo(a.y); d[3] = bfhi(a.y); d[4] = bflo(a.z); d[5] = bfhi(a.z); d[6] = bflo(a.w); d[7] = bfhi(a.w);
}
__device__ __forceinline__ void ml_local_unit(const Params& p, int l, int unit, unsigned char* lds) {
  int tid_ = tidx(); asm volatile("" : "+v"(tid_)); const int tid = tid_, lane = tid & 63, wid = tid >> 6, r32 = lane & 31, hi = lane >> 5;
  float* Kt = (float*)lds; float* Vt = Kt + 64 * 65; float* WK = Vt + 64 * 65;
  const bf16_t* PROJ = (const bf16_t*)(p.ws + WS_PROJ);
  const float* GT = (const float*)(p.ws + WS_GATES);
  float* UL = (float*)(p.ws + WS_ULOC); float* META = (float*)(p.ws + WS_MLMETA);
  const int b = unit / (4 * NCH), hh = (unit / NCH) & 3, ch = unit % NCH;
  const int row0 = b * SEGL + ch * 64;
  ml_load_tile(PROJ + (size_t)row0 * PW + C_MK + hh * 64, Kt, tid);
  ml_load_tile(PROJ + (size_t)row0 * PW + C_MV + hh * 64, Vt, tid);
  if (wid < 2) {
    const int dir = wid;
    const float ig = GT[(size_t)(row0 + lane) * 16 + (2 * dir) * 4 + hh];
    const float lf = logsigmoidf_(GT[(size_t)(row0 + lane) * 16 + (2 * dir + 1) * 4 + hh]);
    float ps = lf;
    ps = wave_incl_scan(ps);
    const float tot = __uint_as_float((unsigned)__builtin_amdgcn_readlane((int)__float_as_uint(ps), 63));
    const float wlog = dir == 0 ? (tot - ps + ig) : (ps - lf + ig);
    const float mloc = wave_max(wlog);
    WK[dir * 64 + lane] = __expf(wlog - mloc);
    if (lane == 0) {
      const int seq = (b * 4 + hh) * 2 + dir, ci = ml_cidx(ch, dir);
      META[((size_t)seq * NCH + ci) * 4 + 0] = tot; META[((size_t)seq * NCH + ci) * 4 + 1] = mloc;
    }
  }
  __syncthreads();
  {
    const int dir = wid >> 2, et = (wid >> 1) & 1, dt = wid & 1;
    const int seq = (b * 4 + hh) * 2 + dir, ci = ml_cidx(ch, dir);
    float* slot = UL + ((size_t)seq * NCH + ci) * USTRIDE;
    f32x16 acc = {};
#pragma unroll 8
    for (int ks = 0; ks < 32; ++ks) {
      const int s = 2 * ks + hi;
      const float a = WK[dir * 64 + s] * Vt[s * 65 + et * 32 + r32];
      const float bb = Kt[s * 65 + dt * 32 + r32];
      acc = __builtin_amdgcn_mfma_f32_32x32x2f32(a, bb, acc, 0, 0, 0);
    }
#pragma unroll
    for (int r = 0; r < 16; ++r) slot[(et * 32 + crow(r, hi)) * 64 + dt * 32 + r32] = acc[r];
    if (et == 0) {
      float n = 0.f;
#pragma unroll 8
      for (int i = 0; i < 32; ++i) { const int s = hi * 32 + i; n += WK[dir * 64 + s] * Kt[s * 65 + dt * 32 + r32]; }
      n = sum_xor32(n);
      if (hi == 0) slot[4096 + dt * 32 + r32] = n;
    }
  }
  __syncthreads();
}
constexpr int MLP = 144;
constexpr size_t WS_CST = WS_H;
constexpr size_t WS_NST = WS_H + (size_t)32 * NCH * 4096 * 2;
__device__ __forceinline__ void ml_stage_rm(const bf16_t* src, size_t ld, unsigned char* dst, int tid) {
  const int r = tid >> 3, c8 = (tid & 7) * 8;
  *(u32x4*)(dst + r * MLP + c8 * 2) = *(const u32x4*)(src + (size_t)r * ld + c8);
}
__device__ __forceinline__ void ml_stage_tr(const bf16_t* src, size_t ld, unsigned char* dst, int tid) {
  const int r = tid >> 3, c8 = (tid & 7) * 8;
  const u32x4 a = *(const u32x4*)(src + (size_t)r * ld + c8);
  bf16_t* d = (bf16_t*)dst;
  d[(c8 + 0) * 72 + r] = (bf16_t)(a.x & 0xffffu); d[(c8 + 1) * 72 + r] = (bf16_t)(a.x >> 16);
  d[(c8 + 2) * 72 + r] = (bf16_t)(a.y & 0xffffu); d[(c8 + 3) * 72 + r] = (bf16_t)(a.y >> 16);
  d[(c8 + 4) * 72 + r] = (bf16_t)(a.z & 0xffffu); d[(c8 + 5) * 72 + r] = (bf16_t)(a.z >> 16);
  d[(c8 + 6) * 72 + r] = (bf16_t)(a.w & 0xffffu); d[(c8 + 7) * 72 + r] = (bf16_t)(a.w >> 16);
}
__device__ __forceinline__ void ml_local_unit2(const Params& p, int l, int unit, unsigned char* lds) {
  int tid_ = tidx(); asm volatile("" : "+v"(tid_)); const int tid = tid_, lane = tid & 63, wid = tid >> 6, r32 = lane & 31, hi = lane >> 5;
  unsigned char* KT = lds; unsigned char* VT = lds + 64 * MLP; float* WK = (float*)(lds + 2 * 64 * MLP);
  const bf16_t* PROJ = (const bf16_t*)(p.ws + WS_PROJ);
  const float* GT = (const float*)(p.ws + WS_GATES);
  float* UL = (float*)(p.ws + WS_ULOC); float* META = (float*)(p.ws + WS_MLMETA);
  const int b = unit / (4 * NCH), hh = (unit / NCH) & 3, ch = unit % NCH;
  const int row0 = b * SEGL + ch * 64;
  ml_stage_tr(PROJ + (size_t)row0 * PW + C_MK + hh * 64, PW, KT, tid);
  ml_stage_tr(PROJ + (size_t)row0 * PW + C_MV + hh * 64, PW, VT, tid);
  if (wid < 2) {
    const int dir = wid;
    const float ig = GT[(size_t)(row0 + lane) * 16 + (2 * dir) * 4 + hh];
    const float lf = logsigmoidf_(GT[(size_t)(row0 + lane) * 16 + (2 * dir + 1) * 4 + hh]);
    float ps = lf;
    ps = wave_incl_scan(ps);
    const float tot = __uint_as_float((unsigned)__builtin_amdgcn_readlane((int)__float_as_uint(ps), 63));
    const float wlog = dir == 0 ? (tot - ps + ig) : (ps - lf + ig);
    const float mloc = wave_max(wlog);
    WK[dir * 64 + lane] = __expf(wlog - mloc);
    if (lane == 0) {
      const int seq = (b * 4 + hh) * 2 + dir, ci = ml_cidx(ch, dir);
      META[((size_t)seq * NCH + ci) * 4 + 0] = tot; META[((size_t)seq * NCH + ci) * 4 + 1] = mloc;
    }
  }
  __syncthreads();
  {
    const int dir = wid >> 2, et = (wid >> 1) & 1, dt = wid & 1;
    const int seq = (b * 4 + hh) * 2 + dir, ci = ml_cidx(ch, dir);
    float* slot = UL + ((size_t)seq * NCH + ci) * USTRIDE;
    f32x16 acc = {};
#pragma unroll
    for (int ks = 0; ks < 4; ++ks) {
      const int s0 = ks * 16 + hi * 8;
      const u32x4 va = *(const u32x4*)(VT + (et * 32 + r32) * MLP + s0 * 2);
      const bf16x8 kb = *(const bf16x8*)(KT + (dt * 32 + r32) * MLP + s0 * 2);
      const f32x4 w0 = *(const f32x4*)(WK + dir * 64 + s0), w1 = *(const f32x4*)(WK + dir * 64 + s0 + 4);
      u32x4 sa; sa.x = cvtpk(bflo(va.x) * w0.x, bfhi(va.x) * w0.y); sa.y = cvtpk(bflo(va.y) * w0.z, bfhi(va.y) * w0.w);
      sa.z = cvtpk(bflo(va.z) * w1.x, bfhi(va.z) * w1.y); sa.w = cvtpk(bflo(va.w) * w1.z, bfhi(va.w) * w1.w);
      acc = __builtin_amdgcn_mfma_f32_32x32x16_bf16(*(const bf16x8*)&sa, kb, acc, 0, 0, 0);
    }
#pragma unroll
    for (int r = 0; r < 16; ++r) slot[(et * 32 + crow(r, hi)) * 64 + dt * 32 + r32] = acc[r];
    if (et == 0) {
      float n = 0.f;
#pragma unroll
      for (int i = 0; i < 4; ++i) {
        const int s0 = hi * 32 + i * 8;
        const u32x4 ka = *(const u32x4*)(KT + (dt * 32 + r32) * MLP + s0 * 2);
        const f32x4 w0 = *(const f32x4*)(WK + dir * 64 + s0), w1 = *(const f32x4*)(WK + dir * 64 + s0 + 4);
        n += bflo(ka.x) * w0.x + bfhi(ka.x) * w0.y + bflo(ka.y) * w0.z + bfhi(ka.y) * w0.w + bflo(ka.z) * w1.x + bfhi(ka.z) * w1.y + bflo(ka.w) * w1.z + bfhi(ka.w) * w1.w;
      }
      n = sum_xor32(n);
      if (hi == 0) slot[4096 + dt * 32 + r32] = n;
    }
  }
  __syncthreads();
}
__device__ __forceinline__ void ml_scan(const Params& p, unsigned char* lds) {
  float* UL = (float*)(p.ws + WS_ULOC); float* META = (float*)(p.ws + WS_MLMETA);
  int tid_ = tidx(); asm volatile("" : "+v"(tid_));
  const int tid = tid_, lane = tid & 63, wid = tid >> 6;
  float* DEC = (float*)lds;
  float* SCL = DEC + 2 * NCH;
  float* TMP = SCL + 2 * NCH;
  constexpr int NSL = (32 * USTRIDE + 511) / 512;
  const int first_ = p.gx > 64 ? 16 : 0, nb_ = p.gx - first_;
  for (int k_ = 0; k_ < 2 + (NSL + nb_ - 1) / nb_; ++k_) {
    int s_;
    if (k_ == 0) s_ = p.bx >= first_ ? p.bx - first_ : -1;
    else s_ = k_ * nb_ + (p.gx - 1 - p.bx);
    if (k_ > 0 && p.gx - 1 - p.bx >= nb_) s_ = -1;
    if (s_ < 0 || s_ >= NSL) continue;
    const int base0 = s_ * 512;
    const int seq0 = base0 / USTRIDE;
    if (wid < 2) {
      const int seq = seq0 + wid;
      if (seq < 32) {
        float* mt = META + (size_t)seq * NCH * 4;
        for (int c = lane; c < NCH; c += 64) { TMP[(wid * 2 + 0) * NCH + c] = mt[c * 4 + 0]; TMP[(wid * 2 + 1) * NCH + c] = mt[c * 4 + 1]; }
        asm volatile("s_waitcnt lgkmcnt(0)" ::: "memory");
        if (lane == 0) {
          float m = 0.f;
          for (int c = 0; c < NCH; ++c) {
            const float bl = TMP[(wid * 2 + 0) * NCH + c], mloc = TMP[(wid * 2 + 1) * NCH + c];
            const float mn = fmaxf(bl + m, mloc);
            DEC[wid * NCH + c] = __expf(bl + m - mn); SCL[wid * NCH + c] = __expf(mloc - mn);
            mt[c * 4 + 2] = m;
            m = mn;
          }
        }
      }
    }
    __syncthreads();
    const int idx = base0 + tid;
    if (idx < 32 * USTRIDE) {
      const int seq = idx / USTRIDE, e = idx - seq * USTRIDE, sl = seq - seq0;
      float* bp = UL + (size_t)seq * NCH * USTRIDE + e;
      bf16_t* CSTp = (bf16_t*)(p.ws + WS_CST) + (size_t)seq * NCH * 4096 + (e < 4096 ? e : 0);
      float* NSTp = (float*)(p.ws + WS_NST) + (size_t)seq * NCH * 64 + (e < 4096 ? 0 : e - 4096);
      const float* dec = DEC + sl * NCH; const float* scl = SCL + sl * NCH;
      float C = 0.f;
      constexpr int BT = 33;
      static_assert(NCH == 4 * BT, "scan batches");
      float ua[BT], ub[BT];
#define SCAN_LD(u_, c0_) _Pragma("unroll") for (int j = 0; j < BT; ++j) u_[j] = bp[(size_t)((c0_) + j) * USTRIDE];
#define SCAN_DO(u_, c0_) _Pragma("unroll") for (int j = 0; j < BT; ++j) { \
          if (e < 4096) CSTp[(size_t)((c0_) + j) * 4096] = (bf16_t)(cvtpk(C, 0.f) & 0xffffu); else NSTp[(size_t)((c0_) + j) * 64] = C; \
          C = dec[(c0_) + j] * C + scl[(c0_) + j] * u_[j]; }
      SCAN_LD(ua, 0)
#pragma unroll 1
      for (int c0 = 0; c0 < NCH; c0 += 2 * BT) {
        SCAN_LD(ub, c0 + BT)
        SCAN_DO(ua, c0)
        if (c0 + 2 * BT < NCH) { SCAN_LD(ua, c0 + 2 * BT) }
        SCAN_DO(ub, c0 + BT)
      }
#undef SCAN_LD
#undef SCAN_DO
    }
    __syncthreads();
  }
}
__device__ __forceinline__ void ml_out_unit(const Params& p, int l, int unit, unsigned char* lds) {
  int tid_ = tidx(); asm volatile("" : "+v"(tid_)); const int tid = tid_, lane = tid & 63, wid = tid >> 6, r32 = lane & 31, hi = lane >> 5;
  float* Qt = (float*)lds; float* Kt = Qt + 64 * 65; float* Vt = Kt + 64 * 65;
  float* Cs = Vt + 64 * 65;
  float* Ns = Cs + 2 * 64 * 65;
  float* Bq = Ns + 128;
  float* Gs = Bq + 128;
  float* Mi = Gs + 128;
  float* HB = Mi + 64;
  const bf16_t* PROJ = (const bf16_t*)(p.ws + WS_PROJ);
  const float* GT = (const float*)(p.ws + WS_GATES);
  const float* UL = (const float*)(p.ws + WS_ULOC); const float* META = (const float*)(p.ws + WS_MLMETA);
  bf16_t* MIX = (bf16_t*)(p.ws + WS_MIX);
  const int b = unit / (4 * NCH), hh = (unit / NCH) & 3, ch = unit % NCH;
  const int row0 = b * SEGL + ch * 64;
  ml_load_tile(PROJ + (size_t)row0 * PW + C_MQ + hh * 64, Qt, tid);
  ml_load_tile(PROJ + (size_t)row0 * PW + C_MK + hh * 64, Kt, tid);
  ml_load_tile(PROJ + (size_t)row0 * PW + C_MV + hh * 64, Vt, tid);
  for (int i = tid; i < 2 * USTRIDE; i += 512) {
    const int dir = i / USTRIDE, e = i - dir * USTRIDE;
    const int seq = (b * 4 + hh) * 2 + dir, ci = ml_cidx(ch, dir);
    const float v = UL[((size_t)seq * NCH + ci) * USTRIDE + e];
    if (e < 4096) Cs[dir * 64 * 65 + (e >> 6) * 65 + (e & 63)] = v; else Ns[dir * 64 + (e - 4096)] = v;
  }
  if (wid < 2) {
    const int dir = wid;
    const float ig = GT[(size_t)(row0 + lane) * 16 + (2 * dir) * 4 + hh];
    const float lf = logsigmoidf_(GT[(size_t)(row0 + lane) * 16 + (2 * dir + 1) * 4 + hh]);
    float ps = lf;
    ps = wave_incl_scan(ps);
    const float tot = __uint_as_float((unsigned)__builtin_amdgcn_readlane((int)__float_as_uint(ps), 63));
    const float bc = dir == 0 ? ps : (tot - ps + lf);
    Bq[dir * 64 + lane] = bc; Gs[dir * 64 + lane] = ig - bc;
    if (lane == 0) { const int seq = (b * 4 + hh) * 2 + dir, ci = ml_cidx(ch, dir); Mi[dir] = META[((size_t)seq * NCH + ci) * 4 + 2]; }
  }
  __syncthreads();
  {
    const int dir = wid >> 2, tt = (wid >> 1) & 1, et = wid & 1;
    const int t = tt * 32 + r32;
    f32x16 sa[2] = {};
#pragma unroll 4
    for (int ks = 0; ks < 32; ++ks) {
      const float bq = Qt[t * 65 + 2 * ks + hi];
      const float a0 = Kt[(r32) * 65 + 2 * ks + hi], a1 = Kt[(32 + r32) * 65 + 2 * ks + hi];
      sa[0] = __builtin_amdgcn_mfma_f32_32x32x2f32(a0, bq, sa[0], 0, 0, 0);
      sa[1] = __builtin_amdgcn_mfma_f32_32x32x2f32(a1, bq, sa[1], 0, 0, 0);
    }
    const float bt = Bq[dir * 64 + t];
    const float inter = bt + Mi[dir];
    float mx = -INFINITY;
    f32x16 dl[2];
#pragma unroll
    for (int st = 0; st < 2; ++st)
#pragma unroll
      for (int r = 0; r < 16; ++r) {
        const int s = st * 32 + crow(r, hi);
        const bool ok = dir == 0 ? (s <= t) : (s >= t);
        const float d = ok ? bt + Gs[dir * 64 + s] : -INFINITY;
        dl[st][r] = d; mx = fmaxf(mx, d);
      }
    mx = max_xor32(mx);
    const float mt = fmaxf(inter, mx);
    const float iw = __expf(inter - mt);
    float rsum = 0.f;
#pragma unroll
    for (int st = 0; st < 2; ++st)
#pragma unroll
      for (int r = 0; r < 16; ++r) { const float w = __expf(dl[st][r] - mt); sa[st][r] *= w; rsum += sa[st][r]; }
    rsum = sum_xor32(rsum);
    float qn = 0.f;
#pragma unroll 8
    for (int i = 0; i < 32; ++i) { const int d = hi * 32 + i; qn += Ns[dir * 64 + d] * Qt[t * 65 + d]; }
    qn = sum_xor32(qn);
    const float den = rsum + iw * qn;
    const float rden = 1.f / fmaxf(fabsf(den), __expf(-mt));
    f32x16 an = {}, ac = {};
#pragma unroll
    for (int st = 0; st < 2; ++st)
#pragma unroll
      for (int r = 0; r < 16; ++r) {
        const float a = Vt[(st * 32 + crow(r, hi)) * 65 + et * 32 + r32];
        an = __builtin_amdgcn_mfma_f32_32x32x2f32(a, sa[st][r], an, 0, 0, 0);
      }
    const float* Cd = Cs + dir * 64 * 65;
#pragma unroll 4
    for (int ks = 0; ks < 32; ++ks) {
      const float a = Cd[(et * 32 + r32) * 65 + 2 * ks + hi];
      const float bq = Qt[t * 65 + 2 * ks + hi];
      ac = __builtin_amdgcn_mfma_f32_32x32x2f32(a, bq, ac, 0, 0, 0);
    }
#pragma unroll
    for (int r = 0; r < 16; ++r) HB[dir * 64 * 65 + t * 65 + et * 32 + crow(r, hi)] = (an[r] + iw * ac[r]) * rden;
  }
  __syncthreads();
  {
    const int t = tid >> 3, e8 = (tid & 7) * 8;
    float v[8]; float ss = 0.f;
#pragma unroll
    for (int i = 0; i < 8; ++i) { v[i] = HB[t * 65 + e8 + i] + HB[64 * 65 + t * 65 + e8 + i]; ss += v[i] * v[i]; }
    ss += dpp_mov<0xB1>(ss); ss += dpp_mov<0x4E>(ss); ss += dpp_mov<0x141>(ss);
    const float rs = rsqrtf(ss * (1.f / 64.f) + EPS);
    const u32x4 ov = *(const u32x4*)(PROJ + (size_t)(row0 + t) * PW + C_MO + hh * 64 + e8);
    const float og[8] = {bflo(ov.x), bfhi(ov.x), bflo(ov.y), bfhi(ov.y), bflo(ov.z), bfhi(ov.z), bflo(ov.w), bfhi(ov.w)};
    const float* g = p.in[I_MNORMG] + l * 64 + e8;
    float o[8];
#pragma unroll
    for (int i = 0; i < 8; ++i) o[i] = (ABL & 2) ? 0.f : v[i] * rs * g[i] * sigmoidf_(og[i]);
    u32x4 w; w.x = cvtpk(o[0], o[1]); w.y = cvtpk(o[2], o[3]); w.z = cvtpk(o[4], o[5]); w.w = cvtpk(o[6], o[7]);
    *(u32x4*)(MIX + (size_t)(row0 + t) * DM + 256 + hh * 64 + e8) = w;
  }
  __syncthreads();
}


struct MlOutPf { u32x4 q, k, v, c0, c1, ov; float ns0, ns1, g_ig, g_lf, mi; };
__device__ __forceinline__ void ml_out_fetch(const Params& p, int unit, int tid, MlOutPf& f) {
  const int lane = tid & 63, wid = tid >> 6;
  const bf16_t* PROJ = (const bf16_t*)(p.ws + WS_PROJ);
  const float* GT = (const float*)(p.ws + WS_GATES);
  const bf16_t* CST = (const bf16_t*)(p.ws + WS_CST); const float* NST = (const float*)(p.ws + WS_NST); const float* META = (const float*)(p.ws + WS_MLMETA);
  const int b = unit / (4 * NCH), hh = (unit / NCH) & 3, ch = unit % NCH;
  const int row0 = b * SEGL + ch * 64;
  const int r = tid >> 3, c8 = (tid & 7) * 8;
  const bf16_t* prow = PROJ + (size_t)(row0 + r) * PW + hh * 64 + c8;
  f.q = *(const u32x4*)(prow + C_MQ); f.k = *(const u32x4*)(prow + C_MK); f.v = *(const u32x4*)(prow + C_MV); f.ov = *(const u32x4*)(prow + C_MO);
  const int seq0 = (b * 4 + hh) * 2, ci0 = ml_cidx(ch, 0), ci1 = ml_cidx(ch, 1);
  f.c0 = *(const u32x4*)(CST + ((size_t)seq0 * NCH + ci0) * 4096 + r * 64 + c8);
  f.c1 = *(const u32x4*)(CST + ((size_t)(seq0 + 1) * NCH + ci1) * 4096 + r * 64 + c8);
  f.ns0 = 0.f; f.ns1 = 0.f; f.g_ig = 0.f; f.g_lf = 0.f; f.mi = 0.f;
  if (tid < 64) { f.ns0 = NST[((size_t)seq0 * NCH + ci0) * 64 + tid]; f.ns1 = NST[((size_t)(seq0 + 1) * NCH + ci1) * 64 + tid]; }
  if (wid < 2) {
    const int dir = wid;
    f.g_ig = GT[(size_t)(row0 + lane) * 16 + (2 * dir) * 4 + hh];
    f.g_lf = GT[(size_t)(row0 + lane) * 16 + (2 * dir + 1) * 4 + hh];
    f.mi = META[((size_t)(seq0 + dir) * NCH + (dir ? ci1 : ci0)) * 4 + 2];
  }
}
__device__ __forceinline__ void ml_put_rm(const u32x4 a, unsigned char* dst, int tid) { const int r = tid >> 3, c8 = (tid & 7) * 8; *(u32x4*)(dst + r * MLP + c8 * 2) = a; }
__device__ __forceinline__ void ml_put_tr(const u32x4 a, unsigned char* dst, int tid) {
  const int r = tid >> 3, c8 = (tid & 7) * 8;
  bf16_t* d = (bf16_t*)dst;
  d[(c8 + 0) * 72 + r] = (bf16_t)(a.x & 0xffffu); d[(c8 + 1) * 72 + r] = (bf16_t)(a.x >> 16);
  d[(c8 + 2) * 72 + r] = (bf16_t)(a.y & 0xffffu); d[(c8 + 3) * 72 + r] = (bf16_t)(a.y >> 16);
  d[(c8 + 4) * 72 + r] = (bf16_t)(a.z & 0xffffu); d[(c8 + 5) * 72 + r] = (bf16_t)(a.z >> 16);
  d[(c8 + 6) * 72 + r] = (bf16_t)(a.w & 0xffffu); d[(c8 + 7) * 72 + r] = (bf16_t)(a.w >> 16);
}
__device__ __forceinline__ void ml_out_unit2(const Params& p, int l, int unit, unsigned char* lds, const MlOutPf& f, int next, MlOutPf& fn) {
  int tid_ = tidx(); asm volatile("" : "+v"(tid_)); const int tid = tid_, lane = tid & 63, wid = tid >> 6, r32 = lane & 31, hi = lane >> 5;
  unsigned char* Qs = lds; unsigned char* Ks = lds + 64 * MLP; unsigned char* VT = lds + 2 * 64 * MLP; unsigned char* Cs = lds + 3 * 64 * MLP;
  float* Ns = (float*)(lds + 5 * 64 * MLP);
  float* Bq = Ns + 128;
  float* Gs = Bq + 128;
  float* Mi = Gs + 128;
  float* HB = Mi + 64;
  const bf16_t* PROJ = (const bf16_t*)(p.ws + WS_PROJ);
  const float* GT = (const float*)(p.ws + WS_GATES);
  const bf16_t* CST = (const bf16_t*)(p.ws + WS_CST); const float* NST = (const float*)(p.ws + WS_NST); const float* META = (const float*)(p.ws + WS_MLMETA);
  bf16_t* MIX = (bf16_t*)(p.ws + WS_MIX);
  const int b = unit / (4 * NCH), hh = (unit / NCH) & 3, ch = unit % NCH;
  const int row0 = b * SEGL + ch * 64;
  ml_put_rm(f.q, Qs, tid); ml_put_rm(f.k, Ks, tid); ml_put_tr(f.v, VT, tid);
  ml_put_rm(f.c0, Cs, tid); ml_put_rm(f.c1, Cs + 64 * MLP, tid);
  if (tid < 64) { Ns[tid] = f.ns0; Ns[64 + tid] = f.ns1; }
  if (wid < 2) {
    const int dir = wid;
    const float ig = f.g_ig;
    const float lf = logsigmoidf_(f.g_lf);
    float ps = lf;
    ps = wave_incl_scan(ps);
    const float tot = __uint_as_float((unsigned)__builtin_amdgcn_readlane((int)__float_as_uint(ps), 63));
    const float bc = dir == 0 ? ps : (tot - ps + lf);
    Bq[dir * 64 + lane] = bc; Gs[dir * 64 + lane] = ig - bc;
    if (lane == 0) Mi[dir] = f.mi;
  }
  const u32x4 ov = f.ov;
  if (next >= 0) ml_out_fetch(p, next, tid, fn);
  __syncthreads();
  {
    const int dir = wid >> 2, tt = (wid >> 1) & 1, et = wid & 1;
    const int t = tt * 32 + r32;
    f32x16 sa[2] = {};
    bf16x8 bq[4];
#pragma unroll
    for (int ks = 0; ks < 4; ++ks) {
      bq[ks] = *(const bf16x8*)(Qs + t * MLP + (ks * 16 + hi * 8) * 2);
      const bf16x8 a0 = *(const bf16x8*)(Ks + r32 * MLP + (ks * 16 + hi * 8) * 2), a1 = *(const bf16x8*)(Ks + (32 + r32) * MLP + (ks * 16 + hi * 8) * 2);
      sa[0] = __builtin_amdgcn_mfma_f32_32x32x16_bf16(a0, bq[ks], sa[0], 0, 0, 0);
      sa[1] = __builtin_amdgcn_mfma_f32_32x32x16_bf16(a1, bq[ks], sa[1], 0, 0, 0);
    }
    const float bt = Bq[dir * 64 + t];
    const float inter = bt + Mi[dir];
    float mx = -INFINITY;
    f32x16 dl[2];
#pragma unroll
    for (int st = 0; st < 2; ++st)
#pragma unroll
      for (int r = 0; r < 16; ++r) {
        const int s = st * 32 + crow(r, hi);
        const bool ok = dir == 0 ? (s <= t) : (s >= t);
        const float d = ok ? bt + Gs[dir * 64 + s] : -INFINITY;
        dl[st][r] = d; mx = fmaxf(mx, d);
      }
    mx = max_xor32(mx);
    const float mt = fmaxf(inter, mx);
    const float iw = __expf(inter - mt);
    float rsum = 0.f;
#pragma unroll
    for (int st = 0; st < 2; ++st)
#pragma unroll
      for (int r = 0; r < 16; ++r) { const float w = __expf(dl[st][r] - mt); sa[st][r] *= w; rsum += sa[st][r]; }
    rsum = sum_xor32(rsum);
    float qn = 0.f;
#pragma unroll
    for (int i = 0; i < 4; ++i) {
      const int d0 = hi * 32 + i * 8;
      const u32x4 qa = *(const u32x4*)(Qs + t * MLP + d0 * 2);
      const f32x4 n0 = *(const f32x4*)(Ns + dir * 64 + d0), n1 = *(const f32x4*)(Ns + dir * 64 + d0 + 4);
      qn += bflo(qa.x) * n0.x + bfhi(qa.x) * n0.y + bflo(qa.y) * n0.z + bfhi(qa.y) * n0.w + bflo(qa.z) * n1.x + bfhi(qa.z) * n1.y + bflo(qa.w) * n1.z + bfhi(qa.w) * n1.w;
    }
    qn = sum_xor32(qn);
    const float den = rsum + iw * qn;
    const float rden = 1.f / fmaxf(fabsf(den), __expf(-mt));
    f32x16 an = {}, ac = {};
#pragma unroll
    for (int st = 0; st < 2; ++st)
#pragma unroll
      for (int k2 = 0; k2 < 2; ++k2) {
        u32x4 bx; bx.x = cvtpk(sa[st][8 * k2 + 0], sa[st][8 * k2 + 1]); bx.y = cvtpk(sa[st][8 * k2 + 2], sa[st][8 * k2 + 3]);
        bx.z = cvtpk(sa[st][8 * k2 + 4], sa[st][8 * k2 + 5]); bx.w = cvtpk(sa[st][8 * k2 + 6], sa[st][8 * k2 + 7]);
        const unsigned char* vrow = VT + (et * 32 + r32) * MLP + (st * 32 + 16 * k2 + 4 * hi) * 2;
        const u32x2 v0 = *(const u32x2*)vrow, v1 = *(const u32x2*)(vrow + 16);
        u32x4 ax; ax.x = v0.x; ax.y = v0.y; ax.z = v1.x; ax.w = v1.y;
        an = __builtin_amdgcn_mfma_f32_32x32x16_bf16(*(const bf16x8*)&ax, *(const bf16x8*)&bx, an, 0, 0, 0);
      }
    const unsigned char* Cd = Cs + dir * 64 * MLP;
#pragma unroll
    for (int ks = 0; ks < 4; ++ks) {
      const bf16x8 a = *(const bf16x8*)(Cd + (et * 32 + r32) * MLP + (ks * 16 + hi * 8) * 2);
      ac = __builtin_amdgcn_mfma_f32_32x32x16_bf16(a, bq[ks], ac, 0, 0, 0);
    }
#pragma unroll
    for (int r = 0; r < 16; ++r) HB[dir * 64 * 65 + t * 65 + et * 32 + crow(r, hi)] = (an[r] + iw * ac[r]) * rden;
  }
  __syncthreads();
  {
    const int t = tid >> 3, e8 = (tid & 7) * 8;
    float v[8]; float ss = 0.f;
#pragma unroll
    for (int i = 0; i < 8; ++i) { v[i] = HB[t * 65 + e8 + i] + HB[64 * 65 + t * 65 + e8 + i]; ss += v[i] * v[i]; }
    ss += dpp_mov<0xB1>(ss); ss += dpp_mov<0x4E>(ss); ss += dpp_mov<0x141>(ss);
    const float rs = rsqrtf(ss * (1.f / 64.f) + EPS);
    const float og[8] = {bflo(ov.x), bfhi(ov.x), bflo(ov.y), bfhi(ov.y), bflo(ov.z), bfhi(ov.z), bflo(ov.w), bfhi(ov.w)};
    const float* g = p.in[I_MNORMG] + l * 64 + e8;
    float o[8];
#pragma unroll
    for (int i = 0; i < 8; ++i) o[i] = (ABL & 2) ? 0.f : v[i] * rs * g[i] * sigmoidf_(og[i]);
    u32x4 w; w.x = cvtpk(o[0], o[1]); w.y = cvtpk(o[2], o[3]); w.z = cvtpk(o[4], o[5]); w.w = cvtpk(o[6], o[7]);
    *(u32x4*)(MIX + (size_t)(row0 + t) * DM + 256 + hh * 64 + e8) = w;
  }
  __syncthreads();
}

#define KSWZ(row, colB) ((row) * 256 + ((colB) ^ (((row) & 15) << 4)))
#define SBAR() __builtin_amdgcn_sched_barrier(0)
constexpr int ATT_SHM_V = 128 * 80, ATT_SHM_K = 64 * QK8_PITCH;
constexpr float ATT_THR = 8.0f;
__device__ __forceinline__ int v_st(int k, int c) { const int kk = (k & ~0xC) | ((k & 4) << 1) | ((k & 8) >> 1); return ((kk >> 3) * 4 + (c >> 5)) * 512 + ((kk & 7) * 32 + (c & 31)) * 2; }
__device__ __forceinline__ int v_rd_base(int lane) { return ((lane & 3) << 3) | (((lane >> 2) & 3) << 6) | (((lane >> 4) & 1) << 5) | (((lane >> 5) & 1) << 8); }
constexpr int v_rd_off(int d0, int ks, int half) { return d0 * 512 + ks * 4096 + half * 2048; }
template <int OFF> __device__ __forceinline__ s16x4 tr_read(int vb) {
  s16x4 r; asm volatile("ds_read_b64_tr_b16 %0, %1 offset:%2" : "=&v"(r) : "v"(vb), "i"(OFF) : "memory"); return r;
}
template <int D0> __device__ __forceinline__ void pv_one(f32x16& od, int vb, bf16x8 pa0, bf16x8 pa1, bf16x8 pa2, bf16x8 pa3) {
  const s16x4 l0 = tr_read<v_rd_off(D0, 0, 0)>(vb), h0 = tr_read<v_rd_off(D0, 0, 1)>(vb), l1 = tr_read<v_rd_off(D0, 1, 0)>(vb), h1 = tr_read<v_rd_off(D0, 1, 1)>(vb);
  const s16x4 l2 = tr_read<v_rd_off(D0, 2, 0)>(vb), h2 = tr_read<v_rd_off(D0, 2, 1)>(vb), l3 = tr_read<v_rd_off(D0, 3, 0)>(vb), h3 = tr_read<v_rd_off(D0, 3, 1)>(vb);
  asm volatile("s_waitcnt lgkmcnt(0)" ::: "memory"); SBAR();
#define PK(L, H) (bf16x8){L[0], L[1], L[2], L[3], H[0], H[1], H[2], H[3]}
  od = __builtin_amdgcn_mfma_f32_32x32x16_bf16(pa0, PK(l0, h0), od, 0, 0, 0);
  od = __builtin_amdgcn_mfma_f32_32x32x16_bf16(pa1, PK(l1, h1), od, 0, 0, 0);
  od = __builtin_amdgcn_mfma_f32_32x32x16_bf16(pa2, PK(l2, h2), od, 0, 0, 0);
  od = __builtin_amdgcn_mfma_f32_32x32x16_bf16(pa3, PK(l3, h3), od, 0, 0, 0);
#undef PK
}
template <int D0> __device__ __forceinline__ void pv_two(f32x16& oa, f32x16& ob, int vb, bf16x8 a0, bf16x8 a1, bf16x8 a2, bf16x8 a3, bf16x8 b0, bf16x8 b1, bf16x8 b2, bf16x8 b3) {
  const s16x4 l0 = tr_read<v_rd_off(D0, 0, 0)>(vb), h0 = tr_read<v_rd_off(D0, 0, 1)>(vb), l1 = tr_read<v_rd_off(D0, 1, 0)>(vb), h1 = tr_read<v_rd_off(D0, 1, 1)>(vb);
  const s16x4 l2 = tr_read<v_rd_off(D0, 2, 0)>(vb), h2 = tr_read<v_rd_off(D0, 2, 1)>(vb), l3 = tr_read<v_rd_off(D0, 3, 0)>(vb), h3 = tr_read<v_rd_off(D0, 3, 1)>(vb);
  asm volatile("s_waitcnt lgkmcnt(0)" ::: "memory"); SBAR();
#define PK(L, H) (bf16x8){L[0], L[1], L[2], L[3], H[0], H[1], H[2], H[3]}
  const bf16x8 v0 = PK(l0, h0), v1 = PK(l1, h1), v2 = PK(l2, h2), v3 = PK(l3, h3);
  oa = __builtin_amdgcn_mfma_f32_32x32x16_bf16(a0, v0, oa, 0, 0, 0);
  ob = __builtin_amdgcn_mfma_f32_32x32x16_bf16(b0, v0, ob, 0, 0, 0);
  oa = __builtin_amdgcn_mfma_f32_32x32x16_bf16(a1, v1, oa, 0, 0, 0);
  ob = __builtin_amdgcn_mfma_f32_32x32x16_bf16(b1, v1, ob, 0, 0, 0);
  oa = __builtin_amdgcn_mfma_f32_32x32x16_bf16(a2, v2, oa, 0, 0, 0);
  ob = __builtin_amdgcn_mfma_f32_32x32x16_bf16(b2, v2, ob, 0, 0, 0);
  oa = __builtin_amdgcn_mfma_f32_32x32x16_bf16(a3, v3, oa, 0, 0, 0);
  ob = __builtin_amdgcn_mfma_f32_32x32x16_bf16(b3, v3, ob, 0, 0, 0);
#undef PK
}
struct KQFrag { bf16x8 b0, b1, q; };
__device__ __forceinline__ void att_ldkq(KQFrag& f, const LAS unsigned char* l3, int akk, int akq) {
  const LAS unsigned char* kp = l3 + akk;
  f.b0 = *(const LAS bf16x8*)kp; f.b1 = *(const LAS bf16x8*)(kp + 8192); f.q = *(const LAS bf16x8*)(l3 + akq);
}
#define ATT_MF(pa_, pb_, f_) do { pa_ = __builtin_amdgcn_mfma_f32_32x32x16_bf16(f_.b0, f_.q, pa_, 0, 0, 0); pb_ = __builtin_amdgcn_mfma_f32_32x32x16_bf16(f_.b1, f_.q, pb_, 0, 0, 0); } while (0)
__device__ __forceinline__ void att_qk_all(f32x16& p0, f32x16& p1, f32x16& q0, f32x16& q1, KQFrag& f0, const LAS unsigned char* l3, int akk0, int akq0, float ia, float ib) {
  KQFrag f1;
#pragma unroll
  for (int r = 0; r < 16; ++r) { p0[r] = ia; p1[r] = ia; q0[r] = ib; q1[r] = ib; }
  att_ldkq(f1, l3, akk0 ^ (1 << 5), akq0 ^ (1 << 5)); ATT_MF(p0, p1, f0); SBAR();
  att_ldkq(f0, l3, akk0 ^ (2 << 5), akq0 ^ (2 << 5)); ATT_MF(p0, p1, f1); SBAR();
  att_ldkq(f1, l3, akk0 ^ (3 << 5), akq0 ^ (3 << 5)); ATT_MF(p0, p1, f0); SBAR();
  att_ldkq(f0, l3, akk0 ^ (4 << 5), akq0 ^ (4 << 5)); ATT_MF(p0, p1, f1); SBAR();
  att_ldkq(f1, l3, akk0 ^ (5 << 5), akq0 ^ (5 << 5)); ATT_MF(q0, q1, f0); SBAR();
  att_ldkq(f0, l3, akk0 ^ (6 << 5), akq0 ^ (6 << 5)); ATT_MF(q0, q1, f1); SBAR();
  att_ldkq(f1, l3, akk0 ^ (7 << 5), akq0 ^ (7 << 5)); ATT_MF(q0, q1, f0); SBAR();
  ATT_MF(q0, q1, f1); SBAR();
}
__device__ __forceinline__ float bf16_near(float x) { return __uint_as_float((__float_as_uint(x) + 0x8000u) & 0xFFFF0000u); }
__device__ __forceinline__ void att_softmax(f32x16& p0, f32x16& p1, float& m_reg, float& l_reg, float& alpha, bool first, i32x8& pa) {
  alpha = 1.f;
  if (first) {
    float pmax = p0[0];
#pragma unroll
    for (int r = 1; r < 16; ++r) pmax = fmaxf(pmax, p0[r]);
#pragma unroll
    for (int r = 0; r < 16; ++r) pmax = fmaxf(pmax, p1[r]);
    { auto rr = __builtin_amdgcn_permlane32_swap(__float_as_uint(pmax), __float_as_uint(pmax), false, false);
      pmax = fmaxf(__uint_as_float(rr[0]), __uint_as_float(rr[1])); }
    pmax = bf16_near(pmax);
    alpha = 0.f; m_reg = pmax;
#pragma unroll
    for (int r = 0; r < 16; ++r) { p0[r] -= pmax; p1[r] -= pmax; }
  }
#pragma unroll
  for (int r = 0; r < 16; ++r) { p0[r] = __builtin_amdgcn_exp2f(p0[r]); p1[r] = __builtin_amdgcn_exp2f(p1[r]); }
  float ps;
  {
#define VADD(d_, a_, b_) asm("v_add_f32_e32 %0, %1, %2" : "=v"(d_) : "v"(a_), "v"(b_))
    float s0, s1, s2, s3;
    VADD(s0, p0[0], p0[1]); VADD(s1, p0[8], p0[9]); VADD(s2, p1[0], p1[1]); VADD(s3, p1[8], p1[9]);
#pragma unroll
    for (int r = 2; r < 8; ++r) { VADD(s0, s0, p0[r]); VADD(s1, s1, p0[8 + r]); VADD(s2, s2, p1[r]); VADD(s3, s3, p1[8 + r]); }
    VADD(s0, s0, s1); VADD(s2, s2, s3); VADD(ps, s0, s2);
#undef VADD
  }
  { auto rr = __builtin_amdgcn_permlane32_swap(__float_as_uint(ps), __float_as_uint(ps), false, false);
    ps = __uint_as_float(rr[0]) + __uint_as_float(rr[1]); }
  if (__builtin_expect(!first && __any(ps > 256.f), 0)) {
    float emax = p0[0];
#pragma unroll
    for (int r = 1; r < 16; ++r) emax = fmaxf(emax, p0[r]);
#pragma unroll
    for (int r = 0; r < 16; ++r) emax = fmaxf(emax, p1[r]);
    { auto rr = __builtin_amdgcn_permlane32_swap(__float_as_uint(emax), __float_as_uint(emax), false, false);
      emax = fmaxf(__uint_as_float(rr[0]), __uint_as_float(rr[1])); }
    const float m_new = bf16_near(m_reg + fmaxf(__builtin_amdgcn_logf(emax), 0.f));
    const float delta = m_new - m_reg;
    alpha = __builtin_amdgcn_exp2f(-delta); m_reg = m_new;
#pragma unroll
    for (int r = 0; r < 16; ++r) { p0[r] *= alpha; p1[r] *= alpha; }
    ps *= alpha;
  }
  l_reg = l_reg * alpha + ps;
#pragma unroll
  for (int v = 0; v < 4; ++v) {
    int w0, w1; asm volatile("" : "=v"(w0), "=v"(w1));
    w0 = __builtin_amdgcn_cvt_pk_fp8_f32(p0[4 * v], p0[4 * v + 1], w0, false); w0 = __builtin_amdgcn_cvt_pk_fp8_f32(p0[4 * v + 2], p0[4 * v + 3], w0, true);
    w1 = __builtin_amdgcn_cvt_pk_fp8_f32(p1[4 * v], p1[4 * v + 1], w1, false); w1 = __builtin_amdgcn_cvt_pk_fp8_f32(p1[4 * v + 2], p1[4 * v + 3], w1, true);
    pa[v] = w0; pa[4 + v] = w1;
  }
}
__device__ __forceinline__ void att_unit(const unsigned char* __restrict__ Q8, const unsigned char* __restrict__ K8, const unsigned char* __restrict__ V8, bf16_t* __restrict__ Ob,
                                         int nkeys, float lam, const float* __restrict__ ng, float oscale, unsigned char* lds) {
  int tid_ = tidx(); asm volatile("" : "+v"(tid_)); const int tid = tid_, wid = tid >> 6, lane = tid & 63, r32 = lane & 31, hi = lane >> 5;
  const int grp = __builtin_amdgcn_readfirstlane(wid >> 2);
  unsigned char* V_lds = lds; unsigned char* K_lds = lds + 2 * ATT_SHM_V;
  float* wsl = (float*)(lds + 2 * ATT_SHM_V + 2 * ATT_SHM_K) + wid * 64; float* li_l = wsl; float* al_l = wsl + 32;
  float m0 = 0.f, l0 = 0.f, m1 = 0.f, l1 = 0.f;
  f32x16 o0[4] = {}, o1[4] = {};
  unsigned char* Q_lds = lds + 2 * ATT_SHM_V + 2 * ATT_SHM_K + 2048;
#pragma unroll
  for (int i = 0; i < 5; ++i) { const int piece = __builtin_amdgcn_readfirstlane(wid) + 8 * i;
    if (piece < 36) __builtin_amdgcn_global_load_lds((const unsigned*)(Q8 + piece * 1024 + lane * 16), (LAS unsigned*)(Q_lds + piece * 1024), 16, 0, 0); }
  const unsigned ldsw = (unsigned)__builtin_amdgcn_readfirstlane(wid) * 1024u;
#define GSTAGE_K(b, k0) do { const unsigned char* ki_ = K8 + (size_t)(k0) * QK8_PITCH + tid * 16; \
      __builtin_amdgcn_global_load_lds((const unsigned*)ki_, (LAS unsigned*)(K_lds + (b) * ATT_SHM_K + ldsw), 16, 0, 0); \
      if (wid < 1) __builtin_amdgcn_global_load_lds((const unsigned*)(ki_ + 8192), (LAS unsigned*)(K_lds + (b) * ATT_SHM_K + 8192 + ldsw), 16, 0, 0); } while (0)
#define GSTAGE_V(b, k0) do { const unsigned char* vi_ = V8 + (size_t)((k0) >> 6) * ATT_SHM_V + tid * 16; \
      __builtin_amdgcn_global_load_lds((const unsigned*)vi_, (LAS unsigned*)(V_lds + (b) * ATT_SHM_V + ldsw), 16, 0, 0); \
      if (wid < 2) __builtin_amdgcn_global_load_lds((const unsigned*)(vi_ + 8192), (LAS unsigned*)(V_lds + (b) * ATT_SHM_V + 8192 + ldsw), 16, 0, 0); } while (0)
#define STAGE_PAIR(jj) do { GSTAGE_V((jj) & 1, (jj) * 64); if ((jj) + 1 < NT) GSTAGE_K((jj) & 1, ((jj) + 1) * 64); } while (0)
#define RESC(o, a) do { if (__any((a) < 1.f)) { if (hi == 0) al_l[r32] = (a); asm volatile("s_waitcnt lgkmcnt(0)" ::: "memory"); \
    _Pragma("unroll") for (int d = 0; d < 4; ++d) _Pragma("unroll") for (int r = 0; r < 16; ++r) o[d][r] *= al_l[crow(r, hi)]; } } while (0)
#define ATT_BAR() do { asm volatile("s_waitcnt lgkmcnt(0)" ::: "memory"); __builtin_amdgcn_s_barrier(); asm volatile("" ::: "memory"); } while (0)
#define ATT_LDK(dst_, off_) do { const u32x4 x0_ = *(const LAS u32x4*)(kb_ + (off_)), x1_ = *(const LAS u32x4*)(kb_ + (off_) + 16); \
      dst_[0] = (int)x0_.x; dst_[1] = (int)x0_.y; dst_[2] = (int)x0_.z; dst_[3] = (int)x0_.w; dst_[4] = (int)x1_.x; dst_[5] = (int)x1_.y; dst_[6] = (int)x1_.z; dst_[7] = (int)x1_.w; } while (0)
#define ATT_SC(acc_, kf_, qf_) acc_ = __builtin_amdgcn_mfma_scale_f32_32x32x64_f8f6f4(kf_, qf_, acc_, 0, 0, 0, 0x7F7F7F7F, 0, 0x7F7F7F7F)
#define ATT_LDQ(dst_, off_) do { const u32x4 x0_ = *(const LAS u32x4*)(qb_ + (off_)), x1_ = *(const LAS u32x4*)(qb_ + (off_) + 16); \
      dst_[0] = (int)x0_.x; dst_[1] = (int)x0_.y; dst_[2] = (int)x0_.z; dst_[3] = (int)x0_.w; dst_[4] = (int)x1_.x; dst_[5] = (int)x1_.y; dst_[6] = (int)x1_.z; dst_[7] = (int)x1_.w; } while (0)
#define ATT_INIT2(pa_, pb_, negm_) do { u32x4 oa_, ob_; unsigned z_ = 0u; asm volatile("" : "+v"(z_)); \
      oa_.x = hi ? z_ : 0x3F80u; oa_.y = z_; oa_.z = z_; oa_.w = z_; ob_.x = hi ? z_ : (__float_as_uint(negm_) >> 16); ob_.y = z_; ob_.z = z_; ob_.w = z_; \
      const f32x16 zz_ = {}; \
      pa_ = __builtin_amdgcn_mfma_f32_32x32x16_bf16(*(const bf16x8*)&oa_, *(const bf16x8*)&ob_, zz_, 0, 0, 0); \
      pb_ = __builtin_amdgcn_mfma_f32_32x32x16_bf16(*(const bf16x8*)&oa_, *(const bf16x8*)&ob_, zz_, 0, 0, 0); } while (0)
#define ATT_QK_ALL(ia_, ib_) do { ATT_INIT2(p0, p1, ia_); ATT_INIT2(q0, q1, ib_); SBAR(); \
      ATT_SC(p0, kf0, qf); SBAR(); ATT_LDK(kf0, 32 * QK8_PITCH); SBAR(); \
      ATT_SC(p1, kf0, qf); SBAR(); ATT_LDK(kf0, 64); ATT_LDQ(qf, 64); SBAR(); \
      ATT_SC(q0, kf0, qf); SBAR(); ATT_LDK(kf0, 32 * QK8_PITCH + 64); SBAR(); \
      ATT_SC(q1, kf0, qf); SBAR(); } while (0)
  const int NT = nkeys / 64;
  GSTAGE_K(1, 0); STAGE_PAIR(0);
  asm volatile("s_waitcnt vmcnt(0)" ::: "memory"); __syncthreads();
  f32x16 p0, p1, q0, q1; i32x8 pa, pb;
  const LAS unsigned char* l3 = (const LAS unsigned char*)lds;
  const int kofs0 = 2 * ATT_SHM_V + r32 * QK8_PITCH + hi * 32;
  const int qofs0 = 2 * ATT_SHM_V + 2 * ATT_SHM_K + 2048 + (__builtin_amdgcn_readfirstlane(wid) * 32 + r32) * QK8_PITCH + hi * 32;
  { i32x8 kf0, qf; const LAS unsigned char* kb_ = l3 + (kofs0 + ATT_SHM_K); const LAS unsigned char* qb_ = l3 + qofs0;
    ATT_LDK(kf0, 0); ATT_LDQ(qf, 0);
    ATT_QK_ALL(0.f, 0.f); }
  if (grp) ATT_BAR();
#pragma unroll 1
  for (int j = 0; j < NT; ++j) {
    const int cur = j & 1;
    const bool more = (j + 1 < NT);
    if (grp && more) STAGE_PAIR(j + 1);
    { float alphaA, alphaB;
      const bool first = (j == 0);
      att_softmax(p0, p1, m0, l0, alphaA, first, pa); SBAR();
      att_softmax(q0, q1, m1, l1, alphaB, first, pb); SBAR();
      RESC(o0, alphaA);
      RESC(o1, alphaB); }
    asm volatile("" : "+v"(pa), "+v"(pb), "+v"(m0), "+v"(l0), "+v"(m1), "+v"(l1));
    asm volatile("" : "+v"(o0[0]), "+v"(o0[1]), "+v"(o0[2]), "+v"(o0[3]), "+v"(o1[0]), "+v"(o1[1]), "+v"(o1[2]), "+v"(o1[3]));
    if (!grp) asm volatile("s_waitcnt vmcnt(0)" ::: "memory");
    ATT_BAR();
    if (!grp && more) STAGE_PAIR(j + 1);
    __builtin_amdgcn_s_setprio(1);
    {
      int kofs = kofs0, qofs = qofs0; asm volatile("" : "+v"(kofs), "+v"(qofs));
      const LAS unsigned char* kb_ = l3 + (kofs + cur * ATT_SHM_K); const LAS unsigned char* qb_ = l3 + qofs;
      i32x8 kf0, qf;
      const LAS unsigned char* vrow = l3 + (r32 * 80 + hi * 32 + cur * ATT_SHM_V);
      u32x4 va0 = *(const LAS u32x4*)vrow, va1 = *(const LAS u32x4*)(vrow + 16), vb0, vb1;
#define ATT_PV(d0_, x0_, x1_) do { i32x8 bv; bv[0] = (int)x0_.x; bv[1] = (int)x0_.y; bv[2] = (int)x0_.z; bv[3] = (int)x0_.w; bv[4] = (int)x1_.x; bv[5] = (int)x1_.y; bv[6] = (int)x1_.z; bv[7] = (int)x1_.w; \
        o0[d0_] = __builtin_amdgcn_mfma_scale_f32_32x32x64_f8f6f4(pa, bv, o0[d0_], 0, 0, 0, 0x7F7F7F7F, 0, 0x7F7F7F7F); \
        o1[d0_] = __builtin_amdgcn_mfma_scale_f32_32x32x64_f8f6f4(pb, bv, o1[d0_], 0, 0, 0, 0x7F7F7F7F, 0, 0x7F7F7F7F); } while (0)
      vb0 = *(const LAS u32x4*)(vrow + 32 * 80); vb1 = *(const LAS u32x4*)(vrow + 32 * 80 + 16); ATT_PV(0, va0, va1); SBAR();
      va0 = *(const LAS u32x4*)(vrow + 64 * 80); va1 = *(const LAS u32x4*)(vrow + 64 * 80 + 16); ATT_PV(1, vb0, vb1); SBAR();
      vb0 = *(const LAS u32x4*)(vrow + 96 * 80); vb1 = *(const LAS u32x4*)(vrow + 96 * 80 + 16); ATT_PV(2, va0, va1); SBAR();
      ATT_LDK(kf0, 0); ATT_LDQ(qf, 0);
      ATT_PV(3, vb0, vb1); SBAR();
#undef ATT_PV
      asm volatile("" : "+v"(o0[0]), "+v"(o0[1]), "+v"(o0[2]), "+v"(o0[3]), "+v"(o1[0]), "+v"(o1[1]), "+v"(o1[2]), "+v"(o1[3]));
      ATT_QK_ALL(-m0, -m1);
      asm volatile("" : "+v"(p0), "+v"(p1), "+v"(q0), "+v"(q1));
    }
    __builtin_amdgcn_s_setprio(0);
    if (grp) asm volatile("s_waitcnt vmcnt(0)" ::: "memory");
    ATT_BAR();
  }
  if (!grp) ATT_BAR();
  if (hi == 0) { li_l[r32] = 1.f / l0; al_l[r32] = lam / l1; }
  asm volatile("s_waitcnt lgkmcnt(0)" ::: "memory");
  float ss[16];
#pragma unroll
  for (int r = 0; r < 16; ++r) {
    const float a = li_l[crow(r, hi)], bq = al_l[crow(r, hi)];
    float s = 0.f;
#pragma unroll
    for (int d = 0; d < 4; ++d) { const float v = o0[d][r] * a - o1[d][r] * bq; o0[d][r] = v; s += v * v; }
    s += dpp_mov<0xB1>(s); s += dpp_mov<0x4E>(s); s += dpp_mov<0x141>(s); s += dpp_mov<0x140>(s);
    { auto rr_ = __builtin_amdgcn_permlane16_swap(__float_as_uint(s), __float_as_uint(s), false, false); s = __uint_as_float(rr_[0]) + __uint_as_float(rr_[1]); }
    ss[r] = rsqrtf(s * (1.f / 128.f) + EPS) * oscale;
  }
  bf16_t* Ow = Ob + (size_t)(wid * 32) * DM;
  unsigned char* ost = lds + 2 * ATT_SHM_V + 2 * ATT_SHM_K + 2048 + wid * (32 * 272);
#pragma unroll
  for (int d = 0; d < 4; ++d) {
    const float g = ng[d * 32 + r32];
#pragma unroll
    for (int r = 0; r < 16; ++r) *(bf16_t*)(ost + crow(r, hi) * 272 + (d * 32 + r32) * 2) = (ABL & 4) ? (bf16_t)0 : (bf16_t)(cvtpk(o0[d][r] * ss[r] * g, 0.f) & 0xffffu);
  }
  asm volatile("s_waitcnt lgkmcnt(0)" ::: "memory");
#pragma unroll
  for (int i = 0; i < 8; ++i) {
    const int c = lane + 64 * i, row = c >> 4, cb = (c & 15) * 16;
    *(u32x4*)((unsigned char*)(Ow + (size_t)row * DM) + cb) = *(const u32x4*)(ost + row * 272 + cb);
  }
  __syncthreads();
#undef ATT_INIT2
#undef ATT_LDK
#undef ATT_LDQ
#undef ATT_SC
#undef ATT_QK_ALL
#undef GSTAGE_K
#undef GSTAGE_V
#undef STAGE_PAIR
#undef RESC
#undef ATT_BAR
}

__device__ __forceinline__ float ins16(float (&a)[16], float x) {
#pragma unroll
  for (int i = 0; i < 16; ++i) { const float h = fmaxf(a[i], x); x = fminf(a[i], x); a[i] = h; }
  return x;
}
__device__ __forceinline__ void bsort16(float (&a)[16]) {
#pragma unroll
  for (int k = 2; k <= 16; k <<= 1)
#pragma unroll
    for (int j = k >> 1; j > 0; j >>= 1)
#pragma unroll
      for (int i = 0; i < 16; ++i) {
        const int q = i ^ j;
        if (q > i) {
          const bool desc = ((i & k) == 0);
          const float hi_ = fmaxf(a[i], a[q]), lo_ = fminf(a[i], a[q]);
          a[i] = desc ? hi_ : lo_; a[q] = desc ? lo_ : hi_;
        }
      }
}
__device__ __forceinline__ void bmerge16(float (&a)[16], const float (&b)[16]) {
#pragma unroll
  for (int i = 0; i < 16; ++i) a[i] = fmaxf(a[i], b[15 - i]);
#pragma unroll
  for (int j = 8; j > 0; j >>= 1)
#pragma unroll
    for (int i = 0; i < 16; ++i) {
      const int q = i ^ j;
      if (q > i) { const float hi_ = fmaxf(a[i], a[q]), lo_ = fminf(a[i], a[q]); a[i] = hi_; a[q] = lo_; }
    }
}
__device__ __forceinline__ float gelu_erf(float x) { return 0.5f * x * (1.f + erff(x * 0.70710678118654752440f)); }
#define XB_TMO      128
#define XB_XCNT(j)  (256  + 64 * (j))
#define XB_XSUB(j)  (1280 + 64 * (j))
#define XB_XGEN(j)  (2304 + 64 * (j))
#define XB_TOP      3328
#define XB_TOPGEN   3392
#define XCD_BAR_WORDS 3456
#define XB_SPIN_CAP (1u << 22)
__device__ __forceinline__ unsigned xb_ld(unsigned* p)              { return __hip_atomic_load(p, __ATOMIC_RELAXED, __HIP_MEMORY_SCOPE_AGENT); }
__device__ __forceinline__ unsigned xb_add(unsigned* p, unsigned v) { return __hip_atomic_fetch_add(p, v, __ATOMIC_RELAXED, __HIP_MEMORY_SCOPE_AGENT); }
__device__ __forceinline__ unsigned xb_xcc_id() { return (unsigned)__builtin_amdgcn_s_getreg((3 << 11) | 20) & 0xFu; }
#define XB_SPIN(cond, bar) do { unsigned _sp = 0; while (cond) { __builtin_amdgcn_s_sleep(1); \
    if ((++_sp & 255u) == 0u) { if (xb_ld(&(bar)[XB_TMO])) break; if (_sp > XB_SPIN_CAP) { atomicAdd(&(bar)[XB_TMO], 1u); break; } } } } while (0)
struct XcdBarrier { unsigned* bar; unsigned x; volatile LAS unsigned* st; };
__device__ __forceinline__ XcdBarrier xcd_barrier_post(unsigned* bar, volatile LAS unsigned* st) {
  XcdBarrier b; b.bar = bar; b.x = xb_xcc_id(); b.st = st;
  if (tidx() == 0) (void)xb_add(&bar[XB_XCNT(b.x)], 1u);
  return b;
}
__device__ __forceinline__ void xcd_barrier_complete(unsigned* bar, unsigned x, unsigned& nloc, unsigned& nx) {
  const unsigned G = gridDim.x * gridDim.y * gridDim.z;
  unsigned sum, cnt, mine, sp = 0u;
  for (;;) {
    sum = 0u; cnt = 0u; mine = 0u;
#pragma unroll
    for (unsigned j = 0; j < 16; ++j) { const unsigned c = xb_ld(&bar[XB_XCNT(j)]); sum += c; cnt += (c > 0u) ? 1u : 0u; mine = (j == x) ? c : mine; }
    if (sum == G) break;
    __builtin_amdgcn_s_sleep(1);
    if ((++sp & 255u) == 0u) { if (xb_ld(&bar[XB_TMO])) break; if (sp > XB_SPIN_CAP) { atomicAdd(&bar[XB_TMO], 1u); break; } }
  }
  nloc = mine > 0u ? mine : 1u; nx = cnt > 0u ? cnt : 1u;
}
__device__ __forceinline__ void xcd_barrier(const XcdBarrier& b) {
  asm volatile("s_waitcnt vmcnt(0)" ::: "memory");
  __syncthreads();
  if (tidx() == 0) {
    unsigned* bar = b.bar;
    __builtin_amdgcn_s_waitcnt(0);
    unsigned nloc = b.st[0], nx = b.st[1];
    if (nloc == 0u) { xcd_barrier_complete(bar, b.x, nloc, nx); b.st[0] = nloc; b.st[1] = nx; }
    const unsigned old = xb_add(&bar[XB_XSUB(b.x)], 1u);
    const unsigned gen = old / nloc;
    if (old + 1u == (gen + 1u) * nloc) {
      __builtin_amdgcn_fence(__ATOMIC_RELEASE, "agent");
      asm volatile("s_waitcnt vmcnt(0)" ::: "memory");
      const unsigned og = xb_add(&bar[XB_TOP], 1u);
      const unsigned tg = og / nx;
      if (og + 1u == (tg + 1u) * nx) xb_add(&bar[XB_TOPGEN], 1u);
      else XB_SPIN(xb_ld(&bar[XB_TOPGEN]) == tg, bar);
      __builtin_amdgcn_fence(__ATOMIC_ACQUIRE, "agent");
      xb_add(&bar[XB_XGEN(b.x)], 1u);
      asm volatile("s_waitcnt vmcnt(0)" ::: "memory");
    } else {
      XB_SPIN(xb_ld(&bar[XB_XGEN(b.x)]) == gen, bar);
      __builtin_amdgcn_fence(__ATOMIC_ACQUIRE, "agent");
      asm volatile("s_waitcnt vmcnt(0)" ::: "memory");
    }
  }
  __syncthreads();
}

constexpr size_t RT_STRIDE = (size_t)T * 128 * 4;
__device__ __forceinline__ void route_unit(const Params& p, int l, int unit, unsigned char* lds) {
  int tid_ = tidx(); asm volatile("" : "+v"(tid_)); const int tid = tid_, lane = tid & 63, wid = tid >> 6, r32 = lane & 31, hi = lane >> 5;
  unsigned char* IDX = lds;
  int* UE = (int*)(lds + 8192); float* UG = (float*)(lds + 8192 + 16384); float* US = (float*)(lds + 8192 + 32768);
  int* EIDG = (int*)(p.ws + WS_EID + (size_t)l * RT_STRIDE); float* GWG = (float*)(p.ws + WS_ULOC + RT_STRIDE); float* SUG = (float*)(p.ws + WS_ULOC + 2 * RT_STRIDE);
  const float* PSC = (const float*)(p.ws + WS_PSC);
  const int row0 = unit * 32;
  const bf16_t* QP = (const bf16_t*)(p.ws + WS_PROJ);
  const bf16_t* KEYS = (const bf16_t*)(p.ws + WS_KEYS) + (size_t)l * 131072;
  for (int rrep = 0; rrep < REP_ROUTE; ++rrep) {
    const int h = wid;
    float top[2][16];
    bf16x8 bq[4], bqn[4], akc[4], akn[4];
    {
      const bf16_t* qrow0 = QP + (size_t)(row0 + r32) * DM + h * 128 + hi * 8;
      const bf16_t* kb0 = KEYS + ((size_t)(h * 2) * 128 + r32) * 64 + hi * 8;
#pragma unroll
      for (int ks = 0; ks < 4; ++ks) { bq[ks] = *(const bf16x8*)(qrow0 + ks * 16); akc[ks] = *(const bf16x8*)(kb0 + ks * 16); }
    }
#pragma unroll
    for (int pp = 0; pp < 2; ++pp) {
      const bf16_t* kb = KEYS + ((size_t)(h * 2 + pp) * 128 + r32) * 64 + hi * 8;
      float (&lst)[16] = top[pp];
#pragma unroll
      for (int i = 0; i < 16; ++i) lst[i] = -INFINITY;
#pragma unroll
      for (int nt = 0; nt < 4; ++nt) {
        if (nt < 3) {
#pragma unroll
          for (int ks = 0; ks < 4; ++ks) akn[ks] = *(const bf16x8*)(kb + (size_t)(nt + 1) * 32 * 64 + ks * 16);
        } else if (pp == 0) {
          const bf16_t* qrow1 = QP + (size_t)(row0 + r32) * DM + h * 128 + 64 + hi * 8;
          const bf16_t* kb1 = KEYS + ((size_t)(h * 2 + 1) * 128 + r32) * 64 + hi * 8;
#pragma unroll
          for (int ks = 0; ks < 4; ++ks) { bqn[ks] = *(const bf16x8*)(qrow1 + ks * 16); akn[ks] = *(const bf16x8*)(kb1 + ks * 16); }
        }
        f32x16 acc = {};
#pragma unroll
        for (int ks = 0; ks < 4; ++ks) acc = __builtin_amdgcn_mfma_f32_32x32x16_bf16(akc[ks], bq[ks], acc, 0, 0, 0);
#pragma unroll
        for (int ks = 0; ks < 4; ++ks) { akc[ks] = akn[ks]; if (nt == 3) bq[ks] = bqn[ks]; }
        float grp[16];
#pragma unroll
        for (int r = 0; r < 16; ++r) grp[r] = __uint_as_float((__float_as_uint(acc[r]) & ~0x7Fu) | (unsigned)(nt * 32 + crow(r, hi)));
        bsort16(grp);
        if (nt == 0) {
#pragma unroll
          for (int i = 0; i < 16; ++i) lst[i] = grp[i];
        } else bmerge16(lst, grp);
        SBAR();
      }
      float oth[16];
#pragma unroll
      for (int i = 0; i < 16; ++i) { auto rr_ = __builtin_amdgcn_permlane32_swap(__float_as_uint(lst[i]), __float_as_uint(lst[i]), false, false); oth[i] = __uint_as_float(hi ? rr_[0] : rr_[1]); }
      bmerge16(lst, oth);
      if (hi == 0) {
        unsigned w[4];
#pragma unroll
        for (int i = 0; i < 4; ++i)
          w[i] = (__float_as_uint(lst[4 * i]) & 0x7Fu) | ((__float_as_uint(lst[4 * i + 1]) & 0x7Fu) << 8) | ((__float_as_uint(lst[4 * i + 2]) & 0x7Fu) << 16) | ((__float_as_uint(lst[4 * i + 3]) & 0x7Fu) << 24);
        *(u32x4*)(IDX + ((r32 * 8 + h) * 2 + pp) * 16) = (u32x4){w[0], w[1], w[2], w[3]};
      }
    }
    float best[16];
#define CAND(i, j) __uint_as_float((__float_as_uint(__uint_as_float(__float_as_uint(top[0][i]) & ~0x7Fu) + __uint_as_float(__float_as_uint(top[1][j]) & ~0x7Fu)) & ~0xFFu) | (unsigned)((i) * 16 + (j)))
    {
#pragma unroll
      for (int j = 0; j < 16; ++j) best[j] = CAND(0, j);
      float y[16];
#pragma unroll
      for (int j = 0; j < 8; ++j) { y[j] = CAND(1, j); y[8 + j] = CAND(15 - j, 0); }
#pragma unroll
      for (int jj = 8; jj > 0; jj >>= 1)
#pragma unroll
        for (int i = 0; i < 16; ++i) { const int q = i ^ jj; if (q > i) { const float hi_ = fmaxf(y[i], y[q]), lo_ = fminf(y[i], y[q]); y[i] = hi_; y[q] = lo_; } }
      bmerge16(best, y);
      float x[16];
      x[0] = CAND(2, 0); x[1] = CAND(2, 1); x[2] = CAND(2, 2); x[3] = CAND(2, 3); x[4] = CAND(2, 4);
      x[5] = CAND(3, 0); x[6] = CAND(3, 1); x[7] = CAND(3, 2); x[8] = CAND(3, 3);
      x[9] = CAND(4, 0); x[10] = CAND(4, 1); x[11] = CAND(4, 2);
      x[12] = CAND(5, 0); x[13] = CAND(5, 1); x[14] = CAND(6, 0); x[15] = CAND(6, 1);
      bsort16(x);
      bmerge16(best, x);
      ins16(best, CAND(7, 0)); ins16(best, CAND(7, 1));
    }
#undef CAND
    asm volatile("s_waitcnt lgkmcnt(0)" ::: "memory");
    if (hi == 0) {
      const unsigned char* ib = IDX + ((r32 * 8 + h) * 2) * 16;
      const float mx = __uint_as_float(__float_as_uint(best[0]) & ~0xFFu);
      float w[16]; float sum = 0.f;
#pragma unroll
      for (int k = 0; k < 16; ++k) { w[k] = __expf(__uint_as_float(__float_as_uint(best[k]) & ~0xFFu) - mx); sum += w[k]; }
      const float rsum = 1.f / sum;
      int ee[16]; float su_[16], sv_[16];
#pragma unroll
      for (int k = 0; k < 16; ++k) {
        const unsigned ij = __float_as_uint(best[k]) & 0xFFu;
        ee[k] = (int)ib[ij >> 4] * 128 + (int)ib[16 + (ij & 15)];
      }
#pragma unroll
      for (int k = 0; k < 16; ++k) { su_[k] = PSC[(size_t)l * NEXP + ee[k]]; sv_[k] = PSC[(size_t)(DEPTH + l) * NEXP + ee[k]]; }
#pragma unroll
      for (int k = 0; k < 16; ++k) {
        UE[r32 * 128 + h * 16 + k] = ee[k]; UG[r32 * 128 + h * 16 + k] = w[k] * rsum * sv_[k];
        US[r32 * 128 + h * 16 + k] = su_[k];
      }
    }
  }
  __syncthreads();
#pragma unroll 1
  for (int tt = 0; tt < 4; ++tt) {
    const int t = wid * 4 + tt;
    const int k0 = UE[t * 128 + lane], k1 = UE[t * 128 + 64 + lane];
    const float g0 = UG[t * 128 + lane], g1 = UG[t * 128 + 64 + lane], s0 = US[t * 128 + lane], s1 = US[t * 128 + 64 + lane];
    const int b0 = k0 >> 11, b1 = k1 >> 11;
    int base = 0, pos0 = 0, pos1 = 0;
#pragma unroll
    for (int b = 0; b < 8; ++b) {
      const unsigned long long m0 = __ballot(b0 == b), m1 = __ballot(b1 == b);
      const int c0 = __popcll(m0), c1 = __popcll(m1);
      const unsigned long long lt = (1ull << lane) - 1ull;
      if (b0 == b) pos0 = base + __popcll(m0 & lt);
      if (b1 == b) pos1 = base + c0 + __popcll(m1 & lt);
      base += c0 + c1;
    }
    const size_t ro = (size_t)(row0 + t) * 128;
    EIDG[ro + pos0] = k0; GWG[ro + pos0] = g0; SUG[ro + pos0] = s0;
    EIDG[ro + pos1] = k1; GWG[ro + pos1] = g1; SUG[ro + pos1] = s1;
  }
}
#define CAS __attribute__((address_space(4)))
typedef int i32x8 __attribute__((ext_vector_type(8)));
struct TokPref { f32x2 gs0, gs1; u32x4 hA, hB; };
struct RowPipe { i32x6 uq[4], vq[4]; i32x8 Ec; };
struct EpiVec { f32x4 g2[4], ng[4], sc[4], sh[4]; int mr; };
__device__ __forceinline__ const CAS i32x8* eid_row(const CAS unsigned char* eidg, int row) {
  return (const CAS i32x8*)(eidg + (size_t)(unsigned)__builtin_amdgcn_readfirstlane(row) * 512u);
}
__device__ __forceinline__ void tok_prefetch(const Params& p, int row, int lane, TokPref& t) {
  const float* GWG = (const float*)(p.ws + WS_ULOC + RT_STRIDE) + (size_t)row * 128;
  const float* SUG = (const float*)(p.ws + WS_ULOC + 2 * RT_STRIDE) + (size_t)row * 128;
  const bf16_t* H = (const bf16_t*)(p.ws + WS_H);
  t.gs0 = f32x2{GWG[lane], SUG[lane]}; t.gs1 = f32x2{GWG[64 + lane], SUG[64 + lane]};
  { const bf16_t* hr_ = H + (size_t)row * DM + lane * 4;
    const u32x2 a0 = *(const u32x2*)hr_, a1 = *(const u32x2*)(hr_ + 256), a2 = *(const u32x2*)(hr_ + 512), a3 = *(const u32x2*)(hr_ + 768);
    t.hA = (u32x4){a0.x, a0.y, a1.x, a1.y}; t.hB = (u32x4){a2.x, a2.y, a3.x, a3.y}; }
}
#define LOADPAIR(dst_, tofs_, ea_, eb_) do { const u32x3v a_ = __builtin_amdgcn_raw_buffer_load_b96(rsT, lane12, (ea_) * PROW + (tofs_), 0); const unsigned b0_ = __builtin_amdgcn_raw_buffer_load_b32(rsT, lane12, (eb_) * PROW + (tofs_), 0); \
      const u32x2v b1_ = __builtin_amdgcn_raw_buffer_load_b64(rsT, lane12 + 4, (eb_) * PROW + (tofs_), 0); \
      dst_[0] = (int)a_.x; dst_[1] = (int)a_.y; dst_[2] = (int)a_.z; dst_[3] = (int)b0_; dst_[4] = (int)b1_.x; dst_[5] = (int)b1_.y; } while (0)
#define LOADGROUP(q_, tofs_, E_) do { LOADPAIR(q_[0], tofs_, E_[0], E_[1]); LOADPAIR(q_[1], tofs_, E_[2], E_[3]); LOADPAIR(q_[2], tofs_, E_[4], E_[5]); LOADPAIR(q_[3], tofs_, E_[6], E_[7]); } while (0)
constexpr int VOFS = (int)(WS_PV - WS_PU);
__device__ __forceinline__ void gather_token(const Params& p, const CAS unsigned char* eidg, const __amdgpu_buffer_rsrc_t rsT, int l, int row, int nextrow, TokPref& tp, RowPipe& rp, EpiVec& ev, unsigned char* lds, int lane, int wid) {
  f32x2* GS = (f32x2*)(lds + wid * 2048);
  float* XC = (float*)(p.ws + WS_XCUR);
  const float* MOD = (const float*)(p.ws + WS_MOD);
  const CAS i32x8* EP = eid_row(eidg, row);
  const bool hasnext = nextrow >= 0;
  const CAS i32x8* EPn = eid_row(eidg, hasnext ? nextrow : row);
  GS[lane] = tp.gs0; GS[64 + lane] = tp.gs1;
  asm volatile("s_waitcnt lgkmcnt(0)" ::: "memory");
  const int eofl = ((lane >> 5) & 1) + 2 * ((lane >> 4) & 1) + 4 * ((lane >> 3) & 1);
  const int lane12 = lane * 12;
  {
    h16x2 hh[8];
    {
      const u32x4 hA = tp.hA, hB = tp.hB;
      hh[0] = __builtin_bit_cast(h16x2, __builtin_amdgcn_cvt_pkrtz(bflo(hA.x), bfhi(hA.x))); hh[1] = __builtin_bit_cast(h16x2, __builtin_amdgcn_cvt_pkrtz(bflo(hA.y), bfhi(hA.y))); hh[2] = __builtin_bit_cast(h16x2, __builtin_amdgcn_cvt_pkrtz(bflo(hA.z), bfhi(hA.z))); hh[3] = __builtin_bit_cast(h16x2, __builtin_amdgcn_cvt_pkrtz(bflo(hA.w), bfhi(hA.w)));
      hh[4] = __builtin_bit_cast(h16x2, __builtin_amdgcn_cvt_pkrtz(bflo(hB.x), bfhi(hB.x))); hh[5] = __builtin_bit_cast(h16x2, __builtin_amdgcn_cvt_pkrtz(bflo(hB.y), bfhi(hB.y))); hh[6] = __builtin_bit_cast(h16x2, __builtin_amdgcn_cvt_pkrtz(bflo(hB.z), bfhi(hB.z))); hh[7] = __builtin_bit_cast(h16x2, __builtin_amdgcn_cvt_pkrtz(bflo(hB.w), bfhi(hB.w)));
    }
    if (hasnext) tok_prefetch(p, nextrow, lane, tp);
    { const int mr_ = mod_row(row);
      if (mr_ != ev.mr) {
        const float* g2_ = MOD + ((size_t)l * 5 + mr_) * 6144 + 5 * 1024 + lane * 4;
        const float* ng_ = (l == DEPTH - 1 ? p.in[I_FINALG] : p.in[I_N1G] + (l + 1) * DM) + lane * 4;
        const float* m_ = MOD + ((size_t)(l == DEPTH - 1 ? l : l + 1) * 5 + mr_) * 6144 + lane * 4;
#pragma unroll
        for (int v4 = 0; v4 < 4; ++v4) { ev.g2[v4] = *(const f32x4*)(g2_ + v4 * 256); ev.ng[v4] = *(const f32x4*)(ng_ + v4 * 256); ev.sc[v4] = *(const f32x4*)(m_ + 1024 + v4 * 256); ev.sh[v4] = *(const f32x4*)(m_ + v4 * 256); }
        ev.mr = mr_;
      } }
    f32x4 xpre[4];
    { const float* xr_ = XC + (size_t)row * DM + lane * 4;
#pragma unroll
      for (int v4 = 0; v4 < 4; ++v4) xpre[v4] = *(const f32x4*)(xr_ + v4 * 256); }
    f32x2 acc2[8];
#pragma unroll
    for (int i = 0; i < 8; ++i) acc2[i] = f32x2{0.f, 0.f};
#pragma unroll 1
    for (int g8 = 0; g8 < 16; ++g8) {
      const bool pf = (g8 < 15) || hasnext;
      const f32x2 gs = GS[g8 * 8 + eofl];
      float d[8];
#pragma unroll
      for (int i2 = 0; i2 < 4; ++i2) {
        const h16x32 r = __builtin_amdgcn_cvt_scalef32_pk32_f16_fp6(rp.uq[i2], 1.0f);
        float a0 = 0.f, a1 = 0.f, b0 = 0.f, b1 = 0.f;
#define UDOT(k_) a0 = __builtin_amdgcn_fdot2(__builtin_shufflevector(r, r, 4 * (k_), 4 * (k_) + 1), hh[2 * (k_)], a0, false); b0 = __builtin_amdgcn_fdot2(__builtin_shufflevector(r, r, 16 + 4 * (k_), 17 + 4 * (k_)), hh[2 * (k_)], b0, false); \
        a1 = __builtin_amdgcn_fdot2(__builtin_shufflevector(r, r, 4 * (k_) + 2, 4 * (k_) + 3), hh[2 * (k_) + 1], a1, false); b1 = __builtin_amdgcn_fdot2(__builtin_shufflevector(r, r, 18 + 4 * (k_), 19 + 4 * (k_)), hh[2 * (k_) + 1], b1, false);
        UDOT(0) UDOT(1) UDOT(2) UDOT(3)
#undef UDOT
        d[2 * i2] = a0 + a1;
        d[2 * i2 + 1] = b0 + b1;
        asm volatile("" : "+v"(d[2 * i2]), "+v"(d[2 * i2 + 1]));
      }
      if (pf) LOADGROUP(rp.uq, 0, rp.Ec);
      float tot;
      {
        auto s01 = __builtin_amdgcn_permlane32_swap(__float_as_uint(d[0]), __float_as_uint(d[1]), false, false);
        auto s23 = __builtin_amdgcn_permlane32_swap(__float_as_uint(d[2]), __float_as_uint(d[3]), false, false);
        auto s45 = __builtin_amdgcn_permlane32_swap(__float_as_uint(d[4]), __float_as_uint(d[5]), false, false);
        auto s67 = __builtin_amdgcn_permlane32_swap(__float_as_uint(d[6]), __float_as_uint(d[7]), false, false);
        const float q01 = __uint_as_float(s01[0]) + __uint_as_float(s01[1]), q23 = __uint_as_float(s23[0]) + __uint_as_float(s23[1]);
        const float q45 = __uint_as_float(s45[0]) + __uint_as_float(s45[1]), q67 = __uint_as_float(s67[0]) + __uint_as_float(s67[1]);
        auto ta = __builtin_amdgcn_permlane16_swap(__float_as_uint(q01), __float_as_uint(q23), false, false);
        auto tb = __builtin_amdgcn_permlane16_swap(__float_as_uint(q45), __float_as_uint(q67), false, false);
        const float r0123 = __uint_as_float(ta[0]) + __uint_as_float(ta[1]);
        const float r4567 = __uint_as_float(tb[0]) + __uint_as_float(tb[1]);
        const bool b3 = (lane & 8) != 0;
        const float keep = b3 ? r4567 : r0123, send = b3 ? r0123 : r4567;
        float x = keep + dpp_mov<0x140>(send);
        x += dpp_mov<0xB1>(x); x += dpp_mov<0x4E>(x); x += dpp_mov<0x141>(x);
        tot = x * gs.y;
      }
      float ge;
      {
        const float v = tot, av = fabsf(v), tq = __builtin_amdgcn_rcpf(av * 0.2316418882f + 1.0f);
        float q = tq * 0.5307027145f + (-0.7265760135f); q = q * tq + 0.7107068705f; q = q * tq + (-0.142248368f); q = q * tq + 0.127414796f; q = q * tq;
        const float ex = __builtin_amdgcn_exp2f(v * v * (-0.72134752044f));
        const float m = v * (q * ex), r = v - m;
        ge = (v < 0.f ? m : r) * gs.x;
      }
      unsigned cw[8];
      { const unsigned gp = __builtin_bit_cast(unsigned, __builtin_amdgcn_cvt_pkrtz(ge * 1024.f, ge * 1024.f));
        cw[0] = (unsigned)__builtin_amdgcn_readlane((int)gp, 0);  cw[4] = (unsigned)__builtin_amdgcn_readlane((int)gp, 8);
        cw[2] = (unsigned)__builtin_amdgcn_readlane((int)gp, 16); cw[6] = (unsigned)__builtin_amdgcn_readlane((int)gp, 24);
        cw[1] = (unsigned)__builtin_amdgcn_readlane((int)gp, 32); cw[5] = (unsigned)__builtin_amdgcn_readlane((int)gp, 40);
        cw[3] = (unsigned)__builtin_amdgcn_readlane((int)gp, 48); cw[7] = (unsigned)__builtin_amdgcn_readlane((int)gp, 56); }
      h16x2 a16[8];
#pragma unroll
      for (int i2 = 0; i2 < 4; ++i2) {
        const h16x32 r = __builtin_amdgcn_cvt_scalef32_pk32_f16_fp6(rp.vq[i2], 1.0f);
        const h16x2 ca = __builtin_bit_cast(h16x2, cw[2 * i2]), cb = __builtin_bit_cast(h16x2, cw[2 * i2 + 1]);
#define VAXL(k_) a16[k_] = (i2 == 0) ? ca * __builtin_shufflevector(r, r, 2 * (k_), 2 * (k_) + 1) : ca * __builtin_shufflevector(r, r, 2 * (k_), 2 * (k_) + 1) + a16[k_];
#define VAXH(k_) a16[k_] = cb * __builtin_shufflevector(r, r, 16 + 2 * (k_), 17 + 2 * (k_)) + a16[k_];
        VAXL(0) VAXL(1) VAXL(2) VAXL(3) VAXL(4) VAXL(5) VAXL(6) VAXL(7)
        asm volatile("" : "+v"(a16[0]), "+v"(a16[1]), "+v"(a16[2]), "+v"(a16[3]), "+v"(a16[4]), "+v"(a16[5]), "+v"(a16[6]), "+v"(a16[7]));
        VAXH(0) VAXH(1) VAXH(2) VAXH(3) VAXH(4) VAXH(5) VAXH(6) VAXH(7)
#undef VAXL
#undef VAXH
        asm volatile("" : "+v"(a16[0]), "+v"(a16[1]), "+v"(a16[2]), "+v"(a16[3]), "+v"(a16[4]), "+v"(a16[5]), "+v"(a16[6]), "+v"(a16[7]));
      }
#pragma unroll
      for (int k = 0; k < 8; ++k) acc2[k] = f32x2{(float)a16[k].x, (float)a16[k].y} * f32x2{1.f / 1024.f, 1.f / 1024.f} + acc2[k];
      if (pf) LOADGROUP(rp.vq, VOFS, rp.Ec);
      { const CAS i32x8* src_ = g8 < 14 ? EP + (g8 + 2) : EPn + (g8 - 14); rp.Ec = *src_; }
    }
    SBAR();
    float acc[16];
#pragma unroll
    for (int i = 0; i < 8; ++i) { acc[2 * i] = acc2[i].x; acc[2 * i + 1] = acc2[i].y; }
    float* xr = XC + (size_t)row * DM;
    float xn[16]; float ssq = 0.f;
    if (ABL & 8) {
#pragma unroll
      for (int i = 0; i < 16; ++i) acc[i] = 0.f;
    }
#pragma unroll
    for (int v4 = 0; v4 < 4; ++v4) {
      const int c = lane * 4 + v4 * 256;
      const f32x4 xo = xpre[v4], gg = ev.g2[v4];
      f32x4 o;
      o.x = xo.x + gg.x * acc[v4 * 4 + 0]; o.y = xo.y + gg.y * acc[v4 * 4 + 1]; o.z = xo.z + gg.z * acc[v4 * 4 + 2]; o.w = xo.w + gg.w * acc[v4 * 4 + 3];
      xn[v4 * 4 + 0] = o.x; xn[v4 * 4 + 1] = o.y; xn[v4 * 4 + 2] = o.z; xn[v4 * 4 + 3] = o.w;
      ssq += (o.x * o.x + o.y * o.y) + (o.z * o.z + o.w * o.w);
      if (l < DEPTH - 1) *(f32x4*)(xr + c) = o;
    }
    const float rs = rsqrtf(wave_sum_fast(ssq) * (1.f / DM) + EPS);
    if (l == DEPTH - 1) {
      const int b = row / SEGL, s = row - b * SEGL;
      float* orow = p.out + ((size_t)(b * SEQ + (s - CTXL))) * DM;
#pragma unroll
      for (int v4 = 0; v4 < 4; ++v4) {
        const int c = lane * 4 + v4 * 256;
        const f32x4 gg = ev.ng[v4];
        f32x4 o; o.x = xn[v4 * 4 + 0] * rs * gg.x; o.y = xn[v4 * 4 + 1] * rs * gg.y; o.z = xn[v4 * 4 + 2] * rs * gg.z; o.w = xn[v4 * 4 + 3] * rs * gg.w;
        *(f32x4*)(orow + c) = o;
      }
    } else {
      bf16_t* hrow = (bf16_t*)(p.ws + WS_H) + (size_t)row * DM;
#pragma unroll
      for (int v4 = 0; v4 < 4; ++v4) {
        float y[4];
#pragma unroll
        for (int i = 0; i < 4; ++i) y[i] = xn[v4 * 4 + i] * rs * ev.ng[v4][i] * (1.f + ev.sc[v4][i]) + ev.sh[v4][i];
        *(u32x2*)(hrow + lane * 4 + v4 * 256) = (u32x2){cvtpk(y[0], y[1]), cvtpk(y[2], y[3])};
        int w8 = 0; w8 = __builtin_amdgcn_cvt_pk_fp8_f32(y[0], y[1], w8, false); w8 = __builtin_amdgcn_cvt_pk_fp8_f32(y[2], y[3], w8, true);
        *(int*)(p.ws + WS_H8 + (size_t)row * DM + lane * 4 + v4 * 256) = w8;
      }
    }
  }
}

__device__ __forceinline__ void ev_signal(unsigned* ctr) {
  asm volatile("s_waitcnt vmcnt(0)" ::: "memory");
  __syncthreads();
  if (tidx() == 0) { __builtin_amdgcn_fence(__ATOMIC_RELEASE, "agent"); asm volatile("s_waitcnt vmcnt(0)" ::: "memory"); (void)xb_add(ctr, 1u); }
}
__device__ __forceinline__ void ev_wait(unsigned* ctr, unsigned n, unsigned* bar) {
  if (tidx() == 0) {
    XB_SPIN(xb_ld(ctr) < n, bar);
    __builtin_amdgcn_fence(__ATOMIC_ACQUIRE, "agent");
    asm volatile("s_waitcnt vmcnt(0)" ::: "memory");
  }
  __syncthreads();
}
constexpr int EV_WORD0 = 8192;
__device__ __forceinline__ void phase_c1(const Params& p, int l, unsigned char* lds) {
  constexpr int NLOC = NBATCH * 4 * NCH, NCONV = T / 32;
  for (int u = p.bx; u < NLOC + NCONV; u += p.gx) {
    if (u < NLOC) ml_local_unit2(p, l, u, lds);
    else {
      const int cu = u - NLOC;
      if (l == DEPTH - 1 && (cu % (SEGL / 32)) < (CTXL / 32)) continue;
      conv_unit(p, l, cu, lds);
    }
  }
}
__device__ __forceinline__ void phase_c3(const Params& p, int l, unsigned char* lds);
__device__ __forceinline__ void phase_c2(const Params& p, int l, unsigned char* lds) {
  unsigned* ev = (unsigned*)(p.ws + WS_CTL) + EV_WORD0 + 64 * l;
  ml_scan(p, lds);
  ev_signal(ev);
  const float* lp = p.in[I_DLAM] + l * 256;
  float s01 = 0.f, s23 = 0.f;
  for (int i = 0; i < 64; ++i) { s01 += lp[i] * lp[64 + i]; s23 += lp[128 + i] * lp[192 + i]; }
  const float lam_init = 0.8f - 0.6f * expf(-0.3f * (float)l);
  const float lam = __uint_as_float((unsigned)__builtin_amdgcn_readfirstlane((int)__float_as_uint(expf(s01) - expf(s23) + lam_init)));
  const bf16_t* PROJ = (const bf16_t*)(p.ws + WS_PROJ);
  bf16_t* MIX = (bf16_t*)(p.ws + WS_MIX);
  const float* ng = p.in[I_DNORMG] + l * 128;
  const int nun = 512 + (l < DEPTH - 1 ? 16 : 0);
  for (int u = p.bx; u < nun; u += p.gx) {
    int bh, qrow, nkeys;
    if (u < 512) { const int xcd = u & 7, i = (u >> 3) & 31, rnd = u >> 8; bh = 2 * xcd + rnd; qrow = CTXL + i * 256; nkeys = SEGL; }
    else { bh = u - 512; qrow = 0; nkeys = CTXL; }
    const int b = bh >> 2, h = bh & 3;
    const size_t tok0 = (size_t)b * SEGL;
    for (int rep = 0; rep < REP_ATT; ++rep)
    att_unit(p.ws + WS_QK8 + ((size_t)bh * SEGL + qrow) * QK8_PITCH, p.ws + WS_QK8 + QK8_IMG + (size_t)bh * SEGL * QK8_PITCH, p.ws + WS_V8T + (size_t)bh * NCH * ATT_SHM_V,
             MIX + (tok0 + qrow) * DM + 512 + h * 128, nkeys, lam, ng, 1.f - lam_init, lds);
  }
  ev_wait(ev, (unsigned)p.gx, p.xbar_words);
  for (int rep = 0; rep < REP_ML; ++rep) phase_c3(p, l, lds);
}
__device__ __forceinline__ void phase_c3(const Params& p, int l, unsigned char* lds) {
  constexpr int NU = NBATCH * 4 * NCH;
  const int nlow = (p.gx > 64 && l < DEPTH - 1) ? 16 : 0, ulow = nlow * 7;
  int u, step;
  if (p.bx < nlow) { u = p.bx; step = nlow; } else { u = ulow + (p.bx - nlow); step = p.gx - nlow; }
  const int uend = p.bx < nlow ? ulow : NU;
  int tid_ = tidx(); asm volatile("" : "+v"(tid_));
  auto valid_from = [&](int v) { while (v < uend && l == DEPTH - 1 && (v % NCH) < 4) v += step; return v < uend ? v : -1; };
  MlOutPf fa, fb;
  u = valid_from(u);
  if (u >= 0) ml_out_fetch(p, u, tid_, fa);
  while (u >= 0) {
    const int nx = valid_from(u + step);
    ml_out_unit2(p, l, u, lds, fa, nx, fb);
    fa = fb; u = nx;
  }
}
__device__ __forceinline__ void phase_route(const Params& p, int l, unsigned char* lds) {
  constexpr int NU = T / 32;
  for (int u = p.bx; u < NU; u += p.gx) {
    if (l == DEPTH - 1 && (u % (SEGL / 32)) < (CTXL / 32)) continue;
    route_unit(p, l, u, lds);
    __syncthreads();
  }
}
__device__ __forceinline__ void phase_gather(const Params& p, int l, unsigned char* lds) {
  int tid_ = tidx(); asm volatile("" : "+v"(tid_)); const int lane = tid_ & 63, wid = __builtin_amdgcn_readfirstlane(tid_ >> 6);
  const int gw = p.bx * 8 + wid, NGW = p.gx * 8;
  const int ntok = (l == DEPTH - 1) ? NBATCH * SEQ : T;
#define TOKROW(ti_) ((l == DEPTH - 1) ? ((ti_) / SEQ) * SEGL + CTXL + ((ti_) % SEQ) : (ti_))
  const CAS unsigned char* eidg = (const CAS unsigned char*)(p.ws + WS_EID + (size_t)l * RT_STRIDE);
  const __amdgpu_buffer_rsrc_t rsT = __builtin_amdgcn_make_buffer_rsrc((void*)(p.ws + WS_PU + (size_t)l * NEXP * PROW), 0, VOFS + NEXP * PROW, 0x00020000);
  const int nfull = ntok / NGW, rem = ntok - nfull * NGW, per = (rem % p.gx == 0) ? rem / p.gx : -1;
  auto tok_at = [&](int r) -> int {
    if (r < nfull) return gw + r * NGW;
    if (r > nfull || rem == 0) return -1;
    if (per >= 0) return wid < per ? nfull * NGW + p.bx * per + wid : -1;
    return gw + r * NGW < ntok ? gw + r * NGW : -1;
  };
  TokPref tp; RowPipe rp; EpiVec ev; ev.mr = -1;
  const int ti0 = tok_at(0);
  if (ti0 >= 0) {
    const int row0 = TOKROW(ti0); const int lane12 = lane * 12;
    tok_prefetch(p, row0, lane, tp);
    const CAS i32x8* EP0 = eid_row(eidg, row0);
    rp.Ec = EP0[0];
    LOADGROUP(rp.uq, 0, rp.Ec); LOADGROUP(rp.vq, VOFS, rp.Ec);
    rp.Ec = EP0[1];
  }
  XcdBarrier xb; xb.bar = p.xbar_words; xb.x = p.xbar_x; xb.st = (volatile LAS unsigned*)((LAS unsigned char*)lds + p.lds_st_off);
  const int nrounds = (ntok + NGW - 1) / NGW;
  for (int r = 0; r < nrounds; ++r) {
    const int ti = tok_at(r);
    if (ti >= 0) {
      const int row = TOKROW(ti);
      const int tn = tok_at(r + 1);
      const int nxt = tn >= 0 ? TOKROW(tn) : -1;
      gather_token(p, eidg, rsT, l, row, nxt, tp, rp, ev, lds, lane, wid);
    }
#if GATHER_SYNC
    if (r + 1 < nrounds) { XcdBarrier xb2 = xb; size_t zb_ = 0; asm volatile("" : "+s"(zb_)); xb2.bar = xb.bar + zb_; xb2.x = xb.x + (unsigned)zb_; xcd_barrier(xb2); }
#endif
  }
#undef TOKROW
}

__global__ void __launch_bounds__(512, 2) mk_fwd(KArgs ka) {
  cg::grid_group grid = cg::this_grid();
  extern __shared__ __attribute__((aligned(16))) unsigned char lds[];
  const int lo = ka.ph_lo, hi = ka.ph_hi;
#define IN(k) (lo <= (k) && (k) < hi)
#ifndef PHASEMASK
#define PHASEMASK 0xFFFF
#endif
#define PH(i) ((PHASEMASK >> (i)) & 1)
#define MKP(q) Params q; { size_t z_ = 0; asm volatile("" : "+s"(z_)); \
    q.in = (InTab)((const __attribute__((address_space(4))) char*)__builtin_amdgcn_kernarg_segment_ptr() + z_); \
    q.out = ka.out + z_; q.ws = ka.ws + z_; q.ph_lo = lo; q.ph_hi = hi; q.bx = (int)blockIdx.x + (int)z_; q.gx = (int)gridDim.x + (int)z_; q.xbar_words = xbar.bar + z_; q.xbar_x = xbar.x + (unsigned)z_; q.lds_st_off = (unsigned)(LDS_BYTES - 64); }
#define SEAM(k) do { if (IN(k) && IN((k) + 1)) { if ((k) == 0) grid.sync(); else { XcdBarrier xb_ = xbar; size_t zb_ = 0; asm volatile("" : "+s"(zb_)); xb_.bar = xbar.bar + zb_; xb_.x = xbar.x + (unsigned)zb_; xcd_barrier(xb_); } } } while (0)
  volatile LAS unsigned* xst = (volatile LAS unsigned*)((LAS unsigned char*)lds + (LDS_BYTES - 64));
  { const int t0_ = threadIdx.x;
    if (t0_ < 2) xst[t0_] = 0u;
    if ((t0_ & 63) == 0) *(volatile LAS int*)((LAS unsigned char*)lds + LDS_WTAB + 4 * hw_wave_key()) = t0_ >> 6; }
  __syncthreads();
  XcdBarrier xbar = xcd_barrier_post((unsigned*)(ka.ws + WS_CTL) + 4096, xst);
  { MKP(p)
    if (PH(0) && IN(0)) for (int rep = 0; rep < REP_MISC; ++rep) { p0_mod(p, lds, (float*)(p.ws + WS_MOD)); p0_convert(p, lds); }
  }
  SEAM(0);
  { MKP(p)
    if (PH(1) && IN(1)) phase_norm(p, 0, 0, true, false);
  }
  SEAM(1);
#define LAYER(LL) { \
    int l = (LL); asm volatile("" : "+s"(l)); \
    const int b = 2 + 9 * (LL); \
    { MKP(q) if (PH(2) && IN(b + 0)) for (int rep = 0; rep < REP_GEMM; ++rep) phase_inproj2(q, l, lds); } \
    SEAM(b + 0); \
    { MKP(q) if (PH(3) && IN(b + 1)) for (int rep = 0; rep < REP_ML; ++rep) phase_c1(q, l, lds); } \
    SEAM(b + 1); \
    { MKP(q) if (PH(4) && IN(b + 2)) phase_c2(q, l, lds); } \
    SEAM(b + 3); \
    { MKP(q) if (PH(6) && IN(b + 4)) phase_outproj2(q, l, lds); } \
    SEAM(b + 4); \
    { MKP(q) if (PH(7) && IN(b + 5)) for (int rep = 0; rep < REP_MISC; ++rep) phase_norm(q, l, 1, false, (LL) == DEPTH - 1); } \
    SEAM(b + 5); \
    { MKP(q) if (PH(8) && IN(b + 6)) for (int rep = 0; rep < REP_GEMM; ++rep) phase_peerq2(q, l, lds); } \
    SEAM(b + 6); \
    { MKP(q) if (PH(9) && IN(b + 7)) phase_route(q, l, lds); } \
    SEAM(b + 7); \
    { MKP(q) if (PH(9) && IN(b + 8)) phase_gather(q, l, lds); } \
    SEAM(b + 8); }
  LAYER(0) LAYER(1) LAYER(2) LAYER(3)
#undef LAYER
#undef IN
#undef SEAM
#undef MKP
}

extern "C" void kernel_launch(void* const* d_in, const int* in_sizes, int n_in, void* d_out, int out_size,
                              void* d_ws, size_t ws_size, hipStream_t stream) {
  static int grid = 0;
  if (grid == 0) {
    int dev = 0, cus = 0, per_cu = 0;
    (void)hipGetDevice(&dev);
    (void)hipDeviceGetAttribute(&cus, hipDeviceAttributeMultiprocessorCount, dev);
    (void)hipFuncSetAttribute((const void*)mk_fwd, hipFuncAttributeMaxDynamicSharedMemorySize, LDS_BYTES);
    (void)hipOccupancyMaxActiveBlocksPerMultiprocessor(&per_cu, (const void*)mk_fwd, 512, LDS_BYTES);
    fprintf(stderr, "kernel_launch: cus %d per_cu %d ws %zu (need %zu) n_in %d\n", cus, per_cu, ws_size, (size_t)WS_END, n_in);
    if (ws_size < WS_END || n_in != 23 || per_cu < 1) { fprintf(stderr, "kernel_launch: bad configuration, nothing launched\n"); grid = -1; return; }
    grid = cus;
  }
  if (grid < 0) return;
  (void)hipMemsetAsync((char*)d_ws + WS_CTL, 0, 65536, stream);
  KArgs p{};
  for (int i = 0; i < 23; ++i) p.in[i] = (const float*)d_in[i];
  p.out = (float*)d_out; p.ws = (unsigned char*)d_ws; p.ph_lo = 0; p.ph_hi = 38;
  void* args[] = {&p};
  hipError_t e = hipLaunchCooperativeKernel((const void*)mk_fwd, dim3(grid), dim3(512), args, LDS_BYTES, stream);
  if (e != hipSuccess) fprintf(stderr, "cooperative launch failed: %s (grid %d)\n", hipGetErrorString(e), grid);
}
```

```cpp
#include <hip/hip_runtime.h>
#include <hip/hip_cooperative_groups.h>
#include <cstdio>
#include <cstdint>
namespace cg = cooperative_groups;

constexpr int DM = 1024, NBATCH = 4, SEQ = 8192, CTXL = 256, SEGL = CTXL + SEQ, T = NBATCH * SEGL, DEPTH = 4;
constexpr int IN_W = 3088, PW = 3072;
constexpr int QK8_PITCH = 144; constexpr size_t QK8_IMG = (size_t)16 * SEGL * QK8_PITCH;
constexpr int C_A = 0, C_MQ = 512, C_MK = 768, C_MV = 1024, C_MO = 1280, C_DQ = 1536, C_DK = 2048, C_DV = 2560;
constexpr int NCH = SEGL / 64;
constexpr int NEXP = 16384;
constexpr float EPS = 1e-6f;
#ifndef ABL
#define ABL 0
#endif
#ifndef GATHER_SYNC
#define GATHER_SYNC 0
#endif
#ifndef REP_ATT
#define REP_ATT 1
#endif
#ifndef GP_MASK
#define GP_MASK 0x3FFF
#endif
#ifndef REP_PEER
#define REP_PEER 1
#endif
#ifndef REP_GEMM
#define REP_GEMM 1
#endif
#ifndef REP_ROUTE
#define REP_ROUTE 1
#endif
#ifndef REP_OUTP
#define REP_OUTP 1
#endif
#ifndef REP_ML
#define REP_ML 1
#endif
#ifndef REP_MISC
#define REP_MISC 1
#endif
constexpr float QSCALE = 0.125f * 1.4426950408889634f;

constexpr size_t MiB = 1u << 20;
constexpr size_t WS_CTL = 0, WS_MOD = 1 * MiB, WS_ROPE = 2 * MiB, WS_WG = 4 * MiB, WS_KEYS = 5 * MiB, WS_MLMETA = 6 * MiB,
                 WS_GATES = 7 * MiB, WS_WIN = 10 * MiB, WS_WOUT = 34 * MiB, WS_WQ = 42 * MiB, WS_PU = 50 * MiB, WS_PV = 114 * MiB, WS_PSC = 178 * MiB  , WS_H8 = 180 * MiB  , WS_W8 = 216 * MiB  ,
                 WS_XCUR = 306 * MiB, WS_H = 438 * MiB, WS_MIX = 504 * MiB, WS_PROJ = 570 * MiB, WS_ULOC = 768 * MiB, WS_V8T = 836 * MiB  , WS_EID = 858 * MiB  , WS_QK8 = 924 * MiB  , WS_END = 964 * MiB;
constexpr int USTRIDE = 4160;

constexpr int LDS_BYTES = 139264 + 512;
constexpr int LDS_WTAB = LDS_BYTES - 64 - 256;

#define LAS __attribute__((address_space(3)))
__device__ __forceinline__ int hw_wave_key() { return (int)(__builtin_amdgcn_s_getreg((5 << 11) | 4) & 63u); }
__device__ __forceinline__ int tidx() {
  extern __shared__ __attribute__((aligned(16))) unsigned char lds_dyn_[];
  const int w = __builtin_amdgcn_readfirstlane(*(const volatile LAS int*)((LAS unsigned char*)lds_dyn_ + LDS_WTAB + 4 * hw_wave_key()));
  unsigned z_ = 0u; asm volatile("" : "+v"(z_));
  return (w << 6) | (int)__builtin_amdgcn_mbcnt_hi(~0u, __builtin_amdgcn_mbcnt_lo(~0u, z_));
}
typedef unsigned short bf16_t;
typedef short bf16x8 __attribute__((ext_vector_type(8)));
typedef short s16x4 __attribute__((ext_vector_type(4)));
typedef float f32x4 __attribute__((ext_vector_type(4)));
typedef float f32x16 __attribute__((ext_vector_type(16)));
typedef unsigned u32x4 __attribute__((ext_vector_type(4)));
typedef unsigned u32x2 __attribute__((ext_vector_type(2)));
typedef __bf16 bf16x2v __attribute__((ext_vector_type(2)));
typedef int i32x8 __attribute__((ext_vector_type(8)));
typedef int i32x6 __attribute__((ext_vector_type(6)));
struct __attribute__((aligned(4))) u32x3 { unsigned x, y, z; };
typedef float f32x32 __attribute__((ext_vector_type(32)));
constexpr int PROW = 768;
typedef float f32x2 __attribute__((ext_vector_type(2)));
typedef _Float16 h16x2 __attribute__((ext_vector_type(2)));
typedef _Float16 h16x32 __attribute__((ext_vector_type(32)));
typedef unsigned u32x3v __attribute__((ext_vector_type(3)));
typedef unsigned u32x2v __attribute__((ext_vector_type(2)));

struct KArgs {
  const float* in[23];
  float* out;
  unsigned char* ws;
  int ph_lo, ph_hi;
};
typedef const float* const __attribute__((address_space(4))) * InTab;
struct Params {
  InTab in;
  float* out;
  unsigned char* ws;
  int ph_lo, ph_hi;
  int bx, gx;
  unsigned* xbar_words; unsigned xbar_x; unsigned lds_st_off;
};
enum { I_X = 0, I_C, I_CTX, I_CCTX, I_ADAW, I_ADAB, I_N1G, I_N2G, I_WIN, I_CONVW, I_CONVB, I_CLNG, I_CLNB, I_GATEB, I_MNORMG, I_DLAM, I_DNORMG,
       I_WOUT, I_PWQ, I_PKEYS, I_PU, I_PV, I_FINALG };

__device__ __forceinline__ unsigned cvtpk(float lo, float hi) { unsigned r; asm volatile("v_cvt_pk_bf16_f32 %0, %1, %2" : "=v"(r) : "v"(lo), "v"(hi)); return r; }
__device__ __forceinline__ float bflo(unsigned u) { return __uint_as_float(u << 16); }
__device__ __forceinline__ float bfhi(unsigned u) { return __uint_as_float(u & 0xffff0000u); }
__device__ __forceinline__ float bf1(bf16_t u) { return __uint_as_float(((unsigned)u) << 16); }
__device__ __forceinline__ int crow(int r, int hi) { return (r & 3) + 8 * (r >> 2) + 4 * hi; }
template <int CTRL> __device__ __forceinline__ float dpp_mov(float v) {
  return __uint_as_float((unsigned)__builtin_amdgcn_update_dpp(0, (int)__float_as_uint(v), CTRL, 0xF, 0xF, true));
}
__device__ __forceinline__ float wave_sum_fast(float x) {
  x += dpp_mov<0xB1>(x); x += dpp_mov<0x4E>(x); x += dpp_mov<0x141>(x); x += dpp_mov<0x140>(x);
  { auto r = __builtin_amdgcn_permlane16_swap(__float_as_uint(x), __float_as_uint(x), false, false); x = __uint_as_float(r[0]) + __uint_as_float(r[1]); }
  { auto r = __builtin_amdgcn_permlane32_swap(__float_as_uint(x), __float_as_uint(x), false, false); x = __uint_as_float(r[0]) + __uint_as_float(r[1]); }
  return x;
}
__device__ __forceinline__ float wave_max_fast(float x) {
  x = fmaxf(x, dpp_mov<0xB1>(x)); x = fmaxf(x, dpp_mov<0x4E>(x)); x = fmaxf(x, dpp_mov<0x141>(x)); x = fmaxf(x, dpp_mov<0x140>(x));
  { auto r = __builtin_amdgcn_permlane16_swap(__float_as_uint(x), __float_as_uint(x), false, false); x = fmaxf(__uint_as_float(r[0]), __uint_as_float(r[1])); }
  { auto r = __builtin_amdgcn_permlane32_swap(__float_as_uint(x), __float_as_uint(x), false, false); x = fmaxf(__uint_as_float(r[0]), __uint_as_float(r[1])); }
  return x;
}
template <int CTRL, int ROWMASK> __device__ __forceinline__ float dpp_mov_rm(float v) {
  return __uint_as_float((unsigned)__builtin_amdgcn_update_dpp(0, (int)__float_as_uint(v), CTRL, ROWMASK, 0xF, true));
}
__device__ __forceinline__ float wave_incl_scan(float x) {
  x += dpp_mov<0x111>(x); x += dpp_mov<0x112>(x); x += dpp_mov<0x114>(x); x += dpp_mov<0x118>(x);
  x += dpp_mov_rm<0x142, 0xA>(x);
  x += dpp_mov_rm<0x143, 0xC>(x);
  return x;
}
__device__ __forceinline__ float wave_sum(float v) { return wave_sum_fast(v); }
__device__ __forceinline__ float sum_xor32(float x) { auto r = __builtin_amdgcn_permlane32_swap(__float_as_uint(x), __float_as_uint(x), false, false); return __uint_as_float(r[0]) + __uint_as_float(r[1]); }
__device__ __forceinline__ float max_xor32(float x) { auto r = __builtin_amdgcn_permlane32_swap(__float_as_uint(x), __float_as_uint(x), false, false); return fmaxf(__uint_as_float(r[0]), __uint_as_float(r[1])); }
__device__ __forceinline__ float wave_max(float v) { return wave_max_fast(v); }
__device__ __forceinline__ float sigmoidf_(float x) { return 1.f / (1.f + __expf(-x)); }
__device__ __forceinline__ float logsigmoidf_(float x) { return fminf(x, 0.f) - log1pf(__expf(-fabsf(x))); }
__device__ __forceinline__ const float* in_row(const float* x, const float* ctx, int row) {
  const int b = row / SEGL, s = row - b * SEGL;
  return s < CTXL ? ctx + ((size_t)(b * CTXL + s)) * DM : x + ((size_t)(b * SEQ + (s - CTXL))) * DM;
}
__device__ __forceinline__ int mod_row(int row) { const int b = row / SEGL, s = row - b * SEGL; return s < CTXL ? 4 : b; }

__device__ __forceinline__ void p0_mod(const Params& p, unsigned char* lds, float* MOD) {
  float* sil = (float*)lds;
  float* red = (float*)(lds + 20480);
  int tid_ = tidx(); asm volatile("" : "+v"(tid_)); const int tid = tid_, lane = tid & 63, wid = tid >> 6;
  for (int i = tid; i < 5 * 1024; i += 512) {
    const float v = i < 4096 ? p.in[I_C][i] : p.in[I_CCTX][i - 4096];
    sil[i] = v / (1.f + __expf(-v));
  }
  __syncthreads();
  for (int item = p.bx; item < DEPTH * 96; item += p.gx) {
    const int l = item / 96, j0 = (item % 96) * 64;
    const float* W = p.in[I_ADAW] + (size_t)l * DM * 6144 + j0 + lane;
    float a0 = 0.f, a1 = 0.f, a2 = 0.f, a3 = 0.f, a4 = 0.f;
    const int k0 = wid * 128;
#pragma unroll 8
    for (int k = k0; k < k0 + 128; ++k) {
      const float w = W[(size_t)k * 6144];
      a0 += sil[k] * w; a1 += sil[1024 + k] * w; a2 += sil[2048 + k] * w; a3 += sil[3072 + k] * w; a4 += sil[4096 + k] * w;
    }
    red[(wid * 5 + 0) * 64 + lane] = a0; red[(wid * 5 + 1) * 64 + lane] = a1; red[(wid * 5 + 2) * 64 + lane] = a2;
    red[(wid * 5 + 3) * 64 + lane] = a3; red[(wid * 5 + 4) * 64 + lane] = a4;
    __syncthreads();
    if (tid < 320) {
      const int r = tid >> 6;
      float s = 0.f;
#pragma unroll
      for (int w = 0; w < 8; ++w) s += red[(w * 5 + r) * 64 + lane];
      MOD[((size_t)l * 5 + r) * 6144 + j0 + lane] = s + p.in[I_ADAB][l * 6144 + j0 + lane];
    }
    __syncthreads();
  }
}
__device__ __forceinline__ void transpose_item(const float* W, int ldw, int srccol0, bf16_t* WT, int K, int n0, int k0, float* scr, int lane, unsigned char* W8 = nullptr) {
#pragma unroll 8
  for (int i = 0; i < 32; ++i) { const int kk = 2 * i + (lane >> 5); scr[kk * 33 + (lane & 31)] = W[(size_t)(k0 + kk) * ldw + srccol0 + (lane & 31)]; }
  asm volatile("s_waitcnt lgkmcnt(0)" ::: "memory");
  const int c = lane & 7;
#pragma unroll
  for (int j = 0; j < 4; ++j) {
    const int n = (lane >> 3) + 8 * j; const float* s = scr + (8 * c) * 33 + n;
    u32x4 o; o.x = cvtpk(s[0], s[33]); o.y = cvtpk(s[66], s[99]); o.z = cvtpk(s[132], s[165]); o.w = cvtpk(s[198], s[231]);
    *(u32x4*)(WT + (size_t)(n0 + n) * K + k0 + 8 * c) = o;
    if (W8) {
      int w0 = 0, w1 = 0;
      w0 = __builtin_amdgcn_cvt_pk_fp8_f32(s[0] * 32.f, s[33] * 32.f, w0, false); w0 = __builtin_amdgcn_cvt_pk_fp8_f32(s[66] * 32.f, s[99] * 32.f, w0, true);
      w1 = __builtin_amdgcn_cvt_pk_fp8_f32(s[132] * 32.f, s[165] * 32.f, w1, false); w1 = __builtin_amdgcn_cvt_pk_fp8_f32(s[198] * 32.f, s[231] * 32.f, w1, true);
      *(u32x2*)(W8 + (size_t)(n0 + n) * K + k0 + 8 * c) = (u32x2){(unsigned)w0, (unsigned)w1};
    }
  }
  asm volatile("s_waitcnt lgkmcnt(0)" ::: "memory");
}
__device__ __forceinline__ void convert_tables(const Params& p, int L, int wv, int nw, int lane, int r_lo, int r_hi) {
  unsigned char* PUq = p.ws + WS_PU; unsigned char* PVq = p.ws + WS_PV; float* PSC = (float*)(p.ws + WS_PSC);
  const int nrows = DEPTH * NEXP;
#define TAB_SROW(r_) ((const f32x4*)(((r_) >= NEXP ? p.in[I_PV] : p.in[I_PU]) + (size_t)(L * NEXP + ((r_) >= NEXP ? (r_) - NEXP : (r_))) * DM) + lane)
#define TAB_LOAD(v_, r_) do { if ((r_) < r_hi) { const f32x4* s_ = TAB_SROW(r_); _Pragma("unroll") for (int j = 0; j < 4; ++j) v_[j] = __builtin_nontemporal_load(s_ + 64 * j); } } while (0)
  auto encode_row = [&](const f32x4 (&v)[4], int r) {
    const int tb = r >= NEXP, rr = L * NEXP + (tb ? r - NEXP : r);
    float mx = 0.f;
#pragma unroll
    for (int j = 0; j < 4; ++j) mx = fmaxf(mx, fmaxf(fmaxf(fabsf(v[j].x), fabsf(v[j].y)), fmaxf(fabsf(v[j].z), fabsf(v[j].w))));
    mx = wave_max_fast(mx);
    const unsigned mb = __float_as_uint(mx);
    const int eb = (int)((mb >> 23) & 0xFFu);
    int sb = ((mb & 0x7FFFFFu) <= 0x700000u ? 129 : 128) - eb + 127; sb = sb < 1 ? 1 : (sb > 253 ? 253 : sb);
    const float sc = __uint_as_float((unsigned)sb << 23), isc = __uint_as_float((unsigned)(254 - sb) << 23);
    const float xv[16] = {v[0].x, v[0].y, v[0].z, v[0].w, v[1].x, v[1].y, v[1].z, v[1].w, v[2].x, v[2].y, v[2].z, v[2].w, v[3].x, v[3].y, v[3].z, v[3].w};
    unsigned wq[3] = {0u, 0u, 0u};
#pragma unroll
    for (int i = 0; i < 16; ++i) {
      const float a = fabsf(xv[i]) * sc;
      unsigned code = a < 2.f ? (unsigned)__builtin_rintf(a * 8.f) : (a < 4.f ? 8u + (unsigned)__builtin_rintf(a * 4.f) : 16u + (unsigned)__builtin_rintf(a * 2.f));
      code = code > 31u ? 31u : code;
      code |= (xv[i] < 0.f) ? 32u : 0u;
      const int bp = 6 * i, dw = bp >> 5, off = bp & 31;
      wq[dw] |= code << off;
      if (off > 26) wq[dw + 1] |= code >> (32 - off);
    }
    u32x3 o; o.x = wq[0]; o.y = wq[1]; o.z = wq[2];
    *(u32x3*)((tb ? PVq : PUq) + (size_t)rr * PROW + lane * 12) = o;
    if (lane == 0) PSC[(size_t)tb * nrows + rr] = isc;
  };
  f32x4 v0[4], v1[4], v2[4];
  TAB_LOAD(v0, r_lo + wv); TAB_LOAD(v1, r_lo + wv + nw);
#pragma unroll 1
  for (int r = r_lo + wv; r < r_hi; r += 3 * nw) {
    TAB_LOAD(v2, r + 2 * nw); encode_row(v0, r);
    if (r + nw < r_hi) { TAB_LOAD(v0, r + 3 * nw); encode_row(v1, r + nw); }
    if (r + 2 * nw < r_hi) { TAB_LOAD(v1, r + 4 * nw); encode_row(v2, r + 2 * nw); }
  }
#undef TAB_LOAD
#undef TAB_SROW
}
__device__ __forceinline__ void tail_filler_tables(const Params& p, int L, int nwg, int r_lo, int r_hi) {
  int tid_ = tidx(); asm volatile("" : "+v"(tid_)); const int lane = tid_ & 63, wid = tid_ >> 6;
  const int nextra = nwg % p.gx, first = nextra, nidle = p.gx - nextra;
  if (p.bx < first) return;
  convert_tables(p, L, (p.bx - first) * 8 + wid, nidle * 8, lane, r_lo, r_hi);
}
__device__ __forceinline__ void p0_convert(const Params& p, unsigned char* lds) {
  int tid_ = tidx(); asm volatile("" : "+v"(tid_)); const int tid = tid_, lane = tid & 63, wid = tid >> 6;
  const int gw = p.bx * 8 + wid, NGW = p.gx * 8;
  const size_t gt = (size_t)p.bx * 512 + tid, NGT = (size_t)p.gx * 512;
  float* scr = (float*)(lds + 32768) + wid * (64 * 33);
  bf16_t* WIN = (bf16_t*)(p.ws + WS_WIN); bf16_t* WOUT = (bf16_t*)(p.ws + WS_WOUT); bf16_t* WQ = (bf16_t*)(p.ws + WS_WQ);
  constexpr int I_IN = 16 * 96, I_O = 16 * 32, PER_L = I_IN + 2 * I_O;
  for (int it = gw; it < DEPTH * PER_L; it += NGW) {
    const int l = it / PER_L; int r = it % PER_L;
    if (r < I_IN) { const int kb = r / 96, nb = r % 96, n0 = nb * 32; const int src = n0 < 1536 ? n0 : n0 + 16;
      transpose_item(p.in[I_WIN] + (size_t)l * DM * IN_W, IN_W, src, WIN + (size_t)l * PW * DM, DM, n0, kb * 64, scr, lane, p.ws + WS_W8 + (size_t)l * PW * DM); continue; }
    r -= I_IN;
    if (r < I_O) { const int kb = r / 32, nb = r % 32;
      transpose_item(p.in[I_WOUT] + (size_t)l * DM * DM, DM, nb * 32, WOUT + (size_t)l * DM * DM, DM, nb * 32, kb * 64, scr, lane); continue; }
    r -= I_O;
    { const int kb = r / 32, nb = r % 32;
      transpose_item(p.in[I_PWQ] + (size_t)l * DM * DM, DM, nb * 32, WQ + (size_t)l * DM * DM, DM, nb * 32, kb * 64, scr, lane); }
  }
  bf16_t* WG = (bf16_t*)(p.ws + WS_WG);
  for (size_t i = gt; i < (size_t)DEPTH * 16 * DM; i += NGT) {
    const int l = (int)(i / (16 * DM)), g = (int)((i / DM) % 16), k = (int)(i % DM);
    WG[i] = (bf16_t)(cvtpk(p.in[I_WIN][(size_t)l * DM * IN_W + (size_t)k * IN_W + 1536 + g], 0.f) & 0xffffu);
  }
  bf16_t* KEYS = (bf16_t*)(p.ws + WS_KEYS);
  for (size_t i = gt; i < (size_t)DEPTH * 131072 / 8; i += NGT) {
    const f32x4 a = ((const f32x4*)p.in[I_PKEYS])[2 * i], b = ((const f32x4*)p.in[I_PKEYS])[2 * i + 1];
    u32x4 o; o.x = cvtpk(a.x, a.y); o.y = cvtpk(a.z, a.w); o.z = cvtpk(b.x, b.y); o.w = cvtpk(b.z, b.w);
    ((u32x4*)KEYS)[i] = o;
  }
  {
    float* RC = (float*)(p.ws + WS_ROPE); float* RS = RC + SEQ * 32;
    for (size_t i = gt; i < (size_t)SEQ * 32; i += NGT) {
      const int pos = (int)(i >> 5), j = (int)(i & 31);
      const int rr = pos >> 6, cc = pos & 63;
      const int jj = j & 15;
      const double e = -(double)jj * 0.83048202372184058696;
      const double fl = __builtin_floor(e); const double f = e - fl;
      const double z = f * 0.69314718055994530942;
      double ez = 1.0 + z * (1.0 + z * (0.5 + z * (1.0 / 6 + z * (1.0 / 24 + z * (1.0 / 120 + z * (1.0 / 720 + z * (1.0 / 5040 + z * (1.0 / 40320 + z * (1.0 / 362880 + z * (1.0 / 3628800 + z * (1.0 / 39916800 + z * (1.0 / 479001600))))))))))));
      const double inv = __builtin_ldexp(ez, (int)fl);
      const float invf = (float)inv;
      const float angf = (float)(j < 16 ? rr : cc) * invf;
      const double ang = (double)angf;
      const double kq = __builtin_rint(ang * 0.63661977236758134308);
      double r = __builtin_fma(-kq, 1.57079632679489655800e+00, ang);
      r = __builtin_fma(-kq, 6.12323399573676603587e-17, r);
      const double r2 = r * r;
      const double sn = r * (1.0 + r2 * (-1.0 / 6 + r2 * (1.0 / 120 + r2 * (-1.0 / 5040 + r2 * (1.0 / 362880 + r2 * (-1.0 / 39916800 + r2 * (1.0 / 6227020800.0)))))));
      const double cs = 1.0 + r2 * (-0.5 + r2 * (1.0 / 24 + r2 * (-1.0 / 720 + r2 * (1.0 / 40320 + r2 * (-1.0 / 3628800 + r2 * (1.0 / 479001600 + r2 * (-1.0 / 87178291200.0)))))));
      const int q = ((int)kq) & 3;
      double co, si;
      if (q == 0) { co = cs; si = sn; } else if (q == 1) { co = -sn; si = cs; } else if (q == 2) { co = -cs; si = -sn; } else { co = sn; si = -cs; }
      RC[i] = (float)co; RS[i] = (float)si;
    }
  }
}

__device__ __forceinline__ void norm_mod_row(const float* xrow, const float* g, const float* sc, const float* sh, bf16_t* orow, int lane) {
  const f32x4* xr = (const f32x4*)xrow + lane;
  f32x4 v[4]; float s = 0.f;
#pragma unroll
  for (int j = 0; j < 4; ++j) { v[j] = xr[64 * j]; s += (v[j].x * v[j].x + v[j].y * v[j].y) + (v[j].z * v[j].z + v[j].w * v[j].w); }
  const float rs = rsqrtf(wave_sum(s) * (1.f / DM) + EPS);
  u32x2* o = (u32x2*)orow + lane;
#pragma unroll
  for (int j = 0; j < 4; ++j) {
    const f32x4 gg = ((const f32x4*)g)[lane + 64 * j], cc = ((const f32x4*)sc)[lane + 64 * j], hh = ((const f32x4*)sh)[lane + 64 * j];
    const float y0 = v[j].x * rs * gg.x * (1.f + cc.x) + hh.x, y1 = v[j].y * rs * gg.y * (1.f + cc.y) + hh.y;
    const float y2 = v[j].z * rs * gg.z * (1.f + cc.z) + hh.z, y3 = v[j].w * rs * gg.w * (1.f + cc.w) + hh.w;
    u32x2 w; w.x = cvtpk(y0, y1); w.y = cvtpk(y2, y3);
    o[64 * j] = w;
  }
}
__device__ __forceinline__ void phase_norm(const Params& p, int l, int which, bool from_input, bool skip_ctx) {
  int tid_ = tidx(); asm volatile("" : "+v"(tid_));
  const int lane = tid_ & 63, wid = tid_ >> 6;
  const int gw = p.bx * 8 + wid, NGW = p.gx * 8;
  const float* MOD = (const float*)(p.ws + WS_MOD);
  const float* XC = (const float*)(p.ws + WS_XCUR);
  bf16_t* H = (bf16_t*)(p.ws + WS_H);
  const float* g = p.in[which ? I_N2G : I_N1G] + l * DM;
  auto next_row = [&](int r_) { while (r_ < T && skip_ctx && mod_row(r_) == 4) r_ += NGW; return r_; };
  auto xrow_of = [&](int r_) { return (const f32x4*)(from_input ? in_row(p.in[I_X], p.in[I_CTX], r_) : XC + (size_t)r_ * DM) + lane; };
  f32x4 gg[4], cc[4], hh[4], v[4], vn[4];
#pragma unroll
  for (int j = 0; j < 4; ++j) gg[j] = ((const f32x4*)g)[lane + 64 * j];
  int mr_cur = -1;
  int row = next_row(gw);
  if (row < T) { const f32x4* xr = xrow_of(row);
#pragma unroll
    for (int j = 0; j < 4; ++j) v[j] = xr[64 * j]; }
  while (row < T) {
    const int nrow = next_row(row + NGW);
    if (nrow < T) { const f32x4* xn = xrow_of(nrow);
#pragma unroll
      for (int j = 0; j < 4; ++j) vn[j] = xn[64 * j]; }
    const int mr = mod_row(row);
    if (mr != mr_cur) {
      const float* m = MOD + ((size_t)l * 5 + mr) * 6144 + which * 3072;
#pragma unroll
      for (int j = 0; j < 4; ++j) { cc[j] = ((const f32x4*)(m + 1024))[lane + 64 * j]; hh[j] = ((const f32x4*)m)[lane + 64 * j]; }
      mr_cur = mr;
    }
    float s = 0.f;
#pragma unroll
    for (int j = 0; j < 4; ++j) s += (v[j].x * v[j].x + v[j].y * v[j].y) + (v[j].z * v[j].z + v[j].w * v[j].w);
    const float rs = rsqrtf(wave_sum(s) * (1.f / DM) + EPS);
    u32x2* o = (u32x2*)(H + (size_t)row * DM) + lane;
#pragma unroll
    for (int j = 0; j < 4; ++j) {
      const float y0 = v[j].x * rs * gg[j].x * (1.f + cc[j].x) + hh[j].x, y1 = v[j].y * rs * gg[j].y * (1.f + cc[j].y) + hh[j].y;
      const float y2 = v[j].z * rs * gg[j].z * (1.f + cc[j].z) + hh[j].z, y3 = v[j].w * rs * gg[j].w * (1.f + cc[j].w) + hh[j].w;
      u32x2 w; w.x = cvtpk(y0, y1); w.y = cvtpk(y2, y3);
      o[64 * j] = w;
      if (which == 0) {
        int w8 = 0; w8 = __builtin_amdgcn_cvt_pk_fp8_f32(y0, y1, w8, false); w8 = __builtin_amdgcn_cvt_pk_fp8_f32(y2, y3, w8, true);
        ((int*)(p.ws + WS_H8 + (size_t)row * DM))[lane + 64 * j] = w8;
      }
    }
#pragma unroll
    for (int j = 0; j < 4; ++j) v[j] = vn[j];
    row = nrow;
  }
}

namespace pg8 {
#define PG8_LAS __attribute__((address_space(3)))
typedef unsigned short bf16_t;
typedef short bf16x8 __attribute__((ext_vector_type(8)));
typedef float f32x4 __attribute__((ext_vector_type(4)));
typedef unsigned u32x4 __attribute__((ext_vector_type(4)));
typedef int i32x4v __attribute__((ext_vector_type(4)));
typedef int i32x8v __attribute__((ext_vector_type(8)));
constexpr int BM = 256, BK = 64, HALF = 128, HTB = HALF * BK * 2  , STAGE_BYTES = 8 * HTB, NXCD = 8, WGM = 8;

__host__ __device__ __forceinline__ int lds_byte(int r, int c) { const int st = (r >> 4) * 2 + (c >> 5), rr = r & 15, cc = c & 31, ob = rr * 64 + cc * 2; return st * 1024 + (ob ^ (((ob >> 9) & 1) << 5)); }
__host__ __device__ __forceinline__ void stage_rc(int b, int& R, int& C) { const int st = b / 1024, sb = b % 1024, swz = sb ^ (((sb >> 9) & 1) << 5); R = (st >> 1) * 16 + swz / 64; C = (st & 1) * 32 + (swz % 64) / 2; }
__host__ __device__ __forceinline__ int perm32(int rho) { const int n = rho >> 4, i = rho & 15; return 8 * (i >> 2) + 4 * n + (i & 3); }

struct Unit { int pm, pn; };
struct Gemm { const bf16_t* A; const bf16_t* Bt; int M, N, K; };

struct StaticOrder {
    int nM, nN, nwg, G, c;
    __host__ __device__ void init(int M, int N, int G_, int c_) { nM = M / BM; nN = N / BM; nwg = nM * nN; G = G_; c = c_; }
    __host__ __device__ bool next(int i, Unit& u) const {
        const long L = (long)i * G + c; if (L >= nwg) return false;
        int wgid = (int)L; { const int q = nwg / NXCD, r = nwg % NXCD, xcd = wgid % NXCD, off = wgid / NXCD; wgid = (xcd < r ? xcd * (q + 1) : r * (q + 1) + (xcd - r) * q) + off; }
        const int nig = WGM * nN, gid = wgid / nig, fm = gid * WGM, gsz = (nM - fm) < WGM ? (nM - fm) : WGM;
        u.pm = fm + ((wgid % nig) % gsz); u.pn = (wgid % nig) / gsz; return true;
    }
    __device__ __forceinline__ void a_ready(const Unit&) const {}
    __device__ __forceinline__ void done(const Unit&) const {}
};
struct F8Order {
    int nM, G, c, heavy, nwg, nN, pn0;
    __host__ __device__ void init(int M, int G_, int c_, int heavy_, int nN_ = 6, int pn0_ = 6) { nM = M / BM; G = G_; c = c_; heavy = heavy_; nN = nN_; pn0 = pn0_; nwg = nM * nN; }
    __host__ __device__ bool next(int i, Unit& u) const {
        int L;
        const int nl = G - heavy, tailbase = nwg - 2 * heavy;
        if (c >= heavy) { L = i * nl + (c - heavy); if (L >= tailbase) return false; }
        else { if (i > 1) return false; L = tailbase + 2 * c + i; }
        int wgid = L; { const int q = nwg / NXCD, r = nwg % NXCD, xcd = wgid % NXCD, off = wgid / NXCD; wgid = (xcd < r ? xcd * (q + 1) : r * (q + 1) + (xcd - r) * q) + off; }
        const int nig = WGM * nN, gid = wgid / nig, fm = gid * WGM, gsz = (nM - fm) < WGM ? (nM - fm) : WGM;
        u.pm = fm + ((wgid % nig) % gsz); u.pn = pn0 + (wgid % nig) / gsz; return true;
    }
    __device__ __forceinline__ void a_ready(const Unit&) const {}
    __device__ __forceinline__ void done(const Unit&) const {}
};
__device__ __forceinline__ unsigned cvt_pk_bf16(float lo, float hi) { unsigned r; asm volatile("v_cvt_pk_bf16_f32 %0, %1, %2" : "=v"(r) : "v"(lo), "v"(hi)); return r; }
template <class Epi, class Sched, bool ALIGN_EPI = false, bool SP2 = false, bool F8 = false>
__device__ __forceinline__ void gemm_phase(PG8_LAS unsigned char* lds, const Gemm g, const Sched& S, const Epi& E) {
    const int tid = tidx(), wid = __builtin_amdgcn_readfirstlane(tid >> 6), lane = tid & 63, wr = wid >> 2, wc = wid & 3, fr = lane & 15, fq = lane >> 4;
    const int K = g.K, nt = K / BK;
    unsigned voffA, voffB;
    { int R, C; stage_rc(tid * 16, R, C); const int Rb = Epi::PERM ? ((R & ~31) + perm32(R & 31)) : R;
      voffA = (unsigned)(R * K + C) * 2u; voffB = (unsigned)(Rb * K + C) * 2u; }
    const size_t kstep = (size_t)(BK * 2);
    const size_t hstep = (size_t)HALF * K * 2;
    const size_t tstep = 2 * hstep;
    const unsigned ldsw = (unsigned)wid * 1024u;
    const int aoff = lds_byte(wr * 64 + fr, fq * 8), boff = lds_byte(wc * 32 + fr, fq * 8);
#define PG8_SA(b, h) (((b) * 2 + (h)) * HTB)
#define PG8_SB(b, h) ((4 + (b) * 2 + (h)) * HTB)
#define PG8_STAGE(bufoff, gbase, voff) do { _Pragma("unroll") for (int _i = 0; _i < 2; ++_i) \
        __builtin_amdgcn_global_load_lds((const unsigned*)((const char*)(gbase) + (size_t)_i * 128u * (unsigned)K + (voff)), (PG8_LAS unsigned*)(lds + (bufoff) + ldsw + _i * 8192), 16, 0, 0); } while (0)
#define PG8_LD32(d8_, addr_) do { const i32x4v x0_ = *(const PG8_LAS i32x4v*)(addr_), x1_ = *(const PG8_LAS i32x4v*)((addr_) + 1024); \
        d8_ = __builtin_shufflevector(x0_, x1_, 0, 1, 2, 3, 4, 5, 6, 7); } while (0)
#define PG8_LDA(dst, b, h) do { if constexpr (F8) { _Pragma("unroll") for (int m = 0; m < 4; ++m) PG8_LD32(dst##8[m], lds + PG8_SA(b, h) + aoff + m * 2048); } \
        else { _Pragma("unroll") for (int m = 0; m < 4; ++m) _Pragma("unroll") for (int k = 0; k < 2; ++k) dst[m][k] = *(const PG8_LAS bf16x8*)(lds + PG8_SA(b, h) + aoff + m * 2048 + k * 1024); } } while (0)
#define PG8_LDB(dst, b, h) do { if constexpr (F8) { _Pragma("unroll") for (int n = 0; n < 2; ++n) PG8_LD32(dst##8[n], lds + PG8_SB(b, h) + boff + n * 2048); } \
        else { _Pragma("unroll") for (int n = 0; n < 2; ++n) _Pragma("unroll") for (int k = 0; k < 2; ++k) dst[n][k] = *(const PG8_LAS bf16x8*)(lds + PG8_SB(b, h) + boff + n * 2048 + k * 1024); } } while (0)
#define PG8_MMA(ai, bj, At, Bt) do { __builtin_amdgcn_s_setprio(1); _Pragma("unroll") for (int m = 0; m < 4; ++m) _Pragma("unroll") for (int n = 0; n < 2; ++n) { \
        if constexpr (F8) acc[ai][bj][m][n] = __builtin_amdgcn_mfma_scale_f32_16x16x128_f8f6f4(Bt##8[n], At##8[m], acc[ai][bj][m][n], 0, 0, 0, 0x7F7F7F7F, 0, 0x7F7F7F7F); \
        else { _Pragma("unroll") for (int k = 0; k < 2; ++k) acc[ai][bj][m][n] = __builtin_amdgcn_mfma_f32_16x16x32_bf16(Bt[n][k], At[m][k], acc[ai][bj][m][n], 0, 0, 0); } } \
        __builtin_amdgcn_s_setprio(0); } while (0)
#define PG8_WAIT_V(n) asm volatile("s_waitcnt vmcnt(" #n ")" ::: "memory")
#define PG8_WAIT_L(n) asm volatile("s_waitcnt lgkmcnt(" #n ")" ::: "memory")
#define PG8_BAR __builtin_amdgcn_s_barrier()
#define PG8_SCHED __builtin_amdgcn_sched_barrier(0)
    Unit cur, nxt; int ui = 0;
    if (!S.next(0, cur)) return;
    f32x4 acc[2][2][4][2];
#pragma unroll
    for (int a = 0; a < 2; ++a)
#pragma unroll
        for (int b = 0; b < 2; ++b)
#pragma unroll
            for (int m = 0; m < 4; ++m)
#pragma unroll
                for (int n = 0; n < 2; ++n) acc[a][b][m][n] = (f32x4){0.f, 0.f, 0.f, 0.f};
    bf16x8 At[4][2], B0[2][2], B1[2][2];
    i32x8v At8[4], B08[2], B18[2];
    const char* cA = (const char*)g.A + (size_t)cur.pm * tstep; const char* cB = (const char*)g.Bt + (size_t)cur.pn * tstep;
    S.a_ready(cur);
    if constexpr (SP2) {
        PG8_STAGE(PG8_SB(0, 0), cB, voffB); PG8_STAGE(PG8_SB(0, 1), cB + hstep, voffB); PG8_STAGE(PG8_SA(0, 0), cA, voffA); PG8_STAGE(PG8_SA(0, 1), cA + hstep, voffA);
        if (wr == 1) PG8_BAR;
        PG8_WAIT_V(2); PG8_BAR;
        PG8_STAGE(PG8_SB(1, 0), cB + kstep, voffB); PG8_STAGE(PG8_SA(1, 0), cA + kstep, voffA); PG8_STAGE(PG8_SB(1, 1), cB + hstep + kstep, voffB);
        PG8_WAIT_V(6); PG8_BAR;
    } else {
        PG8_STAGE(PG8_SB(0, 0), cB, voffB); PG8_STAGE(PG8_SA(0, 0), cA, voffA); PG8_STAGE(PG8_SB(0, 1), cB + hstep, voffB); PG8_STAGE(PG8_SA(0, 1), cA + hstep, voffA);
        if (wr == 1) PG8_BAR;
        PG8_WAIT_V(4); PG8_BAR;
        PG8_STAGE(PG8_SB(1, 0), cB + kstep, voffB); PG8_STAGE(PG8_SA(1, 0), cA + kstep, voffA); PG8_STAGE(PG8_SB(1, 1), cB + hstep + kstep, voffB);
        PG8_WAIT_V(6); PG8_BAR;
    }
    for (;;) {
        const bool has_next = S.next(ui + 1, nxt);
        const char* nA = has_next ? (const char*)g.A + (size_t)nxt.pm * tstep : cA; const char* nB = has_next ? (const char*)g.Bt + (size_t)nxt.pn * tstep : cB;
#pragma unroll 1
        for (int t = 0; t < nt; t += 2) {
            const bool last = (t == nt - 2);
            const char* a1 = cA + (size_t)(t + 1) * kstep;
            const char* a2 = last ? nA : cA + (size_t)(t + 2) * kstep; const char* b2 = last ? nB : cB + (size_t)(t + 2) * kstep;
            const char* a3 = a2 + kstep; const char* b3 = b2 + kstep;
            if (last && has_next) S.a_ready(nxt);
            if constexpr (SP2) {
            PG8_LDB(B0, 0, 0); PG8_LDB(B1, 0, 1); PG8_SCHED; PG8_LDA(At, 0, 0); PG8_STAGE(PG8_SA(1, 1), a1 + hstep, voffA);
            PG8_WAIT_V(8); PG8_WAIT_L(0); PG8_BAR; PG8_MMA(0, 0, At, B0); PG8_MMA(0, 1, At, B1); PG8_BAR; PG8_SCHED;
            PG8_LDA(At, 0, 1); PG8_STAGE(PG8_SB(0, 0), b2, voffB); PG8_STAGE(PG8_SB(0, 1), b2 + hstep, voffB); PG8_STAGE(PG8_SA(0, 0), a2, voffA);
            PG8_WAIT_V(8); PG8_WAIT_L(0); PG8_BAR; PG8_MMA(1, 0, At, B0); PG8_MMA(1, 1, At, B1); PG8_BAR; PG8_SCHED;
            PG8_LDB(B0, 1, 0); PG8_LDB(B1, 1, 1); PG8_SCHED; PG8_LDA(At, 1, 0); PG8_STAGE(PG8_SA(0, 1), a2 + hstep, voffA);
            PG8_WAIT_V(8); PG8_WAIT_L(0); PG8_BAR; PG8_MMA(0, 0, At, B0); PG8_MMA(0, 1, At, B1); PG8_BAR; PG8_SCHED;
            PG8_LDA(At, 1, 1); PG8_STAGE(PG8_SB(1, 0), b3, voffB); PG8_STAGE(PG8_SB(1, 1), b3 + hstep, voffB); PG8_STAGE(PG8_SA(1, 0), a3, voffA);
            PG8_WAIT_V(8); PG8_WAIT_L(0); PG8_BAR; PG8_MMA(1, 0, At, B0); PG8_MMA(1, 1, At, B1); PG8_BAR; PG8_SCHED;
            } else {
            PG8_LDB(B0, 0, 0); PG8_SCHED; PG8_LDA(At, 0, 0); PG8_STAGE(PG8_SA(1, 1), a1 + hstep, voffA);
            PG8_WAIT_L(8); PG8_BAR; PG8_WAIT_L(0); PG8_MMA(0, 0, At, B0); PG8_BAR; PG8_SCHED;
            PG8_LDB(B1, 0, 1); PG8_STAGE(PG8_SB(0, 0), b2, voffB);
            PG8_BAR; PG8_WAIT_L(0); PG8_MMA(0, 1, At, B1); PG8_BAR;
            PG8_LDA(At, 0, 1); PG8_STAGE(PG8_SA(0, 0), a2, voffA);
            PG8_BAR; PG8_WAIT_L(0); PG8_MMA(1, 0, At, B0); PG8_BAR; PG8_SCHED;
            PG8_STAGE(PG8_SB(0, 1), b2 + hstep, voffB);
            PG8_WAIT_V(6); PG8_BAR; PG8_MMA(1, 1, At, B1); PG8_BAR;
            PG8_LDB(B0, 1, 0); PG8_SCHED; PG8_LDA(At, 1, 0); PG8_STAGE(PG8_SA(0, 1), a2 + hstep, voffA);
            PG8_WAIT_L(8); PG8_BAR; PG8_WAIT_L(0); PG8_MMA(0, 0, At, B0); PG8_BAR; PG8_SCHED;
            PG8_LDB(B1, 1, 1); PG8_STAGE(PG8_SB(1, 0), b3, voffB);
            PG8_BAR; PG8_WAIT_L(0); PG8_MMA(0, 1, At, B1); PG8_BAR;
            PG8_LDA(At, 1, 1); PG8_STAGE(PG8_SA(1, 0), a3, voffA);
            PG8_BAR; PG8_WAIT_L(0); PG8_MMA(1, 0, At, B0); PG8_BAR; PG8_SCHED;
            PG8_STAGE(PG8_SB(1, 1), b3 + hstep, voffB);
            PG8_WAIT_V(6); PG8_BAR; PG8_MMA(1, 1, At, B1); PG8_BAR;
            }
        }
        if constexpr (ALIGN_EPI) { if (wr == 0) PG8_BAR; }
        if constexpr (!Epi::AFTER_DRAIN) { int fr_ = fr, fq_ = fq; asm volatile("" : "+v"(fr_), "+v"(fq_));
          E(acc, cur, wr, wc, fr_, fq_); S.done(cur); }
        if (!has_next) break;
#pragma unroll
        for (int a = 0; a < 2; ++a)
#pragma unroll
            for (int b = 0; b < 2; ++b)
#pragma unroll
                for (int m = 0; m < 4; ++m)
#pragma unroll
                    for (int n = 0; n < 2; ++n) acc[a][b][m][n] = (f32x4){0.f, 0.f, 0.f, 0.f};
        cur = nxt; cA = nA; cB = nB; ++ui;
        if constexpr (ALIGN_EPI) { if (wr == 1) PG8_BAR; }
    }
    PG8_WAIT_V(0);
    if constexpr (!ALIGN_EPI) { if (wr == 0) PG8_BAR; }
    PG8_BAR;
    if constexpr (Epi::AFTER_DRAIN) { E.fused(acc, cur, wr, wc, fr, fq, lds, wid, lane); S.done(cur); }
#undef PG8_SA
#undef PG8_SB
#undef PG8_STAGE
#undef PG8_LDA
#undef PG8_LDB
#undef PG8_MMA
#undef PG8_WAIT_V
#undef PG8_WAIT_L
#undef PG8_BAR
#undef PG8_SCHED
}
}

__device__ __forceinline__ int gswz(int row, int chunk) { return row * 128 + ((chunk ^ ((row >> 1) & 7)) << 4); }
__device__ __forceinline__ void gemm_tile(const bf16_t* __restrict__ A, int lda, const bf16_t* __restrict__ Bt, int ldb, int K,
                                          int row0, int col0, unsigned char* lds, f32x16 (&acc)[2][2]) {
  int tid_ = tidx(); asm volatile("" : "+v"(tid_)); const int tid = tid_, lane = tid & 63, wid = tid >> 6, wm = wid >> 1, wn = wid & 1, r32 = lane & 31, hi = lane >> 5;
  unsigned char* As = lds; unsigned char* Bs = lds + 65536;
#pragma unroll
  for (int i = 0; i < 2; ++i)
#pragma unroll
    for (int j = 0; j < 2; ++j) acc[i][j] = f32x16{};
  const int lrow = tid >> 3, lc = tid & 7;
  const bf16_t* Ag = A + (size_t)(row0 + lrow) * lda + lc * 8;
  const bf16_t* Bg = Bt + (size_t)(col0 + lrow) * ldb + lc * 8;
  u32x4 ra[4], rb[2];
#pragma unroll
  for (int i = 0; i < 4; ++i) ra[i] = *(const u32x4*)(Ag + (size_t)(64 * i) * lda);
#pragma unroll
  for (int i = 0; i < 2; ++i) rb[i] = *(const u32x4*)(Bg + (size_t)(64 * i) * ldb);
#pragma unroll
  for (int i = 0; i < 4; ++i) *(u32x4*)(As + gswz(lrow + 64 * i, lc)) = ra[i];
#pragma unroll
  for (int i = 0; i < 2; ++i) *(u32x4*)(Bs + gswz(lrow + 64 * i, lc)) = rb[i];
  __syncthreads();
  const int nk = K / 64;
  for (int kt = 0; kt < nk; ++kt) {
    const int cur = kt & 1;
    if (kt + 1 < nk) {
#pragma unroll
      for (int i = 0; i < 4; ++i) ra[i] = *(const u32x4*)(Ag + (size_t)(64 * i) * lda + (kt + 1) * 64);
#pragma unroll
      for (int i = 0; i < 2; ++i) rb[i] = *(const u32x4*)(Bg + (size_t)(64 * i) * ldb + (kt + 1) * 64);
    }
    const unsigned char* Ac = As + cur * 32768; const unsigned char* Bc = Bs + cur * 16384;
#pragma unroll
    for (int kk = 0; kk < 4; ++kk) {
      bf16x8 af[2], bfr[2];
#pragma unroll
      for (int i = 0; i < 2; ++i) af[i] = *(const bf16x8*)(Ac + gswz(wm * 64 + i * 32 + r32, 2 * kk + hi));
#pragma unroll
      for (int j = 0; j < 2; ++j) bfr[j] = *(const bf16x8*)(Bc + gswz(wn * 64 + j * 32 + r32, 2 * kk + hi));
#pragma unroll
      for (int i = 0; i < 2; ++i)
#pragma unroll
        for (int j = 0; j < 2; ++j) acc[i][j] = __builtin_amdgcn_mfma_f32_32x32x16_bf16(af[i], bfr[j], acc[i][j], 0, 0, 0);
    }
    if (kt + 1 < nk) {
      unsigned char* An = As + (cur ^ 1) * 32768; unsigned char* Bn = Bs + (cur ^ 1) * 16384;
#pragma unroll
      for (int i = 0; i < 4; ++i) *(u32x4*)(An + gswz(lrow + 64 * i, lc)) = ra[i];
#pragma unroll
      for (int i = 0; i < 2; ++i) *(u32x4*)(Bn + gswz(lrow + 64 * i, lc)) = rb[i];
    }
    __syncthreads();
  }
}
__device__ __forceinline__ void pair_xchg(float v0, float v1, int lane, float& lo, float& hi2) {
  const bool odd = lane & 1;
  const float send = odd ? v0 : v1;
  const float recv = dpp_mov<0xB1>(send);
  lo = odd ? recv : v0; hi2 = odd ? v1 : recv;
}

__device__ __forceinline__ void phase_inproj(const Params& p, int l, unsigned char* lds) {
  int tid_ = tidx(); asm volatile("" : "+v"(tid_)); const int tid = tid_, lane = tid & 63, wid = tid >> 6, wm = wid >> 1, wn = wid & 1, r32 = lane & 31, hi = lane >> 5;
  const bf16_t* H = (const bf16_t*)(p.ws + WS_H);
  const bf16_t* W = (const bf16_t*)(p.ws + WS_WIN) + (size_t)l * PW * DM;
  bf16_t* PROJ = (bf16_t*)(p.ws + WS_PROJ);
  const float* RC = (const float*)(p.ws + WS_ROPE); const float* RS = RC + SEQ * 32;
  constexpr int NM = T / 256, NN = PW / 128, NU = NM * NN;
  for (int u = p.bx; u < NU + NM; u += p.gx) {
    if (u < NU) {
      const int pn = u / NM, pm = u % NM;
      const int row0 = pm * 256, col0 = pn * 128;
      f32x16 acc[2][2];
      gemm_tile(H, DM, W, DM, DM, row0, col0, lds, acc);
      const bool rope = (col0 >= C_DQ && col0 < C_DV);
      const float scl = (col0 >= C_MK && col0 < C_MV) ? 0.125f : ((col0 >= C_DQ && col0 < C_DK) ? QSCALE : 1.f);
#pragma unroll
      for (int i = 0; i < 2; ++i)
#pragma unroll
        for (int j = 0; j < 2; ++j)
#pragma unroll
          for (int q = 0; q < 8; ++q) {
            float lo, hi2; pair_xchg(acc[i][j][2 * q], acc[i][j][2 * q + 1], lane, lo, hi2);
            const int row = row0 + wm * 64 + i * 32 + crow(2 * q, hi) + (lane & 1);
            const int col = col0 + wn * 64 + j * 32 + (r32 & ~1);
            if (rope) {
              const int s = row % SEGL;
              if (s >= CTXL) {
                const int idx = (s - CTXL) * 32 + ((col & 63) >> 1);
                const float c = RC[idx], sn = RS[idx];
                const float t1 = lo, t2 = hi2; lo = t1 * c - t2 * sn; hi2 = t1 * sn + t2 * c;
              }
            }
            *(unsigned*)(PROJ + (size_t)row * PW + col) = cvtpk(lo * scl, hi2 * scl);
          }
    } else {
      const int pm = u - NU, rowb = pm * 256 + wid * 32;
      const bf16_t* WG = (const bf16_t*)(p.ws + WS_WG) + (size_t)l * 16 * DM;
      float* GT = (float*)(p.ws + WS_GATES);
      const int r16 = lane & 15, q4 = lane >> 4;
      f32x4 c0 = {0.f, 0.f, 0.f, 0.f}, c1 = {0.f, 0.f, 0.f, 0.f};
      const bf16_t* a0p = H + (size_t)(rowb + r16) * DM + q4 * 8;
      const bf16_t* a1p = a0p + (size_t)16 * DM;
      const bf16_t* bp = WG + (size_t)r16 * DM + q4 * 8;
#pragma unroll 4
      for (int ks = 0; ks < 32; ++ks) {
        const bf16x8 a0 = *(const bf16x8*)(a0p + ks * 32), a1 = *(const bf16x8*)(a1p + ks * 32), b = *(const bf16x8*)(bp + ks * 32);
        c0 = __builtin_amdgcn_mfma_f32_16x16x32_bf16(a0, b, c0, 0, 0, 0);
        c1 = __builtin_amdgcn_mfma_f32_16x16x32_bf16(a1, b, c1, 0, 0, 0);
      }
      const float gb = p.in[I_GATEB][l * 16 + r16];
#pragma unroll
      for (int j = 0; j < 4; ++j) {
        GT[(size_t)(rowb + q4 * 4 + j) * 16 + r16] = c0[j] + gb;
        GT[(size_t)(rowb + 16 + q4 * 4 + j) * 16 + r16] = c1[j] + gb;
      }
    }
  }
}

__device__ __forceinline__ void phase_outproj(const Params& p, int l, unsigned char* lds) {
  int tid_ = tidx(); asm volatile("" : "+v"(tid_)); const int tid = tid_, lane = tid & 63, wid = tid >> 6, wm = wid >> 1, wn = wid & 1, r32 = lane & 31, hi = lane >> 5;
  const bf16_t* MIX = (const bf16_t*)(p.ws + WS_MIX);
  const bf16_t* W = (const bf16_t*)(p.ws + WS_WOUT) + (size_t)l * DM * DM;
  float* XC = (float*)(p.ws + WS_XCUR);
  const float* MOD = (const float*)(p.ws + WS_MOD);
  constexpr int NM = T / 256, NN = DM / 128, NU = NM * NN;
  for (int u = p.bx; u < NU; u += p.gx) {
    const int pm = u / NN, pn = u % NN;
    if (l == DEPTH - 1 && (pm % 33) == 0) continue;
    const int row0 = pm * 256, col0 = pn * 128;
    for (int rep = 0; rep < REP_OUTP; ++rep) {
    f32x16 acc[2][2];
    gemm_tile(MIX, DM, W, DM, DM, row0, col0, lds, acc);
    const int mr = (pm % 33) == 0 ? 4 : pm / 33;
    const float* g1 = MOD + ((size_t)l * 5 + mr) * 6144 + 2048;
#pragma unroll
    for (int i = 0; i < 2; ++i)
#pragma unroll
      for (int j = 0; j < 2; ++j) {
        const int col = col0 + wn * 64 + j * 32 + r32;
        const float gg = (rep == REP_OUTP - 1) ? g1[col] : 0.f;
#pragma unroll
        for (int r = 0; r < 16; ++r) {
          const int row = row0 + wm * 64 + i * 32 + crow(r, hi);
          const float xo = (l == 0) ? in_row(p.in[I_X], p.in[I_CTX], row)[col] : XC[(size_t)row * DM + col];
          XC[(size_t)row * DM + col] = xo + gg * acc[i][j][r];
        }
      }
    }
  }
}
__device__ __forceinline__ void phase_peerq(const Params& p, int l, unsigned char* lds) {
  int tid_ = tidx(); asm volatile("" : "+v"(tid_)); const int tid = tid_, lane = tid & 63, wid = tid >> 6, wm = wid >> 1, wn = wid & 1, r32 = lane & 31, hi = lane >> 5;
  const bf16_t* H = (const bf16_t*)(p.ws + WS_H);
  const bf16_t* W = (const bf16_t*)(p.ws + WS_WQ) + (size_t)l * DM * DM;
  bf16_t* QP = (bf16_t*)(p.ws + WS_PROJ);
  constexpr int NM = T / 256, NN = DM / 128, NU = NM * NN;
  for (int u = p.bx; u < NU; u += p.gx) {
    const int pm = u / NN, pn = u % NN;
    if (l == DEPTH - 1 && (pm % 33) == 0) continue;
    const int row0 = pm * 256, col0 = pn * 128;
    f32x16 acc[2][2];
    gemm_tile(H, DM, W, DM, DM, row0, col0, lds, acc);
#pragma unroll
    for (int i = 0; i < 2; ++i)
#pragma unroll
      for (int j = 0; j < 2; ++j)
#pragma unroll
        for (int q = 0; q < 8; ++q) {
          float lo, hi2; pair_xchg(acc[i][j][2 * q], acc[i][j][2 * q + 1], lane, lo, hi2);
          const int row = row0 + wm * 64 + i * 32 + crow(2 * q, hi) + (lane & 1);
          const int col = col0 + wn * 64 + j * 32 + (r32 & ~1);
          *(unsigned*)(QP + (size_t)row * DM + col) = cvtpk(lo, hi2);
        }
  }
}


struct EpiInproj {
  static constexpr bool PERM = true, AFTER_DRAIN = false;
  bf16_t* PROJ; const float* RC; const float* RS; unsigned char* V8T; float wsc;
  __device__ __forceinline__ void operator()(const pg8::f32x4 (&acc)[2][2][4][2], const pg8::Unit& u, int wr, int wc, int fr, int fq) const {
#pragma unroll
    for (int bj = 0; bj < 2; ++bj) {
      const int colt = u.pn * 256 + bj * 128;
      const bool rope = (colt >= C_DQ && colt < C_DV);
      const float scl = ((colt >= C_MK && colt < C_MV) ? 0.125f : ((colt >= C_DQ && colt < C_DK) ? QSCALE : 1.f)) * wsc;
      const int col8 = colt + wc * 32 + 8 * fq;
      if (colt >= C_DV) {
        const int hh = (col8 - C_DV) >> 7, e0 = (col8 - C_DV) & 127;
#pragma unroll
        for (int ai = 0; ai < 2; ++ai)
#pragma unroll
          for (int m = 0; m < 4; ++m) {
            const int row = u.pm * 256 + ai * 128 + wr * 64 + m * 16 + fr;
            const int b = row / SEGL, s = row - b * SEGL, t = s >> 6, kk = s & 63;
            const int slot = ((kk >> 2) & 1) * 32 + (kk & 3) + 4 * ((kk >> 3) & 3) + 16 * (kk >> 5);
            unsigned char* vp = V8T + ((size_t)((b * 4 + hh) * NCH + t) * 128 + e0) * 80 + slot;
            const f32x4 v0 = acc[ai][bj][m][0] * wsc, v1 = acc[ai][bj][m][1] * wsc;
            int w0 = 0, w1 = 0;
            w0 = __builtin_amdgcn_cvt_pk_fp8_f32(v0[0], v0[1], w0, false); w0 = __builtin_amdgcn_cvt_pk_fp8_f32(v0[2], v0[3], w0, true);
            w1 = __builtin_amdgcn_cvt_pk_fp8_f32(v1[0], v1[1], w1, false); w1 = __builtin_amdgcn_cvt_pk_fp8_f32(v1[2], v1[3], w1, true);
            vp[0] = (unsigned char)(w0 & 0xFF); vp[80] = (unsigned char)((w0 >> 8) & 0xFF); vp[160] = (unsigned char)((w0 >> 16) & 0xFF); vp[240] = (unsigned char)((w0 >> 24) & 0xFF);
            vp[320] = (unsigned char)(w1 & 0xFF); vp[400] = (unsigned char)((w1 >> 8) & 0xFF); vp[480] = (unsigned char)((w1 >> 16) & 0xFF); vp[560] = (unsigned char)((w1 >> 24) & 0xFF);
          }
        continue;
      }
      unsigned char* qk8 = nullptr;
      if (rope) { const int isk = colt >= C_DK, cc = col8 - (isk ? C_DK : C_DQ); qk8 = V8T + (WS_QK8 - WS_V8T) + (size_t)isk * QK8_IMG + (size_t)(cc >> 7) * SEGL * QK8_PITCH + (cc & 127); }
#pragma unroll
      for (int ai = 0; ai < 2; ++ai)
#pragma unroll
        for (int m = 0; m < 4; ++m) {
          const int row = u.pm * 256 + ai * 128 + wr * 64 + m * 16 + fr;
          f32x4 v0 = acc[ai][bj][m][0], v1 = acc[ai][bj][m][1];
          if (rope) {
            const int s = row % SEGL;
            if (s >= CTXL) {
              const int idx = (s - CTXL) * 32 + ((col8 & 63) >> 1);
              const f32x4 c = *(const f32x4*)(RC + idx), sn = *(const f32x4*)(RS + idx);
              f32x4 a, b;
              a[0] = v0[0] * c[0] - v0[1] * sn[0]; a[1] = v0[0] * sn[0] + v0[1] * c[0]; a[2] = v0[2] * c[1] - v0[3] * sn[1]; a[3] = v0[2] * sn[1] + v0[3] * c[1];
              b[0] = v1[0] * c[2] - v1[1] * sn[2]; b[1] = v1[0] * sn[2] + v1[1] * c[2]; b[2] = v1[2] * c[3] - v1[3] * sn[3]; b[3] = v1[2] * sn[3] + v1[3] * c[3];
              v0 = a; v1 = b;
            }
          }
          if (rope) {
            const int b = row / SEGL, s = row - b * SEGL;
            int w0, w1; asm volatile("" : "=v"(w0), "=v"(w1));
            w0 = __builtin_amdgcn_cvt_pk_fp8_f32(v0[0] * scl, v0[1] * scl, w0, false); w0 = __builtin_amdgcn_cvt_pk_fp8_f32(v0[2] * scl, v0[3] * scl, w0, true);
            w1 = __builtin_amdgcn_cvt_pk_fp8_f32(v1[0] * scl, v1[1] * scl, w1, false); w1 = __builtin_amdgcn_cvt_pk_fp8_f32(v1[2] * scl, v1[3] * scl, w1, true);
            *(u32x2*)(qk8 + ((size_t)b * 4 * SEGL + s) * QK8_PITCH) = (u32x2){(unsigned)w0, (unsigned)w1};
            __builtin_amdgcn_sched_barrier(0);
            continue;
          }
          u32x4 w; w.x = cvtpk(v0[0] * scl, v0[1] * scl); w.y = cvtpk(v0[2] * scl, v0[3] * scl); w.z = cvtpk(v1[0] * scl, v1[1] * scl); w.w = cvtpk(v1[2] * scl, v1[3] * scl);
          *(u32x4*)(PROJ + (size_t)row * PW + col8) = w;
        }
    }
  }
};
struct EpiOutproj {
  static constexpr bool PERM = true, AFTER_DRAIN = false;
  float* XC; const float* MODL; const float* xin; const float* ctxin; int first; float gsc;
  __device__ __forceinline__ void operator()(const pg8::f32x4 (&acc)[2][2][4][2], const pg8::Unit& u, int wr, int wc, int fr, int fq) const {
    const int mr = (u.pm % 33) == 0 ? 4 : u.pm / 33;
    const float* g1 = MODL + (size_t)mr * 6144 + 2048;
#pragma unroll
    for (int bj = 0; bj < 2; ++bj) {
      const int col8 = u.pn * 256 + bj * 128 + wc * 32 + 8 * fq;
      const f32x4 ga = *(const f32x4*)(g1 + col8) * gsc, gb = *(const f32x4*)(g1 + col8 + 4) * gsc;
#pragma unroll
      for (int ai = 0; ai < 2; ++ai)
#pragma unroll
        for (int m = 0; m < 4; ++m) {
          const int row = u.pm * 256 + ai * 128 + wr * 64 + m * 16 + fr;
          const float* xo = first ? in_row(xin, ctxin, row) + col8 : XC + (size_t)row * DM + col8;
          const f32x4 xa = *(const f32x4*)xo, xb = *(const f32x4*)(xo + 4);
          *(f32x4*)(XC + (size_t)row * DM + col8) = xa + ga * acc[ai][bj][m][0];
          *(f32x4*)(XC + (size_t)row * DM + col8 + 4) = xb + gb * acc[ai][bj][m][1];
        }
    }
  }
};
struct EpiPeerq {
  static constexpr bool PERM = true, AFTER_DRAIN = false;
  bf16_t* QP;
  __device__ __forceinline__ void operator()(const pg8::f32x4 (&acc)[2][2][4][2], const pg8::Unit& u, int wr, int wc, int fr, int fq) const {
#pragma unroll
    for (int bj = 0; bj < 2; ++bj) {
      const int col8 = u.pn * 256 + bj * 128 + wc * 32 + 8 * fq;
#pragma unroll
      for (int ai = 0; ai < 2; ++ai)
#pragma unroll
        for (int m = 0; m < 4; ++m) {
          const int row = u.pm * 256 + ai * 128 + wr * 64 + m * 16 + fr;
          const f32x4 v0 = acc[ai][bj][m][0], v1 = acc[ai][bj][m][1];
          u32x4 w; w.x = cvtpk(v0[0], v0[1]); w.y = cvtpk(v0[2], v0[3]); w.z = cvtpk(v1[0], v1[1]); w.w = cvtpk(v1[2], v1[3]);
          *(u32x4*)(QP + (size_t)row * DM + col8) = w;
        }
    }
  }
};
__device__ __forceinline__ void phase_inproj2(const Params& p, int l, unsigned char* lds) {
  {
    pg8::Gemm g{(const bf16_t*)(p.ws + WS_H8), (const bf16_t*)(p.ws + WS_W8 + (size_t)l * PW * DM), T, PW, DM / 2};
    pg8::F8Order S; S.init(T, p.gx, p.bx, 0, 12, 0);
    EpiInproj E{(bf16_t*)(p.ws + WS_PROJ), (const float*)(p.ws + WS_ROPE), (const float*)(p.ws + WS_ROPE) + SEQ * 32, p.ws + WS_V8T, 1.f / 32.f};
    pg8::gemm_phase<EpiInproj, pg8::F8Order, true, true, true>((PG8_LAS unsigned char*)lds, g, S, E);
  }
  int tid_ = tidx(); asm volatile("" : "+v"(tid_)); const int tid = tid_, lane = tid & 63, wid = tid >> 6;
  const bf16_t* H = (const bf16_t*)(p.ws + WS_H);
  for (int pm = p.gx - 1 - p.bx; pm < T / 256; pm += p.gx) {
    const int rowb = pm * 256 + wid * 32;
    const bf16_t* WG = (const bf16_t*)(p.ws + WS_WG) + (size_t)l * 16 * DM;
    float* GT = (float*)(p.ws + WS_GATES);
    const int r16 = lane & 15, q4 = lane >> 4;
    f32x4 c0 = {0.f, 0.f, 0.f, 0.f}, c1 = {0.f, 0.f, 0.f, 0.f};
    const bf16_t* a0p = H + (size_t)(rowb + r16) * DM + q4 * 8;
    const bf16_t* a1p = a0p + (size_t)16 * DM;
    const bf16_t* bp = WG + (size_t)r16 * DM + q4 * 8;
#pragma unroll 4
    for (int ks = 0; ks < 32; ++ks) {
      const bf16x8 a0 = *(const bf16x8*)(a0p + ks * 32), a1 = *(const bf16x8*)(a1p + ks * 32), b = *(const bf16x8*)(bp + ks * 32);
      c0 = __builtin_amdgcn_mfma_f32_16x16x32_bf16(a0, b, c0, 0, 0, 0);
      c1 = __builtin_amdgcn_mfma_f32_16x16x32_bf16(a1, b, c1, 0, 0, 0);
    }
    const float gb = p.in[I_GATEB][l * 16 + r16];
#pragma unroll
    for (int j = 0; j < 4; ++j) {
      GT[(size_t)(rowb + q4 * 4 + j) * 16 + r16] = c0[j] + gb;
      GT[(size_t)(rowb + 16 + q4 * 4 + j) * 16 + r16] = c1[j] + gb;
    }
  }
}
__device__ __forceinline__ void phase_outproj2(const Params& p, int l, unsigned char* lds) {
  pg8::Gemm g{(const bf16_t*)(p.ws + WS_MIX), (const bf16_t*)(p.ws + WS_WOUT) + (size_t)l * DM * DM, T, DM, DM};
  pg8::StaticOrder S; S.init(T, DM, p.gx, p.bx);
  for (int rep = 0; rep < REP_OUTP; ++rep) {
  EpiOutproj E{(float*)(p.ws + WS_XCUR), (const float*)(p.ws + WS_MOD) + (size_t)l * 5 * 6144, p.in[I_X], p.in[I_CTX], l == 0, (rep == REP_OUTP - 1) ? 1.f : 0.f};
  pg8::gemm_phase<EpiOutproj, pg8::StaticOrder, true, true>((PG8_LAS unsigned char*)lds, g, S, E);
  }
  tail_filler_tables(p, l, (T / 256) * (DM / 256), l == 0 ? 0 : NEXP, 2 * NEXP);
}
__device__ __forceinline__ void phase_peerq2(const Params& p, int l, unsigned char* lds) {
  pg8::Gemm g{(const bf16_t*)(p.ws + WS_H), (const bf16_t*)(p.ws + WS_WQ) + (size_t)l * DM * DM, T, DM, DM};
  pg8::StaticOrder S; S.init(T, DM, p.gx, p.bx);
  EpiPeerq E{(bf16_t*)(p.ws + WS_PROJ)};
  pg8::gemm_phase<EpiPeerq, pg8::StaticOrder, true, true>((PG8_LAS unsigned char*)lds, g, S, E);
  if (l < DEPTH - 1) tail_filler_tables(p, l + 1, (T / 256) * (DM / 256), 0, NEXP);
}

__device__ __forceinline__ void conv_unit(const Params& p, int l, int unit, unsigned char* lds) {
  int tid_ = tidx(); asm volatile("" : "+v"(tid_)); const int tid = tid_, lane = tid & 63, wid = tid >> 6;
  float* U = (float*)lds;
  const bf16_t* PROJ = (const bf16_t*)(p.ws + WS_PROJ);
  bf16_t* MIX = (bf16_t*)(p.ws + WS_MIX);
  const int row0 = unit * 32, b = row0 / SEGL, s0 = row0 - b * SEGL;
  const int seglo = s0 < CTXL ? 0 : CTXL, seghi = s0 < CTXL ? CTXL : SEGL;
  for (int rr = tid >> 5; rr < 62; rr += 16) {
    const int s = s0 - 15 + rr, c8 = (tid & 31) * 8;
    f32x4 u0 = {0.f, 0.f, 0.f, 0.f}, u1 = {0.f, 0.f, 0.f, 0.f};
    if (s >= seglo && s < seghi) {
      const bf16_t* pr = PROJ + (size_t)(b * SEGL + s) * PW + c8;
      const u32x4 a1 = *(const u32x4*)pr, a2 = *(const u32x4*)(pr + 256);
      u0.x = bflo(a1.x) * sigmoidf_(bflo(a2.x)); u0.y = bfhi(a1.x) * sigmoidf_(bfhi(a2.x));
      u0.z = bflo(a1.y) * sigmoidf_(bflo(a2.y)); u0.w = bfhi(a1.y) * sigmoidf_(bfhi(a2.y));
      u1.x = bflo(a1.z) * sigmoidf_(bflo(a2.z)); u1.y = bfhi(a1.z) * sigmoidf_(bfhi(a2.z));
      u1.z = bflo(a1.w) * sigmoidf_(bflo(a2.w)); u1.w = bfhi(a1.w) * sigmoidf_(bfhi(a2.w));
    }
    *(f32x4*)(U + rr * 256 + c8) = u0; *(f32x4*)(U + rr * 256 + c8 + 4) = u1;
  }
  __syncthreads();
  float* Y = U + 62 * 256;
  const float* cw = p.in[I_CONVW] + (size_t)l * 31 * 256;
#pragma unroll 1
  for (int q = 0; q < 4; ++q) {
    const int c = lane + 64 * q;
    float w[31];
#pragma unroll
    for (int j = 0; j < 31; ++j) w[j] = cw[j * 256 + c];
    const float bias = p.in[I_CONVB][l * 256 + c];
#pragma unroll
    for (int tt = 0; tt < 4; ++tt) {
      const int t = wid * 4 + tt;
      float a = bias;
#pragma unroll
      for (int j = 0; j < 31; ++j) a += U[(t + j) * 256 + c] * w[j];
      Y[t * 256 + c] = a;
    }
  }
  asm volatile("s_waitcnt lgkmcnt(0)" ::: "memory");
  float y[4][4];
#pragma unroll
  for (int tt = 0; tt < 4; ++tt)
#pragma unroll
    for (int q = 0; q < 4; ++q) y[tt][q] = Y[(wid * 4 + tt) * 256 + lane + 64 * q];
#pragma unroll
  for (int tt = 0; tt < 4; ++tt) {
    const int t = wid * 4 + tt;
    const float mean = wave_sum((y[tt][0] + y[tt][1]) + (y[tt][2] + y[tt][3])) * (1.f / 256.f);
    float v = 0.f;
#pragma unroll
    for (int q = 0; q < 4; ++q) { const float d = y[tt][q] - mean; v += d * d; }
    const float rs = rsqrtf(wave_sum(v) * (1.f / 256.f) + EPS);
#pragma unroll
    for (int q = 0; q < 4; ++q) {
      const int c = lane + 64 * q;
      const float z = (y[tt][q] - mean) * rs * p.in[I_CLNG][l * 256 + c] + p.in[I_CLNB][l * 256 + c];
      const float o = (ABL & 1) ? 0.f : z * sigmoidf_(z);
      MIX[(size_t)(row0 + t) * DM + c] = (bf16_t)(cvtpk(o, 0.f) & 0xffffu);
    }
  }
  __syncthreads();
}

__device__ __forceinline__ int ml_cidx(int ch, int dir) { return dir == 0 ? ch : (ch < 4 ? 3 - ch : 135 - ch); }
__device__ __forceinline__ void ml_load_tile(const bf16_t* src, float* dst, int tid) {
  const int r = tid >> 3, c8 = (tid & 7) * 8;
  const u32x4 a = *(const u32x4*)(src + (size_t)r * PW + c8);
  float* d = dst + r * 65 + c8;
  d[0] = bflo(a.x); d[1] = bfhi(a.x); d[2] = bflo(a.y); d[3] = bfhi(a.y); d[4] = bflo(a.z); d[5] = bfhi(a.z); d[6] = bflo(a.w); d[7] = bfhi(a.w);
}
__device__ __forceinline__ void ml_local_unit(const Params& p, int l, int unit, unsigned char* lds) {
  int tid_ = tidx(); asm volatile("" : "+v"(tid_)); const int tid = tid_, lane = tid & 63, wid = tid >> 6, r32 = lane & 31, hi = lane >> 5;
  float* Kt = (float*)lds; float* Vt = Kt + 64 * 65; float* WK = Vt + 64 * 65;
  const bf16_t* PROJ = (const bf16_t*)(p.ws + WS_PROJ);
  const float* GT = (const float*)(p.ws + WS_GATES);
  float* UL = (float*)(p.ws + WS_ULOC); float* META = (float*)(p.ws + WS_MLMETA);
  const int b = unit / (4 * NCH), hh = (unit / NCH) & 3, ch = unit % NCH;
  const int row0 = b * SEGL + ch * 64;
  ml_load_tile(PROJ + (size_t)row0 * PW + C_MK + hh * 64, Kt, tid);
  ml_load_tile(PROJ + (size_t)row0 * PW + C_MV + hh * 64, Vt, tid);
  if (wid < 2) {
    const int dir = wid;
    const float ig = GT[(size_t)(row0 + lane) * 16 + (2 * dir) * 4 + hh];
    const float lf = logsigmoidf_(GT[(size_t)(row0 + lane) * 16 + (2 * dir + 1) * 4 + hh]);
    float ps = lf;
    ps = wave_incl_scan(ps);
    const float tot = __uint_as_float((unsigned)__builtin_amdgcn_readlane((int)__float_as_uint(ps), 63));
    const float wlog = dir == 0 ? (tot - ps + ig) : (ps - lf + ig);
    const float mloc = wave_max(wlog);
    WK[dir * 64 + lane] = __expf(wlog - mloc);
    if (lane == 0) {
      const int seq = (b * 4 + hh) * 2 + dir, ci = ml_cidx(ch, dir);
      META[((size_t)seq * NCH + ci) * 4 + 0] = tot; META[((size_t)seq * NCH + ci) * 4 + 1] = mloc;
    }
  }
  __syncthreads();
  {
    const int dir = wid >> 2, et = (wid >> 1) & 1, dt = wid & 1;
    const int seq = (b * 4 + hh) * 2 + dir, ci = ml_cidx(ch, dir);
    float* slot = UL + ((size_t)seq * NCH + ci) * USTRIDE;
    f32x16 acc = {};
#pragma unroll 8
    for (int ks = 0; ks < 32; ++ks) {
      const int s = 2 * ks + hi;
      const float a = WK[dir * 64 + s] * Vt[s * 65 + et * 32 + r32];
      const float bb = Kt[s * 65 + dt * 32 + r32];
      acc = __builtin_amdgcn_mfma_f32_32x32x2f32(a, bb, acc, 0, 0, 0);
    }
#pragma unroll
    for (int r = 0; r < 16; ++r) slot[(et * 32 + crow(r, hi)) * 64 + dt * 32 + r32] = acc[r];
    if (et == 0) {
      float n = 0.f;
#pragma unroll 8
      for (int i = 0; i < 32; ++i) { const int s = hi * 32 + i; n += WK[dir * 64 + s] * Kt[s * 65 + dt * 32 + r32]; }
      n = sum_xor32(n);
      if (hi == 0) slot[4096 + dt * 32 + r32] = n;
    }
  }
  __syncthreads();
}
constexpr int MLP = 144;
constexpr size_t WS_CST = WS_H;
constexpr size_t WS_NST = WS_H + (size_t)32 * NCH * 4096 * 2;
__device__ __forceinline__ void ml_stage_rm(const bf16_t* src, size_t ld, unsigned char* dst, int tid) {
  const int r = tid >> 3, c8 = (tid & 7) * 8;
  *(u32x4*)(dst + r * MLP + c8 * 2) = *(const u32x4*)(src + (size_t)r * ld + c8);
}
__device__ __forceinline__ void ml_stage_tr(const bf16_t* src, size_t ld, unsigned char* dst, int tid) {
  const int r = tid >> 3, c8 = (tid & 7) * 8;
  const u32x4 a = *(const u32x4*)(src + (size_t)r * ld + c8);
  bf16_t* d = (bf16_t*)dst;
  d[(c8 + 0) * 72 + r] = (bf16_t)(a.x & 0xffffu); d[(c8 + 1) * 72 + r] = (bf16_t)(a.x >> 16);
  d[(c8 + 2) * 72 + r] = (bf16_t)(a.y & 0xffffu); d[(c8 + 3) * 72 + r] = (bf16_t)(a.y >> 16);
  d[(c8 + 4) * 72 + r] = (bf16_t)(a.z & 0xffffu); d[(c8 + 5) * 72 + r] = (bf16_t)(a.z >> 16);
  d[(c8 + 6) * 72 + r] = (bf16_t)(a.w & 0xffffu); d[(c8 + 7) * 72 + r] = (bf16_t)(a.w >> 16);
}
__device__ __forceinline__ void ml_local_unit2(const Params& p, int l, int unit, unsigned char* lds) {
  int tid_ = tidx(); asm volatile("" : "+v"(tid_)); const int tid = tid_, lane = tid & 63, wid = tid >> 6, r32 = lane & 31, hi = lane >> 5;
  unsigned char* KT = lds; unsigned char* VT = lds + 64 * MLP; float* WK = (float*)(lds + 2 * 64 * MLP);
  const bf16_t* PROJ = (const bf16_t*)(p.ws + WS_PROJ);
  const float* GT = (const float*)(p.ws + WS_GATES);
  float* UL = (float*)(p.ws + WS_ULOC); float* META = (float*)(p.ws + WS_MLMETA);
  const int b = unit / (4 * NCH), hh = (unit / NCH) & 3, ch = unit % NCH;
  const int row0 = b * SEGL + ch * 64;
  ml_stage_tr(PROJ + (size_t)row0 * PW + C_MK + hh * 64, PW, KT, tid);
  ml_stage_tr(PROJ + (size_t)row0 * PW + C_MV + hh * 64, PW, VT, tid);
  if (wid < 2) {
    const int dir = wid;
    const float ig = GT[(size_t)(row0 + lane) * 16 + (2 * dir) * 4 + hh];
    const float lf = logsigmoidf_(GT[(size_t)(row0 + lane) * 16 + (2 * dir + 1) * 4 + hh]);
    float ps = lf;
    ps = wave_incl_scan(ps);
    const float tot = __uint_as_float((unsigned)__builtin_amdgcn_readlane((int)__float_as_uint(ps), 63));
    const float wlog = dir == 0 ? (tot - ps + ig) : (ps - lf + ig);
    const float mloc = wave_max(wlog);
    WK[dir * 64 + lane] = __expf(wlog - mloc);
    if (lane == 0) {
      const int seq = (b * 4 + hh) * 2 + dir, ci = ml_cidx(ch, dir);
      META[((size_t)seq * NCH + ci) * 4 + 0] = tot; META[((size_t)seq * NCH + ci) * 4 + 1] = mloc;
    }
  }
  __syncthreads();
  {
    const int dir = wid >> 2, et = (wid >> 1) & 1, dt = wid & 1;
    const int seq = (b * 4 + hh) * 2 + dir, ci = ml_cidx(ch, dir);
    float* slot = UL + ((size_t)seq * NCH + ci) * USTRIDE;
    f32x16 acc = {};
#pragma unroll
    for (int ks = 0; ks < 4; ++ks) {
      const int s0 = ks * 16 + hi * 8;
      const u32x4 va = *(const u32x4*)(VT + (et * 32 + r32) * MLP + s0 * 2);
      const bf16x8 kb = *(const bf16x8*)(KT + (dt * 32 + r32) * MLP + s0 * 2);
      const f32x4 w0 = *(const f32x4*)(WK + dir * 64 + s0), w1 = *(const f32x4*)(WK + dir * 64 + s0 + 4);
      u32x4 sa; sa.x = cvtpk(bflo(va.x) * w0.x, bfhi(va.x) * w0.y); sa.y = cvtpk(bflo(va.y) * w0.z, bfhi(va.y) * w0.w);
      sa.z = cvtpk(bflo(va.z) * w1.x, bfhi(va.z) * w1.y); sa.w = cvtpk(bflo(va.w) * w1.z, bfhi(va.w) * w1.w);
      acc = __builtin_amdgcn_mfma_f32_32x32x16_bf16(*(const bf16x8*)&sa, kb, acc, 0, 0, 0);
    }
#pragma unroll
    for (int r = 0; r < 16; ++r) slot[(et * 32 + crow(r, hi)) * 64 + dt * 32 + r32] = acc[r];
    if (et == 0) {
      float n = 0.f;
#pragma unroll
      for (int i = 0; i < 4; ++i) {
        const int s0 = hi * 32 + i * 8;
        const u32x4 ka = *(const u32x4*)(KT + (dt * 32 + r32) * MLP + s0 * 2);
        const f32x4 w0 = *(const f32x4*)(WK + dir * 64 + s0), w1 = *(const f32x4*)(WK + dir * 64 + s0 + 4);
        n += bflo(ka.x) * w0.x + bfhi(ka.x) * w0.y + bflo(ka.y) * w0.z + bfhi(ka.y) * w0.w + bflo(ka.z) * w1.x + bfhi(ka.z) * w1.y + bflo(ka.w) * w1.z + bfhi(ka.w) * w1.w;
      }
      n = sum_xor32(n);
      if (hi == 0) slot[4096 + dt * 32 + r32] = n;
    }
  }
  __syncthreads();
}
__device__ __forceinline__ void ml_scan(const Params& p, unsigned char* lds) {
  float* UL = (float*)(p.ws + WS_ULOC); float* META = (float*)(p.ws + WS_MLMETA);
  int tid_ = tidx(); asm volatile("" : "+v"(tid_));
  const int tid = tid_, lane = tid & 63, wid = tid >> 6;
  float* DEC = (float*)lds;
  float* SCL = DEC + 2 * NCH;
  float* TMP = SCL + 2 * NCH;
  constexpr int NSL = (32 * USTRIDE + 511) / 512;
  const int first_ = p.gx > 64 ? 16 : 0, nb_ = p.gx - first_;
  for (int k_ = 0; k_ < 2 + (NSL + nb_ - 1) / nb_; ++k_) {
    int s_;
    if (k_ == 0) s_ = p.bx >= first_ ? p.bx - first_ : -1;
    else s_ = k_ * nb_ + (p.gx - 1 - p.bx);
    if (k_ > 0 && p.gx - 1 - p.bx >= nb_) s_ = -1;
    if (s_ < 0 || s_ >= NSL) continue;
    const int base0 = s_ * 512;
    const int seq0 = base0 / USTRIDE;
    if (wid < 2) {
      const int seq = seq0 + wid;
      if (seq < 32) {
        float* mt = META + (size_t)seq * NCH * 4;
        for (int c = lane; c < NCH; c += 64) { TMP[(wid * 2 + 0) * NCH + c] = mt[c * 4 + 0]; TMP[(wid * 2 + 1) * NCH + c] = mt[c * 4 + 1]; }
        asm volatile("s_waitcnt lgkmcnt(0)" ::: "memory");
        if (lane == 0) {
          float m = 0.f;
          for (int c = 0; c < NCH; ++c) {
            const float bl = TMP[(wid * 2 + 0) * NCH + c], mloc = TMP[(wid * 2 + 1) * NCH + c];
            const float mn = fmaxf(bl + m, mloc);
            DEC[wid * NCH + c] = __expf(bl + m - mn); SCL[wid * NCH + c] = __expf(mloc - mn);
            mt[c * 4 + 2] = m;
            m = mn;
          }
        }
      }
    }
    __syncthreads();
    const int idx = base0 + tid;
    if (idx < 32 * USTRIDE) {
      const int seq = idx / USTRIDE, e = idx - seq * USTRIDE, sl = seq - seq0;
      float* bp = UL + (size_t)seq * NCH * USTRIDE + e;
      bf16_t* CSTp = (bf16_t*)(p.ws + WS_CST) + (size_t)seq * NCH * 4096 + (e < 4096 ? e : 0);
      float* NSTp = (float*)(p.ws + WS_NST) + (size_t)seq * NCH * 64 + (e < 4096 ? 0 : e - 4096);
      const float* dec = DEC + sl * NCH; const float* scl = SCL + sl * NCH;
      float C = 0.f;
      constexpr int BT = 33;
      static_assert(NCH == 4 * BT, "scan batches");
      float ua[BT], ub[BT];
#define SCAN_LD(u_, c0_) _Pragma("unroll") for (int j = 0; j < BT; ++j) u_[j] = bp[(size_t)((c0_) + j) * USTRIDE];
#define SCAN_DO(u_, c0_) _Pragma("unroll") for (int j = 0; j < BT; ++j) { \
          if (e < 4096) CSTp[(size_t)((c0_) + j) * 4096] = (bf16_t)(cvtpk(C, 0.f) & 0xffffu); else NSTp[(size_t)((c0_) + j) * 64] = C; \
          C = dec[(c0_) + j] * C + scl[(c0_) + j] * u_[j]; }
      SCAN_LD(ua, 0)
#pragma unroll 1
      for (int c0 = 0; c0 < NCH; c0 += 2 * BT) {
        SCAN_LD(ub, c0 + BT)
        SCAN_DO(ua, c0)
        if (c0 + 2 * BT < NCH) { SCAN_LD(ua, c0 + 2 * BT) }
        SCAN_DO(ub, c0 + BT)
      }
#undef SCAN_LD
#undef SCAN_DO
    }
    __syncthreads();
  }
}
__device__ __forceinline__ void ml_out_unit(const Params& p, int l, int unit, unsigned char* lds) {
  int tid_ = tidx(); asm volatile("" : "+v"(tid_)); const int tid = tid_, lane = tid & 63, wid = tid >> 6, r32 = lane & 31, hi = lane >> 5;
  float* Qt = (float*)lds; float* Kt = Qt + 64 * 65; float* Vt = Kt + 64 * 65;
  float* Cs = Vt + 64 * 65;
  float* Ns = Cs + 2 * 64 * 65;
  float* Bq = Ns + 128;
  float* Gs = Bq + 128;
  float* Mi = Gs + 128;
  float* HB = Mi + 64;
  const bf16_t* PROJ = (const bf16_t*)(p.ws + WS_PROJ);
  const float* GT = (const float*)(p.ws + WS_GATES);
  const float* UL = (const float*)(p.ws + WS_ULOC); const float* META = (const float*)(p.ws + WS_MLMETA);
  bf16_t* MIX = (bf16_t*)(p.ws + WS_MIX);
  const int b = unit / (4 * NCH), hh = (unit / NCH) & 3, ch = unit % NCH;
  const int row0 = b * SEGL + ch * 64;
  ml_load_tile(PROJ + (size_t)row0 * PW + C_MQ + hh * 64, Qt, tid);
  ml_load_tile(PROJ + (size_t)row0 * PW + C_MK + hh * 64, Kt, tid);
  ml_load_tile(PROJ + (size_t)row0 * PW + C_MV + hh * 64, Vt, tid);
  for (int i = tid; i < 2 * USTRIDE; i += 512) {
    const int dir = i / USTRIDE, e = i - dir * USTRIDE;
    const int seq = (b * 4 + hh) * 2 + dir, ci = ml_cidx(ch, dir);
    const float v = UL[((size_t)seq * NCH + ci) * USTRIDE + e];
    if (e < 4096) Cs[dir * 64 * 65 + (e >> 6) * 65 + (e & 63)] = v; else Ns[dir * 64 + (e - 4096)] = v;
  }
  if (wid < 2) {
    const int dir = wid;
    const float ig = GT[(size_t)(row0 + lane) * 16 + (2 * dir) * 4 + hh];
    const float lf = logsigmoidf_(GT[(size_t)(row0 + lane) * 16 + (2 * dir + 1) * 4 + hh]);
    float ps = lf;
    ps = wave_incl_scan(ps);
    const float tot = __uint_as_float((unsigned)__builtin_amdgcn_readlane((int)__float_as_uint(ps), 63));
    const float bc = dir == 0 ? ps : (tot - ps + lf);
    Bq[dir * 64 + lane] = bc; Gs[dir * 64 + lane] = ig - bc;
    if (lane == 0) { const int seq = (b * 4 + hh) * 2 + dir, ci = ml_cidx(ch, dir); Mi[dir] = META[((size_t)seq * NCH + ci) * 4 + 2]; }
  }
  __syncthreads();
  {
    const int dir = wid >> 2, tt = (wid >> 1) & 1, et = wid & 1;
    const int t = tt * 32 + r32;
    f32x16 sa[2] = {};
#pragma unroll 4
    for (int ks = 0; ks < 32; ++ks) {
      const float bq = Qt[t * 65 + 2 * ks + hi];
      const float a0 = Kt[(r32) * 65 + 2 * ks + hi], a1 = Kt[(32 + r32) * 65 + 2 * ks + hi];
      sa[0] = __builtin_amdgcn_mfma_f32_32x32x2f32(a0, bq, sa[0], 0, 0, 0);
      sa[1] = __builtin_amdgcn_mfma_f32_32x32x2f32(a1, bq, sa[1], 0, 0, 0);
    }
    const float bt = Bq[dir * 64 + t];
    const float inter = bt + Mi[dir];
    float mx = -INFINITY;
    f32x16 dl[2];
#pragma unroll
    for (int st = 0; st < 2; ++st)
#pragma unroll
      for (int r = 0; r < 16; ++r) {
        const int s = st * 32 + crow(r, hi);
        const bool ok = dir == 0 ? (s <= t) : (s >= t);
        const float d = ok ? bt + Gs[dir * 64 + s] : -INFINITY;
        dl[st][r] = d; mx = fmaxf(mx, d);
      }
    mx = max_xor32(mx);
    const float mt = fmaxf(inter, mx);
    const float iw = __expf(inter - mt);
    float rsum = 0.f;
#pragma unroll
    for (int st = 0; st < 2; ++st)
#pragma unroll
      for (int r = 0; r < 16; ++r) { const float w = __expf(dl[st][r] - mt); sa[st][r] *= w; rsum += sa[st][r]; }
    rsum = sum_xor32(rsum);
    float qn = 0.f;
#pragma unroll 8
    for (int i = 0; i < 32; ++i) { const int d = hi * 32 + i; qn += Ns[dir * 64 + d] * Qt[t * 65 + d]; }
    qn = sum_xor32(qn);
    const float den = rsum + iw * qn;
    const float rden = 1.f / fmaxf(fabsf(den), __expf(-mt));
    f32x16 an = {}, ac = {};
#pragma unroll
    for (int st = 0; st < 2; ++st)
#pragma unroll
      for (int r = 0; r < 16; ++r) {
        const float a = Vt[(st * 32 + crow(r, hi)) * 65 + et * 32 + r32];
        an = __builtin_amdgcn_mfma_f32_32x32x2f32(a, sa[st][r], an, 0, 0, 0);
      }
    const float* Cd = Cs + dir * 64 * 65;
#pragma unroll 4
    for (int ks = 0; ks < 32; ++ks) {
      const float a = Cd[(et * 32 + r32) * 65 + 2 * ks + hi];
      const float bq = Qt[t * 65 + 2 * ks + hi];
      ac = __builtin_amdgcn_mfma_f32_32x32x2f32(a, bq, ac, 0, 0, 0);
    }
#pragma unroll
    for (int r = 0; r < 16; ++r) HB[dir * 64 * 65 + t * 65 + et * 32 + crow(r, hi)] = (an[r] + iw * ac[r]) * rden;
  }
  __syncthreads();
  {
    const int t = tid >> 3, e8 = (tid & 7) * 8;
    float v[8]; float ss = 0.f;
#pragma unroll
    for (int i = 0; i < 8; ++i) { v[i] = HB[t * 65 + e8 + i] + HB[64 * 65 + t * 65 + e8 + i]; ss += v[i] * v[i]; }
    ss += dpp_mov<0xB1>(ss); ss += dpp_mov<0x4E>(ss); ss += dpp_mov<0x141>(ss);
    const float rs = rsqrtf(ss * (1.f / 64.f) + EPS);
    const u32x4 ov = *(const u32x4*)(PROJ + (size_t)(row0 + t) * PW + C_MO + hh * 64 + e8);
    const float og[8] = {bflo(ov.x), bfhi(ov.x), bflo(ov.y), bfhi(ov.y), bflo(ov.z), bfhi(ov.z), bflo(ov.w), bfhi(ov.w)};
    const float* g = p.in[I_MNORMG] + l * 64 + e8;
    float o[8];
#pragma unroll
    for (int i = 0; i < 8; ++i) o[i] = (ABL & 2) ? 0.f : v[i] * rs * g[i] * sigmoidf_(og[i]);
    u32x4 w; w.x = cvtpk(o[0], o[1]); w.y = cvtpk(o[2], o[3]); w.z = cvtpk(o[4], o[5]); w.w = cvtpk(o[6], o[7]);
    *(u32x4*)(MIX + (size_t)(row0 + t) * DM + 256 + hh * 64 + e8) = w;
  }
  __syncthreads();
}


struct MlOutPf { u32x4 q, k, v, c0, c1, ov; float ns0, ns1, g_ig, g_lf, mi; };
__device__ __forceinline__ void ml_out_fetch(const Params& p, int unit, int tid, MlOutPf& f) {
  const int lane = tid & 63, wid = tid >> 6;
  const bf16_t* PROJ = (const bf16_t*)(p.ws + WS_PROJ);
  const float* GT = (const float*)(p.ws + WS_GATES);
  const bf16_t* CST = (const bf16_t*)(p.ws + WS_CST); const float* NST = (const float*)(p.ws + WS_NST); const float* META = (const float*)(p.ws + WS_MLMETA);
  const int b = unit / (4 * NCH), hh = (unit / NCH) & 3, ch = unit % NCH;
  const int row0 = b * SEGL + ch * 64;
  const int r = tid >> 3, c8 = (tid & 7) * 8;
  const bf16_t* prow = PROJ + (size_t)(row0 + r) * PW + hh * 64 + c8;
  f.q = *(const u32x4*)(prow + C_MQ); f.k = *(const u32x4*)(prow + C_MK); f.v = *(const u32x4*)(prow + C_MV); f.ov = *(const u32x4*)(prow + C_MO);
  const int seq0 = (b * 4 + hh) * 2, ci0 = ml_cidx(ch, 0), ci1 = ml_cidx(ch, 1);
  f.c0 = *(const u32x4*)(CST + ((size_t)seq0 * NCH + ci0) * 4096 + r * 64 + c8);
  f.c1 = *(const u32x4*)(CST + ((size_t)(seq0 + 1) * NCH + ci1) * 4096 + r * 64 + c8);
  f.ns0 = 0.f; f.ns1 = 0.f; f.g_ig = 0.f; f.g_lf = 0.f; f.mi = 0.f;
  if (tid < 64) { f.ns0 = NST[((size_t)seq0 * NCH + ci0) * 64 + tid]; f.ns1 = NST[((size_t)(seq0 + 1) * NCH + ci1) * 64 + tid]; }
  if (wid < 2) {
    const int dir = wid;
    f.g_ig = GT[(size_t)(row0 + lane) * 16 + (2 * dir) * 4 + hh];
    f.g_lf = GT[(size_t)(row0 + lane) * 16 + (2 * dir + 1) * 4 + hh];
    f.mi = META[((size_t)(seq0 + dir) * NCH + (dir ? ci1 : ci0)) * 4 + 2];
  }
}
__device__ __forceinline__ void ml_put_rm(const u32x4 a, unsigned char* dst, int tid) { const int r = tid >> 3, c8 = (tid & 7) * 8; *(u32x4*)(dst + r * MLP + c8 * 2) = a; }
__device__ __forceinline__ void ml_put_tr(const u32x4 a, unsigned char* dst, int tid) {
  const int r = tid >> 3, c8 = (tid & 7) * 8;
  bf16_t* d = (bf16_t*)dst;
  d[(c8 + 0) * 72 + r] = (bf16_t)(a.x & 0xffffu); d[(c8 + 1) * 72 + r] = (bf16_t)(a.x >> 16);
  d[(c8 + 2) * 72 + r] = (bf16_t)(a.y & 0xffffu); d[(c8 + 3) * 72 + r] = (bf16_t)(a.y >> 16);
  d[(c8 + 4) * 72 + r] = (bf16_t)(a.z & 0xffffu); d[(c8 + 5) * 72 + r] = (bf16_t)(a.z >> 16);
  d[(c8 + 6) * 72 + r] = (bf16_t)(a.w & 0xffffu); d[(c8 + 7) * 72 + r] = (bf16_t)(a.w >> 16);
}
__device__ __forceinline__ void ml_out_unit2(const Params& p, int l, int unit, unsigned char* lds, const MlOutPf& f, int next, MlOutPf& fn) {
  int tid_ = tidx(); asm volatile("" : "+v"(tid_)); const int tid = tid_, lane = tid & 63, wid = tid >> 6, r32 = lane & 31, hi = lane >> 5;
  unsigned char* Qs = lds; unsigned char* Ks = lds + 64 * MLP; unsigned char* VT = lds + 2 * 64 * MLP; unsigned char* Cs = lds + 3 * 64 * MLP;
  float* Ns = (float*)(lds + 5 * 64 * MLP);
  float* Bq = Ns + 128;
  float* Gs = Bq + 128;
  float* Mi = Gs + 128;
  float* HB = Mi + 64;
  const bf16_t* PROJ = (const bf16_t*)(p.ws + WS_PROJ);
  const float* GT = (const float*)(p.ws + WS_GATES);
  const bf16_t* CST = (const bf16_t*)(p.ws + WS_CST); const float* NST = (const float*)(p.ws + WS_NST); const float* META = (const float*)(p.ws + WS_MLMETA);
  bf16_t* MIX = (bf16_t*)(p.ws + WS_MIX);
  const int b = unit / (4 * NCH), hh = (unit / NCH) & 3, ch = unit % NCH;
  const int row0 = b * SEGL + ch * 64;
  ml_put_rm(f.q, Qs, tid); ml_put_rm(f.k, Ks, tid); ml_put_tr(f.v, VT, tid);
  ml_put_rm(f.c0, Cs, tid); ml_put_rm(f.c1, Cs + 64 * MLP, tid);
  if (tid < 64) { Ns[tid] = f.ns0; Ns[64 + tid] = f.ns1; }
  if (wid < 2) {
    const int dir = wid;
    const float ig = f.g_ig;
    const float lf = logsigmoidf_(f.g_lf);
    float ps = lf;
    ps = wave_incl_scan(ps);
    const float tot = __uint_as_float((unsigned)__builtin_amdgcn_readlane((int)__float_as_uint(ps), 63));
    const float bc = dir == 0 ? ps : (tot - ps + lf);
    Bq[dir * 64 + lane] = bc; Gs[dir * 64 + lane] = ig - bc;
    if (lane == 0) Mi[dir] = f.mi;
  }
  const u32x4 ov = f.ov;
  if (next >= 0) ml_out_fetch(p, next, tid, fn);
  __syncthreads();
  {
    const int dir = wid >> 2, tt = (wid >> 1) & 1, et = wid & 1;
    const int t = tt * 32 + r32;
    f32x16 sa[2] = {};
    bf16x8 bq[4];
#pragma unroll
    for (int ks = 0; ks < 4; ++ks) {
      bq[ks] = *(const bf16x8*)(Qs + t * MLP + (ks * 16 + hi * 8) * 2);
      const bf16x8 a0 = *(const bf16x8*)(Ks + r32 * MLP + (ks * 16 + hi * 8) * 2), a1 = *(const bf16x8*)(Ks + (32 + r32) * MLP + (ks * 16 + hi * 8) * 2);
      sa[0] = __builtin_amdgcn_mfma_f32_32x32x16_bf16(a0, bq[ks], sa[0], 0, 0, 0);
      sa[1] = __builtin_amdgcn_mfma_f32_32x32x16_bf16(a1, bq[ks], sa[1], 0, 0, 0);
    }
    const float bt = Bq[dir * 64 + t];
    const float inter = bt + Mi[dir];
    float mx = -INFINITY;
    f32x16 dl[2];
#pragma unroll
    for (int st = 0; st < 2; ++st)
#pragma unroll
      for (int r = 0; r < 16; ++r) {
        const int s = st * 32 + crow(r, hi);
        const bool ok = dir == 0 ? (s <= t) : (s >= t);
        const float d = ok ? bt + Gs[dir * 64 + s] : -INFINITY;
        dl[st][r] = d; mx = fmaxf(mx, d);
      }
    mx = max_xor32(mx);
    const float mt = fmaxf(inter, mx);
    const float iw = __expf(inter - mt);
    float rsum = 0.f;
#pragma unroll
    for (int st = 0; st < 2; ++st)
#pragma unroll
      for (int r = 0; r < 16; ++r) { const float w = __expf(dl[st][r] - mt); sa[st][r] *= w; rsum += sa[st][r]; }
    rsum = sum_xor32(rsum);
    float qn = 0.f;
#pragma unroll
    for (int i = 0; i < 4; ++i) {
      const int d0 = hi * 32 + i * 8;
      const u32x4 qa = *(const u32x4*)(Qs + t * MLP + d0 * 2);
      const f32x4 n0 = *(const f32x4*)(Ns + dir * 64 + d0), n1 = *(const f32x4*)(Ns + dir * 64 + d0 + 4);
      qn += bflo(qa.x) * n0.x + bfhi(qa.x) * n0.y + bflo(qa.y) * n0.z + bfhi(qa.y) * n0.w + bflo(qa.z) * n1.x + bfhi(qa.z) * n1.y + bflo(qa.w) * n1.z + bfhi(qa.w) * n1.w;
    }
    qn = sum_xor32(qn);
    const float den = rsum + iw * qn;
    const float rden = 1.f / fmaxf(fabsf(den), __expf(-mt));
    f32x16 an = {}, ac = {};
#pragma unroll
    for (int st = 0; st < 2; ++st)
#pragma unroll
      for (int k2 = 0; k2 < 2; ++k2) {
        u32x4 bx; bx.x = cvtpk(sa[st][8 * k2 + 0], sa[st][8 * k2 + 1]); bx.y = cvtpk(sa[st][8 * k2 + 2], sa[st][8 * k2 + 3]);
        bx.z = cvtpk(sa[st][8 * k2 + 4], sa[st][8 * k2 + 5]); bx.w = cvtpk(sa[st][8 * k2 + 6], sa[st][8 * k2 + 7]);
        const unsigned char* vrow = VT + (et * 32 + r32) * MLP + (st * 32 + 16 * k2 + 4 * hi) * 2;
        const u32x2 v0 = *(const u32x2*)vrow, v1 = *(const u32x2*)(vrow + 16);
        u32x4 ax; ax.x = v0.x; ax.y = v0.y; ax.z = v1.x; ax.w = v1.y;
        an = __builtin_amdgcn_mfma_f32_32x32x16_bf16(*(const bf16x8*)&ax, *(const bf16x8*)&bx, an, 0, 0, 0);
      }
    const unsigned char* Cd = Cs + dir * 64 * MLP;
#pragma unroll
    for (int ks = 0; ks < 4; ++ks) {
      const bf16x8 a = *(const bf16x8*)(Cd + (et * 32 + r32) * MLP + (ks * 16 + hi * 8) * 2);
      ac = __builtin_amdgcn_mfma_f32_32x32x16_bf16(a, bq[ks], ac, 0, 0, 0);
    }
#pragma unroll
    for (int r = 0; r < 16; ++r) HB[dir * 64 * 65 + t * 65 + et * 32 + crow(r, hi)] = (an[r] + iw * ac[r]) * rden;
  }
  __syncthreads();
  {
    const int t = tid >> 3, e8 = (tid & 7) * 8;
    float v[8]; float ss = 0.f;
#pragma unroll
    for (int i = 0; i < 8; ++i) { v[i] = HB[t * 65 + e8 + i] + HB[64 * 65 + t * 65 + e8 + i]; ss += v[i] * v[i]; }
    ss += dpp_mov<0xB1>(ss); ss += dpp_mov<0x4E>(ss); ss += dpp_mov<0x141>(ss);
    const float rs = rsqrtf(ss * (1.f / 64.f) + EPS);
    const float og[8] = {bflo(ov.x), bfhi(ov.x), bflo(ov.y), bfhi(ov.y), bflo(ov.z), bfhi(ov.z), bflo(ov.w), bfhi(ov.w)};
    const float* g = p.in[I_MNORMG] + l * 64 + e8;
    float o[8];
#pragma unroll
    for (int i = 0; i < 8; ++i) o[i] = (ABL & 2) ? 0.f : v[i] * rs * g[i] * sigmoidf_(og[i]);
    u32x4 w; w.x = cvtpk(o[0], o[1]); w.y = cvtpk(o[2], o[3]); w.z = cvtpk(o[4], o[5]); w.w = cvtpk(o[6], o[7]);
    *(u32x4*)(MIX + (size_t)(row0 + t) * DM + 256 + hh * 64 + e8) = w;
  }
  __syncthreads();
}

#define KSWZ(row, colB) ((row) * 256 + ((colB) ^ (((row) & 15) << 4)))
#define SBAR() __builtin_amdgcn_sched_barrier(0)
constexpr int ATT_SHM_V = 128 * 80, ATT_SHM_K = 64 * QK8_PITCH;
constexpr float ATT_THR = 8.0f;
__device__ __forceinline__ int v_st(int k, int c) { const int kk = (k & ~0xC) | ((k & 4) << 1) | ((k & 8) >> 1); return ((kk >> 3) * 4 + (c >> 5)) * 512 + ((kk & 7) * 32 + (c & 31)) * 2; }
__device__ __forceinline__ int v_rd_base(int lane) { return ((lane & 3) << 3) | (((lane >> 2) & 3) << 6) | (((lane >> 4) & 1) << 5) | (((lane >> 5) & 1) << 8); }
constexpr int v_rd_off(int d0, int ks, int half) { return d0 * 512 + ks * 4096 + half * 2048; }
template <int OFF> __device__ __forceinline__ s16x4 tr_read(int vb) {
  s16x4 r; asm volatile("ds_read_b64_tr_b16 %0, %1 offset:%2" : "=&v"(r) : "v"(vb), "i"(OFF) : "memory"); return r;
}
template <int D0> __device__ __forceinline__ void pv_one(f32x16& od, int vb, bf16x8 pa0, bf16x8 pa1, bf16x8 pa2, bf16x8 pa3) {
  const s16x4 l0 = tr_read<v_rd_off(D0, 0, 0)>(vb), h0 = tr_read<v_rd_off(D0, 0, 1)>(vb), l1 = tr_read<v_rd_off(D0, 1, 0)>(vb), h1 = tr_read<v_rd_off(D0, 1, 1)>(vb);
  const s16x4 l2 = tr_read<v_rd_off(D0, 2, 0)>(vb), h2 = tr_read<v_rd_off(D0, 2, 1)>(vb), l3 = tr_read<v_rd_off(D0, 3, 0)>(vb), h3 = tr_read<v_rd_off(D0, 3, 1)>(vb);
  asm volatile("s_waitcnt lgkmcnt(0)" ::: "memory"); SBAR();
#define PK(L, H) (bf16x8){L[0], L[1], L[2], L[3], H[0], H[1], H[2], H[3]}
  od = __builtin_amdgcn_mfma_f32_32x32x16_bf16(pa0, PK(l0, h0), od, 0, 0, 0);
  od = __builtin_amdgcn_mfma_f32_32x32x16_bf16(pa1, PK(l1, h1), od, 0, 0, 0);
  od = __builtin_amdgcn_mfma_f32_32x32x16_bf16(pa2, PK(l2, h2), od, 0, 0, 0);
  od = __builtin_amdgcn_mfma_f32_32x32x16_bf16(pa3, PK(l3, h3), od, 0, 0, 0);
#undef PK
}
template <int D0> __device__ __forceinline__ void pv_two(f32x16& oa, f32x16& ob, int vb, bf16x8 a0, bf16x8 a1, bf16x8 a2, bf16x8 a3, bf16x8 b0, bf16x8 b1, bf16x8 b2, bf16x8 b3) {
  const s16x4 l0 = tr_read<v_rd_off(D0, 0, 0)>(vb), h0 = tr_read<v_rd_off(D0, 0, 1)>(vb), l1 = tr_read<v_rd_off(D0, 1, 0)>(vb), h1 = tr_read<v_rd_off(D0, 1, 1)>(vb);
  const s16x4 l2 = tr_read<v_rd_off(D0, 2, 0)>(vb), h2 = tr_read<v_rd_off(D0, 2, 1)>(vb), l3 = tr_read<v_rd_off(D0, 3, 0)>(vb), h3 = tr_read<v_rd_off(D0, 3, 1)>(vb);
  asm volatile("s_waitcnt lgkmcnt(0)" ::: "memory"); SBAR();
#define PK(L, H) (bf16x8){L[0], L[1], L[2], L[3], H[0], H[1], H[2], H[3]}
  const bf16x8 v0 = PK(l0, h0), v1 = PK(l1, h1), v2 = PK(l2, h2), v3 = PK(l3, h3);
  oa = __builtin_amdgcn_mfma_f32_32x32x16_bf16(a0, v0, oa, 0, 0, 0);
  ob = __builtin_amdgcn_mfma_f32_32x32x16_bf16(b0, v0, ob, 0, 0, 0);
  oa = __builtin_amdgcn_mfma_f32_32x32x16_bf16(a1, v1, oa, 0, 0, 0);
  ob = __builtin_amdgcn_mfma_f32_32x32x16_bf16(b1, v1, ob, 0, 0, 0);
  oa = __builtin_amdgcn_mfma_f32_32x32x16_bf16(a2, v2, oa, 0, 0, 0);
  ob = __builtin_amdgcn_mfma_f32_32x32x16_bf16(b2, v2, ob, 0, 0, 0);
  oa = __builtin_amdgcn_mfma_f32_32x32x16_bf16(a3, v3, oa, 0, 0, 0);
  ob = __builtin_amdgcn_mfma_f32_32x32x16_bf16(b3, v3, ob, 0, 0, 0);
#undef PK
}
struct KQFrag { bf16x8 b0, b1, q; };
__device__ __forceinline__ void att_ldkq(KQFrag& f, const LAS unsigned char* l3, int akk, int akq) {
  const LAS unsigned char* kp = l3 + akk;
  f.b0 = *(const LAS bf16x8*)kp; f.b1 = *(const LAS bf16x8*)(kp + 8192); f.q = *(const LAS bf16x8*)(l3 + akq);
}
#define ATT_MF(pa_, pb_, f_) do { pa_ = __builtin_amdgcn_mfma_f32_32x32x16_bf16(f_.b0, f_.q, pa_, 0, 0, 0); pb_ = __builtin_amdgcn_mfma_f32_32x32x16_bf16(f_.b1, f_.q, pb_, 0, 0, 0); } while (0)
__device__ __forceinline__ void att_qk_all(f32x16& p0, f32x16& p1, f32x16& q0, f32x16& q1, KQFrag& f0, const LAS unsigned char* l3, int akk0, int akq0, float ia, float ib) {
  KQFrag f1;
#pragma unroll
  for (int r = 0; r < 16; ++r) { p0[r] = ia; p1[r] = ia; q0[r] = ib; q1[r] = ib; }
  att_ldkq(f1, l3, akk0 ^ (1 << 5), akq0 ^ (1 << 5)); ATT_MF(p0, p1, f0); SBAR();
  att_ldkq(f0, l3, akk0 ^ (2 << 5), akq0 ^ (2 << 5)); ATT_MF(p0, p1, f1); SBAR();
  att_ldkq(f1, l3, akk0 ^ (3 << 5), akq0 ^ (3 << 5)); ATT_MF(p0, p1, f0); SBAR();
  att_ldkq(f0, l3, akk0 ^ (4 << 5), akq0 ^ (4 << 5)); ATT_MF(p0, p1, f1); SBAR();
  att_ldkq(f1, l3, akk0 ^ (5 << 5), akq0 ^ (5 << 5)); ATT_MF(q0, q1, f0); SBAR();
  att_ldkq(f0, l3, akk0 ^ (6 << 5), akq0 ^ (6 << 5)); ATT_MF(q0, q1, f1); SBAR();
  att_ldkq(f1, l3, akk0 ^ (7 << 5), akq0 ^ (7 << 5)); ATT_MF(q0, q1, f0); SBAR();
  ATT_MF(q0, q1, f1); SBAR();
}
__device__ __forceinline__ float bf16_near(float x) { return __uint_as_float((__float_as_uint(x) + 0x8000u) & 0xFFFF0000u); }
__device__ __forceinline__ void att_softmax(f32x16& p0, f32x16& p1, float& m_reg, float& l_reg, float& alpha, bool first, i32x8& pa) {
  alpha = 1.f;
  if (first) {
    float pmax = p0[0];
#pragma unroll
    for (int r = 1; r < 16; ++r) pmax = fmaxf(pmax, p0[r]);
#pragma unroll
    for (int r = 0; r < 16; ++r) pmax = fmaxf(pmax, p1[r]);
    { auto rr = __builtin_amdgcn_permlane32_swap(__float_as_uint(pmax), __float_as_uint(pmax), false, false);
      pmax = fmaxf(__uint_as_float(rr[0]), __uint_as_float(rr[1])); }
    pmax = bf16_near(pmax);
    alpha = 0.f; m_reg = pmax;
#pragma unroll
    for (int r = 0; r < 16; ++r) { p0[r] -= pmax; p1[r] -= pmax; }
  }
#pragma unroll
  for (int r = 0; r < 16; ++r) { p0[r] = __builtin_amdgcn_exp2f(p0[r]); p1[r] = __builtin_amdgcn_exp2f(p1[r]); }
  float ps;
  {
#define VADD(d_, a_, b_) asm("v_add_f32_e32 %0, %1, %2" : "=v"(d_) : "v"(a_), "v"(b_))
    float s0, s1, s2, s3;
    VADD(s0, p0[0], p0[1]); VADD(s1, p0[8], p0[9]); VADD(s2, p1[0], p1[1]); VADD(s3, p1[8], p1[9]);
#pragma unroll
    for (int r = 2; r < 8; ++r) { VADD(s0, s0, p0[r]); VADD(s1, s1, p0[8 + r]); VADD(s2, s2, p1[r]); VADD(s3, s3, p1[8 + r]); }
    VADD(s0, s0, s1); VADD(s2, s2, s3); VADD(ps, s0, s2);
#undef VADD
  }
  { auto rr = __builtin_amdgcn_permlane32_swap(__float_as_uint(ps), __float_as_uint(ps), false, false);
    ps = __uint_as_float(rr[0]) + __uint_as_float(rr[1]); }
  if (__builtin_expect(!first && __any(ps > 256.f), 0)) {
    float emax = p0[0];
#pragma unroll
    for (int r = 1; r < 16; ++r) emax = fmaxf(emax, p0[r]);
#pragma unroll
    for (int r = 0; r < 16; ++r) emax = fmaxf(emax, p1[r]);
    { auto rr = __builtin_amdgcn_permlane32_swap(__float_as_uint(emax), __float_as_uint(emax), false, false);
      emax = fmaxf(__uint_as_float(rr[0]), __uint_as_float(rr[1])); }
    const float m_new = bf16_near(m_reg + fmaxf(__builtin_amdgcn_logf(emax), 0.f));
    const float delta = m_new - m_reg;
    alpha = __builtin_amdgcn_exp2f(-delta); m_reg = m_new;
#pragma unroll
    for (int r = 0; r < 16; ++r) { p0[r] *= alpha; p1[r] *= alpha; }
    ps *= alpha;
  }
  l_reg = l_reg * alpha + ps;
#pragma unroll
  for (int v = 0; v < 4; ++v) {
    int w0, w1; asm volatile("" : "=v"(w0), "=v"(w1));
    w0 = __builtin_amdgcn_cvt_pk_fp8_f32(p0[4 * v], p0[4 * v + 1], w0, false); w0 = __builtin_amdgcn_cvt_pk_fp8_f32(p0[4 * v + 2], p0[4 * v + 3], w0, true);
    w1 = __builtin_amdgcn_cvt_pk_fp8_f32(p1[4 * v], p1[4 * v + 1], w1, false); w1 = __builtin_amdgcn_cvt_pk_fp8_f32(p1[4 * v + 2], p1[4 * v + 3], w1, true);
    pa[v] = w0; pa[4 + v] = w1;
  }
}
__device__ __forceinline__ void att_unit(const unsigned char* __restrict__ Q8, const unsigned char* __restrict__ K8, const unsigned char* __restrict__ V8, bf16_t* __restrict__ Ob,
                                         int nkeys, float lam, const float* __restrict__ ng, float oscale, unsigned char* lds) {
  int tid_ = tidx(); asm volatile("" : "+v"(tid_)); const int tid = tid_, wid = tid >> 6, lane = tid & 63, r32 = lane & 31, hi = lane >> 5;
  const int grp = __builtin_amdgcn_readfirstlane(wid >> 2);
  unsigned char* V_lds = lds; unsigned char* K_lds = lds + 2 * ATT_SHM_V;
  float* wsl = (float*)(lds + 2 * ATT_SHM_V + 2 * ATT_SHM_K) + wid * 64; float* li_l = wsl; float* al_l = wsl + 32;
  float m0 = 0.f, l0 = 0.f, m1 = 0.f, l1 = 0.f;
  f32x16 o0[4] = {}, o1[4] = {};
  unsigned char* Q_lds = lds + 2 * ATT_SHM_V + 2 * ATT_SHM_K + 2048;
#pragma unroll
  for (int i = 0; i < 5; ++i) { const int piece = __builtin_amdgcn_readfirstlane(wid) + 8 * i;
    if (piece < 36) __builtin_amdgcn_global_load_lds((const unsigned*)(Q8 + piece * 1024 + lane * 16), (LAS unsigned*)(Q_lds + piece * 1024), 16, 0, 0); }
  const unsigned ldsw = (unsigned)__builtin_amdgcn_readfirstlane(wid) * 1024u;
#define GSTAGE_K(b, k0) do { const unsigned char* ki_ = K8 + (size_t)(k0) * QK8_PITCH + tid * 16; \
      __builtin_amdgcn_global_load_lds((const unsigned*)ki_, (LAS unsigned*)(K_lds + (b) * ATT_SHM_K + ldsw), 16, 0, 0); \
      if (wid < 1) __builtin_amdgcn_global_load_lds((const unsigned*)(ki_ + 8192), (LAS unsigned*)(K_lds + (b) * ATT_SHM_K + 8192 + ldsw), 16, 0, 0); } while (0)
#define GSTAGE_V(b, k0) do { const unsigned char* vi_ = V8 + (size_t)((k0) >> 6) * ATT_SHM_V + tid * 16; \
      __builtin_amdgcn_global_load_lds((const unsigned*)vi_, (LAS unsigned*)(V_lds + (b) * ATT_SHM_V + ldsw), 16, 0, 0); \
      if (wid < 2) __builtin_amdgcn_global_load_lds((const unsigned*)(vi_ + 8192), (LAS unsigned*)(V_lds + (b) * ATT_SHM_V + 8192 + ldsw), 16, 0, 0); } while (0)
#define STAGE_PAIR(jj) do { GSTAGE_V((jj) & 1, (jj) * 64); if ((jj) + 1 < NT) GSTAGE_K((jj) & 1, ((jj) + 1) * 64); } while (0)
#define RESC(o, a) do { if (__any((a) < 1.f)) { if (hi == 0) al_l[r32] = (a); asm volatile("s_waitcnt lgkmcnt(0)" ::: "memory"); \
    _Pragma("unroll") for (int d = 0; d < 4; ++d) _Pragma("unroll") for (int r = 0; r < 16; ++r) o[d][r] *= al_l[crow(r, hi)]; } } while (0)
#define ATT_BAR() do { asm volatile("s_waitcnt lgkmcnt(0)" ::: "memory"); __builtin_amdgcn_s_barrier(); asm volatile("" ::: "memory"); } while (0)
#define ATT_LDK(dst_, off_) do { const u32x4 x0_ = *(const LAS u32x4*)(kb_ + (off_)), x1_ = *(const LAS u32x4*)(kb_ + (off_) + 16); \
      dst_[0] = (int)x0_.x; dst_[1] = (int)x0_.y; dst_[2] = (int)x0_.z; dst_[3] = (int)x0_.w; dst_[4] = (int)x1_.x; dst_[5] = (int)x1_.y; dst_[6] = (int)x1_.z; dst_[7] = (int)x1_.w; } while (0)
#define ATT_SC(acc_, kf_, qf_) acc_ = __builtin_amdgcn_mfma_scale_f32_32x32x64_f8f6f4(kf_, qf_, acc_, 0, 0, 0, 0x7F7F7F7F, 0, 0x7F7F7F7F)
#define ATT_LDQ(dst_, off_) do { const u32x4 x0_ = *(const LAS u32x4*)(qb_ + (off_)), x1_ = *(const LAS u32x4*)(qb_ + (off_) + 16); \
      dst_[0] = (int)x0_.x; dst_[1] = (int)x0_.y; dst_[2] = (int)x0_.z; dst_[3] = (int)x0_.w; dst_[4] = (int)x1_.x; dst_[5] = (int)x1_.y; dst_[6] = (int)x1_.z; dst_[7] = (int)x1_.w; } while (0)
#define ATT_INIT2(pa_, pb_, negm_) do { u32x4 oa_, ob_; unsigned z_ = 0u; asm volatile("" : "+v"(z_)); \
      oa_.x = hi ? z_ : 0x3F80u; oa_.y = z_; oa_.z = z_; oa_.w = z_; ob_.x = hi ? z_ : (__float_as_uint(negm_) >> 16); ob_.y = z_; ob_.z = z_; ob_.w = z_; \
      const f32x16 zz_ = {}; \
      pa_ = __builtin_amdgcn_mfma_f32_32x32x16_bf16(*(const bf16x8*)&oa_, *(const bf16x8*)&ob_, zz_, 0, 0, 0); \
      pb_ = __builtin_amdgcn_mfma_f32_32x32x16_bf16(*(const bf16x8*)&oa_, *(const bf16x8*)&ob_, zz_, 0, 0, 0); } while (0)
#define ATT_QK_ALL(ia_, ib_) do { ATT_INIT2(p0, p1, ia_); ATT_INIT2(q0, q1, ib_); SBAR(); \
      ATT_SC(p0, kf0, qf); SBAR(); ATT_LDK(kf0, 32 * QK8_PITCH); SBAR(); \
      ATT_SC(p1, kf0, qf); SBAR(); ATT_LDK(kf0, 64); ATT_LDQ(qf, 64); SBAR(); \
      ATT_SC(q0, kf0, qf); SBAR(); ATT_LDK(kf0, 32 * QK8_PITCH + 64); SBAR(); \
      ATT_SC(q1, kf0, qf); SBAR(); } while (0)
  const int NT = nkeys / 64;
  GSTAGE_K(1, 0); STAGE_PAIR(0);
  asm volatile("s_waitcnt vmcnt(0)" ::: "memory"); __syncthreads();
  f32x16 p0, p1, q0, q1; i32x8 pa, pb;
  const LAS unsigned char* l3 = (const LAS unsigned char*)lds;
  const int kofs0 = 2 * ATT_SHM_V + r32 * QK8_PITCH + hi * 32;
  const int qofs0 = 2 * ATT_SHM_V + 2 * ATT_SHM_K + 2048 + (__builtin_amdgcn_readfirstlane(wid) * 32 + r32) * QK8_PITCH + hi * 32;
  { i32x8 kf0, qf; const LAS unsigned char* kb_ = l3 + (kofs0 + ATT_SHM_K); const LAS unsigned char* qb_ = l3 + qofs0;
    ATT_LDK(kf0, 0); ATT_LDQ(qf, 0);
    ATT_QK_ALL(0.f, 0.f); }
  if (grp) ATT_BAR();
#pragma unroll 1
  for (int j = 0; j < NT; ++j) {
    const int cur = j & 1;
    const bool more = (j + 1 < NT);
    if (grp && more) STAGE_PAIR(j + 1);
    { float alphaA, alphaB;
      const bool first = (j == 0);
      att_softmax(p0, p1, m0, l0, alphaA, first, pa); SBAR();
      att_softmax(q0, q1, m1, l1, alphaB, first, pb); SBAR();
      RESC(o0, alphaA);
      RESC(o1, alphaB); }
    asm volatile("" : "+v"(pa), "+v"(pb), "+v"(m0), "+v"(l0), "+v"(m1), "+v"(l1));
    asm volatile("" : "+v"(o0[0]), "+v"(o0[1]), "+v"(o0[2]), "+v"(o0[3]), "+v"(o1[0]), "+v"(o1[1]), "+v"(o1[2]), "+v"(o1[3]));
    if (!grp) asm volatile("s_waitcnt vmcnt(0)" ::: "memory");
    ATT_BAR();
    if (!grp && more) STAGE_PAIR(j + 1);
    __builtin_amdgcn_s_setprio(1);
    {
      int kofs = kofs0, qofs = qofs0; asm volatile("" : "+v"(kofs), "+v"(qofs));
      const LAS unsigned char* kb_ = l3 + (kofs + cur * ATT_SHM_K); const LAS unsigned char* qb_ = l3 + qofs;
      i32x8 kf0, qf;
      const LAS unsigned char* vrow = l3 + (r32 * 80 + hi * 32 + cur * ATT_SHM_V);
      u32x4 va0 = *(const LAS u32x4*)vrow, va1 = *(const LAS u32x4*)(vrow + 16), vb0, vb1;
#define ATT_PV(d0_, x0_, x1_) do { i32x8 bv; bv[0] = (int)x0_.x; bv[1] = (int)x0_.y; bv[2] = (int)x0_.z; bv[3] = (int)x0_.w; bv[4] = (int)x1_.x; bv[5] = (int)x1_.y; bv[6] = (int)x1_.z; bv[7] = (int)x1_.w; \
        o0[d0_] = __builtin_amdgcn_mfma_scale_f32_32x32x64_f8f6f4(pa, bv, o0[d0_], 0, 0, 0, 0x7F7F7F7F, 0, 0x7F7F7F7F); \
        o1[d0_] = __builtin_amdgcn_mfma_scale_f32_32x32x64_f8f6f4(pb, bv, o1[d0_], 0, 0, 0, 0x7F7F7F7F, 0, 0x7F7F7F7F); } while (0)
      vb0 = *(const LAS u32x4*)(vrow + 32 * 80); vb1 = *(const LAS u32x4*)(vrow + 32 * 80 + 16); ATT_PV(0, va0, va1); SBAR();
      va0 = *(const LAS u32x4*)(vrow + 64 * 80); va1 = *(const LAS u32x4*)(vrow + 64 * 80 + 16); ATT_PV(1, vb0, vb1); SBAR();
      vb0 = *(const LAS u32x4*)(vrow + 96 * 80); vb1 = *(const LAS u32x4*)(vrow + 96 * 80 + 16); ATT_PV(2, va0, va1); SBAR();
      ATT_LDK(kf0, 0); ATT_LDQ(qf, 0);
      ATT_PV(3, vb0, vb1); SBAR();
#undef ATT_PV
      asm volatile("" : "+v"(o0[0]), "+v"(o0[1]), "+v"(o0[2]), "+v"(o0[3]), "+v"(o1[0]), "+v"(o1[1]), "+v"(o1[2]), "+v"(o1[3]));
      ATT_QK_ALL(-m0, -m1);
      asm volatile("" : "+v"(p0), "+v"(p1), "+v"(q0), "+v"(q1));
    }
    __builtin_amdgcn_s_setprio(0);
    if (grp) asm volatile("s_waitcnt vmcnt(0)" ::: "memory");
    ATT_BAR();
  }
  if (!grp) ATT_BAR();
  if (hi == 0) { li_l[r32] = 1.f / l0; al_l[r32] = lam / l1; }
  asm volatile("s_waitcnt lgkmcnt(0)" ::: "memory");
  float ss[16];
#pragma unroll
  for (int r = 0; r < 16; ++r) {
    const float a = li_l[crow(r, hi)], bq = al_l[crow(r, hi)];
    float s = 0.f;
#pragma unroll
    for (int d = 0; d < 4; ++d) { const float v = o0[d][r] * a - o1[d][r] * bq; o0[d][r] = v; s += v * v; }
    s += dpp_mov<0xB1>(s); s += dpp_mov<0x4E>(s); s += dpp_mov<0x141>(s); s += dpp_mov<0x140>(s);
    { auto rr_ = __builtin_amdgcn_permlane16_swap(__float_as_uint(s), __float_as_uint(s), false, false); s = __uint_as_float(rr_[0]) + __uint_as_float(rr_[1]); }
    ss[r] = rsqrtf(s * (1.f / 128.f) + EPS) * oscale;
  }
  bf16_t* Ow = Ob + (size_t)(wid * 32) * DM;
  unsigned char* ost = lds + 2 * ATT_SHM_V + 2 * ATT_SHM_K + 2048 + wid * (32 * 272);
#pragma unroll
  for (int d = 0; d < 4; ++d) {
    const float g = ng[d * 32 + r32];
#pragma unroll
    for (int r = 0; r < 16; ++r) *(bf16_t*)(ost + crow(r, hi) * 272 + (d * 32 + r32) * 2) = (ABL & 4) ? (bf16_t)0 : (bf16_t)(cvtpk(o0[d][r] * ss[r] * g, 0.f) & 0xffffu);
  }
  asm volatile("s_waitcnt lgkmcnt(0)" ::: "memory");
#pragma unroll
  for (int i = 0; i < 8; ++i) {
    const int c = lane + 64 * i, row = c >> 4, cb = (c & 15) * 16;
    *(u32x4*)((unsigned char*)(Ow + (size_t)row * DM) + cb) = *(const u32x4*)(ost + row * 272 + cb);
  }
  __syncthreads();
#undef ATT_INIT2
#undef ATT_LDK
#undef ATT_LDQ
#undef ATT_SC
#undef ATT_QK_ALL
#undef GSTAGE_K
#undef GSTAGE_V
#undef STAGE_PAIR
#undef RESC
#undef ATT_BAR
}

__device__ __forceinline__ float ins16(float (&a)[16], float x) {
#pragma unroll
  for (int i = 0; i < 16; ++i) { const float h = fmaxf(a[i], x); x = fminf(a[i], x); a[i] = h; }
  return x;
}
__device__ __forceinline__ void bsort16(float (&a)[16]) {
#pragma unroll
  for (int k = 2; k <= 16; k <<= 1)
#pragma unroll
    for (int j = k >> 1; j > 0; j >>= 1)
#pragma unroll
      for (int i = 0; i < 16; ++i) {
        const int q = i ^ j;
        if (q > i) {
          const bool desc = ((i & k) == 0);
          const float hi_ = fmaxf(a[i], a[q]), lo_ = fminf(a[i], a[q]);
          a[i] = desc ? hi_ : lo_; a[q] = desc ? lo_ : hi_;
        }
      }
}
__device__ __forceinline__ void bmerge16(float (&a)[16], const float (&b)[16]) {
#pragma unroll
  for (int i = 0; i < 16; ++i) a[i] = fmaxf(a[i], b[15 - i]);
#pragma unroll
  for (int j = 8; j > 0; j >>= 1)
#pragma unroll
    for (int i = 0; i < 16; ++i) {
      const int q = i ^ j;
      if (q > i) { const float hi_ = fmaxf(a[i], a[q]), lo_ = fminf(a[i], a[q]); a[i] = hi_; a[q] = lo_; }
    }
}
__device__ __forceinline__ float gelu_erf(float x) { return 0.5f * x * (1.f + erff(x * 0.70710678118654752440f)); }
#define XB_TMO      128
#define XB_XCNT(j)  (256  + 64 * (j))
#define XB_XSUB(j)  (1280 + 64 * (j))
#define XB_XGEN(j)  (2304 + 64 * (j))
#define XB_TOP      3328
#define XB_TOPGEN   3392
#define XCD_BAR_WORDS 3456
#define XB_SPIN_CAP (1u << 22)
__device__ __forceinline__ unsigned xb_ld(unsigned* p)              { return __hip_atomic_load(p, __ATOMIC_RELAXED, __HIP_MEMORY_SCOPE_AGENT); }
__device__ __forceinline__ unsigned xb_add(unsigned* p, unsigned v) { return __hip_atomic_fetch_add(p, v, __ATOMIC_RELAXED, __HIP_MEMORY_SCOPE_AGENT); }
__device__ __forceinline__ unsigned xb_xcc_id() { return (unsigned)__builtin_amdgcn_s_getreg((3 << 11) | 20) & 0xFu; }
#define XB_SPIN(cond, bar) do { unsigned _sp = 0; while (cond) { __builtin_amdgcn_s_sleep(1); \
    if ((++_sp & 255u) == 0u) { if (xb_ld(&(bar)[XB_TMO])) break; if (_sp > XB_SPIN_CAP) { atomicAdd(&(bar)[XB_TMO], 1u); break; } } } } while (0)
struct XcdBarrier { unsigned* bar; unsigned x; volatile LAS unsigned* st; };
__device__ __forceinline__ XcdBarrier xcd_barrier_post(unsigned* bar, volatile LAS unsigned* st) {
  XcdBarrier b; b.bar = bar; b.x = xb_xcc_id(); b.st = st;
  if (tidx() == 0) (void)xb_add(&bar[XB_XCNT(b.x)], 1u);
  return b;
}
__device__ __forceinline__ void xcd_barrier_complete(unsigned* bar, unsigned x, unsigned& nloc, unsigned& nx) {
  const unsigned G = gridDim.x * gridDim.y * gridDim.z;
  unsigned sum, cnt, mine, sp = 0u;
  for (;;) {
    sum = 0u; cnt = 0u; mine = 0u;
#pragma unroll
    for (unsigned j = 0; j < 16; ++j) { const unsigned c = xb_ld(&bar[XB_XCNT(j)]); sum += c; cnt += (c > 0u) ? 1u : 0u; mine = (j == x) ? c : mine; }
    if (sum == G) break;
    __builtin_amdgcn_s_sleep(1);
    if ((++sp & 255u) == 0u) { if (xb_ld(&bar[XB_TMO])) break; if (sp > XB_SPIN_CAP) { atomicAdd(&bar[XB_TMO], 1u); break; } }
  }
  nloc = mine > 0u ? mine : 1u; nx = cnt > 0u ? cnt : 1u;
}
__device__ __forceinline__ void xcd_barrier(const XcdBarrier& b) {
  asm volatile("s_waitcnt vmcnt(0)" ::: "memory");
  __syncthreads();
  if (tidx() == 0) {
    unsigned* bar = b.bar;
    __builtin_amdgcn_s_waitcnt(0);
    unsigned nloc = b.st[0], nx = b.st[1];
    if (nloc == 0u) { xcd_barrier_complete(bar, b.x, nloc, nx); b.st[0] = nloc; b.st[1] = nx; }
    const unsigned old = xb_add(&bar[XB_XSUB(b.x)], 1u);
    const unsigned gen = old / nloc;
    if (old + 1u == (gen + 1u) * nloc) {
      __builtin_amdgcn_fence(__ATOMIC_RELEASE, "agent");
      asm volatile("s_waitcnt vmcnt(0)" ::: "memory");
      const unsigned og = xb_add(&bar[XB_TOP], 1u);
      const unsigned tg = og / nx;
      if (og + 1u == (tg + 1u) * nx) xb_add(&bar[XB_TOPGEN], 1u);
      else XB_SPIN(xb_ld(&bar[XB_TOPGEN]) == tg, bar);
      __builtin_amdgcn_fence(__ATOMIC_ACQUIRE, "agent");
      xb_add(&bar[XB_XGEN(b.x)], 1u);
      asm volatile("s_waitcnt vmcnt(0)" ::: "memory");
    } else {
      XB_SPIN(xb_ld(&bar[XB_XGEN(b.x)]) == gen, bar);
      __builtin_amdgcn_fence(__ATOMIC_ACQUIRE, "agent");
      asm volatile("s_waitcnt vmcnt(0)" ::: "memory");
    }
  }
  __syncthreads();
}

constexpr size_t RT_STRIDE = (size_t)T * 128 * 4;
__device__ __forceinline__ void route_unit(const Params& p, int l, int unit, unsigned char* lds) {
  int tid_ = tidx(); asm volatile("" : "+v"(tid_)); const int tid = tid_, lane = tid & 63, wid = tid >> 6, r32 = lane & 31, hi = lane >> 5;
  unsigned char* IDX = lds;
  int* UE = (int*)(lds + 8192); float* UG = (float*)(lds + 8192 + 16384); float* US = (float*)(lds + 8192 + 32768);
  int* EIDG = (int*)(p.ws + WS_EID + (size_t)l * RT_STRIDE); float* GWG = (float*)(p.ws + WS_ULOC + RT_STRIDE); float* SUG = (float*)(p.ws + WS_ULOC + 2 * RT_STRIDE);
  const float* PSC = (const float*)(p.ws + WS_PSC);
  const int row0 = unit * 32;
  const bf16_t* QP = (const bf16_t*)(p.ws + WS_PROJ);
  const bf16_t* KEYS = (const bf16_t*)(p.ws + WS_KEYS) + (size_t)l * 131072;
  for (int rrep = 0; rrep < REP_ROUTE; ++rrep) {
    const int h = wid;
    float top[2][16];
    bf16x8 bq[4], bqn[4], akc[4], akn[4];
    {
      const bf16_t* qrow0 = QP + (size_t)(row0 + r32) * DM + h * 128 + hi * 8;
      const bf16_t* kb0 = KEYS + ((size_t)(h * 2) * 128 + r32) * 64 + hi * 8;
#pragma unroll
      for (int ks = 0; ks < 4; ++ks) { bq[ks] = *(const bf16x8*)(qrow0 + ks * 16); akc[ks] = *(const bf16x8*)(kb0 + ks * 16); }
    }
#pragma unroll
    for (int pp = 0; pp < 2; ++pp) {
      const bf16_t* kb = KEYS + ((size_t)(h * 2 + pp) * 128 + r32) * 64 + hi * 8;
      float (&lst)[16] = top[pp];
#pragma unroll
      for (int i = 0; i < 16; ++i) lst[i] = -INFINITY;
#pragma unroll
      for (int nt = 0; nt < 4; ++nt) {
        if (nt < 3) {
#pragma unroll
          for (int ks = 0; ks < 4; ++ks) akn[ks] = *(const bf16x8*)(kb + (size_t)(nt + 1) * 32 * 64 + ks * 16);
        } else if (pp == 0) {
          const bf16_t* qrow1 = QP + (size_t)(row0 + r32) * DM + h * 128 + 64 + hi * 8;
          const bf16_t* kb1 = KEYS + ((size_t)(h * 2 + 1) * 128 + r32) * 64 + hi * 8;
#pragma unroll
          for (int ks = 0; ks < 4; ++ks) { bqn[ks] = *(const bf16x8*)(qrow1 + ks * 16); akn[ks] = *(const bf16x8*)(kb1 + ks * 16); }
        }
        f32x16 acc = {};
#pragma unroll
        for (int ks = 0; ks < 4; ++ks) acc = __builtin_amdgcn_mfma_f32_32x32x16_bf16(akc[ks], bq[ks], acc, 0, 0, 0);
#pragma unroll
        for (int ks = 0; ks < 4; ++ks) { akc[ks] = akn[ks]; if (nt == 3) bq[ks] = bqn[ks]; }
        float grp[16];
#pragma unroll
        for (int r = 0; r < 16; ++r) grp[r] = __uint_as_float((__float_as_uint(acc[r]) & ~0x7Fu) | (unsigned)(nt * 32 + crow(r, hi)));
        bsort16(grp);
        if (nt == 0) {
#pragma unroll
          for (int i = 0; i < 16; ++i) lst[i] = grp[i];
        } else bmerge16(lst, grp);
        SBAR();
      }
      float oth[16];
#pragma unroll
      for (int i = 0; i < 16; ++i) { auto rr_ = __builtin_amdgcn_permlane32_swap(__float_as_uint(lst[i]), __float_as_uint(lst[i]), false, false); oth[i] = __uint_as_float(hi ? rr_[0] : rr_[1]); }
      bmerge16(lst, oth);
      if (hi == 0) {
        unsigned w[4];
#pragma unroll
        for (int i = 0; i < 4; ++i)
          w[i] = (__float_as_uint(lst[4 * i]) & 0x7Fu) | ((__float_as_uint(lst[4 * i + 1]) & 0x7Fu) << 8) | ((__float_as_uint(lst[4 * i + 2]) & 0x7Fu) << 16) | ((__float_as_uint(lst[4 * i + 3]) & 0x7Fu) << 24);
        *(u32x4*)(IDX + ((r32 * 8 + h) * 2 + pp) * 16) = (u32x4){w[0], w[1], w[2], w[3]};
      }
    }
    float best[16];
#define CAND(i, j) __uint_as_float((__float_as_uint(__uint_as_float(__float_as_uint(top[0][i]) & ~0x7Fu) + __uint_as_float(__float_as_uint(top[1][j]) & ~0x7Fu)) & ~0xFFu) | (unsigned)((i) * 16 + (j)))
    {
#pragma unroll
      for (int j = 0; j < 16; ++j) best[j] = CAND(0, j);
      float y[16];
#pragma unroll
      for (int j = 0; j < 8; ++j) { y[j] = CAND(1, j); y[8 + j] = CAND(15 - j, 0); }
#pragma unroll
      for (int jj = 8; jj > 0; jj >>= 1)
#pragma unroll
        for (int i = 0; i < 16; ++i) { const int q = i ^ jj; if (q > i) { const float hi_ = fmaxf(y[i], y[q]), lo_ = fminf(y[i], y[q]); y[i] = hi_; y[q] = lo_; } }
      bmerge16(best, y);
      float x[16];
      x[0] = CAND(2, 0); x[1] = CAND(2, 1); x[2] = CAND(2, 2); x[3] = CAND(2, 3); x[4] = CAND(2, 4);
      x[5] = CAND(3, 0); x[6] = CAND(3, 1); x[7] = CAND(3, 2); x[8] = CAND(3, 3);
      x[9] = CAND(4, 0); x[10] = CAND(4, 1); x[11] = CAND(4, 2);
      x[12] = CAND(5, 0); x[13] = CAND(5, 1); x[14] = CAND(6, 0); x[15] = CAND(6, 1);
      bsort16(x);
      bmerge16(best, x);
      ins16(best, CAND(7, 0)); ins16(best, CAND(7, 1));
    }
#undef CAND
    asm volatile("s_waitcnt lgkmcnt(0)" ::: "memory");
    if (hi == 0) {
      const unsigned char* ib = IDX + ((r32 * 8 + h) * 2) * 16;
      const float mx = __uint_as_float(__float_as_uint(best[0]) & ~0xFFu);
      float w[16]; float sum = 0.f;
#pragma unroll
      for (int k = 0; k < 16; ++k) { w[k] = __expf(__uint_as_float(__float_as_uint(best[k]) & ~0xFFu) - mx); sum += w[k]; }
      const float rsum = 1.f / sum;
      int ee[16]; float su_[16], sv_[16];
#pragma unroll
      for (int k = 0; k < 16; ++k) {
        const unsigned ij = __float_as_uint(best[k]) & 0xFFu;
        ee[k] = (int)ib[ij >> 4] * 128 + (int)ib[16 + (ij & 15)];
      }
#pragma unroll
      for (int k = 0; k < 16; ++k) { su_[k] = PSC[(size_t)l * NEXP + ee[k]]; sv_[k] = PSC[(size_t)(DEPTH + l) * NEXP + ee[k]]; }
#pragma unroll
      for (int k = 0; k < 16; ++k) {
        UE[r32 * 128 + h * 16 + k] = ee[k]; UG[r32 * 128 + h * 16 + k] = w[k] * rsum * sv_[k];
        US[r32 * 128 + h * 16 + k] = su_[k];
      }
    }
  }
  __syncthreads();
#pragma unroll 1
  for (int tt = 0; tt < 4; ++tt) {
    const int t = wid * 4 + tt;
    const int k0 = UE[t * 128 + lane], k1 = UE[t * 128 + 64 + lane];
    const float g0 = UG[t * 128 + lane], g1 = UG[t * 128 + 64 + lane], s0 = US[t * 128 + lane], s1 = US[t * 128 + 64 + lane];
    const int b0 = k0 >> 11, b1 = k1 >> 11;
    int base = 0, pos0 = 0, pos1 = 0;
#pragma unroll
    for (int b = 0; b < 8; ++b) {
      const unsigned long long m0 = __ballot(b0 == b), m1 = __ballot(b1 == b);
      const int c0 = __popcll(m0), c1 = __popcll(m1);
      const unsigned long long lt = (1ull << lane) - 1ull;
      if (b0 == b) pos0 = base + __popcll(m0 & lt);
      if (b1 == b) pos1 = base + c0 + __popcll(m1 & lt);
      base += c0 + c1;
    }
    const size_t ro = (size_t)(row0 + t) * 128;
    EIDG[ro + pos0] = k0; GWG[ro + pos0] = g0; SUG[ro + pos0] = s0;
    EIDG[ro + pos1] = k1; GWG[ro + pos1] = g1; SUG[ro + pos1] = s1;
  }
}
#define CAS __attribute__((address_space(4)))
typedef int i32x8 __attribute__((ext_vector_type(8)));
struct TokPref { f32x2 gs0, gs1; u32x4 hA, hB; };
struct RowPipe { i32x6 uq[4], vq[4]; i32x8 Ec; };
struct EpiVec { f32x4 g2[4], ng[4], sc[4], sh[4]; int mr; };
__device__ __forceinline__ const CAS i32x8* eid_row(const CAS unsigned char* eidg, int row) {
  return (const CAS i32x8*)(eidg + (size_t)(unsigned)__builtin_amdgcn_readfirstlane(row) * 512u);
}
__device__ __forceinline__ void tok_prefetch(const Params& p, int row, int lane, TokPref& t) {
  const float* GWG = (const float*)(p.ws + WS_ULOC + RT_STRIDE) + (size_t)row * 128;
  const float* SUG = (const float*)(p.ws + WS_ULOC + 2 * RT_STRIDE) + (size_t)row * 128;
  const bf16_t* H = (const bf16_t*)(p.ws + WS_H);
  t.gs0 = f32x2{GWG[lane], SUG[lane]}; t.gs1 = f32x2{GWG[64 + lane], SUG[64 + lane]};
  { const bf16_t* hr_ = H + (size_t)row * DM + lane * 4;
    const u32x2 a0 = *(const u32x2*)hr_, a1 = *(const u32x2*)(hr_ + 256), a2 = *(const u32x2*)(hr_ + 512), a3 = *(const u32x2*)(hr_ + 768);
    t.hA = (u32x4){a0.x, a0.y, a1.x, a1.y}; t.hB = (u32x4){a2.x, a2.y, a3.x, a3.y}; }
}
#define LOADPAIR(dst_, tofs_, ea_, eb_) do { const u32x3v a_ = __builtin_amdgcn_raw_buffer_load_b96(rsT, lane12, (ea_) * PROW + (tofs_), 0); const unsigned b0_ = __builtin_amdgcn_raw_buffer_load_b32(rsT, lane12, (eb_) * PROW + (tofs_), 0); \
      const u32x2v b1_ = __builtin_amdgcn_raw_buffer_load_b64(rsT, lane12 + 4, (eb_) * PROW + (tofs_), 0); \
      dst_[0] = (int)a_.x; dst_[1] = (int)a_.y; dst_[2] = (int)a_.z; dst_[3] = (int)b0_; dst_[4] = (int)b1_.x; dst_[5] = (int)b1_.y; } while (0)
#define LOADGROUP(q_, tofs_, E_) do { LOADPAIR(q_[0], tofs_, E_[0], E_[1]); LOADPAIR(q_[1], tofs_, E_[2], E_[3]); LOADPAIR(q_[2], tofs_, E_[4], E_[5]); LOADPAIR(q_[3], tofs_, E_[6], E_[7]); } while (0)
constexpr int VOFS = (int)(WS_PV - WS_PU);
__device__ __forceinline__ void gather_token(const Params& p, const CAS unsigned char* eidg, const __amdgpu_buffer_rsrc_t rsT, int l, int row, int nextrow, TokPref& tp, RowPipe& rp, EpiVec& ev, unsigned char* lds, int lane, int wid) {
  f32x2* GS = (f32x2*)(lds + wid * 2048);
  float* XC = (float*)(p.ws + WS_XCUR);
  const float* MOD = (const float*)(p.ws + WS_MOD);
  const CAS i32x8* EP = eid_row(eidg, row);
  const bool hasnext = nextrow >= 0;
  const CAS i32x8* EPn = eid_row(eidg, hasnext ? nextrow : row);
  GS[lane] = tp.gs0; GS[64 + lane] = tp.gs1;
  asm volatile("s_waitcnt lgkmcnt(0)" ::: "memory");
  const int eofl = ((lane >> 5) & 1) + 2 * ((lane >> 4) & 1) + 4 * ((lane >> 3) & 1);
  const int lane12 = lane * 12;
  {
    h16x2 hh[8];
    {
      const u32x4 hA = tp.hA, hB = tp.hB;
      hh[0] = __builtin_bit_cast(h16x2, __builtin_amdgcn_cvt_pkrtz(bflo(hA.x), bfhi(hA.x))); hh[1] = __builtin_bit_cast(h16x2, __builtin_amdgcn_cvt_pkrtz(bflo(hA.y), bfhi(hA.y))); hh[2] = __builtin_bit_cast(h16x2, __builtin_amdgcn_cvt_pkrtz(bflo(hA.z), bfhi(hA.z))); hh[3] = __builtin_bit_cast(h16x2, __builtin_amdgcn_cvt_pkrtz(bflo(hA.w), bfhi(hA.w)));
      hh[4] = __builtin_bit_cast(h16x2, __builtin_amdgcn_cvt_pkrtz(bflo(hB.x), bfhi(hB.x))); hh[5] = __builtin_bit_cast(h16x2, __builtin_amdgcn_cvt_pkrtz(bflo(hB.y), bfhi(hB.y))); hh[6] = __builtin_bit_cast(h16x2, __builtin_amdgcn_cvt_pkrtz(bflo(hB.z), bfhi(hB.z))); hh[7] = __builtin_bit_cast(h16x2, __builtin_amdgcn_cvt_pkrtz(bflo(hB.w), bfhi(hB.w)));
    }
    if (hasnext) tok_prefetch(p, nextrow, lane, tp);
    { const int mr_ = mod_row(row);
      if (mr_ != ev.mr) {
        const float* g2_ = MOD + ((size_t)l * 5 + mr_) * 6144 + 5 * 1024 + lane * 4;
        const float* ng_ = (l == DEPTH - 1 ? p.in[I_FINALG] : p.in[I_N1G] + (l + 1) * DM) + lane * 4;
        const float* m_ = MOD + ((size_t)(l == DEPTH - 1 ? l : l + 1) * 5 + mr_) * 6144 + lane * 4;
#pragma unroll
        for (int v4 = 0; v4 < 4; ++v4) { ev.g2[v4] = *(const f32x4*)(g2_ + v4 * 256); ev.ng[v4] = *(const f32x4*)(ng_ + v4 * 256); ev.sc[v4] = *(const f32x4*)(m_ + 1024 + v4 * 256); ev.sh[v4] = *(const f32x4*)(m_ + v4 * 256); }
        ev.mr = mr_;
      } }
    f32x4 xpre[4];
    { const float* xr_ = XC + (size_t)row * DM + lane * 4;
#pragma unroll
      for (int v4 = 0; v4 < 4; ++v4) xpre[v4] = *(const f32x4*)(xr_ + v4 * 256); }
    f32x2 acc2[8];
#pragma unroll
    for (int i = 0; i < 8; ++i) acc2[i] = f32x2{0.f, 0.f};
#pragma unroll 1
    for (int g8 = 0; g8 < 16; ++g8) {
      const bool pf = (g8 < 15) || hasnext;
      const f32x2 gs = GS[g8 * 8 + eofl];
      float d[8];
#pragma unroll
      for (int i2 = 0; i2 < 4; ++i2) {
        const h16x32 r = __builtin_amdgcn_cvt_scalef32_pk32_f16_fp6(rp.uq[i2], 1.0f);
        float a0 = 0.f, a1 = 0.f, b0 = 0.f, b1 = 0.f;
#define UDOT(k_) a0 = __builtin_amdgcn_fdot2(__builtin_shufflevector(r, r, 4 * (k_), 4 * (k_) + 1), hh[2 * (k_)], a0, false); b0 = __builtin_amdgcn_fdot2(__builtin_shufflevector(r, r, 16 + 4 * (k_), 17 + 4 * (k_)), hh[2 * (k_)], b0, false); \
        a1 = __builtin_amdgcn_fdot2(__builtin_shufflevector(r, r, 4 * (k_) + 2, 4 * (k_) + 3), hh[2 * (k_) + 1], a1, false); b1 = __builtin_amdgcn_fdot2(__builtin_shufflevector(r, r, 18 + 4 * (k_), 19 + 4 * (k_)), hh[2 * (k_) + 1], b1, false);
        UDOT(0) UDOT(1) UDOT(2) UDOT(3)
#undef UDOT
        d[2 * i2] = a0 + a1;
        d[2 * i2 + 1] = b0 + b1;
        asm volatile("" : "+v"(d[2 * i2]), "+v"(d[2 * i2 + 1]));
      }
      if (pf) LOADGROUP(rp.uq, 0, rp.Ec);
      float tot;
      {
        auto s01 = __builtin_amdgcn_permlane32_swap(__float_as_uint(d[0]), __float_as_uint(d[1]), false, false);
        auto s23 = __builtin_amdgcn_permlane32_swap(__float_as_uint(d[2]), __float_as_uint(d[3]), false, false);
        auto s45 = __builtin_amdgcn_permlane32_swap(__float_as_uint(d[4]), __float_as_uint(d[5]), false, false);
        auto s67 = __builtin_amdgcn_permlane32_swap(__float_as_uint(d[6]), __float_as_uint(d[7]), false, false);
        const float q01 = __uint_as_float(s01[0]) + __uint_as_float(s01[1]), q23 = __uint_as_float(s23[0]) + __uint_as_float(s23[1]);
        const float q45 = __uint_as_float(s45[0]) + __uint_as_float(s45[1]), q67 = __uint_as_float(s67[0]) + __uint_as_float(s67[1]);
        auto ta = __builtin_amdgcn_permlane16_swap(__float_as_uint(q01), __float_as_uint(q23), false, false);
        auto tb = __builtin_amdgcn_permlane16_swap(__float_as_uint(q45), __float_as_uint(q67), false, false);
        const float r0123 = __uint_as_float(ta[0]) + __uint_as_float(ta[1]);
        const float r4567 = __uint_as_float(tb[0]) + __uint_as_float(tb[1]);
        const bool b3 = (lane & 8) != 0;
        const float keep = b3 ? r4567 : r0123, send = b3 ? r0123 : r4567;
        float x = keep + dpp_mov<0x140>(send);
        x += dpp_mov<0xB1>(x); x += dpp_mov<0x4E>(x); x += dpp_mov<0x141>(x);
        tot = x * gs.y;
      }
      float ge;
      {
        const float v = tot, av = fabsf(v), tq = __builtin_amdgcn_rcpf(av * 0.2316418882f + 1.0f);
        float q = tq * 0.5307027145f + (-0.7265760135f); q = q * tq + 0.7107068705f; q = q * tq + (-0.142248368f); q = q * tq + 0.127414796f; q = q * tq;
        const float ex = __builtin_amdgcn_exp2f(v * v * (-0.72134752044f));
        const float m = v * (q * ex), r = v - m;
        ge = (v < 0.f ? m : r) * gs.x;
      }
      unsigned cw[8];
      { const unsigned gp = __builtin_bit_cast(unsigned, __builtin_amdgcn_cvt_pkrtz(ge * 1024.f, ge * 1024.f));
        cw[0] = (unsigned)__builtin_amdgcn_readlane((int)gp, 0);  cw[4] = (unsigned)__builtin_amdgcn_readlane((int)gp, 8);
        cw[2] = (unsigned)__builtin_amdgcn_readlane((int)gp, 16); cw[6] = (unsigned)__builtin_amdgcn_readlane((int)gp, 24);
        cw[1] = (unsigned)__builtin_amdgcn_readlane((int)gp, 32); cw[5] = (unsigned)__builtin_amdgcn_readlane((int)gp, 40);
        cw[3] = (unsigned)__builtin_amdgcn_readlane((int)gp, 48); cw[7] = (unsigned)__builtin_amdgcn_readlane((int)gp, 56); }
      h16x2 a16[8];
#pragma unroll
      for (int i2 = 0; i2 < 4; ++i2) {
        const h16x32 r = __builtin_amdgcn_cvt_scalef32_pk32_f16_fp6(rp.vq[i2], 1.0f);
        const h16x2 ca = __builtin_bit_cast(h16x2, cw[2 * i2]), cb = __builtin_bit_cast(h16x2, cw[2 * i2 + 1]);
#define VAXL(k_) a16[k_] = (i2 == 0) ? ca * __builtin_shufflevector(r, r, 2 * (k_), 2 * (k_) + 1) : ca * __builtin_shufflevector(r, r, 2 * (k_), 2 * (k_) + 1) + a16[k_];
#define VAXH(k_) a16[k_] = cb * __builtin_shufflevector(r, r, 16 + 2 * (k_), 17 + 2 * (k_)) + a16[k_];
        VAXL(0) VAXL(1) VAXL(2) VAXL(3) VAXL(4) VAXL(5) VAXL(6) VAXL(7)
        asm volatile("" : "+v"(a16[0]), "+v"(a16[1]), "+v"(a16[2]), "+v"(a16[3]), "+v"(a16[4]), "+v"(a16[5]), "+v"(a16[6]), "+v"(a16[7]));
        VAXH(0) VAXH(1) VAXH(2) VAXH(3) VAXH(4) VAXH(5) VAXH(6) VAXH(7)
#undef VAXL
#undef VAXH
        asm volatile("" : "+v"(a16[0]), "+v"(a16[1]), "+v"(a16[2]), "+v"(a16[3]), "+v"(a16[4]), "+v"(a16[5]), "+v"(a16[6]), "+v"(a16[7]));
      }
#pragma unroll
      for (int k = 0; k < 8; ++k) acc2[k] = f32x2{(float)a16[k].x, (float)a16[k].y} * f32x2{1.f / 1024.f, 1.f / 1024.f} + acc2[k];
      if (pf) LOADGROUP(rp.vq, VOFS, rp.Ec);
      { const CAS i32x8* src_ = g8 < 14 ? EP + (g8 + 2) : EPn + (g8 - 14); rp.Ec = *src_; }
    }
    SBAR();
    float acc[16];
#pragma unroll
    for (int i = 0; i < 8; ++i) { acc[2 * i] = acc2[i].x; acc[2 * i + 1] = acc2[i].y; }
    float* xr = XC + (size_t)row * DM;
    float xn[16]; float ssq = 0.f;
    if (ABL & 8) {
#pragma unroll
      for (int i = 0; i < 16; ++i) acc[i] = 0.f;
    }
#pragma unroll
    for (int v4 = 0; v4 < 4; ++v4) {
      const int c = lane * 4 + v4 * 256;
      const f32x4 xo = xpre[v4], gg = ev.g2[v4];
      f32x4 o;
      o.x = xo.x + gg.x * acc[v4 * 4 + 0]; o.y = xo.y + gg.y * acc[v4 * 4 + 1]; o.z = xo.z + gg.z * acc[v4 * 4 + 2]; o.w = xo.w + gg.w * acc[v4 * 4 + 3];
      xn[v4 * 4 + 0] = o.x; xn[v4 * 4 + 1] = o.y; xn[v4 * 4 + 2] = o.z; xn[v4 * 4 + 3] = o.w;
      ssq += (o.x * o.x + o.y * o.y) + (o.z * o.z + o.w * o.w);
      if (l < DEPTH - 1) *(f32x4*)(xr + c) = o;
    }
    const float rs = rsqrtf(wave_sum_fast(ssq) * (1.f / DM) + EPS);
    if (l == DEPTH - 1) {
      const int b = row / SEGL, s = row - b * SEGL;
      float* orow = p.out + ((size_t)(b * SEQ + (s - CTXL))) * DM;
#pragma unroll
      for (int v4 = 0; v4 < 4; ++v4) {
        const int c = lane * 4 + v4 * 256;
        const f32x4 gg = ev.ng[v4];
        f32x4 o; o.x = xn[v4 * 4 + 0] * rs * gg.x; o.y = xn[v4 * 4 + 1] * rs * gg.y; o.z = xn[v4 * 4 + 2] * rs * gg.z; o.w = xn[v4 * 4 + 3] * rs * gg.w;
        *(f32x4*)(orow + c) = o;
      }
    } else {
      bf16_t* hrow = (bf16_t*)(p.ws + WS_H) + (size_t)row * DM;
#pragma unroll
      for (int v4 = 0; v4 < 4; ++v4) {
        float y[4];
#pragma unroll
        for (int i = 0; i < 4; ++i) y[i] = xn[v4 * 4 + i] * rs * ev.ng[v4][i] * (1.f + ev.sc[v4][i]) + ev.sh[v4][i];
        *(u32x2*)(hrow + lane * 4 + v4 * 256) = (u32x2){cvtpk(y[0], y[1]), cvtpk(y[2], y[3])};
        int w8 = 0; w8 = __builtin_amdgcn_cvt_pk_fp8_f32(y[0], y[1], w8, false); w8 = __builtin_amdgcn_cvt_pk_fp8_f32(y[2], y[3], w8, true);
        *(int*)(p.ws + WS_H8 + (size_t)row * DM + lane * 4 + v4 * 256) = w8;
      }
    }
  }
}

__device__ __forceinline__ void ev_signal(unsigned* ctr) {
  asm volatile("s_waitcnt vmcnt(0)" ::: "memory");
  __syncthreads();
  if (tidx() == 0) { __builtin_amdgcn_fence(__ATOMIC_RELEASE, "agent"); asm volatile("s_waitcnt vmcnt(0)" ::: "memory"); (void)xb_add(ctr, 1u); }
}
__device__ __forceinline__ void ev_wait(unsigned* ctr, unsigned n, unsigned* bar) {
  if (tidx() == 0) {
    XB_SPIN(xb_ld(ctr) < n, bar);
    __builtin_amdgcn_fence(__ATOMIC_ACQUIRE, "agent");
    asm volatile("s_waitcnt vmcnt(0)" ::: "memory");
  }
  __syncthreads();
}
constexpr int EV_WORD0 = 8192;
__device__ __forceinline__ void phase_c1(const Params& p, int l, unsigned char* lds) {
  constexpr int NLOC = NBATCH * 4 * NCH, NCONV = T / 32;
  for (int u = p.bx; u < NLOC + NCONV; u += p.gx) {
    if (u < NLOC) ml_local_unit2(p, l, u, lds);
    else {
      const int cu = u - NLOC;
      if (l == DEPTH - 1 && (cu % (SEGL / 32)) < (CTXL / 32)) continue;
      conv_unit(p, l, cu, lds);
    }
  }
}
__device__ __forceinline__ void phase_c3(const Params& p, int l, unsigned char* lds);
__device__ __forceinline__ void phase_c2(const Params& p, int l, unsigned char* lds) {
  unsigned* ev = (unsigned*)(p.ws + WS_CTL) + EV_WORD0 + 64 * l;
  ml_scan(p, lds);
  ev_signal(ev);
  const float* lp = p.in[I_DLAM] + l * 256;
  float s01 = 0.f, s23 = 0.f;
  for (int i = 0; i < 64; ++i) { s01 += lp[i] * lp[64 + i]; s23 += lp[128 + i] * lp[192 + i]; }
  const float lam_init = 0.8f - 0.6f * expf(-0.3f * (float)l);
  const float lam = __uint_as_float((unsigned)__builtin_amdgcn_readfirstlane((int)__float_as_uint(expf(s01) - expf(s23) + lam_init)));
  const bf16_t* PROJ = (const bf16_t*)(p.ws + WS_PROJ);
  bf16_t* MIX = (bf16_t*)(p.ws + WS_MIX);
  const float* ng = p.in[I_DNORMG] + l * 128;
  const int nun = 512 + (l < DEPTH - 1 ? 16 : 0);
  for (int u = p.bx; u < nun; u += p.gx) {
    int bh, qrow, nkeys;
    if (u < 512) { const int xcd = u & 7, i = (u >> 3) & 31, rnd = u >> 8; bh = 2 * xcd + rnd; qrow = CTXL + i * 256; nkeys = SEGL; }
    else { bh = u - 512; qrow = 0; nkeys = CTXL; }
    const int b = bh >> 2, h = bh & 3;
    const size_t tok0 = (size_t)b * SEGL;
    for (int rep = 0; rep < REP_ATT; ++rep)
    att_unit(p.ws + WS_QK8 + ((size_t)bh * SEGL + qrow) * QK8_PITCH, p.ws + WS_QK8 + QK8_IMG + (size_t)bh * SEGL * QK8_PITCH, p.ws + WS_V8T + (size_t)bh * NCH * ATT_SHM_V,
             MIX + (tok0 + qrow) * DM + 512 + h * 128, nkeys, lam, ng, 1.f - lam_init, lds);
  }
  ev_wait(ev, (unsigned)p.gx, p.xbar_words);
  for (int rep = 0; rep < REP_ML; ++rep) phase_c3(p, l, lds);
}
__device__ __forceinline__ void phase_c3(const Params& p, int l, unsigned char* lds) {
  constexpr int NU = NBATCH * 4 * NCH;
  const int nlow = (p.gx > 64 && l < DEPTH - 1) ? 16 : 0, ulow = nlow * 7;
  int u, step;
  if (p.bx < nlow) { u = p.bx; step = nlow; } else { u = ulow + (p.bx - nlow); step = p.gx - nlow; }
  const int uend = p.bx < nlow ? ulow : NU;
  int tid_ = tidx(); asm volatile("" : "+v"(tid_));
  auto valid_from = [&](int v) { while (v < uend && l == DEPTH - 1 && (v % NCH) < 4) v += step; return v < uend ? v : -1; };
  MlOutPf fa, fb;
  u = valid_from(u);
  if (u >= 0) ml_out_fetch(p, u, tid_, fa);
  while (u >= 0) {
    const int nx = valid_from(u + step);
    ml_out_unit2(p, l, u, lds, fa, nx, fb);
    fa = fb; u = nx;
  }
}
__device__ __forceinline__ void phase_route(const Params& p, int l, unsigned char* lds) {
  constexpr int NU = T / 32;
  for (int u = p.bx; u < NU; u += p.gx) {
    if (l == DEPTH - 1 && (u % (SEGL / 32)) < (CTXL / 32)) continue;
    route_unit(p, l, u, lds);
    __syncthreads();
  }
}
__device__ __forceinline__ void phase_gather(const Params& p, int l, unsigned char* lds) {
  int tid_ = tidx(); asm volatile("" : "+v"(tid_)); const int lane = tid_ & 63, wid = __builtin_amdgcn_readfirstlane(tid_ >> 6);
  const int gw = p.bx * 8 + wid, NGW = p.gx * 8;
  const int ntok = (l == DEPTH - 1) ? NBATCH * SEQ : T;
#define TOKROW(ti_) ((l == DEPTH - 1) ? ((ti_) / SEQ) * SEGL + CTXL + ((ti_) % SEQ) : (ti_))
  const CAS unsigned char* eidg = (const CAS unsigned char*)(p.ws + WS_EID + (size_t)l * RT_STRIDE);
  const __amdgpu_buffer_rsrc_t rsT = __builtin_amdgcn_make_buffer_rsrc((void*)(p.ws + WS_PU + (size_t)l * NEXP * PROW), 0, VOFS + NEXP * PROW, 0x00020000);
  const int nfull = ntok / NGW, rem = ntok - nfull * NGW, per = (rem % p.gx == 0) ? rem / p.gx : -1;
  auto tok_at = [&](int r) -> int {
    if (r < nfull) return gw + r * NGW;
    if (r > nfull || rem == 0) return -1;
    if (per >= 0) return wid < per ? nfull * NGW + p.bx * per + wid : -1;
    return gw + r * NGW < ntok ? gw + r * NGW : -1;
  };
  TokPref tp; RowPipe rp; EpiVec ev; ev.mr = -1;
  const int ti0 = tok_at(0);
  if (ti0 >= 0) {
    const int row0 = TOKROW(ti0); const int lane12 = lane * 12;
    tok_prefetch(p, row0, lane, tp);
    const CAS i32x8* EP0 = eid_row(eidg, row0);
    rp.Ec = EP0[0];
    LOADGROUP(rp.uq, 0, rp.Ec); LOADGROUP(rp.vq, VOFS, rp.Ec);
    rp.Ec = EP0[1];
  }
  XcdBarrier xb; xb.bar = p.xbar_words; xb.x = p.xbar_x; xb.st = (volatile LAS unsigned*)((LAS unsigned char*)lds + p.lds_st_off);
  const int nrounds = (ntok + NGW - 1) / NGW;
  for (int r = 0; r < nrounds; ++r) {
    const int ti = tok_at(r);
    if (ti >= 0) {
      const int row = TOKROW(ti);
      const int tn = tok_at(r + 1);
      const int nxt = tn >= 0 ? TOKROW(tn) : -1;
      gather_token(p, eidg, rsT, l, row, nxt, tp, rp, ev, lds, lane, wid);
    }
#if GATHER_SYNC
    if (r + 1 < nrounds) { XcdBarrier xb2 = xb; size_t zb_ = 0; asm volatile("" : "+s"(zb_)); xb2.bar = xb.bar + zb_; xb2.x = xb.x + (unsigned)zb_; xcd_barrier(xb2); }
#endif
  }
#undef TOKROW
}

__global__ void __launch_bounds__(512, 2) mk_fwd(KArgs ka) {
  cg::grid_group grid = cg::this_grid();
  extern __shared__ __attribute__((aligned(16))) unsigned char lds[];
  const int lo = ka.ph_lo, hi = ka.ph_hi;
#define IN(k) (lo <= (k) && (k) < hi)
#ifndef PHASEMASK
#define PHASEMASK 0xFFFF
#endif
#define PH(i) ((PHASEMASK >> (i)) & 1)
#define MKP(q) Params q; { size_t z_ = 0; asm volatile("" : "+s"(z_)); \
    q.in = (InTab)((const __attribute__((address_space(4))) char*)__builtin_amdgcn_kernarg_segment_ptr() + z_); \
    q.out = ka.out + z_; q.ws = ka.ws + z_; q.ph_lo = lo; q.ph_hi = hi; q.bx = (int)blockIdx.x + (int)z_; q.gx = (int)gridDim.x + (int)z_; q.xbar_words = xbar.bar + z_; q.xbar_x = xbar.x + (unsigned)z_; q.lds_st_off = (unsigned)(LDS_BYTES - 64); }
#define SEAM(k) do { if (IN(k) && IN((k) + 1)) { if ((k) == 0) grid.sync(); else { XcdBarrier xb_ = xbar; size_t zb_ = 0; asm volatile("" : "+s"(zb_)); xb_.bar = xbar.bar + zb_; xb_.x = xbar.x + (unsigned)zb_; xcd_barrier(xb_); } } } while (0)
  volatile LAS unsigned* xst = (volatile LAS unsigned*)((LAS unsigned char*)lds + (LDS_BYTES - 64));
  { const int t0_ = threadIdx.x;
    if (t0_ < 2) xst[t0_] = 0u;
    if ((t0_ & 63) == 0) *(volatile LAS int*)((LAS unsigned char*)lds + LDS_WTAB + 4 * hw_wave_key()) = t0_ >> 6; }
  __syncthreads();
  XcdBarrier xbar = xcd_barrier_post((unsigned*)(ka.ws + WS_CTL) + 4096, xst);
  { MKP(p)
    if (PH(0) && IN(0)) for (int rep = 0; rep < REP_MISC; ++rep) { p0_mod(p, lds, (float*)(p.ws + WS_MOD)); p0_convert(p, lds); }
  }
  SEAM(0);
  { MKP(p)
    if (PH(1) && IN(1)) phase_norm(p, 0, 0, true, false);
  }
  SEAM(1);
#define LAYER(LL) { \
    int l = (LL); asm volatile("" : "+s"(l)); \
    const int b = 2 + 9 * (LL); \
    { MKP(q) if (PH(2) && IN(b + 0)) for (int rep = 0; rep < REP_GEMM; ++rep) phase_inproj2(q, l, lds); } \
    SEAM(b + 0); \
    { MKP(q) if (PH(3) && IN(b + 1)) for (int rep = 0; rep < REP_ML; ++rep) phase_c1(q, l, lds); } \
    SEAM(b + 1); \
    { MKP(q) if (PH(4) && IN(b + 2)) phase_c2(q, l, lds); } \
    SEAM(b + 3); \
    { MKP(q) if (PH(6) && IN(b + 4)) phase_outproj2(q, l, lds); } \
    SEAM(b + 4); \
    { MKP(q) if (PH(7) && IN(b + 5)) for (int rep = 0; rep < REP_MISC; ++rep) phase_norm(q, l, 1, false, (LL) == DEPTH - 1); } \
    SEAM(b + 5); \
    { MKP(q) if (PH(8) && IN(b + 6)) for (int rep = 0; rep < REP_GEMM; ++rep) phase_peerq2(q, l, lds); } \
    SEAM(b + 6); \
    { MKP(q) if (PH(9) && IN(b + 7)) phase_route(q, l, lds); } \
    SEAM(b + 7); \
    { MKP(q) if (PH(9) && IN(b + 8)) phase_gather(q, l, lds); } \
    SEAM(b + 8); }
  LAYER(0) LAYER(1) LAYER(2) LAYER(3)
#undef LAYER
#undef IN
#undef SEAM
#undef MKP
}

extern "C" void kernel_launch(void* const* d_in, const int* in_sizes, int n_in, void* d_out, int out_size,
                              void* d_ws, size_t ws_size, hipStream_t stream) {
  static int grid = 0;
  if (grid == 0) {
    int dev = 0, cus = 0, per_cu = 0;
    (void)hipGetDevice(&dev);
    (void)hipDeviceGetAttribute(&cus, hipDeviceAttributeMultiprocessorCount, dev);
    (void)hipFuncSetAttribute((const void*)mk_fwd, hipFuncAttributeMaxDynamicSharedMemorySize, LDS_BYTES);
    (void)hipOccupancyMaxActiveBlocksPerMultiprocessor(&per_cu, (const void*)mk_fwd, 512, LDS_BYTES);
    fprintf(stderr, "kernel_launch: cus %d per_cu %d ws %zu (need %zu) n_in %d\n", cus, per_cu, ws_size, (size_t)WS_END, n_in);
    if (ws_size < WS_END || n_in != 23 || per_cu < 1) { fprintf(stderr, "kernel_launch: bad configuration, nothing launched\n"); grid = -1; return; }
    grid = cus;
  }
  if (grid < 0) return;
  (void)hipMemsetAsync((char*)d_ws + WS_CTL, 0, 65536, stream);
  KArgs p{};
  for (int i = 0; i < 23; ++i) p.in[i] = (const float*)d_in[i];
  p.out = (float*)d_out; p.ws = (unsigned char*)d_ws; p.ph_lo = 0; p.ph_hi = 38;
  void* args[] = {&p};
  hipError_t e = hipLaunchCooperativeKernel((const void*)mk_fwd, dim3(grid), dim3(512), args, LDS_BYTES, stream);
  if (e != hipSuccess) fprintf(stderr, "cooperative launch failed: %s (grid %d)\n", hipGetErrorString(e), grid);
}
```

```cpp
#include <hip/hip_runtime.h>
#include <hip/hip_cooperative_groups.h>
#include <cstdio>
#include <cstdint>
namespace cg = cooperative_groups;

constexpr int DM = 1024, NBATCH = 4, SEQ = 8192, CTXL = 256, SEGL = CTXL + SEQ, T = NBATCH * SEGL, DEPTH = 4;
constexpr int IN_W = 3088, PW = 3072;
constexpr int QK8_PITCH = 144; constexpr size_t QK8_IMG = (size_t)16 * SEGL * QK8_PITCH;
constexpr int C_A = 0, C_MQ = 512, C_MK = 768, C_MV = 1024, C_MO = 1280, C_DQ = 1536, C_DK = 2048, C_DV = 2560;
constexpr int NCH = SEGL / 64;
constexpr int NEXP = 16384;
constexpr float EPS = 1e-6f;
#ifndef ABL
#define ABL 0
#endif
#ifndef GATHER_SYNC
#define GATHER_SYNC 0
#endif
#ifndef REP_ATT
#define REP_ATT 1
#endif
#ifndef GP_MASK
#define GP_MASK 0x3FFF
#endif
#ifndef REP_PEER
#define REP_PEER 1
#endif
#ifndef REP_GEMM
#define REP_GEMM 1
#endif
#ifndef REP_ROUTE
#define REP_ROUTE 1
#endif
#ifndef REP_OUTP
#define REP_OUTP 1
#endif
#ifndef REP_ML
#define REP_ML 1
#endif
#ifndef REP_MISC
#define REP_MISC 1
#endif
constexpr float QSCALE = 0.125f * 1.4426950408889634f;

constexpr size_t MiB = 1u << 20;
constexpr size_t WS_CTL = 0, WS_MOD = 1 * MiB, WS_ROPE = 2 * MiB, WS_WG = 4 * MiB, WS_KEYS = 5 * MiB, WS_MLMETA = 6 * MiB,
                 WS_GATES = 7 * MiB, WS_WIN = 10 * MiB, WS_WOUT = 34 * MiB, WS_WQ = 42 * MiB, WS_PU = 50 * MiB, WS_PV = 114 * MiB, WS_PSC = 178 * MiB  , WS_H8 = 180 * MiB  , WS_W8 = 216 * MiB  ,
                 WS_XCUR = 306 * MiB, WS_H = 438 * MiB, WS_MIX = 504 * MiB, WS_PROJ = 570 * MiB, WS_ULOC = 768 * MiB, WS_V8T = 836 * MiB  , WS_EID = 858 * MiB  , WS_QK8 = 924 * MiB  , WS_END = 964 * MiB;
constexpr int USTRIDE = 4160;

constexpr int LDS_BYTES = 139264 + 512;
constexpr int LDS_WTAB = LDS_BYTES - 64 - 256;

#define LAS __attribute__((address_space(3)))
__device__ __forceinline__ int hw_wave_key() { return (int)(__builtin_amdgcn_s_getreg((5 << 11) | 4) & 63u); }
__device__ __forceinline__ int tidx() {
  extern __shared__ __attribute__((aligned(16))) unsigned char lds_dyn_[];
  const int w = __builtin_amdgcn_readfirstlane(*(const volatile LAS int*)((LAS unsigned char*)lds_dyn_ + LDS_WTAB + 4 * hw_wave_key()));
  unsigned z_ = 0u; asm volatile("" : "+v"(z_));
  return (w << 6) | (int)__builtin_amdgcn_mbcnt_hi(~0u, __builtin_amdgcn_mbcnt_lo(~0u, z_));
}
typedef unsigned short bf16_t;
typedef short bf16x8 __attribute__((ext_vector_type(8)));
typedef short s16x4 __attribute__((ext_vector_type(4)));
typedef float f32x4 __attribute__((ext_vector_type(4)));
typedef float f32x16 __attribute__((ext_vector_type(16)));
typedef unsigned u32x4 __attribute__((ext_vector_type(4)));
typedef unsigned u32x2 __attribute__((ext_vector_type(2)));
typedef __bf16 bf16x2v __attribute__((ext_vector_type(2)));
typedef int i32x8 __attribute__((ext_vector_type(8)));
typedef int i32x6 __attribute__((ext_vector_type(6)));
struct __attribute__((aligned(4))) u32x3 { unsigned x, y, z; };
typedef float f32x32 __attribute__((ext_vector_type(32)));
constexpr int PROW = 768;
typedef float f32x2 __attribute__((ext_vector_type(2)));
typedef _Float16 h16x2 __attribute__((ext_vector_type(2)));
typedef _Float16 h16x32 __attribute__((ext_vector_type(32)));
typedef unsigned u32x3v __attribute__((ext_vector_type(3)));
typedef unsigned u32x2v __attribute__((ext_vector_type(2)));

struct KArgs {
  const float* in[23];
  float* out;
  unsigned char* ws;
  int ph_lo, ph_hi;
};
typedef const float* const __attribute__((address_space(4))) * InTab;
struct Params {
  InTab in;
  float* out;
  unsigned char* ws;
  int ph_lo, ph_hi;
  int bx, gx;
  unsigned* xbar_words; unsigned xbar_x; unsigned lds_st_off;
};
enum { I_X = 0, I_C, I_CTX, I_CCTX, I_ADAW, I_ADAB, I_N1G, I_N2G, I_WIN, I_CONVW, I_CONVB, I_CLNG, I_CLNB, I_GATEB, I_MNORMG, I_DLAM, I_DNORMG,
       I_WOUT, I_PWQ, I_PKEYS, I_PU, I_PV, I_FINALG };

__device__ __forceinline__ unsigned cvtpk(float lo, float hi) { unsigned r; asm volatile("v_cvt_pk_bf16_f32 %0, %1, %2" : "=v"(r) : "v"(lo), "v"(hi)); return r; }
__device__ __forceinline__ float bflo(unsigned u) { return __uint_as_float(u << 16); }
__device__ __forceinline__ float bfhi(unsigned u) { return __uint_as_float(u & 0xffff0000u); }
__device__ __forceinline__ float bf1(bf16_t u) { return __uint_as_float(((unsigned)u) << 16); }
__device__ __forceinline__ int crow(int r, int hi) { return (r & 3) + 8 * (r >> 2) + 4 * hi; }
template <int CTRL> __device__ __forceinline__ float dpp_mov(float v) {
  return __uint_as_float((unsigned)__builtin_amdgcn_update_dpp(0, (int)__float_as_uint(v), CTRL, 0xF, 0xF, true));
}
__device__ __forceinline__ float wave_sum_fast(float x) {
  x += dpp_mov<0xB1>(x); x += dpp_mov<0x4E>(x); x += dpp_mov<0x141>(x); x += dpp_mov<0x140>(x);
  { auto r = __builtin_amdgcn_permlane16_swap(__float_as_uint(x), __float_as_uint(x), false, false); x = __uint_as_float(r[0]) + __uint_as_float(r[1]); }
  { auto r = __builtin_amdgcn_permlane32_swap(__float_as_uint(x), __float_as_uint(x), false, false); x = __uint_as_float(r[0]) + __uint_as_float(r[1]); }
  return x;
}
__device__ __forceinline__ float wave_max_fast(float x) {
  x = fmaxf(x, dpp_mov<0xB1>(x)); x = fmaxf(x, dpp_mov<0x4E>(x)); x = fmaxf(x, dpp_mov<0x141>(x)); x = fmaxf(x, dpp_mov<0x140>(x));
  { auto r = __builtin_amdgcn_permlane16_swap(__float_as_uint(x), __float_as_uint(x), false, false); x = fmaxf(__uint_as_float(r[0]), __uint_as_float(r[1])); }
  { auto r = __builtin_amdgcn_permlane32_swap(__float_as_uint(x), __float_as_uint(x), false, false); x = fmaxf(__uint_as_float(r[0]), __uint_as_float(r[1])); }
  return x;
}
template <int CTRL, int ROWMASK> __device__ __forceinline__ float dpp_mov_rm(float v) {
  return __uint_as_float((unsigned)__builtin_amdgcn_update_dpp(0, (int)__float_as_uint(v), CTRL, ROWMASK, 0xF, true));
}
__device__ __forceinline__ float wave_incl_scan(float x) {
  x += dpp_mov<0x111>(x); x += dpp_mov<0x112>(x); x += dpp_mov<0x114>(x); x += dpp_mov<0x118>(x);
  x += dpp_mov_rm<0x142, 0xA>(x);
  x += dpp_mov_rm<0x143, 0xC>(x);
  return x;
}
__device__ __forceinline__ float wave_sum(float v) { return wave_sum_fast(v); }
__device__ __forceinline__ float sum_xor32(float x) { auto r = __builtin_amdgcn_permlane32_swap(__float_as_uint(x), __float_as_uint(x), false, false); return __uint_as_float(r[0]) + __uint_as_float(r[1]); }
__device__ __forceinline__ float max_xor32(float x) { auto r = __builtin_amdgcn_permlane32_swap(__float_as_uint(x), __float_as_uint(x), false, false); return fmaxf(__uint_as_float(r[0]), __uint_as_float(r[1])); }
__device__ __forceinline__ float wave_max(float v) { return wave_max_fast(v); }
__device__ __forceinline__ float sigmoidf_(float x) { return 1.f / (1.f + __expf(-x)); }
__device__ __forceinline__ float logsigmoidf_(float x) { return fminf(x, 0.f) - log1pf(__expf(-fabsf(x))); }
__device__ __forceinline__ const float* in_row(const float* x, const float* ctx, int row) {
  const int b = row / SEGL, s = row - b * SEGL;
  return s < CTXL ? ctx + ((size_t)(b * CTXL + s)) * DM : x + ((size_t)(b * SEQ + (s - CTXL))) * DM;
}
__device__ __forceinline__ int mod_row(int row) { const int b = row / SEGL, s = row - b * SEGL; return s < CTXL ? 4 : b; }

__device__ __forceinline__ void p0_mod(const Params& p, unsigned char* lds, float* MOD) {
  float* sil = (float*)lds;
  float* red = (float*)(lds + 20480);
  int tid_ = tidx(); asm volatile("" : "+v"(tid_)); const int tid = tid_, lane = tid & 63, wid = tid >> 6;
  for (int i = tid; i < 5 * 1024; i += 512) {
    const float v = i < 4096 ? p.in[I_C][i] : p.in[I_CCTX][i - 4096];
    sil[i] = v / (1.f + __expf(-v));
  }
  __syncthreads();
  for (int item = p.bx; item < DEPTH * 96; item += p.gx) {
    const int l = item / 96, j0 = (item % 96) * 64;
    const float* W = p.in[I_ADAW] + (size_t)l * DM * 6144 + j0 + lane;
    float a0 = 0.f, a1 = 0.f, a2 = 0.f, a3 = 0.f, a4 = 0.f;
    const int k0 = wid * 128;
#pragma unroll 8
    for (int k = k0; k < k0 + 128; ++k) {
      const float w = W[(size_t)k * 6144];
      a0 += sil[k] * w; a1 += sil[1024 + k] * w; a2 += sil[2048 + k] * w; a3 += sil[3072 + k] * w; a4 += sil[4096 + k] * w;
    }
    red[(wid * 5 + 0) * 64 + lane] = a0; red[(wid * 5 + 1) * 64 + lane] = a1; red[(wid * 5 + 2) * 64 + lane] = a2;
    red[(wid * 5 + 3) * 64 + lane] = a3; red[(wid * 5 + 4) * 64 + lane] = a4;
    __syncthreads();
    if (tid < 320) {
      const int r = tid >> 6;
      float s = 0.f;
#pragma unroll
      for (int w = 0; w < 8; ++w) s += red[(w * 5 + r) * 64 + lane];
      MOD[((size_t)l * 5 + r) * 6144 + j0 + lane] = s + p.in[I_ADAB][l * 6144 + j0 + lane];
    }
    __syncthreads();
  }
}
__device__ __forceinline__ void transpose_item(const float* W, int ldw, int srccol0, bf16_t* WT, int K, int n0, int k0, float* scr, int lane, unsigned char* W8 = nullptr) {
#pragma unroll 8
  for (int i = 0; i < 32; ++i) { const int kk = 2 * i + (lane >> 5); scr[kk * 33 + (lane & 31)] = W[(size_t)(k0 + kk) * ldw + srccol0 + (lane & 31)]; }
  asm volatile("s_waitcnt lgkmcnt(0)" ::: "memory");
  const int c = lane & 7;
#pragma unroll
  for (int j = 0; j < 4; ++j) {
    const int n = (lane >> 3) + 8 * j; const float* s = scr + (8 * c) * 33 + n;
    u32x4 o; o.x = cvtpk(s[0], s[33]); o.y = cvtpk(s[66], s[99]); o.z = cvtpk(s[132], s[165]); o.w = cvtpk(s[198], s[231]);
    *(u32x4*)(WT + (size_t)(n0 + n) * K + k0 + 8 * c) = o;
    if (W8) {
      int w0 = 0, w1 = 0;
      w0 = __builtin_amdgcn_cvt_pk_fp8_f32(s[0] * 32.f, s[33] * 32.f, w0, false); w0 = __builtin_amdgcn_cvt_pk_fp8_f32(s[66] * 32.f, s[99] * 32.f, w0, true);
      w1 = __builtin_amdgcn_cvt_pk_fp8_f32(s[132] * 32.f, s[165] * 32.f, w1, false); w1 = __builtin_amdgcn_cvt_pk_fp8_f32(s[198] * 32.f, s[231] * 32.f, w1, true);
      *(u32x2*)(W8 + (size_t)(n0 + n) * K + k0 + 8 * c) = (u32x2){(unsigned)w0, (unsigned)w1};
    }
  }
  asm volatile("s_waitcnt lgkmcnt(0)" ::: "memory");
}
__device__ __forceinline__ void convert_tables(const Params& p, int L, int wv, int nw, int lane, int r_lo, int r_hi) {
  unsigned char* PUq = p.ws + WS_PU; unsigned char* PVq = p.ws + WS_PV; float* PSC = (float*)(p.ws + WS_PSC);
  const int nrows = DEPTH * NEXP;
#define TAB_SROW(r_) ((const f32x4*)(((r_) >= NEXP ? p.in[I_PV] : p.in[I_PU]) + (size_t)(L * NEXP + ((r_) >= NEXP ? (r_) - NEXP : (r_))) * DM) + lane)
#define TAB_LOAD(v_, r_) do { if ((r_) < r_hi) { const f32x4* s_ = TAB_SROW(r_); _Pragma("unroll") for (int j = 0; j < 4; ++j) v_[j] = __builtin_nontemporal_load(s_ + 64 * j); } } while (0)
  auto encode_row = [&](const f32x4 (&v)[4], int r) {
    const int tb = r >= NEXP, rr = L * NEXP + (tb ? r - NEXP : r);
    float mx = 0.f;
#pragma unroll
    for (int j = 0; j < 4; ++j) mx = fmaxf(mx, fmaxf(fmaxf(fabsf(v[j].x), fabsf(v[j].y)), fmaxf(fabsf(v[j].z), fabsf(v[j].w))));
    mx = wave_max_fast(mx);
    const unsigned mb = __float_as_uint(mx);
    const int eb = (int)((mb >> 23) & 0xFFu);
    int sb = ((mb & 0x7FFFFFu) <= 0x700000u ? 129 : 128) - eb + 127; sb = sb < 1 ? 1 : (sb > 253 ? 253 : sb);
    const float sc = __uint_as_float((unsigned)sb << 23), isc = __uint_as_float((unsigned)(254 - sb) << 23);
    const float xv[16] = {v[0].x, v[0].y, v[0].z, v[0].w, v[1].x, v[1].y, v[1].z, v[1].w, v[2].x, v[2].y, v[2].z, v[2].w, v[3].x, v[3].y, v[3].z, v[3].w};
    unsigned wq[3] = {0u, 0u, 0u};
#pragma unroll
    for (int i = 0; i < 16; ++i) {
      const float a = fabsf(xv[i]) * sc;
      unsigned code = a < 2.f ? (unsigned)__builtin_rintf(a * 8.f) : (a < 4.f ? 8u + (unsigned)__builtin_rintf(a * 4.f) : 16u + (unsigned)__builtin_rintf(a * 2.f));
      code = code > 31u ? 31u : code;
      code |= (xv[i] < 0.f) ? 32u : 0u;
      const int bp = 6 * i, dw = bp >> 5, off = bp & 31;
      wq[dw] |= code << off;
      if (off > 26) wq[dw + 1] |= code >> (32 - off);
    }
    u32x3 o; o.x = wq[0]; o.y = wq[1]; o.z = wq[2];
    *(u32x3*)((tb ? PVq : PUq) + (size_t)rr * PROW + lane * 12) = o;
    if (lane == 0) PSC[(size_t)tb * nrows + rr] = isc;
  };
  f32x4 v0[4], v1[4], v2[4];
  TAB_LOAD(v0, r_lo + wv); TAB_LOAD(v1, r_lo + wv + nw);
#pragma unroll 1
  for (int r = r_lo + wv; r < r_hi; r += 3 * nw) {
    TAB_LOAD(v2, r + 2 * nw); encode_row(v0, r);
    if (r + nw < r_hi) { TAB_LOAD(v0, r + 3 * nw); encode_row(v1, r + nw); }
    if (r + 2 * nw < r_hi) { TAB_LOAD(v1, r + 4 * nw); encode_row(v2, r + 2 * nw); }
  }
#undef TAB_LOAD
#undef TAB_SROW
}
__device__ __forceinline__ void tail_filler_tables(const Params& p, int L, int nwg, int r_lo, int r_hi) {
  int tid_ = tidx(); asm volatile("" : "+v"(tid_)); const int lane = tid_ & 63, wid = tid_ >> 6;
  const int nextra = nwg % p.gx, first = nextra, nidle = p.gx - nextra;
  if (p.bx < first) return;
  convert_tables(p, L, (p.bx - first) * 8 + wid, nidle * 8, lane, r_lo, r_hi);
}
__device__ __forceinline__ void p0_convert(const Params& p, unsigned char* lds) {
  int tid_ = tidx(); asm volatile("" : "+v"(tid_)); const int tid = tid_, lane = tid & 63, wid = tid >> 6;
  const int gw = p.bx * 8 + wid, NGW = p.gx * 8;
  const size_t gt = (size_t)p.bx * 512 + tid, NGT = (size_t)p.gx * 512;
  float* scr = (float*)(lds + 32768) + wid * (64 * 33);
  bf16_t* WIN = (bf16_t*)(p.ws + WS_WIN); bf16_t* WOUT = (bf16_t*)(p.ws + WS_WOUT); bf16_t* WQ = (bf16_t*)(p.ws + WS_WQ);
  constexpr int I_IN = 16 * 96, I_O = 16 * 32, PER_L = I_IN + 2 * I_O;
  for (int it = gw; it < DEPTH * PER_L; it += NGW) {
    const int l = it / PER_L; int r = it % PER_L;
    if (r < I_IN) { const int kb = r / 96, nb = r % 96, n0 = nb * 32; const int src = n0 < 1536 ? n0 : n0 + 16;
      transpose_item(p.in[I_WIN] + (size_t)l * DM * IN_W, IN_W, src, WIN + (size_t)l * PW * DM, DM, n0, kb * 64, scr, lane, p.ws + WS_W8 + (size_t)l * PW * DM); continue; }
    r -= I_IN;
    if (r < I_O) { const int kb = r / 32, nb = r % 32;
      transpose_item(p.in[I_WOUT] + (size_t)l * DM * DM, DM, nb * 32, WOUT + (size_t)l * DM * DM, DM, nb * 32, kb * 64, scr, lane); continue; }
    r -= I_O;
    { const int kb = r / 32, nb = r % 32;
      transpose_item(p.in[I_PWQ] + (size_t)l * DM * DM, DM, nb * 32, WQ + (size_t)l * DM * DM, DM, nb * 32, kb * 64, scr, lane); }
  }
  bf16_t* WG = (bf16_t*)(p.ws + WS_WG);
  for (size_t i = gt; i < (size_t)DEPTH * 16 * DM; i += NGT) {
    const int l = (int)(i / (16 * DM)), g = (int)((i / DM) % 16), k = (int)(i % DM);
    WG[i] = (bf16_t)(cvtpk(p.in[I_WIN][(size_t)l * DM * IN_W + (size_t)k * IN_W + 1536 + g], 0.f) & 0xffffu);
  }
  bf16_t* KEYS = (bf16_t*)(p.ws + WS_KEYS);
  for (size_t i = gt; i < (size_t)DEPTH * 131072 / 8; i += NGT) {
    const f32x4 a = ((const f32x4*)p.in[I_PKEYS])[2 * i], b = ((const f32x4*)p.in[I_PKEYS])[2 * i + 1];
    u32x4 o; o.x = cvtpk(a.x, a.y); o.y = cvtpk(a.z, a.w); o.z = cvtpk(b.x, b.y); o.w = cvtpk(b.z, b.w);
    ((u32x4*)KEYS)[i] = o;
  }
  {
    float* RC = (float*)(p.ws + WS_ROPE); float* RS = RC + SEQ * 32;
    for (size_t i = gt; i < (size_t)SEQ * 32; i += NGT) {
      const int pos = (int)(i >> 5), j = (int)(i & 31);
      const int rr = pos >> 6, cc = pos & 63;
      const int jj = j & 15;
      const double e = -(double)jj * 0.83048202372184058696;
      const double fl = __builtin_floor(e); const double f = e - fl;
      const double z = f * 0.69314718055994530942;
      double ez = 1.0 + z * (1.0 + z * (0.5 + z * (1.0 / 6 + z * (1.0 / 24 + z * (1.0 / 120 + z * (1.0 / 720 + z * (1.0 / 5040 + z * (1.0 / 40320 + z * (1.0 / 362880 + z * (1.0 / 3628800 + z * (1.0 / 39916800 + z * (1.0 / 479001600))))))))))));
      const double inv = __builtin_ldexp(ez, (int)fl);
      const float invf = (float)inv;
      const float angf = (float)(j < 16 ? rr : cc) * invf;
      const double ang = (double)angf;
      const double kq = __builtin_rint(ang * 0.63661977236758134308);
      double r = __builtin_fma(-kq, 1.57079632679489655800e+00, ang);
      r = __builtin_fma(-kq, 6.12323399573676603587e-17, r);
      const double r2 = r * r;
      const double sn = r * (1.0 + r2 * (-1.0 / 6 + r2 * (1.0 / 120 + r2 * (-1.0 / 5040 + r2 * (1.0 / 362880 + r2 * (-1.0 / 39916800 + r2 * (1.0 / 6227020800.0)))))));
      const double cs = 1.0 + r2 * (-0.5 + r2 * (1.0 / 24 + r2 * (-1.0 / 720 + r2 * (1.0 / 40320 + r2 * (-1.0 / 3628800 + r2 * (1.0 / 479001600 + r2 * (-1.0 / 87178291200.0)))))));
      const int q = ((int)kq) & 3;
      double co, si;
      if (q == 0) { co = cs; si = sn; } else if (q == 1) { co = -sn; si = cs; } else if (q == 2) { co = -cs; si = -sn; } else { co = sn; si = -cs; }
      RC[i] = (float)co; RS[i] = (float)si;
    }
  }
}

__device__ __forceinline__ void norm_mod_row(const float* xrow, const float* g, const float* sc, const float* sh, bf16_t* orow, int lane) {
  const f32x4* xr = (const f32x4*)xrow + lane;
  f32x4 v[4]; float s = 0.f;
#pragma unroll
  for (int j = 0; j < 4; ++j) { v[j] = xr[64 * j]; s += (v[j].x * v[j].x + v[j].y * v[j].y) + (v[j].z * v[j].z + v[j].w * v[j].w); }
  const float rs = rsqrtf(wave_sum(s) * (1.f / DM) + EPS);
  u32x2* o = (u32x2*)orow + lane;
#pragma unroll
  for (int j = 0; j < 4; ++j) {
    const f32x4 gg = ((const f32x4*)g)[lane + 64 * j], cc = ((const f32x4*)sc)[lane + 64 * j], hh = ((const f32x4*)sh)[lane + 64 * j];
    const float y0 = v[j].x * rs * gg.x * (1.f + cc.x) + hh.x, y1 = v[j].y * rs * gg.y * (1.f + cc.y) + hh.y;
    const float y2 = v[j].z * rs * gg.z * (1.f + cc.z) + hh.z, y3 = v[j].w * rs * gg.w * (1.f + cc.w) + hh.w;
    u32x2 w; w.x = cvtpk(y0, y1); w.y = cvtpk(y2, y3);
    o[64 * j] = w;
  }
}
__device__ __forceinline__ void phase_norm(const Params& p, int l, int which, bool from_input, bool skip_ctx) {
  int tid_ = tidx(); asm volatile("" : "+v"(tid_));
  const int lane = tid_ & 63, wid = tid_ >> 6;
  const int gw = p.bx * 8 + wid, NGW = p.gx * 8;
  const float* MOD = (const float*)(p.ws + WS_MOD);
  const float* XC = (const float*)(p.ws + WS_XCUR);
  bf16_t* H = (bf16_t*)(p.ws + WS_H);
  const float* g = p.in[which ? I_N2G : I_N1G] + l * DM;
  auto next_row = [&](int r_) { while (r_ < T && skip_ctx && mod_row(r_) == 4) r_ += NGW; return r_; };
  auto xrow_of = [&](int r_) { return (const f32x4*)(from_input ? in_row(p.in[I_X], p.in[I_CTX], r_) : XC + (size_t)r_ * DM) + lane; };
  f32x4 gg[4], cc[4], hh[4], v[4], vn[4];
#pragma unroll
  for (int j = 0; j < 4; ++j) gg[j] = ((const f32x4*)g)[lane + 64 * j];
  int mr_cur = -1;
  int row = next_row(gw);
  if (row < T) { const f32x4* xr = xrow_of(row);
#pragma unroll
    for (int j = 0; j < 4; ++j) v[j] = xr[64 * j]; }
  while (row < T) {
    const int nrow = next_row(row + NGW);
    if (nrow < T) { const f32x4* xn = xrow_of(nrow);
#pragma unroll
      for (int j = 0; j < 4; ++j) vn[j] = xn[64 * j]; }
    const int mr = mod_row(row);
    if (mr != mr_cur) {
      const float* m = MOD + ((size_t)l * 5 + mr) * 6144 + which * 3072;
#pragma unroll
      for (int j = 0; j < 4; ++j) { cc[j] = ((const f32x4*)(m + 1024))[lane + 64 * j]; hh[j] = ((const f32x4*)m)[lane + 64 * j]; }
      mr_cur = mr;
    }
    float s = 0.f;
#pragma unroll
    for (int j = 0; j < 4; ++j) s += (v[j].x * v[j].x + v[j].y * v[j].y) + (v[j].z * v[j].z + v[j].w * v[j].w);
    const float rs = rsqrtf(wave_sum(s) * (1.f / DM) + EPS);
    u32x2* o = (u32x2*)(H + (size_t)row * DM) + lane;
#pragma unroll
    for (int j = 0; j < 4; ++j) {
      const float y0 = v[j].x * rs * gg[j].x * (1.f + cc[j].x) + hh[j].x, y1 = v[j].y * rs * gg[j].y * (1.f + cc[j].y) + hh[j].y;
      const float y2 = v[j].z * rs * gg[j].z * (1.f + cc[j].z) + hh[j].z, y3 = v[j].w * rs * gg[j].w * (1.f + cc[j].w) + hh[j].w;
      u32x2 w; w.x = cvtpk(y0, y1); w.y = cvtpk(y2, y3);
      o[64 * j] = w;
      if (which == 0) {
        int w8 = 0; w8 = __builtin_amdgcn_cvt_pk_fp8_f32(y0, y1, w8, false); w8 = __builtin_amdgcn_cvt_pk_fp8_f32(y2, y3, w8, true);
        ((int*)(p.ws + WS_H8 + (size_t)row * DM))[lane + 64 * j] = w8;
      }
    }
#pragma unroll
    for (int j = 0; j < 4; ++j) v[j] = vn[j];
    row = nrow;
  }
}

namespace pg8 {
#define PG8_LAS __attribute__((address_space(3)))
typedef unsigned short bf16_t;
typedef short bf16x8 __attribute__((ext_vector_type(8)));
typedef float f32x4 __attribute__((ext_vector_type(4)));
typedef unsigned u32x4 __attribute__((ext_vector_type(4)));
typedef int i32x4v __attribute__((ext_vector_type(4)));
typedef int i32x8v __attribute__((ext_vector_type(8)));
constexpr int BM = 256, BK = 64, HALF = 128, HTB = HALF * BK * 2  , STAGE_BYTES = 8 * HTB, NXCD = 8, WGM = 8;

__host__ __device__ __forceinline__ int lds_byte(int r, int c) { const int st = (r >> 4) * 2 + (c >> 5), rr = r & 15, cc = c & 31, ob = rr * 64 + cc * 2; return st * 1024 + (ob ^ (((ob >> 9) & 1) << 5)); }
__host__ __device__ __forceinline__ void stage_rc(int b, int& R, int& C) { const int st = b / 1024, sb = b % 1024, swz = sb ^ (((sb >> 9) & 1) << 5); R = (st >> 1) * 16 + swz / 64; C = (st & 1) * 32 + (swz % 64) / 2; }
__host__ __device__ __forceinline__ int perm32(int rho) { const int n = rho >> 4, i = rho & 15; return 8 * (i >> 2) + 4 * n + (i & 3); }

struct Unit { int pm, pn; };
struct Gemm { const bf16_t* A; const bf16_t* Bt; int M, N, K; };

struct StaticOrder {
    int nM, nN, nwg, G, c;
    __host__ __device__ void init(int M, int N, int G_, int c_) { nM = M / BM; nN = N / BM; nwg = nM * nN; G = G_; c = c_; }
    __host__ __device__ bool next(int i, Unit& u) const {
        const long L = (long)i * G + c; if (L >= nwg) return false;
        int wgid = (int)L; { const int q = nwg / NXCD, r = nwg % NXCD, xcd = wgid % NXCD, off = wgid / NXCD; wgid = (xcd < r ? xcd * (q + 1) : r * (q + 1) + (xcd - r) * q) + off; }
        const int nig = WGM * nN, gid = wgid / nig, fm = gid * WGM, gsz = (nM - fm) < WGM ? (nM - fm) : WGM;
        u.pm = fm + ((wgid % nig) % gsz); u.pn = (wgid % nig) / gsz; return true;
    }
    __device__ __forceinline__ void a_ready(const Unit&) const {}
    __device__ __forceinline__ void done(const Unit&) const {}
};
struct F8Order {
    int nM, G, c, heavy, nwg, nN, pn0;
    __host__ __device__ void init(int M, int G_, int c_, int heavy_, int nN_ = 6, int pn0_ = 6) { nM = M / BM; G = G_; c = c_; heavy = heavy_; nN = nN_; pn0 = pn0_; nwg = nM * nN; }
    __host__ __device__ bool next(int i, Unit& u) const {
        int L;
        const int nl = G - heavy, tailbase = nwg - 2 * heavy;
        if (c >= heavy) { L = i * nl + (c - heavy); if (L >= tailbase) return false; }
        else { if (i > 1) return false; L = tailbase + 2 * c + i; }
        int wgid = L; { const int q = nwg / NXCD, r = nwg % NXCD, xcd = wgid % NXCD, off = wgid / NXCD; wgid = (xcd < r ? xcd * (q + 1) : r * (q + 1) + (xcd - r) * q) + off; }
        const int nig = WGM * nN, gid = wgid / nig, fm = gid * WGM, gsz = (nM - fm) < WGM ? (nM - fm) : WGM;
        u.pm = fm + ((wgid % nig) % gsz); u.pn = pn0 + (wgid % nig) / gsz; return true;
    }
    __device__ __forceinline__ void a_ready(const Unit&) const {}
    __device__ __forceinline__ void done(const Unit&) const {}
};
__device__ __forceinline__ unsigned cvt_pk_bf16(float lo, float hi) { unsigned r; asm volatile("v_cvt_pk_bf16_f32 %0, %1, %2" : "=v"(r) : "v"(lo), "v"(hi)); return r; }
template <class Epi, class Sched, bool ALIGN_EPI = false, bool SP2 = false, bool F8 = false>
__device__ __forceinline__ void gemm_phase(PG8_LAS unsigned char* lds, const Gemm g, const Sched& S, const Epi& E) {
    const int tid = tidx(), wid = __builtin_amdgcn_readfirstlane(tid >> 6), lane = tid & 63, wr = wid >> 2, wc = wid & 3, fr = lane & 15, fq = lane >> 4;
    const int K = g.K, nt = K / BK;
    unsigned voffA, voffB;
    { int R, C; stage_rc(tid * 16, R, C); const int Rb = Epi::PERM ? ((R & ~31) + perm32(R & 31)) : R;
      voffA = (unsigned)(R * K + C) * 2u; voffB = (unsigned)(Rb * K + C) * 2u; }
    const size_t kstep = (size_t)(BK * 2);
    const size_t hstep = (size_t)HALF * K * 2;
    const size_t tstep = 2 * hstep;
    const unsigned ldsw = (unsigned)wid * 1024u;
    const int aoff = lds_byte(wr * 64 + fr, fq * 8), boff = lds_byte(wc * 32 + fr, fq * 8);
#define PG8_SA(b, h) (((b) * 2 + (h)) * HTB)
#define PG8_SB(b, h) ((4 + (b) * 2 + (h)) * HTB)
#define PG8_STAGE(bufoff, gbase, voff) do { _Pragma("unroll") for (int _i = 0; _i < 2; ++_i) \
        __builtin_amdgcn_global_load_lds((const unsigned*)((const char*)(gbase) + (size_t)_i * 128u * (unsigned)K + (voff)), (PG8_LAS unsigned*)(lds + (bufoff) + ldsw + _i * 8192), 16, 0, 0); } while (0)
#define PG8_LD32(d8_, addr_) do { const i32x4v x0_ = *(const PG8_LAS i32x4v*)(addr_), x1_ = *(const PG8_LAS i32x4v*)((addr_) + 1024); \
        d8_ = __builtin_shufflevector(x0_, x1_, 0, 1, 2, 3, 4, 5, 6, 7); } while (0)
#define PG8_LDA(dst, b, h) do { if constexpr (F8) { _Pragma("unroll") for (int m = 0; m < 4; ++m) PG8_LD32(dst##8[m], lds + PG8_SA(b, h) + aoff + m * 2048); } \
        else { _Pragma("unroll") for (int m = 0; m < 4; ++m) _Pragma("unroll") for (int k = 0; k < 2; ++k) dst[m][k] = *(const PG8_LAS bf16x8*)(lds + PG8_SA(b, h) + aoff + m * 2048 + k * 1024); } } while (0)
#define PG8_LDB(dst, b, h) do { if constexpr (F8) { _Pragma("unroll") for (int n = 0; n < 2; ++n) PG8_LD32(dst##8[n], lds + PG8_SB(b, h) + boff + n * 2048); } \
        else { _Pragma("unroll") for (int n = 0; n < 2; ++n) _Pragma("unroll") for (int k = 0; k < 2; ++k) dst[n][k] = *(const PG8_LAS bf16x8*)(lds + PG8_SB(b, h) + boff + n * 2048 + k * 1024); } } while (0)
#define PG8_MMA(ai, bj, At, Bt) do { __builtin_amdgcn_s_setprio(1); _Pragma("unroll") for (int m = 0; m < 4; ++m) _Pragma("unroll") for (int n = 0; n < 2; ++n) { \
        if constexpr (F8) acc[ai][bj][m][n] = __builtin_amdgcn_mfma_scale_f32_16x16x128_f8f6f4(Bt##8[n], At##8[m], acc[ai][bj][m][n], 0, 0, 0, 0x7F7F7F7F, 0, 0x7F7F7F7F); \
        else { _Pragma("unroll") for (int k = 0; k < 2; ++k) acc[ai][bj][m][n] = __builtin_amdgcn_mfma_f32_16x16x32_bf16(Bt[n][k], At[m][k], acc[ai][bj][m][n], 0, 0, 0); } } \
        __builtin_amdgcn_s_setprio(0); } while (0)
#define PG8_WAIT_V(n) asm volatile("s_waitcnt vmcnt(" #n ")" ::: "memory")
#define PG8_WAIT_L(n) asm volatile("s_waitcnt lgkmcnt(" #n ")" ::: "memory")
#define PG8_BAR __builtin_amdgcn_s_barrier()
#define PG8_SCHED __builtin_amdgcn_sched_barrier(0)
    Unit cur, nxt; int ui = 0;
    if (!S.next(0, cur)) return;
    f32x4 acc[2][2][4][2];
#pragma unroll
    for (int a = 0; a < 2; ++a)
#pragma unroll
        for (int b = 0; b < 2; ++b)
#pragma unroll
            for (int m = 0; m < 4; ++m)
#pragma unroll
                for (int n = 0; n < 2; ++n) acc[a][b][m][n] = (f32x4){0.f, 0.f, 0.f, 0.f};
    bf16x8 At[4][2], B0[2][2], B1[2][2];
    i32x8v At8[4], B08[2], B18[2];
    const char* cA = (const char*)g.A + (size_t)cur.pm * tstep; const char* cB = (const char*)g.Bt + (size_t)cur.pn * tstep;
    S.a_ready(cur);
    if constexpr (SP2) {
        PG8_STAGE(PG8_SB(0, 0), cB, voffB); PG8_STAGE(PG8_SB(0, 1), cB + hstep, voffB); PG8_STAGE(PG8_SA(0, 0), cA, voffA); PG8_STAGE(PG8_SA(0, 1), cA + hstep, voffA);
        if (wr == 1) PG8_BAR;
        PG8_WAIT_V(2); PG8_BAR;
        PG8_STAGE(PG8_SB(1, 0), cB + kstep, voffB); PG8_STAGE(PG8_SA(1, 0), cA + kstep, voffA); PG8_STAGE(PG8_SB(1, 1), cB + hstep + kstep, voffB);
        PG8_WAIT_V(6); PG8_BAR;
    } else {
        PG8_STAGE(PG8_SB(0, 0), cB, voffB); PG8_STAGE(PG8_SA(0, 0), cA, voffA); PG8_STAGE(PG8_SB(0, 1), cB + hstep, voffB); PG8_STAGE(PG8_SA(0, 1), cA + hstep, voffA);
        if (wr == 1) PG8_BAR;
        PG8_WAIT_V(4); PG8_BAR;
        PG8_STAGE(PG8_SB(1, 0), cB + kstep, voffB); PG8_STAGE(PG8_SA(1, 0), cA + kstep, voffA); PG8_STAGE(PG8_SB(1, 1), cB + hstep + kstep, voffB);
        PG8_WAIT_V(6); PG8_BAR;
    }
    for (;;) {
        const bool has_next = S.next(ui + 1, nxt);
        const char* nA = has_next ? (const char*)g.A + (size_t)nxt.pm * tstep : cA; const char* nB = has_next ? (const char*)g.Bt + (size_t)nxt.pn * tstep : cB;
#pragma unroll 1
        for (int t = 0; t < nt; t += 2) {
            const bool last = (t == nt - 2);
            const char* a1 = cA + (size_t)(t + 1) * kstep;
            const char* a2 = last ? nA : cA + (size_t)(t + 2) * kstep; const char* b2 = last ? nB : cB + (size_t)(t + 2) * kstep;
            const char* a3 = a2 + kstep; const char* b3 = b2 + kstep;
            if (last && has_next) S.a_ready(nxt);
            if constexpr (SP2) {
            PG8_LDB(B0, 0, 0); PG8_LDB(B1, 0, 1); PG8_SCHED; PG8_LDA(At, 0, 0); PG8_STAGE(PG8_SA(1, 1), a1 + hstep, voffA);
            PG8_WAIT_V(8); PG8_WAIT_L(0); PG8_BAR; PG8_MMA(0, 0, At, B0); PG8_MMA(0, 1, At, B1); PG8_BAR; PG8_SCHED;
            PG8_LDA(At, 0, 1); PG8_STAGE(PG8_SB(0, 0), b2, voffB); PG8_STAGE(PG8_SB(0, 1), b2 + hstep, voffB); PG8_STAGE(PG8_SA(0, 0), a2, voffA);
            PG8_WAIT_V(8); PG8_WAIT_L(0); PG8_BAR; PG8_MMA(1, 0, At, B0); PG8_MMA(1, 1, At, B1); PG8_BAR; PG8_SCHED;
            PG8_LDB(B0, 1, 0); PG8_LDB(B1, 1, 1); PG8_SCHED; PG8_LDA(At, 1, 0); PG8_STAGE(PG8_SA(0, 1), a2 + hstep, voffA);
            PG8_WAIT_V(8); PG8_WAIT_L(0); PG8_BAR; PG8_MMA(0, 0, At, B0); PG8_MMA(0, 1, At, B1); PG8_BAR; PG8_SCHED;
            PG8_LDA(At, 1, 1); PG8_STAGE(PG8_SB(1, 0), b3, voffB); PG8_STAGE(PG8_SB(1, 1), b3 + hstep, voffB); PG8_STAGE(PG8_SA(1, 0), a3, voffA);
            PG8_WAIT_V(8); PG8_WAIT_L(0); PG8_BAR; PG8_MMA(1, 0, At, B0); PG8_MMA(1, 1, At, B1); PG8_BAR; PG8_SCHED;
            } else {
            PG8_LDB(B0, 0, 0); PG8_SCHED; PG8_LDA(At, 0, 0); PG8_STAGE(PG8_SA(1, 1), a1 + hstep, voffA);
            PG8_WAIT_L(8); PG8_BAR; PG8_WAIT_L(0); PG8_MMA(0, 0, At, B0); PG8_BAR; PG8_SCHED;
            PG8_LDB(B1, 0, 1); PG8_STAGE(PG8_SB(0, 0), b2, voffB);
            PG8_BAR; PG8_WAIT_L(0); PG8_MMA(0, 1, At, B1); PG8_BAR;
            PG8_LDA(At, 0, 1); PG8_STAGE(PG8_SA(0, 0), a2, voffA);
            PG8_BAR; PG8_WAIT_L(0); PG8_MMA(1, 0, At, B0); PG8_BAR; PG8_SCHED;
            PG8_STAGE(PG8_SB(0, 1), b2 + hstep, voffB);
            PG8_WAIT_V(6); PG8_BAR; PG8_MMA(1, 1, At, B1); PG8_BAR;
            PG8_LDB(B0, 1, 0); PG8_SCHED; PG8_LDA(At, 1, 0); PG8_STAGE(PG8_SA(0, 1), a2 + hstep, voffA);
            PG8_WAIT_L(8); PG8_BAR; PG8_WAIT_L(0); PG8_MMA(0, 0, At, B0); PG8_BAR; PG8_SCHED;
            PG8_LDB(B1, 1, 1); PG8_STAGE(PG8_SB(1, 0), b3, voffB);
            PG8_BAR; PG8_WAIT_L(0); PG8_MMA(0, 1, At, B1); PG8_BAR;
            PG8_LDA(At, 1, 1); PG8_STAGE(PG8_SA(1, 0), a3, voffA);
            PG8_BAR; PG8_WAIT_L(0); PG8_MMA(1, 0, At, B0); PG8_BAR; PG8_SCHED;
            PG8_STAGE(PG8_SB(1, 1), b3 + hstep, voffB);
            PG8_WAIT_V(6); PG8_BAR; PG8_MMA(1, 1, At, B1); PG8_BAR;
            }
        }
        if constexpr (ALIGN_EPI) { if (wr == 0) PG8_BAR; }
        if constexpr (!Epi::AFTER_DRAIN) { int fr_ = fr, fq_ = fq; asm volatile("" : "+v"(fr_), "+v"(fq_));
          E(acc, cur, wr, wc, fr_, fq_); S.done(cur); }
        if (!has_next) break;
#pragma unroll
        for (int a = 0; a < 2; ++a)
#pragma unroll
            for (int b = 0; b < 2; ++b)
#pragma unroll
                for (int m = 0; m < 4; ++m)
#pragma unroll
                    for (int n = 0; n < 2; ++n) acc[a][b][m][n] = (f32x4){0.f, 0.f, 0.f, 0.f};
        cur = nxt; cA = nA; cB = nB; ++ui;
        if constexpr (ALIGN_EPI) { if (wr == 1) PG8_BAR; }
    }
    PG8_WAIT_V(0);
    if constexpr (!ALIGN_EPI) { if (wr == 0) PG8_BAR; }
    PG8_BAR;
    if constexpr (Epi::AFTER_DRAIN) { E.fused(acc, cur, wr, wc, fr, fq, lds, wid, lane); S.done(cur); }
#undef PG8_SA
#undef PG8_SB
#undef PG8_STAGE
#undef PG8_LDA
#undef PG8_LDB
#undef PG8_MMA
#undef PG8_WAIT_V
#undef PG8_WAIT_L
#undef PG8_BAR
#undef PG8_SCHED
}
}

__device__ __forceinline__ int gswz(int row, int chunk) { return row * 128 + ((chunk ^ ((row >> 1) & 7)) << 4); }
__device__ __forceinline__ void gemm_tile(const bf16_t* __restrict__ A, int lda, const bf16_t* __restrict__ Bt, int ldb, int K,
                                          int row0, int col0, unsigned char* lds, f32x16 (&acc)[2][2]) {
  int tid_ = tidx(); asm volatile("" : "+v"(tid_)); const int tid = tid_, lane = tid & 63, wid = tid >> 6, wm = wid >> 1, wn = wid & 1, r32 = lane & 31, hi = lane >> 5;
  unsigned char* As = lds; unsigned char* Bs = lds + 65536;
#pragma unroll
  for (int i = 0; i < 2; ++i)
#pragma unroll
    for (int j = 0; j < 2; ++j) acc[i][j] = f32x16{};
  const int lrow = tid >> 3, lc = tid & 7;
  const bf16_t* Ag = A + (size_t)(row0 + lrow) * lda + lc * 8;
  const bf16_t* Bg = Bt + (size_t)(col0 + lrow) * ldb + lc * 8;
  u32x4 ra[4], rb[2];
#pragma unroll
  for (int i = 0; i < 4; ++i) ra[i] = *(const u32x4*)(Ag + (size_t)(64 * i) * lda);
#pragma unroll
  for (int i = 0; i < 2; ++i) rb[i] = *(const u32x4*)(Bg + (size_t)(64 * i) * ldb);
#pragma unroll
  for (int i = 0; i < 4; ++i) *(u32x4*)(As + gswz(lrow + 64 * i, lc)) = ra[i];
#pragma unroll
  for (int i = 0; i < 2; ++i) *(u32x4*)(Bs + gswz(lrow + 64 * i, lc)) = rb[i];
  __syncthreads();
  const int nk = K / 64;
  for (int kt = 0; kt < nk; ++kt) {
    const int cur = kt & 1;
    if (kt + 1 < nk) {
#pragma unroll
      for (int i = 0; i < 4; ++i) ra[i] = *(const u32x4*)(Ag + (size_t)(64 * i) * lda + (kt + 1) * 64);
#pragma unroll
      for (int i = 0; i < 2; ++i) rb[i] = *(const u32x4*)(Bg + (size_t)(64 * i) * ldb + (kt + 1) * 64);
    }
    const unsigned char* Ac = As + cur * 32768; const unsigned char* Bc = Bs + cur * 16384;
#pragma unroll
    for (int kk = 0; kk < 4; ++kk) {
      bf16x8 af[2], bfr[2];
#pragma unroll
      for (int i = 0; i < 2; ++i) af[i] = *(const bf16x8*)(Ac + gswz(wm * 64 + i * 32 + r32, 2 * kk + hi));
#pragma unroll
      for (int j = 0; j < 2; ++j) bfr[j] = *(const bf16x8*)(Bc + gswz(wn * 64 + j * 32 + r32, 2 * kk + hi));
#pragma unroll
      for (int i = 0; i < 2; ++i)
#pragma unroll
        for (int j = 0; j < 2; ++j) acc[i][j] = __builtin_amdgcn_mfma_f32_32x32x16_bf16(af[i], bfr[j], acc[i][j], 0, 0, 0);
    }
    if (kt + 1 < nk) {
      unsigned char* An = As + (cur ^ 1) * 32768; unsigned char* Bn = Bs + (cur ^ 1) * 16384;
#pragma unroll
      for (int i = 0; i < 4; ++i) *(u32x4*)(An + gswz(lrow + 64 * i, lc)) = ra[i];
#pragma unroll
      for (int i = 0; i < 2; ++i) *(u32x4*)(Bn + gswz(lrow + 64 * i, lc)) = rb[i];
    }
    __syncthreads();
  }
}
__device__ __forceinline__ void pair_xchg(float v0, float v1, int lane, float& lo, float& hi2) {
  const bool odd = lane & 1;
  const float send = odd ? v0 : v1;
  const float recv = dpp_mov<0xB1>(send);
  lo = odd ? recv : v0; hi2 = odd ? v1 : recv;
}

__device__ __forceinline__ void phase_inproj(const Params& p, int l, unsigned char* lds) {
  int tid_ = tidx(); asm volatile("" : "+v"(tid_)); const int tid = tid_, lane = tid & 63, wid = tid >> 6, wm = wid >> 1, wn = wid & 1, r32 = lane & 31, hi = lane >> 5;
  const bf16_t* H = (const bf16_t*)(p.ws + WS_H);
  const bf16_t* W = (const bf16_t*)(p.ws + WS_WIN) + (size_t)l * PW * DM;
  bf16_t* PROJ = (bf16_t*)(p.ws + WS_PROJ);
  const float* RC = (const float*)(p.ws + WS_ROPE); const float* RS = RC + SEQ * 32;
  constexpr int NM = T / 256, NN = PW / 128, NU = NM * NN;
  for (int u = p.bx; u < NU + NM; u += p.gx) {
    if (u < NU) {
      const int pn = u / NM, pm = u % NM;
      const int row0 = pm * 256, col0 = pn * 128;
      f32x16 acc[2][2];
      gemm_tile(H, DM, W, DM, DM, row0, col0, lds, acc);
      const bool rope = (col0 >= C_DQ && col0 < C_DV);
      const float scl = (col0 >= C_MK && col0 < C_MV) ? 0.125f : ((col0 >= C_DQ && col0 < C_DK) ? QSCALE : 1.f);
#pragma unroll
      for (int i = 0; i < 2; ++i)
#pragma unroll
        for (int j = 0; j < 2; ++j)
#pragma unroll
          for (int q = 0; q < 8; ++q) {
            float lo, hi2; pair_xchg(acc[i][j][2 * q], acc[i][j][2 * q + 1], lane, lo, hi2);
            const int row = row0 + wm * 64 + i * 32 + crow(2 * q, hi) + (lane & 1);
            const int col = col0 + wn * 64 + j * 32 + (r32 & ~1);
            if (rope) {
              const int s = row % SEGL;
              if (s >= CTXL) {
                const int idx = (s - CTXL) * 32 + ((col & 63) >> 1);
                const float c = RC[idx], sn = RS[idx];
                const float t1 = lo, t2 = hi2; lo = t1 * c - t2 * sn; hi2 = t1 * sn + t2 * c;
              }
            }
            *(unsigned*)(PROJ + (size_t)row * PW + col) = cvtpk(lo * scl, hi2 * scl);
          }
    } else {
      const int pm = u - NU, rowb = pm * 256 + wid * 32;
      const bf16_t* WG = (const bf16_t*)(p.ws + WS_WG) + (size_t)l * 16 * DM;
      float* GT = (float*)(p.ws + WS_GATES);
      const int r16 = lane & 15, q4 = lane >> 4;
      f32x4 c0 = {0.f, 0.f, 0.f, 0.f}, c1 = {0.f, 0.f, 0.f, 0.f};
      const bf16_t* a0p = H + (size_t)(rowb + r16) * DM + q4 * 8;
      const bf16_t* a1p = a0p + (size_t)16 * DM;
      const bf16_t* bp = WG + (size_t)r16 * DM + q4 * 8;
#pragma unroll 4
      for (int ks = 0; ks < 32; ++ks) {
        const bf16x8 a0 = *(const bf16x8*)(a0p + ks * 32), a1 = *(const bf16x8*)(a1p + ks * 32), b = *(const bf16x8*)(bp + ks * 32);
        c0 = __builtin_amdgcn_mfma_f32_16x16x32_bf16(a0, b, c0, 0, 0, 0);
        c1 = __builtin_amdgcn_mfma_f32_16x16x32_bf16(a1, b, c1, 0, 0, 0);
      }
      const float gb = p.in[I_GATEB][l * 16 + r16];
#pragma unroll
      for (int j = 0; j < 4; ++j) {
        GT[(size_t)(rowb + q4 * 4 + j) * 16 + r16] = c0[j] + gb;
        GT[(size_t)(rowb + 16 + q4 * 4 + j) * 16 + r16] = c1[j] + gb;
      }
    }
  }
}

__device__ __forceinline__ void phase_outproj(const Params& p, int l, unsigned char* lds) {
  int tid_ = tidx(); asm volatile("" : "+v"(tid_)); const int tid = tid_, lane = tid & 63, wid = tid >> 6, wm = wid >> 1, wn = wid & 1, r32 = lane & 31, hi = lane >> 5;
  const bf16_t* MIX = (const bf16_t*)(p.ws + WS_MIX);
  const bf16_t* W = (const bf16_t*)(p.ws + WS_WOUT) + (size_t)l * DM * DM;
  float* XC = (float*)(p.ws + WS_XCUR);
  const float* MOD = (const float*)(p.ws + WS_MOD);
  constexpr int NM = T / 256, NN = DM / 128, NU = NM * NN;
  for (int u = p.bx; u < NU; u += p.gx) {
    const int pm = u / NN, pn = u % NN;
    if (l == DEPTH - 1 && (pm % 33) == 0) continue;
    const int row0 = pm * 256, col0 = pn * 128;
    for (int rep = 0; rep < REP_OUTP; ++rep) {
    f32x16 acc[2][2];
    gemm_tile(MIX, DM, W, DM, DM, row0, col0, lds, acc);
    const int mr = (pm % 33) == 0 ? 4 : pm / 33;
    const float* g1 = MOD + ((size_t)l * 5 + mr) * 6144 + 2048;
#pragma unroll
    for (int i = 0; i < 2; ++i)
#pragma unroll
      for (int j = 0; j < 2; ++j) {
        const int col = col0 + wn * 64 + j * 32 + r32;
        const float gg = (rep == REP_OUTP - 1) ? g1[col] : 0.f;
#pragma unroll
        for (int r = 0; r < 16; ++r) {
          const int row = row0 + wm * 64 + i * 32 + crow(r, hi);
          const float xo = (l == 0) ? in_row(p.in[I_X], p.in[I_CTX], row)[col] : XC[(size_t)row * DM + col];
          XC[(size_t)row * DM + col] = xo + gg * acc[i][j][r];
        }
      }
    }
  }
}
__device__ __forceinline__ void phase_peerq(const Params& p, int l, unsigned char* lds) {
  int tid_ = tidx(); asm volatile("" : "+v"(tid_)); const int tid = tid_, lane = tid & 63, wid = tid >> 6, wm = wid >> 1, wn = wid & 1, r32 = lane & 31, hi = lane >> 5;
  const bf16_t* H = (const bf16_t*)(p.ws + WS_H);
  const bf16_t* W = (const bf16_t*)(p.ws + WS_WQ) + (size_t)l * DM * DM;
  bf16_t* QP = (bf16_t*)(p.ws + WS_PROJ);
  constexpr int NM = T / 256, NN = DM / 128, NU = NM * NN;
  for (int u = p.bx; u < NU; u += p.gx) {
    const int pm = u / NN, pn = u % NN;
    if (l == DEPTH - 1 && (pm % 33) == 0) continue;
    const int row0 = pm * 256, col0 = pn * 128;
    f32x16 acc[2][2];
    gemm_tile(H, DM, W, DM, DM, row0, col0, lds, acc);
#pragma unroll
    for (int i = 0; i < 2; ++i)
#pragma unroll
      for (int j = 0; j < 2; ++j)
#pragma unroll
        for (int q = 0; q < 8; ++q) {
          float lo, hi2; pair_xchg(acc[i][j][2 * q], acc[i][j][2 * q + 1], lane, lo, hi2);
          const int row = row0 + wm * 64 + i * 32 + crow(2 * q, hi) + (lane & 1);
          const int col = col0 + wn * 64 + j * 32 + (r32 & ~1);
          *(unsigned*)(QP + (size_t)row * DM + col) = cvtpk(lo, hi2);
        }
  }
}


struct EpiInproj {
  static constexpr bool PERM = true, AFTER_DRAIN = false;
  bf16_t* PROJ; const float* RC; const float* RS; unsigned char* V8T; float wsc;
  __device__ __forceinline__ void operator()(const pg8::f32x4 (&acc)[2][2][4][2], const pg8::Unit& u, int wr, int wc, int fr, int fq) const {
#pragma unroll
    for (int bj = 0; bj < 2; ++bj) {
      const int colt = u.pn * 256 + bj * 128;
      const bool rope = (colt >= C_DQ && colt < C_DV);
      const float scl = ((colt >= C_MK && colt < C_MV) ? 0.125f : ((colt >= C_DQ && colt < C_DK) ? QSCALE : 1.f)) * wsc;
      const int col8 = colt + wc * 32 + 8 * fq;
      if (colt >= C_DV) {
        const int hh = (col8 - C_DV) >> 7, e0 = (col8 - C_DV) & 127;
#pragma unroll
        for (int ai = 0; ai < 2; ++ai)
#pragma unroll
          for (int m = 0; m < 4; ++m) {
            const int row = u.pm * 256 + ai * 128 + wr * 64 + m * 16 + fr;
            const int b = row / SEGL, s = row - b * SEGL, t = s >> 6, kk = s & 63;
            const int slot = ((kk >> 2) & 1) * 32 + (kk & 3) + 4 * ((kk >> 3) & 3) + 16 * (kk >> 5);
            unsigned char* vp = V8T + ((size_t)((b * 4 + hh) * NCH + t) * 128 + e0) * 80 + slot;
            const f32x4 v0 = acc[ai][bj][m][0] * wsc, v1 = acc[ai][bj][m][1] * wsc;
            int w0 = 0, w1 = 0;
            w0 = __builtin_amdgcn_cvt_pk_fp8_f32(v0[0], v0[1], w0, false); w0 = __builtin_amdgcn_cvt_pk_fp8_f32(v0[2], v0[3], w0, true);
            w1 = __builtin_amdgcn_cvt_pk_fp8_f32(v1[0], v1[1], w1, false); w1 = __builtin_amdgcn_cvt_pk_fp8_f32(v1[2], v1[3], w1, true);
            vp[0] = (unsigned char)(w0 & 0xFF); vp[80] = (unsigned char)((w0 >> 8) & 0xFF); vp[160] = (unsigned char)((w0 >> 16) & 0xFF); vp[240] = (unsigned char)((w0 >> 24) & 0xFF);
            vp[320] = (unsigned char)(w1 & 0xFF); vp[400] = (unsigned char)((w1 >> 8) & 0xFF); vp[480] = (unsigned char)((w1 >> 16) & 0xFF); vp[560] = (unsigned char)((w1 >> 24) & 0xFF);
          }
        continue;
      }
      unsigned char* qk8 = nullptr;
      if (rope) { const int isk = colt >= C_DK, cc = col8 - (isk ? C_DK : C_DQ); qk8 = V8T + (WS_QK8 - WS_V8T) + (size_t)isk * QK8_IMG + (size_t)(cc >> 7) * SEGL * QK8_PITCH + (cc & 127); }
#pragma unroll
      for (int ai = 0; ai < 2; ++ai)
#pragma unroll
        for (int m = 0; m < 4; ++m) {
          const int row = u.pm * 256 + ai * 128 + wr * 64 + m * 16 + fr;
          f32x4 v0 = acc[ai][bj][m][0], v1 = acc[ai][bj][m][1];
          if (rope) {
            const int s = row % SEGL;
            if (s >= CTXL) {
              const int idx = (s - CTXL) * 32 + ((col8 & 63) >> 1);
              const f32x4 c = *(const f32x4*)(RC + idx), sn = *(const f32x4*)(RS + idx);
              f32x4 a, b;
              a[0] = v0[0] * c[0] - v0[1] * sn[0]; a[1] = v0[0] * sn[0] + v0[1] * c[0]; a[2] = v0[2] * c[1] - v0[3] * sn[1]; a[3] = v0[2] * sn[1] + v0[3] * c[1];
              b[0] = v1[0] * c[2] - v1[1] * sn[2]; b[1] = v1[0] * sn[2] + v1[1] * c[2]; b[2] = v1[2] * c[3] - v1[3] * sn[3]; b[3] = v1[2] * sn[3] + v1[3] * c[3];
              v0 = a; v1 = b;
            }
          }
          if (rope) {
            const int b = row / SEGL, s = row - b * SEGL;
            int w0, w1; asm volatile("" : "=v"(w0), "=v"(w1));
            w0 = __builtin_amdgcn_cvt_pk_fp8_f32(v0[0] * scl, v0[1] * scl, w0, false); w0 = __builtin_amdgcn_cvt_pk_fp8_f32(v0[2] * scl, v0[3] * scl, w0, true);
            w1 = __builtin_amdgcn_cvt_pk_fp8_f32(v1[0] * scl, v1[1] * scl, w1, false); w1 = __builtin_amdgcn_cvt_pk_fp8_f32(v1[2] * scl, v1[3] * scl, w1, true);
            *(u32x2*)(qk8 + ((size_t)b * 4 * SEGL + s) * QK8_PITCH) = (u32x2){(unsigned)w0, (unsigned)w1};
            __builtin_amdgcn_sched_barrier(0);
            continue;
          }
          u32x4 w; w.x = cvtpk(v0[0] * scl, v0[1] * scl); w.y = cvtpk(v0[2] * scl, v0[3] * scl); w.z = cvtpk(v1[0] * scl, v1[1] * scl); w.w = cvtpk(v1[2] * scl, v1[3] * scl);
          *(u32x4*)(PROJ + (size_t)row * PW + col8) = w;
        }
    }
  }
};
struct EpiOutproj {
  static constexpr bool PERM = true, AFTER_DRAIN = false;
  float* XC; const float* MODL; const float* xin; const float* ctxin; int first; float gsc;
  __device__ __forceinline__ void operator()(const pg8::f32x4 (&acc)[2][2][4][2], const pg8::Unit& u, int wr, int wc, int fr, int fq) const {
    const int mr = (u.pm % 33) == 0 ? 4 : u.pm / 33;
    const float* g1 = MODL + (size_t)mr * 6144 + 2048;
#pragma unroll
    for (int bj = 0; bj < 2; ++bj) {
      const int col8 = u.pn * 256 + bj * 128 + wc * 32 + 8 * fq;
      const f32x4 ga = *(const f32x4*)(g1 + col8) * gsc, gb = *(const f32x4*)(g1 + col8 + 4) * gsc;
#pragma unroll
      for (int ai = 0; ai < 2; ++ai)
#pragma unroll
        for (int m = 0; m < 4; ++m) {
          const int row = u.pm * 256 + ai * 128 + wr * 64 + m * 16 + fr;
          const float* xo = first ? in_row(xin, ctxin, row) + col8 : XC + (size_t)row * DM + col8;
          const f32x4 xa = *(const f32x4*)xo, xb = *(const f32x4*)(xo + 4);
          *(f32x4*)(XC + (size_t)row * DM + col8) = xa + ga * acc[ai][bj][m][0];
          *(f32x4*)(XC + (size_t)row * DM + col8 + 4) = xb + gb * acc[ai][bj][m][1];
        }
    }
  }
};
struct EpiPeerq {
  static constexpr bool PERM = true, AFTER_DRAIN = false;
  bf16_t* QP;
  __device__ __forceinline__ void operator()(const pg8::f32x4 (&acc)[2][2][4][2], const pg8::Unit& u, int wr, int wc, int fr, int fq) const {
#pragma unroll
    for (int bj = 0; bj < 2; ++bj) {
      const int col8 = u.pn * 256 + bj * 128 + wc * 32 + 8 * fq;
#pragma unroll
      for (int ai = 0; ai < 2; ++ai)
#pragma unroll
        for (int m = 0; m < 4; ++m) {
          const int row = u.pm * 256 + ai * 128 + wr * 64 + m * 16 + fr;
          const f32x4 v0 = acc[ai][bj][m][0], v1 = acc[ai][bj][m][1];
          u32x4 w; w.x = cvtpk(v0[0], v0[1]); w.y = cvtpk(v0[2], v0[3]); w.z = cvtpk(v1[0], v1[1]); w.w = cvtpk(v1[2], v1[3]);
          *(u32x4*)(QP + (size_t)row * DM + col8) = w;
        }
    }
  }
};
__device__ __forceinline__ void phase_inproj2(const Params& p, int l, unsigned char* lds) {
  {
    pg8::Gemm g{(const bf16_t*)(p.ws + WS_H8), (const bf16_t*)(p.ws + WS_W8 + (size_t)l * PW * DM), T, PW, DM / 2};
    pg8::F8Order S; S.init(T, p.gx, p.bx, 0, 12, 0);
    EpiInproj E{(bf16_t*)(p.ws + WS_PROJ), (const float*)(p.ws + WS_ROPE), (const float*)(p.ws + WS_ROPE) + SEQ * 32, p.ws + WS_V8T, 1.f / 32.f};
    pg8::gemm_phase<EpiInproj, pg8::F8Order, true, true, true>((PG8_LAS unsigned char*)lds, g, S, E);
  }
  int tid_ = tidx(); asm volatile("" : "+v"(tid_)); const int tid = tid_, lane = tid & 63, wid = tid >> 6;
  const bf16_t* H = (const bf16_t*)(p.ws + WS_H);
  for (int pm = p.gx - 1 - p.bx; pm < T / 256; pm += p.gx) {
    const int rowb = pm * 256 + wid * 32;
    const bf16_t* WG = (const bf16_t*)(p.ws + WS_WG) + (size_t)l * 16 * DM;
    float* GT = (float*)(p.ws + WS_GATES);
    const int r16 = lane & 15, q4 = lane >> 4;
    f32x4 c0 = {0.f, 0.f, 0.f, 0.f}, c1 = {0.f, 0.f, 0.f, 0.f};
    const bf16_t* a0p = H + (size_t)(rowb + r16) * DM + q4 * 8;
    const bf16_t* a1p = a0p + (size_t)16 * DM;
    const bf16_t* bp = WG + (size_t)r16 * DM + q4 * 8;
#pragma unroll 4
    for (int ks = 0; ks < 32; ++ks) {
      const bf16x8 a0 = *(const bf16x8*)(a0p + ks * 32), a1 = *(const bf16x8*)(a1p + ks * 32), b = *(const bf16x8*)(bp + ks * 32);
      c0 = __builtin_amdgcn_mfma_f32_16x16x32_bf16(a0, b, c0, 0, 0, 0);
      c1 = __builtin_amdgcn_mfma_f32_16x16x32_bf16(a1, b, c1, 0, 0, 0);
    }
    const float gb = p.in[I_GATEB][l * 16 + r16];
#pragma unroll
    for (int j = 0; j < 4; ++j) {
      GT[(size_t)(rowb + q4 * 4 + j) * 16 + r16] = c0[j] + gb;
      GT[(size_t)(rowb + 16 + q4 * 4 + j) * 16 + r16] = c1[j] + gb;
    }
  }
}
__device__ __forceinline__ void phase_outproj2(const Params& p, int l, unsigned char* lds) {
  pg8::Gemm g{(const bf16_t*)(p.ws + WS_MIX), (const bf16_t*)(p.ws + WS_WOUT) + (size_t)l * DM * DM, T, DM, DM};
  pg8::StaticOrder S; S.init(T, DM, p.gx, p.bx);
  for (int rep = 0; rep < REP_OUTP; ++rep) {
  EpiOutproj E{(float*)(p.ws + WS_XCUR), (const float*)(p.ws + WS_MOD) + (size_t)l * 5 * 6144, p.in[I_X], p.in[I_CTX], l == 0, (rep == REP_OUTP - 1) ? 1.f : 0.f};
  pg8::gemm_phase<EpiOutproj, pg8::StaticOrder, true, true>((PG8_LAS unsigned char*)lds, g, S, E);
  }
  tail_filler_tables(p, l, (T / 256) * (DM / 256), l == 0 ? 0 : NEXP, 2 * NEXP);
}
__device__ __forceinline__ void phase_peerq2(const Params& p, int l, unsigned char* lds) {
  pg8::Gemm g{(const bf16_t*)(p.ws + WS_H), (const bf16_t*)(p.ws + WS_WQ) + (size_t)l * DM * DM, T, DM, DM};
  pg8::StaticOrder S; S.init(T, DM, p.gx, p.bx);
  EpiPeerq E{(bf16_t*)(p.ws + WS_PROJ)};
  pg8::gemm_phase<EpiPeerq, pg8::StaticOrder, true, true>((PG8_LAS unsigned char*)lds, g, S, E);
  if (l < DEPTH - 1) tail_filler_tables(p, l + 1, (T / 256) * (DM / 256), 0, NEXP);
}

__device__ __forceinline__ void conv_unit(const Params& p, int l, int unit, unsigned char* lds) {
  int tid_ = tidx(); asm volatile("" : "+v"(tid_)); const int tid = tid_, lane = tid & 63, wid = tid >> 6;
  float* U = (float*)lds;
  const bf16_t* PROJ = (const bf16_t*)(p.ws + WS_PROJ);
  bf16_t* MIX = (bf16_t*)(p.ws + WS_MIX);
  const int row0 = unit * 32, b = row0 / SEGL, s0 = row0 - b * SEGL;
  const int seglo = s0 < CTXL ? 0 : CTXL, seghi = s0 < CTXL ? CTXL : SEGL;
  for (int rr = tid >> 5; rr < 62; rr += 16) {
    const int s = s0 - 15 + rr, c8 = (tid & 31) * 8;
    f32x4 u0 = {0.f, 0.f, 0.f, 0.f}, u1 = {0.f, 0.f, 0.f, 0.f};
    if (s >= seglo && s < seghi) {
      const bf16_t* pr = PROJ + (size_t)(b * SEGL + s) * PW + c8;
      const u32x4 a1 = *(const u32x4*)pr, a2 = *(const u32x4*)(pr + 256);
      u0.x = bflo(a1.x) * sigmoidf_(bflo(a2.x)); u0.y = bfhi(a1.x) * sigmoidf_(bfhi(a2.x));
      u0.z = bflo(a1.y) * sigmoidf_(bflo(a2.y)); u0.w = bfhi(a1.y) * sigmoidf_(bfhi(a2.y));
      u1.x = bflo(a1.z) * sigmoidf_(bflo(a2.z)); u1.y = bfhi(a1.z) * sigmoidf_(bfhi(a2.z));
      u1.z = bflo(a1.w) * sigmoidf_(bflo(a2.w)); u1.w = bfhi(a1.w) * sigmoidf_(bfhi(a2.w));
    }
    *(f32x4*)(U + rr * 256 + c8) = u0; *(f32x4*)(U + rr * 256 + c8 + 4) = u1;
  }
  __syncthreads();
  float* Y = U + 62 * 256;
  const float* cw = p.in[I_CONVW] + (size_t)l * 31 * 256;
#pragma unroll 1
  for (int q = 0; q < 4; ++q) {
    const int c = lane + 64 * q;
    float w[31];
#pragma unroll
    for (int j = 0; j < 31; ++j) w[j] = cw[j * 256 + c];
    const float bias = p.in[I_CONVB][l * 256 + c];
#pragma unroll
    for (int tt = 0; tt < 4; ++tt) {
      const int t = wid * 4 + tt;
      float a = bias;
#pragma unroll
      for (int j = 0; j < 31; ++j) a += U[(t + j) * 256 + c] * w[j];
      Y[t * 256 + c] = a;
    }
  }
  asm volatile("s_waitcnt lgkmcnt(0)" ::: "memory");
  float y[4][4];
#pragma unroll
  for (int tt = 0; tt < 4; ++tt)
#pragma unroll
    for (int q = 0; q < 4; ++q) y[tt][q] = Y[(wid * 4 + tt) * 256 + lane + 64 * q];
#pragma unroll
  for (int tt = 0; tt < 4; ++tt) {
    const int t = wid * 4 + tt;
    const float mean = wave_sum((y[tt][0] + y[tt][1]) + (y[tt][2] + y[tt][3])) * (1.f / 256.f);
    float v = 0.f;
#pragma unroll
    for (int q = 0; q < 4; ++q) { const float d = y[tt][q] - mean; v += d * d; }
    const float rs = rsqrtf(wave_sum(v) * (1.f / 256.f) + EPS);
#pragma unroll
    for (int q = 0; q < 4; ++q) {
      const int c = lane + 64 * q;
      const float z = (y[tt][q] - mean) * rs * p.in[I_CLNG][l * 256 + c] + p.in[I_CLNB][l * 256 + c];
      const float o = (ABL & 1) ? 0.f : z * sigmoidf_(z);
      MIX[(size_t)(row0 + t) * DM + c] = (bf16_t)(cvtpk(o, 0.f) & 0xffffu);
    }
  }
  __syncthreads();
}

__device__ __forceinline__ int ml_cidx(int ch, int dir) { return dir == 0 ? ch : (ch < 4 ? 3 - ch : 135 - ch); }
__device__ __forceinline__ void ml_load_tile(const bf16_t* src, float* dst, int tid) {
  const int r = tid >> 3, c8 = (tid & 7) * 8;
  const u32x4 a = *(const u32x4*)(src + (size_t)r * PW + c8);
  float* d = dst + r * 65 + c8;
  d[0] = bflo(a.x); d[1] = bfhi(a.x); d[2] = bflo(a.y); d[3] = bfhi(a.y); d[4] = bflo(a.z); d[5] = bfhi(a.z); d[6] = bflo(a.w); d[7] = bfhi(a.w);
}
__device__ __forceinline__ void ml_local_unit(const Params& p, int l, int unit, unsigned char* lds) {
  int tid_ = tidx(); asm volatile("" : "+v"(tid_)); const int tid = tid_, lane = tid & 63, wid = tid >> 6, r32 = lane & 31, hi = lane >> 5;
  float* Kt = (float*)lds; float* Vt = Kt + 64 * 65; float* WK = Vt + 64 * 65;
  const bf16_t* PROJ = (const bf16_t*)(p.ws + WS_PROJ);
  const float* GT = (const float*)(p.ws + WS_GATES);
  float* UL = (float*)(p.ws + WS_ULOC); float* META = (float*)(p.ws + WS_MLMETA);
  const int b = unit / (4 * NCH), hh = (unit / NCH) & 3, ch = unit % NCH;
  const int row0 = b * SEGL + ch * 64;
  ml_load_tile(PROJ + (size_t)row0 * PW + C_MK + hh * 64, Kt, tid);
  ml_load_tile(PROJ + (size_t)row0 * PW + C_MV + hh * 64, Vt, tid);
  if (wid < 2) {
    const int dir = wid;
    const float ig = GT[(size_t)(row0 + lane) * 16 + (2 * dir) * 4 + hh];
    const float lf = logsigmoidf_(GT[(size_t)(row0 + lane) * 16 + (2 * dir + 1) * 4 + hh]);
    float ps = lf;
    ps = wave_incl_scan(ps);
    const float tot = __uint_as_float((unsigned)__builtin_amdgcn_readlane((int)__float_as_uint(ps), 63));
    const float wlog = dir == 0 ? (tot - ps + ig) : (ps - lf + ig);
    const float mloc = wave_max(wlog);
    WK[dir * 64 + lane] = __expf(wlog - mloc);
    if (lane == 0) {
      const int seq = (b * 4 + hh) * 2 + dir, ci = ml_cidx(ch, dir);
      META[((size_t)seq * NCH + ci) * 4 + 0] = tot; META[((size_t)seq * NCH + ci) * 4 + 1] = mloc;
    }
  }
  __syncthreads();
  {
    const int dir = wid >> 2, et = (wid >> 1) & 1, dt = wid & 1;
    const int seq = (b * 4 + hh) * 2 + dir, ci = ml_cidx(ch, dir);
    float* slot = UL + ((size_t)seq * NCH + ci) * USTRIDE;
    f32x16 acc = {};
#pragma unroll 8
    for (int ks = 0; ks < 32; ++ks) {
      const int s = 2 * ks + hi;
      const float a = WK[dir * 64 + s] * Vt[s * 65 + et * 32 + r32];
      const float bb = Kt[s * 65 + dt * 32 + r32];
      acc = __builtin_amdgcn_mfma_f32_32x32x2f32(a, bb, acc, 0, 0, 0);
    }
#pragma unroll
    for (int r = 0; r < 16; ++r) slot[(et * 32 + crow(r, hi)) * 64 + dt * 32 + r32] = acc[r];
    if (et == 0) {
      float n = 0.f;
#pragma unroll 8
      for (int i = 0; i < 32; ++i) { const int s = hi * 32 + i; n += WK[dir * 64 + s] * Kt[s * 65 + dt * 32 + r32]; }
      n = sum_xor32(n);
      if (hi == 0) slot[4096 + dt * 32 + r32] = n;
    }
  }
  __syncthreads();
}
constexpr int MLP = 144;
constexpr size_t WS_CST = WS_H;
constexpr size_t WS_NST = WS_H + (size_t)32 * NCH * 4096 * 2;
__device__ __forceinline__ void ml_stage_rm(const bf16_t* src, size_t ld, unsigned char* dst, int tid) {
  const int r = tid >> 3, c8 = (tid & 7) * 8;
  *(u32x4*)(dst + r * MLP + c8 * 2) = *(const u32x4*)(src + (size_t)r * ld + c8);
}
__device__ __forceinline__ void ml_stage_tr(const bf16_t* src, size_t ld, unsigned char* dst, int tid) {
  const int r = tid >> 3, c8 = (tid & 7) * 8;
  const u32x4 a = *(const u32x4*)(src + (size_t)r * ld + c8);
  bf16_t* d = (bf16_t*)dst;
  d[(c8 + 0) * 72 + r] = (bf16_t)(a.x & 0xffffu); d[(c8 + 1) * 72 + r] = (bf16_t)(a.x >> 16);
  d[(c8 + 2) * 72 + r] = (bf16_t)(a.y & 0xffffu); d[(c8 + 3) * 72 + r] = (bf16_t)(a.y >> 16);
  d[(c8 + 4) * 72 + r] = (bf16_t)(a.z & 0xffffu); d[(c8 + 5) * 72 + r] = (bf16_t)(a.z >> 16);
  d[(c8 + 6) * 72 + r] = (bf16_t)(a.w & 0xffffu); d[(c8 + 7) * 72 + r] = (bf16_t)(a.w >> 16);
}
__device__ __forceinline__ void ml_local_unit2(const Params& p, int l, int unit, unsigned char* lds) {
  int tid_ = tidx(); asm volatile("" : "+v"(tid_)); const int tid = tid_, lane = tid & 63, wid = tid >> 6, r32 = lane & 31, hi = lane >> 5;
  unsigned char* KT = lds; unsigned char* VT = lds + 64 * MLP; float* WK = (float*)(lds + 2 * 64 * MLP);
  const bf16_t* PROJ = (const bf16_t*)(p.ws + WS_PROJ);
  const float* GT = (const float*)(p.ws + WS_GATES);
  float* UL = (float*)(p.ws + WS_ULOC); float* META = (float*)(p.ws + WS_MLMETA);
  const int b = unit / (4 * NCH), hh = (unit / NCH) & 3, ch = unit % NCH;
  const int row0 = b * SEGL + ch * 64;
  ml_stage_tr(PROJ + (size_t)row0 * PW + C_MK + hh * 64, PW, KT, tid);
  ml_stage_tr(PROJ + (size_t)row0 * PW + C_MV + hh * 64, PW, VT, tid);
  if (wid < 2) {
    const int dir = wid;
    const float ig = GT[(size_t)(row0 + lane) * 16 + (2 * dir) * 4 + hh];
    const float lf = logsigmoidf_(GT[(size_t)(row0 + lane) * 16 + (2 * dir + 1) * 4 + hh]);
    float ps = lf;
    ps = wave_incl_scan(ps);
    const float tot = __uint_as_float((unsigned)__builtin_amdgcn_readlane((int)__float_as_uint(ps), 63));
    const float wlog = dir == 0 ? (tot - ps + ig) : (ps - lf + ig);
    const float mloc = wave_max(wlog);
    WK[dir * 64 + lane] = __expf(wlog - mloc);
    if (lane == 0) {
      const int seq = (b * 4 + hh) * 2 + dir, ci = ml_cidx(ch, dir);
      META[((size_t)seq * NCH + ci) * 4 + 0] = tot; META[((size_t)seq * NCH + ci) * 4 + 1] = mloc;
    }
  }
  __syncthreads();
  {
    const int dir = wid >> 2, et = (wid >> 1) & 1, dt = wid & 1;
    const int seq = (b * 4 + hh) * 2 + dir, ci = ml_cidx(ch, dir);
    float* slot = UL + ((size_t)seq * NCH + ci) * USTRIDE;
    f32x16 acc = {};
#pragma unroll
    for (int ks = 0; ks < 4; ++ks) {
      const int s0 = ks * 16 + hi * 8;
      const u32x4 va = *(const u32x4*)(VT + (et * 32 + r32) * MLP + s0 * 2);
      const bf16x8 kb = *(const bf16x8*)(KT + (dt * 32 + r32) * MLP + s0 * 2);
      const f32x4 w0 = *(const f32x4*)(WK + dir * 64 + s0), w1 = *(const f32x4*)(WK + dir * 64 + s0 + 4);
      u32x4 sa; sa.x = cvtpk(bflo(va.x) * w0.x, bfhi(va.x) * w0.y); sa.y = cvtpk(bflo(va.y) * w0.z, bfhi(va.y) * w0.w);
      sa.z = cvtpk(bflo(va.z) * w1.x, bfhi(va.z) * w1.y); sa.w = cvtpk(bflo(va.w) * w1.z, bfhi(va.w) * w1.w);
      acc = __builtin_amdgcn_mfma_f32_32x32x16_bf16(*(const bf16x8*)&sa, kb, acc, 0, 0, 0);
    }
#pragma unroll
    for (int r = 0; r < 16; ++r) slot[(et * 32 + crow(r, hi)) * 64 + dt * 32 + r32] = acc[r];
    if (et == 0) {
      float n = 0.f;
#pragma unroll
      for (int i = 0; i < 4; ++i) {
        const int s0 = hi * 32 + i * 8;
        const u32x4 ka = *(const u32x4*)(KT + (dt * 32 + r32) * MLP + s0 * 2);
        const f32x4 w0 = *(const f32x4*)(WK + dir * 64 + s0), w1 = *(const f32x4*)(WK + dir * 64 + s0 + 4);
        n += bflo(ka.x) * w0.x + bfhi(ka.x) * w0.y + bflo(ka.y) * w0.z + bfhi(ka.y) * w0.w + bflo(ka.z) * w1.x + bfhi(ka.z) * w1.y + bflo(ka.w) * w1.z + bfhi(ka.w) * w1.w;
      }
      n = sum_xor32(n);
      if (hi == 0) slot[4096 + dt * 32 + r32] = n;
    }
  }
  __syncthreads();
}
__device__ __forceinline__ void ml_scan(const Params& p, unsigned char* lds) {
  float* UL = (float*)(p.ws + WS_ULOC); float* META = (float*)(p.ws + WS_MLMETA);
  int tid_ = tidx(); asm volatile("" : "+v"(tid_));
  const int tid = tid_, lane = tid & 63, wid = tid >> 6;
  float* DEC = (float*)lds;
  float* SCL = DEC + 2 * NCH;
  float* TMP = SCL + 2 * NCH;
  constexpr int NSL = (32 * USTRIDE + 511) / 512;
  const int first_ = p.gx > 64 ? 16 : 0, nb_ = p.gx - first_;
  for (int k_ = 0; k_ < 2 + (NSL + nb_ - 1) / nb_; ++k_) {
    int s_;
    if (k_ == 0) s_ = p.bx >= first_ ? p.bx - first_ : -1;
    else s_ = k_ * nb_ + (p.gx - 1 - p.bx);
    if (k_ > 0 && p.gx - 1 - p.bx >= nb_) s_ = -1;
    if (s_ < 0 || s_ >= NSL) continue;
    const int base0 = s_ * 512;
    const int seq0 = base0 / USTRIDE;
    if (wid < 2) {
      const int seq = seq0 + wid;
      if (seq < 32) {
        float* mt = META + (size_t)seq * NCH * 4;
        for (int c = lane; c < NCH; c += 64) { TMP[(wid * 2 + 0) * NCH + c] = mt[c * 4 + 0]; TMP[(wid * 2 + 1) * NCH + c] = mt[c * 4 + 1]; }
        asm volatile("s_waitcnt lgkmcnt(0)" ::: "memory");
        if (lane == 0) {
          float m = 0.f;
          for (int c = 0; c < NCH; ++c) {
            const float bl = TMP[(wid * 2 + 0) * NCH + c], mloc = TMP[(wid * 2 + 1) * NCH + c];
            const float mn = fmaxf(bl + m, mloc);
            DEC[wid * NCH + c] = __expf(bl + m - mn); SCL[wid * NCH + c] = __expf(mloc - mn);
            mt[c * 4 + 2] = m;
            m = mn;
          }
        }
      }
    }
    __syncthreads();
    const int idx = base0 + tid;
    if (idx < 32 * USTRIDE) {
      const int seq = idx / USTRIDE, e = idx - seq * USTRIDE, sl = seq - seq0;
      float* bp = UL + (size_t)seq * NCH * USTRIDE + e;
      bf16_t* CSTp = (bf16_t*)(p.ws + WS_CST) + (size_t)seq * NCH * 4096 + (e < 4096 ? e : 0);
      float* NSTp = (float*)(p.ws + WS_NST) + (size_t)seq * NCH * 64 + (e < 4096 ? 0 : e - 4096);
      const float* dec = DEC + sl * NCH; const float* scl = SCL + sl * NCH;
      float C = 0.f;
      constexpr int BT = 33;
      static_assert(NCH == 4 * BT, "scan batches");
      float ua[BT], ub[BT];
#define SCAN_LD(u_, c0_) _Pragma("unroll") for (int j = 0; j < BT; ++j) u_[j] = bp[(size_t)((c0_) + j) * USTRIDE];
#define SCAN_DO(u_, c0_) _Pragma("unroll") for (int j = 0; j < BT; ++j) { \
          if (e < 4096) CSTp[(size_t)((c0_) + j) * 4096] = (bf16_t)(cvtpk(C, 0.f) & 0xffffu); else NSTp[(size_t)((c0_) + j) * 64] = C; \
          C = dec[(c0_) + j] * C + scl[(c0_) + j] * u_[j]; }
      SCAN_LD(ua, 0)
#pragma unroll 1
      for (int c0 = 0; c0 < NCH; c0 += 2 * BT) {
        SCAN_LD(ub, c0 + BT)
        SCAN_DO(ua, c0)
        if (c0 + 2 * BT < NCH) { SCAN_LD(ua, c0 + 2 * BT) }
        SCAN_DO(ub, c0 + BT)
      }
#undef SCAN_LD
#undef SCAN_DO
    }
    __syncthreads();
  }
}
__device__ __forceinline__ void ml_out_unit(const Params& p, int l, int unit, unsigned char* lds) {
  int tid_ = tidx(); asm volatile("" : "+v"(tid_)); const int tid = tid_, lane = tid & 63, wid = tid >> 6, r32 = lane & 31, hi = lane >> 5;
  float* Qt = (float*)lds; float* Kt = Qt + 64 * 65; float* Vt = Kt + 64 * 65;
  float* Cs = Vt + 64 * 65;
  float* Ns = Cs + 2 * 64 * 65;
  float* Bq = Ns + 128;
  float* Gs = Bq + 128;
  float* Mi = Gs + 128;
  float* HB = Mi + 64;
  const bf16_t* PROJ = (const bf16_t*)(p.ws + WS_PROJ);
  const float* GT = (const float*)(p.ws + WS_GATES);
  const float* UL = (const float*)(p.ws + WS_ULOC); const float* META = (const float*)(p.ws + WS_MLMETA);
  bf16_t* MIX = (bf16_t*)(p.ws + WS_MIX);
  const int b = unit / (4 * NCH), hh = (unit / NCH) & 3, ch = unit % NCH;
  const int row0 = b * SEGL + ch * 64;
  ml_load_tile(PROJ + (size_t)row0 * PW + C_MQ + hh * 64, Qt, tid);
  ml_load_tile(PROJ + (size_t)row0 * PW + C_MK + hh * 64, Kt, tid);
  ml_load_tile(PROJ + (size_t)row0 * PW + C_MV + hh * 64, Vt, tid);
  for (int i = tid; i < 2 * USTRIDE; i += 512) {
    const int dir = i / USTRIDE, e = i - dir * USTRIDE;
    const int seq = (b * 4 + hh) * 2 + dir, ci = ml_cidx(ch, dir);
    const float v = UL[((size_t)seq * NCH + ci) * USTRIDE + e];
    if (e < 4096) Cs[dir * 64 * 65 + (e >> 6) * 65 + (e & 63)] = v; else Ns[dir * 64 + (e - 4096)] = v;
  }
  if (wid < 2) {
    const int dir = wid;
    const float ig = GT[(size_t)(row0 + lane) * 16 + (2 * dir) * 4 + hh];
    const float lf = logsigmoidf_(GT[(size_t)(row0 + lane) * 16 + (2 * dir + 1) * 4 + hh]);
    float ps = lf;
    ps = wave_incl_scan(ps);
    const float tot = __uint_as_float((unsigned)__builtin_amdgcn_readlane((int)__float_as_uint(ps), 63));
    const float bc = dir == 0 ? ps : (tot - ps + lf);
    Bq[dir * 64 + lane] = bc; Gs[dir * 64 + lane] = ig - bc;
    if (lane == 0) { const int seq = (b * 4 + hh) * 2 + dir, ci = ml_cidx(ch, dir); Mi[dir] = META[((size_t)seq * NCH + ci) * 4 + 2]; }
  }
  __syncthreads();
  {
    const int dir = wid >> 2, tt = (wid >> 1) & 1, et = wid & 1;
    const int t = tt * 32 + r32;
    f32x16 sa[2] = {};
#pragma unroll 4
    for (int ks = 0; ks < 32; ++ks) {
      const float bq = Qt[t * 65 + 2 * ks + hi];
      const float a0 = Kt[(r32) * 65 + 2 * ks + hi], a1 = Kt[(32 + r32) * 65 + 2 * ks + hi];
      sa[0] = __builtin_amdgcn_mfma_f32_32x32x2f32(a0, bq, sa[0], 0, 0, 0);
      sa[1] = __builtin_amdgcn_mfma_f32_32x32x2f32(a1, bq, sa[1], 0, 0, 0);
    }
    const float bt = Bq[dir * 64 + t];
    const float inter = bt + Mi[dir];
    float mx = -INFINITY;
    f32x16 dl[2];
#pragma unroll
    for (int st = 0; st < 2; ++st)
#pragma unroll
      for (int r = 0; r < 16; ++r) {
        const int s = st * 32 + crow(r, hi);
        const bool ok = dir == 0 ? (s <= t) : (s >= t);
        const float d = ok ? bt + Gs[dir * 64 + s] : -INFINITY;
        dl[st][r] = d; mx = fmaxf(mx, d);
      }
    mx = max_xor32(mx);
    const float mt = fmaxf(inter, mx);
    const float iw = __expf(inter - mt);
    float rsum = 0.f;
#pragma unroll
    for (int st = 0; st < 2; ++st)
#pragma unroll
      for (int r = 0; r < 16; ++r) { const float w = __expf(dl[st][r] - mt); sa[st][r] *= w; rsum += sa[st][r]; }
    rsum = sum_xor32(rsum);
    float qn = 0.f;
#pragma unroll 8
    for (int i = 0; i < 32; ++i) { const int d = hi * 32 + i; qn += Ns[dir * 64 + d] * Qt[t * 65 + d]; }
    qn = sum_xor32(qn);
    const float den = rsum + iw * qn;
    const float rden = 1.f / fmaxf(fabsf(den), __expf(-mt));
    f32x16 an = {}, ac = {};
#pragma unroll
    for (int st = 0; st < 2; ++st)
#pragma unroll
      for (int r = 0; r < 16; ++r) {
        const float a = Vt[(st * 32 + crow(r, hi)) * 65 + et * 32 + r32];
        an = __builtin_amdgcn_mfma_f32_32x32x2f32(a, sa[st][r], an, 0, 0, 0);
      }
    const float* Cd = Cs + dir * 64 * 65;
#pragma unroll 4
    for (int ks = 0; ks < 32; ++ks) {
      const float a = Cd[(et * 32 + r32) * 65 + 2 * ks + hi];
      const float bq = Qt[t * 65 + 2 * ks + hi];
      ac = __builtin_amdgcn_mfma_f32_32x32x2f32(a, bq, ac, 0, 0, 0);
    }
#pragma unroll
    for (int r = 0; r < 16; ++r) HB[dir * 64 * 65 + t * 65 + et * 32 + crow(r, hi)] = (an[r] + iw * ac[r]) * rden;
  }
  __syncthreads();
  {
    const int t = tid >> 3, e8 = (tid & 7) * 8;
    float v[8]; float ss = 0.f;
#pragma unroll
    for (int i = 0; i < 8; ++i) { v[i] = HB[t * 65 + e8 + i] + HB[64 * 65 + t * 65 + e8 + i]; ss += v[i] * v[i]; }
    ss += dpp_mov<0xB1>(ss); ss += dpp_mov<0x4E>(ss); ss += dpp_mov<0x141>(ss);
    const float rs = rsqrtf(ss * (1.f / 64.f) + EPS);
    const u32x4 ov = *(const u32x4*)(PROJ + (size_t)(row0 + t) * PW + C_MO + hh * 64 + e8);
    const float og[8] = {bflo(ov.x), bfhi(ov.x), bflo(ov.y), bfhi(ov.y), bflo(ov.z), bfhi(ov.z), bflo(ov.w), bfhi(ov.w)};
    const float* g = p.in[I_MNORMG] + l * 64 + e8;
    float o[8];
#pragma unroll
    for (int i = 0; i < 8; ++i) o[i] = (ABL & 2) ? 0.f : v[i] * rs * g[i] * sigmoidf_(og[i]);
    u32x4 w; w.x = cvtpk(o[0], o[1]); w.y = cvtpk(o[2], o[3]); w.z = cvtpk(o[4], o[5]); w.w = cvtpk(o[6], o[7]);
    *(u32x4*)(MIX + (size_t)(row0 + t) * DM + 256 + hh * 64 + e8) = w;
  }
  __syncthreads();
}


struct MlOutPf { u32x4 q, k, v, c0, c1, ov; float ns0, ns1, g_ig, g_lf, mi; };
__device__ __forceinline__ void ml_out_fetch(const Params& p, int unit, int tid, MlOutPf& f) {
  const int lane = tid & 63, wid = tid >> 6;
  const bf16_t* PROJ = (const bf16_t*)(p.ws + WS_PROJ);
  const float* GT = (const float*)(p.ws + WS_GATES);
  const bf16_t* CST = (const bf16_t*)(p.ws + WS_CST); const float* NST = (const float*)(p.ws + WS_NST); const float* META = (const float*)(p.ws + WS_MLMETA);
  const int b = unit / (4 * NCH), hh = (unit / NCH) & 3, ch = unit % NCH;
  const int row0 = b * SEGL + ch * 64;
  const int r = tid >> 3, c8 = (tid & 7) * 8;
  const bf16_t* prow = PROJ + (size_t)(row0 + r) * PW + hh * 64 + c8;
  f.q = *(const u32x4*)(prow + C_MQ); f.k = *(const u32x4*)(prow + C_MK); f.v = *(const u32x4*)(prow + C_MV); f.ov = *(const u32x4*)(prow + C_MO);
  const int seq0 = (b * 4 + hh) * 2, ci0 = ml_cidx(ch, 0), ci1 = ml_cidx(ch, 1);
  f.c0 = *(const u32x4*)(CST + ((size_t)seq0 * NCH + ci0) * 4096 + r * 64 + c8);
  f.c1 = *(const u32x4*)(CST + ((size_t)(seq0 + 1) * NCH + ci1) * 4096 + r * 64 + c8);
  f.ns0 = 0.f; f.ns1 = 0.f; f.g_ig = 0.f; f.g_lf = 0.f; f.mi = 0.f;
  if (tid < 64) { f.ns0 = NST[((size_t)seq0 * NCH + ci0) * 64 + tid]; f.ns1 = NST[((size_t)(seq0 + 1) * NCH + ci1) * 64 + tid]; }
  if (wid < 2) {
    const int dir = wid;
    f.g_ig = GT[(size_t)(row0 + lane) * 16 + (2 * dir) * 4 + hh];
    f.g_lf = GT[(size_t)(row0 + lane) * 16 + (2 * dir + 1) * 4 + hh];
    f.mi = META[((size_t)(seq0 + dir) * NCH + (dir ? ci1 : ci0)) * 4 + 2];
  }
}
__device__ __forceinline__ void ml_put_rm(const u32x4 a, unsigned char* dst, int tid) { const int r = tid >> 3, c8 = (tid & 7) * 8; *(u32x4*)(dst + r * MLP + c8 * 2) = a; }
__device__ __forceinline__ void ml_put_tr(const u32x4 a, unsigned char* dst, int tid) {
  const int r = tid >> 3, c8 = (tid & 7) * 8;
  bf16_t* d = (bf16_t*)dst;
  d[(c8 + 0) * 72 + r] = (bf16_t)(a.x & 0xffffu); d[(c8 + 1) * 72 + r] = (bf16_t)(a.x >> 16);
  d[(c8 + 2) * 72 + r] = (bf16_t)(a.y & 0xffffu); d[(c8 + 3) * 72 + r] = (bf16_t)(a.y >> 16);
  d[(c8 + 4) * 72 + r] = (bf16_t)(a.z & 0xffffu); d[(c8 + 5) * 72 + r] = (bf16_t)(a.z >> 16);
  d[(c8 + 6) * 72 + r] = (bf16_t)(a.w & 0xffffu); d[(c8 + 7) * 72 + r] = (bf16_t)(a.w >> 16);
}
__device__ __forceinline__ void ml_out_unit2(const Params& p, int l, int unit, unsigned char* lds, const MlOutPf& f, int next, MlOutPf& fn) {
  int tid_ = tidx(); asm volatile("" : "+v"(tid_)); const int tid = tid_, lane = tid & 63, wid = tid >> 6, r32 = lane & 31, hi = lane >> 5;
  unsigned char* Qs = lds; unsigned char* Ks = lds + 64 * MLP; unsigned char* VT = lds + 2 * 64 * MLP; unsigned char* Cs = lds + 3 * 64 * MLP;
  float* Ns = (float*)(lds + 5 * 64 * MLP);
  float* Bq = Ns + 128;
  float* Gs = Bq + 128;
  float* Mi = Gs + 128;
  float* HB = Mi + 64;
  const bf16_t* PROJ = (const bf16_t*)(p.ws + WS_PROJ);
  const float* GT = (const float*)(p.ws + WS_GATES);
  const bf16_t* CST = (const bf16_t*)(p.ws + WS_CST); const float* NST = (const float*)(p.ws + WS_NST); const float* META = (const float*)(p.ws + WS_MLMETA);
  bf16_t* MIX = (bf16_t*)(p.ws + WS_MIX);
  const int b = unit / (4 * NCH), hh = (unit / NCH) & 3, ch = unit % NCH;
  const int row0 = b * SEGL + ch * 64;
  ml_put_rm(f.q, Qs, tid); ml_put_rm(f.k, Ks, tid); ml_put_tr(f.v, VT, tid);
  ml_put_rm(f.c0, Cs, tid); ml_put_rm(f.c1, Cs + 64 * MLP, tid);
  if (tid < 64) { Ns[tid] = f.ns0; Ns[64 + tid] = f.ns1; }
  if (wid < 2) {
    const int dir = wid;
    const float ig = f.g_ig;
    const float lf = logsigmoidf_(f.g_lf);
    float ps = lf;
    ps = wave_incl_scan(ps);
    const float tot = __uint_as_float((unsigned)__builtin_amdgcn_readlane((int)__float_as_uint(ps), 63));
    const float bc = dir == 0 ? ps : (tot - ps + lf);
    Bq[dir * 64 + lane] = bc; Gs[dir * 64 + lane] = ig - bc;
    if (lane == 0) Mi[dir] = f.mi;
  }
  const u32x4 ov = f.ov;
  if (next >= 0) ml_out_fetch(p, next, tid, fn);
  __syncthreads();
  {
    const int dir = wid >> 2, tt = (wid >> 1) & 1, et = wid & 1;
    const int t = tt * 32 + r32;
    f32x16 sa[2] = {};
    bf16x8 bq[4];
#pragma unroll
    for (int ks = 0; ks < 4; ++ks) {
      bq[ks] = *(const bf16x8*)(Qs + t * MLP + (ks * 16 + hi * 8) * 2);
      const bf16x8 a0 = *(const bf16x8*)(Ks + r32 * MLP + (ks * 16 + hi * 8) * 2), a1 = *(const bf16x8*)(Ks + (32 + r32) * MLP + (ks * 16 + hi * 8) * 2);
      sa[0] = __builtin_amdgcn_mfma_f32_32x32x16_bf16(a0, bq[ks], sa[0], 0, 0, 0);
      sa[1] = __builtin_amdgcn_mfma_f32_32x32x16_bf16(a1, bq[ks], sa[1], 0, 0, 0);
    }
    const float bt = Bq[dir * 64 + t];
    const float inter = bt + Mi[dir];
    float mx = -INFINITY;
    f32x16 dl[2];
#pragma unroll
    for (int st = 0; st < 2; ++st)
#pragma unroll
      for (int r = 0; r < 16; ++r) {
        const int s = st * 32 + crow(r, hi);
        const bool ok = dir == 0 ? (s <= t) : (s >= t);
        const float d = ok ? bt + Gs[dir * 64 + s] : -INFINITY;
        dl[st][r] = d; mx = fmaxf(mx, d);
      }
    mx = max_xor32(mx);
    const float mt = fmaxf(inter, mx);
    const float iw = __expf(inter - mt);
    float rsum = 0.f;
#pragma unroll
    for (int st = 0; st < 2; ++st)
#pragma unroll
      for (int r = 0; r < 16; ++r) { const float w = __expf(dl[st][r] - mt); sa[st][r] *= w; rsum += sa[st][r]; }
    rsum = sum_xor32(rsum);
    float qn = 0.f;
#pragma unroll
    for (int i = 0; i < 4; ++i) {
      const int d0 = hi * 32 + i * 8;
      const u32x4 qa = *(const u32x4*)(Qs + t * MLP + d0 * 2);
      const f32x4 n0 = *(const f32x4*)(Ns + dir * 64 + d0), n1 = *(const f32x4*)(Ns + dir * 64 + d0 + 4);
      qn += bflo(qa.x) * n0.x + bfhi(qa.x) * n0.y + bflo(qa.y) * n0.z + bfhi(qa.y) * n0.w + bflo(qa.z) * n1.x + bfhi(qa.z) * n1.y + bflo(qa.w) * n1.z + bfhi(qa.w) * n1.w;
    }
    qn = sum_xor32(qn);
    const float den = rsum + iw * qn;
    const float rden = 1.f / fmaxf(fabsf(den), __expf(-mt));
    f32x16 an = {}, ac = {};
#pragma unroll
    for (int st = 0; st < 2; ++st)
#pragma unroll
      for (int k2 = 0; k2 < 2; ++k2) {
        u32x4 bx; bx.x = cvtpk(sa[st][8 * k2 + 0], sa[st][8 * k2 + 1]); bx.y = cvtpk(sa[st][8 * k2 + 2], sa[st][8 * k2 + 3]);
        bx.z = cvtpk(sa[st][8 * k2 + 4], sa[st][8 * k2 + 5]); bx.w = cvtpk(sa[st][8 * k2 + 6], sa[st][8 * k2 + 7]);
        const unsigned char* vrow = VT + (et * 32 + r32) * MLP + (st * 32 + 16 * k2 + 4 * hi) * 2;
        const u32x2 v0 = *(const u32x2*)vrow, v1 = *(const u32x2*)(vrow + 16);
        u32x4 ax; ax.x = v0.x; ax.y = v0.y; ax.z = v1.x; ax.w = v1.y;
        an = __builtin_amdgcn_mfma_f32_32x32x16_bf16(*(const bf16x8*)&ax, *(const bf16x8*)&bx, an, 0, 0, 0);
      }
    const unsigned char* Cd = Cs + dir * 64 * MLP;
#pragma unroll
    for (int ks = 0; ks < 4; ++ks) {
      const bf16x8 a = *(const bf16x8*)(Cd + (et * 32 + r32) * MLP + (ks * 16 + hi * 8) * 2);
      ac = __builtin_amdgcn_mfma_f32_32x32x16_bf16(a, bq[ks], ac, 0, 0, 0);
    }
#pragma unroll
    for (int r = 0; r < 16; ++r) HB[dir * 64 * 65 + t * 65 + et * 32 + crow(r, hi)] = (an[r] + iw * ac[r]) * rden;
  }
  __syncthreads();
  {
    const int t = tid >> 3, e8 = (tid & 7) * 8;
    float v[8]; float ss = 0.f;
#pragma unroll
    for (int i = 0; i < 8; ++i) { v[i] = HB[t * 65 + e8 + i] + HB[64 * 65 + t * 65 + e8 + i]; ss += v[i] * v[i]; }
    ss += dpp_mov<0xB1>(ss); ss += dpp_mov<0x4E>(ss); ss += dpp_mov<0x141>(ss);
    const float rs = rsqrtf(ss * (1.f / 64.f) + EPS);
    const float og[8] = {bflo(ov.x), bfhi(ov.x), bflo(ov.y), bfhi(ov.y), bflo(ov.z), bfhi(ov.z), bflo(ov.w), bfhi(ov.w)};
    const float* g = p.in[I_MNORMG] + l * 64 + e8;
    float o[8];
#pragma unroll
    for (int i = 0; i < 8; ++i) o[i] = (ABL & 2) ? 0.f : v[i] * rs * g[i] * sigmoidf_(og[i]);
    u32x4 w; w.x = cvtpk(o[0], o[1]); w.y = cvtpk(o[2], o[3]); w.z = cvtpk(o[4], o[5]); w.w = cvtpk(o[6], o[7]);
    *(u32x4*)(MIX + (size_t)(row0 + t) * DM + 256 + hh * 64 + e8) = w;
  }
  __syncthreads();
}

#define KSWZ(row, colB) ((row) * 256 + ((colB) ^ (((row) & 15) << 4)))
#define SBAR() __builtin_amdgcn_sched_barrier(0)
constexpr int ATT_SHM_V = 128 * 80, ATT_SHM_K = 64 * QK8_PITCH;
constexpr float ATT_THR = 8.0f;
__device__ __forceinline__ int v_st(int k, int c) { const int kk = (k & ~0xC) | ((k & 4) << 1) | ((k & 8) >> 1); return ((kk >> 3) * 4 + (c >> 5)) * 512 + ((kk & 7) * 32 + (c & 31)) * 2; }
__device__ __forceinline__ int v_rd_base(int lane) { return ((lane & 3) << 3) | (((lane >> 2) & 3) << 6) | (((lane >> 4) & 1) << 5) | (((lane >> 5) & 1) << 8); }
constexpr int v_rd_off(int d0, int ks, int half) { return d0 * 512 + ks * 4096 + half * 2048; }
template <int OFF> __device__ __forceinline__ s16x4 tr_read(int vb) {
  s16x4 r; asm volatile("ds_read_b64_tr_b16 %0, %1 offset:%2" : "=&v"(r) : "v"(vb), "i"(OFF) : "memory"); return r;
}
template <int D0> __device__ __forceinline__ void pv_one(f32x16& od, int vb, bf16x8 pa0, bf16x8 pa1, bf16x8 pa2, bf16x8 pa3) {
  const s16x4 l0 = tr_read<v_rd_off(D0, 0, 0)>(vb), h0 = tr_read<v_rd_off(D0, 0, 1)>(vb), l1 = tr_read<v_rd_off(D0, 1, 0)>(vb), h1 = tr_read<v_rd_off(D0, 1, 1)>(vb);
  const s16x4 l2 = tr_read<v_rd_off(D0, 2, 0)>(vb), h2 = tr_read<v_rd_off(D0, 2, 1)>(vb), l3 = tr_read<v_rd_off(D0, 3, 0)>(vb), h3 = tr_read<v_rd_off(D0, 3, 1)>(vb);
  asm volatile("s_waitcnt lgkmcnt(0)" ::: "memory"); SBAR();
#define PK(L, H) (bf16x8){L[0], L[1], L[2], L[3], H[0], H[1], H[2], H[3]}
  od = __builtin_amdgcn_mfma_f32_32x32x16_bf16(pa0, PK(l0, h0), od, 0, 0, 0);
  od = __builtin_amdgcn_mfma_f32_32x32x16_bf16(pa1, PK(l1, h1), od, 0, 0, 0);
  od = __builtin_amdgcn_mfma_f32_32x32x16_bf16(pa2, PK(l2, h2), od, 0, 0, 0);
  od = __builtin_amdgcn_mfma_f32_32x32x16_bf16(pa3, PK(l3, h3), od, 0, 0, 0);
#undef PK
}
template <int D0> __device__ __forceinline__ void pv_two(f32x16& oa, f32x16& ob, int vb, bf16x8 a0, bf16x8 a1, bf16x8 a2, bf16x8 a3, bf16x8 b0, bf16x8 b1, bf16x8 b2, bf16x8 b3) {
  const s16x4 l0 = tr_read<v_rd_off(D0, 0, 0)>(vb), h0 = tr_read<v_rd_off(D0, 0, 1)>(vb), l1 = tr_read<v_rd_off(D0, 1, 0)>(vb), h1 = tr_read<v_rd_off(D0, 1, 1)>(vb);
  const s16x4 l2 = tr_read<v_rd_off(D0, 2, 0)>(vb), h2 = tr_read<v_rd_off(D0, 2, 1)>(vb), l3 = tr_read<v_rd_off(D0, 3, 0)>(vb), h3 = tr_read<v_rd_off(D0, 3, 1)>(vb);
  asm volatile("s_waitcnt lgkmcnt(0)" ::: "memory"); SBAR();
#define PK(L, H) (bf16x8){L[0], L[1], L[2], L[3], H[0], H[1], H[2], H[3]}
  const bf16x8 v0 = PK(l0, h0), v1 = PK(l1, h1), v2 = PK(l2, h2), v3 = PK(l3, h3);
  oa = __builtin_amdgcn_mfma_f32_32x32x16_bf16(a0, v0, oa, 0, 0, 0);
  ob = __builtin_amdgcn_mfma_f32_32x32x16_bf16(b0, v0, ob, 0, 0, 0);
  oa = __builtin_amdgcn_mfma_f32_32x32x16_bf16(a1, v1, oa, 0, 0, 0);
  ob = __builtin_amdgcn_mfma_f32_32x32x16_bf16(b1, v1, ob, 0, 0, 0);
  oa = __builtin_amdgcn_mfma_f32_32x32x16_bf16(a2, v2, oa, 0, 0, 0);
  ob = __builtin_amdgcn_mfma_f32_32x32x16_bf16(b2, v2, ob, 0, 0, 0);
  oa = __builtin_amdgcn_mfma_f32_32x32x16_bf16(a3, v3, oa, 0, 0, 0);
  ob = __builtin_amdgcn_mfma_f32_32x32x16_bf16(b3, v3, ob, 0, 0, 0);
#undef PK
}
struct KQFrag { bf16x8 b0, b1, q; };
__device__ __forceinline__ void att_ldkq(KQFrag& f, const LAS unsigned char* l3, int akk, int akq) {
  const LAS unsigned char* kp = l3 + akk;
  f.b0 = *(const LAS bf16x8*)kp; f.b1 = *(const LAS bf16x8*)(kp + 8192); f.q = *(const LAS bf16x8*)(l3 + akq);
}
#define ATT_MF(pa_, pb_, f_) do { pa_ = __builtin_amdgcn_mfma_f32_32x32x16_bf16(f_.b0, f_.q, pa_, 0, 0, 0); pb_ = __builtin_amdgcn_mfma_f32_32x32x16_bf16(f_.b1, f_.q, pb_, 0, 0, 0); } while (0)
__device__ __forceinline__ void att_qk_all(f32x16& p0, f32x16& p1, f32x16& q0, f32x16& q1, KQFrag& f0, const LAS unsigned char* l3, int akk0, int akq0, float ia, float ib) {
  KQFrag f1;
#pragma unroll
  for (int r = 0; r < 16; ++r) { p0[r] = ia; p1[r] = ia; q0[r] = ib; q1[r] = ib; }
  att_ldkq(f1, l3, akk0 ^ (1 << 5), akq0 ^ (1 << 5)); ATT_MF(p0, p1, f0); SBAR();
  att_ldkq(f0, l3, akk0 ^ (2 << 5), akq0 ^ (2 << 5)); ATT_MF(p0, p1, f1); SBAR();
  att_ldkq(f1, l3, akk0 ^ (3 << 5), akq0 ^ (3 << 5)); ATT_MF(p0, p1, f0); SBAR();
  att_ldkq(f0, l3, akk0 ^ (4 << 5), akq0 ^ (4 << 5)); ATT_MF(p0, p1, f1); SBAR();
  att_ldkq(f1, l3, akk0 ^ (5 << 5), akq0 ^ (5 << 5)); ATT_MF(q0, q1, f0); SBAR();
  att_ldkq(f0, l3, akk0 ^ (6 << 5), akq0 ^ (6 << 5)); ATT_MF(q0, q1, f1); SBAR();
  att_ldkq(f1, l3, akk0 ^ (7 << 5), akq0 ^ (7 << 5)); ATT_MF(q0, q1, f0); SBAR();
  ATT_MF(q0, q1, f1); SBAR();
}
__device__ __forceinline__ float bf16_near(float x) { return __uint_as_float((__float_as_uint(x) + 0x8000u) & 0xFFFF0000u); }
__device__ __forceinline__ void att_softmax(f32x16& p0, f32x16& p1, float& m_reg, float& l_reg, float& alpha, bool first, i32x8& pa) {
  alpha = 1.f;
  if (first) {
    float pmax = p0[0];
#pragma unroll
    for (int r = 1; r < 16; ++r) pmax = fmaxf(pmax, p0[r]);
#pragma unroll
    for (int r = 0; r < 16; ++r) pmax = fmaxf(pmax, p1[r]);
    { auto rr = __builtin_amdgcn_permlane32_swap(__float_as_uint(pmax), __float_as_uint(pmax), false, false);
      pmax = fmaxf(__uint_as_float(rr[0]), __uint_as_float(rr[1])); }
    pmax = bf16_near(pmax);
    alpha = 0.f; m_reg = pmax;
#pragma unroll
    for (int r = 0; r < 16; ++r) { p0[r] -= pmax; p1[r] -= pmax; }
  }
#pragma unroll
  for (int r = 0; r < 16; ++r) { p0[r] = __builtin_amdgcn_exp2f(p0[r]); p1[r] = __builtin_amdgcn_exp2f(p1[r]); }
  float ps;
  {
#define VADD(d_, a_, b_) asm("v_add_f32_e32 %0, %1, %2" : "=v"(d_) : "v"(a_), "v"(b_))
    float s0, s1, s2, s3;
    VADD(s0, p0[0], p0[1]); VADD(s1, p0[8], p0[9]); VADD(s2, p1[0], p1[1]); VADD(s3, p1[8], p1[9]);
#pragma unroll
    for (int r = 2; r < 8; ++r) { VADD(s0, s0, p0[r]); VADD(s1, s1, p0[8 + r]); VADD(s2, s2, p1[r]); VADD(s3, s3, p1[8 + r]); }
    VADD(s0, s0, s1); VADD(s2, s2, s3); VADD(ps, s0, s2);
#undef VADD
  }
  { auto rr = __builtin_amdgcn_permlane32_swap(__float_as_uint(ps), __float_as_uint(ps), false, false);
    ps = __uint_as_float(rr[0]) + __uint_as_float(rr[1]); }
  if (__builtin_expect(!first && __any(ps > 256.f), 0)) {
    float emax = p0[0];
#pragma unroll
    for (int r = 1; r < 16; ++r) emax = fmaxf(emax, p0[r]);
#pragma unroll
    for (int r = 0; r < 16; ++r) emax = fmaxf(emax, p1[r]);
    { auto rr = __builtin_amdgcn_permlane32_swap(__float_as_uint(emax), __float_as_uint(emax), false, false);
      emax = fmaxf(__uint_as_float(rr[0]), __uint_as_float(rr[1])); }
    const float m_new = bf16_near(m_reg + fmaxf(__builtin_amdgcn_logf(emax), 0.f));
    const float delta = m_new - m_reg;
    alpha = __builtin_amdgcn_exp2f(-delta); m_reg = m_new;
#pragma unroll
    for (int r = 0; r < 16; ++r) { p0[r] *= alpha; p1[r] *= alpha; }
    ps *= alpha;
  }
  l_reg = l_reg * alpha + ps;
#pragma unroll
  for (int v = 0; v < 4; ++v) {
    int w0, w1; asm volatile("" : "=v"(w0), "=v"(w1));
    w0 = __builtin_amdgcn_cvt_pk_fp8_f32(p0[4 * v], p0[4 * v + 1], w0, false); w0 = __builtin_amdgcn_cvt_pk_fp8_f32(p0[4 * v + 2], p0[4 * v + 3], w0, true);
    w1 = __builtin_amdgcn_cvt_pk_fp8_f32(p1[4 * v], p1[4 * v + 1], w1, false); w1 = __builtin_amdgcn_cvt_pk_fp8_f32(p1[4 * v + 2], p1[4 * v + 3], w1, true);
    pa[v] = w0; pa[4 + v] = w1;
  }
}
__device__ __forceinline__ void att_unit(const unsigned char* __restrict__ Q8, const unsigned char* __restrict__ K8, const unsigned char* __restrict__ V8, bf16_t* __restrict__ Ob,
                                         int nkeys, float lam, const float* __restrict__ ng, float oscale, unsigned char* lds) {
  int tid_ = tidx(); asm volatile("" : "+v"(tid_)); const int tid = tid_, wid = tid >> 6, lane = tid & 63, r32 = lane & 31, hi = lane >> 5;
  const int grp = __builtin_amdgcn_readfirstlane(wid >> 2);
  unsigned char* V_lds = lds; unsigned char* K_lds = lds + 2 * ATT_SHM_V;
  float* wsl = (float*)(lds + 2 * ATT_SHM_V + 2 * ATT_SHM_K) + wid * 64; float* li_l = wsl; float* al_l = wsl + 32;
  float m0 = 0.f, l0 = 0.f, m1 = 0.f, l1 = 0.f;
  f32x16 o0[4] = {}, o1[4] = {};
  unsigned char* Q_lds = lds + 2 * ATT_SHM_V + 2 * ATT_SHM_K + 2048;
#pragma unroll
  for (int i = 0; i < 5; ++i) { const int piece = __builtin_amdgcn_readfirstlane(wid) + 8 * i;
    if (piece < 36) __builtin_amdgcn_global_load_lds((const unsigned*)(Q8 + piece * 1024 + lane * 16), (LAS unsigned*)(Q_lds + piece * 1024), 16, 0, 0); }
  const unsigned ldsw = (unsigned)__builtin_amdgcn_readfirstlane(wid) * 1024u;
#define GSTAGE_K(b, k0) do { const unsigned char* ki_ = K8 + (size_t)(k0) * QK8_PITCH + tid * 16; \
      __builtin_amdgcn_global_load_lds((const unsigned*)ki_, (LAS unsigned*)(K_lds + (b) * ATT_SHM_K + ldsw), 16, 0, 0); \
      if (wid < 1) __builtin_amdgcn_global_load_lds((const unsigned*)(ki_ + 8192), (LAS unsigned*)(K_lds + (b) * ATT_SHM_K + 8192 + ldsw), 16, 0, 0); } while (0)
#define GSTAGE_V(b, k0) do { const unsigned char* vi_ = V8 + (size_t)((k0) >> 6) * ATT_SHM_V + tid * 16; \
      __builtin_amdgcn_global_load_lds((const unsigned*)vi_, (LAS unsigned*)(V_lds + (b) * ATT_SHM_V + ldsw), 16, 0, 0); \
      if (wid < 2) __builtin_amdgcn_global_load_lds((const unsigned*)(vi_ + 8192), (LAS unsigned*)(V_lds + (b) * ATT_SHM_V + 8192 + ldsw), 16, 0, 0); } while (0)
#define STAGE_PAIR(jj) do { GSTAGE_V((jj) & 1, (jj) * 64); if ((jj) + 1 < NT) GSTAGE_K((jj) & 1, ((jj) + 1) * 64); } while (0)
#define RESC(o, a) do { if (__any((a) < 1.f)) { if (hi == 0) al_l[r32] = (a); asm volatile("s_waitcnt lgkmcnt(0)" ::: "memory"); \
    _Pragma("unroll") for (int d = 0; d < 4; ++d) _Pragma("unroll") for (int r = 0; r < 16; ++r) o[d][r] *= al_l[crow(r, hi)]; } } while (0)
#define ATT_BAR() do { asm volatile("s_waitcnt lgkmcnt(0)" ::: "memory"); __builtin_amdgcn_s_barrier(); asm volatile("" ::: "memory"); } while (0)
#define ATT_LDK(dst_, off_) do { const u32x4 x0_ = *(const LAS u32x4*)(kb_ + (off_)), x1_ = *(const LAS u32x4*)(kb_ + (off_) + 16); \
      dst_[0] = (int)x0_.x; dst_[1] = (int)x0_.y; dst_[2] = (int)x0_.z; dst_[3] = (int)x0_.w; dst_[4] = (int)x1_.x; dst_[5] = (int)x1_.y; dst_[6] = (int)x1_.z; dst_[7] = (int)x1_.w; } while (0)
#define ATT_SC(acc_, kf_, qf_) acc_ = __builtin_amdgcn_mfma_scale_f32_32x32x64_f8f6f4(kf_, qf_, acc_, 0, 0, 0, 0x7F7F7F7F, 0, 0x7F7F7F7F)
#define ATT_LDQ(dst_, off_) do { const u32x4 x0_ = *(const LAS u32x4*)(qb_ + (off_)), x1_ = *(const LAS u32x4*)(qb_ + (off_) + 16); \
      dst_[0] = (int)x0_.x; dst_[1] = (int)x0_.y; dst_[2] = (int)x0_.z; dst_[3] = (int)x0_.w; dst_[4] = (int)x1_.x; dst_[5] = (int)x1_.y; dst_[6] = (int)x1_.z; dst_[7] = (int)x1_.w; } while (0)
#define ATT_INIT2(pa_, pb_, negm_) do { u32x4 oa_, ob_; unsigned z_ = 0u; asm volatile("" : "+v"(z_)); \
      oa_.x = hi ? z_ : 0x3F80u; oa_.y = z_; oa_.z = z_; oa_.w = z_; ob_.x = hi ? z_ : (__float_as_uint(negm_) >> 16); ob_.y = z_; ob_.z = z_; ob_.w = z_; \
      const f32x16 zz_ = {}; \
      pa_ = __builtin_amdgcn_mfma_f32_32x32x16_bf16(*(const bf16x8*)&oa_, *(const bf16x8*)&ob_, zz_, 0, 0, 0); \
      pb_ = __builtin_amdgcn_mfma_f32_32x32x16_bf16(*(const bf16x8*)&oa_, *(const bf16x8*)&ob_, zz_, 0, 0, 0); } while (0)
#define ATT_QK_ALL(ia_, ib_) do { ATT_INIT2(p0, p1, ia_); ATT_INIT2(q0, q1, ib_); \
      ATT_SC(p0, kf0, qf); ATT_LDK(kf0, 32 * QK8_PITCH); \
      ATT_SC(p1, kf0, qf); ATT_LDK(kf0, 64); ATT_LDQ(qf, 64); \
      ATT_SC(q0, kf0, qf); ATT_LDK(kf0, 32 * QK8_PITCH + 64); \
      ATT_SC(q1, kf0, qf); } while (0)
  const int NT = nkeys / 64;
  GSTAGE_K(1, 0); STAGE_PAIR(0);
  asm volatile("s_waitcnt vmcnt(0)" ::: "memory"); __syncthreads();
  f32x16 p0, p1, q0, q1; i32x8 pa, pb;
  const LAS unsigned char* l3 = (const LAS unsigned char*)lds;
  const int kofs0 = 2 * ATT_SHM_V + r32 * QK8_PITCH + hi * 32;
  const int qofs0 = 2 * ATT_SHM_V + 2 * ATT_SHM_K + 2048 + (__builtin_amdgcn_readfirstlane(wid) * 32 + r32) * QK8_PITCH + hi * 32;
  { i32x8 kf0, qf; const LAS unsigned char* kb_ = l3 + (kofs0 + ATT_SHM_K); const LAS unsigned char* qb_ = l3 + qofs0;
    ATT_LDK(kf0, 0); ATT_LDQ(qf, 0);
    ATT_QK_ALL(0.f, 0.f); }
  if (grp) ATT_BAR();
#pragma unroll 1
  for (int j = 0; j < NT; ++j) {
    const int cur = j & 1;
    const bool more = (j + 1 < NT);
    if (grp && more) STAGE_PAIR(j + 1);
    { float alphaA, alphaB;
      const bool first = (j == 0);
      att_softmax(p0, p1, m0, l0, alphaA, first, pa); SBAR();
      att_softmax(q0, q1, m1, l1, alphaB, first, pb); SBAR();
      RESC(o0, alphaA);
      RESC(o1, alphaB); }
    asm volatile("" : "+v"(pa), "+v"(pb), "+v"(m0), "+v"(l0), "+v"(m1), "+v"(l1));
    asm volatile("" : "+v"(o0[0]), "+v"(o0[1]), "+v"(o0[2]), "+v"(o0[3]), "+v"(o1[0]), "+v"(o1[1]), "+v"(o1[2]), "+v"(o1[3]));
    if (!grp) asm volatile("s_waitcnt vmcnt(0)" ::: "memory");
    ATT_BAR();
    if (!grp && more) STAGE_PAIR(j + 1);
    __builtin_amdgcn_s_setprio(1);
    {
      int kofs = kofs0, qofs = qofs0; asm volatile("" : "+v"(kofs), "+v"(qofs));
      const LAS unsigned char* kb_ = l3 + (kofs + cur * ATT_SHM_K); const LAS unsigned char* qb_ = l3 + qofs;
      i32x8 kf0, qf;
      const LAS unsigned char* vrow = l3 + (r32 * 80 + hi * 32 + cur * ATT_SHM_V);
      u32x4 va0 = *(const LAS u32x4*)vrow, va1 = *(const LAS u32x4*)(vrow + 16), vb0, vb1;
#define ATT_PV(d0_, x0_, x1_) do { i32x8 bv; bv[0] = (int)x0_.x; bv[1] = (int)x0_.y; bv[2] = (int)x0_.z; bv[3] = (int)x0_.w; bv[4] = (int)x1_.x; bv[5] = (int)x1_.y; bv[6] = (int)x1_.z; bv[7] = (int)x1_.w; \
        o0[d0_] = __builtin_amdgcn_mfma_scale_f32_32x32x64_f8f6f4(pa, bv, o0[d0_], 0, 0, 0, 0x7F7F7F7F, 0, 0x7F7F7F7F); \
        o1[d0_] = __builtin_amdgcn_mfma_scale_f32_32x32x64_f8f6f4(pb, bv, o1[d0_], 0, 0, 0, 0x7F7F7F7F, 0, 0x7F7F7F7F); } while (0)
      vb0 = *(const LAS u32x4*)(vrow + 32 * 80); vb1 = *(const LAS u32x4*)(vrow + 32 * 80 + 16); ATT_PV(0, va0, va1);
      va0 = *(const LAS u32x4*)(vrow + 64 * 80); va1 = *(const LAS u32x4*)(vrow + 64 * 80 + 16); ATT_PV(1, vb0, vb1);
      vb0 = *(const LAS u32x4*)(vrow + 96 * 80); vb1 = *(const LAS u32x4*)(vrow + 96 * 80 + 16); ATT_PV(2, va0, va1);
      ATT_LDK(kf0, 0); ATT_LDQ(qf, 0);
      ATT_PV(3, vb0, vb1);
#undef ATT_PV
      asm volatile("" : "+v"(o0[0]), "+v"(o0[1]), "+v"(o0[2]), "+v"(o0[3]), "+v"(o1[0]), "+v"(o1[1]), "+v"(o1[2]), "+v"(o1[3]));
      ATT_QK_ALL(-m0, -m1);
      asm volatile("" : "+v"(p0), "+v"(p1), "+v"(q0), "+v"(q1));
    }
    __builtin_amdgcn_s_setprio(0);
    if (grp) asm volatile("s_waitcnt vmcnt(0)" ::: "memory");
    ATT_BAR();
  }
  if (!grp) ATT_BAR();
  if (hi == 0) { li_l[r32] = 1.f / l0; al_l[r32] = lam / l1; }
  asm volatile("s_waitcnt lgkmcnt(0)" ::: "memory");
  float ss[16];
#pragma unroll
  for (int r = 0; r < 16; ++r) {
    const float a = li_l[crow(r, hi)], bq = al_l[crow(r, hi)];
    float s = 0.f;
#pragma unroll
    for (int d = 0; d < 4; ++d) { const float v = o0[d][r] * a - o1[d][r] * bq; o0[d][r] = v; s += v * v; }
    s += dpp_mov<0xB1>(s); s += dpp_mov<0x4E>(s); s += dpp_mov<0x141>(s); s += dpp_mov<0x140>(s);
    { auto rr_ = __builtin_amdgcn_permlane16_swap(__float_as_uint(s), __float_as_uint(s), false, false); s = __uint_as_float(rr_[0]) + __uint_as_float(rr_[1]); }
    ss[r] = rsqrtf(s * (1.f / 128.f) + EPS) * oscale;
  }
  bf16_t* Ow = Ob + (size_t)(wid * 32) * DM;
  unsigned char* ost = lds + 2 * ATT_SHM_V + 2 * ATT_SHM_K + 2048 + wid * (32 * 272);
#pragma unroll
  for (int d = 0; d < 4; ++d) {
    const float g = ng[d * 32 + r32];
#pragma unroll
    for (int r = 0; r < 16; ++r) *(bf16_t*)(ost + crow(r, hi) * 272 + (d * 32 + r32) * 2) = (ABL & 4) ? (bf16_t)0 : (bf16_t)(cvtpk(o0[d][r] * ss[r] * g, 0.f) & 0xffffu);
  }
  asm volatile("s_waitcnt lgkmcnt(0)" ::: "memory");
#pragma unroll
  for (int i = 0; i < 8; ++i) {
    const int c = lane + 64 * i, row = c >> 4, cb = (c & 15) * 16;
    *(u32x4*)((unsigned char*)(Ow + (size_t)row * DM) + cb) = *(const u32x4*)(ost + row * 272 + cb);
  }
  __syncthreads();
#undef ATT_INIT2
#undef ATT_LDK
#undef ATT_LDQ
#undef ATT_SC
#undef ATT_QK_ALL
#undef GSTAGE_K
#undef GSTAGE_V
#undef STAGE_PAIR
#undef RESC
#undef ATT_BAR
}

__device__ __forceinline__ float ins16(float (&a)[16], float x) {
#pragma unroll
  for (int i = 0; i < 16; ++i) { const float h = fmaxf(a[i], x); x = fminf(a[i], x); a[i] = h; }
  return x;
}
__device__ __forceinline__ void bsort16(float (&a)[16]) {
#pragma unroll
  for (int k = 2; k <= 16; k <<= 1)
#pragma unroll
    for (int j = k >> 1; j > 0; j >>= 1)
#pragma unroll
      for (int i = 0; i < 16; ++i) {
        const int q = i ^ j;
        if (q > i) {
          const bool desc = ((i & k) == 0);
          const float hi_ = fmaxf(a[i], a[q]), lo_ = fminf(a[i], a[q]);
          a[i] = desc ? hi_ : lo_; a[q] = desc ? lo_ : hi_;
        }
      }
}
__device__ __forceinline__ void bmerge16(float (&a)[16], const float (&b)[16]) {
#pragma unroll
  for (int i = 0; i < 16; ++i) a[i] = fmaxf(a[i], b[15 - i]);
#pragma unroll
  for (int j = 8; j > 0; j >>= 1)
#pragma unroll
    for (int i = 0; i < 16; ++i) {
      const int q = i ^ j;
      if (q > i) { const float hi_ = fmaxf(a[i], a[q]), lo_ = fminf(a[i], a[q]); a[i] = hi_; a[q] = lo_; }
    }
}
__device__ __forceinline__ float gelu_erf(float x) { return 0.5f * x * (1.f + erff(x * 0.70710678118654752440f)); }
#define XB_TMO      128
#define XB_XCNT(j)  (256  + 64 * (j))
#define XB_XSUB(j)  (1280 + 64 * (j))
#define XB_XGEN(j)  (2304 + 64 * (j))
#define XB_TOP      3328
#define XB_TOPGEN   3392
#define XCD_BAR_WORDS 3456
#define XB_SPIN_CAP (1u << 22)
__device__ __forceinline__ unsigned xb_ld(unsigned* p)              { return __hip_atomic_load(p, __ATOMIC_RELAXED, __HIP_MEMORY_SCOPE_AGENT); }
__device__ __forceinline__ unsigned xb_add(unsigned* p, unsigned v) { return __hip_atomic_fetch_add(p, v, __ATOMIC_RELAXED, __HIP_MEMORY_SCOPE_AGENT); }
__device__ __forceinline__ unsigned xb_xcc_id() { return (unsigned)__builtin_amdgcn_s_getreg((3 << 11) | 20) & 0xFu; }
#define XB_SPIN(cond, bar) do { unsigned _sp = 0; while (cond) { __builtin_amdgcn_s_sleep(1); \
    if ((++_sp & 255u) == 0u) { if (xb_ld(&(bar)[XB_TMO])) break; if (_sp > XB_SPIN_CAP) { atomicAdd(&(bar)[XB_TMO], 1u); break; } } } } while (0)
struct XcdBarrier { unsigned* bar; unsigned x; volatile LAS unsigned* st; };
__device__ __forceinline__ XcdBarrier xcd_barrier_post(unsigned* bar, volatile LAS unsigned* st) {
  XcdBarrier b; b.bar = bar; b.x = xb_xcc_id(); b.st = st;
  if (tidx() == 0) (void)xb_add(&bar[XB_XCNT(b.x)], 1u);
  return b;
}
__device__ __forceinline__ void xcd_barrier_complete(unsigned* bar, unsigned x, unsigned& nloc, unsigned& nx) {
  const unsigned G = gridDim.x * gridDim.y * gridDim.z;
  unsigned sum, cnt, mine, sp = 0u;
  for (;;) {
    sum = 0u; cnt = 0u; mine = 0u;
#pragma unroll
    for (unsigned j = 0; j < 16; ++j) { const unsigned c = xb_ld(&bar[XB_XCNT(j)]); sum += c; cnt += (c > 0u) ? 1u : 0u; mine = (j == x) ? c : mine; }
    if (sum == G) break;
    __builtin_amdgcn_s_sleep(1);
    if ((++sp & 255u) == 0u) { if (xb_ld(&bar[XB_TMO])) break; if (sp > XB_SPIN_CAP) { atomicAdd(&bar[XB_TMO], 1u); break; } }
  }
  nloc = mine > 0u ? mine : 1u; nx = cnt > 0u ? cnt : 1u;
}
__device__ __forceinline__ void xcd_barrier(const XcdBarrier& b) {
  asm volatile("s_waitcnt vmcnt(0)" ::: "memory");
  __syncthreads();
  if (tidx() == 0) {
    unsigned* bar = b.bar;
    __builtin_amdgcn_s_waitcnt(0);
    unsigned nloc = b.st[0], nx = b.st[1];
    if (nloc == 0u) { xcd_barrier_complete(bar, b.x, nloc, nx); b.st[0] = nloc; b.st[1] = nx; }
    const unsigned old = xb_add(&bar[XB_XSUB(b.x)], 1u);
    const unsigned gen = old / nloc;
    if (old + 1u == (gen + 1u) * nloc) {
      __builtin_amdgcn_fence(__ATOMIC_RELEASE, "agent");
      asm volatile("s_waitcnt vmcnt(0)" ::: "memory");
      const unsigned og = xb_add(&bar[XB_TOP], 1u);
      const unsigned tg = og / nx;
      if (og + 1u == (tg + 1u) * nx) xb_add(&bar[XB_TOPGEN], 1u);
      else XB_SPIN(xb_ld(&bar[XB_TOPGEN]) == tg, bar);
      __builtin_amdgcn_fence(__ATOMIC_ACQUIRE, "agent");
      xb_add(&bar[XB_XGEN(b.x)], 1u);
      asm volatile("s_waitcnt vmcnt(0)" ::: "memory");
    } else {
      XB_SPIN(xb_ld(&bar[XB_XGEN(b.x)]) == gen, bar);
      __builtin_amdgcn_fence(__ATOMIC_ACQUIRE, "agent");
      asm volatile("s_waitcnt vmcnt(0)" ::: "memory");
    }
  }
  __syncthreads();
}

constexpr size_t RT_STRIDE = (size_t)T * 128 * 4;
__device__ __forceinline__ void route_unit(const Params& p, int l, int unit, unsigned char* lds) {
  int tid_ = tidx(); asm volatile("" : "+v"(tid_)); const int tid = tid_, lane = tid & 63, wid = tid >> 6, r32 = lane & 31, hi = lane >> 5;
  unsigned char* IDX = lds;
  int* UE = (int*)(lds + 8192); float* UG = (float*)(lds + 8192 + 16384); float* US = (float*)(lds + 8192 + 32768);
  int* EIDG = (int*)(p.ws + WS_EID + (size_t)l * RT_STRIDE); float* GWG = (float*)(p.ws + WS_ULOC + RT_STRIDE); float* SUG = (float*)(p.ws + WS_ULOC + 2 * RT_STRIDE);
  const float* PSC = (const float*)(p.ws + WS_PSC);
  const int row0 = unit * 32;
  const bf16_t* QP = (const bf16_t*)(p.ws + WS_PROJ);
  const bf16_t* KEYS = (const bf16_t*)(p.ws + WS_KEYS) + (size_t)l * 131072;
  for (int rrep = 0; rrep < REP_ROUTE; ++rrep) {
    const int h = wid;
    float top[2][16];
    bf16x8 bq[4], bqn[4], akc[4], akn[4];
    {
      const bf16_t* qrow0 = QP + (size_t)(row0 + r32) * DM + h * 128 + hi * 8;
      const bf16_t* kb0 = KEYS + ((size_t)(h * 2) * 128 + r32) * 64 + hi * 8;
#pragma unroll
      for (int ks = 0; ks < 4; ++ks) { bq[ks] = *(const bf16x8*)(qrow0 + ks * 16); akc[ks] = *(const bf16x8*)(kb0 + ks * 16); }
    }
#pragma unroll
    for (int pp = 0; pp < 2; ++pp) {
      const bf16_t* kb = KEYS + ((size_t)(h * 2 + pp) * 128 + r32) * 64 + hi * 8;
      float (&lst)[16] = top[pp];
#pragma unroll
      for (int i = 0; i < 16; ++i) lst[i] = -INFINITY;
#pragma unroll
      for (int nt = 0; nt < 4; ++nt) {
        if (nt < 3) {
#pragma unroll
          for (int ks = 0; ks < 4; ++ks) akn[ks] = *(const bf16x8*)(kb + (size_t)(nt + 1) * 32 * 64 + ks * 16);
        } else if (pp == 0) {
          const bf16_t* qrow1 = QP + (size_t)(row0 + r32) * DM + h * 128 + 64 + hi * 8;
          const bf16_t* kb1 = KEYS + ((size_t)(h * 2 + 1) * 128 + r32) * 64 + hi * 8;
#pragma unroll
          for (int ks = 0; ks < 4; ++ks) { bqn[ks] = *(const bf16x8*)(qrow1 + ks * 16); akn[ks] = *(const bf16x8*)(kb1 + ks * 16); }
        }
        f32x16 acc = {};
#pragma unroll
        for (int ks = 0; ks < 4; ++ks) acc = __builtin_amdgcn_mfma_f32_32x32x16_bf16(akc[ks], bq[ks], acc, 0, 0, 0);
#pragma unroll
        for (int ks = 0; ks < 4; ++ks) { akc[ks] = akn[ks]; if (nt == 3) bq[ks] = bqn[ks]; }
        float grp[16];
#pragma unroll
        for (int r = 0; r < 16; ++r) grp[r] = __uint_as_float((__float_as_uint(acc[r]) & ~0x7Fu) | (unsigned)(nt * 32 + crow(r, hi)));
        bsort16(grp);
        if (nt == 0) {
#pragma unroll
          for (int i = 0; i < 16; ++i) lst[i] = grp[i];
        } else bmerge16(lst, grp);
        SBAR();
      }
      float oth[16];
#pragma unroll
      for (int i = 0; i < 16; ++i) { auto rr_ = __builtin_amdgcn_permlane32_swap(__float_as_uint(lst[i]), __float_as_uint(lst[i]), false, false); oth[i] = __uint_as_float(hi ? rr_[0] : rr_[1]); }
      bmerge16(lst, oth);
      if (hi == 0) {
        unsigned w[4];
#pragma unroll
        for (int i = 0; i < 4; ++i)
          w[i] = (__float_as_uint(lst[4 * i]) & 0x7Fu) | ((__float_as_uint(lst[4 * i + 1]) & 0x7Fu) << 8) | ((__float_as_uint(lst[4 * i + 2]) & 0x7Fu) << 16) | ((__float_as_uint(lst[4 * i + 3]) & 0x7Fu) << 24);
        *(u32x4*)(IDX + ((r32 * 8 + h) * 2 + pp) * 16) = (u32x4){w[0], w[1], w[2], w[3]};
      }
    }
    float best[16];
#define CAND(i, j) __uint_as_float((__float_as_uint(__uint_as_float(__float_as_uint(top[0][i]) & ~0x7Fu) + __uint_as_float(__float_as_uint(top[1][j]) & ~0x7Fu)) & ~0xFFu) | (unsigned)((i) * 16 + (j)))
    {
#pragma unroll
      for (int j = 0; j < 16; ++j) best[j] = CAND(0, j);
      float y[16];
#pragma unroll
      for (int j = 0; j < 8; ++j) { y[j] = CAND(1, j); y[8 + j] = CAND(15 - j, 0); }
#pragma unroll
      for (int jj = 8; jj > 0; jj >>= 1)
#pragma unroll
        for (int i = 0; i < 16; ++i) { const int q = i ^ jj; if (q > i) { const float hi_ = fmaxf(y[i], y[q]), lo_ = fminf(y[i], y[q]); y[i] = hi_; y[q] = lo_; } }
      bmerge16(best, y);
      float x[16];
      x[0] = CAND(2, 0); x[1] = CAND(2, 1); x[2] = CAND(2, 2); x[3] = CAND(2, 3); x[4] = CAND(2, 4);
      x[5] = CAND(3, 0); x[6] = CAND(3, 1); x[7] = CAND(3, 2); x[8] = CAND(3, 3);
      x[9] = CAND(4, 0); x[10] = CAND(4, 1); x[11] = CAND(4, 2);
      x[12] = CAND(5, 0); x[13] = CAND(5, 1); x[14] = CAND(6, 0); x[15] = CAND(6, 1);
      bsort16(x);
      bmerge16(best, x);
      ins16(best, CAND(7, 0)); ins16(best, CAND(7, 1));
    }
#undef CAND
    asm volatile("s_waitcnt lgkmcnt(0)" ::: "memory");
    if (hi == 0) {
      const unsigned char* ib = IDX + ((r32 * 8 + h) * 2) * 16;
      const float mx = __uint_as_float(__float_as_uint(best[0]) & ~0xFFu);
      float w[16]; float sum = 0.f;
#pragma unroll
      for (int k = 0; k < 16; ++k) { w[k] = __expf(__uint_as_float(__float_as_uint(best[k]) & ~0xFFu) - mx); sum += w[k]; }
      const float rsum = 1.f / sum;
      int ee[16]; float su_[16], sv_[16];
#pragma unroll
      for (int k = 0; k < 16; ++k) {
        const unsigned ij = __float_as_uint(best[k]) & 0xFFu;
        ee[k] = (int)ib[ij >> 4] * 128 + (int)ib[16 + (ij & 15)];
      }
#pragma unroll
      for (int k = 0; k < 16; ++k) { su_[k] = PSC[(size_t)l * NEXP + ee[k]]; sv_[k] = PSC[(size_t)(DEPTH + l) * NEXP + ee[k]]; }
#pragma unroll
      for (int k = 0; k < 16; ++k) {
        UE[r32 * 128 + h * 16 + k] = ee[k]; UG[r32 * 128 + h * 16 + k] = w[k] * rsum * sv_[k];
        US[r32 * 128 + h * 16 + k] = su_[k];
      }
    }
  }
  __syncthreads();
#pragma unroll 1
  for (int tt = 0; tt < 4; ++tt) {
    const int t = wid * 4 + tt;
    const int k0 = UE[t * 128 + lane], k1 = UE[t * 128 + 64 + lane];
    const float g0 = UG[t * 128 + lane], g1 = UG[t * 128 + 64 + lane], s0 = US[t * 128 + lane], s1 = US[t * 128 + 64 + lane];
    const int b0 = k0 >> 11, b1 = k1 >> 11;
    int base = 0, pos0 = 0, pos1 = 0;
#pragma unroll
    for (int b = 0; b < 8; ++b) {
      const unsigned long long m0 = __ballot(b0 == b), m1 = __ballot(b1 == b);
      const int c0 = __popcll(m0), c1 = __popcll(m1);
      const unsigned long long lt = (1ull << lane) - 1ull;
      if (b0 == b) pos0 = base + __popcll(m0 & lt);
      if (b1 == b) pos1 = base + c0 + __popcll(m1 & lt);
      base += c0 + c1;
    }
    const size_t ro = (size_t)(row0 + t) * 128;
    EIDG[ro + pos0] = k0; GWG[ro + pos0] = g0; SUG[ro + pos0] = s0;
    EIDG[ro + pos1] = k1; GWG[ro + pos1] = g1; SUG[ro + pos1] = s1;
  }
}
#define CAS __attribute__((address_space(4)))
typedef int i32x8 __attribute__((ext_vector_type(8)));
struct TokPref { f32x2 gs0, gs1; u32x4 hA, hB; };
struct RowPipe { i32x6 uq[4], vq[4]; i32x8 Ec; };
struct EpiVec { f32x4 g2[4], ng[4], sc[4], sh[4]; int mr; };
__device__ __forceinline__ const CAS i32x8* eid_row(const CAS unsigned char* eidg, int row) {
  return (const CAS i32x8*)(eidg + (size_t)(unsigned)__builtin_amdgcn_readfirstlane(row) * 512u);
}
__device__ __forceinline__ void tok_prefetch(const Params& p, int row, int lane, TokPref& t) {
  const float* GWG = (const float*)(p.ws + WS_ULOC + RT_STRIDE) + (size_t)row * 128;
  const float* SUG = (const float*)(p.ws + WS_ULOC + 2 * RT_STRIDE) + (size_t)row * 128;
  const bf16_t* H = (const bf16_t*)(p.ws + WS_H);
  t.gs0 = f32x2{GWG[lane], SUG[lane]}; t.gs1 = f32x2{GWG[64 + lane], SUG[64 + lane]};
  { const bf16_t* hr_ = H + (size_t)row * DM + lane * 4;
    const u32x2 a0 = *(const u32x2*)hr_, a1 = *(const u32x2*)(hr_ + 256), a2 = *(const u32x2*)(hr_ + 512), a3 = *(const u32x2*)(hr_ + 768);
    t.hA = (u32x4){a0.x, a0.y, a1.x, a1.y}; t.hB = (u32x4){a2.x, a2.y, a3.x, a3.y}; }
}
#define LOADPAIR(dst_, tofs_, ea_, eb_) do { const u32x3v a_ = __builtin_amdgcn_raw_buffer_load_b96(rsT, lane12, (ea_) * PROW + (tofs_), 0); const unsigned b0_ = __builtin_amdgcn_raw_buffer_load_b32(rsT, lane12, (eb_) * PROW + (tofs_), 0); \
      const u32x2v b1_ = __builtin_amdgcn_raw_buffer_load_b64(rsT, lane12 + 4, (eb_) * PROW + (tofs_), 0); \
      dst_[0] = (int)a_.x; dst_[1] = (int)a_.y; dst_[2] = (int)a_.z; dst_[3] = (int)b0_; dst_[4] = (int)b1_.x; dst_[5] = (int)b1_.y; } while (0)
#define LOADGROUP(q_, tofs_, E_) do { LOADPAIR(q_[0], tofs_, E_[0], E_[1]); LOADPAIR(q_[1], tofs_, E_[2], E_[3]); LOADPAIR(q_[2], tofs_, E_[4], E_[5]); LOADPAIR(q_[3], tofs_, E_[6], E_[7]); } while (0)
constexpr int VOFS = (int)(WS_PV - WS_PU);
__device__ __forceinline__ void gather_token(const Params& p, const CAS unsigned char* eidg, const __amdgpu_buffer_rsrc_t rsT, int l, int row, int nextrow, TokPref& tp, RowPipe& rp, EpiVec& ev, unsigned char* lds, int lane, int wid) {
  f32x2* GS = (f32x2*)(lds + wid * 2048);
  float* XC = (float*)(p.ws + WS_XCUR);
  const float* MOD = (const float*)(p.ws + WS_MOD);
  const CAS i32x8* EP = eid_row(eidg, row);
  const bool hasnext = nextrow >= 0;
  const CAS i32x8* EPn = eid_row(eidg, hasnext ? nextrow : row);
  GS[lane] = tp.gs0; GS[64 + lane] = tp.gs1;
  asm volatile("s_waitcnt lgkmcnt(0)" ::: "memory");
  const int eofl = ((lane >> 5) & 1) + 2 * ((lane >> 4) & 1) + 4 * ((lane >> 3) & 1);
  const int lane12 = lane * 12;
  {
    h16x2 hh[8];
    {
      const u32x4 hA = tp.hA, hB = tp.hB;
      hh[0] = __builtin_bit_cast(h16x2, __builtin_amdgcn_cvt_pkrtz(bflo(hA.x), bfhi(hA.x))); hh[1] = __builtin_bit_cast(h16x2, __builtin_amdgcn_cvt_pkrtz(bflo(hA.y), bfhi(hA.y))); hh[2] = __builtin_bit_cast(h16x2, __builtin_amdgcn_cvt_pkrtz(bflo(hA.z), bfhi(hA.z))); hh[3] = __builtin_bit_cast(h16x2, __builtin_amdgcn_cvt_pkrtz(bflo(hA.w), bfhi(hA.w)));
      hh[4] = __builtin_bit_cast(h16x2, __builtin_amdgcn_cvt_pkrtz(bflo(hB.x), bfhi(hB.x))); hh[5] = __builtin_bit_cast(h16x2, __builtin_amdgcn_cvt_pkrtz(bflo(hB.y), bfhi(hB.y))); hh[6] = __builtin_bit_cast(h16x2, __builtin_amdgcn_cvt_pkrtz(bflo(hB.z), bfhi(hB.z))); hh[7] = __builtin_bit_cast(h16x2, __builtin_amdgcn_cvt_pkrtz(bflo(hB.w), bfhi(hB.w)));
    }
    if (hasnext) tok_prefetch(p, nextrow, lane, tp);
    { const int mr_ = mod_row(row);
      if (mr_ != ev.mr) {
        const float* g2_ = MOD + ((size_t)l * 5 + mr_) * 6144 + 5 * 1024 + lane * 4;
        const float* ng_ = (l == DEPTH - 1 ? p.in[I_FINALG] : p.in[I_N1G] + (l + 1) * DM) + lane * 4;
        const float* m_ = MOD + ((size_t)(l == DEPTH - 1 ? l : l + 1) * 5 + mr_) * 6144 + lane * 4;
#pragma unroll
        for (int v4 = 0; v4 < 4; ++v4) { ev.g2[v4] = *(const f32x4*)(g2_ + v4 * 256); ev.ng[v4] = *(const f32x4*)(ng_ + v4 * 256); ev.sc[v4] = *(const f32x4*)(m_ + 1024 + v4 * 256); ev.sh[v4] = *(const f32x4*)(m_ + v4 * 256); }
        ev.mr = mr_;
      } }
    f32x4 xpre[4];
    { const float* xr_ = XC + (size_t)row * DM + lane * 4;
#pragma unroll
      for (int v4 = 0; v4 < 4; ++v4) xpre[v4] = *(const f32x4*)(xr_ + v4 * 256); }
    f32x2 acc2[8];
#pragma unroll
    for (int i = 0; i < 8; ++i) acc2[i] = f32x2{0.f, 0.f};
#pragma unroll 1
    for (int g8 = 0; g8 < 16; ++g8) {
      const bool pf = (g8 < 15) || hasnext;
      const f32x2 gs = GS[g8 * 8 + eofl];
      float d[8];
#pragma unroll
      for (int i2 = 0; i2 < 4; ++i2) {
        const h16x32 r = __builtin_amdgcn_cvt_scalef32_pk32_f16_fp6(rp.uq[i2], 1.0f);
        float a0 = 0.f, a1 = 0.f, b0 = 0.f, b1 = 0.f;
#define UDOT(k_) a0 = __builtin_amdgcn_fdot2(__builtin_shufflevector(r, r, 4 * (k_), 4 * (k_) + 1), hh[2 * (k_)], a0, false); b0 = __builtin_amdgcn_fdot2(__builtin_shufflevector(r, r, 16 + 4 * (k_), 17 + 4 * (k_)), hh[2 * (k_)], b0, false); \
        a1 = __builtin_amdgcn_fdot2(__builtin_shufflevector(r, r, 4 * (k_) + 2, 4 * (k_) + 3), hh[2 * (k_) + 1], a1, false); b1 = __builtin_amdgcn_fdot2(__builtin_shufflevector(r, r, 18 + 4 * (k_), 19 + 4 * (k_)), hh[2 * (k_) + 1], b1, false);
        UDOT(0) UDOT(1) UDOT(2) UDOT(3)
#undef UDOT
        d[2 * i2] = a0 + a1;
        d[2 * i2 + 1] = b0 + b1;
        asm volatile("" : "+v"(d[2 * i2]), "+v"(d[2 * i2 + 1]));
      }
      if (pf) LOADGROUP(rp.uq, 0, rp.Ec);
      float tot;
      {
        auto s01 = __builtin_amdgcn_permlane32_swap(__float_as_uint(d[0]), __float_as_uint(d[1]), false, false);
        auto s23 = __builtin_amdgcn_permlane32_swap(__float_as_uint(d[2]), __float_as_uint(d[3]), false, false);
        auto s45 = __builtin_amdgcn_permlane32_swap(__float_as_uint(d[4]), __float_as_uint(d[5]), false, false);
        auto s67 = __builtin_amdgcn_permlane32_swap(__float_as_uint(d[6]), __float_as_uint(d[7]), false, false);
        const float q01 = __uint_as_float(s01[0]) + __uint_as_float(s01[1]), q23 = __uint_as_float(s23[0]) + __uint_as_float(s23[1]);
        const float q45 = __uint_as_float(s45[0]) + __uint_as_float(s45[1]), q67 = __uint_as_float(s67[0]) + __uint_as_float(s67[1]);
        auto ta = __builtin_amdgcn_permlane16_swap(__float_as_uint(q01), __float_as_uint(q23), false, false);
        auto tb = __builtin_amdgcn_permlane16_swap(__float_as_uint(q45), __float_as_uint(q67), false, false);
        const float r0123 = __uint_as_float(ta[0]) + __uint_as_float(ta[1]);
        const float r4567 = __uint_as_float(tb[0]) + __uint_as_float(tb[1]);
        const bool b3 = (lane & 8) != 0;
        const float keep = b3 ? r4567 : r0123, send = b3 ? r0123 : r4567;
        float x = keep + dpp_mov<0x140>(send);
        x += dpp_mov<0xB1>(x); x += dpp_mov<0x4E>(x); x += dpp_mov<0x141>(x);
        tot = x * gs.y;
      }
      float ge;
      {
        const float v = tot, av = fabsf(v), tq = __builtin_amdgcn_rcpf(av * 0.2316418882f + 1.0f);
        float q = tq * 0.5307027145f + (-0.7265760135f); q = q * tq + 0.7107068705f; q = q * tq + (-0.142248368f); q = q * tq + 0.127414796f; q = q * tq;
        const float ex = __builtin_amdgcn_exp2f(v * v * (-0.72134752044f));
        const float m = v * (q * ex), r = v - m;
        ge = (v < 0.f ? m : r) * gs.x;
      }
      unsigned cw[8];
      { const unsigned gp = __builtin_bit_cast(unsigned, __builtin_amdgcn_cvt_pkrtz(ge * 1024.f, ge * 1024.f));
        cw[0] = (unsigned)__builtin_amdgcn_readlane((int)gp, 0);  cw[4] = (unsigned)__builtin_amdgcn_readlane((int)gp, 8);
        cw[2] = (unsigned)__builtin_amdgcn_readlane((int)gp, 16); cw[6] = (unsigned)__builtin_amdgcn_readlane((int)gp, 24);
        cw[1] = (unsigned)__builtin_amdgcn_readlane((int)gp, 32); cw[5] = (unsigned)__builtin_amdgcn_readlane((int)gp, 40);
        cw[3] = (unsigned)__builtin_amdgcn_readlane((int)gp, 48); cw[7] = (unsigned)__builtin_amdgcn_readlane((int)gp, 56); }
      h16x2 a16[8];
#pragma unroll
      for (int i2 = 0; i2 < 4; ++i2) {
        const h16x32 r = __builtin_amdgcn_cvt_scalef32_pk32_f16_fp6(rp.vq[i2], 1.0f);
        const h16x2 ca = __builtin_bit_cast(h16x2, cw[2 * i2]), cb = __builtin_bit_cast(h16x2, cw[2 * i2 + 1]);
#define VAXL(k_) a16[k_] = (i2 == 0) ? ca * __builtin_shufflevector(r, r, 2 * (k_), 2 * (k_) + 1) : ca * __builtin_shufflevector(r, r, 2 * (k_), 2 * (k_) + 1) + a16[k_];
#define VAXH(k_) a16[k_] = cb * __builtin_shufflevector(r, r, 16 + 2 * (k_), 17 + 2 * (k_)) + a16[k_];
        VAXL(0) VAXL(1) VAXL(2) VAXL(3) VAXL(4) VAXL(5) VAXL(6) VAXL(7)
        asm volatile("" : "+v"(a16[0]), "+v"(a16[1]), "+v"(a16[2]), "+v"(a16[3]), "+v"(a16[4]), "+v"(a16[5]), "+v"(a16[6]), "+v"(a16[7]));
        VAXH(0) VAXH(1) VAXH(2) VAXH(3) VAXH(4) VAXH(5) VAXH(6) VAXH(7)
#undef VAXL
#undef VAXH
        asm volatile("" : "+v"(a16[0]), "+v"(a16[1]), "+v"(a16[2]), "+v"(a16[3]), "+v"(a16[4]), "+v"(a16[5]), "+v"(a16[6]), "+v"(a16[7]));
      }
#pragma unroll
      for (int k = 0; k < 8; ++k) acc2[k] = f32x2{(float)a16[k].x, (float)a16[k].y} * f32x2{1.f / 1024.f, 1.f / 1024.f} + acc2[k];
      if (pf) LOADGROUP(rp.vq, VOFS, rp.Ec);
      { const CAS i32x8* src_ = g8 < 14 ? EP + (g8 + 2) : EPn + (g8 - 14); rp.Ec = *src_; }
    }
    SBAR();
    float acc[16];
#pragma unroll
    for (int i = 0; i < 8; ++i) { acc[2 * i] = acc2[i].x; acc[2 * i + 1] = acc2[i].y; }
    float* xr = XC + (size_t)row * DM;
    float xn[16]; float ssq = 0.f;
    if (ABL & 8) {
#pragma unroll
      for (int i = 0; i < 16; ++i) acc[i] = 0.f;
    }
#pragma unroll
    for (int v4 = 0; v4 < 4; ++v4) {
      const int c = lane * 4 + v4 * 256;
      const f32x4 xo = xpre[v4], gg = ev.g2[v4];
      f32x4 o;
      o.x = xo.x + gg.x * acc[v4 * 4 + 0]; o.y = xo.y + gg.y * acc[v4 * 4 + 1]; o.z = xo.z + gg.z * acc[v4 * 4 + 2]; o.w = xo.w + gg.w * acc[v4 * 4 + 3];
      xn[v4 * 4 + 0] = o.x; xn[v4 * 4 + 1] = o.y; xn[v4 * 4 + 2] = o.z; xn[v4 * 4 + 3] = o.w;
      ssq += (o.x * o.x + o.y * o.y) + (o.z * o.z + o.w * o.w);
      if (l < DEPTH - 1) *(f32x4*)(xr + c) = o;
    }
    const float rs = rsqrtf(wave_sum_fast(ssq) * (1.f / DM) + EPS);
    if (l == DEPTH - 1) {
      const int b = row / SEGL, s = row - b * SEGL;
      float* orow = p.out + ((size_t)(b * SEQ + (s - CTXL))) * DM;
#pragma unroll
      for (int v4 = 0; v4 < 4; ++v4) {
        const int c = lane * 4 + v4 * 256;
        const f32x4 gg = ev.ng[v4];
        f32x4 o; o.x = xn[v4 * 4 + 0] * rs * gg.x; o.y = xn[v4 * 4 + 1] * rs * gg.y; o.z = xn[v4 * 4 + 2] * rs * gg.z; o.w = xn[v4 * 4 + 3] * rs * gg.w;
        *(f32x4*)(orow + c) = o;
      }
    } else {
      bf16_t* hrow = (bf16_t*)(p.ws + WS_H) + (size_t)row * DM;
#pragma unroll
      for (int v4 = 0; v4 < 4; ++v4) {
        float y[4];
#pragma unroll
        for (int i = 0; i < 4; ++i) y[i] = xn[v4 * 4 + i] * rs * ev.ng[v4][i] * (1.f + ev.sc[v4][i]) + ev.sh[v4][i];
        *(u32x2*)(hrow + lane * 4 + v4 * 256) = (u32x2){cvtpk(y[0], y[1]), cvtpk(y[2], y[3])};
        int w8 = 0; w8 = __builtin_amdgcn_cvt_pk_fp8_f32(y[0], y[1], w8, false); w8 = __builtin_amdgcn_cvt_pk_fp8_f32(y[2], y[3], w8, true);
        *(int*)(p.ws + WS_H8 + (size_t)row * DM + lane * 4 + v4 * 256) = w8;
      }
    }
  }
}

__device__ __forceinline__ void ev_signal(unsigned* ctr) {
  asm volatile("s_waitcnt vmcnt(0)" ::: "memory");
  __syncthreads();
  if (tidx() == 0) { __builtin_amdgcn_fence(__ATOMIC_RELEASE, "agent"); asm volatile("s_waitcnt vmcnt(0)" ::: "memory"); (void)xb_add(ctr, 1u); }
}
__device__ __forceinline__ void ev_wait(unsigned* ctr, unsigned n, unsigned* bar) {
  if (tidx() == 0) {
    XB_SPIN(xb_ld(ctr) < n, bar);
    __builtin_amdgcn_fence(__ATOMIC_ACQUIRE, "agent");
    asm volatile("s_waitcnt vmcnt(0)" ::: "memory");
  }
  __syncthreads();
}
constexpr int EV_WORD0 = 8192;
__device__ __forceinline__ void phase_c1(const Params& p, int l, unsigned char* lds) {
  constexpr int NLOC = NBATCH * 4 * NCH, NCONV = T / 32;
  for (int u = p.bx; u < NLOC + NCONV; u += p.gx) {
    if (u < NLOC) ml_local_unit2(p, l, u, lds);
    else {
      const int cu = u - NLOC;
      if (l == DEPTH - 1 && (cu % (SEGL / 32)) < (CTXL / 32)) continue;
      conv_unit(p, l, cu, lds);
    }
  }
}
__device__ __forceinline__ void phase_c3(const Params& p, int l, unsigned char* lds);
__device__ __forceinline__ void phase_c2(const Params& p, int l, unsigned char* lds) {
  unsigned* ev = (unsigned*)(p.ws + WS_CTL) + EV_WORD0 + 64 * l;
  ml_scan(p, lds);
  ev_signal(ev);
  const float* lp = p.in[I_DLAM] + l * 256;
  float s01 = 0.f, s23 = 0.f;
  for (int i = 0; i < 64; ++i) { s01 += lp[i] * lp[64 + i]; s23 += lp[128 + i] * lp[192 + i]; }
  const float lam_init = 0.8f - 0.6f * expf(-0.3f * (float)l);
  const float lam = __uint_as_float((unsigned)__builtin_amdgcn_readfirstlane((int)__float_as_uint(expf(s01) - expf(s23) + lam_init)));
  const bf16_t* PROJ = (const bf16_t*)(p.ws + WS_PROJ);
  bf16_t* MIX = (bf16_t*)(p.ws + WS_MIX);
  const float* ng = p.in[I_DNORMG] + l * 128;
  const int nun = 512 + (l < DEPTH - 1 ? 16 : 0);
  for (int u = p.bx; u < nun; u += p.gx) {
    int bh, qrow, nkeys;
    if (u < 512) { const int xcd = u & 7, i = (u >> 3) & 31, rnd = u >> 8; bh = 2 * xcd + rnd; qrow = CTXL + i * 256; nkeys = SEGL; }
    else { bh = u - 512; qrow = 0; nkeys = CTXL; }
    const int b = bh >> 2, h = bh & 3;
    const size_t tok0 = (size_t)b * SEGL;
    for (int rep = 0; rep < REP_ATT; ++rep)
    att_unit(p.ws + WS_QK8 + ((size_t)bh * SEGL + qrow) * QK8_PITCH, p.ws + WS_QK8 + QK8_IMG + (size_t)bh * SEGL * QK8_PITCH, p.ws + WS_V8T + (size_t)bh * NCH * ATT_SHM_V,
             MIX + (tok0 + qrow) * DM + 512 + h * 128, nkeys, lam, ng, 1.f - lam_init, lds);
  }
  ev_wait(ev, (unsigned)p.gx, p.xbar_words);
  for (int rep = 0; rep < REP_ML; ++rep) phase_c3(p, l, lds);
}
__device__ __forceinline__ void phase_c3(const Params& p, int l, unsigned char* lds) {
  constexpr int NU = NBATCH * 4 * NCH;
  const int nlow = (p.gx > 64 && l < DEPTH - 1) ? 16 : 0, ulow = nlow * 7;
  int u, step;
  if (p.bx < nlow) { u = p.bx; step = nlow; } else { u = ulow + (p.bx - nlow); step = p.gx - nlow; }
  const int uend = p.bx < nlow ? ulow : NU;
  int tid_ = tidx(); asm volatile("" : "+v"(tid_));
  auto valid_from = [&](int v) { while (v < uend && l == DEPTH - 1 && (v % NCH) < 4) v += step; return v < uend ? v : -1; };
  MlOutPf fa, fb;
  u = valid_from(u);
  if (u >= 0) ml_out_fetch(p, u, tid_, fa);
  while (u >= 0) {
    const int nx = valid_from(u + step);
    ml_out_unit2(p, l, u, lds, fa, nx, fb);
    fa = fb; u = nx;
  }
}
__device__ __forceinline__ void phase_route(const Params& p, int l, unsigned char* lds) {
  constexpr int NU = T / 32;
  for (int u = p.bx; u < NU; u += p.gx) {
    if (l == DEPTH - 1 && (u % (SEGL / 32)) < (CTXL / 32)) continue;
    route_unit(p, l, u, lds);
    __syncthreads();
  }
}
__device__ __forceinline__ void phase_gather(const Params& p, int l, unsigned char* lds) {
  int tid_ = tidx(); asm volatile("" : "+v"(tid_)); const int lane = tid_ & 63, wid = __builtin_amdgcn_readfirstlane(tid_ >> 6);
  const int gw = p.bx * 8 + wid, NGW = p.gx * 8;
  const int ntok = (l == DEPTH - 1) ? NBATCH * SEQ : T;
#define TOKROW(ti_) ((l == DEPTH - 1) ? ((ti_) / SEQ) * SEGL + CTXL + ((ti_) % SEQ) : (ti_))
  const CAS unsigned char* eidg = (const CAS unsigned char*)(p.ws + WS_EID + (size_t)l * RT_STRIDE);
  const __amdgpu_buffer_rsrc_t rsT = __builtin_amdgcn_make_buffer_rsrc((void*)(p.ws + WS_PU + (size_t)l * NEXP * PROW), 0, VOFS + NEXP * PROW, 0x00020000);
  const int nfull = ntok / NGW, rem = ntok - nfull * NGW, per = (rem % p.gx == 0) ? rem / p.gx : -1;
  auto tok_at = [&](int r) -> int {
    if (r < nfull) return gw + r * NGW;
    if (r > nfull || rem == 0) return -1;
    if (per >= 0) return wid < per ? nfull * NGW + p.bx * per + wid : -1;
    return gw + r * NGW < ntok ? gw + r * NGW : -1;
  };
  TokPref tp; RowPipe rp; EpiVec ev; ev.mr = -1;
  const int ti0 = tok_at(0);
  if (ti0 >= 0) {
    const int row0 = TOKROW(ti0); const int lane12 = lane * 12;
    tok_prefetch(p, row0, lane, tp);
    const CAS i32x8* EP0 = eid_row(eidg, row0);
    rp.Ec = EP0[0];
    LOADGROUP(rp.uq, 0, rp.Ec); LOADGROUP(rp.vq, VOFS, rp.Ec);
    rp.Ec = EP0[1];
  }
  XcdBarrier xb; xb.bar = p.xbar_words; xb.x = p.xbar_x; xb.st = (volatile LAS unsigned*)((LAS unsigned char*)lds + p.lds_st_off);
  const int nrounds = (ntok + NGW - 1) / NGW;
  for (int r = 0; r < nrounds; ++r) {
    const int ti = tok_at(r);
    if (ti >= 0) {
      const int row = TOKROW(ti);
      const int tn = tok_at(r + 1);
      const int nxt = tn >= 0 ? TOKROW(tn) : -1;
      gather_token(p, eidg, rsT, l, row, nxt, tp, rp, ev, lds, lane, wid);
    }
#if GATHER_SYNC
    if (r + 1 < nrounds) { XcdBarrier xb2 = xb; size_t zb_ = 0; asm volatile("" : "+s"(zb_)); xb2.bar = xb.bar + zb_; xb2.x = xb.x + (unsigned)zb_; xcd_barrier(xb2); }
#endif
  }
#undef TOKROW
}

__global__ void __launch_bounds__(512, 2) mk_fwd(KArgs ka) {
  cg::grid_group grid = cg::this_grid();
  extern __shared__ __attribute__((aligned(16))) unsigned char lds[];
  const int lo = ka.ph_lo, hi = ka.ph_hi;
#define IN(k) (lo <= (k) && (k) < hi)
#ifndef PHASEMASK
#define PHASEMASK 0xFFFF
#endif
#define PH(i) ((PHASEMASK >> (i)) & 1)
#define MKP(q) Params q; { size_t z_ = 0; asm volatile("" : "+s"(z_)); \
    q.in = (InTab)((const __attribute__((address_space(4))) char*)__builtin_amdgcn_kernarg_segment_ptr() + z_); \
    q.out = ka.out + z_; q.ws = ka.ws + z_; q.ph_lo = lo; q.ph_hi = hi; q.bx = (int)blockIdx.x + (int)z_; q.gx = (int)gridDim.x + (int)z_; q.xbar_words = xbar.bar + z_; q.xbar_x = xbar.x + (unsigned)z_; q.lds_st_off = (unsigned)(LDS_BYTES - 64); }
#define SEAM(k) do { if (IN(k) && IN((k) + 1)) { if ((k) == 0) grid.sync(); else { XcdBarrier xb_ = xbar; size_t zb_ = 0; asm volatile("" : "+s"(zb_)); xb_.bar = xbar.bar + zb_; xb_.x = xbar.x + (unsigned)zb_; xcd_barrier(xb_); } } } while (0)
  volatile LAS unsigned* xst = (volatile LAS unsigned*)((LAS unsigned char*)lds + (LDS_BYTES - 64));
  { const int t0_ = threadIdx.x;
    if (t0_ < 2) xst[t0_] = 0u;
    if ((t0_ & 63) == 0) *(volatile LAS int*)((LAS unsigned char*)lds + LDS_WTAB + 4 * hw_wave_key()) = t0_ >> 6; }
  __syncthreads();
  XcdBarrier xbar = xcd_barrier_post((unsigned*)(ka.ws + WS_CTL) + 4096, xst);
  { MKP(p)
    if (PH(0) && IN(0)) for (int rep = 0; rep < REP_MISC; ++rep) { p0_mod(p, lds, (float*)(p.ws + WS_MOD)); p0_convert(p, lds); }
  }
  SEAM(0);
  { MKP(p)
    if (PH(1) && IN(1)) phase_norm(p, 0, 0, true, false);
  }
  SEAM(1);
#define LAYER(LL) { \
    int l = (LL); asm volatile("" : "+s"(l)); \
    const int b = 2 + 9 * (LL); \
    { MKP(q) if (PH(2) && IN(b + 0)) for (int rep = 0; rep < REP_GEMM; ++rep) phase_inproj2(q, l, lds); } \
    SEAM(b + 0); \
    { MKP(q) if (PH(3) && IN(b + 1)) for (int rep = 0; rep < REP_ML; ++rep) phase_c1(q, l, lds); } \
    SEAM(b + 1); \
    { MKP(q) if (PH(4) && IN(b + 2)) phase_c2(q, l, lds); } \
    SEAM(b + 3); \
    { MKP(q) if (PH(6) && IN(b + 4)) phase_outproj2(q, l, lds); } \
    SEAM(b + 4); \
    { MKP(q) if (PH(7) && IN(b + 5)) for (int rep = 0; rep < REP_MISC; ++rep) phase_norm(q, l, 1, false, (LL) == DEPTH - 1); } \
    SEAM(b + 5); \
    { MKP(q) if (PH(8) && IN(b + 6)) for (int rep = 0; rep < REP_GEMM; ++rep) phase_peerq2(q, l, lds); } \
    SEAM(b + 6); \
    { MKP(q) if (PH(9) && IN(b + 7)) phase_route(q, l, lds); } \
    SEAM(b + 7); \
    { MKP(q) if (PH(9) && IN(b + 8)) phase_gather(q, l, lds); } \
    SEAM(b + 8); }
  LAYER(0) LAYER(1) LAYER(2) LAYER(3)
#undef LAYER
#undef IN
#undef SEAM
#undef MKP
}

extern "C" void kernel_launch(void* const* d_in, const int* in_sizes, int n_in, void* d_out, int out_size,
                              void* d_ws, size_t ws_size, hipStream_t stream) {
  static int grid = 0;
  if (grid == 0) {
    int dev = 0, cus = 0, per_cu = 0;
    (void)hipGetDevice(&dev);
    (void)hipDeviceGetAttribute(&cus, hipDeviceAttributeMultiprocessorCount, dev);
    (void)hipFuncSetAttribute((const void*)mk_fwd, hipFuncAttributeMaxDynamicSharedMemorySize, LDS_BYTES);
    (void)hipOccupancyMaxActiveBlocksPerMultiprocessor(&per_cu, (const void*)mk_fwd, 512, LDS_BYTES);
    fprintf(stderr, "kernel_launch: cus %d per_cu %d ws %zu (need %zu) n_in %d\n", cus, per_cu, ws_size, (size_t)WS_END, n_in);
    if (ws_size < WS_END || n_in != 23 || per_cu < 1) { fprintf(stderr, "kernel_launch: bad configuration, nothing launched\n"); grid = -1; return; }
    grid = cus;
  }
  if (grid < 0) return;
  (void)hipMemsetAsync((char*)d_ws + WS_CTL, 0, 65536, stream);
  KArgs p{};
  for (int i = 0; i < 23; ++i) p.in[i] = (const float*)d_in[i];
  p.out = (float*)d_out; p.ws = (unsigned char*)d_ws; p.ph_lo = 0; p.ph_hi = 38;
  void* args[] = {&p};
  hipError_t e = hipLaunchCooperativeKernel((const void*)mk_fwd, dim3(grid), dim3(512), args, LDS_BYTES, stream);
  if (e != hipSuccess) fprintf(stderr, "cooperative launch failed: %s (grid %d)\n", hipGetErrorString(e), grid);
}
```
